# Optimizing an MI355X kernel written in HIP

```python
import math
import jax
import jax.numpy as jnp
from jax import lax
import numpy as np

D_MODEL = 1024
BATCH = 16
SEQ = 2048
DEPTH = 2

MIX_DIM = D_MODEL
HEAD_DIM = 64
RWKV_DIM = MIX_DIM // 2
RWKV_HEADS = RWKV_DIM // HEAD_DIM
RWKV_DECAY_LORA = 64
RWKV_A_LORA = 64
RWKV_GATE_LORA = 128
RWKV_GN_EPS = 64e-5
RWKV_COLS = 3 * RWKV_DIM + RWKV_DECAY_LORA + RWKV_A_LORA + RWKV_GATE_LORA
SSM_DIM = MIX_DIM // 2
SSM_HEAD_DIM = 64
SSM_HEADS = SSM_DIM // SSM_HEAD_DIM
SSM_GROUPS = 2
SSM_STATE = 128
SSM_CONV = 4
SSM_CHUNK = 128
SSM_XBC = SSM_DIM + 2 * SSM_GROUPS * SSM_STATE
SSM_COLS = SSM_DIM + SSM_XBC + SSM_HEADS
L0_COLS = RWKV_COLS + SSM_COLS
SB_DIM = MIX_DIM // 2
SB_HEADS = SB_DIM // HEAD_DIM
MLA_NOPE = 64
MLA_ROPE = 32
MLA_V = 64
MLA_HEADS = (MIX_DIM // 2) // MLA_V
MLA_Q_LORA = 256
MLA_KV_LORA = 128
ROPE_THETA = 10000.0
L1_COLS = 3 * SB_DIM + MLA_Q_LORA + MLA_KV_LORA + MLA_ROPE
Q_BLOCK = 128
D_FF = 2816
FFN_CONV = 3
ALPHA = (2 * DEPTH) ** 0.25
BETA = (8 * DEPTH) ** -0.25

kernel_name = 'hybrid_rwkv7_ssd_stickbreak_mla_convffn'


def _layer_norm(x, g, b, eps=1e-5):
    xf = x.astype(jnp.float32)
    mu = jnp.mean(xf, axis=-1, keepdims=True)
    var = jnp.mean(jnp.square(xf - mu), axis=-1, keepdims=True)
    return ((xf - mu) * lax.rsqrt(var + eps) * g + b).astype(x.dtype)


def _rms_norm(x, g, eps=1e-6):
    xf = x.astype(jnp.float32)
    return (xf * lax.rsqrt(jnp.mean(xf * xf, axis=-1, keepdims=True) + eps) * g).astype(x.dtype)


def _causal_dwconv(u, w, b):
    K = w.shape[0]
    T = u.shape[1]
    up = jnp.pad(u, ((0, 0), (K - 1, 0), (0, 0)))
    y = b + up[:, 0:T] * w[0]
    for i in range(1, K):
        y = y + up[:, i:i + T] * w[i]
    return y


def _to_heads(t, n):
    return t.reshape(t.shape[0], t.shape[1], n, -1)


def _rwkv7_scan(r, w, k, v, a, b):
    bsz, T, H, N = r.shape

    def step(S, inp):
        r_t, w_t, k_t, v_t, a_t, b_t = inp
        sa = jnp.einsum('bhij,bhj->bhi', S, a_t)
        S = S * w_t[:, :, None, :] + sa[..., None] * b_t[:, :, None, :] + v_t[..., None] * k_t[:, :, None, :]
        return S, jnp.einsum('bhij,bhj->bhi', S, r_t)

    xs = tuple(jnp.swapaxes(t, 0, 1) for t in (r, w, k, v, a, b))
    _, y = lax.scan(step, jnp.zeros((bsz, H, N, N), jnp.float32), xs)
    return jnp.swapaxes(y, 0, 1)


def _rwkv7_group(p, mix, w0, w2, a0, a2, g2, k_k, k_a, r_k, ln_g, ln_b):
    bsz, T, _ = p.shape
    prev = jnp.pad(p, ((0, 0), (1, 0), (0, 0)))[:, :-1]
    p = p + (prev - p) * mix
    cuts = [RWKV_DIM, 2 * RWKV_DIM, 3 * RWKV_DIM, 3 * RWKV_DIM + RWKV_DECAY_LORA,
            3 * RWKV_DIM + RWKV_DECAY_LORA + RWKV_A_LORA]
    r, k, v, w_lo, a_lo, g_lo = jnp.split(p, cuts, axis=-1)
    log_w = -jax.nn.softplus(-(w0 + jnp.tanh(w_lo) @ w2)) - 0.5
    decay = jnp.exp(-jnp.exp(log_w.astype(jnp.float32)))
    a = jax.nn.sigmoid(a0 + a_lo @ a2)
    g = jax.nn.sigmoid(g_lo) @ g2
    kk = _to_heads(k * k_k, RWKV_HEADS).astype(jnp.float32)
    kk = kk / jnp.maximum(jnp.sqrt(jnp.sum(kk * kk, axis=-1, keepdims=True)), 1e-12)
    k = k * (1 + (a - 1) * k_a)
    r_h, k_h, v_h, a_h, w_h = [_to_heads(t, RWKV_HEADS).astype(jnp.float32) for t in (r, k, v, a, decay)]
    y = _rwkv7_scan(r_h, w_h, k_h, v_h, -kk, kk * a_h)
    mu = jnp.mean(y, axis=-1, keepdims=True)
    var = jnp.mean(jnp.square(y - mu), axis=-1, keepdims=True)
    y = ((y - mu) * lax.rsqrt(var + RWKV_GN_EPS)).reshape(bsz, T, RWKV_DIM) * ln_g + ln_b
    bonus = jnp.sum(r_h * k_h * r_k, axis=-1, keepdims=True) * v_h
    return ((y + bonus.reshape(bsz, T, RWKV_DIM)) * g).astype(p.dtype)


def _segsum(a):
    L = a.shape[-1]
    ar = jnp.broadcast_to(a[..., :, None], a.shape + (L,))
    strict = jnp.tril(jnp.ones((L, L), bool), -1)
    s = jnp.cumsum(jnp.where(strict, ar, 0.0), axis=-2)
    return jnp.where(jnp.tril(jnp.ones((L, L), bool)), s, -jnp.inf)


def _ssd_chunked(xs, dt, A, Bm, Cm):
    bsz, T, H, P = xs.shape
    G, N = Bm.shape[2], Bm.shape[3]
    J = H // G
    c, l = T // SSM_CHUNK, SSM_CHUNK
    X = (xs * dt[..., None]).reshape(bsz, c, l, G, J, P)
    a_dt = (dt * A).reshape(bsz, c, l, G, J).transpose(0, 3, 4, 1, 2)
    Bc = Bm.reshape(bsz, c, l, G, N)
    Cc = Cm.reshape(bsz, c, l, G, N)
    a_cum = jnp.cumsum(a_dt, axis=-1)
    decay_in = jnp.exp(_segsum(a_dt))
    cb = jnp.einsum('bclgn,bcsgn->bgcls', Cc, Bc)
    y_diag = jnp.einsum('bgjcls,bcsgjp->bclgjp', cb[:, :, None] * decay_in, X)
    decay_to_end = jnp.exp(a_cum[..., -1:] - a_cum)
    states = jnp.einsum('bclgn,bgjcl,bclgjp->bcgjpn', Bc, decay_to_end, X)
    states = jnp.concatenate([jnp.zeros_like(states[:, :1]), states], axis=1)
    chunk_decay = jnp.exp(_segsum(jnp.pad(a_cum[..., -1], ((0, 0), (0, 0), (0, 0), (1, 0)))))
    states = jnp.einsum('bgjzc,bcgjpn->bzgjpn', chunk_decay, states)[:, :-1]
    y_off = jnp.einsum('bclgn,bcgjpn,bgjcl->bclgjp', Cc, states, jnp.exp(a_cum))
    return (y_diag + y_off).reshape(bsz, T, H, P)


def _mamba2_group(p, conv_w, conv_b, dt_bias, a_log, d_skip, norm_g):
    bsz, T, _ = p.shape
    z, xbc, dt_raw = jnp.split(p, [SSM_DIM, SSM_DIM + SSM_XBC], axis=-1)
    xbc = jax.nn.silu(_causal_dwconv(xbc, conv_w, conv_b))
    xs, Bm, Cm = jnp.split(xbc, [SSM_DIM, SSM_DIM + SSM_GROUPS * SSM_STATE], axis=-1)
    xs = xs.reshape(bsz, T, SSM_HEADS, SSM_HEAD_DIM).astype(jnp.float32)
    Bm = Bm.reshape(bsz, T, SSM_GROUPS, SSM_STATE).astype(jnp.float32)
    Cm = Cm.reshape(bsz, T, SSM_GROUPS, SSM_STATE).astype(jnp.float32)
    dt = jax.nn.softplus((dt_raw + dt_bias).astype(jnp.float32))
    A = -jnp.exp(a_log.astype(jnp.float32))
    y = _ssd_chunked(xs, dt, A, Bm, Cm) + xs * d_skip[:, None]
    u = (y.reshape(bsz, T, SSM_DIM) * jax.nn.silu(z.astype(jnp.float32))).reshape(bsz, T, SSM_GROUPS, -1)
    u = u * lax.rsqrt(jnp.mean(u * u, axis=-1, keepdims=True) + 1e-5)
    return (u.reshape(bsz, T, SSM_DIM) * norm_g).astype(p.dtype)


def _mixer_rwkv_ssd(h, w_in, mix, w0, w2, a0, a2, g2, k_k, k_a, r_k, ln_g, ln_b,
                    conv_w, conv_b, dt_bias, a_log, d_skip, norm_g, w_out):
    proj = h @ w_in
    y_a = _rwkv7_group(proj[..., :RWKV_COLS], mix, w0, w2, a0, a2, g2, k_k, k_a, r_k, ln_g, ln_b)
    y_b = _mamba2_group(proj[..., RWKV_COLS:], conv_w, conv_b, dt_bias, a_log, d_skip, norm_g)
    return jnp.concatenate([y_a, y_b], axis=-1) @ w_out


def _stick_breaking(q, k, v):
    T = q.shape[2]
    scale = q.shape[-1] ** -0.5
    outs = []
    for start in range(0, T, Q_BLOCK):
        end = start + Q_BLOCK
        z = jnp.einsum('bhqd,bhkd->bhqk', q[:, :, start:end], k[:, :, :end]).astype(jnp.float32) * scale
        strict = jnp.arange(end)[None, :] < jnp.arange(start, end)[:, None]
        log_keep = jnp.where(strict, jax.nn.log_sigmoid(-z), 0.0)
        log_att = jax.nn.log_sigmoid(z) + lax.cumsum(log_keep, axis=3, reverse=True) - log_keep
        att = jnp.where(strict, jnp.exp(log_att), 0.0)
        outs.append(jnp.einsum('bhqk,bhkd->bhqd', att.astype(v.dtype), v[:, :, :end]))
    return jnp.concatenate(outs, axis=2)


def _rope_tables(positions):
    inv_freq = 1.0 / (ROPE_THETA ** (jnp.arange(0, MLA_ROPE, 2, dtype=jnp.float32) / MLA_ROPE))
    ang = positions.astype(jnp.float32)[..., None] * inv_freq
    return jnp.cos(ang), jnp.sin(ang)


def _apply_rope(x, cos, sin):
    half = x.shape[-1] // 2
    x1, x2 = x[..., :half], x[..., half:]
    return jnp.concatenate([x1 * cos - x2 * sin, x2 * cos + x1 * sin], axis=-1)


def _mla_attention(q_nope, q_pe, k_nope, k_pe, v):
    T = q_nope.shape[2]
    scale = (MLA_NOPE + MLA_ROPE) ** -0.5
    outs = []
    for start in range(0, T, Q_BLOCK):
        end = start + Q_BLOCK
        s = (jnp.einsum('bhqd,bhkd->bhqk', q_nope[:, :, start:end], k_nope[:, :, :end])
             + jnp.einsum('bhqd,bkd->bhqk', q_pe[:, :, start:end], k_pe[:, :end])).astype(jnp.float32) * scale
        causal = jnp.arange(end)[None, :] <= jnp.arange(start, end)[:, None]
        prob = jax.nn.softmax(jnp.where(causal, s, -jnp.inf), axis=-1)
        outs.append(jnp.einsum('bhqk,bhkd->bhqd', prob.astype(v.dtype), v[:, :, :end]))
    return jnp.concatenate(outs, axis=2)


def _mixer_sb_mla(h, positions, w_in, q_norm_g, w_uq, kv_norm_g, w_ukv, w_out):
    bsz, T, _ = h.shape
    proj = h @ w_in
    cuts = [SB_DIM, 2 * SB_DIM, 3 * SB_DIM, 3 * SB_DIM + MLA_Q_LORA, 3 * SB_DIM + MLA_Q_LORA + MLA_KV_LORA]
    q_sb, k_sb, v_sb, c_q, c_kv, k_pe = jnp.split(proj, cuts, axis=-1)
    tr = lambda t: t.transpose(0, 2, 1, 3)
    y_c = _stick_breaking(tr(_to_heads(q_sb, SB_HEADS)), tr(_to_heads(k_sb, SB_HEADS)), tr(_to_heads(v_sb, SB_HEADS)))
    y_c = tr(y_c).reshape(bsz, T, SB_DIM)
    q = _to_heads(_rms_norm(c_q, q_norm_g) @ w_uq, MLA_HEADS)
    kv = _to_heads(_rms_norm(c_kv, kv_norm_g) @ w_ukv, MLA_HEADS)
    cos, sin = _rope_tables(positions)
    q_pe = _apply_rope(q[..., MLA_NOPE:], cos[:, :, None], sin[:, :, None])
    k_pe = _apply_rope(k_pe, cos, sin)
    y_d = _mla_attention(tr(q[..., :MLA_NOPE]), tr(q_pe), tr(kv[..., :MLA_NOPE]), k_pe, tr(kv[..., MLA_NOPE:]))
    y_d = tr(y_d).reshape(bsz, T, MLA_HEADS * MLA_V)
    return jnp.concatenate([y_c, y_d.astype(y_c.dtype)], axis=-1) @ w_out


def _conv_ffn(h, w_up, conv_w, conv_b, w_down):
    gate, up = jnp.split(h @ w_up, [D_FF], axis=-1)
    gate = _causal_dwconv(gate, conv_w, conv_b)
    return (jax.nn.silu(gate) * up) @ w_down


def setup_inputs(seed: int = 0) -> dict:
    key = jax.random.key(seed)
    ks = iter(jax.random.split(key, 64))

    def nrm(shape, scale):
        return jax.random.normal(next(ks), shape, jnp.float32) * scale

    def uni(shape, lo, hi):
        return jax.random.uniform(next(ks), shape, jnp.float32, lo, hi)

    def gain(n):
        return 1.0 + nrm((n,), 0.02)

    inp = {}
    inp['x'] = nrm((BATCH, SEQ, D_MODEL), 1.0)
    inp['positions'] = (jax.random.randint(next(ks), (BATCH, 1), 0, 4096, dtype=jnp.int32)
                        + jnp.arange(SEQ, dtype=jnp.int32)[None, :])
    inp['l0_w_in'] = nrm((D_MODEL, L0_COLS), D_MODEL ** -0.5)
    inp['rwkv_mix'] = uni((RWKV_COLS,), 0.0, 1.0)
    inp['rwkv_w0'] = uni((RWKV_DIM,), -6.0, -1.0)
    inp['rwkv_w2'] = nrm((RWKV_DECAY_LORA, RWKV_DIM), 0.1)
    inp['rwkv_a0'] = nrm((RWKV_DIM,), 0.1)
    inp['rwkv_a2'] = nrm((RWKV_A_LORA, RWKV_DIM), 0.1)
    inp['rwkv_g2'] = nrm((RWKV_GATE_LORA, RWKV_DIM), RWKV_GATE_LORA ** -0.5)
    inp['rwkv_k_k'] = 0.85 + nrm((RWKV_DIM,), 0.05)
    inp['rwkv_k_a'] = 1.0 + nrm((RWKV_DIM,), 0.05)
    inp['rwkv_r_k'] = nrm((RWKV_HEADS, HEAD_DIM), 0.1)
    inp['rwkv_ln_g'] = gain(RWKV_DIM)
    inp['rwkv_ln_b'] = nrm((RWKV_DIM,), 0.02)
    inp['ssm_conv_w'] = nrm((SSM_CONV, SSM_XBC), 0.5)
    inp['ssm_conv_b'] = nrm((SSM_XBC,), 0.02)
    dt0 = jnp.exp(uni((SSM_HEADS,), math.log(1e-3), math.log(1e-1)))
    inp['ssm_dt_bias'] = dt0 + jnp.log(-jnp.expm1(-dt0))
    inp['ssm_a_log'] = jnp.log(uni((SSM_HEADS,), 1.0, 16.0))
    inp['ssm_d'] = 1.0 + nrm((SSM_HEADS,), 0.1)
    inp['ssm_norm_g'] = gain(SSM_DIM)
    inp['l0_w_out'] = nrm((MIX_DIM, D_MODEL), MIX_DIM ** -0.5 * BETA)
    inp['l0_ln1_g'] = gain(D_MODEL)
    inp['l0_ln1_b'] = nrm((D_MODEL,), 0.02)
    inp['ffn0_w_up'] = nrm((D_MODEL, 2 * D_FF), D_MODEL ** -0.5)
    inp['ffn0_conv_w'] = nrm((FFN_CONV, D_FF), FFN_CONV ** -0.5)
    inp['ffn0_conv_b'] = nrm((D_FF,), 0.02)
    inp['ffn0_w_down'] = nrm((D_FF, D_MODEL), D_FF ** -0.5 * BETA)
    inp['l0_ln2_g'] = gain(D_MODEL)
    inp['l0_ln2_b'] = nrm((D_MODEL,), 0.02)
    inp['l1_w_in'] = nrm((D_MODEL, L1_COLS), D_MODEL ** -0.5)
    inp['mla_q_norm_g'] = gain(MLA_Q_LORA)
    inp['mla_w_uq'] = nrm((MLA_Q_LORA, MLA_HEADS * (MLA_NOPE + MLA_ROPE)), MLA_Q_LORA ** -0.5)
    inp['mla_kv_norm_g'] = gain(MLA_KV_LORA)
    inp['mla_w_ukv'] = nrm((MLA_KV_LORA, MLA_HEADS * (MLA_NOPE + MLA_V)), MLA_KV_LORA ** -0.5)
    inp['l1_w_out'] = nrm((MIX_DIM, D_MODEL), MIX_DIM ** -0.5 * BETA)
    inp['l1_ln1_g'] = gain(D_MODEL)
    inp['l1_ln1_b'] = nrm((D_MODEL,), 0.02)
    inp['ffn1_w_up'] = nrm((D_MODEL, 2 * D_FF), D_MODEL ** -0.5)
    inp['ffn1_conv_w'] = nrm((FFN_CONV, D_FF), FFN_CONV ** -0.5)
    inp['ffn1_conv_b'] = nrm((D_FF,), 0.02)
    inp['ffn1_w_down'] = nrm((D_FF, D_MODEL), D_FF ** -0.5 * BETA)
    inp['l1_ln2_g'] = gain(D_MODEL)
    inp['l1_ln2_b'] = nrm((D_MODEL,), 0.02)
    return inp


def reference(x, positions, l0_w_in, rwkv_mix, rwkv_w0, rwkv_w2, rwkv_a0, rwkv_a2, rwkv_g2,
              rwkv_k_k, rwkv_k_a, rwkv_r_k, rwkv_ln_g, rwkv_ln_b, ssm_conv_w, ssm_conv_b,
              ssm_dt_bias, ssm_a_log, ssm_d, ssm_norm_g, l0_w_out, l0_ln1_g, l0_ln1_b,
              ffn0_w_up, ffn0_conv_w, ffn0_conv_b, ffn0_w_down, l0_ln2_g, l0_ln2_b,
              l1_w_in, mla_q_norm_g, mla_w_uq, mla_kv_norm_g, mla_w_ukv, l1_w_out,
              l1_ln1_g, l1_ln1_b, ffn1_w_up, ffn1_conv_w, ffn1_conv_b, ffn1_w_down,
              l1_ln2_g, l1_ln2_b):
    mixers = (_mixer_rwkv_ssd, _mixer_sb_mla)
    mixer_args = (
        (l0_w_in, rwkv_mix, rwkv_w0, rwkv_w2, rwkv_a0, rwkv_a2, rwkv_g2, rwkv_k_k, rwkv_k_a,
         rwkv_r_k, rwkv_ln_g, rwkv_ln_b, ssm_conv_w, ssm_conv_b, ssm_dt_bias, ssm_a_log,
         ssm_d, ssm_norm_g, l0_w_out),
        (positions, l1_w_in, mla_q_norm_g, mla_w_uq, mla_kv_norm_g, mla_w_ukv, l1_w_out),
    )
    ffn_args = ((ffn0_w_up, ffn0_conv_w, ffn0_conv_b, ffn0_w_down),
                (ffn1_w_up, ffn1_conv_w, ffn1_conv_b, ffn1_w_down))
    ln_mix = ((l0_ln1_g, l0_ln1_b), (l1_ln1_g, l1_ln1_b))
    ln_ffn = ((l0_ln2_g, l0_ln2_b), (l1_ln2_g, l1_ln2_b))
    h = x
    for layer in range(DEPTH):
        mixed = mixers[layer % 2](h, *mixer_args[layer])
        h = _layer_norm(ALPHA * h + mixed, *ln_mix[layer])
        h = _layer_norm(ALPHA * h + _conv_ffn(h, *ffn_args[layer]), *ln_ffn[layer])
    return h.astype(x.dtype)
```

```cpp
#include <hip/hip_runtime.h>
#include <cstdio>
#include <cstdint>
#include <cmath>

typedef unsigned short bf16_t;
typedef short bf16x8 __attribute__((ext_vector_type(8)));
typedef float f32x16 __attribute__((ext_vector_type(16)));
typedef float f32x4 __attribute__((ext_vector_type(4)));

constexpr int BATCH = 16, SEQ = 2048, DM = 1024, M = BATCH * SEQ;
constexpr int L0P = 3584;
constexpr int L1P = 2048;
constexpr int DFF = 2816;
constexpr float ALPHA = 1.4142135623730951f;

__device__ __forceinline__ unsigned f2bf(float f) { unsigned u = __builtin_bit_cast(unsigned, f); return (u + 0x7fffu + ((u >> 16) & 1u)) >> 16; }
__device__ __forceinline__ float bf2f(bf16_t b) { return __builtin_bit_cast(float, (unsigned)b << 16); }
__device__ __forceinline__ float sigmoidf_(float x) { return 1.f / (1.f + expf(-x)); }
__device__ __forceinline__ float softplusf_(float x) { return fmaxf(x, 0.f) + log1pf(expf(-fabsf(x))); }
__device__ __forceinline__ float siluf_(float x) { return x / (1.f + expf(-x)); }
__device__ __forceinline__ float wave_sum(float v) {
#pragma unroll
    for (int o = 1; o < 64; o <<= 1) v += __shfl_xor(v, o);
    return v;
}

__global__ void k_transpose_cvt(const float* __restrict__ W, int K, int N, bf16_t* __restrict__ Wt, int Npad, const float* __restrict__ kscale) {
    __shared__ float tile[32][33];
    const int n0 = blockIdx.x * 32, k0 = blockIdx.y * 32;
    const int tx = threadIdx.x & 31, ty = threadIdx.x >> 5;
    for (int i = ty; i < 32; i += 8) {
        const int k = k0 + i, n = n0 + tx;
        float v = (n < N) ? W[(size_t)k * N + n] : 0.f;
        if (kscale) v *= kscale[k];
        tile[i][tx] = v;
    }
    __syncthreads();
    for (int i = ty; i < 32; i += 8) {
        const int n = n0 + i, k = k0 + tx;
        if (n < Npad) Wt[(size_t)n * K + k] = (bf16_t)f2bf(tile[tx][i]);
    }
}
__global__ void k_cvt_bf16(const float* __restrict__ x, bf16_t* __restrict__ xb, size_t n) {
    size_t i = (size_t)blockIdx.x * blockDim.x + threadIdx.x;
    const size_t stride = (size_t)gridDim.x * blockDim.x;
    for (; i < n; i += stride) xb[i] = (bf16_t)f2bf(x[i]);
}

struct EpiStoreBf16 { bf16_t* O; const float* rowscale; int ldo; int rs_stride;
    __device__ __forceinline__ void operator()(int r, int c, float v) const { if (rowscale) v *= rowscale[(size_t)r * rs_stride]; O[(size_t)r * ldo + c] = (bf16_t)f2bf(v); } };
struct EpiResidual { const float* hin; float* hout;
    __device__ __forceinline__ void operator()(int r, int c, float v) const { const size_t i = (size_t)r * DM + c; hout[i] = ALPHA * hin[i] + v; } };

template <class Epi>
__global__ void __launch_bounds__(256) k_gemm_simple(const bf16_t* __restrict__ A, int lda, const bf16_t* __restrict__ Bt, int ldb, int N, int K, Epi epi) {
    const int lane = threadIdx.x & 63, wid = threadIdx.x >> 6, wr = wid >> 1, wc = wid & 1;
    const int ntn = N / 128;
    const int tm = blockIdx.x / ntn, tn = blockIdx.x % ntn;
    const int row0 = tm * 128 + wr * 64, col0 = tn * 128 + wc * 64;
    const int l31 = lane & 31, lh = lane >> 5;
    f32x16 acc[2][2];
#pragma unroll
    for (int i = 0; i < 2; ++i)
#pragma unroll
        for (int j = 0; j < 2; ++j)
#pragma unroll
            for (int r = 0; r < 16; ++r) acc[i][j][r] = 0.f;
    const bf16_t* a0 = A + (size_t)(row0 + l31) * lda + 8 * lh;
    const bf16_t* a1 = a0 + (size_t)32 * lda;
    const bf16_t* b0 = Bt + (size_t)(col0 + l31) * ldb + 8 * lh;
    const bf16_t* b1 = b0 + (size_t)32 * ldb;
    for (int k = 0; k < K; k += 16) {
        const bf16x8 fa0 = *(const bf16x8*)(a0 + k), fa1 = *(const bf16x8*)(a1 + k);
        const bf16x8 fb0 = *(const bf16x8*)(b0 + k), fb1 = *(const bf16x8*)(b1 + k);
        acc[0][0] = __builtin_amdgcn_mfma_f32_32x32x16_bf16(fa0, fb0, acc[0][0], 0, 0, 0);
        acc[0][1] = __builtin_amdgcn_mfma_f32_32x32x16_bf16(fa0, fb1, acc[0][1], 0, 0, 0);
        acc[1][0] = __builtin_amdgcn_mfma_f32_32x32x16_bf16(fa1, fb0, acc[1][0], 0, 0, 0);
        acc[1][1] = __builtin_amdgcn_mfma_f32_32x32x16_bf16(fa1, fb1, acc[1][1], 0, 0, 0);
    }
#pragma unroll
    for (int i = 0; i < 2; ++i)
#pragma unroll
        for (int j = 0; j < 2; ++j)
#pragma unroll
            for (int r = 0; r < 16; ++r) {
                const int row = row0 + i * 32 + (r & 3) + 8 * (r >> 2) + 4 * lh;
                const int col = col0 + j * 32 + l31;
                epi(row, col, acc[i][j][r]);
            }
}

__global__ void __launch_bounds__(256) k_layernorm(float* __restrict__ h, bf16_t* __restrict__ hb, const float* __restrict__ g, const float* __restrict__ b) {
    const int lane = threadIdx.x & 63, row = blockIdx.x * 4 + (threadIdx.x >> 6);
    float* p = h + (size_t)row * DM;
    f32x4 v[4]; float s = 0.f;
#pragma unroll
    for (int j = 0; j < 4; ++j) { v[j] = *(const f32x4*)(p + 4 * lane + 256 * j); s += (v[j][0] + v[j][1]) + (v[j][2] + v[j][3]); }
    const float mean = wave_sum(s) * (1.f / DM); float q = 0.f;
#pragma unroll
    for (int j = 0; j < 4; ++j) { v[j] = v[j] - mean; q += (v[j][0] * v[j][0] + v[j][1] * v[j][1]) + (v[j][2] * v[j][2] + v[j][3] * v[j][3]); }
    const float rstd = 1.0f / sqrtf(wave_sum(q) * (1.f / DM) + 1e-5f);
#pragma unroll
    for (int j = 0; j < 4; ++j) {
        const int c = 4 * lane + 256 * j;
        const f32x4 gg = *(const f32x4*)(g + c), bb = *(const f32x4*)(b + c);
        const f32x4 o = v[j] * rstd * gg + bb;
        *(f32x4*)(p + c) = o;
        uint2 w; w.x = f2bf(o[0]) | (f2bf(o[1]) << 16); w.y = f2bf(o[2]) | (f2bf(o[3]) << 16);
        *(uint2*)(hb + (size_t)row * DM + c) = w;
    }
}

__global__ void __launch_bounds__(64) k_rwkv_naive(const bf16_t* __restrict__ proj, const float* __restrict__ mix, const float* __restrict__ w0, const float* __restrict__ w2,
                                                   const float* __restrict__ a0, const float* __restrict__ a2, const float* __restrict__ g2, const float* __restrict__ k_k,
                                                   const float* __restrict__ k_a, const float* __restrict__ r_k, const float* __restrict__ ln_g, const float* __restrict__ ln_b,
                                                   bf16_t* __restrict__ ymix) {
    __shared__ float s_w2[64 * 64], s_a2[64 * 64], s_g2[128 * 64];
    __shared__ float s_tw[64], s_al[64], s_sg[128], s_w[64], s_k[64], s_a[64], s_b[64], s_r[64];
    const int b = blockIdx.x >> 3, h = blockIdx.x & 7, lane = threadIdx.x, c = h * 64 + lane;
    for (int l = 0; l < 64; ++l) { s_w2[l * 64 + lane] = w2[l * 512 + c]; s_a2[l * 64 + lane] = a2[l * 512 + c]; }
    for (int l = 0; l < 128; ++l) s_g2[l * 64 + lane] = g2[l * 512 + c];
    const float mr = mix[c], mk = mix[512 + c], mv = mix[1024 + c], mw = mix[1536 + lane], ma = mix[1600 + lane], mg0 = mix[1664 + lane], mg1 = mix[1728 + lane];
    const float w0c = w0[c], a0c = a0[c], kkc = k_k[c], kac = k_a[c], rkc = r_k[c], lgc = ln_g[c], lbc = ln_b[c];
    float S[64];
#pragma unroll
    for (int j = 0; j < 64; ++j) S[j] = 0.f;
    float pr = 0.f, pk = 0.f, pv = 0.f, pw = 0.f, pa = 0.f, pg0 = 0.f, pg1 = 0.f;
    __syncthreads();
    for (int t = 0; t < SEQ; ++t) {
        const bf16_t* row = proj + (size_t)(b * SEQ + t) * L0P;
        const float cr = bf2f(row[c]), ck = bf2f(row[512 + c]), cv = bf2f(row[1024 + c]), cw = bf2f(row[1536 + lane]), ca = bf2f(row[1600 + lane]),
                    cg0 = bf2f(row[1664 + lane]), cg1 = bf2f(row[1728 + lane]);
        const float r_s = cr + (pr - cr) * mr, k_s = ck + (pk - ck) * mk, v_s = cv + (pv - cv) * mv;
        const float wl = cw + (pw - cw) * mw, al = ca + (pa - ca) * ma, g0 = cg0 + (pg0 - cg0) * mg0, g1 = cg1 + (pg1 - cg1) * mg1;
        pr = cr; pk = ck; pv = cv; pw = cw; pa = ca; pg0 = cg0; pg1 = cg1;
        s_tw[lane] = tanhf(wl); s_al[lane] = al; s_sg[lane] = sigmoidf_(g0); s_sg[64 + lane] = sigmoidf_(g1);
        __syncthreads();
        float wsum = w0c, asum = a0c, gsum = 0.f;
        for (int l = 0; l < 64; ++l) { wsum += s_tw[l] * s_w2[l * 64 + lane]; asum += s_al[l] * s_a2[l * 64 + lane]; }
        for (int l = 0; l < 128; ++l) gsum += s_sg[l] * s_g2[l * 64 + lane];
        const float log_w = -softplusf_(-wsum) - 0.5f;
        const float dec = expf(-expf(log_w));
        const float a = sigmoidf_(asum);
        float kkv = k_s * kkc;
        const float nrm = sqrtf(wave_sum(kkv * kkv));
        kkv = kkv / fmaxf(nrm, 1e-12f);
        const float k2 = k_s * (1.f + (a - 1.f) * kac);
        const float bonus_s = wave_sum(r_s * k2 * rkc);
        s_w[lane] = dec; s_k[lane] = k2; s_a[lane] = -kkv; s_b[lane] = kkv * a; s_r[lane] = r_s;
        __syncthreads();
        float sa = 0.f;
#pragma unroll
        for (int j = 0; j < 64; ++j) sa += S[j] * s_a[j];
        float y = 0.f;
#pragma unroll
        for (int j = 0; j < 64; ++j) { S[j] = S[j] * s_w[j] + sa * s_b[j] + v_s * s_k[j]; y += S[j] * s_r[j]; }
        const float mu = wave_sum(y) * (1.f / 64.f);
        const float d = y - mu;
        const float var = wave_sum(d * d) * (1.f / 64.f);
        const float yn = d * (1.0f / sqrtf(var + 64e-5f)) * lgc + lbc;
        const float o = (yn + bonus_s * v_s) * gsum;
        ymix[(size_t)(b * SEQ + t) * DM + c] = (bf16_t)f2bf(o);
        __syncthreads();
    }
}

__global__ void __launch_bounds__(256) k_ssm_conv(const bf16_t* __restrict__ proj, const float* __restrict__ cw, const float* __restrict__ cb, const float* __restrict__ dtb,
                                                  bf16_t* __restrict__ xbc, float* __restrict__ dt) {
    const int m = blockIdx.x, t = m % SEQ;
    for (int c = threadIdx.x; c < 1024; c += 256) {
        float acc = cb[c];
#pragma unroll
        for (int i = 0; i < 4; ++i) { const int tt = t - 3 + i; if (tt >= 0) acc += cw[i * 1024 + c] * bf2f(proj[(size_t)(m - 3 + i) * L0P + 2304 + c]); }
        xbc[(size_t)m * 1024 + c] = (bf16_t)f2bf(siluf_(acc));
    }
    if (threadIdx.x < 8) dt[(size_t)m * 8 + threadIdx.x] = softplusf_(bf2f(proj[(size_t)m * L0P + 3328 + threadIdx.x]) + dtb[threadIdx.x]);
}
__global__ void __launch_bounds__(256) k_ssd_naive(const bf16_t* __restrict__ xbc, const float* __restrict__ dt, const float* __restrict__ a_log, const float* __restrict__ dsk,
                                                   float* __restrict__ yssm) {
    const int b = blockIdx.x >> 3, h = blockIdx.x & 7, g = h >> 2, p = threadIdx.x >> 2, nq = threadIdx.x & 3;
    const float A = -expf(a_log[h]), D = dsk[h];
    float st[32];
#pragma unroll
    for (int n = 0; n < 32; ++n) st[n] = 0.f;
    for (int t = 0; t < SEQ; ++t) {
        const size_t m = (size_t)b * SEQ + t;
        const float dtv = dt[m * 8 + h], dA = expf(dtv * A);
        const float x = bf2f(xbc[m * 1024 + h * 64 + p]), xdt = x * dtv;
        const bf16_t* Bp = xbc + m * 1024 + 512 + g * 128 + nq * 32;
        const bf16_t* Cp = xbc + m * 1024 + 768 + g * 128 + nq * 32;
        float yp = 0.f;
#pragma unroll
        for (int n = 0; n < 32; ++n) { st[n] = st[n] * dA + xdt * bf2f(Bp[n]); yp += st[n] * bf2f(Cp[n]); }
        yp += __shfl_xor(yp, 1); yp += __shfl_xor(yp, 2);
        if (nq == 0) yssm[m * 512 + h * 64 + p] = yp + D * x;
    }
}
__global__ void __launch_bounds__(256) k_ssm_gate_norm(const float* __restrict__ yssm, const bf16_t* __restrict__ proj, const float* __restrict__ ng, bf16_t* __restrict__ ymix) {
    const int lane = threadIdx.x & 63, wv = blockIdx.x * 4 + (threadIdx.x >> 6);
    const int m = wv >> 1, g = wv & 1;
    float u[4], q = 0.f;
#pragma unroll
    for (int j = 0; j < 4; ++j) { const int c = g * 256 + j * 64 + lane; const float z = bf2f(proj[(size_t)m * L0P + 1792 + c]); u[j] = yssm[(size_t)m * 512 + c] * siluf_(z); q += u[j] * u[j]; }
    const float rs = 1.0f / sqrtf(wave_sum(q) * (1.f / 256.f) + 1e-5f);
#pragma unroll
    for (int j = 0; j < 4; ++j) { const int c = g * 256 + j * 64 + lane; ymix[(size_t)m * DM + 512 + c] = (bf16_t)f2bf(u[j] * rs * ng[c]); }
}

__global__ void __launch_bounds__(256) k_ffn_act(bf16_t* __restrict__ gu, const float* __restrict__ cw, const float* __restrict__ cb) {
    const int m = blockIdx.x, t = m % SEQ;
    for (int c = threadIdx.x; c < DFF; c += 256) {
        float acc = cb[c];
#pragma unroll
        for (int i = 0; i < 3; ++i) { const int tt = t - 2 + i; if (tt >= 0) acc += cw[i * DFF + c] * bf2f(gu[(size_t)(m - 2 + i) * (2 * DFF) + c]); }
        const float up = bf2f(gu[(size_t)m * (2 * DFF) + DFF + c]);
        gu[(size_t)m * (2 * DFF) + DFF + c] = (bf16_t)f2bf(siluf_(acc) * up);
    }
}

__global__ void __launch_bounds__(256) k_mla_prep(const bf16_t* __restrict__ proj1, const int* __restrict__ pos, float* __restrict__ rs, bf16_t* __restrict__ kpe) {
    const int lane = threadIdx.x & 63, m = blockIdx.x * 4 + (threadIdx.x >> 6);
    const bf16_t* row = proj1 + (size_t)m * L1P;
    float q = 0.f;
#pragma unroll
    for (int j = 0; j < 4; ++j) { const float v = bf2f(row[1536 + j * 64 + lane]); q += v * v; }
    q = wave_sum(q);
    float k = 0.f;
#pragma unroll
    for (int j = 0; j < 2; ++j) { const float v = bf2f(row[1792 + j * 64 + lane]); k += v * v; }
    k = wave_sum(k);
    if (lane == 0) { rs[(size_t)m * 2] = 1.0f / sqrtf(q * (1.f / 256.f) + 1e-6f); rs[(size_t)m * 2 + 1] = 1.0f / sqrtf(k * (1.f / 128.f) + 1e-6f); }
    if (lane < 16) {
        const double inv = pow(10000.0, -(double)(2 * lane) / 32.0);
        const double ang = (double)pos[m] * inv;
        const float cs = (float)cos(ang), sn = (float)sin(ang);
        const float x1 = bf2f(row[1920 + lane]), x2 = bf2f(row[1936 + lane]);
        kpe[(size_t)m * 32 + lane] = (bf16_t)f2bf(x1 * cs - x2 * sn);
        kpe[(size_t)m * 32 + 16 + lane] = (bf16_t)f2bf(x2 * cs + x1 * sn);
    }
}
__global__ void __launch_bounds__(128) k_rope_q(bf16_t* __restrict__ qm, const int* __restrict__ pos) {
    const int m = blockIdx.x, h = threadIdx.x >> 4, i = threadIdx.x & 15;
    const double inv = pow(10000.0, -(double)(2 * i) / 32.0);
    const double ang = (double)pos[m] * inv;
    const float cs = (float)cos(ang), sn = (float)sin(ang);
    bf16_t* p = qm + (size_t)m * 768 + h * 96 + 64;
    const float x1 = bf2f(p[i]), x2 = bf2f(p[16 + i]);
    p[i] = (bf16_t)f2bf(x1 * cs - x2 * sn); p[16 + i] = (bf16_t)f2bf(x2 * cs + x1 * sn);
}

__global__ void __launch_bounds__(64) k_sb_naive(const bf16_t* __restrict__ proj1, bf16_t* __restrict__ ymix) {
    const int bh = blockIdx.y, b = bh >> 3, h = bh & 7, t = blockIdx.x * 64 + threadIdx.x;
    const size_t mrow = (size_t)b * SEQ;
    float q[64], o[64];
#pragma unroll
    for (int d = 0; d < 64; ++d) { q[d] = bf2f(proj1[(mrow + t) * L1P + h * 64 + d]) * 0.125f; o[d] = 0.f; }
    float cum = 0.f;
    const int smax = blockIdx.x * 64 + 63;
    for (int s = smax - 1; s >= 0; --s) {
        const bf16_t* kr = proj1 + (mrow + s) * L1P + 512 + h * 64;
        const bf16_t* vr = proj1 + (mrow + s) * L1P + 1024 + h * 64;
        float z = 0.f;
#pragma unroll
        for (int d = 0; d < 64; ++d) z += q[d] * bf2f(kr[d]);
        if (s < t) {
            const float lsp = -softplusf_(-z);
            const float lsn = -softplusf_(z);
            const float att = expf(lsp + cum);
            cum += lsn;
#pragma unroll
            for (int d = 0; d < 64; ++d) o[d] += att * bf2f(vr[d]);
        }
    }
#pragma unroll
    for (int d = 0; d < 64; ++d) ymix[(mrow + t) * DM + h * 64 + d] = (bf16_t)f2bf(o[d]);
}
__global__ void __launch_bounds__(64) k_mla_naive(const bf16_t* __restrict__ qm, const bf16_t* __restrict__ kvm, const bf16_t* __restrict__ kpe, bf16_t* __restrict__ ymix) {
    const int bh = blockIdx.y, b = bh >> 3, h = bh & 7, t = blockIdx.x * 64 + threadIdx.x;
    const size_t mrow = (size_t)b * SEQ;
    const float scale = 0.10206207261596577f;
    float q[96], o[64];
#pragma unroll
    for (int d = 0; d < 96; ++d) q[d] = bf2f(qm[(mrow + t) * 768 + h * 96 + d]) * scale;
#pragma unroll
    for (int d = 0; d < 64; ++d) o[d] = 0.f;
    float mx = -1e30f, l = 0.f;
    const int smax = blockIdx.x * 64 + 63;
    for (int s = 0; s <= smax; ++s) {
        const bf16_t* kr = kvm + (mrow + s) * 1024 + h * 128;
        const bf16_t* pr = kpe + (mrow + s) * 32;
        float z = 0.f;
#pragma unroll
        for (int d = 0; d < 64; ++d) z += q[d] * bf2f(kr[d]);
#pragma unroll
        for (int d = 0; d < 32; ++d) z += q[64 + d] * bf2f(pr[d]);
        if (s <= t) {
            const float mn = fmaxf(mx, z), f = expf(mx - mn), pz = expf(z - mn);
            l = l * f + pz; mx = mn;
#pragma unroll
            for (int d = 0; d < 64; ++d) o[d] = o[d] * f + pz * bf2f(kr[64 + d]);
        }
    }
    const float il = 1.f / l;
#pragma unroll
    for (int d = 0; d < 64; ++d) ymix[(mrow + t) * DM + 512 + h * 64 + d] = (bf16_t)f2bf(o[d] * il);
}

constexpr size_t MiB = 1u << 20;
constexpr size_t WS_W0IN = 2 * MiB, WS_W0OUT = 9 * MiB, WS_WUP0 = 11 * MiB, WS_WDN0 = 22 * MiB, WS_W1IN = 28 * MiB, WS_WUQ = 32 * MiB, WS_WUKV = 33 * MiB,
                 WS_W1OUT = 34 * MiB, WS_WUP1 = 36 * MiB, WS_WDN1 = 47 * MiB;
constexpr size_t WS_XB = 56 * MiB, WS_YMIX = 120 * MiB, WS_BIG = 184 * MiB;
constexpr size_t WS_YSSM = 408 * MiB, WS_DT = 472 * MiB;
constexpr size_t WS_GU = 120 * MiB;
constexpr size_t WS_PROJ1 = 184 * MiB, WS_QM = 312 * MiB, WS_KVM = 360 * MiB, WS_KPE = 424 * MiB, WS_RS = 426 * MiB;

static void transpose_cvt(const float* W, int K, int N, bf16_t* Wt, int Npad, const float* ks, hipStream_t s) {
    dim3 grid((Npad + 31) / 32, K / 32);
    hipLaunchKernelGGL(k_transpose_cvt, grid, dim3(256), 0, s, W, K, N, Wt, Npad, ks);
}
template <class Epi>
static void gemm(const bf16_t* A, int lda, const bf16_t* Bt, int ldb, int N, int K, Epi epi, hipStream_t s) {
    hipLaunchKernelGGL((k_gemm_simple<Epi>), dim3((M / 128) * (N / 128)), dim3(256), 0, s, A, lda, Bt, ldb, N, K, epi);
}

extern "C" void kernel_launch(void* const* d_in, const int* in_sizes, int n_in, void* d_out, int out_size, void* d_ws, size_t ws_size, hipStream_t stream) {
    if (ws_size < 480 * MiB || n_in != 43) { fprintf(stderr, "kernel_launch: unexpected ws_size %zu / n_in %d\n", ws_size, n_in); return; }
    auto F = [&](int i) { return (const float*)d_in[i]; };
    unsigned char* ws = (unsigned char*)d_ws;
    float* out = (float*)d_out;
    bf16_t* W0in = (bf16_t*)(ws + WS_W0IN); bf16_t* W0out = (bf16_t*)(ws + WS_W0OUT); bf16_t* Wup0 = (bf16_t*)(ws + WS_WUP0); bf16_t* Wdn0 = (bf16_t*)(ws + WS_WDN0);
    bf16_t* W1in = (bf16_t*)(ws + WS_W1IN); bf16_t* Wuq = (bf16_t*)(ws + WS_WUQ); bf16_t* Wukv = (bf16_t*)(ws + WS_WUKV); bf16_t* W1out = (bf16_t*)(ws + WS_W1OUT);
    bf16_t* Wup1 = (bf16_t*)(ws + WS_WUP1); bf16_t* Wdn1 = (bf16_t*)(ws + WS_WDN1);
    bf16_t* XB = (bf16_t*)(ws + WS_XB); bf16_t* YMIX = (bf16_t*)(ws + WS_YMIX); bf16_t* PROJ0 = (bf16_t*)(ws + WS_BIG);
    float* YSSM = (float*)(ws + WS_YSSM); float* DT = (float*)(ws + WS_DT); bf16_t* GU = (bf16_t*)(ws + WS_GU);
    bf16_t* PROJ1 = (bf16_t*)(ws + WS_PROJ1); bf16_t* QM = (bf16_t*)(ws + WS_QM); bf16_t* KVM = (bf16_t*)(ws + WS_KVM); bf16_t* KPE = (bf16_t*)(ws + WS_KPE); float* RS = (float*)(ws + WS_RS);
    const int* pos = (const int*)d_in[1];

    transpose_cvt(F(2), 1024, 3336, W0in, L0P, nullptr, stream);
    transpose_cvt(F(20), 1024, 1024, W0out, 1024, nullptr, stream);
    transpose_cvt(F(23), 1024, 5632, Wup0, 5632, nullptr, stream);
    transpose_cvt(F(26), 2816, 1024, Wdn0, 1024, nullptr, stream);
    transpose_cvt(F(29), 1024, 1952, W1in, L1P, nullptr, stream);
    transpose_cvt(F(31), 256, 768, Wuq, 768, F(30), stream);
    transpose_cvt(F(33), 128, 1024, Wukv, 1024, F(32), stream);
    transpose_cvt(F(34), 1024, 1024, W1out, 1024, nullptr, stream);
    transpose_cvt(F(37), 1024, 5632, Wup1, 5632, nullptr, stream);
    transpose_cvt(F(40), 2816, 1024, Wdn1, 1024, nullptr, stream);
    hipLaunchKernelGGL(k_cvt_bf16, dim3(4096), dim3(256), 0, stream, F(0), XB, (size_t)M * DM);

    gemm(XB, DM, W0in, 1024, L0P, 1024, EpiStoreBf16{PROJ0, nullptr, L0P, 0}, stream);
    hipLaunchKernelGGL(k_rwkv_naive, dim3(128), dim3(64), 0, stream, PROJ0, F(3), F(4), F(5), F(6), F(7), F(8), F(9), F(10), F(11), F(12), F(13), YMIX);
    hipLaunchKernelGGL(k_ssm_conv, dim3(M), dim3(256), 0, stream, PROJ0, F(14), F(15), F(16), XB, DT);
    hipLaunchKernelGGL(k_ssd_naive, dim3(128), dim3(256), 0, stream, XB, DT, F(17), F(18), YSSM);
    hipLaunchKernelGGL(k_ssm_gate_norm, dim3(M * 2 / 4), dim3(256), 0, stream, YSSM, PROJ0, F(19), YMIX);
    gemm(YMIX, DM, W0out, 1024, 1024, 1024, EpiResidual{F(0), out}, stream);
    hipLaunchKernelGGL(k_layernorm, dim3(M / 4), dim3(256), 0, stream, out, XB, F(21), F(22));
    gemm(XB, DM, Wup0, 1024, 5632, 1024, EpiStoreBf16{GU, nullptr, 5632, 0}, stream);
    hipLaunchKernelGGL(k_ffn_act, dim3(M), dim3(256), 0, stream, GU, F(24), F(25));
    gemm(GU + DFF, 5632, Wdn0, DFF, 1024, DFF, EpiResidual{out, out}, stream);
    hipLaunchKernelGGL(k_layernorm, dim3(M / 4), dim3(256), 0, stream, out, XB, F(27), F(28));
    gemm(XB, DM, W1in, 1024, L1P, 1024, EpiStoreBf16{PROJ1, nullptr, L1P, 0}, stream);
    hipLaunchKernelGGL(k_mla_prep, dim3(M / 4), dim3(256), 0, stream, PROJ1, pos, RS, KPE);
    gemm(PROJ1 + 1536, L1P, Wuq, 256, 768, 256, EpiStoreBf16{QM, RS, 768, 2}, stream);
    gemm(PROJ1 + 1792, L1P, Wukv, 128, 1024, 128, EpiStoreBf16{KVM, RS + 1, 1024, 2}, stream);
    hipLaunchKernelGGL(k_rope_q, dim3(M), dim3(128), 0, stream, QM, pos);
    hipLaunchKernelGGL(k_sb_naive, dim3(SEQ / 64, 128), dim3(64), 0, stream, PROJ1, YMIX);
    hipLaunchKernelGGL(k_mla_naive, dim3(SEQ / 64, 128), dim3(64), 0, stream, QM, KVM, KPE, YMIX);
    gemm(YMIX, DM, W1out, 1024, 1024, 1024, EpiResidual{out, out}, stream);
    hipLaunchKernelGGL(k_layernorm, dim3(M / 4), dim3(256), 0, stream, out, XB, F(35), F(36));
    gemm(XB, DM, Wup1, 1024, 5632, 1024, EpiStoreBf16{GU, nullptr, 5632, 0}, stream);
    hipLaunchKernelGGL(k_ffn_act, dim3(M), dim3(256), 0, stream, GU, F(38), F(39));
    gemm(GU + DFF, 5632, Wdn1, DFF, 1024, DFF, EpiResidual{out, out}, stream);
    hipLaunchKernelGGL(k_layernorm, dim3(M / 4), dim3(256), 0, stream, out, XB, F(41), F(42));
}
```

```cpp
#include <hip/hip_runtime.h>
#include <cstdio>
#include <cstdint>
#include <cmath>
namespace pg8 {
#define PG8_LAS __attribute__((address_space(3)))
typedef unsigned short bf16_t;
typedef short bf16x8 __attribute__((ext_vector_type(8)));
typedef float f32x4 __attribute__((ext_vector_type(4)));
typedef unsigned u32x4 __attribute__((ext_vector_type(4)));
constexpr int BM = 256, BK = 64, HALF = 128, HTB = HALF * BK * 2  , STAGE_BYTES = 8 * HTB, NXCD = 8, WGM = 8;

__host__ __device__ __forceinline__ int lds_byte(int r, int c) { const int st = (r >> 4) * 2 + (c >> 5), rr = r & 15, cc = c & 31, ob = rr * 64 + cc * 2; return st * 1024 + (ob ^ (((ob >> 9) & 1) << 5)); }
__host__ __device__ __forceinline__ void stage_rc(int b, int& R, int& C) { const int st = b / 1024, sb = b % 1024, swz = sb ^ (((sb >> 9) & 1) << 5); R = (st >> 1) * 16 + swz / 64; C = (st & 1) * 32 + (swz % 64) / 2; }
__host__ __device__ __forceinline__ int perm32(int rho) { const int n = rho >> 4, i = rho & 15; return 8 * (i >> 2) + 4 * n + (i & 3); }

struct Unit { int pm, pn; };
struct Gemm { const bf16_t* A; const bf16_t* Bt; int M, N, K, lda, ldb; };

struct StaticOrder {
    int nM, nN, nwg, G, c;
    __host__ __device__ void init(int M, int N, int G_, int c_) { nM = M / BM; nN = N / BM; nwg = nM * nN; G = G_; c = c_; }
    __host__ __device__ bool next(int i, Unit& u) const {
        const long L = (long)i * G + c; if (L >= nwg) return false;
        int wgid = (int)L; { const int q = nwg / NXCD, r = nwg % NXCD, xcd = wgid % NXCD, off = wgid / NXCD; wgid = (xcd < r ? xcd * (q + 1) : r * (q + 1) + (xcd - r) * q) + off; }
        const int nig = WGM * nN, gid = wgid / nig, fm = gid * WGM, gsz = (nM - fm) < WGM ? (nM - fm) : WGM;
        u.pm = fm + ((wgid % nig) % gsz); u.pn = (wgid % nig) / gsz; return true;
    }
    __device__ __forceinline__ void a_ready(const Unit&) const {}
    __device__ __forceinline__ void done(const Unit&) const {}
};


__device__ __forceinline__ unsigned cvt_pk_bf16(float lo, float hi) { unsigned r; asm volatile("v_cvt_pk_bf16_f32 %0, %1, %2" : "=v"(r) : "v"(lo), "v"(hi)); return r; }
struct EpiBf16S {
    static constexpr bool PERM = true, AFTER_DRAIN = false;
    bf16_t* O; const float* rowscale; int ldc; int rs_stride;
    __device__ __forceinline__ void operator()(const f32x4 (&acc)[2][2][4][2], const Unit& u, int wr, int wc, int fr, int fq) const {
        const int row0 = u.pm * BM + wr * 64 + fr, col0 = u.pn * BM + wc * 32 + 8 * fq;
#pragma unroll
        for (int ai = 0; ai < 2; ++ai)
#pragma unroll
            for (int m = 0; m < 4; ++m) { const int row = row0 + ai * HALF + m * 16; const float sc = rowscale ? rowscale[(size_t)row * rs_stride] : 1.f;
                bf16_t* rowp = O + (size_t)row * ldc + col0;
#pragma unroll
                for (int bj = 0; bj < 2; ++bj) { const f32x4 v0 = acc[ai][bj][m][0] * sc, v1 = acc[ai][bj][m][1] * sc;
                    u32x4 w; w.x = cvt_pk_bf16(v0[0], v0[1]); w.y = cvt_pk_bf16(v0[2], v0[3]); w.z = cvt_pk_bf16(v1[0], v1[1]); w.w = cvt_pk_bf16(v1[2], v1[3]);
                    *(u32x4*)(rowp + bj * HALF) = w; } }
    }
};
struct EpiResid {
    static constexpr bool PERM = false, AFTER_DRAIN = false;
    const float* hin; float* hout; float alpha; int pad;
    __device__ __forceinline__ void operator()(const f32x4 (&acc)[2][2][4][2], const Unit& u, int wr, int wc, int fr, int fq) const {
        const int row0 = u.pm * BM + wr * 64 + fr, col0 = u.pn * BM + wc * 32 + 4 * fq;
#pragma unroll
        for (int ai = 0; ai < 2; ++ai)
#pragma unroll
            for (int m = 0; m < 4; ++m) { const size_t off = (size_t)(row0 + ai * HALF + m * 16) * 1024 + col0;
#pragma unroll
                for (int bj = 0; bj < 2; ++bj)
#pragma unroll
                    for (int n = 0; n < 2; ++n) { const size_t i = off + bj * HALF + n * 16; const f32x4 h = *(const f32x4*)(hin + i); *(f32x4*)(hout + i) = h * alpha + acc[ai][bj][m][n]; } }
    }
};
template <class Epi, class Sched, bool ALIGN_EPI = false, bool SP2 = false>
__device__ __forceinline__ void gemm_phase(PG8_LAS unsigned char* lds, const Gemm g, const Sched& S, const Epi& E) {
    const int tid = threadIdx.x, wid = __builtin_amdgcn_readfirstlane(tid >> 6), lane = tid & 63, wr = wid >> 2, wc = wid & 3, fr = lane & 15, fq = lane >> 4;
    const int K = g.K, nt = K / BK;
    unsigned voffA[2], voffB[2];
#pragma unroll
    for (int i = 0; i < 2; ++i) { int R, C; stage_rc(tid * 16 + i * 8192, R, C); const int Rb = Epi::PERM ? ((R & ~31) + perm32(R & 31)) : R;
        voffA[i] = (unsigned)(R * g.lda + C) * 2u; voffB[i] = (unsigned)(Rb * g.ldb + C) * 2u; }
    const size_t kstep = (size_t)(BK * 2);
    const size_t hstepA = (size_t)HALF * g.lda * 2, hstepB = (size_t)HALF * g.ldb * 2;
    const size_t tstepA = 2 * hstepA, tstepB = 2 * hstepB;
    const unsigned ldsw = (unsigned)wid * 1024u;
    const int aoff = lds_byte(wr * 64 + fr, fq * 8), boff = lds_byte(wc * 32 + fr, fq * 8);
#define PG8_SA(b, h) (((b) * 2 + (h)) * HTB)
#define PG8_SB(b, h) ((4 + (b) * 2 + (h)) * HTB)
#define PG8_STAGE(bufoff, gbase, voff) do { _Pragma("unroll") for (int _i = 0; _i < 2; ++_i) \
        __builtin_amdgcn_global_load_lds((const unsigned*)((const char*)(gbase) + (voff)[_i]), (PG8_LAS unsigned*)(lds + (bufoff) + ldsw + _i * 8192), 16, 0, 0); } while (0)
#define PG8_LDA(dst, b, h) do { _Pragma("unroll") for (int m = 0; m < 4; ++m) _Pragma("unroll") for (int k = 0; k < 2; ++k) dst[m][k] = *(const PG8_LAS bf16x8*)(lds + PG8_SA(b, h) + aoff + m * 2048 + k * 1024); } while (0)
#define PG8_LDB(dst, b, h) do { _Pragma("unroll") for (int n = 0; n < 2; ++n) _Pragma("unroll") for (int k = 0; k < 2; ++k) dst[n][k] = *(const PG8_LAS bf16x8*)(lds + PG8_SB(b, h) + boff + n * 2048 + k * 1024); } while (0)
#define PG8_MMA(ai, bj, At, Bt) do { __builtin_amdgcn_s_setprio(1); _Pragma("unroll") for (int m = 0; m < 4; ++m) _Pragma("unroll") for (int n = 0; n < 2; ++n) _Pragma("unroll") for (int k = 0; k < 2; ++k) \
        acc[ai][bj][m][n] = __builtin_amdgcn_mfma_f32_16x16x32_bf16(Bt[n][k], At[m][k], acc[ai][bj][m][n], 0, 0, 0); __builtin_amdgcn_s_setprio(0); } while (0)
#define PG8_WAIT_V(n) asm volatile("s_waitcnt vmcnt(" #n ")" ::: "memory")
#define PG8_WAIT_L(n) asm volatile("s_waitcnt lgkmcnt(" #n ")" ::: "memory")
#define PG8_BAR __builtin_amdgcn_s_barrier()
#define PG8_SCHED __builtin_amdgcn_sched_barrier(0)
    Unit cur, nxt; int ui = 0;
    if (!S.next(0, cur)) return;
    f32x4 acc[2][2][4][2];
#pragma unroll
    for (int a = 0; a < 2; ++a)
#pragma unroll
        for (int b = 0; b < 2; ++b)
#pragma unroll
            for (int m = 0; m < 4; ++m)
#pragma unroll
                for (int n = 0; n < 2; ++n) acc[a][b][m][n] = (f32x4){0.f, 0.f, 0.f, 0.f};
    bf16x8 At[4][2], B0[2][2], B1[2][2];
    const char* cA = (const char*)g.A + (size_t)cur.pm * tstepA; const char* cB = (const char*)g.Bt + (size_t)cur.pn * tstepB;
    S.a_ready(cur);
    if constexpr (SP2) {
        PG8_STAGE(PG8_SB(0, 0), cB, voffB); PG8_STAGE(PG8_SB(0, 1), cB + hstepB, voffB); PG8_STAGE(PG8_SA(0, 0), cA, voffA); PG8_STAGE(PG8_SA(0, 1), cA + hstepA, voffA);
        if (wr == 1) PG8_BAR;
        PG8_WAIT_V(2); PG8_BAR;
        PG8_STAGE(PG8_SB(1, 0), cB + kstep, voffB); PG8_STAGE(PG8_SA(1, 0), cA + kstep, voffA); PG8_STAGE(PG8_SB(1, 1), cB + hstepB + kstep, voffB);
        PG8_WAIT_V(6); PG8_BAR;
    } else {
        PG8_STAGE(PG8_SB(0, 0), cB, voffB); PG8_STAGE(PG8_SA(0, 0), cA, voffA); PG8_STAGE(PG8_SB(0, 1), cB + hstepB, voffB); PG8_STAGE(PG8_SA(0, 1), cA + hstepA, voffA);
        if (wr == 1) PG8_BAR;
        PG8_WAIT_V(4); PG8_BAR;
        PG8_STAGE(PG8_SB(1, 0), cB + kstep, voffB); PG8_STAGE(PG8_SA(1, 0), cA + kstep, voffA); PG8_STAGE(PG8_SB(1, 1), cB + hstepB + kstep, voffB);
        PG8_WAIT_V(6); PG8_BAR;
    }
    for (;;) {
        const bool has_next = S.next(ui + 1, nxt);
        const char* nA = has_next ? (const char*)g.A + (size_t)nxt.pm * tstepA : cA; const char* nB = has_next ? (const char*)g.Bt + (size_t)nxt.pn * tstepB : cB;
        for (int t = 0; t < nt; t += 2) {
            const bool last = (t == nt - 2);
            const char* a1 = cA + (size_t)(t + 1) * kstep;
            const char* a2 = last ? nA : cA + (size_t)(t + 2) * kstep; const char* b2 = last ? nB : cB + (size_t)(t + 2) * kstep;
            const char* a3 = a2 + kstep; const char* b3 = b2 + kstep;
            if (last && has_next) S.a_ready(nxt);
            if constexpr (SP2) {
            PG8_LDB(B0, 0, 0); PG8_LDB(B1, 0, 1); PG8_SCHED; PG8_LDA(At, 0, 0); PG8_STAGE(PG8_SA(1, 1), a1 + hstepA, voffA);
            PG8_WAIT_V(8); PG8_WAIT_L(0); PG8_BAR; PG8_MMA(0, 0, At, B0); PG8_MMA(0, 1, At, B1); PG8_BAR; PG8_SCHED;
            PG8_LDA(At, 0, 1); PG8_STAGE(PG8_SB(0, 0), b2, voffB); PG8_STAGE(PG8_SB(0, 1), b2 + hstepB, voffB); PG8_STAGE(PG8_SA(0, 0), a2, voffA);
            PG8_WAIT_V(8); PG8_WAIT_L(0); PG8_BAR; PG8_MMA(1, 0, At, B0); PG8_MMA(1, 1, At, B1); PG8_BAR; PG8_SCHED;
            PG8_LDB(B0, 1, 0); PG8_LDB(B1, 1, 1); PG8_SCHED; PG8_LDA(At, 1, 0); PG8_STAGE(PG8_SA(0, 1), a2 + hstepA, voffA);
            PG8_WAIT_V(8); PG8_WAIT_L(0); PG8_BAR; PG8_MMA(0, 0, At, B0); PG8_MMA(0, 1, At, B1); PG8_BAR; PG8_SCHED;
            PG8_LDA(At, 1, 1); PG8_STAGE(PG8_SB(1, 0), b3, voffB); PG8_STAGE(PG8_SB(1, 1), b3 + hstepB, voffB); PG8_STAGE(PG8_SA(1, 0), a3, voffA);
            PG8_WAIT_V(8); PG8_WAIT_L(0); PG8_BAR; PG8_MMA(1, 0, At, B0); PG8_MMA(1, 1, At, B1); PG8_BAR; PG8_SCHED;
            } else {
            PG8_LDB(B0, 0, 0); PG8_SCHED; PG8_LDA(At, 0, 0); PG8_STAGE(PG8_SA(1, 1), a1 + hstepA, voffA);
            PG8_WAIT_L(8); PG8_BAR; PG8_WAIT_L(0); PG8_MMA(0, 0, At, B0); PG8_BAR; PG8_SCHED;
            PG8_LDB(B1, 0, 1); PG8_STAGE(PG8_SB(0, 0), b2, voffB);
            PG8_BAR; PG8_WAIT_L(0); PG8_MMA(0, 1, At, B1); PG8_BAR;
            PG8_LDA(At, 0, 1); PG8_STAGE(PG8_SA(0, 0), a2, voffA);
            PG8_BAR; PG8_WAIT_L(0); PG8_MMA(1, 0, At, B0); PG8_BAR; PG8_SCHED;
            PG8_STAGE(PG8_SB(0, 1), b2 + hstepB, voffB);
            PG8_WAIT_V(6); PG8_BAR; PG8_MMA(1, 1, At, B1); PG8_BAR;
            PG8_LDB(B0, 1, 0); PG8_SCHED; PG8_LDA(At, 1, 0); PG8_STAGE(PG8_SA(0, 1), a2 + hstepA, voffA);
            PG8_WAIT_L(8); PG8_BAR; PG8_WAIT_L(0); PG8_MMA(0, 0, At, B0); PG8_BAR; PG8_SCHED;
            PG8_LDB(B1, 1, 1); PG8_STAGE(PG8_SB(1, 0), b3, voffB);
            PG8_BAR; PG8_WAIT_L(0); PG8_MMA(0, 1, At, B1); PG8_BAR;
            PG8_LDA(At, 1, 1); PG8_STAGE(PG8_SA(1, 0), a3, voffA);
            PG8_BAR; PG8_WAIT_L(0); PG8_MMA(1, 0, At, B0); PG8_BAR; PG8_SCHED;
            PG8_STAGE(PG8_SB(1, 1), b3 + hstepB, voffB);
            PG8_WAIT_V(6); PG8_BAR; PG8_MMA(1, 1, At, B1); PG8_BAR;
            }
        }
        if constexpr (ALIGN_EPI) { if (wr == 0) PG8_BAR; }
        if constexpr (!Epi::AFTER_DRAIN) { E(acc, cur, wr, wc, fr, fq); S.done(cur); }
        if (!has_next) break;
#pragma unroll
        for (int a = 0; a < 2; ++a)
#pragma unroll
            for (int b = 0; b < 2; ++b)
#pragma unroll
                for (int m = 0; m < 4; ++m)
#pragma unroll
                    for (int n = 0; n < 2; ++n) acc[a][b][m][n] = (f32x4){0.f, 0.f, 0.f, 0.f};
        cur = nxt; cA = nA; cB = nB; ++ui;
        if constexpr (ALIGN_EPI) { if (wr == 1) PG8_BAR; }
    }
    PG8_WAIT_V(0);
    if constexpr (!ALIGN_EPI) { if (wr == 0) PG8_BAR; }
    PG8_BAR;
    if constexpr (Epi::AFTER_DRAIN) { E.fused(acc, cur, wr, wc, fr, fq, lds, wid, lane); S.done(cur); }
#undef PG8_SA
#undef PG8_SB
#undef PG8_STAGE
#undef PG8_LDA
#undef PG8_LDB
#undef PG8_MMA
#undef PG8_WAIT_V
#undef PG8_WAIT_L
#undef PG8_BAR
#undef PG8_SCHED
}
}
#define GAS __attribute__((address_space(1)))
#define LAS __attribute__((address_space(3)))
typedef unsigned short bf16;
typedef unsigned v4u __attribute__((ext_vector_type(4)));
typedef float f32x4 __attribute__((ext_vector_type(4)));
typedef short bf16x8 __attribute__((ext_vector_type(8)));
typedef GAS unsigned gu32;
typedef GAS unsigned long long gu64;
#define RLX_AGENT __ATOMIC_RELAXED, __HIP_MEMORY_SCOPE_AGENT
#define LDS_WAIT() asm volatile("s_waitcnt lgkmcnt(0)" ::: "memory")
#define VM_WAIT() asm volatile("s_waitcnt vmcnt(0)" ::: "memory")
__device__ __forceinline__ unsigned long long rt() { return __builtin_amdgcn_s_memrealtime(); }
__device__ __forceinline__ unsigned f2bf(float f) { unsigned u = __builtin_bit_cast(unsigned, f); return (u + 0x7fffu + ((u >> 16) & 1u)) >> 16; }
__device__ __forceinline__ unsigned pk2(float lo, float hi) { return f2bf(lo) | (f2bf(hi) << 16); }

#define XB_TMO      128
#define XB_XCNT(j)  (256  + 64 * (j))
#define XB_XSUB(j)  (1280 + 64 * (j))
#define XB_XGEN(j)  (2304 + 64 * (j))
#define XB_TOP      3328
#define XB_TOPGEN   3392
#define XCD_BAR_WORDS 3456
#define XB_SPIN_CAP (1u << 18)

__device__ __forceinline__ unsigned xb_ld(unsigned* p)              { return __hip_atomic_load(p, __ATOMIC_RELAXED, __HIP_MEMORY_SCOPE_AGENT); }
__device__ __forceinline__ unsigned xb_add(unsigned* p, unsigned v) { return __hip_atomic_fetch_add(p, v, __ATOMIC_RELAXED, __HIP_MEMORY_SCOPE_AGENT); }
__device__ __forceinline__ unsigned xb_xcc_id() { return (unsigned)__builtin_amdgcn_s_getreg((3 << 11) | 20) & 0xFu; }
#define XB_SPIN(cond, bar) do { unsigned _sp = 0; while (cond) { __builtin_amdgcn_s_sleep(1); \
    if ((++_sp & 255u) == 0u) { if (xb_ld(&(bar)[XB_TMO])) break; if (_sp > XB_SPIN_CAP) { atomicAdd(&(bar)[XB_TMO], 1u); break; } } } } while (0)

struct XcdBarrier {
    unsigned* bar; unsigned x;
    volatile LAS unsigned* st;
};

__device__ __forceinline__ XcdBarrier xcd_barrier_post(unsigned* bar, volatile LAS unsigned* st) {
    XcdBarrier b; b.bar = bar; b.x = xb_xcc_id(); b.st = st;
    if (threadIdx.x == 0) (void)xb_add(&bar[XB_XCNT(b.x)], 1u);
    return b;
}
__device__ __forceinline__ void xcd_barrier_complete(unsigned* bar, unsigned x, unsigned& nloc, unsigned& nx) {
    const unsigned G = gridDim.x * gridDim.y * gridDim.z;
    unsigned sum, cnt, mine, sp = 0u;
    for (;;) {
        sum = 0u; cnt = 0u; mine = 0u;
#pragma unroll
        for (unsigned j = 0; j < 16; ++j) { const unsigned c = xb_ld(&bar[XB_XCNT(j)]); sum += c; cnt += (c > 0u) ? 1u : 0u; mine = (j == x) ? c : mine; }
        if (sum == G) break;
        __builtin_amdgcn_s_sleep(1);
        if ((++sp & 255u) == 0u) { if (xb_ld(&bar[XB_TMO])) break; if (sp > XB_SPIN_CAP) { atomicAdd(&bar[XB_TMO], 1u); break; } }
    }
    nloc = mine > 0u ? mine : 1u; nx = cnt > 0u ? cnt : 1u;
}

__device__ __forceinline__ void xcd_barrier(const XcdBarrier& b) {
    asm volatile("s_waitcnt vmcnt(0)" ::: "memory");
    __syncthreads();
    if (threadIdx.x == 0) {
        unsigned* bar = b.bar;
        __builtin_amdgcn_s_waitcnt(0);
        unsigned nloc = b.st[0], nx = b.st[1];
        if (nloc == 0u) { xcd_barrier_complete(bar, b.x, nloc, nx); b.st[0] = nloc; b.st[1] = nx; }
        const unsigned old = xb_add(&bar[XB_XSUB(b.x)], 1u);
        const unsigned gen = old / nloc;
        if (old + 1u == (gen + 1u) * nloc) {
            __builtin_amdgcn_fence(__ATOMIC_RELEASE, "agent");
            asm volatile("s_waitcnt vmcnt(0)" ::: "memory");
            const unsigned og = xb_add(&bar[XB_TOP], 1u);
            const unsigned tg = og / nx;
            if (og + 1u == (tg + 1u) * nx) xb_add(&bar[XB_TOPGEN], 1u);
            else XB_SPIN(xb_ld(&bar[XB_TOPGEN]) == tg, bar);
            __builtin_amdgcn_fence(__ATOMIC_ACQUIRE, "agent");
            xb_add(&bar[XB_XGEN(b.x)], 1u);
            asm volatile("s_waitcnt vmcnt(0)" ::: "memory");
        } else {
            XB_SPIN(xb_ld(&bar[XB_XGEN(b.x)]) == gen, bar);
            __builtin_amdgcn_fence(__ATOMIC_ACQUIRE, "agent");
            asm volatile("s_waitcnt vmcnt(0)" ::: "memory");
        }
    }
    __syncthreads();
}
constexpr int NWAVES = 8;
constexpr int BATCH = 16, SEQ = 2048, DM = 1024, M = BATCH * SEQ;
constexpr int L0P = 3584;
constexpr int L1P = 2048;
constexpr int DFF = 2816;
constexpr float ALPHA = 1.4142135623730951f;
typedef unsigned short bf16_t;
typedef float f32x16 __attribute__((ext_vector_type(16)));

constexpr size_t MiB = 1u << 20;
constexpr size_t WS_CTL = 0, CTL_ZERO_BYTES = 1 * MiB;
constexpr int CW_BAR = 4096;
constexpr size_t WS_W0IN = 2 * MiB, WS_W0OUT = 9 * MiB, WS_WUP0 = 11 * MiB, WS_WDN0 = 22 * MiB, WS_W1IN = 28 * MiB, WS_WUQ = 32 * MiB, WS_WUKV = 33 * MiB,
                 WS_W1OUT = 34 * MiB, WS_WUP1 = 36 * MiB, WS_WDN1 = 47 * MiB;
constexpr size_t WS_XB = 56 * MiB, WS_YMIX = 120 * MiB, WS_BIG = 184 * MiB;
constexpr size_t WS_YSSM = 408 * MiB, WS_DT = 472 * MiB;
constexpr size_t WS_GU = 120 * MiB;
constexpr size_t WS_PROJ1 = 184 * MiB, WS_QM = 312 * MiB, WS_KVM = 360 * MiB, WS_KPE = 424 * MiB, WS_RS = 426 * MiB;
constexpr size_t WS_NEED = 480 * MiB;

constexpr int RING_BYTES = 131072;
constexpr int LDSCTL_OFF = RING_BYTES, MISC_OFF = LDSCTL_OFF + 320;
constexpr int LDS_BYTES = 147456;

__device__ __forceinline__ float bf2f(bf16_t b) { return __builtin_bit_cast(float, (unsigned)b << 16); }
__device__ __forceinline__ float sigmoidf_(float x) { return 1.f / (1.f + expf(-x)); }
__device__ __forceinline__ float softplusf_(float x) { return fmaxf(x, 0.f) + log1pf(expf(-fabsf(x))); }
__device__ __forceinline__ float siluf_(float x) { return x / (1.f + expf(-x)); }
__device__ __forceinline__ float wave_sum(float v) {
#pragma unroll
    for (int o = 1; o < 64; o <<= 1) v += __shfl_xor(v, o);
    return v;
}
#define WSYNC() asm volatile("s_waitcnt lgkmcnt(0)" ::: "memory")

__device__ __forceinline__ void transpose_item(const float* __restrict__ W, int N, bf16_t* __restrict__ WT, int ldt, LAS float* scr, int kb, int nb, int lane, const float* __restrict__ kscale) {
    const int k0 = 64 * kb, n0 = 32 * nb;
#pragma unroll 8
    for (int i = 0; i < 32; ++i) { const int kk = 2 * i + (lane >> 5), n = n0 + (lane & 31); float v = (n < N) ? W[(size_t)(k0 + kk) * N + n] : 0.f; if (kscale) v *= kscale[k0 + kk]; scr[kk * 33 + (lane & 31)] = v; }
    WSYNC();
    const int c = lane & 7;
#pragma unroll
    for (int j = 0; j < 4; ++j) { const int n = (lane >> 3) + 8 * j; const LAS float* s = scr + (8 * c) * 33 + n;
        v4u o; o.x = pk2(s[0 * 33], s[1 * 33]); o.y = pk2(s[2 * 33], s[3 * 33]); o.z = pk2(s[4 * 33], s[5 * 33]); o.w = pk2(s[6 * 33], s[7 * 33]);
        *(v4u*)(WT + (size_t)(n0 + n) * ldt + k0 + 8 * c) = o; }
    WSYNC();
}
__device__ __forceinline__ void transpose_matrix(const float* W, int K, int N, bf16_t* WT, int Npad, int ldt, LAS float* scr, int gw, int NGW, int lane, const float* kscale) {
    const int nblk = Npad / 32, nit = (K / 64) * nblk;
    for (int it = gw; it < nit; it += NGW) transpose_item(W, N, WT, ldt, scr, it / nblk, it % nblk, lane, kscale);
}

__device__ __forceinline__ void ln_rows(float* h, bf16_t* hb, const float* __restrict__ g, const float* __restrict__ b, int gw, int NGW, int lane) {
    for (int row = gw; row < M; row += NGW) {
        float* p = h + (size_t)row * DM;
        f32x4 v[4]; float s = 0.f;
#pragma unroll
        for (int j = 0; j < 4; ++j) { v[j] = *(const f32x4*)(p + 4 * lane + 256 * j); s += (v[j][0] + v[j][1]) + (v[j][2] + v[j][3]); }
        const float mean = wave_sum(s) * (1.f / DM); float q = 0.f;
#pragma unroll
        for (int j = 0; j < 4; ++j) { v[j] = v[j] - mean; q += (v[j][0] * v[j][0] + v[j][1] * v[j][1]) + (v[j][2] * v[j][2] + v[j][3] * v[j][3]); }
        const float rstd = 1.0f / sqrtf(wave_sum(q) * (1.f / DM) + 1e-5f);
#pragma unroll
        for (int j = 0; j < 4; ++j) {
            const int c = 4 * lane + 256 * j;
            const f32x4 gg = *(const f32x4*)(g + c), bb = *(const f32x4*)(b + c);
            const f32x4 o = v[j] * rstd * gg + bb;
            *(f32x4*)(p + c) = o;
            uint2 w; w.x = pk2(o[0], o[1]); w.y = pk2(o[2], o[3]);
            *(uint2*)(hb + (size_t)row * DM + c) = w;
        }
    }
}

__device__ __forceinline__ void rwkv_naive_chain(int chain, int lane, LAS float* sm, const bf16_t* __restrict__ proj, const float* __restrict__ mix, const float* __restrict__ w0, const float* __restrict__ w2,
                                                 const float* __restrict__ a0, const float* __restrict__ a2, const float* __restrict__ g2, const float* __restrict__ k_k,
                                                 const float* __restrict__ k_a, const float* __restrict__ r_k, const float* __restrict__ ln_g, const float* __restrict__ ln_b, bf16_t* __restrict__ ymix) {
    LAS float* s_w2 = sm; LAS float* s_a2 = sm + 4096; LAS float* s_g2 = sm + 8192; LAS float* s_tw = sm + 16384; LAS float* s_al = s_tw + 64; LAS float* s_sg = s_tw + 128;
    LAS float* s_w = s_tw + 256; LAS float* s_k = s_tw + 320; LAS float* s_a = s_tw + 384; LAS float* s_b = s_tw + 448; LAS float* s_r = s_tw + 512;
    const int b = chain >> 3, h = chain & 7, c = h * 64 + lane;
    for (int l = 0; l < 64; ++l) { s_w2[l * 64 + lane] = w2[l * 512 + c]; s_a2[l * 64 + lane] = a2[l * 512 + c]; }
    for (int l = 0; l < 128; ++l) s_g2[l * 64 + lane] = g2[l * 512 + c];
    const float mr = mix[c], mk = mix[512 + c], mv = mix[1024 + c], mw = mix[1536 + lane], ma = mix[1600 + lane], mg0 = mix[1664 + lane], mg1 = mix[1728 + lane];
    const float w0c = w0[c], a0c = a0[c], kkc = k_k[c], kac = k_a[c], rkc = r_k[c], lgc = ln_g[c], lbc = ln_b[c];
    float S[64];
#pragma unroll
    for (int j = 0; j < 64; ++j) S[j] = 0.f;
    float pr = 0.f, pk = 0.f, pv = 0.f, pw = 0.f, pa = 0.f, pg0 = 0.f, pg1 = 0.f;
    WSYNC();
    for (int t = 0; t < SEQ; ++t) {
        const bf16_t* row = proj + (size_t)(b * SEQ + t) * L0P;
        const float cr = bf2f(row[c]), ck = bf2f(row[512 + c]), cv = bf2f(row[1024 + c]), cw = bf2f(row[1536 + lane]), ca = bf2f(row[1600 + lane]),
                    cg0 = bf2f(row[1664 + lane]), cg1 = bf2f(row[1728 + lane]);
        const float r_s = cr + (pr - cr) * mr, k_s = ck + (pk - ck) * mk, v_s = cv + (pv - cv) * mv;
        const float wl = cw + (pw - cw) * mw, al = ca + (pa - ca) * ma, g0 = cg0 + (pg0 - cg0) * mg0, g1 = cg1 + (pg1 - cg1) * mg1;
        pr = cr; pk = ck; pv = cv; pw = cw; pa = ca; pg0 = cg0; pg1 = cg1;
        s_tw[lane] = tanhf(wl); s_al[lane] = al; s_sg[lane] = sigmoidf_(g0); s_sg[64 + lane] = sigmoidf_(g1);
        WSYNC();
        float wsum = w0c, asum = a0c, gsum = 0.f;
#pragma unroll 2
        for (int l = 0; l < 64; ++l) { wsum += s_tw[l] * s_w2[l * 64 + lane]; asum += s_al[l] * s_a2[l * 64 + lane]; }
#pragma unroll 2
        for (int l = 0; l < 128; ++l) gsum += s_sg[l] * s_g2[l * 64 + lane];
        const float log_w = -softplusf_(-wsum) - 0.5f;
        const float dec = expf(-expf(log_w));
        const float a = sigmoidf_(asum);
        float kkv = k_s * kkc;
        const float nrm = sqrtf(wave_sum(kkv * kkv));
        kkv = kkv / fmaxf(nrm, 1e-12f);
        const float k2 = k_s * (1.f + (a - 1.f) * kac);
        const float bonus_s = wave_sum(r_s * k2 * rkc);
        s_w[lane] = dec; s_k[lane] = k2; s_a[lane] = -kkv; s_b[lane] = kkv * a; s_r[lane] = r_s;
        WSYNC();
        float sa = 0.f;
#pragma unroll
        for (int j = 0; j < 64; ++j) sa += S[j] * s_a[j];
        float y = 0.f;
#pragma unroll
        for (int j = 0; j < 64; ++j) { S[j] = S[j] * s_w[j] + sa * s_b[j] + v_s * s_k[j]; y += S[j] * s_r[j]; }
        const float mu = wave_sum(y) * (1.f / 64.f);
        const float d = y - mu;
        const float var = wave_sum(d * d) * (1.f / 64.f);
        const float yn = d * (1.0f / sqrtf(var + 64e-5f)) * lgc + lbc;
        const float o = (yn + bonus_s * v_s) * gsum;
        ymix[(size_t)(b * SEQ + t) * DM + c] = (bf16_t)f2bf(o);
        WSYNC();
    }
}

__device__ __forceinline__ void ssm_conv_all(const bf16_t* __restrict__ proj, const float* __restrict__ cw, const float* __restrict__ cb, const float* __restrict__ dtb,
                                             bf16_t* __restrict__ xbc, float* __restrict__ dt, int gtid, int NT) {
    for (size_t i = gtid; i < (size_t)M * 1024; i += NT) {
        const int m = (int)(i >> 10), c = (int)(i & 1023), t = m & (SEQ - 1);
        float acc = cb[c];
#pragma unroll
        for (int k = 0; k < 4; ++k) { const int tt = t - 3 + k; if (tt >= 0) acc += cw[k * 1024 + c] * bf2f(proj[(size_t)(m - 3 + k) * L0P + 2304 + c]); }
        xbc[i] = (bf16_t)f2bf(siluf_(acc));
    }
    for (int i = gtid; i < M * 8; i += NT) dt[i] = softplusf_(bf2f(proj[(size_t)(i >> 3) * L0P + 3328 + (i & 7)]) + dtb[i & 7]);
}
__device__ __forceinline__ void ssd_naive_task(int task, int lane, const bf16_t* __restrict__ xbc, const float* __restrict__ dt, const float* __restrict__ a_log, const float* __restrict__ dsk, float* __restrict__ yssm) {
    const int chain = task >> 2, q = task & 3, b = chain >> 3, h = chain & 7, g = h >> 2, p = q * 16 + (lane >> 2), nq = lane & 3;
    const float A = -expf(a_log[h]), D = dsk[h];
    float st[32];
#pragma unroll
    for (int n = 0; n < 32; ++n) st[n] = 0.f;
    for (int t = 0; t < SEQ; ++t) {
        const size_t m = (size_t)b * SEQ + t;
        const float dtv = dt[m * 8 + h], dA = expf(dtv * A);
        const float x = bf2f(xbc[m * 1024 + h * 64 + p]), xdt = x * dtv;
        const bf16_t* Bp = xbc + m * 1024 + 512 + g * 128 + nq * 32;
        const bf16_t* Cp = xbc + m * 1024 + 768 + g * 128 + nq * 32;
        float yp = 0.f;
#pragma unroll
        for (int n = 0; n < 32; ++n) { st[n] = st[n] * dA + xdt * bf2f(Bp[n]); yp += st[n] * bf2f(Cp[n]); }
        yp += __shfl_xor(yp, 1); yp += __shfl_xor(yp, 2);
        if (nq == 0) yssm[m * 512 + h * 64 + p] = yp + D * x;
    }
}
__device__ __forceinline__ void ssm_gate_norm_all(const float* __restrict__ yssm, const bf16_t* __restrict__ proj, const float* __restrict__ ng, bf16_t* __restrict__ ymix, int gw, int NGW, int lane) {
    for (int wv = gw; wv < M * 2; wv += NGW) {
        const int m = wv >> 1, g = wv & 1;
        float u[4], q = 0.f;
#pragma unroll
        for (int j = 0; j < 4; ++j) { const int c = g * 256 + j * 64 + lane; const float z = bf2f(proj[(size_t)m * L0P + 1792 + c]); u[j] = yssm[(size_t)m * 512 + c] * siluf_(z); q += u[j] * u[j]; }
        const float rs = 1.0f / sqrtf(wave_sum(q) * (1.f / 256.f) + 1e-5f);
#pragma unroll
        for (int j = 0; j < 4; ++j) { const int c = g * 256 + j * 64 + lane; ymix[(size_t)m * DM + 512 + c] = (bf16_t)f2bf(u[j] * rs * ng[c]); }
    }
}
__device__ __forceinline__ void ffn_act_all(bf16_t* gu, const float* __restrict__ cw, const float* __restrict__ cb, int gtid, int NT) {
    for (size_t i = gtid; i < (size_t)M * DFF; i += NT) {
        const int m = (int)(i / DFF), c = (int)(i - (size_t)m * DFF), t = m & (SEQ - 1);
        float acc = cb[c];
#pragma unroll
        for (int k = 0; k < 3; ++k) { const int tt = t - 2 + k; if (tt >= 0) acc += cw[k * DFF + c] * bf2f(gu[(size_t)(m - 2 + k) * (2 * DFF) + c]); }
        const size_t o = (size_t)m * (2 * DFF) + DFF + c;
        gu[o] = (bf16_t)f2bf(siluf_(acc) * bf2f(gu[o]));
    }
}
__device__ __forceinline__ void mla_prep_all(const bf16_t* __restrict__ proj1, const int* __restrict__ pos, float* __restrict__ rs, bf16_t* __restrict__ kpe, int gw, int NGW, int lane) {
    for (int m = gw; m < M; m += NGW) {
        const bf16_t* row = proj1 + (size_t)m * L1P;
        float q = 0.f;
#pragma unroll
        for (int j = 0; j < 4; ++j) { const float v = bf2f(row[1536 + j * 64 + lane]); q += v * v; }
        q = wave_sum(q);
        float k = 0.f;
#pragma unroll
        for (int j = 0; j < 2; ++j) { const float v = bf2f(row[1792 + j * 64 + lane]); k += v * v; }
        k = wave_sum(k);
        if (lane == 0) { rs[(size_t)m * 2] = 1.0f / sqrtf(q * (1.f / 256.f) + 1e-6f); rs[(size_t)m * 2 + 1] = 1.0f / sqrtf(k * (1.f / 128.f) + 1e-6f); }
        if (lane < 16) {
            const double inv = pow(10000.0, -(double)(2 * lane) / 32.0);
            const double ang = (double)pos[m] * inv;
            const float cs = (float)cos(ang), sn = (float)sin(ang);
            const float x1 = bf2f(row[1920 + lane]), x2 = bf2f(row[1936 + lane]);
            kpe[(size_t)m * 32 + lane] = (bf16_t)f2bf(x1 * cs - x2 * sn);
            kpe[(size_t)m * 32 + 16 + lane] = (bf16_t)f2bf(x2 * cs + x1 * sn);
        }
    }
}
__device__ __forceinline__ void rope_q_all(bf16_t* qm, const int* __restrict__ pos, int gtid, int NT) {
    for (int i = gtid; i < M * 128; i += NT) {
        const int m = i >> 7, h = (i >> 4) & 7, k = i & 15;
        const double inv = pow(10000.0, -(double)(2 * k) / 32.0);
        const double ang = (double)pos[m] * inv;
        const float cs = (float)cos(ang), sn = (float)sin(ang);
        bf16_t* p = qm + (size_t)m * 768 + h * 96 + 64;
        const float x1 = bf2f(p[k]), x2 = bf2f(p[16 + k]);
        p[k] = (bf16_t)f2bf(x1 * cs - x2 * sn); p[16 + k] = (bf16_t)f2bf(x2 * cs + x1 * sn);
    }
}
__device__ __forceinline__ void sb_naive_task(int qblk, int bh, int lane, const bf16_t* __restrict__ proj1, bf16_t* __restrict__ ymix) {
    const int b = bh >> 3, h = bh & 7, t = qblk * 64 + lane;
    const size_t mrow = (size_t)b * SEQ;
    float q[64], o[64];
#pragma unroll
    for (int d = 0; d < 64; ++d) { q[d] = bf2f(proj1[(mrow + t) * L1P + h * 64 + d]) * 0.125f; o[d] = 0.f; }
    float cum = 0.f;
    const int smax = qblk * 64 + 63;
    for (int s = smax - 1; s >= 0; --s) {
        const bf16_t* kr = proj1 + (mrow + s) * L1P + 512 + h * 64;
        const bf16_t* vr = proj1 + (mrow + s) * L1P + 1024 + h * 64;
        float z = 0.f;
#pragma unroll
        for (int d = 0; d < 64; ++d) z += q[d] * bf2f(kr[d]);
        if (s < t) {
            const float lsp = -softplusf_(-z);
            const float lsn = -softplusf_(z);
            const float att = expf(lsp + cum);
            cum += lsn;
#pragma unroll
            for (int d = 0; d < 64; ++d) o[d] += att * bf2f(vr[d]);
        }
    }
#pragma unroll
    for (int d = 0; d < 64; ++d) ymix[(mrow + t) * DM + h * 64 + d] = (bf16_t)f2bf(o[d]);
}
__device__ __forceinline__ void mla_naive_task(int qblk, int bh, int lane, const bf16_t* __restrict__ qm, const bf16_t* __restrict__ kvm, const bf16_t* __restrict__ kpe, bf16_t* __restrict__ ymix) {
    const int b = bh >> 3, h = bh & 7, t = qblk * 64 + lane;
    const size_t mrow = (size_t)b * SEQ;
    const float scale = 0.10206207261596577f;
    float q[96], o[64];
#pragma unroll
    for (int d = 0; d < 96; ++d) q[d] = bf2f(qm[(mrow + t) * 768 + h * 96 + d]) * scale;
#pragma unroll
    for (int d = 0; d < 64; ++d) o[d] = 0.f;
    float mx = -1e30f, l = 0.f;
    const int smax = qblk * 64 + 63;
    for (int s = 0; s <= smax; ++s) {
        const bf16_t* kr = kvm + (mrow + s) * 1024 + h * 128;
        const bf16_t* pr = kpe + (mrow + s) * 32;
        float z = 0.f;
#pragma unroll
        for (int d = 0; d < 64; ++d) z += q[d] * bf2f(kr[d]);
#pragma unroll
        for (int d = 0; d < 32; ++d) z += q[64 + d] * bf2f(pr[d]);
        if (s <= t) {
            const float mn = fmaxf(mx, z), f = expf(mx - mn), pz = expf(z - mn);
            l = l * f + pz; mx = mn;
#pragma unroll
            for (int d = 0; d < 64; ++d) o[d] = o[d] * f + pz * bf2f(kr[64 + d]);
        }
    }
    const float il = 1.f / l;
#pragma unroll
    for (int d = 0; d < 64; ++d) ymix[(mrow + t) * DM + 512 + h * 64 + d] = (bf16_t)f2bf(o[d] * il);
}

struct Args { const float* in[43]; float* out; unsigned char* ws; };
#define GEMM_PHASE(EPI, Aptr, LDA, Bptr, LDB, NN, KK, ...) do { pg8::Gemm g_{(Aptr), (Bptr), M, (NN), (KK), (LDA), (LDB)}; pg8::StaticOrder S_; S_.init(M, (NN), G, (int)blockIdx.x); \
        pg8::EPI E_{__VA_ARGS__}; pg8::gemm_phase<pg8::EPI, pg8::StaticOrder, true, true>(lds3, g_, S_, E_); } while (0)

__global__ void __launch_bounds__(NWAVES * 64, 2) fwd_mega(Args args) {
    extern __shared__ __attribute__((aligned(16))) unsigned char lds[];
    LAS unsigned char* lds3 = (LAS unsigned char*)lds;
    volatile LAS unsigned* MISC = (volatile LAS unsigned*)(lds3 + MISC_OFF);
    const int tid = threadIdx.x, lane = tid & 63, wave = __builtin_amdgcn_readfirstlane(tid >> 6);
    const int G = gridDim.x, gw = blockIdx.x * NWAVES + wave, NGW = G * NWAVES, gtid = blockIdx.x * (NWAVES * 64) + tid, NT = G * NWAVES * 64;
    unsigned char* ws = args.ws;
    gu32* ctl = (gu32*)(ws + WS_CTL);
    for (int u = tid; u < (LDS_BYTES - LDSCTL_OFF) / 4; u += NWAVES * 64) ((LAS unsigned*)(lds3 + LDSCTL_OFF))[u] = 0u;
    __syncthreads();
    XcdBarrier bar = xcd_barrier_post((unsigned*)(ctl + CW_BAR), MISC + 8);
#define GRID_BAR() xcd_barrier(bar)
#define IN(i) (args.in[i])
    float* out = args.out;
    bf16_t* W0in = (bf16_t*)(ws + WS_W0IN); bf16_t* W0out = (bf16_t*)(ws + WS_W0OUT); bf16_t* Wup0 = (bf16_t*)(ws + WS_WUP0); bf16_t* Wdn0 = (bf16_t*)(ws + WS_WDN0);
    bf16_t* W1in = (bf16_t*)(ws + WS_W1IN); bf16_t* Wuq = (bf16_t*)(ws + WS_WUQ); bf16_t* Wukv = (bf16_t*)(ws + WS_WUKV); bf16_t* W1out = (bf16_t*)(ws + WS_W1OUT);
    bf16_t* Wup1 = (bf16_t*)(ws + WS_WUP1); bf16_t* Wdn1 = (bf16_t*)(ws + WS_WDN1);
    bf16_t* XB = (bf16_t*)(ws + WS_XB); bf16_t* YMIX = (bf16_t*)(ws + WS_YMIX); bf16_t* PROJ0 = (bf16_t*)(ws + WS_BIG);
    float* YSSM = (float*)(ws + WS_YSSM); float* DT = (float*)(ws + WS_DT); bf16_t* GU = (bf16_t*)(ws + WS_GU);
    bf16_t* PROJ1 = (bf16_t*)(ws + WS_PROJ1); bf16_t* QM = (bf16_t*)(ws + WS_QM); bf16_t* KVM = (bf16_t*)(ws + WS_KVM); bf16_t* KPE = (bf16_t*)(ws + WS_KPE); float* RS = (float*)(ws + WS_RS);
    const int* pos = (const int*)args.in[1];

    {
        LAS float* scr = (LAS float*)(lds3 + wave * 16384);
        transpose_matrix(IN(2), 1024, 3336, W0in, L0P, 1024, scr, gw, NGW, lane, nullptr);
        transpose_matrix(IN(20), 1024, 1024, W0out, 1024, 1024, scr, gw, NGW, lane, nullptr);
        transpose_matrix(IN(23), 1024, 5632, Wup0, 5632, 1024, scr, gw, NGW, lane, nullptr);
        transpose_matrix(IN(26), 2816, 1024, Wdn0, 1024, 2816, scr, gw, NGW, lane, nullptr);
        transpose_matrix(IN(29), 1024, 1952, W1in, L1P, 1024, scr, gw, NGW, lane, nullptr);
        transpose_matrix(IN(31), 256, 768, Wuq, 768, 256, scr, gw, NGW, lane, IN(30));
        transpose_matrix(IN(33), 128, 1024, Wukv, 1024, 256, scr, gw, NGW, lane, IN(32));
        for (int i = gtid; i < 1024 * 16; i += NT) { const int n = i >> 4, c = i & 15; *(v4u*)(Wukv + (size_t)n * 256 + 128 + c * 8) = (v4u){0u, 0u, 0u, 0u}; }
        transpose_matrix(IN(34), 1024, 1024, W1out, 1024, 1024, scr, gw, NGW, lane, nullptr);
        transpose_matrix(IN(37), 1024, 5632, Wup1, 5632, 1024, scr, gw, NGW, lane, nullptr);
        transpose_matrix(IN(40), 2816, 1024, Wdn1, 1024, 2816, scr, gw, NGW, lane, nullptr);
        const float* x = IN(0);
        for (size_t i = (size_t)gtid * 4; i < (size_t)M * DM; i += (size_t)NT * 4) { const f32x4 v = *(const f32x4*)(x + i); uint2 w; w.x = pk2(v[0], v[1]); w.y = pk2(v[2], v[3]); *(uint2*)(XB + i) = w; }
    }
    GRID_BAR();
    GEMM_PHASE(EpiBf16S, XB, DM, W0in, 1024, L0P, 1024, PROJ0, nullptr, L0P, 0);
    GRID_BAR();
    ssm_conv_all(PROJ0, IN(14), IN(15), IN(16), XB, DT, gtid, NT);
#ifndef NO_RWKV
    if (blockIdx.x < 128 && wave == 0)
        rwkv_naive_chain((int)blockIdx.x, lane, (LAS float*)lds3, PROJ0, IN(3), IN(4), IN(5), IN(6), IN(7), IN(8), IN(9), IN(10), IN(11), IN(12), IN(13), YMIX);
#endif
    GRID_BAR();
#ifndef NO_SSD
    if (wave < 2) ssd_naive_task((int)blockIdx.x + 256 * wave, lane, XB, DT, IN(17), IN(18), YSSM);
#endif
    GRID_BAR();
    ssm_gate_norm_all(YSSM, PROJ0, IN(19), YMIX, gw, NGW, lane);
    GRID_BAR();
    GEMM_PHASE(EpiResid, YMIX, DM, W0out, 1024, 1024, 1024, IN(0), out, ALPHA, 0);
    GRID_BAR();
    ln_rows(out, XB, IN(21), IN(22), gw, NGW, lane);
    GRID_BAR();
    GEMM_PHASE(EpiBf16S, XB, DM, Wup0, 1024, 2 * DFF, 1024, GU, nullptr, 2 * DFF, 0);
    GRID_BAR();
    ffn_act_all(GU, IN(24), IN(25), gtid, NT);
    GRID_BAR();
    GEMM_PHASE(EpiResid, GU + DFF, 2 * DFF, Wdn0, DFF, 1024, DFF, out, out, ALPHA, 0);
    GRID_BAR();
    ln_rows(out, XB, IN(27), IN(28), gw, NGW, lane);
    GRID_BAR();
    GEMM_PHASE(EpiBf16S, XB, DM, W1in, 1024, L1P, 1024, PROJ1, nullptr, L1P, 0);
    GRID_BAR();
    mla_prep_all(PROJ1, pos, RS, KPE, gw, NGW, lane);
    GRID_BAR();
    GEMM_PHASE(EpiBf16S, PROJ1 + 1536, L1P, Wuq, 256, 768, 256, QM, RS, 768, 2);
    GEMM_PHASE(EpiBf16S, PROJ1 + 1792, L1P, Wukv, 256, 1024, 256, KVM, RS + 1, 1024, 2);
    GRID_BAR();
    rope_q_all(QM, pos, gtid, NT);
    GRID_BAR();
#ifndef NO_SB
    for (int i = 0; i < 2; ++i) { const int task = gw + NGW * i; if (task < 4096) { const int qb = (i == 0) ? (task & 31) : 31 - (task & 31); sb_naive_task(qb, task >> 5, lane, PROJ1, YMIX); } }
#endif
#ifndef NO_MLA
    for (int i = 0; i < 2; ++i) { const int task = gw + NGW * i; if (task < 4096) { const int qb = (i == 0) ? (task & 31) : 31 - (task & 31); mla_naive_task(qb, task >> 5, lane, QM, KVM, KPE, YMIX); } }
#endif
    GRID_BAR();
    GEMM_PHASE(EpiResid, YMIX, DM, W1out, 1024, 1024, 1024, out, out, ALPHA, 0);
    GRID_BAR();
    ln_rows(out, XB, IN(35), IN(36), gw, NGW, lane);
    GRID_BAR();
    GEMM_PHASE(EpiBf16S, XB, DM, Wup1, 1024, 2 * DFF, 1024, GU, nullptr, 2 * DFF, 0);
    GRID_BAR();
    ffn_act_all(GU, IN(38), IN(39), gtid, NT);
    GRID_BAR();
    GEMM_PHASE(EpiResid, GU + DFF, 2 * DFF, Wdn1, DFF, 1024, DFF, out, out, ALPHA, 0);
    GRID_BAR();
    ln_rows(out, XB, IN(41), IN(42), gw, NGW, lane);
}

extern "C" void kernel_launch(void* const* d_in, const int* in_sizes, int n_in, void* d_out, int out_size, void* d_ws, size_t ws_size, hipStream_t stream) {
    static int grid = 0;
    if (grid == 0) {
        if (n_in != 43 || ws_size < WS_NEED || out_size != M * DM) { fprintf(stderr, "kernel_launch: unexpected n_in %d / ws %zu / out %d\n", n_in, ws_size, out_size); grid = -1; return; }
        int dev = 0, cus = 0, per_cu = 0;
        if (hipGetDevice(&dev) != hipSuccess || hipDeviceGetAttribute(&cus, hipDeviceAttributeMultiprocessorCount, dev) != hipSuccess) { grid = -1; return; }
        if (hipFuncSetAttribute((const void*)fwd_mega, hipFuncAttributeMaxDynamicSharedMemorySize, LDS_BYTES) != hipSuccess) { fprintf(stderr, "kernel_launch: hipFuncSetAttribute failed\n"); grid = -1; return; }
        if (hipOccupancyMaxActiveBlocksPerMultiprocessor(&per_cu, (const void*)fwd_mega, NWAVES * 64, LDS_BYTES) != hipSuccess || per_cu < 1) fprintf(stderr, "kernel_launch: occupancy query reports %d\n", per_cu);
        (void)hipGetLastError();
        grid = cus;
    }
    if (grid < 0) return;
    (void)hipMemsetAsync((char*)d_ws + WS_CTL, 0, CTL_ZERO_BYTES, stream);
    Args a{};
    for (int i = 0; i < 43; ++i) a.in[i] = (const float*)d_in[i];
    a.out = (float*)d_out; a.ws = (unsigned char*)d_ws;
    hipLaunchKernelGGL(fwd_mega, dim3(grid), dim3(NWAVES * 64), LDS_BYTES, stream, a);
}
```

```cpp
#include <hip/hip_runtime.h>
#include <cstdio>
#include <cstdint>
#include <cmath>
namespace pg8 {
#define PG8_LAS __attribute__((address_space(3)))
typedef unsigned short bf16_t;
typedef short bf16x8 __attribute__((ext_vector_type(8)));
typedef float f32x4 __attribute__((ext_vector_type(4)));
typedef unsigned u32x4 __attribute__((ext_vector_type(4)));
constexpr int BM = 256, BK = 64, HALF = 128, HTB = HALF * BK * 2  , STAGE_BYTES = 8 * HTB, NXCD = 8, WGM = 8;

__host__ __device__ __forceinline__ int lds_byte(int r, int c) { const int st = (r >> 4) * 2 + (c >> 5), rr = r & 15, cc = c & 31, ob = rr * 64 + cc * 2; return st * 1024 + (ob ^ (((ob >> 9) & 1) << 5)); }
__host__ __device__ __forceinline__ void stage_rc(int b, int& R, int& C) { const int st = b / 1024, sb = b % 1024, swz = sb ^ (((sb >> 9) & 1) << 5); R = (st >> 1) * 16 + swz / 64; C = (st & 1) * 32 + (swz % 64) / 2; }
__host__ __device__ __forceinline__ int perm32(int rho) { const int n = rho >> 4, i = rho & 15; return 8 * (i >> 2) + 4 * n + (i & 3); }

struct Unit { int pm, pn; };
struct Gemm { const bf16_t* A; const bf16_t* Bt; int M, N, K, lda, ldb; };

struct StaticOrder {
    int nM, nN, nwg, G, c;
    __host__ __device__ void init(int M, int N, int G_, int c_) { nM = M / BM; nN = N / BM; nwg = nM * nN; G = G_; c = c_; }
    __host__ __device__ bool next(int i, Unit& u) const {
        const long L = (long)i * G + c; if (L >= nwg) return false;
        int wgid = (int)L; { const int q = nwg / NXCD, r = nwg % NXCD, xcd = wgid % NXCD, off = wgid / NXCD; wgid = (xcd < r ? xcd * (q + 1) : r * (q + 1) + (xcd - r) * q) + off; }
        const int nig = WGM * nN, gid = wgid / nig, fm = gid * WGM, gsz = (nM - fm) < WGM ? (nM - fm) : WGM;
        u.pm = fm + ((wgid % nig) % gsz); u.pn = (wgid % nig) / gsz; return true;
    }
    __device__ __forceinline__ void a_ready(const Unit&) const {}
    __device__ __forceinline__ void done(const Unit&) const {}
};


__device__ __forceinline__ unsigned cvt_pk_bf16(float lo, float hi) { unsigned r; asm volatile("v_cvt_pk_bf16_f32 %0, %1, %2" : "=v"(r) : "v"(lo), "v"(hi)); return r; }
struct EpiBf16S {
    static constexpr bool PERM = true, AFTER_DRAIN = false;
    bf16_t* O; const float* rowscale; int ldc; int rs_stride;
    __device__ __forceinline__ void operator()(const f32x4 (&acc)[2][2][4][2], const Unit& u, int wr, int wc, int fr, int fq) const {
        const int row0 = u.pm * BM + wr * 64 + fr, col0 = u.pn * BM + wc * 32 + 8 * fq;
#pragma unroll
        for (int ai = 0; ai < 2; ++ai)
#pragma unroll
            for (int m = 0; m < 4; ++m) { const int row = row0 + ai * HALF + m * 16; const float sc = rowscale ? rowscale[(size_t)row * rs_stride] : 1.f;
                bf16_t* rowp = O + (size_t)row * ldc + col0;
#pragma unroll
                for (int bj = 0; bj < 2; ++bj) { const f32x4 v0 = acc[ai][bj][m][0] * sc, v1 = acc[ai][bj][m][1] * sc;
                    u32x4 w; w.x = cvt_pk_bf16(v0[0], v0[1]); w.y = cvt_pk_bf16(v0[2], v0[3]); w.z = cvt_pk_bf16(v1[0], v1[1]); w.w = cvt_pk_bf16(v1[2], v1[3]);
                    *(u32x4*)(rowp + bj * HALF) = w; } }
    }
};
struct EpiResid {
    static constexpr bool PERM = false, AFTER_DRAIN = false;
    const float* hin; float* hout; float alpha; int pad;
    __device__ __forceinline__ void operator()(const f32x4 (&acc)[2][2][4][2], const Unit& u, int wr, int wc, int fr, int fq) const {
        const int row0 = u.pm * BM + wr * 64 + fr, col0 = u.pn * BM + wc * 32 + 4 * fq;
#pragma unroll
        for (int ai = 0; ai < 2; ++ai)
#pragma unroll
            for (int m = 0; m < 4; ++m) { const size_t off = (size_t)(row0 + ai * HALF + m * 16) * 1024 + col0;
#pragma unroll
                for (int bj = 0; bj < 2; ++bj)
#pragma unroll
                    for (int n = 0; n < 2; ++n) { const size_t i = off + bj * HALF + n * 16; const f32x4 h = *(const f32x4*)(hin + i); *(f32x4*)(hout + i) = h * alpha + acc[ai][bj][m][n]; } }
    }
};
template <class Epi, class Sched, bool ALIGN_EPI = false, bool SP2 = false>
__device__ __forceinline__ void gemm_phase(PG8_LAS unsigned char* lds, const Gemm g, const Sched& S, const Epi& E) {
    const int tid = threadIdx.x, wid = __builtin_amdgcn_readfirstlane(tid >> 6), lane = tid & 63, wr = wid >> 2, wc = wid & 3, fr = lane & 15, fq = lane >> 4;
    const int K = g.K, nt = K / BK;
    unsigned voffA[2], voffB[2];
#pragma unroll
    for (int i = 0; i < 2; ++i) { int R, C; stage_rc(tid * 16 + i * 8192, R, C); const int Rb = Epi::PERM ? ((R & ~31) + perm32(R & 31)) : R;
        voffA[i] = (unsigned)(R * g.lda + C) * 2u; voffB[i] = (unsigned)(Rb * g.ldb + C) * 2u; }
    const size_t kstep = (size_t)(BK * 2);
    const size_t hstepA = (size_t)HALF * g.lda * 2, hstepB = (size_t)HALF * g.ldb * 2;
    const size_t tstepA = 2 * hstepA, tstepB = 2 * hstepB;
    const unsigned ldsw = (unsigned)wid * 1024u;
    const int aoff = lds_byte(wr * 64 + fr, fq * 8), boff = lds_byte(wc * 32 + fr, fq * 8);
#define PG8_SA(b, h) (((b) * 2 + (h)) * HTB)
#define PG8_SB(b, h) ((4 + (b) * 2 + (h)) * HTB)
#define PG8_STAGE(bufoff, gbase, voff) do { _Pragma("unroll") for (int _i = 0; _i < 2; ++_i) \
        __builtin_amdgcn_global_load_lds((const unsigned*)((const char*)(gbase) + (voff)[_i]), (PG8_LAS unsigned*)(lds + (bufoff) + ldsw + _i * 8192), 16, 0, 0); } while (0)
#define PG8_LDA(dst, b, h) do { _Pragma("unroll") for (int m = 0; m < 4; ++m) _Pragma("unroll") for (int k = 0; k < 2; ++k) dst[m][k] = *(const PG8_LAS bf16x8*)(lds + PG8_SA(b, h) + aoff + m * 2048 + k * 1024); } while (0)
#define PG8_LDB(dst, b, h) do { _Pragma("unroll") for (int n = 0; n < 2; ++n) _Pragma("unroll") for (int k = 0; k < 2; ++k) dst[n][k] = *(const PG8_LAS bf16x8*)(lds + PG8_SB(b, h) + boff + n * 2048 + k * 1024); } while (0)
#define PG8_MMA(ai, bj, At, Bt) do { __builtin_amdgcn_s_setprio(1); _Pragma("unroll") for (int m = 0; m < 4; ++m) _Pragma("unroll") for (int n = 0; n < 2; ++n) _Pragma("unroll") for (int k = 0; k < 2; ++k) \
        acc[ai][bj][m][n] = __builtin_amdgcn_mfma_f32_16x16x32_bf16(Bt[n][k], At[m][k], acc[ai][bj][m][n], 0, 0, 0); __builtin_amdgcn_s_setprio(0); } while (0)
#define PG8_WAIT_V(n) asm volatile("s_waitcnt vmcnt(" #n ")" ::: "memory")
#define PG8_WAIT_L(n) asm volatile("s_waitcnt lgkmcnt(" #n ")" ::: "memory")
#define PG8_BAR __builtin_amdgcn_s_barrier()
#define PG8_SCHED __builtin_amdgcn_sched_barrier(0)
    Unit cur, nxt; int ui = 0;
    if (!S.next(0, cur)) return;
    f32x4 acc[2][2][4][2];
#pragma unroll
    for (int a = 0; a < 2; ++a)
#pragma unroll
        for (int b = 0; b < 2; ++b)
#pragma unroll
            for (int m = 0; m < 4; ++m)
#pragma unroll
                for (int n = 0; n < 2; ++n) acc[a][b][m][n] = (f32x4){0.f, 0.f, 0.f, 0.f};
    bf16x8 At[4][2], B0[2][2], B1[2][2];
    const char* cA = (const char*)g.A + (size_t)cur.pm * tstepA; const char* cB = (const char*)g.Bt + (size_t)cur.pn * tstepB;
    S.a_ready(cur);
    if constexpr (SP2) {
        PG8_STAGE(PG8_SB(0, 0), cB, voffB); PG8_STAGE(PG8_SB(0, 1), cB + hstepB, voffB); PG8_STAGE(PG8_SA(0, 0), cA, voffA); PG8_STAGE(PG8_SA(0, 1), cA + hstepA, voffA);
        if (wr == 1) PG8_BAR;
        PG8_WAIT_V(2); PG8_BAR;
        PG8_STAGE(PG8_SB(1, 0), cB + kstep, voffB); PG8_STAGE(PG8_SA(1, 0), cA + kstep, voffA); PG8_STAGE(PG8_SB(1, 1), cB + hstepB + kstep, voffB);
        PG8_WAIT_V(6); PG8_BAR;
    } else {
        PG8_STAGE(PG8_SB(0, 0), cB, voffB); PG8_STAGE(PG8_SA(0, 0), cA, voffA); PG8_STAGE(PG8_SB(0, 1), cB + hstepB, voffB); PG8_STAGE(PG8_SA(0, 1), cA + hstepA, voffA);
        if (wr == 1) PG8_BAR;
        PG8_WAIT_V(4); PG8_BAR;
        PG8_STAGE(PG8_SB(1, 0), cB + kstep, voffB); PG8_STAGE(PG8_SA(1, 0), cA + kstep, voffA); PG8_STAGE(PG8_SB(1, 1), cB + hstepB + kstep, voffB);
        PG8_WAIT_V(6); PG8_BAR;
    }
    for (;;) {
        const bool has_next = S.next(ui + 1, nxt);
        const char* nA = has_next ? (const char*)g.A + (size_t)nxt.pm * tstepA : cA; const char* nB = has_next ? (const char*)g.Bt + (size_t)nxt.pn * tstepB : cB;
        for (int t = 0; t < nt; t += 2) {
            const bool last = (t == nt - 2);
            const char* a1 = cA + (size_t)(t + 1) * kstep;
            const char* a2 = last ? nA : cA + (size_t)(t + 2) * kstep; const char* b2 = last ? nB : cB + (size_t)(t + 2) * kstep;
            const char* a3 = a2 + kstep; const char* b3 = b2 + kstep;
            if (last && has_next) S.a_ready(nxt);
            if constexpr (SP2) {
            PG8_LDB(B0, 0, 0); PG8_LDB(B1, 0, 1); PG8_SCHED; PG8_LDA(At, 0, 0); PG8_STAGE(PG8_SA(1, 1), a1 + hstepA, voffA);
            PG8_WAIT_V(8); PG8_WAIT_L(0); PG8_BAR; PG8_MMA(0, 0, At, B0); PG8_MMA(0, 1, At, B1); PG8_BAR; PG8_SCHED;
            PG8_LDA(At, 0, 1); PG8_STAGE(PG8_SB(0, 0), b2, voffB); PG8_STAGE(PG8_SB(0, 1), b2 + hstepB, voffB); PG8_STAGE(PG8_SA(0, 0), a2, voffA);
            PG8_WAIT_V(8); PG8_WAIT_L(0); PG8_BAR; PG8_MMA(1, 0, At, B0); PG8_MMA(1, 1, At, B1); PG8_BAR; PG8_SCHED;
            PG8_LDB(B0, 1, 0); PG8_LDB(B1, 1, 1); PG8_SCHED; PG8_LDA(At, 1, 0); PG8_STAGE(PG8_SA(0, 1), a2 + hstepA, voffA);
            PG8_WAIT_V(8); PG8_WAIT_L(0); PG8_BAR; PG8_MMA(0, 0, At, B0); PG8_MMA(0, 1, At, B1); PG8_BAR; PG8_SCHED;
            PG8_LDA(At, 1, 1); PG8_STAGE(PG8_SB(1, 0), b3, voffB); PG8_STAGE(PG8_SB(1, 1), b3 + hstepB, voffB); PG8_STAGE(PG8_SA(1, 0), a3, voffA);
            PG8_WAIT_V(8); PG8_WAIT_L(0); PG8_BAR; PG8_MMA(1, 0, At, B0); PG8_MMA(1, 1, At, B1); PG8_BAR; PG8_SCHED;
            } else {
            PG8_LDB(B0, 0, 0); PG8_SCHED; PG8_LDA(At, 0, 0); PG8_STAGE(PG8_SA(1, 1), a1 + hstepA, voffA);
            PG8_WAIT_L(8); PG8_BAR; PG8_WAIT_L(0); PG8_MMA(0, 0, At, B0); PG8_BAR; PG8_SCHED;
            PG8_LDB(B1, 0, 1); PG8_STAGE(PG8_SB(0, 0), b2, voffB);
            PG8_BAR; PG8_WAIT_L(0); PG8_MMA(0, 1, At, B1); PG8_BAR;
            PG8_LDA(At, 0, 1); PG8_STAGE(PG8_SA(0, 0), a2, voffA);
            PG8_BAR; PG8_WAIT_L(0); PG8_MMA(1, 0, At, B0); PG8_BAR; PG8_SCHED;
            PG8_STAGE(PG8_SB(0, 1), b2 + hstepB, voffB);
            PG8_WAIT_V(6); PG8_BAR; PG8_MMA(1, 1, At, B1); PG8_BAR;
            PG8_LDB(B0, 1, 0); PG8_SCHED; PG8_LDA(At, 1, 0); PG8_STAGE(PG8_SA(0, 1), a2 + hstepA, voffA);
            PG8_WAIT_L(8); PG8_BAR; PG8_WAIT_L(0); PG8_MMA(0, 0, At, B0); PG8_BAR; PG8_SCHED;
            PG8_LDB(B1, 1, 1); PG8_STAGE(PG8_SB(1, 0), b3, voffB);
            PG8_BAR; PG8_WAIT_L(0); PG8_MMA(0, 1, At, B1); PG8_BAR;
            PG8_LDA(At, 1, 1); PG8_STAGE(PG8_SA(1, 0), a3, voffA);
            PG8_BAR; PG8_WAIT_L(0); PG8_MMA(1, 0, At, B0); PG8_BAR; PG8_SCHED;
            PG8_STAGE(PG8_SB(1, 1), b3 + hstepB, voffB);
            PG8_WAIT_V(6); PG8_BAR; PG8_MMA(1, 1, At, B1); PG8_BAR;
            }
        }
        if constexpr (ALIGN_EPI) { if (wr == 0) PG8_BAR; }
        if constexpr (!Epi::AFTER_DRAIN) { E(acc, cur, wr, wc, fr, fq); S.done(cur); }
        if (!has_next) break;
#pragma unroll
        for (int a = 0; a < 2; ++a)
#pragma unroll
            for (int b = 0; b < 2; ++b)
#pragma unroll
                for (int m = 0; m < 4; ++m)
#pragma unroll
                    for (int n = 0; n < 2; ++n) acc[a][b][m][n] = (f32x4){0.f, 0.f, 0.f, 0.f};
        cur = nxt; cA = nA; cB = nB; ++ui;
        if constexpr (ALIGN_EPI) { if (wr == 1) PG8_BAR; }
    }
    PG8_WAIT_V(0);
    if constexpr (!ALIGN_EPI) { if (wr == 0) PG8_BAR; }
    PG8_BAR;
    if constexpr (Epi::AFTER_DRAIN) { E.fused(acc, cur, wr, wc, fr, fq, lds, wid, lane); S.done(cur); }
#undef PG8_SA
#undef PG8_SB
#undef PG8_STAGE
#undef PG8_LDA
#undef PG8_LDB
#undef PG8_MMA
#undef PG8_WAIT_V
#undef PG8_WAIT_L
#undef PG8_BAR
#undef PG8_SCHED
}
}
#define GAS __attribute__((address_space(1)))
#define LAS __attribute__((address_space(3)))
typedef unsigned short bf16;
typedef unsigned v4u __attribute__((ext_vector_type(4)));
typedef float f32x4 __attribute__((ext_vector_type(4)));
typedef short bf16x8 __attribute__((ext_vector_type(8)));
typedef GAS unsigned gu32;
typedef GAS unsigned long long gu64;
#define RLX_AGENT __ATOMIC_RELAXED, __HIP_MEMORY_SCOPE_AGENT
#define LDS_WAIT() asm volatile("s_waitcnt lgkmcnt(0)" ::: "memory")
#define VM_WAIT() asm volatile("s_waitcnt vmcnt(0)" ::: "memory")
__device__ __forceinline__ unsigned long long rt() { return __builtin_amdgcn_s_memrealtime(); }
__device__ __forceinline__ unsigned f2bf(float f) { unsigned u = __builtin_bit_cast(unsigned, f); return (u + 0x7fffu + ((u >> 16) & 1u)) >> 16; }
__device__ __forceinline__ unsigned pk2(float lo, float hi) { return f2bf(lo) | (f2bf(hi) << 16); }

#define XB_TMO      128
#define XB_XCNT(j)  (256  + 64 * (j))
#define XB_XSUB(j)  (1280 + 64 * (j))
#define XB_XGEN(j)  (2304 + 64 * (j))
#define XB_TOP      3328
#define XB_TOPGEN   3392
#define XCD_BAR_WORDS 3456
#define XB_SPIN_CAP (1u << 18)

__device__ __forceinline__ unsigned xb_ld(unsigned* p)              { return __hip_atomic_load(p, __ATOMIC_RELAXED, __HIP_MEMORY_SCOPE_AGENT); }
__device__ __forceinline__ unsigned xb_add(unsigned* p, unsigned v) { return __hip_atomic_fetch_add(p, v, __ATOMIC_RELAXED, __HIP_MEMORY_SCOPE_AGENT); }
__device__ __forceinline__ unsigned xb_xcc_id() { return (unsigned)__builtin_amdgcn_s_getreg((3 << 11) | 20) & 0xFu; }
#define XB_SPIN(cond, bar) do { unsigned _sp = 0; while (cond) { __builtin_amdgcn_s_sleep(1); \
    if ((++_sp & 255u) == 0u) { if (xb_ld(&(bar)[XB_TMO])) break; if (_sp > XB_SPIN_CAP) { atomicAdd(&(bar)[XB_TMO], 1u); break; } } } } while (0)

struct XcdBarrier {
    unsigned* bar; unsigned x;
    volatile LAS unsigned* st;
};

__device__ __forceinline__ XcdBarrier xcd_barrier_post(unsigned* bar, volatile LAS unsigned* st) {
    XcdBarrier b; b.bar = bar; b.x = xb_xcc_id(); b.st = st;
    if (threadIdx.x == 0) (void)xb_add(&bar[XB_XCNT(b.x)], 1u);
    return b;
}
__device__ __forceinline__ void xcd_barrier_complete(unsigned* bar, unsigned x, unsigned& nloc, unsigned& nx) {
    const unsigned G = gridDim.x * gridDim.y * gridDim.z;
    unsigned sum, cnt, mine, sp = 0u;
    for (;;) {
        sum = 0u; cnt = 0u; mine = 0u;
#pragma unroll
        for (unsigned j = 0; j < 16; ++j) { const unsigned c = xb_ld(&bar[XB_XCNT(j)]); sum += c; cnt += (c > 0u) ? 1u : 0u; mine = (j == x) ? c : mine; }
        if (sum == G) break;
        __builtin_amdgcn_s_sleep(1);
        if ((++sp & 255u) == 0u) { if (xb_ld(&bar[XB_TMO])) break; if (sp > XB_SPIN_CAP) { atomicAdd(&bar[XB_TMO], 1u); break; } }
    }
    nloc = mine > 0u ? mine : 1u; nx = cnt > 0u ? cnt : 1u;
}

__device__ __forceinline__ void xcd_barrier(const XcdBarrier& b) {
    asm volatile("s_waitcnt vmcnt(0)" ::: "memory");
    __syncthreads();
    if (threadIdx.x == 0) {
        unsigned* bar = b.bar;
        __builtin_amdgcn_s_waitcnt(0);
        unsigned nloc = b.st[0], nx = b.st[1];
        if (nloc == 0u) { xcd_barrier_complete(bar, b.x, nloc, nx); b.st[0] = nloc; b.st[1] = nx; }
        const unsigned old = xb_add(&bar[XB_XSUB(b.x)], 1u);
        const unsigned gen = old / nloc;
        if (old + 1u == (gen + 1u) * nloc) {
            __builtin_amdgcn_fence(__ATOMIC_RELEASE, "agent");
            asm volatile("s_waitcnt vmcnt(0)" ::: "memory");
            const unsigned og = xb_add(&bar[XB_TOP], 1u);
            const unsigned tg = og / nx;
            if (og + 1u == (tg + 1u) * nx) xb_add(&bar[XB_TOPGEN], 1u);
            else XB_SPIN(xb_ld(&bar[XB_TOPGEN]) == tg, bar);
            __builtin_amdgcn_fence(__ATOMIC_ACQUIRE, "agent");
            xb_add(&bar[XB_XGEN(b.x)], 1u);
            asm volatile("s_waitcnt vmcnt(0)" ::: "memory");
        } else {
            XB_SPIN(xb_ld(&bar[XB_XGEN(b.x)]) == gen, bar);
            __builtin_amdgcn_fence(__ATOMIC_ACQUIRE, "agent");
            asm volatile("s_waitcnt vmcnt(0)" ::: "memory");
        }
    }
    __syncthreads();
}
constexpr int NWAVES = 8;
constexpr int BATCH = 16, SEQ = 2048, DM = 1024, M = BATCH * SEQ;
constexpr int L0P = 3584;
constexpr int L1P = 2048;
constexpr int DFF = 2816;
constexpr float ALPHA = 1.4142135623730951f;
typedef unsigned short bf16_t;
typedef float f32x16 __attribute__((ext_vector_type(16)));

constexpr size_t MiB = 1u << 20;
constexpr size_t WS_CTL = 0, CTL_ZERO_BYTES = 1 * MiB;
constexpr int CW_BAR = 4096;
constexpr size_t WS_W0IN = 2 * MiB, WS_W0OUT = 9 * MiB, WS_WUP0 = 11 * MiB, WS_WDN0 = 22 * MiB, WS_W1IN = 28 * MiB, WS_WUQ = 32 * MiB, WS_WUKV = 33 * MiB,
                 WS_W1OUT = 34 * MiB, WS_WUP1 = 36 * MiB, WS_WDN1 = 47 * MiB;
constexpr size_t WS_XB = 56 * MiB, WS_YMIX = 120 * MiB, WS_BIG = 184 * MiB;
constexpr size_t WS_YSSM = 408 * MiB, WS_DT = 472 * MiB;
constexpr size_t WS_GU = 120 * MiB;
constexpr size_t WS_PROJ1 = 184 * MiB, WS_QM = 312 * MiB, WS_KVM = 360 * MiB, WS_KPE = 424 * MiB, WS_RS = 426 * MiB;
constexpr size_t WS_VTS = 428 * MiB, WS_VTM = 460 * MiB;
constexpr size_t WS_NEED = 492 * MiB;

constexpr int RING_BYTES = 131072;
constexpr int LDSCTL_OFF = RING_BYTES, MISC_OFF = LDSCTL_OFF + 320;
constexpr int LDS_BYTES = 147456;

__device__ __forceinline__ float bf2f(bf16_t b) { return __builtin_bit_cast(float, (unsigned)b << 16); }
__device__ __forceinline__ float sigmoidf_(float x) { return 1.f / (1.f + expf(-x)); }
__device__ __forceinline__ float softplusf_(float x) { return fmaxf(x, 0.f) + log1pf(expf(-fabsf(x))); }
__device__ __forceinline__ float siluf_(float x) { return x / (1.f + expf(-x)); }
__device__ __forceinline__ float wave_sum(float v) {
#pragma unroll
    for (int o = 1; o < 64; o <<= 1) v += __shfl_xor(v, o);
    return v;
}
#define WSYNC() asm volatile("s_waitcnt lgkmcnt(0)" ::: "memory")

__device__ __forceinline__ void transpose_item(const float* __restrict__ W, int N, bf16_t* __restrict__ WT, int ldt, LAS float* scr, int kb, int nb, int lane, const float* __restrict__ kscale) {
    const int k0 = 64 * kb, n0 = 32 * nb;
#pragma unroll 8
    for (int i = 0; i < 32; ++i) { const int kk = 2 * i + (lane >> 5), n = n0 + (lane & 31); float v = (n < N) ? W[(size_t)(k0 + kk) * N + n] : 0.f; if (kscale) v *= kscale[k0 + kk]; scr[kk * 33 + (lane & 31)] = v; }
    WSYNC();
    const int c = lane & 7;
#pragma unroll
    for (int j = 0; j < 4; ++j) { const int n = (lane >> 3) + 8 * j; const LAS float* s = scr + (8 * c) * 33 + n;
        v4u o; o.x = pk2(s[0 * 33], s[1 * 33]); o.y = pk2(s[2 * 33], s[3 * 33]); o.z = pk2(s[4 * 33], s[5 * 33]); o.w = pk2(s[6 * 33], s[7 * 33]);
        *(v4u*)(WT + (size_t)(n0 + n) * ldt + k0 + 8 * c) = o; }
    WSYNC();
}
__device__ __forceinline__ void transpose_matrix(const float* W, int K, int N, bf16_t* WT, int Npad, int ldt, LAS float* scr, int gw, int NGW, int lane, const float* kscale) {
    const int nblk = Npad / 32, nit = (K / 64) * nblk;
    for (int it = gw; it < nit; it += NGW) transpose_item(W, N, WT, ldt, scr, it / nblk, it % nblk, lane, kscale);
}

__device__ __forceinline__ void ln_rows(float* h, bf16_t* hb, const float* __restrict__ g, const float* __restrict__ b, int gw, int NGW, int lane) {
    for (int row = gw; row < M; row += NGW) {
        float* p = h + (size_t)row * DM;
        f32x4 v[4]; float s = 0.f;
#pragma unroll
        for (int j = 0; j < 4; ++j) { v[j] = *(const f32x4*)(p + 4 * lane + 256 * j); s += (v[j][0] + v[j][1]) + (v[j][2] + v[j][3]); }
        const float mean = wave_sum(s) * (1.f / DM); float q = 0.f;
#pragma unroll
        for (int j = 0; j < 4; ++j) { v[j] = v[j] - mean; q += (v[j][0] * v[j][0] + v[j][1] * v[j][1]) + (v[j][2] * v[j][2] + v[j][3] * v[j][3]); }
        const float rstd = 1.0f / sqrtf(wave_sum(q) * (1.f / DM) + 1e-5f);
#pragma unroll
        for (int j = 0; j < 4; ++j) {
            const int c = 4 * lane + 256 * j;
            const f32x4 gg = *(const f32x4*)(g + c), bb = *(const f32x4*)(b + c);
            const f32x4 o = v[j] * rstd * gg + bb;
            *(f32x4*)(p + c) = o;
            uint2 w; w.x = pk2(o[0], o[1]); w.y = pk2(o[2], o[3]);
            *(uint2*)(hb + (size_t)row * DM + c) = w;
        }
    }
}

__device__ __forceinline__ void rwkv_naive_chain(int chain, int lane, LAS float* sm, const bf16_t* __restrict__ proj, const float* __restrict__ mix, const float* __restrict__ w0, const float* __restrict__ w2,
                                                 const float* __restrict__ a0, const float* __restrict__ a2, const float* __restrict__ g2, const float* __restrict__ k_k,
                                                 const float* __restrict__ k_a, const float* __restrict__ r_k, const float* __restrict__ ln_g, const float* __restrict__ ln_b, bf16_t* __restrict__ ymix) {
    LAS float* s_w2 = sm; LAS float* s_a2 = sm + 4096; LAS float* s_g2 = sm + 8192; LAS float* s_tw = sm + 16384; LAS float* s_al = s_tw + 64; LAS float* s_sg = s_tw + 128;
    LAS float* s_w = s_tw + 256; LAS float* s_k = s_tw + 320; LAS float* s_a = s_tw + 384; LAS float* s_b = s_tw + 448; LAS float* s_r = s_tw + 512;
    const int b = chain >> 3, h = chain & 7, c = h * 64 + lane;
    for (int l = 0; l < 64; ++l) { s_w2[l * 64 + lane] = w2[l * 512 + c]; s_a2[l * 64 + lane] = a2[l * 512 + c]; }
    for (int l = 0; l < 128; ++l) s_g2[l * 64 + lane] = g2[l * 512 + c];
    const float mr = mix[c], mk = mix[512 + c], mv = mix[1024 + c], mw = mix[1536 + lane], ma = mix[1600 + lane], mg0 = mix[1664 + lane], mg1 = mix[1728 + lane];
    const float w0c = w0[c], a0c = a0[c], kkc = k_k[c], kac = k_a[c], rkc = r_k[c], lgc = ln_g[c], lbc = ln_b[c];
    float S[64];
#pragma unroll
    for (int j = 0; j < 64; ++j) S[j] = 0.f;
    float pr = 0.f, pk = 0.f, pv = 0.f, pw = 0.f, pa = 0.f, pg0 = 0.f, pg1 = 0.f;
    WSYNC();
    for (int t = 0; t < SEQ; ++t) {
        const bf16_t* row = proj + (size_t)(b * SEQ + t) * L0P;
        const float cr = bf2f(row[c]), ck = bf2f(row[512 + c]), cv = bf2f(row[1024 + c]), cw = bf2f(row[1536 + lane]), ca = bf2f(row[1600 + lane]),
                    cg0 = bf2f(row[1664 + lane]), cg1 = bf2f(row[1728 + lane]);
        const float r_s = cr + (pr - cr) * mr, k_s = ck + (pk - ck) * mk, v_s = cv + (pv - cv) * mv;
        const float wl = cw + (pw - cw) * mw, al = ca + (pa - ca) * ma, g0 = cg0 + (pg0 - cg0) * mg0, g1 = cg1 + (pg1 - cg1) * mg1;
        pr = cr; pk = ck; pv = cv; pw = cw; pa = ca; pg0 = cg0; pg1 = cg1;
        s_tw[lane] = tanhf(wl); s_al[lane] = al; s_sg[lane] = sigmoidf_(g0); s_sg[64 + lane] = sigmoidf_(g1);
        WSYNC();
        float wsum = w0c, asum = a0c, gsum = 0.f;
#pragma unroll 2
        for (int l = 0; l < 64; ++l) { wsum += s_tw[l] * s_w2[l * 64 + lane]; asum += s_al[l] * s_a2[l * 64 + lane]; }
#pragma unroll 2
        for (int l = 0; l < 128; ++l) gsum += s_sg[l] * s_g2[l * 64 + lane];
        const float log_w = -softplusf_(-wsum) - 0.5f;
        const float dec = expf(-expf(log_w));
        const float a = sigmoidf_(asum);
        float kkv = k_s * kkc;
        const float nrm = sqrtf(wave_sum(kkv * kkv));
        kkv = kkv / fmaxf(nrm, 1e-12f);
        const float k2 = k_s * (1.f + (a - 1.f) * kac);
        const float bonus_s = wave_sum(r_s * k2 * rkc);
        s_w[lane] = dec; s_k[lane] = k2; s_a[lane] = -kkv; s_b[lane] = kkv * a; s_r[lane] = r_s;
        WSYNC();
        float sa = 0.f;
#pragma unroll
        for (int j = 0; j < 64; ++j) sa += S[j] * s_a[j];
        float y = 0.f;
#pragma unroll
        for (int j = 0; j < 64; ++j) { S[j] = S[j] * s_w[j] + sa * s_b[j] + v_s * s_k[j]; y += S[j] * s_r[j]; }
        const float mu = wave_sum(y) * (1.f / 64.f);
        const float d = y - mu;
        const float var = wave_sum(d * d) * (1.f / 64.f);
        const float yn = d * (1.0f / sqrtf(var + 64e-5f)) * lgc + lbc;
        const float o = (yn + bonus_s * v_s) * gsum;
        ymix[(size_t)(b * SEQ + t) * DM + c] = (bf16_t)f2bf(o);
        WSYNC();
    }
}

__device__ __forceinline__ void ssm_conv_all(const bf16_t* __restrict__ proj, const float* __restrict__ cw, const float* __restrict__ cb, const float* __restrict__ dtb,
                                             bf16_t* __restrict__ xbc, float* __restrict__ dt, int gtid, int NT) {
    for (size_t i = gtid; i < (size_t)M * 1024; i += NT) {
        const int m = (int)(i >> 10), c = (int)(i & 1023), t = m & (SEQ - 1);
        float acc = cb[c];
#pragma unroll
        for (int k = 0; k < 4; ++k) { const int tt = t - 3 + k; if (tt >= 0) acc += cw[k * 1024 + c] * bf2f(proj[(size_t)(m - 3 + k) * L0P + 2304 + c]); }
        xbc[i] = (bf16_t)f2bf(siluf_(acc));
    }
    for (int i = gtid; i < M * 8; i += NT) dt[i] = softplusf_(bf2f(proj[(size_t)(i >> 3) * L0P + 3328 + (i & 7)]) + dtb[i & 7]);
}
__device__ __forceinline__ void ssd_naive_task(int task, int lane, const bf16_t* __restrict__ xbc, const float* __restrict__ dt, const float* __restrict__ a_log, const float* __restrict__ dsk, float* __restrict__ yssm) {
    const int chain = task >> 2, q = task & 3, b = chain >> 3, h = chain & 7, g = h >> 2, p = q * 16 + (lane >> 2), nq = lane & 3;
    const float A = -expf(a_log[h]), D = dsk[h];
    float st[32];
#pragma unroll
    for (int n = 0; n < 32; ++n) st[n] = 0.f;
    for (int t = 0; t < SEQ; ++t) {
        const size_t m = (size_t)b * SEQ + t;
        const float dtv = dt[m * 8 + h], dA = expf(dtv * A);
        const float x = bf2f(xbc[m * 1024 + h * 64 + p]), xdt = x * dtv;
        const bf16_t* Bp = xbc + m * 1024 + 512 + g * 128 + nq * 32;
        const bf16_t* Cp = xbc + m * 1024 + 768 + g * 128 + nq * 32;
        float yp = 0.f;
#pragma unroll
        for (int n = 0; n < 32; ++n) { st[n] = st[n] * dA + xdt * bf2f(Bp[n]); yp += st[n] * bf2f(Cp[n]); }
        yp += __shfl_xor(yp, 1); yp += __shfl_xor(yp, 2);
        if (nq == 0) yssm[m * 512 + h * 64 + p] = yp + D * x;
    }
}
__device__ __forceinline__ void ssm_gate_norm_all(const float* __restrict__ yssm, const bf16_t* __restrict__ proj, const float* __restrict__ ng, bf16_t* __restrict__ ymix, int gw, int NGW, int lane) {
    for (int wv = gw; wv < M * 2; wv += NGW) {
        const int m = wv >> 1, g = wv & 1;
        float u[4], q = 0.f;
#pragma unroll
        for (int j = 0; j < 4; ++j) { const int c = g * 256 + j * 64 + lane; const float z = bf2f(proj[(size_t)m * L0P + 1792 + c]); u[j] = yssm[(size_t)m * 512 + c] * siluf_(z); q += u[j] * u[j]; }
        const float rs = 1.0f / sqrtf(wave_sum(q) * (1.f / 256.f) + 1e-5f);
#pragma unroll
        for (int j = 0; j < 4; ++j) { const int c = g * 256 + j * 64 + lane; ymix[(size_t)m * DM + 512 + c] = (bf16_t)f2bf(u[j] * rs * ng[c]); }
    }
}
__device__ __forceinline__ void ffn_act_all(bf16_t* gu, const float* __restrict__ cw, const float* __restrict__ cb, int gtid, int NT) {
    for (size_t i = gtid; i < (size_t)M * DFF; i += NT) {
        const int m = (int)(i / DFF), c = (int)(i - (size_t)m * DFF), t = m & (SEQ - 1);
        float acc = cb[c];
#pragma unroll
        for (int k = 0; k < 3; ++k) { const int tt = t - 2 + k; if (tt >= 0) acc += cw[k * DFF + c] * bf2f(gu[(size_t)(m - 2 + k) * (2 * DFF) + c]); }
        const size_t o = (size_t)m * (2 * DFF) + DFF + c;
        gu[o] = (bf16_t)f2bf(siluf_(acc) * bf2f(gu[o]));
    }
}
__device__ __forceinline__ void mla_prep_all(const bf16_t* __restrict__ proj1, const int* __restrict__ pos, float* __restrict__ rs, bf16_t* __restrict__ kpe, int gw, int NGW, int lane) {
    for (int m = gw; m < M; m += NGW) {
        const bf16_t* row = proj1 + (size_t)m * L1P;
        float q = 0.f;
#pragma unroll
        for (int j = 0; j < 4; ++j) { const float v = bf2f(row[1536 + j * 64 + lane]); q += v * v; }
        q = wave_sum(q);
        float k = 0.f;
#pragma unroll
        for (int j = 0; j < 2; ++j) { const float v = bf2f(row[1792 + j * 64 + lane]); k += v * v; }
        k = wave_sum(k);
        if (lane == 0) { rs[(size_t)m * 2] = 1.0f / sqrtf(q * (1.f / 256.f) + 1e-6f); rs[(size_t)m * 2 + 1] = 1.0f / sqrtf(k * (1.f / 128.f) + 1e-6f); }
        if (lane < 16) {
            const double inv = pow(10000.0, -(double)(2 * lane) / 32.0);
            const double ang = (double)pos[m] * inv;
            const float cs = (float)cos(ang), sn = (float)sin(ang);
            const float x1 = bf2f(row[1920 + lane]), x2 = bf2f(row[1936 + lane]);
            kpe[(size_t)m * 32 + lane] = (bf16_t)f2bf(x1 * cs - x2 * sn);
            kpe[(size_t)m * 32 + 16 + lane] = (bf16_t)f2bf(x2 * cs + x1 * sn);
        }
    }
}
__device__ __forceinline__ void rope_q_all(bf16_t* qm, const int* __restrict__ pos, int gtid, int NT) {
    for (int i = gtid; i < M * 128; i += NT) {
        const int m = i >> 7, h = (i >> 4) & 7, k = i & 15;
        const double inv = pow(10000.0, -(double)(2 * k) / 32.0);
        const double ang = (double)pos[m] * inv;
        const float cs = (float)cos(ang), sn = (float)sin(ang);
        bf16_t* p = qm + (size_t)m * 768 + h * 96 + 64;
        const float x1 = bf2f(p[k]), x2 = bf2f(p[16 + k]);
        p[k] = (bf16_t)f2bf(x1 * cs - x2 * sn); p[16 + k] = (bf16_t)f2bf(x2 * cs + x1 * sn);
    }
}
__device__ __forceinline__ void sb_naive_task(int qblk, int bh, int lane, const bf16_t* __restrict__ proj1, bf16_t* __restrict__ ymix) {
    const int b = bh >> 3, h = bh & 7, t = qblk * 64 + lane;
    const size_t mrow = (size_t)b * SEQ;
    float q[64], o[64];
#pragma unroll
    for (int d = 0; d < 64; ++d) { q[d] = bf2f(proj1[(mrow + t) * L1P + h * 64 + d]) * 0.125f; o[d] = 0.f; }
    float cum = 0.f;
    const int smax = qblk * 64 + 63;
    for (int s = smax - 1; s >= 0; --s) {
        const bf16_t* kr = proj1 + (mrow + s) * L1P + 512 + h * 64;
        const bf16_t* vr = proj1 + (mrow + s) * L1P + 1024 + h * 64;
        float z = 0.f;
#pragma unroll
        for (int d = 0; d < 64; ++d) z += q[d] * bf2f(kr[d]);
        if (s < t) {
            const float lsp = -softplusf_(-z);
            const float lsn = -softplusf_(z);
            const float att = expf(lsp + cum);
            cum += lsn;
#pragma unroll
            for (int d = 0; d < 64; ++d) o[d] += att * bf2f(vr[d]);
        }
    }
#pragma unroll
    for (int d = 0; d < 64; ++d) ymix[(mrow + t) * DM + h * 64 + d] = (bf16_t)f2bf(o[d]);
}
__device__ __forceinline__ void mla_naive_task(int qblk, int bh, int lane, const bf16_t* __restrict__ qm, const bf16_t* __restrict__ kvm, const bf16_t* __restrict__ kpe, bf16_t* __restrict__ ymix) {
    const int b = bh >> 3, h = bh & 7, t = qblk * 64 + lane;
    const size_t mrow = (size_t)b * SEQ;
    const float scale = 0.10206207261596577f;
    float q[96], o[64];
#pragma unroll
    for (int d = 0; d < 96; ++d) q[d] = bf2f(qm[(mrow + t) * 768 + h * 96 + d]) * scale;
#pragma unroll
    for (int d = 0; d < 64; ++d) o[d] = 0.f;
    float mx = -1e30f, l = 0.f;
    const int smax = qblk * 64 + 63;
    for (int s = 0; s <= smax; ++s) {
        const bf16_t* kr = kvm + (mrow + s) * 1024 + h * 128;
        const bf16_t* pr = kpe + (mrow + s) * 32;
        float z = 0.f;
#pragma unroll
        for (int d = 0; d < 64; ++d) z += q[d] * bf2f(kr[d]);
#pragma unroll
        for (int d = 0; d < 32; ++d) z += q[64 + d] * bf2f(pr[d]);
        if (s <= t) {
            const float mn = fmaxf(mx, z), f = expf(mx - mn), pz = expf(z - mn);
            l = l * f + pz; mx = mn;
#pragma unroll
            for (int d = 0; d < 64; ++d) o[d] = o[d] * f + pz * bf2f(kr[64 + d]);
        }
    }
    const float il = 1.f / l;
#pragma unroll
    for (int d = 0; d < 64; ++d) ymix[(mrow + t) * DM + 512 + h * 64 + d] = (bf16_t)f2bf(o[d] * il);
}


typedef float f32x2_t __attribute__((ext_vector_type(2)));
typedef __bf16 bf16x2_t __attribute__((ext_vector_type(2)));
typedef unsigned u32x2 __attribute__((ext_vector_type(2)));
__device__ __forceinline__ unsigned cvtpk(float lo, float hi) { f32x2_t v = {lo, hi}; bf16x2_t b = __builtin_convertvector(v, bf16x2_t); return __builtin_bit_cast(unsigned, b); }
__device__ __forceinline__ int crow(int r, int hi) { return (r & 3) + 8 * (r >> 2) + 4 * hi; }
#define MFMA32(a, b, c) __builtin_amdgcn_mfma_f32_32x32x16_bf16((a), (b), (c), 0, 0, 0)
constexpr int STG_PITCH = 72;
__device__ __forceinline__ void transpose_tile64(const bf16_t* __restrict__ src, int sp, bf16_t* __restrict__ dst, int dp, LAS bf16_t* scr, int lane) {
#pragma unroll
    for (int i = 0; i < 8; ++i) { const int row = i * 8 + (lane >> 3), ch = lane & 7; const v4u v = *(const v4u*)(src + (size_t)row * sp + ch * 8); *(LAS v4u*)(scr + row * STG_PITCH + ch * 8) = v; }
    WSYNC();
#pragma unroll
    for (int i = 0; i < 8; ++i) { const int d = i * 8 + (lane >> 3), tc = lane & 7; const LAS bf16_t* p = scr + (tc * 8) * STG_PITCH + d;
        v4u o; o.x = (unsigned)p[0] | ((unsigned)p[STG_PITCH] << 16); o.y = (unsigned)p[2 * STG_PITCH] | ((unsigned)p[3 * STG_PITCH] << 16);
        o.z = (unsigned)p[4 * STG_PITCH] | ((unsigned)p[5 * STG_PITCH] << 16); o.w = (unsigned)p[6 * STG_PITCH] | ((unsigned)p[7 * STG_PITCH] << 16);
        *(v4u*)(dst + (size_t)d * dp + tc * 8) = o; }
    WSYNC();
}
__device__ __forceinline__ void store_OT(const f32x16 (&o)[2], float sc, LAS bf16_t* stg, bf16_t* __restrict__ dst, int lane) {
    const int l31 = lane & 31, hi = lane >> 5;
#pragma unroll
    for (int dt = 0; dt < 2; ++dt)
#pragma unroll
        for (int r = 0; r < 16; ++r) stg[l31 * STG_PITCH + 32 * dt + crow(r, hi)] = (bf16_t)f2bf(o[dt][r] * sc);
    WSYNC();
#pragma unroll
    for (int i = 0; i < 4; ++i) { const int row = i * 8 + (lane >> 3), ch = lane & 7; const v4u v = *(const LAS v4u*)(stg + row * STG_PITCH + ch * 8); *(v4u*)(dst + (size_t)row * DM + ch * 8) = v; }
    WSYNC();
}
__device__ __forceinline__ float softplus_fast(float z) { return fmaxf(z, 0.f) + __logf(1.f + __expf(-fabsf(z))); }

__device__ __forceinline__ void sb_task(int bh, int qblk, int lane, const bf16_t* __restrict__ P1, const bf16_t* __restrict__ VT, bf16_t* __restrict__ ymix, LAS bf16_t* stg) {
    const int b = bh >> 3, h = bh & 7, l31 = lane & 31, hi = lane >> 5, q0 = qblk * 32, t = q0 + l31;
    const size_t rowb = (size_t)b * SEQ;
    const bf16_t* Qp = P1 + (rowb + q0 + l31) * L1P + h * 64 + 8 * hi;
    bf16x8 qf[4];
#pragma unroll
    for (int kk = 0; kk < 4; ++kk) qf[kk] = *(const bf16x8*)(Qp + 16 * kk);
    const bf16_t* Kp = P1 + (rowb + l31) * L1P + 512 + h * 64 + 8 * hi;
    const bf16_t* Vp = VT + ((size_t)bh * 64 + l31) * SEQ + 4 * hi;
    f32x16 o[2];
#pragma unroll
    for (int r = 0; r < 16; ++r) { o[0][r] = 0.f; o[1][r] = 0.f; }
    float cum = 0.f;
    bf16x8 kf[4]; u32x2 va[2][2][2];
#define SB_LOAD(S0, KF, VA) do { _Pragma("unroll") for (int kk = 0; kk < 4; ++kk) KF[kk] = *(const bf16x8*)(Kp + (size_t)(S0) * L1P + 16 * kk); \
        _Pragma("unroll") for (int dt = 0; dt < 2; ++dt) _Pragma("unroll") for (int ks = 0; ks < 2; ++ks) { VA[dt][ks][0] = *(const u32x2*)(Vp + (size_t)dt * 32 * SEQ + (S0) + 16 * ks); VA[dt][ks][1] = *(const u32x2*)(Vp + (size_t)dt * 32 * SEQ + (S0) + 16 * ks + 8); } } while (0)
    SB_LOAD(q0, kf, va);
    for (int s0 = q0; s0 >= 0; s0 -= 32) {
        bf16x8 kn[4]; u32x2 vn[2][2][2];
        const int sn = (s0 >= 32) ? s0 - 32 : 0;
        SB_LOAD(sn, kn, vn);
        f32x16 acc;
#pragma unroll
        for (int r = 0; r < 16; ++r) acc[r] = 0.f;
#pragma unroll
        for (int kk = 0; kk < 4; ++kk) acc = MFMA32(kf[kk], qf[kk], acc);
        const bool diag = (s0 == q0);
        float lb[16], lk[16];
#pragma unroll
        for (int r = 0; r < 16; ++r) { const float z = acc[r] * 0.125f; const float sp = softplus_fast(z); float b_ = z - sp, k_ = -sp;
            if (diag) { const bool valid = (s0 + crow(r, hi)) < t; b_ = valid ? b_ : -1e30f; k_ = valid ? k_ : 0.f; }
            lb[r] = b_; lk[r] = k_; }
        float e[16], T[4], U[4];
#pragma unroll
        for (int i = 0; i < 4; ++i) { e[4 * i + 3] = 0.f; e[4 * i + 2] = lk[4 * i + 3]; e[4 * i + 1] = e[4 * i + 2] + lk[4 * i + 2]; e[4 * i] = e[4 * i + 1] + lk[4 * i + 1]; T[i] = e[4 * i] + lk[4 * i]; }
#pragma unroll
        for (int i = 0; i < 4; ++i) U[i] = __shfl_xor(T[i], 32);
        float off[4];
        { const float st2 = T[3], st1 = st2 + T[2], st0 = st1 + T[1]; const float su2 = U[3], su1 = su2 + U[2], su0 = su1 + U[1];
          const float x0 = hi ? 0.f : U[0], x1 = hi ? 0.f : U[1], x2 = hi ? 0.f : U[2], x3 = hi ? 0.f : U[3];
          off[3] = x3; off[2] = st2 + su2 + x2; off[1] = st1 + su1 + x1; off[0] = st0 + su0 + x0;
          const float total = st0 + T[0] + su0 + U[0];
#pragma unroll
          for (int r = 0; r < 16; ++r) acc[r] = __expf(lb[r] + (cum + off[r >> 2] + e[r]));
          cum += total; }
        bf16x8 pf[2];
#pragma unroll
        for (int ks = 0; ks < 2; ++ks) { v4u w; w.x = cvtpk(acc[8 * ks], acc[8 * ks + 1]); w.y = cvtpk(acc[8 * ks + 2], acc[8 * ks + 3]); w.z = cvtpk(acc[8 * ks + 4], acc[8 * ks + 5]); w.w = cvtpk(acc[8 * ks + 6], acc[8 * ks + 7]); pf[ks] = __builtin_bit_cast(bf16x8, w); }
#pragma unroll
        for (int dt = 0; dt < 2; ++dt)
#pragma unroll
            for (int ks = 0; ks < 2; ++ks) { v4u a; a.x = va[dt][ks][0].x; a.y = va[dt][ks][0].y; a.z = va[dt][ks][1].x; a.w = va[dt][ks][1].y; o[dt] = MFMA32(__builtin_bit_cast(bf16x8, a), pf[ks], o[dt]); }
        if (__all(cum < -110.f)) break;
#pragma unroll
        for (int kk = 0; kk < 4; ++kk) kf[kk] = kn[kk];
#pragma unroll
        for (int dt = 0; dt < 2; ++dt)
#pragma unroll
            for (int ks = 0; ks < 2; ++ks) { va[dt][ks][0] = vn[dt][ks][0]; va[dt][ks][1] = vn[dt][ks][1]; }
    }
#undef SB_LOAD
    store_OT(o, 1.0f, stg, ymix + (rowb + q0) * DM + h * 64, lane);
}
__device__ __forceinline__ void mla_task(int bh, int qblk, int lane, const bf16_t* __restrict__ QM, const bf16_t* __restrict__ KVM, const bf16_t* __restrict__ KPE, const bf16_t* __restrict__ VT,
                                         bf16_t* __restrict__ ymix, LAS bf16_t* stg) {
    const int b = bh >> 3, h = bh & 7, l31 = lane & 31, hi = lane >> 5, q0 = qblk * 32, t = q0 + l31;
    const size_t rowb = (size_t)b * SEQ;
    const bf16_t* Qp = QM + (rowb + q0 + l31) * 768 + h * 96 + 8 * hi;
    bf16x8 qf[6];
#pragma unroll
    for (int kk = 0; kk < 6; ++kk) qf[kk] = *(const bf16x8*)(Qp + 16 * kk);
    const bf16_t* Kn = KVM + (rowb + l31) * 1024 + h * 128 + 8 * hi;
    const bf16_t* Kr = KPE + (rowb + l31) * 32 + 8 * hi;
    const bf16_t* Vp = VT + ((size_t)bh * 64 + l31) * SEQ + 4 * hi;
    const float sc2 = 0.10206207261596577f * 1.4426950408889634f;
    f32x16 o[2];
#pragma unroll
    for (int r = 0; r < 16; ++r) { o[0][r] = 0.f; o[1][r] = 0.f; }
    float mrun = -1e30f, lsum = 0.f;
    bf16x8 kf[6]; u32x2 va[2][2][2];
#define ML_LOAD(S0, KF, VA) do { _Pragma("unroll") for (int kk = 0; kk < 4; ++kk) KF[kk] = *(const bf16x8*)(Kn + (size_t)(S0) * 1024 + 16 * kk); \
        _Pragma("unroll") for (int kk = 0; kk < 2; ++kk) KF[4 + kk] = *(const bf16x8*)(Kr + (size_t)(S0) * 32 + 16 * kk); \
        _Pragma("unroll") for (int dt = 0; dt < 2; ++dt) _Pragma("unroll") for (int ks = 0; ks < 2; ++ks) { VA[dt][ks][0] = *(const u32x2*)(Vp + (size_t)dt * 32 * SEQ + (S0) + 16 * ks); VA[dt][ks][1] = *(const u32x2*)(Vp + (size_t)dt * 32 * SEQ + (S0) + 16 * ks + 8); } } while (0)
    ML_LOAD(0, kf, va);
    for (int s0 = 0; s0 <= q0; s0 += 32) {
        bf16x8 kn[6]; u32x2 vn[2][2][2];
        const int sn = (s0 + 32 <= q0) ? s0 + 32 : s0;
        ML_LOAD(sn, kn, vn);
        f32x16 acc;
#pragma unroll
        for (int r = 0; r < 16; ++r) acc[r] = 0.f;
#pragma unroll
        for (int kk = 0; kk < 6; ++kk) acc = MFMA32(kf[kk], qf[kk], acc);
        const bool diag = (s0 == q0);
        float tmax = -1e30f;
#pragma unroll
        for (int r = 0; r < 16; ++r) { float z = acc[r] * sc2; if (diag && (s0 + crow(r, hi)) > t) z = -1e30f; acc[r] = z; tmax = fmaxf(tmax, z); }
        tmax = fmaxf(tmax, __shfl_xor(tmax, 32));
        const float mn = fmaxf(mrun, tmax), alpha = exp2f(mrun - mn); mrun = mn;
        float ps = 0.f;
#pragma unroll
        for (int r = 0; r < 16; ++r) { acc[r] = exp2f(acc[r] - mn); ps += acc[r]; }
        lsum = lsum * alpha + ps;
#pragma unroll
        for (int r = 0; r < 16; ++r) { o[0][r] *= alpha; o[1][r] *= alpha; }
        bf16x8 pf[2];
#pragma unroll
        for (int ks = 0; ks < 2; ++ks) { v4u w; w.x = cvtpk(acc[8 * ks], acc[8 * ks + 1]); w.y = cvtpk(acc[8 * ks + 2], acc[8 * ks + 3]); w.z = cvtpk(acc[8 * ks + 4], acc[8 * ks + 5]); w.w = cvtpk(acc[8 * ks + 6], acc[8 * ks + 7]); pf[ks] = __builtin_bit_cast(bf16x8, w); }
#pragma unroll
        for (int dt = 0; dt < 2; ++dt)
#pragma unroll
            for (int ks = 0; ks < 2; ++ks) { v4u a; a.x = va[dt][ks][0].x; a.y = va[dt][ks][0].y; a.z = va[dt][ks][1].x; a.w = va[dt][ks][1].y; o[dt] = MFMA32(__builtin_bit_cast(bf16x8, a), pf[ks], o[dt]); }
#pragma unroll
        for (int kk = 0; kk < 6; ++kk) kf[kk] = kn[kk];
#pragma unroll
        for (int dt = 0; dt < 2; ++dt)
#pragma unroll
            for (int ks = 0; ks < 2; ++ks) { va[dt][ks][0] = vn[dt][ks][0]; va[dt][ks][1] = vn[dt][ks][1]; }
    }
#undef ML_LOAD
    lsum += __shfl_xor(lsum, 32);
    store_OT(o, 1.0f / lsum, stg, ymix + (rowb + q0) * DM + 512 + h * 64, lane);
}

struct Args { const float* in[43]; float* out; unsigned char* ws; };
#define GEMM_PHASE(EPI, Aptr, LDA, Bptr, LDB, NN, KK, ...) do { pg8::Gemm g_{(Aptr), (Bptr), M, (NN), (KK), (LDA), (LDB)}; pg8::StaticOrder S_; S_.init(M, (NN), G, (int)blockIdx.x); \
        pg8::EPI E_{__VA_ARGS__}; pg8::gemm_phase<pg8::EPI, pg8::StaticOrder, true, true>(lds3, g_, S_, E_); } while (0)

__global__ void __launch_bounds__(NWAVES * 64, 2) fwd_mega(Args args) {
    extern __shared__ __attribute__((aligned(16))) unsigned char lds[];
    LAS unsigned char* lds3 = (LAS unsigned char*)lds;
    volatile LAS unsigned* MISC = (volatile LAS unsigned*)(lds3 + MISC_OFF);
    const int tid = threadIdx.x, lane = tid & 63, wave = __builtin_amdgcn_readfirstlane(tid >> 6);
    const int G = gridDim.x, gw = blockIdx.x * NWAVES + wave, NGW = G * NWAVES, gtid = blockIdx.x * (NWAVES * 64) + tid, NT = G * NWAVES * 64;
    unsigned char* ws = args.ws;
    gu32* ctl = (gu32*)(ws + WS_CTL);
    for (int u = tid; u < (LDS_BYTES - LDSCTL_OFF) / 4; u += NWAVES * 64) ((LAS unsigned*)(lds3 + LDSCTL_OFF))[u] = 0u;
    __syncthreads();
    XcdBarrier bar = xcd_barrier_post((unsigned*)(ctl + CW_BAR), MISC + 8);
#define GRID_BAR() xcd_barrier(bar)
#define IN(i) (args.in[i])
    float* out = args.out;
    bf16_t* W0in = (bf16_t*)(ws + WS_W0IN); bf16_t* W0out = (bf16_t*)(ws + WS_W0OUT); bf16_t* Wup0 = (bf16_t*)(ws + WS_WUP0); bf16_t* Wdn0 = (bf16_t*)(ws + WS_WDN0);
    bf16_t* W1in = (bf16_t*)(ws + WS_W1IN); bf16_t* Wuq = (bf16_t*)(ws + WS_WUQ); bf16_t* Wukv = (bf16_t*)(ws + WS_WUKV); bf16_t* W1out = (bf16_t*)(ws + WS_W1OUT);
    bf16_t* Wup1 = (bf16_t*)(ws + WS_WUP1); bf16_t* Wdn1 = (bf16_t*)(ws + WS_WDN1);
    bf16_t* XB = (bf16_t*)(ws + WS_XB); bf16_t* YMIX = (bf16_t*)(ws + WS_YMIX); bf16_t* PROJ0 = (bf16_t*)(ws + WS_BIG);
    float* YSSM = (float*)(ws + WS_YSSM); float* DT = (float*)(ws + WS_DT); bf16_t* GU = (bf16_t*)(ws + WS_GU);
    bf16_t* PROJ1 = (bf16_t*)(ws + WS_PROJ1); bf16_t* QM = (bf16_t*)(ws + WS_QM); bf16_t* KVM = (bf16_t*)(ws + WS_KVM); bf16_t* KPE = (bf16_t*)(ws + WS_KPE); float* RS = (float*)(ws + WS_RS); bf16_t* VTS = (bf16_t*)(ws + WS_VTS); bf16_t* VTM = (bf16_t*)(ws + WS_VTM);
    const int* pos = (const int*)args.in[1];

    {
        LAS float* scr = (LAS float*)(lds3 + wave * 16384);
        transpose_matrix(IN(2), 1024, 3336, W0in, L0P, 1024, scr, gw, NGW, lane, nullptr);
        transpose_matrix(IN(20), 1024, 1024, W0out, 1024, 1024, scr, gw, NGW, lane, nullptr);
        transpose_matrix(IN(23), 1024, 5632, Wup0, 5632, 1024, scr, gw, NGW, lane, nullptr);
        transpose_matrix(IN(26), 2816, 1024, Wdn0, 1024, 2816, scr, gw, NGW, lane, nullptr);
        transpose_matrix(IN(29), 1024, 1952, W1in, L1P, 1024, scr, gw, NGW, lane, nullptr);
        transpose_matrix(IN(31), 256, 768, Wuq, 768, 256, scr, gw, NGW, lane, IN(30));
        transpose_matrix(IN(33), 128, 1024, Wukv, 1024, 256, scr, gw, NGW, lane, IN(32));
        for (int i = gtid; i < 1024 * 16; i += NT) { const int n = i >> 4, c = i & 15; *(v4u*)(Wukv + (size_t)n * 256 + 128 + c * 8) = (v4u){0u, 0u, 0u, 0u}; }
        transpose_matrix(IN(34), 1024, 1024, W1out, 1024, 1024, scr, gw, NGW, lane, nullptr);
        transpose_matrix(IN(37), 1024, 5632, Wup1, 5632, 1024, scr, gw, NGW, lane, nullptr);
        transpose_matrix(IN(40), 2816, 1024, Wdn1, 1024, 2816, scr, gw, NGW, lane, nullptr);
        const float* x = IN(0);
        for (size_t i = (size_t)gtid * 4; i < (size_t)M * DM; i += (size_t)NT * 4) { const f32x4 v = *(const f32x4*)(x + i); uint2 w; w.x = pk2(v[0], v[1]); w.y = pk2(v[2], v[3]); *(uint2*)(XB + i) = w; }
    }
    GRID_BAR();
    GEMM_PHASE(EpiBf16S, XB, DM, W0in, 1024, L0P, 1024, PROJ0, nullptr, L0P, 0);
    GRID_BAR();
    ssm_conv_all(PROJ0, IN(14), IN(15), IN(16), XB, DT, gtid, NT);
#ifndef NO_RWKV
    if (blockIdx.x < 128 && wave == 0)
        rwkv_naive_chain((int)blockIdx.x, lane, (LAS float*)lds3, PROJ0, IN(3), IN(4), IN(5), IN(6), IN(7), IN(8), IN(9), IN(10), IN(11), IN(12), IN(13), YMIX);
#endif
    GRID_BAR();
#ifndef NO_SSD
    if (wave < 2) ssd_naive_task((int)blockIdx.x + 256 * wave, lane, XB, DT, IN(17), IN(18), YSSM);
#endif
    GRID_BAR();
    ssm_gate_norm_all(YSSM, PROJ0, IN(19), YMIX, gw, NGW, lane);
    GRID_BAR();
    GEMM_PHASE(EpiResid, YMIX, DM, W0out, 1024, 1024, 1024, IN(0), out, ALPHA, 0);
    GRID_BAR();
    ln_rows(out, XB, IN(21), IN(22), gw, NGW, lane);
    GRID_BAR();
    GEMM_PHASE(EpiBf16S, XB, DM, Wup0, 1024, 2 * DFF, 1024, GU, nullptr, 2 * DFF, 0);
    GRID_BAR();
    ffn_act_all(GU, IN(24), IN(25), gtid, NT);
    GRID_BAR();
    GEMM_PHASE(EpiResid, GU + DFF, 2 * DFF, Wdn0, DFF, 1024, DFF, out, out, ALPHA, 0);
    GRID_BAR();
    ln_rows(out, XB, IN(27), IN(28), gw, NGW, lane);
    GRID_BAR();
    GEMM_PHASE(EpiBf16S, XB, DM, W1in, 1024, L1P, 1024, PROJ1, nullptr, L1P, 0);
    GRID_BAR();
    mla_prep_all(PROJ1, pos, RS, KPE, gw, NGW, lane);
    GRID_BAR();
    GEMM_PHASE(EpiBf16S, PROJ1 + 1536, L1P, Wuq, 256, 768, 256, QM, RS, 768, 2);
    GEMM_PHASE(EpiBf16S, PROJ1 + 1792, L1P, Wukv, 256, 1024, 256, KVM, RS + 1, 1024, 2);
    GRID_BAR();
    rope_q_all(QM, pos, gtid, NT);
    {
        LAS bf16_t* scr = (LAS bf16_t*)(lds3 + wave * 16384);
        for (int it = gw; it < 8192; it += NGW) { const int which = it >> 12, r = it & 4095, bh = r >> 5, tt = r & 31, b = bh >> 3, h = bh & 7;
            if (which == 0) transpose_tile64(PROJ1 + ((size_t)b * SEQ + tt * 64) * L1P + 1024 + h * 64, L1P, VTS + (size_t)bh * 64 * SEQ + tt * 64, SEQ, scr, lane);
            else            transpose_tile64(KVM + ((size_t)b * SEQ + tt * 64) * 1024 + h * 128 + 64, 1024, VTM + (size_t)bh * 64 * SEQ + tt * 64, SEQ, scr, lane); }
    }
    GRID_BAR();
    {
        LAS bf16_t* stg = (LAS bf16_t*)(lds3 + wave * 16384);
        for (int g2 = gw; g2 < 2048; g2 += NGW) { const int bh = g2 >> 4, w = g2 & 15;
#pragma unroll 1
            for (int i = 0; i < 4; ++i) { const int qb = (i == 0) ? w : (i == 1) ? 31 - w : (i == 2) ? 32 + w : 63 - w;
                sb_task(bh, qb, lane, PROJ1, VTS, YMIX, stg);
                mla_task(bh, qb, lane, QM, KVM, KPE, VTM, YMIX, stg); } }
    }
    GRID_BAR();
    GEMM_PHASE(EpiResid, YMIX, DM, W1out, 1024, 1024, 1024, out, out, ALPHA, 0);
    GRID_BAR();
    ln_rows(out, XB, IN(35), IN(36), gw, NGW, lane);
    GRID_BAR();
    GEMM_PHASE(EpiBf16S, XB, DM, Wup1, 1024, 2 * DFF, 1024, GU, nullptr, 2 * DFF, 0);
    GRID_BAR();
    ffn_act_all(GU, IN(38), IN(39), gtid, NT);
    GRID_BAR();
    GEMM_PHASE(EpiResid, GU + DFF, 2 * DFF, Wdn1, DFF, 1024, DFF, out, out, ALPHA, 0);
    GRID_BAR();
    ln_rows(out, XB, IN(41), IN(42), gw, NGW, lane);
}

extern "C" void kernel_launch(void* const* d_in, const int* in_sizes, int n_in, void* d_out, int out_size, void* d_ws, size_t ws_size, hipStream_t stream) {
    static int grid = 0;
    if (grid == 0) {
        if (n_in != 43 || ws_size < WS_NEED || out_size != M * DM) { fprintf(stderr, "kernel_launch: unexpected n_in %d / ws %zu / out %d\n", n_in, ws_size, out_size); grid = -1; return; }
        int dev = 0, cus = 0, per_cu = 0;
        if (hipGetDevice(&dev) != hipSuccess || hipDeviceGetAttribute(&cus, hipDeviceAttributeMultiprocessorCount, dev) != hipSuccess) { grid = -1; return; }
        if (hipFuncSetAttribute((const void*)fwd_mega, hipFuncAttributeMaxDynamicSharedMemorySize, LDS_BYTES) != hipSuccess) { fprintf(stderr, "kernel_launch: hipFuncSetAttribute failed\n"); grid = -1; return; }
        if (hipOccupancyMaxActiveBlocksPerMultiprocessor(&per_cu, (const void*)fwd_mega, NWAVES * 64, LDS_BYTES) != hipSuccess || per_cu < 1) fprintf(stderr, "kernel_launch: occupancy query reports %d\n", per_cu);
        (void)hipGetLastError();
        grid = cus;
    }
    if (grid < 0) return;
    (void)hipMemsetAsync((char*)d_ws + WS_CTL, 0, CTL_ZERO_BYTES, stream);
    Args a{};
    for (int i = 0; i < 43; ++i) a.in[i] = (const float*)d_in[i];
    a.out = (float*)d_out; a.ws = (unsigned char*)d_ws;
    hipLaunchKernelGGL(fwd_mega, dim3(grid), dim3(NWAVES * 64), LDS_BYTES, stream, a);
}
```

```cpp
#include <hip/hip_runtime.h>
#include <cstdio>
#include <cstdint>
#include <cmath>
namespace pg8 {
#define PG8_LAS __attribute__((address_space(3)))
typedef unsigned short bf16_t;
typedef short bf16x8 __attribute__((ext_vector_type(8)));
typedef float f32x4 __attribute__((ext_vector_type(4)));
typedef unsigned u32x4 __attribute__((ext_vector_type(4)));
constexpr int BM = 256, BK = 64, HALF = 128, HTB = HALF * BK * 2  , STAGE_BYTES = 8 * HTB, NXCD = 8, WGM = 8;

__host__ __device__ __forceinline__ int lds_byte(int r, int c) { const int st = (r >> 4) * 2 + (c >> 5), rr = r & 15, cc = c & 31, ob = rr * 64 + cc * 2; return st * 1024 + (ob ^ (((ob >> 9) & 1) << 5)); }
__host__ __device__ __forceinline__ void stage_rc(int b, int& R, int& C) { const int st = b / 1024, sb = b % 1024, swz = sb ^ (((sb >> 9) & 1) << 5); R = (st >> 1) * 16 + swz / 64; C = (st & 1) * 32 + (swz % 64) / 2; }
__host__ __device__ __forceinline__ int perm32(int rho) { const int n = rho >> 4, i = rho & 15; return 8 * (i >> 2) + 4 * n + (i & 3); }

struct Unit { int pm, pn; };
struct Gemm { const bf16_t* A; const bf16_t* Bt; int M, N, K, lda, ldb; };

struct StaticOrder {
    int nM, nN, nwg, G, c;
    __host__ __device__ void init(int M, int N, int G_, int c_) { nM = M / BM; nN = N / BM; nwg = nM * nN; G = G_; c = c_; }
    __host__ __device__ bool next(int i, Unit& u) const {
        const long L = (long)i * G + c; if (L >= nwg) return false;
        int wgid = (int)L; { const int q = nwg / NXCD, r = nwg % NXCD, xcd = wgid % NXCD, off = wgid / NXCD; wgid = (xcd < r ? xcd * (q + 1) : r * (q + 1) + (xcd - r) * q) + off; }
        const int nig = WGM * nN, gid = wgid / nig, fm = gid * WGM, gsz = (nM - fm) < WGM ? (nM - fm) : WGM;
        u.pm = fm + ((wgid % nig) % gsz); u.pn = (wgid % nig) / gsz; return true;
    }
    __device__ __forceinline__ void a_ready(const Unit&) const {}
    __device__ __forceinline__ void done(const Unit&) const {}
};


__device__ __forceinline__ unsigned cvt_pk_bf16(float lo, float hi) { unsigned r; asm volatile("v_cvt_pk_bf16_f32 %0, %1, %2" : "=v"(r) : "v"(lo), "v"(hi)); return r; }
struct EpiBf16S {
    static constexpr bool PERM = true, AFTER_DRAIN = false;
    bf16_t* O; const float* rowscale; int ldc; int rs_stride;
    __device__ __forceinline__ void operator()(const f32x4 (&acc)[2][2][4][2], const Unit& u, int wr, int wc, int fr, int fq) const {
        const int row0 = u.pm * BM + wr * 64 + fr, col0 = u.pn * BM + wc * 32 + 8 * fq;
#pragma unroll
        for (int ai = 0; ai < 2; ++ai)
#pragma unroll
            for (int m = 0; m < 4; ++m) { const int row = row0 + ai * HALF + m * 16; const float sc = rowscale ? rowscale[(size_t)row * rs_stride] : 1.f;
                bf16_t* rowp = O + (size_t)row * ldc + col0;
#pragma unroll
                for (int bj = 0; bj < 2; ++bj) { const f32x4 v0 = acc[ai][bj][m][0] * sc, v1 = acc[ai][bj][m][1] * sc;
                    u32x4 w; w.x = cvt_pk_bf16(v0[0], v0[1]); w.y = cvt_pk_bf16(v0[2], v0[3]); w.z = cvt_pk_bf16(v1[0], v1[1]); w.w = cvt_pk_bf16(v1[2], v1[3]);
                    *(u32x4*)(rowp + bj * HALF) = w; } }
    }
};
struct EpiResid {
    static constexpr bool PERM = false, AFTER_DRAIN = false;
    const float* hin; float* hout; float alpha; int pad;
    __device__ __forceinline__ void operator()(const f32x4 (&acc)[2][2][4][2], const Unit& u, int wr, int wc, int fr, int fq) const {
        const int row0 = u.pm * BM + wr * 64 + fr, col0 = u.pn * BM + wc * 32 + 4 * fq;
#pragma unroll
        for (int ai = 0; ai < 2; ++ai)
#pragma unroll
            for (int m = 0; m < 4; ++m) { const size_t off = (size_t)(row0 + ai * HALF + m * 16) * 1024 + col0;
#pragma unroll
                for (int bj = 0; bj < 2; ++bj)
#pragma unroll
                    for (int n = 0; n < 2; ++n) { const size_t i = off + bj * HALF + n * 16; const f32x4 h = *(const f32x4*)(hin + i); *(f32x4*)(hout + i) = h * alpha + acc[ai][bj][m][n]; } }
    }
};
template <class Epi, class Sched, bool ALIGN_EPI = false, bool SP2 = false>
__device__ __forceinline__ void gemm_phase(PG8_LAS unsigned char* lds, const Gemm g, const Sched& S, const Epi& E) {
    const int tid = threadIdx.x, wid = __builtin_amdgcn_readfirstlane(tid >> 6), lane = tid & 63, wr = wid >> 2, wc = wid & 3, fr = lane & 15, fq = lane >> 4;
    const int K = g.K, nt = K / BK;
    unsigned voffA[2], voffB[2];
#pragma unroll
    for (int i = 0; i < 2; ++i) { int R, C; stage_rc(tid * 16 + i * 8192, R, C); const int Rb = Epi::PERM ? ((R & ~31) + perm32(R & 31)) : R;
        voffA[i] = (unsigned)(R * g.lda + C) * 2u; voffB[i] = (unsigned)(Rb * g.ldb + C) * 2u; }
    const size_t kstep = (size_t)(BK * 2);
    const size_t hstepA = (size_t)HALF * g.lda * 2, hstepB = (size_t)HALF * g.ldb * 2;
    const size_t tstepA = 2 * hstepA, tstepB = 2 * hstepB;
    const unsigned ldsw = (unsigned)wid * 1024u;
    const int aoff = lds_byte(wr * 64 + fr, fq * 8), boff = lds_byte(wc * 32 + fr, fq * 8);
#define PG8_SA(b, h) (((b) * 2 + (h)) * HTB)
#define PG8_SB(b, h) ((4 + (b) * 2 + (h)) * HTB)
#define PG8_STAGE(bufoff, gbase, voff) do { _Pragma("unroll") for (int _i = 0; _i < 2; ++_i) \
        __builtin_amdgcn_global_load_lds((const unsigned*)((const char*)(gbase) + (voff)[_i]), (PG8_LAS unsigned*)(lds + (bufoff) + ldsw + _i * 8192), 16, 0, 0); } while (0)
#define PG8_LDA(dst, b, h) do { _Pragma("unroll") for (int m = 0; m < 4; ++m) _Pragma("unroll") for (int k = 0; k < 2; ++k) dst[m][k] = *(const PG8_LAS bf16x8*)(lds + PG8_SA(b, h) + aoff + m * 2048 + k * 1024); } while (0)
#define PG8_LDB(dst, b, h) do { _Pragma("unroll") for (int n = 0; n < 2; ++n) _Pragma("unroll") for (int k = 0; k < 2; ++k) dst[n][k] = *(const PG8_LAS bf16x8*)(lds + PG8_SB(b, h) + boff + n * 2048 + k * 1024); } while (0)
#define PG8_MMA(ai, bj, At, Bt) do { __builtin_amdgcn_s_setprio(1); _Pragma("unroll") for (int m = 0; m < 4; ++m) _Pragma("unroll") for (int n = 0; n < 2; ++n) _Pragma("unroll") for (int k = 0; k < 2; ++k) \
        acc[ai][bj][m][n] = __builtin_amdgcn_mfma_f32_16x16x32_bf16(Bt[n][k], At[m][k], acc[ai][bj][m][n], 0, 0, 0); __builtin_amdgcn_s_setprio(0); } while (0)
#define PG8_WAIT_V(n) asm volatile("s_waitcnt vmcnt(" #n ")" ::: "memory")
#define PG8_WAIT_L(n) asm volatile("s_waitcnt lgkmcnt(" #n ")" ::: "memory")
#define PG8_BAR __builtin_amdgcn_s_barrier()
#define PG8_SCHED __builtin_amdgcn_sched_barrier(0)
    Unit cur, nxt; int ui = 0;
    if (!S.next(0, cur)) return;
    f32x4 acc[2][2][4][2];
#pragma unroll
    for (int a = 0; a < 2; ++a)
#pragma unroll
        for (int b = 0; b < 2; ++b)
#pragma unroll
            for (int m = 0; m < 4; ++m)
#pragma unroll
                for (int n = 0; n < 2; ++n) acc[a][b][m][n] = (f32x4){0.f, 0.f, 0.f, 0.f};
    bf16x8 At[4][2], B0[2][2], B1[2][2];
    const char* cA = (const char*)g.A + (size_t)cur.pm * tstepA; const char* cB = (const char*)g.Bt + (size_t)cur.pn * tstepB;
    S.a_ready(cur);
    if constexpr (SP2) {
        PG8_STAGE(PG8_SB(0, 0), cB, voffB); PG8_STAGE(PG8_SB(0, 1), cB + hstepB, voffB); PG8_STAGE(PG8_SA(0, 0), cA, voffA); PG8_STAGE(PG8_SA(0, 1), cA + hstepA, voffA);
        if (wr == 1) PG8_BAR;
        PG8_WAIT_V(2); PG8_BAR;
        PG8_STAGE(PG8_SB(1, 0), cB + kstep, voffB); PG8_STAGE(PG8_SA(1, 0), cA + kstep, voffA); PG8_STAGE(PG8_SB(1, 1), cB + hstepB + kstep, voffB);
        PG8_WAIT_V(6); PG8_BAR;
    } else {
        PG8_STAGE(PG8_SB(0, 0), cB, voffB); PG8_STAGE(PG8_SA(0, 0), cA, voffA); PG8_STAGE(PG8_SB(0, 1), cB + hstepB, voffB); PG8_STAGE(PG8_SA(0, 1), cA + hstepA, voffA);
        if (wr == 1) PG8_BAR;
        PG8_WAIT_V(4); PG8_BAR;
        PG8_STAGE(PG8_SB(1, 0), cB + kstep, voffB); PG8_STAGE(PG8_SA(1, 0), cA + kstep, voffA); PG8_STAGE(PG8_SB(1, 1), cB + hstepB + kstep, voffB);
        PG8_WAIT_V(6); PG8_BAR;
    }
    for (;;) {
        const bool has_next = S.next(ui + 1, nxt);
        const char* nA = has_next ? (const char*)g.A + (size_t)nxt.pm * tstepA : cA; const char* nB = has_next ? (const char*)g.Bt + (size_t)nxt.pn * tstepB : cB;
        for (int t = 0; t < nt; t += 2) {
            const bool last = (t == nt - 2);
            const char* a1 = cA + (size_t)(t + 1) * kstep;
            const char* a2 = last ? nA : cA + (size_t)(t + 2) * kstep; const char* b2 = last ? nB : cB + (size_t)(t + 2) * kstep;
            const char* a3 = a2 + kstep; const char* b3 = b2 + kstep;
            if (last && has_next) S.a_ready(nxt);
            if constexpr (SP2) {
            PG8_LDB(B0, 0, 0); PG8_LDB(B1, 0, 1); PG8_SCHED; PG8_LDA(At, 0, 0); PG8_STAGE(PG8_SA(1, 1), a1 + hstepA, voffA);
            PG8_WAIT_V(8); PG8_WAIT_L(0); PG8_BAR; PG8_MMA(0, 0, At, B0); PG8_MMA(0, 1, At, B1); PG8_BAR; PG8_SCHED;
            PG8_LDA(At, 0, 1); PG8_STAGE(PG8_SB(0, 0), b2, voffB); PG8_STAGE(PG8_SB(0, 1), b2 + hstepB, voffB); PG8_STAGE(PG8_SA(0, 0), a2, voffA);
            PG8_WAIT_V(8); PG8_WAIT_L(0); PG8_BAR; PG8_MMA(1, 0, At, B0); PG8_MMA(1, 1, At, B1); PG8_BAR; PG8_SCHED;
            PG8_LDB(B0, 1, 0); PG8_LDB(B1, 1, 1); PG8_SCHED; PG8_LDA(At, 1, 0); PG8_STAGE(PG8_SA(0, 1), a2 + hstepA, voffA);
            PG8_WAIT_V(8); PG8_WAIT_L(0); PG8_BAR; PG8_MMA(0, 0, At, B0); PG8_MMA(0, 1, At, B1); PG8_BAR; PG8_SCHED;
            PG8_LDA(At, 1, 1); PG8_STAGE(PG8_SB(1, 0), b3, voffB); PG8_STAGE(PG8_SB(1, 1), b3 + hstepB, voffB); PG8_STAGE(PG8_SA(1, 0), a3, voffA);
            PG8_WAIT_V(8); PG8_WAIT_L(0); PG8_BAR; PG8_MMA(1, 0, At, B0); PG8_MMA(1, 1, At, B1); PG8_BAR; PG8_SCHED;
            } else {
            PG8_LDB(B0, 0, 0); PG8_SCHED; PG8_LDA(At, 0, 0); PG8_STAGE(PG8_SA(1, 1), a1 + hstepA, voffA);
            PG8_WAIT_L(8); PG8_BAR; PG8_WAIT_L(0); PG8_MMA(0, 0, At, B0); PG8_BAR; PG8_SCHED;
            PG8_LDB(B1, 0, 1); PG8_STAGE(PG8_SB(0, 0), b2, voffB);
            PG8_BAR; PG8_WAIT_L(0); PG8_MMA(0, 1, At, B1); PG8_BAR;
            PG8_LDA(At, 0, 1); PG8_STAGE(PG8_SA(0, 0), a2, voffA);
            PG8_BAR; PG8_WAIT_L(0); PG8_MMA(1, 0, At, B0); PG8_BAR; PG8_SCHED;
            PG8_STAGE(PG8_SB(0, 1), b2 + hstepB, voffB);
            PG8_WAIT_V(6); PG8_BAR; PG8_MMA(1, 1, At, B1); PG8_BAR;
            PG8_LDB(B0, 1, 0); PG8_SCHED; PG8_LDA(At, 1, 0); PG8_STAGE(PG8_SA(0, 1), a2 + hstepA, voffA);
            PG8_WAIT_L(8); PG8_BAR; PG8_WAIT_L(0); PG8_MMA(0, 0, At, B0); PG8_BAR; PG8_SCHED;
            PG8_LDB(B1, 1, 1); PG8_STAGE(PG8_SB(1, 0), b3, voffB);
            PG8_BAR; PG8_WAIT_L(0); PG8_MMA(0, 1, At, B1); PG8_BAR;
            PG8_LDA(At, 1, 1); PG8_STAGE(PG8_SA(1, 0), a3, voffA);
            PG8_BAR; PG8_WAIT_L(0); PG8_MMA(1, 0, At, B0); PG8_BAR; PG8_SCHED;
            PG8_STAGE(PG8_SB(1, 1), b3 + hstepB, voffB);
            PG8_WAIT_V(6); PG8_BAR; PG8_MMA(1, 1, At, B1); PG8_BAR;
            }
        }
        if constexpr (ALIGN_EPI) { if (wr == 0) PG8_BAR; }
        if constexpr (!Epi::AFTER_DRAIN) { E(acc, cur, wr, wc, fr, fq); S.done(cur); }
        if (!has_next) break;
#pragma unroll
        for (int a = 0; a < 2; ++a)
#pragma unroll
            for (int b = 0; b < 2; ++b)
#pragma unroll
                for (int m = 0; m < 4; ++m)
#pragma unroll
                    for (int n = 0; n < 2; ++n) acc[a][b][m][n] = (f32x4){0.f, 0.f, 0.f, 0.f};
        cur = nxt; cA = nA; cB = nB; ++ui;
        if constexpr (ALIGN_EPI) { if (wr == 1) PG8_BAR; }
    }
    PG8_WAIT_V(0);
    if constexpr (!ALIGN_EPI) { if (wr == 0) PG8_BAR; }
    PG8_BAR;
    if constexpr (Epi::AFTER_DRAIN) { E.fused(acc, cur, wr, wc, fr, fq, lds, wid, lane); S.done(cur); }
#undef PG8_SA
#undef PG8_SB
#undef PG8_STAGE
#undef PG8_LDA
#undef PG8_LDB
#undef PG8_MMA
#undef PG8_WAIT_V
#undef PG8_WAIT_L
#undef PG8_BAR
#undef PG8_SCHED
}
}
#define GAS __attribute__((address_space(1)))
#define LAS __attribute__((address_space(3)))
typedef unsigned short bf16;
typedef unsigned v4u __attribute__((ext_vector_type(4)));
typedef float f32x4 __attribute__((ext_vector_type(4)));
typedef short bf16x8 __attribute__((ext_vector_type(8)));
typedef GAS unsigned gu32;
typedef GAS unsigned long long gu64;
#define RLX_AGENT __ATOMIC_RELAXED, __HIP_MEMORY_SCOPE_AGENT
#define LDS_WAIT() asm volatile("s_waitcnt lgkmcnt(0)" ::: "memory")
#define VM_WAIT() asm volatile("s_waitcnt vmcnt(0)" ::: "memory")
__device__ __forceinline__ unsigned long long rt() { return __builtin_amdgcn_s_memrealtime(); }
__device__ __forceinline__ unsigned f2bf(float f) { unsigned u = __builtin_bit_cast(unsigned, f); return (u + 0x7fffu + ((u >> 16) & 1u)) >> 16; }
__device__ __forceinline__ unsigned pk2(float lo, float hi) { return f2bf(lo) | (f2bf(hi) << 16); }

#define XB_TMO      128
#define XB_XCNT(j)  (256  + 64 * (j))
#define XB_XSUB(j)  (1280 + 64 * (j))
#define XB_XGEN(j)  (2304 + 64 * (j))
#define XB_TOP      3328
#define XB_TOPGEN   3392
#define XCD_BAR_WORDS 3456
#define XB_SPIN_CAP (1u << 18)

__device__ __forceinline__ unsigned xb_ld(unsigned* p)              { return __hip_atomic_load(p, __ATOMIC_RELAXED, __HIP_MEMORY_SCOPE_AGENT); }
__device__ __forceinline__ unsigned xb_add(unsigned* p, unsigned v) { return __hip_atomic_fetch_add(p, v, __ATOMIC_RELAXED, __HIP_MEMORY_SCOPE_AGENT); }
__device__ __forceinline__ unsigned xb_xcc_id() { return (unsigned)__builtin_amdgcn_s_getreg((3 << 11) | 20) & 0xFu; }
#define XB_SPIN(cond, bar) do { unsigned _sp = 0; while (cond) { __builtin_amdgcn_s_sleep(1); \
    if ((++_sp & 255u) == 0u) { if (xb_ld(&(bar)[XB_TMO])) break; if (_sp > XB_SPIN_CAP) { atomicAdd(&(bar)[XB_TMO], 1u); break; } } } } while (0)

struct XcdBarrier {
    unsigned* bar; unsigned x;
    volatile LAS unsigned* st;
};

__device__ __forceinline__ XcdBarrier xcd_barrier_post(unsigned* bar, volatile LAS unsigned* st) {
    XcdBarrier b; b.bar = bar; b.x = xb_xcc_id(); b.st = st;
    if (threadIdx.x == 0) (void)xb_add(&bar[XB_XCNT(b.x)], 1u);
    return b;
}
__device__ __forceinline__ void xcd_barrier_complete(unsigned* bar, unsigned x, unsigned& nloc, unsigned& nx) {
    const unsigned G = gridDim.x * gridDim.y * gridDim.z;
    unsigned sum, cnt, mine, sp = 0u;
    for (;;) {
        sum = 0u; cnt = 0u; mine = 0u;
#pragma unroll
        for (unsigned j = 0; j < 16; ++j) { const unsigned c = xb_ld(&bar[XB_XCNT(j)]); sum += c; cnt += (c > 0u) ? 1u : 0u; mine = (j == x) ? c : mine; }
        if (sum == G) break;
        __builtin_amdgcn_s_sleep(1);
        if ((++sp & 255u) == 0u) { if (xb_ld(&bar[XB_TMO])) break; if (sp > XB_SPIN_CAP) { atomicAdd(&bar[XB_TMO], 1u); break; } }
    }
    nloc = mine > 0u ? mine : 1u; nx = cnt > 0u ? cnt : 1u;
}

__device__ __forceinline__ void xcd_barrier(const XcdBarrier& b) {
    asm volatile("s_waitcnt vmcnt(0)" ::: "memory");
    __syncthreads();
    if (threadIdx.x == 0) {
        unsigned* bar = b.bar;
        __builtin_amdgcn_s_waitcnt(0);
        unsigned nloc = b.st[0], nx = b.st[1];
        if (nloc == 0u) { xcd_barrier_complete(bar, b.x, nloc, nx); b.st[0] = nloc; b.st[1] = nx; }
        const unsigned old = xb_add(&bar[XB_XSUB(b.x)], 1u);
        const unsigned gen = old / nloc;
        if (old + 1u == (gen + 1u) * nloc) {
            __builtin_amdgcn_fence(__ATOMIC_RELEASE, "agent");
            asm volatile("s_waitcnt vmcnt(0)" ::: "memory");
            const unsigned og = xb_add(&bar[XB_TOP], 1u);
            const unsigned tg = og / nx;
            if (og + 1u == (tg + 1u) * nx) xb_add(&bar[XB_TOPGEN], 1u);
            else XB_SPIN(xb_ld(&bar[XB_TOPGEN]) == tg, bar);
            __builtin_amdgcn_fence(__ATOMIC_ACQUIRE, "agent");
            xb_add(&bar[XB_XGEN(b.x)], 1u);
            asm volatile("s_waitcnt vmcnt(0)" ::: "memory");
        } else {
            XB_SPIN(xb_ld(&bar[XB_XGEN(b.x)]) == gen, bar);
            __builtin_amdgcn_fence(__ATOMIC_ACQUIRE, "agent");
            asm volatile("s_waitcnt vmcnt(0)" ::: "memory");
        }
    }
    __syncthreads();
}
constexpr int NWAVES = 8;
constexpr int BATCH = 16, SEQ = 2048, DM = 1024, M = BATCH * SEQ;
constexpr int L0P = 3584;
constexpr int L1P = 2048;
constexpr int DFF = 2816;
constexpr float ALPHA = 1.4142135623730951f;
typedef unsigned short bf16_t;
typedef float f32x16 __attribute__((ext_vector_type(16)));

constexpr size_t MiB = 1u << 20;
constexpr size_t WS_CTL = 0, CTL_ZERO_BYTES = 1 * MiB;
constexpr int CW_BAR = 4096;
constexpr size_t WS_W0IN = 2 * MiB, WS_W0OUT = 9 * MiB, WS_WUP0 = 11 * MiB, WS_WDN0 = 22 * MiB, WS_W1IN = 28 * MiB, WS_WUQ = 32 * MiB, WS_WUKV = 33 * MiB,
                 WS_W1OUT = 34 * MiB, WS_WUP1 = 36 * MiB, WS_WDN1 = 47 * MiB;
constexpr size_t WS_XB = 56 * MiB, WS_YMIX = 120 * MiB, WS_BIG = 184 * MiB;
constexpr size_t WS_DT = 472 * MiB, WS_G = 408 * MiB, WS_BONUS = 440 * MiB;
constexpr size_t WS_W2T = 53 * MiB, WS_A2T = 53 * MiB + 256 * 1024, WS_G2T = 53 * MiB + 512 * 1024;
constexpr size_t WS_GU = 120 * MiB;
constexpr size_t WS_PROJ1 = 184 * MiB, WS_QM = 312 * MiB, WS_KVM = 360 * MiB, WS_KPE = 424 * MiB, WS_RS = 426 * MiB;
constexpr size_t WS_VTS = 428 * MiB, WS_VTM = 460 * MiB;
constexpr size_t WS_NEED = 492 * MiB;

constexpr int RING_BYTES = 131072;
constexpr int LDSCTL_OFF = 146432, MISC_OFF = LDSCTL_OFF + 320;
constexpr int LDS_BYTES = 147456;

__device__ __forceinline__ float bf2f(bf16_t b) { return __builtin_bit_cast(float, (unsigned)b << 16); }
__device__ __forceinline__ float sigmoidf_(float x) { return 1.f / (1.f + expf(-x)); }
__device__ __forceinline__ float softplusf_(float x) { return fmaxf(x, 0.f) + log1pf(expf(-fabsf(x))); }
__device__ __forceinline__ float siluf_(float x) { return x / (1.f + expf(-x)); }
__device__ __forceinline__ float wave_sum(float v) {
#pragma unroll
    for (int o = 1; o < 64; o <<= 1) v += __shfl_xor(v, o);
    return v;
}
#define WSYNC() asm volatile("s_waitcnt lgkmcnt(0)" ::: "memory")

__device__ __forceinline__ void transpose_item(const float* __restrict__ W, int N, bf16_t* __restrict__ WT, int ldt, LAS float* scr, int kb, int nb, int lane, const float* __restrict__ kscale) {
    const int k0 = 64 * kb, n0 = 32 * nb;
#pragma unroll 8
    for (int i = 0; i < 32; ++i) { const int kk = 2 * i + (lane >> 5), n = n0 + (lane & 31); float v = (n < N) ? W[(size_t)(k0 + kk) * N + n] : 0.f; if (kscale) v *= kscale[k0 + kk]; scr[kk * 33 + (lane & 31)] = v; }
    WSYNC();
    const int c = lane & 7;
#pragma unroll
    for (int j = 0; j < 4; ++j) { const int n = (lane >> 3) + 8 * j; const LAS float* s = scr + (8 * c) * 33 + n;
        v4u o; o.x = pk2(s[0 * 33], s[1 * 33]); o.y = pk2(s[2 * 33], s[3 * 33]); o.z = pk2(s[4 * 33], s[5 * 33]); o.w = pk2(s[6 * 33], s[7 * 33]);
        *(v4u*)(WT + (size_t)(n0 + n) * ldt + k0 + 8 * c) = o; }
    WSYNC();
}
__device__ __forceinline__ void transpose_matrix(const float* W, int K, int N, bf16_t* WT, int Npad, int ldt, LAS float* scr, int gw, int NGW, int lane, const float* kscale) {
    const int nblk = Npad / 32, nit = (K / 64) * nblk;
    for (int it = gw; it < nit; it += NGW) transpose_item(W, N, WT, ldt, scr, it / nblk, it % nblk, lane, kscale);
}

__device__ __forceinline__ void ln_rows(float* h, bf16_t* hb, const float* __restrict__ g, const float* __restrict__ b, int gw, int NGW, int lane) {
    for (int row = gw; row < M; row += NGW) {
        float* p = h + (size_t)row * DM;
        f32x4 v[4]; float s = 0.f;
#pragma unroll
        for (int j = 0; j < 4; ++j) { v[j] = *(const f32x4*)(p + 4 * lane + 256 * j); s += (v[j][0] + v[j][1]) + (v[j][2] + v[j][3]); }
        const float mean = wave_sum(s) * (1.f / DM); float q = 0.f;
#pragma unroll
        for (int j = 0; j < 4; ++j) { v[j] = v[j] - mean; q += (v[j][0] * v[j][0] + v[j][1] * v[j][1]) + (v[j][2] * v[j][2] + v[j][3] * v[j][3]); }
        const float rstd = 1.0f / sqrtf(wave_sum(q) * (1.f / DM) + 1e-5f);
#pragma unroll
        for (int j = 0; j < 4; ++j) {
            const int c = 4 * lane + 256 * j;
            const f32x4 gg = *(const f32x4*)(g + c), bb = *(const f32x4*)(b + c);
            const f32x4 o = v[j] * rstd * gg + bb;
            *(f32x4*)(p + c) = o;
            uint2 w; w.x = pk2(o[0], o[1]); w.y = pk2(o[2], o[3]);
            *(uint2*)(hb + (size_t)row * DM + c) = w;
        }
    }
}

__device__ __forceinline__ void rwkv_naive_chain(int chain, int lane, LAS float* sm, const bf16_t* __restrict__ proj, const float* __restrict__ mix, const float* __restrict__ w0, const float* __restrict__ w2,
                                                 const float* __restrict__ a0, const float* __restrict__ a2, const float* __restrict__ g2, const float* __restrict__ k_k,
                                                 const float* __restrict__ k_a, const float* __restrict__ r_k, const float* __restrict__ ln_g, const float* __restrict__ ln_b, bf16_t* __restrict__ ymix) {
    LAS float* s_w2 = sm; LAS float* s_a2 = sm + 4096; LAS float* s_g2 = sm + 8192; LAS float* s_tw = sm + 16384; LAS float* s_al = s_tw + 64; LAS float* s_sg = s_tw + 128;
    LAS float* s_w = s_tw + 256; LAS float* s_k = s_tw + 320; LAS float* s_a = s_tw + 384; LAS float* s_b = s_tw + 448; LAS float* s_r = s_tw + 512;
    const int b = chain >> 3, h = chain & 7, c = h * 64 + lane;
    for (int l = 0; l < 64; ++l) { s_w2[l * 64 + lane] = w2[l * 512 + c]; s_a2[l * 64 + lane] = a2[l * 512 + c]; }
    for (int l = 0; l < 128; ++l) s_g2[l * 64 + lane] = g2[l * 512 + c];
    const float mr = mix[c], mk = mix[512 + c], mv = mix[1024 + c], mw = mix[1536 + lane], ma = mix[1600 + lane], mg0 = mix[1664 + lane], mg1 = mix[1728 + lane];
    const float w0c = w0[c], a0c = a0[c], kkc = k_k[c], kac = k_a[c], rkc = r_k[c], lgc = ln_g[c], lbc = ln_b[c];
    float S[64];
#pragma unroll
    for (int j = 0; j < 64; ++j) S[j] = 0.f;
    float pr = 0.f, pk = 0.f, pv = 0.f, pw = 0.f, pa = 0.f, pg0 = 0.f, pg1 = 0.f;
    WSYNC();
    for (int t = 0; t < SEQ; ++t) {
        const bf16_t* row = proj + (size_t)(b * SEQ + t) * L0P;
        const float cr = bf2f(row[c]), ck = bf2f(row[512 + c]), cv = bf2f(row[1024 + c]), cw = bf2f(row[1536 + lane]), ca = bf2f(row[1600 + lane]),
                    cg0 = bf2f(row[1664 + lane]), cg1 = bf2f(row[1728 + lane]);
        const float r_s = cr + (pr - cr) * mr, k_s = ck + (pk - ck) * mk, v_s = cv + (pv - cv) * mv;
        const float wl = cw + (pw - cw) * mw, al = ca + (pa - ca) * ma, g0 = cg0 + (pg0 - cg0) * mg0, g1 = cg1 + (pg1 - cg1) * mg1;
        pr = cr; pk = ck; pv = cv; pw = cw; pa = ca; pg0 = cg0; pg1 = cg1;
        s_tw[lane] = tanhf(wl); s_al[lane] = al; s_sg[lane] = sigmoidf_(g0); s_sg[64 + lane] = sigmoidf_(g1);
        WSYNC();
        float wsum = w0c, asum = a0c, gsum = 0.f;
#pragma unroll 2
        for (int l = 0; l < 64; ++l) { wsum += s_tw[l] * s_w2[l * 64 + lane]; asum += s_al[l] * s_a2[l * 64 + lane]; }
#pragma unroll 2
        for (int l = 0; l < 128; ++l) gsum += s_sg[l] * s_g2[l * 64 + lane];
        const float log_w = -softplusf_(-wsum) - 0.5f;
        const float dec = expf(-expf(log_w));
        const float a = sigmoidf_(asum);
        float kkv = k_s * kkc;
        const float nrm = sqrtf(wave_sum(kkv * kkv));
        kkv = kkv / fmaxf(nrm, 1e-12f);
        const float k2 = k_s * (1.f + (a - 1.f) * kac);
        const float bonus_s = wave_sum(r_s * k2 * rkc);
        s_w[lane] = dec; s_k[lane] = k2; s_a[lane] = -kkv; s_b[lane] = kkv * a; s_r[lane] = r_s;
        WSYNC();
        float sa = 0.f;
#pragma unroll
        for (int j = 0; j < 64; ++j) sa += S[j] * s_a[j];
        float y = 0.f;
#pragma unroll
        for (int j = 0; j < 64; ++j) { S[j] = S[j] * s_w[j] + sa * s_b[j] + v_s * s_k[j]; y += S[j] * s_r[j]; }
        const float mu = wave_sum(y) * (1.f / 64.f);
        const float d = y - mu;
        const float var = wave_sum(d * d) * (1.f / 64.f);
        const float yn = d * (1.0f / sqrtf(var + 64e-5f)) * lgc + lbc;
        const float o = (yn + bonus_s * v_s) * gsum;
        ymix[(size_t)(b * SEQ + t) * DM + c] = (bf16_t)f2bf(o);
        WSYNC();
    }
}

__device__ __forceinline__ void ssm_conv_all(const bf16_t* __restrict__ proj, const float* __restrict__ cw, const float* __restrict__ cb, const float* __restrict__ dtb,
                                             bf16_t* __restrict__ xbc, float* __restrict__ dt, int gtid, int NT) {
    for (size_t i = gtid; i < (size_t)M * 1024; i += NT) {
        const int m = (int)(i >> 10), c = (int)(i & 1023), t = m & (SEQ - 1);
        float acc = cb[c];
#pragma unroll
        for (int k = 0; k < 4; ++k) { const int tt = t - 3 + k; if (tt >= 0) acc += cw[k * 1024 + c] * bf2f(proj[(size_t)(m - 3 + k) * L0P + 2304 + c]); }
        xbc[i] = (bf16_t)f2bf(siluf_(acc));
    }
    for (int i = gtid; i < M * 8; i += NT) dt[i] = softplusf_(bf2f(proj[(size_t)(i >> 3) * L0P + 3328 + (i & 7)]) + dtb[i & 7]);
}
__device__ __forceinline__ void ssd_naive_task(int task, int lane, const bf16_t* __restrict__ xbc, const float* __restrict__ dt, const float* __restrict__ a_log, const float* __restrict__ dsk, float* __restrict__ yssm) {
    const int chain = task >> 2, q = task & 3, b = chain >> 3, h = chain & 7, g = h >> 2, p = q * 16 + (lane >> 2), nq = lane & 3;
    const float A = -expf(a_log[h]), D = dsk[h];
    float st[32];
#pragma unroll
    for (int n = 0; n < 32; ++n) st[n] = 0.f;
    for (int t = 0; t < SEQ; ++t) {
        const size_t m = (size_t)b * SEQ + t;
        const float dtv = dt[m * 8 + h], dA = expf(dtv * A);
        const float x = bf2f(xbc[m * 1024 + h * 64 + p]), xdt = x * dtv;
        const bf16_t* Bp = xbc + m * 1024 + 512 + g * 128 + nq * 32;
        const bf16_t* Cp = xbc + m * 1024 + 768 + g * 128 + nq * 32;
        float yp = 0.f;
#pragma unroll
        for (int n = 0; n < 32; ++n) { st[n] = st[n] * dA + xdt * bf2f(Bp[n]); yp += st[n] * bf2f(Cp[n]); }
        yp += __shfl_xor(yp, 1); yp += __shfl_xor(yp, 2);
        if (nq == 0) yssm[m * 512 + h * 64 + p] = yp + D * x;
    }
}
__device__ __forceinline__ void ssm_gate_norm_all(const float* __restrict__ yssm, const bf16_t* __restrict__ proj, const float* __restrict__ ng, bf16_t* __restrict__ ymix, int gw, int NGW, int lane) {
    for (int wv = gw; wv < M * 2; wv += NGW) {
        const int m = wv >> 1, g = wv & 1;
        float u[4], q = 0.f;
#pragma unroll
        for (int j = 0; j < 4; ++j) { const int c = g * 256 + j * 64 + lane; const float z = bf2f(proj[(size_t)m * L0P + 1792 + c]); u[j] = yssm[(size_t)m * 512 + c] * siluf_(z); q += u[j] * u[j]; }
        const float rs = 1.0f / sqrtf(wave_sum(q) * (1.f / 256.f) + 1e-5f);
#pragma unroll
        for (int j = 0; j < 4; ++j) { const int c = g * 256 + j * 64 + lane; ymix[(size_t)m * DM + 512 + c] = (bf16_t)f2bf(u[j] * rs * ng[c]); }
    }
}
__device__ __forceinline__ void ffn_act_all(bf16_t* gu, const float* __restrict__ cw, const float* __restrict__ cb, int gtid, int NT) {
    for (size_t i = gtid; i < (size_t)M * DFF; i += NT) {
        const int m = (int)(i / DFF), c = (int)(i - (size_t)m * DFF), t = m & (SEQ - 1);
        float acc = cb[c];
#pragma unroll
        for (int k = 0; k < 3; ++k) { const int tt = t - 2 + k; if (tt >= 0) acc += cw[k * DFF + c] * bf2f(gu[(size_t)(m - 2 + k) * (2 * DFF) + c]); }
        const size_t o = (size_t)m * (2 * DFF) + DFF + c;
        gu[o] = (bf16_t)f2bf(siluf_(acc) * bf2f(gu[o]));
    }
}
__device__ __forceinline__ void mla_prep_all(const bf16_t* __restrict__ proj1, const int* __restrict__ pos, float* __restrict__ rs, bf16_t* __restrict__ kpe, int gw, int NGW, int lane) {
    for (int m = gw; m < M; m += NGW) {
        const bf16_t* row = proj1 + (size_t)m * L1P;
        float q = 0.f;
#pragma unroll
        for (int j = 0; j < 4; ++j) { const float v = bf2f(row[1536 + j * 64 + lane]); q += v * v; }
        q = wave_sum(q);
        float k = 0.f;
#pragma unroll
        for (int j = 0; j < 2; ++j) { const float v = bf2f(row[1792 + j * 64 + lane]); k += v * v; }
        k = wave_sum(k);
        if (lane == 0) { rs[(size_t)m * 2] = 1.0f / sqrtf(q * (1.f / 256.f) + 1e-6f); rs[(size_t)m * 2 + 1] = 1.0f / sqrtf(k * (1.f / 128.f) + 1e-6f); }
        if (lane < 16) {
            const double inv = pow(10000.0, -(double)(2 * lane) / 32.0);
            const double ang = (double)pos[m] * inv;
            const float cs = (float)cos(ang), sn = (float)sin(ang);
            const float x1 = bf2f(row[1920 + lane]), x2 = bf2f(row[1936 + lane]);
            kpe[(size_t)m * 32 + lane] = (bf16_t)f2bf(x1 * cs - x2 * sn);
            kpe[(size_t)m * 32 + 16 + lane] = (bf16_t)f2bf(x2 * cs + x1 * sn);
        }
    }
}
__device__ __forceinline__ void rope_q_all(bf16_t* qm, const int* __restrict__ pos, int gtid, int NT) {
    for (int i = gtid; i < M * 128; i += NT) {
        const int m = i >> 7, h = (i >> 4) & 7, k = i & 15;
        const double inv = pow(10000.0, -(double)(2 * k) / 32.0);
        const double ang = (double)pos[m] * inv;
        const float cs = (float)cos(ang), sn = (float)sin(ang);
        bf16_t* p = qm + (size_t)m * 768 + h * 96 + 64;
        const float x1 = bf2f(p[k]), x2 = bf2f(p[16 + k]);
        p[k] = (bf16_t)f2bf(x1 * cs - x2 * sn); p[16 + k] = (bf16_t)f2bf(x2 * cs + x1 * sn);
    }
}
__device__ __forceinline__ void sb_naive_task(int qblk, int bh, int lane, const bf16_t* __restrict__ proj1, bf16_t* __restrict__ ymix) {
    const int b = bh >> 3, h = bh & 7, t = qblk * 64 + lane;
    const size_t mrow = (size_t)b * SEQ;
    float q[64], o[64];
#pragma unroll
    for (int d = 0; d < 64; ++d) { q[d] = bf2f(proj1[(mrow + t) * L1P + h * 64 + d]) * 0.125f; o[d] = 0.f; }
    float cum = 0.f;
    const int smax = qblk * 64 + 63;
    for (int s = smax - 1; s >= 0; --s) {
        const bf16_t* kr = proj1 + (mrow + s) * L1P + 512 + h * 64;
        const bf16_t* vr = proj1 + (mrow + s) * L1P + 1024 + h * 64;
        float z = 0.f;
#pragma unroll
        for (int d = 0; d < 64; ++d) z += q[d] * bf2f(kr[d]);
        if (s < t) {
            const float lsp = -softplusf_(-z);
            const float lsn = -softplusf_(z);
            const float att = expf(lsp + cum);
            cum += lsn;
#pragma unroll
            for (int d = 0; d < 64; ++d) o[d] += att * bf2f(vr[d]);
        }
    }
#pragma unroll
    for (int d = 0; d < 64; ++d) ymix[(mrow + t) * DM + h * 64 + d] = (bf16_t)f2bf(o[d]);
}
__device__ __forceinline__ void mla_naive_task(int qblk, int bh, int lane, const bf16_t* __restrict__ qm, const bf16_t* __restrict__ kvm, const bf16_t* __restrict__ kpe, bf16_t* __restrict__ ymix) {
    const int b = bh >> 3, h = bh & 7, t = qblk * 64 + lane;
    const size_t mrow = (size_t)b * SEQ;
    const float scale = 0.10206207261596577f;
    float q[96], o[64];
#pragma unroll
    for (int d = 0; d < 96; ++d) q[d] = bf2f(qm[(mrow + t) * 768 + h * 96 + d]) * scale;
#pragma unroll
    for (int d = 0; d < 64; ++d) o[d] = 0.f;
    float mx = -1e30f, l = 0.f;
    const int smax = qblk * 64 + 63;
    for (int s = 0; s <= smax; ++s) {
        const bf16_t* kr = kvm + (mrow + s) * 1024 + h * 128;
        const bf16_t* pr = kpe + (mrow + s) * 32;
        float z = 0.f;
#pragma unroll
        for (int d = 0; d < 64; ++d) z += q[d] * bf2f(kr[d]);
#pragma unroll
        for (int d = 0; d < 32; ++d) z += q[64 + d] * bf2f(pr[d]);
        if (s <= t) {
            const float mn = fmaxf(mx, z), f = expf(mx - mn), pz = expf(z - mn);
            l = l * f + pz; mx = mn;
#pragma unroll
            for (int d = 0; d < 64; ++d) o[d] = o[d] * f + pz * bf2f(kr[64 + d]);
        }
    }
    const float il = 1.f / l;
#pragma unroll
    for (int d = 0; d < 64; ++d) ymix[(mrow + t) * DM + 512 + h * 64 + d] = (bf16_t)f2bf(o[d] * il);
}


typedef float f32x2_t __attribute__((ext_vector_type(2)));
typedef __bf16 bf16x2_t __attribute__((ext_vector_type(2)));
typedef unsigned u32x2 __attribute__((ext_vector_type(2)));
__device__ __forceinline__ unsigned cvtpk(float lo, float hi) { f32x2_t v = {lo, hi}; bf16x2_t b = __builtin_convertvector(v, bf16x2_t); return __builtin_bit_cast(unsigned, b); }
__device__ __forceinline__ int crow(int r, int hi) { return (r & 3) + 8 * (r >> 2) + 4 * hi; }
#define MFMA32(a, b, c) __builtin_amdgcn_mfma_f32_32x32x16_bf16((a), (b), (c), 0, 0, 0)
constexpr int STG_PITCH = 72;
__device__ __forceinline__ void transpose_tile64(const bf16_t* __restrict__ src, int sp, bf16_t* __restrict__ dst, int dp, LAS bf16_t* scr, int lane) {
#pragma unroll
    for (int i = 0; i < 8; ++i) { const int row = i * 8 + (lane >> 3), ch = lane & 7; const v4u v = *(const v4u*)(src + (size_t)row * sp + ch * 8); *(LAS v4u*)(scr + row * STG_PITCH + ch * 8) = v; }
    WSYNC();
#pragma unroll
    for (int i = 0; i < 8; ++i) { const int d = i * 8 + (lane >> 3), tc = lane & 7; const LAS bf16_t* p = scr + (tc * 8) * STG_PITCH + d;
        v4u o; o.x = (unsigned)p[0] | ((unsigned)p[STG_PITCH] << 16); o.y = (unsigned)p[2 * STG_PITCH] | ((unsigned)p[3 * STG_PITCH] << 16);
        o.z = (unsigned)p[4 * STG_PITCH] | ((unsigned)p[5 * STG_PITCH] << 16); o.w = (unsigned)p[6 * STG_PITCH] | ((unsigned)p[7 * STG_PITCH] << 16);
        *(v4u*)(dst + (size_t)d * dp + tc * 8) = o; }
    WSYNC();
}
__device__ __forceinline__ void store_OT(const f32x16 (&o)[2], float sc, LAS bf16_t* stg, bf16_t* __restrict__ dst, int lane) {
    const int l31 = lane & 31, hi = lane >> 5;
#pragma unroll
    for (int dt = 0; dt < 2; ++dt)
#pragma unroll
        for (int r = 0; r < 16; ++r) stg[l31 * STG_PITCH + 32 * dt + crow(r, hi)] = (bf16_t)f2bf(o[dt][r] * sc);
    WSYNC();
#pragma unroll
    for (int i = 0; i < 4; ++i) { const int row = i * 8 + (lane >> 3), ch = lane & 7; const v4u v = *(const LAS v4u*)(stg + row * STG_PITCH + ch * 8); *(v4u*)(dst + (size_t)row * DM + ch * 8) = v; }
    WSYNC();
}
__device__ __forceinline__ float softplus_fast(float z) { return fmaxf(z, 0.f) + __logf(1.f + __expf(-fabsf(z))); }

__device__ __forceinline__ void sb_task(int bh, int qblk, int lane, const bf16_t* __restrict__ P1, const bf16_t* __restrict__ VT, bf16_t* __restrict__ ymix, LAS bf16_t* stg) {
    const int b = bh >> 3, h = bh & 7, l31 = lane & 31, hi = lane >> 5, q0 = qblk * 32, t = q0 + l31;
    const size_t rowb = (size_t)b * SEQ;
    const bf16_t* Qp = P1 + (rowb + q0 + l31) * L1P + h * 64 + 8 * hi;
    bf16x8 qf[4];
#pragma unroll
    for (int kk = 0; kk < 4; ++kk) qf[kk] = *(const bf16x8*)(Qp + 16 * kk);
    const bf16_t* Kp = P1 + (rowb + l31) * L1P + 512 + h * 64 + 8 * hi;
    const bf16_t* Vp = VT + ((size_t)bh * 64 + l31) * SEQ + 4 * hi;
    f32x16 o[2];
#pragma unroll
    for (int r = 0; r < 16; ++r) { o[0][r] = 0.f; o[1][r] = 0.f; }
    float cum = 0.f;
    bf16x8 kf[4]; u32x2 va[2][2][2];
#define SB_LOAD(S0, KF, VA) do { _Pragma("unroll") for (int kk = 0; kk < 4; ++kk) KF[kk] = *(const bf16x8*)(Kp + (size_t)(S0) * L1P + 16 * kk); \
        _Pragma("unroll") for (int dt = 0; dt < 2; ++dt) _Pragma("unroll") for (int ks = 0; ks < 2; ++ks) { VA[dt][ks][0] = *(const u32x2*)(Vp + (size_t)dt * 32 * SEQ + (S0) + 16 * ks); VA[dt][ks][1] = *(const u32x2*)(Vp + (size_t)dt * 32 * SEQ + (S0) + 16 * ks + 8); } } while (0)
    SB_LOAD(q0, kf, va);
    for (int s0 = q0; s0 >= 0; s0 -= 32) {
        bf16x8 kn[4]; u32x2 vn[2][2][2];
        const int sn = (s0 >= 32) ? s0 - 32 : 0;
        SB_LOAD(sn, kn, vn);
        f32x16 acc;
#pragma unroll
        for (int r = 0; r < 16; ++r) acc[r] = 0.f;
#pragma unroll
        for (int kk = 0; kk < 4; ++kk) acc = MFMA32(kf[kk], qf[kk], acc);
        const bool diag = (s0 == q0);
        float lb[16], lk[16];
#pragma unroll
        for (int r = 0; r < 16; ++r) { const float z = acc[r] * 0.125f; const float sp = softplus_fast(z); float b_ = z - sp, k_ = -sp;
            if (diag) { const bool valid = (s0 + crow(r, hi)) < t; b_ = valid ? b_ : -1e30f; k_ = valid ? k_ : 0.f; }
            lb[r] = b_; lk[r] = k_; }
        float e[16], T[4], U[4];
#pragma unroll
        for (int i = 0; i < 4; ++i) { e[4 * i + 3] = 0.f; e[4 * i + 2] = lk[4 * i + 3]; e[4 * i + 1] = e[4 * i + 2] + lk[4 * i + 2]; e[4 * i] = e[4 * i + 1] + lk[4 * i + 1]; T[i] = e[4 * i] + lk[4 * i]; }
#pragma unroll
        for (int i = 0; i < 4; ++i) U[i] = __shfl_xor(T[i], 32);
        float off[4];
        { const float st2 = T[3], st1 = st2 + T[2], st0 = st1 + T[1]; const float su2 = U[3], su1 = su2 + U[2], su0 = su1 + U[1];
          const float x0 = hi ? 0.f : U[0], x1 = hi ? 0.f : U[1], x2 = hi ? 0.f : U[2], x3 = hi ? 0.f : U[3];
          off[3] = x3; off[2] = st2 + su2 + x2; off[1] = st1 + su1 + x1; off[0] = st0 + su0 + x0;
          const float total = st0 + T[0] + su0 + U[0];
#pragma unroll
          for (int r = 0; r < 16; ++r) acc[r] = __expf(lb[r] + (cum + off[r >> 2] + e[r]));
          cum += total; }
        bf16x8 pf[2];
#pragma unroll
        for (int ks = 0; ks < 2; ++ks) { v4u w; w.x = cvtpk(acc[8 * ks], acc[8 * ks + 1]); w.y = cvtpk(acc[8 * ks + 2], acc[8 * ks + 3]); w.z = cvtpk(acc[8 * ks + 4], acc[8 * ks + 5]); w.w = cvtpk(acc[8 * ks + 6], acc[8 * ks + 7]); pf[ks] = __builtin_bit_cast(bf16x8, w); }
#pragma unroll
        for (int dt = 0; dt < 2; ++dt)
#pragma unroll
            for (int ks = 0; ks < 2; ++ks) { v4u a; a.x = va[dt][ks][0].x; a.y = va[dt][ks][0].y; a.z = va[dt][ks][1].x; a.w = va[dt][ks][1].y; o[dt] = MFMA32(__builtin_bit_cast(bf16x8, a), pf[ks], o[dt]); }
        if (__all(cum < -110.f)) break;
#pragma unroll
        for (int kk = 0; kk < 4; ++kk) kf[kk] = kn[kk];
#pragma unroll
        for (int dt = 0; dt < 2; ++dt)
#pragma unroll
            for (int ks = 0; ks < 2; ++ks) { va[dt][ks][0] = vn[dt][ks][0]; va[dt][ks][1] = vn[dt][ks][1]; }
    }
#undef SB_LOAD
    store_OT(o, 1.0f, stg, ymix + (rowb + q0) * DM + h * 64, lane);
}
__device__ __forceinline__ void mla_task(int bh, int qblk, int lane, const bf16_t* __restrict__ QM, const bf16_t* __restrict__ KVM, const bf16_t* __restrict__ KPE, const bf16_t* __restrict__ VT,
                                         bf16_t* __restrict__ ymix, LAS bf16_t* stg) {
    const int b = bh >> 3, h = bh & 7, l31 = lane & 31, hi = lane >> 5, q0 = qblk * 32, t = q0 + l31;
    const size_t rowb = (size_t)b * SEQ;
    const bf16_t* Qp = QM + (rowb + q0 + l31) * 768 + h * 96 + 8 * hi;
    bf16x8 qf[6];
#pragma unroll
    for (int kk = 0; kk < 6; ++kk) qf[kk] = *(const bf16x8*)(Qp + 16 * kk);
    const bf16_t* Kn = KVM + (rowb + l31) * 1024 + h * 128 + 8 * hi;
    const bf16_t* Kr = KPE + (rowb + l31) * 32 + 8 * hi;
    const bf16_t* Vp = VT + ((size_t)bh * 64 + l31) * SEQ + 4 * hi;
    const float sc2 = 0.10206207261596577f * 1.4426950408889634f;
    f32x16 o[2];
#pragma unroll
    for (int r = 0; r < 16; ++r) { o[0][r] = 0.f; o[1][r] = 0.f; }
    float mrun = -1e30f, lsum = 0.f;
    bf16x8 kf[6]; u32x2 va[2][2][2];
#define ML_LOAD(S0, KF, VA) do { _Pragma("unroll") for (int kk = 0; kk < 4; ++kk) KF[kk] = *(const bf16x8*)(Kn + (size_t)(S0) * 1024 + 16 * kk); \
        _Pragma("unroll") for (int kk = 0; kk < 2; ++kk) KF[4 + kk] = *(const bf16x8*)(Kr + (size_t)(S0) * 32 + 16 * kk); \
        _Pragma("unroll") for (int dt = 0; dt < 2; ++dt) _Pragma("unroll") for (int ks = 0; ks < 2; ++ks) { VA[dt][ks][0] = *(const u32x2*)(Vp + (size_t)dt * 32 * SEQ + (S0) + 16 * ks); VA[dt][ks][1] = *(const u32x2*)(Vp + (size_t)dt * 32 * SEQ + (S0) + 16 * ks + 8); } } while (0)
    ML_LOAD(0, kf, va);
    for (int s0 = 0; s0 <= q0; s0 += 32) {
        bf16x8 kn[6]; u32x2 vn[2][2][2];
        const int sn = (s0 + 32 <= q0) ? s0 + 32 : s0;
        ML_LOAD(sn, kn, vn);
        f32x16 acc;
#pragma unroll
        for (int r = 0; r < 16; ++r) acc[r] = 0.f;
#pragma unroll
        for (int kk = 0; kk < 6; ++kk) acc = MFMA32(kf[kk], qf[kk], acc);
        const bool diag = (s0 == q0);
        float tmax = -1e30f;
#pragma unroll
        for (int r = 0; r < 16; ++r) { float z = acc[r] * sc2; if (diag && (s0 + crow(r, hi)) > t) z = -1e30f; acc[r] = z; tmax = fmaxf(tmax, z); }
        tmax = fmaxf(tmax, __shfl_xor(tmax, 32));
        const float mn = fmaxf(mrun, tmax), alpha = exp2f(mrun - mn); mrun = mn;
        float ps = 0.f;
#pragma unroll
        for (int r = 0; r < 16; ++r) { acc[r] = exp2f(acc[r] - mn); ps += acc[r]; }
        lsum = lsum * alpha + ps;
#pragma unroll
        for (int r = 0; r < 16; ++r) { o[0][r] *= alpha; o[1][r] *= alpha; }
        bf16x8 pf[2];
#pragma unroll
        for (int ks = 0; ks < 2; ++ks) { v4u w; w.x = cvtpk(acc[8 * ks], acc[8 * ks + 1]); w.y = cvtpk(acc[8 * ks + 2], acc[8 * ks + 3]); w.z = cvtpk(acc[8 * ks + 4], acc[8 * ks + 5]); w.w = cvtpk(acc[8 * ks + 6], acc[8 * ks + 7]); pf[ks] = __builtin_bit_cast(bf16x8, w); }
#pragma unroll
        for (int dt = 0; dt < 2; ++dt)
#pragma unroll
            for (int ks = 0; ks < 2; ++ks) { v4u a; a.x = va[dt][ks][0].x; a.y = va[dt][ks][0].y; a.z = va[dt][ks][1].x; a.w = va[dt][ks][1].y; o[dt] = MFMA32(__builtin_bit_cast(bf16x8, a), pf[ks], o[dt]); }
#pragma unroll
        for (int kk = 0; kk < 6; ++kk) kf[kk] = kn[kk];
#pragma unroll
        for (int dt = 0; dt < 2; ++dt)
#pragma unroll
            for (int ks = 0; ks < 2; ++ks) { va[dt][ks][0] = vn[dt][ks][0]; va[dt][ks][1] = vn[dt][ks][1]; }
    }
#undef ML_LOAD
    lsum += __shfl_xor(lsum, 32);
    store_OT(o, 1.0f / lsum, stg, ymix + (rowb + q0) * DM + 512 + h * 64, lane);
}


constexpr int RW_RAWW = 0, RW_RAWA = 2048, RW_RS = 4096, RW_KS = 6144, RW_VS = 8192;
constexpr int RW_CH0 = 10240, RW_CHSZ = 11328;
constexpr int RW_YB = RW_CH0 + 2 * RW_CHSZ;
constexpr int RW_MIX = RW_YB + 1024;
static_assert((RW_MIX + 256) * 4 <= 146432, "rwkv LDS map");
template <int CTRL> __device__ __forceinline__ float dpp_mov(float x) { return __builtin_bit_cast(float, __builtin_amdgcn_update_dpp(0, __builtin_bit_cast(int, x), CTRL, 0xF, 0xF, true)); }
__device__ __forceinline__ float rowsum16(float x) { x += dpp_mov<0x128>(x); x += dpp_mov<0x124>(x); x += dpp_mov<0x122>(x); x += dpp_mov<0x121>(x); return x; }
__device__ __forceinline__ float bflo(unsigned u) { return __builtin_bit_cast(float, u << 16); }
__device__ __forceinline__ float bfhi(unsigned u) { return __builtin_bit_cast(float, u & 0xffff0000u); }
__device__ __forceinline__ float tanh_fast(float x) { return 1.f - 2.f / (1.f + __expf(2.f * x)); }
__device__ __forceinline__ float sigmoid_fast(float x) { return 1.f / (1.f + __expf(-x)); }

__device__ __forceinline__ void rwkv_phase(LAS float* sm, int tid, int lane, int wave, int blk, const bf16_t* __restrict__ proj, const float* __restrict__ mix, const float* __restrict__ w0, const float* __restrict__ a0,
                                           const float* __restrict__ k_k, const float* __restrict__ k_a, const float* __restrict__ r_k, const bf16_t* __restrict__ W2T, const bf16_t* __restrict__ A2T, const bf16_t* __restrict__ G2T,
                                           float* __restrict__ yraw, bf16_t* __restrict__ gout, float* __restrict__ bonus_out) {
    const int chain = blk >> 1, half = blk & 1, b = chain >> 3, h = chain & 7, l31 = lane & 31, hi = lane >> 5;
    const size_t rowb = (size_t)b * SEQ;
    if (tid < 256) sm[RW_MIX + tid] = mix[1536 + tid];
    const int cB = h * 64 + lane;
    const float w0c = w0[cB], a0c = a0[cB], kkc = k_k[cB], kac = k_a[cB], rkc = r_k[cB];
    float mixv[8];
    { const int idx = (wave >= 5) ? wave - 5 : 0; const int ch8 = lane & 7;
#pragma unroll
      for (int j = 0; j < 8; ++j) mixv[j] = mix[512 * idx + h * 64 + ch8 * 8 + j]; }
    __syncthreads();
    float S0 = 0.f, S1 = 0.f, S2 = 0.f, S3 = 0.f;
    const int iloc = 4 * wave + (lane >> 4), jseg = lane & 15;
    v4u ld[16];
#define RW_ISSUE(T0) do { const int t0_ = (T0); \
        if (wave < 4) { const int colb = 1536 + 64 * (wave >> 1) + 8 * hi; const size_t r_ = rowb + t0_ + l31; \
            _Pragma("unroll") for (int kk = 0; kk < 4; ++kk) { ld[kk] = *(const v4u*)(proj + r_ * L0P + colb + 16 * kk); ld[4 + kk] = (t0_ + l31 == 0) ? (v4u){0u, 0u, 0u, 0u} : *(const v4u*)(proj + (r_ - 1) * L0P + colb + 16 * kk); } } \
        else if (wave == 4) { const int colb = 1664 + 8 * hi; const size_t r_ = rowb + t0_ + l31; \
            _Pragma("unroll") for (int kk = 0; kk < 8; ++kk) { ld[kk] = *(const v4u*)(proj + r_ * L0P + colb + 16 * kk); ld[8 + kk] = (t0_ + l31 == 0) ? (v4u){0u, 0u, 0u, 0u} : *(const v4u*)(proj + (r_ - 1) * L0P + colb + 16 * kk); } } \
        else { const int colb = 512 * (wave - 5) + h * 64 + 8 * (lane & 7); \
            _Pragma("unroll") for (int i = 0; i < 4; ++i) { const int tl = i * 8 + (lane >> 3); const size_t r_ = rowb + t0_ + tl; \
                ld[i] = *(const v4u*)(proj + r_ * L0P + colb); ld[4 + i] = (t0_ + tl == 0) ? (v4u){0u, 0u, 0u, 0u} : *(const v4u*)(proj + (r_ - 1) * L0P + colb); } } } while (0)
#define RW_SHIFT8(CUR, PRV, MIXP, OUT) do { const unsigned cu_[4] = {(CUR).x, (CUR).y, (CUR).z, (CUR).w}, pu_[4] = {(PRV).x, (PRV).y, (PRV).z, (PRV).w}; \
        _Pragma("unroll") for (int q = 0; q < 4; ++q) { const float c0 = bflo(cu_[q]), c1 = bfhi(cu_[q]), p0 = bflo(pu_[q]), p1 = bfhi(pu_[q]); \
            OUT[2 * q] = c0 + (p0 - c0) * (MIXP)[2 * q]; OUT[2 * q + 1] = c1 + (p1 - c1) * (MIXP)[2 * q + 1]; } } while (0)
#define RW_PREP(T0, NB) do { const int t0_ = (T0); LAS float* CHn = sm + RW_CH0 + (NB) * RW_CHSZ; \
        if (wave < 4) { const int lora = wave >> 1, jh = wave & 1; const bf16_t* WT = lora ? A2T : W2T; f32x16 acc; \
            _Pragma("unroll") for (int r = 0; r < 16; ++r) acc[r] = 0.f; \
            _Pragma("unroll") for (int kk = 0; kk < 4; ++kk) { float mx_[8], s_[8]; \
                { const f32x4 m0 = *(const LAS f32x4*)(sm + RW_MIX + lora * 64 + 16 * kk + 8 * hi), m1 = *(const LAS f32x4*)(sm + RW_MIX + lora * 64 + 16 * kk + 8 * hi + 4); \
                  mx_[0] = m0[0]; mx_[1] = m0[1]; mx_[2] = m0[2]; mx_[3] = m0[3]; mx_[4] = m1[0]; mx_[5] = m1[1]; mx_[6] = m1[2]; mx_[7] = m1[3]; } \
                RW_SHIFT8(ld[kk], ld[4 + kk], mx_, s_); \
                if (lora == 0) { _Pragma("unroll") for (int j = 0; j < 8; ++j) s_[j] = tanh_fast(s_[j]); } \
                v4u aw; aw.x = cvtpk(s_[0], s_[1]); aw.y = cvtpk(s_[2], s_[3]); aw.z = cvtpk(s_[4], s_[5]); aw.w = cvtpk(s_[6], s_[7]); \
                const bf16x8 bfr = *(const bf16x8*)(WT + (size_t)(h * 64 + jh * 32 + l31) * 64 + 16 * kk + 8 * hi); \
                acc = MFMA32(__builtin_bit_cast(bf16x8, aw), bfr, acc); } \
            LAS float* dst = sm + (lora ? RW_RAWA : RW_RAWW) + jh * 32 + l31; \
            _Pragma("unroll") for (int r = 0; r < 16; ++r) dst[crow(r, hi) * 64] = acc[r]; } \
        else if (wave == 4) { f32x16 acc; \
            _Pragma("unroll") for (int r = 0; r < 16; ++r) acc[r] = 0.f; \
            _Pragma("unroll") for (int kk = 0; kk < 8; ++kk) { float mx_[8], s_[8]; \
                { const f32x4 m0 = *(const LAS f32x4*)(sm + RW_MIX + 128 + 16 * kk + 8 * hi), m1 = *(const LAS f32x4*)(sm + RW_MIX + 128 + 16 * kk + 8 * hi + 4); \
                  mx_[0] = m0[0]; mx_[1] = m0[1]; mx_[2] = m0[2]; mx_[3] = m0[3]; mx_[4] = m1[0]; mx_[5] = m1[1]; mx_[6] = m1[2]; mx_[7] = m1[3]; } \
                RW_SHIFT8(ld[kk], ld[8 + kk], mx_, s_); \
                _Pragma("unroll") for (int j = 0; j < 8; ++j) s_[j] = sigmoid_fast(s_[j]); \
                v4u aw; aw.x = cvtpk(s_[0], s_[1]); aw.y = cvtpk(s_[2], s_[3]); aw.z = cvtpk(s_[4], s_[5]); aw.w = cvtpk(s_[6], s_[7]); \
                const bf16x8 bfr = *(const bf16x8*)(G2T + (size_t)(h * 64 + half * 32 + l31) * 128 + 16 * kk + 8 * hi); \
                acc = MFMA32(__builtin_bit_cast(bf16x8, aw), bfr, acc); } \
            bf16_t* gd = gout + (rowb + t0_) * 512 + h * 64 + half * 32 + l31; \
            _Pragma("unroll") for (int r = 0; r < 16; ++r) gd[(size_t)crow(r, hi) * 512] = (bf16_t)f2bf(acc[r]); } \
        else { LAS float* dst = sm + RW_RS + (wave - 5) * 2048 + (lane & 7) * 8; \
            _Pragma("unroll") for (int i = 0; i < 4; ++i) { const int tl = i * 8 + (lane >> 3); float s_[8]; RW_SHIFT8(ld[i], ld[4 + i], mixv, s_); \
                *(LAS f32x4*)(dst + tl * 64) = (f32x4){s_[0], s_[1], s_[2], s_[3]}; *(LAS f32x4*)(dst + tl * 64 + 4) = (f32x4){s_[4], s_[5], s_[6], s_[7]}; } } \
        __syncthreads(); \
        _Pragma("unroll") for (int tt = 0; tt < 4; ++tt) { const int t = 4 * wave + tt; \
            const float wraw = sm[RW_RAWW + t * 64 + lane], araw = sm[RW_RAWA + t * 64 + lane], r_ = sm[RW_RS + t * 64 + lane], k_ = sm[RW_KS + t * 64 + lane], v_ = sm[RW_VS + t * 64 + lane]; \
            const float wsum = w0c + wraw; const float logw = -softplus_fast(-wsum) - 0.5f; const float dec = __expf(-__expf(logw)); \
            const float a_ = sigmoid_fast(a0c + araw); \
            float kkv = k_ * kkc; const float nrm = sqrtf(wave_sum(kkv * kkv)); kkv = kkv / fmaxf(nrm, 1e-12f); \
            const float k2 = k_ * (1.f + (a_ - 1.f) * kac); const float bv = kkv * a_; \
            const float br = wave_sum(bv * r_), kr = wave_sum(k2 * r_), bon = wave_sum(r_ * k2 * rkc); \
            CHn[t * 64 + lane] = dec; CHn[2048 + t * 64 + lane] = k2; CHn[4096 + t * 64 + lane] = -kkv; CHn[6144 + t * 64 + lane] = bv; CHn[8192 + t * 64 + lane] = dec * r_; \
            if ((lane >> 5) == half) CHn[10240 + t * 32 + (lane & 31)] = v_; \
            if (lane == 0) { CHn[11264 + 2 * t] = br; CHn[11264 + 2 * t + 1] = kr; if (half == 0) bonus_out[(rowb + t0_ + t) * 8 + h] = bon; } } \
        __syncthreads(); } while (0)

    RW_ISSUE(0);
    RW_PREP(0, 0);
    for (int ch = 0; ch < SEQ / 32; ++ch) {
        const int t0 = ch * 32;
        if (ch + 1 < SEQ / 32) RW_ISSUE(t0 + 32);
        const LAS float* CHb = sm + RW_CH0 + (ch & 1) * RW_CHSZ;
#pragma unroll 4
        for (int t = 0; t < 32; ++t) {
            const f32x4 a4 = *(const LAS f32x4*)(CHb + 4096 + t * 64 + 4 * jseg), wr4 = *(const LAS f32x4*)(CHb + 8192 + t * 64 + 4 * jseg);
            const f32x4 w4 = *(const LAS f32x4*)(CHb + t * 64 + 4 * jseg), b4 = *(const LAS f32x4*)(CHb + 6144 + t * 64 + 4 * jseg), k4 = *(const LAS f32x4*)(CHb + 2048 + t * 64 + 4 * jseg);
            const float v = CHb[10240 + t * 32 + iloc]; const float br = CHb[11264 + 2 * t], kr = CHb[11264 + 2 * t + 1];
            float d1 = (S0 * a4[0] + S1 * a4[1]) + (S2 * a4[2] + S3 * a4[3]);
            float d2 = (S0 * wr4[0] + S1 * wr4[1]) + (S2 * wr4[2] + S3 * wr4[3]);
            d1 = rowsum16(d1); d2 = rowsum16(d2);
            const float y = d2 + d1 * br + v * kr;
            S0 = S0 * w4[0] + (d1 * b4[0] + v * k4[0]); S1 = S1 * w4[1] + (d1 * b4[1] + v * k4[1]);
            S2 = S2 * w4[2] + (d1 * b4[2] + v * k4[2]); S3 = S3 * w4[3] + (d1 * b4[3] + v * k4[3]);
            if (jseg == 0) sm[RW_YB + t * 32 + iloc] = y;
        }
        WSYNC();
        if (lane < 32) { const f32x4 yv = *(const LAS f32x4*)(sm + RW_YB + lane * 32 + 4 * wave); *(f32x4*)(yraw + (rowb + t0 + lane) * 512 + h * 64 + half * 32 + 4 * wave) = yv; }
        if (ch + 1 < SEQ / 32) RW_PREP(t0 + 32, (ch + 1) & 1);
    }
#undef RW_ISSUE
#undef RW_PREP
#undef RW_SHIFT8
}
__device__ __forceinline__ void rwkv_post_all(const float* __restrict__ yraw, const bf16_t* __restrict__ proj, const float* __restrict__ mix, const float* __restrict__ bonus, const bf16_t* __restrict__ gbuf,
                                              const float* __restrict__ ln_g, const float* __restrict__ ln_b, bf16_t* __restrict__ ymix, int gw, int NGW, int lane) {
    for (int task = gw; task < M * 8; task += NGW) {
        const int m = task >> 3, h = task & 7, c = h * 64 + lane;
        const float y = yraw[(size_t)m * 512 + c];
        const float mu = wave_sum(y) * (1.f / 64.f), d = y - mu, var = wave_sum(d * d) * (1.f / 64.f);
        const float yn = d * (1.0f / sqrtf(var + 64e-5f)) * ln_g[c] + ln_b[c];
        const float cv = bf2f(proj[(size_t)m * L0P + 1024 + c]); const float pv = (m & (SEQ - 1)) ? bf2f(proj[(size_t)(m - 1) * L0P + 1024 + c]) : 0.f;
        const float v_s = cv + (pv - cv) * mix[1024 + c];
        const float o = (yn + bonus[(size_t)m * 8 + h] * v_s) * bf2f(gbuf[(size_t)m * 512 + c]);
        ymix[(size_t)m * DM + c] = (bf16_t)f2bf(o);
    }
}

struct Args { const float* in[43]; float* out; unsigned char* ws; };
#define GEMM_PHASE(EPI, Aptr, LDA, Bptr, LDB, NN, KK, ...) do { pg8::Gemm g_{(Aptr), (Bptr), M, (NN), (KK), (LDA), (LDB)}; pg8::StaticOrder S_; S_.init(M, (NN), G, (int)blockIdx.x); \
        pg8::EPI E_{__VA_ARGS__}; pg8::gemm_phase<pg8::EPI, pg8::StaticOrder, true, true>(lds3, g_, S_, E_); } while (0)

__global__ void __launch_bounds__(NWAVES * 64, 2) fwd_mega(Args args) {
    extern __shared__ __attribute__((aligned(16))) unsigned char lds[];
    LAS unsigned char* lds3 = (LAS unsigned char*)lds;
    volatile LAS unsigned* MISC = (volatile LAS unsigned*)(lds3 + MISC_OFF);
    const int G = gridDim.x, NGW = G * NWAVES, NT = G * NWAVES * 64;
#define PHASE_IDS() int tid = threadIdx.x; asm volatile("" : "+v"(tid)); const int lane = tid & 63, wave = __builtin_amdgcn_readfirstlane(tid >> 6); const int gw = blockIdx.x * NWAVES + wave, gtid = blockIdx.x * (NWAVES * 64) + tid; (void)lane; (void)gw; (void)gtid
    unsigned char* ws = args.ws;
    gu32* ctl = (gu32*)(ws + WS_CTL);
    for (int u = threadIdx.x; u < (LDS_BYTES - LDSCTL_OFF) / 4; u += NWAVES * 64) ((LAS unsigned*)(lds3 + LDSCTL_OFF))[u] = 0u;
    __syncthreads();
    XcdBarrier bar = xcd_barrier_post((unsigned*)(ctl + CW_BAR), MISC + 8);
#define GRID_BAR() xcd_barrier(bar)
#define IN(i) (args.in[i])
    float* out = args.out;
    bf16_t* W0in = (bf16_t*)(ws + WS_W0IN); bf16_t* W0out = (bf16_t*)(ws + WS_W0OUT); bf16_t* Wup0 = (bf16_t*)(ws + WS_WUP0); bf16_t* Wdn0 = (bf16_t*)(ws + WS_WDN0);
    bf16_t* W1in = (bf16_t*)(ws + WS_W1IN); bf16_t* Wuq = (bf16_t*)(ws + WS_WUQ); bf16_t* Wukv = (bf16_t*)(ws + WS_WUKV); bf16_t* W1out = (bf16_t*)(ws + WS_W1OUT);
    bf16_t* Wup1 = (bf16_t*)(ws + WS_WUP1); bf16_t* Wdn1 = (bf16_t*)(ws + WS_WDN1);
    bf16_t* XB = (bf16_t*)(ws + WS_XB); bf16_t* YMIX = (bf16_t*)(ws + WS_YMIX); bf16_t* PROJ0 = (bf16_t*)(ws + WS_BIG);
    float* YRAW = out; float* YSSM = out + (size_t)M * 512; float* DT = (float*)(ws + WS_DT); bf16_t* GB = (bf16_t*)(ws + WS_G); float* BONUS = (float*)(ws + WS_BONUS);
    bf16_t* W2T = (bf16_t*)(ws + WS_W2T); bf16_t* A2T = (bf16_t*)(ws + WS_A2T); bf16_t* G2T = (bf16_t*)(ws + WS_G2T); bf16_t* GU = (bf16_t*)(ws + WS_GU);
    bf16_t* PROJ1 = (bf16_t*)(ws + WS_PROJ1); bf16_t* QM = (bf16_t*)(ws + WS_QM); bf16_t* KVM = (bf16_t*)(ws + WS_KVM); bf16_t* KPE = (bf16_t*)(ws + WS_KPE); float* RS = (float*)(ws + WS_RS); bf16_t* VTS = (bf16_t*)(ws + WS_VTS); bf16_t* VTM = (bf16_t*)(ws + WS_VTM);
    const int* pos = (const int*)args.in[1];

    {
        PHASE_IDS();
    {
        LAS float* scr = (LAS float*)(lds3 + wave * 16384);
        transpose_matrix(IN(2), 1024, 3336, W0in, L0P, 1024, scr, gw, NGW, lane, nullptr);
        transpose_matrix(IN(20), 1024, 1024, W0out, 1024, 1024, scr, gw, NGW, lane, nullptr);
        transpose_matrix(IN(23), 1024, 5632, Wup0, 5632, 1024, scr, gw, NGW, lane, nullptr);
        transpose_matrix(IN(26), 2816, 1024, Wdn0, 1024, 2816, scr, gw, NGW, lane, nullptr);
        transpose_matrix(IN(29), 1024, 1952, W1in, L1P, 1024, scr, gw, NGW, lane, nullptr);
        transpose_matrix(IN(31), 256, 768, Wuq, 768, 256, scr, gw, NGW, lane, IN(30));
        transpose_matrix(IN(33), 128, 1024, Wukv, 1024, 256, scr, gw, NGW, lane, IN(32));
        for (int i = gtid; i < 1024 * 16; i += NT) { const int n = i >> 4, c = i & 15; *(v4u*)(Wukv + (size_t)n * 256 + 128 + c * 8) = (v4u){0u, 0u, 0u, 0u}; }
        transpose_matrix(IN(34), 1024, 1024, W1out, 1024, 1024, scr, gw, NGW, lane, nullptr);
        transpose_matrix(IN(37), 1024, 5632, Wup1, 5632, 1024, scr, gw, NGW, lane, nullptr);
        transpose_matrix(IN(40), 2816, 1024, Wdn1, 1024, 2816, scr, gw, NGW, lane, nullptr);
        transpose_matrix(IN(5), 64, 512, W2T, 512, 64, scr, gw, NGW, lane, nullptr);
        transpose_matrix(IN(7), 64, 512, A2T, 512, 64, scr, gw, NGW, lane, nullptr);
        transpose_matrix(IN(8), 128, 512, G2T, 512, 128, scr, gw, NGW, lane, nullptr);
        const float* x = IN(0);
        for (size_t i = (size_t)gtid * 4; i < (size_t)M * DM; i += (size_t)NT * 4) { const f32x4 v = *(const f32x4*)(x + i); uint2 w; w.x = pk2(v[0], v[1]); w.y = pk2(v[2], v[3]); *(uint2*)(XB + i) = w; }
    }
    }
    GRID_BAR();
    {
        PHASE_IDS();
    GEMM_PHASE(EpiBf16S, XB, DM, W0in, 1024, L0P, 1024, PROJ0, nullptr, L0P, 0);
    }
    GRID_BAR();
    {
        PHASE_IDS();
    ssm_conv_all(PROJ0, IN(14), IN(15), IN(16), XB, DT, gtid, NT);
    rwkv_phase((LAS float*)lds3, tid, lane, wave, (int)blockIdx.x, PROJ0, IN(3), IN(4), IN(6), IN(9), IN(10), IN(11), W2T, A2T, G2T, YRAW, GB, BONUS);
    }
    GRID_BAR();
    {
        PHASE_IDS();
#ifndef NO_SSD
    if (wave < 2) ssd_naive_task((int)blockIdx.x + 256 * wave, lane, XB, DT, IN(17), IN(18), YSSM);
#endif
    }
    GRID_BAR();
    {
        PHASE_IDS();
    ssm_gate_norm_all(YSSM, PROJ0, IN(19), YMIX, gw, NGW, lane);
    rwkv_post_all(YRAW, PROJ0, IN(3), BONUS, GB, IN(12), IN(13), YMIX, gw, NGW, lane);
    }
    GRID_BAR();
    {
        PHASE_IDS();
    GEMM_PHASE(EpiResid, YMIX, DM, W0out, 1024, 1024, 1024, IN(0), out, ALPHA, 0);
    }
    GRID_BAR();
    {
        PHASE_IDS();
    ln_rows(out, XB, IN(21), IN(22), gw, NGW, lane);
    }
    GRID_BAR();
    {
        PHASE_IDS();
    GEMM_PHASE(EpiBf16S, XB, DM, Wup0, 1024, 2 * DFF, 1024, GU, nullptr, 2 * DFF, 0);
    }
    GRID_BAR();
    {
        PHASE_IDS();
    ffn_act_all(GU, IN(24), IN(25), gtid, NT);
    }
    GRID_BAR();
    {
        PHASE_IDS();
    GEMM_PHASE(EpiResid, GU + DFF, 2 * DFF, Wdn0, DFF, 1024, DFF, out, out, ALPHA, 0);
    }
    GRID_BAR();
    {
        PHASE_IDS();
    ln_rows(out, XB, IN(27), IN(28), gw, NGW, lane);
    }
    GRID_BAR();
    {
        PHASE_IDS();
    GEMM_PHASE(EpiBf16S, XB, DM, W1in, 1024, L1P, 1024, PROJ1, nullptr, L1P, 0);
    }
    GRID_BAR();
    {
        PHASE_IDS();
    mla_prep_all(PROJ1, pos, RS, KPE, gw, NGW, lane);
    }
    GRID_BAR();
    {
        PHASE_IDS();
    GEMM_PHASE(EpiBf16S, PROJ1 + 1536, L1P, Wuq, 256, 768, 256, QM, RS, 768, 2);
    GEMM_PHASE(EpiBf16S, PROJ1 + 1792, L1P, Wukv, 256, 1024, 256, KVM, RS + 1, 1024, 2);
    }
    GRID_BAR();
    {
        PHASE_IDS();
    rope_q_all(QM, pos, gtid, NT);
    {
        LAS bf16_t* scr = (LAS bf16_t*)(lds3 + wave * 16384);
        for (int it = gw; it < 8192; it += NGW) { const int which = it >> 12, r = it & 4095, bh = r >> 5, tt = r & 31, b = bh >> 3, h = bh & 7;
            if (which == 0) transpose_tile64(PROJ1 + ((size_t)b * SEQ + tt * 64) * L1P + 1024 + h * 64, L1P, VTS + (size_t)bh * 64 * SEQ + tt * 64, SEQ, scr, lane);
            else            transpose_tile64(KVM + ((size_t)b * SEQ + tt * 64) * 1024 + h * 128 + 64, 1024, VTM + (size_t)bh * 64 * SEQ + tt * 64, SEQ, scr, lane); }
    }
    }
    GRID_BAR();
    {
        PHASE_IDS();
    {
        LAS bf16_t* stg = (LAS bf16_t*)(lds3 + wave * 16384);
        for (int g2 = gw; g2 < 2048; g2 += NGW) { const int bh = g2 >> 4, w = g2 & 15;
#pragma unroll 1
            for (int i = 0; i < 4; ++i) { const int qb = (i == 0) ? w : (i == 1) ? 31 - w : (i == 2) ? 32 + w : 63 - w;
                sb_task(bh, qb, lane, PROJ1, VTS, YMIX, stg);
                mla_task(bh, qb, lane, QM, KVM, KPE, VTM, YMIX, stg); } }
    }
    }
    GRID_BAR();
    {
        PHASE_IDS();
    GEMM_PHASE(EpiResid, YMIX, DM, W1out, 1024, 1024, 1024, out, out, ALPHA, 0);
    }
    GRID_BAR();
    {
        PHASE_IDS();
    ln_rows(out, XB, IN(35), IN(36), gw, NGW, lane);
    }
    GRID_BAR();
    {
        PHASE_IDS();
    GEMM_PHASE(EpiBf16S, XB, DM, Wup1, 1024, 2 * DFF, 1024, GU, nullptr, 2 * DFF, 0);
    }
    GRID_BAR();
    {
        PHASE_IDS();
    ffn_act_all(GU, IN(38), IN(39), gtid, NT);
    }
    GRID_BAR();
    {
        PHASE_IDS();
    GEMM_PHASE(EpiResid, GU + DFF, 2 * DFF, Wdn1, DFF, 1024, DFF, out, out, ALPHA, 0);
    }
    GRID_BAR();
    {
        PHASE_IDS();
    ln_rows(out, XB, IN(41), IN(42), gw, NGW, lane);
    }
}

extern "C" void kernel_launch(void* const* d_in, const int* in_sizes, int n_in, void* d_out, int out_size, void* d_ws, size_t ws_size, hipStream_t stream) {
    static int grid = 0;
    if (grid == 0) {
        if (n_in != 43 || ws_size < WS_NEED || out_size != M * DM) { fprintf(stderr, "kernel_launch: unexpected n_in %d / ws %zu / out %d\n", n_in, ws_size, out_size); grid = -1; return; }
        int dev = 0, cus = 0, per_cu = 0;
        if (hipGetDevice(&dev) != hipSuccess || hipDeviceGetAttribute(&cus, hipDeviceAttributeMultiprocessorCount, dev) != hipSuccess) { grid = -1; return; }
        if (hipFuncSetAttribute((const void*)fwd_mega, hipFuncAttributeMaxDynamicSharedMemorySize, LDS_BYTES) != hipSuccess) { fprintf(stderr, "kernel_launch: hipFuncSetAttribute failed\n"); grid = -1; return; }
        if (hipOccupancyMaxActiveBlocksPerMultiprocessor(&per_cu, (const void*)fwd_mega, NWAVES * 64, LDS_BYTES) != hipSuccess || per_cu < 1) fprintf(stderr, "kernel_launch: occupancy query reports %d\n", per_cu);
        (void)hipGetLastError();
        grid = cus;
    }
    if (grid < 0) return;
    (void)hipMemsetAsync((char*)d_ws + WS_CTL, 0, CTL_ZERO_BYTES, stream);
    Args a{};
    for (int i = 0; i < 43; ++i) a.in[i] = (const float*)d_in[i];
    a.out = (float*)d_out; a.ws = (unsigned char*)d_ws;
    hipLaunchKernelGGL(fwd_mega, dim3(grid), dim3(NWAVES * 64), LDS_BYTES, stream, a);
}
```

```cpp
#include <hip/hip_runtime.h>
#include <cstdio>
#include <cstdint>
#include <cmath>
namespace pg8 {
#define PG8_LAS __attribute__((address_space(3)))
typedef unsigned short bf16_t;
typedef short bf16x8 __attribute__((ext_vector_type(8)));
typedef float f32x4 __attribute__((ext_vector_type(4)));
typedef unsigned u32x4 __attribute__((ext_vector_type(4)));
constexpr int BM = 256, BK = 64, HALF = 128, HTB = HALF * BK * 2  , STAGE_BYTES = 8 * HTB, NXCD = 8, WGM = 8;

__host__ __device__ __forceinline__ int lds_byte(int r, int c) { const int st = (r >> 4) * 2 + (c >> 5), rr = r & 15, cc = c & 31, ob = rr * 64 + cc * 2; return st * 1024 + (ob ^ (((ob >> 9) & 1) << 5)); }
__host__ __device__ __forceinline__ void stage_rc(int b, int& R, int& C) { const int st = b / 1024, sb = b % 1024, swz = sb ^ (((sb >> 9) & 1) << 5); R = (st >> 1) * 16 + swz / 64; C = (st & 1) * 32 + (swz % 64) / 2; }
__host__ __device__ __forceinline__ int perm32(int rho) { const int n = rho >> 4, i = rho & 15; return 8 * (i >> 2) + 4 * n + (i & 3); }

struct Unit { int pm, pn; };
struct Gemm { const bf16_t* A; const bf16_t* Bt; int M, N, K, lda, ldb; };

struct StaticOrder {
    int nM, nN, nwg, G, c;
    __host__ __device__ void init(int M, int N, int G_, int c_) { nM = M / BM; nN = N / BM; nwg = nM * nN; G = G_; c = c_; }
    __host__ __device__ bool next(int i, Unit& u) const {
        const long L = (long)i * G + c; if (L >= nwg) return false;
        int wgid = (int)L; { const int q = nwg / NXCD, r = nwg % NXCD, xcd = wgid % NXCD, off = wgid / NXCD; wgid = (xcd < r ? xcd * (q + 1) : r * (q + 1) + (xcd - r) * q) + off; }
        const int nig = WGM * nN, gid = wgid / nig, fm = gid * WGM, gsz = (nM - fm) < WGM ? (nM - fm) : WGM;
        u.pm = fm + ((wgid % nig) % gsz); u.pn = (wgid % nig) / gsz; return true;
    }
    __device__ __forceinline__ void a_ready(const Unit&) const {}
    __device__ __forceinline__ void done(const Unit&) const {}
};


__device__ __forceinline__ unsigned cvt_pk_bf16(float lo, float hi) { unsigned r; asm volatile("v_cvt_pk_bf16_f32 %0, %1, %2" : "=v"(r) : "v"(lo), "v"(hi)); return r; }
struct EpiBf16S {
    static constexpr bool PERM = true, AFTER_DRAIN = false;
    bf16_t* O; const float* rowscale; int ldc; int rs_stride;
    __device__ __forceinline__ void operator()(const f32x4 (&acc)[2][2][4][2], const Unit& u, int wr, int wc, int fr, int fq) const {
        const int row0 = u.pm * BM + wr * 64 + fr, col0 = u.pn * BM + wc * 32 + 8 * fq;
#pragma unroll
        for (int ai = 0; ai < 2; ++ai)
#pragma unroll
            for (int m = 0; m < 4; ++m) { const int row = row0 + ai * HALF + m * 16; const float sc = rowscale ? rowscale[(size_t)row * rs_stride] : 1.f;
                bf16_t* rowp = O + (size_t)row * ldc + col0;
#pragma unroll
                for (int bj = 0; bj < 2; ++bj) { const f32x4 v0 = acc[ai][bj][m][0] * sc, v1 = acc[ai][bj][m][1] * sc;
                    u32x4 w; w.x = cvt_pk_bf16(v0[0], v0[1]); w.y = cvt_pk_bf16(v0[2], v0[3]); w.z = cvt_pk_bf16(v1[0], v1[1]); w.w = cvt_pk_bf16(v1[2], v1[3]);
                    *(u32x4*)(rowp + bj * HALF) = w; } }
    }
};
struct EpiResid {
    static constexpr bool PERM = false, AFTER_DRAIN = false;
    const float* hin; float* hout; float alpha; int pad;
    __device__ __forceinline__ void operator()(const f32x4 (&acc)[2][2][4][2], const Unit& u, int wr, int wc, int fr, int fq) const {
        const int row0 = u.pm * BM + wr * 64 + fr, col0 = u.pn * BM + wc * 32 + 4 * fq;
#pragma unroll
        for (int ai = 0; ai < 2; ++ai)
#pragma unroll
            for (int m = 0; m < 4; ++m) { const size_t off = (size_t)(row0 + ai * HALF + m * 16) * 1024 + col0;
#pragma unroll
                for (int bj = 0; bj < 2; ++bj)
#pragma unroll
                    for (int n = 0; n < 2; ++n) { const size_t i = off + bj * HALF + n * 16; const f32x4 h = *(const f32x4*)(hin + i); *(f32x4*)(hout + i) = h * alpha + acc[ai][bj][m][n]; } }
    }
};
template <class Epi, class Sched, bool ALIGN_EPI = false, bool SP2 = false>
__device__ __forceinline__ void gemm_phase(PG8_LAS unsigned char* lds, const Gemm g, const Sched& S, const Epi& E) {
    const int tid = threadIdx.x, wid = __builtin_amdgcn_readfirstlane(tid >> 6), lane = tid & 63, wr = wid >> 2, wc = wid & 3, fr = lane & 15, fq = lane >> 4;
    const int K = g.K, nt = K / BK;
    unsigned voffA[2], voffB[2];
#pragma unroll
    for (int i = 0; i < 2; ++i) { int R, C; stage_rc(tid * 16 + i * 8192, R, C); const int Rb = Epi::PERM ? ((R & ~31) + perm32(R & 31)) : R;
        voffA[i] = (unsigned)(R * g.lda + C) * 2u; voffB[i] = (unsigned)(Rb * g.ldb + C) * 2u; }
    const size_t kstep = (size_t)(BK * 2);
    const size_t hstepA = (size_t)HALF * g.lda * 2, hstepB = (size_t)HALF * g.ldb * 2;
    const size_t tstepA = 2 * hstepA, tstepB = 2 * hstepB;
    const unsigned ldsw = (unsigned)wid * 1024u;
    const int aoff = lds_byte(wr * 64 + fr, fq * 8), boff = lds_byte(wc * 32 + fr, fq * 8);
#define PG8_SA(b, h) (((b) * 2 + (h)) * HTB)
#define PG8_SB(b, h) ((4 + (b) * 2 + (h)) * HTB)
#define PG8_STAGE(bufoff, gbase, voff) do { _Pragma("unroll") for (int _i = 0; _i < 2; ++_i) \
        __builtin_amdgcn_global_load_lds((const unsigned*)((const char*)(gbase) + (voff)[_i]), (PG8_LAS unsigned*)(lds + (bufoff) + ldsw + _i * 8192), 16, 0, 0); } while (0)
#define PG8_LDA(dst, b, h) do { _Pragma("unroll") for (int m = 0; m < 4; ++m) _Pragma("unroll") for (int k = 0; k < 2; ++k) dst[m][k] = *(const PG8_LAS bf16x8*)(lds + PG8_SA(b, h) + aoff + m * 2048 + k * 1024); } while (0)
#define PG8_LDB(dst, b, h) do { _Pragma("unroll") for (int n = 0; n < 2; ++n) _Pragma("unroll") for (int k = 0; k < 2; ++k) dst[n][k] = *(const PG8_LAS bf16x8*)(lds + PG8_SB(b, h) + boff + n * 2048 + k * 1024); } while (0)
#define PG8_MMA(ai, bj, At, Bt) do { __builtin_amdgcn_s_setprio(1); _Pragma("unroll") for (int m = 0; m < 4; ++m) _Pragma("unroll") for (int n = 0; n < 2; ++n) _Pragma("unroll") for (int k = 0; k < 2; ++k) \
        acc[ai][bj][m][n] = __builtin_amdgcn_mfma_f32_16x16x32_bf16(Bt[n][k], At[m][k], acc[ai][bj][m][n], 0, 0, 0); __builtin_amdgcn_s_setprio(0); } while (0)
#define PG8_WAIT_V(n) asm volatile("s_waitcnt vmcnt(" #n ")" ::: "memory")
#define PG8_WAIT_L(n) asm volatile("s_waitcnt lgkmcnt(" #n ")" ::: "memory")
#define PG8_BAR __builtin_amdgcn_s_barrier()
#define PG8_SCHED __builtin_amdgcn_sched_barrier(0)
    Unit cur, nxt; int ui = 0;
    if (!S.next(0, cur)) return;
    f32x4 acc[2][2][4][2];
#pragma unroll
    for (int a = 0; a < 2; ++a)
#pragma unroll
        for (int b = 0; b < 2; ++b)
#pragma unroll
            for (int m = 0; m < 4; ++m)
#pragma unroll
                for (int n = 0; n < 2; ++n) acc[a][b][m][n] = (f32x4){0.f, 0.f, 0.f, 0.f};
    bf16x8 At[4][2], B0[2][2], B1[2][2];
    const char* cA = (const char*)g.A + (size_t)cur.pm * tstepA; const char* cB = (const char*)g.Bt + (size_t)cur.pn * tstepB;
    S.a_ready(cur);
    if constexpr (SP2) {
        PG8_STAGE(PG8_SB(0, 0), cB, voffB); PG8_STAGE(PG8_SB(0, 1), cB + hstepB, voffB); PG8_STAGE(PG8_SA(0, 0), cA, voffA); PG8_STAGE(PG8_SA(0, 1), cA + hstepA, voffA);
        if (wr == 1) PG8_BAR;
        PG8_WAIT_V(2); PG8_BAR;
        PG8_STAGE(PG8_SB(1, 0), cB + kstep, voffB); PG8_STAGE(PG8_SA(1, 0), cA + kstep, voffA); PG8_STAGE(PG8_SB(1, 1), cB + hstepB + kstep, voffB);
        PG8_WAIT_V(6); PG8_BAR;
    } else {
        PG8_STAGE(PG8_SB(0, 0), cB, voffB); PG8_STAGE(PG8_SA(0, 0), cA, voffA); PG8_STAGE(PG8_SB(0, 1), cB + hstepB, voffB); PG8_STAGE(PG8_SA(0, 1), cA + hstepA, voffA);
        if (wr == 1) PG8_BAR;
        PG8_WAIT_V(4); PG8_BAR;
        PG8_STAGE(PG8_SB(1, 0), cB + kstep, voffB); PG8_STAGE(PG8_SA(1, 0), cA + kstep, voffA); PG8_STAGE(PG8_SB(1, 1), cB + hstepB + kstep, voffB);
        PG8_WAIT_V(6); PG8_BAR;
    }
    for (;;) {
        const bool has_next = S.next(ui + 1, nxt);
        const char* nA = has_next ? (const char*)g.A + (size_t)nxt.pm * tstepA : cA; const char* nB = has_next ? (const char*)g.Bt + (size_t)nxt.pn * tstepB : cB;
        for (int t = 0; t < nt; t += 2) {
            const bool last = (t == nt - 2);
            const char* a1 = cA + (size_t)(t + 1) * kstep;
            const char* a2 = last ? nA : cA + (size_t)(t + 2) * kstep; const char* b2 = last ? nB : cB + (size_t)(t + 2) * kstep;
            const char* a3 = a2 + kstep; const char* b3 = b2 + kstep;
            if (last && has_next) S.a_ready(nxt);
            if constexpr (SP2) {
            PG8_LDB(B0, 0, 0); PG8_LDB(B1, 0, 1); PG8_SCHED; PG8_LDA(At, 0, 0); PG8_STAGE(PG8_SA(1, 1), a1 + hstepA, voffA);
            PG8_WAIT_V(8); PG8_WAIT_L(0); PG8_BAR; PG8_MMA(0, 0, At, B0); PG8_MMA(0, 1, At, B1); PG8_BAR; PG8_SCHED;
            PG8_LDA(At, 0, 1); PG8_STAGE(PG8_SB(0, 0), b2, voffB); PG8_STAGE(PG8_SB(0, 1), b2 + hstepB, voffB); PG8_STAGE(PG8_SA(0, 0), a2, voffA);
            PG8_WAIT_V(8); PG8_WAIT_L(0); PG8_BAR; PG8_MMA(1, 0, At, B0); PG8_MMA(1, 1, At, B1); PG8_BAR; PG8_SCHED;
            PG8_LDB(B0, 1, 0); PG8_LDB(B1, 1, 1); PG8_SCHED; PG8_LDA(At, 1, 0); PG8_STAGE(PG8_SA(0, 1), a2 + hstepA, voffA);
            PG8_WAIT_V(8); PG8_WAIT_L(0); PG8_BAR; PG8_MMA(0, 0, At, B0); PG8_MMA(0, 1, At, B1); PG8_BAR; PG8_SCHED;
            PG8_LDA(At, 1, 1); PG8_STAGE(PG8_SB(1, 0), b3, voffB); PG8_STAGE(PG8_SB(1, 1), b3 + hstepB, voffB); PG8_STAGE(PG8_SA(1, 0), a3, voffA);
            PG8_WAIT_V(8); PG8_WAIT_L(0); PG8_BAR; PG8_MMA(1, 0, At, B0); PG8_MMA(1, 1, At, B1); PG8_BAR; PG8_SCHED;
            } else {
            PG8_LDB(B0, 0, 0); PG8_SCHED; PG8_LDA(At, 0, 0); PG8_STAGE(PG8_SA(1, 1), a1 + hstepA, voffA);
            PG8_WAIT_L(8); PG8_BAR; PG8_WAIT_L(0); PG8_MMA(0, 0, At, B0); PG8_BAR; PG8_SCHED;
            PG8_LDB(B1, 0, 1); PG8_STAGE(PG8_SB(0, 0), b2, voffB);
            PG8_BAR; PG8_WAIT_L(0); PG8_MMA(0, 1, At, B1); PG8_BAR;
            PG8_LDA(At, 0, 1); PG8_STAGE(PG8_SA(0, 0), a2, voffA);
            PG8_BAR; PG8_WAIT_L(0); PG8_MMA(1, 0, At, B0); PG8_BAR; PG8_SCHED;
            PG8_STAGE(PG8_SB(0, 1), b2 + hstepB, voffB);
            PG8_WAIT_V(6); PG8_BAR; PG8_MMA(1, 1, At, B1); PG8_BAR;
            PG8_LDB(B0, 1, 0); PG8_SCHED; PG8_LDA(At, 1, 0); PG8_STAGE(PG8_SA(0, 1), a2 + hstepA, voffA);
            PG8_WAIT_L(8); PG8_BAR; PG8_WAIT_L(0); PG8_MMA(0, 0, At, B0); PG8_BAR; PG8_SCHED;
            PG8_LDB(B1, 1, 1); PG8_STAGE(PG8_SB(1, 0), b3, voffB);
            PG8_BAR; PG8_WAIT_L(0); PG8_MMA(0, 1, At, B1); PG8_BAR;
            PG8_LDA(At, 1, 1); PG8_STAGE(PG8_SA(1, 0), a3, voffA);
            PG8_BAR; PG8_WAIT_L(0); PG8_MMA(1, 0, At, B0); PG8_BAR; PG8_SCHED;
            PG8_STAGE(PG8_SB(1, 1), b3 + hstepB, voffB);
            PG8_WAIT_V(6); PG8_BAR; PG8_MMA(1, 1, At, B1); PG8_BAR;
            }
        }
        if constexpr (ALIGN_EPI) { if (wr == 0) PG8_BAR; }
        if constexpr (!Epi::AFTER_DRAIN) { E(acc, cur, wr, wc, fr, fq); S.done(cur); }
        if (!has_next) break;
#pragma unroll
        for (int a = 0; a < 2; ++a)
#pragma unroll
            for (int b = 0; b < 2; ++b)
#pragma unroll
                for (int m = 0; m < 4; ++m)
#pragma unroll
                    for (int n = 0; n < 2; ++n) acc[a][b][m][n] = (f32x4){0.f, 0.f, 0.f, 0.f};
        cur = nxt; cA = nA; cB = nB; ++ui;
        if constexpr (ALIGN_EPI) { if (wr == 1) PG8_BAR; }
    }
    PG8_WAIT_V(0);
    if constexpr (!ALIGN_EPI) { if (wr == 0) PG8_BAR; }
    PG8_BAR;
    if constexpr (Epi::AFTER_DRAIN) { E.fused(acc, cur, wr, wc, fr, fq, lds, wid, lane); S.done(cur); }
#undef PG8_SA
#undef PG8_SB
#undef PG8_STAGE
#undef PG8_LDA
#undef PG8_LDB
#undef PG8_MMA
#undef PG8_WAIT_V
#undef PG8_WAIT_L
#undef PG8_BAR
#undef PG8_SCHED
}
}
#define GAS __attribute__((address_space(1)))
#define LAS __attribute__((address_space(3)))
typedef unsigned short bf16;
typedef unsigned v4u __attribute__((ext_vector_type(4)));
typedef float f32x4 __attribute__((ext_vector_type(4)));
typedef short bf16x8 __attribute__((ext_vector_type(8)));
typedef GAS unsigned gu32;
typedef GAS unsigned long long gu64;
#define RLX_AGENT __ATOMIC_RELAXED, __HIP_MEMORY_SCOPE_AGENT
#define LDS_WAIT() asm volatile("s_waitcnt lgkmcnt(0)" ::: "memory")
#define VM_WAIT() asm volatile("s_waitcnt vmcnt(0)" ::: "memory")
__device__ __forceinline__ unsigned long long rt() { return __builtin_amdgcn_s_memrealtime(); }
__device__ __forceinline__ unsigned f2bf(float f) { unsigned u = __builtin_bit_cast(unsigned, f); return (u + 0x7fffu + ((u >> 16) & 1u)) >> 16; }
__device__ __forceinline__ unsigned pk2(float lo, float hi) { return f2bf(lo) | (f2bf(hi) << 16); }

#define XB_TMO      128
#define XB_XCNT(j)  (256  + 64 * (j))
#define XB_XSUB(j)  (1280 + 64 * (j))
#define XB_XGEN(j)  (2304 + 64 * (j))
#define XB_TOP      3328
#define XB_TOPGEN   3392
#define XCD_BAR_WORDS 3456
#define XB_SPIN_CAP (1u << 18)

__device__ __forceinline__ unsigned xb_ld(unsigned* p)              { return __hip_atomic_load(p, __ATOMIC_RELAXED, __HIP_MEMORY_SCOPE_AGENT); }
__device__ __forceinline__ unsigned xb_add(unsigned* p, unsigned v) { return __hip_atomic_fetch_add(p, v, __ATOMIC_RELAXED, __HIP_MEMORY_SCOPE_AGENT); }
__device__ __forceinline__ unsigned xb_xcc_id() { return (unsigned)__builtin_amdgcn_s_getreg((3 << 11) | 20) & 0xFu; }
#define XB_SPIN(cond, bar) do { unsigned _sp = 0; while (cond) { __builtin_amdgcn_s_sleep(1); \
    if ((++_sp & 255u) == 0u) { if (xb_ld(&(bar)[XB_TMO])) break; if (_sp > XB_SPIN_CAP) { atomicAdd(&(bar)[XB_TMO], 1u); break; } } } } while (0)

struct XcdBarrier {
    unsigned* bar; unsigned x;
    volatile LAS unsigned* st;
};

__device__ __forceinline__ XcdBarrier xcd_barrier_post(unsigned* bar, volatile LAS unsigned* st) {
    XcdBarrier b; b.bar = bar; b.x = xb_xcc_id(); b.st = st;
    if (threadIdx.x == 0) (void)xb_add(&bar[XB_XCNT(b.x)], 1u);
    return b;
}
__device__ __forceinline__ void xcd_barrier_complete(unsigned* bar, unsigned x, unsigned& nloc, unsigned& nx) {
    const unsigned G = gridDim.x * gridDim.y * gridDim.z;
    unsigned sum, cnt, mine, sp = 0u;
    for (;;) {
        sum = 0u; cnt = 0u; mine = 0u;
#pragma unroll
        for (unsigned j = 0; j < 16; ++j) { const unsigned c = xb_ld(&bar[XB_XCNT(j)]); sum += c; cnt += (c > 0u) ? 1u : 0u; mine = (j == x) ? c : mine; }
        if (sum == G) break;
        __builtin_amdgcn_s_sleep(1);
        if ((++sp & 255u) == 0u) { if (xb_ld(&bar[XB_TMO])) break; if (sp > XB_SPIN_CAP) { atomicAdd(&bar[XB_TMO], 1u); break; } }
    }
    nloc = mine > 0u ? mine : 1u; nx = cnt > 0u ? cnt : 1u;
}

__device__ __forceinline__ void xcd_barrier(const XcdBarrier& b) {
    asm volatile("s_waitcnt vmcnt(0)" ::: "memory");
    __syncthreads();
    if (threadIdx.x == 0) {
        unsigned* bar = b.bar;
        __builtin_amdgcn_s_waitcnt(0);
        unsigned nloc = b.st[0], nx = b.st[1];
        if (nloc == 0u) { xcd_barrier_complete(bar, b.x, nloc, nx); b.st[0] = nloc; b.st[1] = nx; }
        const unsigned old = xb_add(&bar[XB_XSUB(b.x)], 1u);
        const unsigned gen = old / nloc;
        if (old + 1u == (gen + 1u) * nloc) {
            __builtin_amdgcn_fence(__ATOMIC_RELEASE, "agent");
            asm volatile("s_waitcnt vmcnt(0)" ::: "memory");
            const unsigned og = xb_add(&bar[XB_TOP], 1u);
            const unsigned tg = og / nx;
            if (og + 1u == (tg + 1u) * nx) xb_add(&bar[XB_TOPGEN], 1u);
            else XB_SPIN(xb_ld(&bar[XB_TOPGEN]) == tg, bar);
            __builtin_amdgcn_fence(__ATOMIC_ACQUIRE, "agent");
            xb_add(&bar[XB_XGEN(b.x)], 1u);
            asm volatile("s_waitcnt vmcnt(0)" ::: "memory");
        } else {
            XB_SPIN(xb_ld(&bar[XB_XGEN(b.x)]) == gen, bar);
            __builtin_amdgcn_fence(__ATOMIC_ACQUIRE, "agent");
            asm volatile("s_waitcnt vmcnt(0)" ::: "memory");
        }
    }
    __syncthreads();
}
constexpr int NWAVES = 8;
constexpr int BATCH = 16, SEQ = 2048, DM = 1024, M = BATCH * SEQ;
constexpr int L0P = 3584;
constexpr int L1P = 2048;
constexpr int DFF = 2816;
constexpr float ALPHA = 1.4142135623730951f;
typedef unsigned short bf16_t;
typedef float f32x16 __attribute__((ext_vector_type(16)));

constexpr size_t MiB = 1u << 20;
constexpr size_t WS_CTL = 0, CTL_ZERO_BYTES = 1 * MiB;
constexpr int CW_BAR = 4096;
constexpr size_t WS_W0IN = 2 * MiB, WS_W0OUT = 9 * MiB, WS_WUP0 = 11 * MiB, WS_WDN0 = 22 * MiB, WS_W1IN = 28 * MiB, WS_WUQ = 32 * MiB, WS_WUKV = 33 * MiB,
                 WS_W1OUT = 34 * MiB, WS_WUP1 = 36 * MiB, WS_WDN1 = 47 * MiB;
constexpr size_t WS_XB = 56 * MiB, WS_YMIX = 120 * MiB, WS_BIG = 184 * MiB;
constexpr size_t WS_G = 408 * MiB, WS_BONUS = 440 * MiB, WS_DT = 441 * MiB, WS_XST = 442 * MiB, WS_BT = 474 * MiB, WS_ASUM = 490 * MiB;
constexpr size_t WS_SLOC = 120 * MiB;
constexpr size_t WS_W2T = 53 * MiB, WS_A2T = 53 * MiB + 256 * 1024, WS_G2T = 53 * MiB + 512 * 1024;
constexpr size_t WS_GU = 120 * MiB;
constexpr size_t WS_PROJ1 = 184 * MiB, WS_QM = 312 * MiB, WS_KVM = 360 * MiB, WS_KPE = 424 * MiB, WS_RS = 426 * MiB;
constexpr size_t WS_VTS = 428 * MiB, WS_VTM = 460 * MiB;
constexpr size_t WS_NEED = 492 * MiB;

constexpr int RING_BYTES = 131072;
constexpr int LDSCTL_OFF = 146432, MISC_OFF = LDSCTL_OFF + 320;
constexpr int LDS_BYTES = 147456;

__device__ __forceinline__ float bf2f(bf16_t b) { return __builtin_bit_cast(float, (unsigned)b << 16); }
__device__ __forceinline__ float sigmoidf_(float x) { return 1.f / (1.f + expf(-x)); }
__device__ __forceinline__ float softplusf_(float x) { return fmaxf(x, 0.f) + log1pf(expf(-fabsf(x))); }
__device__ __forceinline__ float siluf_(float x) { return x / (1.f + expf(-x)); }
__device__ __forceinline__ float wave_sum(float v) {
#pragma unroll
    for (int o = 1; o < 64; o <<= 1) v += __shfl_xor(v, o);
    return v;
}
#define WSYNC() asm volatile("s_waitcnt lgkmcnt(0)" ::: "memory")

__device__ __forceinline__ void transpose_item(const float* __restrict__ W, int N, bf16_t* __restrict__ WT, int ldt, LAS float* scr, int kb, int nb, int lane, const float* __restrict__ kscale) {
    const int k0 = 64 * kb, n0 = 32 * nb;
#pragma unroll 8
    for (int i = 0; i < 32; ++i) { const int kk = 2 * i + (lane >> 5), n = n0 + (lane & 31); float v = (n < N) ? W[(size_t)(k0 + kk) * N + n] : 0.f; if (kscale) v *= kscale[k0 + kk]; scr[kk * 33 + (lane & 31)] = v; }
    WSYNC();
    const int c = lane & 7;
#pragma unroll
    for (int j = 0; j < 4; ++j) { const int n = (lane >> 3) + 8 * j; const LAS float* s = scr + (8 * c) * 33 + n;
        v4u o; o.x = pk2(s[0 * 33], s[1 * 33]); o.y = pk2(s[2 * 33], s[3 * 33]); o.z = pk2(s[4 * 33], s[5 * 33]); o.w = pk2(s[6 * 33], s[7 * 33]);
        *(v4u*)(WT + (size_t)(n0 + n) * ldt + k0 + 8 * c) = o; }
    WSYNC();
}
__device__ __forceinline__ void transpose_matrix(const float* W, int K, int N, bf16_t* WT, int Npad, int ldt, LAS float* scr, int gw, int NGW, int lane, const float* kscale) {
    const int nblk = Npad / 32, nit = (K / 64) * nblk;
    for (int it = gw; it < nit; it += NGW) transpose_item(W, N, WT, ldt, scr, it / nblk, it % nblk, lane, kscale);
}

__device__ __forceinline__ void ln_rows(float* h, bf16_t* hb, const float* __restrict__ g, const float* __restrict__ b, int gw, int NGW, int lane) {
    for (int row = gw; row < M; row += NGW) {
        float* p = h + (size_t)row * DM;
        f32x4 v[4]; float s = 0.f;
#pragma unroll
        for (int j = 0; j < 4; ++j) { v[j] = *(const f32x4*)(p + 4 * lane + 256 * j); s += (v[j][0] + v[j][1]) + (v[j][2] + v[j][3]); }
        const float mean = wave_sum(s) * (1.f / DM); float q = 0.f;
#pragma unroll
        for (int j = 0; j < 4; ++j) { v[j] = v[j] - mean; q += (v[j][0] * v[j][0] + v[j][1] * v[j][1]) + (v[j][2] * v[j][2] + v[j][3] * v[j][3]); }
        const float rstd = 1.0f / sqrtf(wave_sum(q) * (1.f / DM) + 1e-5f);
#pragma unroll
        for (int j = 0; j < 4; ++j) {
            const int c = 4 * lane + 256 * j;
            const f32x4 gg = *(const f32x4*)(g + c), bb = *(const f32x4*)(b + c);
            const f32x4 o = v[j] * rstd * gg + bb;
            *(f32x4*)(p + c) = o;
            uint2 w; w.x = pk2(o[0], o[1]); w.y = pk2(o[2], o[3]);
            *(uint2*)(hb + (size_t)row * DM + c) = w;
        }
    }
}

__device__ __forceinline__ void rwkv_naive_chain(int chain, int lane, LAS float* sm, const bf16_t* __restrict__ proj, const float* __restrict__ mix, const float* __restrict__ w0, const float* __restrict__ w2,
                                                 const float* __restrict__ a0, const float* __restrict__ a2, const float* __restrict__ g2, const float* __restrict__ k_k,
                                                 const float* __restrict__ k_a, const float* __restrict__ r_k, const float* __restrict__ ln_g, const float* __restrict__ ln_b, bf16_t* __restrict__ ymix) {
    LAS float* s_w2 = sm; LAS float* s_a2 = sm + 4096; LAS float* s_g2 = sm + 8192; LAS float* s_tw = sm + 16384; LAS float* s_al = s_tw + 64; LAS float* s_sg = s_tw + 128;
    LAS float* s_w = s_tw + 256; LAS float* s_k = s_tw + 320; LAS float* s_a = s_tw + 384; LAS float* s_b = s_tw + 448; LAS float* s_r = s_tw + 512;
    const int b = chain >> 3, h = chain & 7, c = h * 64 + lane;
    for (int l = 0; l < 64; ++l) { s_w2[l * 64 + lane] = w2[l * 512 + c]; s_a2[l * 64 + lane] = a2[l * 512 + c]; }
    for (int l = 0; l < 128; ++l) s_g2[l * 64 + lane] = g2[l * 512 + c];
    const float mr = mix[c], mk = mix[512 + c], mv = mix[1024 + c], mw = mix[1536 + lane], ma = mix[1600 + lane], mg0 = mix[1664 + lane], mg1 = mix[1728 + lane];
    const float w0c = w0[c], a0c = a0[c], kkc = k_k[c], kac = k_a[c], rkc = r_k[c], lgc = ln_g[c], lbc = ln_b[c];
    float S[64];
#pragma unroll
    for (int j = 0; j < 64; ++j) S[j] = 0.f;
    float pr = 0.f, pk = 0.f, pv = 0.f, pw = 0.f, pa = 0.f, pg0 = 0.f, pg1 = 0.f;
    WSYNC();
    for (int t = 0; t < SEQ; ++t) {
        const bf16_t* row = proj + (size_t)(b * SEQ + t) * L0P;
        const float cr = bf2f(row[c]), ck = bf2f(row[512 + c]), cv = bf2f(row[1024 + c]), cw = bf2f(row[1536 + lane]), ca = bf2f(row[1600 + lane]),
                    cg0 = bf2f(row[1664 + lane]), cg1 = bf2f(row[1728 + lane]);
        const float r_s = cr + (pr - cr) * mr, k_s = ck + (pk - ck) * mk, v_s = cv + (pv - cv) * mv;
        const float wl = cw + (pw - cw) * mw, al = ca + (pa - ca) * ma, g0 = cg0 + (pg0 - cg0) * mg0, g1 = cg1 + (pg1 - cg1) * mg1;
        pr = cr; pk = ck; pv = cv; pw = cw; pa = ca; pg0 = cg0; pg1 = cg1;
        s_tw[lane] = tanhf(wl); s_al[lane] = al; s_sg[lane] = sigmoidf_(g0); s_sg[64 + lane] = sigmoidf_(g1);
        WSYNC();
        float wsum = w0c, asum = a0c, gsum = 0.f;
#pragma unroll 2
        for (int l = 0; l < 64; ++l) { wsum += s_tw[l] * s_w2[l * 64 + lane]; asum += s_al[l] * s_a2[l * 64 + lane]; }
#pragma unroll 2
        for (int l = 0; l < 128; ++l) gsum += s_sg[l] * s_g2[l * 64 + lane];
        const float log_w = -softplusf_(-wsum) - 0.5f;
        const float dec = expf(-expf(log_w));
        const float a = sigmoidf_(asum);
        float kkv = k_s * kkc;
        const float nrm = sqrtf(wave_sum(kkv * kkv));
        kkv = kkv / fmaxf(nrm, 1e-12f);
        const float k2 = k_s * (1.f + (a - 1.f) * kac);
        const float bonus_s = wave_sum(r_s * k2 * rkc);
        s_w[lane] = dec; s_k[lane] = k2; s_a[lane] = -kkv; s_b[lane] = kkv * a; s_r[lane] = r_s;
        WSYNC();
        float sa = 0.f;
#pragma unroll
        for (int j = 0; j < 64; ++j) sa += S[j] * s_a[j];
        float y = 0.f;
#pragma unroll
        for (int j = 0; j < 64; ++j) { S[j] = S[j] * s_w[j] + sa * s_b[j] + v_s * s_k[j]; y += S[j] * s_r[j]; }
        const float mu = wave_sum(y) * (1.f / 64.f);
        const float d = y - mu;
        const float var = wave_sum(d * d) * (1.f / 64.f);
        const float yn = d * (1.0f / sqrtf(var + 64e-5f)) * lgc + lbc;
        const float o = (yn + bonus_s * v_s) * gsum;
        ymix[(size_t)(b * SEQ + t) * DM + c] = (bf16_t)f2bf(o);
        WSYNC();
    }
}

__device__ __forceinline__ void ssm_conv_all(const bf16_t* __restrict__ proj, const float* __restrict__ cw, const float* __restrict__ cb, const float* __restrict__ dtb,
                                             bf16_t* __restrict__ xbc, float* __restrict__ dt, int gtid, int NT) {
    for (size_t i = gtid; i < (size_t)M * 1024; i += NT) {
        const int m = (int)(i >> 10), c = (int)(i & 1023), t = m & (SEQ - 1);
        float acc = cb[c];
#pragma unroll
        for (int k = 0; k < 4; ++k) { const int tt = t - 3 + k; if (tt >= 0) acc += cw[k * 1024 + c] * bf2f(proj[(size_t)(m - 3 + k) * L0P + 2304 + c]); }
        xbc[i] = (bf16_t)f2bf(siluf_(acc));
    }
    for (int i = gtid; i < M * 8; i += NT) dt[i] = softplusf_(bf2f(proj[(size_t)(i >> 3) * L0P + 3328 + (i & 7)]) + dtb[i & 7]);
}
__device__ __forceinline__ void ssd_naive_task(int task, int lane, const bf16_t* __restrict__ xbc, const float* __restrict__ dt, const float* __restrict__ a_log, const float* __restrict__ dsk, float* __restrict__ yssm) {
    const int chain = task >> 2, q = task & 3, b = chain >> 3, h = chain & 7, g = h >> 2, p = q * 16 + (lane >> 2), nq = lane & 3;
    const float A = -expf(a_log[h]), D = dsk[h];
    float st[32];
#pragma unroll
    for (int n = 0; n < 32; ++n) st[n] = 0.f;
    for (int t = 0; t < SEQ; ++t) {
        const size_t m = (size_t)b * SEQ + t;
        const float dtv = dt[m * 8 + h], dA = expf(dtv * A);
        const float x = bf2f(xbc[m * 1024 + h * 64 + p]), xdt = x * dtv;
        const bf16_t* Bp = xbc + m * 1024 + 512 + g * 128 + nq * 32;
        const bf16_t* Cp = xbc + m * 1024 + 768 + g * 128 + nq * 32;
        float yp = 0.f;
#pragma unroll
        for (int n = 0; n < 32; ++n) { st[n] = st[n] * dA + xdt * bf2f(Bp[n]); yp += st[n] * bf2f(Cp[n]); }
        yp += __shfl_xor(yp, 1); yp += __shfl_xor(yp, 2);
        if (nq == 0) yssm[m * 512 + h * 64 + p] = yp + D * x;
    }
}
__device__ __forceinline__ void ssm_gate_norm_all(const bf16_t* __restrict__ yssm, const bf16_t* __restrict__ proj, const float* __restrict__ ng, bf16_t* __restrict__ ymix, int wv0, int wvend, int lane) {
    for (int wv = wv0; wv < wvend; wv += NWAVES) {
        const int m = wv >> 1, g = wv & 1;
        float u[4], q = 0.f;
#pragma unroll
        for (int j = 0; j < 4; ++j) { const int c = g * 256 + j * 64 + lane; const float z = bf2f(proj[(size_t)m * L0P + 1792 + c]); u[j] = bf2f(yssm[(size_t)m * 512 + c]) * siluf_(z); q += u[j] * u[j]; }
        const float rs = 1.0f / sqrtf(wave_sum(q) * (1.f / 256.f) + 1e-5f);
#pragma unroll
        for (int j = 0; j < 4; ++j) { const int c = g * 256 + j * 64 + lane; ymix[(size_t)m * DM + 512 + c] = (bf16_t)f2bf(u[j] * rs * ng[c]); }
    }
}
__device__ __forceinline__ void ffn_act_all(bf16_t* gu, const float* __restrict__ cw, const float* __restrict__ cb, int gtid, int NT) {
    for (size_t i = gtid; i < (size_t)M * DFF; i += NT) {
        const int m = (int)(i / DFF), c = (int)(i - (size_t)m * DFF), t = m & (SEQ - 1);
        float acc = cb[c];
#pragma unroll
        for (int k = 0; k < 3; ++k) { const int tt = t - 2 + k; if (tt >= 0) acc += cw[k * DFF + c] * bf2f(gu[(size_t)(m - 2 + k) * (2 * DFF) + c]); }
        const size_t o = (size_t)m * (2 * DFF) + DFF + c;
        gu[o] = (bf16_t)f2bf(siluf_(acc) * bf2f(gu[o]));
    }
}
__device__ __forceinline__ void mla_prep_all(const bf16_t* __restrict__ proj1, const int* __restrict__ pos, float* __restrict__ rs, bf16_t* __restrict__ kpe, int gw, int NGW, int lane) {
    for (int m = gw; m < M; m += NGW) {
        const bf16_t* row = proj1 + (size_t)m * L1P;
        float q = 0.f;
#pragma unroll
        for (int j = 0; j < 4; ++j) { const float v = bf2f(row[1536 + j * 64 + lane]); q += v * v; }
        q = wave_sum(q);
        float k = 0.f;
#pragma unroll
        for (int j = 0; j < 2; ++j) { const float v = bf2f(row[1792 + j * 64 + lane]); k += v * v; }
        k = wave_sum(k);
        if (lane == 0) { rs[(size_t)m * 2] = 1.0f / sqrtf(q * (1.f / 256.f) + 1e-6f); rs[(size_t)m * 2 + 1] = 1.0f / sqrtf(k * (1.f / 128.f) + 1e-6f); }
        if (lane < 16) {
            const double inv = pow(10000.0, -(double)(2 * lane) / 32.0);
            const double ang = (double)pos[m] * inv;
            const float cs = (float)cos(ang), sn = (float)sin(ang);
            const float x1 = bf2f(row[1920 + lane]), x2 = bf2f(row[1936 + lane]);
            kpe[(size_t)m * 32 + lane] = (bf16_t)f2bf(x1 * cs - x2 * sn);
            kpe[(size_t)m * 32 + 16 + lane] = (bf16_t)f2bf(x2 * cs + x1 * sn);
        }
    }
}
__device__ __forceinline__ void rope_q_all(bf16_t* qm, const int* __restrict__ pos, int gtid, int NT) {
    for (int i = gtid; i < M * 128; i += NT) {
        const int m = i >> 7, h = (i >> 4) & 7, k = i & 15;
        const double inv = pow(10000.0, -(double)(2 * k) / 32.0);
        const double ang = (double)pos[m] * inv;
        const float cs = (float)cos(ang), sn = (float)sin(ang);
        bf16_t* p = qm + (size_t)m * 768 + h * 96 + 64;
        const float x1 = bf2f(p[k]), x2 = bf2f(p[16 + k]);
        p[k] = (bf16_t)f2bf(x1 * cs - x2 * sn); p[16 + k] = (bf16_t)f2bf(x2 * cs + x1 * sn);
    }
}
__device__ __forceinline__ void sb_naive_task(int qblk, int bh, int lane, const bf16_t* __restrict__ proj1, bf16_t* __restrict__ ymix) {
    const int b = bh >> 3, h = bh & 7, t = qblk * 64 + lane;
    const size_t mrow = (size_t)b * SEQ;
    float q[64], o[64];
#pragma unroll
    for (int d = 0; d < 64; ++d) { q[d] = bf2f(proj1[(mrow + t) * L1P + h * 64 + d]) * 0.125f; o[d] = 0.f; }
    float cum = 0.f;
    const int smax = qblk * 64 + 63;
    for (int s = smax - 1; s >= 0; --s) {
        const bf16_t* kr = proj1 + (mrow + s) * L1P + 512 + h * 64;
        const bf16_t* vr = proj1 + (mrow + s) * L1P + 1024 + h * 64;
        float z = 0.f;
#pragma unroll
        for (int d = 0; d < 64; ++d) z += q[d] * bf2f(kr[d]);
        if (s < t) {
            const float lsp = -softplusf_(-z);
            const float lsn = -softplusf_(z);
            const float att = expf(lsp + cum);
            cum += lsn;
#pragma unroll
            for (int d = 0; d < 64; ++d) o[d] += att * bf2f(vr[d]);
        }
    }
#pragma unroll
    for (int d = 0; d < 64; ++d) ymix[(mrow + t) * DM + h * 64 + d] = (bf16_t)f2bf(o[d]);
}
__device__ __forceinline__ void mla_naive_task(int qblk, int bh, int lane, const bf16_t* __restrict__ qm, const bf16_t* __restrict__ kvm, const bf16_t* __restrict__ kpe, bf16_t* __restrict__ ymix) {
    const int b = bh >> 3, h = bh & 7, t = qblk * 64 + lane;
    const size_t mrow = (size_t)b * SEQ;
    const float scale = 0.10206207261596577f;
    float q[96], o[64];
#pragma unroll
    for (int d = 0; d < 96; ++d) q[d] = bf2f(qm[(mrow + t) * 768 + h * 96 + d]) * scale;
#pragma unroll
    for (int d = 0; d < 64; ++d) o[d] = 0.f;
    float mx = -1e30f, l = 0.f;
    const int smax = qblk * 64 + 63;
    for (int s = 0; s <= smax; ++s) {
        const bf16_t* kr = kvm + (mrow + s) * 1024 + h * 128;
        const bf16_t* pr = kpe + (mrow + s) * 32;
        float z = 0.f;
#pragma unroll
        for (int d = 0; d < 64; ++d) z += q[d] * bf2f(kr[d]);
#pragma unroll
        for (int d = 0; d < 32; ++d) z += q[64 + d] * bf2f(pr[d]);
        if (s <= t) {
            const float mn = fmaxf(mx, z), f = expf(mx - mn), pz = expf(z - mn);
            l = l * f + pz; mx = mn;
#pragma unroll
            for (int d = 0; d < 64; ++d) o[d] = o[d] * f + pz * bf2f(kr[64 + d]);
        }
    }
    const float il = 1.f / l;
#pragma unroll
    for (int d = 0; d < 64; ++d) ymix[(mrow + t) * DM + 512 + h * 64 + d] = (bf16_t)f2bf(o[d] * il);
}


typedef float f32x2_t __attribute__((ext_vector_type(2)));
typedef __bf16 bf16x2_t __attribute__((ext_vector_type(2)));
typedef unsigned u32x2 __attribute__((ext_vector_type(2)));
__device__ __forceinline__ unsigned cvtpk(float lo, float hi) { f32x2_t v = {lo, hi}; bf16x2_t b = __builtin_convertvector(v, bf16x2_t); return __builtin_bit_cast(unsigned, b); }
__device__ __forceinline__ int crow(int r, int hi) { return (r & 3) + 8 * (r >> 2) + 4 * hi; }
#define MFMA32(a, b, c) __builtin_amdgcn_mfma_f32_32x32x16_bf16((a), (b), (c), 0, 0, 0)
constexpr int STG_PITCH = 72;
__device__ __forceinline__ void transpose_tile64(const bf16_t* __restrict__ src, int sp, bf16_t* __restrict__ dst, int dp, LAS bf16_t* scr, int lane) {
#pragma unroll
    for (int i = 0; i < 8; ++i) { const int row = i * 8 + (lane >> 3), ch = lane & 7; const v4u v = *(const v4u*)(src + (size_t)row * sp + ch * 8); *(LAS v4u*)(scr + row * STG_PITCH + ch * 8) = v; }
    WSYNC();
#pragma unroll
    for (int i = 0; i < 8; ++i) { const int d = i * 8 + (lane >> 3), tc = lane & 7; const LAS bf16_t* p = scr + (tc * 8) * STG_PITCH + d;
        v4u o; o.x = (unsigned)p[0] | ((unsigned)p[STG_PITCH] << 16); o.y = (unsigned)p[2 * STG_PITCH] | ((unsigned)p[3 * STG_PITCH] << 16);
        o.z = (unsigned)p[4 * STG_PITCH] | ((unsigned)p[5 * STG_PITCH] << 16); o.w = (unsigned)p[6 * STG_PITCH] | ((unsigned)p[7 * STG_PITCH] << 16);
        *(v4u*)(dst + (size_t)d * dp + tc * 8) = o; }
    WSYNC();
}
__device__ __forceinline__ void store_OT(const f32x16 (&o)[2], float sc, LAS bf16_t* stg, bf16_t* __restrict__ dst, int lane) {
    const int l31 = lane & 31, hi = lane >> 5;
#pragma unroll
    for (int dt = 0; dt < 2; ++dt)
#pragma unroll
        for (int r = 0; r < 16; ++r) stg[l31 * STG_PITCH + 32 * dt + crow(r, hi)] = (bf16_t)f2bf(o[dt][r] * sc);
    WSYNC();
#pragma unroll
    for (int i = 0; i < 4; ++i) { const int row = i * 8 + (lane >> 3), ch = lane & 7; const v4u v = *(const LAS v4u*)(stg + row * STG_PITCH + ch * 8); *(v4u*)(dst + (size_t)row * DM + ch * 8) = v; }
    WSYNC();
}
__device__ __forceinline__ float softplus_fast(float z) { return fmaxf(z, 0.f) + __logf(1.f + __expf(-fabsf(z))); }

__device__ __forceinline__ void sb_task(int bh, int qblk, int lane, const bf16_t* __restrict__ P1, const bf16_t* __restrict__ VT, bf16_t* __restrict__ ymix, LAS bf16_t* stg) {
    const int b = bh >> 3, h = bh & 7, l31 = lane & 31, hi = lane >> 5, q0 = qblk * 32, t = q0 + l31;
    const size_t rowb = (size_t)b * SEQ;
    const bf16_t* Qp = P1 + (rowb + q0 + l31) * L1P + h * 64 + 8 * hi;
    bf16x8 qf[4];
#pragma unroll
    for (int kk = 0; kk < 4; ++kk) qf[kk] = *(const bf16x8*)(Qp + 16 * kk);
    const bf16_t* Kp = P1 + (rowb + l31) * L1P + 512 + h * 64 + 8 * hi;
    const bf16_t* Vp = VT + ((size_t)bh * 64 + l31) * SEQ + 4 * hi;
    f32x16 o[2];
#pragma unroll
    for (int r = 0; r < 16; ++r) { o[0][r] = 0.f; o[1][r] = 0.f; }
    float cum = 0.f;
    bf16x8 kf[4]; u32x2 va[2][2][2];
#define SB_LOAD(S0, KF, VA) do { _Pragma("unroll") for (int kk = 0; kk < 4; ++kk) KF[kk] = *(const bf16x8*)(Kp + (size_t)(S0) * L1P + 16 * kk); \
        _Pragma("unroll") for (int dt = 0; dt < 2; ++dt) _Pragma("unroll") for (int ks = 0; ks < 2; ++ks) { VA[dt][ks][0] = *(const u32x2*)(Vp + (size_t)dt * 32 * SEQ + (S0) + 16 * ks); VA[dt][ks][1] = *(const u32x2*)(Vp + (size_t)dt * 32 * SEQ + (S0) + 16 * ks + 8); } } while (0)
    SB_LOAD(q0, kf, va);
    for (int s0 = q0; s0 >= 0; s0 -= 32) {
        bf16x8 kn[4]; u32x2 vn[2][2][2];
        const int sn = (s0 >= 32) ? s0 - 32 : 0;
        SB_LOAD(sn, kn, vn);
        f32x16 acc;
#pragma unroll
        for (int r = 0; r < 16; ++r) acc[r] = 0.f;
#pragma unroll
        for (int kk = 0; kk < 4; ++kk) acc = MFMA32(kf[kk], qf[kk], acc);
        const bool diag = (s0 == q0);
        float lb[16], lk[16];
#pragma unroll
        for (int r = 0; r < 16; ++r) { const float z = acc[r] * 0.125f; const float sp = softplus_fast(z); float b_ = z - sp, k_ = -sp;
            if (diag) { const bool valid = (s0 + crow(r, hi)) < t; b_ = valid ? b_ : -1e30f; k_ = valid ? k_ : 0.f; }
            lb[r] = b_; lk[r] = k_; }
        float e[16], T[4], U[4];
#pragma unroll
        for (int i = 0; i < 4; ++i) { e[4 * i + 3] = 0.f; e[4 * i + 2] = lk[4 * i + 3]; e[4 * i + 1] = e[4 * i + 2] + lk[4 * i + 2]; e[4 * i] = e[4 * i + 1] + lk[4 * i + 1]; T[i] = e[4 * i] + lk[4 * i]; }
#pragma unroll
        for (int i = 0; i < 4; ++i) U[i] = __shfl_xor(T[i], 32);
        float off[4];
        { const float st2 = T[3], st1 = st2 + T[2], st0 = st1 + T[1]; const float su2 = U[3], su1 = su2 + U[2], su0 = su1 + U[1];
          const float x0 = hi ? 0.f : U[0], x1 = hi ? 0.f : U[1], x2 = hi ? 0.f : U[2], x3 = hi ? 0.f : U[3];
          off[3] = x3; off[2] = st2 + su2 + x2; off[1] = st1 + su1 + x1; off[0] = st0 + su0 + x0;
          const float total = st0 + T[0] + su0 + U[0];
#pragma unroll
          for (int r = 0; r < 16; ++r) acc[r] = __expf(lb[r] + (cum + off[r >> 2] + e[r]));
          cum += total; }
        bf16x8 pf[2];
#pragma unroll
        for (int ks = 0; ks < 2; ++ks) { v4u w; w.x = cvtpk(acc[8 * ks], acc[8 * ks + 1]); w.y = cvtpk(acc[8 * ks + 2], acc[8 * ks + 3]); w.z = cvtpk(acc[8 * ks + 4], acc[8 * ks + 5]); w.w = cvtpk(acc[8 * ks + 6], acc[8 * ks + 7]); pf[ks] = __builtin_bit_cast(bf16x8, w); }
#pragma unroll
        for (int dt = 0; dt < 2; ++dt)
#pragma unroll
            for (int ks = 0; ks < 2; ++ks) { v4u a; a.x = va[dt][ks][0].x; a.y = va[dt][ks][0].y; a.z = va[dt][ks][1].x; a.w = va[dt][ks][1].y; o[dt] = MFMA32(__builtin_bit_cast(bf16x8, a), pf[ks], o[dt]); }
        if (__all(cum < -110.f)) break;
#pragma unroll
        for (int kk = 0; kk < 4; ++kk) kf[kk] = kn[kk];
#pragma unroll
        for (int dt = 0; dt < 2; ++dt)
#pragma unroll
            for (int ks = 0; ks < 2; ++ks) { va[dt][ks][0] = vn[dt][ks][0]; va[dt][ks][1] = vn[dt][ks][1]; }
    }
#undef SB_LOAD
    store_OT(o, 1.0f, stg, ymix + (rowb + q0) * DM + h * 64, lane);
}
__device__ __forceinline__ void mla_task(int bh, int qblk, int lane, const bf16_t* __restrict__ QM, const bf16_t* __restrict__ KVM, const bf16_t* __restrict__ KPE, const bf16_t* __restrict__ VT,
                                         bf16_t* __restrict__ ymix, LAS bf16_t* stg) {
    const int b = bh >> 3, h = bh & 7, l31 = lane & 31, hi = lane >> 5, q0 = qblk * 32, t = q0 + l31;
    const size_t rowb = (size_t)b * SEQ;
    const bf16_t* Qp = QM + (rowb + q0 + l31) * 768 + h * 96 + 8 * hi;
    bf16x8 qf[6];
#pragma unroll
    for (int kk = 0; kk < 6; ++kk) qf[kk] = *(const bf16x8*)(Qp + 16 * kk);
    const bf16_t* Kn = KVM + (rowb + l31) * 1024 + h * 128 + 8 * hi;
    const bf16_t* Kr = KPE + (rowb + l31) * 32 + 8 * hi;
    const bf16_t* Vp = VT + ((size_t)bh * 64 + l31) * SEQ + 4 * hi;
    const float sc2 = 0.10206207261596577f * 1.4426950408889634f;
    f32x16 o[2];
#pragma unroll
    for (int r = 0; r < 16; ++r) { o[0][r] = 0.f; o[1][r] = 0.f; }
    float mrun = -1e30f, lsum = 0.f;
    bf16x8 kf[6]; u32x2 va[2][2][2];
#define ML_LOAD(S0, KF, VA) do { _Pragma("unroll") for (int kk = 0; kk < 4; ++kk) KF[kk] = *(const bf16x8*)(Kn + (size_t)(S0) * 1024 + 16 * kk); \
        _Pragma("unroll") for (int kk = 0; kk < 2; ++kk) KF[4 + kk] = *(const bf16x8*)(Kr + (size_t)(S0) * 32 + 16 * kk); \
        _Pragma("unroll") for (int dt = 0; dt < 2; ++dt) _Pragma("unroll") for (int ks = 0; ks < 2; ++ks) { VA[dt][ks][0] = *(const u32x2*)(Vp + (size_t)dt * 32 * SEQ + (S0) + 16 * ks); VA[dt][ks][1] = *(const u32x2*)(Vp + (size_t)dt * 32 * SEQ + (S0) + 16 * ks + 8); } } while (0)
    ML_LOAD(0, kf, va);
    for (int s0 = 0; s0 <= q0; s0 += 32) {
        bf16x8 kn[6]; u32x2 vn[2][2][2];
        const int sn = (s0 + 32 <= q0) ? s0 + 32 : s0;
        ML_LOAD(sn, kn, vn);
        f32x16 acc;
#pragma unroll
        for (int r = 0; r < 16; ++r) acc[r] = 0.f;
#pragma unroll
        for (int kk = 0; kk < 6; ++kk) acc = MFMA32(kf[kk], qf[kk], acc);
        const bool diag = (s0 == q0);
        float tmax = -1e30f;
#pragma unroll
        for (int r = 0; r < 16; ++r) { float z = acc[r] * sc2; if (diag && (s0 + crow(r, hi)) > t) z = -1e30f; acc[r] = z; tmax = fmaxf(tmax, z); }
        tmax = fmaxf(tmax, __shfl_xor(tmax, 32));
        const float mn = fmaxf(mrun, tmax), alpha = exp2f(mrun - mn); mrun = mn;
        float ps = 0.f;
#pragma unroll
        for (int r = 0; r < 16; ++r) { acc[r] = exp2f(acc[r] - mn); ps += acc[r]; }
        lsum = lsum * alpha + ps;
#pragma unroll
        for (int r = 0; r < 16; ++r) { o[0][r] *= alpha; o[1][r] *= alpha; }
        bf16x8 pf[2];
#pragma unroll
        for (int ks = 0; ks < 2; ++ks) { v4u w; w.x = cvtpk(acc[8 * ks], acc[8 * ks + 1]); w.y = cvtpk(acc[8 * ks + 2], acc[8 * ks + 3]); w.z = cvtpk(acc[8 * ks + 4], acc[8 * ks + 5]); w.w = cvtpk(acc[8 * ks + 6], acc[8 * ks + 7]); pf[ks] = __builtin_bit_cast(bf16x8, w); }
#pragma unroll
        for (int dt = 0; dt < 2; ++dt)
#pragma unroll
            for (int ks = 0; ks < 2; ++ks) { v4u a; a.x = va[dt][ks][0].x; a.y = va[dt][ks][0].y; a.z = va[dt][ks][1].x; a.w = va[dt][ks][1].y; o[dt] = MFMA32(__builtin_bit_cast(bf16x8, a), pf[ks], o[dt]); }
#pragma unroll
        for (int kk = 0; kk < 6; ++kk) kf[kk] = kn[kk];
#pragma unroll
        for (int dt = 0; dt < 2; ++dt)
#pragma unroll
            for (int ks = 0; ks < 2; ++ks) { va[dt][ks][0] = vn[dt][ks][0]; va[dt][ks][1] = vn[dt][ks][1]; }
    }
#undef ML_LOAD
    lsum += __shfl_xor(lsum, 32);
    store_OT(o, 1.0f / lsum, stg, ymix + (rowb + q0) * DM + 512 + h * 64, lane);
}


constexpr int RW_RAWW = 0, RW_RAWA = 2048, RW_RS = 4096, RW_KS = 6144, RW_VS = 8192;
constexpr int RW_CH0 = 10240, RW_CHSZ = 11328;
constexpr int RW_YB = RW_CH0 + 2 * RW_CHSZ;
constexpr int RW_MIX = RW_YB + 1024;
static_assert((RW_MIX + 256) * 4 <= 146432, "rwkv LDS map");
template <int CTRL> __device__ __forceinline__ float dpp_mov(float x) { return __builtin_bit_cast(float, __builtin_amdgcn_update_dpp(0, __builtin_bit_cast(int, x), CTRL, 0xF, 0xF, true)); }
__device__ __forceinline__ float rowsum16(float x) { x += dpp_mov<0x128>(x); x += dpp_mov<0x124>(x); x += dpp_mov<0x122>(x); x += dpp_mov<0x121>(x); return x; }
__device__ __forceinline__ float bflo(unsigned u) { return __builtin_bit_cast(float, u << 16); }
__device__ __forceinline__ float bfhi(unsigned u) { return __builtin_bit_cast(float, u & 0xffff0000u); }
__device__ __forceinline__ float tanh_fast(float x) { return 1.f - 2.f / (1.f + __expf(2.f * x)); }
__device__ __forceinline__ float sigmoid_fast(float x) { return 1.f / (1.f + __expf(-x)); }

__device__ __forceinline__ void rwkv_phase(LAS float* sm, int tid, int lane, int wave, int blk, const bf16_t* __restrict__ proj, const float* __restrict__ mix, const float* __restrict__ w0, const float* __restrict__ a0,
                                           const float* __restrict__ k_k, const float* __restrict__ k_a, const float* __restrict__ r_k, const bf16_t* __restrict__ W2T, const bf16_t* __restrict__ A2T, const bf16_t* __restrict__ G2T,
                                           float* __restrict__ yraw, bf16_t* __restrict__ gout, float* __restrict__ bonus_out) {
    const int chain = blk >> 1, half = blk & 1, b = chain >> 3, h = chain & 7, l31 = lane & 31, hi = lane >> 5;
    const size_t rowb = (size_t)b * SEQ;
    if (tid < 256) sm[RW_MIX + tid] = mix[1536 + tid];
    const int cB = h * 64 + lane;
    const float w0c = w0[cB], a0c = a0[cB], kkc = k_k[cB], kac = k_a[cB], rkc = r_k[cB];
    float mixv[8];
    { const int idx = (wave >= 5) ? wave - 5 : 0; const int ch8 = lane & 7;
#pragma unroll
      for (int j = 0; j < 8; ++j) mixv[j] = mix[512 * idx + h * 64 + ch8 * 8 + j]; }
    __syncthreads();
    float S0 = 0.f, S1 = 0.f, S2 = 0.f, S3 = 0.f;
    const int iloc = 4 * wave + (lane >> 4), jseg = lane & 15;
    v4u ld[16];
#define RW_ISSUE(T0) do { const int t0_ = (T0); \
        if (wave < 4) { const int colb = 1536 + 64 * (wave >> 1) + 8 * hi; const size_t r_ = rowb + t0_ + l31; \
            _Pragma("unroll") for (int kk = 0; kk < 4; ++kk) { ld[kk] = *(const v4u*)(proj + r_ * L0P + colb + 16 * kk); ld[4 + kk] = (t0_ + l31 == 0) ? (v4u){0u, 0u, 0u, 0u} : *(const v4u*)(proj + (r_ - 1) * L0P + colb + 16 * kk); } } \
        else if (wave == 4) { const int colb = 1664 + 8 * hi; const size_t r_ = rowb + t0_ + l31; \
            _Pragma("unroll") for (int kk = 0; kk < 8; ++kk) { ld[kk] = *(const v4u*)(proj + r_ * L0P + colb + 16 * kk); ld[8 + kk] = (t0_ + l31 == 0) ? (v4u){0u, 0u, 0u, 0u} : *(const v4u*)(proj + (r_ - 1) * L0P + colb + 16 * kk); } } \
        else { const int colb = 512 * (wave - 5) + h * 64 + 8 * (lane & 7); \
            _Pragma("unroll") for (int i = 0; i < 4; ++i) { const int tl = i * 8 + (lane >> 3); const size_t r_ = rowb + t0_ + tl; \
                ld[i] = *(const v4u*)(proj + r_ * L0P + colb); ld[4 + i] = (t0_ + tl == 0) ? (v4u){0u, 0u, 0u, 0u} : *(const v4u*)(proj + (r_ - 1) * L0P + colb); } } } while (0)
#define RW_SHIFT8(CUR, PRV, MIXP, OUT) do { const unsigned cu_[4] = {(CUR).x, (CUR).y, (CUR).z, (CUR).w}, pu_[4] = {(PRV).x, (PRV).y, (PRV).z, (PRV).w}; \
        _Pragma("unroll") for (int q = 0; q < 4; ++q) { const float c0 = bflo(cu_[q]), c1 = bfhi(cu_[q]), p0 = bflo(pu_[q]), p1 = bfhi(pu_[q]); \
            OUT[2 * q] = c0 + (p0 - c0) * (MIXP)[2 * q]; OUT[2 * q + 1] = c1 + (p1 - c1) * (MIXP)[2 * q + 1]; } } while (0)
#define RW_PREP(T0, NB) do { const int t0_ = (T0); LAS float* CHn = sm + RW_CH0 + (NB) * RW_CHSZ; \
        if (wave < 4) { const int lora = wave >> 1, jh = wave & 1; const bf16_t* WT = lora ? A2T : W2T; f32x16 acc; \
            _Pragma("unroll") for (int r = 0; r < 16; ++r) acc[r] = 0.f; \
            _Pragma("unroll") for (int kk = 0; kk < 4; ++kk) { float mx_[8], s_[8]; \
                { const f32x4 m0 = *(const LAS f32x4*)(sm + RW_MIX + lora * 64 + 16 * kk + 8 * hi), m1 = *(const LAS f32x4*)(sm + RW_MIX + lora * 64 + 16 * kk + 8 * hi + 4); \
                  mx_[0] = m0[0]; mx_[1] = m0[1]; mx_[2] = m0[2]; mx_[3] = m0[3]; mx_[4] = m1[0]; mx_[5] = m1[1]; mx_[6] = m1[2]; mx_[7] = m1[3]; } \
                RW_SHIFT8(ld[kk], ld[4 + kk], mx_, s_); \
                if (lora == 0) { _Pragma("unroll") for (int j = 0; j < 8; ++j) s_[j] = tanh_fast(s_[j]); } \
                v4u aw; aw.x = cvtpk(s_[0], s_[1]); aw.y = cvtpk(s_[2], s_[3]); aw.z = cvtpk(s_[4], s_[5]); aw.w = cvtpk(s_[6], s_[7]); \
                const bf16x8 bfr = *(const bf16x8*)(WT + (size_t)(h * 64 + jh * 32 + l31) * 64 + 16 * kk + 8 * hi); \
                acc = MFMA32(__builtin_bit_cast(bf16x8, aw), bfr, acc); } \
            LAS float* dst = sm + (lora ? RW_RAWA : RW_RAWW) + jh * 32 + l31; \
            _Pragma("unroll") for (int r = 0; r < 16; ++r) dst[crow(r, hi) * 64] = acc[r]; } \
        else if (wave == 4) { f32x16 acc; \
            _Pragma("unroll") for (int r = 0; r < 16; ++r) acc[r] = 0.f; \
            _Pragma("unroll") for (int kk = 0; kk < 8; ++kk) { float mx_[8], s_[8]; \
                { const f32x4 m0 = *(const LAS f32x4*)(sm + RW_MIX + 128 + 16 * kk + 8 * hi), m1 = *(const LAS f32x4*)(sm + RW_MIX + 128 + 16 * kk + 8 * hi + 4); \
                  mx_[0] = m0[0]; mx_[1] = m0[1]; mx_[2] = m0[2]; mx_[3] = m0[3]; mx_[4] = m1[0]; mx_[5] = m1[1]; mx_[6] = m1[2]; mx_[7] = m1[3]; } \
                RW_SHIFT8(ld[kk], ld[8 + kk], mx_, s_); \
                _Pragma("unroll") for (int j = 0; j < 8; ++j) s_[j] = sigmoid_fast(s_[j]); \
                v4u aw; aw.x = cvtpk(s_[0], s_[1]); aw.y = cvtpk(s_[2], s_[3]); aw.z = cvtpk(s_[4], s_[5]); aw.w = cvtpk(s_[6], s_[7]); \
                const bf16x8 bfr = *(const bf16x8*)(G2T + (size_t)(h * 64 + half * 32 + l31) * 128 + 16 * kk + 8 * hi); \
                acc = MFMA32(__builtin_bit_cast(bf16x8, aw), bfr, acc); } \
            bf16_t* gd = gout + (rowb + t0_) * 512 + h * 64 + half * 32 + l31; \
            _Pragma("unroll") for (int r = 0; r < 16; ++r) gd[(size_t)crow(r, hi) * 512] = (bf16_t)f2bf(acc[r]); } \
        else { LAS float* dst = sm + RW_RS + (wave - 5) * 2048 + (lane & 7) * 8; \
            _Pragma("unroll") for (int i = 0; i < 4; ++i) { const int tl = i * 8 + (lane >> 3); float s_[8]; RW_SHIFT8(ld[i], ld[4 + i], mixv, s_); \
                *(LAS f32x4*)(dst + tl * 64) = (f32x4){s_[0], s_[1], s_[2], s_[3]}; *(LAS f32x4*)(dst + tl * 64 + 4) = (f32x4){s_[4], s_[5], s_[6], s_[7]}; } } \
        __syncthreads(); \
        _Pragma("unroll") for (int tt = 0; tt < 4; ++tt) { const int t = 4 * wave + tt; \
            const float wraw = sm[RW_RAWW + t * 64 + lane], araw = sm[RW_RAWA + t * 64 + lane], r_ = sm[RW_RS + t * 64 + lane], k_ = sm[RW_KS + t * 64 + lane], v_ = sm[RW_VS + t * 64 + lane]; \
            const float wsum = w0c + wraw; const float logw = -softplus_fast(-wsum) - 0.5f; const float dec = __expf(-__expf(logw)); \
            const float a_ = sigmoid_fast(a0c + araw); \
            float kkv = k_ * kkc; const float nrm = sqrtf(wave_sum(kkv * kkv)); kkv = kkv / fmaxf(nrm, 1e-12f); \
            const float k2 = k_ * (1.f + (a_ - 1.f) * kac); const float bv = kkv * a_; \
            const float br = wave_sum(bv * r_), kr = wave_sum(k2 * r_), bon = wave_sum(r_ * k2 * rkc); \
            CHn[t * 64 + lane] = dec; CHn[2048 + t * 64 + lane] = k2; CHn[4096 + t * 64 + lane] = -kkv; CHn[6144 + t * 64 + lane] = bv; CHn[8192 + t * 64 + lane] = dec * r_; \
            if ((lane >> 5) == half) CHn[10240 + t * 32 + (lane & 31)] = v_; \
            if (lane == 0) { CHn[11264 + 2 * t] = br; CHn[11264 + 2 * t + 1] = kr; if (half == 0) bonus_out[(rowb + t0_ + t) * 8 + h] = bon; } } \
        __syncthreads(); } while (0)

    RW_ISSUE(0);
    RW_PREP(0, 0);
    for (int ch = 0; ch < SEQ / 32; ++ch) {
        const int t0 = ch * 32;
        if (ch + 1 < SEQ / 32) RW_ISSUE(t0 + 32);
        const LAS float* CHb = sm + RW_CH0 + (ch & 1) * RW_CHSZ;
#pragma unroll 4
        for (int t = 0; t < 32; ++t) {
            const f32x4 a4 = *(const LAS f32x4*)(CHb + 4096 + t * 64 + 4 * jseg), wr4 = *(const LAS f32x4*)(CHb + 8192 + t * 64 + 4 * jseg);
            const f32x4 w4 = *(const LAS f32x4*)(CHb + t * 64 + 4 * jseg), b4 = *(const LAS f32x4*)(CHb + 6144 + t * 64 + 4 * jseg), k4 = *(const LAS f32x4*)(CHb + 2048 + t * 64 + 4 * jseg);
            const float v = CHb[10240 + t * 32 + iloc]; const float br = CHb[11264 + 2 * t], kr = CHb[11264 + 2 * t + 1];
            float d1 = (S0 * a4[0] + S1 * a4[1]) + (S2 * a4[2] + S3 * a4[3]);
            float d2 = (S0 * wr4[0] + S1 * wr4[1]) + (S2 * wr4[2] + S3 * wr4[3]);
            d1 = rowsum16(d1); d2 = rowsum16(d2);
            const float y = d2 + d1 * br + v * kr;
            S0 = S0 * w4[0] + (d1 * b4[0] + v * k4[0]); S1 = S1 * w4[1] + (d1 * b4[1] + v * k4[1]);
            S2 = S2 * w4[2] + (d1 * b4[2] + v * k4[2]); S3 = S3 * w4[3] + (d1 * b4[3] + v * k4[3]);
            if (jseg == 0) sm[RW_YB + t * 32 + iloc] = y;
        }
        WSYNC();
        if (lane < 32) { const f32x4 yv = *(const LAS f32x4*)(sm + RW_YB + lane * 32 + 4 * wave); *(f32x4*)(yraw + (rowb + t0 + lane) * 512 + h * 64 + half * 32 + 4 * wave) = yv; }
        if (ch + 1 < SEQ / 32) RW_PREP(t0 + 32, (ch + 1) & 1);
    }
#undef RW_ISSUE
#undef RW_PREP
#undef RW_SHIFT8
}
__device__ __forceinline__ void rwkv_post_all(const float* __restrict__ yraw, const bf16_t* __restrict__ proj, const float* __restrict__ mix, const float* __restrict__ bonus, const bf16_t* __restrict__ gbuf,
                                              const float* __restrict__ ln_g, const float* __restrict__ ln_b, bf16_t* __restrict__ ymix, int gw, int NGW, int lane) {
    for (int task = gw; task < M * 8; task += NGW) {
        const int m = task >> 3, h = task & 7, c = h * 64 + lane;
        const float y = yraw[(size_t)m * 512 + c];
        const float mu = wave_sum(y) * (1.f / 64.f), d = y - mu, var = wave_sum(d * d) * (1.f / 64.f);
        const float yn = d * (1.0f / sqrtf(var + 64e-5f)) * ln_g[c] + ln_b[c];
        const float cv = bf2f(proj[(size_t)m * L0P + 1024 + c]); const float pv = (m & (SEQ - 1)) ? bf2f(proj[(size_t)(m - 1) * L0P + 1024 + c]) : 0.f;
        const float v_s = cv + (pv - cv) * mix[1024 + c];
        const float o = (yn + bonus[(size_t)m * 8 + h] * v_s) * bf2f(gbuf[(size_t)m * 512 + c]);
        ymix[(size_t)m * DM + c] = (bf16_t)f2bf(o);
    }
}


__device__ __forceinline__ void ssd_conv_tile(int it, int lane, LAS bf16_t* scr, const bf16_t* __restrict__ proj, const float* __restrict__ cw, const float* __restrict__ cb,
                                              bf16_t* __restrict__ xbc, bf16_t* __restrict__ xst, bf16_t* __restrict__ bt) {
    const int tt = it >> 4, ct = it & 15, m0 = tt * 64, b = m0 >> 11, t0 = m0 & (SEQ - 1), c = ct * 64 + lane;
    const float w0 = cw[c], w1 = cw[1024 + c], w2 = cw[2048 + c], w3 = cw[3072 + c], bias = cb[c];
    const bf16_t* src = proj + (size_t)m0 * L0P + 2304 + c;
    float u3 = 0.f, u2 = 0.f, u1 = 0.f;
    if (t0 > 0) { u3 = bf2f(src[-3 * L0P]); u2 = bf2f(src[-2 * L0P]); u1 = bf2f(src[-1 * L0P]); }
#pragma unroll 8
    for (int t = 0; t < 64; ++t) {
        const float u = bf2f(src[(size_t)t * L0P]);
        const float y = bias + w0 * u3 + w1 * u2 + w2 * u1 + w3 * u;
        const bf16_t o = (bf16_t)f2bf(y / (1.f + __expf(-y)));
        xbc[(size_t)(m0 + t) * 1024 + c] = o;
        scr[t * STG_PITCH + lane] = o;
        u3 = u2; u2 = u1; u1 = u;
    }
    WSYNC();
    if (ct < 12) {
        bf16_t* dst = (ct < 8) ? xst + ((size_t)(b * 8 + ct) * 64) * SEQ + t0 : bt + ((size_t)(b * 2 + ((ct - 8) >> 1)) * 128 + ((ct - 8) & 1) * 64) * SEQ + t0;
#pragma unroll
        for (int i = 0; i < 8; ++i) { const int d = i * 8 + (lane >> 3), tc = lane & 7; const LAS bf16_t* p = scr + (tc * 8) * STG_PITCH + d;
            v4u o; o.x = (unsigned)p[0] | ((unsigned)p[STG_PITCH] << 16); o.y = (unsigned)p[2 * STG_PITCH] | ((unsigned)p[3 * STG_PITCH] << 16);
            o.z = (unsigned)p[4 * STG_PITCH] | ((unsigned)p[5 * STG_PITCH] << 16); o.w = (unsigned)p[6 * STG_PITCH] | ((unsigned)p[7 * STG_PITCH] << 16);
            *(v4u*)(dst + (size_t)d * SEQ + tc * 8) = o; }
    }
    WSYNC();
}
__device__ __forceinline__ void scan128(float& x0, float& x1, int lane) {
#pragma unroll
    for (int o = 1; o < 64; o <<= 1) { const float t0 = __shfl_up(x0, o), t1 = __shfl_up(x1, o); if (lane >= o) { x0 += t0; x1 += t1; } }
    x1 += __shfl(x0, 63);
}
__device__ __forceinline__ void ssd_s1_unit(int unit, int lane, LAS float* tab, const bf16_t* __restrict__ xst, const bf16_t* __restrict__ bt, const float* __restrict__ dt, const float* __restrict__ a_log,
                                            float* __restrict__ sloc, float* __restrict__ asum) {
    const int h = unit & 7, c = (unit >> 3) & 15, b = unit >> 7, g = h >> 2, l0 = c * 128, l31 = lane & 31, hi = lane >> 5;
    const size_t m0 = (size_t)b * SEQ + l0;
    const float A = -expf(a_log[h]);
    const float d0 = dt[(m0 + lane) * 8 + h], d1 = dt[(m0 + 64 + lane) * 8 + h];
    float ac0 = d0 * A, ac1 = d1 * A;
    scan128(ac0, ac1, lane);
    const float aend = __shfl(ac1, 63);
    tab[lane] = __expf(aend - ac0) * d0; tab[64 + lane] = __expf(aend - ac1) * d1;
    if (lane == 0) asum[unit] = aend;
    WSYNC();
    f32x16 acc[2][4];
#pragma unroll
    for (int pt = 0; pt < 2; ++pt)
#pragma unroll
        for (int nt = 0; nt < 4; ++nt)
#pragma unroll
            for (int r = 0; r < 16; ++r) acc[pt][nt][r] = 0.f;
    const bf16_t* Xp = xst + ((size_t)(b * 8 + h) * 64 + l31) * SEQ + l0 + 8 * hi;
    const bf16_t* Bp = bt + ((size_t)(b * 2 + g) * 128 + l31) * SEQ + l0 + 8 * hi;
#pragma unroll 2
    for (int kk = 0; kk < 8; ++kk) {
        const f32x4 wa = *(const LAS f32x4*)(tab + 16 * kk + 8 * hi), wb = *(const LAS f32x4*)(tab + 16 * kk + 8 * hi + 4);
        bf16x8 af[2], bfr[4];
#pragma unroll
        for (int pt = 0; pt < 2; ++pt) { const v4u raw = *(const v4u*)(Xp + (size_t)pt * 32 * SEQ + 16 * kk);
            v4u w; w.x = cvtpk(bflo(raw.x) * wa[0], bfhi(raw.x) * wa[1]); w.y = cvtpk(bflo(raw.y) * wa[2], bfhi(raw.y) * wa[3]);
            w.z = cvtpk(bflo(raw.z) * wb[0], bfhi(raw.z) * wb[1]); w.w = cvtpk(bflo(raw.w) * wb[2], bfhi(raw.w) * wb[3]); af[pt] = __builtin_bit_cast(bf16x8, w); }
#pragma unroll
        for (int nt = 0; nt < 4; ++nt) bfr[nt] = *(const bf16x8*)(Bp + (size_t)nt * 32 * SEQ + 16 * kk);
#pragma unroll
        for (int pt = 0; pt < 2; ++pt)
#pragma unroll
            for (int nt = 0; nt < 4; ++nt) acc[pt][nt] = MFMA32(af[pt], bfr[nt], acc[pt][nt]);
    }
    float* dst = sloc + (size_t)unit * 8192 + l31;
#pragma unroll
    for (int pt = 0; pt < 2; ++pt)
#pragma unroll
        for (int nt = 0; nt < 4; ++nt)
#pragma unroll
            for (int r = 0; r < 16; ++r) dst[(32 * pt + crow(r, hi)) * 128 + 32 * nt] = acc[pt][nt][r];
    WSYNC();
}
__device__ __forceinline__ void ssd_s2_all(const float* __restrict__ sloc, const float* __restrict__ asum, bf16_t* __restrict__ stb, int gtid, int NT) {
    for (int i = gtid; i < 128 * 2048; i += NT) {
        const int bh = i >> 11, e4 = i & 2047, b = bh >> 3, h = bh & 7;
        f32x4 run = {0.f, 0.f, 0.f, 0.f};
#pragma unroll 4
        for (int c = 0; c < 16; ++c) { const int unit = (b * 16 + c) * 8 + h; const f32x4 tmp = *(const f32x4*)(sloc + (size_t)unit * 8192 + e4 * 4);
            uint2 w; w.x = cvtpk(run[0], run[1]); w.y = cvtpk(run[2], run[3]); *(uint2*)(stb + (size_t)unit * 8192 + e4 * 4) = w;
            run = run * __expf(asum[unit]) + tmp; }
    }
}
__device__ __forceinline__ void ssd_s3_unit(int unit, int lane, LAS float* tab, const bf16_t* __restrict__ xbc, const bf16_t* __restrict__ xst, const bf16_t* __restrict__ stb, const float* __restrict__ dt,
                                            const float* __restrict__ a_log, const float* __restrict__ dsk, bf16_t* __restrict__ yssm) {
    const int h = unit & 7, c = (unit >> 3) & 15, b = unit >> 7, g = h >> 2, l0 = c * 128, l31 = lane & 31, hi = lane >> 5;
    const size_t m0 = (size_t)b * SEQ + l0;
    const float A = -expf(a_log[h]), D = dsk[h];
    const float d0 = dt[(m0 + lane) * 8 + h], d1 = dt[(m0 + 64 + lane) * 8 + h];
    float ac0 = d0 * A, ac1 = d1 * A;
    scan128(ac0, ac1, lane);
    tab[lane] = ac0; tab[64 + lane] = ac1; tab[128 + lane] = d0; tab[192 + lane] = d1;
    WSYNC();
    const bf16_t* Cp = xbc + (m0 + l31) * 1024 + 768 + g * 128 + 8 * hi;
    const bf16_t* Sp = stb + (size_t)unit * 8192 + l31 * 128 + 8 * hi;
    const bf16_t* Bp = xbc + (m0 + l31) * 1024 + 512 + g * 128 + 8 * hi;
    const bf16_t* Xp = xst + ((size_t)(b * 8 + h) * 64 + l31) * SEQ + l0 + 4 * hi;
    LAS float* tr = tab + 256;
    const int row = lane >> 1, p0 = (lane & 1) * 16;
#pragma unroll 1
    for (int lt = 0; lt < 4; ++lt) {
        f32x16 y[2];
#pragma unroll
        for (int r = 0; r < 16; ++r) { y[0][r] = 0.f; y[1][r] = 0.f; }
        const float acl = tab[32 * lt + l31];
#pragma unroll 4
        for (int kk = 0; kk < 8; ++kk) {
            const bf16x8 cf = *(const bf16x8*)(Cp + (size_t)lt * 32 * 1024 + 16 * kk);
            const bf16x8 s0 = *(const bf16x8*)(Sp + 16 * kk), s1 = *(const bf16x8*)(Sp + 32 * 128 + 16 * kk);
            y[0] = MFMA32(s0, cf, y[0]); y[1] = MFMA32(s1, cf, y[1]);
        }
        { const float el = __expf(acl);
#pragma unroll
          for (int r = 0; r < 16; ++r) { y[0][r] *= el; y[1][r] *= el; } }
#pragma unroll 1
        for (int st = 0; st <= lt; ++st) {
            f32x16 cbt;
#pragma unroll
            for (int r = 0; r < 16; ++r) cbt[r] = 0.f;
#pragma unroll 4
            for (int kk = 0; kk < 8; ++kk) { const bf16x8 bf_ = *(const bf16x8*)(Bp + (size_t)st * 32 * 1024 + 16 * kk), cf_ = *(const bf16x8*)(Cp + (size_t)lt * 32 * 1024 + 16 * kk); cbt = MFMA32(bf_, cf_, cbt); }
#pragma unroll
            for (int r = 0; r < 16; ++r) { const int sl = 32 * st + crow(r, hi); const float acs = tab[sl], dts = tab[128 + sl];
                float v = cbt[r] * __expf(acl - acs) * dts; if (st == lt && crow(r, hi) > l31) v = 0.f; cbt[r] = v; }
            bf16x8 pf[2];
#pragma unroll
            for (int ks = 0; ks < 2; ++ks) { v4u w; w.x = cvtpk(cbt[8 * ks], cbt[8 * ks + 1]); w.y = cvtpk(cbt[8 * ks + 2], cbt[8 * ks + 3]); w.z = cvtpk(cbt[8 * ks + 4], cbt[8 * ks + 5]); w.w = cvtpk(cbt[8 * ks + 6], cbt[8 * ks + 7]); pf[ks] = __builtin_bit_cast(bf16x8, w); }
#pragma unroll
            for (int pt = 0; pt < 2; ++pt)
#pragma unroll
                for (int ks = 0; ks < 2; ++ks) { const bf16_t* xp = Xp + (size_t)pt * 32 * SEQ + st * 32 + 16 * ks; const u32x2 x0 = *(const u32x2*)xp, x1 = *(const u32x2*)(xp + 8);
                    v4u a; a.x = x0.x; a.y = x0.y; a.z = x1.x; a.w = x1.y; y[pt] = MFMA32(__builtin_bit_cast(bf16x8, a), pf[ks], y[pt]); }
        }
#pragma unroll
        for (int pt = 0; pt < 2; ++pt) {
#pragma unroll
            for (int r = 0; r < 16; ++r) tr[l31 * 33 + crow(r, hi)] = y[pt][r];
            WSYNC();
            const size_t m = m0 + 32 * lt + row;
            const v4u xa = *(const v4u*)(xbc + m * 1024 + h * 64 + 32 * pt + p0), xb = *(const v4u*)(xbc + m * 1024 + h * 64 + 32 * pt + p0 + 8);
            const unsigned xu[8] = {xa.x, xa.y, xa.z, xa.w, xb.x, xb.y, xb.z, xb.w};
            unsigned ow[8];
#pragma unroll
            for (int q = 0; q < 8; ++q) { const float v0 = tr[row * 33 + p0 + 2 * q] + D * bflo(xu[q]), v1 = tr[row * 33 + p0 + 2 * q + 1] + D * bfhi(xu[q]); ow[q] = cvtpk(v0, v1); }
            bf16_t* dst = yssm + m * 512 + h * 64 + 32 * pt + p0;
            *(v4u*)dst = (v4u){ow[0], ow[1], ow[2], ow[3]}; *(v4u*)(dst + 8) = (v4u){ow[4], ow[5], ow[6], ow[7]};
            WSYNC();
        }
    }
}

struct Args { const float* in[43]; float* out; unsigned char* ws; };
#define GEMM_PHASE(EPI, Aptr, LDA, Bptr, LDB, NN, KK, ...) do { pg8::Gemm g_{(Aptr), (Bptr), M, (NN), (KK), (LDA), (LDB)}; pg8::StaticOrder S_; S_.init(M, (NN), G, (int)blockIdx.x); \
        pg8::EPI E_{__VA_ARGS__}; pg8::gemm_phase<pg8::EPI, pg8::StaticOrder, true, true>(lds3, g_, S_, E_); } while (0)

__global__ void __launch_bounds__(NWAVES * 64, 2) fwd_mega(Args args) {
    extern __shared__ __attribute__((aligned(16))) unsigned char lds[];
    LAS unsigned char* lds3 = (LAS unsigned char*)lds;
    volatile LAS unsigned* MISC = (volatile LAS unsigned*)(lds3 + MISC_OFF);
    const int G = gridDim.x, NGW = G * NWAVES, NT = G * NWAVES * 64;
#define PHASE_IDS() int tid = threadIdx.x; asm volatile("" : "+v"(tid)); const int lane = tid & 63, wave = __builtin_amdgcn_readfirstlane(tid >> 6); const int gw = blockIdx.x * NWAVES + wave, gtid = blockIdx.x * (NWAVES * 64) + tid; (void)lane; (void)gw; (void)gtid
    unsigned char* ws = args.ws;
    gu32* ctl = (gu32*)(ws + WS_CTL);
    for (int u = threadIdx.x; u < (LDS_BYTES - LDSCTL_OFF) / 4; u += NWAVES * 64) ((LAS unsigned*)(lds3 + LDSCTL_OFF))[u] = 0u;
    __syncthreads();
    XcdBarrier bar = xcd_barrier_post((unsigned*)(ctl + CW_BAR), MISC + 8);
#define GRID_BAR() xcd_barrier(bar)
#define IN(i) (args.in[i])
    float* out = args.out;
    bf16_t* W0in = (bf16_t*)(ws + WS_W0IN); bf16_t* W0out = (bf16_t*)(ws + WS_W0OUT); bf16_t* Wup0 = (bf16_t*)(ws + WS_WUP0); bf16_t* Wdn0 = (bf16_t*)(ws + WS_WDN0);
    bf16_t* W1in = (bf16_t*)(ws + WS_W1IN); bf16_t* Wuq = (bf16_t*)(ws + WS_WUQ); bf16_t* Wukv = (bf16_t*)(ws + WS_WUKV); bf16_t* W1out = (bf16_t*)(ws + WS_W1OUT);
    bf16_t* Wup1 = (bf16_t*)(ws + WS_WUP1); bf16_t* Wdn1 = (bf16_t*)(ws + WS_WDN1);
    bf16_t* XB = (bf16_t*)(ws + WS_XB); bf16_t* YMIX = (bf16_t*)(ws + WS_YMIX); bf16_t* PROJ0 = (bf16_t*)(ws + WS_BIG);
    float* YRAW = out; bf16_t* YSSM = (bf16_t*)(out + (size_t)M * 512); bf16_t* STB = (bf16_t*)(out + (size_t)M * 768); bf16_t* XST = (bf16_t*)(ws + WS_XST); bf16_t* BT = (bf16_t*)(ws + WS_BT); float* ASUM = (float*)(ws + WS_ASUM); float* SLOC = (float*)(ws + WS_SLOC); float* DT = (float*)(ws + WS_DT); bf16_t* GB = (bf16_t*)(ws + WS_G); float* BONUS = (float*)(ws + WS_BONUS);
    bf16_t* W2T = (bf16_t*)(ws + WS_W2T); bf16_t* A2T = (bf16_t*)(ws + WS_A2T); bf16_t* G2T = (bf16_t*)(ws + WS_G2T); bf16_t* GU = (bf16_t*)(ws + WS_GU);
    bf16_t* PROJ1 = (bf16_t*)(ws + WS_PROJ1); bf16_t* QM = (bf16_t*)(ws + WS_QM); bf16_t* KVM = (bf16_t*)(ws + WS_KVM); bf16_t* KPE = (bf16_t*)(ws + WS_KPE); float* RS = (float*)(ws + WS_RS); bf16_t* VTS = (bf16_t*)(ws + WS_VTS); bf16_t* VTM = (bf16_t*)(ws + WS_VTM);
    const int* pos = (const int*)args.in[1];

    {
        PHASE_IDS();
    {
        LAS float* scr = (LAS float*)(lds3 + wave * 16384);
        transpose_matrix(IN(2), 1024, 3336, W0in, L0P, 1024, scr, gw, NGW, lane, nullptr);
        transpose_matrix(IN(20), 1024, 1024, W0out, 1024, 1024, scr, gw, NGW, lane, nullptr);
        transpose_matrix(IN(23), 1024, 5632, Wup0, 5632, 1024, scr, gw, NGW, lane, nullptr);
        transpose_matrix(IN(26), 2816, 1024, Wdn0, 1024, 2816, scr, gw, NGW, lane, nullptr);
        transpose_matrix(IN(29), 1024, 1952, W1in, L1P, 1024, scr, gw, NGW, lane, nullptr);
        transpose_matrix(IN(31), 256, 768, Wuq, 768, 256, scr, gw, NGW, lane, IN(30));
        transpose_matrix(IN(33), 128, 1024, Wukv, 1024, 256, scr, gw, NGW, lane, IN(32));
        for (int i = gtid; i < 1024 * 16; i += NT) { const int n = i >> 4, c = i & 15; *(v4u*)(Wukv + (size_t)n * 256 + 128 + c * 8) = (v4u){0u, 0u, 0u, 0u}; }
        transpose_matrix(IN(34), 1024, 1024, W1out, 1024, 1024, scr, gw, NGW, lane, nullptr);
        transpose_matrix(IN(37), 1024, 5632, Wup1, 5632, 1024, scr, gw, NGW, lane, nullptr);
        transpose_matrix(IN(40), 2816, 1024, Wdn1, 1024, 2816, scr, gw, NGW, lane, nullptr);
        transpose_matrix(IN(5), 64, 512, W2T, 512, 64, scr, gw, NGW, lane, nullptr);
        transpose_matrix(IN(7), 64, 512, A2T, 512, 64, scr, gw, NGW, lane, nullptr);
        transpose_matrix(IN(8), 128, 512, G2T, 512, 128, scr, gw, NGW, lane, nullptr);
        const float* x = IN(0);
        for (size_t i = (size_t)gtid * 4; i < (size_t)M * DM; i += (size_t)NT * 4) { const f32x4 v = *(const f32x4*)(x + i); uint2 w; w.x = pk2(v[0], v[1]); w.y = pk2(v[2], v[3]); *(uint2*)(XB + i) = w; }
    }
    }
    GRID_BAR();
    {
        PHASE_IDS();
    GEMM_PHASE(EpiBf16S, XB, DM, W0in, 1024, L0P, 1024, PROJ0, nullptr, L0P, 0);
    }
    GRID_BAR();
    {
        PHASE_IDS();
        const int blk = (int)blockIdx.x, m0 = blk * 128;
        {   LAS bf16_t* scr = (LAS bf16_t*)(lds3 + wave * 16384);
#pragma unroll 1
            for (int k = 0; k < 4; ++k) ssd_conv_tile((2 * blk + (k & 1)) * 16 + wave + 8 * (k >> 1), lane, scr, PROJ0, IN(14), IN(15), XB, XST, BT);
            for (int i = tid; i < 1024; i += NWAVES * 64) { const int m = m0 + (i >> 3); DT[(size_t)m * 8 + (i & 7)] = softplusf_(bf2f(PROJ0[(size_t)m * L0P + 3328 + (i & 7)]) + IN(16)[i & 7]); }
        }
        __syncthreads();
        ssd_s1_unit(blk * 8 + wave, lane, (LAS float*)(lds3 + wave * 16384), XST, BT, DT, IN(17), SLOC, ASUM);
    }
    GRID_BAR();
    {
        PHASE_IDS();
        ssd_s2_all(SLOC, ASUM, STB, gtid, NT);
        rwkv_phase((LAS float*)lds3, tid, lane, wave, (int)blockIdx.x, PROJ0, IN(3), IN(4), IN(6), IN(9), IN(10), IN(11), W2T, A2T, G2T, YRAW, GB, BONUS);
    }
    GRID_BAR();
    {
        PHASE_IDS();
        const int blk = (int)blockIdx.x;
        ssd_s3_unit(blk * 8 + wave, lane, (LAS float*)(lds3 + wave * 16384), XB, XST, STB, DT, IN(17), IN(18), YSSM);
        __syncthreads();
        ssm_gate_norm_all(YSSM, PROJ0, IN(19), YMIX, blk * 256 + wave, blk * 256 + 256, lane);
        rwkv_post_all(YRAW, PROJ0, IN(3), BONUS, GB, IN(12), IN(13), YMIX, gw, NGW, lane);
    }
    GRID_BAR();
    {
        PHASE_IDS();
    GEMM_PHASE(EpiResid, YMIX, DM, W0out, 1024, 1024, 1024, IN(0), out, ALPHA, 0);
    }
    GRID_BAR();
    {
        PHASE_IDS();
    ln_rows(out, XB, IN(21), IN(22), gw, NGW, lane);
    }
    GRID_BAR();
    {
        PHASE_IDS();
    GEMM_PHASE(EpiBf16S, XB, DM, Wup0, 1024, 2 * DFF, 1024, GU, nullptr, 2 * DFF, 0);
    }
    GRID_BAR();
    {
        PHASE_IDS();
    ffn_act_all(GU, IN(24), IN(25), gtid, NT);
    }
    GRID_BAR();
    {
        PHASE_IDS();
    GEMM_PHASE(EpiResid, GU + DFF, 2 * DFF, Wdn0, DFF, 1024, DFF, out, out, ALPHA, 0);
    }
    GRID_BAR();
    {
        PHASE_IDS();
    ln_rows(out, XB, IN(27), IN(28), gw, NGW, lane);
    }
    GRID_BAR();
    {
        PHASE_IDS();
    GEMM_PHASE(EpiBf16S, XB, DM, W1in, 1024, L1P, 1024, PROJ1, nullptr, L1P, 0);
    }
    GRID_BAR();
    {
        PHASE_IDS();
    mla_prep_all(PROJ1, pos, RS, KPE, gw, NGW, lane);
    }
    GRID_BAR();
    {
        PHASE_IDS();
    GEMM_PHASE(EpiBf16S, PROJ1 + 1536, L1P, Wuq, 256, 768, 256, QM, RS, 768, 2);
    GEMM_PHASE(EpiBf16S, PROJ1 + 1792, L1P, Wukv, 256, 1024, 256, KVM, RS + 1, 1024, 2);
    }
    GRID_BAR();
    {
        PHASE_IDS();
    rope_q_all(QM, pos, gtid, NT);
    {
        LAS bf16_t* scr = (LAS bf16_t*)(lds3 + wave * 16384);
        for (int it = gw; it < 8192; it += NGW) { const int which = it >> 12, r = it & 4095, bh = r >> 5, tt = r & 31, b = bh >> 3, h = bh & 7;
            if (which == 0) transpose_tile64(PROJ1 + ((size_t)b * SEQ + tt * 64) * L1P + 1024 + h * 64, L1P, VTS + (size_t)bh * 64 * SEQ + tt * 64, SEQ, scr, lane);
            else            transpose_tile64(KVM + ((size_t)b * SEQ + tt * 64) * 1024 + h * 128 + 64, 1024, VTM + (size_t)bh * 64 * SEQ + tt * 64, SEQ, scr, lane); }
    }
    }
    GRID_BAR();
    {
        PHASE_IDS();
    {
        LAS bf16_t* stg = (LAS bf16_t*)(lds3 + wave * 16384);
        for (int g2 = gw; g2 < 2048; g2 += NGW) { const int bh = g2 >> 4, w = g2 & 15;
#pragma unroll 1
            for (int i = 0; i < 4; ++i) { const int qb = (i == 0) ? w : (i == 1) ? 31 - w : (i == 2) ? 32 + w : 63 - w;
                sb_task(bh, qb, lane, PROJ1, VTS, YMIX, stg);
                mla_task(bh, qb, lane, QM, KVM, KPE, VTM, YMIX, stg); } }
    }
    }
    GRID_BAR();
    {
        PHASE_IDS();
    GEMM_PHASE(EpiResid, YMIX, DM, W1out, 1024, 1024, 1024, out, out, ALPHA, 0);
    }
    GRID_BAR();
    {
        PHASE_IDS();
    ln_rows(out, XB, IN(35), IN(36), gw, NGW, lane);
    }
    GRID_BAR();
    {
        PHASE_IDS();
    GEMM_PHASE(EpiBf16S, XB, DM, Wup1, 1024, 2 * DFF, 1024, GU, nullptr, 2 * DFF, 0);
    }
    GRID_BAR();
    {
        PHASE_IDS();
    ffn_act_all(GU, IN(38), IN(39), gtid, NT);
    }
    GRID_BAR();
    {
        PHASE_IDS();
    GEMM_PHASE(EpiResid, GU + DFF, 2 * DFF, Wdn1, DFF, 1024, DFF, out, out, ALPHA, 0);
    }
    GRID_BAR();
    {
        PHASE_IDS();
    ln_rows(out, XB, IN(41), IN(42), gw, NGW, lane);
    }
}

extern "C" void kernel_launch(void* const* d_in, const int* in_sizes, int n_in, void* d_out, int out_size, void* d_ws, size_t ws_size, hipStream_t stream) {
    static int grid = 0;
    if (grid == 0) {
        if (n_in != 43 || ws_size < WS_NEED || out_size != M * DM) { fprintf(stderr, "kernel_launch: unexpected n_in %d / ws %zu / out %d\n", n_in, ws_size, out_size); grid = -1; return; }
        int dev = 0, cus = 0, per_cu = 0;
        if (hipGetDevice(&dev) != hipSuccess || hipDeviceGetAttribute(&cus, hipDeviceAttributeMultiprocessorCount, dev) != hipSuccess) { grid = -1; return; }
        if (hipFuncSetAttribute((const void*)fwd_mega, hipFuncAttributeMaxDynamicSharedMemorySize, LDS_BYTES) != hipSuccess) { fprintf(stderr, "kernel_launch: hipFuncSetAttribute failed\n"); grid = -1; return; }
        if (hipOccupancyMaxActiveBlocksPerMultiprocessor(&per_cu, (const void*)fwd_mega, NWAVES * 64, LDS_BYTES) != hipSuccess || per_cu < 1) fprintf(stderr, "kernel_launch: occupancy query reports %d\n", per_cu);
        (void)hipGetLastError();
        grid = cus;
    }
    if (grid < 0) return;
    (void)hipMemsetAsync((char*)d_ws + WS_CTL, 0, CTL_ZERO_BYTES, stream);
    Args a{};
    for (int i = 0; i < 43; ++i) a.in[i] = (const float*)d_in[i];
    a.out = (float*)d_out; a.ws = (unsigned char*)d_ws;
    hipLaunchKernelGGL(fwd_mega, dim3(grid), dim3(NWAVES * 64), LDS_BYTES, stream, a);
}
```

```cpp
#include <hip/hip_runtime.h>
#include <cstdio>
#include <cstdint>
#include <cmath>
namespace pg8 {
#define PG8_LAS __attribute__((address_space(3)))
typedef unsigned short bf16_t;
typedef short bf16x8 __attribute__((ext_vector_type(8)));
typedef float f32x4 __attribute__((ext_vector_type(4)));
typedef unsigned u32x4 __attribute__((ext_vector_type(4)));
constexpr int BM = 256, BK = 64, HALF = 128, HTB = HALF * BK * 2  , STAGE_BYTES = 8 * HTB, NXCD = 8, WGM = 8;

__host__ __device__ __forceinline__ int lds_byte(int r, int c) { const int st = (r >> 4) * 2 + (c >> 5), rr = r & 15, cc = c & 31, ob = rr * 64 + cc * 2; return st * 1024 + (ob ^ (((ob >> 9) & 1) << 5)); }
__host__ __device__ __forceinline__ void stage_rc(int b, int& R, int& C) { const int st = b / 1024, sb = b % 1024, swz = sb ^ (((sb >> 9) & 1) << 5); R = (st >> 1) * 16 + swz / 64; C = (st & 1) * 32 + (swz % 64) / 2; }
__host__ __device__ __forceinline__ int perm32(int rho) { const int n = rho >> 4, i = rho & 15; return 8 * (i >> 2) + 4 * n + (i & 3); }

struct Unit { int pm, pn; };
struct Gemm { const bf16_t* A; const bf16_t* Bt; int M, N, K, lda, ldb; };

struct StaticOrder {
    int nM, nN, nwg, G, c;
    __host__ __device__ void init(int M, int N, int G_, int c_) { nM = M / BM; nN = N / BM; nwg = nM * nN; G = G_; c = c_; }
    __host__ __device__ bool next(int i, Unit& u) const {
        const long L = (long)i * G + c; if (L >= nwg) return false;
        int wgid = (int)L; { const int q = nwg / NXCD, r = nwg % NXCD, xcd = wgid % NXCD, off = wgid / NXCD; wgid = (xcd < r ? xcd * (q + 1) : r * (q + 1) + (xcd - r) * q) + off; }
        const int nig = WGM * nN, gid = wgid / nig, fm = gid * WGM, gsz = (nM - fm) < WGM ? (nM - fm) : WGM;
        u.pm = fm + ((wgid % nig) % gsz); u.pn = (wgid % nig) / gsz; return true;
    }
    __device__ __forceinline__ void a_ready(const Unit&) const {}
    __device__ __forceinline__ void done(const Unit&) const {}
};


__device__ __forceinline__ unsigned cvt_pk_bf16(float lo, float hi) { unsigned r; asm volatile("v_cvt_pk_bf16_f32 %0, %1, %2" : "=v"(r) : "v"(lo), "v"(hi)); return r; }
struct EpiBf16S {
    static constexpr bool PERM = true, AFTER_DRAIN = false;
    bf16_t* O; const float* rowscale; int ldc; int rs_stride;
    __device__ __forceinline__ void operator()(const f32x4 (&acc)[2][2][4][2], const Unit& u, int wr, int wc, int fr, int fq) const {
        const int row0 = u.pm * BM + wr * 64 + fr, col0 = u.pn * BM + wc * 32 + 8 * fq;
#pragma unroll
        for (int ai = 0; ai < 2; ++ai)
#pragma unroll
            for (int m = 0; m < 4; ++m) { const int row = row0 + ai * HALF + m * 16; const float sc = rowscale ? rowscale[(size_t)row * rs_stride] : 1.f;
                bf16_t* rowp = O + (size_t)row * ldc + col0;
#pragma unroll
                for (int bj = 0; bj < 2; ++bj) { const f32x4 v0 = acc[ai][bj][m][0] * sc, v1 = acc[ai][bj][m][1] * sc;
                    u32x4 w; w.x = cvt_pk_bf16(v0[0], v0[1]); w.y = cvt_pk_bf16(v0[2], v0[3]); w.z = cvt_pk_bf16(v1[0], v1[1]); w.w = cvt_pk_bf16(v1[2], v1[3]);
                    *(u32x4*)(rowp + bj * HALF) = w; } }
    }
};
struct EpiResid {
    static constexpr bool PERM = false, AFTER_DRAIN = false;
    const float* hin; float* hout; float alpha; int pad;
    __device__ __forceinline__ void operator()(const f32x4 (&acc)[2][2][4][2], const Unit& u, int wr, int wc, int fr, int fq) const {
        const int row0 = u.pm * BM + wr * 64 + fr, col0 = u.pn * BM + wc * 32 + 4 * fq;
#pragma unroll
        for (int ai = 0; ai < 2; ++ai)
#pragma unroll
            for (int m = 0; m < 4; ++m) { const size_t off = (size_t)(row0 + ai * HALF + m * 16) * 1024 + col0;
#pragma unroll
                for (int bj = 0; bj < 2; ++bj)
#pragma unroll
                    for (int n = 0; n < 2; ++n) { const size_t i = off + bj * HALF + n * 16; const f32x4 h = *(const f32x4*)(hin + i); *(f32x4*)(hout + i) = h * alpha + acc[ai][bj][m][n]; } }
    }
};
template <class Epi, class Sched, bool ALIGN_EPI = false, bool SP2 = false>
__device__ __forceinline__ void gemm_phase(PG8_LAS unsigned char* lds, const Gemm g, const Sched& S, const Epi& E) {
    const int tid = threadIdx.x, wid = __builtin_amdgcn_readfirstlane(tid >> 6), lane = tid & 63, wr = wid >> 2, wc = wid & 3, fr = lane & 15, fq = lane >> 4;
    const int K = g.K, nt = K / BK;
    unsigned voffA[2], voffB[2];
#pragma unroll
    for (int i = 0; i < 2; ++i) { int R, C; stage_rc(tid * 16 + i * 8192, R, C); const int Rb = Epi::PERM ? ((R & ~31) + perm32(R & 31)) : R;
        voffA[i] = (unsigned)(R * g.lda + C) * 2u; voffB[i] = (unsigned)(Rb * g.ldb + C) * 2u; }
    const size_t kstep = (size_t)(BK * 2);
    const size_t hstepA = (size_t)HALF * g.lda * 2, hstepB = (size_t)HALF * g.ldb * 2;
    const size_t tstepA = 2 * hstepA, tstepB = 2 * hstepB;
    const unsigned ldsw = (unsigned)wid * 1024u;
    const int aoff = lds_byte(wr * 64 + fr, fq * 8), boff = lds_byte(wc * 32 + fr, fq * 8);
#define PG8_SA(b, h) (((b) * 2 + (h)) * HTB)
#define PG8_SB(b, h) ((4 + (b) * 2 + (h)) * HTB)
#define PG8_STAGE(bufoff, gbase, voff) do { _Pragma("unroll") for (int _i = 0; _i < 2; ++_i) \
        __builtin_amdgcn_global_load_lds((const unsigned*)((const char*)(gbase) + (voff)[_i]), (PG8_LAS unsigned*)(lds + (bufoff) + ldsw + _i * 8192), 16, 0, 0); } while (0)
#define PG8_LDA(dst, b, h) do { _Pragma("unroll") for (int m = 0; m < 4; ++m) _Pragma("unroll") for (int k = 0; k < 2; ++k) dst[m][k] = *(const PG8_LAS bf16x8*)(lds + PG8_SA(b, h) + aoff + m * 2048 + k * 1024); } while (0)
#define PG8_LDB(dst, b, h) do { _Pragma("unroll") for (int n = 0; n < 2; ++n) _Pragma("unroll") for (int k = 0; k < 2; ++k) dst[n][k] = *(const PG8_LAS bf16x8*)(lds + PG8_SB(b, h) + boff + n * 2048 + k * 1024); } while (0)
#define PG8_MMA(ai, bj, At, Bt) do { __builtin_amdgcn_s_setprio(1); _Pragma("unroll") for (int m = 0; m < 4; ++m) _Pragma("unroll") for (int n = 0; n < 2; ++n) _Pragma("unroll") for (int k = 0; k < 2; ++k) \
        acc[ai][bj][m][n] = __builtin_amdgcn_mfma_f32_16x16x32_bf16(Bt[n][k], At[m][k], acc[ai][bj][m][n], 0, 0, 0); __builtin_amdgcn_s_setprio(0); } while (0)
#define PG8_WAIT_V(n) asm volatile("s_waitcnt vmcnt(" #n ")" ::: "memory")
#define PG8_WAIT_L(n) asm volatile("s_waitcnt lgkmcnt(" #n ")" ::: "memory")
#define PG8_BAR __builtin_amdgcn_s_barrier()
#define PG8_SCHED __builtin_amdgcn_sched_barrier(0)
    Unit cur, nxt; int ui = 0;
    if (!S.next(0, cur)) return;
    f32x4 acc[2][2][4][2];
#pragma unroll
    for (int a = 0; a < 2; ++a)
#pragma unroll
        for (int b = 0; b < 2; ++b)
#pragma unroll
            for (int m = 0; m < 4; ++m)
#pragma unroll
                for (int n = 0; n < 2; ++n) acc[a][b][m][n] = (f32x4){0.f, 0.f, 0.f, 0.f};
    bf16x8 At[4][2], B0[2][2], B1[2][2];
    const char* cA = (const char*)g.A + (size_t)cur.pm * tstepA; const char* cB = (const char*)g.Bt + (size_t)cur.pn * tstepB;
    S.a_ready(cur);
    if constexpr (SP2) {
        PG8_STAGE(PG8_SB(0, 0), cB, voffB); PG8_STAGE(PG8_SB(0, 1), cB + hstepB, voffB); PG8_STAGE(PG8_SA(0, 0), cA, voffA); PG8_STAGE(PG8_SA(0, 1), cA + hstepA, voffA);
        if (wr == 1) PG8_BAR;
        PG8_WAIT_V(2); PG8_BAR;
        PG8_STAGE(PG8_SB(1, 0), cB + kstep, voffB); PG8_STAGE(PG8_SA(1, 0), cA + kstep, voffA); PG8_STAGE(PG8_SB(1, 1), cB + hstepB + kstep, voffB);
        PG8_WAIT_V(6); PG8_BAR;
    } else {
        PG8_STAGE(PG8_SB(0, 0), cB, voffB); PG8_STAGE(PG8_SA(0, 0), cA, voffA); PG8_STAGE(PG8_SB(0, 1), cB + hstepB, voffB); PG8_STAGE(PG8_SA(0, 1), cA + hstepA, voffA);
        if (wr == 1) PG8_BAR;
        PG8_WAIT_V(4); PG8_BAR;
        PG8_STAGE(PG8_SB(1, 0), cB + kstep, voffB); PG8_STAGE(PG8_SA(1, 0), cA + kstep, voffA); PG8_STAGE(PG8_SB(1, 1), cB + hstepB + kstep, voffB);
        PG8_WAIT_V(6); PG8_BAR;
    }
    for (;;) {
        const bool has_next = S.next(ui + 1, nxt);
        const char* nA = has_next ? (const char*)g.A + (size_t)nxt.pm * tstepA : cA; const char* nB = has_next ? (const char*)g.Bt + (size_t)nxt.pn * tstepB : cB;
        for (int t = 0; t < nt; t += 2) {
            const bool last = (t == nt - 2);
            const char* a1 = cA + (size_t)(t + 1) * kstep;
            const char* a2 = last ? nA : cA + (size_t)(t + 2) * kstep; const char* b2 = last ? nB : cB + (size_t)(t + 2) * kstep;
            const char* a3 = a2 + kstep; const char* b3 = b2 + kstep;
            if (last && has_next) S.a_ready(nxt);
            if constexpr (SP2) {
            PG8_LDB(B0, 0, 0); PG8_LDB(B1, 0, 1); PG8_SCHED; PG8_LDA(At, 0, 0); PG8_STAGE(PG8_SA(1, 1), a1 + hstepA, voffA);
            PG8_WAIT_V(8); PG8_WAIT_L(0); PG8_BAR; PG8_MMA(0, 0, At, B0); PG8_MMA(0, 1, At, B1); PG8_BAR; PG8_SCHED;
            PG8_LDA(At, 0, 1); PG8_STAGE(PG8_SB(0, 0), b2, voffB); PG8_STAGE(PG8_SB(0, 1), b2 + hstepB, voffB); PG8_STAGE(PG8_SA(0, 0), a2, voffA);
            PG8_WAIT_V(8); PG8_WAIT_L(0); PG8_BAR; PG8_MMA(1, 0, At, B0); PG8_MMA(1, 1, At, B1); PG8_BAR; PG8_SCHED;
            PG8_LDB(B0, 1, 0); PG8_LDB(B1, 1, 1); PG8_SCHED; PG8_LDA(At, 1, 0); PG8_STAGE(PG8_SA(0, 1), a2 + hstepA, voffA);
            PG8_WAIT_V(8); PG8_WAIT_L(0); PG8_BAR; PG8_MMA(0, 0, At, B0); PG8_MMA(0, 1, At, B1); PG8_BAR; PG8_SCHED;
            PG8_LDA(At, 1, 1); PG8_STAGE(PG8_SB(1, 0), b3, voffB); PG8_STAGE(PG8_SB(1, 1), b3 + hstepB, voffB); PG8_STAGE(PG8_SA(1, 0), a3, voffA);
            PG8_WAIT_V(8); PG8_WAIT_L(0); PG8_BAR; PG8_MMA(1, 0, At, B0); PG8_MMA(1, 1, At, B1); PG8_BAR; PG8_SCHED;
            } else {
            PG8_LDB(B0, 0, 0); PG8_SCHED; PG8_LDA(At, 0, 0); PG8_STAGE(PG8_SA(1, 1), a1 + hstepA, voffA);
            PG8_WAIT_L(8); PG8_BAR; PG8_WAIT_L(0); PG8_MMA(0, 0, At, B0); PG8_BAR; PG8_SCHED;
            PG8_LDB(B1, 0, 1); PG8_STAGE(PG8_SB(0, 0), b2, voffB);
            PG8_BAR; PG8_WAIT_L(0); PG8_MMA(0, 1, At, B1); PG8_BAR;
            PG8_LDA(At, 0, 1); PG8_STAGE(PG8_SA(0, 0), a2, voffA);
            PG8_BAR; PG8_WAIT_L(0); PG8_MMA(1, 0, At, B0); PG8_BAR; PG8_SCHED;
            PG8_STAGE(PG8_SB(0, 1), b2 + hstepB, voffB);
            PG8_WAIT_V(6); PG8_BAR; PG8_MMA(1, 1, At, B1); PG8_BAR;
            PG8_LDB(B0, 1, 0); PG8_SCHED; PG8_LDA(At, 1, 0); PG8_STAGE(PG8_SA(0, 1), a2 + hstepA, voffA);
            PG8_WAIT_L(8); PG8_BAR; PG8_WAIT_L(0); PG8_MMA(0, 0, At, B0); PG8_BAR; PG8_SCHED;
            PG8_LDB(B1, 1, 1); PG8_STAGE(PG8_SB(1, 0), b3, voffB);
            PG8_BAR; PG8_WAIT_L(0); PG8_MMA(0, 1, At, B1); PG8_BAR;
            PG8_LDA(At, 1, 1); PG8_STAGE(PG8_SA(1, 0), a3, voffA);
            PG8_BAR; PG8_WAIT_L(0); PG8_MMA(1, 0, At, B0); PG8_BAR; PG8_SCHED;
            PG8_STAGE(PG8_SB(1, 1), b3 + hstepB, voffB);
            PG8_WAIT_V(6); PG8_BAR; PG8_MMA(1, 1, At, B1); PG8_BAR;
            }
        }
        if constexpr (ALIGN_EPI) { if (wr == 0) PG8_BAR; }
        if constexpr (!Epi::AFTER_DRAIN) { E(acc, cur, wr, wc, fr, fq); S.done(cur); }
        if (!has_next) break;
#pragma unroll
        for (int a = 0; a < 2; ++a)
#pragma unroll
            for (int b = 0; b < 2; ++b)
#pragma unroll
                for (int m = 0; m < 4; ++m)
#pragma unroll
                    for (int n = 0; n < 2; ++n) acc[a][b][m][n] = (f32x4){0.f, 0.f, 0.f, 0.f};
        cur = nxt; cA = nA; cB = nB; ++ui;
        if constexpr (ALIGN_EPI) { if (wr == 1) PG8_BAR; }
    }
    PG8_WAIT_V(0);
    if constexpr (!ALIGN_EPI) { if (wr == 0) PG8_BAR; }
    PG8_BAR;
    if constexpr (Epi::AFTER_DRAIN) { E.fused(acc, cur, wr, wc, fr, fq, lds, wid, lane); S.done(cur); }
#undef PG8_SA
#undef PG8_SB
#undef PG8_STAGE
#undef PG8_LDA
#undef PG8_LDB
#undef PG8_MMA
#undef PG8_WAIT_V
#undef PG8_WAIT_L
#undef PG8_BAR
#undef PG8_SCHED
}
}
#define GAS __attribute__((address_space(1)))
#define LAS __attribute__((address_space(3)))
typedef unsigned short bf16;
typedef unsigned v4u __attribute__((ext_vector_type(4)));
typedef float f32x4 __attribute__((ext_vector_type(4)));
typedef short bf16x8 __attribute__((ext_vector_type(8)));
typedef GAS unsigned gu32;
typedef GAS unsigned long long gu64;
#define RLX_AGENT __ATOMIC_RELAXED, __HIP_MEMORY_SCOPE_AGENT
#define LDS_WAIT() asm volatile("s_waitcnt lgkmcnt(0)" ::: "memory")
#define VM_WAIT() asm volatile("s_waitcnt vmcnt(0)" ::: "memory")
__device__ __forceinline__ unsigned long long rt() { return __builtin_amdgcn_s_memrealtime(); }
__device__ __forceinline__ unsigned f2bf(float f) { unsigned u = __builtin_bit_cast(unsigned, f); return (u + 0x7fffu + ((u >> 16) & 1u)) >> 16; }
__device__ __forceinline__ unsigned pk2(float lo, float hi) { return f2bf(lo) | (f2bf(hi) << 16); }

#define XB_TMO      128
#define XB_XCNT(j)  (256  + 64 * (j))
#define XB_XSUB(j)  (1280 + 64 * (j))
#define XB_XGEN(j)  (2304 + 64 * (j))
#define XB_TOP      3328
#define XB_TOPGEN   3392
#define XCD_BAR_WORDS 3456
#define XB_SPIN_CAP (1u << 18)

__device__ __forceinline__ unsigned xb_ld(unsigned* p)              { return __hip_atomic_load(p, __ATOMIC_RELAXED, __HIP_MEMORY_SCOPE_AGENT); }
__device__ __forceinline__ unsigned xb_add(unsigned* p, unsigned v) { return __hip_atomic_fetch_add(p, v, __ATOMIC_RELAXED, __HIP_MEMORY_SCOPE_AGENT); }
__device__ __forceinline__ unsigned xb_xcc_id() { return (unsigned)__builtin_amdgcn_s_getreg((3 << 11) | 20) & 0xFu; }
#define XB_SPIN(cond, bar) do { unsigned _sp = 0; while (cond) { __builtin_amdgcn_s_sleep(1); \
    if ((++_sp & 255u) == 0u) { if (xb_ld(&(bar)[XB_TMO])) break; if (_sp > XB_SPIN_CAP) { atomicAdd(&(bar)[XB_TMO], 1u); break; } } } } while (0)

struct XcdBarrier {
    unsigned* bar; unsigned x;
    volatile LAS unsigned* st;
};

__device__ __forceinline__ XcdBarrier xcd_barrier_post(unsigned* bar, volatile LAS unsigned* st) {
    XcdBarrier b; b.bar = bar; b.x = xb_xcc_id(); b.st = st;
    if (threadIdx.x == 0) (void)xb_add(&bar[XB_XCNT(b.x)], 1u);
    return b;
}
__device__ __forceinline__ void xcd_barrier_complete(unsigned* bar, unsigned x, unsigned& nloc, unsigned& nx) {
    const unsigned G = gridDim.x * gridDim.y * gridDim.z;
    unsigned sum, cnt, mine, sp = 0u;
    for (;;) {
        sum = 0u; cnt = 0u; mine = 0u;
#pragma unroll
        for (unsigned j = 0; j < 16; ++j) { const unsigned c = xb_ld(&bar[XB_XCNT(j)]); sum += c; cnt += (c > 0u) ? 1u : 0u; mine = (j == x) ? c : mine; }
        if (sum == G) break;
        __builtin_amdgcn_s_sleep(1);
        if ((++sp & 255u) == 0u) { if (xb_ld(&bar[XB_TMO])) break; if (sp > XB_SPIN_CAP) { atomicAdd(&bar[XB_TMO], 1u); break; } }
    }
    nloc = mine > 0u ? mine : 1u; nx = cnt > 0u ? cnt : 1u;
}

__device__ __forceinline__ void xcd_barrier(const XcdBarrier& b) {
    asm volatile("s_waitcnt vmcnt(0)" ::: "memory");
    __syncthreads();
    if (threadIdx.x == 0) {
        unsigned* bar = b.bar;
        __builtin_amdgcn_s_waitcnt(0);
        unsigned nloc = b.st[0], nx = b.st[1];
        if (nloc == 0u) { xcd_barrier_complete(bar, b.x, nloc, nx); b.st[0] = nloc; b.st[1] = nx; }
        const unsigned old = xb_add(&bar[XB_XSUB(b.x)], 1u);
        const unsigned gen = old / nloc;
        if (old + 1u == (gen + 1u) * nloc) {
            __builtin_amdgcn_fence(__ATOMIC_RELEASE, "agent");
            asm volatile("s_waitcnt vmcnt(0)" ::: "memory");
            const unsigned og = xb_add(&bar[XB_TOP], 1u);
            const unsigned tg = og / nx;
            if (og + 1u == (tg + 1u) * nx) xb_add(&bar[XB_TOPGEN], 1u);
            else XB_SPIN(xb_ld(&bar[XB_TOPGEN]) == tg, bar);
            __builtin_amdgcn_fence(__ATOMIC_ACQUIRE, "agent");
            xb_add(&bar[XB_XGEN(b.x)], 1u);
            asm volatile("s_waitcnt vmcnt(0)" ::: "memory");
        } else {
            XB_SPIN(xb_ld(&bar[XB_XGEN(b.x)]) == gen, bar);
            __builtin_amdgcn_fence(__ATOMIC_ACQUIRE, "agent");
            asm volatile("s_waitcnt vmcnt(0)" ::: "memory");
        }
    }
    __syncthreads();
}
constexpr int NWAVES = 8;
constexpr int BATCH = 16, SEQ = 2048, DM = 1024, M = BATCH * SEQ;
constexpr int L0P = 3584;
constexpr int L1P = 2048;
constexpr int DFF = 2816;
constexpr float ALPHA = 1.4142135623730951f;
typedef unsigned short bf16_t;
typedef float f32x16 __attribute__((ext_vector_type(16)));

constexpr size_t MiB = 1u << 20;
constexpr size_t WS_CTL = 0, CTL_ZERO_BYTES = 1 * MiB;
constexpr int CW_BAR = 4096;
constexpr size_t WS_W0IN = 2 * MiB, WS_W0OUT = 9 * MiB, WS_WUP0 = 11 * MiB, WS_WDN0 = 22 * MiB, WS_W1IN = 28 * MiB, WS_WUQ = 32 * MiB, WS_WUKV = 33 * MiB,
                 WS_W1OUT = 34 * MiB, WS_WUP1 = 36 * MiB, WS_WDN1 = 47 * MiB;
constexpr size_t WS_XB = 56 * MiB, WS_YMIX = 120 * MiB, WS_BIG = 184 * MiB;
constexpr size_t WS_G = 408 * MiB, WS_BONUS = 440 * MiB, WS_DT = 441 * MiB, WS_XST = 442 * MiB, WS_BT = 474 * MiB, WS_ASUM = 490 * MiB;
constexpr size_t WS_SLOC = 120 * MiB;
constexpr size_t WS_W2T = 53 * MiB, WS_A2T = 53 * MiB + 256 * 1024, WS_G2T = 53 * MiB + 512 * 1024;
constexpr size_t WS_GU = 120 * MiB;
constexpr size_t WS_PROJ1 = 184 * MiB, WS_QM = 312 * MiB, WS_KVM = 360 * MiB, WS_KPE = 424 * MiB, WS_RS = 426 * MiB;
constexpr size_t WS_VTS = 428 * MiB, WS_VTM = 460 * MiB;
constexpr size_t WS_NEED = 492 * MiB;

constexpr int RING_BYTES = 131072;
constexpr int LDSCTL_OFF = 146432, MISC_OFF = LDSCTL_OFF + 320;
constexpr int LDS_BYTES = 147456;

__device__ __forceinline__ float bf2f(bf16_t b) { return __builtin_bit_cast(float, (unsigned)b << 16); }
__device__ __forceinline__ float sigmoidf_(float x) { return 1.f / (1.f + expf(-x)); }
__device__ __forceinline__ float softplusf_(float x) { return fmaxf(x, 0.f) + log1pf(expf(-fabsf(x))); }
__device__ __forceinline__ float siluf_(float x) { return x / (1.f + expf(-x)); }
__device__ __forceinline__ float wave_sum(float v) {
#pragma unroll
    for (int o = 1; o < 64; o <<= 1) v += __shfl_xor(v, o);
    return v;
}
#define WSYNC() asm volatile("s_waitcnt lgkmcnt(0)" ::: "memory")

__device__ __forceinline__ void transpose_item(const float* __restrict__ W, int N, bf16_t* __restrict__ WT, int ldt, LAS float* scr, int kb, int nb, int lane, const float* __restrict__ kscale) {
    const int k0 = 64 * kb, n0 = 32 * nb;
#pragma unroll 8
    for (int i = 0; i < 32; ++i) { const int kk = 2 * i + (lane >> 5), n = n0 + (lane & 31); float v = (n < N) ? W[(size_t)(k0 + kk) * N + n] : 0.f; if (kscale) v *= kscale[k0 + kk]; scr[kk * 33 + (lane & 31)] = v; }
    WSYNC();
    const int c = lane & 7;
#pragma unroll
    for (int j = 0; j < 4; ++j) { const int n = (lane >> 3) + 8 * j; const LAS float* s = scr + (8 * c) * 33 + n;
        v4u o; o.x = pk2(s[0 * 33], s[1 * 33]); o.y = pk2(s[2 * 33], s[3 * 33]); o.z = pk2(s[4 * 33], s[5 * 33]); o.w = pk2(s[6 * 33], s[7 * 33]);
        *(v4u*)(WT + (size_t)(n0 + n) * ldt + k0 + 8 * c) = o; }
    WSYNC();
}
__device__ __forceinline__ void transpose_matrix(const float* W, int K, int N, bf16_t* WT, int Npad, int ldt, LAS float* scr, int gw, int NGW, int lane, const float* kscale) {
    const int nblk = Npad / 32, nit = (K / 64) * nblk;
    for (int it = gw; it < nit; it += NGW) transpose_item(W, N, WT, ldt, scr, it / nblk, it % nblk, lane, kscale);
}

__device__ __forceinline__ void ln_rows(float* h, bf16_t* hb, const float* __restrict__ g, const float* __restrict__ b, int gw, int NGW, int lane) {
    for (int row = gw; row < M; row += NGW) {
        float* p = h + (size_t)row * DM;
        f32x4 v[4]; float s = 0.f;
#pragma unroll
        for (int j = 0; j < 4; ++j) { v[j] = *(const f32x4*)(p + 4 * lane + 256 * j); s += (v[j][0] + v[j][1]) + (v[j][2] + v[j][3]); }
        const float mean = wave_sum(s) * (1.f / DM); float q = 0.f;
#pragma unroll
        for (int j = 0; j < 4; ++j) { v[j] = v[j] - mean; q += (v[j][0] * v[j][0] + v[j][1] * v[j][1]) + (v[j][2] * v[j][2] + v[j][3] * v[j][3]); }
        const float rstd = 1.0f / sqrtf(wave_sum(q) * (1.f / DM) + 1e-5f);
#pragma unroll
        for (int j = 0; j < 4; ++j) {
            const int c = 4 * lane + 256 * j;
            const f32x4 gg = *(const f32x4*)(g + c), bb = *(const f32x4*)(b + c);
            const f32x4 o = v[j] * rstd * gg + bb;
            *(f32x4*)(p + c) = o;
            uint2 w; w.x = pk2(o[0], o[1]); w.y = pk2(o[2], o[3]);
            *(uint2*)(hb + (size_t)row * DM + c) = w;
        }
    }
}

__device__ __forceinline__ void rwkv_naive_chain(int chain, int lane, LAS float* sm, const bf16_t* __restrict__ proj, const float* __restrict__ mix, const float* __restrict__ w0, const float* __restrict__ w2,
                                                 const float* __restrict__ a0, const float* __restrict__ a2, const float* __restrict__ g2, const float* __restrict__ k_k,
                                                 const float* __restrict__ k_a, const float* __restrict__ r_k, const float* __restrict__ ln_g, const float* __restrict__ ln_b, bf16_t* __restrict__ ymix) {
    LAS float* s_w2 = sm; LAS float* s_a2 = sm + 4096; LAS float* s_g2 = sm + 8192; LAS float* s_tw = sm + 16384; LAS float* s_al = s_tw + 64; LAS float* s_sg = s_tw + 128;
    LAS float* s_w = s_tw + 256; LAS float* s_k = s_tw + 320; LAS float* s_a = s_tw + 384; LAS float* s_b = s_tw + 448; LAS float* s_r = s_tw + 512;
    const int b = chain >> 3, h = chain & 7, c = h * 64 + lane;
    for (int l = 0; l < 64; ++l) { s_w2[l * 64 + lane] = w2[l * 512 + c]; s_a2[l * 64 + lane] = a2[l * 512 + c]; }
    for (int l = 0; l < 128; ++l) s_g2[l * 64 + lane] = g2[l * 512 + c];
    const float mr = mix[c], mk = mix[512 + c], mv = mix[1024 + c], mw = mix[1536 + lane], ma = mix[1600 + lane], mg0 = mix[1664 + lane], mg1 = mix[1728 + lane];
    const float w0c = w0[c], a0c = a0[c], kkc = k_k[c], kac = k_a[c], rkc = r_k[c], lgc = ln_g[c], lbc = ln_b[c];
    float S[64];
#pragma unroll
    for (int j = 0; j < 64; ++j) S[j] = 0.f;
    float pr = 0.f, pk = 0.f, pv = 0.f, pw = 0.f, pa = 0.f, pg0 = 0.f, pg1 = 0.f;
    WSYNC();
    for (int t = 0; t < SEQ; ++t) {
        const bf16_t* row = proj + (size_t)(b * SEQ + t) * L0P;
        const float cr = bf2f(row[c]), ck = bf2f(row[512 + c]), cv = bf2f(row[1024 + c]), cw = bf2f(row[1536 + lane]), ca = bf2f(row[1600 + lane]),
                    cg0 = bf2f(row[1664 + lane]), cg1 = bf2f(row[1728 + lane]);
        const float r_s = cr + (pr - cr) * mr, k_s = ck + (pk - ck) * mk, v_s = cv + (pv - cv) * mv;
        const float wl = cw + (pw - cw) * mw, al = ca + (pa - ca) * ma, g0 = cg0 + (pg0 - cg0) * mg0, g1 = cg1 + (pg1 - cg1) * mg1;
        pr = cr; pk = ck; pv = cv; pw = cw; pa = ca; pg0 = cg0; pg1 = cg1;
        s_tw[lane] = tanhf(wl); s_al[lane] = al; s_sg[lane] = sigmoidf_(g0); s_sg[64 + lane] = sigmoidf_(g1);
        WSYNC();
        float wsum = w0c, asum = a0c, gsum = 0.f;
#pragma unroll 2
        for (int l = 0; l < 64; ++l) { wsum += s_tw[l] * s_w2[l * 64 + lane]; asum += s_al[l] * s_a2[l * 64 + lane]; }
#pragma unroll 2
        for (int l = 0; l < 128; ++l) gsum += s_sg[l] * s_g2[l * 64 + lane];
        const float log_w = -softplusf_(-wsum) - 0.5f;
        const float dec = expf(-expf(log_w));
        const float a = sigmoidf_(asum);
        float kkv = k_s * kkc;
        const float nrm = sqrtf(wave_sum(kkv * kkv));
        kkv = kkv / fmaxf(nrm, 1e-12f);
        const float k2 = k_s * (1.f + (a - 1.f) * kac);
        const float bonus_s = wave_sum(r_s * k2 * rkc);
        s_w[lane] = dec; s_k[lane] = k2; s_a[lane] = -kkv; s_b[lane] = kkv * a; s_r[lane] = r_s;
        WSYNC();
        float sa = 0.f;
#pragma unroll
        for (int j = 0; j < 64; ++j) sa += S[j] * s_a[j];
        float y = 0.f;
#pragma unroll
        for (int j = 0; j < 64; ++j) { S[j] = S[j] * s_w[j] + sa * s_b[j] + v_s * s_k[j]; y += S[j] * s_r[j]; }
        const float mu = wave_sum(y) * (1.f / 64.f);
        const float d = y - mu;
        const float var = wave_sum(d * d) * (1.f / 64.f);
        const float yn = d * (1.0f / sqrtf(var + 64e-5f)) * lgc + lbc;
        const float o = (yn + bonus_s * v_s) * gsum;
        ymix[(size_t)(b * SEQ + t) * DM + c] = (bf16_t)f2bf(o);
        WSYNC();
    }
}

__device__ __forceinline__ void ssm_conv_all(const bf16_t* __restrict__ proj, const float* __restrict__ cw, const float* __restrict__ cb, const float* __restrict__ dtb,
                                             bf16_t* __restrict__ xbc, float* __restrict__ dt, int gtid, int NT) {
    for (size_t i = gtid; i < (size_t)M * 1024; i += NT) {
        const int m = (int)(i >> 10), c = (int)(i & 1023), t = m & (SEQ - 1);
        float acc = cb[c];
#pragma unroll
        for (int k = 0; k < 4; ++k) { const int tt = t - 3 + k; if (tt >= 0) acc += cw[k * 1024 + c] * bf2f(proj[(size_t)(m - 3 + k) * L0P + 2304 + c]); }
        xbc[i] = (bf16_t)f2bf(siluf_(acc));
    }
    for (int i = gtid; i < M * 8; i += NT) dt[i] = softplusf_(bf2f(proj[(size_t)(i >> 3) * L0P + 3328 + (i & 7)]) + dtb[i & 7]);
}
__device__ __forceinline__ void ssd_naive_task(int task, int lane, const bf16_t* __restrict__ xbc, const float* __restrict__ dt, const float* __restrict__ a_log, const float* __restrict__ dsk, float* __restrict__ yssm) {
    const int chain = task >> 2, q = task & 3, b = chain >> 3, h = chain & 7, g = h >> 2, p = q * 16 + (lane >> 2), nq = lane & 3;
    const float A = -expf(a_log[h]), D = dsk[h];
    float st[32];
#pragma unroll
    for (int n = 0; n < 32; ++n) st[n] = 0.f;
    for (int t = 0; t < SEQ; ++t) {
        const size_t m = (size_t)b * SEQ + t;
        const float dtv = dt[m * 8 + h], dA = expf(dtv * A);
        const float x = bf2f(xbc[m * 1024 + h * 64 + p]), xdt = x * dtv;
        const bf16_t* Bp = xbc + m * 1024 + 512 + g * 128 + nq * 32;
        const bf16_t* Cp = xbc + m * 1024 + 768 + g * 128 + nq * 32;
        float yp = 0.f;
#pragma unroll
        for (int n = 0; n < 32; ++n) { st[n] = st[n] * dA + xdt * bf2f(Bp[n]); yp += st[n] * bf2f(Cp[n]); }
        yp += __shfl_xor(yp, 1); yp += __shfl_xor(yp, 2);
        if (nq == 0) yssm[m * 512 + h * 64 + p] = yp + D * x;
    }
}
__device__ __forceinline__ void ssm_gate_norm_all(const bf16_t* __restrict__ yssm, const bf16_t* __restrict__ proj, const float* __restrict__ ng, bf16_t* __restrict__ ymix, int wv0, int wvend, int lane) {
    for (int wv = wv0; wv < wvend; wv += NWAVES) {
        const int m = wv >> 1, g = wv & 1;
        float u[4], q = 0.f;
#pragma unroll
        for (int j = 0; j < 4; ++j) { const int c = g * 256 + j * 64 + lane; const float z = bf2f(proj[(size_t)m * L0P + 1792 + c]); u[j] = bf2f(yssm[(size_t)m * 512 + c]) * siluf_(z); q += u[j] * u[j]; }
        const float rs = 1.0f / sqrtf(wave_sum(q) * (1.f / 256.f) + 1e-5f);
#pragma unroll
        for (int j = 0; j < 4; ++j) { const int c = g * 256 + j * 64 + lane; ymix[(size_t)m * DM + 512 + c] = (bf16_t)f2bf(u[j] * rs * ng[c]); }
    }
}
__device__ __forceinline__ void ffn_act_all(bf16_t* gu, const float* __restrict__ cw, const float* __restrict__ cb, int gtid, int NT) {
    for (size_t i = gtid; i < (size_t)M * DFF; i += NT) {
        const int m = (int)(i / DFF), c = (int)(i - (size_t)m * DFF), t = m & (SEQ - 1);
        float acc = cb[c];
#pragma unroll
        for (int k = 0; k < 3; ++k) { const int tt = t - 2 + k; if (tt >= 0) acc += cw[k * DFF + c] * bf2f(gu[(size_t)(m - 2 + k) * (2 * DFF) + c]); }
        const size_t o = (size_t)m * (2 * DFF) + DFF + c;
        gu[o] = (bf16_t)f2bf(siluf_(acc) * bf2f(gu[o]));
    }
}
__device__ __forceinline__ void mla_prep_all(const bf16_t* __restrict__ proj1, const int* __restrict__ pos, float* __restrict__ rs, bf16_t* __restrict__ kpe, int gw, int NGW, int lane) {
    for (int m = gw; m < M; m += NGW) {
        const bf16_t* row = proj1 + (size_t)m * L1P;
        float q = 0.f;
#pragma unroll
        for (int j = 0; j < 4; ++j) { const float v = bf2f(row[1536 + j * 64 + lane]); q += v * v; }
        q = wave_sum(q);
        float k = 0.f;
#pragma unroll
        for (int j = 0; j < 2; ++j) { const float v = bf2f(row[1792 + j * 64 + lane]); k += v * v; }
        k = wave_sum(k);
        if (lane == 0) { rs[(size_t)m * 2] = 1.0f / sqrtf(q * (1.f / 256.f) + 1e-6f); rs[(size_t)m * 2 + 1] = 1.0f / sqrtf(k * (1.f / 128.f) + 1e-6f); }
        if (lane < 16) {
            const double inv = pow(10000.0, -(double)(2 * lane) / 32.0);
            const double ang = (double)pos[m] * inv;
            const float cs = (float)cos(ang), sn = (float)sin(ang);
            const float x1 = bf2f(row[1920 + lane]), x2 = bf2f(row[1936 + lane]);
            kpe[(size_t)m * 32 + lane] = (bf16_t)f2bf(x1 * cs - x2 * sn);
            kpe[(size_t)m * 32 + 16 + lane] = (bf16_t)f2bf(x2 * cs + x1 * sn);
        }
    }
}
__device__ __forceinline__ void rope_q_all(bf16_t* qm, const int* __restrict__ pos, int gtid, int NT) {
    for (int i = gtid; i < M * 128; i += NT) {
        const int m = i >> 7, h = (i >> 4) & 7, k = i & 15;
        const double inv = pow(10000.0, -(double)(2 * k) / 32.0);
        const double ang = (double)pos[m] * inv;
        const float cs = (float)cos(ang), sn = (float)sin(ang);
        bf16_t* p = qm + (size_t)m * 768 + h * 96 + 64;
        const float x1 = bf2f(p[k]), x2 = bf2f(p[16 + k]);
        p[k] = (bf16_t)f2bf(x1 * cs - x2 * sn); p[16 + k] = (bf16_t)f2bf(x2 * cs + x1 * sn);
    }
}
__device__ __forceinline__ void sb_naive_task(int qblk, int bh, int lane, const bf16_t* __restrict__ proj1, bf16_t* __restrict__ ymix) {
    const int b = bh >> 3, h = bh & 7, t = qblk * 64 + lane;
    const size_t mrow = (size_t)b * SEQ;
    float q[64], o[64];
#pragma unroll
    for (int d = 0; d < 64; ++d) { q[d] = bf2f(proj1[(mrow + t) * L1P + h * 64 + d]) * 0.125f; o[d] = 0.f; }
    float cum = 0.f;
    const int smax = qblk * 64 + 63;
    for (int s = smax - 1; s >= 0; --s) {
        const bf16_t* kr = proj1 + (mrow + s) * L1P + 512 + h * 64;
        const bf16_t* vr = proj1 + (mrow + s) * L1P + 1024 + h * 64;
        float z = 0.f;
#pragma unroll
        for (int d = 0; d < 64; ++d) z += q[d] * bf2f(kr[d]);
        if (s < t) {
            const float lsp = -softplusf_(-z);
            const float lsn = -softplusf_(z);
            const float att = expf(lsp + cum);
            cum += lsn;
#pragma unroll
            for (int d = 0; d < 64; ++d) o[d] += att * bf2f(vr[d]);
        }
    }
#pragma unroll
    for (int d = 0; d < 64; ++d) ymix[(mrow + t) * DM + h * 64 + d] = (bf16_t)f2bf(o[d]);
}
__device__ __forceinline__ void mla_naive_task(int qblk, int bh, int lane, const bf16_t* __restrict__ qm, const bf16_t* __restrict__ kvm, const bf16_t* __restrict__ kpe, bf16_t* __restrict__ ymix) {
    const int b = bh >> 3, h = bh & 7, t = qblk * 64 + lane;
    const size_t mrow = (size_t)b * SEQ;
    const float scale = 0.10206207261596577f;
    float q[96], o[64];
#pragma unroll
    for (int d = 0; d < 96; ++d) q[d] = bf2f(qm[(mrow + t) * 768 + h * 96 + d]) * scale;
#pragma unroll
    for (int d = 0; d < 64; ++d) o[d] = 0.f;
    float mx = -1e30f, l = 0.f;
    const int smax = qblk * 64 + 63;
    for (int s = 0; s <= smax; ++s) {
        const bf16_t* kr = kvm + (mrow + s) * 1024 + h * 128;
        const bf16_t* pr = kpe + (mrow + s) * 32;
        float z = 0.f;
#pragma unroll
        for (int d = 0; d < 64; ++d) z += q[d] * bf2f(kr[d]);
#pragma unroll
        for (int d = 0; d < 32; ++d) z += q[64 + d] * bf2f(pr[d]);
        if (s <= t) {
            const float mn = fmaxf(mx, z), f = expf(mx - mn), pz = expf(z - mn);
            l = l * f + pz; mx = mn;
#pragma unroll
            for (int d = 0; d < 64; ++d) o[d] = o[d] * f + pz * bf2f(kr[64 + d]);
        }
    }
    const float il = 1.f / l;
#pragma unroll
    for (int d = 0; d < 64; ++d) ymix[(mrow + t) * DM + 512 + h * 64 + d] = (bf16_t)f2bf(o[d] * il);
}


typedef float f32x2_t __attribute__((ext_vector_type(2)));
typedef __bf16 bf16x2_t __attribute__((ext_vector_type(2)));
typedef unsigned u32x2 __attribute__((ext_vector_type(2)));
__device__ __forceinline__ unsigned cvtpk(float lo, float hi) { f32x2_t v = {lo, hi}; bf16x2_t b = __builtin_convertvector(v, bf16x2_t); return __builtin_bit_cast(unsigned, b); }
__device__ __forceinline__ int crow(int r, int hi) { return (r & 3) + 8 * (r >> 2) + 4 * hi; }
#define MFMA32(a, b, c) __builtin_amdgcn_mfma_f32_32x32x16_bf16((a), (b), (c), 0, 0, 0)
constexpr int STG_PITCH = 72;
__device__ __forceinline__ void transpose_tile64(const bf16_t* __restrict__ src, int sp, bf16_t* __restrict__ dst, int dp, LAS bf16_t* scr, int lane) {
#pragma unroll
    for (int i = 0; i < 8; ++i) { const int row = i * 8 + (lane >> 3), ch = lane & 7; const v4u v = *(const v4u*)(src + (size_t)row * sp + ch * 8); *(LAS v4u*)(scr + row * STG_PITCH + ch * 8) = v; }
    WSYNC();
#pragma unroll
    for (int i = 0; i < 8; ++i) { const int d = i * 8 + (lane >> 3), tc = lane & 7; const LAS bf16_t* p = scr + (tc * 8) * STG_PITCH + d;
        v4u o; o.x = (unsigned)p[0] | ((unsigned)p[STG_PITCH] << 16); o.y = (unsigned)p[2 * STG_PITCH] | ((unsigned)p[3 * STG_PITCH] << 16);
        o.z = (unsigned)p[4 * STG_PITCH] | ((unsigned)p[5 * STG_PITCH] << 16); o.w = (unsigned)p[6 * STG_PITCH] | ((unsigned)p[7 * STG_PITCH] << 16);
        *(v4u*)(dst + (size_t)d * dp + tc * 8) = o; }
    WSYNC();
}
__device__ __forceinline__ void store_OT(const f32x16 (&o)[2], float sc, LAS bf16_t* stg, bf16_t* __restrict__ dst, int lane) {
    const int l31 = lane & 31, hi = lane >> 5;
#pragma unroll
    for (int dt = 0; dt < 2; ++dt)
#pragma unroll
        for (int r = 0; r < 16; ++r) stg[l31 * STG_PITCH + 32 * dt + crow(r, hi)] = (bf16_t)f2bf(o[dt][r] * sc);
    WSYNC();
#pragma unroll
    for (int i = 0; i < 4; ++i) { const int row = i * 8 + (lane >> 3), ch = lane & 7; const v4u v = *(const LAS v4u*)(stg + row * STG_PITCH + ch * 8); *(v4u*)(dst + (size_t)row * DM + ch * 8) = v; }
    WSYNC();
}
__device__ __forceinline__ float softplus_fast(float z) { return fmaxf(z, 0.f) + __logf(1.f + __expf(-fabsf(z))); }

__device__ __forceinline__ void sb_task(int bh, int qblk, int lane, const bf16_t* __restrict__ P1, const bf16_t* __restrict__ VT, bf16_t* __restrict__ ymix, LAS bf16_t* stg) {
    const int b = bh >> 3, h = bh & 7, l31 = lane & 31, hi = lane >> 5, q0 = qblk * 32, t = q0 + l31;
    const size_t rowb = (size_t)b * SEQ;
    const bf16_t* Qp = P1 + (rowb + q0 + l31) * L1P + h * 64 + 8 * hi;
    bf16x8 qf[4];
#pragma unroll
    for (int kk = 0; kk < 4; ++kk) qf[kk] = *(const bf16x8*)(Qp + 16 * kk);
    const bf16_t* Kp = P1 + (rowb + l31) * L1P + 512 + h * 64 + 8 * hi;
    const bf16_t* Vp = VT + ((size_t)bh * 64 + l31) * SEQ + 4 * hi;
    f32x16 o[2];
#pragma unroll
    for (int r = 0; r < 16; ++r) { o[0][r] = 0.f; o[1][r] = 0.f; }
    float cum = 0.f;
    bf16x8 kf[4]; u32x2 va[2][2][2];
#define SB_LOAD(S0, KF, VA) do { _Pragma("unroll") for (int kk = 0; kk < 4; ++kk) KF[kk] = *(const bf16x8*)(Kp + (size_t)(S0) * L1P + 16 * kk); \
        _Pragma("unroll") for (int dt = 0; dt < 2; ++dt) _Pragma("unroll") for (int ks = 0; ks < 2; ++ks) { VA[dt][ks][0] = *(const u32x2*)(Vp + (size_t)dt * 32 * SEQ + (S0) + 16 * ks); VA[dt][ks][1] = *(const u32x2*)(Vp + (size_t)dt * 32 * SEQ + (S0) + 16 * ks + 8); } } while (0)
    SB_LOAD(q0, kf, va);
    for (int s0 = q0; s0 >= 0; s0 -= 32) {
        bf16x8 kn[4]; u32x2 vn[2][2][2];
        const int sn = (s0 >= 32) ? s0 - 32 : 0;
        SB_LOAD(sn, kn, vn);
        f32x16 acc;
#pragma unroll
        for (int r = 0; r < 16; ++r) acc[r] = 0.f;
#pragma unroll
        for (int kk = 0; kk < 4; ++kk) acc = MFMA32(kf[kk], qf[kk], acc);
        const bool diag = (s0 == q0);
        float lb[16], lk[16];
#pragma unroll
        for (int r = 0; r < 16; ++r) { const float z = acc[r] * 0.125f; const float sp = softplus_fast(z); float b_ = z - sp, k_ = -sp;
            if (diag) { const bool valid = (s0 + crow(r, hi)) < t; b_ = valid ? b_ : -1e30f; k_ = valid ? k_ : 0.f; }
            lb[r] = b_; lk[r] = k_; }
        float e[16], T[4], U[4];
#pragma unroll
        for (int i = 0; i < 4; ++i) { e[4 * i + 3] = 0.f; e[4 * i + 2] = lk[4 * i + 3]; e[4 * i + 1] = e[4 * i + 2] + lk[4 * i + 2]; e[4 * i] = e[4 * i + 1] + lk[4 * i + 1]; T[i] = e[4 * i] + lk[4 * i]; }
#pragma unroll
        for (int i = 0; i < 4; ++i) U[i] = __shfl_xor(T[i], 32);
        float off[4];
        { const float st2 = T[3], st1 = st2 + T[2], st0 = st1 + T[1]; const float su2 = U[3], su1 = su2 + U[2], su0 = su1 + U[1];
          const float x0 = hi ? 0.f : U[0], x1 = hi ? 0.f : U[1], x2 = hi ? 0.f : U[2], x3 = hi ? 0.f : U[3];
          off[3] = x3; off[2] = st2 + su2 + x2; off[1] = st1 + su1 + x1; off[0] = st0 + su0 + x0;
          const float total = st0 + T[0] + su0 + U[0];
#pragma unroll
          for (int r = 0; r < 16; ++r) acc[r] = __expf(lb[r] + (cum + off[r >> 2] + e[r]));
          cum += total; }
        bf16x8 pf[2];
#pragma unroll
        for (int ks = 0; ks < 2; ++ks) { v4u w; w.x = cvtpk(acc[8 * ks], acc[8 * ks + 1]); w.y = cvtpk(acc[8 * ks + 2], acc[8 * ks + 3]); w.z = cvtpk(acc[8 * ks + 4], acc[8 * ks + 5]); w.w = cvtpk(acc[8 * ks + 6], acc[8 * ks + 7]); pf[ks] = __builtin_bit_cast(bf16x8, w); }
#pragma unroll
        for (int dt = 0; dt < 2; ++dt)
#pragma unroll
            for (int ks = 0; ks < 2; ++ks) { v4u a; a.x = va[dt][ks][0].x; a.y = va[dt][ks][0].y; a.z = va[dt][ks][1].x; a.w = va[dt][ks][1].y; o[dt] = MFMA32(__builtin_bit_cast(bf16x8, a), pf[ks], o[dt]); }
        if (__all(cum < -110.f)) break;
#pragma unroll
        for (int kk = 0; kk < 4; ++kk) kf[kk] = kn[kk];
#pragma unroll
        for (int dt = 0; dt < 2; ++dt)
#pragma unroll
            for (int ks = 0; ks < 2; ++ks) { va[dt][ks][0] = vn[dt][ks][0]; va[dt][ks][1] = vn[dt][ks][1]; }
    }
#undef SB_LOAD
    store_OT(o, 1.0f, stg, ymix + (rowb + q0) * DM + h * 64, lane);
}
__device__ __forceinline__ void mla_task(int bh, int qblk, int lane, const bf16_t* __restrict__ QM, const bf16_t* __restrict__ KVM, const bf16_t* __restrict__ KPE, const bf16_t* __restrict__ VT,
                                         bf16_t* __restrict__ ymix, LAS bf16_t* stg) {
    const int b = bh >> 3, h = bh & 7, l31 = lane & 31, hi = lane >> 5, q0 = qblk * 32, t = q0 + l31;
    const size_t rowb = (size_t)b * SEQ;
    const bf16_t* Qp = QM + (rowb + q0 + l31) * 768 + h * 96 + 8 * hi;
    bf16x8 qf[6];
#pragma unroll
    for (int kk = 0; kk < 6; ++kk) qf[kk] = *(const bf16x8*)(Qp + 16 * kk);
    const bf16_t* Kn = KVM + (rowb + l31) * 1024 + h * 128 + 8 * hi;
    const bf16_t* Kr = KPE + (rowb + l31) * 32 + 8 * hi;
    const bf16_t* Vp = VT + ((size_t)bh * 64 + l31) * SEQ + 4 * hi;
    const float sc2 = 0.10206207261596577f * 1.4426950408889634f;
    f32x16 o[2];
#pragma unroll
    for (int r = 0; r < 16; ++r) { o[0][r] = 0.f; o[1][r] = 0.f; }
    float mrun = -1e30f, lsum = 0.f;
    bf16x8 kf[6]; u32x2 va[2][2][2];
#define ML_LOAD(S0, KF, VA) do { _Pragma("unroll") for (int kk = 0; kk < 4; ++kk) KF[kk] = *(const bf16x8*)(Kn + (size_t)(S0) * 1024 + 16 * kk); \
        _Pragma("unroll") for (int kk = 0; kk < 2; ++kk) KF[4 + kk] = *(const bf16x8*)(Kr + (size_t)(S0) * 32 + 16 * kk); \
        _Pragma("unroll") for (int dt = 0; dt < 2; ++dt) _Pragma("unroll") for (int ks = 0; ks < 2; ++ks) { VA[dt][ks][0] = *(const u32x2*)(Vp + (size_t)dt * 32 * SEQ + (S0) + 16 * ks); VA[dt][ks][1] = *(const u32x2*)(Vp + (size_t)dt * 32 * SEQ + (S0) + 16 * ks + 8); } } while (0)
    ML_LOAD(0, kf, va);
    for (int s0 = 0; s0 <= q0; s0 += 32) {
        bf16x8 kn[6]; u32x2 vn[2][2][2];
        const int sn = (s0 + 32 <= q0) ? s0 + 32 : s0;
        ML_LOAD(sn, kn, vn);
        f32x16 acc;
#pragma unroll
        for (int r = 0; r < 16; ++r) acc[r] = 0.f;
#pragma unroll
        for (int kk = 0; kk < 6; ++kk) acc = MFMA32(kf[kk], qf[kk], acc);
        const bool diag = (s0 == q0);
        float tmax = -1e30f;
#pragma unroll
        for (int r = 0; r < 16; ++r) { float z = acc[r] * sc2; if (diag && (s0 + crow(r, hi)) > t) z = -1e30f; acc[r] = z; tmax = fmaxf(tmax, z); }
        tmax = fmaxf(tmax, __shfl_xor(tmax, 32));
        const float mn = fmaxf(mrun, tmax), alpha = exp2f(mrun - mn); mrun = mn;
        float ps = 0.f;
#pragma unroll
        for (int r = 0; r < 16; ++r) { acc[r] = exp2f(acc[r] - mn); ps += acc[r]; }
        lsum = lsum * alpha + ps;
#pragma unroll
        for (int r = 0; r < 16; ++r) { o[0][r] *= alpha; o[1][r] *= alpha; }
        bf16x8 pf[2];
#pragma unroll
        for (int ks = 0; ks < 2; ++ks) { v4u w; w.x = cvtpk(acc[8 * ks], acc[8 * ks + 1]); w.y = cvtpk(acc[8 * ks + 2], acc[8 * ks + 3]); w.z = cvtpk(acc[8 * ks + 4], acc[8 * ks + 5]); w.w = cvtpk(acc[8 * ks + 6], acc[8 * ks + 7]); pf[ks] = __builtin_bit_cast(bf16x8, w); }
#pragma unroll
        for (int dt = 0; dt < 2; ++dt)
#pragma unroll
            for (int ks = 0; ks < 2; ++ks) { v4u a; a.x = va[dt][ks][0].x; a.y = va[dt][ks][0].y; a.z = va[dt][ks][1].x; a.w = va[dt][ks][1].y; o[dt] = MFMA32(__builtin_bit_cast(bf16x8, a), pf[ks], o[dt]); }
#pragma unroll
        for (int kk = 0; kk < 6; ++kk) kf[kk] = kn[kk];
#pragma unroll
        for (int dt = 0; dt < 2; ++dt)
#pragma unroll
            for (int ks = 0; ks < 2; ++ks) { va[dt][ks][0] = vn[dt][ks][0]; va[dt][ks][1] = vn[dt][ks][1]; }
    }
#undef ML_LOAD
    lsum += __shfl_xor(lsum, 32);
    store_OT(o, 1.0f / lsum, stg, ymix + (rowb + q0) * DM + 512 + h * 64, lane);
}


constexpr int RW_RAWW = 0, RW_RAWA = 2048, RW_RS = 4096, RW_KS = 6144, RW_VS = 8192;
constexpr int RW_CH0 = 10240, RW_CHSZ = 11328;
constexpr int RW_YB = RW_CH0 + 2 * RW_CHSZ;
constexpr int RW_MIX = RW_YB + 1024;
static_assert((RW_MIX + 256) * 4 <= 146432, "rwkv LDS map");
template <int CTRL> __device__ __forceinline__ float dpp_mov(float x) { return __builtin_bit_cast(float, __builtin_amdgcn_update_dpp(0, __builtin_bit_cast(int, x), CTRL, 0xF, 0xF, true)); }
__device__ __forceinline__ float rowsum16(float x) { x += dpp_mov<0x128>(x); x += dpp_mov<0x124>(x); x += dpp_mov<0x122>(x); x += dpp_mov<0x121>(x); return x; }
__device__ __forceinline__ float rl(float x, int l) { return __builtin_bit_cast(float, __builtin_amdgcn_readlane(__builtin_bit_cast(int, x), l)); }
__device__ __forceinline__ float wave_sum_dpp(float x) { x = rowsum16(x); return (rl(x, 0) + rl(x, 16)) + (rl(x, 32) + rl(x, 48)); }
__device__ __forceinline__ float bflo(unsigned u) { return __builtin_bit_cast(float, u << 16); }
__device__ __forceinline__ float bfhi(unsigned u) { return __builtin_bit_cast(float, u & 0xffff0000u); }
__device__ __forceinline__ float tanh_fast(float x) { return 1.f - 2.f / (1.f + __expf(2.f * x)); }
__device__ __forceinline__ float sigmoid_fast(float x) { return 1.f / (1.f + __expf(-x)); }

__device__ __forceinline__ void rwkv_phase(LAS float* sm, int tid, int lane, int wave, int blk, const bf16_t* __restrict__ proj, const float* __restrict__ mix, const float* __restrict__ w0, const float* __restrict__ a0,
                                           const float* __restrict__ k_k, const float* __restrict__ k_a, const float* __restrict__ r_k, const bf16_t* __restrict__ W2T, const bf16_t* __restrict__ A2T, const bf16_t* __restrict__ G2T,
                                           float* __restrict__ yraw, bf16_t* __restrict__ gout, float* __restrict__ bonus_out) {
    const int chain = blk >> 1, half = blk & 1, b = chain >> 3, h = chain & 7, l31 = lane & 31, hi = lane >> 5;
    const size_t rowb = (size_t)b * SEQ;
    if (tid < 256) sm[RW_MIX + tid] = mix[1536 + tid];
    const int cB = h * 64 + lane;
    const float w0c = w0[cB], a0c = a0[cB], kkc = k_k[cB], kac = k_a[cB], rkc = r_k[cB];
    float mixv[8];
    { const int idx = (wave >= 5) ? wave - 5 : 0; const int ch8 = lane & 7;
#pragma unroll
      for (int j = 0; j < 8; ++j) mixv[j] = mix[512 * idx + h * 64 + ch8 * 8 + j]; }
    __syncthreads();
    float S0 = 0.f, S1 = 0.f, S2 = 0.f, S3 = 0.f;
    const int iloc = 4 * wave + (lane >> 4), jseg = lane & 15;
    v4u ld[16];
#define RW_ISSUE(T0) do { const int t0_ = (T0); \
        if (wave < 4) { const int colb = 1536 + 64 * (wave >> 1) + 8 * hi; const size_t r_ = rowb + t0_ + l31; const size_t rp_ = (t0_ + l31 == 0) ? r_ : r_ - 1; \
            _Pragma("unroll") for (int kk = 0; kk < 4; ++kk) { ld[kk] = *(const v4u*)(proj + r_ * L0P + colb + 16 * kk); ld[4 + kk] = *(const v4u*)(proj + rp_ * L0P + colb + 16 * kk); } } \
        else if (wave == 4) { const int colb = 1664 + 8 * hi; const size_t r_ = rowb + t0_ + l31; const size_t rp_ = (t0_ + l31 == 0) ? r_ : r_ - 1; \
            _Pragma("unroll") for (int kk = 0; kk < 8; ++kk) { ld[kk] = *(const v4u*)(proj + r_ * L0P + colb + 16 * kk); ld[8 + kk] = *(const v4u*)(proj + rp_ * L0P + colb + 16 * kk); } } \
        else { const int colb = 512 * (wave - 5) + h * 64 + 8 * (lane & 7); \
            _Pragma("unroll") for (int i = 0; i < 4; ++i) { const int tl = i * 8 + (lane >> 3); const size_t r_ = rowb + t0_ + tl; const size_t rp_ = (t0_ + tl == 0) ? r_ : r_ - 1; \
                ld[i] = *(const v4u*)(proj + r_ * L0P + colb); ld[4 + i] = *(const v4u*)(proj + rp_ * L0P + colb); } } } while (0)
#define RW_SHIFT8(CUR, PRV, MIXP, OUT, PZ) do { const unsigned cu_[4] = {(CUR).x, (CUR).y, (CUR).z, (CUR).w}, pu_[4] = {(PRV).x, (PRV).y, (PRV).z, (PRV).w}; \
        _Pragma("unroll") for (int q = 0; q < 4; ++q) { const float c0 = bflo(cu_[q]), c1 = bfhi(cu_[q]), p0 = bflo(pu_[q]) * (PZ), p1 = bfhi(pu_[q]) * (PZ); \
            OUT[2 * q] = c0 + (p0 - c0) * (MIXP)[2 * q]; OUT[2 * q + 1] = c1 + (p1 - c1) * (MIXP)[2 * q + 1]; } } while (0)
#define RW_PREP(T0, NB) do { const int t0_ = (T0); LAS float* CHn = sm + RW_CH0 + (NB) * RW_CHSZ; const float pz_ = (t0_ + l31 == 0) ? 0.f : 1.f; (void)pz_; \
        if (wave < 4) { const int lora = wave >> 1, jh = wave & 1; const bf16_t* WT = lora ? A2T : W2T; f32x16 acc; \
            _Pragma("unroll") for (int r = 0; r < 16; ++r) acc[r] = 0.f; \
            _Pragma("unroll") for (int kk = 0; kk < 4; ++kk) { float mx_[8], s_[8]; \
                { const f32x4 m0 = *(const LAS f32x4*)(sm + RW_MIX + lora * 64 + 16 * kk + 8 * hi), m1 = *(const LAS f32x4*)(sm + RW_MIX + lora * 64 + 16 * kk + 8 * hi + 4); \
                  mx_[0] = m0[0]; mx_[1] = m0[1]; mx_[2] = m0[2]; mx_[3] = m0[3]; mx_[4] = m1[0]; mx_[5] = m1[1]; mx_[6] = m1[2]; mx_[7] = m1[3]; } \
                RW_SHIFT8(ld[kk], ld[4 + kk], mx_, s_, pz_); \
                if (lora == 0) { _Pragma("unroll") for (int j = 0; j < 8; ++j) s_[j] = tanh_fast(s_[j]); } \
                v4u aw; aw.x = cvtpk(s_[0], s_[1]); aw.y = cvtpk(s_[2], s_[3]); aw.z = cvtpk(s_[4], s_[5]); aw.w = cvtpk(s_[6], s_[7]); \
                const bf16x8 bfr = *(const bf16x8*)(WT + (size_t)(h * 64 + jh * 32 + l31) * 64 + 16 * kk + 8 * hi); \
                acc = MFMA32(__builtin_bit_cast(bf16x8, aw), bfr, acc); } \
            LAS float* dst = sm + (lora ? RW_RAWA : RW_RAWW) + jh * 32 + l31; \
            _Pragma("unroll") for (int r = 0; r < 16; ++r) dst[crow(r, hi) * 64] = acc[r]; } \
        else if (wave == 4) { f32x16 acc; \
            _Pragma("unroll") for (int r = 0; r < 16; ++r) acc[r] = 0.f; \
            _Pragma("unroll") for (int kk = 0; kk < 8; ++kk) { float mx_[8], s_[8]; \
                { const f32x4 m0 = *(const LAS f32x4*)(sm + RW_MIX + 128 + 16 * kk + 8 * hi), m1 = *(const LAS f32x4*)(sm + RW_MIX + 128 + 16 * kk + 8 * hi + 4); \
                  mx_[0] = m0[0]; mx_[1] = m0[1]; mx_[2] = m0[2]; mx_[3] = m0[3]; mx_[4] = m1[0]; mx_[5] = m1[1]; mx_[6] = m1[2]; mx_[7] = m1[3]; } \
                RW_SHIFT8(ld[kk], ld[8 + kk], mx_, s_, pz_); \
                _Pragma("unroll") for (int j = 0; j < 8; ++j) s_[j] = sigmoid_fast(s_[j]); \
                v4u aw; aw.x = cvtpk(s_[0], s_[1]); aw.y = cvtpk(s_[2], s_[3]); aw.z = cvtpk(s_[4], s_[5]); aw.w = cvtpk(s_[6], s_[7]); \
                const bf16x8 bfr = *(const bf16x8*)(G2T + (size_t)(h * 64 + half * 32 + l31) * 128 + 16 * kk + 8 * hi); \
                acc = MFMA32(__builtin_bit_cast(bf16x8, aw), bfr, acc); } \
            bf16_t* gd = gout + (rowb + t0_) * 512 + h * 64 + half * 32 + l31; \
            _Pragma("unroll") for (int r = 0; r < 16; ++r) gd[(size_t)crow(r, hi) * 512] = (bf16_t)f2bf(acc[r]); } \
        else { LAS float* dst = sm + RW_RS + (wave - 5) * 2048 + (lane & 7) * 8; \
            _Pragma("unroll") for (int i = 0; i < 4; ++i) { const int tl = i * 8 + (lane >> 3); float s_[8]; const float pzs_ = (t0_ + tl == 0) ? 0.f : 1.f; RW_SHIFT8(ld[i], ld[4 + i], mixv, s_, pzs_); \
                *(LAS f32x4*)(dst + tl * 64) = (f32x4){s_[0], s_[1], s_[2], s_[3]}; *(LAS f32x4*)(dst + tl * 64 + 4) = (f32x4){s_[4], s_[5], s_[6], s_[7]}; } } \
        __syncthreads(); \
        _Pragma("unroll") for (int tt = 0; tt < 4; ++tt) { const int t = 4 * wave + tt; \
            const float wraw = sm[RW_RAWW + t * 64 + lane], araw = sm[RW_RAWA + t * 64 + lane], r_ = sm[RW_RS + t * 64 + lane], k_ = sm[RW_KS + t * 64 + lane], v_ = sm[RW_VS + t * 64 + lane]; \
            const float wsum = w0c + wraw; const float logw = -softplus_fast(-wsum) - 0.5f; const float dec = __expf(-__expf(logw)); \
            const float a_ = sigmoid_fast(a0c + araw); \
            float kkv = k_ * kkc; const float nrm2 = wave_sum_dpp(kkv * kkv); kkv = kkv * __builtin_amdgcn_rsqf(fmaxf(nrm2, 1e-24f)); \
            const float k2 = k_ * (1.f + (a_ - 1.f) * kac); const float bv = kkv * a_; \
            const float br = wave_sum_dpp(bv * r_), kr = wave_sum_dpp(k2 * r_), bon = wave_sum_dpp(r_ * k2 * rkc); \
            CHn[t * 64 + lane] = dec; CHn[2048 + t * 64 + lane] = k2; CHn[4096 + t * 64 + lane] = -kkv; CHn[6144 + t * 64 + lane] = bv; CHn[8192 + t * 64 + lane] = dec * r_; \
            if ((lane >> 5) == half) CHn[10240 + t * 32 + (lane & 31)] = v_; \
            if (lane == 0) { CHn[11264 + 2 * t] = br; CHn[11264 + 2 * t + 1] = kr; if (half == 0) bonus_out[(rowb + t0_ + t) * 8 + h] = bon; } } \
        __syncthreads(); } while (0)

    RW_ISSUE(0);
    RW_PREP(0, 0);
#pragma unroll 1
    for (int ch = 0; ch < SEQ / 32; ++ch) {
        const int t0 = ch * 32, tn = (ch + 1 < SEQ / 32) ? t0 + 32 : t0;
        RW_ISSUE(tn);
        const LAS float* CHb = sm + RW_CH0 + (ch & 1) * RW_CHSZ + 4 * jseg;
        const LAS float* CHv = sm + RW_CH0 + (ch & 1) * RW_CHSZ + 10240 + iloc;
        const LAS float* CHs = sm + RW_CH0 + (ch & 1) * RW_CHSZ + 11264;
        f32x4 a4 = *(const LAS f32x4*)(CHb + 4096), wr4 = *(const LAS f32x4*)(CHb + 8192), w4 = *(const LAS f32x4*)(CHb), b4 = *(const LAS f32x4*)(CHb + 6144), k4 = *(const LAS f32x4*)(CHb + 2048);
        float v = CHv[0]; f32x2_t sc = *(const LAS f32x2_t*)(CHs);
#pragma unroll 2
        for (int t = 0; t < 32; ++t) {
            const int tq = (t + 1) & 31;
            const f32x4 a4n = *(const LAS f32x4*)(CHb + 4096 + tq * 64), wr4n = *(const LAS f32x4*)(CHb + 8192 + tq * 64), w4n = *(const LAS f32x4*)(CHb + tq * 64),
                        b4n = *(const LAS f32x4*)(CHb + 6144 + tq * 64), k4n = *(const LAS f32x4*)(CHb + 2048 + tq * 64);
            const float vn = CHv[tq * 32]; const f32x2_t scn = *(const LAS f32x2_t*)(CHs + 2 * tq);
            float d1 = (S0 * a4[0] + S1 * a4[1]) + (S2 * a4[2] + S3 * a4[3]);
            float d2 = (S0 * wr4[0] + S1 * wr4[1]) + (S2 * wr4[2] + S3 * wr4[3]);
            d1 = rowsum16(d1); d2 = rowsum16(d2);
            const float y = d2 + d1 * sc[0] + v * sc[1];
            S0 = S0 * w4[0] + (d1 * b4[0] + v * k4[0]); S1 = S1 * w4[1] + (d1 * b4[1] + v * k4[1]);
            S2 = S2 * w4[2] + (d1 * b4[2] + v * k4[2]); S3 = S3 * w4[3] + (d1 * b4[3] + v * k4[3]);
            if (jseg == 0) sm[RW_YB + t * 32 + iloc] = y;
            a4 = a4n; wr4 = wr4n; w4 = w4n; b4 = b4n; k4 = k4n; v = vn; sc = scn;
        }
        WSYNC();
        if (lane < 32) { const f32x4 yv = *(const LAS f32x4*)(sm + RW_YB + lane * 32 + 4 * wave); *(f32x4*)(yraw + (rowb + t0 + lane) * 512 + h * 64 + half * 32 + 4 * wave) = yv; }
        RW_PREP(tn, (ch + 1) & 1);
    }
#undef RW_ISSUE
#undef RW_PREP
#undef RW_SHIFT8
}
__device__ __forceinline__ void rwkv_post_all(const float* __restrict__ yraw, const bf16_t* __restrict__ proj, const float* __restrict__ mix, const float* __restrict__ bonus, const bf16_t* __restrict__ gbuf,
                                              const float* __restrict__ ln_g, const float* __restrict__ ln_b, bf16_t* __restrict__ ymix, int gw, int NGW, int lane) {
    for (int task = gw; task < M * 8; task += NGW) {
        const int m = task >> 3, h = task & 7, c = h * 64 + lane;
        const float y = yraw[(size_t)m * 512 + c];
        const float mu = wave_sum(y) * (1.f / 64.f), d = y - mu, var = wave_sum(d * d) * (1.f / 64.f);
        const float yn = d * (1.0f / sqrtf(var + 64e-5f)) * ln_g[c] + ln_b[c];
        const float cv = bf2f(proj[(size_t)m * L0P + 1024 + c]); const float pv = (m & (SEQ - 1)) ? bf2f(proj[(size_t)(m - 1) * L0P + 1024 + c]) : 0.f;
        const float v_s = cv + (pv - cv) * mix[1024 + c];
        const float o = (yn + bonus[(size_t)m * 8 + h] * v_s) * bf2f(gbuf[(size_t)m * 512 + c]);
        ymix[(size_t)m * DM + c] = (bf16_t)f2bf(o);
    }
}


__device__ __forceinline__ void ssd_conv_tile(int it, int lane, LAS bf16_t* scr, const bf16_t* __restrict__ proj, const float* __restrict__ cw, const float* __restrict__ cb,
                                              bf16_t* __restrict__ xbc, bf16_t* __restrict__ xst, bf16_t* __restrict__ bt) {
    const int tt = it >> 4, ct = it & 15, m0 = tt * 64, b = m0 >> 11, t0 = m0 & (SEQ - 1), c = ct * 64 + lane;
    const float w0 = cw[c], w1 = cw[1024 + c], w2 = cw[2048 + c], w3 = cw[3072 + c], bias = cb[c];
    const bf16_t* src = proj + (size_t)m0 * L0P + 2304 + c;
    float u3 = 0.f, u2 = 0.f, u1 = 0.f;
    if (t0 > 0) { u3 = bf2f(src[-3 * L0P]); u2 = bf2f(src[-2 * L0P]); u1 = bf2f(src[-1 * L0P]); }
#pragma unroll 8
    for (int t = 0; t < 64; ++t) {
        const float u = bf2f(src[(size_t)t * L0P]);
        const float y = bias + w0 * u3 + w1 * u2 + w2 * u1 + w3 * u;
        const bf16_t o = (bf16_t)f2bf(y / (1.f + __expf(-y)));
        xbc[(size_t)(m0 + t) * 1024 + c] = o;
        scr[t * STG_PITCH + lane] = o;
        u3 = u2; u2 = u1; u1 = u;
    }
    WSYNC();
    if (ct < 12) {
        bf16_t* dst = (ct < 8) ? xst + ((size_t)(b * 8 + ct) * 64) * SEQ + t0 : bt + ((size_t)(b * 2 + ((ct - 8) >> 1)) * 128 + ((ct - 8) & 1) * 64) * SEQ + t0;
#pragma unroll
        for (int i = 0; i < 8; ++i) { const int d = i * 8 + (lane >> 3), tc = lane & 7; const LAS bf16_t* p = scr + (tc * 8) * STG_PITCH + d;
            v4u o; o.x = (unsigned)p[0] | ((unsigned)p[STG_PITCH] << 16); o.y = (unsigned)p[2 * STG_PITCH] | ((unsigned)p[3 * STG_PITCH] << 16);
            o.z = (unsigned)p[4 * STG_PITCH] | ((unsigned)p[5 * STG_PITCH] << 16); o.w = (unsigned)p[6 * STG_PITCH] | ((unsigned)p[7 * STG_PITCH] << 16);
            *(v4u*)(dst + (size_t)d * SEQ + tc * 8) = o; }
    }
    WSYNC();
}
__device__ __forceinline__ void scan128(float& x0, float& x1, int lane) {
#pragma unroll
    for (int o = 1; o < 64; o <<= 1) { const float t0 = __shfl_up(x0, o), t1 = __shfl_up(x1, o); if (lane >= o) { x0 += t0; x1 += t1; } }
    x1 += __shfl(x0, 63);
}
__device__ __forceinline__ void ssd_s1_unit(int unit, int lane, LAS float* tab, const bf16_t* __restrict__ xst, const bf16_t* __restrict__ bt, const float* __restrict__ dt, const float* __restrict__ a_log,
                                            float* __restrict__ sloc, float* __restrict__ asum) {
    const int h = unit & 7, c = (unit >> 3) & 15, b = unit >> 7, g = h >> 2, l0 = c * 128, l31 = lane & 31, hi = lane >> 5;
    const size_t m0 = (size_t)b * SEQ + l0;
    const float A = -expf(a_log[h]);
    const float d0 = dt[(m0 + lane) * 8 + h], d1 = dt[(m0 + 64 + lane) * 8 + h];
    float ac0 = d0 * A, ac1 = d1 * A;
    scan128(ac0, ac1, lane);
    const float aend = __shfl(ac1, 63);
    tab[lane] = __expf(aend - ac0) * d0; tab[64 + lane] = __expf(aend - ac1) * d1;
    if (lane == 0) asum[unit] = aend;
    WSYNC();
    f32x16 acc[2][4];
#pragma unroll
    for (int pt = 0; pt < 2; ++pt)
#pragma unroll
        for (int nt = 0; nt < 4; ++nt)
#pragma unroll
            for (int r = 0; r < 16; ++r) acc[pt][nt][r] = 0.f;
    const bf16_t* Xp = xst + ((size_t)(b * 8 + h) * 64 + l31) * SEQ + l0 + 8 * hi;
    const bf16_t* Bp = bt + ((size_t)(b * 2 + g) * 128 + l31) * SEQ + l0 + 8 * hi;
#pragma unroll 2
    for (int kk = 0; kk < 8; ++kk) {
        const f32x4 wa = *(const LAS f32x4*)(tab + 16 * kk + 8 * hi), wb = *(const LAS f32x4*)(tab + 16 * kk + 8 * hi + 4);
        bf16x8 af[2], bfr[4];
#pragma unroll
        for (int pt = 0; pt < 2; ++pt) { const v4u raw = *(const v4u*)(Xp + (size_t)pt * 32 * SEQ + 16 * kk);
            v4u w; w.x = cvtpk(bflo(raw.x) * wa[0], bfhi(raw.x) * wa[1]); w.y = cvtpk(bflo(raw.y) * wa[2], bfhi(raw.y) * wa[3]);
            w.z = cvtpk(bflo(raw.z) * wb[0], bfhi(raw.z) * wb[1]); w.w = cvtpk(bflo(raw.w) * wb[2], bfhi(raw.w) * wb[3]); af[pt] = __builtin_bit_cast(bf16x8, w); }
#pragma unroll
        for (int nt = 0; nt < 4; ++nt) bfr[nt] = *(const bf16x8*)(Bp + (size_t)nt * 32 * SEQ + 16 * kk);
#pragma unroll
        for (int pt = 0; pt < 2; ++pt)
#pragma unroll
            for (int nt = 0; nt < 4; ++nt) acc[pt][nt] = MFMA32(af[pt], bfr[nt], acc[pt][nt]);
    }
    float* dst = sloc + (size_t)unit * 8192 + l31;
#pragma unroll
    for (int pt = 0; pt < 2; ++pt)
#pragma unroll
        for (int nt = 0; nt < 4; ++nt)
#pragma unroll
            for (int r = 0; r < 16; ++r) dst[(32 * pt + crow(r, hi)) * 128 + 32 * nt] = acc[pt][nt][r];
    WSYNC();
}
__device__ __forceinline__ void ssd_s2_all(const float* __restrict__ sloc, const float* __restrict__ asum, bf16_t* __restrict__ stb, int gtid, int NT) {
    for (int i = gtid; i < 128 * 2048; i += NT) {
        const int bh = i >> 11, e4 = i & 2047, b = bh >> 3, h = bh & 7;
        f32x4 run = {0.f, 0.f, 0.f, 0.f};
#pragma unroll 4
        for (int c = 0; c < 16; ++c) { const int unit = (b * 16 + c) * 8 + h; const f32x4 tmp = *(const f32x4*)(sloc + (size_t)unit * 8192 + e4 * 4);
            uint2 w; w.x = cvtpk(run[0], run[1]); w.y = cvtpk(run[2], run[3]); *(uint2*)(stb + (size_t)unit * 8192 + e4 * 4) = w;
            run = run * __expf(asum[unit]) + tmp; }
    }
}
__device__ __forceinline__ void ssd_s3_unit(int unit, int lane, LAS float* tab, const bf16_t* __restrict__ xbc, const bf16_t* __restrict__ xst, const bf16_t* __restrict__ stb, const float* __restrict__ dt,
                                            const float* __restrict__ a_log, const float* __restrict__ dsk, bf16_t* __restrict__ yssm) {
    const int h = unit & 7, c = (unit >> 3) & 15, b = unit >> 7, g = h >> 2, l0 = c * 128, l31 = lane & 31, hi = lane >> 5;
    const size_t m0 = (size_t)b * SEQ + l0;
    const float A = -expf(a_log[h]), D = dsk[h];
    const float d0 = dt[(m0 + lane) * 8 + h], d1 = dt[(m0 + 64 + lane) * 8 + h];
    float ac0 = d0 * A, ac1 = d1 * A;
    scan128(ac0, ac1, lane);
    tab[lane] = ac0; tab[64 + lane] = ac1; tab[128 + lane] = d0; tab[192 + lane] = d1;
    WSYNC();
    const bf16_t* Cp = xbc + (m0 + l31) * 1024 + 768 + g * 128 + 8 * hi;
    const bf16_t* Sp = stb + (size_t)unit * 8192 + l31 * 128 + 8 * hi;
    const bf16_t* Bp = xbc + (m0 + l31) * 1024 + 512 + g * 128 + 8 * hi;
    const bf16_t* Xp = xst + ((size_t)(b * 8 + h) * 64 + l31) * SEQ + l0 + 4 * hi;
    LAS float* tr = tab + 256;
    const int row = lane >> 1, p0 = (lane & 1) * 16;
#pragma unroll 1
    for (int lt = 0; lt < 4; ++lt) {
        f32x16 y[2];
#pragma unroll
        for (int r = 0; r < 16; ++r) { y[0][r] = 0.f; y[1][r] = 0.f; }
        const float acl = tab[32 * lt + l31];
#pragma unroll 4
        for (int kk = 0; kk < 8; ++kk) {
            const bf16x8 cf = *(const bf16x8*)(Cp + (size_t)lt * 32 * 1024 + 16 * kk);
            const bf16x8 s0 = *(const bf16x8*)(Sp + 16 * kk), s1 = *(const bf16x8*)(Sp + 32 * 128 + 16 * kk);
            y[0] = MFMA32(s0, cf, y[0]); y[1] = MFMA32(s1, cf, y[1]);
        }
        { const float el = __expf(acl);
#pragma unroll
          for (int r = 0; r < 16; ++r) { y[0][r] *= el; y[1][r] *= el; } }
#pragma unroll 1
        for (int st = 0; st <= lt; ++st) {
            f32x16 cbt;
#pragma unroll
            for (int r = 0; r < 16; ++r) cbt[r] = 0.f;
#pragma unroll 4
            for (int kk = 0; kk < 8; ++kk) { const bf16x8 bf_ = *(const bf16x8*)(Bp + (size_t)st * 32 * 1024 + 16 * kk), cf_ = *(const bf16x8*)(Cp + (size_t)lt * 32 * 1024 + 16 * kk); cbt = MFMA32(bf_, cf_, cbt); }
#pragma unroll
            for (int r = 0; r < 16; ++r) { const int sl = 32 * st + crow(r, hi); const float acs = tab[sl], dts = tab[128 + sl];
                float v = cbt[r] * __expf(acl - acs) * dts; if (st == lt && crow(r, hi) > l31) v = 0.f; cbt[r] = v; }
            bf16x8 pf[2];
#pragma unroll
            for (int ks = 0; ks < 2; ++ks) { v4u w; w.x = cvtpk(cbt[8 * ks], cbt[8 * ks + 1]); w.y = cvtpk(cbt[8 * ks + 2], cbt[8 * ks + 3]); w.z = cvtpk(cbt[8 * ks + 4], cbt[8 * ks + 5]); w.w = cvtpk(cbt[8 * ks + 6], cbt[8 * ks + 7]); pf[ks] = __builtin_bit_cast(bf16x8, w); }
#pragma unroll
            for (int pt = 0; pt < 2; ++pt)
#pragma unroll
                for (int ks = 0; ks < 2; ++ks) { const bf16_t* xp = Xp + (size_t)pt * 32 * SEQ + st * 32 + 16 * ks; const u32x2 x0 = *(const u32x2*)xp, x1 = *(const u32x2*)(xp + 8);
                    v4u a; a.x = x0.x; a.y = x0.y; a.z = x1.x; a.w = x1.y; y[pt] = MFMA32(__builtin_bit_cast(bf16x8, a), pf[ks], y[pt]); }
        }
#pragma unroll
        for (int pt = 0; pt < 2; ++pt) {
#pragma unroll
            for (int r = 0; r < 16; ++r) tr[l31 * 33 + crow(r, hi)] = y[pt][r];
            WSYNC();
            const size_t m = m0 + 32 * lt + row;
            const v4u xa = *(const v4u*)(xbc + m * 1024 + h * 64 + 32 * pt + p0), xb = *(const v4u*)(xbc + m * 1024 + h * 64 + 32 * pt + p0 + 8);
            const unsigned xu[8] = {xa.x, xa.y, xa.z, xa.w, xb.x, xb.y, xb.z, xb.w};
            unsigned ow[8];
#pragma unroll
            for (int q = 0; q < 8; ++q) { const float v0 = tr[row * 33 + p0 + 2 * q] + D * bflo(xu[q]), v1 = tr[row * 33 + p0 + 2 * q + 1] + D * bfhi(xu[q]); ow[q] = cvtpk(v0, v1); }
            bf16_t* dst = yssm + m * 512 + h * 64 + 32 * pt + p0;
            *(v4u*)dst = (v4u){ow[0], ow[1], ow[2], ow[3]}; *(v4u*)(dst + 8) = (v4u){ow[4], ow[5], ow[6], ow[7]};
            WSYNC();
        }
    }
}

struct Args { const float* in[43]; float* out; unsigned char* ws; };
#define GEMM_PHASE(EPI, Aptr, LDA, Bptr, LDB, NN, KK, ...) do { pg8::Gemm g_{(Aptr), (Bptr), M, (NN), (KK), (LDA), (LDB)}; pg8::StaticOrder S_; S_.init(M, (NN), G, (int)blockIdx.x); \
        pg8::EPI E_{__VA_ARGS__}; pg8::gemm_phase<pg8::EPI, pg8::StaticOrder, true, true>(lds3, g_, S_, E_); } while (0)

__global__ void __launch_bounds__(NWAVES * 64, 2) fwd_mega(Args args) {
    extern __shared__ __attribute__((aligned(16))) unsigned char lds[];
    LAS unsigned char* lds3 = (LAS unsigned char*)lds;
    volatile LAS unsigned* MISC = (volatile LAS unsigned*)(lds3 + MISC_OFF);
    const int G = gridDim.x, NGW = G * NWAVES, NT = G * NWAVES * 64;
#define PHASE_IDS() int tid = threadIdx.x; asm volatile("" : "+v"(tid)); const int lane = tid & 63, wave = __builtin_amdgcn_readfirstlane(tid >> 6); const int gw = blockIdx.x * NWAVES + wave, gtid = blockIdx.x * (NWAVES * 64) + tid; (void)lane; (void)gw; (void)gtid
    unsigned char* ws = args.ws;
    gu32* ctl = (gu32*)(ws + WS_CTL);
    for (int u = threadIdx.x; u < (LDS_BYTES - LDSCTL_OFF) / 4; u += NWAVES * 64) ((LAS unsigned*)(lds3 + LDSCTL_OFF))[u] = 0u;
    __syncthreads();
    XcdBarrier bar = xcd_barrier_post((unsigned*)(ctl + CW_BAR), MISC + 8);
#define GRID_BAR() xcd_barrier(bar)
#define IN(i) (args.in[i])
    float* out = args.out;
    bf16_t* W0in = (bf16_t*)(ws + WS_W0IN); bf16_t* W0out = (bf16_t*)(ws + WS_W0OUT); bf16_t* Wup0 = (bf16_t*)(ws + WS_WUP0); bf16_t* Wdn0 = (bf16_t*)(ws + WS_WDN0);
    bf16_t* W1in = (bf16_t*)(ws + WS_W1IN); bf16_t* Wuq = (bf16_t*)(ws + WS_WUQ); bf16_t* Wukv = (bf16_t*)(ws + WS_WUKV); bf16_t* W1out = (bf16_t*)(ws + WS_W1OUT);
    bf16_t* Wup1 = (bf16_t*)(ws + WS_WUP1); bf16_t* Wdn1 = (bf16_t*)(ws + WS_WDN1);
    bf16_t* XB = (bf16_t*)(ws + WS_XB); bf16_t* YMIX = (bf16_t*)(ws + WS_YMIX); bf16_t* PROJ0 = (bf16_t*)(ws + WS_BIG);
    float* YRAW = out; bf16_t* YSSM = (bf16_t*)(out + (size_t)M * 512); bf16_t* STB = (bf16_t*)(out + (size_t)M * 768); bf16_t* XST = (bf16_t*)(ws + WS_XST); bf16_t* BT = (bf16_t*)(ws + WS_BT); float* ASUM = (float*)(ws + WS_ASUM); float* SLOC = (float*)(ws + WS_SLOC); float* DT = (float*)(ws + WS_DT); bf16_t* GB = (bf16_t*)(ws + WS_G); float* BONUS = (float*)(ws + WS_BONUS);
    bf16_t* W2T = (bf16_t*)(ws + WS_W2T); bf16_t* A2T = (bf16_t*)(ws + WS_A2T); bf16_t* G2T = (bf16_t*)(ws + WS_G2T); bf16_t* GU = (bf16_t*)(ws + WS_GU);
    bf16_t* PROJ1 = (bf16_t*)(ws + WS_PROJ1); bf16_t* QM = (bf16_t*)(ws + WS_QM); bf16_t* KVM = (bf16_t*)(ws + WS_KVM); bf16_t* KPE = (bf16_t*)(ws + WS_KPE); float* RS = (float*)(ws + WS_RS); bf16_t* VTS = (bf16_t*)(ws + WS_VTS); bf16_t* VTM = (bf16_t*)(ws + WS_VTM);
    const int* pos = (const int*)args.in[1];

    {
        PHASE_IDS();
    {
        LAS float* scr = (LAS float*)(lds3 + wave * 16384);
        transpose_matrix(IN(2), 1024, 3336, W0in, L0P, 1024, scr, gw, NGW, lane, nullptr);
        transpose_matrix(IN(20), 1024, 1024, W0out, 1024, 1024, scr, gw, NGW, lane, nullptr);
        transpose_matrix(IN(23), 1024, 5632, Wup0, 5632, 1024, scr, gw, NGW, lane, nullptr);
        transpose_matrix(IN(26), 2816, 1024, Wdn0, 1024, 2816, scr, gw, NGW, lane, nullptr);
        transpose_matrix(IN(29), 1024, 1952, W1in, L1P, 1024, scr, gw, NGW, lane, nullptr);
        transpose_matrix(IN(31), 256, 768, Wuq, 768, 256, scr, gw, NGW, lane, IN(30));
        transpose_matrix(IN(33), 128, 1024, Wukv, 1024, 256, scr, gw, NGW, lane, IN(32));
        for (int i = gtid; i < 1024 * 16; i += NT) { const int n = i >> 4, c = i & 15; *(v4u*)(Wukv + (size_t)n * 256 + 128 + c * 8) = (v4u){0u, 0u, 0u, 0u}; }
        transpose_matrix(IN(34), 1024, 1024, W1out, 1024, 1024, scr, gw, NGW, lane, nullptr);
        transpose_matrix(IN(37), 1024, 5632, Wup1, 5632, 1024, scr, gw, NGW, lane, nullptr);
        transpose_matrix(IN(40), 2816, 1024, Wdn1, 1024, 2816, scr, gw, NGW, lane, nullptr);
        transpose_matrix(IN(5), 64, 512, W2T, 512, 64, scr, gw, NGW, lane, nullptr);
        transpose_matrix(IN(7), 64, 512, A2T, 512, 64, scr, gw, NGW, lane, nullptr);
        transpose_matrix(IN(8), 128, 512, G2T, 512, 128, scr, gw, NGW, lane, nullptr);
        const float* x = IN(0);
        for (size_t i = (size_t)gtid * 4; i < (size_t)M * DM; i += (size_t)NT * 4) { const f32x4 v = *(const f32x4*)(x + i); uint2 w; w.x = pk2(v[0], v[1]); w.y = pk2(v[2], v[3]); *(uint2*)(XB + i) = w; }
    }
    }
    GRID_BAR();
    {
        PHASE_IDS();
    GEMM_PHASE(EpiBf16S, XB, DM, W0in, 1024, L0P, 1024, PROJ0, nullptr, L0P, 0);
    }
    GRID_BAR();
    {
        PHASE_IDS();
        const int blk = (int)blockIdx.x, m0 = blk * 128;
        {   LAS bf16_t* scr = (LAS bf16_t*)(lds3 + wave * 16384);
#pragma unroll 1
            for (int k = 0; k < 4; ++k) ssd_conv_tile((2 * blk + (k & 1)) * 16 + wave + 8 * (k >> 1), lane, scr, PROJ0, IN(14), IN(15), XB, XST, BT);
            for (int i = tid; i < 1024; i += NWAVES * 64) { const int m = m0 + (i >> 3); DT[(size_t)m * 8 + (i & 7)] = softplusf_(bf2f(PROJ0[(size_t)m * L0P + 3328 + (i & 7)]) + IN(16)[i & 7]); }
        }
        __syncthreads();
        ssd_s1_unit(blk * 8 + wave, lane, (LAS float*)(lds3 + wave * 16384), XST, BT, DT, IN(17), SLOC, ASUM);
    }
    GRID_BAR();
    {
        PHASE_IDS();
        ssd_s2_all(SLOC, ASUM, STB, gtid, NT);
        rwkv_phase((LAS float*)lds3, tid, lane, wave, (int)blockIdx.x, PROJ0, IN(3), IN(4), IN(6), IN(9), IN(10), IN(11), W2T, A2T, G2T, YRAW, GB, BONUS);
    }
    GRID_BAR();
    {
        PHASE_IDS();
        const int blk = (int)blockIdx.x;
        ssd_s3_unit(blk * 8 + wave, lane, (LAS float*)(lds3 + wave * 16384), XB, XST, STB, DT, IN(17), IN(18), YSSM);
        __syncthreads();
        ssm_gate_norm_all(YSSM, PROJ0, IN(19), YMIX, blk * 256 + wave, blk * 256 + 256, lane);
        rwkv_post_all(YRAW, PROJ0, IN(3), BONUS, GB, IN(12), IN(13), YMIX, gw, NGW, lane);
    }
    GRID_BAR();
    {
        PHASE_IDS();
    GEMM_PHASE(EpiResid, YMIX, DM, W0out, 1024, 1024, 1024, IN(0), out, ALPHA, 0);
    }
    GRID_BAR();
    {
        PHASE_IDS();
    ln_rows(out, XB, IN(21), IN(22), gw, NGW, lane);
    }
    GRID_BAR();
    {
        PHASE_IDS();
    GEMM_PHASE(EpiBf16S, XB, DM, Wup0, 1024, 2 * DFF, 1024, GU, nullptr, 2 * DFF, 0);
    }
    GRID_BAR();
    {
        PHASE_IDS();
    ffn_act_all(GU, IN(24), IN(25), gtid, NT);
    }
    GRID_BAR();
    {
        PHASE_IDS();
    GEMM_PHASE(EpiResid, GU + DFF, 2 * DFF, Wdn0, DFF, 1024, DFF, out, out, ALPHA, 0);
    }
    GRID_BAR();
    {
        PHASE_IDS();
    ln_rows(out, XB, IN(27), IN(28), gw, NGW, lane);
    }
    GRID_BAR();
    {
        PHASE_IDS();
    GEMM_PHASE(EpiBf16S, XB, DM, W1in, 1024, L1P, 1024, PROJ1, nullptr, L1P, 0);
    }
    GRID_BAR();
    {
        PHASE_IDS();
    mla_prep_all(PROJ1, pos, RS, KPE, gw, NGW, lane);
    }
    GRID_BAR();
    {
        PHASE_IDS();
    GEMM_PHASE(EpiBf16S, PROJ1 + 1536, L1P, Wuq, 256, 768, 256, QM, RS, 768, 2);
    GEMM_PHASE(EpiBf16S, PROJ1 + 1792, L1P, Wukv, 256, 1024, 256, KVM, RS + 1, 1024, 2);
    }
    GRID_BAR();
    {
        PHASE_IDS();
    rope_q_all(QM, pos, gtid, NT);
    {
        LAS bf16_t* scr = (LAS bf16_t*)(lds3 + wave * 16384);
        for (int it = gw; it < 8192; it += NGW) { const int which = it >> 12, r = it & 4095, bh = r >> 5, tt = r & 31, b = bh >> 3, h = bh & 7;
            if (which == 0) transpose_tile64(PROJ1 + ((size_t)b * SEQ + tt * 64) * L1P + 1024 + h * 64, L1P, VTS + (size_t)bh * 64 * SEQ + tt * 64, SEQ, scr, lane);
            else            transpose_tile64(KVM + ((size_t)b * SEQ + tt * 64) * 1024 + h * 128 + 64, 1024, VTM + (size_t)bh * 64 * SEQ + tt * 64, SEQ, scr, lane); }
    }
    }
    GRID_BAR();
    {
        PHASE_IDS();
    {
        LAS bf16_t* stg = (LAS bf16_t*)(lds3 + wave * 16384);
        for (int g2 = gw; g2 < 2048; g2 += NGW) { const int bh = g2 >> 4, w = g2 & 15;
#pragma unroll 1
            for (int i = 0; i < 4; ++i) { const int qb = (i == 0) ? w : (i == 1) ? 31 - w : (i == 2) ? 32 + w : 63 - w;
                sb_task(bh, qb, lane, PROJ1, VTS, YMIX, stg);
                mla_task(bh, qb, lane, QM, KVM, KPE, VTM, YMIX, stg); } }
    }
    }
    GRID_BAR();
    {
        PHASE_IDS();
    GEMM_PHASE(EpiResid, YMIX, DM, W1out, 1024, 1024, 1024, out, out, ALPHA, 0);
    }
    GRID_BAR();
    {
        PHASE_IDS();
    ln_rows(out, XB, IN(35), IN(36), gw, NGW, lane);
    }
    GRID_BAR();
    {
        PHASE_IDS();
    GEMM_PHASE(EpiBf16S, XB, DM, Wup1, 1024, 2 * DFF, 1024, GU, nullptr, 2 * DFF, 0);
    }
    GRID_BAR();
    {
        PHASE_IDS();
    ffn_act_all(GU, IN(38), IN(39), gtid, NT);
    }
    GRID_BAR();
    {
        PHASE_IDS();
    GEMM_PHASE(EpiResid, GU + DFF, 2 * DFF, Wdn1, DFF, 1024, DFF, out, out, ALPHA, 0);
    }
    GRID_BAR();
    {
        PHASE_IDS();
    ln_rows(out, XB, IN(41), IN(42), gw, NGW, lane);
    }
}

extern "C" void kernel_launch(void* const* d_in, const int* in_sizes, int n_in, void* d_out, int out_size, void* d_ws, size_t ws_size, hipStream_t stream) {
    static int grid = 0;
    if (grid == 0) {
        if (n_in != 43 || ws_size < WS_NEED || out_size != M * DM) { fprintf(stderr, "kernel_launch: unexpected n_in %d / ws %zu / out %d\n", n_in, ws_size, out_size); grid = -1; return; }
        int dev = 0, cus = 0, per_cu = 0;
        if (hipGetDevice(&dev) != hipSuccess || hipDeviceGetAttribute(&cus, hipDeviceAttributeMultiprocessorCount, dev) != hipSuccess) { grid = -1; return; }
        if (hipFuncSetAttribute((const void*)fwd_mega, hipFuncAttributeMaxDynamicSharedMemorySize, LDS_BYTES) != hipSuccess) { fprintf(stderr, "kernel_launch: hipFuncSetAttribute failed\n"); grid = -1; return; }
        if (hipOccupancyMaxActiveBlocksPerMultiprocessor(&per_cu, (const void*)fwd_mega, NWAVES * 64, LDS_BYTES) != hipSuccess || per_cu < 1) fprintf(stderr, "kernel_launch: occupancy query reports %d\n", per_cu);
        (void)hipGetLastError();
        grid = cus;
    }
    if (grid < 0) return;
    (void)hipMemsetAsync((char*)d_ws + WS_CTL, 0, CTL_ZERO_BYTES, stream);
    Args a{};
    for (int i = 0; i < 43; ++i) a.in[i] = (const float*)d_in[i];
    a.out = (float*)d_out; a.ws = (unsigned char*)d_ws;
    hipLaunchKernelGGL(fwd_mega, dim3(grid), dim3(NWAVES * 64), LDS_BYTES, stream, a);
}
```

```cpp
#include <hip/hip_runtime.h>
#include <cstdio>
#include <cstdint>
#include <cmath>
namespace pg8 {
#define PG8_LAS __attribute__((address_space(3)))
typedef unsigned short bf16_t;
typedef short bf16x8 __attribute__((ext_vector_type(8)));
typedef float f32x4 __attribute__((ext_vector_type(4)));
typedef unsigned u32x4 __attribute__((ext_vector_type(4)));
constexpr int BM = 256, BK = 64, HALF = 128, HTB = HALF * BK * 2  , STAGE_BYTES = 8 * HTB, NXCD = 8, WGM = 8;

__host__ __device__ __forceinline__ int lds_byte(int r, int c) { const int st = (r >> 4) * 2 + (c >> 5), rr = r & 15, cc = c & 31, ob = rr * 64 + cc * 2; return st * 1024 + (ob ^ (((ob >> 9) & 1) << 5)); }
__host__ __device__ __forceinline__ void stage_rc(int b, int& R, int& C) { const int st = b / 1024, sb = b % 1024, swz = sb ^ (((sb >> 9) & 1) << 5); R = (st >> 1) * 16 + swz / 64; C = (st & 1) * 32 + (swz % 64) / 2; }
__host__ __device__ __forceinline__ int perm32(int rho) { const int n = rho >> 4, i = rho & 15; return 8 * (i >> 2) + 4 * n + (i & 3); }

struct Unit { int pm, pn; };
struct Gemm { const bf16_t* A; const bf16_t* Bt; int M, N, K, lda, ldb; };

struct StaticOrder {
    int nM, nN, nwg, G, c;
    __host__ __device__ void init(int M, int N, int G_, int c_) { nM = M / BM; nN = N / BM; nwg = nM * nN; G = G_; c = c_; }
    __host__ __device__ bool next(int i, Unit& u) const {
        const long L = (long)i * G + c; if (L >= nwg) return false;
        int wgid = (int)L; { const int q = nwg / NXCD, r = nwg % NXCD, xcd = wgid % NXCD, off = wgid / NXCD; wgid = (xcd < r ? xcd * (q + 1) : r * (q + 1) + (xcd - r) * q) + off; }
        const int nig = WGM * nN, gid = wgid / nig, fm = gid * WGM, gsz = (nM - fm) < WGM ? (nM - fm) : WGM;
        u.pm = fm + ((wgid % nig) % gsz); u.pn = (wgid % nig) / gsz; return true;
    }
    __device__ __forceinline__ void a_ready(const Unit&) const {}
    __device__ __forceinline__ void done(const Unit&) const {}
};


__device__ __forceinline__ unsigned cvt_pk_bf16(float lo, float hi) { unsigned r; asm volatile("v_cvt_pk_bf16_f32 %0, %1, %2" : "=v"(r) : "v"(lo), "v"(hi)); return r; }
struct EpiBf16S {
    static constexpr bool PERM = true, AFTER_DRAIN = false;
    bf16_t* O; const float* rowscale; int ldc; int rs_stride;
    __device__ __forceinline__ void operator()(const f32x4 (&acc)[2][2][4][2], const Unit& u, int wr, int wc, int fr, int fq) const {
        const int row0 = u.pm * BM + wr * 64 + fr, col0 = u.pn * BM + wc * 32 + 8 * fq;
#pragma unroll
        for (int ai = 0; ai < 2; ++ai)
#pragma unroll
            for (int m = 0; m < 4; ++m) { const int row = row0 + ai * HALF + m * 16; const float sc = rowscale ? rowscale[(size_t)row * rs_stride] : 1.f;
                bf16_t* rowp = O + (size_t)row * ldc + col0;
#pragma unroll
                for (int bj = 0; bj < 2; ++bj) { const f32x4 v0 = acc[ai][bj][m][0] * sc, v1 = acc[ai][bj][m][1] * sc;
                    u32x4 w; w.x = cvt_pk_bf16(v0[0], v0[1]); w.y = cvt_pk_bf16(v0[2], v0[3]); w.z = cvt_pk_bf16(v1[0], v1[1]); w.w = cvt_pk_bf16(v1[2], v1[3]);
                    *(u32x4*)(rowp + bj * HALF) = w; } }
    }
};
struct EpiResid {
    static constexpr bool PERM = false, AFTER_DRAIN = false;
    const float* hin; float* hout; float alpha; int pad;
    __device__ __forceinline__ void operator()(const f32x4 (&acc)[2][2][4][2], const Unit& u, int wr, int wc, int fr, int fq) const {
        const int row0 = u.pm * BM + wr * 64 + fr, col0 = u.pn * BM + wc * 32 + 4 * fq;
#pragma unroll
        for (int ai = 0; ai < 2; ++ai)
#pragma unroll
            for (int m = 0; m < 4; ++m) { const size_t off = (size_t)(row0 + ai * HALF + m * 16) * 1024 + col0;
#pragma unroll
                for (int bj = 0; bj < 2; ++bj)
#pragma unroll
                    for (int n = 0; n < 2; ++n) { const size_t i = off + bj * HALF + n * 16; const f32x4 h = *(const f32x4*)(hin + i); *(f32x4*)(hout + i) = h * alpha + acc[ai][bj][m][n]; } }
    }
};
template <class Epi, class Sched, bool ALIGN_EPI = false, bool SP2 = false>
__device__ __forceinline__ void gemm_phase(PG8_LAS unsigned char* lds, const Gemm g, const Sched& S, const Epi& E) {
    const int tid = threadIdx.x, wid = __builtin_amdgcn_readfirstlane(tid >> 6), lane = tid & 63, wr = wid >> 2, wc = wid & 3, fr = lane & 15, fq = lane >> 4;
    const int K = g.K, nt = K / BK;
    unsigned voffA[2], voffB[2];
#pragma unroll
    for (int i = 0; i < 2; ++i) { int R, C; stage_rc(tid * 16 + i * 8192, R, C); const int Rb = Epi::PERM ? ((R & ~31) + perm32(R & 31)) : R;
        voffA[i] = (unsigned)(R * g.lda + C) * 2u; voffB[i] = (unsigned)(Rb * g.ldb + C) * 2u; }
    const size_t kstep = (size_t)(BK * 2);
    const size_t hstepA = (size_t)HALF * g.lda * 2, hstepB = (size_t)HALF * g.ldb * 2;
    const size_t tstepA = 2 * hstepA, tstepB = 2 * hstepB;
    const unsigned ldsw = (unsigned)wid * 1024u;
    const int aoff = lds_byte(wr * 64 + fr, fq * 8), boff = lds_byte(wc * 32 + fr, fq * 8);
#define PG8_SA(b, h) (((b) * 2 + (h)) * HTB)
#define PG8_SB(b, h) ((4 + (b) * 2 + (h)) * HTB)
#define PG8_STAGE(bufoff, gbase, voff) do { _Pragma("unroll") for (int _i = 0; _i < 2; ++_i) \
        __builtin_amdgcn_global_load_lds((const unsigned*)((const char*)(gbase) + (voff)[_i]), (PG8_LAS unsigned*)(lds + (bufoff) + ldsw + _i * 8192), 16, 0, 0); } while (0)
#define PG8_LDA(dst, b, h) do { _Pragma("unroll") for (int m = 0; m < 4; ++m) _Pragma("unroll") for (int k = 0; k < 2; ++k) dst[m][k] = *(const PG8_LAS bf16x8*)(lds + PG8_SA(b, h) + aoff + m * 2048 + k * 1024); } while (0)
#define PG8_LDB(dst, b, h) do { _Pragma("unroll") for (int n = 0; n < 2; ++n) _Pragma("unroll") for (int k = 0; k < 2; ++k) dst[n][k] = *(const PG8_LAS bf16x8*)(lds + PG8_SB(b, h) + boff + n * 2048 + k * 1024); } while (0)
#define PG8_MMA(ai, bj, At, Bt) do { __builtin_amdgcn_s_setprio(1); _Pragma("unroll") for (int m = 0; m < 4; ++m) _Pragma("unroll") for (int n = 0; n < 2; ++n) _Pragma("unroll") for (int k = 0; k < 2; ++k) \
        acc[ai][bj][m][n] = __builtin_amdgcn_mfma_f32_16x16x32_bf16(Bt[n][k], At[m][k], acc[ai][bj][m][n], 0, 0, 0); __builtin_amdgcn_s_setprio(0); } while (0)
#define PG8_WAIT_V(n) asm volatile("s_waitcnt vmcnt(" #n ")" ::: "memory")
#define PG8_WAIT_L(n) asm volatile("s_waitcnt lgkmcnt(" #n ")" ::: "memory")
#define PG8_BAR __builtin_amdgcn_s_barrier()
#define PG8_SCHED __builtin_amdgcn_sched_barrier(0)
    Unit cur, nxt; int ui = 0;
    if (!S.next(0, cur)) return;
    f32x4 acc[2][2][4][2];
#pragma unroll
    for (int a = 0; a < 2; ++a)
#pragma unroll
        for (int b = 0; b < 2; ++b)
#pragma unroll
            for (int m = 0; m < 4; ++m)
#pragma unroll
                for (int n = 0; n < 2; ++n) acc[a][b][m][n] = (f32x4){0.f, 0.f, 0.f, 0.f};
    bf16x8 At[4][2], B0[2][2], B1[2][2];
    const char* cA = (const char*)g.A + (size_t)cur.pm * tstepA; const char* cB = (const char*)g.Bt + (size_t)cur.pn * tstepB;
    S.a_ready(cur);
    if constexpr (SP2) {
        PG8_STAGE(PG8_SB(0, 0), cB, voffB); PG8_STAGE(PG8_SB(0, 1), cB + hstepB, voffB); PG8_STAGE(PG8_SA(0, 0), cA, voffA); PG8_STAGE(PG8_SA(0, 1), cA + hstepA, voffA);
        if (wr == 1) PG8_BAR;
        PG8_WAIT_V(2); PG8_BAR;
        PG8_STAGE(PG8_SB(1, 0), cB + kstep, voffB); PG8_STAGE(PG8_SA(1, 0), cA + kstep, voffA); PG8_STAGE(PG8_SB(1, 1), cB + hstepB + kstep, voffB);
        PG8_WAIT_V(6); PG8_BAR;
    } else {
        PG8_STAGE(PG8_SB(0, 0), cB, voffB); PG8_STAGE(PG8_SA(0, 0), cA, voffA); PG8_STAGE(PG8_SB(0, 1), cB + hstepB, voffB); PG8_STAGE(PG8_SA(0, 1), cA + hstepA, voffA);
        if (wr == 1) PG8_BAR;
        PG8_WAIT_V(4); PG8_BAR;
        PG8_STAGE(PG8_SB(1, 0), cB + kstep, voffB); PG8_STAGE(PG8_SA(1, 0), cA + kstep, voffA); PG8_STAGE(PG8_SB(1, 1), cB + hstepB + kstep, voffB);
        PG8_WAIT_V(6); PG8_BAR;
    }
    for (;;) {
        const bool has_next = S.next(ui + 1, nxt);
        const char* nA = has_next ? (const char*)g.A + (size_t)nxt.pm * tstepA : cA; const char* nB = has_next ? (const char*)g.Bt + (size_t)nxt.pn * tstepB : cB;
        for (int t = 0; t < nt; t += 2) {
            const bool last = (t == nt - 2);
            const char* a1 = cA + (size_t)(t + 1) * kstep;
            const char* a2 = last ? nA : cA + (size_t)(t + 2) * kstep; const char* b2 = last ? nB : cB + (size_t)(t + 2) * kstep;
            const char* a3 = a2 + kstep; const char* b3 = b2 + kstep;
            if (last && has_next) S.a_ready(nxt);
            if constexpr (SP2) {
            PG8_LDB(B0, 0, 0); PG8_LDB(B1, 0, 1); PG8_SCHED; PG8_LDA(At, 0, 0); PG8_STAGE(PG8_SA(1, 1), a1 + hstepA, voffA);
            PG8_WAIT_V(8); PG8_WAIT_L(0); PG8_BAR; PG8_MMA(0, 0, At, B0); PG8_MMA(0, 1, At, B1); PG8_BAR; PG8_SCHED;
            PG8_LDA(At, 0, 1); PG8_STAGE(PG8_SB(0, 0), b2, voffB); PG8_STAGE(PG8_SB(0, 1), b2 + hstepB, voffB); PG8_STAGE(PG8_SA(0, 0), a2, voffA);
            PG8_WAIT_V(8); PG8_WAIT_L(0); PG8_BAR; PG8_MMA(1, 0, At, B0); PG8_MMA(1, 1, At, B1); PG8_BAR; PG8_SCHED;
            PG8_LDB(B0, 1, 0); PG8_LDB(B1, 1, 1); PG8_SCHED; PG8_LDA(At, 1, 0); PG8_STAGE(PG8_SA(0, 1), a2 + hstepA, voffA);
            PG8_WAIT_V(8); PG8_WAIT_L(0); PG8_BAR; PG8_MMA(0, 0, At, B0); PG8_MMA(0, 1, At, B1); PG8_BAR; PG8_SCHED;
            PG8_LDA(At, 1, 1); PG8_STAGE(PG8_SB(1, 0), b3, voffB); PG8_STAGE(PG8_SB(1, 1), b3 + hstepB, voffB); PG8_STAGE(PG8_SA(1, 0), a3, voffA);
            PG8_WAIT_V(8); PG8_WAIT_L(0); PG8_BAR; PG8_MMA(1, 0, At, B0); PG8_MMA(1, 1, At, B1); PG8_BAR; PG8_SCHED;
            } else {
            PG8_LDB(B0, 0, 0); PG8_SCHED; PG8_LDA(At, 0, 0); PG8_STAGE(PG8_SA(1, 1), a1 + hstepA, voffA);
            PG8_WAIT_L(8); PG8_BAR; PG8_WAIT_L(0); PG8_MMA(0, 0, At, B0); PG8_BAR; PG8_SCHED;
            PG8_LDB(B1, 0, 1); PG8_STAGE(PG8_SB(0, 0), b2, voffB);
            PG8_BAR; PG8_WAIT_L(0); PG8_MMA(0, 1, At, B1); PG8_BAR;
            PG8_LDA(At, 0, 1); PG8_STAGE(PG8_SA(0, 0), a2, voffA);
            PG8_BAR; PG8_WAIT_L(0); PG8_MMA(1, 0, At, B0); PG8_BAR; PG8_SCHED;
            PG8_STAGE(PG8_SB(0, 1), b2 + hstepB, voffB);
            PG8_WAIT_V(6); PG8_BAR; PG8_MMA(1, 1, At, B1); PG8_BAR;
            PG8_LDB(B0, 1, 0); PG8_SCHED; PG8_LDA(At, 1, 0); PG8_STAGE(PG8_SA(0, 1), a2 + hstepA, voffA);
            PG8_WAIT_L(8); PG8_BAR; PG8_WAIT_L(0); PG8_MMA(0, 0, At, B0); PG8_BAR; PG8_SCHED;
            PG8_LDB(B1, 1, 1); PG8_STAGE(PG8_SB(1, 0), b3, voffB);
            PG8_BAR; PG8_WAIT_L(0); PG8_MMA(0, 1, At, B1); PG8_BAR;
            PG8_LDA(At, 1, 1); PG8_STAGE(PG8_SA(1, 0), a3, voffA);
            PG8_BAR; PG8_WAIT_L(0); PG8_MMA(1, 0, At, B0); PG8_BAR; PG8_SCHED;
            PG8_STAGE(PG8_SB(1, 1), b3 + hstepB, voffB);
            PG8_WAIT_V(6); PG8_BAR; PG8_MMA(1, 1, At, B1); PG8_BAR;
            }
        }
        if constexpr (ALIGN_EPI) { if (wr == 0) PG8_BAR; }
        if constexpr (!Epi::AFTER_DRAIN) { E(acc, cur, wr, wc, fr, fq); S.done(cur); }
        if (!has_next) break;
#pragma unroll
        for (int a = 0; a < 2; ++a)
#pragma unroll
            for (int b = 0; b < 2; ++b)
#pragma unroll
                for (int m = 0; m < 4; ++m)
#pragma unroll
                    for (int n = 0; n < 2; ++n) acc[a][b][m][n] = (f32x4){0.f, 0.f, 0.f, 0.f};
        cur = nxt; cA = nA; cB = nB; ++ui;
        if constexpr (ALIGN_EPI) { if (wr == 1) PG8_BAR; }
    }
    PG8_WAIT_V(0);
    if constexpr (!ALIGN_EPI) { if (wr == 0) PG8_BAR; }
    PG8_BAR;
    if constexpr (Epi::AFTER_DRAIN) { E.fused(acc, cur, wr, wc, fr, fq, lds, wid, lane); S.done(cur); }
#undef PG8_SA
#undef PG8_SB
#undef PG8_STAGE
#undef PG8_LDA
#undef PG8_LDB
#undef PG8_MMA
#undef PG8_WAIT_V
#undef PG8_WAIT_L
#undef PG8_BAR
#undef PG8_SCHED
}
}
#define GAS __attribute__((address_space(1)))
#define LAS __attribute__((address_space(3)))
typedef unsigned short bf16;
typedef unsigned v4u __attribute__((ext_vector_type(4)));
typedef float f32x4 __attribute__((ext_vector_type(4)));
typedef short bf16x8 __attribute__((ext_vector_type(8)));
typedef GAS unsigned gu32;
typedef GAS unsigned long long gu64;
#define RLX_AGENT __ATOMIC_RELAXED, __HIP_MEMORY_SCOPE_AGENT
#define LDS_WAIT() asm volatile("s_waitcnt lgkmcnt(0)" ::: "memory")
#define VM_WAIT() asm volatile("s_waitcnt vmcnt(0)" ::: "memory")
__device__ __forceinline__ unsigned long long rt() { return __builtin_amdgcn_s_memrealtime(); }
__device__ __forceinline__ unsigned f2bf(float f) { unsigned u = __builtin_bit_cast(unsigned, f); return (u + 0x7fffu + ((u >> 16) & 1u)) >> 16; }
__device__ __forceinline__ unsigned pk2(float lo, float hi) { return f2bf(lo) | (f2bf(hi) << 16); }

#define XB_TMO      128
#define XB_XCNT(j)  (256  + 64 * (j))
#define XB_XSUB(j)  (1280 + 64 * (j))
#define XB_XGEN(j)  (2304 + 64 * (j))
#define XB_TOP      3328
#define XB_TOPGEN   3392
#define XCD_BAR_WORDS 3456
#define XB_SPIN_CAP (1u << 18)

__device__ __forceinline__ unsigned xb_ld(unsigned* p)              { return __hip_atomic_load(p, __ATOMIC_RELAXED, __HIP_MEMORY_SCOPE_AGENT); }
__device__ __forceinline__ unsigned xb_add(unsigned* p, unsigned v) { return __hip_atomic_fetch_add(p, v, __ATOMIC_RELAXED, __HIP_MEMORY_SCOPE_AGENT); }
__device__ __forceinline__ unsigned xb_xcc_id() { return (unsigned)__builtin_amdgcn_s_getreg((3 << 11) | 20) & 0xFu; }
#define XB_SPIN(cond, bar) do { unsigned _sp = 0; while (cond) { __builtin_amdgcn_s_sleep(1); \
    if ((++_sp & 255u) == 0u) { if (xb_ld(&(bar)[XB_TMO])) break; if (_sp > XB_SPIN_CAP) { atomicAdd(&(bar)[XB_TMO], 1u); break; } } } } while (0)

struct XcdBarrier {
    unsigned* bar; unsigned x;
    volatile LAS unsigned* st;
};

__device__ __forceinline__ XcdBarrier xcd_barrier_post(unsigned* bar, volatile LAS unsigned* st) {
    XcdBarrier b; b.bar = bar; b.x = xb_xcc_id(); b.st = st;
    if (threadIdx.x == 0) (void)xb_add(&bar[XB_XCNT(b.x)], 1u);
    return b;
}
__device__ __forceinline__ void xcd_barrier_complete(unsigned* bar, unsigned x, unsigned& nloc, unsigned& nx) {
    const unsigned G = gridDim.x * gridDim.y * gridDim.z;
    unsigned sum, cnt, mine, sp = 0u;
    for (;;) {
        sum = 0u; cnt = 0u; mine = 0u;
#pragma unroll
        for (unsigned j = 0; j < 16; ++j) { const unsigned c = xb_ld(&bar[XB_XCNT(j)]); sum += c; cnt += (c > 0u) ? 1u : 0u; mine = (j == x) ? c : mine; }
        if (sum == G) break;
        __builtin_amdgcn_s_sleep(1);
        if ((++sp & 255u) == 0u) { if (xb_ld(&bar[XB_TMO])) break; if (sp > XB_SPIN_CAP) { atomicAdd(&bar[XB_TMO], 1u); break; } }
    }
    nloc = mine > 0u ? mine : 1u; nx = cnt > 0u ? cnt : 1u;
}

__device__ __forceinline__ void xcd_barrier(const XcdBarrier& b) {
    asm volatile("s_waitcnt vmcnt(0)" ::: "memory");
    __syncthreads();
    if (threadIdx.x == 0) {
        unsigned* bar = b.bar;
        __builtin_amdgcn_s_waitcnt(0);
        unsigned nloc = b.st[0], nx = b.st[1];
        if (nloc == 0u) { xcd_barrier_complete(bar, b.x, nloc, nx); b.st[0] = nloc; b.st[1] = nx; }
        const unsigned old = xb_add(&bar[XB_XSUB(b.x)], 1u);
        const unsigned gen = old / nloc;
        if (old + 1u == (gen + 1u) * nloc) {
            __builtin_amdgcn_fence(__ATOMIC_RELEASE, "agent");
            asm volatile("s_waitcnt vmcnt(0)" ::: "memory");
            const unsigned og = xb_add(&bar[XB_TOP], 1u);
            const unsigned tg = og / nx;
            if (og + 1u == (tg + 1u) * nx) xb_add(&bar[XB_TOPGEN], 1u);
            else XB_SPIN(xb_ld(&bar[XB_TOPGEN]) == tg, bar);
            __builtin_amdgcn_fence(__ATOMIC_ACQUIRE, "agent");
            xb_add(&bar[XB_XGEN(b.x)], 1u);
            asm volatile("s_waitcnt vmcnt(0)" ::: "memory");
        } else {
            XB_SPIN(xb_ld(&bar[XB_XGEN(b.x)]) == gen, bar);
            __builtin_amdgcn_fence(__ATOMIC_ACQUIRE, "agent");
            asm volatile("s_waitcnt vmcnt(0)" ::: "memory");
        }
    }
    __syncthreads();
}
constexpr int NWAVES = 8;
constexpr int BATCH = 16, SEQ = 2048, DM = 1024, M = BATCH * SEQ;
constexpr int L0P = 3584;
constexpr int L1P = 2048;
constexpr int DFF = 2816;
constexpr float ALPHA = 1.4142135623730951f;
typedef unsigned short bf16_t;
typedef float f32x16 __attribute__((ext_vector_type(16)));

constexpr size_t MiB = 1u << 20;
constexpr size_t WS_CTL = 0, CTL_ZERO_BYTES = 1 * MiB;
constexpr int CW_BAR = 4096;
constexpr size_t WS_W0IN = 2 * MiB, WS_W0OUT = 9 * MiB, WS_WUP0 = 11 * MiB, WS_WDN0 = 22 * MiB, WS_W1IN = 28 * MiB, WS_WUQ = 32 * MiB, WS_WUKV = 33 * MiB,
                 WS_W1OUT = 34 * MiB, WS_WUP1 = 36 * MiB, WS_WDN1 = 47 * MiB;
constexpr size_t WS_XB = 56 * MiB, WS_YMIX = 120 * MiB, WS_BIG = 184 * MiB;
constexpr size_t WS_G = 408 * MiB, WS_BONUS = 440 * MiB, WS_DT = 441 * MiB, WS_XST = 442 * MiB, WS_BT = 474 * MiB, WS_ASUM = 490 * MiB;
constexpr size_t WS_SLOC = 120 * MiB;
constexpr size_t WS_W2T = 53 * MiB, WS_A2T = 53 * MiB + 256 * 1024, WS_G2T = 53 * MiB + 512 * 1024;
constexpr size_t WS_GU = 120 * MiB;
constexpr size_t WS_PROJ1 = 184 * MiB, WS_QM = 312 * MiB, WS_KVM = 360 * MiB, WS_KPE = 424 * MiB, WS_RS = 426 * MiB;
constexpr size_t WS_VTS = 428 * MiB, WS_VTM = 460 * MiB;
constexpr size_t WS_NEED = 492 * MiB;

constexpr int RING_BYTES = 131072;
constexpr int LDSCTL_OFF = 146432, MISC_OFF = LDSCTL_OFF + 320;
constexpr int LDS_BYTES = 147456;

__device__ __forceinline__ float bf2f(bf16_t b) { return __builtin_bit_cast(float, (unsigned)b << 16); }
__device__ __forceinline__ float sigmoidf_(float x) { return 1.f / (1.f + expf(-x)); }
__device__ __forceinline__ float softplusf_(float x) { return fmaxf(x, 0.f) + log1pf(expf(-fabsf(x))); }
__device__ __forceinline__ float siluf_(float x) { return x / (1.f + expf(-x)); }
__device__ __forceinline__ float wave_sum(float v) {
#pragma unroll
    for (int o = 1; o < 64; o <<= 1) v += __shfl_xor(v, o);
    return v;
}
#define WSYNC() asm volatile("s_waitcnt lgkmcnt(0)" ::: "memory")
typedef float f32x2_t __attribute__((ext_vector_type(2)));
typedef __bf16 bf16x2_t __attribute__((ext_vector_type(2)));
typedef unsigned u32x2 __attribute__((ext_vector_type(2)));
__device__ __forceinline__ unsigned cvtpk(float lo, float hi) { f32x2_t v = {lo, hi}; bf16x2_t b = __builtin_convertvector(v, bf16x2_t); return __builtin_bit_cast(unsigned, b); }
__device__ __forceinline__ float bflo(unsigned u) { return __builtin_bit_cast(float, u << 16); }
__device__ __forceinline__ float bfhi(unsigned u) { return __builtin_bit_cast(float, u & 0xffff0000u); }

__device__ __forceinline__ void transpose_item(const float* __restrict__ W, int N, bf16_t* __restrict__ WT, int ldt, LAS float* scr, int kb, int nb, int lane, const float* __restrict__ kscale) {
    const int k0 = 64 * kb, n0 = 32 * nb;
#pragma unroll 8
    for (int i = 0; i < 32; ++i) { const int kk = 2 * i + (lane >> 5), n = n0 + (lane & 31); float v = (n < N) ? W[(size_t)(k0 + kk) * N + n] : 0.f; if (kscale) v *= kscale[k0 + kk]; scr[kk * 33 + (lane & 31)] = v; }
    WSYNC();
    const int c = lane & 7;
#pragma unroll
    for (int j = 0; j < 4; ++j) { const int n = (lane >> 3) + 8 * j; const LAS float* s = scr + (8 * c) * 33 + n;
        v4u o; o.x = pk2(s[0 * 33], s[1 * 33]); o.y = pk2(s[2 * 33], s[3 * 33]); o.z = pk2(s[4 * 33], s[5 * 33]); o.w = pk2(s[6 * 33], s[7 * 33]);
        *(v4u*)(WT + (size_t)(n0 + n) * ldt + k0 + 8 * c) = o; }
    WSYNC();
}
__device__ __forceinline__ void transpose_matrix(const float* W, int K, int N, bf16_t* WT, int Npad, int ldt, LAS float* scr, int gw, int NGW, int lane, const float* kscale) {
    const int nblk = Npad / 32, nit = (K / 64) * nblk;
    for (int it = gw; it < nit; it += NGW) transpose_item(W, N, WT, ldt, scr, it / nblk, it % nblk, lane, kscale);
}

template <bool ST = true> __device__ __forceinline__ void ln_rows(float* h, bf16_t* hb, const float* __restrict__ g, const float* __restrict__ b, int gw, int NGW, int lane) {
    for (int row = gw; row < M; row += NGW) {
        float* p = h + (size_t)row * DM;
        f32x4 v[4]; float s = 0.f;
#pragma unroll
        for (int j = 0; j < 4; ++j) { v[j] = *(const f32x4*)(p + 4 * lane + 256 * j); s += (v[j][0] + v[j][1]) + (v[j][2] + v[j][3]); }
        const float mean = wave_sum(s) * (1.f / DM); float q = 0.f;
#pragma unroll
        for (int j = 0; j < 4; ++j) { v[j] = v[j] - mean; q += (v[j][0] * v[j][0] + v[j][1] * v[j][1]) + (v[j][2] * v[j][2] + v[j][3] * v[j][3]); }
        const float rstd = 1.0f / sqrtf(wave_sum(q) * (1.f / DM) + 1e-5f);
#pragma unroll
        for (int j = 0; j < 4; ++j) {
            const int c = 4 * lane + 256 * j;
            const f32x4 gg = *(const f32x4*)(g + c), bb = *(const f32x4*)(b + c);
            const f32x4 o = v[j] * rstd * gg + bb;
            uint2 w; w.x = pk2(o[0], o[1]); w.y = pk2(o[2], o[3]);
            if (ST) { *(f32x4*)(p + c) = o; *(uint2*)(hb + (size_t)row * DM + c) = w; } else asm volatile("" :: "v"(w.x), "v"(w.y), "v"(o[0]), "v"(o[1]), "v"(o[2]), "v"(o[3]));
        }
    }
}

__device__ __forceinline__ void rwkv_naive_chain(int chain, int lane, LAS float* sm, const bf16_t* __restrict__ proj, const float* __restrict__ mix, const float* __restrict__ w0, const float* __restrict__ w2,
                                                 const float* __restrict__ a0, const float* __restrict__ a2, const float* __restrict__ g2, const float* __restrict__ k_k,
                                                 const float* __restrict__ k_a, const float* __restrict__ r_k, const float* __restrict__ ln_g, const float* __restrict__ ln_b, bf16_t* __restrict__ ymix) {
    LAS float* s_w2 = sm; LAS float* s_a2 = sm + 4096; LAS float* s_g2 = sm + 8192; LAS float* s_tw = sm + 16384; LAS float* s_al = s_tw + 64; LAS float* s_sg = s_tw + 128;
    LAS float* s_w = s_tw + 256; LAS float* s_k = s_tw + 320; LAS float* s_a = s_tw + 384; LAS float* s_b = s_tw + 448; LAS float* s_r = s_tw + 512;
    const int b = chain >> 3, h = chain & 7, c = h * 64 + lane;
    for (int l = 0; l < 64; ++l) { s_w2[l * 64 + lane] = w2[l * 512 + c]; s_a2[l * 64 + lane] = a2[l * 512 + c]; }
    for (int l = 0; l < 128; ++l) s_g2[l * 64 + lane] = g2[l * 512 + c];
    const float mr = mix[c], mk = mix[512 + c], mv = mix[1024 + c], mw = mix[1536 + lane], ma = mix[1600 + lane], mg0 = mix[1664 + lane], mg1 = mix[1728 + lane];
    const float w0c = w0[c], a0c = a0[c], kkc = k_k[c], kac = k_a[c], rkc = r_k[c], lgc = ln_g[c], lbc = ln_b[c];
    float S[64];
#pragma unroll
    for (int j = 0; j < 64; ++j) S[j] = 0.f;
    float pr = 0.f, pk = 0.f, pv = 0.f, pw = 0.f, pa = 0.f, pg0 = 0.f, pg1 = 0.f;
    WSYNC();
    for (int t = 0; t < SEQ; ++t) {
        const bf16_t* row = proj + (size_t)(b * SEQ + t) * L0P;
        const float cr = bf2f(row[c]), ck = bf2f(row[512 + c]), cv = bf2f(row[1024 + c]), cw = bf2f(row[1536 + lane]), ca = bf2f(row[1600 + lane]),
                    cg0 = bf2f(row[1664 + lane]), cg1 = bf2f(row[1728 + lane]);
        const float r_s = cr + (pr - cr) * mr, k_s = ck + (pk - ck) * mk, v_s = cv + (pv - cv) * mv;
        const float wl = cw + (pw - cw) * mw, al = ca + (pa - ca) * ma, g0 = cg0 + (pg0 - cg0) * mg0, g1 = cg1 + (pg1 - cg1) * mg1;
        pr = cr; pk = ck; pv = cv; pw = cw; pa = ca; pg0 = cg0; pg1 = cg1;
        s_tw[lane] = tanhf(wl); s_al[lane] = al; s_sg[lane] = sigmoidf_(g0); s_sg[64 + lane] = sigmoidf_(g1);
        WSYNC();
        float wsum = w0c, asum = a0c, gsum = 0.f;
#pragma unroll 2
        for (int l = 0; l < 64; ++l) { wsum += s_tw[l] * s_w2[l * 64 + lane]; asum += s_al[l] * s_a2[l * 64 + lane]; }
#pragma unroll 2
        for (int l = 0; l < 128; ++l) gsum += s_sg[l] * s_g2[l * 64 + lane];
        const float log_w = -softplusf_(-wsum) - 0.5f;
        const float dec = expf(-expf(log_w));
        const float a = sigmoidf_(asum);
        float kkv = k_s * kkc;
        const float nrm = sqrtf(wave_sum(kkv * kkv));
        kkv = kkv / fmaxf(nrm, 1e-12f);
        const float k2 = k_s * (1.f + (a - 1.f) * kac);
        const float bonus_s = wave_sum(r_s * k2 * rkc);
        s_w[lane] = dec; s_k[lane] = k2; s_a[lane] = -kkv; s_b[lane] = kkv * a; s_r[lane] = r_s;
        WSYNC();
        float sa = 0.f;
#pragma unroll
        for (int j = 0; j < 64; ++j) sa += S[j] * s_a[j];
        float y = 0.f;
#pragma unroll
        for (int j = 0; j < 64; ++j) { S[j] = S[j] * s_w[j] + sa * s_b[j] + v_s * s_k[j]; y += S[j] * s_r[j]; }
        const float mu = wave_sum(y) * (1.f / 64.f);
        const float d = y - mu;
        const float var = wave_sum(d * d) * (1.f / 64.f);
        const float yn = d * (1.0f / sqrtf(var + 64e-5f)) * lgc + lbc;
        const float o = (yn + bonus_s * v_s) * gsum;
        ymix[(size_t)(b * SEQ + t) * DM + c] = (bf16_t)f2bf(o);
        WSYNC();
    }
}

__device__ __forceinline__ void ssm_conv_all(const bf16_t* __restrict__ proj, const float* __restrict__ cw, const float* __restrict__ cb, const float* __restrict__ dtb,
                                             bf16_t* __restrict__ xbc, float* __restrict__ dt, int gtid, int NT) {
    for (size_t i = gtid; i < (size_t)M * 1024; i += NT) {
        const int m = (int)(i >> 10), c = (int)(i & 1023), t = m & (SEQ - 1);
        float acc = cb[c];
#pragma unroll
        for (int k = 0; k < 4; ++k) { const int tt = t - 3 + k; if (tt >= 0) acc += cw[k * 1024 + c] * bf2f(proj[(size_t)(m - 3 + k) * L0P + 2304 + c]); }
        xbc[i] = (bf16_t)f2bf(siluf_(acc));
    }
    for (int i = gtid; i < M * 8; i += NT) dt[i] = softplusf_(bf2f(proj[(size_t)(i >> 3) * L0P + 3328 + (i & 7)]) + dtb[i & 7]);
}
__device__ __forceinline__ void ssd_naive_task(int task, int lane, const bf16_t* __restrict__ xbc, const float* __restrict__ dt, const float* __restrict__ a_log, const float* __restrict__ dsk, float* __restrict__ yssm) {
    const int chain = task >> 2, q = task & 3, b = chain >> 3, h = chain & 7, g = h >> 2, p = q * 16 + (lane >> 2), nq = lane & 3;
    const float A = -expf(a_log[h]), D = dsk[h];
    float st[32];
#pragma unroll
    for (int n = 0; n < 32; ++n) st[n] = 0.f;
    for (int t = 0; t < SEQ; ++t) {
        const size_t m = (size_t)b * SEQ + t;
        const float dtv = dt[m * 8 + h], dA = expf(dtv * A);
        const float x = bf2f(xbc[m * 1024 + h * 64 + p]), xdt = x * dtv;
        const bf16_t* Bp = xbc + m * 1024 + 512 + g * 128 + nq * 32;
        const bf16_t* Cp = xbc + m * 1024 + 768 + g * 128 + nq * 32;
        float yp = 0.f;
#pragma unroll
        for (int n = 0; n < 32; ++n) { st[n] = st[n] * dA + xdt * bf2f(Bp[n]); yp += st[n] * bf2f(Cp[n]); }
        yp += __shfl_xor(yp, 1); yp += __shfl_xor(yp, 2);
        if (nq == 0) yssm[m * 512 + h * 64 + p] = yp + D * x;
    }
}
template <bool ST = true> __device__ __forceinline__ void ssm_gate_norm_all(const bf16_t* __restrict__ yssm, const bf16_t* __restrict__ proj, const float* __restrict__ ng, bf16_t* __restrict__ ymix, int wv0, int wvend, int lane) {
    for (int wv = wv0; wv < wvend; wv += NWAVES) {
        const int m = wv >> 1, g = wv & 1;
        float u[4], q = 0.f;
#pragma unroll
        for (int j = 0; j < 4; ++j) { const int c = g * 256 + j * 64 + lane; const float z = bf2f(proj[(size_t)m * L0P + 1792 + c]); u[j] = bf2f(yssm[(size_t)m * 512 + c]) * siluf_(z); q += u[j] * u[j]; }
        const float rs = 1.0f / sqrtf(wave_sum(q) * (1.f / 256.f) + 1e-5f);
#pragma unroll
        for (int j = 0; j < 4; ++j) { const int c = g * 256 + j * 64 + lane; const float o_ = u[j] * rs * ng[c]; if (ST) ymix[(size_t)m * DM + 512 + c] = (bf16_t)f2bf(o_); else asm volatile("" :: "v"(o_)); }
    }
}
template <bool ST = true> __device__ __forceinline__ void ffn_act_all(bf16_t* gu, const float* __restrict__ cw, const float* __restrict__ cb, int gtid, int NT) {
    constexpr int NCH = DFF / 8, NSTRIP = M / 32;
    for (int task = gtid; task < NSTRIP * NCH; task += NT) {
        const int strip = task / NCH, q = task - strip * NCH, c0 = q * 8, m0 = strip * 32;
        float w0[8], w1[8], w2[8], bb[8], g2[8], g1[8];
#pragma unroll
        for (int j = 0; j < 8; j += 4) { const f32x4 a = *(const f32x4*)(cw + c0 + j), b = *(const f32x4*)(cw + DFF + c0 + j), c = *(const f32x4*)(cw + 2 * DFF + c0 + j), d = *(const f32x4*)(cb + c0 + j);
#pragma unroll
            for (int k = 0; k < 4; ++k) { w0[j + k] = a[k]; w1[j + k] = b[k]; w2[j + k] = c[k]; bb[j + k] = d[k]; } }
        bf16_t* base = gu + (size_t)m0 * (2 * DFF) + c0;
        if ((m0 & (SEQ - 1)) != 0) { const v4u a = *(const v4u*)(base - 2 * (2 * DFF)), b = *(const v4u*)(base - (2 * DFF));
            g2[0] = bflo(a.x); g2[1] = bfhi(a.x); g2[2] = bflo(a.y); g2[3] = bfhi(a.y); g2[4] = bflo(a.z); g2[5] = bfhi(a.z); g2[6] = bflo(a.w); g2[7] = bfhi(a.w);
            g1[0] = bflo(b.x); g1[1] = bfhi(b.x); g1[2] = bflo(b.y); g1[3] = bfhi(b.y); g1[4] = bflo(b.z); g1[5] = bfhi(b.z); g1[6] = bflo(b.w); g1[7] = bfhi(b.w); }
        else {
#pragma unroll
            for (int j = 0; j < 8; ++j) { g2[j] = 0.f; g1[j] = 0.f; } }
#pragma unroll 4
        for (int r = 0; r < 32; ++r) {
            const v4u gv = *(const v4u*)(base + (size_t)r * (2 * DFF)), uv = *(const v4u*)(base + (size_t)r * (2 * DFF) + DFF);
            const unsigned gw_[4] = {gv.x, gv.y, gv.z, gv.w}, uw_[4] = {uv.x, uv.y, uv.z, uv.w};
            unsigned ow[4];
#pragma unroll
            for (int k = 0; k < 4; ++k) {
                const float ga = bflo(gw_[k]), gb = bfhi(gw_[k]);
                const float ya = bb[2 * k] + w0[2 * k] * g2[2 * k] + w1[2 * k] * g1[2 * k] + w2[2 * k] * ga;
                const float yb = bb[2 * k + 1] + w0[2 * k + 1] * g2[2 * k + 1] + w1[2 * k + 1] * g1[2 * k + 1] + w2[2 * k + 1] * gb;
                g2[2 * k] = g1[2 * k]; g1[2 * k] = ga; g2[2 * k + 1] = g1[2 * k + 1]; g1[2 * k + 1] = gb;
                ow[k] = cvtpk(ya / (1.f + __expf(-ya)) * bflo(uw_[k]), yb / (1.f + __expf(-yb)) * bfhi(uw_[k]));
            }
            if (ST) *(v4u*)(base + (size_t)r * (2 * DFF) + DFF) = (v4u){ow[0], ow[1], ow[2], ow[3]}; else asm volatile("" :: "v"(ow[0]), "v"(ow[1]), "v"(ow[2]), "v"(ow[3]));
        }
    }
}
template <bool ST = true> __device__ __forceinline__ void mla_prep_all(const bf16_t* __restrict__ proj1, const int* __restrict__ pos, float* __restrict__ rs, bf16_t* __restrict__ kpe, int gw, int NGW, int lane) {
    for (int m = gw; m < M; m += NGW) {
        const bf16_t* row = proj1 + (size_t)m * L1P;
        float q = 0.f;
#pragma unroll
        for (int j = 0; j < 4; ++j) { const float v = bf2f(row[1536 + j * 64 + lane]); q += v * v; }
        q = wave_sum(q);
        float k = 0.f;
#pragma unroll
        for (int j = 0; j < 2; ++j) { const float v = bf2f(row[1792 + j * 64 + lane]); k += v * v; }
        k = wave_sum(k);
        if (ST && lane == 0) { rs[(size_t)m * 2] = 1.0f / sqrtf(q * (1.f / 256.f) + 1e-6f); rs[(size_t)m * 2 + 1] = 1.0f / sqrtf(k * (1.f / 128.f) + 1e-6f); }
        if (lane < 16) {
            const double inv = pow(10000.0, -(double)(2 * lane) / 32.0);
            const double ang = (double)pos[m] * inv;
            const float cs = (float)cos(ang), sn = (float)sin(ang);
            const float x1 = bf2f(row[1920 + lane]), x2 = bf2f(row[1936 + lane]);
            const bf16_t r1_ = (bf16_t)f2bf(x1 * cs - x2 * sn), r2_ = (bf16_t)f2bf(x2 * cs + x1 * sn);
            if (ST) { kpe[(size_t)m * 32 + lane] = r1_; kpe[(size_t)m * 32 + 16 + lane] = r2_; } else asm volatile("" :: "v"((unsigned)r1_), "v"((unsigned)r2_), "v"(q), "v"(k));
        }
    }
}
template <bool ST = true> __device__ __forceinline__ void rope_q_all(bf16_t* qm, const int* __restrict__ pos, int gtid, int NT) {
    for (int i = gtid; i < M * 128; i += NT) {
        const int m = i >> 7, h = (i >> 4) & 7, k = i & 15;
        const double inv = pow(10000.0, -(double)(2 * k) / 32.0);
        const double ang = (double)pos[m] * inv;
        const float cs = (float)cos(ang), sn = (float)sin(ang);
        bf16_t* p = qm + (size_t)m * 768 + h * 96 + 64;
        const float x1 = bf2f(p[k]), x2 = bf2f(p[16 + k]);
        const bf16_t r1_ = (bf16_t)f2bf(x1 * cs - x2 * sn), r2_ = (bf16_t)f2bf(x2 * cs + x1 * sn); if (ST) { p[k] = r1_; p[16 + k] = r2_; } else asm volatile("" :: "v"((unsigned)r1_), "v"((unsigned)r2_));
    }
}
__device__ __forceinline__ void sb_naive_task(int qblk, int bh, int lane, const bf16_t* __restrict__ proj1, bf16_t* __restrict__ ymix) {
    const int b = bh >> 3, h = bh & 7, t = qblk * 64 + lane;
    const size_t mrow = (size_t)b * SEQ;
    float q[64], o[64];
#pragma unroll
    for (int d = 0; d < 64; ++d) { q[d] = bf2f(proj1[(mrow + t) * L1P + h * 64 + d]) * 0.125f; o[d] = 0.f; }
    float cum = 0.f;
    const int smax = qblk * 64 + 63;
    for (int s = smax - 1; s >= 0; --s) {
        const bf16_t* kr = proj1 + (mrow + s) * L1P + 512 + h * 64;
        const bf16_t* vr = proj1 + (mrow + s) * L1P + 1024 + h * 64;
        float z = 0.f;
#pragma unroll
        for (int d = 0; d < 64; ++d) z += q[d] * bf2f(kr[d]);
        if (s < t) {
            const float lsp = -softplusf_(-z);
            const float lsn = -softplusf_(z);
            const float att = expf(lsp + cum);
            cum += lsn;
#pragma unroll
            for (int d = 0; d < 64; ++d) o[d] += att * bf2f(vr[d]);
        }
    }
#pragma unroll
    for (int d = 0; d < 64; ++d) ymix[(mrow + t) * DM + h * 64 + d] = (bf16_t)f2bf(o[d]);
}
__device__ __forceinline__ void mla_naive_task(int qblk, int bh, int lane, const bf16_t* __restrict__ qm, const bf16_t* __restrict__ kvm, const bf16_t* __restrict__ kpe, bf16_t* __restrict__ ymix) {
    const int b = bh >> 3, h = bh & 7, t = qblk * 64 + lane;
    const size_t mrow = (size_t)b * SEQ;
    const float scale = 0.10206207261596577f;
    float q[96], o[64];
#pragma unroll
    for (int d = 0; d < 96; ++d) q[d] = bf2f(qm[(mrow + t) * 768 + h * 96 + d]) * scale;
#pragma unroll
    for (int d = 0; d < 64; ++d) o[d] = 0.f;
    float mx = -1e30f, l = 0.f;
    const int smax = qblk * 64 + 63;
    for (int s = 0; s <= smax; ++s) {
        const bf16_t* kr = kvm + (mrow + s) * 1024 + h * 128;
        const bf16_t* pr = kpe + (mrow + s) * 32;
        float z = 0.f;
#pragma unroll
        for (int d = 0; d < 64; ++d) z += q[d] * bf2f(kr[d]);
#pragma unroll
        for (int d = 0; d < 32; ++d) z += q[64 + d] * bf2f(pr[d]);
        if (s <= t) {
            const float mn = fmaxf(mx, z), f = expf(mx - mn), pz = expf(z - mn);
            l = l * f + pz; mx = mn;
#pragma unroll
            for (int d = 0; d < 64; ++d) o[d] = o[d] * f + pz * bf2f(kr[64 + d]);
        }
    }
    const float il = 1.f / l;
#pragma unroll
    for (int d = 0; d < 64; ++d) ymix[(mrow + t) * DM + 512 + h * 64 + d] = (bf16_t)f2bf(o[d] * il);
}


__device__ __forceinline__ int crow(int r, int hi) { return (r & 3) + 8 * (r >> 2) + 4 * hi; }
#define MFMA32(a, b, c) __builtin_amdgcn_mfma_f32_32x32x16_bf16((a), (b), (c), 0, 0, 0)
constexpr int STG_PITCH = 72;
__device__ __forceinline__ void transpose_tile64(const bf16_t* __restrict__ src, int sp, bf16_t* __restrict__ dst, int dp, LAS bf16_t* scr, int lane) {
#pragma unroll
    for (int i = 0; i < 8; ++i) { const int row = i * 8 + (lane >> 3), ch = lane & 7; const v4u v = *(const v4u*)(src + (size_t)row * sp + ch * 8); *(LAS v4u*)(scr + row * STG_PITCH + ch * 8) = v; }
    WSYNC();
#pragma unroll
    for (int i = 0; i < 8; ++i) { const int d = i * 8 + (lane >> 3), tc = lane & 7; const LAS bf16_t* p = scr + (tc * 8) * STG_PITCH + d;
        v4u o; o.x = (unsigned)p[0] | ((unsigned)p[STG_PITCH] << 16); o.y = (unsigned)p[2 * STG_PITCH] | ((unsigned)p[3 * STG_PITCH] << 16);
        o.z = (unsigned)p[4 * STG_PITCH] | ((unsigned)p[5 * STG_PITCH] << 16); o.w = (unsigned)p[6 * STG_PITCH] | ((unsigned)p[7 * STG_PITCH] << 16);
        *(v4u*)(dst + (size_t)d * dp + tc * 8) = o; }
    WSYNC();
}
__device__ __forceinline__ void store_OT(const f32x16 (&o)[2], float sc, LAS bf16_t* stg, bf16_t* __restrict__ dst, int lane) {
    const int l31 = lane & 31, hi = lane >> 5;
#pragma unroll
    for (int dt = 0; dt < 2; ++dt)
#pragma unroll
        for (int r = 0; r < 16; ++r) stg[l31 * STG_PITCH + 32 * dt + crow(r, hi)] = (bf16_t)f2bf(o[dt][r] * sc);
    WSYNC();
#pragma unroll
    for (int i = 0; i < 4; ++i) { const int row = i * 8 + (lane >> 3), ch = lane & 7; const v4u v = *(const LAS v4u*)(stg + row * STG_PITCH + ch * 8); *(v4u*)(dst + (size_t)row * DM + ch * 8) = v; }
    WSYNC();
}
__device__ __forceinline__ float softplus_fast(float z) { return fmaxf(z, 0.f) + __logf(1.f + __expf(-fabsf(z))); }

__device__ __forceinline__ void sb_task(int bh, int qblk, int lane, const bf16_t* __restrict__ P1, const bf16_t* __restrict__ VT, bf16_t* __restrict__ ymix, LAS bf16_t* stg) {
    const int b = bh >> 3, h = bh & 7, l31 = lane & 31, hi = lane >> 5, q0 = qblk * 32, t = q0 + l31;
    const size_t rowb = (size_t)b * SEQ;
    const bf16_t* Qp = P1 + (rowb + q0 + l31) * L1P + h * 64 + 8 * hi;
    bf16x8 qf[4];
#pragma unroll
    for (int kk = 0; kk < 4; ++kk) qf[kk] = *(const bf16x8*)(Qp + 16 * kk);
    const bf16_t* Kp = P1 + (rowb + l31) * L1P + 512 + h * 64 + 8 * hi;
    const bf16_t* Vp = VT + ((size_t)bh * 64 + l31) * SEQ + 4 * hi;
    f32x16 o[2];
#pragma unroll
    for (int r = 0; r < 16; ++r) { o[0][r] = 0.f; o[1][r] = 0.f; }
    float cum = 0.f;
    bf16x8 kf[4]; u32x2 va[2][2][2];
#define SB_LOAD(S0, KF, VA) do { _Pragma("unroll") for (int kk = 0; kk < 4; ++kk) KF[kk] = *(const bf16x8*)(Kp + (size_t)(S0) * L1P + 16 * kk); \
        _Pragma("unroll") for (int dt = 0; dt < 2; ++dt) _Pragma("unroll") for (int ks = 0; ks < 2; ++ks) { VA[dt][ks][0] = *(const u32x2*)(Vp + (size_t)dt * 32 * SEQ + (S0) + 16 * ks); VA[dt][ks][1] = *(const u32x2*)(Vp + (size_t)dt * 32 * SEQ + (S0) + 16 * ks + 8); } } while (0)
    SB_LOAD(q0, kf, va);
    for (int s0 = q0; s0 >= 0; s0 -= 32) {
        bf16x8 kn[4]; u32x2 vn[2][2][2];
        const int sn = (s0 >= 32) ? s0 - 32 : 0;
        SB_LOAD(sn, kn, vn);
        f32x16 acc;
#pragma unroll
        for (int r = 0; r < 16; ++r) acc[r] = 0.f;
#pragma unroll
        for (int kk = 0; kk < 4; ++kk) acc = MFMA32(kf[kk], qf[kk], acc);
        const bool diag = (s0 == q0);
        float lb[16], lk[16];
#pragma unroll
        for (int r = 0; r < 16; ++r) { const float z = acc[r] * 0.125f; const float sp = softplus_fast(z); float b_ = z - sp, k_ = -sp;
            if (diag) { const bool valid = (s0 + crow(r, hi)) < t; b_ = valid ? b_ : -1e30f; k_ = valid ? k_ : 0.f; }
            lb[r] = b_; lk[r] = k_; }
        float e[16], T[4], U[4];
#pragma unroll
        for (int i = 0; i < 4; ++i) { e[4 * i + 3] = 0.f; e[4 * i + 2] = lk[4 * i + 3]; e[4 * i + 1] = e[4 * i + 2] + lk[4 * i + 2]; e[4 * i] = e[4 * i + 1] + lk[4 * i + 1]; T[i] = e[4 * i] + lk[4 * i]; }
#pragma unroll
        for (int i = 0; i < 4; ++i) U[i] = __shfl_xor(T[i], 32);
        float off[4];
        { const float st2 = T[3], st1 = st2 + T[2], st0 = st1 + T[1]; const float su2 = U[3], su1 = su2 + U[2], su0 = su1 + U[1];
          const float x0 = hi ? 0.f : U[0], x1 = hi ? 0.f : U[1], x2 = hi ? 0.f : U[2], x3 = hi ? 0.f : U[3];
          off[3] = x3; off[2] = st2 + su2 + x2; off[1] = st1 + su1 + x1; off[0] = st0 + su0 + x0;
          const float total = st0 + T[0] + su0 + U[0];
#pragma unroll
          for (int r = 0; r < 16; ++r) acc[r] = __expf(lb[r] + (cum + off[r >> 2] + e[r]));
          cum += total; }
        bf16x8 pf[2];
#pragma unroll
        for (int ks = 0; ks < 2; ++ks) { v4u w; w.x = cvtpk(acc[8 * ks], acc[8 * ks + 1]); w.y = cvtpk(acc[8 * ks + 2], acc[8 * ks + 3]); w.z = cvtpk(acc[8 * ks + 4], acc[8 * ks + 5]); w.w = cvtpk(acc[8 * ks + 6], acc[8 * ks + 7]); pf[ks] = __builtin_bit_cast(bf16x8, w); }
#pragma unroll
        for (int dt = 0; dt < 2; ++dt)
#pragma unroll
            for (int ks = 0; ks < 2; ++ks) { v4u a; a.x = va[dt][ks][0].x; a.y = va[dt][ks][0].y; a.z = va[dt][ks][1].x; a.w = va[dt][ks][1].y; o[dt] = MFMA32(__builtin_bit_cast(bf16x8, a), pf[ks], o[dt]); }
        if (__all(cum < -110.f)) break;
#pragma unroll
        for (int kk = 0; kk < 4; ++kk) kf[kk] = kn[kk];
#pragma unroll
        for (int dt = 0; dt < 2; ++dt)
#pragma unroll
            for (int ks = 0; ks < 2; ++ks) { va[dt][ks][0] = vn[dt][ks][0]; va[dt][ks][1] = vn[dt][ks][1]; }
    }
#undef SB_LOAD
    store_OT(o, 1.0f, stg, ymix + (rowb + q0) * DM + h * 64, lane);
}
__device__ __forceinline__ void mla_task(int bh, int qblk, int lane, const bf16_t* __restrict__ QM, const bf16_t* __restrict__ KVM, const bf16_t* __restrict__ KPE, const bf16_t* __restrict__ VT,
                                         bf16_t* __restrict__ ymix, LAS bf16_t* stg) {
    const int b = bh >> 3, h = bh & 7, l31 = lane & 31, hi = lane >> 5, q0 = qblk * 32, t = q0 + l31;
    const size_t rowb = (size_t)b * SEQ;
    const bf16_t* Qp = QM + (rowb + q0 + l31) * 768 + h * 96 + 8 * hi;
    bf16x8 qf[6];
#pragma unroll
    for (int kk = 0; kk < 6; ++kk) qf[kk] = *(const bf16x8*)(Qp + 16 * kk);
    const bf16_t* Kn = KVM + (rowb + l31) * 1024 + h * 128 + 8 * hi;
    const bf16_t* Kr = KPE + (rowb + l31) * 32 + 8 * hi;
    const bf16_t* Vp = VT + ((size_t)bh * 64 + l31) * SEQ + 4 * hi;
    const float sc2 = 0.10206207261596577f * 1.4426950408889634f;
    f32x16 o[2];
#pragma unroll
    for (int r = 0; r < 16; ++r) { o[0][r] = 0.f; o[1][r] = 0.f; }
    float mrun = -1e30f, lsum = 0.f;
    bf16x8 kf[6]; u32x2 va[2][2][2];
#define ML_LOAD(S0, KF, VA) do { _Pragma("unroll") for (int kk = 0; kk < 4; ++kk) KF[kk] = *(const bf16x8*)(Kn + (size_t)(S0) * 1024 + 16 * kk); \
        _Pragma("unroll") for (int kk = 0; kk < 2; ++kk) KF[4 + kk] = *(const bf16x8*)(Kr + (size_t)(S0) * 32 + 16 * kk); \
        _Pragma("unroll") for (int dt = 0; dt < 2; ++dt) _Pragma("unroll") for (int ks = 0; ks < 2; ++ks) { VA[dt][ks][0] = *(const u32x2*)(Vp + (size_t)dt * 32 * SEQ + (S0) + 16 * ks); VA[dt][ks][1] = *(const u32x2*)(Vp + (size_t)dt * 32 * SEQ + (S0) + 16 * ks + 8); } } while (0)
    ML_LOAD(0, kf, va);
    for (int s0 = 0; s0 <= q0; s0 += 32) {
        bf16x8 kn[6]; u32x2 vn[2][2][2];
        const int sn = (s0 + 32 <= q0) ? s0 + 32 : s0;
        ML_LOAD(sn, kn, vn);
        f32x16 acc;
#pragma unroll
        for (int r = 0; r < 16; ++r) acc[r] = 0.f;
#pragma unroll
        for (int kk = 0; kk < 6; ++kk) acc = MFMA32(kf[kk], qf[kk], acc);
        const bool diag = (s0 == q0);
        float tmax = -1e30f;
#pragma unroll
        for (int r = 0; r < 16; ++r) { float z = acc[r] * sc2; if (diag && (s0 + crow(r, hi)) > t) z = -1e30f; acc[r] = z; tmax = fmaxf(tmax, z); }
        tmax = fmaxf(tmax, __shfl_xor(tmax, 32));
        const float mn = fmaxf(mrun, tmax), alpha = exp2f(mrun - mn); mrun = mn;
        float ps = 0.f;
#pragma unroll
        for (int r = 0; r < 16; ++r) { acc[r] = exp2f(acc[r] - mn); ps += acc[r]; }
        lsum = lsum * alpha + ps;
#pragma unroll
        for (int r = 0; r < 16; ++r) { o[0][r] *= alpha; o[1][r] *= alpha; }
        bf16x8 pf[2];
#pragma unroll
        for (int ks = 0; ks < 2; ++ks) { v4u w; w.x = cvtpk(acc[8 * ks], acc[8 * ks + 1]); w.y = cvtpk(acc[8 * ks + 2], acc[8 * ks + 3]); w.z = cvtpk(acc[8 * ks + 4], acc[8 * ks + 5]); w.w = cvtpk(acc[8 * ks + 6], acc[8 * ks + 7]); pf[ks] = __builtin_bit_cast(bf16x8, w); }
#pragma unroll
        for (int dt = 0; dt < 2; ++dt)
#pragma unroll
            for (int ks = 0; ks < 2; ++ks) { v4u a; a.x = va[dt][ks][0].x; a.y = va[dt][ks][0].y; a.z = va[dt][ks][1].x; a.w = va[dt][ks][1].y; o[dt] = MFMA32(__builtin_bit_cast(bf16x8, a), pf[ks], o[dt]); }
#pragma unroll
        for (int kk = 0; kk < 6; ++kk) kf[kk] = kn[kk];
#pragma unroll
        for (int dt = 0; dt < 2; ++dt)
#pragma unroll
            for (int ks = 0; ks < 2; ++ks) { va[dt][ks][0] = vn[dt][ks][0]; va[dt][ks][1] = vn[dt][ks][1]; }
    }
#undef ML_LOAD
    lsum += __shfl_xor(lsum, 32);
    store_OT(o, 1.0f / lsum, stg, ymix + (rowb + q0) * DM + 512 + h * 64, lane);
}


constexpr int RW_RAWW = 0, RW_RAWA = 2048, RW_RS = 4096, RW_KS = 6144, RW_VS = 8192;
constexpr int RW_CH0 = 10240, RW_CHSZ = 11328;
constexpr int RW_YB = RW_CH0 + 2 * RW_CHSZ;
constexpr int RW_MIX = RW_YB + 1024;
static_assert((RW_MIX + 256) * 4 <= 146432, "rwkv LDS map");
template <int CTRL> __device__ __forceinline__ float dpp_mov(float x) { return __builtin_bit_cast(float, __builtin_amdgcn_update_dpp(0, __builtin_bit_cast(int, x), CTRL, 0xF, 0xF, true)); }
__device__ __forceinline__ float rowsum16(float x) { x += dpp_mov<0x128>(x); x += dpp_mov<0x124>(x); x += dpp_mov<0x122>(x); x += dpp_mov<0x121>(x); return x; }
__device__ __forceinline__ float rl(float x, int l) { return __builtin_bit_cast(float, __builtin_amdgcn_readlane(__builtin_bit_cast(int, x), l)); }
__device__ __forceinline__ float wave_sum_dpp(float x) { x = rowsum16(x); return (rl(x, 0) + rl(x, 16)) + (rl(x, 32) + rl(x, 48)); }
__device__ __forceinline__ float tanh_fast(float x) { return 1.f - 2.f / (1.f + __expf(2.f * x)); }
__device__ __forceinline__ float sigmoid_fast(float x) { return 1.f / (1.f + __expf(-x)); }

__device__ __forceinline__ void rwkv_phase(LAS float* sm, int tid, int lane, int wave, int blk, const bf16_t* __restrict__ proj, const float* __restrict__ mix, const float* __restrict__ w0, const float* __restrict__ a0,
                                           const float* __restrict__ k_k, const float* __restrict__ k_a, const float* __restrict__ r_k, const bf16_t* __restrict__ W2T, const bf16_t* __restrict__ A2T, const bf16_t* __restrict__ G2T,
                                           float* __restrict__ yraw, bf16_t* __restrict__ gout, float* __restrict__ bonus_out) {
    const int chain = blk >> 1, half = blk & 1, b = chain >> 3, h = chain & 7, l31 = lane & 31, hi = lane >> 5;
    const size_t rowb = (size_t)b * SEQ;
    if (tid < 256) sm[RW_MIX + tid] = mix[1536 + tid];
    const int cB = h * 64 + lane;
    const float w0c = w0[cB], a0c = a0[cB], kkc = k_k[cB], kac = k_a[cB], rkc = r_k[cB];
    float mixv[8];
    { const int idx = (wave >= 5) ? wave - 5 : 0; const int ch8 = lane & 7;
#pragma unroll
      for (int j = 0; j < 8; ++j) mixv[j] = mix[512 * idx + h * 64 + ch8 * 8 + j]; }
    __syncthreads();
    float S0 = 0.f, S1 = 0.f, S2 = 0.f, S3 = 0.f;
    const int iloc = 4 * wave + (lane >> 4), jseg = lane & 15;
    v4u ld[16];
#define RW_ISSUE(T0) do { const int t0_ = (T0); \
        if (wave < 4) { const int colb = 1536 + 64 * (wave >> 1) + 8 * hi; const size_t r_ = rowb + t0_ + l31; const size_t rp_ = (t0_ + l31 == 0) ? r_ : r_ - 1; \
            _Pragma("unroll") for (int kk = 0; kk < 4; ++kk) { ld[kk] = *(const v4u*)(proj + r_ * L0P + colb + 16 * kk); ld[4 + kk] = *(const v4u*)(proj + rp_ * L0P + colb + 16 * kk); } } \
        else if (wave == 4) { const int colb = 1664 + 8 * hi; const size_t r_ = rowb + t0_ + l31; const size_t rp_ = (t0_ + l31 == 0) ? r_ : r_ - 1; \
            _Pragma("unroll") for (int kk = 0; kk < 8; ++kk) { ld[kk] = *(const v4u*)(proj + r_ * L0P + colb + 16 * kk); ld[8 + kk] = *(const v4u*)(proj + rp_ * L0P + colb + 16 * kk); } } \
        else { const int colb = 512 * (wave - 5) + h * 64 + 8 * (lane & 7); \
            _Pragma("unroll") for (int i = 0; i < 4; ++i) { const int tl = i * 8 + (lane >> 3); const size_t r_ = rowb + t0_ + tl; const size_t rp_ = (t0_ + tl == 0) ? r_ : r_ - 1; \
                ld[i] = *(const v4u*)(proj + r_ * L0P + colb); ld[4 + i] = *(const v4u*)(proj + rp_ * L0P + colb); } } } while (0)
#define RW_SHIFT8(CUR, PRV, MIXP, OUT, PZ) do { const unsigned cu_[4] = {(CUR).x, (CUR).y, (CUR).z, (CUR).w}, pu_[4] = {(PRV).x, (PRV).y, (PRV).z, (PRV).w}; \
        _Pragma("unroll") for (int q = 0; q < 4; ++q) { const float c0 = bflo(cu_[q]), c1 = bfhi(cu_[q]), p0 = bflo(pu_[q]) * (PZ), p1 = bfhi(pu_[q]) * (PZ); \
            OUT[2 * q] = c0 + (p0 - c0) * (MIXP)[2 * q]; OUT[2 * q + 1] = c1 + (p1 - c1) * (MIXP)[2 * q + 1]; } } while (0)
#define RW_PREP(T0, NB) do { const int t0_ = (T0); LAS float* CHn = sm + RW_CH0 + (NB) * RW_CHSZ; const float pz_ = (t0_ + l31 == 0) ? 0.f : 1.f; (void)pz_; \
        if (wave < 4) { const int lora = wave >> 1, jh = wave & 1; const bf16_t* WT = lora ? A2T : W2T; f32x16 acc; \
            _Pragma("unroll") for (int r = 0; r < 16; ++r) acc[r] = 0.f; \
            _Pragma("unroll") for (int kk = 0; kk < 4; ++kk) { float mx_[8], s_[8]; \
                { const f32x4 m0 = *(const LAS f32x4*)(sm + RW_MIX + lora * 64 + 16 * kk + 8 * hi), m1 = *(const LAS f32x4*)(sm + RW_MIX + lora * 64 + 16 * kk + 8 * hi + 4); \
                  mx_[0] = m0[0]; mx_[1] = m0[1]; mx_[2] = m0[2]; mx_[3] = m0[3]; mx_[4] = m1[0]; mx_[5] = m1[1]; mx_[6] = m1[2]; mx_[7] = m1[3]; } \
                RW_SHIFT8(ld[kk], ld[4 + kk], mx_, s_, pz_); \
                if (lora == 0) { _Pragma("unroll") for (int j = 0; j < 8; ++j) s_[j] = tanh_fast(s_[j]); } \
                v4u aw; aw.x = cvtpk(s_[0], s_[1]); aw.y = cvtpk(s_[2], s_[3]); aw.z = cvtpk(s_[4], s_[5]); aw.w = cvtpk(s_[6], s_[7]); \
                const bf16x8 bfr = *(const bf16x8*)(WT + (size_t)(h * 64 + jh * 32 + l31) * 64 + 16 * kk + 8 * hi); \
                acc = MFMA32(__builtin_bit_cast(bf16x8, aw), bfr, acc); } \
            LAS float* dst = sm + (lora ? RW_RAWA : RW_RAWW) + jh * 32 + l31; \
            _Pragma("unroll") for (int r = 0; r < 16; ++r) dst[crow(r, hi) * 64] = acc[r]; } \
        else if (wave == 4) { f32x16 acc; \
            _Pragma("unroll") for (int r = 0; r < 16; ++r) acc[r] = 0.f; \
            _Pragma("unroll") for (int kk = 0; kk < 8; ++kk) { float mx_[8], s_[8]; \
                { const f32x4 m0 = *(const LAS f32x4*)(sm + RW_MIX + 128 + 16 * kk + 8 * hi), m1 = *(const LAS f32x4*)(sm + RW_MIX + 128 + 16 * kk + 8 * hi + 4); \
                  mx_[0] = m0[0]; mx_[1] = m0[1]; mx_[2] = m0[2]; mx_[3] = m0[3]; mx_[4] = m1[0]; mx_[5] = m1[1]; mx_[6] = m1[2]; mx_[7] = m1[3]; } \
                RW_SHIFT8(ld[kk], ld[8 + kk], mx_, s_, pz_); \
                _Pragma("unroll") for (int j = 0; j < 8; ++j) s_[j] = sigmoid_fast(s_[j]); \
                v4u aw; aw.x = cvtpk(s_[0], s_[1]); aw.y = cvtpk(s_[2], s_[3]); aw.z = cvtpk(s_[4], s_[5]); aw.w = cvtpk(s_[6], s_[7]); \
                const bf16x8 bfr = *(const bf16x8*)(G2T + (size_t)(h * 64 + half * 32 + l31) * 128 + 16 * kk + 8 * hi); \
                acc = MFMA32(__builtin_bit_cast(bf16x8, aw), bfr, acc); } \
            bf16_t* gd = gout + (rowb + t0_) * 512 + h * 64 + half * 32 + l31; \
            _Pragma("unroll") for (int r = 0; r < 16; ++r) gd[(size_t)crow(r, hi) * 512] = (bf16_t)f2bf(acc[r]); } \
        else { LAS float* dst = sm + RW_RS + (wave - 5) * 2048 + (lane & 7) * 8; \
            _Pragma("unroll") for (int i = 0; i < 4; ++i) { const int tl = i * 8 + (lane >> 3); float s_[8]; const float pzs_ = (t0_ + tl == 0) ? 0.f : 1.f; RW_SHIFT8(ld[i], ld[4 + i], mixv, s_, pzs_); \
                *(LAS f32x4*)(dst + tl * 64) = (f32x4){s_[0], s_[1], s_[2], s_[3]}; *(LAS f32x4*)(dst + tl * 64 + 4) = (f32x4){s_[4], s_[5], s_[6], s_[7]}; } } \
        __syncthreads(); \
        _Pragma("unroll") for (int tt = 0; tt < 4; ++tt) { const int t = 4 * wave + tt; \
            const float wraw = sm[RW_RAWW + t * 64 + lane], araw = sm[RW_RAWA + t * 64 + lane], r_ = sm[RW_RS + t * 64 + lane], k_ = sm[RW_KS + t * 64 + lane], v_ = sm[RW_VS + t * 64 + lane]; \
            const float wsum = w0c + wraw; const float logw = -softplus_fast(-wsum) - 0.5f; const float dec = __expf(-__expf(logw)); \
            const float a_ = sigmoid_fast(a0c + araw); \
            float kkv = k_ * kkc; const float nrm2 = wave_sum_dpp(kkv * kkv); kkv = kkv * __builtin_amdgcn_rsqf(fmaxf(nrm2, 1e-24f)); \
            const float k2 = k_ * (1.f + (a_ - 1.f) * kac); const float bv = kkv * a_; \
            const float br = wave_sum_dpp(bv * r_), kr = wave_sum_dpp(k2 * r_), bon = wave_sum_dpp(r_ * k2 * rkc); \
            CHn[t * 64 + lane] = dec; CHn[2048 + t * 64 + lane] = k2; CHn[4096 + t * 64 + lane] = -kkv; CHn[6144 + t * 64 + lane] = bv; CHn[8192 + t * 64 + lane] = dec * r_; \
            if ((lane >> 5) == half) CHn[10240 + t * 32 + (lane & 31)] = v_; \
            if (lane == 0) { CHn[11264 + 2 * t] = br; CHn[11264 + 2 * t + 1] = kr; if (half == 0) bonus_out[(rowb + t0_ + t) * 8 + h] = bon; } } \
        __syncthreads(); } while (0)

    RW_ISSUE(0);
    RW_PREP(0, 0);
#pragma unroll 1
    for (int ch = 0; ch < SEQ / 32; ++ch) {
        const int t0 = ch * 32, tn = (ch + 1 < SEQ / 32) ? t0 + 32 : t0;
        RW_ISSUE(tn);
        const LAS float* CHb = sm + RW_CH0 + (ch & 1) * RW_CHSZ + 4 * jseg;
        const LAS float* CHv = sm + RW_CH0 + (ch & 1) * RW_CHSZ + 10240 + iloc;
        const LAS float* CHs = sm + RW_CH0 + (ch & 1) * RW_CHSZ + 11264;
        f32x4 a4 = *(const LAS f32x4*)(CHb + 4096), wr4 = *(const LAS f32x4*)(CHb + 8192), w4 = *(const LAS f32x4*)(CHb), b4 = *(const LAS f32x4*)(CHb + 6144), k4 = *(const LAS f32x4*)(CHb + 2048);
        float v = CHv[0]; f32x2_t sc = *(const LAS f32x2_t*)(CHs);
#pragma unroll 2
        for (int t = 0; t < 32; ++t) {
            const int tq = (t + 1) & 31;
            const f32x4 a4n = *(const LAS f32x4*)(CHb + 4096 + tq * 64), wr4n = *(const LAS f32x4*)(CHb + 8192 + tq * 64), w4n = *(const LAS f32x4*)(CHb + tq * 64),
                        b4n = *(const LAS f32x4*)(CHb + 6144 + tq * 64), k4n = *(const LAS f32x4*)(CHb + 2048 + tq * 64);
            const float vn = CHv[tq * 32]; const f32x2_t scn = *(const LAS f32x2_t*)(CHs + 2 * tq);
            float d1 = (S0 * a4[0] + S1 * a4[1]) + (S2 * a4[2] + S3 * a4[3]);
            float d2 = (S0 * wr4[0] + S1 * wr4[1]) + (S2 * wr4[2] + S3 * wr4[3]);
            d1 = rowsum16(d1); d2 = rowsum16(d2);
            const float y = d2 + d1 * sc[0] + v * sc[1];
            S0 = S0 * w4[0] + (d1 * b4[0] + v * k4[0]); S1 = S1 * w4[1] + (d1 * b4[1] + v * k4[1]);
            S2 = S2 * w4[2] + (d1 * b4[2] + v * k4[2]); S3 = S3 * w4[3] + (d1 * b4[3] + v * k4[3]);
            if (jseg == 0) sm[RW_YB + t * 32 + iloc] = y;
            a4 = a4n; wr4 = wr4n; w4 = w4n; b4 = b4n; k4 = k4n; v = vn; sc = scn;
        }
        WSYNC();
        if (lane < 32) { const f32x4 yv = *(const LAS f32x4*)(sm + RW_YB + lane * 32 + 4 * wave); *(f32x4*)(yraw + (rowb + t0 + lane) * 512 + h * 64 + half * 32 + 4 * wave) = yv; }
        RW_PREP(tn, (ch + 1) & 1);
    }
#undef RW_ISSUE
#undef RW_PREP
#undef RW_SHIFT8
}
template <bool ST = true> __device__ __forceinline__ void rwkv_post_all(const float* __restrict__ yraw, const bf16_t* __restrict__ proj, const float* __restrict__ mix, const float* __restrict__ bonus, const bf16_t* __restrict__ gbuf,
                                              const float* __restrict__ ln_g, const float* __restrict__ ln_b, bf16_t* __restrict__ ymix, int gw, int NGW, int lane) {
    for (int task = gw; task < M * 8; task += NGW) {
        const int m = task >> 3, h = task & 7, c = h * 64 + lane;
        const float y = yraw[(size_t)m * 512 + c];
        const float mu = wave_sum(y) * (1.f / 64.f), d = y - mu, var = wave_sum(d * d) * (1.f / 64.f);
        const float yn = d * (1.0f / sqrtf(var + 64e-5f)) * ln_g[c] + ln_b[c];
        const float cv = bf2f(proj[(size_t)m * L0P + 1024 + c]); const float pv = (m & (SEQ - 1)) ? bf2f(proj[(size_t)(m - 1) * L0P + 1024 + c]) : 0.f;
        const float v_s = cv + (pv - cv) * mix[1024 + c];
        const float o = (yn + bonus[(size_t)m * 8 + h] * v_s) * bf2f(gbuf[(size_t)m * 512 + c]);
        if (ST) ymix[(size_t)m * DM + c] = (bf16_t)f2bf(o); else asm volatile("" :: "v"(o));
    }
}


__device__ __forceinline__ void ssd_conv_tile(int it, int lane, LAS bf16_t* scr, const bf16_t* __restrict__ proj, const float* __restrict__ cw, const float* __restrict__ cb,
                                              bf16_t* __restrict__ xbc, bf16_t* __restrict__ xst, bf16_t* __restrict__ bt) {
    const int tt = it >> 4, ct = it & 15, m0 = tt * 64, b = m0 >> 11, t0 = m0 & (SEQ - 1), c = ct * 64 + lane;
    const float w0 = cw[c], w1 = cw[1024 + c], w2 = cw[2048 + c], w3 = cw[3072 + c], bias = cb[c];
    const bf16_t* src = proj + (size_t)m0 * L0P + 2304 + c;
    float u3 = 0.f, u2 = 0.f, u1 = 0.f;
    if (t0 > 0) { u3 = bf2f(src[-3 * L0P]); u2 = bf2f(src[-2 * L0P]); u1 = bf2f(src[-1 * L0P]); }
#pragma unroll 8
    for (int t = 0; t < 64; ++t) {
        const float u = bf2f(src[(size_t)t * L0P]);
        const float y = bias + w0 * u3 + w1 * u2 + w2 * u1 + w3 * u;
        const bf16_t o = (bf16_t)f2bf(y / (1.f + __expf(-y)));
        xbc[(size_t)(m0 + t) * 1024 + c] = o;
        scr[t * STG_PITCH + lane] = o;
        u3 = u2; u2 = u1; u1 = u;
    }
    WSYNC();
    if (ct < 12) {
        bf16_t* dst = (ct < 8) ? xst + ((size_t)(b * 8 + ct) * 64) * SEQ + t0 : bt + ((size_t)(b * 2 + ((ct - 8) >> 1)) * 128 + ((ct - 8) & 1) * 64) * SEQ + t0;
#pragma unroll
        for (int i = 0; i < 8; ++i) { const int d = i * 8 + (lane >> 3), tc = lane & 7; const LAS bf16_t* p = scr + (tc * 8) * STG_PITCH + d;
            v4u o; o.x = (unsigned)p[0] | ((unsigned)p[STG_PITCH] << 16); o.y = (unsigned)p[2 * STG_PITCH] | ((unsigned)p[3 * STG_PITCH] << 16);
            o.z = (unsigned)p[4 * STG_PITCH] | ((unsigned)p[5 * STG_PITCH] << 16); o.w = (unsigned)p[6 * STG_PITCH] | ((unsigned)p[7 * STG_PITCH] << 16);
            *(v4u*)(dst + (size_t)d * SEQ + tc * 8) = o; }
    }
    WSYNC();
}
__device__ __forceinline__ void scan128(float& x0, float& x1, int lane) {
#pragma unroll
    for (int o = 1; o < 64; o <<= 1) { const float t0 = __shfl_up(x0, o), t1 = __shfl_up(x1, o); if (lane >= o) { x0 += t0; x1 += t1; } }
    x1 += __shfl(x0, 63);
}
__device__ __forceinline__ void ssd_s1_unit(int unit, int lane, LAS float* tab, const bf16_t* __restrict__ xst, const bf16_t* __restrict__ bt, const float* __restrict__ dt, const float* __restrict__ a_log,
                                            float* __restrict__ sloc, float* __restrict__ asum) {
    const int h = unit & 7, c = (unit >> 3) & 15, b = unit >> 7, g = h >> 2, l0 = c * 128, l31 = lane & 31, hi = lane >> 5;
    const size_t m0 = (size_t)b * SEQ + l0;
    const float A = -expf(a_log[h]);
    const float d0 = dt[(m0 + lane) * 8 + h], d1 = dt[(m0 + 64 + lane) * 8 + h];
    float ac0 = d0 * A, ac1 = d1 * A;
    scan128(ac0, ac1, lane);
    const float aend = __shfl(ac1, 63);
    tab[lane] = __expf(aend - ac0) * d0; tab[64 + lane] = __expf(aend - ac1) * d1;
    if (lane == 0) asum[unit] = aend;
    WSYNC();
    f32x16 acc[2][4];
#pragma unroll
    for (int pt = 0; pt < 2; ++pt)
#pragma unroll
        for (int nt = 0; nt < 4; ++nt)
#pragma unroll
            for (int r = 0; r < 16; ++r) acc[pt][nt][r] = 0.f;
    const bf16_t* Xp = xst + ((size_t)(b * 8 + h) * 64 + l31) * SEQ + l0 + 8 * hi;
    const bf16_t* Bp = bt + ((size_t)(b * 2 + g) * 128 + l31) * SEQ + l0 + 8 * hi;
#pragma unroll 2
    for (int kk = 0; kk < 8; ++kk) {
        const f32x4 wa = *(const LAS f32x4*)(tab + 16 * kk + 8 * hi), wb = *(const LAS f32x4*)(tab + 16 * kk + 8 * hi + 4);
        bf16x8 af[2], bfr[4];
#pragma unroll
        for (int pt = 0; pt < 2; ++pt) { const v4u raw = *(const v4u*)(Xp + (size_t)pt * 32 * SEQ + 16 * kk);
            v4u w; w.x = cvtpk(bflo(raw.x) * wa[0], bfhi(raw.x) * wa[1]); w.y = cvtpk(bflo(raw.y) * wa[2], bfhi(raw.y) * wa[3]);
            w.z = cvtpk(bflo(raw.z) * wb[0], bfhi(raw.z) * wb[1]); w.w = cvtpk(bflo(raw.w) * wb[2], bfhi(raw.w) * wb[3]); af[pt] = __builtin_bit_cast(bf16x8, w); }
#pragma unroll
        for (int nt = 0; nt < 4; ++nt) bfr[nt] = *(const bf16x8*)(Bp + (size_t)nt * 32 * SEQ + 16 * kk);
#pragma unroll
        for (int pt = 0; pt < 2; ++pt)
#pragma unroll
            for (int nt = 0; nt < 4; ++nt) acc[pt][nt] = MFMA32(af[pt], bfr[nt], acc[pt][nt]);
    }
    float* dst = sloc + (size_t)unit * 8192 + l31;
#pragma unroll
    for (int pt = 0; pt < 2; ++pt)
#pragma unroll
        for (int nt = 0; nt < 4; ++nt)
#pragma unroll
            for (int r = 0; r < 16; ++r) dst[(32 * pt + crow(r, hi)) * 128 + 32 * nt] = acc[pt][nt][r];
    WSYNC();
}
__device__ __forceinline__ void ssd_s2_all(const float* __restrict__ sloc, const float* __restrict__ asum, bf16_t* __restrict__ stb, int gtid, int NT) {
    for (int i = gtid; i < 128 * 2048; i += NT) {
        const int bh = i >> 11, e4 = i & 2047, b = bh >> 3, h = bh & 7;
        f32x4 run = {0.f, 0.f, 0.f, 0.f};
#pragma unroll 4
        for (int c = 0; c < 16; ++c) { const int unit = (b * 16 + c) * 8 + h; const f32x4 tmp = *(const f32x4*)(sloc + (size_t)unit * 8192 + e4 * 4);
            uint2 w; w.x = cvtpk(run[0], run[1]); w.y = cvtpk(run[2], run[3]); *(uint2*)(stb + (size_t)unit * 8192 + e4 * 4) = w;
            run = run * __expf(asum[unit]) + tmp; }
    }
}
__device__ __forceinline__ void ssd_s3_unit(int unit, int lane, LAS float* tab, const bf16_t* __restrict__ xbc, const bf16_t* __restrict__ xst, const bf16_t* __restrict__ stb, const float* __restrict__ dt,
                                            const float* __restrict__ a_log, const float* __restrict__ dsk, bf16_t* __restrict__ yssm) {
    const int h = unit & 7, c = (unit >> 3) & 15, b = unit >> 7, g = h >> 2, l0 = c * 128, l31 = lane & 31, hi = lane >> 5;
    const size_t m0 = (size_t)b * SEQ + l0;
    const float A = -expf(a_log[h]), D = dsk[h];
    const float d0 = dt[(m0 + lane) * 8 + h], d1 = dt[(m0 + 64 + lane) * 8 + h];
    float ac0 = d0 * A, ac1 = d1 * A;
    scan128(ac0, ac1, lane);
    tab[lane] = ac0; tab[64 + lane] = ac1; tab[128 + lane] = d0; tab[192 + lane] = d1;
    WSYNC();
    const bf16_t* Cp = xbc + (m0 + l31) * 1024 + 768 + g * 128 + 8 * hi;
    const bf16_t* Sp = stb + (size_t)unit * 8192 + l31 * 128 + 8 * hi;
    const bf16_t* Bp = xbc + (m0 + l31) * 1024 + 512 + g * 128 + 8 * hi;
    const bf16_t* Xp = xst + ((size_t)(b * 8 + h) * 64 + l31) * SEQ + l0 + 4 * hi;
    LAS float* tr = tab + 256;
    const int row = lane >> 1, p0 = (lane & 1) * 16;
#pragma unroll 1
    for (int lt = 0; lt < 4; ++lt) {
        f32x16 y[2];
#pragma unroll
        for (int r = 0; r < 16; ++r) { y[0][r] = 0.f; y[1][r] = 0.f; }
        const float acl = tab[32 * lt + l31];
#pragma unroll 4
        for (int kk = 0; kk < 8; ++kk) {
            const bf16x8 cf = *(const bf16x8*)(Cp + (size_t)lt * 32 * 1024 + 16 * kk);
            const bf16x8 s0 = *(const bf16x8*)(Sp + 16 * kk), s1 = *(const bf16x8*)(Sp + 32 * 128 + 16 * kk);
            y[0] = MFMA32(s0, cf, y[0]); y[1] = MFMA32(s1, cf, y[1]);
        }
        { const float el = __expf(acl);
#pragma unroll
          for (int r = 0; r < 16; ++r) { y[0][r] *= el; y[1][r] *= el; } }
#pragma unroll 1
        for (int st = 0; st <= lt; ++st) {
            f32x16 cbt;
#pragma unroll
            for (int r = 0; r < 16; ++r) cbt[r] = 0.f;
#pragma unroll 4
            for (int kk = 0; kk < 8; ++kk) { const bf16x8 bf_ = *(const bf16x8*)(Bp + (size_t)st * 32 * 1024 + 16 * kk), cf_ = *(const bf16x8*)(Cp + (size_t)lt * 32 * 1024 + 16 * kk); cbt = MFMA32(bf_, cf_, cbt); }
#pragma unroll
            for (int r = 0; r < 16; ++r) { const int sl = 32 * st + crow(r, hi); const float acs = tab[sl], dts = tab[128 + sl];
                float v = cbt[r] * __expf(acl - acs) * dts; if (st == lt && crow(r, hi) > l31) v = 0.f; cbt[r] = v; }
            bf16x8 pf[2];
#pragma unroll
            for (int ks = 0; ks < 2; ++ks) { v4u w; w.x = cvtpk(cbt[8 * ks], cbt[8 * ks + 1]); w.y = cvtpk(cbt[8 * ks + 2], cbt[8 * ks + 3]); w.z = cvtpk(cbt[8 * ks + 4], cbt[8 * ks + 5]); w.w = cvtpk(cbt[8 * ks + 6], cbt[8 * ks + 7]); pf[ks] = __builtin_bit_cast(bf16x8, w); }
#pragma unroll
            for (int pt = 0; pt < 2; ++pt)
#pragma unroll
                for (int ks = 0; ks < 2; ++ks) { const bf16_t* xp = Xp + (size_t)pt * 32 * SEQ + st * 32 + 16 * ks; const u32x2 x0 = *(const u32x2*)xp, x1 = *(const u32x2*)(xp + 8);
                    v4u a; a.x = x0.x; a.y = x0.y; a.z = x1.x; a.w = x1.y; y[pt] = MFMA32(__builtin_bit_cast(bf16x8, a), pf[ks], y[pt]); }
        }
#pragma unroll
        for (int pt = 0; pt < 2; ++pt) {
#pragma unroll
            for (int r = 0; r < 16; ++r) tr[l31 * 33 + crow(r, hi)] = y[pt][r];
            WSYNC();
            const size_t m = m0 + 32 * lt + row;
            const v4u xa = *(const v4u*)(xbc + m * 1024 + h * 64 + 32 * pt + p0), xb = *(const v4u*)(xbc + m * 1024 + h * 64 + 32 * pt + p0 + 8);
            const unsigned xu[8] = {xa.x, xa.y, xa.z, xa.w, xb.x, xb.y, xb.z, xb.w};
            unsigned ow[8];
#pragma unroll
            for (int q = 0; q < 8; ++q) { const float v0 = tr[row * 33 + p0 + 2 * q] + D * bflo(xu[q]), v1 = tr[row * 33 + p0 + 2 * q + 1] + D * bfhi(xu[q]); ow[q] = cvtpk(v0, v1); }
            bf16_t* dst = yssm + m * 512 + h * 64 + 32 * pt + p0;
            *(v4u*)dst = (v4u){ow[0], ow[1], ow[2], ow[3]}; *(v4u*)(dst + 8) = (v4u){ow[4], ow[5], ow[6], ow[7]};
            WSYNC();
        }
    }
}

struct Args { const float* in[43]; float* out; unsigned char* ws; };
#define GEMM_PHASE(EPI, Aptr, LDA, Bptr, LDB, NN, KK, ...) do { pg8::Gemm g_{(Aptr), (Bptr), M, (NN), (KK), (LDA), (LDB)}; pg8::StaticOrder S_; S_.init(M, (NN), G, (int)blockIdx.x); \
        pg8::EPI E_{__VA_ARGS__}; pg8::gemm_phase<pg8::EPI, pg8::StaticOrder, true, true>(lds3, g_, S_, E_); } while (0)

__global__ void __launch_bounds__(NWAVES * 64, 2) fwd_mega(Args args) {
    extern __shared__ __attribute__((aligned(16))) unsigned char lds[];
    LAS unsigned char* lds3 = (LAS unsigned char*)lds;
    volatile LAS unsigned* MISC = (volatile LAS unsigned*)(lds3 + MISC_OFF);
    const int G = gridDim.x, NGW = G * NWAVES, NT = G * NWAVES * 64;
#define PHASE_IDS() int tid = threadIdx.x; asm volatile("" : "+v"(tid)); const int lane = tid & 63, wave = __builtin_amdgcn_readfirstlane(tid >> 6); const int gw = blockIdx.x * NWAVES + wave, gtid = blockIdx.x * (NWAVES * 64) + tid; (void)lane; (void)gw; (void)gtid
    unsigned char* ws = args.ws;
    gu32* ctl = (gu32*)(ws + WS_CTL);
    for (int u = threadIdx.x; u < (LDS_BYTES - LDSCTL_OFF) / 4; u += NWAVES * 64) ((LAS unsigned*)(lds3 + LDSCTL_OFF))[u] = 0u;
    __syncthreads();
    XcdBarrier bar = xcd_barrier_post((unsigned*)(ctl + CW_BAR), MISC + 8);
#define GRID_BAR() xcd_barrier(bar)
#define IN(i) (args.in[i])
    float* out = args.out;
    bf16_t* W0in = (bf16_t*)(ws + WS_W0IN); bf16_t* W0out = (bf16_t*)(ws + WS_W0OUT); bf16_t* Wup0 = (bf16_t*)(ws + WS_WUP0); bf16_t* Wdn0 = (bf16_t*)(ws + WS_WDN0);
    bf16_t* W1in = (bf16_t*)(ws + WS_W1IN); bf16_t* Wuq = (bf16_t*)(ws + WS_WUQ); bf16_t* Wukv = (bf16_t*)(ws + WS_WUKV); bf16_t* W1out = (bf16_t*)(ws + WS_W1OUT);
    bf16_t* Wup1 = (bf16_t*)(ws + WS_WUP1); bf16_t* Wdn1 = (bf16_t*)(ws + WS_WDN1);
    bf16_t* XB = (bf16_t*)(ws + WS_XB); bf16_t* YMIX = (bf16_t*)(ws + WS_YMIX); bf16_t* PROJ0 = (bf16_t*)(ws + WS_BIG);
    float* YRAW = out; bf16_t* YSSM = (bf16_t*)(out + (size_t)M * 512); bf16_t* STB = (bf16_t*)(out + (size_t)M * 768); bf16_t* XST = (bf16_t*)(ws + WS_XST); bf16_t* BT = (bf16_t*)(ws + WS_BT); float* ASUM = (float*)(ws + WS_ASUM); float* SLOC = (float*)(ws + WS_SLOC); float* DT = (float*)(ws + WS_DT); bf16_t* GB = (bf16_t*)(ws + WS_G); float* BONUS = (float*)(ws + WS_BONUS);
    bf16_t* W2T = (bf16_t*)(ws + WS_W2T); bf16_t* A2T = (bf16_t*)(ws + WS_A2T); bf16_t* G2T = (bf16_t*)(ws + WS_G2T); bf16_t* GU = (bf16_t*)(ws + WS_GU);
    bf16_t* PROJ1 = (bf16_t*)(ws + WS_PROJ1); bf16_t* QM = (bf16_t*)(ws + WS_QM); bf16_t* KVM = (bf16_t*)(ws + WS_KVM); bf16_t* KPE = (bf16_t*)(ws + WS_KPE); float* RS = (float*)(ws + WS_RS); bf16_t* VTS = (bf16_t*)(ws + WS_VTS); bf16_t* VTM = (bf16_t*)(ws + WS_VTM);
    const int* pos = (const int*)args.in[1];

    {
        PHASE_IDS();
    {
        LAS float* scr = (LAS float*)(lds3 + wave * 16384);
        transpose_matrix(IN(2), 1024, 3336, W0in, L0P, 1024, scr, gw, NGW, lane, nullptr);
        transpose_matrix(IN(20), 1024, 1024, W0out, 1024, 1024, scr, gw, NGW, lane, nullptr);
        transpose_matrix(IN(23), 1024, 5632, Wup0, 5632, 1024, scr, gw, NGW, lane, nullptr);
        transpose_matrix(IN(26), 2816, 1024, Wdn0, 1024, 2816, scr, gw, NGW, lane, nullptr);
        transpose_matrix(IN(29), 1024, 1952, W1in, L1P, 1024, scr, gw, NGW, lane, nullptr);
        transpose_matrix(IN(31), 256, 768, Wuq, 768, 256, scr, gw, NGW, lane, IN(30));
        transpose_matrix(IN(33), 128, 1024, Wukv, 1024, 256, scr, gw, NGW, lane, IN(32));
        for (int i = gtid; i < 1024 * 16; i += NT) { const int n = i >> 4, c = i & 15; *(v4u*)(Wukv + (size_t)n * 256 + 128 + c * 8) = (v4u){0u, 0u, 0u, 0u}; }
        transpose_matrix(IN(34), 1024, 1024, W1out, 1024, 1024, scr, gw, NGW, lane, nullptr);
        transpose_matrix(IN(37), 1024, 5632, Wup1, 5632, 1024, scr, gw, NGW, lane, nullptr);
        transpose_matrix(IN(40), 2816, 1024, Wdn1, 1024, 2816, scr, gw, NGW, lane, nullptr);
        transpose_matrix(IN(5), 64, 512, W2T, 512, 64, scr, gw, NGW, lane, nullptr);
        transpose_matrix(IN(7), 64, 512, A2T, 512, 64, scr, gw, NGW, lane, nullptr);
        transpose_matrix(IN(8), 128, 512, G2T, 512, 128, scr, gw, NGW, lane, nullptr);
        const float* x = IN(0);
        for (size_t i = (size_t)gtid * 4; i < (size_t)M * DM; i += (size_t)NT * 4) { const f32x4 v = *(const f32x4*)(x + i); uint2 w; w.x = pk2(v[0], v[1]); w.y = pk2(v[2], v[3]); *(uint2*)(XB + i) = w; }
    }
    }
    GRID_BAR();
    {
        PHASE_IDS();
    GEMM_PHASE(EpiBf16S, XB, DM, W0in, 1024, L0P, 1024, PROJ0, nullptr, L0P, 0);
    }
    GRID_BAR();
    {
        PHASE_IDS();
        const int blk = (int)blockIdx.x, m0 = blk * 128;
        {   LAS bf16_t* scr = (LAS bf16_t*)(lds3 + wave * 16384);
#pragma unroll 1
            for (int k = 0; k < 4; ++k) ssd_conv_tile((2 * blk + (k & 1)) * 16 + wave + 8 * (k >> 1), lane, scr, PROJ0, IN(14), IN(15), XB, XST, BT);
            for (int i = tid; i < 1024; i += NWAVES * 64) { const int m = m0 + (i >> 3); DT[(size_t)m * 8 + (i & 7)] = softplusf_(bf2f(PROJ0[(size_t)m * L0P + 3328 + (i & 7)]) + IN(16)[i & 7]); }
        }
        __syncthreads();
        ssd_s1_unit(blk * 8 + wave, lane, (LAS float*)(lds3 + wave * 16384), XST, BT, DT, IN(17), SLOC, ASUM);
    }
    GRID_BAR();
    {
        PHASE_IDS();
        ssd_s2_all(SLOC, ASUM, STB, gtid, NT);
        rwkv_phase((LAS float*)lds3, tid, lane, wave, (int)blockIdx.x, PROJ0, IN(3), IN(4), IN(6), IN(9), IN(10), IN(11), W2T, A2T, G2T, YRAW, GB, BONUS);
    }
    GRID_BAR();
    {
        PHASE_IDS();
        const int blk = (int)blockIdx.x;
        ssd_s3_unit(blk * 8 + wave, lane, (LAS float*)(lds3 + wave * 16384), XB, XST, STB, DT, IN(17), IN(18), YSSM);
        __syncthreads();
        ssm_gate_norm_all(YSSM, PROJ0, IN(19), YMIX, blk * 256 + wave, blk * 256 + 256, lane);
        rwkv_post_all(YRAW, PROJ0, IN(3), BONUS, GB, IN(12), IN(13), YMIX, gw, NGW, lane);
    }
    GRID_BAR();
    {
        PHASE_IDS();
    GEMM_PHASE(EpiResid, YMIX, DM, W0out, 1024, 1024, 1024, IN(0), out, ALPHA, 0);
    }
    GRID_BAR();
    {
        PHASE_IDS();
    ln_rows(out, XB, IN(21), IN(22), gw, NGW, lane);
    }
    GRID_BAR();
    {
        PHASE_IDS();
    GEMM_PHASE(EpiBf16S, XB, DM, Wup0, 1024, 2 * DFF, 1024, GU, nullptr, 2 * DFF, 0);
    }
    GRID_BAR();
    {
        PHASE_IDS();
    ffn_act_all(GU, IN(24), IN(25), gtid, NT);
    }
    GRID_BAR();
    {
        PHASE_IDS();
    GEMM_PHASE(EpiResid, GU + DFF, 2 * DFF, Wdn0, DFF, 1024, DFF, out, out, ALPHA, 0);
    }
    GRID_BAR();
    {
        PHASE_IDS();
    ln_rows(out, XB, IN(27), IN(28), gw, NGW, lane);
    }
    GRID_BAR();
    {
        PHASE_IDS();
    GEMM_PHASE(EpiBf16S, XB, DM, W1in, 1024, L1P, 1024, PROJ1, nullptr, L1P, 0);
    }
    GRID_BAR();
    {
        PHASE_IDS();
    mla_prep_all(PROJ1, pos, RS, KPE, gw, NGW, lane);
    }
    GRID_BAR();
    {
        PHASE_IDS();
    GEMM_PHASE(EpiBf16S, PROJ1 + 1536, L1P, Wuq, 256, 768, 256, QM, RS, 768, 2);
    GEMM_PHASE(EpiBf16S, PROJ1 + 1792, L1P, Wukv, 256, 1024, 256, KVM, RS + 1, 1024, 2);
    }
    GRID_BAR();
    {
        PHASE_IDS();
    rope_q_all(QM, pos, gtid, NT);
    {
        LAS bf16_t* scr = (LAS bf16_t*)(lds3 + wave * 16384);
        for (int it = gw; it < 8192; it += NGW) { const int which = it >> 12, r = it & 4095, bh = r >> 5, tt = r & 31, b = bh >> 3, h = bh & 7;
            if (which == 0) transpose_tile64(PROJ1 + ((size_t)b * SEQ + tt * 64) * L1P + 1024 + h * 64, L1P, VTS + (size_t)bh * 64 * SEQ + tt * 64, SEQ, scr, lane);
            else            transpose_tile64(KVM + ((size_t)b * SEQ + tt * 64) * 1024 + h * 128 + 64, 1024, VTM + (size_t)bh * 64 * SEQ + tt * 64, SEQ, scr, lane); }
    }
    }
    GRID_BAR();
    {
        PHASE_IDS();
    {
        LAS bf16_t* stg = (LAS bf16_t*)(lds3 + wave * 16384);
        for (int g2 = gw; g2 < 2048; g2 += NGW) { const int bh = g2 >> 4, w = g2 & 15;
#pragma unroll 1
            for (int i = 0; i < 4; ++i) { const int qb = (i == 0) ? w : (i == 1) ? 31 - w : (i == 2) ? 32 + w : 63 - w;
                sb_task(bh, qb, lane, PROJ1, VTS, YMIX, stg);
                mla_task(bh, qb, lane, QM, KVM, KPE, VTM, YMIX, stg); } }
    }
    }
    GRID_BAR();
    {
        PHASE_IDS();
    GEMM_PHASE(EpiResid, YMIX, DM, W1out, 1024, 1024, 1024, out, out, ALPHA, 0);
    }
    GRID_BAR();
    {
        PHASE_IDS();
    ln_rows(out, XB, IN(35), IN(36), gw, NGW, lane);
    }
    GRID_BAR();
    {
        PHASE_IDS();
    GEMM_PHASE(EpiBf16S, XB, DM, Wup1, 1024, 2 * DFF, 1024, GU, nullptr, 2 * DFF, 0);
    }
    GRID_BAR();
    {
        PHASE_IDS();
    ffn_act_all(GU, IN(38), IN(39), gtid, NT);
    }
    GRID_BAR();
    {
        PHASE_IDS();
    GEMM_PHASE(EpiResid, GU + DFF, 2 * DFF, Wdn1, DFF, 1024, DFF, out, out, ALPHA, 0);
    }
    GRID_BAR();
    {
        PHASE_IDS();
    ln_rows(out, XB, IN(41), IN(42), gw, NGW, lane);
    }
}

extern "C" void kernel_launch(void* const* d_in, const int* in_sizes, int n_in, void* d_out, int out_size, void* d_ws, size_t ws_size, hipStream_t stream) {
    static int grid = 0;
    if (grid == 0) {
        if (n_in != 43 || ws_size < WS_NEED || out_size != M * DM) { fprintf(stderr, "kernel_launch: unexpected n_in %d / ws %zu / out %d\n", n_in, ws_size, out_size); grid = -1; return; }
        int dev = 0, cus = 0, per_cu = 0;
        if (hipGetDevice(&dev) != hipSuccess || hipDeviceGetAttribute(&cus, hipDeviceAttributeMultiprocessorCount, dev) != hipSuccess) { grid = -1; return; }
        if (hipFuncSetAttribute((const void*)fwd_mega, hipFuncAttributeMaxDynamicSharedMemorySize, LDS_BYTES) != hipSuccess) { fprintf(stderr, "kernel_launch: hipFuncSetAttribute failed\n"); grid = -1; return; }
        if (hipOccupancyMaxActiveBlocksPerMultiprocessor(&per_cu, (const void*)fwd_mega, NWAVES * 64, LDS_BYTES) != hipSuccess || per_cu < 1) fprintf(stderr, "kernel_launch: occupancy query reports %d\n", per_cu);
        (void)hipGetLastError();
        grid = cus;
    }
    if (grid < 0) return;
    (void)hipMemsetAsync((char*)d_ws + WS_CTL, 0, CTL_ZERO_BYTES, stream);
    Args a{};
    for (int i = 0; i < 43; ++i) a.in[i] = (const float*)d_in[i];
    a.out = (float*)d_out; a.ws = (unsigned char*)d_ws;
    hipLaunchKernelGGL(fwd_mega, dim3(grid), dim3(NWAVES * 64), LDS_BYTES, stream, a);
}
```

```cpp
#include <hip/hip_runtime.h>
#include <cstdio>
#include <cstdint>
#include <cmath>
namespace pg8 {
#define PG8_LAS __attribute__((address_space(3)))
typedef unsigned short bf16_t;
typedef short bf16x8 __attribute__((ext_vector_type(8)));
typedef float f32x4 __attribute__((ext_vector_type(4)));
typedef unsigned u32x4 __attribute__((ext_vector_type(4)));
constexpr int BM = 256, BK = 64, HALF = 128, HTB = HALF * BK * 2  , STAGE_BYTES = 8 * HTB, NXCD = 8, WGM = 8;

__host__ __device__ __forceinline__ int lds_byte(int r, int c) { const int st = (r >> 4) * 2 + (c >> 5), rr = r & 15, cc = c & 31, ob = rr * 64 + cc * 2; return st * 1024 + (ob ^ (((ob >> 9) & 1) << 5)); }
__host__ __device__ __forceinline__ void stage_rc(int b, int& R, int& C) { const int st = b / 1024, sb = b % 1024, swz = sb ^ (((sb >> 9) & 1) << 5); R = (st >> 1) * 16 + swz / 64; C = (st & 1) * 32 + (swz % 64) / 2; }
__host__ __device__ __forceinline__ int perm32(int rho) { const int n = rho >> 4, i = rho & 15; return 8 * (i >> 2) + 4 * n + (i & 3); }

struct Unit { int pm, pn; };
struct Gemm { const bf16_t* A; const bf16_t* Bt; int M, N, K, lda, ldb; };

struct StaticOrder {
    int nM, nN, nwg, G, c;
    __host__ __device__ void init(int M, int N, int G_, int c_) { nM = M / BM; nN = N / BM; nwg = nM * nN; G = G_; c = c_; }
    __host__ __device__ bool next(int i, Unit& u) const {
        const long L = (long)i * G + c; if (L >= nwg) return false;
        int wgid = (int)L; { const int q = nwg / NXCD, r = nwg % NXCD, xcd = wgid % NXCD, off = wgid / NXCD; wgid = (xcd < r ? xcd * (q + 1) : r * (q + 1) + (xcd - r) * q) + off; }
        const int nig = WGM * nN, gid = wgid / nig, fm = gid * WGM, gsz = (nM - fm) < WGM ? (nM - fm) : WGM;
        u.pm = fm + ((wgid % nig) % gsz); u.pn = (wgid % nig) / gsz; return true;
    }
    __device__ __forceinline__ void a_ready(const Unit&) const {}
    __device__ __forceinline__ void done(const Unit&) const {}
};


__device__ __forceinline__ unsigned cvt_pk_bf16(float lo, float hi) { unsigned r; asm volatile("v_cvt_pk_bf16_f32 %0, %1, %2" : "=v"(r) : "v"(lo), "v"(hi)); return r; }
struct EpiBf16S {
    static constexpr bool PERM = true, AFTER_DRAIN = false;
    bf16_t* O; const float* rowscale; int ldc; int rs_stride;
    __device__ __forceinline__ void operator()(const f32x4 (&acc)[2][2][4][2], const Unit& u, int wr, int wc, int fr, int fq) const {
        const int row0 = u.pm * BM + wr * 64 + fr, col0 = u.pn * BM + wc * 32 + 8 * fq;
#pragma unroll
        for (int ai = 0; ai < 2; ++ai)
#pragma unroll
            for (int m = 0; m < 4; ++m) { const int row = row0 + ai * HALF + m * 16; const float sc = rowscale ? rowscale[(size_t)row * rs_stride] : 1.f;
                bf16_t* rowp = O + (size_t)row * ldc + col0;
#pragma unroll
                for (int bj = 0; bj < 2; ++bj) { const f32x4 v0 = acc[ai][bj][m][0] * sc, v1 = acc[ai][bj][m][1] * sc;
                    u32x4 w; w.x = cvt_pk_bf16(v0[0], v0[1]); w.y = cvt_pk_bf16(v0[2], v0[3]); w.z = cvt_pk_bf16(v1[0], v1[1]); w.w = cvt_pk_bf16(v1[2], v1[3]);
                    *(u32x4*)(rowp + bj * HALF) = w; } }
    }
};
struct EpiResid {
    static constexpr bool PERM = false, AFTER_DRAIN = false;
    const float* hin; float* hout; float alpha; int pad;
    __device__ __forceinline__ void operator()(const f32x4 (&acc)[2][2][4][2], const Unit& u, int wr, int wc, int fr, int fq) const {
        const int row0 = u.pm * BM + wr * 64 + fr, col0 = u.pn * BM + wc * 32 + 4 * fq;
#pragma unroll
        for (int ai = 0; ai < 2; ++ai)
#pragma unroll
            for (int m = 0; m < 4; ++m) { const size_t off = (size_t)(row0 + ai * HALF + m * 16) * 1024 + col0;
#pragma unroll
                for (int bj = 0; bj < 2; ++bj)
#pragma unroll
                    for (int n = 0; n < 2; ++n) { const size_t i = off + bj * HALF + n * 16; const f32x4 h = *(const f32x4*)(hin + i); *(f32x4*)(hout + i) = h * alpha + acc[ai][bj][m][n]; } }
    }
};
template <class Epi, class Sched, bool ALIGN_EPI = false, bool SP2 = false>
__device__ __forceinline__ void gemm_phase(PG8_LAS unsigned char* lds, const Gemm g, const Sched& S, const Epi& E) {
    const int tid = threadIdx.x, wid = __builtin_amdgcn_readfirstlane(tid >> 6), lane = tid & 63, wr = wid >> 2, wc = wid & 3, fr = lane & 15, fq = lane >> 4;
    const int K = g.K, nt = K / BK;
    unsigned voffA[2], voffB[2];
#pragma unroll
    for (int i = 0; i < 2; ++i) { int R, C; stage_rc(tid * 16 + i * 8192, R, C); const int Rb = Epi::PERM ? ((R & ~31) + perm32(R & 31)) : R;
        voffA[i] = (unsigned)(R * g.lda + C) * 2u; voffB[i] = (unsigned)(Rb * g.ldb + C) * 2u; }
    const size_t kstep = (size_t)(BK * 2);
    const size_t hstepA = (size_t)HALF * g.lda * 2, hstepB = (size_t)HALF * g.ldb * 2;
    const size_t tstepA = 2 * hstepA, tstepB = 2 * hstepB;
    const unsigned ldsw = (unsigned)wid * 1024u;
    const int aoff = lds_byte(wr * 64 + fr, fq * 8), boff = lds_byte(wc * 32 + fr, fq * 8);
#define PG8_SA(b, h) (((b) * 2 + (h)) * HTB)
#define PG8_SB(b, h) ((4 + (b) * 2 + (h)) * HTB)
#define PG8_STAGE(bufoff, gbase, voff) do { _Pragma("unroll") for (int _i = 0; _i < 2; ++_i) \
        __builtin_amdgcn_global_load_lds((const unsigned*)((const char*)(gbase) + (voff)[_i]), (PG8_LAS unsigned*)(lds + (bufoff) + ldsw + _i * 8192), 16, 0, 0); } while (0)
#define PG8_LDA(dst, b, h) do { _Pragma("unroll") for (int m = 0; m < 4; ++m) _Pragma("unroll") for (int k = 0; k < 2; ++k) dst[m][k] = *(const PG8_LAS bf16x8*)(lds + PG8_SA(b, h) + aoff + m * 2048 + k * 1024); } while (0)
#define PG8_LDB(dst, b, h) do { _Pragma("unroll") for (int n = 0; n < 2; ++n) _Pragma("unroll") for (int k = 0; k < 2; ++k) dst[n][k] = *(const PG8_LAS bf16x8*)(lds + PG8_SB(b, h) + boff + n * 2048 + k * 1024); } while (0)
#define PG8_MMA(ai, bj, At, Bt) do { __builtin_amdgcn_s_setprio(1); _Pragma("unroll") for (int m = 0; m < 4; ++m) _Pragma("unroll") for (int n = 0; n < 2; ++n) _Pragma("unroll") for (int k = 0; k < 2; ++k) \
        acc[ai][bj][m][n] = __builtin_amdgcn_mfma_f32_16x16x32_bf16(Bt[n][k], At[m][k], acc[ai][bj][m][n], 0, 0, 0); __builtin_amdgcn_s_setprio(0); } while (0)
#define PG8_WAIT_V(n) asm volatile("s_waitcnt vmcnt(" #n ")" ::: "memory")
#define PG8_WAIT_L(n) asm volatile("s_waitcnt lgkmcnt(" #n ")" ::: "memory")
#define PG8_BAR __builtin_amdgcn_s_barrier()
#define PG8_SCHED __builtin_amdgcn_sched_barrier(0)
    Unit cur, nxt; int ui = 0;
    if (!S.next(0, cur)) return;
    f32x4 acc[2][2][4][2];
#pragma unroll
    for (int a = 0; a < 2; ++a)
#pragma unroll
        for (int b = 0; b < 2; ++b)
#pragma unroll
            for (int m = 0; m < 4; ++m)
#pragma unroll
                for (int n = 0; n < 2; ++n) acc[a][b][m][n] = (f32x4){0.f, 0.f, 0.f, 0.f};
    bf16x8 At[4][2], B0[2][2], B1[2][2];
    const char* cA = (const char*)g.A + (size_t)cur.pm * tstepA; const char* cB = (const char*)g.Bt + (size_t)cur.pn * tstepB;
    S.a_ready(cur);
    if constexpr (SP2) {
        PG8_STAGE(PG8_SB(0, 0), cB, voffB); PG8_STAGE(PG8_SB(0, 1), cB + hstepB, voffB); PG8_STAGE(PG8_SA(0, 0), cA, voffA); PG8_STAGE(PG8_SA(0, 1), cA + hstepA, voffA);
        if (wr == 1) PG8_BAR;
        PG8_WAIT_V(2); PG8_BAR;
        PG8_STAGE(PG8_SB(1, 0), cB + kstep, voffB); PG8_STAGE(PG8_SA(1, 0), cA + kstep, voffA); PG8_STAGE(PG8_SB(1, 1), cB + hstepB + kstep, voffB);
        PG8_WAIT_V(6); PG8_BAR;
    } else {
        PG8_STAGE(PG8_SB(0, 0), cB, voffB); PG8_STAGE(PG8_SA(0, 0), cA, voffA); PG8_STAGE(PG8_SB(0, 1), cB + hstepB, voffB); PG8_STAGE(PG8_SA(0, 1), cA + hstepA, voffA);
        if (wr == 1) PG8_BAR;
        PG8_WAIT_V(4); PG8_BAR;
        PG8_STAGE(PG8_SB(1, 0), cB + kstep, voffB); PG8_STAGE(PG8_SA(1, 0), cA + kstep, voffA); PG8_STAGE(PG8_SB(1, 1), cB + hstepB + kstep, voffB);
        PG8_WAIT_V(6); PG8_BAR;
    }
    for (;;) {
        const bool has_next = S.next(ui + 1, nxt);
        const char* nA = has_next ? (const char*)g.A + (size_t)nxt.pm * tstepA : cA; const char* nB = has_next ? (const char*)g.Bt + (size_t)nxt.pn * tstepB : cB;
        for (int t = 0; t < nt; t += 2) {
            const bool last = (t == nt - 2);
            const char* a1 = cA + (size_t)(t + 1) * kstep;
            const char* a2 = last ? nA : cA + (size_t)(t + 2) * kstep; const char* b2 = last ? nB : cB + (size_t)(t + 2) * kstep;
            const char* a3 = a2 + kstep; const char* b3 = b2 + kstep;
            if (last && has_next) S.a_ready(nxt);
            if constexpr (SP2) {
            PG8_LDB(B0, 0, 0); PG8_LDB(B1, 0, 1); PG8_SCHED; PG8_LDA(At, 0, 0); PG8_STAGE(PG8_SA(1, 1), a1 + hstepA, voffA);
            PG8_WAIT_V(8); PG8_WAIT_L(0); PG8_BAR; PG8_MMA(0, 0, At, B0); PG8_MMA(0, 1, At, B1); PG8_BAR; PG8_SCHED;
            PG8_LDA(At, 0, 1); PG8_STAGE(PG8_SB(0, 0), b2, voffB); PG8_STAGE(PG8_SB(0, 1), b2 + hstepB, voffB); PG8_STAGE(PG8_SA(0, 0), a2, voffA);
            PG8_WAIT_V(8); PG8_WAIT_L(0); PG8_BAR; PG8_MMA(1, 0, At, B0); PG8_MMA(1, 1, At, B1); PG8_BAR; PG8_SCHED;
            PG8_LDB(B0, 1, 0); PG8_LDB(B1, 1, 1); PG8_SCHED; PG8_LDA(At, 1, 0); PG8_STAGE(PG8_SA(0, 1), a2 + hstepA, voffA);
            PG8_WAIT_V(8); PG8_WAIT_L(0); PG8_BAR; PG8_MMA(0, 0, At, B0); PG8_MMA(0, 1, At, B1); PG8_BAR; PG8_SCHED;
            PG8_LDA(At, 1, 1); PG8_STAGE(PG8_SB(1, 0), b3, voffB); PG8_STAGE(PG8_SB(1, 1), b3 + hstepB, voffB); PG8_STAGE(PG8_SA(1, 0), a3, voffA);
            PG8_WAIT_V(8); PG8_WAIT_L(0); PG8_BAR; PG8_MMA(1, 0, At, B0); PG8_MMA(1, 1, At, B1); PG8_BAR; PG8_SCHED;
            } else {
            PG8_LDB(B0, 0, 0); PG8_SCHED; PG8_LDA(At, 0, 0); PG8_STAGE(PG8_SA(1, 1), a1 + hstepA, voffA);
            PG8_WAIT_L(8); PG8_BAR; PG8_WAIT_L(0); PG8_MMA(0, 0, At, B0); PG8_BAR; PG8_SCHED;
            PG8_LDB(B1, 0, 1); PG8_STAGE(PG8_SB(0, 0), b2, voffB);
            PG8_BAR; PG8_WAIT_L(0); PG8_MMA(0, 1, At, B1); PG8_BAR;
            PG8_LDA(At, 0, 1); PG8_STAGE(PG8_SA(0, 0), a2, voffA);
            PG8_BAR; PG8_WAIT_L(0); PG8_MMA(1, 0, At, B0); PG8_BAR; PG8_SCHED;
            PG8_STAGE(PG8_SB(0, 1), b2 + hstepB, voffB);
            PG8_WAIT_V(6); PG8_BAR; PG8_MMA(1, 1, At, B1); PG8_BAR;
            PG8_LDB(B0, 1, 0); PG8_SCHED; PG8_LDA(At, 1, 0); PG8_STAGE(PG8_SA(0, 1), a2 + hstepA, voffA);
            PG8_WAIT_L(8); PG8_BAR; PG8_WAIT_L(0); PG8_MMA(0, 0, At, B0); PG8_BAR; PG8_SCHED;
            PG8_LDB(B1, 1, 1); PG8_STAGE(PG8_SB(1, 0), b3, voffB);
            PG8_BAR; PG8_WAIT_L(0); PG8_MMA(0, 1, At, B1); PG8_BAR;
            PG8_LDA(At, 1, 1); PG8_STAGE(PG8_SA(1, 0), a3, voffA);
            PG8_BAR; PG8_WAIT_L(0); PG8_MMA(1, 0, At, B0); PG8_BAR; PG8_SCHED;
            PG8_STAGE(PG8_SB(1, 1), b3 + hstepB, voffB);
            PG8_WAIT_V(6); PG8_BAR; PG8_MMA(1, 1, At, B1); PG8_BAR;
            }
        }
        if constexpr (ALIGN_EPI) { if (wr == 0) PG8_BAR; }
        if constexpr (!Epi::AFTER_DRAIN) { E(acc, cur, wr, wc, fr, fq); S.done(cur); }
        if (!has_next) break;
#pragma unroll
        for (int a = 0; a < 2; ++a)
#pragma unroll
            for (int b = 0; b < 2; ++b)
#pragma unroll
                for (int m = 0; m < 4; ++m)
#pragma unroll
                    for (int n = 0; n < 2; ++n) acc[a][b][m][n] = (f32x4){0.f, 0.f, 0.f, 0.f};
        cur = nxt; cA = nA; cB = nB; ++ui;
        if constexpr (ALIGN_EPI) { if (wr == 1) PG8_BAR; }
    }
    PG8_WAIT_V(0);
    if constexpr (!ALIGN_EPI) { if (wr == 0) PG8_BAR; }
    PG8_BAR;
    if constexpr (Epi::AFTER_DRAIN) { E.fused(acc, cur, wr, wc, fr, fq, lds, wid, lane); S.done(cur); }
#undef PG8_SA
#undef PG8_SB
#undef PG8_STAGE
#undef PG8_LDA
#undef PG8_LDB
#undef PG8_MMA
#undef PG8_WAIT_V
#undef PG8_WAIT_L
#undef PG8_BAR
#undef PG8_SCHED
}
}
#define GAS __attribute__((address_space(1)))
#define LAS __attribute__((address_space(3)))
typedef unsigned short bf16;
typedef unsigned v4u __attribute__((ext_vector_type(4)));
typedef float f32x4 __attribute__((ext_vector_type(4)));
typedef short bf16x8 __attribute__((ext_vector_type(8)));
typedef GAS unsigned gu32;
typedef GAS unsigned long long gu64;
#define RLX_AGENT __ATOMIC_RELAXED, __HIP_MEMORY_SCOPE_AGENT
#define LDS_WAIT() asm volatile("s_waitcnt lgkmcnt(0)" ::: "memory")
#define VM_WAIT() asm volatile("s_waitcnt vmcnt(0)" ::: "memory")
__device__ __forceinline__ unsigned long long rt() { return __builtin_amdgcn_s_memrealtime(); }
__device__ __forceinline__ unsigned f2bf(float f) { unsigned u = __builtin_bit_cast(unsigned, f); return (u + 0x7fffu + ((u >> 16) & 1u)) >> 16; }
__device__ __forceinline__ unsigned pk2(float lo, float hi) { return f2bf(lo) | (f2bf(hi) << 16); }

#define XB_TMO      128
#define XB_XCNT(j)  (256  + 64 * (j))
#define XB_XSUB(j)  (1280 + 64 * (j))
#define XB_XGEN(j)  (2304 + 64 * (j))
#define XB_TOP      3328
#define XB_TOPGEN   3392
#define XCD_BAR_WORDS 3456
#define XB_SPIN_CAP (1u << 18)

__device__ __forceinline__ unsigned xb_ld(unsigned* p)              { return __hip_atomic_load(p, __ATOMIC_RELAXED, __HIP_MEMORY_SCOPE_AGENT); }
__device__ __forceinline__ unsigned xb_add(unsigned* p, unsigned v) { return __hip_atomic_fetch_add(p, v, __ATOMIC_RELAXED, __HIP_MEMORY_SCOPE_AGENT); }
__device__ __forceinline__ unsigned xb_xcc_id() { return (unsigned)__builtin_amdgcn_s_getreg((3 << 11) | 20) & 0xFu; }
#define XB_SPIN(cond, bar) do { unsigned _sp = 0; while (cond) { __builtin_amdgcn_s_sleep(1); \
    if ((++_sp & 255u) == 0u) { if (xb_ld(&(bar)[XB_TMO])) break; if (_sp > XB_SPIN_CAP) { atomicAdd(&(bar)[XB_TMO], 1u); break; } } } } while (0)

struct XcdBarrier {
    unsigned* bar; unsigned x;
    volatile LAS unsigned* st;
};

__device__ __forceinline__ XcdBarrier xcd_barrier_post(unsigned* bar, volatile LAS unsigned* st) {
    XcdBarrier b; b.bar = bar; b.x = xb_xcc_id(); b.st = st;
    if (threadIdx.x == 0) (void)xb_add(&bar[XB_XCNT(b.x)], 1u);
    return b;
}
__device__ __forceinline__ void xcd_barrier_complete(unsigned* bar, unsigned x, unsigned& nloc, unsigned& nx) {
    const unsigned G = gridDim.x * gridDim.y * gridDim.z;
    unsigned sum, cnt, mine, sp = 0u;
    for (;;) {
        sum = 0u; cnt = 0u; mine = 0u;
#pragma unroll
        for (unsigned j = 0; j < 16; ++j) { const unsigned c = xb_ld(&bar[XB_XCNT(j)]); sum += c; cnt += (c > 0u) ? 1u : 0u; mine = (j == x) ? c : mine; }
        if (sum == G) break;
        __builtin_amdgcn_s_sleep(1);
        if ((++sp & 255u) == 0u) { if (xb_ld(&bar[XB_TMO])) break; if (sp > XB_SPIN_CAP) { atomicAdd(&bar[XB_TMO], 1u); break; } }
    }
    nloc = mine > 0u ? mine : 1u; nx = cnt > 0u ? cnt : 1u;
}

__device__ __forceinline__ void xcd_barrier(const XcdBarrier& b) {
    asm volatile("s_waitcnt vmcnt(0)" ::: "memory");
    __syncthreads();
    if (threadIdx.x == 0) {
        unsigned* bar = b.bar;
        __builtin_amdgcn_s_waitcnt(0);
        unsigned nloc = b.st[0], nx = b.st[1];
        if (nloc == 0u) { xcd_barrier_complete(bar, b.x, nloc, nx); b.st[0] = nloc; b.st[1] = nx; }
        const unsigned old = xb_add(&bar[XB_XSUB(b.x)], 1u);
        const unsigned gen = old / nloc;
        if (old + 1u == (gen + 1u) * nloc) {
            __builtin_amdgcn_fence(__ATOMIC_RELEASE, "agent");
            asm volatile("s_waitcnt vmcnt(0)" ::: "memory");
            const unsigned og = xb_add(&bar[XB_TOP], 1u);
            const unsigned tg = og / nx;
            if (og + 1u == (tg + 1u) * nx) xb_add(&bar[XB_TOPGEN], 1u);
            else XB_SPIN(xb_ld(&bar[XB_TOPGEN]) == tg, bar);
            __builtin_amdgcn_fence(__ATOMIC_ACQUIRE, "agent");
            xb_add(&bar[XB_XGEN(b.x)], 1u);
            asm volatile("s_waitcnt vmcnt(0)" ::: "memory");
        } else {
            XB_SPIN(xb_ld(&bar[XB_XGEN(b.x)]) == gen, bar);
            __builtin_amdgcn_fence(__ATOMIC_ACQUIRE, "agent");
            asm volatile("s_waitcnt vmcnt(0)" ::: "memory");
        }
    }
    __syncthreads();
}
constexpr int NWAVES = 8;
constexpr int BATCH = 16, SEQ = 2048, DM = 1024, M = BATCH * SEQ;
constexpr int L0P = 3584;
constexpr int L1P = 2048;
constexpr int DFF = 2816;
constexpr float ALPHA = 1.4142135623730951f;
typedef unsigned short bf16_t;
typedef float f32x16 __attribute__((ext_vector_type(16)));

constexpr size_t MiB = 1u << 20;
constexpr size_t WS_CTL = 0, CTL_ZERO_BYTES = 1 * MiB;
constexpr int CW_BAR = 4096;
constexpr size_t WS_W0IN = 2 * MiB, WS_W0OUT = 9 * MiB, WS_WUP0 = 11 * MiB, WS_WDN0 = 22 * MiB, WS_W1IN = 28 * MiB, WS_WUQ = 32 * MiB, WS_WUKV = 33 * MiB,
                 WS_W1OUT = 34 * MiB, WS_WUP1 = 36 * MiB, WS_WDN1 = 47 * MiB;
constexpr size_t WS_XB = 56 * MiB, WS_YMIX = 120 * MiB, WS_BIG = 184 * MiB;
constexpr size_t WS_G = 408 * MiB, WS_BONUS = 440 * MiB, WS_DT = 441 * MiB, WS_XST = 442 * MiB, WS_BT = 474 * MiB, WS_ASUM = 490 * MiB;
constexpr size_t WS_SLOC = 120 * MiB;
constexpr size_t WS_W2T = 53 * MiB, WS_A2T = 53 * MiB + 256 * 1024, WS_G2T = 53 * MiB + 512 * 1024;
constexpr size_t WS_GU = 120 * MiB;
constexpr size_t WS_PROJ1 = 184 * MiB, WS_QM = 312 * MiB, WS_KVM = 360 * MiB, WS_KPE = 424 * MiB, WS_RS = 426 * MiB;
constexpr size_t WS_VTS = 428 * MiB, WS_VTM = 460 * MiB;
constexpr size_t WS_NEED = 492 * MiB;

constexpr int RING_BYTES = 131072;
constexpr int LDSCTL_OFF = 146432, MISC_OFF = LDSCTL_OFF + 320;
constexpr int LDS_BYTES = 147456;

__device__ __forceinline__ float bf2f(bf16_t b) { return __builtin_bit_cast(float, (unsigned)b << 16); }
__device__ __forceinline__ float sigmoidf_(float x) { return 1.f / (1.f + expf(-x)); }
__device__ __forceinline__ float softplusf_(float x) { return fmaxf(x, 0.f) + log1pf(expf(-fabsf(x))); }
__device__ __forceinline__ float siluf_(float x) { return x / (1.f + expf(-x)); }
__device__ __forceinline__ float wave_sum(float v) {
#pragma unroll
    for (int o = 1; o < 64; o <<= 1) v += __shfl_xor(v, o);
    return v;
}
#define WSYNC() asm volatile("s_waitcnt lgkmcnt(0)" ::: "memory")
typedef float f32x2_t __attribute__((ext_vector_type(2)));
typedef __bf16 bf16x2_t __attribute__((ext_vector_type(2)));
typedef unsigned u32x2 __attribute__((ext_vector_type(2)));
__device__ __forceinline__ unsigned cvtpk(float lo, float hi) { f32x2_t v = {lo, hi}; bf16x2_t b = __builtin_convertvector(v, bf16x2_t); return __builtin_bit_cast(unsigned, b); }
__device__ __forceinline__ float bflo(unsigned u) { return __builtin_bit_cast(float, u << 16); }
__device__ __forceinline__ float bfhi(unsigned u) { return __builtin_bit_cast(float, u & 0xffff0000u); }

__device__ __forceinline__ void transpose_item(const float* __restrict__ W, int N, bf16_t* __restrict__ WT, int ldt, LAS float* scr, int kb, int nb, int lane, const float* __restrict__ kscale) {
    const int k0 = 64 * kb, n0 = 32 * nb;
#pragma unroll 8
    for (int i = 0; i < 32; ++i) { const int kk = 2 * i + (lane >> 5), n = n0 + (lane & 31); float v = (n < N) ? W[(size_t)(k0 + kk) * N + n] : 0.f; if (kscale) v *= kscale[k0 + kk]; scr[kk * 33 + (lane & 31)] = v; }
    WSYNC();
    const int c = lane & 7;
#pragma unroll
    for (int j = 0; j < 4; ++j) { const int n = (lane >> 3) + 8 * j; const LAS float* s = scr + (8 * c) * 33 + n;
        v4u o; o.x = pk2(s[0 * 33], s[1 * 33]); o.y = pk2(s[2 * 33], s[3 * 33]); o.z = pk2(s[4 * 33], s[5 * 33]); o.w = pk2(s[6 * 33], s[7 * 33]);
        *(v4u*)(WT + (size_t)(n0 + n) * ldt + k0 + 8 * c) = o; }
    WSYNC();
}
__device__ __forceinline__ void transpose_matrix(const float* W, int K, int N, bf16_t* WT, int Npad, int ldt, LAS float* scr, int gw, int NGW, int lane, const float* kscale) {
    const int nblk = Npad / 32, nit = (K / 64) * nblk;
    for (int it = gw; it < nit; it += NGW) transpose_item(W, N, WT, ldt, scr, it / nblk, it % nblk, lane, kscale);
}

template <bool ST = true> __device__ __forceinline__ void ln_rows(float* h, bf16_t* hb, const float* __restrict__ g, const float* __restrict__ b, int gw, int NGW, int lane) {
    for (int row = gw; row < M; row += NGW) {
        float* p = h + (size_t)row * DM;
        f32x4 v[4]; float s = 0.f;
#pragma unroll
        for (int j = 0; j < 4; ++j) { v[j] = *(const f32x4*)(p + 4 * lane + 256 * j); s += (v[j][0] + v[j][1]) + (v[j][2] + v[j][3]); }
        const float mean = wave_sum(s) * (1.f / DM); float q = 0.f;
#pragma unroll
        for (int j = 0; j < 4; ++j) { v[j] = v[j] - mean; q += (v[j][0] * v[j][0] + v[j][1] * v[j][1]) + (v[j][2] * v[j][2] + v[j][3] * v[j][3]); }
        const float rstd = 1.0f / sqrtf(wave_sum(q) * (1.f / DM) + 1e-5f);
#pragma unroll
        for (int j = 0; j < 4; ++j) {
            const int c = 4 * lane + 256 * j;
            const f32x4 gg = *(const f32x4*)(g + c), bb = *(const f32x4*)(b + c);
            const f32x4 o = v[j] * rstd * gg + bb;
            uint2 w; w.x = pk2(o[0], o[1]); w.y = pk2(o[2], o[3]);
            if (ST) { *(f32x4*)(p + c) = o; *(uint2*)(hb + (size_t)row * DM + c) = w; } else asm volatile("" :: "v"(w.x), "v"(w.y), "v"(o[0]), "v"(o[1]), "v"(o[2]), "v"(o[3]));
        }
    }
}

__device__ __forceinline__ void rwkv_naive_chain(int chain, int lane, LAS float* sm, const bf16_t* __restrict__ proj, const float* __restrict__ mix, const float* __restrict__ w0, const float* __restrict__ w2,
                                                 const float* __restrict__ a0, const float* __restrict__ a2, const float* __restrict__ g2, const float* __restrict__ k_k,
                                                 const float* __restrict__ k_a, const float* __restrict__ r_k, const float* __restrict__ ln_g, const float* __restrict__ ln_b, bf16_t* __restrict__ ymix) {
    LAS float* s_w2 = sm; LAS float* s_a2 = sm + 4096; LAS float* s_g2 = sm + 8192; LAS float* s_tw = sm + 16384; LAS float* s_al = s_tw + 64; LAS float* s_sg = s_tw + 128;
    LAS float* s_w = s_tw + 256; LAS float* s_k = s_tw + 320; LAS float* s_a = s_tw + 384; LAS float* s_b = s_tw + 448; LAS float* s_r = s_tw + 512;
    const int b = chain >> 3, h = chain & 7, c = h * 64 + lane;
    for (int l = 0; l < 64; ++l) { s_w2[l * 64 + lane] = w2[l * 512 + c]; s_a2[l * 64 + lane] = a2[l * 512 + c]; }
    for (int l = 0; l < 128; ++l) s_g2[l * 64 + lane] = g2[l * 512 + c];
    const float mr = mix[c], mk = mix[512 + c], mv = mix[1024 + c], mw = mix[1536 + lane], ma = mix[1600 + lane], mg0 = mix[1664 + lane], mg1 = mix[1728 + lane];
    const float w0c = w0[c], a0c = a0[c], kkc = k_k[c], kac = k_a[c], rkc = r_k[c], lgc = ln_g[c], lbc = ln_b[c];
    float S[64];
#pragma unroll
    for (int j = 0; j < 64; ++j) S[j] = 0.f;
    float pr = 0.f, pk = 0.f, pv = 0.f, pw = 0.f, pa = 0.f, pg0 = 0.f, pg1 = 0.f;
    WSYNC();
    for (int t = 0; t < SEQ; ++t) {
        const bf16_t* row = proj + (size_t)(b * SEQ + t) * L0P;
        const float cr = bf2f(row[c]), ck = bf2f(row[512 + c]), cv = bf2f(row[1024 + c]), cw = bf2f(row[1536 + lane]), ca = bf2f(row[1600 + lane]),
                    cg0 = bf2f(row[1664 + lane]), cg1 = bf2f(row[1728 + lane]);
        const float r_s = cr + (pr - cr) * mr, k_s = ck + (pk - ck) * mk, v_s = cv + (pv - cv) * mv;
        const float wl = cw + (pw - cw) * mw, al = ca + (pa - ca) * ma, g0 = cg0 + (pg0 - cg0) * mg0, g1 = cg1 + (pg1 - cg1) * mg1;
        pr = cr; pk = ck; pv = cv; pw = cw; pa = ca; pg0 = cg0; pg1 = cg1;
        s_tw[lane] = tanhf(wl); s_al[lane] = al; s_sg[lane] = sigmoidf_(g0); s_sg[64 + lane] = sigmoidf_(g1);
        WSYNC();
        float wsum = w0c, asum = a0c, gsum = 0.f;
#pragma unroll 2
        for (int l = 0; l < 64; ++l) { wsum += s_tw[l] * s_w2[l * 64 + lane]; asum += s_al[l] * s_a2[l * 64 + lane]; }
#pragma unroll 2
        for (int l = 0; l < 128; ++l) gsum += s_sg[l] * s_g2[l * 64 + lane];
        const float log_w = -softplusf_(-wsum) - 0.5f;
        const float dec = expf(-expf(log_w));
        const float a = sigmoidf_(asum);
        float kkv = k_s * kkc;
        const float nrm = sqrtf(wave_sum(kkv * kkv));
        kkv = kkv / fmaxf(nrm, 1e-12f);
        const float k2 = k_s * (1.f + (a - 1.f) * kac);
        const float bonus_s = wave_sum(r_s * k2 * rkc);
        s_w[lane] = dec; s_k[lane] = k2; s_a[lane] = -kkv; s_b[lane] = kkv * a; s_r[lane] = r_s;
        WSYNC();
        float sa = 0.f;
#pragma unroll
        for (int j = 0; j < 64; ++j) sa += S[j] * s_a[j];
        float y = 0.f;
#pragma unroll
        for (int j = 0; j < 64; ++j) { S[j] = S[j] * s_w[j] + sa * s_b[j] + v_s * s_k[j]; y += S[j] * s_r[j]; }
        const float mu = wave_sum(y) * (1.f / 64.f);
        const float d = y - mu;
        const float var = wave_sum(d * d) * (1.f / 64.f);
        const float yn = d * (1.0f / sqrtf(var + 64e-5f)) * lgc + lbc;
        const float o = (yn + bonus_s * v_s) * gsum;
        ymix[(size_t)(b * SEQ + t) * DM + c] = (bf16_t)f2bf(o);
        WSYNC();
    }
}

__device__ __forceinline__ void ssm_conv_all(const bf16_t* __restrict__ proj, const float* __restrict__ cw, const float* __restrict__ cb, const float* __restrict__ dtb,
                                             bf16_t* __restrict__ xbc, float* __restrict__ dt, int gtid, int NT) {
    for (size_t i = gtid; i < (size_t)M * 1024; i += NT) {
        const int m = (int)(i >> 10), c = (int)(i & 1023), t = m & (SEQ - 1);
        float acc = cb[c];
#pragma unroll
        for (int k = 0; k < 4; ++k) { const int tt = t - 3 + k; if (tt >= 0) acc += cw[k * 1024 + c] * bf2f(proj[(size_t)(m - 3 + k) * L0P + 2304 + c]); }
        xbc[i] = (bf16_t)f2bf(siluf_(acc));
    }
    for (int i = gtid; i < M * 8; i += NT) dt[i] = softplusf_(bf2f(proj[(size_t)(i >> 3) * L0P + 3328 + (i & 7)]) + dtb[i & 7]);
}
__device__ __forceinline__ void ssd_naive_task(int task, int lane, const bf16_t* __restrict__ xbc, const float* __restrict__ dt, const float* __restrict__ a_log, const float* __restrict__ dsk, float* __restrict__ yssm) {
    const int chain = task >> 2, q = task & 3, b = chain >> 3, h = chain & 7, g = h >> 2, p = q * 16 + (lane >> 2), nq = lane & 3;
    const float A = -expf(a_log[h]), D = dsk[h];
    float st[32];
#pragma unroll
    for (int n = 0; n < 32; ++n) st[n] = 0.f;
    for (int t = 0; t < SEQ; ++t) {
        const size_t m = (size_t)b * SEQ + t;
        const float dtv = dt[m * 8 + h], dA = expf(dtv * A);
        const float x = bf2f(xbc[m * 1024 + h * 64 + p]), xdt = x * dtv;
        const bf16_t* Bp = xbc + m * 1024 + 512 + g * 128 + nq * 32;
        const bf16_t* Cp = xbc + m * 1024 + 768 + g * 128 + nq * 32;
        float yp = 0.f;
#pragma unroll
        for (int n = 0; n < 32; ++n) { st[n] = st[n] * dA + xdt * bf2f(Bp[n]); yp += st[n] * bf2f(Cp[n]); }
        yp += __shfl_xor(yp, 1); yp += __shfl_xor(yp, 2);
        if (nq == 0) yssm[m * 512 + h * 64 + p] = yp + D * x;
    }
}
template <bool ST = true> __device__ __forceinline__ void ssm_gate_norm_all(const bf16_t* __restrict__ yssm, const bf16_t* __restrict__ proj, const float* __restrict__ ng, bf16_t* __restrict__ ymix, int wv0, int wvend, int lane) {
    for (int wv = wv0; wv < wvend; wv += NWAVES) {
        const int m = wv >> 1, g = wv & 1;
        float u[4], q = 0.f;
#pragma unroll
        for (int j = 0; j < 4; ++j) { const int c = g * 256 + j * 64 + lane; const float z = bf2f(proj[(size_t)m * L0P + 1792 + c]); u[j] = bf2f(yssm[(size_t)m * 512 + c]) * siluf_(z); q += u[j] * u[j]; }
        const float rs = 1.0f / sqrtf(wave_sum(q) * (1.f / 256.f) + 1e-5f);
#pragma unroll
        for (int j = 0; j < 4; ++j) { const int c = g * 256 + j * 64 + lane; const float o_ = u[j] * rs * ng[c]; if (ST) ymix[(size_t)m * DM + 512 + c] = (bf16_t)f2bf(o_); else asm volatile("" :: "v"(o_)); }
    }
}
template <bool ST = true> __device__ __forceinline__ void ffn_act_all(bf16_t* gu, const float* __restrict__ cw, const float* __restrict__ cb, int gtid, int NT) {
    constexpr int NCH = DFF / 8, NSTRIP = M / 32;
    for (int task = gtid; task < NSTRIP * NCH; task += NT) {
        const int strip = task / NCH, q = task - strip * NCH, c0 = q * 8, m0 = strip * 32;
        float w0[8], w1[8], w2[8], bb[8], g2[8], g1[8];
#pragma unroll
        for (int j = 0; j < 8; j += 4) { const f32x4 a = *(const f32x4*)(cw + c0 + j), b = *(const f32x4*)(cw + DFF + c0 + j), c = *(const f32x4*)(cw + 2 * DFF + c0 + j), d = *(const f32x4*)(cb + c0 + j);
#pragma unroll
            for (int k = 0; k < 4; ++k) { w0[j + k] = a[k]; w1[j + k] = b[k]; w2[j + k] = c[k]; bb[j + k] = d[k]; } }
        bf16_t* base = gu + (size_t)m0 * (2 * DFF) + c0;
        if ((m0 & (SEQ - 1)) != 0) { const v4u a = *(const v4u*)(base - 2 * (2 * DFF)), b = *(const v4u*)(base - (2 * DFF));
            g2[0] = bflo(a.x); g2[1] = bfhi(a.x); g2[2] = bflo(a.y); g2[3] = bfhi(a.y); g2[4] = bflo(a.z); g2[5] = bfhi(a.z); g2[6] = bflo(a.w); g2[7] = bfhi(a.w);
            g1[0] = bflo(b.x); g1[1] = bfhi(b.x); g1[2] = bflo(b.y); g1[3] = bfhi(b.y); g1[4] = bflo(b.z); g1[5] = bfhi(b.z); g1[6] = bflo(b.w); g1[7] = bfhi(b.w); }
        else {
#pragma unroll
            for (int j = 0; j < 8; ++j) { g2[j] = 0.f; g1[j] = 0.f; } }
#pragma unroll 4
        for (int r = 0; r < 32; ++r) {
            const v4u gv = *(const v4u*)(base + (size_t)r * (2 * DFF)), uv = *(const v4u*)(base + (size_t)r * (2 * DFF) + DFF);
            const unsigned gw_[4] = {gv.x, gv.y, gv.z, gv.w}, uw_[4] = {uv.x, uv.y, uv.z, uv.w};
            unsigned ow[4];
#pragma unroll
            for (int k = 0; k < 4; ++k) {
                const float ga = bflo(gw_[k]), gb = bfhi(gw_[k]);
                const float ya = bb[2 * k] + w0[2 * k] * g2[2 * k] + w1[2 * k] * g1[2 * k] + w2[2 * k] * ga;
                const float yb = bb[2 * k + 1] + w0[2 * k + 1] * g2[2 * k + 1] + w1[2 * k + 1] * g1[2 * k + 1] + w2[2 * k + 1] * gb;
                g2[2 * k] = g1[2 * k]; g1[2 * k] = ga; g2[2 * k + 1] = g1[2 * k + 1]; g1[2 * k + 1] = gb;
                ow[k] = cvtpk(ya / (1.f + __expf(-ya)) * bflo(uw_[k]), yb / (1.f + __expf(-yb)) * bfhi(uw_[k]));
            }
            if (ST) *(v4u*)(base + (size_t)r * (2 * DFF) + DFF) = (v4u){ow[0], ow[1], ow[2], ow[3]}; else asm volatile("" :: "v"(ow[0]), "v"(ow[1]), "v"(ow[2]), "v"(ow[3]));
        }
    }
}
template <bool ST = true> __device__ __forceinline__ void mla_prep_all(const bf16_t* __restrict__ proj1, const int* __restrict__ pos, float* __restrict__ rs, bf16_t* __restrict__ kpe, int gw, int NGW, int lane) {
    for (int m = gw; m < M; m += NGW) {
        const bf16_t* row = proj1 + (size_t)m * L1P;
        float q = 0.f;
#pragma unroll
        for (int j = 0; j < 4; ++j) { const float v = bf2f(row[1536 + j * 64 + lane]); q += v * v; }
        q = wave_sum(q);
        float k = 0.f;
#pragma unroll
        for (int j = 0; j < 2; ++j) { const float v = bf2f(row[1792 + j * 64 + lane]); k += v * v; }
        k = wave_sum(k);
        if (ST && lane == 0) { rs[(size_t)m * 2] = 1.0f / sqrtf(q * (1.f / 256.f) + 1e-6f); rs[(size_t)m * 2 + 1] = 1.0f / sqrtf(k * (1.f / 128.f) + 1e-6f); }
        if (lane < 16) {
            const double inv = pow(10000.0, -(double)(2 * lane) / 32.0);
            const double ang = (double)pos[m] * inv;
            const float cs = (float)cos(ang), sn = (float)sin(ang);
            const float x1 = bf2f(row[1920 + lane]), x2 = bf2f(row[1936 + lane]);
            const bf16_t r1_ = (bf16_t)f2bf(x1 * cs - x2 * sn), r2_ = (bf16_t)f2bf(x2 * cs + x1 * sn);
            if (ST) { kpe[(size_t)m * 32 + lane] = r1_; kpe[(size_t)m * 32 + 16 + lane] = r2_; } else asm volatile("" :: "v"((unsigned)r1_), "v"((unsigned)r2_), "v"(q), "v"(k));
        }
    }
}
template <bool ST = true> __device__ __forceinline__ void rope_q_all(bf16_t* qm, const int* __restrict__ pos, int gtid, int NT) {
    for (int i = gtid; i < M * 128; i += NT) {
        const int m = i >> 7, h = (i >> 4) & 7, k = i & 15;
        const double inv = pow(10000.0, -(double)(2 * k) / 32.0);
        const double ang = (double)pos[m] * inv;
        const float cs = (float)cos(ang), sn = (float)sin(ang);
        bf16_t* p = qm + (size_t)m * 768 + h * 96 + 64;
        const float x1 = bf2f(p[k]), x2 = bf2f(p[16 + k]);
        const bf16_t r1_ = (bf16_t)f2bf(x1 * cs - x2 * sn), r2_ = (bf16_t)f2bf(x2 * cs + x1 * sn); if (ST) { p[k] = r1_; p[16 + k] = r2_; } else asm volatile("" :: "v"((unsigned)r1_), "v"((unsigned)r2_));
    }
}
__device__ __forceinline__ void sb_naive_task(int qblk, int bh, int lane, const bf16_t* __restrict__ proj1, bf16_t* __restrict__ ymix) {
    const int b = bh >> 3, h = bh & 7, t = qblk * 64 + lane;
    const size_t mrow = (size_t)b * SEQ;
    float q[64], o[64];
#pragma unroll
    for (int d = 0; d < 64; ++d) { q[d] = bf2f(proj1[(mrow + t) * L1P + h * 64 + d]) * 0.125f; o[d] = 0.f; }
    float cum = 0.f;
    const int smax = qblk * 64 + 63;
    for (int s = smax - 1; s >= 0; --s) {
        const bf16_t* kr = proj1 + (mrow + s) * L1P + 512 + h * 64;
        const bf16_t* vr = proj1 + (mrow + s) * L1P + 1024 + h * 64;
        float z = 0.f;
#pragma unroll
        for (int d = 0; d < 64; ++d) z += q[d] * bf2f(kr[d]);
        if (s < t) {
            const float lsp = -softplusf_(-z);
            const float lsn = -softplusf_(z);
            const float att = expf(lsp + cum);
            cum += lsn;
#pragma unroll
            for (int d = 0; d < 64; ++d) o[d] += att * bf2f(vr[d]);
        }
    }
#pragma unroll
    for (int d = 0; d < 64; ++d) ymix[(mrow + t) * DM + h * 64 + d] = (bf16_t)f2bf(o[d]);
}
__device__ __forceinline__ void mla_naive_task(int qblk, int bh, int lane, const bf16_t* __restrict__ qm, const bf16_t* __restrict__ kvm, const bf16_t* __restrict__ kpe, bf16_t* __restrict__ ymix) {
    const int b = bh >> 3, h = bh & 7, t = qblk * 64 + lane;
    const size_t mrow = (size_t)b * SEQ;
    const float scale = 0.10206207261596577f;
    float q[96], o[64];
#pragma unroll
    for (int d = 0; d < 96; ++d) q[d] = bf2f(qm[(mrow + t) * 768 + h * 96 + d]) * scale;
#pragma unroll
    for (int d = 0; d < 64; ++d) o[d] = 0.f;
    float mx = -1e30f, l = 0.f;
    const int smax = qblk * 64 + 63;
    for (int s = 0; s <= smax; ++s) {
        const bf16_t* kr = kvm + (mrow + s) * 1024 + h * 128;
        const bf16_t* pr = kpe + (mrow + s) * 32;
        float z = 0.f;
#pragma unroll
        for (int d = 0; d < 64; ++d) z += q[d] * bf2f(kr[d]);
#pragma unroll
        for (int d = 0; d < 32; ++d) z += q[64 + d] * bf2f(pr[d]);
        if (s <= t) {
            const float mn = fmaxf(mx, z), f = expf(mx - mn), pz = expf(z - mn);
            l = l * f + pz; mx = mn;
#pragma unroll
            for (int d = 0; d < 64; ++d) o[d] = o[d] * f + pz * bf2f(kr[64 + d]);
        }
    }
    const float il = 1.f / l;
#pragma unroll
    for (int d = 0; d < 64; ++d) ymix[(mrow + t) * DM + 512 + h * 64 + d] = (bf16_t)f2bf(o[d] * il);
}


__device__ __forceinline__ int crow(int r, int hi) { return (r & 3) + 8 * (r >> 2) + 4 * hi; }
#define MFMA32(a, b, c) __builtin_amdgcn_mfma_f32_32x32x16_bf16((a), (b), (c), 0, 0, 0)
constexpr int STG_PITCH = 72;
__device__ __forceinline__ void transpose_tile64(const bf16_t* __restrict__ src, int sp, bf16_t* __restrict__ dst, int dp, LAS bf16_t* scr, int lane) {
#pragma unroll
    for (int i = 0; i < 8; ++i) { const int row = i * 8 + (lane >> 3), ch = lane & 7; const v4u v = *(const v4u*)(src + (size_t)row * sp + ch * 8); *(LAS v4u*)(scr + row * STG_PITCH + ch * 8) = v; }
    WSYNC();
#pragma unroll
    for (int i = 0; i < 8; ++i) { const int d = i * 8 + (lane >> 3), tc = lane & 7; const LAS bf16_t* p = scr + (tc * 8) * STG_PITCH + d;
        v4u o; o.x = (unsigned)p[0] | ((unsigned)p[STG_PITCH] << 16); o.y = (unsigned)p[2 * STG_PITCH] | ((unsigned)p[3 * STG_PITCH] << 16);
        o.z = (unsigned)p[4 * STG_PITCH] | ((unsigned)p[5 * STG_PITCH] << 16); o.w = (unsigned)p[6 * STG_PITCH] | ((unsigned)p[7 * STG_PITCH] << 16);
        *(v4u*)(dst + (size_t)d * dp + tc * 8) = o; }
    WSYNC();
}
__device__ __forceinline__ void store_OT(const f32x16 (&o)[2], float sc, LAS bf16_t* stg, bf16_t* __restrict__ dst, int lane) {
    const int l31 = lane & 31, hi = lane >> 5;
#pragma unroll
    for (int dt = 0; dt < 2; ++dt)
#pragma unroll
        for (int r = 0; r < 16; ++r) stg[l31 * STG_PITCH + 32 * dt + crow(r, hi)] = (bf16_t)f2bf(o[dt][r] * sc);
    WSYNC();
#pragma unroll
    for (int i = 0; i < 4; ++i) { const int row = i * 8 + (lane >> 3), ch = lane & 7; const v4u v = *(const LAS v4u*)(stg + row * STG_PITCH + ch * 8); *(v4u*)(dst + (size_t)row * DM + ch * 8) = v; }
    WSYNC();
}
__device__ __forceinline__ float softplus_fast(float z) { return fmaxf(z, 0.f) + __logf(1.f + __expf(-fabsf(z))); }

__device__ __forceinline__ void sb_task(int bh, int qblk, int lane, const bf16_t* __restrict__ P1, const bf16_t* __restrict__ VT, bf16_t* __restrict__ ymix, LAS bf16_t* stg) {
    const int b = bh >> 3, h = bh & 7, l31 = lane & 31, hi = lane >> 5, q0 = qblk * 32, t = q0 + l31;
    const size_t rowb = (size_t)b * SEQ;
    const bf16_t* Qp = P1 + (rowb + q0 + l31) * L1P + h * 64 + 8 * hi;
    bf16x8 qf[4];
#pragma unroll
    for (int kk = 0; kk < 4; ++kk) qf[kk] = *(const bf16x8*)(Qp + 16 * kk);
    const bf16_t* Kp = P1 + (rowb + l31) * L1P + 512 + h * 64 + 8 * hi;
    const bf16_t* Vp = VT + ((size_t)bh * 64 + l31) * SEQ + 4 * hi;
    f32x16 o[2];
#pragma unroll
    for (int r = 0; r < 16; ++r) { o[0][r] = 0.f; o[1][r] = 0.f; }
    float cum = 0.f;
    bf16x8 kf[4]; u32x2 va[2][2][2];
#define SB_LOAD(S0, KF, VA) do { _Pragma("unroll") for (int kk = 0; kk < 4; ++kk) KF[kk] = *(const bf16x8*)(Kp + (size_t)(S0) * L1P + 16 * kk); \
        _Pragma("unroll") for (int dt = 0; dt < 2; ++dt) _Pragma("unroll") for (int ks = 0; ks < 2; ++ks) { VA[dt][ks][0] = *(const u32x2*)(Vp + (size_t)dt * 32 * SEQ + (S0) + 16 * ks); VA[dt][ks][1] = *(const u32x2*)(Vp + (size_t)dt * 32 * SEQ + (S0) + 16 * ks + 8); } } while (0)
    SB_LOAD(q0, kf, va);
    for (int s0 = q0; s0 >= 0; s0 -= 32) {
        bf16x8 kn[4]; u32x2 vn[2][2][2];
        const int sn = (s0 >= 32) ? s0 - 32 : 0;
        SB_LOAD(sn, kn, vn);
        f32x16 acc;
#pragma unroll
        for (int r = 0; r < 16; ++r) acc[r] = 0.f;
#pragma unroll
        for (int kk = 0; kk < 4; ++kk) acc = MFMA32(kf[kk], qf[kk], acc);
        const bool diag = (s0 == q0);
        float lb[16], lk[16];
#pragma unroll
        for (int r = 0; r < 16; ++r) { const float z = acc[r] * 0.125f; const float sp = softplus_fast(z); float b_ = z - sp, k_ = -sp;
            if (diag) { const bool valid = (s0 + crow(r, hi)) < t; b_ = valid ? b_ : -1e30f; k_ = valid ? k_ : 0.f; }
            lb[r] = b_; lk[r] = k_; }
        float e[16], T[4], U[4];
#pragma unroll
        for (int i = 0; i < 4; ++i) { e[4 * i + 3] = 0.f; e[4 * i + 2] = lk[4 * i + 3]; e[4 * i + 1] = e[4 * i + 2] + lk[4 * i + 2]; e[4 * i] = e[4 * i + 1] + lk[4 * i + 1]; T[i] = e[4 * i] + lk[4 * i]; }
#pragma unroll
        for (int i = 0; i < 4; ++i) U[i] = __shfl_xor(T[i], 32);
        float off[4];
        { const float st2 = T[3], st1 = st2 + T[2], st0 = st1 + T[1]; const float su2 = U[3], su1 = su2 + U[2], su0 = su1 + U[1];
          const float x0 = hi ? 0.f : U[0], x1 = hi ? 0.f : U[1], x2 = hi ? 0.f : U[2], x3 = hi ? 0.f : U[3];
          off[3] = x3; off[2] = st2 + su2 + x2; off[1] = st1 + su1 + x1; off[0] = st0 + su0 + x0;
          const float total = st0 + T[0] + su0 + U[0];
#pragma unroll
          for (int r = 0; r < 16; ++r) acc[r] = __expf(lb[r] + (cum + off[r >> 2] + e[r]));
          cum += total; }
        bf16x8 pf[2];
#pragma unroll
        for (int ks = 0; ks < 2; ++ks) { v4u w; w.x = cvtpk(acc[8 * ks], acc[8 * ks + 1]); w.y = cvtpk(acc[8 * ks + 2], acc[8 * ks + 3]); w.z = cvtpk(acc[8 * ks + 4], acc[8 * ks + 5]); w.w = cvtpk(acc[8 * ks + 6], acc[8 * ks + 7]); pf[ks] = __builtin_bit_cast(bf16x8, w); }
#pragma unroll
        for (int dt = 0; dt < 2; ++dt)
#pragma unroll
            for (int ks = 0; ks < 2; ++ks) { v4u a; a.x = va[dt][ks][0].x; a.y = va[dt][ks][0].y; a.z = va[dt][ks][1].x; a.w = va[dt][ks][1].y; o[dt] = MFMA32(__builtin_bit_cast(bf16x8, a), pf[ks], o[dt]); }
        if (__all(cum < -110.f)) break;
#pragma unroll
        for (int kk = 0; kk < 4; ++kk) kf[kk] = kn[kk];
#pragma unroll
        for (int dt = 0; dt < 2; ++dt)
#pragma unroll
            for (int ks = 0; ks < 2; ++ks) { va[dt][ks][0] = vn[dt][ks][0]; va[dt][ks][1] = vn[dt][ks][1]; }
    }
#undef SB_LOAD
    store_OT(o, 1.0f, stg, ymix + (rowb + q0) * DM + h * 64, lane);
}
__device__ __forceinline__ void mla_task(int bh, int qblk, int lane, const bf16_t* __restrict__ QM, const bf16_t* __restrict__ KVM, const bf16_t* __restrict__ KPE, const bf16_t* __restrict__ VT,
                                         bf16_t* __restrict__ ymix, LAS bf16_t* stg) {
    const int b = bh >> 3, h = bh & 7, l31 = lane & 31, hi = lane >> 5, q0 = qblk * 32, t = q0 + l31;
    const size_t rowb = (size_t)b * SEQ;
    const bf16_t* Qp = QM + (rowb + q0 + l31) * 768 + h * 96 + 8 * hi;
    bf16x8 qf[6];
#pragma unroll
    for (int kk = 0; kk < 6; ++kk) qf[kk] = *(const bf16x8*)(Qp + 16 * kk);
    const bf16_t* Kn = KVM + (rowb + l31) * 1024 + h * 128 + 8 * hi;
    const bf16_t* Kr = KPE + (rowb + l31) * 32 + 8 * hi;
    const bf16_t* Vp = VT + ((size_t)bh * 64 + l31) * SEQ + 4 * hi;
    const float sc2 = 0.10206207261596577f * 1.4426950408889634f;
    f32x16 o[2];
#pragma unroll
    for (int r = 0; r < 16; ++r) { o[0][r] = 0.f; o[1][r] = 0.f; }
    float mrun = -1e30f, lsum = 0.f;
    bf16x8 kf[6]; u32x2 va[2][2][2];
#define ML_LOAD(S0, KF, VA) do { _Pragma("unroll") for (int kk = 0; kk < 4; ++kk) KF[kk] = *(const bf16x8*)(Kn + (size_t)(S0) * 1024 + 16 * kk); \
        _Pragma("unroll") for (int kk = 0; kk < 2; ++kk) KF[4 + kk] = *(const bf16x8*)(Kr + (size_t)(S0) * 32 + 16 * kk); \
        _Pragma("unroll") for (int dt = 0; dt < 2; ++dt) _Pragma("unroll") for (int ks = 0; ks < 2; ++ks) { VA[dt][ks][0] = *(const u32x2*)(Vp + (size_t)dt * 32 * SEQ + (S0) + 16 * ks); VA[dt][ks][1] = *(const u32x2*)(Vp + (size_t)dt * 32 * SEQ + (S0) + 16 * ks + 8); } } while (0)
    ML_LOAD(0, kf, va);
    for (int s0 = 0; s0 <= q0; s0 += 32) {
        bf16x8 kn[6]; u32x2 vn[2][2][2];
        const int sn = (s0 + 32 <= q0) ? s0 + 32 : s0;
        ML_LOAD(sn, kn, vn);
        f32x16 acc;
#pragma unroll
        for (int r = 0; r < 16; ++r) acc[r] = 0.f;
#pragma unroll
        for (int kk = 0; kk < 6; ++kk) acc = MFMA32(kf[kk], qf[kk], acc);
        const bool diag = (s0 == q0);
        float tmax = -1e30f;
#pragma unroll
        for (int r = 0; r < 16; ++r) { float z = acc[r] * sc2; if (diag && (s0 + crow(r, hi)) > t) z = -1e30f; acc[r] = z; tmax = fmaxf(tmax, z); }
        tmax = fmaxf(tmax, __shfl_xor(tmax, 32));
        const float mn = fmaxf(mrun, tmax), alpha = exp2f(mrun - mn); mrun = mn;
        float ps = 0.f;
#pragma unroll
        for (int r = 0; r < 16; ++r) { acc[r] = exp2f(acc[r] - mn); ps += acc[r]; }
        lsum = lsum * alpha + ps;
#pragma unroll
        for (int r = 0; r < 16; ++r) { o[0][r] *= alpha; o[1][r] *= alpha; }
        bf16x8 pf[2];
#pragma unroll
        for (int ks = 0; ks < 2; ++ks) { v4u w; w.x = cvtpk(acc[8 * ks], acc[8 * ks + 1]); w.y = cvtpk(acc[8 * ks + 2], acc[8 * ks + 3]); w.z = cvtpk(acc[8 * ks + 4], acc[8 * ks + 5]); w.w = cvtpk(acc[8 * ks + 6], acc[8 * ks + 7]); pf[ks] = __builtin_bit_cast(bf16x8, w); }
#pragma unroll
        for (int dt = 0; dt < 2; ++dt)
#pragma unroll
            for (int ks = 0; ks < 2; ++ks) { v4u a; a.x = va[dt][ks][0].x; a.y = va[dt][ks][0].y; a.z = va[dt][ks][1].x; a.w = va[dt][ks][1].y; o[dt] = MFMA32(__builtin_bit_cast(bf16x8, a), pf[ks], o[dt]); }
#pragma unroll
        for (int kk = 0; kk < 6; ++kk) kf[kk] = kn[kk];
#pragma unroll
        for (int dt = 0; dt < 2; ++dt)
#pragma unroll
            for (int ks = 0; ks < 2; ++ks) { va[dt][ks][0] = vn[dt][ks][0]; va[dt][ks][1] = vn[dt][ks][1]; }
    }
#undef ML_LOAD
    lsum += __shfl_xor(lsum, 32);
    store_OT(o, 1.0f / lsum, stg, ymix + (rowb + q0) * DM + 512 + h * 64, lane);
}


constexpr int RW_RAWW = 0, RW_RAWA = 2048, RW_RS = 4096, RW_KS = 6144, RW_VS = 8192;
constexpr int RW_CH0 = 10240, RW_CHSZ = 11328;
constexpr int RW_YB = RW_CH0 + 2 * RW_CHSZ;
constexpr int RW_MIX = RW_YB + 1024;
static_assert((RW_MIX + 256) * 4 <= 146432, "rwkv LDS map");
template <int CTRL> __device__ __forceinline__ float dpp_mov(float x) { return __builtin_bit_cast(float, __builtin_amdgcn_update_dpp(0, __builtin_bit_cast(int, x), CTRL, 0xF, 0xF, true)); }
__device__ __forceinline__ float rowsum16(float x) { x += dpp_mov<0x128>(x); x += dpp_mov<0x124>(x); x += dpp_mov<0x122>(x); x += dpp_mov<0x121>(x); return x; }
__device__ __forceinline__ float rl(float x, int l) { return __builtin_bit_cast(float, __builtin_amdgcn_readlane(__builtin_bit_cast(int, x), l)); }
__device__ __forceinline__ float wave_sum_dpp(float x) { x = rowsum16(x); return (rl(x, 0) + rl(x, 16)) + (rl(x, 32) + rl(x, 48)); }
__device__ __forceinline__ float tanh_fast(float x) { return 1.f - 2.f / (1.f + __expf(2.f * x)); }
__device__ __forceinline__ float sigmoid_fast(float x) { return 1.f / (1.f + __expf(-x)); }

#define MFMA16(a, b, c) __builtin_amdgcn_mfma_f32_16x16x32_bf16((a), (b), (c), 0, 0, 0)
constexpr int RW2_CH0 = 0, RW2_YB = 2 * RW_CHSZ, RW2_MIX = RW2_YB + 1024, RW2_STG = RW2_MIX + 448;
static_assert((RW2_STG + 2 * 3072) * 4 <= 146432, "rwkv LDS map");
__device__ __forceinline__ void rwkv_phase(LAS float* sm, int tid, int lane, int wave, int blk, const bf16_t* __restrict__ proj, const float* __restrict__ mix, const float* __restrict__ w0, const float* __restrict__ a0,
                                           const float* __restrict__ k_k, const float* __restrict__ k_a, const float* __restrict__ r_k, const bf16_t* __restrict__ W2T, const bf16_t* __restrict__ A2T, const bf16_t* __restrict__ G2T,
                                           float* __restrict__ yraw, bf16_t* __restrict__ gout, float* __restrict__ bonus_out) {
    const int chain = blk >> 1, half = blk & 1, b = chain >> 3, h = chain & 7, l15 = lane & 15, kg = lane >> 4;
    const size_t rowb = (size_t)b * SEQ;
    constexpr int NCHUNK = SEQ / 32;
    if (tid < 256) sm[RW2_MIX + tid] = mix[1536 + tid];
    else if (tid < 448) { const int q = tid - 256; sm[RW2_MIX + tid] = mix[512 * (q >> 6) + h * 64 + (q & 63)]; }
    __syncthreads();
#define RW_SH8(CUR, PRV, M0, M1, OUT, PZ) do { const unsigned cu_[4] = {(CUR).x, (CUR).y, (CUR).z, (CUR).w}, pu_[4] = {(PRV).x, (PRV).y, (PRV).z, (PRV).w}; \
        const float mm_[8] = {(M0)[0], (M0)[1], (M0)[2], (M0)[3], (M1)[0], (M1)[1], (M1)[2], (M1)[3]}; \
        _Pragma("unroll") for (int q = 0; q < 4; ++q) { const float c0 = bflo(cu_[q]), c1 = bfhi(cu_[q]), p0 = bflo(pu_[q]) * (PZ), p1 = bfhi(pu_[q]) * (PZ); \
            OUT[2 * q] = c0 + (p0 - c0) * mm_[2 * q]; OUT[2 * q + 1] = c1 + (p1 - c1) * mm_[2 * q + 1]; } } while (0)
    if (wave < 4) {
        const int iA = 8 * wave + kg, iB = iA + 4, jseg = l15;
        float A0 = 0.f, A1 = 0.f, A2 = 0.f, A3 = 0.f, B0 = 0.f, B1 = 0.f, B2 = 0.f, B3 = 0.f;
        __syncthreads();
#pragma unroll 1
        for (int ch = 0; ch < NCHUNK; ++ch) {
            const int t0 = ch * 32;
            const LAS float* CHb = sm + RW2_CH0 + (ch & 1) * RW_CHSZ + 4 * jseg;
            const LAS float* CHv = sm + RW2_CH0 + (ch & 1) * RW_CHSZ + 10240 + iA;
            const LAS float* CHs = sm + RW2_CH0 + (ch & 1) * RW_CHSZ + 11264;
            f32x4 a4 = *(const LAS f32x4*)(CHb + 4096), wr4 = *(const LAS f32x4*)(CHb + 8192), w4 = *(const LAS f32x4*)(CHb), b4 = *(const LAS f32x4*)(CHb + 6144), k4 = *(const LAS f32x4*)(CHb + 2048);
            float vA = CHv[0], vB = CHv[4]; f32x2_t sc = *(const LAS f32x2_t*)(CHs);
#pragma unroll 2
            for (int t = 0; t < 32; ++t) {
                const int tq = (t + 1) & 31;
                const f32x4 a4n = *(const LAS f32x4*)(CHb + 4096 + tq * 64), wr4n = *(const LAS f32x4*)(CHb + 8192 + tq * 64), w4n = *(const LAS f32x4*)(CHb + tq * 64),
                            b4n = *(const LAS f32x4*)(CHb + 6144 + tq * 64), k4n = *(const LAS f32x4*)(CHb + 2048 + tq * 64);
                const float vAn = CHv[tq * 32], vBn = CHv[tq * 32 + 4]; const f32x2_t scn = *(const LAS f32x2_t*)(CHs + 2 * tq);
                float d1A = (A0 * a4[0] + A1 * a4[1]) + (A2 * a4[2] + A3 * a4[3]), d1B = (B0 * a4[0] + B1 * a4[1]) + (B2 * a4[2] + B3 * a4[3]);
                float d2A = (A0 * wr4[0] + A1 * wr4[1]) + (A2 * wr4[2] + A3 * wr4[3]), d2B = (B0 * wr4[0] + B1 * wr4[1]) + (B2 * wr4[2] + B3 * wr4[3]);
                d1A = rowsum16(d1A); d1B = rowsum16(d1B); d2A = rowsum16(d2A); d2B = rowsum16(d2B);
                const float yA = d2A + d1A * sc[0] + vA * sc[1], yB = d2B + d1B * sc[0] + vB * sc[1];
                A0 = A0 * w4[0] + (d1A * b4[0] + vA * k4[0]); A1 = A1 * w4[1] + (d1A * b4[1] + vA * k4[1]); A2 = A2 * w4[2] + (d1A * b4[2] + vA * k4[2]); A3 = A3 * w4[3] + (d1A * b4[3] + vA * k4[3]);
                B0 = B0 * w4[0] + (d1B * b4[0] + vB * k4[0]); B1 = B1 * w4[1] + (d1B * b4[1] + vB * k4[1]); B2 = B2 * w4[2] + (d1B * b4[2] + vB * k4[2]); B3 = B3 * w4[3] + (d1B * b4[3] + vB * k4[3]);
                if (jseg == 0) { sm[RW2_YB + t * 32 + iA] = yA; sm[RW2_YB + t * 32 + iB] = yB; }
                a4 = a4n; wr4 = wr4n; w4 = w4n; b4 = b4n; k4 = k4n; vA = vAn; vB = vBn; sc = scn;
            }
            WSYNC();
            { const int tt = lane >> 1, hh = lane & 1; const f32x4 yv = *(const LAS f32x4*)(sm + RW2_YB + tt * 32 + 8 * wave + 4 * hh);
              *(f32x4*)(yraw + (rowb + t0 + tt) * 512 + h * 64 + half * 32 + 8 * wave + 4 * hh) = yv; }
            __syncthreads();
        }
    } else if (wave < 6) {
        const int tp = wave - 4, tb = 16 * tp;
        LAS float* stg = sm + RW2_STG + tp * 3072;
        float w0c[4], a0c[4], kkc[4], kac[4], rkc[4];
#pragma unroll
        for (int nt = 0; nt < 4; ++nt) { const int c = h * 64 + 16 * nt + l15; w0c[nt] = w0[c]; a0c[nt] = a0[c]; kkc[nt] = k_k[c]; kac[nt] = k_a[c]; rkc[nt] = r_k[c]; }
        v4u ld[20];
#define PREP_ISSUE(T0) do { const int t0_ = (T0); { const size_t r_ = rowb + t0_ + tb + l15; const size_t rp_ = (t0_ + tb + l15 == 0) ? r_ : r_ - 1; \
            _Pragma("unroll") for (int lo = 0; lo < 2; ++lo) _Pragma("unroll") for (int ks = 0; ks < 2; ++ks) { const int col = 1536 + 64 * lo + 32 * ks + 8 * kg; \
                ld[(lo * 2 + ks) * 2] = *(const v4u*)(proj + r_ * L0P + col); ld[(lo * 2 + ks) * 2 + 1] = *(const v4u*)(proj + rp_ * L0P + col); } } \
            _Pragma("unroll") for (int ar = 0; ar < 3; ++ar) _Pragma("unroll") for (int i = 0; i < 2; ++i) { const int p_ = lane + 64 * i, row_ = p_ >> 3, c8_ = p_ & 7; \
                const size_t r_ = rowb + t0_ + tb + row_; const size_t rp_ = (t0_ + tb + row_ == 0) ? r_ : r_ - 1; const int col = 512 * ar + h * 64 + 8 * c8_; \
                ld[8 + (ar * 2 + i) * 2] = *(const v4u*)(proj + r_ * L0P + col); ld[8 + (ar * 2 + i) * 2 + 1] = *(const v4u*)(proj + rp_ * L0P + col); } } while (0)
#define PREP_BUILD(T0, NB) do { const int t0_ = (T0); LAS float* CHn = sm + RW2_CH0 + (NB) * RW_CHSZ; \
            f32x4 accw[4], acca[4]; \
            _Pragma("unroll") for (int nt = 0; nt < 4; ++nt) { accw[nt] = (f32x4){0.f, 0.f, 0.f, 0.f}; acca[nt] = (f32x4){0.f, 0.f, 0.f, 0.f}; } \
            { const float pz_ = (t0_ + tb + l15 == 0) ? 0.f : 1.f; \
              _Pragma("unroll") for (int lo = 0; lo < 2; ++lo) _Pragma("unroll") for (int ks = 0; ks < 2; ++ks) { float s_[8]; \
                const f32x4 m0 = *(const LAS f32x4*)(sm + RW2_MIX + 64 * lo + 32 * ks + 8 * kg), m1 = *(const LAS f32x4*)(sm + RW2_MIX + 64 * lo + 32 * ks + 8 * kg + 4); \
                RW_SH8(ld[(lo * 2 + ks) * 2], ld[(lo * 2 + ks) * 2 + 1], m0, m1, s_, pz_); \
                if (lo == 0) { _Pragma("unroll") for (int j = 0; j < 8; ++j) s_[j] = tanh_fast(s_[j]); } \
                v4u aw; aw.x = cvtpk(s_[0], s_[1]); aw.y = cvtpk(s_[2], s_[3]); aw.z = cvtpk(s_[4], s_[5]); aw.w = cvtpk(s_[6], s_[7]); const bf16x8 af = __builtin_bit_cast(bf16x8, aw); \
                const bf16_t* WT = lo ? A2T : W2T; \
                _Pragma("unroll") for (int nt = 0; nt < 4; ++nt) { const bf16x8 bfr = *(const bf16x8*)(WT + (size_t)(h * 64 + 16 * nt + l15) * 64 + 32 * ks + 8 * kg); \
                    if (lo == 0) accw[nt] = MFMA16(af, bfr, accw[nt]); else acca[nt] = MFMA16(af, bfr, acca[nt]); } } } \
            _Pragma("unroll") for (int ar = 0; ar < 3; ++ar) _Pragma("unroll") for (int i = 0; i < 2; ++i) { const int p_ = lane + 64 * i, row_ = p_ >> 3, c8_ = p_ & 7; float s_[8]; \
                const float pz_ = (t0_ + tb + row_ == 0) ? 0.f : 1.f; const f32x4 m0 = *(const LAS f32x4*)(sm + RW2_MIX + 256 + ar * 64 + c8_ * 8), m1 = *(const LAS f32x4*)(sm + RW2_MIX + 256 + ar * 64 + c8_ * 8 + 4); \
                RW_SH8(ld[8 + (ar * 2 + i) * 2], ld[8 + (ar * 2 + i) * 2 + 1], m0, m1, s_, pz_); \
                *(LAS f32x4*)(stg + ar * 1024 + row_ * 64 + c8_ * 8) = (f32x4){s_[0], s_[1], s_[2], s_[3]}; *(LAS f32x4*)(stg + ar * 1024 + row_ * 64 + c8_ * 8 + 4) = (f32x4){s_[4], s_[5], s_[6], s_[7]}; } \
            WSYNC(); \
            PREP_ISSUE(((T0) + 32 < SEQ) ? (T0) + 32 : (T0)); \
            _Pragma("unroll") for (int rg = 0; rg < 4; ++rg) { const int tl = 4 * kg + rg, t = tb + tl; \
                float r_[4], k_[4], v_[4], kkv[4], nrm2 = 0.f; \
                _Pragma("unroll") for (int nt = 0; nt < 4; ++nt) { r_[nt] = stg[tl * 64 + 16 * nt + l15]; k_[nt] = stg[1024 + tl * 64 + 16 * nt + l15]; v_[nt] = stg[2048 + tl * 64 + 16 * nt + l15]; \
                    kkv[nt] = k_[nt] * kkc[nt]; nrm2 += kkv[nt] * kkv[nt]; } \
                nrm2 = rowsum16(nrm2); const float rn = __builtin_amdgcn_rsqf(fmaxf(nrm2, 1e-24f)); \
                float br = 0.f, kr = 0.f, bon = 0.f; \
                _Pragma("unroll") for (int nt = 0; nt < 4; ++nt) { const int j = 16 * nt + l15; \
                    const float wsum = w0c[nt] + accw[nt][rg]; const float logw = -softplus_fast(-wsum) - 0.5f; const float dec = __expf(-__expf(logw)); \
                    const float a_ = sigmoid_fast(a0c[nt] + acca[nt][rg]); const float kn = kkv[nt] * rn; \
                    const float k2 = k_[nt] * (1.f + (a_ - 1.f) * kac[nt]); const float bv = kn * a_; \
                    br += bv * r_[nt]; kr += k2 * r_[nt]; bon += r_[nt] * k2 * rkc[nt]; \
                    CHn[t * 64 + j] = dec; CHn[2048 + t * 64 + j] = k2; CHn[4096 + t * 64 + j] = -kn; CHn[6144 + t * 64 + j] = bv; CHn[8192 + t * 64 + j] = dec * r_[nt]; \
                    if ((nt >> 1) == half) CHn[10240 + t * 32 + (j & 31)] = v_[nt]; } \
                br = rowsum16(br); kr = rowsum16(kr); bon = rowsum16(bon); \
                if (l15 == 0) { CHn[11264 + 2 * t] = br; CHn[11264 + 2 * t + 1] = kr; if (half == 0) bonus_out[(rowb + t0_ + t) * 8 + h] = bon; } } \
            WSYNC(); } while (0)
        PREP_ISSUE(0);
        PREP_BUILD(0, 0);
        __syncthreads();
#pragma unroll 1
        for (int ch = 0; ch < NCHUNK; ++ch) {
            if (ch + 1 < NCHUNK) PREP_BUILD(ch * 32 + 32, (ch + 1) & 1);
            __syncthreads();
        }
#undef PREP_ISSUE
#undef PREP_BUILD
    } else {
        const int tp = wave - 6, tb = 16 * tp;
        v4u ld[8];
#define G_ISSUE(T0) do { const int t0_ = (T0); const size_t r_ = rowb + t0_ + tb + l15; const size_t rp_ = (t0_ + tb + l15 == 0) ? r_ : r_ - 1; \
            _Pragma("unroll") for (int ks = 0; ks < 4; ++ks) { const int col = 1664 + 32 * ks + 8 * kg; ld[2 * ks] = *(const v4u*)(proj + r_ * L0P + col); ld[2 * ks + 1] = *(const v4u*)(proj + rp_ * L0P + col); } } while (0)
#define G_BUILD(T0) do { const int t0_ = (T0); f32x4 accg[2] = {(f32x4){0.f, 0.f, 0.f, 0.f}, (f32x4){0.f, 0.f, 0.f, 0.f}}; const float pz_ = (t0_ + tb + l15 == 0) ? 0.f : 1.f; \
            _Pragma("unroll") for (int ks = 0; ks < 4; ++ks) { float s_[8]; \
                const f32x4 m0 = *(const LAS f32x4*)(sm + RW2_MIX + 128 + 32 * ks + 8 * kg), m1 = *(const LAS f32x4*)(sm + RW2_MIX + 128 + 32 * ks + 8 * kg + 4); \
                RW_SH8(ld[2 * ks], ld[2 * ks + 1], m0, m1, s_, pz_); \
                _Pragma("unroll") for (int j = 0; j < 8; ++j) s_[j] = sigmoid_fast(s_[j]); \
                v4u aw; aw.x = cvtpk(s_[0], s_[1]); aw.y = cvtpk(s_[2], s_[3]); aw.z = cvtpk(s_[4], s_[5]); aw.w = cvtpk(s_[6], s_[7]); const bf16x8 af = __builtin_bit_cast(bf16x8, aw); \
                _Pragma("unroll") for (int nt = 0; nt < 2; ++nt) { const bf16x8 bfr = *(const bf16x8*)(G2T + (size_t)(h * 64 + half * 32 + 16 * nt + l15) * 128 + 32 * ks + 8 * kg); accg[nt] = MFMA16(af, bfr, accg[nt]); } } \
            G_ISSUE(((T0) + 32 < SEQ) ? (T0) + 32 : (T0)); \
            _Pragma("unroll") for (int nt = 0; nt < 2; ++nt) _Pragma("unroll") for (int rg = 0; rg < 4; ++rg) \
                gout[(rowb + t0_ + tb + 4 * kg + rg) * 512 + h * 64 + half * 32 + 16 * nt + l15] = (bf16_t)f2bf(accg[nt][rg]); } while (0)
        G_ISSUE(0);
        G_BUILD(0);
        __syncthreads();
#pragma unroll 1
        for (int ch = 0; ch < NCHUNK; ++ch) {
            if (ch + 1 < NCHUNK) G_BUILD(ch * 32 + 32);
            __syncthreads();
        }
#undef G_ISSUE
#undef G_BUILD
    }
#undef RW_SH8
    __syncthreads();
}
template <bool ST = true> __device__ __forceinline__ void rwkv_post_all(const float* __restrict__ yraw, const bf16_t* __restrict__ proj, const float* __restrict__ mix, const float* __restrict__ bonus, const bf16_t* __restrict__ gbuf,
                                              const float* __restrict__ ln_g, const float* __restrict__ ln_b, bf16_t* __restrict__ ymix, int gw, int NGW, int lane) {
    for (int task = gw; task < M * 8; task += NGW) {
        const int m = task >> 3, h = task & 7, c = h * 64 + lane;
        const float y = yraw[(size_t)m * 512 + c];
        const float mu = wave_sum(y) * (1.f / 64.f), d = y - mu, var = wave_sum(d * d) * (1.f / 64.f);
        const float yn = d * (1.0f / sqrtf(var + 64e-5f)) * ln_g[c] + ln_b[c];
        const float cv = bf2f(proj[(size_t)m * L0P + 1024 + c]); const float pv = (m & (SEQ - 1)) ? bf2f(proj[(size_t)(m - 1) * L0P + 1024 + c]) : 0.f;
        const float v_s = cv + (pv - cv) * mix[1024 + c];
        const float o = (yn + bonus[(size_t)m * 8 + h] * v_s) * bf2f(gbuf[(size_t)m * 512 + c]);
        if (ST) ymix[(size_t)m * DM + c] = (bf16_t)f2bf(o); else asm volatile("" :: "v"(o));
    }
}


__device__ __forceinline__ void ssd_conv_tile(int it, int lane, LAS bf16_t* scr, const bf16_t* __restrict__ proj, const float* __restrict__ cw, const float* __restrict__ cb,
                                              bf16_t* __restrict__ xbc, bf16_t* __restrict__ xst, bf16_t* __restrict__ bt) {
    const int tt = it >> 4, ct = it & 15, m0 = tt * 64, b = m0 >> 11, t0 = m0 & (SEQ - 1), c = ct * 64 + lane;
    const float w0 = cw[c], w1 = cw[1024 + c], w2 = cw[2048 + c], w3 = cw[3072 + c], bias = cb[c];
    const bf16_t* src = proj + (size_t)m0 * L0P + 2304 + c;
    float u3 = 0.f, u2 = 0.f, u1 = 0.f;
    if (t0 > 0) { u3 = bf2f(src[-3 * L0P]); u2 = bf2f(src[-2 * L0P]); u1 = bf2f(src[-1 * L0P]); }
#pragma unroll 8
    for (int t = 0; t < 64; ++t) {
        const float u = bf2f(src[(size_t)t * L0P]);
        const float y = bias + w0 * u3 + w1 * u2 + w2 * u1 + w3 * u;
        const bf16_t o = (bf16_t)f2bf(y / (1.f + __expf(-y)));
        xbc[(size_t)(m0 + t) * 1024 + c] = o;
        scr[t * STG_PITCH + lane] = o;
        u3 = u2; u2 = u1; u1 = u;
    }
    WSYNC();
    if (ct < 12) {
        bf16_t* dst = (ct < 8) ? xst + ((size_t)(b * 8 + ct) * 64) * SEQ + t0 : bt + ((size_t)(b * 2 + ((ct - 8) >> 1)) * 128 + ((ct - 8) & 1) * 64) * SEQ + t0;
#pragma unroll
        for (int i = 0; i < 8; ++i) { const int d = i * 8 + (lane >> 3), tc = lane & 7; const LAS bf16_t* p = scr + (tc * 8) * STG_PITCH + d;
            v4u o; o.x = (unsigned)p[0] | ((unsigned)p[STG_PITCH] << 16); o.y = (unsigned)p[2 * STG_PITCH] | ((unsigned)p[3 * STG_PITCH] << 16);
            o.z = (unsigned)p[4 * STG_PITCH] | ((unsigned)p[5 * STG_PITCH] << 16); o.w = (unsigned)p[6 * STG_PITCH] | ((unsigned)p[7 * STG_PITCH] << 16);
            *(v4u*)(dst + (size_t)d * SEQ + tc * 8) = o; }
    }
    WSYNC();
}
__device__ __forceinline__ void scan128(float& x0, float& x1, int lane) {
#pragma unroll
    for (int o = 1; o < 64; o <<= 1) { const float t0 = __shfl_up(x0, o), t1 = __shfl_up(x1, o); if (lane >= o) { x0 += t0; x1 += t1; } }
    x1 += __shfl(x0, 63);
}
__device__ __forceinline__ void ssd_s1_unit(int unit, int lane, LAS float* tab, const bf16_t* __restrict__ xst, const bf16_t* __restrict__ bt, const float* __restrict__ dt, const float* __restrict__ a_log,
                                            float* __restrict__ sloc, float* __restrict__ asum) {
    const int h = unit & 7, c = (unit >> 3) & 15, b = unit >> 7, g = h >> 2, l0 = c * 128, l31 = lane & 31, hi = lane >> 5;
    const size_t m0 = (size_t)b * SEQ + l0;
    const float A = -expf(a_log[h]);
    const float d0 = dt[(m0 + lane) * 8 + h], d1 = dt[(m0 + 64 + lane) * 8 + h];
    float ac0 = d0 * A, ac1 = d1 * A;
    scan128(ac0, ac1, lane);
    const float aend = __shfl(ac1, 63);
    tab[lane] = __expf(aend - ac0) * d0; tab[64 + lane] = __expf(aend - ac1) * d1;
    if (lane == 0) asum[unit] = aend;
    WSYNC();
    f32x16 acc[2][4];
#pragma unroll
    for (int pt = 0; pt < 2; ++pt)
#pragma unroll
        for (int nt = 0; nt < 4; ++nt)
#pragma unroll
            for (int r = 0; r < 16; ++r) acc[pt][nt][r] = 0.f;
    const bf16_t* Xp = xst + ((size_t)(b * 8 + h) * 64 + l31) * SEQ + l0 + 8 * hi;
    const bf16_t* Bp = bt + ((size_t)(b * 2 + g) * 128 + l31) * SEQ + l0 + 8 * hi;
#pragma unroll 2
    for (int kk = 0; kk < 8; ++kk) {
        const f32x4 wa = *(const LAS f32x4*)(tab + 16 * kk + 8 * hi), wb = *(const LAS f32x4*)(tab + 16 * kk + 8 * hi + 4);
        bf16x8 af[2], bfr[4];
#pragma unroll
        for (int pt = 0; pt < 2; ++pt) { const v4u raw = *(const v4u*)(Xp + (size_t)pt * 32 * SEQ + 16 * kk);
            v4u w; w.x = cvtpk(bflo(raw.x) * wa[0], bfhi(raw.x) * wa[1]); w.y = cvtpk(bflo(raw.y) * wa[2], bfhi(raw.y) * wa[3]);
            w.z = cvtpk(bflo(raw.z) * wb[0], bfhi(raw.z) * wb[1]); w.w = cvtpk(bflo(raw.w) * wb[2], bfhi(raw.w) * wb[3]); af[pt] = __builtin_bit_cast(bf16x8, w); }
#pragma unroll
        for (int nt = 0; nt < 4; ++nt) bfr[nt] = *(const bf16x8*)(Bp + (size_t)nt * 32 * SEQ + 16 * kk);
#pragma unroll
        for (int pt = 0; pt < 2; ++pt)
#pragma unroll
            for (int nt = 0; nt < 4; ++nt) acc[pt][nt] = MFMA32(af[pt], bfr[nt], acc[pt][nt]);
    }
    float* dst = sloc + (size_t)unit * 8192 + l31;
#pragma unroll
    for (int pt = 0; pt < 2; ++pt)
#pragma unroll
        for (int nt = 0; nt < 4; ++nt)
#pragma unroll
            for (int r = 0; r < 16; ++r) dst[(32 * pt + crow(r, hi)) * 128 + 32 * nt] = acc[pt][nt][r];
    WSYNC();
}
__device__ __forceinline__ void ssd_s2_all(const float* __restrict__ sloc, const float* __restrict__ asum, bf16_t* __restrict__ stb, int gtid, int NT) {
    for (int i = gtid; i < 128 * 2048; i += NT) {
        const int bh = i >> 11, e4 = i & 2047, b = bh >> 3, h = bh & 7;
        f32x4 run = {0.f, 0.f, 0.f, 0.f};
#pragma unroll 4
        for (int c = 0; c < 16; ++c) { const int unit = (b * 16 + c) * 8 + h; const f32x4 tmp = *(const f32x4*)(sloc + (size_t)unit * 8192 + e4 * 4);
            uint2 w; w.x = cvtpk(run[0], run[1]); w.y = cvtpk(run[2], run[3]); *(uint2*)(stb + (size_t)unit * 8192 + e4 * 4) = w;
            run = run * __expf(asum[unit]) + tmp; }
    }
}
__device__ __forceinline__ void ssd_s3_unit(int unit, int lane, LAS float* tab, const bf16_t* __restrict__ xbc, const bf16_t* __restrict__ xst, const bf16_t* __restrict__ stb, const float* __restrict__ dt,
                                            const float* __restrict__ a_log, const float* __restrict__ dsk, bf16_t* __restrict__ yssm) {
    const int h = unit & 7, c = (unit >> 3) & 15, b = unit >> 7, g = h >> 2, l0 = c * 128, l31 = lane & 31, hi = lane >> 5;
    const size_t m0 = (size_t)b * SEQ + l0;
    const float A = -expf(a_log[h]), D = dsk[h];
    const float d0 = dt[(m0 + lane) * 8 + h], d1 = dt[(m0 + 64 + lane) * 8 + h];
    float ac0 = d0 * A, ac1 = d1 * A;
    scan128(ac0, ac1, lane);
    tab[lane] = ac0; tab[64 + lane] = ac1; tab[128 + lane] = d0; tab[192 + lane] = d1;
    WSYNC();
    const bf16_t* Cp = xbc + (m0 + l31) * 1024 + 768 + g * 128 + 8 * hi;
    const bf16_t* Sp = stb + (size_t)unit * 8192 + l31 * 128 + 8 * hi;
    const bf16_t* Bp = xbc + (m0 + l31) * 1024 + 512 + g * 128 + 8 * hi;
    const bf16_t* Xp = xst + ((size_t)(b * 8 + h) * 64 + l31) * SEQ + l0 + 4 * hi;
    LAS float* tr = tab + 256;
    const int row = lane >> 1, p0 = (lane & 1) * 16;
#pragma unroll 1
    for (int lt = 0; lt < 4; ++lt) {
        f32x16 y[2];
#pragma unroll
        for (int r = 0; r < 16; ++r) { y[0][r] = 0.f; y[1][r] = 0.f; }
        const float acl = tab[32 * lt + l31];
#pragma unroll 4
        for (int kk = 0; kk < 8; ++kk) {
            const bf16x8 cf = *(const bf16x8*)(Cp + (size_t)lt * 32 * 1024 + 16 * kk);
            const bf16x8 s0 = *(const bf16x8*)(Sp + 16 * kk), s1 = *(const bf16x8*)(Sp + 32 * 128 + 16 * kk);
            y[0] = MFMA32(s0, cf, y[0]); y[1] = MFMA32(s1, cf, y[1]);
        }
        { const float el = __expf(acl);
#pragma unroll
          for (int r = 0; r < 16; ++r) { y[0][r] *= el; y[1][r] *= el; } }
#pragma unroll 1
        for (int st = 0; st <= lt; ++st) {
            f32x16 cbt;
#pragma unroll
            for (int r = 0; r < 16; ++r) cbt[r] = 0.f;
#pragma unroll 4
            for (int kk = 0; kk < 8; ++kk) { const bf16x8 bf_ = *(const bf16x8*)(Bp + (size_t)st * 32 * 1024 + 16 * kk), cf_ = *(const bf16x8*)(Cp + (size_t)lt * 32 * 1024 + 16 * kk); cbt = MFMA32(bf_, cf_, cbt); }
#pragma unroll
            for (int r = 0; r < 16; ++r) { const int sl = 32 * st + crow(r, hi); const float acs = tab[sl], dts = tab[128 + sl];
                float v = cbt[r] * __expf(acl - acs) * dts; if (st == lt && crow(r, hi) > l31) v = 0.f; cbt[r] = v; }
            bf16x8 pf[2];
#pragma unroll
            for (int ks = 0; ks < 2; ++ks) { v4u w; w.x = cvtpk(cbt[8 * ks], cbt[8 * ks + 1]); w.y = cvtpk(cbt[8 * ks + 2], cbt[8 * ks + 3]); w.z = cvtpk(cbt[8 * ks + 4], cbt[8 * ks + 5]); w.w = cvtpk(cbt[8 * ks + 6], cbt[8 * ks + 7]); pf[ks] = __builtin_bit_cast(bf16x8, w); }
#pragma unroll
            for (int pt = 0; pt < 2; ++pt)
#pragma unroll
                for (int ks = 0; ks < 2; ++ks) { const bf16_t* xp = Xp + (size_t)pt * 32 * SEQ + st * 32 + 16 * ks; const u32x2 x0 = *(const u32x2*)xp, x1 = *(const u32x2*)(xp + 8);
                    v4u a; a.x = x0.x; a.y = x0.y; a.z = x1.x; a.w = x1.y; y[pt] = MFMA32(__builtin_bit_cast(bf16x8, a), pf[ks], y[pt]); }
        }
#pragma unroll
        for (int pt = 0; pt < 2; ++pt) {
#pragma unroll
            for (int r = 0; r < 16; ++r) tr[l31 * 33 + crow(r, hi)] = y[pt][r];
            WSYNC();
            const size_t m = m0 + 32 * lt + row;
            const v4u xa = *(const v4u*)(xbc + m * 1024 + h * 64 + 32 * pt + p0), xb = *(const v4u*)(xbc + m * 1024 + h * 64 + 32 * pt + p0 + 8);
            const unsigned xu[8] = {xa.x, xa.y, xa.z, xa.w, xb.x, xb.y, xb.z, xb.w};
            unsigned ow[8];
#pragma unroll
            for (int q = 0; q < 8; ++q) { const float v0 = tr[row * 33 + p0 + 2 * q] + D * bflo(xu[q]), v1 = tr[row * 33 + p0 + 2 * q + 1] + D * bfhi(xu[q]); ow[q] = cvtpk(v0, v1); }
            bf16_t* dst = yssm + m * 512 + h * 64 + 32 * pt + p0;
            *(v4u*)dst = (v4u){ow[0], ow[1], ow[2], ow[3]}; *(v4u*)(dst + 8) = (v4u){ow[4], ow[5], ow[6], ow[7]};
            WSYNC();
        }
    }
}

struct Args { const float* in[43]; float* out; unsigned char* ws; };
#define GEMM_PHASE(EPI, Aptr, LDA, Bptr, LDB, NN, KK, ...) do { pg8::Gemm g_{(Aptr), (Bptr), M, (NN), (KK), (LDA), (LDB)}; pg8::StaticOrder S_; S_.init(M, (NN), G, (int)blockIdx.x); \
        pg8::EPI E_{__VA_ARGS__}; pg8::gemm_phase<pg8::EPI, pg8::StaticOrder, true, true>(lds3, g_, S_, E_); } while (0)

__global__ void __launch_bounds__(NWAVES * 64, 2) fwd_mega(Args args) {
    extern __shared__ __attribute__((aligned(16))) unsigned char lds[];
    LAS unsigned char* lds3 = (LAS unsigned char*)lds;
    volatile LAS unsigned* MISC = (volatile LAS unsigned*)(lds3 + MISC_OFF);
    const int G = gridDim.x, NGW = G * NWAVES, NT = G * NWAVES * 64;
#define PHASE_IDS() int tid = threadIdx.x; asm volatile("" : "+v"(tid)); const int lane = tid & 63, wave = __builtin_amdgcn_readfirstlane(tid >> 6); const int gw = blockIdx.x * NWAVES + wave, gtid = blockIdx.x * (NWAVES * 64) + tid; (void)lane; (void)gw; (void)gtid
    unsigned char* ws = args.ws;
    gu32* ctl = (gu32*)(ws + WS_CTL);
    for (int u = threadIdx.x; u < (LDS_BYTES - LDSCTL_OFF) / 4; u += NWAVES * 64) ((LAS unsigned*)(lds3 + LDSCTL_OFF))[u] = 0u;
    __syncthreads();
    XcdBarrier bar = xcd_barrier_post((unsigned*)(ctl + CW_BAR), MISC + 8);
#define GRID_BAR() xcd_barrier(bar)
#define IN(i) (args.in[i])
    float* out = args.out;
    bf16_t* W0in = (bf16_t*)(ws + WS_W0IN); bf16_t* W0out = (bf16_t*)(ws + WS_W0OUT); bf16_t* Wup0 = (bf16_t*)(ws + WS_WUP0); bf16_t* Wdn0 = (bf16_t*)(ws + WS_WDN0);
    bf16_t* W1in = (bf16_t*)(ws + WS_W1IN); bf16_t* Wuq = (bf16_t*)(ws + WS_WUQ); bf16_t* Wukv = (bf16_t*)(ws + WS_WUKV); bf16_t* W1out = (bf16_t*)(ws + WS_W1OUT);
    bf16_t* Wup1 = (bf16_t*)(ws + WS_WUP1); bf16_t* Wdn1 = (bf16_t*)(ws + WS_WDN1);
    bf16_t* XB = (bf16_t*)(ws + WS_XB); bf16_t* YMIX = (bf16_t*)(ws + WS_YMIX); bf16_t* PROJ0 = (bf16_t*)(ws + WS_BIG);
    float* YRAW = out; bf16_t* YSSM = (bf16_t*)(out + (size_t)M * 512); bf16_t* STB = (bf16_t*)(out + (size_t)M * 768); bf16_t* XST = (bf16_t*)(ws + WS_XST); bf16_t* BT = (bf16_t*)(ws + WS_BT); float* ASUM = (float*)(ws + WS_ASUM); float* SLOC = (float*)(ws + WS_SLOC); float* DT = (float*)(ws + WS_DT); bf16_t* GB = (bf16_t*)(ws + WS_G); float* BONUS = (float*)(ws + WS_BONUS);
    bf16_t* W2T = (bf16_t*)(ws + WS_W2T); bf16_t* A2T = (bf16_t*)(ws + WS_A2T); bf16_t* G2T = (bf16_t*)(ws + WS_G2T); bf16_t* GU = (bf16_t*)(ws + WS_GU);
    bf16_t* PROJ1 = (bf16_t*)(ws + WS_PROJ1); bf16_t* QM = (bf16_t*)(ws + WS_QM); bf16_t* KVM = (bf16_t*)(ws + WS_KVM); bf16_t* KPE = (bf16_t*)(ws + WS_KPE); float* RS = (float*)(ws + WS_RS); bf16_t* VTS = (bf16_t*)(ws + WS_VTS); bf16_t* VTM = (bf16_t*)(ws + WS_VTM);
    const int* pos = (const int*)args.in[1];

    {
        PHASE_IDS();
    {
        LAS float* scr = (LAS float*)(lds3 + wave * 16384);
        transpose_matrix(IN(2), 1024, 3336, W0in, L0P, 1024, scr, gw, NGW, lane, nullptr);
        transpose_matrix(IN(20), 1024, 1024, W0out, 1024, 1024, scr, gw, NGW, lane, nullptr);
        transpose_matrix(IN(23), 1024, 5632, Wup0, 5632, 1024, scr, gw, NGW, lane, nullptr);
        transpose_matrix(IN(26), 2816, 1024, Wdn0, 1024, 2816, scr, gw, NGW, lane, nullptr);
        transpose_matrix(IN(29), 1024, 1952, W1in, L1P, 1024, scr, gw, NGW, lane, nullptr);
        transpose_matrix(IN(31), 256, 768, Wuq, 768, 256, scr, gw, NGW, lane, IN(30));
        transpose_matrix(IN(33), 128, 1024, Wukv, 1024, 256, scr, gw, NGW, lane, IN(32));
        for (int i = gtid; i < 1024 * 16; i += NT) { const int n = i >> 4, c = i & 15; *(v4u*)(Wukv + (size_t)n * 256 + 128 + c * 8) = (v4u){0u, 0u, 0u, 0u}; }
        transpose_matrix(IN(34), 1024, 1024, W1out, 1024, 1024, scr, gw, NGW, lane, nullptr);
        transpose_matrix(IN(37), 1024, 5632, Wup1, 5632, 1024, scr, gw, NGW, lane, nullptr);
        transpose_matrix(IN(40), 2816, 1024, Wdn1, 1024, 2816, scr, gw, NGW, lane, nullptr);
        transpose_matrix(IN(5), 64, 512, W2T, 512, 64, scr, gw, NGW, lane, nullptr);
        transpose_matrix(IN(7), 64, 512, A2T, 512, 64, scr, gw, NGW, lane, nullptr);
        transpose_matrix(IN(8), 128, 512, G2T, 512, 128, scr, gw, NGW, lane, nullptr);
        const float* x = IN(0);
        for (size_t i = (size_t)gtid * 4; i < (size_t)M * DM; i += (size_t)NT * 4) { const f32x4 v = *(const f32x4*)(x + i); uint2 w; w.x = pk2(v[0], v[1]); w.y = pk2(v[2], v[3]); *(uint2*)(XB + i) = w; }
    }
    }
    GRID_BAR();
    {
        PHASE_IDS();
    GEMM_PHASE(EpiBf16S, XB, DM, W0in, 1024, L0P, 1024, PROJ0, nullptr, L0P, 0);
    }
    GRID_BAR();
    {
        PHASE_IDS();
        const int blk = (int)blockIdx.x, m0 = blk * 128;
        {   LAS bf16_t* scr = (LAS bf16_t*)(lds3 + wave * 16384);
#pragma unroll 1
            for (int k = 0; k < 4; ++k) ssd_conv_tile((2 * blk + (k & 1)) * 16 + wave + 8 * (k >> 1), lane, scr, PROJ0, IN(14), IN(15), XB, XST, BT);
            for (int i = tid; i < 1024; i += NWAVES * 64) { const int m = m0 + (i >> 3); DT[(size_t)m * 8 + (i & 7)] = softplusf_(bf2f(PROJ0[(size_t)m * L0P + 3328 + (i & 7)]) + IN(16)[i & 7]); }
        }
        __syncthreads();
        ssd_s1_unit(blk * 8 + wave, lane, (LAS float*)(lds3 + wave * 16384), XST, BT, DT, IN(17), SLOC, ASUM);
    }
    GRID_BAR();
    {
        PHASE_IDS();
        ssd_s2_all(SLOC, ASUM, STB, gtid, NT);
        rwkv_phase((LAS float*)lds3, tid, lane, wave, (int)blockIdx.x, PROJ0, IN(3), IN(4), IN(6), IN(9), IN(10), IN(11), W2T, A2T, G2T, YRAW, GB, BONUS);
    }
    GRID_BAR();
    {
        PHASE_IDS();
        const int blk = (int)blockIdx.x;
        ssd_s3_unit(blk * 8 + wave, lane, (LAS float*)(lds3 + wave * 16384), XB, XST, STB, DT, IN(17), IN(18), YSSM);
        __syncthreads();
        ssm_gate_norm_all(YSSM, PROJ0, IN(19), YMIX, blk * 256 + wave, blk * 256 + 256, lane);
        rwkv_post_all(YRAW, PROJ0, IN(3), BONUS, GB, IN(12), IN(13), YMIX, gw, NGW, lane);
    }
    GRID_BAR();
    {
        PHASE_IDS();
    GEMM_PHASE(EpiResid, YMIX, DM, W0out, 1024, 1024, 1024, IN(0), out, ALPHA, 0);
    }
    GRID_BAR();
    {
        PHASE_IDS();
    ln_rows(out, XB, IN(21), IN(22), gw, NGW, lane);
    }
    GRID_BAR();
    {
        PHASE_IDS();
    GEMM_PHASE(EpiBf16S, XB, DM, Wup0, 1024, 2 * DFF, 1024, GU, nullptr, 2 * DFF, 0);
    }
    GRID_BAR();
    {
        PHASE_IDS();
    ffn_act_all(GU, IN(24), IN(25), gtid, NT);
    }
    GRID_BAR();
    {
        PHASE_IDS();
    GEMM_PHASE(EpiResid, GU + DFF, 2 * DFF, Wdn0, DFF, 1024, DFF, out, out, ALPHA, 0);
    }
    GRID_BAR();
    {
        PHASE_IDS();
    ln_rows(out, XB, IN(27), IN(28), gw, NGW, lane);
    }
    GRID_BAR();
    {
        PHASE_IDS();
    GEMM_PHASE(EpiBf16S, XB, DM, W1in, 1024, L1P, 1024, PROJ1, nullptr, L1P, 0);
    }
    GRID_BAR();
    {
        PHASE_IDS();
    mla_prep_all(PROJ1, pos, RS, KPE, gw, NGW, lane);
    }
    GRID_BAR();
    {
        PHASE_IDS();
    GEMM_PHASE(EpiBf16S, PROJ1 + 1536, L1P, Wuq, 256, 768, 256, QM, RS, 768, 2);
    GEMM_PHASE(EpiBf16S, PROJ1 + 1792, L1P, Wukv, 256, 1024, 256, KVM, RS + 1, 1024, 2);
    }
    GRID_BAR();
    {
        PHASE_IDS();
    rope_q_all(QM, pos, gtid, NT);
    {
        LAS bf16_t* scr = (LAS bf16_t*)(lds3 + wave * 16384);
        for (int it = gw; it < 8192; it += NGW) { const int which = it >> 12, r = it & 4095, bh = r >> 5, tt = r & 31, b = bh >> 3, h = bh & 7;
            if (which == 0) transpose_tile64(PROJ1 + ((size_t)b * SEQ + tt * 64) * L1P + 1024 + h * 64, L1P, VTS + (size_t)bh * 64 * SEQ + tt * 64, SEQ, scr, lane);
            else            transpose_tile64(KVM + ((size_t)b * SEQ + tt * 64) * 1024 + h * 128 + 64, 1024, VTM + (size_t)bh * 64 * SEQ + tt * 64, SEQ, scr, lane); }
    }
    }
    GRID_BAR();
    {
        PHASE_IDS();
    {
        LAS bf16_t* stg = (LAS bf16_t*)(lds3 + wave * 16384);
        for (int g2 = gw; g2 < 2048; g2 += NGW) { const int bh = g2 >> 4, w = g2 & 15;
#pragma unroll 1
            for (int i = 0; i < 4; ++i) { const int qb = (i == 0) ? w : (i == 1) ? 31 - w : (i == 2) ? 32 + w : 63 - w;
                sb_task(bh, qb, lane, PROJ1, VTS, YMIX, stg);
                mla_task(bh, qb, lane, QM, KVM, KPE, VTM, YMIX, stg); } }
    }
    }
    GRID_BAR();
    {
        PHASE_IDS();
    GEMM_PHASE(EpiResid, YMIX, DM, W1out, 1024, 1024, 1024, out, out, ALPHA, 0);
    }
    GRID_BAR();
    {
        PHASE_IDS();
    ln_rows(out, XB, IN(35), IN(36), gw, NGW, lane);
    }
    GRID_BAR();
    {
        PHASE_IDS();
    GEMM_PHASE(EpiBf16S, XB, DM, Wup1, 1024, 2 * DFF, 1024, GU, nullptr, 2 * DFF, 0);
    }
    GRID_BAR();
    {
        PHASE_IDS();
    ffn_act_all(GU, IN(38), IN(39), gtid, NT);
    }
    GRID_BAR();
    {
        PHASE_IDS();
    GEMM_PHASE(EpiResid, GU + DFF, 2 * DFF, Wdn1, DFF, 1024, DFF, out, out, ALPHA, 0);
    }
    GRID_BAR();
    {
        PHASE_IDS();
    ln_rows(out, XB, IN(41), IN(42), gw, NGW, lane);
    }
}

extern "C" void kernel_launch(void* const* d_in, const int* in_sizes, int n_in, void* d_out, int out_size, void* d_ws, size_t ws_size, hipStream_t stream) {
    static int grid = 0;
    if (grid == 0) {
        if (n_in != 43 || ws_size < WS_NEED || out_size != M * DM) { fprintf(stderr, "kernel_launch: unexpected n_in %d / ws %zu / out %d\n", n_in, ws_size, out_size); grid = -1; return; }
        int dev = 0, cus = 0, per_cu = 0;
        if (hipGetDevice(&dev) != hipSuccess || hipDeviceGetAttribute(&cus, hipDeviceAttributeMultiprocessorCount, dev) != hipSuccess) { grid = -1; return; }
        if (hipFuncSetAttribute((const void*)fwd_mega, hipFuncAttributeMaxDynamicSharedMemorySize, LDS_BYTES) != hipSuccess) { fprintf(stderr, "kernel_launch: hipFuncSetAttribute failed\n"); grid = -1; return; }
        if (hipOccupancyMaxActiveBlocksPerMultiprocessor(&per_cu, (const void*)fwd_mega, NWAVES * 64, LDS_BYTES) != hipSuccess || per_cu < 1) fprintf(stderr, "kernel_launch: occupancy query reports %d\n", per_cu);
        (void)hipGetLastError();
        grid = cus;
    }
    if (grid < 0) return;
    (void)hipMemsetAsync((char*)d_ws + WS_CTL, 0, CTL_ZERO_BYTES, stream);
    Args a{};
    for (int i = 0; i < 43; ++i) a.in[i] = (const float*)d_in[i];
    a.out = (float*)d_out; a.ws = (unsigned char*)d_ws;
    hipLaunchKernelGGL(fwd_mega, dim3(grid), dim3(NWAVES * 64), LDS_BYTES, stream, a);
}
```

```cpp
#include <hip/hip_runtime.h>
#include <cstdio>
#include <cstdint>
#include <cmath>
namespace pg8 {
#define PG8_LAS __attribute__((address_space(3)))
typedef unsigned short bf16_t;
typedef short bf16x8 __attribute__((ext_vector_type(8)));
typedef float f32x4 __attribute__((ext_vector_type(4)));
typedef unsigned u32x4 __attribute__((ext_vector_type(4)));
constexpr int BM = 256, BK = 64, HALF = 128, HTB = HALF * BK * 2  , STAGE_BYTES = 8 * HTB, NXCD = 8, WGM = 8;

__host__ __device__ __forceinline__ int lds_byte(int r, int c) { const int st = (r >> 4) * 2 + (c >> 5), rr = r & 15, cc = c & 31, ob = rr * 64 + cc * 2; return st * 1024 + (ob ^ (((ob >> 9) & 1) << 5)); }
__host__ __device__ __forceinline__ void stage_rc(int b, int& R, int& C) { const int st = b / 1024, sb = b % 1024, swz = sb ^ (((sb >> 9) & 1) << 5); R = (st >> 1) * 16 + swz / 64; C = (st & 1) * 32 + (swz % 64) / 2; }
__host__ __device__ __forceinline__ int perm32(int rho) { const int n = rho >> 4, i = rho & 15; return 8 * (i >> 2) + 4 * n + (i & 3); }

struct Unit { int pm, pn; };
struct Gemm { const bf16_t* A; const bf16_t* Bt; int M, N, K, lda, ldb; };

struct StaticOrder {
    int nM, nN, nwg, G, c;
    __host__ __device__ void init(int M, int N, int G_, int c_) { nM = M / BM; nN = N / BM; nwg = nM * nN; G = G_; c = c_; }
    __host__ __device__ bool next(int i, Unit& u) const {
        const long L = (long)i * G + c; if (L >= nwg) return false;
        int wgid = (int)L; { const int q = nwg / NXCD, r = nwg % NXCD, xcd = wgid % NXCD, off = wgid / NXCD; wgid = (xcd < r ? xcd * (q + 1) : r * (q + 1) + (xcd - r) * q) + off; }
        const int nig = WGM * nN, gid = wgid / nig, fm = gid * WGM, gsz = (nM - fm) < WGM ? (nM - fm) : WGM;
        u.pm = fm + ((wgid % nig) % gsz); u.pn = (wgid % nig) / gsz; return true;
    }
    __device__ __forceinline__ void a_ready(const Unit&) const {}
    __device__ __forceinline__ void done(const Unit&) const {}
};


__device__ __forceinline__ unsigned cvt_pk_bf16(float lo, float hi) { unsigned r; asm volatile("v_cvt_pk_bf16_f32 %0, %1, %2" : "=v"(r) : "v"(lo), "v"(hi)); return r; }
struct EpiBf16S {
    static constexpr bool PERM = true, AFTER_DRAIN = false;
    bf16_t* O; const float* rowscale; int ldc; int rs_stride;
    __device__ __forceinline__ void operator()(const f32x4 (&acc)[2][2][4][2], const Unit& u, int wr, int wc, int fr, int fq) const {
        const int row0 = u.pm * BM + wr * 64 + fr, col0 = u.pn * BM + wc * 32 + 8 * fq;
#pragma unroll
        for (int ai = 0; ai < 2; ++ai)
#pragma unroll
            for (int m = 0; m < 4; ++m) { const int row = row0 + ai * HALF + m * 16; const float sc = rowscale ? rowscale[(size_t)row * rs_stride] : 1.f;
                bf16_t* rowp = O + (size_t)row * ldc + col0;
#pragma unroll
                for (int bj = 0; bj < 2; ++bj) { const f32x4 v0 = acc[ai][bj][m][0] * sc, v1 = acc[ai][bj][m][1] * sc;
                    u32x4 w; w.x = cvt_pk_bf16(v0[0], v0[1]); w.y = cvt_pk_bf16(v0[2], v0[3]); w.z = cvt_pk_bf16(v1[0], v1[1]); w.w = cvt_pk_bf16(v1[2], v1[3]);
                    *(u32x4*)(rowp + bj * HALF) = w; } }
    }
};
struct EpiResid {
    static constexpr bool PERM = false, AFTER_DRAIN = false;
    const float* hin; float* hout; float alpha; int pad;
    __device__ __forceinline__ void operator()(const f32x4 (&acc)[2][2][4][2], const Unit& u, int wr, int wc, int fr, int fq) const {
        const int row0 = u.pm * BM + wr * 64 + fr, col0 = u.pn * BM + wc * 32 + 4 * fq;
#pragma unroll
        for (int ai = 0; ai < 2; ++ai)
#pragma unroll
            for (int m = 0; m < 4; ++m) { const size_t off = (size_t)(row0 + ai * HALF + m * 16) * 1024 + col0;
#pragma unroll
                for (int bj = 0; bj < 2; ++bj)
#pragma unroll
                    for (int n = 0; n < 2; ++n) { const size_t i = off + bj * HALF + n * 16; const f32x4 h = *(const f32x4*)(hin + i); *(f32x4*)(hout + i) = h * alpha + acc[ai][bj][m][n]; } }
    }
};
template <class Epi, class Sched, bool ALIGN_EPI = false, bool SP2 = false>
__device__ __forceinline__ void gemm_phase(PG8_LAS unsigned char* lds, const Gemm g, const Sched& S, const Epi& E) {
    const int tid = threadIdx.x, wid = __builtin_amdgcn_readfirstlane(tid >> 6), lane = tid & 63, wr = wid >> 2, wc = wid & 3, fr = lane & 15, fq = lane >> 4;
    const int K = g.K, nt = K / BK;
    unsigned voffA[2], voffB[2];
#pragma unroll
    for (int i = 0; i < 2; ++i) { int R, C; stage_rc(tid * 16 + i * 8192, R, C); const int Rb = Epi::PERM ? ((R & ~31) + perm32(R & 31)) : R;
        voffA[i] = (unsigned)(R * g.lda + C) * 2u; voffB[i] = (unsigned)(Rb * g.ldb + C) * 2u; }
    const size_t kstep = (size_t)(BK * 2);
    const size_t hstepA = (size_t)HALF * g.lda * 2, hstepB = (size_t)HALF * g.ldb * 2;
    const size_t tstepA = 2 * hstepA, tstepB = 2 * hstepB;
    const unsigned ldsw = (unsigned)wid * 1024u;
    const int aoff = lds_byte(wr * 64 + fr, fq * 8), boff = lds_byte(wc * 32 + fr, fq * 8);
#define PG8_SA(b, h) (((b) * 2 + (h)) * HTB)
#define PG8_SB(b, h) ((4 + (b) * 2 + (h)) * HTB)
#define PG8_STAGE(bufoff, gbase, voff) do { _Pragma("unroll") for (int _i = 0; _i < 2; ++_i) \
        __builtin_amdgcn_global_load_lds((const unsigned*)((const char*)(gbase) + (voff)[_i]), (PG8_LAS unsigned*)(lds + (bufoff) + ldsw + _i * 8192), 16, 0, 0); } while (0)
#define PG8_LDA(dst, b, h) do { _Pragma("unroll") for (int m = 0; m < 4; ++m) _Pragma("unroll") for (int k = 0; k < 2; ++k) dst[m][k] = *(const PG8_LAS bf16x8*)(lds + PG8_SA(b, h) + aoff + m * 2048 + k * 1024); } while (0)
#define PG8_LDB(dst, b, h) do { _Pragma("unroll") for (int n = 0; n < 2; ++n) _Pragma("unroll") for (int k = 0; k < 2; ++k) dst[n][k] = *(const PG8_LAS bf16x8*)(lds + PG8_SB(b, h) + boff + n * 2048 + k * 1024); } while (0)
#define PG8_MMA(ai, bj, At, Bt) do { __builtin_amdgcn_s_setprio(1); _Pragma("unroll") for (int m = 0; m < 4; ++m) _Pragma("unroll") for (int n = 0; n < 2; ++n) _Pragma("unroll") for (int k = 0; k < 2; ++k) \
        acc[ai][bj][m][n] = __builtin_amdgcn_mfma_f32_16x16x32_bf16(Bt[n][k], At[m][k], acc[ai][bj][m][n], 0, 0, 0); __builtin_amdgcn_s_setprio(0); } while (0)
#define PG8_WAIT_V(n) asm volatile("s_waitcnt vmcnt(" #n ")" ::: "memory")
#define PG8_WAIT_L(n) asm volatile("s_waitcnt lgkmcnt(" #n ")" ::: "memory")
#define PG8_BAR __builtin_amdgcn_s_barrier()
#define PG8_SCHED __builtin_amdgcn_sched_barrier(0)
    Unit cur, nxt; int ui = 0;
    if (!S.next(0, cur)) return;
    f32x4 acc[2][2][4][2];
#pragma unroll
    for (int a = 0; a < 2; ++a)
#pragma unroll
        for (int b = 0; b < 2; ++b)
#pragma unroll
            for (int m = 0; m < 4; ++m)
#pragma unroll
                for (int n = 0; n < 2; ++n) acc[a][b][m][n] = (f32x4){0.f, 0.f, 0.f, 0.f};
    bf16x8 At[4][2], B0[2][2], B1[2][2];
    const char* cA = (const char*)g.A + (size_t)cur.pm * tstepA; const char* cB = (const char*)g.Bt + (size_t)cur.pn * tstepB;
    S.a_ready(cur);
    if constexpr (SP2) {
        PG8_STAGE(PG8_SB(0, 0), cB, voffB); PG8_STAGE(PG8_SB(0, 1), cB + hstepB, voffB); PG8_STAGE(PG8_SA(0, 0), cA, voffA); PG8_STAGE(PG8_SA(0, 1), cA + hstepA, voffA);
        if (wr == 1) PG8_BAR;
        PG8_WAIT_V(2); PG8_BAR;
        PG8_STAGE(PG8_SB(1, 0), cB + kstep, voffB); PG8_STAGE(PG8_SA(1, 0), cA + kstep, voffA); PG8_STAGE(PG8_SB(1, 1), cB + hstepB + kstep, voffB);
        PG8_WAIT_V(6); PG8_BAR;
    } else {
        PG8_STAGE(PG8_SB(0, 0), cB, voffB); PG8_STAGE(PG8_SA(0, 0), cA, voffA); PG8_STAGE(PG8_SB(0, 1), cB + hstepB, voffB); PG8_STAGE(PG8_SA(0, 1), cA + hstepA, voffA);
        if (wr == 1) PG8_BAR;
        PG8_WAIT_V(4); PG8_BAR;
        PG8_STAGE(PG8_SB(1, 0), cB + kstep, voffB); PG8_STAGE(PG8_SA(1, 0), cA + kstep, voffA); PG8_STAGE(PG8_SB(1, 1), cB + hstepB + kstep, voffB);
        PG8_WAIT_V(6); PG8_BAR;
    }
    for (;;) {
        const bool has_next = S.next(ui + 1, nxt);
        const char* nA = has_next ? (const char*)g.A + (size_t)nxt.pm * tstepA : cA; const char* nB = has_next ? (const char*)g.Bt + (size_t)nxt.pn * tstepB : cB;
        for (int t = 0; t < nt; t += 2) {
            const bool last = (t == nt - 2);
            const char* a1 = cA + (size_t)(t + 1) * kstep;
            const char* a2 = last ? nA : cA + (size_t)(t + 2) * kstep; const char* b2 = last ? nB : cB + (size_t)(t + 2) * kstep;
            const char* a3 = a2 + kstep; const char* b3 = b2 + kstep;
            if (last && has_next) S.a_ready(nxt);
            if constexpr (SP2) {
            PG8_LDB(B0, 0, 0); PG8_LDB(B1, 0, 1); PG8_SCHED; PG8_LDA(At, 0, 0); PG8_STAGE(PG8_SA(1, 1), a1 + hstepA, voffA);
            PG8_WAIT_V(8); PG8_WAIT_L(0); PG8_BAR; PG8_MMA(0, 0, At, B0); PG8_MMA(0, 1, At, B1); PG8_BAR; PG8_SCHED;
            PG8_LDA(At, 0, 1); PG8_STAGE(PG8_SB(0, 0), b2, voffB); PG8_STAGE(PG8_SB(0, 1), b2 + hstepB, voffB); PG8_STAGE(PG8_SA(0, 0), a2, voffA);
            PG8_WAIT_V(8); PG8_WAIT_L(0); PG8_BAR; PG8_MMA(1, 0, At, B0); PG8_MMA(1, 1, At, B1); PG8_BAR; PG8_SCHED;
            PG8_LDB(B0, 1, 0); PG8_LDB(B1, 1, 1); PG8_SCHED; PG8_LDA(At, 1, 0); PG8_STAGE(PG8_SA(0, 1), a2 + hstepA, voffA);
            PG8_WAIT_V(8); PG8_WAIT_L(0); PG8_BAR; PG8_MMA(0, 0, At, B0); PG8_MMA(0, 1, At, B1); PG8_BAR; PG8_SCHED;
            PG8_LDA(At, 1, 1); PG8_STAGE(PG8_SB(1, 0), b3, voffB); PG8_STAGE(PG8_SB(1, 1), b3 + hstepB, voffB); PG8_STAGE(PG8_SA(1, 0), a3, voffA);
            PG8_WAIT_V(8); PG8_WAIT_L(0); PG8_BAR; PG8_MMA(1, 0, At, B0); PG8_MMA(1, 1, At, B1); PG8_BAR; PG8_SCHED;
            } else {
            PG8_LDB(B0, 0, 0); PG8_SCHED; PG8_LDA(At, 0, 0); PG8_STAGE(PG8_SA(1, 1), a1 + hstepA, voffA);
            PG8_WAIT_L(8); PG8_BAR; PG8_WAIT_L(0); PG8_MMA(0, 0, At, B0); PG8_BAR; PG8_SCHED;
            PG8_LDB(B1, 0, 1); PG8_STAGE(PG8_SB(0, 0), b2, voffB);
            PG8_BAR; PG8_WAIT_L(0); PG8_MMA(0, 1, At, B1); PG8_BAR;
            PG8_LDA(At, 0, 1); PG8_STAGE(PG8_SA(0, 0), a2, voffA);
            PG8_BAR; PG8_WAIT_L(0); PG8_MMA(1, 0, At, B0); PG8_BAR; PG8_SCHED;
            PG8_STAGE(PG8_SB(0, 1), b2 + hstepB, voffB);
            PG8_WAIT_V(6); PG8_BAR; PG8_MMA(1, 1, At, B1); PG8_BAR;
            PG8_LDB(B0, 1, 0); PG8_SCHED; PG8_LDA(At, 1, 0); PG8_STAGE(PG8_SA(0, 1), a2 + hstepA, voffA);
            PG8_WAIT_L(8); PG8_BAR; PG8_WAIT_L(0); PG8_MMA(0, 0, At, B0); PG8_BAR; PG8_SCHED;
            PG8_LDB(B1, 1, 1); PG8_STAGE(PG8_SB(1, 0), b3, voffB);
            PG8_BAR; PG8_WAIT_L(0); PG8_MMA(0, 1, At, B1); PG8_BAR;
            PG8_LDA(At, 1, 1); PG8_STAGE(PG8_SA(1, 0), a3, voffA);
            PG8_BAR; PG8_WAIT_L(0); PG8_MMA(1, 0, At, B0); PG8_BAR; PG8_SCHED;
            PG8_STAGE(PG8_SB(1, 1), b3 + hstepB, voffB);
            PG8_WAIT_V(6); PG8_BAR; PG8_MMA(1, 1, At, B1); PG8_BAR;
            }
        }
        if constexpr (ALIGN_EPI) { if (wr == 0) PG8_BAR; }
        if constexpr (!Epi::AFTER_DRAIN) { E(acc, cur, wr, wc, fr, fq); S.done(cur); }
        if (!has_next) break;
#pragma unroll
        for (int a = 0; a < 2; ++a)
#pragma unroll
            for (int b = 0; b < 2; ++b)
#pragma unroll
                for (int m = 0; m < 4; ++m)
#pragma unroll
                    for (int n = 0; n < 2; ++n) acc[a][b][m][n] = (f32x4){0.f, 0.f, 0.f, 0.f};
        cur = nxt; cA = nA; cB = nB; ++ui;
        if constexpr (ALIGN_EPI) { if (wr == 1) PG8_BAR; }
    }
    PG8_WAIT_V(0);
    if constexpr (!ALIGN_EPI) { if (wr == 0) PG8_BAR; }
    PG8_BAR;
    if constexpr (Epi::AFTER_DRAIN) { E.fused(acc, cur, wr, wc, fr, fq, lds, wid, lane); S.done(cur); }
#undef PG8_SA
#undef PG8_SB
#undef PG8_STAGE
#undef PG8_LDA
#undef PG8_LDB
#undef PG8_MMA
#undef PG8_WAIT_V
#undef PG8_WAIT_L
#undef PG8_BAR
#undef PG8_SCHED
}
}
#define GAS __attribute__((address_space(1)))
#define LAS __attribute__((address_space(3)))
typedef unsigned short bf16;
typedef unsigned v4u __attribute__((ext_vector_type(4)));
typedef float f32x4 __attribute__((ext_vector_type(4)));
typedef short bf16x8 __attribute__((ext_vector_type(8)));
typedef GAS unsigned gu32;
typedef GAS unsigned long long gu64;
#define RLX_AGENT __ATOMIC_RELAXED, __HIP_MEMORY_SCOPE_AGENT
#define LDS_WAIT() asm volatile("s_waitcnt lgkmcnt(0)" ::: "memory")
#define VM_WAIT() asm volatile("s_waitcnt vmcnt(0)" ::: "memory")
__device__ __forceinline__ unsigned long long rt() { return __builtin_amdgcn_s_memrealtime(); }
__device__ __forceinline__ unsigned f2bf(float f) { unsigned u = __builtin_bit_cast(unsigned, f); return (u + 0x7fffu + ((u >> 16) & 1u)) >> 16; }
__device__ __forceinline__ unsigned pk2(float lo, float hi) { return f2bf(lo) | (f2bf(hi) << 16); }

#define XB_TMO      128
#define XB_XCNT(j)  (256  + 64 * (j))
#define XB_XSUB(j)  (1280 + 64 * (j))
#define XB_XGEN(j)  (2304 + 64 * (j))
#define XB_TOP      3328
#define XB_TOPGEN   3392
#define XCD_BAR_WORDS 3456
#define XB_SPIN_CAP (1u << 18)

__device__ __forceinline__ unsigned xb_ld(unsigned* p)              { return __hip_atomic_load(p, __ATOMIC_RELAXED, __HIP_MEMORY_SCOPE_AGENT); }
__device__ __forceinline__ unsigned xb_add(unsigned* p, unsigned v) { return __hip_atomic_fetch_add(p, v, __ATOMIC_RELAXED, __HIP_MEMORY_SCOPE_AGENT); }
__device__ __forceinline__ unsigned xb_xcc_id() { return (unsigned)__builtin_amdgcn_s_getreg((3 << 11) | 20) & 0xFu; }
#define XB_SPIN(cond, bar) do { unsigned _sp = 0; while (cond) { __builtin_amdgcn_s_sleep(1); \
    if ((++_sp & 255u) == 0u) { if (xb_ld(&(bar)[XB_TMO])) break; if (_sp > XB_SPIN_CAP) { atomicAdd(&(bar)[XB_TMO], 1u); break; } } } } while (0)

struct XcdBarrier {
    unsigned* bar; unsigned x;
    volatile LAS unsigned* st;
};

__device__ __forceinline__ XcdBarrier xcd_barrier_post(unsigned* bar, volatile LAS unsigned* st) {
    XcdBarrier b; b.bar = bar; b.x = xb_xcc_id(); b.st = st;
    if (threadIdx.x == 0) (void)xb_add(&bar[XB_XCNT(b.x)], 1u);
    return b;
}
__device__ __forceinline__ void xcd_barrier_complete(unsigned* bar, unsigned x, unsigned& nloc, unsigned& nx) {
    const unsigned G = gridDim.x * gridDim.y * gridDim.z;
    unsigned sum, cnt, mine, sp = 0u;
    for (;;) {
        sum = 0u; cnt = 0u; mine = 0u;
#pragma unroll
        for (unsigned j = 0; j < 16; ++j) { const unsigned c = xb_ld(&bar[XB_XCNT(j)]); sum += c; cnt += (c > 0u) ? 1u : 0u; mine = (j == x) ? c : mine; }
        if (sum == G) break;
        __builtin_amdgcn_s_sleep(1);
        if ((++sp & 255u) == 0u) { if (xb_ld(&bar[XB_TMO])) break; if (sp > XB_SPIN_CAP) { atomicAdd(&bar[XB_TMO], 1u); break; } }
    }
    nloc = mine > 0u ? mine : 1u; nx = cnt > 0u ? cnt : 1u;
}

__device__ __forceinline__ void xcd_barrier(const XcdBarrier& b) {
    asm volatile("s_waitcnt vmcnt(0)" ::: "memory");
    __syncthreads();
    if (threadIdx.x == 0) {
        unsigned* bar = b.bar;
        __builtin_amdgcn_s_waitcnt(0);
        unsigned nloc = b.st[0], nx = b.st[1];
        if (nloc == 0u) { xcd_barrier_complete(bar, b.x, nloc, nx); b.st[0] = nloc; b.st[1] = nx; }
        const unsigned old = xb_add(&bar[XB_XSUB(b.x)], 1u);
        const unsigned gen = old / nloc;
        if (old + 1u == (gen + 1u) * nloc) {
            __builtin_amdgcn_fence(__ATOMIC_RELEASE, "agent");
            asm volatile("s_waitcnt vmcnt(0)" ::: "memory");
            const unsigned og = xb_add(&bar[XB_TOP], 1u);
            const unsigned tg = og / nx;
            if (og + 1u == (tg + 1u) * nx) xb_add(&bar[XB_TOPGEN], 1u);
            else XB_SPIN(xb_ld(&bar[XB_TOPGEN]) == tg, bar);
            __builtin_amdgcn_fence(__ATOMIC_ACQUIRE, "agent");
            xb_add(&bar[XB_XGEN(b.x)], 1u);
            asm volatile("s_waitcnt vmcnt(0)" ::: "memory");
        } else {
            XB_SPIN(xb_ld(&bar[XB_XGEN(b.x)]) == gen, bar);
            __builtin_amdgcn_fence(__ATOMIC_ACQUIRE, "agent");
            asm volatile("s_waitcnt vmcnt(0)" ::: "memory");
        }
    }
    __syncthreads();
}
constexpr int NWAVES = 8;
constexpr int BATCH = 16, SEQ = 2048, DM = 1024, M = BATCH * SEQ;
constexpr int L0P = 3584;
constexpr int L1P = 2048;
constexpr int DFF = 2816;
constexpr float ALPHA = 1.4142135623730951f;
typedef unsigned short bf16_t;
typedef float f32x16 __attribute__((ext_vector_type(16)));

constexpr size_t MiB = 1u << 20;
constexpr size_t WS_CTL = 0, CTL_ZERO_BYTES = 1 * MiB;
constexpr int CW_BAR = 4096;
constexpr size_t WS_W0IN = 2 * MiB, WS_W0OUT = 9 * MiB, WS_WUP0 = 11 * MiB, WS_WDN0 = 22 * MiB, WS_W1IN = 28 * MiB, WS_WUQ = 32 * MiB, WS_WUKV = 33 * MiB,
                 WS_W1OUT = 34 * MiB, WS_WUP1 = 36 * MiB, WS_WDN1 = 47 * MiB;
constexpr size_t WS_XB = 56 * MiB, WS_YMIX = 120 * MiB, WS_BIG = 184 * MiB;
constexpr size_t WS_G = 408 * MiB, WS_BONUS = 440 * MiB, WS_DT = 441 * MiB, WS_XST = 442 * MiB, WS_BT = 474 * MiB, WS_ASUM = 490 * MiB;
constexpr size_t WS_SLOC = 120 * MiB;
constexpr size_t WS_W2T = 53 * MiB, WS_A2T = 53 * MiB + 256 * 1024, WS_G2T = 53 * MiB + 512 * 1024;
constexpr size_t WS_GU = 120 * MiB;
constexpr size_t WS_PROJ1 = 184 * MiB, WS_QM = 312 * MiB, WS_KVM = 360 * MiB, WS_KPE = 424 * MiB, WS_RS = 426 * MiB;
constexpr size_t WS_CSTAB = 492 * MiB;
constexpr size_t WS_VTS = 428 * MiB, WS_VTM = 460 * MiB;
constexpr size_t WS_NEED = 496 * MiB;

constexpr int RING_BYTES = 131072;
constexpr int LDSCTL_OFF = 146432, MISC_OFF = LDSCTL_OFF + 320;
constexpr int LDS_BYTES = 147456;

__device__ __forceinline__ float bf2f(bf16_t b) { return __builtin_bit_cast(float, (unsigned)b << 16); }
__device__ __forceinline__ float sigmoidf_(float x) { return 1.f / (1.f + expf(-x)); }
__device__ __forceinline__ float softplusf_(float x) { return fmaxf(x, 0.f) + log1pf(expf(-fabsf(x))); }
__device__ __forceinline__ float siluf_(float x) { return x / (1.f + expf(-x)); }
__device__ __forceinline__ float wave_sum(float v) {
#pragma unroll
    for (int o = 1; o < 64; o <<= 1) v += __shfl_xor(v, o);
    return v;
}
#define WSYNC() asm volatile("s_waitcnt lgkmcnt(0)" ::: "memory")
typedef float f32x2_t __attribute__((ext_vector_type(2)));
typedef __bf16 bf16x2_t __attribute__((ext_vector_type(2)));
typedef unsigned u32x2 __attribute__((ext_vector_type(2)));
__device__ __forceinline__ unsigned cvtpk(float lo, float hi) { f32x2_t v = {lo, hi}; bf16x2_t b = __builtin_convertvector(v, bf16x2_t); return __builtin_bit_cast(unsigned, b); }
__device__ __forceinline__ float bflo(unsigned u) { return __builtin_bit_cast(float, u << 16); }
__device__ __forceinline__ float bfhi(unsigned u) { return __builtin_bit_cast(float, u & 0xffff0000u); }

__device__ __forceinline__ void transpose_matrix(const float* __restrict__ W, int K, int N, bf16_t* __restrict__ WT, int Npad, int ldt, LAS float* scr, int gw, int NGW, int lane, const float* __restrict__ kscale) {
    (void)scr;
    const int nblk = Npad / 64, nit = (K / 64) * nblk;
    for (int it = gw; it < nit; it += NGW) {
        const int kb = it / nblk, nb = it - kb * nblk, n = nb * 64 + lane, k0 = kb * 64;
        const bool ok = n < N; const float* src = W + (size_t)k0 * N + (ok ? n : 0);
#pragma unroll
        for (int hc = 0; hc < 2; ++hc) {
            float v[32];
#pragma unroll
            for (int i = 0; i < 32; ++i) v[i] = src[(size_t)(hc * 32 + i) * N];
#pragma unroll
            for (int c = 0; c < 4; ++c) { float u[8];
#pragma unroll
                for (int i = 0; i < 8; ++i) { u[i] = ok ? v[c * 8 + i] : 0.f; if (kscale) u[i] *= kscale[k0 + hc * 32 + c * 8 + i]; }
                v4u o; o.x = cvtpk(u[0], u[1]); o.y = cvtpk(u[2], u[3]); o.z = cvtpk(u[4], u[5]); o.w = cvtpk(u[6], u[7]);
                *(v4u*)(WT + (size_t)n * ldt + k0 + hc * 32 + c * 8) = o; }
        }
    }
}

template <bool ST = true> __device__ __forceinline__ void ln_rows(float* h, bf16_t* hb, const float* __restrict__ g, const float* __restrict__ b, int gw, int NGW, int lane) {
    for (int row = gw; row < M; row += NGW) {
        float* p = h + (size_t)row * DM;
        f32x4 v[4]; float s = 0.f;
#pragma unroll
        for (int j = 0; j < 4; ++j) { v[j] = *(const f32x4*)(p + 4 * lane + 256 * j); s += (v[j][0] + v[j][1]) + (v[j][2] + v[j][3]); }
        const float mean = wave_sum(s) * (1.f / DM); float q = 0.f;
#pragma unroll
        for (int j = 0; j < 4; ++j) { v[j] = v[j] - mean; q += (v[j][0] * v[j][0] + v[j][1] * v[j][1]) + (v[j][2] * v[j][2] + v[j][3] * v[j][3]); }
        const float rstd = 1.0f / sqrtf(wave_sum(q) * (1.f / DM) + 1e-5f);
#pragma unroll
        for (int j = 0; j < 4; ++j) {
            const int c = 4 * lane + 256 * j;
            const f32x4 gg = *(const f32x4*)(g + c), bb = *(const f32x4*)(b + c);
            const f32x4 o = v[j] * rstd * gg + bb;
            uint2 w; w.x = pk2(o[0], o[1]); w.y = pk2(o[2], o[3]);
            if (ST) { *(f32x4*)(p + c) = o; *(uint2*)(hb + (size_t)row * DM + c) = w; } else asm volatile("" :: "v"(w.x), "v"(w.y), "v"(o[0]), "v"(o[1]), "v"(o[2]), "v"(o[3]));
        }
    }
}

__device__ __forceinline__ void rwkv_naive_chain(int chain, int lane, LAS float* sm, const bf16_t* __restrict__ proj, const float* __restrict__ mix, const float* __restrict__ w0, const float* __restrict__ w2,
                                                 const float* __restrict__ a0, const float* __restrict__ a2, const float* __restrict__ g2, const float* __restrict__ k_k,
                                                 const float* __restrict__ k_a, const float* __restrict__ r_k, const float* __restrict__ ln_g, const float* __restrict__ ln_b, bf16_t* __restrict__ ymix) {
    LAS float* s_w2 = sm; LAS float* s_a2 = sm + 4096; LAS float* s_g2 = sm + 8192; LAS float* s_tw = sm + 16384; LAS float* s_al = s_tw + 64; LAS float* s_sg = s_tw + 128;
    LAS float* s_w = s_tw + 256; LAS float* s_k = s_tw + 320; LAS float* s_a = s_tw + 384; LAS float* s_b = s_tw + 448; LAS float* s_r = s_tw + 512;
    const int b = chain >> 3, h = chain & 7, c = h * 64 + lane;
    for (int l = 0; l < 64; ++l) { s_w2[l * 64 + lane] = w2[l * 512 + c]; s_a2[l * 64 + lane] = a2[l * 512 + c]; }
    for (int l = 0; l < 128; ++l) s_g2[l * 64 + lane] = g2[l * 512 + c];
    const float mr = mix[c], mk = mix[512 + c], mv = mix[1024 + c], mw = mix[1536 + lane], ma = mix[1600 + lane], mg0 = mix[1664 + lane], mg1 = mix[1728 + lane];
    const float w0c = w0[c], a0c = a0[c], kkc = k_k[c], kac = k_a[c], rkc = r_k[c], lgc = ln_g[c], lbc = ln_b[c];
    float S[64];
#pragma unroll
    for (int j = 0; j < 64; ++j) S[j] = 0.f;
    float pr = 0.f, pk = 0.f, pv = 0.f, pw = 0.f, pa = 0.f, pg0 = 0.f, pg1 = 0.f;
    WSYNC();
    for (int t = 0; t < SEQ; ++t) {
        const bf16_t* row = proj + (size_t)(b * SEQ + t) * L0P;
        const float cr = bf2f(row[c]), ck = bf2f(row[512 + c]), cv = bf2f(row[1024 + c]), cw = bf2f(row[1536 + lane]), ca = bf2f(row[1600 + lane]),
                    cg0 = bf2f(row[1664 + lane]), cg1 = bf2f(row[1728 + lane]);
        const float r_s = cr + (pr - cr) * mr, k_s = ck + (pk - ck) * mk, v_s = cv + (pv - cv) * mv;
        const float wl = cw + (pw - cw) * mw, al = ca + (pa - ca) * ma, g0 = cg0 + (pg0 - cg0) * mg0, g1 = cg1 + (pg1 - cg1) * mg1;
        pr = cr; pk = ck; pv = cv; pw = cw; pa = ca; pg0 = cg0; pg1 = cg1;
        s_tw[lane] = tanhf(wl); s_al[lane] = al; s_sg[lane] = sigmoidf_(g0); s_sg[64 + lane] = sigmoidf_(g1);
        WSYNC();
        float wsum = w0c, asum = a0c, gsum = 0.f;
#pragma unroll 2
        for (int l = 0; l < 64; ++l) { wsum += s_tw[l] * s_w2[l * 64 + lane]; asum += s_al[l] * s_a2[l * 64 + lane]; }
#pragma unroll 2
        for (int l = 0; l < 128; ++l) gsum += s_sg[l] * s_g2[l * 64 + lane];
        const float log_w = -softplusf_(-wsum) - 0.5f;
        const float dec = expf(-expf(log_w));
        const float a = sigmoidf_(asum);
        float kkv = k_s * kkc;
        const float nrm = sqrtf(wave_sum(kkv * kkv));
        kkv = kkv / fmaxf(nrm, 1e-12f);
        const float k2 = k_s * (1.f + (a - 1.f) * kac);
        const float bonus_s = wave_sum(r_s * k2 * rkc);
        s_w[lane] = dec; s_k[lane] = k2; s_a[lane] = -kkv; s_b[lane] = kkv * a; s_r[lane] = r_s;
        WSYNC();
        float sa = 0.f;
#pragma unroll
        for (int j = 0; j < 64; ++j) sa += S[j] * s_a[j];
        float y = 0.f;
#pragma unroll
        for (int j = 0; j < 64; ++j) { S[j] = S[j] * s_w[j] + sa * s_b[j] + v_s * s_k[j]; y += S[j] * s_r[j]; }
        const float mu = wave_sum(y) * (1.f / 64.f);
        const float d = y - mu;
        const float var = wave_sum(d * d) * (1.f / 64.f);
        const float yn = d * (1.0f / sqrtf(var + 64e-5f)) * lgc + lbc;
        const float o = (yn + bonus_s * v_s) * gsum;
        ymix[(size_t)(b * SEQ + t) * DM + c] = (bf16_t)f2bf(o);
        WSYNC();
    }
}

__device__ __forceinline__ void ssm_conv_all(const bf16_t* __restrict__ proj, const float* __restrict__ cw, const float* __restrict__ cb, const float* __restrict__ dtb,
                                             bf16_t* __restrict__ xbc, float* __restrict__ dt, int gtid, int NT) {
    for (size_t i = gtid; i < (size_t)M * 1024; i += NT) {
        const int m = (int)(i >> 10), c = (int)(i & 1023), t = m & (SEQ - 1);
        float acc = cb[c];
#pragma unroll
        for (int k = 0; k < 4; ++k) { const int tt = t - 3 + k; if (tt >= 0) acc += cw[k * 1024 + c] * bf2f(proj[(size_t)(m - 3 + k) * L0P + 2304 + c]); }
        xbc[i] = (bf16_t)f2bf(siluf_(acc));
    }
    for (int i = gtid; i < M * 8; i += NT) dt[i] = softplusf_(bf2f(proj[(size_t)(i >> 3) * L0P + 3328 + (i & 7)]) + dtb[i & 7]);
}
__device__ __forceinline__ void ssd_naive_task(int task, int lane, const bf16_t* __restrict__ xbc, const float* __restrict__ dt, const float* __restrict__ a_log, const float* __restrict__ dsk, float* __restrict__ yssm) {
    const int chain = task >> 2, q = task & 3, b = chain >> 3, h = chain & 7, g = h >> 2, p = q * 16 + (lane >> 2), nq = lane & 3;
    const float A = -expf(a_log[h]), D = dsk[h];
    float st[32];
#pragma unroll
    for (int n = 0; n < 32; ++n) st[n] = 0.f;
    for (int t = 0; t < SEQ; ++t) {
        const size_t m = (size_t)b * SEQ + t;
        const float dtv = dt[m * 8 + h], dA = expf(dtv * A);
        const float x = bf2f(xbc[m * 1024 + h * 64 + p]), xdt = x * dtv;
        const bf16_t* Bp = xbc + m * 1024 + 512 + g * 128 + nq * 32;
        const bf16_t* Cp = xbc + m * 1024 + 768 + g * 128 + nq * 32;
        float yp = 0.f;
#pragma unroll
        for (int n = 0; n < 32; ++n) { st[n] = st[n] * dA + xdt * bf2f(Bp[n]); yp += st[n] * bf2f(Cp[n]); }
        yp += __shfl_xor(yp, 1); yp += __shfl_xor(yp, 2);
        if (nq == 0) yssm[m * 512 + h * 64 + p] = yp + D * x;
    }
}
template <bool ST = true> __device__ __forceinline__ void ssm_gate_norm_all(const bf16_t* __restrict__ yssm, const bf16_t* __restrict__ proj, const float* __restrict__ ng, bf16_t* __restrict__ ymix, int wv0, int wvend, int lane) {
    for (int wv = wv0; wv < wvend; wv += NWAVES) {
        const int m = wv >> 1, g = wv & 1;
        float u[4], q = 0.f;
#pragma unroll
        for (int j = 0; j < 4; ++j) { const int c = g * 256 + j * 64 + lane; const float z = bf2f(proj[(size_t)m * L0P + 1792 + c]); u[j] = bf2f(yssm[(size_t)m * 512 + c]) * siluf_(z); q += u[j] * u[j]; }
        const float rs = 1.0f / sqrtf(wave_sum(q) * (1.f / 256.f) + 1e-5f);
#pragma unroll
        for (int j = 0; j < 4; ++j) { const int c = g * 256 + j * 64 + lane; const float o_ = u[j] * rs * ng[c]; if (ST) ymix[(size_t)m * DM + 512 + c] = (bf16_t)f2bf(o_); else asm volatile("" :: "v"(o_)); }
    }
}
template <bool ST = true> __device__ __forceinline__ void ffn_act_all(bf16_t* gu, const float* __restrict__ cw, const float* __restrict__ cb, int gtid, int NT) {
    constexpr int NCH = DFF / 8, NSTRIP = M / 32;
    for (int task = gtid; task < NSTRIP * NCH; task += NT) {
        const int strip = task / NCH, q = task - strip * NCH, c0 = q * 8, m0 = strip * 32;
        float w0[8], w1[8], w2[8], bb[8], g2[8], g1[8];
#pragma unroll
        for (int j = 0; j < 8; j += 4) { const f32x4 a = *(const f32x4*)(cw + c0 + j), b = *(const f32x4*)(cw + DFF + c0 + j), c = *(const f32x4*)(cw + 2 * DFF + c0 + j), d = *(const f32x4*)(cb + c0 + j);
#pragma unroll
            for (int k = 0; k < 4; ++k) { w0[j + k] = a[k]; w1[j + k] = b[k]; w2[j + k] = c[k]; bb[j + k] = d[k]; } }
        bf16_t* base = gu + (size_t)m0 * (2 * DFF) + c0;
        if ((m0 & (SEQ - 1)) != 0) { const v4u a = *(const v4u*)(base - 2 * (2 * DFF)), b = *(const v4u*)(base - (2 * DFF));
            g2[0] = bflo(a.x); g2[1] = bfhi(a.x); g2[2] = bflo(a.y); g2[3] = bfhi(a.y); g2[4] = bflo(a.z); g2[5] = bfhi(a.z); g2[6] = bflo(a.w); g2[7] = bfhi(a.w);
            g1[0] = bflo(b.x); g1[1] = bfhi(b.x); g1[2] = bflo(b.y); g1[3] = bfhi(b.y); g1[4] = bflo(b.z); g1[5] = bfhi(b.z); g1[6] = bflo(b.w); g1[7] = bfhi(b.w); }
        else {
#pragma unroll
            for (int j = 0; j < 8; ++j) { g2[j] = 0.f; g1[j] = 0.f; } }
#pragma unroll 4
        for (int r = 0; r < 32; ++r) {
            const v4u gv = *(const v4u*)(base + (size_t)r * (2 * DFF)), uv = *(const v4u*)(base + (size_t)r * (2 * DFF) + DFF);
            const unsigned gw_[4] = {gv.x, gv.y, gv.z, gv.w}, uw_[4] = {uv.x, uv.y, uv.z, uv.w};
            unsigned ow[4];
#pragma unroll
            for (int k = 0; k < 4; ++k) {
                const float ga = bflo(gw_[k]), gb = bfhi(gw_[k]);
                const float ya = bb[2 * k] + w0[2 * k] * g2[2 * k] + w1[2 * k] * g1[2 * k] + w2[2 * k] * ga;
                const float yb = bb[2 * k + 1] + w0[2 * k + 1] * g2[2 * k + 1] + w1[2 * k + 1] * g1[2 * k + 1] + w2[2 * k + 1] * gb;
                g2[2 * k] = g1[2 * k]; g1[2 * k] = ga; g2[2 * k + 1] = g1[2 * k + 1]; g1[2 * k + 1] = gb;
                ow[k] = cvtpk(ya / (1.f + __expf(-ya)) * bflo(uw_[k]), yb / (1.f + __expf(-yb)) * bfhi(uw_[k]));
            }
            if (ST) *(v4u*)(base + (size_t)r * (2 * DFF) + DFF) = (v4u){ow[0], ow[1], ow[2], ow[3]}; else asm volatile("" :: "v"(ow[0]), "v"(ow[1]), "v"(ow[2]), "v"(ow[3]));
        }
    }
}
template <bool ST = true> __device__ __forceinline__ void mla_prep_all(const bf16_t* __restrict__ proj1, const int* __restrict__ pos, float* __restrict__ rs, bf16_t* __restrict__ kpe, float* __restrict__ cstab, int gw, int NGW, int lane) {
    for (int m = gw; m < M; m += NGW) {
        const bf16_t* row = proj1 + (size_t)m * L1P;
        float q = 0.f;
#pragma unroll
        for (int j = 0; j < 4; ++j) { const float v = bf2f(row[1536 + j * 64 + lane]); q += v * v; }
        q = wave_sum(q);
        float k = 0.f;
#pragma unroll
        for (int j = 0; j < 2; ++j) { const float v = bf2f(row[1792 + j * 64 + lane]); k += v * v; }
        k = wave_sum(k);
        if (ST && lane == 0) { rs[(size_t)m * 2] = 1.0f / sqrtf(q * (1.f / 256.f) + 1e-6f); rs[(size_t)m * 2 + 1] = 1.0f / sqrtf(k * (1.f / 128.f) + 1e-6f); }
        if (lane < 16) {
            const double inv = pow(10000.0, -(double)(2 * lane) / 32.0);
            const double ang = (double)pos[m] * inv;
            const float cs = (float)cos(ang), sn = (float)sin(ang);
            if (ST) { cstab[(size_t)m * 32 + lane] = cs; cstab[(size_t)m * 32 + 16 + lane] = sn; }
            const float x1 = bf2f(row[1920 + lane]), x2 = bf2f(row[1936 + lane]);
            const bf16_t r1_ = (bf16_t)f2bf(x1 * cs - x2 * sn), r2_ = (bf16_t)f2bf(x2 * cs + x1 * sn);
            if (ST) { kpe[(size_t)m * 32 + lane] = r1_; kpe[(size_t)m * 32 + 16 + lane] = r2_; } else asm volatile("" :: "v"((unsigned)r1_), "v"((unsigned)r2_), "v"(q), "v"(k));
        }
    }
}
template <bool ST = true> __device__ __forceinline__ void rope_q_all(bf16_t* qm, const float* __restrict__ cstab, int gtid, int NT) {
    for (int i = gtid; i < M * 16; i += NT) {
        const int m = i >> 4, h = (i >> 1) & 7, k0 = (i & 1) * 8;
        bf16_t* p = qm + (size_t)m * 768 + h * 96 + 64 + k0;
        const v4u a = *(const v4u*)p, b = *(const v4u*)(p + 16);
        const f32x4 c0 = *(const f32x4*)(cstab + (size_t)m * 32 + k0), c1 = *(const f32x4*)(cstab + (size_t)m * 32 + k0 + 4), s0 = *(const f32x4*)(cstab + (size_t)m * 32 + 16 + k0), s1 = *(const f32x4*)(cstab + (size_t)m * 32 + 16 + k0 + 4);
        const unsigned au[4] = {a.x, a.y, a.z, a.w}, bu[4] = {b.x, b.y, b.z, b.w};
        const float cs[8] = {c0[0], c0[1], c0[2], c0[3], c1[0], c1[1], c1[2], c1[3]}, sn[8] = {s0[0], s0[1], s0[2], s0[3], s1[0], s1[1], s1[2], s1[3]};
        unsigned o1[4], o2[4];
#pragma unroll
        for (int q = 0; q < 4; ++q) { const float x1a = bflo(au[q]), x1b = bfhi(au[q]), x2a = bflo(bu[q]), x2b = bfhi(bu[q]);
            o1[q] = cvtpk(x1a * cs[2 * q] - x2a * sn[2 * q], x1b * cs[2 * q + 1] - x2b * sn[2 * q + 1]);
            o2[q] = cvtpk(x2a * cs[2 * q] + x1a * sn[2 * q], x2b * cs[2 * q + 1] + x1b * sn[2 * q + 1]); }
        if (ST) { *(v4u*)p = (v4u){o1[0], o1[1], o1[2], o1[3]}; *(v4u*)(p + 16) = (v4u){o2[0], o2[1], o2[2], o2[3]}; }
    }
}
__device__ __forceinline__ void sb_naive_task(int qblk, int bh, int lane, const bf16_t* __restrict__ proj1, bf16_t* __restrict__ ymix) {
    const int b = bh >> 3, h = bh & 7, t = qblk * 64 + lane;
    const size_t mrow = (size_t)b * SEQ;
    float q[64], o[64];
#pragma unroll
    for (int d = 0; d < 64; ++d) { q[d] = bf2f(proj1[(mrow + t) * L1P + h * 64 + d]) * 0.125f; o[d] = 0.f; }
    float cum = 0.f;
    const int smax = qblk * 64 + 63;
    for (int s = smax - 1; s >= 0; --s) {
        const bf16_t* kr = proj1 + (mrow + s) * L1P + 512 + h * 64;
        const bf16_t* vr = proj1 + (mrow + s) * L1P + 1024 + h * 64;
        float z = 0.f;
#pragma unroll
        for (int d = 0; d < 64; ++d) z += q[d] * bf2f(kr[d]);
        if (s < t) {
            const float lsp = -softplusf_(-z);
            const float lsn = -softplusf_(z);
            const float att = expf(lsp + cum);
            cum += lsn;
#pragma unroll
            for (int d = 0; d < 64; ++d) o[d] += att * bf2f(vr[d]);
        }
    }
#pragma unroll
    for (int d = 0; d < 64; ++d) ymix[(mrow + t) * DM + h * 64 + d] = (bf16_t)f2bf(o[d]);
}
__device__ __forceinline__ void mla_naive_task(int qblk, int bh, int lane, const bf16_t* __restrict__ qm, const bf16_t* __restrict__ kvm, const bf16_t* __restrict__ kpe, bf16_t* __restrict__ ymix) {
    const int b = bh >> 3, h = bh & 7, t = qblk * 64 + lane;
    const size_t mrow = (size_t)b * SEQ;
    const float scale = 0.10206207261596577f;
    float q[96], o[64];
#pragma unroll
    for (int d = 0; d < 96; ++d) q[d] = bf2f(qm[(mrow + t) * 768 + h * 96 + d]) * scale;
#pragma unroll
    for (int d = 0; d < 64; ++d) o[d] = 0.f;
    float mx = -1e30f, l = 0.f;
    const int smax = qblk * 64 + 63;
    for (int s = 0; s <= smax; ++s) {
        const bf16_t* kr = kvm + (mrow + s) * 1024 + h * 128;
        const bf16_t* pr = kpe + (mrow + s) * 32;
        float z = 0.f;
#pragma unroll
        for (int d = 0; d < 64; ++d) z += q[d] * bf2f(kr[d]);
#pragma unroll
        for (int d = 0; d < 32; ++d) z += q[64 + d] * bf2f(pr[d]);
        if (s <= t) {
            const float mn = fmaxf(mx, z), f = expf(mx - mn), pz = expf(z - mn);
            l = l * f + pz; mx = mn;
#pragma unroll
            for (int d = 0; d < 64; ++d) o[d] = o[d] * f + pz * bf2f(kr[64 + d]);
        }
    }
    const float il = 1.f / l;
#pragma unroll
    for (int d = 0; d < 64; ++d) ymix[(mrow + t) * DM + 512 + h * 64 + d] = (bf16_t)f2bf(o[d] * il);
}


__device__ __forceinline__ int crow(int r, int hi) { return (r & 3) + 8 * (r >> 2) + 4 * hi; }
#define MFMA32(a, b, c) __builtin_amdgcn_mfma_f32_32x32x16_bf16((a), (b), (c), 0, 0, 0)
constexpr int STG_PITCH = 72;
__device__ __forceinline__ void transpose_tile64(const bf16_t* __restrict__ src, int sp, bf16_t* __restrict__ dst, int dp, LAS bf16_t* scr, int lane) {
#pragma unroll
    for (int i = 0; i < 8; ++i) { const int row = i * 8 + (lane >> 3), ch = lane & 7; const v4u v = *(const v4u*)(src + (size_t)row * sp + ch * 8); *(LAS v4u*)(scr + row * STG_PITCH + ch * 8) = v; }
    WSYNC();
#pragma unroll
    for (int i = 0; i < 8; ++i) { const int d = i * 8 + (lane >> 3), tc = lane & 7; const LAS bf16_t* p = scr + (tc * 8) * STG_PITCH + d;
        v4u o; o.x = (unsigned)p[0] | ((unsigned)p[STG_PITCH] << 16); o.y = (unsigned)p[2 * STG_PITCH] | ((unsigned)p[3 * STG_PITCH] << 16);
        o.z = (unsigned)p[4 * STG_PITCH] | ((unsigned)p[5 * STG_PITCH] << 16); o.w = (unsigned)p[6 * STG_PITCH] | ((unsigned)p[7 * STG_PITCH] << 16);
        *(v4u*)(dst + (size_t)d * dp + tc * 8) = o; }
    WSYNC();
}
__device__ __forceinline__ void store_OT(const f32x16 (&o)[2], float sc, LAS bf16_t* stg, bf16_t* __restrict__ dst, int lane) {
    const int l31 = lane & 31, hi = lane >> 5;
#pragma unroll
    for (int dt = 0; dt < 2; ++dt)
#pragma unroll
        for (int r = 0; r < 16; ++r) stg[l31 * STG_PITCH + 32 * dt + crow(r, hi)] = (bf16_t)f2bf(o[dt][r] * sc);
    WSYNC();
#pragma unroll
    for (int i = 0; i < 4; ++i) { const int row = i * 8 + (lane >> 3), ch = lane & 7; const v4u v = *(const LAS v4u*)(stg + row * STG_PITCH + ch * 8); *(v4u*)(dst + (size_t)row * DM + ch * 8) = v; }
    WSYNC();
}
__device__ __forceinline__ float softplus_fast(float z) { return fmaxf(z, 0.f) + __logf(1.f + __expf(-fabsf(z))); }

__device__ __forceinline__ void sb_task(int bh, int qblk, int lane, const bf16_t* __restrict__ P1, const bf16_t* __restrict__ VT, bf16_t* __restrict__ ymix, LAS bf16_t* stg) {
    const int b = bh >> 3, h = bh & 7, l31 = lane & 31, hi = lane >> 5, q0 = qblk * 32, t = q0 + l31;
    const size_t rowb = (size_t)b * SEQ;
    const bf16_t* Qp = P1 + (rowb + q0 + l31) * L1P + h * 64 + 8 * hi;
    bf16x8 qf[4];
#pragma unroll
    for (int kk = 0; kk < 4; ++kk) qf[kk] = *(const bf16x8*)(Qp + 16 * kk);
    const bf16_t* Kp = P1 + (rowb + l31) * L1P + 512 + h * 64 + 8 * hi;
    const bf16_t* Vp = VT + ((size_t)bh * 64 + l31) * SEQ + 4 * hi;
    f32x16 o[2];
#pragma unroll
    for (int r = 0; r < 16; ++r) { o[0][r] = 0.f; o[1][r] = 0.f; }
    float cum = 0.f;
    bf16x8 kf[4]; u32x2 va[2][2][2];
#define SB_LOAD(S0, KF, VA) do { _Pragma("unroll") for (int kk = 0; kk < 4; ++kk) KF[kk] = *(const bf16x8*)(Kp + (size_t)(S0) * L1P + 16 * kk); \
        _Pragma("unroll") for (int dt = 0; dt < 2; ++dt) _Pragma("unroll") for (int ks = 0; ks < 2; ++ks) { VA[dt][ks][0] = *(const u32x2*)(Vp + (size_t)dt * 32 * SEQ + (S0) + 16 * ks); VA[dt][ks][1] = *(const u32x2*)(Vp + (size_t)dt * 32 * SEQ + (S0) + 16 * ks + 8); } } while (0)
    SB_LOAD(q0, kf, va);
    for (int s0 = q0; s0 >= 0; s0 -= 32) {
        bf16x8 kn[4]; u32x2 vn[2][2][2];
        const int sn = (s0 >= 32) ? s0 - 32 : 0;
        SB_LOAD(sn, kn, vn);
        f32x16 acc;
#pragma unroll
        for (int r = 0; r < 16; ++r) acc[r] = 0.f;
#pragma unroll
        for (int kk = 0; kk < 4; ++kk) acc = MFMA32(kf[kk], qf[kk], acc);
        const bool diag = (s0 == q0);
        float lb[16], lk[16];
#pragma unroll
        for (int r = 0; r < 16; ++r) { const float z = acc[r] * 0.125f; const float sp = softplus_fast(z); float b_ = z - sp, k_ = -sp;
            if (diag) { const bool valid = (s0 + crow(r, hi)) < t; b_ = valid ? b_ : -1e30f; k_ = valid ? k_ : 0.f; }
            lb[r] = b_; lk[r] = k_; }
        float e[16], T[4], U[4];
#pragma unroll
        for (int i = 0; i < 4; ++i) { e[4 * i + 3] = 0.f; e[4 * i + 2] = lk[4 * i + 3]; e[4 * i + 1] = e[4 * i + 2] + lk[4 * i + 2]; e[4 * i] = e[4 * i + 1] + lk[4 * i + 1]; T[i] = e[4 * i] + lk[4 * i]; }
#pragma unroll
        for (int i = 0; i < 4; ++i) U[i] = __shfl_xor(T[i], 32);
        float off[4];
        { const float st2 = T[3], st1 = st2 + T[2], st0 = st1 + T[1]; const float su2 = U[3], su1 = su2 + U[2], su0 = su1 + U[1];
          const float x0 = hi ? 0.f : U[0], x1 = hi ? 0.f : U[1], x2 = hi ? 0.f : U[2], x3 = hi ? 0.f : U[3];
          off[3] = x3; off[2] = st2 + su2 + x2; off[1] = st1 + su1 + x1; off[0] = st0 + su0 + x0;
          const float total = st0 + T[0] + su0 + U[0];
#pragma unroll
          for (int r = 0; r < 16; ++r) acc[r] = __expf(lb[r] + (cum + off[r >> 2] + e[r]));
          cum += total; }
        bf16x8 pf[2];
#pragma unroll
        for (int ks = 0; ks < 2; ++ks) { v4u w; w.x = cvtpk(acc[8 * ks], acc[8 * ks + 1]); w.y = cvtpk(acc[8 * ks + 2], acc[8 * ks + 3]); w.z = cvtpk(acc[8 * ks + 4], acc[8 * ks + 5]); w.w = cvtpk(acc[8 * ks + 6], acc[8 * ks + 7]); pf[ks] = __builtin_bit_cast(bf16x8, w); }
#pragma unroll
        for (int dt = 0; dt < 2; ++dt)
#pragma unroll
            for (int ks = 0; ks < 2; ++ks) { v4u a; a.x = va[dt][ks][0].x; a.y = va[dt][ks][0].y; a.z = va[dt][ks][1].x; a.w = va[dt][ks][1].y; o[dt] = MFMA32(__builtin_bit_cast(bf16x8, a), pf[ks], o[dt]); }
        if (__all(cum < -110.f)) break;
#pragma unroll
        for (int kk = 0; kk < 4; ++kk) kf[kk] = kn[kk];
#pragma unroll
        for (int dt = 0; dt < 2; ++dt)
#pragma unroll
            for (int ks = 0; ks < 2; ++ks) { va[dt][ks][0] = vn[dt][ks][0]; va[dt][ks][1] = vn[dt][ks][1]; }
    }
#undef SB_LOAD
    store_OT(o, 1.0f, stg, ymix + (rowb + q0) * DM + h * 64, lane);
}
__device__ __forceinline__ void mla_task(int bh, int qblk, int lane, const bf16_t* __restrict__ QM, const bf16_t* __restrict__ KVM, const bf16_t* __restrict__ KPE, const bf16_t* __restrict__ VT,
                                         bf16_t* __restrict__ ymix, LAS bf16_t* stg) {
    const int b = bh >> 3, h = bh & 7, l31 = lane & 31, hi = lane >> 5, q0 = qblk * 32, t = q0 + l31;
    const size_t rowb = (size_t)b * SEQ;
    const bf16_t* Qp = QM + (rowb + q0 + l31) * 768 + h * 96 + 8 * hi;
    bf16x8 qf[6];
#pragma unroll
    for (int kk = 0; kk < 6; ++kk) qf[kk] = *(const bf16x8*)(Qp + 16 * kk);
    const bf16_t* Kn = KVM + (rowb + l31) * 1024 + h * 128 + 8 * hi;
    const bf16_t* Kr = KPE + (rowb + l31) * 32 + 8 * hi;
    const bf16_t* Vp = VT + ((size_t)bh * 64 + l31) * SEQ + 4 * hi;
    const float sc2 = 0.10206207261596577f * 1.4426950408889634f;
    f32x16 o[2];
#pragma unroll
    for (int r = 0; r < 16; ++r) { o[0][r] = 0.f; o[1][r] = 0.f; }
    float mrun = -1e30f, lsum = 0.f;
    bf16x8 kf[6]; u32x2 va[2][2][2];
#define ML_LOAD(S0, KF, VA) do { _Pragma("unroll") for (int kk = 0; kk < 4; ++kk) KF[kk] = *(const bf16x8*)(Kn + (size_t)(S0) * 1024 + 16 * kk); \
        _Pragma("unroll") for (int kk = 0; kk < 2; ++kk) KF[4 + kk] = *(const bf16x8*)(Kr + (size_t)(S0) * 32 + 16 * kk); \
        _Pragma("unroll") for (int dt = 0; dt < 2; ++dt) _Pragma("unroll") for (int ks = 0; ks < 2; ++ks) { VA[dt][ks][0] = *(const u32x2*)(Vp + (size_t)dt * 32 * SEQ + (S0) + 16 * ks); VA[dt][ks][1] = *(const u32x2*)(Vp + (size_t)dt * 32 * SEQ + (S0) + 16 * ks + 8); } } while (0)
    ML_LOAD(0, kf, va);
    for (int s0 = 0; s0 <= q0; s0 += 32) {
        bf16x8 kn[6]; u32x2 vn[2][2][2];
        const int sn = (s0 + 32 <= q0) ? s0 + 32 : s0;
        ML_LOAD(sn, kn, vn);
        f32x16 acc;
#pragma unroll
        for (int r = 0; r < 16; ++r) acc[r] = 0.f;
#pragma unroll
        for (int kk = 0; kk < 6; ++kk) acc = MFMA32(kf[kk], qf[kk], acc);
        const bool diag = (s0 == q0);
        float tmax = -1e30f;
#pragma unroll
        for (int r = 0; r < 16; ++r) { float z = acc[r] * sc2; if (diag && (s0 + crow(r, hi)) > t) z = -1e30f; acc[r] = z; tmax = fmaxf(tmax, z); }
        tmax = fmaxf(tmax, __shfl_xor(tmax, 32));
        const float mn = fmaxf(mrun, tmax), alpha = exp2f(mrun - mn); mrun = mn;
        float ps = 0.f;
#pragma unroll
        for (int r = 0; r < 16; ++r) { acc[r] = exp2f(acc[r] - mn); ps += acc[r]; }
        lsum = lsum * alpha + ps;
#pragma unroll
        for (int r = 0; r < 16; ++r) { o[0][r] *= alpha; o[1][r] *= alpha; }
        bf16x8 pf[2];
#pragma unroll
        for (int ks = 0; ks < 2; ++ks) { v4u w; w.x = cvtpk(acc[8 * ks], acc[8 * ks + 1]); w.y = cvtpk(acc[8 * ks + 2], acc[8 * ks + 3]); w.z = cvtpk(acc[8 * ks + 4], acc[8 * ks + 5]); w.w = cvtpk(acc[8 * ks + 6], acc[8 * ks + 7]); pf[ks] = __builtin_bit_cast(bf16x8, w); }
#pragma unroll
        for (int dt = 0; dt < 2; ++dt)
#pragma unroll
            for (int ks = 0; ks < 2; ++ks) { v4u a; a.x = va[dt][ks][0].x; a.y = va[dt][ks][0].y; a.z = va[dt][ks][1].x; a.w = va[dt][ks][1].y; o[dt] = MFMA32(__builtin_bit_cast(bf16x8, a), pf[ks], o[dt]); }
#pragma unroll
        for (int kk = 0; kk < 6; ++kk) kf[kk] = kn[kk];
#pragma unroll
        for (int dt = 0; dt < 2; ++dt)
#pragma unroll
            for (int ks = 0; ks < 2; ++ks) { va[dt][ks][0] = vn[dt][ks][0]; va[dt][ks][1] = vn[dt][ks][1]; }
    }
#undef ML_LOAD
    lsum += __shfl_xor(lsum, 32);
    store_OT(o, 1.0f / lsum, stg, ymix + (rowb + q0) * DM + 512 + h * 64, lane);
}


constexpr int RW_RAWW = 0, RW_RAWA = 2048, RW_RS = 4096, RW_KS = 6144, RW_VS = 8192;
constexpr int RW_CH0 = 10240, RW_CHSZ = 11328;
constexpr int RW_YB = RW_CH0 + 2 * RW_CHSZ;
constexpr int RW_MIX = RW_YB + 1024;
static_assert((RW_MIX + 256) * 4 <= 146432, "rwkv LDS map");
template <int CTRL> __device__ __forceinline__ float dpp_mov(float x) { return __builtin_bit_cast(float, __builtin_amdgcn_update_dpp(0, __builtin_bit_cast(int, x), CTRL, 0xF, 0xF, true)); }
__device__ __forceinline__ float rowsum16(float x) { x += dpp_mov<0x128>(x); x += dpp_mov<0x124>(x); x += dpp_mov<0x122>(x); x += dpp_mov<0x121>(x); return x; }
__device__ __forceinline__ float rl(float x, int l) { return __builtin_bit_cast(float, __builtin_amdgcn_readlane(__builtin_bit_cast(int, x), l)); }
__device__ __forceinline__ float wave_sum_dpp(float x) { x = rowsum16(x); return (rl(x, 0) + rl(x, 16)) + (rl(x, 32) + rl(x, 48)); }
__device__ __forceinline__ float tanh_fast(float x) { return 1.f - 2.f / (1.f + __expf(2.f * x)); }
__device__ __forceinline__ float sigmoid_fast(float x) { return 1.f / (1.f + __expf(-x)); }

#define MFMA16(a, b, c) __builtin_amdgcn_mfma_f32_16x16x32_bf16((a), (b), (c), 0, 0, 0)
constexpr int RW2_CH0 = 0, RW2_YB = 2 * RW_CHSZ, RW2_MIX = RW2_YB + 1024, RW2_STG = RW2_MIX + 448;
static_assert((RW2_STG + 2 * 3072) * 4 <= 146432, "rwkv LDS map");
__device__ __forceinline__ void rwkv_phase(LAS float* sm, int tid, int lane, int wave, int blk, const bf16_t* __restrict__ proj, const float* __restrict__ mix, const float* __restrict__ w0, const float* __restrict__ a0,
                                           const float* __restrict__ k_k, const float* __restrict__ k_a, const float* __restrict__ r_k, const bf16_t* __restrict__ W2T, const bf16_t* __restrict__ A2T, const bf16_t* __restrict__ G2T,
                                           float* __restrict__ yraw, bf16_t* __restrict__ gout, float* __restrict__ bonus_out) {
    const int chain = blk >> 1, half = blk & 1, b = chain >> 3, h = chain & 7, l15 = lane & 15, kg = lane >> 4;
    const size_t rowb = (size_t)b * SEQ;
    constexpr int NCHUNK = SEQ / 32;
    if (tid < 256) sm[RW2_MIX + tid] = mix[1536 + tid];
    else if (tid < 448) { const int q = tid - 256; sm[RW2_MIX + tid] = mix[512 * (q >> 6) + h * 64 + (q & 63)]; }
    __syncthreads();
#define RW_SH8(CUR, PRV, M0, M1, OUT, PZ) do { const unsigned cu_[4] = {(CUR).x, (CUR).y, (CUR).z, (CUR).w}, pu_[4] = {(PRV).x, (PRV).y, (PRV).z, (PRV).w}; \
        const float mm_[8] = {(M0)[0], (M0)[1], (M0)[2], (M0)[3], (M1)[0], (M1)[1], (M1)[2], (M1)[3]}; \
        _Pragma("unroll") for (int q = 0; q < 4; ++q) { const float c0 = bflo(cu_[q]), c1 = bfhi(cu_[q]), p0 = bflo(pu_[q]) * (PZ), p1 = bfhi(pu_[q]) * (PZ); \
            OUT[2 * q] = c0 + (p0 - c0) * mm_[2 * q]; OUT[2 * q + 1] = c1 + (p1 - c1) * mm_[2 * q + 1]; } } while (0)
    if (wave < 4) {
        const int iA = 8 * wave + kg, iB = iA + 4, jseg = l15;
        float A0 = 0.f, A1 = 0.f, A2 = 0.f, A3 = 0.f, B0 = 0.f, B1 = 0.f, B2 = 0.f, B3 = 0.f;
        __syncthreads();
#pragma unroll 1
        for (int ch = 0; ch < NCHUNK; ++ch) {
            const int t0 = ch * 32;
            const LAS float* CHb = sm + RW2_CH0 + (ch & 1) * RW_CHSZ + 4 * jseg;
            const LAS float* CHv = sm + RW2_CH0 + (ch & 1) * RW_CHSZ + 10240 + iA;
            const LAS float* CHs = sm + RW2_CH0 + (ch & 1) * RW_CHSZ + 11264;
            f32x4 a4 = *(const LAS f32x4*)(CHb + 4096), wr4 = *(const LAS f32x4*)(CHb + 8192), w4 = *(const LAS f32x4*)(CHb), b4 = *(const LAS f32x4*)(CHb + 6144), k4 = *(const LAS f32x4*)(CHb + 2048);
            float vA = CHv[0], vB = CHv[4]; f32x2_t sc = *(const LAS f32x2_t*)(CHs);
#pragma unroll 2
            for (int t = 0; t < 32; ++t) {
                const int tq = (t + 1) & 31;
                const f32x4 a4n = *(const LAS f32x4*)(CHb + 4096 + tq * 64), wr4n = *(const LAS f32x4*)(CHb + 8192 + tq * 64), w4n = *(const LAS f32x4*)(CHb + tq * 64),
                            b4n = *(const LAS f32x4*)(CHb + 6144 + tq * 64), k4n = *(const LAS f32x4*)(CHb + 2048 + tq * 64);
                const float vAn = CHv[tq * 32], vBn = CHv[tq * 32 + 4]; const f32x2_t scn = *(const LAS f32x2_t*)(CHs + 2 * tq);
                float d1A = (A0 * a4[0] + A1 * a4[1]) + (A2 * a4[2] + A3 * a4[3]), d1B = (B0 * a4[0] + B1 * a4[1]) + (B2 * a4[2] + B3 * a4[3]);
                float d2A = (A0 * wr4[0] + A1 * wr4[1]) + (A2 * wr4[2] + A3 * wr4[3]), d2B = (B0 * wr4[0] + B1 * wr4[1]) + (B2 * wr4[2] + B3 * wr4[3]);
                d1A = rowsum16(d1A); d1B = rowsum16(d1B); d2A = rowsum16(d2A); d2B = rowsum16(d2B);
                const float yA = d2A + d1A * sc[0] + vA * sc[1], yB = d2B + d1B * sc[0] + vB * sc[1];
                A0 = A0 * w4[0] + (d1A * b4[0] + vA * k4[0]); A1 = A1 * w4[1] + (d1A * b4[1] + vA * k4[1]); A2 = A2 * w4[2] + (d1A * b4[2] + vA * k4[2]); A3 = A3 * w4[3] + (d1A * b4[3] + vA * k4[3]);
                B0 = B0 * w4[0] + (d1B * b4[0] + vB * k4[0]); B1 = B1 * w4[1] + (d1B * b4[1] + vB * k4[1]); B2 = B2 * w4[2] + (d1B * b4[2] + vB * k4[2]); B3 = B3 * w4[3] + (d1B * b4[3] + vB * k4[3]);
                if (jseg == 0) { sm[RW2_YB + t * 32 + iA] = yA; sm[RW2_YB + t * 32 + iB] = yB; }
                a4 = a4n; wr4 = wr4n; w4 = w4n; b4 = b4n; k4 = k4n; vA = vAn; vB = vBn; sc = scn;
            }
            WSYNC();
            { const int tt = lane >> 1, hh = lane & 1; const f32x4 yv = *(const LAS f32x4*)(sm + RW2_YB + tt * 32 + 8 * wave + 4 * hh);
              *(f32x4*)(yraw + (rowb + t0 + tt) * 512 + h * 64 + half * 32 + 8 * wave + 4 * hh) = yv; }
            __syncthreads();
        }
    } else if (wave < 6) {
        const int tp = wave - 4, tb = 16 * tp;
        LAS float* stg = sm + RW2_STG + tp * 3072;
        float w0c[4], a0c[4], kkc[4], kac[4], rkc[4];
#pragma unroll
        for (int nt = 0; nt < 4; ++nt) { const int c = h * 64 + 16 * nt + l15; w0c[nt] = w0[c]; a0c[nt] = a0[c]; kkc[nt] = k_k[c]; kac[nt] = k_a[c]; rkc[nt] = r_k[c]; }
        v4u ld[20];
#define PREP_ISSUE(T0) do { const int t0_ = (T0); { const size_t r_ = rowb + t0_ + tb + l15; const size_t rp_ = (t0_ + tb + l15 == 0) ? r_ : r_ - 1; \
            _Pragma("unroll") for (int lo = 0; lo < 2; ++lo) _Pragma("unroll") for (int ks = 0; ks < 2; ++ks) { const int col = 1536 + 64 * lo + 32 * ks + 8 * kg; \
                ld[(lo * 2 + ks) * 2] = *(const v4u*)(proj + r_ * L0P + col); ld[(lo * 2 + ks) * 2 + 1] = *(const v4u*)(proj + rp_ * L0P + col); } } \
            _Pragma("unroll") for (int ar = 0; ar < 3; ++ar) _Pragma("unroll") for (int i = 0; i < 2; ++i) { const int p_ = lane + 64 * i, row_ = p_ >> 3, c8_ = p_ & 7; \
                const size_t r_ = rowb + t0_ + tb + row_; const size_t rp_ = (t0_ + tb + row_ == 0) ? r_ : r_ - 1; const int col = 512 * ar + h * 64 + 8 * c8_; \
                ld[8 + (ar * 2 + i) * 2] = *(const v4u*)(proj + r_ * L0P + col); ld[8 + (ar * 2 + i) * 2 + 1] = *(const v4u*)(proj + rp_ * L0P + col); } } while (0)
#define PREP_BUILD(T0, NB) do { const int t0_ = (T0); LAS float* CHn = sm + RW2_CH0 + (NB) * RW_CHSZ; \
            f32x4 accw[4], acca[4]; \
            _Pragma("unroll") for (int nt = 0; nt < 4; ++nt) { accw[nt] = (f32x4){0.f, 0.f, 0.f, 0.f}; acca[nt] = (f32x4){0.f, 0.f, 0.f, 0.f}; } \
            { const float pz_ = (t0_ + tb + l15 == 0) ? 0.f : 1.f; \
              _Pragma("unroll") for (int lo = 0; lo < 2; ++lo) _Pragma("unroll") for (int ks = 0; ks < 2; ++ks) { float s_[8]; \
                const f32x4 m0 = *(const LAS f32x4*)(sm + RW2_MIX + 64 * lo + 32 * ks + 8 * kg), m1 = *(const LAS f32x4*)(sm + RW2_MIX + 64 * lo + 32 * ks + 8 * kg + 4); \
                RW_SH8(ld[(lo * 2 + ks) * 2], ld[(lo * 2 + ks) * 2 + 1], m0, m1, s_, pz_); \
                if (lo == 0) { _Pragma("unroll") for (int j = 0; j < 8; ++j) s_[j] = tanh_fast(s_[j]); } \
                v4u aw; aw.x = cvtpk(s_[0], s_[1]); aw.y = cvtpk(s_[2], s_[3]); aw.z = cvtpk(s_[4], s_[5]); aw.w = cvtpk(s_[6], s_[7]); const bf16x8 af = __builtin_bit_cast(bf16x8, aw); \
                const bf16_t* WT = lo ? A2T : W2T; \
                _Pragma("unroll") for (int nt = 0; nt < 4; ++nt) { const bf16x8 bfr = *(const bf16x8*)(WT + (size_t)(h * 64 + 16 * nt + l15) * 64 + 32 * ks + 8 * kg); \
                    if (lo == 0) accw[nt] = MFMA16(af, bfr, accw[nt]); else acca[nt] = MFMA16(af, bfr, acca[nt]); } } } \
            _Pragma("unroll") for (int ar = 0; ar < 3; ++ar) _Pragma("unroll") for (int i = 0; i < 2; ++i) { const int p_ = lane + 64 * i, row_ = p_ >> 3, c8_ = p_ & 7; float s_[8]; \
                const float pz_ = (t0_ + tb + row_ == 0) ? 0.f : 1.f; const f32x4 m0 = *(const LAS f32x4*)(sm + RW2_MIX + 256 + ar * 64 + c8_ * 8), m1 = *(const LAS f32x4*)(sm + RW2_MIX + 256 + ar * 64 + c8_ * 8 + 4); \
                RW_SH8(ld[8 + (ar * 2 + i) * 2], ld[8 + (ar * 2 + i) * 2 + 1], m0, m1, s_, pz_); \
                *(LAS f32x4*)(stg + ar * 1024 + row_ * 64 + c8_ * 8) = (f32x4){s_[0], s_[1], s_[2], s_[3]}; *(LAS f32x4*)(stg + ar * 1024 + row_ * 64 + c8_ * 8 + 4) = (f32x4){s_[4], s_[5], s_[6], s_[7]}; } \
            WSYNC(); \
            PREP_ISSUE(((T0) + 32 < SEQ) ? (T0) + 32 : (T0)); \
            _Pragma("unroll") for (int rg = 0; rg < 4; ++rg) { const int tl = 4 * kg + rg, t = tb + tl; \
                float r_[4], k_[4], v_[4], kkv[4], nrm2 = 0.f; \
                _Pragma("unroll") for (int nt = 0; nt < 4; ++nt) { r_[nt] = stg[tl * 64 + 16 * nt + l15]; k_[nt] = stg[1024 + tl * 64 + 16 * nt + l15]; v_[nt] = stg[2048 + tl * 64 + 16 * nt + l15]; \
                    kkv[nt] = k_[nt] * kkc[nt]; nrm2 += kkv[nt] * kkv[nt]; } \
                nrm2 = rowsum16(nrm2); const float rn = __builtin_amdgcn_rsqf(fmaxf(nrm2, 1e-24f)); \
                float br = 0.f, kr = 0.f, bon = 0.f; \
                _Pragma("unroll") for (int nt = 0; nt < 4; ++nt) { const int j = 16 * nt + l15; \
                    const float wsum = w0c[nt] + accw[nt][rg]; const float logw = -softplus_fast(-wsum) - 0.5f; const float dec = __expf(-__expf(logw)); \
                    const float a_ = sigmoid_fast(a0c[nt] + acca[nt][rg]); const float kn = kkv[nt] * rn; \
                    const float k2 = k_[nt] * (1.f + (a_ - 1.f) * kac[nt]); const float bv = kn * a_; \
                    br += bv * r_[nt]; kr += k2 * r_[nt]; bon += r_[nt] * k2 * rkc[nt]; \
                    CHn[t * 64 + j] = dec; CHn[2048 + t * 64 + j] = k2; CHn[4096 + t * 64 + j] = -kn; CHn[6144 + t * 64 + j] = bv; CHn[8192 + t * 64 + j] = dec * r_[nt]; \
                    if ((nt >> 1) == half) CHn[10240 + t * 32 + (j & 31)] = v_[nt]; } \
                br = rowsum16(br); kr = rowsum16(kr); bon = rowsum16(bon); \
                if (l15 == 0) { CHn[11264 + 2 * t] = br; CHn[11264 + 2 * t + 1] = kr; if (half == 0) bonus_out[(rowb + t0_ + t) * 8 + h] = bon; } } \
            WSYNC(); } while (0)
        PREP_ISSUE(0);
        PREP_BUILD(0, 0);
        __syncthreads();
#pragma unroll 1
        for (int ch = 0; ch < NCHUNK; ++ch) {
            if (ch + 1 < NCHUNK) PREP_BUILD(ch * 32 + 32, (ch + 1) & 1);
            __syncthreads();
        }
#undef PREP_ISSUE
#undef PREP_BUILD
    } else {
        const int tp = wave - 6, tb = 16 * tp;
        v4u ld[8];
#define G_ISSUE(T0) do { const int t0_ = (T0); const size_t r_ = rowb + t0_ + tb + l15; const size_t rp_ = (t0_ + tb + l15 == 0) ? r_ : r_ - 1; \
            _Pragma("unroll") for (int ks = 0; ks < 4; ++ks) { const int col = 1664 + 32 * ks + 8 * kg; ld[2 * ks] = *(const v4u*)(proj + r_ * L0P + col); ld[2 * ks + 1] = *(const v4u*)(proj + rp_ * L0P + col); } } while (0)
#define G_BUILD(T0) do { const int t0_ = (T0); f32x4 accg[2] = {(f32x4){0.f, 0.f, 0.f, 0.f}, (f32x4){0.f, 0.f, 0.f, 0.f}}; const float pz_ = (t0_ + tb + l15 == 0) ? 0.f : 1.f; \
            _Pragma("unroll") for (int ks = 0; ks < 4; ++ks) { float s_[8]; \
                const f32x4 m0 = *(const LAS f32x4*)(sm + RW2_MIX + 128 + 32 * ks + 8 * kg), m1 = *(const LAS f32x4*)(sm + RW2_MIX + 128 + 32 * ks + 8 * kg + 4); \
                RW_SH8(ld[2 * ks], ld[2 * ks + 1], m0, m1, s_, pz_); \
                _Pragma("unroll") for (int j = 0; j < 8; ++j) s_[j] = sigmoid_fast(s_[j]); \
                v4u aw; aw.x = cvtpk(s_[0], s_[1]); aw.y = cvtpk(s_[2], s_[3]); aw.z = cvtpk(s_[4], s_[5]); aw.w = cvtpk(s_[6], s_[7]); const bf16x8 af = __builtin_bit_cast(bf16x8, aw); \
                _Pragma("unroll") for (int nt = 0; nt < 2; ++nt) { const bf16x8 bfr = *(const bf16x8*)(G2T + (size_t)(h * 64 + half * 32 + 16 * nt + l15) * 128 + 32 * ks + 8 * kg); accg[nt] = MFMA16(af, bfr, accg[nt]); } } \
            G_ISSUE(((T0) + 32 < SEQ) ? (T0) + 32 : (T0)); \
            _Pragma("unroll") for (int nt = 0; nt < 2; ++nt) _Pragma("unroll") for (int rg = 0; rg < 4; ++rg) \
                gout[(rowb + t0_ + tb + 4 * kg + rg) * 512 + h * 64 + half * 32 + 16 * nt + l15] = (bf16_t)f2bf(accg[nt][rg]); } while (0)
        G_ISSUE(0);
        G_BUILD(0);
        __syncthreads();
#pragma unroll 1
        for (int ch = 0; ch < NCHUNK; ++ch) {
            if (ch + 1 < NCHUNK) G_BUILD(ch * 32 + 32);
            __syncthreads();
        }
#undef G_ISSUE
#undef G_BUILD
    }
#undef RW_SH8
    __syncthreads();
}
template <bool ST = true> __device__ __forceinline__ void rwkv_post_all(const float* __restrict__ yraw, const bf16_t* __restrict__ proj, const float* __restrict__ mix, const float* __restrict__ bonus, const bf16_t* __restrict__ gbuf,
                                              const float* __restrict__ ln_g, const float* __restrict__ ln_b, bf16_t* __restrict__ ymix, int gw, int NGW, int lane) {
    for (int m = gw; m < M; m += NGW) {
        const bool has_prev = (m & (SEQ - 1)) != 0;
        float y[8], cv[8], pv[8], gg[8], bo[8];
#pragma unroll
        for (int h = 0; h < 8; ++h) { const int c = h * 64 + lane; y[h] = yraw[(size_t)m * 512 + c]; cv[h] = bf2f(proj[(size_t)m * L0P + 1024 + c]);
            pv[h] = bf2f(proj[(size_t)(has_prev ? m - 1 : m) * L0P + 1024 + c]); gg[h] = bf2f(gbuf[(size_t)m * 512 + c]); bo[h] = bonus[(size_t)m * 8 + h]; }
#pragma unroll
        for (int h = 0; h < 8; ++h) { const int c = h * 64 + lane;
            const float mu = wave_sum_dpp(y[h]) * (1.f / 64.f), d = y[h] - mu, var = wave_sum_dpp(d * d) * (1.f / 64.f);
            const float yn = d * __builtin_amdgcn_rsqf(var + 64e-5f) * ln_g[c] + ln_b[c];
            const float pvv = has_prev ? pv[h] : 0.f;
            const float v_s = cv[h] + (pvv - cv[h]) * mix[1024 + c];
            const float o = (yn + bo[h] * v_s) * gg[h];
            if (ST) ymix[(size_t)m * DM + c] = (bf16_t)f2bf(o); else asm volatile("" :: "v"(o)); }
    }
}


__device__ __forceinline__ void ssd_conv_tile(int it, int lane, LAS bf16_t* scr, const bf16_t* __restrict__ proj, const float* __restrict__ cw, const float* __restrict__ cb,
                                              bf16_t* __restrict__ xbc, bf16_t* __restrict__ xst, bf16_t* __restrict__ bt) {
    const int tt = it >> 4, ct = it & 15, m0 = tt * 64, b = m0 >> 11, t0 = m0 & (SEQ - 1), c = ct * 64 + lane;
    const float w0 = cw[c], w1 = cw[1024 + c], w2 = cw[2048 + c], w3 = cw[3072 + c], bias = cb[c];
    const bf16_t* src = proj + (size_t)m0 * L0P + 2304 + c;
    float u3 = 0.f, u2 = 0.f, u1 = 0.f;
    if (t0 > 0) { u3 = bf2f(src[-3 * L0P]); u2 = bf2f(src[-2 * L0P]); u1 = bf2f(src[-1 * L0P]); }
#pragma unroll 8
    for (int t = 0; t < 64; ++t) {
        const float u = bf2f(src[(size_t)t * L0P]);
        const float y = bias + w0 * u3 + w1 * u2 + w2 * u1 + w3 * u;
        const bf16_t o = (bf16_t)f2bf(y / (1.f + __expf(-y)));
        xbc[(size_t)(m0 + t) * 1024 + c] = o;
        scr[t * STG_PITCH + lane] = o;
        u3 = u2; u2 = u1; u1 = u;
    }
    WSYNC();
    if (ct < 12) {
        bf16_t* dst = (ct < 8) ? xst + ((size_t)(b * 8 + ct) * 64) * SEQ + t0 : bt + ((size_t)(b * 2 + ((ct - 8) >> 1)) * 128 + ((ct - 8) & 1) * 64) * SEQ + t0;
#pragma unroll
        for (int i = 0; i < 8; ++i) { const int d = i * 8 + (lane >> 3), tc = lane & 7; const LAS bf16_t* p = scr + (tc * 8) * STG_PITCH + d;
            v4u o; o.x = (unsigned)p[0] | ((unsigned)p[STG_PITCH] << 16); o.y = (unsigned)p[2 * STG_PITCH] | ((unsigned)p[3 * STG_PITCH] << 16);
            o.z = (unsigned)p[4 * STG_PITCH] | ((unsigned)p[5 * STG_PITCH] << 16); o.w = (unsigned)p[6 * STG_PITCH] | ((unsigned)p[7 * STG_PITCH] << 16);
            *(v4u*)(dst + (size_t)d * SEQ + tc * 8) = o; }
    }
    WSYNC();
}
__device__ __forceinline__ void scan128(float& x0, float& x1, int lane) {
#pragma unroll
    for (int o = 1; o < 64; o <<= 1) { const float t0 = __shfl_up(x0, o), t1 = __shfl_up(x1, o); if (lane >= o) { x0 += t0; x1 += t1; } }
    x1 += __shfl(x0, 63);
}
__device__ __forceinline__ void ssd_s1_unit(int unit, int lane, LAS float* tab, const bf16_t* __restrict__ xst, const bf16_t* __restrict__ bt, const float* __restrict__ dt, const float* __restrict__ a_log,
                                            float* __restrict__ sloc, float* __restrict__ asum) {
    const int h = unit & 7, c = (unit >> 3) & 15, b = unit >> 7, g = h >> 2, l0 = c * 128, l31 = lane & 31, hi = lane >> 5;
    const size_t m0 = (size_t)b * SEQ + l0;
    const float A = -expf(a_log[h]);
    const float d0 = dt[(m0 + lane) * 8 + h], d1 = dt[(m0 + 64 + lane) * 8 + h];
    float ac0 = d0 * A, ac1 = d1 * A;
    scan128(ac0, ac1, lane);
    const float aend = __shfl(ac1, 63);
    tab[lane] = __expf(aend - ac0) * d0; tab[64 + lane] = __expf(aend - ac1) * d1;
    if (lane == 0) asum[unit] = aend;
    WSYNC();
    f32x16 acc[2][4];
#pragma unroll
    for (int pt = 0; pt < 2; ++pt)
#pragma unroll
        for (int nt = 0; nt < 4; ++nt)
#pragma unroll
            for (int r = 0; r < 16; ++r) acc[pt][nt][r] = 0.f;
    const bf16_t* Xp = xst + ((size_t)(b * 8 + h) * 64 + l31) * SEQ + l0 + 8 * hi;
    const bf16_t* Bp = bt + ((size_t)(b * 2 + g) * 128 + l31) * SEQ + l0 + 8 * hi;
#pragma unroll 2
    for (int kk = 0; kk < 8; ++kk) {
        const f32x4 wa = *(const LAS f32x4*)(tab + 16 * kk + 8 * hi), wb = *(const LAS f32x4*)(tab + 16 * kk + 8 * hi + 4);
        bf16x8 af[2], bfr[4];
#pragma unroll
        for (int pt = 0; pt < 2; ++pt) { const v4u raw = *(const v4u*)(Xp + (size_t)pt * 32 * SEQ + 16 * kk);
            v4u w; w.x = cvtpk(bflo(raw.x) * wa[0], bfhi(raw.x) * wa[1]); w.y = cvtpk(bflo(raw.y) * wa[2], bfhi(raw.y) * wa[3]);
            w.z = cvtpk(bflo(raw.z) * wb[0], bfhi(raw.z) * wb[1]); w.w = cvtpk(bflo(raw.w) * wb[2], bfhi(raw.w) * wb[3]); af[pt] = __builtin_bit_cast(bf16x8, w); }
#pragma unroll
        for (int nt = 0; nt < 4; ++nt) bfr[nt] = *(const bf16x8*)(Bp + (size_t)nt * 32 * SEQ + 16 * kk);
#pragma unroll
        for (int pt = 0; pt < 2; ++pt)
#pragma unroll
            for (int nt = 0; nt < 4; ++nt) acc[pt][nt] = MFMA32(af[pt], bfr[nt], acc[pt][nt]);
    }
    float* dst = sloc + (size_t)unit * 8192 + l31;
#pragma unroll
    for (int pt = 0; pt < 2; ++pt)
#pragma unroll
        for (int nt = 0; nt < 4; ++nt)
#pragma unroll
            for (int r = 0; r < 16; ++r) dst[(32 * pt + crow(r, hi)) * 128 + 32 * nt] = acc[pt][nt][r];
    WSYNC();
}
__device__ __forceinline__ void ssd_s2_all(const float* __restrict__ sloc, const float* __restrict__ asum, bf16_t* __restrict__ stb, int gtid, int NT) {
    for (int i = gtid; i < 128 * 2048; i += NT) {
        const int bh = i >> 11, e4 = i & 2047, b = bh >> 3, h = bh & 7;
        f32x4 run = {0.f, 0.f, 0.f, 0.f};
#pragma unroll 4
        for (int c = 0; c < 16; ++c) { const int unit = (b * 16 + c) * 8 + h; const f32x4 tmp = *(const f32x4*)(sloc + (size_t)unit * 8192 + e4 * 4);
            uint2 w; w.x = cvtpk(run[0], run[1]); w.y = cvtpk(run[2], run[3]); *(uint2*)(stb + (size_t)unit * 8192 + e4 * 4) = w;
            run = run * __expf(asum[unit]) + tmp; }
    }
}
__device__ __forceinline__ void ssd_s3_unit(int unit, int lane, LAS float* tab, const bf16_t* __restrict__ xbc, const bf16_t* __restrict__ xst, const bf16_t* __restrict__ stb, const float* __restrict__ dt,
                                            const float* __restrict__ a_log, const float* __restrict__ dsk, bf16_t* __restrict__ yssm) {
    const int h = unit & 7, c = (unit >> 3) & 15, b = unit >> 7, g = h >> 2, l0 = c * 128, l31 = lane & 31, hi = lane >> 5;
    const size_t m0 = (size_t)b * SEQ + l0;
    const float A = -expf(a_log[h]), D = dsk[h];
    const float d0 = dt[(m0 + lane) * 8 + h], d1 = dt[(m0 + 64 + lane) * 8 + h];
    float ac0 = d0 * A, ac1 = d1 * A;
    scan128(ac0, ac1, lane);
    tab[lane] = ac0; tab[64 + lane] = ac1; tab[128 + lane] = d0; tab[192 + lane] = d1;
    WSYNC();
    const bf16_t* Cp = xbc + (m0 + l31) * 1024 + 768 + g * 128 + 8 * hi;
    const bf16_t* Sp = stb + (size_t)unit * 8192 + l31 * 128 + 8 * hi;
    const bf16_t* Bp = xbc + (m0 + l31) * 1024 + 512 + g * 128 + 8 * hi;
    const bf16_t* Xp = xst + ((size_t)(b * 8 + h) * 64 + l31) * SEQ + l0 + 4 * hi;
    LAS float* tr = tab + 256;
    const int row = lane >> 1, p0 = (lane & 1) * 16;
#pragma unroll 1
    for (int lt = 0; lt < 4; ++lt) {
        f32x16 y[2];
#pragma unroll
        for (int r = 0; r < 16; ++r) { y[0][r] = 0.f; y[1][r] = 0.f; }
        const float acl = tab[32 * lt + l31];
#pragma unroll 4
        for (int kk = 0; kk < 8; ++kk) {
            const bf16x8 cf = *(const bf16x8*)(Cp + (size_t)lt * 32 * 1024 + 16 * kk);
            const bf16x8 s0 = *(const bf16x8*)(Sp + 16 * kk), s1 = *(const bf16x8*)(Sp + 32 * 128 + 16 * kk);
            y[0] = MFMA32(s0, cf, y[0]); y[1] = MFMA32(s1, cf, y[1]);
        }
        { const float el = __expf(acl);
#pragma unroll
          for (int r = 0; r < 16; ++r) { y[0][r] *= el; y[1][r] *= el; } }
#pragma unroll 1
        for (int st = 0; st <= lt; ++st) {
            f32x16 cbt;
#pragma unroll
            for (int r = 0; r < 16; ++r) cbt[r] = 0.f;
#pragma unroll 4
            for (int kk = 0; kk < 8; ++kk) { const bf16x8 bf_ = *(const bf16x8*)(Bp + (size_t)st * 32 * 1024 + 16 * kk), cf_ = *(const bf16x8*)(Cp + (size_t)lt * 32 * 1024 + 16 * kk); cbt = MFMA32(bf_, cf_, cbt); }
#pragma unroll
            for (int r = 0; r < 16; ++r) { const int sl = 32 * st + crow(r, hi); const float acs = tab[sl], dts = tab[128 + sl];
                float v = cbt[r] * __expf(acl - acs) * dts; if (st == lt && crow(r, hi) > l31) v = 0.f; cbt[r] = v; }
            bf16x8 pf[2];
#pragma unroll
            for (int ks = 0; ks < 2; ++ks) { v4u w; w.x = cvtpk(cbt[8 * ks], cbt[8 * ks + 1]); w.y = cvtpk(cbt[8 * ks + 2], cbt[8 * ks + 3]); w.z = cvtpk(cbt[8 * ks + 4], cbt[8 * ks + 5]); w.w = cvtpk(cbt[8 * ks + 6], cbt[8 * ks + 7]); pf[ks] = __builtin_bit_cast(bf16x8, w); }
#pragma unroll
            for (int pt = 0; pt < 2; ++pt)
#pragma unroll
                for (int ks = 0; ks < 2; ++ks) { const bf16_t* xp = Xp + (size_t)pt * 32 * SEQ + st * 32 + 16 * ks; const u32x2 x0 = *(const u32x2*)xp, x1 = *(const u32x2*)(xp + 8);
                    v4u a; a.x = x0.x; a.y = x0.y; a.z = x1.x; a.w = x1.y; y[pt] = MFMA32(__builtin_bit_cast(bf16x8, a), pf[ks], y[pt]); }
        }
#pragma unroll
        for (int pt = 0; pt < 2; ++pt) {
#pragma unroll
            for (int r = 0; r < 16; ++r) tr[l31 * 33 + crow(r, hi)] = y[pt][r];
            WSYNC();
            const size_t m = m0 + 32 * lt + row;
            const v4u xa = *(const v4u*)(xbc + m * 1024 + h * 64 + 32 * pt + p0), xb = *(const v4u*)(xbc + m * 1024 + h * 64 + 32 * pt + p0 + 8);
            const unsigned xu[8] = {xa.x, xa.y, xa.z, xa.w, xb.x, xb.y, xb.z, xb.w};
            unsigned ow[8];
#pragma unroll
            for (int q = 0; q < 8; ++q) { const float v0 = tr[row * 33 + p0 + 2 * q] + D * bflo(xu[q]), v1 = tr[row * 33 + p0 + 2 * q + 1] + D * bfhi(xu[q]); ow[q] = cvtpk(v0, v1); }
            bf16_t* dst = yssm + m * 512 + h * 64 + 32 * pt + p0;
            *(v4u*)dst = (v4u){ow[0], ow[1], ow[2], ow[3]}; *(v4u*)(dst + 8) = (v4u){ow[4], ow[5], ow[6], ow[7]};
            WSYNC();
        }
    }
}

struct Args { const float* in[43]; float* out; unsigned char* ws; };
#define GEMM_PHASE(EPI, Aptr, LDA, Bptr, LDB, NN, KK, ...) do { pg8::Gemm g_{(Aptr), (Bptr), M, (NN), (KK), (LDA), (LDB)}; pg8::StaticOrder S_; S_.init(M, (NN), G, (int)blockIdx.x); \
        pg8::EPI E_{__VA_ARGS__}; pg8::gemm_phase<pg8::EPI, pg8::StaticOrder, true, true>(lds3, g_, S_, E_); } while (0)

__global__ void __launch_bounds__(NWAVES * 64, 2) fwd_mega(Args args) {
    extern __shared__ __attribute__((aligned(16))) unsigned char lds[];
    LAS unsigned char* lds3 = (LAS unsigned char*)lds;
    volatile LAS unsigned* MISC = (volatile LAS unsigned*)(lds3 + MISC_OFF);
    const int G = gridDim.x, NGW = G * NWAVES, NT = G * NWAVES * 64;
#define PHASE_IDS() int tid = threadIdx.x; asm volatile("" : "+v"(tid)); const int lane = tid & 63, wave = __builtin_amdgcn_readfirstlane(tid >> 6); const int gw = blockIdx.x * NWAVES + wave, gtid = blockIdx.x * (NWAVES * 64) + tid; (void)lane; (void)gw; (void)gtid
    unsigned char* ws = args.ws;
    gu32* ctl = (gu32*)(ws + WS_CTL);
    for (int u = threadIdx.x; u < (LDS_BYTES - LDSCTL_OFF) / 4; u += NWAVES * 64) ((LAS unsigned*)(lds3 + LDSCTL_OFF))[u] = 0u;
    __syncthreads();
    XcdBarrier bar = xcd_barrier_post((unsigned*)(ctl + CW_BAR), MISC + 8);
#if defined(PROBE_STAMPS)
    int nb_ = 0;
    if (blockIdx.x == 0 && threadIdx.x == 0) MISC[16] = (unsigned)__builtin_amdgcn_s_memrealtime();
#define GRID_BAR() do { xcd_barrier(bar); ++nb_; if (blockIdx.x == 0 && threadIdx.x == 0) MISC[16 + nb_] = (unsigned)__builtin_amdgcn_s_memrealtime(); } while (0)
#else
#define GRID_BAR() xcd_barrier(bar)
#endif
#define IN(i) (args.in[i])
    float* out = args.out;
    bf16_t* W0in = (bf16_t*)(ws + WS_W0IN); bf16_t* W0out = (bf16_t*)(ws + WS_W0OUT); bf16_t* Wup0 = (bf16_t*)(ws + WS_WUP0); bf16_t* Wdn0 = (bf16_t*)(ws + WS_WDN0);
    bf16_t* W1in = (bf16_t*)(ws + WS_W1IN); bf16_t* Wuq = (bf16_t*)(ws + WS_WUQ); bf16_t* Wukv = (bf16_t*)(ws + WS_WUKV); bf16_t* W1out = (bf16_t*)(ws + WS_W1OUT);
    bf16_t* Wup1 = (bf16_t*)(ws + WS_WUP1); bf16_t* Wdn1 = (bf16_t*)(ws + WS_WDN1);
    bf16_t* XB = (bf16_t*)(ws + WS_XB); bf16_t* YMIX = (bf16_t*)(ws + WS_YMIX); bf16_t* PROJ0 = (bf16_t*)(ws + WS_BIG);
    float* YRAW = out; bf16_t* YSSM = (bf16_t*)(out + (size_t)M * 512); bf16_t* STB = (bf16_t*)(out + (size_t)M * 768); bf16_t* XST = (bf16_t*)(ws + WS_XST); bf16_t* BT = (bf16_t*)(ws + WS_BT); float* ASUM = (float*)(ws + WS_ASUM); float* SLOC = (float*)(ws + WS_SLOC); float* DT = (float*)(ws + WS_DT); bf16_t* GB = (bf16_t*)(ws + WS_G); float* BONUS = (float*)(ws + WS_BONUS);
    bf16_t* W2T = (bf16_t*)(ws + WS_W2T); bf16_t* A2T = (bf16_t*)(ws + WS_A2T); bf16_t* G2T = (bf16_t*)(ws + WS_G2T); bf16_t* GU = (bf16_t*)(ws + WS_GU);
    bf16_t* PROJ1 = (bf16_t*)(ws + WS_PROJ1); bf16_t* QM = (bf16_t*)(ws + WS_QM); bf16_t* KVM = (bf16_t*)(ws + WS_KVM); bf16_t* KPE = (bf16_t*)(ws + WS_KPE); float* RS = (float*)(ws + WS_RS); float* CSTAB = (float*)(ws + WS_CSTAB); bf16_t* VTS = (bf16_t*)(ws + WS_VTS); bf16_t* VTM = (bf16_t*)(ws + WS_VTM);
    const int* pos = (const int*)args.in[1];

    {
        PHASE_IDS();
    {
        LAS float* scr = (LAS float*)(lds3 + wave * 16384);
        transpose_matrix(IN(2), 1024, 3336, W0in, L0P, 1024, scr, gw, NGW, lane, nullptr);
        transpose_matrix(IN(20), 1024, 1024, W0out, 1024, 1024, scr, gw, NGW, lane, nullptr);
        transpose_matrix(IN(23), 1024, 5632, Wup0, 5632, 1024, scr, gw, NGW, lane, nullptr);
        transpose_matrix(IN(26), 2816, 1024, Wdn0, 1024, 2816, scr, gw, NGW, lane, nullptr);
        transpose_matrix(IN(29), 1024, 1952, W1in, L1P, 1024, scr, gw, NGW, lane, nullptr);
        transpose_matrix(IN(31), 256, 768, Wuq, 768, 256, scr, gw, NGW, lane, IN(30));
        transpose_matrix(IN(33), 128, 1024, Wukv, 1024, 256, scr, gw, NGW, lane, IN(32));
        for (int i = gtid; i < 1024 * 16; i += NT) { const int n = i >> 4, c = i & 15; *(v4u*)(Wukv + (size_t)n * 256 + 128 + c * 8) = (v4u){0u, 0u, 0u, 0u}; }
        transpose_matrix(IN(34), 1024, 1024, W1out, 1024, 1024, scr, gw, NGW, lane, nullptr);
        transpose_matrix(IN(37), 1024, 5632, Wup1, 5632, 1024, scr, gw, NGW, lane, nullptr);
        transpose_matrix(IN(40), 2816, 1024, Wdn1, 1024, 2816, scr, gw, NGW, lane, nullptr);
        transpose_matrix(IN(5), 64, 512, W2T, 512, 64, scr, gw, NGW, lane, nullptr);
        transpose_matrix(IN(7), 64, 512, A2T, 512, 64, scr, gw, NGW, lane, nullptr);
        transpose_matrix(IN(8), 128, 512, G2T, 512, 128, scr, gw, NGW, lane, nullptr);
        const float* x = IN(0);
        {
            constexpr size_t TOT4 = (size_t)M * DM / 4;
            for (size_t i = gtid; i < TOT4; i += (size_t)NT * 8) {
                f32x4 v[8];
#pragma unroll
                for (int u = 0; u < 8; ++u) v[u] = *(const f32x4*)(x + (i + (size_t)u * NT) * 4);
#pragma unroll
                for (int u = 0; u < 8; ++u) { uint2 w; w.x = cvtpk(v[u][0], v[u][1]); w.y = cvtpk(v[u][2], v[u][3]); *(uint2*)(XB + (i + (size_t)u * NT) * 4) = w; }
            }
        }
    }
    }
    GRID_BAR();
    {
        PHASE_IDS();
    GEMM_PHASE(EpiBf16S, XB, DM, W0in, 1024, L0P, 1024, PROJ0, nullptr, L0P, 0);
    }
    GRID_BAR();
    {
        PHASE_IDS();
        const int blk = (int)blockIdx.x, m0 = blk * 128;
        {   LAS bf16_t* scr = (LAS bf16_t*)(lds3 + wave * 16384);
#pragma unroll 1
            for (int k = 0; k < 4; ++k) ssd_conv_tile((2 * blk + (k & 1)) * 16 + wave + 8 * (k >> 1), lane, scr, PROJ0, IN(14), IN(15), XB, XST, BT);
            for (int i = tid; i < 1024; i += NWAVES * 64) { const int m = m0 + (i >> 3); DT[(size_t)m * 8 + (i & 7)] = softplusf_(bf2f(PROJ0[(size_t)m * L0P + 3328 + (i & 7)]) + IN(16)[i & 7]); }
        }
        __syncthreads();
        ssd_s1_unit(blk * 8 + wave, lane, (LAS float*)(lds3 + wave * 16384), XST, BT, DT, IN(17), SLOC, ASUM);
    }
    GRID_BAR();
    {
        PHASE_IDS();
        ssd_s2_all(SLOC, ASUM, STB, gtid, NT);
        rwkv_phase((LAS float*)lds3, tid, lane, wave, (int)blockIdx.x, PROJ0, IN(3), IN(4), IN(6), IN(9), IN(10), IN(11), W2T, A2T, G2T, YRAW, GB, BONUS);
    }
    GRID_BAR();
    {
        PHASE_IDS();
        const int blk = (int)blockIdx.x;
        ssd_s3_unit(blk * 8 + wave, lane, (LAS float*)(lds3 + wave * 16384), XB, XST, STB, DT, IN(17), IN(18), YSSM);
        __syncthreads();
        ssm_gate_norm_all(YSSM, PROJ0, IN(19), YMIX, blk * 256 + wave, blk * 256 + 256, lane);
        rwkv_post_all(YRAW, PROJ0, IN(3), BONUS, GB, IN(12), IN(13), YMIX, gw, NGW, lane);
    }
    GRID_BAR();
    {
        PHASE_IDS();
    GEMM_PHASE(EpiResid, YMIX, DM, W0out, 1024, 1024, 1024, IN(0), out, ALPHA, 0);
    }
    GRID_BAR();
    {
        PHASE_IDS();
    ln_rows(out, XB, IN(21), IN(22), gw, NGW, lane);
    }
    GRID_BAR();
    {
        PHASE_IDS();
    GEMM_PHASE(EpiBf16S, XB, DM, Wup0, 1024, 2 * DFF, 1024, GU, nullptr, 2 * DFF, 0);
    }
    GRID_BAR();
    {
        PHASE_IDS();
    ffn_act_all(GU, IN(24), IN(25), gtid, NT);
    }
    GRID_BAR();
    {
        PHASE_IDS();
    GEMM_PHASE(EpiResid, GU + DFF, 2 * DFF, Wdn0, DFF, 1024, DFF, out, out, ALPHA, 0);
    }
    GRID_BAR();
    {
        PHASE_IDS();
    ln_rows(out, XB, IN(27), IN(28), gw, NGW, lane);
    }
    GRID_BAR();
    {
        PHASE_IDS();
    GEMM_PHASE(EpiBf16S, XB, DM, W1in, 1024, L1P, 1024, PROJ1, nullptr, L1P, 0);
    }
    GRID_BAR();
    {
        PHASE_IDS();
    mla_prep_all(PROJ1, pos, RS, KPE, CSTAB, gw, NGW, lane);
    }
    GRID_BAR();
    {
        PHASE_IDS();
    GEMM_PHASE(EpiBf16S, PROJ1 + 1536, L1P, Wuq, 256, 768, 256, QM, RS, 768, 2);
    GEMM_PHASE(EpiBf16S, PROJ1 + 1792, L1P, Wukv, 256, 1024, 256, KVM, RS + 1, 1024, 2);
    }
    GRID_BAR();
    {
        PHASE_IDS();
    rope_q_all(QM, CSTAB, gtid, NT);
    {
        LAS bf16_t* scr = (LAS bf16_t*)(lds3 + wave * 16384);
        for (int it = gw; it < 8192; it += NGW) { const int which = it >> 12, r = it & 4095, bh = r >> 5, tt = r & 31, b = bh >> 3, h = bh & 7;
            if (which == 0) transpose_tile64(PROJ1 + ((size_t)b * SEQ + tt * 64) * L1P + 1024 + h * 64, L1P, VTS + (size_t)bh * 64 * SEQ + tt * 64, SEQ, scr, lane);
            else            transpose_tile64(KVM + ((size_t)b * SEQ + tt * 64) * 1024 + h * 128 + 64, 1024, VTM + (size_t)bh * 64 * SEQ + tt * 64, SEQ, scr, lane); }
    }
    }
    GRID_BAR();
    {
        PHASE_IDS();
    {
        LAS bf16_t* stg = (LAS bf16_t*)(lds3 + wave * 16384);
        for (int g2 = gw; g2 < 2048; g2 += NGW) { const int bh = g2 >> 4, w = g2 & 15;
#pragma unroll 1
            for (int i = 0; i < 4; ++i) { const int qb = (i == 0) ? w : (i == 1) ? 31 - w : (i == 2) ? 32 + w : 63 - w;
                sb_task(bh, qb, lane, PROJ1, VTS, YMIX, stg);
                mla_task(bh, qb, lane, QM, KVM, KPE, VTM, YMIX, stg); } }
    }
    }
    GRID_BAR();
    {
        PHASE_IDS();
    GEMM_PHASE(EpiResid, YMIX, DM, W1out, 1024, 1024, 1024, out, out, ALPHA, 0);
    }
    GRID_BAR();
    {
        PHASE_IDS();
    ln_rows(out, XB, IN(35), IN(36), gw, NGW, lane);
    }
    GRID_BAR();
    {
        PHASE_IDS();
    GEMM_PHASE(EpiBf16S, XB, DM, Wup1, 1024, 2 * DFF, 1024, GU, nullptr, 2 * DFF, 0);
    }
    GRID_BAR();
    {
        PHASE_IDS();
    ffn_act_all(GU, IN(38), IN(39), gtid, NT);
    }
    GRID_BAR();
    {
        PHASE_IDS();
    GEMM_PHASE(EpiResid, GU + DFF, 2 * DFF, Wdn1, DFF, 1024, DFF, out, out, ALPHA, 0);
    }
    GRID_BAR();
    {
        PHASE_IDS();
    ln_rows(out, XB, IN(41), IN(42), gw, NGW, lane);
    #if defined(PROBE_STAMPS)
    __syncthreads();
    if (blockIdx.x == 0 && threadIdx.x == 0) {
        MISC[16 + 22] = (unsigned)__builtin_amdgcn_s_memrealtime();
        const unsigned d1 = MISC[16 + PROBE_T1_HI] - MISC[16 + PROBE_T1_LO];
        const unsigned long long spin = 100ull * d1;
        const unsigned long long t0 = __builtin_amdgcn_s_memrealtime();
        while (__builtin_amdgcn_s_memrealtime() - t0 < spin) __builtin_amdgcn_s_sleep(8);
    }
#endif
}
}

extern "C" void kernel_launch(void* const* d_in, const int* in_sizes, int n_in, void* d_out, int out_size, void* d_ws, size_t ws_size, hipStream_t stream) {
    static int grid = 0;
    if (grid == 0) {
        if (n_in != 43 || ws_size < WS_NEED || out_size != M * DM) { fprintf(stderr, "kernel_launch: unexpected n_in %d / ws %zu / out %d\n", n_in, ws_size, out_size); grid = -1; return; }
        int dev = 0, cus = 0, per_cu = 0;
        if (hipGetDevice(&dev) != hipSuccess || hipDeviceGetAttribute(&cus, hipDeviceAttributeMultiprocessorCount, dev) != hipSuccess) { grid = -1; return; }
        if (hipFuncSetAttribute((const void*)fwd_mega, hipFuncAttributeMaxDynamicSharedMemorySize, LDS_BYTES) != hipSuccess) { fprintf(stderr, "kernel_launch: hipFuncSetAttribute failed\n"); grid = -1; return; }
        if (hipOccupancyMaxActiveBlocksPerMultiprocessor(&per_cu, (const void*)fwd_mega, NWAVES * 64, LDS_BYTES) != hipSuccess || per_cu < 1) fprintf(stderr, "kernel_launch: occupancy query reports %d\n", per_cu);
        (void)hipGetLastError();
        grid = cus;
    }
    if (grid < 0) return;
    (void)hipMemsetAsync((char*)d_ws + WS_CTL, 0, CTL_ZERO_BYTES, stream);
    Args a{};
    for (int i = 0; i < 43; ++i) a.in[i] = (const float*)d_in[i];
    a.out = (float*)d_out; a.ws = (unsigned char*)d_ws;
    hipLaunchKernelGGL(fwd_mega, dim3(grid), dim3(NWAVES * 64), LDS_BYTES, stream, a);
}
```

```cpp
#include <hip/hip_runtime.h>
#include <cstdio>
#include <cstdint>
#include <cmath>
namespace pg8 {
#define PG8_LAS __attribute__((address_space(3)))
typedef unsigned short bf16_t;
typedef short bf16x8 __attribute__((ext_vector_type(8)));
typedef float f32x4 __attribute__((ext_vector_type(4)));
typedef unsigned u32x4 __attribute__((ext_vector_type(4)));
constexpr int BM = 256, BK = 64, HALF = 128, HTB = HALF * BK * 2  , STAGE_BYTES = 8 * HTB, NXCD = 8, WGM = 8;

__host__ __device__ __forceinline__ int lds_byte(int r, int c) { const int st = (r >> 4) * 2 + (c >> 5), rr = r & 15, cc = c & 31, ob = rr * 64 + cc * 2; return st * 1024 + (ob ^ (((ob >> 9) & 1) << 5)); }
__host__ __device__ __forceinline__ void stage_rc(int b, int& R, int& C) { const int st = b / 1024, sb = b % 1024, swz = sb ^ (((sb >> 9) & 1) << 5); R = (st >> 1) * 16 + swz / 64; C = (st & 1) * 32 + (swz % 64) / 2; }
__host__ __device__ __forceinline__ int perm32(int rho) { const int n = rho >> 4, i = rho & 15; return 8 * (i >> 2) + 4 * n + (i & 3); }

struct Unit { int pm, pn; };
struct Gemm { const bf16_t* A; const bf16_t* Bt; int M, N, K, lda, ldb; };

struct StaticOrder {
    int nM, nN, nwg, G, c;
    __host__ __device__ void init(int M, int N, int G_, int c_) { nM = M / BM; nN = N / BM; nwg = nM * nN; G = G_; c = c_; }
    __host__ __device__ bool next(int i, Unit& u) const {
        const long L = (long)i * G + c; if (L >= nwg) return false;
        int wgid = (int)L; { const int q = nwg / NXCD, r = nwg % NXCD, xcd = wgid % NXCD, off = wgid / NXCD; wgid = (xcd < r ? xcd * (q + 1) : r * (q + 1) + (xcd - r) * q) + off; }
        const int nig = WGM * nN, gid = wgid / nig, fm = gid * WGM, gsz = (nM - fm) < WGM ? (nM - fm) : WGM;
        u.pm = fm + ((wgid % nig) % gsz); u.pn = (wgid % nig) / gsz; return true;
    }
    __device__ __forceinline__ void a_ready(const Unit&) const {}
    __device__ __forceinline__ void done(const Unit&) const {}
};


__device__ __forceinline__ unsigned cvt_pk_bf16(float lo, float hi) { unsigned r; asm volatile("v_cvt_pk_bf16_f32 %0, %1, %2" : "=v"(r) : "v"(lo), "v"(hi)); return r; }
struct EpiBf16S {
    static constexpr bool PERM = true, AFTER_DRAIN = false;
    bf16_t* O; const float* rowscale; int ldc; int rs_stride;
    __device__ __forceinline__ void operator()(const f32x4 (&acc)[2][2][4][2], const Unit& u, int wr, int wc, int fr, int fq) const {
        const int row0 = u.pm * BM + wr * 64 + fr, col0 = u.pn * BM + wc * 32 + 8 * fq;
#pragma unroll
        for (int ai = 0; ai < 2; ++ai)
#pragma unroll
            for (int m = 0; m < 4; ++m) { const int row = row0 + ai * HALF + m * 16; const float sc = rowscale ? rowscale[(size_t)row * rs_stride] : 1.f;
                bf16_t* rowp = O + (size_t)row * ldc + col0;
#pragma unroll
                for (int bj = 0; bj < 2; ++bj) { const f32x4 v0 = acc[ai][bj][m][0] * sc, v1 = acc[ai][bj][m][1] * sc;
                    u32x4 w; w.x = cvt_pk_bf16(v0[0], v0[1]); w.y = cvt_pk_bf16(v0[2], v0[3]); w.z = cvt_pk_bf16(v1[0], v1[1]); w.w = cvt_pk_bf16(v1[2], v1[3]);
                    *(u32x4*)(rowp + bj * HALF) = w; } }
    }
};
struct EpiResid {
    static constexpr bool PERM = false, AFTER_DRAIN = false;
    const float* hin; float* hout; float alpha; int pad;
    __device__ __forceinline__ void operator()(const f32x4 (&acc)[2][2][4][2], const Unit& u, int wr, int wc, int fr, int fq) const {
        const int row0 = u.pm * BM + wr * 64 + fr, col0 = u.pn * BM + wc * 32 + 4 * fq;
#pragma unroll
        for (int ai = 0; ai < 2; ++ai)
#pragma unroll
            for (int m = 0; m < 4; ++m) { const size_t off = (size_t)(row0 + ai * HALF + m * 16) * 1024 + col0;
#pragma unroll
                for (int bj = 0; bj < 2; ++bj)
#pragma unroll
                    for (int n = 0; n < 2; ++n) { const size_t i = off + bj * HALF + n * 16; const f32x4 h = *(const f32x4*)(hin + i); *(f32x4*)(hout + i) = h * alpha + acc[ai][bj][m][n]; } }
    }
};
template <class Epi, class Sched, bool ALIGN_EPI = false, bool SP2 = false>
__device__ __forceinline__ void gemm_phase(PG8_LAS unsigned char* lds, const Gemm g, const Sched& S, const Epi& E) {
    const int tid = threadIdx.x, wid = __builtin_amdgcn_readfirstlane(tid >> 6), lane = tid & 63, wr = wid >> 2, wc = wid & 3, fr = lane & 15, fq = lane >> 4;
    const int K = g.K, nt = K / BK;
    unsigned voffA[2], voffB[2];
#pragma unroll
    for (int i = 0; i < 2; ++i) { int R, C; stage_rc(tid * 16 + i * 8192, R, C); const int Rb = Epi::PERM ? ((R & ~31) + perm32(R & 31)) : R;
        voffA[i] = (unsigned)(R * g.lda + C) * 2u; voffB[i] = (unsigned)(Rb * g.ldb + C) * 2u; }
    const size_t kstep = (size_t)(BK * 2);
    const size_t hstepA = (size_t)HALF * g.lda * 2, hstepB = (size_t)HALF * g.ldb * 2;
    const size_t tstepA = 2 * hstepA, tstepB = 2 * hstepB;
    const unsigned ldsw = (unsigned)wid * 1024u;
    const int aoff = lds_byte(wr * 64 + fr, fq * 8), boff = lds_byte(wc * 32 + fr, fq * 8);
#define PG8_SA(b, h) (((b) * 2 + (h)) * HTB)
#define PG8_SB(b, h) ((4 + (b) * 2 + (h)) * HTB)
#define PG8_STAGE(bufoff, gbase, voff) do { _Pragma("unroll") for (int _i = 0; _i < 2; ++_i) \
        __builtin_amdgcn_global_load_lds((const unsigned*)((const char*)(gbase) + (voff)[_i]), (PG8_LAS unsigned*)(lds + (bufoff) + ldsw + _i * 8192), 16, 0, 0); } while (0)
#define PG8_LDA(dst, b, h) do { _Pragma("unroll") for (int m = 0; m < 4; ++m) _Pragma("unroll") for (int k = 0; k < 2; ++k) dst[m][k] = *(const PG8_LAS bf16x8*)(lds + PG8_SA(b, h) + aoff + m * 2048 + k * 1024); } while (0)
#define PG8_LDB(dst, b, h) do { _Pragma("unroll") for (int n = 0; n < 2; ++n) _Pragma("unroll") for (int k = 0; k < 2; ++k) dst[n][k] = *(const PG8_LAS bf16x8*)(lds + PG8_SB(b, h) + boff + n * 2048 + k * 1024); } while (0)
#define PG8_MMA(ai, bj, At, Bt) do { __builtin_amdgcn_s_setprio(1); _Pragma("unroll") for (int m = 0; m < 4; ++m) _Pragma("unroll") for (int n = 0; n < 2; ++n) _Pragma("unroll") for (int k = 0; k < 2; ++k) \
        acc[ai][bj][m][n] = __builtin_amdgcn_mfma_f32_16x16x32_bf16(Bt[n][k], At[m][k], acc[ai][bj][m][n], 0, 0, 0); __builtin_amdgcn_s_setprio(0); } while (0)
#define PG8_WAIT_V(n) asm volatile("s_waitcnt vmcnt(" #n ")" ::: "memory")
#define PG8_WAIT_L(n) asm volatile("s_waitcnt lgkmcnt(" #n ")" ::: "memory")
#define PG8_BAR __builtin_amdgcn_s_barrier()
#define PG8_SCHED __builtin_amdgcn_sched_barrier(0)
    Unit cur, nxt; int ui = 0;
    if (!S.next(0, cur)) return;
    f32x4 acc[2][2][4][2];
#pragma unroll
    for (int a = 0; a < 2; ++a)
#pragma unroll
        for (int b = 0; b < 2; ++b)
#pragma unroll
            for (int m = 0; m < 4; ++m)
#pragma unroll
                for (int n = 0; n < 2; ++n) acc[a][b][m][n] = (f32x4){0.f, 0.f, 0.f, 0.f};
    bf16x8 At[4][2], B0[2][2], B1[2][2];
    const char* cA = (const char*)g.A + (size_t)cur.pm * tstepA; const char* cB = (const char*)g.Bt + (size_t)cur.pn * tstepB;
    S.a_ready(cur);
    if constexpr (SP2) {
        PG8_STAGE(PG8_SB(0, 0), cB, voffB); PG8_STAGE(PG8_SB(0, 1), cB + hstepB, voffB); PG8_STAGE(PG8_SA(0, 0), cA, voffA); PG8_STAGE(PG8_SA(0, 1), cA + hstepA, voffA);
        if (wr == 1) PG8_BAR;
        PG8_WAIT_V(2); PG8_BAR;
        PG8_STAGE(PG8_SB(1, 0), cB + kstep, voffB); PG8_STAGE(PG8_SA(1, 0), cA + kstep, voffA); PG8_STAGE(PG8_SB(1, 1), cB + hstepB + kstep, voffB);
        PG8_WAIT_V(6); PG8_BAR;
    } else {
        PG8_STAGE(PG8_SB(0, 0), cB, voffB); PG8_STAGE(PG8_SA(0, 0), cA, voffA); PG8_STAGE(PG8_SB(0, 1), cB + hstepB, voffB); PG8_STAGE(PG8_SA(0, 1), cA + hstepA, voffA);
        if (wr == 1) PG8_BAR;
        PG8_WAIT_V(4); PG8_BAR;
        PG8_STAGE(PG8_SB(1, 0), cB + kstep, voffB); PG8_STAGE(PG8_SA(1, 0), cA + kstep, voffA); PG8_STAGE(PG8_SB(1, 1), cB + hstepB + kstep, voffB);
        PG8_WAIT_V(6); PG8_BAR;
    }
    for (;;) {
        const bool has_next = S.next(ui + 1, nxt);
        const char* nA = has_next ? (const char*)g.A + (size_t)nxt.pm * tstepA : cA; const char* nB = has_next ? (const char*)g.Bt + (size_t)nxt.pn * tstepB : cB;
        for (int t = 0; t < nt; t += 2) {
            const bool last = (t == nt - 2);
            const char* a1 = cA + (size_t)(t + 1) * kstep;
            const char* a2 = last ? nA : cA + (size_t)(t + 2) * kstep; const char* b2 = last ? nB : cB + (size_t)(t + 2) * kstep;
            const char* a3 = a2 + kstep; const char* b3 = b2 + kstep;
            if (last && has_next) S.a_ready(nxt);
            if constexpr (SP2) {
            PG8_LDB(B0, 0, 0); PG8_LDB(B1, 0, 1); PG8_SCHED; PG8_LDA(At, 0, 0); PG8_STAGE(PG8_SA(1, 1), a1 + hstepA, voffA);
            PG8_WAIT_V(8); PG8_WAIT_L(0); PG8_BAR; PG8_MMA(0, 0, At, B0); PG8_MMA(0, 1, At, B1); PG8_BAR; PG8_SCHED;
            PG8_LDA(At, 0, 1); PG8_STAGE(PG8_SB(0, 0), b2, voffB); PG8_STAGE(PG8_SB(0, 1), b2 + hstepB, voffB); PG8_STAGE(PG8_SA(0, 0), a2, voffA);
            PG8_WAIT_V(8); PG8_WAIT_L(0); PG8_BAR; PG8_MMA(1, 0, At, B0); PG8_MMA(1, 1, At, B1); PG8_BAR; PG8_SCHED;
            PG8_LDB(B0, 1, 0); PG8_LDB(B1, 1, 1); PG8_SCHED; PG8_LDA(At, 1, 0); PG8_STAGE(PG8_SA(0, 1), a2 + hstepA, voffA);
            PG8_WAIT_V(8); PG8_WAIT_L(0); PG8_BAR; PG8_MMA(0, 0, At, B0); PG8_MMA(0, 1, At, B1); PG8_BAR; PG8_SCHED;
            PG8_LDA(At, 1, 1); PG8_STAGE(PG8_SB(1, 0), b3, voffB); PG8_STAGE(PG8_SB(1, 1), b3 + hstepB, voffB); PG8_STAGE(PG8_SA(1, 0), a3, voffA);
            PG8_WAIT_V(8); PG8_WAIT_L(0); PG8_BAR; PG8_MMA(1, 0, At, B0); PG8_MMA(1, 1, At, B1); PG8_BAR; PG8_SCHED;
            } else {
            PG8_LDB(B0, 0, 0); PG8_SCHED; PG8_LDA(At, 0, 0); PG8_STAGE(PG8_SA(1, 1), a1 + hstepA, voffA);
            PG8_WAIT_L(8); PG8_BAR; PG8_WAIT_L(0); PG8_MMA(0, 0, At, B0); PG8_BAR; PG8_SCHED;
            PG8_LDB(B1, 0, 1); PG8_STAGE(PG8_SB(0, 0), b2, voffB);
            PG8_BAR; PG8_WAIT_L(0); PG8_MMA(0, 1, At, B1); PG8_BAR;
            PG8_LDA(At, 0, 1); PG8_STAGE(PG8_SA(0, 0), a2, voffA);
            PG8_BAR; PG8_WAIT_L(0); PG8_MMA(1, 0, At, B0); PG8_BAR; PG8_SCHED;
            PG8_STAGE(PG8_SB(0, 1), b2 + hstepB, voffB);
            PG8_WAIT_V(6); PG8_BAR; PG8_MMA(1, 1, At, B1); PG8_BAR;
            PG8_LDB(B0, 1, 0); PG8_SCHED; PG8_LDA(At, 1, 0); PG8_STAGE(PG8_SA(0, 1), a2 + hstepA, voffA);
            PG8_WAIT_L(8); PG8_BAR; PG8_WAIT_L(0); PG8_MMA(0, 0, At, B0); PG8_BAR; PG8_SCHED;
            PG8_LDB(B1, 1, 1); PG8_STAGE(PG8_SB(1, 0), b3, voffB);
            PG8_BAR; PG8_WAIT_L(0); PG8_MMA(0, 1, At, B1); PG8_BAR;
            PG8_LDA(At, 1, 1); PG8_STAGE(PG8_SA(1, 0), a3, voffA);
            PG8_BAR; PG8_WAIT_L(0); PG8_MMA(1, 0, At, B0); PG8_BAR; PG8_SCHED;
            PG8_STAGE(PG8_SB(1, 1), b3 + hstepB, voffB);
            PG8_WAIT_V(6); PG8_BAR; PG8_MMA(1, 1, At, B1); PG8_BAR;
            }
        }
        if constexpr (ALIGN_EPI) { if (wr == 0) PG8_BAR; }
        if constexpr (!Epi::AFTER_DRAIN) { E(acc, cur, wr, wc, fr, fq); S.done(cur); }
        if (!has_next) break;
#pragma unroll
        for (int a = 0; a < 2; ++a)
#pragma unroll
            for (int b = 0; b < 2; ++b)
#pragma unroll
                for (int m = 0; m < 4; ++m)
#pragma unroll
                    for (int n = 0; n < 2; ++n) acc[a][b][m][n] = (f32x4){0.f, 0.f, 0.f, 0.f};
        cur = nxt; cA = nA; cB = nB; ++ui;
        if constexpr (ALIGN_EPI) { if (wr == 1) PG8_BAR; }
    }
    PG8_WAIT_V(0);
    if constexpr (!ALIGN_EPI) { if (wr == 0) PG8_BAR; }
    PG8_BAR;
    if constexpr (Epi::AFTER_DRAIN) { E.fused(acc, cur, wr, wc, fr, fq, lds, wid, lane); S.done(cur); }
#undef PG8_SA
#undef PG8_SB
#undef PG8_STAGE
#undef PG8_LDA
#undef PG8_LDB
#undef PG8_MMA
#undef PG8_WAIT_V
#undef PG8_WAIT_L
#undef PG8_BAR
#undef PG8_SCHED
}
}
#define GAS __attribute__((address_space(1)))
#define LAS __attribute__((address_space(3)))
typedef unsigned short bf16;
typedef unsigned v4u __attribute__((ext_vector_type(4)));
typedef float f32x4 __attribute__((ext_vector_type(4)));
typedef short bf16x8 __attribute__((ext_vector_type(8)));
typedef GAS unsigned gu32;
typedef GAS unsigned long long gu64;
#define RLX_AGENT __ATOMIC_RELAXED, __HIP_MEMORY_SCOPE_AGENT
#define LDS_WAIT() asm volatile("s_waitcnt lgkmcnt(0)" ::: "memory")
#define VM_WAIT() asm volatile("s_waitcnt vmcnt(0)" ::: "memory")
__device__ __forceinline__ unsigned long long rt() { return __builtin_amdgcn_s_memrealtime(); }
__device__ __forceinline__ unsigned f2bf(float f) { unsigned u = __builtin_bit_cast(unsigned, f); return (u + 0x7fffu + ((u >> 16) & 1u)) >> 16; }
__device__ __forceinline__ unsigned pk2(float lo, float hi) { return f2bf(lo) | (f2bf(hi) << 16); }

#define XB_TMO      128
#define XB_XCNT(j)  (256  + 64 * (j))
#define XB_XSUB(j)  (1280 + 64 * (j))
#define XB_XGEN(j)  (2304 + 64 * (j))
#define XB_TOP      3328
#define XB_TOPGEN   3392
#define XCD_BAR_WORDS 3456
#define XB_SPIN_CAP (1u << 18)

__device__ __forceinline__ unsigned xb_ld(unsigned* p)              { return __hip_atomic_load(p, __ATOMIC_RELAXED, __HIP_MEMORY_SCOPE_AGENT); }
__device__ __forceinline__ unsigned xb_add(unsigned* p, unsigned v) { return __hip_atomic_fetch_add(p, v, __ATOMIC_RELAXED, __HIP_MEMORY_SCOPE_AGENT); }
__device__ __forceinline__ unsigned xb_xcc_id() { return (unsigned)__builtin_amdgcn_s_getreg((3 << 11) | 20) & 0xFu; }
#define XB_SPIN(cond, bar) do { unsigned _sp = 0; while (cond) { __builtin_amdgcn_s_sleep(1); \
    if ((++_sp & 255u) == 0u) { if (xb_ld(&(bar)[XB_TMO])) break; if (_sp > XB_SPIN_CAP) { atomicAdd(&(bar)[XB_TMO], 1u); break; } } } } while (0)

struct XcdBarrier {
    unsigned* bar; unsigned x;
    volatile LAS unsigned* st;
};

__device__ __forceinline__ XcdBarrier xcd_barrier_post(unsigned* bar, volatile LAS unsigned* st) {
    XcdBarrier b; b.bar = bar; b.x = xb_xcc_id(); b.st = st;
    if (threadIdx.x == 0) (void)xb_add(&bar[XB_XCNT(b.x)], 1u);
    return b;
}
__device__ __forceinline__ void xcd_barrier_complete(unsigned* bar, unsigned x, unsigned& nloc, unsigned& nx) {
    const unsigned G = gridDim.x * gridDim.y * gridDim.z;
    unsigned sum, cnt, mine, sp = 0u;
    for (;;) {
        sum = 0u; cnt = 0u; mine = 0u;
#pragma unroll
        for (unsigned j = 0; j < 16; ++j) { const unsigned c = xb_ld(&bar[XB_XCNT(j)]); sum += c; cnt += (c > 0u) ? 1u : 0u; mine = (j == x) ? c : mine; }
        if (sum == G) break;
        __builtin_amdgcn_s_sleep(1);
        if ((++sp & 255u) == 0u) { if (xb_ld(&bar[XB_TMO])) break; if (sp > XB_SPIN_CAP) { atomicAdd(&bar[XB_TMO], 1u); break; } }
    }
    nloc = mine > 0u ? mine : 1u; nx = cnt > 0u ? cnt : 1u;
}

__device__ __forceinline__ void xcd_barrier(const XcdBarrier& b) {
    asm volatile("s_waitcnt vmcnt(0)" ::: "memory");
    __syncthreads();
    if (threadIdx.x == 0) {
        unsigned* bar = b.bar;
        __builtin_amdgcn_s_waitcnt(0);
        unsigned nloc = b.st[0], nx = b.st[1];
        if (nloc == 0u) { xcd_barrier_complete(bar, b.x, nloc, nx); b.st[0] = nloc; b.st[1] = nx; }
        const unsigned old = xb_add(&bar[XB_XSUB(b.x)], 1u);
        const unsigned gen = old / nloc;
        if (old + 1u == (gen + 1u) * nloc) {
            __builtin_amdgcn_fence(__ATOMIC_RELEASE, "agent");
            asm volatile("s_waitcnt vmcnt(0)" ::: "memory");
            const unsigned og = xb_add(&bar[XB_TOP], 1u);
            const unsigned tg = og / nx;
            if (og + 1u == (tg + 1u) * nx) xb_add(&bar[XB_TOPGEN], 1u);
            else XB_SPIN(xb_ld(&bar[XB_TOPGEN]) == tg, bar);
            __builtin_amdgcn_fence(__ATOMIC_ACQUIRE, "agent");
            xb_add(&bar[XB_XGEN(b.x)], 1u);
            asm volatile("s_waitcnt vmcnt(0)" ::: "memory");
        } else {
            XB_SPIN(xb_ld(&bar[XB_XGEN(b.x)]) == gen, bar);
            __builtin_amdgcn_fence(__ATOMIC_ACQUIRE, "agent");
            asm volatile("s_waitcnt vmcnt(0)" ::: "memory");
        }
    }
    __syncthreads();
}
constexpr int NWAVES = 8;
constexpr int BATCH = 16, SEQ = 2048, DM = 1024, M = BATCH * SEQ;
constexpr int L0P = 3584;
constexpr int L1P = 2048;
constexpr int DFF = 2816;
constexpr float ALPHA = 1.4142135623730951f;
typedef unsigned short bf16_t;
typedef float f32x16 __attribute__((ext_vector_type(16)));

constexpr size_t MiB = 1u << 20;
constexpr size_t WS_CTL = 0, CTL_ZERO_BYTES = 1 * MiB;
constexpr int CW_BAR = 4096;
constexpr size_t WS_W0IN = 2 * MiB, WS_W0OUT = 9 * MiB, WS_WUP0 = 11 * MiB, WS_WDN0 = 22 * MiB, WS_W1IN = 28 * MiB, WS_WUQ = 32 * MiB, WS_WUKV = 33 * MiB,
                 WS_W1OUT = 34 * MiB, WS_WUP1 = 36 * MiB, WS_WDN1 = 47 * MiB;
constexpr size_t WS_XB = 56 * MiB, WS_YMIX = 120 * MiB, WS_BIG = 184 * MiB;
constexpr size_t WS_G = 408 * MiB, WS_BONUS = 440 * MiB, WS_DT = 441 * MiB, WS_XST = 442 * MiB, WS_BT = 474 * MiB, WS_ASUM = 490 * MiB;
constexpr size_t WS_SLOC = 120 * MiB;
constexpr size_t WS_W2T = 53 * MiB, WS_A2T = 53 * MiB + 256 * 1024, WS_G2T = 53 * MiB + 512 * 1024;
constexpr size_t WS_GU = 120 * MiB;
constexpr size_t WS_PROJ1 = 184 * MiB, WS_QM = 312 * MiB, WS_KVM = 360 * MiB, WS_KPE = 424 * MiB, WS_RS = 426 * MiB;
constexpr size_t WS_CSTAB = 492 * MiB;
constexpr size_t WS_VTS = 428 * MiB, WS_VTM = 460 * MiB;
constexpr size_t WS_NEED = 496 * MiB;

constexpr int RING_BYTES = 131072;
constexpr int LDSCTL_OFF = 146432, MISC_OFF = LDSCTL_OFF + 320;
constexpr int LDS_BYTES = 147456;

__device__ __forceinline__ float bf2f(bf16_t b) { return __builtin_bit_cast(float, (unsigned)b << 16); }
__device__ __forceinline__ float sigmoidf_(float x) { return 1.f / (1.f + expf(-x)); }
__device__ __forceinline__ float softplusf_(float x) { return fmaxf(x, 0.f) + log1pf(expf(-fabsf(x))); }
__device__ __forceinline__ float siluf_(float x) { return x / (1.f + expf(-x)); }
__device__ __forceinline__ float wave_sum(float v) {
#pragma unroll
    for (int o = 1; o < 64; o <<= 1) v += __shfl_xor(v, o);
    return v;
}
#define WSYNC() asm volatile("s_waitcnt lgkmcnt(0)" ::: "memory")
typedef float f32x2_t __attribute__((ext_vector_type(2)));
typedef __bf16 bf16x2_t __attribute__((ext_vector_type(2)));
typedef unsigned u32x2 __attribute__((ext_vector_type(2)));
__device__ __forceinline__ unsigned cvtpk(float lo, float hi) { f32x2_t v = {lo, hi}; bf16x2_t b = __builtin_convertvector(v, bf16x2_t); return __builtin_bit_cast(unsigned, b); }
__device__ __forceinline__ float bflo(unsigned u) { return __builtin_bit_cast(float, u << 16); }
__device__ __forceinline__ float bfhi(unsigned u) { return __builtin_bit_cast(float, u & 0xffff0000u); }

__device__ __forceinline__ void transpose_matrix(const float* __restrict__ W, int K, int N, bf16_t* __restrict__ WT, int Npad, int ldt, LAS float* scr, int gw, int NGW, int lane, const float* __restrict__ kscale) {
    (void)scr;
    const int nblk = Npad / 64, nit = (K / 64) * nblk;
    for (int it = gw; it < nit; it += NGW) {
        const int kb = it / nblk, nb = it - kb * nblk, n = nb * 64 + lane, k0 = kb * 64;
        const bool ok = n < N; const float* src = W + (size_t)k0 * N + (ok ? n : 0);
#pragma unroll
        for (int hc = 0; hc < 2; ++hc) {
            float v[32];
#pragma unroll
            for (int i = 0; i < 32; ++i) v[i] = src[(size_t)(hc * 32 + i) * N];
#pragma unroll
            for (int c = 0; c < 4; ++c) { float u[8];
#pragma unroll
                for (int i = 0; i < 8; ++i) { u[i] = ok ? v[c * 8 + i] : 0.f; if (kscale) u[i] *= kscale[k0 + hc * 32 + c * 8 + i]; }
                v4u o; o.x = cvtpk(u[0], u[1]); o.y = cvtpk(u[2], u[3]); o.z = cvtpk(u[4], u[5]); o.w = cvtpk(u[6], u[7]);
                *(v4u*)(WT + (size_t)n * ldt + k0 + hc * 32 + c * 8) = o; }
        }
    }
}

template <bool ST = true> __device__ __forceinline__ void ln_rows(float* h, bf16_t* hb, const float* __restrict__ g, const float* __restrict__ b, int gw, int NGW, int lane) {
    for (int row = gw; row < M; row += NGW) {
        float* p = h + (size_t)row * DM;
        f32x4 v[4]; float s = 0.f;
#pragma unroll
        for (int j = 0; j < 4; ++j) { v[j] = *(const f32x4*)(p + 4 * lane + 256 * j); s += (v[j][0] + v[j][1]) + (v[j][2] + v[j][3]); }
        const float mean = wave_sum(s) * (1.f / DM); float q = 0.f;
#pragma unroll
        for (int j = 0; j < 4; ++j) { v[j] = v[j] - mean; q += (v[j][0] * v[j][0] + v[j][1] * v[j][1]) + (v[j][2] * v[j][2] + v[j][3] * v[j][3]); }
        const float rstd = 1.0f / sqrtf(wave_sum(q) * (1.f / DM) + 1e-5f);
#pragma unroll
        for (int j = 0; j < 4; ++j) {
            const int c = 4 * lane + 256 * j;
            const f32x4 gg = *(const f32x4*)(g + c), bb = *(const f32x4*)(b + c);
            const f32x4 o = v[j] * rstd * gg + bb;
            uint2 w; w.x = pk2(o[0], o[1]); w.y = pk2(o[2], o[3]);
            if (ST) { *(f32x4*)(p + c) = o; *(uint2*)(hb + (size_t)row * DM + c) = w; } else asm volatile("" :: "v"(w.x), "v"(w.y), "v"(o[0]), "v"(o[1]), "v"(o[2]), "v"(o[3]));
        }
    }
}

__device__ __forceinline__ void rwkv_naive_chain(int chain, int lane, LAS float* sm, const bf16_t* __restrict__ proj, const float* __restrict__ mix, const float* __restrict__ w0, const float* __restrict__ w2,
                                                 const float* __restrict__ a0, const float* __restrict__ a2, const float* __restrict__ g2, const float* __restrict__ k_k,
                                                 const float* __restrict__ k_a, const float* __restrict__ r_k, const float* __restrict__ ln_g, const float* __restrict__ ln_b, bf16_t* __restrict__ ymix) {
    LAS float* s_w2 = sm; LAS float* s_a2 = sm + 4096; LAS float* s_g2 = sm + 8192; LAS float* s_tw = sm + 16384; LAS float* s_al = s_tw + 64; LAS float* s_sg = s_tw + 128;
    LAS float* s_w = s_tw + 256; LAS float* s_k = s_tw + 320; LAS float* s_a = s_tw + 384; LAS float* s_b = s_tw + 448; LAS float* s_r = s_tw + 512;
    const int b = chain >> 3, h = chain & 7, c = h * 64 + lane;
    for (int l = 0; l < 64; ++l) { s_w2[l * 64 + lane] = w2[l * 512 + c]; s_a2[l * 64 + lane] = a2[l * 512 + c]; }
    for (int l = 0; l < 128; ++l) s_g2[l * 64 + lane] = g2[l * 512 + c];
    const float mr = mix[c], mk = mix[512 + c], mv = mix[1024 + c], mw = mix[1536 + lane], ma = mix[1600 + lane], mg0 = mix[1664 + lane], mg1 = mix[1728 + lane];
    const float w0c = w0[c], a0c = a0[c], kkc = k_k[c], kac = k_a[c], rkc = r_k[c], lgc = ln_g[c], lbc = ln_b[c];
    float S[64];
#pragma unroll
    for (int j = 0; j < 64; ++j) S[j] = 0.f;
    float pr = 0.f, pk = 0.f, pv = 0.f, pw = 0.f, pa = 0.f, pg0 = 0.f, pg1 = 0.f;
    WSYNC();
    for (int t = 0; t < SEQ; ++t) {
        const bf16_t* row = proj + (size_t)(b * SEQ + t) * L0P;
        const float cr = bf2f(row[c]), ck = bf2f(row[512 + c]), cv = bf2f(row[1024 + c]), cw = bf2f(row[1536 + lane]), ca = bf2f(row[1600 + lane]),
                    cg0 = bf2f(row[1664 + lane]), cg1 = bf2f(row[1728 + lane]);
        const float r_s = cr + (pr - cr) * mr, k_s = ck + (pk - ck) * mk, v_s = cv + (pv - cv) * mv;
        const float wl = cw + (pw - cw) * mw, al = ca + (pa - ca) * ma, g0 = cg0 + (pg0 - cg0) * mg0, g1 = cg1 + (pg1 - cg1) * mg1;
        pr = cr; pk = ck; pv = cv; pw = cw; pa = ca; pg0 = cg0; pg1 = cg1;
        s_tw[lane] = tanhf(wl); s_al[lane] = al; s_sg[lane] = sigmoidf_(g0); s_sg[64 + lane] = sigmoidf_(g1);
        WSYNC();
        float wsum = w0c, asum = a0c, gsum = 0.f;
#pragma unroll 2
        for (int l = 0; l < 64; ++l) { wsum += s_tw[l] * s_w2[l * 64 + lane]; asum += s_al[l] * s_a2[l * 64 + lane]; }
#pragma unroll 2
        for (int l = 0; l < 128; ++l) gsum += s_sg[l] * s_g2[l * 64 + lane];
        const float log_w = -softplusf_(-wsum) - 0.5f;
        const float dec = expf(-expf(log_w));
        const float a = sigmoidf_(asum);
        float kkv = k_s * kkc;
        const float nrm = sqrtf(wave_sum(kkv * kkv));
        kkv = kkv / fmaxf(nrm, 1e-12f);
        const float k2 = k_s * (1.f + (a - 1.f) * kac);
        const float bonus_s = wave_sum(r_s * k2 * rkc);
        s_w[lane] = dec; s_k[lane] = k2; s_a[lane] = -kkv; s_b[lane] = kkv * a; s_r[lane] = r_s;
        WSYNC();
        float sa = 0.f;
#pragma unroll
        for (int j = 0; j < 64; ++j) sa += S[j] * s_a[j];
        float y = 0.f;
#pragma unroll
        for (int j = 0; j < 64; ++j) { S[j] = S[j] * s_w[j] + sa * s_b[j] + v_s * s_k[j]; y += S[j] * s_r[j]; }
        const float mu = wave_sum(y) * (1.f / 64.f);
        const float d = y - mu;
        const float var = wave_sum(d * d) * (1.f / 64.f);
        const float yn = d * (1.0f / sqrtf(var + 64e-5f)) * lgc + lbc;
        const float o = (yn + bonus_s * v_s) * gsum;
        ymix[(size_t)(b * SEQ + t) * DM + c] = (bf16_t)f2bf(o);
        WSYNC();
    }
}

__device__ __forceinline__ void ssm_conv_all(const bf16_t* __restrict__ proj, const float* __restrict__ cw, const float* __restrict__ cb, const float* __restrict__ dtb,
                                             bf16_t* __restrict__ xbc, float* __restrict__ dt, int gtid, int NT) {
    for (size_t i = gtid; i < (size_t)M * 1024; i += NT) {
        const int m = (int)(i >> 10), c = (int)(i & 1023), t = m & (SEQ - 1);
        float acc = cb[c];
#pragma unroll
        for (int k = 0; k < 4; ++k) { const int tt = t - 3 + k; if (tt >= 0) acc += cw[k * 1024 + c] * bf2f(proj[(size_t)(m - 3 + k) * L0P + 2304 + c]); }
        xbc[i] = (bf16_t)f2bf(siluf_(acc));
    }
    for (int i = gtid; i < M * 8; i += NT) dt[i] = softplusf_(bf2f(proj[(size_t)(i >> 3) * L0P + 3328 + (i & 7)]) + dtb[i & 7]);
}
__device__ __forceinline__ void ssd_naive_task(int task, int lane, const bf16_t* __restrict__ xbc, const float* __restrict__ dt, const float* __restrict__ a_log, const float* __restrict__ dsk, float* __restrict__ yssm) {
    const int chain = task >> 2, q = task & 3, b = chain >> 3, h = chain & 7, g = h >> 2, p = q * 16 + (lane >> 2), nq = lane & 3;
    const float A = -expf(a_log[h]), D = dsk[h];
    float st[32];
#pragma unroll
    for (int n = 0; n < 32; ++n) st[n] = 0.f;
    for (int t = 0; t < SEQ; ++t) {
        const size_t m = (size_t)b * SEQ + t;
        const float dtv = dt[m * 8 + h], dA = expf(dtv * A);
        const float x = bf2f(xbc[m * 1024 + h * 64 + p]), xdt = x * dtv;
        const bf16_t* Bp = xbc + m * 1024 + 512 + g * 128 + nq * 32;
        const bf16_t* Cp = xbc + m * 1024 + 768 + g * 128 + nq * 32;
        float yp = 0.f;
#pragma unroll
        for (int n = 0; n < 32; ++n) { st[n] = st[n] * dA + xdt * bf2f(Bp[n]); yp += st[n] * bf2f(Cp[n]); }
        yp += __shfl_xor(yp, 1); yp += __shfl_xor(yp, 2);
        if (nq == 0) yssm[m * 512 + h * 64 + p] = yp + D * x;
    }
}
template <bool ST = true> __device__ __forceinline__ void ssm_gate_norm_all(const bf16_t* __restrict__ yssm, const bf16_t* __restrict__ proj, const float* __restrict__ ng, bf16_t* __restrict__ ymix, int wv0, int wvend, int lane) {
    for (int wv = wv0; wv < wvend; wv += NWAVES) {
        const int m = wv >> 1, g = wv & 1;
        float u[4], q = 0.f;
#pragma unroll
        for (int j = 0; j < 4; ++j) { const int c = g * 256 + j * 64 + lane; const float z = bf2f(proj[(size_t)m * L0P + 1792 + c]); u[j] = bf2f(yssm[(size_t)m * 512 + c]) * siluf_(z); q += u[j] * u[j]; }
        const float rs = 1.0f / sqrtf(wave_sum(q) * (1.f / 256.f) + 1e-5f);
#pragma unroll
        for (int j = 0; j < 4; ++j) { const int c = g * 256 + j * 64 + lane; const float o_ = u[j] * rs * ng[c]; if (ST) ymix[(size_t)m * DM + 512 + c] = (bf16_t)f2bf(o_); else asm volatile("" :: "v"(o_)); }
    }
}
template <bool ST = true> __device__ __forceinline__ void ffn_act_all(bf16_t* gu, const float* __restrict__ cw, const float* __restrict__ cb, int gtid, int NT) {
    constexpr int NCH = DFF / 8, NSTRIP = M / 32;
    for (int task = gtid; task < NSTRIP * NCH; task += NT) {
        const int strip = task / NCH, q = task - strip * NCH, c0 = q * 8, m0 = strip * 32;
        float w0[8], w1[8], w2[8], bb[8], g2[8], g1[8];
#pragma unroll
        for (int j = 0; j < 8; j += 4) { const f32x4 a = *(const f32x4*)(cw + c0 + j), b = *(const f32x4*)(cw + DFF + c0 + j), c = *(const f32x4*)(cw + 2 * DFF + c0 + j), d = *(const f32x4*)(cb + c0 + j);
#pragma unroll
            for (int k = 0; k < 4; ++k) { w0[j + k] = a[k]; w1[j + k] = b[k]; w2[j + k] = c[k]; bb[j + k] = d[k]; } }
        bf16_t* base = gu + (size_t)m0 * (2 * DFF) + c0;
        if ((m0 & (SEQ - 1)) != 0) { const v4u a = *(const v4u*)(base - 2 * (2 * DFF)), b = *(const v4u*)(base - (2 * DFF));
            g2[0] = bflo(a.x); g2[1] = bfhi(a.x); g2[2] = bflo(a.y); g2[3] = bfhi(a.y); g2[4] = bflo(a.z); g2[5] = bfhi(a.z); g2[6] = bflo(a.w); g2[7] = bfhi(a.w);
            g1[0] = bflo(b.x); g1[1] = bfhi(b.x); g1[2] = bflo(b.y); g1[3] = bfhi(b.y); g1[4] = bflo(b.z); g1[5] = bfhi(b.z); g1[6] = bflo(b.w); g1[7] = bfhi(b.w); }
        else {
#pragma unroll
            for (int j = 0; j < 8; ++j) { g2[j] = 0.f; g1[j] = 0.f; } }
#pragma unroll 4
        for (int r = 0; r < 32; ++r) {
            const v4u gv = *(const v4u*)(base + (size_t)r * (2 * DFF)), uv = *(const v4u*)(base + (size_t)r * (2 * DFF) + DFF);
            const unsigned gw_[4] = {gv.x, gv.y, gv.z, gv.w}, uw_[4] = {uv.x, uv.y, uv.z, uv.w};
            unsigned ow[4];
#pragma unroll
            for (int k = 0; k < 4; ++k) {
                const float ga = bflo(gw_[k]), gb = bfhi(gw_[k]);
                const float ya = bb[2 * k] + w0[2 * k] * g2[2 * k] + w1[2 * k] * g1[2 * k] + w2[2 * k] * ga;
                const float yb = bb[2 * k + 1] + w0[2 * k + 1] * g2[2 * k + 1] + w1[2 * k + 1] * g1[2 * k + 1] + w2[2 * k + 1] * gb;
                g2[2 * k] = g1[2 * k]; g1[2 * k] = ga; g2[2 * k + 1] = g1[2 * k + 1]; g1[2 * k + 1] = gb;
                ow[k] = cvtpk(ya / (1.f + __expf(-ya)) * bflo(uw_[k]), yb / (1.f + __expf(-yb)) * bfhi(uw_[k]));
            }
            if (ST) *(v4u*)(base + (size_t)r * (2 * DFF) + DFF) = (v4u){ow[0], ow[1], ow[2], ow[3]}; else asm volatile("" :: "v"(ow[0]), "v"(ow[1]), "v"(ow[2]), "v"(ow[3]));
        }
    }
}
template <bool ST = true> __device__ __forceinline__ void mla_prep_all(const bf16_t* __restrict__ proj1, const int* __restrict__ pos, float* __restrict__ rs, bf16_t* __restrict__ kpe, float* __restrict__ cstab, int gw, int NGW, int lane) {
    for (int m = gw; m < M; m += NGW) {
        const bf16_t* row = proj1 + (size_t)m * L1P;
        float q = 0.f;
#pragma unroll
        for (int j = 0; j < 4; ++j) { const float v = bf2f(row[1536 + j * 64 + lane]); q += v * v; }
        q = wave_sum(q);
        float k = 0.f;
#pragma unroll
        for (int j = 0; j < 2; ++j) { const float v = bf2f(row[1792 + j * 64 + lane]); k += v * v; }
        k = wave_sum(k);
        if (ST && lane == 0) { rs[(size_t)m * 2] = 1.0f / sqrtf(q * (1.f / 256.f) + 1e-6f); rs[(size_t)m * 2 + 1] = 1.0f / sqrtf(k * (1.f / 128.f) + 1e-6f); }
        if (lane < 16) {
            const double inv = pow(10000.0, -(double)(2 * lane) / 32.0);
            const double ang = (double)pos[m] * inv;
            const float cs = (float)cos(ang), sn = (float)sin(ang);
            if (ST) { cstab[(size_t)m * 32 + lane] = cs; cstab[(size_t)m * 32 + 16 + lane] = sn; }
            const float x1 = bf2f(row[1920 + lane]), x2 = bf2f(row[1936 + lane]);
            const bf16_t r1_ = (bf16_t)f2bf(x1 * cs - x2 * sn), r2_ = (bf16_t)f2bf(x2 * cs + x1 * sn);
            if (ST) { kpe[(size_t)m * 32 + lane] = r1_; kpe[(size_t)m * 32 + 16 + lane] = r2_; } else asm volatile("" :: "v"((unsigned)r1_), "v"((unsigned)r2_), "v"(q), "v"(k));
        }
    }
}
template <bool ST = true> __device__ __forceinline__ void rope_q_all(bf16_t* qm, const float* __restrict__ cstab, int gtid, int NT) {
    for (int i = gtid; i < M * 16; i += NT) {
        const int m = i >> 4, h = (i >> 1) & 7, k0 = (i & 1) * 8;
        bf16_t* p = qm + (size_t)m * 768 + h * 96 + 64 + k0;
        const v4u a = *(const v4u*)p, b = *(const v4u*)(p + 16);
        const f32x4 c0 = *(const f32x4*)(cstab + (size_t)m * 32 + k0), c1 = *(const f32x4*)(cstab + (size_t)m * 32 + k0 + 4), s0 = *(const f32x4*)(cstab + (size_t)m * 32 + 16 + k0), s1 = *(const f32x4*)(cstab + (size_t)m * 32 + 16 + k0 + 4);
        const unsigned au[4] = {a.x, a.y, a.z, a.w}, bu[4] = {b.x, b.y, b.z, b.w};
        const float cs[8] = {c0[0], c0[1], c0[2], c0[3], c1[0], c1[1], c1[2], c1[3]}, sn[8] = {s0[0], s0[1], s0[2], s0[3], s1[0], s1[1], s1[2], s1[3]};
        unsigned o1[4], o2[4];
#pragma unroll
        for (int q = 0; q < 4; ++q) { const float x1a = bflo(au[q]), x1b = bfhi(au[q]), x2a = bflo(bu[q]), x2b = bfhi(bu[q]);
            o1[q] = cvtpk(x1a * cs[2 * q] - x2a * sn[2 * q], x1b * cs[2 * q + 1] - x2b * sn[2 * q + 1]);
            o2[q] = cvtpk(x2a * cs[2 * q] + x1a * sn[2 * q], x2b * cs[2 * q + 1] + x1b * sn[2 * q + 1]); }
        if (ST) { *(v4u*)p = (v4u){o1[0], o1[1], o1[2], o1[3]}; *(v4u*)(p + 16) = (v4u){o2[0], o2[1], o2[2], o2[3]}; }
    }
}
__device__ __forceinline__ void sb_naive_task(int qblk, int bh, int lane, const bf16_t* __restrict__ proj1, bf16_t* __restrict__ ymix) {
    const int b = bh >> 3, h = bh & 7, t = qblk * 64 + lane;
    const size_t mrow = (size_t)b * SEQ;
    float q[64], o[64];
#pragma unroll
    for (int d = 0; d < 64; ++d) { q[d] = bf2f(proj1[(mrow + t) * L1P + h * 64 + d]) * 0.125f; o[d] = 0.f; }
    float cum = 0.f;
    const int smax = qblk * 64 + 63;
    for (int s = smax - 1; s >= 0; --s) {
        const bf16_t* kr = proj1 + (mrow + s) * L1P + 512 + h * 64;
        const bf16_t* vr = proj1 + (mrow + s) * L1P + 1024 + h * 64;
        float z = 0.f;
#pragma unroll
        for (int d = 0; d < 64; ++d) z += q[d] * bf2f(kr[d]);
        if (s < t) {
            const float lsp = -softplusf_(-z);
            const float lsn = -softplusf_(z);
            const float att = expf(lsp + cum);
            cum += lsn;
#pragma unroll
            for (int d = 0; d < 64; ++d) o[d] += att * bf2f(vr[d]);
        }
    }
#pragma unroll
    for (int d = 0; d < 64; ++d) ymix[(mrow + t) * DM + h * 64 + d] = (bf16_t)f2bf(o[d]);
}
__device__ __forceinline__ void mla_naive_task(int qblk, int bh, int lane, const bf16_t* __restrict__ qm, const bf16_t* __restrict__ kvm, const bf16_t* __restrict__ kpe, bf16_t* __restrict__ ymix) {
    const int b = bh >> 3, h = bh & 7, t = qblk * 64 + lane;
    const size_t mrow = (size_t)b * SEQ;
    const float scale = 0.10206207261596577f;
    float q[96], o[64];
#pragma unroll
    for (int d = 0; d < 96; ++d) q[d] = bf2f(qm[(mrow + t) * 768 + h * 96 + d]) * scale;
#pragma unroll
    for (int d = 0; d < 64; ++d) o[d] = 0.f;
    float mx = -1e30f, l = 0.f;
    const int smax = qblk * 64 + 63;
    for (int s = 0; s <= smax; ++s) {
        const bf16_t* kr = kvm + (mrow + s) * 1024 + h * 128;
        const bf16_t* pr = kpe + (mrow + s) * 32;
        float z = 0.f;
#pragma unroll
        for (int d = 0; d < 64; ++d) z += q[d] * bf2f(kr[d]);
#pragma unroll
        for (int d = 0; d < 32; ++d) z += q[64 + d] * bf2f(pr[d]);
        if (s <= t) {
            const float mn = fmaxf(mx, z), f = expf(mx - mn), pz = expf(z - mn);
            l = l * f + pz; mx = mn;
#pragma unroll
            for (int d = 0; d < 64; ++d) o[d] = o[d] * f + pz * bf2f(kr[64 + d]);
        }
    }
    const float il = 1.f / l;
#pragma unroll
    for (int d = 0; d < 64; ++d) ymix[(mrow + t) * DM + 512 + h * 64 + d] = (bf16_t)f2bf(o[d] * il);
}


__device__ __forceinline__ int crow(int r, int hi) { return (r & 3) + 8 * (r >> 2) + 4 * hi; }
#define MFMA32(a, b, c) __builtin_amdgcn_mfma_f32_32x32x16_bf16((a), (b), (c), 0, 0, 0)
constexpr int STG_PITCH = 72;
__device__ __forceinline__ void transpose_tile64(const bf16_t* __restrict__ src, int sp, bf16_t* __restrict__ dst, int dp, LAS bf16_t* scr, int lane) {
#pragma unroll
    for (int i = 0; i < 8; ++i) { const int row = i * 8 + (lane >> 3), ch = lane & 7; const v4u v = *(const v4u*)(src + (size_t)row * sp + ch * 8); *(LAS v4u*)(scr + row * STG_PITCH + ch * 8) = v; }
    WSYNC();
#pragma unroll
    for (int i = 0; i < 8; ++i) { const int d = i * 8 + (lane >> 3), tc = lane & 7; const LAS bf16_t* p = scr + (tc * 8) * STG_PITCH + d;
        v4u o; o.x = (unsigned)p[0] | ((unsigned)p[STG_PITCH] << 16); o.y = (unsigned)p[2 * STG_PITCH] | ((unsigned)p[3 * STG_PITCH] << 16);
        o.z = (unsigned)p[4 * STG_PITCH] | ((unsigned)p[5 * STG_PITCH] << 16); o.w = (unsigned)p[6 * STG_PITCH] | ((unsigned)p[7 * STG_PITCH] << 16);
        *(v4u*)(dst + (size_t)d * dp + tc * 8) = o; }
    WSYNC();
}
__device__ __forceinline__ void store_OT(const f32x16 (&o)[2], float sc, LAS bf16_t* stg, bf16_t* __restrict__ dst, int lane) {
    const int l31 = lane & 31, hi = lane >> 5;
#pragma unroll
    for (int dt = 0; dt < 2; ++dt)
#pragma unroll
        for (int r = 0; r < 16; ++r) stg[l31 * STG_PITCH + 32 * dt + crow(r, hi)] = (bf16_t)f2bf(o[dt][r] * sc);
    WSYNC();
#pragma unroll
    for (int i = 0; i < 4; ++i) { const int row = i * 8 + (lane >> 3), ch = lane & 7; const v4u v = *(const LAS v4u*)(stg + row * STG_PITCH + ch * 8); *(v4u*)(dst + (size_t)row * DM + ch * 8) = v; }
    WSYNC();
}
__device__ __forceinline__ float softplus_fast(float z) { return fmaxf(z, 0.f) + __logf(1.f + __expf(-fabsf(z))); }

__device__ __forceinline__ void sb_task(int bh, int qblk, int lane, const bf16_t* __restrict__ P1, const bf16_t* __restrict__ VT, bf16_t* __restrict__ ymix, LAS bf16_t* stg) {
    const int b = bh >> 3, h = bh & 7, l31 = lane & 31, hi = lane >> 5, q0 = qblk * 32, t = q0 + l31;
    const size_t rowb = (size_t)b * SEQ;
    const bf16_t* Qp = P1 + (rowb + q0 + l31) * L1P + h * 64 + 8 * hi;
    bf16x8 qf[4];
#pragma unroll
    for (int kk = 0; kk < 4; ++kk) qf[kk] = *(const bf16x8*)(Qp + 16 * kk);
    const bf16_t* Kp = P1 + (rowb + l31) * L1P + 512 + h * 64 + 8 * hi;
    const bf16_t* Vp = VT + ((size_t)bh * 64 + l31) * SEQ + 4 * hi;
    f32x16 o[2];
#pragma unroll
    for (int r = 0; r < 16; ++r) { o[0][r] = 0.f; o[1][r] = 0.f; }
    float cum = 0.f;
    bf16x8 kf[4]; u32x2 va[2][2][2];
#define SB_LOAD(S0, KF, VA) do { _Pragma("unroll") for (int kk = 0; kk < 4; ++kk) KF[kk] = *(const bf16x8*)(Kp + (size_t)(S0) * L1P + 16 * kk); \
        _Pragma("unroll") for (int dt = 0; dt < 2; ++dt) _Pragma("unroll") for (int ks = 0; ks < 2; ++ks) { VA[dt][ks][0] = *(const u32x2*)(Vp + (size_t)dt * 32 * SEQ + (S0) + 16 * ks); VA[dt][ks][1] = *(const u32x2*)(Vp + (size_t)dt * 32 * SEQ + (S0) + 16 * ks + 8); } } while (0)
    SB_LOAD(q0, kf, va);
    for (int s0 = q0; s0 >= 0; s0 -= 32) {
        bf16x8 kn[4]; u32x2 vn[2][2][2];
        const int sn = (s0 >= 32) ? s0 - 32 : 0;
        SB_LOAD(sn, kn, vn);
        f32x16 acc;
#pragma unroll
        for (int r = 0; r < 16; ++r) acc[r] = 0.f;
#pragma unroll
        for (int kk = 0; kk < 4; ++kk) acc = MFMA32(kf[kk], qf[kk], acc);
        const bool diag = (s0 == q0);
        float lb[16], lk[16];
#pragma unroll
        for (int r = 0; r < 16; ++r) { const float z = acc[r] * 0.125f; const float sp = softplus_fast(z); float b_ = z - sp, k_ = -sp;
            if (diag) { const bool valid = (s0 + crow(r, hi)) < t; b_ = valid ? b_ : -1e30f; k_ = valid ? k_ : 0.f; }
            lb[r] = b_; lk[r] = k_; }
        float e[16], T[4], U[4];
#pragma unroll
        for (int i = 0; i < 4; ++i) { e[4 * i + 3] = 0.f; e[4 * i + 2] = lk[4 * i + 3]; e[4 * i + 1] = e[4 * i + 2] + lk[4 * i + 2]; e[4 * i] = e[4 * i + 1] + lk[4 * i + 1]; T[i] = e[4 * i] + lk[4 * i]; }
#pragma unroll
        for (int i = 0; i < 4; ++i) U[i] = __shfl_xor(T[i], 32);
        float off[4];
        { const float st2 = T[3], st1 = st2 + T[2], st0 = st1 + T[1]; const float su2 = U[3], su1 = su2 + U[2], su0 = su1 + U[1];
          const float x0 = hi ? 0.f : U[0], x1 = hi ? 0.f : U[1], x2 = hi ? 0.f : U[2], x3 = hi ? 0.f : U[3];
          off[3] = x3; off[2] = st2 + su2 + x2; off[1] = st1 + su1 + x1; off[0] = st0 + su0 + x0;
          const float total = st0 + T[0] + su0 + U[0];
#pragma unroll
          for (int r = 0; r < 16; ++r) acc[r] = __expf(lb[r] + (cum + off[r >> 2] + e[r]));
          cum += total; }
        bf16x8 pf[2];
#pragma unroll
        for (int ks = 0; ks < 2; ++ks) { v4u w; w.x = cvtpk(acc[8 * ks], acc[8 * ks + 1]); w.y = cvtpk(acc[8 * ks + 2], acc[8 * ks + 3]); w.z = cvtpk(acc[8 * ks + 4], acc[8 * ks + 5]); w.w = cvtpk(acc[8 * ks + 6], acc[8 * ks + 7]); pf[ks] = __builtin_bit_cast(bf16x8, w); }
#pragma unroll
        for (int dt = 0; dt < 2; ++dt)
#pragma unroll
            for (int ks = 0; ks < 2; ++ks) { v4u a; a.x = va[dt][ks][0].x; a.y = va[dt][ks][0].y; a.z = va[dt][ks][1].x; a.w = va[dt][ks][1].y; o[dt] = MFMA32(__builtin_bit_cast(bf16x8, a), pf[ks], o[dt]); }
        if (__all(cum < -110.f)) break;
#pragma unroll
        for (int kk = 0; kk < 4; ++kk) kf[kk] = kn[kk];
#pragma unroll
        for (int dt = 0; dt < 2; ++dt)
#pragma unroll
            for (int ks = 0; ks < 2; ++ks) { va[dt][ks][0] = vn[dt][ks][0]; va[dt][ks][1] = vn[dt][ks][1]; }
    }
#undef SB_LOAD
    store_OT(o, 1.0f, stg, ymix + (rowb + q0) * DM + h * 64, lane);
}
__device__ __forceinline__ void mla_task(int bh, int qblk, int lane, const bf16_t* __restrict__ QM, const bf16_t* __restrict__ KVM, const bf16_t* __restrict__ KPE, const bf16_t* __restrict__ VT,
                                         bf16_t* __restrict__ ymix, LAS bf16_t* stg) {
    const int b = bh >> 3, h = bh & 7, l31 = lane & 31, hi = lane >> 5, q0 = qblk * 32, t = q0 + l31;
    const size_t rowb = (size_t)b * SEQ;
    const bf16_t* Qp = QM + (rowb + q0 + l31) * 768 + h * 96 + 8 * hi;
    bf16x8 qf[6];
#pragma unroll
    for (int kk = 0; kk < 6; ++kk) qf[kk] = *(const bf16x8*)(Qp + 16 * kk);
    const bf16_t* Kn = KVM + (rowb + l31) * 1024 + h * 128 + 8 * hi;
    const bf16_t* Kr = KPE + (rowb + l31) * 32 + 8 * hi;
    const bf16_t* Vp = VT + ((size_t)bh * 64 + l31) * SEQ + 4 * hi;
    const float sc2 = 0.10206207261596577f * 1.4426950408889634f;
    f32x16 o[2];
#pragma unroll
    for (int r = 0; r < 16; ++r) { o[0][r] = 0.f; o[1][r] = 0.f; }
    float mrun = -1e30f, lsum = 0.f;
    bf16x8 kf[6]; u32x2 va[2][2][2];
#define ML_LOAD(S0, KF, VA) do { _Pragma("unroll") for (int kk = 0; kk < 4; ++kk) KF[kk] = *(const bf16x8*)(Kn + (size_t)(S0) * 1024 + 16 * kk); \
        _Pragma("unroll") for (int kk = 0; kk < 2; ++kk) KF[4 + kk] = *(const bf16x8*)(Kr + (size_t)(S0) * 32 + 16 * kk); \
        _Pragma("unroll") for (int dt = 0; dt < 2; ++dt) _Pragma("unroll") for (int ks = 0; ks < 2; ++ks) { VA[dt][ks][0] = *(const u32x2*)(Vp + (size_t)dt * 32 * SEQ + (S0) + 16 * ks); VA[dt][ks][1] = *(const u32x2*)(Vp + (size_t)dt * 32 * SEQ + (S0) + 16 * ks + 8); } } while (0)
    ML_LOAD(0, kf, va);
    for (int s0 = 0; s0 <= q0; s0 += 32) {
        bf16x8 kn[6]; u32x2 vn[2][2][2];
        const int sn = (s0 + 32 <= q0) ? s0 + 32 : s0;
        ML_LOAD(sn, kn, vn);
        f32x16 acc;
#pragma unroll
        for (int r = 0; r < 16; ++r) acc[r] = 0.f;
#pragma unroll
        for (int kk = 0; kk < 6; ++kk) acc = MFMA32(kf[kk], qf[kk], acc);
        const bool diag = (s0 == q0);
        float tmax = -1e30f;
#pragma unroll
        for (int r = 0; r < 16; ++r) { float z = acc[r] * sc2; if (diag && (s0 + crow(r, hi)) > t) z = -1e30f; acc[r] = z; tmax = fmaxf(tmax, z); }
        tmax = fmaxf(tmax, __shfl_xor(tmax, 32));
        const float mn = fmaxf(mrun, tmax), alpha = exp2f(mrun - mn); mrun = mn;
        float ps = 0.f;
#pragma unroll
        for (int r = 0; r < 16; ++r) { acc[r] = exp2f(acc[r] - mn); ps += acc[r]; }
        lsum = lsum * alpha + ps;
#pragma unroll
        for (int r = 0; r < 16; ++r) { o[0][r] *= alpha; o[1][r] *= alpha; }
        bf16x8 pf[2];
#pragma unroll
        for (int ks = 0; ks < 2; ++ks) { v4u w; w.x = cvtpk(acc[8 * ks], acc[8 * ks + 1]); w.y = cvtpk(acc[8 * ks + 2], acc[8 * ks + 3]); w.z = cvtpk(acc[8 * ks + 4], acc[8 * ks + 5]); w.w = cvtpk(acc[8 * ks + 6], acc[8 * ks + 7]); pf[ks] = __builtin_bit_cast(bf16x8, w); }
#pragma unroll
        for (int dt = 0; dt < 2; ++dt)
#pragma unroll
            for (int ks = 0; ks < 2; ++ks) { v4u a; a.x = va[dt][ks][0].x; a.y = va[dt][ks][0].y; a.z = va[dt][ks][1].x; a.w = va[dt][ks][1].y; o[dt] = MFMA32(__builtin_bit_cast(bf16x8, a), pf[ks], o[dt]); }
#pragma unroll
        for (int kk = 0; kk < 6; ++kk) kf[kk] = kn[kk];
#pragma unroll
        for (int dt = 0; dt < 2; ++dt)
#pragma unroll
            for (int ks = 0; ks < 2; ++ks) { va[dt][ks][0] = vn[dt][ks][0]; va[dt][ks][1] = vn[dt][ks][1]; }
    }
#undef ML_LOAD
    lsum += __shfl_xor(lsum, 32);
    store_OT(o, 1.0f / lsum, stg, ymix + (rowb + q0) * DM + 512 + h * 64, lane);
}


constexpr int MLK_PITCH = 104, MLV_PITCH = 68, MLK_BYTES = 64 * MLK_PITCH * 2, MLV_BYTES = 64 * MLV_PITCH * 2, ML_STAGE = MLK_BYTES + MLV_BYTES;
__device__ __forceinline__ void mla_block(int bh, int sb, int tid, int lane, int wave, LAS unsigned char* lds, const bf16_t* __restrict__ QM, const bf16_t* __restrict__ KVM, const bf16_t* __restrict__ KPE,
                                          const bf16_t* __restrict__ VT, bf16_t* __restrict__ ymix) {
    const int b = bh >> 3, h = bh & 7, l31 = lane & 31, hi = lane >> 5, q0 = 256 * sb + 32 * wave, t = q0 + l31;
    const size_t rowb = (size_t)b * SEQ;
    const int nsteps = 4 * sb + 4;
    bf16x8 qf[6];
    { const bf16_t* Qp = QM + (rowb + q0 + l31) * 768 + h * 96 + 8 * hi;
#pragma unroll
      for (int kk = 0; kk < 6; ++kk) qf[kk] = *(const bf16x8*)(Qp + 16 * kk); }
    const float sc2 = 0.10206207261596577f * 1.4426950408889634f;
    f32x16 o[2];
#pragma unroll
    for (int r = 0; r < 16; ++r) { o[0][r] = 0.f; o[1][r] = 0.f; }
    float mrun = -1e30f, lsum = 0.f;
    const bf16_t* gKn = KVM + (rowb + (tid >> 3)) * 1024 + h * 128 + (tid & 7) * 8;
    const bf16_t* gKr = KPE + (rowb + ((tid & 255) >> 2)) * 32 + (tid & 3) * 8;
    const bf16_t* gVt = VT + ((size_t)bh * 64 + (tid >> 3)) * SEQ + (tid & 7) * 8;
    const int lKn = (tid >> 3) * (MLK_PITCH * 2) + (tid & 7) * 16, lKr = ((tid & 255) >> 2) * (MLK_PITCH * 2) + 128 + (tid & 3) * 16, lVt = MLK_BYTES + (tid >> 3) * (MLV_PITCH * 2) + (tid & 7) * 16;
    v4u rk, rr, rv;
    rk = *(const v4u*)gKn; rr = *(const v4u*)gKr; rv = *(const v4u*)gVt;
    *(LAS v4u*)(lds + lKn) = rk; if (tid < 256) *(LAS v4u*)(lds + lKr) = rr; *(LAS u32x2*)(lds + lVt) = (u32x2){rv.x, rv.y}; *(LAS u32x2*)(lds + lVt + 8) = (u32x2){rv.z, rv.w};
    __syncthreads();
#pragma unroll 1
    for (int step = 0; step < nsteps; ++step) {
        const int nx = (step + 1 < nsteps) ? step + 1 : step;
        rk = *(const v4u*)(gKn + (size_t)nx * 64 * 1024); rr = *(const v4u*)(gKr + (size_t)nx * 64 * 32); rv = *(const v4u*)(gVt + nx * 64);
        const LAS unsigned char* Kb = lds + (step & 1) * ML_STAGE;
        const LAS unsigned char* Vb = Kb + MLK_BYTES;
#pragma unroll
        for (int sub = 0; sub < 2; ++sub) {
            const int s0 = 64 * step + 32 * sub;
            if (s0 <= q0) {
                f32x16 acc;
#pragma unroll
                for (int r = 0; r < 16; ++r) acc[r] = 0.f;
#pragma unroll
                for (int kk = 0; kk < 6; ++kk) { const bf16x8 kf = *(const LAS bf16x8*)(Kb + (32 * sub + l31) * (MLK_PITCH * 2) + (16 * kk + 8 * hi) * 2); acc = MFMA32(kf, qf[kk], acc); }
                const bool diag = (s0 == q0);
                float tmax = -1e30f;
#pragma unroll
                for (int r = 0; r < 16; ++r) { float z = acc[r] * sc2; if (diag && (s0 + crow(r, hi)) > t) z = -1e30f; acc[r] = z; tmax = fmaxf(tmax, z); }
                tmax = fmaxf(tmax, __shfl_xor(tmax, 32));
                const float mn = fmaxf(mrun, tmax), alpha = __builtin_amdgcn_exp2f(mrun - mn); mrun = mn;
                float ps = 0.f;
#pragma unroll
                for (int r = 0; r < 16; ++r) { acc[r] = __builtin_amdgcn_exp2f(acc[r] - mn); ps += acc[r]; }
                lsum = lsum * alpha + ps;
#pragma unroll
                for (int r = 0; r < 16; ++r) { o[0][r] *= alpha; o[1][r] *= alpha; }
                bf16x8 pf[2];
#pragma unroll
                for (int ks = 0; ks < 2; ++ks) { v4u w; w.x = cvtpk(acc[8 * ks], acc[8 * ks + 1]); w.y = cvtpk(acc[8 * ks + 2], acc[8 * ks + 3]); w.z = cvtpk(acc[8 * ks + 4], acc[8 * ks + 5]); w.w = cvtpk(acc[8 * ks + 6], acc[8 * ks + 7]); pf[ks] = __builtin_bit_cast(bf16x8, w); }
#pragma unroll
                for (int dt = 0; dt < 2; ++dt)
#pragma unroll
                    for (int ks = 0; ks < 2; ++ks) { const LAS unsigned char* vp = Vb + (32 * dt + l31) * (MLV_PITCH * 2) + (32 * sub + 16 * ks + 4 * hi) * 2;
                        const u32x2 x0 = *(const LAS u32x2*)vp, x1 = *(const LAS u32x2*)(vp + 16);
                        v4u a; a.x = x0.x; a.y = x0.y; a.z = x1.x; a.w = x1.y; o[dt] = MFMA32(__builtin_bit_cast(bf16x8, a), pf[ks], o[dt]); }
            }
        }
        LAS unsigned char* nb = lds + ((step + 1) & 1) * ML_STAGE;
        *(LAS v4u*)(nb + lKn) = rk; if (tid < 256) *(LAS v4u*)(nb + lKr) = rr; *(LAS u32x2*)(nb + lVt) = (u32x2){rv.x, rv.y}; *(LAS u32x2*)(nb + lVt + 8) = (u32x2){rv.z, rv.w};
        __syncthreads();
    }
    lsum += __shfl_xor(lsum, 32);
    store_OT(o, 1.0f / lsum, (LAS bf16_t*)(lds + 2 * ML_STAGE) + wave * (32 * STG_PITCH), ymix + (rowb + q0) * DM + 512 + h * 64, lane);
    __syncthreads();
}


constexpr int SBK_PITCH = 72, SBK_BYTES = 64 * SBK_PITCH * 2, SB_STAGE = SBK_BYTES + MLV_BYTES;
__device__ __forceinline__ void sb_block(int bh, int sb, int tid, int lane, int wave, LAS unsigned char* lds, const bf16_t* __restrict__ P1, const bf16_t* __restrict__ VT, bf16_t* __restrict__ ymix) {
    const int b = bh >> 3, h = bh & 7, l31 = lane & 31, hi = lane >> 5, q0 = 256 * sb + 32 * wave, t = q0 + l31;
    const size_t rowb = (size_t)b * SEQ;
    bf16x8 qf[4];
    { const bf16_t* Qp = P1 + (rowb + q0 + l31) * L1P + h * 64 + 8 * hi;
#pragma unroll
      for (int kk = 0; kk < 4; ++kk) qf[kk] = *(const bf16x8*)(Qp + 16 * kk); }
    f32x16 o[2];
#pragma unroll
    for (int r = 0; r < 16; ++r) { o[0][r] = 0.f; o[1][r] = 0.f; }
    float cum = 0.f; bool done = false;
    volatile LAS unsigned* flags = (volatile LAS unsigned*)(lds + 2 * SB_STAGE);
    const bf16_t* gK = P1 + (rowb + (tid >> 3)) * L1P + 512 + h * 64 + (tid & 7) * 8;
    const bf16_t* gVt = VT + ((size_t)bh * 64 + (tid >> 3)) * SEQ + (tid & 7) * 8;
    const int lK = (tid >> 3) * (SBK_PITCH * 2) + (tid & 7) * 16, lVt = SBK_BYTES + (tid >> 3) * (MLV_PITCH * 2) + (tid & 7) * 16;
    const int top = 4 * sb + 3;
    v4u rk, rv;
    rk = *(const v4u*)(gK + (size_t)top * 64 * L1P); rv = *(const v4u*)(gVt + top * 64);
    *(LAS v4u*)(lds + lK) = rk; *(LAS u32x2*)(lds + lVt) = (u32x2){rv.x, rv.y}; *(LAS u32x2*)(lds + lVt + 8) = (u32x2){rv.z, rv.w};
    __syncthreads();
#pragma unroll 1
    for (int i = 0; i <= top; ++i) {
        const int step = top - i, nx = (step > 0) ? step - 1 : 0;
        rk = *(const v4u*)(gK + (size_t)nx * 64 * L1P); rv = *(const v4u*)(gVt + nx * 64);
        const LAS unsigned char* Kb = lds + (i & 1) * SB_STAGE;
        const LAS unsigned char* Vb = Kb + SBK_BYTES;
#pragma unroll
        for (int sub = 1; sub >= 0; --sub) {
            const int s0 = 64 * step + 32 * sub;
            if (s0 <= q0 && !done) {
                f32x16 acc;
#pragma unroll
                for (int r = 0; r < 16; ++r) acc[r] = 0.f;
#pragma unroll
                for (int kk = 0; kk < 4; ++kk) { const bf16x8 kf = *(const LAS bf16x8*)(Kb + (32 * sub + l31) * (SBK_PITCH * 2) + (16 * kk + 8 * hi) * 2); acc = MFMA32(kf, qf[kk], acc); }
                const bool diag = (s0 == q0);
                float lb[16], lk[16];
#pragma unroll
                for (int r = 0; r < 16; ++r) { const float z = acc[r] * 0.125f; const float sp = softplus_fast(z); float b_ = z - sp, k_ = -sp;
                    if (diag) { const bool valid = (s0 + crow(r, hi)) < t; b_ = valid ? b_ : -1e30f; k_ = valid ? k_ : 0.f; }
                    lb[r] = b_; lk[r] = k_; }
                float e[16], T[4], U[4];
#pragma unroll
                for (int q = 0; q < 4; ++q) { e[4 * q + 3] = 0.f; e[4 * q + 2] = lk[4 * q + 3]; e[4 * q + 1] = e[4 * q + 2] + lk[4 * q + 2]; e[4 * q] = e[4 * q + 1] + lk[4 * q + 1]; T[q] = e[4 * q] + lk[4 * q]; }
#pragma unroll
                for (int q = 0; q < 4; ++q) U[q] = __shfl_xor(T[q], 32);
                { const float st2 = T[3], st1 = st2 + T[2], st0 = st1 + T[1]; const float su2 = U[3], su1 = su2 + U[2], su0 = su1 + U[1];
                  const float x0 = hi ? 0.f : U[0], x1 = hi ? 0.f : U[1], x2 = hi ? 0.f : U[2], x3 = hi ? 0.f : U[3];
                  const float off[4] = {st0 + su0 + x0, st1 + su1 + x1, st2 + su2 + x2, x3};
                  const float total = st0 + T[0] + su0 + U[0];
#pragma unroll
                  for (int r = 0; r < 16; ++r) acc[r] = __expf(lb[r] + (cum + off[r >> 2] + e[r]));
                  cum += total; }
                bf16x8 pf[2];
#pragma unroll
                for (int ks = 0; ks < 2; ++ks) { v4u w; w.x = cvtpk(acc[8 * ks], acc[8 * ks + 1]); w.y = cvtpk(acc[8 * ks + 2], acc[8 * ks + 3]); w.z = cvtpk(acc[8 * ks + 4], acc[8 * ks + 5]); w.w = cvtpk(acc[8 * ks + 6], acc[8 * ks + 7]); pf[ks] = __builtin_bit_cast(bf16x8, w); }
#pragma unroll
                for (int dt = 0; dt < 2; ++dt)
#pragma unroll
                    for (int ks = 0; ks < 2; ++ks) { const LAS unsigned char* vp = Vb + (32 * dt + l31) * (MLV_PITCH * 2) + (32 * sub + 16 * ks + 4 * hi) * 2;
                        const u32x2 x0 = *(const LAS u32x2*)vp, x1 = *(const LAS u32x2*)(vp + 16);
                        v4u a; a.x = x0.x; a.y = x0.y; a.z = x1.x; a.w = x1.y; o[dt] = MFMA32(__builtin_bit_cast(bf16x8, a), pf[ks], o[dt]); }
                done = __all(cum < -110.f);
            }
        }
        if (lane == 0) flags[(i & 1) * 8 + wave] = done ? 1u : 0u;
        LAS unsigned char* nb = lds + ((i + 1) & 1) * SB_STAGE;
        *(LAS v4u*)(nb + lK) = rk; *(LAS u32x2*)(nb + lVt) = (u32x2){rv.x, rv.y}; *(LAS u32x2*)(nb + lVt + 8) = (u32x2){rv.z, rv.w};
        __syncthreads();
        unsigned nd = 0;
#pragma unroll
        for (int w8 = 0; w8 < 8; ++w8) nd += flags[(i & 1) * 8 + w8];
        if (nd == 8u) break;
    }
    store_OT(o, 1.0f, (LAS bf16_t*)(lds + 2 * SB_STAGE + 256) + wave * (32 * STG_PITCH), ymix + (rowb + q0) * DM + h * 64, lane);
    __syncthreads();
}

constexpr int RW_RAWW = 0, RW_RAWA = 2048, RW_RS = 4096, RW_KS = 6144, RW_VS = 8192;
constexpr int RW_CH0 = 10240, RW_CHSZ = 11328;
constexpr int RW_YB = RW_CH0 + 2 * RW_CHSZ;
constexpr int RW_MIX = RW_YB + 1024;
static_assert((RW_MIX + 256) * 4 <= 146432, "rwkv LDS map");
template <int CTRL> __device__ __forceinline__ float dpp_mov(float x) { return __builtin_bit_cast(float, __builtin_amdgcn_update_dpp(0, __builtin_bit_cast(int, x), CTRL, 0xF, 0xF, true)); }
__device__ __forceinline__ float rowsum16(float x) { x += dpp_mov<0x128>(x); x += dpp_mov<0x124>(x); x += dpp_mov<0x122>(x); x += dpp_mov<0x121>(x); return x; }
__device__ __forceinline__ float rl(float x, int l) { return __builtin_bit_cast(float, __builtin_amdgcn_readlane(__builtin_bit_cast(int, x), l)); }
__device__ __forceinline__ float wave_sum_dpp(float x) { x = rowsum16(x); return (rl(x, 0) + rl(x, 16)) + (rl(x, 32) + rl(x, 48)); }
__device__ __forceinline__ float tanh_fast(float x) { return 1.f - 2.f / (1.f + __expf(2.f * x)); }
__device__ __forceinline__ float sigmoid_fast(float x) { return 1.f / (1.f + __expf(-x)); }

#define MFMA16(a, b, c) __builtin_amdgcn_mfma_f32_16x16x32_bf16((a), (b), (c), 0, 0, 0)
constexpr int RW2_CH0 = 0, RW2_YB = 2 * RW_CHSZ, RW2_MIX = RW2_YB + 1024, RW2_STG = RW2_MIX + 448;
static_assert((RW2_STG + 2 * 3072) * 4 <= 146432, "rwkv LDS map");
__device__ __forceinline__ void rwkv_phase(LAS float* sm, int tid, int lane, int wave, int blk, const bf16_t* __restrict__ proj, const float* __restrict__ mix, const float* __restrict__ w0, const float* __restrict__ a0,
                                           const float* __restrict__ k_k, const float* __restrict__ k_a, const float* __restrict__ r_k, const bf16_t* __restrict__ W2T, const bf16_t* __restrict__ A2T, const bf16_t* __restrict__ G2T,
                                           float* __restrict__ yraw, bf16_t* __restrict__ gout, float* __restrict__ bonus_out) {
    const int chain = blk >> 1, half = blk & 1, b = chain >> 3, h = chain & 7, l15 = lane & 15, kg = lane >> 4;
    const size_t rowb = (size_t)b * SEQ;
    constexpr int NCHUNK = SEQ / 32;
    if (tid < 256) sm[RW2_MIX + tid] = mix[1536 + tid];
    else if (tid < 448) { const int q = tid - 256; sm[RW2_MIX + tid] = mix[512 * (q >> 6) + h * 64 + (q & 63)]; }
    __syncthreads();
#define RW_SH8(CUR, PRV, M0, M1, OUT, PZ) do { const unsigned cu_[4] = {(CUR).x, (CUR).y, (CUR).z, (CUR).w}, pu_[4] = {(PRV).x, (PRV).y, (PRV).z, (PRV).w}; \
        const float mm_[8] = {(M0)[0], (M0)[1], (M0)[2], (M0)[3], (M1)[0], (M1)[1], (M1)[2], (M1)[3]}; \
        _Pragma("unroll") for (int q = 0; q < 4; ++q) { const float c0 = bflo(cu_[q]), c1 = bfhi(cu_[q]), p0 = bflo(pu_[q]) * (PZ), p1 = bfhi(pu_[q]) * (PZ); \
            OUT[2 * q] = c0 + (p0 - c0) * mm_[2 * q]; OUT[2 * q + 1] = c1 + (p1 - c1) * mm_[2 * q + 1]; } } while (0)
    if (wave < 4) {
        const int iA = 8 * wave + kg, iB = iA + 4, jseg = l15;
        float A0 = 0.f, A1 = 0.f, A2 = 0.f, A3 = 0.f, B0 = 0.f, B1 = 0.f, B2 = 0.f, B3 = 0.f;
        __syncthreads();
#pragma unroll 1
        for (int ch = 0; ch < NCHUNK; ++ch) {
            const int t0 = ch * 32;
            const LAS float* CHb = sm + RW2_CH0 + (ch & 1) * RW_CHSZ + 4 * jseg;
            const LAS float* CHv = sm + RW2_CH0 + (ch & 1) * RW_CHSZ + 10240 + iA;
            const LAS float* CHs = sm + RW2_CH0 + (ch & 1) * RW_CHSZ + 11264;
            f32x4 a4 = *(const LAS f32x4*)(CHb + 4096), wr4 = *(const LAS f32x4*)(CHb + 8192), w4 = *(const LAS f32x4*)(CHb), b4 = *(const LAS f32x4*)(CHb + 6144), k4 = *(const LAS f32x4*)(CHb + 2048);
            float vA = CHv[0], vB = CHv[4]; f32x2_t sc = *(const LAS f32x2_t*)(CHs);
#pragma unroll 2
            for (int t = 0; t < 32; ++t) {
                const int tq = (t + 1) & 31;
                const f32x4 a4n = *(const LAS f32x4*)(CHb + 4096 + tq * 64), wr4n = *(const LAS f32x4*)(CHb + 8192 + tq * 64), w4n = *(const LAS f32x4*)(CHb + tq * 64),
                            b4n = *(const LAS f32x4*)(CHb + 6144 + tq * 64), k4n = *(const LAS f32x4*)(CHb + 2048 + tq * 64);
                const float vAn = CHv[tq * 32], vBn = CHv[tq * 32 + 4]; const f32x2_t scn = *(const LAS f32x2_t*)(CHs + 2 * tq);
                float d1A = (A0 * a4[0] + A1 * a4[1]) + (A2 * a4[2] + A3 * a4[3]), d1B = (B0 * a4[0] + B1 * a4[1]) + (B2 * a4[2] + B3 * a4[3]);
                float d2A = (A0 * wr4[0] + A1 * wr4[1]) + (A2 * wr4[2] + A3 * wr4[3]), d2B = (B0 * wr4[0] + B1 * wr4[1]) + (B2 * wr4[2] + B3 * wr4[3]);
                d1A = rowsum16(d1A); d1B = rowsum16(d1B); d2A = rowsum16(d2A); d2B = rowsum16(d2B);
                const float yA = d2A + d1A * sc[0] + vA * sc[1], yB = d2B + d1B * sc[0] + vB * sc[1];
                A0 = A0 * w4[0] + (d1A * b4[0] + vA * k4[0]); A1 = A1 * w4[1] + (d1A * b4[1] + vA * k4[1]); A2 = A2 * w4[2] + (d1A * b4[2] + vA * k4[2]); A3 = A3 * w4[3] + (d1A * b4[3] + vA * k4[3]);
                B0 = B0 * w4[0] + (d1B * b4[0] + vB * k4[0]); B1 = B1 * w4[1] + (d1B * b4[1] + vB * k4[1]); B2 = B2 * w4[2] + (d1B * b4[2] + vB * k4[2]); B3 = B3 * w4[3] + (d1B * b4[3] + vB * k4[3]);
                if (jseg == 0) { sm[RW2_YB + t * 32 + iA] = yA; sm[RW2_YB + t * 32 + iB] = yB; }
                a4 = a4n; wr4 = wr4n; w4 = w4n; b4 = b4n; k4 = k4n; vA = vAn; vB = vBn; sc = scn;
            }
            WSYNC();
            { const int tt = lane >> 1, hh = lane & 1; const f32x4 yv = *(const LAS f32x4*)(sm + RW2_YB + tt * 32 + 8 * wave + 4 * hh);
              *(f32x4*)(yraw + (rowb + t0 + tt) * 512 + h * 64 + half * 32 + 8 * wave + 4 * hh) = yv; }
            __syncthreads();
        }
    } else if (wave < 6) {
        const int tp = wave - 4, tb = 16 * tp;
        LAS float* stg = sm + RW2_STG + tp * 3072;
        float w0c[4], a0c[4], kkc[4], kac[4], rkc[4];
#pragma unroll
        for (int nt = 0; nt < 4; ++nt) { const int c = h * 64 + 16 * nt + l15; w0c[nt] = w0[c]; a0c[nt] = a0[c]; kkc[nt] = k_k[c]; kac[nt] = k_a[c]; rkc[nt] = r_k[c]; }
        v4u ld[20];
#define PREP_ISSUE(T0) do { const int t0_ = (T0); { const size_t r_ = rowb + t0_ + tb + l15; const size_t rp_ = (t0_ + tb + l15 == 0) ? r_ : r_ - 1; \
            _Pragma("unroll") for (int lo = 0; lo < 2; ++lo) _Pragma("unroll") for (int ks = 0; ks < 2; ++ks) { const int col = 1536 + 64 * lo + 32 * ks + 8 * kg; \
                ld[(lo * 2 + ks) * 2] = *(const v4u*)(proj + r_ * L0P + col); ld[(lo * 2 + ks) * 2 + 1] = *(const v4u*)(proj + rp_ * L0P + col); } } \
            _Pragma("unroll") for (int ar = 0; ar < 3; ++ar) _Pragma("unroll") for (int i = 0; i < 2; ++i) { const int p_ = lane + 64 * i, row_ = p_ >> 3, c8_ = p_ & 7; \
                const size_t r_ = rowb + t0_ + tb + row_; const size_t rp_ = (t0_ + tb + row_ == 0) ? r_ : r_ - 1; const int col = 512 * ar + h * 64 + 8 * c8_; \
                ld[8 + (ar * 2 + i) * 2] = *(const v4u*)(proj + r_ * L0P + col); ld[8 + (ar * 2 + i) * 2 + 1] = *(const v4u*)(proj + rp_ * L0P + col); } } while (0)
#define PREP_BUILD(T0, NB) do { const int t0_ = (T0); LAS float* CHn = sm + RW2_CH0 + (NB) * RW_CHSZ; \
            f32x4 accw[4], acca[4]; \
            _Pragma("unroll") for (int nt = 0; nt < 4; ++nt) { accw[nt] = (f32x4){0.f, 0.f, 0.f, 0.f}; acca[nt] = (f32x4){0.f, 0.f, 0.f, 0.f}; } \
            { const float pz_ = (t0_ + tb + l15 == 0) ? 0.f : 1.f; \
              _Pragma("unroll") for (int lo = 0; lo < 2; ++lo) _Pragma("unroll") for (int ks = 0; ks < 2; ++ks) { float s_[8]; \
                const f32x4 m0 = *(const LAS f32x4*)(sm + RW2_MIX + 64 * lo + 32 * ks + 8 * kg), m1 = *(const LAS f32x4*)(sm + RW2_MIX + 64 * lo + 32 * ks + 8 * kg + 4); \
                RW_SH8(ld[(lo * 2 + ks) * 2], ld[(lo * 2 + ks) * 2 + 1], m0, m1, s_, pz_); \
                if (lo == 0) { _Pragma("unroll") for (int j = 0; j < 8; ++j) s_[j] = tanh_fast(s_[j]); } \
                v4u aw; aw.x = cvtpk(s_[0], s_[1]); aw.y = cvtpk(s_[2], s_[3]); aw.z = cvtpk(s_[4], s_[5]); aw.w = cvtpk(s_[6], s_[7]); const bf16x8 af = __builtin_bit_cast(bf16x8, aw); \
                const bf16_t* WT = lo ? A2T : W2T; \
                _Pragma("unroll") for (int nt = 0; nt < 4; ++nt) { const bf16x8 bfr = *(const bf16x8*)(WT + (size_t)(h * 64 + 16 * nt + l15) * 64 + 32 * ks + 8 * kg); \
                    if (lo == 0) accw[nt] = MFMA16(af, bfr, accw[nt]); else acca[nt] = MFMA16(af, bfr, acca[nt]); } } } \
            _Pragma("unroll") for (int ar = 0; ar < 3; ++ar) _Pragma("unroll") for (int i = 0; i < 2; ++i) { const int p_ = lane + 64 * i, row_ = p_ >> 3, c8_ = p_ & 7; float s_[8]; \
                const float pz_ = (t0_ + tb + row_ == 0) ? 0.f : 1.f; const f32x4 m0 = *(const LAS f32x4*)(sm + RW2_MIX + 256 + ar * 64 + c8_ * 8), m1 = *(const LAS f32x4*)(sm + RW2_MIX + 256 + ar * 64 + c8_ * 8 + 4); \
                RW_SH8(ld[8 + (ar * 2 + i) * 2], ld[8 + (ar * 2 + i) * 2 + 1], m0, m1, s_, pz_); \
                *(LAS f32x4*)(stg + ar * 1024 + row_ * 64 + c8_ * 8) = (f32x4){s_[0], s_[1], s_[2], s_[3]}; *(LAS f32x4*)(stg + ar * 1024 + row_ * 64 + c8_ * 8 + 4) = (f32x4){s_[4], s_[5], s_[6], s_[7]}; } \
            WSYNC(); \
            PREP_ISSUE(((T0) + 32 < SEQ) ? (T0) + 32 : (T0)); \
            _Pragma("unroll") for (int rg = 0; rg < 4; ++rg) { const int tl = 4 * kg + rg, t = tb + tl; \
                float r_[4], k_[4], v_[4], kkv[4], nrm2 = 0.f; \
                _Pragma("unroll") for (int nt = 0; nt < 4; ++nt) { r_[nt] = stg[tl * 64 + 16 * nt + l15]; k_[nt] = stg[1024 + tl * 64 + 16 * nt + l15]; v_[nt] = stg[2048 + tl * 64 + 16 * nt + l15]; \
                    kkv[nt] = k_[nt] * kkc[nt]; nrm2 += kkv[nt] * kkv[nt]; } \
                nrm2 = rowsum16(nrm2); const float rn = __builtin_amdgcn_rsqf(fmaxf(nrm2, 1e-24f)); \
                float br = 0.f, kr = 0.f, bon = 0.f; \
                _Pragma("unroll") for (int nt = 0; nt < 4; ++nt) { const int j = 16 * nt + l15; \
                    const float wsum = w0c[nt] + accw[nt][rg]; const float logw = -softplus_fast(-wsum) - 0.5f; const float dec = __expf(-__expf(logw)); \
                    const float a_ = sigmoid_fast(a0c[nt] + acca[nt][rg]); const float kn = kkv[nt] * rn; \
                    const float k2 = k_[nt] * (1.f + (a_ - 1.f) * kac[nt]); const float bv = kn * a_; \
                    br += bv * r_[nt]; kr += k2 * r_[nt]; bon += r_[nt] * k2 * rkc[nt]; \
                    CHn[t * 64 + j] = dec; CHn[2048 + t * 64 + j] = k2; CHn[4096 + t * 64 + j] = -kn; CHn[6144 + t * 64 + j] = bv; CHn[8192 + t * 64 + j] = dec * r_[nt]; \
                    if ((nt >> 1) == half) CHn[10240 + t * 32 + (j & 31)] = v_[nt]; } \
                br = rowsum16(br); kr = rowsum16(kr); bon = rowsum16(bon); \
                if (l15 == 0) { CHn[11264 + 2 * t] = br; CHn[11264 + 2 * t + 1] = kr; if (half == 0) bonus_out[(rowb + t0_ + t) * 8 + h] = bon; } } \
            WSYNC(); } while (0)
        PREP_ISSUE(0);
        PREP_BUILD(0, 0);
        __syncthreads();
#pragma unroll 1
        for (int ch = 0; ch < NCHUNK; ++ch) {
            if (ch + 1 < NCHUNK) PREP_BUILD(ch * 32 + 32, (ch + 1) & 1);
            __syncthreads();
        }
#undef PREP_ISSUE
#undef PREP_BUILD
    } else {
        const int tp = wave - 6, tb = 16 * tp;
        v4u ld[8];
#define G_ISSUE(T0) do { const int t0_ = (T0); const size_t r_ = rowb + t0_ + tb + l15; const size_t rp_ = (t0_ + tb + l15 == 0) ? r_ : r_ - 1; \
            _Pragma("unroll") for (int ks = 0; ks < 4; ++ks) { const int col = 1664 + 32 * ks + 8 * kg; ld[2 * ks] = *(const v4u*)(proj + r_ * L0P + col); ld[2 * ks + 1] = *(const v4u*)(proj + rp_ * L0P + col); } } while (0)
#define G_BUILD(T0) do { const int t0_ = (T0); f32x4 accg[2] = {(f32x4){0.f, 0.f, 0.f, 0.f}, (f32x4){0.f, 0.f, 0.f, 0.f}}; const float pz_ = (t0_ + tb + l15 == 0) ? 0.f : 1.f; \
            _Pragma("unroll") for (int ks = 0; ks < 4; ++ks) { float s_[8]; \
                const f32x4 m0 = *(const LAS f32x4*)(sm + RW2_MIX + 128 + 32 * ks + 8 * kg), m1 = *(const LAS f32x4*)(sm + RW2_MIX + 128 + 32 * ks + 8 * kg + 4); \
                RW_SH8(ld[2 * ks], ld[2 * ks + 1], m0, m1, s_, pz_); \
                _Pragma("unroll") for (int j = 0; j < 8; ++j) s_[j] = sigmoid_fast(s_[j]); \
                v4u aw; aw.x = cvtpk(s_[0], s_[1]); aw.y = cvtpk(s_[2], s_[3]); aw.z = cvtpk(s_[4], s_[5]); aw.w = cvtpk(s_[6], s_[7]); const bf16x8 af = __builtin_bit_cast(bf16x8, aw); \
                _Pragma("unroll") for (int nt = 0; nt < 2; ++nt) { const bf16x8 bfr = *(const bf16x8*)(G2T + (size_t)(h * 64 + half * 32 + 16 * nt + l15) * 128 + 32 * ks + 8 * kg); accg[nt] = MFMA16(af, bfr, accg[nt]); } } \
            G_ISSUE(((T0) + 32 < SEQ) ? (T0) + 32 : (T0)); \
            _Pragma("unroll") for (int nt = 0; nt < 2; ++nt) _Pragma("unroll") for (int rg = 0; rg < 4; ++rg) \
                gout[(rowb + t0_ + tb + 4 * kg + rg) * 512 + h * 64 + half * 32 + 16 * nt + l15] = (bf16_t)f2bf(accg[nt][rg]); } while (0)
        G_ISSUE(0);
        G_BUILD(0);
        __syncthreads();
#pragma unroll 1
        for (int ch = 0; ch < NCHUNK; ++ch) {
            if (ch + 1 < NCHUNK) G_BUILD(ch * 32 + 32);
            __syncthreads();
        }
#undef G_ISSUE
#undef G_BUILD
    }
#undef RW_SH8
    __syncthreads();
}
template <bool ST = true> __device__ __forceinline__ void rwkv_post_all(const float* __restrict__ yraw, const bf16_t* __restrict__ proj, const float* __restrict__ mix, const float* __restrict__ bonus, const bf16_t* __restrict__ gbuf,
                                              const float* __restrict__ ln_g, const float* __restrict__ ln_b, bf16_t* __restrict__ ymix, int gw, int NGW, int lane) {
    for (int m = gw; m < M; m += NGW) {
        const bool has_prev = (m & (SEQ - 1)) != 0;
        float y[8], cv[8], pv[8], gg[8], bo[8];
#pragma unroll
        for (int h = 0; h < 8; ++h) { const int c = h * 64 + lane; y[h] = yraw[(size_t)m * 512 + c]; cv[h] = bf2f(proj[(size_t)m * L0P + 1024 + c]);
            pv[h] = bf2f(proj[(size_t)(has_prev ? m - 1 : m) * L0P + 1024 + c]); gg[h] = bf2f(gbuf[(size_t)m * 512 + c]); bo[h] = bonus[(size_t)m * 8 + h]; }
#pragma unroll
        for (int h = 0; h < 8; ++h) { const int c = h * 64 + lane;
            const float mu = wave_sum_dpp(y[h]) * (1.f / 64.f), d = y[h] - mu, var = wave_sum_dpp(d * d) * (1.f / 64.f);
            const float yn = d * __builtin_amdgcn_rsqf(var + 64e-5f) * ln_g[c] + ln_b[c];
            const float pvv = has_prev ? pv[h] : 0.f;
            const float v_s = cv[h] + (pvv - cv[h]) * mix[1024 + c];
            const float o = (yn + bo[h] * v_s) * gg[h];
            if (ST) ymix[(size_t)m * DM + c] = (bf16_t)f2bf(o); else asm volatile("" :: "v"(o)); }
    }
}


__device__ __forceinline__ void ssd_conv_tile(int it, int lane, LAS bf16_t* scr, const bf16_t* __restrict__ proj, const float* __restrict__ cw, const float* __restrict__ cb,
                                              bf16_t* __restrict__ xbc, bf16_t* __restrict__ xst, bf16_t* __restrict__ bt) {
    const int tt = it >> 4, ct = it & 15, m0 = tt * 64, b = m0 >> 11, t0 = m0 & (SEQ - 1), c = ct * 64 + lane;
    const float w0 = cw[c], w1 = cw[1024 + c], w2 = cw[2048 + c], w3 = cw[3072 + c], bias = cb[c];
    const bf16_t* src = proj + (size_t)m0 * L0P + 2304 + c;
    float u3 = 0.f, u2 = 0.f, u1 = 0.f;
    if (t0 > 0) { u3 = bf2f(src[-3 * L0P]); u2 = bf2f(src[-2 * L0P]); u1 = bf2f(src[-1 * L0P]); }
#pragma unroll 8
    for (int t = 0; t < 64; ++t) {
        const float u = bf2f(src[(size_t)t * L0P]);
        const float y = bias + w0 * u3 + w1 * u2 + w2 * u1 + w3 * u;
        const bf16_t o = (bf16_t)f2bf(y / (1.f + __expf(-y)));
        xbc[(size_t)(m0 + t) * 1024 + c] = o;
        scr[t * STG_PITCH + lane] = o;
        u3 = u2; u2 = u1; u1 = u;
    }
    WSYNC();
    if (ct < 12) {
        bf16_t* dst = (ct < 8) ? xst + ((size_t)(b * 8 + ct) * 64) * SEQ + t0 : bt + ((size_t)(b * 2 + ((ct - 8) >> 1)) * 128 + ((ct - 8) & 1) * 64) * SEQ + t0;
#pragma unroll
        for (int i = 0; i < 8; ++i) { const int d = i * 8 + (lane >> 3), tc = lane & 7; const LAS bf16_t* p = scr + (tc * 8) * STG_PITCH + d;
            v4u o; o.x = (unsigned)p[0] | ((unsigned)p[STG_PITCH] << 16); o.y = (unsigned)p[2 * STG_PITCH] | ((unsigned)p[3 * STG_PITCH] << 16);
            o.z = (unsigned)p[4 * STG_PITCH] | ((unsigned)p[5 * STG_PITCH] << 16); o.w = (unsigned)p[6 * STG_PITCH] | ((unsigned)p[7 * STG_PITCH] << 16);
            *(v4u*)(dst + (size_t)d * SEQ + tc * 8) = o; }
    }
    WSYNC();
}
__device__ __forceinline__ void scan128(float& x0, float& x1, int lane) {
#pragma unroll
    for (int o = 1; o < 64; o <<= 1) { const float t0 = __shfl_up(x0, o), t1 = __shfl_up(x1, o); if (lane >= o) { x0 += t0; x1 += t1; } }
    x1 += __shfl(x0, 63);
}
__device__ __forceinline__ void ssd_s1_unit(int unit, int lane, LAS float* tab, const bf16_t* __restrict__ xst, const bf16_t* __restrict__ bt, const float* __restrict__ dt, const float* __restrict__ a_log,
                                            float* __restrict__ sloc, float* __restrict__ asum) {
    const int h = unit & 7, c = (unit >> 3) & 15, b = unit >> 7, g = h >> 2, l0 = c * 128, l31 = lane & 31, hi = lane >> 5;
    const size_t m0 = (size_t)b * SEQ + l0;
    const float A = -expf(a_log[h]);
    const float d0 = dt[(m0 + lane) * 8 + h], d1 = dt[(m0 + 64 + lane) * 8 + h];
    float ac0 = d0 * A, ac1 = d1 * A;
    scan128(ac0, ac1, lane);
    const float aend = __shfl(ac1, 63);
    tab[lane] = __expf(aend - ac0) * d0; tab[64 + lane] = __expf(aend - ac1) * d1;
    if (lane == 0) asum[unit] = aend;
    WSYNC();
    f32x16 acc[2][4];
#pragma unroll
    for (int pt = 0; pt < 2; ++pt)
#pragma unroll
        for (int nt = 0; nt < 4; ++nt)
#pragma unroll
            for (int r = 0; r < 16; ++r) acc[pt][nt][r] = 0.f;
    const bf16_t* Xp = xst + ((size_t)(b * 8 + h) * 64 + l31) * SEQ + l0 + 8 * hi;
    const bf16_t* Bp = bt + ((size_t)(b * 2 + g) * 128 + l31) * SEQ + l0 + 8 * hi;
#pragma unroll 2
    for (int kk = 0; kk < 8; ++kk) {
        const f32x4 wa = *(const LAS f32x4*)(tab + 16 * kk + 8 * hi), wb = *(const LAS f32x4*)(tab + 16 * kk + 8 * hi + 4);
        bf16x8 af[2], bfr[4];
#pragma unroll
        for (int pt = 0; pt < 2; ++pt) { const v4u raw = *(const v4u*)(Xp + (size_t)pt * 32 * SEQ + 16 * kk);
            v4u w; w.x = cvtpk(bflo(raw.x) * wa[0], bfhi(raw.x) * wa[1]); w.y = cvtpk(bflo(raw.y) * wa[2], bfhi(raw.y) * wa[3]);
            w.z = cvtpk(bflo(raw.z) * wb[0], bfhi(raw.z) * wb[1]); w.w = cvtpk(bflo(raw.w) * wb[2], bfhi(raw.w) * wb[3]); af[pt] = __builtin_bit_cast(bf16x8, w); }
#pragma unroll
        for (int nt = 0; nt < 4; ++nt) bfr[nt] = *(const bf16x8*)(Bp + (size_t)nt * 32 * SEQ + 16 * kk);
#pragma unroll
        for (int pt = 0; pt < 2; ++pt)
#pragma unroll
            for (int nt = 0; nt < 4; ++nt) acc[pt][nt] = MFMA32(af[pt], bfr[nt], acc[pt][nt]);
    }
    float* dst = sloc + (size_t)unit * 8192 + l31;
#pragma unroll
    for (int pt = 0; pt < 2; ++pt)
#pragma unroll
        for (int nt = 0; nt < 4; ++nt)
#pragma unroll
            for (int r = 0; r < 16; ++r) dst[(32 * pt + crow(r, hi)) * 128 + 32 * nt] = acc[pt][nt][r];
    WSYNC();
}
__device__ __forceinline__ void ssd_s2_all(const float* __restrict__ sloc, const float* __restrict__ asum, bf16_t* __restrict__ stb, int gtid, int NT) {
    for (int i = gtid; i < 128 * 2048; i += NT) {
        const int bh = i >> 11, e4 = i & 2047, b = bh >> 3, h = bh & 7;
        f32x4 run = {0.f, 0.f, 0.f, 0.f};
#pragma unroll 4
        for (int c = 0; c < 16; ++c) { const int unit = (b * 16 + c) * 8 + h; const f32x4 tmp = *(const f32x4*)(sloc + (size_t)unit * 8192 + e4 * 4);
            uint2 w; w.x = cvtpk(run[0], run[1]); w.y = cvtpk(run[2], run[3]); *(uint2*)(stb + (size_t)unit * 8192 + e4 * 4) = w;
            run = run * __expf(asum[unit]) + tmp; }
    }
}
__device__ __forceinline__ void ssd_s3_unit(int unit, int lane, LAS float* tab, const bf16_t* __restrict__ xbc, const bf16_t* __restrict__ xst, const bf16_t* __restrict__ stb, const float* __restrict__ dt,
                                            const float* __restrict__ a_log, const float* __restrict__ dsk, bf16_t* __restrict__ yssm) {
    const int h = unit & 7, c = (unit >> 3) & 15, b = unit >> 7, g = h >> 2, l0 = c * 128, l31 = lane & 31, hi = lane >> 5;
    const size_t m0 = (size_t)b * SEQ + l0;
    const float A = -expf(a_log[h]), D = dsk[h];
    const float d0 = dt[(m0 + lane) * 8 + h], d1 = dt[(m0 + 64 + lane) * 8 + h];
    float ac0 = d0 * A, ac1 = d1 * A;
    scan128(ac0, ac1, lane);
    tab[lane] = ac0; tab[64 + lane] = ac1; tab[128 + lane] = d0; tab[192 + lane] = d1;
    WSYNC();
    const bf16_t* Cp = xbc + (m0 + l31) * 1024 + 768 + g * 128 + 8 * hi;
    const bf16_t* Sp = stb + (size_t)unit * 8192 + l31 * 128 + 8 * hi;
    const bf16_t* Bp = xbc + (m0 + l31) * 1024 + 512 + g * 128 + 8 * hi;
    const bf16_t* Xp = xst + ((size_t)(b * 8 + h) * 64 + l31) * SEQ + l0 + 4 * hi;
    LAS float* tr = tab + 256;
    const int row = lane >> 1, p0 = (lane & 1) * 16;
#pragma unroll 1
    for (int lt = 0; lt < 4; ++lt) {
        f32x16 y[2];
#pragma unroll
        for (int r = 0; r < 16; ++r) { y[0][r] = 0.f; y[1][r] = 0.f; }
        const float acl = tab[32 * lt + l31];
#pragma unroll 4
        for (int kk = 0; kk < 8; ++kk) {
            const bf16x8 cf = *(const bf16x8*)(Cp + (size_t)lt * 32 * 1024 + 16 * kk);
            const bf16x8 s0 = *(const bf16x8*)(Sp + 16 * kk), s1 = *(const bf16x8*)(Sp + 32 * 128 + 16 * kk);
            y[0] = MFMA32(s0, cf, y[0]); y[1] = MFMA32(s1, cf, y[1]);
        }
        { const float el = __expf(acl);
#pragma unroll
          for (int r = 0; r < 16; ++r) { y[0][r] *= el; y[1][r] *= el; } }
#pragma unroll 1
        for (int st = 0; st <= lt; ++st) {
            f32x16 cbt;
#pragma unroll
            for (int r = 0; r < 16; ++r) cbt[r] = 0.f;
#pragma unroll 4
            for (int kk = 0; kk < 8; ++kk) { const bf16x8 bf_ = *(const bf16x8*)(Bp + (size_t)st * 32 * 1024 + 16 * kk), cf_ = *(const bf16x8*)(Cp + (size_t)lt * 32 * 1024 + 16 * kk); cbt = MFMA32(bf_, cf_, cbt); }
#pragma unroll
            for (int r = 0; r < 16; ++r) { const int sl = 32 * st + crow(r, hi); const float acs = tab[sl], dts = tab[128 + sl];
                float v = cbt[r] * __expf(acl - acs) * dts; if (st == lt && crow(r, hi) > l31) v = 0.f; cbt[r] = v; }
            bf16x8 pf[2];
#pragma unroll
            for (int ks = 0; ks < 2; ++ks) { v4u w; w.x = cvtpk(cbt[8 * ks], cbt[8 * ks + 1]); w.y = cvtpk(cbt[8 * ks + 2], cbt[8 * ks + 3]); w.z = cvtpk(cbt[8 * ks + 4], cbt[8 * ks + 5]); w.w = cvtpk(cbt[8 * ks + 6], cbt[8 * ks + 7]); pf[ks] = __builtin_bit_cast(bf16x8, w); }
#pragma unroll
            for (int pt = 0; pt < 2; ++pt)
#pragma unroll
                for (int ks = 0; ks < 2; ++ks) { const bf16_t* xp = Xp + (size_t)pt * 32 * SEQ + st * 32 + 16 * ks; const u32x2 x0 = *(const u32x2*)xp, x1 = *(const u32x2*)(xp + 8);
                    v4u a; a.x = x0.x; a.y = x0.y; a.z = x1.x; a.w = x1.y; y[pt] = MFMA32(__builtin_bit_cast(bf16x8, a), pf[ks], y[pt]); }
        }
#pragma unroll
        for (int pt = 0; pt < 2; ++pt) {
#pragma unroll
            for (int r = 0; r < 16; ++r) tr[l31 * 33 + crow(r, hi)] = y[pt][r];
            WSYNC();
            const size_t m = m0 + 32 * lt + row;
            const v4u xa = *(const v4u*)(xbc + m * 1024 + h * 64 + 32 * pt + p0), xb = *(const v4u*)(xbc + m * 1024 + h * 64 + 32 * pt + p0 + 8);
            const unsigned xu[8] = {xa.x, xa.y, xa.z, xa.w, xb.x, xb.y, xb.z, xb.w};
            unsigned ow[8];
#pragma unroll
            for (int q = 0; q < 8; ++q) { const float v0 = tr[row * 33 + p0 + 2 * q] + D * bflo(xu[q]), v1 = tr[row * 33 + p0 + 2 * q + 1] + D * bfhi(xu[q]); ow[q] = cvtpk(v0, v1); }
            bf16_t* dst = yssm + m * 512 + h * 64 + 32 * pt + p0;
            *(v4u*)dst = (v4u){ow[0], ow[1], ow[2], ow[3]}; *(v4u*)(dst + 8) = (v4u){ow[4], ow[5], ow[6], ow[7]};
            WSYNC();
        }
    }
}

struct Args { const float* in[43]; float* out; unsigned char* ws; };
#define GEMM_PHASE(EPI, Aptr, LDA, Bptr, LDB, NN, KK, ...) do { pg8::Gemm g_{(Aptr), (Bptr), M, (NN), (KK), (LDA), (LDB)}; pg8::StaticOrder S_; S_.init(M, (NN), G, (int)blockIdx.x); \
        pg8::EPI E_{__VA_ARGS__}; pg8::gemm_phase<pg8::EPI, pg8::StaticOrder, true, true>(lds3, g_, S_, E_); } while (0)

__global__ void __launch_bounds__(NWAVES * 64, 2) fwd_mega(Args args) {
    extern __shared__ __attribute__((aligned(16))) unsigned char lds[];
    LAS unsigned char* lds3 = (LAS unsigned char*)lds;
    volatile LAS unsigned* MISC = (volatile LAS unsigned*)(lds3 + MISC_OFF);
    const int G = gridDim.x, NGW = G * NWAVES, NT = G * NWAVES * 64;
#define PHASE_IDS() int tid = threadIdx.x; asm volatile("" : "+v"(tid)); const int lane = tid & 63, wave = __builtin_amdgcn_readfirstlane(tid >> 6); const int gw = blockIdx.x * NWAVES + wave, gtid = blockIdx.x * (NWAVES * 64) + tid; (void)lane; (void)gw; (void)gtid
    unsigned char* ws = args.ws;
    gu32* ctl = (gu32*)(ws + WS_CTL);
    for (int u = threadIdx.x; u < (LDS_BYTES - LDSCTL_OFF) / 4; u += NWAVES * 64) ((LAS unsigned*)(lds3 + LDSCTL_OFF))[u] = 0u;
    __syncthreads();
    XcdBarrier bar = xcd_barrier_post((unsigned*)(ctl + CW_BAR), MISC + 8);
#if defined(PROBE_STAMPS)
    int nb_ = 0;
    if (blockIdx.x == 0 && threadIdx.x == 0) MISC[16] = (unsigned)__builtin_amdgcn_s_memrealtime();
#define GRID_BAR() do { xcd_barrier(bar); ++nb_; if (blockIdx.x == 0 && threadIdx.x == 0) MISC[16 + nb_] = (unsigned)__builtin_amdgcn_s_memrealtime(); } while (0)
#else
#define GRID_BAR() xcd_barrier(bar)
#endif
#define IN(i) (args.in[i])
    float* out = args.out;
    bf16_t* W0in = (bf16_t*)(ws + WS_W0IN); bf16_t* W0out = (bf16_t*)(ws + WS_W0OUT); bf16_t* Wup0 = (bf16_t*)(ws + WS_WUP0); bf16_t* Wdn0 = (bf16_t*)(ws + WS_WDN0);
    bf16_t* W1in = (bf16_t*)(ws + WS_W1IN); bf16_t* Wuq = (bf16_t*)(ws + WS_WUQ); bf16_t* Wukv = (bf16_t*)(ws + WS_WUKV); bf16_t* W1out = (bf16_t*)(ws + WS_W1OUT);
    bf16_t* Wup1 = (bf16_t*)(ws + WS_WUP1); bf16_t* Wdn1 = (bf16_t*)(ws + WS_WDN1);
    bf16_t* XB = (bf16_t*)(ws + WS_XB); bf16_t* YMIX = (bf16_t*)(ws + WS_YMIX); bf16_t* PROJ0 = (bf16_t*)(ws + WS_BIG);
    float* YRAW = out; bf16_t* YSSM = (bf16_t*)(out + (size_t)M * 512); bf16_t* STB = (bf16_t*)(out + (size_t)M * 768); bf16_t* XST = (bf16_t*)(ws + WS_XST); bf16_t* BT = (bf16_t*)(ws + WS_BT); float* ASUM = (float*)(ws + WS_ASUM); float* SLOC = (float*)(ws + WS_SLOC); float* DT = (float*)(ws + WS_DT); bf16_t* GB = (bf16_t*)(ws + WS_G); float* BONUS = (float*)(ws + WS_BONUS);
    bf16_t* W2T = (bf16_t*)(ws + WS_W2T); bf16_t* A2T = (bf16_t*)(ws + WS_A2T); bf16_t* G2T = (bf16_t*)(ws + WS_G2T); bf16_t* GU = (bf16_t*)(ws + WS_GU);
    bf16_t* PROJ1 = (bf16_t*)(ws + WS_PROJ1); bf16_t* QM = (bf16_t*)(ws + WS_QM); bf16_t* KVM = (bf16_t*)(ws + WS_KVM); bf16_t* KPE = (bf16_t*)(ws + WS_KPE); float* RS = (float*)(ws + WS_RS); float* CSTAB = (float*)(ws + WS_CSTAB); bf16_t* VTS = (bf16_t*)(ws + WS_VTS); bf16_t* VTM = (bf16_t*)(ws + WS_VTM);
    const int* pos = (const int*)args.in[1];

    {
        PHASE_IDS();
    {
        LAS float* scr = (LAS float*)(lds3 + wave * 16384);
        transpose_matrix(IN(2), 1024, 3336, W0in, L0P, 1024, scr, gw, NGW, lane, nullptr);
        transpose_matrix(IN(20), 1024, 1024, W0out, 1024, 1024, scr, gw, NGW, lane, nullptr);
        transpose_matrix(IN(23), 1024, 5632, Wup0, 5632, 1024, scr, gw, NGW, lane, nullptr);
        transpose_matrix(IN(26), 2816, 1024, Wdn0, 1024, 2816, scr, gw, NGW, lane, nullptr);
        transpose_matrix(IN(29), 1024, 1952, W1in, L1P, 1024, scr, gw, NGW, lane, nullptr);
        transpose_matrix(IN(31), 256, 768, Wuq, 768, 256, scr, gw, NGW, lane, IN(30));
        transpose_matrix(IN(33), 128, 1024, Wukv, 1024, 256, scr, gw, NGW, lane, IN(32));
        for (int i = gtid; i < 1024 * 16; i += NT) { const int n = i >> 4, c = i & 15; *(v4u*)(Wukv + (size_t)n * 256 + 128 + c * 8) = (v4u){0u, 0u, 0u, 0u}; }
        transpose_matrix(IN(34), 1024, 1024, W1out, 1024, 1024, scr, gw, NGW, lane, nullptr);
        transpose_matrix(IN(37), 1024, 5632, Wup1, 5632, 1024, scr, gw, NGW, lane, nullptr);
        transpose_matrix(IN(40), 2816, 1024, Wdn1, 1024, 2816, scr, gw, NGW, lane, nullptr);
        transpose_matrix(IN(5), 64, 512, W2T, 512, 64, scr, gw, NGW, lane, nullptr);
        transpose_matrix(IN(7), 64, 512, A2T, 512, 64, scr, gw, NGW, lane, nullptr);
        transpose_matrix(IN(8), 128, 512, G2T, 512, 128, scr, gw, NGW, lane, nullptr);
        const float* x = IN(0);
        {
            constexpr size_t TOT4 = (size_t)M * DM / 4;
            for (size_t i = gtid; i < TOT4; i += (size_t)NT * 8) {
                f32x4 v[8];
#pragma unroll
                for (int u = 0; u < 8; ++u) v[u] = *(const f32x4*)(x + (i + (size_t)u * NT) * 4);
#pragma unroll
                for (int u = 0; u < 8; ++u) { uint2 w; w.x = cvtpk(v[u][0], v[u][1]); w.y = cvtpk(v[u][2], v[u][3]); *(uint2*)(XB + (i + (size_t)u * NT) * 4) = w; }
            }
        }
    }
    }
    GRID_BAR();
    {
        PHASE_IDS();
    GEMM_PHASE(EpiBf16S, XB, DM, W0in, 1024, L0P, 1024, PROJ0, nullptr, L0P, 0);
    }
    GRID_BAR();
    {
        PHASE_IDS();
        const int blk = (int)blockIdx.x, m0 = blk * 128;
        {   LAS bf16_t* scr = (LAS bf16_t*)(lds3 + wave * 16384);
#pragma unroll 1
            for (int k = 0; k < 4; ++k) ssd_conv_tile((2 * blk + (k & 1)) * 16 + wave + 8 * (k >> 1), lane, scr, PROJ0, IN(14), IN(15), XB, XST, BT);
            for (int i = tid; i < 1024; i += NWAVES * 64) { const int m = m0 + (i >> 3); DT[(size_t)m * 8 + (i & 7)] = softplusf_(bf2f(PROJ0[(size_t)m * L0P + 3328 + (i & 7)]) + IN(16)[i & 7]); }
        }
        __syncthreads();
        ssd_s1_unit(blk * 8 + wave, lane, (LAS float*)(lds3 + wave * 16384), XST, BT, DT, IN(17), SLOC, ASUM);
    }
    GRID_BAR();
    {
        PHASE_IDS();
        ssd_s2_all(SLOC, ASUM, STB, gtid, NT);
        rwkv_phase((LAS float*)lds3, tid, lane, wave, (int)blockIdx.x, PROJ0, IN(3), IN(4), IN(6), IN(9), IN(10), IN(11), W2T, A2T, G2T, YRAW, GB, BONUS);
    }
    GRID_BAR();
    {
        PHASE_IDS();
        const int blk = (int)blockIdx.x;
        ssd_s3_unit(blk * 8 + wave, lane, (LAS float*)(lds3 + wave * 16384), XB, XST, STB, DT, IN(17), IN(18), YSSM);
        __syncthreads();
        ssm_gate_norm_all(YSSM, PROJ0, IN(19), YMIX, blk * 256 + wave, blk * 256 + 256, lane);
        rwkv_post_all(YRAW, PROJ0, IN(3), BONUS, GB, IN(12), IN(13), YMIX, gw, NGW, lane);
    }
    GRID_BAR();
    {
        PHASE_IDS();
    GEMM_PHASE(EpiResid, YMIX, DM, W0out, 1024, 1024, 1024, IN(0), out, ALPHA, 0);
    }
    GRID_BAR();
    {
        PHASE_IDS();
    ln_rows(out, XB, IN(21), IN(22), gw, NGW, lane);
    }
    GRID_BAR();
    {
        PHASE_IDS();
    GEMM_PHASE(EpiBf16S, XB, DM, Wup0, 1024, 2 * DFF, 1024, GU, nullptr, 2 * DFF, 0);
    }
    GRID_BAR();
    {
        PHASE_IDS();
    ffn_act_all(GU, IN(24), IN(25), gtid, NT);
    }
    GRID_BAR();
    {
        PHASE_IDS();
    GEMM_PHASE(EpiResid, GU + DFF, 2 * DFF, Wdn0, DFF, 1024, DFF, out, out, ALPHA, 0);
    }
    GRID_BAR();
    {
        PHASE_IDS();
    ln_rows(out, XB, IN(27), IN(28), gw, NGW, lane);
    }
    GRID_BAR();
    {
        PHASE_IDS();
    GEMM_PHASE(EpiBf16S, XB, DM, W1in, 1024, L1P, 1024, PROJ1, nullptr, L1P, 0);
    }
    GRID_BAR();
    {
        PHASE_IDS();
    mla_prep_all(PROJ1, pos, RS, KPE, CSTAB, gw, NGW, lane);
    }
    GRID_BAR();
    {
        PHASE_IDS();
    GEMM_PHASE(EpiBf16S, PROJ1 + 1536, L1P, Wuq, 256, 768, 256, QM, RS, 768, 2);
    GEMM_PHASE(EpiBf16S, PROJ1 + 1792, L1P, Wukv, 256, 1024, 256, KVM, RS + 1, 1024, 2);
    }
    GRID_BAR();
    {
        PHASE_IDS();
    rope_q_all(QM, CSTAB, gtid, NT);
    {
        LAS bf16_t* scr = (LAS bf16_t*)(lds3 + wave * 16384);
        for (int it = gw; it < 8192; it += NGW) { const int which = it >> 12, r = it & 4095, bh = r >> 5, tt = r & 31, b = bh >> 3, h = bh & 7;
            if (which == 0) transpose_tile64(PROJ1 + ((size_t)b * SEQ + tt * 64) * L1P + 1024 + h * 64, L1P, VTS + (size_t)bh * 64 * SEQ + tt * 64, SEQ, scr, lane);
            else            transpose_tile64(KVM + ((size_t)b * SEQ + tt * 64) * 1024 + h * 128 + 64, 1024, VTM + (size_t)bh * 64 * SEQ + tt * 64, SEQ, scr, lane); }
    }
    }
    GRID_BAR();
    {
        PHASE_IDS();
    {
        for (int g2 = (int)blockIdx.x; g2 < 256; g2 += G) { const int bh = g2 >> 1, part = g2 & 1;
#pragma unroll 1
            for (int i = 0; i < 4; ++i) { const int sbk = part ? ((i == 0) ? 1 : (i == 1) ? 6 : (i == 2) ? 2 : 5) : ((i == 0) ? 0 : (i == 1) ? 7 : (i == 2) ? 3 : 4);
                sb_block(bh, sbk, tid, lane, wave, lds3, PROJ1, VTS, YMIX); } }
        for (int g2 = (int)blockIdx.x; g2 < 256; g2 += G) { const int bh = g2 >> 1, part = g2 & 1;
#pragma unroll 1
            for (int i = 0; i < 4; ++i) { const int sbk = part ? ((i == 0) ? 1 : (i == 1) ? 6 : (i == 2) ? 2 : 5) : ((i == 0) ? 0 : (i == 1) ? 7 : (i == 2) ? 3 : 4);
                mla_block(bh, sbk, tid, lane, wave, lds3, QM, KVM, KPE, VTM, YMIX); } }
    }
    }
    GRID_BAR();
    {
        PHASE_IDS();
    GEMM_PHASE(EpiResid, YMIX, DM, W1out, 1024, 1024, 1024, out, out, ALPHA, 0);
    }
    GRID_BAR();
    {
        PHASE_IDS();
    ln_rows(out, XB, IN(35), IN(36), gw, NGW, lane);
    }
    GRID_BAR();
    {
        PHASE_IDS();
    GEMM_PHASE(EpiBf16S, XB, DM, Wup1, 1024, 2 * DFF, 1024, GU, nullptr, 2 * DFF, 0);
    }
    GRID_BAR();
    {
        PHASE_IDS();
    ffn_act_all(GU, IN(38), IN(39), gtid, NT);
    }
    GRID_BAR();
    {
        PHASE_IDS();
    GEMM_PHASE(EpiResid, GU + DFF, 2 * DFF, Wdn1, DFF, 1024, DFF, out, out, ALPHA, 0);
    }
    GRID_BAR();
    {
        PHASE_IDS();
    ln_rows(out, XB, IN(41), IN(42), gw, NGW, lane);
    #if defined(PROBE_STAMPS)
    __syncthreads();
    if (blockIdx.x == 0 && threadIdx.x == 0) {
        MISC[16 + 22] = (unsigned)__builtin_amdgcn_s_memrealtime();
        const unsigned d1 = MISC[16 + PROBE_T1_HI] - MISC[16 + PROBE_T1_LO];
        const unsigned long long spin = 100ull * d1;
        const unsigned long long t0 = __builtin_amdgcn_s_memrealtime();
        while (__builtin_amdgcn_s_memrealtime() - t0 < spin) __builtin_amdgcn_s_sleep(8);
    }
#endif
}
}

extern "C" void kernel_launch(void* const* d_in, const int* in_sizes, int n_in, void* d_out, int out_size, void* d_ws, size_t ws_size, hipStream_t stream) {
    static int grid = 0;
    if (grid == 0) {
        if (n_in != 43 || ws_size < WS_NEED || out_size != M * DM) { fprintf(stderr, "kernel_launch: unexpected n_in %d / ws %zu / out %d\n", n_in, ws_size, out_size); grid = -1; return; }
        int dev = 0, cus = 0, per_cu = 0;
        if (hipGetDevice(&dev) != hipSuccess || hipDeviceGetAttribute(&cus, hipDeviceAttributeMultiprocessorCount, dev) != hipSuccess) { grid = -1; return; }
        if (hipFuncSetAttribute((const void*)fwd_mega, hipFuncAttributeMaxDynamicSharedMemorySize, LDS_BYTES) != hipSuccess) { fprintf(stderr, "kernel_launch: hipFuncSetAttribute failed\n"); grid = -1; return; }
        if (hipOccupancyMaxActiveBlocksPerMultiprocessor(&per_cu, (const void*)fwd_mega, NWAVES * 64, LDS_BYTES) != hipSuccess || per_cu < 1) fprintf(stderr, "kernel_launch: occupancy query reports %d\n", per_cu);
        (void)hipGetLastError();
        grid = cus;
    }
    if (grid < 0) return;
    (void)hipMemsetAsync((char*)d_ws + WS_CTL, 0, CTL_ZERO_BYTES, stream);
    Args a{};
    for (int i = 0; i < 43; ++i) a.in[i] = (const float*)d_in[i];
    a.out = (float*)d_out; a.ws = (unsigned char*)d_ws;
    hipLaunchKernelGGL(fwd_mega, dim3(grid), dim3(NWAVES * 64), LDS_BYTES, stream, a);
}
```

```cpp
#include <hip/hip_runtime.h>
#include <cstdio>
#include <cstdint>
#include <cmath>
namespace pg8 {
#define PG8_LAS __attribute__((address_space(3)))
typedef unsigned short bf16_t;
typedef short bf16x8 __attribute__((ext_vector_type(8)));
typedef float f32x4 __attribute__((ext_vector_type(4)));
typedef unsigned u32x4 __attribute__((ext_vector_type(4)));
constexpr int BM = 256, BK = 64, HALF = 128, HTB = HALF * BK * 2  , STAGE_BYTES = 8 * HTB, NXCD = 8, WGM = 8;

__host__ __device__ __forceinline__ int lds_byte(int r, int c) { const int st = (r >> 4) * 2 + (c >> 5), rr = r & 15, cc = c & 31, ob = rr * 64 + cc * 2; return st * 1024 + (ob ^ (((ob >> 9) & 1) << 5)); }
__host__ __device__ __forceinline__ void stage_rc(int b, int& R, int& C) { const int st = b / 1024, sb = b % 1024, swz = sb ^ (((sb >> 9) & 1) << 5); R = (st >> 1) * 16 + swz / 64; C = (st & 1) * 32 + (swz % 64) / 2; }
__host__ __device__ __forceinline__ int perm32(int rho) { const int n = rho >> 4, i = rho & 15; return 8 * (i >> 2) + 4 * n + (i & 3); }

struct Unit { int pm, pn; };
struct Gemm { const bf16_t* A; const bf16_t* Bt; int M, N, K, lda, ldb; int hrA = 128, trA = 256, hrB = 128, trB = 256, gatherA = 0; };

struct StaticOrder {
    int nM, nN, nwg, G, c;
    __host__ __device__ void init(int M, int N, int G_, int c_) { nM = M / BM; nN = N / BM; nwg = nM * nN; G = G_; c = c_; }
    __host__ __device__ bool next(int i, Unit& u) const {
        const long L = (long)i * G + c; if (L >= nwg) return false;
        int wgid = (int)L; { const int q = nwg / NXCD, r = nwg % NXCD, xcd = wgid % NXCD, off = wgid / NXCD; wgid = (xcd < r ? xcd * (q + 1) : r * (q + 1) + (xcd - r) * q) + off; }
        const int nig = WGM * nN, gid = wgid / nig, fm = gid * WGM, gsz = (nM - fm) < WGM ? (nM - fm) : WGM;
        u.pm = fm + ((wgid % nig) % gsz); u.pn = (wgid % nig) / gsz; return true;
    }
    __device__ __forceinline__ void a_ready(const Unit&) const {}
    __device__ __forceinline__ void done(const Unit&) const {}
};


__device__ __forceinline__ unsigned cvt_pk_bf16(float lo, float hi) { unsigned r; asm volatile("v_cvt_pk_bf16_f32 %0, %1, %2" : "=v"(r) : "v"(lo), "v"(hi)); return r; }
struct EpiBf16S {
    static constexpr bool PERM = true, AFTER_DRAIN = false;
    bf16_t* O; const float* rowscale; int ldc; int rs_stride;
    __device__ __forceinline__ void operator()(const f32x4 (&acc)[2][2][4][2], const Unit& u, int wr, int wc, int fr, int fq) const {
        const int row0 = u.pm * BM + wr * 64 + fr, col0 = u.pn * BM + wc * 32 + 8 * fq;
#pragma unroll
        for (int ai = 0; ai < 2; ++ai)
#pragma unroll
            for (int m = 0; m < 4; ++m) { const int row = row0 + ai * HALF + m * 16; const float sc = rowscale ? rowscale[(size_t)row * rs_stride] : 1.f;
                bf16_t* rowp = O + (size_t)row * ldc + col0;
#pragma unroll
                for (int bj = 0; bj < 2; ++bj) { const f32x4 v0 = acc[ai][bj][m][0] * sc, v1 = acc[ai][bj][m][1] * sc;
                    u32x4 w; w.x = cvt_pk_bf16(v0[0], v0[1]); w.y = cvt_pk_bf16(v0[2], v0[3]); w.z = cvt_pk_bf16(v1[0], v1[1]); w.w = cvt_pk_bf16(v1[2], v1[3]);
                    *(u32x4*)(rowp + bj * HALF) = w; } }
    }
};
struct EpiResid {
    static constexpr bool PERM = false, AFTER_DRAIN = false;
    const float* hin; float* hout; float alpha; int pad;
    __device__ __forceinline__ void operator()(const f32x4 (&acc)[2][2][4][2], const Unit& u, int wr, int wc, int fr, int fq) const {
        const int row0 = u.pm * BM + wr * 64 + fr, col0 = u.pn * BM + wc * 32 + 4 * fq;
#pragma unroll
        for (int ai = 0; ai < 2; ++ai)
#pragma unroll
            for (int m = 0; m < 4; ++m) { const size_t off = (size_t)(row0 + ai * HALF + m * 16) * 1024 + col0;
#pragma unroll
                for (int bj = 0; bj < 2; ++bj)
#pragma unroll
                    for (int n = 0; n < 2; ++n) { const size_t i = off + bj * HALF + n * 16; const f32x4 h = *(const f32x4*)(hin + i); *(f32x4*)(hout + i) = h * alpha + acc[ai][bj][m][n]; } }
    }
};

template <int CTRL> __device__ __forceinline__ float pg_dpp(float x) { return __builtin_bit_cast(float, __builtin_amdgcn_update_dpp(0, __builtin_bit_cast(int, x), CTRL, 0xF, 0xF, true)); }
struct EpiConvAct {
    static constexpr bool PERM = true, AFTER_DRAIN = false;
    bf16_t* act; const bf16_t* halo; const float* cw; const float* cb; int dff; int seq;
    __device__ __forceinline__ void operator()(const f32x4 (&acc)[2][2][4][2], const Unit& u, int wr, int wc, int fr, int fq) const {
        typedef unsigned u32x2e __attribute__((ext_vector_type(2)));
#pragma unroll
        for (int n = 0; n < 2; ++n) {
            const int ch0 = u.pn * 128 + wc * 32 + 8 * fq + 4 * n;
            const f32x4 w0 = *(const f32x4*)(cw + ch0), w1 = *(const f32x4*)(cw + dff + ch0), w2 = *(const f32x4*)(cw + 2 * dff + ch0), bb = *(const f32x4*)(cb + ch0);
#pragma unroll
            for (int ai = 0; ai < 2; ++ai) {
                const int rb64 = u.pm * BM + ai * HALF + wr * 64;
                f32x4 P = {0.f, 0.f, 0.f, 0.f};
                if ((rb64 & (seq - 1)) != 0 && fr >= 14) { const u32x2e hv = *(const u32x2e*)(halo + (size_t)(2 * (rb64 / 64 - 1) + (fr - 14)) * dff + ch0);
                    P[0] = __builtin_bit_cast(float, hv.x << 16); P[1] = __builtin_bit_cast(float, hv.x & 0xffff0000u); P[2] = __builtin_bit_cast(float, hv.y << 16); P[3] = __builtin_bit_cast(float, hv.y & 0xffff0000u); }
#pragma unroll
                for (int m = 0; m < 4; ++m) {
                    const f32x4 Gv = acc[ai][0][m][n], Uv = acc[ai][1][m][n];
                    float o[4];
#pragma unroll
                    for (int e = 0; e < 4; ++e) {
                        const float t1 = pg_dpp<0x111>(Gv[e]), t2 = pg_dpp<0x112>(Gv[e]), p1 = pg_dpp<0x10F>(P[e]), p2 = pg_dpp<0x10E>(P[e]);
                        const float g1 = (fr >= 1) ? t1 : p1, g2 = (fr >= 2) ? t2 : p2;
                        const float y = bb[e] + w0[e] * g2 + w1[e] * g1 + w2[e] * Gv[e];
                        o[e] = y / (1.f + __expf(-y)) * Uv[e];
                    }
                    u32x2e w; w.x = cvt_pk_bf16(o[0], o[1]); w.y = cvt_pk_bf16(o[2], o[3]);
                    *(u32x2e*)(act + (size_t)(rb64 + m * 16 + fr) * dff + ch0) = w;
                    P = Gv;
                }
            }
        }
    }
};

template <class Epi, class Sched, bool ALIGN_EPI = false, bool SP2 = false>
__device__ __forceinline__ void gemm_phase(PG8_LAS unsigned char* lds, const Gemm g, const Sched& S, const Epi& E) {
    const int tid = threadIdx.x, wid = __builtin_amdgcn_readfirstlane(tid >> 6), lane = tid & 63, wr = wid >> 2, wc = wid & 3, fr = lane & 15, fq = lane >> 4;
    const int K = g.K, nt = K / BK;
    unsigned voffA[2], voffB[2];
#pragma unroll
    for (int i = 0; i < 2; ++i) { int R, C; stage_rc(tid * 16 + i * 8192, R, C); const int Rb = Epi::PERM ? ((R & ~31) + perm32(R & 31)) : R;
        const int Ra = g.gatherA ? (64 * (R >> 1) + 62 + (R & 1)) : R;
        voffA[i] = (unsigned)(Ra * g.lda + C) * 2u; voffB[i] = (unsigned)(Rb * g.ldb + C) * 2u; }
    const size_t kstep = (size_t)(BK * 2);
    const size_t hstepA = (size_t)g.hrA * g.lda * 2, hstepB = (size_t)g.hrB * g.ldb * 2;
    const size_t tstepA = (size_t)g.trA * g.lda * 2, tstepB = (size_t)g.trB * g.ldb * 2;
    const unsigned ldsw = (unsigned)wid * 1024u;
    const int aoff = lds_byte(wr * 64 + fr, fq * 8), boff = lds_byte(wc * 32 + fr, fq * 8);
#define PG8_SA(b, h) (((b) * 2 + (h)) * HTB)
#define PG8_SB(b, h) ((4 + (b) * 2 + (h)) * HTB)
#define PG8_STAGE(bufoff, gbase, voff) do { _Pragma("unroll") for (int _i = 0; _i < 2; ++_i) \
        __builtin_amdgcn_global_load_lds((const unsigned*)((const char*)(gbase) + (voff)[_i]), (PG8_LAS unsigned*)(lds + (bufoff) + ldsw + _i * 8192), 16, 0, 0); } while (0)
#define PG8_LDA(dst, b, h) do { _Pragma("unroll") for (int m = 0; m < 4; ++m) _Pragma("unroll") for (int k = 0; k < 2; ++k) dst[m][k] = *(const PG8_LAS bf16x8*)(lds + PG8_SA(b, h) + aoff + m * 2048 + k * 1024); } while (0)
#define PG8_LDB(dst, b, h) do { _Pragma("unroll") for (int n = 0; n < 2; ++n) _Pragma("unroll") for (int k = 0; k < 2; ++k) dst[n][k] = *(const PG8_LAS bf16x8*)(lds + PG8_SB(b, h) + boff + n * 2048 + k * 1024); } while (0)
#define PG8_MMA(ai, bj, At, Bt) do { __builtin_amdgcn_s_setprio(1); _Pragma("unroll") for (int m = 0; m < 4; ++m) _Pragma("unroll") for (int n = 0; n < 2; ++n) _Pragma("unroll") for (int k = 0; k < 2; ++k) \
        acc[ai][bj][m][n] = __builtin_amdgcn_mfma_f32_16x16x32_bf16(Bt[n][k], At[m][k], acc[ai][bj][m][n], 0, 0, 0); __builtin_amdgcn_s_setprio(0); } while (0)
#define PG8_WAIT_V(n) asm volatile("s_waitcnt vmcnt(" #n ")" ::: "memory")
#define PG8_WAIT_L(n) asm volatile("s_waitcnt lgkmcnt(" #n ")" ::: "memory")
#define PG8_BAR __builtin_amdgcn_s_barrier()
#define PG8_SCHED __builtin_amdgcn_sched_barrier(0)
    Unit cur, nxt; int ui = 0;
    if (!S.next(0, cur)) return;
    f32x4 acc[2][2][4][2];
#pragma unroll
    for (int a = 0; a < 2; ++a)
#pragma unroll
        for (int b = 0; b < 2; ++b)
#pragma unroll
            for (int m = 0; m < 4; ++m)
#pragma unroll
                for (int n = 0; n < 2; ++n) acc[a][b][m][n] = (f32x4){0.f, 0.f, 0.f, 0.f};
    bf16x8 At[4][2], B0[2][2], B1[2][2];
    const char* cA = (const char*)g.A + (size_t)cur.pm * tstepA; const char* cB = (const char*)g.Bt + (size_t)cur.pn * tstepB;
    S.a_ready(cur);
    if constexpr (SP2) {
        PG8_STAGE(PG8_SB(0, 0), cB, voffB); PG8_STAGE(PG8_SB(0, 1), cB + hstepB, voffB); PG8_STAGE(PG8_SA(0, 0), cA, voffA); PG8_STAGE(PG8_SA(0, 1), cA + hstepA, voffA);
        if (wr == 1) PG8_BAR;
        PG8_WAIT_V(2); PG8_BAR;
        PG8_STAGE(PG8_SB(1, 0), cB + kstep, voffB); PG8_STAGE(PG8_SA(1, 0), cA + kstep, voffA); PG8_STAGE(PG8_SB(1, 1), cB + hstepB + kstep, voffB);
        PG8_WAIT_V(6); PG8_BAR;
    } else {
        PG8_STAGE(PG8_SB(0, 0), cB, voffB); PG8_STAGE(PG8_SA(0, 0), cA, voffA); PG8_STAGE(PG8_SB(0, 1), cB + hstepB, voffB); PG8_STAGE(PG8_SA(0, 1), cA + hstepA, voffA);
        if (wr == 1) PG8_BAR;
        PG8_WAIT_V(4); PG8_BAR;
        PG8_STAGE(PG8_SB(1, 0), cB + kstep, voffB); PG8_STAGE(PG8_SA(1, 0), cA + kstep, voffA); PG8_STAGE(PG8_SB(1, 1), cB + hstepB + kstep, voffB);
        PG8_WAIT_V(6); PG8_BAR;
    }
    for (;;) {
        const bool has_next = S.next(ui + 1, nxt);
        const char* nA = has_next ? (const char*)g.A + (size_t)nxt.pm * tstepA : cA; const char* nB = has_next ? (const char*)g.Bt + (size_t)nxt.pn * tstepB : cB;
        for (int t = 0; t < nt; t += 2) {
            const bool last = (t == nt - 2);
            const char* a1 = cA + (size_t)(t + 1) * kstep;
            const char* a2 = last ? nA : cA + (size_t)(t + 2) * kstep; const char* b2 = last ? nB : cB + (size_t)(t + 2) * kstep;
            const char* a3 = a2 + kstep; const char* b3 = b2 + kstep;
            if (last && has_next) S.a_ready(nxt);
            if constexpr (SP2) {
            PG8_LDB(B0, 0, 0); PG8_LDB(B1, 0, 1); PG8_SCHED; PG8_LDA(At, 0, 0); PG8_STAGE(PG8_SA(1, 1), a1 + hstepA, voffA);
            PG8_WAIT_V(8); PG8_WAIT_L(0); PG8_BAR; PG8_MMA(0, 0, At, B0); PG8_MMA(0, 1, At, B1); PG8_BAR; PG8_SCHED;
            PG8_LDA(At, 0, 1); PG8_STAGE(PG8_SB(0, 0), b2, voffB); PG8_STAGE(PG8_SB(0, 1), b2 + hstepB, voffB); PG8_STAGE(PG8_SA(0, 0), a2, voffA);
            PG8_WAIT_V(8); PG8_WAIT_L(0); PG8_BAR; PG8_MMA(1, 0, At, B0); PG8_MMA(1, 1, At, B1); PG8_BAR; PG8_SCHED;
            PG8_LDB(B0, 1, 0); PG8_LDB(B1, 1, 1); PG8_SCHED; PG8_LDA(At, 1, 0); PG8_STAGE(PG8_SA(0, 1), a2 + hstepA, voffA);
            PG8_WAIT_V(8); PG8_WAIT_L(0); PG8_BAR; PG8_MMA(0, 0, At, B0); PG8_MMA(0, 1, At, B1); PG8_BAR; PG8_SCHED;
            PG8_LDA(At, 1, 1); PG8_STAGE(PG8_SB(1, 0), b3, voffB); PG8_STAGE(PG8_SB(1, 1), b3 + hstepB, voffB); PG8_STAGE(PG8_SA(1, 0), a3, voffA);
            PG8_WAIT_V(8); PG8_WAIT_L(0); PG8_BAR; PG8_MMA(1, 0, At, B0); PG8_MMA(1, 1, At, B1); PG8_BAR; PG8_SCHED;
            } else {
            PG8_LDB(B0, 0, 0); PG8_SCHED; PG8_LDA(At, 0, 0); PG8_STAGE(PG8_SA(1, 1), a1 + hstepA, voffA);
            PG8_WAIT_L(8); PG8_BAR; PG8_WAIT_L(0); PG8_MMA(0, 0, At, B0); PG8_BAR; PG8_SCHED;
            PG8_LDB(B1, 0, 1); PG8_STAGE(PG8_SB(0, 0), b2, voffB);
            PG8_BAR; PG8_WAIT_L(0); PG8_MMA(0, 1, At, B1); PG8_BAR;
            PG8_LDA(At, 0, 1); PG8_STAGE(PG8_SA(0, 0), a2, voffA);
            PG8_BAR; PG8_WAIT_L(0); PG8_MMA(1, 0, At, B0); PG8_BAR; PG8_SCHED;
            PG8_STAGE(PG8_SB(0, 1), b2 + hstepB, voffB);
            PG8_WAIT_V(6); PG8_BAR; PG8_MMA(1, 1, At, B1); PG8_BAR;
            PG8_LDB(B0, 1, 0); PG8_SCHED; PG8_LDA(At, 1, 0); PG8_STAGE(PG8_SA(0, 1), a2 + hstepA, voffA);
            PG8_WAIT_L(8); PG8_BAR; PG8_WAIT_L(0); PG8_MMA(0, 0, At, B0); PG8_BAR; PG8_SCHED;
            PG8_LDB(B1, 1, 1); PG8_STAGE(PG8_SB(1, 0), b3, voffB);
            PG8_BAR; PG8_WAIT_L(0); PG8_MMA(0, 1, At, B1); PG8_BAR;
            PG8_LDA(At, 1, 1); PG8_STAGE(PG8_SA(1, 0), a3, voffA);
            PG8_BAR; PG8_WAIT_L(0); PG8_MMA(1, 0, At, B0); PG8_BAR; PG8_SCHED;
            PG8_STAGE(PG8_SB(1, 1), b3 + hstepB, voffB);
            PG8_WAIT_V(6); PG8_BAR; PG8_MMA(1, 1, At, B1); PG8_BAR;
            }
        }
        if constexpr (ALIGN_EPI) { if (wr == 0) PG8_BAR; }
        if constexpr (!Epi::AFTER_DRAIN) { E(acc, cur, wr, wc, fr, fq); S.done(cur); }
        if (!has_next) break;
#pragma unroll
        for (int a = 0; a < 2; ++a)
#pragma unroll
            for (int b = 0; b < 2; ++b)
#pragma unroll
                for (int m = 0; m < 4; ++m)
#pragma unroll
                    for (int n = 0; n < 2; ++n) acc[a][b][m][n] = (f32x4){0.f, 0.f, 0.f, 0.f};
        cur = nxt; cA = nA; cB = nB; ++ui;
        if constexpr (ALIGN_EPI) { if (wr == 1) PG8_BAR; }
    }
    PG8_WAIT_V(0);
    if constexpr (!ALIGN_EPI) { if (wr == 0) PG8_BAR; }
    PG8_BAR;
    if constexpr (Epi::AFTER_DRAIN) { E.fused(acc, cur, wr, wc, fr, fq, lds, wid, lane); S.done(cur); }
#undef PG8_SA
#undef PG8_SB
#undef PG8_STAGE
#undef PG8_LDA
#undef PG8_LDB
#undef PG8_MMA
#undef PG8_WAIT_V
#undef PG8_WAIT_L
#undef PG8_BAR
#undef PG8_SCHED
}
}
#define GAS __attribute__((address_space(1)))
#define LAS __attribute__((address_space(3)))
typedef unsigned short bf16;
typedef unsigned v4u __attribute__((ext_vector_type(4)));
typedef float f32x4 __attribute__((ext_vector_type(4)));
typedef short bf16x8 __attribute__((ext_vector_type(8)));
typedef GAS unsigned gu32;
typedef GAS unsigned long long gu64;
#define RLX_AGENT __ATOMIC_RELAXED, __HIP_MEMORY_SCOPE_AGENT
#define LDS_WAIT() asm volatile("s_waitcnt lgkmcnt(0)" ::: "memory")
#define VM_WAIT() asm volatile("s_waitcnt vmcnt(0)" ::: "memory")
__device__ __forceinline__ unsigned long long rt() { return __builtin_amdgcn_s_memrealtime(); }
__device__ __forceinline__ unsigned f2bf(float f) { unsigned u = __builtin_bit_cast(unsigned, f); return (u + 0x7fffu + ((u >> 16) & 1u)) >> 16; }
__device__ __forceinline__ unsigned pk2(float lo, float hi) { return f2bf(lo) | (f2bf(hi) << 16); }

#define XB_TMO      128
#define XB_XCNT(j)  (256  + 64 * (j))
#define XB_XSUB(j)  (1280 + 64 * (j))
#define XB_XGEN(j)  (2304 + 64 * (j))
#define XB_TOP      3328
#define XB_TOPGEN   3392
#define XCD_BAR_WORDS 3456
#define XB_SPIN_CAP (1u << 18)

__device__ __forceinline__ unsigned xb_ld(unsigned* p)              { return __hip_atomic_load(p, __ATOMIC_RELAXED, __HIP_MEMORY_SCOPE_AGENT); }
__device__ __forceinline__ unsigned xb_add(unsigned* p, unsigned v) { return __hip_atomic_fetch_add(p, v, __ATOMIC_RELAXED, __HIP_MEMORY_SCOPE_AGENT); }
__device__ __forceinline__ unsigned xb_xcc_id() { return (unsigned)__builtin_amdgcn_s_getreg((3 << 11) | 20) & 0xFu; }
#define XB_SPIN(cond, bar) do { unsigned _sp = 0; while (cond) { __builtin_amdgcn_s_sleep(1); \
    if ((++_sp & 255u) == 0u) { if (xb_ld(&(bar)[XB_TMO])) break; if (_sp > XB_SPIN_CAP) { atomicAdd(&(bar)[XB_TMO], 1u); break; } } } } while (0)

struct XcdBarrier {
    unsigned* bar; unsigned x;
    volatile LAS unsigned* st;
};

__device__ __forceinline__ XcdBarrier xcd_barrier_post(unsigned* bar, volatile LAS unsigned* st) {
    XcdBarrier b; b.bar = bar; b.x = xb_xcc_id(); b.st = st;
    if (threadIdx.x == 0) (void)xb_add(&bar[XB_XCNT(b.x)], 1u);
    return b;
}
__device__ __forceinline__ void xcd_barrier_complete(unsigned* bar, unsigned x, unsigned& nloc, unsigned& nx) {
    const unsigned G = gridDim.x * gridDim.y * gridDim.z;
    unsigned sum, cnt, mine, sp = 0u;
    for (;;) {
        sum = 0u; cnt = 0u; mine = 0u;
#pragma unroll
        for (unsigned j = 0; j < 16; ++j) { const unsigned c = xb_ld(&bar[XB_XCNT(j)]); sum += c; cnt += (c > 0u) ? 1u : 0u; mine = (j == x) ? c : mine; }
        if (sum == G) break;
        __builtin_amdgcn_s_sleep(1);
        if ((++sp & 255u) == 0u) { if (xb_ld(&bar[XB_TMO])) break; if (sp > XB_SPIN_CAP) { atomicAdd(&bar[XB_TMO], 1u); break; } }
    }
    nloc = mine > 0u ? mine : 1u; nx = cnt > 0u ? cnt : 1u;
}

__device__ __forceinline__ void xcd_barrier(const XcdBarrier& b) {
    asm volatile("s_waitcnt vmcnt(0)" ::: "memory");
    __syncthreads();
    if (threadIdx.x == 0) {
        unsigned* bar = b.bar;
        __builtin_amdgcn_s_waitcnt(0);
        unsigned nloc = b.st[0], nx = b.st[1];
        if (nloc == 0u) { xcd_barrier_complete(bar, b.x, nloc, nx); b.st[0] = nloc; b.st[1] = nx; }
        const unsigned old = xb_add(&bar[XB_XSUB(b.x)], 1u);
        const unsigned gen = old / nloc;
        if (old + 1u == (gen + 1u) * nloc) {
            __builtin_amdgcn_fence(__ATOMIC_RELEASE, "agent");
            asm volatile("s_waitcnt vmcnt(0)" ::: "memory");
            const unsigned og = xb_add(&bar[XB_TOP], 1u);
            const unsigned tg = og / nx;
            if (og + 1u == (tg + 1u) * nx) xb_add(&bar[XB_TOPGEN], 1u);
            else XB_SPIN(xb_ld(&bar[XB_TOPGEN]) == tg, bar);
            __builtin_amdgcn_fence(__ATOMIC_ACQUIRE, "agent");
            xb_add(&bar[XB_XGEN(b.x)], 1u);
            asm volatile("s_waitcnt vmcnt(0)" ::: "memory");
        } else {
            XB_SPIN(xb_ld(&bar[XB_XGEN(b.x)]) == gen, bar);
            __builtin_amdgcn_fence(__ATOMIC_ACQUIRE, "agent");
            asm volatile("s_waitcnt vmcnt(0)" ::: "memory");
        }
    }
    __syncthreads();
}
constexpr int NWAVES = 8;
constexpr int BATCH = 16, SEQ = 2048, DM = 1024, M = BATCH * SEQ;
constexpr int L0P = 3584;
constexpr int L1P = 2048;
constexpr int DFF = 2816;
constexpr float ALPHA = 1.4142135623730951f;
typedef unsigned short bf16_t;
typedef float f32x16 __attribute__((ext_vector_type(16)));

constexpr size_t MiB = 1u << 20;
constexpr size_t WS_CTL = 0, CTL_ZERO_BYTES = 1 * MiB;
constexpr int CW_BAR = 4096;
constexpr size_t WS_W0IN = 2 * MiB, WS_W0OUT = 9 * MiB, WS_WUP0 = 11 * MiB, WS_WDN0 = 22 * MiB, WS_W1IN = 28 * MiB, WS_WUQ = 32 * MiB, WS_WUKV = 33 * MiB,
                 WS_W1OUT = 34 * MiB, WS_WUP1 = 36 * MiB, WS_WDN1 = 47 * MiB;
constexpr size_t WS_XB = 56 * MiB, WS_YMIX = 120 * MiB, WS_BIG = 184 * MiB;
constexpr size_t WS_G = 408 * MiB, WS_BONUS = 440 * MiB, WS_DT = 441 * MiB, WS_XST = 442 * MiB, WS_BT = 474 * MiB, WS_ASUM = 490 * MiB;
constexpr size_t WS_SLOC = 120 * MiB;
constexpr size_t WS_W2T = 53 * MiB, WS_A2T = 53 * MiB + 256 * 1024, WS_G2T = 53 * MiB + 512 * 1024;
constexpr size_t WS_GU = 120 * MiB;
constexpr size_t WS_PROJ1 = 184 * MiB, WS_QM = 312 * MiB, WS_KVM = 360 * MiB, WS_KPE = 424 * MiB, WS_RS = 426 * MiB;
constexpr size_t WS_CSTAB = 492 * MiB;
constexpr size_t WS_VTS = 428 * MiB, WS_VTM = 460 * MiB;
constexpr size_t WS_NEED = 496 * MiB;

constexpr int RING_BYTES = 131072;
constexpr int LDSCTL_OFF = 146432, MISC_OFF = LDSCTL_OFF + 320;
constexpr int LDS_BYTES = 147456;

__device__ __forceinline__ float bf2f(bf16_t b) { return __builtin_bit_cast(float, (unsigned)b << 16); }
__device__ __forceinline__ float sigmoidf_(float x) { return 1.f / (1.f + expf(-x)); }
__device__ __forceinline__ float softplusf_(float x) { return fmaxf(x, 0.f) + log1pf(expf(-fabsf(x))); }
__device__ __forceinline__ float siluf_(float x) { return x / (1.f + expf(-x)); }
__device__ __forceinline__ float wave_sum(float v) {
#pragma unroll
    for (int o = 1; o < 64; o <<= 1) v += __shfl_xor(v, o);
    return v;
}
#define WSYNC() asm volatile("s_waitcnt lgkmcnt(0)" ::: "memory")
typedef float f32x2_t __attribute__((ext_vector_type(2)));
typedef __bf16 bf16x2_t __attribute__((ext_vector_type(2)));
typedef unsigned u32x2 __attribute__((ext_vector_type(2)));
__device__ __forceinline__ unsigned cvtpk(float lo, float hi) { f32x2_t v = {lo, hi}; bf16x2_t b = __builtin_convertvector(v, bf16x2_t); return __builtin_bit_cast(unsigned, b); }
__device__ __forceinline__ float bflo(unsigned u) { return __builtin_bit_cast(float, u << 16); }
__device__ __forceinline__ float bfhi(unsigned u) { return __builtin_bit_cast(float, u & 0xffff0000u); }

__device__ __forceinline__ void transpose_matrix(const float* __restrict__ W, int K, int N, bf16_t* __restrict__ WT, int Npad, int ldt, LAS float* scr, int gw, int NGW, int lane, const float* __restrict__ kscale, bool ffn_interleave = false) {
    (void)scr;
    const int nblk = Npad / 64, nit = (K / 64) * nblk;
    for (int it = gw; it < nit; it += NGW) {
        const int kb = it / nblk, nb = it - kb * nblk, n = nb * 64 + lane, k0 = kb * 64;
        const bool ok = n < N; const float* src = W + (size_t)k0 * N + (ok ? n : 0);
#pragma unroll
        for (int hc = 0; hc < 2; ++hc) {
            float v[32];
#pragma unroll
            for (int i = 0; i < 32; ++i) v[i] = src[(size_t)(hc * 32 + i) * N];
#pragma unroll
            for (int c = 0; c < 4; ++c) { float u[8];
#pragma unroll
                for (int i = 0; i < 8; ++i) { u[i] = ok ? v[c * 8 + i] : 0.f; if (kscale) u[i] *= kscale[k0 + hc * 32 + c * 8 + i]; }
                v4u o; o.x = cvtpk(u[0], u[1]); o.y = cvtpk(u[2], u[3]); o.z = cvtpk(u[4], u[5]); o.w = cvtpk(u[6], u[7]);
                const int nr = ffn_interleave ? ((n < DFF) ? 256 * (n >> 7) + (n & 127) : 256 * ((n - DFF) >> 7) + 128 + ((n - DFF) & 127)) : n;
                *(v4u*)(WT + (size_t)nr * ldt + k0 + hc * 32 + c * 8) = o; }
        }
    }
}

template <bool ST = true> __device__ __forceinline__ void ln_rows(float* h, bf16_t* hb, const float* __restrict__ g, const float* __restrict__ b, int gw, int NGW, int lane) {
    for (int row = gw; row < M; row += NGW) {
        float* p = h + (size_t)row * DM;
        f32x4 v[4]; float s = 0.f;
#pragma unroll
        for (int j = 0; j < 4; ++j) { v[j] = *(const f32x4*)(p + 4 * lane + 256 * j); s += (v[j][0] + v[j][1]) + (v[j][2] + v[j][3]); }
        const float mean = wave_sum(s) * (1.f / DM); float q = 0.f;
#pragma unroll
        for (int j = 0; j < 4; ++j) { v[j] = v[j] - mean; q += (v[j][0] * v[j][0] + v[j][1] * v[j][1]) + (v[j][2] * v[j][2] + v[j][3] * v[j][3]); }
        const float rstd = 1.0f / sqrtf(wave_sum(q) * (1.f / DM) + 1e-5f);
#pragma unroll
        for (int j = 0; j < 4; ++j) {
            const int c = 4 * lane + 256 * j;
            const f32x4 gg = *(const f32x4*)(g + c), bb = *(const f32x4*)(b + c);
            const f32x4 o = v[j] * rstd * gg + bb;
            uint2 w; w.x = pk2(o[0], o[1]); w.y = pk2(o[2], o[3]);
            if (ST) { *(f32x4*)(p + c) = o; *(uint2*)(hb + (size_t)row * DM + c) = w; } else asm volatile("" :: "v"(w.x), "v"(w.y), "v"(o[0]), "v"(o[1]), "v"(o[2]), "v"(o[3]));
        }
    }
}

__device__ __forceinline__ void rwkv_naive_chain(int chain, int lane, LAS float* sm, const bf16_t* __restrict__ proj, const float* __restrict__ mix, const float* __restrict__ w0, const float* __restrict__ w2,
                                                 const float* __restrict__ a0, const float* __restrict__ a2, const float* __restrict__ g2, const float* __restrict__ k_k,
                                                 const float* __restrict__ k_a, const float* __restrict__ r_k, const float* __restrict__ ln_g, const float* __restrict__ ln_b, bf16_t* __restrict__ ymix) {
    LAS float* s_w2 = sm; LAS float* s_a2 = sm + 4096; LAS float* s_g2 = sm + 8192; LAS float* s_tw = sm + 16384; LAS float* s_al = s_tw + 64; LAS float* s_sg = s_tw + 128;
    LAS float* s_w = s_tw + 256; LAS float* s_k = s_tw + 320; LAS float* s_a = s_tw + 384; LAS float* s_b = s_tw + 448; LAS float* s_r = s_tw + 512;
    const int b = chain >> 3, h = chain & 7, c = h * 64 + lane;
    for (int l = 0; l < 64; ++l) { s_w2[l * 64 + lane] = w2[l * 512 + c]; s_a2[l * 64 + lane] = a2[l * 512 + c]; }
    for (int l = 0; l < 128; ++l) s_g2[l * 64 + lane] = g2[l * 512 + c];
    const float mr = mix[c], mk = mix[512 + c], mv = mix[1024 + c], mw = mix[1536 + lane], ma = mix[1600 + lane], mg0 = mix[1664 + lane], mg1 = mix[1728 + lane];
    const float w0c = w0[c], a0c = a0[c], kkc = k_k[c], kac = k_a[c], rkc = r_k[c], lgc = ln_g[c], lbc = ln_b[c];
    float S[64];
#pragma unroll
    for (int j = 0; j < 64; ++j) S[j] = 0.f;
    float pr = 0.f, pk = 0.f, pv = 0.f, pw = 0.f, pa = 0.f, pg0 = 0.f, pg1 = 0.f;
    WSYNC();
    for (int t = 0; t < SEQ; ++t) {
        const bf16_t* row = proj + (size_t)(b * SEQ + t) * L0P;
        const float cr = bf2f(row[c]), ck = bf2f(row[512 + c]), cv = bf2f(row[1024 + c]), cw = bf2f(row[1536 + lane]), ca = bf2f(row[1600 + lane]),
                    cg0 = bf2f(row[1664 + lane]), cg1 = bf2f(row[1728 + lane]);
        const float r_s = cr + (pr - cr) * mr, k_s = ck + (pk - ck) * mk, v_s = cv + (pv - cv) * mv;
        const float wl = cw + (pw - cw) * mw, al = ca + (pa - ca) * ma, g0 = cg0 + (pg0 - cg0) * mg0, g1 = cg1 + (pg1 - cg1) * mg1;
        pr = cr; pk = ck; pv = cv; pw = cw; pa = ca; pg0 = cg0; pg1 = cg1;
        s_tw[lane] = tanhf(wl); s_al[lane] = al; s_sg[lane] = sigmoidf_(g0); s_sg[64 + lane] = sigmoidf_(g1);
        WSYNC();
        float wsum = w0c, asum = a0c, gsum = 0.f;
#pragma unroll 2
        for (int l = 0; l < 64; ++l) { wsum += s_tw[l] * s_w2[l * 64 + lane]; asum += s_al[l] * s_a2[l * 64 + lane]; }
#pragma unroll 2
        for (int l = 0; l < 128; ++l) gsum += s_sg[l] * s_g2[l * 64 + lane];
        const float log_w = -softplusf_(-wsum) - 0.5f;
        const float dec = expf(-expf(log_w));
        const float a = sigmoidf_(asum);
        float kkv = k_s * kkc;
        const float nrm = sqrtf(wave_sum(kkv * kkv));
        kkv = kkv / fmaxf(nrm, 1e-12f);
        const float k2 = k_s * (1.f + (a - 1.f) * kac);
        const float bonus_s = wave_sum(r_s * k2 * rkc);
        s_w[lane] = dec; s_k[lane] = k2; s_a[lane] = -kkv; s_b[lane] = kkv * a; s_r[lane] = r_s;
        WSYNC();
        float sa = 0.f;
#pragma unroll
        for (int j = 0; j < 64; ++j) sa += S[j] * s_a[j];
        float y = 0.f;
#pragma unroll
        for (int j = 0; j < 64; ++j) { S[j] = S[j] * s_w[j] + sa * s_b[j] + v_s * s_k[j]; y += S[j] * s_r[j]; }
        const float mu = wave_sum(y) * (1.f / 64.f);
        const float d = y - mu;
        const float var = wave_sum(d * d) * (1.f / 64.f);
        const float yn = d * (1.0f / sqrtf(var + 64e-5f)) * lgc + lbc;
        const float o = (yn + bonus_s * v_s) * gsum;
        ymix[(size_t)(b * SEQ + t) * DM + c] = (bf16_t)f2bf(o);
        WSYNC();
    }
}

__device__ __forceinline__ void ssm_conv_all(const bf16_t* __restrict__ proj, const float* __restrict__ cw, const float* __restrict__ cb, const float* __restrict__ dtb,
                                             bf16_t* __restrict__ xbc, float* __restrict__ dt, int gtid, int NT) {
    for (size_t i = gtid; i < (size_t)M * 1024; i += NT) {
        const int m = (int)(i >> 10), c = (int)(i & 1023), t = m & (SEQ - 1);
        float acc = cb[c];
#pragma unroll
        for (int k = 0; k < 4; ++k) { const int tt = t - 3 + k; if (tt >= 0) acc += cw[k * 1024 + c] * bf2f(proj[(size_t)(m - 3 + k) * L0P + 2304 + c]); }
        xbc[i] = (bf16_t)f2bf(siluf_(acc));
    }
    for (int i = gtid; i < M * 8; i += NT) dt[i] = softplusf_(bf2f(proj[(size_t)(i >> 3) * L0P + 3328 + (i & 7)]) + dtb[i & 7]);
}
__device__ __forceinline__ void ssd_naive_task(int task, int lane, const bf16_t* __restrict__ xbc, const float* __restrict__ dt, const float* __restrict__ a_log, const float* __restrict__ dsk, float* __restrict__ yssm) {
    const int chain = task >> 2, q = task & 3, b = chain >> 3, h = chain & 7, g = h >> 2, p = q * 16 + (lane >> 2), nq = lane & 3;
    const float A = -expf(a_log[h]), D = dsk[h];
    float st[32];
#pragma unroll
    for (int n = 0; n < 32; ++n) st[n] = 0.f;
    for (int t = 0; t < SEQ; ++t) {
        const size_t m = (size_t)b * SEQ + t;
        const float dtv = dt[m * 8 + h], dA = expf(dtv * A);
        const float x = bf2f(xbc[m * 1024 + h * 64 + p]), xdt = x * dtv;
        const bf16_t* Bp = xbc + m * 1024 + 512 + g * 128 + nq * 32;
        const bf16_t* Cp = xbc + m * 1024 + 768 + g * 128 + nq * 32;
        float yp = 0.f;
#pragma unroll
        for (int n = 0; n < 32; ++n) { st[n] = st[n] * dA + xdt * bf2f(Bp[n]); yp += st[n] * bf2f(Cp[n]); }
        yp += __shfl_xor(yp, 1); yp += __shfl_xor(yp, 2);
        if (nq == 0) yssm[m * 512 + h * 64 + p] = yp + D * x;
    }
}
template <bool ST = true> __device__ __forceinline__ void ssm_gate_norm_all(const bf16_t* __restrict__ yssm, const bf16_t* __restrict__ proj, const float* __restrict__ ng, bf16_t* __restrict__ ymix, int wv0, int wvend, int lane) {
    for (int wv = wv0; wv < wvend; wv += NWAVES) {
        const int m = wv >> 1, g = wv & 1;
        float u[4], q = 0.f;
#pragma unroll
        for (int j = 0; j < 4; ++j) { const int c = g * 256 + j * 64 + lane; const float z = bf2f(proj[(size_t)m * L0P + 1792 + c]); u[j] = bf2f(yssm[(size_t)m * 512 + c]) * siluf_(z); q += u[j] * u[j]; }
        const float rs = 1.0f / sqrtf(wave_sum(q) * (1.f / 256.f) + 1e-5f);
#pragma unroll
        for (int j = 0; j < 4; ++j) { const int c = g * 256 + j * 64 + lane; const float o_ = u[j] * rs * ng[c]; if (ST) ymix[(size_t)m * DM + 512 + c] = (bf16_t)f2bf(o_); else asm volatile("" :: "v"(o_)); }
    }
}
template <bool ST = true> __device__ __forceinline__ void ffn_act_all(bf16_t* gu, const float* __restrict__ cw, const float* __restrict__ cb, int gtid, int NT) {
    constexpr int NCH = DFF / 8, NSTRIP = M / 32;
    for (int task = gtid; task < NSTRIP * NCH; task += NT) {
        const int strip = task / NCH, q = task - strip * NCH, c0 = q * 8, m0 = strip * 32;
        float w0[8], w1[8], w2[8], bb[8], g2[8], g1[8];
#pragma unroll
        for (int j = 0; j < 8; j += 4) { const f32x4 a = *(const f32x4*)(cw + c0 + j), b = *(const f32x4*)(cw + DFF + c0 + j), c = *(const f32x4*)(cw + 2 * DFF + c0 + j), d = *(const f32x4*)(cb + c0 + j);
#pragma unroll
            for (int k = 0; k < 4; ++k) { w0[j + k] = a[k]; w1[j + k] = b[k]; w2[j + k] = c[k]; bb[j + k] = d[k]; } }
        bf16_t* base = gu + (size_t)m0 * (2 * DFF) + c0;
        if ((m0 & (SEQ - 1)) != 0) { const v4u a = *(const v4u*)(base - 2 * (2 * DFF)), b = *(const v4u*)(base - (2 * DFF));
            g2[0] = bflo(a.x); g2[1] = bfhi(a.x); g2[2] = bflo(a.y); g2[3] = bfhi(a.y); g2[4] = bflo(a.z); g2[5] = bfhi(a.z); g2[6] = bflo(a.w); g2[7] = bfhi(a.w);
            g1[0] = bflo(b.x); g1[1] = bfhi(b.x); g1[2] = bflo(b.y); g1[3] = bfhi(b.y); g1[4] = bflo(b.z); g1[5] = bfhi(b.z); g1[6] = bflo(b.w); g1[7] = bfhi(b.w); }
        else {
#pragma unroll
            for (int j = 0; j < 8; ++j) { g2[j] = 0.f; g1[j] = 0.f; } }
#pragma unroll 4
        for (int r = 0; r < 32; ++r) {
            const v4u gv = *(const v4u*)(base + (size_t)r * (2 * DFF)), uv = *(const v4u*)(base + (size_t)r * (2 * DFF) + DFF);
            const unsigned gw_[4] = {gv.x, gv.y, gv.z, gv.w}, uw_[4] = {uv.x, uv.y, uv.z, uv.w};
            unsigned ow[4];
#pragma unroll
            for (int k = 0; k < 4; ++k) {
                const float ga = bflo(gw_[k]), gb = bfhi(gw_[k]);
                const float ya = bb[2 * k] + w0[2 * k] * g2[2 * k] + w1[2 * k] * g1[2 * k] + w2[2 * k] * ga;
                const float yb = bb[2 * k + 1] + w0[2 * k + 1] * g2[2 * k + 1] + w1[2 * k + 1] * g1[2 * k + 1] + w2[2 * k + 1] * gb;
                g2[2 * k] = g1[2 * k]; g1[2 * k] = ga; g2[2 * k + 1] = g1[2 * k + 1]; g1[2 * k + 1] = gb;
                ow[k] = cvtpk(ya / (1.f + __expf(-ya)) * bflo(uw_[k]), yb / (1.f + __expf(-yb)) * bfhi(uw_[k]));
            }
            if (ST) *(v4u*)(base + (size_t)r * (2 * DFF) + DFF) = (v4u){ow[0], ow[1], ow[2], ow[3]}; else asm volatile("" :: "v"(ow[0]), "v"(ow[1]), "v"(ow[2]), "v"(ow[3]));
        }
    }
}
template <bool ST = true> __device__ __forceinline__ void mla_prep_all(const bf16_t* __restrict__ proj1, const int* __restrict__ pos, float* __restrict__ rs, bf16_t* __restrict__ kpe, float* __restrict__ cstab, int gw, int NGW, int lane) {
    for (int m = gw; m < M; m += NGW) {
        const bf16_t* row = proj1 + (size_t)m * L1P;
        float q = 0.f;
#pragma unroll
        for (int j = 0; j < 4; ++j) { const float v = bf2f(row[1536 + j * 64 + lane]); q += v * v; }
        q = wave_sum(q);
        float k = 0.f;
#pragma unroll
        for (int j = 0; j < 2; ++j) { const float v = bf2f(row[1792 + j * 64 + lane]); k += v * v; }
        k = wave_sum(k);
        if (ST && lane == 0) { rs[(size_t)m * 2] = 1.0f / sqrtf(q * (1.f / 256.f) + 1e-6f); rs[(size_t)m * 2 + 1] = 1.0f / sqrtf(k * (1.f / 128.f) + 1e-6f); }
        if (lane < 16) {
            const double inv = pow(10000.0, -(double)(2 * lane) / 32.0);
            const double ang = (double)pos[m] * inv;
            const float cs = (float)cos(ang), sn = (float)sin(ang);
            if (ST) { cstab[(size_t)m * 32 + lane] = cs; cstab[(size_t)m * 32 + 16 + lane] = sn; }
            const float x1 = bf2f(row[1920 + lane]), x2 = bf2f(row[1936 + lane]);
            const bf16_t r1_ = (bf16_t)f2bf(x1 * cs - x2 * sn), r2_ = (bf16_t)f2bf(x2 * cs + x1 * sn);
            if (ST) { kpe[(size_t)m * 32 + lane] = r1_; kpe[(size_t)m * 32 + 16 + lane] = r2_; } else asm volatile("" :: "v"((unsigned)r1_), "v"((unsigned)r2_), "v"(q), "v"(k));
        }
    }
}
template <bool ST = true> __device__ __forceinline__ void rope_q_all(bf16_t* qm, const float* __restrict__ cstab, int gtid, int NT) {
    for (int i = gtid; i < M * 16; i += NT) {
        const int m = i >> 4, h = (i >> 1) & 7, k0 = (i & 1) * 8;
        bf16_t* p = qm + (size_t)m * 768 + h * 96 + 64 + k0;
        const v4u a = *(const v4u*)p, b = *(const v4u*)(p + 16);
        const f32x4 c0 = *(const f32x4*)(cstab + (size_t)m * 32 + k0), c1 = *(const f32x4*)(cstab + (size_t)m * 32 + k0 + 4), s0 = *(const f32x4*)(cstab + (size_t)m * 32 + 16 + k0), s1 = *(const f32x4*)(cstab + (size_t)m * 32 + 16 + k0 + 4);
        const unsigned au[4] = {a.x, a.y, a.z, a.w}, bu[4] = {b.x, b.y, b.z, b.w};
        const float cs[8] = {c0[0], c0[1], c0[2], c0[3], c1[0], c1[1], c1[2], c1[3]}, sn[8] = {s0[0], s0[1], s0[2], s0[3], s1[0], s1[1], s1[2], s1[3]};
        unsigned o1[4], o2[4];
#pragma unroll
        for (int q = 0; q < 4; ++q) { const float x1a = bflo(au[q]), x1b = bfhi(au[q]), x2a = bflo(bu[q]), x2b = bfhi(bu[q]);
            o1[q] = cvtpk(x1a * cs[2 * q] - x2a * sn[2 * q], x1b * cs[2 * q + 1] - x2b * sn[2 * q + 1]);
            o2[q] = cvtpk(x2a * cs[2 * q] + x1a * sn[2 * q], x2b * cs[2 * q + 1] + x1b * sn[2 * q + 1]); }
        if (ST) { *(v4u*)p = (v4u){o1[0], o1[1], o1[2], o1[3]}; *(v4u*)(p + 16) = (v4u){o2[0], o2[1], o2[2], o2[3]}; }
    }
}
__device__ __forceinline__ void sb_naive_task(int qblk, int bh, int lane, const bf16_t* __restrict__ proj1, bf16_t* __restrict__ ymix) {
    const int b = bh >> 3, h = bh & 7, t = qblk * 64 + lane;
    const size_t mrow = (size_t)b * SEQ;
    float q[64], o[64];
#pragma unroll
    for (int d = 0; d < 64; ++d) { q[d] = bf2f(proj1[(mrow + t) * L1P + h * 64 + d]) * 0.125f; o[d] = 0.f; }
    float cum = 0.f;
    const int smax = qblk * 64 + 63;
    for (int s = smax - 1; s >= 0; --s) {
        const bf16_t* kr = proj1 + (mrow + s) * L1P + 512 + h * 64;
        const bf16_t* vr = proj1 + (mrow + s) * L1P + 1024 + h * 64;
        float z = 0.f;
#pragma unroll
        for (int d = 0; d < 64; ++d) z += q[d] * bf2f(kr[d]);
        if (s < t) {
            const float lsp = -softplusf_(-z);
            const float lsn = -softplusf_(z);
            const float att = expf(lsp + cum);
            cum += lsn;
#pragma unroll
            for (int d = 0; d < 64; ++d) o[d] += att * bf2f(vr[d]);
        }
    }
#pragma unroll
    for (int d = 0; d < 64; ++d) ymix[(mrow + t) * DM + h * 64 + d] = (bf16_t)f2bf(o[d]);
}
__device__ __forceinline__ void mla_naive_task(int qblk, int bh, int lane, const bf16_t* __restrict__ qm, const bf16_t* __restrict__ kvm, const bf16_t* __restrict__ kpe, bf16_t* __restrict__ ymix) {
    const int b = bh >> 3, h = bh & 7, t = qblk * 64 + lane;
    const size_t mrow = (size_t)b * SEQ;
    const float scale = 0.10206207261596577f;
    float q[96], o[64];
#pragma unroll
    for (int d = 0; d < 96; ++d) q[d] = bf2f(qm[(mrow + t) * 768 + h * 96 + d]) * scale;
#pragma unroll
    for (int d = 0; d < 64; ++d) o[d] = 0.f;
    float mx = -1e30f, l = 0.f;
    const int smax = qblk * 64 + 63;
    for (int s = 0; s <= smax; ++s) {
        const bf16_t* kr = kvm + (mrow + s) * 1024 + h * 128;
        const bf16_t* pr = kpe + (mrow + s) * 32;
        float z = 0.f;
#pragma unroll
        for (int d = 0; d < 64; ++d) z += q[d] * bf2f(kr[d]);
#pragma unroll
        for (int d = 0; d < 32; ++d) z += q[64 + d] * bf2f(pr[d]);
        if (s <= t) {
            const float mn = fmaxf(mx, z), f = expf(mx - mn), pz = expf(z - mn);
            l = l * f + pz; mx = mn;
#pragma unroll
            for (int d = 0; d < 64; ++d) o[d] = o[d] * f + pz * bf2f(kr[64 + d]);
        }
    }
    const float il = 1.f / l;
#pragma unroll
    for (int d = 0; d < 64; ++d) ymix[(mrow + t) * DM + 512 + h * 64 + d] = (bf16_t)f2bf(o[d] * il);
}


__device__ __forceinline__ int crow(int r, int hi) { return (r & 3) + 8 * (r >> 2) + 4 * hi; }
#define MFMA32(a, b, c) __builtin_amdgcn_mfma_f32_32x32x16_bf16((a), (b), (c), 0, 0, 0)
constexpr int STG_PITCH = 72;
__device__ __forceinline__ void transpose_tile64(const bf16_t* __restrict__ src, int sp, bf16_t* __restrict__ dst, int dp, LAS bf16_t* scr, int lane) {
#pragma unroll
    for (int i = 0; i < 8; ++i) { const int row = i * 8 + (lane >> 3), ch = lane & 7; const v4u v = *(const v4u*)(src + (size_t)row * sp + ch * 8); *(LAS v4u*)(scr + row * STG_PITCH + ch * 8) = v; }
    WSYNC();
#pragma unroll
    for (int i = 0; i < 8; ++i) { const int d = i * 8 + (lane >> 3), tc = lane & 7; const LAS bf16_t* p = scr + (tc * 8) * STG_PITCH + d;
        v4u o; o.x = (unsigned)p[0] | ((unsigned)p[STG_PITCH] << 16); o.y = (unsigned)p[2 * STG_PITCH] | ((unsigned)p[3 * STG_PITCH] << 16);
        o.z = (unsigned)p[4 * STG_PITCH] | ((unsigned)p[5 * STG_PITCH] << 16); o.w = (unsigned)p[6 * STG_PITCH] | ((unsigned)p[7 * STG_PITCH] << 16);
        *(v4u*)(dst + (size_t)d * dp + tc * 8) = o; }
    WSYNC();
}
__device__ __forceinline__ void store_OT(const f32x16 (&o)[2], float sc, LAS bf16_t* stg, bf16_t* __restrict__ dst, int lane) {
    const int l31 = lane & 31, hi = lane >> 5;
#pragma unroll
    for (int dt = 0; dt < 2; ++dt)
#pragma unroll
        for (int r = 0; r < 16; ++r) stg[l31 * STG_PITCH + 32 * dt + crow(r, hi)] = (bf16_t)f2bf(o[dt][r] * sc);
    WSYNC();
#pragma unroll
    for (int i = 0; i < 4; ++i) { const int row = i * 8 + (lane >> 3), ch = lane & 7; const v4u v = *(const LAS v4u*)(stg + row * STG_PITCH + ch * 8); *(v4u*)(dst + (size_t)row * DM + ch * 8) = v; }
    WSYNC();
}
__device__ __forceinline__ float softplus_fast(float z) { return fmaxf(z, 0.f) + __logf(1.f + __expf(-fabsf(z))); }

__device__ __forceinline__ void sb_task(int bh, int qblk, int lane, const bf16_t* __restrict__ P1, const bf16_t* __restrict__ VT, bf16_t* __restrict__ ymix, LAS bf16_t* stg) {
    const int b = bh >> 3, h = bh & 7, l31 = lane & 31, hi = lane >> 5, q0 = qblk * 32, t = q0 + l31;
    const size_t rowb = (size_t)b * SEQ;
    const bf16_t* Qp = P1 + (rowb + q0 + l31) * L1P + h * 64 + 8 * hi;
    bf16x8 qf[4];
#pragma unroll
    for (int kk = 0; kk < 4; ++kk) qf[kk] = *(const bf16x8*)(Qp + 16 * kk);
    const bf16_t* Kp = P1 + (rowb + l31) * L1P + 512 + h * 64 + 8 * hi;
    const bf16_t* Vp = VT + ((size_t)bh * 64 + l31) * SEQ + 4 * hi;
    f32x16 o[2];
#pragma unroll
    for (int r = 0; r < 16; ++r) { o[0][r] = 0.f; o[1][r] = 0.f; }
    float cum = 0.f;
    bf16x8 kf[4]; u32x2 va[2][2][2];
#define SB_LOAD(S0, KF, VA) do { _Pragma("unroll") for (int kk = 0; kk < 4; ++kk) KF[kk] = *(const bf16x8*)(Kp + (size_t)(S0) * L1P + 16 * kk); \
        _Pragma("unroll") for (int dt = 0; dt < 2; ++dt) _Pragma("unroll") for (int ks = 0; ks < 2; ++ks) { VA[dt][ks][0] = *(const u32x2*)(Vp + (size_t)dt * 32 * SEQ + (S0) + 16 * ks); VA[dt][ks][1] = *(const u32x2*)(Vp + (size_t)dt * 32 * SEQ + (S0) + 16 * ks + 8); } } while (0)
    SB_LOAD(q0, kf, va);
    for (int s0 = q0; s0 >= 0; s0 -= 32) {
        bf16x8 kn[4]; u32x2 vn[2][2][2];
        const int sn = (s0 >= 32) ? s0 - 32 : 0;
        SB_LOAD(sn, kn, vn);
        f32x16 acc;
#pragma unroll
        for (int r = 0; r < 16; ++r) acc[r] = 0.f;
#pragma unroll
        for (int kk = 0; kk < 4; ++kk) acc = MFMA32(kf[kk], qf[kk], acc);
        const bool diag = (s0 == q0);
        float lb[16], lk[16];
#pragma unroll
        for (int r = 0; r < 16; ++r) { const float z = acc[r] * 0.125f; const float sp = softplus_fast(z); float b_ = z - sp, k_ = -sp;
            if (diag) { const bool valid = (s0 + crow(r, hi)) < t; b_ = valid ? b_ : -1e30f; k_ = valid ? k_ : 0.f; }
            lb[r] = b_; lk[r] = k_; }
        float e[16], T[4], U[4];
#pragma unroll
        for (int i = 0; i < 4; ++i) { e[4 * i + 3] = 0.f; e[4 * i + 2] = lk[4 * i + 3]; e[4 * i + 1] = e[4 * i + 2] + lk[4 * i + 2]; e[4 * i] = e[4 * i + 1] + lk[4 * i + 1]; T[i] = e[4 * i] + lk[4 * i]; }
#pragma unroll
        for (int i = 0; i < 4; ++i) U[i] = __shfl_xor(T[i], 32);
        float off[4];
        { const float st2 = T[3], st1 = st2 + T[2], st0 = st1 + T[1]; const float su2 = U[3], su1 = su2 + U[2], su0 = su1 + U[1];
          const float x0 = hi ? 0.f : U[0], x1 = hi ? 0.f : U[1], x2 = hi ? 0.f : U[2], x3 = hi ? 0.f : U[3];
          off[3] = x3; off[2] = st2 + su2 + x2; off[1] = st1 + su1 + x1; off[0] = st0 + su0 + x0;
          const float total = st0 + T[0] + su0 + U[0];
#pragma unroll
          for (int r = 0; r < 16; ++r) acc[r] = __expf(lb[r] + (cum + off[r >> 2] + e[r]));
          cum += total; }
        bf16x8 pf[2];
#pragma unroll
        for (int ks = 0; ks < 2; ++ks) { v4u w; w.x = cvtpk(acc[8 * ks], acc[8 * ks + 1]); w.y = cvtpk(acc[8 * ks + 2], acc[8 * ks + 3]); w.z = cvtpk(acc[8 * ks + 4], acc[8 * ks + 5]); w.w = cvtpk(acc[8 * ks + 6], acc[8 * ks + 7]); pf[ks] = __builtin_bit_cast(bf16x8, w); }
#pragma unroll
        for (int dt = 0; dt < 2; ++dt)
#pragma unroll
            for (int ks = 0; ks < 2; ++ks) { v4u a; a.x = va[dt][ks][0].x; a.y = va[dt][ks][0].y; a.z = va[dt][ks][1].x; a.w = va[dt][ks][1].y; o[dt] = MFMA32(__builtin_bit_cast(bf16x8, a), pf[ks], o[dt]); }
        if (__all(cum < -110.f)) break;
#pragma unroll
        for (int kk = 0; kk < 4; ++kk) kf[kk] = kn[kk];
#pragma unroll
        for (int dt = 0; dt < 2; ++dt)
#pragma unroll
            for (int ks = 0; ks < 2; ++ks) { va[dt][ks][0] = vn[dt][ks][0]; va[dt][ks][1] = vn[dt][ks][1]; }
    }
#undef SB_LOAD
    store_OT(o, 1.0f, stg, ymix + (rowb + q0) * DM + h * 64, lane);
}
__device__ __forceinline__ void mla_task(int bh, int qblk, int lane, const bf16_t* __restrict__ QM, const bf16_t* __restrict__ KVM, const bf16_t* __restrict__ KPE, const bf16_t* __restrict__ VT,
                                         bf16_t* __restrict__ ymix, LAS bf16_t* stg) {
    const int b = bh >> 3, h = bh & 7, l31 = lane & 31, hi = lane >> 5, q0 = qblk * 32, t = q0 + l31;
    const size_t rowb = (size_t)b * SEQ;
    const bf16_t* Qp = QM + (rowb + q0 + l31) * 768 + h * 96 + 8 * hi;
    bf16x8 qf[6];
#pragma unroll
    for (int kk = 0; kk < 6; ++kk) qf[kk] = *(const bf16x8*)(Qp + 16 * kk);
    const bf16_t* Kn = KVM + (rowb + l31) * 1024 + h * 128 + 8 * hi;
    const bf16_t* Kr = KPE + (rowb + l31) * 32 + 8 * hi;
    const bf16_t* Vp = VT + ((size_t)bh * 64 + l31) * SEQ + 4 * hi;
    const float sc2 = 0.10206207261596577f * 1.4426950408889634f;
    f32x16 o[2];
#pragma unroll
    for (int r = 0; r < 16; ++r) { o[0][r] = 0.f; o[1][r] = 0.f; }
    float mrun = -1e30f, lsum = 0.f;
    bf16x8 kf[6]; u32x2 va[2][2][2];
#define ML_LOAD(S0, KF, VA) do { _Pragma("unroll") for (int kk = 0; kk < 4; ++kk) KF[kk] = *(const bf16x8*)(Kn + (size_t)(S0) * 1024 + 16 * kk); \
        _Pragma("unroll") for (int kk = 0; kk < 2; ++kk) KF[4 + kk] = *(const bf16x8*)(Kr + (size_t)(S0) * 32 + 16 * kk); \
        _Pragma("unroll") for (int dt = 0; dt < 2; ++dt) _Pragma("unroll") for (int ks = 0; ks < 2; ++ks) { VA[dt][ks][0] = *(const u32x2*)(Vp + (size_t)dt * 32 * SEQ + (S0) + 16 * ks); VA[dt][ks][1] = *(const u32x2*)(Vp + (size_t)dt * 32 * SEQ + (S0) + 16 * ks + 8); } } while (0)
    ML_LOAD(0, kf, va);
    for (int s0 = 0; s0 <= q0; s0 += 32) {
        bf16x8 kn[6]; u32x2 vn[2][2][2];
        const int sn = (s0 + 32 <= q0) ? s0 + 32 : s0;
        ML_LOAD(sn, kn, vn);
        f32x16 acc;
#pragma unroll
        for (int r = 0; r < 16; ++r) acc[r] = 0.f;
#pragma unroll
        for (int kk = 0; kk < 6; ++kk) acc = MFMA32(kf[kk], qf[kk], acc);
        const bool diag = (s0 == q0);
        float tmax = -1e30f;
#pragma unroll
        for (int r = 0; r < 16; ++r) { float z = acc[r] * sc2; if (diag && (s0 + crow(r, hi)) > t) z = -1e30f; acc[r] = z; tmax = fmaxf(tmax, z); }
        tmax = fmaxf(tmax, __shfl_xor(tmax, 32));
        const float mn = fmaxf(mrun, tmax), alpha = exp2f(mrun - mn); mrun = mn;
        float ps = 0.f;
#pragma unroll
        for (int r = 0; r < 16; ++r) { acc[r] = exp2f(acc[r] - mn); ps += acc[r]; }
        lsum = lsum * alpha + ps;
#pragma unroll
        for (int r = 0; r < 16; ++r) { o[0][r] *= alpha; o[1][r] *= alpha; }
        bf16x8 pf[2];
#pragma unroll
        for (int ks = 0; ks < 2; ++ks) { v4u w; w.x = cvtpk(acc[8 * ks], acc[8 * ks + 1]); w.y = cvtpk(acc[8 * ks + 2], acc[8 * ks + 3]); w.z = cvtpk(acc[8 * ks + 4], acc[8 * ks + 5]); w.w = cvtpk(acc[8 * ks + 6], acc[8 * ks + 7]); pf[ks] = __builtin_bit_cast(bf16x8, w); }
#pragma unroll
        for (int dt = 0; dt < 2; ++dt)
#pragma unroll
            for (int ks = 0; ks < 2; ++ks) { v4u a; a.x = va[dt][ks][0].x; a.y = va[dt][ks][0].y; a.z = va[dt][ks][1].x; a.w = va[dt][ks][1].y; o[dt] = MFMA32(__builtin_bit_cast(bf16x8, a), pf[ks], o[dt]); }
#pragma unroll
        for (int kk = 0; kk < 6; ++kk) kf[kk] = kn[kk];
#pragma unroll
        for (int dt = 0; dt < 2; ++dt)
#pragma unroll
            for (int ks = 0; ks < 2; ++ks) { va[dt][ks][0] = vn[dt][ks][0]; va[dt][ks][1] = vn[dt][ks][1]; }
    }
#undef ML_LOAD
    lsum += __shfl_xor(lsum, 32);
    store_OT(o, 1.0f / lsum, stg, ymix + (rowb + q0) * DM + 512 + h * 64, lane);
}


constexpr int MLK_PITCH = 104, MLV_PITCH = 68, MLK_BYTES = 64 * MLK_PITCH * 2, MLV_BYTES = 64 * MLV_PITCH * 2, ML_STAGE = MLK_BYTES + MLV_BYTES;
__device__ __forceinline__ void mla_block(int bh, int sb, int tid, int lane, int wave, LAS unsigned char* lds, const bf16_t* __restrict__ QM, const bf16_t* __restrict__ KVM, const bf16_t* __restrict__ KPE,
                                          const bf16_t* __restrict__ VT, bf16_t* __restrict__ ymix) {
    const int b = bh >> 3, h = bh & 7, l31 = lane & 31, hi = lane >> 5, q0 = 256 * sb + 32 * wave, t = q0 + l31;
    const size_t rowb = (size_t)b * SEQ;
    const int nsteps = 4 * sb + 4;
    bf16x8 qf[6];
    { const bf16_t* Qp = QM + (rowb + q0 + l31) * 768 + h * 96 + 8 * hi;
#pragma unroll
      for (int kk = 0; kk < 6; ++kk) qf[kk] = *(const bf16x8*)(Qp + 16 * kk); }
    const float sc2 = 0.10206207261596577f * 1.4426950408889634f;
    f32x16 o[2];
#pragma unroll
    for (int r = 0; r < 16; ++r) { o[0][r] = 0.f; o[1][r] = 0.f; }
    float mrun = -1e30f, lsum = 0.f;
    const bf16_t* gKn = KVM + (rowb + (tid >> 3)) * 1024 + h * 128 + (tid & 7) * 8;
    const bf16_t* gKr = KPE + (rowb + ((tid & 255) >> 2)) * 32 + (tid & 3) * 8;
    const bf16_t* gVt = VT + ((size_t)bh * 64 + (tid >> 3)) * SEQ + (tid & 7) * 8;
    const int lKn = (tid >> 3) * (MLK_PITCH * 2) + (tid & 7) * 16, lKr = ((tid & 255) >> 2) * (MLK_PITCH * 2) + 128 + (tid & 3) * 16, lVt = MLK_BYTES + (tid >> 3) * (MLV_PITCH * 2) + (tid & 7) * 16;
    v4u rk, rr, rv;
    rk = *(const v4u*)gKn; rr = *(const v4u*)gKr; rv = *(const v4u*)gVt;
    *(LAS v4u*)(lds + lKn) = rk; if (tid < 256) *(LAS v4u*)(lds + lKr) = rr; *(LAS u32x2*)(lds + lVt) = (u32x2){rv.x, rv.y}; *(LAS u32x2*)(lds + lVt + 8) = (u32x2){rv.z, rv.w};
    __syncthreads();
#pragma unroll 1
    for (int step = 0; step < nsteps; ++step) {
        const int nx = (step + 1 < nsteps) ? step + 1 : step;
        rk = *(const v4u*)(gKn + (size_t)nx * 64 * 1024); rr = *(const v4u*)(gKr + (size_t)nx * 64 * 32); rv = *(const v4u*)(gVt + nx * 64);
        const LAS unsigned char* Kb = lds + (step & 1) * ML_STAGE;
        const LAS unsigned char* Vb = Kb + MLK_BYTES;
#pragma unroll
        for (int sub = 0; sub < 2; ++sub) {
            const int s0 = 64 * step + 32 * sub;
            if (s0 <= q0) {
                f32x16 acc;
#pragma unroll
                for (int r = 0; r < 16; ++r) acc[r] = 0.f;
#pragma unroll
                for (int kk = 0; kk < 6; ++kk) { const bf16x8 kf = *(const LAS bf16x8*)(Kb + (32 * sub + l31) * (MLK_PITCH * 2) + (16 * kk + 8 * hi) * 2); acc = MFMA32(kf, qf[kk], acc); }
                const bool diag = (s0 == q0);
                float tmax = -1e30f;
#pragma unroll
                for (int r = 0; r < 16; ++r) { float z = acc[r] * sc2; if (diag && (s0 + crow(r, hi)) > t) z = -1e30f; acc[r] = z; tmax = fmaxf(tmax, z); }
                tmax = fmaxf(tmax, __shfl_xor(tmax, 32));
                const float mn = fmaxf(mrun, tmax), alpha = __builtin_amdgcn_exp2f(mrun - mn); mrun = mn;
                float ps = 0.f;
#pragma unroll
                for (int r = 0; r < 16; ++r) { acc[r] = __builtin_amdgcn_exp2f(acc[r] - mn); ps += acc[r]; }
                lsum = lsum * alpha + ps;
#pragma unroll
                for (int r = 0; r < 16; ++r) { o[0][r] *= alpha; o[1][r] *= alpha; }
                bf16x8 pf[2];
#pragma unroll
                for (int ks = 0; ks < 2; ++ks) { v4u w; w.x = cvtpk(acc[8 * ks], acc[8 * ks + 1]); w.y = cvtpk(acc[8 * ks + 2], acc[8 * ks + 3]); w.z = cvtpk(acc[8 * ks + 4], acc[8 * ks + 5]); w.w = cvtpk(acc[8 * ks + 6], acc[8 * ks + 7]); pf[ks] = __builtin_bit_cast(bf16x8, w); }
#pragma unroll
                for (int dt = 0; dt < 2; ++dt)
#pragma unroll
                    for (int ks = 0; ks < 2; ++ks) { const LAS unsigned char* vp = Vb + (32 * dt + l31) * (MLV_PITCH * 2) + (32 * sub + 16 * ks + 4 * hi) * 2;
                        const u32x2 x0 = *(const LAS u32x2*)vp, x1 = *(const LAS u32x2*)(vp + 16);
                        v4u a; a.x = x0.x; a.y = x0.y; a.z = x1.x; a.w = x1.y; o[dt] = MFMA32(__builtin_bit_cast(bf16x8, a), pf[ks], o[dt]); }
            }
        }
        LAS unsigned char* nb = lds + ((step + 1) & 1) * ML_STAGE;
        *(LAS v4u*)(nb + lKn) = rk; if (tid < 256) *(LAS v4u*)(nb + lKr) = rr; *(LAS u32x2*)(nb + lVt) = (u32x2){rv.x, rv.y}; *(LAS u32x2*)(nb + lVt + 8) = (u32x2){rv.z, rv.w};
        __syncthreads();
    }
    lsum += __shfl_xor(lsum, 32);
    store_OT(o, 1.0f / lsum, (LAS bf16_t*)(lds + 2 * ML_STAGE) + wave * (32 * STG_PITCH), ymix + (rowb + q0) * DM + 512 + h * 64, lane);
    __syncthreads();
}


constexpr int SBK_PITCH = 72, SBK_BYTES = 64 * SBK_PITCH * 2, SB_STAGE = SBK_BYTES + MLV_BYTES;
__device__ __forceinline__ void sb_block(int bh, int sb, int tid, int lane, int wave, LAS unsigned char* lds, const bf16_t* __restrict__ P1, const bf16_t* __restrict__ VT, bf16_t* __restrict__ ymix) {
    const int b = bh >> 3, h = bh & 7, l31 = lane & 31, hi = lane >> 5, q0 = 256 * sb + 32 * wave, t = q0 + l31;
    const size_t rowb = (size_t)b * SEQ;
    bf16x8 qf[4];
    { const bf16_t* Qp = P1 + (rowb + q0 + l31) * L1P + h * 64 + 8 * hi;
#pragma unroll
      for (int kk = 0; kk < 4; ++kk) qf[kk] = *(const bf16x8*)(Qp + 16 * kk); }
    f32x16 o[2];
#pragma unroll
    for (int r = 0; r < 16; ++r) { o[0][r] = 0.f; o[1][r] = 0.f; }
    float cum = 0.f; bool done = false;
    volatile LAS unsigned* flags = (volatile LAS unsigned*)(lds + 2 * SB_STAGE);
    const bf16_t* gK = P1 + (rowb + (tid >> 3)) * L1P + 512 + h * 64 + (tid & 7) * 8;
    const bf16_t* gVt = VT + ((size_t)bh * 64 + (tid >> 3)) * SEQ + (tid & 7) * 8;
    const int lK = (tid >> 3) * (SBK_PITCH * 2) + (tid & 7) * 16, lVt = SBK_BYTES + (tid >> 3) * (MLV_PITCH * 2) + (tid & 7) * 16;
    const int top = 4 * sb + 3;
    v4u rk, rv;
    rk = *(const v4u*)(gK + (size_t)top * 64 * L1P); rv = *(const v4u*)(gVt + top * 64);
    *(LAS v4u*)(lds + lK) = rk; *(LAS u32x2*)(lds + lVt) = (u32x2){rv.x, rv.y}; *(LAS u32x2*)(lds + lVt + 8) = (u32x2){rv.z, rv.w};
    __syncthreads();
#pragma unroll 1
    for (int i = 0; i <= top; ++i) {
        const int step = top - i, nx = (step > 0) ? step - 1 : 0;
        rk = *(const v4u*)(gK + (size_t)nx * 64 * L1P); rv = *(const v4u*)(gVt + nx * 64);
        const LAS unsigned char* Kb = lds + (i & 1) * SB_STAGE;
        const LAS unsigned char* Vb = Kb + SBK_BYTES;
#pragma unroll
        for (int sub = 1; sub >= 0; --sub) {
            const int s0 = 64 * step + 32 * sub;
            if (s0 <= q0 && !done) {
                f32x16 acc;
#pragma unroll
                for (int r = 0; r < 16; ++r) acc[r] = 0.f;
#pragma unroll
                for (int kk = 0; kk < 4; ++kk) { const bf16x8 kf = *(const LAS bf16x8*)(Kb + (32 * sub + l31) * (SBK_PITCH * 2) + (16 * kk + 8 * hi) * 2); acc = MFMA32(kf, qf[kk], acc); }
                const bool diag = (s0 == q0);
                float lb[16], lk[16];
#pragma unroll
                for (int r = 0; r < 16; ++r) { const float z = acc[r] * 0.125f; const float sp = softplus_fast(z); float b_ = z - sp, k_ = -sp;
                    if (diag) { const bool valid = (s0 + crow(r, hi)) < t; b_ = valid ? b_ : -1e30f; k_ = valid ? k_ : 0.f; }
                    lb[r] = b_; lk[r] = k_; }
                float e[16], T[4], U[4];
#pragma unroll
                for (int q = 0; q < 4; ++q) { e[4 * q + 3] = 0.f; e[4 * q + 2] = lk[4 * q + 3]; e[4 * q + 1] = e[4 * q + 2] + lk[4 * q + 2]; e[4 * q] = e[4 * q + 1] + lk[4 * q + 1]; T[q] = e[4 * q] + lk[4 * q]; }
#pragma unroll
                for (int q = 0; q < 4; ++q) U[q] = __shfl_xor(T[q], 32);
                { const float st2 = T[3], st1 = st2 + T[2], st0 = st1 + T[1]; const float su2 = U[3], su1 = su2 + U[2], su0 = su1 + U[1];
                  const float x0 = hi ? 0.f : U[0], x1 = hi ? 0.f : U[1], x2 = hi ? 0.f : U[2], x3 = hi ? 0.f : U[3];
                  const float off[4] = {st0 + su0 + x0, st1 + su1 + x1, st2 + su2 + x2, x3};
                  const float total = st0 + T[0] + su0 + U[0];
#pragma unroll
                  for (int r = 0; r < 16; ++r) acc[r] = __expf(lb[r] + (cum + off[r >> 2] + e[r]));
                  cum += total; }
                bf16x8 pf[2];
#pragma unroll
                for (int ks = 0; ks < 2; ++ks) { v4u w; w.x = cvtpk(acc[8 * ks], acc[8 * ks + 1]); w.y = cvtpk(acc[8 * ks + 2], acc[8 * ks + 3]); w.z = cvtpk(acc[8 * ks + 4], acc[8 * ks + 5]); w.w = cvtpk(acc[8 * ks + 6], acc[8 * ks + 7]); pf[ks] = __builtin_bit_cast(bf16x8, w); }
#pragma unroll
                for (int dt = 0; dt < 2; ++dt)
#pragma unroll
                    for (int ks = 0; ks < 2; ++ks) { const LAS unsigned char* vp = Vb + (32 * dt + l31) * (MLV_PITCH * 2) + (32 * sub + 16 * ks + 4 * hi) * 2;
                        const u32x2 x0 = *(const LAS u32x2*)vp, x1 = *(const LAS u32x2*)(vp + 16);
                        v4u a; a.x = x0.x; a.y = x0.y; a.z = x1.x; a.w = x1.y; o[dt] = MFMA32(__builtin_bit_cast(bf16x8, a), pf[ks], o[dt]); }
                done = __all(cum < -110.f);
            }
        }
        if (lane == 0) flags[(i & 1) * 8 + wave] = done ? 1u : 0u;
        LAS unsigned char* nb = lds + ((i + 1) & 1) * SB_STAGE;
        *(LAS v4u*)(nb + lK) = rk; *(LAS u32x2*)(nb + lVt) = (u32x2){rv.x, rv.y}; *(LAS u32x2*)(nb + lVt + 8) = (u32x2){rv.z, rv.w};
        __syncthreads();
        unsigned nd = 0;
#pragma unroll
        for (int w8 = 0; w8 < 8; ++w8) nd += flags[(i & 1) * 8 + w8];
        if (nd == 8u) break;
    }
    store_OT(o, 1.0f, (LAS bf16_t*)(lds + 2 * SB_STAGE + 256) + wave * (32 * STG_PITCH), ymix + (rowb + q0) * DM + h * 64, lane);
    __syncthreads();
}

constexpr int RW_RAWW = 0, RW_RAWA = 2048, RW_RS = 4096, RW_KS = 6144, RW_VS = 8192;
constexpr int RW_CH0 = 10240, RW_CHSZ = 11328;
constexpr int RW_YB = RW_CH0 + 2 * RW_CHSZ;
constexpr int RW_MIX = RW_YB + 1024;
static_assert((RW_MIX + 256) * 4 <= 146432, "rwkv LDS map");
template <int CTRL> __device__ __forceinline__ float dpp_mov(float x) { return __builtin_bit_cast(float, __builtin_amdgcn_update_dpp(0, __builtin_bit_cast(int, x), CTRL, 0xF, 0xF, true)); }
__device__ __forceinline__ float rowsum16(float x) { x += dpp_mov<0x128>(x); x += dpp_mov<0x124>(x); x += dpp_mov<0x122>(x); x += dpp_mov<0x121>(x); return x; }
__device__ __forceinline__ float rl(float x, int l) { return __builtin_bit_cast(float, __builtin_amdgcn_readlane(__builtin_bit_cast(int, x), l)); }
__device__ __forceinline__ float wave_sum_dpp(float x) { x = rowsum16(x); return (rl(x, 0) + rl(x, 16)) + (rl(x, 32) + rl(x, 48)); }
__device__ __forceinline__ float tanh_fast(float x) { return 1.f - 2.f / (1.f + __expf(2.f * x)); }
__device__ __forceinline__ float sigmoid_fast(float x) { return 1.f / (1.f + __expf(-x)); }

#define MFMA16(a, b, c) __builtin_amdgcn_mfma_f32_16x16x32_bf16((a), (b), (c), 0, 0, 0)
constexpr int RW2_CH0 = 0, RW2_YB = 2 * RW_CHSZ, RW2_MIX = RW2_YB + 1024, RW2_STG = RW2_MIX + 448;
static_assert((RW2_STG + 2 * 3072) * 4 <= 146432, "rwkv LDS map");
__device__ __forceinline__ void rwkv_phase(LAS float* sm, int tid, int lane, int wave, int blk, const bf16_t* __restrict__ proj, const float* __restrict__ mix, const float* __restrict__ w0, const float* __restrict__ a0,
                                           const float* __restrict__ k_k, const float* __restrict__ k_a, const float* __restrict__ r_k, const bf16_t* __restrict__ W2T, const bf16_t* __restrict__ A2T, const bf16_t* __restrict__ G2T,
                                           float* __restrict__ yraw, bf16_t* __restrict__ gout, float* __restrict__ bonus_out) {
    const int chain = blk >> 1, half = blk & 1, b = chain >> 3, h = chain & 7, l15 = lane & 15, kg = lane >> 4;
    const size_t rowb = (size_t)b * SEQ;
    constexpr int NCHUNK = SEQ / 32;
    if (tid < 256) sm[RW2_MIX + tid] = mix[1536 + tid];
    else if (tid < 448) { const int q = tid - 256; sm[RW2_MIX + tid] = mix[512 * (q >> 6) + h * 64 + (q & 63)]; }
    __syncthreads();
#define RW_SH8(CUR, PRV, M0, M1, OUT, PZ) do { const unsigned cu_[4] = {(CUR).x, (CUR).y, (CUR).z, (CUR).w}, pu_[4] = {(PRV).x, (PRV).y, (PRV).z, (PRV).w}; \
        const float mm_[8] = {(M0)[0], (M0)[1], (M0)[2], (M0)[3], (M1)[0], (M1)[1], (M1)[2], (M1)[3]}; \
        _Pragma("unroll") for (int q = 0; q < 4; ++q) { const float c0 = bflo(cu_[q]), c1 = bfhi(cu_[q]), p0 = bflo(pu_[q]) * (PZ), p1 = bfhi(pu_[q]) * (PZ); \
            OUT[2 * q] = c0 + (p0 - c0) * mm_[2 * q]; OUT[2 * q + 1] = c1 + (p1 - c1) * mm_[2 * q + 1]; } } while (0)
    if (wave < 4) {
        const int iA = 8 * wave + kg, iB = iA + 4, jseg = l15;
        float A0 = 0.f, A1 = 0.f, A2 = 0.f, A3 = 0.f, B0 = 0.f, B1 = 0.f, B2 = 0.f, B3 = 0.f;
        __syncthreads();
#pragma unroll 1
        for (int ch = 0; ch < NCHUNK; ++ch) {
            const int t0 = ch * 32;
            const LAS float* CHb = sm + RW2_CH0 + (ch & 1) * RW_CHSZ + 4 * jseg;
            const LAS float* CHv = sm + RW2_CH0 + (ch & 1) * RW_CHSZ + 10240 + iA;
            const LAS float* CHs = sm + RW2_CH0 + (ch & 1) * RW_CHSZ + 11264;
            f32x4 a4 = *(const LAS f32x4*)(CHb + 4096), wr4 = *(const LAS f32x4*)(CHb + 8192), w4 = *(const LAS f32x4*)(CHb), b4 = *(const LAS f32x4*)(CHb + 6144), k4 = *(const LAS f32x4*)(CHb + 2048);
            float vA = CHv[0], vB = CHv[4]; f32x2_t sc = *(const LAS f32x2_t*)(CHs);
#pragma unroll 2
            for (int t = 0; t < 32; ++t) {
                const int tq = (t + 1) & 31;
                const f32x4 a4n = *(const LAS f32x4*)(CHb + 4096 + tq * 64), wr4n = *(const LAS f32x4*)(CHb + 8192 + tq * 64), w4n = *(const LAS f32x4*)(CHb + tq * 64),
                            b4n = *(const LAS f32x4*)(CHb + 6144 + tq * 64), k4n = *(const LAS f32x4*)(CHb + 2048 + tq * 64);
                const float vAn = CHv[tq * 32], vBn = CHv[tq * 32 + 4]; const f32x2_t scn = *(const LAS f32x2_t*)(CHs + 2 * tq);
                float d1A = (A0 * a4[0] + A1 * a4[1]) + (A2 * a4[2] + A3 * a4[3]), d1B = (B0 * a4[0] + B1 * a4[1]) + (B2 * a4[2] + B3 * a4[3]);
                float d2A = (A0 * wr4[0] + A1 * wr4[1]) + (A2 * wr4[2] + A3 * wr4[3]), d2B = (B0 * wr4[0] + B1 * wr4[1]) + (B2 * wr4[2] + B3 * wr4[3]);
                d1A = rowsum16(d1A); d1B = rowsum16(d1B); d2A = rowsum16(d2A); d2B = rowsum16(d2B);
                const float yA = d2A + d1A * sc[0] + vA * sc[1], yB = d2B + d1B * sc[0] + vB * sc[1];
                A0 = A0 * w4[0] + (d1A * b4[0] + vA * k4[0]); A1 = A1 * w4[1] + (d1A * b4[1] + vA * k4[1]); A2 = A2 * w4[2] + (d1A * b4[2] + vA * k4[2]); A3 = A3 * w4[3] + (d1A * b4[3] + vA * k4[3]);
                B0 = B0 * w4[0] + (d1B * b4[0] + vB * k4[0]); B1 = B1 * w4[1] + (d1B * b4[1] + vB * k4[1]); B2 = B2 * w4[2] + (d1B * b4[2] + vB * k4[2]); B3 = B3 * w4[3] + (d1B * b4[3] + vB * k4[3]);
                if (jseg == 0) { sm[RW2_YB + t * 32 + iA] = yA; sm[RW2_YB + t * 32 + iB] = yB; }
                a4 = a4n; wr4 = wr4n; w4 = w4n; b4 = b4n; k4 = k4n; vA = vAn; vB = vBn; sc = scn;
            }
            WSYNC();
            { const int tt = lane >> 1, hh = lane & 1; const f32x4 yv = *(const LAS f32x4*)(sm + RW2_YB + tt * 32 + 8 * wave + 4 * hh);
              *(f32x4*)(yraw + (rowb + t0 + tt) * 512 + h * 64 + half * 32 + 8 * wave + 4 * hh) = yv; }
            __syncthreads();
        }
    } else if (wave < 6) {
        const int tp = wave - 4, tb = 16 * tp;
        LAS float* stg = sm + RW2_STG + tp * 3072;
        float w0c[4], a0c[4], kkc[4], kac[4], rkc[4];
#pragma unroll
        for (int nt = 0; nt < 4; ++nt) { const int c = h * 64 + 16 * nt + l15; w0c[nt] = w0[c]; a0c[nt] = a0[c]; kkc[nt] = k_k[c]; kac[nt] = k_a[c]; rkc[nt] = r_k[c]; }
        v4u ld[20];
#define PREP_ISSUE(T0) do { const int t0_ = (T0); { const size_t r_ = rowb + t0_ + tb + l15; const size_t rp_ = (t0_ + tb + l15 == 0) ? r_ : r_ - 1; \
            _Pragma("unroll") for (int lo = 0; lo < 2; ++lo) _Pragma("unroll") for (int ks = 0; ks < 2; ++ks) { const int col = 1536 + 64 * lo + 32 * ks + 8 * kg; \
                ld[(lo * 2 + ks) * 2] = *(const v4u*)(proj + r_ * L0P + col); ld[(lo * 2 + ks) * 2 + 1] = *(const v4u*)(proj + rp_ * L0P + col); } } \
            _Pragma("unroll") for (int ar = 0; ar < 3; ++ar) _Pragma("unroll") for (int i = 0; i < 2; ++i) { const int p_ = lane + 64 * i, row_ = p_ >> 3, c8_ = p_ & 7; \
                const size_t r_ = rowb + t0_ + tb + row_; const size_t rp_ = (t0_ + tb + row_ == 0) ? r_ : r_ - 1; const int col = 512 * ar + h * 64 + 8 * c8_; \
                ld[8 + (ar * 2 + i) * 2] = *(const v4u*)(proj + r_ * L0P + col); ld[8 + (ar * 2 + i) * 2 + 1] = *(const v4u*)(proj + rp_ * L0P + col); } } while (0)
#define PREP_BUILD(T0, NB) do { const int t0_ = (T0); LAS float* CHn = sm + RW2_CH0 + (NB) * RW_CHSZ; \
            f32x4 accw[4], acca[4]; \
            _Pragma("unroll") for (int nt = 0; nt < 4; ++nt) { accw[nt] = (f32x4){0.f, 0.f, 0.f, 0.f}; acca[nt] = (f32x4){0.f, 0.f, 0.f, 0.f}; } \
            { const float pz_ = (t0_ + tb + l15 == 0) ? 0.f : 1.f; \
              _Pragma("unroll") for (int lo = 0; lo < 2; ++lo) _Pragma("unroll") for (int ks = 0; ks < 2; ++ks) { float s_[8]; \
                const f32x4 m0 = *(const LAS f32x4*)(sm + RW2_MIX + 64 * lo + 32 * ks + 8 * kg), m1 = *(const LAS f32x4*)(sm + RW2_MIX + 64 * lo + 32 * ks + 8 * kg + 4); \
                RW_SH8(ld[(lo * 2 + ks) * 2], ld[(lo * 2 + ks) * 2 + 1], m0, m1, s_, pz_); \
                if (lo == 0) { _Pragma("unroll") for (int j = 0; j < 8; ++j) s_[j] = tanh_fast(s_[j]); } \
                v4u aw; aw.x = cvtpk(s_[0], s_[1]); aw.y = cvtpk(s_[2], s_[3]); aw.z = cvtpk(s_[4], s_[5]); aw.w = cvtpk(s_[6], s_[7]); const bf16x8 af = __builtin_bit_cast(bf16x8, aw); \
                const bf16_t* WT = lo ? A2T : W2T; \
                _Pragma("unroll") for (int nt = 0; nt < 4; ++nt) { const bf16x8 bfr = *(const bf16x8*)(WT + (size_t)(h * 64 + 16 * nt + l15) * 64 + 32 * ks + 8 * kg); \
                    if (lo == 0) accw[nt] = MFMA16(af, bfr, accw[nt]); else acca[nt] = MFMA16(af, bfr, acca[nt]); } } } \
            _Pragma("unroll") for (int ar = 0; ar < 3; ++ar) _Pragma("unroll") for (int i = 0; i < 2; ++i) { const int p_ = lane + 64 * i, row_ = p_ >> 3, c8_ = p_ & 7; float s_[8]; \
                const float pz_ = (t0_ + tb + row_ == 0) ? 0.f : 1.f; const f32x4 m0 = *(const LAS f32x4*)(sm + RW2_MIX + 256 + ar * 64 + c8_ * 8), m1 = *(const LAS f32x4*)(sm + RW2_MIX + 256 + ar * 64 + c8_ * 8 + 4); \
                RW_SH8(ld[8 + (ar * 2 + i) * 2], ld[8 + (ar * 2 + i) * 2 + 1], m0, m1, s_, pz_); \
                *(LAS f32x4*)(stg + ar * 1024 + row_ * 64 + c8_ * 8) = (f32x4){s_[0], s_[1], s_[2], s_[3]}; *(LAS f32x4*)(stg + ar * 1024 + row_ * 64 + c8_ * 8 + 4) = (f32x4){s_[4], s_[5], s_[6], s_[7]}; } \
            WSYNC(); \
            PREP_ISSUE(((T0) + 32 < SEQ) ? (T0) + 32 : (T0)); \
            _Pragma("unroll") for (int rg = 0; rg < 4; ++rg) { const int tl = 4 * kg + rg, t = tb + tl; \
                float r_[4], k_[4], v_[4], kkv[4], nrm2 = 0.f; \
                _Pragma("unroll") for (int nt = 0; nt < 4; ++nt) { r_[nt] = stg[tl * 64 + 16 * nt + l15]; k_[nt] = stg[1024 + tl * 64 + 16 * nt + l15]; v_[nt] = stg[2048 + tl * 64 + 16 * nt + l15]; \
                    kkv[nt] = k_[nt] * kkc[nt]; nrm2 += kkv[nt] * kkv[nt]; } \
                nrm2 = rowsum16(nrm2); const float rn = __builtin_amdgcn_rsqf(fmaxf(nrm2, 1e-24f)); \
                float br = 0.f, kr = 0.f, bon = 0.f; \
                _Pragma("unroll") for (int nt = 0; nt < 4; ++nt) { const int j = 16 * nt + l15; \
                    const float wsum = w0c[nt] + accw[nt][rg]; const float logw = -softplus_fast(-wsum) - 0.5f; const float dec = __expf(-__expf(logw)); \
                    const float a_ = sigmoid_fast(a0c[nt] + acca[nt][rg]); const float kn = kkv[nt] * rn; \
                    const float k2 = k_[nt] * (1.f + (a_ - 1.f) * kac[nt]); const float bv = kn * a_; \
                    br += bv * r_[nt]; kr += k2 * r_[nt]; bon += r_[nt] * k2 * rkc[nt]; \
                    CHn[t * 64 + j] = dec; CHn[2048 + t * 64 + j] = k2; CHn[4096 + t * 64 + j] = -kn; CHn[6144 + t * 64 + j] = bv; CHn[8192 + t * 64 + j] = dec * r_[nt]; \
                    if ((nt >> 1) == half) CHn[10240 + t * 32 + (j & 31)] = v_[nt]; } \
                br = rowsum16(br); kr = rowsum16(kr); bon = rowsum16(bon); \
                if (l15 == 0) { CHn[11264 + 2 * t] = br; CHn[11264 + 2 * t + 1] = kr; if (half == 0) bonus_out[(rowb + t0_ + t) * 8 + h] = bon; } } \
            WSYNC(); } while (0)
        PREP_ISSUE(0);
        PREP_BUILD(0, 0);
        __syncthreads();
#pragma unroll 1
        for (int ch = 0; ch < NCHUNK; ++ch) {
            if (ch + 1 < NCHUNK) PREP_BUILD(ch * 32 + 32, (ch + 1) & 1);
            __syncthreads();
        }
#undef PREP_ISSUE
#undef PREP_BUILD
    } else {
        const int tp = wave - 6, tb = 16 * tp;
        v4u ld[8];
#define G_ISSUE(T0) do { const int t0_ = (T0); const size_t r_ = rowb + t0_ + tb + l15; const size_t rp_ = (t0_ + tb + l15 == 0) ? r_ : r_ - 1; \
            _Pragma("unroll") for (int ks = 0; ks < 4; ++ks) { const int col = 1664 + 32 * ks + 8 * kg; ld[2 * ks] = *(const v4u*)(proj + r_ * L0P + col); ld[2 * ks + 1] = *(const v4u*)(proj + rp_ * L0P + col); } } while (0)
#define G_BUILD(T0) do { const int t0_ = (T0); f32x4 accg[2] = {(f32x4){0.f, 0.f, 0.f, 0.f}, (f32x4){0.f, 0.f, 0.f, 0.f}}; const float pz_ = (t0_ + tb + l15 == 0) ? 0.f : 1.f; \
            _Pragma("unroll") for (int ks = 0; ks < 4; ++ks) { float s_[8]; \
                const f32x4 m0 = *(const LAS f32x4*)(sm + RW2_MIX + 128 + 32 * ks + 8 * kg), m1 = *(const LAS f32x4*)(sm + RW2_MIX + 128 + 32 * ks + 8 * kg + 4); \
                RW_SH8(ld[2 * ks], ld[2 * ks + 1], m0, m1, s_, pz_); \
                _Pragma("unroll") for (int j = 0; j < 8; ++j) s_[j] = sigmoid_fast(s_[j]); \
                v4u aw; aw.x = cvtpk(s_[0], s_[1]); aw.y = cvtpk(s_[2], s_[3]); aw.z = cvtpk(s_[4], s_[5]); aw.w = cvtpk(s_[6], s_[7]); const bf16x8 af = __builtin_bit_cast(bf16x8, aw); \
                _Pragma("unroll") for (int nt = 0; nt < 2; ++nt) { const bf16x8 bfr = *(const bf16x8*)(G2T + (size_t)(h * 64 + half * 32 + 16 * nt + l15) * 128 + 32 * ks + 8 * kg); accg[nt] = MFMA16(af, bfr, accg[nt]); } } \
            G_ISSUE(((T0) + 32 < SEQ) ? (T0) + 32 : (T0)); \
            _Pragma("unroll") for (int nt = 0; nt < 2; ++nt) _Pragma("unroll") for (int rg = 0; rg < 4; ++rg) \
                gout[(rowb + t0_ + tb + 4 * kg + rg) * 512 + h * 64 + half * 32 + 16 * nt + l15] = (bf16_t)f2bf(accg[nt][rg]); } while (0)
        G_ISSUE(0);
        G_BUILD(0);
        __syncthreads();
#pragma unroll 1
        for (int ch = 0; ch < NCHUNK; ++ch) {
            if (ch + 1 < NCHUNK) G_BUILD(ch * 32 + 32);
            __syncthreads();
        }
#undef G_ISSUE
#undef G_BUILD
    }
#undef RW_SH8
    __syncthreads();
}
template <bool ST = true> __device__ __forceinline__ void rwkv_post_all(const float* __restrict__ yraw, const bf16_t* __restrict__ proj, const float* __restrict__ mix, const float* __restrict__ bonus, const bf16_t* __restrict__ gbuf,
                                              const float* __restrict__ ln_g, const float* __restrict__ ln_b, bf16_t* __restrict__ ymix, int gw, int NGW, int lane) {
    for (int m = gw; m < M; m += NGW) {
        const bool has_prev = (m & (SEQ - 1)) != 0;
        float y[8], cv[8], pv[8], gg[8], bo[8];
#pragma unroll
        for (int h = 0; h < 8; ++h) { const int c = h * 64 + lane; y[h] = yraw[(size_t)m * 512 + c]; cv[h] = bf2f(proj[(size_t)m * L0P + 1024 + c]);
            pv[h] = bf2f(proj[(size_t)(has_prev ? m - 1 : m) * L0P + 1024 + c]); gg[h] = bf2f(gbuf[(size_t)m * 512 + c]); bo[h] = bonus[(size_t)m * 8 + h]; }
#pragma unroll
        for (int h = 0; h < 8; ++h) { const int c = h * 64 + lane;
            const float mu = wave_sum_dpp(y[h]) * (1.f / 64.f), d = y[h] - mu, var = wave_sum_dpp(d * d) * (1.f / 64.f);
            const float yn = d * __builtin_amdgcn_rsqf(var + 64e-5f) * ln_g[c] + ln_b[c];
            const float pvv = has_prev ? pv[h] : 0.f;
            const float v_s = cv[h] + (pvv - cv[h]) * mix[1024 + c];
            const float o = (yn + bo[h] * v_s) * gg[h];
            if (ST) ymix[(size_t)m * DM + c] = (bf16_t)f2bf(o); else asm volatile("" :: "v"(o)); }
    }
}


__device__ __forceinline__ void ssd_conv_tile(int it, int lane, LAS bf16_t* scr, const bf16_t* __restrict__ proj, const float* __restrict__ cw, const float* __restrict__ cb,
                                              bf16_t* __restrict__ xbc, bf16_t* __restrict__ xst, bf16_t* __restrict__ bt) {
    const int tt = it >> 4, ct = it & 15, m0 = tt * 64, b = m0 >> 11, t0 = m0 & (SEQ - 1), c = ct * 64 + lane;
    const float w0 = cw[c], w1 = cw[1024 + c], w2 = cw[2048 + c], w3 = cw[3072 + c], bias = cb[c];
    const bf16_t* src = proj + (size_t)m0 * L0P + 2304 + c;
    float u3 = 0.f, u2 = 0.f, u1 = 0.f;
    if (t0 > 0) { u3 = bf2f(src[-3 * L0P]); u2 = bf2f(src[-2 * L0P]); u1 = bf2f(src[-1 * L0P]); }
#pragma unroll 8
    for (int t = 0; t < 64; ++t) {
        const float u = bf2f(src[(size_t)t * L0P]);
        const float y = bias + w0 * u3 + w1 * u2 + w2 * u1 + w3 * u;
        const bf16_t o = (bf16_t)f2bf(y / (1.f + __expf(-y)));
        xbc[(size_t)(m0 + t) * 1024 + c] = o;
        scr[t * STG_PITCH + lane] = o;
        u3 = u2; u2 = u1; u1 = u;
    }
    WSYNC();
    if (ct < 12) {
        bf16_t* dst = (ct < 8) ? xst + ((size_t)(b * 8 + ct) * 64) * SEQ + t0 : bt + ((size_t)(b * 2 + ((ct - 8) >> 1)) * 128 + ((ct - 8) & 1) * 64) * SEQ + t0;
#pragma unroll
        for (int i = 0; i < 8; ++i) { const int d = i * 8 + (lane >> 3), tc = lane & 7; const LAS bf16_t* p = scr + (tc * 8) * STG_PITCH + d;
            v4u o; o.x = (unsigned)p[0] | ((unsigned)p[STG_PITCH] << 16); o.y = (unsigned)p[2 * STG_PITCH] | ((unsigned)p[3 * STG_PITCH] << 16);
            o.z = (unsigned)p[4 * STG_PITCH] | ((unsigned)p[5 * STG_PITCH] << 16); o.w = (unsigned)p[6 * STG_PITCH] | ((unsigned)p[7 * STG_PITCH] << 16);
            *(v4u*)(dst + (size_t)d * SEQ + tc * 8) = o; }
    }
    WSYNC();
}
__device__ __forceinline__ void scan128(float& x0, float& x1, int lane) {
#pragma unroll
    for (int o = 1; o < 64; o <<= 1) { const float t0 = __shfl_up(x0, o), t1 = __shfl_up(x1, o); if (lane >= o) { x0 += t0; x1 += t1; } }
    x1 += __shfl(x0, 63);
}
__device__ __forceinline__ void ssd_s1_unit(int unit, int lane, LAS float* tab, const bf16_t* __restrict__ xst, const bf16_t* __restrict__ bt, const float* __restrict__ dt, const float* __restrict__ a_log,
                                            float* __restrict__ sloc, float* __restrict__ asum) {
    const int h = unit & 7, c = (unit >> 3) & 15, b = unit >> 7, g = h >> 2, l0 = c * 128, l31 = lane & 31, hi = lane >> 5;
    const size_t m0 = (size_t)b * SEQ + l0;
    const float A = -expf(a_log[h]);
    const float d0 = dt[(m0 + lane) * 8 + h], d1 = dt[(m0 + 64 + lane) * 8 + h];
    float ac0 = d0 * A, ac1 = d1 * A;
    scan128(ac0, ac1, lane);
    const float aend = __shfl(ac1, 63);
    tab[lane] = __expf(aend - ac0) * d0; tab[64 + lane] = __expf(aend - ac1) * d1;
    if (lane == 0) asum[unit] = aend;
    WSYNC();
    f32x16 acc[2][4];
#pragma unroll
    for (int pt = 0; pt < 2; ++pt)
#pragma unroll
        for (int nt = 0; nt < 4; ++nt)
#pragma unroll
            for (int r = 0; r < 16; ++r) acc[pt][nt][r] = 0.f;
    const bf16_t* Xp = xst + ((size_t)(b * 8 + h) * 64 + l31) * SEQ + l0 + 8 * hi;
    const bf16_t* Bp = bt + ((size_t)(b * 2 + g) * 128 + l31) * SEQ + l0 + 8 * hi;
#pragma unroll 2
    for (int kk = 0; kk < 8; ++kk) {
        const f32x4 wa = *(const LAS f32x4*)(tab + 16 * kk + 8 * hi), wb = *(const LAS f32x4*)(tab + 16 * kk + 8 * hi + 4);
        bf16x8 af[2], bfr[4];
#pragma unroll
        for (int pt = 0; pt < 2; ++pt) { const v4u raw = *(const v4u*)(Xp + (size_t)pt * 32 * SEQ + 16 * kk);
            v4u w; w.x = cvtpk(bflo(raw.x) * wa[0], bfhi(raw.x) * wa[1]); w.y = cvtpk(bflo(raw.y) * wa[2], bfhi(raw.y) * wa[3]);
            w.z = cvtpk(bflo(raw.z) * wb[0], bfhi(raw.z) * wb[1]); w.w = cvtpk(bflo(raw.w) * wb[2], bfhi(raw.w) * wb[3]); af[pt] = __builtin_bit_cast(bf16x8, w); }
#pragma unroll
        for (int nt = 0; nt < 4; ++nt) bfr[nt] = *(const bf16x8*)(Bp + (size_t)nt * 32 * SEQ + 16 * kk);
#pragma unroll
        for (int pt = 0; pt < 2; ++pt)
#pragma unroll
            for (int nt = 0; nt < 4; ++nt) acc[pt][nt] = MFMA32(af[pt], bfr[nt], acc[pt][nt]);
    }
    float* dst = sloc + (size_t)unit * 8192 + l31;
#pragma unroll
    for (int pt = 0; pt < 2; ++pt)
#pragma unroll
        for (int nt = 0; nt < 4; ++nt)
#pragma unroll
            for (int r = 0; r < 16; ++r) dst[(32 * pt + crow(r, hi)) * 128 + 32 * nt] = acc[pt][nt][r];
    WSYNC();
}
__device__ __forceinline__ void ssd_s2_all(const float* __restrict__ sloc, const float* __restrict__ asum, bf16_t* __restrict__ stb, int gtid, int NT) {
    for (int i = gtid; i < 128 * 2048; i += NT) {
        const int bh = i >> 11, e4 = i & 2047, b = bh >> 3, h = bh & 7;
        f32x4 run = {0.f, 0.f, 0.f, 0.f};
#pragma unroll 4
        for (int c = 0; c < 16; ++c) { const int unit = (b * 16 + c) * 8 + h; const f32x4 tmp = *(const f32x4*)(sloc + (size_t)unit * 8192 + e4 * 4);
            uint2 w; w.x = cvtpk(run[0], run[1]); w.y = cvtpk(run[2], run[3]); *(uint2*)(stb + (size_t)unit * 8192 + e4 * 4) = w;
            run = run * __expf(asum[unit]) + tmp; }
    }
}
__device__ __forceinline__ void ssd_s3_unit(int unit, int lane, LAS float* tab, const bf16_t* __restrict__ xbc, const bf16_t* __restrict__ xst, const bf16_t* __restrict__ stb, const float* __restrict__ dt,
                                            const float* __restrict__ a_log, const float* __restrict__ dsk, bf16_t* __restrict__ yssm) {
    const int h = unit & 7, c = (unit >> 3) & 15, b = unit >> 7, g = h >> 2, l0 = c * 128, l31 = lane & 31, hi = lane >> 5;
    const size_t m0 = (size_t)b * SEQ + l0;
    const float A = -expf(a_log[h]), D = dsk[h];
    const float d0 = dt[(m0 + lane) * 8 + h], d1 = dt[(m0 + 64 + lane) * 8 + h];
    float ac0 = d0 * A, ac1 = d1 * A;
    scan128(ac0, ac1, lane);
    tab[lane] = ac0; tab[64 + lane] = ac1; tab[128 + lane] = d0; tab[192 + lane] = d1;
    WSYNC();
    const bf16_t* Cp = xbc + (m0 + l31) * 1024 + 768 + g * 128 + 8 * hi;
    const bf16_t* Sp = stb + (size_t)unit * 8192 + l31 * 128 + 8 * hi;
    const bf16_t* Bp = xbc + (m0 + l31) * 1024 + 512 + g * 128 + 8 * hi;
    const bf16_t* Xp = xst + ((size_t)(b * 8 + h) * 64 + l31) * SEQ + l0 + 4 * hi;
    LAS float* tr = tab + 256;
    const int row = lane >> 1, p0 = (lane & 1) * 16;
#pragma unroll 1
    for (int lt = 0; lt < 4; ++lt) {
        f32x16 y[2];
#pragma unroll
        for (int r = 0; r < 16; ++r) { y[0][r] = 0.f; y[1][r] = 0.f; }
        const float acl = tab[32 * lt + l31];
#pragma unroll 4
        for (int kk = 0; kk < 8; ++kk) {
            const bf16x8 cf = *(const bf16x8*)(Cp + (size_t)lt * 32 * 1024 + 16 * kk);
            const bf16x8 s0 = *(const bf16x8*)(Sp + 16 * kk), s1 = *(const bf16x8*)(Sp + 32 * 128 + 16 * kk);
            y[0] = MFMA32(s0, cf, y[0]); y[1] = MFMA32(s1, cf, y[1]);
        }
        { const float el = __expf(acl);
#pragma unroll
          for (int r = 0; r < 16; ++r) { y[0][r] *= el; y[1][r] *= el; } }
#pragma unroll 1
        for (int st = 0; st <= lt; ++st) {
            f32x16 cbt;
#pragma unroll
            for (int r = 0; r < 16; ++r) cbt[r] = 0.f;
#pragma unroll 4
            for (int kk = 0; kk < 8; ++kk) { const bf16x8 bf_ = *(const bf16x8*)(Bp + (size_t)st * 32 * 1024 + 16 * kk), cf_ = *(const bf16x8*)(Cp + (size_t)lt * 32 * 1024 + 16 * kk); cbt = MFMA32(bf_, cf_, cbt); }
#pragma unroll
            for (int r = 0; r < 16; ++r) { const int sl = 32 * st + crow(r, hi); const float acs = tab[sl], dts = tab[128 + sl];
                float v = cbt[r] * __expf(acl - acs) * dts; if (st == lt && crow(r, hi) > l31) v = 0.f; cbt[r] = v; }
            bf16x8 pf[2];
#pragma unroll
            for (int ks = 0; ks < 2; ++ks) { v4u w; w.x = cvtpk(cbt[8 * ks], cbt[8 * ks + 1]); w.y = cvtpk(cbt[8 * ks + 2], cbt[8 * ks + 3]); w.z = cvtpk(cbt[8 * ks + 4], cbt[8 * ks + 5]); w.w = cvtpk(cbt[8 * ks + 6], cbt[8 * ks + 7]); pf[ks] = __builtin_bit_cast(bf16x8, w); }
#pragma unroll
            for (int pt = 0; pt < 2; ++pt)
#pragma unroll
                for (int ks = 0; ks < 2; ++ks) { const bf16_t* xp = Xp + (size_t)pt * 32 * SEQ + st * 32 + 16 * ks; const u32x2 x0 = *(const u32x2*)xp, x1 = *(const u32x2*)(xp + 8);
                    v4u a; a.x = x0.x; a.y = x0.y; a.z = x1.x; a.w = x1.y; y[pt] = MFMA32(__builtin_bit_cast(bf16x8, a), pf[ks], y[pt]); }
        }
#pragma unroll
        for (int pt = 0; pt < 2; ++pt) {
#pragma unroll
            for (int r = 0; r < 16; ++r) tr[l31 * 33 + crow(r, hi)] = y[pt][r];
            WSYNC();
            const size_t m = m0 + 32 * lt + row;
            const v4u xa = *(const v4u*)(xbc + m * 1024 + h * 64 + 32 * pt + p0), xb = *(const v4u*)(xbc + m * 1024 + h * 64 + 32 * pt + p0 + 8);
            const unsigned xu[8] = {xa.x, xa.y, xa.z, xa.w, xb.x, xb.y, xb.z, xb.w};
            unsigned ow[8];
#pragma unroll
            for (int q = 0; q < 8; ++q) { const float v0 = tr[row * 33 + p0 + 2 * q] + D * bflo(xu[q]), v1 = tr[row * 33 + p0 + 2 * q + 1] + D * bfhi(xu[q]); ow[q] = cvtpk(v0, v1); }
            bf16_t* dst = yssm + m * 512 + h * 64 + 32 * pt + p0;
            *(v4u*)dst = (v4u){ow[0], ow[1], ow[2], ow[3]}; *(v4u*)(dst + 8) = (v4u){ow[4], ow[5], ow[6], ow[7]};
            WSYNC();
        }
    }
}

struct Args { const float* in[43]; float* out; unsigned char* ws; };
#define GEMM_PHASE(EPI, Aptr, LDA, Bptr, LDB, NN, KK, ...) do { pg8::Gemm g_{(Aptr), (Bptr), M, (NN), (KK), (LDA), (LDB)}; pg8::StaticOrder S_; S_.init(M, (NN), G, (int)blockIdx.x); \
        pg8::EPI E_{__VA_ARGS__}; pg8::gemm_phase<pg8::EPI, pg8::StaticOrder, true, true>(lds3, g_, S_, E_); } while (0)

__global__ void __launch_bounds__(NWAVES * 64, 2) fwd_mega(Args args) {
    extern __shared__ __attribute__((aligned(16))) unsigned char lds[];
    LAS unsigned char* lds3 = (LAS unsigned char*)lds;
    volatile LAS unsigned* MISC = (volatile LAS unsigned*)(lds3 + MISC_OFF);
    const int G = gridDim.x, NGW = G * NWAVES, NT = G * NWAVES * 64;
#define PHASE_IDS() int tid = threadIdx.x; asm volatile("" : "+v"(tid)); const int lane = tid & 63, wave = __builtin_amdgcn_readfirstlane(tid >> 6); const int gw = blockIdx.x * NWAVES + wave, gtid = blockIdx.x * (NWAVES * 64) + tid; (void)lane; (void)gw; (void)gtid
    unsigned char* ws = args.ws;
    gu32* ctl = (gu32*)(ws + WS_CTL);
    for (int u = threadIdx.x; u < (LDS_BYTES - LDSCTL_OFF) / 4; u += NWAVES * 64) ((LAS unsigned*)(lds3 + LDSCTL_OFF))[u] = 0u;
    __syncthreads();
    XcdBarrier bar = xcd_barrier_post((unsigned*)(ctl + CW_BAR), MISC + 8);
#if defined(PROBE_STAMPS)
    int nb_ = 0;
    if (blockIdx.x == 0 && threadIdx.x == 0) MISC[16] = (unsigned)__builtin_amdgcn_s_memrealtime();
#define GRID_BAR() do { xcd_barrier(bar); ++nb_; if (blockIdx.x == 0 && threadIdx.x == 0) MISC[16 + nb_] = (unsigned)__builtin_amdgcn_s_memrealtime(); } while (0)
#else
#define GRID_BAR() xcd_barrier(bar)
#endif
#define IN(i) (args.in[i])
    float* out = args.out;
    bf16_t* W0in = (bf16_t*)(ws + WS_W0IN); bf16_t* W0out = (bf16_t*)(ws + WS_W0OUT); bf16_t* Wup0 = (bf16_t*)(ws + WS_WUP0); bf16_t* Wdn0 = (bf16_t*)(ws + WS_WDN0);
    bf16_t* W1in = (bf16_t*)(ws + WS_W1IN); bf16_t* Wuq = (bf16_t*)(ws + WS_WUQ); bf16_t* Wukv = (bf16_t*)(ws + WS_WUKV); bf16_t* W1out = (bf16_t*)(ws + WS_W1OUT);
    bf16_t* Wup1 = (bf16_t*)(ws + WS_WUP1); bf16_t* Wdn1 = (bf16_t*)(ws + WS_WDN1);
    bf16_t* XB = (bf16_t*)(ws + WS_XB); bf16_t* YMIX = (bf16_t*)(ws + WS_YMIX); bf16_t* PROJ0 = (bf16_t*)(ws + WS_BIG);
    float* YRAW = out; bf16_t* YSSM = (bf16_t*)(out + (size_t)M * 512); bf16_t* STB = (bf16_t*)(out + (size_t)M * 768); bf16_t* XST = (bf16_t*)(ws + WS_XST); bf16_t* BT = (bf16_t*)(ws + WS_BT); float* ASUM = (float*)(ws + WS_ASUM); float* SLOC = (float*)(ws + WS_SLOC); float* DT = (float*)(ws + WS_DT); bf16_t* GB = (bf16_t*)(ws + WS_G); float* BONUS = (float*)(ws + WS_BONUS);
    bf16_t* W2T = (bf16_t*)(ws + WS_W2T); bf16_t* A2T = (bf16_t*)(ws + WS_A2T); bf16_t* G2T = (bf16_t*)(ws + WS_G2T); bf16_t* ACT = (bf16_t*)(ws + WS_GU); bf16_t* HALO = (bf16_t*)(ws + WS_GU + 176 * MiB);
    bf16_t* PROJ1 = (bf16_t*)(ws + WS_PROJ1); bf16_t* QM = (bf16_t*)(ws + WS_QM); bf16_t* KVM = (bf16_t*)(ws + WS_KVM); bf16_t* KPE = (bf16_t*)(ws + WS_KPE); float* RS = (float*)(ws + WS_RS); float* CSTAB = (float*)(ws + WS_CSTAB); bf16_t* VTS = (bf16_t*)(ws + WS_VTS); bf16_t* VTM = (bf16_t*)(ws + WS_VTM);
    const int* pos = (const int*)args.in[1];

    {
        PHASE_IDS();
    {
        LAS float* scr = (LAS float*)(lds3 + wave * 16384);
        transpose_matrix(IN(2), 1024, 3336, W0in, L0P, 1024, scr, gw, NGW, lane, nullptr);
        transpose_matrix(IN(20), 1024, 1024, W0out, 1024, 1024, scr, gw, NGW, lane, nullptr);
        transpose_matrix(IN(23), 1024, 5632, Wup0, 5632, 1024, scr, gw, NGW, lane, nullptr, true);
        transpose_matrix(IN(26), 2816, 1024, Wdn0, 1024, 2816, scr, gw, NGW, lane, nullptr);
        transpose_matrix(IN(29), 1024, 1952, W1in, L1P, 1024, scr, gw, NGW, lane, nullptr);
        transpose_matrix(IN(31), 256, 768, Wuq, 768, 256, scr, gw, NGW, lane, IN(30));
        transpose_matrix(IN(33), 128, 1024, Wukv, 1024, 256, scr, gw, NGW, lane, IN(32));
        for (int i = gtid; i < 1024 * 16; i += NT) { const int n = i >> 4, c = i & 15; *(v4u*)(Wukv + (size_t)n * 256 + 128 + c * 8) = (v4u){0u, 0u, 0u, 0u}; }
        transpose_matrix(IN(34), 1024, 1024, W1out, 1024, 1024, scr, gw, NGW, lane, nullptr);
        transpose_matrix(IN(37), 1024, 5632, Wup1, 5632, 1024, scr, gw, NGW, lane, nullptr, true);
        transpose_matrix(IN(40), 2816, 1024, Wdn1, 1024, 2816, scr, gw, NGW, lane, nullptr);
        transpose_matrix(IN(5), 64, 512, W2T, 512, 64, scr, gw, NGW, lane, nullptr);
        transpose_matrix(IN(7), 64, 512, A2T, 512, 64, scr, gw, NGW, lane, nullptr);
        transpose_matrix(IN(8), 128, 512, G2T, 512, 128, scr, gw, NGW, lane, nullptr);
        const float* x = IN(0);
        {
            constexpr size_t TOT4 = (size_t)M * DM / 4;
            for (size_t i = gtid; i < TOT4; i += (size_t)NT * 8) {
                f32x4 v[8];
#pragma unroll
                for (int u = 0; u < 8; ++u) v[u] = *(const f32x4*)(x + (i + (size_t)u * NT) * 4);
#pragma unroll
                for (int u = 0; u < 8; ++u) { uint2 w; w.x = cvtpk(v[u][0], v[u][1]); w.y = cvtpk(v[u][2], v[u][3]); *(uint2*)(XB + (i + (size_t)u * NT) * 4) = w; }
            }
        }
    }
    }
    GRID_BAR();
    {
        PHASE_IDS();
    GEMM_PHASE(EpiBf16S, XB, DM, W0in, 1024, L0P, 1024, PROJ0, nullptr, L0P, 0);
    }
    GRID_BAR();
    {
        PHASE_IDS();
        const int blk = (int)blockIdx.x, m0 = blk * 128;
        {   LAS bf16_t* scr = (LAS bf16_t*)(lds3 + wave * 16384);
#pragma unroll 1
            for (int k = 0; k < 4; ++k) ssd_conv_tile((2 * blk + (k & 1)) * 16 + wave + 8 * (k >> 1), lane, scr, PROJ0, IN(14), IN(15), XB, XST, BT);
            for (int i = tid; i < 1024; i += NWAVES * 64) { const int m = m0 + (i >> 3); DT[(size_t)m * 8 + (i & 7)] = softplusf_(bf2f(PROJ0[(size_t)m * L0P + 3328 + (i & 7)]) + IN(16)[i & 7]); }
        }
        __syncthreads();
        ssd_s1_unit(blk * 8 + wave, lane, (LAS float*)(lds3 + wave * 16384), XST, BT, DT, IN(17), SLOC, ASUM);
    }
    GRID_BAR();
    {
        PHASE_IDS();
        ssd_s2_all(SLOC, ASUM, STB, gtid, NT);
        rwkv_phase((LAS float*)lds3, tid, lane, wave, (int)blockIdx.x, PROJ0, IN(3), IN(4), IN(6), IN(9), IN(10), IN(11), W2T, A2T, G2T, YRAW, GB, BONUS);
    }
    GRID_BAR();
    {
        PHASE_IDS();
        const int blk = (int)blockIdx.x;
        ssd_s3_unit(blk * 8 + wave, lane, (LAS float*)(lds3 + wave * 16384), XB, XST, STB, DT, IN(17), IN(18), YSSM);
        __syncthreads();
        ssm_gate_norm_all(YSSM, PROJ0, IN(19), YMIX, blk * 256 + wave, blk * 256 + 256, lane);
        rwkv_post_all(YRAW, PROJ0, IN(3), BONUS, GB, IN(12), IN(13), YMIX, gw, NGW, lane);
    }
    GRID_BAR();
    {
        PHASE_IDS();
    GEMM_PHASE(EpiResid, YMIX, DM, W0out, 1024, 1024, 1024, IN(0), out, ALPHA, 0);
    }
    GRID_BAR();
    {
        PHASE_IDS();
    ln_rows(out, XB, IN(21), IN(22), gw, NGW, lane);
    }
    GRID_BAR();
    {
        PHASE_IDS();
        { pg8::Gemm g_{XB, Wup0, M / 32, DFF, 1024, DM, 1024, 4096, 8192, 256, 512, 1}; pg8::StaticOrder S_; S_.init(M / 32, DFF, G, (int)blockIdx.x);
          pg8::EpiBf16S E_{HALO, nullptr, DFF, 0}; pg8::gemm_phase<pg8::EpiBf16S, pg8::StaticOrder, true, true>(lds3, g_, S_, E_); }
    }
    GRID_BAR();
    {
        PHASE_IDS();
        { pg8::Gemm g_{XB, Wup0, M, 2 * DFF, 1024, DM, 1024}; pg8::StaticOrder S_; S_.init(M, 2 * DFF, G, (int)blockIdx.x);
          pg8::EpiConvAct E_{ACT, HALO, IN(24), IN(25), DFF, SEQ}; pg8::gemm_phase<pg8::EpiConvAct, pg8::StaticOrder, true, true>(lds3, g_, S_, E_); }
    }
    GRID_BAR();
    {
        PHASE_IDS();
    GEMM_PHASE(EpiResid, ACT, DFF, Wdn0, DFF, 1024, DFF, out, out, ALPHA, 0);
    }
    GRID_BAR();
    {
        PHASE_IDS();
    ln_rows(out, XB, IN(27), IN(28), gw, NGW, lane);
    }
    GRID_BAR();
    {
        PHASE_IDS();
    GEMM_PHASE(EpiBf16S, XB, DM, W1in, 1024, L1P, 1024, PROJ1, nullptr, L1P, 0);
    }
    GRID_BAR();
    {
        PHASE_IDS();
    mla_prep_all(PROJ1, pos, RS, KPE, CSTAB, gw, NGW, lane);
    }
    GRID_BAR();
    {
        PHASE_IDS();
    GEMM_PHASE(EpiBf16S, PROJ1 + 1536, L1P, Wuq, 256, 768, 256, QM, RS, 768, 2);
    GEMM_PHASE(EpiBf16S, PROJ1 + 1792, L1P, Wukv, 256, 1024, 256, KVM, RS + 1, 1024, 2);
    }
    GRID_BAR();
    {
        PHASE_IDS();
    rope_q_all(QM, CSTAB, gtid, NT);
    {
        LAS bf16_t* scr = (LAS bf16_t*)(lds3 + wave * 16384);
        for (int it = gw; it < 8192; it += NGW) { const int which = it >> 12, r = it & 4095, bh = r >> 5, tt = r & 31, b = bh >> 3, h = bh & 7;
            if (which == 0) transpose_tile64(PROJ1 + ((size_t)b * SEQ + tt * 64) * L1P + 1024 + h * 64, L1P, VTS + (size_t)bh * 64 * SEQ + tt * 64, SEQ, scr, lane);
            else            transpose_tile64(KVM + ((size_t)b * SEQ + tt * 64) * 1024 + h * 128 + 64, 1024, VTM + (size_t)bh * 64 * SEQ + tt * 64, SEQ, scr, lane); }
    }
    }
    GRID_BAR();
    {
        PHASE_IDS();
    {
        for (int g2 = (int)blockIdx.x; g2 < 256; g2 += G) { const int bh = g2 >> 1, part = g2 & 1;
#pragma unroll 1
            for (int i = 0; i < 4; ++i) { const int sbk = part ? ((i == 0) ? 1 : (i == 1) ? 6 : (i == 2) ? 2 : 5) : ((i == 0) ? 0 : (i == 1) ? 7 : (i == 2) ? 3 : 4);
                sb_block(bh, sbk, tid, lane, wave, lds3, PROJ1, VTS, YMIX); } }
        for (int g2 = (int)blockIdx.x; g2 < 256; g2 += G) { const int bh = g2 >> 1, part = g2 & 1;
#pragma unroll 1
            for (int i = 0; i < 4; ++i) { const int sbk = part ? ((i == 0) ? 1 : (i == 1) ? 6 : (i == 2) ? 2 : 5) : ((i == 0) ? 0 : (i == 1) ? 7 : (i == 2) ? 3 : 4);
                mla_block(bh, sbk, tid, lane, wave, lds3, QM, KVM, KPE, VTM, YMIX); } }
    }
    }
    GRID_BAR();
    {
        PHASE_IDS();
    GEMM_PHASE(EpiResid, YMIX, DM, W1out, 1024, 1024, 1024, out, out, ALPHA, 0);
    }
    GRID_BAR();
    {
        PHASE_IDS();
    ln_rows(out, XB, IN(35), IN(36), gw, NGW, lane);
    }
    GRID_BAR();
    {
        PHASE_IDS();
        { pg8::Gemm g_{XB, Wup1, M / 32, DFF, 1024, DM, 1024, 4096, 8192, 256, 512, 1}; pg8::StaticOrder S_; S_.init(M / 32, DFF, G, (int)blockIdx.x);
          pg8::EpiBf16S E_{HALO, nullptr, DFF, 0}; pg8::gemm_phase<pg8::EpiBf16S, pg8::StaticOrder, true, true>(lds3, g_, S_, E_); }
    }
    GRID_BAR();
    {
        PHASE_IDS();
        { pg8::Gemm g_{XB, Wup1, M, 2 * DFF, 1024, DM, 1024}; pg8::StaticOrder S_; S_.init(M, 2 * DFF, G, (int)blockIdx.x);
          pg8::EpiConvAct E_{ACT, HALO, IN(38), IN(39), DFF, SEQ}; pg8::gemm_phase<pg8::EpiConvAct, pg8::StaticOrder, true, true>(lds3, g_, S_, E_); }
    }
    GRID_BAR();
    {
        PHASE_IDS();
    GEMM_PHASE(EpiResid, ACT, DFF, Wdn1, DFF, 1024, DFF, out, out, ALPHA, 0);
    }
    GRID_BAR();
    {
        PHASE_IDS();
    ln_rows(out, XB, IN(41), IN(42), gw, NGW, lane);
    #if defined(PROBE_STAMPS)
    __syncthreads();
    if (blockIdx.x == 0 && threadIdx.x == 0) {
        MISC[16 + 22] = (unsigned)__builtin_amdgcn_s_memrealtime();
        const unsigned d1 = MISC[16 + PROBE_T1_HI] - MISC[16 + PROBE_T1_LO];
        const unsigned long long spin = 100ull * d1;
        const unsigned long long t0 = __builtin_amdgcn_s_memrealtime();
        while (__builtin_amdgcn_s_memrealtime() - t0 < spin) __builtin_amdgcn_s_sleep(8);
    }
#endif
}
}

extern "C" void kernel_launch(void* const* d_in, const int* in_sizes, int n_in, void* d_out, int out_size, void* d_ws, size_t ws_size, hipStream_t stream) {
    static int grid = 0;
    if (grid == 0) {
        if (n_in != 43 || ws_size < WS_NEED || out_size != M * DM) { fprintf(stderr, "kernel_launch: unexpected n_in %d / ws %zu / out %d\n", n_in, ws_size, out_size); grid = -1; return; }
        int dev = 0, cus = 0, per_cu = 0;
        if (hipGetDevice(&dev) != hipSuccess || hipDeviceGetAttribute(&cus, hipDeviceAttributeMultiprocessorCount, dev) != hipSuccess) { grid = -1; return; }
        if (hipFuncSetAttribute((const void*)fwd_mega, hipFuncAttributeMaxDynamicSharedMemorySize, LDS_BYTES) != hipSuccess) { fprintf(stderr, "kernel_launch: hipFuncSetAttribute failed\n"); grid = -1; return; }
        if (hipOccupancyMaxActiveBlocksPerMultiprocessor(&per_cu, (const void*)fwd_mega, NWAVES * 64, LDS_BYTES) != hipSuccess || per_cu < 1) fprintf(stderr, "kernel_launch: occupancy query reports %d\n", per_cu);
        (void)hipGetLastError();
        grid = cus;
    }
    if (grid < 0) return;
    (void)hipMemsetAsync((char*)d_ws + WS_CTL, 0, CTL_ZERO_BYTES, stream);
    Args a{};
    for (int i = 0; i < 43; ++i) a.in[i] = (const float*)d_in[i];
    a.out = (float*)d_out; a.ws = (unsigned char*)d_ws;
    hipLaunchKernelGGL(fwd_mega, dim3(grid), dim3(NWAVES * 64), LDS_BYTES, stream, a);
}
```

```cpp
#include <hip/hip_runtime.h>
#include <cstdio>
#include <cstdint>
#include <cmath>
namespace pg8 {
#define PG8_LAS __attribute__((address_space(3)))
typedef unsigned short bf16_t;
typedef short bf16x8 __attribute__((ext_vector_type(8)));
typedef float f32x4 __attribute__((ext_vector_type(4)));
typedef unsigned u32x4 __attribute__((ext_vector_type(4)));
constexpr int BM = 256, BK = 64, HALF = 128, HTB = HALF * BK * 2  , STAGE_BYTES = 8 * HTB, NXCD = 8, WGM = 8;

__host__ __device__ __forceinline__ int lds_byte(int r, int c) { const int st = (r >> 4) * 2 + (c >> 5), rr = r & 15, cc = c & 31, ob = rr * 64 + cc * 2; return st * 1024 + (ob ^ (((ob >> 9) & 1) << 5)); }
__host__ __device__ __forceinline__ void stage_rc(int b, int& R, int& C) { const int st = b / 1024, sb = b % 1024, swz = sb ^ (((sb >> 9) & 1) << 5); R = (st >> 1) * 16 + swz / 64; C = (st & 1) * 32 + (swz % 64) / 2; }
__host__ __device__ __forceinline__ int perm32(int rho) { const int n = rho >> 4, i = rho & 15; return 8 * (i >> 2) + 4 * n + (i & 3); }

struct Unit { int pm, pn; };
struct Gemm { const bf16_t* A; const bf16_t* Bt; int M, N, K, lda, ldb; int hrA = 128, trA = 256, hrB = 128, trB = 256, gatherA = 0; };

struct StaticOrder {
    int nM, nN, nwg, G, c;
    __host__ __device__ void init(int M, int N, int G_, int c_) { nM = M / BM; nN = N / BM; nwg = nM * nN; G = G_; c = c_; }
    __host__ __device__ bool next(int i, Unit& u) const {
        const long L = (long)i * G + c; if (L >= nwg) return false;
        int wgid = (int)L; { const int q = nwg / NXCD, r = nwg % NXCD, xcd = wgid % NXCD, off = wgid / NXCD; wgid = (xcd < r ? xcd * (q + 1) : r * (q + 1) + (xcd - r) * q) + off; }
        const int nig = WGM * nN, gid = wgid / nig, fm = gid * WGM, gsz = (nM - fm) < WGM ? (nM - fm) : WGM;
        u.pm = fm + ((wgid % nig) % gsz); u.pn = (wgid % nig) / gsz; return true;
    }
    __device__ __forceinline__ void a_ready(const Unit&) const {}
    __device__ __forceinline__ void done(const Unit&) const {}
};


__device__ __forceinline__ unsigned cvt_pk_bf16(float lo, float hi) { unsigned r; asm volatile("v_cvt_pk_bf16_f32 %0, %1, %2" : "=v"(r) : "v"(lo), "v"(hi)); return r; }
struct EpiBf16S {
    static constexpr bool PERM = true, AFTER_DRAIN = false;
    bf16_t* O; const float* rowscale; int ldc; int rs_stride;
    __device__ __forceinline__ void operator()(const f32x4 (&acc)[2][2][4][2], const Unit& u, int wr, int wc, int fr, int fq) const {
        const int row0 = u.pm * BM + wr * 64 + fr, col0 = u.pn * BM + wc * 32 + 8 * fq;
#pragma unroll
        for (int ai = 0; ai < 2; ++ai)
#pragma unroll
            for (int m = 0; m < 4; ++m) { const int row = row0 + ai * HALF + m * 16; const float sc = rowscale ? rowscale[(size_t)row * rs_stride] : 1.f;
                bf16_t* rowp = O + (size_t)row * ldc + col0;
#pragma unroll
                for (int bj = 0; bj < 2; ++bj) { const f32x4 v0 = acc[ai][bj][m][0] * sc, v1 = acc[ai][bj][m][1] * sc;
                    u32x4 w; w.x = cvt_pk_bf16(v0[0], v0[1]); w.y = cvt_pk_bf16(v0[2], v0[3]); w.z = cvt_pk_bf16(v1[0], v1[1]); w.w = cvt_pk_bf16(v1[2], v1[3]);
                    *(u32x4*)(rowp + bj * HALF) = w; } }
    }
};
struct EpiResid {
    static constexpr bool PERM = false, AFTER_DRAIN = false;
    const float* hin; float* hout; float alpha; int pad;
    __device__ __forceinline__ void operator()(const f32x4 (&acc)[2][2][4][2], const Unit& u, int wr, int wc, int fr, int fq) const {
        const int row0 = u.pm * BM + wr * 64 + fr, col0 = u.pn * BM + wc * 32 + 4 * fq;
#pragma unroll
        for (int ai = 0; ai < 2; ++ai)
#pragma unroll
            for (int m = 0; m < 4; ++m) { const size_t off = (size_t)(row0 + ai * HALF + m * 16) * 1024 + col0;
#pragma unroll
                for (int bj = 0; bj < 2; ++bj)
#pragma unroll
                    for (int n = 0; n < 2; ++n) { const size_t i = off + bj * HALF + n * 16; const f32x4 h = *(const f32x4*)(hin + i); *(f32x4*)(hout + i) = h * alpha + acc[ai][bj][m][n]; } }
    }
};

template <int CTRL> __device__ __forceinline__ float pg_dpp(float x) { return __builtin_bit_cast(float, __builtin_amdgcn_update_dpp(0, __builtin_bit_cast(int, x), CTRL, 0xF, 0xF, true)); }
struct EpiConvAct {
    static constexpr bool PERM = true, AFTER_DRAIN = false;
    bf16_t* act; const bf16_t* halo; const float* cw; const float* cb; int dff; int seq;
    __device__ __forceinline__ void operator()(const f32x4 (&acc)[2][2][4][2], const Unit& u, int wr, int wc, int fr, int fq) const {
        typedef unsigned u32x2e __attribute__((ext_vector_type(2)));
#pragma unroll
        for (int n = 0; n < 2; ++n) {
            const int ch0 = u.pn * 128 + wc * 32 + 8 * fq + 4 * n;
            const f32x4 w0 = *(const f32x4*)(cw + ch0), w1 = *(const f32x4*)(cw + dff + ch0), w2 = *(const f32x4*)(cw + 2 * dff + ch0), bb = *(const f32x4*)(cb + ch0);
#pragma unroll
            for (int ai = 0; ai < 2; ++ai) {
                const int rb64 = u.pm * BM + ai * HALF + wr * 64;
                f32x4 P = {0.f, 0.f, 0.f, 0.f};
                if ((rb64 & (seq - 1)) != 0 && fr >= 14) { const u32x2e hv = *(const u32x2e*)(halo + (size_t)(2 * (rb64 / 64 - 1) + (fr - 14)) * dff + ch0);
                    P[0] = __builtin_bit_cast(float, hv.x << 16); P[1] = __builtin_bit_cast(float, hv.x & 0xffff0000u); P[2] = __builtin_bit_cast(float, hv.y << 16); P[3] = __builtin_bit_cast(float, hv.y & 0xffff0000u); }
#pragma unroll
                for (int m = 0; m < 4; ++m) {
                    const f32x4 Gv = acc[ai][0][m][n], Uv = acc[ai][1][m][n];
                    float o[4];
#pragma unroll
                    for (int e = 0; e < 4; ++e) {
                        const float t1 = pg_dpp<0x111>(Gv[e]), t2 = pg_dpp<0x112>(Gv[e]), p1 = pg_dpp<0x10F>(P[e]), p2 = pg_dpp<0x10E>(P[e]);
                        const float g1 = (fr >= 1) ? t1 : p1, g2 = (fr >= 2) ? t2 : p2;
                        const float y = bb[e] + w0[e] * g2 + w1[e] * g1 + w2[e] * Gv[e];
                        o[e] = y / (1.f + __expf(-y)) * Uv[e];
                    }
                    u32x2e w; w.x = cvt_pk_bf16(o[0], o[1]); w.y = cvt_pk_bf16(o[2], o[3]);
                    *(u32x2e*)(act + (size_t)(rb64 + m * 16 + fr) * dff + ch0) = w;
                    P = Gv;
                }
            }
        }
    }
};

template <class Epi, class Sched, bool ALIGN_EPI = false, bool SP2 = false>
__device__ __forceinline__ void gemm_phase(PG8_LAS unsigned char* lds, const Gemm g, const Sched& S, const Epi& E) {
    int tid = threadIdx.x; asm volatile("" : "+v"(tid));
    const int wid = __builtin_amdgcn_readfirstlane(tid >> 6), lane = tid & 63, wr = wid >> 2, wc = wid & 3, fr = lane & 15, fq = lane >> 4;
    const int K = g.K, nt = K / BK;
    unsigned voffA[2], voffB[2];
#pragma unroll
    for (int i = 0; i < 2; ++i) { int R, C; stage_rc(tid * 16 + i * 8192, R, C); const int Rb = Epi::PERM ? ((R & ~31) + perm32(R & 31)) : R;
        const int Ra = g.gatherA ? (64 * (R >> 1) + 62 + (R & 1)) : R;
        voffA[i] = (unsigned)(Ra * g.lda + C) * 2u; voffB[i] = (unsigned)(Rb * g.ldb + C) * 2u; }
    const size_t kstep = (size_t)(BK * 2);
    const size_t hstepA = (size_t)g.hrA * g.lda * 2, hstepB = (size_t)g.hrB * g.ldb * 2;
    const size_t tstepA = (size_t)g.trA * g.lda * 2, tstepB = (size_t)g.trB * g.ldb * 2;
    const unsigned ldsw = (unsigned)wid * 1024u;
    const int aoff = lds_byte(wr * 64 + fr, fq * 8), boff = lds_byte(wc * 32 + fr, fq * 8);
#define PG8_SA(b, h) (((b) * 2 + (h)) * HTB)
#define PG8_SB(b, h) ((4 + (b) * 2 + (h)) * HTB)
#define PG8_STAGE(bufoff, gbase, voff) do { _Pragma("unroll") for (int _i = 0; _i < 2; ++_i) \
        __builtin_amdgcn_global_load_lds((const unsigned*)((const char*)(gbase) + (voff)[_i]), (PG8_LAS unsigned*)(lds + (bufoff) + ldsw + _i * 8192), 16, 0, 0); } while (0)
#define PG8_LDA(dst, b, h) do { _Pragma("unroll") for (int m = 0; m < 4; ++m) _Pragma("unroll") for (int k = 0; k < 2; ++k) dst[m][k] = *(const PG8_LAS bf16x8*)(lds + PG8_SA(b, h) + aoff + m * 2048 + k * 1024); } while (0)
#define PG8_LDB(dst, b, h) do { _Pragma("unroll") for (int n = 0; n < 2; ++n) _Pragma("unroll") for (int k = 0; k < 2; ++k) dst[n][k] = *(const PG8_LAS bf16x8*)(lds + PG8_SB(b, h) + boff + n * 2048 + k * 1024); } while (0)
#define PG8_MMA(ai, bj, At, Bt) do { __builtin_amdgcn_s_setprio(1); _Pragma("unroll") for (int m = 0; m < 4; ++m) _Pragma("unroll") for (int n = 0; n < 2; ++n) _Pragma("unroll") for (int k = 0; k < 2; ++k) \
        acc[ai][bj][m][n] = __builtin_amdgcn_mfma_f32_16x16x32_bf16(Bt[n][k], At[m][k], acc[ai][bj][m][n], 0, 0, 0); __builtin_amdgcn_s_setprio(0); } while (0)
#define PG8_WAIT_V(n) asm volatile("s_waitcnt vmcnt(" #n ")" ::: "memory")
#define PG8_WAIT_L(n) asm volatile("s_waitcnt lgkmcnt(" #n ")" ::: "memory")
#define PG8_BAR __builtin_amdgcn_s_barrier()
#define PG8_SCHED __builtin_amdgcn_sched_barrier(0)
    Unit cur, nxt; int ui = 0;
    if (!S.next(0, cur)) return;
    f32x4 acc[2][2][4][2];
#pragma unroll
    for (int a = 0; a < 2; ++a)
#pragma unroll
        for (int b = 0; b < 2; ++b)
#pragma unroll
            for (int m = 0; m < 4; ++m)
#pragma unroll
                for (int n = 0; n < 2; ++n) acc[a][b][m][n] = (f32x4){0.f, 0.f, 0.f, 0.f};
    bf16x8 At[4][2], B0[2][2], B1[2][2];
    const char* cA = (const char*)g.A + (size_t)cur.pm * tstepA; const char* cB = (const char*)g.Bt + (size_t)cur.pn * tstepB;
    S.a_ready(cur);
    if constexpr (SP2) {
        PG8_STAGE(PG8_SB(0, 0), cB, voffB); PG8_STAGE(PG8_SB(0, 1), cB + hstepB, voffB); PG8_STAGE(PG8_SA(0, 0), cA, voffA); PG8_STAGE(PG8_SA(0, 1), cA + hstepA, voffA);
        if (wr == 1) PG8_BAR;
        PG8_WAIT_V(2); PG8_BAR;
        PG8_STAGE(PG8_SB(1, 0), cB + kstep, voffB); PG8_STAGE(PG8_SA(1, 0), cA + kstep, voffA); PG8_STAGE(PG8_SB(1, 1), cB + hstepB + kstep, voffB);
        PG8_WAIT_V(6); PG8_BAR;
    } else {
        PG8_STAGE(PG8_SB(0, 0), cB, voffB); PG8_STAGE(PG8_SA(0, 0), cA, voffA); PG8_STAGE(PG8_SB(0, 1), cB + hstepB, voffB); PG8_STAGE(PG8_SA(0, 1), cA + hstepA, voffA);
        if (wr == 1) PG8_BAR;
        PG8_WAIT_V(4); PG8_BAR;
        PG8_STAGE(PG8_SB(1, 0), cB + kstep, voffB); PG8_STAGE(PG8_SA(1, 0), cA + kstep, voffA); PG8_STAGE(PG8_SB(1, 1), cB + hstepB + kstep, voffB);
        PG8_WAIT_V(6); PG8_BAR;
    }
    for (;;) {
        const bool has_next = S.next(ui + 1, nxt);
        const char* nA = has_next ? (const char*)g.A + (size_t)nxt.pm * tstepA : cA; const char* nB = has_next ? (const char*)g.Bt + (size_t)nxt.pn * tstepB : cB;
        for (int t = 0; t < nt; t += 2) {
            const bool last = (t == nt - 2);
            const char* a1 = cA + (size_t)(t + 1) * kstep;
            const char* a2 = last ? nA : cA + (size_t)(t + 2) * kstep; const char* b2 = last ? nB : cB + (size_t)(t + 2) * kstep;
            const char* a3 = a2 + kstep; const char* b3 = b2 + kstep;
            if (last && has_next) S.a_ready(nxt);
            if constexpr (SP2) {
            PG8_LDB(B0, 0, 0); PG8_LDB(B1, 0, 1); PG8_SCHED; PG8_LDA(At, 0, 0); PG8_STAGE(PG8_SA(1, 1), a1 + hstepA, voffA);
            PG8_WAIT_V(8); PG8_WAIT_L(0); PG8_BAR; PG8_MMA(0, 0, At, B0); PG8_MMA(0, 1, At, B1); PG8_BAR; PG8_SCHED;
            PG8_LDA(At, 0, 1); PG8_STAGE(PG8_SB(0, 0), b2, voffB); PG8_STAGE(PG8_SB(0, 1), b2 + hstepB, voffB); PG8_STAGE(PG8_SA(0, 0), a2, voffA);
            PG8_WAIT_V(8); PG8_WAIT_L(0); PG8_BAR; PG8_MMA(1, 0, At, B0); PG8_MMA(1, 1, At, B1); PG8_BAR; PG8_SCHED;
            PG8_LDB(B0, 1, 0); PG8_LDB(B1, 1, 1); PG8_SCHED; PG8_LDA(At, 1, 0); PG8_STAGE(PG8_SA(0, 1), a2 + hstepA, voffA);
            PG8_WAIT_V(8); PG8_WAIT_L(0); PG8_BAR; PG8_MMA(0, 0, At, B0); PG8_MMA(0, 1, At, B1); PG8_BAR; PG8_SCHED;
            PG8_LDA(At, 1, 1); PG8_STAGE(PG8_SB(1, 0), b3, voffB); PG8_STAGE(PG8_SB(1, 1), b3 + hstepB, voffB); PG8_STAGE(PG8_SA(1, 0), a3, voffA);
            PG8_WAIT_V(8); PG8_WAIT_L(0); PG8_BAR; PG8_MMA(1, 0, At, B0); PG8_MMA(1, 1, At, B1); PG8_BAR; PG8_SCHED;
            } else {
            PG8_LDB(B0, 0, 0); PG8_SCHED; PG8_LDA(At, 0, 0); PG8_STAGE(PG8_SA(1, 1), a1 + hstepA, voffA);
            PG8_WAIT_L(8); PG8_BAR; PG8_WAIT_L(0); PG8_MMA(0, 0, At, B0); PG8_BAR; PG8_SCHED;
            PG8_LDB(B1, 0, 1); PG8_STAGE(PG8_SB(0, 0), b2, voffB);
            PG8_BAR; PG8_WAIT_L(0); PG8_MMA(0, 1, At, B1); PG8_BAR;
            PG8_LDA(At, 0, 1); PG8_STAGE(PG8_SA(0, 0), a2, voffA);
            PG8_BAR; PG8_WAIT_L(0); PG8_MMA(1, 0, At, B0); PG8_BAR; PG8_SCHED;
            PG8_STAGE(PG8_SB(0, 1), b2 + hstepB, voffB);
            PG8_WAIT_V(6); PG8_BAR; PG8_MMA(1, 1, At, B1); PG8_BAR;
            PG8_LDB(B0, 1, 0); PG8_SCHED; PG8_LDA(At, 1, 0); PG8_STAGE(PG8_SA(0, 1), a2 + hstepA, voffA);
            PG8_WAIT_L(8); PG8_BAR; PG8_WAIT_L(0); PG8_MMA(0, 0, At, B0); PG8_BAR; PG8_SCHED;
            PG8_LDB(B1, 1, 1); PG8_STAGE(PG8_SB(1, 0), b3, voffB);
            PG8_BAR; PG8_WAIT_L(0); PG8_MMA(0, 1, At, B1); PG8_BAR;
            PG8_LDA(At, 1, 1); PG8_STAGE(PG8_SA(1, 0), a3, voffA);
            PG8_BAR; PG8_WAIT_L(0); PG8_MMA(1, 0, At, B0); PG8_BAR; PG8_SCHED;
            PG8_STAGE(PG8_SB(1, 1), b3 + hstepB, voffB);
            PG8_WAIT_V(6); PG8_BAR; PG8_MMA(1, 1, At, B1); PG8_BAR;
            }
        }
        if constexpr (ALIGN_EPI) { if (wr == 0) PG8_BAR; }
        if constexpr (!Epi::AFTER_DRAIN) { E(acc, cur, wr, wc, fr, fq); S.done(cur); }
        if (!has_next) break;
#pragma unroll
        for (int a = 0; a < 2; ++a)
#pragma unroll
            for (int b = 0; b < 2; ++b)
#pragma unroll
                for (int m = 0; m < 4; ++m)
#pragma unroll
                    for (int n = 0; n < 2; ++n) acc[a][b][m][n] = (f32x4){0.f, 0.f, 0.f, 0.f};
        cur = nxt; cA = nA; cB = nB; ++ui;
        if constexpr (ALIGN_EPI) { if (wr == 1) PG8_BAR; }
    }
    PG8_WAIT_V(0);
    if constexpr (!ALIGN_EPI) { if (wr == 0) PG8_BAR; }
    PG8_BAR;
    if constexpr (Epi::AFTER_DRAIN) { E.fused(acc, cur, wr, wc, fr, fq, lds, wid, lane); S.done(cur); }
#undef PG8_SA
#undef PG8_SB
#undef PG8_STAGE
#undef PG8_LDA
#undef PG8_LDB
#undef PG8_MMA
#undef PG8_WAIT_V
#undef PG8_WAIT_L
#undef PG8_BAR
#undef PG8_SCHED
}
}
#define GAS __attribute__((address_space(1)))
#define LAS __attribute__((address_space(3)))
typedef unsigned short bf16;
typedef unsigned v4u __attribute__((ext_vector_type(4)));
typedef float f32x4 __attribute__((ext_vector_type(4)));
typedef short bf16x8 __attribute__((ext_vector_type(8)));
typedef GAS unsigned gu32;
typedef GAS unsigned long long gu64;
#define RLX_AGENT __ATOMIC_RELAXED, __HIP_MEMORY_SCOPE_AGENT
#define LDS_WAIT() asm volatile("s_waitcnt lgkmcnt(0)" ::: "memory")
#define VM_WAIT() asm volatile("s_waitcnt vmcnt(0)" ::: "memory")
__device__ __forceinline__ unsigned long long rt() { return __builtin_amdgcn_s_memrealtime(); }
__device__ __forceinline__ unsigned f2bf(float f) { unsigned u = __builtin_bit_cast(unsigned, f); return (u + 0x7fffu + ((u >> 16) & 1u)) >> 16; }
__device__ __forceinline__ unsigned pk2(float lo, float hi) { return f2bf(lo) | (f2bf(hi) << 16); }

#define XB_TMO      128
#define XB_XCNT(j)  (256  + 64 * (j))
#define XB_XSUB(j)  (1280 + 64 * (j))
#define XB_XGEN(j)  (2304 + 64 * (j))
#define XB_TOP      3328
#define XB_TOPGEN   3392
#define XCD_BAR_WORDS 3456
#define XB_SPIN_CAP (1u << 18)

__device__ __forceinline__ unsigned xb_ld(unsigned* p)              { return __hip_atomic_load(p, __ATOMIC_RELAXED, __HIP_MEMORY_SCOPE_AGENT); }
__device__ __forceinline__ unsigned xb_add(unsigned* p, unsigned v) { return __hip_atomic_fetch_add(p, v, __ATOMIC_RELAXED, __HIP_MEMORY_SCOPE_AGENT); }
__device__ __forceinline__ unsigned xb_xcc_id() { return (unsigned)__builtin_amdgcn_s_getreg((3 << 11) | 20) & 0xFu; }
#define XB_SPIN(cond, bar) do { unsigned _sp = 0; while (cond) { __builtin_amdgcn_s_sleep(1); \
    if ((++_sp & 255u) == 0u) { if (xb_ld(&(bar)[XB_TMO])) break; if (_sp > XB_SPIN_CAP) { atomicAdd(&(bar)[XB_TMO], 1u); break; } } } } while (0)

struct XcdBarrier {
    unsigned* bar; unsigned x;
    volatile LAS unsigned* st;
};

__device__ __forceinline__ XcdBarrier xcd_barrier_post(unsigned* bar, volatile LAS unsigned* st) {
    XcdBarrier b; b.bar = bar; b.x = xb_xcc_id(); b.st = st;
    if (threadIdx.x == 0) (void)xb_add(&bar[XB_XCNT(b.x)], 1u);
    return b;
}
__device__ __forceinline__ void xcd_barrier_complete(unsigned* bar, unsigned x, unsigned& nloc, unsigned& nx) {
    const unsigned G = gridDim.x * gridDim.y * gridDim.z;
    unsigned sum, cnt, mine, sp = 0u;
    for (;;) {
        sum = 0u; cnt = 0u; mine = 0u;
#pragma unroll
        for (unsigned j = 0; j < 16; ++j) { const unsigned c = xb_ld(&bar[XB_XCNT(j)]); sum += c; cnt += (c > 0u) ? 1u : 0u; mine = (j == x) ? c : mine; }
        if (sum == G) break;
        __builtin_amdgcn_s_sleep(1);
        if ((++sp & 255u) == 0u) { if (xb_ld(&bar[XB_TMO])) break; if (sp > XB_SPIN_CAP) { atomicAdd(&bar[XB_TMO], 1u); break; } }
    }
    nloc = mine > 0u ? mine : 1u; nx = cnt > 0u ? cnt : 1u;
}

__device__ __forceinline__ void xcd_barrier(const XcdBarrier& b) {
    asm volatile("s_waitcnt vmcnt(0)" ::: "memory");
    __syncthreads();
    if (threadIdx.x == 0) {
        unsigned* bar = b.bar;
        __builtin_amdgcn_s_waitcnt(0);
        unsigned nloc = b.st[0], nx = b.st[1];
        if (nloc == 0u) { xcd_barrier_complete(bar, b.x, nloc, nx); b.st[0] = nloc; b.st[1] = nx; }
        const unsigned old = xb_add(&bar[XB_XSUB(b.x)], 1u);
        const unsigned gen = old / nloc;
        if (old + 1u == (gen + 1u) * nloc) {
            __builtin_amdgcn_fence(__ATOMIC_RELEASE, "agent");
            asm volatile("s_waitcnt vmcnt(0)" ::: "memory");
            const unsigned og = xb_add(&bar[XB_TOP], 1u);
            const unsigned tg = og / nx;
            if (og + 1u == (tg + 1u) * nx) xb_add(&bar[XB_TOPGEN], 1u);
            else XB_SPIN(xb_ld(&bar[XB_TOPGEN]) == tg, bar);
            __builtin_amdgcn_fence(__ATOMIC_ACQUIRE, "agent");
            xb_add(&bar[XB_XGEN(b.x)], 1u);
            asm volatile("s_waitcnt vmcnt(0)" ::: "memory");
        } else {
            XB_SPIN(xb_ld(&bar[XB_XGEN(b.x)]) == gen, bar);
            __builtin_amdgcn_fence(__ATOMIC_ACQUIRE, "agent");
            asm volatile("s_waitcnt vmcnt(0)" ::: "memory");
        }
    }
    __syncthreads();
}
constexpr int NWAVES = 8;
constexpr int BATCH = 16, SEQ = 2048, DM = 1024, M = BATCH * SEQ;
constexpr int L0P = 3584;
constexpr int L1P = 2048;
constexpr int DFF = 2816;
constexpr float ALPHA = 1.4142135623730951f;
typedef unsigned short bf16_t;
typedef float f32x16 __attribute__((ext_vector_type(16)));

constexpr size_t MiB = 1u << 20;
constexpr size_t WS_CTL = 0, CTL_ZERO_BYTES = 1 * MiB;
constexpr int CW_BAR = 4096;
constexpr size_t WS_W0IN = 2 * MiB, WS_W0OUT = 9 * MiB, WS_WUP0 = 11 * MiB, WS_WDN0 = 22 * MiB, WS_W1IN = 28 * MiB, WS_WUQ = 32 * MiB, WS_WUKV = 33 * MiB,
                 WS_W1OUT = 34 * MiB, WS_WUP1 = 36 * MiB, WS_WDN1 = 47 * MiB;
constexpr size_t WS_XB = 56 * MiB, WS_YMIX = 120 * MiB, WS_BIG = 184 * MiB;
constexpr size_t WS_G = 408 * MiB, WS_BONUS = 440 * MiB, WS_DT = 441 * MiB, WS_XST = 442 * MiB, WS_BT = 474 * MiB, WS_ASUM = 490 * MiB;
constexpr size_t WS_SLOC = 120 * MiB;
constexpr size_t WS_W2T = 53 * MiB, WS_A2T = 53 * MiB + 256 * 1024, WS_G2T = 53 * MiB + 512 * 1024;
constexpr size_t WS_GU = 120 * MiB;
constexpr size_t WS_PROJ1 = 184 * MiB, WS_QM = 312 * MiB, WS_KVM = 360 * MiB, WS_KPE = 424 * MiB, WS_RS = 426 * MiB;
constexpr size_t WS_CSTAB = 492 * MiB;
constexpr size_t WS_VTS = 428 * MiB, WS_VTM = 460 * MiB;
constexpr size_t WS_NEED = 496 * MiB;

constexpr int RING_BYTES = 131072;
constexpr int LDSCTL_OFF = 146432, MISC_OFF = LDSCTL_OFF + 320;
constexpr int LDS_BYTES = 147456;

__device__ __forceinline__ float bf2f(bf16_t b) { return __builtin_bit_cast(float, (unsigned)b << 16); }
__device__ __forceinline__ float sigmoidf_(float x) { return 1.f / (1.f + expf(-x)); }
__device__ __forceinline__ float softplusf_(float x) { return fmaxf(x, 0.f) + log1pf(expf(-fabsf(x))); }
__device__ __forceinline__ float siluf_(float x) { return x / (1.f + expf(-x)); }
__device__ __forceinline__ float wave_sum(float v) {
#pragma unroll
    for (int o = 1; o < 64; o <<= 1) v += __shfl_xor(v, o);
    return v;
}
#define WSYNC() asm volatile("s_waitcnt lgkmcnt(0)" ::: "memory")
typedef float f32x2_t __attribute__((ext_vector_type(2)));
typedef __bf16 bf16x2_t __attribute__((ext_vector_type(2)));
typedef unsigned u32x2 __attribute__((ext_vector_type(2)));
__device__ __forceinline__ unsigned cvtpk(float lo, float hi) { f32x2_t v = {lo, hi}; bf16x2_t b = __builtin_convertvector(v, bf16x2_t); return __builtin_bit_cast(unsigned, b); }
__device__ __forceinline__ float bflo(unsigned u) { return __builtin_bit_cast(float, u << 16); }
__device__ __forceinline__ float bfhi(unsigned u) { return __builtin_bit_cast(float, u & 0xffff0000u); }
template <int CTRL> __device__ __forceinline__ float dpp_mov(float x) { return __builtin_bit_cast(float, __builtin_amdgcn_update_dpp(0, __builtin_bit_cast(int, x), CTRL, 0xF, 0xF, true)); }
__device__ __forceinline__ float rowsum16(float x) { x += dpp_mov<0x128>(x); x += dpp_mov<0x124>(x); x += dpp_mov<0x122>(x); x += dpp_mov<0x121>(x); return x; }
__device__ __forceinline__ float rl(float x, int l) { return __builtin_bit_cast(float, __builtin_amdgcn_readlane(__builtin_bit_cast(int, x), l)); }
__device__ __forceinline__ float wave_sum_dpp(float x) { x = rowsum16(x); return (rl(x, 0) + rl(x, 16)) + (rl(x, 32) + rl(x, 48)); }

__device__ __forceinline__ void transpose_matrix(const float* __restrict__ W, int K, int N, bf16_t* __restrict__ WT, int Npad, int ldt, LAS float* scr, int gw, int NGW, int lane, const float* __restrict__ kscale, bool ffn_interleave = false) {
    (void)scr;
    const int nblk = Npad / 64, nit = (K / 64) * nblk;
    for (int it = gw; it < nit; it += NGW) {
        const int kb = it / nblk, nb = it - kb * nblk, n = nb * 64 + lane, k0 = kb * 64;
        const bool ok = n < N; const float* src = W + (size_t)k0 * N + (ok ? n : 0);
#pragma unroll
        for (int hc = 0; hc < 2; ++hc) {
            float v[32];
#pragma unroll
            for (int i = 0; i < 32; ++i) v[i] = src[(size_t)(hc * 32 + i) * N];
#pragma unroll
            for (int c = 0; c < 4; ++c) { float u[8];
#pragma unroll
                for (int i = 0; i < 8; ++i) { u[i] = ok ? v[c * 8 + i] : 0.f; if (kscale) u[i] *= kscale[k0 + hc * 32 + c * 8 + i]; }
                v4u o; o.x = cvtpk(u[0], u[1]); o.y = cvtpk(u[2], u[3]); o.z = cvtpk(u[4], u[5]); o.w = cvtpk(u[6], u[7]);
                const int nr = ffn_interleave ? ((n < DFF) ? 256 * (n >> 7) + (n & 127) : 256 * ((n - DFF) >> 7) + 128 + ((n - DFF) & 127)) : n;
                *(v4u*)(WT + (size_t)nr * ldt + k0 + hc * 32 + c * 8) = o; }
        }
    }
}

template <bool ST = true> __device__ __forceinline__ void ln_rows(float* h, bf16_t* hb, const float* __restrict__ g, const float* __restrict__ b, int gw, int NGW, int lane) {
    for (int row = gw * 2; row < M; row += NGW * 2) {
        float* p = h + (size_t)row * DM;
        f32x4 v[2][4]; float s[2] = {0.f, 0.f};
#pragma unroll
        for (int r = 0; r < 2; ++r)
#pragma unroll
            for (int j = 0; j < 4; ++j) v[r][j] = *(const f32x4*)(p + r * DM + 4 * lane + 256 * j);
#pragma unroll
        for (int r = 0; r < 2; ++r)
#pragma unroll
            for (int j = 0; j < 4; ++j) s[r] += (v[r][j][0] + v[r][j][1]) + (v[r][j][2] + v[r][j][3]);
        float mean[2], q[2] = {0.f, 0.f}, rstd[2];
#pragma unroll
        for (int r = 0; r < 2; ++r) { mean[r] = wave_sum_dpp(s[r]) * (1.f / DM);
#pragma unroll
            for (int j = 0; j < 4; ++j) { v[r][j] = v[r][j] - mean[r]; q[r] += (v[r][j][0] * v[r][j][0] + v[r][j][1] * v[r][j][1]) + (v[r][j][2] * v[r][j][2] + v[r][j][3] * v[r][j][3]); } }
#pragma unroll
        for (int r = 0; r < 2; ++r) rstd[r] = 1.0f / sqrtf(wave_sum_dpp(q[r]) * (1.f / DM) + 1e-5f);
#pragma unroll
        for (int j = 0; j < 4; ++j) {
            const int c = 4 * lane + 256 * j;
            const f32x4 gg = *(const f32x4*)(g + c), bb = *(const f32x4*)(b + c);
#pragma unroll
            for (int r = 0; r < 2; ++r) {
                const f32x4 o = v[r][j] * rstd[r] * gg + bb;
                uint2 w; w.x = cvtpk(o[0], o[1]); w.y = cvtpk(o[2], o[3]);
                if (ST) { *(f32x4*)(p + r * DM + c) = o; *(uint2*)(hb + (size_t)(row + r) * DM + c) = w; } else asm volatile("" :: "v"(w.x), "v"(w.y), "v"(o[0]), "v"(o[1]), "v"(o[2]), "v"(o[3]));
            }
        }
    }
}

__device__ __forceinline__ void rwkv_naive_chain(int chain, int lane, LAS float* sm, const bf16_t* __restrict__ proj, const float* __restrict__ mix, const float* __restrict__ w0, const float* __restrict__ w2,
                                                 const float* __restrict__ a0, const float* __restrict__ a2, const float* __restrict__ g2, const float* __restrict__ k_k,
                                                 const float* __restrict__ k_a, const float* __restrict__ r_k, const float* __restrict__ ln_g, const float* __restrict__ ln_b, bf16_t* __restrict__ ymix) {
    LAS float* s_w2 = sm; LAS float* s_a2 = sm + 4096; LAS float* s_g2 = sm + 8192; LAS float* s_tw = sm + 16384; LAS float* s_al = s_tw + 64; LAS float* s_sg = s_tw + 128;
    LAS float* s_w = s_tw + 256; LAS float* s_k = s_tw + 320; LAS float* s_a = s_tw + 384; LAS float* s_b = s_tw + 448; LAS float* s_r = s_tw + 512;
    const int b = chain >> 3, h = chain & 7, c = h * 64 + lane;
    for (int l = 0; l < 64; ++l) { s_w2[l * 64 + lane] = w2[l * 512 + c]; s_a2[l * 64 + lane] = a2[l * 512 + c]; }
    for (int l = 0; l < 128; ++l) s_g2[l * 64 + lane] = g2[l * 512 + c];
    const float mr = mix[c], mk = mix[512 + c], mv = mix[1024 + c], mw = mix[1536 + lane], ma = mix[1600 + lane], mg0 = mix[1664 + lane], mg1 = mix[1728 + lane];
    const float w0c = w0[c], a0c = a0[c], kkc = k_k[c], kac = k_a[c], rkc = r_k[c], lgc = ln_g[c], lbc = ln_b[c];
    float S[64];
#pragma unroll
    for (int j = 0; j < 64; ++j) S[j] = 0.f;
    float pr = 0.f, pk = 0.f, pv = 0.f, pw = 0.f, pa = 0.f, pg0 = 0.f, pg1 = 0.f;
    WSYNC();
    for (int t = 0; t < SEQ; ++t) {
        const bf16_t* row = proj + (size_t)(b * SEQ + t) * L0P;
        const float cr = bf2f(row[c]), ck = bf2f(row[512 + c]), cv = bf2f(row[1024 + c]), cw = bf2f(row[1536 + lane]), ca = bf2f(row[1600 + lane]),
                    cg0 = bf2f(row[1664 + lane]), cg1 = bf2f(row[1728 + lane]);
        const float r_s = cr + (pr - cr) * mr, k_s = ck + (pk - ck) * mk, v_s = cv + (pv - cv) * mv;
        const float wl = cw + (pw - cw) * mw, al = ca + (pa - ca) * ma, g0 = cg0 + (pg0 - cg0) * mg0, g1 = cg1 + (pg1 - cg1) * mg1;
        pr = cr; pk = ck; pv = cv; pw = cw; pa = ca; pg0 = cg0; pg1 = cg1;
        s_tw[lane] = tanhf(wl); s_al[lane] = al; s_sg[lane] = sigmoidf_(g0); s_sg[64 + lane] = sigmoidf_(g1);
        WSYNC();
        float wsum = w0c, asum = a0c, gsum = 0.f;
#pragma unroll 2
        for (int l = 0; l < 64; ++l) { wsum += s_tw[l] * s_w2[l * 64 + lane]; asum += s_al[l] * s_a2[l * 64 + lane]; }
#pragma unroll 2
        for (int l = 0; l < 128; ++l) gsum += s_sg[l] * s_g2[l * 64 + lane];
        const float log_w = -softplusf_(-wsum) - 0.5f;
        const float dec = expf(-expf(log_w));
        const float a = sigmoidf_(asum);
        float kkv = k_s * kkc;
        const float nrm = sqrtf(wave_sum(kkv * kkv));
        kkv = kkv / fmaxf(nrm, 1e-12f);
        const float k2 = k_s * (1.f + (a - 1.f) * kac);
        const float bonus_s = wave_sum(r_s * k2 * rkc);
        s_w[lane] = dec; s_k[lane] = k2; s_a[lane] = -kkv; s_b[lane] = kkv * a; s_r[lane] = r_s;
        WSYNC();
        float sa = 0.f;
#pragma unroll
        for (int j = 0; j < 64; ++j) sa += S[j] * s_a[j];
        float y = 0.f;
#pragma unroll
        for (int j = 0; j < 64; ++j) { S[j] = S[j] * s_w[j] + sa * s_b[j] + v_s * s_k[j]; y += S[j] * s_r[j]; }
        const float mu = wave_sum(y) * (1.f / 64.f);
        const float d = y - mu;
        const float var = wave_sum(d * d) * (1.f / 64.f);
        const float yn = d * (1.0f / sqrtf(var + 64e-5f)) * lgc + lbc;
        const float o = (yn + bonus_s * v_s) * gsum;
        ymix[(size_t)(b * SEQ + t) * DM + c] = (bf16_t)f2bf(o);
        WSYNC();
    }
}

__device__ __forceinline__ void ssm_conv_all(const bf16_t* __restrict__ proj, const float* __restrict__ cw, const float* __restrict__ cb, const float* __restrict__ dtb,
                                             bf16_t* __restrict__ xbc, float* __restrict__ dt, int gtid, int NT) {
    for (size_t i = gtid; i < (size_t)M * 1024; i += NT) {
        const int m = (int)(i >> 10), c = (int)(i & 1023), t = m & (SEQ - 1);
        float acc = cb[c];
#pragma unroll
        for (int k = 0; k < 4; ++k) { const int tt = t - 3 + k; if (tt >= 0) acc += cw[k * 1024 + c] * bf2f(proj[(size_t)(m - 3 + k) * L0P + 2304 + c]); }
        xbc[i] = (bf16_t)f2bf(siluf_(acc));
    }
    for (int i = gtid; i < M * 8; i += NT) dt[i] = softplusf_(bf2f(proj[(size_t)(i >> 3) * L0P + 3328 + (i & 7)]) + dtb[i & 7]);
}
__device__ __forceinline__ void ssd_naive_task(int task, int lane, const bf16_t* __restrict__ xbc, const float* __restrict__ dt, const float* __restrict__ a_log, const float* __restrict__ dsk, float* __restrict__ yssm) {
    const int chain = task >> 2, q = task & 3, b = chain >> 3, h = chain & 7, g = h >> 2, p = q * 16 + (lane >> 2), nq = lane & 3;
    const float A = -expf(a_log[h]), D = dsk[h];
    float st[32];
#pragma unroll
    for (int n = 0; n < 32; ++n) st[n] = 0.f;
    for (int t = 0; t < SEQ; ++t) {
        const size_t m = (size_t)b * SEQ + t;
        const float dtv = dt[m * 8 + h], dA = expf(dtv * A);
        const float x = bf2f(xbc[m * 1024 + h * 64 + p]), xdt = x * dtv;
        const bf16_t* Bp = xbc + m * 1024 + 512 + g * 128 + nq * 32;
        const bf16_t* Cp = xbc + m * 1024 + 768 + g * 128 + nq * 32;
        float yp = 0.f;
#pragma unroll
        for (int n = 0; n < 32; ++n) { st[n] = st[n] * dA + xdt * bf2f(Bp[n]); yp += st[n] * bf2f(Cp[n]); }
        yp += __shfl_xor(yp, 1); yp += __shfl_xor(yp, 2);
        if (nq == 0) yssm[m * 512 + h * 64 + p] = yp + D * x;
    }
}
template <bool ST = true> __device__ __forceinline__ void ssm_gate_norm_all(const bf16_t* __restrict__ yssm, const bf16_t* __restrict__ proj, const float* __restrict__ ng, bf16_t* __restrict__ ymix, int wv0, int wvend, int lane) {
#pragma unroll 2
    for (int wv = wv0; wv < wvend; wv += NWAVES) {
        const int m = wv >> 1, g = wv & 1;
        float u[4], q = 0.f;
#pragma unroll
        for (int j = 0; j < 4; ++j) { const int c = g * 256 + j * 64 + lane; const float z = bf2f(proj[(size_t)m * L0P + 1792 + c]); u[j] = bf2f(yssm[(size_t)m * 512 + c]) * siluf_(z); q += u[j] * u[j]; }
        const float rs = 1.0f / sqrtf(wave_sum(q) * (1.f / 256.f) + 1e-5f);
#pragma unroll
        for (int j = 0; j < 4; ++j) { const int c = g * 256 + j * 64 + lane; const float o_ = u[j] * rs * ng[c]; if (ST) ymix[(size_t)m * DM + 512 + c] = (bf16_t)f2bf(o_); else asm volatile("" :: "v"(o_)); }
    }
}
template <bool ST = true> __device__ __forceinline__ void ffn_act_all(bf16_t* gu, const float* __restrict__ cw, const float* __restrict__ cb, int gtid, int NT) {
    constexpr int NCH = DFF / 8, NSTRIP = M / 32;
    for (int task = gtid; task < NSTRIP * NCH; task += NT) {
        const int strip = task / NCH, q = task - strip * NCH, c0 = q * 8, m0 = strip * 32;
        float w0[8], w1[8], w2[8], bb[8], g2[8], g1[8];
#pragma unroll
        for (int j = 0; j < 8; j += 4) { const f32x4 a = *(const f32x4*)(cw + c0 + j), b = *(const f32x4*)(cw + DFF + c0 + j), c = *(const f32x4*)(cw + 2 * DFF + c0 + j), d = *(const f32x4*)(cb + c0 + j);
#pragma unroll
            for (int k = 0; k < 4; ++k) { w0[j + k] = a[k]; w1[j + k] = b[k]; w2[j + k] = c[k]; bb[j + k] = d[k]; } }
        bf16_t* base = gu + (size_t)m0 * (2 * DFF) + c0;
        if ((m0 & (SEQ - 1)) != 0) { const v4u a = *(const v4u*)(base - 2 * (2 * DFF)), b = *(const v4u*)(base - (2 * DFF));
            g2[0] = bflo(a.x); g2[1] = bfhi(a.x); g2[2] = bflo(a.y); g2[3] = bfhi(a.y); g2[4] = bflo(a.z); g2[5] = bfhi(a.z); g2[6] = bflo(a.w); g2[7] = bfhi(a.w);
            g1[0] = bflo(b.x); g1[1] = bfhi(b.x); g1[2] = bflo(b.y); g1[3] = bfhi(b.y); g1[4] = bflo(b.z); g1[5] = bfhi(b.z); g1[6] = bflo(b.w); g1[7] = bfhi(b.w); }
        else {
#pragma unroll
            for (int j = 0; j < 8; ++j) { g2[j] = 0.f; g1[j] = 0.f; } }
#pragma unroll 4
        for (int r = 0; r < 32; ++r) {
            const v4u gv = *(const v4u*)(base + (size_t)r * (2 * DFF)), uv = *(const v4u*)(base + (size_t)r * (2 * DFF) + DFF);
            const unsigned gw_[4] = {gv.x, gv.y, gv.z, gv.w}, uw_[4] = {uv.x, uv.y, uv.z, uv.w};
            unsigned ow[4];
#pragma unroll
            for (int k = 0; k < 4; ++k) {
                const float ga = bflo(gw_[k]), gb = bfhi(gw_[k]);
                const float ya = bb[2 * k] + w0[2 * k] * g2[2 * k] + w1[2 * k] * g1[2 * k] + w2[2 * k] * ga;
                const float yb = bb[2 * k + 1] + w0[2 * k + 1] * g2[2 * k + 1] + w1[2 * k + 1] * g1[2 * k + 1] + w2[2 * k + 1] * gb;
                g2[2 * k] = g1[2 * k]; g1[2 * k] = ga; g2[2 * k + 1] = g1[2 * k + 1]; g1[2 * k + 1] = gb;
                ow[k] = cvtpk(ya / (1.f + __expf(-ya)) * bflo(uw_[k]), yb / (1.f + __expf(-yb)) * bfhi(uw_[k]));
            }
            if (ST) *(v4u*)(base + (size_t)r * (2 * DFF) + DFF) = (v4u){ow[0], ow[1], ow[2], ow[3]}; else asm volatile("" :: "v"(ow[0]), "v"(ow[1]), "v"(ow[2]), "v"(ow[3]));
        }
    }
}
template <bool ST = true> __device__ __forceinline__ void mla_prep_all(const bf16_t* __restrict__ proj1, const int* __restrict__ pos, float* __restrict__ rs, bf16_t* __restrict__ kpe, float* __restrict__ cstab, int gw, int NGW, int lane) {
    for (int m = gw; m < M; m += NGW) {
        const bf16_t* row = proj1 + (size_t)m * L1P;
        float q = 0.f;
#pragma unroll
        for (int j = 0; j < 4; ++j) { const float v = bf2f(row[1536 + j * 64 + lane]); q += v * v; }
        q = wave_sum(q);
        float k = 0.f;
#pragma unroll
        for (int j = 0; j < 2; ++j) { const float v = bf2f(row[1792 + j * 64 + lane]); k += v * v; }
        k = wave_sum(k);
        if (ST && lane == 0) { rs[(size_t)m * 2] = 1.0f / sqrtf(q * (1.f / 256.f) + 1e-6f); rs[(size_t)m * 2 + 1] = 1.0f / sqrtf(k * (1.f / 128.f) + 1e-6f); }
        if (lane < 16) {
            const double inv = pow(10000.0, -(double)(2 * lane) / 32.0);
            const double ang = (double)pos[m] * inv;
            const float cs = (float)cos(ang), sn = (float)sin(ang);
            if (ST) { cstab[(size_t)m * 32 + lane] = cs; cstab[(size_t)m * 32 + 16 + lane] = sn; }
            const float x1 = bf2f(row[1920 + lane]), x2 = bf2f(row[1936 + lane]);
            const bf16_t r1_ = (bf16_t)f2bf(x1 * cs - x2 * sn), r2_ = (bf16_t)f2bf(x2 * cs + x1 * sn);
            if (ST) { kpe[(size_t)m * 32 + lane] = r1_; kpe[(size_t)m * 32 + 16 + lane] = r2_; } else asm volatile("" :: "v"((unsigned)r1_), "v"((unsigned)r2_), "v"(q), "v"(k));
        }
    }
}
template <bool ST = true> __device__ __forceinline__ void rope_q_all(bf16_t* qm, const float* __restrict__ cstab, int gtid, int NT) {
    for (int i = gtid; i < M * 16; i += NT) {
        const int m = i >> 4, h = (i >> 1) & 7, k0 = (i & 1) * 8;
        bf16_t* p = qm + (size_t)m * 768 + h * 96 + 64 + k0;
        const v4u a = *(const v4u*)p, b = *(const v4u*)(p + 16);
        const f32x4 c0 = *(const f32x4*)(cstab + (size_t)m * 32 + k0), c1 = *(const f32x4*)(cstab + (size_t)m * 32 + k0 + 4), s0 = *(const f32x4*)(cstab + (size_t)m * 32 + 16 + k0), s1 = *(const f32x4*)(cstab + (size_t)m * 32 + 16 + k0 + 4);
        const unsigned au[4] = {a.x, a.y, a.z, a.w}, bu[4] = {b.x, b.y, b.z, b.w};
        const float cs[8] = {c0[0], c0[1], c0[2], c0[3], c1[0], c1[1], c1[2], c1[3]}, sn[8] = {s0[0], s0[1], s0[2], s0[3], s1[0], s1[1], s1[2], s1[3]};
        unsigned o1[4], o2[4];
#pragma unroll
        for (int q = 0; q < 4; ++q) { const float x1a = bflo(au[q]), x1b = bfhi(au[q]), x2a = bflo(bu[q]), x2b = bfhi(bu[q]);
            o1[q] = cvtpk(x1a * cs[2 * q] - x2a * sn[2 * q], x1b * cs[2 * q + 1] - x2b * sn[2 * q + 1]);
            o2[q] = cvtpk(x2a * cs[2 * q] + x1a * sn[2 * q], x2b * cs[2 * q + 1] + x1b * sn[2 * q + 1]); }
        if (ST) { *(v4u*)p = (v4u){o1[0], o1[1], o1[2], o1[3]}; *(v4u*)(p + 16) = (v4u){o2[0], o2[1], o2[2], o2[3]}; }
    }
}
__device__ __forceinline__ void sb_naive_task(int qblk, int bh, int lane, const bf16_t* __restrict__ proj1, bf16_t* __restrict__ ymix) {
    const int b = bh >> 3, h = bh & 7, t = qblk * 64 + lane;
    const size_t mrow = (size_t)b * SEQ;
    float q[64], o[64];
#pragma unroll
    for (int d = 0; d < 64; ++d) { q[d] = bf2f(proj1[(mrow + t) * L1P + h * 64 + d]) * 0.125f; o[d] = 0.f; }
    float cum = 0.f;
    const int smax = qblk * 64 + 63;
    for (int s = smax - 1; s >= 0; --s) {
        const bf16_t* kr = proj1 + (mrow + s) * L1P + 512 + h * 64;
        const bf16_t* vr = proj1 + (mrow + s) * L1P + 1024 + h * 64;
        float z = 0.f;
#pragma unroll
        for (int d = 0; d < 64; ++d) z += q[d] * bf2f(kr[d]);
        if (s < t) {
            const float lsp = -softplusf_(-z);
            const float lsn = -softplusf_(z);
            const float att = expf(lsp + cum);
            cum += lsn;
#pragma unroll
            for (int d = 0; d < 64; ++d) o[d] += att * bf2f(vr[d]);
        }
    }
#pragma unroll
    for (int d = 0; d < 64; ++d) ymix[(mrow + t) * DM + h * 64 + d] = (bf16_t)f2bf(o[d]);
}
__device__ __forceinline__ void mla_naive_task(int qblk, int bh, int lane, const bf16_t* __restrict__ qm, const bf16_t* __restrict__ kvm, const bf16_t* __restrict__ kpe, bf16_t* __restrict__ ymix) {
    const int b = bh >> 3, h = bh & 7, t = qblk * 64 + lane;
    const size_t mrow = (size_t)b * SEQ;
    const float scale = 0.10206207261596577f;
    float q[96], o[64];
#pragma unroll
    for (int d = 0; d < 96; ++d) q[d] = bf2f(qm[(mrow + t) * 768 + h * 96 + d]) * scale;
#pragma unroll
    for (int d = 0; d < 64; ++d) o[d] = 0.f;
    float mx = -1e30f, l = 0.f;
    const int smax = qblk * 64 + 63;
    for (int s = 0; s <= smax; ++s) {
        const bf16_t* kr = kvm + (mrow + s) * 1024 + h * 128;
        const bf16_t* pr = kpe + (mrow + s) * 32;
        float z = 0.f;
#pragma unroll
        for (int d = 0; d < 64; ++d) z += q[d] * bf2f(kr[d]);
#pragma unroll
        for (int d = 0; d < 32; ++d) z += q[64 + d] * bf2f(pr[d]);
        if (s <= t) {
            const float mn = fmaxf(mx, z), f = expf(mx - mn), pz = expf(z - mn);
            l = l * f + pz; mx = mn;
#pragma unroll
            for (int d = 0; d < 64; ++d) o[d] = o[d] * f + pz * bf2f(kr[64 + d]);
        }
    }
    const float il = 1.f / l;
#pragma unroll
    for (int d = 0; d < 64; ++d) ymix[(mrow + t) * DM + 512 + h * 64 + d] = (bf16_t)f2bf(o[d] * il);
}


__device__ __forceinline__ int crow(int r, int hi) { return (r & 3) + 8 * (r >> 2) + 4 * hi; }
#define MFMA32(a, b, c) __builtin_amdgcn_mfma_f32_32x32x16_bf16((a), (b), (c), 0, 0, 0)
constexpr int STG_PITCH = 72;
__device__ __forceinline__ void transpose_tile64(const bf16_t* __restrict__ src, int sp, bf16_t* __restrict__ dst, int dp, LAS bf16_t* scr, int lane) {
#pragma unroll
    for (int i = 0; i < 8; ++i) { const int row = i * 8 + (lane >> 3), ch = lane & 7; const v4u v = *(const v4u*)(src + (size_t)row * sp + ch * 8); *(LAS v4u*)(scr + row * STG_PITCH + ch * 8) = v; }
    WSYNC();
#pragma unroll
    for (int i = 0; i < 8; ++i) { const int d = i * 8 + (lane >> 3), tc = lane & 7; const LAS bf16_t* p = scr + (tc * 8) * STG_PITCH + d;
        v4u o; o.x = (unsigned)p[0] | ((unsigned)p[STG_PITCH] << 16); o.y = (unsigned)p[2 * STG_PITCH] | ((unsigned)p[3 * STG_PITCH] << 16);
        o.z = (unsigned)p[4 * STG_PITCH] | ((unsigned)p[5 * STG_PITCH] << 16); o.w = (unsigned)p[6 * STG_PITCH] | ((unsigned)p[7 * STG_PITCH] << 16);
        *(v4u*)(dst + (size_t)d * dp + tc * 8) = o; }
    WSYNC();
}
__device__ __forceinline__ void store_OT(const f32x16 (&o)[2], float sc, LAS bf16_t* stg, bf16_t* __restrict__ dst, int lane) {
    const int l31 = lane & 31, hi = lane >> 5;
#pragma unroll
    for (int dt = 0; dt < 2; ++dt)
#pragma unroll
        for (int r = 0; r < 16; ++r) stg[l31 * STG_PITCH + 32 * dt + crow(r, hi)] = (bf16_t)f2bf(o[dt][r] * sc);
    WSYNC();
#pragma unroll
    for (int i = 0; i < 4; ++i) { const int row = i * 8 + (lane >> 3), ch = lane & 7; const v4u v = *(const LAS v4u*)(stg + row * STG_PITCH + ch * 8); *(v4u*)(dst + (size_t)row * DM + ch * 8) = v; }
    WSYNC();
}
__device__ __forceinline__ float softplus_fast(float z) { return fmaxf(z, 0.f) + __logf(1.f + __expf(-fabsf(z))); }

__device__ __forceinline__ void sb_task(int bh, int qblk, int lane, const bf16_t* __restrict__ P1, const bf16_t* __restrict__ VT, bf16_t* __restrict__ ymix, LAS bf16_t* stg) {
    const int b = bh >> 3, h = bh & 7, l31 = lane & 31, hi = lane >> 5, q0 = qblk * 32, t = q0 + l31;
    const size_t rowb = (size_t)b * SEQ;
    const bf16_t* Qp = P1 + (rowb + q0 + l31) * L1P + h * 64 + 8 * hi;
    bf16x8 qf[4];
#pragma unroll
    for (int kk = 0; kk < 4; ++kk) qf[kk] = *(const bf16x8*)(Qp + 16 * kk);
    const bf16_t* Kp = P1 + (rowb + l31) * L1P + 512 + h * 64 + 8 * hi;
    const bf16_t* Vp = VT + ((size_t)bh * 64 + l31) * SEQ + 4 * hi;
    f32x16 o[2];
#pragma unroll
    for (int r = 0; r < 16; ++r) { o[0][r] = 0.f; o[1][r] = 0.f; }
    float cum = 0.f;
    bf16x8 kf[4]; u32x2 va[2][2][2];
#define SB_LOAD(S0, KF, VA) do { _Pragma("unroll") for (int kk = 0; kk < 4; ++kk) KF[kk] = *(const bf16x8*)(Kp + (size_t)(S0) * L1P + 16 * kk); \
        _Pragma("unroll") for (int dt = 0; dt < 2; ++dt) _Pragma("unroll") for (int ks = 0; ks < 2; ++ks) { VA[dt][ks][0] = *(const u32x2*)(Vp + (size_t)dt * 32 * SEQ + (S0) + 16 * ks); VA[dt][ks][1] = *(const u32x2*)(Vp + (size_t)dt * 32 * SEQ + (S0) + 16 * ks + 8); } } while (0)
    SB_LOAD(q0, kf, va);
    for (int s0 = q0; s0 >= 0; s0 -= 32) {
        bf16x8 kn[4]; u32x2 vn[2][2][2];
        const int sn = (s0 >= 32) ? s0 - 32 : 0;
        SB_LOAD(sn, kn, vn);
        f32x16 acc;
#pragma unroll
        for (int r = 0; r < 16; ++r) acc[r] = 0.f;
#pragma unroll
        for (int kk = 0; kk < 4; ++kk) acc = MFMA32(kf[kk], qf[kk], acc);
        const bool diag = (s0 == q0);
        float lb[16], lk[16];
#pragma unroll
        for (int r = 0; r < 16; ++r) { const float z = acc[r] * 0.125f; const float sp = softplus_fast(z); float b_ = z - sp, k_ = -sp;
            if (diag) { const bool valid = (s0 + crow(r, hi)) < t; b_ = valid ? b_ : -1e30f; k_ = valid ? k_ : 0.f; }
            lb[r] = b_; lk[r] = k_; }
        float e[16], T[4], U[4];
#pragma unroll
        for (int i = 0; i < 4; ++i) { e[4 * i + 3] = 0.f; e[4 * i + 2] = lk[4 * i + 3]; e[4 * i + 1] = e[4 * i + 2] + lk[4 * i + 2]; e[4 * i] = e[4 * i + 1] + lk[4 * i + 1]; T[i] = e[4 * i] + lk[4 * i]; }
#pragma unroll
        for (int i = 0; i < 4; ++i) U[i] = __shfl_xor(T[i], 32);
        float off[4];
        { const float st2 = T[3], st1 = st2 + T[2], st0 = st1 + T[1]; const float su2 = U[3], su1 = su2 + U[2], su0 = su1 + U[1];
          const float x0 = hi ? 0.f : U[0], x1 = hi ? 0.f : U[1], x2 = hi ? 0.f : U[2], x3 = hi ? 0.f : U[3];
          off[3] = x3; off[2] = st2 + su2 + x2; off[1] = st1 + su1 + x1; off[0] = st0 + su0 + x0;
          const float total = st0 + T[0] + su0 + U[0];
#pragma unroll
          for (int r = 0; r < 16; ++r) acc[r] = __expf(lb[r] + (cum + off[r >> 2] + e[r]));
          cum += total; }
        bf16x8 pf[2];
#pragma unroll
        for (int ks = 0; ks < 2; ++ks) { v4u w; w.x = cvtpk(acc[8 * ks], acc[8 * ks + 1]); w.y = cvtpk(acc[8 * ks + 2], acc[8 * ks + 3]); w.z = cvtpk(acc[8 * ks + 4], acc[8 * ks + 5]); w.w = cvtpk(acc[8 * ks + 6], acc[8 * ks + 7]); pf[ks] = __builtin_bit_cast(bf16x8, w); }
#pragma unroll
        for (int dt = 0; dt < 2; ++dt)
#pragma unroll
            for (int ks = 0; ks < 2; ++ks) { v4u a; a.x = va[dt][ks][0].x; a.y = va[dt][ks][0].y; a.z = va[dt][ks][1].x; a.w = va[dt][ks][1].y; o[dt] = MFMA32(__builtin_bit_cast(bf16x8, a), pf[ks], o[dt]); }
        if (__all(cum < -110.f)) break;
#pragma unroll
        for (int kk = 0; kk < 4; ++kk) kf[kk] = kn[kk];
#pragma unroll
        for (int dt = 0; dt < 2; ++dt)
#pragma unroll
            for (int ks = 0; ks < 2; ++ks) { va[dt][ks][0] = vn[dt][ks][0]; va[dt][ks][1] = vn[dt][ks][1]; }
    }
#undef SB_LOAD
    store_OT(o, 1.0f, stg, ymix + (rowb + q0) * DM + h * 64, lane);
}
__device__ __forceinline__ void mla_task(int bh, int qblk, int lane, const bf16_t* __restrict__ QM, const bf16_t* __restrict__ KVM, const bf16_t* __restrict__ KPE, const bf16_t* __restrict__ VT,
                                         bf16_t* __restrict__ ymix, LAS bf16_t* stg) {
    const int b = bh >> 3, h = bh & 7, l31 = lane & 31, hi = lane >> 5, q0 = qblk * 32, t = q0 + l31;
    const size_t rowb = (size_t)b * SEQ;
    const bf16_t* Qp = QM + (rowb + q0 + l31) * 768 + h * 96 + 8 * hi;
    bf16x8 qf[6];
#pragma unroll
    for (int kk = 0; kk < 6; ++kk) qf[kk] = *(const bf16x8*)(Qp + 16 * kk);
    const bf16_t* Kn = KVM + (rowb + l31) * 1024 + h * 128 + 8 * hi;
    const bf16_t* Kr = KPE + (rowb + l31) * 32 + 8 * hi;
    const bf16_t* Vp = VT + ((size_t)bh * 64 + l31) * SEQ + 4 * hi;
    const float sc2 = 0.10206207261596577f * 1.4426950408889634f;
    f32x16 o[2];
#pragma unroll
    for (int r = 0; r < 16; ++r) { o[0][r] = 0.f; o[1][r] = 0.f; }
    float mrun = -1e30f, lsum = 0.f;
    bf16x8 kf[6]; u32x2 va[2][2][2];
#define ML_LOAD(S0, KF, VA) do { _Pragma("unroll") for (int kk = 0; kk < 4; ++kk) KF[kk] = *(const bf16x8*)(Kn + (size_t)(S0) * 1024 + 16 * kk); \
        _Pragma("unroll") for (int kk = 0; kk < 2; ++kk) KF[4 + kk] = *(const bf16x8*)(Kr + (size_t)(S0) * 32 + 16 * kk); \
        _Pragma("unroll") for (int dt = 0; dt < 2; ++dt) _Pragma("unroll") for (int ks = 0; ks < 2; ++ks) { VA[dt][ks][0] = *(const u32x2*)(Vp + (size_t)dt * 32 * SEQ + (S0) + 16 * ks); VA[dt][ks][1] = *(const u32x2*)(Vp + (size_t)dt * 32 * SEQ + (S0) + 16 * ks + 8); } } while (0)
    ML_LOAD(0, kf, va);
    for (int s0 = 0; s0 <= q0; s0 += 32) {
        bf16x8 kn[6]; u32x2 vn[2][2][2];
        const int sn = (s0 + 32 <= q0) ? s0 + 32 : s0;
        ML_LOAD(sn, kn, vn);
        f32x16 acc;
#pragma unroll
        for (int r = 0; r < 16; ++r) acc[r] = 0.f;
#pragma unroll
        for (int kk = 0; kk < 6; ++kk) acc = MFMA32(kf[kk], qf[kk], acc);
        const bool diag = (s0 == q0);
        float tmax = -1e30f;
#pragma unroll
        for (int r = 0; r < 16; ++r) { float z = acc[r] * sc2; if (diag && (s0 + crow(r, hi)) > t) z = -1e30f; acc[r] = z; tmax = fmaxf(tmax, z); }
        tmax = fmaxf(tmax, __shfl_xor(tmax, 32));
        const float mn = fmaxf(mrun, tmax), alpha = exp2f(mrun - mn); mrun = mn;
        float ps = 0.f;
#pragma unroll
        for (int r = 0; r < 16; ++r) { acc[r] = exp2f(acc[r] - mn); ps += acc[r]; }
        lsum = lsum * alpha + ps;
#pragma unroll
        for (int r = 0; r < 16; ++r) { o[0][r] *= alpha; o[1][r] *= alpha; }
        bf16x8 pf[2];
#pragma unroll
        for (int ks = 0; ks < 2; ++ks) { v4u w; w.x = cvtpk(acc[8 * ks], acc[8 * ks + 1]); w.y = cvtpk(acc[8 * ks + 2], acc[8 * ks + 3]); w.z = cvtpk(acc[8 * ks + 4], acc[8 * ks + 5]); w.w = cvtpk(acc[8 * ks + 6], acc[8 * ks + 7]); pf[ks] = __builtin_bit_cast(bf16x8, w); }
#pragma unroll
        for (int dt = 0; dt < 2; ++dt)
#pragma unroll
            for (int ks = 0; ks < 2; ++ks) { v4u a; a.x = va[dt][ks][0].x; a.y = va[dt][ks][0].y; a.z = va[dt][ks][1].x; a.w = va[dt][ks][1].y; o[dt] = MFMA32(__builtin_bit_cast(bf16x8, a), pf[ks], o[dt]); }
#pragma unroll
        for (int kk = 0; kk < 6; ++kk) kf[kk] = kn[kk];
#pragma unroll
        for (int dt = 0; dt < 2; ++dt)
#pragma unroll
            for (int ks = 0; ks < 2; ++ks) { va[dt][ks][0] = vn[dt][ks][0]; va[dt][ks][1] = vn[dt][ks][1]; }
    }
#undef ML_LOAD
    lsum += __shfl_xor(lsum, 32);
    store_OT(o, 1.0f / lsum, stg, ymix + (rowb + q0) * DM + 512 + h * 64, lane);
}


constexpr int MLK_PITCH = 104, MLV_PITCH = 68, MLK_BYTES = 64 * MLK_PITCH * 2, MLV_BYTES = 64 * MLV_PITCH * 2, ML_STAGE = MLK_BYTES + MLV_BYTES;
__device__ __forceinline__ void mla_block(int bh, int sb, int tid, int lane, int wave, LAS unsigned char* lds, const bf16_t* __restrict__ QM, const bf16_t* __restrict__ KVM, const bf16_t* __restrict__ KPE,
                                          const bf16_t* __restrict__ VT, bf16_t* __restrict__ ymix) {
    const int b = bh >> 3, h = bh & 7, l31 = lane & 31, hi = lane >> 5, q0 = 256 * sb + 32 * wave, t = q0 + l31;
    const size_t rowb = (size_t)b * SEQ;
    const int nsteps = 4 * sb + 4;
    bf16x8 qf[6];
    { const bf16_t* Qp = QM + (rowb + q0 + l31) * 768 + h * 96 + 8 * hi;
#pragma unroll
      for (int kk = 0; kk < 6; ++kk) qf[kk] = *(const bf16x8*)(Qp + 16 * kk); }
    const float sc2 = 0.10206207261596577f * 1.4426950408889634f;
    f32x16 o[2];
#pragma unroll
    for (int r = 0; r < 16; ++r) { o[0][r] = 0.f; o[1][r] = 0.f; }
    float mrun = -1e30f, lsum = 0.f;
    const bf16_t* gKn = KVM + (rowb + (tid >> 3)) * 1024 + h * 128 + (tid & 7) * 8;
    const bf16_t* gKr = KPE + (rowb + ((tid & 255) >> 2)) * 32 + (tid & 3) * 8;
    const bf16_t* gVt = VT + ((size_t)bh * 64 + (tid >> 3)) * SEQ + (tid & 7) * 8;
    const int lKn = (tid >> 3) * (MLK_PITCH * 2) + (tid & 7) * 16, lKr = ((tid & 255) >> 2) * (MLK_PITCH * 2) + 128 + (tid & 3) * 16, lVt = MLK_BYTES + (tid >> 3) * (MLV_PITCH * 2) + (tid & 7) * 16;
    v4u rk, rr, rv;
    rk = *(const v4u*)gKn; rr = *(const v4u*)gKr; rv = *(const v4u*)gVt;
    *(LAS v4u*)(lds + lKn) = rk; if (tid < 256) *(LAS v4u*)(lds + lKr) = rr; *(LAS u32x2*)(lds + lVt) = (u32x2){rv.x, rv.y}; *(LAS u32x2*)(lds + lVt + 8) = (u32x2){rv.z, rv.w};
    __syncthreads();
#pragma unroll 1
    for (int step = 0; step < nsteps; ++step) {
        const int nx = (step + 1 < nsteps) ? step + 1 : step;
        rk = *(const v4u*)(gKn + (size_t)nx * 64 * 1024); rr = *(const v4u*)(gKr + (size_t)nx * 64 * 32); rv = *(const v4u*)(gVt + nx * 64);
        const LAS unsigned char* Kb = lds + (step & 1) * ML_STAGE;
        const LAS unsigned char* Vb = Kb + MLK_BYTES;
#pragma unroll
        for (int sub = 0; sub < 2; ++sub) {
            const int s0 = 64 * step + 32 * sub;
            if (s0 <= q0) {
                f32x16 acc;
#pragma unroll
                for (int r = 0; r < 16; ++r) acc[r] = 0.f;
#pragma unroll
                for (int kk = 0; kk < 6; ++kk) { const bf16x8 kf = *(const LAS bf16x8*)(Kb + (32 * sub + l31) * (MLK_PITCH * 2) + (16 * kk + 8 * hi) * 2); acc = MFMA32(kf, qf[kk], acc); }
                const bool diag = (s0 == q0);
                float tmax = -1e30f;
#pragma unroll
                for (int r = 0; r < 16; ++r) { float z = acc[r] * sc2; if (diag && (s0 + crow(r, hi)) > t) z = -1e30f; acc[r] = z; tmax = fmaxf(tmax, z); }
                tmax = fmaxf(tmax, __shfl_xor(tmax, 32));
                const float mn = fmaxf(mrun, tmax), alpha = __builtin_amdgcn_exp2f(mrun - mn); mrun = mn;
                float ps = 0.f;
#pragma unroll
                for (int r = 0; r < 16; ++r) { acc[r] = __builtin_amdgcn_exp2f(acc[r] - mn); ps += acc[r]; }
                lsum = lsum * alpha + ps;
#pragma unroll
                for (int r = 0; r < 16; ++r) { o[0][r] *= alpha; o[1][r] *= alpha; }
                bf16x8 pf[2];
#pragma unroll
                for (int ks = 0; ks < 2; ++ks) { v4u w; w.x = cvtpk(acc[8 * ks], acc[8 * ks + 1]); w.y = cvtpk(acc[8 * ks + 2], acc[8 * ks + 3]); w.z = cvtpk(acc[8 * ks + 4], acc[8 * ks + 5]); w.w = cvtpk(acc[8 * ks + 6], acc[8 * ks + 7]); pf[ks] = __builtin_bit_cast(bf16x8, w); }
#pragma unroll
                for (int dt = 0; dt < 2; ++dt)
#pragma unroll
                    for (int ks = 0; ks < 2; ++ks) { const LAS unsigned char* vp = Vb + (32 * dt + l31) * (MLV_PITCH * 2) + (32 * sub + 16 * ks + 4 * hi) * 2;
                        const u32x2 x0 = *(const LAS u32x2*)vp, x1 = *(const LAS u32x2*)(vp + 16);
                        v4u a; a.x = x0.x; a.y = x0.y; a.z = x1.x; a.w = x1.y; o[dt] = MFMA32(__builtin_bit_cast(bf16x8, a), pf[ks], o[dt]); }
            }
        }
        LAS unsigned char* nb = lds + ((step + 1) & 1) * ML_STAGE;
        *(LAS v4u*)(nb + lKn) = rk; if (tid < 256) *(LAS v4u*)(nb + lKr) = rr; *(LAS u32x2*)(nb + lVt) = (u32x2){rv.x, rv.y}; *(LAS u32x2*)(nb + lVt + 8) = (u32x2){rv.z, rv.w};
        __syncthreads();
    }
    lsum += __shfl_xor(lsum, 32);
    store_OT(o, 1.0f / lsum, (LAS bf16_t*)(lds + 2 * ML_STAGE) + wave * (32 * STG_PITCH), ymix + (rowb + q0) * DM + 512 + h * 64, lane);
    __syncthreads();
}


constexpr int SBK_PITCH = 72, SBK_BYTES = 64 * SBK_PITCH * 2, SB_STAGE = SBK_BYTES + MLV_BYTES;
__device__ __forceinline__ void sb_block(int bh, int sb, int tid, int lane, int wave, LAS unsigned char* lds, const bf16_t* __restrict__ P1, const bf16_t* __restrict__ VT, bf16_t* __restrict__ ymix) {
    const int b = bh >> 3, h = bh & 7, l31 = lane & 31, hi = lane >> 5, q0 = 256 * sb + 32 * wave, t = q0 + l31;
    const size_t rowb = (size_t)b * SEQ;
    bf16x8 qf[4];
    { const bf16_t* Qp = P1 + (rowb + q0 + l31) * L1P + h * 64 + 8 * hi;
#pragma unroll
      for (int kk = 0; kk < 4; ++kk) qf[kk] = *(const bf16x8*)(Qp + 16 * kk); }
    f32x16 o[2];
#pragma unroll
    for (int r = 0; r < 16; ++r) { o[0][r] = 0.f; o[1][r] = 0.f; }
    float cum = 0.f; bool done = false;
    volatile LAS unsigned* flags = (volatile LAS unsigned*)(lds + 2 * SB_STAGE);
    const bf16_t* gK = P1 + (rowb + (tid >> 3)) * L1P + 512 + h * 64 + (tid & 7) * 8;
    const bf16_t* gVt = VT + ((size_t)bh * 64 + (tid >> 3)) * SEQ + (tid & 7) * 8;
    const int lK = (tid >> 3) * (SBK_PITCH * 2) + (tid & 7) * 16, lVt = SBK_BYTES + (tid >> 3) * (MLV_PITCH * 2) + (tid & 7) * 16;
    const int top = 4 * sb + 3;
    v4u rk, rv;
    rk = *(const v4u*)(gK + (size_t)top * 64 * L1P); rv = *(const v4u*)(gVt + top * 64);
    *(LAS v4u*)(lds + lK) = rk; *(LAS u32x2*)(lds + lVt) = (u32x2){rv.x, rv.y}; *(LAS u32x2*)(lds + lVt + 8) = (u32x2){rv.z, rv.w};
    __syncthreads();
#pragma unroll 1
    for (int i = 0; i <= top; ++i) {
        const int step = top - i, nx = (step > 0) ? step - 1 : 0;
        rk = *(const v4u*)(gK + (size_t)nx * 64 * L1P); rv = *(const v4u*)(gVt + nx * 64);
        const LAS unsigned char* Kb = lds + (i & 1) * SB_STAGE;
        const LAS unsigned char* Vb = Kb + SBK_BYTES;
#pragma unroll
        for (int sub = 1; sub >= 0; --sub) {
            const int s0 = 64 * step + 32 * sub;
            if (s0 <= q0 && !done) {
                f32x16 acc;
#pragma unroll
                for (int r = 0; r < 16; ++r) acc[r] = 0.f;
#pragma unroll
                for (int kk = 0; kk < 4; ++kk) { const bf16x8 kf = *(const LAS bf16x8*)(Kb + (32 * sub + l31) * (SBK_PITCH * 2) + (16 * kk + 8 * hi) * 2); acc = MFMA32(kf, qf[kk], acc); }
                const bool diag = (s0 == q0);
                float lb[16], lk[16];
#pragma unroll
                for (int r = 0; r < 16; ++r) { const float z = acc[r] * 0.125f; const float sp = softplus_fast(z); float b_ = z - sp, k_ = -sp;
                    if (diag) { const bool valid = (s0 + crow(r, hi)) < t; b_ = valid ? b_ : -1e30f; k_ = valid ? k_ : 0.f; }
                    lb[r] = b_; lk[r] = k_; }
                float e[16], T[4], U[4];
#pragma unroll
                for (int q = 0; q < 4; ++q) { e[4 * q + 3] = 0.f; e[4 * q + 2] = lk[4 * q + 3]; e[4 * q + 1] = e[4 * q + 2] + lk[4 * q + 2]; e[4 * q] = e[4 * q + 1] + lk[4 * q + 1]; T[q] = e[4 * q] + lk[4 * q]; }
#pragma unroll
                for (int q = 0; q < 4; ++q) U[q] = __shfl_xor(T[q], 32);
                { const float st2 = T[3], st1 = st2 + T[2], st0 = st1 + T[1]; const float su2 = U[3], su1 = su2 + U[2], su0 = su1 + U[1];
                  const float x0 = hi ? 0.f : U[0], x1 = hi ? 0.f : U[1], x2 = hi ? 0.f : U[2], x3 = hi ? 0.f : U[3];
                  const float off[4] = {st0 + su0 + x0, st1 + su1 + x1, st2 + su2 + x2, x3};
                  const float total = st0 + T[0] + su0 + U[0];
#pragma unroll
                  for (int r = 0; r < 16; ++r) acc[r] = __expf(lb[r] + (cum + off[r >> 2] + e[r]));
                  cum += total; }
                bf16x8 pf[2];
#pragma unroll
                for (int ks = 0; ks < 2; ++ks) { v4u w; w.x = cvtpk(acc[8 * ks], acc[8 * ks + 1]); w.y = cvtpk(acc[8 * ks + 2], acc[8 * ks + 3]); w.z = cvtpk(acc[8 * ks + 4], acc[8 * ks + 5]); w.w = cvtpk(acc[8 * ks + 6], acc[8 * ks + 7]); pf[ks] = __builtin_bit_cast(bf16x8, w); }
#pragma unroll
                for (int dt = 0; dt < 2; ++dt)
#pragma unroll
                    for (int ks = 0; ks < 2; ++ks) { const LAS unsigned char* vp = Vb + (32 * dt + l31) * (MLV_PITCH * 2) + (32 * sub + 16 * ks + 4 * hi) * 2;
                        const u32x2 x0 = *(const LAS u32x2*)vp, x1 = *(const LAS u32x2*)(vp + 16);
                        v4u a; a.x = x0.x; a.y = x0.y; a.z = x1.x; a.w = x1.y; o[dt] = MFMA32(__builtin_bit_cast(bf16x8, a), pf[ks], o[dt]); }
                done = __all(cum < -110.f);
            }
        }
        if (lane == 0) flags[(i & 1) * 8 + wave] = done ? 1u : 0u;
        LAS unsigned char* nb = lds + ((i + 1) & 1) * SB_STAGE;
        *(LAS v4u*)(nb + lK) = rk; *(LAS u32x2*)(nb + lVt) = (u32x2){rv.x, rv.y}; *(LAS u32x2*)(nb + lVt + 8) = (u32x2){rv.z, rv.w};
        __syncthreads();
        unsigned nd = 0;
#pragma unroll
        for (int w8 = 0; w8 < 8; ++w8) nd += flags[(i & 1) * 8 + w8];
        if (nd == 8u) break;
    }
    store_OT(o, 1.0f, (LAS bf16_t*)(lds + 2 * SB_STAGE + 256) + wave * (32 * STG_PITCH), ymix + (rowb + q0) * DM + h * 64, lane);
    __syncthreads();
}

constexpr int RW_RAWW = 0, RW_RAWA = 2048, RW_RS = 4096, RW_KS = 6144, RW_VS = 8192;
constexpr int RW_CH0 = 10240, RW_CHSZ = 11328;
constexpr int RW_YB = RW_CH0 + 2 * RW_CHSZ;
constexpr int RW_MIX = RW_YB + 1024;
static_assert((RW_MIX + 256) * 4 <= 146432, "rwkv LDS map");
__device__ __forceinline__ float tanh_fast(float x) { return 1.f - 2.f / (1.f + __expf(2.f * x)); }
__device__ __forceinline__ float sigmoid_fast(float x) { return 1.f / (1.f + __expf(-x)); }

#define MFMA16(a, b, c) __builtin_amdgcn_mfma_f32_16x16x32_bf16((a), (b), (c), 0, 0, 0)
constexpr int RW2_CH0 = 0, RW2_YB = 2 * RW_CHSZ, RW2_MIX = RW2_YB + 1024, RW2_STG = RW2_MIX + 448;
static_assert((RW2_STG + 2 * 3072) * 4 <= 146432, "rwkv LDS map");
__device__ __forceinline__ void rwkv_phase_scan(LAS float* sm, int tid, int lane, int wave, int blk, const bf16_t* __restrict__ proj, const float* __restrict__ mix, const float* __restrict__ w0, const float* __restrict__ a0,
                                           const float* __restrict__ k_k, const float* __restrict__ k_a, const float* __restrict__ r_k, const bf16_t* __restrict__ W2T, const bf16_t* __restrict__ A2T, const bf16_t* __restrict__ G2T,
                                           float* __restrict__ yraw, bf16_t* __restrict__ gout, float* __restrict__ bonus_out) {
    const int chain = blk >> 1, half = blk & 1, b = chain >> 3, h = chain & 7, l15 = lane & 15, kg = lane >> 4;
    const size_t rowb = (size_t)b * SEQ;
    constexpr int NCHUNK = SEQ / 32;
    if (tid < 256) sm[RW2_MIX + tid] = mix[1536 + tid];
    else if (tid < 448) { const int q = tid - 256; sm[RW2_MIX + tid] = mix[512 * (q >> 6) + h * 64 + (q & 63)]; }
    __syncthreads();
#define RW_SH8(CUR, PRV, M0, M1, OUT, PZ) do { const unsigned cu_[4] = {(CUR).x, (CUR).y, (CUR).z, (CUR).w}, pu_[4] = {(PRV).x, (PRV).y, (PRV).z, (PRV).w}; \
        const float mm_[8] = {(M0)[0], (M0)[1], (M0)[2], (M0)[3], (M1)[0], (M1)[1], (M1)[2], (M1)[3]}; \
        _Pragma("unroll") for (int q = 0; q < 4; ++q) { const float c0 = bflo(cu_[q]), c1 = bfhi(cu_[q]), p0 = bflo(pu_[q]) * (PZ), p1 = bfhi(pu_[q]) * (PZ); \
            OUT[2 * q] = c0 + (p0 - c0) * mm_[2 * q]; OUT[2 * q + 1] = c1 + (p1 - c1) * mm_[2 * q + 1]; } } while (0)
    if (wave < 4) {
        const int iA = 8 * wave + kg, iB = iA + 4, jseg = l15;
        float A0 = 0.f, A1 = 0.f, A2 = 0.f, A3 = 0.f, B0 = 0.f, B1 = 0.f, B2 = 0.f, B3 = 0.f;
        __syncthreads();
#pragma unroll 1
        for (int ch = 0; ch < NCHUNK; ++ch) {
            const int t0 = ch * 32;
            const LAS float* CHb = sm + RW2_CH0 + (ch & 1) * RW_CHSZ + 4 * jseg;
            const LAS float* CHv = sm + RW2_CH0 + (ch & 1) * RW_CHSZ + 10240 + iA;
            const LAS float* CHs = sm + RW2_CH0 + (ch & 1) * RW_CHSZ + 11264;
            f32x4 a4 = *(const LAS f32x4*)(CHb + 4096), wr4 = *(const LAS f32x4*)(CHb + 8192), w4 = *(const LAS f32x4*)(CHb), b4 = *(const LAS f32x4*)(CHb + 6144), k4 = *(const LAS f32x4*)(CHb + 2048);
            float vA = CHv[0], vB = CHv[4]; f32x2_t sc = *(const LAS f32x2_t*)(CHs);
#pragma unroll 2
            for (int t = 0; t < 32; ++t) {
                const int tq = (t + 1) & 31;
                const f32x4 a4n = *(const LAS f32x4*)(CHb + 4096 + tq * 64), wr4n = *(const LAS f32x4*)(CHb + 8192 + tq * 64), w4n = *(const LAS f32x4*)(CHb + tq * 64),
                            b4n = *(const LAS f32x4*)(CHb + 6144 + tq * 64), k4n = *(const LAS f32x4*)(CHb + 2048 + tq * 64);
                const float vAn = CHv[tq * 32], vBn = CHv[tq * 32 + 4]; const f32x2_t scn = *(const LAS f32x2_t*)(CHs + 2 * tq);
                float d1A = (A0 * a4[0] + A1 * a4[1]) + (A2 * a4[2] + A3 * a4[3]), d1B = (B0 * a4[0] + B1 * a4[1]) + (B2 * a4[2] + B3 * a4[3]);
                float d2A = (A0 * wr4[0] + A1 * wr4[1]) + (A2 * wr4[2] + A3 * wr4[3]), d2B = (B0 * wr4[0] + B1 * wr4[1]) + (B2 * wr4[2] + B3 * wr4[3]);
                d1A = rowsum16(d1A); d1B = rowsum16(d1B); d2A = rowsum16(d2A); d2B = rowsum16(d2B);
                const float yA = d2A + d1A * sc[0] + vA * sc[1], yB = d2B + d1B * sc[0] + vB * sc[1];
                A0 = A0 * w4[0] + (d1A * b4[0] + vA * k4[0]); A1 = A1 * w4[1] + (d1A * b4[1] + vA * k4[1]); A2 = A2 * w4[2] + (d1A * b4[2] + vA * k4[2]); A3 = A3 * w4[3] + (d1A * b4[3] + vA * k4[3]);
                B0 = B0 * w4[0] + (d1B * b4[0] + vB * k4[0]); B1 = B1 * w4[1] + (d1B * b4[1] + vB * k4[1]); B2 = B2 * w4[2] + (d1B * b4[2] + vB * k4[2]); B3 = B3 * w4[3] + (d1B * b4[3] + vB * k4[3]);
                if (jseg == 0) { sm[RW2_YB + t * 32 + iA] = yA; sm[RW2_YB + t * 32 + iB] = yB; }
                a4 = a4n; wr4 = wr4n; w4 = w4n; b4 = b4n; k4 = k4n; vA = vAn; vB = vBn; sc = scn;
            }
            WSYNC();
            { const int tt = lane >> 1, hh = lane & 1; const f32x4 yv = *(const LAS f32x4*)(sm + RW2_YB + tt * 32 + 8 * wave + 4 * hh);
              *(f32x4*)(yraw + (rowb + t0 + tt) * 512 + h * 64 + half * 32 + 8 * wave + 4 * hh) = yv; }
            __syncthreads();
        }
    } else if (wave < 6) {
        const int tp = wave - 4, tb = 16 * tp;
        LAS float* stg = sm + RW2_STG + tp * 3072;
        float w0c[4], a0c[4], kkc[4], kac[4], rkc[4];
#pragma unroll
        for (int nt = 0; nt < 4; ++nt) { const int c = h * 64 + 16 * nt + l15; w0c[nt] = w0[c]; a0c[nt] = a0[c]; kkc[nt] = k_k[c]; kac[nt] = k_a[c]; rkc[nt] = r_k[c]; }
        v4u ld[20];
#define PREP_ISSUE(T0) do { const int t0_ = (T0); { const size_t r_ = rowb + t0_ + tb + l15; const size_t rp_ = (t0_ + tb + l15 == 0) ? r_ : r_ - 1; \
            _Pragma("unroll") for (int lo = 0; lo < 2; ++lo) _Pragma("unroll") for (int ks = 0; ks < 2; ++ks) { const int col = 1536 + 64 * lo + 32 * ks + 8 * kg; \
                ld[(lo * 2 + ks) * 2] = *(const v4u*)(proj + r_ * L0P + col); ld[(lo * 2 + ks) * 2 + 1] = *(const v4u*)(proj + rp_ * L0P + col); } } \
            _Pragma("unroll") for (int ar = 0; ar < 3; ++ar) _Pragma("unroll") for (int i = 0; i < 2; ++i) { const int p_ = lane + 64 * i, row_ = p_ >> 3, c8_ = p_ & 7; \
                const size_t r_ = rowb + t0_ + tb + row_; const size_t rp_ = (t0_ + tb + row_ == 0) ? r_ : r_ - 1; const int col = 512 * ar + h * 64 + 8 * c8_; \
                ld[8 + (ar * 2 + i) * 2] = *(const v4u*)(proj + r_ * L0P + col); ld[8 + (ar * 2 + i) * 2 + 1] = *(const v4u*)(proj + rp_ * L0P + col); } } while (0)
#define PREP_BUILD(T0, NB) do { const int t0_ = (T0); LAS float* CHn = sm + RW2_CH0 + (NB) * RW_CHSZ; \
            f32x4 accw[4], acca[4]; \
            _Pragma("unroll") for (int nt = 0; nt < 4; ++nt) { accw[nt] = (f32x4){0.f, 0.f, 0.f, 0.f}; acca[nt] = (f32x4){0.f, 0.f, 0.f, 0.f}; } \
            { const float pz_ = (t0_ + tb + l15 == 0) ? 0.f : 1.f; \
              _Pragma("unroll") for (int lo = 0; lo < 2; ++lo) _Pragma("unroll") for (int ks = 0; ks < 2; ++ks) { float s_[8]; \
                const f32x4 m0 = *(const LAS f32x4*)(sm + RW2_MIX + 64 * lo + 32 * ks + 8 * kg), m1 = *(const LAS f32x4*)(sm + RW2_MIX + 64 * lo + 32 * ks + 8 * kg + 4); \
                RW_SH8(ld[(lo * 2 + ks) * 2], ld[(lo * 2 + ks) * 2 + 1], m0, m1, s_, pz_); \
                if (lo == 0) { _Pragma("unroll") for (int j = 0; j < 8; ++j) s_[j] = tanh_fast(s_[j]); } \
                v4u aw; aw.x = cvtpk(s_[0], s_[1]); aw.y = cvtpk(s_[2], s_[3]); aw.z = cvtpk(s_[4], s_[5]); aw.w = cvtpk(s_[6], s_[7]); const bf16x8 af = __builtin_bit_cast(bf16x8, aw); \
                const bf16_t* WT = lo ? A2T : W2T; \
                _Pragma("unroll") for (int nt = 0; nt < 4; ++nt) { const bf16x8 bfr = *(const bf16x8*)(WT + (size_t)(h * 64 + 16 * nt + l15) * 64 + 32 * ks + 8 * kg); \
                    if (lo == 0) accw[nt] = MFMA16(af, bfr, accw[nt]); else acca[nt] = MFMA16(af, bfr, acca[nt]); } } } \
            _Pragma("unroll") for (int ar = 0; ar < 3; ++ar) _Pragma("unroll") for (int i = 0; i < 2; ++i) { const int p_ = lane + 64 * i, row_ = p_ >> 3, c8_ = p_ & 7; float s_[8]; \
                const float pz_ = (t0_ + tb + row_ == 0) ? 0.f : 1.f; const f32x4 m0 = *(const LAS f32x4*)(sm + RW2_MIX + 256 + ar * 64 + c8_ * 8), m1 = *(const LAS f32x4*)(sm + RW2_MIX + 256 + ar * 64 + c8_ * 8 + 4); \
                RW_SH8(ld[8 + (ar * 2 + i) * 2], ld[8 + (ar * 2 + i) * 2 + 1], m0, m1, s_, pz_); \
                *(LAS f32x4*)(stg + ar * 1024 + row_ * 64 + c8_ * 8) = (f32x4){s_[0], s_[1], s_[2], s_[3]}; *(LAS f32x4*)(stg + ar * 1024 + row_ * 64 + c8_ * 8 + 4) = (f32x4){s_[4], s_[5], s_[6], s_[7]}; } \
            WSYNC(); \
            PREP_ISSUE(((T0) + 32 < SEQ) ? (T0) + 32 : (T0)); \
            _Pragma("unroll") for (int rg = 0; rg < 4; ++rg) { const int tl = 4 * kg + rg, t = tb + tl; \
                float r_[4], k_[4], v_[4], kkv[4], nrm2 = 0.f; \
                _Pragma("unroll") for (int nt = 0; nt < 4; ++nt) { r_[nt] = stg[tl * 64 + 16 * nt + l15]; k_[nt] = stg[1024 + tl * 64 + 16 * nt + l15]; v_[nt] = stg[2048 + tl * 64 + 16 * nt + l15]; \
                    kkv[nt] = k_[nt] * kkc[nt]; nrm2 += kkv[nt] * kkv[nt]; } \
                nrm2 = rowsum16(nrm2); const float rn = __builtin_amdgcn_rsqf(fmaxf(nrm2, 1e-24f)); \
                float br = 0.f, kr = 0.f, bon = 0.f; \
                _Pragma("unroll") for (int nt = 0; nt < 4; ++nt) { const int j = 16 * nt + l15; \
                    const float wsum = w0c[nt] + accw[nt][rg]; const float logw = -softplus_fast(-wsum) - 0.5f; const float dec = __expf(-__expf(logw)); \
                    const float a_ = sigmoid_fast(a0c[nt] + acca[nt][rg]); const float kn = kkv[nt] * rn; \
                    const float k2 = k_[nt] * (1.f + (a_ - 1.f) * kac[nt]); const float bv = kn * a_; \
                    br += bv * r_[nt]; kr += k2 * r_[nt]; bon += r_[nt] * k2 * rkc[nt]; \
                    CHn[t * 64 + j] = dec; CHn[2048 + t * 64 + j] = k2; CHn[4096 + t * 64 + j] = -kn; CHn[6144 + t * 64 + j] = bv; CHn[8192 + t * 64 + j] = dec * r_[nt]; \
                    if ((nt >> 1) == half) CHn[10240 + t * 32 + (j & 31)] = v_[nt]; } \
                br = rowsum16(br); kr = rowsum16(kr); bon = rowsum16(bon); \
                if (l15 == 0) { CHn[11264 + 2 * t] = br; CHn[11264 + 2 * t + 1] = kr; if (half == 0) bonus_out[(rowb + t0_ + t) * 8 + h] = bon; } } \
            WSYNC(); } while (0)
        PREP_ISSUE(0);
        PREP_BUILD(0, 0);
        __syncthreads();
#pragma unroll 1
        for (int ch = 0; ch < NCHUNK; ++ch) {
            if (ch + 1 < NCHUNK) PREP_BUILD(ch * 32 + 32, (ch + 1) & 1);
            __syncthreads();
        }
#undef PREP_ISSUE
#undef PREP_BUILD
    } else {
        const int tp = wave - 6, tb = 16 * tp;
        v4u ld[8];
#define G_ISSUE(T0) do { const int t0_ = (T0); const size_t r_ = rowb + t0_ + tb + l15; const size_t rp_ = (t0_ + tb + l15 == 0) ? r_ : r_ - 1; \
            _Pragma("unroll") for (int ks = 0; ks < 4; ++ks) { const int col = 1664 + 32 * ks + 8 * kg; ld[2 * ks] = *(const v4u*)(proj + r_ * L0P + col); ld[2 * ks + 1] = *(const v4u*)(proj + rp_ * L0P + col); } } while (0)
#define G_BUILD(T0) do { const int t0_ = (T0); f32x4 accg[2] = {(f32x4){0.f, 0.f, 0.f, 0.f}, (f32x4){0.f, 0.f, 0.f, 0.f}}; const float pz_ = (t0_ + tb + l15 == 0) ? 0.f : 1.f; \
            _Pragma("unroll") for (int ks = 0; ks < 4; ++ks) { float s_[8]; \
                const f32x4 m0 = *(const LAS f32x4*)(sm + RW2_MIX + 128 + 32 * ks + 8 * kg), m1 = *(const LAS f32x4*)(sm + RW2_MIX + 128 + 32 * ks + 8 * kg + 4); \
                RW_SH8(ld[2 * ks], ld[2 * ks + 1], m0, m1, s_, pz_); \
                _Pragma("unroll") for (int j = 0; j < 8; ++j) s_[j] = sigmoid_fast(s_[j]); \
                v4u aw; aw.x = cvtpk(s_[0], s_[1]); aw.y = cvtpk(s_[2], s_[3]); aw.z = cvtpk(s_[4], s_[5]); aw.w = cvtpk(s_[6], s_[7]); const bf16x8 af = __builtin_bit_cast(bf16x8, aw); \
                _Pragma("unroll") for (int nt = 0; nt < 2; ++nt) { const bf16x8 bfr = *(const bf16x8*)(G2T + (size_t)(h * 64 + half * 32 + 16 * nt + l15) * 128 + 32 * ks + 8 * kg); accg[nt] = MFMA16(af, bfr, accg[nt]); } } \
            G_ISSUE(((T0) + 32 < SEQ) ? (T0) + 32 : (T0)); \
            _Pragma("unroll") for (int nt = 0; nt < 2; ++nt) _Pragma("unroll") for (int rg = 0; rg < 4; ++rg) \
                gout[(rowb + t0_ + tb + 4 * kg + rg) * 512 + h * 64 + half * 32 + 16 * nt + l15] = (bf16_t)f2bf(accg[nt][rg]); } while (0)
        G_ISSUE(0);
        G_BUILD(0);
        __syncthreads();
#pragma unroll 1
        for (int ch = 0; ch < NCHUNK; ++ch) {
            if (ch + 1 < NCHUNK) G_BUILD(ch * 32 + 32);
            __syncthreads();
        }
#undef G_ISSUE
#undef G_BUILD
    }
#undef RW_SH8
    __syncthreads();
}

constexpr int CK_BK = 0, CK_AR = 4608, CK_BBT = 9216, CK_KBT = 12288, CK_VT = 15360, CK_GC = 16896, CK_SLOT = 17408, CK_NSLOT = 5;
constexpr int CK_STG = CK_SLOT * CK_NSLOT;
constexpr int CK_MIX = CK_STG + 4 * 12288;
constexpr int CK_FLAGS = CK_MIX + 448 * 4;
static_assert(CK_FLAGS + 64 <= 146432, "rwkv chunked LDS map");
__device__ __forceinline__ bf16x8 pack8(float a0, float a1, float a2, float a3, float a4, float a5, float a6, float a7) {
    v4u w; w.x = cvtpk(a0, a1); w.y = cvtpk(a2, a3); w.z = cvtpk(a4, a5); w.w = cvtpk(a6, a7); return __builtin_bit_cast(bf16x8, w); }
__device__ __forceinline__ void rwkv_phase(LAS float* smf, int tid, int lane, int wave, int blk, const bf16_t* __restrict__ proj, const float* __restrict__ mix, const float* __restrict__ w0, const float* __restrict__ a0,
                                           const float* __restrict__ k_k, const float* __restrict__ k_a, const float* __restrict__ r_k, const bf16_t* __restrict__ W2T, const bf16_t* __restrict__ A2T, const bf16_t* __restrict__ G2T,
                                           float* __restrict__ yraw, bf16_t* __restrict__ gout, float* __restrict__ bonus_out) {
    LAS unsigned char* lds = (LAS unsigned char*)smf;
    LAS float* mixs = (LAS float*)(lds + CK_MIX);
    volatile LAS unsigned* flags = (volatile LAS unsigned*)(lds + CK_FLAGS);
    const int chain = blk >> 1, ihalf = blk & 1, b = chain >> 3, h = chain & 7, l15 = lane & 15, kg = lane >> 4, l31 = lane & 31, hi = lane >> 5;
    const size_t rowb = (size_t)b * SEQ;
    constexpr int NCH = SEQ / 16;
    if (tid < 256) mixs[tid] = mix[1536 + tid];
    else if (tid < 448) { const int q = tid - 256; mixs[tid] = mix[512 * (q >> 6) + h * 64 + (q & 63)]; }
    if (tid < 16) flags[tid] = 0u;
    __syncthreads();
#define RW_SH8(CUR, PRV, M0, M1, OUT, PZ) do { const unsigned cu_[4] = {(CUR).x, (CUR).y, (CUR).z, (CUR).w}, pu_[4] = {(PRV).x, (PRV).y, (PRV).z, (PRV).w}; \
        const float mm_[8] = {(M0)[0], (M0)[1], (M0)[2], (M0)[3], (M1)[0], (M1)[1], (M1)[2], (M1)[3]}; \
        _Pragma("unroll") for (int q = 0; q < 4; ++q) { const float c0 = bflo(cu_[q]), c1 = bfhi(cu_[q]), p0 = bflo(pu_[q]) * (PZ), p1 = bfhi(pu_[q]) * (PZ); \
            OUT[2 * q] = c0 + (p0 - c0) * mm_[2 * q]; OUT[2 * q + 1] = c1 + (p1 - c1) * mm_[2 * q + 1]; } } while (0)
    if (wave == 0) {
        f32x16 ST[2];
#pragma unroll
        for (int r = 0; r < 16; ++r) { ST[0][r] = 0.f; ST[1][r] = 0.f; }
#pragma unroll 1
        for (int k = 0; k < NCH; ++k) {
            { const unsigned want = (unsigned)(k + 1); const int sl = k % CK_NSLOT; while (flags[sl] != want) __builtin_amdgcn_s_sleep(1); }
            asm volatile("" ::: "memory");
            const LAS unsigned char* im = lds + (k % CK_NSLOT) * CK_SLOT;
            f32x16 G;
#pragma unroll
            for (int r = 0; r < 16; ++r) G[r] = 0.f;
#pragma unroll
            for (int kk = 0; kk < 4; ++kk) { const bf16x8 fa = *(const LAS bf16x8*)(im + CK_BK + l31 * 144 + (16 * kk + 8 * hi) * 2), fb = *(const LAS bf16x8*)(im + CK_AR + l31 * 144 + (16 * kk + 8 * hi) * 2); G = MFMA32(fa, fb, G); }
            { const int tcol = l31 & 15; const bool strict = l31 < 16;
#pragma unroll
              for (int r = 0; r < 16; ++r) { const int srow = crow(r & 7, hi); const bool keep = strict ? (srow < tcol) : (srow <= tcol); G[r] = keep ? G[r] : 0.f; } }
            const bf16x8 gB = pack8(G[0], G[1], G[2], G[3], G[4], G[5], G[6], G[7]), gK = pack8(G[8], G[9], G[10], G[11], G[12], G[13], G[14], G[15]);
            f32x16 XT;
#pragma unroll
            for (int r = 0; r < 16; ++r) XT[r] = 0.f;
#pragma unroll
            for (int jt = 0; jt < 2; ++jt)
#pragma unroll
                for (int sp = 0; sp < 2; ++sp) { const LAS unsigned char* ap = im + CK_AR + l31 * 144 + (32 * jt + 16 * sp + 4 * hi) * 2;
                    const u32x2 x0 = *(const LAS u32x2*)ap, x1 = *(const LAS u32x2*)(ap + 16); v4u aw; aw.x = x0.x; aw.y = x0.y; aw.z = x1.x; aw.w = x1.y;
                    const bf16x8 sb_ = pack8(ST[jt][8 * sp], ST[jt][8 * sp + 1], ST[jt][8 * sp + 2], ST[jt][8 * sp + 3], ST[jt][8 * sp + 4], ST[jt][8 * sp + 5], ST[jt][8 * sp + 6], ST[jt][8 * sp + 7]);
                    XT = MFMA32(__builtin_bit_cast(bf16x8, aw), sb_, XT); }
            { const LAS unsigned char* vp = im + CK_VT + l31 * 48 + (4 * hi) * 2; const u32x2 x0 = *(const LAS u32x2*)vp, x1 = *(const LAS u32x2*)(vp + 16); v4u vw; vw.x = x0.x; vw.y = x0.y; vw.z = x1.x; vw.w = x1.y;
              XT = MFMA32(gK, __builtin_bit_cast(bf16x8, vw), XT); }
            float u[16];
#pragma unroll
            for (int q = 0; q < 8; ++q) { const float own = XT[q], oth = __shfl_xor(own, 32); const int tlo = (q & 3) + 8 * (q >> 2); u[tlo] = hi ? oth : own; u[tlo + 4] = hi ? own : oth; }
#pragma unroll
            for (int t = 1; t < 16; ++t) {
                float acc_ = u[t];
#pragma unroll
                for (int s2 = 0; s2 < t; ++s2) { const int hs = (s2 >> 2) & 1, rs = (s2 & 3) + 4 * (s2 >> 3); acc_ += rl(G[rs], t + 32 * hs) * u[s2]; }
                u[t] = acc_;
            }
            { const bf16x8 uP = hi ? pack8(u[4], u[5], u[6], u[7], u[12], u[13], u[14], u[15]) : pack8(u[0], u[1], u[2], u[3], u[8], u[9], u[10], u[11]);
              XT = MFMA32(gB, uP, XT); }
            { float* yp = yraw + (rowb + 16 * k) * 512 + h * 64 + 32 * ihalf + l31;
#pragma unroll
              for (int q = 0; q < 8; ++q) yp[(size_t)crow(q, hi) * 512] = XT[8 + q]; }
            { const LAS float* gc = (const LAS float*)(im + CK_GC);
#pragma unroll
              for (int jt = 0; jt < 2; ++jt)
#pragma unroll
                  for (int r = 0; r < 16; ++r) ST[jt][r] *= gc[32 * jt + crow(r, hi)]; }
            { const bf16x8 uN = hi ? pack8(u[8], u[9], u[10], u[11], u[12], u[13], u[14], u[15]) : pack8(u[0], u[1], u[2], u[3], u[4], u[5], u[6], u[7]);
              const bf16x8 vN = *(const LAS bf16x8*)(im + CK_VT + l31 * 48 + (8 * hi) * 2);
#pragma unroll
              for (int jt = 0; jt < 2; ++jt) { const bf16x8 a1 = *(const LAS bf16x8*)(im + CK_BBT + (32 * jt + l31) * 48 + (8 * hi) * 2), a2 = *(const LAS bf16x8*)(im + CK_KBT + (32 * jt + l31) * 48 + (8 * hi) * 2);
                  ST[jt] = MFMA32(a1, uN, ST[jt]); ST[jt] = MFMA32(a2, vN, ST[jt]); } }
            WSYNC();
            if (lane == 0) flags[8] = (unsigned)(k + 1);
        }
    } else if (wave <= 4) {
        const int pw = wave - 1;
        LAS float* stg = (LAS float*)(lds + CK_STG) + pw * 3072;
        float w0c[4], a0c[4], kkc[4], kac[4], rkc[4];
#pragma unroll
        for (int nt = 0; nt < 4; ++nt) { const int c = h * 64 + 16 * nt + l15; w0c[nt] = w0[c]; a0c[nt] = a0[c]; kkc[nt] = k_k[c]; kac[nt] = k_a[c]; rkc[nt] = r_k[c]; }
        v4u ld[20];
#define CK_ISSUE(T0) do { const int t0_ = (T0); { const size_t r_ = rowb + t0_ + l15; const size_t rp_ = (t0_ + l15 == 0) ? r_ : r_ - 1; \
            _Pragma("unroll") for (int lo = 0; lo < 2; ++lo) _Pragma("unroll") for (int ks = 0; ks < 2; ++ks) { const int col = 1536 + 64 * lo + 32 * ks + 8 * kg; \
                ld[(lo * 2 + ks) * 2] = *(const v4u*)(proj + r_ * L0P + col); ld[(lo * 2 + ks) * 2 + 1] = *(const v4u*)(proj + rp_ * L0P + col); } } \
            _Pragma("unroll") for (int ar = 0; ar < 3; ++ar) _Pragma("unroll") for (int i = 0; i < 2; ++i) { const int p_ = lane + 64 * i, row_ = p_ >> 3, c8_ = p_ & 7; \
                const size_t r_ = rowb + t0_ + row_; const size_t rp_ = (t0_ + row_ == 0) ? r_ : r_ - 1; const int col = 512 * ar + h * 64 + 8 * c8_; \
                ld[8 + (ar * 2 + i) * 2] = *(const v4u*)(proj + r_ * L0P + col); ld[8 + (ar * 2 + i) * 2 + 1] = *(const v4u*)(proj + rp_ * L0P + col); } } while (0)
        CK_ISSUE(16 * pw);
#pragma unroll 1
        for (int k = pw; k < NCH; k += 4) {
            const int t0 = 16 * k;
            f32x4 accw[4], acca[4];
#pragma unroll
            for (int nt = 0; nt < 4; ++nt) { accw[nt] = (f32x4){0.f, 0.f, 0.f, 0.f}; acca[nt] = (f32x4){0.f, 0.f, 0.f, 0.f}; }
            { const float pz_ = (t0 + l15 == 0) ? 0.f : 1.f;
#pragma unroll
              for (int lo = 0; lo < 2; ++lo)
#pragma unroll
                for (int ks = 0; ks < 2; ++ks) { float s_[8];
                    const f32x4 m0 = *(const LAS f32x4*)(mixs + 64 * lo + 32 * ks + 8 * kg), m1 = *(const LAS f32x4*)(mixs + 64 * lo + 32 * ks + 8 * kg + 4);
                    RW_SH8(ld[(lo * 2 + ks) * 2], ld[(lo * 2 + ks) * 2 + 1], m0, m1, s_, pz_);
                    if (lo == 0) {
#pragma unroll
                        for (int j = 0; j < 8; ++j) s_[j] = tanh_fast(s_[j]); }
                    const bf16x8 af = pack8(s_[0], s_[1], s_[2], s_[3], s_[4], s_[5], s_[6], s_[7]);
                    const bf16_t* WT = lo ? A2T : W2T;
#pragma unroll
                    for (int nt = 0; nt < 4; ++nt) { const bf16x8 bfr = *(const bf16x8*)(WT + (size_t)(h * 64 + 16 * nt + l15) * 64 + 32 * ks + 8 * kg);
                        if (lo == 0) accw[nt] = MFMA16(af, bfr, accw[nt]); else acca[nt] = MFMA16(af, bfr, acca[nt]); } } }
#pragma unroll
            for (int ar = 0; ar < 3; ++ar)
#pragma unroll
                for (int i = 0; i < 2; ++i) { const int p_ = lane + 64 * i, row_ = p_ >> 3, c8_ = p_ & 7; float s_[8];
                    const float pz_ = (t0 + row_ == 0) ? 0.f : 1.f; const f32x4 m0 = *(const LAS f32x4*)(mixs + 256 + ar * 64 + c8_ * 8), m1 = *(const LAS f32x4*)(mixs + 256 + ar * 64 + c8_ * 8 + 4);
                    RW_SH8(ld[8 + (ar * 2 + i) * 2], ld[8 + (ar * 2 + i) * 2 + 1], m0, m1, s_, pz_);
                    *(LAS f32x4*)(stg + ar * 1024 + row_ * 64 + c8_ * 8) = (f32x4){s_[0], s_[1], s_[2], s_[3]}; *(LAS f32x4*)(stg + ar * 1024 + row_ * 64 + c8_ * 8 + 4) = (f32x4){s_[4], s_[5], s_[6], s_[7]}; }
            WSYNC();
            { const int need = k - (CK_NSLOT - 1); if (need > 0) { while ((int)flags[8] < need) __builtin_amdgcn_s_sleep(2); } }
            asm volatile("" ::: "memory");
            LAS unsigned char* im = lds + (k % CK_NSLOT) * CK_SLOT;
            float lwv[4][4], av[4][4], knv[4][4];
#pragma unroll
            for (int rg = 0; rg < 4; ++rg) { const int tl = 4 * kg + rg;
                float kkv[4], nrm2 = 0.f, vv[4], rr_[4], kr_[4];
#pragma unroll
                for (int nt = 0; nt < 4; ++nt) { rr_[nt] = stg[tl * 64 + 16 * nt + l15]; kr_[nt] = stg[1024 + tl * 64 + 16 * nt + l15]; vv[nt] = stg[2048 + tl * 64 + 16 * nt + l15];
                    kkv[nt] = kr_[nt] * kkc[nt]; nrm2 += kkv[nt] * kkv[nt]; }
                nrm2 = rowsum16(nrm2); const float rn = __builtin_amdgcn_rsqf(fmaxf(nrm2, 1e-24f));
                float bon = 0.f;
#pragma unroll
                for (int nt = 0; nt < 4; ++nt) {
                    const float wsum = w0c[nt] + accw[nt][rg]; const float logw = -softplus_fast(-wsum) - 0.5f; lwv[nt][rg] = -__expf(logw);
                    const float a_ = sigmoid_fast(a0c[nt] + acca[nt][rg]); av[nt][rg] = a_; knv[nt][rg] = kkv[nt] * rn;
                    const float k2 = kr_[nt] * (1.f + (a_ - 1.f) * kac[nt]); stg[1024 + tl * 64 + 16 * nt + l15] = k2;
                    bon += rr_[nt] * k2 * rkc[nt];
                    if ((nt >> 1) == ihalf) *(LAS bf16_t*)(im + CK_VT + (16 * (nt & 1) + l15) * 48 + tl * 2) = (bf16_t)f2bf(vv[nt]);
                }
                bon = rowsum16(bon);
                if (l15 == 0 && ihalf == 0) bonus_out[(rowb + t0 + tl) * 8 + h] = bon;
            }
#pragma unroll
            for (int nt = 0; nt < 4; ++nt) {
                float L[4]; L[0] = lwv[nt][0]; L[1] = L[0] + lwv[nt][1]; L[2] = L[1] + lwv[nt][2]; L[3] = L[2] + lwv[nt][3];
                const float T0 = __shfl(L[3], l15), T1 = __shfl(L[3], 16 + l15), T2 = __shfl(L[3], 32 + l15), T3 = __shfl(L[3], 48 + l15);
                const float off = (kg > 0 ? T0 : 0.f) + (kg > 1 ? T1 : 0.f) + (kg > 2 ? T2 : 0.f), LC = (T0 + T1) + (T2 + T3);
                const int j = 16 * nt + l15;
                unsigned bb2[2], kb2[2];
#pragma unroll
                for (int rg = 0; rg < 4; ++rg) { const int tl = 4 * kg + rg; const float Lt = off + L[rg], e1 = __expf(Lt), e2 = __builtin_amdgcn_rcpf(e1), e3 = __expf(Lt - lwv[nt][rg]), e4 = __expf(LC - Lt);
                    const float kn = knv[nt][rg], bvv = kn * av[nt][rg], k2 = stg[1024 + tl * 64 + j], rr2 = stg[tl * 64 + j];
                    *(LAS bf16_t*)(im + CK_BK + tl * 144 + j * 2) = (bf16_t)f2bf(bvv * e2); *(LAS bf16_t*)(im + CK_BK + (16 + tl) * 144 + j * 2) = (bf16_t)f2bf(k2 * e2);
                    *(LAS bf16_t*)(im + CK_AR + tl * 144 + j * 2) = (bf16_t)f2bf(-kn * e3); *(LAS bf16_t*)(im + CK_AR + (16 + tl) * 144 + j * 2) = (bf16_t)f2bf(rr2 * e1);
                    const unsigned bq = f2bf(bvv * e4), kq = f2bf(k2 * e4);
                    if (rg & 1) { bb2[rg >> 1] |= bq << 16; kb2[rg >> 1] |= kq << 16; } else { bb2[rg >> 1] = bq; kb2[rg >> 1] = kq; } }
                *(LAS u32x2*)(im + CK_BBT + j * 48 + (4 * kg) * 2) = (u32x2){bb2[0], bb2[1]}; *(LAS u32x2*)(im + CK_KBT + j * 48 + (4 * kg) * 2) = (u32x2){kb2[0], kb2[1]};
                if (kg == 0) *(LAS float*)(im + CK_GC + j * 4) = __expf(LC);
            }
            WSYNC();
            if (lane == 0) flags[k % CK_NSLOT] = (unsigned)(k + 1);
            CK_ISSUE((k + 4 < NCH) ? t0 + 64 : t0);
        }
#undef CK_ISSUE
    } else if (wave <= 6) {
        const int gq = wave - 5;
        v4u ld[8];
#define G_ISSUE(T0) do { const int t0_ = (T0); const size_t r_ = rowb + t0_ + l15; const size_t rp_ = (t0_ + l15 == 0) ? r_ : r_ - 1; \
            _Pragma("unroll") for (int ks = 0; ks < 4; ++ks) { const int col = 1664 + 32 * ks + 8 * kg; ld[2 * ks] = *(const v4u*)(proj + r_ * L0P + col); ld[2 * ks + 1] = *(const v4u*)(proj + rp_ * L0P + col); } } while (0)
        G_ISSUE(16 * gq);
#pragma unroll 1
        for (int k = gq; k < NCH; k += 2) {
            const int t0 = 16 * k;
            f32x4 accg[2] = {(f32x4){0.f, 0.f, 0.f, 0.f}, (f32x4){0.f, 0.f, 0.f, 0.f}}; const float pz_ = (t0 + l15 == 0) ? 0.f : 1.f;
#pragma unroll
            for (int ks = 0; ks < 4; ++ks) { float s_[8];
                const f32x4 m0 = *(const LAS f32x4*)(mixs + 128 + 32 * ks + 8 * kg), m1 = *(const LAS f32x4*)(mixs + 128 + 32 * ks + 8 * kg + 4);
                RW_SH8(ld[2 * ks], ld[2 * ks + 1], m0, m1, s_, pz_);
#pragma unroll
                for (int j = 0; j < 8; ++j) s_[j] = sigmoid_fast(s_[j]);
                const bf16x8 af = pack8(s_[0], s_[1], s_[2], s_[3], s_[4], s_[5], s_[6], s_[7]);
#pragma unroll
                for (int nt = 0; nt < 2; ++nt) { const bf16x8 bfr = *(const bf16x8*)(G2T + (size_t)(h * 64 + ihalf * 32 + 16 * nt + l15) * 128 + 32 * ks + 8 * kg); accg[nt] = MFMA16(af, bfr, accg[nt]); } }
            G_ISSUE((k + 2 < NCH) ? t0 + 32 : t0);
#pragma unroll
            for (int nt = 0; nt < 2; ++nt)
#pragma unroll
                for (int rg = 0; rg < 4; ++rg) gout[(rowb + t0 + 4 * kg + rg) * 512 + h * 64 + ihalf * 32 + 16 * nt + l15] = (bf16_t)f2bf(accg[nt][rg]);
        }
#undef G_ISSUE
    }
#undef RW_SH8
    __syncthreads();
}

template <bool ST = true> __device__ __forceinline__ void rwkv_post_all(const float* __restrict__ yraw, const bf16_t* __restrict__ proj, const float* __restrict__ mix, const float* __restrict__ bonus, const bf16_t* __restrict__ gbuf,
                                              const float* __restrict__ ln_g, const float* __restrict__ ln_b, bf16_t* __restrict__ ymix, int gw, int NGW, int lane) {
    for (int m = gw; m < M; m += NGW) {
        const bool has_prev = (m & (SEQ - 1)) != 0;
        float y[8], cv[8], pv[8], gg[8], bo[8];
#pragma unroll
        for (int h = 0; h < 8; ++h) { const int c = h * 64 + lane; y[h] = yraw[(size_t)m * 512 + c]; cv[h] = bf2f(proj[(size_t)m * L0P + 1024 + c]);
            pv[h] = bf2f(proj[(size_t)(has_prev ? m - 1 : m) * L0P + 1024 + c]); gg[h] = bf2f(gbuf[(size_t)m * 512 + c]); bo[h] = bonus[(size_t)m * 8 + h]; }
#pragma unroll
        for (int h = 0; h < 8; ++h) { const int c = h * 64 + lane;
            const float mu = wave_sum_dpp(y[h]) * (1.f / 64.f), d = y[h] - mu, var = wave_sum_dpp(d * d) * (1.f / 64.f);
            const float yn = d * __builtin_amdgcn_rsqf(var + 64e-5f) * ln_g[c] + ln_b[c];
            const float pvv = has_prev ? pv[h] : 0.f;
            const float v_s = cv[h] + (pvv - cv[h]) * mix[1024 + c];
            const float o = (yn + bo[h] * v_s) * gg[h];
            if (ST) ymix[(size_t)m * DM + c] = (bf16_t)f2bf(o); else asm volatile("" :: "v"(o)); }
    }
}


__device__ __forceinline__ void ssd_conv_tile(int it, int lane, LAS bf16_t* scr, const bf16_t* __restrict__ proj, const float* __restrict__ cw, const float* __restrict__ cb,
                                              bf16_t* __restrict__ xbc, bf16_t* __restrict__ xst, bf16_t* __restrict__ bt) {
    const int tt = it >> 4, ct = it & 15, m0 = tt * 64, b = m0 >> 11, t0 = m0 & (SEQ - 1), c = ct * 64 + lane;
    const float w0 = cw[c], w1 = cw[1024 + c], w2 = cw[2048 + c], w3 = cw[3072 + c], bias = cb[c];
    const bf16_t* src = proj + (size_t)m0 * L0P + 2304 + c;
    float u3 = 0.f, u2 = 0.f, u1 = 0.f;
    if (t0 > 0) { u3 = bf2f(src[-3 * L0P]); u2 = bf2f(src[-2 * L0P]); u1 = bf2f(src[-1 * L0P]); }
#pragma unroll 16
    for (int t = 0; t < 64; ++t) {
        const float u = bf2f(src[(size_t)t * L0P]);
        const float y = bias + w0 * u3 + w1 * u2 + w2 * u1 + w3 * u;
        const bf16_t o = (bf16_t)f2bf(y / (1.f + __expf(-y)));
        xbc[(size_t)(m0 + t) * 1024 + c] = o;
        scr[t * STG_PITCH + lane] = o;
        u3 = u2; u2 = u1; u1 = u;
    }
    WSYNC();
    if (ct < 12) {
        bf16_t* dst = (ct < 8) ? xst + ((size_t)(b * 8 + ct) * 64) * SEQ + t0 : bt + ((size_t)(b * 2 + ((ct - 8) >> 1)) * 128 + ((ct - 8) & 1) * 64) * SEQ + t0;
#pragma unroll
        for (int i = 0; i < 8; ++i) { const int d = i * 8 + (lane >> 3), tc = lane & 7; const LAS bf16_t* p = scr + (tc * 8) * STG_PITCH + d;
            v4u o; o.x = (unsigned)p[0] | ((unsigned)p[STG_PITCH] << 16); o.y = (unsigned)p[2 * STG_PITCH] | ((unsigned)p[3 * STG_PITCH] << 16);
            o.z = (unsigned)p[4 * STG_PITCH] | ((unsigned)p[5 * STG_PITCH] << 16); o.w = (unsigned)p[6 * STG_PITCH] | ((unsigned)p[7 * STG_PITCH] << 16);
            *(v4u*)(dst + (size_t)d * SEQ + tc * 8) = o; }
    }
    WSYNC();
}
__device__ __forceinline__ void scan128(float& x0, float& x1, int lane) {
#pragma unroll
    for (int o = 1; o < 64; o <<= 1) { const float t0 = __shfl_up(x0, o), t1 = __shfl_up(x1, o); if (lane >= o) { x0 += t0; x1 += t1; } }
    x1 += __shfl(x0, 63);
}
__device__ __forceinline__ void ssd_s1_unit(int unit, int lane, LAS float* tab, const bf16_t* __restrict__ xst, const bf16_t* __restrict__ bt, const float* __restrict__ dt, const float* __restrict__ a_log,
                                            float* __restrict__ sloc, float* __restrict__ asum) {
    const int h = unit & 7, c = (unit >> 3) & 15, b = unit >> 7, g = h >> 2, l0 = c * 128, l31 = lane & 31, hi = lane >> 5;
    const size_t m0 = (size_t)b * SEQ + l0;
    const float A = -expf(a_log[h]);
    const float d0 = dt[(m0 + lane) * 8 + h], d1 = dt[(m0 + 64 + lane) * 8 + h];
    float ac0 = d0 * A, ac1 = d1 * A;
    scan128(ac0, ac1, lane);
    const float aend = __shfl(ac1, 63);
    tab[lane] = __expf(aend - ac0) * d0; tab[64 + lane] = __expf(aend - ac1) * d1;
    if (lane == 0) asum[unit] = aend;
    WSYNC();
    f32x16 acc[2][4];
#pragma unroll
    for (int pt = 0; pt < 2; ++pt)
#pragma unroll
        for (int nt = 0; nt < 4; ++nt)
#pragma unroll
            for (int r = 0; r < 16; ++r) acc[pt][nt][r] = 0.f;
    const bf16_t* Xp = xst + ((size_t)(b * 8 + h) * 64 + l31) * SEQ + l0 + 8 * hi;
    const bf16_t* Bp = bt + ((size_t)(b * 2 + g) * 128 + l31) * SEQ + l0 + 8 * hi;
#pragma unroll 2
    for (int kk = 0; kk < 8; ++kk) {
        const f32x4 wa = *(const LAS f32x4*)(tab + 16 * kk + 8 * hi), wb = *(const LAS f32x4*)(tab + 16 * kk + 8 * hi + 4);
        bf16x8 af[2], bfr[4];
#pragma unroll
        for (int pt = 0; pt < 2; ++pt) { const v4u raw = *(const v4u*)(Xp + (size_t)pt * 32 * SEQ + 16 * kk);
            v4u w; w.x = cvtpk(bflo(raw.x) * wa[0], bfhi(raw.x) * wa[1]); w.y = cvtpk(bflo(raw.y) * wa[2], bfhi(raw.y) * wa[3]);
            w.z = cvtpk(bflo(raw.z) * wb[0], bfhi(raw.z) * wb[1]); w.w = cvtpk(bflo(raw.w) * wb[2], bfhi(raw.w) * wb[3]); af[pt] = __builtin_bit_cast(bf16x8, w); }
#pragma unroll
        for (int nt = 0; nt < 4; ++nt) bfr[nt] = *(const bf16x8*)(Bp + (size_t)nt * 32 * SEQ + 16 * kk);
#pragma unroll
        for (int pt = 0; pt < 2; ++pt)
#pragma unroll
            for (int nt = 0; nt < 4; ++nt) acc[pt][nt] = MFMA32(af[pt], bfr[nt], acc[pt][nt]);
    }
    float* dst = sloc + (size_t)unit * 8192 + l31;
#pragma unroll
    for (int pt = 0; pt < 2; ++pt)
#pragma unroll
        for (int nt = 0; nt < 4; ++nt)
#pragma unroll
            for (int r = 0; r < 16; ++r) dst[(32 * pt + crow(r, hi)) * 128 + 32 * nt] = acc[pt][nt][r];
    WSYNC();
}
__device__ __forceinline__ void ssd_s2_all(const float* __restrict__ sloc, const float* __restrict__ asum, bf16_t* __restrict__ stb, int gtid, int NT) {
    for (int i = gtid; i < 128 * 2048; i += NT) {
        const int bh = i >> 11, e4 = i & 2047, b = bh >> 3, h = bh & 7;
        f32x4 run = {0.f, 0.f, 0.f, 0.f};
#pragma unroll 4
        for (int c = 0; c < 16; ++c) { const int unit = (b * 16 + c) * 8 + h; const f32x4 tmp = *(const f32x4*)(sloc + (size_t)unit * 8192 + e4 * 4);
            uint2 w; w.x = cvtpk(run[0], run[1]); w.y = cvtpk(run[2], run[3]); *(uint2*)(stb + (size_t)unit * 8192 + e4 * 4) = w;
            run = run * __expf(asum[unit]) + tmp; }
    }
}
__device__ __forceinline__ void ssd_s3_unit(int unit, int lane, LAS float* tab, const bf16_t* __restrict__ xbc, const bf16_t* __restrict__ xst, const bf16_t* __restrict__ stb, const float* __restrict__ dt,
                                            const float* __restrict__ a_log, const float* __restrict__ dsk, bf16_t* __restrict__ yssm) {
    const int h = unit & 7, c = (unit >> 3) & 15, b = unit >> 7, g = h >> 2, l0 = c * 128, l31 = lane & 31, hi = lane >> 5;
    const size_t m0 = (size_t)b * SEQ + l0;
    const float A = -expf(a_log[h]), D = dsk[h];
    const float d0 = dt[(m0 + lane) * 8 + h], d1 = dt[(m0 + 64 + lane) * 8 + h];
    float ac0 = d0 * A, ac1 = d1 * A;
    scan128(ac0, ac1, lane);
    tab[lane] = ac0; tab[64 + lane] = ac1; tab[128 + lane] = d0; tab[192 + lane] = d1;
    WSYNC();
    const bf16_t* Cp = xbc + (m0 + l31) * 1024 + 768 + g * 128 + 8 * hi;
    const bf16_t* Sp = stb + (size_t)unit * 8192 + l31 * 128 + 8 * hi;
    const bf16_t* Bp = xbc + (m0 + l31) * 1024 + 512 + g * 128 + 8 * hi;
    const bf16_t* Xp = xst + ((size_t)(b * 8 + h) * 64 + l31) * SEQ + l0 + 4 * hi;
    LAS float* tr = tab + 256;
    const int row = lane >> 1, p0 = (lane & 1) * 16;
#pragma unroll 1
    for (int lt = 0; lt < 4; ++lt) {
        f32x16 y[2];
#pragma unroll
        for (int r = 0; r < 16; ++r) { y[0][r] = 0.f; y[1][r] = 0.f; }
        const float acl = tab[32 * lt + l31];
#pragma unroll 4
        for (int kk = 0; kk < 8; ++kk) {
            const bf16x8 cf = *(const bf16x8*)(Cp + (size_t)lt * 32 * 1024 + 16 * kk);
            const bf16x8 s0 = *(const bf16x8*)(Sp + 16 * kk), s1 = *(const bf16x8*)(Sp + 32 * 128 + 16 * kk);
            y[0] = MFMA32(s0, cf, y[0]); y[1] = MFMA32(s1, cf, y[1]);
        }
        { const float el = __expf(acl);
#pragma unroll
          for (int r = 0; r < 16; ++r) { y[0][r] *= el; y[1][r] *= el; } }
#pragma unroll 1
        for (int st = 0; st <= lt; ++st) {
            f32x16 cbt;
#pragma unroll
            for (int r = 0; r < 16; ++r) cbt[r] = 0.f;
#pragma unroll 4
            for (int kk = 0; kk < 8; ++kk) { const bf16x8 bf_ = *(const bf16x8*)(Bp + (size_t)st * 32 * 1024 + 16 * kk), cf_ = *(const bf16x8*)(Cp + (size_t)lt * 32 * 1024 + 16 * kk); cbt = MFMA32(bf_, cf_, cbt); }
#pragma unroll
            for (int r = 0; r < 16; ++r) { const int sl = 32 * st + crow(r, hi); const float acs = tab[sl], dts = tab[128 + sl];
                float v = cbt[r] * __expf(acl - acs) * dts; if (st == lt && crow(r, hi) > l31) v = 0.f; cbt[r] = v; }
            bf16x8 pf[2];
#pragma unroll
            for (int ks = 0; ks < 2; ++ks) { v4u w; w.x = cvtpk(cbt[8 * ks], cbt[8 * ks + 1]); w.y = cvtpk(cbt[8 * ks + 2], cbt[8 * ks + 3]); w.z = cvtpk(cbt[8 * ks + 4], cbt[8 * ks + 5]); w.w = cvtpk(cbt[8 * ks + 6], cbt[8 * ks + 7]); pf[ks] = __builtin_bit_cast(bf16x8, w); }
#pragma unroll
            for (int pt = 0; pt < 2; ++pt)
#pragma unroll
                for (int ks = 0; ks < 2; ++ks) { const bf16_t* xp = Xp + (size_t)pt * 32 * SEQ + st * 32 + 16 * ks; const u32x2 x0 = *(const u32x2*)xp, x1 = *(const u32x2*)(xp + 8);
                    v4u a; a.x = x0.x; a.y = x0.y; a.z = x1.x; a.w = x1.y; y[pt] = MFMA32(__builtin_bit_cast(bf16x8, a), pf[ks], y[pt]); }
        }
#pragma unroll
        for (int pt = 0; pt < 2; ++pt) {
#pragma unroll
            for (int r = 0; r < 16; ++r) tr[l31 * 33 + crow(r, hi)] = y[pt][r];
            WSYNC();
            const size_t m = m0 + 32 * lt + row;
            const v4u xa = *(const v4u*)(xbc + m * 1024 + h * 64 + 32 * pt + p0), xb = *(const v4u*)(xbc + m * 1024 + h * 64 + 32 * pt + p0 + 8);
            const unsigned xu[8] = {xa.x, xa.y, xa.z, xa.w, xb.x, xb.y, xb.z, xb.w};
            unsigned ow[8];
#pragma unroll
            for (int q = 0; q < 8; ++q) { const float v0 = tr[row * 33 + p0 + 2 * q] + D * bflo(xu[q]), v1 = tr[row * 33 + p0 + 2 * q + 1] + D * bfhi(xu[q]); ow[q] = cvtpk(v0, v1); }
            bf16_t* dst = yssm + m * 512 + h * 64 + 32 * pt + p0;
            *(v4u*)dst = (v4u){ow[0], ow[1], ow[2], ow[3]}; *(v4u*)(dst + 8) = (v4u){ow[4], ow[5], ow[6], ow[7]};
            WSYNC();
        }
    }
}

struct Args { const float* in[43]; float* out; unsigned char* ws; };
#define GEMM_PHASE(EPI, Aptr, LDA, Bptr, LDB, NN, KK, ...) do { pg8::Gemm g_{(Aptr), (Bptr), M, (NN), (KK), (LDA), (LDB)}; pg8::StaticOrder S_; S_.init(M, (NN), G, (int)blockIdx.x); \
        pg8::EPI E_{__VA_ARGS__}; pg8::gemm_phase<pg8::EPI, pg8::StaticOrder, true, true>(lds3, g_, S_, E_); } while (0)

__global__ void __launch_bounds__(NWAVES * 64, 2) fwd_mega(Args args) {
    extern __shared__ __attribute__((aligned(16))) unsigned char lds[];
    LAS unsigned char* lds3 = (LAS unsigned char*)lds;
    volatile LAS unsigned* MISC = (volatile LAS unsigned*)(lds3 + MISC_OFF);
    const int G = gridDim.x, NGW = G * NWAVES, NT = G * NWAVES * 64;
#define PHASE_IDS() int tid = threadIdx.x; asm volatile("" : "+v"(tid)); const int lane = tid & 63, wave = __builtin_amdgcn_readfirstlane(tid >> 6); const int gw = blockIdx.x * NWAVES + wave, gtid = blockIdx.x * (NWAVES * 64) + tid; (void)lane; (void)gw; (void)gtid
    unsigned char* ws = args.ws;
    gu32* ctl = (gu32*)(ws + WS_CTL);
    for (int u = threadIdx.x; u < (LDS_BYTES - LDSCTL_OFF) / 4; u += NWAVES * 64) ((LAS unsigned*)(lds3 + LDSCTL_OFF))[u] = 0u;
    __syncthreads();
    XcdBarrier bar = xcd_barrier_post((unsigned*)(ctl + CW_BAR), MISC + 8);
#if defined(PROBE_STAMPS)
    int nb_ = 0;
    if (blockIdx.x == 0 && threadIdx.x == 0) MISC[16] = (unsigned)__builtin_amdgcn_s_memrealtime();
#define GRID_BAR() do { xcd_barrier(bar); ++nb_; if (blockIdx.x == 0 && threadIdx.x == 0) MISC[16 + nb_] = (unsigned)__builtin_amdgcn_s_memrealtime(); } while (0)
#else
#define GRID_BAR() xcd_barrier(bar)
#endif
#define IN(i) (args.in[i])
    float* out = args.out;
    bf16_t* W0in = (bf16_t*)(ws + WS_W0IN); bf16_t* W0out = (bf16_t*)(ws + WS_W0OUT); bf16_t* Wup0 = (bf16_t*)(ws + WS_WUP0); bf16_t* Wdn0 = (bf16_t*)(ws + WS_WDN0);
    bf16_t* W1in = (bf16_t*)(ws + WS_W1IN); bf16_t* Wuq = (bf16_t*)(ws + WS_WUQ); bf16_t* Wukv = (bf16_t*)(ws + WS_WUKV); bf16_t* W1out = (bf16_t*)(ws + WS_W1OUT);
    bf16_t* Wup1 = (bf16_t*)(ws + WS_WUP1); bf16_t* Wdn1 = (bf16_t*)(ws + WS_WDN1);
    bf16_t* XB = (bf16_t*)(ws + WS_XB); bf16_t* YMIX = (bf16_t*)(ws + WS_YMIX); bf16_t* PROJ0 = (bf16_t*)(ws + WS_BIG);
    float* YRAW = out; bf16_t* YSSM = (bf16_t*)(out + (size_t)M * 512); bf16_t* STB = (bf16_t*)(out + (size_t)M * 768); bf16_t* XST = (bf16_t*)(ws + WS_XST); bf16_t* BT = (bf16_t*)(ws + WS_BT); float* ASUM = (float*)(ws + WS_ASUM); float* SLOC = (float*)(ws + WS_SLOC); float* DT = (float*)(ws + WS_DT); bf16_t* GB = (bf16_t*)(ws + WS_G); float* BONUS = (float*)(ws + WS_BONUS);
    bf16_t* W2T = (bf16_t*)(ws + WS_W2T); bf16_t* A2T = (bf16_t*)(ws + WS_A2T); bf16_t* G2T = (bf16_t*)(ws + WS_G2T); bf16_t* ACT = (bf16_t*)(ws + WS_GU); bf16_t* HALO = (bf16_t*)(ws + WS_GU + 176 * MiB);
    bf16_t* PROJ1 = (bf16_t*)(ws + WS_PROJ1); bf16_t* QM = (bf16_t*)(ws + WS_QM); bf16_t* KVM = (bf16_t*)(ws + WS_KVM); bf16_t* KPE = (bf16_t*)(ws + WS_KPE); float* RS = (float*)(ws + WS_RS); float* CSTAB = (float*)(ws + WS_CSTAB); bf16_t* VTS = (bf16_t*)(ws + WS_VTS); bf16_t* VTM = (bf16_t*)(ws + WS_VTM);
    const int* pos = (const int*)args.in[1];

    {
        PHASE_IDS();
    {
        LAS float* scr = (LAS float*)(lds3 + wave * 16384);
        transpose_matrix(IN(2), 1024, 3336, W0in, L0P, 1024, scr, gw, NGW, lane, nullptr);
        transpose_matrix(IN(20), 1024, 1024, W0out, 1024, 1024, scr, gw, NGW, lane, nullptr);
        transpose_matrix(IN(23), 1024, 5632, Wup0, 5632, 1024, scr, gw, NGW, lane, nullptr, true);
        transpose_matrix(IN(26), 2816, 1024, Wdn0, 1024, 2816, scr, gw, NGW, lane, nullptr);
        transpose_matrix(IN(29), 1024, 1952, W1in, L1P, 1024, scr, gw, NGW, lane, nullptr);
        transpose_matrix(IN(31), 256, 768, Wuq, 768, 256, scr, gw, NGW, lane, IN(30));
        transpose_matrix(IN(33), 128, 1024, Wukv, 1024, 256, scr, gw, NGW, lane, IN(32));
        for (int i = gtid; i < 1024 * 16; i += NT) { const int n = i >> 4, c = i & 15; *(v4u*)(Wukv + (size_t)n * 256 + 128 + c * 8) = (v4u){0u, 0u, 0u, 0u}; }
        transpose_matrix(IN(34), 1024, 1024, W1out, 1024, 1024, scr, gw, NGW, lane, nullptr);
        transpose_matrix(IN(37), 1024, 5632, Wup1, 5632, 1024, scr, gw, NGW, lane, nullptr, true);
        transpose_matrix(IN(40), 2816, 1024, Wdn1, 1024, 2816, scr, gw, NGW, lane, nullptr);
        transpose_matrix(IN(5), 64, 512, W2T, 512, 64, scr, gw, NGW, lane, nullptr);
        transpose_matrix(IN(7), 64, 512, A2T, 512, 64, scr, gw, NGW, lane, nullptr);
        transpose_matrix(IN(8), 128, 512, G2T, 512, 128, scr, gw, NGW, lane, nullptr);
        const float* x = IN(0);
        {
            constexpr size_t TOT4 = (size_t)M * DM / 4;
            for (size_t i = gtid; i < TOT4; i += (size_t)NT * 8) {
                f32x4 v[8];
#pragma unroll
                for (int u = 0; u < 8; ++u) v[u] = *(const f32x4*)(x + (i + (size_t)u * NT) * 4);
#pragma unroll
                for (int u = 0; u < 8; ++u) { uint2 w; w.x = cvtpk(v[u][0], v[u][1]); w.y = cvtpk(v[u][2], v[u][3]); *(uint2*)(XB + (i + (size_t)u * NT) * 4) = w; }
            }
        }
    }
    }
    GRID_BAR();
    {
        PHASE_IDS();
    GEMM_PHASE(EpiBf16S, XB, DM, W0in, 1024, L0P, 1024, PROJ0, nullptr, L0P, 0);
    }
    GRID_BAR();
    {
        PHASE_IDS();
        const int blk = (int)blockIdx.x, m0 = blk * 128;
        {   LAS bf16_t* scr = (LAS bf16_t*)(lds3 + wave * 16384);
#pragma unroll 1
            for (int k = 0; k < 4; ++k) ssd_conv_tile((2 * blk + (k & 1)) * 16 + wave + 8 * (k >> 1), lane, scr, PROJ0, IN(14), IN(15), XB, XST, BT);
            for (int i = tid; i < 1024; i += NWAVES * 64) { const int m = m0 + (i >> 3); DT[(size_t)m * 8 + (i & 7)] = softplusf_(bf2f(PROJ0[(size_t)m * L0P + 3328 + (i & 7)]) + IN(16)[i & 7]); }
        }
        __syncthreads();
        ssd_s1_unit(blk * 8 + wave, lane, (LAS float*)(lds3 + wave * 16384), XST, BT, DT, IN(17), SLOC, ASUM);
    }
    GRID_BAR();
    {
        PHASE_IDS();
        ssd_s2_all(SLOC, ASUM, STB, gtid, NT);
        rwkv_phase((LAS float*)lds3, tid, lane, wave, (int)blockIdx.x, PROJ0, IN(3), IN(4), IN(6), IN(9), IN(10), IN(11), W2T, A2T, G2T, YRAW, GB, BONUS);
    }
    GRID_BAR();
    {
        PHASE_IDS();
        const int blk = (int)blockIdx.x;
        ssd_s3_unit(blk * 8 + wave, lane, (LAS float*)(lds3 + wave * 16384), XB, XST, STB, DT, IN(17), IN(18), YSSM);
        __syncthreads();
        ssm_gate_norm_all(YSSM, PROJ0, IN(19), YMIX, blk * 256 + wave, blk * 256 + 256, lane);
        rwkv_post_all(YRAW, PROJ0, IN(3), BONUS, GB, IN(12), IN(13), YMIX, gw, NGW, lane);
    }
    GRID_BAR();
    {
        PHASE_IDS();
    GEMM_PHASE(EpiResid, YMIX, DM, W0out, 1024, 1024, 1024, IN(0), out, ALPHA, 0);
    }
    GRID_BAR();
    {
        PHASE_IDS();
    ln_rows(out, XB, IN(21), IN(22), gw, NGW, lane);
    }
    GRID_BAR();
    {
        PHASE_IDS();
        { pg8::Gemm g_{XB, Wup0, M / 32, DFF, 1024, DM, 1024, 4096, 8192, 256, 512, 1}; pg8::StaticOrder S_; S_.init(M / 32, DFF, G, (int)blockIdx.x);
          pg8::EpiBf16S E_{HALO, nullptr, DFF, 0}; pg8::gemm_phase<pg8::EpiBf16S, pg8::StaticOrder, true, true>(lds3, g_, S_, E_); }
    }
    GRID_BAR();
    {
        PHASE_IDS();
        { pg8::Gemm g_{XB, Wup0, M, 2 * DFF, 1024, DM, 1024}; pg8::StaticOrder S_; S_.init(M, 2 * DFF, G, (int)blockIdx.x);
          pg8::EpiConvAct E_{ACT, HALO, IN(24), IN(25), DFF, SEQ}; pg8::gemm_phase<pg8::EpiConvAct, pg8::StaticOrder, true, true>(lds3, g_, S_, E_); }
    }
    GRID_BAR();
    {
        PHASE_IDS();
    GEMM_PHASE(EpiResid, ACT, DFF, Wdn0, DFF, 1024, DFF, out, out, ALPHA, 0);
    }
    GRID_BAR();
    {
        PHASE_IDS();
    ln_rows(out, XB, IN(27), IN(28), gw, NGW, lane);
    }
    GRID_BAR();
    {
        PHASE_IDS();
    GEMM_PHASE(EpiBf16S, XB, DM, W1in, 1024, L1P, 1024, PROJ1, nullptr, L1P, 0);
    }
    GRID_BAR();
    {
        PHASE_IDS();
    mla_prep_all(PROJ1, pos, RS, KPE, CSTAB, gw, NGW, lane);
    }
    GRID_BAR();
    {
        PHASE_IDS();
    GEMM_PHASE(EpiBf16S, PROJ1 + 1536, L1P, Wuq, 256, 768, 256, QM, RS, 768, 2);
    GEMM_PHASE(EpiBf16S, PROJ1 + 1792, L1P, Wukv, 256, 1024, 256, KVM, RS + 1, 1024, 2);
    }
    GRID_BAR();
    {
        PHASE_IDS();
    rope_q_all(QM, CSTAB, gtid, NT);
    {
        LAS bf16_t* scr = (LAS bf16_t*)(lds3 + wave * 16384);
        for (int it = gw; it < 8192; it += NGW) { const int which = it >> 12, r = it & 4095, bh = r >> 5, tt = r & 31, b = bh >> 3, h = bh & 7;
            if (which == 0) transpose_tile64(PROJ1 + ((size_t)b * SEQ + tt * 64) * L1P + 1024 + h * 64, L1P, VTS + (size_t)bh * 64 * SEQ + tt * 64, SEQ, scr, lane);
            else            transpose_tile64(KVM + ((size_t)b * SEQ + tt * 64) * 1024 + h * 128 + 64, 1024, VTM + (size_t)bh * 64 * SEQ + tt * 64, SEQ, scr, lane); }
    }
    }
    GRID_BAR();
    {
        PHASE_IDS();
    {
        for (int g2 = (int)blockIdx.x; g2 < 256; g2 += G) { const int bh = g2 >> 1, part = g2 & 1;
#pragma unroll 1
            for (int i = 0; i < 4; ++i) { const int sbk = part ? ((i == 0) ? 1 : (i == 1) ? 6 : (i == 2) ? 2 : 5) : ((i == 0) ? 0 : (i == 1) ? 7 : (i == 2) ? 3 : 4);
                sb_block(bh, sbk, tid, lane, wave, lds3, PROJ1, VTS, YMIX); } }
        for (int g2 = (int)blockIdx.x; g2 < 256; g2 += G) { const int bh = g2 >> 1, part = g2 & 1;
#pragma unroll 1
            for (int i = 0; i < 4; ++i) { const int sbk = part ? ((i == 0) ? 1 : (i == 1) ? 6 : (i == 2) ? 2 : 5) : ((i == 0) ? 0 : (i == 1) ? 7 : (i == 2) ? 3 : 4);
                mla_block(bh, sbk, tid, lane, wave, lds3, QM, KVM, KPE, VTM, YMIX); } }
    }
    }
    GRID_BAR();
    {
        PHASE_IDS();
    GEMM_PHASE(EpiResid, YMIX, DM, W1out, 1024, 1024, 1024, out, out, ALPHA, 0);
    }
    GRID_BAR();
    {
        PHASE_IDS();
    ln_rows(out, XB, IN(35), IN(36), gw, NGW, lane);
    }
    GRID_BAR();
    {
        PHASE_IDS();
        { pg8::Gemm g_{XB, Wup1, M / 32, DFF, 1024, DM, 1024, 4096, 8192, 256, 512, 1}; pg8::StaticOrder S_; S_.init(M / 32, DFF, G, (int)blockIdx.x);
          pg8::EpiBf16S E_{HALO, nullptr, DFF, 0}; pg8::gemm_phase<pg8::EpiBf16S, pg8::StaticOrder, true, true>(lds3, g_, S_, E_); }
    }
    GRID_BAR();
    {
        PHASE_IDS();
        { pg8::Gemm g_{XB, Wup1, M, 2 * DFF, 1024, DM, 1024}; pg8::StaticOrder S_; S_.init(M, 2 * DFF, G, (int)blockIdx.x);
          pg8::EpiConvAct E_{ACT, HALO, IN(38), IN(39), DFF, SEQ}; pg8::gemm_phase<pg8::EpiConvAct, pg8::StaticOrder, true, true>(lds3, g_, S_, E_); }
    }
    GRID_BAR();
    {
        PHASE_IDS();
    GEMM_PHASE(EpiResid, ACT, DFF, Wdn1, DFF, 1024, DFF, out, out, ALPHA, 0);
    }
    GRID_BAR();
    {
        PHASE_IDS();
    ln_rows(out, XB, IN(41), IN(42), gw, NGW, lane);
    #if defined(PROBE_STAMPS)
    __syncthreads();
    if (blockIdx.x == 0 && threadIdx.x == 0) {
        MISC[16 + 22] = (unsigned)__builtin_amdgcn_s_memrealtime();
        const unsigned d1 = MISC[16 + PROBE_T1_HI] - MISC[16 + PROBE_T1_LO];
        const unsigned long long spin = 100ull * d1;
        const unsigned long long t0 = __builtin_amdgcn_s_memrealtime();
        while (__builtin_amdgcn_s_memrealtime() - t0 < spin) __builtin_amdgcn_s_sleep(8);
    }
#endif
}
}

extern "C" void kernel_launch(void* const* d_in, const int* in_sizes, int n_in, void* d_out, int out_size, void* d_ws, size_t ws_size, hipStream_t stream) {
    static int grid = 0;
    if (grid == 0) {
        if (n_in != 43 || ws_size < WS_NEED || out_size != M * DM) { fprintf(stderr, "kernel_launch: unexpected n_in %d / ws %zu / out %d\n", n_in, ws_size, out_size); grid = -1; return; }
        int dev = 0, cus = 0, per_cu = 0;
        if (hipGetDevice(&dev) != hipSuccess || hipDeviceGetAttribute(&cus, hipDeviceAttributeMultiprocessorCount, dev) != hipSuccess) { grid = -1; return; }
        if (hipFuncSetAttribute((const void*)fwd_mega, hipFuncAttributeMaxDynamicSharedMemorySize, LDS_BYTES) != hipSuccess) { fprintf(stderr, "kernel_launch: hipFuncSetAttribute failed\n"); grid = -1; return; }
        if (hipOccupancyMaxActiveBlocksPerMultiprocessor(&per_cu, (const void*)fwd_mega, NWAVES * 64, LDS_BYTES) != hipSuccess || per_cu < 1) fprintf(stderr, "kernel_launch: occupancy query reports %d\n", per_cu);
        (void)hipGetLastError();
        grid = cus;
    }
    if (grid < 0) return;
    (void)hipMemsetAsync((char*)d_ws + WS_CTL, 0, CTL_ZERO_BYTES, stream);
    Args a{};
    for (int i = 0; i < 43; ++i) a.in[i] = (const float*)d_in[i];
    a.out = (float*)d_out; a.ws = (unsigned char*)d_ws;
    hipLaunchKernelGGL(fwd_mega, dim3(grid), dim3(NWAVES * 64), LDS_BYTES, stream, a);
}
```

```cpp
#include <hip/hip_runtime.h>
#include <cstdio>
#include <cstdint>
#include <cmath>
namespace pg8 {
#define PG8_LAS __attribute__((address_space(3)))
typedef unsigned short bf16_t;
typedef short bf16x8 __attribute__((ext_vector_type(8)));
typedef float f32x4 __attribute__((ext_vector_type(4)));
typedef unsigned u32x4 __attribute__((ext_vector_type(4)));
constexpr int BM = 256, BK = 64, HALF = 128, HTB = HALF * BK * 2  , STAGE_BYTES = 8 * HTB, NXCD = 8, WGM = 8;

__host__ __device__ __forceinline__ int lds_byte(int r, int c) { const int st = (r >> 4) * 2 + (c >> 5), rr = r & 15, cc = c & 31, ob = rr * 64 + cc * 2; return st * 1024 + (ob ^ (((ob >> 9) & 1) << 5)); }
__host__ __device__ __forceinline__ void stage_rc(int b, int& R, int& C) { const int st = b / 1024, sb = b % 1024, swz = sb ^ (((sb >> 9) & 1) << 5); R = (st >> 1) * 16 + swz / 64; C = (st & 1) * 32 + (swz % 64) / 2; }
__host__ __device__ __forceinline__ int perm32(int rho) { const int n = rho >> 4, i = rho & 15; return 8 * (i >> 2) + 4 * n + (i & 3); }

struct Unit { int pm, pn; };
struct Gemm { const bf16_t* A; const bf16_t* Bt; int M, N, K, lda, ldb; int hrA = 128, trA = 256, hrB = 128, trB = 256, gatherA = 0; };

struct StaticOrder {
    int nM, nN, nwg, G, c;
    __host__ __device__ void init(int M, int N, int G_, int c_) { nM = M / BM; nN = N / BM; nwg = nM * nN; G = G_; c = c_; }
    __host__ __device__ bool next(int i, Unit& u) const {
        const long L = (long)i * G + c; if (L >= nwg) return false;
        int wgid = (int)L; { const int q = nwg / NXCD, r = nwg % NXCD, xcd = wgid % NXCD, off = wgid / NXCD; wgid = (xcd < r ? xcd * (q + 1) : r * (q + 1) + (xcd - r) * q) + off; }
        const int nig = WGM * nN, gid = wgid / nig, fm = gid * WGM, gsz = (nM - fm) < WGM ? (nM - fm) : WGM;
        u.pm = fm + ((wgid % nig) % gsz); u.pn = (wgid % nig) / gsz; return true;
    }
    __device__ __forceinline__ void a_ready(const Unit&) const {}
    __device__ __forceinline__ void done(const Unit&) const {}
};


__device__ __forceinline__ unsigned cvt_pk_bf16(float lo, float hi) { unsigned r; asm volatile("v_cvt_pk_bf16_f32 %0, %1, %2" : "=v"(r) : "v"(lo), "v"(hi)); return r; }
struct EpiBf16S {
    static constexpr bool PERM = true, AFTER_DRAIN = false;
    bf16_t* O; const float* rowscale; int ldc; int rs_stride;
    __device__ __forceinline__ void operator()(const f32x4 (&acc)[2][2][4][2], const Unit& u, int wr, int wc, int fr, int fq) const {
        const int row0 = u.pm * BM + wr * 64 + fr, col0 = u.pn * BM + wc * 32 + 8 * fq;
#pragma unroll
        for (int ai = 0; ai < 2; ++ai)
#pragma unroll
            for (int m = 0; m < 4; ++m) { const int row = row0 + ai * HALF + m * 16; const float sc = rowscale ? rowscale[(size_t)row * rs_stride] : 1.f;
                bf16_t* rowp = O + (size_t)row * ldc + col0;
#pragma unroll
                for (int bj = 0; bj < 2; ++bj) { const f32x4 v0 = acc[ai][bj][m][0] * sc, v1 = acc[ai][bj][m][1] * sc;
                    u32x4 w; w.x = cvt_pk_bf16(v0[0], v0[1]); w.y = cvt_pk_bf16(v0[2], v0[3]); w.z = cvt_pk_bf16(v1[0], v1[1]); w.w = cvt_pk_bf16(v1[2], v1[3]);
                    *(u32x4*)(rowp + bj * HALF) = w; } }
    }
};
struct EpiResid {
    static constexpr bool PERM = false, AFTER_DRAIN = false;
    const float* hin; float* hout; float alpha; int pad;
    __device__ __forceinline__ void operator()(const f32x4 (&acc)[2][2][4][2], const Unit& u, int wr, int wc, int fr, int fq) const {
        const int row0 = u.pm * BM + wr * 64 + fr, col0 = u.pn * BM + wc * 32 + 4 * fq;
#pragma unroll
        for (int ai = 0; ai < 2; ++ai)
#pragma unroll
            for (int m = 0; m < 4; ++m) { const size_t off = (size_t)(row0 + ai * HALF + m * 16) * 1024 + col0;
#pragma unroll
                for (int bj = 0; bj < 2; ++bj)
#pragma unroll
                    for (int n = 0; n < 2; ++n) { const size_t i = off + bj * HALF + n * 16; const f32x4 h = *(const f32x4*)(hin + i); *(f32x4*)(hout + i) = h * alpha + acc[ai][bj][m][n]; } }
    }
};

template <int CTRL> __device__ __forceinline__ float pg_dpp(float x) { return __builtin_bit_cast(float, __builtin_amdgcn_update_dpp(0, __builtin_bit_cast(int, x), CTRL, 0xF, 0xF, true)); }
struct EpiConvAct {
    static constexpr bool PERM = true, AFTER_DRAIN = false;
    bf16_t* act; const bf16_t* halo; const float* cw; const float* cb; int dff; int seq;
    __device__ __forceinline__ void operator()(const f32x4 (&acc)[2][2][4][2], const Unit& u, int wr, int wc, int fr, int fq) const {
        typedef unsigned u32x2e __attribute__((ext_vector_type(2)));
#pragma unroll
        for (int n = 0; n < 2; ++n) {
            const int ch0 = u.pn * 128 + wc * 32 + 8 * fq + 4 * n;
            const f32x4 w0 = *(const f32x4*)(cw + ch0), w1 = *(const f32x4*)(cw + dff + ch0), w2 = *(const f32x4*)(cw + 2 * dff + ch0), bb = *(const f32x4*)(cb + ch0);
#pragma unroll
            for (int ai = 0; ai < 2; ++ai) {
                const int rb64 = u.pm * BM + ai * HALF + wr * 64;
                f32x4 P = {0.f, 0.f, 0.f, 0.f};
                if ((rb64 & (seq - 1)) != 0 && fr >= 14) { const u32x2e hv = *(const u32x2e*)(halo + (size_t)(2 * (rb64 / 64 - 1) + (fr - 14)) * dff + ch0);
                    P[0] = __builtin_bit_cast(float, hv.x << 16); P[1] = __builtin_bit_cast(float, hv.x & 0xffff0000u); P[2] = __builtin_bit_cast(float, hv.y << 16); P[3] = __builtin_bit_cast(float, hv.y & 0xffff0000u); }
#pragma unroll
                for (int m = 0; m < 4; ++m) {
                    const f32x4 Gv = acc[ai][0][m][n], Uv = acc[ai][1][m][n];
                    float o[4];
#pragma unroll
                    for (int e = 0; e < 4; ++e) {
                        const float t1 = pg_dpp<0x111>(Gv[e]), t2 = pg_dpp<0x112>(Gv[e]), p1 = pg_dpp<0x10F>(P[e]), p2 = pg_dpp<0x10E>(P[e]);
                        const float g1 = (fr >= 1) ? t1 : p1, g2 = (fr >= 2) ? t2 : p2;
                        const float y = bb[e] + w0[e] * g2 + w1[e] * g1 + w2[e] * Gv[e];
                        o[e] = y / (1.f + __expf(-y)) * Uv[e];
                    }
                    u32x2e w; w.x = cvt_pk_bf16(o[0], o[1]); w.y = cvt_pk_bf16(o[2], o[3]);
                    *(u32x2e*)(act + (size_t)(rb64 + m * 16 + fr) * dff + ch0) = w;
                    P = Gv;
                }
            }
        }
    }
};

template <class Epi, class Sched, bool ALIGN_EPI = false, bool SP2 = false>
__device__ __forceinline__ void gemm_phase(PG8_LAS unsigned char* lds, const Gemm g, const Sched& S, const Epi& E) {
    int tid = threadIdx.x; asm volatile("" : "+v"(tid));
    const int wid = __builtin_amdgcn_readfirstlane(tid >> 6), lane = tid & 63, wr = wid >> 2, wc = wid & 3, fr = lane & 15, fq = lane >> 4;
    const int K = g.K, nt = K / BK;
    unsigned voffA[2], voffB[2];
#pragma unroll
    for (int i = 0; i < 2; ++i) { int R, C; stage_rc(tid * 16 + i * 8192, R, C); const int Rb = Epi::PERM ? ((R & ~31) + perm32(R & 31)) : R;
        const int Ra = g.gatherA ? (64 * (R >> 1) + 62 + (R & 1)) : R;
        voffA[i] = (unsigned)(Ra * g.lda + C) * 2u; voffB[i] = (unsigned)(Rb * g.ldb + C) * 2u; }
    const size_t kstep = (size_t)(BK * 2);
    const size_t hstepA = (size_t)g.hrA * g.lda * 2, hstepB = (size_t)g.hrB * g.ldb * 2;
    const size_t tstepA = (size_t)g.trA * g.lda * 2, tstepB = (size_t)g.trB * g.ldb * 2;
    const unsigned ldsw = (unsigned)wid * 1024u;
    const int aoff = lds_byte(wr * 64 + fr, fq * 8), boff = lds_byte(wc * 32 + fr, fq * 8);
#define PG8_SA(b, h) (((b) * 2 + (h)) * HTB)
#define PG8_SB(b, h) ((4 + (b) * 2 + (h)) * HTB)
#define PG8_STAGE(bufoff, gbase, voff) do { _Pragma("unroll") for (int _i = 0; _i < 2; ++_i) \
        __builtin_amdgcn_global_load_lds((const unsigned*)((const char*)(gbase) + (voff)[_i]), (PG8_LAS unsigned*)(lds + (bufoff) + ldsw + _i * 8192), 16, 0, 0); } while (0)
#define PG8_LDA(dst, b, h) do { _Pragma("unroll") for (int m = 0; m < 4; ++m) _Pragma("unroll") for (int k = 0; k < 2; ++k) dst[m][k] = *(const PG8_LAS bf16x8*)(lds + PG8_SA(b, h) + aoff + m * 2048 + k * 1024); } while (0)
#define PG8_LDB(dst, b, h) do { _Pragma("unroll") for (int n = 0; n < 2; ++n) _Pragma("unroll") for (int k = 0; k < 2; ++k) dst[n][k] = *(const PG8_LAS bf16x8*)(lds + PG8_SB(b, h) + boff + n * 2048 + k * 1024); } while (0)
#define PG8_MMA(ai, bj, At, Bt) do { __builtin_amdgcn_s_setprio(1); _Pragma("unroll") for (int m = 0; m < 4; ++m) _Pragma("unroll") for (int n = 0; n < 2; ++n) _Pragma("unroll") for (int k = 0; k < 2; ++k) \
        acc[ai][bj][m][n] = __builtin_amdgcn_mfma_f32_16x16x32_bf16(Bt[n][k], At[m][k], acc[ai][bj][m][n], 0, 0, 0); __builtin_amdgcn_s_setprio(0); } while (0)
#define PG8_WAIT_V(n) asm volatile("s_waitcnt vmcnt(" #n ")" ::: "memory")
#define PG8_WAIT_L(n) asm volatile("s_waitcnt lgkmcnt(" #n ")" ::: "memory")
#define PG8_BAR __builtin_amdgcn_s_barrier()
#define PG8_SCHED __builtin_amdgcn_sched_barrier(0)
    Unit cur, nxt; int ui = 0;
    if (!S.next(0, cur)) return;
    f32x4 acc[2][2][4][2];
#pragma unroll
    for (int a = 0; a < 2; ++a)
#pragma unroll
        for (int b = 0; b < 2; ++b)
#pragma unroll
            for (int m = 0; m < 4; ++m)
#pragma unroll
                for (int n = 0; n < 2; ++n) acc[a][b][m][n] = (f32x4){0.f, 0.f, 0.f, 0.f};
    bf16x8 At[4][2], B0[2][2], B1[2][2];
    const char* cA = (const char*)g.A + (size_t)cur.pm * tstepA; const char* cB = (const char*)g.Bt + (size_t)cur.pn * tstepB;
    S.a_ready(cur);
    if constexpr (SP2) {
        PG8_STAGE(PG8_SB(0, 0), cB, voffB); PG8_STAGE(PG8_SB(0, 1), cB + hstepB, voffB); PG8_STAGE(PG8_SA(0, 0), cA, voffA); PG8_STAGE(PG8_SA(0, 1), cA + hstepA, voffA);
        if (wr == 1) PG8_BAR;
        PG8_WAIT_V(2); PG8_BAR;
        PG8_STAGE(PG8_SB(1, 0), cB + kstep, voffB); PG8_STAGE(PG8_SA(1, 0), cA + kstep, voffA); PG8_STAGE(PG8_SB(1, 1), cB + hstepB + kstep, voffB);
        PG8_WAIT_V(6); PG8_BAR;
    } else {
        PG8_STAGE(PG8_SB(0, 0), cB, voffB); PG8_STAGE(PG8_SA(0, 0), cA, voffA); PG8_STAGE(PG8_SB(0, 1), cB + hstepB, voffB); PG8_STAGE(PG8_SA(0, 1), cA + hstepA, voffA);
        if (wr == 1) PG8_BAR;
        PG8_WAIT_V(4); PG8_BAR;
        PG8_STAGE(PG8_SB(1, 0), cB + kstep, voffB); PG8_STAGE(PG8_SA(1, 0), cA + kstep, voffA); PG8_STAGE(PG8_SB(1, 1), cB + hstepB + kstep, voffB);
        PG8_WAIT_V(6); PG8_BAR;
    }
    for (;;) {
        const bool has_next = S.next(ui + 1, nxt);
        const char* nA = has_next ? (const char*)g.A + (size_t)nxt.pm * tstepA : cA; const char* nB = has_next ? (const char*)g.Bt + (size_t)nxt.pn * tstepB : cB;
        for (int t = 0; t < nt; t += 2) {
            const bool last = (t == nt - 2);
            const char* a1 = cA + (size_t)(t + 1) * kstep;
            const char* a2 = last ? nA : cA + (size_t)(t + 2) * kstep; const char* b2 = last ? nB : cB + (size_t)(t + 2) * kstep;
            const char* a3 = a2 + kstep; const char* b3 = b2 + kstep;
            if (last && has_next) S.a_ready(nxt);
            if constexpr (SP2) {
            PG8_LDB(B0, 0, 0); PG8_LDB(B1, 0, 1); PG8_SCHED; PG8_LDA(At, 0, 0); PG8_STAGE(PG8_SA(1, 1), a1 + hstepA, voffA);
            PG8_WAIT_V(8); PG8_WAIT_L(0); PG8_BAR; PG8_MMA(0, 0, At, B0); PG8_MMA(0, 1, At, B1); PG8_BAR; PG8_SCHED;
            PG8_LDA(At, 0, 1); PG8_STAGE(PG8_SB(0, 0), b2, voffB); PG8_STAGE(PG8_SB(0, 1), b2 + hstepB, voffB); PG8_STAGE(PG8_SA(0, 0), a2, voffA);
            PG8_WAIT_V(8); PG8_WAIT_L(0); PG8_BAR; PG8_MMA(1, 0, At, B0); PG8_MMA(1, 1, At, B1); PG8_BAR; PG8_SCHED;
            PG8_LDB(B0, 1, 0); PG8_LDB(B1, 1, 1); PG8_SCHED; PG8_LDA(At, 1, 0); PG8_STAGE(PG8_SA(0, 1), a2 + hstepA, voffA);
            PG8_WAIT_V(8); PG8_WAIT_L(0); PG8_BAR; PG8_MMA(0, 0, At, B0); PG8_MMA(0, 1, At, B1); PG8_BAR; PG8_SCHED;
            PG8_LDA(At, 1, 1); PG8_STAGE(PG8_SB(1, 0), b3, voffB); PG8_STAGE(PG8_SB(1, 1), b3 + hstepB, voffB); PG8_STAGE(PG8_SA(1, 0), a3, voffA);
            PG8_WAIT_V(8); PG8_WAIT_L(0); PG8_BAR; PG8_MMA(1, 0, At, B0); PG8_MMA(1, 1, At, B1); PG8_BAR; PG8_SCHED;
            } else {
            PG8_LDB(B0, 0, 0); PG8_SCHED; PG8_LDA(At, 0, 0); PG8_STAGE(PG8_SA(1, 1), a1 + hstepA, voffA);
            PG8_WAIT_L(8); PG8_BAR; PG8_WAIT_L(0); PG8_MMA(0, 0, At, B0); PG8_BAR; PG8_SCHED;
            PG8_LDB(B1, 0, 1); PG8_STAGE(PG8_SB(0, 0), b2, voffB);
            PG8_BAR; PG8_WAIT_L(0); PG8_MMA(0, 1, At, B1); PG8_BAR;
            PG8_LDA(At, 0, 1); PG8_STAGE(PG8_SA(0, 0), a2, voffA);
            PG8_BAR; PG8_WAIT_L(0); PG8_MMA(1, 0, At, B0); PG8_BAR; PG8_SCHED;
            PG8_STAGE(PG8_SB(0, 1), b2 + hstepB, voffB);
            PG8_WAIT_V(6); PG8_BAR; PG8_MMA(1, 1, At, B1); PG8_BAR;
            PG8_LDB(B0, 1, 0); PG8_SCHED; PG8_LDA(At, 1, 0); PG8_STAGE(PG8_SA(0, 1), a2 + hstepA, voffA);
            PG8_WAIT_L(8); PG8_BAR; PG8_WAIT_L(0); PG8_MMA(0, 0, At, B0); PG8_BAR; PG8_SCHED;
            PG8_LDB(B1, 1, 1); PG8_STAGE(PG8_SB(1, 0), b3, voffB);
            PG8_BAR; PG8_WAIT_L(0); PG8_MMA(0, 1, At, B1); PG8_BAR;
            PG8_LDA(At, 1, 1); PG8_STAGE(PG8_SA(1, 0), a3, voffA);
            PG8_BAR; PG8_WAIT_L(0); PG8_MMA(1, 0, At, B0); PG8_BAR; PG8_SCHED;
            PG8_STAGE(PG8_SB(1, 1), b3 + hstepB, voffB);
            PG8_WAIT_V(6); PG8_BAR; PG8_MMA(1, 1, At, B1); PG8_BAR;
            }
        }
        if constexpr (ALIGN_EPI) { if (wr == 0) PG8_BAR; }
        if constexpr (!Epi::AFTER_DRAIN) { E(acc, cur, wr, wc, fr, fq); S.done(cur); }
        if (!has_next) break;
#pragma unroll
        for (int a = 0; a < 2; ++a)
#pragma unroll
            for (int b = 0; b < 2; ++b)
#pragma unroll
                for (int m = 0; m < 4; ++m)
#pragma unroll
                    for (int n = 0; n < 2; ++n) acc[a][b][m][n] = (f32x4){0.f, 0.f, 0.f, 0.f};
        cur = nxt; cA = nA; cB = nB; ++ui;
        if constexpr (ALIGN_EPI) { if (wr == 1) PG8_BAR; }
    }
    PG8_WAIT_V(0);
    if constexpr (!ALIGN_EPI) { if (wr == 0) PG8_BAR; }
    PG8_BAR;
    if constexpr (Epi::AFTER_DRAIN) { E.fused(acc, cur, wr, wc, fr, fq, lds, wid, lane); S.done(cur); }
#undef PG8_SA
#undef PG8_SB
#undef PG8_STAGE
#undef PG8_LDA
#undef PG8_LDB
#undef PG8_MMA
#undef PG8_WAIT_V
#undef PG8_WAIT_L
#undef PG8_BAR
#undef PG8_SCHED
}
}
#define GAS __attribute__((address_space(1)))
#define LAS __attribute__((address_space(3)))
typedef unsigned short bf16;
typedef unsigned v4u __attribute__((ext_vector_type(4)));
typedef float f32x4 __attribute__((ext_vector_type(4)));
typedef short bf16x8 __attribute__((ext_vector_type(8)));
typedef GAS unsigned gu32;
typedef GAS unsigned long long gu64;
#define RLX_AGENT __ATOMIC_RELAXED, __HIP_MEMORY_SCOPE_AGENT
#define LDS_WAIT() asm volatile("s_waitcnt lgkmcnt(0)" ::: "memory")
#define VM_WAIT() asm volatile("s_waitcnt vmcnt(0)" ::: "memory")
__device__ __forceinline__ unsigned long long rt() { return __builtin_amdgcn_s_memrealtime(); }
__device__ __forceinline__ unsigned f2bf(float f) { unsigned u = __builtin_bit_cast(unsigned, f); return (u + 0x7fffu + ((u >> 16) & 1u)) >> 16; }
__device__ __forceinline__ unsigned pk2(float lo, float hi) { return f2bf(lo) | (f2bf(hi) << 16); }

#define XB_TMO      128
#define XB_XCNT(j)  (256  + 64 * (j))
#define XB_XSUB(j)  (1280 + 64 * (j))
#define XB_XGEN(j)  (2304 + 64 * (j))
#define XB_TOP      3328
#define XB_TOPGEN   3392
#define XCD_BAR_WORDS 3456
#define XB_SPIN_CAP (1u << 18)

__device__ __forceinline__ unsigned xb_ld(unsigned* p)              { return __hip_atomic_load(p, __ATOMIC_RELAXED, __HIP_MEMORY_SCOPE_AGENT); }
__device__ __forceinline__ unsigned xb_add(unsigned* p, unsigned v) { return __hip_atomic_fetch_add(p, v, __ATOMIC_RELAXED, __HIP_MEMORY_SCOPE_AGENT); }
__device__ __forceinline__ unsigned xb_xcc_id() { return (unsigned)__builtin_amdgcn_s_getreg((3 << 11) | 20) & 0xFu; }
#define XB_SPIN(cond, bar) do { unsigned _sp = 0; while (cond) { __builtin_amdgcn_s_sleep(1); \
    if ((++_sp & 255u) == 0u) { if (xb_ld(&(bar)[XB_TMO])) break; if (_sp > XB_SPIN_CAP) { atomicAdd(&(bar)[XB_TMO], 1u); break; } } } } while (0)

struct XcdBarrier {
    unsigned* bar; unsigned x;
    volatile LAS unsigned* st;
};

__device__ __forceinline__ XcdBarrier xcd_barrier_post(unsigned* bar, volatile LAS unsigned* st) {
    XcdBarrier b; b.bar = bar; b.x = xb_xcc_id(); b.st = st;
    if (threadIdx.x == 0) (void)xb_add(&bar[XB_XCNT(b.x)], 1u);
    return b;
}
__device__ __forceinline__ void xcd_barrier_complete(unsigned* bar, unsigned x, unsigned& nloc, unsigned& nx) {
    const unsigned G = gridDim.x * gridDim.y * gridDim.z;
    unsigned sum, cnt, mine, sp = 0u;
    for (;;) {
        sum = 0u; cnt = 0u; mine = 0u;
#pragma unroll
        for (unsigned j = 0; j < 16; ++j) { const unsigned c = xb_ld(&bar[XB_XCNT(j)]); sum += c; cnt += (c > 0u) ? 1u : 0u; mine = (j == x) ? c : mine; }
        if (sum == G) break;
        __builtin_amdgcn_s_sleep(1);
        if ((++sp & 255u) == 0u) { if (xb_ld(&bar[XB_TMO])) break; if (sp > XB_SPIN_CAP) { atomicAdd(&bar[XB_TMO], 1u); break; } }
    }
    nloc = mine > 0u ? mine : 1u; nx = cnt > 0u ? cnt : 1u;
}

__device__ __forceinline__ void xcd_barrier(const XcdBarrier& b) {
    asm volatile("s_waitcnt vmcnt(0)" ::: "memory");
    __syncthreads();
    if (threadIdx.x == 0) {
        unsigned* bar = b.bar;
        __builtin_amdgcn_s_waitcnt(0);
        unsigned nloc = b.st[0], nx = b.st[1];
        if (nloc == 0u) { xcd_barrier_complete(bar, b.x, nloc, nx); b.st[0] = nloc; b.st[1] = nx; }
        const unsigned old = xb_add(&bar[XB_XSUB(b.x)], 1u);
        const unsigned gen = old / nloc;
        if (old + 1u == (gen + 1u) * nloc) {
            __builtin_amdgcn_fence(__ATOMIC_RELEASE, "agent");
            asm volatile("s_waitcnt vmcnt(0)" ::: "memory");
            const unsigned og = xb_add(&bar[XB_TOP], 1u);
            const unsigned tg = og / nx;
            if (og + 1u == (tg + 1u) * nx) xb_add(&bar[XB_TOPGEN], 1u);
            else XB_SPIN(xb_ld(&bar[XB_TOPGEN]) == tg, bar);
            __builtin_amdgcn_fence(__ATOMIC_ACQUIRE, "agent");
            xb_add(&bar[XB_XGEN(b.x)], 1u);
            asm volatile("s_waitcnt vmcnt(0)" ::: "memory");
        } else {
            XB_SPIN(xb_ld(&bar[XB_XGEN(b.x)]) == gen, bar);
            __builtin_amdgcn_fence(__ATOMIC_ACQUIRE, "agent");
            asm volatile("s_waitcnt vmcnt(0)" ::: "memory");
        }
    }
    __syncthreads();
}
constexpr int NWAVES = 8;
constexpr int BATCH = 16, SEQ = 2048, DM = 1024, M = BATCH * SEQ;
constexpr int L0P = 3584;
constexpr int L1P = 2048;
constexpr int DFF = 2816;
constexpr float ALPHA = 1.4142135623730951f;
typedef unsigned short bf16_t;
typedef float f32x16 __attribute__((ext_vector_type(16)));

constexpr size_t MiB = 1u << 20;
constexpr size_t WS_CTL = 0, CTL_ZERO_BYTES = 1 * MiB;
constexpr int CW_BAR = 4096;
constexpr size_t WS_W0IN = 2 * MiB, WS_W0OUT = 9 * MiB, WS_WUP0 = 11 * MiB, WS_WDN0 = 22 * MiB, WS_W1IN = 28 * MiB, WS_WUQ = 32 * MiB, WS_WUKV = 33 * MiB,
                 WS_W1OUT = 34 * MiB, WS_WUP1 = 36 * MiB, WS_WDN1 = 47 * MiB;
constexpr size_t WS_XB = 56 * MiB, WS_YMIX = 120 * MiB, WS_BIG = 184 * MiB;
constexpr size_t WS_G = 408 * MiB, WS_BONUS = 440 * MiB, WS_DT = 441 * MiB, WS_XST = 442 * MiB, WS_BT = 474 * MiB, WS_ASUM = 490 * MiB;
constexpr size_t WS_SLOC = 120 * MiB;
constexpr size_t WS_W2T = 53 * MiB, WS_A2T = 53 * MiB + 256 * 1024, WS_G2T = 53 * MiB + 512 * 1024;
constexpr size_t WS_GU = 120 * MiB;
constexpr size_t WS_PROJ1 = 184 * MiB, WS_QM = 312 * MiB, WS_KVM = 360 * MiB, WS_KPE = 424 * MiB, WS_RS = 426 * MiB;
constexpr size_t WS_CSTAB = 492 * MiB;
constexpr size_t WS_VTS = 428 * MiB, WS_VTM = 460 * MiB;
constexpr size_t WS_NEED = 496 * MiB;

constexpr int RING_BYTES = 131072;
constexpr int LDSCTL_OFF = 146432, MISC_OFF = LDSCTL_OFF + 320;
constexpr int LDS_BYTES = 147456;

__device__ __forceinline__ float bf2f(bf16_t b) { return __builtin_bit_cast(float, (unsigned)b << 16); }
__device__ __forceinline__ float sigmoidf_(float x) { return 1.f / (1.f + expf(-x)); }
__device__ __forceinline__ float softplusf_(float x) { return fmaxf(x, 0.f) + log1pf(expf(-fabsf(x))); }
__device__ __forceinline__ float siluf_(float x) { return x / (1.f + expf(-x)); }
__device__ __forceinline__ float wave_sum(float v) {
#pragma unroll
    for (int o = 1; o < 64; o <<= 1) v += __shfl_xor(v, o);
    return v;
}
#define WSYNC() asm volatile("s_waitcnt lgkmcnt(0)" ::: "memory")
typedef float f32x2_t __attribute__((ext_vector_type(2)));
typedef __bf16 bf16x2_t __attribute__((ext_vector_type(2)));
typedef unsigned u32x2 __attribute__((ext_vector_type(2)));
__device__ __forceinline__ unsigned cvtpk(float lo, float hi) { f32x2_t v = {lo, hi}; bf16x2_t b = __builtin_convertvector(v, bf16x2_t); return __builtin_bit_cast(unsigned, b); }
__device__ __forceinline__ float bflo(unsigned u) { return __builtin_bit_cast(float, u << 16); }
__device__ __forceinline__ float bfhi(unsigned u) { return __builtin_bit_cast(float, u & 0xffff0000u); }
template <int CTRL> __device__ __forceinline__ float dpp_mov(float x) { return __builtin_bit_cast(float, __builtin_amdgcn_update_dpp(0, __builtin_bit_cast(int, x), CTRL, 0xF, 0xF, true)); }
__device__ __forceinline__ float rowsum16(float x) { x += dpp_mov<0x128>(x); x += dpp_mov<0x124>(x); x += dpp_mov<0x122>(x); x += dpp_mov<0x121>(x); return x; }
__device__ __forceinline__ float rl(float x, int l) { return __builtin_bit_cast(float, __builtin_amdgcn_readlane(__builtin_bit_cast(int, x), l)); }
__device__ __forceinline__ float wave_sum_dpp(float x) { x = rowsum16(x); return (rl(x, 0) + rl(x, 16)) + (rl(x, 32) + rl(x, 48)); }

__device__ __forceinline__ void transpose_matrix(const float* __restrict__ W, int K, int N, bf16_t* __restrict__ WT, int Npad, int ldt, LAS float* scr, int gw, int NGW, int lane, const float* __restrict__ kscale, bool ffn_interleave = false) {
    (void)scr;
    const int nblk = Npad / 64, nit = (K / 64) * nblk;
    for (int it = gw; it < nit; it += NGW) {
        const int kb = it / nblk, nb = it - kb * nblk, n = nb * 64 + lane, k0 = kb * 64;
        const bool ok = n < N; const float* src = W + (size_t)k0 * N + (ok ? n : 0);
#pragma unroll
        for (int hc = 0; hc < 2; ++hc) {
            float v[32];
#pragma unroll
            for (int i = 0; i < 32; ++i) v[i] = src[(size_t)(hc * 32 + i) * N];
#pragma unroll
            for (int c = 0; c < 4; ++c) { float u[8];
#pragma unroll
                for (int i = 0; i < 8; ++i) { u[i] = ok ? v[c * 8 + i] : 0.f; if (kscale) u[i] *= kscale[k0 + hc * 32 + c * 8 + i]; }
                v4u o; o.x = cvtpk(u[0], u[1]); o.y = cvtpk(u[2], u[3]); o.z = cvtpk(u[4], u[5]); o.w = cvtpk(u[6], u[7]);
                const int nr = ffn_interleave ? ((n < DFF) ? 256 * (n >> 7) + (n & 127) : 256 * ((n - DFF) >> 7) + 128 + ((n - DFF) & 127)) : n;
                *(v4u*)(WT + (size_t)nr * ldt + k0 + hc * 32 + c * 8) = o; }
        }
    }
}

template <bool ST = true> __device__ __forceinline__ void ln_rows(float* h, bf16_t* hb, const float* __restrict__ g, const float* __restrict__ b, int gw, int NGW, int lane) {
    for (int row = gw * 2; row < M; row += NGW * 2) {
        float* p = h + (size_t)row * DM;
        f32x4 v[2][4]; float s[2] = {0.f, 0.f};
#pragma unroll
        for (int r = 0; r < 2; ++r)
#pragma unroll
            for (int j = 0; j < 4; ++j) v[r][j] = *(const f32x4*)(p + r * DM + 4 * lane + 256 * j);
#pragma unroll
        for (int r = 0; r < 2; ++r)
#pragma unroll
            for (int j = 0; j < 4; ++j) s[r] += (v[r][j][0] + v[r][j][1]) + (v[r][j][2] + v[r][j][3]);
        float mean[2], q[2] = {0.f, 0.f}, rstd[2];
#pragma unroll
        for (int r = 0; r < 2; ++r) { mean[r] = wave_sum_dpp(s[r]) * (1.f / DM);
#pragma unroll
            for (int j = 0; j < 4; ++j) { v[r][j] = v[r][j] - mean[r]; q[r] += (v[r][j][0] * v[r][j][0] + v[r][j][1] * v[r][j][1]) + (v[r][j][2] * v[r][j][2] + v[r][j][3] * v[r][j][3]); } }
#pragma unroll
        for (int r = 0; r < 2; ++r) rstd[r] = 1.0f / sqrtf(wave_sum_dpp(q[r]) * (1.f / DM) + 1e-5f);
#pragma unroll
        for (int j = 0; j < 4; ++j) {
            const int c = 4 * lane + 256 * j;
            const f32x4 gg = *(const f32x4*)(g + c), bb = *(const f32x4*)(b + c);
#pragma unroll
            for (int r = 0; r < 2; ++r) {
                const f32x4 o = v[r][j] * rstd[r] * gg + bb;
                uint2 w; w.x = cvtpk(o[0], o[1]); w.y = cvtpk(o[2], o[3]);
                if (ST) { *(f32x4*)(p + r * DM + c) = o; *(uint2*)(hb + (size_t)(row + r) * DM + c) = w; } else asm volatile("" :: "v"(w.x), "v"(w.y), "v"(o[0]), "v"(o[1]), "v"(o[2]), "v"(o[3]));
            }
        }
    }
}

__device__ __forceinline__ void rwkv_naive_chain(int chain, int lane, LAS float* sm, const bf16_t* __restrict__ proj, const float* __restrict__ mix, const float* __restrict__ w0, const float* __restrict__ w2,
                                                 const float* __restrict__ a0, const float* __restrict__ a2, const float* __restrict__ g2, const float* __restrict__ k_k,
                                                 const float* __restrict__ k_a, const float* __restrict__ r_k, const float* __restrict__ ln_g, const float* __restrict__ ln_b, bf16_t* __restrict__ ymix) {
    LAS float* s_w2 = sm; LAS float* s_a2 = sm + 4096; LAS float* s_g2 = sm + 8192; LAS float* s_tw = sm + 16384; LAS float* s_al = s_tw + 64; LAS float* s_sg = s_tw + 128;
    LAS float* s_w = s_tw + 256; LAS float* s_k = s_tw + 320; LAS float* s_a = s_tw + 384; LAS float* s_b = s_tw + 448; LAS float* s_r = s_tw + 512;
    const int b = chain >> 3, h = chain & 7, c = h * 64 + lane;
    for (int l = 0; l < 64; ++l) { s_w2[l * 64 + lane] = w2[l * 512 + c]; s_a2[l * 64 + lane] = a2[l * 512 + c]; }
    for (int l = 0; l < 128; ++l) s_g2[l * 64 + lane] = g2[l * 512 + c];
    const float mr = mix[c], mk = mix[512 + c], mv = mix[1024 + c], mw = mix[1536 + lane], ma = mix[1600 + lane], mg0 = mix[1664 + lane], mg1 = mix[1728 + lane];
    const float w0c = w0[c], a0c = a0[c], kkc = k_k[c], kac = k_a[c], rkc = r_k[c], lgc = ln_g[c], lbc = ln_b[c];
    float S[64];
#pragma unroll
    for (int j = 0; j < 64; ++j) S[j] = 0.f;
    float pr = 0.f, pk = 0.f, pv = 0.f, pw = 0.f, pa = 0.f, pg0 = 0.f, pg1 = 0.f;
    WSYNC();
    for (int t = 0; t < SEQ; ++t) {
        const bf16_t* row = proj + (size_t)(b * SEQ + t) * L0P;
        const float cr = bf2f(row[c]), ck = bf2f(row[512 + c]), cv = bf2f(row[1024 + c]), cw = bf2f(row[1536 + lane]), ca = bf2f(row[1600 + lane]),
                    cg0 = bf2f(row[1664 + lane]), cg1 = bf2f(row[1728 + lane]);
        const float r_s = cr + (pr - cr) * mr, k_s = ck + (pk - ck) * mk, v_s = cv + (pv - cv) * mv;
        const float wl = cw + (pw - cw) * mw, al = ca + (pa - ca) * ma, g0 = cg0 + (pg0 - cg0) * mg0, g1 = cg1 + (pg1 - cg1) * mg1;
        pr = cr; pk = ck; pv = cv; pw = cw; pa = ca; pg0 = cg0; pg1 = cg1;
        s_tw[lane] = tanhf(wl); s_al[lane] = al; s_sg[lane] = sigmoidf_(g0); s_sg[64 + lane] = sigmoidf_(g1);
        WSYNC();
        float wsum = w0c, asum = a0c, gsum = 0.f;
#pragma unroll 2
        for (int l = 0; l < 64; ++l) { wsum += s_tw[l] * s_w2[l * 64 + lane]; asum += s_al[l] * s_a2[l * 64 + lane]; }
#pragma unroll 2
        for (int l = 0; l < 128; ++l) gsum += s_sg[l] * s_g2[l * 64 + lane];
        const float log_w = -softplusf_(-wsum) - 0.5f;
        const float dec = expf(-expf(log_w));
        const float a = sigmoidf_(asum);
        float kkv = k_s * kkc;
        const float nrm = sqrtf(wave_sum(kkv * kkv));
        kkv = kkv / fmaxf(nrm, 1e-12f);
        const float k2 = k_s * (1.f + (a - 1.f) * kac);
        const float bonus_s = wave_sum(r_s * k2 * rkc);
        s_w[lane] = dec; s_k[lane] = k2; s_a[lane] = -kkv; s_b[lane] = kkv * a; s_r[lane] = r_s;
        WSYNC();
        float sa = 0.f;
#pragma unroll
        for (int j = 0; j < 64; ++j) sa += S[j] * s_a[j];
        float y = 0.f;
#pragma unroll
        for (int j = 0; j < 64; ++j) { S[j] = S[j] * s_w[j] + sa * s_b[j] + v_s * s_k[j]; y += S[j] * s_r[j]; }
        const float mu = wave_sum(y) * (1.f / 64.f);
        const float d = y - mu;
        const float var = wave_sum(d * d) * (1.f / 64.f);
        const float yn = d * (1.0f / sqrtf(var + 64e-5f)) * lgc + lbc;
        const float o = (yn + bonus_s * v_s) * gsum;
        ymix[(size_t)(b * SEQ + t) * DM + c] = (bf16_t)f2bf(o);
        WSYNC();
    }
}

__device__ __forceinline__ void ssm_conv_all(const bf16_t* __restrict__ proj, const float* __restrict__ cw, const float* __restrict__ cb, const float* __restrict__ dtb,
                                             bf16_t* __restrict__ xbc, float* __restrict__ dt, int gtid, int NT) {
    for (size_t i = gtid; i < (size_t)M * 1024; i += NT) {
        const int m = (int)(i >> 10), c = (int)(i & 1023), t = m & (SEQ - 1);
        float acc = cb[c];
#pragma unroll
        for (int k = 0; k < 4; ++k) { const int tt = t - 3 + k; if (tt >= 0) acc += cw[k * 1024 + c] * bf2f(proj[(size_t)(m - 3 + k) * L0P + 2304 + c]); }
        xbc[i] = (bf16_t)f2bf(siluf_(acc));
    }
    for (int i = gtid; i < M * 8; i += NT) dt[i] = softplusf_(bf2f(proj[(size_t)(i >> 3) * L0P + 3328 + (i & 7)]) + dtb[i & 7]);
}
__device__ __forceinline__ void ssd_naive_task(int task, int lane, const bf16_t* __restrict__ xbc, const float* __restrict__ dt, const float* __restrict__ a_log, const float* __restrict__ dsk, float* __restrict__ yssm) {
    const int chain = task >> 2, q = task & 3, b = chain >> 3, h = chain & 7, g = h >> 2, p = q * 16 + (lane >> 2), nq = lane & 3;
    const float A = -expf(a_log[h]), D = dsk[h];
    float st[32];
#pragma unroll
    for (int n = 0; n < 32; ++n) st[n] = 0.f;
    for (int t = 0; t < SEQ; ++t) {
        const size_t m = (size_t)b * SEQ + t;
        const float dtv = dt[m * 8 + h], dA = expf(dtv * A);
        const float x = bf2f(xbc[m * 1024 + h * 64 + p]), xdt = x * dtv;
        const bf16_t* Bp = xbc + m * 1024 + 512 + g * 128 + nq * 32;
        const bf16_t* Cp = xbc + m * 1024 + 768 + g * 128 + nq * 32;
        float yp = 0.f;
#pragma unroll
        for (int n = 0; n < 32; ++n) { st[n] = st[n] * dA + xdt * bf2f(Bp[n]); yp += st[n] * bf2f(Cp[n]); }
        yp += __shfl_xor(yp, 1); yp += __shfl_xor(yp, 2);
        if (nq == 0) yssm[m * 512 + h * 64 + p] = yp + D * x;
    }
}
template <bool ST = true> __device__ __forceinline__ void ssm_gate_norm_all(const bf16_t* __restrict__ yssm, const bf16_t* __restrict__ proj, const float* __restrict__ ng, bf16_t* __restrict__ ymix, int wv0, int wvend, int lane) {
#pragma unroll 2
    for (int wv = wv0; wv < wvend; wv += NWAVES) {
        const int m = wv >> 1, g = wv & 1;
        float u[4], q = 0.f;
#pragma unroll
        for (int j = 0; j < 4; ++j) { const int c = g * 256 + j * 64 + lane; const float z = bf2f(proj[(size_t)m * L0P + 1792 + c]); u[j] = bf2f(yssm[(size_t)m * 512 + c]) * siluf_(z); q += u[j] * u[j]; }
        const float rs = 1.0f / sqrtf(wave_sum(q) * (1.f / 256.f) + 1e-5f);
#pragma unroll
        for (int j = 0; j < 4; ++j) { const int c = g * 256 + j * 64 + lane; const float o_ = u[j] * rs * ng[c]; if (ST) ymix[(size_t)m * DM + 512 + c] = (bf16_t)f2bf(o_); else asm volatile("" :: "v"(o_)); }
    }
}
template <bool ST = true> __device__ __forceinline__ void ffn_act_all(bf16_t* gu, const float* __restrict__ cw, const float* __restrict__ cb, int gtid, int NT) {
    constexpr int NCH = DFF / 8, NSTRIP = M / 32;
    for (int task = gtid; task < NSTRIP * NCH; task += NT) {
        const int strip = task / NCH, q = task - strip * NCH, c0 = q * 8, m0 = strip * 32;
        float w0[8], w1[8], w2[8], bb[8], g2[8], g1[8];
#pragma unroll
        for (int j = 0; j < 8; j += 4) { const f32x4 a = *(const f32x4*)(cw + c0 + j), b = *(const f32x4*)(cw + DFF + c0 + j), c = *(const f32x4*)(cw + 2 * DFF + c0 + j), d = *(const f32x4*)(cb + c0 + j);
#pragma unroll
            for (int k = 0; k < 4; ++k) { w0[j + k] = a[k]; w1[j + k] = b[k]; w2[j + k] = c[k]; bb[j + k] = d[k]; } }
        bf16_t* base = gu + (size_t)m0 * (2 * DFF) + c0;
        if ((m0 & (SEQ - 1)) != 0) { const v4u a = *(const v4u*)(base - 2 * (2 * DFF)), b = *(const v4u*)(base - (2 * DFF));
            g2[0] = bflo(a.x); g2[1] = bfhi(a.x); g2[2] = bflo(a.y); g2[3] = bfhi(a.y); g2[4] = bflo(a.z); g2[5] = bfhi(a.z); g2[6] = bflo(a.w); g2[7] = bfhi(a.w);
            g1[0] = bflo(b.x); g1[1] = bfhi(b.x); g1[2] = bflo(b.y); g1[3] = bfhi(b.y); g1[4] = bflo(b.z); g1[5] = bfhi(b.z); g1[6] = bflo(b.w); g1[7] = bfhi(b.w); }
        else {
#pragma unroll
            for (int j = 0; j < 8; ++j) { g2[j] = 0.f; g1[j] = 0.f; } }
#pragma unroll 4
        for (int r = 0; r < 32; ++r) {
            const v4u gv = *(const v4u*)(base + (size_t)r * (2 * DFF)), uv = *(const v4u*)(base + (size_t)r * (2 * DFF) + DFF);
            const unsigned gw_[4] = {gv.x, gv.y, gv.z, gv.w}, uw_[4] = {uv.x, uv.y, uv.z, uv.w};
            unsigned ow[4];
#pragma unroll
            for (int k = 0; k < 4; ++k) {
                const float ga = bflo(gw_[k]), gb = bfhi(gw_[k]);
                const float ya = bb[2 * k] + w0[2 * k] * g2[2 * k] + w1[2 * k] * g1[2 * k] + w2[2 * k] * ga;
                const float yb = bb[2 * k + 1] + w0[2 * k + 1] * g2[2 * k + 1] + w1[2 * k + 1] * g1[2 * k + 1] + w2[2 * k + 1] * gb;
                g2[2 * k] = g1[2 * k]; g1[2 * k] = ga; g2[2 * k + 1] = g1[2 * k + 1]; g1[2 * k + 1] = gb;
                ow[k] = cvtpk(ya / (1.f + __expf(-ya)) * bflo(uw_[k]), yb / (1.f + __expf(-yb)) * bfhi(uw_[k]));
            }
            if (ST) *(v4u*)(base + (size_t)r * (2 * DFF) + DFF) = (v4u){ow[0], ow[1], ow[2], ow[3]}; else asm volatile("" :: "v"(ow[0]), "v"(ow[1]), "v"(ow[2]), "v"(ow[3]));
        }
    }
}
template <bool ST = true> __device__ __forceinline__ void mla_prep_all(const bf16_t* __restrict__ proj1, const int* __restrict__ pos, float* __restrict__ rs, bf16_t* __restrict__ kpe, float* __restrict__ cstab, int gw, int NGW, int lane) {
    for (int m = gw; m < M; m += NGW) {
        const bf16_t* row = proj1 + (size_t)m * L1P;
        float q = 0.f;
#pragma unroll
        for (int j = 0; j < 4; ++j) { const float v = bf2f(row[1536 + j * 64 + lane]); q += v * v; }
        q = wave_sum(q);
        float k = 0.f;
#pragma unroll
        for (int j = 0; j < 2; ++j) { const float v = bf2f(row[1792 + j * 64 + lane]); k += v * v; }
        k = wave_sum(k);
        if (ST && lane == 0) { rs[(size_t)m * 2] = 1.0f / sqrtf(q * (1.f / 256.f) + 1e-6f); rs[(size_t)m * 2 + 1] = 1.0f / sqrtf(k * (1.f / 128.f) + 1e-6f); }
        if (lane < 16) {
            const double inv = pow(10000.0, -(double)(2 * lane) / 32.0);
            const double ang = (double)pos[m] * inv;
            const float cs = (float)cos(ang), sn = (float)sin(ang);
            if (ST) { cstab[(size_t)m * 32 + lane] = cs; cstab[(size_t)m * 32 + 16 + lane] = sn; }
            const float x1 = bf2f(row[1920 + lane]), x2 = bf2f(row[1936 + lane]);
            const bf16_t r1_ = (bf16_t)f2bf(x1 * cs - x2 * sn), r2_ = (bf16_t)f2bf(x2 * cs + x1 * sn);
            if (ST) { kpe[(size_t)m * 32 + lane] = r1_; kpe[(size_t)m * 32 + 16 + lane] = r2_; } else asm volatile("" :: "v"((unsigned)r1_), "v"((unsigned)r2_), "v"(q), "v"(k));
        }
    }
}
template <bool ST = true> __device__ __forceinline__ void rope_q_all(bf16_t* qm, const float* __restrict__ cstab, int gtid, int NT) {
    for (int i = gtid; i < M * 16; i += NT) {
        const int m = i >> 4, h = (i >> 1) & 7, k0 = (i & 1) * 8;
        bf16_t* p = qm + (size_t)m * 768 + h * 96 + 64 + k0;
        const v4u a = *(const v4u*)p, b = *(const v4u*)(p + 16);
        const f32x4 c0 = *(const f32x4*)(cstab + (size_t)m * 32 + k0), c1 = *(const f32x4*)(cstab + (size_t)m * 32 + k0 + 4), s0 = *(const f32x4*)(cstab + (size_t)m * 32 + 16 + k0), s1 = *(const f32x4*)(cstab + (size_t)m * 32 + 16 + k0 + 4);
        const unsigned au[4] = {a.x, a.y, a.z, a.w}, bu[4] = {b.x, b.y, b.z, b.w};
        const float cs[8] = {c0[0], c0[1], c0[2], c0[3], c1[0], c1[1], c1[2], c1[3]}, sn[8] = {s0[0], s0[1], s0[2], s0[3], s1[0], s1[1], s1[2], s1[3]};
        unsigned o1[4], o2[4];
#pragma unroll
        for (int q = 0; q < 4; ++q) { const float x1a = bflo(au[q]), x1b = bfhi(au[q]), x2a = bflo(bu[q]), x2b = bfhi(bu[q]);
            o1[q] = cvtpk(x1a * cs[2 * q] - x2a * sn[2 * q], x1b * cs[2 * q + 1] - x2b * sn[2 * q + 1]);
            o2[q] = cvtpk(x2a * cs[2 * q] + x1a * sn[2 * q], x2b * cs[2 * q + 1] + x1b * sn[2 * q + 1]); }
        if (ST) { *(v4u*)p = (v4u){o1[0], o1[1], o1[2], o1[3]}; *(v4u*)(p + 16) = (v4u){o2[0], o2[1], o2[2], o2[3]}; }
    }
}
__device__ __forceinline__ void sb_naive_task(int qblk, int bh, int lane, const bf16_t* __restrict__ proj1, bf16_t* __restrict__ ymix) {
    const int b = bh >> 3, h = bh & 7, t = qblk * 64 + lane;
    const size_t mrow = (size_t)b * SEQ;
    float q[64], o[64];
#pragma unroll
    for (int d = 0; d < 64; ++d) { q[d] = bf2f(proj1[(mrow + t) * L1P + h * 64 + d]) * 0.125f; o[d] = 0.f; }
    float cum = 0.f;
    const int smax = qblk * 64 + 63;
    for (int s = smax - 1; s >= 0; --s) {
        const bf16_t* kr = proj1 + (mrow + s) * L1P + 512 + h * 64;
        const bf16_t* vr = proj1 + (mrow + s) * L1P + 1024 + h * 64;
        float z = 0.f;
#pragma unroll
        for (int d = 0; d < 64; ++d) z += q[d] * bf2f(kr[d]);
        if (s < t) {
            const float lsp = -softplusf_(-z);
            const float lsn = -softplusf_(z);
            const float att = expf(lsp + cum);
            cum += lsn;
#pragma unroll
            for (int d = 0; d < 64; ++d) o[d] += att * bf2f(vr[d]);
        }
    }
#pragma unroll
    for (int d = 0; d < 64; ++d) ymix[(mrow + t) * DM + h * 64 + d] = (bf16_t)f2bf(o[d]);
}
__device__ __forceinline__ void mla_naive_task(int qblk, int bh, int lane, const bf16_t* __restrict__ qm, const bf16_t* __restrict__ kvm, const bf16_t* __restrict__ kpe, bf16_t* __restrict__ ymix) {
    const int b = bh >> 3, h = bh & 7, t = qblk * 64 + lane;
    const size_t mrow = (size_t)b * SEQ;
    const float scale = 0.10206207261596577f;
    float q[96], o[64];
#pragma unroll
    for (int d = 0; d < 96; ++d) q[d] = bf2f(qm[(mrow + t) * 768 + h * 96 + d]) * scale;
#pragma unroll
    for (int d = 0; d < 64; ++d) o[d] = 0.f;
    float mx = -1e30f, l = 0.f;
    const int smax = qblk * 64 + 63;
    for (int s = 0; s <= smax; ++s) {
        const bf16_t* kr = kvm + (mrow + s) * 1024 + h * 128;
        const bf16_t* pr = kpe + (mrow + s) * 32;
        float z = 0.f;
#pragma unroll
        for (int d = 0; d < 64; ++d) z += q[d] * bf2f(kr[d]);
#pragma unroll
        for (int d = 0; d < 32; ++d) z += q[64 + d] * bf2f(pr[d]);
        if (s <= t) {
            const float mn = fmaxf(mx, z), f = expf(mx - mn), pz = expf(z - mn);
            l = l * f + pz; mx = mn;
#pragma unroll
            for (int d = 0; d < 64; ++d) o[d] = o[d] * f + pz * bf2f(kr[64 + d]);
        }
    }
    const float il = 1.f / l;
#pragma unroll
    for (int d = 0; d < 64; ++d) ymix[(mrow + t) * DM + 512 + h * 64 + d] = (bf16_t)f2bf(o[d] * il);
}


__device__ __forceinline__ int crow(int r, int hi) { return (r & 3) + 8 * (r >> 2) + 4 * hi; }
#define MFMA32(a, b, c) __builtin_amdgcn_mfma_f32_32x32x16_bf16((a), (b), (c), 0, 0, 0)
constexpr int STG_PITCH = 72;
__device__ __forceinline__ void transpose_tile64(const bf16_t* __restrict__ src, int sp, bf16_t* __restrict__ dst, int dp, LAS bf16_t* scr, int lane) {
#pragma unroll
    for (int i = 0; i < 8; ++i) { const int row = i * 8 + (lane >> 3), ch = lane & 7; const v4u v = *(const v4u*)(src + (size_t)row * sp + ch * 8); *(LAS v4u*)(scr + row * STG_PITCH + ch * 8) = v; }
    WSYNC();
#pragma unroll
    for (int i = 0; i < 8; ++i) { const int d = i * 8 + (lane >> 3), tc = lane & 7; const LAS bf16_t* p = scr + (tc * 8) * STG_PITCH + d;
        v4u o; o.x = (unsigned)p[0] | ((unsigned)p[STG_PITCH] << 16); o.y = (unsigned)p[2 * STG_PITCH] | ((unsigned)p[3 * STG_PITCH] << 16);
        o.z = (unsigned)p[4 * STG_PITCH] | ((unsigned)p[5 * STG_PITCH] << 16); o.w = (unsigned)p[6 * STG_PITCH] | ((unsigned)p[7 * STG_PITCH] << 16);
        *(v4u*)(dst + (size_t)d * dp + tc * 8) = o; }
    WSYNC();
}
__device__ __forceinline__ void store_OT(const f32x16 (&o)[2], float sc, LAS bf16_t* stg, bf16_t* __restrict__ dst, int lane) {
    const int l31 = lane & 31, hi = lane >> 5;
#pragma unroll
    for (int dt = 0; dt < 2; ++dt)
#pragma unroll
        for (int r = 0; r < 16; ++r) stg[l31 * STG_PITCH + 32 * dt + crow(r, hi)] = (bf16_t)f2bf(o[dt][r] * sc);
    WSYNC();
#pragma unroll
    for (int i = 0; i < 4; ++i) { const int row = i * 8 + (lane >> 3), ch = lane & 7; const v4u v = *(const LAS v4u*)(stg + row * STG_PITCH + ch * 8); *(v4u*)(dst + (size_t)row * DM + ch * 8) = v; }
    WSYNC();
}
__device__ __forceinline__ float softplus_fast(float z) { return fmaxf(z, 0.f) + __logf(1.f + __expf(-fabsf(z))); }

__device__ __forceinline__ void sb_task(int bh, int qblk, int lane, const bf16_t* __restrict__ P1, const bf16_t* __restrict__ VT, bf16_t* __restrict__ ymix, LAS bf16_t* stg) {
    const int b = bh >> 3, h = bh & 7, l31 = lane & 31, hi = lane >> 5, q0 = qblk * 32, t = q0 + l31;
    const size_t rowb = (size_t)b * SEQ;
    const bf16_t* Qp = P1 + (rowb + q0 + l31) * L1P + h * 64 + 8 * hi;
    bf16x8 qf[4];
#pragma unroll
    for (int kk = 0; kk < 4; ++kk) qf[kk] = *(const bf16x8*)(Qp + 16 * kk);
    const bf16_t* Kp = P1 + (rowb + l31) * L1P + 512 + h * 64 + 8 * hi;
    const bf16_t* Vp = VT + ((size_t)bh * 64 + l31) * SEQ + 4 * hi;
    f32x16 o[2];
#pragma unroll
    for (int r = 0; r < 16; ++r) { o[0][r] = 0.f; o[1][r] = 0.f; }
    float cum = 0.f;
    bf16x8 kf[4]; u32x2 va[2][2][2];
#define SB_LOAD(S0, KF, VA) do { _Pragma("unroll") for (int kk = 0; kk < 4; ++kk) KF[kk] = *(const bf16x8*)(Kp + (size_t)(S0) * L1P + 16 * kk); \
        _Pragma("unroll") for (int dt = 0; dt < 2; ++dt) _Pragma("unroll") for (int ks = 0; ks < 2; ++ks) { VA[dt][ks][0] = *(const u32x2*)(Vp + (size_t)dt * 32 * SEQ + (S0) + 16 * ks); VA[dt][ks][1] = *(const u32x2*)(Vp + (size_t)dt * 32 * SEQ + (S0) + 16 * ks + 8); } } while (0)
    SB_LOAD(q0, kf, va);
    for (int s0 = q0; s0 >= 0; s0 -= 32) {
        bf16x8 kn[4]; u32x2 vn[2][2][2];
        const int sn = (s0 >= 32) ? s0 - 32 : 0;
        SB_LOAD(sn, kn, vn);
        f32x16 acc;
#pragma unroll
        for (int r = 0; r < 16; ++r) acc[r] = 0.f;
#pragma unroll
        for (int kk = 0; kk < 4; ++kk) acc = MFMA32(kf[kk], qf[kk], acc);
        const bool diag = (s0 == q0);
        float lb[16], lk[16];
#pragma unroll
        for (int r = 0; r < 16; ++r) { const float z = acc[r] * 0.125f; const float sp = softplus_fast(z); float b_ = z - sp, k_ = -sp;
            if (diag) { const bool valid = (s0 + crow(r, hi)) < t; b_ = valid ? b_ : -1e30f; k_ = valid ? k_ : 0.f; }
            lb[r] = b_; lk[r] = k_; }
        float e[16], T[4], U[4];
#pragma unroll
        for (int i = 0; i < 4; ++i) { e[4 * i + 3] = 0.f; e[4 * i + 2] = lk[4 * i + 3]; e[4 * i + 1] = e[4 * i + 2] + lk[4 * i + 2]; e[4 * i] = e[4 * i + 1] + lk[4 * i + 1]; T[i] = e[4 * i] + lk[4 * i]; }
#pragma unroll
        for (int i = 0; i < 4; ++i) U[i] = __shfl_xor(T[i], 32);
        float off[4];
        { const float st2 = T[3], st1 = st2 + T[2], st0 = st1 + T[1]; const float su2 = U[3], su1 = su2 + U[2], su0 = su1 + U[1];
          const float x0 = hi ? 0.f : U[0], x1 = hi ? 0.f : U[1], x2 = hi ? 0.f : U[2], x3 = hi ? 0.f : U[3];
          off[3] = x3; off[2] = st2 + su2 + x2; off[1] = st1 + su1 + x1; off[0] = st0 + su0 + x0;
          const float total = st0 + T[0] + su0 + U[0];
#pragma unroll
          for (int r = 0; r < 16; ++r) acc[r] = __expf(lb[r] + (cum + off[r >> 2] + e[r]));
          cum += total; }
        bf16x8 pf[2];
#pragma unroll
        for (int ks = 0; ks < 2; ++ks) { v4u w; w.x = cvtpk(acc[8 * ks], acc[8 * ks + 1]); w.y = cvtpk(acc[8 * ks + 2], acc[8 * ks + 3]); w.z = cvtpk(acc[8 * ks + 4], acc[8 * ks + 5]); w.w = cvtpk(acc[8 * ks + 6], acc[8 * ks + 7]); pf[ks] = __builtin_bit_cast(bf16x8, w); }
#pragma unroll
        for (int dt = 0; dt < 2; ++dt)
#pragma unroll
            for (int ks = 0; ks < 2; ++ks) { v4u a; a.x = va[dt][ks][0].x; a.y = va[dt][ks][0].y; a.z = va[dt][ks][1].x; a.w = va[dt][ks][1].y; o[dt] = MFMA32(__builtin_bit_cast(bf16x8, a), pf[ks], o[dt]); }
        if (__all(cum < -110.f)) break;
#pragma unroll
        for (int kk = 0; kk < 4; ++kk) kf[kk] = kn[kk];
#pragma unroll
        for (int dt = 0; dt < 2; ++dt)
#pragma unroll
            for (int ks = 0; ks < 2; ++ks) { va[dt][ks][0] = vn[dt][ks][0]; va[dt][ks][1] = vn[dt][ks][1]; }
    }
#undef SB_LOAD
    store_OT(o, 1.0f, stg, ymix + (rowb + q0) * DM + h * 64, lane);
}
__device__ __forceinline__ void mla_task(int bh, int qblk, int lane, const bf16_t* __restrict__ QM, const bf16_t* __restrict__ KVM, const bf16_t* __restrict__ KPE, const bf16_t* __restrict__ VT,
                                         bf16_t* __restrict__ ymix, LAS bf16_t* stg) {
    const int b = bh >> 3, h = bh & 7, l31 = lane & 31, hi = lane >> 5, q0 = qblk * 32, t = q0 + l31;
    const size_t rowb = (size_t)b * SEQ;
    const bf16_t* Qp = QM + (rowb + q0 + l31) * 768 + h * 96 + 8 * hi;
    bf16x8 qf[6];
#pragma unroll
    for (int kk = 0; kk < 6; ++kk) qf[kk] = *(const bf16x8*)(Qp + 16 * kk);
    const bf16_t* Kn = KVM + (rowb + l31) * 1024 + h * 128 + 8 * hi;
    const bf16_t* Kr = KPE + (rowb + l31) * 32 + 8 * hi;
    const bf16_t* Vp = VT + ((size_t)bh * 64 + l31) * SEQ + 4 * hi;
    const float sc2 = 0.10206207261596577f * 1.4426950408889634f;
    f32x16 o[2];
#pragma unroll
    for (int r = 0; r < 16; ++r) { o[0][r] = 0.f; o[1][r] = 0.f; }
    float mrun = -1e30f, lsum = 0.f;
    bf16x8 kf[6]; u32x2 va[2][2][2];
#define ML_LOAD(S0, KF, VA) do { _Pragma("unroll") for (int kk = 0; kk < 4; ++kk) KF[kk] = *(const bf16x8*)(Kn + (size_t)(S0) * 1024 + 16 * kk); \
        _Pragma("unroll") for (int kk = 0; kk < 2; ++kk) KF[4 + kk] = *(const bf16x8*)(Kr + (size_t)(S0) * 32 + 16 * kk); \
        _Pragma("unroll") for (int dt = 0; dt < 2; ++dt) _Pragma("unroll") for (int ks = 0; ks < 2; ++ks) { VA[dt][ks][0] = *(const u32x2*)(Vp + (size_t)dt * 32 * SEQ + (S0) + 16 * ks); VA[dt][ks][1] = *(const u32x2*)(Vp + (size_t)dt * 32 * SEQ + (S0) + 16 * ks + 8); } } while (0)
    ML_LOAD(0, kf, va);
    for (int s0 = 0; s0 <= q0; s0 += 32) {
        bf16x8 kn[6]; u32x2 vn[2][2][2];
        const int sn = (s0 + 32 <= q0) ? s0 + 32 : s0;
        ML_LOAD(sn, kn, vn);
        f32x16 acc;
#pragma unroll
        for (int r = 0; r < 16; ++r) acc[r] = 0.f;
#pragma unroll
        for (int kk = 0; kk < 6; ++kk) acc = MFMA32(kf[kk], qf[kk], acc);
        const bool diag = (s0 == q0);
        float tmax = -1e30f;
#pragma unroll
        for (int r = 0; r < 16; ++r) { float z = acc[r] * sc2; if (diag && (s0 + crow(r, hi)) > t) z = -1e30f; acc[r] = z; tmax = fmaxf(tmax, z); }
        tmax = fmaxf(tmax, __shfl_xor(tmax, 32));
        const float mn = fmaxf(mrun, tmax), alpha = exp2f(mrun - mn); mrun = mn;
        float ps = 0.f;
#pragma unroll
        for (int r = 0; r < 16; ++r) { acc[r] = exp2f(acc[r] - mn); ps += acc[r]; }
        lsum = lsum * alpha + ps;
#pragma unroll
        for (int r = 0; r < 16; ++r) { o[0][r] *= alpha; o[1][r] *= alpha; }
        bf16x8 pf[2];
#pragma unroll
        for (int ks = 0; ks < 2; ++ks) { v4u w; w.x = cvtpk(acc[8 * ks], acc[8 * ks + 1]); w.y = cvtpk(acc[8 * ks + 2], acc[8 * ks + 3]); w.z = cvtpk(acc[8 * ks + 4], acc[8 * ks + 5]); w.w = cvtpk(acc[8 * ks + 6], acc[8 * ks + 7]); pf[ks] = __builtin_bit_cast(bf16x8, w); }
#pragma unroll
        for (int dt = 0; dt < 2; ++dt)
#pragma unroll
            for (int ks = 0; ks < 2; ++ks) { v4u a; a.x = va[dt][ks][0].x; a.y = va[dt][ks][0].y; a.z = va[dt][ks][1].x; a.w = va[dt][ks][1].y; o[dt] = MFMA32(__builtin_bit_cast(bf16x8, a), pf[ks], o[dt]); }
#pragma unroll
        for (int kk = 0; kk < 6; ++kk) kf[kk] = kn[kk];
#pragma unroll
        for (int dt = 0; dt < 2; ++dt)
#pragma unroll
            for (int ks = 0; ks < 2; ++ks) { va[dt][ks][0] = vn[dt][ks][0]; va[dt][ks][1] = vn[dt][ks][1]; }
    }
#undef ML_LOAD
    lsum += __shfl_xor(lsum, 32);
    store_OT(o, 1.0f / lsum, stg, ymix + (rowb + q0) * DM + 512 + h * 64, lane);
}


constexpr int MLK_PITCH = 104, MLV_PITCH = 68, MLK_BYTES = 64 * MLK_PITCH * 2, MLV_BYTES = 64 * MLV_PITCH * 2, ML_STAGE = MLK_BYTES + MLV_BYTES;
__device__ __forceinline__ void mla_block(int bh, int sb, int tid, int lane, int wave, LAS unsigned char* lds, const bf16_t* __restrict__ QM, const bf16_t* __restrict__ KVM, const bf16_t* __restrict__ KPE,
                                          const bf16_t* __restrict__ VT, bf16_t* __restrict__ ymix) {
    const int b = bh >> 3, h = bh & 7, l31 = lane & 31, hi = lane >> 5, q0 = 256 * sb + 32 * wave, t = q0 + l31;
    const size_t rowb = (size_t)b * SEQ;
    const int nsteps = 4 * sb + 4;
    bf16x8 qf[6];
    { const bf16_t* Qp = QM + (rowb + q0 + l31) * 768 + h * 96 + 8 * hi;
#pragma unroll
      for (int kk = 0; kk < 6; ++kk) qf[kk] = *(const bf16x8*)(Qp + 16 * kk); }
    const float sc2 = 0.10206207261596577f * 1.4426950408889634f;
    f32x16 o[2];
#pragma unroll
    for (int r = 0; r < 16; ++r) { o[0][r] = 0.f; o[1][r] = 0.f; }
    float mrun = -1e30f, lsum = 0.f;
    const bf16_t* gKn = KVM + (rowb + (tid >> 3)) * 1024 + h * 128 + (tid & 7) * 8;
    const bf16_t* gKr = KPE + (rowb + ((tid & 255) >> 2)) * 32 + (tid & 3) * 8;
    const bf16_t* gVt = VT + ((size_t)bh * 64 + (tid >> 3)) * SEQ + (tid & 7) * 8;
    const int lKn = (tid >> 3) * (MLK_PITCH * 2) + (tid & 7) * 16, lKr = ((tid & 255) >> 2) * (MLK_PITCH * 2) + 128 + (tid & 3) * 16, lVt = MLK_BYTES + (tid >> 3) * (MLV_PITCH * 2) + (tid & 7) * 16;
    v4u rk, rr, rv;
    rk = *(const v4u*)gKn; rr = *(const v4u*)gKr; rv = *(const v4u*)gVt;
    *(LAS v4u*)(lds + lKn) = rk; if (tid < 256) *(LAS v4u*)(lds + lKr) = rr; *(LAS u32x2*)(lds + lVt) = (u32x2){rv.x, rv.y}; *(LAS u32x2*)(lds + lVt + 8) = (u32x2){rv.z, rv.w};
    __syncthreads();
#pragma unroll 1
    for (int step = 0; step < nsteps; ++step) {
        const int nx = (step + 1 < nsteps) ? step + 1 : step;
        rk = *(const v4u*)(gKn + (size_t)nx * 64 * 1024); rr = *(const v4u*)(gKr + (size_t)nx * 64 * 32); rv = *(const v4u*)(gVt + nx * 64);
        const LAS unsigned char* Kb = lds + (step & 1) * ML_STAGE;
        const LAS unsigned char* Vb = Kb + MLK_BYTES;
#pragma unroll
        for (int sub = 0; sub < 2; ++sub) {
            const int s0 = 64 * step + 32 * sub;
            if (s0 <= q0) {
                f32x16 acc;
#pragma unroll
                for (int r = 0; r < 16; ++r) acc[r] = 0.f;
#pragma unroll
                for (int kk = 0; kk < 6; ++kk) { const bf16x8 kf = *(const LAS bf16x8*)(Kb + (32 * sub + l31) * (MLK_PITCH * 2) + (16 * kk + 8 * hi) * 2); acc = MFMA32(kf, qf[kk], acc); }
                const bool diag = (s0 == q0);
                float tmax = -1e30f;
#pragma unroll
                for (int r = 0; r < 16; ++r) { float z = acc[r] * sc2; if (diag && (s0 + crow(r, hi)) > t) z = -1e30f; acc[r] = z; tmax = fmaxf(tmax, z); }
                tmax = fmaxf(tmax, __shfl_xor(tmax, 32));
                const float mn = fmaxf(mrun, tmax), alpha = __builtin_amdgcn_exp2f(mrun - mn); mrun = mn;
                float ps = 0.f;
#pragma unroll
                for (int r = 0; r < 16; ++r) { acc[r] = __builtin_amdgcn_exp2f(acc[r] - mn); ps += acc[r]; }
                lsum = lsum * alpha + ps;
#pragma unroll
                for (int r = 0; r < 16; ++r) { o[0][r] *= alpha; o[1][r] *= alpha; }
                bf16x8 pf[2];
#pragma unroll
                for (int ks = 0; ks < 2; ++ks) { v4u w; w.x = cvtpk(acc[8 * ks], acc[8 * ks + 1]); w.y = cvtpk(acc[8 * ks + 2], acc[8 * ks + 3]); w.z = cvtpk(acc[8 * ks + 4], acc[8 * ks + 5]); w.w = cvtpk(acc[8 * ks + 6], acc[8 * ks + 7]); pf[ks] = __builtin_bit_cast(bf16x8, w); }
#pragma unroll
                for (int dt = 0; dt < 2; ++dt)
#pragma unroll
                    for (int ks = 0; ks < 2; ++ks) { const LAS unsigned char* vp = Vb + (32 * dt + l31) * (MLV_PITCH * 2) + (32 * sub + 16 * ks + 4 * hi) * 2;
                        const u32x2 x0 = *(const LAS u32x2*)vp, x1 = *(const LAS u32x2*)(vp + 16);
                        v4u a; a.x = x0.x; a.y = x0.y; a.z = x1.x; a.w = x1.y; o[dt] = MFMA32(__builtin_bit_cast(bf16x8, a), pf[ks], o[dt]); }
            }
        }
        LAS unsigned char* nb = lds + ((step + 1) & 1) * ML_STAGE;
        *(LAS v4u*)(nb + lKn) = rk; if (tid < 256) *(LAS v4u*)(nb + lKr) = rr; *(LAS u32x2*)(nb + lVt) = (u32x2){rv.x, rv.y}; *(LAS u32x2*)(nb + lVt + 8) = (u32x2){rv.z, rv.w};
        __syncthreads();
    }
    lsum += __shfl_xor(lsum, 32);
    store_OT(o, 1.0f / lsum, (LAS bf16_t*)(lds + 2 * ML_STAGE) + wave * (32 * STG_PITCH), ymix + (rowb + q0) * DM + 512 + h * 64, lane);
    __syncthreads();
}


constexpr int SBK_PITCH = 72, SBK_BYTES = 64 * SBK_PITCH * 2, SB_STAGE = SBK_BYTES + MLV_BYTES;
__device__ __forceinline__ void sb_block(int bh, int sb, int tid, int lane, int wave, LAS unsigned char* lds, const bf16_t* __restrict__ P1, const bf16_t* __restrict__ VT, bf16_t* __restrict__ ymix) {
    const int b = bh >> 3, h = bh & 7, l31 = lane & 31, hi = lane >> 5, q0 = 256 * sb + 32 * wave, t = q0 + l31;
    const size_t rowb = (size_t)b * SEQ;
    bf16x8 qf[4];
    { const bf16_t* Qp = P1 + (rowb + q0 + l31) * L1P + h * 64 + 8 * hi;
#pragma unroll
      for (int kk = 0; kk < 4; ++kk) qf[kk] = *(const bf16x8*)(Qp + 16 * kk); }
    f32x16 o[2];
#pragma unroll
    for (int r = 0; r < 16; ++r) { o[0][r] = 0.f; o[1][r] = 0.f; }
    float cum = 0.f; bool done = false;
    volatile LAS unsigned* flags = (volatile LAS unsigned*)(lds + 2 * SB_STAGE);
    const bf16_t* gK = P1 + (rowb + (tid >> 3)) * L1P + 512 + h * 64 + (tid & 7) * 8;
    const bf16_t* gVt = VT + ((size_t)bh * 64 + (tid >> 3)) * SEQ + (tid & 7) * 8;
    const int lK = (tid >> 3) * (SBK_PITCH * 2) + (tid & 7) * 16, lVt = SBK_BYTES + (tid >> 3) * (MLV_PITCH * 2) + (tid & 7) * 16;
    const int top = 4 * sb + 3;
    v4u rk, rv;
    rk = *(const v4u*)(gK + (size_t)top * 64 * L1P); rv = *(const v4u*)(gVt + top * 64);
    *(LAS v4u*)(lds + lK) = rk; *(LAS u32x2*)(lds + lVt) = (u32x2){rv.x, rv.y}; *(LAS u32x2*)(lds + lVt + 8) = (u32x2){rv.z, rv.w};
    __syncthreads();
#pragma unroll 1
    for (int i = 0; i <= top; ++i) {
        const int step = top - i, nx = (step > 0) ? step - 1 : 0;
        rk = *(const v4u*)(gK + (size_t)nx * 64 * L1P); rv = *(const v4u*)(gVt + nx * 64);
        const LAS unsigned char* Kb = lds + (i & 1) * SB_STAGE;
        const LAS unsigned char* Vb = Kb + SBK_BYTES;
#pragma unroll
        for (int sub = 1; sub >= 0; --sub) {
            const int s0 = 64 * step + 32 * sub;
            if (s0 <= q0 && !done) {
                f32x16 acc;
#pragma unroll
                for (int r = 0; r < 16; ++r) acc[r] = 0.f;
#pragma unroll
                for (int kk = 0; kk < 4; ++kk) { const bf16x8 kf = *(const LAS bf16x8*)(Kb + (32 * sub + l31) * (SBK_PITCH * 2) + (16 * kk + 8 * hi) * 2); acc = MFMA32(kf, qf[kk], acc); }
                const bool diag = (s0 == q0);
                float lb[16], lk[16];
#pragma unroll
                for (int r = 0; r < 16; ++r) { const float z = acc[r] * 0.125f; const float sp = softplus_fast(z); float b_ = z - sp, k_ = -sp;
                    if (diag) { const bool valid = (s0 + crow(r, hi)) < t; b_ = valid ? b_ : -1e30f; k_ = valid ? k_ : 0.f; }
                    lb[r] = b_; lk[r] = k_; }
                float e[16], T[4], U[4];
#pragma unroll
                for (int q = 0; q < 4; ++q) { e[4 * q + 3] = 0.f; e[4 * q + 2] = lk[4 * q + 3]; e[4 * q + 1] = e[4 * q + 2] + lk[4 * q + 2]; e[4 * q] = e[4 * q + 1] + lk[4 * q + 1]; T[q] = e[4 * q] + lk[4 * q]; }
#pragma unroll
                for (int q = 0; q < 4; ++q) U[q] = __shfl_xor(T[q], 32);
                { const float st2 = T[3], st1 = st2 + T[2], st0 = st1 + T[1]; const float su2 = U[3], su1 = su2 + U[2], su0 = su1 + U[1];
                  const float x0 = hi ? 0.f : U[0], x1 = hi ? 0.f : U[1], x2 = hi ? 0.f : U[2], x3 = hi ? 0.f : U[3];
                  const float off[4] = {st0 + su0 + x0, st1 + su1 + x1, st2 + su2 + x2, x3};
                  const float total = st0 + T[0] + su0 + U[0];
#pragma unroll
                  for (int r = 0; r < 16; ++r) acc[r] = __expf(lb[r] + (cum + off[r >> 2] + e[r]));
                  cum += total; }
                bf16x8 pf[2];
#pragma unroll
                for (int ks = 0; ks < 2; ++ks) { v4u w; w.x = cvtpk(acc[8 * ks], acc[8 * ks + 1]); w.y = cvtpk(acc[8 * ks + 2], acc[8 * ks + 3]); w.z = cvtpk(acc[8 * ks + 4], acc[8 * ks + 5]); w.w = cvtpk(acc[8 * ks + 6], acc[8 * ks + 7]); pf[ks] = __builtin_bit_cast(bf16x8, w); }
#pragma unroll
                for (int dt = 0; dt < 2; ++dt)
#pragma unroll
                    for (int ks = 0; ks < 2; ++ks) { const LAS unsigned char* vp = Vb + (32 * dt + l31) * (MLV_PITCH * 2) + (32 * sub + 16 * ks + 4 * hi) * 2;
                        const u32x2 x0 = *(const LAS u32x2*)vp, x1 = *(const LAS u32x2*)(vp + 16);
                        v4u a; a.x = x0.x; a.y = x0.y; a.z = x1.x; a.w = x1.y; o[dt] = MFMA32(__builtin_bit_cast(bf16x8, a), pf[ks], o[dt]); }
                done = __all(cum < -110.f);
            }
        }
        if (lane == 0) flags[(i & 1) * 8 + wave] = done ? 1u : 0u;
        LAS unsigned char* nb = lds + ((i + 1) & 1) * SB_STAGE;
        *(LAS v4u*)(nb + lK) = rk; *(LAS u32x2*)(nb + lVt) = (u32x2){rv.x, rv.y}; *(LAS u32x2*)(nb + lVt + 8) = (u32x2){rv.z, rv.w};
        __syncthreads();
        unsigned nd = 0;
#pragma unroll
        for (int w8 = 0; w8 < 8; ++w8) nd += flags[(i & 1) * 8 + w8];
        if (nd == 8u) break;
    }
    store_OT(o, 1.0f, (LAS bf16_t*)(lds + 2 * SB_STAGE + 256) + wave * (32 * STG_PITCH), ymix + (rowb + q0) * DM + h * 64, lane);
    __syncthreads();
}

constexpr int RW_RAWW = 0, RW_RAWA = 2048, RW_RS = 4096, RW_KS = 6144, RW_VS = 8192;
constexpr int RW_CH0 = 10240, RW_CHSZ = 11328;
constexpr int RW_YB = RW_CH0 + 2 * RW_CHSZ;
constexpr int RW_MIX = RW_YB + 1024;
static_assert((RW_MIX + 256) * 4 <= 146432, "rwkv LDS map");
__device__ __forceinline__ float tanh_fast(float x) { return 1.f - 2.f * __builtin_amdgcn_rcpf(1.f + __expf(2.f * x)); }
__device__ __forceinline__ float sigmoid_fast(float x) { return __builtin_amdgcn_rcpf(1.f + __expf(-x)); }
__device__ __forceinline__ bf16_t bf1(float x) { return (bf16_t)(cvtpk(x, x) & 0xffffu); }

#define MFMA16(a, b, c) __builtin_amdgcn_mfma_f32_16x16x32_bf16((a), (b), (c), 0, 0, 0)
constexpr int RW2_CH0 = 0, RW2_YB = 2 * RW_CHSZ, RW2_MIX = RW2_YB + 1024, RW2_STG = RW2_MIX + 448;
static_assert((RW2_STG + 2 * 3072) * 4 <= 146432, "rwkv LDS map");
__device__ __forceinline__ void rwkv_phase_scan(LAS float* sm, int tid, int lane, int wave, int blk, const bf16_t* __restrict__ proj, const float* __restrict__ mix, const float* __restrict__ w0, const float* __restrict__ a0,
                                           const float* __restrict__ k_k, const float* __restrict__ k_a, const float* __restrict__ r_k, const bf16_t* __restrict__ W2T, const bf16_t* __restrict__ A2T, const bf16_t* __restrict__ G2T,
                                           float* __restrict__ yraw, bf16_t* __restrict__ gout, float* __restrict__ bonus_out) {
    const int chain = blk >> 1, half = blk & 1, b = chain >> 3, h = chain & 7, l15 = lane & 15, kg = lane >> 4;
    const size_t rowb = (size_t)b * SEQ;
    constexpr int NCHUNK = SEQ / 32;
    if (tid < 256) sm[RW2_MIX + tid] = mix[1536 + tid];
    else if (tid < 448) { const int q = tid - 256; sm[RW2_MIX + tid] = mix[512 * (q >> 6) + h * 64 + (q & 63)]; }
    __syncthreads();
#define RW_SH8(CUR, PRV, M0, M1, OUT, PZ) do { const unsigned cu_[4] = {(CUR).x, (CUR).y, (CUR).z, (CUR).w}, pu_[4] = {(PRV).x, (PRV).y, (PRV).z, (PRV).w}; \
        const float mm_[8] = {(M0)[0], (M0)[1], (M0)[2], (M0)[3], (M1)[0], (M1)[1], (M1)[2], (M1)[3]}; \
        _Pragma("unroll") for (int q = 0; q < 4; ++q) { const float c0 = bflo(cu_[q]), c1 = bfhi(cu_[q]), p0 = bflo(pu_[q]) * (PZ), p1 = bfhi(pu_[q]) * (PZ); \
            OUT[2 * q] = c0 + (p0 - c0) * mm_[2 * q]; OUT[2 * q + 1] = c1 + (p1 - c1) * mm_[2 * q + 1]; } } while (0)
    if (wave < 4) {
        const int iA = 8 * wave + kg, iB = iA + 4, jseg = l15;
        float A0 = 0.f, A1 = 0.f, A2 = 0.f, A3 = 0.f, B0 = 0.f, B1 = 0.f, B2 = 0.f, B3 = 0.f;
        __syncthreads();
#pragma unroll 1
        for (int ch = 0; ch < NCHUNK; ++ch) {
            const int t0 = ch * 32;
            const LAS float* CHb = sm + RW2_CH0 + (ch & 1) * RW_CHSZ + 4 * jseg;
            const LAS float* CHv = sm + RW2_CH0 + (ch & 1) * RW_CHSZ + 10240 + iA;
            const LAS float* CHs = sm + RW2_CH0 + (ch & 1) * RW_CHSZ + 11264;
            f32x4 a4 = *(const LAS f32x4*)(CHb + 4096), wr4 = *(const LAS f32x4*)(CHb + 8192), w4 = *(const LAS f32x4*)(CHb), b4 = *(const LAS f32x4*)(CHb + 6144), k4 = *(const LAS f32x4*)(CHb + 2048);
            float vA = CHv[0], vB = CHv[4]; f32x2_t sc = *(const LAS f32x2_t*)(CHs);
#pragma unroll 2
            for (int t = 0; t < 32; ++t) {
                const int tq = (t + 1) & 31;
                const f32x4 a4n = *(const LAS f32x4*)(CHb + 4096 + tq * 64), wr4n = *(const LAS f32x4*)(CHb + 8192 + tq * 64), w4n = *(const LAS f32x4*)(CHb + tq * 64),
                            b4n = *(const LAS f32x4*)(CHb + 6144 + tq * 64), k4n = *(const LAS f32x4*)(CHb + 2048 + tq * 64);
                const float vAn = CHv[tq * 32], vBn = CHv[tq * 32 + 4]; const f32x2_t scn = *(const LAS f32x2_t*)(CHs + 2 * tq);
                float d1A = (A0 * a4[0] + A1 * a4[1]) + (A2 * a4[2] + A3 * a4[3]), d1B = (B0 * a4[0] + B1 * a4[1]) + (B2 * a4[2] + B3 * a4[3]);
                float d2A = (A0 * wr4[0] + A1 * wr4[1]) + (A2 * wr4[2] + A3 * wr4[3]), d2B = (B0 * wr4[0] + B1 * wr4[1]) + (B2 * wr4[2] + B3 * wr4[3]);
                d1A = rowsum16(d1A); d1B = rowsum16(d1B); d2A = rowsum16(d2A); d2B = rowsum16(d2B);
                const float yA = d2A + d1A * sc[0] + vA * sc[1], yB = d2B + d1B * sc[0] + vB * sc[1];
                A0 = A0 * w4[0] + (d1A * b4[0] + vA * k4[0]); A1 = A1 * w4[1] + (d1A * b4[1] + vA * k4[1]); A2 = A2 * w4[2] + (d1A * b4[2] + vA * k4[2]); A3 = A3 * w4[3] + (d1A * b4[3] + vA * k4[3]);
                B0 = B0 * w4[0] + (d1B * b4[0] + vB * k4[0]); B1 = B1 * w4[1] + (d1B * b4[1] + vB * k4[1]); B2 = B2 * w4[2] + (d1B * b4[2] + vB * k4[2]); B3 = B3 * w4[3] + (d1B * b4[3] + vB * k4[3]);
                if (jseg == 0) { sm[RW2_YB + t * 32 + iA] = yA; sm[RW2_YB + t * 32 + iB] = yB; }
                a4 = a4n; wr4 = wr4n; w4 = w4n; b4 = b4n; k4 = k4n; vA = vAn; vB = vBn; sc = scn;
            }
            WSYNC();
            { const int tt = lane >> 1, hh = lane & 1; const f32x4 yv = *(const LAS f32x4*)(sm + RW2_YB + tt * 32 + 8 * wave + 4 * hh);
              *(f32x4*)(yraw + (rowb + t0 + tt) * 512 + h * 64 + half * 32 + 8 * wave + 4 * hh) = yv; }
            __syncthreads();
        }
    } else if (wave < 6) {
        const int tp = wave - 4, tb = 16 * tp;
        LAS float* stg = sm + RW2_STG + tp * 3072;
        float w0c[4], a0c[4], kkc[4], kac[4], rkc[4];
#pragma unroll
        for (int nt = 0; nt < 4; ++nt) { const int c = h * 64 + 16 * nt + l15; w0c[nt] = w0[c]; a0c[nt] = a0[c]; kkc[nt] = k_k[c]; kac[nt] = k_a[c]; rkc[nt] = r_k[c]; }
        v4u ld[20];
#define PREP_ISSUE(T0) do { const int t0_ = (T0); { const size_t r_ = rowb + t0_ + tb + l15; const size_t rp_ = (t0_ + tb + l15 == 0) ? r_ : r_ - 1; \
            _Pragma("unroll") for (int lo = 0; lo < 2; ++lo) _Pragma("unroll") for (int ks = 0; ks < 2; ++ks) { const int col = 1536 + 64 * lo + 32 * ks + 8 * kg; \
                ld[(lo * 2 + ks) * 2] = *(const v4u*)(proj + r_ * L0P + col); ld[(lo * 2 + ks) * 2 + 1] = *(const v4u*)(proj + rp_ * L0P + col); } } \
            _Pragma("unroll") for (int ar = 0; ar < 3; ++ar) _Pragma("unroll") for (int i = 0; i < 2; ++i) { const int p_ = lane + 64 * i, row_ = p_ >> 3, c8_ = p_ & 7; \
                const size_t r_ = rowb + t0_ + tb + row_; const size_t rp_ = (t0_ + tb + row_ == 0) ? r_ : r_ - 1; const int col = 512 * ar + h * 64 + 8 * c8_; \
                ld[8 + (ar * 2 + i) * 2] = *(const v4u*)(proj + r_ * L0P + col); ld[8 + (ar * 2 + i) * 2 + 1] = *(const v4u*)(proj + rp_ * L0P + col); } } while (0)
#define PREP_BUILD(T0, NB) do { const int t0_ = (T0); LAS float* CHn = sm + RW2_CH0 + (NB) * RW_CHSZ; \
            f32x4 accw[4], acca[4]; \
            _Pragma("unroll") for (int nt = 0; nt < 4; ++nt) { accw[nt] = (f32x4){0.f, 0.f, 0.f, 0.f}; acca[nt] = (f32x4){0.f, 0.f, 0.f, 0.f}; } \
            { const float pz_ = (t0_ + tb + l15 == 0) ? 0.f : 1.f; \
              _Pragma("unroll") for (int lo = 0; lo < 2; ++lo) _Pragma("unroll") for (int ks = 0; ks < 2; ++ks) { float s_[8]; \
                const f32x4 m0 = *(const LAS f32x4*)(sm + RW2_MIX + 64 * lo + 32 * ks + 8 * kg), m1 = *(const LAS f32x4*)(sm + RW2_MIX + 64 * lo + 32 * ks + 8 * kg + 4); \
                RW_SH8(ld[(lo * 2 + ks) * 2], ld[(lo * 2 + ks) * 2 + 1], m0, m1, s_, pz_); \
                if (lo == 0) { _Pragma("unroll") for (int j = 0; j < 8; ++j) s_[j] = tanh_fast(s_[j]); } \
                v4u aw; aw.x = cvtpk(s_[0], s_[1]); aw.y = cvtpk(s_[2], s_[3]); aw.z = cvtpk(s_[4], s_[5]); aw.w = cvtpk(s_[6], s_[7]); const bf16x8 af = __builtin_bit_cast(bf16x8, aw); \
                const bf16_t* WT = lo ? A2T : W2T; \
                _Pragma("unroll") for (int nt = 0; nt < 4; ++nt) { const bf16x8 bfr = *(const bf16x8*)(WT + (size_t)(h * 64 + 16 * nt + l15) * 64 + 32 * ks + 8 * kg); \
                    if (lo == 0) accw[nt] = MFMA16(af, bfr, accw[nt]); else acca[nt] = MFMA16(af, bfr, acca[nt]); } } } \
            _Pragma("unroll") for (int ar = 0; ar < 3; ++ar) _Pragma("unroll") for (int i = 0; i < 2; ++i) { const int p_ = lane + 64 * i, row_ = p_ >> 3, c8_ = p_ & 7; float s_[8]; \
                const float pz_ = (t0_ + tb + row_ == 0) ? 0.f : 1.f; const f32x4 m0 = *(const LAS f32x4*)(sm + RW2_MIX + 256 + ar * 64 + c8_ * 8), m1 = *(const LAS f32x4*)(sm + RW2_MIX + 256 + ar * 64 + c8_ * 8 + 4); \
                RW_SH8(ld[8 + (ar * 2 + i) * 2], ld[8 + (ar * 2 + i) * 2 + 1], m0, m1, s_, pz_); \
                *(LAS f32x4*)(stg + ar * 1024 + row_ * 64 + c8_ * 8) = (f32x4){s_[0], s_[1], s_[2], s_[3]}; *(LAS f32x4*)(stg + ar * 1024 + row_ * 64 + c8_ * 8 + 4) = (f32x4){s_[4], s_[5], s_[6], s_[7]}; } \
            WSYNC(); \
            PREP_ISSUE(((T0) + 32 < SEQ) ? (T0) + 32 : (T0)); \
            _Pragma("unroll") for (int rg = 0; rg < 4; ++rg) { const int tl = 4 * kg + rg, t = tb + tl; \
                float r_[4], k_[4], v_[4], kkv[4], nrm2 = 0.f; \
                _Pragma("unroll") for (int nt = 0; nt < 4; ++nt) { r_[nt] = stg[tl * 64 + 16 * nt + l15]; k_[nt] = stg[1024 + tl * 64 + 16 * nt + l15]; v_[nt] = stg[2048 + tl * 64 + 16 * nt + l15]; \
                    kkv[nt] = k_[nt] * kkc[nt]; nrm2 += kkv[nt] * kkv[nt]; } \
                nrm2 = rowsum16(nrm2); const float rn = __builtin_amdgcn_rsqf(fmaxf(nrm2, 1e-24f)); \
                float br = 0.f, kr = 0.f, bon = 0.f; \
                _Pragma("unroll") for (int nt = 0; nt < 4; ++nt) { const int j = 16 * nt + l15; \
                    const float wsum = w0c[nt] + accw[nt][rg]; const float logw = -softplus_fast(-wsum) - 0.5f; const float dec = __expf(-__expf(logw)); \
                    const float a_ = sigmoid_fast(a0c[nt] + acca[nt][rg]); const float kn = kkv[nt] * rn; \
                    const float k2 = k_[nt] * (1.f + (a_ - 1.f) * kac[nt]); const float bv = kn * a_; \
                    br += bv * r_[nt]; kr += k2 * r_[nt]; bon += r_[nt] * k2 * rkc[nt]; \
                    CHn[t * 64 + j] = dec; CHn[2048 + t * 64 + j] = k2; CHn[4096 + t * 64 + j] = -kn; CHn[6144 + t * 64 + j] = bv; CHn[8192 + t * 64 + j] = dec * r_[nt]; \
                    if ((nt >> 1) == half) CHn[10240 + t * 32 + (j & 31)] = v_[nt]; } \
                br = rowsum16(br); kr = rowsum16(kr); bon = rowsum16(bon); \
                if (l15 == 0) { CHn[11264 + 2 * t] = br; CHn[11264 + 2 * t + 1] = kr; if (half == 0) bonus_out[(rowb + t0_ + t) * 8 + h] = bon; } } \
            WSYNC(); } while (0)
        PREP_ISSUE(0);
        PREP_BUILD(0, 0);
        __syncthreads();
#pragma unroll 1
        for (int ch = 0; ch < NCHUNK; ++ch) {
            if (ch + 1 < NCHUNK) PREP_BUILD(ch * 32 + 32, (ch + 1) & 1);
            __syncthreads();
        }
#undef PREP_ISSUE
#undef PREP_BUILD
    } else {
        const int tp = wave - 6, tb = 16 * tp;
        v4u ld[8];
#define G_ISSUE(T0) do { const int t0_ = (T0); const size_t r_ = rowb + t0_ + tb + l15; const size_t rp_ = (t0_ + tb + l15 == 0) ? r_ : r_ - 1; \
            _Pragma("unroll") for (int ks = 0; ks < 4; ++ks) { const int col = 1664 + 32 * ks + 8 * kg; ld[2 * ks] = *(const v4u*)(proj + r_ * L0P + col); ld[2 * ks + 1] = *(const v4u*)(proj + rp_ * L0P + col); } } while (0)
#define G_BUILD(T0) do { const int t0_ = (T0); f32x4 accg[2] = {(f32x4){0.f, 0.f, 0.f, 0.f}, (f32x4){0.f, 0.f, 0.f, 0.f}}; const float pz_ = (t0_ + tb + l15 == 0) ? 0.f : 1.f; \
            _Pragma("unroll") for (int ks = 0; ks < 4; ++ks) { float s_[8]; \
                const f32x4 m0 = *(const LAS f32x4*)(sm + RW2_MIX + 128 + 32 * ks + 8 * kg), m1 = *(const LAS f32x4*)(sm + RW2_MIX + 128 + 32 * ks + 8 * kg + 4); \
                RW_SH8(ld[2 * ks], ld[2 * ks + 1], m0, m1, s_, pz_); \
                _Pragma("unroll") for (int j = 0; j < 8; ++j) s_[j] = sigmoid_fast(s_[j]); \
                v4u aw; aw.x = cvtpk(s_[0], s_[1]); aw.y = cvtpk(s_[2], s_[3]); aw.z = cvtpk(s_[4], s_[5]); aw.w = cvtpk(s_[6], s_[7]); const bf16x8 af = __builtin_bit_cast(bf16x8, aw); \
                _Pragma("unroll") for (int nt = 0; nt < 2; ++nt) { const bf16x8 bfr = *(const bf16x8*)(G2T + (size_t)(h * 64 + half * 32 + 16 * nt + l15) * 128 + 32 * ks + 8 * kg); accg[nt] = MFMA16(af, bfr, accg[nt]); } } \
            G_ISSUE(((T0) + 32 < SEQ) ? (T0) + 32 : (T0)); \
            _Pragma("unroll") for (int nt = 0; nt < 2; ++nt) _Pragma("unroll") for (int rg = 0; rg < 4; ++rg) \
                gout[(rowb + t0_ + tb + 4 * kg + rg) * 512 + h * 64 + half * 32 + 16 * nt + l15] = (bf16_t)f2bf(accg[nt][rg]); } while (0)
        G_ISSUE(0);
        G_BUILD(0);
        __syncthreads();
#pragma unroll 1
        for (int ch = 0; ch < NCHUNK; ++ch) {
            if (ch + 1 < NCHUNK) G_BUILD(ch * 32 + 32);
            __syncthreads();
        }
#undef G_ISSUE
#undef G_BUILD
    }
#undef RW_SH8
    __syncthreads();
}

constexpr int CK_BK = 0, CK_AR = 4608, CK_BBT = 9216, CK_KBT = 12288, CK_VT = 15360, CK_GC = 16896, CK_TT = 17152, CK_SLOT = 18688, CK_NSLOT = 5;
constexpr int CK_STG = CK_SLOT * CK_NSLOT;
constexpr int CK_MIX = CK_STG + 4 * 12288;
constexpr int CK_FLAGS = CK_MIX + 448 * 4;
static_assert(CK_FLAGS + 64 <= 146432, "rwkv chunked LDS map");
__device__ __forceinline__ bf16x8 pack8(float a0, float a1, float a2, float a3, float a4, float a5, float a6, float a7) {
    v4u w; w.x = cvtpk(a0, a1); w.y = cvtpk(a2, a3); w.z = cvtpk(a4, a5); w.w = cvtpk(a6, a7); return __builtin_bit_cast(bf16x8, w); }
__device__ __forceinline__ void rwkv_phase(LAS float* smf, int tid, int lane, int wave, int blk, const bf16_t* __restrict__ proj, const float* __restrict__ mix, const float* __restrict__ w0, const float* __restrict__ a0,
                                           const float* __restrict__ k_k, const float* __restrict__ k_a, const float* __restrict__ r_k, const bf16_t* __restrict__ W2T, const bf16_t* __restrict__ A2T, const bf16_t* __restrict__ G2T,
                                           float* __restrict__ yraw, bf16_t* __restrict__ gout, float* __restrict__ bonus_out) {
    LAS unsigned char* lds = (LAS unsigned char*)smf;
    LAS float* mixs = (LAS float*)(lds + CK_MIX);
    volatile LAS unsigned* flags = (volatile LAS unsigned*)(lds + CK_FLAGS);
    const int chain = blk >> 1, ihalf = blk & 1, b = chain >> 3, h = chain & 7, l15 = lane & 15, kg = lane >> 4, l31 = lane & 31, hi = lane >> 5;
    const size_t rowb = (size_t)b * SEQ;
    constexpr int NCH = SEQ / 16;
    if (tid < 256) mixs[tid] = mix[1536 + tid];
    else if (tid < 448) { const int q = tid - 256; mixs[tid] = mix[512 * (q >> 6) + h * 64 + (q & 63)]; }
    if (tid < 16) flags[tid] = 0u;
    for (int q = tid; q < CK_NSLOT * 384; q += NWAVES * 64) *(LAS unsigned*)(lds + (q / 384) * CK_SLOT + CK_TT + (q % 384) * 4) = 0u;
    __syncthreads();
#define RW_SH8(CUR, PRV, M0, M1, OUT, PZ) do { const unsigned cu_[4] = {(CUR).x, (CUR).y, (CUR).z, (CUR).w}, pu_[4] = {(PRV).x, (PRV).y, (PRV).z, (PRV).w}; \
        const float mm_[8] = {(M0)[0], (M0)[1], (M0)[2], (M0)[3], (M1)[0], (M1)[1], (M1)[2], (M1)[3]}; \
        _Pragma("unroll") for (int q = 0; q < 4; ++q) { const float c0 = bflo(cu_[q]), c1 = bfhi(cu_[q]), p0 = bflo(pu_[q]) * (PZ), p1 = bfhi(pu_[q]) * (PZ); \
            OUT[2 * q] = c0 + (p0 - c0) * mm_[2 * q]; OUT[2 * q + 1] = c1 + (p1 - c1) * mm_[2 * q + 1]; } } while (0)
    if (wave == 0) {
        f32x16 ST[2];
#pragma unroll
        for (int r = 0; r < 16; ++r) { ST[0][r] = 0.f; ST[1][r] = 0.f; }
#pragma unroll 1
        for (int k = 0; k < NCH; ++k) {
#if defined(PROBE_STAMPS)
            const unsigned tw0_ = (unsigned)__builtin_amdgcn_s_memrealtime();
#endif
            { const unsigned want = (unsigned)(k + 1); const int sl = k % CK_NSLOT; while (flags[sl] != want) __builtin_amdgcn_s_sleep(1); }
#if defined(PROBE_STAMPS)
            if (blk == 0 && lane == 0) ((volatile LAS unsigned*)(lds + 146432 + 320))[16 + 24] += (unsigned)__builtin_amdgcn_s_memrealtime() - tw0_;
#endif
            asm volatile("" ::: "memory");
            const LAS unsigned char* im = lds + (k % CK_NSLOT) * CK_SLOT;
            f32x16 G;
#pragma unroll
            for (int r = 0; r < 16; ++r) G[r] = 0.f;
#pragma unroll
            for (int kk = 0; kk < 4; ++kk) { const bf16x8 fa = *(const LAS bf16x8*)(im + CK_BK + l31 * 144 + (16 * kk + 8 * hi) * 2), fb = *(const LAS bf16x8*)(im + CK_AR + l31 * 144 + (16 * kk + 8 * hi) * 2); G = MFMA32(fa, fb, G); }
            { const int tcol = l31 & 15; const bool strict = l31 < 16;
#pragma unroll
              for (int r = 0; r < 16; ++r) { const int srow = crow(r & 7, hi); const bool keep = strict ? (srow < tcol) : (srow <= tcol); G[r] = keep ? G[r] : 0.f; } }
            const bf16x8 gB = pack8(G[0], G[1], G[2], G[3], G[4], G[5], G[6], G[7]), gK = pack8(G[8], G[9], G[10], G[11], G[12], G[13], G[14], G[15]);
            f32x16 XT;
#pragma unroll
            for (int r = 0; r < 16; ++r) XT[r] = 0.f;
#pragma unroll
            for (int jt = 0; jt < 2; ++jt)
#pragma unroll
                for (int sp = 0; sp < 2; ++sp) { const LAS unsigned char* ap = im + CK_AR + l31 * 144 + (32 * jt + 16 * sp + 4 * hi) * 2;
                    const u32x2 x0 = *(const LAS u32x2*)ap, x1 = *(const LAS u32x2*)(ap + 16); v4u aw; aw.x = x0.x; aw.y = x0.y; aw.z = x1.x; aw.w = x1.y;
                    const bf16x8 sb_ = pack8(ST[jt][8 * sp], ST[jt][8 * sp + 1], ST[jt][8 * sp + 2], ST[jt][8 * sp + 3], ST[jt][8 * sp + 4], ST[jt][8 * sp + 5], ST[jt][8 * sp + 6], ST[jt][8 * sp + 7]);
                    XT = MFMA32(__builtin_bit_cast(bf16x8, aw), sb_, XT); }
            bf16x8 vP;
            { const LAS unsigned char* vp = im + CK_VT + l31 * 48 + (4 * hi) * 2; const u32x2 x0 = *(const LAS u32x2*)vp, x1 = *(const LAS u32x2*)(vp + 16); v4u vw; vw.x = x0.x; vw.y = x0.y; vw.z = x1.x; vw.w = x1.y;
              vP = __builtin_bit_cast(bf16x8, vw); XT = MFMA32(gK, vP, XT); }
            bf16x8 uP;
            { const LAS unsigned char* tp = im + CK_TT + l31 * 48 + (4 * hi) * 2; const u32x2 x0 = *(const LAS u32x2*)tp, x1 = *(const LAS u32x2*)(tp + 16); v4u tw; tw.x = x0.x; tw.y = x0.y; tw.z = x1.x; tw.w = x1.y;
              f32x16 UT;
#pragma unroll
              for (int r = 0; r < 16; ++r) UT[r] = 0.f;
              UT = MFMA32(__builtin_bit_cast(bf16x8, tw), pack8(XT[0], XT[1], XT[2], XT[3], XT[4], XT[5], XT[6], XT[7]), UT);
              uP = pack8(UT[0], UT[1], UT[2], UT[3], UT[4], UT[5], UT[6], UT[7]); }
            XT = MFMA32(gB, uP, XT);
            { float* yp = yraw + (rowb + 16 * k) * 512 + h * 64 + 32 * ihalf + l31;
#pragma unroll
              for (int q = 0; q < 8; ++q) yp[(size_t)crow(q, hi) * 512] = XT[8 + q]; }
            { const LAS float* gc = (const LAS float*)(im + CK_GC);
#pragma unroll
              for (int jt = 0; jt < 2; ++jt)
#pragma unroll
                  for (int r = 0; r < 16; ++r) ST[jt][r] *= gc[32 * jt + crow(r, hi)]; }
#pragma unroll
            for (int jt = 0; jt < 2; ++jt) { const LAS unsigned char* bp = im + CK_BBT + (32 * jt + l31) * 48 + (4 * hi) * 2; const LAS unsigned char* kp = im + CK_KBT + (32 * jt + l31) * 48 + (4 * hi) * 2;
                const u32x2 b0 = *(const LAS u32x2*)bp, b1 = *(const LAS u32x2*)(bp + 16), k0 = *(const LAS u32x2*)kp, k1 = *(const LAS u32x2*)(kp + 16);
                v4u a1; a1.x = b0.x; a1.y = b0.y; a1.z = b1.x; a1.w = b1.y; v4u a2; a2.x = k0.x; a2.y = k0.y; a2.z = k1.x; a2.w = k1.y;
                ST[jt] = MFMA32(__builtin_bit_cast(bf16x8, a1), uP, ST[jt]); ST[jt] = MFMA32(__builtin_bit_cast(bf16x8, a2), vP, ST[jt]); }
            WSYNC();
            if (lane == 0) flags[8] = (unsigned)(k + 1);
        }
    } else if (wave <= 4) {
        const int pw = wave - 1;
        LAS float* stg = (LAS float*)(lds + CK_STG) + pw * 3072;
        float w0c[4], a0c[4], kkc[4], kac[4], rkc[4];
#pragma unroll
        for (int nt = 0; nt < 4; ++nt) { const int c = h * 64 + 16 * nt + l15; w0c[nt] = w0[c]; a0c[nt] = a0[c]; kkc[nt] = k_k[c]; kac[nt] = k_a[c]; rkc[nt] = r_k[c]; }
        v4u ld[20];
#define CK_ISSUE(T0) do { const int t0_ = (T0); { const size_t r_ = rowb + t0_ + l15; const size_t rp_ = (t0_ + l15 == 0) ? r_ : r_ - 1; \
            _Pragma("unroll") for (int lo = 0; lo < 2; ++lo) _Pragma("unroll") for (int ks = 0; ks < 2; ++ks) { const int col = 1536 + 64 * lo + 32 * ks + 8 * kg; \
                ld[(lo * 2 + ks) * 2] = *(const v4u*)(proj + r_ * L0P + col); ld[(lo * 2 + ks) * 2 + 1] = *(const v4u*)(proj + rp_ * L0P + col); } } \
            _Pragma("unroll") for (int ar = 0; ar < 3; ++ar) _Pragma("unroll") for (int i = 0; i < 2; ++i) { const int p_ = lane + 64 * i, row_ = p_ >> 3, c8_ = p_ & 7; \
                const size_t r_ = rowb + t0_ + row_; const size_t rp_ = (t0_ + row_ == 0) ? r_ : r_ - 1; const int col = 512 * ar + h * 64 + 8 * c8_; \
                ld[8 + (ar * 2 + i) * 2] = *(const v4u*)(proj + r_ * L0P + col); ld[8 + (ar * 2 + i) * 2 + 1] = *(const v4u*)(proj + rp_ * L0P + col); } } while (0)
        CK_ISSUE(16 * pw);
#pragma unroll 1
        for (int k = pw; k < NCH; k += 4) {
            const int t0 = 16 * k;
#if defined(PROBE_STAMPS)
            const unsigned ts0_ = (unsigned)__builtin_amdgcn_s_memrealtime();
#endif
            unsigned pf0, pf1;
            { const int tpf = (k + 8 < NCH) ? t0 + 128 : t0; const int wh = lane & 3; const bf16_t* rp = proj + (rowb + tpf + (lane >> 2)) * L0P;
              pf0 = *(const unsigned*)(rp + ((wh < 3) ? 512 * wh + h * 64 : 1536)); pf1 = *(const unsigned*)(rp + 1600); }
            f32x4 accw[4], acca[4];
#pragma unroll
            for (int nt = 0; nt < 4; ++nt) { accw[nt] = (f32x4){0.f, 0.f, 0.f, 0.f}; acca[nt] = (f32x4){0.f, 0.f, 0.f, 0.f}; }
            { const float pz_ = (t0 + l15 == 0) ? 0.f : 1.f;
#pragma unroll
              for (int lo = 0; lo < 2; ++lo)
#pragma unroll
                for (int ks = 0; ks < 2; ++ks) { float s_[8];
                    const f32x4 m0 = *(const LAS f32x4*)(mixs + 64 * lo + 32 * ks + 8 * kg), m1 = *(const LAS f32x4*)(mixs + 64 * lo + 32 * ks + 8 * kg + 4);
                    RW_SH8(ld[(lo * 2 + ks) * 2], ld[(lo * 2 + ks) * 2 + 1], m0, m1, s_, pz_);
                    if (lo == 0) {
#pragma unroll
                        for (int j = 0; j < 8; ++j) s_[j] = tanh_fast(s_[j]); }
                    const bf16x8 af = pack8(s_[0], s_[1], s_[2], s_[3], s_[4], s_[5], s_[6], s_[7]);
                    const bf16_t* WT = lo ? A2T : W2T;
#pragma unroll
                    for (int nt = 0; nt < 4; ++nt) { const bf16x8 bfr = *(const bf16x8*)(WT + (size_t)(h * 64 + 16 * nt + l15) * 64 + 32 * ks + 8 * kg);
                        if (lo == 0) accw[nt] = MFMA16(af, bfr, accw[nt]); else acca[nt] = MFMA16(af, bfr, acca[nt]); } } }
#pragma unroll
            for (int ar = 0; ar < 3; ++ar)
#pragma unroll
                for (int i = 0; i < 2; ++i) { const int p_ = lane + 64 * i, row_ = p_ >> 3, c8_ = p_ & 7; float s_[8];
                    const float pz_ = (t0 + row_ == 0) ? 0.f : 1.f; const f32x4 m0 = *(const LAS f32x4*)(mixs + 256 + ar * 64 + c8_ * 8), m1 = *(const LAS f32x4*)(mixs + 256 + ar * 64 + c8_ * 8 + 4);
                    RW_SH8(ld[8 + (ar * 2 + i) * 2], ld[8 + (ar * 2 + i) * 2 + 1], m0, m1, s_, pz_);
                    *(LAS f32x4*)(stg + ar * 1024 + row_ * 64 + c8_ * 8) = (f32x4){s_[0], s_[1], s_[2], s_[3]}; *(LAS f32x4*)(stg + ar * 1024 + row_ * 64 + c8_ * 8 + 4) = (f32x4){s_[4], s_[5], s_[6], s_[7]}; }
            WSYNC();
#if defined(PROBE_STAMPS)
            if (blk == 0 && wave == 1 && lane == 0) ((volatile LAS unsigned*)(lds + 146432 + 320))[16 + 26] += (unsigned)__builtin_amdgcn_s_memrealtime() - ts0_;
#endif
#if defined(PROBE_STAMPS)
            const unsigned tb0_ = (unsigned)__builtin_amdgcn_s_memrealtime();
#endif
            { const int need = k - (CK_NSLOT - 1); if (need > 0) { while ((int)flags[8] < need) __builtin_amdgcn_s_sleep(2); } }
#if defined(PROBE_STAMPS)
            if (blk == 0 && wave == 1 && lane == 0) ((volatile LAS unsigned*)(lds + 146432 + 320))[16 + 25] += (unsigned)__builtin_amdgcn_s_memrealtime() - tb0_;
#endif
            asm volatile("" ::: "memory");
            LAS unsigned char* im = lds + (k % CK_NSLOT) * CK_SLOT;
#if defined(PROBE_STAMPS)
            const unsigned ts1_ = (unsigned)__builtin_amdgcn_s_memrealtime();
#endif
            float lwv[4][4], av[4][4], knv[4][4], rv[4][4], kv[4][4];
#pragma unroll
            for (int rg = 0; rg < 4; ++rg) { const int tl = 4 * kg + rg;
                float kkv[4], nrm2 = 0.f, vv[4], rr_[4], kr_[4];
#pragma unroll
                for (int nt = 0; nt < 4; ++nt) { rr_[nt] = stg[tl * 64 + 16 * nt + l15]; kr_[nt] = stg[1024 + tl * 64 + 16 * nt + l15]; vv[nt] = stg[2048 + tl * 64 + 16 * nt + l15];
                    kkv[nt] = kr_[nt] * kkc[nt]; nrm2 += kkv[nt] * kkv[nt]; }
                nrm2 = rowsum16(nrm2); const float rn = __builtin_amdgcn_rsqf(fmaxf(nrm2, 1e-24f));
                float bon = 0.f;
#pragma unroll
                for (int nt = 0; nt < 4; ++nt) {
                    const float wsum = w0c[nt] + accw[nt][rg]; lwv[nt][rg] = -0.6065306597126334f * sigmoid_fast(wsum);
                    const float a_ = sigmoid_fast(a0c[nt] + acca[nt][rg]); av[nt][rg] = a_; knv[nt][rg] = kkv[nt] * rn;
                    const float k2 = kr_[nt] * (1.f + (a_ - 1.f) * kac[nt]); kv[nt][rg] = k2; rv[nt][rg] = rr_[nt];
                    bon += rr_[nt] * k2 * rkc[nt];
                    if ((nt >> 1) == ihalf) *(LAS bf16_t*)(im + CK_VT + (16 * (nt & 1) + l15) * 48 + tl * 2) = bf1(vv[nt]);
                }
                bon = rowsum16(bon);
                if (l15 == 0 && ihalf == 0) bonus_out[(rowb + t0 + tl) * 8 + h] = bon;
            }
#pragma unroll
            for (int nt = 0; nt < 4; ++nt) {
                float L[4]; L[0] = lwv[nt][0]; L[1] = L[0] + lwv[nt][1]; L[2] = L[1] + lwv[nt][2]; L[3] = L[2] + lwv[nt][3];
                const float T0 = __shfl(L[3], l15), T1 = __shfl(L[3], 16 + l15), T2 = __shfl(L[3], 32 + l15), T3 = __shfl(L[3], 48 + l15);
                const float off = (kg > 0 ? T0 : 0.f) + (kg > 1 ? T1 : 0.f) + (kg > 2 ? T2 : 0.f), LC = (T0 + T1) + (T2 + T3);
                const int j = 16 * nt + l15;
                unsigned bb2[2], kb2[2];
                const float gC = __expf(LC); float eprev = __expf(off);
#pragma unroll
                for (int rg = 0; rg < 4; ++rg) { const int tl = 4 * kg + rg; const float Lt = off + L[rg], e1 = __expf(Lt), e2 = __builtin_amdgcn_rcpf(e1), e3 = eprev, e4 = gC * e2; eprev = e1;
                    const float kn = knv[nt][rg], bvv = kn * av[nt][rg], k2 = kv[nt][rg], rr2 = rv[nt][rg];
                    *(LAS bf16_t*)(im + CK_BK + tl * 144 + j * 2) = bf1(bvv * e2); *(LAS bf16_t*)(im + CK_BK + (16 + tl) * 144 + j * 2) = bf1(k2 * e2);
                    *(LAS bf16_t*)(im + CK_AR + tl * 144 + j * 2) = bf1(-kn * e3); *(LAS bf16_t*)(im + CK_AR + (16 + tl) * 144 + j * 2) = bf1(rr2 * e1);
                    const unsigned bq = bf1(bvv * e4), kq = bf1(k2 * e4);
                    if (rg & 1) { bb2[rg >> 1] |= bq << 16; kb2[rg >> 1] |= kq << 16; } else { bb2[rg >> 1] = bq; kb2[rg >> 1] = kq; } }
                *(LAS u32x2*)(im + CK_BBT + j * 48 + (4 * kg) * 2) = (u32x2){bb2[0], bb2[1]}; *(LAS u32x2*)(im + CK_KBT + j * 48 + (4 * kg) * 2) = (u32x2){kb2[0], kb2[1]};
                if (kg == 0) *(LAS float*)(im + CK_GC + j * 4) = gC;
            }
            WSYNC();
#if defined(PROBE_STAMPS)
            const unsigned ts2_ = (unsigned)__builtin_amdgcn_s_memrealtime();
            if (blk == 0 && wave == 1 && lane == 0) ((volatile LAS unsigned*)(lds + 146432 + 320))[16 + 27] += ts2_ - ts1_;
#endif
            {
                f32x4 nacc = {0.f, 0.f, 0.f, 0.f};
#pragma unroll
                for (int ks = 0; ks < 2; ++ks) { const bf16x8 fa = *(const LAS bf16x8*)(im + CK_BK + l15 * 144 + (32 * ks + 8 * kg) * 2), fb = *(const LAS bf16x8*)(im + CK_AR + l15 * 144 + (32 * ks + 8 * kg) * 2); nacc = MFMA16(fa, fb, nacc); }
#pragma unroll
                for (int rg = 0; rg < 4; ++rg) nacc[rg] = ((4 * kg + rg) < l15) ? nacc[rg] : 0.f;
                float Tr[16];
#pragma unroll
                for (int t = 0; t < 16; ++t) { float acc_ = (l15 == t) ? 1.f : 0.f;
#pragma unroll
                    for (int s2 = 0; s2 < t; ++s2) acc_ += Tr[s2] * rl(nacc[s2 & 3], t + 16 * (s2 >> 2));
                    Tr[t] = acc_; }
                if (kg == 0) {
#pragma unroll
                    for (int t = 0; t < 16; ++t) *(LAS bf16_t*)(im + CK_TT + t * 48 + l15 * 2) = bf1(Tr[t]); }
            }
            WSYNC();
#if defined(PROBE_STAMPS)
            if (blk == 0 && wave == 1 && lane == 0) ((volatile LAS unsigned*)(lds + 146432 + 320))[16 + 28] += (unsigned)__builtin_amdgcn_s_memrealtime() - ts2_;
#endif
            if (lane == 0) flags[k % CK_NSLOT] = (unsigned)(k + 1);
            CK_ISSUE((k + 4 < NCH) ? t0 + 64 : t0);
            asm volatile("" :: "v"(pf0), "v"(pf1));
        }
#undef CK_ISSUE
    } else if (wave <= 6) {
        const int gq = wave - 5;
        v4u ld[8];
#define G_ISSUE(T0) do { const int t0_ = (T0); const size_t r_ = rowb + t0_ + l15; const size_t rp_ = (t0_ + l15 == 0) ? r_ : r_ - 1; \
            _Pragma("unroll") for (int ks = 0; ks < 4; ++ks) { const int col = 1664 + 32 * ks + 8 * kg; ld[2 * ks] = *(const v4u*)(proj + r_ * L0P + col); ld[2 * ks + 1] = *(const v4u*)(proj + rp_ * L0P + col); } } while (0)
        G_ISSUE(16 * gq);
#pragma unroll 1
        for (int k = gq; k < NCH; k += 2) {
            const int t0 = 16 * k;
            f32x4 accg[2] = {(f32x4){0.f, 0.f, 0.f, 0.f}, (f32x4){0.f, 0.f, 0.f, 0.f}}; const float pz_ = (t0 + l15 == 0) ? 0.f : 1.f;
#pragma unroll
            for (int ks = 0; ks < 4; ++ks) { float s_[8];
                const f32x4 m0 = *(const LAS f32x4*)(mixs + 128 + 32 * ks + 8 * kg), m1 = *(const LAS f32x4*)(mixs + 128 + 32 * ks + 8 * kg + 4);
                RW_SH8(ld[2 * ks], ld[2 * ks + 1], m0, m1, s_, pz_);
#pragma unroll
                for (int j = 0; j < 8; ++j) s_[j] = sigmoid_fast(s_[j]);
                const bf16x8 af = pack8(s_[0], s_[1], s_[2], s_[3], s_[4], s_[5], s_[6], s_[7]);
#pragma unroll
                for (int nt = 0; nt < 2; ++nt) { const bf16x8 bfr = *(const bf16x8*)(G2T + (size_t)(h * 64 + ihalf * 32 + 16 * nt + l15) * 128 + 32 * ks + 8 * kg); accg[nt] = MFMA16(af, bfr, accg[nt]); } }
            G_ISSUE((k + 2 < NCH) ? t0 + 32 : t0);
#pragma unroll
            for (int nt = 0; nt < 2; ++nt)
#pragma unroll
                for (int rg = 0; rg < 4; ++rg) gout[(rowb + t0 + 4 * kg + rg) * 512 + h * 64 + ihalf * 32 + 16 * nt + l15] = bf1(accg[nt][rg]);
        }
#undef G_ISSUE
    }
#undef RW_SH8
    __syncthreads();
}

template <bool ST = true> __device__ __forceinline__ void rwkv_post_all(const float* __restrict__ yraw, const bf16_t* __restrict__ proj, const float* __restrict__ mix, const float* __restrict__ bonus, const bf16_t* __restrict__ gbuf,
                                              const float* __restrict__ ln_g, const float* __restrict__ ln_b, bf16_t* __restrict__ ymix, int gw, int NGW, int lane) {
    for (int m = gw; m < M; m += NGW) {
        const bool has_prev = (m & (SEQ - 1)) != 0;
        float y[8], cv[8], pv[8], gg[8], bo[8];
#pragma unroll
        for (int h = 0; h < 8; ++h) { const int c = h * 64 + lane; y[h] = yraw[(size_t)m * 512 + c]; cv[h] = bf2f(proj[(size_t)m * L0P + 1024 + c]);
            pv[h] = bf2f(proj[(size_t)(has_prev ? m - 1 : m) * L0P + 1024 + c]); gg[h] = bf2f(gbuf[(size_t)m * 512 + c]); bo[h] = bonus[(size_t)m * 8 + h]; }
#pragma unroll
        for (int h = 0; h < 8; ++h) { const int c = h * 64 + lane;
            const float mu = wave_sum_dpp(y[h]) * (1.f / 64.f), d = y[h] - mu, var = wave_sum_dpp(d * d) * (1.f / 64.f);
            const float yn = d * __builtin_amdgcn_rsqf(var + 64e-5f) * ln_g[c] + ln_b[c];
            const float pvv = has_prev ? pv[h] : 0.f;
            const float v_s = cv[h] + (pvv - cv[h]) * mix[1024 + c];
            const float o = (yn + bo[h] * v_s) * gg[h];
            if (ST) ymix[(size_t)m * DM + c] = (bf16_t)f2bf(o); else asm volatile("" :: "v"(o)); }
    }
}


__device__ __forceinline__ void ssd_conv_tile(int it, int lane, LAS bf16_t* scr, const bf16_t* __restrict__ proj, const float* __restrict__ cw, const float* __restrict__ cb,
                                              bf16_t* __restrict__ xbc, bf16_t* __restrict__ xst, bf16_t* __restrict__ bt) {
    const int tt = it >> 4, ct = it & 15, m0 = tt * 64, b = m0 >> 11, t0 = m0 & (SEQ - 1), c = ct * 64 + lane;
    const float w0 = cw[c], w1 = cw[1024 + c], w2 = cw[2048 + c], w3 = cw[3072 + c], bias = cb[c];
    const bf16_t* src = proj + (size_t)m0 * L0P + 2304 + c;
    float u3 = 0.f, u2 = 0.f, u1 = 0.f;
    if (t0 > 0) { u3 = bf2f(src[-3 * L0P]); u2 = bf2f(src[-2 * L0P]); u1 = bf2f(src[-1 * L0P]); }
#pragma unroll 16
    for (int t = 0; t < 64; ++t) {
        const float u = bf2f(src[(size_t)t * L0P]);
        const float y = bias + w0 * u3 + w1 * u2 + w2 * u1 + w3 * u;
        const bf16_t o = (bf16_t)f2bf(y / (1.f + __expf(-y)));
        xbc[(size_t)(m0 + t) * 1024 + c] = o;
        scr[t * STG_PITCH + lane] = o;
        u3 = u2; u2 = u1; u1 = u;
    }
    WSYNC();
    if (ct < 12) {
        bf16_t* dst = (ct < 8) ? xst + ((size_t)(b * 8 + ct) * 64) * SEQ + t0 : bt + ((size_t)(b * 2 + ((ct - 8) >> 1)) * 128 + ((ct - 8) & 1) * 64) * SEQ + t0;
#pragma unroll
        for (int i = 0; i < 8; ++i) { const int d = i * 8 + (lane >> 3), tc = lane & 7; const LAS bf16_t* p = scr + (tc * 8) * STG_PITCH + d;
            v4u o; o.x = (unsigned)p[0] | ((unsigned)p[STG_PITCH] << 16); o.y = (unsigned)p[2 * STG_PITCH] | ((unsigned)p[3 * STG_PITCH] << 16);
            o.z = (unsigned)p[4 * STG_PITCH] | ((unsigned)p[5 * STG_PITCH] << 16); o.w = (unsigned)p[6 * STG_PITCH] | ((unsigned)p[7 * STG_PITCH] << 16);
            *(v4u*)(dst + (size_t)d * SEQ + tc * 8) = o; }
    }
    WSYNC();
}
__device__ __forceinline__ float bperm(int srclane, float x) { return __builtin_bit_cast(float, __builtin_amdgcn_ds_bpermute(srclane << 2, __builtin_bit_cast(int, x))); }
__device__ __forceinline__ void scan128(float& x0, float& x1, int lane) {
#pragma unroll
    for (int o = 1; o < 64; o <<= 1) { const int sl = (lane >= o) ? lane - o : lane; const float t0 = bperm(sl, x0), t1 = bperm(sl, x1); if (lane >= o) { x0 += t0; x1 += t1; } }
    x1 += rl(x0, 63);
}
__device__ __forceinline__ void ssd_s1_unit(int unit, int lane, LAS float* tab, const bf16_t* __restrict__ xst, const bf16_t* __restrict__ bt, const float* __restrict__ dt, const float* __restrict__ a_log,
                                            float* __restrict__ sloc, float* __restrict__ asum) {
    const int h = unit & 7, c = (unit >> 3) & 15, b = unit >> 7, g = h >> 2, l0 = c * 128, l31 = lane & 31, hi = lane >> 5;
    const size_t m0 = (size_t)b * SEQ + l0;
    const float A = -expf(a_log[h]);
    const float d0 = dt[(m0 + lane) * 8 + h], d1 = dt[(m0 + 64 + lane) * 8 + h];
    float ac0 = d0 * A, ac1 = d1 * A;
    scan128(ac0, ac1, lane);
    const float aend = rl(ac1, 63);
    tab[lane] = __expf(aend - ac0) * d0; tab[64 + lane] = __expf(aend - ac1) * d1;
    if (lane == 0) asum[unit] = aend;
    WSYNC();
    f32x16 acc[2][4];
#pragma unroll
    for (int pt = 0; pt < 2; ++pt)
#pragma unroll
        for (int nt = 0; nt < 4; ++nt)
#pragma unroll
            for (int r = 0; r < 16; ++r) acc[pt][nt][r] = 0.f;
    const bf16_t* Xp = xst + ((size_t)(b * 8 + h) * 64 + l31) * SEQ + l0 + 8 * hi;
    const bf16_t* Bp = bt + ((size_t)(b * 2 + g) * 128 + l31) * SEQ + l0 + 8 * hi;
#pragma unroll 2
    for (int kk = 0; kk < 8; ++kk) {
        const f32x4 wa = *(const LAS f32x4*)(tab + 16 * kk + 8 * hi), wb = *(const LAS f32x4*)(tab + 16 * kk + 8 * hi + 4);
        bf16x8 af[2], bfr[4];
#pragma unroll
        for (int pt = 0; pt < 2; ++pt) { const v4u raw = *(const v4u*)(Xp + (size_t)pt * 32 * SEQ + 16 * kk);
            v4u w; w.x = cvtpk(bflo(raw.x) * wa[0], bfhi(raw.x) * wa[1]); w.y = cvtpk(bflo(raw.y) * wa[2], bfhi(raw.y) * wa[3]);
            w.z = cvtpk(bflo(raw.z) * wb[0], bfhi(raw.z) * wb[1]); w.w = cvtpk(bflo(raw.w) * wb[2], bfhi(raw.w) * wb[3]); af[pt] = __builtin_bit_cast(bf16x8, w); }
#pragma unroll
        for (int nt = 0; nt < 4; ++nt) bfr[nt] = *(const bf16x8*)(Bp + (size_t)nt * 32 * SEQ + 16 * kk);
#pragma unroll
        for (int pt = 0; pt < 2; ++pt)
#pragma unroll
            for (int nt = 0; nt < 4; ++nt) acc[pt][nt] = MFMA32(af[pt], bfr[nt], acc[pt][nt]);
    }
    float* dst = sloc + (size_t)unit * 8192 + l31;
#pragma unroll
    for (int pt = 0; pt < 2; ++pt)
#pragma unroll
        for (int nt = 0; nt < 4; ++nt)
#pragma unroll
            for (int r = 0; r < 16; ++r) dst[(32 * pt + crow(r, hi)) * 128 + 32 * nt] = acc[pt][nt][r];
    WSYNC();
}
__device__ __forceinline__ void ssd_s2_all(const float* __restrict__ sloc, const float* __restrict__ asum, bf16_t* __restrict__ stb, int gtid, int NT) {
    for (int i = gtid; i < 128 * 2048; i += NT) {
        const int bh = i >> 11, e4 = i & 2047, b = bh >> 3, h = bh & 7;
        f32x4 run = {0.f, 0.f, 0.f, 0.f};
#pragma unroll 4
        for (int c = 0; c < 16; ++c) { const int unit = (b * 16 + c) * 8 + h; const f32x4 tmp = *(const f32x4*)(sloc + (size_t)unit * 8192 + e4 * 4);
            uint2 w; w.x = cvtpk(run[0], run[1]); w.y = cvtpk(run[2], run[3]); *(uint2*)(stb + (size_t)unit * 8192 + e4 * 4) = w;
            run = run * __expf(asum[unit]) + tmp; }
    }
}
__device__ __forceinline__ void ssd_s3_unit(int unit, int lane, LAS float* tab, const bf16_t* __restrict__ xbc, const bf16_t* __restrict__ xst, const bf16_t* __restrict__ stb, const float* __restrict__ dt,
                                            const float* __restrict__ a_log, const float* __restrict__ dsk, bf16_t* __restrict__ yssm) {
    const int h = unit & 7, c = (unit >> 3) & 15, b = unit >> 7, g = h >> 2, l0 = c * 128, l31 = lane & 31, hi = lane >> 5;
    const size_t m0 = (size_t)b * SEQ + l0;
    const float A = -expf(a_log[h]), D = dsk[h];
    const float d0 = dt[(m0 + lane) * 8 + h], d1 = dt[(m0 + 64 + lane) * 8 + h];
    float ac0 = d0 * A, ac1 = d1 * A;
    scan128(ac0, ac1, lane);
    tab[lane] = ac0; tab[64 + lane] = ac1; tab[128 + lane] = d0; tab[192 + lane] = d1;
    WSYNC();
    const bf16_t* Cp = xbc + (m0 + l31) * 1024 + 768 + g * 128 + 8 * hi;
    const bf16_t* Sp = stb + (size_t)unit * 8192 + l31 * 128 + 8 * hi;
    const bf16_t* Bp = xbc + (m0 + l31) * 1024 + 512 + g * 128 + 8 * hi;
    const bf16_t* Xp = xst + ((size_t)(b * 8 + h) * 64 + l31) * SEQ + l0 + 4 * hi;
    LAS float* tr = tab + 256;
    const int row = lane >> 1, p0 = (lane & 1) * 16;
#pragma unroll 1
    for (int lt = 0; lt < 4; ++lt) {
        f32x16 y[2];
#pragma unroll
        for (int r = 0; r < 16; ++r) { y[0][r] = 0.f; y[1][r] = 0.f; }
        const float acl = tab[32 * lt + l31];
#pragma unroll 4
        for (int kk = 0; kk < 8; ++kk) {
            const bf16x8 cf = *(const bf16x8*)(Cp + (size_t)lt * 32 * 1024 + 16 * kk);
            const bf16x8 s0 = *(const bf16x8*)(Sp + 16 * kk), s1 = *(const bf16x8*)(Sp + 32 * 128 + 16 * kk);
            y[0] = MFMA32(s0, cf, y[0]); y[1] = MFMA32(s1, cf, y[1]);
        }
        { const float el = __expf(acl);
#pragma unroll
          for (int r = 0; r < 16; ++r) { y[0][r] *= el; y[1][r] *= el; } }
#pragma unroll 1
        for (int st = 0; st <= lt; ++st) {
            f32x16 cbt;
#pragma unroll
            for (int r = 0; r < 16; ++r) cbt[r] = 0.f;
#pragma unroll 4
            for (int kk = 0; kk < 8; ++kk) { const bf16x8 bf_ = *(const bf16x8*)(Bp + (size_t)st * 32 * 1024 + 16 * kk), cf_ = *(const bf16x8*)(Cp + (size_t)lt * 32 * 1024 + 16 * kk); cbt = MFMA32(bf_, cf_, cbt); }
#pragma unroll
            for (int r = 0; r < 16; ++r) { const int sl = 32 * st + crow(r, hi); const float acs = tab[sl], dts = tab[128 + sl];
                float v = cbt[r] * __expf(acl - acs) * dts; if (st == lt && crow(r, hi) > l31) v = 0.f; cbt[r] = v; }
            bf16x8 pf[2];
#pragma unroll
            for (int ks = 0; ks < 2; ++ks) { v4u w; w.x = cvtpk(cbt[8 * ks], cbt[8 * ks + 1]); w.y = cvtpk(cbt[8 * ks + 2], cbt[8 * ks + 3]); w.z = cvtpk(cbt[8 * ks + 4], cbt[8 * ks + 5]); w.w = cvtpk(cbt[8 * ks + 6], cbt[8 * ks + 7]); pf[ks] = __builtin_bit_cast(bf16x8, w); }
#pragma unroll
            for (int pt = 0; pt < 2; ++pt)
#pragma unroll
                for (int ks = 0; ks < 2; ++ks) { const bf16_t* xp = Xp + (size_t)pt * 32 * SEQ + st * 32 + 16 * ks; const u32x2 x0 = *(const u32x2*)xp, x1 = *(const u32x2*)(xp + 8);
                    v4u a; a.x = x0.x; a.y = x0.y; a.z = x1.x; a.w = x1.y; y[pt] = MFMA32(__builtin_bit_cast(bf16x8, a), pf[ks], y[pt]); }
        }
#pragma unroll
        for (int pt = 0; pt < 2; ++pt) {
#pragma unroll
            for (int r = 0; r < 16; ++r) tr[l31 * 33 + crow(r, hi)] = y[pt][r];
            WSYNC();
            const size_t m = m0 + 32 * lt + row;
            const v4u xa = *(const v4u*)(xbc + m * 1024 + h * 64 + 32 * pt + p0), xb = *(const v4u*)(xbc + m * 1024 + h * 64 + 32 * pt + p0 + 8);
            const unsigned xu[8] = {xa.x, xa.y, xa.z, xa.w, xb.x, xb.y, xb.z, xb.w};
            unsigned ow[8];
#pragma unroll
            for (int q = 0; q < 8; ++q) { const float v0 = tr[row * 33 + p0 + 2 * q] + D * bflo(xu[q]), v1 = tr[row * 33 + p0 + 2 * q + 1] + D * bfhi(xu[q]); ow[q] = cvtpk(v0, v1); }
            bf16_t* dst = yssm + m * 512 + h * 64 + 32 * pt + p0;
            *(v4u*)dst = (v4u){ow[0], ow[1], ow[2], ow[3]}; *(v4u*)(dst + 8) = (v4u){ow[4], ow[5], ow[6], ow[7]};
            WSYNC();
        }
    }
}

struct Args { const float* in[43]; float* out; unsigned char* ws; };
#define GEMM_PHASE(EPI, Aptr, LDA, Bptr, LDB, NN, KK, ...) do { pg8::Gemm g_{(Aptr), (Bptr), M, (NN), (KK), (LDA), (LDB)}; pg8::StaticOrder S_; S_.init(M, (NN), G, (int)blockIdx.x); \
        pg8::EPI E_{__VA_ARGS__}; pg8::gemm_phase<pg8::EPI, pg8::StaticOrder, true, true>(lds3, g_, S_, E_); } while (0)

__global__ void __launch_bounds__(NWAVES * 64, 2) fwd_mega(Args args) {
    extern __shared__ __attribute__((aligned(16))) unsigned char lds[];
    LAS unsigned char* lds3 = (LAS unsigned char*)lds;
    volatile LAS unsigned* MISC = (volatile LAS unsigned*)(lds3 + MISC_OFF);
    const int G = gridDim.x, NGW = G * NWAVES, NT = G * NWAVES * 64;
#define PHASE_IDS() int tid = threadIdx.x; asm volatile("" : "+v"(tid)); const int lane = tid & 63, wave = __builtin_amdgcn_readfirstlane(tid >> 6); const int gw = blockIdx.x * NWAVES + wave, gtid = blockIdx.x * (NWAVES * 64) + tid; (void)lane; (void)gw; (void)gtid
    unsigned char* ws = args.ws;
    gu32* ctl = (gu32*)(ws + WS_CTL);
    for (int u = threadIdx.x; u < (LDS_BYTES - LDSCTL_OFF) / 4; u += NWAVES * 64) ((LAS unsigned*)(lds3 + LDSCTL_OFF))[u] = 0u;
    __syncthreads();
    XcdBarrier bar = xcd_barrier_post((unsigned*)(ctl + CW_BAR), MISC + 8);
#if defined(PROBE_STAMPS)
    int nb_ = 0;
    if (blockIdx.x == 0 && threadIdx.x == 0) MISC[16] = (unsigned)__builtin_amdgcn_s_memrealtime();
#define GRID_BAR() do { xcd_barrier(bar); ++nb_; if (blockIdx.x == 0 && threadIdx.x == 0) MISC[16 + nb_] = (unsigned)__builtin_amdgcn_s_memrealtime(); } while (0)
#else
#define GRID_BAR() xcd_barrier(bar)
#endif
#define IN(i) (args.in[i])
    float* out = args.out;
    bf16_t* W0in = (bf16_t*)(ws + WS_W0IN); bf16_t* W0out = (bf16_t*)(ws + WS_W0OUT); bf16_t* Wup0 = (bf16_t*)(ws + WS_WUP0); bf16_t* Wdn0 = (bf16_t*)(ws + WS_WDN0);
    bf16_t* W1in = (bf16_t*)(ws + WS_W1IN); bf16_t* Wuq = (bf16_t*)(ws + WS_WUQ); bf16_t* Wukv = (bf16_t*)(ws + WS_WUKV); bf16_t* W1out = (bf16_t*)(ws + WS_W1OUT);
    bf16_t* Wup1 = (bf16_t*)(ws + WS_WUP1); bf16_t* Wdn1 = (bf16_t*)(ws + WS_WDN1);
    bf16_t* XB = (bf16_t*)(ws + WS_XB); bf16_t* YMIX = (bf16_t*)(ws + WS_YMIX); bf16_t* PROJ0 = (bf16_t*)(ws + WS_BIG);
    float* YRAW = out; bf16_t* YSSM = (bf16_t*)(out + (size_t)M * 512); bf16_t* STB = (bf16_t*)(out + (size_t)M * 768); bf16_t* XST = (bf16_t*)(ws + WS_XST); bf16_t* BT = (bf16_t*)(ws + WS_BT); float* ASUM = (float*)(ws + WS_ASUM); float* SLOC = (float*)(ws + WS_SLOC); float* DT = (float*)(ws + WS_DT); bf16_t* GB = (bf16_t*)(ws + WS_G); float* BONUS = (float*)(ws + WS_BONUS);
    bf16_t* W2T = (bf16_t*)(ws + WS_W2T); bf16_t* A2T = (bf16_t*)(ws + WS_A2T); bf16_t* G2T = (bf16_t*)(ws + WS_G2T); bf16_t* ACT = (bf16_t*)(ws + WS_GU); bf16_t* HALO = (bf16_t*)(ws + WS_GU + 176 * MiB);
    bf16_t* PROJ1 = (bf16_t*)(ws + WS_PROJ1); bf16_t* QM = (bf16_t*)(ws + WS_QM); bf16_t* KVM = (bf16_t*)(ws + WS_KVM); bf16_t* KPE = (bf16_t*)(ws + WS_KPE); float* RS = (float*)(ws + WS_RS); float* CSTAB = (float*)(ws + WS_CSTAB); bf16_t* VTS = (bf16_t*)(ws + WS_VTS); bf16_t* VTM = (bf16_t*)(ws + WS_VTM);
    const int* pos = (const int*)args.in[1];

    {
        PHASE_IDS();
    {
        LAS float* scr = (LAS float*)(lds3 + wave * 16384);
        transpose_matrix(IN(2), 1024, 3336, W0in, L0P, 1024, scr, gw, NGW, lane, nullptr);
        transpose_matrix(IN(20), 1024, 1024, W0out, 1024, 1024, scr, gw, NGW, lane, nullptr);
        transpose_matrix(IN(23), 1024, 5632, Wup0, 5632, 1024, scr, gw, NGW, lane, nullptr, true);
        transpose_matrix(IN(26), 2816, 1024, Wdn0, 1024, 2816, scr, gw, NGW, lane, nullptr);
        transpose_matrix(IN(29), 1024, 1952, W1in, L1P, 1024, scr, gw, NGW, lane, nullptr);
        transpose_matrix(IN(31), 256, 768, Wuq, 768, 256, scr, gw, NGW, lane, IN(30));
        transpose_matrix(IN(33), 128, 1024, Wukv, 1024, 256, scr, gw, NGW, lane, IN(32));
        for (int i = gtid; i < 1024 * 16; i += NT) { const int n = i >> 4, c = i & 15; *(v4u*)(Wukv + (size_t)n * 256 + 128 + c * 8) = (v4u){0u, 0u, 0u, 0u}; }
        transpose_matrix(IN(34), 1024, 1024, W1out, 1024, 1024, scr, gw, NGW, lane, nullptr);
        transpose_matrix(IN(37), 1024, 5632, Wup1, 5632, 1024, scr, gw, NGW, lane, nullptr, true);
        transpose_matrix(IN(40), 2816, 1024, Wdn1, 1024, 2816, scr, gw, NGW, lane, nullptr);
        transpose_matrix(IN(5), 64, 512, W2T, 512, 64, scr, gw, NGW, lane, nullptr);
        transpose_matrix(IN(7), 64, 512, A2T, 512, 64, scr, gw, NGW, lane, nullptr);
        transpose_matrix(IN(8), 128, 512, G2T, 512, 128, scr, gw, NGW, lane, nullptr);
        const float* x = IN(0);
        {
            constexpr size_t TOT4 = (size_t)M * DM / 4;
            for (size_t i = gtid; i < TOT4; i += (size_t)NT * 8) {
                f32x4 v[8];
#pragma unroll
                for (int u = 0; u < 8; ++u) v[u] = *(const f32x4*)(x + (i + (size_t)u * NT) * 4);
#pragma unroll
                for (int u = 0; u < 8; ++u) { uint2 w; w.x = cvtpk(v[u][0], v[u][1]); w.y = cvtpk(v[u][2], v[u][3]); *(uint2*)(XB + (i + (size_t)u * NT) * 4) = w; }
            }
        }
    }
    }
    GRID_BAR();
    {
        PHASE_IDS();
    GEMM_PHASE(EpiBf16S, XB, DM, W0in, 1024, L0P, 1024, PROJ0, nullptr, L0P, 0);
    }
    GRID_BAR();
    {
        PHASE_IDS();
        const int blk = (int)blockIdx.x, m0 = blk * 128;
        {   LAS bf16_t* scr = (LAS bf16_t*)(lds3 + wave * 16384);
#pragma unroll 1
            for (int k = 0; k < 4; ++k) ssd_conv_tile((2 * blk + (k & 1)) * 16 + wave + 8 * (k >> 1), lane, scr, PROJ0, IN(14), IN(15), XB, XST, BT);
            for (int i = tid; i < 1024; i += NWAVES * 64) { const int m = m0 + (i >> 3); DT[(size_t)m * 8 + (i & 7)] = softplusf_(bf2f(PROJ0[(size_t)m * L0P + 3328 + (i & 7)]) + IN(16)[i & 7]); }
        }
        __syncthreads();
        ssd_s1_unit(blk * 8 + wave, lane, (LAS float*)(lds3 + wave * 16384), XST, BT, DT, IN(17), SLOC, ASUM);
    }
    GRID_BAR();
    {
        PHASE_IDS();
        ssd_s2_all(SLOC, ASUM, STB, gtid, NT);
#if defined(PROBE_STAMPS)
        __syncthreads(); if (blockIdx.x == 0 && threadIdx.x == 0) MISC[16 + 23] = (unsigned)__builtin_amdgcn_s_memrealtime();
#endif
        rwkv_phase((LAS float*)lds3, tid, lane, wave, (int)blockIdx.x, PROJ0, IN(3), IN(4), IN(6), IN(9), IN(10), IN(11), W2T, A2T, G2T, YRAW, GB, BONUS);
    }
    GRID_BAR();
    {
        PHASE_IDS();
        const int blk = (int)blockIdx.x;
        ssd_s3_unit(blk * 8 + wave, lane, (LAS float*)(lds3 + wave * 16384), XB, XST, STB, DT, IN(17), IN(18), YSSM);
        __syncthreads();
        ssm_gate_norm_all(YSSM, PROJ0, IN(19), YMIX, blk * 256 + wave, blk * 256 + 256, lane);
        rwkv_post_all(YRAW, PROJ0, IN(3), BONUS, GB, IN(12), IN(13), YMIX, gw, NGW, lane);
    }
    GRID_BAR();
    {
        PHASE_IDS();
    GEMM_PHASE(EpiResid, YMIX, DM, W0out, 1024, 1024, 1024, IN(0), out, ALPHA, 0);
    }
    GRID_BAR();
    {
        PHASE_IDS();
    ln_rows(out, XB, IN(21), IN(22), gw, NGW, lane);
    }
    GRID_BAR();
    {
        PHASE_IDS();
        { pg8::Gemm g_{XB, Wup0, M / 32, DFF, 1024, DM, 1024, 4096, 8192, 256, 512, 1}; pg8::StaticOrder S_; S_.init(M / 32, DFF, G, (int)blockIdx.x);
          pg8::EpiBf16S E_{HALO, nullptr, DFF, 0}; pg8::gemm_phase<pg8::EpiBf16S, pg8::StaticOrder, true, true>(lds3, g_, S_, E_); }
    }
    GRID_BAR();
    {
        PHASE_IDS();
        { pg8::Gemm g_{XB, Wup0, M, 2 * DFF, 1024, DM, 1024}; pg8::StaticOrder S_; S_.init(M, 2 * DFF, G, (int)blockIdx.x);
          pg8::EpiConvAct E_{ACT, HALO, IN(24), IN(25), DFF, SEQ}; pg8::gemm_phase<pg8::EpiConvAct, pg8::StaticOrder, true, true>(lds3, g_, S_, E_); }
    }
    GRID_BAR();
    {
        PHASE_IDS();
    GEMM_PHASE(EpiResid, ACT, DFF, Wdn0, DFF, 1024, DFF, out, out, ALPHA, 0);
    }
    GRID_BAR();
    {
        PHASE_IDS();
    ln_rows(out, XB, IN(27), IN(28), gw, NGW, lane);
    }
    GRID_BAR();
    {
        PHASE_IDS();
    GEMM_PHASE(EpiBf16S, XB, DM, W1in, 1024, L1P, 1024, PROJ1, nullptr, L1P, 0);
    }
    GRID_BAR();
    {
        PHASE_IDS();
    mla_prep_all(PROJ1, pos, RS, KPE, CSTAB, gw, NGW, lane);
    }
    GRID_BAR();
    {
        PHASE_IDS();
    GEMM_PHASE(EpiBf16S, PROJ1 + 1536, L1P, Wuq, 256, 768, 256, QM, RS, 768, 2);
    GEMM_PHASE(EpiBf16S, PROJ1 + 1792, L1P, Wukv, 256, 1024, 256, KVM, RS + 1, 1024, 2);
    }
    GRID_BAR();
    {
        PHASE_IDS();
    rope_q_all(QM, CSTAB, gtid, NT);
    {
        LAS bf16_t* scr = (LAS bf16_t*)(lds3 + wave * 16384);
        for (int it = gw; it < 8192; it += NGW) { const int which = it >> 12, r = it & 4095, bh = r >> 5, tt = r & 31, b = bh >> 3, h = bh & 7;
            if (which == 0) transpose_tile64(PROJ1 + ((size_t)b * SEQ + tt * 64) * L1P + 1024 + h * 64, L1P, VTS + (size_t)bh * 64 * SEQ + tt * 64, SEQ, scr, lane);
            else            transpose_tile64(KVM + ((size_t)b * SEQ + tt * 64) * 1024 + h * 128 + 64, 1024, VTM + (size_t)bh * 64 * SEQ + tt * 64, SEQ, scr, lane); }
    }
    }
    GRID_BAR();
    {
        PHASE_IDS();
    {
        for (int g2 = (int)blockIdx.x; g2 < 256; g2 += G) { const int bh = g2 >> 1, part = g2 & 1;
#pragma unroll 1
            for (int i = 0; i < 4; ++i) { const int sbk = part ? ((i == 0) ? 1 : (i == 1) ? 6 : (i == 2) ? 2 : 5) : ((i == 0) ? 0 : (i == 1) ? 7 : (i == 2) ? 3 : 4);
                sb_block(bh, sbk, tid, lane, wave, lds3, PROJ1, VTS, YMIX); } }
        for (int g2 = (int)blockIdx.x; g2 < 256; g2 += G) { const int bh = g2 >> 1, part = g2 & 1;
#pragma unroll 1
            for (int i = 0; i < 4; ++i) { const int sbk = part ? ((i == 0) ? 1 : (i == 1) ? 6 : (i == 2) ? 2 : 5) : ((i == 0) ? 0 : (i == 1) ? 7 : (i == 2) ? 3 : 4);
                mla_block(bh, sbk, tid, lane, wave, lds3, QM, KVM, KPE, VTM, YMIX); } }
    }
    }
    GRID_BAR();
    {
        PHASE_IDS();
    GEMM_PHASE(EpiResid, YMIX, DM, W1out, 1024, 1024, 1024, out, out, ALPHA, 0);
    }
    GRID_BAR();
    {
        PHASE_IDS();
    ln_rows(out, XB, IN(35), IN(36), gw, NGW, lane);
    }
    GRID_BAR();
    {
        PHASE_IDS();
        { pg8::Gemm g_{XB, Wup1, M / 32, DFF, 1024, DM, 1024, 4096, 8192, 256, 512, 1}; pg8::StaticOrder S_; S_.init(M / 32, DFF, G, (int)blockIdx.x);
          pg8::EpiBf16S E_{HALO, nullptr, DFF, 0}; pg8::gemm_phase<pg8::EpiBf16S, pg8::StaticOrder, true, true>(lds3, g_, S_, E_); }
    }
    GRID_BAR();
    {
        PHASE_IDS();
        { pg8::Gemm g_{XB, Wup1, M, 2 * DFF, 1024, DM, 1024}; pg8::StaticOrder S_; S_.init(M, 2 * DFF, G, (int)blockIdx.x);
          pg8::EpiConvAct E_{ACT, HALO, IN(38), IN(39), DFF, SEQ}; pg8::gemm_phase<pg8::EpiConvAct, pg8::StaticOrder, true, true>(lds3, g_, S_, E_); }
    }
    GRID_BAR();
    {
        PHASE_IDS();
    GEMM_PHASE(EpiResid, ACT, DFF, Wdn1, DFF, 1024, DFF, out, out, ALPHA, 0);
    }
    GRID_BAR();
    {
        PHASE_IDS();
    ln_rows(out, XB, IN(41), IN(42), gw, NGW, lane);
    #if defined(PROBE_STAMPS)
    __syncthreads();
    if (blockIdx.x == 0 && threadIdx.x == 0) {
        MISC[16 + 22] = (unsigned)__builtin_amdgcn_s_memrealtime();
#if defined(PROBE_ACC)
        const unsigned d1 = MISC[16 + PROBE_ACC];
#else
        const unsigned d1 = MISC[16 + PROBE_T1_HI] - MISC[16 + PROBE_T1_LO];
#endif
        const unsigned long long spin = 100ull * d1;
        const unsigned long long t0 = __builtin_amdgcn_s_memrealtime();
        while (__builtin_amdgcn_s_memrealtime() - t0 < spin) __builtin_amdgcn_s_sleep(8);
    }
#endif
}
}

extern "C" void kernel_launch(void* const* d_in, const int* in_sizes, int n_in, void* d_out, int out_size, void* d_ws, size_t ws_size, hipStream_t stream) {
    static int grid = 0;
    if (grid == 0) {
        if (n_in != 43 || ws_size < WS_NEED || out_size != M * DM) { fprintf(stderr, "kernel_launch: unexpected n_in %d / ws %zu / out %d\n", n_in, ws_size, out_size); grid = -1; return; }
        int dev = 0, cus = 0, per_cu = 0;
        if (hipGetDevice(&dev) != hipSuccess || hipDeviceGetAttribute(&cus, hipDeviceAttributeMultiprocessorCount, dev) != hipSuccess) { grid = -1; return; }
        if (hipFuncSetAttribute((const void*)fwd_mega, hipFuncAttributeMaxDynamicSharedMemorySize, LDS_BYTES) != hipSuccess) { fprintf(stderr, "kernel_launch: hipFuncSetAttribute failed\n"); grid = -1; return; }
        if (hipOccupancyMaxActiveBlocksPerMultiprocessor(&per_cu, (const void*)fwd_mega, NWAVES * 64, LDS_BYTES) != hipSuccess || per_cu < 1) fprintf(stderr, "kernel_launch: occupancy query reports %d\n", per_cu);
        (void)hipGetLastError();
        grid = cus;
    }
    if (grid < 0) return;
    (void)hipMemsetAsync((char*)d_ws + WS_CTL, 0, CTL_ZERO_BYTES, stream);
    Args a{};
    for (int i = 0; i < 43; ++i) a.in[i] = (const float*)d_in[i];
    a.out = (float*)d_out; a.ws = (unsigned char*)d_ws;
    hipLaunchKernelGGL(fwd_mega, dim3(grid), dim3(NWAVES * 64), LDS_BYTES, stream, a);
}
```

```cpp
#include <hip/hip_runtime.h>
#include <cstdio>
#include <cstdint>
#include <cmath>
namespace pg8 {
#define PG8_LAS __attribute__((address_space(3)))
typedef unsigned short bf16_t;
typedef short bf16x8 __attribute__((ext_vector_type(8)));
typedef float f32x4 __attribute__((ext_vector_type(4)));
typedef unsigned u32x4 __attribute__((ext_vector_type(4)));
constexpr int BM = 256, BK = 64, HALF = 128, HTB = HALF * BK * 2  , STAGE_BYTES = 8 * HTB, NXCD = 8, WGM = 8;

__host__ __device__ __forceinline__ int lds_byte(int r, int c) { const int st = (r >> 4) * 2 + (c >> 5), rr = r & 15, cc = c & 31, ob = rr * 64 + cc * 2; return st * 1024 + (ob ^ (((ob >> 9) & 1) << 5)); }
__host__ __device__ __forceinline__ void stage_rc(int b, int& R, int& C) { const int st = b / 1024, sb = b % 1024, swz = sb ^ (((sb >> 9) & 1) << 5); R = (st >> 1) * 16 + swz / 64; C = (st & 1) * 32 + (swz % 64) / 2; }
__host__ __device__ __forceinline__ int perm32(int rho) { const int n = rho >> 4, i = rho & 15; return 8 * (i >> 2) + 4 * n + (i & 3); }

struct Unit { int pm, pn; };
struct Gemm { const bf16_t* A; const bf16_t* Bt; int M, N, K, lda, ldb; int hrA = 128, trA = 256, hrB = 128, trB = 256, gatherA = 0; };

struct StaticOrder {
    int nM, nN, nwg, G, c;
    __host__ __device__ void init(int M, int N, int G_, int c_) { nM = M / BM; nN = N / BM; nwg = nM * nN; G = G_; c = c_; }
    __host__ __device__ bool next(int i, Unit& u) const {
        const long L = (long)i * G + c; if (L >= nwg) return false;
        int wgid = (int)L; { const int q = nwg / NXCD, r = nwg % NXCD, xcd = wgid % NXCD, off = wgid / NXCD; wgid = (xcd < r ? xcd * (q + 1) : r * (q + 1) + (xcd - r) * q) + off; }
        const int nig = WGM * nN, gid = wgid / nig, fm = gid * WGM, gsz = (nM - fm) < WGM ? (nM - fm) : WGM;
        u.pm = fm + ((wgid % nig) % gsz); u.pn = (wgid % nig) / gsz; return true;
    }
    __device__ __forceinline__ void a_ready(const Unit&) const {}
    __device__ __forceinline__ void done(const Unit&) const {}
};


__device__ __forceinline__ unsigned cvt_pk_bf16(float lo, float hi) { unsigned r; asm volatile("v_cvt_pk_bf16_f32 %0, %1, %2" : "=v"(r) : "v"(lo), "v"(hi)); return r; }
struct EpiBf16S {
    static constexpr bool PERM = true, AFTER_DRAIN = false;
    bf16_t* O; const float* rowscale; int ldc; int rs_stride;
    __device__ __forceinline__ void operator()(const f32x4 (&acc)[2][2][4][2], const Unit& u, int wr, int wc, int fr, int fq) const {
        const int row0 = u.pm * BM + wr * 64 + fr, col0 = u.pn * BM + wc * 32 + 8 * fq;
#pragma unroll
        for (int ai = 0; ai < 2; ++ai)
#pragma unroll
            for (int m = 0; m < 4; ++m) { const int row = row0 + ai * HALF + m * 16; const float sc = rowscale ? rowscale[(size_t)row * rs_stride] : 1.f;
                bf16_t* rowp = O + (size_t)row * ldc + col0;
#pragma unroll
                for (int bj = 0; bj < 2; ++bj) { const f32x4 v0 = acc[ai][bj][m][0] * sc, v1 = acc[ai][bj][m][1] * sc;
                    u32x4 w; w.x = cvt_pk_bf16(v0[0], v0[1]); w.y = cvt_pk_bf16(v0[2], v0[3]); w.z = cvt_pk_bf16(v1[0], v1[1]); w.w = cvt_pk_bf16(v1[2], v1[3]);
                    *(u32x4*)(rowp + bj * HALF) = w; } }
    }
};
struct EpiResid {
    static constexpr bool PERM = false, AFTER_DRAIN = false;
    const float* hin; float* hout; float alpha; int pad;
    __device__ __forceinline__ void operator()(const f32x4 (&acc)[2][2][4][2], const Unit& u, int wr, int wc, int fr, int fq) const {
        const int row0 = u.pm * BM + wr * 64 + fr, col0 = u.pn * BM + wc * 32 + 4 * fq;
#pragma unroll
        for (int ai = 0; ai < 2; ++ai)
#pragma unroll
            for (int m = 0; m < 4; ++m) { const size_t off = (size_t)(row0 + ai * HALF + m * 16) * 1024 + col0;
#pragma unroll
                for (int bj = 0; bj < 2; ++bj)
#pragma unroll
                    for (int n = 0; n < 2; ++n) { const size_t i = off + bj * HALF + n * 16; const f32x4 h = *(const f32x4*)(hin + i); *(f32x4*)(hout + i) = h * alpha + acc[ai][bj][m][n]; } }
    }
};

template <int CTRL> __device__ __forceinline__ float pg_dpp(float x) { return __builtin_bit_cast(float, __builtin_amdgcn_update_dpp(0, __builtin_bit_cast(int, x), CTRL, 0xF, 0xF, true)); }
struct EpiConvAct {
    static constexpr bool PERM = true, AFTER_DRAIN = false;
    bf16_t* act; const bf16_t* halo; const float* cw; const float* cb; int dff; int seq;
    __device__ __forceinline__ void operator()(const f32x4 (&acc)[2][2][4][2], const Unit& u, int wr, int wc, int fr, int fq) const {
        typedef unsigned u32x2e __attribute__((ext_vector_type(2)));
#pragma unroll
        for (int n = 0; n < 2; ++n) {
            const int ch0 = u.pn * 128 + wc * 32 + 8 * fq + 4 * n;
            const f32x4 w0 = *(const f32x4*)(cw + ch0), w1 = *(const f32x4*)(cw + dff + ch0), w2 = *(const f32x4*)(cw + 2 * dff + ch0), bb = *(const f32x4*)(cb + ch0);
#pragma unroll
            for (int ai = 0; ai < 2; ++ai) {
                const int rb64 = u.pm * BM + ai * HALF + wr * 64;
                f32x4 P = {0.f, 0.f, 0.f, 0.f};
                if ((rb64 & (seq - 1)) != 0 && fr >= 14) { const u32x2e hv = *(const u32x2e*)(halo + (size_t)(2 * (rb64 / 64 - 1) + (fr - 14)) * dff + ch0);
                    P[0] = __builtin_bit_cast(float, hv.x << 16); P[1] = __builtin_bit_cast(float, hv.x & 0xffff0000u); P[2] = __builtin_bit_cast(float, hv.y << 16); P[3] = __builtin_bit_cast(float, hv.y & 0xffff0000u); }
#pragma unroll
                for (int m = 0; m < 4; ++m) {
                    const f32x4 Gv = acc[ai][0][m][n], Uv = acc[ai][1][m][n];
                    float o[4];
#pragma unroll
                    for (int e = 0; e < 4; ++e) {
                        const float t1 = pg_dpp<0x111>(Gv[e]), t2 = pg_dpp<0x112>(Gv[e]), p1 = pg_dpp<0x10F>(P[e]), p2 = pg_dpp<0x10E>(P[e]);
                        const float g1 = (fr >= 1) ? t1 : p1, g2 = (fr >= 2) ? t2 : p2;
                        const float y = bb[e] + w0[e] * g2 + w1[e] * g1 + w2[e] * Gv[e];
                        o[e] = y / (1.f + __expf(-y)) * Uv[e];
                    }
                    u32x2e w; w.x = cvt_pk_bf16(o[0], o[1]); w.y = cvt_pk_bf16(o[2], o[3]);
                    *(u32x2e*)(act + (size_t)(rb64 + m * 16 + fr) * dff + ch0) = w;
                    P = Gv;
                }
            }
        }
    }
};

template <class Epi, class Sched, bool ALIGN_EPI = false, bool SP2 = false>
__device__ __forceinline__ void gemm_phase(PG8_LAS unsigned char* lds, const Gemm g, const Sched& S, const Epi& E) {
    int tid = threadIdx.x; asm volatile("" : "+v"(tid));
    const int wid = __builtin_amdgcn_readfirstlane(tid >> 6), lane = tid & 63, wr = wid >> 2, wc = wid & 3, fr = lane & 15, fq = lane >> 4;
    const int K = g.K, nt = K / BK;
    unsigned voffA[2], voffB[2];
#pragma unroll
    for (int i = 0; i < 2; ++i) { int R, C; stage_rc(tid * 16 + i * 8192, R, C); const int Rb = Epi::PERM ? ((R & ~31) + perm32(R & 31)) : R;
        const int Ra = g.gatherA ? (64 * (R >> 1) + 62 + (R & 1)) : R;
        voffA[i] = (unsigned)(Ra * g.lda + C) * 2u; voffB[i] = (unsigned)(Rb * g.ldb + C) * 2u; }
    const size_t kstep = (size_t)(BK * 2);
    const size_t hstepA = (size_t)g.hrA * g.lda * 2, hstepB = (size_t)g.hrB * g.ldb * 2;
    const size_t tstepA = (size_t)g.trA * g.lda * 2, tstepB = (size_t)g.trB * g.ldb * 2;
    const unsigned ldsw = (unsigned)wid * 1024u;
    const int aoff = lds_byte(wr * 64 + fr, fq * 8), boff = lds_byte(wc * 32 + fr, fq * 8);
#define PG8_SA(b, h) (((b) * 2 + (h)) * HTB)
#define PG8_SB(b, h) ((4 + (b) * 2 + (h)) * HTB)
#define PG8_STAGE(bufoff, gbase, voff) do { _Pragma("unroll") for (int _i = 0; _i < 2; ++_i) \
        __builtin_amdgcn_global_load_lds((const unsigned*)((const char*)(gbase) + (voff)[_i]), (PG8_LAS unsigned*)(lds + (bufoff) + ldsw + _i * 8192), 16, 0, 0); } while (0)
#define PG8_LDA(dst, b, h) do { _Pragma("unroll") for (int m = 0; m < 4; ++m) _Pragma("unroll") for (int k = 0; k < 2; ++k) dst[m][k] = *(const PG8_LAS bf16x8*)(lds + PG8_SA(b, h) + aoff + m * 2048 + k * 1024); } while (0)
#define PG8_LDB(dst, b, h) do { _Pragma("unroll") for (int n = 0; n < 2; ++n) _Pragma("unroll") for (int k = 0; k < 2; ++k) dst[n][k] = *(const PG8_LAS bf16x8*)(lds + PG8_SB(b, h) + boff + n * 2048 + k * 1024); } while (0)
#define PG8_MMA(ai, bj, At, Bt) do { __builtin_amdgcn_s_setprio(1); _Pragma("unroll") for (int m = 0; m < 4; ++m) _Pragma("unroll") for (int n = 0; n < 2; ++n) _Pragma("unroll") for (int k = 0; k < 2; ++k) \
        acc[ai][bj][m][n] = __builtin_amdgcn_mfma_f32_16x16x32_bf16(Bt[n][k], At[m][k], acc[ai][bj][m][n], 0, 0, 0); __builtin_amdgcn_s_setprio(0); } while (0)
#define PG8_WAIT_V(n) asm volatile("s_waitcnt vmcnt(" #n ")" ::: "memory")
#define PG8_WAIT_L(n) asm volatile("s_waitcnt lgkmcnt(" #n ")" ::: "memory")
#define PG8_BAR __builtin_amdgcn_s_barrier()
#define PG8_SCHED __builtin_amdgcn_sched_barrier(0)
    Unit cur, nxt; int ui = 0;
    if (!S.next(0, cur)) return;
    f32x4 acc[2][2][4][2];
#pragma unroll
    for (int a = 0; a < 2; ++a)
#pragma unroll
        for (int b = 0; b < 2; ++b)
#pragma unroll
            for (int m = 0; m < 4; ++m)
#pragma unroll
                for (int n = 0; n < 2; ++n) acc[a][b][m][n] = (f32x4){0.f, 0.f, 0.f, 0.f};
    bf16x8 At[4][2], B0[2][2], B1[2][2];
    const char* cA = (const char*)g.A + (size_t)cur.pm * tstepA; const char* cB = (const char*)g.Bt + (size_t)cur.pn * tstepB;
    S.a_ready(cur);
    if constexpr (SP2) {
        PG8_STAGE(PG8_SB(0, 0), cB, voffB); PG8_STAGE(PG8_SB(0, 1), cB + hstepB, voffB); PG8_STAGE(PG8_SA(0, 0), cA, voffA); PG8_STAGE(PG8_SA(0, 1), cA + hstepA, voffA);
        if (wr == 1) PG8_BAR;
        PG8_WAIT_V(2); PG8_BAR;
        PG8_STAGE(PG8_SB(1, 0), cB + kstep, voffB); PG8_STAGE(PG8_SA(1, 0), cA + kstep, voffA); PG8_STAGE(PG8_SB(1, 1), cB + hstepB + kstep, voffB);
        PG8_WAIT_V(6); PG8_BAR;
    } else {
        PG8_STAGE(PG8_SB(0, 0), cB, voffB); PG8_STAGE(PG8_SA(0, 0), cA, voffA); PG8_STAGE(PG8_SB(0, 1), cB + hstepB, voffB); PG8_STAGE(PG8_SA(0, 1), cA + hstepA, voffA);
        if (wr == 1) PG8_BAR;
        PG8_WAIT_V(4); PG8_BAR;
        PG8_STAGE(PG8_SB(1, 0), cB + kstep, voffB); PG8_STAGE(PG8_SA(1, 0), cA + kstep, voffA); PG8_STAGE(PG8_SB(1, 1), cB + hstepB + kstep, voffB);
        PG8_WAIT_V(6); PG8_BAR;
    }
    for (;;) {
        const bool has_next = S.next(ui + 1, nxt);
        const char* nA = has_next ? (const char*)g.A + (size_t)nxt.pm * tstepA : cA; const char* nB = has_next ? (const char*)g.Bt + (size_t)nxt.pn * tstepB : cB;
        for (int t = 0; t < nt; t += 2) {
            const bool last = (t == nt - 2);
            const char* a1 = cA + (size_t)(t + 1) * kstep;
            const char* a2 = last ? nA : cA + (size_t)(t + 2) * kstep; const char* b2 = last ? nB : cB + (size_t)(t + 2) * kstep;
            const char* a3 = a2 + kstep; const char* b3 = b2 + kstep;
            if (last && has_next) S.a_ready(nxt);
            if constexpr (SP2) {
            PG8_LDB(B0, 0, 0); PG8_LDB(B1, 0, 1); PG8_SCHED; PG8_LDA(At, 0, 0); PG8_STAGE(PG8_SA(1, 1), a1 + hstepA, voffA);
            PG8_WAIT_V(8); PG8_WAIT_L(0); PG8_BAR; PG8_MMA(0, 0, At, B0); PG8_MMA(0, 1, At, B1); PG8_BAR; PG8_SCHED;
            PG8_LDA(At, 0, 1); PG8_STAGE(PG8_SB(0, 0), b2, voffB); PG8_STAGE(PG8_SB(0, 1), b2 + hstepB, voffB); PG8_STAGE(PG8_SA(0, 0), a2, voffA);
            PG8_WAIT_V(8); PG8_WAIT_L(0); PG8_BAR; PG8_MMA(1, 0, At, B0); PG8_MMA(1, 1, At, B1); PG8_BAR; PG8_SCHED;
            PG8_LDB(B0, 1, 0); PG8_LDB(B1, 1, 1); PG8_SCHED; PG8_LDA(At, 1, 0); PG8_STAGE(PG8_SA(0, 1), a2 + hstepA, voffA);
            PG8_WAIT_V(8); PG8_WAIT_L(0); PG8_BAR; PG8_MMA(0, 0, At, B0); PG8_MMA(0, 1, At, B1); PG8_BAR; PG8_SCHED;
            PG8_LDA(At, 1, 1); PG8_STAGE(PG8_SB(1, 0), b3, voffB); PG8_STAGE(PG8_SB(1, 1), b3 + hstepB, voffB); PG8_STAGE(PG8_SA(1, 0), a3, voffA);
            PG8_WAIT_V(8); PG8_WAIT_L(0); PG8_BAR; PG8_MMA(1, 0, At, B0); PG8_MMA(1, 1, At, B1); PG8_BAR; PG8_SCHED;
            } else {
            PG8_LDB(B0, 0, 0); PG8_SCHED; PG8_LDA(At, 0, 0); PG8_STAGE(PG8_SA(1, 1), a1 + hstepA, voffA);
            PG8_WAIT_L(8); PG8_BAR; PG8_WAIT_L(0); PG8_MMA(0, 0, At, B0); PG8_BAR; PG8_SCHED;
            PG8_LDB(B1, 0, 1); PG8_STAGE(PG8_SB(0, 0), b2, voffB);
            PG8_BAR; PG8_WAIT_L(0); PG8_MMA(0, 1, At, B1); PG8_BAR;
            PG8_LDA(At, 0, 1); PG8_STAGE(PG8_SA(0, 0), a2, voffA);
            PG8_BAR; PG8_WAIT_L(0); PG8_MMA(1, 0, At, B0); PG8_BAR; PG8_SCHED;
            PG8_STAGE(PG8_SB(0, 1), b2 + hstepB, voffB);
            PG8_WAIT_V(6); PG8_BAR; PG8_MMA(1, 1, At, B1); PG8_BAR;
            PG8_LDB(B0, 1, 0); PG8_SCHED; PG8_LDA(At, 1, 0); PG8_STAGE(PG8_SA(0, 1), a2 + hstepA, voffA);
            PG8_WAIT_L(8); PG8_BAR; PG8_WAIT_L(0); PG8_MMA(0, 0, At, B0); PG8_BAR; PG8_SCHED;
            PG8_LDB(B1, 1, 1); PG8_STAGE(PG8_SB(1, 0), b3, voffB);
            PG8_BAR; PG8_WAIT_L(0); PG8_MMA(0, 1, At, B1); PG8_BAR;
            PG8_LDA(At, 1, 1); PG8_STAGE(PG8_SA(1, 0), a3, voffA);
            PG8_BAR; PG8_WAIT_L(0); PG8_MMA(1, 0, At, B0); PG8_BAR; PG8_SCHED;
            PG8_STAGE(PG8_SB(1, 1), b3 + hstepB, voffB);
            PG8_WAIT_V(6); PG8_BAR; PG8_MMA(1, 1, At, B1); PG8_BAR;
            }
        }
        if constexpr (ALIGN_EPI) { if (wr == 0) PG8_BAR; }
        if constexpr (!Epi::AFTER_DRAIN) { E(acc, cur, wr, wc, fr, fq); S.done(cur); }
        if (!has_next) break;
#pragma unroll
        for (int a = 0; a < 2; ++a)
#pragma unroll
            for (int b = 0; b < 2; ++b)
#pragma unroll
                for (int m = 0; m < 4; ++m)
#pragma unroll
                    for (int n = 0; n < 2; ++n) acc[a][b][m][n] = (f32x4){0.f, 0.f, 0.f, 0.f};
        cur = nxt; cA = nA; cB = nB; ++ui;
        if constexpr (ALIGN_EPI) { if (wr == 1) PG8_BAR; }
    }
    PG8_WAIT_V(0);
    if constexpr (!ALIGN_EPI) { if (wr == 0) PG8_BAR; }
    PG8_BAR;
    if constexpr (Epi::AFTER_DRAIN) { E.fused(acc, cur, wr, wc, fr, fq, lds, wid, lane); S.done(cur); }
#undef PG8_SA
#undef PG8_SB
#undef PG8_STAGE
#undef PG8_LDA
#undef PG8_LDB
#undef PG8_MMA
#undef PG8_WAIT_V
#undef PG8_WAIT_L
#undef PG8_BAR
#undef PG8_SCHED
}
}
#define GAS __attribute__((address_space(1)))
#define LAS __attribute__((address_space(3)))
typedef unsigned short bf16;
typedef unsigned v4u __attribute__((ext_vector_type(4)));
typedef float f32x4 __attribute__((ext_vector_type(4)));
typedef short bf16x8 __attribute__((ext_vector_type(8)));
typedef GAS unsigned gu32;
typedef GAS unsigned long long gu64;
#define RLX_AGENT __ATOMIC_RELAXED, __HIP_MEMORY_SCOPE_AGENT
#define LDS_WAIT() asm volatile("s_waitcnt lgkmcnt(0)" ::: "memory")
#define VM_WAIT() asm volatile("s_waitcnt vmcnt(0)" ::: "memory")
__device__ __forceinline__ unsigned long long rt() { return __builtin_amdgcn_s_memrealtime(); }
__device__ __forceinline__ unsigned f2bf(float f) { unsigned u = __builtin_bit_cast(unsigned, f); return (u + 0x7fffu + ((u >> 16) & 1u)) >> 16; }
__device__ __forceinline__ unsigned pk2(float lo, float hi) { return f2bf(lo) | (f2bf(hi) << 16); }

#define XB_TMO      128
#define XB_XCNT(j)  (256  + 64 * (j))
#define XB_XSUB(j)  (1280 + 64 * (j))
#define XB_XGEN(j)  (2304 + 64 * (j))
#define XB_TOP      3328
#define XB_TOPGEN   3392
#define XCD_BAR_WORDS 3456
#define XB_SPIN_CAP (1u << 18)

__device__ __forceinline__ unsigned xb_ld(unsigned* p)              { return __hip_atomic_load(p, __ATOMIC_RELAXED, __HIP_MEMORY_SCOPE_AGENT); }
__device__ __forceinline__ unsigned xb_add(unsigned* p, unsigned v) { return __hip_atomic_fetch_add(p, v, __ATOMIC_RELAXED, __HIP_MEMORY_SCOPE_AGENT); }
__device__ __forceinline__ unsigned xb_xcc_id() { return (unsigned)__builtin_amdgcn_s_getreg((3 << 11) | 20) & 0xFu; }
#define XB_SPIN(cond, bar) do { unsigned _sp = 0; while (cond) { __builtin_amdgcn_s_sleep(1); \
    if ((++_sp & 255u) == 0u) { if (xb_ld(&(bar)[XB_TMO])) break; if (_sp > XB_SPIN_CAP) { atomicAdd(&(bar)[XB_TMO], 1u); break; } } } } while (0)

struct XcdBarrier {
    unsigned* bar; unsigned x;
    volatile LAS unsigned* st;
};

__device__ __forceinline__ XcdBarrier xcd_barrier_post(unsigned* bar, volatile LAS unsigned* st) {
    XcdBarrier b; b.bar = bar; b.x = xb_xcc_id(); b.st = st;
    if (threadIdx.x == 0) (void)xb_add(&bar[XB_XCNT(b.x)], 1u);
    return b;
}
__device__ __forceinline__ void xcd_barrier_complete(unsigned* bar, unsigned x, unsigned& nloc, unsigned& nx) {
    const unsigned G = gridDim.x * gridDim.y * gridDim.z;
    unsigned sum, cnt, mine, sp = 0u;
    for (;;) {
        sum = 0u; cnt = 0u; mine = 0u;
#pragma unroll
        for (unsigned j = 0; j < 16; ++j) { const unsigned c = xb_ld(&bar[XB_XCNT(j)]); sum += c; cnt += (c > 0u) ? 1u : 0u; mine = (j == x) ? c : mine; }
        if (sum == G) break;
        __builtin_amdgcn_s_sleep(1);
        if ((++sp & 255u) == 0u) { if (xb_ld(&bar[XB_TMO])) break; if (sp > XB_SPIN_CAP) { atomicAdd(&bar[XB_TMO], 1u); break; } }
    }
    nloc = mine > 0u ? mine : 1u; nx = cnt > 0u ? cnt : 1u;
}

__device__ __forceinline__ void xcd_barrier(const XcdBarrier& b) {
    asm volatile("s_waitcnt vmcnt(0)" ::: "memory");
    __syncthreads();
    if (threadIdx.x == 0) {
        unsigned* bar = b.bar;
        __builtin_amdgcn_s_waitcnt(0);
        unsigned nloc = b.st[0], nx = b.st[1];
        if (nloc == 0u) { xcd_barrier_complete(bar, b.x, nloc, nx); b.st[0] = nloc; b.st[1] = nx; }
        const unsigned old = xb_add(&bar[XB_XSUB(b.x)], 1u);
        const unsigned gen = old / nloc;
        if (old + 1u == (gen + 1u) * nloc) {
            __builtin_amdgcn_fence(__ATOMIC_RELEASE, "agent");
            asm volatile("s_waitcnt vmcnt(0)" ::: "memory");
            const unsigned og = xb_add(&bar[XB_TOP], 1u);
            const unsigned tg = og / nx;
            if (og + 1u == (tg + 1u) * nx) xb_add(&bar[XB_TOPGEN], 1u);
            else XB_SPIN(xb_ld(&bar[XB_TOPGEN]) == tg, bar);
            __builtin_amdgcn_fence(__ATOMIC_ACQUIRE, "agent");
            xb_add(&bar[XB_XGEN(b.x)], 1u);
            asm volatile("s_waitcnt vmcnt(0)" ::: "memory");
        } else {
            XB_SPIN(xb_ld(&bar[XB_XGEN(b.x)]) == gen, bar);
            __builtin_amdgcn_fence(__ATOMIC_ACQUIRE, "agent");
            asm volatile("s_waitcnt vmcnt(0)" ::: "memory");
        }
    }
    __syncthreads();
}
constexpr int NWAVES = 8;
constexpr int BATCH = 16, SEQ = 2048, DM = 1024, M = BATCH * SEQ;
constexpr int L0P = 3584;
constexpr int L1P = 2048;
constexpr int DFF = 2816;
constexpr float ALPHA = 1.4142135623730951f;
typedef unsigned short bf16_t;
typedef float f32x16 __attribute__((ext_vector_type(16)));

constexpr size_t MiB = 1u << 20;
constexpr size_t WS_CTL = 0, CTL_ZERO_BYTES = 1 * MiB;
constexpr int CW_BAR = 4096;
constexpr size_t WS_W0IN = 2 * MiB, WS_W0OUT = 9 * MiB, WS_WUP0 = 11 * MiB, WS_WDN0 = 22 * MiB, WS_W1IN = 28 * MiB, WS_WUQ = 32 * MiB, WS_WUKV = 33 * MiB,
                 WS_W1OUT = 34 * MiB, WS_WUP1 = 36 * MiB, WS_WDN1 = 47 * MiB;
constexpr size_t WS_XB = 56 * MiB, WS_YMIX = 120 * MiB, WS_BIG = 184 * MiB;
constexpr size_t WS_G = 408 * MiB, WS_BONUS = 440 * MiB, WS_DT = 441 * MiB, WS_XST = 442 * MiB, WS_BT = 474 * MiB, WS_ASUM = 490 * MiB;
constexpr size_t WS_SLOC = 120 * MiB;
constexpr size_t WS_W2T = 53 * MiB, WS_A2T = 53 * MiB + 256 * 1024, WS_G2T = 53 * MiB + 512 * 1024;
constexpr size_t WS_GU = 120 * MiB;
constexpr size_t WS_PROJ1 = 184 * MiB, WS_QM = 312 * MiB, WS_KVM = 360 * MiB, WS_KPE = 424 * MiB, WS_RS = 426 * MiB;
constexpr size_t WS_CSTAB = 492 * MiB;
constexpr size_t WS_VTS = 428 * MiB, WS_VTM = 460 * MiB;
constexpr size_t WS_NEED = 496 * MiB;

constexpr int RING_BYTES = 131072;
constexpr int LDSCTL_OFF = 146432, MISC_OFF = LDSCTL_OFF + 320;
constexpr int LDS_BYTES = 147456;

__device__ __forceinline__ float bf2f(bf16_t b) { return __builtin_bit_cast(float, (unsigned)b << 16); }
__device__ __forceinline__ float sigmoidf_(float x) { return 1.f / (1.f + expf(-x)); }
__device__ __forceinline__ float softplusf_(float x) { return fmaxf(x, 0.f) + log1pf(expf(-fabsf(x))); }
__device__ __forceinline__ float siluf_(float x) { return x / (1.f + expf(-x)); }
__device__ __forceinline__ float wave_sum(float v) {
#pragma unroll
    for (int o = 1; o < 64; o <<= 1) v += __shfl_xor(v, o);
    return v;
}
#define WSYNC() asm volatile("s_waitcnt lgkmcnt(0)" ::: "memory")
typedef float f32x2_t __attribute__((ext_vector_type(2)));
typedef __bf16 bf16x2_t __attribute__((ext_vector_type(2)));
typedef unsigned u32x2 __attribute__((ext_vector_type(2)));
__device__ __forceinline__ unsigned cvtpk(float lo, float hi) { f32x2_t v = {lo, hi}; bf16x2_t b = __builtin_convertvector(v, bf16x2_t); return __builtin_bit_cast(unsigned, b); }
__device__ __forceinline__ float bflo(unsigned u) { return __builtin_bit_cast(float, u << 16); }
__device__ __forceinline__ float bfhi(unsigned u) { return __builtin_bit_cast(float, u & 0xffff0000u); }
__device__ __forceinline__ bf16_t bf1(float x) { return (bf16_t)(cvtpk(x, x) & 0xffffu); }
template <int CTRL> __device__ __forceinline__ float dpp_mov(float x) { return __builtin_bit_cast(float, __builtin_amdgcn_update_dpp(0, __builtin_bit_cast(int, x), CTRL, 0xF, 0xF, true)); }
__device__ __forceinline__ float rowsum16(float x) { x += dpp_mov<0x128>(x); x += dpp_mov<0x124>(x); x += dpp_mov<0x122>(x); x += dpp_mov<0x121>(x); return x; }
__device__ __forceinline__ float rl(float x, int l) { return __builtin_bit_cast(float, __builtin_amdgcn_readlane(__builtin_bit_cast(int, x), l)); }
__device__ __forceinline__ float wave_sum_dpp(float x) { x = rowsum16(x); return (rl(x, 0) + rl(x, 16)) + (rl(x, 32) + rl(x, 48)); }

__device__ __forceinline__ void transpose_matrix(const float* __restrict__ W, int K, int N, bf16_t* __restrict__ WT, int Npad, int ldt, LAS float* scr, int gw, int NGW, int lane, const float* __restrict__ kscale, bool ffn_interleave = false) {
    (void)scr;
    const int nblk = Npad / 64, nit = (K / 64) * nblk;
    for (int it = gw; it < nit; it += NGW) {
        const int kb = it / nblk, nb = it - kb * nblk, n = nb * 64 + lane, k0 = kb * 64;
        const bool ok = n < N; const float* src = W + (size_t)k0 * N + (ok ? n : 0);
#pragma unroll
        for (int hc = 0; hc < 2; ++hc) {
            float v[32];
#pragma unroll
            for (int i = 0; i < 32; ++i) v[i] = src[(size_t)(hc * 32 + i) * N];
#pragma unroll
            for (int c = 0; c < 4; ++c) { float u[8];
#pragma unroll
                for (int i = 0; i < 8; ++i) { u[i] = ok ? v[c * 8 + i] : 0.f; if (kscale) u[i] *= kscale[k0 + hc * 32 + c * 8 + i]; }
                v4u o; o.x = cvtpk(u[0], u[1]); o.y = cvtpk(u[2], u[3]); o.z = cvtpk(u[4], u[5]); o.w = cvtpk(u[6], u[7]);
                const int nr = ffn_interleave ? ((n < DFF) ? 256 * (n >> 7) + (n & 127) : 256 * ((n - DFF) >> 7) + 128 + ((n - DFF) & 127)) : n;
                *(v4u*)(WT + (size_t)nr * ldt + k0 + hc * 32 + c * 8) = o; }
        }
    }
}

template <bool ST = true> __device__ __forceinline__ void ln_rows(float* h, bf16_t* hb, const float* __restrict__ g, const float* __restrict__ b, int gw, int NGW, int lane) {
    for (int row = gw * 2; row < M; row += NGW * 2) {
        float* p = h + (size_t)row * DM;
        f32x4 v[2][4]; float s[2] = {0.f, 0.f};
#pragma unroll
        for (int r = 0; r < 2; ++r)
#pragma unroll
            for (int j = 0; j < 4; ++j) v[r][j] = *(const f32x4*)(p + r * DM + 4 * lane + 256 * j);
#pragma unroll
        for (int r = 0; r < 2; ++r)
#pragma unroll
            for (int j = 0; j < 4; ++j) s[r] += (v[r][j][0] + v[r][j][1]) + (v[r][j][2] + v[r][j][3]);
        float mean[2], q[2] = {0.f, 0.f}, rstd[2];
#pragma unroll
        for (int r = 0; r < 2; ++r) { mean[r] = wave_sum_dpp(s[r]) * (1.f / DM);
#pragma unroll
            for (int j = 0; j < 4; ++j) { v[r][j] = v[r][j] - mean[r]; q[r] += (v[r][j][0] * v[r][j][0] + v[r][j][1] * v[r][j][1]) + (v[r][j][2] * v[r][j][2] + v[r][j][3] * v[r][j][3]); } }
#pragma unroll
        for (int r = 0; r < 2; ++r) rstd[r] = 1.0f / sqrtf(wave_sum_dpp(q[r]) * (1.f / DM) + 1e-5f);
#pragma unroll
        for (int j = 0; j < 4; ++j) {
            const int c = 4 * lane + 256 * j;
            const f32x4 gg = *(const f32x4*)(g + c), bb = *(const f32x4*)(b + c);
#pragma unroll
            for (int r = 0; r < 2; ++r) {
                const f32x4 o = v[r][j] * rstd[r] * gg + bb;
                uint2 w; w.x = cvtpk(o[0], o[1]); w.y = cvtpk(o[2], o[3]);
                if (ST) { *(f32x4*)(p + r * DM + c) = o; *(uint2*)(hb + (size_t)(row + r) * DM + c) = w; } else asm volatile("" :: "v"(w.x), "v"(w.y), "v"(o[0]), "v"(o[1]), "v"(o[2]), "v"(o[3]));
            }
        }
    }
}

__device__ __forceinline__ void rwkv_naive_chain(int chain, int lane, LAS float* sm, const bf16_t* __restrict__ proj, const float* __restrict__ mix, const float* __restrict__ w0, const float* __restrict__ w2,
                                                 const float* __restrict__ a0, const float* __restrict__ a2, const float* __restrict__ g2, const float* __restrict__ k_k,
                                                 const float* __restrict__ k_a, const float* __restrict__ r_k, const float* __restrict__ ln_g, const float* __restrict__ ln_b, bf16_t* __restrict__ ymix) {
    LAS float* s_w2 = sm; LAS float* s_a2 = sm + 4096; LAS float* s_g2 = sm + 8192; LAS float* s_tw = sm + 16384; LAS float* s_al = s_tw + 64; LAS float* s_sg = s_tw + 128;
    LAS float* s_w = s_tw + 256; LAS float* s_k = s_tw + 320; LAS float* s_a = s_tw + 384; LAS float* s_b = s_tw + 448; LAS float* s_r = s_tw + 512;
    const int b = chain >> 3, h = chain & 7, c = h * 64 + lane;
    for (int l = 0; l < 64; ++l) { s_w2[l * 64 + lane] = w2[l * 512 + c]; s_a2[l * 64 + lane] = a2[l * 512 + c]; }
    for (int l = 0; l < 128; ++l) s_g2[l * 64 + lane] = g2[l * 512 + c];
    const float mr = mix[c], mk = mix[512 + c], mv = mix[1024 + c], mw = mix[1536 + lane], ma = mix[1600 + lane], mg0 = mix[1664 + lane], mg1 = mix[1728 + lane];
    const float w0c = w0[c], a0c = a0[c], kkc = k_k[c], kac = k_a[c], rkc = r_k[c], lgc = ln_g[c], lbc = ln_b[c];
    float S[64];
#pragma unroll
    for (int j = 0; j < 64; ++j) S[j] = 0.f;
    float pr = 0.f, pk = 0.f, pv = 0.f, pw = 0.f, pa = 0.f, pg0 = 0.f, pg1 = 0.f;
    WSYNC();
    for (int t = 0; t < SEQ; ++t) {
        const bf16_t* row = proj + (size_t)(b * SEQ + t) * L0P;
        const float cr = bf2f(row[c]), ck = bf2f(row[512 + c]), cv = bf2f(row[1024 + c]), cw = bf2f(row[1536 + lane]), ca = bf2f(row[1600 + lane]),
                    cg0 = bf2f(row[1664 + lane]), cg1 = bf2f(row[1728 + lane]);
        const float r_s = cr + (pr - cr) * mr, k_s = ck + (pk - ck) * mk, v_s = cv + (pv - cv) * mv;
        const float wl = cw + (pw - cw) * mw, al = ca + (pa - ca) * ma, g0 = cg0 + (pg0 - cg0) * mg0, g1 = cg1 + (pg1 - cg1) * mg1;
        pr = cr; pk = ck; pv = cv; pw = cw; pa = ca; pg0 = cg0; pg1 = cg1;
        s_tw[lane] = tanhf(wl); s_al[lane] = al; s_sg[lane] = sigmoidf_(g0); s_sg[64 + lane] = sigmoidf_(g1);
        WSYNC();
        float wsum = w0c, asum = a0c, gsum = 0.f;
#pragma unroll 2
        for (int l = 0; l < 64; ++l) { wsum += s_tw[l] * s_w2[l * 64 + lane]; asum += s_al[l] * s_a2[l * 64 + lane]; }
#pragma unroll 2
        for (int l = 0; l < 128; ++l) gsum += s_sg[l] * s_g2[l * 64 + lane];
        const float log_w = -softplusf_(-wsum) - 0.5f;
        const float dec = expf(-expf(log_w));
        const float a = sigmoidf_(asum);
        float kkv = k_s * kkc;
        const float nrm = sqrtf(wave_sum(kkv * kkv));
        kkv = kkv / fmaxf(nrm, 1e-12f);
        const float k2 = k_s * (1.f + (a - 1.f) * kac);
        const float bonus_s = wave_sum(r_s * k2 * rkc);
        s_w[lane] = dec; s_k[lane] = k2; s_a[lane] = -kkv; s_b[lane] = kkv * a; s_r[lane] = r_s;
        WSYNC();
        float sa = 0.f;
#pragma unroll
        for (int j = 0; j < 64; ++j) sa += S[j] * s_a[j];
        float y = 0.f;
#pragma unroll
        for (int j = 0; j < 64; ++j) { S[j] = S[j] * s_w[j] + sa * s_b[j] + v_s * s_k[j]; y += S[j] * s_r[j]; }
        const float mu = wave_sum(y) * (1.f / 64.f);
        const float d = y - mu;
        const float var = wave_sum(d * d) * (1.f / 64.f);
        const float yn = d * (1.0f / sqrtf(var + 64e-5f)) * lgc + lbc;
        const float o = (yn + bonus_s * v_s) * gsum;
        ymix[(size_t)(b * SEQ + t) * DM + c] = (bf16_t)f2bf(o);
        WSYNC();
    }
}

__device__ __forceinline__ void ssm_conv_all(const bf16_t* __restrict__ proj, const float* __restrict__ cw, const float* __restrict__ cb, const float* __restrict__ dtb,
                                             bf16_t* __restrict__ xbc, float* __restrict__ dt, int gtid, int NT) {
    for (size_t i = gtid; i < (size_t)M * 1024; i += NT) {
        const int m = (int)(i >> 10), c = (int)(i & 1023), t = m & (SEQ - 1);
        float acc = cb[c];
#pragma unroll
        for (int k = 0; k < 4; ++k) { const int tt = t - 3 + k; if (tt >= 0) acc += cw[k * 1024 + c] * bf2f(proj[(size_t)(m - 3 + k) * L0P + 2304 + c]); }
        xbc[i] = (bf16_t)f2bf(siluf_(acc));
    }
    for (int i = gtid; i < M * 8; i += NT) dt[i] = softplusf_(bf2f(proj[(size_t)(i >> 3) * L0P + 3328 + (i & 7)]) + dtb[i & 7]);
}
__device__ __forceinline__ void ssd_naive_task(int task, int lane, const bf16_t* __restrict__ xbc, const float* __restrict__ dt, const float* __restrict__ a_log, const float* __restrict__ dsk, float* __restrict__ yssm) {
    const int chain = task >> 2, q = task & 3, b = chain >> 3, h = chain & 7, g = h >> 2, p = q * 16 + (lane >> 2), nq = lane & 3;
    const float A = -expf(a_log[h]), D = dsk[h];
    float st[32];
#pragma unroll
    for (int n = 0; n < 32; ++n) st[n] = 0.f;
    for (int t = 0; t < SEQ; ++t) {
        const size_t m = (size_t)b * SEQ + t;
        const float dtv = dt[m * 8 + h], dA = expf(dtv * A);
        const float x = bf2f(xbc[m * 1024 + h * 64 + p]), xdt = x * dtv;
        const bf16_t* Bp = xbc + m * 1024 + 512 + g * 128 + nq * 32;
        const bf16_t* Cp = xbc + m * 1024 + 768 + g * 128 + nq * 32;
        float yp = 0.f;
#pragma unroll
        for (int n = 0; n < 32; ++n) { st[n] = st[n] * dA + xdt * bf2f(Bp[n]); yp += st[n] * bf2f(Cp[n]); }
        yp += __shfl_xor(yp, 1); yp += __shfl_xor(yp, 2);
        if (nq == 0) yssm[m * 512 + h * 64 + p] = yp + D * x;
    }
}
template <bool ST = true> __device__ __forceinline__ void ssm_gate_norm_all(const bf16_t* __restrict__ yssm, const bf16_t* __restrict__ proj, const float* __restrict__ ng, bf16_t* __restrict__ ymix, int wv0, int wvend, int lane) {
    for (int wvb = wv0 * 4 - (wv0 & ~7) * 3; wvb < wvend; wvb += NWAVES * 4) {
        float u[4][4], q[4];
#pragma unroll
        for (int k = 0; k < 4; ++k) { const int wv = wvb + k, m = wv >> 1, g = wv & 1; q[k] = 0.f;
#pragma unroll
            for (int j = 0; j < 4; ++j) { const int c = g * 256 + j * 64 + lane; const float z = bf2f(proj[(size_t)m * L0P + 1792 + c]); u[k][j] = bf2f(yssm[(size_t)m * 512 + c]) * (z * __builtin_amdgcn_rcpf(1.f + __expf(-z))); q[k] += u[k][j] * u[k][j]; } }
#pragma unroll
        for (int k = 0; k < 4; ++k) { const int wv = wvb + k, m = wv >> 1, g = wv & 1;
            const float rs = __builtin_amdgcn_rsqf(wave_sum_dpp(q[k]) * (1.f / 256.f) + 1e-5f);
#pragma unroll
            for (int j = 0; j < 4; ++j) { const int c = g * 256 + j * 64 + lane; const float o_ = u[k][j] * rs * ng[c]; if (ST) ymix[(size_t)m * DM + 512 + c] = bf1(o_); else asm volatile("" :: "v"(o_)); } }
    }
}
template <bool ST = true> __device__ __forceinline__ void ffn_act_all(bf16_t* gu, const float* __restrict__ cw, const float* __restrict__ cb, int gtid, int NT) {
    constexpr int NCH = DFF / 8, NSTRIP = M / 32;
    for (int task = gtid; task < NSTRIP * NCH; task += NT) {
        const int strip = task / NCH, q = task - strip * NCH, c0 = q * 8, m0 = strip * 32;
        float w0[8], w1[8], w2[8], bb[8], g2[8], g1[8];
#pragma unroll
        for (int j = 0; j < 8; j += 4) { const f32x4 a = *(const f32x4*)(cw + c0 + j), b = *(const f32x4*)(cw + DFF + c0 + j), c = *(const f32x4*)(cw + 2 * DFF + c0 + j), d = *(const f32x4*)(cb + c0 + j);
#pragma unroll
            for (int k = 0; k < 4; ++k) { w0[j + k] = a[k]; w1[j + k] = b[k]; w2[j + k] = c[k]; bb[j + k] = d[k]; } }
        bf16_t* base = gu + (size_t)m0 * (2 * DFF) + c0;
        if ((m0 & (SEQ - 1)) != 0) { const v4u a = *(const v4u*)(base - 2 * (2 * DFF)), b = *(const v4u*)(base - (2 * DFF));
            g2[0] = bflo(a.x); g2[1] = bfhi(a.x); g2[2] = bflo(a.y); g2[3] = bfhi(a.y); g2[4] = bflo(a.z); g2[5] = bfhi(a.z); g2[6] = bflo(a.w); g2[7] = bfhi(a.w);
            g1[0] = bflo(b.x); g1[1] = bfhi(b.x); g1[2] = bflo(b.y); g1[3] = bfhi(b.y); g1[4] = bflo(b.z); g1[5] = bfhi(b.z); g1[6] = bflo(b.w); g1[7] = bfhi(b.w); }
        else {
#pragma unroll
            for (int j = 0; j < 8; ++j) { g2[j] = 0.f; g1[j] = 0.f; } }
#pragma unroll 4
        for (int r = 0; r < 32; ++r) {
            const v4u gv = *(const v4u*)(base + (size_t)r * (2 * DFF)), uv = *(const v4u*)(base + (size_t)r * (2 * DFF) + DFF);
            const unsigned gw_[4] = {gv.x, gv.y, gv.z, gv.w}, uw_[4] = {uv.x, uv.y, uv.z, uv.w};
            unsigned ow[4];
#pragma unroll
            for (int k = 0; k < 4; ++k) {
                const float ga = bflo(gw_[k]), gb = bfhi(gw_[k]);
                const float ya = bb[2 * k] + w0[2 * k] * g2[2 * k] + w1[2 * k] * g1[2 * k] + w2[2 * k] * ga;
                const float yb = bb[2 * k + 1] + w0[2 * k + 1] * g2[2 * k + 1] + w1[2 * k + 1] * g1[2 * k + 1] + w2[2 * k + 1] * gb;
                g2[2 * k] = g1[2 * k]; g1[2 * k] = ga; g2[2 * k + 1] = g1[2 * k + 1]; g1[2 * k + 1] = gb;
                ow[k] = cvtpk(ya / (1.f + __expf(-ya)) * bflo(uw_[k]), yb / (1.f + __expf(-yb)) * bfhi(uw_[k]));
            }
            if (ST) *(v4u*)(base + (size_t)r * (2 * DFF) + DFF) = (v4u){ow[0], ow[1], ow[2], ow[3]}; else asm volatile("" :: "v"(ow[0]), "v"(ow[1]), "v"(ow[2]), "v"(ow[3]));
        }
    }
}
template <bool ST = true> __device__ __forceinline__ void mla_prep_all(const bf16_t* __restrict__ proj1, const int* __restrict__ pos, float* __restrict__ rs, bf16_t* __restrict__ kpe, float* __restrict__ cstab, int gw, int NGW, int lane) {
    for (int m = gw; m < M; m += NGW) {
        const bf16_t* row = proj1 + (size_t)m * L1P;
        float q = 0.f;
#pragma unroll
        for (int j = 0; j < 4; ++j) { const float v = bf2f(row[1536 + j * 64 + lane]); q += v * v; }
        q = wave_sum(q);
        float k = 0.f;
#pragma unroll
        for (int j = 0; j < 2; ++j) { const float v = bf2f(row[1792 + j * 64 + lane]); k += v * v; }
        k = wave_sum(k);
        if (ST && lane == 0) { rs[(size_t)m * 2] = 1.0f / sqrtf(q * (1.f / 256.f) + 1e-6f); rs[(size_t)m * 2 + 1] = 1.0f / sqrtf(k * (1.f / 128.f) + 1e-6f); }
        if (lane < 16) {
            const double inv = pow(10000.0, -(double)(2 * lane) / 32.0);
            const double ang = (double)pos[m] * inv;
            const float cs = (float)cos(ang), sn = (float)sin(ang);
            if (ST) { cstab[(size_t)m * 32 + lane] = cs; cstab[(size_t)m * 32 + 16 + lane] = sn; }
            const float x1 = bf2f(row[1920 + lane]), x2 = bf2f(row[1936 + lane]);
            const bf16_t r1_ = (bf16_t)f2bf(x1 * cs - x2 * sn), r2_ = (bf16_t)f2bf(x2 * cs + x1 * sn);
            if (ST) { kpe[(size_t)m * 32 + lane] = r1_; kpe[(size_t)m * 32 + 16 + lane] = r2_; } else asm volatile("" :: "v"((unsigned)r1_), "v"((unsigned)r2_), "v"(q), "v"(k));
        }
    }
}
template <bool ST = true> __device__ __forceinline__ void rope_q_all(bf16_t* qm, const float* __restrict__ cstab, int gtid, int NT) {
    for (int i = gtid; i < M * 16; i += NT) {
        const int m = i >> 4, h = (i >> 1) & 7, k0 = (i & 1) * 8;
        bf16_t* p = qm + (size_t)m * 768 + h * 96 + 64 + k0;
        const v4u a = *(const v4u*)p, b = *(const v4u*)(p + 16);
        const f32x4 c0 = *(const f32x4*)(cstab + (size_t)m * 32 + k0), c1 = *(const f32x4*)(cstab + (size_t)m * 32 + k0 + 4), s0 = *(const f32x4*)(cstab + (size_t)m * 32 + 16 + k0), s1 = *(const f32x4*)(cstab + (size_t)m * 32 + 16 + k0 + 4);
        const unsigned au[4] = {a.x, a.y, a.z, a.w}, bu[4] = {b.x, b.y, b.z, b.w};
        const float cs[8] = {c0[0], c0[1], c0[2], c0[3], c1[0], c1[1], c1[2], c1[3]}, sn[8] = {s0[0], s0[1], s0[2], s0[3], s1[0], s1[1], s1[2], s1[3]};
        unsigned o1[4], o2[4];
#pragma unroll
        for (int q = 0; q < 4; ++q) { const float x1a = bflo(au[q]), x1b = bfhi(au[q]), x2a = bflo(bu[q]), x2b = bfhi(bu[q]);
            o1[q] = cvtpk(x1a * cs[2 * q] - x2a * sn[2 * q], x1b * cs[2 * q + 1] - x2b * sn[2 * q + 1]);
            o2[q] = cvtpk(x2a * cs[2 * q] + x1a * sn[2 * q], x2b * cs[2 * q + 1] + x1b * sn[2 * q + 1]); }
        if (ST) { *(v4u*)p = (v4u){o1[0], o1[1], o1[2], o1[3]}; *(v4u*)(p + 16) = (v4u){o2[0], o2[1], o2[2], o2[3]}; }
    }
}
__device__ __forceinline__ void sb_naive_task(int qblk, int bh, int lane, const bf16_t* __restrict__ proj1, bf16_t* __restrict__ ymix) {
    const int b = bh >> 3, h = bh & 7, t = qblk * 64 + lane;
    const size_t mrow = (size_t)b * SEQ;
    float q[64], o[64];
#pragma unroll
    for (int d = 0; d < 64; ++d) { q[d] = bf2f(proj1[(mrow + t) * L1P + h * 64 + d]) * 0.125f; o[d] = 0.f; }
    float cum = 0.f;
    const int smax = qblk * 64 + 63;
    for (int s = smax - 1; s >= 0; --s) {
        const bf16_t* kr = proj1 + (mrow + s) * L1P + 512 + h * 64;
        const bf16_t* vr = proj1 + (mrow + s) * L1P + 1024 + h * 64;
        float z = 0.f;
#pragma unroll
        for (int d = 0; d < 64; ++d) z += q[d] * bf2f(kr[d]);
        if (s < t) {
            const float lsp = -softplusf_(-z);
            const float lsn = -softplusf_(z);
            const float att = expf(lsp + cum);
            cum += lsn;
#pragma unroll
            for (int d = 0; d < 64; ++d) o[d] += att * bf2f(vr[d]);
        }
    }
#pragma unroll
    for (int d = 0; d < 64; ++d) ymix[(mrow + t) * DM + h * 64 + d] = (bf16_t)f2bf(o[d]);
}
__device__ __forceinline__ void mla_naive_task(int qblk, int bh, int lane, const bf16_t* __restrict__ qm, const bf16_t* __restrict__ kvm, const bf16_t* __restrict__ kpe, bf16_t* __restrict__ ymix) {
    const int b = bh >> 3, h = bh & 7, t = qblk * 64 + lane;
    const size_t mrow = (size_t)b * SEQ;
    const float scale = 0.10206207261596577f;
    float q[96], o[64];
#pragma unroll
    for (int d = 0; d < 96; ++d) q[d] = bf2f(qm[(mrow + t) * 768 + h * 96 + d]) * scale;
#pragma unroll
    for (int d = 0; d < 64; ++d) o[d] = 0.f;
    float mx = -1e30f, l = 0.f;
    const int smax = qblk * 64 + 63;
    for (int s = 0; s <= smax; ++s) {
        const bf16_t* kr = kvm + (mrow + s) * 1024 + h * 128;
        const bf16_t* pr = kpe + (mrow + s) * 32;
        float z = 0.f;
#pragma unroll
        for (int d = 0; d < 64; ++d) z += q[d] * bf2f(kr[d]);
#pragma unroll
        for (int d = 0; d < 32; ++d) z += q[64 + d] * bf2f(pr[d]);
        if (s <= t) {
            const float mn = fmaxf(mx, z), f = expf(mx - mn), pz = expf(z - mn);
            l = l * f + pz; mx = mn;
#pragma unroll
            for (int d = 0; d < 64; ++d) o[d] = o[d] * f + pz * bf2f(kr[64 + d]);
        }
    }
    const float il = 1.f / l;
#pragma unroll
    for (int d = 0; d < 64; ++d) ymix[(mrow + t) * DM + 512 + h * 64 + d] = (bf16_t)f2bf(o[d] * il);
}


__device__ __forceinline__ int crow(int r, int hi) { return (r & 3) + 8 * (r >> 2) + 4 * hi; }
#define MFMA32(a, b, c) __builtin_amdgcn_mfma_f32_32x32x16_bf16((a), (b), (c), 0, 0, 0)
constexpr int STG_PITCH = 72;
__device__ __forceinline__ void transpose_tile64(const bf16_t* __restrict__ src, int sp, bf16_t* __restrict__ dst, int dp, LAS bf16_t* scr, int lane) {
#pragma unroll
    for (int i = 0; i < 8; ++i) { const int row = i * 8 + (lane >> 3), ch = lane & 7; const v4u v = *(const v4u*)(src + (size_t)row * sp + ch * 8); *(LAS v4u*)(scr + row * STG_PITCH + ch * 8) = v; }
    WSYNC();
#pragma unroll
    for (int i = 0; i < 8; ++i) { const int d = i * 8 + (lane >> 3), tc = lane & 7; const LAS bf16_t* p = scr + (tc * 8) * STG_PITCH + d;
        v4u o; o.x = (unsigned)p[0] | ((unsigned)p[STG_PITCH] << 16); o.y = (unsigned)p[2 * STG_PITCH] | ((unsigned)p[3 * STG_PITCH] << 16);
        o.z = (unsigned)p[4 * STG_PITCH] | ((unsigned)p[5 * STG_PITCH] << 16); o.w = (unsigned)p[6 * STG_PITCH] | ((unsigned)p[7 * STG_PITCH] << 16);
        *(v4u*)(dst + (size_t)d * dp + tc * 8) = o; }
    WSYNC();
}
__device__ __forceinline__ void store_OT(const f32x16 (&o)[2], float sc, LAS bf16_t* stg, bf16_t* __restrict__ dst, int lane) {
    const int l31 = lane & 31, hi = lane >> 5;
#pragma unroll
    for (int dt = 0; dt < 2; ++dt)
#pragma unroll
        for (int r = 0; r < 16; ++r) stg[l31 * STG_PITCH + 32 * dt + crow(r, hi)] = (bf16_t)f2bf(o[dt][r] * sc);
    WSYNC();
#pragma unroll
    for (int i = 0; i < 4; ++i) { const int row = i * 8 + (lane >> 3), ch = lane & 7; const v4u v = *(const LAS v4u*)(stg + row * STG_PITCH + ch * 8); *(v4u*)(dst + (size_t)row * DM + ch * 8) = v; }
    WSYNC();
}
__device__ __forceinline__ float softplus_fast(float z) { return fmaxf(z, 0.f) + __logf(1.f + __expf(-fabsf(z))); }

__device__ __forceinline__ void sb_task(int bh, int qblk, int lane, const bf16_t* __restrict__ P1, const bf16_t* __restrict__ VT, bf16_t* __restrict__ ymix, LAS bf16_t* stg) {
    const int b = bh >> 3, h = bh & 7, l31 = lane & 31, hi = lane >> 5, q0 = qblk * 32, t = q0 + l31;
    const size_t rowb = (size_t)b * SEQ;
    const bf16_t* Qp = P1 + (rowb + q0 + l31) * L1P + h * 64 + 8 * hi;
    bf16x8 qf[4];
#pragma unroll
    for (int kk = 0; kk < 4; ++kk) qf[kk] = *(const bf16x8*)(Qp + 16 * kk);
    const bf16_t* Kp = P1 + (rowb + l31) * L1P + 512 + h * 64 + 8 * hi;
    const bf16_t* Vp = VT + ((size_t)bh * 64 + l31) * SEQ + 4 * hi;
    f32x16 o[2];
#pragma unroll
    for (int r = 0; r < 16; ++r) { o[0][r] = 0.f; o[1][r] = 0.f; }
    float cum = 0.f;
    bf16x8 kf[4]; u32x2 va[2][2][2];
#define SB_LOAD(S0, KF, VA) do { _Pragma("unroll") for (int kk = 0; kk < 4; ++kk) KF[kk] = *(const bf16x8*)(Kp + (size_t)(S0) * L1P + 16 * kk); \
        _Pragma("unroll") for (int dt = 0; dt < 2; ++dt) _Pragma("unroll") for (int ks = 0; ks < 2; ++ks) { VA[dt][ks][0] = *(const u32x2*)(Vp + (size_t)dt * 32 * SEQ + (S0) + 16 * ks); VA[dt][ks][1] = *(const u32x2*)(Vp + (size_t)dt * 32 * SEQ + (S0) + 16 * ks + 8); } } while (0)
    SB_LOAD(q0, kf, va);
    for (int s0 = q0; s0 >= 0; s0 -= 32) {
        bf16x8 kn[4]; u32x2 vn[2][2][2];
        const int sn = (s0 >= 32) ? s0 - 32 : 0;
        SB_LOAD(sn, kn, vn);
        f32x16 acc;
#pragma unroll
        for (int r = 0; r < 16; ++r) acc[r] = 0.f;
#pragma unroll
        for (int kk = 0; kk < 4; ++kk) acc = MFMA32(kf[kk], qf[kk], acc);
        const bool diag = (s0 == q0);
        float lb[16], lk[16];
#pragma unroll
        for (int r = 0; r < 16; ++r) { const float z = acc[r] * 0.125f; const float sp = softplus_fast(z); float b_ = z - sp, k_ = -sp;
            if (diag) { const bool valid = (s0 + crow(r, hi)) < t; b_ = valid ? b_ : -1e30f; k_ = valid ? k_ : 0.f; }
            lb[r] = b_; lk[r] = k_; }
        float e[16], T[4], U[4];
#pragma unroll
        for (int i = 0; i < 4; ++i) { e[4 * i + 3] = 0.f; e[4 * i + 2] = lk[4 * i + 3]; e[4 * i + 1] = e[4 * i + 2] + lk[4 * i + 2]; e[4 * i] = e[4 * i + 1] + lk[4 * i + 1]; T[i] = e[4 * i] + lk[4 * i]; }
#pragma unroll
        for (int i = 0; i < 4; ++i) U[i] = __shfl_xor(T[i], 32);
        float off[4];
        { const float st2 = T[3], st1 = st2 + T[2], st0 = st1 + T[1]; const float su2 = U[3], su1 = su2 + U[2], su0 = su1 + U[1];
          const float x0 = hi ? 0.f : U[0], x1 = hi ? 0.f : U[1], x2 = hi ? 0.f : U[2], x3 = hi ? 0.f : U[3];
          off[3] = x3; off[2] = st2 + su2 + x2; off[1] = st1 + su1 + x1; off[0] = st0 + su0 + x0;
          const float total = st0 + T[0] + su0 + U[0];
#pragma unroll
          for (int r = 0; r < 16; ++r) acc[r] = __expf(lb[r] + (cum + off[r >> 2] + e[r]));
          cum += total; }
        bf16x8 pf[2];
#pragma unroll
        for (int ks = 0; ks < 2; ++ks) { v4u w; w.x = cvtpk(acc[8 * ks], acc[8 * ks + 1]); w.y = cvtpk(acc[8 * ks + 2], acc[8 * ks + 3]); w.z = cvtpk(acc[8 * ks + 4], acc[8 * ks + 5]); w.w = cvtpk(acc[8 * ks + 6], acc[8 * ks + 7]); pf[ks] = __builtin_bit_cast(bf16x8, w); }
#pragma unroll
        for (int dt = 0; dt < 2; ++dt)
#pragma unroll
            for (int ks = 0; ks < 2; ++ks) { v4u a; a.x = va[dt][ks][0].x; a.y = va[dt][ks][0].y; a.z = va[dt][ks][1].x; a.w = va[dt][ks][1].y; o[dt] = MFMA32(__builtin_bit_cast(bf16x8, a), pf[ks], o[dt]); }
        if (__all(cum < -110.f)) break;
#pragma unroll
        for (int kk = 0; kk < 4; ++kk) kf[kk] = kn[kk];
#pragma unroll
        for (int dt = 0; dt < 2; ++dt)
#pragma unroll
            for (int ks = 0; ks < 2; ++ks) { va[dt][ks][0] = vn[dt][ks][0]; va[dt][ks][1] = vn[dt][ks][1]; }
    }
#undef SB_LOAD
    store_OT(o, 1.0f, stg, ymix + (rowb + q0) * DM + h * 64, lane);
}
__device__ __forceinline__ void mla_task(int bh, int qblk, int lane, const bf16_t* __restrict__ QM, const bf16_t* __restrict__ KVM, const bf16_t* __restrict__ KPE, const bf16_t* __restrict__ VT,
                                         bf16_t* __restrict__ ymix, LAS bf16_t* stg) {
    const int b = bh >> 3, h = bh & 7, l31 = lane & 31, hi = lane >> 5, q0 = qblk * 32, t = q0 + l31;
    const size_t rowb = (size_t)b * SEQ;
    const bf16_t* Qp = QM + (rowb + q0 + l31) * 768 + h * 96 + 8 * hi;
    bf16x8 qf[6];
#pragma unroll
    for (int kk = 0; kk < 6; ++kk) qf[kk] = *(const bf16x8*)(Qp + 16 * kk);
    const bf16_t* Kn = KVM + (rowb + l31) * 1024 + h * 128 + 8 * hi;
    const bf16_t* Kr = KPE + (rowb + l31) * 32 + 8 * hi;
    const bf16_t* Vp = VT + ((size_t)bh * 64 + l31) * SEQ + 4 * hi;
    const float sc2 = 0.10206207261596577f * 1.4426950408889634f;
    f32x16 o[2];
#pragma unroll
    for (int r = 0; r < 16; ++r) { o[0][r] = 0.f; o[1][r] = 0.f; }
    float mrun = -1e30f, lsum = 0.f;
    bf16x8 kf[6]; u32x2 va[2][2][2];
#define ML_LOAD(S0, KF, VA) do { _Pragma("unroll") for (int kk = 0; kk < 4; ++kk) KF[kk] = *(const bf16x8*)(Kn + (size_t)(S0) * 1024 + 16 * kk); \
        _Pragma("unroll") for (int kk = 0; kk < 2; ++kk) KF[4 + kk] = *(const bf16x8*)(Kr + (size_t)(S0) * 32 + 16 * kk); \
        _Pragma("unroll") for (int dt = 0; dt < 2; ++dt) _Pragma("unroll") for (int ks = 0; ks < 2; ++ks) { VA[dt][ks][0] = *(const u32x2*)(Vp + (size_t)dt * 32 * SEQ + (S0) + 16 * ks); VA[dt][ks][1] = *(const u32x2*)(Vp + (size_t)dt * 32 * SEQ + (S0) + 16 * ks + 8); } } while (0)
    ML_LOAD(0, kf, va);
    for (int s0 = 0; s0 <= q0; s0 += 32) {
        bf16x8 kn[6]; u32x2 vn[2][2][2];
        const int sn = (s0 + 32 <= q0) ? s0 + 32 : s0;
        ML_LOAD(sn, kn, vn);
        f32x16 acc;
#pragma unroll
        for (int r = 0; r < 16; ++r) acc[r] = 0.f;
#pragma unroll
        for (int kk = 0; kk < 6; ++kk) acc = MFMA32(kf[kk], qf[kk], acc);
        const bool diag = (s0 == q0);
        float tmax = -1e30f;
#pragma unroll
        for (int r = 0; r < 16; ++r) { float z = acc[r] * sc2; if (diag && (s0 + crow(r, hi)) > t) z = -1e30f; acc[r] = z; tmax = fmaxf(tmax, z); }
        tmax = fmaxf(tmax, __shfl_xor(tmax, 32));
        const float mn = fmaxf(mrun, tmax), alpha = exp2f(mrun - mn); mrun = mn;
        float ps = 0.f;
#pragma unroll
        for (int r = 0; r < 16; ++r) { acc[r] = exp2f(acc[r] - mn); ps += acc[r]; }
        lsum = lsum * alpha + ps;
#pragma unroll
        for (int r = 0; r < 16; ++r) { o[0][r] *= alpha; o[1][r] *= alpha; }
        bf16x8 pf[2];
#pragma unroll
        for (int ks = 0; ks < 2; ++ks) { v4u w; w.x = cvtpk(acc[8 * ks], acc[8 * ks + 1]); w.y = cvtpk(acc[8 * ks + 2], acc[8 * ks + 3]); w.z = cvtpk(acc[8 * ks + 4], acc[8 * ks + 5]); w.w = cvtpk(acc[8 * ks + 6], acc[8 * ks + 7]); pf[ks] = __builtin_bit_cast(bf16x8, w); }
#pragma unroll
        for (int dt = 0; dt < 2; ++dt)
#pragma unroll
            for (int ks = 0; ks < 2; ++ks) { v4u a; a.x = va[dt][ks][0].x; a.y = va[dt][ks][0].y; a.z = va[dt][ks][1].x; a.w = va[dt][ks][1].y; o[dt] = MFMA32(__builtin_bit_cast(bf16x8, a), pf[ks], o[dt]); }
#pragma unroll
        for (int kk = 0; kk < 6; ++kk) kf[kk] = kn[kk];
#pragma unroll
        for (int dt = 0; dt < 2; ++dt)
#pragma unroll
            for (int ks = 0; ks < 2; ++ks) { va[dt][ks][0] = vn[dt][ks][0]; va[dt][ks][1] = vn[dt][ks][1]; }
    }
#undef ML_LOAD
    lsum += __shfl_xor(lsum, 32);
    store_OT(o, 1.0f / lsum, stg, ymix + (rowb + q0) * DM + 512 + h * 64, lane);
}


constexpr int MLK_PITCH = 104, MLV_PITCH = 68, MLK_BYTES = 64 * MLK_PITCH * 2, MLV_BYTES = 64 * MLV_PITCH * 2, ML_STAGE = MLK_BYTES + MLV_BYTES;
__device__ __forceinline__ void mla_block(int bh, int sb, int tid, int lane, int wave, LAS unsigned char* lds, const bf16_t* __restrict__ QM, const bf16_t* __restrict__ KVM, const bf16_t* __restrict__ KPE,
                                          const bf16_t* __restrict__ VT, bf16_t* __restrict__ ymix) {
    const int b = bh >> 3, h = bh & 7, l31 = lane & 31, hi = lane >> 5, q0 = 256 * sb + 32 * wave, t = q0 + l31;
    const size_t rowb = (size_t)b * SEQ;
    const int nsteps = 4 * sb + 4;
    bf16x8 qf[6];
    { const bf16_t* Qp = QM + (rowb + q0 + l31) * 768 + h * 96 + 8 * hi;
#pragma unroll
      for (int kk = 0; kk < 6; ++kk) qf[kk] = *(const bf16x8*)(Qp + 16 * kk); }
    const float sc2 = 0.10206207261596577f * 1.4426950408889634f;
    f32x16 o[2];
#pragma unroll
    for (int r = 0; r < 16; ++r) { o[0][r] = 0.f; o[1][r] = 0.f; }
    float mrun = -1e30f, lsum = 0.f;
    const bf16_t* gKn = KVM + (rowb + (tid >> 3)) * 1024 + h * 128 + (tid & 7) * 8;
    const bf16_t* gKr = KPE + (rowb + ((tid & 255) >> 2)) * 32 + (tid & 3) * 8;
    const bf16_t* gVt = VT + ((size_t)bh * 64 + (tid >> 3)) * SEQ + (tid & 7) * 8;
    const int lKn = (tid >> 3) * (MLK_PITCH * 2) + (tid & 7) * 16, lKr = ((tid & 255) >> 2) * (MLK_PITCH * 2) + 128 + (tid & 3) * 16, lVt = MLK_BYTES + (tid >> 3) * (MLV_PITCH * 2) + (tid & 7) * 16;
    v4u rk, rr, rv;
    rk = *(const v4u*)gKn; rr = *(const v4u*)gKr; rv = *(const v4u*)gVt;
    *(LAS v4u*)(lds + lKn) = rk; if (tid < 256) *(LAS v4u*)(lds + lKr) = rr; *(LAS u32x2*)(lds + lVt) = (u32x2){rv.x, rv.y}; *(LAS u32x2*)(lds + lVt + 8) = (u32x2){rv.z, rv.w};
    __syncthreads();
#pragma unroll 1
    for (int step = 0; step < nsteps; ++step) {
        const int nx = (step + 1 < nsteps) ? step + 1 : step;
        rk = *(const v4u*)(gKn + (size_t)nx * 64 * 1024); rr = *(const v4u*)(gKr + (size_t)nx * 64 * 32); rv = *(const v4u*)(gVt + nx * 64);
        const LAS unsigned char* Kb = lds + (step & 1) * ML_STAGE;
        const LAS unsigned char* Vb = Kb + MLK_BYTES;
#pragma unroll
        for (int sub = 0; sub < 2; ++sub) {
            const int s0 = 64 * step + 32 * sub;
            if (s0 <= q0) {
                f32x16 acc;
#pragma unroll
                for (int r = 0; r < 16; ++r) acc[r] = 0.f;
#pragma unroll
                for (int kk = 0; kk < 6; ++kk) { const bf16x8 kf = *(const LAS bf16x8*)(Kb + (32 * sub + l31) * (MLK_PITCH * 2) + (16 * kk + 8 * hi) * 2); acc = MFMA32(kf, qf[kk], acc); }
                const bool diag = (s0 == q0);
                float tmax = -1e30f;
#pragma unroll
                for (int r = 0; r < 16; ++r) { float z = acc[r] * sc2; if (diag && (s0 + crow(r, hi)) > t) z = -1e30f; acc[r] = z; tmax = fmaxf(tmax, z); }
                tmax = fmaxf(tmax, __shfl_xor(tmax, 32));
                const float mn = fmaxf(mrun, tmax), alpha = __builtin_amdgcn_exp2f(mrun - mn); mrun = mn;
                float ps = 0.f;
#pragma unroll
                for (int r = 0; r < 16; ++r) { acc[r] = __builtin_amdgcn_exp2f(acc[r] - mn); ps += acc[r]; }
                lsum = lsum * alpha + ps;
#pragma unroll
                for (int r = 0; r < 16; ++r) { o[0][r] *= alpha; o[1][r] *= alpha; }
                bf16x8 pf[2];
#pragma unroll
                for (int ks = 0; ks < 2; ++ks) { v4u w; w.x = cvtpk(acc[8 * ks], acc[8 * ks + 1]); w.y = cvtpk(acc[8 * ks + 2], acc[8 * ks + 3]); w.z = cvtpk(acc[8 * ks + 4], acc[8 * ks + 5]); w.w = cvtpk(acc[8 * ks + 6], acc[8 * ks + 7]); pf[ks] = __builtin_bit_cast(bf16x8, w); }
#pragma unroll
                for (int dt = 0; dt < 2; ++dt)
#pragma unroll
                    for (int ks = 0; ks < 2; ++ks) { const LAS unsigned char* vp = Vb + (32 * dt + l31) * (MLV_PITCH * 2) + (32 * sub + 16 * ks + 4 * hi) * 2;
                        const u32x2 x0 = *(const LAS u32x2*)vp, x1 = *(const LAS u32x2*)(vp + 16);
                        v4u a; a.x = x0.x; a.y = x0.y; a.z = x1.x; a.w = x1.y; o[dt] = MFMA32(__builtin_bit_cast(bf16x8, a), pf[ks], o[dt]); }
            }
        }
        LAS unsigned char* nb = lds + ((step + 1) & 1) * ML_STAGE;
        *(LAS v4u*)(nb + lKn) = rk; if (tid < 256) *(LAS v4u*)(nb + lKr) = rr; *(LAS u32x2*)(nb + lVt) = (u32x2){rv.x, rv.y}; *(LAS u32x2*)(nb + lVt + 8) = (u32x2){rv.z, rv.w};
        __syncthreads();
    }
    lsum += __shfl_xor(lsum, 32);
    store_OT(o, 1.0f / lsum, (LAS bf16_t*)(lds + 2 * ML_STAGE) + wave * (32 * STG_PITCH), ymix + (rowb + q0) * DM + 512 + h * 64, lane);
    __syncthreads();
}


constexpr int SBK_PITCH = 72, SBK_BYTES = 64 * SBK_PITCH * 2, SB_STAGE = SBK_BYTES + MLV_BYTES;
__device__ __forceinline__ void sb_block(int bh, int sb, int tid, int lane, int wave, LAS unsigned char* lds, const bf16_t* __restrict__ P1, const bf16_t* __restrict__ VT, bf16_t* __restrict__ ymix) {
    const int b = bh >> 3, h = bh & 7, l31 = lane & 31, hi = lane >> 5, q0 = 256 * sb + 32 * wave, t = q0 + l31;
    const size_t rowb = (size_t)b * SEQ;
    bf16x8 qf[4];
    { const bf16_t* Qp = P1 + (rowb + q0 + l31) * L1P + h * 64 + 8 * hi;
#pragma unroll
      for (int kk = 0; kk < 4; ++kk) qf[kk] = *(const bf16x8*)(Qp + 16 * kk); }
    f32x16 o[2];
#pragma unroll
    for (int r = 0; r < 16; ++r) { o[0][r] = 0.f; o[1][r] = 0.f; }
    float cum = 0.f; bool done = false;
    volatile LAS unsigned* flags = (volatile LAS unsigned*)(lds + 2 * SB_STAGE);
    const bf16_t* gK = P1 + (rowb + (tid >> 3)) * L1P + 512 + h * 64 + (tid & 7) * 8;
    const bf16_t* gVt = VT + ((size_t)bh * 64 + (tid >> 3)) * SEQ + (tid & 7) * 8;
    const int lK = (tid >> 3) * (SBK_PITCH * 2) + (tid & 7) * 16, lVt = SBK_BYTES + (tid >> 3) * (MLV_PITCH * 2) + (tid & 7) * 16;
    const int top = 4 * sb + 3;
    v4u rk, rv;
    rk = *(const v4u*)(gK + (size_t)top * 64 * L1P); rv = *(const v4u*)(gVt + top * 64);
    *(LAS v4u*)(lds + lK) = rk; *(LAS u32x2*)(lds + lVt) = (u32x2){rv.x, rv.y}; *(LAS u32x2*)(lds + lVt + 8) = (u32x2){rv.z, rv.w};
    __syncthreads();
#pragma unroll 1
    for (int i = 0; i <= top; ++i) {
        const int step = top - i, nx = (step > 0) ? step - 1 : 0;
        rk = *(const v4u*)(gK + (size_t)nx * 64 * L1P); rv = *(const v4u*)(gVt + nx * 64);
        const LAS unsigned char* Kb = lds + (i & 1) * SB_STAGE;
        const LAS unsigned char* Vb = Kb + SBK_BYTES;
#pragma unroll
        for (int sub = 1; sub >= 0; --sub) {
            const int s0 = 64 * step + 32 * sub;
            if (s0 <= q0 && !done) {
                f32x16 acc;
#pragma unroll
                for (int r = 0; r < 16; ++r) acc[r] = 0.f;
#pragma unroll
                for (int kk = 0; kk < 4; ++kk) { const bf16x8 kf = *(const LAS bf16x8*)(Kb + (32 * sub + l31) * (SBK_PITCH * 2) + (16 * kk + 8 * hi) * 2); acc = MFMA32(kf, qf[kk], acc); }
                const bool diag = (s0 == q0);
                float lb[16], lk[16];
#pragma unroll
                for (int r = 0; r < 16; ++r) { const float z = acc[r] * 0.125f; const float sp = softplus_fast(z); float b_ = z - sp, k_ = -sp;
                    if (diag) { const bool valid = (s0 + crow(r, hi)) < t; b_ = valid ? b_ : -1e30f; k_ = valid ? k_ : 0.f; }
                    lb[r] = b_; lk[r] = k_; }
                float e[16], T[4], U[4];
#pragma unroll
                for (int q = 0; q < 4; ++q) { e[4 * q + 3] = 0.f; e[4 * q + 2] = lk[4 * q + 3]; e[4 * q + 1] = e[4 * q + 2] + lk[4 * q + 2]; e[4 * q] = e[4 * q + 1] + lk[4 * q + 1]; T[q] = e[4 * q] + lk[4 * q]; }
#pragma unroll
                for (int q = 0; q < 4; ++q) U[q] = __shfl_xor(T[q], 32);
                { const float st2 = T[3], st1 = st2 + T[2], st0 = st1 + T[1]; const float su2 = U[3], su1 = su2 + U[2], su0 = su1 + U[1];
                  const float x0 = hi ? 0.f : U[0], x1 = hi ? 0.f : U[1], x2 = hi ? 0.f : U[2], x3 = hi ? 0.f : U[3];
                  const float off[4] = {st0 + su0 + x0, st1 + su1 + x1, st2 + su2 + x2, x3};
                  const float total = st0 + T[0] + su0 + U[0];
#pragma unroll
                  for (int r = 0; r < 16; ++r) acc[r] = __expf(lb[r] + (cum + off[r >> 2] + e[r]));
                  cum += total; }
                bf16x8 pf[2];
#pragma unroll
                for (int ks = 0; ks < 2; ++ks) { v4u w; w.x = cvtpk(acc[8 * ks], acc[8 * ks + 1]); w.y = cvtpk(acc[8 * ks + 2], acc[8 * ks + 3]); w.z = cvtpk(acc[8 * ks + 4], acc[8 * ks + 5]); w.w = cvtpk(acc[8 * ks + 6], acc[8 * ks + 7]); pf[ks] = __builtin_bit_cast(bf16x8, w); }
#pragma unroll
                for (int dt = 0; dt < 2; ++dt)
#pragma unroll
                    for (int ks = 0; ks < 2; ++ks) { const LAS unsigned char* vp = Vb + (32 * dt + l31) * (MLV_PITCH * 2) + (32 * sub + 16 * ks + 4 * hi) * 2;
                        const u32x2 x0 = *(const LAS u32x2*)vp, x1 = *(const LAS u32x2*)(vp + 16);
                        v4u a; a.x = x0.x; a.y = x0.y; a.z = x1.x; a.w = x1.y; o[dt] = MFMA32(__builtin_bit_cast(bf16x8, a), pf[ks], o[dt]); }
                done = __all(cum < -110.f);
            }
        }
        if (lane == 0) flags[(i & 1) * 8 + wave] = done ? 1u : 0u;
        LAS unsigned char* nb = lds + ((i + 1) & 1) * SB_STAGE;
        *(LAS v4u*)(nb + lK) = rk; *(LAS u32x2*)(nb + lVt) = (u32x2){rv.x, rv.y}; *(LAS u32x2*)(nb + lVt + 8) = (u32x2){rv.z, rv.w};
        __syncthreads();
        unsigned nd = 0;
#pragma unroll
        for (int w8 = 0; w8 < 8; ++w8) nd += flags[(i & 1) * 8 + w8];
        if (nd == 8u) break;
    }
    store_OT(o, 1.0f, (LAS bf16_t*)(lds + 2 * SB_STAGE + 256) + wave * (32 * STG_PITCH), ymix + (rowb + q0) * DM + h * 64, lane);
    __syncthreads();
}

constexpr int RW_RAWW = 0, RW_RAWA = 2048, RW_RS = 4096, RW_KS = 6144, RW_VS = 8192;
constexpr int RW_CH0 = 10240, RW_CHSZ = 11328;
constexpr int RW_YB = RW_CH0 + 2 * RW_CHSZ;
constexpr int RW_MIX = RW_YB + 1024;
static_assert((RW_MIX + 256) * 4 <= 146432, "rwkv LDS map");
__device__ __forceinline__ float tanh_fast(float x) { return 1.f - 2.f * __builtin_amdgcn_rcpf(1.f + __expf(2.f * x)); }
__device__ __forceinline__ float sigmoid_fast(float x) { return __builtin_amdgcn_rcpf(1.f + __expf(-x)); }

#define MFMA16(a, b, c) __builtin_amdgcn_mfma_f32_16x16x32_bf16((a), (b), (c), 0, 0, 0)
constexpr int RW2_CH0 = 0, RW2_YB = 2 * RW_CHSZ, RW2_MIX = RW2_YB + 1024, RW2_STG = RW2_MIX + 448;
static_assert((RW2_STG + 2 * 3072) * 4 <= 146432, "rwkv LDS map");
__device__ __forceinline__ void rwkv_phase_scan(LAS float* sm, int tid, int lane, int wave, int blk, const bf16_t* __restrict__ proj, const float* __restrict__ mix, const float* __restrict__ w0, const float* __restrict__ a0,
                                           const float* __restrict__ k_k, const float* __restrict__ k_a, const float* __restrict__ r_k, const bf16_t* __restrict__ W2T, const bf16_t* __restrict__ A2T, const bf16_t* __restrict__ G2T,
                                           float* __restrict__ yraw, bf16_t* __restrict__ gout, float* __restrict__ bonus_out) {
    const int chain = blk >> 1, half = blk & 1, b = chain >> 3, h = chain & 7, l15 = lane & 15, kg = lane >> 4;
    const size_t rowb = (size_t)b * SEQ;
    constexpr int NCHUNK = SEQ / 32;
    if (tid < 256) sm[RW2_MIX + tid] = mix[1536 + tid];
    else if (tid < 448) { const int q = tid - 256; sm[RW2_MIX + tid] = mix[512 * (q >> 6) + h * 64 + (q & 63)]; }
    __syncthreads();
#define RW_SH8(CUR, PRV, M0, M1, OUT, PZ) do { const unsigned cu_[4] = {(CUR).x, (CUR).y, (CUR).z, (CUR).w}, pu_[4] = {(PRV).x, (PRV).y, (PRV).z, (PRV).w}; \
        const float mm_[8] = {(M0)[0], (M0)[1], (M0)[2], (M0)[3], (M1)[0], (M1)[1], (M1)[2], (M1)[3]}; \
        _Pragma("unroll") for (int q = 0; q < 4; ++q) { const float c0 = bflo(cu_[q]), c1 = bfhi(cu_[q]), p0 = bflo(pu_[q]) * (PZ), p1 = bfhi(pu_[q]) * (PZ); \
            OUT[2 * q] = c0 + (p0 - c0) * mm_[2 * q]; OUT[2 * q + 1] = c1 + (p1 - c1) * mm_[2 * q + 1]; } } while (0)
    if (wave < 4) {
        const int iA = 8 * wave + kg, iB = iA + 4, jseg = l15;
        float A0 = 0.f, A1 = 0.f, A2 = 0.f, A3 = 0.f, B0 = 0.f, B1 = 0.f, B2 = 0.f, B3 = 0.f;
        __syncthreads();
#pragma unroll 1
        for (int ch = 0; ch < NCHUNK; ++ch) {
            const int t0 = ch * 32;
            const LAS float* CHb = sm + RW2_CH0 + (ch & 1) * RW_CHSZ + 4 * jseg;
            const LAS float* CHv = sm + RW2_CH0 + (ch & 1) * RW_CHSZ + 10240 + iA;
            const LAS float* CHs = sm + RW2_CH0 + (ch & 1) * RW_CHSZ + 11264;
            f32x4 a4 = *(const LAS f32x4*)(CHb + 4096), wr4 = *(const LAS f32x4*)(CHb + 8192), w4 = *(const LAS f32x4*)(CHb), b4 = *(const LAS f32x4*)(CHb + 6144), k4 = *(const LAS f32x4*)(CHb + 2048);
            float vA = CHv[0], vB = CHv[4]; f32x2_t sc = *(const LAS f32x2_t*)(CHs);
#pragma unroll 2
            for (int t = 0; t < 32; ++t) {
                const int tq = (t + 1) & 31;
                const f32x4 a4n = *(const LAS f32x4*)(CHb + 4096 + tq * 64), wr4n = *(const LAS f32x4*)(CHb + 8192 + tq * 64), w4n = *(const LAS f32x4*)(CHb + tq * 64),
                            b4n = *(const LAS f32x4*)(CHb + 6144 + tq * 64), k4n = *(const LAS f32x4*)(CHb + 2048 + tq * 64);
                const float vAn = CHv[tq * 32], vBn = CHv[tq * 32 + 4]; const f32x2_t scn = *(const LAS f32x2_t*)(CHs + 2 * tq);
                float d1A = (A0 * a4[0] + A1 * a4[1]) + (A2 * a4[2] + A3 * a4[3]), d1B = (B0 * a4[0] + B1 * a4[1]) + (B2 * a4[2] + B3 * a4[3]);
                float d2A = (A0 * wr4[0] + A1 * wr4[1]) + (A2 * wr4[2] + A3 * wr4[3]), d2B = (B0 * wr4[0] + B1 * wr4[1]) + (B2 * wr4[2] + B3 * wr4[3]);
                d1A = rowsum16(d1A); d1B = rowsum16(d1B); d2A = rowsum16(d2A); d2B = rowsum16(d2B);
                const float yA = d2A + d1A * sc[0] + vA * sc[1], yB = d2B + d1B * sc[0] + vB * sc[1];
                A0 = A0 * w4[0] + (d1A * b4[0] + vA * k4[0]); A1 = A1 * w4[1] + (d1A * b4[1] + vA * k4[1]); A2 = A2 * w4[2] + (d1A * b4[2] + vA * k4[2]); A3 = A3 * w4[3] + (d1A * b4[3] + vA * k4[3]);
                B0 = B0 * w4[0] + (d1B * b4[0] + vB * k4[0]); B1 = B1 * w4[1] + (d1B * b4[1] + vB * k4[1]); B2 = B2 * w4[2] + (d1B * b4[2] + vB * k4[2]); B3 = B3 * w4[3] + (d1B * b4[3] + vB * k4[3]);
                if (jseg == 0) { sm[RW2_YB + t * 32 + iA] = yA; sm[RW2_YB + t * 32 + iB] = yB; }
                a4 = a4n; wr4 = wr4n; w4 = w4n; b4 = b4n; k4 = k4n; vA = vAn; vB = vBn; sc = scn;
            }
            WSYNC();
            { const int tt = lane >> 1, hh = lane & 1; const f32x4 yv = *(const LAS f32x4*)(sm + RW2_YB + tt * 32 + 8 * wave + 4 * hh);
              *(f32x4*)(yraw + (rowb + t0 + tt) * 512 + h * 64 + half * 32 + 8 * wave + 4 * hh) = yv; }
            __syncthreads();
        }
    } else if (wave < 6) {
        const int tp = wave - 4, tb = 16 * tp;
        LAS float* stg = sm + RW2_STG + tp * 3072;
        float w0c[4], a0c[4], kkc[4], kac[4], rkc[4];
#pragma unroll
        for (int nt = 0; nt < 4; ++nt) { const int c = h * 64 + 16 * nt + l15; w0c[nt] = w0[c]; a0c[nt] = a0[c]; kkc[nt] = k_k[c]; kac[nt] = k_a[c]; rkc[nt] = r_k[c]; }
        v4u ld[20];
#define PREP_ISSUE(T0) do { const int t0_ = (T0); { const size_t r_ = rowb + t0_ + tb + l15; const size_t rp_ = (t0_ + tb + l15 == 0) ? r_ : r_ - 1; \
            _Pragma("unroll") for (int lo = 0; lo < 2; ++lo) _Pragma("unroll") for (int ks = 0; ks < 2; ++ks) { const int col = 1536 + 64 * lo + 32 * ks + 8 * kg; \
                ld[(lo * 2 + ks) * 2] = *(const v4u*)(proj + r_ * L0P + col); ld[(lo * 2 + ks) * 2 + 1] = *(const v4u*)(proj + rp_ * L0P + col); } } \
            _Pragma("unroll") for (int ar = 0; ar < 3; ++ar) _Pragma("unroll") for (int i = 0; i < 2; ++i) { const int p_ = lane + 64 * i, row_ = p_ >> 3, c8_ = p_ & 7; \
                const size_t r_ = rowb + t0_ + tb + row_; const size_t rp_ = (t0_ + tb + row_ == 0) ? r_ : r_ - 1; const int col = 512 * ar + h * 64 + 8 * c8_; \
                ld[8 + (ar * 2 + i) * 2] = *(const v4u*)(proj + r_ * L0P + col); ld[8 + (ar * 2 + i) * 2 + 1] = *(const v4u*)(proj + rp_ * L0P + col); } } while (0)
#define PREP_BUILD(T0, NB) do { const int t0_ = (T0); LAS float* CHn = sm + RW2_CH0 + (NB) * RW_CHSZ; \
            f32x4 accw[4], acca[4]; \
            _Pragma("unroll") for (int nt = 0; nt < 4; ++nt) { accw[nt] = (f32x4){0.f, 0.f, 0.f, 0.f}; acca[nt] = (f32x4){0.f, 0.f, 0.f, 0.f}; } \
            { const float pz_ = (t0_ + tb + l15 == 0) ? 0.f : 1.f; \
              _Pragma("unroll") for (int lo = 0; lo < 2; ++lo) _Pragma("unroll") for (int ks = 0; ks < 2; ++ks) { float s_[8]; \
                const f32x4 m0 = *(const LAS f32x4*)(sm + RW2_MIX + 64 * lo + 32 * ks + 8 * kg), m1 = *(const LAS f32x4*)(sm + RW2_MIX + 64 * lo + 32 * ks + 8 * kg + 4); \
                RW_SH8(ld[(lo * 2 + ks) * 2], ld[(lo * 2 + ks) * 2 + 1], m0, m1, s_, pz_); \
                if (lo == 0) { _Pragma("unroll") for (int j = 0; j < 8; ++j) s_[j] = tanh_fast(s_[j]); } \
                v4u aw; aw.x = cvtpk(s_[0], s_[1]); aw.y = cvtpk(s_[2], s_[3]); aw.z = cvtpk(s_[4], s_[5]); aw.w = cvtpk(s_[6], s_[7]); const bf16x8 af = __builtin_bit_cast(bf16x8, aw); \
                const bf16_t* WT = lo ? A2T : W2T; \
                _Pragma("unroll") for (int nt = 0; nt < 4; ++nt) { const bf16x8 bfr = *(const bf16x8*)(WT + (size_t)(h * 64 + 16 * nt + l15) * 64 + 32 * ks + 8 * kg); \
                    if (lo == 0) accw[nt] = MFMA16(af, bfr, accw[nt]); else acca[nt] = MFMA16(af, bfr, acca[nt]); } } } \
            _Pragma("unroll") for (int ar = 0; ar < 3; ++ar) _Pragma("unroll") for (int i = 0; i < 2; ++i) { const int p_ = lane + 64 * i, row_ = p_ >> 3, c8_ = p_ & 7; float s_[8]; \
                const float pz_ = (t0_ + tb + row_ == 0) ? 0.f : 1.f; const f32x4 m0 = *(const LAS f32x4*)(sm + RW2_MIX + 256 + ar * 64 + c8_ * 8), m1 = *(const LAS f32x4*)(sm + RW2_MIX + 256 + ar * 64 + c8_ * 8 + 4); \
                RW_SH8(ld[8 + (ar * 2 + i) * 2], ld[8 + (ar * 2 + i) * 2 + 1], m0, m1, s_, pz_); \
                *(LAS f32x4*)(stg + ar * 1024 + row_ * 64 + c8_ * 8) = (f32x4){s_[0], s_[1], s_[2], s_[3]}; *(LAS f32x4*)(stg + ar * 1024 + row_ * 64 + c8_ * 8 + 4) = (f32x4){s_[4], s_[5], s_[6], s_[7]}; } \
            WSYNC(); \
            PREP_ISSUE(((T0) + 32 < SEQ) ? (T0) + 32 : (T0)); \
            _Pragma("unroll") for (int rg = 0; rg < 4; ++rg) { const int tl = 4 * kg + rg, t = tb + tl; \
                float r_[4], k_[4], v_[4], kkv[4], nrm2 = 0.f; \
                _Pragma("unroll") for (int nt = 0; nt < 4; ++nt) { r_[nt] = stg[tl * 64 + 16 * nt + l15]; k_[nt] = stg[1024 + tl * 64 + 16 * nt + l15]; v_[nt] = stg[2048 + tl * 64 + 16 * nt + l15]; \
                    kkv[nt] = k_[nt] * kkc[nt]; nrm2 += kkv[nt] * kkv[nt]; } \
                nrm2 = rowsum16(nrm2); const float rn = __builtin_amdgcn_rsqf(fmaxf(nrm2, 1e-24f)); \
                float br = 0.f, kr = 0.f, bon = 0.f; \
                _Pragma("unroll") for (int nt = 0; nt < 4; ++nt) { const int j = 16 * nt + l15; \
                    const float wsum = w0c[nt] + accw[nt][rg]; const float logw = -softplus_fast(-wsum) - 0.5f; const float dec = __expf(-__expf(logw)); \
                    const float a_ = sigmoid_fast(a0c[nt] + acca[nt][rg]); const float kn = kkv[nt] * rn; \
                    const float k2 = k_[nt] * (1.f + (a_ - 1.f) * kac[nt]); const float bv = kn * a_; \
                    br += bv * r_[nt]; kr += k2 * r_[nt]; bon += r_[nt] * k2 * rkc[nt]; \
                    CHn[t * 64 + j] = dec; CHn[2048 + t * 64 + j] = k2; CHn[4096 + t * 64 + j] = -kn; CHn[6144 + t * 64 + j] = bv; CHn[8192 + t * 64 + j] = dec * r_[nt]; \
                    if ((nt >> 1) == half) CHn[10240 + t * 32 + (j & 31)] = v_[nt]; } \
                br = rowsum16(br); kr = rowsum16(kr); bon = rowsum16(bon); \
                if (l15 == 0) { CHn[11264 + 2 * t] = br; CHn[11264 + 2 * t + 1] = kr; if (half == 0) bonus_out[(rowb + t0_ + t) * 8 + h] = bon; } } \
            WSYNC(); } while (0)
        PREP_ISSUE(0);
        PREP_BUILD(0, 0);
        __syncthreads();
#pragma unroll 1
        for (int ch = 0; ch < NCHUNK; ++ch) {
            if (ch + 1 < NCHUNK) PREP_BUILD(ch * 32 + 32, (ch + 1) & 1);
            __syncthreads();
        }
#undef PREP_ISSUE
#undef PREP_BUILD
    } else {
        const int tp = wave - 6, tb = 16 * tp;
        v4u ld[8];
#define G_ISSUE(T0) do { const int t0_ = (T0); const size_t r_ = rowb + t0_ + tb + l15; const size_t rp_ = (t0_ + tb + l15 == 0) ? r_ : r_ - 1; \
            _Pragma("unroll") for (int ks = 0; ks < 4; ++ks) { const int col = 1664 + 32 * ks + 8 * kg; ld[2 * ks] = *(const v4u*)(proj + r_ * L0P + col); ld[2 * ks + 1] = *(const v4u*)(proj + rp_ * L0P + col); } } while (0)
#define G_BUILD(T0) do { const int t0_ = (T0); f32x4 accg[2] = {(f32x4){0.f, 0.f, 0.f, 0.f}, (f32x4){0.f, 0.f, 0.f, 0.f}}; const float pz_ = (t0_ + tb + l15 == 0) ? 0.f : 1.f; \
            _Pragma("unroll") for (int ks = 0; ks < 4; ++ks) { float s_[8]; \
                const f32x4 m0 = *(const LAS f32x4*)(sm + RW2_MIX + 128 + 32 * ks + 8 * kg), m1 = *(const LAS f32x4*)(sm + RW2_MIX + 128 + 32 * ks + 8 * kg + 4); \
                RW_SH8(ld[2 * ks], ld[2 * ks + 1], m0, m1, s_, pz_); \
                _Pragma("unroll") for (int j = 0; j < 8; ++j) s_[j] = sigmoid_fast(s_[j]); \
                v4u aw; aw.x = cvtpk(s_[0], s_[1]); aw.y = cvtpk(s_[2], s_[3]); aw.z = cvtpk(s_[4], s_[5]); aw.w = cvtpk(s_[6], s_[7]); const bf16x8 af = __builtin_bit_cast(bf16x8, aw); \
                _Pragma("unroll") for (int nt = 0; nt < 2; ++nt) { const bf16x8 bfr = *(const bf16x8*)(G2T + (size_t)(h * 64 + half * 32 + 16 * nt + l15) * 128 + 32 * ks + 8 * kg); accg[nt] = MFMA16(af, bfr, accg[nt]); } } \
            G_ISSUE(((T0) + 32 < SEQ) ? (T0) + 32 : (T0)); \
            _Pragma("unroll") for (int nt = 0; nt < 2; ++nt) _Pragma("unroll") for (int rg = 0; rg < 4; ++rg) \
                gout[(rowb + t0_ + tb + 4 * kg + rg) * 512 + h * 64 + half * 32 + 16 * nt + l15] = (bf16_t)f2bf(accg[nt][rg]); } while (0)
        G_ISSUE(0);
        G_BUILD(0);
        __syncthreads();
#pragma unroll 1
        for (int ch = 0; ch < NCHUNK; ++ch) {
            if (ch + 1 < NCHUNK) G_BUILD(ch * 32 + 32);
            __syncthreads();
        }
#undef G_ISSUE
#undef G_BUILD
    }
#undef RW_SH8
    __syncthreads();
}

constexpr int CK_BK = 0, CK_AR = 4608, CK_BBT = 9216, CK_KBT = 12288, CK_VT = 15360, CK_GC = 16896, CK_TT = 17152, CK_SLOT = 18688, CK_NSLOT = 5;
constexpr int CK_STG = CK_SLOT * CK_NSLOT;
constexpr int CK_MIX = CK_STG + 4 * 12288;
constexpr int CK_FLAGS = CK_MIX + 448 * 4;
static_assert(CK_FLAGS + 64 <= 146432, "rwkv chunked LDS map");
__device__ __forceinline__ bf16x8 pack8(float a0, float a1, float a2, float a3, float a4, float a5, float a6, float a7) {
    v4u w; w.x = cvtpk(a0, a1); w.y = cvtpk(a2, a3); w.z = cvtpk(a4, a5); w.w = cvtpk(a6, a7); return __builtin_bit_cast(bf16x8, w); }
__device__ __forceinline__ void rwkv_phase(LAS float* smf, int tid, int lane, int wave, int blk, const bf16_t* __restrict__ proj, const float* __restrict__ mix, const float* __restrict__ w0, const float* __restrict__ a0,
                                           const float* __restrict__ k_k, const float* __restrict__ k_a, const float* __restrict__ r_k, const bf16_t* __restrict__ W2T, const bf16_t* __restrict__ A2T, const bf16_t* __restrict__ G2T,
                                           float* __restrict__ yraw, bf16_t* __restrict__ gout, float* __restrict__ bonus_out) {
    LAS unsigned char* lds = (LAS unsigned char*)smf;
    LAS float* mixs = (LAS float*)(lds + CK_MIX);
    volatile LAS unsigned* flags = (volatile LAS unsigned*)(lds + CK_FLAGS);
    const int chain = blk >> 1, ihalf = blk & 1, b = chain >> 3, h = chain & 7, l15 = lane & 15, kg = lane >> 4, l31 = lane & 31, hi = lane >> 5;
    const size_t rowb = (size_t)b * SEQ;
    constexpr int NCH = SEQ / 16;
    if (tid < 256) mixs[tid] = mix[1536 + tid];
    else if (tid < 448) { const int q = tid - 256; mixs[tid] = mix[512 * (q >> 6) + h * 64 + (q & 63)]; }
    if (tid < 16) flags[tid] = 0u;
    for (int q = tid; q < CK_NSLOT * 384; q += NWAVES * 64) *(LAS unsigned*)(lds + (q / 384) * CK_SLOT + CK_TT + (q % 384) * 4) = 0u;
    __syncthreads();
#define RW_SH8(CUR, PRV, M0, M1, OUT, PZ) do { const unsigned cu_[4] = {(CUR).x, (CUR).y, (CUR).z, (CUR).w}, pu_[4] = {(PRV).x, (PRV).y, (PRV).z, (PRV).w}; \
        const float mm_[8] = {(M0)[0], (M0)[1], (M0)[2], (M0)[3], (M1)[0], (M1)[1], (M1)[2], (M1)[3]}; \
        _Pragma("unroll") for (int q = 0; q < 4; ++q) { const float c0 = bflo(cu_[q]), c1 = bfhi(cu_[q]), p0 = bflo(pu_[q]) * (PZ), p1 = bfhi(pu_[q]) * (PZ); \
            OUT[2 * q] = c0 + (p0 - c0) * mm_[2 * q]; OUT[2 * q + 1] = c1 + (p1 - c1) * mm_[2 * q + 1]; } } while (0)
    if (wave == 0) {
        f32x16 ST[2];
#pragma unroll
        for (int r = 0; r < 16; ++r) { ST[0][r] = 0.f; ST[1][r] = 0.f; }
#pragma unroll 1
        for (int k = 0; k < NCH; ++k) {
#if defined(PROBE_STAMPS)
            const unsigned tw0_ = (unsigned)__builtin_amdgcn_s_memrealtime();
#endif
            { const unsigned want = (unsigned)(k + 1); const int sl = k % CK_NSLOT; while (flags[sl] != want) __builtin_amdgcn_s_sleep(1); }
#if defined(PROBE_STAMPS)
            if (blk == 0 && lane == 0) ((volatile LAS unsigned*)(lds + 146432 + 320))[16 + 24] += (unsigned)__builtin_amdgcn_s_memrealtime() - tw0_;
#endif
            asm volatile("" ::: "memory");
            const LAS unsigned char* im = lds + (k % CK_NSLOT) * CK_SLOT;
            f32x16 G;
#pragma unroll
            for (int r = 0; r < 16; ++r) G[r] = 0.f;
#pragma unroll
            for (int kk = 0; kk < 4; ++kk) { const bf16x8 fa = *(const LAS bf16x8*)(im + CK_BK + l31 * 144 + (16 * kk + 8 * hi) * 2), fb = *(const LAS bf16x8*)(im + CK_AR + l31 * 144 + (16 * kk + 8 * hi) * 2); G = MFMA32(fa, fb, G); }
            { const int tcol = l31 & 15; const bool strict = l31 < 16;
#pragma unroll
              for (int r = 0; r < 16; ++r) { const int srow = crow(r & 7, hi); const bool keep = strict ? (srow < tcol) : (srow <= tcol); G[r] = keep ? G[r] : 0.f; } }
            const bf16x8 gB = pack8(G[0], G[1], G[2], G[3], G[4], G[5], G[6], G[7]), gK = pack8(G[8], G[9], G[10], G[11], G[12], G[13], G[14], G[15]);
            f32x16 XT;
#pragma unroll
            for (int r = 0; r < 16; ++r) XT[r] = 0.f;
#pragma unroll
            for (int jt = 0; jt < 2; ++jt)
#pragma unroll
                for (int sp = 0; sp < 2; ++sp) { const LAS unsigned char* ap = im + CK_AR + l31 * 144 + (32 * jt + 16 * sp + 4 * hi) * 2;
                    const u32x2 x0 = *(const LAS u32x2*)ap, x1 = *(const LAS u32x2*)(ap + 16); v4u aw; aw.x = x0.x; aw.y = x0.y; aw.z = x1.x; aw.w = x1.y;
                    const bf16x8 sb_ = pack8(ST[jt][8 * sp], ST[jt][8 * sp + 1], ST[jt][8 * sp + 2], ST[jt][8 * sp + 3], ST[jt][8 * sp + 4], ST[jt][8 * sp + 5], ST[jt][8 * sp + 6], ST[jt][8 * sp + 7]);
                    XT = MFMA32(__builtin_bit_cast(bf16x8, aw), sb_, XT); }
            bf16x8 vP;
            { const LAS unsigned char* vp = im + CK_VT + l31 * 48 + (4 * hi) * 2; const u32x2 x0 = *(const LAS u32x2*)vp, x1 = *(const LAS u32x2*)(vp + 16); v4u vw; vw.x = x0.x; vw.y = x0.y; vw.z = x1.x; vw.w = x1.y;
              vP = __builtin_bit_cast(bf16x8, vw); XT = MFMA32(gK, vP, XT); }
            bf16x8 uP;
            { const LAS unsigned char* tp = im + CK_TT + l31 * 48 + (4 * hi) * 2; const u32x2 x0 = *(const LAS u32x2*)tp, x1 = *(const LAS u32x2*)(tp + 16); v4u tw; tw.x = x0.x; tw.y = x0.y; tw.z = x1.x; tw.w = x1.y;
              f32x16 UT;
#pragma unroll
              for (int r = 0; r < 16; ++r) UT[r] = 0.f;
              UT = MFMA32(__builtin_bit_cast(bf16x8, tw), pack8(XT[0], XT[1], XT[2], XT[3], XT[4], XT[5], XT[6], XT[7]), UT);
              uP = pack8(UT[0], UT[1], UT[2], UT[3], UT[4], UT[5], UT[6], UT[7]); }
            XT = MFMA32(gB, uP, XT);
            { float* yp = yraw + (rowb + 16 * k) * 512 + h * 64 + 32 * ihalf + l31;
#pragma unroll
              for (int q = 0; q < 8; ++q) yp[(size_t)crow(q, hi) * 512] = XT[8 + q]; }
            { const LAS float* gc = (const LAS float*)(im + CK_GC);
#pragma unroll
              for (int jt = 0; jt < 2; ++jt)
#pragma unroll
                  for (int r = 0; r < 16; ++r) ST[jt][r] *= gc[32 * jt + crow(r, hi)]; }
#pragma unroll
            for (int jt = 0; jt < 2; ++jt) { const LAS unsigned char* bp = im + CK_BBT + (32 * jt + l31) * 48 + (4 * hi) * 2; const LAS unsigned char* kp = im + CK_KBT + (32 * jt + l31) * 48 + (4 * hi) * 2;
                const u32x2 b0 = *(const LAS u32x2*)bp, b1 = *(const LAS u32x2*)(bp + 16), k0 = *(const LAS u32x2*)kp, k1 = *(const LAS u32x2*)(kp + 16);
                v4u a1; a1.x = b0.x; a1.y = b0.y; a1.z = b1.x; a1.w = b1.y; v4u a2; a2.x = k0.x; a2.y = k0.y; a2.z = k1.x; a2.w = k1.y;
                ST[jt] = MFMA32(__builtin_bit_cast(bf16x8, a1), uP, ST[jt]); ST[jt] = MFMA32(__builtin_bit_cast(bf16x8, a2), vP, ST[jt]); }
            WSYNC();
            if (lane == 0) flags[8] = (unsigned)(k + 1);
        }
    } else if (wave <= 4) {
        const int pw = wave - 1;
        LAS float* stg = (LAS float*)(lds + CK_STG) + pw * 3072;
        float w0c[4], a0c[4], kkc[4], kac[4], rkc[4];
#pragma unroll
        for (int nt = 0; nt < 4; ++nt) { const int c = h * 64 + 16 * nt + l15; w0c[nt] = w0[c]; a0c[nt] = a0[c]; kkc[nt] = k_k[c]; kac[nt] = k_a[c]; rkc[nt] = r_k[c]; }
        v4u ld[20];
#define CK_ISSUE(T0) do { const int t0_ = (T0); { const size_t r_ = rowb + t0_ + l15; const size_t rp_ = (t0_ + l15 == 0) ? r_ : r_ - 1; \
            _Pragma("unroll") for (int lo = 0; lo < 2; ++lo) _Pragma("unroll") for (int ks = 0; ks < 2; ++ks) { const int col = 1536 + 64 * lo + 32 * ks + 8 * kg; \
                ld[(lo * 2 + ks) * 2] = *(const v4u*)(proj + r_ * L0P + col); ld[(lo * 2 + ks) * 2 + 1] = *(const v4u*)(proj + rp_ * L0P + col); } } \
            _Pragma("unroll") for (int ar = 0; ar < 3; ++ar) _Pragma("unroll") for (int i = 0; i < 2; ++i) { const int p_ = lane + 64 * i, row_ = p_ >> 3, c8_ = p_ & 7; \
                const size_t r_ = rowb + t0_ + row_; const size_t rp_ = (t0_ + row_ == 0) ? r_ : r_ - 1; const int col = 512 * ar + h * 64 + 8 * c8_; \
                ld[8 + (ar * 2 + i) * 2] = *(const v4u*)(proj + r_ * L0P + col); ld[8 + (ar * 2 + i) * 2 + 1] = *(const v4u*)(proj + rp_ * L0P + col); } } while (0)
        CK_ISSUE(16 * pw);
#pragma unroll 1
        for (int k = pw; k < NCH; k += 4) {
            const int t0 = 16 * k;
#if defined(PROBE_STAMPS)
            const unsigned ts0_ = (unsigned)__builtin_amdgcn_s_memrealtime();
#endif
            unsigned pf0, pf1;
            { const int tpf = (k + 8 < NCH) ? t0 + 128 : t0; const int wh = lane & 3; const bf16_t* rp = proj + (rowb + tpf + (lane >> 2)) * L0P;
              pf0 = *(const unsigned*)(rp + ((wh < 3) ? 512 * wh + h * 64 : 1536)); pf1 = *(const unsigned*)(rp + 1600); }
            f32x4 accw[4], acca[4];
#pragma unroll
            for (int nt = 0; nt < 4; ++nt) { accw[nt] = (f32x4){0.f, 0.f, 0.f, 0.f}; acca[nt] = (f32x4){0.f, 0.f, 0.f, 0.f}; }
            { const float pz_ = (t0 + l15 == 0) ? 0.f : 1.f;
#pragma unroll
              for (int lo = 0; lo < 2; ++lo)
#pragma unroll
                for (int ks = 0; ks < 2; ++ks) { float s_[8];
                    const f32x4 m0 = *(const LAS f32x4*)(mixs + 64 * lo + 32 * ks + 8 * kg), m1 = *(const LAS f32x4*)(mixs + 64 * lo + 32 * ks + 8 * kg + 4);
                    RW_SH8(ld[(lo * 2 + ks) * 2], ld[(lo * 2 + ks) * 2 + 1], m0, m1, s_, pz_);
                    if (lo == 0) {
#pragma unroll
                        for (int j = 0; j < 8; ++j) s_[j] = tanh_fast(s_[j]); }
                    const bf16x8 af = pack8(s_[0], s_[1], s_[2], s_[3], s_[4], s_[5], s_[6], s_[7]);
                    const bf16_t* WT = lo ? A2T : W2T;
#pragma unroll
                    for (int nt = 0; nt < 4; ++nt) { const bf16x8 bfr = *(const bf16x8*)(WT + (size_t)(h * 64 + 16 * nt + l15) * 64 + 32 * ks + 8 * kg);
                        if (lo == 0) accw[nt] = MFMA16(af, bfr, accw[nt]); else acca[nt] = MFMA16(af, bfr, acca[nt]); } } }
#pragma unroll
            for (int ar = 0; ar < 3; ++ar)
#pragma unroll
                for (int i = 0; i < 2; ++i) { const int p_ = lane + 64 * i, row_ = p_ >> 3, c8_ = p_ & 7; float s_[8];
                    const float pz_ = (t0 + row_ == 0) ? 0.f : 1.f; const f32x4 m0 = *(const LAS f32x4*)(mixs + 256 + ar * 64 + c8_ * 8), m1 = *(const LAS f32x4*)(mixs + 256 + ar * 64 + c8_ * 8 + 4);
                    RW_SH8(ld[8 + (ar * 2 + i) * 2], ld[8 + (ar * 2 + i) * 2 + 1], m0, m1, s_, pz_);
                    *(LAS f32x4*)(stg + ar * 1024 + row_ * 64 + c8_ * 8) = (f32x4){s_[0], s_[1], s_[2], s_[3]}; *(LAS f32x4*)(stg + ar * 1024 + row_ * 64 + c8_ * 8 + 4) = (f32x4){s_[4], s_[5], s_[6], s_[7]}; }
            WSYNC();
#if defined(PROBE_STAMPS)
            if (blk == 0 && wave == 1 && lane == 0) ((volatile LAS unsigned*)(lds + 146432 + 320))[16 + 26] += (unsigned)__builtin_amdgcn_s_memrealtime() - ts0_;
#endif
#if defined(PROBE_STAMPS)
            const unsigned tb0_ = (unsigned)__builtin_amdgcn_s_memrealtime();
#endif
            { const int need = k - (CK_NSLOT - 1); if (need > 0) { while ((int)flags[8] < need) __builtin_amdgcn_s_sleep(2); } }
#if defined(PROBE_STAMPS)
            if (blk == 0 && wave == 1 && lane == 0) ((volatile LAS unsigned*)(lds + 146432 + 320))[16 + 25] += (unsigned)__builtin_amdgcn_s_memrealtime() - tb0_;
#endif
            asm volatile("" ::: "memory");
            LAS unsigned char* im = lds + (k % CK_NSLOT) * CK_SLOT;
#if defined(PROBE_STAMPS)
            const unsigned ts1_ = (unsigned)__builtin_amdgcn_s_memrealtime();
#endif
            float lwv[4][4], av[4][4], knv[4][4], rv[4][4], kv[4][4];
#pragma unroll
            for (int rg = 0; rg < 4; ++rg) { const int tl = 4 * kg + rg;
                float kkv[4], nrm2 = 0.f, vv[4], rr_[4], kr_[4];
#pragma unroll
                for (int nt = 0; nt < 4; ++nt) { rr_[nt] = stg[tl * 64 + 16 * nt + l15]; kr_[nt] = stg[1024 + tl * 64 + 16 * nt + l15]; vv[nt] = stg[2048 + tl * 64 + 16 * nt + l15];
                    kkv[nt] = kr_[nt] * kkc[nt]; nrm2 += kkv[nt] * kkv[nt]; }
                nrm2 = rowsum16(nrm2); const float rn = __builtin_amdgcn_rsqf(fmaxf(nrm2, 1e-24f));
                float bon = 0.f;
#pragma unroll
                for (int nt = 0; nt < 4; ++nt) {
                    const float wsum = w0c[nt] + accw[nt][rg]; lwv[nt][rg] = -0.6065306597126334f * sigmoid_fast(wsum);
                    const float a_ = sigmoid_fast(a0c[nt] + acca[nt][rg]); av[nt][rg] = a_; knv[nt][rg] = kkv[nt] * rn;
                    const float k2 = kr_[nt] * (1.f + (a_ - 1.f) * kac[nt]); kv[nt][rg] = k2; rv[nt][rg] = rr_[nt];
                    bon += rr_[nt] * k2 * rkc[nt];
                    if ((nt >> 1) == ihalf) *(LAS bf16_t*)(im + CK_VT + (16 * (nt & 1) + l15) * 48 + tl * 2) = bf1(vv[nt]);
                }
                bon = rowsum16(bon);
                if (l15 == 0 && ihalf == 0) bonus_out[(rowb + t0 + tl) * 8 + h] = bon;
            }
#pragma unroll
            for (int nt = 0; nt < 4; ++nt) {
                float L[4]; L[0] = lwv[nt][0]; L[1] = L[0] + lwv[nt][1]; L[2] = L[1] + lwv[nt][2]; L[3] = L[2] + lwv[nt][3];
                const float T0 = __shfl(L[3], l15), T1 = __shfl(L[3], 16 + l15), T2 = __shfl(L[3], 32 + l15), T3 = __shfl(L[3], 48 + l15);
                const float off = (kg > 0 ? T0 : 0.f) + (kg > 1 ? T1 : 0.f) + (kg > 2 ? T2 : 0.f), LC = (T0 + T1) + (T2 + T3);
                const int j = 16 * nt + l15;
                unsigned bb2[2], kb2[2];
                const float gC = __expf(LC); float eprev = __expf(off);
#pragma unroll
                for (int rg = 0; rg < 4; ++rg) { const int tl = 4 * kg + rg; const float Lt = off + L[rg], e1 = __expf(Lt), e2 = __builtin_amdgcn_rcpf(e1), e3 = eprev, e4 = gC * e2; eprev = e1;
                    const float kn = knv[nt][rg], bvv = kn * av[nt][rg], k2 = kv[nt][rg], rr2 = rv[nt][rg];
                    *(LAS bf16_t*)(im + CK_BK + tl * 144 + j * 2) = bf1(bvv * e2); *(LAS bf16_t*)(im + CK_BK + (16 + tl) * 144 + j * 2) = bf1(k2 * e2);
                    *(LAS bf16_t*)(im + CK_AR + tl * 144 + j * 2) = bf1(-kn * e3); *(LAS bf16_t*)(im + CK_AR + (16 + tl) * 144 + j * 2) = bf1(rr2 * e1);
                    const unsigned bq = bf1(bvv * e4), kq = bf1(k2 * e4);
                    if (rg & 1) { bb2[rg >> 1] |= bq << 16; kb2[rg >> 1] |= kq << 16; } else { bb2[rg >> 1] = bq; kb2[rg >> 1] = kq; } }
                *(LAS u32x2*)(im + CK_BBT + j * 48 + (4 * kg) * 2) = (u32x2){bb2[0], bb2[1]}; *(LAS u32x2*)(im + CK_KBT + j * 48 + (4 * kg) * 2) = (u32x2){kb2[0], kb2[1]};
                if (kg == 0) *(LAS float*)(im + CK_GC + j * 4) = gC;
            }
            WSYNC();
#if defined(PROBE_STAMPS)
            const unsigned ts2_ = (unsigned)__builtin_amdgcn_s_memrealtime();
            if (blk == 0 && wave == 1 && lane == 0) ((volatile LAS unsigned*)(lds + 146432 + 320))[16 + 27] += ts2_ - ts1_;
#endif
            {
                f32x4 nacc = {0.f, 0.f, 0.f, 0.f};
#pragma unroll
                for (int ks = 0; ks < 2; ++ks) { const bf16x8 fa = *(const LAS bf16x8*)(im + CK_BK + l15 * 144 + (32 * ks + 8 * kg) * 2), fb = *(const LAS bf16x8*)(im + CK_AR + l15 * 144 + (32 * ks + 8 * kg) * 2); nacc = MFMA16(fa, fb, nacc); }
#pragma unroll
                for (int rg = 0; rg < 4; ++rg) nacc[rg] = ((4 * kg + rg) < l15) ? nacc[rg] : 0.f;
                float Tr[16];
#pragma unroll
                for (int t = 0; t < 16; ++t) { float acc_ = (l15 == t) ? 1.f : 0.f;
#pragma unroll
                    for (int s2 = 0; s2 < t; ++s2) acc_ += Tr[s2] * rl(nacc[s2 & 3], t + 16 * (s2 >> 2));
                    Tr[t] = acc_; }
                if (kg == 0) {
#pragma unroll
                    for (int t = 0; t < 16; ++t) *(LAS bf16_t*)(im + CK_TT + t * 48 + l15 * 2) = bf1(Tr[t]); }
            }
            WSYNC();
#if defined(PROBE_STAMPS)
            if (blk == 0 && wave == 1 && lane == 0) ((volatile LAS unsigned*)(lds + 146432 + 320))[16 + 28] += (unsigned)__builtin_amdgcn_s_memrealtime() - ts2_;
#endif
            if (lane == 0) flags[k % CK_NSLOT] = (unsigned)(k + 1);
            CK_ISSUE((k + 4 < NCH) ? t0 + 64 : t0);
            asm volatile("" :: "v"(pf0), "v"(pf1));
        }
#undef CK_ISSUE
    } else if (wave <= 6) {
        const int gq = wave - 5;
        v4u ld[8];
#define G_ISSUE(T0) do { const int t0_ = (T0); const size_t r_ = rowb + t0_ + l15; const size_t rp_ = (t0_ + l15 == 0) ? r_ : r_ - 1; \
            _Pragma("unroll") for (int ks = 0; ks < 4; ++ks) { const int col = 1664 + 32 * ks + 8 * kg; ld[2 * ks] = *(const v4u*)(proj + r_ * L0P + col); ld[2 * ks + 1] = *(const v4u*)(proj + rp_ * L0P + col); } } while (0)
        G_ISSUE(16 * gq);
#pragma unroll 1
        for (int k = gq; k < NCH; k += 2) {
            const int t0 = 16 * k;
            f32x4 accg[2] = {(f32x4){0.f, 0.f, 0.f, 0.f}, (f32x4){0.f, 0.f, 0.f, 0.f}}; const float pz_ = (t0 + l15 == 0) ? 0.f : 1.f;
#pragma unroll
            for (int ks = 0; ks < 4; ++ks) { float s_[8];
                const f32x4 m0 = *(const LAS f32x4*)(mixs + 128 + 32 * ks + 8 * kg), m1 = *(const LAS f32x4*)(mixs + 128 + 32 * ks + 8 * kg + 4);
                RW_SH8(ld[2 * ks], ld[2 * ks + 1], m0, m1, s_, pz_);
#pragma unroll
                for (int j = 0; j < 8; ++j) s_[j] = sigmoid_fast(s_[j]);
                const bf16x8 af = pack8(s_[0], s_[1], s_[2], s_[3], s_[4], s_[5], s_[6], s_[7]);
#pragma unroll
                for (int nt = 0; nt < 2; ++nt) { const bf16x8 bfr = *(const bf16x8*)(G2T + (size_t)(h * 64 + ihalf * 32 + 16 * nt + l15) * 128 + 32 * ks + 8 * kg); accg[nt] = MFMA16(af, bfr, accg[nt]); } }
            G_ISSUE((k + 2 < NCH) ? t0 + 32 : t0);
#pragma unroll
            for (int nt = 0; nt < 2; ++nt)
#pragma unroll
                for (int rg = 0; rg < 4; ++rg) gout[(rowb + t0 + 4 * kg + rg) * 512 + h * 64 + ihalf * 32 + 16 * nt + l15] = bf1(accg[nt][rg]);
        }
#undef G_ISSUE
    }
#undef RW_SH8
    __syncthreads();
}

template <bool ST = true> __device__ __forceinline__ void rwkv_post_all(const float* __restrict__ yraw, const bf16_t* __restrict__ proj, const float* __restrict__ mix, const float* __restrict__ bonus, const bf16_t* __restrict__ gbuf,
                                              const float* __restrict__ ln_g, const float* __restrict__ ln_b, bf16_t* __restrict__ ymix, int gw, int NGW, int lane) {
    for (int m = gw; m < M; m += NGW) {
        const bool has_prev = (m & (SEQ - 1)) != 0;
        float y[8], cv[8], pv[8], gg[8], bo[8];
#pragma unroll
        for (int h = 0; h < 8; ++h) { const int c = h * 64 + lane; y[h] = yraw[(size_t)m * 512 + c]; cv[h] = bf2f(proj[(size_t)m * L0P + 1024 + c]);
            pv[h] = bf2f(proj[(size_t)(has_prev ? m - 1 : m) * L0P + 1024 + c]); gg[h] = bf2f(gbuf[(size_t)m * 512 + c]); bo[h] = bonus[(size_t)m * 8 + h]; }
#pragma unroll
        for (int h = 0; h < 8; ++h) { const int c = h * 64 + lane;
            const float mu = wave_sum_dpp(y[h]) * (1.f / 64.f), d = y[h] - mu, var = wave_sum_dpp(d * d) * (1.f / 64.f);
            const float yn = d * __builtin_amdgcn_rsqf(var + 64e-5f) * ln_g[c] + ln_b[c];
            const float pvv = has_prev ? pv[h] : 0.f;
            const float v_s = cv[h] + (pvv - cv[h]) * mix[1024 + c];
            const float o = (yn + bo[h] * v_s) * gg[h];
            if (ST) ymix[(size_t)m * DM + c] = (bf16_t)f2bf(o); else asm volatile("" :: "v"(o)); }
    }
}


__device__ __forceinline__ void ssd_conv_tile(int it, int lane, LAS bf16_t* scr, const bf16_t* __restrict__ proj, const float* __restrict__ cw, const float* __restrict__ cb,
                                              bf16_t* __restrict__ xbc, bf16_t* __restrict__ xst, bf16_t* __restrict__ bt) {
    const int tt = it >> 4, ct = it & 15, m0 = tt * 64, b = m0 >> 11, t0 = m0 & (SEQ - 1), c = ct * 64 + lane;
    const float w0 = cw[c], w1 = cw[1024 + c], w2 = cw[2048 + c], w3 = cw[3072 + c], bias = cb[c];
    const bf16_t* src = proj + (size_t)m0 * L0P + 2304 + c;
    bf16_t raw[67];
    const int lo = (t0 > 0) ? -3 : 0;
#pragma unroll
    for (int t = -3; t < 64; ++t) raw[t + 3] = src[(ptrdiff_t)((t < lo) ? lo : t) * L0P];
    float u3 = (t0 > 0) ? bf2f(raw[0]) : 0.f, u2 = (t0 > 0) ? bf2f(raw[1]) : 0.f, u1 = (t0 > 0) ? bf2f(raw[2]) : 0.f;
#pragma unroll
    for (int t = 0; t < 64; ++t) {
        const float u = bf2f(raw[t + 3]);
        const float y = bias + w0 * u3 + w1 * u2 + w2 * u1 + w3 * u;
        const bf16_t o = bf1(y * __builtin_amdgcn_rcpf(1.f + __expf(-y)));
        xbc[(size_t)(m0 + t) * 1024 + c] = o;
        scr[t * STG_PITCH + lane] = o;
        u3 = u2; u2 = u1; u1 = u;
    }
    WSYNC();
    if (ct < 12) {
        bf16_t* dst = (ct < 8) ? xst + ((size_t)(b * 8 + ct) * 64) * SEQ + t0 : bt + ((size_t)(b * 2 + ((ct - 8) >> 1)) * 128 + ((ct - 8) & 1) * 64) * SEQ + t0;
#pragma unroll
        for (int i = 0; i < 8; ++i) { const int d = i * 8 + (lane >> 3), tc = lane & 7; const LAS bf16_t* p = scr + (tc * 8) * STG_PITCH + d;
            v4u o; o.x = (unsigned)p[0] | ((unsigned)p[STG_PITCH] << 16); o.y = (unsigned)p[2 * STG_PITCH] | ((unsigned)p[3 * STG_PITCH] << 16);
            o.z = (unsigned)p[4 * STG_PITCH] | ((unsigned)p[5 * STG_PITCH] << 16); o.w = (unsigned)p[6 * STG_PITCH] | ((unsigned)p[7 * STG_PITCH] << 16);
            *(v4u*)(dst + (size_t)d * SEQ + tc * 8) = o; }
    }
    WSYNC();
}
__device__ __forceinline__ float bperm(int srclane, float x) { return __builtin_bit_cast(float, __builtin_amdgcn_ds_bpermute(srclane << 2, __builtin_bit_cast(int, x))); }
__device__ __forceinline__ void scan128(float& x0, float& x1, int lane) {
#pragma unroll
    for (int o = 1; o < 64; o <<= 1) { const int sl = (lane >= o) ? lane - o : lane; const float t0 = bperm(sl, x0), t1 = bperm(sl, x1); if (lane >= o) { x0 += t0; x1 += t1; } }
    x1 += rl(x0, 63);
}
__device__ __forceinline__ void ssd_s1_unit(int unit, int lane, LAS float* tab, const bf16_t* __restrict__ xst, const bf16_t* __restrict__ bt, const float* __restrict__ dt, const float* __restrict__ a_log,
                                            float* __restrict__ sloc, float* __restrict__ asum) {
    const int h = unit & 7, c = (unit >> 3) & 15, b = unit >> 7, g = h >> 2, l0 = c * 128, l31 = lane & 31, hi = lane >> 5;
    const size_t m0 = (size_t)b * SEQ + l0;
    const float A = -expf(a_log[h]);
    const float d0 = dt[(m0 + lane) * 8 + h], d1 = dt[(m0 + 64 + lane) * 8 + h];
    float ac0 = d0 * A, ac1 = d1 * A;
    scan128(ac0, ac1, lane);
    const float aend = rl(ac1, 63);
    tab[lane] = __expf(aend - ac0) * d0; tab[64 + lane] = __expf(aend - ac1) * d1;
    if (lane == 0) asum[unit] = aend;
    WSYNC();
    f32x16 acc[2][4];
#pragma unroll
    for (int pt = 0; pt < 2; ++pt)
#pragma unroll
        for (int nt = 0; nt < 4; ++nt)
#pragma unroll
            for (int r = 0; r < 16; ++r) acc[pt][nt][r] = 0.f;
    const bf16_t* Xp = xst + ((size_t)(b * 8 + h) * 64 + l31) * SEQ + l0 + 8 * hi;
    const bf16_t* Bp = bt + ((size_t)(b * 2 + g) * 128 + l31) * SEQ + l0 + 8 * hi;
#pragma unroll 2
    for (int kk = 0; kk < 8; ++kk) {
        const f32x4 wa = *(const LAS f32x4*)(tab + 16 * kk + 8 * hi), wb = *(const LAS f32x4*)(tab + 16 * kk + 8 * hi + 4);
        bf16x8 af[2], bfr[4];
#pragma unroll
        for (int pt = 0; pt < 2; ++pt) { const v4u raw = *(const v4u*)(Xp + (size_t)pt * 32 * SEQ + 16 * kk);
            v4u w; w.x = cvtpk(bflo(raw.x) * wa[0], bfhi(raw.x) * wa[1]); w.y = cvtpk(bflo(raw.y) * wa[2], bfhi(raw.y) * wa[3]);
            w.z = cvtpk(bflo(raw.z) * wb[0], bfhi(raw.z) * wb[1]); w.w = cvtpk(bflo(raw.w) * wb[2], bfhi(raw.w) * wb[3]); af[pt] = __builtin_bit_cast(bf16x8, w); }
#pragma unroll
        for (int nt = 0; nt < 4; ++nt) bfr[nt] = *(const bf16x8*)(Bp + (size_t)nt * 32 * SEQ + 16 * kk);
#pragma unroll
        for (int pt = 0; pt < 2; ++pt)
#pragma unroll
            for (int nt = 0; nt < 4; ++nt) acc[pt][nt] = MFMA32(af[pt], bfr[nt], acc[pt][nt]);
    }
    float* dst = sloc + (size_t)unit * 8192 + l31;
#pragma unroll
    for (int pt = 0; pt < 2; ++pt)
#pragma unroll
        for (int nt = 0; nt < 4; ++nt)
#pragma unroll
            for (int r = 0; r < 16; ++r) dst[(32 * pt + crow(r, hi)) * 128 + 32 * nt] = acc[pt][nt][r];
    WSYNC();
}
__device__ __forceinline__ void ssd_s2_all(const float* __restrict__ sloc, const float* __restrict__ asum, bf16_t* __restrict__ stb, int gtid, int NT) {
    for (int i = gtid; i < 128 * 2048; i += NT) {
        const int bh = i >> 11, e4 = i & 2047, b = bh >> 3, h = bh & 7;
        f32x4 run = {0.f, 0.f, 0.f, 0.f};
#pragma unroll 4
        for (int c = 0; c < 16; ++c) { const int unit = (b * 16 + c) * 8 + h; const f32x4 tmp = *(const f32x4*)(sloc + (size_t)unit * 8192 + e4 * 4);
            uint2 w; w.x = cvtpk(run[0], run[1]); w.y = cvtpk(run[2], run[3]); *(uint2*)(stb + (size_t)unit * 8192 + e4 * 4) = w;
            run = run * __expf(asum[unit]) + tmp; }
    }
}
__device__ __forceinline__ void ssd_s3_unit(int unit, int lane, LAS float* tab, const bf16_t* __restrict__ xbc, const bf16_t* __restrict__ xst, const bf16_t* __restrict__ stb, const float* __restrict__ dt,
                                            const float* __restrict__ a_log, const float* __restrict__ dsk, bf16_t* __restrict__ yssm) {
    const int h = unit & 7, c = (unit >> 3) & 15, b = unit >> 7, g = h >> 2, l0 = c * 128, l31 = lane & 31, hi = lane >> 5;
    const size_t m0 = (size_t)b * SEQ + l0;
    const float A = -expf(a_log[h]), D = dsk[h];
    const float d0 = dt[(m0 + lane) * 8 + h], d1 = dt[(m0 + 64 + lane) * 8 + h];
    float ac0 = d0 * A, ac1 = d1 * A;
    scan128(ac0, ac1, lane);
    tab[lane] = ac0; tab[64 + lane] = ac1; tab[128 + lane] = d0; tab[192 + lane] = d1;
    WSYNC();
    const bf16_t* Cp = xbc + (m0 + l31) * 1024 + 768 + g * 128 + 8 * hi;
    const bf16_t* Sp = stb + (size_t)unit * 8192 + l31 * 128 + 8 * hi;
    const bf16_t* Bp = xbc + (m0 + l31) * 1024 + 512 + g * 128 + 8 * hi;
    const bf16_t* Xp = xst + ((size_t)(b * 8 + h) * 64 + l31) * SEQ + l0 + 4 * hi;
    LAS float* tr = tab + 256;
    const int row = lane >> 1, p0 = (lane & 1) * 16;
#pragma unroll 1
    for (int lt = 0; lt < 4; ++lt) {
        f32x16 y[2];
#pragma unroll
        for (int r = 0; r < 16; ++r) { y[0][r] = 0.f; y[1][r] = 0.f; }
        const float acl = tab[32 * lt + l31];
#pragma unroll 4
        for (int kk = 0; kk < 8; ++kk) {
            const bf16x8 cf = *(const bf16x8*)(Cp + (size_t)lt * 32 * 1024 + 16 * kk);
            const bf16x8 s0 = *(const bf16x8*)(Sp + 16 * kk), s1 = *(const bf16x8*)(Sp + 32 * 128 + 16 * kk);
            y[0] = MFMA32(s0, cf, y[0]); y[1] = MFMA32(s1, cf, y[1]);
        }
        { const float el = __expf(acl);
#pragma unroll
          for (int r = 0; r < 16; ++r) { y[0][r] *= el; y[1][r] *= el; } }
#pragma unroll 1
        for (int st = 0; st <= lt; ++st) {
            f32x16 cbt;
#pragma unroll
            for (int r = 0; r < 16; ++r) cbt[r] = 0.f;
#pragma unroll 4
            for (int kk = 0; kk < 8; ++kk) { const bf16x8 bf_ = *(const bf16x8*)(Bp + (size_t)st * 32 * 1024 + 16 * kk), cf_ = *(const bf16x8*)(Cp + (size_t)lt * 32 * 1024 + 16 * kk); cbt = MFMA32(bf_, cf_, cbt); }
#pragma unroll
            for (int r = 0; r < 16; ++r) { const int sl = 32 * st + crow(r, hi); const float acs = tab[sl], dts = tab[128 + sl];
                float v = cbt[r] * __expf(acl - acs) * dts; if (st == lt && crow(r, hi) > l31) v = 0.f; cbt[r] = v; }
            bf16x8 pf[2];
#pragma unroll
            for (int ks = 0; ks < 2; ++ks) { v4u w; w.x = cvtpk(cbt[8 * ks], cbt[8 * ks + 1]); w.y = cvtpk(cbt[8 * ks + 2], cbt[8 * ks + 3]); w.z = cvtpk(cbt[8 * ks + 4], cbt[8 * ks + 5]); w.w = cvtpk(cbt[8 * ks + 6], cbt[8 * ks + 7]); pf[ks] = __builtin_bit_cast(bf16x8, w); }
#pragma unroll
            for (int pt = 0; pt < 2; ++pt)
#pragma unroll
                for (int ks = 0; ks < 2; ++ks) { const bf16_t* xp = Xp + (size_t)pt * 32 * SEQ + st * 32 + 16 * ks; const u32x2 x0 = *(const u32x2*)xp, x1 = *(const u32x2*)(xp + 8);
                    v4u a; a.x = x0.x; a.y = x0.y; a.z = x1.x; a.w = x1.y; y[pt] = MFMA32(__builtin_bit_cast(bf16x8, a), pf[ks], y[pt]); }
        }
#pragma unroll
        for (int pt = 0; pt < 2; ++pt) {
#pragma unroll
            for (int r = 0; r < 16; ++r) tr[l31 * 33 + crow(r, hi)] = y[pt][r];
            WSYNC();
            const size_t m = m0 + 32 * lt + row;
            const v4u xa = *(const v4u*)(xbc + m * 1024 + h * 64 + 32 * pt + p0), xb = *(const v4u*)(xbc + m * 1024 + h * 64 + 32 * pt + p0 + 8);
            const unsigned xu[8] = {xa.x, xa.y, xa.z, xa.w, xb.x, xb.y, xb.z, xb.w};
            unsigned ow[8];
#pragma unroll
            for (int q = 0; q < 8; ++q) { const float v0 = tr[row * 33 + p0 + 2 * q] + D * bflo(xu[q]), v1 = tr[row * 33 + p0 + 2 * q + 1] + D * bfhi(xu[q]); ow[q] = cvtpk(v0, v1); }
            bf16_t* dst = yssm + m * 512 + h * 64 + 32 * pt + p0;
            *(v4u*)dst = (v4u){ow[0], ow[1], ow[2], ow[3]}; *(v4u*)(dst + 8) = (v4u){ow[4], ow[5], ow[6], ow[7]};
            WSYNC();
        }
    }
}

struct Args { const float* in[43]; float* out; unsigned char* ws; };
#define GEMM_PHASE(EPI, Aptr, LDA, Bptr, LDB, NN, KK, ...) do { pg8::Gemm g_{(Aptr), (Bptr), M, (NN), (KK), (LDA), (LDB)}; pg8::StaticOrder S_; S_.init(M, (NN), G, (int)blockIdx.x); \
        pg8::EPI E_{__VA_ARGS__}; pg8::gemm_phase<pg8::EPI, pg8::StaticOrder, true, true>(lds3, g_, S_, E_); } while (0)

__global__ void __launch_bounds__(NWAVES * 64, 2) fwd_mega(Args args) {
    extern __shared__ __attribute__((aligned(16))) unsigned char lds[];
    LAS unsigned char* lds3 = (LAS unsigned char*)lds;
    volatile LAS unsigned* MISC = (volatile LAS unsigned*)(lds3 + MISC_OFF);
    const int G = gridDim.x, NGW = G * NWAVES, NT = G * NWAVES * 64;
#define PHASE_IDS() int tid = threadIdx.x; asm volatile("" : "+v"(tid)); const int lane = tid & 63, wave = __builtin_amdgcn_readfirstlane(tid >> 6); const int gw = blockIdx.x * NWAVES + wave, gtid = blockIdx.x * (NWAVES * 64) + tid; (void)lane; (void)gw; (void)gtid
    unsigned char* ws = args.ws;
    gu32* ctl = (gu32*)(ws + WS_CTL);
    for (int u = threadIdx.x; u < (LDS_BYTES - LDSCTL_OFF) / 4; u += NWAVES * 64) ((LAS unsigned*)(lds3 + LDSCTL_OFF))[u] = 0u;
    __syncthreads();
    XcdBarrier bar = xcd_barrier_post((unsigned*)(ctl + CW_BAR), MISC + 8);
#if defined(PROBE_STAMPS)
    int nb_ = 0;
    if (blockIdx.x == 0 && threadIdx.x == 0) MISC[16] = (unsigned)__builtin_amdgcn_s_memrealtime();
#define GRID_BAR() do { xcd_barrier(bar); ++nb_; if (blockIdx.x == 0 && threadIdx.x == 0) MISC[16 + nb_] = (unsigned)__builtin_amdgcn_s_memrealtime(); } while (0)
#else
#define GRID_BAR() xcd_barrier(bar)
#endif
#define IN(i) (args.in[i])
    float* out = args.out;
    bf16_t* W0in = (bf16_t*)(ws + WS_W0IN); bf16_t* W0out = (bf16_t*)(ws + WS_W0OUT); bf16_t* Wup0 = (bf16_t*)(ws + WS_WUP0); bf16_t* Wdn0 = (bf16_t*)(ws + WS_WDN0);
    bf16_t* W1in = (bf16_t*)(ws + WS_W1IN); bf16_t* Wuq = (bf16_t*)(ws + WS_WUQ); bf16_t* Wukv = (bf16_t*)(ws + WS_WUKV); bf16_t* W1out = (bf16_t*)(ws + WS_W1OUT);
    bf16_t* Wup1 = (bf16_t*)(ws + WS_WUP1); bf16_t* Wdn1 = (bf16_t*)(ws + WS_WDN1);
    bf16_t* XB = (bf16_t*)(ws + WS_XB); bf16_t* YMIX = (bf16_t*)(ws + WS_YMIX); bf16_t* PROJ0 = (bf16_t*)(ws + WS_BIG);
    float* YRAW = out; bf16_t* YSSM = (bf16_t*)(out + (size_t)M * 512); bf16_t* STB = (bf16_t*)(out + (size_t)M * 768); bf16_t* XST = (bf16_t*)(ws + WS_XST); bf16_t* BT = (bf16_t*)(ws + WS_BT); float* ASUM = (float*)(ws + WS_ASUM); float* SLOC = (float*)(ws + WS_SLOC); float* DT = (float*)(ws + WS_DT); bf16_t* GB = (bf16_t*)(ws + WS_G); float* BONUS = (float*)(ws + WS_BONUS);
    bf16_t* W2T = (bf16_t*)(ws + WS_W2T); bf16_t* A2T = (bf16_t*)(ws + WS_A2T); bf16_t* G2T = (bf16_t*)(ws + WS_G2T); bf16_t* ACT = (bf16_t*)(ws + WS_GU); bf16_t* HALO = (bf16_t*)(ws + WS_GU + 176 * MiB);
    bf16_t* PROJ1 = (bf16_t*)(ws + WS_PROJ1); bf16_t* QM = (bf16_t*)(ws + WS_QM); bf16_t* KVM = (bf16_t*)(ws + WS_KVM); bf16_t* KPE = (bf16_t*)(ws + WS_KPE); float* RS = (float*)(ws + WS_RS); float* CSTAB = (float*)(ws + WS_CSTAB); bf16_t* VTS = (bf16_t*)(ws + WS_VTS); bf16_t* VTM = (bf16_t*)(ws + WS_VTM);
    const int* pos = (const int*)args.in[1];

    {
        PHASE_IDS();
    {
        LAS float* scr = (LAS float*)(lds3 + wave * 16384);
        transpose_matrix(IN(2), 1024, 3336, W0in, L0P, 1024, scr, gw, NGW, lane, nullptr);
        transpose_matrix(IN(20), 1024, 1024, W0out, 1024, 1024, scr, gw, NGW, lane, nullptr);
        transpose_matrix(IN(23), 1024, 5632, Wup0, 5632, 1024, scr, gw, NGW, lane, nullptr, true);
        transpose_matrix(IN(26), 2816, 1024, Wdn0, 1024, 2816, scr, gw, NGW, lane, nullptr);
        transpose_matrix(IN(29), 1024, 1952, W1in, L1P, 1024, scr, gw, NGW, lane, nullptr);
        transpose_matrix(IN(31), 256, 768, Wuq, 768, 256, scr, gw, NGW, lane, IN(30));
        transpose_matrix(IN(33), 128, 1024, Wukv, 1024, 256, scr, gw, NGW, lane, IN(32));
        for (int i = gtid; i < 1024 * 16; i += NT) { const int n = i >> 4, c = i & 15; *(v4u*)(Wukv + (size_t)n * 256 + 128 + c * 8) = (v4u){0u, 0u, 0u, 0u}; }
        transpose_matrix(IN(34), 1024, 1024, W1out, 1024, 1024, scr, gw, NGW, lane, nullptr);
        transpose_matrix(IN(37), 1024, 5632, Wup1, 5632, 1024, scr, gw, NGW, lane, nullptr, true);
        transpose_matrix(IN(40), 2816, 1024, Wdn1, 1024, 2816, scr, gw, NGW, lane, nullptr);
        transpose_matrix(IN(5), 64, 512, W2T, 512, 64, scr, gw, NGW, lane, nullptr);
        transpose_matrix(IN(7), 64, 512, A2T, 512, 64, scr, gw, NGW, lane, nullptr);
        transpose_matrix(IN(8), 128, 512, G2T, 512, 128, scr, gw, NGW, lane, nullptr);
        const float* x = IN(0);
        {
            constexpr size_t TOT4 = (size_t)M * DM / 4;
            for (size_t i = gtid; i < TOT4; i += (size_t)NT * 8) {
                f32x4 v[8];
#pragma unroll
                for (int u = 0; u < 8; ++u) v[u] = *(const f32x4*)(x + (i + (size_t)u * NT) * 4);
#pragma unroll
                for (int u = 0; u < 8; ++u) { uint2 w; w.x = cvtpk(v[u][0], v[u][1]); w.y = cvtpk(v[u][2], v[u][3]); *(uint2*)(XB + (i + (size_t)u * NT) * 4) = w; }
            }
        }
    }
    }
    GRID_BAR();
    {
        PHASE_IDS();
    GEMM_PHASE(EpiBf16S, XB, DM, W0in, 1024, L0P, 1024, PROJ0, nullptr, L0P, 0);
    }
    GRID_BAR();
    {
        PHASE_IDS();
        const int blk = (int)blockIdx.x, m0 = blk * 128;
        {   LAS bf16_t* scr = (LAS bf16_t*)(lds3 + wave * 16384);
#pragma unroll 1
            for (int k = 0; k < 4; ++k) ssd_conv_tile((2 * blk + (k & 1)) * 16 + wave + 8 * (k >> 1), lane, scr, PROJ0, IN(14), IN(15), XB, XST, BT);
            for (int i = tid; i < 1024; i += NWAVES * 64) { const int m = m0 + (i >> 3); DT[(size_t)m * 8 + (i & 7)] = softplusf_(bf2f(PROJ0[(size_t)m * L0P + 3328 + (i & 7)]) + IN(16)[i & 7]); }
        }
        __syncthreads();
#if defined(PROBE_STAMPS)
        if (blockIdx.x == 0 && threadIdx.x == 0) MISC[16 + 29] = (unsigned)__builtin_amdgcn_s_memrealtime();
#endif
        ssd_s1_unit(blk * 8 + wave, lane, (LAS float*)(lds3 + wave * 16384), XST, BT, DT, IN(17), SLOC, ASUM);
    }
    GRID_BAR();
    {
        PHASE_IDS();
        ssd_s2_all(SLOC, ASUM, STB, gtid, NT);
#if defined(PROBE_STAMPS)
        __syncthreads(); if (blockIdx.x == 0 && threadIdx.x == 0) MISC[16 + 23] = (unsigned)__builtin_amdgcn_s_memrealtime();
#endif
        rwkv_phase((LAS float*)lds3, tid, lane, wave, (int)blockIdx.x, PROJ0, IN(3), IN(4), IN(6), IN(9), IN(10), IN(11), W2T, A2T, G2T, YRAW, GB, BONUS);
    }
    GRID_BAR();
    {
        PHASE_IDS();
        const int blk = (int)blockIdx.x;
        ssd_s3_unit(blk * 8 + wave, lane, (LAS float*)(lds3 + wave * 16384), XB, XST, STB, DT, IN(17), IN(18), YSSM);
        __syncthreads();
        ssm_gate_norm_all(YSSM, PROJ0, IN(19), YMIX, blk * 256 + wave, blk * 256 + 256, lane);
        rwkv_post_all(YRAW, PROJ0, IN(3), BONUS, GB, IN(12), IN(13), YMIX, gw, NGW, lane);
    }
    GRID_BAR();
    {
        PHASE_IDS();
    GEMM_PHASE(EpiResid, YMIX, DM, W0out, 1024, 1024, 1024, IN(0), out, ALPHA, 0);
    }
    GRID_BAR();
    {
        PHASE_IDS();
    ln_rows(out, XB, IN(21), IN(22), gw, NGW, lane);
    }
    GRID_BAR();
    {
        PHASE_IDS();
        { pg8::Gemm g_{XB, Wup0, M / 32, DFF, 1024, DM, 1024, 4096, 8192, 256, 512, 1}; pg8::StaticOrder S_; S_.init(M / 32, DFF, G, (int)blockIdx.x);
          pg8::EpiBf16S E_{HALO, nullptr, DFF, 0}; pg8::gemm_phase<pg8::EpiBf16S, pg8::StaticOrder, true, true>(lds3, g_, S_, E_); }
    }
    GRID_BAR();
    {
        PHASE_IDS();
        { pg8::Gemm g_{XB, Wup0, M, 2 * DFF, 1024, DM, 1024}; pg8::StaticOrder S_; S_.init(M, 2 * DFF, G, (int)blockIdx.x);
          pg8::EpiConvAct E_{ACT, HALO, IN(24), IN(25), DFF, SEQ}; pg8::gemm_phase<pg8::EpiConvAct, pg8::StaticOrder, true, true>(lds3, g_, S_, E_); }
    }
    GRID_BAR();
    {
        PHASE_IDS();
    GEMM_PHASE(EpiResid, ACT, DFF, Wdn0, DFF, 1024, DFF, out, out, ALPHA, 0);
    }
    GRID_BAR();
    {
        PHASE_IDS();
    ln_rows(out, XB, IN(27), IN(28), gw, NGW, lane);
    }
    GRID_BAR();
    {
        PHASE_IDS();
    GEMM_PHASE(EpiBf16S, XB, DM, W1in, 1024, L1P, 1024, PROJ1, nullptr, L1P, 0);
    }
    GRID_BAR();
    {
        PHASE_IDS();
    mla_prep_all(PROJ1, pos, RS, KPE, CSTAB, gw, NGW, lane);
    }
    GRID_BAR();
    {
        PHASE_IDS();
    GEMM_PHASE(EpiBf16S, PROJ1 + 1536, L1P, Wuq, 256, 768, 256, QM, RS, 768, 2);
    GEMM_PHASE(EpiBf16S, PROJ1 + 1792, L1P, Wukv, 256, 1024, 256, KVM, RS + 1, 1024, 2);
    }
    GRID_BAR();
    {
        PHASE_IDS();
    rope_q_all(QM, CSTAB, gtid, NT);
    {
        LAS bf16_t* scr = (LAS bf16_t*)(lds3 + wave * 16384);
        for (int it = gw; it < 8192; it += NGW) { const int which = it >> 12, r = it & 4095, bh = r >> 5, tt = r & 31, b = bh >> 3, h = bh & 7;
            if (which == 0) transpose_tile64(PROJ1 + ((size_t)b * SEQ + tt * 64) * L1P + 1024 + h * 64, L1P, VTS + (size_t)bh * 64 * SEQ + tt * 64, SEQ, scr, lane);
            else            transpose_tile64(KVM + ((size_t)b * SEQ + tt * 64) * 1024 + h * 128 + 64, 1024, VTM + (size_t)bh * 64 * SEQ + tt * 64, SEQ, scr, lane); }
    }
    }
    GRID_BAR();
    {
        PHASE_IDS();
    {
        for (int g2 = (int)blockIdx.x; g2 < 256; g2 += G) { const int bh = g2 >> 1, part = g2 & 1;
#pragma unroll 1
            for (int i = 0; i < 4; ++i) { const int sbk = part ? ((i == 0) ? 1 : (i == 1) ? 6 : (i == 2) ? 2 : 5) : ((i == 0) ? 0 : (i == 1) ? 7 : (i == 2) ? 3 : 4);
                sb_block(bh, sbk, tid, lane, wave, lds3, PROJ1, VTS, YMIX); } }
        for (int g2 = (int)blockIdx.x; g2 < 256; g2 += G) { const int bh = g2 >> 1, part = g2 & 1;
#pragma unroll 1
            for (int i = 0; i < 4; ++i) { const int sbk = part ? ((i == 0) ? 1 : (i == 1) ? 6 : (i == 2) ? 2 : 5) : ((i == 0) ? 0 : (i == 1) ? 7 : (i == 2) ? 3 : 4);
                mla_block(bh, sbk, tid, lane, wave, lds3, QM, KVM, KPE, VTM, YMIX); } }
    }
    }
    GRID_BAR();
    {
        PHASE_IDS();
    GEMM_PHASE(EpiResid, YMIX, DM, W1out, 1024, 1024, 1024, out, out, ALPHA, 0);
    }
    GRID_BAR();
    {
        PHASE_IDS();
    ln_rows(out, XB, IN(35), IN(36), gw, NGW, lane);
    }
    GRID_BAR();
    {
        PHASE_IDS();
        { pg8::Gemm g_{XB, Wup1, M / 32, DFF, 1024, DM, 1024, 4096, 8192, 256, 512, 1}; pg8::StaticOrder S_; S_.init(M / 32, DFF, G, (int)blockIdx.x);
          pg8::EpiBf16S E_{HALO, nullptr, DFF, 0}; pg8::gemm_phase<pg8::EpiBf16S, pg8::StaticOrder, true, true>(lds3, g_, S_, E_); }
    }
    GRID_BAR();
    {
        PHASE_IDS();
        { pg8::Gemm g_{XB, Wup1, M, 2 * DFF, 1024, DM, 1024}; pg8::StaticOrder S_; S_.init(M, 2 * DFF, G, (int)blockIdx.x);
          pg8::EpiConvAct E_{ACT, HALO, IN(38), IN(39), DFF, SEQ}; pg8::gemm_phase<pg8::EpiConvAct, pg8::StaticOrder, true, true>(lds3, g_, S_, E_); }
    }
    GRID_BAR();
    {
        PHASE_IDS();
    GEMM_PHASE(EpiResid, ACT, DFF, Wdn1, DFF, 1024, DFF, out, out, ALPHA, 0);
    }
    GRID_BAR();
    {
        PHASE_IDS();
    ln_rows(out, XB, IN(41), IN(42), gw, NGW, lane);
    #if defined(PROBE_STAMPS)
    __syncthreads();
    if (blockIdx.x == 0 && threadIdx.x == 0) {
        MISC[16 + 22] = (unsigned)__builtin_amdgcn_s_memrealtime();
#if defined(PROBE_ACC)
        const unsigned d1 = MISC[16 + PROBE_ACC];
#else
        const unsigned d1 = MISC[16 + PROBE_T1_HI] - MISC[16 + PROBE_T1_LO];
#endif
        const unsigned long long spin = 100ull * d1;
        const unsigned long long t0 = __builtin_amdgcn_s_memrealtime();
        while (__builtin_amdgcn_s_memrealtime() - t0 < spin) __builtin_amdgcn_s_sleep(8);
    }
#endif
}
}

extern "C" void kernel_launch(void* const* d_in, const int* in_sizes, int n_in, void* d_out, int out_size, void* d_ws, size_t ws_size, hipStream_t stream) {
    static int grid = 0;
    if (grid == 0) {
        if (n_in != 43 || ws_size < WS_NEED || out_size != M * DM) { fprintf(stderr, "kernel_launch: unexpected n_in %d / ws %zu / out %d\n", n_in, ws_size, out_size); grid = -1; return; }
        int dev = 0, cus = 0, per_cu = 0;
        if (hipGetDevice(&dev) != hipSuccess || hipDeviceGetAttribute(&cus, hipDeviceAttributeMultiprocessorCount, dev) != hipSuccess) { grid = -1; return; }
        if (hipFuncSetAttribute((const void*)fwd_mega, hipFuncAttributeMaxDynamicSharedMemorySize, LDS_BYTES) != hipSuccess) { fprintf(stderr, "kernel_launch: hipFuncSetAttribute failed\n"); grid = -1; return; }
        if (hipOccupancyMaxActiveBlocksPerMultiprocessor(&per_cu, (const void*)fwd_mega, NWAVES * 64, LDS_BYTES) != hipSuccess || per_cu < 1) fprintf(stderr, "kernel_launch: occupancy query reports %d\n", per_cu);
        (void)hipGetLastError();
        grid = cus;
    }
    if (grid < 0) return;
    (void)hipMemsetAsync((char*)d_ws + WS_CTL, 0, CTL_ZERO_BYTES, stream);
    Args a{};
    for (int i = 0; i < 43; ++i) a.in[i] = (const float*)d_in[i];
    a.out = (float*)d_out; a.ws = (unsigned char*)d_ws;
    hipLaunchKernelGGL(fwd_mega, dim3(grid), dim3(NWAVES * 64), LDS_BYTES, stream, a);
}
```

```cpp
#include <hip/hip_runtime.h>
#include <cstdio>
#include <cstdint>
#include <cmath>
namespace pg8 {
#define PG8_LAS __attribute__((address_space(3)))
typedef unsigned short bf16_t;
typedef short bf16x8 __attribute__((ext_vector_type(8)));
typedef float f32x4 __attribute__((ext_vector_type(4)));
typedef unsigned u32x4 __attribute__((ext_vector_type(4)));
constexpr int BM = 256, BK = 64, HALF = 128, HTB = HALF * BK * 2  , STAGE_BYTES = 8 * HTB, NXCD = 8, WGM = 8;

__host__ __device__ __forceinline__ int lds_byte(int r, int c) { const int st = (r >> 4) * 2 + (c >> 5), rr = r & 15, cc = c & 31, ob = rr * 64 + cc * 2; return st * 1024 + (ob ^ (((ob >> 9) & 1) << 5)); }
__host__ __device__ __forceinline__ void stage_rc(int b, int& R, int& C) { const int st = b / 1024, sb = b % 1024, swz = sb ^ (((sb >> 9) & 1) << 5); R = (st >> 1) * 16 + swz / 64; C = (st & 1) * 32 + (swz % 64) / 2; }
__host__ __device__ __forceinline__ int perm32(int rho) { const int n = rho >> 4, i = rho & 15; return 8 * (i >> 2) + 4 * n + (i & 3); }

struct Unit { int pm, pn; };
struct Gemm { const bf16_t* A; const bf16_t* Bt; int M, N, K, lda, ldb; int hrA = 128, trA = 256, hrB = 128, trB = 256, gatherA = 0; };

struct StaticOrder {
    int nM, nN, nwg, G, c;
    __host__ __device__ void init(int M, int N, int G_, int c_) { nM = M / BM; nN = N / BM; nwg = nM * nN; G = G_; c = c_; }
    __host__ __device__ bool next(int i, Unit& u) const {
        const long L = (long)i * G + c; if (L >= nwg) return false;
        int wgid = (int)L; { const int q = nwg / NXCD, r = nwg % NXCD, xcd = wgid % NXCD, off = wgid / NXCD; wgid = (xcd < r ? xcd * (q + 1) : r * (q + 1) + (xcd - r) * q) + off; }
        const int nig = WGM * nN, gid = wgid / nig, fm = gid * WGM, gsz = (nM - fm) < WGM ? (nM - fm) : WGM;
        u.pm = fm + ((wgid % nig) % gsz); u.pn = (wgid % nig) / gsz; return true;
    }
    __device__ __forceinline__ void a_ready(const Unit&) const {}
    __device__ __forceinline__ void done(const Unit&) const {}
};


__device__ __forceinline__ unsigned cvt_pk_bf16(float lo, float hi) { unsigned r; asm volatile("v_cvt_pk_bf16_f32 %0, %1, %2" : "=v"(r) : "v"(lo), "v"(hi)); return r; }
struct EpiBf16S {
    static constexpr bool PERM = true, AFTER_DRAIN = false;
    bf16_t* O; const float* rowscale; int ldc; int rs_stride;
    __device__ __forceinline__ void operator()(const f32x4 (&acc)[2][2][4][2], const Unit& u, int wr, int wc, int fr, int fq) const {
        const int row0 = u.pm * BM + wr * 64 + fr, col0 = u.pn * BM + wc * 32 + 8 * fq;
#pragma unroll
        for (int ai = 0; ai < 2; ++ai)
#pragma unroll
            for (int m = 0; m < 4; ++m) { const int row = row0 + ai * HALF + m * 16; const float sc = rowscale ? rowscale[(size_t)row * rs_stride] : 1.f;
                bf16_t* rowp = O + (size_t)row * ldc + col0;
#pragma unroll
                for (int bj = 0; bj < 2; ++bj) { const f32x4 v0 = acc[ai][bj][m][0] * sc, v1 = acc[ai][bj][m][1] * sc;
                    u32x4 w; w.x = cvt_pk_bf16(v0[0], v0[1]); w.y = cvt_pk_bf16(v0[2], v0[3]); w.z = cvt_pk_bf16(v1[0], v1[1]); w.w = cvt_pk_bf16(v1[2], v1[3]);
                    *(u32x4*)(rowp + bj * HALF) = w; } }
    }
};
struct EpiResid {
    static constexpr bool PERM = false, AFTER_DRAIN = false;
    const float* hin; float* hout; float alpha; int pad;
    __device__ __forceinline__ void operator()(const f32x4 (&acc)[2][2][4][2], const Unit& u, int wr, int wc, int fr, int fq) const {
        const int row0 = u.pm * BM + wr * 64 + fr, col0 = u.pn * BM + wc * 32 + 4 * fq;
#pragma unroll
        for (int ai = 0; ai < 2; ++ai)
#pragma unroll
            for (int m = 0; m < 4; ++m) { const size_t off = (size_t)(row0 + ai * HALF + m * 16) * 1024 + col0;
#pragma unroll
                for (int bj = 0; bj < 2; ++bj)
#pragma unroll
                    for (int n = 0; n < 2; ++n) { const size_t i = off + bj * HALF + n * 16; const f32x4 h = *(const f32x4*)(hin + i); *(f32x4*)(hout + i) = h * alpha + acc[ai][bj][m][n]; } }
    }
};

struct EpiResidLN {
    static constexpr bool PERM = false, AFTER_DRAIN = false;
    float* hio; const float* stats; const float* g; const float* b; float alpha; int pad;
    __device__ __forceinline__ void operator()(const f32x4 (&acc)[2][2][4][2], const Unit& u, int wr, int wc, int fr, int fq) const {
        const int row0 = u.pm * BM + wr * 64 + fr, col0 = u.pn * BM + wc * 32 + 4 * fq;
        f32x4 gg[2][2], bb[2][2];
#pragma unroll
        for (int bj = 0; bj < 2; ++bj)
#pragma unroll
            for (int n = 0; n < 2; ++n) { gg[bj][n] = *(const f32x4*)(g + col0 + bj * HALF + n * 16) * alpha; bb[bj][n] = *(const f32x4*)(b + col0 + bj * HALF + n * 16) * alpha; }
#pragma unroll
        for (int ai = 0; ai < 2; ++ai)
#pragma unroll
            for (int m = 0; m < 4; ++m) { const int row = row0 + ai * HALF + m * 16; const size_t off = (size_t)row * 1024 + col0;
                const float mu = stats[2 * row], rs = stats[2 * row + 1];
#pragma unroll
                for (int bj = 0; bj < 2; ++bj)
#pragma unroll
                    for (int n = 0; n < 2; ++n) { const size_t i = off + bj * HALF + n * 16; const f32x4 p = *(const f32x4*)(hio + i); *(f32x4*)(hio + i) = (p - mu) * rs * gg[bj][n] + bb[bj][n] + acc[ai][bj][m][n]; } }
    }
};

template <int CTRL> __device__ __forceinline__ float pg_dpp(float x) { return __builtin_bit_cast(float, __builtin_amdgcn_update_dpp(0, __builtin_bit_cast(int, x), CTRL, 0xF, 0xF, true)); }
struct EpiConvAct {
    static constexpr bool PERM = true, AFTER_DRAIN = false;
    bf16_t* act; const bf16_t* halo; const float* cw; const float* cb; int dff; int seq;
    __device__ __forceinline__ void operator()(const f32x4 (&acc)[2][2][4][2], const Unit& u, int wr, int wc, int fr, int fq) const {
        typedef unsigned u32x2e __attribute__((ext_vector_type(2)));
#pragma unroll
        for (int n = 0; n < 2; ++n) {
            const int ch0 = u.pn * 128 + wc * 32 + 8 * fq + 4 * n;
            const f32x4 w0 = *(const f32x4*)(cw + ch0), w1 = *(const f32x4*)(cw + dff + ch0), w2 = *(const f32x4*)(cw + 2 * dff + ch0), bb = *(const f32x4*)(cb + ch0);
#pragma unroll
            for (int ai = 0; ai < 2; ++ai) {
                const int rb64 = u.pm * BM + ai * HALF + wr * 64;
                f32x4 P = {0.f, 0.f, 0.f, 0.f};
                if ((rb64 & (seq - 1)) != 0 && fr >= 14) { const u32x2e hv = *(const u32x2e*)(halo + (size_t)(2 * (rb64 / 64 - 1) + (fr - 14)) * dff + ch0);
                    P[0] = __builtin_bit_cast(float, hv.x << 16); P[1] = __builtin_bit_cast(float, hv.x & 0xffff0000u); P[2] = __builtin_bit_cast(float, hv.y << 16); P[3] = __builtin_bit_cast(float, hv.y & 0xffff0000u); }
#pragma unroll
                for (int m = 0; m < 4; ++m) {
                    const f32x4 Gv = acc[ai][0][m][n], Uv = acc[ai][1][m][n];
                    float o[4];
#pragma unroll
                    for (int e = 0; e < 4; ++e) {
                        const float t1 = pg_dpp<0x111>(Gv[e]), t2 = pg_dpp<0x112>(Gv[e]), p1 = pg_dpp<0x10F>(P[e]), p2 = pg_dpp<0x10E>(P[e]);
                        const float g1 = (fr >= 1) ? t1 : p1, g2 = (fr >= 2) ? t2 : p2;
                        const float y = bb[e] + w0[e] * g2 + w1[e] * g1 + w2[e] * Gv[e];
                        o[e] = y / (1.f + __expf(-y)) * Uv[e];
                    }
                    u32x2e w; w.x = cvt_pk_bf16(o[0], o[1]); w.y = cvt_pk_bf16(o[2], o[3]);
                    *(u32x2e*)(act + (size_t)(rb64 + m * 16 + fr) * dff + ch0) = w;
                    P = Gv;
                }
            }
        }
    }
};

template <class Epi, class Sched, bool ALIGN_EPI = false, bool SP2 = false>
__device__ __forceinline__ void gemm_phase(PG8_LAS unsigned char* lds, const Gemm g, const Sched& S, const Epi& E) {
    int tid = threadIdx.x; asm volatile("" : "+v"(tid));
    const int wid = __builtin_amdgcn_readfirstlane(tid >> 6), lane = tid & 63, wr = wid >> 2, wc = wid & 3, fr = lane & 15, fq = lane >> 4;
    const int K = g.K, nt = K / BK;
    unsigned voffA[2], voffB[2];
#pragma unroll
    for (int i = 0; i < 2; ++i) { int R, C; stage_rc(tid * 16 + i * 8192, R, C); const int Rb = Epi::PERM ? ((R & ~31) + perm32(R & 31)) : R;
        const int Ra = g.gatherA ? (64 * (R >> 1) + 62 + (R & 1)) : R;
        voffA[i] = (unsigned)(Ra * g.lda + C) * 2u; voffB[i] = (unsigned)(Rb * g.ldb + C) * 2u; }
    const size_t kstep = (size_t)(BK * 2);
    const size_t hstepA = (size_t)g.hrA * g.lda * 2, hstepB = (size_t)g.hrB * g.ldb * 2;
    const size_t tstepA = (size_t)g.trA * g.lda * 2, tstepB = (size_t)g.trB * g.ldb * 2;
    const unsigned ldsw = (unsigned)wid * 1024u;
    const int aoff = lds_byte(wr * 64 + fr, fq * 8), boff = lds_byte(wc * 32 + fr, fq * 8);
#define PG8_SA(b, h) (((b) * 2 + (h)) * HTB)
#define PG8_SB(b, h) ((4 + (b) * 2 + (h)) * HTB)
#define PG8_STAGE(bufoff, gbase, voff) do { _Pragma("unroll") for (int _i = 0; _i < 2; ++_i) \
        __builtin_amdgcn_global_load_lds((const unsigned*)((const char*)(gbase) + (voff)[_i]), (PG8_LAS unsigned*)(lds + (bufoff) + ldsw + _i * 8192), 16, 0, 0); } while (0)
#define PG8_LDA(dst, b, h) do { _Pragma("unroll") for (int m = 0; m < 4; ++m) _Pragma("unroll") for (int k = 0; k < 2; ++k) dst[m][k] = *(const PG8_LAS bf16x8*)(lds + PG8_SA(b, h) + aoff + m * 2048 + k * 1024); } while (0)
#define PG8_LDB(dst, b, h) do { _Pragma("unroll") for (int n = 0; n < 2; ++n) _Pragma("unroll") for (int k = 0; k < 2; ++k) dst[n][k] = *(const PG8_LAS bf16x8*)(lds + PG8_SB(b, h) + boff + n * 2048 + k * 1024); } while (0)
#define PG8_MMA(ai, bj, At, Bt) do { __builtin_amdgcn_s_setprio(1); _Pragma("unroll") for (int m = 0; m < 4; ++m) _Pragma("unroll") for (int n = 0; n < 2; ++n) _Pragma("unroll") for (int k = 0; k < 2; ++k) \
        acc[ai][bj][m][n] = __builtin_amdgcn_mfma_f32_16x16x32_bf16(Bt[n][k], At[m][k], acc[ai][bj][m][n], 0, 0, 0); __builtin_amdgcn_s_setprio(0); } while (0)
#define PG8_WAIT_V(n) asm volatile("s_waitcnt vmcnt(" #n ")" ::: "memory")
#define PG8_WAIT_L(n) asm volatile("s_waitcnt lgkmcnt(" #n ")" ::: "memory")
#define PG8_BAR __builtin_amdgcn_s_barrier()
#define PG8_SCHED __builtin_amdgcn_sched_barrier(0)
    Unit cur, nxt; int ui = 0;
    if (!S.next(0, cur)) return;
    f32x4 acc[2][2][4][2];
#pragma unroll
    for (int a = 0; a < 2; ++a)
#pragma unroll
        for (int b = 0; b < 2; ++b)
#pragma unroll
            for (int m = 0; m < 4; ++m)
#pragma unroll
                for (int n = 0; n < 2; ++n) acc[a][b][m][n] = (f32x4){0.f, 0.f, 0.f, 0.f};
    bf16x8 At[4][2], B0[2][2], B1[2][2];
    const char* cA = (const char*)g.A + (size_t)cur.pm * tstepA; const char* cB = (const char*)g.Bt + (size_t)cur.pn * tstepB;
    S.a_ready(cur);
    if constexpr (SP2) {
        PG8_STAGE(PG8_SB(0, 0), cB, voffB); PG8_STAGE(PG8_SB(0, 1), cB + hstepB, voffB); PG8_STAGE(PG8_SA(0, 0), cA, voffA); PG8_STAGE(PG8_SA(0, 1), cA + hstepA, voffA);
        if (wr == 1) PG8_BAR;
        PG8_WAIT_V(2); PG8_BAR;
        PG8_STAGE(PG8_SB(1, 0), cB + kstep, voffB); PG8_STAGE(PG8_SA(1, 0), cA + kstep, voffA); PG8_STAGE(PG8_SB(1, 1), cB + hstepB + kstep, voffB);
        PG8_WAIT_V(6); PG8_BAR;
    } else {
        PG8_STAGE(PG8_SB(0, 0), cB, voffB); PG8_STAGE(PG8_SA(0, 0), cA, voffA); PG8_STAGE(PG8_SB(0, 1), cB + hstepB, voffB); PG8_STAGE(PG8_SA(0, 1), cA + hstepA, voffA);
        if (wr == 1) PG8_BAR;
        PG8_WAIT_V(4); PG8_BAR;
        PG8_STAGE(PG8_SB(1, 0), cB + kstep, voffB); PG8_STAGE(PG8_SA(1, 0), cA + kstep, voffA); PG8_STAGE(PG8_SB(1, 1), cB + hstepB + kstep, voffB);
        PG8_WAIT_V(6); PG8_BAR;
    }
    for (;;) {
        const bool has_next = S.next(ui + 1, nxt);
        const char* nA = has_next ? (const char*)g.A + (size_t)nxt.pm * tstepA : cA; const char* nB = has_next ? (const char*)g.Bt + (size_t)nxt.pn * tstepB : cB;
        for (int t = 0; t < nt; t += 2) {
            const bool last = (t == nt - 2);
            const char* a1 = cA + (size_t)(t + 1) * kstep;
            const char* a2 = last ? nA : cA + (size_t)(t + 2) * kstep; const char* b2 = last ? nB : cB + (size_t)(t + 2) * kstep;
            const char* a3 = a2 + kstep; const char* b3 = b2 + kstep;
            if (last && has_next) S.a_ready(nxt);
            if constexpr (SP2) {
            PG8_LDB(B0, 0, 0); PG8_LDB(B1, 0, 1); PG8_SCHED; PG8_LDA(At, 0, 0); PG8_STAGE(PG8_SA(1, 1), a1 + hstepA, voffA);
            PG8_WAIT_V(8); PG8_WAIT_L(0); PG8_BAR; PG8_MMA(0, 0, At, B0); PG8_MMA(0, 1, At, B1); PG8_BAR; PG8_SCHED;
            PG8_LDA(At, 0, 1); PG8_STAGE(PG8_SB(0, 0), b2, voffB); PG8_STAGE(PG8_SB(0, 1), b2 + hstepB, voffB); PG8_STAGE(PG8_SA(0, 0), a2, voffA);
            PG8_WAIT_V(8); PG8_WAIT_L(0); PG8_BAR; PG8_MMA(1, 0, At, B0); PG8_MMA(1, 1, At, B1); PG8_BAR; PG8_SCHED;
            PG8_LDB(B0, 1, 0); PG8_LDB(B1, 1, 1); PG8_SCHED; PG8_LDA(At, 1, 0); PG8_STAGE(PG8_SA(0, 1), a2 + hstepA, voffA);
            PG8_WAIT_V(8); PG8_WAIT_L(0); PG8_BAR; PG8_MMA(0, 0, At, B0); PG8_MMA(0, 1, At, B1); PG8_BAR; PG8_SCHED;
            PG8_LDA(At, 1, 1); PG8_STAGE(PG8_SB(1, 0), b3, voffB); PG8_STAGE(PG8_SB(1, 1), b3 + hstepB, voffB); PG8_STAGE(PG8_SA(1, 0), a3, voffA);
            PG8_WAIT_V(8); PG8_WAIT_L(0); PG8_BAR; PG8_MMA(1, 0, At, B0); PG8_MMA(1, 1, At, B1); PG8_BAR; PG8_SCHED;
            } else {
            PG8_LDB(B0, 0, 0); PG8_SCHED; PG8_LDA(At, 0, 0); PG8_STAGE(PG8_SA(1, 1), a1 + hstepA, voffA);
            PG8_WAIT_L(8); PG8_BAR; PG8_WAIT_L(0); PG8_MMA(0, 0, At, B0); PG8_BAR; PG8_SCHED;
            PG8_LDB(B1, 0, 1); PG8_STAGE(PG8_SB(0, 0), b2, voffB);
            PG8_BAR; PG8_WAIT_L(0); PG8_MMA(0, 1, At, B1); PG8_BAR;
            PG8_LDA(At, 0, 1); PG8_STAGE(PG8_SA(0, 0), a2, voffA);
            PG8_BAR; PG8_WAIT_L(0); PG8_MMA(1, 0, At, B0); PG8_BAR; PG8_SCHED;
            PG8_STAGE(PG8_SB(0, 1), b2 + hstepB, voffB);
            PG8_WAIT_V(6); PG8_BAR; PG8_MMA(1, 1, At, B1); PG8_BAR;
            PG8_LDB(B0, 1, 0); PG8_SCHED; PG8_LDA(At, 1, 0); PG8_STAGE(PG8_SA(0, 1), a2 + hstepA, voffA);
            PG8_WAIT_L(8); PG8_BAR; PG8_WAIT_L(0); PG8_MMA(0, 0, At, B0); PG8_BAR; PG8_SCHED;
            PG8_LDB(B1, 1, 1); PG8_STAGE(PG8_SB(1, 0), b3, voffB);
            PG8_BAR; PG8_WAIT_L(0); PG8_MMA(0, 1, At, B1); PG8_BAR;
            PG8_LDA(At, 1, 1); PG8_STAGE(PG8_SA(1, 0), a3, voffA);
            PG8_BAR; PG8_WAIT_L(0); PG8_MMA(1, 0, At, B0); PG8_BAR; PG8_SCHED;
            PG8_STAGE(PG8_SB(1, 1), b3 + hstepB, voffB);
            PG8_WAIT_V(6); PG8_BAR; PG8_MMA(1, 1, At, B1); PG8_BAR;
            }
        }
        if constexpr (ALIGN_EPI) { if (wr == 0) PG8_BAR; }
        if constexpr (!Epi::AFTER_DRAIN) { E(acc, cur, wr, wc, fr, fq); S.done(cur); }
        if (!has_next) break;
#pragma unroll
        for (int a = 0; a < 2; ++a)
#pragma unroll
            for (int b = 0; b < 2; ++b)
#pragma unroll
                for (int m = 0; m < 4; ++m)
#pragma unroll
                    for (int n = 0; n < 2; ++n) acc[a][b][m][n] = (f32x4){0.f, 0.f, 0.f, 0.f};
        cur = nxt; cA = nA; cB = nB; ++ui;
        if constexpr (ALIGN_EPI) { if (wr == 1) PG8_BAR; }
    }
    PG8_WAIT_V(0);
    if constexpr (!ALIGN_EPI) { if (wr == 0) PG8_BAR; }
    PG8_BAR;
    if constexpr (Epi::AFTER_DRAIN) { E.fused(acc, cur, wr, wc, fr, fq, lds, wid, lane); S.done(cur); }
#undef PG8_SA
#undef PG8_SB
#undef PG8_STAGE
#undef PG8_LDA
#undef PG8_LDB
#undef PG8_MMA
#undef PG8_WAIT_V
#undef PG8_WAIT_L
#undef PG8_BAR
#undef PG8_SCHED
}
}
#define GAS __attribute__((address_space(1)))
#define LAS __attribute__((address_space(3)))
typedef unsigned short bf16;
typedef unsigned v4u __attribute__((ext_vector_type(4)));
typedef float f32x4 __attribute__((ext_vector_type(4)));
typedef short bf16x8 __attribute__((ext_vector_type(8)));
typedef GAS unsigned gu32;
typedef GAS unsigned long long gu64;
#define RLX_AGENT __ATOMIC_RELAXED, __HIP_MEMORY_SCOPE_AGENT
#define LDS_WAIT() asm volatile("s_waitcnt lgkmcnt(0)" ::: "memory")
#define VM_WAIT() asm volatile("s_waitcnt vmcnt(0)" ::: "memory")
__device__ __forceinline__ unsigned long long rt() { return __builtin_amdgcn_s_memrealtime(); }
__device__ __forceinline__ unsigned f2bf(float f) { unsigned u = __builtin_bit_cast(unsigned, f); return (u + 0x7fffu + ((u >> 16) & 1u)) >> 16; }
__device__ __forceinline__ unsigned pk2(float lo, float hi) { return f2bf(lo) | (f2bf(hi) << 16); }

#define XB_TMO      128
#define XB_XCNT(j)  (256  + 64 * (j))
#define XB_XSUB(j)  (1280 + 64 * (j))
#define XB_XGEN(j)  (2304 + 64 * (j))
#define XB_TOP      3328
#define XB_TOPGEN   3392
#define XCD_BAR_WORDS 3456
#define XB_SPIN_CAP (1u << 18)

__device__ __forceinline__ unsigned xb_ld(unsigned* p)              { return __hip_atomic_load(p, __ATOMIC_RELAXED, __HIP_MEMORY_SCOPE_AGENT); }
__device__ __forceinline__ unsigned xb_add(unsigned* p, unsigned v) { return __hip_atomic_fetch_add(p, v, __ATOMIC_RELAXED, __HIP_MEMORY_SCOPE_AGENT); }
__device__ __forceinline__ unsigned xb_xcc_id() { return (unsigned)__builtin_amdgcn_s_getreg((3 << 11) | 20) & 0xFu; }
#define XB_SPIN(cond, bar) do { unsigned _sp = 0; while (cond) { __builtin_amdgcn_s_sleep(1); \
    if ((++_sp & 255u) == 0u) { if (xb_ld(&(bar)[XB_TMO])) break; if (_sp > XB_SPIN_CAP) { atomicAdd(&(bar)[XB_TMO], 1u); break; } } } } while (0)

struct XcdBarrier {
    unsigned* bar; unsigned x;
    volatile LAS unsigned* st;
};

__device__ __forceinline__ XcdBarrier xcd_barrier_post(unsigned* bar, volatile LAS unsigned* st) {
    XcdBarrier b; b.bar = bar; b.x = xb_xcc_id(); b.st = st;
    if (threadIdx.x == 0) (void)xb_add(&bar[XB_XCNT(b.x)], 1u);
    return b;
}
__device__ __forceinline__ void xcd_barrier_complete(unsigned* bar, unsigned x, unsigned& nloc, unsigned& nx) {
    const unsigned G = gridDim.x * gridDim.y * gridDim.z;
    unsigned sum, cnt, mine, sp = 0u;
    for (;;) {
        sum = 0u; cnt = 0u; mine = 0u;
#pragma unroll
        for (unsigned j = 0; j < 16; ++j) { const unsigned c = xb_ld(&bar[XB_XCNT(j)]); sum += c; cnt += (c > 0u) ? 1u : 0u; mine = (j == x) ? c : mine; }
        if (sum == G) break;
        __builtin_amdgcn_s_sleep(1);
        if ((++sp & 255u) == 0u) { if (xb_ld(&bar[XB_TMO])) break; if (sp > XB_SPIN_CAP) { atomicAdd(&bar[XB_TMO], 1u); break; } }
    }
    nloc = mine > 0u ? mine : 1u; nx = cnt > 0u ? cnt : 1u;
}

__device__ __forceinline__ void xcd_barrier(const XcdBarrier& b) {
    asm volatile("s_waitcnt vmcnt(0)" ::: "memory");
    __syncthreads();
    if (threadIdx.x == 0) {
        unsigned* bar = b.bar;
        __builtin_amdgcn_s_waitcnt(0);
        unsigned nloc = b.st[0], nx = b.st[1];
        if (nloc == 0u) { xcd_barrier_complete(bar, b.x, nloc, nx); b.st[0] = nloc; b.st[1] = nx; }
        const unsigned old = xb_add(&bar[XB_XSUB(b.x)], 1u);
        const unsigned gen = old / nloc;
        if (old + 1u == (gen + 1u) * nloc) {
            __builtin_amdgcn_fence(__ATOMIC_RELEASE, "agent");
            asm volatile("s_waitcnt vmcnt(0)" ::: "memory");
            const unsigned og = xb_add(&bar[XB_TOP], 1u);
            const unsigned tg = og / nx;
            if (og + 1u == (tg + 1u) * nx) xb_add(&bar[XB_TOPGEN], 1u);
            else XB_SPIN(xb_ld(&bar[XB_TOPGEN]) == tg, bar);
            __builtin_amdgcn_fence(__ATOMIC_ACQUIRE, "agent");
            xb_add(&bar[XB_XGEN(b.x)], 1u);
            asm volatile("s_waitcnt vmcnt(0)" ::: "memory");
        } else {
            XB_SPIN(xb_ld(&bar[XB_XGEN(b.x)]) == gen, bar);
            __builtin_amdgcn_fence(__ATOMIC_ACQUIRE, "agent");
            asm volatile("s_waitcnt vmcnt(0)" ::: "memory");
        }
    }
    __syncthreads();
}
constexpr int NWAVES = 8;
constexpr int BATCH = 16, SEQ = 2048, DM = 1024, M = BATCH * SEQ;
constexpr int L0P = 3584;
constexpr int L1P = 2048;
constexpr int DFF = 2816;
constexpr float ALPHA = 1.4142135623730951f;
typedef unsigned short bf16_t;
typedef float f32x16 __attribute__((ext_vector_type(16)));

constexpr size_t MiB = 1u << 20;
constexpr size_t WS_CTL = 0, CTL_ZERO_BYTES = 1 * MiB;
constexpr int CW_BAR = 4096;
constexpr size_t WS_W0IN = 2 * MiB, WS_W0OUT = 9 * MiB, WS_WUP0 = 11 * MiB, WS_WDN0 = 22 * MiB, WS_W1IN = 28 * MiB, WS_WUQ = 32 * MiB, WS_WUKV = 33 * MiB,
                 WS_W1OUT = 34 * MiB, WS_WUP1 = 36 * MiB, WS_WDN1 = 47 * MiB;
constexpr size_t WS_XB = 56 * MiB, WS_YMIX = 120 * MiB, WS_BIG = 184 * MiB;
constexpr size_t WS_G = 408 * MiB, WS_BONUS = 440 * MiB, WS_DT = 441 * MiB, WS_XST = 442 * MiB, WS_BT = 474 * MiB, WS_ASUM = 490 * MiB;
constexpr size_t WS_SLOC = 120 * MiB;
constexpr size_t WS_W2T = 53 * MiB, WS_A2T = 53 * MiB + 256 * 1024, WS_G2T = 53 * MiB + 512 * 1024;
constexpr size_t WS_GU = 120 * MiB;
constexpr size_t WS_PROJ1 = 184 * MiB, WS_QM = 312 * MiB, WS_KVM = 360 * MiB, WS_KPE = 424 * MiB, WS_RS = 426 * MiB;
constexpr size_t WS_CSTAB = 492 * MiB;
constexpr size_t WS_VTS = 428 * MiB, WS_VTM = 460 * MiB;
constexpr size_t WS_NEED = 497 * MiB;

constexpr int RING_BYTES = 131072;
constexpr int LDSCTL_OFF = 146432, MISC_OFF = LDSCTL_OFF + 320;
constexpr int LDS_BYTES = 147456;

__device__ __forceinline__ float bf2f(bf16_t b) { return __builtin_bit_cast(float, (unsigned)b << 16); }
__device__ __forceinline__ float sigmoidf_(float x) { return 1.f / (1.f + expf(-x)); }
__device__ __forceinline__ float softplusf_(float x) { return fmaxf(x, 0.f) + log1pf(expf(-fabsf(x))); }
__device__ __forceinline__ float siluf_(float x) { return x / (1.f + expf(-x)); }
__device__ __forceinline__ float wave_sum(float v) {
#pragma unroll
    for (int o = 1; o < 64; o <<= 1) v += __shfl_xor(v, o);
    return v;
}
#define WSYNC() asm volatile("s_waitcnt lgkmcnt(0)" ::: "memory")
typedef float f32x2_t __attribute__((ext_vector_type(2)));
typedef __bf16 bf16x2_t __attribute__((ext_vector_type(2)));
typedef unsigned u32x2 __attribute__((ext_vector_type(2)));
__device__ __forceinline__ unsigned cvtpk(float lo, float hi) { f32x2_t v = {lo, hi}; bf16x2_t b = __builtin_convertvector(v, bf16x2_t); return __builtin_bit_cast(unsigned, b); }
__device__ __forceinline__ float bflo(unsigned u) { return __builtin_bit_cast(float, u << 16); }
__device__ __forceinline__ float bfhi(unsigned u) { return __builtin_bit_cast(float, u & 0xffff0000u); }
__device__ __forceinline__ bf16_t bf1(float x) { return (bf16_t)(cvtpk(x, x) & 0xffffu); }
template <int CTRL> __device__ __forceinline__ float dpp_mov(float x) { return __builtin_bit_cast(float, __builtin_amdgcn_update_dpp(0, __builtin_bit_cast(int, x), CTRL, 0xF, 0xF, true)); }
__device__ __forceinline__ float rowsum16(float x) { x += dpp_mov<0x128>(x); x += dpp_mov<0x124>(x); x += dpp_mov<0x122>(x); x += dpp_mov<0x121>(x); return x; }
__device__ __forceinline__ float rl(float x, int l) { return __builtin_bit_cast(float, __builtin_amdgcn_readlane(__builtin_bit_cast(int, x), l)); }
__device__ __forceinline__ float wave_sum_dpp(float x) { x = rowsum16(x); return (rl(x, 0) + rl(x, 16)) + (rl(x, 32) + rl(x, 48)); }

__device__ __forceinline__ void transpose_matrix(const float* __restrict__ W, int K, int N, bf16_t* __restrict__ WT, int Npad, int ldt, LAS float* scr, int gw, int NGW, int lane, const float* __restrict__ kscale, bool ffn_interleave = false) {
    (void)scr;
    const int nblk = Npad / 64, nit = (K / 64) * nblk;
    for (int it = gw; it < nit; it += NGW) {
        const int kb = it / nblk, nb = it - kb * nblk, n = nb * 64 + lane, k0 = kb * 64;
        const bool ok = n < N; const float* src = W + (size_t)k0 * N + (ok ? n : 0);
#pragma unroll
        for (int hc = 0; hc < 2; ++hc) {
            float v[32];
#pragma unroll
            for (int i = 0; i < 32; ++i) v[i] = src[(size_t)(hc * 32 + i) * N];
#pragma unroll
            for (int c = 0; c < 4; ++c) { float u[8];
#pragma unroll
                for (int i = 0; i < 8; ++i) { u[i] = ok ? v[c * 8 + i] : 0.f; if (kscale) u[i] *= kscale[k0 + hc * 32 + c * 8 + i]; }
                v4u o; o.x = cvtpk(u[0], u[1]); o.y = cvtpk(u[2], u[3]); o.z = cvtpk(u[4], u[5]); o.w = cvtpk(u[6], u[7]);
                const int nr = ffn_interleave ? ((n < DFF) ? 256 * (n >> 7) + (n & 127) : 256 * ((n - DFF) >> 7) + 128 + ((n - DFF) & 127)) : n;
                *(v4u*)(WT + (size_t)nr * ldt + k0 + hc * 32 + c * 8) = o; }
        }
    }
}

template <int MODE> __device__ __forceinline__ void ln_rows(float* h, bf16_t* hb, float* stats, const float* __restrict__ g, const float* __restrict__ b, int gw, int NGW, int lane) {
    for (int row = gw * 2; row < M; row += NGW * 2) {
        float* p = h + (size_t)row * DM;
        f32x4 v[2][4]; float s[2] = {0.f, 0.f};
#pragma unroll
        for (int r = 0; r < 2; ++r)
#pragma unroll
            for (int j = 0; j < 4; ++j) v[r][j] = *(const f32x4*)(p + r * DM + 4 * lane + 256 * j);
#pragma unroll
        for (int r = 0; r < 2; ++r)
#pragma unroll
            for (int j = 0; j < 4; ++j) s[r] += (v[r][j][0] + v[r][j][1]) + (v[r][j][2] + v[r][j][3]);
        float mean[2], q[2] = {0.f, 0.f}, rstd[2];
#pragma unroll
        for (int r = 0; r < 2; ++r) { mean[r] = wave_sum_dpp(s[r]) * (1.f / DM);
#pragma unroll
            for (int j = 0; j < 4; ++j) { v[r][j] = v[r][j] - mean[r]; q[r] += (v[r][j][0] * v[r][j][0] + v[r][j][1] * v[r][j][1]) + (v[r][j][2] * v[r][j][2] + v[r][j][3] * v[r][j][3]); } }
#pragma unroll
        for (int r = 0; r < 2; ++r) rstd[r] = 1.0f / sqrtf(wave_sum_dpp(q[r]) * (1.f / DM) + 1e-5f);
        if (MODE == 1 && lane < 2) { stats[2 * (row + lane)] = lane ? mean[1] : mean[0]; stats[2 * (row + lane) + 1] = lane ? rstd[1] : rstd[0]; }
#pragma unroll
        for (int j = 0; j < 4; ++j) {
            const int c = 4 * lane + 256 * j;
            const f32x4 gg = *(const f32x4*)(g + c), bb = *(const f32x4*)(b + c);
#pragma unroll
            for (int r = 0; r < 2; ++r) {
                const f32x4 o = v[r][j] * rstd[r] * gg + bb;
                if (MODE == 1) { uint2 w; w.x = cvtpk(o[0], o[1]); w.y = cvtpk(o[2], o[3]); *(uint2*)(hb + (size_t)(row + r) * DM + c) = w; }
                else *(f32x4*)(p + r * DM + c) = o;
            }
        }
    }
}

__device__ __forceinline__ void rwkv_naive_chain(int chain, int lane, LAS float* sm, const bf16_t* __restrict__ proj, const float* __restrict__ mix, const float* __restrict__ w0, const float* __restrict__ w2,
                                                 const float* __restrict__ a0, const float* __restrict__ a2, const float* __restrict__ g2, const float* __restrict__ k_k,
                                                 const float* __restrict__ k_a, const float* __restrict__ r_k, const float* __restrict__ ln_g, const float* __restrict__ ln_b, bf16_t* __restrict__ ymix) {
    LAS float* s_w2 = sm; LAS float* s_a2 = sm + 4096; LAS float* s_g2 = sm + 8192; LAS float* s_tw = sm + 16384; LAS float* s_al = s_tw + 64; LAS float* s_sg = s_tw + 128;
    LAS float* s_w = s_tw + 256; LAS float* s_k = s_tw + 320; LAS float* s_a = s_tw + 384; LAS float* s_b = s_tw + 448; LAS float* s_r = s_tw + 512;
    const int b = chain >> 3, h = chain & 7, c = h * 64 + lane;
    for (int l = 0; l < 64; ++l) { s_w2[l * 64 + lane] = w2[l * 512 + c]; s_a2[l * 64 + lane] = a2[l * 512 + c]; }
    for (int l = 0; l < 128; ++l) s_g2[l * 64 + lane] = g2[l * 512 + c];
    const float mr = mix[c], mk = mix[512 + c], mv = mix[1024 + c], mw = mix[1536 + lane], ma = mix[1600 + lane], mg0 = mix[1664 + lane], mg1 = mix[1728 + lane];
    const float w0c = w0[c], a0c = a0[c], kkc = k_k[c], kac = k_a[c], rkc = r_k[c], lgc = ln_g[c], lbc = ln_b[c];
    float S[64];
#pragma unroll
    for (int j = 0; j < 64; ++j) S[j] = 0.f;
    float pr = 0.f, pk = 0.f, pv = 0.f, pw = 0.f, pa = 0.f, pg0 = 0.f, pg1 = 0.f;
    WSYNC();
    for (int t = 0; t < SEQ; ++t) {
        const bf16_t* row = proj + (size_t)(b * SEQ + t) * L0P;
        const float cr = bf2f(row[c]), ck = bf2f(row[512 + c]), cv = bf2f(row[1024 + c]), cw = bf2f(row[1536 + lane]), ca = bf2f(row[1600 + lane]),
                    cg0 = bf2f(row[1664 + lane]), cg1 = bf2f(row[1728 + lane]);
        const float r_s = cr + (pr - cr) * mr, k_s = ck + (pk - ck) * mk, v_s = cv + (pv - cv) * mv;
        const float wl = cw + (pw - cw) * mw, al = ca + (pa - ca) * ma, g0 = cg0 + (pg0 - cg0) * mg0, g1 = cg1 + (pg1 - cg1) * mg1;
        pr = cr; pk = ck; pv = cv; pw = cw; pa = ca; pg0 = cg0; pg1 = cg1;
        s_tw[lane] = tanhf(wl); s_al[lane] = al; s_sg[lane] = sigmoidf_(g0); s_sg[64 + lane] = sigmoidf_(g1);
        WSYNC();
        float wsum = w0c, asum = a0c, gsum = 0.f;
#pragma unroll 2
        for (int l = 0; l < 64; ++l) { wsum += s_tw[l] * s_w2[l * 64 + lane]; asum += s_al[l] * s_a2[l * 64 + lane]; }
#pragma unroll 2
        for (int l = 0; l < 128; ++l) gsum += s_sg[l] * s_g2[l * 64 + lane];
        const float log_w = -softplusf_(-wsum) - 0.5f;
        const float dec = expf(-expf(log_w));
        const float a = sigmoidf_(asum);
        float kkv = k_s * kkc;
        const float nrm = sqrtf(wave_sum(kkv * kkv));
        kkv = kkv / fmaxf(nrm, 1e-12f);
        const float k2 = k_s * (1.f + (a - 1.f) * kac);
        const float bonus_s = wave_sum(r_s * k2 * rkc);
        s_w[lane] = dec; s_k[lane] = k2; s_a[lane] = -kkv; s_b[lane] = kkv * a; s_r[lane] = r_s;
        WSYNC();
        float sa = 0.f;
#pragma unroll
        for (int j = 0; j < 64; ++j) sa += S[j] * s_a[j];
        float y = 0.f;
#pragma unroll
        for (int j = 0; j < 64; ++j) { S[j] = S[j] * s_w[j] + sa * s_b[j] + v_s * s_k[j]; y += S[j] * s_r[j]; }
        const float mu = wave_sum(y) * (1.f / 64.f);
        const float d = y - mu;
        const float var = wave_sum(d * d) * (1.f / 64.f);
        const float yn = d * (1.0f / sqrtf(var + 64e-5f)) * lgc + lbc;
        const float o = (yn + bonus_s * v_s) * gsum;
        ymix[(size_t)(b * SEQ + t) * DM + c] = (bf16_t)f2bf(o);
        WSYNC();
    }
}

__device__ __forceinline__ void ssm_conv_all(const bf16_t* __restrict__ proj, const float* __restrict__ cw, const float* __restrict__ cb, const float* __restrict__ dtb,
                                             bf16_t* __restrict__ xbc, float* __restrict__ dt, int gtid, int NT) {
    for (size_t i = gtid; i < (size_t)M * 1024; i += NT) {
        const int m = (int)(i >> 10), c = (int)(i & 1023), t = m & (SEQ - 1);
        float acc = cb[c];
#pragma unroll
        for (int k = 0; k < 4; ++k) { const int tt = t - 3 + k; if (tt >= 0) acc += cw[k * 1024 + c] * bf2f(proj[(size_t)(m - 3 + k) * L0P + 2304 + c]); }
        xbc[i] = (bf16_t)f2bf(siluf_(acc));
    }
    for (int i = gtid; i < M * 8; i += NT) dt[i] = softplusf_(bf2f(proj[(size_t)(i >> 3) * L0P + 3328 + (i & 7)]) + dtb[i & 7]);
}
__device__ __forceinline__ void ssd_naive_task(int task, int lane, const bf16_t* __restrict__ xbc, const float* __restrict__ dt, const float* __restrict__ a_log, const float* __restrict__ dsk, float* __restrict__ yssm) {
    const int chain = task >> 2, q = task & 3, b = chain >> 3, h = chain & 7, g = h >> 2, p = q * 16 + (lane >> 2), nq = lane & 3;
    const float A = -expf(a_log[h]), D = dsk[h];
    float st[32];
#pragma unroll
    for (int n = 0; n < 32; ++n) st[n] = 0.f;
    for (int t = 0; t < SEQ; ++t) {
        const size_t m = (size_t)b * SEQ + t;
        const float dtv = dt[m * 8 + h], dA = expf(dtv * A);
        const float x = bf2f(xbc[m * 1024 + h * 64 + p]), xdt = x * dtv;
        const bf16_t* Bp = xbc + m * 1024 + 512 + g * 128 + nq * 32;
        const bf16_t* Cp = xbc + m * 1024 + 768 + g * 128 + nq * 32;
        float yp = 0.f;
#pragma unroll
        for (int n = 0; n < 32; ++n) { st[n] = st[n] * dA + xdt * bf2f(Bp[n]); yp += st[n] * bf2f(Cp[n]); }
        yp += __shfl_xor(yp, 1); yp += __shfl_xor(yp, 2);
        if (nq == 0) yssm[m * 512 + h * 64 + p] = yp + D * x;
    }
}
template <bool ST = true> __device__ __forceinline__ void ssm_gate_norm_all(const bf16_t* __restrict__ yssm, const bf16_t* __restrict__ proj, const float* __restrict__ ng, bf16_t* __restrict__ ymix, int wv0, int wvend, int lane) {
    for (int wvb = wv0 * 4 - (wv0 & ~7) * 3; wvb < wvend; wvb += NWAVES * 4) {
        float u[4][4], q[4];
#pragma unroll
        for (int k = 0; k < 4; ++k) { const int wv = wvb + k, m = wv >> 1, g = wv & 1; q[k] = 0.f;
#pragma unroll
            for (int j = 0; j < 4; ++j) { const int c = g * 256 + j * 64 + lane; const float z = bf2f(proj[(size_t)m * L0P + 1792 + c]); u[k][j] = bf2f(yssm[(size_t)m * 512 + c]) * (z * __builtin_amdgcn_rcpf(1.f + __expf(-z))); q[k] += u[k][j] * u[k][j]; } }
#pragma unroll
        for (int k = 0; k < 4; ++k) { const int wv = wvb + k, m = wv >> 1, g = wv & 1;
            const float rs = __builtin_amdgcn_rsqf(wave_sum_dpp(q[k]) * (1.f / 256.f) + 1e-5f);
#pragma unroll
            for (int j = 0; j < 4; ++j) { const int c = g * 256 + j * 64 + lane; const float o_ = u[k][j] * rs * ng[c]; if (ST) ymix[(size_t)m * DM + 512 + c] = bf1(o_); else asm volatile("" :: "v"(o_)); } }
    }
}
template <bool ST = true> __device__ __forceinline__ void ffn_act_all(bf16_t* gu, const float* __restrict__ cw, const float* __restrict__ cb, int gtid, int NT) {
    constexpr int NCH = DFF / 8, NSTRIP = M / 32;
    for (int task = gtid; task < NSTRIP * NCH; task += NT) {
        const int strip = task / NCH, q = task - strip * NCH, c0 = q * 8, m0 = strip * 32;
        float w0[8], w1[8], w2[8], bb[8], g2[8], g1[8];
#pragma unroll
        for (int j = 0; j < 8; j += 4) { const f32x4 a = *(const f32x4*)(cw + c0 + j), b = *(const f32x4*)(cw + DFF + c0 + j), c = *(const f32x4*)(cw + 2 * DFF + c0 + j), d = *(const f32x4*)(cb + c0 + j);
#pragma unroll
            for (int k = 0; k < 4; ++k) { w0[j + k] = a[k]; w1[j + k] = b[k]; w2[j + k] = c[k]; bb[j + k] = d[k]; } }
        bf16_t* base = gu + (size_t)m0 * (2 * DFF) + c0;
        if ((m0 & (SEQ - 1)) != 0) { const v4u a = *(const v4u*)(base - 2 * (2 * DFF)), b = *(const v4u*)(base - (2 * DFF));
            g2[0] = bflo(a.x); g2[1] = bfhi(a.x); g2[2] = bflo(a.y); g2[3] = bfhi(a.y); g2[4] = bflo(a.z); g2[5] = bfhi(a.z); g2[6] = bflo(a.w); g2[7] = bfhi(a.w);
            g1[0] = bflo(b.x); g1[1] = bfhi(b.x); g1[2] = bflo(b.y); g1[3] = bfhi(b.y); g1[4] = bflo(b.z); g1[5] = bfhi(b.z); g1[6] = bflo(b.w); g1[7] = bfhi(b.w); }
        else {
#pragma unroll
            for (int j = 0; j < 8; ++j) { g2[j] = 0.f; g1[j] = 0.f; } }
#pragma unroll 4
        for (int r = 0; r < 32; ++r) {
            const v4u gv = *(const v4u*)(base + (size_t)r * (2 * DFF)), uv = *(const v4u*)(base + (size_t)r * (2 * DFF) + DFF);
            const unsigned gw_[4] = {gv.x, gv.y, gv.z, gv.w}, uw_[4] = {uv.x, uv.y, uv.z, uv.w};
            unsigned ow[4];
#pragma unroll
            for (int k = 0; k < 4; ++k) {
                const float ga = bflo(gw_[k]), gb = bfhi(gw_[k]);
                const float ya = bb[2 * k] + w0[2 * k] * g2[2 * k] + w1[2 * k] * g1[2 * k] + w2[2 * k] * ga;
                const float yb = bb[2 * k + 1] + w0[2 * k + 1] * g2[2 * k + 1] + w1[2 * k + 1] * g1[2 * k + 1] + w2[2 * k + 1] * gb;
                g2[2 * k] = g1[2 * k]; g1[2 * k] = ga; g2[2 * k + 1] = g1[2 * k + 1]; g1[2 * k + 1] = gb;
                ow[k] = cvtpk(ya / (1.f + __expf(-ya)) * bflo(uw_[k]), yb / (1.f + __expf(-yb)) * bfhi(uw_[k]));
            }
            if (ST) *(v4u*)(base + (size_t)r * (2 * DFF) + DFF) = (v4u){ow[0], ow[1], ow[2], ow[3]}; else asm volatile("" :: "v"(ow[0]), "v"(ow[1]), "v"(ow[2]), "v"(ow[3]));
        }
    }
}
template <bool ST = true> __device__ __forceinline__ void mla_prep_all(const bf16_t* __restrict__ proj1, const int* __restrict__ pos, float* __restrict__ rs, bf16_t* __restrict__ kpe, float* __restrict__ cstab, int gw, int NGW, int lane) {
    for (int m = gw; m < M; m += NGW) {
        const bf16_t* row = proj1 + (size_t)m * L1P;
        float q = 0.f;
#pragma unroll
        for (int j = 0; j < 4; ++j) { const float v = bf2f(row[1536 + j * 64 + lane]); q += v * v; }
        q = wave_sum(q);
        float k = 0.f;
#pragma unroll
        for (int j = 0; j < 2; ++j) { const float v = bf2f(row[1792 + j * 64 + lane]); k += v * v; }
        k = wave_sum(k);
        if (ST && lane == 0) { rs[(size_t)m * 2] = 1.0f / sqrtf(q * (1.f / 256.f) + 1e-6f); rs[(size_t)m * 2 + 1] = 1.0f / sqrtf(k * (1.f / 128.f) + 1e-6f); }
        if (lane < 16) {
            const double inv = pow(10000.0, -(double)(2 * lane) / 32.0);
            const double ang = (double)pos[m] * inv;
            const float cs = (float)cos(ang), sn = (float)sin(ang);
            if (ST) { cstab[(size_t)m * 32 + lane] = cs; cstab[(size_t)m * 32 + 16 + lane] = sn; }
            const float x1 = bf2f(row[1920 + lane]), x2 = bf2f(row[1936 + lane]);
            const bf16_t r1_ = (bf16_t)f2bf(x1 * cs - x2 * sn), r2_ = (bf16_t)f2bf(x2 * cs + x1 * sn);
            if (ST) { kpe[(size_t)m * 32 + lane] = r1_; kpe[(size_t)m * 32 + 16 + lane] = r2_; } else asm volatile("" :: "v"((unsigned)r1_), "v"((unsigned)r2_), "v"(q), "v"(k));
        }
    }
}
template <bool ST = true> __device__ __forceinline__ void rope_q_all(bf16_t* qm, const float* __restrict__ cstab, int gtid, int NT) {
    for (int i = gtid; i < M * 16; i += NT) {
        const int m = i >> 4, h = (i >> 1) & 7, k0 = (i & 1) * 8;
        bf16_t* p = qm + (size_t)m * 768 + h * 96 + 64 + k0;
        const v4u a = *(const v4u*)p, b = *(const v4u*)(p + 16);
        const f32x4 c0 = *(const f32x4*)(cstab + (size_t)m * 32 + k0), c1 = *(const f32x4*)(cstab + (size_t)m * 32 + k0 + 4), s0 = *(const f32x4*)(cstab + (size_t)m * 32 + 16 + k0), s1 = *(const f32x4*)(cstab + (size_t)m * 32 + 16 + k0 + 4);
        const unsigned au[4] = {a.x, a.y, a.z, a.w}, bu[4] = {b.x, b.y, b.z, b.w};
        const float cs[8] = {c0[0], c0[1], c0[2], c0[3], c1[0], c1[1], c1[2], c1[3]}, sn[8] = {s0[0], s0[1], s0[2], s0[3], s1[0], s1[1], s1[2], s1[3]};
        unsigned o1[4], o2[4];
#pragma unroll
        for (int q = 0; q < 4; ++q) { const float x1a = bflo(au[q]), x1b = bfhi(au[q]), x2a = bflo(bu[q]), x2b = bfhi(bu[q]);
            o1[q] = cvtpk(x1a * cs[2 * q] - x2a * sn[2 * q], x1b * cs[2 * q + 1] - x2b * sn[2 * q + 1]);
            o2[q] = cvtpk(x2a * cs[2 * q] + x1a * sn[2 * q], x2b * cs[2 * q + 1] + x1b * sn[2 * q + 1]); }
        if (ST) { *(v4u*)p = (v4u){o1[0], o1[1], o1[2], o1[3]}; *(v4u*)(p + 16) = (v4u){o2[0], o2[1], o2[2], o2[3]}; }
    }
}
__device__ __forceinline__ void sb_naive_task(int qblk, int bh, int lane, const bf16_t* __restrict__ proj1, bf16_t* __restrict__ ymix) {
    const int b = bh >> 3, h = bh & 7, t = qblk * 64 + lane;
    const size_t mrow = (size_t)b * SEQ;
    float q[64], o[64];
#pragma unroll
    for (int d = 0; d < 64; ++d) { q[d] = bf2f(proj1[(mrow + t) * L1P + h * 64 + d]) * 0.125f; o[d] = 0.f; }
    float cum = 0.f;
    const int smax = qblk * 64 + 63;
    for (int s = smax - 1; s >= 0; --s) {
        const bf16_t* kr = proj1 + (mrow + s) * L1P + 512 + h * 64;
        const bf16_t* vr = proj1 + (mrow + s) * L1P + 1024 + h * 64;
        float z = 0.f;
#pragma unroll
        for (int d = 0; d < 64; ++d) z += q[d] * bf2f(kr[d]);
        if (s < t) {
            const float lsp = -softplusf_(-z);
            const float lsn = -softplusf_(z);
            const float att = expf(lsp + cum);
            cum += lsn;
#pragma unroll
            for (int d = 0; d < 64; ++d) o[d] += att * bf2f(vr[d]);
        }
    }
#pragma unroll
    for (int d = 0; d < 64; ++d) ymix[(mrow + t) * DM + h * 64 + d] = (bf16_t)f2bf(o[d]);
}
__device__ __forceinline__ void mla_naive_task(int qblk, int bh, int lane, const bf16_t* __restrict__ qm, const bf16_t* __restrict__ kvm, const bf16_t* __restrict__ kpe, bf16_t* __restrict__ ymix) {
    const int b = bh >> 3, h = bh & 7, t = qblk * 64 + lane;
    const size_t mrow = (size_t)b * SEQ;
    const float scale = 0.10206207261596577f;
    float q[96], o[64];
#pragma unroll
    for (int d = 0; d < 96; ++d) q[d] = bf2f(qm[(mrow + t) * 768 + h * 96 + d]) * scale;
#pragma unroll
    for (int d = 0; d < 64; ++d) o[d] = 0.f;
    float mx = -1e30f, l = 0.f;
    const int smax = qblk * 64 + 63;
    for (int s = 0; s <= smax; ++s) {
        const bf16_t* kr = kvm + (mrow + s) * 1024 + h * 128;
        const bf16_t* pr = kpe + (mrow + s) * 32;
        float z = 0.f;
#pragma unroll
        for (int d = 0; d < 64; ++d) z += q[d] * bf2f(kr[d]);
#pragma unroll
        for (int d = 0; d < 32; ++d) z += q[64 + d] * bf2f(pr[d]);
        if (s <= t) {
            const float mn = fmaxf(mx, z), f = expf(mx - mn), pz = expf(z - mn);
            l = l * f + pz; mx = mn;
#pragma unroll
            for (int d = 0; d < 64; ++d) o[d] = o[d] * f + pz * bf2f(kr[64 + d]);
        }
    }
    const float il = 1.f / l;
#pragma unroll
    for (int d = 0; d < 64; ++d) ymix[(mrow + t) * DM + 512 + h * 64 + d] = (bf16_t)f2bf(o[d] * il);
}


__device__ __forceinline__ int crow(int r, int hi) { return (r & 3) + 8 * (r >> 2) + 4 * hi; }
#define MFMA32(a, b, c) __builtin_amdgcn_mfma_f32_32x32x16_bf16((a), (b), (c), 0, 0, 0)
constexpr int STG_PITCH = 72;
__device__ __forceinline__ void transpose_tile64(const bf16_t* __restrict__ src, int sp, bf16_t* __restrict__ dst, int dp, LAS bf16_t* scr, int lane) {
#pragma unroll
    for (int i = 0; i < 8; ++i) { const int row = i * 8 + (lane >> 3), ch = lane & 7; const v4u v = *(const v4u*)(src + (size_t)row * sp + ch * 8); *(LAS v4u*)(scr + row * STG_PITCH + ch * 8) = v; }
    WSYNC();
#pragma unroll
    for (int i = 0; i < 8; ++i) { const int d = i * 8 + (lane >> 3), tc = lane & 7; const LAS bf16_t* p = scr + (tc * 8) * STG_PITCH + d;
        v4u o; o.x = (unsigned)p[0] | ((unsigned)p[STG_PITCH] << 16); o.y = (unsigned)p[2 * STG_PITCH] | ((unsigned)p[3 * STG_PITCH] << 16);
        o.z = (unsigned)p[4 * STG_PITCH] | ((unsigned)p[5 * STG_PITCH] << 16); o.w = (unsigned)p[6 * STG_PITCH] | ((unsigned)p[7 * STG_PITCH] << 16);
        *(v4u*)(dst + (size_t)d * dp + tc * 8) = o; }
    WSYNC();
}
__device__ __forceinline__ void store_OT(const f32x16 (&o)[2], float sc, LAS bf16_t* stg, bf16_t* __restrict__ dst, int lane) {
    const int l31 = lane & 31, hi = lane >> 5;
#pragma unroll
    for (int dt = 0; dt < 2; ++dt)
#pragma unroll
        for (int r = 0; r < 16; ++r) stg[l31 * STG_PITCH + 32 * dt + crow(r, hi)] = (bf16_t)f2bf(o[dt][r] * sc);
    WSYNC();
#pragma unroll
    for (int i = 0; i < 4; ++i) { const int row = i * 8 + (lane >> 3), ch = lane & 7; const v4u v = *(const LAS v4u*)(stg + row * STG_PITCH + ch * 8); *(v4u*)(dst + (size_t)row * DM + ch * 8) = v; }
    WSYNC();
}
__device__ __forceinline__ float softplus_fast(float z) { return fmaxf(z, 0.f) + __logf(1.f + __expf(-fabsf(z))); }

__device__ __forceinline__ void sb_task(int bh, int qblk, int lane, const bf16_t* __restrict__ P1, const bf16_t* __restrict__ VT, bf16_t* __restrict__ ymix, LAS bf16_t* stg) {
    const int b = bh >> 3, h = bh & 7, l31 = lane & 31, hi = lane >> 5, q0 = qblk * 32, t = q0 + l31;
    const size_t rowb = (size_t)b * SEQ;
    const bf16_t* Qp = P1 + (rowb + q0 + l31) * L1P + h * 64 + 8 * hi;
    bf16x8 qf[4];
#pragma unroll
    for (int kk = 0; kk < 4; ++kk) qf[kk] = *(const bf16x8*)(Qp + 16 * kk);
    const bf16_t* Kp = P1 + (rowb + l31) * L1P + 512 + h * 64 + 8 * hi;
    const bf16_t* Vp = VT + ((size_t)bh * 64 + l31) * SEQ + 4 * hi;
    f32x16 o[2];
#pragma unroll
    for (int r = 0; r < 16; ++r) { o[0][r] = 0.f; o[1][r] = 0.f; }
    float cum = 0.f;
    bf16x8 kf[4]; u32x2 va[2][2][2];
#define SB_LOAD(S0, KF, VA) do { _Pragma("unroll") for (int kk = 0; kk < 4; ++kk) KF[kk] = *(const bf16x8*)(Kp + (size_t)(S0) * L1P + 16 * kk); \
        _Pragma("unroll") for (int dt = 0; dt < 2; ++dt) _Pragma("unroll") for (int ks = 0; ks < 2; ++ks) { VA[dt][ks][0] = *(const u32x2*)(Vp + (size_t)dt * 32 * SEQ + (S0) + 16 * ks); VA[dt][ks][1] = *(const u32x2*)(Vp + (size_t)dt * 32 * SEQ + (S0) + 16 * ks + 8); } } while (0)
    SB_LOAD(q0, kf, va);
    for (int s0 = q0; s0 >= 0; s0 -= 32) {
        bf16x8 kn[4]; u32x2 vn[2][2][2];
        const int sn = (s0 >= 32) ? s0 - 32 : 0;
        SB_LOAD(sn, kn, vn);
        f32x16 acc;
#pragma unroll
        for (int r = 0; r < 16; ++r) acc[r] = 0.f;
#pragma unroll
        for (int kk = 0; kk < 4; ++kk) acc = MFMA32(kf[kk], qf[kk], acc);
        const bool diag = (s0 == q0);
        float lb[16], lk[16];
#pragma unroll
        for (int r = 0; r < 16; ++r) { const float z = acc[r] * 0.125f; const float sp = softplus_fast(z); float b_ = z - sp, k_ = -sp;
            if (diag) { const bool valid = (s0 + crow(r, hi)) < t; b_ = valid ? b_ : -1e30f; k_ = valid ? k_ : 0.f; }
            lb[r] = b_; lk[r] = k_; }
        float e[16], T[4], U[4];
#pragma unroll
        for (int i = 0; i < 4; ++i) { e[4 * i + 3] = 0.f; e[4 * i + 2] = lk[4 * i + 3]; e[4 * i + 1] = e[4 * i + 2] + lk[4 * i + 2]; e[4 * i] = e[4 * i + 1] + lk[4 * i + 1]; T[i] = e[4 * i] + lk[4 * i]; }
#pragma unroll
        for (int i = 0; i < 4; ++i) U[i] = __shfl_xor(T[i], 32);
        float off[4];
        { const float st2 = T[3], st1 = st2 + T[2], st0 = st1 + T[1]; const float su2 = U[3], su1 = su2 + U[2], su0 = su1 + U[1];
          const float x0 = hi ? 0.f : U[0], x1 = hi ? 0.f : U[1], x2 = hi ? 0.f : U[2], x3 = hi ? 0.f : U[3];
          off[3] = x3; off[2] = st2 + su2 + x2; off[1] = st1 + su1 + x1; off[0] = st0 + su0 + x0;
          const float total = st0 + T[0] + su0 + U[0];
#pragma unroll
          for (int r = 0; r < 16; ++r) acc[r] = __expf(lb[r] + (cum + off[r >> 2] + e[r]));
          cum += total; }
        bf16x8 pf[2];
#pragma unroll
        for (int ks = 0; ks < 2; ++ks) { v4u w; w.x = cvtpk(acc[8 * ks], acc[8 * ks + 1]); w.y = cvtpk(acc[8 * ks + 2], acc[8 * ks + 3]); w.z = cvtpk(acc[8 * ks + 4], acc[8 * ks + 5]); w.w = cvtpk(acc[8 * ks + 6], acc[8 * ks + 7]); pf[ks] = __builtin_bit_cast(bf16x8, w); }
#pragma unroll
        for (int dt = 0; dt < 2; ++dt)
#pragma unroll
            for (int ks = 0; ks < 2; ++ks) { v4u a; a.x = va[dt][ks][0].x; a.y = va[dt][ks][0].y; a.z = va[dt][ks][1].x; a.w = va[dt][ks][1].y; o[dt] = MFMA32(__builtin_bit_cast(bf16x8, a), pf[ks], o[dt]); }
        if (__all(cum < -110.f)) break;
#pragma unroll
        for (int kk = 0; kk < 4; ++kk) kf[kk] = kn[kk];
#pragma unroll
        for (int dt = 0; dt < 2; ++dt)
#pragma unroll
            for (int ks = 0; ks < 2; ++ks) { va[dt][ks][0] = vn[dt][ks][0]; va[dt][ks][1] = vn[dt][ks][1]; }
    }
#undef SB_LOAD
    store_OT(o, 1.0f, stg, ymix + (rowb + q0) * DM + h * 64, lane);
}
__device__ __forceinline__ void mla_task(int bh, int qblk, int lane, const bf16_t* __restrict__ QM, const bf16_t* __restrict__ KVM, const bf16_t* __restrict__ KPE, const bf16_t* __restrict__ VT,
                                         bf16_t* __restrict__ ymix, LAS bf16_t* stg) {
    const int b = bh >> 3, h = bh & 7, l31 = lane & 31, hi = lane >> 5, q0 = qblk * 32, t = q0 + l31;
    const size_t rowb = (size_t)b * SEQ;
    const bf16_t* Qp = QM + (rowb + q0 + l31) * 768 + h * 96 + 8 * hi;
    bf16x8 qf[6];
#pragma unroll
    for (int kk = 0; kk < 6; ++kk) qf[kk] = *(const bf16x8*)(Qp + 16 * kk);
    const bf16_t* Kn = KVM + (rowb + l31) * 1024 + h * 128 + 8 * hi;
    const bf16_t* Kr = KPE + (rowb + l31) * 32 + 8 * hi;
    const bf16_t* Vp = VT + ((size_t)bh * 64 + l31) * SEQ + 4 * hi;
    const float sc2 = 0.10206207261596577f * 1.4426950408889634f;
    f32x16 o[2];
#pragma unroll
    for (int r = 0; r < 16; ++r) { o[0][r] = 0.f; o[1][r] = 0.f; }
    float mrun = -1e30f, lsum = 0.f;
    bf16x8 kf[6]; u32x2 va[2][2][2];
#define ML_LOAD(S0, KF, VA) do { _Pragma("unroll") for (int kk = 0; kk < 4; ++kk) KF[kk] = *(const bf16x8*)(Kn + (size_t)(S0) * 1024 + 16 * kk); \
        _Pragma("unroll") for (int kk = 0; kk < 2; ++kk) KF[4 + kk] = *(const bf16x8*)(Kr + (size_t)(S0) * 32 + 16 * kk); \
        _Pragma("unroll") for (int dt = 0; dt < 2; ++dt) _Pragma("unroll") for (int ks = 0; ks < 2; ++ks) { VA[dt][ks][0] = *(const u32x2*)(Vp + (size_t)dt * 32 * SEQ + (S0) + 16 * ks); VA[dt][ks][1] = *(const u32x2*)(Vp + (size_t)dt * 32 * SEQ + (S0) + 16 * ks + 8); } } while (0)
    ML_LOAD(0, kf, va);
    for (int s0 = 0; s0 <= q0; s0 += 32) {
        bf16x8 kn[6]; u32x2 vn[2][2][2];
        const int sn = (s0 + 32 <= q0) ? s0 + 32 : s0;
        ML_LOAD(sn, kn, vn);
        f32x16 acc;
#pragma unroll
        for (int r = 0; r < 16; ++r) acc[r] = 0.f;
#pragma unroll
        for (int kk = 0; kk < 6; ++kk) acc = MFMA32(kf[kk], qf[kk], acc);
        const bool diag = (s0 == q0);
        float tmax = -1e30f;
#pragma unroll
        for (int r = 0; r < 16; ++r) { float z = acc[r] * sc2; if (diag && (s0 + crow(r, hi)) > t) z = -1e30f; acc[r] = z; tmax = fmaxf(tmax, z); }
        tmax = fmaxf(tmax, __shfl_xor(tmax, 32));
        const float mn = fmaxf(mrun, tmax), alpha = exp2f(mrun - mn); mrun = mn;
        float ps = 0.f;
#pragma unroll
        for (int r = 0; r < 16; ++r) { acc[r] = exp2f(acc[r] - mn); ps += acc[r]; }
        lsum = lsum * alpha + ps;
#pragma unroll
        for (int r = 0; r < 16; ++r) { o[0][r] *= alpha; o[1][r] *= alpha; }
        bf16x8 pf[2];
#pragma unroll
        for (int ks = 0; ks < 2; ++ks) { v4u w; w.x = cvtpk(acc[8 * ks], acc[8 * ks + 1]); w.y = cvtpk(acc[8 * ks + 2], acc[8 * ks + 3]); w.z = cvtpk(acc[8 * ks + 4], acc[8 * ks + 5]); w.w = cvtpk(acc[8 * ks + 6], acc[8 * ks + 7]); pf[ks] = __builtin_bit_cast(bf16x8, w); }
#pragma unroll
        for (int dt = 0; dt < 2; ++dt)
#pragma unroll
            for (int ks = 0; ks < 2; ++ks) { v4u a; a.x = va[dt][ks][0].x; a.y = va[dt][ks][0].y; a.z = va[dt][ks][1].x; a.w = va[dt][ks][1].y; o[dt] = MFMA32(__builtin_bit_cast(bf16x8, a), pf[ks], o[dt]); }
#pragma unroll
        for (int kk = 0; kk < 6; ++kk) kf[kk] = kn[kk];
#pragma unroll
        for (int dt = 0; dt < 2; ++dt)
#pragma unroll
            for (int ks = 0; ks < 2; ++ks) { va[dt][ks][0] = vn[dt][ks][0]; va[dt][ks][1] = vn[dt][ks][1]; }
    }
#undef ML_LOAD
    lsum += __shfl_xor(lsum, 32);
    store_OT(o, 1.0f / lsum, stg, ymix + (rowb + q0) * DM + 512 + h * 64, lane);
}


constexpr int MLK_PITCH = 104, MLV_PITCH = 68, MLK_BYTES = 64 * MLK_PITCH * 2, MLV_BYTES = 64 * MLV_PITCH * 2, ML_STAGE = MLK_BYTES + MLV_BYTES;
__device__ __forceinline__ void mla_block(int bh, int sb, int tid, int lane, int wave, LAS unsigned char* lds, const bf16_t* __restrict__ QM, const bf16_t* __restrict__ KVM, const bf16_t* __restrict__ KPE,
                                          const bf16_t* __restrict__ VT, bf16_t* __restrict__ ymix) {
    const int b = bh >> 3, h = bh & 7, l31 = lane & 31, hi = lane >> 5, q0 = 256 * sb + 32 * wave, t = q0 + l31;
    const size_t rowb = (size_t)b * SEQ;
    const int nsteps = 4 * sb + 4;
    bf16x8 qf[6];
    { const bf16_t* Qp = QM + (rowb + q0 + l31) * 768 + h * 96 + 8 * hi;
#pragma unroll
      for (int kk = 0; kk < 6; ++kk) qf[kk] = *(const bf16x8*)(Qp + 16 * kk); }
    const float sc2 = 0.10206207261596577f * 1.4426950408889634f;
    f32x16 o[2];
#pragma unroll
    for (int r = 0; r < 16; ++r) { o[0][r] = 0.f; o[1][r] = 0.f; }
    float mrun = -1e30f, lsum = 0.f;
    const bf16_t* gKn = KVM + (rowb + (tid >> 3)) * 1024 + h * 128 + (tid & 7) * 8;
    const bf16_t* gKr = KPE + (rowb + ((tid & 255) >> 2)) * 32 + (tid & 3) * 8;
    const bf16_t* gVt = VT + ((size_t)bh * 64 + (tid >> 3)) * SEQ + (tid & 7) * 8;
    const int lKn = (tid >> 3) * (MLK_PITCH * 2) + (tid & 7) * 16, lKr = ((tid & 255) >> 2) * (MLK_PITCH * 2) + 128 + (tid & 3) * 16, lVt = MLK_BYTES + (tid >> 3) * (MLV_PITCH * 2) + (tid & 7) * 16;
    v4u rk, rr, rv;
    rk = *(const v4u*)gKn; rr = *(const v4u*)gKr; rv = *(const v4u*)gVt;
    *(LAS v4u*)(lds + lKn) = rk; if (tid < 256) *(LAS v4u*)(lds + lKr) = rr; *(LAS u32x2*)(lds + lVt) = (u32x2){rv.x, rv.y}; *(LAS u32x2*)(lds + lVt + 8) = (u32x2){rv.z, rv.w};
    __syncthreads();
#pragma unroll 1
    for (int step = 0; step < nsteps; ++step) {
        const int nx = (step + 1 < nsteps) ? step + 1 : step;
        rk = *(const v4u*)(gKn + (size_t)nx * 64 * 1024); rr = *(const v4u*)(gKr + (size_t)nx * 64 * 32); rv = *(const v4u*)(gVt + nx * 64);
        const LAS unsigned char* Kb = lds + (step & 1) * ML_STAGE;
        const LAS unsigned char* Vb = Kb + MLK_BYTES;
#pragma unroll
        for (int sub = 0; sub < 2; ++sub) {
            const int s0 = 64 * step + 32 * sub;
            if (s0 <= q0) {
                f32x16 acc;
#pragma unroll
                for (int r = 0; r < 16; ++r) acc[r] = 0.f;
#pragma unroll
                for (int kk = 0; kk < 6; ++kk) { const bf16x8 kf = *(const LAS bf16x8*)(Kb + (32 * sub + l31) * (MLK_PITCH * 2) + (16 * kk + 8 * hi) * 2); acc = MFMA32(kf, qf[kk], acc); }
                const bool diag = (s0 == q0);
                float tmax = -1e30f;
#pragma unroll
                for (int r = 0; r < 16; ++r) { float z = acc[r] * sc2; if (diag && (s0 + crow(r, hi)) > t) z = -1e30f; acc[r] = z; tmax = fmaxf(tmax, z); }
                tmax = fmaxf(tmax, __shfl_xor(tmax, 32));
                const float mn = fmaxf(mrun, tmax), alpha = __builtin_amdgcn_exp2f(mrun - mn); mrun = mn;
                float ps = 0.f;
#pragma unroll
                for (int r = 0; r < 16; ++r) { acc[r] = __builtin_amdgcn_exp2f(acc[r] - mn); ps += acc[r]; }
                lsum = lsum * alpha + ps;
#pragma unroll
                for (int r = 0; r < 16; ++r) { o[0][r] *= alpha; o[1][r] *= alpha; }
                bf16x8 pf[2];
#pragma unroll
                for (int ks = 0; ks < 2; ++ks) { v4u w; w.x = cvtpk(acc[8 * ks], acc[8 * ks + 1]); w.y = cvtpk(acc[8 * ks + 2], acc[8 * ks + 3]); w.z = cvtpk(acc[8 * ks + 4], acc[8 * ks + 5]); w.w = cvtpk(acc[8 * ks + 6], acc[8 * ks + 7]); pf[ks] = __builtin_bit_cast(bf16x8, w); }
#pragma unroll
                for (int dt = 0; dt < 2; ++dt)
#pragma unroll
                    for (int ks = 0; ks < 2; ++ks) { const LAS unsigned char* vp = Vb + (32 * dt + l31) * (MLV_PITCH * 2) + (32 * sub + 16 * ks + 4 * hi) * 2;
                        const u32x2 x0 = *(const LAS u32x2*)vp, x1 = *(const LAS u32x2*)(vp + 16);
                        v4u a; a.x = x0.x; a.y = x0.y; a.z = x1.x; a.w = x1.y; o[dt] = MFMA32(__builtin_bit_cast(bf16x8, a), pf[ks], o[dt]); }
            }
        }
        LAS unsigned char* nb = lds + ((step + 1) & 1) * ML_STAGE;
        *(LAS v4u*)(nb + lKn) = rk; if (tid < 256) *(LAS v4u*)(nb + lKr) = rr; *(LAS u32x2*)(nb + lVt) = (u32x2){rv.x, rv.y}; *(LAS u32x2*)(nb + lVt + 8) = (u32x2){rv.z, rv.w};
        __syncthreads();
    }
    lsum += __shfl_xor(lsum, 32);
    store_OT(o, 1.0f / lsum, (LAS bf16_t*)(lds + 2 * ML_STAGE) + wave * (32 * STG_PITCH), ymix + (rowb + q0) * DM + 512 + h * 64, lane);
    __syncthreads();
}


constexpr int SBK_PITCH = 72, SBK_BYTES = 64 * SBK_PITCH * 2, SB_STAGE = SBK_BYTES + MLV_BYTES;
__device__ __forceinline__ void sb_block(int bh, int sb, int tid, int lane, int wave, LAS unsigned char* lds, const bf16_t* __restrict__ P1, const bf16_t* __restrict__ VT, bf16_t* __restrict__ ymix) {
    const int b = bh >> 3, h = bh & 7, l31 = lane & 31, hi = lane >> 5, q0 = 256 * sb + 32 * wave, t = q0 + l31;
    const size_t rowb = (size_t)b * SEQ;
    bf16x8 qf[4];
    { const bf16_t* Qp = P1 + (rowb + q0 + l31) * L1P + h * 64 + 8 * hi;
#pragma unroll
      for (int kk = 0; kk < 4; ++kk) qf[kk] = *(const bf16x8*)(Qp + 16 * kk); }
    f32x16 o[2];
#pragma unroll
    for (int r = 0; r < 16; ++r) { o[0][r] = 0.f; o[1][r] = 0.f; }
    float cum = 0.f; bool done = false;
    volatile LAS unsigned* flags = (volatile LAS unsigned*)(lds + 2 * SB_STAGE);
    const bf16_t* gK = P1 + (rowb + (tid >> 3)) * L1P + 512 + h * 64 + (tid & 7) * 8;
    const bf16_t* gVt = VT + ((size_t)bh * 64 + (tid >> 3)) * SEQ + (tid & 7) * 8;
    const int lK = (tid >> 3) * (SBK_PITCH * 2) + (tid & 7) * 16, lVt = SBK_BYTES + (tid >> 3) * (MLV_PITCH * 2) + (tid & 7) * 16;
    const int top = 4 * sb + 3;
    v4u rk, rv;
    rk = *(const v4u*)(gK + (size_t)top * 64 * L1P); rv = *(const v4u*)(gVt + top * 64);
    *(LAS v4u*)(lds + lK) = rk; *(LAS u32x2*)(lds + lVt) = (u32x2){rv.x, rv.y}; *(LAS u32x2*)(lds + lVt + 8) = (u32x2){rv.z, rv.w};
    __syncthreads();
#pragma unroll 1
    for (int i = 0; i <= top; ++i) {
        const int step = top - i, nx = (step > 0) ? step - 1 : 0;
        rk = *(const v4u*)(gK + (size_t)nx * 64 * L1P); rv = *(const v4u*)(gVt + nx * 64);
        const LAS unsigned char* Kb = lds + (i & 1) * SB_STAGE;
        const LAS unsigned char* Vb = Kb + SBK_BYTES;
#pragma unroll
        for (int sub = 1; sub >= 0; --sub) {
            const int s0 = 64 * step + 32 * sub;
            if (s0 <= q0 && !done) {
                f32x16 acc;
#pragma unroll
                for (int r = 0; r < 16; ++r) acc[r] = 0.f;
#pragma unroll
                for (int kk = 0; kk < 4; ++kk) { const bf16x8 kf = *(const LAS bf16x8*)(Kb + (32 * sub + l31) * (SBK_PITCH * 2) + (16 * kk + 8 * hi) * 2); acc = MFMA32(kf, qf[kk], acc); }
                const bool diag = (s0 == q0);
                float lb[16], lk[16];
#pragma unroll
                for (int r = 0; r < 16; ++r) { const float z = acc[r] * 0.125f; const float sp = softplus_fast(z); float b_ = z - sp, k_ = -sp;
                    if (diag) { const bool valid = (s0 + crow(r, hi)) < t; b_ = valid ? b_ : -1e30f; k_ = valid ? k_ : 0.f; }
                    lb[r] = b_; lk[r] = k_; }
                float e[16], T[4], U[4];
#pragma unroll
                for (int q = 0; q < 4; ++q) { e[4 * q + 3] = 0.f; e[4 * q + 2] = lk[4 * q + 3]; e[4 * q + 1] = e[4 * q + 2] + lk[4 * q + 2]; e[4 * q] = e[4 * q + 1] + lk[4 * q + 1]; T[q] = e[4 * q] + lk[4 * q]; }
#pragma unroll
                for (int q = 0; q < 4; ++q) U[q] = __shfl_xor(T[q], 32);
                { const float st2 = T[3], st1 = st2 + T[2], st0 = st1 + T[1]; const float su2 = U[3], su1 = su2 + U[2], su0 = su1 + U[1];
                  const float x0 = hi ? 0.f : U[0], x1 = hi ? 0.f : U[1], x2 = hi ? 0.f : U[2], x3 = hi ? 0.f : U[3];
                  const float off[4] = {st0 + su0 + x0, st1 + su1 + x1, st2 + su2 + x2, x3};
                  const float total = st0 + T[0] + su0 + U[0];
#pragma unroll
                  for (int r = 0; r < 16; ++r) acc[r] = __expf(lb[r] + (cum + off[r >> 2] + e[r]));
                  cum += total; }
                bf16x8 pf[2];
#pragma unroll
                for (int ks = 0; ks < 2; ++ks) { v4u w; w.x = cvtpk(acc[8 * ks], acc[8 * ks + 1]); w.y = cvtpk(acc[8 * ks + 2], acc[8 * ks + 3]); w.z = cvtpk(acc[8 * ks + 4], acc[8 * ks + 5]); w.w = cvtpk(acc[8 * ks + 6], acc[8 * ks + 7]); pf[ks] = __builtin_bit_cast(bf16x8, w); }
#pragma unroll
                for (int dt = 0; dt < 2; ++dt)
#pragma unroll
                    for (int ks = 0; ks < 2; ++ks) { const LAS unsigned char* vp = Vb + (32 * dt + l31) * (MLV_PITCH * 2) + (32 * sub + 16 * ks + 4 * hi) * 2;
                        const u32x2 x0 = *(const LAS u32x2*)vp, x1 = *(const LAS u32x2*)(vp + 16);
                        v4u a; a.x = x0.x; a.y = x0.y; a.z = x1.x; a.w = x1.y; o[dt] = MFMA32(__builtin_bit_cast(bf16x8, a), pf[ks], o[dt]); }
                done = __all(cum < -110.f);
            }
        }
        if (lane == 0) flags[(i & 1) * 8 + wave] = done ? 1u : 0u;
        LAS unsigned char* nb = lds + ((i + 1) & 1) * SB_STAGE;
        *(LAS v4u*)(nb + lK) = rk; *(LAS u32x2*)(nb + lVt) = (u32x2){rv.x, rv.y}; *(LAS u32x2*)(nb + lVt + 8) = (u32x2){rv.z, rv.w};
        __syncthreads();
        unsigned nd = 0;
#pragma unroll
        for (int w8 = 0; w8 < 8; ++w8) nd += flags[(i & 1) * 8 + w8];
        if (nd == 8u) break;
    }
    store_OT(o, 1.0f, (LAS bf16_t*)(lds + 2 * SB_STAGE + 256) + wave * (32 * STG_PITCH), ymix + (rowb + q0) * DM + h * 64, lane);
    __syncthreads();
}

constexpr int RW_RAWW = 0, RW_RAWA = 2048, RW_RS = 4096, RW_KS = 6144, RW_VS = 8192;
constexpr int RW_CH0 = 10240, RW_CHSZ = 11328;
constexpr int RW_YB = RW_CH0 + 2 * RW_CHSZ;
constexpr int RW_MIX = RW_YB + 1024;
static_assert((RW_MIX + 256) * 4 <= 146432, "rwkv LDS map");
__device__ __forceinline__ float tanh_fast(float x) { return 1.f - 2.f * __builtin_amdgcn_rcpf(1.f + __expf(2.f * x)); }
__device__ __forceinline__ float sigmoid_fast(float x) { return __builtin_amdgcn_rcpf(1.f + __expf(-x)); }

#define MFMA16(a, b, c) __builtin_amdgcn_mfma_f32_16x16x32_bf16((a), (b), (c), 0, 0, 0)
constexpr int RW2_CH0 = 0, RW2_YB = 2 * RW_CHSZ, RW2_MIX = RW2_YB + 1024, RW2_STG = RW2_MIX + 448;
static_assert((RW2_STG + 2 * 3072) * 4 <= 146432, "rwkv LDS map");
__device__ __forceinline__ void rwkv_phase_scan(LAS float* sm, int tid, int lane, int wave, int blk, const bf16_t* __restrict__ proj, const float* __restrict__ mix, const float* __restrict__ w0, const float* __restrict__ a0,
                                           const float* __restrict__ k_k, const float* __restrict__ k_a, const float* __restrict__ r_k, const bf16_t* __restrict__ W2T, const bf16_t* __restrict__ A2T, const bf16_t* __restrict__ G2T,
                                           float* __restrict__ yraw, bf16_t* __restrict__ gout, float* __restrict__ bonus_out) {
    const int chain = blk >> 1, half = blk & 1, b = chain >> 3, h = chain & 7, l15 = lane & 15, kg = lane >> 4;
    const size_t rowb = (size_t)b * SEQ;
    constexpr int NCHUNK = SEQ / 32;
    if (tid < 256) sm[RW2_MIX + tid] = mix[1536 + tid];
    else if (tid < 448) { const int q = tid - 256; sm[RW2_MIX + tid] = mix[512 * (q >> 6) + h * 64 + (q & 63)]; }
    __syncthreads();
#define RW_SH8(CUR, PRV, M0, M1, OUT, PZ) do { const unsigned cu_[4] = {(CUR).x, (CUR).y, (CUR).z, (CUR).w}, pu_[4] = {(PRV).x, (PRV).y, (PRV).z, (PRV).w}; \
        const float mm_[8] = {(M0)[0], (M0)[1], (M0)[2], (M0)[3], (M1)[0], (M1)[1], (M1)[2], (M1)[3]}; \
        _Pragma("unroll") for (int q = 0; q < 4; ++q) { const float c0 = bflo(cu_[q]), c1 = bfhi(cu_[q]), p0 = bflo(pu_[q]) * (PZ), p1 = bfhi(pu_[q]) * (PZ); \
            OUT[2 * q] = c0 + (p0 - c0) * mm_[2 * q]; OUT[2 * q + 1] = c1 + (p1 - c1) * mm_[2 * q + 1]; } } while (0)
    if (wave < 4) {
        const int iA = 8 * wave + kg, iB = iA + 4, jseg = l15;
        float A0 = 0.f, A1 = 0.f, A2 = 0.f, A3 = 0.f, B0 = 0.f, B1 = 0.f, B2 = 0.f, B3 = 0.f;
        __syncthreads();
#pragma unroll 1
        for (int ch = 0; ch < NCHUNK; ++ch) {
            const int t0 = ch * 32;
            const LAS float* CHb = sm + RW2_CH0 + (ch & 1) * RW_CHSZ + 4 * jseg;
            const LAS float* CHv = sm + RW2_CH0 + (ch & 1) * RW_CHSZ + 10240 + iA;
            const LAS float* CHs = sm + RW2_CH0 + (ch & 1) * RW_CHSZ + 11264;
            f32x4 a4 = *(const LAS f32x4*)(CHb + 4096), wr4 = *(const LAS f32x4*)(CHb + 8192), w4 = *(const LAS f32x4*)(CHb), b4 = *(const LAS f32x4*)(CHb + 6144), k4 = *(const LAS f32x4*)(CHb + 2048);
            float vA = CHv[0], vB = CHv[4]; f32x2_t sc = *(const LAS f32x2_t*)(CHs);
#pragma unroll 2
            for (int t = 0; t < 32; ++t) {
                const int tq = (t + 1) & 31;
                const f32x4 a4n = *(const LAS f32x4*)(CHb + 4096 + tq * 64), wr4n = *(const LAS f32x4*)(CHb + 8192 + tq * 64), w4n = *(const LAS f32x4*)(CHb + tq * 64),
                            b4n = *(const LAS f32x4*)(CHb + 6144 + tq * 64), k4n = *(const LAS f32x4*)(CHb + 2048 + tq * 64);
                const float vAn = CHv[tq * 32], vBn = CHv[tq * 32 + 4]; const f32x2_t scn = *(const LAS f32x2_t*)(CHs + 2 * tq);
                float d1A = (A0 * a4[0] + A1 * a4[1]) + (A2 * a4[2] + A3 * a4[3]), d1B = (B0 * a4[0] + B1 * a4[1]) + (B2 * a4[2] + B3 * a4[3]);
                float d2A = (A0 * wr4[0] + A1 * wr4[1]) + (A2 * wr4[2] + A3 * wr4[3]), d2B = (B0 * wr4[0] + B1 * wr4[1]) + (B2 * wr4[2] + B3 * wr4[3]);
                d1A = rowsum16(d1A); d1B = rowsum16(d1B); d2A = rowsum16(d2A); d2B = rowsum16(d2B);
                const float yA = d2A + d1A * sc[0] + vA * sc[1], yB = d2B + d1B * sc[0] + vB * sc[1];
                A0 = A0 * w4[0] + (d1A * b4[0] + vA * k4[0]); A1 = A1 * w4[1] + (d1A * b4[1] + vA * k4[1]); A2 = A2 * w4[2] + (d1A * b4[2] + vA * k4[2]); A3 = A3 * w4[3] + (d1A * b4[3] + vA * k4[3]);
                B0 = B0 * w4[0] + (d1B * b4[0] + vB * k4[0]); B1 = B1 * w4[1] + (d1B * b4[1] + vB * k4[1]); B2 = B2 * w4[2] + (d1B * b4[2] + vB * k4[2]); B3 = B3 * w4[3] + (d1B * b4[3] + vB * k4[3]);
                if (jseg == 0) { sm[RW2_YB + t * 32 + iA] = yA; sm[RW2_YB + t * 32 + iB] = yB; }
                a4 = a4n; wr4 = wr4n; w4 = w4n; b4 = b4n; k4 = k4n; vA = vAn; vB = vBn; sc = scn;
            }
            WSYNC();
            { const int tt = lane >> 1, hh = lane & 1; const f32x4 yv = *(const LAS f32x4*)(sm + RW2_YB + tt * 32 + 8 * wave + 4 * hh);
              *(f32x4*)(yraw + (rowb + t0 + tt) * 512 + h * 64 + half * 32 + 8 * wave + 4 * hh) = yv; }
            __syncthreads();
        }
    } else if (wave < 6) {
        const int tp = wave - 4, tb = 16 * tp;
        LAS float* stg = sm + RW2_STG + tp * 3072;
        float w0c[4], a0c[4], kkc[4], kac[4], rkc[4];
#pragma unroll
        for (int nt = 0; nt < 4; ++nt) { const int c = h * 64 + 16 * nt + l15; w0c[nt] = w0[c]; a0c[nt] = a0[c]; kkc[nt] = k_k[c]; kac[nt] = k_a[c]; rkc[nt] = r_k[c]; }
        v4u ld[20];
#define PREP_ISSUE(T0) do { const int t0_ = (T0); { const size_t r_ = rowb + t0_ + tb + l15; const size_t rp_ = (t0_ + tb + l15 == 0) ? r_ : r_ - 1; \
            _Pragma("unroll") for (int lo = 0; lo < 2; ++lo) _Pragma("unroll") for (int ks = 0; ks < 2; ++ks) { const int col = 1536 + 64 * lo + 32 * ks + 8 * kg; \
                ld[(lo * 2 + ks) * 2] = *(const v4u*)(proj + r_ * L0P + col); ld[(lo * 2 + ks) * 2 + 1] = *(const v4u*)(proj + rp_ * L0P + col); } } \
            _Pragma("unroll") for (int ar = 0; ar < 3; ++ar) _Pragma("unroll") for (int i = 0; i < 2; ++i) { const int p_ = lane + 64 * i, row_ = p_ >> 3, c8_ = p_ & 7; \
                const size_t r_ = rowb + t0_ + tb + row_; const size_t rp_ = (t0_ + tb + row_ == 0) ? r_ : r_ - 1; const int col = 512 * ar + h * 64 + 8 * c8_; \
                ld[8 + (ar * 2 + i) * 2] = *(const v4u*)(proj + r_ * L0P + col); ld[8 + (ar * 2 + i) * 2 + 1] = *(const v4u*)(proj + rp_ * L0P + col); } } while (0)
#define PREP_BUILD(T0, NB) do { const int t0_ = (T0); LAS float* CHn = sm + RW2_CH0 + (NB) * RW_CHSZ; \
            f32x4 accw[4], acca[4]; \
            _Pragma("unroll") for (int nt = 0; nt < 4; ++nt) { accw[nt] = (f32x4){0.f, 0.f, 0.f, 0.f}; acca[nt] = (f32x4){0.f, 0.f, 0.f, 0.f}; } \
            { const float pz_ = (t0_ + tb + l15 == 0) ? 0.f : 1.f; \
              _Pragma("unroll") for (int lo = 0; lo < 2; ++lo) _Pragma("unroll") for (int ks = 0; ks < 2; ++ks) { float s_[8]; \
                const f32x4 m0 = *(const LAS f32x4*)(sm + RW2_MIX + 64 * lo + 32 * ks + 8 * kg), m1 = *(const LAS f32x4*)(sm + RW2_MIX + 64 * lo + 32 * ks + 8 * kg + 4); \
                RW_SH8(ld[(lo * 2 + ks) * 2], ld[(lo * 2 + ks) * 2 + 1], m0, m1, s_, pz_); \
                if (lo == 0) { _Pragma("unroll") for (int j = 0; j < 8; ++j) s_[j] = tanh_fast(s_[j]); } \
                v4u aw; aw.x = cvtpk(s_[0], s_[1]); aw.y = cvtpk(s_[2], s_[3]); aw.z = cvtpk(s_[4], s_[5]); aw.w = cvtpk(s_[6], s_[7]); const bf16x8 af = __builtin_bit_cast(bf16x8, aw); \
                const bf16_t* WT = lo ? A2T : W2T; \
                _Pragma("unroll") for (int nt = 0; nt < 4; ++nt) { const bf16x8 bfr = *(const bf16x8*)(WT + (size_t)(h * 64 + 16 * nt + l15) * 64 + 32 * ks + 8 * kg); \
                    if (lo == 0) accw[nt] = MFMA16(af, bfr, accw[nt]); else acca[nt] = MFMA16(af, bfr, acca[nt]); } } } \
            _Pragma("unroll") for (int ar = 0; ar < 3; ++ar) _Pragma("unroll") for (int i = 0; i < 2; ++i) { const int p_ = lane + 64 * i, row_ = p_ >> 3, c8_ = p_ & 7; float s_[8]; \
                const float pz_ = (t0_ + tb + row_ == 0) ? 0.f : 1.f; const f32x4 m0 = *(const LAS f32x4*)(sm + RW2_MIX + 256 + ar * 64 + c8_ * 8), m1 = *(const LAS f32x4*)(sm + RW2_MIX + 256 + ar * 64 + c8_ * 8 + 4); \
                RW_SH8(ld[8 + (ar * 2 + i) * 2], ld[8 + (ar * 2 + i) * 2 + 1], m0, m1, s_, pz_); \
                *(LAS f32x4*)(stg + ar * 1024 + row_ * 64 + c8_ * 8) = (f32x4){s_[0], s_[1], s_[2], s_[3]}; *(LAS f32x4*)(stg + ar * 1024 + row_ * 64 + c8_ * 8 + 4) = (f32x4){s_[4], s_[5], s_[6], s_[7]}; } \
            WSYNC(); \
            PREP_ISSUE(((T0) + 32 < SEQ) ? (T0) + 32 : (T0)); \
            _Pragma("unroll") for (int rg = 0; rg < 4; ++rg) { const int tl = 4 * kg + rg, t = tb + tl; \
                float r_[4], k_[4], v_[4], kkv[4], nrm2 = 0.f; \
                _Pragma("unroll") for (int nt = 0; nt < 4; ++nt) { r_[nt] = stg[tl * 64 + 16 * nt + l15]; k_[nt] = stg[1024 + tl * 64 + 16 * nt + l15]; v_[nt] = stg[2048 + tl * 64 + 16 * nt + l15]; \
                    kkv[nt] = k_[nt] * kkc[nt]; nrm2 += kkv[nt] * kkv[nt]; } \
                nrm2 = rowsum16(nrm2); const float rn = __builtin_amdgcn_rsqf(fmaxf(nrm2, 1e-24f)); \
                float br = 0.f, kr = 0.f, bon = 0.f; \
                _Pragma("unroll") for (int nt = 0; nt < 4; ++nt) { const int j = 16 * nt + l15; \
                    const float wsum = w0c[nt] + accw[nt][rg]; const float logw = -softplus_fast(-wsum) - 0.5f; const float dec = __expf(-__expf(logw)); \
                    const float a_ = sigmoid_fast(a0c[nt] + acca[nt][rg]); const float kn = kkv[nt] * rn; \
                    const float k2 = k_[nt] * (1.f + (a_ - 1.f) * kac[nt]); const float bv = kn * a_; \
                    br += bv * r_[nt]; kr += k2 * r_[nt]; bon += r_[nt] * k2 * rkc[nt]; \
                    CHn[t * 64 + j] = dec; CHn[2048 + t * 64 + j] = k2; CHn[4096 + t * 64 + j] = -kn; CHn[6144 + t * 64 + j] = bv; CHn[8192 + t * 64 + j] = dec * r_[nt]; \
                    if ((nt >> 1) == half) CHn[10240 + t * 32 + (j & 31)] = v_[nt]; } \
                br = rowsum16(br); kr = rowsum16(kr); bon = rowsum16(bon); \
                if (l15 == 0) { CHn[11264 + 2 * t] = br; CHn[11264 + 2 * t + 1] = kr; if (half == 0) bonus_out[(rowb + t0_ + t) * 8 + h] = bon; } } \
            WSYNC(); } while (0)
        PREP_ISSUE(0);
        PREP_BUILD(0, 0);
        __syncthreads();
#pragma unroll 1
        for (int ch = 0; ch < NCHUNK; ++ch) {
            if (ch + 1 < NCHUNK) PREP_BUILD(ch * 32 + 32, (ch + 1) & 1);
            __syncthreads();
        }
#undef PREP_ISSUE
#undef PREP_BUILD
    } else {
        const int tp = wave - 6, tb = 16 * tp;
        v4u ld[8];
#define G_ISSUE(T0) do { const int t0_ = (T0); const size_t r_ = rowb + t0_ + tb + l15; const size_t rp_ = (t0_ + tb + l15 == 0) ? r_ : r_ - 1; \
            _Pragma("unroll") for (int ks = 0; ks < 4; ++ks) { const int col = 1664 + 32 * ks + 8 * kg; ld[2 * ks] = *(const v4u*)(proj + r_ * L0P + col); ld[2 * ks + 1] = *(const v4u*)(proj + rp_ * L0P + col); } } while (0)
#define G_BUILD(T0) do { const int t0_ = (T0); f32x4 accg[2] = {(f32x4){0.f, 0.f, 0.f, 0.f}, (f32x4){0.f, 0.f, 0.f, 0.f}}; const float pz_ = (t0_ + tb + l15 == 0) ? 0.f : 1.f; \
            _Pragma("unroll") for (int ks = 0; ks < 4; ++ks) { float s_[8]; \
                const f32x4 m0 = *(const LAS f32x4*)(sm + RW2_MIX + 128 + 32 * ks + 8 * kg), m1 = *(const LAS f32x4*)(sm + RW2_MIX + 128 + 32 * ks + 8 * kg + 4); \
                RW_SH8(ld[2 * ks], ld[2 * ks + 1], m0, m1, s_, pz_); \
                _Pragma("unroll") for (int j = 0; j < 8; ++j) s_[j] = sigmoid_fast(s_[j]); \
                v4u aw; aw.x = cvtpk(s_[0], s_[1]); aw.y = cvtpk(s_[2], s_[3]); aw.z = cvtpk(s_[4], s_[5]); aw.w = cvtpk(s_[6], s_[7]); const bf16x8 af = __builtin_bit_cast(bf16x8, aw); \
                _Pragma("unroll") for (int nt = 0; nt < 2; ++nt) { const bf16x8 bfr = *(const bf16x8*)(G2T + (size_t)(h * 64 + half * 32 + 16 * nt + l15) * 128 + 32 * ks + 8 * kg); accg[nt] = MFMA16(af, bfr, accg[nt]); } } \
            G_ISSUE(((T0) + 32 < SEQ) ? (T0) + 32 : (T0)); \
            _Pragma("unroll") for (int nt = 0; nt < 2; ++nt) _Pragma("unroll") for (int rg = 0; rg < 4; ++rg) \
                gout[(rowb + t0_ + tb + 4 * kg + rg) * 512 + h * 64 + half * 32 + 16 * nt + l15] = (bf16_t)f2bf(accg[nt][rg]); } while (0)
        G_ISSUE(0);
        G_BUILD(0);
        __syncthreads();
#pragma unroll 1
        for (int ch = 0; ch < NCHUNK; ++ch) {
            if (ch + 1 < NCHUNK) G_BUILD(ch * 32 + 32);
            __syncthreads();
        }
#undef G_ISSUE
#undef G_BUILD
    }
#undef RW_SH8
    __syncthreads();
}

constexpr int CK_BK = 0, CK_AR = 4608, CK_BBT = 9216, CK_KBT = 12288, CK_VT = 15360, CK_GC = 16896, CK_TT = 17152, CK_SLOT = 18688, CK_NSLOT = 5;
constexpr int CK_STG = CK_SLOT * CK_NSLOT;
constexpr int CK_MIX = CK_STG + 4 * 12288;
constexpr int CK_FLAGS = CK_MIX + 448 * 4;
static_assert(CK_FLAGS + 64 <= 146432, "rwkv chunked LDS map");
__device__ __forceinline__ bf16x8 pack8(float a0, float a1, float a2, float a3, float a4, float a5, float a6, float a7) {
    v4u w; w.x = cvtpk(a0, a1); w.y = cvtpk(a2, a3); w.z = cvtpk(a4, a5); w.w = cvtpk(a6, a7); return __builtin_bit_cast(bf16x8, w); }
__device__ __forceinline__ void rwkv_phase(LAS float* smf, int tid, int lane, int wave, int blk, const bf16_t* __restrict__ proj, const float* __restrict__ mix, const float* __restrict__ w0, const float* __restrict__ a0,
                                           const float* __restrict__ k_k, const float* __restrict__ k_a, const float* __restrict__ r_k, const bf16_t* __restrict__ W2T, const bf16_t* __restrict__ A2T, const bf16_t* __restrict__ G2T,
                                           float* __restrict__ yraw, bf16_t* __restrict__ gout, float* __restrict__ bonus_out) {
    LAS unsigned char* lds = (LAS unsigned char*)smf;
    LAS float* mixs = (LAS float*)(lds + CK_MIX);
    volatile LAS unsigned* flags = (volatile LAS unsigned*)(lds + CK_FLAGS);
    const int chain = blk >> 1, ihalf = blk & 1, b = chain >> 3, h = chain & 7, l15 = lane & 15, kg = lane >> 4, l31 = lane & 31, hi = lane >> 5;
    const size_t rowb = (size_t)b * SEQ;
    constexpr int NCH = SEQ / 16;
    if (tid < 256) mixs[tid] = mix[1536 + tid];
    else if (tid < 448) { const int q = tid - 256; mixs[tid] = mix[512 * (q >> 6) + h * 64 + (q & 63)]; }
    if (tid < 16) flags[tid] = 0u;
    for (int q = tid; q < CK_NSLOT * 384; q += NWAVES * 64) *(LAS unsigned*)(lds + (q / 384) * CK_SLOT + CK_TT + (q % 384) * 4) = 0u;
    __syncthreads();
#define RW_SH8(CUR, PRV, M0, M1, OUT, PZ) do { const unsigned cu_[4] = {(CUR).x, (CUR).y, (CUR).z, (CUR).w}, pu_[4] = {(PRV).x, (PRV).y, (PRV).z, (PRV).w}; \
        const float mm_[8] = {(M0)[0], (M0)[1], (M0)[2], (M0)[3], (M1)[0], (M1)[1], (M1)[2], (M1)[3]}; \
        _Pragma("unroll") for (int q = 0; q < 4; ++q) { const float c0 = bflo(cu_[q]), c1 = bfhi(cu_[q]), p0 = bflo(pu_[q]) * (PZ), p1 = bfhi(pu_[q]) * (PZ); \
            OUT[2 * q] = c0 + (p0 - c0) * mm_[2 * q]; OUT[2 * q + 1] = c1 + (p1 - c1) * mm_[2 * q + 1]; } } while (0)
    if (wave == 0) {
        f32x16 ST[2];
#pragma unroll
        for (int r = 0; r < 16; ++r) { ST[0][r] = 0.f; ST[1][r] = 0.f; }
#pragma unroll 1
        for (int k = 0; k < NCH; ++k) {
#if defined(PROBE_STAMPS)
            const unsigned tw0_ = (unsigned)__builtin_amdgcn_s_memrealtime();
#endif
            { const unsigned want = (unsigned)(k + 1); const int sl = k % CK_NSLOT; while (flags[sl] != want) __builtin_amdgcn_s_sleep(1); }
#if defined(PROBE_STAMPS)
            if (blk == 0 && lane == 0) ((volatile LAS unsigned*)(lds + 146432 + 320))[16 + 24] += (unsigned)__builtin_amdgcn_s_memrealtime() - tw0_;
#endif
            asm volatile("" ::: "memory");
            const LAS unsigned char* im = lds + (k % CK_NSLOT) * CK_SLOT;
            f32x16 G;
#pragma unroll
            for (int r = 0; r < 16; ++r) G[r] = 0.f;
#pragma unroll
            for (int kk = 0; kk < 4; ++kk) { const bf16x8 fa = *(const LAS bf16x8*)(im + CK_BK + l31 * 144 + (16 * kk + 8 * hi) * 2), fb = *(const LAS bf16x8*)(im + CK_AR + l31 * 144 + (16 * kk + 8 * hi) * 2); G = MFMA32(fa, fb, G); }
            { const int tcol = l31 & 15; const bool strict = l31 < 16;
#pragma unroll
              for (int r = 0; r < 16; ++r) { const int srow = crow(r & 7, hi); const bool keep = strict ? (srow < tcol) : (srow <= tcol); G[r] = keep ? G[r] : 0.f; } }
            const bf16x8 gB = pack8(G[0], G[1], G[2], G[3], G[4], G[5], G[6], G[7]), gK = pack8(G[8], G[9], G[10], G[11], G[12], G[13], G[14], G[15]);
            f32x16 XT;
#pragma unroll
            for (int r = 0; r < 16; ++r) XT[r] = 0.f;
#pragma unroll
            for (int jt = 0; jt < 2; ++jt)
#pragma unroll
                for (int sp = 0; sp < 2; ++sp) { const LAS unsigned char* ap = im + CK_AR + l31 * 144 + (32 * jt + 16 * sp + 4 * hi) * 2;
                    const u32x2 x0 = *(const LAS u32x2*)ap, x1 = *(const LAS u32x2*)(ap + 16); v4u aw; aw.x = x0.x; aw.y = x0.y; aw.z = x1.x; aw.w = x1.y;
                    const bf16x8 sb_ = pack8(ST[jt][8 * sp], ST[jt][8 * sp + 1], ST[jt][8 * sp + 2], ST[jt][8 * sp + 3], ST[jt][8 * sp + 4], ST[jt][8 * sp + 5], ST[jt][8 * sp + 6], ST[jt][8 * sp + 7]);
                    XT = MFMA32(__builtin_bit_cast(bf16x8, aw), sb_, XT); }
            bf16x8 vP;
            { const LAS unsigned char* vp = im + CK_VT + l31 * 48 + (4 * hi) * 2; const u32x2 x0 = *(const LAS u32x2*)vp, x1 = *(const LAS u32x2*)(vp + 16); v4u vw; vw.x = x0.x; vw.y = x0.y; vw.z = x1.x; vw.w = x1.y;
              vP = __builtin_bit_cast(bf16x8, vw); XT = MFMA32(gK, vP, XT); }
            bf16x8 uP;
            { const LAS unsigned char* tp = im + CK_TT + l31 * 48 + (4 * hi) * 2; const u32x2 x0 = *(const LAS u32x2*)tp, x1 = *(const LAS u32x2*)(tp + 16); v4u tw; tw.x = x0.x; tw.y = x0.y; tw.z = x1.x; tw.w = x1.y;
              f32x16 UT;
#pragma unroll
              for (int r = 0; r < 16; ++r) UT[r] = 0.f;
              UT = MFMA32(__builtin_bit_cast(bf16x8, tw), pack8(XT[0], XT[1], XT[2], XT[3], XT[4], XT[5], XT[6], XT[7]), UT);
              uP = pack8(UT[0], UT[1], UT[2], UT[3], UT[4], UT[5], UT[6], UT[7]); }
            XT = MFMA32(gB, uP, XT);
            { float* yp = yraw + (rowb + 16 * k) * 512 + h * 64 + 32 * ihalf + l31;
#pragma unroll
              for (int q = 0; q < 8; ++q) yp[(size_t)crow(q, hi) * 512] = XT[8 + q]; }
            { const LAS float* gc = (const LAS float*)(im + CK_GC);
#pragma unroll
              for (int jt = 0; jt < 2; ++jt)
#pragma unroll
                  for (int r = 0; r < 16; ++r) ST[jt][r] *= gc[32 * jt + crow(r, hi)]; }
#pragma unroll
            for (int jt = 0; jt < 2; ++jt) { const LAS unsigned char* bp = im + CK_BBT + (32 * jt + l31) * 48 + (4 * hi) * 2; const LAS unsigned char* kp = im + CK_KBT + (32 * jt + l31) * 48 + (4 * hi) * 2;
                const u32x2 b0 = *(const LAS u32x2*)bp, b1 = *(const LAS u32x2*)(bp + 16), k0 = *(const LAS u32x2*)kp, k1 = *(const LAS u32x2*)(kp + 16);
                v4u a1; a1.x = b0.x; a1.y = b0.y; a1.z = b1.x; a1.w = b1.y; v4u a2; a2.x = k0.x; a2.y = k0.y; a2.z = k1.x; a2.w = k1.y;
                ST[jt] = MFMA32(__builtin_bit_cast(bf16x8, a1), uP, ST[jt]); ST[jt] = MFMA32(__builtin_bit_cast(bf16x8, a2), vP, ST[jt]); }
            WSYNC();
            if (lane == 0) flags[8] = (unsigned)(k + 1);
        }
    } else if (wave <= 4) {
        const int pw = wave - 1;
        LAS float* stg = (LAS float*)(lds + CK_STG) + pw * 3072;
        float w0c[4], a0c[4], kkc[4], kac[4], rkc[4];
#pragma unroll
        for (int nt = 0; nt < 4; ++nt) { const int c = h * 64 + 16 * nt + l15; w0c[nt] = w0[c]; a0c[nt] = a0[c]; kkc[nt] = k_k[c]; kac[nt] = k_a[c]; rkc[nt] = r_k[c]; }
        v4u ld[20];
#define CK_ISSUE(T0) do { const int t0_ = (T0); { const size_t r_ = rowb + t0_ + l15; const size_t rp_ = (t0_ + l15 == 0) ? r_ : r_ - 1; \
            _Pragma("unroll") for (int lo = 0; lo < 2; ++lo) _Pragma("unroll") for (int ks = 0; ks < 2; ++ks) { const int col = 1536 + 64 * lo + 32 * ks + 8 * kg; \
                ld[(lo * 2 + ks) * 2] = *(const v4u*)(proj + r_ * L0P + col); ld[(lo * 2 + ks) * 2 + 1] = *(const v4u*)(proj + rp_ * L0P + col); } } \
            _Pragma("unroll") for (int ar = 0; ar < 3; ++ar) _Pragma("unroll") for (int i = 0; i < 2; ++i) { const int p_ = lane + 64 * i, row_ = p_ >> 3, c8_ = p_ & 7; \
                const size_t r_ = rowb + t0_ + row_; const size_t rp_ = (t0_ + row_ == 0) ? r_ : r_ - 1; const int col = 512 * ar + h * 64 + 8 * c8_; \
                ld[8 + (ar * 2 + i) * 2] = *(const v4u*)(proj + r_ * L0P + col); ld[8 + (ar * 2 + i) * 2 + 1] = *(const v4u*)(proj + rp_ * L0P + col); } } while (0)
        CK_ISSUE(16 * pw);
#pragma unroll 1
        for (int k = pw; k < NCH; k += 4) {
            const int t0 = 16 * k;
#if defined(PROBE_STAMPS)
            const unsigned ts0_ = (unsigned)__builtin_amdgcn_s_memrealtime();
#endif
            unsigned pf0, pf1;
            { const int tpf = (k + 8 < NCH) ? t0 + 128 : t0; const int wh = lane & 3; const bf16_t* rp = proj + (rowb + tpf + (lane >> 2)) * L0P;
              pf0 = *(const unsigned*)(rp + ((wh < 3) ? 512 * wh + h * 64 : 1536)); pf1 = *(const unsigned*)(rp + 1600); }
            f32x4 accw[4], acca[4];
#pragma unroll
            for (int nt = 0; nt < 4; ++nt) { accw[nt] = (f32x4){0.f, 0.f, 0.f, 0.f}; acca[nt] = (f32x4){0.f, 0.f, 0.f, 0.f}; }
            { const float pz_ = (t0 + l15 == 0) ? 0.f : 1.f;
#pragma unroll
              for (int lo = 0; lo < 2; ++lo)
#pragma unroll
                for (int ks = 0; ks < 2; ++ks) { float s_[8];
                    const f32x4 m0 = *(const LAS f32x4*)(mixs + 64 * lo + 32 * ks + 8 * kg), m1 = *(const LAS f32x4*)(mixs + 64 * lo + 32 * ks + 8 * kg + 4);
                    RW_SH8(ld[(lo * 2 + ks) * 2], ld[(lo * 2 + ks) * 2 + 1], m0, m1, s_, pz_);
                    if (lo == 0) {
#pragma unroll
                        for (int j = 0; j < 8; ++j) s_[j] = tanh_fast(s_[j]); }
                    const bf16x8 af = pack8(s_[0], s_[1], s_[2], s_[3], s_[4], s_[5], s_[6], s_[7]);
                    const bf16_t* WT = lo ? A2T : W2T;
#pragma unroll
                    for (int nt = 0; nt < 4; ++nt) { const bf16x8 bfr = *(const bf16x8*)(WT + (size_t)(h * 64 + 16 * nt + l15) * 64 + 32 * ks + 8 * kg);
                        if (lo == 0) accw[nt] = MFMA16(af, bfr, accw[nt]); else acca[nt] = MFMA16(af, bfr, acca[nt]); } } }
#pragma unroll
            for (int ar = 0; ar < 3; ++ar)
#pragma unroll
                for (int i = 0; i < 2; ++i) { const int p_ = lane + 64 * i, row_ = p_ >> 3, c8_ = p_ & 7; float s_[8];
                    const float pz_ = (t0 + row_ == 0) ? 0.f : 1.f; const f32x4 m0 = *(const LAS f32x4*)(mixs + 256 + ar * 64 + c8_ * 8), m1 = *(const LAS f32x4*)(mixs + 256 + ar * 64 + c8_ * 8 + 4);
                    RW_SH8(ld[8 + (ar * 2 + i) * 2], ld[8 + (ar * 2 + i) * 2 + 1], m0, m1, s_, pz_);
                    *(LAS f32x4*)(stg + ar * 1024 + row_ * 64 + c8_ * 8) = (f32x4){s_[0], s_[1], s_[2], s_[3]}; *(LAS f32x4*)(stg + ar * 1024 + row_ * 64 + c8_ * 8 + 4) = (f32x4){s_[4], s_[5], s_[6], s_[7]}; }
            WSYNC();
#if defined(PROBE_STAMPS)
            if (blk == 0 && wave == 1 && lane == 0) ((volatile LAS unsigned*)(lds + 146432 + 320))[16 + 26] += (unsigned)__builtin_amdgcn_s_memrealtime() - ts0_;
#endif
#if defined(PROBE_STAMPS)
            const unsigned tb0_ = (unsigned)__builtin_amdgcn_s_memrealtime();
#endif
            { const int need = k - (CK_NSLOT - 1); if (need > 0) { while ((int)flags[8] < need) __builtin_amdgcn_s_sleep(2); } }
#if defined(PROBE_STAMPS)
            if (blk == 0 && wave == 1 && lane == 0) ((volatile LAS unsigned*)(lds + 146432 + 320))[16 + 25] += (unsigned)__builtin_amdgcn_s_memrealtime() - tb0_;
#endif
            asm volatile("" ::: "memory");
            LAS unsigned char* im = lds + (k % CK_NSLOT) * CK_SLOT;
#if defined(PROBE_STAMPS)
            const unsigned ts1_ = (unsigned)__builtin_amdgcn_s_memrealtime();
#endif
            float lwv[4][4], av[4][4], knv[4][4], rv[4][4], kv[4][4];
#pragma unroll
            for (int rg = 0; rg < 4; ++rg) { const int tl = 4 * kg + rg;
                float kkv[4], nrm2 = 0.f, vv[4], rr_[4], kr_[4];
#pragma unroll
                for (int nt = 0; nt < 4; ++nt) { rr_[nt] = stg[tl * 64 + 16 * nt + l15]; kr_[nt] = stg[1024 + tl * 64 + 16 * nt + l15]; vv[nt] = stg[2048 + tl * 64 + 16 * nt + l15];
                    kkv[nt] = kr_[nt] * kkc[nt]; nrm2 += kkv[nt] * kkv[nt]; }
                nrm2 = rowsum16(nrm2); const float rn = __builtin_amdgcn_rsqf(fmaxf(nrm2, 1e-24f));
                float bon = 0.f;
#pragma unroll
                for (int nt = 0; nt < 4; ++nt) {
                    const float wsum = w0c[nt] + accw[nt][rg]; lwv[nt][rg] = -0.6065306597126334f * sigmoid_fast(wsum);
                    const float a_ = sigmoid_fast(a0c[nt] + acca[nt][rg]); av[nt][rg] = a_; knv[nt][rg] = kkv[nt] * rn;
                    const float k2 = kr_[nt] * (1.f + (a_ - 1.f) * kac[nt]); kv[nt][rg] = k2; rv[nt][rg] = rr_[nt];
                    bon += rr_[nt] * k2 * rkc[nt];
                    if ((nt >> 1) == ihalf) *(LAS bf16_t*)(im + CK_VT + (16 * (nt & 1) + l15) * 48 + tl * 2) = bf1(vv[nt]);
                }
                bon = rowsum16(bon);
                if (l15 == 0 && ihalf == 0) bonus_out[(rowb + t0 + tl) * 8 + h] = bon;
            }
#pragma unroll
            for (int nt = 0; nt < 4; ++nt) {
                float L[4]; L[0] = lwv[nt][0]; L[1] = L[0] + lwv[nt][1]; L[2] = L[1] + lwv[nt][2]; L[3] = L[2] + lwv[nt][3];
                const float T0 = __shfl(L[3], l15), T1 = __shfl(L[3], 16 + l15), T2 = __shfl(L[3], 32 + l15), T3 = __shfl(L[3], 48 + l15);
                const float off = (kg > 0 ? T0 : 0.f) + (kg > 1 ? T1 : 0.f) + (kg > 2 ? T2 : 0.f), LC = (T0 + T1) + (T2 + T3);
                const int j = 16 * nt + l15;
                unsigned bb2[2], kb2[2];
                const float gC = __expf(LC); float eprev = __expf(off);
#pragma unroll
                for (int rg = 0; rg < 4; ++rg) { const int tl = 4 * kg + rg; const float Lt = off + L[rg], e1 = __expf(Lt), e2 = __builtin_amdgcn_rcpf(e1), e3 = eprev, e4 = gC * e2; eprev = e1;
                    const float kn = knv[nt][rg], bvv = kn * av[nt][rg], k2 = kv[nt][rg], rr2 = rv[nt][rg];
                    *(LAS bf16_t*)(im + CK_BK + tl * 144 + j * 2) = bf1(bvv * e2); *(LAS bf16_t*)(im + CK_BK + (16 + tl) * 144 + j * 2) = bf1(k2 * e2);
                    *(LAS bf16_t*)(im + CK_AR + tl * 144 + j * 2) = bf1(-kn * e3); *(LAS bf16_t*)(im + CK_AR + (16 + tl) * 144 + j * 2) = bf1(rr2 * e1);
                    const unsigned bq = bf1(bvv * e4), kq = bf1(k2 * e4);
                    if (rg & 1) { bb2[rg >> 1] |= bq << 16; kb2[rg >> 1] |= kq << 16; } else { bb2[rg >> 1] = bq; kb2[rg >> 1] = kq; } }
                *(LAS u32x2*)(im + CK_BBT + j * 48 + (4 * kg) * 2) = (u32x2){bb2[0], bb2[1]}; *(LAS u32x2*)(im + CK_KBT + j * 48 + (4 * kg) * 2) = (u32x2){kb2[0], kb2[1]};
                if (kg == 0) *(LAS float*)(im + CK_GC + j * 4) = gC;
            }
            WSYNC();
#if defined(PROBE_STAMPS)
            const unsigned ts2_ = (unsigned)__builtin_amdgcn_s_memrealtime();
            if (blk == 0 && wave == 1 && lane == 0) ((volatile LAS unsigned*)(lds + 146432 + 320))[16 + 27] += ts2_ - ts1_;
#endif
            {
                f32x4 nacc = {0.f, 0.f, 0.f, 0.f};
#pragma unroll
                for (int ks = 0; ks < 2; ++ks) { const bf16x8 fa = *(const LAS bf16x8*)(im + CK_BK + l15 * 144 + (32 * ks + 8 * kg) * 2), fb = *(const LAS bf16x8*)(im + CK_AR + l15 * 144 + (32 * ks + 8 * kg) * 2); nacc = MFMA16(fa, fb, nacc); }
#pragma unroll
                for (int rg = 0; rg < 4; ++rg) nacc[rg] = ((4 * kg + rg) < l15) ? nacc[rg] : 0.f;
                float Tr[16];
#pragma unroll
                for (int t = 0; t < 16; ++t) { float acc_ = (l15 == t) ? 1.f : 0.f;
#pragma unroll
                    for (int s2 = 0; s2 < t; ++s2) acc_ += Tr[s2] * rl(nacc[s2 & 3], t + 16 * (s2 >> 2));
                    Tr[t] = acc_; }
                if (kg == 0) {
#pragma unroll
                    for (int t = 0; t < 16; ++t) *(LAS bf16_t*)(im + CK_TT + t * 48 + l15 * 2) = bf1(Tr[t]); }
            }
            WSYNC();
#if defined(PROBE_STAMPS)
            if (blk == 0 && wave == 1 && lane == 0) ((volatile LAS unsigned*)(lds + 146432 + 320))[16 + 28] += (unsigned)__builtin_amdgcn_s_memrealtime() - ts2_;
#endif
            if (lane == 0) flags[k % CK_NSLOT] = (unsigned)(k + 1);
            CK_ISSUE((k + 4 < NCH) ? t0 + 64 : t0);
            asm volatile("" :: "v"(pf0), "v"(pf1));
        }
#undef CK_ISSUE
    } else if (wave <= 6) {
        const int gq = wave - 5;
        v4u ld[8];
#define G_ISSUE(T0) do { const int t0_ = (T0); const size_t r_ = rowb + t0_ + l15; const size_t rp_ = (t0_ + l15 == 0) ? r_ : r_ - 1; \
            _Pragma("unroll") for (int ks = 0; ks < 4; ++ks) { const int col = 1664 + 32 * ks + 8 * kg; ld[2 * ks] = *(const v4u*)(proj + r_ * L0P + col); ld[2 * ks + 1] = *(const v4u*)(proj + rp_ * L0P + col); } } while (0)
        G_ISSUE(16 * gq);
#pragma unroll 1
        for (int k = gq; k < NCH; k += 2) {
            const int t0 = 16 * k;
            f32x4 accg[2] = {(f32x4){0.f, 0.f, 0.f, 0.f}, (f32x4){0.f, 0.f, 0.f, 0.f}}; const float pz_ = (t0 + l15 == 0) ? 0.f : 1.f;
#pragma unroll
            for (int ks = 0; ks < 4; ++ks) { float s_[8];
                const f32x4 m0 = *(const LAS f32x4*)(mixs + 128 + 32 * ks + 8 * kg), m1 = *(const LAS f32x4*)(mixs + 128 + 32 * ks + 8 * kg + 4);
                RW_SH8(ld[2 * ks], ld[2 * ks + 1], m0, m1, s_, pz_);
#pragma unroll
                for (int j = 0; j < 8; ++j) s_[j] = sigmoid_fast(s_[j]);
                const bf16x8 af = pack8(s_[0], s_[1], s_[2], s_[3], s_[4], s_[5], s_[6], s_[7]);
#pragma unroll
                for (int nt = 0; nt < 2; ++nt) { const bf16x8 bfr = *(const bf16x8*)(G2T + (size_t)(h * 64 + ihalf * 32 + 16 * nt + l15) * 128 + 32 * ks + 8 * kg); accg[nt] = MFMA16(af, bfr, accg[nt]); } }
            G_ISSUE((k + 2 < NCH) ? t0 + 32 : t0);
#pragma unroll
            for (int nt = 0; nt < 2; ++nt)
#pragma unroll
                for (int rg = 0; rg < 4; ++rg) gout[(rowb + t0 + 4 * kg + rg) * 512 + h * 64 + ihalf * 32 + 16 * nt + l15] = bf1(accg[nt][rg]);
        }
#undef G_ISSUE
    }
#undef RW_SH8
    __syncthreads();
}

template <bool ST = true> __device__ __forceinline__ void rwkv_post_all(const float* __restrict__ yraw, const bf16_t* __restrict__ proj, const float* __restrict__ mix, const float* __restrict__ bonus, const bf16_t* __restrict__ gbuf,
                                              const float* __restrict__ ln_g, const float* __restrict__ ln_b, bf16_t* __restrict__ ymix, int gw, int NGW, int lane) {
    for (int m = gw; m < M; m += NGW) {
        const bool has_prev = (m & (SEQ - 1)) != 0;
        float y[8], cv[8], pv[8], gg[8], bo[8];
#pragma unroll
        for (int h = 0; h < 8; ++h) { const int c = h * 64 + lane; y[h] = yraw[(size_t)m * 512 + c]; cv[h] = bf2f(proj[(size_t)m * L0P + 1024 + c]);
            pv[h] = bf2f(proj[(size_t)(has_prev ? m - 1 : m) * L0P + 1024 + c]); gg[h] = bf2f(gbuf[(size_t)m * 512 + c]); bo[h] = bonus[(size_t)m * 8 + h]; }
#pragma unroll
        for (int h = 0; h < 8; ++h) { const int c = h * 64 + lane;
            const float mu = wave_sum_dpp(y[h]) * (1.f / 64.f), d = y[h] - mu, var = wave_sum_dpp(d * d) * (1.f / 64.f);
            const float yn = d * __builtin_amdgcn_rsqf(var + 64e-5f) * ln_g[c] + ln_b[c];
            const float pvv = has_prev ? pv[h] : 0.f;
            const float v_s = cv[h] + (pvv - cv[h]) * mix[1024 + c];
            const float o = (yn + bo[h] * v_s) * gg[h];
            if (ST) ymix[(size_t)m * DM + c] = (bf16_t)f2bf(o); else asm volatile("" :: "v"(o)); }
    }
}


__device__ __forceinline__ void ssd_conv_tile(int it, int lane, LAS bf16_t* scr, const bf16_t* __restrict__ proj, const float* __restrict__ cw, const float* __restrict__ cb,
                                              bf16_t* __restrict__ xbc, bf16_t* __restrict__ xst, bf16_t* __restrict__ bt) {
    const int tt = it >> 4, ct = it & 15, m0 = tt * 64, b = m0 >> 11, t0 = m0 & (SEQ - 1), c = ct * 64 + lane;
    const float w0 = cw[c], w1 = cw[1024 + c], w2 = cw[2048 + c], w3 = cw[3072 + c], bias = cb[c];
    const bf16_t* src = proj + (size_t)m0 * L0P + 2304 + c;
    bf16_t raw[67];
    const int lo = (t0 > 0) ? -3 : 0;
#pragma unroll
    for (int t = -3; t < 64; ++t) raw[t + 3] = src[(ptrdiff_t)((t < lo) ? lo : t) * L0P];
    float u3 = (t0 > 0) ? bf2f(raw[0]) : 0.f, u2 = (t0 > 0) ? bf2f(raw[1]) : 0.f, u1 = (t0 > 0) ? bf2f(raw[2]) : 0.f;
#pragma unroll
    for (int t = 0; t < 64; ++t) {
        const float u = bf2f(raw[t + 3]);
        const float y = bias + w0 * u3 + w1 * u2 + w2 * u1 + w3 * u;
        const bf16_t o = bf1(y * __builtin_amdgcn_rcpf(1.f + __expf(-y)));
        xbc[(size_t)(m0 + t) * 1024 + c] = o;
        scr[t * STG_PITCH + lane] = o;
        u3 = u2; u2 = u1; u1 = u;
    }
    WSYNC();
    if (ct < 12) {
        bf16_t* dst = (ct < 8) ? xst + ((size_t)(b * 8 + ct) * 64) * SEQ + t0 : bt + ((size_t)(b * 2 + ((ct - 8) >> 1)) * 128 + ((ct - 8) & 1) * 64) * SEQ + t0;
#pragma unroll
        for (int i = 0; i < 8; ++i) { const int d = i * 8 + (lane >> 3), tc = lane & 7; const LAS bf16_t* p = scr + (tc * 8) * STG_PITCH + d;
            v4u o; o.x = (unsigned)p[0] | ((unsigned)p[STG_PITCH] << 16); o.y = (unsigned)p[2 * STG_PITCH] | ((unsigned)p[3 * STG_PITCH] << 16);
            o.z = (unsigned)p[4 * STG_PITCH] | ((unsigned)p[5 * STG_PITCH] << 16); o.w = (unsigned)p[6 * STG_PITCH] | ((unsigned)p[7 * STG_PITCH] << 16);
            *(v4u*)(dst + (size_t)d * SEQ + tc * 8) = o; }
    }
    WSYNC();
}
__device__ __forceinline__ float bperm(int srclane, float x) { return __builtin_bit_cast(float, __builtin_amdgcn_ds_bpermute(srclane << 2, __builtin_bit_cast(int, x))); }
__device__ __forceinline__ void scan128(float& x0, float& x1, int lane) {
#pragma unroll
    for (int o = 1; o < 64; o <<= 1) { const int sl = (lane >= o) ? lane - o : lane; const float t0 = bperm(sl, x0), t1 = bperm(sl, x1); if (lane >= o) { x0 += t0; x1 += t1; } }
    x1 += rl(x0, 63);
}
__device__ __forceinline__ void ssd_s1_unit(int unit, int lane, LAS float* tab, const bf16_t* __restrict__ xst, const bf16_t* __restrict__ bt, const float* __restrict__ dt, const float* __restrict__ a_log,
                                            float* __restrict__ sloc, float* __restrict__ asum) {
    const int h = unit & 7, c = (unit >> 3) & 15, b = unit >> 7, g = h >> 2, l0 = c * 128, l31 = lane & 31, hi = lane >> 5;
    const size_t m0 = (size_t)b * SEQ + l0;
    const float A = -expf(a_log[h]);
    const float d0 = dt[(m0 + lane) * 8 + h], d1 = dt[(m0 + 64 + lane) * 8 + h];
    float ac0 = d0 * A, ac1 = d1 * A;
    scan128(ac0, ac1, lane);
    const float aend = rl(ac1, 63);
    tab[lane] = __expf(aend - ac0) * d0; tab[64 + lane] = __expf(aend - ac1) * d1;
    if (lane == 0) asum[unit] = aend;
    WSYNC();
    f32x16 acc[2][4];
#pragma unroll
    for (int pt = 0; pt < 2; ++pt)
#pragma unroll
        for (int nt = 0; nt < 4; ++nt)
#pragma unroll
            for (int r = 0; r < 16; ++r) acc[pt][nt][r] = 0.f;
    const bf16_t* Xp = xst + ((size_t)(b * 8 + h) * 64 + l31) * SEQ + l0 + 8 * hi;
    const bf16_t* Bp = bt + ((size_t)(b * 2 + g) * 128 + l31) * SEQ + l0 + 8 * hi;
#pragma unroll 2
    for (int kk = 0; kk < 8; ++kk) {
        const f32x4 wa = *(const LAS f32x4*)(tab + 16 * kk + 8 * hi), wb = *(const LAS f32x4*)(tab + 16 * kk + 8 * hi + 4);
        bf16x8 af[2], bfr[4];
#pragma unroll
        for (int pt = 0; pt < 2; ++pt) { const v4u raw = *(const v4u*)(Xp + (size_t)pt * 32 * SEQ + 16 * kk);
            v4u w; w.x = cvtpk(bflo(raw.x) * wa[0], bfhi(raw.x) * wa[1]); w.y = cvtpk(bflo(raw.y) * wa[2], bfhi(raw.y) * wa[3]);
            w.z = cvtpk(bflo(raw.z) * wb[0], bfhi(raw.z) * wb[1]); w.w = cvtpk(bflo(raw.w) * wb[2], bfhi(raw.w) * wb[3]); af[pt] = __builtin_bit_cast(bf16x8, w); }
#pragma unroll
        for (int nt = 0; nt < 4; ++nt) bfr[nt] = *(const bf16x8*)(Bp + (size_t)nt * 32 * SEQ + 16 * kk);
#pragma unroll
        for (int pt = 0; pt < 2; ++pt)
#pragma unroll
            for (int nt = 0; nt < 4; ++nt) acc[pt][nt] = MFMA32(af[pt], bfr[nt], acc[pt][nt]);
    }
    float* dst = sloc + (size_t)unit * 8192 + l31;
#pragma unroll
    for (int pt = 0; pt < 2; ++pt)
#pragma unroll
        for (int nt = 0; nt < 4; ++nt)
#pragma unroll
            for (int r = 0; r < 16; ++r) dst[(32 * pt + crow(r, hi)) * 128 + 32 * nt] = acc[pt][nt][r];
    WSYNC();
}
__device__ __forceinline__ void ssd_s2_all(const float* __restrict__ sloc, const float* __restrict__ asum, bf16_t* __restrict__ stb, int gtid, int NT) {
    for (int i = gtid; i < 128 * 2048; i += NT) {
        const int bh = i >> 11, e4 = i & 2047, b = bh >> 3, h = bh & 7;
        f32x4 run = {0.f, 0.f, 0.f, 0.f};
#pragma unroll 4
        for (int c = 0; c < 16; ++c) { const int unit = (b * 16 + c) * 8 + h; const f32x4 tmp = *(const f32x4*)(sloc + (size_t)unit * 8192 + e4 * 4);
            uint2 w; w.x = cvtpk(run[0], run[1]); w.y = cvtpk(run[2], run[3]); *(uint2*)(stb + (size_t)unit * 8192 + e4 * 4) = w;
            run = run * __expf(asum[unit]) + tmp; }
    }
}
__device__ __forceinline__ void ssd_s3_unit(int unit, int lane, LAS float* tab, const bf16_t* __restrict__ xbc, const bf16_t* __restrict__ xst, const bf16_t* __restrict__ stb, const float* __restrict__ dt,
                                            const float* __restrict__ a_log, const float* __restrict__ dsk, bf16_t* __restrict__ yssm) {
    const int h = unit & 7, c = (unit >> 3) & 15, b = unit >> 7, g = h >> 2, l0 = c * 128, l31 = lane & 31, hi = lane >> 5;
    const size_t m0 = (size_t)b * SEQ + l0;
    const float A = -expf(a_log[h]), D = dsk[h];
    const float d0 = dt[(m0 + lane) * 8 + h], d1 = dt[(m0 + 64 + lane) * 8 + h];
    float ac0 = d0 * A, ac1 = d1 * A;
    scan128(ac0, ac1, lane);
    tab[lane] = ac0; tab[64 + lane] = ac1; tab[128 + lane] = d0; tab[192 + lane] = d1;
    WSYNC();
    const bf16_t* Cp = xbc + (m0 + l31) * 1024 + 768 + g * 128 + 8 * hi;
    const bf16_t* Sp = stb + (size_t)unit * 8192 + l31 * 128 + 8 * hi;
    const bf16_t* Bp = xbc + (m0 + l31) * 1024 + 512 + g * 128 + 8 * hi;
    const bf16_t* Xp = xst + ((size_t)(b * 8 + h) * 64 + l31) * SEQ + l0 + 4 * hi;
    LAS float* tr = tab + 256;
    const int row = lane >> 1, p0 = (lane & 1) * 16;
#pragma unroll 1
    for (int lt = 0; lt < 4; ++lt) {
        f32x16 y[2];
#pragma unroll
        for (int r = 0; r < 16; ++r) { y[0][r] = 0.f; y[1][r] = 0.f; }
        const float acl = tab[32 * lt + l31];
#pragma unroll 4
        for (int kk = 0; kk < 8; ++kk) {
            const bf16x8 cf = *(const bf16x8*)(Cp + (size_t)lt * 32 * 1024 + 16 * kk);
            const bf16x8 s0 = *(const bf16x8*)(Sp + 16 * kk), s1 = *(const bf16x8*)(Sp + 32 * 128 + 16 * kk);
            y[0] = MFMA32(s0, cf, y[0]); y[1] = MFMA32(s1, cf, y[1]);
        }
        { const float el = __expf(acl);
#pragma unroll
          for (int r = 0; r < 16; ++r) { y[0][r] *= el; y[1][r] *= el; } }
#pragma unroll 1
        for (int st = 0; st <= lt; ++st) {
            f32x16 cbt;
#pragma unroll
            for (int r = 0; r < 16; ++r) cbt[r] = 0.f;
#pragma unroll 4
            for (int kk = 0; kk < 8; ++kk) { const bf16x8 bf_ = *(const bf16x8*)(Bp + (size_t)st * 32 * 1024 + 16 * kk), cf_ = *(const bf16x8*)(Cp + (size_t)lt * 32 * 1024 + 16 * kk); cbt = MFMA32(bf_, cf_, cbt); }
#pragma unroll
            for (int r = 0; r < 16; ++r) { const int sl = 32 * st + crow(r, hi); const float acs = tab[sl], dts = tab[128 + sl];
                float v = cbt[r] * __expf(acl - acs) * dts; if (st == lt && crow(r, hi) > l31) v = 0.f; cbt[r] = v; }
            bf16x8 pf[2];
#pragma unroll
            for (int ks = 0; ks < 2; ++ks) { v4u w; w.x = cvtpk(cbt[8 * ks], cbt[8 * ks + 1]); w.y = cvtpk(cbt[8 * ks + 2], cbt[8 * ks + 3]); w.z = cvtpk(cbt[8 * ks + 4], cbt[8 * ks + 5]); w.w = cvtpk(cbt[8 * ks + 6], cbt[8 * ks + 7]); pf[ks] = __builtin_bit_cast(bf16x8, w); }
#pragma unroll
            for (int pt = 0; pt < 2; ++pt)
#pragma unroll
                for (int ks = 0; ks < 2; ++ks) { const bf16_t* xp = Xp + (size_t)pt * 32 * SEQ + st * 32 + 16 * ks; const u32x2 x0 = *(const u32x2*)xp, x1 = *(const u32x2*)(xp + 8);
                    v4u a; a.x = x0.x; a.y = x0.y; a.z = x1.x; a.w = x1.y; y[pt] = MFMA32(__builtin_bit_cast(bf16x8, a), pf[ks], y[pt]); }
        }
#pragma unroll
        for (int pt = 0; pt < 2; ++pt) {
#pragma unroll
            for (int r = 0; r < 16; ++r) tr[l31 * 33 + crow(r, hi)] = y[pt][r];
            WSYNC();
            const size_t m = m0 + 32 * lt + row;
            const v4u xa = *(const v4u*)(xbc + m * 1024 + h * 64 + 32 * pt + p0), xb = *(const v4u*)(xbc + m * 1024 + h * 64 + 32 * pt + p0 + 8);
            const unsigned xu[8] = {xa.x, xa.y, xa.z, xa.w, xb.x, xb.y, xb.z, xb.w};
            unsigned ow[8];
#pragma unroll
            for (int q = 0; q < 8; ++q) { const float v0 = tr[row * 33 + p0 + 2 * q] + D * bflo(xu[q]), v1 = tr[row * 33 + p0 + 2 * q + 1] + D * bfhi(xu[q]); ow[q] = cvtpk(v0, v1); }
            bf16_t* dst = yssm + m * 512 + h * 64 + 32 * pt + p0;
            *(v4u*)dst = (v4u){ow[0], ow[1], ow[2], ow[3]}; *(v4u*)(dst + 8) = (v4u){ow[4], ow[5], ow[6], ow[7]};
            WSYNC();
        }
    }
}

struct Args { const float* in[43]; float* out; unsigned char* ws; };
#define GEMM_PHASE(EPI, Aptr, LDA, Bptr, LDB, NN, KK, ...) do { pg8::Gemm g_{(Aptr), (Bptr), M, (NN), (KK), (LDA), (LDB)}; pg8::StaticOrder S_; S_.init(M, (NN), G, (int)blockIdx.x); \
        pg8::EPI E_{__VA_ARGS__}; pg8::gemm_phase<pg8::EPI, pg8::StaticOrder, true, true>(lds3, g_, S_, E_); } while (0)

__global__ void __launch_bounds__(NWAVES * 64, 2) fwd_mega(Args args) {
    extern __shared__ __attribute__((aligned(16))) unsigned char lds[];
    LAS unsigned char* lds3 = (LAS unsigned char*)lds;
    volatile LAS unsigned* MISC = (volatile LAS unsigned*)(lds3 + MISC_OFF);
    const int G = gridDim.x, NGW = G * NWAVES, NT = G * NWAVES * 64;
#define PHASE_IDS() int tid = threadIdx.x; asm volatile("" : "+v"(tid)); const int lane = tid & 63, wave = __builtin_amdgcn_readfirstlane(tid >> 6); const int gw = blockIdx.x * NWAVES + wave, gtid = blockIdx.x * (NWAVES * 64) + tid; (void)lane; (void)gw; (void)gtid
    unsigned char* ws = args.ws;
    gu32* ctl = (gu32*)(ws + WS_CTL);
    for (int u = threadIdx.x; u < (LDS_BYTES - LDSCTL_OFF) / 4; u += NWAVES * 64) ((LAS unsigned*)(lds3 + LDSCTL_OFF))[u] = 0u;
    __syncthreads();
    XcdBarrier bar = xcd_barrier_post((unsigned*)(ctl + CW_BAR), MISC + 8);
#if defined(PROBE_STAMPS)
    int nb_ = 0;
    if (blockIdx.x == 0 && threadIdx.x == 0) MISC[16] = (unsigned)__builtin_amdgcn_s_memrealtime();
#define GRID_BAR() do { xcd_barrier(bar); ++nb_; if (blockIdx.x == 0 && threadIdx.x == 0) MISC[16 + nb_] = (unsigned)__builtin_amdgcn_s_memrealtime(); } while (0)
#else
#define GRID_BAR() xcd_barrier(bar)
#endif
#define IN(i) (args.in[i])
    float* out = args.out;
    bf16_t* W0in = (bf16_t*)(ws + WS_W0IN); bf16_t* W0out = (bf16_t*)(ws + WS_W0OUT); bf16_t* Wup0 = (bf16_t*)(ws + WS_WUP0); bf16_t* Wdn0 = (bf16_t*)(ws + WS_WDN0);
    bf16_t* W1in = (bf16_t*)(ws + WS_W1IN); bf16_t* Wuq = (bf16_t*)(ws + WS_WUQ); bf16_t* Wukv = (bf16_t*)(ws + WS_WUKV); bf16_t* W1out = (bf16_t*)(ws + WS_W1OUT);
    bf16_t* Wup1 = (bf16_t*)(ws + WS_WUP1); bf16_t* Wdn1 = (bf16_t*)(ws + WS_WDN1);
    bf16_t* XB = (bf16_t*)(ws + WS_XB); bf16_t* YMIX = (bf16_t*)(ws + WS_YMIX); bf16_t* PROJ0 = (bf16_t*)(ws + WS_BIG);
    float* YRAW = out; bf16_t* YSSM = (bf16_t*)(out + (size_t)M * 512); bf16_t* STB = (bf16_t*)(out + (size_t)M * 768); bf16_t* XST = (bf16_t*)(ws + WS_XST); bf16_t* BT = (bf16_t*)(ws + WS_BT); float* ASUM = (float*)(ws + WS_ASUM); float* SLOC = (float*)(ws + WS_SLOC); float* DT = (float*)(ws + WS_DT); bf16_t* GB = (bf16_t*)(ws + WS_G); float* BONUS = (float*)(ws + WS_BONUS);
    bf16_t* W2T = (bf16_t*)(ws + WS_W2T); bf16_t* A2T = (bf16_t*)(ws + WS_A2T); bf16_t* G2T = (bf16_t*)(ws + WS_G2T); bf16_t* ACT = (bf16_t*)(ws + WS_GU); bf16_t* HALO = (bf16_t*)(ws + WS_GU + 176 * MiB);
    bf16_t* PROJ1 = (bf16_t*)(ws + WS_PROJ1); bf16_t* QM = (bf16_t*)(ws + WS_QM); bf16_t* KVM = (bf16_t*)(ws + WS_KVM); bf16_t* KPE = (bf16_t*)(ws + WS_KPE); float* RS = (float*)(ws + WS_RS); float* CSTAB = (float*)(ws + WS_CSTAB); float* STATS = (float*)(ws + WS_CSTAB + 4 * MiB); bf16_t* VTS = (bf16_t*)(ws + WS_VTS); bf16_t* VTM = (bf16_t*)(ws + WS_VTM);
    const int* pos = (const int*)args.in[1];

    {
        PHASE_IDS();
    {
        LAS float* scr = (LAS float*)(lds3 + wave * 16384);
        transpose_matrix(IN(2), 1024, 3336, W0in, L0P, 1024, scr, gw, NGW, lane, nullptr);
        transpose_matrix(IN(20), 1024, 1024, W0out, 1024, 1024, scr, gw, NGW, lane, nullptr);
        transpose_matrix(IN(23), 1024, 5632, Wup0, 5632, 1024, scr, gw, NGW, lane, nullptr, true);
        transpose_matrix(IN(26), 2816, 1024, Wdn0, 1024, 2816, scr, gw, NGW, lane, nullptr);
        transpose_matrix(IN(29), 1024, 1952, W1in, L1P, 1024, scr, gw, NGW, lane, nullptr);
        transpose_matrix(IN(31), 256, 768, Wuq, 768, 256, scr, gw, NGW, lane, IN(30));
        transpose_matrix(IN(33), 128, 1024, Wukv, 1024, 256, scr, gw, NGW, lane, IN(32));
        for (int i = gtid; i < 1024 * 16; i += NT) { const int n = i >> 4, c = i & 15; *(v4u*)(Wukv + (size_t)n * 256 + 128 + c * 8) = (v4u){0u, 0u, 0u, 0u}; }
        transpose_matrix(IN(34), 1024, 1024, W1out, 1024, 1024, scr, gw, NGW, lane, nullptr);
        transpose_matrix(IN(37), 1024, 5632, Wup1, 5632, 1024, scr, gw, NGW, lane, nullptr, true);
        transpose_matrix(IN(40), 2816, 1024, Wdn1, 1024, 2816, scr, gw, NGW, lane, nullptr);
        transpose_matrix(IN(5), 64, 512, W2T, 512, 64, scr, gw, NGW, lane, nullptr);
        transpose_matrix(IN(7), 64, 512, A2T, 512, 64, scr, gw, NGW, lane, nullptr);
        transpose_matrix(IN(8), 128, 512, G2T, 512, 128, scr, gw, NGW, lane, nullptr);
        const float* x = IN(0);
        {
            constexpr size_t TOT4 = (size_t)M * DM / 4;
            for (size_t i = gtid; i < TOT4; i += (size_t)NT * 8) {
                f32x4 v[8];
#pragma unroll
                for (int u = 0; u < 8; ++u) v[u] = *(const f32x4*)(x + (i + (size_t)u * NT) * 4);
#pragma unroll
                for (int u = 0; u < 8; ++u) { uint2 w; w.x = cvtpk(v[u][0], v[u][1]); w.y = cvtpk(v[u][2], v[u][3]); *(uint2*)(XB + (i + (size_t)u * NT) * 4) = w; }
            }
        }
    }
    }
    GRID_BAR();
    {
        PHASE_IDS();
    GEMM_PHASE(EpiBf16S, XB, DM, W0in, 1024, L0P, 1024, PROJ0, nullptr, L0P, 0);
    }
    GRID_BAR();
    {
        PHASE_IDS();
        const int blk = (int)blockIdx.x, m0 = blk * 128;
        {   LAS bf16_t* scr = (LAS bf16_t*)(lds3 + wave * 16384);
#pragma unroll 1
            for (int k = 0; k < 4; ++k) ssd_conv_tile((2 * blk + (k & 1)) * 16 + wave + 8 * (k >> 1), lane, scr, PROJ0, IN(14), IN(15), XB, XST, BT);
            for (int i = tid; i < 1024; i += NWAVES * 64) { const int m = m0 + (i >> 3); DT[(size_t)m * 8 + (i & 7)] = softplusf_(bf2f(PROJ0[(size_t)m * L0P + 3328 + (i & 7)]) + IN(16)[i & 7]); }
        }
        __syncthreads();
#if defined(PROBE_STAMPS)
        if (blockIdx.x == 0 && threadIdx.x == 0) MISC[16 + 29] = (unsigned)__builtin_amdgcn_s_memrealtime();
#endif
        ssd_s1_unit(blk * 8 + wave, lane, (LAS float*)(lds3 + wave * 16384), XST, BT, DT, IN(17), SLOC, ASUM);
    }
    GRID_BAR();
    {
        PHASE_IDS();
        ssd_s2_all(SLOC, ASUM, STB, gtid, NT);
#if defined(PROBE_STAMPS)
        __syncthreads(); if (blockIdx.x == 0 && threadIdx.x == 0) MISC[16 + 23] = (unsigned)__builtin_amdgcn_s_memrealtime();
#endif
        rwkv_phase((LAS float*)lds3, tid, lane, wave, (int)blockIdx.x, PROJ0, IN(3), IN(4), IN(6), IN(9), IN(10), IN(11), W2T, A2T, G2T, YRAW, GB, BONUS);
    }
    GRID_BAR();
    {
        PHASE_IDS();
        const int blk = (int)blockIdx.x;
        ssd_s3_unit(blk * 8 + wave, lane, (LAS float*)(lds3 + wave * 16384), XB, XST, STB, DT, IN(17), IN(18), YSSM);
        __syncthreads();
        ssm_gate_norm_all(YSSM, PROJ0, IN(19), YMIX, blk * 256 + wave, blk * 256 + 256, lane);
        rwkv_post_all(YRAW, PROJ0, IN(3), BONUS, GB, IN(12), IN(13), YMIX, gw, NGW, lane);
    }
    GRID_BAR();
    {
        PHASE_IDS();
    GEMM_PHASE(EpiResid, YMIX, DM, W0out, 1024, 1024, 1024, IN(0), out, ALPHA, 0);
    }
    GRID_BAR();
    {
        PHASE_IDS();
    ln_rows<1>(out, XB, STATS, IN(21), IN(22), gw, NGW, lane);
    }
    GRID_BAR();
    {
        PHASE_IDS();
        { pg8::Gemm g_{XB, Wup0, M / 32, DFF, 1024, DM, 1024, 4096, 8192, 256, 512, 1}; pg8::StaticOrder S_; S_.init(M / 32, DFF, G, (int)blockIdx.x);
          pg8::EpiBf16S E_{HALO, nullptr, DFF, 0}; pg8::gemm_phase<pg8::EpiBf16S, pg8::StaticOrder, true, true>(lds3, g_, S_, E_); }
    }
    GRID_BAR();
    {
        PHASE_IDS();
        { pg8::Gemm g_{XB, Wup0, M, 2 * DFF, 1024, DM, 1024}; pg8::StaticOrder S_; S_.init(M, 2 * DFF, G, (int)blockIdx.x);
          pg8::EpiConvAct E_{ACT, HALO, IN(24), IN(25), DFF, SEQ}; pg8::gemm_phase<pg8::EpiConvAct, pg8::StaticOrder, true, true>(lds3, g_, S_, E_); }
    }
    GRID_BAR();
    {
        PHASE_IDS();
    GEMM_PHASE(EpiResidLN, ACT, DFF, Wdn0, DFF, 1024, DFF, out, STATS, IN(21), IN(22), ALPHA, 0);
    }
    GRID_BAR();
    {
        PHASE_IDS();
    ln_rows<1>(out, XB, STATS, IN(27), IN(28), gw, NGW, lane);
    }
    GRID_BAR();
    {
        PHASE_IDS();
    GEMM_PHASE(EpiBf16S, XB, DM, W1in, 1024, L1P, 1024, PROJ1, nullptr, L1P, 0);
    }
    GRID_BAR();
    {
        PHASE_IDS();
    mla_prep_all(PROJ1, pos, RS, KPE, CSTAB, gw, NGW, lane);
    }
    GRID_BAR();
    {
        PHASE_IDS();
    GEMM_PHASE(EpiBf16S, PROJ1 + 1536, L1P, Wuq, 256, 768, 256, QM, RS, 768, 2);
    GEMM_PHASE(EpiBf16S, PROJ1 + 1792, L1P, Wukv, 256, 1024, 256, KVM, RS + 1, 1024, 2);
    }
    GRID_BAR();
    {
        PHASE_IDS();
    rope_q_all(QM, CSTAB, gtid, NT);
    {
        LAS bf16_t* scr = (LAS bf16_t*)(lds3 + wave * 16384);
        for (int it = gw; it < 8192; it += NGW) { const int which = it >> 12, r = it & 4095, bh = r >> 5, tt = r & 31, b = bh >> 3, h = bh & 7;
            if (which == 0) transpose_tile64(PROJ1 + ((size_t)b * SEQ + tt * 64) * L1P + 1024 + h * 64, L1P, VTS + (size_t)bh * 64 * SEQ + tt * 64, SEQ, scr, lane);
            else            transpose_tile64(KVM + ((size_t)b * SEQ + tt * 64) * 1024 + h * 128 + 64, 1024, VTM + (size_t)bh * 64 * SEQ + tt * 64, SEQ, scr, lane); }
    }
    }
    GRID_BAR();
    {
        PHASE_IDS();
    {
        for (int g2 = (int)blockIdx.x; g2 < 256; g2 += G) { const int bh = g2 >> 1, part = g2 & 1;
#pragma unroll 1
            for (int i = 0; i < 4; ++i) { const int sbk = part ? ((i == 0) ? 1 : (i == 1) ? 6 : (i == 2) ? 2 : 5) : ((i == 0) ? 0 : (i == 1) ? 7 : (i == 2) ? 3 : 4);
                sb_block(bh, sbk, tid, lane, wave, lds3, PROJ1, VTS, YMIX); } }
        for (int g2 = (int)blockIdx.x; g2 < 256; g2 += G) { const int bh = g2 >> 1, part = g2 & 1;
#pragma unroll 1
            for (int i = 0; i < 4; ++i) { const int sbk = part ? ((i == 0) ? 1 : (i == 1) ? 6 : (i == 2) ? 2 : 5) : ((i == 0) ? 0 : (i == 1) ? 7 : (i == 2) ? 3 : 4);
                mla_block(bh, sbk, tid, lane, wave, lds3, QM, KVM, KPE, VTM, YMIX); } }
    }
    }
    GRID_BAR();
    {
        PHASE_IDS();
    GEMM_PHASE(EpiResidLN, YMIX, DM, W1out, 1024, 1024, 1024, out, STATS, IN(27), IN(28), ALPHA, 0);
    }
    GRID_BAR();
    {
        PHASE_IDS();
    ln_rows<1>(out, XB, STATS, IN(35), IN(36), gw, NGW, lane);
    }
    GRID_BAR();
    {
        PHASE_IDS();
        { pg8::Gemm g_{XB, Wup1, M / 32, DFF, 1024, DM, 1024, 4096, 8192, 256, 512, 1}; pg8::StaticOrder S_; S_.init(M / 32, DFF, G, (int)blockIdx.x);
          pg8::EpiBf16S E_{HALO, nullptr, DFF, 0}; pg8::gemm_phase<pg8::EpiBf16S, pg8::StaticOrder, true, true>(lds3, g_, S_, E_); }
    }
    GRID_BAR();
    {
        PHASE_IDS();
        { pg8::Gemm g_{XB, Wup1, M, 2 * DFF, 1024, DM, 1024}; pg8::StaticOrder S_; S_.init(M, 2 * DFF, G, (int)blockIdx.x);
          pg8::EpiConvAct E_{ACT, HALO, IN(38), IN(39), DFF, SEQ}; pg8::gemm_phase<pg8::EpiConvAct, pg8::StaticOrder, true, true>(lds3, g_, S_, E_); }
    }
    GRID_BAR();
    {
        PHASE_IDS();
    GEMM_PHASE(EpiResidLN, ACT, DFF, Wdn1, DFF, 1024, DFF, out, STATS, IN(35), IN(36), ALPHA, 0);
    }
    GRID_BAR();
    {
        PHASE_IDS();
    ln_rows<2>(out, XB, STATS, IN(41), IN(42), gw, NGW, lane);
    #if defined(PROBE_STAMPS)
    __syncthreads();
    if (blockIdx.x == 0 && threadIdx.x == 0) {
        MISC[16 + 22] = (unsigned)__builtin_amdgcn_s_memrealtime();
#if defined(PROBE_ACC)
        const unsigned d1 = MISC[16 + PROBE_ACC];
#else
        const unsigned d1 = MISC[16 + PROBE_T1_HI] - MISC[16 + PROBE_T1_LO];
#endif
        const unsigned long long spin = 100ull * d1;
        const unsigned long long t0 = __builtin_amdgcn_s_memrealtime();
        while (__builtin_amdgcn_s_memrealtime() - t0 < spin) __builtin_amdgcn_s_sleep(8);
    }
#endif
}
}

extern "C" void kernel_launch(void* const* d_in, const int* in_sizes, int n_in, void* d_out, int out_size, void* d_ws, size_t ws_size, hipStream_t stream) {
    static int grid = 0;
    if (grid == 0) {
        if (n_in != 43 || ws_size < WS_NEED || out_size != M * DM) { fprintf(stderr, "kernel_launch: unexpected n_in %d / ws %zu / out %d\n", n_in, ws_size, out_size); grid = -1; return; }
        int dev = 0, cus = 0, per_cu = 0;
        if (hipGetDevice(&dev) != hipSuccess || hipDeviceGetAttribute(&cus, hipDeviceAttributeMultiprocessorCount, dev) != hipSuccess) { grid = -1; return; }
        if (hipFuncSetAttribute((const void*)fwd_mega, hipFuncAttributeMaxDynamicSharedMemorySize, LDS_BYTES) != hipSuccess) { fprintf(stderr, "kernel_launch: hipFuncSetAttribute failed\n"); grid = -1; return; }
        if (hipOccupancyMaxActiveBlocksPerMultiprocessor(&per_cu, (const void*)fwd_mega, NWAVES * 64, LDS_BYTES) != hipSuccess || per_cu < 1) fprintf(stderr, "kernel_launch: occupancy query reports %d\n", per_cu);
        (void)hipGetLastError();
        grid = cus;
    }
    if (grid < 0) return;
    (void)hipMemsetAsync((char*)d_ws + WS_CTL, 0, CTL_ZERO_BYTES, stream);
    Args a{};
    for (int i = 0; i < 43; ++i) a.in[i] = (const float*)d_in[i];
    a.out = (float*)d_out; a.ws = (unsigned char*)d_ws;
    hipLaunchKernelGGL(fwd_mega, dim3(grid), dim3(NWAVES * 64), LDS_BYTES, stream, a);
}
```

```cpp
#include <hip/hip_runtime.h>
#include <cstdio>
#include <cstdint>
#include <cmath>
namespace pg8 {
#define PG8_LAS __attribute__((address_space(3)))
typedef unsigned short bf16_t;
typedef short bf16x8 __attribute__((ext_vector_type(8)));
typedef float f32x4 __attribute__((ext_vector_type(4)));
typedef unsigned u32x4 __attribute__((ext_vector_type(4)));
constexpr int BM = 256, BK = 64, HALF = 128, HTB = HALF * BK * 2  , STAGE_BYTES = 8 * HTB, NXCD = 8, WGM = 8;

__host__ __device__ __forceinline__ int lds_byte(int r, int c) { const int st = (r >> 4) * 2 + (c >> 5), rr = r & 15, cc = c & 31, ob = rr * 64 + cc * 2; return st * 1024 + (ob ^ (((ob >> 9) & 1) << 5)); }
__host__ __device__ __forceinline__ void stage_rc(int b, int& R, int& C) { const int st = b / 1024, sb = b % 1024, swz = sb ^ (((sb >> 9) & 1) << 5); R = (st >> 1) * 16 + swz / 64; C = (st & 1) * 32 + (swz % 64) / 2; }
__host__ __device__ __forceinline__ int perm32(int rho) { const int n = rho >> 4, i = rho & 15; return 8 * (i >> 2) + 4 * n + (i & 3); }

struct Unit { int pm, pn; };
struct Gemm { const bf16_t* A; const bf16_t* Bt; int M, N, K, lda, ldb; int hrA = 128, trA = 256, hrB = 128, trB = 256, gatherA = 0; };

struct StaticOrder {
    int nM, nN, nwg, G, c;
    __host__ __device__ void init(int M, int N, int G_, int c_) { nM = M / BM; nN = N / BM; nwg = nM * nN; G = G_; c = c_; }
    __host__ __device__ bool next(int i, Unit& u) const {
        const long L = (long)i * G + c; if (L >= nwg) return false;
        int wgid = (int)L; { const int q = nwg / NXCD, r = nwg % NXCD, xcd = wgid % NXCD, off = wgid / NXCD; wgid = (xcd < r ? xcd * (q + 1) : r * (q + 1) + (xcd - r) * q) + off; }
        const int nig = WGM * nN, gid = wgid / nig, fm = gid * WGM, gsz = (nM - fm) < WGM ? (nM - fm) : WGM;
        u.pm = fm + ((wgid % nig) % gsz); u.pn = (wgid % nig) / gsz; return true;
    }
    __device__ __forceinline__ void a_ready(const Unit&) const {}
    __device__ __forceinline__ void done(const Unit&) const {}
};


__device__ __forceinline__ unsigned cvt_pk_bf16(float lo, float hi) { unsigned r; asm volatile("v_cvt_pk_bf16_f32 %0, %1, %2" : "=v"(r) : "v"(lo), "v"(hi)); return r; }
struct EpiBf16S {
    static constexpr bool PERM = true, AFTER_DRAIN = false;
    bf16_t* O; const float* rowscale; int ldc; int rs_stride;
    __device__ __forceinline__ void operator()(const f32x4 (&acc)[2][2][4][2], const Unit& u, int wr, int wc, int fr, int fq) const {
        const int row0 = u.pm * BM + wr * 64 + fr, col0 = u.pn * BM + wc * 32 + 8 * fq;
#pragma unroll
        for (int ai = 0; ai < 2; ++ai)
#pragma unroll
            for (int m = 0; m < 4; ++m) { const int row = row0 + ai * HALF + m * 16; const float sc = rowscale ? rowscale[(size_t)row * rs_stride] : 1.f;
                bf16_t* rowp = O + (size_t)row * ldc + col0;
#pragma unroll
                for (int bj = 0; bj < 2; ++bj) { const f32x4 v0 = acc[ai][bj][m][0] * sc, v1 = acc[ai][bj][m][1] * sc;
                    u32x4 w; w.x = cvt_pk_bf16(v0[0], v0[1]); w.y = cvt_pk_bf16(v0[2], v0[3]); w.z = cvt_pk_bf16(v1[0], v1[1]); w.w = cvt_pk_bf16(v1[2], v1[3]);
                    *(u32x4*)(rowp + bj * HALF) = w; } }
    }
};
struct EpiResid {
    static constexpr bool PERM = false, AFTER_DRAIN = false;
    const float* hin; float* hout; float alpha; int pad;
    __device__ __forceinline__ void operator()(const f32x4 (&acc)[2][2][4][2], const Unit& u, int wr, int wc, int fr, int fq) const {
        const int row0 = u.pm * BM + wr * 64 + fr, col0 = u.pn * BM + wc * 32 + 4 * fq;
#pragma unroll
        for (int ai = 0; ai < 2; ++ai)
#pragma unroll
            for (int m = 0; m < 4; ++m) { const size_t off = (size_t)(row0 + ai * HALF + m * 16) * 1024 + col0;
#pragma unroll
                for (int bj = 0; bj < 2; ++bj)
#pragma unroll
                    for (int n = 0; n < 2; ++n) { const size_t i = off + bj * HALF + n * 16; const f32x4 h = *(const f32x4*)(hin + i); *(f32x4*)(hout + i) = h * alpha + acc[ai][bj][m][n]; } }
    }
};

struct EpiResidLN {
    static constexpr bool PERM = false, AFTER_DRAIN = false;
    float* hio; const float* stats; const float* g; const float* b; float alpha; int pad;
    __device__ __forceinline__ void operator()(const f32x4 (&acc)[2][2][4][2], const Unit& u, int wr, int wc, int fr, int fq) const {
        const int row0 = u.pm * BM + wr * 64 + fr, col0 = u.pn * BM + wc * 32 + 4 * fq;
        f32x4 gg[2][2], bb[2][2];
#pragma unroll
        for (int bj = 0; bj < 2; ++bj)
#pragma unroll
            for (int n = 0; n < 2; ++n) { gg[bj][n] = *(const f32x4*)(g + col0 + bj * HALF + n * 16) * alpha; bb[bj][n] = *(const f32x4*)(b + col0 + bj * HALF + n * 16) * alpha; }
#pragma unroll
        for (int ai = 0; ai < 2; ++ai)
#pragma unroll
            for (int m = 0; m < 4; ++m) { const int row = row0 + ai * HALF + m * 16; const size_t off = (size_t)row * 1024 + col0;
                const float mu = stats[2 * row], rs = stats[2 * row + 1];
#pragma unroll
                for (int bj = 0; bj < 2; ++bj)
#pragma unroll
                    for (int n = 0; n < 2; ++n) { const size_t i = off + bj * HALF + n * 16; const f32x4 p = *(const f32x4*)(hio + i); *(f32x4*)(hio + i) = (p - mu) * rs * gg[bj][n] + bb[bj][n] + acc[ai][bj][m][n]; } }
    }
};

template <int CTRL> __device__ __forceinline__ float pg_dpp(float x) { return __builtin_bit_cast(float, __builtin_amdgcn_update_dpp(0, __builtin_bit_cast(int, x), CTRL, 0xF, 0xF, true)); }
struct EpiConvAct {
    static constexpr bool PERM = true, AFTER_DRAIN = false;
    bf16_t* act; const bf16_t* halo; const float* cw; const float* cb; int dff; int seq;
    __device__ __forceinline__ void operator()(const f32x4 (&acc)[2][2][4][2], const Unit& u, int wr, int wc, int fr, int fq) const {
        typedef unsigned u32x2e __attribute__((ext_vector_type(2)));
#pragma unroll
        for (int n = 0; n < 2; ++n) {
            const int ch0 = u.pn * 128 + wc * 32 + 8 * fq + 4 * n;
            const f32x4 w0 = *(const f32x4*)(cw + ch0), w1 = *(const f32x4*)(cw + dff + ch0), w2 = *(const f32x4*)(cw + 2 * dff + ch0), bb = *(const f32x4*)(cb + ch0);
#pragma unroll
            for (int ai = 0; ai < 2; ++ai) {
                const int rb64 = u.pm * BM + ai * HALF + wr * 64;
                f32x4 P = {0.f, 0.f, 0.f, 0.f};
                if ((rb64 & (seq - 1)) != 0 && fr >= 14) { const u32x2e hv = *(const u32x2e*)(halo + (size_t)(2 * (rb64 / 64 - 1) + (fr - 14)) * dff + ch0);
                    P[0] = __builtin_bit_cast(float, hv.x << 16); P[1] = __builtin_bit_cast(float, hv.x & 0xffff0000u); P[2] = __builtin_bit_cast(float, hv.y << 16); P[3] = __builtin_bit_cast(float, hv.y & 0xffff0000u); }
#pragma unroll
                for (int m = 0; m < 4; ++m) {
                    const f32x4 Gv = acc[ai][0][m][n], Uv = acc[ai][1][m][n];
                    float o[4];
#pragma unroll
                    for (int e = 0; e < 4; ++e) {
                        const float t1 = pg_dpp<0x111>(Gv[e]), t2 = pg_dpp<0x112>(Gv[e]), p1 = pg_dpp<0x10F>(P[e]), p2 = pg_dpp<0x10E>(P[e]);
                        const float g1 = (fr >= 1) ? t1 : p1, g2 = (fr >= 2) ? t2 : p2;
                        const float y = bb[e] + w0[e] * g2 + w1[e] * g1 + w2[e] * Gv[e];
                        o[e] = y / (1.f + __expf(-y)) * Uv[e];
                    }
                    u32x2e w; w.x = cvt_pk_bf16(o[0], o[1]); w.y = cvt_pk_bf16(o[2], o[3]);
                    *(u32x2e*)(act + (size_t)(rb64 + m * 16 + fr) * dff + ch0) = w;
                    P = Gv;
                }
            }
        }
    }
};

template <class Epi, class Sched, bool ALIGN_EPI = false, bool SP2 = false>
__device__ __forceinline__ void gemm_phase(PG8_LAS unsigned char* lds, const Gemm g, const Sched& S, const Epi& E) {
    int tid = threadIdx.x; asm volatile("" : "+v"(tid));
    const int wid = __builtin_amdgcn_readfirstlane(tid >> 6), lane = tid & 63, wr = wid >> 2, wc = wid & 3, fr = lane & 15, fq = lane >> 4;
    const int K = g.K, nt = K / BK;
    unsigned voffA[2], voffB[2];
#pragma unroll
    for (int i = 0; i < 2; ++i) { int R, C; stage_rc(tid * 16 + i * 8192, R, C); const int Rb = Epi::PERM ? ((R & ~31) + perm32(R & 31)) : R;
        const int Ra = g.gatherA ? (64 * (R >> 1) + 62 + (R & 1)) : R;
        voffA[i] = (unsigned)(Ra * g.lda + C) * 2u; voffB[i] = (unsigned)(Rb * g.ldb + C) * 2u; }
    const size_t kstep = (size_t)(BK * 2);
    const size_t hstepA = (size_t)g.hrA * g.lda * 2, hstepB = (size_t)g.hrB * g.ldb * 2;
    const size_t tstepA = (size_t)g.trA * g.lda * 2, tstepB = (size_t)g.trB * g.ldb * 2;
    const unsigned ldsw = (unsigned)wid * 1024u;
    const int aoff = lds_byte(wr * 64 + fr, fq * 8), boff = lds_byte(wc * 32 + fr, fq * 8);
#define PG8_SA(b, h) (((b) * 2 + (h)) * HTB)
#define PG8_SB(b, h) ((4 + (b) * 2 + (h)) * HTB)
#define PG8_STAGE(bufoff, gbase, voff) do { _Pragma("unroll") for (int _i = 0; _i < 2; ++_i) \
        __builtin_amdgcn_global_load_lds((const unsigned*)((const char*)(gbase) + (voff)[_i]), (PG8_LAS unsigned*)(lds + (bufoff) + ldsw + _i * 8192), 16, 0, 0); } while (0)
#define PG8_LDA(dst, b, h) do { _Pragma("unroll") for (int m = 0; m < 4; ++m) _Pragma("unroll") for (int k = 0; k < 2; ++k) dst[m][k] = *(const PG8_LAS bf16x8*)(lds + PG8_SA(b, h) + aoff + m * 2048 + k * 1024); } while (0)
#define PG8_LDB(dst, b, h) do { _Pragma("unroll") for (int n = 0; n < 2; ++n) _Pragma("unroll") for (int k = 0; k < 2; ++k) dst[n][k] = *(const PG8_LAS bf16x8*)(lds + PG8_SB(b, h) + boff + n * 2048 + k * 1024); } while (0)
#define PG8_MMA(ai, bj, At, Bt) do { __builtin_amdgcn_s_setprio(1); _Pragma("unroll") for (int m = 0; m < 4; ++m) _Pragma("unroll") for (int n = 0; n < 2; ++n) _Pragma("unroll") for (int k = 0; k < 2; ++k) \
        acc[ai][bj][m][n] = __builtin_amdgcn_mfma_f32_16x16x32_bf16(Bt[n][k], At[m][k], acc[ai][bj][m][n], 0, 0, 0); __builtin_amdgcn_s_setprio(0); } while (0)
#define PG8_WAIT_V(n) asm volatile("s_waitcnt vmcnt(" #n ")" ::: "memory")
#define PG8_WAIT_L(n) asm volatile("s_waitcnt lgkmcnt(" #n ")" ::: "memory")
#define PG8_BAR __builtin_amdgcn_s_barrier()
#define PG8_SCHED __builtin_amdgcn_sched_barrier(0)
    Unit cur, nxt; int ui = 0;
    if (!S.next(0, cur)) return;
    f32x4 acc[2][2][4][2];
#pragma unroll
    for (int a = 0; a < 2; ++a)
#pragma unroll
        for (int b = 0; b < 2; ++b)
#pragma unroll
            for (int m = 0; m < 4; ++m)
#pragma unroll
                for (int n = 0; n < 2; ++n) acc[a][b][m][n] = (f32x4){0.f, 0.f, 0.f, 0.f};
    bf16x8 At[4][2], B0[2][2], B1[2][2];
    const char* cA = (const char*)g.A + (size_t)cur.pm * tstepA; const char* cB = (const char*)g.Bt + (size_t)cur.pn * tstepB;
    S.a_ready(cur);
    if constexpr (SP2) {
        PG8_STAGE(PG8_SB(0, 0), cB, voffB); PG8_STAGE(PG8_SB(0, 1), cB + hstepB, voffB); PG8_STAGE(PG8_SA(0, 0), cA, voffA); PG8_STAGE(PG8_SA(0, 1), cA + hstepA, voffA);
        if (wr == 1) PG8_BAR;
        PG8_WAIT_V(2); PG8_BAR;
        PG8_STAGE(PG8_SB(1, 0), cB + kstep, voffB); PG8_STAGE(PG8_SA(1, 0), cA + kstep, voffA); PG8_STAGE(PG8_SB(1, 1), cB + hstepB + kstep, voffB);
        PG8_WAIT_V(6); PG8_BAR;
    } else {
        PG8_STAGE(PG8_SB(0, 0), cB, voffB); PG8_STAGE(PG8_SA(0, 0), cA, voffA); PG8_STAGE(PG8_SB(0, 1), cB + hstepB, voffB); PG8_STAGE(PG8_SA(0, 1), cA + hstepA, voffA);
        if (wr == 1) PG8_BAR;
        PG8_WAIT_V(4); PG8_BAR;
        PG8_STAGE(PG8_SB(1, 0), cB + kstep, voffB); PG8_STAGE(PG8_SA(1, 0), cA + kstep, voffA); PG8_STAGE(PG8_SB(1, 1), cB + hstepB + kstep, voffB);
        PG8_WAIT_V(6); PG8_BAR;
    }
    for (;;) {
        const bool has_next = S.next(ui + 1, nxt);
        const char* nA = has_next ? (const char*)g.A + (size_t)nxt.pm * tstepA : cA; const char* nB = has_next ? (const char*)g.Bt + (size_t)nxt.pn * tstepB : cB;
        for (int t = 0; t < nt; t += 2) {
            const bool last = (t == nt - 2);
            const char* a1 = cA + (size_t)(t + 1) * kstep;
            const char* a2 = last ? nA : cA + (size_t)(t + 2) * kstep; const char* b2 = last ? nB : cB + (size_t)(t + 2) * kstep;
            const char* a3 = a2 + kstep; const char* b3 = b2 + kstep;
            if (last && has_next) S.a_ready(nxt);
            if constexpr (SP2) {
            PG8_LDB(B0, 0, 0); PG8_LDB(B1, 0, 1); PG8_SCHED; PG8_LDA(At, 0, 0); PG8_STAGE(PG8_SA(1, 1), a1 + hstepA, voffA);
            PG8_WAIT_V(8); PG8_WAIT_L(0); PG8_BAR; PG8_MMA(0, 0, At, B0); PG8_MMA(0, 1, At, B1); PG8_BAR; PG8_SCHED;
            PG8_LDA(At, 0, 1); PG8_STAGE(PG8_SB(0, 0), b2, voffB); PG8_STAGE(PG8_SB(0, 1), b2 + hstepB, voffB); PG8_STAGE(PG8_SA(0, 0), a2, voffA);
            PG8_WAIT_V(8); PG8_WAIT_L(0); PG8_BAR; PG8_MMA(1, 0, At, B0); PG8_MMA(1, 1, At, B1); PG8_BAR; PG8_SCHED;
            PG8_LDB(B0, 1, 0); PG8_LDB(B1, 1, 1); PG8_SCHED; PG8_LDA(At, 1, 0); PG8_STAGE(PG8_SA(0, 1), a2 + hstepA, voffA);
            PG8_WAIT_V(8); PG8_WAIT_L(0); PG8_BAR; PG8_MMA(0, 0, At, B0); PG8_MMA(0, 1, At, B1); PG8_BAR; PG8_SCHED;
            PG8_LDA(At, 1, 1); PG8_STAGE(PG8_SB(1, 0), b3, voffB); PG8_STAGE(PG8_SB(1, 1), b3 + hstepB, voffB); PG8_STAGE(PG8_SA(1, 0), a3, voffA);
            PG8_WAIT_V(8); PG8_WAIT_L(0); PG8_BAR; PG8_MMA(1, 0, At, B0); PG8_MMA(1, 1, At, B1); PG8_BAR; PG8_SCHED;
            } else {
            PG8_LDB(B0, 0, 0); PG8_SCHED; PG8_LDA(At, 0, 0); PG8_STAGE(PG8_SA(1, 1), a1 + hstepA, voffA);
            PG8_WAIT_L(8); PG8_BAR; PG8_WAIT_L(0); PG8_MMA(0, 0, At, B0); PG8_BAR; PG8_SCHED;
            PG8_LDB(B1, 0, 1); PG8_STAGE(PG8_SB(0, 0), b2, voffB);
            PG8_BAR; PG8_WAIT_L(0); PG8_MMA(0, 1, At, B1); PG8_BAR;
            PG8_LDA(At, 0, 1); PG8_STAGE(PG8_SA(0, 0), a2, voffA);
            PG8_BAR; PG8_WAIT_L(0); PG8_MMA(1, 0, At, B0); PG8_BAR; PG8_SCHED;
            PG8_STAGE(PG8_SB(0, 1), b2 + hstepB, voffB);
            PG8_WAIT_V(6); PG8_BAR; PG8_MMA(1, 1, At, B1); PG8_BAR;
            PG8_LDB(B0, 1, 0); PG8_SCHED; PG8_LDA(At, 1, 0); PG8_STAGE(PG8_SA(0, 1), a2 + hstepA, voffA);
            PG8_WAIT_L(8); PG8_BAR; PG8_WAIT_L(0); PG8_MMA(0, 0, At, B0); PG8_BAR; PG8_SCHED;
            PG8_LDB(B1, 1, 1); PG8_STAGE(PG8_SB(1, 0), b3, voffB);
            PG8_BAR; PG8_WAIT_L(0); PG8_MMA(0, 1, At, B1); PG8_BAR;
            PG8_LDA(At, 1, 1); PG8_STAGE(PG8_SA(1, 0), a3, voffA);
            PG8_BAR; PG8_WAIT_L(0); PG8_MMA(1, 0, At, B0); PG8_BAR; PG8_SCHED;
            PG8_STAGE(PG8_SB(1, 1), b3 + hstepB, voffB);
            PG8_WAIT_V(6); PG8_BAR; PG8_MMA(1, 1, At, B1); PG8_BAR;
            }
        }
        if constexpr (ALIGN_EPI) { if (wr == 0) PG8_BAR; }
        if constexpr (!Epi::AFTER_DRAIN) { E(acc, cur, wr, wc, fr, fq); S.done(cur); }
        if (!has_next) break;
#pragma unroll
        for (int a = 0; a < 2; ++a)
#pragma unroll
            for (int b = 0; b < 2; ++b)
#pragma unroll
                for (int m = 0; m < 4; ++m)
#pragma unroll
                    for (int n = 0; n < 2; ++n) acc[a][b][m][n] = (f32x4){0.f, 0.f, 0.f, 0.f};
        cur = nxt; cA = nA; cB = nB; ++ui;
        if constexpr (ALIGN_EPI) { if (wr == 1) PG8_BAR; }
    }
    PG8_WAIT_V(0);
    if constexpr (!ALIGN_EPI) { if (wr == 0) PG8_BAR; }
    PG8_BAR;
    if constexpr (Epi::AFTER_DRAIN) { E.fused(acc, cur, wr, wc, fr, fq, lds, wid, lane); S.done(cur); }
#undef PG8_SA
#undef PG8_SB
#undef PG8_STAGE
#undef PG8_LDA
#undef PG8_LDB
#undef PG8_MMA
#undef PG8_WAIT_V
#undef PG8_WAIT_L
#undef PG8_BAR
#undef PG8_SCHED
}
}
#define GAS __attribute__((address_space(1)))
#define LAS __attribute__((address_space(3)))
typedef unsigned short bf16;
typedef unsigned v4u __attribute__((ext_vector_type(4)));
typedef float f32x4 __attribute__((ext_vector_type(4)));
typedef short bf16x8 __attribute__((ext_vector_type(8)));
typedef GAS unsigned gu32;
typedef GAS unsigned long long gu64;
#define RLX_AGENT __ATOMIC_RELAXED, __HIP_MEMORY_SCOPE_AGENT
#define LDS_WAIT() asm volatile("s_waitcnt lgkmcnt(0)" ::: "memory")
#define VM_WAIT() asm volatile("s_waitcnt vmcnt(0)" ::: "memory")
__device__ __forceinline__ unsigned long long rt() { return __builtin_amdgcn_s_memrealtime(); }
__device__ __forceinline__ unsigned f2bf(float f) { unsigned u = __builtin_bit_cast(unsigned, f); return (u + 0x7fffu + ((u >> 16) & 1u)) >> 16; }
__device__ __forceinline__ unsigned pk2(float lo, float hi) { return f2bf(lo) | (f2bf(hi) << 16); }

#define XB_TMO      128
#define XB_XCNT(j)  (256  + 64 * (j))
#define XB_XSUB(j)  (1280 + 64 * (j))
#define XB_XGEN(j)  (2304 + 64 * (j))
#define XB_TOP      3328
#define XB_TOPGEN   3392
#define XCD_BAR_WORDS 3456
#define XB_SPIN_CAP (1u << 18)

__device__ __forceinline__ unsigned xb_ld(unsigned* p)              { return __hip_atomic_load(p, __ATOMIC_RELAXED, __HIP_MEMORY_SCOPE_AGENT); }
__device__ __forceinline__ unsigned xb_add(unsigned* p, unsigned v) { return __hip_atomic_fetch_add(p, v, __ATOMIC_RELAXED, __HIP_MEMORY_SCOPE_AGENT); }
__device__ __forceinline__ unsigned xb_xcc_id() { return (unsigned)__builtin_amdgcn_s_getreg((3 << 11) | 20) & 0xFu; }
#define XB_SPIN(cond, bar) do { unsigned _sp = 0; while (cond) { __builtin_amdgcn_s_sleep(1); \
    if ((++_sp & 255u) == 0u) { if (xb_ld(&(bar)[XB_TMO])) break; if (_sp > XB_SPIN_CAP) { atomicAdd(&(bar)[XB_TMO], 1u); break; } } } } while (0)

struct XcdBarrier {
    unsigned* bar; unsigned x;
    volatile LAS unsigned* st;
};

__device__ __forceinline__ XcdBarrier xcd_barrier_post(unsigned* bar, volatile LAS unsigned* st) {
    XcdBarrier b; b.bar = bar; b.x = xb_xcc_id(); b.st = st;
    if (threadIdx.x == 0) (void)xb_add(&bar[XB_XCNT(b.x)], 1u);
    return b;
}
__device__ __forceinline__ void xcd_barrier_complete(unsigned* bar, unsigned x, unsigned& nloc, unsigned& nx) {
    const unsigned G = gridDim.x * gridDim.y * gridDim.z;
    unsigned sum, cnt, mine, sp = 0u;
    for (;;) {
        sum = 0u; cnt = 0u; mine = 0u;
#pragma unroll
        for (unsigned j = 0; j < 16; ++j) { const unsigned c = xb_ld(&bar[XB_XCNT(j)]); sum += c; cnt += (c > 0u) ? 1u : 0u; mine = (j == x) ? c : mine; }
        if (sum == G) break;
        __builtin_amdgcn_s_sleep(1);
        if ((++sp & 255u) == 0u) { if (xb_ld(&bar[XB_TMO])) break; if (sp > XB_SPIN_CAP) { atomicAdd(&bar[XB_TMO], 1u); break; } }
    }
    nloc = mine > 0u ? mine : 1u; nx = cnt > 0u ? cnt : 1u;
}

__device__ __forceinline__ void xcd_barrier(const XcdBarrier& b) {
    asm volatile("s_waitcnt vmcnt(0)" ::: "memory");
    __syncthreads();
    if (threadIdx.x == 0) {
        unsigned* bar = b.bar;
        __builtin_amdgcn_s_waitcnt(0);
        unsigned nloc = b.st[0], nx = b.st[1];
        if (nloc == 0u) { xcd_barrier_complete(bar, b.x, nloc, nx); b.st[0] = nloc; b.st[1] = nx; }
        const unsigned old = xb_add(&bar[XB_XSUB(b.x)], 1u);
        const unsigned gen = old / nloc;
        if (old + 1u == (gen + 1u) * nloc) {
            __builtin_amdgcn_fence(__ATOMIC_RELEASE, "agent");
            asm volatile("s_waitcnt vmcnt(0)" ::: "memory");
            const unsigned og = xb_add(&bar[XB_TOP], 1u);
            const unsigned tg = og / nx;
            if (og + 1u == (tg + 1u) * nx) xb_add(&bar[XB_TOPGEN], 1u);
            else XB_SPIN(xb_ld(&bar[XB_TOPGEN]) == tg, bar);
            __builtin_amdgcn_fence(__ATOMIC_ACQUIRE, "agent");
            xb_add(&bar[XB_XGEN(b.x)], 1u);
            asm volatile("s_waitcnt vmcnt(0)" ::: "memory");
        } else {
            XB_SPIN(xb_ld(&bar[XB_XGEN(b.x)]) == gen, bar);
            __builtin_amdgcn_fence(__ATOMIC_ACQUIRE, "agent");
            asm volatile("s_waitcnt vmcnt(0)" ::: "memory");
        }
    }
    __syncthreads();
}
constexpr int NWAVES = 8;
constexpr int BATCH = 16, SEQ = 2048, DM = 1024, M = BATCH * SEQ;
constexpr int L0P = 3584;
constexpr int L1P = 2048;
constexpr int DFF = 2816;
constexpr float ALPHA = 1.4142135623730951f;
typedef unsigned short bf16_t;
typedef float f32x16 __attribute__((ext_vector_type(16)));

constexpr size_t MiB = 1u << 20;
constexpr size_t WS_CTL = 0, CTL_ZERO_BYTES = 1 * MiB;
constexpr int CW_BAR = 4096;
constexpr size_t WS_W0IN = 2 * MiB, WS_W0OUT = 9 * MiB, WS_WUP0 = 11 * MiB, WS_WDN0 = 22 * MiB, WS_W1IN = 28 * MiB, WS_WUQ = 32 * MiB, WS_WUKV = 33 * MiB,
                 WS_W1OUT = 34 * MiB, WS_WUP1 = 36 * MiB, WS_WDN1 = 47 * MiB;
constexpr size_t WS_XB = 56 * MiB, WS_YMIX = 120 * MiB, WS_BIG = 184 * MiB;
constexpr size_t WS_G = 408 * MiB, WS_BONUS = 440 * MiB, WS_DT = 441 * MiB, WS_XST = 442 * MiB, WS_BT = 474 * MiB, WS_ASUM = 490 * MiB;
constexpr size_t WS_SLOC = 120 * MiB;
constexpr size_t WS_W2T = 53 * MiB, WS_A2T = 53 * MiB + 256 * 1024, WS_G2T = 53 * MiB + 512 * 1024;
constexpr size_t WS_GU = 120 * MiB;
constexpr size_t WS_PROJ1 = 184 * MiB, WS_QM = 312 * MiB, WS_KVM = 360 * MiB, WS_KPE = 424 * MiB, WS_RS = 426 * MiB;
constexpr size_t WS_CSTAB = 492 * MiB;
constexpr size_t WS_VTS = 428 * MiB, WS_VTM = 460 * MiB;
constexpr size_t WS_NEED = 497 * MiB;

constexpr int RING_BYTES = 131072;
constexpr int LDSCTL_OFF = 146432, MISC_OFF = LDSCTL_OFF + 320;
constexpr int LDS_BYTES = 147456;

__device__ __forceinline__ float bf2f(bf16_t b) { return __builtin_bit_cast(float, (unsigned)b << 16); }
__device__ __forceinline__ float sigmoidf_(float x) { return 1.f / (1.f + expf(-x)); }
__device__ __forceinline__ float softplusf_(float x) { return fmaxf(x, 0.f) + log1pf(expf(-fabsf(x))); }
__device__ __forceinline__ float siluf_(float x) { return x / (1.f + expf(-x)); }
__device__ __forceinline__ float wave_sum(float v) {
#pragma unroll
    for (int o = 1; o < 64; o <<= 1) v += __shfl_xor(v, o);
    return v;
}
#define WSYNC() asm volatile("s_waitcnt lgkmcnt(0)" ::: "memory")
typedef float f32x2_t __attribute__((ext_vector_type(2)));
typedef __bf16 bf16x2_t __attribute__((ext_vector_type(2)));
typedef unsigned u32x2 __attribute__((ext_vector_type(2)));
__device__ __forceinline__ unsigned cvtpk(float lo, float hi) { f32x2_t v = {lo, hi}; bf16x2_t b = __builtin_convertvector(v, bf16x2_t); return __builtin_bit_cast(unsigned, b); }
__device__ __forceinline__ float bflo(unsigned u) { return __builtin_bit_cast(float, u << 16); }
__device__ __forceinline__ float bfhi(unsigned u) { return __builtin_bit_cast(float, u & 0xffff0000u); }
__device__ __forceinline__ bf16_t bf1(float x) { return (bf16_t)(cvtpk(x, x) & 0xffffu); }
__device__ __forceinline__ bf16x8 pack8(float a0, float a1, float a2, float a3, float a4, float a5, float a6, float a7) {
    v4u w; w.x = cvtpk(a0, a1); w.y = cvtpk(a2, a3); w.z = cvtpk(a4, a5); w.w = cvtpk(a6, a7); return __builtin_bit_cast(bf16x8, w); }
template <int CTRL> __device__ __forceinline__ float dpp_mov(float x) { return __builtin_bit_cast(float, __builtin_amdgcn_update_dpp(0, __builtin_bit_cast(int, x), CTRL, 0xF, 0xF, true)); }
__device__ __forceinline__ float rowsum16(float x) { x += dpp_mov<0x128>(x); x += dpp_mov<0x124>(x); x += dpp_mov<0x122>(x); x += dpp_mov<0x121>(x); return x; }
__device__ __forceinline__ float rl(float x, int l) { return __builtin_bit_cast(float, __builtin_amdgcn_readlane(__builtin_bit_cast(int, x), l)); }
__device__ __forceinline__ float wave_sum_dpp(float x) { x = rowsum16(x); return (rl(x, 0) + rl(x, 16)) + (rl(x, 32) + rl(x, 48)); }

__device__ __forceinline__ void transpose_matrix(const float* __restrict__ W, int K, int N, bf16_t* __restrict__ WT, int Npad, int ldt, LAS float* scr, int gw, int NGW, int lane, const float* __restrict__ kscale, bool ffn_interleave = false) {
    (void)scr;
    const int nblk = Npad / 64, nit = (K / 64) * nblk;
    for (int it = gw; it < nit; it += NGW) {
        const int kb = it / nblk, nb = it - kb * nblk, n = nb * 64 + lane, k0 = kb * 64;
        const bool ok = n < N; const float* src = W + (size_t)k0 * N + (ok ? n : 0);
#pragma unroll
        for (int hc = 0; hc < 2; ++hc) {
            float v[32];
#pragma unroll
            for (int i = 0; i < 32; ++i) v[i] = src[(size_t)(hc * 32 + i) * N];
#pragma unroll
            for (int c = 0; c < 4; ++c) { float u[8];
#pragma unroll
                for (int i = 0; i < 8; ++i) { u[i] = ok ? v[c * 8 + i] : 0.f; if (kscale) u[i] *= kscale[k0 + hc * 32 + c * 8 + i]; }
                v4u o; o.x = cvtpk(u[0], u[1]); o.y = cvtpk(u[2], u[3]); o.z = cvtpk(u[4], u[5]); o.w = cvtpk(u[6], u[7]);
                const int nr = ffn_interleave ? ((n < DFF) ? 256 * (n >> 7) + (n & 127) : 256 * ((n - DFF) >> 7) + 128 + ((n - DFF) & 127)) : n;
                *(v4u*)(WT + (size_t)nr * ldt + k0 + hc * 32 + c * 8) = o; }
        }
    }
}

template <int MODE> __device__ __forceinline__ void ln_rows(float* h, bf16_t* hb, float* stats, const float* __restrict__ g, const float* __restrict__ b, int gw, int NGW, int lane) {
    for (int row = gw * 2; row < M; row += NGW * 2) {
        float* p = h + (size_t)row * DM;
        f32x4 v[2][4]; float s[2] = {0.f, 0.f};
#pragma unroll
        for (int r = 0; r < 2; ++r)
#pragma unroll
            for (int j = 0; j < 4; ++j) v[r][j] = *(const f32x4*)(p + r * DM + 4 * lane + 256 * j);
#pragma unroll
        for (int r = 0; r < 2; ++r)
#pragma unroll
            for (int j = 0; j < 4; ++j) s[r] += (v[r][j][0] + v[r][j][1]) + (v[r][j][2] + v[r][j][3]);
        float mean[2], q[2] = {0.f, 0.f}, rstd[2];
#pragma unroll
        for (int r = 0; r < 2; ++r) { mean[r] = wave_sum_dpp(s[r]) * (1.f / DM);
#pragma unroll
            for (int j = 0; j < 4; ++j) { v[r][j] = v[r][j] - mean[r]; q[r] += (v[r][j][0] * v[r][j][0] + v[r][j][1] * v[r][j][1]) + (v[r][j][2] * v[r][j][2] + v[r][j][3] * v[r][j][3]); } }
#pragma unroll
        for (int r = 0; r < 2; ++r) rstd[r] = 1.0f / sqrtf(wave_sum_dpp(q[r]) * (1.f / DM) + 1e-5f);
        if (MODE == 1 && lane < 2) { stats[2 * (row + lane)] = lane ? mean[1] : mean[0]; stats[2 * (row + lane) + 1] = lane ? rstd[1] : rstd[0]; }
#pragma unroll
        for (int j = 0; j < 4; ++j) {
            const int c = 4 * lane + 256 * j;
            const f32x4 gg = *(const f32x4*)(g + c), bb = *(const f32x4*)(b + c);
#pragma unroll
            for (int r = 0; r < 2; ++r) {
                const f32x4 o = v[r][j] * rstd[r] * gg + bb;
                if (MODE == 1) { uint2 w; w.x = cvtpk(o[0], o[1]); w.y = cvtpk(o[2], o[3]); *(uint2*)(hb + (size_t)(row + r) * DM + c) = w; }
                else *(f32x4*)(p + r * DM + c) = o;
            }
        }
    }
}

__device__ __forceinline__ void rwkv_naive_chain(int chain, int lane, LAS float* sm, const bf16_t* __restrict__ proj, const float* __restrict__ mix, const float* __restrict__ w0, const float* __restrict__ w2,
                                                 const float* __restrict__ a0, const float* __restrict__ a2, const float* __restrict__ g2, const float* __restrict__ k_k,
                                                 const float* __restrict__ k_a, const float* __restrict__ r_k, const float* __restrict__ ln_g, const float* __restrict__ ln_b, bf16_t* __restrict__ ymix) {
    LAS float* s_w2 = sm; LAS float* s_a2 = sm + 4096; LAS float* s_g2 = sm + 8192; LAS float* s_tw = sm + 16384; LAS float* s_al = s_tw + 64; LAS float* s_sg = s_tw + 128;
    LAS float* s_w = s_tw + 256; LAS float* s_k = s_tw + 320; LAS float* s_a = s_tw + 384; LAS float* s_b = s_tw + 448; LAS float* s_r = s_tw + 512;
    const int b = chain >> 3, h = chain & 7, c = h * 64 + lane;
    for (int l = 0; l < 64; ++l) { s_w2[l * 64 + lane] = w2[l * 512 + c]; s_a2[l * 64 + lane] = a2[l * 512 + c]; }
    for (int l = 0; l < 128; ++l) s_g2[l * 64 + lane] = g2[l * 512 + c];
    const float mr = mix[c], mk = mix[512 + c], mv = mix[1024 + c], mw = mix[1536 + lane], ma = mix[1600 + lane], mg0 = mix[1664 + lane], mg1 = mix[1728 + lane];
    const float w0c = w0[c], a0c = a0[c], kkc = k_k[c], kac = k_a[c], rkc = r_k[c], lgc = ln_g[c], lbc = ln_b[c];
    float S[64];
#pragma unroll
    for (int j = 0; j < 64; ++j) S[j] = 0.f;
    float pr = 0.f, pk = 0.f, pv = 0.f, pw = 0.f, pa = 0.f, pg0 = 0.f, pg1 = 0.f;
    WSYNC();
    for (int t = 0; t < SEQ; ++t) {
        const bf16_t* row = proj + (size_t)(b * SEQ + t) * L0P;
        const float cr = bf2f(row[c]), ck = bf2f(row[512 + c]), cv = bf2f(row[1024 + c]), cw = bf2f(row[1536 + lane]), ca = bf2f(row[1600 + lane]),
                    cg0 = bf2f(row[1664 + lane]), cg1 = bf2f(row[1728 + lane]);
        const float r_s = cr + (pr - cr) * mr, k_s = ck + (pk - ck) * mk, v_s = cv + (pv - cv) * mv;
        const float wl = cw + (pw - cw) * mw, al = ca + (pa - ca) * ma, g0 = cg0 + (pg0 - cg0) * mg0, g1 = cg1 + (pg1 - cg1) * mg1;
        pr = cr; pk = ck; pv = cv; pw = cw; pa = ca; pg0 = cg0; pg1 = cg1;
        s_tw[lane] = tanhf(wl); s_al[lane] = al; s_sg[lane] = sigmoidf_(g0); s_sg[64 + lane] = sigmoidf_(g1);
        WSYNC();
        float wsum = w0c, asum = a0c, gsum = 0.f;
#pragma unroll 2
        for (int l = 0; l < 64; ++l) { wsum += s_tw[l] * s_w2[l * 64 + lane]; asum += s_al[l] * s_a2[l * 64 + lane]; }
#pragma unroll 2
        for (int l = 0; l < 128; ++l) gsum += s_sg[l] * s_g2[l * 64 + lane];
        const float log_w = -softplusf_(-wsum) - 0.5f;
        const float dec = expf(-expf(log_w));
        const float a = sigmoidf_(asum);
        float kkv = k_s * kkc;
        const float nrm = sqrtf(wave_sum(kkv * kkv));
        kkv = kkv / fmaxf(nrm, 1e-12f);
        const float k2 = k_s * (1.f + (a - 1.f) * kac);
        const float bonus_s = wave_sum(r_s * k2 * rkc);
        s_w[lane] = dec; s_k[lane] = k2; s_a[lane] = -kkv; s_b[lane] = kkv * a; s_r[lane] = r_s;
        WSYNC();
        float sa = 0.f;
#pragma unroll
        for (int j = 0; j < 64; ++j) sa += S[j] * s_a[j];
        float y = 0.f;
#pragma unroll
        for (int j = 0; j < 64; ++j) { S[j] = S[j] * s_w[j] + sa * s_b[j] + v_s * s_k[j]; y += S[j] * s_r[j]; }
        const float mu = wave_sum(y) * (1.f / 64.f);
        const float d = y - mu;
        const float var = wave_sum(d * d) * (1.f / 64.f);
        const float yn = d * (1.0f / sqrtf(var + 64e-5f)) * lgc + lbc;
        const float o = (yn + bonus_s * v_s) * gsum;
        ymix[(size_t)(b * SEQ + t) * DM + c] = (bf16_t)f2bf(o);
        WSYNC();
    }
}

__device__ __forceinline__ void ssm_conv_all(const bf16_t* __restrict__ proj, const float* __restrict__ cw, const float* __restrict__ cb, const float* __restrict__ dtb,
                                             bf16_t* __restrict__ xbc, float* __restrict__ dt, int gtid, int NT) {
    for (size_t i = gtid; i < (size_t)M * 1024; i += NT) {
        const int m = (int)(i >> 10), c = (int)(i & 1023), t = m & (SEQ - 1);
        float acc = cb[c];
#pragma unroll
        for (int k = 0; k < 4; ++k) { const int tt = t - 3 + k; if (tt >= 0) acc += cw[k * 1024 + c] * bf2f(proj[(size_t)(m - 3 + k) * L0P + 2304 + c]); }
        xbc[i] = (bf16_t)f2bf(siluf_(acc));
    }
    for (int i = gtid; i < M * 8; i += NT) dt[i] = softplusf_(bf2f(proj[(size_t)(i >> 3) * L0P + 3328 + (i & 7)]) + dtb[i & 7]);
}
__device__ __forceinline__ void ssd_naive_task(int task, int lane, const bf16_t* __restrict__ xbc, const float* __restrict__ dt, const float* __restrict__ a_log, const float* __restrict__ dsk, float* __restrict__ yssm) {
    const int chain = task >> 2, q = task & 3, b = chain >> 3, h = chain & 7, g = h >> 2, p = q * 16 + (lane >> 2), nq = lane & 3;
    const float A = -expf(a_log[h]), D = dsk[h];
    float st[32];
#pragma unroll
    for (int n = 0; n < 32; ++n) st[n] = 0.f;
    for (int t = 0; t < SEQ; ++t) {
        const size_t m = (size_t)b * SEQ + t;
        const float dtv = dt[m * 8 + h], dA = expf(dtv * A);
        const float x = bf2f(xbc[m * 1024 + h * 64 + p]), xdt = x * dtv;
        const bf16_t* Bp = xbc + m * 1024 + 512 + g * 128 + nq * 32;
        const bf16_t* Cp = xbc + m * 1024 + 768 + g * 128 + nq * 32;
        float yp = 0.f;
#pragma unroll
        for (int n = 0; n < 32; ++n) { st[n] = st[n] * dA + xdt * bf2f(Bp[n]); yp += st[n] * bf2f(Cp[n]); }
        yp += __shfl_xor(yp, 1); yp += __shfl_xor(yp, 2);
        if (nq == 0) yssm[m * 512 + h * 64 + p] = yp + D * x;
    }
}
template <bool ST = true> __device__ __forceinline__ void ssm_gate_norm_all(const bf16_t* __restrict__ yssm, const bf16_t* __restrict__ proj, const float* __restrict__ ng, bf16_t* __restrict__ ymix, int wv0, int wvend, int lane) {
    for (int wvb = wv0 * 4 - (wv0 & ~7) * 3; wvb < wvend; wvb += NWAVES * 4) {
        float u[4][4], q[4];
#pragma unroll
        for (int k = 0; k < 4; ++k) { const int wv = wvb + k, m = wv >> 1, g = wv & 1; q[k] = 0.f;
#pragma unroll
            for (int j = 0; j < 4; ++j) { const int c = g * 256 + j * 64 + lane; const float z = bf2f(proj[(size_t)m * L0P + 1792 + c]); u[k][j] = bf2f(yssm[(size_t)m * 512 + c]) * (z * __builtin_amdgcn_rcpf(1.f + __expf(-z))); q[k] += u[k][j] * u[k][j]; } }
#pragma unroll
        for (int k = 0; k < 4; ++k) { const int wv = wvb + k, m = wv >> 1, g = wv & 1;
            const float rs = __builtin_amdgcn_rsqf(wave_sum_dpp(q[k]) * (1.f / 256.f) + 1e-5f);
#pragma unroll
            for (int j = 0; j < 4; ++j) { const int c = g * 256 + j * 64 + lane; const float o_ = u[k][j] * rs * ng[c]; if (ST) ymix[(size_t)m * DM + 512 + c] = bf1(o_); else asm volatile("" :: "v"(o_)); } }
    }
}
template <bool ST = true> __device__ __forceinline__ void ffn_act_all(bf16_t* gu, const float* __restrict__ cw, const float* __restrict__ cb, int gtid, int NT) {
    constexpr int NCH = DFF / 8, NSTRIP = M / 32;
    for (int task = gtid; task < NSTRIP * NCH; task += NT) {
        const int strip = task / NCH, q = task - strip * NCH, c0 = q * 8, m0 = strip * 32;
        float w0[8], w1[8], w2[8], bb[8], g2[8], g1[8];
#pragma unroll
        for (int j = 0; j < 8; j += 4) { const f32x4 a = *(const f32x4*)(cw + c0 + j), b = *(const f32x4*)(cw + DFF + c0 + j), c = *(const f32x4*)(cw + 2 * DFF + c0 + j), d = *(const f32x4*)(cb + c0 + j);
#pragma unroll
            for (int k = 0; k < 4; ++k) { w0[j + k] = a[k]; w1[j + k] = b[k]; w2[j + k] = c[k]; bb[j + k] = d[k]; } }
        bf16_t* base = gu + (size_t)m0 * (2 * DFF) + c0;
        if ((m0 & (SEQ - 1)) != 0) { const v4u a = *(const v4u*)(base - 2 * (2 * DFF)), b = *(const v4u*)(base - (2 * DFF));
            g2[0] = bflo(a.x); g2[1] = bfhi(a.x); g2[2] = bflo(a.y); g2[3] = bfhi(a.y); g2[4] = bflo(a.z); g2[5] = bfhi(a.z); g2[6] = bflo(a.w); g2[7] = bfhi(a.w);
            g1[0] = bflo(b.x); g1[1] = bfhi(b.x); g1[2] = bflo(b.y); g1[3] = bfhi(b.y); g1[4] = bflo(b.z); g1[5] = bfhi(b.z); g1[6] = bflo(b.w); g1[7] = bfhi(b.w); }
        else {
#pragma unroll
            for (int j = 0; j < 8; ++j) { g2[j] = 0.f; g1[j] = 0.f; } }
#pragma unroll 4
        for (int r = 0; r < 32; ++r) {
            const v4u gv = *(const v4u*)(base + (size_t)r * (2 * DFF)), uv = *(const v4u*)(base + (size_t)r * (2 * DFF) + DFF);
            const unsigned gw_[4] = {gv.x, gv.y, gv.z, gv.w}, uw_[4] = {uv.x, uv.y, uv.z, uv.w};
            unsigned ow[4];
#pragma unroll
            for (int k = 0; k < 4; ++k) {
                const float ga = bflo(gw_[k]), gb = bfhi(gw_[k]);
                const float ya = bb[2 * k] + w0[2 * k] * g2[2 * k] + w1[2 * k] * g1[2 * k] + w2[2 * k] * ga;
                const float yb = bb[2 * k + 1] + w0[2 * k + 1] * g2[2 * k + 1] + w1[2 * k + 1] * g1[2 * k + 1] + w2[2 * k + 1] * gb;
                g2[2 * k] = g1[2 * k]; g1[2 * k] = ga; g2[2 * k + 1] = g1[2 * k + 1]; g1[2 * k + 1] = gb;
                ow[k] = cvtpk(ya / (1.f + __expf(-ya)) * bflo(uw_[k]), yb / (1.f + __expf(-yb)) * bfhi(uw_[k]));
            }
            if (ST) *(v4u*)(base + (size_t)r * (2 * DFF) + DFF) = (v4u){ow[0], ow[1], ow[2], ow[3]}; else asm volatile("" :: "v"(ow[0]), "v"(ow[1]), "v"(ow[2]), "v"(ow[3]));
        }
    }
}
template <bool ST = true> __device__ __forceinline__ void mla_prep_all(const bf16_t* __restrict__ proj1, const int* __restrict__ pos, float* __restrict__ rs, bf16_t* __restrict__ kpe, float* __restrict__ cstab, int gw, int NGW, int lane) {
    for (int m = gw; m < M; m += NGW) {
        const bf16_t* row = proj1 + (size_t)m * L1P;
        float q = 0.f;
#pragma unroll
        for (int j = 0; j < 4; ++j) { const float v = bf2f(row[1536 + j * 64 + lane]); q += v * v; }
        q = wave_sum(q);
        float k = 0.f;
#pragma unroll
        for (int j = 0; j < 2; ++j) { const float v = bf2f(row[1792 + j * 64 + lane]); k += v * v; }
        k = wave_sum(k);
        if (ST && lane == 0) { rs[(size_t)m * 2] = 1.0f / sqrtf(q * (1.f / 256.f) + 1e-6f); rs[(size_t)m * 2 + 1] = 1.0f / sqrtf(k * (1.f / 128.f) + 1e-6f); }
        if (lane < 16) {
            const double inv = pow(10000.0, -(double)(2 * lane) / 32.0);
            const double ang = (double)pos[m] * inv;
            const float cs = (float)cos(ang), sn = (float)sin(ang);
            if (ST) { cstab[(size_t)m * 32 + lane] = cs; cstab[(size_t)m * 32 + 16 + lane] = sn; }
            const float x1 = bf2f(row[1920 + lane]), x2 = bf2f(row[1936 + lane]);
            const bf16_t r1_ = (bf16_t)f2bf(x1 * cs - x2 * sn), r2_ = (bf16_t)f2bf(x2 * cs + x1 * sn);
            if (ST) { kpe[(size_t)m * 32 + lane] = r1_; kpe[(size_t)m * 32 + 16 + lane] = r2_; } else asm volatile("" :: "v"((unsigned)r1_), "v"((unsigned)r2_), "v"(q), "v"(k));
        }
    }
}
template <bool ST = true> __device__ __forceinline__ void rope_q_all(bf16_t* qm, const float* __restrict__ cstab, int gtid, int NT) {
    for (int i = gtid; i < M * 16; i += NT) {
        const int m = i >> 4, h = (i >> 1) & 7, k0 = (i & 1) * 8;
        bf16_t* p = qm + (size_t)m * 768 + h * 96 + 64 + k0;
        const v4u a = *(const v4u*)p, b = *(const v4u*)(p + 16);
        const f32x4 c0 = *(const f32x4*)(cstab + (size_t)m * 32 + k0), c1 = *(const f32x4*)(cstab + (size_t)m * 32 + k0 + 4), s0 = *(const f32x4*)(cstab + (size_t)m * 32 + 16 + k0), s1 = *(const f32x4*)(cstab + (size_t)m * 32 + 16 + k0 + 4);
        const unsigned au[4] = {a.x, a.y, a.z, a.w}, bu[4] = {b.x, b.y, b.z, b.w};
        const float cs[8] = {c0[0], c0[1], c0[2], c0[3], c1[0], c1[1], c1[2], c1[3]}, sn[8] = {s0[0], s0[1], s0[2], s0[3], s1[0], s1[1], s1[2], s1[3]};
        unsigned o1[4], o2[4];
#pragma unroll
        for (int q = 0; q < 4; ++q) { const float x1a = bflo(au[q]), x1b = bfhi(au[q]), x2a = bflo(bu[q]), x2b = bfhi(bu[q]);
            o1[q] = cvtpk(x1a * cs[2 * q] - x2a * sn[2 * q], x1b * cs[2 * q + 1] - x2b * sn[2 * q + 1]);
            o2[q] = cvtpk(x2a * cs[2 * q] + x1a * sn[2 * q], x2b * cs[2 * q + 1] + x1b * sn[2 * q + 1]); }
        if (ST) { *(v4u*)p = (v4u){o1[0], o1[1], o1[2], o1[3]}; *(v4u*)(p + 16) = (v4u){o2[0], o2[1], o2[2], o2[3]}; }
    }
}
__device__ __forceinline__ void sb_naive_task(int qblk, int bh, int lane, const bf16_t* __restrict__ proj1, bf16_t* __restrict__ ymix) {
    const int b = bh >> 3, h = bh & 7, t = qblk * 64 + lane;
    const size_t mrow = (size_t)b * SEQ;
    float q[64], o[64];
#pragma unroll
    for (int d = 0; d < 64; ++d) { q[d] = bf2f(proj1[(mrow + t) * L1P + h * 64 + d]) * 0.125f; o[d] = 0.f; }
    float cum = 0.f;
    const int smax = qblk * 64 + 63;
    for (int s = smax - 1; s >= 0; --s) {
        const bf16_t* kr = proj1 + (mrow + s) * L1P + 512 + h * 64;
        const bf16_t* vr = proj1 + (mrow + s) * L1P + 1024 + h * 64;
        float z = 0.f;
#pragma unroll
        for (int d = 0; d < 64; ++d) z += q[d] * bf2f(kr[d]);
        if (s < t) {
            const float lsp = -softplusf_(-z);
            const float lsn = -softplusf_(z);
            const float att = expf(lsp + cum);
            cum += lsn;
#pragma unroll
            for (int d = 0; d < 64; ++d) o[d] += att * bf2f(vr[d]);
        }
    }
#pragma unroll
    for (int d = 0; d < 64; ++d) ymix[(mrow + t) * DM + h * 64 + d] = (bf16_t)f2bf(o[d]);
}
__device__ __forceinline__ void mla_naive_task(int qblk, int bh, int lane, const bf16_t* __restrict__ qm, const bf16_t* __restrict__ kvm, const bf16_t* __restrict__ kpe, bf16_t* __restrict__ ymix) {
    const int b = bh >> 3, h = bh & 7, t = qblk * 64 + lane;
    const size_t mrow = (size_t)b * SEQ;
    const float scale = 0.10206207261596577f;
    float q[96], o[64];
#pragma unroll
    for (int d = 0; d < 96; ++d) q[d] = bf2f(qm[(mrow + t) * 768 + h * 96 + d]) * scale;
#pragma unroll
    for (int d = 0; d < 64; ++d) o[d] = 0.f;
    float mx = -1e30f, l = 0.f;
    const int smax = qblk * 64 + 63;
    for (int s = 0; s <= smax; ++s) {
        const bf16_t* kr = kvm + (mrow + s) * 1024 + h * 128;
        const bf16_t* pr = kpe + (mrow + s) * 32;
        float z = 0.f;
#pragma unroll
        for (int d = 0; d < 64; ++d) z += q[d] * bf2f(kr[d]);
#pragma unroll
        for (int d = 0; d < 32; ++d) z += q[64 + d] * bf2f(pr[d]);
        if (s <= t) {
            const float mn = fmaxf(mx, z), f = expf(mx - mn), pz = expf(z - mn);
            l = l * f + pz; mx = mn;
#pragma unroll
            for (int d = 0; d < 64; ++d) o[d] = o[d] * f + pz * bf2f(kr[64 + d]);
        }
    }
    const float il = 1.f / l;
#pragma unroll
    for (int d = 0; d < 64; ++d) ymix[(mrow + t) * DM + 512 + h * 64 + d] = (bf16_t)f2bf(o[d] * il);
}


__device__ __forceinline__ int crow(int r, int hi) { return (r & 3) + 8 * (r >> 2) + 4 * hi; }
#define MFMA32(a, b, c) __builtin_amdgcn_mfma_f32_32x32x16_bf16((a), (b), (c), 0, 0, 0)
constexpr int STG_PITCH = 72;
__device__ __forceinline__ void transpose_tile64(const bf16_t* __restrict__ src, int sp, bf16_t* __restrict__ dst, int dp, LAS bf16_t* scr, int lane) {
#pragma unroll
    for (int i = 0; i < 8; ++i) { const int row = i * 8 + (lane >> 3), ch = lane & 7; const v4u v = *(const v4u*)(src + (size_t)row * sp + ch * 8); *(LAS v4u*)(scr + row * STG_PITCH + ch * 8) = v; }
    WSYNC();
#pragma unroll
    for (int i = 0; i < 8; ++i) { const int d = i * 8 + (lane >> 3), tc = lane & 7; const LAS bf16_t* p = scr + (tc * 8) * STG_PITCH + d;
        v4u o; o.x = (unsigned)p[0] | ((unsigned)p[STG_PITCH] << 16); o.y = (unsigned)p[2 * STG_PITCH] | ((unsigned)p[3 * STG_PITCH] << 16);
        o.z = (unsigned)p[4 * STG_PITCH] | ((unsigned)p[5 * STG_PITCH] << 16); o.w = (unsigned)p[6 * STG_PITCH] | ((unsigned)p[7 * STG_PITCH] << 16);
        *(v4u*)(dst + (size_t)d * dp + tc * 8) = o; }
    WSYNC();
}
__device__ __forceinline__ void store_OT(const f32x16 (&o)[2], float sc, LAS bf16_t* stg, bf16_t* __restrict__ dst, int lane) {
    const int l31 = lane & 31, hi = lane >> 5;
#pragma unroll
    for (int dt = 0; dt < 2; ++dt)
#pragma unroll
        for (int r = 0; r < 16; ++r) stg[l31 * STG_PITCH + 32 * dt + crow(r, hi)] = (bf16_t)f2bf(o[dt][r] * sc);
    WSYNC();
#pragma unroll
    for (int i = 0; i < 4; ++i) { const int row = i * 8 + (lane >> 3), ch = lane & 7; const v4u v = *(const LAS v4u*)(stg + row * STG_PITCH + ch * 8); *(v4u*)(dst + (size_t)row * DM + ch * 8) = v; }
    WSYNC();
}
__device__ __forceinline__ float softplus_fast(float z) { return fmaxf(z, 0.f) + __logf(1.f + __expf(-fabsf(z))); }

__device__ __forceinline__ void sb_task(int bh, int qblk, int lane, const bf16_t* __restrict__ P1, const bf16_t* __restrict__ VT, bf16_t* __restrict__ ymix, LAS bf16_t* stg) {
    const int b = bh >> 3, h = bh & 7, l31 = lane & 31, hi = lane >> 5, q0 = qblk * 32, t = q0 + l31;
    const size_t rowb = (size_t)b * SEQ;
    const bf16_t* Qp = P1 + (rowb + q0 + l31) * L1P + h * 64 + 8 * hi;
    bf16x8 qf[4];
#pragma unroll
    for (int kk = 0; kk < 4; ++kk) qf[kk] = *(const bf16x8*)(Qp + 16 * kk);
    const bf16_t* Kp = P1 + (rowb + l31) * L1P + 512 + h * 64 + 8 * hi;
    const bf16_t* Vp = VT + ((size_t)bh * 64 + l31) * SEQ + 4 * hi;
    f32x16 o[2];
#pragma unroll
    for (int r = 0; r < 16; ++r) { o[0][r] = 0.f; o[1][r] = 0.f; }
    float cum = 0.f;
    bf16x8 kf[4]; u32x2 va[2][2][2];
#define SB_LOAD(S0, KF, VA) do { _Pragma("unroll") for (int kk = 0; kk < 4; ++kk) KF[kk] = *(const bf16x8*)(Kp + (size_t)(S0) * L1P + 16 * kk); \
        _Pragma("unroll") for (int dt = 0; dt < 2; ++dt) _Pragma("unroll") for (int ks = 0; ks < 2; ++ks) { VA[dt][ks][0] = *(const u32x2*)(Vp + (size_t)dt * 32 * SEQ + (S0) + 16 * ks); VA[dt][ks][1] = *(const u32x2*)(Vp + (size_t)dt * 32 * SEQ + (S0) + 16 * ks + 8); } } while (0)
    SB_LOAD(q0, kf, va);
    for (int s0 = q0; s0 >= 0; s0 -= 32) {
        bf16x8 kn[4]; u32x2 vn[2][2][2];
        const int sn = (s0 >= 32) ? s0 - 32 : 0;
        SB_LOAD(sn, kn, vn);
        f32x16 acc;
#pragma unroll
        for (int r = 0; r < 16; ++r) acc[r] = 0.f;
#pragma unroll
        for (int kk = 0; kk < 4; ++kk) acc = MFMA32(kf[kk], qf[kk], acc);
        const bool diag = (s0 == q0);
        float lb[16], lk[16];
#pragma unroll
        for (int r = 0; r < 16; ++r) { const float z = acc[r] * 0.125f; const float sp = softplus_fast(z); float b_ = z - sp, k_ = -sp;
            if (diag) { const bool valid = (s0 + crow(r, hi)) < t; b_ = valid ? b_ : -1e30f; k_ = valid ? k_ : 0.f; }
            lb[r] = b_; lk[r] = k_; }
        float e[16], T[4], U[4];
#pragma unroll
        for (int i = 0; i < 4; ++i) { e[4 * i + 3] = 0.f; e[4 * i + 2] = lk[4 * i + 3]; e[4 * i + 1] = e[4 * i + 2] + lk[4 * i + 2]; e[4 * i] = e[4 * i + 1] + lk[4 * i + 1]; T[i] = e[4 * i] + lk[4 * i]; }
#pragma unroll
        for (int i = 0; i < 4; ++i) U[i] = __shfl_xor(T[i], 32);
        float off[4];
        { const float st2 = T[3], st1 = st2 + T[2], st0 = st1 + T[1]; const float su2 = U[3], su1 = su2 + U[2], su0 = su1 + U[1];
          const float x0 = hi ? 0.f : U[0], x1 = hi ? 0.f : U[1], x2 = hi ? 0.f : U[2], x3 = hi ? 0.f : U[3];
          off[3] = x3; off[2] = st2 + su2 + x2; off[1] = st1 + su1 + x1; off[0] = st0 + su0 + x0;
          const float total = st0 + T[0] + su0 + U[0];
#pragma unroll
          for (int r = 0; r < 16; ++r) acc[r] = __expf(lb[r] + (cum + off[r >> 2] + e[r]));
          cum += total; }
        bf16x8 pf[2];
#pragma unroll
        for (int ks = 0; ks < 2; ++ks) { v4u w; w.x = cvtpk(acc[8 * ks], acc[8 * ks + 1]); w.y = cvtpk(acc[8 * ks + 2], acc[8 * ks + 3]); w.z = cvtpk(acc[8 * ks + 4], acc[8 * ks + 5]); w.w = cvtpk(acc[8 * ks + 6], acc[8 * ks + 7]); pf[ks] = __builtin_bit_cast(bf16x8, w); }
#pragma unroll
        for (int dt = 0; dt < 2; ++dt)
#pragma unroll
            for (int ks = 0; ks < 2; ++ks) { v4u a; a.x = va[dt][ks][0].x; a.y = va[dt][ks][0].y; a.z = va[dt][ks][1].x; a.w = va[dt][ks][1].y; o[dt] = MFMA32(__builtin_bit_cast(bf16x8, a), pf[ks], o[dt]); }
        if (__all(cum < -110.f)) break;
#pragma unroll
        for (int kk = 0; kk < 4; ++kk) kf[kk] = kn[kk];
#pragma unroll
        for (int dt = 0; dt < 2; ++dt)
#pragma unroll
            for (int ks = 0; ks < 2; ++ks) { va[dt][ks][0] = vn[dt][ks][0]; va[dt][ks][1] = vn[dt][ks][1]; }
    }
#undef SB_LOAD
    store_OT(o, 1.0f, stg, ymix + (rowb + q0) * DM + h * 64, lane);
}
__device__ __forceinline__ void mla_task(int bh, int qblk, int lane, const bf16_t* __restrict__ QM, const bf16_t* __restrict__ KVM, const bf16_t* __restrict__ KPE, const bf16_t* __restrict__ VT,
                                         bf16_t* __restrict__ ymix, LAS bf16_t* stg) {
    const int b = bh >> 3, h = bh & 7, l31 = lane & 31, hi = lane >> 5, q0 = qblk * 32, t = q0 + l31;
    const size_t rowb = (size_t)b * SEQ;
    const bf16_t* Qp = QM + (rowb + q0 + l31) * 768 + h * 96 + 8 * hi;
    bf16x8 qf[6];
#pragma unroll
    for (int kk = 0; kk < 6; ++kk) qf[kk] = *(const bf16x8*)(Qp + 16 * kk);
    const bf16_t* Kn = KVM + (rowb + l31) * 1024 + h * 128 + 8 * hi;
    const bf16_t* Kr = KPE + (rowb + l31) * 32 + 8 * hi;
    const bf16_t* Vp = VT + ((size_t)bh * 64 + l31) * SEQ + 4 * hi;
    const float sc2 = 0.10206207261596577f * 1.4426950408889634f;
    f32x16 o[2];
#pragma unroll
    for (int r = 0; r < 16; ++r) { o[0][r] = 0.f; o[1][r] = 0.f; }
    float mrun = -1e30f, lsum = 0.f;
    bf16x8 kf[6]; u32x2 va[2][2][2];
#define ML_LOAD(S0, KF, VA) do { _Pragma("unroll") for (int kk = 0; kk < 4; ++kk) KF[kk] = *(const bf16x8*)(Kn + (size_t)(S0) * 1024 + 16 * kk); \
        _Pragma("unroll") for (int kk = 0; kk < 2; ++kk) KF[4 + kk] = *(const bf16x8*)(Kr + (size_t)(S0) * 32 + 16 * kk); \
        _Pragma("unroll") for (int dt = 0; dt < 2; ++dt) _Pragma("unroll") for (int ks = 0; ks < 2; ++ks) { VA[dt][ks][0] = *(const u32x2*)(Vp + (size_t)dt * 32 * SEQ + (S0) + 16 * ks); VA[dt][ks][1] = *(const u32x2*)(Vp + (size_t)dt * 32 * SEQ + (S0) + 16 * ks + 8); } } while (0)
    ML_LOAD(0, kf, va);
    for (int s0 = 0; s0 <= q0; s0 += 32) {
        bf16x8 kn[6]; u32x2 vn[2][2][2];
        const int sn = (s0 + 32 <= q0) ? s0 + 32 : s0;
        ML_LOAD(sn, kn, vn);
        f32x16 acc;
#pragma unroll
        for (int r = 0; r < 16; ++r) acc[r] = 0.f;
#pragma unroll
        for (int kk = 0; kk < 6; ++kk) acc = MFMA32(kf[kk], qf[kk], acc);
        const bool diag = (s0 == q0);
        float tmax = -1e30f;
#pragma unroll
        for (int r = 0; r < 16; ++r) { float z = acc[r] * sc2; if (diag && (s0 + crow(r, hi)) > t) z = -1e30f; acc[r] = z; tmax = fmaxf(tmax, z); }
        tmax = fmaxf(tmax, __shfl_xor(tmax, 32));
        const float mn = fmaxf(mrun, tmax), alpha = exp2f(mrun - mn); mrun = mn;
        float ps = 0.f;
#pragma unroll
        for (int r = 0; r < 16; ++r) { acc[r] = exp2f(acc[r] - mn); ps += acc[r]; }
        lsum = lsum * alpha + ps;
#pragma unroll
        for (int r = 0; r < 16; ++r) { o[0][r] *= alpha; o[1][r] *= alpha; }
        bf16x8 pf[2];
#pragma unroll
        for (int ks = 0; ks < 2; ++ks) { v4u w; w.x = cvtpk(acc[8 * ks], acc[8 * ks + 1]); w.y = cvtpk(acc[8 * ks + 2], acc[8 * ks + 3]); w.z = cvtpk(acc[8 * ks + 4], acc[8 * ks + 5]); w.w = cvtpk(acc[8 * ks + 6], acc[8 * ks + 7]); pf[ks] = __builtin_bit_cast(bf16x8, w); }
#pragma unroll
        for (int dt = 0; dt < 2; ++dt)
#pragma unroll
            for (int ks = 0; ks < 2; ++ks) { v4u a; a.x = va[dt][ks][0].x; a.y = va[dt][ks][0].y; a.z = va[dt][ks][1].x; a.w = va[dt][ks][1].y; o[dt] = MFMA32(__builtin_bit_cast(bf16x8, a), pf[ks], o[dt]); }
#pragma unroll
        for (int kk = 0; kk < 6; ++kk) kf[kk] = kn[kk];
#pragma unroll
        for (int dt = 0; dt < 2; ++dt)
#pragma unroll
            for (int ks = 0; ks < 2; ++ks) { va[dt][ks][0] = vn[dt][ks][0]; va[dt][ks][1] = vn[dt][ks][1]; }
    }
#undef ML_LOAD
    lsum += __shfl_xor(lsum, 32);
    store_OT(o, 1.0f / lsum, stg, ymix + (rowb + q0) * DM + 512 + h * 64, lane);
}


constexpr int MLK_PITCH = 104, MLV_PITCH = 68, MLK_BYTES = 64 * MLK_PITCH * 2, MLV_BYTES = 64 * MLV_PITCH * 2, ML_STAGE = MLK_BYTES + MLV_BYTES;
__device__ __forceinline__ void mla_block(int bh, int sb, int tid, int lane, int wave, LAS unsigned char* lds, const bf16_t* __restrict__ QM, const bf16_t* __restrict__ KVM, const bf16_t* __restrict__ KPE,
                                          const bf16_t* __restrict__ VT, bf16_t* __restrict__ ymix) {
    const int b = bh >> 3, h = bh & 7, l31 = lane & 31, hi = lane >> 5, q0 = 256 * sb + 32 * wave, t = q0 + l31;
    const size_t rowb = (size_t)b * SEQ;
    const int nsteps = 4 * sb + 4;
    bf16x8 qf[6];
    { const bf16_t* Qp = QM + (rowb + q0 + l31) * 768 + h * 96 + 8 * hi;
#pragma unroll
      for (int kk = 0; kk < 6; ++kk) qf[kk] = *(const bf16x8*)(Qp + 16 * kk); }
    const float sc2 = 0.10206207261596577f * 1.4426950408889634f;
    f32x16 o[2];
#pragma unroll
    for (int r = 0; r < 16; ++r) { o[0][r] = 0.f; o[1][r] = 0.f; }
    float mrun = -1e30f, lsum = 0.f;
    const bf16_t* gKn = KVM + (rowb + (tid >> 3)) * 1024 + h * 128 + (tid & 7) * 8;
    const bf16_t* gKr = KPE + (rowb + ((tid & 255) >> 2)) * 32 + (tid & 3) * 8;
    const bf16_t* gVt = VT + ((size_t)bh * 64 + (tid >> 3)) * SEQ + (tid & 7) * 8;
    const int lKn = (tid >> 3) * (MLK_PITCH * 2) + (tid & 7) * 16, lKr = ((tid & 255) >> 2) * (MLK_PITCH * 2) + 128 + (tid & 3) * 16, lVt = MLK_BYTES + (tid >> 3) * (MLV_PITCH * 2) + (tid & 7) * 16;
    v4u rk, rr, rv;
    rk = *(const v4u*)gKn; rr = *(const v4u*)gKr; rv = *(const v4u*)gVt;
    *(LAS v4u*)(lds + lKn) = rk; if (tid < 256) *(LAS v4u*)(lds + lKr) = rr; *(LAS u32x2*)(lds + lVt) = (u32x2){rv.x, rv.y}; *(LAS u32x2*)(lds + lVt + 8) = (u32x2){rv.z, rv.w};
    __syncthreads();
#pragma unroll 1
    for (int step = 0; step < nsteps; ++step) {
        const int nx = (step + 1 < nsteps) ? step + 1 : step;
        rk = *(const v4u*)(gKn + (size_t)nx * 64 * 1024); rr = *(const v4u*)(gKr + (size_t)nx * 64 * 32); rv = *(const v4u*)(gVt + nx * 64);
        const LAS unsigned char* Kb = lds + (step & 1) * ML_STAGE;
        const LAS unsigned char* Vb = Kb + MLK_BYTES;
        if (64 * step <= q0) {
            f32x16 acc[2];
#pragma unroll
            for (int sub = 0; sub < 2; ++sub) {
#pragma unroll
                for (int r = 0; r < 16; ++r) acc[sub][r] = 0.f;
#pragma unroll
                for (int kk = 0; kk < 6; ++kk) { const bf16x8 kf = *(const LAS bf16x8*)(Kb + (32 * sub + l31) * (MLK_PITCH * 2) + (16 * kk + 8 * hi) * 2); acc[sub] = MFMA32(kf, qf[kk], acc[sub]); }
            }
            float tmax = -1e30f;
#pragma unroll
            for (int sub = 0; sub < 2; ++sub) { const int s0 = 64 * step + 32 * sub; const bool need_mask = (s0 + 31 > q0);
#pragma unroll
                for (int r = 0; r < 16; ++r) { float z = acc[sub][r] * sc2; if (need_mask && (s0 + crow(r, hi)) > t) z = -1e30f; acc[sub][r] = z; tmax = fmaxf(tmax, z); } }
            tmax = fmaxf(tmax, __shfl_xor(tmax, 32));
            const float mn = fmaxf(mrun, tmax), alpha = __builtin_amdgcn_exp2f(mrun - mn); mrun = mn;
            float ps = 0.f;
#pragma unroll
            for (int sub = 0; sub < 2; ++sub)
#pragma unroll
                for (int r = 0; r < 16; ++r) { acc[sub][r] = __builtin_amdgcn_exp2f(acc[sub][r] - mn); ps += acc[sub][r]; }
            lsum = lsum * alpha + ps;
#pragma unroll
            for (int r = 0; r < 16; ++r) { o[0][r] *= alpha; o[1][r] *= alpha; }
#pragma unroll
            for (int sub = 0; sub < 2; ++sub) {
                bf16x8 pf[2];
#pragma unroll
                for (int ks = 0; ks < 2; ++ks) pf[ks] = pack8(acc[sub][8 * ks], acc[sub][8 * ks + 1], acc[sub][8 * ks + 2], acc[sub][8 * ks + 3], acc[sub][8 * ks + 4], acc[sub][8 * ks + 5], acc[sub][8 * ks + 6], acc[sub][8 * ks + 7]);
#pragma unroll
                for (int dt = 0; dt < 2; ++dt)
#pragma unroll
                    for (int ks = 0; ks < 2; ++ks) { const LAS unsigned char* vp = Vb + (32 * dt + l31) * (MLV_PITCH * 2) + (32 * sub + 16 * ks + 4 * hi) * 2;
                        const u32x2 x0 = *(const LAS u32x2*)vp, x1 = *(const LAS u32x2*)(vp + 16);
                        v4u a; a.x = x0.x; a.y = x0.y; a.z = x1.x; a.w = x1.y; o[dt] = MFMA32(__builtin_bit_cast(bf16x8, a), pf[ks], o[dt]); }
            }
        }
        LAS unsigned char* nb = lds + ((step + 1) & 1) * ML_STAGE;
        *(LAS v4u*)(nb + lKn) = rk; if (tid < 256) *(LAS v4u*)(nb + lKr) = rr; *(LAS u32x2*)(nb + lVt) = (u32x2){rv.x, rv.y}; *(LAS u32x2*)(nb + lVt + 8) = (u32x2){rv.z, rv.w};
        __syncthreads();
    }
    lsum += __shfl_xor(lsum, 32);
    store_OT(o, 1.0f / lsum, (LAS bf16_t*)(lds + 2 * ML_STAGE) + wave * (32 * STG_PITCH), ymix + (rowb + q0) * DM + 512 + h * 64, lane);
    __syncthreads();
}


constexpr int SBK_PITCH = 72, SBK_BYTES = 64 * SBK_PITCH * 2, SB_STAGE = SBK_BYTES + MLV_BYTES;
__device__ __forceinline__ void sb_block(int bh, int sb, int tid, int lane, int wave, LAS unsigned char* lds, const bf16_t* __restrict__ P1, const bf16_t* __restrict__ VT, bf16_t* __restrict__ ymix) {
    const int b = bh >> 3, h = bh & 7, l31 = lane & 31, hi = lane >> 5, q0 = 256 * sb + 32 * wave, t = q0 + l31;
    const size_t rowb = (size_t)b * SEQ;
    bf16x8 qf[4];
    { const bf16_t* Qp = P1 + (rowb + q0 + l31) * L1P + h * 64 + 8 * hi;
#pragma unroll
      for (int kk = 0; kk < 4; ++kk) qf[kk] = *(const bf16x8*)(Qp + 16 * kk); }
    f32x16 o[2];
#pragma unroll
    for (int r = 0; r < 16; ++r) { o[0][r] = 0.f; o[1][r] = 0.f; }
    float cum = 0.f; bool done = false;
    volatile LAS unsigned* flags = (volatile LAS unsigned*)(lds + 2 * SB_STAGE);
    const bf16_t* gK = P1 + (rowb + (tid >> 3)) * L1P + 512 + h * 64 + (tid & 7) * 8;
    const bf16_t* gVt = VT + ((size_t)bh * 64 + (tid >> 3)) * SEQ + (tid & 7) * 8;
    const int lK = (tid >> 3) * (SBK_PITCH * 2) + (tid & 7) * 16, lVt = SBK_BYTES + (tid >> 3) * (MLV_PITCH * 2) + (tid & 7) * 16;
    const int top = 4 * sb + 3;
    v4u rk, rv;
    rk = *(const v4u*)(gK + (size_t)top * 64 * L1P); rv = *(const v4u*)(gVt + top * 64);
    *(LAS v4u*)(lds + lK) = rk; *(LAS u32x2*)(lds + lVt) = (u32x2){rv.x, rv.y}; *(LAS u32x2*)(lds + lVt + 8) = (u32x2){rv.z, rv.w};
    __syncthreads();
#pragma unroll 1
    for (int i = 0; i <= top; ++i) {
        const int step = top - i, nx = (step > 0) ? step - 1 : 0;
        rk = *(const v4u*)(gK + (size_t)nx * 64 * L1P); rv = *(const v4u*)(gVt + nx * 64);
        const LAS unsigned char* Kb = lds + (i & 1) * SB_STAGE;
        const LAS unsigned char* Vb = Kb + SBK_BYTES;
#pragma unroll
        for (int sub = 1; sub >= 0; --sub) {
            const int s0 = 64 * step + 32 * sub;
            if (s0 <= q0 && !done) {
                f32x16 acc;
#pragma unroll
                for (int r = 0; r < 16; ++r) acc[r] = 0.f;
#pragma unroll
                for (int kk = 0; kk < 4; ++kk) { const bf16x8 kf = *(const LAS bf16x8*)(Kb + (32 * sub + l31) * (SBK_PITCH * 2) + (16 * kk + 8 * hi) * 2); acc = MFMA32(kf, qf[kk], acc); }
                const bool diag = (s0 == q0);
                float lb[16], lk[16];
#pragma unroll
                for (int r = 0; r < 16; ++r) { const float z = acc[r] * 0.125f; const float sp = softplus_fast(z); float b_ = z - sp, k_ = -sp;
                    if (diag) { const bool valid = (s0 + crow(r, hi)) < t; b_ = valid ? b_ : -1e30f; k_ = valid ? k_ : 0.f; }
                    lb[r] = b_; lk[r] = k_; }
                float e[16], T[4], U[4];
#pragma unroll
                for (int q = 0; q < 4; ++q) { e[4 * q + 3] = 0.f; e[4 * q + 2] = lk[4 * q + 3]; e[4 * q + 1] = e[4 * q + 2] + lk[4 * q + 2]; e[4 * q] = e[4 * q + 1] + lk[4 * q + 1]; T[q] = e[4 * q] + lk[4 * q]; }
#pragma unroll
                for (int q = 0; q < 4; ++q) U[q] = __shfl_xor(T[q], 32);
                { const float st2 = T[3], st1 = st2 + T[2], st0 = st1 + T[1]; const float su2 = U[3], su1 = su2 + U[2], su0 = su1 + U[1];
                  const float x0 = hi ? 0.f : U[0], x1 = hi ? 0.f : U[1], x2 = hi ? 0.f : U[2], x3 = hi ? 0.f : U[3];
                  const float off[4] = {st0 + su0 + x0, st1 + su1 + x1, st2 + su2 + x2, x3};
                  const float total = st0 + T[0] + su0 + U[0];
#pragma unroll
                  for (int r = 0; r < 16; ++r) acc[r] = __expf(lb[r] + (cum + off[r >> 2] + e[r]));
                  cum += total; }
                bf16x8 pf[2];
#pragma unroll
                for (int ks = 0; ks < 2; ++ks) { v4u w; w.x = cvtpk(acc[8 * ks], acc[8 * ks + 1]); w.y = cvtpk(acc[8 * ks + 2], acc[8 * ks + 3]); w.z = cvtpk(acc[8 * ks + 4], acc[8 * ks + 5]); w.w = cvtpk(acc[8 * ks + 6], acc[8 * ks + 7]); pf[ks] = __builtin_bit_cast(bf16x8, w); }
#pragma unroll
                for (int dt = 0; dt < 2; ++dt)
#pragma unroll
                    for (int ks = 0; ks < 2; ++ks) { const LAS unsigned char* vp = Vb + (32 * dt + l31) * (MLV_PITCH * 2) + (32 * sub + 16 * ks + 4 * hi) * 2;
                        const u32x2 x0 = *(const LAS u32x2*)vp, x1 = *(const LAS u32x2*)(vp + 16);
                        v4u a; a.x = x0.x; a.y = x0.y; a.z = x1.x; a.w = x1.y; o[dt] = MFMA32(__builtin_bit_cast(bf16x8, a), pf[ks], o[dt]); }
                done = __all(cum < -110.f);
            }
        }
        if (lane == 0) flags[(i & 1) * 8 + wave] = done ? 1u : 0u;
        LAS unsigned char* nb = lds + ((i + 1) & 1) * SB_STAGE;
        *(LAS v4u*)(nb + lK) = rk; *(LAS u32x2*)(nb + lVt) = (u32x2){rv.x, rv.y}; *(LAS u32x2*)(nb + lVt + 8) = (u32x2){rv.z, rv.w};
        __syncthreads();
        unsigned nd = 0;
#pragma unroll
        for (int w8 = 0; w8 < 8; ++w8) nd += flags[(i & 1) * 8 + w8];
        if (nd == 8u) break;
    }
    store_OT(o, 1.0f, (LAS bf16_t*)(lds + 2 * SB_STAGE + 256) + wave * (32 * STG_PITCH), ymix + (rowb + q0) * DM + h * 64, lane);
    __syncthreads();
}

constexpr int RW_RAWW = 0, RW_RAWA = 2048, RW_RS = 4096, RW_KS = 6144, RW_VS = 8192;
constexpr int RW_CH0 = 10240, RW_CHSZ = 11328;
constexpr int RW_YB = RW_CH0 + 2 * RW_CHSZ;
constexpr int RW_MIX = RW_YB + 1024;
static_assert((RW_MIX + 256) * 4 <= 146432, "rwkv LDS map");
__device__ __forceinline__ float tanh_fast(float x) { return 1.f - 2.f * __builtin_amdgcn_rcpf(1.f + __expf(2.f * x)); }
__device__ __forceinline__ float sigmoid_fast(float x) { return __builtin_amdgcn_rcpf(1.f + __expf(-x)); }

#define MFMA16(a, b, c) __builtin_amdgcn_mfma_f32_16x16x32_bf16((a), (b), (c), 0, 0, 0)
constexpr int RW2_CH0 = 0, RW2_YB = 2 * RW_CHSZ, RW2_MIX = RW2_YB + 1024, RW2_STG = RW2_MIX + 448;
static_assert((RW2_STG + 2 * 3072) * 4 <= 146432, "rwkv LDS map");
__device__ __forceinline__ void rwkv_phase_scan(LAS float* sm, int tid, int lane, int wave, int blk, const bf16_t* __restrict__ proj, const float* __restrict__ mix, const float* __restrict__ w0, const float* __restrict__ a0,
                                           const float* __restrict__ k_k, const float* __restrict__ k_a, const float* __restrict__ r_k, const bf16_t* __restrict__ W2T, const bf16_t* __restrict__ A2T, const bf16_t* __restrict__ G2T,
                                           float* __restrict__ yraw, bf16_t* __restrict__ gout, float* __restrict__ bonus_out) {
    const int chain = blk >> 1, half = blk & 1, b = chain >> 3, h = chain & 7, l15 = lane & 15, kg = lane >> 4;
    const size_t rowb = (size_t)b * SEQ;
    constexpr int NCHUNK = SEQ / 32;
    if (tid < 256) sm[RW2_MIX + tid] = mix[1536 + tid];
    else if (tid < 448) { const int q = tid - 256; sm[RW2_MIX + tid] = mix[512 * (q >> 6) + h * 64 + (q & 63)]; }
    __syncthreads();
#define RW_SH8(CUR, PRV, M0, M1, OUT, PZ) do { const unsigned cu_[4] = {(CUR).x, (CUR).y, (CUR).z, (CUR).w}, pu_[4] = {(PRV).x, (PRV).y, (PRV).z, (PRV).w}; \
        const float mm_[8] = {(M0)[0], (M0)[1], (M0)[2], (M0)[3], (M1)[0], (M1)[1], (M1)[2], (M1)[3]}; \
        _Pragma("unroll") for (int q = 0; q < 4; ++q) { const float c0 = bflo(cu_[q]), c1 = bfhi(cu_[q]), p0 = bflo(pu_[q]) * (PZ), p1 = bfhi(pu_[q]) * (PZ); \
            OUT[2 * q] = c0 + (p0 - c0) * mm_[2 * q]; OUT[2 * q + 1] = c1 + (p1 - c1) * mm_[2 * q + 1]; } } while (0)
    if (wave < 4) {
        const int iA = 8 * wave + kg, iB = iA + 4, jseg = l15;
        float A0 = 0.f, A1 = 0.f, A2 = 0.f, A3 = 0.f, B0 = 0.f, B1 = 0.f, B2 = 0.f, B3 = 0.f;
        __syncthreads();
#pragma unroll 1
        for (int ch = 0; ch < NCHUNK; ++ch) {
            const int t0 = ch * 32;
            const LAS float* CHb = sm + RW2_CH0 + (ch & 1) * RW_CHSZ + 4 * jseg;
            const LAS float* CHv = sm + RW2_CH0 + (ch & 1) * RW_CHSZ + 10240 + iA;
            const LAS float* CHs = sm + RW2_CH0 + (ch & 1) * RW_CHSZ + 11264;
            f32x4 a4 = *(const LAS f32x4*)(CHb + 4096), wr4 = *(const LAS f32x4*)(CHb + 8192), w4 = *(const LAS f32x4*)(CHb), b4 = *(const LAS f32x4*)(CHb + 6144), k4 = *(const LAS f32x4*)(CHb + 2048);
            float vA = CHv[0], vB = CHv[4]; f32x2_t sc = *(const LAS f32x2_t*)(CHs);
#pragma unroll 2
            for (int t = 0; t < 32; ++t) {
                const int tq = (t + 1) & 31;
                const f32x4 a4n = *(const LAS f32x4*)(CHb + 4096 + tq * 64), wr4n = *(const LAS f32x4*)(CHb + 8192 + tq * 64), w4n = *(const LAS f32x4*)(CHb + tq * 64),
                            b4n = *(const LAS f32x4*)(CHb + 6144 + tq * 64), k4n = *(const LAS f32x4*)(CHb + 2048 + tq * 64);
                const float vAn = CHv[tq * 32], vBn = CHv[tq * 32 + 4]; const f32x2_t scn = *(const LAS f32x2_t*)(CHs + 2 * tq);
                float d1A = (A0 * a4[0] + A1 * a4[1]) + (A2 * a4[2] + A3 * a4[3]), d1B = (B0 * a4[0] + B1 * a4[1]) + (B2 * a4[2] + B3 * a4[3]);
                float d2A = (A0 * wr4[0] + A1 * wr4[1]) + (A2 * wr4[2] + A3 * wr4[3]), d2B = (B0 * wr4[0] + B1 * wr4[1]) + (B2 * wr4[2] + B3 * wr4[3]);
                d1A = rowsum16(d1A); d1B = rowsum16(d1B); d2A = rowsum16(d2A); d2B = rowsum16(d2B);
                const float yA = d2A + d1A * sc[0] + vA * sc[1], yB = d2B + d1B * sc[0] + vB * sc[1];
                A0 = A0 * w4[0] + (d1A * b4[0] + vA * k4[0]); A1 = A1 * w4[1] + (d1A * b4[1] + vA * k4[1]); A2 = A2 * w4[2] + (d1A * b4[2] + vA * k4[2]); A3 = A3 * w4[3] + (d1A * b4[3] + vA * k4[3]);
                B0 = B0 * w4[0] + (d1B * b4[0] + vB * k4[0]); B1 = B1 * w4[1] + (d1B * b4[1] + vB * k4[1]); B2 = B2 * w4[2] + (d1B * b4[2] + vB * k4[2]); B3 = B3 * w4[3] + (d1B * b4[3] + vB * k4[3]);
                if (jseg == 0) { sm[RW2_YB + t * 32 + iA] = yA; sm[RW2_YB + t * 32 + iB] = yB; }
                a4 = a4n; wr4 = wr4n; w4 = w4n; b4 = b4n; k4 = k4n; vA = vAn; vB = vBn; sc = scn;
            }
            WSYNC();
            { const int tt = lane >> 1, hh = lane & 1; const f32x4 yv = *(const LAS f32x4*)(sm + RW2_YB + tt * 32 + 8 * wave + 4 * hh);
              *(f32x4*)(yraw + (rowb + t0 + tt) * 512 + h * 64 + half * 32 + 8 * wave + 4 * hh) = yv; }
            __syncthreads();
        }
    } else if (wave < 6) {
        const int tp = wave - 4, tb = 16 * tp;
        LAS float* stg = sm + RW2_STG + tp * 3072;
        float w0c[4], a0c[4], kkc[4], kac[4], rkc[4];
#pragma unroll
        for (int nt = 0; nt < 4; ++nt) { const int c = h * 64 + 16 * nt + l15; w0c[nt] = w0[c]; a0c[nt] = a0[c]; kkc[nt] = k_k[c]; kac[nt] = k_a[c]; rkc[nt] = r_k[c]; }
        v4u ld[20];
#define PREP_ISSUE(T0) do { const int t0_ = (T0); { const size_t r_ = rowb + t0_ + tb + l15; const size_t rp_ = (t0_ + tb + l15 == 0) ? r_ : r_ - 1; \
            _Pragma("unroll") for (int lo = 0; lo < 2; ++lo) _Pragma("unroll") for (int ks = 0; ks < 2; ++ks) { const int col = 1536 + 64 * lo + 32 * ks + 8 * kg; \
                ld[(lo * 2 + ks) * 2] = *(const v4u*)(proj + r_ * L0P + col); ld[(lo * 2 + ks) * 2 + 1] = *(const v4u*)(proj + rp_ * L0P + col); } } \
            _Pragma("unroll") for (int ar = 0; ar < 3; ++ar) _Pragma("unroll") for (int i = 0; i < 2; ++i) { const int p_ = lane + 64 * i, row_ = p_ >> 3, c8_ = p_ & 7; \
                const size_t r_ = rowb + t0_ + tb + row_; const size_t rp_ = (t0_ + tb + row_ == 0) ? r_ : r_ - 1; const int col = 512 * ar + h * 64 + 8 * c8_; \
                ld[8 + (ar * 2 + i) * 2] = *(const v4u*)(proj + r_ * L0P + col); ld[8 + (ar * 2 + i) * 2 + 1] = *(const v4u*)(proj + rp_ * L0P + col); } } while (0)
#define PREP_BUILD(T0, NB) do { const int t0_ = (T0); LAS float* CHn = sm + RW2_CH0 + (NB) * RW_CHSZ; \
            f32x4 accw[4], acca[4]; \
            _Pragma("unroll") for (int nt = 0; nt < 4; ++nt) { accw[nt] = (f32x4){0.f, 0.f, 0.f, 0.f}; acca[nt] = (f32x4){0.f, 0.f, 0.f, 0.f}; } \
            { const float pz_ = (t0_ + tb + l15 == 0) ? 0.f : 1.f; \
              _Pragma("unroll") for (int lo = 0; lo < 2; ++lo) _Pragma("unroll") for (int ks = 0; ks < 2; ++ks) { float s_[8]; \
                const f32x4 m0 = *(const LAS f32x4*)(sm + RW2_MIX + 64 * lo + 32 * ks + 8 * kg), m1 = *(const LAS f32x4*)(sm + RW2_MIX + 64 * lo + 32 * ks + 8 * kg + 4); \
                RW_SH8(ld[(lo * 2 + ks) * 2], ld[(lo * 2 + ks) * 2 + 1], m0, m1, s_, pz_); \
                if (lo == 0) { _Pragma("unroll") for (int j = 0; j < 8; ++j) s_[j] = tanh_fast(s_[j]); } \
                v4u aw; aw.x = cvtpk(s_[0], s_[1]); aw.y = cvtpk(s_[2], s_[3]); aw.z = cvtpk(s_[4], s_[5]); aw.w = cvtpk(s_[6], s_[7]); const bf16x8 af = __builtin_bit_cast(bf16x8, aw); \
                const bf16_t* WT = lo ? A2T : W2T; \
                _Pragma("unroll") for (int nt = 0; nt < 4; ++nt) { const bf16x8 bfr = *(const bf16x8*)(WT + (size_t)(h * 64 + 16 * nt + l15) * 64 + 32 * ks + 8 * kg); \
                    if (lo == 0) accw[nt] = MFMA16(af, bfr, accw[nt]); else acca[nt] = MFMA16(af, bfr, acca[nt]); } } } \
            _Pragma("unroll") for (int ar = 0; ar < 3; ++ar) _Pragma("unroll") for (int i = 0; i < 2; ++i) { const int p_ = lane + 64 * i, row_ = p_ >> 3, c8_ = p_ & 7; float s_[8]; \
                const float pz_ = (t0_ + tb + row_ == 0) ? 0.f : 1.f; const f32x4 m0 = *(const LAS f32x4*)(sm + RW2_MIX + 256 + ar * 64 + c8_ * 8), m1 = *(const LAS f32x4*)(sm + RW2_MIX + 256 + ar * 64 + c8_ * 8 + 4); \
                RW_SH8(ld[8 + (ar * 2 + i) * 2], ld[8 + (ar * 2 + i) * 2 + 1], m0, m1, s_, pz_); \
                *(LAS f32x4*)(stg + ar * 1024 + row_ * 64 + c8_ * 8) = (f32x4){s_[0], s_[1], s_[2], s_[3]}; *(LAS f32x4*)(stg + ar * 1024 + row_ * 64 + c8_ * 8 + 4) = (f32x4){s_[4], s_[5], s_[6], s_[7]}; } \
            WSYNC(); \
            PREP_ISSUE(((T0) + 32 < SEQ) ? (T0) + 32 : (T0)); \
            _Pragma("unroll") for (int rg = 0; rg < 4; ++rg) { const int tl = 4 * kg + rg, t = tb + tl; \
                float r_[4], k_[4], v_[4], kkv[4], nrm2 = 0.f; \
                _Pragma("unroll") for (int nt = 0; nt < 4; ++nt) { r_[nt] = stg[tl * 64 + 16 * nt + l15]; k_[nt] = stg[1024 + tl * 64 + 16 * nt + l15]; v_[nt] = stg[2048 + tl * 64 + 16 * nt + l15]; \
                    kkv[nt] = k_[nt] * kkc[nt]; nrm2 += kkv[nt] * kkv[nt]; } \
                nrm2 = rowsum16(nrm2); const float rn = __builtin_amdgcn_rsqf(fmaxf(nrm2, 1e-24f)); \
                float br = 0.f, kr = 0.f, bon = 0.f; \
                _Pragma("unroll") for (int nt = 0; nt < 4; ++nt) { const int j = 16 * nt + l15; \
                    const float wsum = w0c[nt] + accw[nt][rg]; const float logw = -softplus_fast(-wsum) - 0.5f; const float dec = __expf(-__expf(logw)); \
                    const float a_ = sigmoid_fast(a0c[nt] + acca[nt][rg]); const float kn = kkv[nt] * rn; \
                    const float k2 = k_[nt] * (1.f + (a_ - 1.f) * kac[nt]); const float bv = kn * a_; \
                    br += bv * r_[nt]; kr += k2 * r_[nt]; bon += r_[nt] * k2 * rkc[nt]; \
                    CHn[t * 64 + j] = dec; CHn[2048 + t * 64 + j] = k2; CHn[4096 + t * 64 + j] = -kn; CHn[6144 + t * 64 + j] = bv; CHn[8192 + t * 64 + j] = dec * r_[nt]; \
                    if ((nt >> 1) == half) CHn[10240 + t * 32 + (j & 31)] = v_[nt]; } \
                br = rowsum16(br); kr = rowsum16(kr); bon = rowsum16(bon); \
                if (l15 == 0) { CHn[11264 + 2 * t] = br; CHn[11264 + 2 * t + 1] = kr; if (half == 0) bonus_out[(rowb + t0_ + t) * 8 + h] = bon; } } \
            WSYNC(); } while (0)
        PREP_ISSUE(0);
        PREP_BUILD(0, 0);
        __syncthreads();
#pragma unroll 1
        for (int ch = 0; ch < NCHUNK; ++ch) {
            if (ch + 1 < NCHUNK) PREP_BUILD(ch * 32 + 32, (ch + 1) & 1);
            __syncthreads();
        }
#undef PREP_ISSUE
#undef PREP_BUILD
    } else {
        const int tp = wave - 6, tb = 16 * tp;
        v4u ld[8];
#define G_ISSUE(T0) do { const int t0_ = (T0); const size_t r_ = rowb + t0_ + tb + l15; const size_t rp_ = (t0_ + tb + l15 == 0) ? r_ : r_ - 1; \
            _Pragma("unroll") for (int ks = 0; ks < 4; ++ks) { const int col = 1664 + 32 * ks + 8 * kg; ld[2 * ks] = *(const v4u*)(proj + r_ * L0P + col); ld[2 * ks + 1] = *(const v4u*)(proj + rp_ * L0P + col); } } while (0)
#define G_BUILD(T0) do { const int t0_ = (T0); f32x4 accg[2] = {(f32x4){0.f, 0.f, 0.f, 0.f}, (f32x4){0.f, 0.f, 0.f, 0.f}}; const float pz_ = (t0_ + tb + l15 == 0) ? 0.f : 1.f; \
            _Pragma("unroll") for (int ks = 0; ks < 4; ++ks) { float s_[8]; \
                const f32x4 m0 = *(const LAS f32x4*)(sm + RW2_MIX + 128 + 32 * ks + 8 * kg), m1 = *(const LAS f32x4*)(sm + RW2_MIX + 128 + 32 * ks + 8 * kg + 4); \
                RW_SH8(ld[2 * ks], ld[2 * ks + 1], m0, m1, s_, pz_); \
                _Pragma("unroll") for (int j = 0; j < 8; ++j) s_[j] = sigmoid_fast(s_[j]); \
                v4u aw; aw.x = cvtpk(s_[0], s_[1]); aw.y = cvtpk(s_[2], s_[3]); aw.z = cvtpk(s_[4], s_[5]); aw.w = cvtpk(s_[6], s_[7]); const bf16x8 af = __builtin_bit_cast(bf16x8, aw); \
                _Pragma("unroll") for (int nt = 0; nt < 2; ++nt) { const bf16x8 bfr = *(const bf16x8*)(G2T + (size_t)(h * 64 + half * 32 + 16 * nt + l15) * 128 + 32 * ks + 8 * kg); accg[nt] = MFMA16(af, bfr, accg[nt]); } } \
            G_ISSUE(((T0) + 32 < SEQ) ? (T0) + 32 : (T0)); \
            _Pragma("unroll") for (int nt = 0; nt < 2; ++nt) _Pragma("unroll") for (int rg = 0; rg < 4; ++rg) \
                gout[(rowb + t0_ + tb + 4 * kg + rg) * 512 + h * 64 + half * 32 + 16 * nt + l15] = (bf16_t)f2bf(accg[nt][rg]); } while (0)
        G_ISSUE(0);
        G_BUILD(0);
        __syncthreads();
#pragma unroll 1
        for (int ch = 0; ch < NCHUNK; ++ch) {
            if (ch + 1 < NCHUNK) G_BUILD(ch * 32 + 32);
            __syncthreads();
        }
#undef G_ISSUE
#undef G_BUILD
    }
#undef RW_SH8
    __syncthreads();
}

constexpr int CK_BK = 0, CK_AR = 4608, CK_BBT = 9216, CK_KBT = 12288, CK_VT = 15360, CK_GC = 16896, CK_TT = 17152, CK_SLOT = 18688, CK_NSLOT = 5;
constexpr int CK_STG = CK_SLOT * CK_NSLOT;
constexpr int CK_MIX = CK_STG + 4 * 12288;
constexpr int CK_FLAGS = CK_MIX + 448 * 4;
static_assert(CK_FLAGS + 64 <= 146432, "rwkv chunked LDS map");
__device__ __forceinline__ void rwkv_phase(LAS float* smf, int tid, int lane, int wave, int blk, const bf16_t* __restrict__ proj, const float* __restrict__ mix, const float* __restrict__ w0, const float* __restrict__ a0,
                                           const float* __restrict__ k_k, const float* __restrict__ k_a, const float* __restrict__ r_k, const bf16_t* __restrict__ W2T, const bf16_t* __restrict__ A2T, const bf16_t* __restrict__ G2T,
                                           float* __restrict__ yraw, bf16_t* __restrict__ gout, float* __restrict__ bonus_out) {
    LAS unsigned char* lds = (LAS unsigned char*)smf;
    LAS float* mixs = (LAS float*)(lds + CK_MIX);
    volatile LAS unsigned* flags = (volatile LAS unsigned*)(lds + CK_FLAGS);
    const int chain = blk >> 1, ihalf = blk & 1, b = chain >> 3, h = chain & 7, l15 = lane & 15, kg = lane >> 4, l31 = lane & 31, hi = lane >> 5;
    const size_t rowb = (size_t)b * SEQ;
    constexpr int NCH = SEQ / 16;
    if (tid < 256) mixs[tid] = mix[1536 + tid];
    else if (tid < 448) { const int q = tid - 256; mixs[tid] = mix[512 * (q >> 6) + h * 64 + (q & 63)]; }
    if (tid < 16) flags[tid] = 0u;
    for (int q = tid; q < CK_NSLOT * 384; q += NWAVES * 64) *(LAS unsigned*)(lds + (q / 384) * CK_SLOT + CK_TT + (q % 384) * 4) = 0u;
    __syncthreads();
#define RW_SH8(CUR, PRV, M0, M1, OUT, PZ) do { const unsigned cu_[4] = {(CUR).x, (CUR).y, (CUR).z, (CUR).w}, pu_[4] = {(PRV).x, (PRV).y, (PRV).z, (PRV).w}; \
        const float mm_[8] = {(M0)[0], (M0)[1], (M0)[2], (M0)[3], (M1)[0], (M1)[1], (M1)[2], (M1)[3]}; \
        _Pragma("unroll") for (int q = 0; q < 4; ++q) { const float c0 = bflo(cu_[q]), c1 = bfhi(cu_[q]), p0 = bflo(pu_[q]) * (PZ), p1 = bfhi(pu_[q]) * (PZ); \
            OUT[2 * q] = c0 + (p0 - c0) * mm_[2 * q]; OUT[2 * q + 1] = c1 + (p1 - c1) * mm_[2 * q + 1]; } } while (0)
    if (wave == 0) {
        f32x16 ST[2];
#pragma unroll
        for (int r = 0; r < 16; ++r) { ST[0][r] = 0.f; ST[1][r] = 0.f; }
#pragma unroll 1
        for (int k = 0; k < NCH; ++k) {
#if defined(PROBE_STAMPS)
            const unsigned tw0_ = (unsigned)__builtin_amdgcn_s_memrealtime();
#endif
            { const unsigned want = (unsigned)(k + 1); const int sl = k % CK_NSLOT; while (flags[sl] != want) __builtin_amdgcn_s_sleep(1); }
#if defined(PROBE_STAMPS)
            if (blk == 0 && lane == 0) ((volatile LAS unsigned*)(lds + 146432 + 320))[16 + 24] += (unsigned)__builtin_amdgcn_s_memrealtime() - tw0_;
#endif
            asm volatile("" ::: "memory");
            const LAS unsigned char* im = lds + (k % CK_NSLOT) * CK_SLOT;
            f32x16 G;
#pragma unroll
            for (int r = 0; r < 16; ++r) G[r] = 0.f;
#pragma unroll
            for (int kk = 0; kk < 4; ++kk) { const bf16x8 fa = *(const LAS bf16x8*)(im + CK_BK + l31 * 144 + (16 * kk + 8 * hi) * 2), fb = *(const LAS bf16x8*)(im + CK_AR + l31 * 144 + (16 * kk + 8 * hi) * 2); G = MFMA32(fa, fb, G); }
            { const int tcol = l31 & 15; const bool strict = l31 < 16;
#pragma unroll
              for (int r = 0; r < 16; ++r) { const int srow = crow(r & 7, hi); const bool keep = strict ? (srow < tcol) : (srow <= tcol); G[r] = keep ? G[r] : 0.f; } }
            const bf16x8 gB = pack8(G[0], G[1], G[2], G[3], G[4], G[5], G[6], G[7]), gK = pack8(G[8], G[9], G[10], G[11], G[12], G[13], G[14], G[15]);
            f32x16 XT;
#pragma unroll
            for (int r = 0; r < 16; ++r) XT[r] = 0.f;
#pragma unroll
            for (int jt = 0; jt < 2; ++jt)
#pragma unroll
                for (int sp = 0; sp < 2; ++sp) { const LAS unsigned char* ap = im + CK_AR + l31 * 144 + (32 * jt + 16 * sp + 4 * hi) * 2;
                    const u32x2 x0 = *(const LAS u32x2*)ap, x1 = *(const LAS u32x2*)(ap + 16); v4u aw; aw.x = x0.x; aw.y = x0.y; aw.z = x1.x; aw.w = x1.y;
                    const bf16x8 sb_ = pack8(ST[jt][8 * sp], ST[jt][8 * sp + 1], ST[jt][8 * sp + 2], ST[jt][8 * sp + 3], ST[jt][8 * sp + 4], ST[jt][8 * sp + 5], ST[jt][8 * sp + 6], ST[jt][8 * sp + 7]);
                    XT = MFMA32(__builtin_bit_cast(bf16x8, aw), sb_, XT); }
            bf16x8 vP;
            { const LAS unsigned char* vp = im + CK_VT + l31 * 48 + (4 * hi) * 2; const u32x2 x0 = *(const LAS u32x2*)vp, x1 = *(const LAS u32x2*)(vp + 16); v4u vw; vw.x = x0.x; vw.y = x0.y; vw.z = x1.x; vw.w = x1.y;
              vP = __builtin_bit_cast(bf16x8, vw); XT = MFMA32(gK, vP, XT); }
            bf16x8 uP;
            { const LAS unsigned char* tp = im + CK_TT + l31 * 48 + (4 * hi) * 2; const u32x2 x0 = *(const LAS u32x2*)tp, x1 = *(const LAS u32x2*)(tp + 16); v4u tw; tw.x = x0.x; tw.y = x0.y; tw.z = x1.x; tw.w = x1.y;
              f32x16 UT;
#pragma unroll
              for (int r = 0; r < 16; ++r) UT[r] = 0.f;
              UT = MFMA32(__builtin_bit_cast(bf16x8, tw), pack8(XT[0], XT[1], XT[2], XT[3], XT[4], XT[5], XT[6], XT[7]), UT);
              uP = pack8(UT[0], UT[1], UT[2], UT[3], UT[4], UT[5], UT[6], UT[7]); }
            XT = MFMA32(gB, uP, XT);
            { float* yp = yraw + (rowb + 16 * k) * 512 + h * 64 + 32 * ihalf + l31;
#pragma unroll
              for (int q = 0; q < 8; ++q) yp[(size_t)crow(q, hi) * 512] = XT[8 + q]; }
            { const LAS float* gc = (const LAS float*)(im + CK_GC);
#pragma unroll
              for (int jt = 0; jt < 2; ++jt)
#pragma unroll
                  for (int r = 0; r < 16; ++r) ST[jt][r] *= gc[32 * jt + crow(r, hi)]; }
#pragma unroll
            for (int jt = 0; jt < 2; ++jt) { const LAS unsigned char* bp = im + CK_BBT + (32 * jt + l31) * 48 + (4 * hi) * 2; const LAS unsigned char* kp = im + CK_KBT + (32 * jt + l31) * 48 + (4 * hi) * 2;
                const u32x2 b0 = *(const LAS u32x2*)bp, b1 = *(const LAS u32x2*)(bp + 16), k0 = *(const LAS u32x2*)kp, k1 = *(const LAS u32x2*)(kp + 16);
                v4u a1; a1.x = b0.x; a1.y = b0.y; a1.z = b1.x; a1.w = b1.y; v4u a2; a2.x = k0.x; a2.y = k0.y; a2.z = k1.x; a2.w = k1.y;
                ST[jt] = MFMA32(__builtin_bit_cast(bf16x8, a1), uP, ST[jt]); ST[jt] = MFMA32(__builtin_bit_cast(bf16x8, a2), vP, ST[jt]); }
            WSYNC();
            if (lane == 0) flags[8] = (unsigned)(k + 1);
        }
    } else if (wave <= 4) {
        const int pw = wave - 1;
        LAS float* stg = (LAS float*)(lds + CK_STG) + pw * 3072;
        float w0c[4], a0c[4], kkc[4], kac[4], rkc[4];
#pragma unroll
        for (int nt = 0; nt < 4; ++nt) { const int c = h * 64 + 16 * nt + l15; w0c[nt] = w0[c]; a0c[nt] = a0[c]; kkc[nt] = k_k[c]; kac[nt] = k_a[c]; rkc[nt] = r_k[c]; }
        v4u ld[20];
#define CK_ISSUE_A(T0) do { const int t0_ = (T0); const size_t r_ = rowb + t0_ + l15; const size_t rp_ = (t0_ + l15 == 0) ? r_ : r_ - 1; \
            _Pragma("unroll") for (int lo = 0; lo < 2; ++lo) _Pragma("unroll") for (int ks = 0; ks < 2; ++ks) { const int col = 1536 + 64 * lo + 32 * ks + 8 * kg; \
                ld[(lo * 2 + ks) * 2] = *(const v4u*)(proj + r_ * L0P + col); ld[(lo * 2 + ks) * 2 + 1] = *(const v4u*)(proj + rp_ * L0P + col); } } while (0)
#define CK_ISSUE_B(T0) do { const int t0_ = (T0); \
            _Pragma("unroll") for (int ar = 0; ar < 3; ++ar) _Pragma("unroll") for (int i = 0; i < 2; ++i) { const int p_ = lane + 64 * i, row_ = p_ >> 3, c8_ = p_ & 7; \
                const size_t r_ = rowb + t0_ + row_; const size_t rp_ = (t0_ + row_ == 0) ? r_ : r_ - 1; const int col = 512 * ar + h * 64 + 8 * c8_; \
                ld[8 + (ar * 2 + i) * 2] = *(const v4u*)(proj + r_ * L0P + col); ld[8 + (ar * 2 + i) * 2 + 1] = *(const v4u*)(proj + rp_ * L0P + col); } } while (0)
#define CK_ISSUE(T0) do { CK_ISSUE_A(T0); CK_ISSUE_B(T0); } while (0)
        CK_ISSUE(16 * pw);
#pragma unroll 1
        for (int k = pw; k < NCH; k += 4) {
            const int t0 = 16 * k;
#if defined(PROBE_STAMPS)
            const unsigned ts0_ = (unsigned)__builtin_amdgcn_s_memrealtime();
#endif
            f32x4 accw[4], acca[4];
#pragma unroll
            for (int nt = 0; nt < 4; ++nt) { accw[nt] = (f32x4){0.f, 0.f, 0.f, 0.f}; acca[nt] = (f32x4){0.f, 0.f, 0.f, 0.f}; }
            { const float pz_ = (t0 + l15 == 0) ? 0.f : 1.f;
#pragma unroll
              for (int lo = 0; lo < 2; ++lo)
#pragma unroll
                for (int ks = 0; ks < 2; ++ks) { float s_[8];
                    const f32x4 m0 = *(const LAS f32x4*)(mixs + 64 * lo + 32 * ks + 8 * kg), m1 = *(const LAS f32x4*)(mixs + 64 * lo + 32 * ks + 8 * kg + 4);
                    RW_SH8(ld[(lo * 2 + ks) * 2], ld[(lo * 2 + ks) * 2 + 1], m0, m1, s_, pz_);
                    if (lo == 0) {
#pragma unroll
                        for (int j = 0; j < 8; ++j) s_[j] = tanh_fast(s_[j]); }
                    const bf16x8 af = pack8(s_[0], s_[1], s_[2], s_[3], s_[4], s_[5], s_[6], s_[7]);
                    const bf16_t* WT = lo ? A2T : W2T;
#pragma unroll
                    for (int nt = 0; nt < 4; ++nt) { const bf16x8 bfr = *(const bf16x8*)(WT + (size_t)(h * 64 + 16 * nt + l15) * 64 + 32 * ks + 8 * kg);
                        if (lo == 0) accw[nt] = MFMA16(af, bfr, accw[nt]); else acca[nt] = MFMA16(af, bfr, acca[nt]); } } }
#pragma unroll
            for (int ar = 0; ar < 3; ++ar)
#pragma unroll
                for (int i = 0; i < 2; ++i) { const int p_ = lane + 64 * i, row_ = p_ >> 3, c8_ = p_ & 7; float s_[8];
                    const float pz_ = (t0 + row_ == 0) ? 0.f : 1.f; const f32x4 m0 = *(const LAS f32x4*)(mixs + 256 + ar * 64 + c8_ * 8), m1 = *(const LAS f32x4*)(mixs + 256 + ar * 64 + c8_ * 8 + 4);
                    RW_SH8(ld[8 + (ar * 2 + i) * 2], ld[8 + (ar * 2 + i) * 2 + 1], m0, m1, s_, pz_);
                    *(LAS f32x4*)(stg + ar * 1024 + row_ * 64 + c8_ * 8) = (f32x4){s_[0], s_[1], s_[2], s_[3]}; *(LAS f32x4*)(stg + ar * 1024 + row_ * 64 + c8_ * 8 + 4) = (f32x4){s_[4], s_[5], s_[6], s_[7]}; }
            WSYNC();
#if defined(PROBE_STAMPS)
            if (blk == 0 && wave == 1 && lane == 0) ((volatile LAS unsigned*)(lds + 146432 + 320))[16 + 26] += (unsigned)__builtin_amdgcn_s_memrealtime() - ts0_;
#endif
#if defined(PROBE_STAMPS)
            const unsigned tb0_ = (unsigned)__builtin_amdgcn_s_memrealtime();
#endif
            { const int need = k - (CK_NSLOT - 1); if (need > 0) { while ((int)flags[8] < need) __builtin_amdgcn_s_sleep(2); } }
#if defined(PROBE_STAMPS)
            if (blk == 0 && wave == 1 && lane == 0) ((volatile LAS unsigned*)(lds + 146432 + 320))[16 + 25] += (unsigned)__builtin_amdgcn_s_memrealtime() - tb0_;
#endif
            asm volatile("" ::: "memory");
            LAS unsigned char* im = lds + (k % CK_NSLOT) * CK_SLOT;
#if defined(PROBE_STAMPS)
            const unsigned ts1_ = (unsigned)__builtin_amdgcn_s_memrealtime();
#endif
            float lwv[4][4], av[4][4], knv[4][4];
#pragma unroll
            for (int rg = 0; rg < 4; ++rg) { const int tl = 4 * kg + rg;
                float kkv[4], nrm2 = 0.f, vv[4], rr_[4], kr_[4];
#pragma unroll
                for (int nt = 0; nt < 4; ++nt) { rr_[nt] = stg[tl * 64 + 16 * nt + l15]; kr_[nt] = stg[1024 + tl * 64 + 16 * nt + l15]; vv[nt] = stg[2048 + tl * 64 + 16 * nt + l15];
                    kkv[nt] = kr_[nt] * kkc[nt]; nrm2 += kkv[nt] * kkv[nt]; }
                nrm2 = rowsum16(nrm2); const float rn = __builtin_amdgcn_rsqf(fmaxf(nrm2, 1e-24f));
                float bon = 0.f;
#pragma unroll
                for (int nt = 0; nt < 4; ++nt) {
                    const float wsum = w0c[nt] + accw[nt][rg]; lwv[nt][rg] = -0.6065306597126334f * sigmoid_fast(wsum);
                    const float a_ = sigmoid_fast(a0c[nt] + acca[nt][rg]); av[nt][rg] = a_; knv[nt][rg] = kkv[nt] * rn;
                    const float k2 = kr_[nt] * (1.f + (a_ - 1.f) * kac[nt]); stg[1024 + tl * 64 + 16 * nt + l15] = k2;
                    bon += rr_[nt] * k2 * rkc[nt];
                    if ((nt >> 1) == ihalf) *(LAS bf16_t*)(im + CK_VT + (16 * (nt & 1) + l15) * 48 + tl * 2) = bf1(vv[nt]);
                }
                bon = rowsum16(bon);
                if (l15 == 0 && ihalf == 0) bonus_out[(rowb + t0 + tl) * 8 + h] = bon;
            }
            CK_ISSUE_A((k + 4 < NCH) ? t0 + 64 : t0);
#pragma unroll
            for (int nt = 0; nt < 4; ++nt) {
                float L[4]; L[0] = lwv[nt][0]; L[1] = L[0] + lwv[nt][1]; L[2] = L[1] + lwv[nt][2]; L[3] = L[2] + lwv[nt][3];
                const float T0 = __shfl(L[3], l15), T1 = __shfl(L[3], 16 + l15), T2 = __shfl(L[3], 32 + l15), T3 = __shfl(L[3], 48 + l15);
                const float off = (kg > 0 ? T0 : 0.f) + (kg > 1 ? T1 : 0.f) + (kg > 2 ? T2 : 0.f), LC = (T0 + T1) + (T2 + T3);
                const int j = 16 * nt + l15;
                unsigned bb2[2], kb2[2];
                const float gC = __expf(LC); float eprev = __expf(off);
#pragma unroll
                for (int rg = 0; rg < 4; ++rg) { const int tl = 4 * kg + rg; const float Lt = off + L[rg], e1 = __expf(Lt), e2 = __builtin_amdgcn_rcpf(e1), e3 = eprev, e4 = gC * e2; eprev = e1;
                    const float kn = knv[nt][rg], bvv = kn * av[nt][rg], k2 = stg[1024 + tl * 64 + j], rr2 = stg[tl * 64 + j];
                    *(LAS bf16_t*)(im + CK_BK + tl * 144 + j * 2) = bf1(bvv * e2); *(LAS bf16_t*)(im + CK_BK + (16 + tl) * 144 + j * 2) = bf1(k2 * e2);
                    *(LAS bf16_t*)(im + CK_AR + tl * 144 + j * 2) = bf1(-kn * e3); *(LAS bf16_t*)(im + CK_AR + (16 + tl) * 144 + j * 2) = bf1(rr2 * e1);
                    const unsigned bq = bf1(bvv * e4), kq = bf1(k2 * e4);
                    if (rg & 1) { bb2[rg >> 1] |= bq << 16; kb2[rg >> 1] |= kq << 16; } else { bb2[rg >> 1] = bq; kb2[rg >> 1] = kq; } }
                *(LAS u32x2*)(im + CK_BBT + j * 48 + (4 * kg) * 2) = (u32x2){bb2[0], bb2[1]}; *(LAS u32x2*)(im + CK_KBT + j * 48 + (4 * kg) * 2) = (u32x2){kb2[0], kb2[1]};
                if (kg == 0) *(LAS float*)(im + CK_GC + j * 4) = gC;
            }
            WSYNC();
#if defined(PROBE_STAMPS)
            const unsigned ts2_ = (unsigned)__builtin_amdgcn_s_memrealtime();
            if (blk == 0 && wave == 1 && lane == 0) ((volatile LAS unsigned*)(lds + 146432 + 320))[16 + 27] += ts2_ - ts1_;
#endif
            {
                f32x4 nacc = {0.f, 0.f, 0.f, 0.f};
#pragma unroll
                for (int ks = 0; ks < 2; ++ks) { const bf16x8 fa = *(const LAS bf16x8*)(im + CK_BK + l15 * 144 + (32 * ks + 8 * kg) * 2), fb = *(const LAS bf16x8*)(im + CK_AR + l15 * 144 + (32 * ks + 8 * kg) * 2); nacc = MFMA16(fa, fb, nacc); }
#pragma unroll
                for (int rg = 0; rg < 4; ++rg) nacc[rg] = ((4 * kg + rg) < l15) ? nacc[rg] : 0.f;
                float Tr[16];
#pragma unroll
                for (int t = 0; t < 16; ++t) { float acc_ = (l15 == t) ? 1.f : 0.f;
#pragma unroll
                    for (int s2 = 0; s2 < t; ++s2) acc_ += Tr[s2] * rl(nacc[s2 & 3], t + 16 * (s2 >> 2));
                    Tr[t] = acc_; }
                if (kg == 0) {
#pragma unroll
                    for (int t = 0; t < 16; ++t) *(LAS bf16_t*)(im + CK_TT + t * 48 + l15 * 2) = bf1(Tr[t]); }
            }
            WSYNC();
#if defined(PROBE_STAMPS)
            if (blk == 0 && wave == 1 && lane == 0) ((volatile LAS unsigned*)(lds + 146432 + 320))[16 + 28] += (unsigned)__builtin_amdgcn_s_memrealtime() - ts2_;
#endif
            if (lane == 0) flags[k % CK_NSLOT] = (unsigned)(k + 1);
            CK_ISSUE_B((k + 4 < NCH) ? t0 + 64 : t0);
        }
#undef CK_ISSUE
#undef CK_ISSUE_A
#undef CK_ISSUE_B
    } else if (wave <= 6) {
        const int gq = wave - 5;
        v4u ld[8];
#define G_ISSUE(T0) do { const int t0_ = (T0); const size_t r_ = rowb + t0_ + l15; const size_t rp_ = (t0_ + l15 == 0) ? r_ : r_ - 1; \
            _Pragma("unroll") for (int ks = 0; ks < 4; ++ks) { const int col = 1664 + 32 * ks + 8 * kg; ld[2 * ks] = *(const v4u*)(proj + r_ * L0P + col); ld[2 * ks + 1] = *(const v4u*)(proj + rp_ * L0P + col); } } while (0)
        G_ISSUE(16 * gq);
#pragma unroll 1
        for (int k = gq; k < NCH; k += 2) {
            const int t0 = 16 * k;
            f32x4 accg[2] = {(f32x4){0.f, 0.f, 0.f, 0.f}, (f32x4){0.f, 0.f, 0.f, 0.f}}; const float pz_ = (t0 + l15 == 0) ? 0.f : 1.f;
#pragma unroll
            for (int ks = 0; ks < 4; ++ks) { float s_[8];
                const f32x4 m0 = *(const LAS f32x4*)(mixs + 128 + 32 * ks + 8 * kg), m1 = *(const LAS f32x4*)(mixs + 128 + 32 * ks + 8 * kg + 4);
                RW_SH8(ld[2 * ks], ld[2 * ks + 1], m0, m1, s_, pz_);
#pragma unroll
                for (int j = 0; j < 8; ++j) s_[j] = sigmoid_fast(s_[j]);
                const bf16x8 af = pack8(s_[0], s_[1], s_[2], s_[3], s_[4], s_[5], s_[6], s_[7]);
#pragma unroll
                for (int nt = 0; nt < 2; ++nt) { const bf16x8 bfr = *(const bf16x8*)(G2T + (size_t)(h * 64 + ihalf * 32 + 16 * nt + l15) * 128 + 32 * ks + 8 * kg); accg[nt] = MFMA16(af, bfr, accg[nt]); } }
            G_ISSUE((k + 2 < NCH) ? t0 + 32 : t0);
#pragma unroll
            for (int nt = 0; nt < 2; ++nt)
#pragma unroll
                for (int rg = 0; rg < 4; ++rg) gout[(rowb + t0 + 4 * kg + rg) * 512 + h * 64 + ihalf * 32 + 16 * nt + l15] = bf1(accg[nt][rg]);
        }
#undef G_ISSUE
    }
#undef RW_SH8
    __syncthreads();
}

template <bool ST = true> __device__ __forceinline__ void rwkv_post_all(const float* __restrict__ yraw, const bf16_t* __restrict__ proj, const float* __restrict__ mix, const float* __restrict__ bonus, const bf16_t* __restrict__ gbuf,
                                              const float* __restrict__ ln_g, const float* __restrict__ ln_b, bf16_t* __restrict__ ymix, int gw, int NGW, int lane) {
    for (int m = gw; m < M; m += NGW) {
        const bool has_prev = (m & (SEQ - 1)) != 0;
        float y[8], cv[8], pv[8], gg[8], bo[8];
#pragma unroll
        for (int h = 0; h < 8; ++h) { const int c = h * 64 + lane; y[h] = yraw[(size_t)m * 512 + c]; cv[h] = bf2f(proj[(size_t)m * L0P + 1024 + c]);
            pv[h] = bf2f(proj[(size_t)(has_prev ? m - 1 : m) * L0P + 1024 + c]); gg[h] = bf2f(gbuf[(size_t)m * 512 + c]); bo[h] = bonus[(size_t)m * 8 + h]; }
#pragma unroll
        for (int h = 0; h < 8; ++h) { const int c = h * 64 + lane;
            const float mu = wave_sum_dpp(y[h]) * (1.f / 64.f), d = y[h] - mu, var = wave_sum_dpp(d * d) * (1.f / 64.f);
            const float yn = d * __builtin_amdgcn_rsqf(var + 64e-5f) * ln_g[c] + ln_b[c];
            const float pvv = has_prev ? pv[h] : 0.f;
            const float v_s = cv[h] + (pvv - cv[h]) * mix[1024 + c];
            const float o = (yn + bo[h] * v_s) * gg[h];
            if (ST) ymix[(size_t)m * DM + c] = (bf16_t)f2bf(o); else asm volatile("" :: "v"(o)); }
    }
}


__device__ __forceinline__ void ssd_conv_tile(int it, int lane, LAS bf16_t* scr, const bf16_t* __restrict__ proj, const float* __restrict__ cw, const float* __restrict__ cb,
                                              bf16_t* __restrict__ xbc, bf16_t* __restrict__ xst, bf16_t* __restrict__ bt) {
    const int tt = it >> 4, ct = it & 15, m0 = tt * 64, b = m0 >> 11, t0 = m0 & (SEQ - 1), c = ct * 64 + lane;
    const float w0 = cw[c], w1 = cw[1024 + c], w2 = cw[2048 + c], w3 = cw[3072 + c], bias = cb[c];
    const bf16_t* src = proj + (size_t)m0 * L0P + 2304 + c;
    bf16_t raw[67];
    const int lo = (t0 > 0) ? -3 : 0;
#pragma unroll
    for (int t = -3; t < 64; ++t) raw[t + 3] = src[(ptrdiff_t)((t < lo) ? lo : t) * L0P];
    float u3 = (t0 > 0) ? bf2f(raw[0]) : 0.f, u2 = (t0 > 0) ? bf2f(raw[1]) : 0.f, u1 = (t0 > 0) ? bf2f(raw[2]) : 0.f;
#pragma unroll
    for (int t = 0; t < 64; ++t) {
        const float u = bf2f(raw[t + 3]);
        const float y = bias + w0 * u3 + w1 * u2 + w2 * u1 + w3 * u;
        const bf16_t o = bf1(y * __builtin_amdgcn_rcpf(1.f + __expf(-y)));
        xbc[(size_t)(m0 + t) * 1024 + c] = o;
        scr[t * STG_PITCH + lane] = o;
        u3 = u2; u2 = u1; u1 = u;
    }
    WSYNC();
    if (ct < 12) {
        bf16_t* dst = (ct < 8) ? xst + ((size_t)(b * 8 + ct) * 64) * SEQ + t0 : bt + ((size_t)(b * 2 + ((ct - 8) >> 1)) * 128 + ((ct - 8) & 1) * 64) * SEQ + t0;
#pragma unroll
        for (int i = 0; i < 8; ++i) { const int d = i * 8 + (lane >> 3), tc = lane & 7; const LAS bf16_t* p = scr + (tc * 8) * STG_PITCH + d;
            v4u o; o.x = (unsigned)p[0] | ((unsigned)p[STG_PITCH] << 16); o.y = (unsigned)p[2 * STG_PITCH] | ((unsigned)p[3 * STG_PITCH] << 16);
            o.z = (unsigned)p[4 * STG_PITCH] | ((unsigned)p[5 * STG_PITCH] << 16); o.w = (unsigned)p[6 * STG_PITCH] | ((unsigned)p[7 * STG_PITCH] << 16);
            *(v4u*)(dst + (size_t)d * SEQ + tc * 8) = o; }
    }
    WSYNC();
}
__device__ __forceinline__ float bperm(int srclane, float x) { return __builtin_bit_cast(float, __builtin_amdgcn_ds_bpermute(srclane << 2, __builtin_bit_cast(int, x))); }
__device__ __forceinline__ void scan128(float& x0, float& x1, int lane) {
#pragma unroll
    for (int o = 1; o < 64; o <<= 1) { const int sl = (lane >= o) ? lane - o : lane; const float t0 = bperm(sl, x0), t1 = bperm(sl, x1); if (lane >= o) { x0 += t0; x1 += t1; } }
    x1 += rl(x0, 63);
}
__device__ __forceinline__ void ssd_s1_unit(int unit, int lane, LAS float* tab, const bf16_t* __restrict__ xst, const bf16_t* __restrict__ bt, const float* __restrict__ dt, const float* __restrict__ a_log,
                                            float* __restrict__ sloc, float* __restrict__ asum) {
    const int h = unit & 7, c = (unit >> 3) & 15, b = unit >> 7, g = h >> 2, l0 = c * 128, l31 = lane & 31, hi = lane >> 5;
    const size_t m0 = (size_t)b * SEQ + l0;
    const float A = -expf(a_log[h]);
    const float d0 = dt[(m0 + lane) * 8 + h], d1 = dt[(m0 + 64 + lane) * 8 + h];
    float ac0 = d0 * A, ac1 = d1 * A;
    scan128(ac0, ac1, lane);
    const float aend = rl(ac1, 63);
    tab[lane] = __expf(aend - ac0) * d0; tab[64 + lane] = __expf(aend - ac1) * d1;
    if (lane == 0) asum[unit] = aend;
    WSYNC();
    f32x16 acc[2][4];
#pragma unroll
    for (int pt = 0; pt < 2; ++pt)
#pragma unroll
        for (int nt = 0; nt < 4; ++nt)
#pragma unroll
            for (int r = 0; r < 16; ++r) acc[pt][nt][r] = 0.f;
    const bf16_t* Xp = xst + ((size_t)(b * 8 + h) * 64 + l31) * SEQ + l0 + 8 * hi;
    const bf16_t* Bp = bt + ((size_t)(b * 2 + g) * 128 + l31) * SEQ + l0 + 8 * hi;
#pragma unroll 2
    for (int kk = 0; kk < 8; ++kk) {
        const f32x4 wa = *(const LAS f32x4*)(tab + 16 * kk + 8 * hi), wb = *(const LAS f32x4*)(tab + 16 * kk + 8 * hi + 4);
        bf16x8 af[2], bfr[4];
#pragma unroll
        for (int pt = 0; pt < 2; ++pt) { const v4u raw = *(const v4u*)(Xp + (size_t)pt * 32 * SEQ + 16 * kk);
            v4u w; w.x = cvtpk(bflo(raw.x) * wa[0], bfhi(raw.x) * wa[1]); w.y = cvtpk(bflo(raw.y) * wa[2], bfhi(raw.y) * wa[3]);
            w.z = cvtpk(bflo(raw.z) * wb[0], bfhi(raw.z) * wb[1]); w.w = cvtpk(bflo(raw.w) * wb[2], bfhi(raw.w) * wb[3]); af[pt] = __builtin_bit_cast(bf16x8, w); }
#pragma unroll
        for (int nt = 0; nt < 4; ++nt) bfr[nt] = *(const bf16x8*)(Bp + (size_t)nt * 32 * SEQ + 16 * kk);
#pragma unroll
        for (int pt = 0; pt < 2; ++pt)
#pragma unroll
            for (int nt = 0; nt < 4; ++nt) acc[pt][nt] = MFMA32(af[pt], bfr[nt], acc[pt][nt]);
    }
    float* dst = sloc + (size_t)unit * 8192 + l31;
#pragma unroll
    for (int pt = 0; pt < 2; ++pt)
#pragma unroll
        for (int nt = 0; nt < 4; ++nt)
#pragma unroll
            for (int r = 0; r < 16; ++r) dst[(32 * pt + crow(r, hi)) * 128 + 32 * nt] = acc[pt][nt][r];
    WSYNC();
}
__device__ __forceinline__ void ssd_s2_all(const float* __restrict__ sloc, const float* __restrict__ asum, bf16_t* __restrict__ stb, int gtid, int NT) {
    for (int i = gtid; i < 128 * 2048; i += NT) {
        const int bh = i >> 11, e4 = i & 2047, b = bh >> 3, h = bh & 7;
        f32x4 run = {0.f, 0.f, 0.f, 0.f};
#pragma unroll 4
        for (int c = 0; c < 16; ++c) { const int unit = (b * 16 + c) * 8 + h; const f32x4 tmp = *(const f32x4*)(sloc + (size_t)unit * 8192 + e4 * 4);
            uint2 w; w.x = cvtpk(run[0], run[1]); w.y = cvtpk(run[2], run[3]); *(uint2*)(stb + (size_t)unit * 8192 + e4 * 4) = w;
            run = run * __expf(asum[unit]) + tmp; }
    }
}
__device__ __forceinline__ void ssd_s3_unit(int unit, int lane, LAS float* tab, const bf16_t* __restrict__ xbc, const bf16_t* __restrict__ xst, const bf16_t* __restrict__ stb, const float* __restrict__ dt,
                                            const float* __restrict__ a_log, const float* __restrict__ dsk, bf16_t* __restrict__ yssm) {
    const int h = unit & 7, c = (unit >> 3) & 15, b = unit >> 7, g = h >> 2, l0 = c * 128, l31 = lane & 31, hi = lane >> 5;
    const size_t m0 = (size_t)b * SEQ + l0;
    const float A = -expf(a_log[h]), D = dsk[h];
    const float d0 = dt[(m0 + lane) * 8 + h], d1 = dt[(m0 + 64 + lane) * 8 + h];
    float ac0 = d0 * A, ac1 = d1 * A;
    scan128(ac0, ac1, lane);
    tab[lane] = ac0; tab[64 + lane] = ac1; tab[128 + lane] = d0; tab[192 + lane] = d1;
    WSYNC();
    const bf16_t* Cp = xbc + (m0 + l31) * 1024 + 768 + g * 128 + 8 * hi;
    const bf16_t* Sp = stb + (size_t)unit * 8192 + l31 * 128 + 8 * hi;
    const bf16_t* Bp = xbc + (m0 + l31) * 1024 + 512 + g * 128 + 8 * hi;
    const bf16_t* Xp = xst + ((size_t)(b * 8 + h) * 64 + l31) * SEQ + l0 + 4 * hi;
    LAS float* tr = tab + 256;
    const int row = lane >> 1, p0 = (lane & 1) * 16;
#pragma unroll 1
    for (int lt = 0; lt < 4; ++lt) {
        f32x16 y[2];
#pragma unroll
        for (int r = 0; r < 16; ++r) { y[0][r] = 0.f; y[1][r] = 0.f; }
        const float acl = tab[32 * lt + l31];
#pragma unroll 4
        for (int kk = 0; kk < 8; ++kk) {
            const bf16x8 cf = *(const bf16x8*)(Cp + (size_t)lt * 32 * 1024 + 16 * kk);
            const bf16x8 s0 = *(const bf16x8*)(Sp + 16 * kk), s1 = *(const bf16x8*)(Sp + 32 * 128 + 16 * kk);
            y[0] = MFMA32(s0, cf, y[0]); y[1] = MFMA32(s1, cf, y[1]);
        }
        { const float el = __expf(acl);
#pragma unroll
          for (int r = 0; r < 16; ++r) { y[0][r] *= el; y[1][r] *= el; } }
#pragma unroll 1
        for (int st = 0; st <= lt; ++st) {
            f32x16 cbt;
#pragma unroll
            for (int r = 0; r < 16; ++r) cbt[r] = 0.f;
#pragma unroll 4
            for (int kk = 0; kk < 8; ++kk) { const bf16x8 bf_ = *(const bf16x8*)(Bp + (size_t)st * 32 * 1024 + 16 * kk), cf_ = *(const bf16x8*)(Cp + (size_t)lt * 32 * 1024 + 16 * kk); cbt = MFMA32(bf_, cf_, cbt); }
#pragma unroll
            for (int r = 0; r < 16; ++r) { const int sl = 32 * st + crow(r, hi); const float acs = tab[sl], dts = tab[128 + sl];
                float v = cbt[r] * __expf(acl - acs) * dts; if (st == lt && crow(r, hi) > l31) v = 0.f; cbt[r] = v; }
            bf16x8 pf[2];
#pragma unroll
            for (int ks = 0; ks < 2; ++ks) { v4u w; w.x = cvtpk(cbt[8 * ks], cbt[8 * ks + 1]); w.y = cvtpk(cbt[8 * ks + 2], cbt[8 * ks + 3]); w.z = cvtpk(cbt[8 * ks + 4], cbt[8 * ks + 5]); w.w = cvtpk(cbt[8 * ks + 6], cbt[8 * ks + 7]); pf[ks] = __builtin_bit_cast(bf16x8, w); }
#pragma unroll
            for (int pt = 0; pt < 2; ++pt)
#pragma unroll
                for (int ks = 0; ks < 2; ++ks) { const bf16_t* xp = Xp + (size_t)pt * 32 * SEQ + st * 32 + 16 * ks; const u32x2 x0 = *(const u32x2*)xp, x1 = *(const u32x2*)(xp + 8);
                    v4u a; a.x = x0.x; a.y = x0.y; a.z = x1.x; a.w = x1.y; y[pt] = MFMA32(__builtin_bit_cast(bf16x8, a), pf[ks], y[pt]); }
        }
#pragma unroll
        for (int pt = 0; pt < 2; ++pt) {
#pragma unroll
            for (int r = 0; r < 16; ++r) tr[l31 * 33 + crow(r, hi)] = y[pt][r];
            WSYNC();
            const size_t m = m0 + 32 * lt + row;
            const v4u xa = *(const v4u*)(xbc + m * 1024 + h * 64 + 32 * pt + p0), xb = *(const v4u*)(xbc + m * 1024 + h * 64 + 32 * pt + p0 + 8);
            const unsigned xu[8] = {xa.x, xa.y, xa.z, xa.w, xb.x, xb.y, xb.z, xb.w};
            unsigned ow[8];
#pragma unroll
            for (int q = 0; q < 8; ++q) { const float v0 = tr[row * 33 + p0 + 2 * q] + D * bflo(xu[q]), v1 = tr[row * 33 + p0 + 2 * q + 1] + D * bfhi(xu[q]); ow[q] = cvtpk(v0, v1); }
            bf16_t* dst = yssm + m * 512 + h * 64 + 32 * pt + p0;
            *(v4u*)dst = (v4u){ow[0], ow[1], ow[2], ow[3]}; *(v4u*)(dst + 8) = (v4u){ow[4], ow[5], ow[6], ow[7]};
            WSYNC();
        }
    }
}

struct Args { const float* in[43]; float* out; unsigned char* ws; };
#define GEMM_PHASE(EPI, Aptr, LDA, Bptr, LDB, NN, KK, ...) do { pg8::Gemm g_{(Aptr), (Bptr), M, (NN), (KK), (LDA), (LDB)}; pg8::StaticOrder S_; S_.init(M, (NN), G, (int)blockIdx.x); \
        pg8::EPI E_{__VA_ARGS__}; pg8::gemm_phase<pg8::EPI, pg8::StaticOrder, true, true>(lds3, g_, S_, E_); } while (0)

__global__ void __launch_bounds__(NWAVES * 64, 2) fwd_mega(Args args) {
    extern __shared__ __attribute__((aligned(16))) unsigned char lds[];
    LAS unsigned char* lds3 = (LAS unsigned char*)lds;
    volatile LAS unsigned* MISC = (volatile LAS unsigned*)(lds3 + MISC_OFF);
    const int G = gridDim.x, NGW = G * NWAVES, NT = G * NWAVES * 64;
#define PHASE_IDS() int tid = threadIdx.x; asm volatile("" : "+v"(tid)); const int lane = tid & 63, wave = __builtin_amdgcn_readfirstlane(tid >> 6); const int gw = blockIdx.x * NWAVES + wave, gtid = blockIdx.x * (NWAVES * 64) + tid; (void)lane; (void)gw; (void)gtid
    unsigned char* ws = args.ws;
    gu32* ctl = (gu32*)(ws + WS_CTL);
    for (int u = threadIdx.x; u < (LDS_BYTES - LDSCTL_OFF) / 4; u += NWAVES * 64) ((LAS unsigned*)(lds3 + LDSCTL_OFF))[u] = 0u;
    __syncthreads();
    XcdBarrier bar = xcd_barrier_post((unsigned*)(ctl + CW_BAR), MISC + 8);
#if defined(PROBE_STAMPS)
    int nb_ = 0;
    if (blockIdx.x == 0 && threadIdx.x == 0) MISC[16] = (unsigned)__builtin_amdgcn_s_memrealtime();
#define GRID_BAR() do { xcd_barrier(bar); ++nb_; if (blockIdx.x == 0 && threadIdx.x == 0) MISC[16 + nb_] = (unsigned)__builtin_amdgcn_s_memrealtime(); } while (0)
#else
#define GRID_BAR() xcd_barrier(bar)
#endif
#define IN(i) (args.in[i])
    float* out = args.out;
    bf16_t* W0in = (bf16_t*)(ws + WS_W0IN); bf16_t* W0out = (bf16_t*)(ws + WS_W0OUT); bf16_t* Wup0 = (bf16_t*)(ws + WS_WUP0); bf16_t* Wdn0 = (bf16_t*)(ws + WS_WDN0);
    bf16_t* W1in = (bf16_t*)(ws + WS_W1IN); bf16_t* Wuq = (bf16_t*)(ws + WS_WUQ); bf16_t* Wukv = (bf16_t*)(ws + WS_WUKV); bf16_t* W1out = (bf16_t*)(ws + WS_W1OUT);
    bf16_t* Wup1 = (bf16_t*)(ws + WS_WUP1); bf16_t* Wdn1 = (bf16_t*)(ws + WS_WDN1);
    bf16_t* XB = (bf16_t*)(ws + WS_XB); bf16_t* YMIX = (bf16_t*)(ws + WS_YMIX); bf16_t* PROJ0 = (bf16_t*)(ws + WS_BIG);
    float* YRAW = out; bf16_t* YSSM = (bf16_t*)(out + (size_t)M * 512); bf16_t* STB = (bf16_t*)(out + (size_t)M * 768); bf16_t* XST = (bf16_t*)(ws + WS_XST); bf16_t* BT = (bf16_t*)(ws + WS_BT); float* ASUM = (float*)(ws + WS_ASUM); float* SLOC = (float*)(ws + WS_SLOC); float* DT = (float*)(ws + WS_DT); bf16_t* GB = (bf16_t*)(ws + WS_G); float* BONUS = (float*)(ws + WS_BONUS);
    bf16_t* W2T = (bf16_t*)(ws + WS_W2T); bf16_t* A2T = (bf16_t*)(ws + WS_A2T); bf16_t* G2T = (bf16_t*)(ws + WS_G2T); bf16_t* ACT = (bf16_t*)(ws + WS_GU); bf16_t* HALO = (bf16_t*)(ws + WS_GU + 176 * MiB);
    bf16_t* PROJ1 = (bf16_t*)(ws + WS_PROJ1); bf16_t* QM = (bf16_t*)(ws + WS_QM); bf16_t* KVM = (bf16_t*)(ws + WS_KVM); bf16_t* KPE = (bf16_t*)(ws + WS_KPE); float* RS = (float*)(ws + WS_RS); float* CSTAB = (float*)(ws + WS_CSTAB); float* STATS = (float*)(ws + WS_CSTAB + 4 * MiB); bf16_t* VTS = (bf16_t*)(ws + WS_VTS); bf16_t* VTM = (bf16_t*)(ws + WS_VTM);
    const int* pos = (const int*)args.in[1];

    {
        PHASE_IDS();
    {
        LAS float* scr = (LAS float*)(lds3 + wave * 16384);
        transpose_matrix(IN(2), 1024, 3336, W0in, L0P, 1024, scr, gw, NGW, lane, nullptr);
        transpose_matrix(IN(20), 1024, 1024, W0out, 1024, 1024, scr, gw, NGW, lane, nullptr);
        transpose_matrix(IN(23), 1024, 5632, Wup0, 5632, 1024, scr, gw, NGW, lane, nullptr, true);
        transpose_matrix(IN(26), 2816, 1024, Wdn0, 1024, 2816, scr, gw, NGW, lane, nullptr);
        transpose_matrix(IN(29), 1024, 1952, W1in, L1P, 1024, scr, gw, NGW, lane, nullptr);
        transpose_matrix(IN(31), 256, 768, Wuq, 768, 256, scr, gw, NGW, lane, IN(30));
        transpose_matrix(IN(33), 128, 1024, Wukv, 1024, 256, scr, gw, NGW, lane, IN(32));
        for (int i = gtid; i < 1024 * 16; i += NT) { const int n = i >> 4, c = i & 15; *(v4u*)(Wukv + (size_t)n * 256 + 128 + c * 8) = (v4u){0u, 0u, 0u, 0u}; }
        transpose_matrix(IN(34), 1024, 1024, W1out, 1024, 1024, scr, gw, NGW, lane, nullptr);
        transpose_matrix(IN(37), 1024, 5632, Wup1, 5632, 1024, scr, gw, NGW, lane, nullptr, true);
        transpose_matrix(IN(40), 2816, 1024, Wdn1, 1024, 2816, scr, gw, NGW, lane, nullptr);
        transpose_matrix(IN(5), 64, 512, W2T, 512, 64, scr, gw, NGW, lane, nullptr);
        transpose_matrix(IN(7), 64, 512, A2T, 512, 64, scr, gw, NGW, lane, nullptr);
        transpose_matrix(IN(8), 128, 512, G2T, 512, 128, scr, gw, NGW, lane, nullptr);
        const float* x = IN(0);
        {
            constexpr size_t TOT4 = (size_t)M * DM / 4;
            for (size_t i = gtid; i < TOT4; i += (size_t)NT * 8) {
                f32x4 v[8];
#pragma unroll
                for (int u = 0; u < 8; ++u) v[u] = *(const f32x4*)(x + (i + (size_t)u * NT) * 4);
#pragma unroll
                for (int u = 0; u < 8; ++u) { uint2 w; w.x = cvtpk(v[u][0], v[u][1]); w.y = cvtpk(v[u][2], v[u][3]); *(uint2*)(XB + (i + (size_t)u * NT) * 4) = w; }
            }
        }
    }
    }
    GRID_BAR();
    {
        PHASE_IDS();
    GEMM_PHASE(EpiBf16S, XB, DM, W0in, 1024, L0P, 1024, PROJ0, nullptr, L0P, 0);
    }
    GRID_BAR();
    {
        PHASE_IDS();
        const int blk = (int)blockIdx.x, m0 = blk * 128;
        {   LAS bf16_t* scr = (LAS bf16_t*)(lds3 + wave * 16384);
#pragma unroll 1
            for (int k = 0; k < 4; ++k) ssd_conv_tile((2 * blk + (k & 1)) * 16 + wave + 8 * (k >> 1), lane, scr, PROJ0, IN(14), IN(15), XB, XST, BT);
            for (int i = tid; i < 1024; i += NWAVES * 64) { const int m = m0 + (i >> 3); DT[(size_t)m * 8 + (i & 7)] = softplusf_(bf2f(PROJ0[(size_t)m * L0P + 3328 + (i & 7)]) + IN(16)[i & 7]); }
        }
        __syncthreads();
#if defined(PROBE_STAMPS)
        if (blockIdx.x == 0 && threadIdx.x == 0) MISC[16 + 29] = (unsigned)__builtin_amdgcn_s_memrealtime();
#endif
        ssd_s1_unit(blk * 8 + wave, lane, (LAS float*)(lds3 + wave * 16384), XST, BT, DT, IN(17), SLOC, ASUM);
    }
    GRID_BAR();
    {
        PHASE_IDS();
        ssd_s2_all(SLOC, ASUM, STB, gtid, NT);
#if defined(PROBE_STAMPS)
        __syncthreads(); if (blockIdx.x == 0 && threadIdx.x == 0) MISC[16 + 23] = (unsigned)__builtin_amdgcn_s_memrealtime();
#endif
        rwkv_phase((LAS float*)lds3, tid, lane, wave, (int)blockIdx.x, PROJ0, IN(3), IN(4), IN(6), IN(9), IN(10), IN(11), W2T, A2T, G2T, YRAW, GB, BONUS);
    }
    GRID_BAR();
    {
        PHASE_IDS();
        const int blk = (int)blockIdx.x;
        ssd_s3_unit(blk * 8 + wave, lane, (LAS float*)(lds3 + wave * 16384), XB, XST, STB, DT, IN(17), IN(18), YSSM);
        __syncthreads();
        ssm_gate_norm_all(YSSM, PROJ0, IN(19), YMIX, blk * 256 + wave, blk * 256 + 256, lane);
        rwkv_post_all(YRAW, PROJ0, IN(3), BONUS, GB, IN(12), IN(13), YMIX, gw, NGW, lane);
    }
    GRID_BAR();
    {
        PHASE_IDS();
    GEMM_PHASE(EpiResid, YMIX, DM, W0out, 1024, 1024, 1024, IN(0), out, ALPHA, 0);
    }
    GRID_BAR();
    {
        PHASE_IDS();
    ln_rows<1>(out, XB, STATS, IN(21), IN(22), gw, NGW, lane);
    }
    GRID_BAR();
    {
        PHASE_IDS();
        { pg8::Gemm g_{XB, Wup0, M / 32, DFF, 1024, DM, 1024, 4096, 8192, 256, 512, 1}; pg8::StaticOrder S_; S_.init(M / 32, DFF, G, (int)blockIdx.x);
          pg8::EpiBf16S E_{HALO, nullptr, DFF, 0}; pg8::gemm_phase<pg8::EpiBf16S, pg8::StaticOrder, true, true>(lds3, g_, S_, E_); }
    }
    GRID_BAR();
    {
        PHASE_IDS();
        { pg8::Gemm g_{XB, Wup0, M, 2 * DFF, 1024, DM, 1024}; pg8::StaticOrder S_; S_.init(M, 2 * DFF, G, (int)blockIdx.x);
          pg8::EpiConvAct E_{ACT, HALO, IN(24), IN(25), DFF, SEQ}; pg8::gemm_phase<pg8::EpiConvAct, pg8::StaticOrder, true, true>(lds3, g_, S_, E_); }
    }
    GRID_BAR();
    {
        PHASE_IDS();
    GEMM_PHASE(EpiResidLN, ACT, DFF, Wdn0, DFF, 1024, DFF, out, STATS, IN(21), IN(22), ALPHA, 0);
    }
    GRID_BAR();
    {
        PHASE_IDS();
    ln_rows<1>(out, XB, STATS, IN(27), IN(28), gw, NGW, lane);
    }
    GRID_BAR();
    {
        PHASE_IDS();
    GEMM_PHASE(EpiBf16S, XB, DM, W1in, 1024, L1P, 1024, PROJ1, nullptr, L1P, 0);
    }
    GRID_BAR();
    {
        PHASE_IDS();
    mla_prep_all(PROJ1, pos, RS, KPE, CSTAB, gw, NGW, lane);
    }
    GRID_BAR();
    {
        PHASE_IDS();
    GEMM_PHASE(EpiBf16S, PROJ1 + 1536, L1P, Wuq, 256, 768, 256, QM, RS, 768, 2);
    GEMM_PHASE(EpiBf16S, PROJ1 + 1792, L1P, Wukv, 256, 1024, 256, KVM, RS + 1, 1024, 2);
    }
    GRID_BAR();
    {
        PHASE_IDS();
    rope_q_all(QM, CSTAB, gtid, NT);
    {
        LAS bf16_t* scr = (LAS bf16_t*)(lds3 + wave * 16384);
        for (int it = gw; it < 8192; it += NGW) { const int which = it >> 12, r = it & 4095, bh = r >> 5, tt = r & 31, b = bh >> 3, h = bh & 7;
            if (which == 0) transpose_tile64(PROJ1 + ((size_t)b * SEQ + tt * 64) * L1P + 1024 + h * 64, L1P, VTS + (size_t)bh * 64 * SEQ + tt * 64, SEQ, scr, lane);
            else            transpose_tile64(KVM + ((size_t)b * SEQ + tt * 64) * 1024 + h * 128 + 64, 1024, VTM + (size_t)bh * 64 * SEQ + tt * 64, SEQ, scr, lane); }
    }
    }
    GRID_BAR();
    {
        PHASE_IDS();
    {
        for (int g2 = (int)blockIdx.x; g2 < 256; g2 += G) { const int bh = g2 >> 1, part = g2 & 1;
#pragma unroll 1
            for (int i = 0; i < 4; ++i) { const int sbk = part ? ((i == 0) ? 1 : (i == 1) ? 6 : (i == 2) ? 2 : 5) : ((i == 0) ? 0 : (i == 1) ? 7 : (i == 2) ? 3 : 4);
                sb_block(bh, sbk, tid, lane, wave, lds3, PROJ1, VTS, YMIX); } }
        for (int g2 = (int)blockIdx.x; g2 < 256; g2 += G) { const int bh = g2 >> 1, part = g2 & 1;
#pragma unroll 1
            for (int i = 0; i < 4; ++i) { const int sbk = part ? ((i == 0) ? 1 : (i == 1) ? 6 : (i == 2) ? 2 : 5) : ((i == 0) ? 0 : (i == 1) ? 7 : (i == 2) ? 3 : 4);
                mla_block(bh, sbk, tid, lane, wave, lds3, QM, KVM, KPE, VTM, YMIX); } }
    }
    }
    GRID_BAR();
    {
        PHASE_IDS();
    GEMM_PHASE(EpiResidLN, YMIX, DM, W1out, 1024, 1024, 1024, out, STATS, IN(27), IN(28), ALPHA, 0);
    }
    GRID_BAR();
    {
        PHASE_IDS();
    ln_rows<1>(out, XB, STATS, IN(35), IN(36), gw, NGW, lane);
    }
    GRID_BAR();
    {
        PHASE_IDS();
        { pg8::Gemm g_{XB, Wup1, M / 32, DFF, 1024, DM, 1024, 4096, 8192, 256, 512, 1}; pg8::StaticOrder S_; S_.init(M / 32, DFF, G, (int)blockIdx.x);
          pg8::EpiBf16S E_{HALO, nullptr, DFF, 0}; pg8::gemm_phase<pg8::EpiBf16S, pg8::StaticOrder, true, true>(lds3, g_, S_, E_); }
    }
    GRID_BAR();
    {
        PHASE_IDS();
        { pg8::Gemm g_{XB, Wup1, M, 2 * DFF, 1024, DM, 1024}; pg8::StaticOrder S_; S_.init(M, 2 * DFF, G, (int)blockIdx.x);
          pg8::EpiConvAct E_{ACT, HALO, IN(38), IN(39), DFF, SEQ}; pg8::gemm_phase<pg8::EpiConvAct, pg8::StaticOrder, true, true>(lds3, g_, S_, E_); }
    }
    GRID_BAR();
    {
        PHASE_IDS();
    GEMM_PHASE(EpiResidLN, ACT, DFF, Wdn1, DFF, 1024, DFF, out, STATS, IN(35), IN(36), ALPHA, 0);
    }
    GRID_BAR();
    {
        PHASE_IDS();
    ln_rows<2>(out, XB, STATS, IN(41), IN(42), gw, NGW, lane);
    #if defined(PROBE_STAMPS)
    __syncthreads();
    if (blockIdx.x == 0 && threadIdx.x == 0) {
        MISC[16 + 22] = (unsigned)__builtin_amdgcn_s_memrealtime();
#if defined(PROBE_ACC)
        const unsigned d1 = MISC[16 + PROBE_ACC];
#else
        const unsigned d1 = MISC[16 + PROBE_T1_HI] - MISC[16 + PROBE_T1_LO];
#endif
        const unsigned long long spin = 100ull * d1;
        const unsigned long long t0 = __builtin_amdgcn_s_memrealtime();
        while (__builtin_amdgcn_s_memrealtime() - t0 < spin) __builtin_amdgcn_s_sleep(8);
    }
#endif
}
}

extern "C" void kernel_launch(void* const* d_in, const int* in_sizes, int n_in, void* d_out, int out_size, void* d_ws, size_t ws_size, hipStream_t stream) {
    static int grid = 0;
    if (grid == 0) {
        if (n_in != 43 || ws_size < WS_NEED || out_size != M * DM) { fprintf(stderr, "kernel_launch: unexpected n_in %d / ws %zu / out %d\n", n_in, ws_size, out_size); grid = -1; return; }
        int dev = 0, cus = 0, per_cu = 0;
        if (hipGetDevice(&dev) != hipSuccess || hipDeviceGetAttribute(&cus, hipDeviceAttributeMultiprocessorCount, dev) != hipSuccess) { grid = -1; return; }
        if (hipFuncSetAttribute((const void*)fwd_mega, hipFuncAttributeMaxDynamicSharedMemorySize, LDS_BYTES) != hipSuccess) { fprintf(stderr, "kernel_launch: hipFuncSetAttribute failed\n"); grid = -1; return; }
        if (hipOccupancyMaxActiveBlocksPerMultiprocessor(&per_cu, (const void*)fwd_mega, NWAVES * 64, LDS_BYTES) != hipSuccess || per_cu < 1) fprintf(stderr, "kernel_launch: occupancy query reports %d\n", per_cu);
        (void)hipGetLastError();
        grid = cus;
    }
    if (grid < 0) return;
    (void)hipMemsetAsync((char*)d_ws + WS_CTL, 0, CTL_ZERO_BYTES, stream);
    Args a{};
    for (int i = 0; i < 43; ++i) a.in[i] = (const float*)d_in[i];
    a.out = (float*)d_out; a.ws = (unsigned char*)d_ws;
    hipLaunchKernelGGL(fwd_mega, dim3(grid), dim3(NWAVES * 64), LDS_BYTES, stream, a);
}
```

```cpp
#include <hip/hip_runtime.h>
#include <cstdio>
#include <cstdint>
#include <cmath>
namespace pg8 {
#define PG8_LAS __attribute__((address_space(3)))
typedef unsigned short bf16_t;
typedef short bf16x8 __attribute__((ext_vector_type(8)));
typedef float f32x4 __attribute__((ext_vector_type(4)));
typedef unsigned u32x4 __attribute__((ext_vector_type(4)));
constexpr int BM = 256, BK = 64, HALF = 128, HTB = HALF * BK * 2  , STAGE_BYTES = 8 * HTB, NXCD = 8, WGM = 8;

__host__ __device__ __forceinline__ int lds_byte(int r, int c) { const int st = (r >> 4) * 2 + (c >> 5), rr = r & 15, cc = c & 31, ob = rr * 64 + cc * 2; return st * 1024 + (ob ^ (((ob >> 9) & 1) << 5)); }
__host__ __device__ __forceinline__ void stage_rc(int b, int& R, int& C) { const int st = b / 1024, sb = b % 1024, swz = sb ^ (((sb >> 9) & 1) << 5); R = (st >> 1) * 16 + swz / 64; C = (st & 1) * 32 + (swz % 64) / 2; }
__host__ __device__ __forceinline__ int perm32(int rho) { const int n = rho >> 4, i = rho & 15; return 8 * (i >> 2) + 4 * n + (i & 3); }

struct Unit { int pm, pn; };
struct Gemm { const bf16_t* A; const bf16_t* Bt; int M, N, K, lda, ldb; int hrA = 128, trA = 256, hrB = 128, trB = 256, gatherA = 0; };

struct StaticOrder {
    int nM, nN, nwg, G, c;
    __host__ __device__ void init(int M, int N, int G_, int c_) { nM = M / BM; nN = N / BM; nwg = nM * nN; G = G_; c = c_; }
    __host__ __device__ bool next(int i, Unit& u) const {
        const long L = (long)i * G + c; if (L >= nwg) return false;
        int wgid = (int)L; { const int q = nwg / NXCD, r = nwg % NXCD, xcd = wgid % NXCD, off = wgid / NXCD; wgid = (xcd < r ? xcd * (q + 1) : r * (q + 1) + (xcd - r) * q) + off; }
        const int nig = WGM * nN, gid = wgid / nig, fm = gid * WGM, gsz = (nM - fm) < WGM ? (nM - fm) : WGM;
        u.pm = fm + ((wgid % nig) % gsz); u.pn = (wgid % nig) / gsz; return true;
    }
    __device__ __forceinline__ void a_ready(const Unit&) const {}
    __device__ __forceinline__ void done(const Unit&) const {}
};


__device__ __forceinline__ unsigned cvt_pk_bf16(float lo, float hi) { unsigned r; asm volatile("v_cvt_pk_bf16_f32 %0, %1, %2" : "=v"(r) : "v"(lo), "v"(hi)); return r; }
struct EpiBf16S {
    static constexpr bool PERM = true, AFTER_DRAIN = false;
    bf16_t* O; const float* rowscale; int ldc; int rs_stride;
    __device__ __forceinline__ void operator()(const f32x4 (&acc)[2][2][4][2], const Unit& u, int wr, int wc, int fr, int fq) const {
        const int row0 = u.pm * BM + wr * 64 + fr, col0 = u.pn * BM + wc * 32 + 8 * fq;
#pragma unroll
        for (int ai = 0; ai < 2; ++ai)
#pragma unroll
            for (int m = 0; m < 4; ++m) { const int row = row0 + ai * HALF + m * 16; const float sc = rowscale ? rowscale[(size_t)row * rs_stride] : 1.f;
                bf16_t* rowp = O + (size_t)row * ldc + col0;
#pragma unroll
                for (int bj = 0; bj < 2; ++bj) { const f32x4 v0 = acc[ai][bj][m][0] * sc, v1 = acc[ai][bj][m][1] * sc;
                    u32x4 w; w.x = cvt_pk_bf16(v0[0], v0[1]); w.y = cvt_pk_bf16(v0[2], v0[3]); w.z = cvt_pk_bf16(v1[0], v1[1]); w.w = cvt_pk_bf16(v1[2], v1[3]);
                    *(u32x4*)(rowp + bj * HALF) = w; } }
    }
};
struct EpiResid {
    static constexpr bool PERM = false, AFTER_DRAIN = false;
    const float* hin; float* hout; float alpha; int pad;
    __device__ __forceinline__ void operator()(const f32x4 (&acc)[2][2][4][2], const Unit& u, int wr, int wc, int fr, int fq) const {
        const int row0 = u.pm * BM + wr * 64 + fr, col0 = u.pn * BM + wc * 32 + 4 * fq;
#pragma unroll
        for (int ai = 0; ai < 2; ++ai)
#pragma unroll
            for (int m = 0; m < 4; ++m) { const size_t off = (size_t)(row0 + ai * HALF + m * 16) * 1024 + col0;
#pragma unroll
                for (int bj = 0; bj < 2; ++bj)
#pragma unroll
                    for (int n = 0; n < 2; ++n) { const size_t i = off + bj * HALF + n * 16; const f32x4 h = *(const f32x4*)(hin + i); *(f32x4*)(hout + i) = h * alpha + acc[ai][bj][m][n]; } }
    }
};

struct EpiResidLN {
    static constexpr bool PERM = false, AFTER_DRAIN = false;
    float* hio; const float* stats; const float* g; const float* b; float alpha; int pad;
    __device__ __forceinline__ void operator()(const f32x4 (&acc)[2][2][4][2], const Unit& u, int wr, int wc, int fr, int fq) const {
        const int row0 = u.pm * BM + wr * 64 + fr, col0 = u.pn * BM + wc * 32 + 4 * fq;
        f32x4 gg[2][2], bb[2][2];
#pragma unroll
        for (int bj = 0; bj < 2; ++bj)
#pragma unroll
            for (int n = 0; n < 2; ++n) { gg[bj][n] = *(const f32x4*)(g + col0 + bj * HALF + n * 16) * alpha; bb[bj][n] = *(const f32x4*)(b + col0 + bj * HALF + n * 16) * alpha; }
#pragma unroll
        for (int ai = 0; ai < 2; ++ai)
#pragma unroll
            for (int m = 0; m < 4; ++m) { const int row = row0 + ai * HALF + m * 16; const size_t off = (size_t)row * 1024 + col0;
                const float mu = stats[2 * row], rs = stats[2 * row + 1];
#pragma unroll
                for (int bj = 0; bj < 2; ++bj)
#pragma unroll
                    for (int n = 0; n < 2; ++n) { const size_t i = off + bj * HALF + n * 16; const f32x4 p = *(const f32x4*)(hio + i); *(f32x4*)(hio + i) = (p - mu) * rs * gg[bj][n] + bb[bj][n] + acc[ai][bj][m][n]; } }
    }
};

template <int CTRL> __device__ __forceinline__ float pg_dpp(float x) { return __builtin_bit_cast(float, __builtin_amdgcn_update_dpp(0, __builtin_bit_cast(int, x), CTRL, 0xF, 0xF, true)); }
struct EpiConvAct {
    static constexpr bool PERM = true, AFTER_DRAIN = false;
    bf16_t* act; const bf16_t* halo; const float* cw; const float* cb; int dff; int seq;
    __device__ __forceinline__ void operator()(const f32x4 (&acc)[2][2][4][2], const Unit& u, int wr, int wc, int fr, int fq) const {
        typedef unsigned u32x2e __attribute__((ext_vector_type(2)));
#pragma unroll
        for (int n = 0; n < 2; ++n) {
            const int ch0 = u.pn * 128 + wc * 32 + 8 * fq + 4 * n;
            const f32x4 w0 = *(const f32x4*)(cw + ch0), w1 = *(const f32x4*)(cw + dff + ch0), w2 = *(const f32x4*)(cw + 2 * dff + ch0), bb = *(const f32x4*)(cb + ch0);
#pragma unroll
            for (int ai = 0; ai < 2; ++ai) {
                const int rb64 = u.pm * BM + ai * HALF + wr * 64;
                f32x4 P = {0.f, 0.f, 0.f, 0.f};
                if ((rb64 & (seq - 1)) != 0 && fr >= 14) { const u32x2e hv = *(const u32x2e*)(halo + (size_t)(2 * (rb64 / 64 - 1) + (fr - 14)) * dff + ch0);
                    P[0] = __builtin_bit_cast(float, hv.x << 16); P[1] = __builtin_bit_cast(float, hv.x & 0xffff0000u); P[2] = __builtin_bit_cast(float, hv.y << 16); P[3] = __builtin_bit_cast(float, hv.y & 0xffff0000u); }
#pragma unroll
                for (int m = 0; m < 4; ++m) {
                    const f32x4 Gv = acc[ai][0][m][n], Uv = acc[ai][1][m][n];
                    float o[4];
#pragma unroll
                    for (int e = 0; e < 4; ++e) {
                        const float t1 = pg_dpp<0x111>(Gv[e]), t2 = pg_dpp<0x112>(Gv[e]), p1 = pg_dpp<0x10F>(P[e]), p2 = pg_dpp<0x10E>(P[e]);
                        const float g1 = (fr >= 1) ? t1 : p1, g2 = (fr >= 2) ? t2 : p2;
                        const float y = bb[e] + w0[e] * g2 + w1[e] * g1 + w2[e] * Gv[e];
                        o[e] = y * __builtin_amdgcn_rcpf(1.f + __builtin_amdgcn_exp2f(-1.4426950408889634f * y)) * Uv[e];
                    }
                    u32x2e w; w.x = cvt_pk_bf16(o[0], o[1]); w.y = cvt_pk_bf16(o[2], o[3]);
                    *(u32x2e*)(act + (size_t)(rb64 + m * 16 + fr) * dff + ch0) = w;
                    P = Gv;
                }
            }
        }
    }
};

template <class Epi, class Sched, bool ALIGN_EPI = false, bool SP2 = false>
__device__ __forceinline__ void gemm_phase(PG8_LAS unsigned char* lds, const Gemm g, const Sched& S, const Epi& E) {
    int tid = threadIdx.x; asm volatile("" : "+v"(tid));
    const int wid = __builtin_amdgcn_readfirstlane(tid >> 6), lane = tid & 63, wr = wid >> 2, wc = wid & 3, fr = lane & 15, fq = lane >> 4;
    const int K = g.K, nt = K / BK;
    unsigned voffA[2], voffB[2];
#pragma unroll
    for (int i = 0; i < 2; ++i) { int R, C; stage_rc(tid * 16 + i * 8192, R, C); const int Rb = Epi::PERM ? ((R & ~31) + perm32(R & 31)) : R;
        const int Ra = g.gatherA ? (64 * (R >> 1) + 62 + (R & 1)) : R;
        voffA[i] = (unsigned)(Ra * g.lda + C) * 2u; voffB[i] = (unsigned)(Rb * g.ldb + C) * 2u; }
    const size_t kstep = (size_t)(BK * 2);
    const size_t hstepA = (size_t)g.hrA * g.lda * 2, hstepB = (size_t)g.hrB * g.ldb * 2;
    const size_t tstepA = (size_t)g.trA * g.lda * 2, tstepB = (size_t)g.trB * g.ldb * 2;
    const unsigned ldsw = (unsigned)wid * 1024u;
    const int aoff = lds_byte(wr * 64 + fr, fq * 8), boff = lds_byte(wc * 32 + fr, fq * 8);
#define PG8_SA(b, h) (((b) * 2 + (h)) * HTB)
#define PG8_SB(b, h) ((4 + (b) * 2 + (h)) * HTB)
#define PG8_STAGE(bufoff, gbase, voff) do { _Pragma("unroll") for (int _i = 0; _i < 2; ++_i) \
        __builtin_amdgcn_global_load_lds((const unsigned*)((const char*)(gbase) + (voff)[_i]), (PG8_LAS unsigned*)(lds + (bufoff) + ldsw + _i * 8192), 16, 0, 0); } while (0)
#define PG8_LDA(dst, b, h) do { _Pragma("unroll") for (int m = 0; m < 4; ++m) _Pragma("unroll") for (int k = 0; k < 2; ++k) dst[m][k] = *(const PG8_LAS bf16x8*)(lds + PG8_SA(b, h) + aoff + m * 2048 + k * 1024); } while (0)
#define PG8_LDB(dst, b, h) do { _Pragma("unroll") for (int n = 0; n < 2; ++n) _Pragma("unroll") for (int k = 0; k < 2; ++k) dst[n][k] = *(const PG8_LAS bf16x8*)(lds + PG8_SB(b, h) + boff + n * 2048 + k * 1024); } while (0)
#define PG8_MMA(ai, bj, At, Bt) do { __builtin_amdgcn_s_setprio(1); _Pragma("unroll") for (int m = 0; m < 4; ++m) _Pragma("unroll") for (int n = 0; n < 2; ++n) _Pragma("unroll") for (int k = 0; k < 2; ++k) \
        acc[ai][bj][m][n] = __builtin_amdgcn_mfma_f32_16x16x32_bf16(Bt[n][k], At[m][k], acc[ai][bj][m][n], 0, 0, 0); __builtin_amdgcn_s_setprio(0); } while (0)
#define PG8_WAIT_V(n) asm volatile("s_waitcnt vmcnt(" #n ")" ::: "memory")
#define PG8_WAIT_L(n) asm volatile("s_waitcnt lgkmcnt(" #n ")" ::: "memory")
#define PG8_BAR __builtin_amdgcn_s_barrier()
#define PG8_SCHED __builtin_amdgcn_sched_barrier(0)
    Unit cur, nxt; int ui = 0;
    if (!S.next(0, cur)) return;
    f32x4 acc[2][2][4][2];
#pragma unroll
    for (int a = 0; a < 2; ++a)
#pragma unroll
        for (int b = 0; b < 2; ++b)
#pragma unroll
            for (int m = 0; m < 4; ++m)
#pragma unroll
                for (int n = 0; n < 2; ++n) acc[a][b][m][n] = (f32x4){0.f, 0.f, 0.f, 0.f};
    bf16x8 At[4][2], B0[2][2], B1[2][2];
    const char* cA = (const char*)g.A + (size_t)cur.pm * tstepA; const char* cB = (const char*)g.Bt + (size_t)cur.pn * tstepB;
    S.a_ready(cur);
    if constexpr (SP2) {
        PG8_STAGE(PG8_SB(0, 0), cB, voffB); PG8_STAGE(PG8_SB(0, 1), cB + hstepB, voffB); PG8_STAGE(PG8_SA(0, 0), cA, voffA); PG8_STAGE(PG8_SA(0, 1), cA + hstepA, voffA);
        if (wr == 1) PG8_BAR;
        PG8_WAIT_V(2); PG8_BAR;
        PG8_STAGE(PG8_SB(1, 0), cB + kstep, voffB); PG8_STAGE(PG8_SA(1, 0), cA + kstep, voffA); PG8_STAGE(PG8_SB(1, 1), cB + hstepB + kstep, voffB);
        PG8_WAIT_V(6); PG8_BAR;
    } else {
        PG8_STAGE(PG8_SB(0, 0), cB, voffB); PG8_STAGE(PG8_SA(0, 0), cA, voffA); PG8_STAGE(PG8_SB(0, 1), cB + hstepB, voffB); PG8_STAGE(PG8_SA(0, 1), cA + hstepA, voffA);
        if (wr == 1) PG8_BAR;
        PG8_WAIT_V(4); PG8_BAR;
        PG8_STAGE(PG8_SB(1, 0), cB + kstep, voffB); PG8_STAGE(PG8_SA(1, 0), cA + kstep, voffA); PG8_STAGE(PG8_SB(1, 1), cB + hstepB + kstep, voffB);
        PG8_WAIT_V(6); PG8_BAR;
    }
    for (;;) {
        const bool has_next = S.next(ui + 1, nxt);
        const char* nA = has_next ? (const char*)g.A + (size_t)nxt.pm * tstepA : cA; const char* nB = has_next ? (const char*)g.Bt + (size_t)nxt.pn * tstepB : cB;
        for (int t = 0; t < nt; t += 2) {
            const bool last = (t == nt - 2);
            const char* a1 = cA + (size_t)(t + 1) * kstep;
            const char* a2 = last ? nA : cA + (size_t)(t + 2) * kstep; const char* b2 = last ? nB : cB + (size_t)(t + 2) * kstep;
            const char* a3 = a2 + kstep; const char* b3 = b2 + kstep;
            if (last && has_next) S.a_ready(nxt);
            if constexpr (SP2) {
            PG8_LDB(B0, 0, 0); PG8_LDB(B1, 0, 1); PG8_SCHED; PG8_LDA(At, 0, 0); PG8_STAGE(PG8_SA(1, 1), a1 + hstepA, voffA);
            PG8_WAIT_V(8); PG8_WAIT_L(0); PG8_BAR; PG8_MMA(0, 0, At, B0); PG8_MMA(0, 1, At, B1); PG8_BAR; PG8_SCHED;
            PG8_LDA(At, 0, 1); PG8_STAGE(PG8_SB(0, 0), b2, voffB); PG8_STAGE(PG8_SB(0, 1), b2 + hstepB, voffB); PG8_STAGE(PG8_SA(0, 0), a2, voffA);
            PG8_WAIT_V(8); PG8_WAIT_L(0); PG8_BAR; PG8_MMA(1, 0, At, B0); PG8_MMA(1, 1, At, B1); PG8_BAR; PG8_SCHED;
            PG8_LDB(B0, 1, 0); PG8_LDB(B1, 1, 1); PG8_SCHED; PG8_LDA(At, 1, 0); PG8_STAGE(PG8_SA(0, 1), a2 + hstepA, voffA);
            PG8_WAIT_V(8); PG8_WAIT_L(0); PG8_BAR; PG8_MMA(0, 0, At, B0); PG8_MMA(0, 1, At, B1); PG8_BAR; PG8_SCHED;
            PG8_LDA(At, 1, 1); PG8_STAGE(PG8_SB(1, 0), b3, voffB); PG8_STAGE(PG8_SB(1, 1), b3 + hstepB, voffB); PG8_STAGE(PG8_SA(1, 0), a3, voffA);
            PG8_WAIT_V(8); PG8_WAIT_L(0); PG8_BAR; PG8_MMA(1, 0, At, B0); PG8_MMA(1, 1, At, B1); PG8_BAR; PG8_SCHED;
            } else {
            PG8_LDB(B0, 0, 0); PG8_SCHED; PG8_LDA(At, 0, 0); PG8_STAGE(PG8_SA(1, 1), a1 + hstepA, voffA);
            PG8_WAIT_L(8); PG8_BAR; PG8_WAIT_L(0); PG8_MMA(0, 0, At, B0); PG8_BAR; PG8_SCHED;
            PG8_LDB(B1, 0, 1); PG8_STAGE(PG8_SB(0, 0), b2, voffB);
            PG8_BAR; PG8_WAIT_L(0); PG8_MMA(0, 1, At, B1); PG8_BAR;
            PG8_LDA(At, 0, 1); PG8_STAGE(PG8_SA(0, 0), a2, voffA);
            PG8_BAR; PG8_WAIT_L(0); PG8_MMA(1, 0, At, B0); PG8_BAR; PG8_SCHED;
            PG8_STAGE(PG8_SB(0, 1), b2 + hstepB, voffB);
            PG8_WAIT_V(6); PG8_BAR; PG8_MMA(1, 1, At, B1); PG8_BAR;
            PG8_LDB(B0, 1, 0); PG8_SCHED; PG8_LDA(At, 1, 0); PG8_STAGE(PG8_SA(0, 1), a2 + hstepA, voffA);
            PG8_WAIT_L(8); PG8_BAR; PG8_WAIT_L(0); PG8_MMA(0, 0, At, B0); PG8_BAR; PG8_SCHED;
            PG8_LDB(B1, 1, 1); PG8_STAGE(PG8_SB(1, 0), b3, voffB);
            PG8_BAR; PG8_WAIT_L(0); PG8_MMA(0, 1, At, B1); PG8_BAR;
            PG8_LDA(At, 1, 1); PG8_STAGE(PG8_SA(1, 0), a3, voffA);
            PG8_BAR; PG8_WAIT_L(0); PG8_MMA(1, 0, At, B0); PG8_BAR; PG8_SCHED;
            PG8_STAGE(PG8_SB(1, 1), b3 + hstepB, voffB);
            PG8_WAIT_V(6); PG8_BAR; PG8_MMA(1, 1, At, B1); PG8_BAR;
            }
        }
        if constexpr (ALIGN_EPI) { if (wr == 0) PG8_BAR; }
        if constexpr (!Epi::AFTER_DRAIN) { E(acc, cur, wr, wc, fr, fq); S.done(cur); }
        if (!has_next) break;
#pragma unroll
        for (int a = 0; a < 2; ++a)
#pragma unroll
            for (int b = 0; b < 2; ++b)
#pragma unroll
                for (int m = 0; m < 4; ++m)
#pragma unroll
                    for (int n = 0; n < 2; ++n) acc[a][b][m][n] = (f32x4){0.f, 0.f, 0.f, 0.f};
        cur = nxt; cA = nA; cB = nB; ++ui;
        if constexpr (ALIGN_EPI) { if (wr == 1) PG8_BAR; }
    }
    PG8_WAIT_V(0);
    if constexpr (!ALIGN_EPI) { if (wr == 0) PG8_BAR; }
    PG8_BAR;
    if constexpr (Epi::AFTER_DRAIN) { E.fused(acc, cur, wr, wc, fr, fq, lds, wid, lane); S.done(cur); }
#undef PG8_SA
#undef PG8_SB
#undef PG8_STAGE
#undef PG8_LDA
#undef PG8_LDB
#undef PG8_MMA
#undef PG8_WAIT_V
#undef PG8_WAIT_L
#undef PG8_BAR
#undef PG8_SCHED
}
}
#define GAS __attribute__((address_space(1)))
#define LAS __attribute__((address_space(3)))
typedef unsigned short bf16;
typedef unsigned v4u __attribute__((ext_vector_type(4)));
typedef float f32x4 __attribute__((ext_vector_type(4)));
typedef short bf16x8 __attribute__((ext_vector_type(8)));
typedef GAS unsigned gu32;
typedef GAS unsigned long long gu64;
#define RLX_AGENT __ATOMIC_RELAXED, __HIP_MEMORY_SCOPE_AGENT
#define LDS_WAIT() asm volatile("s_waitcnt lgkmcnt(0)" ::: "memory")
#define VM_WAIT() asm volatile("s_waitcnt vmcnt(0)" ::: "memory")
__device__ __forceinline__ unsigned long long rt() { return __builtin_amdgcn_s_memrealtime(); }
__device__ __forceinline__ unsigned f2bf(float f) { unsigned u = __builtin_bit_cast(unsigned, f); return (u + 0x7fffu + ((u >> 16) & 1u)) >> 16; }
__device__ __forceinline__ unsigned pk2(float lo, float hi) { return f2bf(lo) | (f2bf(hi) << 16); }

#define XB_TMO      128
#define XB_XCNT(j)  (256  + 64 * (j))
#define XB_XSUB(j)  (1280 + 64 * (j))
#define XB_XGEN(j)  (2304 + 64 * (j))
#define XB_TOP      3328
#define XB_TOPGEN   3392
#define XCD_BAR_WORDS 3456
#define XB_SPIN_CAP (1u << 18)

__device__ __forceinline__ unsigned xb_ld(unsigned* p)              { return __hip_atomic_load(p, __ATOMIC_RELAXED, __HIP_MEMORY_SCOPE_AGENT); }
__device__ __forceinline__ unsigned xb_add(unsigned* p, unsigned v) { return __hip_atomic_fetch_add(p, v, __ATOMIC_RELAXED, __HIP_MEMORY_SCOPE_AGENT); }
__device__ __forceinline__ unsigned xb_xcc_id() { return (unsigned)__builtin_amdgcn_s_getreg((3 << 11) | 20) & 0xFu; }
#define XB_SPIN(cond, bar) do { unsigned _sp = 0; while (cond) { __builtin_amdgcn_s_sleep(1); \
    if ((++_sp & 255u) == 0u) { if (xb_ld(&(bar)[XB_TMO])) break; if (_sp > XB_SPIN_CAP) { atomicAdd(&(bar)[XB_TMO], 1u); break; } } } } while (0)

struct XcdBarrier {
    unsigned* bar; unsigned x;
    volatile LAS unsigned* st;
};

__device__ __forceinline__ XcdBarrier xcd_barrier_post(unsigned* bar, volatile LAS unsigned* st) {
    XcdBarrier b; b.bar = bar; b.x = xb_xcc_id(); b.st = st;
    if (threadIdx.x == 0) (void)xb_add(&bar[XB_XCNT(b.x)], 1u);
    return b;
}
__device__ __forceinline__ void xcd_barrier_complete(unsigned* bar, unsigned x, unsigned& nloc, unsigned& nx) {
    const unsigned G = gridDim.x * gridDim.y * gridDim.z;
    unsigned sum, cnt, mine, sp = 0u;
    for (;;) {
        sum = 0u; cnt = 0u; mine = 0u;
#pragma unroll
        for (unsigned j = 0; j < 16; ++j) { const unsigned c = xb_ld(&bar[XB_XCNT(j)]); sum += c; cnt += (c > 0u) ? 1u : 0u; mine = (j == x) ? c : mine; }
        if (sum == G) break;
        __builtin_amdgcn_s_sleep(1);
        if ((++sp & 255u) == 0u) { if (xb_ld(&bar[XB_TMO])) break; if (sp > XB_SPIN_CAP) { atomicAdd(&bar[XB_TMO], 1u); break; } }
    }
    nloc = mine > 0u ? mine : 1u; nx = cnt > 0u ? cnt : 1u;
}

__device__ __forceinline__ void xcd_barrier(const XcdBarrier& b) {
    asm volatile("s_waitcnt vmcnt(0)" ::: "memory");
    __syncthreads();
    if (threadIdx.x == 0) {
        unsigned* bar = b.bar;
        __builtin_amdgcn_s_waitcnt(0);
        unsigned nloc = b.st[0], nx = b.st[1];
        if (nloc == 0u) { xcd_barrier_complete(bar, b.x, nloc, nx); b.st[0] = nloc; b.st[1] = nx; }
        const unsigned old = xb_add(&bar[XB_XSUB(b.x)], 1u);
        const unsigned gen = old / nloc;
        if (old + 1u == (gen + 1u) * nloc) {
            __builtin_amdgcn_fence(__ATOMIC_RELEASE, "agent");
            asm volatile("s_waitcnt vmcnt(0)" ::: "memory");
            const unsigned og = xb_add(&bar[XB_TOP], 1u);
            const unsigned tg = og / nx;
            if (og + 1u == (tg + 1u) * nx) xb_add(&bar[XB_TOPGEN], 1u);
            else XB_SPIN(xb_ld(&bar[XB_TOPGEN]) == tg, bar);
            __builtin_amdgcn_fence(__ATOMIC_ACQUIRE, "agent");
            xb_add(&bar[XB_XGEN(b.x)], 1u);
            asm volatile("s_waitcnt vmcnt(0)" ::: "memory");
        } else {
            XB_SPIN(xb_ld(&bar[XB_XGEN(b.x)]) == gen, bar);
            __builtin_amdgcn_fence(__ATOMIC_ACQUIRE, "agent");
            asm volatile("s_waitcnt vmcnt(0)" ::: "memory");
        }
    }
    __syncthreads();
}
constexpr int NWAVES = 8;
constexpr int BATCH = 16, SEQ = 2048, DM = 1024, M = BATCH * SEQ;
constexpr int L0P = 3584;
constexpr int L1P = 2048;
constexpr int DFF = 2816;
constexpr float ALPHA = 1.4142135623730951f;
typedef unsigned short bf16_t;
typedef float f32x16 __attribute__((ext_vector_type(16)));

constexpr size_t MiB = 1u << 20;
constexpr size_t WS_CTL = 0, CTL_ZERO_BYTES = 1 * MiB;
constexpr int CW_BAR = 4096;
constexpr size_t WS_W0IN = 2 * MiB, WS_W0OUT = 9 * MiB, WS_WUP0 = 11 * MiB, WS_WDN0 = 22 * MiB, WS_W1IN = 28 * MiB, WS_WUQ = 32 * MiB, WS_WUKV = 33 * MiB,
                 WS_W1OUT = 34 * MiB, WS_WUP1 = 36 * MiB, WS_WDN1 = 47 * MiB;
constexpr size_t WS_XB = 56 * MiB, WS_YMIX = 120 * MiB, WS_BIG = 184 * MiB;
constexpr size_t WS_G = 408 * MiB, WS_BONUS = 440 * MiB, WS_DT = 441 * MiB, WS_XST = 442 * MiB, WS_BT = 474 * MiB, WS_ASUM = 490 * MiB;
constexpr size_t WS_SLOC = 120 * MiB;
constexpr size_t WS_W2T = 53 * MiB, WS_A2T = 53 * MiB + 256 * 1024, WS_G2T = 53 * MiB + 512 * 1024;
constexpr size_t WS_GU = 120 * MiB;
constexpr size_t WS_PROJ1 = 184 * MiB, WS_QM = 312 * MiB, WS_KVM = 360 * MiB, WS_KPE = 424 * MiB, WS_RS = 426 * MiB;
constexpr size_t WS_CSTAB = 492 * MiB;
constexpr size_t WS_VTS = 428 * MiB, WS_VTM = 460 * MiB;
constexpr size_t WS_NEED = 497 * MiB;

constexpr int RING_BYTES = 131072;
constexpr int LDSCTL_OFF = 146432, MISC_OFF = LDSCTL_OFF + 320;
constexpr int LDS_BYTES = 147456;

__device__ __forceinline__ float bf2f(bf16_t b) { return __builtin_bit_cast(float, (unsigned)b << 16); }
__device__ __forceinline__ float sigmoidf_(float x) { return 1.f / (1.f + expf(-x)); }
__device__ __forceinline__ float softplusf_(float x) { return fmaxf(x, 0.f) + log1pf(expf(-fabsf(x))); }
__device__ __forceinline__ float siluf_(float x) { return x / (1.f + expf(-x)); }
__device__ __forceinline__ float wave_sum(float v) {
#pragma unroll
    for (int o = 1; o < 64; o <<= 1) v += __shfl_xor(v, o);
    return v;
}
#define WSYNC() asm volatile("s_waitcnt lgkmcnt(0)" ::: "memory")
typedef float f32x2_t __attribute__((ext_vector_type(2)));
typedef __bf16 bf16x2_t __attribute__((ext_vector_type(2)));
typedef unsigned u32x2 __attribute__((ext_vector_type(2)));
__device__ __forceinline__ unsigned cvtpk(float lo, float hi) { f32x2_t v = {lo, hi}; bf16x2_t b = __builtin_convertvector(v, bf16x2_t); return __builtin_bit_cast(unsigned, b); }
__device__ __forceinline__ float bflo(unsigned u) { return __builtin_bit_cast(float, u << 16); }
__device__ __forceinline__ float bfhi(unsigned u) { return __builtin_bit_cast(float, u & 0xffff0000u); }
__device__ __forceinline__ bf16_t bf1(float x) { return (bf16_t)(cvtpk(x, x) & 0xffffu); }
__device__ __forceinline__ bf16x8 pack8(float a0, float a1, float a2, float a3, float a4, float a5, float a6, float a7) {
    v4u w; w.x = cvtpk(a0, a1); w.y = cvtpk(a2, a3); w.z = cvtpk(a4, a5); w.w = cvtpk(a6, a7); return __builtin_bit_cast(bf16x8, w); }
template <int CTRL> __device__ __forceinline__ float dpp_mov(float x) { return __builtin_bit_cast(float, __builtin_amdgcn_update_dpp(0, __builtin_bit_cast(int, x), CTRL, 0xF, 0xF, true)); }
__device__ __forceinline__ float rowsum16(float x) { x += dpp_mov<0x128>(x); x += dpp_mov<0x124>(x); x += dpp_mov<0x122>(x); x += dpp_mov<0x121>(x); return x; }
__device__ __forceinline__ float rl(float x, int l) { return __builtin_bit_cast(float, __builtin_amdgcn_readlane(__builtin_bit_cast(int, x), l)); }
__device__ __forceinline__ float wave_sum_dpp(float x) { x = rowsum16(x); return (rl(x, 0) + rl(x, 16)) + (rl(x, 32) + rl(x, 48)); }

__device__ __forceinline__ void transpose_matrix(const float* __restrict__ W, int K, int N, bf16_t* __restrict__ WT, int Npad, int ldt, LAS float* scr, int gw, int NGW, int lane, const float* __restrict__ kscale, bool ffn_interleave = false) {
    (void)scr;
    const int nblk = Npad / 64, nit = (K / 64) * nblk;
    for (int it = gw; it < nit; it += NGW) {
        const int kb = it / nblk, nb = it - kb * nblk, n = nb * 64 + lane, k0 = kb * 64;
        const bool ok = n < N; const float* src = W + (size_t)k0 * N + (ok ? n : 0);
#pragma unroll
        for (int hc = 0; hc < 2; ++hc) {
            float v[32];
#pragma unroll
            for (int i = 0; i < 32; ++i) v[i] = src[(size_t)(hc * 32 + i) * N];
#pragma unroll
            for (int c = 0; c < 4; ++c) { float u[8];
#pragma unroll
                for (int i = 0; i < 8; ++i) { u[i] = ok ? v[c * 8 + i] : 0.f; if (kscale) u[i] *= kscale[k0 + hc * 32 + c * 8 + i]; }
                v4u o; o.x = cvtpk(u[0], u[1]); o.y = cvtpk(u[2], u[3]); o.z = cvtpk(u[4], u[5]); o.w = cvtpk(u[6], u[7]);
                const int nr = ffn_interleave ? ((n < DFF) ? 256 * (n >> 7) + (n & 127) : 256 * ((n - DFF) >> 7) + 128 + ((n - DFF) & 127)) : n;
                *(v4u*)(WT + (size_t)nr * ldt + k0 + hc * 32 + c * 8) = o; }
        }
    }
}

template <int MODE> __device__ __forceinline__ void ln_rows(float* h, bf16_t* hb, float* stats, const float* __restrict__ g, const float* __restrict__ b, int gw, int NGW, int lane) {
    for (int row = gw * 2; row < M; row += NGW * 2) {
        float* p = h + (size_t)row * DM;
        f32x4 v[2][4]; float s[2] = {0.f, 0.f};
#pragma unroll
        for (int r = 0; r < 2; ++r)
#pragma unroll
            for (int j = 0; j < 4; ++j) v[r][j] = *(const f32x4*)(p + r * DM + 4 * lane + 256 * j);
#pragma unroll
        for (int r = 0; r < 2; ++r)
#pragma unroll
            for (int j = 0; j < 4; ++j) s[r] += (v[r][j][0] + v[r][j][1]) + (v[r][j][2] + v[r][j][3]);
        float mean[2], q[2] = {0.f, 0.f}, rstd[2];
#pragma unroll
        for (int r = 0; r < 2; ++r) { mean[r] = wave_sum_dpp(s[r]) * (1.f / DM);
#pragma unroll
            for (int j = 0; j < 4; ++j) { v[r][j] = v[r][j] - mean[r]; q[r] += (v[r][j][0] * v[r][j][0] + v[r][j][1] * v[r][j][1]) + (v[r][j][2] * v[r][j][2] + v[r][j][3] * v[r][j][3]); } }
#pragma unroll
        for (int r = 0; r < 2; ++r) rstd[r] = 1.0f / sqrtf(wave_sum_dpp(q[r]) * (1.f / DM) + 1e-5f);
        if (MODE == 1 && lane < 2) { stats[2 * (row + lane)] = lane ? mean[1] : mean[0]; stats[2 * (row + lane) + 1] = lane ? rstd[1] : rstd[0]; }
#pragma unroll
        for (int j = 0; j < 4; ++j) {
            const int c = 4 * lane + 256 * j;
            const f32x4 gg = *(const f32x4*)(g + c), bb = *(const f32x4*)(b + c);
#pragma unroll
            for (int r = 0; r < 2; ++r) {
                const f32x4 o = v[r][j] * rstd[r] * gg + bb;
                if (MODE == 1) { uint2 w; w.x = cvtpk(o[0], o[1]); w.y = cvtpk(o[2], o[3]); *(uint2*)(hb + (size_t)(row + r) * DM + c) = w; }
                else *(f32x4*)(p + r * DM + c) = o;
            }
        }
    }
}

__device__ __forceinline__ void rwkv_naive_chain(int chain, int lane, LAS float* sm, const bf16_t* __restrict__ proj, const float* __restrict__ mix, const float* __restrict__ w0, const float* __restrict__ w2,
                                                 const float* __restrict__ a0, const float* __restrict__ a2, const float* __restrict__ g2, const float* __restrict__ k_k,
                                                 const float* __restrict__ k_a, const float* __restrict__ r_k, const float* __restrict__ ln_g, const float* __restrict__ ln_b, bf16_t* __restrict__ ymix) {
    LAS float* s_w2 = sm; LAS float* s_a2 = sm + 4096; LAS float* s_g2 = sm + 8192; LAS float* s_tw = sm + 16384; LAS float* s_al = s_tw + 64; LAS float* s_sg = s_tw + 128;
    LAS float* s_w = s_tw + 256; LAS float* s_k = s_tw + 320; LAS float* s_a = s_tw + 384; LAS float* s_b = s_tw + 448; LAS float* s_r = s_tw + 512;
    const int b = chain >> 3, h = chain & 7, c = h * 64 + lane;
    for (int l = 0; l < 64; ++l) { s_w2[l * 64 + lane] = w2[l * 512 + c]; s_a2[l * 64 + lane] = a2[l * 512 + c]; }
    for (int l = 0; l < 128; ++l) s_g2[l * 64 + lane] = g2[l * 512 + c];
    const float mr = mix[c], mk = mix[512 + c], mv = mix[1024 + c], mw = mix[1536 + lane], ma = mix[1600 + lane], mg0 = mix[1664 + lane], mg1 = mix[1728 + lane];
    const float w0c = w0[c], a0c = a0[c], kkc = k_k[c], kac = k_a[c], rkc = r_k[c], lgc = ln_g[c], lbc = ln_b[c];
    float S[64];
#pragma unroll
    for (int j = 0; j < 64; ++j) S[j] = 0.f;
    float pr = 0.f, pk = 0.f, pv = 0.f, pw = 0.f, pa = 0.f, pg0 = 0.f, pg1 = 0.f;
    WSYNC();
    for (int t = 0; t < SEQ; ++t) {
        const bf16_t* row = proj + (size_t)(b * SEQ + t) * L0P;
        const float cr = bf2f(row[c]), ck = bf2f(row[512 + c]), cv = bf2f(row[1024 + c]), cw = bf2f(row[1536 + lane]), ca = bf2f(row[1600 + lane]),
                    cg0 = bf2f(row[1664 + lane]), cg1 = bf2f(row[1728 + lane]);
        const float r_s = cr + (pr - cr) * mr, k_s = ck + (pk - ck) * mk, v_s = cv + (pv - cv) * mv;
        const float wl = cw + (pw - cw) * mw, al = ca + (pa - ca) * ma, g0 = cg0 + (pg0 - cg0) * mg0, g1 = cg1 + (pg1 - cg1) * mg1;
        pr = cr; pk = ck; pv = cv; pw = cw; pa = ca; pg0 = cg0; pg1 = cg1;
        s_tw[lane] = tanhf(wl); s_al[lane] = al; s_sg[lane] = sigmoidf_(g0); s_sg[64 + lane] = sigmoidf_(g1);
        WSYNC();
        float wsum = w0c, asum = a0c, gsum = 0.f;
#pragma unroll 2
        for (int l = 0; l < 64; ++l) { wsum += s_tw[l] * s_w2[l * 64 + lane]; asum += s_al[l] * s_a2[l * 64 + lane]; }
#pragma unroll 2
        for (int l = 0; l < 128; ++l) gsum += s_sg[l] * s_g2[l * 64 + lane];
        const float log_w = -softplusf_(-wsum) - 0.5f;
        const float dec = expf(-expf(log_w));
        const float a = sigmoidf_(asum);
        float kkv = k_s * kkc;
        const float nrm = sqrtf(wave_sum(kkv * kkv));
        kkv = kkv / fmaxf(nrm, 1e-12f);
        const float k2 = k_s * (1.f + (a - 1.f) * kac);
        const float bonus_s = wave_sum(r_s * k2 * rkc);
        s_w[lane] = dec; s_k[lane] = k2; s_a[lane] = -kkv; s_b[lane] = kkv * a; s_r[lane] = r_s;
        WSYNC();
        float sa = 0.f;
#pragma unroll
        for (int j = 0; j < 64; ++j) sa += S[j] * s_a[j];
        float y = 0.f;
#pragma unroll
        for (int j = 0; j < 64; ++j) { S[j] = S[j] * s_w[j] + sa * s_b[j] + v_s * s_k[j]; y += S[j] * s_r[j]; }
        const float mu = wave_sum(y) * (1.f / 64.f);
        const float d = y - mu;
        const float var = wave_sum(d * d) * (1.f / 64.f);
        const float yn = d * (1.0f / sqrtf(var + 64e-5f)) * lgc + lbc;
        const float o = (yn + bonus_s * v_s) * gsum;
        ymix[(size_t)(b * SEQ + t) * DM + c] = (bf16_t)f2bf(o);
        WSYNC();
    }
}

__device__ __forceinline__ void ssm_conv_all(const bf16_t* __restrict__ proj, const float* __restrict__ cw, const float* __restrict__ cb, const float* __restrict__ dtb,
                                             bf16_t* __restrict__ xbc, float* __restrict__ dt, int gtid, int NT) {
    for (size_t i = gtid; i < (size_t)M * 1024; i += NT) {
        const int m = (int)(i >> 10), c = (int)(i & 1023), t = m & (SEQ - 1);
        float acc = cb[c];
#pragma unroll
        for (int k = 0; k < 4; ++k) { const int tt = t - 3 + k; if (tt >= 0) acc += cw[k * 1024 + c] * bf2f(proj[(size_t)(m - 3 + k) * L0P + 2304 + c]); }
        xbc[i] = (bf16_t)f2bf(siluf_(acc));
    }
    for (int i = gtid; i < M * 8; i += NT) dt[i] = softplusf_(bf2f(proj[(size_t)(i >> 3) * L0P + 3328 + (i & 7)]) + dtb[i & 7]);
}
__device__ __forceinline__ void ssd_naive_task(int task, int lane, const bf16_t* __restrict__ xbc, const float* __restrict__ dt, const float* __restrict__ a_log, const float* __restrict__ dsk, float* __restrict__ yssm) {
    const int chain = task >> 2, q = task & 3, b = chain >> 3, h = chain & 7, g = h >> 2, p = q * 16 + (lane >> 2), nq = lane & 3;
    const float A = -expf(a_log[h]), D = dsk[h];
    float st[32];
#pragma unroll
    for (int n = 0; n < 32; ++n) st[n] = 0.f;
    for (int t = 0; t < SEQ; ++t) {
        const size_t m = (size_t)b * SEQ + t;
        const float dtv = dt[m * 8 + h], dA = expf(dtv * A);
        const float x = bf2f(xbc[m * 1024 + h * 64 + p]), xdt = x * dtv;
        const bf16_t* Bp = xbc + m * 1024 + 512 + g * 128 + nq * 32;
        const bf16_t* Cp = xbc + m * 1024 + 768 + g * 128 + nq * 32;
        float yp = 0.f;
#pragma unroll
        for (int n = 0; n < 32; ++n) { st[n] = st[n] * dA + xdt * bf2f(Bp[n]); yp += st[n] * bf2f(Cp[n]); }
        yp += __shfl_xor(yp, 1); yp += __shfl_xor(yp, 2);
        if (nq == 0) yssm[m * 512 + h * 64 + p] = yp + D * x;
    }
}
template <bool ST = true> __device__ __forceinline__ void ssm_gate_norm_all(const bf16_t* __restrict__ yssm, const bf16_t* __restrict__ proj, const float* __restrict__ ng, bf16_t* __restrict__ ymix, int wv0, int wvend, int lane) {
    for (int wvb = wv0 * 4 - (wv0 & ~7) * 3; wvb < wvend; wvb += NWAVES * 4) {
        float u[4][4], q[4];
#pragma unroll
        for (int k = 0; k < 4; ++k) { const int wv = wvb + k, m = wv >> 1, g = wv & 1; q[k] = 0.f;
#pragma unroll
            for (int j = 0; j < 4; ++j) { const int c = g * 256 + j * 64 + lane; const float z = bf2f(proj[(size_t)m * L0P + 1792 + c]); u[k][j] = bf2f(yssm[(size_t)m * 512 + c]) * (z * __builtin_amdgcn_rcpf(1.f + __expf(-z))); q[k] += u[k][j] * u[k][j]; } }
#pragma unroll
        for (int k = 0; k < 4; ++k) { const int wv = wvb + k, m = wv >> 1, g = wv & 1;
            const float rs = __builtin_amdgcn_rsqf(wave_sum_dpp(q[k]) * (1.f / 256.f) + 1e-5f);
#pragma unroll
            for (int j = 0; j < 4; ++j) { const int c = g * 256 + j * 64 + lane; const float o_ = u[k][j] * rs * ng[c]; if (ST) ymix[(size_t)m * DM + 512 + c] = bf1(o_); else asm volatile("" :: "v"(o_)); } }
    }
}
template <bool ST = true> __device__ __forceinline__ void ffn_act_all(bf16_t* gu, const float* __restrict__ cw, const float* __restrict__ cb, int gtid, int NT) {
    constexpr int NCH = DFF / 8, NSTRIP = M / 32;
    for (int task = gtid; task < NSTRIP * NCH; task += NT) {
        const int strip = task / NCH, q = task - strip * NCH, c0 = q * 8, m0 = strip * 32;
        float w0[8], w1[8], w2[8], bb[8], g2[8], g1[8];
#pragma unroll
        for (int j = 0; j < 8; j += 4) { const f32x4 a = *(const f32x4*)(cw + c0 + j), b = *(const f32x4*)(cw + DFF + c0 + j), c = *(const f32x4*)(cw + 2 * DFF + c0 + j), d = *(const f32x4*)(cb + c0 + j);
#pragma unroll
            for (int k = 0; k < 4; ++k) { w0[j + k] = a[k]; w1[j + k] = b[k]; w2[j + k] = c[k]; bb[j + k] = d[k]; } }
        bf16_t* base = gu + (size_t)m0 * (2 * DFF) + c0;
        if ((m0 & (SEQ - 1)) != 0) { const v4u a = *(const v4u*)(base - 2 * (2 * DFF)), b = *(const v4u*)(base - (2 * DFF));
            g2[0] = bflo(a.x); g2[1] = bfhi(a.x); g2[2] = bflo(a.y); g2[3] = bfhi(a.y); g2[4] = bflo(a.z); g2[5] = bfhi(a.z); g2[6] = bflo(a.w); g2[7] = bfhi(a.w);
            g1[0] = bflo(b.x); g1[1] = bfhi(b.x); g1[2] = bflo(b.y); g1[3] = bfhi(b.y); g1[4] = bflo(b.z); g1[5] = bfhi(b.z); g1[6] = bflo(b.w); g1[7] = bfhi(b.w); }
        else {
#pragma unroll
            for (int j = 0; j < 8; ++j) { g2[j] = 0.f; g1[j] = 0.f; } }
#pragma unroll 4
        for (int r = 0; r < 32; ++r) {
            const v4u gv = *(const v4u*)(base + (size_t)r * (2 * DFF)), uv = *(const v4u*)(base + (size_t)r * (2 * DFF) + DFF);
            const unsigned gw_[4] = {gv.x, gv.y, gv.z, gv.w}, uw_[4] = {uv.x, uv.y, uv.z, uv.w};
            unsigned ow[4];
#pragma unroll
            for (int k = 0; k < 4; ++k) {
                const float ga = bflo(gw_[k]), gb = bfhi(gw_[k]);
                const float ya = bb[2 * k] + w0[2 * k] * g2[2 * k] + w1[2 * k] * g1[2 * k] + w2[2 * k] * ga;
                const float yb = bb[2 * k + 1] + w0[2 * k + 1] * g2[2 * k + 1] + w1[2 * k + 1] * g1[2 * k + 1] + w2[2 * k + 1] * gb;
                g2[2 * k] = g1[2 * k]; g1[2 * k] = ga; g2[2 * k + 1] = g1[2 * k + 1]; g1[2 * k + 1] = gb;
                ow[k] = cvtpk(ya / (1.f + __expf(-ya)) * bflo(uw_[k]), yb / (1.f + __expf(-yb)) * bfhi(uw_[k]));
            }
            if (ST) *(v4u*)(base + (size_t)r * (2 * DFF) + DFF) = (v4u){ow[0], ow[1], ow[2], ow[3]}; else asm volatile("" :: "v"(ow[0]), "v"(ow[1]), "v"(ow[2]), "v"(ow[3]));
        }
    }
}
template <bool ST = true> __device__ __forceinline__ void mla_prep_all(const bf16_t* __restrict__ proj1, const int* __restrict__ pos, float* __restrict__ rs, bf16_t* __restrict__ kpe, float* __restrict__ cstab, int gw, int NGW, int lane) {
    for (int m4 = gw * 4; m4 < M; m4 += NGW * 4) {
        const int mt = m4 + (lane >> 4), fi = lane & 15;
        const double inv = exp2(-(double)(2 * fi) * (13.287712379549449 / 32.0));
        const double ang = (double)pos[mt] * inv;
        const float cs = (float)cos(ang), sn = (float)sin(ang);
        cstab[(size_t)mt * 32 + fi] = cs; cstab[(size_t)mt * 32 + 16 + fi] = sn;
        { const bf16_t* row = proj1 + (size_t)mt * L1P; const float x1 = bf2f(row[1920 + fi]), x2 = bf2f(row[1936 + fi]);
          kpe[(size_t)mt * 32 + fi] = bf1(x1 * cs - x2 * sn); kpe[(size_t)mt * 32 + 16 + fi] = bf1(x2 * cs + x1 * sn); }
        float q[4], k[4];
#pragma unroll
        for (int u = 0; u < 4; ++u) { const bf16_t* row = proj1 + (size_t)(m4 + u) * L1P; q[u] = 0.f; k[u] = 0.f;
#pragma unroll
            for (int j = 0; j < 4; ++j) { const float v = bf2f(row[1536 + j * 64 + lane]); q[u] += v * v; }
#pragma unroll
            for (int j = 0; j < 2; ++j) { const float v = bf2f(row[1792 + j * 64 + lane]); k[u] += v * v; } }
#pragma unroll
        for (int u = 0; u < 4; ++u) { q[u] = wave_sum_dpp(q[u]); k[u] = wave_sum_dpp(k[u]); }
        if (lane < 4) { const float qq = lane == 0 ? q[0] : lane == 1 ? q[1] : lane == 2 ? q[2] : q[3], kk2 = lane == 0 ? k[0] : lane == 1 ? k[1] : lane == 2 ? k[2] : k[3];
            rs[(size_t)(m4 + lane) * 2] = 1.0f / sqrtf(qq * (1.f / 256.f) + 1e-6f); rs[(size_t)(m4 + lane) * 2 + 1] = 1.0f / sqrtf(kk2 * (1.f / 128.f) + 1e-6f); }
    }
}
template <bool ST = true> __device__ __forceinline__ void rope_q_all(bf16_t* qm, const float* __restrict__ cstab, int gtid, int NT) {
    for (int i = gtid; i < M * 16; i += NT) {
        const int m = i >> 4, h = (i >> 1) & 7, k0 = (i & 1) * 8;
        bf16_t* p = qm + (size_t)m * 768 + h * 96 + 64 + k0;
        const v4u a = *(const v4u*)p, b = *(const v4u*)(p + 16);
        const f32x4 c0 = *(const f32x4*)(cstab + (size_t)m * 32 + k0), c1 = *(const f32x4*)(cstab + (size_t)m * 32 + k0 + 4), s0 = *(const f32x4*)(cstab + (size_t)m * 32 + 16 + k0), s1 = *(const f32x4*)(cstab + (size_t)m * 32 + 16 + k0 + 4);
        const unsigned au[4] = {a.x, a.y, a.z, a.w}, bu[4] = {b.x, b.y, b.z, b.w};
        const float cs[8] = {c0[0], c0[1], c0[2], c0[3], c1[0], c1[1], c1[2], c1[3]}, sn[8] = {s0[0], s0[1], s0[2], s0[3], s1[0], s1[1], s1[2], s1[3]};
        unsigned o1[4], o2[4];
#pragma unroll
        for (int q = 0; q < 4; ++q) { const float x1a = bflo(au[q]), x1b = bfhi(au[q]), x2a = bflo(bu[q]), x2b = bfhi(bu[q]);
            o1[q] = cvtpk(x1a * cs[2 * q] - x2a * sn[2 * q], x1b * cs[2 * q + 1] - x2b * sn[2 * q + 1]);
            o2[q] = cvtpk(x2a * cs[2 * q] + x1a * sn[2 * q], x2b * cs[2 * q + 1] + x1b * sn[2 * q + 1]); }
        if (ST) { *(v4u*)p = (v4u){o1[0], o1[1], o1[2], o1[3]}; *(v4u*)(p + 16) = (v4u){o2[0], o2[1], o2[2], o2[3]}; }
    }
}
__device__ __forceinline__ void sb_naive_task(int qblk, int bh, int lane, const bf16_t* __restrict__ proj1, bf16_t* __restrict__ ymix) {
    const int b = bh >> 3, h = bh & 7, t = qblk * 64 + lane;
    const size_t mrow = (size_t)b * SEQ;
    float q[64], o[64];
#pragma unroll
    for (int d = 0; d < 64; ++d) { q[d] = bf2f(proj1[(mrow + t) * L1P + h * 64 + d]) * 0.125f; o[d] = 0.f; }
    float cum = 0.f;
    const int smax = qblk * 64 + 63;
    for (int s = smax - 1; s >= 0; --s) {
        const bf16_t* kr = proj1 + (mrow + s) * L1P + 512 + h * 64;
        const bf16_t* vr = proj1 + (mrow + s) * L1P + 1024 + h * 64;
        float z = 0.f;
#pragma unroll
        for (int d = 0; d < 64; ++d) z += q[d] * bf2f(kr[d]);
        if (s < t) {
            const float lsp = -softplusf_(-z);
            const float lsn = -softplusf_(z);
            const float att = expf(lsp + cum);
            cum += lsn;
#pragma unroll
            for (int d = 0; d < 64; ++d) o[d] += att * bf2f(vr[d]);
        }
    }
#pragma unroll
    for (int d = 0; d < 64; ++d) ymix[(mrow + t) * DM + h * 64 + d] = (bf16_t)f2bf(o[d]);
}
__device__ __forceinline__ void mla_naive_task(int qblk, int bh, int lane, const bf16_t* __restrict__ qm, const bf16_t* __restrict__ kvm, const bf16_t* __restrict__ kpe, bf16_t* __restrict__ ymix) {
    const int b = bh >> 3, h = bh & 7, t = qblk * 64 + lane;
    const size_t mrow = (size_t)b * SEQ;
    const float scale = 0.10206207261596577f;
    float q[96], o[64];
#pragma unroll
    for (int d = 0; d < 96; ++d) q[d] = bf2f(qm[(mrow + t) * 768 + h * 96 + d]) * scale;
#pragma unroll
    for (int d = 0; d < 64; ++d) o[d] = 0.f;
    float mx = -1e30f, l = 0.f;
    const int smax = qblk * 64 + 63;
    for (int s = 0; s <= smax; ++s) {
        const bf16_t* kr = kvm + (mrow + s) * 1024 + h * 128;
        const bf16_t* pr = kpe + (mrow + s) * 32;
        float z = 0.f;
#pragma unroll
        for (int d = 0; d < 64; ++d) z += q[d] * bf2f(kr[d]);
#pragma unroll
        for (int d = 0; d < 32; ++d) z += q[64 + d] * bf2f(pr[d]);
        if (s <= t) {
            const float mn = fmaxf(mx, z), f = expf(mx - mn), pz = expf(z - mn);
            l = l * f + pz; mx = mn;
#pragma unroll
            for (int d = 0; d < 64; ++d) o[d] = o[d] * f + pz * bf2f(kr[64 + d]);
        }
    }
    const float il = 1.f / l;
#pragma unroll
    for (int d = 0; d < 64; ++d) ymix[(mrow + t) * DM + 512 + h * 64 + d] = (bf16_t)f2bf(o[d] * il);
}


__device__ __forceinline__ int crow(int r, int hi) { return (r & 3) + 8 * (r >> 2) + 4 * hi; }
#define MFMA32(a, b, c) __builtin_amdgcn_mfma_f32_32x32x16_bf16((a), (b), (c), 0, 0, 0)
constexpr int STG_PITCH = 72;
__device__ __forceinline__ void transpose_tile64(const bf16_t* __restrict__ src, int sp, bf16_t* __restrict__ dst, int dp, LAS bf16_t* scr, int lane) {
#pragma unroll
    for (int i = 0; i < 8; ++i) { const int row = i * 8 + (lane >> 3), ch = lane & 7; const v4u v = *(const v4u*)(src + (size_t)row * sp + ch * 8); *(LAS v4u*)(scr + row * STG_PITCH + ch * 8) = v; }
    WSYNC();
#pragma unroll
    for (int i = 0; i < 8; ++i) { const int d = i * 8 + (lane >> 3), tc = lane & 7; const LAS bf16_t* p = scr + (tc * 8) * STG_PITCH + d;
        v4u o; o.x = (unsigned)p[0] | ((unsigned)p[STG_PITCH] << 16); o.y = (unsigned)p[2 * STG_PITCH] | ((unsigned)p[3 * STG_PITCH] << 16);
        o.z = (unsigned)p[4 * STG_PITCH] | ((unsigned)p[5 * STG_PITCH] << 16); o.w = (unsigned)p[6 * STG_PITCH] | ((unsigned)p[7 * STG_PITCH] << 16);
        *(v4u*)(dst + (size_t)d * dp + tc * 8) = o; }
    WSYNC();
}
__device__ __forceinline__ void store_OT(const f32x16 (&o)[2], float sc, LAS bf16_t* stg, bf16_t* __restrict__ dst, int lane) {
    const int l31 = lane & 31, hi = lane >> 5;
#pragma unroll
    for (int dt = 0; dt < 2; ++dt)
#pragma unroll
        for (int r = 0; r < 16; ++r) stg[l31 * STG_PITCH + 32 * dt + crow(r, hi)] = (bf16_t)f2bf(o[dt][r] * sc);
    WSYNC();
#pragma unroll
    for (int i = 0; i < 4; ++i) { const int row = i * 8 + (lane >> 3), ch = lane & 7; const v4u v = *(const LAS v4u*)(stg + row * STG_PITCH + ch * 8); *(v4u*)(dst + (size_t)row * DM + ch * 8) = v; }
    WSYNC();
}
__device__ __forceinline__ float softplus_fast(float z) { return fmaxf(z, 0.f) + __logf(1.f + __expf(-fabsf(z))); }

__device__ __forceinline__ void sb_task(int bh, int qblk, int lane, const bf16_t* __restrict__ P1, const bf16_t* __restrict__ VT, bf16_t* __restrict__ ymix, LAS bf16_t* stg) {
    const int b = bh >> 3, h = bh & 7, l31 = lane & 31, hi = lane >> 5, q0 = qblk * 32, t = q0 + l31;
    const size_t rowb = (size_t)b * SEQ;
    const bf16_t* Qp = P1 + (rowb + q0 + l31) * L1P + h * 64 + 8 * hi;
    bf16x8 qf[4];
#pragma unroll
    for (int kk = 0; kk < 4; ++kk) qf[kk] = *(const bf16x8*)(Qp + 16 * kk);
    const bf16_t* Kp = P1 + (rowb + l31) * L1P + 512 + h * 64 + 8 * hi;
    const bf16_t* Vp = VT + ((size_t)bh * 64 + l31) * SEQ + 4 * hi;
    f32x16 o[2];
#pragma unroll
    for (int r = 0; r < 16; ++r) { o[0][r] = 0.f; o[1][r] = 0.f; }
    float cum = 0.f;
    bf16x8 kf[4]; u32x2 va[2][2][2];
#define SB_LOAD(S0, KF, VA) do { _Pragma("unroll") for (int kk = 0; kk < 4; ++kk) KF[kk] = *(const bf16x8*)(Kp + (size_t)(S0) * L1P + 16 * kk); \
        _Pragma("unroll") for (int dt = 0; dt < 2; ++dt) _Pragma("unroll") for (int ks = 0; ks < 2; ++ks) { VA[dt][ks][0] = *(const u32x2*)(Vp + (size_t)dt * 32 * SEQ + (S0) + 16 * ks); VA[dt][ks][1] = *(const u32x2*)(Vp + (size_t)dt * 32 * SEQ + (S0) + 16 * ks + 8); } } while (0)
    SB_LOAD(q0, kf, va);
    for (int s0 = q0; s0 >= 0; s0 -= 32) {
        bf16x8 kn[4]; u32x2 vn[2][2][2];
        const int sn = (s0 >= 32) ? s0 - 32 : 0;
        SB_LOAD(sn, kn, vn);
        f32x16 acc;
#pragma unroll
        for (int r = 0; r < 16; ++r) acc[r] = 0.f;
#pragma unroll
        for (int kk = 0; kk < 4; ++kk) acc = MFMA32(kf[kk], qf[kk], acc);
        const bool diag = (s0 == q0);
        float lb[16], lk[16];
#pragma unroll
        for (int r = 0; r < 16; ++r) { const float z = acc[r] * 0.125f; const float sp = softplus_fast(z); float b_ = z - sp, k_ = -sp;
            if (diag) { const bool valid = (s0 + crow(r, hi)) < t; b_ = valid ? b_ : -1e30f; k_ = valid ? k_ : 0.f; }
            lb[r] = b_; lk[r] = k_; }
        float e[16], T[4], U[4];
#pragma unroll
        for (int i = 0; i < 4; ++i) { e[4 * i + 3] = 0.f; e[4 * i + 2] = lk[4 * i + 3]; e[4 * i + 1] = e[4 * i + 2] + lk[4 * i + 2]; e[4 * i] = e[4 * i + 1] + lk[4 * i + 1]; T[i] = e[4 * i] + lk[4 * i]; }
#pragma unroll
        for (int i = 0; i < 4; ++i) U[i] = __shfl_xor(T[i], 32);
        float off[4];
        { const float st2 = T[3], st1 = st2 + T[2], st0 = st1 + T[1]; const float su2 = U[3], su1 = su2 + U[2], su0 = su1 + U[1];
          const float x0 = hi ? 0.f : U[0], x1 = hi ? 0.f : U[1], x2 = hi ? 0.f : U[2], x3 = hi ? 0.f : U[3];
          off[3] = x3; off[2] = st2 + su2 + x2; off[1] = st1 + su1 + x1; off[0] = st0 + su0 + x0;
          const float total = st0 + T[0] + su0 + U[0];
#pragma unroll
          for (int r = 0; r < 16; ++r) acc[r] = __expf(lb[r] + (cum + off[r >> 2] + e[r]));
          cum += total; }
        bf16x8 pf[2];
#pragma unroll
        for (int ks = 0; ks < 2; ++ks) { v4u w; w.x = cvtpk(acc[8 * ks], acc[8 * ks + 1]); w.y = cvtpk(acc[8 * ks + 2], acc[8 * ks + 3]); w.z = cvtpk(acc[8 * ks + 4], acc[8 * ks + 5]); w.w = cvtpk(acc[8 * ks + 6], acc[8 * ks + 7]); pf[ks] = __builtin_bit_cast(bf16x8, w); }
#pragma unroll
        for (int dt = 0; dt < 2; ++dt)
#pragma unroll
            for (int ks = 0; ks < 2; ++ks) { v4u a; a.x = va[dt][ks][0].x; a.y = va[dt][ks][0].y; a.z = va[dt][ks][1].x; a.w = va[dt][ks][1].y; o[dt] = MFMA32(__builtin_bit_cast(bf16x8, a), pf[ks], o[dt]); }
        if (__all(cum < -110.f)) break;
#pragma unroll
        for (int kk = 0; kk < 4; ++kk) kf[kk] = kn[kk];
#pragma unroll
        for (int dt = 0; dt < 2; ++dt)
#pragma unroll
            for (int ks = 0; ks < 2; ++ks) { va[dt][ks][0] = vn[dt][ks][0]; va[dt][ks][1] = vn[dt][ks][1]; }
    }
#undef SB_LOAD
    store_OT(o, 1.0f, stg, ymix + (rowb + q0) * DM + h * 64, lane);
}
__device__ __forceinline__ void mla_task(int bh, int qblk, int lane, const bf16_t* __restrict__ QM, const bf16_t* __restrict__ KVM, const bf16_t* __restrict__ KPE, const bf16_t* __restrict__ VT,
                                         bf16_t* __restrict__ ymix, LAS bf16_t* stg) {
    const int b = bh >> 3, h = bh & 7, l31 = lane & 31, hi = lane >> 5, q0 = qblk * 32, t = q0 + l31;
    const size_t rowb = (size_t)b * SEQ;
    const bf16_t* Qp = QM + (rowb + q0 + l31) * 768 + h * 96 + 8 * hi;
    bf16x8 qf[6];
#pragma unroll
    for (int kk = 0; kk < 6; ++kk) qf[kk] = *(const bf16x8*)(Qp + 16 * kk);
    const bf16_t* Kn = KVM + (rowb + l31) * 1024 + h * 128 + 8 * hi;
    const bf16_t* Kr = KPE + (rowb + l31) * 32 + 8 * hi;
    const bf16_t* Vp = VT + ((size_t)bh * 64 + l31) * SEQ + 4 * hi;
    const float sc2 = 0.10206207261596577f * 1.4426950408889634f;
    f32x16 o[2];
#pragma unroll
    for (int r = 0; r < 16; ++r) { o[0][r] = 0.f; o[1][r] = 0.f; }
    float mrun = -1e30f, lsum = 0.f;
    bf16x8 kf[6]; u32x2 va[2][2][2];
#define ML_LOAD(S0, KF, VA) do { _Pragma("unroll") for (int kk = 0; kk < 4; ++kk) KF[kk] = *(const bf16x8*)(Kn + (size_t)(S0) * 1024 + 16 * kk); \
        _Pragma("unroll") for (int kk = 0; kk < 2; ++kk) KF[4 + kk] = *(const bf16x8*)(Kr + (size_t)(S0) * 32 + 16 * kk); \
        _Pragma("unroll") for (int dt = 0; dt < 2; ++dt) _Pragma("unroll") for (int ks = 0; ks < 2; ++ks) { VA[dt][ks][0] = *(const u32x2*)(Vp + (size_t)dt * 32 * SEQ + (S0) + 16 * ks); VA[dt][ks][1] = *(const u32x2*)(Vp + (size_t)dt * 32 * SEQ + (S0) + 16 * ks + 8); } } while (0)
    ML_LOAD(0, kf, va);
    for (int s0 = 0; s0 <= q0; s0 += 32) {
        bf16x8 kn[6]; u32x2 vn[2][2][2];
        const int sn = (s0 + 32 <= q0) ? s0 + 32 : s0;
        ML_LOAD(sn, kn, vn);
        f32x16 acc;
#pragma unroll
        for (int r = 0; r < 16; ++r) acc[r] = 0.f;
#pragma unroll
        for (int kk = 0; kk < 6; ++kk) acc = MFMA32(kf[kk], qf[kk], acc);
        const bool diag = (s0 == q0);
        float tmax = -1e30f;
#pragma unroll
        for (int r = 0; r < 16; ++r) { float z = acc[r] * sc2; if (diag && (s0 + crow(r, hi)) > t) z = -1e30f; acc[r] = z; tmax = fmaxf(tmax, z); }
        tmax = fmaxf(tmax, __shfl_xor(tmax, 32));
        const float mn = fmaxf(mrun, tmax), alpha = exp2f(mrun - mn); mrun = mn;
        float ps = 0.f;
#pragma unroll
        for (int r = 0; r < 16; ++r) { acc[r] = exp2f(acc[r] - mn); ps += acc[r]; }
        lsum = lsum * alpha + ps;
#pragma unroll
        for (int r = 0; r < 16; ++r) { o[0][r] *= alpha; o[1][r] *= alpha; }
        bf16x8 pf[2];
#pragma unroll
        for (int ks = 0; ks < 2; ++ks) { v4u w; w.x = cvtpk(acc[8 * ks], acc[8 * ks + 1]); w.y = cvtpk(acc[8 * ks + 2], acc[8 * ks + 3]); w.z = cvtpk(acc[8 * ks + 4], acc[8 * ks + 5]); w.w = cvtpk(acc[8 * ks + 6], acc[8 * ks + 7]); pf[ks] = __builtin_bit_cast(bf16x8, w); }
#pragma unroll
        for (int dt = 0; dt < 2; ++dt)
#pragma unroll
            for (int ks = 0; ks < 2; ++ks) { v4u a; a.x = va[dt][ks][0].x; a.y = va[dt][ks][0].y; a.z = va[dt][ks][1].x; a.w = va[dt][ks][1].y; o[dt] = MFMA32(__builtin_bit_cast(bf16x8, a), pf[ks], o[dt]); }
#pragma unroll
        for (int kk = 0; kk < 6; ++kk) kf[kk] = kn[kk];
#pragma unroll
        for (int dt = 0; dt < 2; ++dt)
#pragma unroll
            for (int ks = 0; ks < 2; ++ks) { va[dt][ks][0] = vn[dt][ks][0]; va[dt][ks][1] = vn[dt][ks][1]; }
    }
#undef ML_LOAD
    lsum += __shfl_xor(lsum, 32);
    store_OT(o, 1.0f / lsum, stg, ymix + (rowb + q0) * DM + 512 + h * 64, lane);
}


constexpr int MLK_PITCH = 104, MLV_PITCH = 68, MLK_BYTES = 64 * MLK_PITCH * 2, MLV_BYTES = 64 * MLV_PITCH * 2, ML_STAGE = MLK_BYTES + MLV_BYTES;
__device__ __forceinline__ void mla_block(int bh, int sb, int tid, int lane, int wave, LAS unsigned char* lds, const bf16_t* __restrict__ QM, const bf16_t* __restrict__ KVM, const bf16_t* __restrict__ KPE,
                                          const bf16_t* __restrict__ VT, bf16_t* __restrict__ ymix) {
    const int b = bh >> 3, h = bh & 7, l31 = lane & 31, hi = lane >> 5, q0 = 256 * sb + 32 * wave, t = q0 + l31;
    const size_t rowb = (size_t)b * SEQ;
    const int nsteps = 4 * sb + 4;
    bf16x8 qf[6];
    { const bf16_t* Qp = QM + (rowb + q0 + l31) * 768 + h * 96 + 8 * hi;
#pragma unroll
      for (int kk = 0; kk < 6; ++kk) qf[kk] = *(const bf16x8*)(Qp + 16 * kk); }
    const float sc2 = 0.10206207261596577f * 1.4426950408889634f;
    f32x16 o[2];
#pragma unroll
    for (int r = 0; r < 16; ++r) { o[0][r] = 0.f; o[1][r] = 0.f; }
    float mrun = -1e30f, lsum = 0.f;
    const bf16_t* gKn = KVM + (rowb + (tid >> 3)) * 1024 + h * 128 + (tid & 7) * 8;
    const bf16_t* gKr = KPE + (rowb + ((tid & 255) >> 2)) * 32 + (tid & 3) * 8;
    const bf16_t* gVt = VT + ((size_t)bh * 64 + (tid >> 3)) * SEQ + (tid & 7) * 8;
    const int lKn = (tid >> 3) * (MLK_PITCH * 2) + (tid & 7) * 16, lKr = ((tid & 255) >> 2) * (MLK_PITCH * 2) + 128 + (tid & 3) * 16, lVt = MLK_BYTES + (tid >> 3) * (MLV_PITCH * 2) + (tid & 7) * 16;
    v4u rk, rr, rv;
    rk = *(const v4u*)gKn; rr = *(const v4u*)gKr; rv = *(const v4u*)gVt;
    *(LAS v4u*)(lds + lKn) = rk; if (tid < 256) *(LAS v4u*)(lds + lKr) = rr; *(LAS u32x2*)(lds + lVt) = (u32x2){rv.x, rv.y}; *(LAS u32x2*)(lds + lVt + 8) = (u32x2){rv.z, rv.w};
    __syncthreads();
#pragma unroll 1
    for (int step = 0; step < nsteps; ++step) {
        const int nx = (step + 1 < nsteps) ? step + 1 : step;
        rk = *(const v4u*)(gKn + (size_t)nx * 64 * 1024); rr = *(const v4u*)(gKr + (size_t)nx * 64 * 32); rv = *(const v4u*)(gVt + nx * 64);
        const LAS unsigned char* Kb = lds + (step & 1) * ML_STAGE;
        const LAS unsigned char* Vb = Kb + MLK_BYTES;
        if (64 * step <= q0) {
            f32x16 acc[2];
#pragma unroll
            for (int sub = 0; sub < 2; ++sub) {
#pragma unroll
                for (int r = 0; r < 16; ++r) acc[sub][r] = 0.f;
#pragma unroll
                for (int kk = 0; kk < 6; ++kk) { const bf16x8 kf = *(const LAS bf16x8*)(Kb + (32 * sub + l31) * (MLK_PITCH * 2) + (16 * kk + 8 * hi) * 2); acc[sub] = MFMA32(kf, qf[kk], acc[sub]); }
            }
            float tmax = -1e30f;
#pragma unroll
            for (int sub = 0; sub < 2; ++sub) { const int s0 = 64 * step + 32 * sub; const bool need_mask = (s0 + 31 > q0);
#pragma unroll
                for (int r = 0; r < 16; ++r) { float z = acc[sub][r] * sc2; if (need_mask && (s0 + crow(r, hi)) > t) z = -1e30f; acc[sub][r] = z; tmax = fmaxf(tmax, z); } }
            tmax = fmaxf(tmax, __shfl_xor(tmax, 32));
            const float mn = fmaxf(mrun, tmax), alpha = __builtin_amdgcn_exp2f(mrun - mn); mrun = mn;
            float ps = 0.f;
#pragma unroll
            for (int sub = 0; sub < 2; ++sub)
#pragma unroll
                for (int r = 0; r < 16; ++r) { acc[sub][r] = __builtin_amdgcn_exp2f(acc[sub][r] - mn); ps += acc[sub][r]; }
            lsum = lsum * alpha + ps;
#pragma unroll
            for (int r = 0; r < 16; ++r) { o[0][r] *= alpha; o[1][r] *= alpha; }
#pragma unroll
            for (int sub = 0; sub < 2; ++sub) {
                bf16x8 pf[2];
#pragma unroll
                for (int ks = 0; ks < 2; ++ks) pf[ks] = pack8(acc[sub][8 * ks], acc[sub][8 * ks + 1], acc[sub][8 * ks + 2], acc[sub][8 * ks + 3], acc[sub][8 * ks + 4], acc[sub][8 * ks + 5], acc[sub][8 * ks + 6], acc[sub][8 * ks + 7]);
#pragma unroll
                for (int dt = 0; dt < 2; ++dt)
#pragma unroll
                    for (int ks = 0; ks < 2; ++ks) { const LAS unsigned char* vp = Vb + (32 * dt + l31) * (MLV_PITCH * 2) + (32 * sub + 16 * ks + 4 * hi) * 2;
                        const u32x2 x0 = *(const LAS u32x2*)vp, x1 = *(const LAS u32x2*)(vp + 16);
                        v4u a; a.x = x0.x; a.y = x0.y; a.z = x1.x; a.w = x1.y; o[dt] = MFMA32(__builtin_bit_cast(bf16x8, a), pf[ks], o[dt]); }
            }
        }
        LAS unsigned char* nb = lds + ((step + 1) & 1) * ML_STAGE;
        *(LAS v4u*)(nb + lKn) = rk; if (tid < 256) *(LAS v4u*)(nb + lKr) = rr; *(LAS u32x2*)(nb + lVt) = (u32x2){rv.x, rv.y}; *(LAS u32x2*)(nb + lVt + 8) = (u32x2){rv.z, rv.w};
        __syncthreads();
    }
    lsum += __shfl_xor(lsum, 32);
    store_OT(o, 1.0f / lsum, (LAS bf16_t*)(lds + 2 * ML_STAGE) + wave * (32 * STG_PITCH), ymix + (rowb + q0) * DM + 512 + h * 64, lane);
    __syncthreads();
}


constexpr int SBK_PITCH = 72, SBK_BYTES = 64 * SBK_PITCH * 2, SB_STAGE = SBK_BYTES + MLV_BYTES;
__device__ __forceinline__ void sb_block(int bh, int sb, int tid, int lane, int wave, LAS unsigned char* lds, const bf16_t* __restrict__ P1, const bf16_t* __restrict__ VT, bf16_t* __restrict__ ymix) {
    const int b = bh >> 3, h = bh & 7, l31 = lane & 31, hi = lane >> 5, q0 = 256 * sb + 32 * wave, t = q0 + l31;
    const size_t rowb = (size_t)b * SEQ;
    bf16x8 qf[4];
    { const bf16_t* Qp = P1 + (rowb + q0 + l31) * L1P + h * 64 + 8 * hi;
#pragma unroll
      for (int kk = 0; kk < 4; ++kk) qf[kk] = *(const bf16x8*)(Qp + 16 * kk); }
    f32x16 o[2];
#pragma unroll
    for (int r = 0; r < 16; ++r) { o[0][r] = 0.f; o[1][r] = 0.f; }
    float cum = 0.f; bool done = false;
    volatile LAS unsigned* flags = (volatile LAS unsigned*)(lds + 2 * SB_STAGE);
    const bf16_t* gK = P1 + (rowb + (tid >> 3)) * L1P + 512 + h * 64 + (tid & 7) * 8;
    const bf16_t* gVt = VT + ((size_t)bh * 64 + (tid >> 3)) * SEQ + (tid & 7) * 8;
    const int lK = (tid >> 3) * (SBK_PITCH * 2) + (tid & 7) * 16, lVt = SBK_BYTES + (tid >> 3) * (MLV_PITCH * 2) + (tid & 7) * 16;
    const int top = 4 * sb + 3;
    v4u rk, rv;
    rk = *(const v4u*)(gK + (size_t)top * 64 * L1P); rv = *(const v4u*)(gVt + top * 64);
    *(LAS v4u*)(lds + lK) = rk; *(LAS u32x2*)(lds + lVt) = (u32x2){rv.x, rv.y}; *(LAS u32x2*)(lds + lVt + 8) = (u32x2){rv.z, rv.w};
    __syncthreads();
#pragma unroll 1
    for (int i = 0; i <= top; ++i) {
        const int step = top - i, nx = (step > 0) ? step - 1 : 0;
        rk = *(const v4u*)(gK + (size_t)nx * 64 * L1P); rv = *(const v4u*)(gVt + nx * 64);
        const LAS unsigned char* Kb = lds + (i & 1) * SB_STAGE;
        const LAS unsigned char* Vb = Kb + SBK_BYTES;
#pragma unroll
        for (int sub = 1; sub >= 0; --sub) {
            const int s0 = 64 * step + 32 * sub;
            if (s0 <= q0 && !done) {
                f32x16 acc;
#pragma unroll
                for (int r = 0; r < 16; ++r) acc[r] = 0.f;
#pragma unroll
                for (int kk = 0; kk < 4; ++kk) { const bf16x8 kf = *(const LAS bf16x8*)(Kb + (32 * sub + l31) * (SBK_PITCH * 2) + (16 * kk + 8 * hi) * 2); acc = MFMA32(kf, qf[kk], acc); }
                const bool diag = (s0 == q0);
                float lb[16], lk[16];
#pragma unroll
                for (int r = 0; r < 16; ++r) { const float z = acc[r] * 0.125f; const float sp = softplus_fast(z); float b_ = z - sp, k_ = -sp;
                    if (diag) { const bool valid = (s0 + crow(r, hi)) < t; b_ = valid ? b_ : -1e30f; k_ = valid ? k_ : 0.f; }
                    lb[r] = b_; lk[r] = k_; }
                float e[16], T[4], U[4];
#pragma unroll
                for (int q = 0; q < 4; ++q) { e[4 * q + 3] = 0.f; e[4 * q + 2] = lk[4 * q + 3]; e[4 * q + 1] = e[4 * q + 2] + lk[4 * q + 2]; e[4 * q] = e[4 * q + 1] + lk[4 * q + 1]; T[q] = e[4 * q] + lk[4 * q]; }
#pragma unroll
                for (int q = 0; q < 4; ++q) U[q] = __shfl_xor(T[q], 32);
                { const float st2 = T[3], st1 = st2 + T[2], st0 = st1 + T[1]; const float su2 = U[3], su1 = su2 + U[2], su0 = su1 + U[1];
                  const float x0 = hi ? 0.f : U[0], x1 = hi ? 0.f : U[1], x2 = hi ? 0.f : U[2], x3 = hi ? 0.f : U[3];
                  const float off[4] = {st0 + su0 + x0, st1 + su1 + x1, st2 + su2 + x2, x3};
                  const float total = st0 + T[0] + su0 + U[0];
#pragma unroll
                  for (int r = 0; r < 16; ++r) acc[r] = __expf(lb[r] + (cum + off[r >> 2] + e[r]));
                  cum += total; }
                bf16x8 pf[2];
#pragma unroll
                for (int ks = 0; ks < 2; ++ks) { v4u w; w.x = cvtpk(acc[8 * ks], acc[8 * ks + 1]); w.y = cvtpk(acc[8 * ks + 2], acc[8 * ks + 3]); w.z = cvtpk(acc[8 * ks + 4], acc[8 * ks + 5]); w.w = cvtpk(acc[8 * ks + 6], acc[8 * ks + 7]); pf[ks] = __builtin_bit_cast(bf16x8, w); }
#pragma unroll
                for (int dt = 0; dt < 2; ++dt)
#pragma unroll
                    for (int ks = 0; ks < 2; ++ks) { const LAS unsigned char* vp = Vb + (32 * dt + l31) * (MLV_PITCH * 2) + (32 * sub + 16 * ks + 4 * hi) * 2;
                        const u32x2 x0 = *(const LAS u32x2*)vp, x1 = *(const LAS u32x2*)(vp + 16);
                        v4u a; a.x = x0.x; a.y = x0.y; a.z = x1.x; a.w = x1.y; o[dt] = MFMA32(__builtin_bit_cast(bf16x8, a), pf[ks], o[dt]); }
                done = __all(cum < -110.f);
            }
        }
        if (lane == 0) flags[(i & 1) * 8 + wave] = done ? 1u : 0u;
        LAS unsigned char* nb = lds + ((i + 1) & 1) * SB_STAGE;
        *(LAS v4u*)(nb + lK) = rk; *(LAS u32x2*)(nb + lVt) = (u32x2){rv.x, rv.y}; *(LAS u32x2*)(nb + lVt + 8) = (u32x2){rv.z, rv.w};
        __syncthreads();
        unsigned nd = 0;
#pragma unroll
        for (int w8 = 0; w8 < 8; ++w8) nd += flags[(i & 1) * 8 + w8];
        if (nd == 8u) break;
    }
    store_OT(o, 1.0f, (LAS bf16_t*)(lds + 2 * SB_STAGE + 256) + wave * (32 * STG_PITCH), ymix + (rowb + q0) * DM + h * 64, lane);
    __syncthreads();
}

constexpr int RW_RAWW = 0, RW_RAWA = 2048, RW_RS = 4096, RW_KS = 6144, RW_VS = 8192;
constexpr int RW_CH0 = 10240, RW_CHSZ = 11328;
constexpr int RW_YB = RW_CH0 + 2 * RW_CHSZ;
constexpr int RW_MIX = RW_YB + 1024;
static_assert((RW_MIX + 256) * 4 <= 146432, "rwkv LDS map");
__device__ __forceinline__ float tanh_fast(float x) { return 1.f - 2.f * __builtin_amdgcn_rcpf(1.f + __expf(2.f * x)); }
__device__ __forceinline__ float sigmoid_fast(float x) { return __builtin_amdgcn_rcpf(1.f + __expf(-x)); }

#define MFMA16(a, b, c) __builtin_amdgcn_mfma_f32_16x16x32_bf16((a), (b), (c), 0, 0, 0)
constexpr int RW2_CH0 = 0, RW2_YB = 2 * RW_CHSZ, RW2_MIX = RW2_YB + 1024, RW2_STG = RW2_MIX + 448;
static_assert((RW2_STG + 2 * 3072) * 4 <= 146432, "rwkv LDS map");
__device__ __forceinline__ void rwkv_phase_scan(LAS float* sm, int tid, int lane, int wave, int blk, const bf16_t* __restrict__ proj, const float* __restrict__ mix, const float* __restrict__ w0, const float* __restrict__ a0,
                                           const float* __restrict__ k_k, const float* __restrict__ k_a, const float* __restrict__ r_k, const bf16_t* __restrict__ W2T, const bf16_t* __restrict__ A2T, const bf16_t* __restrict__ G2T,
                                           float* __restrict__ yraw, bf16_t* __restrict__ gout, float* __restrict__ bonus_out) {
    const int chain = blk >> 1, half = blk & 1, b = chain >> 3, h = chain & 7, l15 = lane & 15, kg = lane >> 4;
    const size_t rowb = (size_t)b * SEQ;
    constexpr int NCHUNK = SEQ / 32;
    if (tid < 256) sm[RW2_MIX + tid] = mix[1536 + tid];
    else if (tid < 448) { const int q = tid - 256; sm[RW2_MIX + tid] = mix[512 * (q >> 6) + h * 64 + (q & 63)]; }
    __syncthreads();
#define RW_SH8(CUR, PRV, M0, M1, OUT, PZ) do { const unsigned cu_[4] = {(CUR).x, (CUR).y, (CUR).z, (CUR).w}, pu_[4] = {(PRV).x, (PRV).y, (PRV).z, (PRV).w}; \
        const float mm_[8] = {(M0)[0], (M0)[1], (M0)[2], (M0)[3], (M1)[0], (M1)[1], (M1)[2], (M1)[3]}; \
        _Pragma("unroll") for (int q = 0; q < 4; ++q) { const float c0 = bflo(cu_[q]), c1 = bfhi(cu_[q]), p0 = bflo(pu_[q]) * (PZ), p1 = bfhi(pu_[q]) * (PZ); \
            OUT[2 * q] = c0 + (p0 - c0) * mm_[2 * q]; OUT[2 * q + 1] = c1 + (p1 - c1) * mm_[2 * q + 1]; } } while (0)
    if (wave < 4) {
        const int iA = 8 * wave + kg, iB = iA + 4, jseg = l15;
        float A0 = 0.f, A1 = 0.f, A2 = 0.f, A3 = 0.f, B0 = 0.f, B1 = 0.f, B2 = 0.f, B3 = 0.f;
        __syncthreads();
#pragma unroll 1
        for (int ch = 0; ch < NCHUNK; ++ch) {
            const int t0 = ch * 32;
            const LAS float* CHb = sm + RW2_CH0 + (ch & 1) * RW_CHSZ + 4 * jseg;
            const LAS float* CHv = sm + RW2_CH0 + (ch & 1) * RW_CHSZ + 10240 + iA;
            const LAS float* CHs = sm + RW2_CH0 + (ch & 1) * RW_CHSZ + 11264;
            f32x4 a4 = *(const LAS f32x4*)(CHb + 4096), wr4 = *(const LAS f32x4*)(CHb + 8192), w4 = *(const LAS f32x4*)(CHb), b4 = *(const LAS f32x4*)(CHb + 6144), k4 = *(const LAS f32x4*)(CHb + 2048);
            float vA = CHv[0], vB = CHv[4]; f32x2_t sc = *(const LAS f32x2_t*)(CHs);
#pragma unroll 2
            for (int t = 0; t < 32; ++t) {
                const int tq = (t + 1) & 31;
                const f32x4 a4n = *(const LAS f32x4*)(CHb + 4096 + tq * 64), wr4n = *(const LAS f32x4*)(CHb + 8192 + tq * 64), w4n = *(const LAS f32x4*)(CHb + tq * 64),
                            b4n = *(const LAS f32x4*)(CHb + 6144 + tq * 64), k4n = *(const LAS f32x4*)(CHb + 2048 + tq * 64);
                const float vAn = CHv[tq * 32], vBn = CHv[tq * 32 + 4]; const f32x2_t scn = *(const LAS f32x2_t*)(CHs + 2 * tq);
                float d1A = (A0 * a4[0] + A1 * a4[1]) + (A2 * a4[2] + A3 * a4[3]), d1B = (B0 * a4[0] + B1 * a4[1]) + (B2 * a4[2] + B3 * a4[3]);
                float d2A = (A0 * wr4[0] + A1 * wr4[1]) + (A2 * wr4[2] + A3 * wr4[3]), d2B = (B0 * wr4[0] + B1 * wr4[1]) + (B2 * wr4[2] + B3 * wr4[3]);
                d1A = rowsum16(d1A); d1B = rowsum16(d1B); d2A = rowsum16(d2A); d2B = rowsum16(d2B);
                const float yA = d2A + d1A * sc[0] + vA * sc[1], yB = d2B + d1B * sc[0] + vB * sc[1];
                A0 = A0 * w4[0] + (d1A * b4[0] + vA * k4[0]); A1 = A1 * w4[1] + (d1A * b4[1] + vA * k4[1]); A2 = A2 * w4[2] + (d1A * b4[2] + vA * k4[2]); A3 = A3 * w4[3] + (d1A * b4[3] + vA * k4[3]);
                B0 = B0 * w4[0] + (d1B * b4[0] + vB * k4[0]); B1 = B1 * w4[1] + (d1B * b4[1] + vB * k4[1]); B2 = B2 * w4[2] + (d1B * b4[2] + vB * k4[2]); B3 = B3 * w4[3] + (d1B * b4[3] + vB * k4[3]);
                if (jseg == 0) { sm[RW2_YB + t * 32 + iA] = yA; sm[RW2_YB + t * 32 + iB] = yB; }
                a4 = a4n; wr4 = wr4n; w4 = w4n; b4 = b4n; k4 = k4n; vA = vAn; vB = vBn; sc = scn;
            }
            WSYNC();
            { const int tt = lane >> 1, hh = lane & 1; const f32x4 yv = *(const LAS f32x4*)(sm + RW2_YB + tt * 32 + 8 * wave + 4 * hh);
              *(f32x4*)(yraw + (rowb + t0 + tt) * 512 + h * 64 + half * 32 + 8 * wave + 4 * hh) = yv; }
            __syncthreads();
        }
    } else if (wave < 6) {
        const int tp = wave - 4, tb = 16 * tp;
        LAS float* stg = sm + RW2_STG + tp * 3072;
        float w0c[4], a0c[4], kkc[4], kac[4], rkc[4];
#pragma unroll
        for (int nt = 0; nt < 4; ++nt) { const int c = h * 64 + 16 * nt + l15; w0c[nt] = w0[c]; a0c[nt] = a0[c]; kkc[nt] = k_k[c]; kac[nt] = k_a[c]; rkc[nt] = r_k[c]; }
        v4u ld[20];
#define PREP_ISSUE(T0) do { const int t0_ = (T0); { const size_t r_ = rowb + t0_ + tb + l15; const size_t rp_ = (t0_ + tb + l15 == 0) ? r_ : r_ - 1; \
            _Pragma("unroll") for (int lo = 0; lo < 2; ++lo) _Pragma("unroll") for (int ks = 0; ks < 2; ++ks) { const int col = 1536 + 64 * lo + 32 * ks + 8 * kg; \
                ld[(lo * 2 + ks) * 2] = *(const v4u*)(proj + r_ * L0P + col); ld[(lo * 2 + ks) * 2 + 1] = *(const v4u*)(proj + rp_ * L0P + col); } } \
            _Pragma("unroll") for (int ar = 0; ar < 3; ++ar) _Pragma("unroll") for (int i = 0; i < 2; ++i) { const int p_ = lane + 64 * i, row_ = p_ >> 3, c8_ = p_ & 7; \
                const size_t r_ = rowb + t0_ + tb + row_; const size_t rp_ = (t0_ + tb + row_ == 0) ? r_ : r_ - 1; const int col = 512 * ar + h * 64 + 8 * c8_; \
                ld[8 + (ar * 2 + i) * 2] = *(const v4u*)(proj + r_ * L0P + col); ld[8 + (ar * 2 + i) * 2 + 1] = *(const v4u*)(proj + rp_ * L0P + col); } } while (0)
#define PREP_BUILD(T0, NB) do { const int t0_ = (T0); LAS float* CHn = sm + RW2_CH0 + (NB) * RW_CHSZ; \
            f32x4 accw[4], acca[4]; \
            _Pragma("unroll") for (int nt = 0; nt < 4; ++nt) { accw[nt] = (f32x4){0.f, 0.f, 0.f, 0.f}; acca[nt] = (f32x4){0.f, 0.f, 0.f, 0.f}; } \
            { const float pz_ = (t0_ + tb + l15 == 0) ? 0.f : 1.f; \
              _Pragma("unroll") for (int lo = 0; lo < 2; ++lo) _Pragma("unroll") for (int ks = 0; ks < 2; ++ks) { float s_[8]; \
                const f32x4 m0 = *(const LAS f32x4*)(sm + RW2_MIX + 64 * lo + 32 * ks + 8 * kg), m1 = *(const LAS f32x4*)(sm + RW2_MIX + 64 * lo + 32 * ks + 8 * kg + 4); \
                RW_SH8(ld[(lo * 2 + ks) * 2], ld[(lo * 2 + ks) * 2 + 1], m0, m1, s_, pz_); \
                if (lo == 0) { _Pragma("unroll") for (int j = 0; j < 8; ++j) s_[j] = tanh_fast(s_[j]); } \
                v4u aw; aw.x = cvtpk(s_[0], s_[1]); aw.y = cvtpk(s_[2], s_[3]); aw.z = cvtpk(s_[4], s_[5]); aw.w = cvtpk(s_[6], s_[7]); const bf16x8 af = __builtin_bit_cast(bf16x8, aw); \
                const bf16_t* WT = lo ? A2T : W2T; \
                _Pragma("unroll") for (int nt = 0; nt < 4; ++nt) { const bf16x8 bfr = *(const bf16x8*)(WT + (size_t)(h * 64 + 16 * nt + l15) * 64 + 32 * ks + 8 * kg); \
                    if (lo == 0) accw[nt] = MFMA16(af, bfr, accw[nt]); else acca[nt] = MFMA16(af, bfr, acca[nt]); } } } \
            _Pragma("unroll") for (int ar = 0; ar < 3; ++ar) _Pragma("unroll") for (int i = 0; i < 2; ++i) { const int p_ = lane + 64 * i, row_ = p_ >> 3, c8_ = p_ & 7; float s_[8]; \
                const float pz_ = (t0_ + tb + row_ == 0) ? 0.f : 1.f; const f32x4 m0 = *(const LAS f32x4*)(sm + RW2_MIX + 256 + ar * 64 + c8_ * 8), m1 = *(const LAS f32x4*)(sm + RW2_MIX + 256 + ar * 64 + c8_ * 8 + 4); \
                RW_SH8(ld[8 + (ar * 2 + i) * 2], ld[8 + (ar * 2 + i) * 2 + 1], m0, m1, s_, pz_); \
                *(LAS f32x4*)(stg + ar * 1024 + row_ * 64 + c8_ * 8) = (f32x4){s_[0], s_[1], s_[2], s_[3]}; *(LAS f32x4*)(stg + ar * 1024 + row_ * 64 + c8_ * 8 + 4) = (f32x4){s_[4], s_[5], s_[6], s_[7]}; } \
            WSYNC(); \
            PREP_ISSUE(((T0) + 32 < SEQ) ? (T0) + 32 : (T0)); \
            _Pragma("unroll") for (int rg = 0; rg < 4; ++rg) { const int tl = 4 * kg + rg, t = tb + tl; \
                float r_[4], k_[4], v_[4], kkv[4], nrm2 = 0.f; \
                _Pragma("unroll") for (int nt = 0; nt < 4; ++nt) { r_[nt] = stg[tl * 64 + 16 * nt + l15]; k_[nt] = stg[1024 + tl * 64 + 16 * nt + l15]; v_[nt] = stg[2048 + tl * 64 + 16 * nt + l15]; \
                    kkv[nt] = k_[nt] * kkc[nt]; nrm2 += kkv[nt] * kkv[nt]; } \
                nrm2 = rowsum16(nrm2); const float rn = __builtin_amdgcn_rsqf(fmaxf(nrm2, 1e-24f)); \
                float br = 0.f, kr = 0.f, bon = 0.f; \
                _Pragma("unroll") for (int nt = 0; nt < 4; ++nt) { const int j = 16 * nt + l15; \
                    const float wsum = w0c[nt] + accw[nt][rg]; const float logw = -softplus_fast(-wsum) - 0.5f; const float dec = __expf(-__expf(logw)); \
                    const float a_ = sigmoid_fast(a0c[nt] + acca[nt][rg]); const float kn = kkv[nt] * rn; \
                    const float k2 = k_[nt] * (1.f + (a_ - 1.f) * kac[nt]); const float bv = kn * a_; \
                    br += bv * r_[nt]; kr += k2 * r_[nt]; bon += r_[nt] * k2 * rkc[nt]; \
                    CHn[t * 64 + j] = dec; CHn[2048 + t * 64 + j] = k2; CHn[4096 + t * 64 + j] = -kn; CHn[6144 + t * 64 + j] = bv; CHn[8192 + t * 64 + j] = dec * r_[nt]; \
                    if ((nt >> 1) == half) CHn[10240 + t * 32 + (j & 31)] = v_[nt]; } \
                br = rowsum16(br); kr = rowsum16(kr); bon = rowsum16(bon); \
                if (l15 == 0) { CHn[11264 + 2 * t] = br; CHn[11264 + 2 * t + 1] = kr; if (half == 0) bonus_out[(rowb + t0_ + t) * 8 + h] = bon; } } \
            WSYNC(); } while (0)
        PREP_ISSUE(0);
        PREP_BUILD(0, 0);
        __syncthreads();
#pragma unroll 1
        for (int ch = 0; ch < NCHUNK; ++ch) {
            if (ch + 1 < NCHUNK) PREP_BUILD(ch * 32 + 32, (ch + 1) & 1);
            __syncthreads();
        }
#undef PREP_ISSUE
#undef PREP_BUILD
    } else {
        const int tp = wave - 6, tb = 16 * tp;
        v4u ld[8];
#define G_ISSUE(T0) do { const int t0_ = (T0); const size_t r_ = rowb + t0_ + tb + l15; const size_t rp_ = (t0_ + tb + l15 == 0) ? r_ : r_ - 1; \
            _Pragma("unroll") for (int ks = 0; ks < 4; ++ks) { const int col = 1664 + 32 * ks + 8 * kg; ld[2 * ks] = *(const v4u*)(proj + r_ * L0P + col); ld[2 * ks + 1] = *(const v4u*)(proj + rp_ * L0P + col); } } while (0)
#define G_BUILD(T0) do { const int t0_ = (T0); f32x4 accg[2] = {(f32x4){0.f, 0.f, 0.f, 0.f}, (f32x4){0.f, 0.f, 0.f, 0.f}}; const float pz_ = (t0_ + tb + l15 == 0) ? 0.f : 1.f; \
            _Pragma("unroll") for (int ks = 0; ks < 4; ++ks) { float s_[8]; \
                const f32x4 m0 = *(const LAS f32x4*)(sm + RW2_MIX + 128 + 32 * ks + 8 * kg), m1 = *(const LAS f32x4*)(sm + RW2_MIX + 128 + 32 * ks + 8 * kg + 4); \
                RW_SH8(ld[2 * ks], ld[2 * ks + 1], m0, m1, s_, pz_); \
                _Pragma("unroll") for (int j = 0; j < 8; ++j) s_[j] = sigmoid_fast(s_[j]); \
                v4u aw; aw.x = cvtpk(s_[0], s_[1]); aw.y = cvtpk(s_[2], s_[3]); aw.z = cvtpk(s_[4], s_[5]); aw.w = cvtpk(s_[6], s_[7]); const bf16x8 af = __builtin_bit_cast(bf16x8, aw); \
                _Pragma("unroll") for (int nt = 0; nt < 2; ++nt) { const bf16x8 bfr = *(const bf16x8*)(G2T + (size_t)(h * 64 + half * 32 + 16 * nt + l15) * 128 + 32 * ks + 8 * kg); accg[nt] = MFMA16(af, bfr, accg[nt]); } } \
            G_ISSUE(((T0) + 32 < SEQ) ? (T0) + 32 : (T0)); \
            _Pragma("unroll") for (int nt = 0; nt < 2; ++nt) _Pragma("unroll") for (int rg = 0; rg < 4; ++rg) \
                gout[(rowb + t0_ + tb + 4 * kg + rg) * 512 + h * 64 + half * 32 + 16 * nt + l15] = (bf16_t)f2bf(accg[nt][rg]); } while (0)
        G_ISSUE(0);
        G_BUILD(0);
        __syncthreads();
#pragma unroll 1
        for (int ch = 0; ch < NCHUNK; ++ch) {
            if (ch + 1 < NCHUNK) G_BUILD(ch * 32 + 32);
            __syncthreads();
        }
#undef G_ISSUE
#undef G_BUILD
    }
#undef RW_SH8
    __syncthreads();
}

constexpr int CK_BK = 0, CK_AR = 4608, CK_BBT = 9216, CK_KBT = 12288, CK_VT = 15360, CK_GC = 16896, CK_TT = 17152, CK_SLOT = 18688, CK_NSLOT = 5;
constexpr int CK_STG = CK_SLOT * CK_NSLOT;
constexpr int CK_MIX = CK_STG + 4 * 12288;
constexpr int CK_FLAGS = CK_MIX + 448 * 4;
static_assert(CK_FLAGS + 64 <= 146432, "rwkv chunked LDS map");
__device__ __forceinline__ void rwkv_phase(LAS float* smf, int tid, int lane, int wave, int blk, const bf16_t* __restrict__ proj, const float* __restrict__ mix, const float* __restrict__ w0, const float* __restrict__ a0,
                                           const float* __restrict__ k_k, const float* __restrict__ k_a, const float* __restrict__ r_k, const bf16_t* __restrict__ W2T, const bf16_t* __restrict__ A2T, const bf16_t* __restrict__ G2T,
                                           float* __restrict__ yraw, bf16_t* __restrict__ gout, float* __restrict__ bonus_out) {
    LAS unsigned char* lds = (LAS unsigned char*)smf;
    LAS float* mixs = (LAS float*)(lds + CK_MIX);
    volatile LAS unsigned* flags = (volatile LAS unsigned*)(lds + CK_FLAGS);
    const int chain = blk >> 1, ihalf = blk & 1, b = chain >> 3, h = chain & 7, l15 = lane & 15, kg = lane >> 4, l31 = lane & 31, hi = lane >> 5;
    const size_t rowb = (size_t)b * SEQ;
    constexpr int NCH = SEQ / 16;
    if (tid < 256) mixs[tid] = mix[1536 + tid];
    else if (tid < 448) { const int q = tid - 256; mixs[tid] = mix[512 * (q >> 6) + h * 64 + (q & 63)]; }
    if (tid < 16) flags[tid] = 0u;
    for (int q = tid; q < CK_NSLOT * 384; q += NWAVES * 64) *(LAS unsigned*)(lds + (q / 384) * CK_SLOT + CK_TT + (q % 384) * 4) = 0u;
    __syncthreads();
#define RW_SH8(CUR, PRV, M0, M1, OUT, PZ) do { const unsigned cu_[4] = {(CUR).x, (CUR).y, (CUR).z, (CUR).w}, pu_[4] = {(PRV).x, (PRV).y, (PRV).z, (PRV).w}; \
        const float mm_[8] = {(M0)[0], (M0)[1], (M0)[2], (M0)[3], (M1)[0], (M1)[1], (M1)[2], (M1)[3]}; \
        _Pragma("unroll") for (int q = 0; q < 4; ++q) { const float c0 = bflo(cu_[q]), c1 = bfhi(cu_[q]), p0 = bflo(pu_[q]) * (PZ), p1 = bfhi(pu_[q]) * (PZ); \
            OUT[2 * q] = c0 + (p0 - c0) * mm_[2 * q]; OUT[2 * q + 1] = c1 + (p1 - c1) * mm_[2 * q + 1]; } } while (0)
    if (wave == 0) {
        f32x16 ST[2];
#pragma unroll
        for (int r = 0; r < 16; ++r) { ST[0][r] = 0.f; ST[1][r] = 0.f; }
#pragma unroll 1
        for (int k = 0; k < NCH; ++k) {
#if defined(PROBE_STAMPS)
            const unsigned tw0_ = (unsigned)__builtin_amdgcn_s_memrealtime();
#endif
            { const unsigned want = (unsigned)(k + 1); const int sl = k % CK_NSLOT; while (flags[sl] != want) __builtin_amdgcn_s_sleep(1); }
#if defined(PROBE_STAMPS)
            if (blk == 0 && lane == 0) ((volatile LAS unsigned*)(lds + 146432 + 320))[16 + 24] += (unsigned)__builtin_amdgcn_s_memrealtime() - tw0_;
#endif
            asm volatile("" ::: "memory");
            const LAS unsigned char* im = lds + (k % CK_NSLOT) * CK_SLOT;
            f32x16 G;
#pragma unroll
            for (int r = 0; r < 16; ++r) G[r] = 0.f;
#pragma unroll
            for (int kk = 0; kk < 4; ++kk) { const bf16x8 fa = *(const LAS bf16x8*)(im + CK_BK + l31 * 144 + (16 * kk + 8 * hi) * 2), fb = *(const LAS bf16x8*)(im + CK_AR + l31 * 144 + (16 * kk + 8 * hi) * 2); G = MFMA32(fa, fb, G); }
            { const int tcol = l31 & 15; const bool strict = l31 < 16;
#pragma unroll
              for (int r = 0; r < 16; ++r) { const int srow = crow(r & 7, hi); const bool keep = strict ? (srow < tcol) : (srow <= tcol); G[r] = keep ? G[r] : 0.f; } }
            const bf16x8 gB = pack8(G[0], G[1], G[2], G[3], G[4], G[5], G[6], G[7]), gK = pack8(G[8], G[9], G[10], G[11], G[12], G[13], G[14], G[15]);
            f32x16 XT;
#pragma unroll
            for (int r = 0; r < 16; ++r) XT[r] = 0.f;
#pragma unroll
            for (int jt = 0; jt < 2; ++jt)
#pragma unroll
                for (int sp = 0; sp < 2; ++sp) { const LAS unsigned char* ap = im + CK_AR + l31 * 144 + (32 * jt + 16 * sp + 4 * hi) * 2;
                    const u32x2 x0 = *(const LAS u32x2*)ap, x1 = *(const LAS u32x2*)(ap + 16); v4u aw; aw.x = x0.x; aw.y = x0.y; aw.z = x1.x; aw.w = x1.y;
                    const bf16x8 sb_ = pack8(ST[jt][8 * sp], ST[jt][8 * sp + 1], ST[jt][8 * sp + 2], ST[jt][8 * sp + 3], ST[jt][8 * sp + 4], ST[jt][8 * sp + 5], ST[jt][8 * sp + 6], ST[jt][8 * sp + 7]);
                    XT = MFMA32(__builtin_bit_cast(bf16x8, aw), sb_, XT); }
            bf16x8 vP;
            { const LAS unsigned char* vp = im + CK_VT + l31 * 48 + (4 * hi) * 2; const u32x2 x0 = *(const LAS u32x2*)vp, x1 = *(const LAS u32x2*)(vp + 16); v4u vw; vw.x = x0.x; vw.y = x0.y; vw.z = x1.x; vw.w = x1.y;
              vP = __builtin_bit_cast(bf16x8, vw); XT = MFMA32(gK, vP, XT); }
            bf16x8 uP;
            { const LAS unsigned char* tp = im + CK_TT + l31 * 48 + (4 * hi) * 2; const u32x2 x0 = *(const LAS u32x2*)tp, x1 = *(const LAS u32x2*)(tp + 16); v4u tw; tw.x = x0.x; tw.y = x0.y; tw.z = x1.x; tw.w = x1.y;
              f32x16 UT;
#pragma unroll
              for (int r = 0; r < 16; ++r) UT[r] = 0.f;
              UT = MFMA32(__builtin_bit_cast(bf16x8, tw), pack8(XT[0], XT[1], XT[2], XT[3], XT[4], XT[5], XT[6], XT[7]), UT);
              uP = pack8(UT[0], UT[1], UT[2], UT[3], UT[4], UT[5], UT[6], UT[7]); }
            XT = MFMA32(gB, uP, XT);
            { float* yp = yraw + (rowb + 16 * k) * 512 + h * 64 + 32 * ihalf + l31;
#pragma unroll
              for (int q = 0; q < 8; ++q) yp[(size_t)crow(q, hi) * 512] = XT[8 + q]; }
            { const LAS float* gc = (const LAS float*)(im + CK_GC);
#pragma unroll
              for (int jt = 0; jt < 2; ++jt)
#pragma unroll
                  for (int r = 0; r < 16; ++r) ST[jt][r] *= gc[32 * jt + crow(r, hi)]; }
#pragma unroll
            for (int jt = 0; jt < 2; ++jt) { const LAS unsigned char* bp = im + CK_BBT + (32 * jt + l31) * 48 + (4 * hi) * 2; const LAS unsigned char* kp = im + CK_KBT + (32 * jt + l31) * 48 + (4 * hi) * 2;
                const u32x2 b0 = *(const LAS u32x2*)bp, b1 = *(const LAS u32x2*)(bp + 16), k0 = *(const LAS u32x2*)kp, k1 = *(const LAS u32x2*)(kp + 16);
                v4u a1; a1.x = b0.x; a1.y = b0.y; a1.z = b1.x; a1.w = b1.y; v4u a2; a2.x = k0.x; a2.y = k0.y; a2.z = k1.x; a2.w = k1.y;
                ST[jt] = MFMA32(__builtin_bit_cast(bf16x8, a1), uP, ST[jt]); ST[jt] = MFMA32(__builtin_bit_cast(bf16x8, a2), vP, ST[jt]); }
            WSYNC();
            if (lane == 0) flags[8] = (unsigned)(k + 1);
        }
    } else if (wave <= 4) {
        const int pw = wave - 1;
        LAS float* stg = (LAS float*)(lds + CK_STG) + pw * 3072;
        float w0c[4], a0c[4], kkc[4], kac[4], rkc[4];
#pragma unroll
        for (int nt = 0; nt < 4; ++nt) { const int c = h * 64 + 16 * nt + l15; w0c[nt] = w0[c]; a0c[nt] = a0[c]; kkc[nt] = k_k[c]; kac[nt] = k_a[c]; rkc[nt] = r_k[c]; }
        v4u ld[20];
#define CK_ISSUE_A(T0) do { const int t0_ = (T0); const size_t r_ = rowb + t0_ + l15; const size_t rp_ = (t0_ + l15 == 0) ? r_ : r_ - 1; \
            _Pragma("unroll") for (int lo = 0; lo < 2; ++lo) _Pragma("unroll") for (int ks = 0; ks < 2; ++ks) { const int col = 1536 + 64 * lo + 32 * ks + 8 * kg; \
                ld[(lo * 2 + ks) * 2] = *(const v4u*)(proj + r_ * L0P + col); ld[(lo * 2 + ks) * 2 + 1] = *(const v4u*)(proj + rp_ * L0P + col); } } while (0)
#define CK_ISSUE_B(T0) do { const int t0_ = (T0); \
            _Pragma("unroll") for (int ar = 0; ar < 3; ++ar) _Pragma("unroll") for (int i = 0; i < 2; ++i) { const int p_ = lane + 64 * i, row_ = p_ >> 3, c8_ = p_ & 7; \
                const size_t r_ = rowb + t0_ + row_; const size_t rp_ = (t0_ + row_ == 0) ? r_ : r_ - 1; const int col = 512 * ar + h * 64 + 8 * c8_; \
                ld[8 + (ar * 2 + i) * 2] = *(const v4u*)(proj + r_ * L0P + col); ld[8 + (ar * 2 + i) * 2 + 1] = *(const v4u*)(proj + rp_ * L0P + col); } } while (0)
#define CK_ISSUE(T0) do { CK_ISSUE_A(T0); CK_ISSUE_B(T0); } while (0)
        CK_ISSUE(16 * pw);
#pragma unroll 1
        for (int k = pw; k < NCH; k += 4) {
            const int t0 = 16 * k;
#if defined(PROBE_STAMPS)
            const unsigned ts0_ = (unsigned)__builtin_amdgcn_s_memrealtime();
#endif
            f32x4 accw[4], acca[4];
#pragma unroll
            for (int nt = 0; nt < 4; ++nt) { accw[nt] = (f32x4){0.f, 0.f, 0.f, 0.f}; acca[nt] = (f32x4){0.f, 0.f, 0.f, 0.f}; }
            { const float pz_ = (t0 + l15 == 0) ? 0.f : 1.f;
#pragma unroll
              for (int lo = 0; lo < 2; ++lo)
#pragma unroll
                for (int ks = 0; ks < 2; ++ks) { float s_[8];
                    const f32x4 m0 = *(const LAS f32x4*)(mixs + 64 * lo + 32 * ks + 8 * kg), m1 = *(const LAS f32x4*)(mixs + 64 * lo + 32 * ks + 8 * kg + 4);
                    RW_SH8(ld[(lo * 2 + ks) * 2], ld[(lo * 2 + ks) * 2 + 1], m0, m1, s_, pz_);
                    if (lo == 0) {
#pragma unroll
                        for (int j = 0; j < 8; ++j) s_[j] = tanh_fast(s_[j]); }
                    const bf16x8 af = pack8(s_[0], s_[1], s_[2], s_[3], s_[4], s_[5], s_[6], s_[7]);
                    const bf16_t* WT = lo ? A2T : W2T;
#pragma unroll
                    for (int nt = 0; nt < 4; ++nt) { const bf16x8 bfr = *(const bf16x8*)(WT + (size_t)(h * 64 + 16 * nt + l15) * 64 + 32 * ks + 8 * kg);
                        if (lo == 0) accw[nt] = MFMA16(af, bfr, accw[nt]); else acca[nt] = MFMA16(af, bfr, acca[nt]); } } }
#pragma unroll
            for (int ar = 0; ar < 3; ++ar)
#pragma unroll
                for (int i = 0; i < 2; ++i) { const int p_ = lane + 64 * i, row_ = p_ >> 3, c8_ = p_ & 7; float s_[8];
                    const float pz_ = (t0 + row_ == 0) ? 0.f : 1.f; const f32x4 m0 = *(const LAS f32x4*)(mixs + 256 + ar * 64 + c8_ * 8), m1 = *(const LAS f32x4*)(mixs + 256 + ar * 64 + c8_ * 8 + 4);
                    RW_SH8(ld[8 + (ar * 2 + i) * 2], ld[8 + (ar * 2 + i) * 2 + 1], m0, m1, s_, pz_);
                    *(LAS f32x4*)(stg + ar * 1024 + row_ * 64 + c8_ * 8) = (f32x4){s_[0], s_[1], s_[2], s_[3]}; *(LAS f32x4*)(stg + ar * 1024 + row_ * 64 + c8_ * 8 + 4) = (f32x4){s_[4], s_[5], s_[6], s_[7]}; }
            WSYNC();
#if defined(PROBE_STAMPS)
            if (blk == 0 && wave == 1 && lane == 0) ((volatile LAS unsigned*)(lds + 146432 + 320))[16 + 26] += (unsigned)__builtin_amdgcn_s_memrealtime() - ts0_;
#endif
#if defined(PROBE_STAMPS)
            const unsigned tb0_ = (unsigned)__builtin_amdgcn_s_memrealtime();
#endif
            { const int need = k - (CK_NSLOT - 1); if (need > 0) { while ((int)flags[8] < need) __builtin_amdgcn_s_sleep(2); } }
#if defined(PROBE_STAMPS)
            if (blk == 0 && wave == 1 && lane == 0) ((volatile LAS unsigned*)(lds + 146432 + 320))[16 + 25] += (unsigned)__builtin_amdgcn_s_memrealtime() - tb0_;
#endif
            asm volatile("" ::: "memory");
            LAS unsigned char* im = lds + (k % CK_NSLOT) * CK_SLOT;
#if defined(PROBE_STAMPS)
            const unsigned ts1_ = (unsigned)__builtin_amdgcn_s_memrealtime();
#endif
            float lwv[4][4], av[4][4], knv[4][4];
#pragma unroll
            for (int rg = 0; rg < 4; ++rg) { const int tl = 4 * kg + rg;
                float kkv[4], nrm2 = 0.f, vv[4], rr_[4], kr_[4];
#pragma unroll
                for (int nt = 0; nt < 4; ++nt) { rr_[nt] = stg[tl * 64 + 16 * nt + l15]; kr_[nt] = stg[1024 + tl * 64 + 16 * nt + l15]; vv[nt] = stg[2048 + tl * 64 + 16 * nt + l15];
                    kkv[nt] = kr_[nt] * kkc[nt]; nrm2 += kkv[nt] * kkv[nt]; }
                nrm2 = rowsum16(nrm2); const float rn = __builtin_amdgcn_rsqf(fmaxf(nrm2, 1e-24f));
                float bon = 0.f;
#pragma unroll
                for (int nt = 0; nt < 4; ++nt) {
                    const float wsum = w0c[nt] + accw[nt][rg]; lwv[nt][rg] = -0.6065306597126334f * sigmoid_fast(wsum);
                    const float a_ = sigmoid_fast(a0c[nt] + acca[nt][rg]); av[nt][rg] = a_; knv[nt][rg] = kkv[nt] * rn;
                    const float k2 = kr_[nt] * (1.f + (a_ - 1.f) * kac[nt]); stg[1024 + tl * 64 + 16 * nt + l15] = k2;
                    bon += rr_[nt] * k2 * rkc[nt];
                    if ((nt >> 1) == ihalf) *(LAS bf16_t*)(im + CK_VT + (16 * (nt & 1) + l15) * 48 + tl * 2) = bf1(vv[nt]);
                }
                bon = rowsum16(bon);
                if (l15 == 0 && ihalf == 0) bonus_out[(rowb + t0 + tl) * 8 + h] = bon;
            }
            CK_ISSUE_A((k + 4 < NCH) ? t0 + 64 : t0);
#pragma unroll
            for (int nt = 0; nt < 4; ++nt) {
                float L[4]; L[0] = lwv[nt][0]; L[1] = L[0] + lwv[nt][1]; L[2] = L[1] + lwv[nt][2]; L[3] = L[2] + lwv[nt][3];
                const float T0 = __shfl(L[3], l15), T1 = __shfl(L[3], 16 + l15), T2 = __shfl(L[3], 32 + l15), T3 = __shfl(L[3], 48 + l15);
                const float off = (kg > 0 ? T0 : 0.f) + (kg > 1 ? T1 : 0.f) + (kg > 2 ? T2 : 0.f), LC = (T0 + T1) + (T2 + T3);
                const int j = 16 * nt + l15;
                unsigned bb2[2], kb2[2];
                const float gC = __expf(LC); float eprev = __expf(off);
#pragma unroll
                for (int rg = 0; rg < 4; ++rg) { const int tl = 4 * kg + rg; const float Lt = off + L[rg], e1 = __expf(Lt), e2 = __builtin_amdgcn_rcpf(e1), e3 = eprev, e4 = gC * e2; eprev = e1;
                    const float kn = knv[nt][rg], bvv = kn * av[nt][rg], k2 = stg[1024 + tl * 64 + j], rr2 = stg[tl * 64 + j];
                    *(LAS bf16_t*)(im + CK_BK + tl * 144 + j * 2) = bf1(bvv * e2); *(LAS bf16_t*)(im + CK_BK + (16 + tl) * 144 + j * 2) = bf1(k2 * e2);
                    *(LAS bf16_t*)(im + CK_AR + tl * 144 + j * 2) = bf1(-kn * e3); *(LAS bf16_t*)(im + CK_AR + (16 + tl) * 144 + j * 2) = bf1(rr2 * e1);
                    const unsigned bq = bf1(bvv * e4), kq = bf1(k2 * e4);
                    if (rg & 1) { bb2[rg >> 1] |= bq << 16; kb2[rg >> 1] |= kq << 16; } else { bb2[rg >> 1] = bq; kb2[rg >> 1] = kq; } }
                *(LAS u32x2*)(im + CK_BBT + j * 48 + (4 * kg) * 2) = (u32x2){bb2[0], bb2[1]}; *(LAS u32x2*)(im + CK_KBT + j * 48 + (4 * kg) * 2) = (u32x2){kb2[0], kb2[1]};
                if (kg == 0) *(LAS float*)(im + CK_GC + j * 4) = gC;
            }
            WSYNC();
#if defined(PROBE_STAMPS)
            const unsigned ts2_ = (unsigned)__builtin_amdgcn_s_memrealtime();
            if (blk == 0 && wave == 1 && lane == 0) ((volatile LAS unsigned*)(lds + 146432 + 320))[16 + 27] += ts2_ - ts1_;
#endif
            {
                f32x4 nacc = {0.f, 0.f, 0.f, 0.f};
#pragma unroll
                for (int ks = 0; ks < 2; ++ks) { const bf16x8 fa = *(const LAS bf16x8*)(im + CK_BK + l15 * 144 + (32 * ks + 8 * kg) * 2), fb = *(const LAS bf16x8*)(im + CK_AR + l15 * 144 + (32 * ks + 8 * kg) * 2); nacc = MFMA16(fa, fb, nacc); }
#pragma unroll
                for (int rg = 0; rg < 4; ++rg) nacc[rg] = ((4 * kg + rg) < l15) ? nacc[rg] : 0.f;
                float Tr[16];
#pragma unroll
                for (int t = 0; t < 16; ++t) { float acc_ = (l15 == t) ? 1.f : 0.f;
#pragma unroll
                    for (int s2 = 0; s2 < t; ++s2) acc_ += Tr[s2] * rl(nacc[s2 & 3], t + 16 * (s2 >> 2));
                    Tr[t] = acc_; }
                if (kg == 0) {
#pragma unroll
                    for (int t = 0; t < 16; ++t) *(LAS bf16_t*)(im + CK_TT + t * 48 + l15 * 2) = bf1(Tr[t]); }
            }
            WSYNC();
#if defined(PROBE_STAMPS)
            if (blk == 0 && wave == 1 && lane == 0) ((volatile LAS unsigned*)(lds + 146432 + 320))[16 + 28] += (unsigned)__builtin_amdgcn_s_memrealtime() - ts2_;
#endif
            if (lane == 0) flags[k % CK_NSLOT] = (unsigned)(k + 1);
            CK_ISSUE_B((k + 4 < NCH) ? t0 + 64 : t0);
        }
#undef CK_ISSUE
#undef CK_ISSUE_A
#undef CK_ISSUE_B
    } else if (wave <= 6) {
        const int gq = wave - 5;
        v4u ld[8];
#define G_ISSUE(T0) do { const int t0_ = (T0); const size_t r_ = rowb + t0_ + l15; const size_t rp_ = (t0_ + l15 == 0) ? r_ : r_ - 1; \
            _Pragma("unroll") for (int ks = 0; ks < 4; ++ks) { const int col = 1664 + 32 * ks + 8 * kg; ld[2 * ks] = *(const v4u*)(proj + r_ * L0P + col); ld[2 * ks + 1] = *(const v4u*)(proj + rp_ * L0P + col); } } while (0)
        G_ISSUE(16 * gq);
#pragma unroll 1
        for (int k = gq; k < NCH; k += 2) {
            const int t0 = 16 * k;
            f32x4 accg[2] = {(f32x4){0.f, 0.f, 0.f, 0.f}, (f32x4){0.f, 0.f, 0.f, 0.f}}; const float pz_ = (t0 + l15 == 0) ? 0.f : 1.f;
#pragma unroll
            for (int ks = 0; ks < 4; ++ks) { float s_[8];
                const f32x4 m0 = *(const LAS f32x4*)(mixs + 128 + 32 * ks + 8 * kg), m1 = *(const LAS f32x4*)(mixs + 128 + 32 * ks + 8 * kg + 4);
                RW_SH8(ld[2 * ks], ld[2 * ks + 1], m0, m1, s_, pz_);
#pragma unroll
                for (int j = 0; j < 8; ++j) s_[j] = sigmoid_fast(s_[j]);
                const bf16x8 af = pack8(s_[0], s_[1], s_[2], s_[3], s_[4], s_[5], s_[6], s_[7]);
#pragma unroll
                for (int nt = 0; nt < 2; ++nt) { const bf16x8 bfr = *(const bf16x8*)(G2T + (size_t)(h * 64 + ihalf * 32 + 16 * nt + l15) * 128 + 32 * ks + 8 * kg); accg[nt] = MFMA16(af, bfr, accg[nt]); } }
            G_ISSUE((k + 2 < NCH) ? t0 + 32 : t0);
#pragma unroll
            for (int nt = 0; nt < 2; ++nt)
#pragma unroll
                for (int rg = 0; rg < 4; ++rg) gout[(rowb + t0 + 4 * kg + rg) * 512 + h * 64 + ihalf * 32 + 16 * nt + l15] = bf1(accg[nt][rg]);
        }
#undef G_ISSUE
    }
#undef RW_SH8
    __syncthreads();
}

template <bool ST = true> __device__ __forceinline__ void rwkv_post_all(const float* __restrict__ yraw, const bf16_t* __restrict__ proj, const float* __restrict__ mix, const float* __restrict__ bonus, const bf16_t* __restrict__ gbuf,
                                              const float* __restrict__ ln_g, const float* __restrict__ ln_b, bf16_t* __restrict__ ymix, int gw, int NGW, int lane) {
    for (int m = gw; m < M; m += NGW) {
        const bool has_prev = (m & (SEQ - 1)) != 0;
        float y[8], cv[8], pv[8], gg[8], bo[8];
#pragma unroll
        for (int h = 0; h < 8; ++h) { const int c = h * 64 + lane; y[h] = yraw[(size_t)m * 512 + c]; cv[h] = bf2f(proj[(size_t)m * L0P + 1024 + c]);
            pv[h] = bf2f(proj[(size_t)(has_prev ? m - 1 : m) * L0P + 1024 + c]); gg[h] = bf2f(gbuf[(size_t)m * 512 + c]); bo[h] = bonus[(size_t)m * 8 + h]; }
#pragma unroll
        for (int h = 0; h < 8; ++h) { const int c = h * 64 + lane;
            const float mu = wave_sum_dpp(y[h]) * (1.f / 64.f), d = y[h] - mu, var = wave_sum_dpp(d * d) * (1.f / 64.f);
            const float yn = d * __builtin_amdgcn_rsqf(var + 64e-5f) * ln_g[c] + ln_b[c];
            const float pvv = has_prev ? pv[h] : 0.f;
            const float v_s = cv[h] + (pvv - cv[h]) * mix[1024 + c];
            const float o = (yn + bo[h] * v_s) * gg[h];
            if (ST) ymix[(size_t)m * DM + c] = (bf16_t)f2bf(o); else asm volatile("" :: "v"(o)); }
    }
}


__device__ __forceinline__ void ssd_conv_tile(int it, int lane, LAS bf16_t* scr, const bf16_t* __restrict__ proj, const float* __restrict__ cw, const float* __restrict__ cb,
                                              bf16_t* __restrict__ xbc, bf16_t* __restrict__ xst, bf16_t* __restrict__ bt) {
    const int tt = it >> 4, ct = it & 15, m0 = tt * 64, b = m0 >> 11, t0 = m0 & (SEQ - 1), c = ct * 64 + lane;
    const float w0 = cw[c], w1 = cw[1024 + c], w2 = cw[2048 + c], w3 = cw[3072 + c], bias = cb[c];
    const bf16_t* src = proj + (size_t)m0 * L0P + 2304 + c;
    bf16_t raw[67];
    const int lo = (t0 > 0) ? -3 : 0;
#pragma unroll
    for (int t = -3; t < 64; ++t) raw[t + 3] = src[(ptrdiff_t)((t < lo) ? lo : t) * L0P];
    float u3 = (t0 > 0) ? bf2f(raw[0]) : 0.f, u2 = (t0 > 0) ? bf2f(raw[1]) : 0.f, u1 = (t0 > 0) ? bf2f(raw[2]) : 0.f;
#pragma unroll
    for (int t = 0; t < 64; ++t) {
        const float u = bf2f(raw[t + 3]);
        const float y = bias + w0 * u3 + w1 * u2 + w2 * u1 + w3 * u;
        const bf16_t o = bf1(y * __builtin_amdgcn_rcpf(1.f + __expf(-y)));
        xbc[(size_t)(m0 + t) * 1024 + c] = o;
        scr[t * STG_PITCH + lane] = o;
        u3 = u2; u2 = u1; u1 = u;
    }
    WSYNC();
    if (ct < 12) {
        bf16_t* dst = (ct < 8) ? xst + ((size_t)(b * 8 + ct) * 64) * SEQ + t0 : bt + ((size_t)(b * 2 + ((ct - 8) >> 1)) * 128 + ((ct - 8) & 1) * 64) * SEQ + t0;
#pragma unroll
        for (int i = 0; i < 8; ++i) { const int d = i * 8 + (lane >> 3), tc = lane & 7; const LAS bf16_t* p = scr + (tc * 8) * STG_PITCH + d;
            v4u o; o.x = (unsigned)p[0] | ((unsigned)p[STG_PITCH] << 16); o.y = (unsigned)p[2 * STG_PITCH] | ((unsigned)p[3 * STG_PITCH] << 16);
            o.z = (unsigned)p[4 * STG_PITCH] | ((unsigned)p[5 * STG_PITCH] << 16); o.w = (unsigned)p[6 * STG_PITCH] | ((unsigned)p[7 * STG_PITCH] << 16);
            *(v4u*)(dst + (size_t)d * SEQ + tc * 8) = o; }
    }
    WSYNC();
}
__device__ __forceinline__ float bperm(int srclane, float x) { return __builtin_bit_cast(float, __builtin_amdgcn_ds_bpermute(srclane << 2, __builtin_bit_cast(int, x))); }
__device__ __forceinline__ void scan128(float& x0, float& x1, int lane) {
#pragma unroll
    for (int o = 1; o < 64; o <<= 1) { const int sl = (lane >= o) ? lane - o : lane; const float t0 = bperm(sl, x0), t1 = bperm(sl, x1); if (lane >= o) { x0 += t0; x1 += t1; } }
    x1 += rl(x0, 63);
}
__device__ __forceinline__ void ssd_s1_unit(int unit, int lane, LAS float* tab, const bf16_t* __restrict__ xst, const bf16_t* __restrict__ bt, const float* __restrict__ dt, const float* __restrict__ a_log,
                                            float* __restrict__ sloc, float* __restrict__ asum) {
    const int h = unit & 7, c = (unit >> 3) & 15, b = unit >> 7, g = h >> 2, l0 = c * 128, l31 = lane & 31, hi = lane >> 5;
    const size_t m0 = (size_t)b * SEQ + l0;
    const float A = -expf(a_log[h]);
    const float d0 = dt[(m0 + lane) * 8 + h], d1 = dt[(m0 + 64 + lane) * 8 + h];
    float ac0 = d0 * A, ac1 = d1 * A;
    scan128(ac0, ac1, lane);
    const float aend = rl(ac1, 63);
    tab[lane] = __expf(aend - ac0) * d0; tab[64 + lane] = __expf(aend - ac1) * d1;
    if (lane == 0) asum[unit] = aend;
    WSYNC();
    f32x16 acc[2][4];
#pragma unroll
    for (int pt = 0; pt < 2; ++pt)
#pragma unroll
        for (int nt = 0; nt < 4; ++nt)
#pragma unroll
            for (int r = 0; r < 16; ++r) acc[pt][nt][r] = 0.f;
    const bf16_t* Xp = xst + ((size_t)(b * 8 + h) * 64 + l31) * SEQ + l0 + 8 * hi;
    const bf16_t* Bp = bt + ((size_t)(b * 2 + g) * 128 + l31) * SEQ + l0 + 8 * hi;
#pragma unroll 2
    for (int kk = 0; kk < 8; ++kk) {
        const f32x4 wa = *(const LAS f32x4*)(tab + 16 * kk + 8 * hi), wb = *(const LAS f32x4*)(tab + 16 * kk + 8 * hi + 4);
        bf16x8 af[2], bfr[4];
#pragma unroll
        for (int pt = 0; pt < 2; ++pt) { const v4u raw = *(const v4u*)(Xp + (size_t)pt * 32 * SEQ + 16 * kk);
            v4u w; w.x = cvtpk(bflo(raw.x) * wa[0], bfhi(raw.x) * wa[1]); w.y = cvtpk(bflo(raw.y) * wa[2], bfhi(raw.y) * wa[3]);
            w.z = cvtpk(bflo(raw.z) * wb[0], bfhi(raw.z) * wb[1]); w.w = cvtpk(bflo(raw.w) * wb[2], bfhi(raw.w) * wb[3]); af[pt] = __builtin_bit_cast(bf16x8, w); }
#pragma unroll
        for (int nt = 0; nt < 4; ++nt) bfr[nt] = *(const bf16x8*)(Bp + (size_t)nt * 32 * SEQ + 16 * kk);
#pragma unroll
        for (int pt = 0; pt < 2; ++pt)
#pragma unroll
            for (int nt = 0; nt < 4; ++nt) acc[pt][nt] = MFMA32(af[pt], bfr[nt], acc[pt][nt]);
    }
    float* dst = sloc + (size_t)unit * 8192 + l31;
#pragma unroll
    for (int pt = 0; pt < 2; ++pt)
#pragma unroll
        for (int nt = 0; nt < 4; ++nt)
#pragma unroll
            for (int r = 0; r < 16; ++r) dst[(32 * pt + crow(r, hi)) * 128 + 32 * nt] = acc[pt][nt][r];
    WSYNC();
}
__device__ __forceinline__ void ssd_s2_all(const float* __restrict__ sloc, const float* __restrict__ asum, bf16_t* __restrict__ stb, int gtid, int NT) {
    for (int i = gtid; i < 128 * 2048; i += NT) {
        const int bh = i >> 11, e4 = i & 2047, b = bh >> 3, h = bh & 7;
        f32x4 run = {0.f, 0.f, 0.f, 0.f};
#pragma unroll 4
        for (int c = 0; c < 16; ++c) { const int unit = (b * 16 + c) * 8 + h; const f32x4 tmp = *(const f32x4*)(sloc + (size_t)unit * 8192 + e4 * 4);
            uint2 w; w.x = cvtpk(run[0], run[1]); w.y = cvtpk(run[2], run[3]); *(uint2*)(stb + (size_t)unit * 8192 + e4 * 4) = w;
            run = run * __expf(asum[unit]) + tmp; }
    }
}
__device__ __forceinline__ void ssd_s3_unit(int unit, int lane, LAS float* tab, const bf16_t* __restrict__ xbc, const bf16_t* __restrict__ xst, const bf16_t* __restrict__ stb, const float* __restrict__ dt,
                                            const float* __restrict__ a_log, const float* __restrict__ dsk, bf16_t* __restrict__ yssm) {
    const int h = unit & 7, c = (unit >> 3) & 15, b = unit >> 7, g = h >> 2, l0 = c * 128, l31 = lane & 31, hi = lane >> 5;
    const size_t m0 = (size_t)b * SEQ + l0;
    const float A = -expf(a_log[h]), D = dsk[h];
    const float d0 = dt[(m0 + lane) * 8 + h], d1 = dt[(m0 + 64 + lane) * 8 + h];
    float ac0 = d0 * A, ac1 = d1 * A;
    scan128(ac0, ac1, lane);
    tab[lane] = ac0; tab[64 + lane] = ac1; tab[128 + lane] = d0; tab[192 + lane] = d1;
    WSYNC();
    const bf16_t* Cp = xbc + (m0 + l31) * 1024 + 768 + g * 128 + 8 * hi;
    const bf16_t* Sp = stb + (size_t)unit * 8192 + l31 * 128 + 8 * hi;
    const bf16_t* Bp = xbc + (m0 + l31) * 1024 + 512 + g * 128 + 8 * hi;
    const bf16_t* Xp = xst + ((size_t)(b * 8 + h) * 64 + l31) * SEQ + l0 + 4 * hi;
    LAS float* tr = tab + 256;
    const int row = lane >> 1, p0 = (lane & 1) * 16;
#pragma unroll 1
    for (int lt = 0; lt < 4; ++lt) {
        f32x16 y[2];
#pragma unroll
        for (int r = 0; r < 16; ++r) { y[0][r] = 0.f; y[1][r] = 0.f; }
        const float acl = tab[32 * lt + l31];
        bf16x8 cfr[8];
#pragma unroll
        for (int kk = 0; kk < 8; ++kk) cfr[kk] = *(const bf16x8*)(Cp + (size_t)lt * 32 * 1024 + 16 * kk);
        {   bf16x8 s0[8], s1[8];
#pragma unroll
            for (int kk = 0; kk < 8; ++kk) { s0[kk] = *(const bf16x8*)(Sp + 16 * kk); s1[kk] = *(const bf16x8*)(Sp + 32 * 128 + 16 * kk); }
#pragma unroll
            for (int kk = 0; kk < 8; ++kk) { y[0] = MFMA32(s0[kk], cfr[kk], y[0]); y[1] = MFMA32(s1[kk], cfr[kk], y[1]); }
        }
        { const float el = __expf(acl);
#pragma unroll
          for (int r = 0; r < 16; ++r) { y[0][r] *= el; y[1][r] *= el; } }
#pragma unroll 1
        for (int st = 0; st <= lt; ++st) {
            bf16x8 bfr[8]; u32x2 xf[2][2][2];
#pragma unroll
            for (int kk = 0; kk < 8; ++kk) bfr[kk] = *(const bf16x8*)(Bp + (size_t)st * 32 * 1024 + 16 * kk);
#pragma unroll
            for (int pt = 0; pt < 2; ++pt)
#pragma unroll
                for (int ks = 0; ks < 2; ++ks) { const bf16_t* xp = Xp + (size_t)pt * 32 * SEQ + st * 32 + 16 * ks; xf[pt][ks][0] = *(const u32x2*)xp; xf[pt][ks][1] = *(const u32x2*)(xp + 8); }
            f32x16 cbt;
#pragma unroll
            for (int r = 0; r < 16; ++r) cbt[r] = 0.f;
#pragma unroll
            for (int kk = 0; kk < 8; ++kk) cbt = MFMA32(bfr[kk], cfr[kk], cbt);
#pragma unroll
            for (int r = 0; r < 16; ++r) { const int sl = 32 * st + crow(r, hi); const float acs = tab[sl], dts = tab[128 + sl];
                float v = cbt[r] * __expf(acl - acs) * dts; if (st == lt && crow(r, hi) > l31) v = 0.f; cbt[r] = v; }
            bf16x8 pf[2];
#pragma unroll
            for (int ks = 0; ks < 2; ++ks) pf[ks] = pack8(cbt[8 * ks], cbt[8 * ks + 1], cbt[8 * ks + 2], cbt[8 * ks + 3], cbt[8 * ks + 4], cbt[8 * ks + 5], cbt[8 * ks + 6], cbt[8 * ks + 7]);
#pragma unroll
            for (int pt = 0; pt < 2; ++pt)
#pragma unroll
                for (int ks = 0; ks < 2; ++ks) { v4u a; a.x = xf[pt][ks][0].x; a.y = xf[pt][ks][0].y; a.z = xf[pt][ks][1].x; a.w = xf[pt][ks][1].y; y[pt] = MFMA32(__builtin_bit_cast(bf16x8, a), pf[ks], y[pt]); }
        }
#pragma unroll
        for (int pt = 0; pt < 2; ++pt) {
#pragma unroll
            for (int r = 0; r < 16; ++r) tr[l31 * 33 + crow(r, hi)] = y[pt][r];
            WSYNC();
            const size_t m = m0 + 32 * lt + row;
            const v4u xa = *(const v4u*)(xbc + m * 1024 + h * 64 + 32 * pt + p0), xb = *(const v4u*)(xbc + m * 1024 + h * 64 + 32 * pt + p0 + 8);
            const unsigned xu[8] = {xa.x, xa.y, xa.z, xa.w, xb.x, xb.y, xb.z, xb.w};
            unsigned ow[8];
#pragma unroll
            for (int q = 0; q < 8; ++q) { const float v0 = tr[row * 33 + p0 + 2 * q] + D * bflo(xu[q]), v1 = tr[row * 33 + p0 + 2 * q + 1] + D * bfhi(xu[q]); ow[q] = cvtpk(v0, v1); }
            bf16_t* dst = yssm + m * 512 + h * 64 + 32 * pt + p0;
            *(v4u*)dst = (v4u){ow[0], ow[1], ow[2], ow[3]}; *(v4u*)(dst + 8) = (v4u){ow[4], ow[5], ow[6], ow[7]};
            WSYNC();
        }
    }
}

struct Args { const float* in[43]; float* out; unsigned char* ws; };
#define GEMM_PHASE(EPI, Aptr, LDA, Bptr, LDB, NN, KK, ...) do { pg8::Gemm g_{(Aptr), (Bptr), M, (NN), (KK), (LDA), (LDB)}; pg8::StaticOrder S_; S_.init(M, (NN), G, (int)blockIdx.x); \
        pg8::EPI E_{__VA_ARGS__}; pg8::gemm_phase<pg8::EPI, pg8::StaticOrder, true, true>(lds3, g_, S_, E_); } while (0)

__global__ void __launch_bounds__(NWAVES * 64, 2) fwd_mega(Args args) {
    extern __shared__ __attribute__((aligned(16))) unsigned char lds[];
    LAS unsigned char* lds3 = (LAS unsigned char*)lds;
    volatile LAS unsigned* MISC = (volatile LAS unsigned*)(lds3 + MISC_OFF);
    const int G = gridDim.x, NGW = G * NWAVES, NT = G * NWAVES * 64;
#define PHASE_IDS() int tid = threadIdx.x; asm volatile("" : "+v"(tid)); const int lane = tid & 63, wave = __builtin_amdgcn_readfirstlane(tid >> 6); const int gw = blockIdx.x * NWAVES + wave, gtid = blockIdx.x * (NWAVES * 64) + tid; (void)lane; (void)gw; (void)gtid
    unsigned char* ws = args.ws;
    gu32* ctl = (gu32*)(ws + WS_CTL);
    for (int u = threadIdx.x; u < (LDS_BYTES - LDSCTL_OFF) / 4; u += NWAVES * 64) ((LAS unsigned*)(lds3 + LDSCTL_OFF))[u] = 0u;
    __syncthreads();
    XcdBarrier bar = xcd_barrier_post((unsigned*)(ctl + CW_BAR), MISC + 8);
#if defined(PROBE_STAMPS)
    int nb_ = 0;
    if (blockIdx.x == 0 && threadIdx.x == 0) MISC[16] = (unsigned)__builtin_amdgcn_s_memrealtime();
#define GRID_BAR() do { xcd_barrier(bar); ++nb_; if (blockIdx.x == 0 && threadIdx.x == 0) MISC[16 + nb_] = (unsigned)__builtin_amdgcn_s_memrealtime(); } while (0)
#else
#define GRID_BAR() xcd_barrier(bar)
#endif
#define IN(i) (args.in[i])
    float* out = args.out;
    bf16_t* W0in = (bf16_t*)(ws + WS_W0IN); bf16_t* W0out = (bf16_t*)(ws + WS_W0OUT); bf16_t* Wup0 = (bf16_t*)(ws + WS_WUP0); bf16_t* Wdn0 = (bf16_t*)(ws + WS_WDN0);
    bf16_t* W1in = (bf16_t*)(ws + WS_W1IN); bf16_t* Wuq = (bf16_t*)(ws + WS_WUQ); bf16_t* Wukv = (bf16_t*)(ws + WS_WUKV); bf16_t* W1out = (bf16_t*)(ws + WS_W1OUT);
    bf16_t* Wup1 = (bf16_t*)(ws + WS_WUP1); bf16_t* Wdn1 = (bf16_t*)(ws + WS_WDN1);
    bf16_t* XB = (bf16_t*)(ws + WS_XB); bf16_t* YMIX = (bf16_t*)(ws + WS_YMIX); bf16_t* PROJ0 = (bf16_t*)(ws + WS_BIG);
    float* YRAW = out; bf16_t* YSSM = (bf16_t*)(out + (size_t)M * 512); bf16_t* STB = (bf16_t*)(out + (size_t)M * 768); bf16_t* XST = (bf16_t*)(ws + WS_XST); bf16_t* BT = (bf16_t*)(ws + WS_BT); float* ASUM = (float*)(ws + WS_ASUM); float* SLOC = (float*)(ws + WS_SLOC); float* DT = (float*)(ws + WS_DT); bf16_t* GB = (bf16_t*)(ws + WS_G); float* BONUS = (float*)(ws + WS_BONUS);
    bf16_t* W2T = (bf16_t*)(ws + WS_W2T); bf16_t* A2T = (bf16_t*)(ws + WS_A2T); bf16_t* G2T = (bf16_t*)(ws + WS_G2T); bf16_t* ACT = (bf16_t*)(ws + WS_GU); bf16_t* HALO = (bf16_t*)(ws + WS_GU + 176 * MiB);
    bf16_t* PROJ1 = (bf16_t*)(ws + WS_PROJ1); bf16_t* QM = (bf16_t*)(ws + WS_QM); bf16_t* KVM = (bf16_t*)(ws + WS_KVM); bf16_t* KPE = (bf16_t*)(ws + WS_KPE); float* RS = (float*)(ws + WS_RS); float* CSTAB = (float*)(ws + WS_CSTAB); float* STATS = (float*)(ws + WS_CSTAB + 4 * MiB); bf16_t* VTS = (bf16_t*)(ws + WS_VTS); bf16_t* VTM = (bf16_t*)(ws + WS_VTM);
    const int* pos = (const int*)args.in[1];

    {
        PHASE_IDS();
    {
        LAS float* scr = (LAS float*)(lds3 + wave * 16384);
        transpose_matrix(IN(2), 1024, 3336, W0in, L0P, 1024, scr, gw, NGW, lane, nullptr);
        transpose_matrix(IN(20), 1024, 1024, W0out, 1024, 1024, scr, gw, NGW, lane, nullptr);
        transpose_matrix(IN(23), 1024, 5632, Wup0, 5632, 1024, scr, gw, NGW, lane, nullptr, true);
        transpose_matrix(IN(26), 2816, 1024, Wdn0, 1024, 2816, scr, gw, NGW, lane, nullptr);
        transpose_matrix(IN(29), 1024, 1952, W1in, L1P, 1024, scr, gw, NGW, lane, nullptr);
        transpose_matrix(IN(31), 256, 768, Wuq, 768, 256, scr, gw, NGW, lane, IN(30));
        transpose_matrix(IN(33), 128, 1024, Wukv, 1024, 256, scr, gw, NGW, lane, IN(32));
        for (int i = gtid; i < 1024 * 16; i += NT) { const int n = i >> 4, c = i & 15; *(v4u*)(Wukv + (size_t)n * 256 + 128 + c * 8) = (v4u){0u, 0u, 0u, 0u}; }
        transpose_matrix(IN(34), 1024, 1024, W1out, 1024, 1024, scr, gw, NGW, lane, nullptr);
        transpose_matrix(IN(37), 1024, 5632, Wup1, 5632, 1024, scr, gw, NGW, lane, nullptr, true);
        transpose_matrix(IN(40), 2816, 1024, Wdn1, 1024, 2816, scr, gw, NGW, lane, nullptr);
        transpose_matrix(IN(5), 64, 512, W2T, 512, 64, scr, gw, NGW, lane, nullptr);
        transpose_matrix(IN(7), 64, 512, A2T, 512, 64, scr, gw, NGW, lane, nullptr);
        transpose_matrix(IN(8), 128, 512, G2T, 512, 128, scr, gw, NGW, lane, nullptr);
        const float* x = IN(0);
        {
            constexpr size_t TOT4 = (size_t)M * DM / 4;
            for (size_t i = gtid; i < TOT4; i += (size_t)NT * 8) {
                f32x4 v[8];
#pragma unroll
                for (int u = 0; u < 8; ++u) v[u] = *(const f32x4*)(x + (i + (size_t)u * NT) * 4);
#pragma unroll
                for (int u = 0; u < 8; ++u) { uint2 w; w.x = cvtpk(v[u][0], v[u][1]); w.y = cvtpk(v[u][2], v[u][3]); *(uint2*)(XB + (i + (size_t)u * NT) * 4) = w; }
            }
        }
    }
    }
    GRID_BAR();
    {
        PHASE_IDS();
    GEMM_PHASE(EpiBf16S, XB, DM, W0in, 1024, L0P, 1024, PROJ0, nullptr, L0P, 0);
    }
    GRID_BAR();
    {
        PHASE_IDS();
        const int blk = (int)blockIdx.x, m0 = blk * 128;
        {   LAS bf16_t* scr = (LAS bf16_t*)(lds3 + wave * 16384);
#pragma unroll 1
            for (int k = 0; k < 4; ++k) ssd_conv_tile((2 * blk + (k & 1)) * 16 + wave + 8 * (k >> 1), lane, scr, PROJ0, IN(14), IN(15), XB, XST, BT);
            for (int i = tid; i < 1024; i += NWAVES * 64) { const int m = m0 + (i >> 3); DT[(size_t)m * 8 + (i & 7)] = softplusf_(bf2f(PROJ0[(size_t)m * L0P + 3328 + (i & 7)]) + IN(16)[i & 7]); }
        }
        __syncthreads();
#if defined(PROBE_STAMPS)
        if (blockIdx.x == 0 && threadIdx.x == 0) MISC[16 + 29] = (unsigned)__builtin_amdgcn_s_memrealtime();
#endif
        ssd_s1_unit(blk * 8 + wave, lane, (LAS float*)(lds3 + wave * 16384), XST, BT, DT, IN(17), SLOC, ASUM);
    }
    GRID_BAR();
    {
        PHASE_IDS();
        ssd_s2_all(SLOC, ASUM, STB, gtid, NT);
#if defined(PROBE_STAMPS)
        __syncthreads(); if (blockIdx.x == 0 && threadIdx.x == 0) MISC[16 + 23] = (unsigned)__builtin_amdgcn_s_memrealtime();
#endif
        rwkv_phase((LAS float*)lds3, tid, lane, wave, (int)blockIdx.x, PROJ0, IN(3), IN(4), IN(6), IN(9), IN(10), IN(11), W2T, A2T, G2T, YRAW, GB, BONUS);
    }
    GRID_BAR();
    {
        PHASE_IDS();
        const int blk = (int)blockIdx.x;
        ssd_s3_unit(blk * 8 + wave, lane, (LAS float*)(lds3 + wave * 16384), XB, XST, STB, DT, IN(17), IN(18), YSSM);
        __syncthreads();
        ssm_gate_norm_all(YSSM, PROJ0, IN(19), YMIX, blk * 256 + wave, blk * 256 + 256, lane);
        rwkv_post_all(YRAW, PROJ0, IN(3), BONUS, GB, IN(12), IN(13), YMIX, gw, NGW, lane);
    }
    GRID_BAR();
    {
        PHASE_IDS();
    GEMM_PHASE(EpiResid, YMIX, DM, W0out, 1024, 1024, 1024, IN(0), out, ALPHA, 0);
    }
    GRID_BAR();
    {
        PHASE_IDS();
    ln_rows<1>(out, XB, STATS, IN(21), IN(22), gw, NGW, lane);
    }
    GRID_BAR();
    {
        PHASE_IDS();
        { pg8::Gemm g_{XB, Wup0, M / 32, DFF, 1024, DM, 1024, 4096, 8192, 256, 512, 1}; pg8::StaticOrder S_; S_.init(M / 32, DFF, G, (int)blockIdx.x);
          pg8::EpiBf16S E_{HALO, nullptr, DFF, 0}; pg8::gemm_phase<pg8::EpiBf16S, pg8::StaticOrder, true, true>(lds3, g_, S_, E_); }
    }
    GRID_BAR();
    {
        PHASE_IDS();
        { pg8::Gemm g_{XB, Wup0, M, 2 * DFF, 1024, DM, 1024}; pg8::StaticOrder S_; S_.init(M, 2 * DFF, G, (int)blockIdx.x);
          pg8::EpiConvAct E_{ACT, HALO, IN(24), IN(25), DFF, SEQ}; pg8::gemm_phase<pg8::EpiConvAct, pg8::StaticOrder, true, true>(lds3, g_, S_, E_); }
    }
    GRID_BAR();
    {
        PHASE_IDS();
    GEMM_PHASE(EpiResidLN, ACT, DFF, Wdn0, DFF, 1024, DFF, out, STATS, IN(21), IN(22), ALPHA, 0);
    }
    GRID_BAR();
    {
        PHASE_IDS();
    ln_rows<1>(out, XB, STATS, IN(27), IN(28), gw, NGW, lane);
    }
    GRID_BAR();
    {
        PHASE_IDS();
    GEMM_PHASE(EpiBf16S, XB, DM, W1in, 1024, L1P, 1024, PROJ1, nullptr, L1P, 0);
    }
    GRID_BAR();
    {
        PHASE_IDS();
    mla_prep_all(PROJ1, pos, RS, KPE, CSTAB, gw, NGW, lane);
    }
    GRID_BAR();
    {
        PHASE_IDS();
    GEMM_PHASE(EpiBf16S, PROJ1 + 1536, L1P, Wuq, 256, 768, 256, QM, RS, 768, 2);
    GEMM_PHASE(EpiBf16S, PROJ1 + 1792, L1P, Wukv, 256, 1024, 256, KVM, RS + 1, 1024, 2);
    }
    GRID_BAR();
    {
        PHASE_IDS();
    rope_q_all(QM, CSTAB, gtid, NT);
    {
        LAS bf16_t* scr = (LAS bf16_t*)(lds3 + wave * 16384);
        for (int it = gw; it < 8192; it += NGW) { const int which = it >> 12, r = it & 4095, bh = r >> 5, tt = r & 31, b = bh >> 3, h = bh & 7;
            if (which == 0) transpose_tile64(PROJ1 + ((size_t)b * SEQ + tt * 64) * L1P + 1024 + h * 64, L1P, VTS + (size_t)bh * 64 * SEQ + tt * 64, SEQ, scr, lane);
            else            transpose_tile64(KVM + ((size_t)b * SEQ + tt * 64) * 1024 + h * 128 + 64, 1024, VTM + (size_t)bh * 64 * SEQ + tt * 64, SEQ, scr, lane); }
    }
    }
    GRID_BAR();
    {
        PHASE_IDS();
    {
        for (int g2 = (int)blockIdx.x; g2 < 256; g2 += G) { const int bh = g2 >> 1, part = g2 & 1;
#pragma unroll 1
            for (int i = 0; i < 4; ++i) { const int sbk = part ? ((i == 0) ? 1 : (i == 1) ? 6 : (i == 2) ? 2 : 5) : ((i == 0) ? 0 : (i == 1) ? 7 : (i == 2) ? 3 : 4);
                sb_block(bh, sbk, tid, lane, wave, lds3, PROJ1, VTS, YMIX); } }
        for (int g2 = (int)blockIdx.x; g2 < 256; g2 += G) { const int bh = g2 >> 1, part = g2 & 1;
#pragma unroll 1
            for (int i = 0; i < 4; ++i) { const int sbk = part ? ((i == 0) ? 1 : (i == 1) ? 6 : (i == 2) ? 2 : 5) : ((i == 0) ? 0 : (i == 1) ? 7 : (i == 2) ? 3 : 4);
                mla_block(bh, sbk, tid, lane, wave, lds3, QM, KVM, KPE, VTM, YMIX); } }
    }
    }
    GRID_BAR();
    {
        PHASE_IDS();
    GEMM_PHASE(EpiResidLN, YMIX, DM, W1out, 1024, 1024, 1024, out, STATS, IN(27), IN(28), ALPHA, 0);
    }
    GRID_BAR();
    {
        PHASE_IDS();
    ln_rows<1>(out, XB, STATS, IN(35), IN(36), gw, NGW, lane);
    }
    GRID_BAR();
    {
        PHASE_IDS();
        { pg8::Gemm g_{XB, Wup1, M / 32, DFF, 1024, DM, 1024, 4096, 8192, 256, 512, 1}; pg8::StaticOrder S_; S_.init(M / 32, DFF, G, (int)blockIdx.x);
          pg8::EpiBf16S E_{HALO, nullptr, DFF, 0}; pg8::gemm_phase<pg8::EpiBf16S, pg8::StaticOrder, true, true>(lds3, g_, S_, E_); }
    }
    GRID_BAR();
    {
        PHASE_IDS();
        { pg8::Gemm g_{XB, Wup1, M, 2 * DFF, 1024, DM, 1024}; pg8::StaticOrder S_; S_.init(M, 2 * DFF, G, (int)blockIdx.x);
          pg8::EpiConvAct E_{ACT, HALO, IN(38), IN(39), DFF, SEQ}; pg8::gemm_phase<pg8::EpiConvAct, pg8::StaticOrder, true, true>(lds3, g_, S_, E_); }
    }
    GRID_BAR();
    {
        PHASE_IDS();
    GEMM_PHASE(EpiResidLN, ACT, DFF, Wdn1, DFF, 1024, DFF, out, STATS, IN(35), IN(36), ALPHA, 0);
    }
    GRID_BAR();
    {
        PHASE_IDS();
    ln_rows<2>(out, XB, STATS, IN(41), IN(42), gw, NGW, lane);
    #if defined(PROBE_STAMPS)
    __syncthreads();
    if (blockIdx.x == 0 && threadIdx.x == 0) {
        MISC[16 + 22] = (unsigned)__builtin_amdgcn_s_memrealtime();
#if defined(PROBE_ACC)
        const unsigned d1 = MISC[16 + PROBE_ACC];
#else
        const unsigned d1 = MISC[16 + PROBE_T1_HI] - MISC[16 + PROBE_T1_LO];
#endif
        const unsigned long long spin = 100ull * d1;
        const unsigned long long t0 = __builtin_amdgcn_s_memrealtime();
        while (__builtin_amdgcn_s_memrealtime() - t0 < spin) __builtin_amdgcn_s_sleep(8);
    }
#endif
}
}

extern "C" void kernel_launch(void* const* d_in, const int* in_sizes, int n_in, void* d_out, int out_size, void* d_ws, size_t ws_size, hipStream_t stream) {
    static int grid = 0;
    if (grid == 0) {
        if (n_in != 43 || ws_size < WS_NEED || out_size != M * DM) { fprintf(stderr, "kernel_launch: unexpected n_in %d / ws %zu / out %d\n", n_in, ws_size, out_size); grid = -1; return; }
        int dev = 0, cus = 0, per_cu = 0;
        if (hipGetDevice(&dev) != hipSuccess || hipDeviceGetAttribute(&cus, hipDeviceAttributeMultiprocessorCount, dev) != hipSuccess) { grid = -1; return; }
        if (hipFuncSetAttribute((const void*)fwd_mega, hipFuncAttributeMaxDynamicSharedMemorySize, LDS_BYTES) != hipSuccess) { fprintf(stderr, "kernel_launch: hipFuncSetAttribute failed\n"); grid = -1; return; }
        if (hipOccupancyMaxActiveBlocksPerMultiprocessor(&per_cu, (const void*)fwd_mega, NWAVES * 64, LDS_BYTES) != hipSuccess || per_cu < 1) fprintf(stderr, "kernel_launch: occupancy query reports %d\n", per_cu);
        (void)hipGetLastError();
        grid = cus;
    }
    if (grid < 0) return;
    (void)hipMemsetAsync((char*)d_ws + WS_CTL, 0, CTL_ZERO_BYTES, stream);
    Args a{};
    for (int i = 0; i < 43; ++i) a.in[i] = (const float*)d_in[i];
    a.out = (float*)d_out; a.ws = (unsigned char*)d_ws;
    hipLaunchKernelGGL(fwd_mega, dim3(grid), dim3(NWAVES * 64), LDS_BYTES, stream, a);
}
```

```cpp
#include <hip/hip_runtime.h>
#include <cstdio>
#include <cstdint>
#include <cmath>
namespace pg8 {
#define PG8_LAS __attribute__((address_space(3)))
typedef unsigned short bf16_t;
typedef short bf16x8 __attribute__((ext_vector_type(8)));
typedef float f32x4 __attribute__((ext_vector_type(4)));
typedef unsigned u32x4 __attribute__((ext_vector_type(4)));
constexpr int BM = 256, BK = 64, HALF = 128, HTB = HALF * BK * 2  , STAGE_BYTES = 8 * HTB, NXCD = 8, WGM = 8;

__host__ __device__ __forceinline__ int lds_byte(int r, int c) { const int st = (r >> 4) * 2 + (c >> 5), rr = r & 15, cc = c & 31, ob = rr * 64 + cc * 2; return st * 1024 + (ob ^ (((ob >> 9) & 1) << 5)); }
__host__ __device__ __forceinline__ void stage_rc(int b, int& R, int& C) { const int st = b / 1024, sb = b % 1024, swz = sb ^ (((sb >> 9) & 1) << 5); R = (st >> 1) * 16 + swz / 64; C = (st & 1) * 32 + (swz % 64) / 2; }
__host__ __device__ __forceinline__ int perm32(int rho) { const int n = rho >> 4, i = rho & 15; return 8 * (i >> 2) + 4 * n + (i & 3); }

struct Unit { int pm, pn; };
struct Gemm { const bf16_t* A; const bf16_t* Bt; int M, N, K, lda, ldb; int hrA = 128, trA = 256, hrB = 128, trB = 256, gatherA = 0; };

struct StaticOrder {
    int nM, nN, nwg, G, c;
    __host__ __device__ void init(int M, int N, int G_, int c_) { nM = M / BM; nN = N / BM; nwg = nM * nN; G = G_; c = c_; }
    __host__ __device__ bool next(int i, Unit& u) const {
        const long L = (long)i * G + c; if (L >= nwg) return false;
        int wgid = (int)L; { const int q = nwg / NXCD, r = nwg % NXCD, xcd = wgid % NXCD, off = wgid / NXCD; wgid = (xcd < r ? xcd * (q + 1) : r * (q + 1) + (xcd - r) * q) + off; }
        const int nig = WGM * nN, gid = wgid / nig, fm = gid * WGM, gsz = (nM - fm) < WGM ? (nM - fm) : WGM;
        u.pm = fm + ((wgid % nig) % gsz); u.pn = (wgid % nig) / gsz; return true;
    }
    __device__ __forceinline__ void a_ready(const Unit&) const {}
    __device__ __forceinline__ void done(const Unit&) const {}
};


__device__ __forceinline__ unsigned cvt_pk_bf16(float lo, float hi) { unsigned r; asm volatile("v_cvt_pk_bf16_f32 %0, %1, %2" : "=v"(r) : "v"(lo), "v"(hi)); return r; }
struct EpiBf16S {
    static constexpr bool PERM = true, AFTER_DRAIN = false;
    bf16_t* O; const float* rowscale; int ldc; int rs_stride;
    __device__ __forceinline__ void operator()(const f32x4 (&acc)[2][2][4][2], const Unit& u, int wr, int wc, int fr, int fq) const {
        const int row0 = u.pm * BM + wr * 64 + fr, col0 = u.pn * BM + wc * 32 + 8 * fq;
#pragma unroll
        for (int ai = 0; ai < 2; ++ai)
#pragma unroll
            for (int m = 0; m < 4; ++m) { const int row = row0 + ai * HALF + m * 16; const float sc = rowscale ? rowscale[(size_t)row * rs_stride] : 1.f;
                bf16_t* rowp = O + (size_t)row * ldc + col0;
#pragma unroll
                for (int bj = 0; bj < 2; ++bj) { const f32x4 v0 = acc[ai][bj][m][0] * sc, v1 = acc[ai][bj][m][1] * sc;
                    u32x4 w; w.x = cvt_pk_bf16(v0[0], v0[1]); w.y = cvt_pk_bf16(v0[2], v0[3]); w.z = cvt_pk_bf16(v1[0], v1[1]); w.w = cvt_pk_bf16(v1[2], v1[3]);
                    *(u32x4*)(rowp + bj * HALF) = w; } }
    }
};
struct EpiResid {
    static constexpr bool PERM = false, AFTER_DRAIN = false;
    const float* hin; float* hout; float alpha; int pad;
    __device__ __forceinline__ void operator()(const f32x4 (&acc)[2][2][4][2], const Unit& u, int wr, int wc, int fr, int fq) const {
        const int row0 = u.pm * BM + wr * 64 + fr, col0 = u.pn * BM + wc * 32 + 4 * fq;
#pragma unroll
        for (int ai = 0; ai < 2; ++ai)
#pragma unroll
            for (int m = 0; m < 4; ++m) { const size_t off = (size_t)(row0 + ai * HALF + m * 16) * 1024 + col0;
#pragma unroll
                for (int bj = 0; bj < 2; ++bj)
#pragma unroll
                    for (int n = 0; n < 2; ++n) { const size_t i = off + bj * HALF + n * 16; const f32x4 h = *(const f32x4*)(hin + i); *(f32x4*)(hout + i) = h * alpha + acc[ai][bj][m][n]; } }
    }
};

struct EpiResidLN {
    static constexpr bool PERM = false, AFTER_DRAIN = false;
    float* hio; const float* stats; const float* g; const float* b; float alpha; int pad;
    __device__ __forceinline__ void operator()(const f32x4 (&acc)[2][2][4][2], const Unit& u, int wr, int wc, int fr, int fq) const {
        const int row0 = u.pm * BM + wr * 64 + fr, col0 = u.pn * BM + wc * 32 + 4 * fq;
        f32x4 gg[2][2], bb[2][2];
#pragma unroll
        for (int bj = 0; bj < 2; ++bj)
#pragma unroll
            for (int n = 0; n < 2; ++n) { gg[bj][n] = *(const f32x4*)(g + col0 + bj * HALF + n * 16) * alpha; bb[bj][n] = *(const f32x4*)(b + col0 + bj * HALF + n * 16) * alpha; }
#pragma unroll
        for (int ai = 0; ai < 2; ++ai)
#pragma unroll
            for (int m = 0; m < 4; ++m) { const int row = row0 + ai * HALF + m * 16; const size_t off = (size_t)row * 1024 + col0;
                const float mu = stats[2 * row], rs = stats[2 * row + 1];
#pragma unroll
                for (int bj = 0; bj < 2; ++bj)
#pragma unroll
                    for (int n = 0; n < 2; ++n) { const size_t i = off + bj * HALF + n * 16; const f32x4 p = *(const f32x4*)(hio + i); *(f32x4*)(hio + i) = (p - mu) * rs * gg[bj][n] + bb[bj][n] + acc[ai][bj][m][n]; } }
    }
};

template <int CTRL> __device__ __forceinline__ float pg_dpp(float x) { return __builtin_bit_cast(float, __builtin_amdgcn_update_dpp(0, __builtin_bit_cast(int, x), CTRL, 0xF, 0xF, true)); }
struct EpiConvAct {
    static constexpr bool PERM = true, AFTER_DRAIN = false;
    bf16_t* act; const bf16_t* halo; const float* cw; const float* cb; int dff; int seq;
    __device__ __forceinline__ void operator()(const f32x4 (&acc)[2][2][4][2], const Unit& u, int wr, int wc, int fr, int fq) const {
        typedef unsigned u32x2e __attribute__((ext_vector_type(2)));
#pragma unroll
        for (int n = 0; n < 2; ++n) {
            const int ch0 = u.pn * 128 + wc * 32 + 8 * fq + 4 * n;
            const f32x4 w0 = *(const f32x4*)(cw + ch0), w1 = *(const f32x4*)(cw + dff + ch0), w2 = *(const f32x4*)(cw + 2 * dff + ch0), bb = *(const f32x4*)(cb + ch0);
#pragma unroll
            for (int ai = 0; ai < 2; ++ai) {
                const int rb64 = u.pm * BM + ai * HALF + wr * 64;
                f32x4 P = {0.f, 0.f, 0.f, 0.f};
                if ((rb64 & (seq - 1)) != 0 && fr >= 14) { const u32x2e hv = *(const u32x2e*)(halo + (size_t)(2 * (rb64 / 64 - 1) + (fr - 14)) * dff + ch0);
                    P[0] = __builtin_bit_cast(float, hv.x << 16); P[1] = __builtin_bit_cast(float, hv.x & 0xffff0000u); P[2] = __builtin_bit_cast(float, hv.y << 16); P[3] = __builtin_bit_cast(float, hv.y & 0xffff0000u); }
#pragma unroll
                for (int m = 0; m < 4; ++m) {
                    const f32x4 Gv = acc[ai][0][m][n], Uv = acc[ai][1][m][n];
                    float o[4];
#pragma unroll
                    for (int e = 0; e < 4; ++e) {
                        const float t1 = pg_dpp<0x111>(Gv[e]), t2 = pg_dpp<0x112>(Gv[e]), p1 = pg_dpp<0x10F>(P[e]), p2 = pg_dpp<0x10E>(P[e]);
                        const float g1 = (fr >= 1) ? t1 : p1, g2 = (fr >= 2) ? t2 : p2;
                        const float y = bb[e] + w0[e] * g2 + w1[e] * g1 + w2[e] * Gv[e];
                        o[e] = y * __builtin_amdgcn_rcpf(1.f + __builtin_amdgcn_exp2f(-1.4426950408889634f * y)) * Uv[e];
                    }
                    u32x2e w; w.x = cvt_pk_bf16(o[0], o[1]); w.y = cvt_pk_bf16(o[2], o[3]);
                    *(u32x2e*)(act + (size_t)(rb64 + m * 16 + fr) * dff + ch0) = w;
                    P = Gv;
                }
            }
        }
    }
};

template <class Epi, class Sched, bool ALIGN_EPI = false, bool SP2 = false>
__device__ __forceinline__ void gemm_phase(PG8_LAS unsigned char* lds, const Gemm g, const Sched& S, const Epi& E) {
    int tid = threadIdx.x; asm volatile("" : "+v"(tid));
    const int wid = __builtin_amdgcn_readfirstlane(tid >> 6), lane = tid & 63, wr = wid >> 2, wc = wid & 3, fr = lane & 15, fq = lane >> 4;
    const int K = g.K, nt = K / BK;
    unsigned voffA[2], voffB[2];
#pragma unroll
    for (int i = 0; i < 2; ++i) { int R, C; stage_rc(tid * 16 + i * 8192, R, C); const int Rb = Epi::PERM ? ((R & ~31) + perm32(R & 31)) : R;
        const int Ra = g.gatherA ? (64 * (R >> 1) + 62 + (R & 1)) : R;
        voffA[i] = (unsigned)(Ra * g.lda + C) * 2u; voffB[i] = (unsigned)(Rb * g.ldb + C) * 2u; }
    const size_t kstep = (size_t)(BK * 2);
    const size_t hstepA = (size_t)g.hrA * g.lda * 2, hstepB = (size_t)g.hrB * g.ldb * 2;
    const size_t tstepA = (size_t)g.trA * g.lda * 2, tstepB = (size_t)g.trB * g.ldb * 2;
    const unsigned ldsw = (unsigned)wid * 1024u;
    const int aoff = lds_byte(wr * 64 + fr, fq * 8), boff = lds_byte(wc * 32 + fr, fq * 8);
#define PG8_SA(b, h) (((b) * 2 + (h)) * HTB)
#define PG8_SB(b, h) ((4 + (b) * 2 + (h)) * HTB)
#define PG8_STAGE(bufoff, gbase, voff) do { _Pragma("unroll") for (int _i = 0; _i < 2; ++_i) \
        __builtin_amdgcn_global_load_lds((const unsigned*)((const char*)(gbase) + (voff)[_i]), (PG8_LAS unsigned*)(lds + (bufoff) + ldsw + _i * 8192), 16, 0, 0); } while (0)
#define PG8_LDA(dst, b, h) do { _Pragma("unroll") for (int m = 0; m < 4; ++m) _Pragma("unroll") for (int k = 0; k < 2; ++k) dst[m][k] = *(const PG8_LAS bf16x8*)(lds + PG8_SA(b, h) + aoff + m * 2048 + k * 1024); } while (0)
#define PG8_LDB(dst, b, h) do { _Pragma("unroll") for (int n = 0; n < 2; ++n) _Pragma("unroll") for (int k = 0; k < 2; ++k) dst[n][k] = *(const PG8_LAS bf16x8*)(lds + PG8_SB(b, h) + boff + n * 2048 + k * 1024); } while (0)
#define PG8_MMA(ai, bj, At, Bt) do { __builtin_amdgcn_s_setprio(1); _Pragma("unroll") for (int m = 0; m < 4; ++m) _Pragma("unroll") for (int n = 0; n < 2; ++n) _Pragma("unroll") for (int k = 0; k < 2; ++k) \
        acc[ai][bj][m][n] = __builtin_amdgcn_mfma_f32_16x16x32_bf16(Bt[n][k], At[m][k], acc[ai][bj][m][n], 0, 0, 0); __builtin_amdgcn_s_setprio(0); } while (0)
#define PG8_WAIT_V(n) asm volatile("s_waitcnt vmcnt(" #n ")" ::: "memory")
#define PG8_WAIT_L(n) asm volatile("s_waitcnt lgkmcnt(" #n ")" ::: "memory")
#define PG8_BAR __builtin_amdgcn_s_barrier()
#define PG8_SCHED __builtin_amdgcn_sched_barrier(0)
    Unit cur, nxt; int ui = 0;
    if (!S.next(0, cur)) return;
    f32x4 acc[2][2][4][2];
#pragma unroll
    for (int a = 0; a < 2; ++a)
#pragma unroll
        for (int b = 0; b < 2; ++b)
#pragma unroll
            for (int m = 0; m < 4; ++m)
#pragma unroll
                for (int n = 0; n < 2; ++n) acc[a][b][m][n] = (f32x4){0.f, 0.f, 0.f, 0.f};
    bf16x8 At[4][2], B0[2][2], B1[2][2];
    const char* cA = (const char*)g.A + (size_t)cur.pm * tstepA; const char* cB = (const char*)g.Bt + (size_t)cur.pn * tstepB;
    S.a_ready(cur);
    if constexpr (SP2) {
        PG8_STAGE(PG8_SB(0, 0), cB, voffB); PG8_STAGE(PG8_SB(0, 1), cB + hstepB, voffB); PG8_STAGE(PG8_SA(0, 0), cA, voffA); PG8_STAGE(PG8_SA(0, 1), cA + hstepA, voffA);
        if (wr == 1) PG8_BAR;
        PG8_WAIT_V(2); PG8_BAR;
        PG8_STAGE(PG8_SB(1, 0), cB + kstep, voffB); PG8_STAGE(PG8_SA(1, 0), cA + kstep, voffA); PG8_STAGE(PG8_SB(1, 1), cB + hstepB + kstep, voffB);
        PG8_WAIT_V(6); PG8_BAR;
    } else {
        PG8_STAGE(PG8_SB(0, 0), cB, voffB); PG8_STAGE(PG8_SA(0, 0), cA, voffA); PG8_STAGE(PG8_SB(0, 1), cB + hstepB, voffB); PG8_STAGE(PG8_SA(0, 1), cA + hstepA, voffA);
        if (wr == 1) PG8_BAR;
        PG8_WAIT_V(4); PG8_BAR;
        PG8_STAGE(PG8_SB(1, 0), cB + kstep, voffB); PG8_STAGE(PG8_SA(1, 0), cA + kstep, voffA); PG8_STAGE(PG8_SB(1, 1), cB + hstepB + kstep, voffB);
        PG8_WAIT_V(6); PG8_BAR;
    }
    for (;;) {
        const bool has_next = S.next(ui + 1, nxt);
        const char* nA = has_next ? (const char*)g.A + (size_t)nxt.pm * tstepA : cA; const char* nB = has_next ? (const char*)g.Bt + (size_t)nxt.pn * tstepB : cB;
        for (int t = 0; t < nt; t += 2) {
            const bool last = (t == nt - 2);
            const char* a1 = cA + (size_t)(t + 1) * kstep;
            const char* a2 = last ? nA : cA + (size_t)(t + 2) * kstep; const char* b2 = last ? nB : cB + (size_t)(t + 2) * kstep;
            const char* a3 = a2 + kstep; const char* b3 = b2 + kstep;
            if (last && has_next) S.a_ready(nxt);
            if constexpr (SP2) {
            PG8_LDB(B0, 0, 0); PG8_LDB(B1, 0, 1); PG8_SCHED; PG8_LDA(At, 0, 0); PG8_STAGE(PG8_SA(1, 1), a1 + hstepA, voffA);
            PG8_WAIT_V(8); PG8_WAIT_L(0); PG8_BAR; PG8_MMA(0, 0, At, B0); PG8_MMA(0, 1, At, B1); PG8_BAR; PG8_SCHED;
            PG8_LDA(At, 0, 1); PG8_STAGE(PG8_SB(0, 0), b2, voffB); PG8_STAGE(PG8_SB(0, 1), b2 + hstepB, voffB); PG8_STAGE(PG8_SA(0, 0), a2, voffA);
            PG8_WAIT_V(8); PG8_WAIT_L(0); PG8_BAR; PG8_MMA(1, 0, At, B0); PG8_MMA(1, 1, At, B1); PG8_BAR; PG8_SCHED;
            PG8_LDB(B0, 1, 0); PG8_LDB(B1, 1, 1); PG8_SCHED; PG8_LDA(At, 1, 0); PG8_STAGE(PG8_SA(0, 1), a2 + hstepA, voffA);
            PG8_WAIT_V(8); PG8_WAIT_L(0); PG8_BAR; PG8_MMA(0, 0, At, B0); PG8_MMA(0, 1, At, B1); PG8_BAR; PG8_SCHED;
            PG8_LDA(At, 1, 1); PG8_STAGE(PG8_SB(1, 0), b3, voffB); PG8_STAGE(PG8_SB(1, 1), b3 + hstepB, voffB); PG8_STAGE(PG8_SA(1, 0), a3, voffA);
            PG8_WAIT_V(8); PG8_WAIT_L(0); PG8_BAR; PG8_MMA(1, 0, At, B0); PG8_MMA(1, 1, At, B1); PG8_BAR; PG8_SCHED;
            } else {
            PG8_LDB(B0, 0, 0); PG8_SCHED; PG8_LDA(At, 0, 0); PG8_STAGE(PG8_SA(1, 1), a1 + hstepA, voffA);
            PG8_WAIT_L(8); PG8_BAR; PG8_WAIT_L(0); PG8_MMA(0, 0, At, B0); PG8_BAR; PG8_SCHED;
            PG8_LDB(B1, 0, 1); PG8_STAGE(PG8_SB(0, 0), b2, voffB);
            PG8_BAR; PG8_WAIT_L(0); PG8_MMA(0, 1, At, B1); PG8_BAR;
            PG8_LDA(At, 0, 1); PG8_STAGE(PG8_SA(0, 0), a2, voffA);
            PG8_BAR; PG8_WAIT_L(0); PG8_MMA(1, 0, At, B0); PG8_BAR; PG8_SCHED;
            PG8_STAGE(PG8_SB(0, 1), b2 + hstepB, voffB);
            PG8_WAIT_V(6); PG8_BAR; PG8_MMA(1, 1, At, B1); PG8_BAR;
            PG8_LDB(B0, 1, 0); PG8_SCHED; PG8_LDA(At, 1, 0); PG8_STAGE(PG8_SA(0, 1), a2 + hstepA, voffA);
            PG8_WAIT_L(8); PG8_BAR; PG8_WAIT_L(0); PG8_MMA(0, 0, At, B0); PG8_BAR; PG8_SCHED;
            PG8_LDB(B1, 1, 1); PG8_STAGE(PG8_SB(1, 0), b3, voffB);
            PG8_BAR; PG8_WAIT_L(0); PG8_MMA(0, 1, At, B1); PG8_BAR;
            PG8_LDA(At, 1, 1); PG8_STAGE(PG8_SA(1, 0), a3, voffA);
            PG8_BAR; PG8_WAIT_L(0); PG8_MMA(1, 0, At, B0); PG8_BAR; PG8_SCHED;
            PG8_STAGE(PG8_SB(1, 1), b3 + hstepB, voffB);
            PG8_WAIT_V(6); PG8_BAR; PG8_MMA(1, 1, At, B1); PG8_BAR;
            }
        }
        if constexpr (ALIGN_EPI) { if (wr == 0) PG8_BAR; }
        if constexpr (!Epi::AFTER_DRAIN) { E(acc, cur, wr, wc, fr, fq); S.done(cur); }
        if (!has_next) break;
#pragma unroll
        for (int a = 0; a < 2; ++a)
#pragma unroll
            for (int b = 0; b < 2; ++b)
#pragma unroll
                for (int m = 0; m < 4; ++m)
#pragma unroll
                    for (int n = 0; n < 2; ++n) acc[a][b][m][n] = (f32x4){0.f, 0.f, 0.f, 0.f};
        cur = nxt; cA = nA; cB = nB; ++ui;
        if constexpr (ALIGN_EPI) { if (wr == 1) PG8_BAR; }
    }
    PG8_WAIT_V(0);
    if constexpr (!ALIGN_EPI) { if (wr == 0) PG8_BAR; }
    PG8_BAR;
    if constexpr (Epi::AFTER_DRAIN) { E.fused(acc, cur, wr, wc, fr, fq, lds, wid, lane); S.done(cur); }
#undef PG8_SA
#undef PG8_SB
#undef PG8_STAGE
#undef PG8_LDA
#undef PG8_LDB
#undef PG8_MMA
#undef PG8_WAIT_V
#undef PG8_WAIT_L
#undef PG8_BAR
#undef PG8_SCHED
}
}
#define GAS __attribute__((address_space(1)))
#define LAS __attribute__((address_space(3)))
typedef unsigned short bf16;
typedef unsigned v4u __attribute__((ext_vector_type(4)));
typedef float f32x4 __attribute__((ext_vector_type(4)));
typedef short bf16x8 __attribute__((ext_vector_type(8)));
typedef GAS unsigned gu32;
typedef GAS unsigned long long gu64;
#define RLX_AGENT __ATOMIC_RELAXED, __HIP_MEMORY_SCOPE_AGENT
#define LDS_WAIT() asm volatile("s_waitcnt lgkmcnt(0)" ::: "memory")
#define VM_WAIT() asm volatile("s_waitcnt vmcnt(0)" ::: "memory")
__device__ __forceinline__ unsigned long long rt() { return __builtin_amdgcn_s_memrealtime(); }
__device__ __forceinline__ unsigned f2bf(float f) { unsigned u = __builtin_bit_cast(unsigned, f); return (u + 0x7fffu + ((u >> 16) & 1u)) >> 16; }
__device__ __forceinline__ unsigned pk2(float lo, float hi) { return f2bf(lo) | (f2bf(hi) << 16); }

#define XB_TMO      128
#define XB_XCNT(j)  (256  + 64 * (j))
#define XB_XSUB(j)  (1280 + 64 * (j))
#define XB_XGEN(j)  (2304 + 64 * (j))
#define XB_TOP      3328
#define XB_TOPGEN   3392
#define XCD_BAR_WORDS 3456
#define XB_SPIN_CAP (1u << 18)

__device__ __forceinline__ unsigned xb_ld(unsigned* p)              { return __hip_atomic_load(p, __ATOMIC_RELAXED, __HIP_MEMORY_SCOPE_AGENT); }
__device__ __forceinline__ unsigned xb_add(unsigned* p, unsigned v) { return __hip_atomic_fetch_add(p, v, __ATOMIC_RELAXED, __HIP_MEMORY_SCOPE_AGENT); }
__device__ __forceinline__ unsigned xb_xcc_id() { return (unsigned)__builtin_amdgcn_s_getreg((3 << 11) | 20) & 0xFu; }
#define XB_SPIN(cond, bar) do { unsigned _sp = 0; while (cond) { __builtin_amdgcn_s_sleep(1); \
    if ((++_sp & 255u) == 0u) { if (xb_ld(&(bar)[XB_TMO])) break; if (_sp > XB_SPIN_CAP) { atomicAdd(&(bar)[XB_TMO], 1u); break; } } } } while (0)

struct XcdBarrier {
    unsigned* bar; unsigned x;
    volatile LAS unsigned* st;
};

__device__ __forceinline__ XcdBarrier xcd_barrier_post(unsigned* bar, volatile LAS unsigned* st) {
    XcdBarrier b; b.bar = bar; b.x = xb_xcc_id(); b.st = st;
    if (threadIdx.x == 0) (void)xb_add(&bar[XB_XCNT(b.x)], 1u);
    return b;
}
__device__ __forceinline__ void xcd_barrier_complete(unsigned* bar, unsigned x, unsigned& nloc, unsigned& nx) {
    const unsigned G = gridDim.x * gridDim.y * gridDim.z;
    unsigned sum, cnt, mine, sp = 0u;
    for (;;) {
        sum = 0u; cnt = 0u; mine = 0u;
#pragma unroll
        for (unsigned j = 0; j < 16; ++j) { const unsigned c = xb_ld(&bar[XB_XCNT(j)]); sum += c; cnt += (c > 0u) ? 1u : 0u; mine = (j == x) ? c : mine; }
        if (sum == G) break;
        __builtin_amdgcn_s_sleep(1);
        if ((++sp & 255u) == 0u) { if (xb_ld(&bar[XB_TMO])) break; if (sp > XB_SPIN_CAP) { atomicAdd(&bar[XB_TMO], 1u); break; } }
    }
    nloc = mine > 0u ? mine : 1u; nx = cnt > 0u ? cnt : 1u;
}

__device__ __forceinline__ void xcd_barrier(const XcdBarrier& b) {
    asm volatile("s_waitcnt vmcnt(0)" ::: "memory");
    __syncthreads();
    if (threadIdx.x == 0) {
        unsigned* bar = b.bar;
        __builtin_amdgcn_s_waitcnt(0);
        unsigned nloc = b.st[0], nx = b.st[1];
        if (nloc == 0u) { xcd_barrier_complete(bar, b.x, nloc, nx); b.st[0] = nloc; b.st[1] = nx; }
        const unsigned old = xb_add(&bar[XB_XSUB(b.x)], 1u);
        const unsigned gen = old / nloc;
        if (old + 1u == (gen + 1u) * nloc) {
            __builtin_amdgcn_fence(__ATOMIC_RELEASE, "agent");
            asm volatile("s_waitcnt vmcnt(0)" ::: "memory");
            const unsigned og = xb_add(&bar[XB_TOP], 1u);
            const unsigned tg = og / nx;
            if (og + 1u == (tg + 1u) * nx) xb_add(&bar[XB_TOPGEN], 1u);
            else XB_SPIN(xb_ld(&bar[XB_TOPGEN]) == tg, bar);
            __builtin_amdgcn_fence(__ATOMIC_ACQUIRE, "agent");
            xb_add(&bar[XB_XGEN(b.x)], 1u);
            asm volatile("s_waitcnt vmcnt(0)" ::: "memory");
        } else {
            XB_SPIN(xb_ld(&bar[XB_XGEN(b.x)]) == gen, bar);
            __builtin_amdgcn_fence(__ATOMIC_ACQUIRE, "agent");
            asm volatile("s_waitcnt vmcnt(0)" ::: "memory");
        }
    }
    __syncthreads();
}
constexpr int NWAVES = 8;
constexpr int BATCH = 16, SEQ = 2048, DM = 1024, M = BATCH * SEQ;
constexpr int L0P = 3584;
constexpr int L1P = 2048;
constexpr int DFF = 2816;
constexpr float ALPHA = 1.4142135623730951f;
typedef unsigned short bf16_t;
typedef float f32x16 __attribute__((ext_vector_type(16)));

constexpr size_t MiB = 1u << 20;
constexpr size_t WS_CTL = 0, CTL_ZERO_BYTES = 1 * MiB;
constexpr int CW_BAR = 4096;
constexpr size_t WS_W0IN = 2 * MiB, WS_W0OUT = 9 * MiB, WS_WUP0 = 11 * MiB, WS_WDN0 = 22 * MiB, WS_W1IN = 28 * MiB, WS_WUQ = 32 * MiB, WS_WUKV = 33 * MiB,
                 WS_W1OUT = 34 * MiB, WS_WUP1 = 36 * MiB, WS_WDN1 = 47 * MiB;
constexpr size_t WS_XB = 56 * MiB, WS_YMIX = 120 * MiB, WS_BIG = 184 * MiB;
constexpr size_t WS_G = 408 * MiB, WS_BONUS = 440 * MiB, WS_DT = 441 * MiB, WS_XST = 442 * MiB, WS_BT = 474 * MiB, WS_ASUM = 490 * MiB;
constexpr size_t WS_SLOC = 120 * MiB;
constexpr size_t WS_W2T = 53 * MiB, WS_A2T = 53 * MiB + 256 * 1024, WS_G2T = 53 * MiB + 512 * 1024;
constexpr size_t WS_GU = 120 * MiB;
constexpr size_t WS_PROJ1 = 184 * MiB, WS_QM = 312 * MiB, WS_KVM = 360 * MiB, WS_KPE = 424 * MiB, WS_RS = 426 * MiB;
constexpr size_t WS_CSTAB = 492 * MiB;
constexpr size_t WS_VTS = 428 * MiB, WS_VTM = 460 * MiB;
constexpr size_t WS_NEED = 497 * MiB;

constexpr int RING_BYTES = 131072;
constexpr int LDSCTL_OFF = 146432, MISC_OFF = LDSCTL_OFF + 320;
constexpr int LDS_BYTES = 147456;

__device__ __forceinline__ float bf2f(bf16_t b) { return __builtin_bit_cast(float, (unsigned)b << 16); }
__device__ __forceinline__ float sigmoidf_(float x) { return 1.f / (1.f + expf(-x)); }
__device__ __forceinline__ float softplusf_(float x) { return fmaxf(x, 0.f) + log1pf(expf(-fabsf(x))); }
__device__ __forceinline__ float siluf_(float x) { return x / (1.f + expf(-x)); }
__device__ __forceinline__ float wave_sum(float v) {
#pragma unroll
    for (int o = 1; o < 64; o <<= 1) v += __shfl_xor(v, o);
    return v;
}
#define WSYNC() asm volatile("s_waitcnt lgkmcnt(0)" ::: "memory")
typedef float f32x2_t __attribute__((ext_vector_type(2)));
typedef __bf16 bf16x2_t __attribute__((ext_vector_type(2)));
typedef unsigned u32x2 __attribute__((ext_vector_type(2)));
__device__ __forceinline__ unsigned cvtpk(float lo, float hi) { f32x2_t v = {lo, hi}; bf16x2_t b = __builtin_convertvector(v, bf16x2_t); return __builtin_bit_cast(unsigned, b); }
__device__ __forceinline__ float bflo(unsigned u) { return __builtin_bit_cast(float, u << 16); }
__device__ __forceinline__ float bfhi(unsigned u) { return __builtin_bit_cast(float, u & 0xffff0000u); }
__device__ __forceinline__ bf16_t bf1(float x) { return (bf16_t)(cvtpk(x, x) & 0xffffu); }
__device__ __forceinline__ bf16x8 pack8(float a0, float a1, float a2, float a3, float a4, float a5, float a6, float a7) {
    v4u w; w.x = cvtpk(a0, a1); w.y = cvtpk(a2, a3); w.z = cvtpk(a4, a5); w.w = cvtpk(a6, a7); return __builtin_bit_cast(bf16x8, w); }
template <int CTRL> __device__ __forceinline__ float dpp_mov(float x) { return __builtin_bit_cast(float, __builtin_amdgcn_update_dpp(0, __builtin_bit_cast(int, x), CTRL, 0xF, 0xF, true)); }
__device__ __forceinline__ float rowsum16(float x) { x += dpp_mov<0x128>(x); x += dpp_mov<0x124>(x); x += dpp_mov<0x122>(x); x += dpp_mov<0x121>(x); return x; }
__device__ __forceinline__ float rl(float x, int l) { return __builtin_bit_cast(float, __builtin_amdgcn_readlane(__builtin_bit_cast(int, x), l)); }
__device__ __forceinline__ float wave_sum_dpp(float x) { x = rowsum16(x); return (rl(x, 0) + rl(x, 16)) + (rl(x, 32) + rl(x, 48)); }

__device__ __forceinline__ void transpose_matrix(const float* __restrict__ W, int K, int N, bf16_t* __restrict__ WT, int Npad, int ldt, LAS float* scr, int gw, int NGW, int lane, const float* __restrict__ kscale, int& tr_base, bool ffn_interleave = false) {
    (void)scr;
    const int nblk = Npad / 64, nit = (K / 64) * nblk;
    int it0 = gw - (tr_base % NGW); if (it0 < 0) it0 += NGW; tr_base += nit;
    for (int it = it0; it < nit; it += NGW) {
        const int kb = it / nblk, nb = it - kb * nblk, n = nb * 64 + lane, k0 = kb * 64;
        const bool ok = n < N; const float* src = W + (size_t)k0 * N + (ok ? n : 0);
#pragma unroll
        for (int hc = 0; hc < 2; ++hc) {
            float v[32];
#pragma unroll
            for (int i = 0; i < 32; ++i) v[i] = src[(size_t)(hc * 32 + i) * N];
#pragma unroll
            for (int c = 0; c < 4; ++c) { float u[8];
#pragma unroll
                for (int i = 0; i < 8; ++i) { u[i] = ok ? v[c * 8 + i] : 0.f; if (kscale) u[i] *= kscale[k0 + hc * 32 + c * 8 + i]; }
                v4u o; o.x = cvtpk(u[0], u[1]); o.y = cvtpk(u[2], u[3]); o.z = cvtpk(u[4], u[5]); o.w = cvtpk(u[6], u[7]);
                const int nr = ffn_interleave ? ((n < DFF) ? 256 * (n >> 7) + (n & 127) : 256 * ((n - DFF) >> 7) + 128 + ((n - DFF) & 127)) : n;
                *(v4u*)(WT + (size_t)nr * ldt + k0 + hc * 32 + c * 8) = o; }
        }
    }
}

template <int MODE> __device__ __forceinline__ void ln_rows(float* h, bf16_t* hb, float* stats, const float* __restrict__ g, const float* __restrict__ b, int gw, int NGW, int lane) {
    for (int row = gw * 2; row < M; row += NGW * 2) {
        float* p = h + (size_t)row * DM;
        f32x4 v[2][4]; float s[2] = {0.f, 0.f};
#pragma unroll
        for (int r = 0; r < 2; ++r)
#pragma unroll
            for (int j = 0; j < 4; ++j) v[r][j] = *(const f32x4*)(p + r * DM + 4 * lane + 256 * j);
#pragma unroll
        for (int r = 0; r < 2; ++r)
#pragma unroll
            for (int j = 0; j < 4; ++j) s[r] += (v[r][j][0] + v[r][j][1]) + (v[r][j][2] + v[r][j][3]);
        float mean[2], q[2] = {0.f, 0.f}, rstd[2];
#pragma unroll
        for (int r = 0; r < 2; ++r) { mean[r] = wave_sum_dpp(s[r]) * (1.f / DM);
#pragma unroll
            for (int j = 0; j < 4; ++j) { v[r][j] = v[r][j] - mean[r]; q[r] += (v[r][j][0] * v[r][j][0] + v[r][j][1] * v[r][j][1]) + (v[r][j][2] * v[r][j][2] + v[r][j][3] * v[r][j][3]); } }
#pragma unroll
        for (int r = 0; r < 2; ++r) rstd[r] = 1.0f / sqrtf(wave_sum_dpp(q[r]) * (1.f / DM) + 1e-5f);
        if (MODE == 1 && lane < 2) { stats[2 * (row + lane)] = lane ? mean[1] : mean[0]; stats[2 * (row + lane) + 1] = lane ? rstd[1] : rstd[0]; }
#pragma unroll
        for (int j = 0; j < 4; ++j) {
            const int c = 4 * lane + 256 * j;
            const f32x4 gg = *(const f32x4*)(g + c), bb = *(const f32x4*)(b + c);
#pragma unroll
            for (int r = 0; r < 2; ++r) {
                const f32x4 o = v[r][j] * rstd[r] * gg + bb;
                if (MODE == 1) { uint2 w; w.x = cvtpk(o[0], o[1]); w.y = cvtpk(o[2], o[3]); *(uint2*)(hb + (size_t)(row + r) * DM + c) = w; }
                else *(f32x4*)(p + r * DM + c) = o;
            }
        }
    }
}

__device__ __forceinline__ void rwkv_naive_chain(int chain, int lane, LAS float* sm, const bf16_t* __restrict__ proj, const float* __restrict__ mix, const float* __restrict__ w0, const float* __restrict__ w2,
                                                 const float* __restrict__ a0, const float* __restrict__ a2, const float* __restrict__ g2, const float* __restrict__ k_k,
                                                 const float* __restrict__ k_a, const float* __restrict__ r_k, const float* __restrict__ ln_g, const float* __restrict__ ln_b, bf16_t* __restrict__ ymix) {
    LAS float* s_w2 = sm; LAS float* s_a2 = sm + 4096; LAS float* s_g2 = sm + 8192; LAS float* s_tw = sm + 16384; LAS float* s_al = s_tw + 64; LAS float* s_sg = s_tw + 128;
    LAS float* s_w = s_tw + 256; LAS float* s_k = s_tw + 320; LAS float* s_a = s_tw + 384; LAS float* s_b = s_tw + 448; LAS float* s_r = s_tw + 512;
    const int b = chain >> 3, h = chain & 7, c = h * 64 + lane;
    for (int l = 0; l < 64; ++l) { s_w2[l * 64 + lane] = w2[l * 512 + c]; s_a2[l * 64 + lane] = a2[l * 512 + c]; }
    for (int l = 0; l < 128; ++l) s_g2[l * 64 + lane] = g2[l * 512 + c];
    const float mr = mix[c], mk = mix[512 + c], mv = mix[1024 + c], mw = mix[1536 + lane], ma = mix[1600 + lane], mg0 = mix[1664 + lane], mg1 = mix[1728 + lane];
    const float w0c = w0[c], a0c = a0[c], kkc = k_k[c], kac = k_a[c], rkc = r_k[c], lgc = ln_g[c], lbc = ln_b[c];
    float S[64];
#pragma unroll
    for (int j = 0; j < 64; ++j) S[j] = 0.f;
    float pr = 0.f, pk = 0.f, pv = 0.f, pw = 0.f, pa = 0.f, pg0 = 0.f, pg1 = 0.f;
    WSYNC();
    for (int t = 0; t < SEQ; ++t) {
        const bf16_t* row = proj + (size_t)(b * SEQ + t) * L0P;
        const float cr = bf2f(row[c]), ck = bf2f(row[512 + c]), cv = bf2f(row[1024 + c]), cw = bf2f(row[1536 + lane]), ca = bf2f(row[1600 + lane]),
                    cg0 = bf2f(row[1664 + lane]), cg1 = bf2f(row[1728 + lane]);
        const float r_s = cr + (pr - cr) * mr, k_s = ck + (pk - ck) * mk, v_s = cv + (pv - cv) * mv;
        const float wl = cw + (pw - cw) * mw, al = ca + (pa - ca) * ma, g0 = cg0 + (pg0 - cg0) * mg0, g1 = cg1 + (pg1 - cg1) * mg1;
        pr = cr; pk = ck; pv = cv; pw = cw; pa = ca; pg0 = cg0; pg1 = cg1;
        s_tw[lane] = tanhf(wl); s_al[lane] = al; s_sg[lane] = sigmoidf_(g0); s_sg[64 + lane] = sigmoidf_(g1);
        WSYNC();
        float wsum = w0c, asum = a0c, gsum = 0.f;
#pragma unroll 2
        for (int l = 0; l < 64; ++l) { wsum += s_tw[l] * s_w2[l * 64 + lane]; asum += s_al[l] * s_a2[l * 64 + lane]; }
#pragma unroll 2
        for (int l = 0; l < 128; ++l) gsum += s_sg[l] * s_g2[l * 64 + lane];
        const float log_w = -softplusf_(-wsum) - 0.5f;
        const float dec = expf(-expf(log_w));
        const float a = sigmoidf_(asum);
        float kkv = k_s * kkc;
        const float nrm = sqrtf(wave_sum(kkv * kkv));
        kkv = kkv / fmaxf(nrm, 1e-12f);
        const float k2 = k_s * (1.f + (a - 1.f) * kac);
        const float bonus_s = wave_sum(r_s * k2 * rkc);
        s_w[lane] = dec; s_k[lane] = k2; s_a[lane] = -kkv; s_b[lane] = kkv * a; s_r[lane] = r_s;
        WSYNC();
        float sa = 0.f;
#pragma unroll
        for (int j = 0; j < 64; ++j) sa += S[j] * s_a[j];
        float y = 0.f;
#pragma unroll
        for (int j = 0; j < 64; ++j) { S[j] = S[j] * s_w[j] + sa * s_b[j] + v_s * s_k[j]; y += S[j] * s_r[j]; }
        const float mu = wave_sum(y) * (1.f / 64.f);
        const float d = y - mu;
        const float var = wave_sum(d * d) * (1.f / 64.f);
        const float yn = d * (1.0f / sqrtf(var + 64e-5f)) * lgc + lbc;
        const float o = (yn + bonus_s * v_s) * gsum;
        ymix[(size_t)(b * SEQ + t) * DM + c] = (bf16_t)f2bf(o);
        WSYNC();
    }
}

__device__ __forceinline__ void ssm_conv_all(const bf16_t* __restrict__ proj, const float* __restrict__ cw, const float* __restrict__ cb, const float* __restrict__ dtb,
                                             bf16_t* __restrict__ xbc, float* __restrict__ dt, int gtid, int NT) {
    for (size_t i = gtid; i < (size_t)M * 1024; i += NT) {
        const int m = (int)(i >> 10), c = (int)(i & 1023), t = m & (SEQ - 1);
        float acc = cb[c];
#pragma unroll
        for (int k = 0; k < 4; ++k) { const int tt = t - 3 + k; if (tt >= 0) acc += cw[k * 1024 + c] * bf2f(proj[(size_t)(m - 3 + k) * L0P + 2304 + c]); }
        xbc[i] = (bf16_t)f2bf(siluf_(acc));
    }
    for (int i = gtid; i < M * 8; i += NT) dt[i] = softplusf_(bf2f(proj[(size_t)(i >> 3) * L0P + 3328 + (i & 7)]) + dtb[i & 7]);
}
__device__ __forceinline__ void ssd_naive_task(int task, int lane, const bf16_t* __restrict__ xbc, const float* __restrict__ dt, const float* __restrict__ a_log, const float* __restrict__ dsk, float* __restrict__ yssm) {
    const int chain = task >> 2, q = task & 3, b = chain >> 3, h = chain & 7, g = h >> 2, p = q * 16 + (lane >> 2), nq = lane & 3;
    const float A = -expf(a_log[h]), D = dsk[h];
    float st[32];
#pragma unroll
    for (int n = 0; n < 32; ++n) st[n] = 0.f;
    for (int t = 0; t < SEQ; ++t) {
        const size_t m = (size_t)b * SEQ + t;
        const float dtv = dt[m * 8 + h], dA = expf(dtv * A);
        const float x = bf2f(xbc[m * 1024 + h * 64 + p]), xdt = x * dtv;
        const bf16_t* Bp = xbc + m * 1024 + 512 + g * 128 + nq * 32;
        const bf16_t* Cp = xbc + m * 1024 + 768 + g * 128 + nq * 32;
        float yp = 0.f;
#pragma unroll
        for (int n = 0; n < 32; ++n) { st[n] = st[n] * dA + xdt * bf2f(Bp[n]); yp += st[n] * bf2f(Cp[n]); }
        yp += __shfl_xor(yp, 1); yp += __shfl_xor(yp, 2);
        if (nq == 0) yssm[m * 512 + h * 64 + p] = yp + D * x;
    }
}
template <bool ST = true> __device__ __forceinline__ void ssm_gate_norm_all(const bf16_t* __restrict__ yssm, const bf16_t* __restrict__ proj, const float* __restrict__ ng, bf16_t* __restrict__ ymix, int wv0, int wvend, int lane) {
    for (int wvb = wv0 * 4 - (wv0 & ~7) * 3; wvb < wvend; wvb += NWAVES * 4) {
        float u[4][4], q[4];
#pragma unroll
        for (int k = 0; k < 4; ++k) { const int wv = wvb + k, m = wv >> 1, g = wv & 1; q[k] = 0.f;
#pragma unroll
            for (int j = 0; j < 4; ++j) { const int c = g * 256 + j * 64 + lane; const float z = bf2f(proj[(size_t)m * L0P + 1792 + c]); u[k][j] = bf2f(yssm[(size_t)m * 512 + c]) * (z * __builtin_amdgcn_rcpf(1.f + __expf(-z))); q[k] += u[k][j] * u[k][j]; } }
#pragma unroll
        for (int k = 0; k < 4; ++k) { const int wv = wvb + k, m = wv >> 1, g = wv & 1;
            const float rs = __builtin_amdgcn_rsqf(wave_sum_dpp(q[k]) * (1.f / 256.f) + 1e-5f);
#pragma unroll
            for (int j = 0; j < 4; ++j) { const int c = g * 256 + j * 64 + lane; const float o_ = u[k][j] * rs * ng[c]; if (ST) ymix[(size_t)m * DM + 512 + c] = bf1(o_); else asm volatile("" :: "v"(o_)); } }
    }
}
template <bool ST = true> __device__ __forceinline__ void ffn_act_all(bf16_t* gu, const float* __restrict__ cw, const float* __restrict__ cb, int gtid, int NT) {
    constexpr int NCH = DFF / 8, NSTRIP = M / 32;
    for (int task = gtid; task < NSTRIP * NCH; task += NT) {
        const int strip = task / NCH, q = task - strip * NCH, c0 = q * 8, m0 = strip * 32;
        float w0[8], w1[8], w2[8], bb[8], g2[8], g1[8];
#pragma unroll
        for (int j = 0; j < 8; j += 4) { const f32x4 a = *(const f32x4*)(cw + c0 + j), b = *(const f32x4*)(cw + DFF + c0 + j), c = *(const f32x4*)(cw + 2 * DFF + c0 + j), d = *(const f32x4*)(cb + c0 + j);
#pragma unroll
            for (int k = 0; k < 4; ++k) { w0[j + k] = a[k]; w1[j + k] = b[k]; w2[j + k] = c[k]; bb[j + k] = d[k]; } }
        bf16_t* base = gu + (size_t)m0 * (2 * DFF) + c0;
        if ((m0 & (SEQ - 1)) != 0) { const v4u a = *(const v4u*)(base - 2 * (2 * DFF)), b = *(const v4u*)(base - (2 * DFF));
            g2[0] = bflo(a.x); g2[1] = bfhi(a.x); g2[2] = bflo(a.y); g2[3] = bfhi(a.y); g2[4] = bflo(a.z); g2[5] = bfhi(a.z); g2[6] = bflo(a.w); g2[7] = bfhi(a.w);
            g1[0] = bflo(b.x); g1[1] = bfhi(b.x); g1[2] = bflo(b.y); g1[3] = bfhi(b.y); g1[4] = bflo(b.z); g1[5] = bfhi(b.z); g1[6] = bflo(b.w); g1[7] = bfhi(b.w); }
        else {
#pragma unroll
            for (int j = 0; j < 8; ++j) { g2[j] = 0.f; g1[j] = 0.f; } }
#pragma unroll 4
        for (int r = 0; r < 32; ++r) {
            const v4u gv = *(const v4u*)(base + (size_t)r * (2 * DFF)), uv = *(const v4u*)(base + (size_t)r * (2 * DFF) + DFF);
            const unsigned gw_[4] = {gv.x, gv.y, gv.z, gv.w}, uw_[4] = {uv.x, uv.y, uv.z, uv.w};
            unsigned ow[4];
#pragma unroll
            for (int k = 0; k < 4; ++k) {
                const float ga = bflo(gw_[k]), gb = bfhi(gw_[k]);
                const float ya = bb[2 * k] + w0[2 * k] * g2[2 * k] + w1[2 * k] * g1[2 * k] + w2[2 * k] * ga;
                const float yb = bb[2 * k + 1] + w0[2 * k + 1] * g2[2 * k + 1] + w1[2 * k + 1] * g1[2 * k + 1] + w2[2 * k + 1] * gb;
                g2[2 * k] = g1[2 * k]; g1[2 * k] = ga; g2[2 * k + 1] = g1[2 * k + 1]; g1[2 * k + 1] = gb;
                ow[k] = cvtpk(ya / (1.f + __expf(-ya)) * bflo(uw_[k]), yb / (1.f + __expf(-yb)) * bfhi(uw_[k]));
            }
            if (ST) *(v4u*)(base + (size_t)r * (2 * DFF) + DFF) = (v4u){ow[0], ow[1], ow[2], ow[3]}; else asm volatile("" :: "v"(ow[0]), "v"(ow[1]), "v"(ow[2]), "v"(ow[3]));
        }
    }
}
template <bool ST = true> __device__ __forceinline__ void mla_prep_all(const bf16_t* __restrict__ proj1, const int* __restrict__ pos, float* __restrict__ rs, bf16_t* __restrict__ kpe, float* __restrict__ cstab, int gw, int NGW, int lane) {
    for (int m4 = gw * 4; m4 < M; m4 += NGW * 4) {
        const int mt = m4 + (lane >> 4), fi = lane & 15;
        const double inv = exp2(-(double)(2 * fi) * (13.287712379549449 / 32.0));
        const double ang = (double)pos[mt] * inv;
        const float cs = (float)cos(ang), sn = (float)sin(ang);
        cstab[(size_t)mt * 32 + fi] = cs; cstab[(size_t)mt * 32 + 16 + fi] = sn;
        { const bf16_t* row = proj1 + (size_t)mt * L1P; const float x1 = bf2f(row[1920 + fi]), x2 = bf2f(row[1936 + fi]);
          kpe[(size_t)mt * 32 + fi] = bf1(x1 * cs - x2 * sn); kpe[(size_t)mt * 32 + 16 + fi] = bf1(x2 * cs + x1 * sn); }
        float q[4], k[4];
#pragma unroll
        for (int u = 0; u < 4; ++u) { const bf16_t* row = proj1 + (size_t)(m4 + u) * L1P; q[u] = 0.f; k[u] = 0.f;
#pragma unroll
            for (int j = 0; j < 4; ++j) { const float v = bf2f(row[1536 + j * 64 + lane]); q[u] += v * v; }
#pragma unroll
            for (int j = 0; j < 2; ++j) { const float v = bf2f(row[1792 + j * 64 + lane]); k[u] += v * v; } }
#pragma unroll
        for (int u = 0; u < 4; ++u) { q[u] = wave_sum_dpp(q[u]); k[u] = wave_sum_dpp(k[u]); }
        if (lane < 4) { const float qq = lane == 0 ? q[0] : lane == 1 ? q[1] : lane == 2 ? q[2] : q[3], kk2 = lane == 0 ? k[0] : lane == 1 ? k[1] : lane == 2 ? k[2] : k[3];
            rs[(size_t)(m4 + lane) * 2] = 1.0f / sqrtf(qq * (1.f / 256.f) + 1e-6f); rs[(size_t)(m4 + lane) * 2 + 1] = 1.0f / sqrtf(kk2 * (1.f / 128.f) + 1e-6f); }
    }
}
template <bool ST = true> __device__ __forceinline__ void rope_q_all(bf16_t* qm, const float* __restrict__ cstab, int gtid, int NT) {
    for (int i = gtid; i < M * 16; i += NT) {
        const int m = i >> 4, h = (i >> 1) & 7, k0 = (i & 1) * 8;
        bf16_t* p = qm + (size_t)m * 768 + h * 96 + 64 + k0;
        const v4u a = *(const v4u*)p, b = *(const v4u*)(p + 16);
        const f32x4 c0 = *(const f32x4*)(cstab + (size_t)m * 32 + k0), c1 = *(const f32x4*)(cstab + (size_t)m * 32 + k0 + 4), s0 = *(const f32x4*)(cstab + (size_t)m * 32 + 16 + k0), s1 = *(const f32x4*)(cstab + (size_t)m * 32 + 16 + k0 + 4);
        const unsigned au[4] = {a.x, a.y, a.z, a.w}, bu[4] = {b.x, b.y, b.z, b.w};
        const float cs[8] = {c0[0], c0[1], c0[2], c0[3], c1[0], c1[1], c1[2], c1[3]}, sn[8] = {s0[0], s0[1], s0[2], s0[3], s1[0], s1[1], s1[2], s1[3]};
        unsigned o1[4], o2[4];
#pragma unroll
        for (int q = 0; q < 4; ++q) { const float x1a = bflo(au[q]), x1b = bfhi(au[q]), x2a = bflo(bu[q]), x2b = bfhi(bu[q]);
            o1[q] = cvtpk(x1a * cs[2 * q] - x2a * sn[2 * q], x1b * cs[2 * q + 1] - x2b * sn[2 * q + 1]);
            o2[q] = cvtpk(x2a * cs[2 * q] + x1a * sn[2 * q], x2b * cs[2 * q + 1] + x1b * sn[2 * q + 1]); }
        if (ST) { *(v4u*)p = (v4u){o1[0], o1[1], o1[2], o1[3]}; *(v4u*)(p + 16) = (v4u){o2[0], o2[1], o2[2], o2[3]}; }
    }
}
__device__ __forceinline__ void sb_naive_task(int qblk, int bh, int lane, const bf16_t* __restrict__ proj1, bf16_t* __restrict__ ymix) {
    const int b = bh >> 3, h = bh & 7, t = qblk * 64 + lane;
    const size_t mrow = (size_t)b * SEQ;
    float q[64], o[64];
#pragma unroll
    for (int d = 0; d < 64; ++d) { q[d] = bf2f(proj1[(mrow + t) * L1P + h * 64 + d]) * 0.125f; o[d] = 0.f; }
    float cum = 0.f;
    const int smax = qblk * 64 + 63;
    for (int s = smax - 1; s >= 0; --s) {
        const bf16_t* kr = proj1 + (mrow + s) * L1P + 512 + h * 64;
        const bf16_t* vr = proj1 + (mrow + s) * L1P + 1024 + h * 64;
        float z = 0.f;
#pragma unroll
        for (int d = 0; d < 64; ++d) z += q[d] * bf2f(kr[d]);
        if (s < t) {
            const float lsp = -softplusf_(-z);
            const float lsn = -softplusf_(z);
            const float att = expf(lsp + cum);
            cum += lsn;
#pragma unroll
            for (int d = 0; d < 64; ++d) o[d] += att * bf2f(vr[d]);
        }
    }
#pragma unroll
    for (int d = 0; d < 64; ++d) ymix[(mrow + t) * DM + h * 64 + d] = (bf16_t)f2bf(o[d]);
}
__device__ __forceinline__ void mla_naive_task(int qblk, int bh, int lane, const bf16_t* __restrict__ qm, const bf16_t* __restrict__ kvm, const bf16_t* __restrict__ kpe, bf16_t* __restrict__ ymix) {
    const int b = bh >> 3, h = bh & 7, t = qblk * 64 + lane;
    const size_t mrow = (size_t)b * SEQ;
    const float scale = 0.10206207261596577f;
    float q[96], o[64];
#pragma unroll
    for (int d = 0; d < 96; ++d) q[d] = bf2f(qm[(mrow + t) * 768 + h * 96 + d]) * scale;
#pragma unroll
    for (int d = 0; d < 64; ++d) o[d] = 0.f;
    float mx = -1e30f, l = 0.f;
    const int smax = qblk * 64 + 63;
    for (int s = 0; s <= smax; ++s) {
        const bf16_t* kr = kvm + (mrow + s) * 1024 + h * 128;
        const bf16_t* pr = kpe + (mrow + s) * 32;
        float z = 0.f;
#pragma unroll
        for (int d = 0; d < 64; ++d) z += q[d] * bf2f(kr[d]);
#pragma unroll
        for (int d = 0; d < 32; ++d) z += q[64 + d] * bf2f(pr[d]);
        if (s <= t) {
            const float mn = fmaxf(mx, z), f = expf(mx - mn), pz = expf(z - mn);
            l = l * f + pz; mx = mn;
#pragma unroll
            for (int d = 0; d < 64; ++d) o[d] = o[d] * f + pz * bf2f(kr[64 + d]);
        }
    }
    const float il = 1.f / l;
#pragma unroll
    for (int d = 0; d < 64; ++d) ymix[(mrow + t) * DM + 512 + h * 64 + d] = (bf16_t)f2bf(o[d] * il);
}


__device__ __forceinline__ int crow(int r, int hi) { return (r & 3) + 8 * (r >> 2) + 4 * hi; }
#define MFMA32(a, b, c) __builtin_amdgcn_mfma_f32_32x32x16_bf16((a), (b), (c), 0, 0, 0)
constexpr int STG_PITCH = 72;
__device__ __forceinline__ void transpose_tile64(const bf16_t* __restrict__ src, int sp, bf16_t* __restrict__ dst, int dp, LAS bf16_t* scr, int lane) {
#pragma unroll
    for (int i = 0; i < 8; ++i) { const int row = i * 8 + (lane >> 3), ch = lane & 7; const v4u v = *(const v4u*)(src + (size_t)row * sp + ch * 8); *(LAS v4u*)(scr + row * STG_PITCH + ch * 8) = v; }
    WSYNC();
#pragma unroll
    for (int i = 0; i < 8; ++i) { const int d = i * 8 + (lane >> 3), tc = lane & 7; const LAS bf16_t* p = scr + (tc * 8) * STG_PITCH + d;
        v4u o; o.x = (unsigned)p[0] | ((unsigned)p[STG_PITCH] << 16); o.y = (unsigned)p[2 * STG_PITCH] | ((unsigned)p[3 * STG_PITCH] << 16);
        o.z = (unsigned)p[4 * STG_PITCH] | ((unsigned)p[5 * STG_PITCH] << 16); o.w = (unsigned)p[6 * STG_PITCH] | ((unsigned)p[7 * STG_PITCH] << 16);
        *(v4u*)(dst + (size_t)d * dp + tc * 8) = o; }
    WSYNC();
}
__device__ __forceinline__ void store_OT(const f32x16 (&o)[2], float sc, LAS bf16_t* stg, bf16_t* __restrict__ dst, int lane) {
    const int l31 = lane & 31, hi = lane >> 5;
#pragma unroll
    for (int dt = 0; dt < 2; ++dt)
#pragma unroll
        for (int r = 0; r < 16; ++r) stg[l31 * STG_PITCH + 32 * dt + crow(r, hi)] = (bf16_t)f2bf(o[dt][r] * sc);
    WSYNC();
#pragma unroll
    for (int i = 0; i < 4; ++i) { const int row = i * 8 + (lane >> 3), ch = lane & 7; const v4u v = *(const LAS v4u*)(stg + row * STG_PITCH + ch * 8); *(v4u*)(dst + (size_t)row * DM + ch * 8) = v; }
    WSYNC();
}
__device__ __forceinline__ float softplus_fast(float z) { return fmaxf(z, 0.f) + __logf(1.f + __expf(-fabsf(z))); }

__device__ __forceinline__ void sb_task(int bh, int qblk, int lane, const bf16_t* __restrict__ P1, const bf16_t* __restrict__ VT, bf16_t* __restrict__ ymix, LAS bf16_t* stg) {
    const int b = bh >> 3, h = bh & 7, l31 = lane & 31, hi = lane >> 5, q0 = qblk * 32, t = q0 + l31;
    const size_t rowb = (size_t)b * SEQ;
    const bf16_t* Qp = P1 + (rowb + q0 + l31) * L1P + h * 64 + 8 * hi;
    bf16x8 qf[4];
#pragma unroll
    for (int kk = 0; kk < 4; ++kk) qf[kk] = *(const bf16x8*)(Qp + 16 * kk);
    const bf16_t* Kp = P1 + (rowb + l31) * L1P + 512 + h * 64 + 8 * hi;
    const bf16_t* Vp = VT + ((size_t)bh * 64 + l31) * SEQ + 4 * hi;
    f32x16 o[2];
#pragma unroll
    for (int r = 0; r < 16; ++r) { o[0][r] = 0.f; o[1][r] = 0.f; }
    float cum = 0.f;
    bf16x8 kf[4]; u32x2 va[2][2][2];
#define SB_LOAD(S0, KF, VA) do { _Pragma("unroll") for (int kk = 0; kk < 4; ++kk) KF[kk] = *(const bf16x8*)(Kp + (size_t)(S0) * L1P + 16 * kk); \
        _Pragma("unroll") for (int dt = 0; dt < 2; ++dt) _Pragma("unroll") for (int ks = 0; ks < 2; ++ks) { VA[dt][ks][0] = *(const u32x2*)(Vp + (size_t)dt * 32 * SEQ + (S0) + 16 * ks); VA[dt][ks][1] = *(const u32x2*)(Vp + (size_t)dt * 32 * SEQ + (S0) + 16 * ks + 8); } } while (0)
    SB_LOAD(q0, kf, va);
    for (int s0 = q0; s0 >= 0; s0 -= 32) {
        bf16x8 kn[4]; u32x2 vn[2][2][2];
        const int sn = (s0 >= 32) ? s0 - 32 : 0;
        SB_LOAD(sn, kn, vn);
        f32x16 acc;
#pragma unroll
        for (int r = 0; r < 16; ++r) acc[r] = 0.f;
#pragma unroll
        for (int kk = 0; kk < 4; ++kk) acc = MFMA32(kf[kk], qf[kk], acc);
        const bool diag = (s0 == q0);
        float lb[16], lk[16];
#pragma unroll
        for (int r = 0; r < 16; ++r) { const float z = acc[r] * 0.125f; const float sp = softplus_fast(z); float b_ = z - sp, k_ = -sp;
            if (diag) { const bool valid = (s0 + crow(r, hi)) < t; b_ = valid ? b_ : -1e30f; k_ = valid ? k_ : 0.f; }
            lb[r] = b_; lk[r] = k_; }
        float e[16], T[4], U[4];
#pragma unroll
        for (int i = 0; i < 4; ++i) { e[4 * i + 3] = 0.f; e[4 * i + 2] = lk[4 * i + 3]; e[4 * i + 1] = e[4 * i + 2] + lk[4 * i + 2]; e[4 * i] = e[4 * i + 1] + lk[4 * i + 1]; T[i] = e[4 * i] + lk[4 * i]; }
#pragma unroll
        for (int i = 0; i < 4; ++i) U[i] = __shfl_xor(T[i], 32);
        float off[4];
        { const float st2 = T[3], st1 = st2 + T[2], st0 = st1 + T[1]; const float su2 = U[3], su1 = su2 + U[2], su0 = su1 + U[1];
          const float x0 = hi ? 0.f : U[0], x1 = hi ? 0.f : U[1], x2 = hi ? 0.f : U[2], x3 = hi ? 0.f : U[3];
          off[3] = x3; off[2] = st2 + su2 + x2; off[1] = st1 + su1 + x1; off[0] = st0 + su0 + x0;
          const float total = st0 + T[0] + su0 + U[0];
#pragma unroll
          for (int r = 0; r < 16; ++r) acc[r] = __expf(lb[r] + (cum + off[r >> 2] + e[r]));
          cum += total; }
        bf16x8 pf[2];
#pragma unroll
        for (int ks = 0; ks < 2; ++ks) { v4u w; w.x = cvtpk(acc[8 * ks], acc[8 * ks + 1]); w.y = cvtpk(acc[8 * ks + 2], acc[8 * ks + 3]); w.z = cvtpk(acc[8 * ks + 4], acc[8 * ks + 5]); w.w = cvtpk(acc[8 * ks + 6], acc[8 * ks + 7]); pf[ks] = __builtin_bit_cast(bf16x8, w); }
#pragma unroll
        for (int dt = 0; dt < 2; ++dt)
#pragma unroll
            for (int ks = 0; ks < 2; ++ks) { v4u a; a.x = va[dt][ks][0].x; a.y = va[dt][ks][0].y; a.z = va[dt][ks][1].x; a.w = va[dt][ks][1].y; o[dt] = MFMA32(__builtin_bit_cast(bf16x8, a), pf[ks], o[dt]); }
        if (__all(cum < -110.f)) break;
#pragma unroll
        for (int kk = 0; kk < 4; ++kk) kf[kk] = kn[kk];
#pragma unroll
        for (int dt = 0; dt < 2; ++dt)
#pragma unroll
            for (int ks = 0; ks < 2; ++ks) { va[dt][ks][0] = vn[dt][ks][0]; va[dt][ks][1] = vn[dt][ks][1]; }
    }
#undef SB_LOAD
    store_OT(o, 1.0f, stg, ymix + (rowb + q0) * DM + h * 64, lane);
}
__device__ __forceinline__ void mla_task(int bh, int qblk, int lane, const bf16_t* __restrict__ QM, const bf16_t* __restrict__ KVM, const bf16_t* __restrict__ KPE, const bf16_t* __restrict__ VT,
                                         bf16_t* __restrict__ ymix, LAS bf16_t* stg) {
    const int b = bh >> 3, h = bh & 7, l31 = lane & 31, hi = lane >> 5, q0 = qblk * 32, t = q0 + l31;
    const size_t rowb = (size_t)b * SEQ;
    const bf16_t* Qp = QM + (rowb + q0 + l31) * 768 + h * 96 + 8 * hi;
    bf16x8 qf[6];
#pragma unroll
    for (int kk = 0; kk < 6; ++kk) qf[kk] = *(const bf16x8*)(Qp + 16 * kk);
    const bf16_t* Kn = KVM + (rowb + l31) * 1024 + h * 128 + 8 * hi;
    const bf16_t* Kr = KPE + (rowb + l31) * 32 + 8 * hi;
    const bf16_t* Vp = VT + ((size_t)bh * 64 + l31) * SEQ + 4 * hi;
    const float sc2 = 0.10206207261596577f * 1.4426950408889634f;
    f32x16 o[2];
#pragma unroll
    for (int r = 0; r < 16; ++r) { o[0][r] = 0.f; o[1][r] = 0.f; }
    float mrun = -1e30f, lsum = 0.f;
    bf16x8 kf[6]; u32x2 va[2][2][2];
#define ML_LOAD(S0, KF, VA) do { _Pragma("unroll") for (int kk = 0; kk < 4; ++kk) KF[kk] = *(const bf16x8*)(Kn + (size_t)(S0) * 1024 + 16 * kk); \
        _Pragma("unroll") for (int kk = 0; kk < 2; ++kk) KF[4 + kk] = *(const bf16x8*)(Kr + (size_t)(S0) * 32 + 16 * kk); \
        _Pragma("unroll") for (int dt = 0; dt < 2; ++dt) _Pragma("unroll") for (int ks = 0; ks < 2; ++ks) { VA[dt][ks][0] = *(const u32x2*)(Vp + (size_t)dt * 32 * SEQ + (S0) + 16 * ks); VA[dt][ks][1] = *(const u32x2*)(Vp + (size_t)dt * 32 * SEQ + (S0) + 16 * ks + 8); } } while (0)
    ML_LOAD(0, kf, va);
    for (int s0 = 0; s0 <= q0; s0 += 32) {
        bf16x8 kn[6]; u32x2 vn[2][2][2];
        const int sn = (s0 + 32 <= q0) ? s0 + 32 : s0;
        ML_LOAD(sn, kn, vn);
        f32x16 acc;
#pragma unroll
        for (int r = 0; r < 16; ++r) acc[r] = 0.f;
#pragma unroll
        for (int kk = 0; kk < 6; ++kk) acc = MFMA32(kf[kk], qf[kk], acc);
        const bool diag = (s0 == q0);
        float tmax = -1e30f;
#pragma unroll
        for (int r = 0; r < 16; ++r) { float z = acc[r] * sc2; if (diag && (s0 + crow(r, hi)) > t) z = -1e30f; acc[r] = z; tmax = fmaxf(tmax, z); }
        tmax = fmaxf(tmax, __shfl_xor(tmax, 32));
        const float mn = fmaxf(mrun, tmax), alpha = exp2f(mrun - mn); mrun = mn;
        float ps = 0.f;
#pragma unroll
        for (int r = 0; r < 16; ++r) { acc[r] = exp2f(acc[r] - mn); ps += acc[r]; }
        lsum = lsum * alpha + ps;
#pragma unroll
        for (int r = 0; r < 16; ++r) { o[0][r] *= alpha; o[1][r] *= alpha; }
        bf16x8 pf[2];
#pragma unroll
        for (int ks = 0; ks < 2; ++ks) { v4u w; w.x = cvtpk(acc[8 * ks], acc[8 * ks + 1]); w.y = cvtpk(acc[8 * ks + 2], acc[8 * ks + 3]); w.z = cvtpk(acc[8 * ks + 4], acc[8 * ks + 5]); w.w = cvtpk(acc[8 * ks + 6], acc[8 * ks + 7]); pf[ks] = __builtin_bit_cast(bf16x8, w); }
#pragma unroll
        for (int dt = 0; dt < 2; ++dt)
#pragma unroll
            for (int ks = 0; ks < 2; ++ks) { v4u a; a.x = va[dt][ks][0].x; a.y = va[dt][ks][0].y; a.z = va[dt][ks][1].x; a.w = va[dt][ks][1].y; o[dt] = MFMA32(__builtin_bit_cast(bf16x8, a), pf[ks], o[dt]); }
#pragma unroll
        for (int kk = 0; kk < 6; ++kk) kf[kk] = kn[kk];
#pragma unroll
        for (int dt = 0; dt < 2; ++dt)
#pragma unroll
            for (int ks = 0; ks < 2; ++ks) { va[dt][ks][0] = vn[dt][ks][0]; va[dt][ks][1] = vn[dt][ks][1]; }
    }
#undef ML_LOAD
    lsum += __shfl_xor(lsum, 32);
    store_OT(o, 1.0f / lsum, stg, ymix + (rowb + q0) * DM + 512 + h * 64, lane);
}


constexpr int MLK_PITCH = 104, MLV_PITCH = 68, MLK_BYTES = 64 * MLK_PITCH * 2, MLV_BYTES = 64 * MLV_PITCH * 2, ML_STAGE = MLK_BYTES + MLV_BYTES;
__device__ __forceinline__ void mla_block(int bh, int sb, int tid, int lane, int wave, LAS unsigned char* lds, const bf16_t* __restrict__ QM, const bf16_t* __restrict__ KVM, const bf16_t* __restrict__ KPE,
                                          const bf16_t* __restrict__ VT, bf16_t* __restrict__ ymix) {
    const int b = bh >> 3, h = bh & 7, l31 = lane & 31, hi = lane >> 5, q0 = 256 * sb + 32 * wave, t = q0 + l31;
    const size_t rowb = (size_t)b * SEQ;
    const int nsteps = 4 * sb + 4;
    bf16x8 qf[6];
    { const bf16_t* Qp = QM + (rowb + q0 + l31) * 768 + h * 96 + 8 * hi;
#pragma unroll
      for (int kk = 0; kk < 6; ++kk) qf[kk] = *(const bf16x8*)(Qp + 16 * kk); }
    const float sc2 = 0.10206207261596577f * 1.4426950408889634f;
    f32x16 o[2];
#pragma unroll
    for (int r = 0; r < 16; ++r) { o[0][r] = 0.f; o[1][r] = 0.f; }
    float mrun = -1e30f, lsum = 0.f;
    const bf16_t* gKn = KVM + (rowb + (tid >> 3)) * 1024 + h * 128 + (tid & 7) * 8;
    const bf16_t* gKr = KPE + (rowb + ((tid & 255) >> 2)) * 32 + (tid & 3) * 8;
    const bf16_t* gVt = VT + ((size_t)bh * 64 + (tid >> 3)) * SEQ + (tid & 7) * 8;
    const int lKn = (tid >> 3) * (MLK_PITCH * 2) + (tid & 7) * 16, lKr = ((tid & 255) >> 2) * (MLK_PITCH * 2) + 128 + (tid & 3) * 16, lVt = MLK_BYTES + (tid >> 3) * (MLV_PITCH * 2) + (tid & 7) * 16;
    v4u rk, rr, rv;
    rk = *(const v4u*)gKn; rr = *(const v4u*)gKr; rv = *(const v4u*)gVt;
    *(LAS v4u*)(lds + lKn) = rk; if (tid < 256) *(LAS v4u*)(lds + lKr) = rr; *(LAS u32x2*)(lds + lVt) = (u32x2){rv.x, rv.y}; *(LAS u32x2*)(lds + lVt + 8) = (u32x2){rv.z, rv.w};
    __syncthreads();
#pragma unroll 1
    for (int step = 0; step < nsteps; ++step) {
        const int nx = (step + 1 < nsteps) ? step + 1 : step;
        rk = *(const v4u*)(gKn + (size_t)nx * 64 * 1024); rr = *(const v4u*)(gKr + (size_t)nx * 64 * 32); rv = *(const v4u*)(gVt + nx * 64);
        const LAS unsigned char* Kb = lds + (step & 1) * ML_STAGE;
        const LAS unsigned char* Vb = Kb + MLK_BYTES;
        if (64 * step <= q0) {
            f32x16 acc[2];
#pragma unroll
            for (int sub = 0; sub < 2; ++sub) {
#pragma unroll
                for (int r = 0; r < 16; ++r) acc[sub][r] = 0.f;
#pragma unroll
                for (int kk = 0; kk < 6; ++kk) { const bf16x8 kf = *(const LAS bf16x8*)(Kb + (32 * sub + l31) * (MLK_PITCH * 2) + (16 * kk + 8 * hi) * 2); acc[sub] = MFMA32(kf, qf[kk], acc[sub]); }
            }
            float tmax = -1e30f;
#pragma unroll
            for (int sub = 0; sub < 2; ++sub) { const int s0 = 64 * step + 32 * sub; const bool need_mask = (s0 + 31 > q0);
#pragma unroll
                for (int r = 0; r < 16; ++r) { float z = acc[sub][r] * sc2; if (need_mask && (s0 + crow(r, hi)) > t) z = -1e30f; acc[sub][r] = z; tmax = fmaxf(tmax, z); } }
            tmax = fmaxf(tmax, __shfl_xor(tmax, 32));
            const float mn = fmaxf(mrun, tmax), alpha = __builtin_amdgcn_exp2f(mrun - mn); mrun = mn;
            float ps = 0.f;
#pragma unroll
            for (int sub = 0; sub < 2; ++sub)
#pragma unroll
                for (int r = 0; r < 16; ++r) { acc[sub][r] = __builtin_amdgcn_exp2f(acc[sub][r] - mn); ps += acc[sub][r]; }
            lsum = lsum * alpha + ps;
#pragma unroll
            for (int r = 0; r < 16; ++r) { o[0][r] *= alpha; o[1][r] *= alpha; }
#pragma unroll
            for (int sub = 0; sub < 2; ++sub) {
                bf16x8 pf[2];
#pragma unroll
                for (int ks = 0; ks < 2; ++ks) pf[ks] = pack8(acc[sub][8 * ks], acc[sub][8 * ks + 1], acc[sub][8 * ks + 2], acc[sub][8 * ks + 3], acc[sub][8 * ks + 4], acc[sub][8 * ks + 5], acc[sub][8 * ks + 6], acc[sub][8 * ks + 7]);
#pragma unroll
                for (int dt = 0; dt < 2; ++dt)
#pragma unroll
                    for (int ks = 0; ks < 2; ++ks) { const LAS unsigned char* vp = Vb + (32 * dt + l31) * (MLV_PITCH * 2) + (32 * sub + 16 * ks + 4 * hi) * 2;
                        const u32x2 x0 = *(const LAS u32x2*)vp, x1 = *(const LAS u32x2*)(vp + 16);
                        v4u a; a.x = x0.x; a.y = x0.y; a.z = x1.x; a.w = x1.y; o[dt] = MFMA32(__builtin_bit_cast(bf16x8, a), pf[ks], o[dt]); }
            }
        }
        LAS unsigned char* nb = lds + ((step + 1) & 1) * ML_STAGE;
        *(LAS v4u*)(nb + lKn) = rk; if (tid < 256) *(LAS v4u*)(nb + lKr) = rr; *(LAS u32x2*)(nb + lVt) = (u32x2){rv.x, rv.y}; *(LAS u32x2*)(nb + lVt + 8) = (u32x2){rv.z, rv.w};
        __syncthreads();
    }
    lsum += __shfl_xor(lsum, 32);
    store_OT(o, 1.0f / lsum, (LAS bf16_t*)(lds + 2 * ML_STAGE) + wave * (32 * STG_PITCH), ymix + (rowb + q0) * DM + 512 + h * 64, lane);
    __syncthreads();
}


constexpr int SBK_PITCH = 72, SBK_BYTES = 64 * SBK_PITCH * 2, SB_STAGE = SBK_BYTES + MLV_BYTES;
__device__ __forceinline__ void sb_block(int bh, int sb, int tid, int lane, int wave, LAS unsigned char* lds, const bf16_t* __restrict__ P1, const bf16_t* __restrict__ VT, bf16_t* __restrict__ ymix) {
    const int b = bh >> 3, h = bh & 7, l31 = lane & 31, hi = lane >> 5, q0 = 256 * sb + 32 * wave, t = q0 + l31;
    const size_t rowb = (size_t)b * SEQ;
    bf16x8 qf[4];
    { const bf16_t* Qp = P1 + (rowb + q0 + l31) * L1P + h * 64 + 8 * hi;
#pragma unroll
      for (int kk = 0; kk < 4; ++kk) qf[kk] = *(const bf16x8*)(Qp + 16 * kk); }
    f32x16 o[2];
#pragma unroll
    for (int r = 0; r < 16; ++r) { o[0][r] = 0.f; o[1][r] = 0.f; }
    float cum = 0.f; bool done = false;
    volatile LAS unsigned* flags = (volatile LAS unsigned*)(lds + 2 * SB_STAGE);
    const bf16_t* gK = P1 + (rowb + (tid >> 3)) * L1P + 512 + h * 64 + (tid & 7) * 8;
    const bf16_t* gVt = VT + ((size_t)bh * 64 + (tid >> 3)) * SEQ + (tid & 7) * 8;
    const int lK = (tid >> 3) * (SBK_PITCH * 2) + (tid & 7) * 16, lVt = SBK_BYTES + (tid >> 3) * (MLV_PITCH * 2) + (tid & 7) * 16;
    const int top = 4 * sb + 3;
    v4u rk, rv;
    rk = *(const v4u*)(gK + (size_t)top * 64 * L1P); rv = *(const v4u*)(gVt + top * 64);
    *(LAS v4u*)(lds + lK) = rk; *(LAS u32x2*)(lds + lVt) = (u32x2){rv.x, rv.y}; *(LAS u32x2*)(lds + lVt + 8) = (u32x2){rv.z, rv.w};
    __syncthreads();
#pragma unroll 1
    for (int i = 0; i <= top; ++i) {
        const int step = top - i, nx = (step > 0) ? step - 1 : 0;
        rk = *(const v4u*)(gK + (size_t)nx * 64 * L1P); rv = *(const v4u*)(gVt + nx * 64);
        const LAS unsigned char* Kb = lds + (i & 1) * SB_STAGE;
        const LAS unsigned char* Vb = Kb + SBK_BYTES;
#pragma unroll
        for (int sub = 1; sub >= 0; --sub) {
            const int s0 = 64 * step + 32 * sub;
            if (s0 <= q0 && !done) {
                f32x16 acc;
#pragma unroll
                for (int r = 0; r < 16; ++r) acc[r] = 0.f;
#pragma unroll
                for (int kk = 0; kk < 4; ++kk) { const bf16x8 kf = *(const LAS bf16x8*)(Kb + (32 * sub + l31) * (SBK_PITCH * 2) + (16 * kk + 8 * hi) * 2); acc = MFMA32(kf, qf[kk], acc); }
                const bool diag = (s0 == q0);
                float lb[16], lk[16];
#pragma unroll
                for (int r = 0; r < 16; ++r) { const float z = acc[r] * 0.125f; const float sp = softplus_fast(z); float b_ = z - sp, k_ = -sp;
                    if (diag) { const bool valid = (s0 + crow(r, hi)) < t; b_ = valid ? b_ : -1e30f; k_ = valid ? k_ : 0.f; }
                    lb[r] = b_; lk[r] = k_; }
                float e[16], T[4], U[4];
#pragma unroll
                for (int q = 0; q < 4; ++q) { e[4 * q + 3] = 0.f; e[4 * q + 2] = lk[4 * q + 3]; e[4 * q + 1] = e[4 * q + 2] + lk[4 * q + 2]; e[4 * q] = e[4 * q + 1] + lk[4 * q + 1]; T[q] = e[4 * q] + lk[4 * q]; }
#pragma unroll
                for (int q = 0; q < 4; ++q) U[q] = __shfl_xor(T[q], 32);
                { const float st2 = T[3], st1 = st2 + T[2], st0 = st1 + T[1]; const float su2 = U[3], su1 = su2 + U[2], su0 = su1 + U[1];
                  const float x0 = hi ? 0.f : U[0], x1 = hi ? 0.f : U[1], x2 = hi ? 0.f : U[2], x3 = hi ? 0.f : U[3];
                  const float off[4] = {st0 + su0 + x0, st1 + su1 + x1, st2 + su2 + x2, x3};
                  const float total = st0 + T[0] + su0 + U[0];
#pragma unroll
                  for (int r = 0; r < 16; ++r) acc[r] = __expf(lb[r] + (cum + off[r >> 2] + e[r]));
                  cum += total; }
                bf16x8 pf[2];
#pragma unroll
                for (int ks = 0; ks < 2; ++ks) { v4u w; w.x = cvtpk(acc[8 * ks], acc[8 * ks + 1]); w.y = cvtpk(acc[8 * ks + 2], acc[8 * ks + 3]); w.z = cvtpk(acc[8 * ks + 4], acc[8 * ks + 5]); w.w = cvtpk(acc[8 * ks + 6], acc[8 * ks + 7]); pf[ks] = __builtin_bit_cast(bf16x8, w); }
#pragma unroll
                for (int dt = 0; dt < 2; ++dt)
#pragma unroll
                    for (int ks = 0; ks < 2; ++ks) { const LAS unsigned char* vp = Vb + (32 * dt + l31) * (MLV_PITCH * 2) + (32 * sub + 16 * ks + 4 * hi) * 2;
                        const u32x2 x0 = *(const LAS u32x2*)vp, x1 = *(const LAS u32x2*)(vp + 16);
                        v4u a; a.x = x0.x; a.y = x0.y; a.z = x1.x; a.w = x1.y; o[dt] = MFMA32(__builtin_bit_cast(bf16x8, a), pf[ks], o[dt]); }
                done = __all(cum < -110.f);
            }
        }
        if (lane == 0) flags[(i & 1) * 8 + wave] = done ? 1u : 0u;
        LAS unsigned char* nb = lds + ((i + 1) & 1) * SB_STAGE;
        *(LAS v4u*)(nb + lK) = rk; *(LAS u32x2*)(nb + lVt) = (u32x2){rv.x, rv.y}; *(LAS u32x2*)(nb + lVt + 8) = (u32x2){rv.z, rv.w};
        __syncthreads();
        unsigned nd = 0;
#pragma unroll
        for (int w8 = 0; w8 < 8; ++w8) nd += flags[(i & 1) * 8 + w8];
        if (nd == 8u) break;
    }
    store_OT(o, 1.0f, (LAS bf16_t*)(lds + 2 * SB_STAGE + 256) + wave * (32 * STG_PITCH), ymix + (rowb + q0) * DM + h * 64, lane);
    __syncthreads();
}

constexpr int RW_RAWW = 0, RW_RAWA = 2048, RW_RS = 4096, RW_KS = 6144, RW_VS = 8192;
constexpr int RW_CH0 = 10240, RW_CHSZ = 11328;
constexpr int RW_YB = RW_CH0 + 2 * RW_CHSZ;
constexpr int RW_MIX = RW_YB + 1024;
static_assert((RW_MIX + 256) * 4 <= 146432, "rwkv LDS map");
__device__ __forceinline__ float tanh_fast(float x) { return 1.f - 2.f * __builtin_amdgcn_rcpf(1.f + __expf(2.f * x)); }
__device__ __forceinline__ float sigmoid_fast(float x) { return __builtin_amdgcn_rcpf(1.f + __expf(-x)); }

#define MFMA16(a, b, c) __builtin_amdgcn_mfma_f32_16x16x32_bf16((a), (b), (c), 0, 0, 0)
constexpr int RW2_CH0 = 0, RW2_YB = 2 * RW_CHSZ, RW2_MIX = RW2_YB + 1024, RW2_STG = RW2_MIX + 448;
static_assert((RW2_STG + 2 * 3072) * 4 <= 146432, "rwkv LDS map");
__device__ __forceinline__ void rwkv_phase_scan(LAS float* sm, int tid, int lane, int wave, int blk, const bf16_t* __restrict__ proj, const float* __restrict__ mix, const float* __restrict__ w0, const float* __restrict__ a0,
                                           const float* __restrict__ k_k, const float* __restrict__ k_a, const float* __restrict__ r_k, const bf16_t* __restrict__ W2T, const bf16_t* __restrict__ A2T, const bf16_t* __restrict__ G2T,
                                           float* __restrict__ yraw, bf16_t* __restrict__ gout, float* __restrict__ bonus_out) {
    const int chain = blk >> 1, half = blk & 1, b = chain >> 3, h = chain & 7, l15 = lane & 15, kg = lane >> 4;
    const size_t rowb = (size_t)b * SEQ;
    constexpr int NCHUNK = SEQ / 32;
    if (tid < 256) sm[RW2_MIX + tid] = mix[1536 + tid];
    else if (tid < 448) { const int q = tid - 256; sm[RW2_MIX + tid] = mix[512 * (q >> 6) + h * 64 + (q & 63)]; }
    __syncthreads();
#define RW_SH8(CUR, PRV, M0, M1, OUT, PZ) do { const unsigned cu_[4] = {(CUR).x, (CUR).y, (CUR).z, (CUR).w}, pu_[4] = {(PRV).x, (PRV).y, (PRV).z, (PRV).w}; \
        const float mm_[8] = {(M0)[0], (M0)[1], (M0)[2], (M0)[3], (M1)[0], (M1)[1], (M1)[2], (M1)[3]}; \
        _Pragma("unroll") for (int q = 0; q < 4; ++q) { const float c0 = bflo(cu_[q]), c1 = bfhi(cu_[q]), p0 = bflo(pu_[q]) * (PZ), p1 = bfhi(pu_[q]) * (PZ); \
            OUT[2 * q] = c0 + (p0 - c0) * mm_[2 * q]; OUT[2 * q + 1] = c1 + (p1 - c1) * mm_[2 * q + 1]; } } while (0)
    if (wave < 4) {
        const int iA = 8 * wave + kg, iB = iA + 4, jseg = l15;
        float A0 = 0.f, A1 = 0.f, A2 = 0.f, A3 = 0.f, B0 = 0.f, B1 = 0.f, B2 = 0.f, B3 = 0.f;
        __syncthreads();
#pragma unroll 1
        for (int ch = 0; ch < NCHUNK; ++ch) {
            const int t0 = ch * 32;
            const LAS float* CHb = sm + RW2_CH0 + (ch & 1) * RW_CHSZ + 4 * jseg;
            const LAS float* CHv = sm + RW2_CH0 + (ch & 1) * RW_CHSZ + 10240 + iA;
            const LAS float* CHs = sm + RW2_CH0 + (ch & 1) * RW_CHSZ + 11264;
            f32x4 a4 = *(const LAS f32x4*)(CHb + 4096), wr4 = *(const LAS f32x4*)(CHb + 8192), w4 = *(const LAS f32x4*)(CHb), b4 = *(const LAS f32x4*)(CHb + 6144), k4 = *(const LAS f32x4*)(CHb + 2048);
            float vA = CHv[0], vB = CHv[4]; f32x2_t sc = *(const LAS f32x2_t*)(CHs);
#pragma unroll 2
            for (int t = 0; t < 32; ++t) {
                const int tq = (t + 1) & 31;
                const f32x4 a4n = *(const LAS f32x4*)(CHb + 4096 + tq * 64), wr4n = *(const LAS f32x4*)(CHb + 8192 + tq * 64), w4n = *(const LAS f32x4*)(CHb + tq * 64),
                            b4n = *(const LAS f32x4*)(CHb + 6144 + tq * 64), k4n = *(const LAS f32x4*)(CHb + 2048 + tq * 64);
                const float vAn = CHv[tq * 32], vBn = CHv[tq * 32 + 4]; const f32x2_t scn = *(const LAS f32x2_t*)(CHs + 2 * tq);
                float d1A = (A0 * a4[0] + A1 * a4[1]) + (A2 * a4[2] + A3 * a4[3]), d1B = (B0 * a4[0] + B1 * a4[1]) + (B2 * a4[2] + B3 * a4[3]);
                float d2A = (A0 * wr4[0] + A1 * wr4[1]) + (A2 * wr4[2] + A3 * wr4[3]), d2B = (B0 * wr4[0] + B1 * wr4[1]) + (B2 * wr4[2] + B3 * wr4[3]);
                d1A = rowsum16(d1A); d1B = rowsum16(d1B); d2A = rowsum16(d2A); d2B = rowsum16(d2B);
                const float yA = d2A + d1A * sc[0] + vA * sc[1], yB = d2B + d1B * sc[0] + vB * sc[1];
                A0 = A0 * w4[0] + (d1A * b4[0] + vA * k4[0]); A1 = A1 * w4[1] + (d1A * b4[1] + vA * k4[1]); A2 = A2 * w4[2] + (d1A * b4[2] + vA * k4[2]); A3 = A3 * w4[3] + (d1A * b4[3] + vA * k4[3]);
                B0 = B0 * w4[0] + (d1B * b4[0] + vB * k4[0]); B1 = B1 * w4[1] + (d1B * b4[1] + vB * k4[1]); B2 = B2 * w4[2] + (d1B * b4[2] + vB * k4[2]); B3 = B3 * w4[3] + (d1B * b4[3] + vB * k4[3]);
                if (jseg == 0) { sm[RW2_YB + t * 32 + iA] = yA; sm[RW2_YB + t * 32 + iB] = yB; }
                a4 = a4n; wr4 = wr4n; w4 = w4n; b4 = b4n; k4 = k4n; vA = vAn; vB = vBn; sc = scn;
            }
            WSYNC();
            { const int tt = lane >> 1, hh = lane & 1; const f32x4 yv = *(const LAS f32x4*)(sm + RW2_YB + tt * 32 + 8 * wave + 4 * hh);
              *(f32x4*)(yraw + (rowb + t0 + tt) * 512 + h * 64 + half * 32 + 8 * wave + 4 * hh) = yv; }
            __syncthreads();
        }
    } else if (wave < 6) {
        const int tp = wave - 4, tb = 16 * tp;
        LAS float* stg = sm + RW2_STG + tp * 3072;
        float w0c[4], a0c[4], kkc[4], kac[4], rkc[4];
#pragma unroll
        for (int nt = 0; nt < 4; ++nt) { const int c = h * 64 + 16 * nt + l15; w0c[nt] = w0[c]; a0c[nt] = a0[c]; kkc[nt] = k_k[c]; kac[nt] = k_a[c]; rkc[nt] = r_k[c]; }
        v4u ld[20];
#define PREP_ISSUE(T0) do { const int t0_ = (T0); { const size_t r_ = rowb + t0_ + tb + l15; const size_t rp_ = (t0_ + tb + l15 == 0) ? r_ : r_ - 1; \
            _Pragma("unroll") for (int lo = 0; lo < 2; ++lo) _Pragma("unroll") for (int ks = 0; ks < 2; ++ks) { const int col = 1536 + 64 * lo + 32 * ks + 8 * kg; \
                ld[(lo * 2 + ks) * 2] = *(const v4u*)(proj + r_ * L0P + col); ld[(lo * 2 + ks) * 2 + 1] = *(const v4u*)(proj + rp_ * L0P + col); } } \
            _Pragma("unroll") for (int ar = 0; ar < 3; ++ar) _Pragma("unroll") for (int i = 0; i < 2; ++i) { const int p_ = lane + 64 * i, row_ = p_ >> 3, c8_ = p_ & 7; \
                const size_t r_ = rowb + t0_ + tb + row_; const size_t rp_ = (t0_ + tb + row_ == 0) ? r_ : r_ - 1; const int col = 512 * ar + h * 64 + 8 * c8_; \
                ld[8 + (ar * 2 + i) * 2] = *(const v4u*)(proj + r_ * L0P + col); ld[8 + (ar * 2 + i) * 2 + 1] = *(const v4u*)(proj + rp_ * L0P + col); } } while (0)
#define PREP_BUILD(T0, NB) do { const int t0_ = (T0); LAS float* CHn = sm + RW2_CH0 + (NB) * RW_CHSZ; \
            f32x4 accw[4], acca[4]; \
            _Pragma("unroll") for (int nt = 0; nt < 4; ++nt) { accw[nt] = (f32x4){0.f, 0.f, 0.f, 0.f}; acca[nt] = (f32x4){0.f, 0.f, 0.f, 0.f}; } \
            { const float pz_ = (t0_ + tb + l15 == 0) ? 0.f : 1.f; \
              _Pragma("unroll") for (int lo = 0; lo < 2; ++lo) _Pragma("unroll") for (int ks = 0; ks < 2; ++ks) { float s_[8]; \
                const f32x4 m0 = *(const LAS f32x4*)(sm + RW2_MIX + 64 * lo + 32 * ks + 8 * kg), m1 = *(const LAS f32x4*)(sm + RW2_MIX + 64 * lo + 32 * ks + 8 * kg + 4); \
                RW_SH8(ld[(lo * 2 + ks) * 2], ld[(lo * 2 + ks) * 2 + 1], m0, m1, s_, pz_); \
                if (lo == 0) { _Pragma("unroll") for (int j = 0; j < 8; ++j) s_[j] = tanh_fast(s_[j]); } \
                v4u aw; aw.x = cvtpk(s_[0], s_[1]); aw.y = cvtpk(s_[2], s_[3]); aw.z = cvtpk(s_[4], s_[5]); aw.w = cvtpk(s_[6], s_[7]); const bf16x8 af = __builtin_bit_cast(bf16x8, aw); \
                const bf16_t* WT = lo ? A2T : W2T; \
                _Pragma("unroll") for (int nt = 0; nt < 4; ++nt) { const bf16x8 bfr = *(const bf16x8*)(WT + (size_t)(h * 64 + 16 * nt + l15) * 64 + 32 * ks + 8 * kg); \
                    if (lo == 0) accw[nt] = MFMA16(af, bfr, accw[nt]); else acca[nt] = MFMA16(af, bfr, acca[nt]); } } } \
            _Pragma("unroll") for (int ar = 0; ar < 3; ++ar) _Pragma("unroll") for (int i = 0; i < 2; ++i) { const int p_ = lane + 64 * i, row_ = p_ >> 3, c8_ = p_ & 7; float s_[8]; \
                const float pz_ = (t0_ + tb + row_ == 0) ? 0.f : 1.f; const f32x4 m0 = *(const LAS f32x4*)(sm + RW2_MIX + 256 + ar * 64 + c8_ * 8), m1 = *(const LAS f32x4*)(sm + RW2_MIX + 256 + ar * 64 + c8_ * 8 + 4); \
                RW_SH8(ld[8 + (ar * 2 + i) * 2], ld[8 + (ar * 2 + i) * 2 + 1], m0, m1, s_, pz_); \
                *(LAS f32x4*)(stg + ar * 1024 + row_ * 64 + c8_ * 8) = (f32x4){s_[0], s_[1], s_[2], s_[3]}; *(LAS f32x4*)(stg + ar * 1024 + row_ * 64 + c8_ * 8 + 4) = (f32x4){s_[4], s_[5], s_[6], s_[7]}; } \
            WSYNC(); \
            PREP_ISSUE(((T0) + 32 < SEQ) ? (T0) + 32 : (T0)); \
            _Pragma("unroll") for (int rg = 0; rg < 4; ++rg) { const int tl = 4 * kg + rg, t = tb + tl; \
                float r_[4], k_[4], v_[4], kkv[4], nrm2 = 0.f; \
                _Pragma("unroll") for (int nt = 0; nt < 4; ++nt) { r_[nt] = stg[tl * 64 + 16 * nt + l15]; k_[nt] = stg[1024 + tl * 64 + 16 * nt + l15]; v_[nt] = stg[2048 + tl * 64 + 16 * nt + l15]; \
                    kkv[nt] = k_[nt] * kkc[nt]; nrm2 += kkv[nt] * kkv[nt]; } \
                nrm2 = rowsum16(nrm2); const float rn = __builtin_amdgcn_rsqf(fmaxf(nrm2, 1e-24f)); \
                float br = 0.f, kr = 0.f, bon = 0.f; \
                _Pragma("unroll") for (int nt = 0; nt < 4; ++nt) { const int j = 16 * nt + l15; \
                    const float wsum = w0c[nt] + accw[nt][rg]; const float logw = -softplus_fast(-wsum) - 0.5f; const float dec = __expf(-__expf(logw)); \
                    const float a_ = sigmoid_fast(a0c[nt] + acca[nt][rg]); const float kn = kkv[nt] * rn; \
                    const float k2 = k_[nt] * (1.f + (a_ - 1.f) * kac[nt]); const float bv = kn * a_; \
                    br += bv * r_[nt]; kr += k2 * r_[nt]; bon += r_[nt] * k2 * rkc[nt]; \
                    CHn[t * 64 + j] = dec; CHn[2048 + t * 64 + j] = k2; CHn[4096 + t * 64 + j] = -kn; CHn[6144 + t * 64 + j] = bv; CHn[8192 + t * 64 + j] = dec * r_[nt]; \
                    if ((nt >> 1) == half) CHn[10240 + t * 32 + (j & 31)] = v_[nt]; } \
                br = rowsum16(br); kr = rowsum16(kr); bon = rowsum16(bon); \
                if (l15 == 0) { CHn[11264 + 2 * t] = br; CHn[11264 + 2 * t + 1] = kr; if (half == 0) bonus_out[(rowb + t0_ + t) * 8 + h] = bon; } } \
            WSYNC(); } while (0)
        PREP_ISSUE(0);
        PREP_BUILD(0, 0);
        __syncthreads();
#pragma unroll 1
        for (int ch = 0; ch < NCHUNK; ++ch) {
            if (ch + 1 < NCHUNK) PREP_BUILD(ch * 32 + 32, (ch + 1) & 1);
            __syncthreads();
        }
#undef PREP_ISSUE
#undef PREP_BUILD
    } else {
        const int tp = wave - 6, tb = 16 * tp;
        v4u ld[8];
#define G_ISSUE(T0) do { const int t0_ = (T0); const size_t r_ = rowb + t0_ + tb + l15; const size_t rp_ = (t0_ + tb + l15 == 0) ? r_ : r_ - 1; \
            _Pragma("unroll") for (int ks = 0; ks < 4; ++ks) { const int col = 1664 + 32 * ks + 8 * kg; ld[2 * ks] = *(const v4u*)(proj + r_ * L0P + col); ld[2 * ks + 1] = *(const v4u*)(proj + rp_ * L0P + col); } } while (0)
#define G_BUILD(T0) do { const int t0_ = (T0); f32x4 accg[2] = {(f32x4){0.f, 0.f, 0.f, 0.f}, (f32x4){0.f, 0.f, 0.f, 0.f}}; const float pz_ = (t0_ + tb + l15 == 0) ? 0.f : 1.f; \
            _Pragma("unroll") for (int ks = 0; ks < 4; ++ks) { float s_[8]; \
                const f32x4 m0 = *(const LAS f32x4*)(sm + RW2_MIX + 128 + 32 * ks + 8 * kg), m1 = *(const LAS f32x4*)(sm + RW2_MIX + 128 + 32 * ks + 8 * kg + 4); \
                RW_SH8(ld[2 * ks], ld[2 * ks + 1], m0, m1, s_, pz_); \
                _Pragma("unroll") for (int j = 0; j < 8; ++j) s_[j] = sigmoid_fast(s_[j]); \
                v4u aw; aw.x = cvtpk(s_[0], s_[1]); aw.y = cvtpk(s_[2], s_[3]); aw.z = cvtpk(s_[4], s_[5]); aw.w = cvtpk(s_[6], s_[7]); const bf16x8 af = __builtin_bit_cast(bf16x8, aw); \
                _Pragma("unroll") for (int nt = 0; nt < 2; ++nt) { const bf16x8 bfr = *(const bf16x8*)(G2T + (size_t)(h * 64 + half * 32 + 16 * nt + l15) * 128 + 32 * ks + 8 * kg); accg[nt] = MFMA16(af, bfr, accg[nt]); } } \
            G_ISSUE(((T0) + 32 < SEQ) ? (T0) + 32 : (T0)); \
            _Pragma("unroll") for (int nt = 0; nt < 2; ++nt) _Pragma("unroll") for (int rg = 0; rg < 4; ++rg) \
                gout[(rowb + t0_ + tb + 4 * kg + rg) * 512 + h * 64 + half * 32 + 16 * nt + l15] = (bf16_t)f2bf(accg[nt][rg]); } while (0)
        G_ISSUE(0);
        G_BUILD(0);
        __syncthreads();
#pragma unroll 1
        for (int ch = 0; ch < NCHUNK; ++ch) {
            if (ch + 1 < NCHUNK) G_BUILD(ch * 32 + 32);
            __syncthreads();
        }
#undef G_ISSUE
#undef G_BUILD
    }
#undef RW_SH8
    __syncthreads();
}

constexpr int CK_BK = 0, CK_AR = 4608, CK_BBT = 9216, CK_KBT = 12288, CK_VT = 15360, CK_GC = 16896, CK_TT = 17152, CK_SLOT = 18688, CK_NSLOT = 5;
constexpr int CK_STG = CK_SLOT * CK_NSLOT;
constexpr int CK_MIX = CK_STG + 4 * 12288;
constexpr int CK_FLAGS = CK_MIX + 448 * 4;
static_assert(CK_FLAGS + 64 <= 146432, "rwkv chunked LDS map");
__device__ __forceinline__ void rwkv_phase(LAS float* smf, int tid, int lane, int wave, int blk, const bf16_t* __restrict__ proj, const float* __restrict__ mix, const float* __restrict__ w0, const float* __restrict__ a0,
                                           const float* __restrict__ k_k, const float* __restrict__ k_a, const float* __restrict__ r_k, const bf16_t* __restrict__ W2T, const bf16_t* __restrict__ A2T, const bf16_t* __restrict__ G2T,
                                           float* __restrict__ yraw, bf16_t* __restrict__ gout, float* __restrict__ bonus_out) {
    LAS unsigned char* lds = (LAS unsigned char*)smf;
    LAS float* mixs = (LAS float*)(lds + CK_MIX);
    volatile LAS unsigned* flags = (volatile LAS unsigned*)(lds + CK_FLAGS);
    const int chain = blk >> 1, ihalf = blk & 1, b = chain >> 3, h = chain & 7, l15 = lane & 15, kg = lane >> 4, l31 = lane & 31, hi = lane >> 5;
    const size_t rowb = (size_t)b * SEQ;
    constexpr int NCH = SEQ / 16;
    if (tid < 256) mixs[tid] = mix[1536 + tid];
    else if (tid < 448) { const int q = tid - 256; mixs[tid] = mix[512 * (q >> 6) + h * 64 + (q & 63)]; }
    if (tid < 16) flags[tid] = 0u;
    for (int q = tid; q < CK_NSLOT * 384; q += NWAVES * 64) *(LAS unsigned*)(lds + (q / 384) * CK_SLOT + CK_TT + (q % 384) * 4) = 0u;
    __syncthreads();
#define RW_SH8(CUR, PRV, M0, M1, OUT, PZ) do { const unsigned cu_[4] = {(CUR).x, (CUR).y, (CUR).z, (CUR).w}, pu_[4] = {(PRV).x, (PRV).y, (PRV).z, (PRV).w}; \
        const float mm_[8] = {(M0)[0], (M0)[1], (M0)[2], (M0)[3], (M1)[0], (M1)[1], (M1)[2], (M1)[3]}; \
        _Pragma("unroll") for (int q = 0; q < 4; ++q) { const float c0 = bflo(cu_[q]), c1 = bfhi(cu_[q]), p0 = bflo(pu_[q]) * (PZ), p1 = bfhi(pu_[q]) * (PZ); \
            OUT[2 * q] = c0 + (p0 - c0) * mm_[2 * q]; OUT[2 * q + 1] = c1 + (p1 - c1) * mm_[2 * q + 1]; } } while (0)
    if (wave == 0) {
        f32x16 ST[2];
#pragma unroll
        for (int r = 0; r < 16; ++r) { ST[0][r] = 0.f; ST[1][r] = 0.f; }
#pragma unroll 1
        for (int k = 0; k < NCH; ++k) {
#if defined(PROBE_STAMPS)
            const unsigned tw0_ = (unsigned)__builtin_amdgcn_s_memrealtime();
#endif
            { const unsigned want = (unsigned)(k + 1); const int sl = k % CK_NSLOT; while (flags[sl] != want) __builtin_amdgcn_s_sleep(1); }
#if defined(PROBE_STAMPS)
            if (blk == 0 && lane == 0) ((volatile LAS unsigned*)(lds + 146432 + 320))[16 + 24] += (unsigned)__builtin_amdgcn_s_memrealtime() - tw0_;
#endif
            asm volatile("" ::: "memory");
            const LAS unsigned char* im = lds + (k % CK_NSLOT) * CK_SLOT;
            f32x16 G;
#pragma unroll
            for (int r = 0; r < 16; ++r) G[r] = 0.f;
#pragma unroll
            for (int kk = 0; kk < 4; ++kk) { const bf16x8 fa = *(const LAS bf16x8*)(im + CK_BK + l31 * 144 + (16 * kk + 8 * hi) * 2), fb = *(const LAS bf16x8*)(im + CK_AR + l31 * 144 + (16 * kk + 8 * hi) * 2); G = MFMA32(fa, fb, G); }
            { const int tcol = l31 & 15; const bool strict = l31 < 16;
#pragma unroll
              for (int r = 0; r < 16; ++r) { const int srow = crow(r & 7, hi); const bool keep = strict ? (srow < tcol) : (srow <= tcol); G[r] = keep ? G[r] : 0.f; } }
            const bf16x8 gB = pack8(G[0], G[1], G[2], G[3], G[4], G[5], G[6], G[7]), gK = pack8(G[8], G[9], G[10], G[11], G[12], G[13], G[14], G[15]);
            f32x16 XT;
#pragma unroll
            for (int r = 0; r < 16; ++r) XT[r] = 0.f;
#pragma unroll
            for (int jt = 0; jt < 2; ++jt)
#pragma unroll
                for (int sp = 0; sp < 2; ++sp) { const LAS unsigned char* ap = im + CK_AR + l31 * 144 + (32 * jt + 16 * sp + 4 * hi) * 2;
                    const u32x2 x0 = *(const LAS u32x2*)ap, x1 = *(const LAS u32x2*)(ap + 16); v4u aw; aw.x = x0.x; aw.y = x0.y; aw.z = x1.x; aw.w = x1.y;
                    const bf16x8 sb_ = pack8(ST[jt][8 * sp], ST[jt][8 * sp + 1], ST[jt][8 * sp + 2], ST[jt][8 * sp + 3], ST[jt][8 * sp + 4], ST[jt][8 * sp + 5], ST[jt][8 * sp + 6], ST[jt][8 * sp + 7]);
                    XT = MFMA32(__builtin_bit_cast(bf16x8, aw), sb_, XT); }
            bf16x8 vP;
            { const LAS unsigned char* vp = im + CK_VT + l31 * 48 + (4 * hi) * 2; const u32x2 x0 = *(const LAS u32x2*)vp, x1 = *(const LAS u32x2*)(vp + 16); v4u vw; vw.x = x0.x; vw.y = x0.y; vw.z = x1.x; vw.w = x1.y;
              vP = __builtin_bit_cast(bf16x8, vw); XT = MFMA32(gK, vP, XT); }
            bf16x8 uP;
            { const LAS unsigned char* tp = im + CK_TT + l31 * 48 + (4 * hi) * 2; const u32x2 x0 = *(const LAS u32x2*)tp, x1 = *(const LAS u32x2*)(tp + 16); v4u tw; tw.x = x0.x; tw.y = x0.y; tw.z = x1.x; tw.w = x1.y;
              f32x16 UT;
#pragma unroll
              for (int r = 0; r < 16; ++r) UT[r] = 0.f;
              UT = MFMA32(__builtin_bit_cast(bf16x8, tw), pack8(XT[0], XT[1], XT[2], XT[3], XT[4], XT[5], XT[6], XT[7]), UT);
              uP = pack8(UT[0], UT[1], UT[2], UT[3], UT[4], UT[5], UT[6], UT[7]); }
            XT = MFMA32(gB, uP, XT);
            { float* yp = yraw + (rowb + 16 * k) * 512 + h * 64 + 32 * ihalf + l31;
#pragma unroll
              for (int q = 0; q < 8; ++q) yp[(size_t)crow(q, hi) * 512] = XT[8 + q]; }
            { const LAS float* gc = (const LAS float*)(im + CK_GC);
#pragma unroll
              for (int jt = 0; jt < 2; ++jt)
#pragma unroll
                  for (int r = 0; r < 16; ++r) ST[jt][r] *= gc[32 * jt + crow(r, hi)]; }
#pragma unroll
            for (int jt = 0; jt < 2; ++jt) { const LAS unsigned char* bp = im + CK_BBT + (32 * jt + l31) * 48 + (4 * hi) * 2; const LAS unsigned char* kp = im + CK_KBT + (32 * jt + l31) * 48 + (4 * hi) * 2;
                const u32x2 b0 = *(const LAS u32x2*)bp, b1 = *(const LAS u32x2*)(bp + 16), k0 = *(const LAS u32x2*)kp, k1 = *(const LAS u32x2*)(kp + 16);
                v4u a1; a1.x = b0.x; a1.y = b0.y; a1.z = b1.x; a1.w = b1.y; v4u a2; a2.x = k0.x; a2.y = k0.y; a2.z = k1.x; a2.w = k1.y;
                ST[jt] = MFMA32(__builtin_bit_cast(bf16x8, a1), uP, ST[jt]); ST[jt] = MFMA32(__builtin_bit_cast(bf16x8, a2), vP, ST[jt]); }
            WSYNC();
            if (lane == 0) flags[8] = (unsigned)(k + 1);
        }
    } else if (wave <= 4) {
        const int pw = wave - 1;
        LAS float* stg = (LAS float*)(lds + CK_STG) + pw * 3072;
        float w0c[4], a0c[4], kkc[4], kac[4], rkc[4];
#pragma unroll
        for (int nt = 0; nt < 4; ++nt) { const int c = h * 64 + 16 * nt + l15; w0c[nt] = w0[c]; a0c[nt] = a0[c]; kkc[nt] = k_k[c]; kac[nt] = k_a[c]; rkc[nt] = r_k[c]; }
        v4u ld[20];
#define CK_ISSUE_A(T0) do { const int t0_ = (T0); const size_t r_ = rowb + t0_ + l15; const size_t rp_ = (t0_ + l15 == 0) ? r_ : r_ - 1; \
            _Pragma("unroll") for (int lo = 0; lo < 2; ++lo) _Pragma("unroll") for (int ks = 0; ks < 2; ++ks) { const int col = 1536 + 64 * lo + 32 * ks + 8 * kg; \
                ld[(lo * 2 + ks) * 2] = *(const v4u*)(proj + r_ * L0P + col); ld[(lo * 2 + ks) * 2 + 1] = *(const v4u*)(proj + rp_ * L0P + col); } } while (0)
#define CK_ISSUE_B(T0) do { const int t0_ = (T0); \
            _Pragma("unroll") for (int ar = 0; ar < 3; ++ar) _Pragma("unroll") for (int i = 0; i < 2; ++i) { const int p_ = lane + 64 * i, row_ = p_ >> 3, c8_ = p_ & 7; \
                const size_t r_ = rowb + t0_ + row_; const size_t rp_ = (t0_ + row_ == 0) ? r_ : r_ - 1; const int col = 512 * ar + h * 64 + 8 * c8_; \
                ld[8 + (ar * 2 + i) * 2] = *(const v4u*)(proj + r_ * L0P + col); ld[8 + (ar * 2 + i) * 2 + 1] = *(const v4u*)(proj + rp_ * L0P + col); } } while (0)
#define CK_ISSUE(T0) do { CK_ISSUE_A(T0); CK_ISSUE_B(T0); } while (0)
        CK_ISSUE(16 * pw);
#pragma unroll 1
        for (int k = pw; k < NCH; k += 4) {
            const int t0 = 16 * k;
#if defined(PROBE_STAMPS)
            const unsigned ts0_ = (unsigned)__builtin_amdgcn_s_memrealtime();
#endif
            f32x4 accw[4], acca[4];
#pragma unroll
            for (int nt = 0; nt < 4; ++nt) { accw[nt] = (f32x4){0.f, 0.f, 0.f, 0.f}; acca[nt] = (f32x4){0.f, 0.f, 0.f, 0.f}; }
            { const float pz_ = (t0 + l15 == 0) ? 0.f : 1.f;
#pragma unroll
              for (int lo = 0; lo < 2; ++lo)
#pragma unroll
                for (int ks = 0; ks < 2; ++ks) { float s_[8];
                    const f32x4 m0 = *(const LAS f32x4*)(mixs + 64 * lo + 32 * ks + 8 * kg), m1 = *(const LAS f32x4*)(mixs + 64 * lo + 32 * ks + 8 * kg + 4);
                    RW_SH8(ld[(lo * 2 + ks) * 2], ld[(lo * 2 + ks) * 2 + 1], m0, m1, s_, pz_);
                    if (lo == 0) {
#pragma unroll
                        for (int j = 0; j < 8; ++j) s_[j] = tanh_fast(s_[j]); }
                    const bf16x8 af = pack8(s_[0], s_[1], s_[2], s_[3], s_[4], s_[5], s_[6], s_[7]);
                    const bf16_t* WT = lo ? A2T : W2T;
#pragma unroll
                    for (int nt = 0; nt < 4; ++nt) { const bf16x8 bfr = *(const bf16x8*)(WT + (size_t)(h * 64 + 16 * nt + l15) * 64 + 32 * ks + 8 * kg);
                        if (lo == 0) accw[nt] = MFMA16(af, bfr, accw[nt]); else acca[nt] = MFMA16(af, bfr, acca[nt]); } } }
#pragma unroll
            for (int ar = 0; ar < 3; ++ar)
#pragma unroll
                for (int i = 0; i < 2; ++i) { const int p_ = lane + 64 * i, row_ = p_ >> 3, c8_ = p_ & 7; float s_[8];
                    const float pz_ = (t0 + row_ == 0) ? 0.f : 1.f; const f32x4 m0 = *(const LAS f32x4*)(mixs + 256 + ar * 64 + c8_ * 8), m1 = *(const LAS f32x4*)(mixs + 256 + ar * 64 + c8_ * 8 + 4);
                    RW_SH8(ld[8 + (ar * 2 + i) * 2], ld[8 + (ar * 2 + i) * 2 + 1], m0, m1, s_, pz_);
                    *(LAS f32x4*)(stg + ar * 1024 + row_ * 64 + c8_ * 8) = (f32x4){s_[0], s_[1], s_[2], s_[3]}; *(LAS f32x4*)(stg + ar * 1024 + row_ * 64 + c8_ * 8 + 4) = (f32x4){s_[4], s_[5], s_[6], s_[7]}; }
            WSYNC();
#if defined(PROBE_STAMPS)
            if (blk == 0 && wave == 1 && lane == 0) ((volatile LAS unsigned*)(lds + 146432 + 320))[16 + 26] += (unsigned)__builtin_amdgcn_s_memrealtime() - ts0_;
#endif
#if defined(PROBE_STAMPS)
            const unsigned tb0_ = (unsigned)__builtin_amdgcn_s_memrealtime();
#endif
            { const int need = k - (CK_NSLOT - 1); if (need > 0) { while ((int)flags[8] < need) __builtin_amdgcn_s_sleep(2); } }
#if defined(PROBE_STAMPS)
            if (blk == 0 && wave == 1 && lane == 0) ((volatile LAS unsigned*)(lds + 146432 + 320))[16 + 25] += (unsigned)__builtin_amdgcn_s_memrealtime() - tb0_;
#endif
            asm volatile("" ::: "memory");
            LAS unsigned char* im = lds + (k % CK_NSLOT) * CK_SLOT;
#if defined(PROBE_STAMPS)
            const unsigned ts1_ = (unsigned)__builtin_amdgcn_s_memrealtime();
#endif
            float lwv[4][4], av[4][4], knv[4][4];
#pragma unroll
            for (int rg = 0; rg < 4; ++rg) { const int tl = 4 * kg + rg;
                float kkv[4], nrm2 = 0.f, vv[4], rr_[4], kr_[4];
#pragma unroll
                for (int nt = 0; nt < 4; ++nt) { rr_[nt] = stg[tl * 64 + 16 * nt + l15]; kr_[nt] = stg[1024 + tl * 64 + 16 * nt + l15]; vv[nt] = stg[2048 + tl * 64 + 16 * nt + l15];
                    kkv[nt] = kr_[nt] * kkc[nt]; nrm2 += kkv[nt] * kkv[nt]; }
                nrm2 = rowsum16(nrm2); const float rn = __builtin_amdgcn_rsqf(fmaxf(nrm2, 1e-24f));
                float bon = 0.f;
#pragma unroll
                for (int nt = 0; nt < 4; ++nt) {
                    const float wsum = w0c[nt] + accw[nt][rg]; lwv[nt][rg] = -0.6065306597126334f * sigmoid_fast(wsum);
                    const float a_ = sigmoid_fast(a0c[nt] + acca[nt][rg]); av[nt][rg] = a_; knv[nt][rg] = kkv[nt] * rn;
                    const float k2 = kr_[nt] * (1.f + (a_ - 1.f) * kac[nt]); stg[1024 + tl * 64 + 16 * nt + l15] = k2;
                    bon += rr_[nt] * k2 * rkc[nt];
                    if ((nt >> 1) == ihalf) *(LAS bf16_t*)(im + CK_VT + (16 * (nt & 1) + l15) * 48 + tl * 2) = bf1(vv[nt]);
                }
                bon = rowsum16(bon);
                if (l15 == 0 && ihalf == 0) bonus_out[(rowb + t0 + tl) * 8 + h] = bon;
            }
            CK_ISSUE_A((k + 4 < NCH) ? t0 + 64 : t0);
#pragma unroll
            for (int nt = 0; nt < 4; ++nt) {
                float L[4]; L[0] = lwv[nt][0]; L[1] = L[0] + lwv[nt][1]; L[2] = L[1] + lwv[nt][2]; L[3] = L[2] + lwv[nt][3];
                const float T0 = __shfl(L[3], l15), T1 = __shfl(L[3], 16 + l15), T2 = __shfl(L[3], 32 + l15), T3 = __shfl(L[3], 48 + l15);
                const float off = (kg > 0 ? T0 : 0.f) + (kg > 1 ? T1 : 0.f) + (kg > 2 ? T2 : 0.f), LC = (T0 + T1) + (T2 + T3);
                const int j = 16 * nt + l15;
                unsigned bb2[2], kb2[2];
                const float gC = __expf(LC); float eprev = __expf(off);
#pragma unroll
                for (int rg = 0; rg < 4; ++rg) { const int tl = 4 * kg + rg; const float Lt = off + L[rg], e1 = __expf(Lt), e2 = __builtin_amdgcn_rcpf(e1), e3 = eprev, e4 = gC * e2; eprev = e1;
                    const float kn = knv[nt][rg], bvv = kn * av[nt][rg], k2 = stg[1024 + tl * 64 + j], rr2 = stg[tl * 64 + j];
                    *(LAS bf16_t*)(im + CK_BK + tl * 144 + j * 2) = bf1(bvv * e2); *(LAS bf16_t*)(im + CK_BK + (16 + tl) * 144 + j * 2) = bf1(k2 * e2);
                    *(LAS bf16_t*)(im + CK_AR + tl * 144 + j * 2) = bf1(-kn * e3); *(LAS bf16_t*)(im + CK_AR + (16 + tl) * 144 + j * 2) = bf1(rr2 * e1);
                    const unsigned bq = bf1(bvv * e4), kq = bf1(k2 * e4);
                    if (rg & 1) { bb2[rg >> 1] |= bq << 16; kb2[rg >> 1] |= kq << 16; } else { bb2[rg >> 1] = bq; kb2[rg >> 1] = kq; } }
                *(LAS u32x2*)(im + CK_BBT + j * 48 + (4 * kg) * 2) = (u32x2){bb2[0], bb2[1]}; *(LAS u32x2*)(im + CK_KBT + j * 48 + (4 * kg) * 2) = (u32x2){kb2[0], kb2[1]};
                if (kg == 0) *(LAS float*)(im + CK_GC + j * 4) = gC;
            }
            WSYNC();
#if defined(PROBE_STAMPS)
            const unsigned ts2_ = (unsigned)__builtin_amdgcn_s_memrealtime();
            if (blk == 0 && wave == 1 && lane == 0) ((volatile LAS unsigned*)(lds + 146432 + 320))[16 + 27] += ts2_ - ts1_;
#endif
            {
                f32x4 nacc = {0.f, 0.f, 0.f, 0.f};
#pragma unroll
                for (int ks = 0; ks < 2; ++ks) { const bf16x8 fa = *(const LAS bf16x8*)(im + CK_BK + l15 * 144 + (32 * ks + 8 * kg) * 2), fb = *(const LAS bf16x8*)(im + CK_AR + l15 * 144 + (32 * ks + 8 * kg) * 2); nacc = MFMA16(fa, fb, nacc); }
#pragma unroll
                for (int rg = 0; rg < 4; ++rg) nacc[rg] = ((4 * kg + rg) < l15) ? nacc[rg] : 0.f;
                float Tr[16];
#pragma unroll
                for (int t = 0; t < 16; ++t) { float acc_ = (l15 == t) ? 1.f : 0.f;
#pragma unroll
                    for (int s2 = 0; s2 < t; ++s2) acc_ += Tr[s2] * rl(nacc[s2 & 3], t + 16 * (s2 >> 2));
                    Tr[t] = acc_; }
                if (kg == 0) {
#pragma unroll
                    for (int t = 0; t < 16; ++t) *(LAS bf16_t*)(im + CK_TT + t * 48 + l15 * 2) = bf1(Tr[t]); }
            }
            WSYNC();
#if defined(PROBE_STAMPS)
            if (blk == 0 && wave == 1 && lane == 0) ((volatile LAS unsigned*)(lds + 146432 + 320))[16 + 28] += (unsigned)__builtin_amdgcn_s_memrealtime() - ts2_;
#endif
            if (lane == 0) flags[k % CK_NSLOT] = (unsigned)(k + 1);
            CK_ISSUE_B((k + 4 < NCH) ? t0 + 64 : t0);
        }
#undef CK_ISSUE
#undef CK_ISSUE_A
#undef CK_ISSUE_B
    } else if (wave <= 6) {
        const int gq = wave - 5;
        v4u ld[8];
#define G_ISSUE(T0) do { const int t0_ = (T0); const size_t r_ = rowb + t0_ + l15; const size_t rp_ = (t0_ + l15 == 0) ? r_ : r_ - 1; \
            _Pragma("unroll") for (int ks = 0; ks < 4; ++ks) { const int col = 1664 + 32 * ks + 8 * kg; ld[2 * ks] = *(const v4u*)(proj + r_ * L0P + col); ld[2 * ks + 1] = *(const v4u*)(proj + rp_ * L0P + col); } } while (0)
        G_ISSUE(16 * gq);
#pragma unroll 1
        for (int k = gq; k < NCH; k += 2) {
            const int t0 = 16 * k;
            f32x4 accg[2] = {(f32x4){0.f, 0.f, 0.f, 0.f}, (f32x4){0.f, 0.f, 0.f, 0.f}}; const float pz_ = (t0 + l15 == 0) ? 0.f : 1.f;
#pragma unroll
            for (int ks = 0; ks < 4; ++ks) { float s_[8];
                const f32x4 m0 = *(const LAS f32x4*)(mixs + 128 + 32 * ks + 8 * kg), m1 = *(const LAS f32x4*)(mixs + 128 + 32 * ks + 8 * kg + 4);
                RW_SH8(ld[2 * ks], ld[2 * ks + 1], m0, m1, s_, pz_);
#pragma unroll
                for (int j = 0; j < 8; ++j) s_[j] = sigmoid_fast(s_[j]);
                const bf16x8 af = pack8(s_[0], s_[1], s_[2], s_[3], s_[4], s_[5], s_[6], s_[7]);
#pragma unroll
                for (int nt = 0; nt < 2; ++nt) { const bf16x8 bfr = *(const bf16x8*)(G2T + (size_t)(h * 64 + ihalf * 32 + 16 * nt + l15) * 128 + 32 * ks + 8 * kg); accg[nt] = MFMA16(af, bfr, accg[nt]); } }
            G_ISSUE((k + 2 < NCH) ? t0 + 32 : t0);
#pragma unroll
            for (int nt = 0; nt < 2; ++nt)
#pragma unroll
                for (int rg = 0; rg < 4; ++rg) gout[(rowb + t0 + 4 * kg + rg) * 512 + h * 64 + ihalf * 32 + 16 * nt + l15] = bf1(accg[nt][rg]);
        }
#undef G_ISSUE
    }
#undef RW_SH8
    __syncthreads();
}

template <bool ST = true> __device__ __forceinline__ void rwkv_post_all(const float* __restrict__ yraw, const bf16_t* __restrict__ proj, const float* __restrict__ mix, const float* __restrict__ bonus, const bf16_t* __restrict__ gbuf,
                                              const float* __restrict__ ln_g, const float* __restrict__ ln_b, bf16_t* __restrict__ ymix, int gw, int NGW, int lane) {
    for (int m = gw; m < M; m += NGW) {
        const bool has_prev = (m & (SEQ - 1)) != 0;
        float y[8], cv[8], pv[8], gg[8], bo[8];
#pragma unroll
        for (int h = 0; h < 8; ++h) { const int c = h * 64 + lane; y[h] = yraw[(size_t)m * 512 + c]; cv[h] = bf2f(proj[(size_t)m * L0P + 1024 + c]);
            pv[h] = bf2f(proj[(size_t)(has_prev ? m - 1 : m) * L0P + 1024 + c]); gg[h] = bf2f(gbuf[(size_t)m * 512 + c]); bo[h] = bonus[(size_t)m * 8 + h]; }
#pragma unroll
        for (int h = 0; h < 8; ++h) { const int c = h * 64 + lane;
            const float mu = wave_sum_dpp(y[h]) * (1.f / 64.f), d = y[h] - mu, var = wave_sum_dpp(d * d) * (1.f / 64.f);
            const float yn = d * __builtin_amdgcn_rsqf(var + 64e-5f) * ln_g[c] + ln_b[c];
            const float pvv = has_prev ? pv[h] : 0.f;
            const float v_s = cv[h] + (pvv - cv[h]) * mix[1024 + c];
            const float o = (yn + bo[h] * v_s) * gg[h];
            if (ST) ymix[(size_t)m * DM + c] = (bf16_t)f2bf(o); else asm volatile("" :: "v"(o)); }
    }
}


__device__ __forceinline__ void ssd_conv_tile(int it, int lane, LAS bf16_t* scr, const bf16_t* __restrict__ proj, const float* __restrict__ cw, const float* __restrict__ cb,
                                              bf16_t* __restrict__ xbc, bf16_t* __restrict__ xst, bf16_t* __restrict__ bt) {
    const int tt = it >> 4, ct = it & 15, m0 = tt * 64, b = m0 >> 11, t0 = m0 & (SEQ - 1), c = ct * 64 + lane;
    const float w0 = cw[c], w1 = cw[1024 + c], w2 = cw[2048 + c], w3 = cw[3072 + c], bias = cb[c];
    const bf16_t* src = proj + (size_t)m0 * L0P + 2304 + c;
    bf16_t raw[67];
    const int lo = (t0 > 0) ? -3 : 0;
#pragma unroll
    for (int t = -3; t < 64; ++t) raw[t + 3] = src[(ptrdiff_t)((t < lo) ? lo : t) * L0P];
    float u3 = (t0 > 0) ? bf2f(raw[0]) : 0.f, u2 = (t0 > 0) ? bf2f(raw[1]) : 0.f, u1 = (t0 > 0) ? bf2f(raw[2]) : 0.f;
#pragma unroll
    for (int t = 0; t < 64; ++t) {
        const float u = bf2f(raw[t + 3]);
        const float y = bias + w0 * u3 + w1 * u2 + w2 * u1 + w3 * u;
        const bf16_t o = bf1(y * __builtin_amdgcn_rcpf(1.f + __expf(-y)));
        xbc[(size_t)(m0 + t) * 1024 + c] = o;
        scr[t * STG_PITCH + lane] = o;
        u3 = u2; u2 = u1; u1 = u;
    }
    WSYNC();
    if (ct < 12) {
        bf16_t* dst = (ct < 8) ? xst + ((size_t)(b * 8 + ct) * 64) * SEQ + t0 : bt + ((size_t)(b * 2 + ((ct - 8) >> 1)) * 128 + ((ct - 8) & 1) * 64) * SEQ + t0;
#pragma unroll
        for (int i = 0; i < 8; ++i) { const int d = i * 8 + (lane >> 3), tc = lane & 7; const LAS bf16_t* p = scr + (tc * 8) * STG_PITCH + d;
            v4u o; o.x = (unsigned)p[0] | ((unsigned)p[STG_PITCH] << 16); o.y = (unsigned)p[2 * STG_PITCH] | ((unsigned)p[3 * STG_PITCH] << 16);
            o.z = (unsigned)p[4 * STG_PITCH] | ((unsigned)p[5 * STG_PITCH] << 16); o.w = (unsigned)p[6 * STG_PITCH] | ((unsigned)p[7 * STG_PITCH] << 16);
            *(v4u*)(dst + (size_t)d * SEQ + tc * 8) = o; }
    }
    WSYNC();
}
__device__ __forceinline__ float bperm(int srclane, float x) { return __builtin_bit_cast(float, __builtin_amdgcn_ds_bpermute(srclane << 2, __builtin_bit_cast(int, x))); }
__device__ __forceinline__ void scan128(float& x0, float& x1, int lane) {
#pragma unroll
    for (int o = 1; o < 64; o <<= 1) { const int sl = (lane >= o) ? lane - o : lane; const float t0 = bperm(sl, x0), t1 = bperm(sl, x1); if (lane >= o) { x0 += t0; x1 += t1; } }
    x1 += rl(x0, 63);
}
__device__ __forceinline__ void ssd_s1_unit(int unit, int lane, LAS float* tab, const bf16_t* __restrict__ xst, const bf16_t* __restrict__ bt, const float* __restrict__ dt, const float* __restrict__ a_log,
                                            float* __restrict__ sloc, float* __restrict__ asum) {
    const int h = unit & 7, c = (unit >> 3) & 15, b = unit >> 7, g = h >> 2, l0 = c * 128, l31 = lane & 31, hi = lane >> 5;
    const size_t m0 = (size_t)b * SEQ + l0;
    const float A = -expf(a_log[h]);
    const float d0 = dt[(m0 + lane) * 8 + h], d1 = dt[(m0 + 64 + lane) * 8 + h];
    float ac0 = d0 * A, ac1 = d1 * A;
    scan128(ac0, ac1, lane);
    const float aend = rl(ac1, 63);
    tab[lane] = __expf(aend - ac0) * d0; tab[64 + lane] = __expf(aend - ac1) * d1;
    if (lane == 0) asum[unit] = aend;
    WSYNC();
    f32x16 acc[2][4];
#pragma unroll
    for (int pt = 0; pt < 2; ++pt)
#pragma unroll
        for (int nt = 0; nt < 4; ++nt)
#pragma unroll
            for (int r = 0; r < 16; ++r) acc[pt][nt][r] = 0.f;
    const bf16_t* Xp = xst + ((size_t)(b * 8 + h) * 64 + l31) * SEQ + l0 + 8 * hi;
    const bf16_t* Bp = bt + ((size_t)(b * 2 + g) * 128 + l31) * SEQ + l0 + 8 * hi;
#pragma unroll 2
    for (int kk = 0; kk < 8; ++kk) {
        const f32x4 wa = *(const LAS f32x4*)(tab + 16 * kk + 8 * hi), wb = *(const LAS f32x4*)(tab + 16 * kk + 8 * hi + 4);
        bf16x8 af[2], bfr[4];
#pragma unroll
        for (int pt = 0; pt < 2; ++pt) { const v4u raw = *(const v4u*)(Xp + (size_t)pt * 32 * SEQ + 16 * kk);
            v4u w; w.x = cvtpk(bflo(raw.x) * wa[0], bfhi(raw.x) * wa[1]); w.y = cvtpk(bflo(raw.y) * wa[2], bfhi(raw.y) * wa[3]);
            w.z = cvtpk(bflo(raw.z) * wb[0], bfhi(raw.z) * wb[1]); w.w = cvtpk(bflo(raw.w) * wb[2], bfhi(raw.w) * wb[3]); af[pt] = __builtin_bit_cast(bf16x8, w); }
#pragma unroll
        for (int nt = 0; nt < 4; ++nt) bfr[nt] = *(const bf16x8*)(Bp + (size_t)nt * 32 * SEQ + 16 * kk);
#pragma unroll
        for (int pt = 0; pt < 2; ++pt)
#pragma unroll
            for (int nt = 0; nt < 4; ++nt) acc[pt][nt] = MFMA32(af[pt], bfr[nt], acc[pt][nt]);
    }
    float* dst = sloc + (size_t)unit * 8192 + l31;
#pragma unroll
    for (int pt = 0; pt < 2; ++pt)
#pragma unroll
        for (int nt = 0; nt < 4; ++nt)
#pragma unroll
            for (int r = 0; r < 16; ++r) dst[(32 * pt + crow(r, hi)) * 128 + 32 * nt] = acc[pt][nt][r];
    WSYNC();
}
__device__ __forceinline__ void ssd_s2_all(const float* __restrict__ sloc, const float* __restrict__ asum, bf16_t* __restrict__ stb, int gtid, int NT) {
    for (int i = gtid; i < 128 * 2048; i += NT) {
        const int bh = i >> 11, e4 = i & 2047, b = bh >> 3, h = bh & 7;
        f32x4 run = {0.f, 0.f, 0.f, 0.f};
#pragma unroll 4
        for (int c = 0; c < 16; ++c) { const int unit = (b * 16 + c) * 8 + h; const f32x4 tmp = *(const f32x4*)(sloc + (size_t)unit * 8192 + e4 * 4);
            uint2 w; w.x = cvtpk(run[0], run[1]); w.y = cvtpk(run[2], run[3]); *(uint2*)(stb + (size_t)unit * 8192 + e4 * 4) = w;
            run = run * __expf(asum[unit]) + tmp; }
    }
}
__device__ __forceinline__ void ssd_s3_unit(int unit, int lane, LAS float* tab, const bf16_t* __restrict__ xbc, const bf16_t* __restrict__ xst, const bf16_t* __restrict__ stb, const float* __restrict__ dt,
                                            const float* __restrict__ a_log, const float* __restrict__ dsk, bf16_t* __restrict__ yssm) {
    const int h = unit & 7, c = (unit >> 3) & 15, b = unit >> 7, g = h >> 2, l0 = c * 128, l31 = lane & 31, hi = lane >> 5;
    const size_t m0 = (size_t)b * SEQ + l0;
    const float A = -expf(a_log[h]), D = dsk[h];
    const float d0 = dt[(m0 + lane) * 8 + h], d1 = dt[(m0 + 64 + lane) * 8 + h];
    float ac0 = d0 * A, ac1 = d1 * A;
    scan128(ac0, ac1, lane);
    tab[lane] = ac0; tab[64 + lane] = ac1; tab[128 + lane] = d0; tab[192 + lane] = d1;
    WSYNC();
    const bf16_t* Cp = xbc + (m0 + l31) * 1024 + 768 + g * 128 + 8 * hi;
    const bf16_t* Sp = stb + (size_t)unit * 8192 + l31 * 128 + 8 * hi;
    const bf16_t* Bp = xbc + (m0 + l31) * 1024 + 512 + g * 128 + 8 * hi;
    const bf16_t* Xp = xst + ((size_t)(b * 8 + h) * 64 + l31) * SEQ + l0 + 4 * hi;
    LAS float* tr = tab + 256;
    const int row = lane >> 1, p0 = (lane & 1) * 16;
#pragma unroll 1
    for (int lt = 0; lt < 4; ++lt) {
        f32x16 y[2];
#pragma unroll
        for (int r = 0; r < 16; ++r) { y[0][r] = 0.f; y[1][r] = 0.f; }
        const float acl = tab[32 * lt + l31];
        bf16x8 cfr[8];
#pragma unroll
        for (int kk = 0; kk < 8; ++kk) cfr[kk] = *(const bf16x8*)(Cp + (size_t)lt * 32 * 1024 + 16 * kk);
        {   bf16x8 s0[8], s1[8];
#pragma unroll
            for (int kk = 0; kk < 8; ++kk) { s0[kk] = *(const bf16x8*)(Sp + 16 * kk); s1[kk] = *(const bf16x8*)(Sp + 32 * 128 + 16 * kk); }
#pragma unroll
            for (int kk = 0; kk < 8; ++kk) { y[0] = MFMA32(s0[kk], cfr[kk], y[0]); y[1] = MFMA32(s1[kk], cfr[kk], y[1]); }
        }
        { const float el = __expf(acl);
#pragma unroll
          for (int r = 0; r < 16; ++r) { y[0][r] *= el; y[1][r] *= el; } }
#pragma unroll 1
        for (int st = 0; st <= lt; ++st) {
            bf16x8 bfr[8]; u32x2 xf[2][2][2];
#pragma unroll
            for (int kk = 0; kk < 8; ++kk) bfr[kk] = *(const bf16x8*)(Bp + (size_t)st * 32 * 1024 + 16 * kk);
#pragma unroll
            for (int pt = 0; pt < 2; ++pt)
#pragma unroll
                for (int ks = 0; ks < 2; ++ks) { const bf16_t* xp = Xp + (size_t)pt * 32 * SEQ + st * 32 + 16 * ks; xf[pt][ks][0] = *(const u32x2*)xp; xf[pt][ks][1] = *(const u32x2*)(xp + 8); }
            f32x16 cbt;
#pragma unroll
            for (int r = 0; r < 16; ++r) cbt[r] = 0.f;
#pragma unroll
            for (int kk = 0; kk < 8; ++kk) cbt = MFMA32(bfr[kk], cfr[kk], cbt);
#pragma unroll
            for (int r = 0; r < 16; ++r) { const int sl = 32 * st + crow(r, hi); const float acs = tab[sl], dts = tab[128 + sl];
                float v = cbt[r] * __expf(acl - acs) * dts; if (st == lt && crow(r, hi) > l31) v = 0.f; cbt[r] = v; }
            bf16x8 pf[2];
#pragma unroll
            for (int ks = 0; ks < 2; ++ks) pf[ks] = pack8(cbt[8 * ks], cbt[8 * ks + 1], cbt[8 * ks + 2], cbt[8 * ks + 3], cbt[8 * ks + 4], cbt[8 * ks + 5], cbt[8 * ks + 6], cbt[8 * ks + 7]);
#pragma unroll
            for (int pt = 0; pt < 2; ++pt)
#pragma unroll
                for (int ks = 0; ks < 2; ++ks) { v4u a; a.x = xf[pt][ks][0].x; a.y = xf[pt][ks][0].y; a.z = xf[pt][ks][1].x; a.w = xf[pt][ks][1].y; y[pt] = MFMA32(__builtin_bit_cast(bf16x8, a), pf[ks], y[pt]); }
        }
#pragma unroll
        for (int pt = 0; pt < 2; ++pt) {
#pragma unroll
            for (int r = 0; r < 16; ++r) tr[l31 * 33 + crow(r, hi)] = y[pt][r];
            WSYNC();
            const size_t m = m0 + 32 * lt + row;
            const v4u xa = *(const v4u*)(xbc + m * 1024 + h * 64 + 32 * pt + p0), xb = *(const v4u*)(xbc + m * 1024 + h * 64 + 32 * pt + p0 + 8);
            const unsigned xu[8] = {xa.x, xa.y, xa.z, xa.w, xb.x, xb.y, xb.z, xb.w};
            unsigned ow[8];
#pragma unroll
            for (int q = 0; q < 8; ++q) { const float v0 = tr[row * 33 + p0 + 2 * q] + D * bflo(xu[q]), v1 = tr[row * 33 + p0 + 2 * q + 1] + D * bfhi(xu[q]); ow[q] = cvtpk(v0, v1); }
            bf16_t* dst = yssm + m * 512 + h * 64 + 32 * pt + p0;
            *(v4u*)dst = (v4u){ow[0], ow[1], ow[2], ow[3]}; *(v4u*)(dst + 8) = (v4u){ow[4], ow[5], ow[6], ow[7]};
            WSYNC();
        }
    }
}

struct Args { const float* in[43]; float* out; unsigned char* ws; };
#define GEMM_PHASE(EPI, Aptr, LDA, Bptr, LDB, NN, KK, ...) do { pg8::Gemm g_{(Aptr), (Bptr), M, (NN), (KK), (LDA), (LDB)}; pg8::StaticOrder S_; S_.init(M, (NN), G, (int)blockIdx.x); \
        pg8::EPI E_{__VA_ARGS__}; pg8::gemm_phase<pg8::EPI, pg8::StaticOrder, true, true>(lds3, g_, S_, E_); } while (0)

__global__ void __launch_bounds__(NWAVES * 64, 2) fwd_mega(Args args) {
    extern __shared__ __attribute__((aligned(16))) unsigned char lds[];
    LAS unsigned char* lds3 = (LAS unsigned char*)lds;
    volatile LAS unsigned* MISC = (volatile LAS unsigned*)(lds3 + MISC_OFF);
    const int G = gridDim.x, NGW = G * NWAVES, NT = G * NWAVES * 64;
#define PHASE_IDS() int tid = threadIdx.x; asm volatile("" : "+v"(tid)); const int lane = tid & 63, wave = __builtin_amdgcn_readfirstlane(tid >> 6); const int gw = blockIdx.x * NWAVES + wave, gtid = blockIdx.x * (NWAVES * 64) + tid; (void)lane; (void)gw; (void)gtid
    unsigned char* ws = args.ws;
    gu32* ctl = (gu32*)(ws + WS_CTL);
    for (int u = threadIdx.x; u < (LDS_BYTES - LDSCTL_OFF) / 4; u += NWAVES * 64) ((LAS unsigned*)(lds3 + LDSCTL_OFF))[u] = 0u;
    __syncthreads();
    XcdBarrier bar = xcd_barrier_post((unsigned*)(ctl + CW_BAR), MISC + 8);
#if defined(PROBE_STAMPS)
    int nb_ = 0;
    if (blockIdx.x == 0 && threadIdx.x == 0) MISC[16] = (unsigned)__builtin_amdgcn_s_memrealtime();
#define GRID_BAR() do { xcd_barrier(bar); ++nb_; if (blockIdx.x == 0 && threadIdx.x == 0) MISC[16 + nb_] = (unsigned)__builtin_amdgcn_s_memrealtime(); } while (0)
#else
#define GRID_BAR() xcd_barrier(bar)
#endif
#define IN(i) (args.in[i])
    float* out = args.out;
    bf16_t* W0in = (bf16_t*)(ws + WS_W0IN); bf16_t* W0out = (bf16_t*)(ws + WS_W0OUT); bf16_t* Wup0 = (bf16_t*)(ws + WS_WUP0); bf16_t* Wdn0 = (bf16_t*)(ws + WS_WDN0);
    bf16_t* W1in = (bf16_t*)(ws + WS_W1IN); bf16_t* Wuq = (bf16_t*)(ws + WS_WUQ); bf16_t* Wukv = (bf16_t*)(ws + WS_WUKV); bf16_t* W1out = (bf16_t*)(ws + WS_W1OUT);
    bf16_t* Wup1 = (bf16_t*)(ws + WS_WUP1); bf16_t* Wdn1 = (bf16_t*)(ws + WS_WDN1);
    bf16_t* XB = (bf16_t*)(ws + WS_XB); bf16_t* YMIX = (bf16_t*)(ws + WS_YMIX); bf16_t* PROJ0 = (bf16_t*)(ws + WS_BIG);
    float* YRAW = out; bf16_t* YSSM = (bf16_t*)(out + (size_t)M * 512); bf16_t* STB = (bf16_t*)(out + (size_t)M * 768); bf16_t* XST = (bf16_t*)(ws + WS_XST); bf16_t* BT = (bf16_t*)(ws + WS_BT); float* ASUM = (float*)(ws + WS_ASUM); float* SLOC = (float*)(ws + WS_SLOC); float* DT = (float*)(ws + WS_DT); bf16_t* GB = (bf16_t*)(ws + WS_G); float* BONUS = (float*)(ws + WS_BONUS);
    bf16_t* W2T = (bf16_t*)(ws + WS_W2T); bf16_t* A2T = (bf16_t*)(ws + WS_A2T); bf16_t* G2T = (bf16_t*)(ws + WS_G2T); bf16_t* ACT = (bf16_t*)(ws + WS_GU); bf16_t* HALO = (bf16_t*)(ws + WS_GU + 176 * MiB);
    bf16_t* PROJ1 = (bf16_t*)(ws + WS_PROJ1); bf16_t* QM = (bf16_t*)(ws + WS_QM); bf16_t* KVM = (bf16_t*)(ws + WS_KVM); bf16_t* KPE = (bf16_t*)(ws + WS_KPE); float* RS = (float*)(ws + WS_RS); float* CSTAB = (float*)(ws + WS_CSTAB); float* STATS = (float*)(ws + WS_CSTAB + 4 * MiB); bf16_t* VTS = (bf16_t*)(ws + WS_VTS); bf16_t* VTM = (bf16_t*)(ws + WS_VTM);
    const int* pos = (const int*)args.in[1];

    {
        PHASE_IDS();
    {
        LAS float* scr = (LAS float*)(lds3 + wave * 16384); int trb = 0;
        transpose_matrix(IN(2), 1024, 3336, W0in, L0P, 1024, scr, gw, NGW, lane, nullptr, trb);
        transpose_matrix(IN(20), 1024, 1024, W0out, 1024, 1024, scr, gw, NGW, lane, nullptr, trb);
        transpose_matrix(IN(23), 1024, 5632, Wup0, 5632, 1024, scr, gw, NGW, lane, nullptr, trb, true);
        transpose_matrix(IN(26), 2816, 1024, Wdn0, 1024, 2816, scr, gw, NGW, lane, nullptr, trb);
        transpose_matrix(IN(29), 1024, 1952, W1in, L1P, 1024, scr, gw, NGW, lane, nullptr, trb);
        transpose_matrix(IN(31), 256, 768, Wuq, 768, 256, scr, gw, NGW, lane, IN(30), trb);
        transpose_matrix(IN(33), 128, 1024, Wukv, 1024, 256, scr, gw, NGW, lane, IN(32), trb);
        for (int i = gtid; i < 1024 * 16; i += NT) { const int n = i >> 4, c = i & 15; *(v4u*)(Wukv + (size_t)n * 256 + 128 + c * 8) = (v4u){0u, 0u, 0u, 0u}; }
        transpose_matrix(IN(34), 1024, 1024, W1out, 1024, 1024, scr, gw, NGW, lane, nullptr, trb);
        transpose_matrix(IN(37), 1024, 5632, Wup1, 5632, 1024, scr, gw, NGW, lane, nullptr, trb, true);
        transpose_matrix(IN(40), 2816, 1024, Wdn1, 1024, 2816, scr, gw, NGW, lane, nullptr, trb);
        transpose_matrix(IN(5), 64, 512, W2T, 512, 64, scr, gw, NGW, lane, nullptr, trb);
        transpose_matrix(IN(7), 64, 512, A2T, 512, 64, scr, gw, NGW, lane, nullptr, trb);
        transpose_matrix(IN(8), 128, 512, G2T, 512, 128, scr, gw, NGW, lane, nullptr, trb);
        const float* x = IN(0);
        {
            constexpr size_t TOT4 = (size_t)M * DM / 4;
            for (size_t i = gtid; i < TOT4; i += (size_t)NT * 8) {
                f32x4 v[8];
#pragma unroll
                for (int u = 0; u < 8; ++u) v[u] = *(const f32x4*)(x + (i + (size_t)u * NT) * 4);
#pragma unroll
                for (int u = 0; u < 8; ++u) { uint2 w; w.x = cvtpk(v[u][0], v[u][1]); w.y = cvtpk(v[u][2], v[u][3]); *(uint2*)(XB + (i + (size_t)u * NT) * 4) = w; }
            }
        }
    }
    }
    GRID_BAR();
    {
        PHASE_IDS();
    GEMM_PHASE(EpiBf16S, XB, DM, W0in, 1024, L0P, 1024, PROJ0, nullptr, L0P, 0);
    }
    GRID_BAR();
    {
        PHASE_IDS();
        const int blk = (int)blockIdx.x, m0 = blk * 128;
        {   LAS bf16_t* scr = (LAS bf16_t*)(lds3 + wave * 16384);
#pragma unroll 1
            for (int k = 0; k < 4; ++k) ssd_conv_tile((2 * blk + (k & 1)) * 16 + wave + 8 * (k >> 1), lane, scr, PROJ0, IN(14), IN(15), XB, XST, BT);
            for (int i = tid; i < 1024; i += NWAVES * 64) { const int m = m0 + (i >> 3); DT[(size_t)m * 8 + (i & 7)] = softplusf_(bf2f(PROJ0[(size_t)m * L0P + 3328 + (i & 7)]) + IN(16)[i & 7]); }
        }
        __syncthreads();
#if defined(PROBE_STAMPS)
        if (blockIdx.x == 0 && threadIdx.x == 0) MISC[16 + 29] = (unsigned)__builtin_amdgcn_s_memrealtime();
#endif
        ssd_s1_unit(blk * 8 + wave, lane, (LAS float*)(lds3 + wave * 16384), XST, BT, DT, IN(17), SLOC, ASUM);
    }
    GRID_BAR();
    {
        PHASE_IDS();
        ssd_s2_all(SLOC, ASUM, STB, gtid, NT);
#if defined(PROBE_STAMPS)
        __syncthreads(); if (blockIdx.x == 0 && threadIdx.x == 0) MISC[16 + 23] = (unsigned)__builtin_amdgcn_s_memrealtime();
#endif
        rwkv_phase((LAS float*)lds3, tid, lane, wave, (int)blockIdx.x, PROJ0, IN(3), IN(4), IN(6), IN(9), IN(10), IN(11), W2T, A2T, G2T, YRAW, GB, BONUS);
    }
    GRID_BAR();
    {
        PHASE_IDS();
        const int blk = (int)blockIdx.x;
        ssd_s3_unit(blk * 8 + wave, lane, (LAS float*)(lds3 + wave * 16384), XB, XST, STB, DT, IN(17), IN(18), YSSM);
        __syncthreads();
        ssm_gate_norm_all(YSSM, PROJ0, IN(19), YMIX, blk * 256 + wave, blk * 256 + 256, lane);
        rwkv_post_all(YRAW, PROJ0, IN(3), BONUS, GB, IN(12), IN(13), YMIX, gw, NGW, lane);
    }
    GRID_BAR();
    {
        PHASE_IDS();
    GEMM_PHASE(EpiResid, YMIX, DM, W0out, 1024, 1024, 1024, IN(0), out, ALPHA, 0);
    }
    GRID_BAR();
    {
        PHASE_IDS();
    ln_rows<1>(out, XB, STATS, IN(21), IN(22), gw, NGW, lane);
    }
    GRID_BAR();
    {
        PHASE_IDS();
        { pg8::Gemm g_{XB, Wup0, M / 32, DFF, 1024, DM, 1024, 4096, 8192, 256, 512, 1}; pg8::StaticOrder S_; S_.init(M / 32, DFF, G, (int)blockIdx.x);
          pg8::EpiBf16S E_{HALO, nullptr, DFF, 0}; pg8::gemm_phase<pg8::EpiBf16S, pg8::StaticOrder, true, true>(lds3, g_, S_, E_); }
    }
    GRID_BAR();
    {
        PHASE_IDS();
        { pg8::Gemm g_{XB, Wup0, M, 2 * DFF, 1024, DM, 1024}; pg8::StaticOrder S_; S_.init(M, 2 * DFF, G, (int)blockIdx.x);
          pg8::EpiConvAct E_{ACT, HALO, IN(24), IN(25), DFF, SEQ}; pg8::gemm_phase<pg8::EpiConvAct, pg8::StaticOrder, true, true>(lds3, g_, S_, E_); }
    }
    GRID_BAR();
    {
        PHASE_IDS();
    GEMM_PHASE(EpiResidLN, ACT, DFF, Wdn0, DFF, 1024, DFF, out, STATS, IN(21), IN(22), ALPHA, 0);
    }
    GRID_BAR();
    {
        PHASE_IDS();
    ln_rows<1>(out, XB, STATS, IN(27), IN(28), gw, NGW, lane);
    }
    GRID_BAR();
    {
        PHASE_IDS();
    GEMM_PHASE(EpiBf16S, XB, DM, W1in, 1024, L1P, 1024, PROJ1, nullptr, L1P, 0);
    }
    GRID_BAR();
    {
        PHASE_IDS();
    mla_prep_all(PROJ1, pos, RS, KPE, CSTAB, gw, NGW, lane);
    }
    GRID_BAR();
    {
        PHASE_IDS();
    GEMM_PHASE(EpiBf16S, PROJ1 + 1536, L1P, Wuq, 256, 768, 256, QM, RS, 768, 2);
    GEMM_PHASE(EpiBf16S, PROJ1 + 1792, L1P, Wukv, 256, 1024, 256, KVM, RS + 1, 1024, 2);
    }
    GRID_BAR();
    {
        PHASE_IDS();
    rope_q_all(QM, CSTAB, gtid, NT);
    {
        LAS bf16_t* scr = (LAS bf16_t*)(lds3 + wave * 16384);
        for (int it = gw; it < 8192; it += NGW) { const int which = it >> 12, r = it & 4095, bh = r >> 5, tt = r & 31, b = bh >> 3, h = bh & 7;
            if (which == 0) transpose_tile64(PROJ1 + ((size_t)b * SEQ + tt * 64) * L1P + 1024 + h * 64, L1P, VTS + (size_t)bh * 64 * SEQ + tt * 64, SEQ, scr, lane);
            else            transpose_tile64(KVM + ((size_t)b * SEQ + tt * 64) * 1024 + h * 128 + 64, 1024, VTM + (size_t)bh * 64 * SEQ + tt * 64, SEQ, scr, lane); }
    }
    }
    GRID_BAR();
    {
        PHASE_IDS();
    {
        for (int g2 = (int)blockIdx.x; g2 < 256; g2 += G) { const int bh = g2 >> 1, part = g2 & 1;
#pragma unroll 1
            for (int i = 0; i < 4; ++i) { const int sbk = part ? ((i == 0) ? 1 : (i == 1) ? 6 : (i == 2) ? 2 : 5) : ((i == 0) ? 0 : (i == 1) ? 7 : (i == 2) ? 3 : 4);
                sb_block(bh, sbk, tid, lane, wave, lds3, PROJ1, VTS, YMIX); } }
        for (int g2 = (int)blockIdx.x; g2 < 256; g2 += G) { const int bh = g2 >> 1, part = g2 & 1;
#pragma unroll 1
            for (int i = 0; i < 4; ++i) { const int sbk = part ? ((i == 0) ? 1 : (i == 1) ? 6 : (i == 2) ? 2 : 5) : ((i == 0) ? 0 : (i == 1) ? 7 : (i == 2) ? 3 : 4);
                mla_block(bh, sbk, tid, lane, wave, lds3, QM, KVM, KPE, VTM, YMIX); } }
    }
    }
    GRID_BAR();
    {
        PHASE_IDS();
    GEMM_PHASE(EpiResidLN, YMIX, DM, W1out, 1024, 1024, 1024, out, STATS, IN(27), IN(28), ALPHA, 0);
    }
    GRID_BAR();
    {
        PHASE_IDS();
    ln_rows<1>(out, XB, STATS, IN(35), IN(36), gw, NGW, lane);
    }
    GRID_BAR();
    {
        PHASE_IDS();
        { pg8::Gemm g_{XB, Wup1, M / 32, DFF, 1024, DM, 1024, 4096, 8192, 256, 512, 1}; pg8::StaticOrder S_; S_.init(M / 32, DFF, G, (int)blockIdx.x);
          pg8::EpiBf16S E_{HALO, nullptr, DFF, 0}; pg8::gemm_phase<pg8::EpiBf16S, pg8::StaticOrder, true, true>(lds3, g_, S_, E_); }
    }
    GRID_BAR();
    {
        PHASE_IDS();
        { pg8::Gemm g_{XB, Wup1, M, 2 * DFF, 1024, DM, 1024}; pg8::StaticOrder S_; S_.init(M, 2 * DFF, G, (int)blockIdx.x);
          pg8::EpiConvAct E_{ACT, HALO, IN(38), IN(39), DFF, SEQ}; pg8::gemm_phase<pg8::EpiConvAct, pg8::StaticOrder, true, true>(lds3, g_, S_, E_); }
    }
    GRID_BAR();
    {
        PHASE_IDS();
    GEMM_PHASE(EpiResidLN, ACT, DFF, Wdn1, DFF, 1024, DFF, out, STATS, IN(35), IN(36), ALPHA, 0);
    }
    GRID_BAR();
    {
        PHASE_IDS();
    ln_rows<2>(out, XB, STATS, IN(41), IN(42), gw, NGW, lane);
    #if defined(PROBE_STAMPS)
    __syncthreads();
    if (blockIdx.x == 0 && threadIdx.x == 0) {
        MISC[16 + 22] = (unsigned)__builtin_amdgcn_s_memrealtime();
#if defined(PROBE_ACC)
        const unsigned d1 = MISC[16 + PROBE_ACC];
#else
        const unsigned d1 = MISC[16 + PROBE_T1_HI] - MISC[16 + PROBE_T1_LO];
#endif
        const unsigned long long spin = 100ull * d1;
        const unsigned long long t0 = __builtin_amdgcn_s_memrealtime();
        while (__builtin_amdgcn_s_memrealtime() - t0 < spin) __builtin_amdgcn_s_sleep(8);
    }
#endif
}
}

extern "C" void kernel_launch(void* const* d_in, const int* in_sizes, int n_in, void* d_out, int out_size, void* d_ws, size_t ws_size, hipStream_t stream) {
    static int grid = 0;
    if (grid == 0) {
        if (n_in != 43 || ws_size < WS_NEED || out_size != M * DM) { fprintf(stderr, "kernel_launch: unexpected n_in %d / ws %zu / out %d\n", n_in, ws_size, out_size); grid = -1; return; }
        int dev = 0, cus = 0, per_cu = 0;
        if (hipGetDevice(&dev) != hipSuccess || hipDeviceGetAttribute(&cus, hipDeviceAttributeMultiprocessorCount, dev) != hipSuccess) { grid = -1; return; }
        if (hipFuncSetAttribute((const void*)fwd_mega, hipFuncAttributeMaxDynamicSharedMemorySize, LDS_BYTES) != hipSuccess) { fprintf(stderr, "kernel_launch: hipFuncSetAttribute failed\n"); grid = -1; return; }
        if (hipOccupancyMaxActiveBlocksPerMultiprocessor(&per_cu, (const void*)fwd_mega, NWAVES * 64, LDS_BYTES) != hipSuccess || per_cu < 1) fprintf(stderr, "kernel_launch: occupancy query reports %d\n", per_cu);
        (void)hipGetLastError();
        grid = cus;
    }
    if (grid < 0) return;
    (void)hipMemsetAsync((char*)d_ws + WS_CTL, 0, CTL_ZERO_BYTES, stream);
    Args a{};
    for (int i = 0; i < 43; ++i) a.in[i] = (const float*)d_in[i];
    a.out = (float*)d_out; a.ws = (unsigned char*)d_ws;
    hipLaunchKernelGGL(fwd_mega, dim3(grid), dim3(NWAVES * 64), LDS_BYTES, stream, a);
}
```

```cpp
#include <hip/hip_runtime.h>
#include <cstdio>
#include <cstdint>
#include <cmath>
namespace pg8 {
#define PG8_LAS __attribute__((address_space(3)))
typedef unsigned short bf16_t;
typedef short bf16x8 __attribute__((ext_vector_type(8)));
typedef float f32x4 __attribute__((ext_vector_type(4)));
typedef unsigned u32x4 __attribute__((ext_vector_type(4)));
constexpr int BM = 256, BK = 64, HALF = 128, HTB = HALF * BK * 2  , STAGE_BYTES = 8 * HTB, NXCD = 8, WGM = 8;

__host__ __device__ __forceinline__ int lds_byte(int r, int c) { const int st = (r >> 4) * 2 + (c >> 5), rr = r & 15, cc = c & 31, ob = rr * 64 + cc * 2; return st * 1024 + (ob ^ (((ob >> 9) & 1) << 5)); }
__host__ __device__ __forceinline__ void stage_rc(int b, int& R, int& C) { const int st = b / 1024, sb = b % 1024, swz = sb ^ (((sb >> 9) & 1) << 5); R = (st >> 1) * 16 + swz / 64; C = (st & 1) * 32 + (swz % 64) / 2; }
__host__ __device__ __forceinline__ int perm32(int rho) { const int n = rho >> 4, i = rho & 15; return 8 * (i >> 2) + 4 * n + (i & 3); }

struct Unit { int pm, pn; };
struct Gemm { const bf16_t* A; const bf16_t* Bt; int M, N, K, lda, ldb; int hrA = 128, trA = 256, hrB = 128, trB = 256, gatherA = 0; };

struct StaticOrder {
    int nM, nN, nwg, G, c;
    __host__ __device__ void init(int M, int N, int G_, int c_) { nM = M / BM; nN = N / BM; nwg = nM * nN; G = G_; c = c_; }
    __host__ __device__ bool next(int i, Unit& u) const {
        const long L = (long)i * G + c; if (L >= nwg) return false;
        int wgid = (int)L; { const int q = nwg / NXCD, r = nwg % NXCD, xcd = wgid % NXCD, off = wgid / NXCD; wgid = (xcd < r ? xcd * (q + 1) : r * (q + 1) + (xcd - r) * q) + off; }
        const int nig = WGM * nN, gid = wgid / nig, fm = gid * WGM, gsz = (nM - fm) < WGM ? (nM - fm) : WGM;
        u.pm = fm + ((wgid % nig) % gsz); u.pn = (wgid % nig) / gsz; return true;
    }
    __device__ __forceinline__ void a_ready(const Unit&) const {}
    __device__ __forceinline__ void done(const Unit&) const {}
};


__device__ __forceinline__ unsigned cvt_pk_bf16(float lo, float hi) { unsigned r; asm volatile("v_cvt_pk_bf16_f32 %0, %1, %2" : "=v"(r) : "v"(lo), "v"(hi)); return r; }
struct EpiBf16S {
    static constexpr bool PERM = true, AFTER_DRAIN = false;
    bf16_t* O; const float* rowscale; int ldc; int rs_stride;
    __device__ __forceinline__ void operator()(const f32x4 (&acc)[2][2][4][2], const Unit& u, int wr, int wc, int fr, int fq) const {
        const int row0 = u.pm * BM + wr * 64 + fr, col0 = u.pn * BM + wc * 32 + 8 * fq;
#pragma unroll
        for (int ai = 0; ai < 2; ++ai)
#pragma unroll
            for (int m = 0; m < 4; ++m) { const int row = row0 + ai * HALF + m * 16; const float sc = rowscale ? rowscale[(size_t)row * rs_stride] : 1.f;
                bf16_t* rowp = O + (size_t)row * ldc + col0;
#pragma unroll
                for (int bj = 0; bj < 2; ++bj) { const f32x4 v0 = acc[ai][bj][m][0] * sc, v1 = acc[ai][bj][m][1] * sc;
                    u32x4 w; w.x = cvt_pk_bf16(v0[0], v0[1]); w.y = cvt_pk_bf16(v0[2], v0[3]); w.z = cvt_pk_bf16(v1[0], v1[1]); w.w = cvt_pk_bf16(v1[2], v1[3]);
                    *(u32x4*)(rowp + bj * HALF) = w; } }
    }
};
struct EpiResid {
    static constexpr bool PERM = false, AFTER_DRAIN = false;
    const float* hin; float* hout; float alpha; int pad;
    __device__ __forceinline__ void operator()(const f32x4 (&acc)[2][2][4][2], const Unit& u, int wr, int wc, int fr, int fq) const {
        const int row0 = u.pm * BM + wr * 64 + fr, col0 = u.pn * BM + wc * 32 + 4 * fq;
#pragma unroll
        for (int ai = 0; ai < 2; ++ai)
#pragma unroll
            for (int m = 0; m < 4; ++m) { const size_t off = (size_t)(row0 + ai * HALF + m * 16) * 1024 + col0;
#pragma unroll
                for (int bj = 0; bj < 2; ++bj)
#pragma unroll
                    for (int n = 0; n < 2; ++n) { const size_t i = off + bj * HALF + n * 16; const f32x4 h = *(const f32x4*)(hin + i); *(f32x4*)(hout + i) = h * alpha + acc[ai][bj][m][n]; } }
    }
};

struct EpiResidLN {
    static constexpr bool PERM = false, AFTER_DRAIN = false;
    float* hio; const float* stats; const float* g; const float* b; float alpha; int pad;
    __device__ __forceinline__ void operator()(const f32x4 (&acc)[2][2][4][2], const Unit& u, int wr, int wc, int fr, int fq) const {
        const int row0 = u.pm * BM + wr * 64 + fr, col0 = u.pn * BM + wc * 32 + 4 * fq;
        f32x4 gg[2][2], bb[2][2];
#pragma unroll
        for (int bj = 0; bj < 2; ++bj)
#pragma unroll
            for (int n = 0; n < 2; ++n) { gg[bj][n] = *(const f32x4*)(g + col0 + bj * HALF + n * 16) * alpha; bb[bj][n] = *(const f32x4*)(b + col0 + bj * HALF + n * 16) * alpha; }
#pragma unroll
        for (int ai = 0; ai < 2; ++ai)
#pragma unroll
            for (int m = 0; m < 4; ++m) { const int row = row0 + ai * HALF + m * 16; const size_t off = (size_t)row * 1024 + col0;
                const float mu = stats[2 * row], rs = stats[2 * row + 1];
#pragma unroll
                for (int bj = 0; bj < 2; ++bj)
#pragma unroll
                    for (int n = 0; n < 2; ++n) { const size_t i = off + bj * HALF + n * 16; const f32x4 p = *(const f32x4*)(hio + i); *(f32x4*)(hio + i) = (p - mu) * rs * gg[bj][n] + bb[bj][n] + acc[ai][bj][m][n]; } }
    }
};

template <int CTRL> __device__ __forceinline__ float pg_dpp(float x) { return __builtin_bit_cast(float, __builtin_amdgcn_update_dpp(0, __builtin_bit_cast(int, x), CTRL, 0xF, 0xF, true)); }
struct EpiConvAct {
    static constexpr bool PERM = true, AFTER_DRAIN = false;
    bf16_t* act; const bf16_t* halo; const float* cw; const float* cb; int dff; int seq;
    __device__ __forceinline__ void operator()(const f32x4 (&acc)[2][2][4][2], const Unit& u, int wr, int wc, int fr, int fq) const {
        typedef unsigned u32x2e __attribute__((ext_vector_type(2)));
#pragma unroll
        for (int n = 0; n < 2; ++n) {
            const int ch0 = u.pn * 128 + wc * 32 + 8 * fq + 4 * n;
            const f32x4 w0 = *(const f32x4*)(cw + ch0), w1 = *(const f32x4*)(cw + dff + ch0), w2 = *(const f32x4*)(cw + 2 * dff + ch0), bb = *(const f32x4*)(cb + ch0);
#pragma unroll
            for (int ai = 0; ai < 2; ++ai) {
                const int rb64 = u.pm * BM + ai * HALF + wr * 64;
                f32x4 P = {0.f, 0.f, 0.f, 0.f};
                if ((rb64 & (seq - 1)) != 0 && fr >= 14) { const u32x2e hv = *(const u32x2e*)(halo + (size_t)(2 * (rb64 / 64 - 1) + (fr - 14)) * dff + ch0);
                    P[0] = __builtin_bit_cast(float, hv.x << 16); P[1] = __builtin_bit_cast(float, hv.x & 0xffff0000u); P[2] = __builtin_bit_cast(float, hv.y << 16); P[3] = __builtin_bit_cast(float, hv.y & 0xffff0000u); }
#pragma unroll
                for (int m = 0; m < 4; ++m) {
                    const f32x4 Gv = acc[ai][0][m][n], Uv = acc[ai][1][m][n];
                    float o[4];
#pragma unroll
                    for (int e = 0; e < 4; ++e) {
                        const float t1 = pg_dpp<0x111>(Gv[e]), t2 = pg_dpp<0x112>(Gv[e]), p1 = pg_dpp<0x10F>(P[e]), p2 = pg_dpp<0x10E>(P[e]);
                        const float g1 = (fr >= 1) ? t1 : p1, g2 = (fr >= 2) ? t2 : p2;
                        const float y = bb[e] + w0[e] * g2 + w1[e] * g1 + w2[e] * Gv[e];
                        o[e] = y * __builtin_amdgcn_rcpf(1.f + __builtin_amdgcn_exp2f(-1.4426950408889634f * y)) * Uv[e];
                    }
                    u32x2e w; w.x = cvt_pk_bf16(o[0], o[1]); w.y = cvt_pk_bf16(o[2], o[3]);
                    *(u32x2e*)(act + (size_t)(rb64 + m * 16 + fr) * dff + ch0) = w;
                    P = Gv;
                }
            }
        }
    }
};

template <class Epi, class Sched, bool ALIGN_EPI = false, bool SP2 = false>
__device__ __forceinline__ void gemm_phase(PG8_LAS unsigned char* lds, const Gemm g, const Sched& S, const Epi& E) {
    int tid = threadIdx.x; asm volatile("" : "+v"(tid));
    const int wid = __builtin_amdgcn_readfirstlane(tid >> 6), lane = tid & 63, wr = wid >> 2, wc = wid & 3, fr = lane & 15, fq = lane >> 4;
    const int K = g.K, nt = K / BK;
    unsigned voffA[2], voffB[2];
#pragma unroll
    for (int i = 0; i < 2; ++i) { int R, C; stage_rc(tid * 16 + i * 8192, R, C); const int Rb = Epi::PERM ? ((R & ~31) + perm32(R & 31)) : R;
        const int Ra = g.gatherA ? (64 * (R >> 1) + 62 + (R & 1)) : R;
        voffA[i] = (unsigned)(Ra * g.lda + C) * 2u; voffB[i] = (unsigned)(Rb * g.ldb + C) * 2u; }
    const size_t kstep = (size_t)(BK * 2);
    const size_t hstepA = (size_t)g.hrA * g.lda * 2, hstepB = (size_t)g.hrB * g.ldb * 2;
    const size_t tstepA = (size_t)g.trA * g.lda * 2, tstepB = (size_t)g.trB * g.ldb * 2;
    const unsigned ldsw = (unsigned)wid * 1024u;
    const int aoff = lds_byte(wr * 64 + fr, fq * 8), boff = lds_byte(wc * 32 + fr, fq * 8);
#define PG8_SA(b, h) (((b) * 2 + (h)) * HTB)
#define PG8_SB(b, h) ((4 + (b) * 2 + (h)) * HTB)
#define PG8_STAGE(bufoff, gbase, voff) do { _Pragma("unroll") for (int _i = 0; _i < 2; ++_i) \
        __builtin_amdgcn_global_load_lds((const unsigned*)((const char*)(gbase) + (voff)[_i]), (PG8_LAS unsigned*)(lds + (bufoff) + ldsw + _i * 8192), 16, 0, 0); } while (0)
#define PG8_LDA(dst, b, h) do { _Pragma("unroll") for (int m = 0; m < 4; ++m) _Pragma("unroll") for (int k = 0; k < 2; ++k) dst[m][k] = *(const PG8_LAS bf16x8*)(lds + PG8_SA(b, h) + aoff + m * 2048 + k * 1024); } while (0)
#define PG8_LDB(dst, b, h) do { _Pragma("unroll") for (int n = 0; n < 2; ++n) _Pragma("unroll") for (int k = 0; k < 2; ++k) dst[n][k] = *(const PG8_LAS bf16x8*)(lds + PG8_SB(b, h) + boff + n * 2048 + k * 1024); } while (0)
#define PG8_MMA(ai, bj, At, Bt) do { __builtin_amdgcn_s_setprio(1); _Pragma("unroll") for (int m = 0; m < 4; ++m) _Pragma("unroll") for (int n = 0; n < 2; ++n) _Pragma("unroll") for (int k = 0; k < 2; ++k) \
        acc[ai][bj][m][n] = __builtin_amdgcn_mfma_f32_16x16x32_bf16(Bt[n][k], At[m][k], acc[ai][bj][m][n], 0, 0, 0); __builtin_amdgcn_s_setprio(0); } while (0)
#define PG8_WAIT_V(n) asm volatile("s_waitcnt vmcnt(" #n ")" ::: "memory")
#define PG8_WAIT_L(n) asm volatile("s_waitcnt lgkmcnt(" #n ")" ::: "memory")
#define PG8_BAR __builtin_amdgcn_s_barrier()
#define PG8_SCHED __builtin_amdgcn_sched_barrier(0)
    Unit cur, nxt; int ui = 0;
    if (!S.next(0, cur)) return;
    f32x4 acc[2][2][4][2];
#pragma unroll
    for (int a = 0; a < 2; ++a)
#pragma unroll
        for (int b = 0; b < 2; ++b)
#pragma unroll
            for (int m = 0; m < 4; ++m)
#pragma unroll
                for (int n = 0; n < 2; ++n) acc[a][b][m][n] = (f32x4){0.f, 0.f, 0.f, 0.f};
    bf16x8 At[4][2], B0[2][2], B1[2][2];
    const char* cA = (const char*)g.A + (size_t)cur.pm * tstepA; const char* cB = (const char*)g.Bt + (size_t)cur.pn * tstepB;
    S.a_ready(cur);
    if constexpr (SP2) {
        PG8_STAGE(PG8_SB(0, 0), cB, voffB); PG8_STAGE(PG8_SB(0, 1), cB + hstepB, voffB); PG8_STAGE(PG8_SA(0, 0), cA, voffA); PG8_STAGE(PG8_SA(0, 1), cA + hstepA, voffA);
        if (wr == 1) PG8_BAR;
        PG8_WAIT_V(2); PG8_BAR;
        PG8_STAGE(PG8_SB(1, 0), cB + kstep, voffB); PG8_STAGE(PG8_SA(1, 0), cA + kstep, voffA); PG8_STAGE(PG8_SB(1, 1), cB + hstepB + kstep, voffB);
        PG8_WAIT_V(6); PG8_BAR;
    } else {
        PG8_STAGE(PG8_SB(0, 0), cB, voffB); PG8_STAGE(PG8_SA(0, 0), cA, voffA); PG8_STAGE(PG8_SB(0, 1), cB + hstepB, voffB); PG8_STAGE(PG8_SA(0, 1), cA + hstepA, voffA);
        if (wr == 1) PG8_BAR;
        PG8_WAIT_V(4); PG8_BAR;
        PG8_STAGE(PG8_SB(1, 0), cB + kstep, voffB); PG8_STAGE(PG8_SA(1, 0), cA + kstep, voffA); PG8_STAGE(PG8_SB(1, 1), cB + hstepB + kstep, voffB);
        PG8_WAIT_V(6); PG8_BAR;
    }
    for (;;) {
        const bool has_next = S.next(ui + 1, nxt);
        const char* nA = has_next ? (const char*)g.A + (size_t)nxt.pm * tstepA : cA; const char* nB = has_next ? (const char*)g.Bt + (size_t)nxt.pn * tstepB : cB;
        for (int t = 0; t < nt; t += 2) {
            const bool last = (t == nt - 2);
            const char* a1 = cA + (size_t)(t + 1) * kstep;
            const char* a2 = last ? nA : cA + (size_t)(t + 2) * kstep; const char* b2 = last ? nB : cB + (size_t)(t + 2) * kstep;
            const char* a3 = a2 + kstep; const char* b3 = b2 + kstep;
            if (last && has_next) S.a_ready(nxt);
            if constexpr (SP2) {
            PG8_LDB(B0, 0, 0); PG8_LDB(B1, 0, 1); PG8_SCHED; PG8_LDA(At, 0, 0); PG8_STAGE(PG8_SA(1, 1), a1 + hstepA, voffA);
            PG8_WAIT_V(8); PG8_WAIT_L(0); PG8_BAR; PG8_MMA(0, 0, At, B0); PG8_MMA(0, 1, At, B1); PG8_BAR; PG8_SCHED;
            PG8_LDA(At, 0, 1); PG8_STAGE(PG8_SB(0, 0), b2, voffB); PG8_STAGE(PG8_SB(0, 1), b2 + hstepB, voffB); PG8_STAGE(PG8_SA(0, 0), a2, voffA);
            PG8_WAIT_V(8); PG8_WAIT_L(0); PG8_BAR; PG8_MMA(1, 0, At, B0); PG8_MMA(1, 1, At, B1); PG8_BAR; PG8_SCHED;
            PG8_LDB(B0, 1, 0); PG8_LDB(B1, 1, 1); PG8_SCHED; PG8_LDA(At, 1, 0); PG8_STAGE(PG8_SA(0, 1), a2 + hstepA, voffA);
            PG8_WAIT_V(8); PG8_WAIT_L(0); PG8_BAR; PG8_MMA(0, 0, At, B0); PG8_MMA(0, 1, At, B1); PG8_BAR; PG8_SCHED;
            PG8_LDA(At, 1, 1); PG8_STAGE(PG8_SB(1, 0), b3, voffB); PG8_STAGE(PG8_SB(1, 1), b3 + hstepB, voffB); PG8_STAGE(PG8_SA(1, 0), a3, voffA);
            PG8_WAIT_V(8); PG8_WAIT_L(0); PG8_BAR; PG8_MMA(1, 0, At, B0); PG8_MMA(1, 1, At, B1); PG8_BAR; PG8_SCHED;
            } else {
            PG8_LDB(B0, 0, 0); PG8_SCHED; PG8_LDA(At, 0, 0); PG8_STAGE(PG8_SA(1, 1), a1 + hstepA, voffA);
            PG8_WAIT_L(8); PG8_BAR; PG8_WAIT_L(0); PG8_MMA(0, 0, At, B0); PG8_BAR; PG8_SCHED;
            PG8_LDB(B1, 0, 1); PG8_STAGE(PG8_SB(0, 0), b2, voffB);
            PG8_BAR; PG8_WAIT_L(0); PG8_MMA(0, 1, At, B1); PG8_BAR;
            PG8_LDA(At, 0, 1); PG8_STAGE(PG8_SA(0, 0), a2, voffA);
            PG8_BAR; PG8_WAIT_L(0); PG8_MMA(1, 0, At, B0); PG8_BAR; PG8_SCHED;
            PG8_STAGE(PG8_SB(0, 1), b2 + hstepB, voffB);
            PG8_WAIT_V(6); PG8_BAR; PG8_MMA(1, 1, At, B1); PG8_BAR;
            PG8_LDB(B0, 1, 0); PG8_SCHED; PG8_LDA(At, 1, 0); PG8_STAGE(PG8_SA(0, 1), a2 + hstepA, voffA);
            PG8_WAIT_L(8); PG8_BAR; PG8_WAIT_L(0); PG8_MMA(0, 0, At, B0); PG8_BAR; PG8_SCHED;
            PG8_LDB(B1, 1, 1); PG8_STAGE(PG8_SB(1, 0), b3, voffB);
            PG8_BAR; PG8_WAIT_L(0); PG8_MMA(0, 1, At, B1); PG8_BAR;
            PG8_LDA(At, 1, 1); PG8_STAGE(PG8_SA(1, 0), a3, voffA);
            PG8_BAR; PG8_WAIT_L(0); PG8_MMA(1, 0, At, B0); PG8_BAR; PG8_SCHED;
            PG8_STAGE(PG8_SB(1, 1), b3 + hstepB, voffB);
            PG8_WAIT_V(6); PG8_BAR; PG8_MMA(1, 1, At, B1); PG8_BAR;
            }
        }
        if constexpr (ALIGN_EPI) { if (wr == 0) PG8_BAR; }
        if constexpr (!Epi::AFTER_DRAIN) { E(acc, cur, wr, wc, fr, fq); S.done(cur); }
        if (!has_next) break;
#pragma unroll
        for (int a = 0; a < 2; ++a)
#pragma unroll
            for (int b = 0; b < 2; ++b)
#pragma unroll
                for (int m = 0; m < 4; ++m)
#pragma unroll
                    for (int n = 0; n < 2; ++n) acc[a][b][m][n] = (f32x4){0.f, 0.f, 0.f, 0.f};
        cur = nxt; cA = nA; cB = nB; ++ui;
        if constexpr (ALIGN_EPI) { if (wr == 1) PG8_BAR; }
    }
    PG8_WAIT_V(0);
    if constexpr (!ALIGN_EPI) { if (wr == 0) PG8_BAR; }
    PG8_BAR;
    if constexpr (Epi::AFTER_DRAIN) { E.fused(acc, cur, wr, wc, fr, fq, lds, wid, lane); S.done(cur); }
#undef PG8_SA
#undef PG8_SB
#undef PG8_STAGE
#undef PG8_LDA
#undef PG8_LDB
#undef PG8_MMA
#undef PG8_WAIT_V
#undef PG8_WAIT_L
#undef PG8_BAR
#undef PG8_SCHED
}
}
#define GAS __attribute__((address_space(1)))
#define LAS __attribute__((address_space(3)))
typedef unsigned short bf16;
typedef unsigned v4u __attribute__((ext_vector_type(4)));
typedef float f32x4 __attribute__((ext_vector_type(4)));
typedef short bf16x8 __attribute__((ext_vector_type(8)));
typedef GAS unsigned gu32;
typedef GAS unsigned long long gu64;
#define RLX_AGENT __ATOMIC_RELAXED, __HIP_MEMORY_SCOPE_AGENT
#define LDS_WAIT() asm volatile("s_waitcnt lgkmcnt(0)" ::: "memory")
#define VM_WAIT() asm volatile("s_waitcnt vmcnt(0)" ::: "memory")
__device__ __forceinline__ unsigned long long rt() { return __builtin_amdgcn_s_memrealtime(); }
__device__ __forceinline__ unsigned f2bf(float f) { unsigned u = __builtin_bit_cast(unsigned, f); return (u + 0x7fffu + ((u >> 16) & 1u)) >> 16; }
__device__ __forceinline__ unsigned pk2(float lo, float hi) { return f2bf(lo) | (f2bf(hi) << 16); }

#define XB_TMO      128
#define XB_XCNT(j)  (256  + 64 * (j))
#define XB_XSUB(j)  (1280 + 64 * (j))
#define XB_XGEN(j)  (2304 + 64 * (j))
#define XB_TOP      3328
#define XB_TOPGEN   3392
#define XCD_BAR_WORDS 3456
#define XB_SPIN_CAP (1u << 18)

__device__ __forceinline__ unsigned xb_ld(unsigned* p)              { return __hip_atomic_load(p, __ATOMIC_RELAXED, __HIP_MEMORY_SCOPE_AGENT); }
__device__ __forceinline__ unsigned xb_add(unsigned* p, unsigned v) { return __hip_atomic_fetch_add(p, v, __ATOMIC_RELAXED, __HIP_MEMORY_SCOPE_AGENT); }
__device__ __forceinline__ unsigned xb_xcc_id() { return (unsigned)__builtin_amdgcn_s_getreg((3 << 11) | 20) & 0xFu; }
#define XB_SPIN(cond, bar) do { unsigned _sp = 0; while (cond) { __builtin_amdgcn_s_sleep(1); \
    if ((++_sp & 255u) == 0u) { if (xb_ld(&(bar)[XB_TMO])) break; if (_sp > XB_SPIN_CAP) { atomicAdd(&(bar)[XB_TMO], 1u); break; } } } } while (0)

struct XcdBarrier {
    unsigned* bar; unsigned x;
    volatile LAS unsigned* st;
};

__device__ __forceinline__ XcdBarrier xcd_barrier_post(unsigned* bar, volatile LAS unsigned* st) {
    XcdBarrier b; b.bar = bar; b.x = xb_xcc_id(); b.st = st;
    if (threadIdx.x == 0) (void)xb_add(&bar[XB_XCNT(b.x)], 1u);
    return b;
}
__device__ __forceinline__ void xcd_barrier_complete(unsigned* bar, unsigned x, unsigned& nloc, unsigned& nx) {
    const unsigned G = gridDim.x * gridDim.y * gridDim.z;
    unsigned sum, cnt, mine, sp = 0u;
    for (;;) {
        sum = 0u; cnt = 0u; mine = 0u;
#pragma unroll
        for (unsigned j = 0; j < 16; ++j) { const unsigned c = xb_ld(&bar[XB_XCNT(j)]); sum += c; cnt += (c > 0u) ? 1u : 0u; mine = (j == x) ? c : mine; }
        if (sum == G) break;
        __builtin_amdgcn_s_sleep(1);
        if ((++sp & 255u) == 0u) { if (xb_ld(&bar[XB_TMO])) break; if (sp > XB_SPIN_CAP) { atomicAdd(&bar[XB_TMO], 1u); break; } }
    }
    nloc = mine > 0u ? mine : 1u; nx = cnt > 0u ? cnt : 1u;
}

__device__ __forceinline__ void xcd_barrier(const XcdBarrier& b) {
    asm volatile("s_waitcnt vmcnt(0)" ::: "memory");
    __syncthreads();
    if (threadIdx.x == 0) {
        unsigned* bar = b.bar;
        __builtin_amdgcn_s_waitcnt(0);
        unsigned nloc = b.st[0], nx = b.st[1];
        if (nloc == 0u) { xcd_barrier_complete(bar, b.x, nloc, nx); b.st[0] = nloc; b.st[1] = nx; }
        const unsigned old = xb_add(&bar[XB_XSUB(b.x)], 1u);
        const unsigned gen = old / nloc;
        if (old + 1u == (gen + 1u) * nloc) {
            __builtin_amdgcn_fence(__ATOMIC_RELEASE, "agent");
            asm volatile("s_waitcnt vmcnt(0)" ::: "memory");
            const unsigned og = xb_add(&bar[XB_TOP], 1u);
            const unsigned tg = og / nx;
            if (og + 1u == (tg + 1u) * nx) xb_add(&bar[XB_TOPGEN], 1u);
            else XB_SPIN(xb_ld(&bar[XB_TOPGEN]) == tg, bar);
            __builtin_amdgcn_fence(__ATOMIC_ACQUIRE, "agent");
            xb_add(&bar[XB_XGEN(b.x)], 1u);
            asm volatile("s_waitcnt vmcnt(0)" ::: "memory");
        } else {
            XB_SPIN(xb_ld(&bar[XB_XGEN(b.x)]) == gen, bar);
            __builtin_amdgcn_fence(__ATOMIC_ACQUIRE, "agent");
            asm volatile("s_waitcnt vmcnt(0)" ::: "memory");
        }
    }
    __syncthreads();
}
constexpr int NWAVES = 8;
constexpr int BATCH = 16, SEQ = 2048, DM = 1024, M = BATCH * SEQ;
constexpr int L0P = 3584;
constexpr int L1P = 2048;
constexpr int DFF = 2816;
constexpr float ALPHA = 1.4142135623730951f;
typedef unsigned short bf16_t;
typedef float f32x16 __attribute__((ext_vector_type(16)));

constexpr size_t MiB = 1u << 20;
constexpr size_t WS_CTL = 0, CTL_ZERO_BYTES = 1 * MiB;
constexpr int CW_BAR = 4096;
constexpr size_t WS_W0IN = 2 * MiB, WS_W0OUT = 9 * MiB, WS_WUP0 = 11 * MiB, WS_WDN0 = 22 * MiB, WS_W1IN = 28 * MiB, WS_WUQ = 32 * MiB, WS_WUKV = 33 * MiB,
                 WS_W1OUT = 34 * MiB, WS_WUP1 = 36 * MiB, WS_WDN1 = 47 * MiB;
constexpr size_t WS_XB = 56 * MiB, WS_YMIX = 120 * MiB, WS_BIG = 184 * MiB;
constexpr size_t WS_G = 408 * MiB, WS_BONUS = 440 * MiB, WS_DT = 441 * MiB, WS_XST = 442 * MiB, WS_BT = 474 * MiB, WS_ASUM = 490 * MiB;
constexpr size_t WS_SLOC = 120 * MiB;
constexpr size_t WS_W2T = 53 * MiB, WS_A2T = 53 * MiB + 256 * 1024, WS_G2T = 53 * MiB + 512 * 1024;
constexpr size_t WS_GU = 120 * MiB;
constexpr size_t WS_PROJ1 = 184 * MiB, WS_QM = 312 * MiB, WS_KVM = 360 * MiB, WS_KPE = 424 * MiB, WS_RS = 426 * MiB;
constexpr size_t WS_CSTAB = 492 * MiB;
constexpr size_t WS_VTS = 428 * MiB, WS_VTM = 460 * MiB;
constexpr size_t WS_NEED = 497 * MiB;

constexpr int RING_BYTES = 131072;
constexpr int LDSCTL_OFF = 146432, MISC_OFF = LDSCTL_OFF + 320;
constexpr int LDS_BYTES = 147456;

__device__ __forceinline__ float bf2f(bf16_t b) { return __builtin_bit_cast(float, (unsigned)b << 16); }
__device__ __forceinline__ float sigmoidf_(float x) { return 1.f / (1.f + expf(-x)); }
__device__ __forceinline__ float softplusf_(float x) { return fmaxf(x, 0.f) + log1pf(expf(-fabsf(x))); }
__device__ __forceinline__ float siluf_(float x) { return x / (1.f + expf(-x)); }
__device__ __forceinline__ float wave_sum(float v) {
#pragma unroll
    for (int o = 1; o < 64; o <<= 1) v += __shfl_xor(v, o);
    return v;
}
#define WSYNC() asm volatile("s_waitcnt lgkmcnt(0)" ::: "memory")
typedef float f32x2_t __attribute__((ext_vector_type(2)));
typedef __bf16 bf16x2_t __attribute__((ext_vector_type(2)));
typedef unsigned u32x2 __attribute__((ext_vector_type(2)));
__device__ __forceinline__ unsigned cvtpk(float lo, float hi) { f32x2_t v = {lo, hi}; bf16x2_t b = __builtin_convertvector(v, bf16x2_t); return __builtin_bit_cast(unsigned, b); }
__device__ __forceinline__ float bflo(unsigned u) { return __builtin_bit_cast(float, u << 16); }
__device__ __forceinline__ float bfhi(unsigned u) { return __builtin_bit_cast(float, u & 0xffff0000u); }
__device__ __forceinline__ bf16_t bf1(float x) { return (bf16_t)(cvtpk(x, x) & 0xffffu); }
__device__ __forceinline__ bf16x8 pack8(float a0, float a1, float a2, float a3, float a4, float a5, float a6, float a7) {
    v4u w; w.x = cvtpk(a0, a1); w.y = cvtpk(a2, a3); w.z = cvtpk(a4, a5); w.w = cvtpk(a6, a7); return __builtin_bit_cast(bf16x8, w); }
template <int CTRL> __device__ __forceinline__ float dpp_mov(float x) { return __builtin_bit_cast(float, __builtin_amdgcn_update_dpp(0, __builtin_bit_cast(int, x), CTRL, 0xF, 0xF, true)); }
__device__ __forceinline__ float rowsum16(float x) { x += dpp_mov<0x128>(x); x += dpp_mov<0x124>(x); x += dpp_mov<0x122>(x); x += dpp_mov<0x121>(x); return x; }
__device__ __forceinline__ float rl(float x, int l) { return __builtin_bit_cast(float, __builtin_amdgcn_readlane(__builtin_bit_cast(int, x), l)); }
__device__ __forceinline__ float wave_sum_dpp(float x) { x = rowsum16(x); return (rl(x, 0) + rl(x, 16)) + (rl(x, 32) + rl(x, 48)); }

__device__ __forceinline__ void transpose_matrix(const float* __restrict__ W, int K, int N, bf16_t* __restrict__ WT, int Npad, int ldt, LAS float* scr, int gw, int NGW, int lane, const float* __restrict__ kscale, int& tr_base, bool ffn_interleave = false) {
    (void)scr;
    const int nblk = Npad / 64, nit = (K / 64) * nblk;
    int it0 = gw - (tr_base % NGW); if (it0 < 0) it0 += NGW; tr_base += nit;
    for (int it = it0; it < nit; it += NGW) {
        const int kb = it / nblk, nb = it - kb * nblk, n = nb * 64 + lane, k0 = kb * 64;
        const bool ok = n < N; const float* src = W + (size_t)k0 * N + (ok ? n : 0);
#pragma unroll
        for (int hc = 0; hc < 2; ++hc) {
            float v[32];
#pragma unroll
            for (int i = 0; i < 32; ++i) v[i] = src[(size_t)(hc * 32 + i) * N];
#pragma unroll
            for (int c = 0; c < 4; ++c) { float u[8];
#pragma unroll
                for (int i = 0; i < 8; ++i) { u[i] = ok ? v[c * 8 + i] : 0.f; if (kscale) u[i] *= kscale[k0 + hc * 32 + c * 8 + i]; }
                v4u o; o.x = cvtpk(u[0], u[1]); o.y = cvtpk(u[2], u[3]); o.z = cvtpk(u[4], u[5]); o.w = cvtpk(u[6], u[7]);
                const int nr = ffn_interleave ? ((n < DFF) ? 256 * (n >> 7) + (n & 127) : 256 * ((n - DFF) >> 7) + 128 + ((n - DFF) & 127)) : n;
                *(v4u*)(WT + (size_t)nr * ldt + k0 + hc * 32 + c * 8) = o; }
        }
    }
}

template <int MODE> __device__ __forceinline__ void ln_rows(float* h, bf16_t* hb, float* stats, const float* __restrict__ g, const float* __restrict__ b, int gw, int NGW, int lane) {
    for (int row = gw * 2; row < M; row += NGW * 2) {
        float* p = h + (size_t)row * DM;
        f32x4 v[2][4]; float s[2] = {0.f, 0.f};
#pragma unroll
        for (int r = 0; r < 2; ++r)
#pragma unroll
            for (int j = 0; j < 4; ++j) v[r][j] = *(const f32x4*)(p + r * DM + 4 * lane + 256 * j);
#pragma unroll
        for (int r = 0; r < 2; ++r)
#pragma unroll
            for (int j = 0; j < 4; ++j) s[r] += (v[r][j][0] + v[r][j][1]) + (v[r][j][2] + v[r][j][3]);
        float mean[2], q[2] = {0.f, 0.f}, rstd[2];
#pragma unroll
        for (int r = 0; r < 2; ++r) { mean[r] = wave_sum_dpp(s[r]) * (1.f / DM);
#pragma unroll
            for (int j = 0; j < 4; ++j) { v[r][j] = v[r][j] - mean[r]; q[r] += (v[r][j][0] * v[r][j][0] + v[r][j][1] * v[r][j][1]) + (v[r][j][2] * v[r][j][2] + v[r][j][3] * v[r][j][3]); } }
#pragma unroll
        for (int r = 0; r < 2; ++r) rstd[r] = 1.0f / sqrtf(wave_sum_dpp(q[r]) * (1.f / DM) + 1e-5f);
        if (MODE == 1 && lane < 2) { stats[2 * (row + lane)] = lane ? mean[1] : mean[0]; stats[2 * (row + lane) + 1] = lane ? rstd[1] : rstd[0]; }
#pragma unroll
        for (int j = 0; j < 4; ++j) {
            const int c = 4 * lane + 256 * j;
            const f32x4 gg = *(const f32x4*)(g + c), bb = *(const f32x4*)(b + c);
#pragma unroll
            for (int r = 0; r < 2; ++r) {
                const f32x4 o = v[r][j] * rstd[r] * gg + bb;
                if (MODE == 1) { uint2 w; w.x = cvtpk(o[0], o[1]); w.y = cvtpk(o[2], o[3]); *(uint2*)(hb + (size_t)(row + r) * DM + c) = w; }
                else *(f32x4*)(p + r * DM + c) = o;
            }
        }
    }
}

__device__ __forceinline__ void rwkv_naive_chain(int chain, int lane, LAS float* sm, const bf16_t* __restrict__ proj, const float* __restrict__ mix, const float* __restrict__ w0, const float* __restrict__ w2,
                                                 const float* __restrict__ a0, const float* __restrict__ a2, const float* __restrict__ g2, const float* __restrict__ k_k,
                                                 const float* __restrict__ k_a, const float* __restrict__ r_k, const float* __restrict__ ln_g, const float* __restrict__ ln_b, bf16_t* __restrict__ ymix) {
    LAS float* s_w2 = sm; LAS float* s_a2 = sm + 4096; LAS float* s_g2 = sm + 8192; LAS float* s_tw = sm + 16384; LAS float* s_al = s_tw + 64; LAS float* s_sg = s_tw + 128;
    LAS float* s_w = s_tw + 256; LAS float* s_k = s_tw + 320; LAS float* s_a = s_tw + 384; LAS float* s_b = s_tw + 448; LAS float* s_r = s_tw + 512;
    const int b = chain >> 3, h = chain & 7, c = h * 64 + lane;
    for (int l = 0; l < 64; ++l) { s_w2[l * 64 + lane] = w2[l * 512 + c]; s_a2[l * 64 + lane] = a2[l * 512 + c]; }
    for (int l = 0; l < 128; ++l) s_g2[l * 64 + lane] = g2[l * 512 + c];
    const float mr = mix[c], mk = mix[512 + c], mv = mix[1024 + c], mw = mix[1536 + lane], ma = mix[1600 + lane], mg0 = mix[1664 + lane], mg1 = mix[1728 + lane];
    const float w0c = w0[c], a0c = a0[c], kkc = k_k[c], kac = k_a[c], rkc = r_k[c], lgc = ln_g[c], lbc = ln_b[c];
    float S[64];
#pragma unroll
    for (int j = 0; j < 64; ++j) S[j] = 0.f;
    float pr = 0.f, pk = 0.f, pv = 0.f, pw = 0.f, pa = 0.f, pg0 = 0.f, pg1 = 0.f;
    WSYNC();
    for (int t = 0; t < SEQ; ++t) {
        const bf16_t* row = proj + (size_t)(b * SEQ + t) * L0P;
        const float cr = bf2f(row[c]), ck = bf2f(row[512 + c]), cv = bf2f(row[1024 + c]), cw = bf2f(row[1536 + lane]), ca = bf2f(row[1600 + lane]),
                    cg0 = bf2f(row[1664 + lane]), cg1 = bf2f(row[1728 + lane]);
        const float r_s = cr + (pr - cr) * mr, k_s = ck + (pk - ck) * mk, v_s = cv + (pv - cv) * mv;
        const float wl = cw + (pw - cw) * mw, al = ca + (pa - ca) * ma, g0 = cg0 + (pg0 - cg0) * mg0, g1 = cg1 + (pg1 - cg1) * mg1;
        pr = cr; pk = ck; pv = cv; pw = cw; pa = ca; pg0 = cg0; pg1 = cg1;
        s_tw[lane] = tanhf(wl); s_al[lane] = al; s_sg[lane] = sigmoidf_(g0); s_sg[64 + lane] = sigmoidf_(g1);
        WSYNC();
        float wsum = w0c, asum = a0c, gsum = 0.f;
#pragma unroll 2
        for (int l = 0; l < 64; ++l) { wsum += s_tw[l] * s_w2[l * 64 + lane]; asum += s_al[l] * s_a2[l * 64 + lane]; }
#pragma unroll 2
        for (int l = 0; l < 128; ++l) gsum += s_sg[l] * s_g2[l * 64 + lane];
        const float log_w = -softplusf_(-wsum) - 0.5f;
        const float dec = expf(-expf(log_w));
        const float a = sigmoidf_(asum);
        float kkv = k_s * kkc;
        const float nrm = sqrtf(wave_sum(kkv * kkv));
        kkv = kkv / fmaxf(nrm, 1e-12f);
        const float k2 = k_s * (1.f + (a - 1.f) * kac);
        const float bonus_s = wave_sum(r_s * k2 * rkc);
        s_w[lane] = dec; s_k[lane] = k2; s_a[lane] = -kkv; s_b[lane] = kkv * a; s_r[lane] = r_s;
        WSYNC();
        float sa = 0.f;
#pragma unroll
        for (int j = 0; j < 64; ++j) sa += S[j] * s_a[j];
        float y = 0.f;
#pragma unroll
        for (int j = 0; j < 64; ++j) { S[j] = S[j] * s_w[j] + sa * s_b[j] + v_s * s_k[j]; y += S[j] * s_r[j]; }
        const float mu = wave_sum(y) * (1.f / 64.f);
        const float d = y - mu;
        const float var = wave_sum(d * d) * (1.f / 64.f);
        const float yn = d * (1.0f / sqrtf(var + 64e-5f)) * lgc + lbc;
        const float o = (yn + bonus_s * v_s) * gsum;
        ymix[(size_t)(b * SEQ + t) * DM + c] = (bf16_t)f2bf(o);
        WSYNC();
    }
}

__device__ __forceinline__ void ssm_conv_all(const bf16_t* __restrict__ proj, const float* __restrict__ cw, const float* __restrict__ cb, const float* __restrict__ dtb,
                                             bf16_t* __restrict__ xbc, float* __restrict__ dt, int gtid, int NT) {
    for (size_t i = gtid; i < (size_t)M * 1024; i += NT) {
        const int m = (int)(i >> 10), c = (int)(i & 1023), t = m & (SEQ - 1);
        float acc = cb[c];
#pragma unroll
        for (int k = 0; k < 4; ++k) { const int tt = t - 3 + k; if (tt >= 0) acc += cw[k * 1024 + c] * bf2f(proj[(size_t)(m - 3 + k) * L0P + 2304 + c]); }
        xbc[i] = (bf16_t)f2bf(siluf_(acc));
    }
    for (int i = gtid; i < M * 8; i += NT) dt[i] = softplusf_(bf2f(proj[(size_t)(i >> 3) * L0P + 3328 + (i & 7)]) + dtb[i & 7]);
}
__device__ __forceinline__ void ssd_naive_task(int task, int lane, const bf16_t* __restrict__ xbc, const float* __restrict__ dt, const float* __restrict__ a_log, const float* __restrict__ dsk, float* __restrict__ yssm) {
    const int chain = task >> 2, q = task & 3, b = chain >> 3, h = chain & 7, g = h >> 2, p = q * 16 + (lane >> 2), nq = lane & 3;
    const float A = -expf(a_log[h]), D = dsk[h];
    float st[32];
#pragma unroll
    for (int n = 0; n < 32; ++n) st[n] = 0.f;
    for (int t = 0; t < SEQ; ++t) {
        const size_t m = (size_t)b * SEQ + t;
        const float dtv = dt[m * 8 + h], dA = expf(dtv * A);
        const float x = bf2f(xbc[m * 1024 + h * 64 + p]), xdt = x * dtv;
        const bf16_t* Bp = xbc + m * 1024 + 512 + g * 128 + nq * 32;
        const bf16_t* Cp = xbc + m * 1024 + 768 + g * 128 + nq * 32;
        float yp = 0.f;
#pragma unroll
        for (int n = 0; n < 32; ++n) { st[n] = st[n] * dA + xdt * bf2f(Bp[n]); yp += st[n] * bf2f(Cp[n]); }
        yp += __shfl_xor(yp, 1); yp += __shfl_xor(yp, 2);
        if (nq == 0) yssm[m * 512 + h * 64 + p] = yp + D * x;
    }
}
template <bool ST = true> __device__ __forceinline__ void ssm_gate_norm_all(const bf16_t* __restrict__ yssm, const bf16_t* __restrict__ proj, const float* __restrict__ ng, bf16_t* __restrict__ ymix, int wv0, int wvend, int lane) {
    for (int wvb = wv0 * 4 - (wv0 & ~7) * 3; wvb < wvend; wvb += NWAVES * 4) {
        float u[4][4], q[4];
#pragma unroll
        for (int k = 0; k < 4; ++k) { const int wv = wvb + k, m = wv >> 1, g = wv & 1; q[k] = 0.f;
#pragma unroll
            for (int j = 0; j < 4; ++j) { const int c = g * 256 + j * 64 + lane; const float z = bf2f(proj[(size_t)m * L0P + 1792 + c]); u[k][j] = bf2f(yssm[(size_t)m * 512 + c]) * (z * __builtin_amdgcn_rcpf(1.f + __expf(-z))); q[k] += u[k][j] * u[k][j]; } }
#pragma unroll
        for (int k = 0; k < 4; ++k) { const int wv = wvb + k, m = wv >> 1, g = wv & 1;
            const float rs = __builtin_amdgcn_rsqf(wave_sum_dpp(q[k]) * (1.f / 256.f) + 1e-5f);
#pragma unroll
            for (int j = 0; j < 4; ++j) { const int c = g * 256 + j * 64 + lane; const float o_ = u[k][j] * rs * ng[c]; if (ST) ymix[(size_t)m * DM + 512 + c] = bf1(o_); else asm volatile("" :: "v"(o_)); } }
    }
}
template <bool ST = true> __device__ __forceinline__ void ffn_act_all(bf16_t* gu, const float* __restrict__ cw, const float* __restrict__ cb, int gtid, int NT) {
    constexpr int NCH = DFF / 8, NSTRIP = M / 32;
    for (int task = gtid; task < NSTRIP * NCH; task += NT) {
        const int strip = task / NCH, q = task - strip * NCH, c0 = q * 8, m0 = strip * 32;
        float w0[8], w1[8], w2[8], bb[8], g2[8], g1[8];
#pragma unroll
        for (int j = 0; j < 8; j += 4) { const f32x4 a = *(const f32x4*)(cw + c0 + j), b = *(const f32x4*)(cw + DFF + c0 + j), c = *(const f32x4*)(cw + 2 * DFF + c0 + j), d = *(const f32x4*)(cb + c0 + j);
#pragma unroll
            for (int k = 0; k < 4; ++k) { w0[j + k] = a[k]; w1[j + k] = b[k]; w2[j + k] = c[k]; bb[j + k] = d[k]; } }
        bf16_t* base = gu + (size_t)m0 * (2 * DFF) + c0;
        if ((m0 & (SEQ - 1)) != 0) { const v4u a = *(const v4u*)(base - 2 * (2 * DFF)), b = *(const v4u*)(base - (2 * DFF));
            g2[0] = bflo(a.x); g2[1] = bfhi(a.x); g2[2] = bflo(a.y); g2[3] = bfhi(a.y); g2[4] = bflo(a.z); g2[5] = bfhi(a.z); g2[6] = bflo(a.w); g2[7] = bfhi(a.w);
            g1[0] = bflo(b.x); g1[1] = bfhi(b.x); g1[2] = bflo(b.y); g1[3] = bfhi(b.y); g1[4] = bflo(b.z); g1[5] = bfhi(b.z); g1[6] = bflo(b.w); g1[7] = bfhi(b.w); }
        else {
#pragma unroll
            for (int j = 0; j < 8; ++j) { g2[j] = 0.f; g1[j] = 0.f; } }
#pragma unroll 4
        for (int r = 0; r < 32; ++r) {
            const v4u gv = *(const v4u*)(base + (size_t)r * (2 * DFF)), uv = *(const v4u*)(base + (size_t)r * (2 * DFF) + DFF);
            const unsigned gw_[4] = {gv.x, gv.y, gv.z, gv.w}, uw_[4] = {uv.x, uv.y, uv.z, uv.w};
            unsigned ow[4];
#pragma unroll
            for (int k = 0; k < 4; ++k) {
                const float ga = bflo(gw_[k]), gb = bfhi(gw_[k]);
                const float ya = bb[2 * k] + w0[2 * k] * g2[2 * k] + w1[2 * k] * g1[2 * k] + w2[2 * k] * ga;
                const float yb = bb[2 * k + 1] + w0[2 * k + 1] * g2[2 * k + 1] + w1[2 * k + 1] * g1[2 * k + 1] + w2[2 * k + 1] * gb;
                g2[2 * k] = g1[2 * k]; g1[2 * k] = ga; g2[2 * k + 1] = g1[2 * k + 1]; g1[2 * k + 1] = gb;
                ow[k] = cvtpk(ya / (1.f + __expf(-ya)) * bflo(uw_[k]), yb / (1.f + __expf(-yb)) * bfhi(uw_[k]));
            }
            if (ST) *(v4u*)(base + (size_t)r * (2 * DFF) + DFF) = (v4u){ow[0], ow[1], ow[2], ow[3]}; else asm volatile("" :: "v"(ow[0]), "v"(ow[1]), "v"(ow[2]), "v"(ow[3]));
        }
    }
}
template <bool ST = true> __device__ __forceinline__ void mla_prep_all(const bf16_t* __restrict__ proj1, const int* __restrict__ pos, float* __restrict__ rs, bf16_t* __restrict__ kpe, float* __restrict__ cstab, int gw, int NGW, int lane) {
    for (int m4 = gw * 4; m4 < M; m4 += NGW * 4) {
        const int mt = m4 + (lane >> 4), fi = lane & 15;
        const double inv = exp2(-(double)(2 * fi) * (13.287712379549449 / 32.0));
        const double ang = (double)pos[mt] * inv;
        const float cs = (float)cos(ang), sn = (float)sin(ang);
        cstab[(size_t)mt * 32 + fi] = cs; cstab[(size_t)mt * 32 + 16 + fi] = sn;
        { const bf16_t* row = proj1 + (size_t)mt * L1P; const float x1 = bf2f(row[1920 + fi]), x2 = bf2f(row[1936 + fi]);
          kpe[(size_t)mt * 32 + fi] = bf1(x1 * cs - x2 * sn); kpe[(size_t)mt * 32 + 16 + fi] = bf1(x2 * cs + x1 * sn); }
        float q[4], k[4];
#pragma unroll
        for (int u = 0; u < 4; ++u) { const bf16_t* row = proj1 + (size_t)(m4 + u) * L1P; q[u] = 0.f; k[u] = 0.f;
#pragma unroll
            for (int j = 0; j < 4; ++j) { const float v = bf2f(row[1536 + j * 64 + lane]); q[u] += v * v; }
#pragma unroll
            for (int j = 0; j < 2; ++j) { const float v = bf2f(row[1792 + j * 64 + lane]); k[u] += v * v; } }
#pragma unroll
        for (int u = 0; u < 4; ++u) { q[u] = wave_sum_dpp(q[u]); k[u] = wave_sum_dpp(k[u]); }
        if (lane < 4) { const float qq = lane == 0 ? q[0] : lane == 1 ? q[1] : lane == 2 ? q[2] : q[3], kk2 = lane == 0 ? k[0] : lane == 1 ? k[1] : lane == 2 ? k[2] : k[3];
            rs[(size_t)(m4 + lane) * 2] = 1.0f / sqrtf(qq * (1.f / 256.f) + 1e-6f); rs[(size_t)(m4 + lane) * 2 + 1] = 1.0f / sqrtf(kk2 * (1.f / 128.f) + 1e-6f); }
    }
}
template <bool ST = true> __device__ __forceinline__ void rope_q_all(bf16_t* qm, const float* __restrict__ cstab, int gtid, int NT) {
    for (int i = gtid; i < M * 16; i += NT) {
        const int m = i >> 4, h = (i >> 1) & 7, k0 = (i & 1) * 8;
        bf16_t* p = qm + (size_t)m * 768 + h * 96 + 64 + k0;
        const v4u a = *(const v4u*)p, b = *(const v4u*)(p + 16);
        const f32x4 c0 = *(const f32x4*)(cstab + (size_t)m * 32 + k0), c1 = *(const f32x4*)(cstab + (size_t)m * 32 + k0 + 4), s0 = *(const f32x4*)(cstab + (size_t)m * 32 + 16 + k0), s1 = *(const f32x4*)(cstab + (size_t)m * 32 + 16 + k0 + 4);
        const unsigned au[4] = {a.x, a.y, a.z, a.w}, bu[4] = {b.x, b.y, b.z, b.w};
        const float cs[8] = {c0[0], c0[1], c0[2], c0[3], c1[0], c1[1], c1[2], c1[3]}, sn[8] = {s0[0], s0[1], s0[2], s0[3], s1[0], s1[1], s1[2], s1[3]};
        unsigned o1[4], o2[4];
#pragma unroll
        for (int q = 0; q < 4; ++q) { const float x1a = bflo(au[q]), x1b = bfhi(au[q]), x2a = bflo(bu[q]), x2b = bfhi(bu[q]);
            o1[q] = cvtpk(x1a * cs[2 * q] - x2a * sn[2 * q], x1b * cs[2 * q + 1] - x2b * sn[2 * q + 1]);
            o2[q] = cvtpk(x2a * cs[2 * q] + x1a * sn[2 * q], x2b * cs[2 * q + 1] + x1b * sn[2 * q + 1]); }
        if (ST) { *(v4u*)p = (v4u){o1[0], o1[1], o1[2], o1[3]}; *(v4u*)(p + 16) = (v4u){o2[0], o2[1], o2[2], o2[3]}; }
    }
}
__device__ __forceinline__ void sb_naive_task(int qblk, int bh, int lane, const bf16_t* __restrict__ proj1, bf16_t* __restrict__ ymix) {
    const int b = bh >> 3, h = bh & 7, t = qblk * 64 + lane;
    const size_t mrow = (size_t)b * SEQ;
    float q[64], o[64];
#pragma unroll
    for (int d = 0; d < 64; ++d) { q[d] = bf2f(proj1[(mrow + t) * L1P + h * 64 + d]) * 0.125f; o[d] = 0.f; }
    float cum = 0.f;
    const int smax = qblk * 64 + 63;
    for (int s = smax - 1; s >= 0; --s) {
        const bf16_t* kr = proj1 + (mrow + s) * L1P + 512 + h * 64;
        const bf16_t* vr = proj1 + (mrow + s) * L1P + 1024 + h * 64;
        float z = 0.f;
#pragma unroll
        for (int d = 0; d < 64; ++d) z += q[d] * bf2f(kr[d]);
        if (s < t) {
            const float lsp = -softplusf_(-z);
            const float lsn = -softplusf_(z);
            const float att = expf(lsp + cum);
            cum += lsn;
#pragma unroll
            for (int d = 0; d < 64; ++d) o[d] += att * bf2f(vr[d]);
        }
    }
#pragma unroll
    for (int d = 0; d < 64; ++d) ymix[(mrow + t) * DM + h * 64 + d] = (bf16_t)f2bf(o[d]);
}
__device__ __forceinline__ void mla_naive_task(int qblk, int bh, int lane, const bf16_t* __restrict__ qm, const bf16_t* __restrict__ kvm, const bf16_t* __restrict__ kpe, bf16_t* __restrict__ ymix) {
    const int b = bh >> 3, h = bh & 7, t = qblk * 64 + lane;
    const size_t mrow = (size_t)b * SEQ;
    const float scale = 0.10206207261596577f;
    float q[96], o[64];
#pragma unroll
    for (int d = 0; d < 96; ++d) q[d] = bf2f(qm[(mrow + t) * 768 + h * 96 + d]) * scale;
#pragma unroll
    for (int d = 0; d < 64; ++d) o[d] = 0.f;
    float mx = -1e30f, l = 0.f;
    const int smax = qblk * 64 + 63;
    for (int s = 0; s <= smax; ++s) {
        const bf16_t* kr = kvm + (mrow + s) * 1024 + h * 128;
        const bf16_t* pr = kpe + (mrow + s) * 32;
        float z = 0.f;
#pragma unroll
        for (int d = 0; d < 64; ++d) z += q[d] * bf2f(kr[d]);
#pragma unroll
        for (int d = 0; d < 32; ++d) z += q[64 + d] * bf2f(pr[d]);
        if (s <= t) {
            const float mn = fmaxf(mx, z), f = expf(mx - mn), pz = expf(z - mn);
            l = l * f + pz; mx = mn;
#pragma unroll
            for (int d = 0; d < 64; ++d) o[d] = o[d] * f + pz * bf2f(kr[64 + d]);
        }
    }
    const float il = 1.f / l;
#pragma unroll
    for (int d = 0; d < 64; ++d) ymix[(mrow + t) * DM + 512 + h * 64 + d] = (bf16_t)f2bf(o[d] * il);
}


__device__ __forceinline__ int crow(int r, int hi) { return (r & 3) + 8 * (r >> 2) + 4 * hi; }
#define MFMA32(a, b, c) __builtin_amdgcn_mfma_f32_32x32x16_bf16((a), (b), (c), 0, 0, 0)
constexpr int STG_PITCH = 72;
__device__ __forceinline__ void transpose_tile64(const bf16_t* __restrict__ src, int sp, bf16_t* __restrict__ dst, int dp, LAS bf16_t* scr, int lane) {
#pragma unroll
    for (int i = 0; i < 8; ++i) { const int row = i * 8 + (lane >> 3), ch = lane & 7; const v4u v = *(const v4u*)(src + (size_t)row * sp + ch * 8); *(LAS v4u*)(scr + row * STG_PITCH + ch * 8) = v; }
    WSYNC();
#pragma unroll
    for (int i = 0; i < 8; ++i) { const int d = i * 8 + (lane >> 3), tc = lane & 7; const LAS bf16_t* p = scr + (tc * 8) * STG_PITCH + d;
        v4u o; o.x = (unsigned)p[0] | ((unsigned)p[STG_PITCH] << 16); o.y = (unsigned)p[2 * STG_PITCH] | ((unsigned)p[3 * STG_PITCH] << 16);
        o.z = (unsigned)p[4 * STG_PITCH] | ((unsigned)p[5 * STG_PITCH] << 16); o.w = (unsigned)p[6 * STG_PITCH] | ((unsigned)p[7 * STG_PITCH] << 16);
        *(v4u*)(dst + (size_t)d * dp + tc * 8) = o; }
    WSYNC();
}
__device__ __forceinline__ void store_OT(const f32x16 (&o)[2], float sc, LAS bf16_t* stg, bf16_t* __restrict__ dst, int lane) {
    const int l31 = lane & 31, hi = lane >> 5;
#pragma unroll
    for (int dt = 0; dt < 2; ++dt)
#pragma unroll
        for (int r = 0; r < 16; ++r) stg[l31 * STG_PITCH + 32 * dt + crow(r, hi)] = (bf16_t)f2bf(o[dt][r] * sc);
    WSYNC();
#pragma unroll
    for (int i = 0; i < 4; ++i) { const int row = i * 8 + (lane >> 3), ch = lane & 7; const v4u v = *(const LAS v4u*)(stg + row * STG_PITCH + ch * 8); *(v4u*)(dst + (size_t)row * DM + ch * 8) = v; }
    WSYNC();
}
__device__ __forceinline__ float softplus_fast(float z) { return fmaxf(z, 0.f) + __logf(1.f + __expf(-fabsf(z))); }

__device__ __forceinline__ void sb_task(int bh, int qblk, int lane, const bf16_t* __restrict__ P1, const bf16_t* __restrict__ VT, bf16_t* __restrict__ ymix, LAS bf16_t* stg) {
    const int b = bh >> 3, h = bh & 7, l31 = lane & 31, hi = lane >> 5, q0 = qblk * 32, t = q0 + l31;
    const size_t rowb = (size_t)b * SEQ;
    const bf16_t* Qp = P1 + (rowb + q0 + l31) * L1P + h * 64 + 8 * hi;
    bf16x8 qf[4];
#pragma unroll
    for (int kk = 0; kk < 4; ++kk) qf[kk] = *(const bf16x8*)(Qp + 16 * kk);
    const bf16_t* Kp = P1 + (rowb + l31) * L1P + 512 + h * 64 + 8 * hi;
    const bf16_t* Vp = VT + ((size_t)bh * 64 + l31) * SEQ + 4 * hi;
    f32x16 o[2];
#pragma unroll
    for (int r = 0; r < 16; ++r) { o[0][r] = 0.f; o[1][r] = 0.f; }
    float cum = 0.f;
    bf16x8 kf[4]; u32x2 va[2][2][2];
#define SB_LOAD(S0, KF, VA) do { _Pragma("unroll") for (int kk = 0; kk < 4; ++kk) KF[kk] = *(const bf16x8*)(Kp + (size_t)(S0) * L1P + 16 * kk); \
        _Pragma("unroll") for (int dt = 0; dt < 2; ++dt) _Pragma("unroll") for (int ks = 0; ks < 2; ++ks) { VA[dt][ks][0] = *(const u32x2*)(Vp + (size_t)dt * 32 * SEQ + (S0) + 16 * ks); VA[dt][ks][1] = *(const u32x2*)(Vp + (size_t)dt * 32 * SEQ + (S0) + 16 * ks + 8); } } while (0)
    SB_LOAD(q0, kf, va);
    for (int s0 = q0; s0 >= 0; s0 -= 32) {
        bf16x8 kn[4]; u32x2 vn[2][2][2];
        const int sn = (s0 >= 32) ? s0 - 32 : 0;
        SB_LOAD(sn, kn, vn);
        f32x16 acc;
#pragma unroll
        for (int r = 0; r < 16; ++r) acc[r] = 0.f;
#pragma unroll
        for (int kk = 0; kk < 4; ++kk) acc = MFMA32(kf[kk], qf[kk], acc);
        const bool diag = (s0 == q0);
        float lb[16], lk[16];
#pragma unroll
        for (int r = 0; r < 16; ++r) { const float z = acc[r] * 0.125f; const float sp = softplus_fast(z); float b_ = z - sp, k_ = -sp;
            if (diag) { const bool valid = (s0 + crow(r, hi)) < t; b_ = valid ? b_ : -1e30f; k_ = valid ? k_ : 0.f; }
            lb[r] = b_; lk[r] = k_; }
        float e[16], T[4], U[4];
#pragma unroll
        for (int i = 0; i < 4; ++i) { e[4 * i + 3] = 0.f; e[4 * i + 2] = lk[4 * i + 3]; e[4 * i + 1] = e[4 * i + 2] + lk[4 * i + 2]; e[4 * i] = e[4 * i + 1] + lk[4 * i + 1]; T[i] = e[4 * i] + lk[4 * i]; }
#pragma unroll
        for (int i = 0; i < 4; ++i) U[i] = __shfl_xor(T[i], 32);
        float off[4];
        { const float st2 = T[3], st1 = st2 + T[2], st0 = st1 + T[1]; const float su2 = U[3], su1 = su2 + U[2], su0 = su1 + U[1];
          const float x0 = hi ? 0.f : U[0], x1 = hi ? 0.f : U[1], x2 = hi ? 0.f : U[2], x3 = hi ? 0.f : U[3];
          off[3] = x3; off[2] = st2 + su2 + x2; off[1] = st1 + su1 + x1; off[0] = st0 + su0 + x0;
          const float total = st0 + T[0] + su0 + U[0];
#pragma unroll
          for (int r = 0; r < 16; ++r) acc[r] = __expf(lb[r] + (cum + off[r >> 2] + e[r]));
          cum += total; }
        bf16x8 pf[2];
#pragma unroll
        for (int ks = 0; ks < 2; ++ks) { v4u w; w.x = cvtpk(acc[8 * ks], acc[8 * ks + 1]); w.y = cvtpk(acc[8 * ks + 2], acc[8 * ks + 3]); w.z = cvtpk(acc[8 * ks + 4], acc[8 * ks + 5]); w.w = cvtpk(acc[8 * ks + 6], acc[8 * ks + 7]); pf[ks] = __builtin_bit_cast(bf16x8, w); }
#pragma unroll
        for (int dt = 0; dt < 2; ++dt)
#pragma unroll
            for (int ks = 0; ks < 2; ++ks) { v4u a; a.x = va[dt][ks][0].x; a.y = va[dt][ks][0].y; a.z = va[dt][ks][1].x; a.w = va[dt][ks][1].y; o[dt] = MFMA32(__builtin_bit_cast(bf16x8, a), pf[ks], o[dt]); }
        if (__all(cum < -110.f)) break;
#pragma unroll
        for (int kk = 0; kk < 4; ++kk) kf[kk] = kn[kk];
#pragma unroll
        for (int dt = 0; dt < 2; ++dt)
#pragma unroll
            for (int ks = 0; ks < 2; ++ks) { va[dt][ks][0] = vn[dt][ks][0]; va[dt][ks][1] = vn[dt][ks][1]; }
    }
#undef SB_LOAD
    store_OT(o, 1.0f, stg, ymix + (rowb + q0) * DM + h * 64, lane);
}
__device__ __forceinline__ void mla_task(int bh, int qblk, int lane, const bf16_t* __restrict__ QM, const bf16_t* __restrict__ KVM, const bf16_t* __restrict__ KPE, const bf16_t* __restrict__ VT,
                                         bf16_t* __restrict__ ymix, LAS bf16_t* stg) {
    const int b = bh >> 3, h = bh & 7, l31 = lane & 31, hi = lane >> 5, q0 = qblk * 32, t = q0 + l31;
    const size_t rowb = (size_t)b * SEQ;
    const bf16_t* Qp = QM + (rowb + q0 + l31) * 768 + h * 96 + 8 * hi;
    bf16x8 qf[6];
#pragma unroll
    for (int kk = 0; kk < 6; ++kk) qf[kk] = *(const bf16x8*)(Qp + 16 * kk);
    const bf16_t* Kn = KVM + (rowb + l31) * 1024 + h * 128 + 8 * hi;
    const bf16_t* Kr = KPE + (rowb + l31) * 32 + 8 * hi;
    const bf16_t* Vp = VT + ((size_t)bh * 64 + l31) * SEQ + 4 * hi;
    const float sc2 = 0.10206207261596577f * 1.4426950408889634f;
    f32x16 o[2];
#pragma unroll
    for (int r = 0; r < 16; ++r) { o[0][r] = 0.f; o[1][r] = 0.f; }
    float mrun = -1e30f, lsum = 0.f;
    bf16x8 kf[6]; u32x2 va[2][2][2];
#define ML_LOAD(S0, KF, VA) do { _Pragma("unroll") for (int kk = 0; kk < 4; ++kk) KF[kk] = *(const bf16x8*)(Kn + (size_t)(S0) * 1024 + 16 * kk); \
        _Pragma("unroll") for (int kk = 0; kk < 2; ++kk) KF[4 + kk] = *(const bf16x8*)(Kr + (size_t)(S0) * 32 + 16 * kk); \
        _Pragma("unroll") for (int dt = 0; dt < 2; ++dt) _Pragma("unroll") for (int ks = 0; ks < 2; ++ks) { VA[dt][ks][0] = *(const u32x2*)(Vp + (size_t)dt * 32 * SEQ + (S0) + 16 * ks); VA[dt][ks][1] = *(const u32x2*)(Vp + (size_t)dt * 32 * SEQ + (S0) + 16 * ks + 8); } } while (0)
    ML_LOAD(0, kf, va);
    for (int s0 = 0; s0 <= q0; s0 += 32) {
        bf16x8 kn[6]; u32x2 vn[2][2][2];
        const int sn = (s0 + 32 <= q0) ? s0 + 32 : s0;
        ML_LOAD(sn, kn, vn);
        f32x16 acc;
#pragma unroll
        for (int r = 0; r < 16; ++r) acc[r] = 0.f;
#pragma unroll
        for (int kk = 0; kk < 6; ++kk) acc = MFMA32(kf[kk], qf[kk], acc);
        const bool diag = (s0 == q0);
        float tmax = -1e30f;
#pragma unroll
        for (int r = 0; r < 16; ++r) { float z = acc[r] * sc2; if (diag && (s0 + crow(r, hi)) > t) z = -1e30f; acc[r] = z; tmax = fmaxf(tmax, z); }
        tmax = fmaxf(tmax, __shfl_xor(tmax, 32));
        const float mn = fmaxf(mrun, tmax), alpha = exp2f(mrun - mn); mrun = mn;
        float ps = 0.f;
#pragma unroll
        for (int r = 0; r < 16; ++r) { acc[r] = exp2f(acc[r] - mn); ps += acc[r]; }
        lsum = lsum * alpha + ps;
#pragma unroll
        for (int r = 0; r < 16; ++r) { o[0][r] *= alpha; o[1][r] *= alpha; }
        bf16x8 pf[2];
#pragma unroll
        for (int ks = 0; ks < 2; ++ks) { v4u w; w.x = cvtpk(acc[8 * ks], acc[8 * ks + 1]); w.y = cvtpk(acc[8 * ks + 2], acc[8 * ks + 3]); w.z = cvtpk(acc[8 * ks + 4], acc[8 * ks + 5]); w.w = cvtpk(acc[8 * ks + 6], acc[8 * ks + 7]); pf[ks] = __builtin_bit_cast(bf16x8, w); }
#pragma unroll
        for (int dt = 0; dt < 2; ++dt)
#pragma unroll
            for (int ks = 0; ks < 2; ++ks) { v4u a; a.x = va[dt][ks][0].x; a.y = va[dt][ks][0].y; a.z = va[dt][ks][1].x; a.w = va[dt][ks][1].y; o[dt] = MFMA32(__builtin_bit_cast(bf16x8, a), pf[ks], o[dt]); }
#pragma unroll
        for (int kk = 0; kk < 6; ++kk) kf[kk] = kn[kk];
#pragma unroll
        for (int dt = 0; dt < 2; ++dt)
#pragma unroll
            for (int ks = 0; ks < 2; ++ks) { va[dt][ks][0] = vn[dt][ks][0]; va[dt][ks][1] = vn[dt][ks][1]; }
    }
#undef ML_LOAD
    lsum += __shfl_xor(lsum, 32);
    store_OT(o, 1.0f / lsum, stg, ymix + (rowb + q0) * DM + 512 + h * 64, lane);
}


constexpr int MLK_PITCH = 104, MLV_PITCH = 68, MLK_BYTES = 64 * MLK_PITCH * 2, MLV_BYTES = 64 * MLV_PITCH * 2, ML_STAGE = MLK_BYTES + MLV_BYTES;
__device__ __forceinline__ void mla_block(int bh, int sb, int tid, int lane, int wave, LAS unsigned char* lds, const bf16_t* __restrict__ QM, const bf16_t* __restrict__ KVM, const bf16_t* __restrict__ KPE,
                                          const bf16_t* __restrict__ VT, bf16_t* __restrict__ ymix) {
    const int b = bh >> 3, h = bh & 7, l31 = lane & 31, hi = lane >> 5, q0 = 256 * sb + 32 * wave, t = q0 + l31;
    const size_t rowb = (size_t)b * SEQ;
    const int nsteps = 4 * sb + 4;
    bf16x8 qf[6];
    { const bf16_t* Qp = QM + (rowb + q0 + l31) * 768 + h * 96 + 8 * hi;
#pragma unroll
      for (int kk = 0; kk < 6; ++kk) qf[kk] = *(const bf16x8*)(Qp + 16 * kk); }
    const float sc2 = 0.10206207261596577f * 1.4426950408889634f;
    f32x16 o[2];
#pragma unroll
    for (int r = 0; r < 16; ++r) { o[0][r] = 0.f; o[1][r] = 0.f; }
    float mrun = -1e30f, lsum = 0.f;
    const bf16_t* gKn = KVM + (rowb + (tid >> 3)) * 1024 + h * 128 + (tid & 7) * 8;
    const bf16_t* gKr = KPE + (rowb + ((tid & 255) >> 2)) * 32 + (tid & 3) * 8;
    const bf16_t* gVt = VT + ((size_t)bh * 64 + (tid >> 3)) * SEQ + (tid & 7) * 8;
    const int lKn = (tid >> 3) * (MLK_PITCH * 2) + (tid & 7) * 16, lKr = ((tid & 255) >> 2) * (MLK_PITCH * 2) + 128 + (tid & 3) * 16, lVt = MLK_BYTES + (tid >> 3) * (MLV_PITCH * 2) + (tid & 7) * 16;
    v4u rk, rr, rv;
    rk = *(const v4u*)gKn; rr = *(const v4u*)gKr; rv = *(const v4u*)gVt;
    *(LAS v4u*)(lds + lKn) = rk; if (tid < 256) *(LAS v4u*)(lds + lKr) = rr; *(LAS u32x2*)(lds + lVt) = (u32x2){rv.x, rv.y}; *(LAS u32x2*)(lds + lVt + 8) = (u32x2){rv.z, rv.w};
    __syncthreads();
#pragma unroll 1
    for (int step = 0; step < nsteps; ++step) {
        const int nx = (step + 1 < nsteps) ? step + 1 : step;
        rk = *(const v4u*)(gKn + (size_t)nx * 64 * 1024); rr = *(const v4u*)(gKr + (size_t)nx * 64 * 32); rv = *(const v4u*)(gVt + nx * 64);
        const LAS unsigned char* Kb = lds + (step & 1) * ML_STAGE;
        const LAS unsigned char* Vb = Kb + MLK_BYTES;
        if (64 * step <= q0) {
            f32x16 acc[2];
#pragma unroll
            for (int sub = 0; sub < 2; ++sub) {
#pragma unroll
                for (int r = 0; r < 16; ++r) acc[sub][r] = 0.f;
#pragma unroll
                for (int kk = 0; kk < 6; ++kk) { const bf16x8 kf = *(const LAS bf16x8*)(Kb + (32 * sub + l31) * (MLK_PITCH * 2) + (16 * kk + 8 * hi) * 2); acc[sub] = MFMA32(kf, qf[kk], acc[sub]); }
            }
            float tmax = -1e30f;
#pragma unroll
            for (int sub = 0; sub < 2; ++sub) { const int s0 = 64 * step + 32 * sub; const bool need_mask = (s0 + 31 > q0);
#pragma unroll
                for (int r = 0; r < 16; ++r) { float z = acc[sub][r] * sc2; if (need_mask && (s0 + crow(r, hi)) > t) z = -1e30f; acc[sub][r] = z; tmax = fmaxf(tmax, z); } }
            tmax = fmaxf(tmax, __shfl_xor(tmax, 32));
            const float mn = fmaxf(mrun, tmax), alpha = __builtin_amdgcn_exp2f(mrun - mn); mrun = mn;
            float ps = 0.f;
#pragma unroll
            for (int sub = 0; sub < 2; ++sub)
#pragma unroll
                for (int r = 0; r < 16; ++r) { acc[sub][r] = __builtin_amdgcn_exp2f(acc[sub][r] - mn); ps += acc[sub][r]; }
            lsum = lsum * alpha + ps;
#pragma unroll
            for (int r = 0; r < 16; ++r) { o[0][r] *= alpha; o[1][r] *= alpha; }
#pragma unroll
            for (int sub = 0; sub < 2; ++sub) {
                bf16x8 pf[2];
#pragma unroll
                for (int ks = 0; ks < 2; ++ks) pf[ks] = pack8(acc[sub][8 * ks], acc[sub][8 * ks + 1], acc[sub][8 * ks + 2], acc[sub][8 * ks + 3], acc[sub][8 * ks + 4], acc[sub][8 * ks + 5], acc[sub][8 * ks + 6], acc[sub][8 * ks + 7]);
#pragma unroll
                for (int dt = 0; dt < 2; ++dt)
#pragma unroll
                    for (int ks = 0; ks < 2; ++ks) { const LAS unsigned char* vp = Vb + (32 * dt + l31) * (MLV_PITCH * 2) + (32 * sub + 16 * ks + 4 * hi) * 2;
                        const u32x2 x0 = *(const LAS u32x2*)vp, x1 = *(const LAS u32x2*)(vp + 16);
                        v4u a; a.x = x0.x; a.y = x0.y; a.z = x1.x; a.w = x1.y; o[dt] = MFMA32(__builtin_bit_cast(bf16x8, a), pf[ks], o[dt]); }
            }
        }
        LAS unsigned char* nb = lds + ((step + 1) & 1) * ML_STAGE;
        *(LAS v4u*)(nb + lKn) = rk; if (tid < 256) *(LAS v4u*)(nb + lKr) = rr; *(LAS u32x2*)(nb + lVt) = (u32x2){rv.x, rv.y}; *(LAS u32x2*)(nb + lVt + 8) = (u32x2){rv.z, rv.w};
        __syncthreads();
    }
    lsum += __shfl_xor(lsum, 32);
    store_OT(o, 1.0f / lsum, (LAS bf16_t*)(lds + 2 * ML_STAGE) + wave * (32 * STG_PITCH), ymix + (rowb + q0) * DM + 512 + h * 64, lane);
    __syncthreads();
}


constexpr int SBK_PITCH = 72, SBK_BYTES = 64 * SBK_PITCH * 2, SB_STAGE = SBK_BYTES + MLV_BYTES;
__device__ __forceinline__ void sb_block(int bh, int sb, int tid, int lane, int wave, LAS unsigned char* lds, const bf16_t* __restrict__ P1, const bf16_t* __restrict__ VT, bf16_t* __restrict__ ymix) {
    const int b = bh >> 3, h = bh & 7, l31 = lane & 31, hi = lane >> 5, q0 = 256 * sb + 32 * wave, t = q0 + l31;
    const size_t rowb = (size_t)b * SEQ;
    bf16x8 qf[4];
    { const bf16_t* Qp = P1 + (rowb + q0 + l31) * L1P + h * 64 + 8 * hi;
#pragma unroll
      for (int kk = 0; kk < 4; ++kk) qf[kk] = *(const bf16x8*)(Qp + 16 * kk); }
    f32x16 o[2];
#pragma unroll
    for (int r = 0; r < 16; ++r) { o[0][r] = 0.f; o[1][r] = 0.f; }
    float cum = 0.f; bool done = false;
    volatile LAS unsigned* flags = (volatile LAS unsigned*)(lds + 2 * SB_STAGE);
    const bf16_t* gK = P1 + (rowb + (tid >> 3)) * L1P + 512 + h * 64 + (tid & 7) * 8;
    const bf16_t* gVt = VT + ((size_t)bh * 64 + (tid >> 3)) * SEQ + (tid & 7) * 8;
    const int lK = (tid >> 3) * (SBK_PITCH * 2) + (tid & 7) * 16, lVt = SBK_BYTES + (tid >> 3) * (MLV_PITCH * 2) + (tid & 7) * 16;
    const int top = 4 * sb + 3;
    v4u rk, rv;
    rk = *(const v4u*)(gK + (size_t)top * 64 * L1P); rv = *(const v4u*)(gVt + top * 64);
    *(LAS v4u*)(lds + lK) = rk; *(LAS u32x2*)(lds + lVt) = (u32x2){rv.x, rv.y}; *(LAS u32x2*)(lds + lVt + 8) = (u32x2){rv.z, rv.w};
    __syncthreads();
#pragma unroll 1
    for (int i = 0; i <= top; ++i) {
        const int step = top - i, nx = (step > 0) ? step - 1 : 0;
        rk = *(const v4u*)(gK + (size_t)nx * 64 * L1P); rv = *(const v4u*)(gVt + nx * 64);
        const LAS unsigned char* Kb = lds + (i & 1) * SB_STAGE;
        const LAS unsigned char* Vb = Kb + SBK_BYTES;
#pragma unroll
        for (int sub = 1; sub >= 0; --sub) {
            const int s0 = 64 * step + 32 * sub;
            if (s0 <= q0 && !done) {
                f32x16 acc;
#pragma unroll
                for (int r = 0; r < 16; ++r) acc[r] = 0.f;
#pragma unroll
                for (int kk = 0; kk < 4; ++kk) { const bf16x8 kf = *(const LAS bf16x8*)(Kb + (32 * sub + l31) * (SBK_PITCH * 2) + (16 * kk + 8 * hi) * 2); acc = MFMA32(kf, qf[kk], acc); }
                const bool diag = (s0 == q0);
                float lb[16], lk[16];
#pragma unroll
                for (int r = 0; r < 16; ++r) { const float z = acc[r] * 0.125f; const float sp = softplus_fast(z); float b_ = z - sp, k_ = -sp;
                    if (diag) { const bool valid = (s0 + crow(r, hi)) < t; b_ = valid ? b_ : -1e30f; k_ = valid ? k_ : 0.f; }
                    lb[r] = b_; lk[r] = k_; }
                float e[16], T[4], U[4];
#pragma unroll
                for (int q = 0; q < 4; ++q) { e[4 * q + 3] = 0.f; e[4 * q + 2] = lk[4 * q + 3]; e[4 * q + 1] = e[4 * q + 2] + lk[4 * q + 2]; e[4 * q] = e[4 * q + 1] + lk[4 * q + 1]; T[q] = e[4 * q] + lk[4 * q]; }
#pragma unroll
                for (int q = 0; q < 4; ++q) U[q] = __shfl_xor(T[q], 32);
                { const float st2 = T[3], st1 = st2 + T[2], st0 = st1 + T[1]; const float su2 = U[3], su1 = su2 + U[2], su0 = su1 + U[1];
                  const float x0 = hi ? 0.f : U[0], x1 = hi ? 0.f : U[1], x2 = hi ? 0.f : U[2], x3 = hi ? 0.f : U[3];
                  const float off[4] = {st0 + su0 + x0, st1 + su1 + x1, st2 + su2 + x2, x3};
                  const float total = st0 + T[0] + su0 + U[0];
#pragma unroll
                  for (int r = 0; r < 16; ++r) acc[r] = __expf(lb[r] + (cum + off[r >> 2] + e[r]));
                  cum += total; }
                bf16x8 pf[2];
#pragma unroll
                for (int ks = 0; ks < 2; ++ks) { v4u w; w.x = cvtpk(acc[8 * ks], acc[8 * ks + 1]); w.y = cvtpk(acc[8 * ks + 2], acc[8 * ks + 3]); w.z = cvtpk(acc[8 * ks + 4], acc[8 * ks + 5]); w.w = cvtpk(acc[8 * ks + 6], acc[8 * ks + 7]); pf[ks] = __builtin_bit_cast(bf16x8, w); }
#pragma unroll
                for (int dt = 0; dt < 2; ++dt)
#pragma unroll
                    for (int ks = 0; ks < 2; ++ks) { const LAS unsigned char* vp = Vb + (32 * dt + l31) * (MLV_PITCH * 2) + (32 * sub + 16 * ks + 4 * hi) * 2;
                        const u32x2 x0 = *(const LAS u32x2*)vp, x1 = *(const LAS u32x2*)(vp + 16);
                        v4u a; a.x = x0.x; a.y = x0.y; a.z = x1.x; a.w = x1.y; o[dt] = MFMA32(__builtin_bit_cast(bf16x8, a), pf[ks], o[dt]); }
                done = __all(cum < -110.f);
            }
        }
        if (lane == 0) flags[(i & 1) * 8 + wave] = done ? 1u : 0u;
        LAS unsigned char* nb = lds + ((i + 1) & 1) * SB_STAGE;
        *(LAS v4u*)(nb + lK) = rk; *(LAS u32x2*)(nb + lVt) = (u32x2){rv.x, rv.y}; *(LAS u32x2*)(nb + lVt + 8) = (u32x2){rv.z, rv.w};
        __syncthreads();
        unsigned nd = 0;
#pragma unroll
        for (int w8 = 0; w8 < 8; ++w8) nd += flags[(i & 1) * 8 + w8];
        if (nd == 8u) break;
    }
    store_OT(o, 1.0f, (LAS bf16_t*)(lds + 2 * SB_STAGE + 256) + wave * (32 * STG_PITCH), ymix + (rowb + q0) * DM + h * 64, lane);
    __syncthreads();
}

constexpr int RW_RAWW = 0, RW_RAWA = 2048, RW_RS = 4096, RW_KS = 6144, RW_VS = 8192;
constexpr int RW_CH0 = 10240, RW_CHSZ = 11328;
constexpr int RW_YB = RW_CH0 + 2 * RW_CHSZ;
constexpr int RW_MIX = RW_YB + 1024;
static_assert((RW_MIX + 256) * 4 <= 146432, "rwkv LDS map");
__device__ __forceinline__ float tanh_fast(float x) { return 1.f - 2.f * __builtin_amdgcn_rcpf(1.f + __expf(2.f * x)); }
__device__ __forceinline__ float sigmoid_fast(float x) { return __builtin_amdgcn_rcpf(1.f + __expf(-x)); }

#define MFMA16(a, b, c) __builtin_amdgcn_mfma_f32_16x16x32_bf16((a), (b), (c), 0, 0, 0)
constexpr int RW2_CH0 = 0, RW2_YB = 2 * RW_CHSZ, RW2_MIX = RW2_YB + 1024, RW2_STG = RW2_MIX + 448;
static_assert((RW2_STG + 2 * 3072) * 4 <= 146432, "rwkv LDS map");
__device__ __forceinline__ void rwkv_phase_scan(LAS float* sm, int tid, int lane, int wave, int blk, const bf16_t* __restrict__ proj, const float* __restrict__ mix, const float* __restrict__ w0, const float* __restrict__ a0,
                                           const float* __restrict__ k_k, const float* __restrict__ k_a, const float* __restrict__ r_k, const bf16_t* __restrict__ W2T, const bf16_t* __restrict__ A2T, const bf16_t* __restrict__ G2T,
                                           float* __restrict__ yraw, bf16_t* __restrict__ gout, float* __restrict__ bonus_out) {
    const int chain = blk >> 1, half = blk & 1, b = chain >> 3, h = chain & 7, l15 = lane & 15, kg = lane >> 4;
    const size_t rowb = (size_t)b * SEQ;
    constexpr int NCHUNK = SEQ / 32;
    if (tid < 256) sm[RW2_MIX + tid] = mix[1536 + tid];
    else if (tid < 448) { const int q = tid - 256; sm[RW2_MIX + tid] = mix[512 * (q >> 6) + h * 64 + (q & 63)]; }
    __syncthreads();
#define RW_SH8(CUR, PRV, M0, M1, OUT, PZ) do { const unsigned cu_[4] = {(CUR).x, (CUR).y, (CUR).z, (CUR).w}, pu_[4] = {(PRV).x, (PRV).y, (PRV).z, (PRV).w}; \
        const float mm_[8] = {(M0)[0], (M0)[1], (M0)[2], (M0)[3], (M1)[0], (M1)[1], (M1)[2], (M1)[3]}; \
        _Pragma("unroll") for (int q = 0; q < 4; ++q) { const float c0 = bflo(cu_[q]), c1 = bfhi(cu_[q]), p0 = bflo(pu_[q]) * (PZ), p1 = bfhi(pu_[q]) * (PZ); \
            OUT[2 * q] = c0 + (p0 - c0) * mm_[2 * q]; OUT[2 * q + 1] = c1 + (p1 - c1) * mm_[2 * q + 1]; } } while (0)
    if (wave < 4) {
        const int iA = 8 * wave + kg, iB = iA + 4, jseg = l15;
        float A0 = 0.f, A1 = 0.f, A2 = 0.f, A3 = 0.f, B0 = 0.f, B1 = 0.f, B2 = 0.f, B3 = 0.f;
        __syncthreads();
#pragma unroll 1
        for (int ch = 0; ch < NCHUNK; ++ch) {
            const int t0 = ch * 32;
            const LAS float* CHb = sm + RW2_CH0 + (ch & 1) * RW_CHSZ + 4 * jseg;
            const LAS float* CHv = sm + RW2_CH0 + (ch & 1) * RW_CHSZ + 10240 + iA;
            const LAS float* CHs = sm + RW2_CH0 + (ch & 1) * RW_CHSZ + 11264;
            f32x4 a4 = *(const LAS f32x4*)(CHb + 4096), wr4 = *(const LAS f32x4*)(CHb + 8192), w4 = *(const LAS f32x4*)(CHb), b4 = *(const LAS f32x4*)(CHb + 6144), k4 = *(const LAS f32x4*)(CHb + 2048);
            float vA = CHv[0], vB = CHv[4]; f32x2_t sc = *(const LAS f32x2_t*)(CHs);
#pragma unroll 2
            for (int t = 0; t < 32; ++t) {
                const int tq = (t + 1) & 31;
                const f32x4 a4n = *(const LAS f32x4*)(CHb + 4096 + tq * 64), wr4n = *(const LAS f32x4*)(CHb + 8192 + tq * 64), w4n = *(const LAS f32x4*)(CHb + tq * 64),
                            b4n = *(const LAS f32x4*)(CHb + 6144 + tq * 64), k4n = *(const LAS f32x4*)(CHb + 2048 + tq * 64);
                const float vAn = CHv[tq * 32], vBn = CHv[tq * 32 + 4]; const f32x2_t scn = *(const LAS f32x2_t*)(CHs + 2 * tq);
                float d1A = (A0 * a4[0] + A1 * a4[1]) + (A2 * a4[2] + A3 * a4[3]), d1B = (B0 * a4[0] + B1 * a4[1]) + (B2 * a4[2] + B3 * a4[3]);
                float d2A = (A0 * wr4[0] + A1 * wr4[1]) + (A2 * wr4[2] + A3 * wr4[3]), d2B = (B0 * wr4[0] + B1 * wr4[1]) + (B2 * wr4[2] + B3 * wr4[3]);
                d1A = rowsum16(d1A); d1B = rowsum16(d1B); d2A = rowsum16(d2A); d2B = rowsum16(d2B);
                const float yA = d2A + d1A * sc[0] + vA * sc[1], yB = d2B + d1B * sc[0] + vB * sc[1];
                A0 = A0 * w4[0] + (d1A * b4[0] + vA * k4[0]); A1 = A1 * w4[1] + (d1A * b4[1] + vA * k4[1]); A2 = A2 * w4[2] + (d1A * b4[2] + vA * k4[2]); A3 = A3 * w4[3] + (d1A * b4[3] + vA * k4[3]);
                B0 = B0 * w4[0] + (d1B * b4[0] + vB * k4[0]); B1 = B1 * w4[1] + (d1B * b4[1] + vB * k4[1]); B2 = B2 * w4[2] + (d1B * b4[2] + vB * k4[2]); B3 = B3 * w4[3] + (d1B * b4[3] + vB * k4[3]);
                if (jseg == 0) { sm[RW2_YB + t * 32 + iA] = yA; sm[RW2_YB + t * 32 + iB] = yB; }
                a4 = a4n; wr4 = wr4n; w4 = w4n; b4 = b4n; k4 = k4n; vA = vAn; vB = vBn; sc = scn;
            }
            WSYNC();
            { const int tt = lane >> 1, hh = lane & 1; const f32x4 yv = *(const LAS f32x4*)(sm + RW2_YB + tt * 32 + 8 * wave + 4 * hh);
              *(f32x4*)(yraw + (rowb + t0 + tt) * 512 + h * 64 + half * 32 + 8 * wave + 4 * hh) = yv; }
            __syncthreads();
        }
    } else if (wave < 6) {
        const int tp = wave - 4, tb = 16 * tp;
        LAS float* stg = sm + RW2_STG + tp * 3072;
        float w0c[4], a0c[4], kkc[4], kac[4], rkc[4];
#pragma unroll
        for (int nt = 0; nt < 4; ++nt) { const int c = h * 64 + 16 * nt + l15; w0c[nt] = w0[c]; a0c[nt] = a0[c]; kkc[nt] = k_k[c]; kac[nt] = k_a[c]; rkc[nt] = r_k[c]; }
        v4u ld[20];
#define PREP_ISSUE(T0) do { const int t0_ = (T0); { const size_t r_ = rowb + t0_ + tb + l15; const size_t rp_ = (t0_ + tb + l15 == 0) ? r_ : r_ - 1; \
            _Pragma("unroll") for (int lo = 0; lo < 2; ++lo) _Pragma("unroll") for (int ks = 0; ks < 2; ++ks) { const int col = 1536 + 64 * lo + 32 * ks + 8 * kg; \
                ld[(lo * 2 + ks) * 2] = *(const v4u*)(proj + r_ * L0P + col); ld[(lo * 2 + ks) * 2 + 1] = *(const v4u*)(proj + rp_ * L0P + col); } } \
            _Pragma("unroll") for (int ar = 0; ar < 3; ++ar) _Pragma("unroll") for (int i = 0; i < 2; ++i) { const int p_ = lane + 64 * i, row_ = p_ >> 3, c8_ = p_ & 7; \
                const size_t r_ = rowb + t0_ + tb + row_; const size_t rp_ = (t0_ + tb + row_ == 0) ? r_ : r_ - 1; const int col = 512 * ar + h * 64 + 8 * c8_; \
                ld[8 + (ar * 2 + i) * 2] = *(const v4u*)(proj + r_ * L0P + col); ld[8 + (ar * 2 + i) * 2 + 1] = *(const v4u*)(proj + rp_ * L0P + col); } } while (0)
#define PREP_BUILD(T0, NB) do { const int t0_ = (T0); LAS float* CHn = sm + RW2_CH0 + (NB) * RW_CHSZ; \
            f32x4 accw[4], acca[4]; \
            _Pragma("unroll") for (int nt = 0; nt < 4; ++nt) { accw[nt] = (f32x4){0.f, 0.f, 0.f, 0.f}; acca[nt] = (f32x4){0.f, 0.f, 0.f, 0.f}; } \
            { const float pz_ = (t0_ + tb + l15 == 0) ? 0.f : 1.f; \
              _Pragma("unroll") for (int lo = 0; lo < 2; ++lo) _Pragma("unroll") for (int ks = 0; ks < 2; ++ks) { float s_[8]; \
                const f32x4 m0 = *(const LAS f32x4*)(sm + RW2_MIX + 64 * lo + 32 * ks + 8 * kg), m1 = *(const LAS f32x4*)(sm + RW2_MIX + 64 * lo + 32 * ks + 8 * kg + 4); \
                RW_SH8(ld[(lo * 2 + ks) * 2], ld[(lo * 2 + ks) * 2 + 1], m0, m1, s_, pz_); \
                if (lo == 0) { _Pragma("unroll") for (int j = 0; j < 8; ++j) s_[j] = tanh_fast(s_[j]); } \
                v4u aw; aw.x = cvtpk(s_[0], s_[1]); aw.y = cvtpk(s_[2], s_[3]); aw.z = cvtpk(s_[4], s_[5]); aw.w = cvtpk(s_[6], s_[7]); const bf16x8 af = __builtin_bit_cast(bf16x8, aw); \
                const bf16_t* WT = lo ? A2T : W2T; \
                _Pragma("unroll") for (int nt = 0; nt < 4; ++nt) { const bf16x8 bfr = *(const bf16x8*)(WT + (size_t)(h * 64 + 16 * nt + l15) * 64 + 32 * ks + 8 * kg); \
                    if (lo == 0) accw[nt] = MFMA16(af, bfr, accw[nt]); else acca[nt] = MFMA16(af, bfr, acca[nt]); } } } \
            _Pragma("unroll") for (int ar = 0; ar < 3; ++ar) _Pragma("unroll") for (int i = 0; i < 2; ++i) { const int p_ = lane + 64 * i, row_ = p_ >> 3, c8_ = p_ & 7; float s_[8]; \
                const float pz_ = (t0_ + tb + row_ == 0) ? 0.f : 1.f; const f32x4 m0 = *(const LAS f32x4*)(sm + RW2_MIX + 256 + ar * 64 + c8_ * 8), m1 = *(const LAS f32x4*)(sm + RW2_MIX + 256 + ar * 64 + c8_ * 8 + 4); \
                RW_SH8(ld[8 + (ar * 2 + i) * 2], ld[8 + (ar * 2 + i) * 2 + 1], m0, m1, s_, pz_); \
                *(LAS f32x4*)(stg + ar * 1024 + row_ * 64 + c8_ * 8) = (f32x4){s_[0], s_[1], s_[2], s_[3]}; *(LAS f32x4*)(stg + ar * 1024 + row_ * 64 + c8_ * 8 + 4) = (f32x4){s_[4], s_[5], s_[6], s_[7]}; } \
            WSYNC(); \
            PREP_ISSUE(((T0) + 32 < SEQ) ? (T0) + 32 : (T0)); \
            _Pragma("unroll") for (int rg = 0; rg < 4; ++rg) { const int tl = 4 * kg + rg, t = tb + tl; \
                float r_[4], k_[4], v_[4], kkv[4], nrm2 = 0.f; \
                _Pragma("unroll") for (int nt = 0; nt < 4; ++nt) { r_[nt] = stg[tl * 64 + 16 * nt + l15]; k_[nt] = stg[1024 + tl * 64 + 16 * nt + l15]; v_[nt] = stg[2048 + tl * 64 + 16 * nt + l15]; \
                    kkv[nt] = k_[nt] * kkc[nt]; nrm2 += kkv[nt] * kkv[nt]; } \
                nrm2 = rowsum16(nrm2); const float rn = __builtin_amdgcn_rsqf(fmaxf(nrm2, 1e-24f)); \
                float br = 0.f, kr = 0.f, bon = 0.f; \
                _Pragma("unroll") for (int nt = 0; nt < 4; ++nt) { const int j = 16 * nt + l15; \
                    const float wsum = w0c[nt] + accw[nt][rg]; const float logw = -softplus_fast(-wsum) - 0.5f; const float dec = __expf(-__expf(logw)); \
                    const float a_ = sigmoid_fast(a0c[nt] + acca[nt][rg]); const float kn = kkv[nt] * rn; \
                    const float k2 = k_[nt] * (1.f + (a_ - 1.f) * kac[nt]); const float bv = kn * a_; \
                    br += bv * r_[nt]; kr += k2 * r_[nt]; bon += r_[nt] * k2 * rkc[nt]; \
                    CHn[t * 64 + j] = dec; CHn[2048 + t * 64 + j] = k2; CHn[4096 + t * 64 + j] = -kn; CHn[6144 + t * 64 + j] = bv; CHn[8192 + t * 64 + j] = dec * r_[nt]; \
                    if ((nt >> 1) == half) CHn[10240 + t * 32 + (j & 31)] = v_[nt]; } \
                br = rowsum16(br); kr = rowsum16(kr); bon = rowsum16(bon); \
                if (l15 == 0) { CHn[11264 + 2 * t] = br; CHn[11264 + 2 * t + 1] = kr; if (half == 0) bonus_out[(rowb + t0_ + t) * 8 + h] = bon; } } \
            WSYNC(); } while (0)
        PREP_ISSUE(0);
        PREP_BUILD(0, 0);
        __syncthreads();
#pragma unroll 1
        for (int ch = 0; ch < NCHUNK; ++ch) {
            if (ch + 1 < NCHUNK) PREP_BUILD(ch * 32 + 32, (ch + 1) & 1);
            __syncthreads();
        }
#undef PREP_ISSUE
#undef PREP_BUILD
    } else {
        const int tp = wave - 6, tb = 16 * tp;
        v4u ld[8];
#define G_ISSUE(T0) do { const int t0_ = (T0); const size_t r_ = rowb + t0_ + tb + l15; const size_t rp_ = (t0_ + tb + l15 == 0) ? r_ : r_ - 1; \
            _Pragma("unroll") for (int ks = 0; ks < 4; ++ks) { const int col = 1664 + 32 * ks + 8 * kg; ld[2 * ks] = *(const v4u*)(proj + r_ * L0P + col); ld[2 * ks + 1] = *(const v4u*)(proj + rp_ * L0P + col); } } while (0)
#define G_BUILD(T0) do { const int t0_ = (T0); f32x4 accg[2] = {(f32x4){0.f, 0.f, 0.f, 0.f}, (f32x4){0.f, 0.f, 0.f, 0.f}}; const float pz_ = (t0_ + tb + l15 == 0) ? 0.f : 1.f; \
            _Pragma("unroll") for (int ks = 0; ks < 4; ++ks) { float s_[8]; \
                const f32x4 m0 = *(const LAS f32x4*)(sm + RW2_MIX + 128 + 32 * ks + 8 * kg), m1 = *(const LAS f32x4*)(sm + RW2_MIX + 128 + 32 * ks + 8 * kg + 4); \
                RW_SH8(ld[2 * ks], ld[2 * ks + 1], m0, m1, s_, pz_); \
                _Pragma("unroll") for (int j = 0; j < 8; ++j) s_[j] = sigmoid_fast(s_[j]); \
                v4u aw; aw.x = cvtpk(s_[0], s_[1]); aw.y = cvtpk(s_[2], s_[3]); aw.z = cvtpk(s_[4], s_[5]); aw.w = cvtpk(s_[6], s_[7]); const bf16x8 af = __builtin_bit_cast(bf16x8, aw); \
                _Pragma("unroll") for (int nt = 0; nt < 2; ++nt) { const bf16x8 bfr = *(const bf16x8*)(G2T + (size_t)(h * 64 + half * 32 + 16 * nt + l15) * 128 + 32 * ks + 8 * kg); accg[nt] = MFMA16(af, bfr, accg[nt]); } } \
            G_ISSUE(((T0) + 32 < SEQ) ? (T0) + 32 : (T0)); \
            _Pragma("unroll") for (int nt = 0; nt < 2; ++nt) _Pragma("unroll") for (int rg = 0; rg < 4; ++rg) \
                gout[(rowb + t0_ + tb + 4 * kg + rg) * 512 + h * 64 + half * 32 + 16 * nt + l15] = (bf16_t)f2bf(accg[nt][rg]); } while (0)
        G_ISSUE(0);
        G_BUILD(0);
        __syncthreads();
#pragma unroll 1
        for (int ch = 0; ch < NCHUNK; ++ch) {
            if (ch + 1 < NCHUNK) G_BUILD(ch * 32 + 32);
            __syncthreads();
        }
#undef G_ISSUE
#undef G_BUILD
    }
#undef RW_SH8
    __syncthreads();
}

constexpr int CK_BK = 0, CK_AR = 4608, CK_BBT = 9216, CK_KBT = 12288, CK_VT = 15360, CK_GC = 16896, CK_TT = 17152, CK_SLOT = 18688, CK_NSLOT = 6, CK_NBUILD = 5;
constexpr int CK_STG = CK_SLOT * CK_NSLOT;
constexpr int CK_MIX = CK_STG + CK_NBUILD * 6144;
constexpr int CK_FLAGS = CK_MIX + 448 * 4;
static_assert(CK_FLAGS + 64 <= 146432, "rwkv chunked LDS map");
__device__ __forceinline__ void rwkv_phase(LAS float* smf, int tid, int lane, int wave, int blk, const bf16_t* __restrict__ proj, const float* __restrict__ mix, const float* __restrict__ w0, const float* __restrict__ a0,
                                           const float* __restrict__ k_k, const float* __restrict__ k_a, const float* __restrict__ r_k, const bf16_t* __restrict__ W2T, const bf16_t* __restrict__ A2T, const bf16_t* __restrict__ G2T,
                                           float* __restrict__ yraw, bf16_t* __restrict__ gout, float* __restrict__ bonus_out) {
    LAS unsigned char* lds = (LAS unsigned char*)smf;
    LAS float* mixs = (LAS float*)(lds + CK_MIX);
    volatile LAS unsigned* flags = (volatile LAS unsigned*)(lds + CK_FLAGS);
    const int chain = blk >> 1, ihalf = blk & 1, b = chain >> 3, h = chain & 7, l15 = lane & 15, kg = lane >> 4, l31 = lane & 31, hi = lane >> 5;
    const size_t rowb = (size_t)b * SEQ;
    constexpr int NCH = SEQ / 16;
    if (tid < 256) mixs[tid] = mix[1536 + tid];
    else if (tid < 448) { const int q = tid - 256; mixs[tid] = mix[512 * (q >> 6) + h * 64 + (q & 63)]; }
    if (tid < 16) flags[tid] = 0u;
    for (int q = tid; q < CK_NSLOT * 384; q += NWAVES * 64) *(LAS unsigned*)(lds + (q / 384) * CK_SLOT + CK_TT + (q % 384) * 4) = 0u;
    __syncthreads();
#define RW_SH8(CUR, PRV, M0, M1, OUT, PZ) do { const unsigned cu_[4] = {(CUR).x, (CUR).y, (CUR).z, (CUR).w}, pu_[4] = {(PRV).x, (PRV).y, (PRV).z, (PRV).w}; \
        const float mm_[8] = {(M0)[0], (M0)[1], (M0)[2], (M0)[3], (M1)[0], (M1)[1], (M1)[2], (M1)[3]}; \
        _Pragma("unroll") for (int q = 0; q < 4; ++q) { const float c0 = bflo(cu_[q]), c1 = bfhi(cu_[q]), p0 = bflo(pu_[q]) * (PZ), p1 = bfhi(pu_[q]) * (PZ); \
            OUT[2 * q] = c0 + (p0 - c0) * mm_[2 * q]; OUT[2 * q + 1] = c1 + (p1 - c1) * mm_[2 * q + 1]; } } while (0)
    if (wave == 0) {
        f32x16 ST[2];
#pragma unroll
        for (int r = 0; r < 16; ++r) { ST[0][r] = 0.f; ST[1][r] = 0.f; }
#pragma unroll 1
        for (int k = 0; k < NCH; ++k) {
#if defined(PROBE_STAMPS)
            const unsigned tw0_ = (unsigned)__builtin_amdgcn_s_memrealtime();
#endif
            { const unsigned want = (unsigned)(k + 1); const int sl = k % CK_NSLOT; while (flags[sl] != want) __builtin_amdgcn_s_sleep(1); }
#if defined(PROBE_STAMPS)
            if (blk == 0 && lane == 0) ((volatile LAS unsigned*)(lds + 146432 + 320))[16 + 24] += (unsigned)__builtin_amdgcn_s_memrealtime() - tw0_;
#endif
            asm volatile("" ::: "memory");
            const LAS unsigned char* im = lds + (k % CK_NSLOT) * CK_SLOT;
            f32x16 G;
#pragma unroll
            for (int r = 0; r < 16; ++r) G[r] = 0.f;
#pragma unroll
            for (int kk = 0; kk < 4; ++kk) { const bf16x8 fa = *(const LAS bf16x8*)(im + CK_BK + l31 * 144 + (16 * kk + 8 * hi) * 2), fb = *(const LAS bf16x8*)(im + CK_AR + l31 * 144 + (16 * kk + 8 * hi) * 2); G = MFMA32(fa, fb, G); }
            { const int tcol = l31 & 15; const bool strict = l31 < 16;
#pragma unroll
              for (int r = 0; r < 16; ++r) { const int srow = crow(r & 7, hi); const bool keep = strict ? (srow < tcol) : (srow <= tcol); G[r] = keep ? G[r] : 0.f; } }
            const bf16x8 gB = pack8(G[0], G[1], G[2], G[3], G[4], G[5], G[6], G[7]), gK = pack8(G[8], G[9], G[10], G[11], G[12], G[13], G[14], G[15]);
            f32x16 XT;
#pragma unroll
            for (int r = 0; r < 16; ++r) XT[r] = 0.f;
#pragma unroll
            for (int jt = 0; jt < 2; ++jt)
#pragma unroll
                for (int sp = 0; sp < 2; ++sp) { const LAS unsigned char* ap = im + CK_AR + l31 * 144 + (32 * jt + 16 * sp + 4 * hi) * 2;
                    const u32x2 x0 = *(const LAS u32x2*)ap, x1 = *(const LAS u32x2*)(ap + 16); v4u aw; aw.x = x0.x; aw.y = x0.y; aw.z = x1.x; aw.w = x1.y;
                    const bf16x8 sb_ = pack8(ST[jt][8 * sp], ST[jt][8 * sp + 1], ST[jt][8 * sp + 2], ST[jt][8 * sp + 3], ST[jt][8 * sp + 4], ST[jt][8 * sp + 5], ST[jt][8 * sp + 6], ST[jt][8 * sp + 7]);
                    XT = MFMA32(__builtin_bit_cast(bf16x8, aw), sb_, XT); }
            bf16x8 vP;
            { const LAS unsigned char* vp = im + CK_VT + l31 * 48 + (4 * hi) * 2; const u32x2 x0 = *(const LAS u32x2*)vp, x1 = *(const LAS u32x2*)(vp + 16); v4u vw; vw.x = x0.x; vw.y = x0.y; vw.z = x1.x; vw.w = x1.y;
              vP = __builtin_bit_cast(bf16x8, vw); XT = MFMA32(gK, vP, XT); }
            bf16x8 uP;
            { const LAS unsigned char* tp = im + CK_TT + l31 * 48 + (4 * hi) * 2; const u32x2 x0 = *(const LAS u32x2*)tp, x1 = *(const LAS u32x2*)(tp + 16); v4u tw; tw.x = x0.x; tw.y = x0.y; tw.z = x1.x; tw.w = x1.y;
              f32x16 UT;
#pragma unroll
              for (int r = 0; r < 16; ++r) UT[r] = 0.f;
              UT = MFMA32(__builtin_bit_cast(bf16x8, tw), pack8(XT[0], XT[1], XT[2], XT[3], XT[4], XT[5], XT[6], XT[7]), UT);
              uP = pack8(UT[0], UT[1], UT[2], UT[3], UT[4], UT[5], UT[6], UT[7]); }
            XT = MFMA32(gB, uP, XT);
            { float* yp = yraw + (rowb + 16 * k) * 512 + h * 64 + 32 * ihalf + l31;
#pragma unroll
              for (int q = 0; q < 8; ++q) yp[(size_t)crow(q, hi) * 512] = XT[8 + q]; }
            { const LAS float* gc = (const LAS float*)(im + CK_GC);
#pragma unroll
              for (int jt = 0; jt < 2; ++jt)
#pragma unroll
                  for (int r = 0; r < 16; ++r) ST[jt][r] *= gc[32 * jt + crow(r, hi)]; }
#pragma unroll
            for (int jt = 0; jt < 2; ++jt) { const LAS unsigned char* bp = im + CK_BBT + (32 * jt + l31) * 48 + (4 * hi) * 2; const LAS unsigned char* kp = im + CK_KBT + (32 * jt + l31) * 48 + (4 * hi) * 2;
                const u32x2 b0 = *(const LAS u32x2*)bp, b1 = *(const LAS u32x2*)(bp + 16), k0 = *(const LAS u32x2*)kp, k1 = *(const LAS u32x2*)(kp + 16);
                v4u a1; a1.x = b0.x; a1.y = b0.y; a1.z = b1.x; a1.w = b1.y; v4u a2; a2.x = k0.x; a2.y = k0.y; a2.z = k1.x; a2.w = k1.y;
                ST[jt] = MFMA32(__builtin_bit_cast(bf16x8, a1), uP, ST[jt]); ST[jt] = MFMA32(__builtin_bit_cast(bf16x8, a2), vP, ST[jt]); }
            WSYNC();
            if (lane == 0) flags[8] = (unsigned)(k + 1);
        }
    } else if (wave <= CK_NBUILD) {
        const int pw = wave - 1;
        LAS bf16_t* stg = (LAS bf16_t*)(lds + CK_STG) + pw * 3072;
        float w0c[4], a0c[4], kkc[4], kac[4], rkc[4];
#pragma unroll
        for (int nt = 0; nt < 4; ++nt) { const int c = h * 64 + 16 * nt + l15; w0c[nt] = w0[c]; a0c[nt] = a0[c]; kkc[nt] = k_k[c]; kac[nt] = k_a[c]; rkc[nt] = r_k[c]; }
        v4u ld[20];
#define CK_ISSUE_A(T0) do { const int t0_ = (T0); const size_t r_ = rowb + t0_ + l15; const size_t rp_ = (t0_ + l15 == 0) ? r_ : r_ - 1; \
            _Pragma("unroll") for (int lo = 0; lo < 2; ++lo) _Pragma("unroll") for (int ks = 0; ks < 2; ++ks) { const int col = 1536 + 64 * lo + 32 * ks + 8 * kg; \
                ld[(lo * 2 + ks) * 2] = *(const v4u*)(proj + r_ * L0P + col); ld[(lo * 2 + ks) * 2 + 1] = *(const v4u*)(proj + rp_ * L0P + col); } } while (0)
#define CK_ISSUE_B(T0) do { const int t0_ = (T0); \
            _Pragma("unroll") for (int ar = 0; ar < 3; ++ar) _Pragma("unroll") for (int i = 0; i < 2; ++i) { const int p_ = lane + 64 * i, row_ = p_ >> 3, c8_ = p_ & 7; \
                const size_t r_ = rowb + t0_ + row_; const size_t rp_ = (t0_ + row_ == 0) ? r_ : r_ - 1; const int col = 512 * ar + h * 64 + 8 * c8_; \
                ld[8 + (ar * 2 + i) * 2] = *(const v4u*)(proj + r_ * L0P + col); ld[8 + (ar * 2 + i) * 2 + 1] = *(const v4u*)(proj + rp_ * L0P + col); } } while (0)
#define CK_ISSUE(T0) do { CK_ISSUE_A(T0); CK_ISSUE_B(T0); } while (0)
        CK_ISSUE(16 * pw);
#pragma unroll 1
        for (int k = pw; k < NCH; k += CK_NBUILD) {
            const int t0 = 16 * k;
#if defined(PROBE_STAMPS)
            const unsigned ts0_ = (unsigned)__builtin_amdgcn_s_memrealtime();
#endif
            f32x4 accw[4], acca[4];
#pragma unroll
            for (int nt = 0; nt < 4; ++nt) { accw[nt] = (f32x4){0.f, 0.f, 0.f, 0.f}; acca[nt] = (f32x4){0.f, 0.f, 0.f, 0.f}; }
            { const float pz_ = (t0 + l15 == 0) ? 0.f : 1.f;
#pragma unroll
              for (int lo = 0; lo < 2; ++lo)
#pragma unroll
                for (int ks = 0; ks < 2; ++ks) { float s_[8];
                    const f32x4 m0 = *(const LAS f32x4*)(mixs + 64 * lo + 32 * ks + 8 * kg), m1 = *(const LAS f32x4*)(mixs + 64 * lo + 32 * ks + 8 * kg + 4);
                    RW_SH8(ld[(lo * 2 + ks) * 2], ld[(lo * 2 + ks) * 2 + 1], m0, m1, s_, pz_);
                    if (lo == 0) {
#pragma unroll
                        for (int j = 0; j < 8; ++j) s_[j] = tanh_fast(s_[j]); }
                    const bf16x8 af = pack8(s_[0], s_[1], s_[2], s_[3], s_[4], s_[5], s_[6], s_[7]);
                    const bf16_t* WT = lo ? A2T : W2T;
#pragma unroll
                    for (int nt = 0; nt < 4; ++nt) { const bf16x8 bfr = *(const bf16x8*)(WT + (size_t)(h * 64 + 16 * nt + l15) * 64 + 32 * ks + 8 * kg);
                        if (lo == 0) accw[nt] = MFMA16(af, bfr, accw[nt]); else acca[nt] = MFMA16(af, bfr, acca[nt]); } } }
#pragma unroll
            for (int ar = 0; ar < 3; ++ar)
#pragma unroll
                for (int i = 0; i < 2; ++i) { const int p_ = lane + 64 * i, row_ = p_ >> 3, c8_ = p_ & 7; float s_[8];
                    const float pz_ = (t0 + row_ == 0) ? 0.f : 1.f; const f32x4 m0 = *(const LAS f32x4*)(mixs + 256 + ar * 64 + c8_ * 8), m1 = *(const LAS f32x4*)(mixs + 256 + ar * 64 + c8_ * 8 + 4);
                    RW_SH8(ld[8 + (ar * 2 + i) * 2], ld[8 + (ar * 2 + i) * 2 + 1], m0, m1, s_, pz_);
                    *(LAS bf16x8*)(stg + ar * 1024 + row_ * 64 + c8_ * 8) = pack8(s_[0], s_[1], s_[2], s_[3], s_[4], s_[5], s_[6], s_[7]); }
            WSYNC();
#if defined(PROBE_STAMPS)
            if (blk == 0 && wave == 1 && lane == 0) ((volatile LAS unsigned*)(lds + 146432 + 320))[16 + 26] += (unsigned)__builtin_amdgcn_s_memrealtime() - ts0_;
#endif
#if defined(PROBE_STAMPS)
            const unsigned tb0_ = (unsigned)__builtin_amdgcn_s_memrealtime();
#endif
            { const int need = k - (CK_NSLOT - 1); if (need > 0) { while ((int)flags[8] < need) __builtin_amdgcn_s_sleep(2); } }
#if defined(PROBE_STAMPS)
            if (blk == 0 && wave == 1 && lane == 0) ((volatile LAS unsigned*)(lds + 146432 + 320))[16 + 25] += (unsigned)__builtin_amdgcn_s_memrealtime() - tb0_;
#endif
            asm volatile("" ::: "memory");
            LAS unsigned char* im = lds + (k % CK_NSLOT) * CK_SLOT;
#if defined(PROBE_STAMPS)
            const unsigned ts1_ = (unsigned)__builtin_amdgcn_s_memrealtime();
#endif
            float lwv[4][4], av[4][4], knv[4][4];
#pragma unroll
            for (int rg = 0; rg < 4; ++rg) { const int tl = 4 * kg + rg;
                float kkv[4], nrm2 = 0.f, vv[4], rr_[4], kr_[4];
#pragma unroll
                for (int nt = 0; nt < 4; ++nt) { rr_[nt] = bf2f(stg[tl * 64 + 16 * nt + l15]); kr_[nt] = bf2f(stg[1024 + tl * 64 + 16 * nt + l15]); vv[nt] = bf2f(stg[2048 + tl * 64 + 16 * nt + l15]);
                    kkv[nt] = kr_[nt] * kkc[nt]; nrm2 += kkv[nt] * kkv[nt]; }
                nrm2 = rowsum16(nrm2); const float rn = __builtin_amdgcn_rsqf(fmaxf(nrm2, 1e-24f));
                float bon = 0.f;
#pragma unroll
                for (int nt = 0; nt < 4; ++nt) {
                    const float wsum = w0c[nt] + accw[nt][rg]; lwv[nt][rg] = -0.6065306597126334f * sigmoid_fast(wsum);
                    const float a_ = sigmoid_fast(a0c[nt] + acca[nt][rg]); av[nt][rg] = a_; knv[nt][rg] = kkv[nt] * rn;
                    const float k2 = kr_[nt] * (1.f + (a_ - 1.f) * kac[nt]); stg[1024 + tl * 64 + 16 * nt + l15] = bf1(k2);
                    bon += rr_[nt] * k2 * rkc[nt];
                    if ((nt >> 1) == ihalf) *(LAS bf16_t*)(im + CK_VT + (16 * (nt & 1) + l15) * 48 + tl * 2) = bf1(vv[nt]);
                }
                bon = rowsum16(bon);
                if (l15 == 0 && ihalf == 0) bonus_out[(rowb + t0 + tl) * 8 + h] = bon;
            }
            CK_ISSUE_A((k + CK_NBUILD < NCH) ? t0 + 16 * CK_NBUILD : t0);
#pragma unroll
            for (int nt = 0; nt < 4; ++nt) {
                float L[4]; L[0] = lwv[nt][0]; L[1] = L[0] + lwv[nt][1]; L[2] = L[1] + lwv[nt][2]; L[3] = L[2] + lwv[nt][3];
                const float T0 = __shfl(L[3], l15), T1 = __shfl(L[3], 16 + l15), T2 = __shfl(L[3], 32 + l15), T3 = __shfl(L[3], 48 + l15);
                const float off = (kg > 0 ? T0 : 0.f) + (kg > 1 ? T1 : 0.f) + (kg > 2 ? T2 : 0.f), LC = (T0 + T1) + (T2 + T3);
                const int j = 16 * nt + l15;
                unsigned bb2[2], kb2[2];
                const float gC = __expf(LC); float eprev = __expf(off);
#pragma unroll
                for (int rg = 0; rg < 4; ++rg) { const int tl = 4 * kg + rg; const float Lt = off + L[rg], e1 = __expf(Lt), e2 = __builtin_amdgcn_rcpf(e1), e3 = eprev, e4 = gC * e2; eprev = e1;
                    const float kn = knv[nt][rg], bvv = kn * av[nt][rg], k2 = bf2f(stg[1024 + tl * 64 + j]), rr2 = bf2f(stg[tl * 64 + j]);
                    *(LAS bf16_t*)(im + CK_BK + tl * 144 + j * 2) = bf1(bvv * e2); *(LAS bf16_t*)(im + CK_BK + (16 + tl) * 144 + j * 2) = bf1(k2 * e2);
                    *(LAS bf16_t*)(im + CK_AR + tl * 144 + j * 2) = bf1(-kn * e3); *(LAS bf16_t*)(im + CK_AR + (16 + tl) * 144 + j * 2) = bf1(rr2 * e1);
                    const unsigned bq = bf1(bvv * e4), kq = bf1(k2 * e4);
                    if (rg & 1) { bb2[rg >> 1] |= bq << 16; kb2[rg >> 1] |= kq << 16; } else { bb2[rg >> 1] = bq; kb2[rg >> 1] = kq; } }
                *(LAS u32x2*)(im + CK_BBT + j * 48 + (4 * kg) * 2) = (u32x2){bb2[0], bb2[1]}; *(LAS u32x2*)(im + CK_KBT + j * 48 + (4 * kg) * 2) = (u32x2){kb2[0], kb2[1]};
                if (kg == 0) *(LAS float*)(im + CK_GC + j * 4) = gC;
            }
            WSYNC();
#if defined(PROBE_STAMPS)
            const unsigned ts2_ = (unsigned)__builtin_amdgcn_s_memrealtime();
            if (blk == 0 && wave == 1 && lane == 0) ((volatile LAS unsigned*)(lds + 146432 + 320))[16 + 27] += ts2_ - ts1_;
#endif
            {
                f32x4 nacc = {0.f, 0.f, 0.f, 0.f};
#pragma unroll
                for (int ks = 0; ks < 2; ++ks) { const bf16x8 fa = *(const LAS bf16x8*)(im + CK_BK + l15 * 144 + (32 * ks + 8 * kg) * 2), fb = *(const LAS bf16x8*)(im + CK_AR + l15 * 144 + (32 * ks + 8 * kg) * 2); nacc = MFMA16(fa, fb, nacc); }
#pragma unroll
                for (int rg = 0; rg < 4; ++rg) nacc[rg] = ((4 * kg + rg) < l15) ? nacc[rg] : 0.f;
                float Tr[16];
#pragma unroll
                for (int t = 0; t < 16; ++t) { float acc_ = (l15 == t) ? 1.f : 0.f;
#pragma unroll
                    for (int s2 = 0; s2 < t; ++s2) acc_ += Tr[s2] * rl(nacc[s2 & 3], t + 16 * (s2 >> 2));
                    Tr[t] = acc_; }
                if (kg == 0) {
#pragma unroll
                    for (int t = 0; t < 16; ++t) *(LAS bf16_t*)(im + CK_TT + t * 48 + l15 * 2) = bf1(Tr[t]); }
            }
            WSYNC();
#if defined(PROBE_STAMPS)
            if (blk == 0 && wave == 1 && lane == 0) ((volatile LAS unsigned*)(lds + 146432 + 320))[16 + 28] += (unsigned)__builtin_amdgcn_s_memrealtime() - ts2_;
#endif
            if (lane == 0) flags[k % CK_NSLOT] = (unsigned)(k + 1);
            CK_ISSUE_B((k + CK_NBUILD < NCH) ? t0 + 16 * CK_NBUILD : t0);
        }
#undef CK_ISSUE
#undef CK_ISSUE_A
#undef CK_ISSUE_B
    } else {
        const int gq = wave - 6;
        v4u ld[8];
#define G_ISSUE(T0) do { const int t0_ = (T0); const size_t r_ = rowb + t0_ + l15; const size_t rp_ = (t0_ + l15 == 0) ? r_ : r_ - 1; \
            _Pragma("unroll") for (int ks = 0; ks < 4; ++ks) { const int col = 1664 + 32 * ks + 8 * kg; ld[2 * ks] = *(const v4u*)(proj + r_ * L0P + col); ld[2 * ks + 1] = *(const v4u*)(proj + rp_ * L0P + col); } } while (0)
        G_ISSUE(16 * gq);
#pragma unroll 1
        for (int k = gq; k < NCH; k += 2) {
            const int t0 = 16 * k;
            f32x4 accg[2] = {(f32x4){0.f, 0.f, 0.f, 0.f}, (f32x4){0.f, 0.f, 0.f, 0.f}}; const float pz_ = (t0 + l15 == 0) ? 0.f : 1.f;
#pragma unroll
            for (int ks = 0; ks < 4; ++ks) { float s_[8];
                const f32x4 m0 = *(const LAS f32x4*)(mixs + 128 + 32 * ks + 8 * kg), m1 = *(const LAS f32x4*)(mixs + 128 + 32 * ks + 8 * kg + 4);
                RW_SH8(ld[2 * ks], ld[2 * ks + 1], m0, m1, s_, pz_);
#pragma unroll
                for (int j = 0; j < 8; ++j) s_[j] = sigmoid_fast(s_[j]);
                const bf16x8 af = pack8(s_[0], s_[1], s_[2], s_[3], s_[4], s_[5], s_[6], s_[7]);
#pragma unroll
                for (int nt = 0; nt < 2; ++nt) { const bf16x8 bfr = *(const bf16x8*)(G2T + (size_t)(h * 64 + ihalf * 32 + 16 * nt + l15) * 128 + 32 * ks + 8 * kg); accg[nt] = MFMA16(af, bfr, accg[nt]); } }
            G_ISSUE((k + 2 < NCH) ? t0 + 32 : t0);
#pragma unroll
            for (int nt = 0; nt < 2; ++nt)
#pragma unroll
                for (int rg = 0; rg < 4; ++rg) gout[(rowb + t0 + 4 * kg + rg) * 512 + h * 64 + ihalf * 32 + 16 * nt + l15] = bf1(accg[nt][rg]);
        }
#undef G_ISSUE
    }
#undef RW_SH8
    __syncthreads();
}

template <bool ST = true> __device__ __forceinline__ void rwkv_post_all(const float* __restrict__ yraw, const bf16_t* __restrict__ proj, const float* __restrict__ mix, const float* __restrict__ bonus, const bf16_t* __restrict__ gbuf,
                                              const float* __restrict__ ln_g, const float* __restrict__ ln_b, bf16_t* __restrict__ ymix, int gw, int NGW, int lane) {
    for (int m = gw; m < M; m += NGW) {
        const bool has_prev = (m & (SEQ - 1)) != 0;
        float y[8], cv[8], pv[8], gg[8], bo[8];
#pragma unroll
        for (int h = 0; h < 8; ++h) { const int c = h * 64 + lane; y[h] = yraw[(size_t)m * 512 + c]; cv[h] = bf2f(proj[(size_t)m * L0P + 1024 + c]);
            pv[h] = bf2f(proj[(size_t)(has_prev ? m - 1 : m) * L0P + 1024 + c]); gg[h] = bf2f(gbuf[(size_t)m * 512 + c]); bo[h] = bonus[(size_t)m * 8 + h]; }
#pragma unroll
        for (int h = 0; h < 8; ++h) { const int c = h * 64 + lane;
            const float mu = wave_sum_dpp(y[h]) * (1.f / 64.f), d = y[h] - mu, var = wave_sum_dpp(d * d) * (1.f / 64.f);
            const float yn = d * __builtin_amdgcn_rsqf(var + 64e-5f) * ln_g[c] + ln_b[c];
            const float pvv = has_prev ? pv[h] : 0.f;
            const float v_s = cv[h] + (pvv - cv[h]) * mix[1024 + c];
            const float o = (yn + bo[h] * v_s) * gg[h];
            if (ST) ymix[(size_t)m * DM + c] = (bf16_t)f2bf(o); else asm volatile("" :: "v"(o)); }
    }
}


__device__ __forceinline__ void ssd_conv_tile(int it, int lane, LAS bf16_t* scr, const bf16_t* __restrict__ proj, const float* __restrict__ cw, const float* __restrict__ cb,
                                              bf16_t* __restrict__ xbc, bf16_t* __restrict__ xst, bf16_t* __restrict__ bt) {
    const int tt = it >> 4, ct = it & 15, m0 = tt * 64, b = m0 >> 11, t0 = m0 & (SEQ - 1), c = ct * 64 + lane;
    const float w0 = cw[c], w1 = cw[1024 + c], w2 = cw[2048 + c], w3 = cw[3072 + c], bias = cb[c];
    const bf16_t* src = proj + (size_t)m0 * L0P + 2304 + c;
    bf16_t raw[67];
    const int lo = (t0 > 0) ? -3 : 0;
#pragma unroll
    for (int t = -3; t < 64; ++t) raw[t + 3] = src[(ptrdiff_t)((t < lo) ? lo : t) * L0P];
    float u3 = (t0 > 0) ? bf2f(raw[0]) : 0.f, u2 = (t0 > 0) ? bf2f(raw[1]) : 0.f, u1 = (t0 > 0) ? bf2f(raw[2]) : 0.f;
#pragma unroll
    for (int t = 0; t < 64; ++t) {
        const float u = bf2f(raw[t + 3]);
        const float y = bias + w0 * u3 + w1 * u2 + w2 * u1 + w3 * u;
        const bf16_t o = bf1(y * __builtin_amdgcn_rcpf(1.f + __expf(-y)));
        xbc[(size_t)(m0 + t) * 1024 + c] = o;
        scr[t * STG_PITCH + lane] = o;
        u3 = u2; u2 = u1; u1 = u;
    }
    WSYNC();
    if (ct < 12) {
        bf16_t* dst = (ct < 8) ? xst + ((size_t)(b * 8 + ct) * 64) * SEQ + t0 : bt + ((size_t)(b * 2 + ((ct - 8) >> 1)) * 128 + ((ct - 8) & 1) * 64) * SEQ + t0;
#pragma unroll
        for (int i = 0; i < 8; ++i) { const int d = i * 8 + (lane >> 3), tc = lane & 7; const LAS bf16_t* p = scr + (tc * 8) * STG_PITCH + d;
            v4u o; o.x = (unsigned)p[0] | ((unsigned)p[STG_PITCH] << 16); o.y = (unsigned)p[2 * STG_PITCH] | ((unsigned)p[3 * STG_PITCH] << 16);
            o.z = (unsigned)p[4 * STG_PITCH] | ((unsigned)p[5 * STG_PITCH] << 16); o.w = (unsigned)p[6 * STG_PITCH] | ((unsigned)p[7 * STG_PITCH] << 16);
            *(v4u*)(dst + (size_t)d * SEQ + tc * 8) = o; }
    }
    WSYNC();
}
__device__ __forceinline__ float bperm(int srclane, float x) { return __builtin_bit_cast(float, __builtin_amdgcn_ds_bpermute(srclane << 2, __builtin_bit_cast(int, x))); }
__device__ __forceinline__ void scan128(float& x0, float& x1, int lane) {
#pragma unroll
    for (int o = 1; o < 64; o <<= 1) { const int sl = (lane >= o) ? lane - o : lane; const float t0 = bperm(sl, x0), t1 = bperm(sl, x1); if (lane >= o) { x0 += t0; x1 += t1; } }
    x1 += rl(x0, 63);
}
__device__ __forceinline__ void ssd_s1_unit(int unit, int lane, LAS float* tab, const bf16_t* __restrict__ xst, const bf16_t* __restrict__ bt, const float* __restrict__ dt, const float* __restrict__ a_log,
                                            float* __restrict__ sloc, float* __restrict__ asum) {
    const int h = unit & 7, c = (unit >> 3) & 15, b = unit >> 7, g = h >> 2, l0 = c * 128, l31 = lane & 31, hi = lane >> 5;
    const size_t m0 = (size_t)b * SEQ + l0;
    const float A = -expf(a_log[h]);
    const float d0 = dt[(m0 + lane) * 8 + h], d1 = dt[(m0 + 64 + lane) * 8 + h];
    float ac0 = d0 * A, ac1 = d1 * A;
    scan128(ac0, ac1, lane);
    const float aend = rl(ac1, 63);
    tab[lane] = __expf(aend - ac0) * d0; tab[64 + lane] = __expf(aend - ac1) * d1;
    if (lane == 0) asum[unit] = aend;
    WSYNC();
    f32x16 acc[2][4];
#pragma unroll
    for (int pt = 0; pt < 2; ++pt)
#pragma unroll
        for (int nt = 0; nt < 4; ++nt)
#pragma unroll
            for (int r = 0; r < 16; ++r) acc[pt][nt][r] = 0.f;
    const bf16_t* Xp = xst + ((size_t)(b * 8 + h) * 64 + l31) * SEQ + l0 + 8 * hi;
    const bf16_t* Bp = bt + ((size_t)(b * 2 + g) * 128 + l31) * SEQ + l0 + 8 * hi;
#pragma unroll 2
    for (int kk = 0; kk < 8; ++kk) {
        const f32x4 wa = *(const LAS f32x4*)(tab + 16 * kk + 8 * hi), wb = *(const LAS f32x4*)(tab + 16 * kk + 8 * hi + 4);
        bf16x8 af[2], bfr[4];
#pragma unroll
        for (int pt = 0; pt < 2; ++pt) { const v4u raw = *(const v4u*)(Xp + (size_t)pt * 32 * SEQ + 16 * kk);
            v4u w; w.x = cvtpk(bflo(raw.x) * wa[0], bfhi(raw.x) * wa[1]); w.y = cvtpk(bflo(raw.y) * wa[2], bfhi(raw.y) * wa[3]);
            w.z = cvtpk(bflo(raw.z) * wb[0], bfhi(raw.z) * wb[1]); w.w = cvtpk(bflo(raw.w) * wb[2], bfhi(raw.w) * wb[3]); af[pt] = __builtin_bit_cast(bf16x8, w); }
#pragma unroll
        for (int nt = 0; nt < 4; ++nt) bfr[nt] = *(const bf16x8*)(Bp + (size_t)nt * 32 * SEQ + 16 * kk);
#pragma unroll
        for (int pt = 0; pt < 2; ++pt)
#pragma unroll
            for (int nt = 0; nt < 4; ++nt) acc[pt][nt] = MFMA32(af[pt], bfr[nt], acc[pt][nt]);
    }
    float* dst = sloc + (size_t)unit * 8192 + l31;
#pragma unroll
    for (int pt = 0; pt < 2; ++pt)
#pragma unroll
        for (int nt = 0; nt < 4; ++nt)
#pragma unroll
            for (int r = 0; r < 16; ++r) dst[(32 * pt + crow(r, hi)) * 128 + 32 * nt] = acc[pt][nt][r];
    WSYNC();
}
__device__ __forceinline__ void ssd_s2_all(const float* __restrict__ sloc, const float* __restrict__ asum, bf16_t* __restrict__ stb, int gtid, int NT) {
    for (int i = gtid; i < 128 * 2048; i += NT) {
        const int bh = i >> 11, e4 = i & 2047, b = bh >> 3, h = bh & 7;
        f32x4 run = {0.f, 0.f, 0.f, 0.f};
#pragma unroll 4
        for (int c = 0; c < 16; ++c) { const int unit = (b * 16 + c) * 8 + h; const f32x4 tmp = *(const f32x4*)(sloc + (size_t)unit * 8192 + e4 * 4);
            uint2 w; w.x = cvtpk(run[0], run[1]); w.y = cvtpk(run[2], run[3]); *(uint2*)(stb + (size_t)unit * 8192 + e4 * 4) = w;
            run = run * __expf(asum[unit]) + tmp; }
    }
}
__device__ __forceinline__ void ssd_s3_unit(int unit, int lane, LAS float* tab, const bf16_t* __restrict__ xbc, const bf16_t* __restrict__ xst, const bf16_t* __restrict__ stb, const float* __restrict__ dt,
                                            const float* __restrict__ a_log, const float* __restrict__ dsk, bf16_t* __restrict__ yssm) {
    const int h = unit & 7, c = (unit >> 3) & 15, b = unit >> 7, g = h >> 2, l0 = c * 128, l31 = lane & 31, hi = lane >> 5;
    const size_t m0 = (size_t)b * SEQ + l0;
    const float A = -expf(a_log[h]), D = dsk[h];
    const float d0 = dt[(m0 + lane) * 8 + h], d1 = dt[(m0 + 64 + lane) * 8 + h];
    float ac0 = d0 * A, ac1 = d1 * A;
    scan128(ac0, ac1, lane);
    tab[lane] = ac0; tab[64 + lane] = ac1; tab[128 + lane] = d0; tab[192 + lane] = d1;
    WSYNC();
    const bf16_t* Cp = xbc + (m0 + l31) * 1024 + 768 + g * 128 + 8 * hi;
    const bf16_t* Sp = stb + (size_t)unit * 8192 + l31 * 128 + 8 * hi;
    const bf16_t* Bp = xbc + (m0 + l31) * 1024 + 512 + g * 128 + 8 * hi;
    const bf16_t* Xp = xst + ((size_t)(b * 8 + h) * 64 + l31) * SEQ + l0 + 4 * hi;
    LAS float* tr = tab + 256;
    const int row = lane >> 1, p0 = (lane & 1) * 16;
#pragma unroll 1
    for (int lt = 0; lt < 4; ++lt) {
        f32x16 y[2];
#pragma unroll
        for (int r = 0; r < 16; ++r) { y[0][r] = 0.f; y[1][r] = 0.f; }
        const float acl = tab[32 * lt + l31];
        bf16x8 cfr[8];
#pragma unroll
        for (int kk = 0; kk < 8; ++kk) cfr[kk] = *(const bf16x8*)(Cp + (size_t)lt * 32 * 1024 + 16 * kk);
        {   bf16x8 s0[8], s1[8];
#pragma unroll
            for (int kk = 0; kk < 8; ++kk) { s0[kk] = *(const bf16x8*)(Sp + 16 * kk); s1[kk] = *(const bf16x8*)(Sp + 32 * 128 + 16 * kk); }
#pragma unroll
            for (int kk = 0; kk < 8; ++kk) { y[0] = MFMA32(s0[kk], cfr[kk], y[0]); y[1] = MFMA32(s1[kk], cfr[kk], y[1]); }
        }
        { const float el = __expf(acl);
#pragma unroll
          for (int r = 0; r < 16; ++r) { y[0][r] *= el; y[1][r] *= el; } }
#pragma unroll 1
        for (int st = 0; st <= lt; ++st) {
            bf16x8 bfr[8]; u32x2 xf[2][2][2];
#pragma unroll
            for (int kk = 0; kk < 8; ++kk) bfr[kk] = *(const bf16x8*)(Bp + (size_t)st * 32 * 1024 + 16 * kk);
#pragma unroll
            for (int pt = 0; pt < 2; ++pt)
#pragma unroll
                for (int ks = 0; ks < 2; ++ks) { const bf16_t* xp = Xp + (size_t)pt * 32 * SEQ + st * 32 + 16 * ks; xf[pt][ks][0] = *(const u32x2*)xp; xf[pt][ks][1] = *(const u32x2*)(xp + 8); }
            f32x16 cbt;
#pragma unroll
            for (int r = 0; r < 16; ++r) cbt[r] = 0.f;
#pragma unroll
            for (int kk = 0; kk < 8; ++kk) cbt = MFMA32(bfr[kk], cfr[kk], cbt);
#pragma unroll
            for (int r = 0; r < 16; ++r) { const int sl = 32 * st + crow(r, hi); const float acs = tab[sl], dts = tab[128 + sl];
                float v = cbt[r] * __expf(acl - acs) * dts; if (st == lt && crow(r, hi) > l31) v = 0.f; cbt[r] = v; }
            bf16x8 pf[2];
#pragma unroll
            for (int ks = 0; ks < 2; ++ks) pf[ks] = pack8(cbt[8 * ks], cbt[8 * ks + 1], cbt[8 * ks + 2], cbt[8 * ks + 3], cbt[8 * ks + 4], cbt[8 * ks + 5], cbt[8 * ks + 6], cbt[8 * ks + 7]);
#pragma unroll
            for (int pt = 0; pt < 2; ++pt)
#pragma unroll
                for (int ks = 0; ks < 2; ++ks) { v4u a; a.x = xf[pt][ks][0].x; a.y = xf[pt][ks][0].y; a.z = xf[pt][ks][1].x; a.w = xf[pt][ks][1].y; y[pt] = MFMA32(__builtin_bit_cast(bf16x8, a), pf[ks], y[pt]); }
        }
#pragma unroll
        for (int pt = 0; pt < 2; ++pt) {
#pragma unroll
            for (int r = 0; r < 16; ++r) tr[l31 * 33 + crow(r, hi)] = y[pt][r];
            WSYNC();
            const size_t m = m0 + 32 * lt + row;
            const v4u xa = *(const v4u*)(xbc + m * 1024 + h * 64 + 32 * pt + p0), xb = *(const v4u*)(xbc + m * 1024 + h * 64 + 32 * pt + p0 + 8);
            const unsigned xu[8] = {xa.x, xa.y, xa.z, xa.w, xb.x, xb.y, xb.z, xb.w};
            unsigned ow[8];
#pragma unroll
            for (int q = 0; q < 8; ++q) { const float v0 = tr[row * 33 + p0 + 2 * q] + D * bflo(xu[q]), v1 = tr[row * 33 + p0 + 2 * q + 1] + D * bfhi(xu[q]); ow[q] = cvtpk(v0, v1); }
            bf16_t* dst = yssm + m * 512 + h * 64 + 32 * pt + p0;
            *(v4u*)dst = (v4u){ow[0], ow[1], ow[2], ow[3]}; *(v4u*)(dst + 8) = (v4u){ow[4], ow[5], ow[6], ow[7]};
            WSYNC();
        }
    }
}

struct Args { const float* in[43]; float* out; unsigned char* ws; };
#define GEMM_PHASE(EPI, Aptr, LDA, Bptr, LDB, NN, KK, ...) do { pg8::Gemm g_{(Aptr), (Bptr), M, (NN), (KK), (LDA), (LDB)}; pg8::StaticOrder S_; S_.init(M, (NN), G, (int)blockIdx.x); \
        pg8::EPI E_{__VA_ARGS__}; pg8::gemm_phase<pg8::EPI, pg8::StaticOrder, true, true>(lds3, g_, S_, E_); } while (0)

__global__ void __launch_bounds__(NWAVES * 64, 2) fwd_mega(Args args) {
    extern __shared__ __attribute__((aligned(16))) unsigned char lds[];
    LAS unsigned char* lds3 = (LAS unsigned char*)lds;
    volatile LAS unsigned* MISC = (volatile LAS unsigned*)(lds3 + MISC_OFF);
    const int G = gridDim.x, NGW = G * NWAVES, NT = G * NWAVES * 64;
#define PHASE_IDS() int tid = threadIdx.x; asm volatile("" : "+v"(tid)); const int lane = tid & 63, wave = __builtin_amdgcn_readfirstlane(tid >> 6); const int gw = blockIdx.x * NWAVES + wave, gtid = blockIdx.x * (NWAVES * 64) + tid; (void)lane; (void)gw; (void)gtid
    unsigned char* ws = args.ws;
    gu32* ctl = (gu32*)(ws + WS_CTL);
    for (int u = threadIdx.x; u < (LDS_BYTES - LDSCTL_OFF) / 4; u += NWAVES * 64) ((LAS unsigned*)(lds3 + LDSCTL_OFF))[u] = 0u;
    __syncthreads();
    XcdBarrier bar = xcd_barrier_post((unsigned*)(ctl + CW_BAR), MISC + 8);
#if defined(PROBE_STAMPS)
    int nb_ = 0;
    if (blockIdx.x == 0 && threadIdx.x == 0) MISC[16] = (unsigned)__builtin_amdgcn_s_memrealtime();
#define GRID_BAR() do { xcd_barrier(bar); ++nb_; if (blockIdx.x == 0 && threadIdx.x == 0) MISC[16 + nb_] = (unsigned)__builtin_amdgcn_s_memrealtime(); } while (0)
#else
#define GRID_BAR() xcd_barrier(bar)
#endif
#define IN(i) (args.in[i])
    float* out = args.out;
    bf16_t* W0in = (bf16_t*)(ws + WS_W0IN); bf16_t* W0out = (bf16_t*)(ws + WS_W0OUT); bf16_t* Wup0 = (bf16_t*)(ws + WS_WUP0); bf16_t* Wdn0 = (bf16_t*)(ws + WS_WDN0);
    bf16_t* W1in = (bf16_t*)(ws + WS_W1IN); bf16_t* Wuq = (bf16_t*)(ws + WS_WUQ); bf16_t* Wukv = (bf16_t*)(ws + WS_WUKV); bf16_t* W1out = (bf16_t*)(ws + WS_W1OUT);
    bf16_t* Wup1 = (bf16_t*)(ws + WS_WUP1); bf16_t* Wdn1 = (bf16_t*)(ws + WS_WDN1);
    bf16_t* XB = (bf16_t*)(ws + WS_XB); bf16_t* YMIX = (bf16_t*)(ws + WS_YMIX); bf16_t* PROJ0 = (bf16_t*)(ws + WS_BIG);
    float* YRAW = out; bf16_t* YSSM = (bf16_t*)(out + (size_t)M * 512); bf16_t* STB = (bf16_t*)(out + (size_t)M * 768); bf16_t* XST = (bf16_t*)(ws + WS_XST); bf16_t* BT = (bf16_t*)(ws + WS_BT); float* ASUM = (float*)(ws + WS_ASUM); float* SLOC = (float*)(ws + WS_SLOC); float* DT = (float*)(ws + WS_DT); bf16_t* GB = (bf16_t*)(ws + WS_G); float* BONUS = (float*)(ws + WS_BONUS);
    bf16_t* W2T = (bf16_t*)(ws + WS_W2T); bf16_t* A2T = (bf16_t*)(ws + WS_A2T); bf16_t* G2T = (bf16_t*)(ws + WS_G2T); bf16_t* ACT = (bf16_t*)(ws + WS_GU); bf16_t* HALO = (bf16_t*)(ws + WS_GU + 176 * MiB);
    bf16_t* PROJ1 = (bf16_t*)(ws + WS_PROJ1); bf16_t* QM = (bf16_t*)(ws + WS_QM); bf16_t* KVM = (bf16_t*)(ws + WS_KVM); bf16_t* KPE = (bf16_t*)(ws + WS_KPE); float* RS = (float*)(ws + WS_RS); float* CSTAB = (float*)(ws + WS_CSTAB); float* STATS = (float*)(ws + WS_CSTAB + 4 * MiB); bf16_t* VTS = (bf16_t*)(ws + WS_VTS); bf16_t* VTM = (bf16_t*)(ws + WS_VTM);
    const int* pos = (const int*)args.in[1];

    {
        PHASE_IDS();
    {
        LAS float* scr = (LAS float*)(lds3 + wave * 16384); int trb = 0;
        transpose_matrix(IN(2), 1024, 3336, W0in, L0P, 1024, scr, gw, NGW, lane, nullptr, trb);
        transpose_matrix(IN(20), 1024, 1024, W0out, 1024, 1024, scr, gw, NGW, lane, nullptr, trb);
        transpose_matrix(IN(23), 1024, 5632, Wup0, 5632, 1024, scr, gw, NGW, lane, nullptr, trb, true);
        transpose_matrix(IN(26), 2816, 1024, Wdn0, 1024, 2816, scr, gw, NGW, lane, nullptr, trb);
        transpose_matrix(IN(29), 1024, 1952, W1in, L1P, 1024, scr, gw, NGW, lane, nullptr, trb);
        transpose_matrix(IN(31), 256, 768, Wuq, 768, 256, scr, gw, NGW, lane, IN(30), trb);
        transpose_matrix(IN(33), 128, 1024, Wukv, 1024, 256, scr, gw, NGW, lane, IN(32), trb);
        for (int i = gtid; i < 1024 * 16; i += NT) { const int n = i >> 4, c = i & 15; *(v4u*)(Wukv + (size_t)n * 256 + 128 + c * 8) = (v4u){0u, 0u, 0u, 0u}; }
        transpose_matrix(IN(34), 1024, 1024, W1out, 1024, 1024, scr, gw, NGW, lane, nullptr, trb);
        transpose_matrix(IN(37), 1024, 5632, Wup1, 5632, 1024, scr, gw, NGW, lane, nullptr, trb, true);
        transpose_matrix(IN(40), 2816, 1024, Wdn1, 1024, 2816, scr, gw, NGW, lane, nullptr, trb);
        transpose_matrix(IN(5), 64, 512, W2T, 512, 64, scr, gw, NGW, lane, nullptr, trb);
        transpose_matrix(IN(7), 64, 512, A2T, 512, 64, scr, gw, NGW, lane, nullptr, trb);
        transpose_matrix(IN(8), 128, 512, G2T, 512, 128, scr, gw, NGW, lane, nullptr, trb);
        const float* x = IN(0);
        {
            constexpr size_t TOT4 = (size_t)M * DM / 4;
            for (size_t i = gtid; i < TOT4; i += (size_t)NT * 8) {
                f32x4 v[8];
#pragma unroll
                for (int u = 0; u < 8; ++u) v[u] = *(const f32x4*)(x + (i + (size_t)u * NT) * 4);
#pragma unroll
                for (int u = 0; u < 8; ++u) { uint2 w; w.x = cvtpk(v[u][0], v[u][1]); w.y = cvtpk(v[u][2], v[u][3]); *(uint2*)(XB + (i + (size_t)u * NT) * 4) = w; }
            }
        }
    }
    }
    GRID_BAR();
    {
        PHASE_IDS();
    GEMM_PHASE(EpiBf16S, XB, DM, W0in, 1024, L0P, 1024, PROJ0, nullptr, L0P, 0);
    }
    GRID_BAR();
    {
        PHASE_IDS();
        const int blk = (int)blockIdx.x, m0 = blk * 128;
        {   LAS bf16_t* scr = (LAS bf16_t*)(lds3 + wave * 16384);
#pragma unroll 1
            for (int k = 0; k < 4; ++k) ssd_conv_tile((2 * blk + (k & 1)) * 16 + wave + 8 * (k >> 1), lane, scr, PROJ0, IN(14), IN(15), XB, XST, BT);
            for (int i = tid; i < 1024; i += NWAVES * 64) { const int m = m0 + (i >> 3); DT[(size_t)m * 8 + (i & 7)] = softplusf_(bf2f(PROJ0[(size_t)m * L0P + 3328 + (i & 7)]) + IN(16)[i & 7]); }
        }
        __syncthreads();
#if defined(PROBE_STAMPS)
        if (blockIdx.x == 0 && threadIdx.x == 0) MISC[16 + 29] = (unsigned)__builtin_amdgcn_s_memrealtime();
#endif
        ssd_s1_unit(blk * 8 + wave, lane, (LAS float*)(lds3 + wave * 16384), XST, BT, DT, IN(17), SLOC, ASUM);
    }
    GRID_BAR();
    {
        PHASE_IDS();
        ssd_s2_all(SLOC, ASUM, STB, gtid, NT);
#if defined(PROBE_STAMPS)
        __syncthreads(); if (blockIdx.x == 0 && threadIdx.x == 0) MISC[16 + 23] = (unsigned)__builtin_amdgcn_s_memrealtime();
#endif
        rwkv_phase((LAS float*)lds3, tid, lane, wave, (int)blockIdx.x, PROJ0, IN(3), IN(4), IN(6), IN(9), IN(10), IN(11), W2T, A2T, G2T, YRAW, GB, BONUS);
    }
    GRID_BAR();
    {
        PHASE_IDS();
        const int blk = (int)blockIdx.x;
        ssd_s3_unit(blk * 8 + wave, lane, (LAS float*)(lds3 + wave * 16384), XB, XST, STB, DT, IN(17), IN(18), YSSM);
        __syncthreads();
        ssm_gate_norm_all(YSSM, PROJ0, IN(19), YMIX, blk * 256 + wave, blk * 256 + 256, lane);
        rwkv_post_all(YRAW, PROJ0, IN(3), BONUS, GB, IN(12), IN(13), YMIX, gw, NGW, lane);
    }
    GRID_BAR();
    {
        PHASE_IDS();
    GEMM_PHASE(EpiResid, YMIX, DM, W0out, 1024, 1024, 1024, IN(0), out, ALPHA, 0);
    }
    GRID_BAR();
    {
        PHASE_IDS();
    ln_rows<1>(out, XB, STATS, IN(21), IN(22), gw, NGW, lane);
    }
    GRID_BAR();
    {
        PHASE_IDS();
        { pg8::Gemm g_{XB, Wup0, M / 32, DFF, 1024, DM, 1024, 4096, 8192, 256, 512, 1}; pg8::StaticOrder S_; S_.init(M / 32, DFF, G, (int)blockIdx.x);
          pg8::EpiBf16S E_{HALO, nullptr, DFF, 0}; pg8::gemm_phase<pg8::EpiBf16S, pg8::StaticOrder, true, true>(lds3, g_, S_, E_); }
    }
    GRID_BAR();
    {
        PHASE_IDS();
        { pg8::Gemm g_{XB, Wup0, M, 2 * DFF, 1024, DM, 1024}; pg8::StaticOrder S_; S_.init(M, 2 * DFF, G, (int)blockIdx.x);
          pg8::EpiConvAct E_{ACT, HALO, IN(24), IN(25), DFF, SEQ}; pg8::gemm_phase<pg8::EpiConvAct, pg8::StaticOrder, true, true>(lds3, g_, S_, E_); }
    }
    GRID_BAR();
    {
        PHASE_IDS();
    GEMM_PHASE(EpiResidLN, ACT, DFF, Wdn0, DFF, 1024, DFF, out, STATS, IN(21), IN(22), ALPHA, 0);
    }
    GRID_BAR();
    {
        PHASE_IDS();
    ln_rows<1>(out, XB, STATS, IN(27), IN(28), gw, NGW, lane);
    }
    GRID_BAR();
    {
        PHASE_IDS();
    GEMM_PHASE(EpiBf16S, XB, DM, W1in, 1024, L1P, 1024, PROJ1, nullptr, L1P, 0);
    }
    GRID_BAR();
    {
        PHASE_IDS();
    mla_prep_all(PROJ1, pos, RS, KPE, CSTAB, gw, NGW, lane);
    }
    GRID_BAR();
    {
        PHASE_IDS();
    GEMM_PHASE(EpiBf16S, PROJ1 + 1536, L1P, Wuq, 256, 768, 256, QM, RS, 768, 2);
    GEMM_PHASE(EpiBf16S, PROJ1 + 1792, L1P, Wukv, 256, 1024, 256, KVM, RS + 1, 1024, 2);
    }
    GRID_BAR();
    {
        PHASE_IDS();
    rope_q_all(QM, CSTAB, gtid, NT);
    {
        LAS bf16_t* scr = (LAS bf16_t*)(lds3 + wave * 16384);
        for (int it = gw; it < 8192; it += NGW) { const int which = it >> 12, r = it & 4095, bh = r >> 5, tt = r & 31, b = bh >> 3, h = bh & 7;
            if (which == 0) transpose_tile64(PROJ1 + ((size_t)b * SEQ + tt * 64) * L1P + 1024 + h * 64, L1P, VTS + (size_t)bh * 64 * SEQ + tt * 64, SEQ, scr, lane);
            else            transpose_tile64(KVM + ((size_t)b * SEQ + tt * 64) * 1024 + h * 128 + 64, 1024, VTM + (size_t)bh * 64 * SEQ + tt * 64, SEQ, scr, lane); }
    }
    }
    GRID_BAR();
    {
        PHASE_IDS();
    {
        for (int g2 = (int)blockIdx.x; g2 < 256; g2 += G) { const int bh = g2 >> 1, part = g2 & 1;
#pragma unroll 1
            for (int i = 0; i < 4; ++i) { const int sbk = part ? ((i == 0) ? 1 : (i == 1) ? 6 : (i == 2) ? 2 : 5) : ((i == 0) ? 0 : (i == 1) ? 7 : (i == 2) ? 3 : 4);
                sb_block(bh, sbk, tid, lane, wave, lds3, PROJ1, VTS, YMIX); } }
        for (int g2 = (int)blockIdx.x; g2 < 256; g2 += G) { const int bh = g2 >> 1, part = g2 & 1;
#pragma unroll 1
            for (int i = 0; i < 4; ++i) { const int sbk = part ? ((i == 0) ? 1 : (i == 1) ? 6 : (i == 2) ? 2 : 5) : ((i == 0) ? 0 : (i == 1) ? 7 : (i == 2) ? 3 : 4);
                mla_block(bh, sbk, tid, lane, wave, lds3, QM, KVM, KPE, VTM, YMIX); } }
    }
    }
    GRID_BAR();
    {
        PHASE_IDS();
    GEMM_PHASE(EpiResidLN, YMIX, DM, W1out, 1024, 1024, 1024, out, STATS, IN(27), IN(28), ALPHA, 0);
    }
    GRID_BAR();
    {
        PHASE_IDS();
    ln_rows<1>(out, XB, STATS, IN(35), IN(36), gw, NGW, lane);
    }
    GRID_BAR();
    {
        PHASE_IDS();
        { pg8::Gemm g_{XB, Wup1, M / 32, DFF, 1024, DM, 1024, 4096, 8192, 256, 512, 1}; pg8::StaticOrder S_; S_.init(M / 32, DFF, G, (int)blockIdx.x);
          pg8::EpiBf16S E_{HALO, nullptr, DFF, 0}; pg8::gemm_phase<pg8::EpiBf16S, pg8::StaticOrder, true, true>(lds3, g_, S_, E_); }
    }
    GRID_BAR();
    {
        PHASE_IDS();
        { pg8::Gemm g_{XB, Wup1, M, 2 * DFF, 1024, DM, 1024}; pg8::StaticOrder S_; S_.init(M, 2 * DFF, G, (int)blockIdx.x);
          pg8::EpiConvAct E_{ACT, HALO, IN(38), IN(39), DFF, SEQ}; pg8::gemm_phase<pg8::EpiConvAct, pg8::StaticOrder, true, true>(lds3, g_, S_, E_); }
    }
    GRID_BAR();
    {
        PHASE_IDS();
    GEMM_PHASE(EpiResidLN, ACT, DFF, Wdn1, DFF, 1024, DFF, out, STATS, IN(35), IN(36), ALPHA, 0);
    }
    GRID_BAR();
    {
        PHASE_IDS();
    ln_rows<2>(out, XB, STATS, IN(41), IN(42), gw, NGW, lane);
    #if defined(PROBE_STAMPS)
    __syncthreads();
    if (blockIdx.x == 0 && threadIdx.x == 0) {
        MISC[16 + 22] = (unsigned)__builtin_amdgcn_s_memrealtime();
#if defined(PROBE_ACC)
        const unsigned d1 = MISC[16 + PROBE_ACC];
#else
        const unsigned d1 = MISC[16 + PROBE_T1_HI] - MISC[16 + PROBE_T1_LO];
#endif
        const unsigned long long spin = 100ull * d1;
        const unsigned long long t0 = __builtin_amdgcn_s_memrealtime();
        while (__builtin_amdgcn_s_memrealtime() - t0 < spin) __builtin_amdgcn_s_sleep(8);
    }
#endif
}
}

extern "C" void kernel_launch(void* const* d_in, const int* in_sizes, int n_in, void* d_out, int out_size, void* d_ws, size_t ws_size, hipStream_t stream) {
    static int grid = 0;
    if (grid == 0) {
        if (n_in != 43 || ws_size < WS_NEED || out_size != M * DM) { fprintf(stderr, "kernel_launch: unexpected n_in %d / ws %zu / out %d\n", n_in, ws_size, out_size); grid = -1; return; }
        int dev = 0, cus = 0, per_cu = 0;
        if (hipGetDevice(&dev) != hipSuccess || hipDeviceGetAttribute(&cus, hipDeviceAttributeMultiprocessorCount, dev) != hipSuccess) { grid = -1; return; }
        if (hipFuncSetAttribute((const void*)fwd_mega, hipFuncAttributeMaxDynamicSharedMemorySize, LDS_BYTES) != hipSuccess) { fprintf(stderr, "kernel_launch: hipFuncSetAttribute failed\n"); grid = -1; return; }
        if (hipOccupancyMaxActiveBlocksPerMultiprocessor(&per_cu, (const void*)fwd_mega, NWAVES * 64, LDS_BYTES) != hipSuccess || per_cu < 1) fprintf(stderr, "kernel_launch: occupancy query reports %d\n", per_cu);
        (void)hipGetLastError();
        grid = cus;
    }
    if (grid < 0) return;
    (void)hipMemsetAsync((char*)d_ws + WS_CTL, 0, CTL_ZERO_BYTES, stream);
    Args a{};
    for (int i = 0; i < 43; ++i) a.in[i] = (const float*)d_in[i];
    a.out = (float*)d_out; a.ws = (unsigned char*)d_ws;
    hipLaunchKernelGGL(fwd_mega, dim3(grid), dim3(NWAVES * 64), LDS_BYTES, stream, a);
}
```

```cpp
#include <hip/hip_runtime.h>
#include <cstdio>
#include <cstdint>
#include <cmath>
namespace pg8 {
#define PG8_LAS __attribute__((address_space(3)))
typedef unsigned short bf16_t;
typedef short bf16x8 __attribute__((ext_vector_type(8)));
typedef float f32x4 __attribute__((ext_vector_type(4)));
typedef unsigned u32x4 __attribute__((ext_vector_type(4)));
constexpr int BM = 256, BK = 64, HALF = 128, HTB = HALF * BK * 2  , STAGE_BYTES = 8 * HTB, NXCD = 8, WGM = 8;

__host__ __device__ __forceinline__ int lds_byte(int r, int c) { const int st = (r >> 4) * 2 + (c >> 5), rr = r & 15, cc = c & 31, ob = rr * 64 + cc * 2; return st * 1024 + (ob ^ (((ob >> 9) & 1) << 5)); }
__host__ __device__ __forceinline__ void stage_rc(int b, int& R, int& C) { const int st = b / 1024, sb = b % 1024, swz = sb ^ (((sb >> 9) & 1) << 5); R = (st >> 1) * 16 + swz / 64; C = (st & 1) * 32 + (swz % 64) / 2; }
__host__ __device__ __forceinline__ int perm32(int rho) { const int n = rho >> 4, i = rho & 15; return 8 * (i >> 2) + 4 * n + (i & 3); }

struct Unit { int pm, pn; };
struct Gemm { const bf16_t* A; const bf16_t* Bt; int M, N, K, lda, ldb; int hrA = 128, trA = 256, hrB = 128, trB = 256, gatherA = 0; };

struct StaticOrder {
    int nM, nN, nwg, G, c;
    __host__ __device__ void init(int M, int N, int G_, int c_) { nM = M / BM; nN = N / BM; nwg = nM * nN; G = G_; c = c_; }
    __host__ __device__ bool next(int i, Unit& u) const {
        const long L = (long)i * G + c; if (L >= nwg) return false;
        int wgid = (int)L; { const int q = nwg / NXCD, r = nwg % NXCD, xcd = wgid % NXCD, off = wgid / NXCD; wgid = (xcd < r ? xcd * (q + 1) : r * (q + 1) + (xcd - r) * q) + off; }
        const int nig = WGM * nN, gid = wgid / nig, fm = gid * WGM, gsz = (nM - fm) < WGM ? (nM - fm) : WGM;
        u.pm = fm + ((wgid % nig) % gsz); u.pn = (wgid % nig) / gsz; return true;
    }
    __device__ __forceinline__ void a_ready(const Unit&) const {}
    __device__ __forceinline__ void done(const Unit&) const {}
};


__device__ __forceinline__ unsigned cvt_pk_bf16(float lo, float hi) { unsigned r; asm volatile("v_cvt_pk_bf16_f32 %0, %1, %2" : "=v"(r) : "v"(lo), "v"(hi)); return r; }
struct EpiBf16S {
    static constexpr bool PERM = true, AFTER_DRAIN = false;
    bf16_t* O; const float* rowscale; int ldc; int rs_stride;
    __device__ __forceinline__ void operator()(const f32x4 (&acc)[2][2][4][2], const Unit& u, int wr, int wc, int fr, int fq) const {
        const int row0 = u.pm * BM + wr * 64 + fr, col0 = u.pn * BM + wc * 32 + 8 * fq;
#pragma unroll
        for (int ai = 0; ai < 2; ++ai)
#pragma unroll
            for (int m = 0; m < 4; ++m) { const int row = row0 + ai * HALF + m * 16; const float sc = rowscale ? rowscale[(size_t)row * rs_stride] : 1.f;
                bf16_t* rowp = O + (size_t)row * ldc + col0;
#pragma unroll
                for (int bj = 0; bj < 2; ++bj) { const f32x4 v0 = acc[ai][bj][m][0] * sc, v1 = acc[ai][bj][m][1] * sc;
                    u32x4 w; w.x = cvt_pk_bf16(v0[0], v0[1]); w.y = cvt_pk_bf16(v0[2], v0[3]); w.z = cvt_pk_bf16(v1[0], v1[1]); w.w = cvt_pk_bf16(v1[2], v1[3]);
                    *(u32x4*)(rowp + bj * HALF) = w; } }
    }
};
struct EpiResid {
    static constexpr bool PERM = false, AFTER_DRAIN = false;
    const float* hin; float* hout; float alpha; int pad;
    __device__ __forceinline__ void operator()(const f32x4 (&acc)[2][2][4][2], const Unit& u, int wr, int wc, int fr, int fq) const {
        const int row0 = u.pm * BM + wr * 64 + fr, col0 = u.pn * BM + wc * 32 + 4 * fq;
#pragma unroll
        for (int ai = 0; ai < 2; ++ai)
#pragma unroll
            for (int m = 0; m < 4; ++m) { const size_t off = (size_t)(row0 + ai * HALF + m * 16) * 1024 + col0;
#pragma unroll
                for (int bj = 0; bj < 2; ++bj)
#pragma unroll
                    for (int n = 0; n < 2; ++n) { const size_t i = off + bj * HALF + n * 16; const f32x4 h = *(const f32x4*)(hin + i); *(f32x4*)(hout + i) = h * alpha + acc[ai][bj][m][n]; } }
    }
};

struct EpiResidLN {
    static constexpr bool PERM = false, AFTER_DRAIN = false;
    float* hio; const float* stats; const float* g; const float* b; float alpha; int pad;
    __device__ __forceinline__ void operator()(const f32x4 (&acc)[2][2][4][2], const Unit& u, int wr, int wc, int fr, int fq) const {
        const int row0 = u.pm * BM + wr * 64 + fr, col0 = u.pn * BM + wc * 32 + 4 * fq;
        f32x4 gg[2][2], bb[2][2];
#pragma unroll
        for (int bj = 0; bj < 2; ++bj)
#pragma unroll
            for (int n = 0; n < 2; ++n) { gg[bj][n] = *(const f32x4*)(g + col0 + bj * HALF + n * 16) * alpha; bb[bj][n] = *(const f32x4*)(b + col0 + bj * HALF + n * 16) * alpha; }
#pragma unroll
        for (int ai = 0; ai < 2; ++ai)
#pragma unroll
            for (int m = 0; m < 4; ++m) { const int row = row0 + ai * HALF + m * 16; const size_t off = (size_t)row * 1024 + col0;
                const float mu = stats[2 * row], rs = stats[2 * row + 1];
#pragma unroll
                for (int bj = 0; bj < 2; ++bj)
#pragma unroll
                    for (int n = 0; n < 2; ++n) { const size_t i = off + bj * HALF + n * 16; const f32x4 p = *(const f32x4*)(hio + i); *(f32x4*)(hio + i) = (p - mu) * rs * gg[bj][n] + bb[bj][n] + acc[ai][bj][m][n]; } }
    }
};

template <int CTRL> __device__ __forceinline__ float pg_dpp(float x) { return __builtin_bit_cast(float, __builtin_amdgcn_update_dpp(0, __builtin_bit_cast(int, x), CTRL, 0xF, 0xF, true)); }
struct EpiConvAct {
    static constexpr bool PERM = true, AFTER_DRAIN = false;
    bf16_t* act; const bf16_t* halo; const float* cw; const float* cb; int dff; int seq;
    __device__ __forceinline__ void operator()(const f32x4 (&acc)[2][2][4][2], const Unit& u, int wr, int wc, int fr, int fq) const {
        typedef unsigned u32x2e __attribute__((ext_vector_type(2)));
#pragma unroll
        for (int n = 0; n < 2; ++n) {
            const int ch0 = u.pn * 128 + wc * 32 + 8 * fq + 4 * n;
            const f32x4 w0 = *(const f32x4*)(cw + ch0), w1 = *(const f32x4*)(cw + dff + ch0), w2 = *(const f32x4*)(cw + 2 * dff + ch0), bb = *(const f32x4*)(cb + ch0);
#pragma unroll
            for (int ai = 0; ai < 2; ++ai) {
                const int rb64 = u.pm * BM + ai * HALF + wr * 64;
                f32x4 P = {0.f, 0.f, 0.f, 0.f};
                if ((rb64 & (seq - 1)) != 0 && fr >= 14) { const u32x2e hv = *(const u32x2e*)(halo + (size_t)(2 * (rb64 / 64 - 1) + (fr - 14)) * dff + ch0);
                    P[0] = __builtin_bit_cast(float, hv.x << 16); P[1] = __builtin_bit_cast(float, hv.x & 0xffff0000u); P[2] = __builtin_bit_cast(float, hv.y << 16); P[3] = __builtin_bit_cast(float, hv.y & 0xffff0000u); }
#pragma unroll
                for (int m = 0; m < 4; ++m) {
                    const f32x4 Gv = acc[ai][0][m][n], Uv = acc[ai][1][m][n];
                    float o[4];
#pragma unroll
                    for (int e = 0; e < 4; ++e) {
                        const float t1 = pg_dpp<0x111>(Gv[e]), t2 = pg_dpp<0x112>(Gv[e]), p1 = pg_dpp<0x10F>(P[e]), p2 = pg_dpp<0x10E>(P[e]);
                        const float g1 = (fr >= 1) ? t1 : p1, g2 = (fr >= 2) ? t2 : p2;
                        const float y = bb[e] + w0[e] * g2 + w1[e] * g1 + w2[e] * Gv[e];
                        o[e] = y * __builtin_amdgcn_rcpf(1.f + __builtin_amdgcn_exp2f(-1.4426950408889634f * y)) * Uv[e];
                    }
                    u32x2e w; w.x = cvt_pk_bf16(o[0], o[1]); w.y = cvt_pk_bf16(o[2], o[3]);
                    *(u32x2e*)(act + (size_t)(rb64 + m * 16 + fr) * dff + ch0) = w;
                    P = Gv;
                }
            }
        }
    }
};

template <class Epi, class Sched, bool ALIGN_EPI = false, bool SP2 = false>
__device__ __forceinline__ void gemm_phase(PG8_LAS unsigned char* lds, const Gemm g, const Sched& S, const Epi& E) {
    int tid = threadIdx.x; asm volatile("" : "+v"(tid));
    const int wid = __builtin_amdgcn_readfirstlane(tid >> 6), lane = tid & 63, wr = wid >> 2, wc = wid & 3, fr = lane & 15, fq = lane >> 4;
    const int K = g.K, nt = K / BK;
    unsigned voffA[2], voffB[2];
#pragma unroll
    for (int i = 0; i < 2; ++i) { int R, C; stage_rc(tid * 16 + i * 8192, R, C); const int Rb = Epi::PERM ? ((R & ~31) + perm32(R & 31)) : R;
        const int Ra = g.gatherA ? (64 * (R >> 1) + 62 + (R & 1)) : R;
        voffA[i] = (unsigned)(Ra * g.lda + C) * 2u; voffB[i] = (unsigned)(Rb * g.ldb + C) * 2u; }
    const size_t kstep = (size_t)(BK * 2);
    const size_t hstepA = (size_t)g.hrA * g.lda * 2, hstepB = (size_t)g.hrB * g.ldb * 2;
    const size_t tstepA = (size_t)g.trA * g.lda * 2, tstepB = (size_t)g.trB * g.ldb * 2;
    const unsigned ldsw = (unsigned)wid * 1024u;
    const int aoff = lds_byte(wr * 64 + fr, fq * 8), boff = lds_byte(wc * 32 + fr, fq * 8);
#define PG8_SA(b, h) (((b) * 2 + (h)) * HTB)
#define PG8_SB(b, h) ((4 + (b) * 2 + (h)) * HTB)
#define PG8_STAGE(bufoff, gbase, voff) do { _Pragma("unroll") for (int _i = 0; _i < 2; ++_i) \
        __builtin_amdgcn_global_load_lds((const unsigned*)((const char*)(gbase) + (voff)[_i]), (PG8_LAS unsigned*)(lds + (bufoff) + ldsw + _i * 8192), 16, 0, 0); } while (0)
#define PG8_LDA(dst, b, h) do { _Pragma("unroll") for (int m = 0; m < 4; ++m) _Pragma("unroll") for (int k = 0; k < 2; ++k) dst[m][k] = *(const PG8_LAS bf16x8*)(lds + PG8_SA(b, h) + aoff + m * 2048 + k * 1024); } while (0)
#define PG8_LDB(dst, b, h) do { _Pragma("unroll") for (int n = 0; n < 2; ++n) _Pragma("unroll") for (int k = 0; k < 2; ++k) dst[n][k] = *(const PG8_LAS bf16x8*)(lds + PG8_SB(b, h) + boff + n * 2048 + k * 1024); } while (0)
#define PG8_MMA(ai, bj, At, Bt) do { __builtin_amdgcn_s_setprio(1); _Pragma("unroll") for (int m = 0; m < 4; ++m) _Pragma("unroll") for (int n = 0; n < 2; ++n) _Pragma("unroll") for (int k = 0; k < 2; ++k) \
        acc[ai][bj][m][n] = __builtin_amdgcn_mfma_f32_16x16x32_bf16(Bt[n][k], At[m][k], acc[ai][bj][m][n], 0, 0, 0); __builtin_amdgcn_s_setprio(0); } while (0)
#define PG8_WAIT_V(n) asm volatile("s_waitcnt vmcnt(" #n ")" ::: "memory")
#define PG8_WAIT_L(n) asm volatile("s_waitcnt lgkmcnt(" #n ")" ::: "memory")
#define PG8_BAR __builtin_amdgcn_s_barrier()
#define PG8_SCHED __builtin_amdgcn_sched_barrier(0)
    Unit cur, nxt; int ui = 0;
    if (!S.next(0, cur)) return;
    f32x4 acc[2][2][4][2];
#pragma unroll
    for (int a = 0; a < 2; ++a)
#pragma unroll
        for (int b = 0; b < 2; ++b)
#pragma unroll
            for (int m = 0; m < 4; ++m)
#pragma unroll
                for (int n = 0; n < 2; ++n) acc[a][b][m][n] = (f32x4){0.f, 0.f, 0.f, 0.f};
    bf16x8 At[4][2], B0[2][2], B1[2][2];
    const char* cA = (const char*)g.A + (size_t)cur.pm * tstepA; const char* cB = (const char*)g.Bt + (size_t)cur.pn * tstepB;
    S.a_ready(cur);
    if constexpr (SP2) {
        PG8_STAGE(PG8_SB(0, 0), cB, voffB); PG8_STAGE(PG8_SB(0, 1), cB + hstepB, voffB); PG8_STAGE(PG8_SA(0, 0), cA, voffA); PG8_STAGE(PG8_SA(0, 1), cA + hstepA, voffA);
        if (wr == 1) PG8_BAR;
        PG8_WAIT_V(2); PG8_BAR;
        PG8_STAGE(PG8_SB(1, 0), cB + kstep, voffB); PG8_STAGE(PG8_SA(1, 0), cA + kstep, voffA); PG8_STAGE(PG8_SB(1, 1), cB + hstepB + kstep, voffB);
        PG8_WAIT_V(6); PG8_BAR;
    } else {
        PG8_STAGE(PG8_SB(0, 0), cB, voffB); PG8_STAGE(PG8_SA(0, 0), cA, voffA); PG8_STAGE(PG8_SB(0, 1), cB + hstepB, voffB); PG8_STAGE(PG8_SA(0, 1), cA + hstepA, voffA);
        if (wr == 1) PG8_BAR;
        PG8_WAIT_V(4); PG8_BAR;
        PG8_STAGE(PG8_SB(1, 0), cB + kstep, voffB); PG8_STAGE(PG8_SA(1, 0), cA + kstep, voffA); PG8_STAGE(PG8_SB(1, 1), cB + hstepB + kstep, voffB);
        PG8_WAIT_V(6); PG8_BAR;
    }
    for (;;) {
        const bool has_next = S.next(ui + 1, nxt);
        const char* nA = has_next ? (const char*)g.A + (size_t)nxt.pm * tstepA : cA; const char* nB = has_next ? (const char*)g.Bt + (size_t)nxt.pn * tstepB : cB;
        for (int t = 0; t < nt; t += 2) {
            const bool last = (t == nt - 2);
            const char* a1 = cA + (size_t)(t + 1) * kstep;
            const char* a2 = last ? nA : cA + (size_t)(t + 2) * kstep; const char* b2 = last ? nB : cB + (size_t)(t + 2) * kstep;
            const char* a3 = a2 + kstep; const char* b3 = b2 + kstep;
            if (last && has_next) S.a_ready(nxt);
            if constexpr (SP2) {
            PG8_LDB(B0, 0, 0); PG8_LDB(B1, 0, 1); PG8_SCHED; PG8_LDA(At, 0, 0); PG8_STAGE(PG8_SA(1, 1), a1 + hstepA, voffA);
            PG8_WAIT_V(8); PG8_WAIT_L(0); PG8_BAR; PG8_MMA(0, 0, At, B0); PG8_MMA(0, 1, At, B1); PG8_BAR; PG8_SCHED;
            PG8_LDA(At, 0, 1); PG8_STAGE(PG8_SB(0, 0), b2, voffB); PG8_STAGE(PG8_SB(0, 1), b2 + hstepB, voffB); PG8_STAGE(PG8_SA(0, 0), a2, voffA);
            PG8_WAIT_V(8); PG8_WAIT_L(0); PG8_BAR; PG8_MMA(1, 0, At, B0); PG8_MMA(1, 1, At, B1); PG8_BAR; PG8_SCHED;
            PG8_LDB(B0, 1, 0); PG8_LDB(B1, 1, 1); PG8_SCHED; PG8_LDA(At, 1, 0); PG8_STAGE(PG8_SA(0, 1), a2 + hstepA, voffA);
            PG8_WAIT_V(8); PG8_WAIT_L(0); PG8_BAR; PG8_MMA(0, 0, At, B0); PG8_MMA(0, 1, At, B1); PG8_BAR; PG8_SCHED;
            PG8_LDA(At, 1, 1); PG8_STAGE(PG8_SB(1, 0), b3, voffB); PG8_STAGE(PG8_SB(1, 1), b3 + hstepB, voffB); PG8_STAGE(PG8_SA(1, 0), a3, voffA);
            PG8_WAIT_V(8); PG8_WAIT_L(0); PG8_BAR; PG8_MMA(1, 0, At, B0); PG8_MMA(1, 1, At, B1); PG8_BAR; PG8_SCHED;
            } else {
            PG8_LDB(B0, 0, 0); PG8_SCHED; PG8_LDA(At, 0, 0); PG8_STAGE(PG8_SA(1, 1), a1 + hstepA, voffA);
            PG8_WAIT_L(8); PG8_BAR; PG8_WAIT_L(0); PG8_MMA(0, 0, At, B0); PG8_BAR; PG8_SCHED;
            PG8_LDB(B1, 0, 1); PG8_STAGE(PG8_SB(0, 0), b2, voffB);
            PG8_BAR; PG8_WAIT_L(0); PG8_MMA(0, 1, At, B1); PG8_BAR;
            PG8_LDA(At, 0, 1); PG8_STAGE(PG8_SA(0, 0), a2, voffA);
            PG8_BAR; PG8_WAIT_L(0); PG8_MMA(1, 0, At, B0); PG8_BAR; PG8_SCHED;
            PG8_STAGE(PG8_SB(0, 1), b2 + hstepB, voffB);
            PG8_WAIT_V(6); PG8_BAR; PG8_MMA(1, 1, At, B1); PG8_BAR;
            PG8_LDB(B0, 1, 0); PG8_SCHED; PG8_LDA(At, 1, 0); PG8_STAGE(PG8_SA(0, 1), a2 + hstepA, voffA);
            PG8_WAIT_L(8); PG8_BAR; PG8_WAIT_L(0); PG8_MMA(0, 0, At, B0); PG8_BAR; PG8_SCHED;
            PG8_LDB(B1, 1, 1); PG8_STAGE(PG8_SB(1, 0), b3, voffB);
            PG8_BAR; PG8_WAIT_L(0); PG8_MMA(0, 1, At, B1); PG8_BAR;
            PG8_LDA(At, 1, 1); PG8_STAGE(PG8_SA(1, 0), a3, voffA);
            PG8_BAR; PG8_WAIT_L(0); PG8_MMA(1, 0, At, B0); PG8_BAR; PG8_SCHED;
            PG8_STAGE(PG8_SB(1, 1), b3 + hstepB, voffB);
            PG8_WAIT_V(6); PG8_BAR; PG8_MMA(1, 1, At, B1); PG8_BAR;
            }
        }
        if constexpr (ALIGN_EPI) { if (wr == 0) PG8_BAR; }
        if constexpr (!Epi::AFTER_DRAIN) { E(acc, cur, wr, wc, fr, fq); S.done(cur); }
        if (!has_next) break;
#pragma unroll
        for (int a = 0; a < 2; ++a)
#pragma unroll
            for (int b = 0; b < 2; ++b)
#pragma unroll
                for (int m = 0; m < 4; ++m)
#pragma unroll
                    for (int n = 0; n < 2; ++n) acc[a][b][m][n] = (f32x4){0.f, 0.f, 0.f, 0.f};
        cur = nxt; cA = nA; cB = nB; ++ui;
        if constexpr (ALIGN_EPI) { if (wr == 1) PG8_BAR; }
    }
    PG8_WAIT_V(0);
    if constexpr (!ALIGN_EPI) { if (wr == 0) PG8_BAR; }
    PG8_BAR;
    if constexpr (Epi::AFTER_DRAIN) { E.fused(acc, cur, wr, wc, fr, fq, lds, wid, lane); S.done(cur); }
#undef PG8_SA
#undef PG8_SB
#undef PG8_STAGE
#undef PG8_LDA
#undef PG8_LDB
#undef PG8_MMA
#undef PG8_WAIT_V
#undef PG8_WAIT_L
#undef PG8_BAR
#undef PG8_SCHED
}
}
#define GAS __attribute__((address_space(1)))
#define LAS __attribute__((address_space(3)))
typedef unsigned short bf16;
typedef unsigned v4u __attribute__((ext_vector_type(4)));
typedef float f32x4 __attribute__((ext_vector_type(4)));
typedef short bf16x8 __attribute__((ext_vector_type(8)));
typedef GAS unsigned gu32;
typedef GAS unsigned long long gu64;
#define RLX_AGENT __ATOMIC_RELAXED, __HIP_MEMORY_SCOPE_AGENT
#define LDS_WAIT() asm volatile("s_waitcnt lgkmcnt(0)" ::: "memory")
#define VM_WAIT() asm volatile("s_waitcnt vmcnt(0)" ::: "memory")
__device__ __forceinline__ unsigned long long rt() { return __builtin_amdgcn_s_memrealtime(); }
__device__ __forceinline__ unsigned f2bf(float f) { unsigned u = __builtin_bit_cast(unsigned, f); return (u + 0x7fffu + ((u >> 16) & 1u)) >> 16; }
__device__ __forceinline__ unsigned pk2(float lo, float hi) { return f2bf(lo) | (f2bf(hi) << 16); }

#define XB_TMO      128
#define XB_XCNT(j)  (256  + 64 * (j))
#define XB_XSUB(j)  (1280 + 64 * (j))
#define XB_XGEN(j)  (2304 + 64 * (j))
#define XB_TOP      3328
#define XB_TOPGEN   3392
#define XCD_BAR_WORDS 3456
#define XB_SPIN_CAP (1u << 18)

__device__ __forceinline__ unsigned xb_ld(unsigned* p)              { return __hip_atomic_load(p, __ATOMIC_RELAXED, __HIP_MEMORY_SCOPE_AGENT); }
__device__ __forceinline__ unsigned xb_add(unsigned* p, unsigned v) { return __hip_atomic_fetch_add(p, v, __ATOMIC_RELAXED, __HIP_MEMORY_SCOPE_AGENT); }
__device__ __forceinline__ unsigned xb_xcc_id() { return (unsigned)__builtin_amdgcn_s_getreg((3 << 11) | 20) & 0xFu; }
#define XB_SPIN(cond, bar) do { unsigned _sp = 0; while (cond) { __builtin_amdgcn_s_sleep(1); \
    if ((++_sp & 255u) == 0u) { if (xb_ld(&(bar)[XB_TMO])) break; if (_sp > XB_SPIN_CAP) { atomicAdd(&(bar)[XB_TMO], 1u); break; } } } } while (0)

struct XcdBarrier {
    unsigned* bar; unsigned x;
    volatile LAS unsigned* st;
};

__device__ __forceinline__ XcdBarrier xcd_barrier_post(unsigned* bar, volatile LAS unsigned* st) {
    XcdBarrier b; b.bar = bar; b.x = xb_xcc_id(); b.st = st;
    if (threadIdx.x == 0) (void)xb_add(&bar[XB_XCNT(b.x)], 1u);
    return b;
}
__device__ __forceinline__ void xcd_barrier_complete(unsigned* bar, unsigned x, unsigned& nloc, unsigned& nx) {
    const unsigned G = gridDim.x * gridDim.y * gridDim.z;
    unsigned sum, cnt, mine, sp = 0u;
    for (;;) {
        sum = 0u; cnt = 0u; mine = 0u;
#pragma unroll
        for (unsigned j = 0; j < 16; ++j) { const unsigned c = xb_ld(&bar[XB_XCNT(j)]); sum += c; cnt += (c > 0u) ? 1u : 0u; mine = (j == x) ? c : mine; }
        if (sum == G) break;
        __builtin_amdgcn_s_sleep(1);
        if ((++sp & 255u) == 0u) { if (xb_ld(&bar[XB_TMO])) break; if (sp > XB_SPIN_CAP) { atomicAdd(&bar[XB_TMO], 1u); break; } }
    }
    nloc = mine > 0u ? mine : 1u; nx = cnt > 0u ? cnt : 1u;
}

__device__ __forceinline__ void xcd_barrier(const XcdBarrier& b) {
    asm volatile("s_waitcnt vmcnt(0)" ::: "memory");
    __syncthreads();
    if (threadIdx.x == 0) {
        unsigned* bar = b.bar;
        __builtin_amdgcn_s_waitcnt(0);
        unsigned nloc = b.st[0], nx = b.st[1];
        if (nloc == 0u) { xcd_barrier_complete(bar, b.x, nloc, nx); b.st[0] = nloc; b.st[1] = nx; }
        const unsigned old = xb_add(&bar[XB_XSUB(b.x)], 1u);
        const unsigned gen = old / nloc;
        if (old + 1u == (gen + 1u) * nloc) {
            __builtin_amdgcn_fence(__ATOMIC_RELEASE, "agent");
            asm volatile("s_waitcnt vmcnt(0)" ::: "memory");
            const unsigned og = xb_add(&bar[XB_TOP], 1u);
            const unsigned tg = og / nx;
            if (og + 1u == (tg + 1u) * nx) xb_add(&bar[XB_TOPGEN], 1u);
            else XB_SPIN(xb_ld(&bar[XB_TOPGEN]) == tg, bar);
            __builtin_amdgcn_fence(__ATOMIC_ACQUIRE, "agent");
            xb_add(&bar[XB_XGEN(b.x)], 1u);
            asm volatile("s_waitcnt vmcnt(0)" ::: "memory");
        } else {
            XB_SPIN(xb_ld(&bar[XB_XGEN(b.x)]) == gen, bar);
            __builtin_amdgcn_fence(__ATOMIC_ACQUIRE, "agent");
            asm volatile("s_waitcnt vmcnt(0)" ::: "memory");
        }
    }
    __syncthreads();
}
constexpr int NWAVES = 8;
constexpr int BATCH = 16, SEQ = 2048, DM = 1024, M = BATCH * SEQ;
constexpr int L0P = 3584;
constexpr int L1P = 2048;
constexpr int DFF = 2816;
constexpr float ALPHA = 1.4142135623730951f;
typedef unsigned short bf16_t;
typedef float f32x16 __attribute__((ext_vector_type(16)));

constexpr size_t MiB = 1u << 20;
constexpr size_t WS_CTL = 0, CTL_ZERO_BYTES = 1 * MiB;
constexpr int CW_BAR = 4096;
constexpr size_t WS_W0IN = 2 * MiB, WS_W0OUT = 9 * MiB, WS_WUP0 = 11 * MiB, WS_WDN0 = 22 * MiB, WS_W1IN = 28 * MiB, WS_WUQ = 32 * MiB, WS_WUKV = 33 * MiB,
                 WS_W1OUT = 34 * MiB, WS_WUP1 = 36 * MiB, WS_WDN1 = 47 * MiB;
constexpr size_t WS_XB = 56 * MiB, WS_YMIX = 120 * MiB, WS_BIG = 184 * MiB;
constexpr size_t WS_G = 408 * MiB, WS_BONUS = 440 * MiB, WS_DT = 441 * MiB, WS_XST = 442 * MiB, WS_BT = 474 * MiB, WS_ASUM = 490 * MiB;
constexpr size_t WS_SLOC = 120 * MiB;
constexpr size_t WS_W2T = 53 * MiB, WS_A2T = 53 * MiB + 256 * 1024, WS_G2T = 53 * MiB + 512 * 1024;
constexpr size_t WS_GU = 120 * MiB;
constexpr size_t WS_PROJ1 = 184 * MiB, WS_QM = 312 * MiB, WS_KVM = 360 * MiB, WS_KPE = 424 * MiB, WS_RS = 426 * MiB;
constexpr size_t WS_CSTAB = 492 * MiB;
constexpr size_t WS_VTS = 428 * MiB, WS_VTM = 460 * MiB;
constexpr size_t WS_NEED = 497 * MiB;

constexpr int RING_BYTES = 131072;
constexpr int LDSCTL_OFF = 146432, MISC_OFF = LDSCTL_OFF + 320;
constexpr int LDS_BYTES = 147456;

__device__ __forceinline__ float bf2f(bf16_t b) { return __builtin_bit_cast(float, (unsigned)b << 16); }
__device__ __forceinline__ float sigmoidf_(float x) { return 1.f / (1.f + expf(-x)); }
__device__ __forceinline__ float softplusf_(float x) { return fmaxf(x, 0.f) + log1pf(expf(-fabsf(x))); }
__device__ __forceinline__ float siluf_(float x) { return x / (1.f + expf(-x)); }
__device__ __forceinline__ float wave_sum(float v) {
#pragma unroll
    for (int o = 1; o < 64; o <<= 1) v += __shfl_xor(v, o);
    return v;
}
#define WSYNC() asm volatile("s_waitcnt lgkmcnt(0)" ::: "memory")
typedef float f32x2_t __attribute__((ext_vector_type(2)));
typedef __bf16 bf16x2_t __attribute__((ext_vector_type(2)));
typedef unsigned u32x2 __attribute__((ext_vector_type(2)));
__device__ __forceinline__ unsigned cvtpk(float lo, float hi) { f32x2_t v = {lo, hi}; bf16x2_t b = __builtin_convertvector(v, bf16x2_t); return __builtin_bit_cast(unsigned, b); }
__device__ __forceinline__ float bflo(unsigned u) { return __builtin_bit_cast(float, u << 16); }
__device__ __forceinline__ float bfhi(unsigned u) { return __builtin_bit_cast(float, u & 0xffff0000u); }
__device__ __forceinline__ bf16_t bf1(float x) { return (bf16_t)(cvtpk(x, x) & 0xffffu); }
__device__ __forceinline__ bf16x8 pack8(float a0, float a1, float a2, float a3, float a4, float a5, float a6, float a7) {
    v4u w; w.x = cvtpk(a0, a1); w.y = cvtpk(a2, a3); w.z = cvtpk(a4, a5); w.w = cvtpk(a6, a7); return __builtin_bit_cast(bf16x8, w); }
template <int CTRL> __device__ __forceinline__ float dpp_mov(float x) { return __builtin_bit_cast(float, __builtin_amdgcn_update_dpp(0, __builtin_bit_cast(int, x), CTRL, 0xF, 0xF, true)); }
__device__ __forceinline__ float rowsum16(float x) { x += dpp_mov<0x128>(x); x += dpp_mov<0x124>(x); x += dpp_mov<0x122>(x); x += dpp_mov<0x121>(x); return x; }
__device__ __forceinline__ float rl(float x, int l) { return __builtin_bit_cast(float, __builtin_amdgcn_readlane(__builtin_bit_cast(int, x), l)); }
__device__ __forceinline__ float wave_sum_dpp(float x) { x = rowsum16(x); return (rl(x, 0) + rl(x, 16)) + (rl(x, 32) + rl(x, 48)); }

__device__ __forceinline__ void transpose_matrix(const float* __restrict__ W, int K, int N, bf16_t* __restrict__ WT, int Npad, int ldt, LAS float* scr, int gw, int NGW, int lane, const float* __restrict__ kscale, int& tr_base, bool ffn_interleave = false) {
    (void)scr;
    const int nblk = Npad / 64, nit = (K / 64) * nblk;
    int it0 = gw - (tr_base % NGW); if (it0 < 0) it0 += NGW; tr_base += nit;
    for (int it = it0; it < nit; it += NGW) {
        const int kb = it / nblk, nb = it - kb * nblk, n = nb * 64 + lane, k0 = kb * 64;
        const bool ok = n < N; const float* src = W + (size_t)k0 * N + (ok ? n : 0);
#pragma unroll
        for (int hc = 0; hc < 2; ++hc) {
            float v[32];
#pragma unroll
            for (int i = 0; i < 32; ++i) v[i] = src[(size_t)(hc * 32 + i) * N];
#pragma unroll
            for (int c = 0; c < 4; ++c) { float u[8];
#pragma unroll
                for (int i = 0; i < 8; ++i) { u[i] = ok ? v[c * 8 + i] : 0.f; if (kscale) u[i] *= kscale[k0 + hc * 32 + c * 8 + i]; }
                v4u o; o.x = cvtpk(u[0], u[1]); o.y = cvtpk(u[2], u[3]); o.z = cvtpk(u[4], u[5]); o.w = cvtpk(u[6], u[7]);
                const int nr = ffn_interleave ? ((n < DFF) ? 256 * (n >> 7) + (n & 127) : 256 * ((n - DFF) >> 7) + 128 + ((n - DFF) & 127)) : n;
                *(v4u*)(WT + (size_t)nr * ldt + k0 + hc * 32 + c * 8) = o; }
        }
    }
}

template <int MODE> __device__ __forceinline__ void ln_rows(float* h, bf16_t* hb, float* stats, const float* __restrict__ g, const float* __restrict__ b, int gw, int NGW, int lane) {
    for (int row = gw * 2; row < M; row += NGW * 2) {
        float* p = h + (size_t)row * DM;
        f32x4 v[2][4]; float s[2] = {0.f, 0.f};
#pragma unroll
        for (int r = 0; r < 2; ++r)
#pragma unroll
            for (int j = 0; j < 4; ++j) v[r][j] = *(const f32x4*)(p + r * DM + 4 * lane + 256 * j);
#pragma unroll
        for (int r = 0; r < 2; ++r)
#pragma unroll
            for (int j = 0; j < 4; ++j) s[r] += (v[r][j][0] + v[r][j][1]) + (v[r][j][2] + v[r][j][3]);
        float mean[2], q[2] = {0.f, 0.f}, rstd[2];
#pragma unroll
        for (int r = 0; r < 2; ++r) { mean[r] = wave_sum_dpp(s[r]) * (1.f / DM);
#pragma unroll
            for (int j = 0; j < 4; ++j) { v[r][j] = v[r][j] - mean[r]; q[r] += (v[r][j][0] * v[r][j][0] + v[r][j][1] * v[r][j][1]) + (v[r][j][2] * v[r][j][2] + v[r][j][3] * v[r][j][3]); } }
#pragma unroll
        for (int r = 0; r < 2; ++r) rstd[r] = 1.0f / sqrtf(wave_sum_dpp(q[r]) * (1.f / DM) + 1e-5f);
        if (MODE == 1 && lane < 2) { stats[2 * (row + lane)] = lane ? mean[1] : mean[0]; stats[2 * (row + lane) + 1] = lane ? rstd[1] : rstd[0]; }
#pragma unroll
        for (int j = 0; j < 4; ++j) {
            const int c = 4 * lane + 256 * j;
            const f32x4 gg = *(const f32x4*)(g + c), bb = *(const f32x4*)(b + c);
#pragma unroll
            for (int r = 0; r < 2; ++r) {
                const f32x4 o = v[r][j] * rstd[r] * gg + bb;
                if (MODE == 1) { uint2 w; w.x = cvtpk(o[0], o[1]); w.y = cvtpk(o[2], o[3]); *(uint2*)(hb + (size_t)(row + r) * DM + c) = w; }
                else *(f32x4*)(p + r * DM + c) = o;
            }
        }
    }
}

__device__ __forceinline__ void rwkv_naive_chain(int chain, int lane, LAS float* sm, const bf16_t* __restrict__ proj, const float* __restrict__ mix, const float* __restrict__ w0, const float* __restrict__ w2,
                                                 const float* __restrict__ a0, const float* __restrict__ a2, const float* __restrict__ g2, const float* __restrict__ k_k,
                                                 const float* __restrict__ k_a, const float* __restrict__ r_k, const float* __restrict__ ln_g, const float* __restrict__ ln_b, bf16_t* __restrict__ ymix) {
    LAS float* s_w2 = sm; LAS float* s_a2 = sm + 4096; LAS float* s_g2 = sm + 8192; LAS float* s_tw = sm + 16384; LAS float* s_al = s_tw + 64; LAS float* s_sg = s_tw + 128;
    LAS float* s_w = s_tw + 256; LAS float* s_k = s_tw + 320; LAS float* s_a = s_tw + 384; LAS float* s_b = s_tw + 448; LAS float* s_r = s_tw + 512;
    const int b = chain >> 3, h = chain & 7, c = h * 64 + lane;
    for (int l = 0; l < 64; ++l) { s_w2[l * 64 + lane] = w2[l * 512 + c]; s_a2[l * 64 + lane] = a2[l * 512 + c]; }
    for (int l = 0; l < 128; ++l) s_g2[l * 64 + lane] = g2[l * 512 + c];
    const float mr = mix[c], mk = mix[512 + c], mv = mix[1024 + c], mw = mix[1536 + lane], ma = mix[1600 + lane], mg0 = mix[1664 + lane], mg1 = mix[1728 + lane];
    const float w0c = w0[c], a0c = a0[c], kkc = k_k[c], kac = k_a[c], rkc = r_k[c], lgc = ln_g[c], lbc = ln_b[c];
    float S[64];
#pragma unroll
    for (int j = 0; j < 64; ++j) S[j] = 0.f;
    float pr = 0.f, pk = 0.f, pv = 0.f, pw = 0.f, pa = 0.f, pg0 = 0.f, pg1 = 0.f;
    WSYNC();
    for (int t = 0; t < SEQ; ++t) {
        const bf16_t* row = proj + (size_t)(b * SEQ + t) * L0P;
        const float cr = bf2f(row[c]), ck = bf2f(row[512 + c]), cv = bf2f(row[1024 + c]), cw = bf2f(row[1536 + lane]), ca = bf2f(row[1600 + lane]),
                    cg0 = bf2f(row[1664 + lane]), cg1 = bf2f(row[1728 + lane]);
        const float r_s = cr + (pr - cr) * mr, k_s = ck + (pk - ck) * mk, v_s = cv + (pv - cv) * mv;
        const float wl = cw + (pw - cw) * mw, al = ca + (pa - ca) * ma, g0 = cg0 + (pg0 - cg0) * mg0, g1 = cg1 + (pg1 - cg1) * mg1;
        pr = cr; pk = ck; pv = cv; pw = cw; pa = ca; pg0 = cg0; pg1 = cg1;
        s_tw[lane] = tanhf(wl); s_al[lane] = al; s_sg[lane] = sigmoidf_(g0); s_sg[64 + lane] = sigmoidf_(g1);
        WSYNC();
        float wsum = w0c, asum = a0c, gsum = 0.f;
#pragma unroll 2
        for (int l = 0; l < 64; ++l) { wsum += s_tw[l] * s_w2[l * 64 + lane]; asum += s_al[l] * s_a2[l * 64 + lane]; }
#pragma unroll 2
        for (int l = 0; l < 128; ++l) gsum += s_sg[l] * s_g2[l * 64 + lane];
        const float log_w = -softplusf_(-wsum) - 0.5f;
        const float dec = expf(-expf(log_w));
        const float a = sigmoidf_(asum);
        float kkv = k_s * kkc;
        const float nrm = sqrtf(wave_sum(kkv * kkv));
        kkv = kkv / fmaxf(nrm, 1e-12f);
        const float k2 = k_s * (1.f + (a - 1.f) * kac);
        const float bonus_s = wave_sum(r_s * k2 * rkc);
        s_w[lane] = dec; s_k[lane] = k2; s_a[lane] = -kkv; s_b[lane] = kkv * a; s_r[lane] = r_s;
        WSYNC();
        float sa = 0.f;
#pragma unroll
        for (int j = 0; j < 64; ++j) sa += S[j] * s_a[j];
        float y = 0.f;
#pragma unroll
        for (int j = 0; j < 64; ++j) { S[j] = S[j] * s_w[j] + sa * s_b[j] + v_s * s_k[j]; y += S[j] * s_r[j]; }
        const float mu = wave_sum(y) * (1.f / 64.f);
        const float d = y - mu;
        const float var = wave_sum(d * d) * (1.f / 64.f);
        const float yn = d * (1.0f / sqrtf(var + 64e-5f)) * lgc + lbc;
        const float o = (yn + bonus_s * v_s) * gsum;
        ymix[(size_t)(b * SEQ + t) * DM + c] = (bf16_t)f2bf(o);
        WSYNC();
    }
}

__device__ __forceinline__ void ssm_conv_all(const bf16_t* __restrict__ proj, const float* __restrict__ cw, const float* __restrict__ cb, const float* __restrict__ dtb,
                                             bf16_t* __restrict__ xbc, float* __restrict__ dt, int gtid, int NT) {
    for (size_t i = gtid; i < (size_t)M * 1024; i += NT) {
        const int m = (int)(i >> 10), c = (int)(i & 1023), t = m & (SEQ - 1);
        float acc = cb[c];
#pragma unroll
        for (int k = 0; k < 4; ++k) { const int tt = t - 3 + k; if (tt >= 0) acc += cw[k * 1024 + c] * bf2f(proj[(size_t)(m - 3 + k) * L0P + 2304 + c]); }
        xbc[i] = (bf16_t)f2bf(siluf_(acc));
    }
    for (int i = gtid; i < M * 8; i += NT) dt[i] = softplusf_(bf2f(proj[(size_t)(i >> 3) * L0P + 3328 + (i & 7)]) + dtb[i & 7]);
}
__device__ __forceinline__ void ssd_naive_task(int task, int lane, const bf16_t* __restrict__ xbc, const float* __restrict__ dt, const float* __restrict__ a_log, const float* __restrict__ dsk, float* __restrict__ yssm) {
    const int chain = task >> 2, q = task & 3, b = chain >> 3, h = chain & 7, g = h >> 2, p = q * 16 + (lane >> 2), nq = lane & 3;
    const float A = -expf(a_log[h]), D = dsk[h];
    float st[32];
#pragma unroll
    for (int n = 0; n < 32; ++n) st[n] = 0.f;
    for (int t = 0; t < SEQ; ++t) {
        const size_t m = (size_t)b * SEQ + t;
        const float dtv = dt[m * 8 + h], dA = expf(dtv * A);
        const float x = bf2f(xbc[m * 1024 + h * 64 + p]), xdt = x * dtv;
        const bf16_t* Bp = xbc + m * 1024 + 512 + g * 128 + nq * 32;
        const bf16_t* Cp = xbc + m * 1024 + 768 + g * 128 + nq * 32;
        float yp = 0.f;
#pragma unroll
        for (int n = 0; n < 32; ++n) { st[n] = st[n] * dA + xdt * bf2f(Bp[n]); yp += st[n] * bf2f(Cp[n]); }
        yp += __shfl_xor(yp, 1); yp += __shfl_xor(yp, 2);
        if (nq == 0) yssm[m * 512 + h * 64 + p] = yp + D * x;
    }
}
template <bool ST = true> __device__ __forceinline__ void ssm_gate_norm_all(const bf16_t* __restrict__ yssm, const bf16_t* __restrict__ proj, const float* __restrict__ ng, bf16_t* __restrict__ ymix, int wv0, int wvend, int lane) {
    for (int wvb = wv0 * 4 - (wv0 & ~7) * 3; wvb < wvend; wvb += NWAVES * 4) {
        float u[4][4], q[4];
#pragma unroll
        for (int k = 0; k < 4; ++k) { const int wv = wvb + k, m = wv >> 1, g = wv & 1; q[k] = 0.f;
#pragma unroll
            for (int j = 0; j < 4; ++j) { const int c = g * 256 + j * 64 + lane; const float z = bf2f(proj[(size_t)m * L0P + 1792 + c]); u[k][j] = bf2f(yssm[(size_t)m * 512 + c]) * (z * __builtin_amdgcn_rcpf(1.f + __expf(-z))); q[k] += u[k][j] * u[k][j]; } }
#pragma unroll
        for (int k = 0; k < 4; ++k) { const int wv = wvb + k, m = wv >> 1, g = wv & 1;
            const float rs = __builtin_amdgcn_rsqf(wave_sum_dpp(q[k]) * (1.f / 256.f) + 1e-5f);
#pragma unroll
            for (int j = 0; j < 4; ++j) { const int c = g * 256 + j * 64 + lane; const float o_ = u[k][j] * rs * ng[c]; if (ST) ymix[(size_t)m * DM + 512 + c] = bf1(o_); else asm volatile("" :: "v"(o_)); } }
    }
}
template <bool ST = true> __device__ __forceinline__ void ffn_act_all(bf16_t* gu, const float* __restrict__ cw, const float* __restrict__ cb, int gtid, int NT) {
    constexpr int NCH = DFF / 8, NSTRIP = M / 32;
    for (int task = gtid; task < NSTRIP * NCH; task += NT) {
        const int strip = task / NCH, q = task - strip * NCH, c0 = q * 8, m0 = strip * 32;
        float w0[8], w1[8], w2[8], bb[8], g2[8], g1[8];
#pragma unroll
        for (int j = 0; j < 8; j += 4) { const f32x4 a = *(const f32x4*)(cw + c0 + j), b = *(const f32x4*)(cw + DFF + c0 + j), c = *(const f32x4*)(cw + 2 * DFF + c0 + j), d = *(const f32x4*)(cb + c0 + j);
#pragma unroll
            for (int k = 0; k < 4; ++k) { w0[j + k] = a[k]; w1[j + k] = b[k]; w2[j + k] = c[k]; bb[j + k] = d[k]; } }
        bf16_t* base = gu + (size_t)m0 * (2 * DFF) + c0;
        if ((m0 & (SEQ - 1)) != 0) { const v4u a = *(const v4u*)(base - 2 * (2 * DFF)), b = *(const v4u*)(base - (2 * DFF));
            g2[0] = bflo(a.x); g2[1] = bfhi(a.x); g2[2] = bflo(a.y); g2[3] = bfhi(a.y); g2[4] = bflo(a.z); g2[5] = bfhi(a.z); g2[6] = bflo(a.w); g2[7] = bfhi(a.w);
            g1[0] = bflo(b.x); g1[1] = bfhi(b.x); g1[2] = bflo(b.y); g1[3] = bfhi(b.y); g1[4] = bflo(b.z); g1[5] = bfhi(b.z); g1[6] = bflo(b.w); g1[7] = bfhi(b.w); }
        else {
#pragma unroll
            for (int j = 0; j < 8; ++j) { g2[j] = 0.f; g1[j] = 0.f; } }
#pragma unroll 4
        for (int r = 0; r < 32; ++r) {
            const v4u gv = *(const v4u*)(base + (size_t)r * (2 * DFF)), uv = *(const v4u*)(base + (size_t)r * (2 * DFF) + DFF);
            const unsigned gw_[4] = {gv.x, gv.y, gv.z, gv.w}, uw_[4] = {uv.x, uv.y, uv.z, uv.w};
            unsigned ow[4];
#pragma unroll
            for (int k = 0; k < 4; ++k) {
                const float ga = bflo(gw_[k]), gb = bfhi(gw_[k]);
                const float ya = bb[2 * k] + w0[2 * k] * g2[2 * k] + w1[2 * k] * g1[2 * k] + w2[2 * k] * ga;
                const float yb = bb[2 * k + 1] + w0[2 * k + 1] * g2[2 * k + 1] + w1[2 * k + 1] * g1[2 * k + 1] + w2[2 * k + 1] * gb;
                g2[2 * k] = g1[2 * k]; g1[2 * k] = ga; g2[2 * k + 1] = g1[2 * k + 1]; g1[2 * k + 1] = gb;
                ow[k] = cvtpk(ya / (1.f + __expf(-ya)) * bflo(uw_[k]), yb / (1.f + __expf(-yb)) * bfhi(uw_[k]));
            }
            if (ST) *(v4u*)(base + (size_t)r * (2 * DFF) + DFF) = (v4u){ow[0], ow[1], ow[2], ow[3]}; else asm volatile("" :: "v"(ow[0]), "v"(ow[1]), "v"(ow[2]), "v"(ow[3]));
        }
    }
}
template <bool ST = true> __device__ __forceinline__ void mla_prep_all(const bf16_t* __restrict__ proj1, const int* __restrict__ pos, float* __restrict__ rs, bf16_t* __restrict__ kpe, float* __restrict__ cstab, int gw, int NGW, int lane) {
    for (int m4 = gw * 4; m4 < M; m4 += NGW * 4) {
        const int mt = m4 + (lane >> 4), fi = lane & 15;
        const double inv = exp2(-(double)(2 * fi) * (13.287712379549449 / 32.0));
        const double ang = (double)pos[mt] * inv;
        const float cs = (float)cos(ang), sn = (float)sin(ang);
        cstab[(size_t)mt * 32 + fi] = cs; cstab[(size_t)mt * 32 + 16 + fi] = sn;
        { const bf16_t* row = proj1 + (size_t)mt * L1P; const float x1 = bf2f(row[1920 + fi]), x2 = bf2f(row[1936 + fi]);
          kpe[(size_t)mt * 32 + fi] = bf1(x1 * cs - x2 * sn); kpe[(size_t)mt * 32 + 16 + fi] = bf1(x2 * cs + x1 * sn); }
        float q[4], k[4];
#pragma unroll
        for (int u = 0; u < 4; ++u) { const bf16_t* row = proj1 + (size_t)(m4 + u) * L1P; q[u] = 0.f; k[u] = 0.f;
#pragma unroll
            for (int j = 0; j < 4; ++j) { const float v = bf2f(row[1536 + j * 64 + lane]); q[u] += v * v; }
#pragma unroll
            for (int j = 0; j < 2; ++j) { const float v = bf2f(row[1792 + j * 64 + lane]); k[u] += v * v; } }
#pragma unroll
        for (int u = 0; u < 4; ++u) { q[u] = wave_sum_dpp(q[u]); k[u] = wave_sum_dpp(k[u]); }
        if (lane < 4) { const float qq = lane == 0 ? q[0] : lane == 1 ? q[1] : lane == 2 ? q[2] : q[3], kk2 = lane == 0 ? k[0] : lane == 1 ? k[1] : lane == 2 ? k[2] : k[3];
            rs[(size_t)(m4 + lane) * 2] = 1.0f / sqrtf(qq * (1.f / 256.f) + 1e-6f); rs[(size_t)(m4 + lane) * 2 + 1] = 1.0f / sqrtf(kk2 * (1.f / 128.f) + 1e-6f); }
    }
}
template <bool ST = true> __device__ __forceinline__ void rope_q_all(bf16_t* qm, const float* __restrict__ cstab, int gtid, int NT) {
    for (int i = gtid; i < M * 16; i += NT) {
        const int m = i >> 4, h = (i >> 1) & 7, k0 = (i & 1) * 8;
        bf16_t* p = qm + (size_t)m * 768 + h * 96 + 64 + k0;
        const v4u a = *(const v4u*)p, b = *(const v4u*)(p + 16);
        const f32x4 c0 = *(const f32x4*)(cstab + (size_t)m * 32 + k0), c1 = *(const f32x4*)(cstab + (size_t)m * 32 + k0 + 4), s0 = *(const f32x4*)(cstab + (size_t)m * 32 + 16 + k0), s1 = *(const f32x4*)(cstab + (size_t)m * 32 + 16 + k0 + 4);
        const unsigned au[4] = {a.x, a.y, a.z, a.w}, bu[4] = {b.x, b.y, b.z, b.w};
        const float cs[8] = {c0[0], c0[1], c0[2], c0[3], c1[0], c1[1], c1[2], c1[3]}, sn[8] = {s0[0], s0[1], s0[2], s0[3], s1[0], s1[1], s1[2], s1[3]};
        unsigned o1[4], o2[4];
#pragma unroll
        for (int q = 0; q < 4; ++q) { const float x1a = bflo(au[q]), x1b = bfhi(au[q]), x2a = bflo(bu[q]), x2b = bfhi(bu[q]);
            o1[q] = cvtpk(x1a * cs[2 * q] - x2a * sn[2 * q], x1b * cs[2 * q + 1] - x2b * sn[2 * q + 1]);
            o2[q] = cvtpk(x2a * cs[2 * q] + x1a * sn[2 * q], x2b * cs[2 * q + 1] + x1b * sn[2 * q + 1]); }
        if (ST) { *(v4u*)p = (v4u){o1[0], o1[1], o1[2], o1[3]}; *(v4u*)(p + 16) = (v4u){o2[0], o2[1], o2[2], o2[3]}; }
    }
}
__device__ __forceinline__ void sb_naive_task(int qblk, int bh, int lane, const bf16_t* __restrict__ proj1, bf16_t* __restrict__ ymix) {
    const int b = bh >> 3, h = bh & 7, t = qblk * 64 + lane;
    const size_t mrow = (size_t)b * SEQ;
    float q[64], o[64];
#pragma unroll
    for (int d = 0; d < 64; ++d) { q[d] = bf2f(proj1[(mrow + t) * L1P + h * 64 + d]) * 0.125f; o[d] = 0.f; }
    float cum = 0.f;
    const int smax = qblk * 64 + 63;
    for (int s = smax - 1; s >= 0; --s) {
        const bf16_t* kr = proj1 + (mrow + s) * L1P + 512 + h * 64;
        const bf16_t* vr = proj1 + (mrow + s) * L1P + 1024 + h * 64;
        float z = 0.f;
#pragma unroll
        for (int d = 0; d < 64; ++d) z += q[d] * bf2f(kr[d]);
        if (s < t) {
            const float lsp = -softplusf_(-z);
            const float lsn = -softplusf_(z);
            const float att = expf(lsp + cum);
            cum += lsn;
#pragma unroll
            for (int d = 0; d < 64; ++d) o[d] += att * bf2f(vr[d]);
        }
    }
#pragma unroll
    for (int d = 0; d < 64; ++d) ymix[(mrow + t) * DM + h * 64 + d] = (bf16_t)f2bf(o[d]);
}
__device__ __forceinline__ void mla_naive_task(int qblk, int bh, int lane, const bf16_t* __restrict__ qm, const bf16_t* __restrict__ kvm, const bf16_t* __restrict__ kpe, bf16_t* __restrict__ ymix) {
    const int b = bh >> 3, h = bh & 7, t = qblk * 64 + lane;
    const size_t mrow = (size_t)b * SEQ;
    const float scale = 0.10206207261596577f;
    float q[96], o[64];
#pragma unroll
    for (int d = 0; d < 96; ++d) q[d] = bf2f(qm[(mrow + t) * 768 + h * 96 + d]) * scale;
#pragma unroll
    for (int d = 0; d < 64; ++d) o[d] = 0.f;
    float mx = -1e30f, l = 0.f;
    const int smax = qblk * 64 + 63;
    for (int s = 0; s <= smax; ++s) {
        const bf16_t* kr = kvm + (mrow + s) * 1024 + h * 128;
        const bf16_t* pr = kpe + (mrow + s) * 32;
        float z = 0.f;
#pragma unroll
        for (int d = 0; d < 64; ++d) z += q[d] * bf2f(kr[d]);
#pragma unroll
        for (int d = 0; d < 32; ++d) z += q[64 + d] * bf2f(pr[d]);
        if (s <= t) {
            const float mn = fmaxf(mx, z), f = expf(mx - mn), pz = expf(z - mn);
            l = l * f + pz; mx = mn;
#pragma unroll
            for (int d = 0; d < 64; ++d) o[d] = o[d] * f + pz * bf2f(kr[64 + d]);
        }
    }
    const float il = 1.f / l;
#pragma unroll
    for (int d = 0; d < 64; ++d) ymix[(mrow + t) * DM + 512 + h * 64 + d] = (bf16_t)f2bf(o[d] * il);
}


__device__ __forceinline__ int crow(int r, int hi) { return (r & 3) + 8 * (r >> 2) + 4 * hi; }
#define MFMA32(a, b, c) __builtin_amdgcn_mfma_f32_32x32x16_bf16((a), (b), (c), 0, 0, 0)
constexpr int STG_PITCH = 72;
__device__ __forceinline__ void transpose_tile64(const bf16_t* __restrict__ src, int sp, bf16_t* __restrict__ dst, int dp, LAS bf16_t* scr, int lane) {
#pragma unroll
    for (int i = 0; i < 8; ++i) { const int row = i * 8 + (lane >> 3), ch = lane & 7; const v4u v = *(const v4u*)(src + (size_t)row * sp + ch * 8); *(LAS v4u*)(scr + row * STG_PITCH + ch * 8) = v; }
    WSYNC();
#pragma unroll
    for (int i = 0; i < 8; ++i) { const int d = i * 8 + (lane >> 3), tc = lane & 7; const LAS bf16_t* p = scr + (tc * 8) * STG_PITCH + d;
        v4u o; o.x = (unsigned)p[0] | ((unsigned)p[STG_PITCH] << 16); o.y = (unsigned)p[2 * STG_PITCH] | ((unsigned)p[3 * STG_PITCH] << 16);
        o.z = (unsigned)p[4 * STG_PITCH] | ((unsigned)p[5 * STG_PITCH] << 16); o.w = (unsigned)p[6 * STG_PITCH] | ((unsigned)p[7 * STG_PITCH] << 16);
        *(v4u*)(dst + (size_t)d * dp + tc * 8) = o; }
    WSYNC();
}
__device__ __forceinline__ void store_OT(const f32x16 (&o)[2], float sc, LAS bf16_t* stg, bf16_t* __restrict__ dst, int lane) {
    const int l31 = lane & 31, hi = lane >> 5;
#pragma unroll
    for (int dt = 0; dt < 2; ++dt)
#pragma unroll
        for (int r = 0; r < 16; ++r) stg[l31 * STG_PITCH + 32 * dt + crow(r, hi)] = bf1(o[dt][r] * sc);
    WSYNC();
#pragma unroll
    for (int i = 0; i < 4; ++i) { const int row = i * 8 + (lane >> 3), ch = lane & 7; const v4u v = *(const LAS v4u*)(stg + row * STG_PITCH + ch * 8); *(v4u*)(dst + (size_t)row * DM + ch * 8) = v; }
    WSYNC();
}
__device__ __forceinline__ float softplus_fast(float z) { return fmaxf(z, 0.f) + __logf(1.f + __expf(-fabsf(z))); }

__device__ __forceinline__ void sb_task(int bh, int qblk, int lane, const bf16_t* __restrict__ P1, const bf16_t* __restrict__ VT, bf16_t* __restrict__ ymix, LAS bf16_t* stg) {
    const int b = bh >> 3, h = bh & 7, l31 = lane & 31, hi = lane >> 5, q0 = qblk * 32, t = q0 + l31;
    const size_t rowb = (size_t)b * SEQ;
    const bf16_t* Qp = P1 + (rowb + q0 + l31) * L1P + h * 64 + 8 * hi;
    bf16x8 qf[4];
#pragma unroll
    for (int kk = 0; kk < 4; ++kk) qf[kk] = *(const bf16x8*)(Qp + 16 * kk);
    const bf16_t* Kp = P1 + (rowb + l31) * L1P + 512 + h * 64 + 8 * hi;
    const bf16_t* Vp = VT + ((size_t)bh * 64 + l31) * SEQ + 4 * hi;
    f32x16 o[2];
#pragma unroll
    for (int r = 0; r < 16; ++r) { o[0][r] = 0.f; o[1][r] = 0.f; }
    float cum = 0.f;
    bf16x8 kf[4]; u32x2 va[2][2][2];
#define SB_LOAD(S0, KF, VA) do { _Pragma("unroll") for (int kk = 0; kk < 4; ++kk) KF[kk] = *(const bf16x8*)(Kp + (size_t)(S0) * L1P + 16 * kk); \
        _Pragma("unroll") for (int dt = 0; dt < 2; ++dt) _Pragma("unroll") for (int ks = 0; ks < 2; ++ks) { VA[dt][ks][0] = *(const u32x2*)(Vp + (size_t)dt * 32 * SEQ + (S0) + 16 * ks); VA[dt][ks][1] = *(const u32x2*)(Vp + (size_t)dt * 32 * SEQ + (S0) + 16 * ks + 8); } } while (0)
    SB_LOAD(q0, kf, va);
    for (int s0 = q0; s0 >= 0; s0 -= 32) {
        bf16x8 kn[4]; u32x2 vn[2][2][2];
        const int sn = (s0 >= 32) ? s0 - 32 : 0;
        SB_LOAD(sn, kn, vn);
        f32x16 acc;
#pragma unroll
        for (int r = 0; r < 16; ++r) acc[r] = 0.f;
#pragma unroll
        for (int kk = 0; kk < 4; ++kk) acc = MFMA32(kf[kk], qf[kk], acc);
        const bool diag = (s0 == q0);
        float lb[16], lk[16];
#pragma unroll
        for (int r = 0; r < 16; ++r) { const float z = acc[r] * 0.125f; const float sp = softplus_fast(z); float b_ = z - sp, k_ = -sp;
            if (diag) { const bool valid = (s0 + crow(r, hi)) < t; b_ = valid ? b_ : -1e30f; k_ = valid ? k_ : 0.f; }
            lb[r] = b_; lk[r] = k_; }
        float e[16], T[4], U[4];
#pragma unroll
        for (int i = 0; i < 4; ++i) { e[4 * i + 3] = 0.f; e[4 * i + 2] = lk[4 * i + 3]; e[4 * i + 1] = e[4 * i + 2] + lk[4 * i + 2]; e[4 * i] = e[4 * i + 1] + lk[4 * i + 1]; T[i] = e[4 * i] + lk[4 * i]; }
#pragma unroll
        for (int i = 0; i < 4; ++i) U[i] = __shfl_xor(T[i], 32);
        float off[4];
        { const float st2 = T[3], st1 = st2 + T[2], st0 = st1 + T[1]; const float su2 = U[3], su1 = su2 + U[2], su0 = su1 + U[1];
          const float x0 = hi ? 0.f : U[0], x1 = hi ? 0.f : U[1], x2 = hi ? 0.f : U[2], x3 = hi ? 0.f : U[3];
          off[3] = x3; off[2] = st2 + su2 + x2; off[1] = st1 + su1 + x1; off[0] = st0 + su0 + x0;
          const float total = st0 + T[0] + su0 + U[0];
#pragma unroll
          for (int r = 0; r < 16; ++r) acc[r] = __expf(lb[r] + (cum + off[r >> 2] + e[r]));
          cum += total; }
        bf16x8 pf[2];
#pragma unroll
        for (int ks = 0; ks < 2; ++ks) { v4u w; w.x = cvtpk(acc[8 * ks], acc[8 * ks + 1]); w.y = cvtpk(acc[8 * ks + 2], acc[8 * ks + 3]); w.z = cvtpk(acc[8 * ks + 4], acc[8 * ks + 5]); w.w = cvtpk(acc[8 * ks + 6], acc[8 * ks + 7]); pf[ks] = __builtin_bit_cast(bf16x8, w); }
#pragma unroll
        for (int dt = 0; dt < 2; ++dt)
#pragma unroll
            for (int ks = 0; ks < 2; ++ks) { v4u a; a.x = va[dt][ks][0].x; a.y = va[dt][ks][0].y; a.z = va[dt][ks][1].x; a.w = va[dt][ks][1].y; o[dt] = MFMA32(__builtin_bit_cast(bf16x8, a), pf[ks], o[dt]); }
        if (__all(cum < -110.f)) break;
#pragma unroll
        for (int kk = 0; kk < 4; ++kk) kf[kk] = kn[kk];
#pragma unroll
        for (int dt = 0; dt < 2; ++dt)
#pragma unroll
            for (int ks = 0; ks < 2; ++ks) { va[dt][ks][0] = vn[dt][ks][0]; va[dt][ks][1] = vn[dt][ks][1]; }
    }
#undef SB_LOAD
    store_OT(o, 1.0f, stg, ymix + (rowb + q0) * DM + h * 64, lane);
}
__device__ __forceinline__ void mla_task(int bh, int qblk, int lane, const bf16_t* __restrict__ QM, const bf16_t* __restrict__ KVM, const bf16_t* __restrict__ KPE, const bf16_t* __restrict__ VT,
                                         bf16_t* __restrict__ ymix, LAS bf16_t* stg) {
    const int b = bh >> 3, h = bh & 7, l31 = lane & 31, hi = lane >> 5, q0 = qblk * 32, t = q0 + l31;
    const size_t rowb = (size_t)b * SEQ;
    const bf16_t* Qp = QM + (rowb + q0 + l31) * 768 + h * 96 + 8 * hi;
    bf16x8 qf[6];
#pragma unroll
    for (int kk = 0; kk < 6; ++kk) qf[kk] = *(const bf16x8*)(Qp + 16 * kk);
    const bf16_t* Kn = KVM + (rowb + l31) * 1024 + h * 128 + 8 * hi;
    const bf16_t* Kr = KPE + (rowb + l31) * 32 + 8 * hi;
    const bf16_t* Vp = VT + ((size_t)bh * 64 + l31) * SEQ + 4 * hi;
    const float sc2 = 0.10206207261596577f * 1.4426950408889634f;
    f32x16 o[2];
#pragma unroll
    for (int r = 0; r < 16; ++r) { o[0][r] = 0.f; o[1][r] = 0.f; }
    float mrun = -1e30f, lsum = 0.f;
    bf16x8 kf[6]; u32x2 va[2][2][2];
#define ML_LOAD(S0, KF, VA) do { _Pragma("unroll") for (int kk = 0; kk < 4; ++kk) KF[kk] = *(const bf16x8*)(Kn + (size_t)(S0) * 1024 + 16 * kk); \
        _Pragma("unroll") for (int kk = 0; kk < 2; ++kk) KF[4 + kk] = *(const bf16x8*)(Kr + (size_t)(S0) * 32 + 16 * kk); \
        _Pragma("unroll") for (int dt = 0; dt < 2; ++dt) _Pragma("unroll") for (int ks = 0; ks < 2; ++ks) { VA[dt][ks][0] = *(const u32x2*)(Vp + (size_t)dt * 32 * SEQ + (S0) + 16 * ks); VA[dt][ks][1] = *(const u32x2*)(Vp + (size_t)dt * 32 * SEQ + (S0) + 16 * ks + 8); } } while (0)
    ML_LOAD(0, kf, va);
    for (int s0 = 0; s0 <= q0; s0 += 32) {
        bf16x8 kn[6]; u32x2 vn[2][2][2];
        const int sn = (s0 + 32 <= q0) ? s0 + 32 : s0;
        ML_LOAD(sn, kn, vn);
        f32x16 acc;
#pragma unroll
        for (int r = 0; r < 16; ++r) acc[r] = 0.f;
#pragma unroll
        for (int kk = 0; kk < 6; ++kk) acc = MFMA32(kf[kk], qf[kk], acc);
        const bool diag = (s0 == q0);
        float tmax = -1e30f;
#pragma unroll
        for (int r = 0; r < 16; ++r) { float z = acc[r] * sc2; if (diag && (s0 + crow(r, hi)) > t) z = -1e30f; acc[r] = z; tmax = fmaxf(tmax, z); }
        tmax = fmaxf(tmax, __shfl_xor(tmax, 32));
        const float mn = fmaxf(mrun, tmax), alpha = exp2f(mrun - mn); mrun = mn;
        float ps = 0.f;
#pragma unroll
        for (int r = 0; r < 16; ++r) { acc[r] = exp2f(acc[r] - mn); ps += acc[r]; }
        lsum = lsum * alpha + ps;
#pragma unroll
        for (int r = 0; r < 16; ++r) { o[0][r] *= alpha; o[1][r] *= alpha; }
        bf16x8 pf[2];
#pragma unroll
        for (int ks = 0; ks < 2; ++ks) { v4u w; w.x = cvtpk(acc[8 * ks], acc[8 * ks + 1]); w.y = cvtpk(acc[8 * ks + 2], acc[8 * ks + 3]); w.z = cvtpk(acc[8 * ks + 4], acc[8 * ks + 5]); w.w = cvtpk(acc[8 * ks + 6], acc[8 * ks + 7]); pf[ks] = __builtin_bit_cast(bf16x8, w); }
#pragma unroll
        for (int dt = 0; dt < 2; ++dt)
#pragma unroll
            for (int ks = 0; ks < 2; ++ks) { v4u a; a.x = va[dt][ks][0].x; a.y = va[dt][ks][0].y; a.z = va[dt][ks][1].x; a.w = va[dt][ks][1].y; o[dt] = MFMA32(__builtin_bit_cast(bf16x8, a), pf[ks], o[dt]); }
#pragma unroll
        for (int kk = 0; kk < 6; ++kk) kf[kk] = kn[kk];
#pragma unroll
        for (int dt = 0; dt < 2; ++dt)
#pragma unroll
            for (int ks = 0; ks < 2; ++ks) { va[dt][ks][0] = vn[dt][ks][0]; va[dt][ks][1] = vn[dt][ks][1]; }
    }
#undef ML_LOAD
    lsum += __shfl_xor(lsum, 32);
    store_OT(o, 1.0f / lsum, stg, ymix + (rowb + q0) * DM + 512 + h * 64, lane);
}


constexpr int MLK_PITCH = 104, MLV_PITCH = 68, MLK_BYTES = 64 * MLK_PITCH * 2, MLV_BYTES = 64 * MLV_PITCH * 2, ML_STAGE = MLK_BYTES + MLV_BYTES;
__device__ __forceinline__ void mla_block(int bh, int sb, int tid, int lane, int wave, LAS unsigned char* lds, const bf16_t* __restrict__ QM, const bf16_t* __restrict__ KVM, const bf16_t* __restrict__ KPE,
                                          const bf16_t* __restrict__ VT, bf16_t* __restrict__ ymix) {
    const int b = bh >> 3, h = bh & 7, l31 = lane & 31, hi = lane >> 5, q0 = 256 * sb + 32 * wave, t = q0 + l31;
    const size_t rowb = (size_t)b * SEQ;
    const int nsteps = 4 * sb + 4;
    bf16x8 qf[6];
    { const bf16_t* Qp = QM + (rowb + q0 + l31) * 768 + h * 96 + 8 * hi;
#pragma unroll
      for (int kk = 0; kk < 6; ++kk) qf[kk] = *(const bf16x8*)(Qp + 16 * kk); }
    const float sc2 = 0.10206207261596577f * 1.4426950408889634f;
    f32x16 o[2];
#pragma unroll
    for (int r = 0; r < 16; ++r) { o[0][r] = 0.f; o[1][r] = 0.f; }
    float mrun = -1e30f, lsum = 0.f;
    const bf16_t* gKn = KVM + (rowb + (tid >> 3)) * 1024 + h * 128 + (tid & 7) * 8;
    const bf16_t* gKr = KPE + (rowb + ((tid & 255) >> 2)) * 32 + (tid & 3) * 8;
    const bf16_t* gVt = VT + ((size_t)bh * 64 + (tid >> 3)) * SEQ + (tid & 7) * 8;
    const int lKn = (tid >> 3) * (MLK_PITCH * 2) + (tid & 7) * 16, lKr = ((tid & 255) >> 2) * (MLK_PITCH * 2) + 128 + (tid & 3) * 16, lVt = MLK_BYTES + (tid >> 3) * (MLV_PITCH * 2) + (tid & 7) * 16;
    v4u rk, rr, rv;
    rk = *(const v4u*)gKn; rr = *(const v4u*)gKr; rv = *(const v4u*)gVt;
    *(LAS v4u*)(lds + lKn) = rk; if (tid < 256) *(LAS v4u*)(lds + lKr) = rr; *(LAS u32x2*)(lds + lVt) = (u32x2){rv.x, rv.y}; *(LAS u32x2*)(lds + lVt + 8) = (u32x2){rv.z, rv.w};
    __syncthreads();
#pragma unroll 1
    for (int step = 0; step < nsteps; ++step) {
        const int nx = (step + 1 < nsteps) ? step + 1 : step;
        rk = *(const v4u*)(gKn + (size_t)nx * 64 * 1024); rr = *(const v4u*)(gKr + (size_t)nx * 64 * 32); rv = *(const v4u*)(gVt + nx * 64);
        const LAS unsigned char* Kb = lds + (step & 1) * ML_STAGE;
        const LAS unsigned char* Vb = Kb + MLK_BYTES;
        if (64 * step <= q0) {
            f32x16 acc[2];
#pragma unroll
            for (int sub = 0; sub < 2; ++sub) {
#pragma unroll
                for (int r = 0; r < 16; ++r) acc[sub][r] = 0.f;
#pragma unroll
                for (int kk = 0; kk < 6; ++kk) { const bf16x8 kf = *(const LAS bf16x8*)(Kb + (32 * sub + l31) * (MLK_PITCH * 2) + (16 * kk + 8 * hi) * 2); acc[sub] = MFMA32(kf, qf[kk], acc[sub]); }
            }
            float tmax = -1e30f;
#pragma unroll
            for (int sub = 0; sub < 2; ++sub) { const int s0 = 64 * step + 32 * sub; const bool need_mask = (s0 + 31 > q0);
#pragma unroll
                for (int r = 0; r < 16; ++r) { float z = acc[sub][r] * sc2; if (need_mask && (s0 + crow(r, hi)) > t) z = -1e30f; acc[sub][r] = z; tmax = fmaxf(tmax, z); } }
            tmax = fmaxf(tmax, __shfl_xor(tmax, 32));
            const float mn = fmaxf(mrun, tmax), alpha = __builtin_amdgcn_exp2f(mrun - mn); mrun = mn;
            float ps = 0.f;
#pragma unroll
            for (int sub = 0; sub < 2; ++sub)
#pragma unroll
                for (int r = 0; r < 16; ++r) { acc[sub][r] = __builtin_amdgcn_exp2f(acc[sub][r] - mn); ps += acc[sub][r]; }
            lsum = lsum * alpha + ps;
#pragma unroll
            for (int r = 0; r < 16; ++r) { o[0][r] *= alpha; o[1][r] *= alpha; }
#pragma unroll
            for (int sub = 0; sub < 2; ++sub) {
                bf16x8 pf[2];
#pragma unroll
                for (int ks = 0; ks < 2; ++ks) pf[ks] = pack8(acc[sub][8 * ks], acc[sub][8 * ks + 1], acc[sub][8 * ks + 2], acc[sub][8 * ks + 3], acc[sub][8 * ks + 4], acc[sub][8 * ks + 5], acc[sub][8 * ks + 6], acc[sub][8 * ks + 7]);
#pragma unroll
                for (int dt = 0; dt < 2; ++dt)
#pragma unroll
                    for (int ks = 0; ks < 2; ++ks) { const LAS unsigned char* vp = Vb + (32 * dt + l31) * (MLV_PITCH * 2) + (32 * sub + 16 * ks + 4 * hi) * 2;
                        const u32x2 x0 = *(const LAS u32x2*)vp, x1 = *(const LAS u32x2*)(vp + 16);
                        v4u a; a.x = x0.x; a.y = x0.y; a.z = x1.x; a.w = x1.y; o[dt] = MFMA32(__builtin_bit_cast(bf16x8, a), pf[ks], o[dt]); }
            }
        }
        LAS unsigned char* nb = lds + ((step + 1) & 1) * ML_STAGE;
        *(LAS v4u*)(nb + lKn) = rk; if (tid < 256) *(LAS v4u*)(nb + lKr) = rr; *(LAS u32x2*)(nb + lVt) = (u32x2){rv.x, rv.y}; *(LAS u32x2*)(nb + lVt + 8) = (u32x2){rv.z, rv.w};
        __syncthreads();
    }
    lsum += __shfl_xor(lsum, 32);
    store_OT(o, 1.0f / lsum, (LAS bf16_t*)(lds + 2 * ML_STAGE) + wave * (32 * STG_PITCH), ymix + (rowb + q0) * DM + 512 + h * 64, lane);
    __syncthreads();
}


constexpr int SBK_PITCH = 72, SBK_BYTES = 64 * SBK_PITCH * 2, SB_STAGE = SBK_BYTES + MLV_BYTES;
__device__ __forceinline__ void sb_block(int bh, int sb, int tid, int lane, int wave, LAS unsigned char* lds, const bf16_t* __restrict__ P1, const bf16_t* __restrict__ VT, bf16_t* __restrict__ ymix) {
    const int b = bh >> 3, h = bh & 7, l31 = lane & 31, hi = lane >> 5, q0 = 256 * sb + 32 * wave, t = q0 + l31;
    const size_t rowb = (size_t)b * SEQ;
    bf16x8 qf[4];
    { const bf16_t* Qp = P1 + (rowb + q0 + l31) * L1P + h * 64 + 8 * hi;
#pragma unroll
      for (int kk = 0; kk < 4; ++kk) qf[kk] = *(const bf16x8*)(Qp + 16 * kk); }
    f32x16 o[2];
#pragma unroll
    for (int r = 0; r < 16; ++r) { o[0][r] = 0.f; o[1][r] = 0.f; }
    float cum = 0.f; bool done = false;
    volatile LAS unsigned* flags = (volatile LAS unsigned*)(lds + 2 * SB_STAGE);
    const bf16_t* gK = P1 + (rowb + (tid >> 3)) * L1P + 512 + h * 64 + (tid & 7) * 8;
    const bf16_t* gVt = VT + ((size_t)bh * 64 + (tid >> 3)) * SEQ + (tid & 7) * 8;
    const int lK = (tid >> 3) * (SBK_PITCH * 2) + (tid & 7) * 16, lVt = SBK_BYTES + (tid >> 3) * (MLV_PITCH * 2) + (tid & 7) * 16;
    const int top = 4 * sb + 3;
    v4u rk, rv;
    rk = *(const v4u*)(gK + (size_t)top * 64 * L1P); rv = *(const v4u*)(gVt + top * 64);
    *(LAS v4u*)(lds + lK) = rk; *(LAS u32x2*)(lds + lVt) = (u32x2){rv.x, rv.y}; *(LAS u32x2*)(lds + lVt + 8) = (u32x2){rv.z, rv.w};
    __syncthreads();
#pragma unroll 1
    for (int i = 0; i <= top; ++i) {
        const int step = top - i, nx = (step > 0) ? step - 1 : 0;
        rk = *(const v4u*)(gK + (size_t)nx * 64 * L1P); rv = *(const v4u*)(gVt + nx * 64);
        const LAS unsigned char* Kb = lds + (i & 1) * SB_STAGE;
        const LAS unsigned char* Vb = Kb + SBK_BYTES;
#pragma unroll
        for (int sub = 1; sub >= 0; --sub) {
            const int s0 = 64 * step + 32 * sub;
            if (s0 <= q0 && !done) {
                f32x16 acc;
#pragma unroll
                for (int r = 0; r < 16; ++r) acc[r] = 0.f;
#pragma unroll
                for (int kk = 0; kk < 4; ++kk) { const bf16x8 kf = *(const LAS bf16x8*)(Kb + (32 * sub + l31) * (SBK_PITCH * 2) + (16 * kk + 8 * hi) * 2); acc = MFMA32(kf, qf[kk], acc); }
                const bool diag = (s0 == q0);
                float lb[16], lk[16];
#pragma unroll
                for (int r = 0; r < 16; ++r) { const float z = acc[r] * 0.125f; const float sp = softplus_fast(z); float b_ = z - sp, k_ = -sp;
                    if (diag) { const bool valid = (s0 + crow(r, hi)) < t; b_ = valid ? b_ : -1e30f; k_ = valid ? k_ : 0.f; }
                    lb[r] = b_; lk[r] = k_; }
                float e[16], T[4], U[4];
#pragma unroll
                for (int q = 0; q < 4; ++q) { e[4 * q + 3] = 0.f; e[4 * q + 2] = lk[4 * q + 3]; e[4 * q + 1] = e[4 * q + 2] + lk[4 * q + 2]; e[4 * q] = e[4 * q + 1] + lk[4 * q + 1]; T[q] = e[4 * q] + lk[4 * q]; }
#pragma unroll
                for (int q = 0; q < 4; ++q) U[q] = __shfl_xor(T[q], 32);
                { const float st2 = T[3], st1 = st2 + T[2], st0 = st1 + T[1]; const float su2 = U[3], su1 = su2 + U[2], su0 = su1 + U[1];
                  const float x0 = hi ? 0.f : U[0], x1 = hi ? 0.f : U[1], x2 = hi ? 0.f : U[2], x3 = hi ? 0.f : U[3];
                  const float off[4] = {st0 + su0 + x0, st1 + su1 + x1, st2 + su2 + x2, x3};
                  const float total = st0 + T[0] + su0 + U[0];
#pragma unroll
                  for (int r = 0; r < 16; ++r) acc[r] = __expf(lb[r] + (cum + off[r >> 2] + e[r]));
                  cum += total; }
                bf16x8 pf[2];
#pragma unroll
                for (int ks = 0; ks < 2; ++ks) { v4u w; w.x = cvtpk(acc[8 * ks], acc[8 * ks + 1]); w.y = cvtpk(acc[8 * ks + 2], acc[8 * ks + 3]); w.z = cvtpk(acc[8 * ks + 4], acc[8 * ks + 5]); w.w = cvtpk(acc[8 * ks + 6], acc[8 * ks + 7]); pf[ks] = __builtin_bit_cast(bf16x8, w); }
#pragma unroll
                for (int dt = 0; dt < 2; ++dt)
#pragma unroll
                    for (int ks = 0; ks < 2; ++ks) { const LAS unsigned char* vp = Vb + (32 * dt + l31) * (MLV_PITCH * 2) + (32 * sub + 16 * ks + 4 * hi) * 2;
                        const u32x2 x0 = *(const LAS u32x2*)vp, x1 = *(const LAS u32x2*)(vp + 16);
                        v4u a; a.x = x0.x; a.y = x0.y; a.z = x1.x; a.w = x1.y; o[dt] = MFMA32(__builtin_bit_cast(bf16x8, a), pf[ks], o[dt]); }
                done = __all(cum < -110.f);
            }
        }
        if (lane == 0) flags[(i & 1) * 8 + wave] = done ? 1u : 0u;
        LAS unsigned char* nb = lds + ((i + 1) & 1) * SB_STAGE;
        *(LAS v4u*)(nb + lK) = rk; *(LAS u32x2*)(nb + lVt) = (u32x2){rv.x, rv.y}; *(LAS u32x2*)(nb + lVt + 8) = (u32x2){rv.z, rv.w};
        __syncthreads();
        unsigned nd = 0;
#pragma unroll
        for (int w8 = 0; w8 < 8; ++w8) nd += flags[(i & 1) * 8 + w8];
        if (nd == 8u) break;
    }
    store_OT(o, 1.0f, (LAS bf16_t*)(lds + 2 * SB_STAGE + 256) + wave * (32 * STG_PITCH), ymix + (rowb + q0) * DM + h * 64, lane);
    __syncthreads();
}

constexpr int RW_RAWW = 0, RW_RAWA = 2048, RW_RS = 4096, RW_KS = 6144, RW_VS = 8192;
constexpr int RW_CH0 = 10240, RW_CHSZ = 11328;
constexpr int RW_YB = RW_CH0 + 2 * RW_CHSZ;
constexpr int RW_MIX = RW_YB + 1024;
static_assert((RW_MIX + 256) * 4 <= 146432, "rwkv LDS map");
__device__ __forceinline__ float tanh_fast(float x) { return 1.f - 2.f * __builtin_amdgcn_rcpf(1.f + __expf(2.f * x)); }
__device__ __forceinline__ float sigmoid_fast(float x) { return __builtin_amdgcn_rcpf(1.f + __expf(-x)); }

#define MFMA16(a, b, c) __builtin_amdgcn_mfma_f32_16x16x32_bf16((a), (b), (c), 0, 0, 0)
constexpr int RW2_CH0 = 0, RW2_YB = 2 * RW_CHSZ, RW2_MIX = RW2_YB + 1024, RW2_STG = RW2_MIX + 448;
static_assert((RW2_STG + 2 * 3072) * 4 <= 146432, "rwkv LDS map");
__device__ __forceinline__ void rwkv_phase_scan(LAS float* sm, int tid, int lane, int wave, int blk, const bf16_t* __restrict__ proj, const float* __restrict__ mix, const float* __restrict__ w0, const float* __restrict__ a0,
                                           const float* __restrict__ k_k, const float* __restrict__ k_a, const float* __restrict__ r_k, const bf16_t* __restrict__ W2T, const bf16_t* __restrict__ A2T, const bf16_t* __restrict__ G2T,
                                           float* __restrict__ yraw, bf16_t* __restrict__ gout, float* __restrict__ bonus_out) {
    const int chain = blk >> 1, half = blk & 1, b = chain >> 3, h = chain & 7, l15 = lane & 15, kg = lane >> 4;
    const size_t rowb = (size_t)b * SEQ;
    constexpr int NCHUNK = SEQ / 32;
    if (tid < 256) sm[RW2_MIX + tid] = mix[1536 + tid];
    else if (tid < 448) { const int q = tid - 256; sm[RW2_MIX + tid] = mix[512 * (q >> 6) + h * 64 + (q & 63)]; }
    __syncthreads();
#define RW_SH8(CUR, PRV, M0, M1, OUT, PZ) do { const unsigned cu_[4] = {(CUR).x, (CUR).y, (CUR).z, (CUR).w}, pu_[4] = {(PRV).x, (PRV).y, (PRV).z, (PRV).w}; \
        const float mm_[8] = {(M0)[0], (M0)[1], (M0)[2], (M0)[3], (M1)[0], (M1)[1], (M1)[2], (M1)[3]}; \
        _Pragma("unroll") for (int q = 0; q < 4; ++q) { const float c0 = bflo(cu_[q]), c1 = bfhi(cu_[q]), p0 = bflo(pu_[q]) * (PZ), p1 = bfhi(pu_[q]) * (PZ); \
            OUT[2 * q] = c0 + (p0 - c0) * mm_[2 * q]; OUT[2 * q + 1] = c1 + (p1 - c1) * mm_[2 * q + 1]; } } while (0)
    if (wave < 4) {
        const int iA = 8 * wave + kg, iB = iA + 4, jseg = l15;
        float A0 = 0.f, A1 = 0.f, A2 = 0.f, A3 = 0.f, B0 = 0.f, B1 = 0.f, B2 = 0.f, B3 = 0.f;
        __syncthreads();
#pragma unroll 1
        for (int ch = 0; ch < NCHUNK; ++ch) {
            const int t0 = ch * 32;
            const LAS float* CHb = sm + RW2_CH0 + (ch & 1) * RW_CHSZ + 4 * jseg;
            const LAS float* CHv = sm + RW2_CH0 + (ch & 1) * RW_CHSZ + 10240 + iA;
            const LAS float* CHs = sm + RW2_CH0 + (ch & 1) * RW_CHSZ + 11264;
            f32x4 a4 = *(const LAS f32x4*)(CHb + 4096), wr4 = *(const LAS f32x4*)(CHb + 8192), w4 = *(const LAS f32x4*)(CHb), b4 = *(const LAS f32x4*)(CHb + 6144), k4 = *(const LAS f32x4*)(CHb + 2048);
            float vA = CHv[0], vB = CHv[4]; f32x2_t sc = *(const LAS f32x2_t*)(CHs);
#pragma unroll 2
            for (int t = 0; t < 32; ++t) {
                const int tq = (t + 1) & 31;
                const f32x4 a4n = *(const LAS f32x4*)(CHb + 4096 + tq * 64), wr4n = *(const LAS f32x4*)(CHb + 8192 + tq * 64), w4n = *(const LAS f32x4*)(CHb + tq * 64),
                            b4n = *(const LAS f32x4*)(CHb + 6144 + tq * 64), k4n = *(const LAS f32x4*)(CHb + 2048 + tq * 64);
                const float vAn = CHv[tq * 32], vBn = CHv[tq * 32 + 4]; const f32x2_t scn = *(const LAS f32x2_t*)(CHs + 2 * tq);
                float d1A = (A0 * a4[0] + A1 * a4[1]) + (A2 * a4[2] + A3 * a4[3]), d1B = (B0 * a4[0] + B1 * a4[1]) + (B2 * a4[2] + B3 * a4[3]);
                float d2A = (A0 * wr4[0] + A1 * wr4[1]) + (A2 * wr4[2] + A3 * wr4[3]), d2B = (B0 * wr4[0] + B1 * wr4[1]) + (B2 * wr4[2] + B3 * wr4[3]);
                d1A = rowsum16(d1A); d1B = rowsum16(d1B); d2A = rowsum16(d2A); d2B = rowsum16(d2B);
                const float yA = d2A + d1A * sc[0] + vA * sc[1], yB = d2B + d1B * sc[0] + vB * sc[1];
                A0 = A0 * w4[0] + (d1A * b4[0] + vA * k4[0]); A1 = A1 * w4[1] + (d1A * b4[1] + vA * k4[1]); A2 = A2 * w4[2] + (d1A * b4[2] + vA * k4[2]); A3 = A3 * w4[3] + (d1A * b4[3] + vA * k4[3]);
                B0 = B0 * w4[0] + (d1B * b4[0] + vB * k4[0]); B1 = B1 * w4[1] + (d1B * b4[1] + vB * k4[1]); B2 = B2 * w4[2] + (d1B * b4[2] + vB * k4[2]); B3 = B3 * w4[3] + (d1B * b4[3] + vB * k4[3]);
                if (jseg == 0) { sm[RW2_YB + t * 32 + iA] = yA; sm[RW2_YB + t * 32 + iB] = yB; }
                a4 = a4n; wr4 = wr4n; w4 = w4n; b4 = b4n; k4 = k4n; vA = vAn; vB = vBn; sc = scn;
            }
            WSYNC();
            { const int tt = lane >> 1, hh = lane & 1; const f32x4 yv = *(const LAS f32x4*)(sm + RW2_YB + tt * 32 + 8 * wave + 4 * hh);
              *(f32x4*)(yraw + (rowb + t0 + tt) * 512 + h * 64 + half * 32 + 8 * wave + 4 * hh) = yv; }
            __syncthreads();
        }
    } else if (wave < 6) {
        const int tp = wave - 4, tb = 16 * tp;
        LAS float* stg = sm + RW2_STG + tp * 3072;
        float w0c[4], a0c[4], kkc[4], kac[4], rkc[4];
#pragma unroll
        for (int nt = 0; nt < 4; ++nt) { const int c = h * 64 + 16 * nt + l15; w0c[nt] = w0[c]; a0c[nt] = a0[c]; kkc[nt] = k_k[c]; kac[nt] = k_a[c]; rkc[nt] = r_k[c]; }
        v4u ld[20];
#define PREP_ISSUE(T0) do { const int t0_ = (T0); { const size_t r_ = rowb + t0_ + tb + l15; const size_t rp_ = (t0_ + tb + l15 == 0) ? r_ : r_ - 1; \
            _Pragma("unroll") for (int lo = 0; lo < 2; ++lo) _Pragma("unroll") for (int ks = 0; ks < 2; ++ks) { const int col = 1536 + 64 * lo + 32 * ks + 8 * kg; \
                ld[(lo * 2 + ks) * 2] = *(const v4u*)(proj + r_ * L0P + col); ld[(lo * 2 + ks) * 2 + 1] = *(const v4u*)(proj + rp_ * L0P + col); } } \
            _Pragma("unroll") for (int ar = 0; ar < 3; ++ar) _Pragma("unroll") for (int i = 0; i < 2; ++i) { const int p_ = lane + 64 * i, row_ = p_ >> 3, c8_ = p_ & 7; \
                const size_t r_ = rowb + t0_ + tb + row_; const size_t rp_ = (t0_ + tb + row_ == 0) ? r_ : r_ - 1; const int col = 512 * ar + h * 64 + 8 * c8_; \
                ld[8 + (ar * 2 + i) * 2] = *(const v4u*)(proj + r_ * L0P + col); ld[8 + (ar * 2 + i) * 2 + 1] = *(const v4u*)(proj + rp_ * L0P + col); } } while (0)
#define PREP_BUILD(T0, NB) do { const int t0_ = (T0); LAS float* CHn = sm + RW2_CH0 + (NB) * RW_CHSZ; \
            f32x4 accw[4], acca[4]; \
            _Pragma("unroll") for (int nt = 0; nt < 4; ++nt) { accw[nt] = (f32x4){0.f, 0.f, 0.f, 0.f}; acca[nt] = (f32x4){0.f, 0.f, 0.f, 0.f}; } \
            { const float pz_ = (t0_ + tb + l15 == 0) ? 0.f : 1.f; \
              _Pragma("unroll") for (int lo = 0; lo < 2; ++lo) _Pragma("unroll") for (int ks = 0; ks < 2; ++ks) { float s_[8]; \
                const f32x4 m0 = *(const LAS f32x4*)(sm + RW2_MIX + 64 * lo + 32 * ks + 8 * kg), m1 = *(const LAS f32x4*)(sm + RW2_MIX + 64 * lo + 32 * ks + 8 * kg + 4); \
                RW_SH8(ld[(lo * 2 + ks) * 2], ld[(lo * 2 + ks) * 2 + 1], m0, m1, s_, pz_); \
                if (lo == 0) { _Pragma("unroll") for (int j = 0; j < 8; ++j) s_[j] = tanh_fast(s_[j]); } \
                v4u aw; aw.x = cvtpk(s_[0], s_[1]); aw.y = cvtpk(s_[2], s_[3]); aw.z = cvtpk(s_[4], s_[5]); aw.w = cvtpk(s_[6], s_[7]); const bf16x8 af = __builtin_bit_cast(bf16x8, aw); \
                const bf16_t* WT = lo ? A2T : W2T; \
                _Pragma("unroll") for (int nt = 0; nt < 4; ++nt) { const bf16x8 bfr = *(const bf16x8*)(WT + (size_t)(h * 64 + 16 * nt + l15) * 64 + 32 * ks + 8 * kg); \
                    if (lo == 0) accw[nt] = MFMA16(af, bfr, accw[nt]); else acca[nt] = MFMA16(af, bfr, acca[nt]); } } } \
            _Pragma("unroll") for (int ar = 0; ar < 3; ++ar) _Pragma("unroll") for (int i = 0; i < 2; ++i) { const int p_ = lane + 64 * i, row_ = p_ >> 3, c8_ = p_ & 7; float s_[8]; \
                const float pz_ = (t0_ + tb + row_ == 0) ? 0.f : 1.f; const f32x4 m0 = *(const LAS f32x4*)(sm + RW2_MIX + 256 + ar * 64 + c8_ * 8), m1 = *(const LAS f32x4*)(sm + RW2_MIX + 256 + ar * 64 + c8_ * 8 + 4); \
                RW_SH8(ld[8 + (ar * 2 + i) * 2], ld[8 + (ar * 2 + i) * 2 + 1], m0, m1, s_, pz_); \
                *(LAS f32x4*)(stg + ar * 1024 + row_ * 64 + c8_ * 8) = (f32x4){s_[0], s_[1], s_[2], s_[3]}; *(LAS f32x4*)(stg + ar * 1024 + row_ * 64 + c8_ * 8 + 4) = (f32x4){s_[4], s_[5], s_[6], s_[7]}; } \
            WSYNC(); \
            PREP_ISSUE(((T0) + 32 < SEQ) ? (T0) + 32 : (T0)); \
            _Pragma("unroll") for (int rg = 0; rg < 4; ++rg) { const int tl = 4 * kg + rg, t = tb + tl; \
                float r_[4], k_[4], v_[4], kkv[4], nrm2 = 0.f; \
                _Pragma("unroll") for (int nt = 0; nt < 4; ++nt) { r_[nt] = stg[tl * 64 + 16 * nt + l15]; k_[nt] = stg[1024 + tl * 64 + 16 * nt + l15]; v_[nt] = stg[2048 + tl * 64 + 16 * nt + l15]; \
                    kkv[nt] = k_[nt] * kkc[nt]; nrm2 += kkv[nt] * kkv[nt]; } \
                nrm2 = rowsum16(nrm2); const float rn = __builtin_amdgcn_rsqf(fmaxf(nrm2, 1e-24f)); \
                float br = 0.f, kr = 0.f, bon = 0.f; \
                _Pragma("unroll") for (int nt = 0; nt < 4; ++nt) { const int j = 16 * nt + l15; \
                    const float wsum = w0c[nt] + accw[nt][rg]; const float logw = -softplus_fast(-wsum) - 0.5f; const float dec = __expf(-__expf(logw)); \
                    const float a_ = sigmoid_fast(a0c[nt] + acca[nt][rg]); const float kn = kkv[nt] * rn; \
                    const float k2 = k_[nt] * (1.f + (a_ - 1.f) * kac[nt]); const float bv = kn * a_; \
                    br += bv * r_[nt]; kr += k2 * r_[nt]; bon += r_[nt] * k2 * rkc[nt]; \
                    CHn[t * 64 + j] = dec; CHn[2048 + t * 64 + j] = k2; CHn[4096 + t * 64 + j] = -kn; CHn[6144 + t * 64 + j] = bv; CHn[8192 + t * 64 + j] = dec * r_[nt]; \
                    if ((nt >> 1) == half) CHn[10240 + t * 32 + (j & 31)] = v_[nt]; } \
                br = rowsum16(br); kr = rowsum16(kr); bon = rowsum16(bon); \
                if (l15 == 0) { CHn[11264 + 2 * t] = br; CHn[11264 + 2 * t + 1] = kr; if (half == 0) bonus_out[(rowb + t0_ + t) * 8 + h] = bon; } } \
            WSYNC(); } while (0)
        PREP_ISSUE(0);
        PREP_BUILD(0, 0);
        __syncthreads();
#pragma unroll 1
        for (int ch = 0; ch < NCHUNK; ++ch) {
            if (ch + 1 < NCHUNK) PREP_BUILD(ch * 32 + 32, (ch + 1) & 1);
            __syncthreads();
        }
#undef PREP_ISSUE
#undef PREP_BUILD
    } else {
        const int tp = wave - 6, tb = 16 * tp;
        v4u ld[8];
#define G_ISSUE(T0) do { const int t0_ = (T0); const size_t r_ = rowb + t0_ + tb + l15; const size_t rp_ = (t0_ + tb + l15 == 0) ? r_ : r_ - 1; \
            _Pragma("unroll") for (int ks = 0; ks < 4; ++ks) { const int col = 1664 + 32 * ks + 8 * kg; ld[2 * ks] = *(const v4u*)(proj + r_ * L0P + col); ld[2 * ks + 1] = *(const v4u*)(proj + rp_ * L0P + col); } } while (0)
#define G_BUILD(T0) do { const int t0_ = (T0); f32x4 accg[2] = {(f32x4){0.f, 0.f, 0.f, 0.f}, (f32x4){0.f, 0.f, 0.f, 0.f}}; const float pz_ = (t0_ + tb + l15 == 0) ? 0.f : 1.f; \
            _Pragma("unroll") for (int ks = 0; ks < 4; ++ks) { float s_[8]; \
                const f32x4 m0 = *(const LAS f32x4*)(sm + RW2_MIX + 128 + 32 * ks + 8 * kg), m1 = *(const LAS f32x4*)(sm + RW2_MIX + 128 + 32 * ks + 8 * kg + 4); \
                RW_SH8(ld[2 * ks], ld[2 * ks + 1], m0, m1, s_, pz_); \
                _Pragma("unroll") for (int j = 0; j < 8; ++j) s_[j] = sigmoid_fast(s_[j]); \
                v4u aw; aw.x = cvtpk(s_[0], s_[1]); aw.y = cvtpk(s_[2], s_[3]); aw.z = cvtpk(s_[4], s_[5]); aw.w = cvtpk(s_[6], s_[7]); const bf16x8 af = __builtin_bit_cast(bf16x8, aw); \
                _Pragma("unroll") for (int nt = 0; nt < 2; ++nt) { const bf16x8 bfr = *(const bf16x8*)(G2T + (size_t)(h * 64 + half * 32 + 16 * nt + l15) * 128 + 32 * ks + 8 * kg); accg[nt] = MFMA16(af, bfr, accg[nt]); } } \
            G_ISSUE(((T0) + 32 < SEQ) ? (T0) + 32 : (T0)); \
            _Pragma("unroll") for (int nt = 0; nt < 2; ++nt) _Pragma("unroll") for (int rg = 0; rg < 4; ++rg) \
                gout[(rowb + t0_ + tb + 4 * kg + rg) * 512 + h * 64 + half * 32 + 16 * nt + l15] = (bf16_t)f2bf(accg[nt][rg]); } while (0)
        G_ISSUE(0);
        G_BUILD(0);
        __syncthreads();
#pragma unroll 1
        for (int ch = 0; ch < NCHUNK; ++ch) {
            if (ch + 1 < NCHUNK) G_BUILD(ch * 32 + 32);
            __syncthreads();
        }
#undef G_ISSUE
#undef G_BUILD
    }
#undef RW_SH8
    __syncthreads();
}

constexpr int CK_BK = 0, CK_AR = 4608, CK_BBT = 9216, CK_KBT = 12288, CK_VT = 15360, CK_GC = 16896, CK_TT = 17152, CK_SLOT = 18688, CK_NSLOT = 6, CK_NBUILD = 5;
constexpr int CK_STG = CK_SLOT * CK_NSLOT;
constexpr int CK_MIX = CK_STG + CK_NBUILD * 6144;
constexpr int CK_FLAGS = CK_MIX + 448 * 4;
static_assert(CK_FLAGS + 64 <= 146432, "rwkv chunked LDS map");
__device__ __forceinline__ void rwkv_phase(LAS float* smf, int tid, int lane, int wave, int blk, const bf16_t* __restrict__ proj, const float* __restrict__ mix, const float* __restrict__ w0, const float* __restrict__ a0,
                                           const float* __restrict__ k_k, const float* __restrict__ k_a, const float* __restrict__ r_k, const bf16_t* __restrict__ W2T, const bf16_t* __restrict__ A2T, const bf16_t* __restrict__ G2T,
                                           float* __restrict__ yraw, bf16_t* __restrict__ gout, float* __restrict__ bonus_out) {
    LAS unsigned char* lds = (LAS unsigned char*)smf;
    LAS float* mixs = (LAS float*)(lds + CK_MIX);
    volatile LAS unsigned* flags = (volatile LAS unsigned*)(lds + CK_FLAGS);
    const int chain = blk >> 1, ihalf = blk & 1, b = chain >> 3, h = chain & 7, l15 = lane & 15, kg = lane >> 4, l31 = lane & 31, hi = lane >> 5;
    const size_t rowb = (size_t)b * SEQ;
    constexpr int NCH = SEQ / 16;
    if (tid < 256) mixs[tid] = mix[1536 + tid];
    else if (tid < 448) { const int q = tid - 256; mixs[tid] = mix[512 * (q >> 6) + h * 64 + (q & 63)]; }
    if (tid < 16) flags[tid] = 0u;
    for (int q = tid; q < CK_NSLOT * 384; q += NWAVES * 64) *(LAS unsigned*)(lds + (q / 384) * CK_SLOT + CK_TT + (q % 384) * 4) = 0u;
    __syncthreads();
#define RW_SH8(CUR, PRV, M0, M1, OUT, PZ) do { const unsigned cu_[4] = {(CUR).x, (CUR).y, (CUR).z, (CUR).w}, pu_[4] = {(PRV).x, (PRV).y, (PRV).z, (PRV).w}; \
        const float mm_[8] = {(M0)[0], (M0)[1], (M0)[2], (M0)[3], (M1)[0], (M1)[1], (M1)[2], (M1)[3]}; \
        _Pragma("unroll") for (int q = 0; q < 4; ++q) { const float c0 = bflo(cu_[q]), c1 = bfhi(cu_[q]), p0 = bflo(pu_[q]) * (PZ), p1 = bfhi(pu_[q]) * (PZ); \
            OUT[2 * q] = c0 + (p0 - c0) * mm_[2 * q]; OUT[2 * q + 1] = c1 + (p1 - c1) * mm_[2 * q + 1]; } } while (0)
    if (wave == 0) {
        f32x16 ST[2];
#pragma unroll
        for (int r = 0; r < 16; ++r) { ST[0][r] = 0.f; ST[1][r] = 0.f; }
#pragma unroll 1
        for (int k = 0; k < NCH; ++k) {
#if defined(PROBE_STAMPS)
            const unsigned tw0_ = (unsigned)__builtin_amdgcn_s_memrealtime();
#endif
            { const unsigned want = (unsigned)(k + 1); const int sl = k % CK_NSLOT; while (flags[sl] != want) __builtin_amdgcn_s_sleep(1); }
#if defined(PROBE_STAMPS)
            if (blk == 0 && lane == 0) ((volatile LAS unsigned*)(lds + 146432 + 320))[16 + 24] += (unsigned)__builtin_amdgcn_s_memrealtime() - tw0_;
#endif
            asm volatile("" ::: "memory");
            const LAS unsigned char* im = lds + (k % CK_NSLOT) * CK_SLOT;
            f32x16 G;
#pragma unroll
            for (int r = 0; r < 16; ++r) G[r] = 0.f;
#pragma unroll
            for (int kk = 0; kk < 4; ++kk) { const bf16x8 fa = *(const LAS bf16x8*)(im + CK_BK + l31 * 144 + (16 * kk + 8 * hi) * 2), fb = *(const LAS bf16x8*)(im + CK_AR + l31 * 144 + (16 * kk + 8 * hi) * 2); G = MFMA32(fa, fb, G); }
            { const int tcol = l31 & 15; const bool strict = l31 < 16;
#pragma unroll
              for (int r = 0; r < 16; ++r) { const int srow = crow(r & 7, hi); const bool keep = strict ? (srow < tcol) : (srow <= tcol); G[r] = keep ? G[r] : 0.f; } }
            const bf16x8 gB = pack8(G[0], G[1], G[2], G[3], G[4], G[5], G[6], G[7]), gK = pack8(G[8], G[9], G[10], G[11], G[12], G[13], G[14], G[15]);
            f32x16 XT;
#pragma unroll
            for (int r = 0; r < 16; ++r) XT[r] = 0.f;
#pragma unroll
            for (int jt = 0; jt < 2; ++jt)
#pragma unroll
                for (int sp = 0; sp < 2; ++sp) { const LAS unsigned char* ap = im + CK_AR + l31 * 144 + (32 * jt + 16 * sp + 4 * hi) * 2;
                    const u32x2 x0 = *(const LAS u32x2*)ap, x1 = *(const LAS u32x2*)(ap + 16); v4u aw; aw.x = x0.x; aw.y = x0.y; aw.z = x1.x; aw.w = x1.y;
                    const bf16x8 sb_ = pack8(ST[jt][8 * sp], ST[jt][8 * sp + 1], ST[jt][8 * sp + 2], ST[jt][8 * sp + 3], ST[jt][8 * sp + 4], ST[jt][8 * sp + 5], ST[jt][8 * sp + 6], ST[jt][8 * sp + 7]);
                    XT = MFMA32(__builtin_bit_cast(bf16x8, aw), sb_, XT); }
            bf16x8 vP;
            { const LAS unsigned char* vp = im + CK_VT + l31 * 48 + (4 * hi) * 2; const u32x2 x0 = *(const LAS u32x2*)vp, x1 = *(const LAS u32x2*)(vp + 16); v4u vw; vw.x = x0.x; vw.y = x0.y; vw.z = x1.x; vw.w = x1.y;
              vP = __builtin_bit_cast(bf16x8, vw); XT = MFMA32(gK, vP, XT); }
            bf16x8 uP;
            { const LAS unsigned char* tp = im + CK_TT + l31 * 48 + (4 * hi) * 2; const u32x2 x0 = *(const LAS u32x2*)tp, x1 = *(const LAS u32x2*)(tp + 16); v4u tw; tw.x = x0.x; tw.y = x0.y; tw.z = x1.x; tw.w = x1.y;
              f32x16 UT;
#pragma unroll
              for (int r = 0; r < 16; ++r) UT[r] = 0.f;
              UT = MFMA32(__builtin_bit_cast(bf16x8, tw), pack8(XT[0], XT[1], XT[2], XT[3], XT[4], XT[5], XT[6], XT[7]), UT);
              uP = pack8(UT[0], UT[1], UT[2], UT[3], UT[4], UT[5], UT[6], UT[7]); }
            XT = MFMA32(gB, uP, XT);
            { float* yp = yraw + (rowb + 16 * k) * 512 + h * 64 + 32 * ihalf + l31;
#pragma unroll
              for (int q = 0; q < 8; ++q) yp[(size_t)crow(q, hi) * 512] = XT[8 + q]; }
            { const LAS float* gc = (const LAS float*)(im + CK_GC);
#pragma unroll
              for (int jt = 0; jt < 2; ++jt)
#pragma unroll
                  for (int r = 0; r < 16; ++r) ST[jt][r] *= gc[32 * jt + crow(r, hi)]; }
#pragma unroll
            for (int jt = 0; jt < 2; ++jt) { const LAS unsigned char* bp = im + CK_BBT + (32 * jt + l31) * 48 + (4 * hi) * 2; const LAS unsigned char* kp = im + CK_KBT + (32 * jt + l31) * 48 + (4 * hi) * 2;
                const u32x2 b0 = *(const LAS u32x2*)bp, b1 = *(const LAS u32x2*)(bp + 16), k0 = *(const LAS u32x2*)kp, k1 = *(const LAS u32x2*)(kp + 16);
                v4u a1; a1.x = b0.x; a1.y = b0.y; a1.z = b1.x; a1.w = b1.y; v4u a2; a2.x = k0.x; a2.y = k0.y; a2.z = k1.x; a2.w = k1.y;
                ST[jt] = MFMA32(__builtin_bit_cast(bf16x8, a1), uP, ST[jt]); ST[jt] = MFMA32(__builtin_bit_cast(bf16x8, a2), vP, ST[jt]); }
            WSYNC();
            if (lane == 0) flags[8] = (unsigned)(k + 1);
        }
    } else if (wave <= CK_NBUILD) {
        const int pw = wave - 1;
        LAS bf16_t* stg = (LAS bf16_t*)(lds + CK_STG) + pw * 3072;
        float w0c[4], a0c[4], kkc[4], kac[4], rkc[4];
#pragma unroll
        for (int nt = 0; nt < 4; ++nt) { const int c = h * 64 + 16 * nt + l15; w0c[nt] = w0[c]; a0c[nt] = a0[c]; kkc[nt] = k_k[c]; kac[nt] = k_a[c]; rkc[nt] = r_k[c]; }
        v4u ld[20];
#define CK_ISSUE_A(T0) do { const int t0_ = (T0); const size_t r_ = rowb + t0_ + l15; const size_t rp_ = (t0_ + l15 == 0) ? r_ : r_ - 1; \
            _Pragma("unroll") for (int lo = 0; lo < 2; ++lo) _Pragma("unroll") for (int ks = 0; ks < 2; ++ks) { const int col = 1536 + 64 * lo + 32 * ks + 8 * kg; \
                ld[(lo * 2 + ks) * 2] = *(const v4u*)(proj + r_ * L0P + col); ld[(lo * 2 + ks) * 2 + 1] = *(const v4u*)(proj + rp_ * L0P + col); } } while (0)
#define CK_ISSUE_B(T0) do { const int t0_ = (T0); \
            _Pragma("unroll") for (int ar = 0; ar < 3; ++ar) _Pragma("unroll") for (int i = 0; i < 2; ++i) { const int p_ = lane + 64 * i, row_ = p_ >> 3, c8_ = p_ & 7; \
                const size_t r_ = rowb + t0_ + row_; const size_t rp_ = (t0_ + row_ == 0) ? r_ : r_ - 1; const int col = 512 * ar + h * 64 + 8 * c8_; \
                ld[8 + (ar * 2 + i) * 2] = *(const v4u*)(proj + r_ * L0P + col); ld[8 + (ar * 2 + i) * 2 + 1] = *(const v4u*)(proj + rp_ * L0P + col); } } while (0)
#define CK_ISSUE(T0) do { CK_ISSUE_A(T0); CK_ISSUE_B(T0); } while (0)
        CK_ISSUE(16 * pw);
#pragma unroll 1
        for (int k = pw; k < NCH; k += CK_NBUILD) {
            const int t0 = 16 * k;
#if defined(PROBE_STAMPS)
            const unsigned ts0_ = (unsigned)__builtin_amdgcn_s_memrealtime();
#endif
            f32x4 accw[4], acca[4];
#pragma unroll
            for (int nt = 0; nt < 4; ++nt) { accw[nt] = (f32x4){0.f, 0.f, 0.f, 0.f}; acca[nt] = (f32x4){0.f, 0.f, 0.f, 0.f}; }
            { const float pz_ = (t0 + l15 == 0) ? 0.f : 1.f;
#pragma unroll
              for (int lo = 0; lo < 2; ++lo)
#pragma unroll
                for (int ks = 0; ks < 2; ++ks) { float s_[8];
                    const f32x4 m0 = *(const LAS f32x4*)(mixs + 64 * lo + 32 * ks + 8 * kg), m1 = *(const LAS f32x4*)(mixs + 64 * lo + 32 * ks + 8 * kg + 4);
                    RW_SH8(ld[(lo * 2 + ks) * 2], ld[(lo * 2 + ks) * 2 + 1], m0, m1, s_, pz_);
                    if (lo == 0) {
#pragma unroll
                        for (int j = 0; j < 8; ++j) s_[j] = tanh_fast(s_[j]); }
                    const bf16x8 af = pack8(s_[0], s_[1], s_[2], s_[3], s_[4], s_[5], s_[6], s_[7]);
                    const bf16_t* WT = lo ? A2T : W2T;
#pragma unroll
                    for (int nt = 0; nt < 4; ++nt) { const bf16x8 bfr = *(const bf16x8*)(WT + (size_t)(h * 64 + 16 * nt + l15) * 64 + 32 * ks + 8 * kg);
                        if (lo == 0) accw[nt] = MFMA16(af, bfr, accw[nt]); else acca[nt] = MFMA16(af, bfr, acca[nt]); } } }
#pragma unroll
            for (int ar = 0; ar < 3; ++ar)
#pragma unroll
                for (int i = 0; i < 2; ++i) { const int p_ = lane + 64 * i, row_ = p_ >> 3, c8_ = p_ & 7; float s_[8];
                    const float pz_ = (t0 + row_ == 0) ? 0.f : 1.f; const f32x4 m0 = *(const LAS f32x4*)(mixs + 256 + ar * 64 + c8_ * 8), m1 = *(const LAS f32x4*)(mixs + 256 + ar * 64 + c8_ * 8 + 4);
                    RW_SH8(ld[8 + (ar * 2 + i) * 2], ld[8 + (ar * 2 + i) * 2 + 1], m0, m1, s_, pz_);
                    *(LAS bf16x8*)(stg + ar * 1024 + row_ * 64 + c8_ * 8) = pack8(s_[0], s_[1], s_[2], s_[3], s_[4], s_[5], s_[6], s_[7]); }
            WSYNC();
#if defined(PROBE_STAMPS)
            if (blk == 0 && wave == 1 && lane == 0) ((volatile LAS unsigned*)(lds + 146432 + 320))[16 + 26] += (unsigned)__builtin_amdgcn_s_memrealtime() - ts0_;
#endif
#if defined(PROBE_STAMPS)
            const unsigned tb0_ = (unsigned)__builtin_amdgcn_s_memrealtime();
#endif
            { const int need = k - (CK_NSLOT - 1); if (need > 0) { while ((int)flags[8] < need) __builtin_amdgcn_s_sleep(2); } }
#if defined(PROBE_STAMPS)
            if (blk == 0 && wave == 1 && lane == 0) ((volatile LAS unsigned*)(lds + 146432 + 320))[16 + 25] += (unsigned)__builtin_amdgcn_s_memrealtime() - tb0_;
#endif
            asm volatile("" ::: "memory");
            LAS unsigned char* im = lds + (k % CK_NSLOT) * CK_SLOT;
#if defined(PROBE_STAMPS)
            const unsigned ts1_ = (unsigned)__builtin_amdgcn_s_memrealtime();
#endif
            float lwv[4][4], av[4][4], knv[4][4];
#pragma unroll
            for (int rg = 0; rg < 4; ++rg) { const int tl = 4 * kg + rg;
                float kkv[4], nrm2 = 0.f, vv[4], rr_[4], kr_[4];
#pragma unroll
                for (int nt = 0; nt < 4; ++nt) { rr_[nt] = bf2f(stg[tl * 64 + 16 * nt + l15]); kr_[nt] = bf2f(stg[1024 + tl * 64 + 16 * nt + l15]); vv[nt] = bf2f(stg[2048 + tl * 64 + 16 * nt + l15]);
                    kkv[nt] = kr_[nt] * kkc[nt]; nrm2 += kkv[nt] * kkv[nt]; }
                nrm2 = rowsum16(nrm2); const float rn = __builtin_amdgcn_rsqf(fmaxf(nrm2, 1e-24f));
                float bon = 0.f;
#pragma unroll
                for (int nt = 0; nt < 4; ++nt) {
                    const float wsum = w0c[nt] + accw[nt][rg]; lwv[nt][rg] = -0.6065306597126334f * sigmoid_fast(wsum);
                    const float a_ = sigmoid_fast(a0c[nt] + acca[nt][rg]); av[nt][rg] = a_; knv[nt][rg] = kkv[nt] * rn;
                    const float k2 = kr_[nt] * (1.f + (a_ - 1.f) * kac[nt]); stg[1024 + tl * 64 + 16 * nt + l15] = bf1(k2);
                    bon += rr_[nt] * k2 * rkc[nt];
                    if ((nt >> 1) == ihalf) *(LAS bf16_t*)(im + CK_VT + (16 * (nt & 1) + l15) * 48 + tl * 2) = bf1(vv[nt]);
                }
                bon = rowsum16(bon);
                if (l15 == 0 && ihalf == 0) bonus_out[(rowb + t0 + tl) * 8 + h] = bon;
            }
            CK_ISSUE_A((k + CK_NBUILD < NCH) ? t0 + 16 * CK_NBUILD : t0);
#pragma unroll
            for (int nt = 0; nt < 4; ++nt) {
                float L[4]; L[0] = lwv[nt][0]; L[1] = L[0] + lwv[nt][1]; L[2] = L[1] + lwv[nt][2]; L[3] = L[2] + lwv[nt][3];
                const float T0 = __shfl(L[3], l15), T1 = __shfl(L[3], 16 + l15), T2 = __shfl(L[3], 32 + l15), T3 = __shfl(L[3], 48 + l15);
                const float off = (kg > 0 ? T0 : 0.f) + (kg > 1 ? T1 : 0.f) + (kg > 2 ? T2 : 0.f), LC = (T0 + T1) + (T2 + T3);
                const int j = 16 * nt + l15;
                unsigned bb2[2], kb2[2];
                const float gC = __expf(LC); float eprev = __expf(off);
#pragma unroll
                for (int rg = 0; rg < 4; ++rg) { const int tl = 4 * kg + rg; const float Lt = off + L[rg], e1 = __expf(Lt), e2 = __builtin_amdgcn_rcpf(e1), e3 = eprev, e4 = gC * e2; eprev = e1;
                    const float kn = knv[nt][rg], bvv = kn * av[nt][rg], k2 = bf2f(stg[1024 + tl * 64 + j]), rr2 = bf2f(stg[tl * 64 + j]);
                    *(LAS bf16_t*)(im + CK_BK + tl * 144 + j * 2) = bf1(bvv * e2); *(LAS bf16_t*)(im + CK_BK + (16 + tl) * 144 + j * 2) = bf1(k2 * e2);
                    *(LAS bf16_t*)(im + CK_AR + tl * 144 + j * 2) = bf1(-kn * e3); *(LAS bf16_t*)(im + CK_AR + (16 + tl) * 144 + j * 2) = bf1(rr2 * e1);
                    const unsigned bq = bf1(bvv * e4), kq = bf1(k2 * e4);
                    if (rg & 1) { bb2[rg >> 1] |= bq << 16; kb2[rg >> 1] |= kq << 16; } else { bb2[rg >> 1] = bq; kb2[rg >> 1] = kq; } }
                *(LAS u32x2*)(im + CK_BBT + j * 48 + (4 * kg) * 2) = (u32x2){bb2[0], bb2[1]}; *(LAS u32x2*)(im + CK_KBT + j * 48 + (4 * kg) * 2) = (u32x2){kb2[0], kb2[1]};
                if (kg == 0) *(LAS float*)(im + CK_GC + j * 4) = gC;
            }
            WSYNC();
#if defined(PROBE_STAMPS)
            const unsigned ts2_ = (unsigned)__builtin_amdgcn_s_memrealtime();
            if (blk == 0 && wave == 1 && lane == 0) ((volatile LAS unsigned*)(lds + 146432 + 320))[16 + 27] += ts2_ - ts1_;
#endif
            {
                f32x4 nacc = {0.f, 0.f, 0.f, 0.f};
#pragma unroll
                for (int ks = 0; ks < 2; ++ks) { const bf16x8 fa = *(const LAS bf16x8*)(im + CK_BK + l15 * 144 + (32 * ks + 8 * kg) * 2), fb = *(const LAS bf16x8*)(im + CK_AR + l15 * 144 + (32 * ks + 8 * kg) * 2); nacc = MFMA16(fa, fb, nacc); }
#pragma unroll
                for (int rg = 0; rg < 4; ++rg) nacc[rg] = ((4 * kg + rg) < l15) ? nacc[rg] : 0.f;
                float Tr[16];
#pragma unroll
                for (int t = 0; t < 16; ++t) { float acc_ = (l15 == t) ? 1.f : 0.f;
#pragma unroll
                    for (int s2 = 0; s2 < t; ++s2) acc_ += Tr[s2] * rl(nacc[s2 & 3], t + 16 * (s2 >> 2));
                    Tr[t] = acc_; }
                if (kg == 0) {
#pragma unroll
                    for (int t = 0; t < 16; ++t) *(LAS bf16_t*)(im + CK_TT + t * 48 + l15 * 2) = bf1(Tr[t]); }
            }
            WSYNC();
#if defined(PROBE_STAMPS)
            if (blk == 0 && wave == 1 && lane == 0) ((volatile LAS unsigned*)(lds + 146432 + 320))[16 + 28] += (unsigned)__builtin_amdgcn_s_memrealtime() - ts2_;
#endif
            if (lane == 0) flags[k % CK_NSLOT] = (unsigned)(k + 1);
            CK_ISSUE_B((k + CK_NBUILD < NCH) ? t0 + 16 * CK_NBUILD : t0);
        }
#undef CK_ISSUE
#undef CK_ISSUE_A
#undef CK_ISSUE_B
    } else {
        const int gq = wave - 6;
        v4u ld[8];
#define G_ISSUE(T0) do { const int t0_ = (T0); const size_t r_ = rowb + t0_ + l15; const size_t rp_ = (t0_ + l15 == 0) ? r_ : r_ - 1; \
            _Pragma("unroll") for (int ks = 0; ks < 4; ++ks) { const int col = 1664 + 32 * ks + 8 * kg; ld[2 * ks] = *(const v4u*)(proj + r_ * L0P + col); ld[2 * ks + 1] = *(const v4u*)(proj + rp_ * L0P + col); } } while (0)
        G_ISSUE(16 * gq);
#pragma unroll 1
        for (int k = gq; k < NCH; k += 2) {
            const int t0 = 16 * k;
            f32x4 accg[2] = {(f32x4){0.f, 0.f, 0.f, 0.f}, (f32x4){0.f, 0.f, 0.f, 0.f}}; const float pz_ = (t0 + l15 == 0) ? 0.f : 1.f;
#pragma unroll
            for (int ks = 0; ks < 4; ++ks) { float s_[8];
                const f32x4 m0 = *(const LAS f32x4*)(mixs + 128 + 32 * ks + 8 * kg), m1 = *(const LAS f32x4*)(mixs + 128 + 32 * ks + 8 * kg + 4);
                RW_SH8(ld[2 * ks], ld[2 * ks + 1], m0, m1, s_, pz_);
#pragma unroll
                for (int j = 0; j < 8; ++j) s_[j] = sigmoid_fast(s_[j]);
                const bf16x8 af = pack8(s_[0], s_[1], s_[2], s_[3], s_[4], s_[5], s_[6], s_[7]);
#pragma unroll
                for (int nt = 0; nt < 2; ++nt) { const bf16x8 bfr = *(const bf16x8*)(G2T + (size_t)(h * 64 + ihalf * 32 + 16 * nt + l15) * 128 + 32 * ks + 8 * kg); accg[nt] = MFMA16(af, bfr, accg[nt]); } }
            G_ISSUE((k + 2 < NCH) ? t0 + 32 : t0);
#pragma unroll
            for (int nt = 0; nt < 2; ++nt)
#pragma unroll
                for (int rg = 0; rg < 4; ++rg) gout[(rowb + t0 + 4 * kg + rg) * 512 + h * 64 + ihalf * 32 + 16 * nt + l15] = bf1(accg[nt][rg]);
        }
#undef G_ISSUE
    }
#undef RW_SH8
    __syncthreads();
}

template <bool ST = true> __device__ __forceinline__ void rwkv_post_all(const float* __restrict__ yraw, const bf16_t* __restrict__ proj, const float* __restrict__ mix, const float* __restrict__ bonus, const bf16_t* __restrict__ gbuf,
                                              const float* __restrict__ ln_g, const float* __restrict__ ln_b, bf16_t* __restrict__ ymix, int gw, int NGW, int lane) {
    for (int m = gw; m < M; m += NGW) {
        const bool has_prev = (m & (SEQ - 1)) != 0;
        float y[8], cv[8], pv[8], gg[8], bo[8];
#pragma unroll
        for (int h = 0; h < 8; ++h) { const int c = h * 64 + lane; y[h] = yraw[(size_t)m * 512 + c]; cv[h] = bf2f(proj[(size_t)m * L0P + 1024 + c]);
            pv[h] = bf2f(proj[(size_t)(has_prev ? m - 1 : m) * L0P + 1024 + c]); gg[h] = bf2f(gbuf[(size_t)m * 512 + c]); bo[h] = bonus[(size_t)m * 8 + h]; }
#pragma unroll
        for (int h = 0; h < 8; ++h) { const int c = h * 64 + lane;
            const float mu = wave_sum_dpp(y[h]) * (1.f / 64.f), d = y[h] - mu, var = wave_sum_dpp(d * d) * (1.f / 64.f);
            const float yn = d * __builtin_amdgcn_rsqf(var + 64e-5f) * ln_g[c] + ln_b[c];
            const float pvv = has_prev ? pv[h] : 0.f;
            const float v_s = cv[h] + (pvv - cv[h]) * mix[1024 + c];
            const float o = (yn + bo[h] * v_s) * gg[h];
            if (ST) ymix[(size_t)m * DM + c] = bf1(o); else asm volatile("" :: "v"(o)); }
    }
}


__device__ __forceinline__ void ssd_conv_tile(int it, int lane, LAS bf16_t* scr, const bf16_t* __restrict__ proj, const float* __restrict__ cw, const float* __restrict__ cb,
                                              bf16_t* __restrict__ xbc, bf16_t* __restrict__ xst, bf16_t* __restrict__ bt) {
    const int tt = it >> 4, ct = it & 15, m0 = tt * 64, b = m0 >> 11, t0 = m0 & (SEQ - 1), c = ct * 64 + lane;
    const float w0 = cw[c], w1 = cw[1024 + c], w2 = cw[2048 + c], w3 = cw[3072 + c], bias = cb[c];
    const bf16_t* src = proj + (size_t)m0 * L0P + 2304 + c;
    bf16_t raw[67];
    const int lo = (t0 > 0) ? -3 : 0;
#pragma unroll
    for (int t = -3; t < 64; ++t) raw[t + 3] = src[(ptrdiff_t)((t < lo) ? lo : t) * L0P];
    float u3 = (t0 > 0) ? bf2f(raw[0]) : 0.f, u2 = (t0 > 0) ? bf2f(raw[1]) : 0.f, u1 = (t0 > 0) ? bf2f(raw[2]) : 0.f;
#pragma unroll
    for (int t = 0; t < 64; ++t) {
        const float u = bf2f(raw[t + 3]);
        const float y = bias + w0 * u3 + w1 * u2 + w2 * u1 + w3 * u;
        const bf16_t o = bf1(y * __builtin_amdgcn_rcpf(1.f + __expf(-y)));
        xbc[(size_t)(m0 + t) * 1024 + c] = o;
        scr[t * STG_PITCH + lane] = o;
        u3 = u2; u2 = u1; u1 = u;
    }
    WSYNC();
    if (ct < 12) {
        bf16_t* dst = (ct < 8) ? xst + ((size_t)(b * 8 + ct) * 64) * SEQ + t0 : bt + ((size_t)(b * 2 + ((ct - 8) >> 1)) * 128 + ((ct - 8) & 1) * 64) * SEQ + t0;
#pragma unroll
        for (int i = 0; i < 8; ++i) { const int d = i * 8 + (lane >> 3), tc = lane & 7; const LAS bf16_t* p = scr + (tc * 8) * STG_PITCH + d;
            v4u o; o.x = (unsigned)p[0] | ((unsigned)p[STG_PITCH] << 16); o.y = (unsigned)p[2 * STG_PITCH] | ((unsigned)p[3 * STG_PITCH] << 16);
            o.z = (unsigned)p[4 * STG_PITCH] | ((unsigned)p[5 * STG_PITCH] << 16); o.w = (unsigned)p[6 * STG_PITCH] | ((unsigned)p[7 * STG_PITCH] << 16);
            *(v4u*)(dst + (size_t)d * SEQ + tc * 8) = o; }
    }
    WSYNC();
}
__device__ __forceinline__ float bperm(int srclane, float x) { return __builtin_bit_cast(float, __builtin_amdgcn_ds_bpermute(srclane << 2, __builtin_bit_cast(int, x))); }
__device__ __forceinline__ void scan128(float& x0, float& x1, int lane) {
#pragma unroll
    for (int o = 1; o < 64; o <<= 1) { const int sl = (lane >= o) ? lane - o : lane; const float t0 = bperm(sl, x0), t1 = bperm(sl, x1); if (lane >= o) { x0 += t0; x1 += t1; } }
    x1 += rl(x0, 63);
}
__device__ __forceinline__ void ssd_s1_unit(int unit, int lane, LAS float* tab, const bf16_t* __restrict__ xst, const bf16_t* __restrict__ bt, const float* __restrict__ dt, const float* __restrict__ a_log,
                                            float* __restrict__ sloc, float* __restrict__ asum) {
    const int h = unit & 7, c = (unit >> 3) & 15, b = unit >> 7, g = h >> 2, l0 = c * 128, l31 = lane & 31, hi = lane >> 5;
    const size_t m0 = (size_t)b * SEQ + l0;
    const float A = -expf(a_log[h]);
    const float d0 = dt[(m0 + lane) * 8 + h], d1 = dt[(m0 + 64 + lane) * 8 + h];
    float ac0 = d0 * A, ac1 = d1 * A;
    scan128(ac0, ac1, lane);
    const float aend = rl(ac1, 63);
    tab[lane] = __expf(aend - ac0) * d0; tab[64 + lane] = __expf(aend - ac1) * d1;
    if (lane == 0) asum[unit] = aend;
    WSYNC();
    f32x16 acc[2][4];
#pragma unroll
    for (int pt = 0; pt < 2; ++pt)
#pragma unroll
        for (int nt = 0; nt < 4; ++nt)
#pragma unroll
            for (int r = 0; r < 16; ++r) acc[pt][nt][r] = 0.f;
    const bf16_t* Xp = xst + ((size_t)(b * 8 + h) * 64 + l31) * SEQ + l0 + 8 * hi;
    const bf16_t* Bp = bt + ((size_t)(b * 2 + g) * 128 + l31) * SEQ + l0 + 8 * hi;
#pragma unroll 2
    for (int kk = 0; kk < 8; ++kk) {
        const f32x4 wa = *(const LAS f32x4*)(tab + 16 * kk + 8 * hi), wb = *(const LAS f32x4*)(tab + 16 * kk + 8 * hi + 4);
        bf16x8 af[2], bfr[4];
#pragma unroll
        for (int pt = 0; pt < 2; ++pt) { const v4u raw = *(const v4u*)(Xp + (size_t)pt * 32 * SEQ + 16 * kk);
            v4u w; w.x = cvtpk(bflo(raw.x) * wa[0], bfhi(raw.x) * wa[1]); w.y = cvtpk(bflo(raw.y) * wa[2], bfhi(raw.y) * wa[3]);
            w.z = cvtpk(bflo(raw.z) * wb[0], bfhi(raw.z) * wb[1]); w.w = cvtpk(bflo(raw.w) * wb[2], bfhi(raw.w) * wb[3]); af[pt] = __builtin_bit_cast(bf16x8, w); }
#pragma unroll
        for (int nt = 0; nt < 4; ++nt) bfr[nt] = *(const bf16x8*)(Bp + (size_t)nt * 32 * SEQ + 16 * kk);
#pragma unroll
        for (int pt = 0; pt < 2; ++pt)
#pragma unroll
            for (int nt = 0; nt < 4; ++nt) acc[pt][nt] = MFMA32(af[pt], bfr[nt], acc[pt][nt]);
    }
    float* dst = sloc + (size_t)unit * 8192 + l31;
#pragma unroll
    for (int pt = 0; pt < 2; ++pt)
#pragma unroll
        for (int nt = 0; nt < 4; ++nt)
#pragma unroll
            for (int r = 0; r < 16; ++r) dst[(32 * pt + crow(r, hi)) * 128 + 32 * nt] = acc[pt][nt][r];
    WSYNC();
}
__device__ __forceinline__ void ssd_s2_all(const float* __restrict__ sloc, const float* __restrict__ asum, bf16_t* __restrict__ stb, int gtid, int NT) {
    for (int i = gtid; i < 128 * 2048; i += NT) {
        const int bh = i >> 11, e4 = i & 2047, b = bh >> 3, h = bh & 7;
        f32x4 run = {0.f, 0.f, 0.f, 0.f};
#pragma unroll 4
        for (int c = 0; c < 16; ++c) { const int unit = (b * 16 + c) * 8 + h; const f32x4 tmp = *(const f32x4*)(sloc + (size_t)unit * 8192 + e4 * 4);
            uint2 w; w.x = cvtpk(run[0], run[1]); w.y = cvtpk(run[2], run[3]); *(uint2*)(stb + (size_t)unit * 8192 + e4 * 4) = w;
            run = run * __expf(asum[unit]) + tmp; }
    }
}
__device__ __forceinline__ void ssd_s3_unit(int unit, int lane, LAS float* tab, const bf16_t* __restrict__ xbc, const bf16_t* __restrict__ xst, const bf16_t* __restrict__ stb, const float* __restrict__ dt,
                                            const float* __restrict__ a_log, const float* __restrict__ dsk, bf16_t* __restrict__ yssm) {
    const int h = unit & 7, c = (unit >> 3) & 15, b = unit >> 7, g = h >> 2, l0 = c * 128, l31 = lane & 31, hi = lane >> 5;
    const size_t m0 = (size_t)b * SEQ + l0;
    const float A = -expf(a_log[h]), D = dsk[h];
    const float d0 = dt[(m0 + lane) * 8 + h], d1 = dt[(m0 + 64 + lane) * 8 + h];
    float ac0 = d0 * A, ac1 = d1 * A;
    scan128(ac0, ac1, lane);
    tab[lane] = ac0; tab[64 + lane] = ac1; tab[128 + lane] = d0; tab[192 + lane] = d1;
    WSYNC();
    const bf16_t* Cp = xbc + (m0 + l31) * 1024 + 768 + g * 128 + 8 * hi;
    const bf16_t* Sp = stb + (size_t)unit * 8192 + l31 * 128 + 8 * hi;
    const bf16_t* Bp = xbc + (m0 + l31) * 1024 + 512 + g * 128 + 8 * hi;
    const bf16_t* Xp = xst + ((size_t)(b * 8 + h) * 64 + l31) * SEQ + l0 + 4 * hi;
    LAS float* tr = tab + 256;
    const int row = lane >> 1, p0 = (lane & 1) * 16;
#pragma unroll 1
    for (int lt = 0; lt < 4; ++lt) {
        f32x16 y[2];
#pragma unroll
        for (int r = 0; r < 16; ++r) { y[0][r] = 0.f; y[1][r] = 0.f; }
        const float acl = tab[32 * lt + l31];
        bf16x8 cfr[8];
#pragma unroll
        for (int kk = 0; kk < 8; ++kk) cfr[kk] = *(const bf16x8*)(Cp + (size_t)lt * 32 * 1024 + 16 * kk);
        {   bf16x8 s0[8], s1[8];
#pragma unroll
            for (int kk = 0; kk < 8; ++kk) { s0[kk] = *(const bf16x8*)(Sp + 16 * kk); s1[kk] = *(const bf16x8*)(Sp + 32 * 128 + 16 * kk); }
#pragma unroll
            for (int kk = 0; kk < 8; ++kk) { y[0] = MFMA32(s0[kk], cfr[kk], y[0]); y[1] = MFMA32(s1[kk], cfr[kk], y[1]); }
        }
        { const float el = __expf(acl);
#pragma unroll
          for (int r = 0; r < 16; ++r) { y[0][r] *= el; y[1][r] *= el; } }
#pragma unroll 1
        for (int st = 0; st <= lt; ++st) {
            bf16x8 bfr[8]; u32x2 xf[2][2][2];
#pragma unroll
            for (int kk = 0; kk < 8; ++kk) bfr[kk] = *(const bf16x8*)(Bp + (size_t)st * 32 * 1024 + 16 * kk);
#pragma unroll
            for (int pt = 0; pt < 2; ++pt)
#pragma unroll
                for (int ks = 0; ks < 2; ++ks) { const bf16_t* xp = Xp + (size_t)pt * 32 * SEQ + st * 32 + 16 * ks; xf[pt][ks][0] = *(const u32x2*)xp; xf[pt][ks][1] = *(const u32x2*)(xp + 8); }
            f32x16 cbt;
#pragma unroll
            for (int r = 0; r < 16; ++r) cbt[r] = 0.f;
#pragma unroll
            for (int kk = 0; kk < 8; ++kk) cbt = MFMA32(bfr[kk], cfr[kk], cbt);
#pragma unroll
            for (int r = 0; r < 16; ++r) { const int sl = 32 * st + crow(r, hi); const float acs = tab[sl], dts = tab[128 + sl];
                float v = cbt[r] * __expf(acl - acs) * dts; if (st == lt && crow(r, hi) > l31) v = 0.f; cbt[r] = v; }
            bf16x8 pf[2];
#pragma unroll
            for (int ks = 0; ks < 2; ++ks) pf[ks] = pack8(cbt[8 * ks], cbt[8 * ks + 1], cbt[8 * ks + 2], cbt[8 * ks + 3], cbt[8 * ks + 4], cbt[8 * ks + 5], cbt[8 * ks + 6], cbt[8 * ks + 7]);
#pragma unroll
            for (int pt = 0; pt < 2; ++pt)
#pragma unroll
                for (int ks = 0; ks < 2; ++ks) { v4u a; a.x = xf[pt][ks][0].x; a.y = xf[pt][ks][0].y; a.z = xf[pt][ks][1].x; a.w = xf[pt][ks][1].y; y[pt] = MFMA32(__builtin_bit_cast(bf16x8, a), pf[ks], y[pt]); }
        }
#pragma unroll
        for (int pt = 0; pt < 2; ++pt) {
#pragma unroll
            for (int r = 0; r < 16; ++r) tr[l31 * 33 + crow(r, hi)] = y[pt][r];
            WSYNC();
            const size_t m = m0 + 32 * lt + row;
            const v4u xa = *(const v4u*)(xbc + m * 1024 + h * 64 + 32 * pt + p0), xb = *(const v4u*)(xbc + m * 1024 + h * 64 + 32 * pt + p0 + 8);
            const unsigned xu[8] = {xa.x, xa.y, xa.z, xa.w, xb.x, xb.y, xb.z, xb.w};
            unsigned ow[8];
#pragma unroll
            for (int q = 0; q < 8; ++q) { const float v0 = tr[row * 33 + p0 + 2 * q] + D * bflo(xu[q]), v1 = tr[row * 33 + p0 + 2 * q + 1] + D * bfhi(xu[q]); ow[q] = cvtpk(v0, v1); }
            bf16_t* dst = yssm + m * 512 + h * 64 + 32 * pt + p0;
            *(v4u*)dst = (v4u){ow[0], ow[1], ow[2], ow[3]}; *(v4u*)(dst + 8) = (v4u){ow[4], ow[5], ow[6], ow[7]};
            WSYNC();
        }
    }
}

struct Args { const float* in[43]; float* out; unsigned char* ws; };
#define GEMM_PHASE(EPI, Aptr, LDA, Bptr, LDB, NN, KK, ...) do { pg8::Gemm g_{(Aptr), (Bptr), M, (NN), (KK), (LDA), (LDB)}; pg8::StaticOrder S_; S_.init(M, (NN), G, (int)blockIdx.x); \
        pg8::EPI E_{__VA_ARGS__}; pg8::gemm_phase<pg8::EPI, pg8::StaticOrder, true, true>(lds3, g_, S_, E_); } while (0)

__global__ void __launch_bounds__(NWAVES * 64, 2) fwd_mega(Args args) {
    extern __shared__ __attribute__((aligned(16))) unsigned char lds[];
    LAS unsigned char* lds3 = (LAS unsigned char*)lds;
    volatile LAS unsigned* MISC = (volatile LAS unsigned*)(lds3 + MISC_OFF);
    const int G = gridDim.x, NGW = G * NWAVES, NT = G * NWAVES * 64;
#define PHASE_IDS() int tid = threadIdx.x; asm volatile("" : "+v"(tid)); const int lane = tid & 63, wave = __builtin_amdgcn_readfirstlane(tid >> 6); const int gw = blockIdx.x * NWAVES + wave, gtid = blockIdx.x * (NWAVES * 64) + tid; (void)lane; (void)gw; (void)gtid
    unsigned char* ws = args.ws;
    gu32* ctl = (gu32*)(ws + WS_CTL);
    for (int u = threadIdx.x; u < (LDS_BYTES - LDSCTL_OFF) / 4; u += NWAVES * 64) ((LAS unsigned*)(lds3 + LDSCTL_OFF))[u] = 0u;
    __syncthreads();
    XcdBarrier bar = xcd_barrier_post((unsigned*)(ctl + CW_BAR), MISC + 8);
#if defined(PROBE_STAMPS)
    int nb_ = 0;
    if (blockIdx.x == 0 && threadIdx.x == 0) MISC[16] = (unsigned)__builtin_amdgcn_s_memrealtime();
#define GRID_BAR() do { xcd_barrier(bar); ++nb_; if (blockIdx.x == 0 && threadIdx.x == 0) MISC[16 + nb_] = (unsigned)__builtin_amdgcn_s_memrealtime(); } while (0)
#else
#define GRID_BAR() xcd_barrier(bar)
#endif
#define IN(i) (args.in[i])
    float* out = args.out;
    bf16_t* W0in = (bf16_t*)(ws + WS_W0IN); bf16_t* W0out = (bf16_t*)(ws + WS_W0OUT); bf16_t* Wup0 = (bf16_t*)(ws + WS_WUP0); bf16_t* Wdn0 = (bf16_t*)(ws + WS_WDN0);
    bf16_t* W1in = (bf16_t*)(ws + WS_W1IN); bf16_t* Wuq = (bf16_t*)(ws + WS_WUQ); bf16_t* Wukv = (bf16_t*)(ws + WS_WUKV); bf16_t* W1out = (bf16_t*)(ws + WS_W1OUT);
    bf16_t* Wup1 = (bf16_t*)(ws + WS_WUP1); bf16_t* Wdn1 = (bf16_t*)(ws + WS_WDN1);
    bf16_t* XB = (bf16_t*)(ws + WS_XB); bf16_t* YMIX = (bf16_t*)(ws + WS_YMIX); bf16_t* PROJ0 = (bf16_t*)(ws + WS_BIG);
    float* YRAW = out; bf16_t* YSSM = (bf16_t*)(out + (size_t)M * 512); bf16_t* STB = (bf16_t*)(out + (size_t)M * 768); bf16_t* XST = (bf16_t*)(ws + WS_XST); bf16_t* BT = (bf16_t*)(ws + WS_BT); float* ASUM = (float*)(ws + WS_ASUM); float* SLOC = (float*)(ws + WS_SLOC); float* DT = (float*)(ws + WS_DT); bf16_t* GB = (bf16_t*)(ws + WS_G); float* BONUS = (float*)(ws + WS_BONUS);
    bf16_t* W2T = (bf16_t*)(ws + WS_W2T); bf16_t* A2T = (bf16_t*)(ws + WS_A2T); bf16_t* G2T = (bf16_t*)(ws + WS_G2T); bf16_t* ACT = (bf16_t*)(ws + WS_GU); bf16_t* HALO = (bf16_t*)(ws + WS_GU + 176 * MiB);
    bf16_t* PROJ1 = (bf16_t*)(ws + WS_PROJ1); bf16_t* QM = (bf16_t*)(ws + WS_QM); bf16_t* KVM = (bf16_t*)(ws + WS_KVM); bf16_t* KPE = (bf16_t*)(ws + WS_KPE); float* RS = (float*)(ws + WS_RS); float* CSTAB = (float*)(ws + WS_CSTAB); float* STATS = (float*)(ws + WS_CSTAB + 4 * MiB); bf16_t* VTS = (bf16_t*)(ws + WS_VTS); bf16_t* VTM = (bf16_t*)(ws + WS_VTM);
    const int* pos = (const int*)args.in[1];

    {
        PHASE_IDS();
    {
        LAS float* scr = (LAS float*)(lds3 + wave * 16384); int trb = 0;
        transpose_matrix(IN(2), 1024, 3336, W0in, L0P, 1024, scr, gw, NGW, lane, nullptr, trb);
        transpose_matrix(IN(20), 1024, 1024, W0out, 1024, 1024, scr, gw, NGW, lane, nullptr, trb);
        transpose_matrix(IN(23), 1024, 5632, Wup0, 5632, 1024, scr, gw, NGW, lane, nullptr, trb, true);
        transpose_matrix(IN(26), 2816, 1024, Wdn0, 1024, 2816, scr, gw, NGW, lane, nullptr, trb);
        transpose_matrix(IN(29), 1024, 1952, W1in, L1P, 1024, scr, gw, NGW, lane, nullptr, trb);
        transpose_matrix(IN(31), 256, 768, Wuq, 768, 256, scr, gw, NGW, lane, IN(30), trb);
        transpose_matrix(IN(33), 128, 1024, Wukv, 1024, 256, scr, gw, NGW, lane, IN(32), trb);
        for (int i = gtid; i < 1024 * 16; i += NT) { const int n = i >> 4, c = i & 15; *(v4u*)(Wukv + (size_t)n * 256 + 128 + c * 8) = (v4u){0u, 0u, 0u, 0u}; }
        transpose_matrix(IN(34), 1024, 1024, W1out, 1024, 1024, scr, gw, NGW, lane, nullptr, trb);
        transpose_matrix(IN(37), 1024, 5632, Wup1, 5632, 1024, scr, gw, NGW, lane, nullptr, trb, true);
        transpose_matrix(IN(40), 2816, 1024, Wdn1, 1024, 2816, scr, gw, NGW, lane, nullptr, trb);
        transpose_matrix(IN(5), 64, 512, W2T, 512, 64, scr, gw, NGW, lane, nullptr, trb);
        transpose_matrix(IN(7), 64, 512, A2T, 512, 64, scr, gw, NGW, lane, nullptr, trb);
        transpose_matrix(IN(8), 128, 512, G2T, 512, 128, scr, gw, NGW, lane, nullptr, trb);
        const float* x = IN(0);
        {
            constexpr size_t TOT4 = (size_t)M * DM / 4;
            for (size_t i = gtid; i < TOT4; i += (size_t)NT * 8) {
                f32x4 v[8];
#pragma unroll
                for (int u = 0; u < 8; ++u) v[u] = *(const f32x4*)(x + (i + (size_t)u * NT) * 4);
#pragma unroll
                for (int u = 0; u < 8; ++u) { uint2 w; w.x = cvtpk(v[u][0], v[u][1]); w.y = cvtpk(v[u][2], v[u][3]); *(uint2*)(XB + (i + (size_t)u * NT) * 4) = w; }
            }
        }
    }
    }
    GRID_BAR();
    {
        PHASE_IDS();
    GEMM_PHASE(EpiBf16S, XB, DM, W0in, 1024, L0P, 1024, PROJ0, nullptr, L0P, 0);
    }
    GRID_BAR();
    {
        PHASE_IDS();
        const int blk = (int)blockIdx.x, m0 = blk * 128;
        {   LAS bf16_t* scr = (LAS bf16_t*)(lds3 + wave * 16384);
#pragma unroll 1
            for (int k = 0; k < 4; ++k) ssd_conv_tile((2 * blk + (k & 1)) * 16 + wave + 8 * (k >> 1), lane, scr, PROJ0, IN(14), IN(15), XB, XST, BT);
            for (int i = tid; i < 1024; i += NWAVES * 64) { const int m = m0 + (i >> 3); DT[(size_t)m * 8 + (i & 7)] = softplusf_(bf2f(PROJ0[(size_t)m * L0P + 3328 + (i & 7)]) + IN(16)[i & 7]); }
        }
        __syncthreads();
#if defined(PROBE_STAMPS)
        if (blockIdx.x == 0 && threadIdx.x == 0) MISC[16 + 29] = (unsigned)__builtin_amdgcn_s_memrealtime();
#endif
        ssd_s1_unit(blk * 8 + wave, lane, (LAS float*)(lds3 + wave * 16384), XST, BT, DT, IN(17), SLOC, ASUM);
    }
    GRID_BAR();
    {
        PHASE_IDS();
        ssd_s2_all(SLOC, ASUM, STB, gtid, NT);
#if defined(PROBE_STAMPS)
        __syncthreads(); if (blockIdx.x == 0 && threadIdx.x == 0) MISC[16 + 23] = (unsigned)__builtin_amdgcn_s_memrealtime();
#endif
        rwkv_phase((LAS float*)lds3, tid, lane, wave, (int)blockIdx.x, PROJ0, IN(3), IN(4), IN(6), IN(9), IN(10), IN(11), W2T, A2T, G2T, YRAW, GB, BONUS);
    }
    GRID_BAR();
    {
        PHASE_IDS();
        const int blk = (int)blockIdx.x;
        ssd_s3_unit(blk * 8 + wave, lane, (LAS float*)(lds3 + wave * 16384), XB, XST, STB, DT, IN(17), IN(18), YSSM);
        __syncthreads();
        ssm_gate_norm_all(YSSM, PROJ0, IN(19), YMIX, blk * 256 + wave, blk * 256 + 256, lane);
        rwkv_post_all(YRAW, PROJ0, IN(3), BONUS, GB, IN(12), IN(13), YMIX, gw, NGW, lane);
    }
    GRID_BAR();
    {
        PHASE_IDS();
    GEMM_PHASE(EpiResid, YMIX, DM, W0out, 1024, 1024, 1024, IN(0), out, ALPHA, 0);
    }
    GRID_BAR();
    {
        PHASE_IDS();
    ln_rows<1>(out, XB, STATS, IN(21), IN(22), gw, NGW, lane);
    }
    GRID_BAR();
    {
        PHASE_IDS();
        { pg8::Gemm g_{XB, Wup0, M / 32, DFF, 1024, DM, 1024, 4096, 8192, 256, 512, 1}; pg8::StaticOrder S_; S_.init(M / 32, DFF, G, (int)blockIdx.x);
          pg8::EpiBf16S E_{HALO, nullptr, DFF, 0}; pg8::gemm_phase<pg8::EpiBf16S, pg8::StaticOrder, true, true>(lds3, g_, S_, E_); }
    }
    GRID_BAR();
    {
        PHASE_IDS();
        { pg8::Gemm g_{XB, Wup0, M, 2 * DFF, 1024, DM, 1024}; pg8::StaticOrder S_; S_.init(M, 2 * DFF, G, (int)blockIdx.x);
          pg8::EpiConvAct E_{ACT, HALO, IN(24), IN(25), DFF, SEQ}; pg8::gemm_phase<pg8::EpiConvAct, pg8::StaticOrder, true, true>(lds3, g_, S_, E_); }
    }
    GRID_BAR();
    {
        PHASE_IDS();
    GEMM_PHASE(EpiResidLN, ACT, DFF, Wdn0, DFF, 1024, DFF, out, STATS, IN(21), IN(22), ALPHA, 0);
    }
    GRID_BAR();
    {
        PHASE_IDS();
    ln_rows<1>(out, XB, STATS, IN(27), IN(28), gw, NGW, lane);
    }
    GRID_BAR();
    {
        PHASE_IDS();
    GEMM_PHASE(EpiBf16S, XB, DM, W1in, 1024, L1P, 1024, PROJ1, nullptr, L1P, 0);
    }
    GRID_BAR();
    {
        PHASE_IDS();
    mla_prep_all(PROJ1, pos, RS, KPE, CSTAB, gw, NGW, lane);
    }
    GRID_BAR();
    {
        PHASE_IDS();
    GEMM_PHASE(EpiBf16S, PROJ1 + 1536, L1P, Wuq, 256, 768, 256, QM, RS, 768, 2);
    GEMM_PHASE(EpiBf16S, PROJ1 + 1792, L1P, Wukv, 256, 1024, 256, KVM, RS + 1, 1024, 2);
    }
    GRID_BAR();
    {
        PHASE_IDS();
    rope_q_all(QM, CSTAB, gtid, NT);
    {
        LAS bf16_t* scr = (LAS bf16_t*)(lds3 + wave * 16384);
        for (int it = gw; it < 8192; it += NGW) { const int which = it >> 12, r = it & 4095, bh = r >> 5, tt = r & 31, b = bh >> 3, h = bh & 7;
            if (which == 0) transpose_tile64(PROJ1 + ((size_t)b * SEQ + tt * 64) * L1P + 1024 + h * 64, L1P, VTS + (size_t)bh * 64 * SEQ + tt * 64, SEQ, scr, lane);
            else            transpose_tile64(KVM + ((size_t)b * SEQ + tt * 64) * 1024 + h * 128 + 64, 1024, VTM + (size_t)bh * 64 * SEQ + tt * 64, SEQ, scr, lane); }
    }
    }
    GRID_BAR();
    {
        PHASE_IDS();
    {
        for (int g2 = (int)blockIdx.x; g2 < 256; g2 += G) { const int bh = g2 >> 1, part = g2 & 1;
#pragma unroll 1
            for (int i = 0; i < 4; ++i) { const int sbk = part ? ((i == 0) ? 1 : (i == 1) ? 6 : (i == 2) ? 2 : 5) : ((i == 0) ? 0 : (i == 1) ? 7 : (i == 2) ? 3 : 4);
                sb_block(bh, sbk, tid, lane, wave, lds3, PROJ1, VTS, YMIX); } }
        for (int g2 = (int)blockIdx.x; g2 < 256; g2 += G) { const int bh = g2 >> 1, part = g2 & 1;
#pragma unroll 1
            for (int i = 0; i < 4; ++i) { const int sbk = part ? ((i == 0) ? 1 : (i == 1) ? 6 : (i == 2) ? 2 : 5) : ((i == 0) ? 0 : (i == 1) ? 7 : (i == 2) ? 3 : 4);
                mla_block(bh, sbk, tid, lane, wave, lds3, QM, KVM, KPE, VTM, YMIX); } }
    }
    }
    GRID_BAR();
    {
        PHASE_IDS();
    GEMM_PHASE(EpiResidLN, YMIX, DM, W1out, 1024, 1024, 1024, out, STATS, IN(27), IN(28), ALPHA, 0);
    }
    GRID_BAR();
    {
        PHASE_IDS();
    ln_rows<1>(out, XB, STATS, IN(35), IN(36), gw, NGW, lane);
    }
    GRID_BAR();
    {
        PHASE_IDS();
        { pg8::Gemm g_{XB, Wup1, M / 32, DFF, 1024, DM, 1024, 4096, 8192, 256, 512, 1}; pg8::StaticOrder S_; S_.init(M / 32, DFF, G, (int)blockIdx.x);
          pg8::EpiBf16S E_{HALO, nullptr, DFF, 0}; pg8::gemm_phase<pg8::EpiBf16S, pg8::StaticOrder, true, true>(lds3, g_, S_, E_); }
    }
    GRID_BAR();
    {
        PHASE_IDS();
        { pg8::Gemm g_{XB, Wup1, M, 2 * DFF, 1024, DM, 1024}; pg8::StaticOrder S_; S_.init(M, 2 * DFF, G, (int)blockIdx.x);
          pg8::EpiConvAct E_{ACT, HALO, IN(38), IN(39), DFF, SEQ}; pg8::gemm_phase<pg8::EpiConvAct, pg8::StaticOrder, true, true>(lds3, g_, S_, E_); }
    }
    GRID_BAR();
    {
        PHASE_IDS();
    GEMM_PHASE(EpiResidLN, ACT, DFF, Wdn1, DFF, 1024, DFF, out, STATS, IN(35), IN(36), ALPHA, 0);
    }
    GRID_BAR();
    {
        PHASE_IDS();
    ln_rows<2>(out, XB, STATS, IN(41), IN(42), gw, NGW, lane);
    #if defined(PROBE_STAMPS)
    __syncthreads();
    if (blockIdx.x == 0 && threadIdx.x == 0) {
        MISC[16 + 22] = (unsigned)__builtin_amdgcn_s_memrealtime();
#if defined(PROBE_ACC)
        const unsigned d1 = MISC[16 + PROBE_ACC];
#else
        const unsigned d1 = MISC[16 + PROBE_T1_HI] - MISC[16 + PROBE_T1_LO];
#endif
        const unsigned long long spin = 100ull * d1;
        const unsigned long long t0 = __builtin_amdgcn_s_memrealtime();
        while (__builtin_amdgcn_s_memrealtime() - t0 < spin) __builtin_amdgcn_s_sleep(8);
    }
#endif
}
}

extern "C" void kernel_launch(void* const* d_in, const int* in_sizes, int n_in, void* d_out, int out_size, void* d_ws, size_t ws_size, hipStream_t stream) {
    static int grid = 0;
    if (grid == 0) {
        if (n_in != 43 || ws_size < WS_NEED || out_size != M * DM) { fprintf(stderr, "kernel_launch: unexpected n_in %d / ws %zu / out %d\n", n_in, ws_size, out_size); grid = -1; return; }
        int dev = 0, cus = 0, per_cu = 0;
        if (hipGetDevice(&dev) != hipSuccess || hipDeviceGetAttribute(&cus, hipDeviceAttributeMultiprocessorCount, dev) != hipSuccess) { grid = -1; return; }
        if (hipFuncSetAttribute((const void*)fwd_mega, hipFuncAttributeMaxDynamicSharedMemorySize, LDS_BYTES) != hipSuccess) { fprintf(stderr, "kernel_launch: hipFuncSetAttribute failed\n"); grid = -1; return; }
        if (hipOccupancyMaxActiveBlocksPerMultiprocessor(&per_cu, (const void*)fwd_mega, NWAVES * 64, LDS_BYTES) != hipSuccess || per_cu < 1) fprintf(stderr, "kernel_launch: occupancy query reports %d\n", per_cu);
        (void)hipGetLastError();
        grid = cus;
    }
    if (grid < 0) return;
    (void)hipMemsetAsync((char*)d_ws + WS_CTL, 0, CTL_ZERO_BYTES, stream);
    Args a{};
    for (int i = 0; i < 43; ++i) a.in[i] = (const float*)d_in[i];
    a.out = (float*)d_out; a.ws = (unsigned char*)d_ws;
    hipLaunchKernelGGL(fwd_mega, dim3(grid), dim3(NWAVES * 64), LDS_BYTES, stream, a);
}
```

```cpp
#include <hip/hip_runtime.h>
#include <cstdio>
#include <cstdint>
#include <cmath>
namespace pg8 {
#define PG8_LAS __attribute__((address_space(3)))
typedef unsigned short bf16_t;
typedef short bf16x8 __attribute__((ext_vector_type(8)));
typedef float f32x4 __attribute__((ext_vector_type(4)));
typedef unsigned u32x4 __attribute__((ext_vector_type(4)));
constexpr int BM = 256, BK = 64, HALF = 128, HTB = HALF * BK * 2  , STAGE_BYTES = 8 * HTB, NXCD = 8, WGM = 8;

__host__ __device__ __forceinline__ int lds_byte(int r, int c) { const int st = (r >> 4) * 2 + (c >> 5), rr = r & 15, cc = c & 31, ob = rr * 64 + cc * 2; return st * 1024 + (ob ^ (((ob >> 9) & 1) << 5)); }
__host__ __device__ __forceinline__ void stage_rc(int b, int& R, int& C) { const int st = b / 1024, sb = b % 1024, swz = sb ^ (((sb >> 9) & 1) << 5); R = (st >> 1) * 16 + swz / 64; C = (st & 1) * 32 + (swz % 64) / 2; }
__host__ __device__ __forceinline__ int perm32(int rho) { const int n = rho >> 4, i = rho & 15; return 8 * (i >> 2) + 4 * n + (i & 3); }

struct Unit { int pm, pn; };
struct Gemm { const bf16_t* A; const bf16_t* Bt; int M, N, K, lda, ldb; int hrA = 128, trA = 256, hrB = 128, trB = 256, gatherA = 0; };

struct StaticOrder {
    int nM, nN, nwg, G, c;
    __host__ __device__ void init(int M, int N, int G_, int c_) { nM = M / BM; nN = N / BM; nwg = nM * nN; G = G_; c = c_; }
    __host__ __device__ bool next(int i, Unit& u) const {
        const long L = (long)i * G + c; if (L >= nwg) return false;
        int wgid = (int)L; { const int q = nwg / NXCD, r = nwg % NXCD, xcd = wgid % NXCD, off = wgid / NXCD; wgid = (xcd < r ? xcd * (q + 1) : r * (q + 1) + (xcd - r) * q) + off; }
        const int nig = WGM * nN, gid = wgid / nig, fm = gid * WGM, gsz = (nM - fm) < WGM ? (nM - fm) : WGM;
        u.pm = fm + ((wgid % nig) % gsz); u.pn = (wgid % nig) / gsz; return true;
    }
    __device__ __forceinline__ void a_ready(const Unit&) const {}
    __device__ __forceinline__ void done(const Unit&) const {}
};


__device__ __forceinline__ unsigned cvt_pk_bf16(float lo, float hi) { unsigned r; asm volatile("v_cvt_pk_bf16_f32 %0, %1, %2" : "=v"(r) : "v"(lo), "v"(hi)); return r; }
struct EpiBf16S {
    static constexpr bool PERM = true, AFTER_DRAIN = false;
    bf16_t* O; const float* rowscale; int ldc; int rs_stride;
    __device__ __forceinline__ void operator()(const f32x4 (&acc)[2][2][4][2], const Unit& u, int wr, int wc, int fr, int fq) const {
        const int row0 = u.pm * BM + wr * 64 + fr, col0 = u.pn * BM + wc * 32 + 8 * fq;
#pragma unroll
        for (int ai = 0; ai < 2; ++ai)
#pragma unroll
            for (int m = 0; m < 4; ++m) { const int row = row0 + ai * HALF + m * 16; const float sc = rowscale ? rowscale[(size_t)row * rs_stride] : 1.f;
                bf16_t* rowp = O + (size_t)row * ldc + col0;
#pragma unroll
                for (int bj = 0; bj < 2; ++bj) { const f32x4 v0 = acc[ai][bj][m][0] * sc, v1 = acc[ai][bj][m][1] * sc;
                    u32x4 w; w.x = cvt_pk_bf16(v0[0], v0[1]); w.y = cvt_pk_bf16(v0[2], v0[3]); w.z = cvt_pk_bf16(v1[0], v1[1]); w.w = cvt_pk_bf16(v1[2], v1[3]);
                    *(u32x4*)(rowp + bj * HALF) = w; } }
    }
};
struct EpiResid {
    static constexpr bool PERM = false, AFTER_DRAIN = false;
    const float* hin; float* hout; float alpha; int pad;
    __device__ __forceinline__ void operator()(const f32x4 (&acc)[2][2][4][2], const Unit& u, int wr, int wc, int fr, int fq) const {
        const int row0 = u.pm * BM + wr * 64 + fr, col0 = u.pn * BM + wc * 32 + 4 * fq;
#pragma unroll
        for (int ai = 0; ai < 2; ++ai)
#pragma unroll
            for (int m = 0; m < 4; ++m) { const size_t off = (size_t)(row0 + ai * HALF + m * 16) * 1024 + col0;
#pragma unroll
                for (int bj = 0; bj < 2; ++bj)
#pragma unroll
                    for (int n = 0; n < 2; ++n) { const size_t i = off + bj * HALF + n * 16; const f32x4 h = *(const f32x4*)(hin + i); *(f32x4*)(hout + i) = h * alpha + acc[ai][bj][m][n]; } }
    }
};

struct EpiResidLN {
    static constexpr bool PERM = false, AFTER_DRAIN = false;
    float* hio; const float* stats; const float* g; const float* b; float alpha; int pad;
    __device__ __forceinline__ void operator()(const f32x4 (&acc)[2][2][4][2], const Unit& u, int wr, int wc, int fr, int fq) const {
        const int row0 = u.pm * BM + wr * 64 + fr, col0 = u.pn * BM + wc * 32 + 4 * fq;
        f32x4 gg[2][2], bb[2][2];
#pragma unroll
        for (int bj = 0; bj < 2; ++bj)
#pragma unroll
            for (int n = 0; n < 2; ++n) { gg[bj][n] = *(const f32x4*)(g + col0 + bj * HALF + n * 16) * alpha; bb[bj][n] = *(const f32x4*)(b + col0 + bj * HALF + n * 16) * alpha; }
#pragma unroll
        for (int ai = 0; ai < 2; ++ai)
#pragma unroll
            for (int m = 0; m < 4; ++m) { const int row = row0 + ai * HALF + m * 16; const size_t off = (size_t)row * 1024 + col0;
                const float mu = stats[2 * row], rs = stats[2 * row + 1];
#pragma unroll
                for (int bj = 0; bj < 2; ++bj)
#pragma unroll
                    for (int n = 0; n < 2; ++n) { const size_t i = off + bj * HALF + n * 16; const f32x4 p = *(const f32x4*)(hio + i); *(f32x4*)(hio + i) = (p - mu) * rs * gg[bj][n] + bb[bj][n] + acc[ai][bj][m][n]; } }
    }
};

template <int CTRL> __device__ __forceinline__ float pg_dpp(float x) { return __builtin_bit_cast(float, __builtin_amdgcn_update_dpp(0, __builtin_bit_cast(int, x), CTRL, 0xF, 0xF, true)); }
struct EpiConvAct {
    static constexpr bool PERM = true, AFTER_DRAIN = false;
    bf16_t* act; const bf16_t* halo; const float* cw; const float* cb; int dff; int seq;
    __device__ __forceinline__ void operator()(const f32x4 (&acc)[2][2][4][2], const Unit& u, int wr, int wc, int fr, int fq) const {
        typedef unsigned u32x2e __attribute__((ext_vector_type(2)));
#pragma unroll
        for (int n = 0; n < 2; ++n) {
            const int ch0 = u.pn * 128 + wc * 32 + 8 * fq + 4 * n;
            const f32x4 w0 = *(const f32x4*)(cw + ch0), w1 = *(const f32x4*)(cw + dff + ch0), w2 = *(const f32x4*)(cw + 2 * dff + ch0), bb = *(const f32x4*)(cb + ch0);
#pragma unroll
            for (int ai = 0; ai < 2; ++ai) {
                const int rb64 = u.pm * BM + ai * HALF + wr * 64;
                f32x4 P = {0.f, 0.f, 0.f, 0.f};
                if ((rb64 & (seq - 1)) != 0 && fr >= 14) { const u32x2e hv = *(const u32x2e*)(halo + (size_t)(2 * (rb64 / 64 - 1) + (fr - 14)) * dff + ch0);
                    P[0] = __builtin_bit_cast(float, hv.x << 16); P[1] = __builtin_bit_cast(float, hv.x & 0xffff0000u); P[2] = __builtin_bit_cast(float, hv.y << 16); P[3] = __builtin_bit_cast(float, hv.y & 0xffff0000u); }
#pragma unroll
                for (int m = 0; m < 4; ++m) {
                    const f32x4 Gv = acc[ai][0][m][n], Uv = acc[ai][1][m][n];
                    float o[4];
#pragma unroll
                    for (int e = 0; e < 4; ++e) {
                        const float t1 = pg_dpp<0x111>(Gv[e]), t2 = pg_dpp<0x112>(Gv[e]), p1 = pg_dpp<0x10F>(P[e]), p2 = pg_dpp<0x10E>(P[e]);
                        const float g1 = (fr >= 1) ? t1 : p1, g2 = (fr >= 2) ? t2 : p2;
                        const float y = bb[e] + w0[e] * g2 + w1[e] * g1 + w2[e] * Gv[e];
                        o[e] = y * __builtin_amdgcn_rcpf(1.f + __builtin_amdgcn_exp2f(-1.4426950408889634f * y)) * Uv[e];
                    }
                    u32x2e w; w.x = cvt_pk_bf16(o[0], o[1]); w.y = cvt_pk_bf16(o[2], o[3]);
                    *(u32x2e*)(act + (size_t)(rb64 + m * 16 + fr) * dff + ch0) = w;
                    P = Gv;
                }
            }
        }
    }
};

template <class Epi, class Sched, bool ALIGN_EPI = false, bool SP2 = false>
__device__ __forceinline__ void gemm_phase(PG8_LAS unsigned char* lds, const Gemm g, const Sched& S, const Epi& E) {
    int tid = threadIdx.x; asm volatile("" : "+v"(tid));
    const int wid = __builtin_amdgcn_readfirstlane(tid >> 6), lane = tid & 63, wr = wid >> 2, wc = wid & 3, fr = lane & 15, fq = lane >> 4;
    const int K = g.K, nt = K / BK;
    unsigned voffA[2], voffB[2];
#pragma unroll
    for (int i = 0; i < 2; ++i) { int R, C; stage_rc(tid * 16 + i * 8192, R, C); const int Rb = Epi::PERM ? ((R & ~31) + perm32(R & 31)) : R;
        const int Ra = g.gatherA ? (64 * (R >> 1) + 62 + (R & 1)) : R;
        voffA[i] = (unsigned)(Ra * g.lda + C) * 2u; voffB[i] = (unsigned)(Rb * g.ldb + C) * 2u; }
    const size_t kstep = (size_t)(BK * 2);
    const size_t hstepA = (size_t)g.hrA * g.lda * 2, hstepB = (size_t)g.hrB * g.ldb * 2;
    const size_t tstepA = (size_t)g.trA * g.lda * 2, tstepB = (size_t)g.trB * g.ldb * 2;
    const unsigned ldsw = (unsigned)wid * 1024u;
    const int aoff = lds_byte(wr * 64 + fr, fq * 8), boff = lds_byte(wc * 32 + fr, fq * 8);
#define PG8_SA(b, h) (((b) * 2 + (h)) * HTB)
#define PG8_SB(b, h) ((4 + (b) * 2 + (h)) * HTB)
#define PG8_STAGE(bufoff, gbase, voff) do { _Pragma("unroll") for (int _i = 0; _i < 2; ++_i) \
        __builtin_amdgcn_global_load_lds((const unsigned*)((const char*)(gbase) + (voff)[_i]), (PG8_LAS unsigned*)(lds + (bufoff) + ldsw + _i * 8192), 16, 0, 0); } while (0)
#define PG8_LDA(dst, b, h) do { _Pragma("unroll") for (int m = 0; m < 4; ++m) _Pragma("unroll") for (int k = 0; k < 2; ++k) dst[m][k] = *(const PG8_LAS bf16x8*)(lds + PG8_SA(b, h) + aoff + m * 2048 + k * 1024); } while (0)
#define PG8_LDB(dst, b, h) do { _Pragma("unroll") for (int n = 0; n < 2; ++n) _Pragma("unroll") for (int k = 0; k < 2; ++k) dst[n][k] = *(const PG8_LAS bf16x8*)(lds + PG8_SB(b, h) + boff + n * 2048 + k * 1024); } while (0)
#define PG8_MMA(ai, bj, At, Bt) do { __builtin_amdgcn_s_setprio(1); _Pragma("unroll") for (int m = 0; m < 4; ++m) _Pragma("unroll") for (int n = 0; n < 2; ++n) _Pragma("unroll") for (int k = 0; k < 2; ++k) \
        acc[ai][bj][m][n] = __builtin_amdgcn_mfma_f32_16x16x32_bf16(Bt[n][k], At[m][k], acc[ai][bj][m][n], 0, 0, 0); __builtin_amdgcn_s_setprio(0); } while (0)
#define PG8_WAIT_V(n) asm volatile("s_waitcnt vmcnt(" #n ")" ::: "memory")
#define PG8_WAIT_L(n) asm volatile("s_waitcnt lgkmcnt(" #n ")" ::: "memory")
#define PG8_BAR __builtin_amdgcn_s_barrier()
#define PG8_SCHED __builtin_amdgcn_sched_barrier(0)
    Unit cur, nxt; int ui = 0;
    if (!S.next(0, cur)) return;
    f32x4 acc[2][2][4][2];
#pragma unroll
    for (int a = 0; a < 2; ++a)
#pragma unroll
        for (int b = 0; b < 2; ++b)
#pragma unroll
            for (int m = 0; m < 4; ++m)
#pragma unroll
                for (int n = 0; n < 2; ++n) acc[a][b][m][n] = (f32x4){0.f, 0.f, 0.f, 0.f};
    bf16x8 At[4][2], B0[2][2], B1[2][2];
    const char* cA = (const char*)g.A + (size_t)cur.pm * tstepA; const char* cB = (const char*)g.Bt + (size_t)cur.pn * tstepB;
    S.a_ready(cur);
    if constexpr (SP2) {
        PG8_STAGE(PG8_SB(0, 0), cB, voffB); PG8_STAGE(PG8_SB(0, 1), cB + hstepB, voffB); PG8_STAGE(PG8_SA(0, 0), cA, voffA); PG8_STAGE(PG8_SA(0, 1), cA + hstepA, voffA);
        if (wr == 1) PG8_BAR;
        PG8_WAIT_V(2); PG8_BAR;
        PG8_STAGE(PG8_SB(1, 0), cB + kstep, voffB); PG8_STAGE(PG8_SA(1, 0), cA + kstep, voffA); PG8_STAGE(PG8_SB(1, 1), cB + hstepB + kstep, voffB);
        PG8_WAIT_V(6); PG8_BAR;
    } else {
        PG8_STAGE(PG8_SB(0, 0), cB, voffB); PG8_STAGE(PG8_SA(0, 0), cA, voffA); PG8_STAGE(PG8_SB(0, 1), cB + hstepB, voffB); PG8_STAGE(PG8_SA(0, 1), cA + hstepA, voffA);
        if (wr == 1) PG8_BAR;
        PG8_WAIT_V(4); PG8_BAR;
        PG8_STAGE(PG8_SB(1, 0), cB + kstep, voffB); PG8_STAGE(PG8_SA(1, 0), cA + kstep, voffA); PG8_STAGE(PG8_SB(1, 1), cB + hstepB + kstep, voffB);
        PG8_WAIT_V(6); PG8_BAR;
    }
    for (;;) {
        const bool has_next = S.next(ui + 1, nxt);
        const char* nA = has_next ? (const char*)g.A + (size_t)nxt.pm * tstepA : cA; const char* nB = has_next ? (const char*)g.Bt + (size_t)nxt.pn * tstepB : cB;
        for (int t = 0; t < nt; t += 2) {
            const bool last = (t == nt - 2);
            const char* a1 = cA + (size_t)(t + 1) * kstep;
            const char* a2 = last ? nA : cA + (size_t)(t + 2) * kstep; const char* b2 = last ? nB : cB + (size_t)(t + 2) * kstep;
            const char* a3 = a2 + kstep; const char* b3 = b2 + kstep;
            if (last && has_next) S.a_ready(nxt);
            if constexpr (SP2) {
            PG8_LDB(B0, 0, 0); PG8_LDB(B1, 0, 1); PG8_SCHED; PG8_LDA(At, 0, 0); PG8_STAGE(PG8_SA(1, 1), a1 + hstepA, voffA);
            PG8_WAIT_V(8); PG8_WAIT_L(0); PG8_BAR; PG8_MMA(0, 0, At, B0); PG8_MMA(0, 1, At, B1); PG8_BAR; PG8_SCHED;
            PG8_LDA(At, 0, 1); PG8_STAGE(PG8_SB(0, 0), b2, voffB); PG8_STAGE(PG8_SB(0, 1), b2 + hstepB, voffB); PG8_STAGE(PG8_SA(0, 0), a2, voffA);
            PG8_WAIT_V(8); PG8_WAIT_L(0); PG8_BAR; PG8_MMA(1, 0, At, B0); PG8_MMA(1, 1, At, B1); PG8_BAR; PG8_SCHED;
            PG8_LDB(B0, 1, 0); PG8_LDB(B1, 1, 1); PG8_SCHED; PG8_LDA(At, 1, 0); PG8_STAGE(PG8_SA(0, 1), a2 + hstepA, voffA);
            PG8_WAIT_V(8); PG8_WAIT_L(0); PG8_BAR; PG8_MMA(0, 0, At, B0); PG8_MMA(0, 1, At, B1); PG8_BAR; PG8_SCHED;
            PG8_LDA(At, 1, 1); PG8_STAGE(PG8_SB(1, 0), b3, voffB); PG8_STAGE(PG8_SB(1, 1), b3 + hstepB, voffB); PG8_STAGE(PG8_SA(1, 0), a3, voffA);
            PG8_WAIT_V(8); PG8_WAIT_L(0); PG8_BAR; PG8_MMA(1, 0, At, B0); PG8_MMA(1, 1, At, B1); PG8_BAR; PG8_SCHED;
            } else {
            PG8_LDB(B0, 0, 0); PG8_SCHED; PG8_LDA(At, 0, 0); PG8_STAGE(PG8_SA(1, 1), a1 + hstepA, voffA);
            PG8_WAIT_L(8); PG8_BAR; PG8_WAIT_L(0); PG8_MMA(0, 0, At, B0); PG8_BAR; PG8_SCHED;
            PG8_LDB(B1, 0, 1); PG8_STAGE(PG8_SB(0, 0), b2, voffB);
            PG8_BAR; PG8_WAIT_L(0); PG8_MMA(0, 1, At, B1); PG8_BAR;
            PG8_LDA(At, 0, 1); PG8_STAGE(PG8_SA(0, 0), a2, voffA);
            PG8_BAR; PG8_WAIT_L(0); PG8_MMA(1, 0, At, B0); PG8_BAR; PG8_SCHED;
            PG8_STAGE(PG8_SB(0, 1), b2 + hstepB, voffB);
            PG8_WAIT_V(6); PG8_BAR; PG8_MMA(1, 1, At, B1); PG8_BAR;
            PG8_LDB(B0, 1, 0); PG8_SCHED; PG8_LDA(At, 1, 0); PG8_STAGE(PG8_SA(0, 1), a2 + hstepA, voffA);
            PG8_WAIT_L(8); PG8_BAR; PG8_WAIT_L(0); PG8_MMA(0, 0, At, B0); PG8_BAR; PG8_SCHED;
            PG8_LDB(B1, 1, 1); PG8_STAGE(PG8_SB(1, 0), b3, voffB);
            PG8_BAR; PG8_WAIT_L(0); PG8_MMA(0, 1, At, B1); PG8_BAR;
            PG8_LDA(At, 1, 1); PG8_STAGE(PG8_SA(1, 0), a3, voffA);
            PG8_BAR; PG8_WAIT_L(0); PG8_MMA(1, 0, At, B0); PG8_BAR; PG8_SCHED;
            PG8_STAGE(PG8_SB(1, 1), b3 + hstepB, voffB);
            PG8_WAIT_V(6); PG8_BAR; PG8_MMA(1, 1, At, B1); PG8_BAR;
            }
        }
        if constexpr (ALIGN_EPI) { if (wr == 0) PG8_BAR; }
        if constexpr (!Epi::AFTER_DRAIN) { E(acc, cur, wr, wc, fr, fq); S.done(cur); }
        if (!has_next) break;
#pragma unroll
        for (int a = 0; a < 2; ++a)
#pragma unroll
            for (int b = 0; b < 2; ++b)
#pragma unroll
                for (int m = 0; m < 4; ++m)
#pragma unroll
                    for (int n = 0; n < 2; ++n) acc[a][b][m][n] = (f32x4){0.f, 0.f, 0.f, 0.f};
        cur = nxt; cA = nA; cB = nB; ++ui;
        if constexpr (ALIGN_EPI) { if (wr == 1) PG8_BAR; }
    }
    PG8_WAIT_V(0);
    if constexpr (!ALIGN_EPI) { if (wr == 0) PG8_BAR; }
    PG8_BAR;
    if constexpr (Epi::AFTER_DRAIN) { E.fused(acc, cur, wr, wc, fr, fq, lds, wid, lane); S.done(cur); }
#undef PG8_SA
#undef PG8_SB
#undef PG8_STAGE
#undef PG8_LDA
#undef PG8_LDB
#undef PG8_MMA
#undef PG8_WAIT_V
#undef PG8_WAIT_L
#undef PG8_BAR
#undef PG8_SCHED
}
}
#define GAS __attribute__((address_space(1)))
#define LAS __attribute__((address_space(3)))
typedef unsigned short bf16;
typedef unsigned v4u __attribute__((ext_vector_type(4)));
typedef float f32x4 __attribute__((ext_vector_type(4)));
typedef short bf16x8 __attribute__((ext_vector_type(8)));
typedef GAS unsigned gu32;
typedef GAS unsigned long long gu64;
#define RLX_AGENT __ATOMIC_RELAXED, __HIP_MEMORY_SCOPE_AGENT
#define LDS_WAIT() asm volatile("s_waitcnt lgkmcnt(0)" ::: "memory")
#define VM_WAIT() asm volatile("s_waitcnt vmcnt(0)" ::: "memory")
__device__ __forceinline__ unsigned long long rt() { return __builtin_amdgcn_s_memrealtime(); }
__device__ __forceinline__ unsigned f2bf(float f) { unsigned u = __builtin_bit_cast(unsigned, f); return (u + 0x7fffu + ((u >> 16) & 1u)) >> 16; }
__device__ __forceinline__ unsigned pk2(float lo, float hi) { return f2bf(lo) | (f2bf(hi) << 16); }

#define XB_TMO      128
#define XB_XCNT(j)  (256  + 64 * (j))
#define XB_XSUB(j)  (1280 + 64 * (j))
#define XB_XGEN(j)  (2304 + 64 * (j))
#define XB_TOP      3328
#define XB_TOPGEN   3392
#define XCD_BAR_WORDS 3456
#define XB_SPIN_CAP (1u << 18)

__device__ __forceinline__ unsigned xb_ld(unsigned* p)              { return __hip_atomic_load(p, __ATOMIC_RELAXED, __HIP_MEMORY_SCOPE_AGENT); }
__device__ __forceinline__ unsigned xb_add(unsigned* p, unsigned v) { return __hip_atomic_fetch_add(p, v, __ATOMIC_RELAXED, __HIP_MEMORY_SCOPE_AGENT); }
__device__ __forceinline__ unsigned xb_xcc_id() { return (unsigned)__builtin_amdgcn_s_getreg((3 << 11) | 20) & 0xFu; }
#define XB_SPIN(cond, bar) do { unsigned _sp = 0; while (cond) { __builtin_amdgcn_s_sleep(1); \
    if ((++_sp & 255u) == 0u) { if (xb_ld(&(bar)[XB_TMO])) break; if (_sp > XB_SPIN_CAP) { atomicAdd(&(bar)[XB_TMO], 1u); break; } } } } while (0)

struct XcdBarrier {
    unsigned* bar; unsigned x;
    volatile LAS unsigned* st;
};

__device__ __forceinline__ XcdBarrier xcd_barrier_post(unsigned* bar, volatile LAS unsigned* st) {
    XcdBarrier b; b.bar = bar; b.x = xb_xcc_id(); b.st = st;
    if (threadIdx.x == 0) (void)xb_add(&bar[XB_XCNT(b.x)], 1u);
    return b;
}
__device__ __forceinline__ void xcd_barrier_complete(unsigned* bar, unsigned x, unsigned& nloc, unsigned& nx) {
    const unsigned G = gridDim.x * gridDim.y * gridDim.z;
    unsigned sum, cnt, mine, sp = 0u;
    for (;;) {
        sum = 0u; cnt = 0u; mine = 0u;
#pragma unroll
        for (unsigned j = 0; j < 16; ++j) { const unsigned c = xb_ld(&bar[XB_XCNT(j)]); sum += c; cnt += (c > 0u) ? 1u : 0u; mine = (j == x) ? c : mine; }
        if (sum == G) break;
        __builtin_amdgcn_s_sleep(1);
        if ((++sp & 255u) == 0u) { if (xb_ld(&bar[XB_TMO])) break; if (sp > XB_SPIN_CAP) { atomicAdd(&bar[XB_TMO], 1u); break; } }
    }
    nloc = mine > 0u ? mine : 1u; nx = cnt > 0u ? cnt : 1u;
}

__device__ __forceinline__ void xcd_barrier(const XcdBarrier& b) {
    asm volatile("s_waitcnt vmcnt(0)" ::: "memory");
    __syncthreads();
    if (threadIdx.x == 0) {
        unsigned* bar = b.bar;
        __builtin_amdgcn_s_waitcnt(0);
        unsigned nloc = b.st[0], nx = b.st[1];
        if (nloc == 0u) { xcd_barrier_complete(bar, b.x, nloc, nx); b.st[0] = nloc; b.st[1] = nx; }
        const unsigned old = xb_add(&bar[XB_XSUB(b.x)], 1u);
        const unsigned gen = old / nloc;
        if (old + 1u == (gen + 1u) * nloc) {
            __builtin_amdgcn_fence(__ATOMIC_RELEASE, "agent");
            asm volatile("s_waitcnt vmcnt(0)" ::: "memory");
            const unsigned og = xb_add(&bar[XB_TOP], 1u);
            const unsigned tg = og / nx;
            if (og + 1u == (tg + 1u) * nx) xb_add(&bar[XB_TOPGEN], 1u);
            else XB_SPIN(xb_ld(&bar[XB_TOPGEN]) == tg, bar);
            __builtin_amdgcn_fence(__ATOMIC_ACQUIRE, "agent");
            xb_add(&bar[XB_XGEN(b.x)], 1u);
            asm volatile("s_waitcnt vmcnt(0)" ::: "memory");
        } else {
            XB_SPIN(xb_ld(&bar[XB_XGEN(b.x)]) == gen, bar);
            __builtin_amdgcn_fence(__ATOMIC_ACQUIRE, "agent");
            asm volatile("s_waitcnt vmcnt(0)" ::: "memory");
        }
    }
    __syncthreads();
}
constexpr int NWAVES = 8;
constexpr int BATCH = 16, SEQ = 2048, DM = 1024, M = BATCH * SEQ;
constexpr int L0P = 3584;
constexpr int L1P = 2048;
constexpr int DFF = 2816;
constexpr float ALPHA = 1.4142135623730951f;
typedef unsigned short bf16_t;
typedef float f32x16 __attribute__((ext_vector_type(16)));

constexpr size_t MiB = 1u << 20;
constexpr size_t WS_CTL = 0, CTL_ZERO_BYTES = 1 * MiB;
constexpr int CW_BAR = 4096;
constexpr size_t WS_W0IN = 2 * MiB, WS_W0OUT = 9 * MiB, WS_WUP0 = 11 * MiB, WS_WDN0 = 22 * MiB, WS_W1IN = 28 * MiB, WS_WUQ = 32 * MiB, WS_WUKV = 33 * MiB,
                 WS_W1OUT = 34 * MiB, WS_WUP1 = 36 * MiB, WS_WDN1 = 47 * MiB;
constexpr size_t WS_XB = 56 * MiB, WS_YMIX = 120 * MiB, WS_BIG = 184 * MiB;
constexpr size_t WS_G = 408 * MiB, WS_BONUS = 440 * MiB, WS_DT = 441 * MiB, WS_XST = 442 * MiB, WS_BT = 474 * MiB, WS_ASUM = 490 * MiB;
constexpr size_t WS_SLOC = 120 * MiB;
constexpr size_t WS_W2T = 53 * MiB, WS_A2T = 53 * MiB + 256 * 1024, WS_G2T = 53 * MiB + 512 * 1024;
constexpr size_t WS_GU = 120 * MiB;
constexpr size_t WS_PROJ1 = 184 * MiB, WS_QM = 312 * MiB, WS_KVM = 360 * MiB, WS_KPE = 424 * MiB, WS_RS = 426 * MiB;
constexpr size_t WS_CSTAB = 492 * MiB;
constexpr size_t WS_VTS = 428 * MiB, WS_VTM = 460 * MiB;
constexpr size_t WS_NEED = 497 * MiB;

constexpr int RING_BYTES = 131072;
constexpr int LDSCTL_OFF = 146432, MISC_OFF = LDSCTL_OFF + 320;
constexpr int LDS_BYTES = 147456;

__device__ __forceinline__ float bf2f(bf16_t b) { return __builtin_bit_cast(float, (unsigned)b << 16); }
__device__ __forceinline__ float sigmoidf_(float x) { return 1.f / (1.f + expf(-x)); }
__device__ __forceinline__ float softplusf_(float x) { return fmaxf(x, 0.f) + log1pf(expf(-fabsf(x))); }
__device__ __forceinline__ float siluf_(float x) { return x / (1.f + expf(-x)); }
__device__ __forceinline__ float wave_sum(float v) {
#pragma unroll
    for (int o = 1; o < 64; o <<= 1) v += __shfl_xor(v, o);
    return v;
}
#define WSYNC() asm volatile("s_waitcnt lgkmcnt(0)" ::: "memory")
typedef float f32x2_t __attribute__((ext_vector_type(2)));
typedef __bf16 bf16x2_t __attribute__((ext_vector_type(2)));
typedef unsigned u32x2 __attribute__((ext_vector_type(2)));
__device__ __forceinline__ unsigned cvtpk(float lo, float hi) { f32x2_t v = {lo, hi}; bf16x2_t b = __builtin_convertvector(v, bf16x2_t); return __builtin_bit_cast(unsigned, b); }
__device__ __forceinline__ float bflo(unsigned u) { return __builtin_bit_cast(float, u << 16); }
__device__ __forceinline__ float bfhi(unsigned u) { return __builtin_bit_cast(float, u & 0xffff0000u); }
__device__ __forceinline__ bf16_t bf1(float x) { return (bf16_t)(cvtpk(x, x) & 0xffffu); }
__device__ __forceinline__ bf16x8 pack8(float a0, float a1, float a2, float a3, float a4, float a5, float a6, float a7) {
    v4u w; w.x = cvtpk(a0, a1); w.y = cvtpk(a2, a3); w.z = cvtpk(a4, a5); w.w = cvtpk(a6, a7); return __builtin_bit_cast(bf16x8, w); }
template <int CTRL> __device__ __forceinline__ float dpp_mov(float x) { return __builtin_bit_cast(float, __builtin_amdgcn_update_dpp(0, __builtin_bit_cast(int, x), CTRL, 0xF, 0xF, true)); }
__device__ __forceinline__ float rowsum16(float x) { x += dpp_mov<0x128>(x); x += dpp_mov<0x124>(x); x += dpp_mov<0x122>(x); x += dpp_mov<0x121>(x); return x; }
__device__ __forceinline__ float rl(float x, int l) { return __builtin_bit_cast(float, __builtin_amdgcn_readlane(__builtin_bit_cast(int, x), l)); }
__device__ __forceinline__ float wave_sum_dpp(float x) { x = rowsum16(x); return (rl(x, 0) + rl(x, 16)) + (rl(x, 32) + rl(x, 48)); }

__device__ __forceinline__ void transpose_matrix(const float* __restrict__ W, int K, int N, bf16_t* __restrict__ WT, int Npad, int ldt, LAS float* scr, int gw, int NGW, int lane, const float* __restrict__ kscale, int& tr_base, bool ffn_interleave = false) {
    (void)scr;
    const int nblk = Npad / 64, nit = (K / 64) * nblk;
    int it0 = gw - (tr_base % NGW); if (it0 < 0) it0 += NGW; tr_base += nit;
    for (int it = it0; it < nit; it += NGW) {
        const int kb = it / nblk, nb = it - kb * nblk, n = nb * 64 + lane, k0 = kb * 64;
        const bool ok = n < N; const float* src = W + (size_t)k0 * N + (ok ? n : 0);
#pragma unroll
        for (int hc = 0; hc < 2; ++hc) {
            float v[32];
#pragma unroll
            for (int i = 0; i < 32; ++i) v[i] = src[(size_t)(hc * 32 + i) * N];
#pragma unroll
            for (int c = 0; c < 4; ++c) { float u[8];
#pragma unroll
                for (int i = 0; i < 8; ++i) { u[i] = ok ? v[c * 8 + i] : 0.f; if (kscale) u[i] *= kscale[k0 + hc * 32 + c * 8 + i]; }
                v4u o; o.x = cvtpk(u[0], u[1]); o.y = cvtpk(u[2], u[3]); o.z = cvtpk(u[4], u[5]); o.w = cvtpk(u[6], u[7]);
                const int nr = ffn_interleave ? ((n < DFF) ? 256 * (n >> 7) + (n & 127) : 256 * ((n - DFF) >> 7) + 128 + ((n - DFF) & 127)) : n;
                *(v4u*)(WT + (size_t)nr * ldt + k0 + hc * 32 + c * 8) = o; }
        }
    }
}

template <int MODE> __device__ __forceinline__ void ln_rows(float* h, bf16_t* hb, float* stats, const float* __restrict__ g, const float* __restrict__ b, int gw, int NGW, int lane) {
    for (int row = gw * 2; row < M; row += NGW * 2) {
        float* p = h + (size_t)row * DM;
        f32x4 v[2][4]; float s[2] = {0.f, 0.f};
#pragma unroll
        for (int r = 0; r < 2; ++r)
#pragma unroll
            for (int j = 0; j < 4; ++j) v[r][j] = *(const f32x4*)(p + r * DM + 4 * lane + 256 * j);
#pragma unroll
        for (int r = 0; r < 2; ++r)
#pragma unroll
            for (int j = 0; j < 4; ++j) s[r] += (v[r][j][0] + v[r][j][1]) + (v[r][j][2] + v[r][j][3]);
        float mean[2], q[2] = {0.f, 0.f}, rstd[2];
#pragma unroll
        for (int r = 0; r < 2; ++r) { mean[r] = wave_sum_dpp(s[r]) * (1.f / DM);
#pragma unroll
            for (int j = 0; j < 4; ++j) { v[r][j] = v[r][j] - mean[r]; q[r] += (v[r][j][0] * v[r][j][0] + v[r][j][1] * v[r][j][1]) + (v[r][j][2] * v[r][j][2] + v[r][j][3] * v[r][j][3]); } }
#pragma unroll
        for (int r = 0; r < 2; ++r) rstd[r] = 1.0f / sqrtf(wave_sum_dpp(q[r]) * (1.f / DM) + 1e-5f);
        if (MODE == 1 && lane < 2) { stats[2 * (row + lane)] = lane ? mean[1] : mean[0]; stats[2 * (row + lane) + 1] = lane ? rstd[1] : rstd[0]; }
#pragma unroll
        for (int j = 0; j < 4; ++j) {
            const int c = 4 * lane + 256 * j;
            const f32x4 gg = *(const f32x4*)(g + c), bb = *(const f32x4*)(b + c);
#pragma unroll
            for (int r = 0; r < 2; ++r) {
                const f32x4 o = v[r][j] * rstd[r] * gg + bb;
                if (MODE == 1) { uint2 w; w.x = cvtpk(o[0], o[1]); w.y = cvtpk(o[2], o[3]); *(uint2*)(hb + (size_t)(row + r) * DM + c) = w; }
                else *(f32x4*)(p + r * DM + c) = o;
            }
        }
    }
}

__device__ __forceinline__ void rwkv_naive_chain(int chain, int lane, LAS float* sm, const bf16_t* __restrict__ proj, const float* __restrict__ mix, const float* __restrict__ w0, const float* __restrict__ w2,
                                                 const float* __restrict__ a0, const float* __restrict__ a2, const float* __restrict__ g2, const float* __restrict__ k_k,
                                                 const float* __restrict__ k_a, const float* __restrict__ r_k, const float* __restrict__ ln_g, const float* __restrict__ ln_b, bf16_t* __restrict__ ymix) {
    LAS float* s_w2 = sm; LAS float* s_a2 = sm + 4096; LAS float* s_g2 = sm + 8192; LAS float* s_tw = sm + 16384; LAS float* s_al = s_tw + 64; LAS float* s_sg = s_tw + 128;
    LAS float* s_w = s_tw + 256; LAS float* s_k = s_tw + 320; LAS float* s_a = s_tw + 384; LAS float* s_b = s_tw + 448; LAS float* s_r = s_tw + 512;
    const int b = chain >> 3, h = chain & 7, c = h * 64 + lane;
    for (int l = 0; l < 64; ++l) { s_w2[l * 64 + lane] = w2[l * 512 + c]; s_a2[l * 64 + lane] = a2[l * 512 + c]; }
    for (int l = 0; l < 128; ++l) s_g2[l * 64 + lane] = g2[l * 512 + c];
    const float mr = mix[c], mk = mix[512 + c], mv = mix[1024 + c], mw = mix[1536 + lane], ma = mix[1600 + lane], mg0 = mix[1664 + lane], mg1 = mix[1728 + lane];
    const float w0c = w0[c], a0c = a0[c], kkc = k_k[c], kac = k_a[c], rkc = r_k[c], lgc = ln_g[c], lbc = ln_b[c];
    float S[64];
#pragma unroll
    for (int j = 0; j < 64; ++j) S[j] = 0.f;
    float pr = 0.f, pk = 0.f, pv = 0.f, pw = 0.f, pa = 0.f, pg0 = 0.f, pg1 = 0.f;
    WSYNC();
    for (int t = 0; t < SEQ; ++t) {
        const bf16_t* row = proj + (size_t)(b * SEQ + t) * L0P;
        const float cr = bf2f(row[c]), ck = bf2f(row[512 + c]), cv = bf2f(row[1024 + c]), cw = bf2f(row[1536 + lane]), ca = bf2f(row[1600 + lane]),
                    cg0 = bf2f(row[1664 + lane]), cg1 = bf2f(row[1728 + lane]);
        const float r_s = cr + (pr - cr) * mr, k_s = ck + (pk - ck) * mk, v_s = cv + (pv - cv) * mv;
        const float wl = cw + (pw - cw) * mw, al = ca + (pa - ca) * ma, g0 = cg0 + (pg0 - cg0) * mg0, g1 = cg1 + (pg1 - cg1) * mg1;
        pr = cr; pk = ck; pv = cv; pw = cw; pa = ca; pg0 = cg0; pg1 = cg1;
        s_tw[lane] = tanhf(wl); s_al[lane] = al; s_sg[lane] = sigmoidf_(g0); s_sg[64 + lane] = sigmoidf_(g1);
        WSYNC();
        float wsum = w0c, asum = a0c, gsum = 0.f;
#pragma unroll 2
        for (int l = 0; l < 64; ++l) { wsum += s_tw[l] * s_w2[l * 64 + lane]; asum += s_al[l] * s_a2[l * 64 + lane]; }
#pragma unroll 2
        for (int l = 0; l < 128; ++l) gsum += s_sg[l] * s_g2[l * 64 + lane];
        const float log_w = -softplusf_(-wsum) - 0.5f;
        const float dec = expf(-expf(log_w));
        const float a = sigmoidf_(asum);
        float kkv = k_s * kkc;
        const float nrm = sqrtf(wave_sum(kkv * kkv));
        kkv = kkv / fmaxf(nrm, 1e-12f);
        const float k2 = k_s * (1.f + (a - 1.f) * kac);
        const float bonus_s = wave_sum(r_s * k2 * rkc);
        s_w[lane] = dec; s_k[lane] = k2; s_a[lane] = -kkv; s_b[lane] = kkv * a; s_r[lane] = r_s;
        WSYNC();
        float sa = 0.f;
#pragma unroll
        for (int j = 0; j < 64; ++j) sa += S[j] * s_a[j];
        float y = 0.f;
#pragma unroll
        for (int j = 0; j < 64; ++j) { S[j] = S[j] * s_w[j] + sa * s_b[j] + v_s * s_k[j]; y += S[j] * s_r[j]; }
        const float mu = wave_sum(y) * (1.f / 64.f);
        const float d = y - mu;
        const float var = wave_sum(d * d) * (1.f / 64.f);
        const float yn = d * (1.0f / sqrtf(var + 64e-5f)) * lgc + lbc;
        const float o = (yn + bonus_s * v_s) * gsum;
        ymix[(size_t)(b * SEQ + t) * DM + c] = (bf16_t)f2bf(o);
        WSYNC();
    }
}

__device__ __forceinline__ void ssm_conv_all(const bf16_t* __restrict__ proj, const float* __restrict__ cw, const float* __restrict__ cb, const float* __restrict__ dtb,
                                             bf16_t* __restrict__ xbc, float* __restrict__ dt, int gtid, int NT) {
    for (size_t i = gtid; i < (size_t)M * 1024; i += NT) {
        const int m = (int)(i >> 10), c = (int)(i & 1023), t = m & (SEQ - 1);
        float acc = cb[c];
#pragma unroll
        for (int k = 0; k < 4; ++k) { const int tt = t - 3 + k; if (tt >= 0) acc += cw[k * 1024 + c] * bf2f(proj[(size_t)(m - 3 + k) * L0P + 2304 + c]); }
        xbc[i] = (bf16_t)f2bf(siluf_(acc));
    }
    for (int i = gtid; i < M * 8; i += NT) dt[i] = softplusf_(bf2f(proj[(size_t)(i >> 3) * L0P + 3328 + (i & 7)]) + dtb[i & 7]);
}
__device__ __forceinline__ void ssd_naive_task(int task, int lane, const bf16_t* __restrict__ xbc, const float* __restrict__ dt, const float* __restrict__ a_log, const float* __restrict__ dsk, float* __restrict__ yssm) {
    const int chain = task >> 2, q = task & 3, b = chain >> 3, h = chain & 7, g = h >> 2, p = q * 16 + (lane >> 2), nq = lane & 3;
    const float A = -expf(a_log[h]), D = dsk[h];
    float st[32];
#pragma unroll
    for (int n = 0; n < 32; ++n) st[n] = 0.f;
    for (int t = 0; t < SEQ; ++t) {
        const size_t m = (size_t)b * SEQ + t;
        const float dtv = dt[m * 8 + h], dA = expf(dtv * A);
        const float x = bf2f(xbc[m * 1024 + h * 64 + p]), xdt = x * dtv;
        const bf16_t* Bp = xbc + m * 1024 + 512 + g * 128 + nq * 32;
        const bf16_t* Cp = xbc + m * 1024 + 768 + g * 128 + nq * 32;
        float yp = 0.f;
#pragma unroll
        for (int n = 0; n < 32; ++n) { st[n] = st[n] * dA + xdt * bf2f(Bp[n]); yp += st[n] * bf2f(Cp[n]); }
        yp += __shfl_xor(yp, 1); yp += __shfl_xor(yp, 2);
        if (nq == 0) yssm[m * 512 + h * 64 + p] = yp + D * x;
    }
}
template <bool ST = true> __device__ __forceinline__ void ssm_gate_norm_all(const bf16_t* __restrict__ yssm, const bf16_t* __restrict__ proj, const float* __restrict__ ng, bf16_t* __restrict__ ymix, int wv0, int wvend, int lane) {
    for (int wvb = wv0 * 4 - (wv0 & ~7) * 3; wvb < wvend; wvb += NWAVES * 4) {
        float u[4][4], q[4];
#pragma unroll
        for (int k = 0; k < 4; ++k) { const int wv = wvb + k, m = wv >> 1, g = wv & 1; q[k] = 0.f;
#pragma unroll
            for (int j = 0; j < 4; ++j) { const int c = g * 256 + j * 64 + lane; const float z = bf2f(proj[(size_t)m * L0P + 1792 + c]); u[k][j] = bf2f(yssm[(size_t)m * 512 + c]) * (z * __builtin_amdgcn_rcpf(1.f + __expf(-z))); q[k] += u[k][j] * u[k][j]; } }
#pragma unroll
        for (int k = 0; k < 4; ++k) { const int wv = wvb + k, m = wv >> 1, g = wv & 1;
            const float rs = __builtin_amdgcn_rsqf(wave_sum_dpp(q[k]) * (1.f / 256.f) + 1e-5f);
#pragma unroll
            for (int j = 0; j < 4; ++j) { const int c = g * 256 + j * 64 + lane; const float o_ = u[k][j] * rs * ng[c]; if (ST) ymix[(size_t)m * DM + 512 + c] = bf1(o_); else asm volatile("" :: "v"(o_)); } }
    }
}
template <bool ST = true> __device__ __forceinline__ void ffn_act_all(bf16_t* gu, const float* __restrict__ cw, const float* __restrict__ cb, int gtid, int NT) {
    constexpr int NCH = DFF / 8, NSTRIP = M / 32;
    for (int task = gtid; task < NSTRIP * NCH; task += NT) {
        const int strip = task / NCH, q = task - strip * NCH, c0 = q * 8, m0 = strip * 32;
        float w0[8], w1[8], w2[8], bb[8], g2[8], g1[8];
#pragma unroll
        for (int j = 0; j < 8; j += 4) { const f32x4 a = *(const f32x4*)(cw + c0 + j), b = *(const f32x4*)(cw + DFF + c0 + j), c = *(const f32x4*)(cw + 2 * DFF + c0 + j), d = *(const f32x4*)(cb + c0 + j);
#pragma unroll
            for (int k = 0; k < 4; ++k) { w0[j + k] = a[k]; w1[j + k] = b[k]; w2[j + k] = c[k]; bb[j + k] = d[k]; } }
        bf16_t* base = gu + (size_t)m0 * (2 * DFF) + c0;
        if ((m0 & (SEQ - 1)) != 0) { const v4u a = *(const v4u*)(base - 2 * (2 * DFF)), b = *(const v4u*)(base - (2 * DFF));
            g2[0] = bflo(a.x); g2[1] = bfhi(a.x); g2[2] = bflo(a.y); g2[3] = bfhi(a.y); g2[4] = bflo(a.z); g2[5] = bfhi(a.z); g2[6] = bflo(a.w); g2[7] = bfhi(a.w);
            g1[0] = bflo(b.x); g1[1] = bfhi(b.x); g1[2] = bflo(b.y); g1[3] = bfhi(b.y); g1[4] = bflo(b.z); g1[5] = bfhi(b.z); g1[6] = bflo(b.w); g1[7] = bfhi(b.w); }
        else {
#pragma unroll
            for (int j = 0; j < 8; ++j) { g2[j] = 0.f; g1[j] = 0.f; } }
#pragma unroll 4
        for (int r = 0; r < 32; ++r) {
            const v4u gv = *(const v4u*)(base + (size_t)r * (2 * DFF)), uv = *(const v4u*)(base + (size_t)r * (2 * DFF) + DFF);
            const unsigned gw_[4] = {gv.x, gv.y, gv.z, gv.w}, uw_[4] = {uv.x, uv.y, uv.z, uv.w};
            unsigned ow[4];
#pragma unroll
            for (int k = 0; k < 4; ++k) {
                const float ga = bflo(gw_[k]), gb = bfhi(gw_[k]);
                const float ya = bb[2 * k] + w0[2 * k] * g2[2 * k] + w1[2 * k] * g1[2 * k] + w2[2 * k] * ga;
                const float yb = bb[2 * k + 1] + w0[2 * k + 1] * g2[2 * k + 1] + w1[2 * k + 1] * g1[2 * k + 1] + w2[2 * k + 1] * gb;
                g2[2 * k] = g1[2 * k]; g1[2 * k] = ga; g2[2 * k + 1] = g1[2 * k + 1]; g1[2 * k + 1] = gb;
                ow[k] = cvtpk(ya / (1.f + __expf(-ya)) * bflo(uw_[k]), yb / (1.f + __expf(-yb)) * bfhi(uw_[k]));
            }
            if (ST) *(v4u*)(base + (size_t)r * (2 * DFF) + DFF) = (v4u){ow[0], ow[1], ow[2], ow[3]}; else asm volatile("" :: "v"(ow[0]), "v"(ow[1]), "v"(ow[2]), "v"(ow[3]));
        }
    }
}
template <bool ST = true> __device__ __forceinline__ void mla_prep_all(const bf16_t* __restrict__ proj1, const int* __restrict__ pos, float* __restrict__ rs, bf16_t* __restrict__ kpe, float* __restrict__ cstab, int gw, int NGW, int lane) {
    for (int m4 = gw * 4; m4 < M; m4 += NGW * 4) {
        const int mt = m4 + (lane >> 4), fi = lane & 15;
        const double inv = exp2(-(double)(2 * fi) * (13.287712379549449 / 32.0));
        const double ang = (double)pos[mt] * inv;
        const float cs = (float)cos(ang), sn = (float)sin(ang);
        cstab[(size_t)mt * 32 + fi] = cs; cstab[(size_t)mt * 32 + 16 + fi] = sn;
        { const bf16_t* row = proj1 + (size_t)mt * L1P; const float x1 = bf2f(row[1920 + fi]), x2 = bf2f(row[1936 + fi]);
          kpe[(size_t)mt * 32 + fi] = bf1(x1 * cs - x2 * sn); kpe[(size_t)mt * 32 + 16 + fi] = bf1(x2 * cs + x1 * sn); }
        float q[4], k[4];
#pragma unroll
        for (int u = 0; u < 4; ++u) { const bf16_t* row = proj1 + (size_t)(m4 + u) * L1P; q[u] = 0.f; k[u] = 0.f;
#pragma unroll
            for (int j = 0; j < 4; ++j) { const float v = bf2f(row[1536 + j * 64 + lane]); q[u] += v * v; }
#pragma unroll
            for (int j = 0; j < 2; ++j) { const float v = bf2f(row[1792 + j * 64 + lane]); k[u] += v * v; } }
#pragma unroll
        for (int u = 0; u < 4; ++u) { q[u] = wave_sum_dpp(q[u]); k[u] = wave_sum_dpp(k[u]); }
        if (lane < 4) { const float qq = lane == 0 ? q[0] : lane == 1 ? q[1] : lane == 2 ? q[2] : q[3], kk2 = lane == 0 ? k[0] : lane == 1 ? k[1] : lane == 2 ? k[2] : k[3];
            rs[(size_t)(m4 + lane) * 2] = 1.0f / sqrtf(qq * (1.f / 256.f) + 1e-6f); rs[(size_t)(m4 + lane) * 2 + 1] = 1.0f / sqrtf(kk2 * (1.f / 128.f) + 1e-6f); }
    }
}
template <bool ST = true> __device__ __forceinline__ void rope_q_all(bf16_t* qm, const float* __restrict__ cstab, int gtid, int NT) {
    for (int i = gtid; i < M * 16; i += NT) {
        const int m = i >> 4, h = (i >> 1) & 7, k0 = (i & 1) * 8;
        bf16_t* p = qm + (size_t)m * 768 + h * 96 + 64 + k0;
        const v4u a = *(const v4u*)p, b = *(const v4u*)(p + 16);
        const f32x4 c0 = *(const f32x4*)(cstab + (size_t)m * 32 + k0), c1 = *(const f32x4*)(cstab + (size_t)m * 32 + k0 + 4), s0 = *(const f32x4*)(cstab + (size_t)m * 32 + 16 + k0), s1 = *(const f32x4*)(cstab + (size_t)m * 32 + 16 + k0 + 4);
        const unsigned au[4] = {a.x, a.y, a.z, a.w}, bu[4] = {b.x, b.y, b.z, b.w};
        const float cs[8] = {c0[0], c0[1], c0[2], c0[3], c1[0], c1[1], c1[2], c1[3]}, sn[8] = {s0[0], s0[1], s0[2], s0[3], s1[0], s1[1], s1[2], s1[3]};
        unsigned o1[4], o2[4];
#pragma unroll
        for (int q = 0; q < 4; ++q) { const float x1a = bflo(au[q]), x1b = bfhi(au[q]), x2a = bflo(bu[q]), x2b = bfhi(bu[q]);
            o1[q] = cvtpk(x1a * cs[2 * q] - x2a * sn[2 * q], x1b * cs[2 * q + 1] - x2b * sn[2 * q + 1]);
            o2[q] = cvtpk(x2a * cs[2 * q] + x1a * sn[2 * q], x2b * cs[2 * q + 1] + x1b * sn[2 * q + 1]); }
        if (ST) { *(v4u*)p = (v4u){o1[0], o1[1], o1[2], o1[3]}; *(v4u*)(p + 16) = (v4u){o2[0], o2[1], o2[2], o2[3]}; }
    }
}
__device__ __forceinline__ void sb_naive_task(int qblk, int bh, int lane, const bf16_t* __restrict__ proj1, bf16_t* __restrict__ ymix) {
    const int b = bh >> 3, h = bh & 7, t = qblk * 64 + lane;
    const size_t mrow = (size_t)b * SEQ;
    float q[64], o[64];
#pragma unroll
    for (int d = 0; d < 64; ++d) { q[d] = bf2f(proj1[(mrow + t) * L1P + h * 64 + d]) * 0.125f; o[d] = 0.f; }
    float cum = 0.f;
    const int smax = qblk * 64 + 63;
    for (int s = smax - 1; s >= 0; --s) {
        const bf16_t* kr = proj1 + (mrow + s) * L1P + 512 + h * 64;
        const bf16_t* vr = proj1 + (mrow + s) * L1P + 1024 + h * 64;
        float z = 0.f;
#pragma unroll
        for (int d = 0; d < 64; ++d) z += q[d] * bf2f(kr[d]);
        if (s < t) {
            const float lsp = -softplusf_(-z);
            const float lsn = -softplusf_(z);
            const float att = expf(lsp + cum);
            cum += lsn;
#pragma unroll
            for (int d = 0; d < 64; ++d) o[d] += att * bf2f(vr[d]);
        }
    }
#pragma unroll
    for (int d = 0; d < 64; ++d) ymix[(mrow + t) * DM + h * 64 + d] = (bf16_t)f2bf(o[d]);
}
__device__ __forceinline__ void mla_naive_task(int qblk, int bh, int lane, const bf16_t* __restrict__ qm, const bf16_t* __restrict__ kvm, const bf16_t* __restrict__ kpe, bf16_t* __restrict__ ymix) {
    const int b = bh >> 3, h = bh & 7, t = qblk * 64 + lane;
    const size_t mrow = (size_t)b * SEQ;
    const float scale = 0.10206207261596577f;
    float q[96], o[64];
#pragma unroll
    for (int d = 0; d < 96; ++d) q[d] = bf2f(qm[(mrow + t) * 768 + h * 96 + d]) * scale;
#pragma unroll
    for (int d = 0; d < 64; ++d) o[d] = 0.f;
    float mx = -1e30f, l = 0.f;
    const int smax = qblk * 64 + 63;
    for (int s = 0; s <= smax; ++s) {
        const bf16_t* kr = kvm + (mrow + s) * 1024 + h * 128;
        const bf16_t* pr = kpe + (mrow + s) * 32;
        float z = 0.f;
#pragma unroll
        for (int d = 0; d < 64; ++d) z += q[d] * bf2f(kr[d]);
#pragma unroll
        for (int d = 0; d < 32; ++d) z += q[64 + d] * bf2f(pr[d]);
        if (s <= t) {
            const float mn = fmaxf(mx, z), f = expf(mx - mn), pz = expf(z - mn);
            l = l * f + pz; mx = mn;
#pragma unroll
            for (int d = 0; d < 64; ++d) o[d] = o[d] * f + pz * bf2f(kr[64 + d]);
        }
    }
    const float il = 1.f / l;
#pragma unroll
    for (int d = 0; d < 64; ++d) ymix[(mrow + t) * DM + 512 + h * 64 + d] = (bf16_t)f2bf(o[d] * il);
}


__device__ __forceinline__ int crow(int r, int hi) { return (r & 3) + 8 * (r >> 2) + 4 * hi; }
#define MFMA32(a, b, c) __builtin_amdgcn_mfma_f32_32x32x16_bf16((a), (b), (c), 0, 0, 0)
constexpr int STG_PITCH = 72;
__device__ __forceinline__ void transpose_tile64(const bf16_t* __restrict__ src, int sp, bf16_t* __restrict__ dst, int dp, LAS bf16_t* scr, int lane) {
#pragma unroll
    for (int i = 0; i < 8; ++i) { const int row = i * 8 + (lane >> 3), ch = lane & 7; const v4u v = *(const v4u*)(src + (size_t)row * sp + ch * 8); *(LAS v4u*)(scr + row * STG_PITCH + ch * 8) = v; }
    WSYNC();
#pragma unroll
    for (int i = 0; i < 8; ++i) { const int d = i * 8 + (lane >> 3), tc = lane & 7; const LAS bf16_t* p = scr + (tc * 8) * STG_PITCH + d;
        v4u o; o.x = (unsigned)p[0] | ((unsigned)p[STG_PITCH] << 16); o.y = (unsigned)p[2 * STG_PITCH] | ((unsigned)p[3 * STG_PITCH] << 16);
        o.z = (unsigned)p[4 * STG_PITCH] | ((unsigned)p[5 * STG_PITCH] << 16); o.w = (unsigned)p[6 * STG_PITCH] | ((unsigned)p[7 * STG_PITCH] << 16);
        *(v4u*)(dst + (size_t)d * dp + tc * 8) = o; }
    WSYNC();
}
__device__ __forceinline__ void store_OT(const f32x16 (&o)[2], float sc, LAS bf16_t* stg, bf16_t* __restrict__ dst, int lane) {
    const int l31 = lane & 31, hi = lane >> 5;
#pragma unroll
    for (int dt = 0; dt < 2; ++dt)
#pragma unroll
        for (int r = 0; r < 16; ++r) stg[l31 * STG_PITCH + 32 * dt + crow(r, hi)] = bf1(o[dt][r] * sc);
    WSYNC();
#pragma unroll
    for (int i = 0; i < 4; ++i) { const int row = i * 8 + (lane >> 3), ch = lane & 7; const v4u v = *(const LAS v4u*)(stg + row * STG_PITCH + ch * 8); *(v4u*)(dst + (size_t)row * DM + ch * 8) = v; }
    WSYNC();
}
__device__ __forceinline__ float softplus_fast(float z) { return fmaxf(z, 0.f) + __logf(1.f + __expf(-fabsf(z))); }

__device__ __forceinline__ void sb_task(int bh, int qblk, int lane, const bf16_t* __restrict__ P1, const bf16_t* __restrict__ VT, bf16_t* __restrict__ ymix, LAS bf16_t* stg) {
    const int b = bh >> 3, h = bh & 7, l31 = lane & 31, hi = lane >> 5, q0 = qblk * 32, t = q0 + l31;
    const size_t rowb = (size_t)b * SEQ;
    const bf16_t* Qp = P1 + (rowb + q0 + l31) * L1P + h * 64 + 8 * hi;
    bf16x8 qf[4];
#pragma unroll
    for (int kk = 0; kk < 4; ++kk) qf[kk] = *(const bf16x8*)(Qp + 16 * kk);
    const bf16_t* Kp = P1 + (rowb + l31) * L1P + 512 + h * 64 + 8 * hi;
    const bf16_t* Vp = VT + ((size_t)bh * 64 + l31) * SEQ + 4 * hi;
    f32x16 o[2];
#pragma unroll
    for (int r = 0; r < 16; ++r) { o[0][r] = 0.f; o[1][r] = 0.f; }
    float cum = 0.f;
    bf16x8 kf[4]; u32x2 va[2][2][2];
#define SB_LOAD(S0, KF, VA) do { _Pragma("unroll") for (int kk = 0; kk < 4; ++kk) KF[kk] = *(const bf16x8*)(Kp + (size_t)(S0) * L1P + 16 * kk); \
        _Pragma("unroll") for (int dt = 0; dt < 2; ++dt) _Pragma("unroll") for (int ks = 0; ks < 2; ++ks) { VA[dt][ks][0] = *(const u32x2*)(Vp + (size_t)dt * 32 * SEQ + (S0) + 16 * ks); VA[dt][ks][1] = *(const u32x2*)(Vp + (size_t)dt * 32 * SEQ + (S0) + 16 * ks + 8); } } while (0)
    SB_LOAD(q0, kf, va);
    for (int s0 = q0; s0 >= 0; s0 -= 32) {
        bf16x8 kn[4]; u32x2 vn[2][2][2];
        const int sn = (s0 >= 32) ? s0 - 32 : 0;
        SB_LOAD(sn, kn, vn);
        f32x16 acc;
#pragma unroll
        for (int r = 0; r < 16; ++r) acc[r] = 0.f;
#pragma unroll
        for (int kk = 0; kk < 4; ++kk) acc = MFMA32(kf[kk], qf[kk], acc);
        const bool diag = (s0 == q0);
        float lb[16], lk[16];
#pragma unroll
        for (int r = 0; r < 16; ++r) { const float z = acc[r] * 0.125f; const float sp = softplus_fast(z); float b_ = z - sp, k_ = -sp;
            if (diag) { const bool valid = (s0 + crow(r, hi)) < t; b_ = valid ? b_ : -1e30f; k_ = valid ? k_ : 0.f; }
            lb[r] = b_; lk[r] = k_; }
        float e[16], T[4], U[4];
#pragma unroll
        for (int i = 0; i < 4; ++i) { e[4 * i + 3] = 0.f; e[4 * i + 2] = lk[4 * i + 3]; e[4 * i + 1] = e[4 * i + 2] + lk[4 * i + 2]; e[4 * i] = e[4 * i + 1] + lk[4 * i + 1]; T[i] = e[4 * i] + lk[4 * i]; }
#pragma unroll
        for (int i = 0; i < 4; ++i) U[i] = __shfl_xor(T[i], 32);
        float off[4];
        { const float st2 = T[3], st1 = st2 + T[2], st0 = st1 + T[1]; const float su2 = U[3], su1 = su2 + U[2], su0 = su1 + U[1];
          const float x0 = hi ? 0.f : U[0], x1 = hi ? 0.f : U[1], x2 = hi ? 0.f : U[2], x3 = hi ? 0.f : U[3];
          off[3] = x3; off[2] = st2 + su2 + x2; off[1] = st1 + su1 + x1; off[0] = st0 + su0 + x0;
          const float total = st0 + T[0] + su0 + U[0];
#pragma unroll
          for (int r = 0; r < 16; ++r) acc[r] = __expf(lb[r] + (cum + off[r >> 2] + e[r]));
          cum += total; }
        bf16x8 pf[2];
#pragma unroll
        for (int ks = 0; ks < 2; ++ks) { v4u w; w.x = cvtpk(acc[8 * ks], acc[8 * ks + 1]); w.y = cvtpk(acc[8 * ks + 2], acc[8 * ks + 3]); w.z = cvtpk(acc[8 * ks + 4], acc[8 * ks + 5]); w.w = cvtpk(acc[8 * ks + 6], acc[8 * ks + 7]); pf[ks] = __builtin_bit_cast(bf16x8, w); }
#pragma unroll
        for (int dt = 0; dt < 2; ++dt)
#pragma unroll
            for (int ks = 0; ks < 2; ++ks) { v4u a; a.x = va[dt][ks][0].x; a.y = va[dt][ks][0].y; a.z = va[dt][ks][1].x; a.w = va[dt][ks][1].y; o[dt] = MFMA32(__builtin_bit_cast(bf16x8, a), pf[ks], o[dt]); }
        if (__all(cum < -110.f)) break;
#pragma unroll
        for (int kk = 0; kk < 4; ++kk) kf[kk] = kn[kk];
#pragma unroll
        for (int dt = 0; dt < 2; ++dt)
#pragma unroll
            for (int ks = 0; ks < 2; ++ks) { va[dt][ks][0] = vn[dt][ks][0]; va[dt][ks][1] = vn[dt][ks][1]; }
    }
#undef SB_LOAD
    store_OT(o, 1.0f, stg, ymix + (rowb + q0) * DM + h * 64, lane);
}
__device__ __forceinline__ void mla_task(int bh, int qblk, int lane, const bf16_t* __restrict__ QM, const bf16_t* __restrict__ KVM, const bf16_t* __restrict__ KPE, const bf16_t* __restrict__ VT,
                                         bf16_t* __restrict__ ymix, LAS bf16_t* stg) {
    const int b = bh >> 3, h = bh & 7, l31 = lane & 31, hi = lane >> 5, q0 = qblk * 32, t = q0 + l31;
    const size_t rowb = (size_t)b * SEQ;
    const bf16_t* Qp = QM + (rowb + q0 + l31) * 768 + h * 96 + 8 * hi;
    bf16x8 qf[6];
#pragma unroll
    for (int kk = 0; kk < 6; ++kk) qf[kk] = *(const bf16x8*)(Qp + 16 * kk);
    const bf16_t* Kn = KVM + (rowb + l31) * 1024 + h * 128 + 8 * hi;
    const bf16_t* Kr = KPE + (rowb + l31) * 32 + 8 * hi;
    const bf16_t* Vp = VT + ((size_t)bh * 64 + l31) * SEQ + 4 * hi;
    const float sc2 = 0.10206207261596577f * 1.4426950408889634f;
    f32x16 o[2];
#pragma unroll
    for (int r = 0; r < 16; ++r) { o[0][r] = 0.f; o[1][r] = 0.f; }
    float mrun = -1e30f, lsum = 0.f;
    bf16x8 kf[6]; u32x2 va[2][2][2];
#define ML_LOAD(S0, KF, VA) do { _Pragma("unroll") for (int kk = 0; kk < 4; ++kk) KF[kk] = *(const bf16x8*)(Kn + (size_t)(S0) * 1024 + 16 * kk); \
        _Pragma("unroll") for (int kk = 0; kk < 2; ++kk) KF[4 + kk] = *(const bf16x8*)(Kr + (size_t)(S0) * 32 + 16 * kk); \
        _Pragma("unroll") for (int dt = 0; dt < 2; ++dt) _Pragma("unroll") for (int ks = 0; ks < 2; ++ks) { VA[dt][ks][0] = *(const u32x2*)(Vp + (size_t)dt * 32 * SEQ + (S0) + 16 * ks); VA[dt][ks][1] = *(const u32x2*)(Vp + (size_t)dt * 32 * SEQ + (S0) + 16 * ks + 8); } } while (0)
    ML_LOAD(0, kf, va);
    for (int s0 = 0; s0 <= q0; s0 += 32) {
        bf16x8 kn[6]; u32x2 vn[2][2][2];
        const int sn = (s0 + 32 <= q0) ? s0 + 32 : s0;
        ML_LOAD(sn, kn, vn);
        f32x16 acc;
#pragma unroll
        for (int r = 0; r < 16; ++r) acc[r] = 0.f;
#pragma unroll
        for (int kk = 0; kk < 6; ++kk) acc = MFMA32(kf[kk], qf[kk], acc);
        const bool diag = (s0 == q0);
        float tmax = -1e30f;
#pragma unroll
        for (int r = 0; r < 16; ++r) { float z = acc[r] * sc2; if (diag && (s0 + crow(r, hi)) > t) z = -1e30f; acc[r] = z; tmax = fmaxf(tmax, z); }
        tmax = fmaxf(tmax, __shfl_xor(tmax, 32));
        const float mn = fmaxf(mrun, tmax), alpha = exp2f(mrun - mn); mrun = mn;
        float ps = 0.f;
#pragma unroll
        for (int r = 0; r < 16; ++r) { acc[r] = exp2f(acc[r] - mn); ps += acc[r]; }
        lsum = lsum * alpha + ps;
#pragma unroll
        for (int r = 0; r < 16; ++r) { o[0][r] *= alpha; o[1][r] *= alpha; }
        bf16x8 pf[2];
#pragma unroll
        for (int ks = 0; ks < 2; ++ks) { v4u w; w.x = cvtpk(acc[8 * ks], acc[8 * ks + 1]); w.y = cvtpk(acc[8 * ks + 2], acc[8 * ks + 3]); w.z = cvtpk(acc[8 * ks + 4], acc[8 * ks + 5]); w.w = cvtpk(acc[8 * ks + 6], acc[8 * ks + 7]); pf[ks] = __builtin_bit_cast(bf16x8, w); }
#pragma unroll
        for (int dt = 0; dt < 2; ++dt)
#pragma unroll
            for (int ks = 0; ks < 2; ++ks) { v4u a; a.x = va[dt][ks][0].x; a.y = va[dt][ks][0].y; a.z = va[dt][ks][1].x; a.w = va[dt][ks][1].y; o[dt] = MFMA32(__builtin_bit_cast(bf16x8, a), pf[ks], o[dt]); }
#pragma unroll
        for (int kk = 0; kk < 6; ++kk) kf[kk] = kn[kk];
#pragma unroll
        for (int dt = 0; dt < 2; ++dt)
#pragma unroll
            for (int ks = 0; ks < 2; ++ks) { va[dt][ks][0] = vn[dt][ks][0]; va[dt][ks][1] = vn[dt][ks][1]; }
    }
#undef ML_LOAD
    lsum += __shfl_xor(lsum, 32);
    store_OT(o, 1.0f / lsum, stg, ymix + (rowb + q0) * DM + 512 + h * 64, lane);
}


constexpr int MLK_PITCH = 104, MLV_PITCH = 68, MLK_BYTES = 64 * MLK_PITCH * 2, MLV_BYTES = 64 * MLV_PITCH * 2, ML_STAGE = MLK_BYTES + MLV_BYTES;
__device__ __forceinline__ void mla_block(int bh, int sb, int tid, int lane, int wave, LAS unsigned char* lds, const bf16_t* __restrict__ QM, const bf16_t* __restrict__ KVM, const bf16_t* __restrict__ KPE,
                                          const bf16_t* __restrict__ VT, bf16_t* __restrict__ ymix) {
    const int b = bh >> 3, h = bh & 7, l31 = lane & 31, hi = lane >> 5, q0 = 256 * sb + 32 * wave, t = q0 + l31;
    const size_t rowb = (size_t)b * SEQ;
    const int nsteps = 4 * sb + 4;
    bf16x8 qf[6];
    { const bf16_t* Qp = QM + (rowb + q0 + l31) * 768 + h * 96 + 8 * hi;
#pragma unroll
      for (int kk = 0; kk < 6; ++kk) qf[kk] = *(const bf16x8*)(Qp + 16 * kk); }
    const float sc2 = 0.10206207261596577f * 1.4426950408889634f;
    f32x16 o[2];
#pragma unroll
    for (int r = 0; r < 16; ++r) { o[0][r] = 0.f; o[1][r] = 0.f; }
    float mrun = -1e30f, lsum = 0.f;
    const bf16_t* gKn = KVM + (rowb + (tid >> 3)) * 1024 + h * 128 + (tid & 7) * 8;
    const bf16_t* gKr = KPE + (rowb + ((tid & 255) >> 2)) * 32 + (tid & 3) * 8;
    const bf16_t* gVt = VT + ((size_t)bh * 64 + (tid >> 3)) * SEQ + (tid & 7) * 8;
    const int lKn = (tid >> 3) * (MLK_PITCH * 2) + (tid & 7) * 16, lKr = ((tid & 255) >> 2) * (MLK_PITCH * 2) + 128 + (tid & 3) * 16, lVt = MLK_BYTES + (tid >> 3) * (MLV_PITCH * 2) + (tid & 7) * 16;
    v4u rk, rr, rv;
    rk = *(const v4u*)gKn; rr = *(const v4u*)gKr; rv = *(const v4u*)gVt;
    *(LAS v4u*)(lds + lKn) = rk; if (tid < 256) *(LAS v4u*)(lds + lKr) = rr; *(LAS u32x2*)(lds + lVt) = (u32x2){rv.x, rv.y}; *(LAS u32x2*)(lds + lVt + 8) = (u32x2){rv.z, rv.w};
    __syncthreads();
#pragma unroll 1
    for (int step = 0; step < nsteps; ++step) {
        const int nx = (step + 1 < nsteps) ? step + 1 : step;
        rk = *(const v4u*)(gKn + (size_t)nx * 64 * 1024); rr = *(const v4u*)(gKr + (size_t)nx * 64 * 32); rv = *(const v4u*)(gVt + nx * 64);
        const LAS unsigned char* Kb = lds + (step & 1) * ML_STAGE;
        const LAS unsigned char* Vb = Kb + MLK_BYTES;
        if (64 * step <= q0) {
            f32x16 acc[2];
#pragma unroll
            for (int sub = 0; sub < 2; ++sub) {
#pragma unroll
                for (int r = 0; r < 16; ++r) acc[sub][r] = 0.f;
#pragma unroll
                for (int kk = 0; kk < 6; ++kk) { const bf16x8 kf = *(const LAS bf16x8*)(Kb + (32 * sub + l31) * (MLK_PITCH * 2) + (16 * kk + 8 * hi) * 2); acc[sub] = MFMA32(kf, qf[kk], acc[sub]); }
            }
            float tmax = -1e30f;
#pragma unroll
            for (int sub = 0; sub < 2; ++sub) { const int s0 = 64 * step + 32 * sub;
                if (s0 + 31 > q0) {
#pragma unroll
                    for (int r = 0; r < 16; ++r) if ((s0 + crow(r, hi)) > t) acc[sub][r] = -1e30f; }
#pragma unroll
                for (int r = 0; r < 16; ++r) tmax = fmaxf(tmax, acc[sub][r]); }
            tmax = fmaxf(tmax, __shfl_xor(tmax, 32)) * sc2;
            if (__any(tmax - mrun > 6.f)) {
                const float mn = fmaxf(mrun, tmax), alpha = __builtin_amdgcn_exp2f(mrun - mn); mrun = mn; lsum *= alpha;
#pragma unroll
                for (int r = 0; r < 16; ++r) { o[0][r] *= alpha; o[1][r] *= alpha; }
            }
            float ps = 0.f;
#pragma unroll
            for (int sub = 0; sub < 2; ++sub)
#pragma unroll
                for (int r = 0; r < 16; ++r) { acc[sub][r] = __builtin_amdgcn_exp2f(acc[sub][r] * sc2 - mrun); ps += acc[sub][r]; }
            lsum += ps;
#pragma unroll
            for (int sub = 0; sub < 2; ++sub) {
                bf16x8 pf[2];
#pragma unroll
                for (int ks = 0; ks < 2; ++ks) pf[ks] = pack8(acc[sub][8 * ks], acc[sub][8 * ks + 1], acc[sub][8 * ks + 2], acc[sub][8 * ks + 3], acc[sub][8 * ks + 4], acc[sub][8 * ks + 5], acc[sub][8 * ks + 6], acc[sub][8 * ks + 7]);
#pragma unroll
                for (int dt = 0; dt < 2; ++dt)
#pragma unroll
                    for (int ks = 0; ks < 2; ++ks) { const LAS unsigned char* vp = Vb + (32 * dt + l31) * (MLV_PITCH * 2) + (32 * sub + 16 * ks + 4 * hi) * 2;
                        const u32x2 x0 = *(const LAS u32x2*)vp, x1 = *(const LAS u32x2*)(vp + 16);
                        v4u a; a.x = x0.x; a.y = x0.y; a.z = x1.x; a.w = x1.y; o[dt] = MFMA32(__builtin_bit_cast(bf16x8, a), pf[ks], o[dt]); }
            }
        }
        LAS unsigned char* nb = lds + ((step + 1) & 1) * ML_STAGE;
        *(LAS v4u*)(nb + lKn) = rk; if (tid < 256) *(LAS v4u*)(nb + lKr) = rr; *(LAS u32x2*)(nb + lVt) = (u32x2){rv.x, rv.y}; *(LAS u32x2*)(nb + lVt + 8) = (u32x2){rv.z, rv.w};
        __syncthreads();
    }
    lsum += __shfl_xor(lsum, 32);
    store_OT(o, 1.0f / lsum, (LAS bf16_t*)(lds + 2 * ML_STAGE) + wave * (32 * STG_PITCH), ymix + (rowb + q0) * DM + 512 + h * 64, lane);
    __syncthreads();
}


constexpr int SBK_PITCH = 72, SBK_BYTES = 64 * SBK_PITCH * 2, SB_STAGE = SBK_BYTES + MLV_BYTES;
__device__ __forceinline__ void sb_block(int bh, int sb, int tid, int lane, int wave, LAS unsigned char* lds, const bf16_t* __restrict__ P1, const bf16_t* __restrict__ VT, bf16_t* __restrict__ ymix) {
    const int b = bh >> 3, h = bh & 7, l31 = lane & 31, hi = lane >> 5, q0 = 256 * sb + 32 * wave, t = q0 + l31;
    const size_t rowb = (size_t)b * SEQ;
    bf16x8 qf[4];
    { const bf16_t* Qp = P1 + (rowb + q0 + l31) * L1P + h * 64 + 8 * hi;
#pragma unroll
      for (int kk = 0; kk < 4; ++kk) qf[kk] = *(const bf16x8*)(Qp + 16 * kk); }
    f32x16 o[2];
#pragma unroll
    for (int r = 0; r < 16; ++r) { o[0][r] = 0.f; o[1][r] = 0.f; }
    float cum = 1.f; bool done = false;
    volatile LAS unsigned* flags = (volatile LAS unsigned*)(lds + 2 * SB_STAGE);
    const bf16_t* gK = P1 + (rowb + (tid >> 3)) * L1P + 512 + h * 64 + (tid & 7) * 8;
    const bf16_t* gVt = VT + ((size_t)bh * 64 + (tid >> 3)) * SEQ + (tid & 7) * 8;
    const int lK = (tid >> 3) * (SBK_PITCH * 2) + (tid & 7) * 16, lVt = SBK_BYTES + (tid >> 3) * (MLV_PITCH * 2) + (tid & 7) * 16;
    const int top = 4 * sb + 3;
    v4u rk, rv;
    rk = *(const v4u*)(gK + (size_t)top * 64 * L1P); rv = *(const v4u*)(gVt + top * 64);
    *(LAS v4u*)(lds + lK) = rk; *(LAS u32x2*)(lds + lVt) = (u32x2){rv.x, rv.y}; *(LAS u32x2*)(lds + lVt + 8) = (u32x2){rv.z, rv.w};
    __syncthreads();
#pragma unroll 1
    for (int i = 0; i <= top; ++i) {
        const int step = top - i, nx = (step > 0) ? step - 1 : 0;
        rk = *(const v4u*)(gK + (size_t)nx * 64 * L1P); rv = *(const v4u*)(gVt + nx * 64);
        const LAS unsigned char* Kb = lds + (i & 1) * SB_STAGE;
        const LAS unsigned char* Vb = Kb + SBK_BYTES;
#pragma unroll
        for (int sub = 1; sub >= 0; --sub) {
            const int s0 = 64 * step + 32 * sub;
            if (s0 <= q0 && !done) {
                f32x16 acc;
#pragma unroll
                for (int r = 0; r < 16; ++r) acc[r] = 0.f;
#pragma unroll
                for (int kk = 0; kk < 4; ++kk) { const bf16x8 kf = *(const LAS bf16x8*)(Kb + (32 * sub + l31) * (SBK_PITCH * 2) + (16 * kk + 8 * hi) * 2); acc = MFMA32(kf, qf[kk], acc); }
                const bool diag = (s0 == q0);
                float bt[16], kp[16];
#pragma unroll
                for (int r = 0; r < 16; ++r) { const float ee = __builtin_amdgcn_exp2f(fminf(acc[r] * (-0.125f * 1.4426950408889634f), 100.f)); const float ri = __builtin_amdgcn_rcpf(1.f + ee);
                    float b_ = ri, k_ = ee * ri;
                    if (diag) { const bool valid = (s0 + crow(r, hi)) < t; b_ = valid ? b_ : 0.f; k_ = valid ? k_ : 1.f; }
                    bt[r] = b_; kp[r] = k_; }
                float e[16], T[4], U[4];
#pragma unroll
                for (int q = 0; q < 4; ++q) { e[4 * q + 3] = 1.f; e[4 * q + 2] = kp[4 * q + 3]; e[4 * q + 1] = e[4 * q + 2] * kp[4 * q + 2]; e[4 * q] = e[4 * q + 1] * kp[4 * q + 1]; T[q] = e[4 * q] * kp[4 * q]; }
#pragma unroll
                for (int q = 0; q < 4; ++q) U[q] = __shfl_xor(T[q], 32);
                { const float st2 = T[3], st1 = st2 * T[2], st0 = st1 * T[1]; const float su2 = U[3], su1 = su2 * U[2], su0 = su1 * U[1];
                  const float x0 = hi ? 1.f : U[0], x1 = hi ? 1.f : U[1], x2 = hi ? 1.f : U[2], x3 = hi ? 1.f : U[3];
                  const float off[4] = {cum * (st0 * su0 * x0), cum * (st1 * su1 * x1), cum * (st2 * su2 * x2), cum * x3};
#pragma unroll
                  for (int r = 0; r < 16; ++r) acc[r] = bt[r] * (off[r >> 2] * e[r]);
                  cum *= (st0 * T[0]) * (su0 * U[0]); }
                bf16x8 pf[2];
#pragma unroll
                for (int ks = 0; ks < 2; ++ks) { v4u w; w.x = cvtpk(acc[8 * ks], acc[8 * ks + 1]); w.y = cvtpk(acc[8 * ks + 2], acc[8 * ks + 3]); w.z = cvtpk(acc[8 * ks + 4], acc[8 * ks + 5]); w.w = cvtpk(acc[8 * ks + 6], acc[8 * ks + 7]); pf[ks] = __builtin_bit_cast(bf16x8, w); }
#pragma unroll
                for (int dt = 0; dt < 2; ++dt)
#pragma unroll
                    for (int ks = 0; ks < 2; ++ks) { const LAS unsigned char* vp = Vb + (32 * dt + l31) * (MLV_PITCH * 2) + (32 * sub + 16 * ks + 4 * hi) * 2;
                        const u32x2 x0 = *(const LAS u32x2*)vp, x1 = *(const LAS u32x2*)(vp + 16);
                        v4u a; a.x = x0.x; a.y = x0.y; a.z = x1.x; a.w = x1.y; o[dt] = MFMA32(__builtin_bit_cast(bf16x8, a), pf[ks], o[dt]); }
                done = __all(cum < 1e-35f);
            }
        }
        if (lane == 0) flags[(i & 1) * 8 + wave] = done ? 1u : 0u;
        LAS unsigned char* nb = lds + ((i + 1) & 1) * SB_STAGE;
        *(LAS v4u*)(nb + lK) = rk; *(LAS u32x2*)(nb + lVt) = (u32x2){rv.x, rv.y}; *(LAS u32x2*)(nb + lVt + 8) = (u32x2){rv.z, rv.w};
        __syncthreads();
        unsigned nd = 0;
#pragma unroll
        for (int w8 = 0; w8 < 8; ++w8) nd += flags[(i & 1) * 8 + w8];
        if (nd == 8u) break;
    }
    store_OT(o, 1.0f, (LAS bf16_t*)(lds + 2 * SB_STAGE + 256) + wave * (32 * STG_PITCH), ymix + (rowb + q0) * DM + h * 64, lane);
    __syncthreads();
}

constexpr int RW_RAWW = 0, RW_RAWA = 2048, RW_RS = 4096, RW_KS = 6144, RW_VS = 8192;
constexpr int RW_CH0 = 10240, RW_CHSZ = 11328;
constexpr int RW_YB = RW_CH0 + 2 * RW_CHSZ;
constexpr int RW_MIX = RW_YB + 1024;
static_assert((RW_MIX + 256) * 4 <= 146432, "rwkv LDS map");
__device__ __forceinline__ float tanh_fast(float x) { return 1.f - 2.f * __builtin_amdgcn_rcpf(1.f + __expf(2.f * x)); }
__device__ __forceinline__ float sigmoid_fast(float x) { return __builtin_amdgcn_rcpf(1.f + __expf(-x)); }

#define MFMA16(a, b, c) __builtin_amdgcn_mfma_f32_16x16x32_bf16((a), (b), (c), 0, 0, 0)
constexpr int RW2_CH0 = 0, RW2_YB = 2 * RW_CHSZ, RW2_MIX = RW2_YB + 1024, RW2_STG = RW2_MIX + 448;
static_assert((RW2_STG + 2 * 3072) * 4 <= 146432, "rwkv LDS map");
__device__ __forceinline__ void rwkv_phase_scan(LAS float* sm, int tid, int lane, int wave, int blk, const bf16_t* __restrict__ proj, const float* __restrict__ mix, const float* __restrict__ w0, const float* __restrict__ a0,
                                           const float* __restrict__ k_k, const float* __restrict__ k_a, const float* __restrict__ r_k, const bf16_t* __restrict__ W2T, const bf16_t* __restrict__ A2T, const bf16_t* __restrict__ G2T,
                                           float* __restrict__ yraw, bf16_t* __restrict__ gout, float* __restrict__ bonus_out) {
    const int chain = blk >> 1, half = blk & 1, b = chain >> 3, h = chain & 7, l15 = lane & 15, kg = lane >> 4;
    const size_t rowb = (size_t)b * SEQ;
    constexpr int NCHUNK = SEQ / 32;
    if (tid < 256) sm[RW2_MIX + tid] = mix[1536 + tid];
    else if (tid < 448) { const int q = tid - 256; sm[RW2_MIX + tid] = mix[512 * (q >> 6) + h * 64 + (q & 63)]; }
    __syncthreads();
#define RW_SH8(CUR, PRV, M0, M1, OUT, PZ) do { const unsigned cu_[4] = {(CUR).x, (CUR).y, (CUR).z, (CUR).w}, pu_[4] = {(PRV).x, (PRV).y, (PRV).z, (PRV).w}; \
        const float mm_[8] = {(M0)[0], (M0)[1], (M0)[2], (M0)[3], (M1)[0], (M1)[1], (M1)[2], (M1)[3]}; \
        _Pragma("unroll") for (int q = 0; q < 4; ++q) { const float c0 = bflo(cu_[q]), c1 = bfhi(cu_[q]), p0 = bflo(pu_[q]) * (PZ), p1 = bfhi(pu_[q]) * (PZ); \
            OUT[2 * q] = c0 + (p0 - c0) * mm_[2 * q]; OUT[2 * q + 1] = c1 + (p1 - c1) * mm_[2 * q + 1]; } } while (0)
    if (wave < 4) {
        const int iA = 8 * wave + kg, iB = iA + 4, jseg = l15;
        float A0 = 0.f, A1 = 0.f, A2 = 0.f, A3 = 0.f, B0 = 0.f, B1 = 0.f, B2 = 0.f, B3 = 0.f;
        __syncthreads();
#pragma unroll 1
        for (int ch = 0; ch < NCHUNK; ++ch) {
            const int t0 = ch * 32;
            const LAS float* CHb = sm + RW2_CH0 + (ch & 1) * RW_CHSZ + 4 * jseg;
            const LAS float* CHv = sm + RW2_CH0 + (ch & 1) * RW_CHSZ + 10240 + iA;
            const LAS float* CHs = sm + RW2_CH0 + (ch & 1) * RW_CHSZ + 11264;
            f32x4 a4 = *(const LAS f32x4*)(CHb + 4096), wr4 = *(const LAS f32x4*)(CHb + 8192), w4 = *(const LAS f32x4*)(CHb), b4 = *(const LAS f32x4*)(CHb + 6144), k4 = *(const LAS f32x4*)(CHb + 2048);
            float vA = CHv[0], vB = CHv[4]; f32x2_t sc = *(const LAS f32x2_t*)(CHs);
#pragma unroll 2
            for (int t = 0; t < 32; ++t) {
                const int tq = (t + 1) & 31;
                const f32x4 a4n = *(const LAS f32x4*)(CHb + 4096 + tq * 64), wr4n = *(const LAS f32x4*)(CHb + 8192 + tq * 64), w4n = *(const LAS f32x4*)(CHb + tq * 64),
                            b4n = *(const LAS f32x4*)(CHb + 6144 + tq * 64), k4n = *(const LAS f32x4*)(CHb + 2048 + tq * 64);
                const float vAn = CHv[tq * 32], vBn = CHv[tq * 32 + 4]; const f32x2_t scn = *(const LAS f32x2_t*)(CHs + 2 * tq);
                float d1A = (A0 * a4[0] + A1 * a4[1]) + (A2 * a4[2] + A3 * a4[3]), d1B = (B0 * a4[0] + B1 * a4[1]) + (B2 * a4[2] + B3 * a4[3]);
                float d2A = (A0 * wr4[0] + A1 * wr4[1]) + (A2 * wr4[2] + A3 * wr4[3]), d2B = (B0 * wr4[0] + B1 * wr4[1]) + (B2 * wr4[2] + B3 * wr4[3]);
                d1A = rowsum16(d1A); d1B = rowsum16(d1B); d2A = rowsum16(d2A); d2B = rowsum16(d2B);
                const float yA = d2A + d1A * sc[0] + vA * sc[1], yB = d2B + d1B * sc[0] + vB * sc[1];
                A0 = A0 * w4[0] + (d1A * b4[0] + vA * k4[0]); A1 = A1 * w4[1] + (d1A * b4[1] + vA * k4[1]); A2 = A2 * w4[2] + (d1A * b4[2] + vA * k4[2]); A3 = A3 * w4[3] + (d1A * b4[3] + vA * k4[3]);
                B0 = B0 * w4[0] + (d1B * b4[0] + vB * k4[0]); B1 = B1 * w4[1] + (d1B * b4[1] + vB * k4[1]); B2 = B2 * w4[2] + (d1B * b4[2] + vB * k4[2]); B3 = B3 * w4[3] + (d1B * b4[3] + vB * k4[3]);
                if (jseg == 0) { sm[RW2_YB + t * 32 + iA] = yA; sm[RW2_YB + t * 32 + iB] = yB; }
                a4 = a4n; wr4 = wr4n; w4 = w4n; b4 = b4n; k4 = k4n; vA = vAn; vB = vBn; sc = scn;
            }
            WSYNC();
            { const int tt = lane >> 1, hh = lane & 1; const f32x4 yv = *(const LAS f32x4*)(sm + RW2_YB + tt * 32 + 8 * wave + 4 * hh);
              *(f32x4*)(yraw + (rowb + t0 + tt) * 512 + h * 64 + half * 32 + 8 * wave + 4 * hh) = yv; }
            __syncthreads();
        }
    } else if (wave < 6) {
        const int tp = wave - 4, tb = 16 * tp;
        LAS float* stg = sm + RW2_STG + tp * 3072;
        float w0c[4], a0c[4], kkc[4], kac[4], rkc[4];
#pragma unroll
        for (int nt = 0; nt < 4; ++nt) { const int c = h * 64 + 16 * nt + l15; w0c[nt] = w0[c]; a0c[nt] = a0[c]; kkc[nt] = k_k[c]; kac[nt] = k_a[c]; rkc[nt] = r_k[c]; }
        v4u ld[20];
#define PREP_ISSUE(T0) do { const int t0_ = (T0); { const size_t r_ = rowb + t0_ + tb + l15; const size_t rp_ = (t0_ + tb + l15 == 0) ? r_ : r_ - 1; \
            _Pragma("unroll") for (int lo = 0; lo < 2; ++lo) _Pragma("unroll") for (int ks = 0; ks < 2; ++ks) { const int col = 1536 + 64 * lo + 32 * ks + 8 * kg; \
                ld[(lo * 2 + ks) * 2] = *(const v4u*)(proj + r_ * L0P + col); ld[(lo * 2 + ks) * 2 + 1] = *(const v4u*)(proj + rp_ * L0P + col); } } \
            _Pragma("unroll") for (int ar = 0; ar < 3; ++ar) _Pragma("unroll") for (int i = 0; i < 2; ++i) { const int p_ = lane + 64 * i, row_ = p_ >> 3, c8_ = p_ & 7; \
                const size_t r_ = rowb + t0_ + tb + row_; const size_t rp_ = (t0_ + tb + row_ == 0) ? r_ : r_ - 1; const int col = 512 * ar + h * 64 + 8 * c8_; \
                ld[8 + (ar * 2 + i) * 2] = *(const v4u*)(proj + r_ * L0P + col); ld[8 + (ar * 2 + i) * 2 + 1] = *(const v4u*)(proj + rp_ * L0P + col); } } while (0)
#define PREP_BUILD(T0, NB) do { const int t0_ = (T0); LAS float* CHn = sm + RW2_CH0 + (NB) * RW_CHSZ; \
            f32x4 accw[4], acca[4]; \
            _Pragma("unroll") for (int nt = 0; nt < 4; ++nt) { accw[nt] = (f32x4){0.f, 0.f, 0.f, 0.f}; acca[nt] = (f32x4){0.f, 0.f, 0.f, 0.f}; } \
            { const float pz_ = (t0_ + tb + l15 == 0) ? 0.f : 1.f; \
              _Pragma("unroll") for (int lo = 0; lo < 2; ++lo) _Pragma("unroll") for (int ks = 0; ks < 2; ++ks) { float s_[8]; \
                const f32x4 m0 = *(const LAS f32x4*)(sm + RW2_MIX + 64 * lo + 32 * ks + 8 * kg), m1 = *(const LAS f32x4*)(sm + RW2_MIX + 64 * lo + 32 * ks + 8 * kg + 4); \
                RW_SH8(ld[(lo * 2 + ks) * 2], ld[(lo * 2 + ks) * 2 + 1], m0, m1, s_, pz_); \
                if (lo == 0) { _Pragma("unroll") for (int j = 0; j < 8; ++j) s_[j] = tanh_fast(s_[j]); } \
                v4u aw; aw.x = cvtpk(s_[0], s_[1]); aw.y = cvtpk(s_[2], s_[3]); aw.z = cvtpk(s_[4], s_[5]); aw.w = cvtpk(s_[6], s_[7]); const bf16x8 af = __builtin_bit_cast(bf16x8, aw); \
                const bf16_t* WT = lo ? A2T : W2T; \
                _Pragma("unroll") for (int nt = 0; nt < 4; ++nt) { const bf16x8 bfr = *(const bf16x8*)(WT + (size_t)(h * 64 + 16 * nt + l15) * 64 + 32 * ks + 8 * kg); \
                    if (lo == 0) accw[nt] = MFMA16(af, bfr, accw[nt]); else acca[nt] = MFMA16(af, bfr, acca[nt]); } } } \
            _Pragma("unroll") for (int ar = 0; ar < 3; ++ar) _Pragma("unroll") for (int i = 0; i < 2; ++i) { const int p_ = lane + 64 * i, row_ = p_ >> 3, c8_ = p_ & 7; float s_[8]; \
                const float pz_ = (t0_ + tb + row_ == 0) ? 0.f : 1.f; const f32x4 m0 = *(const LAS f32x4*)(sm + RW2_MIX + 256 + ar * 64 + c8_ * 8), m1 = *(const LAS f32x4*)(sm + RW2_MIX + 256 + ar * 64 + c8_ * 8 + 4); \
                RW_SH8(ld[8 + (ar * 2 + i) * 2], ld[8 + (ar * 2 + i) * 2 + 1], m0, m1, s_, pz_); \
                *(LAS f32x4*)(stg + ar * 1024 + row_ * 64 + c8_ * 8) = (f32x4){s_[0], s_[1], s_[2], s_[3]}; *(LAS f32x4*)(stg + ar * 1024 + row_ * 64 + c8_ * 8 + 4) = (f32x4){s_[4], s_[5], s_[6], s_[7]}; } \
            WSYNC(); \
            PREP_ISSUE(((T0) + 32 < SEQ) ? (T0) + 32 : (T0)); \
            _Pragma("unroll") for (int rg = 0; rg < 4; ++rg) { const int tl = 4 * kg + rg, t = tb + tl; \
                float r_[4], k_[4], v_[4], kkv[4], nrm2 = 0.f; \
                _Pragma("unroll") for (int nt = 0; nt < 4; ++nt) { r_[nt] = stg[tl * 64 + 16 * nt + l15]; k_[nt] = stg[1024 + tl * 64 + 16 * nt + l15]; v_[nt] = stg[2048 + tl * 64 + 16 * nt + l15]; \
                    kkv[nt] = k_[nt] * kkc[nt]; nrm2 += kkv[nt] * kkv[nt]; } \
                nrm2 = rowsum16(nrm2); const float rn = __builtin_amdgcn_rsqf(fmaxf(nrm2, 1e-24f)); \
                float br = 0.f, kr = 0.f, bon = 0.f; \
                _Pragma("unroll") for (int nt = 0; nt < 4; ++nt) { const int j = 16 * nt + l15; \
                    const float wsum = w0c[nt] + accw[nt][rg]; const float logw = -softplus_fast(-wsum) - 0.5f; const float dec = __expf(-__expf(logw)); \
                    const float a_ = sigmoid_fast(a0c[nt] + acca[nt][rg]); const float kn = kkv[nt] * rn; \
                    const float k2 = k_[nt] * (1.f + (a_ - 1.f) * kac[nt]); const float bv = kn * a_; \
                    br += bv * r_[nt]; kr += k2 * r_[nt]; bon += r_[nt] * k2 * rkc[nt]; \
                    CHn[t * 64 + j] = dec; CHn[2048 + t * 64 + j] = k2; CHn[4096 + t * 64 + j] = -kn; CHn[6144 + t * 64 + j] = bv; CHn[8192 + t * 64 + j] = dec * r_[nt]; \
                    if ((nt >> 1) == half) CHn[10240 + t * 32 + (j & 31)] = v_[nt]; } \
                br = rowsum16(br); kr = rowsum16(kr); bon = rowsum16(bon); \
                if (l15 == 0) { CHn[11264 + 2 * t] = br; CHn[11264 + 2 * t + 1] = kr; if (half == 0) bonus_out[(rowb + t0_ + t) * 8 + h] = bon; } } \
            WSYNC(); } while (0)
        PREP_ISSUE(0);
        PREP_BUILD(0, 0);
        __syncthreads();
#pragma unroll 1
        for (int ch = 0; ch < NCHUNK; ++ch) {
            if (ch + 1 < NCHUNK) PREP_BUILD(ch * 32 + 32, (ch + 1) & 1);
            __syncthreads();
        }
#undef PREP_ISSUE
#undef PREP_BUILD
    } else {
        const int tp = wave - 6, tb = 16 * tp;
        v4u ld[8];
#define G_ISSUE(T0) do { const int t0_ = (T0); const size_t r_ = rowb + t0_ + tb + l15; const size_t rp_ = (t0_ + tb + l15 == 0) ? r_ : r_ - 1; \
            _Pragma("unroll") for (int ks = 0; ks < 4; ++ks) { const int col = 1664 + 32 * ks + 8 * kg; ld[2 * ks] = *(const v4u*)(proj + r_ * L0P + col); ld[2 * ks + 1] = *(const v4u*)(proj + rp_ * L0P + col); } } while (0)
#define G_BUILD(T0) do { const int t0_ = (T0); f32x4 accg[2] = {(f32x4){0.f, 0.f, 0.f, 0.f}, (f32x4){0.f, 0.f, 0.f, 0.f}}; const float pz_ = (t0_ + tb + l15 == 0) ? 0.f : 1.f; \
            _Pragma("unroll") for (int ks = 0; ks < 4; ++ks) { float s_[8]; \
                const f32x4 m0 = *(const LAS f32x4*)(sm + RW2_MIX + 128 + 32 * ks + 8 * kg), m1 = *(const LAS f32x4*)(sm + RW2_MIX + 128 + 32 * ks + 8 * kg + 4); \
                RW_SH8(ld[2 * ks], ld[2 * ks + 1], m0, m1, s_, pz_); \
                _Pragma("unroll") for (int j = 0; j < 8; ++j) s_[j] = sigmoid_fast(s_[j]); \
                v4u aw; aw.x = cvtpk(s_[0], s_[1]); aw.y = cvtpk(s_[2], s_[3]); aw.z = cvtpk(s_[4], s_[5]); aw.w = cvtpk(s_[6], s_[7]); const bf16x8 af = __builtin_bit_cast(bf16x8, aw); \
                _Pragma("unroll") for (int nt = 0; nt < 2; ++nt) { const bf16x8 bfr = *(const bf16x8*)(G2T + (size_t)(h * 64 + half * 32 + 16 * nt + l15) * 128 + 32 * ks + 8 * kg); accg[nt] = MFMA16(af, bfr, accg[nt]); } } \
            G_ISSUE(((T0) + 32 < SEQ) ? (T0) + 32 : (T0)); \
            _Pragma("unroll") for (int nt = 0; nt < 2; ++nt) _Pragma("unroll") for (int rg = 0; rg < 4; ++rg) \
                gout[(rowb + t0_ + tb + 4 * kg + rg) * 512 + h * 64 + half * 32 + 16 * nt + l15] = (bf16_t)f2bf(accg[nt][rg]); } while (0)
        G_ISSUE(0);
        G_BUILD(0);
        __syncthreads();
#pragma unroll 1
        for (int ch = 0; ch < NCHUNK; ++ch) {
            if (ch + 1 < NCHUNK) G_BUILD(ch * 32 + 32);
            __syncthreads();
        }
#undef G_ISSUE
#undef G_BUILD
    }
#undef RW_SH8
    __syncthreads();
}

constexpr int CK_BK = 0, CK_AR = 4608, CK_BBT = 9216, CK_KBT = 12288, CK_VT = 15360, CK_GC = 16896, CK_TT = 17152, CK_SLOT = 18688, CK_NSLOT = 6, CK_NBUILD = 5;
constexpr int CK_STG = CK_SLOT * CK_NSLOT;
constexpr int CK_MIX = CK_STG + CK_NBUILD * 6144;
constexpr int CK_FLAGS = CK_MIX + 448 * 4;
static_assert(CK_FLAGS + 64 <= 146432, "rwkv chunked LDS map");
__device__ __forceinline__ void rwkv_phase(LAS float* smf, int tid, int lane, int wave, int blk, const bf16_t* __restrict__ proj, const float* __restrict__ mix, const float* __restrict__ w0, const float* __restrict__ a0,
                                           const float* __restrict__ k_k, const float* __restrict__ k_a, const float* __restrict__ r_k, const bf16_t* __restrict__ W2T, const bf16_t* __restrict__ A2T, const bf16_t* __restrict__ G2T,
                                           float* __restrict__ yraw, bf16_t* __restrict__ gout, float* __restrict__ bonus_out) {
    LAS unsigned char* lds = (LAS unsigned char*)smf;
    LAS float* mixs = (LAS float*)(lds + CK_MIX);
    volatile LAS unsigned* flags = (volatile LAS unsigned*)(lds + CK_FLAGS);
    const int chain = blk >> 1, ihalf = blk & 1, b = chain >> 3, h = chain & 7, l15 = lane & 15, kg = lane >> 4, l31 = lane & 31, hi = lane >> 5;
    const size_t rowb = (size_t)b * SEQ;
    constexpr int NCH = SEQ / 16;
    if (tid < 256) mixs[tid] = mix[1536 + tid];
    else if (tid < 448) { const int q = tid - 256; mixs[tid] = mix[512 * (q >> 6) + h * 64 + (q & 63)]; }
    if (tid < 16) flags[tid] = 0u;
    for (int q = tid; q < CK_NSLOT * 384; q += NWAVES * 64) *(LAS unsigned*)(lds + (q / 384) * CK_SLOT + CK_TT + (q % 384) * 4) = 0u;
    __syncthreads();
#define RW_SH8(CUR, PRV, M0, M1, OUT, PZ) do { const unsigned cu_[4] = {(CUR).x, (CUR).y, (CUR).z, (CUR).w}, pu_[4] = {(PRV).x, (PRV).y, (PRV).z, (PRV).w}; \
        const float mm_[8] = {(M0)[0], (M0)[1], (M0)[2], (M0)[3], (M1)[0], (M1)[1], (M1)[2], (M1)[3]}; \
        _Pragma("unroll") for (int q = 0; q < 4; ++q) { const float c0 = bflo(cu_[q]), c1 = bfhi(cu_[q]), p0 = bflo(pu_[q]) * (PZ), p1 = bfhi(pu_[q]) * (PZ); \
            OUT[2 * q] = c0 + (p0 - c0) * mm_[2 * q]; OUT[2 * q + 1] = c1 + (p1 - c1) * mm_[2 * q + 1]; } } while (0)
    if (wave == 0) {
        f32x16 ST[2];
#pragma unroll
        for (int r = 0; r < 16; ++r) { ST[0][r] = 0.f; ST[1][r] = 0.f; }
#pragma unroll 1
        for (int k = 0; k < NCH; ++k) {
#if defined(PROBE_STAMPS)
            const unsigned tw0_ = (unsigned)__builtin_amdgcn_s_memrealtime();
#endif
            { const unsigned want = (unsigned)(k + 1); const int sl = k % CK_NSLOT; while (flags[sl] != want) __builtin_amdgcn_s_sleep(1); }
#if defined(PROBE_STAMPS)
            if (blk == 0 && lane == 0) ((volatile LAS unsigned*)(lds + 146432 + 320))[16 + 24] += (unsigned)__builtin_amdgcn_s_memrealtime() - tw0_;
#endif
            asm volatile("" ::: "memory");
            const LAS unsigned char* im = lds + (k % CK_NSLOT) * CK_SLOT;
            f32x16 G;
#pragma unroll
            for (int r = 0; r < 16; ++r) G[r] = 0.f;
#pragma unroll
            for (int kk = 0; kk < 4; ++kk) { const bf16x8 fa = *(const LAS bf16x8*)(im + CK_BK + l31 * 144 + (16 * kk + 8 * hi) * 2), fb = *(const LAS bf16x8*)(im + CK_AR + l31 * 144 + (16 * kk + 8 * hi) * 2); G = MFMA32(fa, fb, G); }
            { const int tcol = l31 & 15; const bool strict = l31 < 16;
#pragma unroll
              for (int r = 0; r < 16; ++r) { const int srow = crow(r & 7, hi); const bool keep = strict ? (srow < tcol) : (srow <= tcol); G[r] = keep ? G[r] : 0.f; } }
            const bf16x8 gB = pack8(G[0], G[1], G[2], G[3], G[4], G[5], G[6], G[7]), gK = pack8(G[8], G[9], G[10], G[11], G[12], G[13], G[14], G[15]);
            f32x16 XT;
#pragma unroll
            for (int r = 0; r < 16; ++r) XT[r] = 0.f;
#pragma unroll
            for (int jt = 0; jt < 2; ++jt)
#pragma unroll
                for (int sp = 0; sp < 2; ++sp) { const LAS unsigned char* ap = im + CK_AR + l31 * 144 + (32 * jt + 16 * sp + 4 * hi) * 2;
                    const u32x2 x0 = *(const LAS u32x2*)ap, x1 = *(const LAS u32x2*)(ap + 16); v4u aw; aw.x = x0.x; aw.y = x0.y; aw.z = x1.x; aw.w = x1.y;
                    const bf16x8 sb_ = pack8(ST[jt][8 * sp], ST[jt][8 * sp + 1], ST[jt][8 * sp + 2], ST[jt][8 * sp + 3], ST[jt][8 * sp + 4], ST[jt][8 * sp + 5], ST[jt][8 * sp + 6], ST[jt][8 * sp + 7]);
                    XT = MFMA32(__builtin_bit_cast(bf16x8, aw), sb_, XT); }
            bf16x8 vP;
            { const LAS unsigned char* vp = im + CK_VT + l31 * 48 + (4 * hi) * 2; const u32x2 x0 = *(const LAS u32x2*)vp, x1 = *(const LAS u32x2*)(vp + 16); v4u vw; vw.x = x0.x; vw.y = x0.y; vw.z = x1.x; vw.w = x1.y;
              vP = __builtin_bit_cast(bf16x8, vw); XT = MFMA32(gK, vP, XT); }
            bf16x8 uP;
            { const LAS unsigned char* tp = im + CK_TT + l31 * 48 + (4 * hi) * 2; const u32x2 x0 = *(const LAS u32x2*)tp, x1 = *(const LAS u32x2*)(tp + 16); v4u tw; tw.x = x0.x; tw.y = x0.y; tw.z = x1.x; tw.w = x1.y;
              f32x16 UT;
#pragma unroll
              for (int r = 0; r < 16; ++r) UT[r] = 0.f;
              UT = MFMA32(__builtin_bit_cast(bf16x8, tw), pack8(XT[0], XT[1], XT[2], XT[3], XT[4], XT[5], XT[6], XT[7]), UT);
              uP = pack8(UT[0], UT[1], UT[2], UT[3], UT[4], UT[5], UT[6], UT[7]); }
            XT = MFMA32(gB, uP, XT);
            { float* yp = yraw + (rowb + 16 * k) * 512 + h * 64 + 32 * ihalf + l31;
#pragma unroll
              for (int q = 0; q < 8; ++q) yp[(size_t)crow(q, hi) * 512] = XT[8 + q]; }
            { const LAS float* gc = (const LAS float*)(im + CK_GC);
#pragma unroll
              for (int jt = 0; jt < 2; ++jt)
#pragma unroll
                  for (int r = 0; r < 16; ++r) ST[jt][r] *= gc[32 * jt + crow(r, hi)]; }
#pragma unroll
            for (int jt = 0; jt < 2; ++jt) { const LAS unsigned char* bp = im + CK_BBT + (32 * jt + l31) * 48 + (4 * hi) * 2; const LAS unsigned char* kp = im + CK_KBT + (32 * jt + l31) * 48 + (4 * hi) * 2;
                const u32x2 b0 = *(const LAS u32x2*)bp, b1 = *(const LAS u32x2*)(bp + 16), k0 = *(const LAS u32x2*)kp, k1 = *(const LAS u32x2*)(kp + 16);
                v4u a1; a1.x = b0.x; a1.y = b0.y; a1.z = b1.x; a1.w = b1.y; v4u a2; a2.x = k0.x; a2.y = k0.y; a2.z = k1.x; a2.w = k1.y;
                ST[jt] = MFMA32(__builtin_bit_cast(bf16x8, a1), uP, ST[jt]); ST[jt] = MFMA32(__builtin_bit_cast(bf16x8, a2), vP, ST[jt]); }
            WSYNC();
            if (lane == 0) flags[8] = (unsigned)(k + 1);
        }
    } else if (wave <= CK_NBUILD) {
        const int pw = wave - 1;
        LAS bf16_t* stg = (LAS bf16_t*)(lds + CK_STG) + pw * 3072;
        float w0c[4], a0c[4], kkc[4], kac[4], rkc[4];
#pragma unroll
        for (int nt = 0; nt < 4; ++nt) { const int c = h * 64 + 16 * nt + l15; w0c[nt] = w0[c]; a0c[nt] = a0[c]; kkc[nt] = k_k[c]; kac[nt] = k_a[c]; rkc[nt] = r_k[c]; }
        v4u ld[20];
#define CK_ISSUE_A(T0) do { const int t0_ = (T0); const size_t r_ = rowb + t0_ + l15; const size_t rp_ = (t0_ + l15 == 0) ? r_ : r_ - 1; \
            _Pragma("unroll") for (int lo = 0; lo < 2; ++lo) _Pragma("unroll") for (int ks = 0; ks < 2; ++ks) { const int col = 1536 + 64 * lo + 32 * ks + 8 * kg; \
                ld[(lo * 2 + ks) * 2] = *(const v4u*)(proj + r_ * L0P + col); ld[(lo * 2 + ks) * 2 + 1] = *(const v4u*)(proj + rp_ * L0P + col); } } while (0)
#define CK_ISSUE_B(T0) do { const int t0_ = (T0); \
            _Pragma("unroll") for (int ar = 0; ar < 3; ++ar) _Pragma("unroll") for (int i = 0; i < 2; ++i) { const int p_ = lane + 64 * i, row_ = p_ >> 3, c8_ = p_ & 7; \
                const size_t r_ = rowb + t0_ + row_; const size_t rp_ = (t0_ + row_ == 0) ? r_ : r_ - 1; const int col = 512 * ar + h * 64 + 8 * c8_; \
                ld[8 + (ar * 2 + i) * 2] = *(const v4u*)(proj + r_ * L0P + col); ld[8 + (ar * 2 + i) * 2 + 1] = *(const v4u*)(proj + rp_ * L0P + col); } } while (0)
#define CK_ISSUE(T0) do { CK_ISSUE_A(T0); CK_ISSUE_B(T0); } while (0)
        CK_ISSUE(16 * pw);
#pragma unroll 1
        for (int k = pw; k < NCH; k += CK_NBUILD) {
            const int t0 = 16 * k;
#if defined(PROBE_STAMPS)
            const unsigned ts0_ = (unsigned)__builtin_amdgcn_s_memrealtime();
#endif
            f32x4 accw[4], acca[4];
#pragma unroll
            for (int nt = 0; nt < 4; ++nt) { accw[nt] = (f32x4){0.f, 0.f, 0.f, 0.f}; acca[nt] = (f32x4){0.f, 0.f, 0.f, 0.f}; }
            { const float pz_ = (t0 + l15 == 0) ? 0.f : 1.f;
#pragma unroll
              for (int lo = 0; lo < 2; ++lo)
#pragma unroll
                for (int ks = 0; ks < 2; ++ks) { float s_[8];
                    const f32x4 m0 = *(const LAS f32x4*)(mixs + 64 * lo + 32 * ks + 8 * kg), m1 = *(const LAS f32x4*)(mixs + 64 * lo + 32 * ks + 8 * kg + 4);
                    RW_SH8(ld[(lo * 2 + ks) * 2], ld[(lo * 2 + ks) * 2 + 1], m0, m1, s_, pz_);
                    if (lo == 0) {
#pragma unroll
                        for (int j = 0; j < 8; ++j) s_[j] = tanh_fast(s_[j]); }
                    const bf16x8 af = pack8(s_[0], s_[1], s_[2], s_[3], s_[4], s_[5], s_[6], s_[7]);
                    const bf16_t* WT = lo ? A2T : W2T;
#pragma unroll
                    for (int nt = 0; nt < 4; ++nt) { const bf16x8 bfr = *(const bf16x8*)(WT + (size_t)(h * 64 + 16 * nt + l15) * 64 + 32 * ks + 8 * kg);
                        if (lo == 0) accw[nt] = MFMA16(af, bfr, accw[nt]); else acca[nt] = MFMA16(af, bfr, acca[nt]); } } }
#pragma unroll
            for (int ar = 0; ar < 3; ++ar)
#pragma unroll
                for (int i = 0; i < 2; ++i) { const int p_ = lane + 64 * i, row_ = p_ >> 3, c8_ = p_ & 7; float s_[8];
                    const float pz_ = (t0 + row_ == 0) ? 0.f : 1.f; const f32x4 m0 = *(const LAS f32x4*)(mixs + 256 + ar * 64 + c8_ * 8), m1 = *(const LAS f32x4*)(mixs + 256 + ar * 64 + c8_ * 8 + 4);
                    RW_SH8(ld[8 + (ar * 2 + i) * 2], ld[8 + (ar * 2 + i) * 2 + 1], m0, m1, s_, pz_);
                    *(LAS bf16x8*)(stg + ar * 1024 + row_ * 64 + c8_ * 8) = pack8(s_[0], s_[1], s_[2], s_[3], s_[4], s_[5], s_[6], s_[7]); }
            WSYNC();
#if defined(PROBE_STAMPS)
            if (blk == 0 && wave == 1 && lane == 0) ((volatile LAS unsigned*)(lds + 146432 + 320))[16 + 26] += (unsigned)__builtin_amdgcn_s_memrealtime() - ts0_;
#endif
#if defined(PROBE_STAMPS)
            const unsigned tb0_ = (unsigned)__builtin_amdgcn_s_memrealtime();
#endif
            { const int need = k - (CK_NSLOT - 1); if (need > 0) { while ((int)flags[8] < need) __builtin_amdgcn_s_sleep(2); } }
#if defined(PROBE_STAMPS)
            if (blk == 0 && wave == 1 && lane == 0) ((volatile LAS unsigned*)(lds + 146432 + 320))[16 + 25] += (unsigned)__builtin_amdgcn_s_memrealtime() - tb0_;
#endif
            asm volatile("" ::: "memory");
            LAS unsigned char* im = lds + (k % CK_NSLOT) * CK_SLOT;
#if defined(PROBE_STAMPS)
            const unsigned ts1_ = (unsigned)__builtin_amdgcn_s_memrealtime();
#endif
            float lwv[4][4], av[4][4], knv[4][4];
#pragma unroll
            for (int rg = 0; rg < 4; ++rg) { const int tl = 4 * kg + rg;
                float kkv[4], nrm2 = 0.f, vv[4], rr_[4], kr_[4];
#pragma unroll
                for (int nt = 0; nt < 4; ++nt) { rr_[nt] = bf2f(stg[tl * 64 + 16 * nt + l15]); kr_[nt] = bf2f(stg[1024 + tl * 64 + 16 * nt + l15]); vv[nt] = bf2f(stg[2048 + tl * 64 + 16 * nt + l15]);
                    kkv[nt] = kr_[nt] * kkc[nt]; nrm2 += kkv[nt] * kkv[nt]; }
                nrm2 = rowsum16(nrm2); const float rn = __builtin_amdgcn_rsqf(fmaxf(nrm2, 1e-24f));
                float bon = 0.f;
#pragma unroll
                for (int nt = 0; nt < 4; ++nt) {
                    const float wsum = w0c[nt] + accw[nt][rg]; lwv[nt][rg] = -0.6065306597126334f * sigmoid_fast(wsum);
                    const float a_ = sigmoid_fast(a0c[nt] + acca[nt][rg]); av[nt][rg] = a_; knv[nt][rg] = kkv[nt] * rn;
                    const float k2 = kr_[nt] * (1.f + (a_ - 1.f) * kac[nt]); stg[1024 + tl * 64 + 16 * nt + l15] = bf1(k2);
                    bon += rr_[nt] * k2 * rkc[nt];
                    if ((nt >> 1) == ihalf) *(LAS bf16_t*)(im + CK_VT + (16 * (nt & 1) + l15) * 48 + tl * 2) = bf1(vv[nt]);
                }
                bon = rowsum16(bon);
                if (l15 == 0 && ihalf == 0) bonus_out[(rowb + t0 + tl) * 8 + h] = bon;
            }
            CK_ISSUE_A((k + CK_NBUILD < NCH) ? t0 + 16 * CK_NBUILD : t0);
#pragma unroll
            for (int nt = 0; nt < 4; ++nt) {
                float L[4]; L[0] = lwv[nt][0]; L[1] = L[0] + lwv[nt][1]; L[2] = L[1] + lwv[nt][2]; L[3] = L[2] + lwv[nt][3];
                const float T0 = __shfl(L[3], l15), T1 = __shfl(L[3], 16 + l15), T2 = __shfl(L[3], 32 + l15), T3 = __shfl(L[3], 48 + l15);
                const float off = (kg > 0 ? T0 : 0.f) + (kg > 1 ? T1 : 0.f) + (kg > 2 ? T2 : 0.f), LC = (T0 + T1) + (T2 + T3);
                const int j = 16 * nt + l15;
                unsigned bb2[2], kb2[2];
                const float gC = __expf(LC); float eprev = __expf(off);
#pragma unroll
                for (int rg = 0; rg < 4; ++rg) { const int tl = 4 * kg + rg; const float Lt = off + L[rg], e1 = __expf(Lt), e2 = __builtin_amdgcn_rcpf(e1), e3 = eprev, e4 = gC * e2; eprev = e1;
                    const float kn = knv[nt][rg], bvv = kn * av[nt][rg], k2 = bf2f(stg[1024 + tl * 64 + j]), rr2 = bf2f(stg[tl * 64 + j]);
                    *(LAS bf16_t*)(im + CK_BK + tl * 144 + j * 2) = bf1(bvv * e2); *(LAS bf16_t*)(im + CK_BK + (16 + tl) * 144 + j * 2) = bf1(k2 * e2);
                    *(LAS bf16_t*)(im + CK_AR + tl * 144 + j * 2) = bf1(-kn * e3); *(LAS bf16_t*)(im + CK_AR + (16 + tl) * 144 + j * 2) = bf1(rr2 * e1);
                    const unsigned bq = bf1(bvv * e4), kq = bf1(k2 * e4);
                    if (rg & 1) { bb2[rg >> 1] |= bq << 16; kb2[rg >> 1] |= kq << 16; } else { bb2[rg >> 1] = bq; kb2[rg >> 1] = kq; } }
                *(LAS u32x2*)(im + CK_BBT + j * 48 + (4 * kg) * 2) = (u32x2){bb2[0], bb2[1]}; *(LAS u32x2*)(im + CK_KBT + j * 48 + (4 * kg) * 2) = (u32x2){kb2[0], kb2[1]};
                if (kg == 0) *(LAS float*)(im + CK_GC + j * 4) = gC;
            }
            WSYNC();
#if defined(PROBE_STAMPS)
            const unsigned ts2_ = (unsigned)__builtin_amdgcn_s_memrealtime();
            if (blk == 0 && wave == 1 && lane == 0) ((volatile LAS unsigned*)(lds + 146432 + 320))[16 + 27] += ts2_ - ts1_;
#endif
            {
                f32x4 nacc = {0.f, 0.f, 0.f, 0.f};
#pragma unroll
                for (int ks = 0; ks < 2; ++ks) { const bf16x8 fa = *(const LAS bf16x8*)(im + CK_BK + l15 * 144 + (32 * ks + 8 * kg) * 2), fb = *(const LAS bf16x8*)(im + CK_AR + l15 * 144 + (32 * ks + 8 * kg) * 2); nacc = MFMA16(fa, fb, nacc); }
#pragma unroll
                for (int rg = 0; rg < 4; ++rg) nacc[rg] = ((4 * kg + rg) < l15) ? nacc[rg] : 0.f;
                float Tr[16];
#pragma unroll
                for (int t = 0; t < 16; ++t) { float acc_ = (l15 == t) ? 1.f : 0.f;
#pragma unroll
                    for (int s2 = 0; s2 < t; ++s2) acc_ += Tr[s2] * rl(nacc[s2 & 3], t + 16 * (s2 >> 2));
                    Tr[t] = acc_; }
                if (kg == 0) {
#pragma unroll
                    for (int t = 0; t < 16; ++t) *(LAS bf16_t*)(im + CK_TT + t * 48 + l15 * 2) = bf1(Tr[t]); }
            }
            WSYNC();
#if defined(PROBE_STAMPS)
            if (blk == 0 && wave == 1 && lane == 0) ((volatile LAS unsigned*)(lds + 146432 + 320))[16 + 28] += (unsigned)__builtin_amdgcn_s_memrealtime() - ts2_;
#endif
            if (lane == 0) flags[k % CK_NSLOT] = (unsigned)(k + 1);
            CK_ISSUE_B((k + CK_NBUILD < NCH) ? t0 + 16 * CK_NBUILD : t0);
        }
#undef CK_ISSUE
#undef CK_ISSUE_A
#undef CK_ISSUE_B
    } else {
        const int gq = wave - 6;
        v4u ld[8];
#define G_ISSUE(T0) do { const int t0_ = (T0); const size_t r_ = rowb + t0_ + l15; const size_t rp_ = (t0_ + l15 == 0) ? r_ : r_ - 1; \
            _Pragma("unroll") for (int ks = 0; ks < 4; ++ks) { const int col = 1664 + 32 * ks + 8 * kg; ld[2 * ks] = *(const v4u*)(proj + r_ * L0P + col); ld[2 * ks + 1] = *(const v4u*)(proj + rp_ * L0P + col); } } while (0)
        G_ISSUE(16 * gq);
#pragma unroll 1
        for (int k = gq; k < NCH; k += 2) {
            const int t0 = 16 * k;
            f32x4 accg[2] = {(f32x4){0.f, 0.f, 0.f, 0.f}, (f32x4){0.f, 0.f, 0.f, 0.f}}; const float pz_ = (t0 + l15 == 0) ? 0.f : 1.f;
#pragma unroll
            for (int ks = 0; ks < 4; ++ks) { float s_[8];
                const f32x4 m0 = *(const LAS f32x4*)(mixs + 128 + 32 * ks + 8 * kg), m1 = *(const LAS f32x4*)(mixs + 128 + 32 * ks + 8 * kg + 4);
                RW_SH8(ld[2 * ks], ld[2 * ks + 1], m0, m1, s_, pz_);
#pragma unroll
                for (int j = 0; j < 8; ++j) s_[j] = sigmoid_fast(s_[j]);
                const bf16x8 af = pack8(s_[0], s_[1], s_[2], s_[3], s_[4], s_[5], s_[6], s_[7]);
#pragma unroll
                for (int nt = 0; nt < 2; ++nt) { const bf16x8 bfr = *(const bf16x8*)(G2T + (size_t)(h * 64 + ihalf * 32 + 16 * nt + l15) * 128 + 32 * ks + 8 * kg); accg[nt] = MFMA16(af, bfr, accg[nt]); } }
            G_ISSUE((k + 2 < NCH) ? t0 + 32 : t0);
#pragma unroll
            for (int nt = 0; nt < 2; ++nt)
#pragma unroll
                for (int rg = 0; rg < 4; ++rg) gout[(rowb + t0 + 4 * kg + rg) * 512 + h * 64 + ihalf * 32 + 16 * nt + l15] = bf1(accg[nt][rg]);
        }
#undef G_ISSUE
    }
#undef RW_SH8
    __syncthreads();
}

template <bool ST = true> __device__ __forceinline__ void rwkv_post_all(const float* __restrict__ yraw, const bf16_t* __restrict__ proj, const float* __restrict__ mix, const float* __restrict__ bonus, const bf16_t* __restrict__ gbuf,
                                              const float* __restrict__ ln_g, const float* __restrict__ ln_b, bf16_t* __restrict__ ymix, int gw, int NGW, int lane) {
    for (int m = gw; m < M; m += NGW) {
        const bool has_prev = (m & (SEQ - 1)) != 0;
        float y[8], cv[8], pv[8], gg[8], bo[8];
#pragma unroll
        for (int h = 0; h < 8; ++h) { const int c = h * 64 + lane; y[h] = yraw[(size_t)m * 512 + c]; cv[h] = bf2f(proj[(size_t)m * L0P + 1024 + c]);
            pv[h] = bf2f(proj[(size_t)(has_prev ? m - 1 : m) * L0P + 1024 + c]); gg[h] = bf2f(gbuf[(size_t)m * 512 + c]); bo[h] = bonus[(size_t)m * 8 + h]; }
#pragma unroll
        for (int h = 0; h < 8; ++h) { const int c = h * 64 + lane;
            const float mu = wave_sum_dpp(y[h]) * (1.f / 64.f), d = y[h] - mu, var = wave_sum_dpp(d * d) * (1.f / 64.f);
            const float yn = d * __builtin_amdgcn_rsqf(var + 64e-5f) * ln_g[c] + ln_b[c];
            const float pvv = has_prev ? pv[h] : 0.f;
            const float v_s = cv[h] + (pvv - cv[h]) * mix[1024 + c];
            const float o = (yn + bo[h] * v_s) * gg[h];
            if (ST) ymix[(size_t)m * DM + c] = bf1(o); else asm volatile("" :: "v"(o)); }
    }
}


__device__ __forceinline__ void ssd_conv_tile(int it, int lane, LAS bf16_t* scr, const bf16_t* __restrict__ proj, const float* __restrict__ cw, const float* __restrict__ cb,
                                              bf16_t* __restrict__ xbc, bf16_t* __restrict__ xst, bf16_t* __restrict__ bt) {
    const int tt = it >> 4, ct = it & 15, m0 = tt * 64, b = m0 >> 11, t0 = m0 & (SEQ - 1), c = ct * 64 + lane;
    const float w0 = cw[c], w1 = cw[1024 + c], w2 = cw[2048 + c], w3 = cw[3072 + c], bias = cb[c];
    const bf16_t* src = proj + (size_t)m0 * L0P + 2304 + c;
    bf16_t raw[67];
    const int lo = (t0 > 0) ? -3 : 0;
#pragma unroll
    for (int t = -3; t < 64; ++t) raw[t + 3] = src[(ptrdiff_t)((t < lo) ? lo : t) * L0P];
    float u3 = (t0 > 0) ? bf2f(raw[0]) : 0.f, u2 = (t0 > 0) ? bf2f(raw[1]) : 0.f, u1 = (t0 > 0) ? bf2f(raw[2]) : 0.f;
#pragma unroll
    for (int t = 0; t < 64; ++t) {
        const float u = bf2f(raw[t + 3]);
        const float y = bias + w0 * u3 + w1 * u2 + w2 * u1 + w3 * u;
        const bf16_t o = bf1(y * __builtin_amdgcn_rcpf(1.f + __expf(-y)));
        xbc[(size_t)(m0 + t) * 1024 + c] = o;
        scr[t * STG_PITCH + lane] = o;
        u3 = u2; u2 = u1; u1 = u;
    }
    WSYNC();
    if (ct < 12) {
        bf16_t* dst = (ct < 8) ? xst + ((size_t)(b * 8 + ct) * 64) * SEQ + t0 : bt + ((size_t)(b * 2 + ((ct - 8) >> 1)) * 128 + ((ct - 8) & 1) * 64) * SEQ + t0;
#pragma unroll
        for (int i = 0; i < 8; ++i) { const int d = i * 8 + (lane >> 3), tc = lane & 7; const LAS bf16_t* p = scr + (tc * 8) * STG_PITCH + d;
            v4u o; o.x = (unsigned)p[0] | ((unsigned)p[STG_PITCH] << 16); o.y = (unsigned)p[2 * STG_PITCH] | ((unsigned)p[3 * STG_PITCH] << 16);
            o.z = (unsigned)p[4 * STG_PITCH] | ((unsigned)p[5 * STG_PITCH] << 16); o.w = (unsigned)p[6 * STG_PITCH] | ((unsigned)p[7 * STG_PITCH] << 16);
            *(v4u*)(dst + (size_t)d * SEQ + tc * 8) = o; }
    }
    WSYNC();
}
__device__ __forceinline__ float bperm(int srclane, float x) { return __builtin_bit_cast(float, __builtin_amdgcn_ds_bpermute(srclane << 2, __builtin_bit_cast(int, x))); }
__device__ __forceinline__ void scan128(float& x0, float& x1, int lane) {
#pragma unroll
    for (int o = 1; o < 64; o <<= 1) { const int sl = (lane >= o) ? lane - o : lane; const float t0 = bperm(sl, x0), t1 = bperm(sl, x1); if (lane >= o) { x0 += t0; x1 += t1; } }
    x1 += rl(x0, 63);
}
__device__ __forceinline__ void ssd_s1_unit(int unit, int lane, LAS float* tab, const bf16_t* __restrict__ xst, const bf16_t* __restrict__ bt, const float* __restrict__ dt, const float* __restrict__ a_log,
                                            float* __restrict__ sloc, float* __restrict__ asum) {
    const int h = unit & 7, c = (unit >> 3) & 15, b = unit >> 7, g = h >> 2, l0 = c * 128, l31 = lane & 31, hi = lane >> 5;
    const size_t m0 = (size_t)b * SEQ + l0;
    const float A = -expf(a_log[h]);
    const float d0 = dt[(m0 + lane) * 8 + h], d1 = dt[(m0 + 64 + lane) * 8 + h];
    float ac0 = d0 * A, ac1 = d1 * A;
    scan128(ac0, ac1, lane);
    const float aend = rl(ac1, 63);
    tab[lane] = __expf(aend - ac0) * d0; tab[64 + lane] = __expf(aend - ac1) * d1;
    if (lane == 0) asum[unit] = aend;
    WSYNC();
    f32x16 acc[2][4];
#pragma unroll
    for (int pt = 0; pt < 2; ++pt)
#pragma unroll
        for (int nt = 0; nt < 4; ++nt)
#pragma unroll
            for (int r = 0; r < 16; ++r) acc[pt][nt][r] = 0.f;
    const bf16_t* Xp = xst + ((size_t)(b * 8 + h) * 64 + l31) * SEQ + l0 + 8 * hi;
    const bf16_t* Bp = bt + ((size_t)(b * 2 + g) * 128 + l31) * SEQ + l0 + 8 * hi;
#pragma unroll 2
    for (int kk = 0; kk < 8; ++kk) {
        const f32x4 wa = *(const LAS f32x4*)(tab + 16 * kk + 8 * hi), wb = *(const LAS f32x4*)(tab + 16 * kk + 8 * hi + 4);
        bf16x8 af[2], bfr[4];
#pragma unroll
        for (int pt = 0; pt < 2; ++pt) { const v4u raw = *(const v4u*)(Xp + (size_t)pt * 32 * SEQ + 16 * kk);
            v4u w; w.x = cvtpk(bflo(raw.x) * wa[0], bfhi(raw.x) * wa[1]); w.y = cvtpk(bflo(raw.y) * wa[2], bfhi(raw.y) * wa[3]);
            w.z = cvtpk(bflo(raw.z) * wb[0], bfhi(raw.z) * wb[1]); w.w = cvtpk(bflo(raw.w) * wb[2], bfhi(raw.w) * wb[3]); af[pt] = __builtin_bit_cast(bf16x8, w); }
#pragma unroll
        for (int nt = 0; nt < 4; ++nt) bfr[nt] = *(const bf16x8*)(Bp + (size_t)nt * 32 * SEQ + 16 * kk);
#pragma unroll
        for (int pt = 0; pt < 2; ++pt)
#pragma unroll
            for (int nt = 0; nt < 4; ++nt) acc[pt][nt] = MFMA32(af[pt], bfr[nt], acc[pt][nt]);
    }
    float* dst = sloc + (size_t)unit * 8192 + l31;
#pragma unroll
    for (int pt = 0; pt < 2; ++pt)
#pragma unroll
        for (int nt = 0; nt < 4; ++nt)
#pragma unroll
            for (int r = 0; r < 16; ++r) dst[(32 * pt + crow(r, hi)) * 128 + 32 * nt] = acc[pt][nt][r];
    WSYNC();
}
__device__ __forceinline__ void ssd_s2_all(const float* __restrict__ sloc, const float* __restrict__ asum, bf16_t* __restrict__ stb, int gtid, int NT) {
    for (int i = gtid; i < 128 * 2048; i += NT) {
        const int bh = i >> 11, e4 = i & 2047, b = bh >> 3, h = bh & 7;
        f32x4 run = {0.f, 0.f, 0.f, 0.f};
#pragma unroll 4
        for (int c = 0; c < 16; ++c) { const int unit = (b * 16 + c) * 8 + h; const f32x4 tmp = *(const f32x4*)(sloc + (size_t)unit * 8192 + e4 * 4);
            uint2 w; w.x = cvtpk(run[0], run[1]); w.y = cvtpk(run[2], run[3]); *(uint2*)(stb + (size_t)unit * 8192 + e4 * 4) = w;
            run = run * __expf(asum[unit]) + tmp; }
    }
}
__device__ __forceinline__ void ssd_s3_unit(int unit, int lane, LAS float* tab, const bf16_t* __restrict__ xbc, const bf16_t* __restrict__ xst, const bf16_t* __restrict__ stb, const float* __restrict__ dt,
                                            const float* __restrict__ a_log, const float* __restrict__ dsk, bf16_t* __restrict__ yssm) {
    const int h = unit & 7, c = (unit >> 3) & 15, b = unit >> 7, g = h >> 2, l0 = c * 128, l31 = lane & 31, hi = lane >> 5;
    const size_t m0 = (size_t)b * SEQ + l0;
    const float A = -expf(a_log[h]), D = dsk[h];
    const float d0 = dt[(m0 + lane) * 8 + h], d1 = dt[(m0 + 64 + lane) * 8 + h];
    float ac0 = d0 * A, ac1 = d1 * A;
    scan128(ac0, ac1, lane);
    tab[lane] = ac0; tab[64 + lane] = ac1; tab[128 + lane] = d0; tab[192 + lane] = d1;
    WSYNC();
    const bf16_t* Cp = xbc + (m0 + l31) * 1024 + 768 + g * 128 + 8 * hi;
    const bf16_t* Sp = stb + (size_t)unit * 8192 + l31 * 128 + 8 * hi;
    const bf16_t* Bp = xbc + (m0 + l31) * 1024 + 512 + g * 128 + 8 * hi;
    const bf16_t* Xp = xst + ((size_t)(b * 8 + h) * 64 + l31) * SEQ + l0 + 4 * hi;
    LAS float* tr = tab + 256;
    const int row = lane >> 1, p0 = (lane & 1) * 16;
#pragma unroll 1
    for (int lt = 0; lt < 4; ++lt) {
        f32x16 y[2];
#pragma unroll
        for (int r = 0; r < 16; ++r) { y[0][r] = 0.f; y[1][r] = 0.f; }
        const float acl = tab[32 * lt + l31];
        bf16x8 cfr[8];
#pragma unroll
        for (int kk = 0; kk < 8; ++kk) cfr[kk] = *(const bf16x8*)(Cp + (size_t)lt * 32 * 1024 + 16 * kk);
        {   bf16x8 s0[8], s1[8];
#pragma unroll
            for (int kk = 0; kk < 8; ++kk) { s0[kk] = *(const bf16x8*)(Sp + 16 * kk); s1[kk] = *(const bf16x8*)(Sp + 32 * 128 + 16 * kk); }
#pragma unroll
            for (int kk = 0; kk < 8; ++kk) { y[0] = MFMA32(s0[kk], cfr[kk], y[0]); y[1] = MFMA32(s1[kk], cfr[kk], y[1]); }
        }
        { const float el = __expf(acl);
#pragma unroll
          for (int r = 0; r < 16; ++r) { y[0][r] *= el; y[1][r] *= el; } }
#pragma unroll 1
        for (int st = 0; st <= lt; ++st) {
            bf16x8 bfr[8]; u32x2 xf[2][2][2];
#pragma unroll
            for (int kk = 0; kk < 8; ++kk) bfr[kk] = *(const bf16x8*)(Bp + (size_t)st * 32 * 1024 + 16 * kk);
#pragma unroll
            for (int pt = 0; pt < 2; ++pt)
#pragma unroll
                for (int ks = 0; ks < 2; ++ks) { const bf16_t* xp = Xp + (size_t)pt * 32 * SEQ + st * 32 + 16 * ks; xf[pt][ks][0] = *(const u32x2*)xp; xf[pt][ks][1] = *(const u32x2*)(xp + 8); }
            f32x16 cbt;
#pragma unroll
            for (int r = 0; r < 16; ++r) cbt[r] = 0.f;
#pragma unroll
            for (int kk = 0; kk < 8; ++kk) cbt = MFMA32(bfr[kk], cfr[kk], cbt);
#pragma unroll
            for (int r = 0; r < 16; ++r) { const int sl = 32 * st + crow(r, hi); const float acs = tab[sl], dts = tab[128 + sl];
                float v = cbt[r] * __expf(acl - acs) * dts; if (st == lt && crow(r, hi) > l31) v = 0.f; cbt[r] = v; }
            bf16x8 pf[2];
#pragma unroll
            for (int ks = 0; ks < 2; ++ks) pf[ks] = pack8(cbt[8 * ks], cbt[8 * ks + 1], cbt[8 * ks + 2], cbt[8 * ks + 3], cbt[8 * ks + 4], cbt[8 * ks + 5], cbt[8 * ks + 6], cbt[8 * ks + 7]);
#pragma unroll
            for (int pt = 0; pt < 2; ++pt)
#pragma unroll
                for (int ks = 0; ks < 2; ++ks) { v4u a; a.x = xf[pt][ks][0].x; a.y = xf[pt][ks][0].y; a.z = xf[pt][ks][1].x; a.w = xf[pt][ks][1].y; y[pt] = MFMA32(__builtin_bit_cast(bf16x8, a), pf[ks], y[pt]); }
        }
#pragma unroll
        for (int pt = 0; pt < 2; ++pt) {
#pragma unroll
            for (int r = 0; r < 16; ++r) tr[l31 * 33 + crow(r, hi)] = y[pt][r];
            WSYNC();
            const size_t m = m0 + 32 * lt + row;
            const v4u xa = *(const v4u*)(xbc + m * 1024 + h * 64 + 32 * pt + p0), xb = *(const v4u*)(xbc + m * 1024 + h * 64 + 32 * pt + p0 + 8);
            const unsigned xu[8] = {xa.x, xa.y, xa.z, xa.w, xb.x, xb.y, xb.z, xb.w};
            unsigned ow[8];
#pragma unroll
            for (int q = 0; q < 8; ++q) { const float v0 = tr[row * 33 + p0 + 2 * q] + D * bflo(xu[q]), v1 = tr[row * 33 + p0 + 2 * q + 1] + D * bfhi(xu[q]); ow[q] = cvtpk(v0, v1); }
            bf16_t* dst = yssm + m * 512 + h * 64 + 32 * pt + p0;
            *(v4u*)dst = (v4u){ow[0], ow[1], ow[2], ow[3]}; *(v4u*)(dst + 8) = (v4u){ow[4], ow[5], ow[6], ow[7]};
            WSYNC();
        }
    }
}

struct Args { const float* in[43]; float* out; unsigned char* ws; };
#define GEMM_PHASE(EPI, Aptr, LDA, Bptr, LDB, NN, KK, ...) do { pg8::Gemm g_{(Aptr), (Bptr), M, (NN), (KK), (LDA), (LDB)}; pg8::StaticOrder S_; S_.init(M, (NN), G, (int)blockIdx.x); \
        pg8::EPI E_{__VA_ARGS__}; pg8::gemm_phase<pg8::EPI, pg8::StaticOrder, true, true>(lds3, g_, S_, E_); } while (0)

__global__ void __launch_bounds__(NWAVES * 64, 2) fwd_mega(Args args) {
    extern __shared__ __attribute__((aligned(16))) unsigned char lds[];
    LAS unsigned char* lds3 = (LAS unsigned char*)lds;
    volatile LAS unsigned* MISC = (volatile LAS unsigned*)(lds3 + MISC_OFF);
    const int G = gridDim.x, NGW = G * NWAVES, NT = G * NWAVES * 64;
#define PHASE_IDS() int tid = threadIdx.x; asm volatile("" : "+v"(tid)); const int lane = tid & 63, wave = __builtin_amdgcn_readfirstlane(tid >> 6); const int gw = blockIdx.x * NWAVES + wave, gtid = blockIdx.x * (NWAVES * 64) + tid; (void)lane; (void)gw; (void)gtid
    unsigned char* ws = args.ws;
    gu32* ctl = (gu32*)(ws + WS_CTL);
    for (int u = threadIdx.x; u < (LDS_BYTES - LDSCTL_OFF) / 4; u += NWAVES * 64) ((LAS unsigned*)(lds3 + LDSCTL_OFF))[u] = 0u;
    __syncthreads();
    XcdBarrier bar = xcd_barrier_post((unsigned*)(ctl + CW_BAR), MISC + 8);
#if defined(PROBE_STAMPS)
    int nb_ = 0;
    if (blockIdx.x == 0 && threadIdx.x == 0) MISC[16] = (unsigned)__builtin_amdgcn_s_memrealtime();
#define GRID_BAR() do { xcd_barrier(bar); ++nb_; if (blockIdx.x == 0 && threadIdx.x == 0) MISC[16 + nb_] = (unsigned)__builtin_amdgcn_s_memrealtime(); } while (0)
#else
#define GRID_BAR() xcd_barrier(bar)
#endif
#define IN(i) (args.in[i])
    float* out = args.out;
    bf16_t* W0in = (bf16_t*)(ws + WS_W0IN); bf16_t* W0out = (bf16_t*)(ws + WS_W0OUT); bf16_t* Wup0 = (bf16_t*)(ws + WS_WUP0); bf16_t* Wdn0 = (bf16_t*)(ws + WS_WDN0);
    bf16_t* W1in = (bf16_t*)(ws + WS_W1IN); bf16_t* Wuq = (bf16_t*)(ws + WS_WUQ); bf16_t* Wukv = (bf16_t*)(ws + WS_WUKV); bf16_t* W1out = (bf16_t*)(ws + WS_W1OUT);
    bf16_t* Wup1 = (bf16_t*)(ws + WS_WUP1); bf16_t* Wdn1 = (bf16_t*)(ws + WS_WDN1);
    bf16_t* XB = (bf16_t*)(ws + WS_XB); bf16_t* YMIX = (bf16_t*)(ws + WS_YMIX); bf16_t* PROJ0 = (bf16_t*)(ws + WS_BIG);
    float* YRAW = out; bf16_t* YSSM = (bf16_t*)(out + (size_t)M * 512); bf16_t* STB = (bf16_t*)(out + (size_t)M * 768); bf16_t* XST = (bf16_t*)(ws + WS_XST); bf16_t* BT = (bf16_t*)(ws + WS_BT); float* ASUM = (float*)(ws + WS_ASUM); float* SLOC = (float*)(ws + WS_SLOC); float* DT = (float*)(ws + WS_DT); bf16_t* GB = (bf16_t*)(ws + WS_G); float* BONUS = (float*)(ws + WS_BONUS);
    bf16_t* W2T = (bf16_t*)(ws + WS_W2T); bf16_t* A2T = (bf16_t*)(ws + WS_A2T); bf16_t* G2T = (bf16_t*)(ws + WS_G2T); bf16_t* ACT = (bf16_t*)(ws + WS_GU); bf16_t* HALO = (bf16_t*)(ws + WS_GU + 176 * MiB);
    bf16_t* PROJ1 = (bf16_t*)(ws + WS_PROJ1); bf16_t* QM = (bf16_t*)(ws + WS_QM); bf16_t* KVM = (bf16_t*)(ws + WS_KVM); bf16_t* KPE = (bf16_t*)(ws + WS_KPE); float* RS = (float*)(ws + WS_RS); float* CSTAB = (float*)(ws + WS_CSTAB); float* STATS = (float*)(ws + WS_CSTAB + 4 * MiB); bf16_t* VTS = (bf16_t*)(ws + WS_VTS); bf16_t* VTM = (bf16_t*)(ws + WS_VTM);
    const int* pos = (const int*)args.in[1];

    {
        PHASE_IDS();
    {
        LAS float* scr = (LAS float*)(lds3 + wave * 16384); int trb = 0;
        transpose_matrix(IN(2), 1024, 3336, W0in, L0P, 1024, scr, gw, NGW, lane, nullptr, trb);
        transpose_matrix(IN(20), 1024, 1024, W0out, 1024, 1024, scr, gw, NGW, lane, nullptr, trb);
        transpose_matrix(IN(23), 1024, 5632, Wup0, 5632, 1024, scr, gw, NGW, lane, nullptr, trb, true);
        transpose_matrix(IN(26), 2816, 1024, Wdn0, 1024, 2816, scr, gw, NGW, lane, nullptr, trb);
        transpose_matrix(IN(29), 1024, 1952, W1in, L1P, 1024, scr, gw, NGW, lane, nullptr, trb);
        transpose_matrix(IN(31), 256, 768, Wuq, 768, 256, scr, gw, NGW, lane, IN(30), trb);
        transpose_matrix(IN(33), 128, 1024, Wukv, 1024, 256, scr, gw, NGW, lane, IN(32), trb);
        for (int i = gtid; i < 1024 * 16; i += NT) { const int n = i >> 4, c = i & 15; *(v4u*)(Wukv + (size_t)n * 256 + 128 + c * 8) = (v4u){0u, 0u, 0u, 0u}; }
        transpose_matrix(IN(34), 1024, 1024, W1out, 1024, 1024, scr, gw, NGW, lane, nullptr, trb);
        transpose_matrix(IN(37), 1024, 5632, Wup1, 5632, 1024, scr, gw, NGW, lane, nullptr, trb, true);
        transpose_matrix(IN(40), 2816, 1024, Wdn1, 1024, 2816, scr, gw, NGW, lane, nullptr, trb);
        transpose_matrix(IN(5), 64, 512, W2T, 512, 64, scr, gw, NGW, lane, nullptr, trb);
        transpose_matrix(IN(7), 64, 512, A2T, 512, 64, scr, gw, NGW, lane, nullptr, trb);
        transpose_matrix(IN(8), 128, 512, G2T, 512, 128, scr, gw, NGW, lane, nullptr, trb);
        const float* x = IN(0);
        {
            constexpr size_t TOT4 = (size_t)M * DM / 4;
            for (size_t i = gtid; i < TOT4; i += (size_t)NT * 8) {
                f32x4 v[8];
#pragma unroll
                for (int u = 0; u < 8; ++u) v[u] = *(const f32x4*)(x + (i + (size_t)u * NT) * 4);
#pragma unroll
                for (int u = 0; u < 8; ++u) { uint2 w; w.x = cvtpk(v[u][0], v[u][1]); w.y = cvtpk(v[u][2], v[u][3]); *(uint2*)(XB + (i + (size_t)u * NT) * 4) = w; }
            }
        }
    }
    }
    GRID_BAR();
    {
        PHASE_IDS();
    GEMM_PHASE(EpiBf16S, XB, DM, W0in, 1024, L0P, 1024, PROJ0, nullptr, L0P, 0);
    }
    GRID_BAR();
    {
        PHASE_IDS();
        const int blk = (int)blockIdx.x, m0 = blk * 128;
        {   LAS bf16_t* scr = (LAS bf16_t*)(lds3 + wave * 16384);
#pragma unroll 1
            for (int k = 0; k < 4; ++k) ssd_conv_tile((2 * blk + (k & 1)) * 16 + wave + 8 * (k >> 1), lane, scr, PROJ0, IN(14), IN(15), XB, XST, BT);
            for (int i = tid; i < 1024; i += NWAVES * 64) { const int m = m0 + (i >> 3); DT[(size_t)m * 8 + (i & 7)] = softplusf_(bf2f(PROJ0[(size_t)m * L0P + 3328 + (i & 7)]) + IN(16)[i & 7]); }
        }
        __syncthreads();
#if defined(PROBE_STAMPS)
        if (blockIdx.x == 0 && threadIdx.x == 0) MISC[16 + 29] = (unsigned)__builtin_amdgcn_s_memrealtime();
#endif
        ssd_s1_unit(blk * 8 + wave, lane, (LAS float*)(lds3 + wave * 16384), XST, BT, DT, IN(17), SLOC, ASUM);
    }
    GRID_BAR();
    {
        PHASE_IDS();
        ssd_s2_all(SLOC, ASUM, STB, gtid, NT);
#if defined(PROBE_STAMPS)
        __syncthreads(); if (blockIdx.x == 0 && threadIdx.x == 0) MISC[16 + 23] = (unsigned)__builtin_amdgcn_s_memrealtime();
#endif
        rwkv_phase((LAS float*)lds3, tid, lane, wave, (int)blockIdx.x, PROJ0, IN(3), IN(4), IN(6), IN(9), IN(10), IN(11), W2T, A2T, G2T, YRAW, GB, BONUS);
    }
    GRID_BAR();
    {
        PHASE_IDS();
        const int blk = (int)blockIdx.x;
        ssd_s3_unit(blk * 8 + wave, lane, (LAS float*)(lds3 + wave * 16384), XB, XST, STB, DT, IN(17), IN(18), YSSM);
        __syncthreads();
        ssm_gate_norm_all(YSSM, PROJ0, IN(19), YMIX, blk * 256 + wave, blk * 256 + 256, lane);
        rwkv_post_all(YRAW, PROJ0, IN(3), BONUS, GB, IN(12), IN(13), YMIX, gw, NGW, lane);
    }
    GRID_BAR();
    {
        PHASE_IDS();
    GEMM_PHASE(EpiResid, YMIX, DM, W0out, 1024, 1024, 1024, IN(0), out, ALPHA, 0);
    }
    GRID_BAR();
    {
        PHASE_IDS();
    ln_rows<1>(out, XB, STATS, IN(21), IN(22), gw, NGW, lane);
    }
    GRID_BAR();
    {
        PHASE_IDS();
        { pg8::Gemm g_{XB, Wup0, M / 32, DFF, 1024, DM, 1024, 4096, 8192, 256, 512, 1}; pg8::StaticOrder S_; S_.init(M / 32, DFF, G, (int)blockIdx.x);
          pg8::EpiBf16S E_{HALO, nullptr, DFF, 0}; pg8::gemm_phase<pg8::EpiBf16S, pg8::StaticOrder, true, true>(lds3, g_, S_, E_); }
    }
    GRID_BAR();
    {
        PHASE_IDS();
        { pg8::Gemm g_{XB, Wup0, M, 2 * DFF, 1024, DM, 1024}; pg8::StaticOrder S_; S_.init(M, 2 * DFF, G, (int)blockIdx.x);
          pg8::EpiConvAct E_{ACT, HALO, IN(24), IN(25), DFF, SEQ}; pg8::gemm_phase<pg8::EpiConvAct, pg8::StaticOrder, true, true>(lds3, g_, S_, E_); }
    }
    GRID_BAR();
    {
        PHASE_IDS();
    GEMM_PHASE(EpiResidLN, ACT, DFF, Wdn0, DFF, 1024, DFF, out, STATS, IN(21), IN(22), ALPHA, 0);
    }
    GRID_BAR();
    {
        PHASE_IDS();
    ln_rows<1>(out, XB, STATS, IN(27), IN(28), gw, NGW, lane);
    }
    GRID_BAR();
    {
        PHASE_IDS();
    GEMM_PHASE(EpiBf16S, XB, DM, W1in, 1024, L1P, 1024, PROJ1, nullptr, L1P, 0);
    }
    GRID_BAR();
    {
        PHASE_IDS();
    mla_prep_all(PROJ1, pos, RS, KPE, CSTAB, gw, NGW, lane);
    }
    GRID_BAR();
    {
        PHASE_IDS();
    GEMM_PHASE(EpiBf16S, PROJ1 + 1536, L1P, Wuq, 256, 768, 256, QM, RS, 768, 2);
    GEMM_PHASE(EpiBf16S, PROJ1 + 1792, L1P, Wukv, 256, 1024, 256, KVM, RS + 1, 1024, 2);
    }
    GRID_BAR();
    {
        PHASE_IDS();
    rope_q_all(QM, CSTAB, gtid, NT);
    {
        LAS bf16_t* scr = (LAS bf16_t*)(lds3 + wave * 16384);
        for (int it = gw; it < 8192; it += NGW) { const int which = it >> 12, r = it & 4095, bh = r >> 5, tt = r & 31, b = bh >> 3, h = bh & 7;
            if (which == 0) transpose_tile64(PROJ1 + ((size_t)b * SEQ + tt * 64) * L1P + 1024 + h * 64, L1P, VTS + (size_t)bh * 64 * SEQ + tt * 64, SEQ, scr, lane);
            else            transpose_tile64(KVM + ((size_t)b * SEQ + tt * 64) * 1024 + h * 128 + 64, 1024, VTM + (size_t)bh * 64 * SEQ + tt * 64, SEQ, scr, lane); }
    }
    }
    GRID_BAR();
    {
        PHASE_IDS();
    {
        for (int g2 = (int)blockIdx.x; g2 < 256; g2 += G) { const int bh = g2 >> 1, part = g2 & 1;
#pragma unroll 1
            for (int i = 0; i < 4; ++i) { const int sbk = part ? ((i == 0) ? 1 : (i == 1) ? 6 : (i == 2) ? 2 : 5) : ((i == 0) ? 0 : (i == 1) ? 7 : (i == 2) ? 3 : 4);
                sb_block(bh, sbk, tid, lane, wave, lds3, PROJ1, VTS, YMIX); } }
        for (int g2 = (int)blockIdx.x; g2 < 256; g2 += G) { const int bh = g2 >> 1, part = g2 & 1;
#pragma unroll 1
            for (int i = 0; i < 4; ++i) { const int sbk = part ? ((i == 0) ? 1 : (i == 1) ? 6 : (i == 2) ? 2 : 5) : ((i == 0) ? 0 : (i == 1) ? 7 : (i == 2) ? 3 : 4);
                mla_block(bh, sbk, tid, lane, wave, lds3, QM, KVM, KPE, VTM, YMIX); } }
    }
    }
    GRID_BAR();
    {
        PHASE_IDS();
    GEMM_PHASE(EpiResidLN, YMIX, DM, W1out, 1024, 1024, 1024, out, STATS, IN(27), IN(28), ALPHA, 0);
    }
    GRID_BAR();
    {
        PHASE_IDS();
    ln_rows<1>(out, XB, STATS, IN(35), IN(36), gw, NGW, lane);
    }
    GRID_BAR();
    {
        PHASE_IDS();
        { pg8::Gemm g_{XB, Wup1, M / 32, DFF, 1024, DM, 1024, 4096, 8192, 256, 512, 1}; pg8::StaticOrder S_; S_.init(M / 32, DFF, G, (int)blockIdx.x);
          pg8::EpiBf16S E_{HALO, nullptr, DFF, 0}; pg8::gemm_phase<pg8::EpiBf16S, pg8::StaticOrder, true, true>(lds3, g_, S_, E_); }
    }
    GRID_BAR();
    {
        PHASE_IDS();
        { pg8::Gemm g_{XB, Wup1, M, 2 * DFF, 1024, DM, 1024}; pg8::StaticOrder S_; S_.init(M, 2 * DFF, G, (int)blockIdx.x);
          pg8::EpiConvAct E_{ACT, HALO, IN(38), IN(39), DFF, SEQ}; pg8::gemm_phase<pg8::EpiConvAct, pg8::StaticOrder, true, true>(lds3, g_, S_, E_); }
    }
    GRID_BAR();
    {
        PHASE_IDS();
    GEMM_PHASE(EpiResidLN, ACT, DFF, Wdn1, DFF, 1024, DFF, out, STATS, IN(35), IN(36), ALPHA, 0);
    }
    GRID_BAR();
    {
        PHASE_IDS();
    ln_rows<2>(out, XB, STATS, IN(41), IN(42), gw, NGW, lane);
    #if defined(PROBE_STAMPS)
    __syncthreads();
    if (blockIdx.x == 0 && threadIdx.x == 0) {
        MISC[16 + 22] = (unsigned)__builtin_amdgcn_s_memrealtime();
#if defined(PROBE_ACC)
        const unsigned d1 = MISC[16 + PROBE_ACC];
#else
        const unsigned d1 = MISC[16 + PROBE_T1_HI] - MISC[16 + PROBE_T1_LO];
#endif
        const unsigned long long spin = 100ull * d1;
        const unsigned long long t0 = __builtin_amdgcn_s_memrealtime();
        while (__builtin_amdgcn_s_memrealtime() - t0 < spin) __builtin_amdgcn_s_sleep(8);
    }
#endif
}
}

extern "C" void kernel_launch(void* const* d_in, const int* in_sizes, int n_in, void* d_out, int out_size, void* d_ws, size_t ws_size, hipStream_t stream) {
    static int grid = 0;
    if (grid == 0) {
        if (n_in != 43 || ws_size < WS_NEED || out_size != M * DM) { fprintf(stderr, "kernel_launch: unexpected n_in %d / ws %zu / out %d\n", n_in, ws_size, out_size); grid = -1; return; }
        int dev = 0, cus = 0, per_cu = 0;
        if (hipGetDevice(&dev) != hipSuccess || hipDeviceGetAttribute(&cus, hipDeviceAttributeMultiprocessorCount, dev) != hipSuccess) { grid = -1; return; }
        if (hipFuncSetAttribute((const void*)fwd_mega, hipFuncAttributeMaxDynamicSharedMemorySize, LDS_BYTES) != hipSuccess) { fprintf(stderr, "kernel_launch: hipFuncSetAttribute failed\n"); grid = -1; return; }
        if (hipOccupancyMaxActiveBlocksPerMultiprocessor(&per_cu, (const void*)fwd_mega, NWAVES * 64, LDS_BYTES) != hipSuccess || per_cu < 1) fprintf(stderr, "kernel_launch: occupancy query reports %d\n", per_cu);
        (void)hipGetLastError();
        grid = cus;
    }
    if (grid < 0) return;
    (void)hipMemsetAsync((char*)d_ws + WS_CTL, 0, CTL_ZERO_BYTES, stream);
    Args a{};
    for (int i = 0; i < 43; ++i) a.in[i] = (const float*)d_in[i];
    a.out = (float*)d_out; a.ws = (unsigned char*)d_ws;
    hipLaunchKernelGGL(fwd_mega, dim3(grid), dim3(NWAVES * 64), LDS_BYTES, stream, a);
}
```

```cpp
#include <hip/hip_runtime.h>
#include <cstdio>
#include <cstdint>
#include <cmath>
namespace pg8 {
#define PG8_LAS __attribute__((address_space(3)))
typedef unsigned short bf16_t;
typedef short bf16x8 __attribute__((ext_vector_type(8)));
typedef float f32x4 __attribute__((ext_vector_type(4)));
typedef unsigned u32x4 __attribute__((ext_vector_type(4)));
constexpr int BM = 256, BK = 64, HALF = 128, HTB = HALF * BK * 2  , STAGE_BYTES = 8 * HTB, NXCD = 8, WGM = 8;

__host__ __device__ __forceinline__ int lds_byte(int r, int c) { const int st = (r >> 4) * 2 + (c >> 5), rr = r & 15, cc = c & 31, ob = rr * 64 + cc * 2; return st * 1024 + (ob ^ (((ob >> 9) & 1) << 5)); }
__host__ __device__ __forceinline__ void stage_rc(int b, int& R, int& C) { const int st = b / 1024, sb = b % 1024, swz = sb ^ (((sb >> 9) & 1) << 5); R = (st >> 1) * 16 + swz / 64; C = (st & 1) * 32 + (swz % 64) / 2; }
__host__ __device__ __forceinline__ int perm32(int rho) { const int n = rho >> 4, i = rho & 15; return 8 * (i >> 2) + 4 * n + (i & 3); }

struct Unit { int pm, pn; };
struct Gemm { const bf16_t* A; const bf16_t* Bt; int M, N, K, lda, ldb; int hrA = 128, trA = 256, hrB = 128, trB = 256, gatherA = 0; };

struct StaticOrder {
    int nM, nN, nwg, G, c;
    __host__ __device__ void init(int M, int N, int G_, int c_) { nM = M / BM; nN = N / BM; nwg = nM * nN; G = G_; c = c_; }
    __host__ __device__ bool next(int i, Unit& u) const {
        const long L = (long)i * G + c; if (L >= nwg) return false;
        int wgid = (int)L; { const int q = nwg / NXCD, r = nwg % NXCD, xcd = wgid % NXCD, off = wgid / NXCD; wgid = (xcd < r ? xcd * (q + 1) : r * (q + 1) + (xcd - r) * q) + off; }
        const int nig = WGM * nN, gid = wgid / nig, fm = gid * WGM, gsz = (nM - fm) < WGM ? (nM - fm) : WGM;
        u.pm = fm + ((wgid % nig) % gsz); u.pn = (wgid % nig) / gsz; return true;
    }
    __device__ __forceinline__ void a_ready(const Unit&) const {}
    __device__ __forceinline__ void done(const Unit&) const {}
};


__device__ __forceinline__ unsigned cvt_pk_bf16(float lo, float hi) { unsigned r; asm volatile("v_cvt_pk_bf16_f32 %0, %1, %2" : "=v"(r) : "v"(lo), "v"(hi)); return r; }
struct EpiBf16S {
    static constexpr bool PERM = true, AFTER_DRAIN = false;
    bf16_t* O; const float* rowscale; int ldc; int rs_stride;
    __device__ __forceinline__ void operator()(const f32x4 (&acc)[2][2][4][2], const Unit& u, int wr, int wc, int fr, int fq) const {
        const int row0 = u.pm * BM + wr * 64 + fr, col0 = u.pn * BM + wc * 32 + 8 * fq;
#pragma unroll
        for (int ai = 0; ai < 2; ++ai)
#pragma unroll
            for (int m = 0; m < 4; ++m) { const int row = row0 + ai * HALF + m * 16; const float sc = rowscale ? rowscale[(size_t)row * rs_stride] : 1.f;
                bf16_t* rowp = O + (size_t)row * ldc + col0;
#pragma unroll
                for (int bj = 0; bj < 2; ++bj) { const f32x4 v0 = acc[ai][bj][m][0] * sc, v1 = acc[ai][bj][m][1] * sc;
                    u32x4 w; w.x = cvt_pk_bf16(v0[0], v0[1]); w.y = cvt_pk_bf16(v0[2], v0[3]); w.z = cvt_pk_bf16(v1[0], v1[1]); w.w = cvt_pk_bf16(v1[2], v1[3]);
                    *(u32x4*)(rowp + bj * HALF) = w; } }
    }
};
struct EpiResid {
    static constexpr bool PERM = false, AFTER_DRAIN = false;
    const float* hin; float* hout; float alpha; int pad;
    __device__ __forceinline__ void operator()(const f32x4 (&acc)[2][2][4][2], const Unit& u, int wr, int wc, int fr, int fq) const {
        const int row0 = u.pm * BM + wr * 64 + fr, col0 = u.pn * BM + wc * 32 + 4 * fq;
#pragma unroll
        for (int ai = 0; ai < 2; ++ai)
#pragma unroll
            for (int m = 0; m < 4; ++m) { const size_t off = (size_t)(row0 + ai * HALF + m * 16) * 1024 + col0;
#pragma unroll
                for (int bj = 0; bj < 2; ++bj)
#pragma unroll
                    for (int n = 0; n < 2; ++n) { const size_t i = off + bj * HALF + n * 16; const f32x4 h = *(const f32x4*)(hin + i); *(f32x4*)(hout + i) = h * alpha + acc[ai][bj][m][n]; } }
    }
};

struct EpiResidLN {
    static constexpr bool PERM = false, AFTER_DRAIN = false;
    float* hio; const float* stats; const float* g; const float* b; float alpha; int pad;
    __device__ __forceinline__ void operator()(const f32x4 (&acc)[2][2][4][2], const Unit& u, int wr, int wc, int fr, int fq) const {
        const int row0 = u.pm * BM + wr * 64 + fr, col0 = u.pn * BM + wc * 32 + 4 * fq;
        f32x4 gg[2][2], bb[2][2];
#pragma unroll
        for (int bj = 0; bj < 2; ++bj)
#pragma unroll
            for (int n = 0; n < 2; ++n) { gg[bj][n] = *(const f32x4*)(g + col0 + bj * HALF + n * 16) * alpha; bb[bj][n] = *(const f32x4*)(b + col0 + bj * HALF + n * 16) * alpha; }
#pragma unroll
        for (int ai = 0; ai < 2; ++ai)
#pragma unroll
            for (int m = 0; m < 4; ++m) { const int row = row0 + ai * HALF + m * 16; const size_t off = (size_t)row * 1024 + col0;
                const float mu = stats[2 * row], rs = stats[2 * row + 1];
#pragma unroll
                for (int bj = 0; bj < 2; ++bj)
#pragma unroll
                    for (int n = 0; n < 2; ++n) { const size_t i = off + bj * HALF + n * 16; const f32x4 p = *(const f32x4*)(hio + i); *(f32x4*)(hio + i) = (p - mu) * rs * gg[bj][n] + bb[bj][n] + acc[ai][bj][m][n]; } }
    }
};

template <int CTRL> __device__ __forceinline__ float pg_dpp(float x) { return __builtin_bit_cast(float, __builtin_amdgcn_update_dpp(0, __builtin_bit_cast(int, x), CTRL, 0xF, 0xF, true)); }
struct EpiConvAct {
    static constexpr bool PERM = true, AFTER_DRAIN = false;
    bf16_t* act; const bf16_t* halo; const float* cw; const float* cb; int dff; int seq;
    __device__ __forceinline__ void operator()(const f32x4 (&acc)[2][2][4][2], const Unit& u, int wr, int wc, int fr, int fq) const {
        typedef unsigned u32x2e __attribute__((ext_vector_type(2)));
#pragma unroll
        for (int n = 0; n < 2; ++n) {
            const int ch0 = u.pn * 128 + wc * 32 + 8 * fq + 4 * n;
            const f32x4 w0 = *(const f32x4*)(cw + ch0), w1 = *(const f32x4*)(cw + dff + ch0), w2 = *(const f32x4*)(cw + 2 * dff + ch0), bb = *(const f32x4*)(cb + ch0);
#pragma unroll
            for (int ai = 0; ai < 2; ++ai) {
                const int rb64 = u.pm * BM + ai * HALF + wr * 64;
                f32x4 P = {0.f, 0.f, 0.f, 0.f};
                if ((rb64 & (seq - 1)) != 0 && fr >= 14) { const u32x2e hv = *(const u32x2e*)(halo + (size_t)(2 * (rb64 / 64 - 1) + (fr - 14)) * dff + ch0);
                    P[0] = __builtin_bit_cast(float, hv.x << 16); P[1] = __builtin_bit_cast(float, hv.x & 0xffff0000u); P[2] = __builtin_bit_cast(float, hv.y << 16); P[3] = __builtin_bit_cast(float, hv.y & 0xffff0000u); }
#pragma unroll
                for (int m = 0; m < 4; ++m) {
                    const f32x4 Gv = acc[ai][0][m][n], Uv = acc[ai][1][m][n];
                    float o[4];
#pragma unroll
                    for (int e = 0; e < 4; ++e) {
                        const float t1 = pg_dpp<0x111>(Gv[e]), t2 = pg_dpp<0x112>(Gv[e]), p1 = pg_dpp<0x10F>(P[e]), p2 = pg_dpp<0x10E>(P[e]);
                        const float g1 = (fr >= 1) ? t1 : p1, g2 = (fr >= 2) ? t2 : p2;
                        const float y = bb[e] + w0[e] * g2 + w1[e] * g1 + w2[e] * Gv[e];
                        o[e] = y * __builtin_amdgcn_rcpf(1.f + __builtin_amdgcn_exp2f(-1.4426950408889634f * y)) * Uv[e];
                    }
                    u32x2e w; w.x = cvt_pk_bf16(o[0], o[1]); w.y = cvt_pk_bf16(o[2], o[3]);
                    *(u32x2e*)(act + (size_t)(rb64 + m * 16 + fr) * dff + ch0) = w;
                    P = Gv;
                }
            }
        }
    }
};

template <class Epi, class Sched, bool ALIGN_EPI = false, bool SP2 = false>
__device__ __forceinline__ void gemm_phase(PG8_LAS unsigned char* lds, const Gemm g, const Sched& S, const Epi& E) {
    int tid = threadIdx.x; asm volatile("" : "+v"(tid));
    const int wid = __builtin_amdgcn_readfirstlane(tid >> 6), lane = tid & 63, wr = wid >> 2, wc = wid & 3, fr = lane & 15, fq = lane >> 4;
    const int K = g.K, nt = K / BK;
    unsigned voffA[2], voffB[2];
#pragma unroll
    for (int i = 0; i < 2; ++i) { int R, C; stage_rc(tid * 16 + i * 8192, R, C); const int Rb = Epi::PERM ? ((R & ~31) + perm32(R & 31)) : R;
        const int Ra = g.gatherA ? (64 * (R >> 1) + 62 + (R & 1)) : R;
        voffA[i] = (unsigned)(Ra * g.lda + C) * 2u; voffB[i] = (unsigned)(Rb * g.ldb + C) * 2u; }
    const size_t kstep = (size_t)(BK * 2);
    const size_t hstepA = (size_t)g.hrA * g.lda * 2, hstepB = (size_t)g.hrB * g.ldb * 2;
    const size_t tstepA = (size_t)g.trA * g.lda * 2, tstepB = (size_t)g.trB * g.ldb * 2;
    const unsigned ldsw = (unsigned)wid * 1024u;
    const int aoff = lds_byte(wr * 64 + fr, fq * 8), boff = lds_byte(wc * 32 + fr, fq * 8);
#define PG8_SA(b, h) (((b) * 2 + (h)) * HTB)
#define PG8_SB(b, h) ((4 + (b) * 2 + (h)) * HTB)
#define PG8_STAGE(bufoff, gbase, voff) do { _Pragma("unroll") for (int _i = 0; _i < 2; ++_i) \
        __builtin_amdgcn_global_load_lds((const unsigned*)((const char*)(gbase) + (voff)[_i]), (PG8_LAS unsigned*)(lds + (bufoff) + ldsw + _i * 8192), 16, 0, 0); } while (0)
#define PG8_LDA(dst, b, h) do { _Pragma("unroll") for (int m = 0; m < 4; ++m) _Pragma("unroll") for (int k = 0; k < 2; ++k) dst[m][k] = *(const PG8_LAS bf16x8*)(lds + PG8_SA(b, h) + aoff + m * 2048 + k * 1024); } while (0)
#define PG8_LDB(dst, b, h) do { _Pragma("unroll") for (int n = 0; n < 2; ++n) _Pragma("unroll") for (int k = 0; k < 2; ++k) dst[n][k] = *(const PG8_LAS bf16x8*)(lds + PG8_SB(b, h) + boff + n * 2048 + k * 1024); } while (0)
#define PG8_MMA(ai, bj, At, Bt) do { __builtin_amdgcn_s_setprio(1); _Pragma("unroll") for (int m = 0; m < 4; ++m) _Pragma("unroll") for (int n = 0; n < 2; ++n) _Pragma("unroll") for (int k = 0; k < 2; ++k) \
        acc[ai][bj][m][n] = __builtin_amdgcn_mfma_f32_16x16x32_bf16(Bt[n][k], At[m][k], acc[ai][bj][m][n], 0, 0, 0); __builtin_amdgcn_s_setprio(0); } while (0)
#define PG8_WAIT_V(n) asm volatile("s_waitcnt vmcnt(" #n ")" ::: "memory")
#define PG8_WAIT_L(n) asm volatile("s_waitcnt lgkmcnt(" #n ")" ::: "memory")
#define PG8_BAR __builtin_amdgcn_s_barrier()
#define PG8_SCHED __builtin_amdgcn_sched_barrier(0)
    Unit cur, nxt; int ui = 0;
    if (!S.next(0, cur)) return;
    f32x4 acc[2][2][4][2];
#pragma unroll
    for (int a = 0; a < 2; ++a)
#pragma unroll
        for (int b = 0; b < 2; ++b)
#pragma unroll
            for (int m = 0; m < 4; ++m)
#pragma unroll
                for (int n = 0; n < 2; ++n) acc[a][b][m][n] = (f32x4){0.f, 0.f, 0.f, 0.f};
    bf16x8 At[4][2], B0[2][2], B1[2][2];
    const char* cA = (const char*)g.A + (size_t)cur.pm * tstepA; const char* cB = (const char*)g.Bt + (size_t)cur.pn * tstepB;
    S.a_ready(cur);
    if constexpr (SP2) {
        PG8_STAGE(PG8_SB(0, 0), cB, voffB); PG8_STAGE(PG8_SB(0, 1), cB + hstepB, voffB); PG8_STAGE(PG8_SA(0, 0), cA, voffA); PG8_STAGE(PG8_SA(0, 1), cA + hstepA, voffA);
        if (wr == 1) PG8_BAR;
        PG8_WAIT_V(2); PG8_BAR;
        PG8_STAGE(PG8_SB(1, 0), cB + kstep, voffB); PG8_STAGE(PG8_SA(1, 0), cA + kstep, voffA); PG8_STAGE(PG8_SB(1, 1), cB + hstepB + kstep, voffB);
        PG8_WAIT_V(6); PG8_BAR;
    } else {
        PG8_STAGE(PG8_SB(0, 0), cB, voffB); PG8_STAGE(PG8_SA(0, 0), cA, voffA); PG8_STAGE(PG8_SB(0, 1), cB + hstepB, voffB); PG8_STAGE(PG8_SA(0, 1), cA + hstepA, voffA);
        if (wr == 1) PG8_BAR;
        PG8_WAIT_V(4); PG8_BAR;
        PG8_STAGE(PG8_SB(1, 0), cB + kstep, voffB); PG8_STAGE(PG8_SA(1, 0), cA + kstep, voffA); PG8_STAGE(PG8_SB(1, 1), cB + hstepB + kstep, voffB);
        PG8_WAIT_V(6); PG8_BAR;
    }
    for (;;) {
        const bool has_next = S.next(ui + 1, nxt);
        const char* nA = has_next ? (const char*)g.A + (size_t)nxt.pm * tstepA : cA; const char* nB = has_next ? (const char*)g.Bt + (size_t)nxt.pn * tstepB : cB;
        for (int t = 0; t < nt; t += 2) {
            const bool last = (t == nt - 2);
            const char* a1 = cA + (size_t)(t + 1) * kstep;
            const char* a2 = last ? nA : cA + (size_t)(t + 2) * kstep; const char* b2 = last ? nB : cB + (size_t)(t + 2) * kstep;
            const char* a3 = a2 + kstep; const char* b3 = b2 + kstep;
            if (last && has_next) S.a_ready(nxt);
            if constexpr (SP2) {
            PG8_LDB(B0, 0, 0); PG8_LDB(B1, 0, 1); PG8_SCHED; PG8_LDA(At, 0, 0); PG8_STAGE(PG8_SA(1, 1), a1 + hstepA, voffA);
            PG8_WAIT_V(8); PG8_WAIT_L(0); PG8_BAR; PG8_MMA(0, 0, At, B0); PG8_MMA(0, 1, At, B1); PG8_BAR; PG8_SCHED;
            PG8_LDA(At, 0, 1); PG8_STAGE(PG8_SB(0, 0), b2, voffB); PG8_STAGE(PG8_SB(0, 1), b2 + hstepB, voffB); PG8_STAGE(PG8_SA(0, 0), a2, voffA);
            PG8_WAIT_V(8); PG8_WAIT_L(0); PG8_BAR; PG8_MMA(1, 0, At, B0); PG8_MMA(1, 1, At, B1); PG8_BAR; PG8_SCHED;
            PG8_LDB(B0, 1, 0); PG8_LDB(B1, 1, 1); PG8_SCHED; PG8_LDA(At, 1, 0); PG8_STAGE(PG8_SA(0, 1), a2 + hstepA, voffA);
            PG8_WAIT_V(8); PG8_WAIT_L(0); PG8_BAR; PG8_MMA(0, 0, At, B0); PG8_MMA(0, 1, At, B1); PG8_BAR; PG8_SCHED;
            PG8_LDA(At, 1, 1); PG8_STAGE(PG8_SB(1, 0), b3, voffB); PG8_STAGE(PG8_SB(1, 1), b3 + hstepB, voffB); PG8_STAGE(PG8_SA(1, 0), a3, voffA);
            PG8_WAIT_V(8); PG8_WAIT_L(0); PG8_BAR; PG8_MMA(1, 0, At, B0); PG8_MMA(1, 1, At, B1); PG8_BAR; PG8_SCHED;
            } else {
            PG8_LDB(B0, 0, 0); PG8_SCHED; PG8_LDA(At, 0, 0); PG8_STAGE(PG8_SA(1, 1), a1 + hstepA, voffA);
            PG8_WAIT_L(8); PG8_BAR; PG8_WAIT_L(0); PG8_MMA(0, 0, At, B0); PG8_BAR; PG8_SCHED;
            PG8_LDB(B1, 0, 1); PG8_STAGE(PG8_SB(0, 0), b2, voffB);
            PG8_BAR; PG8_WAIT_L(0); PG8_MMA(0, 1, At, B1); PG8_BAR;
            PG8_LDA(At, 0, 1); PG8_STAGE(PG8_SA(0, 0), a2, voffA);
            PG8_BAR; PG8_WAIT_L(0); PG8_MMA(1, 0, At, B0); PG8_BAR; PG8_SCHED;
            PG8_STAGE(PG8_SB(0, 1), b2 + hstepB, voffB);
            PG8_WAIT_V(6); PG8_BAR; PG8_MMA(1, 1, At, B1); PG8_BAR;
            PG8_LDB(B0, 1, 0); PG8_SCHED; PG8_LDA(At, 1, 0); PG8_STAGE(PG8_SA(0, 1), a2 + hstepA, voffA);
            PG8_WAIT_L(8); PG8_BAR; PG8_WAIT_L(0); PG8_MMA(0, 0, At, B0); PG8_BAR; PG8_SCHED;
            PG8_LDB(B1, 1, 1); PG8_STAGE(PG8_SB(1, 0), b3, voffB);
            PG8_BAR; PG8_WAIT_L(0); PG8_MMA(0, 1, At, B1); PG8_BAR;
            PG8_LDA(At, 1, 1); PG8_STAGE(PG8_SA(1, 0), a3, voffA);
            PG8_BAR; PG8_WAIT_L(0); PG8_MMA(1, 0, At, B0); PG8_BAR; PG8_SCHED;
            PG8_STAGE(PG8_SB(1, 1), b3 + hstepB, voffB);
            PG8_WAIT_V(6); PG8_BAR; PG8_MMA(1, 1, At, B1); PG8_BAR;
            }
        }
        if constexpr (ALIGN_EPI) { if (wr == 0) PG8_BAR; }
        if constexpr (!Epi::AFTER_DRAIN) { E(acc, cur, wr, wc, fr, fq); S.done(cur); }
        if (!has_next) break;
#pragma unroll
        for (int a = 0; a < 2; ++a)
#pragma unroll
            for (int b = 0; b < 2; ++b)
#pragma unroll
                for (int m = 0; m < 4; ++m)
#pragma unroll
                    for (int n = 0; n < 2; ++n) acc[a][b][m][n] = (f32x4){0.f, 0.f, 0.f, 0.f};
        cur = nxt; cA = nA; cB = nB; ++ui;
        if constexpr (ALIGN_EPI) { if (wr == 1) PG8_BAR; }
    }
    PG8_WAIT_V(0);
    if constexpr (!ALIGN_EPI) { if (wr == 0) PG8_BAR; }
    PG8_BAR;
    if constexpr (Epi::AFTER_DRAIN) { E.fused(acc, cur, wr, wc, fr, fq, lds, wid, lane); S.done(cur); }
#undef PG8_SA
#undef PG8_SB
#undef PG8_STAGE
#undef PG8_LDA
#undef PG8_LDB
#undef PG8_MMA
#undef PG8_WAIT_V
#undef PG8_WAIT_L
#undef PG8_BAR
#undef PG8_SCHED
}
}
#define GAS __attribute__((address_space(1)))
#define LAS __attribute__((address_space(3)))
typedef unsigned short bf16;
typedef unsigned v4u __attribute__((ext_vector_type(4)));
typedef float f32x4 __attribute__((ext_vector_type(4)));
typedef short bf16x8 __attribute__((ext_vector_type(8)));
typedef GAS unsigned gu32;
typedef GAS unsigned long long gu64;
#define RLX_AGENT __ATOMIC_RELAXED, __HIP_MEMORY_SCOPE_AGENT
#define LDS_WAIT() asm volatile("s_waitcnt lgkmcnt(0)" ::: "memory")
#define VM_WAIT() asm volatile("s_waitcnt vmcnt(0)" ::: "memory")
__device__ __forceinline__ unsigned long long rt() { return __builtin_amdgcn_s_memrealtime(); }
__device__ __forceinline__ unsigned f2bf(float f) { unsigned u = __builtin_bit_cast(unsigned, f); return (u + 0x7fffu + ((u >> 16) & 1u)) >> 16; }
__device__ __forceinline__ unsigned pk2(float lo, float hi) { return f2bf(lo) | (f2bf(hi) << 16); }

#define XB_TMO      128
#define XB_XCNT(j)  (256  + 64 * (j))
#define XB_XSUB(j)  (1280 + 64 * (j))
#define XB_XGEN(j)  (2304 + 64 * (j))
#define XB_TOP      3328
#define XB_TOPGEN   3392
#define XCD_BAR_WORDS 3456
#define XB_SPIN_CAP (1u << 18)

__device__ __forceinline__ unsigned xb_ld(unsigned* p)              { return __hip_atomic_load(p, __ATOMIC_RELAXED, __HIP_MEMORY_SCOPE_AGENT); }
__device__ __forceinline__ unsigned xb_add(unsigned* p, unsigned v) { return __hip_atomic_fetch_add(p, v, __ATOMIC_RELAXED, __HIP_MEMORY_SCOPE_AGENT); }
__device__ __forceinline__ unsigned xb_xcc_id() { return (unsigned)__builtin_amdgcn_s_getreg((3 << 11) | 20) & 0xFu; }
#define XB_SPIN(cond, bar) do { unsigned _sp = 0; while (cond) { __builtin_amdgcn_s_sleep(1); \
    if ((++_sp & 255u) == 0u) { if (xb_ld(&(bar)[XB_TMO])) break; if (_sp > XB_SPIN_CAP) { atomicAdd(&(bar)[XB_TMO], 1u); break; } } } } while (0)

struct XcdBarrier {
    unsigned* bar; unsigned x;
    volatile LAS unsigned* st;
};

__device__ __forceinline__ XcdBarrier xcd_barrier_post(unsigned* bar, volatile LAS unsigned* st) {
    XcdBarrier b; b.bar = bar; b.x = xb_xcc_id(); b.st = st;
    if (threadIdx.x == 0) (void)xb_add(&bar[XB_XCNT(b.x)], 1u);
    return b;
}
__device__ __forceinline__ void xcd_barrier_complete(unsigned* bar, unsigned x, unsigned& nloc, unsigned& nx) {
    const unsigned G = gridDim.x * gridDim.y * gridDim.z;
    unsigned sum, cnt, mine, sp = 0u;
    for (;;) {
        sum = 0u; cnt = 0u; mine = 0u;
#pragma unroll
        for (unsigned j = 0; j < 16; ++j) { const unsigned c = xb_ld(&bar[XB_XCNT(j)]); sum += c; cnt += (c > 0u) ? 1u : 0u; mine = (j == x) ? c : mine; }
        if (sum == G) break;
        __builtin_amdgcn_s_sleep(1);
        if ((++sp & 255u) == 0u) { if (xb_ld(&bar[XB_TMO])) break; if (sp > XB_SPIN_CAP) { atomicAdd(&bar[XB_TMO], 1u); break; } }
    }
    nloc = mine > 0u ? mine : 1u; nx = cnt > 0u ? cnt : 1u;
}

__device__ __forceinline__ void xcd_barrier(const XcdBarrier& b) {
    asm volatile("s_waitcnt vmcnt(0)" ::: "memory");
    __syncthreads();
    if (threadIdx.x == 0) {
        unsigned* bar = b.bar;
        __builtin_amdgcn_s_waitcnt(0);
        unsigned nloc = b.st[0], nx = b.st[1];
        if (nloc == 0u) { xcd_barrier_complete(bar, b.x, nloc, nx); b.st[0] = nloc; b.st[1] = nx; }
        const unsigned old = xb_add(&bar[XB_XSUB(b.x)], 1u);
        const unsigned gen = old / nloc;
        if (old + 1u == (gen + 1u) * nloc) {
            __builtin_amdgcn_fence(__ATOMIC_RELEASE, "agent");
            asm volatile("s_waitcnt vmcnt(0)" ::: "memory");
            const unsigned og = xb_add(&bar[XB_TOP], 1u);
            const unsigned tg = og / nx;
            if (og + 1u == (tg + 1u) * nx) xb_add(&bar[XB_TOPGEN], 1u);
            else XB_SPIN(xb_ld(&bar[XB_TOPGEN]) == tg, bar);
            __builtin_amdgcn_fence(__ATOMIC_ACQUIRE, "agent");
            xb_add(&bar[XB_XGEN(b.x)], 1u);
            asm volatile("s_waitcnt vmcnt(0)" ::: "memory");
        } else {
            XB_SPIN(xb_ld(&bar[XB_XGEN(b.x)]) == gen, bar);
            __builtin_amdgcn_fence(__ATOMIC_ACQUIRE, "agent");
            asm volatile("s_waitcnt vmcnt(0)" ::: "memory");
        }
    }
    __syncthreads();
}
constexpr int NWAVES = 8;
constexpr int BATCH = 16, SEQ = 2048, DM = 1024, M = BATCH * SEQ;
constexpr int L0P = 3584;
constexpr int L1P = 2048;
constexpr int DFF = 2816;
constexpr float ALPHA = 1.4142135623730951f;
typedef unsigned short bf16_t;
typedef float f32x16 __attribute__((ext_vector_type(16)));

constexpr size_t MiB = 1u << 20;
constexpr size_t WS_CTL = 0, CTL_ZERO_BYTES = 1 * MiB;
constexpr int CW_BAR = 4096;
constexpr size_t WS_W0IN = 2 * MiB, WS_W0OUT = 9 * MiB, WS_WUP0 = 11 * MiB, WS_WDN0 = 22 * MiB, WS_W1IN = 28 * MiB, WS_WUQ = 32 * MiB, WS_WUKV = 33 * MiB,
                 WS_W1OUT = 34 * MiB, WS_WUP1 = 36 * MiB, WS_WDN1 = 47 * MiB;
constexpr size_t WS_XB = 56 * MiB, WS_YMIX = 120 * MiB, WS_BIG = 184 * MiB;
constexpr size_t WS_G = 408 * MiB, WS_BONUS = 440 * MiB, WS_DT = 441 * MiB, WS_XST = 442 * MiB, WS_BT = 474 * MiB, WS_ASUM = 490 * MiB;
constexpr size_t WS_SLOC = 120 * MiB;
constexpr size_t WS_W2T = 53 * MiB, WS_A2T = 53 * MiB + 256 * 1024, WS_G2T = 53 * MiB + 512 * 1024;
constexpr size_t WS_GU = 120 * MiB;
constexpr size_t WS_PROJ1 = 184 * MiB, WS_QM = 312 * MiB, WS_KVM = 360 * MiB, WS_KPE = 424 * MiB, WS_RS = 426 * MiB;
constexpr size_t WS_CSTAB = 492 * MiB;
constexpr size_t WS_VTS = 428 * MiB, WS_VTM = 460 * MiB;
constexpr size_t WS_NEED = 497 * MiB;

constexpr int RING_BYTES = 131072;
constexpr int LDSCTL_OFF = 146432, MISC_OFF = LDSCTL_OFF + 320;
constexpr int LDS_BYTES = 147456;

__device__ __forceinline__ float bf2f(bf16_t b) { return __builtin_bit_cast(float, (unsigned)b << 16); }
__device__ __forceinline__ float sigmoidf_(float x) { return 1.f / (1.f + expf(-x)); }
__device__ __forceinline__ float softplusf_(float x) { return fmaxf(x, 0.f) + log1pf(expf(-fabsf(x))); }
__device__ __forceinline__ float siluf_(float x) { return x / (1.f + expf(-x)); }
__device__ __forceinline__ float wave_sum(float v) {
#pragma unroll
    for (int o = 1; o < 64; o <<= 1) v += __shfl_xor(v, o);
    return v;
}
#define WSYNC() asm volatile("s_waitcnt lgkmcnt(0)" ::: "memory")
typedef float f32x2_t __attribute__((ext_vector_type(2)));
typedef __bf16 bf16x2_t __attribute__((ext_vector_type(2)));
typedef unsigned u32x2 __attribute__((ext_vector_type(2)));
__device__ __forceinline__ unsigned cvtpk(float lo, float hi) { f32x2_t v = {lo, hi}; bf16x2_t b = __builtin_convertvector(v, bf16x2_t); return __builtin_bit_cast(unsigned, b); }
__device__ __forceinline__ float bflo(unsigned u) { return __builtin_bit_cast(float, u << 16); }
__device__ __forceinline__ float bfhi(unsigned u) { return __builtin_bit_cast(float, u & 0xffff0000u); }
__device__ __forceinline__ bf16_t bf1(float x) { return (bf16_t)(cvtpk(x, x) & 0xffffu); }
__device__ __forceinline__ bf16x8 pack8(float a0, float a1, float a2, float a3, float a4, float a5, float a6, float a7) {
    v4u w; w.x = cvtpk(a0, a1); w.y = cvtpk(a2, a3); w.z = cvtpk(a4, a5); w.w = cvtpk(a6, a7); return __builtin_bit_cast(bf16x8, w); }
template <int CTRL> __device__ __forceinline__ float dpp_mov(float x) { return __builtin_bit_cast(float, __builtin_amdgcn_update_dpp(0, __builtin_bit_cast(int, x), CTRL, 0xF, 0xF, true)); }
__device__ __forceinline__ float rowsum16(float x) { x += dpp_mov<0x128>(x); x += dpp_mov<0x124>(x); x += dpp_mov<0x122>(x); x += dpp_mov<0x121>(x); return x; }
__device__ __forceinline__ float rl(float x, int l) { return __builtin_bit_cast(float, __builtin_amdgcn_readlane(__builtin_bit_cast(int, x), l)); }
__device__ __forceinline__ float wave_sum_dpp(float x) { x = rowsum16(x); return (rl(x, 0) + rl(x, 16)) + (rl(x, 32) + rl(x, 48)); }

__device__ __forceinline__ void transpose_matrix(const float* __restrict__ W, int K, int N, bf16_t* __restrict__ WT, int Npad, int ldt, LAS float* scr, int gw, int NGW, int lane, const float* __restrict__ kscale, int& tr_base, bool ffn_interleave = false) {
    (void)scr;
    const int nblk = Npad / 64, nit = (K / 64) * nblk;
    int it0 = gw - (tr_base % NGW); if (it0 < 0) it0 += NGW; tr_base += nit;
    for (int it = it0; it < nit; it += NGW) {
        const int kb = it / nblk, nb = it - kb * nblk, n = nb * 64 + lane, k0 = kb * 64;
        const bool ok = n < N; const float* src = W + (size_t)k0 * N + (ok ? n : 0);
#pragma unroll
        for (int hc = 0; hc < 2; ++hc) {
            float v[32];
#pragma unroll
            for (int i = 0; i < 32; ++i) v[i] = src[(size_t)(hc * 32 + i) * N];
#pragma unroll
            for (int c = 0; c < 4; ++c) { float u[8];
#pragma unroll
                for (int i = 0; i < 8; ++i) { u[i] = ok ? v[c * 8 + i] : 0.f; if (kscale) u[i] *= kscale[k0 + hc * 32 + c * 8 + i]; }
                v4u o; o.x = cvtpk(u[0], u[1]); o.y = cvtpk(u[2], u[3]); o.z = cvtpk(u[4], u[5]); o.w = cvtpk(u[6], u[7]);
                const int nr = ffn_interleave ? ((n < DFF) ? 256 * (n >> 7) + (n & 127) : 256 * ((n - DFF) >> 7) + 128 + ((n - DFF) & 127)) : n;
                *(v4u*)(WT + (size_t)nr * ldt + k0 + hc * 32 + c * 8) = o; }
        }
    }
}

template <int MODE> __device__ __forceinline__ void ln_rows(float* h, bf16_t* hb, float* stats, const float* __restrict__ g, const float* __restrict__ b, int gw, int NGW, int lane) {
    for (int row = gw * 2; row < M; row += NGW * 2) {
        float* p = h + (size_t)row * DM;
        f32x4 v[2][4]; float s[2] = {0.f, 0.f};
#pragma unroll
        for (int r = 0; r < 2; ++r)
#pragma unroll
            for (int j = 0; j < 4; ++j) v[r][j] = *(const f32x4*)(p + r * DM + 4 * lane + 256 * j);
#pragma unroll
        for (int r = 0; r < 2; ++r)
#pragma unroll
            for (int j = 0; j < 4; ++j) s[r] += (v[r][j][0] + v[r][j][1]) + (v[r][j][2] + v[r][j][3]);
        float mean[2], q[2] = {0.f, 0.f}, rstd[2];
#pragma unroll
        for (int r = 0; r < 2; ++r) { mean[r] = wave_sum_dpp(s[r]) * (1.f / DM);
#pragma unroll
            for (int j = 0; j < 4; ++j) { v[r][j] = v[r][j] - mean[r]; q[r] += (v[r][j][0] * v[r][j][0] + v[r][j][1] * v[r][j][1]) + (v[r][j][2] * v[r][j][2] + v[r][j][3] * v[r][j][3]); } }
#pragma unroll
        for (int r = 0; r < 2; ++r) rstd[r] = 1.0f / sqrtf(wave_sum_dpp(q[r]) * (1.f / DM) + 1e-5f);
        if (MODE == 1 && lane < 2) { stats[2 * (row + lane)] = lane ? mean[1] : mean[0]; stats[2 * (row + lane) + 1] = lane ? rstd[1] : rstd[0]; }
#pragma unroll
        for (int j = 0; j < 4; ++j) {
            const int c = 4 * lane + 256 * j;
            const f32x4 gg = *(const f32x4*)(g + c), bb = *(const f32x4*)(b + c);
#pragma unroll
            for (int r = 0; r < 2; ++r) {
                const f32x4 o = v[r][j] * rstd[r] * gg + bb;
                if (MODE == 1) { uint2 w; w.x = cvtpk(o[0], o[1]); w.y = cvtpk(o[2], o[3]); *(uint2*)(hb + (size_t)(row + r) * DM + c) = w; }
                else *(f32x4*)(p + r * DM + c) = o;
            }
        }
    }
}

__device__ __forceinline__ void rwkv_naive_chain(int chain, int lane, LAS float* sm, const bf16_t* __restrict__ proj, const float* __restrict__ mix, const float* __restrict__ w0, const float* __restrict__ w2,
                                                 const float* __restrict__ a0, const float* __restrict__ a2, const float* __restrict__ g2, const float* __restrict__ k_k,
                                                 const float* __restrict__ k_a, const float* __restrict__ r_k, const float* __restrict__ ln_g, const float* __restrict__ ln_b, bf16_t* __restrict__ ymix) {
    LAS float* s_w2 = sm; LAS float* s_a2 = sm + 4096; LAS float* s_g2 = sm + 8192; LAS float* s_tw = sm + 16384; LAS float* s_al = s_tw + 64; LAS float* s_sg = s_tw + 128;
    LAS float* s_w = s_tw + 256; LAS float* s_k = s_tw + 320; LAS float* s_a = s_tw + 384; LAS float* s_b = s_tw + 448; LAS float* s_r = s_tw + 512;
    const int b = chain >> 3, h = chain & 7, c = h * 64 + lane;
    for (int l = 0; l < 64; ++l) { s_w2[l * 64 + lane] = w2[l * 512 + c]; s_a2[l * 64 + lane] = a2[l * 512 + c]; }
    for (int l = 0; l < 128; ++l) s_g2[l * 64 + lane] = g2[l * 512 + c];
    const float mr = mix[c], mk = mix[512 + c], mv = mix[1024 + c], mw = mix[1536 + lane], ma = mix[1600 + lane], mg0 = mix[1664 + lane], mg1 = mix[1728 + lane];
    const float w0c = w0[c], a0c = a0[c], kkc = k_k[c], kac = k_a[c], rkc = r_k[c], lgc = ln_g[c], lbc = ln_b[c];
    float S[64];
#pragma unroll
    for (int j = 0; j < 64; ++j) S[j] = 0.f;
    float pr = 0.f, pk = 0.f, pv = 0.f, pw = 0.f, pa = 0.f, pg0 = 0.f, pg1 = 0.f;
    WSYNC();
    for (int t = 0; t < SEQ; ++t) {
        const bf16_t* row = proj + (size_t)(b * SEQ + t) * L0P;
        const float cr = bf2f(row[c]), ck = bf2f(row[512 + c]), cv = bf2f(row[1024 + c]), cw = bf2f(row[1536 + lane]), ca = bf2f(row[1600 + lane]),
                    cg0 = bf2f(row[1664 + lane]), cg1 = bf2f(row[1728 + lane]);
        const float r_s = cr + (pr - cr) * mr, k_s = ck + (pk - ck) * mk, v_s = cv + (pv - cv) * mv;
        const float wl = cw + (pw - cw) * mw, al = ca + (pa - ca) * ma, g0 = cg0 + (pg0 - cg0) * mg0, g1 = cg1 + (pg1 - cg1) * mg1;
        pr = cr; pk = ck; pv = cv; pw = cw; pa = ca; pg0 = cg0; pg1 = cg1;
        s_tw[lane] = tanhf(wl); s_al[lane] = al; s_sg[lane] = sigmoidf_(g0); s_sg[64 + lane] = sigmoidf_(g1);
        WSYNC();
        float wsum = w0c, asum = a0c, gsum = 0.f;
#pragma unroll 2
        for (int l = 0; l < 64; ++l) { wsum += s_tw[l] * s_w2[l * 64 + lane]; asum += s_al[l] * s_a2[l * 64 + lane]; }
#pragma unroll 2
        for (int l = 0; l < 128; ++l) gsum += s_sg[l] * s_g2[l * 64 + lane];
        const float log_w = -softplusf_(-wsum) - 0.5f;
        const float dec = expf(-expf(log_w));
        const float a = sigmoidf_(asum);
        float kkv = k_s * kkc;
        const float nrm = sqrtf(wave_sum(kkv * kkv));
        kkv = kkv / fmaxf(nrm, 1e-12f);
        const float k2 = k_s * (1.f + (a - 1.f) * kac);
        const float bonus_s = wave_sum(r_s * k2 * rkc);
        s_w[lane] = dec; s_k[lane] = k2; s_a[lane] = -kkv; s_b[lane] = kkv * a; s_r[lane] = r_s;
        WSYNC();
        float sa = 0.f;
#pragma unroll
        for (int j = 0; j < 64; ++j) sa += S[j] * s_a[j];
        float y = 0.f;
#pragma unroll
        for (int j = 0; j < 64; ++j) { S[j] = S[j] * s_w[j] + sa * s_b[j] + v_s * s_k[j]; y += S[j] * s_r[j]; }
        const float mu = wave_sum(y) * (1.f / 64.f);
        const float d = y - mu;
        const float var = wave_sum(d * d) * (1.f / 64.f);
        const float yn = d * (1.0f / sqrtf(var + 64e-5f)) * lgc + lbc;
        const float o = (yn + bonus_s * v_s) * gsum;
        ymix[(size_t)(b * SEQ + t) * DM + c] = (bf16_t)f2bf(o);
        WSYNC();
    }
}

__device__ __forceinline__ void ssm_conv_all(const bf16_t* __restrict__ proj, const float* __restrict__ cw, const float* __restrict__ cb, const float* __restrict__ dtb,
                                             bf16_t* __restrict__ xbc, float* __restrict__ dt, int gtid, int NT) {
    for (size_t i = gtid; i < (size_t)M * 1024; i += NT) {
        const int m = (int)(i >> 10), c = (int)(i & 1023), t = m & (SEQ - 1);
        float acc = cb[c];
#pragma unroll
        for (int k = 0; k < 4; ++k) { const int tt = t - 3 + k; if (tt >= 0) acc += cw[k * 1024 + c] * bf2f(proj[(size_t)(m - 3 + k) * L0P + 2304 + c]); }
        xbc[i] = (bf16_t)f2bf(siluf_(acc));
    }
    for (int i = gtid; i < M * 8; i += NT) dt[i] = softplusf_(bf2f(proj[(size_t)(i >> 3) * L0P + 3328 + (i & 7)]) + dtb[i & 7]);
}
__device__ __forceinline__ void ssd_naive_task(int task, int lane, const bf16_t* __restrict__ xbc, const float* __restrict__ dt, const float* __restrict__ a_log, const float* __restrict__ dsk, float* __restrict__ yssm) {
    const int chain = task >> 2, q = task & 3, b = chain >> 3, h = chain & 7, g = h >> 2, p = q * 16 + (lane >> 2), nq = lane & 3;
    const float A = -expf(a_log[h]), D = dsk[h];
    float st[32];
#pragma unroll
    for (int n = 0; n < 32; ++n) st[n] = 0.f;
    for (int t = 0; t < SEQ; ++t) {
        const size_t m = (size_t)b * SEQ + t;
        const float dtv = dt[m * 8 + h], dA = expf(dtv * A);
        const float x = bf2f(xbc[m * 1024 + h * 64 + p]), xdt = x * dtv;
        const bf16_t* Bp = xbc + m * 1024 + 512 + g * 128 + nq * 32;
        const bf16_t* Cp = xbc + m * 1024 + 768 + g * 128 + nq * 32;
        float yp = 0.f;
#pragma unroll
        for (int n = 0; n < 32; ++n) { st[n] = st[n] * dA + xdt * bf2f(Bp[n]); yp += st[n] * bf2f(Cp[n]); }
        yp += __shfl_xor(yp, 1); yp += __shfl_xor(yp, 2);
        if (nq == 0) yssm[m * 512 + h * 64 + p] = yp + D * x;
    }
}
template <bool ST = true> __device__ __forceinline__ void ssm_gate_norm_all(const bf16_t* __restrict__ yssm, const bf16_t* __restrict__ proj, const float* __restrict__ ng, bf16_t* __restrict__ ymix, int wv0, int wvend, int lane) {
    for (int wvb = wv0 * 4 - (wv0 & ~7) * 3; wvb < wvend; wvb += NWAVES * 4) {
        float u[4][4], q[4];
#pragma unroll
        for (int k = 0; k < 4; ++k) { const int wv = wvb + k, m = wv >> 1, g = wv & 1; q[k] = 0.f;
#pragma unroll
            for (int j = 0; j < 4; ++j) { const int c = g * 256 + j * 64 + lane; const float z = bf2f(proj[(size_t)m * L0P + 1792 + c]); u[k][j] = bf2f(yssm[(size_t)m * 512 + c]) * (z * __builtin_amdgcn_rcpf(1.f + __expf(-z))); q[k] += u[k][j] * u[k][j]; } }
#pragma unroll
        for (int k = 0; k < 4; ++k) { const int wv = wvb + k, m = wv >> 1, g = wv & 1;
            const float rs = __builtin_amdgcn_rsqf(wave_sum_dpp(q[k]) * (1.f / 256.f) + 1e-5f);
#pragma unroll
            for (int j = 0; j < 4; ++j) { const int c = g * 256 + j * 64 + lane; const float o_ = u[k][j] * rs * ng[c]; if (ST) ymix[(size_t)m * DM + 512 + c] = bf1(o_); else asm volatile("" :: "v"(o_)); } }
    }
}
template <bool ST = true> __device__ __forceinline__ void ffn_act_all(bf16_t* gu, const float* __restrict__ cw, const float* __restrict__ cb, int gtid, int NT) {
    constexpr int NCH = DFF / 8, NSTRIP = M / 32;
    for (int task = gtid; task < NSTRIP * NCH; task += NT) {
        const int strip = task / NCH, q = task - strip * NCH, c0 = q * 8, m0 = strip * 32;
        float w0[8], w1[8], w2[8], bb[8], g2[8], g1[8];
#pragma unroll
        for (int j = 0; j < 8; j += 4) { const f32x4 a = *(const f32x4*)(cw + c0 + j), b = *(const f32x4*)(cw + DFF + c0 + j), c = *(const f32x4*)(cw + 2 * DFF + c0 + j), d = *(const f32x4*)(cb + c0 + j);
#pragma unroll
            for (int k = 0; k < 4; ++k) { w0[j + k] = a[k]; w1[j + k] = b[k]; w2[j + k] = c[k]; bb[j + k] = d[k]; } }
        bf16_t* base = gu + (size_t)m0 * (2 * DFF) + c0;
        if ((m0 & (SEQ - 1)) != 0) { const v4u a = *(const v4u*)(base - 2 * (2 * DFF)), b = *(const v4u*)(base - (2 * DFF));
            g2[0] = bflo(a.x); g2[1] = bfhi(a.x); g2[2] = bflo(a.y); g2[3] = bfhi(a.y); g2[4] = bflo(a.z); g2[5] = bfhi(a.z); g2[6] = bflo(a.w); g2[7] = bfhi(a.w);
            g1[0] = bflo(b.x); g1[1] = bfhi(b.x); g1[2] = bflo(b.y); g1[3] = bfhi(b.y); g1[4] = bflo(b.z); g1[5] = bfhi(b.z); g1[6] = bflo(b.w); g1[7] = bfhi(b.w); }
        else {
#pragma unroll
            for (int j = 0; j < 8; ++j) { g2[j] = 0.f; g1[j] = 0.f; } }
#pragma unroll 4
        for (int r = 0; r < 32; ++r) {
            const v4u gv = *(const v4u*)(base + (size_t)r * (2 * DFF)), uv = *(const v4u*)(base + (size_t)r * (2 * DFF) + DFF);
            const unsigned gw_[4] = {gv.x, gv.y, gv.z, gv.w}, uw_[4] = {uv.x, uv.y, uv.z, uv.w};
            unsigned ow[4];
#pragma unroll
            for (int k = 0; k < 4; ++k) {
                const float ga = bflo(gw_[k]), gb = bfhi(gw_[k]);
                const float ya = bb[2 * k] + w0[2 * k] * g2[2 * k] + w1[2 * k] * g1[2 * k] + w2[2 * k] * ga;
                const float yb = bb[2 * k + 1] + w0[2 * k + 1] * g2[2 * k + 1] + w1[2 * k + 1] * g1[2 * k + 1] + w2[2 * k + 1] * gb;
                g2[2 * k] = g1[2 * k]; g1[2 * k] = ga; g2[2 * k + 1] = g1[2 * k + 1]; g1[2 * k + 1] = gb;
                ow[k] = cvtpk(ya / (1.f + __expf(-ya)) * bflo(uw_[k]), yb / (1.f + __expf(-yb)) * bfhi(uw_[k]));
            }
            if (ST) *(v4u*)(base + (size_t)r * (2 * DFF) + DFF) = (v4u){ow[0], ow[1], ow[2], ow[3]}; else asm volatile("" :: "v"(ow[0]), "v"(ow[1]), "v"(ow[2]), "v"(ow[3]));
        }
    }
}
template <bool ST = true> __device__ __forceinline__ void mla_prep_all(const bf16_t* __restrict__ proj1, const int* __restrict__ pos, float* __restrict__ rs, bf16_t* __restrict__ kpe, float* __restrict__ cstab, int gw, int NGW, int lane) {
    for (int m4 = gw * 4; m4 < M; m4 += NGW * 4) {
        const int mt = m4 + (lane >> 4), fi = lane & 15;
        const double inv = exp2(-(double)(2 * fi) * (13.287712379549449 / 32.0));
        const double ang = (double)pos[mt] * inv;
        const float cs = (float)cos(ang), sn = (float)sin(ang);
        cstab[(size_t)mt * 32 + fi] = cs; cstab[(size_t)mt * 32 + 16 + fi] = sn;
        { const bf16_t* row = proj1 + (size_t)mt * L1P; const float x1 = bf2f(row[1920 + fi]), x2 = bf2f(row[1936 + fi]);
          kpe[(size_t)mt * 32 + fi] = bf1(x1 * cs - x2 * sn); kpe[(size_t)mt * 32 + 16 + fi] = bf1(x2 * cs + x1 * sn); }
        float q[4], k[4];
#pragma unroll
        for (int u = 0; u < 4; ++u) { const bf16_t* row = proj1 + (size_t)(m4 + u) * L1P; q[u] = 0.f; k[u] = 0.f;
#pragma unroll
            for (int j = 0; j < 4; ++j) { const float v = bf2f(row[1536 + j * 64 + lane]); q[u] += v * v; }
#pragma unroll
            for (int j = 0; j < 2; ++j) { const float v = bf2f(row[1792 + j * 64 + lane]); k[u] += v * v; } }
#pragma unroll
        for (int u = 0; u < 4; ++u) { q[u] = wave_sum_dpp(q[u]); k[u] = wave_sum_dpp(k[u]); }
        if (lane < 4) { const float qq = lane == 0 ? q[0] : lane == 1 ? q[1] : lane == 2 ? q[2] : q[3], kk2 = lane == 0 ? k[0] : lane == 1 ? k[1] : lane == 2 ? k[2] : k[3];
            rs[(size_t)(m4 + lane) * 2] = 1.0f / sqrtf(qq * (1.f / 256.f) + 1e-6f); rs[(size_t)(m4 + lane) * 2 + 1] = 1.0f / sqrtf(kk2 * (1.f / 128.f) + 1e-6f); }
    }
}
template <bool ST = true> __device__ __forceinline__ void rope_q_all(bf16_t* qm, const float* __restrict__ cstab, int gtid, int NT) {
    for (int i = gtid; i < M * 16; i += NT) {
        const int m = i >> 4, h = (i >> 1) & 7, k0 = (i & 1) * 8;
        bf16_t* p = qm + (size_t)m * 768 + h * 96 + 64 + k0;
        const v4u a = *(const v4u*)p, b = *(const v4u*)(p + 16);
        const f32x4 c0 = *(const f32x4*)(cstab + (size_t)m * 32 + k0), c1 = *(const f32x4*)(cstab + (size_t)m * 32 + k0 + 4), s0 = *(const f32x4*)(cstab + (size_t)m * 32 + 16 + k0), s1 = *(const f32x4*)(cstab + (size_t)m * 32 + 16 + k0 + 4);
        const unsigned au[4] = {a.x, a.y, a.z, a.w}, bu[4] = {b.x, b.y, b.z, b.w};
        const float cs[8] = {c0[0], c0[1], c0[2], c0[3], c1[0], c1[1], c1[2], c1[3]}, sn[8] = {s0[0], s0[1], s0[2], s0[3], s1[0], s1[1], s1[2], s1[3]};
        unsigned o1[4], o2[4];
#pragma unroll
        for (int q = 0; q < 4; ++q) { const float x1a = bflo(au[q]), x1b = bfhi(au[q]), x2a = bflo(bu[q]), x2b = bfhi(bu[q]);
            o1[q] = cvtpk(x1a * cs[2 * q] - x2a * sn[2 * q], x1b * cs[2 * q + 1] - x2b * sn[2 * q + 1]);
            o2[q] = cvtpk(x2a * cs[2 * q] + x1a * sn[2 * q], x2b * cs[2 * q + 1] + x1b * sn[2 * q + 1]); }
        if (ST) { *(v4u*)p = (v4u){o1[0], o1[1], o1[2], o1[3]}; *(v4u*)(p + 16) = (v4u){o2[0], o2[1], o2[2], o2[3]}; }
    }
}
__device__ __forceinline__ void sb_naive_task(int qblk, int bh, int lane, const bf16_t* __restrict__ proj1, bf16_t* __restrict__ ymix) {
    const int b = bh >> 3, h = bh & 7, t = qblk * 64 + lane;
    const size_t mrow = (size_t)b * SEQ;
    float q[64], o[64];
#pragma unroll
    for (int d = 0; d < 64; ++d) { q[d] = bf2f(proj1[(mrow + t) * L1P + h * 64 + d]) * 0.125f; o[d] = 0.f; }
    float cum = 0.f;
    const int smax = qblk * 64 + 63;
    for (int s = smax - 1; s >= 0; --s) {
        const bf16_t* kr = proj1 + (mrow + s) * L1P + 512 + h * 64;
        const bf16_t* vr = proj1 + (mrow + s) * L1P + 1024 + h * 64;
        float z = 0.f;
#pragma unroll
        for (int d = 0; d < 64; ++d) z += q[d] * bf2f(kr[d]);
        if (s < t) {
            const float lsp = -softplusf_(-z);
            const float lsn = -softplusf_(z);
            const float att = expf(lsp + cum);
            cum += lsn;
#pragma unroll
            for (int d = 0; d < 64; ++d) o[d] += att * bf2f(vr[d]);
        }
    }
#pragma unroll
    for (int d = 0; d < 64; ++d) ymix[(mrow + t) * DM + h * 64 + d] = (bf16_t)f2bf(o[d]);
}
__device__ __forceinline__ void mla_naive_task(int qblk, int bh, int lane, const bf16_t* __restrict__ qm, const bf16_t* __restrict__ kvm, const bf16_t* __restrict__ kpe, bf16_t* __restrict__ ymix) {
    const int b = bh >> 3, h = bh & 7, t = qblk * 64 + lane;
    const size_t mrow = (size_t)b * SEQ;
    const float scale = 0.10206207261596577f;
    float q[96], o[64];
#pragma unroll
    for (int d = 0; d < 96; ++d) q[d] = bf2f(qm[(mrow + t) * 768 + h * 96 + d]) * scale;
#pragma unroll
    for (int d = 0; d < 64; ++d) o[d] = 0.f;
    float mx = -1e30f, l = 0.f;
    const int smax = qblk * 64 + 63;
    for (int s = 0; s <= smax; ++s) {
        const bf16_t* kr = kvm + (mrow + s) * 1024 + h * 128;
        const bf16_t* pr = kpe + (mrow + s) * 32;
        float z = 0.f;
#pragma unroll
        for (int d = 0; d < 64; ++d) z += q[d] * bf2f(kr[d]);
#pragma unroll
        for (int d = 0; d < 32; ++d) z += q[64 + d] * bf2f(pr[d]);
        if (s <= t) {
            const float mn = fmaxf(mx, z), f = expf(mx - mn), pz = expf(z - mn);
            l = l * f + pz; mx = mn;
#pragma unroll
            for (int d = 0; d < 64; ++d) o[d] = o[d] * f + pz * bf2f(kr[64 + d]);
        }
    }
    const float il = 1.f / l;
#pragma unroll
    for (int d = 0; d < 64; ++d) ymix[(mrow + t) * DM + 512 + h * 64 + d] = (bf16_t)f2bf(o[d] * il);
}


__device__ __forceinline__ int crow(int r, int hi) { return (r & 3) + 8 * (r >> 2) + 4 * hi; }
#define MFMA32(a, b, c) __builtin_amdgcn_mfma_f32_32x32x16_bf16((a), (b), (c), 0, 0, 0)
constexpr int STG_PITCH = 72;
__device__ __forceinline__ void transpose_tile64(const bf16_t* __restrict__ src, int sp, bf16_t* __restrict__ dst, int dp, LAS bf16_t* scr, int lane) {
#pragma unroll
    for (int i = 0; i < 8; ++i) { const int row = i * 8 + (lane >> 3), ch = lane & 7; const v4u v = *(const v4u*)(src + (size_t)row * sp + ch * 8); *(LAS v4u*)(scr + row * STG_PITCH + ch * 8) = v; }
    WSYNC();
#pragma unroll
    for (int i = 0; i < 8; ++i) { const int d = i * 8 + (lane >> 3), tc = lane & 7; const LAS bf16_t* p = scr + (tc * 8) * STG_PITCH + d;
        v4u o; o.x = (unsigned)p[0] | ((unsigned)p[STG_PITCH] << 16); o.y = (unsigned)p[2 * STG_PITCH] | ((unsigned)p[3 * STG_PITCH] << 16);
        o.z = (unsigned)p[4 * STG_PITCH] | ((unsigned)p[5 * STG_PITCH] << 16); o.w = (unsigned)p[6 * STG_PITCH] | ((unsigned)p[7 * STG_PITCH] << 16);
        *(v4u*)(dst + (size_t)d * dp + tc * 8) = o; }
    WSYNC();
}
__device__ __forceinline__ void store_OT(const f32x16 (&o)[2], float sc, LAS bf16_t* stg, bf16_t* __restrict__ dst, int lane) {
    const int l31 = lane & 31, hi = lane >> 5;
#pragma unroll
    for (int dt = 0; dt < 2; ++dt)
#pragma unroll
        for (int r = 0; r < 16; ++r) stg[l31 * STG_PITCH + 32 * dt + crow(r, hi)] = bf1(o[dt][r] * sc);
    WSYNC();
#pragma unroll
    for (int i = 0; i < 4; ++i) { const int row = i * 8 + (lane >> 3), ch = lane & 7; const v4u v = *(const LAS v4u*)(stg + row * STG_PITCH + ch * 8); *(v4u*)(dst + (size_t)row * DM + ch * 8) = v; }
    WSYNC();
}
__device__ __forceinline__ float softplus_fast(float z) { return fmaxf(z, 0.f) + __logf(1.f + __expf(-fabsf(z))); }

__device__ __forceinline__ void sb_task(int bh, int qblk, int lane, const bf16_t* __restrict__ P1, const bf16_t* __restrict__ VT, bf16_t* __restrict__ ymix, LAS bf16_t* stg) {
    const int b = bh >> 3, h = bh & 7, l31 = lane & 31, hi = lane >> 5, q0 = qblk * 32, t = q0 + l31;
    const size_t rowb = (size_t)b * SEQ;
    const bf16_t* Qp = P1 + (rowb + q0 + l31) * L1P + h * 64 + 8 * hi;
    bf16x8 qf[4];
#pragma unroll
    for (int kk = 0; kk < 4; ++kk) qf[kk] = *(const bf16x8*)(Qp + 16 * kk);
    const bf16_t* Kp = P1 + (rowb + l31) * L1P + 512 + h * 64 + 8 * hi;
    const bf16_t* Vp = VT + ((size_t)bh * 64 + l31) * SEQ + 4 * hi;
    f32x16 o[2];
#pragma unroll
    for (int r = 0; r < 16; ++r) { o[0][r] = 0.f; o[1][r] = 0.f; }
    float cum = 0.f;
    bf16x8 kf[4]; u32x2 va[2][2][2];
#define SB_LOAD(S0, KF, VA) do { _Pragma("unroll") for (int kk = 0; kk < 4; ++kk) KF[kk] = *(const bf16x8*)(Kp + (size_t)(S0) * L1P + 16 * kk); \
        _Pragma("unroll") for (int dt = 0; dt < 2; ++dt) _Pragma("unroll") for (int ks = 0; ks < 2; ++ks) { VA[dt][ks][0] = *(const u32x2*)(Vp + (size_t)dt * 32 * SEQ + (S0) + 16 * ks); VA[dt][ks][1] = *(const u32x2*)(Vp + (size_t)dt * 32 * SEQ + (S0) + 16 * ks + 8); } } while (0)
    SB_LOAD(q0, kf, va);
    for (int s0 = q0; s0 >= 0; s0 -= 32) {
        bf16x8 kn[4]; u32x2 vn[2][2][2];
        const int sn = (s0 >= 32) ? s0 - 32 : 0;
        SB_LOAD(sn, kn, vn);
        f32x16 acc;
#pragma unroll
        for (int r = 0; r < 16; ++r) acc[r] = 0.f;
#pragma unroll
        for (int kk = 0; kk < 4; ++kk) acc = MFMA32(kf[kk], qf[kk], acc);
        const bool diag = (s0 == q0);
        float lb[16], lk[16];
#pragma unroll
        for (int r = 0; r < 16; ++r) { const float z = acc[r] * 0.125f; const float sp = softplus_fast(z); float b_ = z - sp, k_ = -sp;
            if (diag) { const bool valid = (s0 + crow(r, hi)) < t; b_ = valid ? b_ : -1e30f; k_ = valid ? k_ : 0.f; }
            lb[r] = b_; lk[r] = k_; }
        float e[16], T[4], U[4];
#pragma unroll
        for (int i = 0; i < 4; ++i) { e[4 * i + 3] = 0.f; e[4 * i + 2] = lk[4 * i + 3]; e[4 * i + 1] = e[4 * i + 2] + lk[4 * i + 2]; e[4 * i] = e[4 * i + 1] + lk[4 * i + 1]; T[i] = e[4 * i] + lk[4 * i]; }
#pragma unroll
        for (int i = 0; i < 4; ++i) U[i] = __shfl_xor(T[i], 32);
        float off[4];
        { const float st2 = T[3], st1 = st2 + T[2], st0 = st1 + T[1]; const float su2 = U[3], su1 = su2 + U[2], su0 = su1 + U[1];
          const float x0 = hi ? 0.f : U[0], x1 = hi ? 0.f : U[1], x2 = hi ? 0.f : U[2], x3 = hi ? 0.f : U[3];
          off[3] = x3; off[2] = st2 + su2 + x2; off[1] = st1 + su1 + x1; off[0] = st0 + su0 + x0;
          const float total = st0 + T[0] + su0 + U[0];
#pragma unroll
          for (int r = 0; r < 16; ++r) acc[r] = __expf(lb[r] + (cum + off[r >> 2] + e[r]));
          cum += total; }
        bf16x8 pf[2];
#pragma unroll
        for (int ks = 0; ks < 2; ++ks) { v4u w; w.x = cvtpk(acc[8 * ks], acc[8 * ks + 1]); w.y = cvtpk(acc[8 * ks + 2], acc[8 * ks + 3]); w.z = cvtpk(acc[8 * ks + 4], acc[8 * ks + 5]); w.w = cvtpk(acc[8 * ks + 6], acc[8 * ks + 7]); pf[ks] = __builtin_bit_cast(bf16x8, w); }
#pragma unroll
        for (int dt = 0; dt < 2; ++dt)
#pragma unroll
            for (int ks = 0; ks < 2; ++ks) { v4u a; a.x = va[dt][ks][0].x; a.y = va[dt][ks][0].y; a.z = va[dt][ks][1].x; a.w = va[dt][ks][1].y; o[dt] = MFMA32(__builtin_bit_cast(bf16x8, a), pf[ks], o[dt]); }
        if (__all(cum < -110.f)) break;
#pragma unroll
        for (int kk = 0; kk < 4; ++kk) kf[kk] = kn[kk];
#pragma unroll
        for (int dt = 0; dt < 2; ++dt)
#pragma unroll
            for (int ks = 0; ks < 2; ++ks) { va[dt][ks][0] = vn[dt][ks][0]; va[dt][ks][1] = vn[dt][ks][1]; }
    }
#undef SB_LOAD
    store_OT(o, 1.0f, stg, ymix + (rowb + q0) * DM + h * 64, lane);
}
__device__ __forceinline__ void mla_task(int bh, int qblk, int lane, const bf16_t* __restrict__ QM, const bf16_t* __restrict__ KVM, const bf16_t* __restrict__ KPE, const bf16_t* __restrict__ VT,
                                         bf16_t* __restrict__ ymix, LAS bf16_t* stg) {
    const int b = bh >> 3, h = bh & 7, l31 = lane & 31, hi = lane >> 5, q0 = qblk * 32, t = q0 + l31;
    const size_t rowb = (size_t)b * SEQ;
    const bf16_t* Qp = QM + (rowb + q0 + l31) * 768 + h * 96 + 8 * hi;
    bf16x8 qf[6];
#pragma unroll
    for (int kk = 0; kk < 6; ++kk) qf[kk] = *(const bf16x8*)(Qp + 16 * kk);
    const bf16_t* Kn = KVM + (rowb + l31) * 1024 + h * 128 + 8 * hi;
    const bf16_t* Kr = KPE + (rowb + l31) * 32 + 8 * hi;
    const bf16_t* Vp = VT + ((size_t)bh * 64 + l31) * SEQ + 4 * hi;
    const float sc2 = 0.10206207261596577f * 1.4426950408889634f;
    f32x16 o[2];
#pragma unroll
    for (int r = 0; r < 16; ++r) { o[0][r] = 0.f; o[1][r] = 0.f; }
    float mrun = -1e30f, lsum = 0.f;
    bf16x8 kf[6]; u32x2 va[2][2][2];
#define ML_LOAD(S0, KF, VA) do { _Pragma("unroll") for (int kk = 0; kk < 4; ++kk) KF[kk] = *(const bf16x8*)(Kn + (size_t)(S0) * 1024 + 16 * kk); \
        _Pragma("unroll") for (int kk = 0; kk < 2; ++kk) KF[4 + kk] = *(const bf16x8*)(Kr + (size_t)(S0) * 32 + 16 * kk); \
        _Pragma("unroll") for (int dt = 0; dt < 2; ++dt) _Pragma("unroll") for (int ks = 0; ks < 2; ++ks) { VA[dt][ks][0] = *(const u32x2*)(Vp + (size_t)dt * 32 * SEQ + (S0) + 16 * ks); VA[dt][ks][1] = *(const u32x2*)(Vp + (size_t)dt * 32 * SEQ + (S0) + 16 * ks + 8); } } while (0)
    ML_LOAD(0, kf, va);
    for (int s0 = 0; s0 <= q0; s0 += 32) {
        bf16x8 kn[6]; u32x2 vn[2][2][2];
        const int sn = (s0 + 32 <= q0) ? s0 + 32 : s0;
        ML_LOAD(sn, kn, vn);
        f32x16 acc;
#pragma unroll
        for (int r = 0; r < 16; ++r) acc[r] = 0.f;
#pragma unroll
        for (int kk = 0; kk < 6; ++kk) acc = MFMA32(kf[kk], qf[kk], acc);
        const bool diag = (s0 == q0);
        float tmax = -1e30f;
#pragma unroll
        for (int r = 0; r < 16; ++r) { float z = acc[r] * sc2; if (diag && (s0 + crow(r, hi)) > t) z = -1e30f; acc[r] = z; tmax = fmaxf(tmax, z); }
        tmax = fmaxf(tmax, __shfl_xor(tmax, 32));
        const float mn = fmaxf(mrun, tmax), alpha = exp2f(mrun - mn); mrun = mn;
        float ps = 0.f;
#pragma unroll
        for (int r = 0; r < 16; ++r) { acc[r] = exp2f(acc[r] - mn); ps += acc[r]; }
        lsum = lsum * alpha + ps;
#pragma unroll
        for (int r = 0; r < 16; ++r) { o[0][r] *= alpha; o[1][r] *= alpha; }
        bf16x8 pf[2];
#pragma unroll
        for (int ks = 0; ks < 2; ++ks) { v4u w; w.x = cvtpk(acc[8 * ks], acc[8 * ks + 1]); w.y = cvtpk(acc[8 * ks + 2], acc[8 * ks + 3]); w.z = cvtpk(acc[8 * ks + 4], acc[8 * ks + 5]); w.w = cvtpk(acc[8 * ks + 6], acc[8 * ks + 7]); pf[ks] = __builtin_bit_cast(bf16x8, w); }
#pragma unroll
        for (int dt = 0; dt < 2; ++dt)
#pragma unroll
            for (int ks = 0; ks < 2; ++ks) { v4u a; a.x = va[dt][ks][0].x; a.y = va[dt][ks][0].y; a.z = va[dt][ks][1].x; a.w = va[dt][ks][1].y; o[dt] = MFMA32(__builtin_bit_cast(bf16x8, a), pf[ks], o[dt]); }
#pragma unroll
        for (int kk = 0; kk < 6; ++kk) kf[kk] = kn[kk];
#pragma unroll
        for (int dt = 0; dt < 2; ++dt)
#pragma unroll
            for (int ks = 0; ks < 2; ++ks) { va[dt][ks][0] = vn[dt][ks][0]; va[dt][ks][1] = vn[dt][ks][1]; }
    }
#undef ML_LOAD
    lsum += __shfl_xor(lsum, 32);
    store_OT(o, 1.0f / lsum, stg, ymix + (rowb + q0) * DM + 512 + h * 64, lane);
}


__device__ __forceinline__ void sb_wave(int bh, int qblk, int lane, const bf16_t* __restrict__ P1, const bf16_t* __restrict__ VT, bf16_t* __restrict__ ymix, LAS unsigned char* wl) {
    const int b = bh >> 3, h = bh & 7, l31 = lane & 31, hi = lane >> 5, q0 = qblk * 32, t = q0 + l31;
    const size_t rowb = (size_t)b * SEQ;
    bf16x8 qf[4];
    { const bf16_t* Qp = P1 + (rowb + q0 + l31) * L1P + h * 64 + 8 * hi;
#pragma unroll
      for (int kk = 0; kk < 4; ++kk) qf[kk] = *(const bf16x8*)(Qp + 16 * kk); }
    f32x16 o[2];
#pragma unroll
    for (int r = 0; r < 16; ++r) { o[0][r] = 0.f; o[1][r] = 0.f; }
    float cum = 1.f;
    const bf16_t* gK = P1 + (rowb + (lane >> 3)) * L1P + 512 + h * 64 + (lane & 7) * 8;
    const bf16_t* gV = VT + ((size_t)bh * 64 + (lane >> 2)) * SEQ + (lane & 3) * 8;
    const int lK = (lane >> 3) * 144 + (lane & 7) * 16, lV = 4608 + (lane >> 2) * 72 + (lane & 3) * 16;
    v4u rk[4], rv[4];
#pragma unroll
    for (int i = 0; i < 4; ++i) { rk[i] = *(const v4u*)(gK + (size_t)(q0 + 8 * i) * L1P); rv[i] = *(const v4u*)(gV + (size_t)(16 * i) * SEQ + q0); }
#pragma unroll 1
    for (int s0 = q0; s0 >= 0; s0 -= 32) {
#pragma unroll
        for (int i = 0; i < 4; ++i) { *(LAS v4u*)(wl + lK + i * 8 * 144) = rk[i]; *(LAS u32x2*)(wl + lV + i * 16 * 72) = (u32x2){rv[i].x, rv[i].y}; *(LAS u32x2*)(wl + lV + i * 16 * 72 + 8) = (u32x2){rv[i].z, rv[i].w}; }
        { const int sn = (s0 >= 32) ? s0 - 32 : 0;
#pragma unroll
          for (int i = 0; i < 4; ++i) { rk[i] = *(const v4u*)(gK + (size_t)(sn + 8 * i) * L1P); rv[i] = *(const v4u*)(gV + (size_t)(16 * i) * SEQ + sn); } }
        WSYNC();
        f32x16 acc;
#pragma unroll
        for (int r = 0; r < 16; ++r) acc[r] = 0.f;
#pragma unroll
        for (int kk = 0; kk < 4; ++kk) { const bf16x8 kf = *(const LAS bf16x8*)(wl + l31 * 144 + (16 * kk + 8 * hi) * 2); acc = MFMA32(kf, qf[kk], acc); }
        const bool diag = (s0 == q0);
        float bt[16], kp[16];
#pragma unroll
        for (int r = 0; r < 16; ++r) { const float ee = __builtin_amdgcn_exp2f(fminf(acc[r] * (-0.125f * 1.4426950408889634f), 100.f)); const float ri = __builtin_amdgcn_rcpf(1.f + ee);
            float b_ = ri, k_ = ee * ri;
            if (diag) { const bool valid = (s0 + crow(r, hi)) < t; b_ = valid ? b_ : 0.f; k_ = valid ? k_ : 1.f; }
            bt[r] = b_; kp[r] = k_; }
        float e[16], T[4], U[4];
#pragma unroll
        for (int q = 0; q < 4; ++q) { e[4 * q + 3] = 1.f; e[4 * q + 2] = kp[4 * q + 3]; e[4 * q + 1] = e[4 * q + 2] * kp[4 * q + 2]; e[4 * q] = e[4 * q + 1] * kp[4 * q + 1]; T[q] = e[4 * q] * kp[4 * q]; }
#pragma unroll
        for (int q = 0; q < 4; ++q) U[q] = __shfl_xor(T[q], 32);
        { const float st2 = T[3], st1 = st2 * T[2], st0 = st1 * T[1]; const float su2 = U[3], su1 = su2 * U[2], su0 = su1 * U[1];
          const float x0 = hi ? 1.f : U[0], x1 = hi ? 1.f : U[1], x2 = hi ? 1.f : U[2], x3 = hi ? 1.f : U[3];
          const float off[4] = {cum * (st0 * su0 * x0), cum * (st1 * su1 * x1), cum * (st2 * su2 * x2), cum * x3};
#pragma unroll
          for (int r = 0; r < 16; ++r) acc[r] = bt[r] * (off[r >> 2] * e[r]);
          cum *= (st0 * T[0]) * (su0 * U[0]); }
        bf16x8 pf[2];
#pragma unroll
        for (int ks = 0; ks < 2; ++ks) pf[ks] = pack8(acc[8 * ks], acc[8 * ks + 1], acc[8 * ks + 2], acc[8 * ks + 3], acc[8 * ks + 4], acc[8 * ks + 5], acc[8 * ks + 6], acc[8 * ks + 7]);
#pragma unroll
        for (int dt = 0; dt < 2; ++dt)
#pragma unroll
            for (int ks = 0; ks < 2; ++ks) { const LAS unsigned char* vp = wl + 4608 + (32 * dt + l31) * 72 + (16 * ks + 4 * hi) * 2;
                const u32x2 x0 = *(const LAS u32x2*)vp, x1 = *(const LAS u32x2*)(vp + 16);
                v4u a; a.x = x0.x; a.y = x0.y; a.z = x1.x; a.w = x1.y; o[dt] = MFMA32(__builtin_bit_cast(bf16x8, a), pf[ks], o[dt]); }
        WSYNC();
        if (__all(cum < 1e-35f)) break;
    }
    store_OT(o, 1.0f, (LAS bf16_t*)(wl + 9216), ymix + (rowb + q0) * DM + h * 64, lane);
}

constexpr int MLK_PITCH = 104, MLV_PITCH = 68, MLK_BYTES = 64 * MLK_PITCH * 2, MLV_BYTES = 64 * MLV_PITCH * 2, ML_STAGE = MLK_BYTES + MLV_BYTES;
__device__ __forceinline__ void mla_block(int bh, int sb, int tid, int lane, int wave, LAS unsigned char* lds, const bf16_t* __restrict__ QM, const bf16_t* __restrict__ KVM, const bf16_t* __restrict__ KPE,
                                          const bf16_t* __restrict__ VT, bf16_t* __restrict__ ymix) {
    const int b = bh >> 3, h = bh & 7, l31 = lane & 31, hi = lane >> 5, q0 = 256 * sb + 32 * wave, t = q0 + l31;
    const size_t rowb = (size_t)b * SEQ;
    const int nsteps = 4 * sb + 4;
    bf16x8 qf[6];
    { const bf16_t* Qp = QM + (rowb + q0 + l31) * 768 + h * 96 + 8 * hi;
#pragma unroll
      for (int kk = 0; kk < 6; ++kk) qf[kk] = *(const bf16x8*)(Qp + 16 * kk); }
    const float sc2 = 0.10206207261596577f * 1.4426950408889634f;
    f32x16 o[2];
#pragma unroll
    for (int r = 0; r < 16; ++r) { o[0][r] = 0.f; o[1][r] = 0.f; }
    float mrun = -1e30f, lsum = 0.f;
    const bf16_t* gKn = KVM + (rowb + (tid >> 3)) * 1024 + h * 128 + (tid & 7) * 8;
    const bf16_t* gKr = KPE + (rowb + ((tid & 255) >> 2)) * 32 + (tid & 3) * 8;
    const bf16_t* gVt = VT + ((size_t)bh * 64 + (tid >> 3)) * SEQ + (tid & 7) * 8;
    const int lKn = (tid >> 3) * (MLK_PITCH * 2) + (tid & 7) * 16, lKr = ((tid & 255) >> 2) * (MLK_PITCH * 2) + 128 + (tid & 3) * 16, lVt = MLK_BYTES + (tid >> 3) * (MLV_PITCH * 2) + (tid & 7) * 16;
    v4u rk, rr, rv;
    rk = *(const v4u*)gKn; rr = *(const v4u*)gKr; rv = *(const v4u*)gVt;
    *(LAS v4u*)(lds + lKn) = rk; if (tid < 256) *(LAS v4u*)(lds + lKr) = rr; *(LAS u32x2*)(lds + lVt) = (u32x2){rv.x, rv.y}; *(LAS u32x2*)(lds + lVt + 8) = (u32x2){rv.z, rv.w};
    __syncthreads();
#pragma unroll 1
    for (int step = 0; step < nsteps; ++step) {
        const int nx = (step + 1 < nsteps) ? step + 1 : step;
        rk = *(const v4u*)(gKn + (size_t)nx * 64 * 1024); rr = *(const v4u*)(gKr + (size_t)nx * 64 * 32); rv = *(const v4u*)(gVt + nx * 64);
        const LAS unsigned char* Kb = lds + (step & 1) * ML_STAGE;
        const LAS unsigned char* Vb = Kb + MLK_BYTES;
        if (64 * step <= q0) {
            f32x16 acc[2];
#pragma unroll
            for (int sub = 0; sub < 2; ++sub) {
#pragma unroll
                for (int r = 0; r < 16; ++r) acc[sub][r] = 0.f;
#pragma unroll
                for (int kk = 0; kk < 6; ++kk) { const bf16x8 kf = *(const LAS bf16x8*)(Kb + (32 * sub + l31) * (MLK_PITCH * 2) + (16 * kk + 8 * hi) * 2); acc[sub] = MFMA32(kf, qf[kk], acc[sub]); }
            }
            float tmax = -1e30f;
#pragma unroll
            for (int sub = 0; sub < 2; ++sub) { const int s0 = 64 * step + 32 * sub;
                if (s0 + 31 > q0) {
#pragma unroll
                    for (int r = 0; r < 16; ++r) if ((s0 + crow(r, hi)) > t) acc[sub][r] = -1e30f; }
#pragma unroll
                for (int r = 0; r < 16; ++r) tmax = fmaxf(tmax, acc[sub][r]); }
            tmax = fmaxf(tmax, __shfl_xor(tmax, 32)) * sc2;
            if (__any(tmax - mrun > 6.f)) {
                const float mn = fmaxf(mrun, tmax), alpha = __builtin_amdgcn_exp2f(mrun - mn); mrun = mn; lsum *= alpha;
#pragma unroll
                for (int r = 0; r < 16; ++r) { o[0][r] *= alpha; o[1][r] *= alpha; }
            }
            float ps = 0.f;
#pragma unroll
            for (int sub = 0; sub < 2; ++sub)
#pragma unroll
                for (int r = 0; r < 16; ++r) { acc[sub][r] = __builtin_amdgcn_exp2f(acc[sub][r] * sc2 - mrun); ps += acc[sub][r]; }
            lsum += ps;
#pragma unroll
            for (int sub = 0; sub < 2; ++sub) {
                bf16x8 pf[2];
#pragma unroll
                for (int ks = 0; ks < 2; ++ks) pf[ks] = pack8(acc[sub][8 * ks], acc[sub][8 * ks + 1], acc[sub][8 * ks + 2], acc[sub][8 * ks + 3], acc[sub][8 * ks + 4], acc[sub][8 * ks + 5], acc[sub][8 * ks + 6], acc[sub][8 * ks + 7]);
#pragma unroll
                for (int dt = 0; dt < 2; ++dt)
#pragma unroll
                    for (int ks = 0; ks < 2; ++ks) { const LAS unsigned char* vp = Vb + (32 * dt + l31) * (MLV_PITCH * 2) + (32 * sub + 16 * ks + 4 * hi) * 2;
                        const u32x2 x0 = *(const LAS u32x2*)vp, x1 = *(const LAS u32x2*)(vp + 16);
                        v4u a; a.x = x0.x; a.y = x0.y; a.z = x1.x; a.w = x1.y; o[dt] = MFMA32(__builtin_bit_cast(bf16x8, a), pf[ks], o[dt]); }
            }
        }
        LAS unsigned char* nb = lds + ((step + 1) & 1) * ML_STAGE;
        *(LAS v4u*)(nb + lKn) = rk; if (tid < 256) *(LAS v4u*)(nb + lKr) = rr; *(LAS u32x2*)(nb + lVt) = (u32x2){rv.x, rv.y}; *(LAS u32x2*)(nb + lVt + 8) = (u32x2){rv.z, rv.w};
        __syncthreads();
    }
    lsum += __shfl_xor(lsum, 32);
    store_OT(o, 1.0f / lsum, (LAS bf16_t*)(lds + 2 * ML_STAGE) + wave * (32 * STG_PITCH), ymix + (rowb + q0) * DM + 512 + h * 64, lane);
    __syncthreads();
}


constexpr int SBK_PITCH = 72, SBK_BYTES = 64 * SBK_PITCH * 2, SB_STAGE = SBK_BYTES + MLV_BYTES;
__device__ __forceinline__ void sb_block(int bh, int sb, int tid, int lane, int wave, LAS unsigned char* lds, const bf16_t* __restrict__ P1, const bf16_t* __restrict__ VT, bf16_t* __restrict__ ymix) {
    const int b = bh >> 3, h = bh & 7, l31 = lane & 31, hi = lane >> 5, q0 = 256 * sb + 32 * wave, t = q0 + l31;
    const size_t rowb = (size_t)b * SEQ;
    bf16x8 qf[4];
    { const bf16_t* Qp = P1 + (rowb + q0 + l31) * L1P + h * 64 + 8 * hi;
#pragma unroll
      for (int kk = 0; kk < 4; ++kk) qf[kk] = *(const bf16x8*)(Qp + 16 * kk); }
    f32x16 o[2];
#pragma unroll
    for (int r = 0; r < 16; ++r) { o[0][r] = 0.f; o[1][r] = 0.f; }
    float cum = 1.f; bool done = false;
    volatile LAS unsigned* flags = (volatile LAS unsigned*)(lds + 2 * SB_STAGE);
    const bf16_t* gK = P1 + (rowb + (tid >> 3)) * L1P + 512 + h * 64 + (tid & 7) * 8;
    const bf16_t* gVt = VT + ((size_t)bh * 64 + (tid >> 3)) * SEQ + (tid & 7) * 8;
    const int lK = (tid >> 3) * (SBK_PITCH * 2) + (tid & 7) * 16, lVt = SBK_BYTES + (tid >> 3) * (MLV_PITCH * 2) + (tid & 7) * 16;
    const int top = 4 * sb + 3;
    v4u rk, rv;
    rk = *(const v4u*)(gK + (size_t)top * 64 * L1P); rv = *(const v4u*)(gVt + top * 64);
    *(LAS v4u*)(lds + lK) = rk; *(LAS u32x2*)(lds + lVt) = (u32x2){rv.x, rv.y}; *(LAS u32x2*)(lds + lVt + 8) = (u32x2){rv.z, rv.w};
    __syncthreads();
#pragma unroll 1
    for (int i = 0; i <= top; ++i) {
        const int step = top - i, nx = (step > 0) ? step - 1 : 0;
        rk = *(const v4u*)(gK + (size_t)nx * 64 * L1P); rv = *(const v4u*)(gVt + nx * 64);
        const LAS unsigned char* Kb = lds + (i & 1) * SB_STAGE;
        const LAS unsigned char* Vb = Kb + SBK_BYTES;
#pragma unroll
        for (int sub = 1; sub >= 0; --sub) {
            const int s0 = 64 * step + 32 * sub;
            if (s0 <= q0 && !done) {
                f32x16 acc;
#pragma unroll
                for (int r = 0; r < 16; ++r) acc[r] = 0.f;
#pragma unroll
                for (int kk = 0; kk < 4; ++kk) { const bf16x8 kf = *(const LAS bf16x8*)(Kb + (32 * sub + l31) * (SBK_PITCH * 2) + (16 * kk + 8 * hi) * 2); acc = MFMA32(kf, qf[kk], acc); }
                const bool diag = (s0 == q0);
                float bt[16], kp[16];
#pragma unroll
                for (int r = 0; r < 16; ++r) { const float ee = __builtin_amdgcn_exp2f(fminf(acc[r] * (-0.125f * 1.4426950408889634f), 100.f)); const float ri = __builtin_amdgcn_rcpf(1.f + ee);
                    float b_ = ri, k_ = ee * ri;
                    if (diag) { const bool valid = (s0 + crow(r, hi)) < t; b_ = valid ? b_ : 0.f; k_ = valid ? k_ : 1.f; }
                    bt[r] = b_; kp[r] = k_; }
                float e[16], T[4], U[4];
#pragma unroll
                for (int q = 0; q < 4; ++q) { e[4 * q + 3] = 1.f; e[4 * q + 2] = kp[4 * q + 3]; e[4 * q + 1] = e[4 * q + 2] * kp[4 * q + 2]; e[4 * q] = e[4 * q + 1] * kp[4 * q + 1]; T[q] = e[4 * q] * kp[4 * q]; }
#pragma unroll
                for (int q = 0; q < 4; ++q) U[q] = __shfl_xor(T[q], 32);
                { const float st2 = T[3], st1 = st2 * T[2], st0 = st1 * T[1]; const float su2 = U[3], su1 = su2 * U[2], su0 = su1 * U[1];
                  const float x0 = hi ? 1.f : U[0], x1 = hi ? 1.f : U[1], x2 = hi ? 1.f : U[2], x3 = hi ? 1.f : U[3];
                  const float off[4] = {cum * (st0 * su0 * x0), cum * (st1 * su1 * x1), cum * (st2 * su2 * x2), cum * x3};
#pragma unroll
                  for (int r = 0; r < 16; ++r) acc[r] = bt[r] * (off[r >> 2] * e[r]);
                  cum *= (st0 * T[0]) * (su0 * U[0]); }
                bf16x8 pf[2];
#pragma unroll
                for (int ks = 0; ks < 2; ++ks) { v4u w; w.x = cvtpk(acc[8 * ks], acc[8 * ks + 1]); w.y = cvtpk(acc[8 * ks + 2], acc[8 * ks + 3]); w.z = cvtpk(acc[8 * ks + 4], acc[8 * ks + 5]); w.w = cvtpk(acc[8 * ks + 6], acc[8 * ks + 7]); pf[ks] = __builtin_bit_cast(bf16x8, w); }
#pragma unroll
                for (int dt = 0; dt < 2; ++dt)
#pragma unroll
                    for (int ks = 0; ks < 2; ++ks) { const LAS unsigned char* vp = Vb + (32 * dt + l31) * (MLV_PITCH * 2) + (32 * sub + 16 * ks + 4 * hi) * 2;
                        const u32x2 x0 = *(const LAS u32x2*)vp, x1 = *(const LAS u32x2*)(vp + 16);
                        v4u a; a.x = x0.x; a.y = x0.y; a.z = x1.x; a.w = x1.y; o[dt] = MFMA32(__builtin_bit_cast(bf16x8, a), pf[ks], o[dt]); }
                done = __all(cum < 1e-35f);
            }
        }
        if (lane == 0) flags[(i & 1) * 8 + wave] = done ? 1u : 0u;
        LAS unsigned char* nb = lds + ((i + 1) & 1) * SB_STAGE;
        *(LAS v4u*)(nb + lK) = rk; *(LAS u32x2*)(nb + lVt) = (u32x2){rv.x, rv.y}; *(LAS u32x2*)(nb + lVt + 8) = (u32x2){rv.z, rv.w};
        __syncthreads();
        unsigned nd = 0;
#pragma unroll
        for (int w8 = 0; w8 < 8; ++w8) nd += flags[(i & 1) * 8 + w8];
        if (nd == 8u) break;
    }
    store_OT(o, 1.0f, (LAS bf16_t*)(lds + 2 * SB_STAGE + 256) + wave * (32 * STG_PITCH), ymix + (rowb + q0) * DM + h * 64, lane);
    __syncthreads();
}

constexpr int RW_RAWW = 0, RW_RAWA = 2048, RW_RS = 4096, RW_KS = 6144, RW_VS = 8192;
constexpr int RW_CH0 = 10240, RW_CHSZ = 11328;
constexpr int RW_YB = RW_CH0 + 2 * RW_CHSZ;
constexpr int RW_MIX = RW_YB + 1024;
static_assert((RW_MIX + 256) * 4 <= 146432, "rwkv LDS map");
__device__ __forceinline__ float tanh_fast(float x) { return 1.f - 2.f * __builtin_amdgcn_rcpf(1.f + __expf(2.f * x)); }
__device__ __forceinline__ float sigmoid_fast(float x) { return __builtin_amdgcn_rcpf(1.f + __expf(-x)); }

#define MFMA16(a, b, c) __builtin_amdgcn_mfma_f32_16x16x32_bf16((a), (b), (c), 0, 0, 0)
constexpr int RW2_CH0 = 0, RW2_YB = 2 * RW_CHSZ, RW2_MIX = RW2_YB + 1024, RW2_STG = RW2_MIX + 448;
static_assert((RW2_STG + 2 * 3072) * 4 <= 146432, "rwkv LDS map");
__device__ __forceinline__ void rwkv_phase_scan(LAS float* sm, int tid, int lane, int wave, int blk, const bf16_t* __restrict__ proj, const float* __restrict__ mix, const float* __restrict__ w0, const float* __restrict__ a0,
                                           const float* __restrict__ k_k, const float* __restrict__ k_a, const float* __restrict__ r_k, const bf16_t* __restrict__ W2T, const bf16_t* __restrict__ A2T, const bf16_t* __restrict__ G2T,
                                           float* __restrict__ yraw, bf16_t* __restrict__ gout, float* __restrict__ bonus_out) {
    const int chain = blk >> 1, half = blk & 1, b = chain >> 3, h = chain & 7, l15 = lane & 15, kg = lane >> 4;
    const size_t rowb = (size_t)b * SEQ;
    constexpr int NCHUNK = SEQ / 32;
    if (tid < 256) sm[RW2_MIX + tid] = mix[1536 + tid];
    else if (tid < 448) { const int q = tid - 256; sm[RW2_MIX + tid] = mix[512 * (q >> 6) + h * 64 + (q & 63)]; }
    __syncthreads();
#define RW_SH8(CUR, PRV, M0, M1, OUT, PZ) do { const unsigned cu_[4] = {(CUR).x, (CUR).y, (CUR).z, (CUR).w}, pu_[4] = {(PRV).x, (PRV).y, (PRV).z, (PRV).w}; \
        const float mm_[8] = {(M0)[0], (M0)[1], (M0)[2], (M0)[3], (M1)[0], (M1)[1], (M1)[2], (M1)[3]}; \
        _Pragma("unroll") for (int q = 0; q < 4; ++q) { const float c0 = bflo(cu_[q]), c1 = bfhi(cu_[q]), p0 = bflo(pu_[q]) * (PZ), p1 = bfhi(pu_[q]) * (PZ); \
            OUT[2 * q] = c0 + (p0 - c0) * mm_[2 * q]; OUT[2 * q + 1] = c1 + (p1 - c1) * mm_[2 * q + 1]; } } while (0)
    if (wave < 4) {
        const int iA = 8 * wave + kg, iB = iA + 4, jseg = l15;
        float A0 = 0.f, A1 = 0.f, A2 = 0.f, A3 = 0.f, B0 = 0.f, B1 = 0.f, B2 = 0.f, B3 = 0.f;
        __syncthreads();
#pragma unroll 1
        for (int ch = 0; ch < NCHUNK; ++ch) {
            const int t0 = ch * 32;
            const LAS float* CHb = sm + RW2_CH0 + (ch & 1) * RW_CHSZ + 4 * jseg;
            const LAS float* CHv = sm + RW2_CH0 + (ch & 1) * RW_CHSZ + 10240 + iA;
            const LAS float* CHs = sm + RW2_CH0 + (ch & 1) * RW_CHSZ + 11264;
            f32x4 a4 = *(const LAS f32x4*)(CHb + 4096), wr4 = *(const LAS f32x4*)(CHb + 8192), w4 = *(const LAS f32x4*)(CHb), b4 = *(const LAS f32x4*)(CHb + 6144), k4 = *(const LAS f32x4*)(CHb + 2048);
            float vA = CHv[0], vB = CHv[4]; f32x2_t sc = *(const LAS f32x2_t*)(CHs);
#pragma unroll 2
            for (int t = 0; t < 32; ++t) {
                const int tq = (t + 1) & 31;
                const f32x4 a4n = *(const LAS f32x4*)(CHb + 4096 + tq * 64), wr4n = *(const LAS f32x4*)(CHb + 8192 + tq * 64), w4n = *(const LAS f32x4*)(CHb + tq * 64),
                            b4n = *(const LAS f32x4*)(CHb + 6144 + tq * 64), k4n = *(const LAS f32x4*)(CHb + 2048 + tq * 64);
                const float vAn = CHv[tq * 32], vBn = CHv[tq * 32 + 4]; const f32x2_t scn = *(const LAS f32x2_t*)(CHs + 2 * tq);
                float d1A = (A0 * a4[0] + A1 * a4[1]) + (A2 * a4[2] + A3 * a4[3]), d1B = (B0 * a4[0] + B1 * a4[1]) + (B2 * a4[2] + B3 * a4[3]);
                float d2A = (A0 * wr4[0] + A1 * wr4[1]) + (A2 * wr4[2] + A3 * wr4[3]), d2B = (B0 * wr4[0] + B1 * wr4[1]) + (B2 * wr4[2] + B3 * wr4[3]);
                d1A = rowsum16(d1A); d1B = rowsum16(d1B); d2A = rowsum16(d2A); d2B = rowsum16(d2B);
                const float yA = d2A + d1A * sc[0] + vA * sc[1], yB = d2B + d1B * sc[0] + vB * sc[1];
                A0 = A0 * w4[0] + (d1A * b4[0] + vA * k4[0]); A1 = A1 * w4[1] + (d1A * b4[1] + vA * k4[1]); A2 = A2 * w4[2] + (d1A * b4[2] + vA * k4[2]); A3 = A3 * w4[3] + (d1A * b4[3] + vA * k4[3]);
                B0 = B0 * w4[0] + (d1B * b4[0] + vB * k4[0]); B1 = B1 * w4[1] + (d1B * b4[1] + vB * k4[1]); B2 = B2 * w4[2] + (d1B * b4[2] + vB * k4[2]); B3 = B3 * w4[3] + (d1B * b4[3] + vB * k4[3]);
                if (jseg == 0) { sm[RW2_YB + t * 32 + iA] = yA; sm[RW2_YB + t * 32 + iB] = yB; }
                a4 = a4n; wr4 = wr4n; w4 = w4n; b4 = b4n; k4 = k4n; vA = vAn; vB = vBn; sc = scn;
            }
            WSYNC();
            { const int tt = lane >> 1, hh = lane & 1; const f32x4 yv = *(const LAS f32x4*)(sm + RW2_YB + tt * 32 + 8 * wave + 4 * hh);
              *(f32x4*)(yraw + (rowb + t0 + tt) * 512 + h * 64 + half * 32 + 8 * wave + 4 * hh) = yv; }
            __syncthreads();
        }
    } else if (wave < 6) {
        const int tp = wave - 4, tb = 16 * tp;
        LAS float* stg = sm + RW2_STG + tp * 3072;
        float w0c[4], a0c[4], kkc[4], kac[4], rkc[4];
#pragma unroll
        for (int nt = 0; nt < 4; ++nt) { const int c = h * 64 + 16 * nt + l15; w0c[nt] = w0[c]; a0c[nt] = a0[c]; kkc[nt] = k_k[c]; kac[nt] = k_a[c]; rkc[nt] = r_k[c]; }
        v4u ld[20];
#define PREP_ISSUE(T0) do { const int t0_ = (T0); { const size_t r_ = rowb + t0_ + tb + l15; const size_t rp_ = (t0_ + tb + l15 == 0) ? r_ : r_ - 1; \
            _Pragma("unroll") for (int lo = 0; lo < 2; ++lo) _Pragma("unroll") for (int ks = 0; ks < 2; ++ks) { const int col = 1536 + 64 * lo + 32 * ks + 8 * kg; \
                ld[(lo * 2 + ks) * 2] = *(const v4u*)(proj + r_ * L0P + col); ld[(lo * 2 + ks) * 2 + 1] = *(const v4u*)(proj + rp_ * L0P + col); } } \
            _Pragma("unroll") for (int ar = 0; ar < 3; ++ar) _Pragma("unroll") for (int i = 0; i < 2; ++i) { const int p_ = lane + 64 * i, row_ = p_ >> 3, c8_ = p_ & 7; \
                const size_t r_ = rowb + t0_ + tb + row_; const size_t rp_ = (t0_ + tb + row_ == 0) ? r_ : r_ - 1; const int col = 512 * ar + h * 64 + 8 * c8_; \
                ld[8 + (ar * 2 + i) * 2] = *(const v4u*)(proj + r_ * L0P + col); ld[8 + (ar * 2 + i) * 2 + 1] = *(const v4u*)(proj + rp_ * L0P + col); } } while (0)
#define PREP_BUILD(T0, NB) do { const int t0_ = (T0); LAS float* CHn = sm + RW2_CH0 + (NB) * RW_CHSZ; \
            f32x4 accw[4], acca[4]; \
            _Pragma("unroll") for (int nt = 0; nt < 4; ++nt) { accw[nt] = (f32x4){0.f, 0.f, 0.f, 0.f}; acca[nt] = (f32x4){0.f, 0.f, 0.f, 0.f}; } \
            { const float pz_ = (t0_ + tb + l15 == 0) ? 0.f : 1.f; \
              _Pragma("unroll") for (int lo = 0; lo < 2; ++lo) _Pragma("unroll") for (int ks = 0; ks < 2; ++ks) { float s_[8]; \
                const f32x4 m0 = *(const LAS f32x4*)(sm + RW2_MIX + 64 * lo + 32 * ks + 8 * kg), m1 = *(const LAS f32x4*)(sm + RW2_MIX + 64 * lo + 32 * ks + 8 * kg + 4); \
                RW_SH8(ld[(lo * 2 + ks) * 2], ld[(lo * 2 + ks) * 2 + 1], m0, m1, s_, pz_); \
                if (lo == 0) { _Pragma("unroll") for (int j = 0; j < 8; ++j) s_[j] = tanh_fast(s_[j]); } \
                v4u aw; aw.x = cvtpk(s_[0], s_[1]); aw.y = cvtpk(s_[2], s_[3]); aw.z = cvtpk(s_[4], s_[5]); aw.w = cvtpk(s_[6], s_[7]); const bf16x8 af = __builtin_bit_cast(bf16x8, aw); \
                const bf16_t* WT = lo ? A2T : W2T; \
                _Pragma("unroll") for (int nt = 0; nt < 4; ++nt) { const bf16x8 bfr = *(const bf16x8*)(WT + (size_t)(h * 64 + 16 * nt + l15) * 64 + 32 * ks + 8 * kg); \
                    if (lo == 0) accw[nt] = MFMA16(af, bfr, accw[nt]); else acca[nt] = MFMA16(af, bfr, acca[nt]); } } } \
            _Pragma("unroll") for (int ar = 0; ar < 3; ++ar) _Pragma("unroll") for (int i = 0; i < 2; ++i) { const int p_ = lane + 64 * i, row_ = p_ >> 3, c8_ = p_ & 7; float s_[8]; \
                const float pz_ = (t0_ + tb + row_ == 0) ? 0.f : 1.f; const f32x4 m0 = *(const LAS f32x4*)(sm + RW2_MIX + 256 + ar * 64 + c8_ * 8), m1 = *(const LAS f32x4*)(sm + RW2_MIX + 256 + ar * 64 + c8_ * 8 + 4); \
                RW_SH8(ld[8 + (ar * 2 + i) * 2], ld[8 + (ar * 2 + i) * 2 + 1], m0, m1, s_, pz_); \
                *(LAS f32x4*)(stg + ar * 1024 + row_ * 64 + c8_ * 8) = (f32x4){s_[0], s_[1], s_[2], s_[3]}; *(LAS f32x4*)(stg + ar * 1024 + row_ * 64 + c8_ * 8 + 4) = (f32x4){s_[4], s_[5], s_[6], s_[7]}; } \
            WSYNC(); \
            PREP_ISSUE(((T0) + 32 < SEQ) ? (T0) + 32 : (T0)); \
            _Pragma("unroll") for (int rg = 0; rg < 4; ++rg) { const int tl = 4 * kg + rg, t = tb + tl; \
                float r_[4], k_[4], v_[4], kkv[4], nrm2 = 0.f; \
                _Pragma("unroll") for (int nt = 0; nt < 4; ++nt) { r_[nt] = stg[tl * 64 + 16 * nt + l15]; k_[nt] = stg[1024 + tl * 64 + 16 * nt + l15]; v_[nt] = stg[2048 + tl * 64 + 16 * nt + l15]; \
                    kkv[nt] = k_[nt] * kkc[nt]; nrm2 += kkv[nt] * kkv[nt]; } \
                nrm2 = rowsum16(nrm2); const float rn = __builtin_amdgcn_rsqf(fmaxf(nrm2, 1e-24f)); \
                float br = 0.f, kr = 0.f, bon = 0.f; \
                _Pragma("unroll") for (int nt = 0; nt < 4; ++nt) { const int j = 16 * nt + l15; \
                    const float wsum = w0c[nt] + accw[nt][rg]; const float logw = -softplus_fast(-wsum) - 0.5f; const float dec = __expf(-__expf(logw)); \
                    const float a_ = sigmoid_fast(a0c[nt] + acca[nt][rg]); const float kn = kkv[nt] * rn; \
                    const float k2 = k_[nt] * (1.f + (a_ - 1.f) * kac[nt]); const float bv = kn * a_; \
                    br += bv * r_[nt]; kr += k2 * r_[nt]; bon += r_[nt] * k2 * rkc[nt]; \
                    CHn[t * 64 + j] = dec; CHn[2048 + t * 64 + j] = k2; CHn[4096 + t * 64 + j] = -kn; CHn[6144 + t * 64 + j] = bv; CHn[8192 + t * 64 + j] = dec * r_[nt]; \
                    if ((nt >> 1) == half) CHn[10240 + t * 32 + (j & 31)] = v_[nt]; } \
                br = rowsum16(br); kr = rowsum16(kr); bon = rowsum16(bon); \
                if (l15 == 0) { CHn[11264 + 2 * t] = br; CHn[11264 + 2 * t + 1] = kr; if (half == 0) bonus_out[(rowb + t0_ + t) * 8 + h] = bon; } } \
            WSYNC(); } while (0)
        PREP_ISSUE(0);
        PREP_BUILD(0, 0);
        __syncthreads();
#pragma unroll 1
        for (int ch = 0; ch < NCHUNK; ++ch) {
            if (ch + 1 < NCHUNK) PREP_BUILD(ch * 32 + 32, (ch + 1) & 1);
            __syncthreads();
        }
#undef PREP_ISSUE
#undef PREP_BUILD
    } else {
        const int tp = wave - 6, tb = 16 * tp;
        v4u ld[8];
#define G_ISSUE(T0) do { const int t0_ = (T0); const size_t r_ = rowb + t0_ + tb + l15; const size_t rp_ = (t0_ + tb + l15 == 0) ? r_ : r_ - 1; \
            _Pragma("unroll") for (int ks = 0; ks < 4; ++ks) { const int col = 1664 + 32 * ks + 8 * kg; ld[2 * ks] = *(const v4u*)(proj + r_ * L0P + col); ld[2 * ks + 1] = *(const v4u*)(proj + rp_ * L0P + col); } } while (0)
#define G_BUILD(T0) do { const int t0_ = (T0); f32x4 accg[2] = {(f32x4){0.f, 0.f, 0.f, 0.f}, (f32x4){0.f, 0.f, 0.f, 0.f}}; const float pz_ = (t0_ + tb + l15 == 0) ? 0.f : 1.f; \
            _Pragma("unroll") for (int ks = 0; ks < 4; ++ks) { float s_[8]; \
                const f32x4 m0 = *(const LAS f32x4*)(sm + RW2_MIX + 128 + 32 * ks + 8 * kg), m1 = *(const LAS f32x4*)(sm + RW2_MIX + 128 + 32 * ks + 8 * kg + 4); \
                RW_SH8(ld[2 * ks], ld[2 * ks + 1], m0, m1, s_, pz_); \
                _Pragma("unroll") for (int j = 0; j < 8; ++j) s_[j] = sigmoid_fast(s_[j]); \
                v4u aw; aw.x = cvtpk(s_[0], s_[1]); aw.y = cvtpk(s_[2], s_[3]); aw.z = cvtpk(s_[4], s_[5]); aw.w = cvtpk(s_[6], s_[7]); const bf16x8 af = __builtin_bit_cast(bf16x8, aw); \
                _Pragma("unroll") for (int nt = 0; nt < 2; ++nt) { const bf16x8 bfr = *(const bf16x8*)(G2T + (size_t)(h * 64 + half * 32 + 16 * nt + l15) * 128 + 32 * ks + 8 * kg); accg[nt] = MFMA16(af, bfr, accg[nt]); } } \
            G_ISSUE(((T0) + 32 < SEQ) ? (T0) + 32 : (T0)); \
            _Pragma("unroll") for (int nt = 0; nt < 2; ++nt) _Pragma("unroll") for (int rg = 0; rg < 4; ++rg) \
                gout[(rowb + t0_ + tb + 4 * kg + rg) * 512 + h * 64 + half * 32 + 16 * nt + l15] = (bf16_t)f2bf(accg[nt][rg]); } while (0)
        G_ISSUE(0);
        G_BUILD(0);
        __syncthreads();
#pragma unroll 1
        for (int ch = 0; ch < NCHUNK; ++ch) {
            if (ch + 1 < NCHUNK) G_BUILD(ch * 32 + 32);
            __syncthreads();
        }
#undef G_ISSUE
#undef G_BUILD
    }
#undef RW_SH8
    __syncthreads();
}

constexpr int CK_BK = 0, CK_AR = 4608, CK_BBT = 9216, CK_KBT = 12288, CK_VT = 15360, CK_GC = 16896, CK_TT = 17152, CK_SLOT = 18688, CK_NSLOT = 6, CK_NBUILD = 5;
constexpr int CK_STG = CK_SLOT * CK_NSLOT;
constexpr int CK_MIX = CK_STG + CK_NBUILD * 6144;
constexpr int CK_FLAGS = CK_MIX + 448 * 4;
static_assert(CK_FLAGS + 64 <= 146432, "rwkv chunked LDS map");
__device__ __forceinline__ void rwkv_phase(LAS float* smf, int tid, int lane, int wave, int blk, const bf16_t* __restrict__ proj, const float* __restrict__ mix, const float* __restrict__ w0, const float* __restrict__ a0,
                                           const float* __restrict__ k_k, const float* __restrict__ k_a, const float* __restrict__ r_k, const bf16_t* __restrict__ W2T, const bf16_t* __restrict__ A2T, const bf16_t* __restrict__ G2T,
                                           float* __restrict__ yraw, bf16_t* __restrict__ gout, float* __restrict__ bonus_out) {
    LAS unsigned char* lds = (LAS unsigned char*)smf;
    LAS float* mixs = (LAS float*)(lds + CK_MIX);
    volatile LAS unsigned* flags = (volatile LAS unsigned*)(lds + CK_FLAGS);
    const int chain = blk >> 1, ihalf = blk & 1, b = chain >> 3, h = chain & 7, l15 = lane & 15, kg = lane >> 4, l31 = lane & 31, hi = lane >> 5;
    const size_t rowb = (size_t)b * SEQ;
    constexpr int NCH = SEQ / 16;
    if (tid < 256) mixs[tid] = mix[1536 + tid];
    else if (tid < 448) { const int q = tid - 256; mixs[tid] = mix[512 * (q >> 6) + h * 64 + (q & 63)]; }
    if (tid < 16) flags[tid] = 0u;
    for (int q = tid; q < CK_NSLOT * 384; q += NWAVES * 64) *(LAS unsigned*)(lds + (q / 384) * CK_SLOT + CK_TT + (q % 384) * 4) = 0u;
    __syncthreads();
#define RW_SH8(CUR, PRV, M0, M1, OUT, PZ) do { const unsigned cu_[4] = {(CUR).x, (CUR).y, (CUR).z, (CUR).w}, pu_[4] = {(PRV).x, (PRV).y, (PRV).z, (PRV).w}; \
        const float mm_[8] = {(M0)[0], (M0)[1], (M0)[2], (M0)[3], (M1)[0], (M1)[1], (M1)[2], (M1)[3]}; \
        _Pragma("unroll") for (int q = 0; q < 4; ++q) { const float c0 = bflo(cu_[q]), c1 = bfhi(cu_[q]), p0 = bflo(pu_[q]) * (PZ), p1 = bfhi(pu_[q]) * (PZ); \
            OUT[2 * q] = c0 + (p0 - c0) * mm_[2 * q]; OUT[2 * q + 1] = c1 + (p1 - c1) * mm_[2 * q + 1]; } } while (0)
    if (wave == 0) {
        f32x16 ST[2];
#pragma unroll
        for (int r = 0; r < 16; ++r) { ST[0][r] = 0.f; ST[1][r] = 0.f; }
#pragma unroll 1
        for (int k = 0; k < NCH; ++k) {
#if defined(PROBE_STAMPS)
            const unsigned tw0_ = (unsigned)__builtin_amdgcn_s_memrealtime();
#endif
            { const unsigned want = (unsigned)(k + 1); const int sl = k % CK_NSLOT; while (flags[sl] != want) __builtin_amdgcn_s_sleep(1); }
#if defined(PROBE_STAMPS)
            if (blk == 0 && lane == 0) ((volatile LAS unsigned*)(lds + 146432 + 320))[16 + 24] += (unsigned)__builtin_amdgcn_s_memrealtime() - tw0_;
#endif
            asm volatile("" ::: "memory");
            const LAS unsigned char* im = lds + (k % CK_NSLOT) * CK_SLOT;
            f32x16 G;
#pragma unroll
            for (int r = 0; r < 16; ++r) G[r] = 0.f;
#pragma unroll
            for (int kk = 0; kk < 4; ++kk) { const bf16x8 fa = *(const LAS bf16x8*)(im + CK_BK + l31 * 144 + (16 * kk + 8 * hi) * 2), fb = *(const LAS bf16x8*)(im + CK_AR + l31 * 144 + (16 * kk + 8 * hi) * 2); G = MFMA32(fa, fb, G); }
            { const int tcol = l31 & 15; const bool strict = l31 < 16;
#pragma unroll
              for (int r = 0; r < 16; ++r) { const int srow = crow(r & 7, hi); const bool keep = strict ? (srow < tcol) : (srow <= tcol); G[r] = keep ? G[r] : 0.f; } }
            const bf16x8 gB = pack8(G[0], G[1], G[2], G[3], G[4], G[5], G[6], G[7]), gK = pack8(G[8], G[9], G[10], G[11], G[12], G[13], G[14], G[15]);
            f32x16 XT;
#pragma unroll
            for (int r = 0; r < 16; ++r) XT[r] = 0.f;
#pragma unroll
            for (int jt = 0; jt < 2; ++jt)
#pragma unroll
                for (int sp = 0; sp < 2; ++sp) { const LAS unsigned char* ap = im + CK_AR + l31 * 144 + (32 * jt + 16 * sp + 4 * hi) * 2;
                    const u32x2 x0 = *(const LAS u32x2*)ap, x1 = *(const LAS u32x2*)(ap + 16); v4u aw; aw.x = x0.x; aw.y = x0.y; aw.z = x1.x; aw.w = x1.y;
                    const bf16x8 sb_ = pack8(ST[jt][8 * sp], ST[jt][8 * sp + 1], ST[jt][8 * sp + 2], ST[jt][8 * sp + 3], ST[jt][8 * sp + 4], ST[jt][8 * sp + 5], ST[jt][8 * sp + 6], ST[jt][8 * sp + 7]);
                    XT = MFMA32(__builtin_bit_cast(bf16x8, aw), sb_, XT); }
            bf16x8 vP;
            { const LAS unsigned char* vp = im + CK_VT + l31 * 48 + (4 * hi) * 2; const u32x2 x0 = *(const LAS u32x2*)vp, x1 = *(const LAS u32x2*)(vp + 16); v4u vw; vw.x = x0.x; vw.y = x0.y; vw.z = x1.x; vw.w = x1.y;
              vP = __builtin_bit_cast(bf16x8, vw); XT = MFMA32(gK, vP, XT); }
            bf16x8 uP;
            { const LAS unsigned char* tp = im + CK_TT + l31 * 48 + (4 * hi) * 2; const u32x2 x0 = *(const LAS u32x2*)tp, x1 = *(const LAS u32x2*)(tp + 16); v4u tw; tw.x = x0.x; tw.y = x0.y; tw.z = x1.x; tw.w = x1.y;
              f32x16 UT;
#pragma unroll
              for (int r = 0; r < 16; ++r) UT[r] = 0.f;
              UT = MFMA32(__builtin_bit_cast(bf16x8, tw), pack8(XT[0], XT[1], XT[2], XT[3], XT[4], XT[5], XT[6], XT[7]), UT);
              uP = pack8(UT[0], UT[1], UT[2], UT[3], UT[4], UT[5], UT[6], UT[7]); }
            XT = MFMA32(gB, uP, XT);
            { float* yp = yraw + (rowb + 16 * k) * 512 + h * 64 + 32 * ihalf + l31;
#pragma unroll
              for (int q = 0; q < 8; ++q) yp[(size_t)crow(q, hi) * 512] = XT[8 + q]; }
            { const LAS float* gc = (const LAS float*)(im + CK_GC);
#pragma unroll
              for (int jt = 0; jt < 2; ++jt)
#pragma unroll
                  for (int r = 0; r < 16; ++r) ST[jt][r] *= gc[32 * jt + crow(r, hi)]; }
#pragma unroll
            for (int jt = 0; jt < 2; ++jt) { const LAS unsigned char* bp = im + CK_BBT + (32 * jt + l31) * 48 + (4 * hi) * 2; const LAS unsigned char* kp = im + CK_KBT + (32 * jt + l31) * 48 + (4 * hi) * 2;
                const u32x2 b0 = *(const LAS u32x2*)bp, b1 = *(const LAS u32x2*)(bp + 16), k0 = *(const LAS u32x2*)kp, k1 = *(const LAS u32x2*)(kp + 16);
                v4u a1; a1.x = b0.x; a1.y = b0.y; a1.z = b1.x; a1.w = b1.y; v4u a2; a2.x = k0.x; a2.y = k0.y; a2.z = k1.x; a2.w = k1.y;
                ST[jt] = MFMA32(__builtin_bit_cast(bf16x8, a1), uP, ST[jt]); ST[jt] = MFMA32(__builtin_bit_cast(bf16x8, a2), vP, ST[jt]); }
            WSYNC();
            if (lane == 0) flags[8] = (unsigned)(k + 1);
        }
    } else if (wave <= CK_NBUILD) {
        const int pw = wave - 1;
        LAS bf16_t* stg = (LAS bf16_t*)(lds + CK_STG) + pw * 3072;
        float w0c[4], a0c[4], kkc[4], kac[4], rkc[4];
#pragma unroll
        for (int nt = 0; nt < 4; ++nt) { const int c = h * 64 + 16 * nt + l15; w0c[nt] = w0[c]; a0c[nt] = a0[c]; kkc[nt] = k_k[c]; kac[nt] = k_a[c]; rkc[nt] = r_k[c]; }
        v4u ld[20];
#define CK_ISSUE_A(T0) do { const int t0_ = (T0); const size_t r_ = rowb + t0_ + l15; const size_t rp_ = (t0_ + l15 == 0) ? r_ : r_ - 1; \
            _Pragma("unroll") for (int lo = 0; lo < 2; ++lo) _Pragma("unroll") for (int ks = 0; ks < 2; ++ks) { const int col = 1536 + 64 * lo + 32 * ks + 8 * kg; \
                ld[(lo * 2 + ks) * 2] = *(const v4u*)(proj + r_ * L0P + col); ld[(lo * 2 + ks) * 2 + 1] = *(const v4u*)(proj + rp_ * L0P + col); } } while (0)
#define CK_ISSUE_B(T0) do { const int t0_ = (T0); \
            _Pragma("unroll") for (int ar = 0; ar < 3; ++ar) _Pragma("unroll") for (int i = 0; i < 2; ++i) { const int p_ = lane + 64 * i, row_ = p_ >> 3, c8_ = p_ & 7; \
                const size_t r_ = rowb + t0_ + row_; const size_t rp_ = (t0_ + row_ == 0) ? r_ : r_ - 1; const int col = 512 * ar + h * 64 + 8 * c8_; \
                ld[8 + (ar * 2 + i) * 2] = *(const v4u*)(proj + r_ * L0P + col); ld[8 + (ar * 2 + i) * 2 + 1] = *(const v4u*)(proj + rp_ * L0P + col); } } while (0)
#define CK_ISSUE(T0) do { CK_ISSUE_A(T0); CK_ISSUE_B(T0); } while (0)
        CK_ISSUE(16 * pw);
#pragma unroll 1
        for (int k = pw; k < NCH; k += CK_NBUILD) {
            const int t0 = 16 * k;
#if defined(PROBE_STAMPS)
            const unsigned ts0_ = (unsigned)__builtin_amdgcn_s_memrealtime();
#endif
            f32x4 accw[4], acca[4];
#pragma unroll
            for (int nt = 0; nt < 4; ++nt) { accw[nt] = (f32x4){0.f, 0.f, 0.f, 0.f}; acca[nt] = (f32x4){0.f, 0.f, 0.f, 0.f}; }
            { const float pz_ = (t0 + l15 == 0) ? 0.f : 1.f;
#pragma unroll
              for (int lo = 0; lo < 2; ++lo)
#pragma unroll
                for (int ks = 0; ks < 2; ++ks) { float s_[8];
                    const f32x4 m0 = *(const LAS f32x4*)(mixs + 64 * lo + 32 * ks + 8 * kg), m1 = *(const LAS f32x4*)(mixs + 64 * lo + 32 * ks + 8 * kg + 4);
                    RW_SH8(ld[(lo * 2 + ks) * 2], ld[(lo * 2 + ks) * 2 + 1], m0, m1, s_, pz_);
                    if (lo == 0) {
#pragma unroll
                        for (int j = 0; j < 8; ++j) s_[j] = tanh_fast(s_[j]); }
                    const bf16x8 af = pack8(s_[0], s_[1], s_[2], s_[3], s_[4], s_[5], s_[6], s_[7]);
                    const bf16_t* WT = lo ? A2T : W2T;
#pragma unroll
                    for (int nt = 0; nt < 4; ++nt) { const bf16x8 bfr = *(const bf16x8*)(WT + (size_t)(h * 64 + 16 * nt + l15) * 64 + 32 * ks + 8 * kg);
                        if (lo == 0) accw[nt] = MFMA16(af, bfr, accw[nt]); else acca[nt] = MFMA16(af, bfr, acca[nt]); } } }
#pragma unroll
            for (int ar = 0; ar < 3; ++ar)
#pragma unroll
                for (int i = 0; i < 2; ++i) { const int p_ = lane + 64 * i, row_ = p_ >> 3, c8_ = p_ & 7; float s_[8];
                    const float pz_ = (t0 + row_ == 0) ? 0.f : 1.f; const f32x4 m0 = *(const LAS f32x4*)(mixs + 256 + ar * 64 + c8_ * 8), m1 = *(const LAS f32x4*)(mixs + 256 + ar * 64 + c8_ * 8 + 4);
                    RW_SH8(ld[8 + (ar * 2 + i) * 2], ld[8 + (ar * 2 + i) * 2 + 1], m0, m1, s_, pz_);
                    *(LAS bf16x8*)(stg + ar * 1024 + row_ * 64 + c8_ * 8) = pack8(s_[0], s_[1], s_[2], s_[3], s_[4], s_[5], s_[6], s_[7]); }
            WSYNC();
#if defined(PROBE_STAMPS)
            if (blk == 0 && wave == 1 && lane == 0) ((volatile LAS unsigned*)(lds + 146432 + 320))[16 + 26] += (unsigned)__builtin_amdgcn_s_memrealtime() - ts0_;
#endif
#if defined(PROBE_STAMPS)
            const unsigned tb0_ = (unsigned)__builtin_amdgcn_s_memrealtime();
#endif
            { const int need = k - (CK_NSLOT - 1); if (need > 0) { while ((int)flags[8] < need) __builtin_amdgcn_s_sleep(2); } }
#if defined(PROBE_STAMPS)
            if (blk == 0 && wave == 1 && lane == 0) ((volatile LAS unsigned*)(lds + 146432 + 320))[16 + 25] += (unsigned)__builtin_amdgcn_s_memrealtime() - tb0_;
#endif
            asm volatile("" ::: "memory");
            LAS unsigned char* im = lds + (k % CK_NSLOT) * CK_SLOT;
#if defined(PROBE_STAMPS)
            const unsigned ts1_ = (unsigned)__builtin_amdgcn_s_memrealtime();
#endif
            float lwv[4][4], av[4][4], knv[4][4];
#pragma unroll
            for (int rg = 0; rg < 4; ++rg) { const int tl = 4 * kg + rg;
                float kkv[4], nrm2 = 0.f, vv[4], rr_[4], kr_[4];
#pragma unroll
                for (int nt = 0; nt < 4; ++nt) { rr_[nt] = bf2f(stg[tl * 64 + 16 * nt + l15]); kr_[nt] = bf2f(stg[1024 + tl * 64 + 16 * nt + l15]); vv[nt] = bf2f(stg[2048 + tl * 64 + 16 * nt + l15]);
                    kkv[nt] = kr_[nt] * kkc[nt]; nrm2 += kkv[nt] * kkv[nt]; }
                nrm2 = rowsum16(nrm2); const float rn = __builtin_amdgcn_rsqf(fmaxf(nrm2, 1e-24f));
                float bon = 0.f;
#pragma unroll
                for (int nt = 0; nt < 4; ++nt) {
                    const float wsum = w0c[nt] + accw[nt][rg]; lwv[nt][rg] = -0.6065306597126334f * sigmoid_fast(wsum);
                    const float a_ = sigmoid_fast(a0c[nt] + acca[nt][rg]); av[nt][rg] = a_; knv[nt][rg] = kkv[nt] * rn;
                    const float k2 = kr_[nt] * (1.f + (a_ - 1.f) * kac[nt]); stg[1024 + tl * 64 + 16 * nt + l15] = bf1(k2);
                    bon += rr_[nt] * k2 * rkc[nt];
                    if ((nt >> 1) == ihalf) *(LAS bf16_t*)(im + CK_VT + (16 * (nt & 1) + l15) * 48 + tl * 2) = bf1(vv[nt]);
                }
                bon = rowsum16(bon);
                if (l15 == 0 && ihalf == 0) bonus_out[(rowb + t0 + tl) * 8 + h] = bon;
            }
            CK_ISSUE_A((k + CK_NBUILD < NCH) ? t0 + 16 * CK_NBUILD : t0);
#pragma unroll
            for (int nt = 0; nt < 4; ++nt) {
                float L[4]; L[0] = lwv[nt][0]; L[1] = L[0] + lwv[nt][1]; L[2] = L[1] + lwv[nt][2]; L[3] = L[2] + lwv[nt][3];
                const float T0 = __shfl(L[3], l15), T1 = __shfl(L[3], 16 + l15), T2 = __shfl(L[3], 32 + l15), T3 = __shfl(L[3], 48 + l15);
                const float off = (kg > 0 ? T0 : 0.f) + (kg > 1 ? T1 : 0.f) + (kg > 2 ? T2 : 0.f), LC = (T0 + T1) + (T2 + T3);
                const int j = 16 * nt + l15;
                unsigned bb2[2], kb2[2];
                const float gC = __expf(LC); float eprev = __expf(off);
#pragma unroll
                for (int rg = 0; rg < 4; ++rg) { const int tl = 4 * kg + rg; const float Lt = off + L[rg], e1 = __expf(Lt), e2 = __builtin_amdgcn_rcpf(e1), e3 = eprev, e4 = gC * e2; eprev = e1;
                    const float kn = knv[nt][rg], bvv = kn * av[nt][rg], k2 = bf2f(stg[1024 + tl * 64 + j]), rr2 = bf2f(stg[tl * 64 + j]);
                    *(LAS bf16_t*)(im + CK_BK + tl * 144 + j * 2) = bf1(bvv * e2); *(LAS bf16_t*)(im + CK_BK + (16 + tl) * 144 + j * 2) = bf1(k2 * e2);
                    *(LAS bf16_t*)(im + CK_AR + tl * 144 + j * 2) = bf1(-kn * e3); *(LAS bf16_t*)(im + CK_AR + (16 + tl) * 144 + j * 2) = bf1(rr2 * e1);
                    const unsigned bq = bf1(bvv * e4), kq = bf1(k2 * e4);
                    if (rg & 1) { bb2[rg >> 1] |= bq << 16; kb2[rg >> 1] |= kq << 16; } else { bb2[rg >> 1] = bq; kb2[rg >> 1] = kq; } }
                *(LAS u32x2*)(im + CK_BBT + j * 48 + (4 * kg) * 2) = (u32x2){bb2[0], bb2[1]}; *(LAS u32x2*)(im + CK_KBT + j * 48 + (4 * kg) * 2) = (u32x2){kb2[0], kb2[1]};
                if (kg == 0) *(LAS float*)(im + CK_GC + j * 4) = gC;
            }
            WSYNC();
#if defined(PROBE_STAMPS)
            const unsigned ts2_ = (unsigned)__builtin_amdgcn_s_memrealtime();
            if (blk == 0 && wave == 1 && lane == 0) ((volatile LAS unsigned*)(lds + 146432 + 320))[16 + 27] += ts2_ - ts1_;
#endif
            {
                f32x4 nacc = {0.f, 0.f, 0.f, 0.f};
#pragma unroll
                for (int ks = 0; ks < 2; ++ks) { const bf16x8 fa = *(const LAS bf16x8*)(im + CK_BK + l15 * 144 + (32 * ks + 8 * kg) * 2), fb = *(const LAS bf16x8*)(im + CK_AR + l15 * 144 + (32 * ks + 8 * kg) * 2); nacc = MFMA16(fa, fb, nacc); }
#pragma unroll
                for (int rg = 0; rg < 4; ++rg) nacc[rg] = ((4 * kg + rg) < l15) ? nacc[rg] : 0.f;
                float Tr[16];
#pragma unroll
                for (int t = 0; t < 16; ++t) { float acc_ = (l15 == t) ? 1.f : 0.f;
#pragma unroll
                    for (int s2 = 0; s2 < t; ++s2) acc_ += Tr[s2] * rl(nacc[s2 & 3], t + 16 * (s2 >> 2));
                    Tr[t] = acc_; }
                if (kg == 0) {
#pragma unroll
                    for (int t = 0; t < 16; ++t) *(LAS bf16_t*)(im + CK_TT + t * 48 + l15 * 2) = bf1(Tr[t]); }
            }
            WSYNC();
#if defined(PROBE_STAMPS)
            if (blk == 0 && wave == 1 && lane == 0) ((volatile LAS unsigned*)(lds + 146432 + 320))[16 + 28] += (unsigned)__builtin_amdgcn_s_memrealtime() - ts2_;
#endif
            if (lane == 0) flags[k % CK_NSLOT] = (unsigned)(k + 1);
            CK_ISSUE_B((k + CK_NBUILD < NCH) ? t0 + 16 * CK_NBUILD : t0);
        }
#undef CK_ISSUE
#undef CK_ISSUE_A
#undef CK_ISSUE_B
    } else {
        const int gq = wave - 6;
        v4u ld[8];
#define G_ISSUE(T0) do { const int t0_ = (T0); const size_t r_ = rowb + t0_ + l15; const size_t rp_ = (t0_ + l15 == 0) ? r_ : r_ - 1; \
            _Pragma("unroll") for (int ks = 0; ks < 4; ++ks) { const int col = 1664 + 32 * ks + 8 * kg; ld[2 * ks] = *(const v4u*)(proj + r_ * L0P + col); ld[2 * ks + 1] = *(const v4u*)(proj + rp_ * L0P + col); } } while (0)
        G_ISSUE(16 * gq);
#pragma unroll 1
        for (int k = gq; k < NCH; k += 2) {
            const int t0 = 16 * k;
            f32x4 accg[2] = {(f32x4){0.f, 0.f, 0.f, 0.f}, (f32x4){0.f, 0.f, 0.f, 0.f}}; const float pz_ = (t0 + l15 == 0) ? 0.f : 1.f;
#pragma unroll
            for (int ks = 0; ks < 4; ++ks) { float s_[8];
                const f32x4 m0 = *(const LAS f32x4*)(mixs + 128 + 32 * ks + 8 * kg), m1 = *(const LAS f32x4*)(mixs + 128 + 32 * ks + 8 * kg + 4);
                RW_SH8(ld[2 * ks], ld[2 * ks + 1], m0, m1, s_, pz_);
#pragma unroll
                for (int j = 0; j < 8; ++j) s_[j] = sigmoid_fast(s_[j]);
                const bf16x8 af = pack8(s_[0], s_[1], s_[2], s_[3], s_[4], s_[5], s_[6], s_[7]);
#pragma unroll
                for (int nt = 0; nt < 2; ++nt) { const bf16x8 bfr = *(const bf16x8*)(G2T + (size_t)(h * 64 + ihalf * 32 + 16 * nt + l15) * 128 + 32 * ks + 8 * kg); accg[nt] = MFMA16(af, bfr, accg[nt]); } }
            G_ISSUE((k + 2 < NCH) ? t0 + 32 : t0);
#pragma unroll
            for (int nt = 0; nt < 2; ++nt)
#pragma unroll
                for (int rg = 0; rg < 4; ++rg) gout[(rowb + t0 + 4 * kg + rg) * 512 + h * 64 + ihalf * 32 + 16 * nt + l15] = bf1(accg[nt][rg]);
        }
#undef G_ISSUE
    }
#undef RW_SH8
    __syncthreads();
}

template <bool ST = true> __device__ __forceinline__ void rwkv_post_all(const float* __restrict__ yraw, const bf16_t* __restrict__ proj, const float* __restrict__ mix, const float* __restrict__ bonus, const bf16_t* __restrict__ gbuf,
                                              const float* __restrict__ ln_g, const float* __restrict__ ln_b, bf16_t* __restrict__ ymix, int gw, int NGW, int lane) {
    for (int m = gw; m < M; m += NGW) {
        const bool has_prev = (m & (SEQ - 1)) != 0;
        float y[8], cv[8], pv[8], gg[8], bo[8];
#pragma unroll
        for (int h = 0; h < 8; ++h) { const int c = h * 64 + lane; y[h] = yraw[(size_t)m * 512 + c]; cv[h] = bf2f(proj[(size_t)m * L0P + 1024 + c]);
            pv[h] = bf2f(proj[(size_t)(has_prev ? m - 1 : m) * L0P + 1024 + c]); gg[h] = bf2f(gbuf[(size_t)m * 512 + c]); bo[h] = bonus[(size_t)m * 8 + h]; }
#pragma unroll
        for (int h = 0; h < 8; ++h) { const int c = h * 64 + lane;
            const float mu = wave_sum_dpp(y[h]) * (1.f / 64.f), d = y[h] - mu, var = wave_sum_dpp(d * d) * (1.f / 64.f);
            const float yn = d * __builtin_amdgcn_rsqf(var + 64e-5f) * ln_g[c] + ln_b[c];
            const float pvv = has_prev ? pv[h] : 0.f;
            const float v_s = cv[h] + (pvv - cv[h]) * mix[1024 + c];
            const float o = (yn + bo[h] * v_s) * gg[h];
            if (ST) ymix[(size_t)m * DM + c] = bf1(o); else asm volatile("" :: "v"(o)); }
    }
}


__device__ __forceinline__ void ssd_conv_tile(int it, int lane, LAS bf16_t* scr, const bf16_t* __restrict__ proj, const float* __restrict__ cw, const float* __restrict__ cb,
                                              bf16_t* __restrict__ xbc, bf16_t* __restrict__ xst, bf16_t* __restrict__ bt) {
    const int tt = it >> 4, ct = it & 15, m0 = tt * 64, b = m0 >> 11, t0 = m0 & (SEQ - 1), c = ct * 64 + lane;
    const float w0 = cw[c], w1 = cw[1024 + c], w2 = cw[2048 + c], w3 = cw[3072 + c], bias = cb[c];
    const bf16_t* src = proj + (size_t)m0 * L0P + 2304 + c;
    bf16_t raw[67];
    const int lo = (t0 > 0) ? -3 : 0;
#pragma unroll
    for (int t = -3; t < 64; ++t) raw[t + 3] = src[(ptrdiff_t)((t < lo) ? lo : t) * L0P];
    float u3 = (t0 > 0) ? bf2f(raw[0]) : 0.f, u2 = (t0 > 0) ? bf2f(raw[1]) : 0.f, u1 = (t0 > 0) ? bf2f(raw[2]) : 0.f;
#pragma unroll
    for (int t = 0; t < 64; ++t) {
        const float u = bf2f(raw[t + 3]);
        const float y = bias + w0 * u3 + w1 * u2 + w2 * u1 + w3 * u;
        const bf16_t o = bf1(y * __builtin_amdgcn_rcpf(1.f + __expf(-y)));
        xbc[(size_t)(m0 + t) * 1024 + c] = o;
        scr[t * STG_PITCH + lane] = o;
        u3 = u2; u2 = u1; u1 = u;
    }
    WSYNC();
    if (ct < 12) {
        bf16_t* dst = (ct < 8) ? xst + ((size_t)(b * 8 + ct) * 64) * SEQ + t0 : bt + ((size_t)(b * 2 + ((ct - 8) >> 1)) * 128 + ((ct - 8) & 1) * 64) * SEQ + t0;
#pragma unroll
        for (int i = 0; i < 8; ++i) { const int d = i * 8 + (lane >> 3), tc = lane & 7; const LAS bf16_t* p = scr + (tc * 8) * STG_PITCH + d;
            v4u o; o.x = (unsigned)p[0] | ((unsigned)p[STG_PITCH] << 16); o.y = (unsigned)p[2 * STG_PITCH] | ((unsigned)p[3 * STG_PITCH] << 16);
            o.z = (unsigned)p[4 * STG_PITCH] | ((unsigned)p[5 * STG_PITCH] << 16); o.w = (unsigned)p[6 * STG_PITCH] | ((unsigned)p[7 * STG_PITCH] << 16);
            *(v4u*)(dst + (size_t)d * SEQ + tc * 8) = o; }
    }
    WSYNC();
}
__device__ __forceinline__ float bperm(int srclane, float x) { return __builtin_bit_cast(float, __builtin_amdgcn_ds_bpermute(srclane << 2, __builtin_bit_cast(int, x))); }
__device__ __forceinline__ void scan128(float& x0, float& x1, int lane) {
#pragma unroll
    for (int o = 1; o < 64; o <<= 1) { const int sl = (lane >= o) ? lane - o : lane; const float t0 = bperm(sl, x0), t1 = bperm(sl, x1); if (lane >= o) { x0 += t0; x1 += t1; } }
    x1 += rl(x0, 63);
}
__device__ __forceinline__ void ssd_s1_unit(int unit, int lane, LAS float* tab, const bf16_t* __restrict__ xst, const bf16_t* __restrict__ bt, const float* __restrict__ dt, const float* __restrict__ a_log,
                                            float* __restrict__ sloc, float* __restrict__ asum) {
    const int h = unit & 7, c = (unit >> 3) & 15, b = unit >> 7, g = h >> 2, l0 = c * 128, l31 = lane & 31, hi = lane >> 5;
    const size_t m0 = (size_t)b * SEQ + l0;
    const float A = -expf(a_log[h]);
    const float d0 = dt[(m0 + lane) * 8 + h], d1 = dt[(m0 + 64 + lane) * 8 + h];
    float ac0 = d0 * A, ac1 = d1 * A;
    scan128(ac0, ac1, lane);
    const float aend = rl(ac1, 63);
    tab[lane] = __expf(aend - ac0) * d0; tab[64 + lane] = __expf(aend - ac1) * d1;
    if (lane == 0) asum[unit] = aend;
    WSYNC();
    f32x16 acc[2][4];
#pragma unroll
    for (int pt = 0; pt < 2; ++pt)
#pragma unroll
        for (int nt = 0; nt < 4; ++nt)
#pragma unroll
            for (int r = 0; r < 16; ++r) acc[pt][nt][r] = 0.f;
    const bf16_t* Xp = xst + ((size_t)(b * 8 + h) * 64 + l31) * SEQ + l0 + 8 * hi;
    const bf16_t* Bp = bt + ((size_t)(b * 2 + g) * 128 + l31) * SEQ + l0 + 8 * hi;
#pragma unroll 2
    for (int kk = 0; kk < 8; ++kk) {
        const f32x4 wa = *(const LAS f32x4*)(tab + 16 * kk + 8 * hi), wb = *(const LAS f32x4*)(tab + 16 * kk + 8 * hi + 4);
        bf16x8 af[2], bfr[4];
#pragma unroll
        for (int pt = 0; pt < 2; ++pt) { const v4u raw = *(const v4u*)(Xp + (size_t)pt * 32 * SEQ + 16 * kk);
            v4u w; w.x = cvtpk(bflo(raw.x) * wa[0], bfhi(raw.x) * wa[1]); w.y = cvtpk(bflo(raw.y) * wa[2], bfhi(raw.y) * wa[3]);
            w.z = cvtpk(bflo(raw.z) * wb[0], bfhi(raw.z) * wb[1]); w.w = cvtpk(bflo(raw.w) * wb[2], bfhi(raw.w) * wb[3]); af[pt] = __builtin_bit_cast(bf16x8, w); }
#pragma unroll
        for (int nt = 0; nt < 4; ++nt) bfr[nt] = *(const bf16x8*)(Bp + (size_t)nt * 32 * SEQ + 16 * kk);
#pragma unroll
        for (int pt = 0; pt < 2; ++pt)
#pragma unroll
            for (int nt = 0; nt < 4; ++nt) acc[pt][nt] = MFMA32(af[pt], bfr[nt], acc[pt][nt]);
    }
    float* dst = sloc + (size_t)unit * 8192 + l31;
#pragma unroll
    for (int pt = 0; pt < 2; ++pt)
#pragma unroll
        for (int nt = 0; nt < 4; ++nt)
#pragma unroll
            for (int r = 0; r < 16; ++r) dst[(32 * pt + crow(r, hi)) * 128 + 32 * nt] = acc[pt][nt][r];
    WSYNC();
}
__device__ __forceinline__ void ssd_s2_all(const float* __restrict__ sloc, const float* __restrict__ asum, bf16_t* __restrict__ stb, int gtid, int NT) {
    for (int i = gtid; i < 128 * 2048; i += NT) {
        const int bh = i >> 11, e4 = i & 2047, b = bh >> 3, h = bh & 7;
        f32x4 run = {0.f, 0.f, 0.f, 0.f};
#pragma unroll 4
        for (int c = 0; c < 16; ++c) { const int unit = (b * 16 + c) * 8 + h; const f32x4 tmp = *(const f32x4*)(sloc + (size_t)unit * 8192 + e4 * 4);
            uint2 w; w.x = cvtpk(run[0], run[1]); w.y = cvtpk(run[2], run[3]); *(uint2*)(stb + (size_t)unit * 8192 + e4 * 4) = w;
            run = run * __expf(asum[unit]) + tmp; }
    }
}
__device__ __forceinline__ void ssd_s3_unit(int unit, int lane, LAS float* tab, const bf16_t* __restrict__ xbc, const bf16_t* __restrict__ xst, const bf16_t* __restrict__ stb, const float* __restrict__ dt,
                                            const float* __restrict__ a_log, const float* __restrict__ dsk, bf16_t* __restrict__ yssm) {
    const int h = unit & 7, c = (unit >> 3) & 15, b = unit >> 7, g = h >> 2, l0 = c * 128, l31 = lane & 31, hi = lane >> 5;
    const size_t m0 = (size_t)b * SEQ + l0;
    const float A = -expf(a_log[h]), D = dsk[h];
    const float d0 = dt[(m0 + lane) * 8 + h], d1 = dt[(m0 + 64 + lane) * 8 + h];
    float ac0 = d0 * A, ac1 = d1 * A;
    scan128(ac0, ac1, lane);
    tab[lane] = ac0; tab[64 + lane] = ac1; tab[128 + lane] = d0; tab[192 + lane] = d1;
    WSYNC();
    const bf16_t* Cp = xbc + (m0 + l31) * 1024 + 768 + g * 128 + 8 * hi;
    const bf16_t* Sp = stb + (size_t)unit * 8192 + l31 * 128 + 8 * hi;
    const bf16_t* Bp = xbc + (m0 + l31) * 1024 + 512 + g * 128 + 8 * hi;
    const bf16_t* Xp = xst + ((size_t)(b * 8 + h) * 64 + l31) * SEQ + l0 + 4 * hi;
    LAS float* tr = tab + 256;
    const int row = lane >> 1, p0 = (lane & 1) * 16;
#pragma unroll 1
    for (int lt = 0; lt < 4; ++lt) {
        f32x16 y[2];
#pragma unroll
        for (int r = 0; r < 16; ++r) { y[0][r] = 0.f; y[1][r] = 0.f; }
        const float acl = tab[32 * lt + l31];
        bf16x8 cfr[8];
#pragma unroll
        for (int kk = 0; kk < 8; ++kk) cfr[kk] = *(const bf16x8*)(Cp + (size_t)lt * 32 * 1024 + 16 * kk);
        {   bf16x8 s0[8], s1[8];
#pragma unroll
            for (int kk = 0; kk < 8; ++kk) { s0[kk] = *(const bf16x8*)(Sp + 16 * kk); s1[kk] = *(const bf16x8*)(Sp + 32 * 128 + 16 * kk); }
#pragma unroll
            for (int kk = 0; kk < 8; ++kk) { y[0] = MFMA32(s0[kk], cfr[kk], y[0]); y[1] = MFMA32(s1[kk], cfr[kk], y[1]); }
        }
        { const float el = __expf(acl);
#pragma unroll
          for (int r = 0; r < 16; ++r) { y[0][r] *= el; y[1][r] *= el; } }
#pragma unroll 1
        for (int st = 0; st <= lt; ++st) {
            bf16x8 bfr[8]; u32x2 xf[2][2][2];
#pragma unroll
            for (int kk = 0; kk < 8; ++kk) bfr[kk] = *(const bf16x8*)(Bp + (size_t)st * 32 * 1024 + 16 * kk);
#pragma unroll
            for (int pt = 0; pt < 2; ++pt)
#pragma unroll
                for (int ks = 0; ks < 2; ++ks) { const bf16_t* xp = Xp + (size_t)pt * 32 * SEQ + st * 32 + 16 * ks; xf[pt][ks][0] = *(const u32x2*)xp; xf[pt][ks][1] = *(const u32x2*)(xp + 8); }
            f32x16 cbt;
#pragma unroll
            for (int r = 0; r < 16; ++r) cbt[r] = 0.f;
#pragma unroll
            for (int kk = 0; kk < 8; ++kk) cbt = MFMA32(bfr[kk], cfr[kk], cbt);
#pragma unroll
            for (int r = 0; r < 16; ++r) { const int sl = 32 * st + crow(r, hi); const float acs = tab[sl], dts = tab[128 + sl];
                float v = cbt[r] * __expf(acl - acs) * dts; if (st == lt && crow(r, hi) > l31) v = 0.f; cbt[r] = v; }
            bf16x8 pf[2];
#pragma unroll
            for (int ks = 0; ks < 2; ++ks) pf[ks] = pack8(cbt[8 * ks], cbt[8 * ks + 1], cbt[8 * ks + 2], cbt[8 * ks + 3], cbt[8 * ks + 4], cbt[8 * ks + 5], cbt[8 * ks + 6], cbt[8 * ks + 7]);
#pragma unroll
            for (int pt = 0; pt < 2; ++pt)
#pragma unroll
                for (int ks = 0; ks < 2; ++ks) { v4u a; a.x = xf[pt][ks][0].x; a.y = xf[pt][ks][0].y; a.z = xf[pt][ks][1].x; a.w = xf[pt][ks][1].y; y[pt] = MFMA32(__builtin_bit_cast(bf16x8, a), pf[ks], y[pt]); }
        }
#pragma unroll
        for (int pt = 0; pt < 2; ++pt) {
#pragma unroll
            for (int r = 0; r < 16; ++r) tr[l31 * 33 + crow(r, hi)] = y[pt][r];
            WSYNC();
            const size_t m = m0 + 32 * lt + row;
            const v4u xa = *(const v4u*)(xbc + m * 1024 + h * 64 + 32 * pt + p0), xb = *(const v4u*)(xbc + m * 1024 + h * 64 + 32 * pt + p0 + 8);
            const unsigned xu[8] = {xa.x, xa.y, xa.z, xa.w, xb.x, xb.y, xb.z, xb.w};
            unsigned ow[8];
#pragma unroll
            for (int q = 0; q < 8; ++q) { const float v0 = tr[row * 33 + p0 + 2 * q] + D * bflo(xu[q]), v1 = tr[row * 33 + p0 + 2 * q + 1] + D * bfhi(xu[q]); ow[q] = cvtpk(v0, v1); }
            bf16_t* dst = yssm + m * 512 + h * 64 + 32 * pt + p0;
            *(v4u*)dst = (v4u){ow[0], ow[1], ow[2], ow[3]}; *(v4u*)(dst + 8) = (v4u){ow[4], ow[5], ow[6], ow[7]};
            WSYNC();
        }
    }
}

struct Args { const float* in[43]; float* out; unsigned char* ws; };
#define GEMM_PHASE(EPI, Aptr, LDA, Bptr, LDB, NN, KK, ...) do { pg8::Gemm g_{(Aptr), (Bptr), M, (NN), (KK), (LDA), (LDB)}; pg8::StaticOrder S_; S_.init(M, (NN), G, (int)blockIdx.x); \
        pg8::EPI E_{__VA_ARGS__}; pg8::gemm_phase<pg8::EPI, pg8::StaticOrder, true, true>(lds3, g_, S_, E_); } while (0)

__global__ void __launch_bounds__(NWAVES * 64, 2) fwd_mega(Args args) {
    extern __shared__ __attribute__((aligned(16))) unsigned char lds[];
    LAS unsigned char* lds3 = (LAS unsigned char*)lds;
    volatile LAS unsigned* MISC = (volatile LAS unsigned*)(lds3 + MISC_OFF);
    const int G = gridDim.x, NGW = G * NWAVES, NT = G * NWAVES * 64;
#define PHASE_IDS() int tid = threadIdx.x; asm volatile("" : "+v"(tid)); const int lane = tid & 63, wave = __builtin_amdgcn_readfirstlane(tid >> 6); const int gw = blockIdx.x * NWAVES + wave, gtid = blockIdx.x * (NWAVES * 64) + tid; (void)lane; (void)gw; (void)gtid
    unsigned char* ws = args.ws;
    gu32* ctl = (gu32*)(ws + WS_CTL);
    for (int u = threadIdx.x; u < (LDS_BYTES - LDSCTL_OFF) / 4; u += NWAVES * 64) ((LAS unsigned*)(lds3 + LDSCTL_OFF))[u] = 0u;
    __syncthreads();
    XcdBarrier bar = xcd_barrier_post((unsigned*)(ctl + CW_BAR), MISC + 8);
#if defined(PROBE_STAMPS)
    int nb_ = 0;
    if (blockIdx.x == 0 && threadIdx.x == 0) MISC[16] = (unsigned)__builtin_amdgcn_s_memrealtime();
#define GRID_BAR() do { xcd_barrier(bar); ++nb_; if (blockIdx.x == 0 && threadIdx.x == 0) MISC[16 + nb_] = (unsigned)__builtin_amdgcn_s_memrealtime(); } while (0)
#else
#define GRID_BAR() xcd_barrier(bar)
#endif
#define IN(i) (args.in[i])
    float* out = args.out;
    bf16_t* W0in = (bf16_t*)(ws + WS_W0IN); bf16_t* W0out = (bf16_t*)(ws + WS_W0OUT); bf16_t* Wup0 = (bf16_t*)(ws + WS_WUP0); bf16_t* Wdn0 = (bf16_t*)(ws + WS_WDN0);
    bf16_t* W1in = (bf16_t*)(ws + WS_W1IN); bf16_t* Wuq = (bf16_t*)(ws + WS_WUQ); bf16_t* Wukv = (bf16_t*)(ws + WS_WUKV); bf16_t* W1out = (bf16_t*)(ws + WS_W1OUT);
    bf16_t* Wup1 = (bf16_t*)(ws + WS_WUP1); bf16_t* Wdn1 = (bf16_t*)(ws + WS_WDN1);
    bf16_t* XB = (bf16_t*)(ws + WS_XB); bf16_t* YMIX = (bf16_t*)(ws + WS_YMIX); bf16_t* PROJ0 = (bf16_t*)(ws + WS_BIG);
    float* YRAW = out; bf16_t* YSSM = (bf16_t*)(out + (size_t)M * 512); bf16_t* STB = (bf16_t*)(out + (size_t)M * 768); bf16_t* XST = (bf16_t*)(ws + WS_XST); bf16_t* BT = (bf16_t*)(ws + WS_BT); float* ASUM = (float*)(ws + WS_ASUM); float* SLOC = (float*)(ws + WS_SLOC); float* DT = (float*)(ws + WS_DT); bf16_t* GB = (bf16_t*)(ws + WS_G); float* BONUS = (float*)(ws + WS_BONUS);
    bf16_t* W2T = (bf16_t*)(ws + WS_W2T); bf16_t* A2T = (bf16_t*)(ws + WS_A2T); bf16_t* G2T = (bf16_t*)(ws + WS_G2T); bf16_t* ACT = (bf16_t*)(ws + WS_GU); bf16_t* HALO = (bf16_t*)(ws + WS_GU + 176 * MiB);
    bf16_t* PROJ1 = (bf16_t*)(ws + WS_PROJ1); bf16_t* QM = (bf16_t*)(ws + WS_QM); bf16_t* KVM = (bf16_t*)(ws + WS_KVM); bf16_t* KPE = (bf16_t*)(ws + WS_KPE); float* RS = (float*)(ws + WS_RS); float* CSTAB = (float*)(ws + WS_CSTAB); float* STATS = (float*)(ws + WS_CSTAB + 4 * MiB); bf16_t* VTS = (bf16_t*)(ws + WS_VTS); bf16_t* VTM = (bf16_t*)(ws + WS_VTM);
    const int* pos = (const int*)args.in[1];

    {
        PHASE_IDS();
    {
        LAS float* scr = (LAS float*)(lds3 + wave * 16384); int trb = 0;
        transpose_matrix(IN(2), 1024, 3336, W0in, L0P, 1024, scr, gw, NGW, lane, nullptr, trb);
        transpose_matrix(IN(20), 1024, 1024, W0out, 1024, 1024, scr, gw, NGW, lane, nullptr, trb);
        transpose_matrix(IN(23), 1024, 5632, Wup0, 5632, 1024, scr, gw, NGW, lane, nullptr, trb, true);
        transpose_matrix(IN(26), 2816, 1024, Wdn0, 1024, 2816, scr, gw, NGW, lane, nullptr, trb);
        transpose_matrix(IN(29), 1024, 1952, W1in, L1P, 1024, scr, gw, NGW, lane, nullptr, trb);
        transpose_matrix(IN(31), 256, 768, Wuq, 768, 256, scr, gw, NGW, lane, IN(30), trb);
        transpose_matrix(IN(33), 128, 1024, Wukv, 1024, 256, scr, gw, NGW, lane, IN(32), trb);
        for (int i = gtid; i < 1024 * 16; i += NT) { const int n = i >> 4, c = i & 15; *(v4u*)(Wukv + (size_t)n * 256 + 128 + c * 8) = (v4u){0u, 0u, 0u, 0u}; }
        transpose_matrix(IN(34), 1024, 1024, W1out, 1024, 1024, scr, gw, NGW, lane, nullptr, trb);
        transpose_matrix(IN(37), 1024, 5632, Wup1, 5632, 1024, scr, gw, NGW, lane, nullptr, trb, true);
        transpose_matrix(IN(40), 2816, 1024, Wdn1, 1024, 2816, scr, gw, NGW, lane, nullptr, trb);
        transpose_matrix(IN(5), 64, 512, W2T, 512, 64, scr, gw, NGW, lane, nullptr, trb);
        transpose_matrix(IN(7), 64, 512, A2T, 512, 64, scr, gw, NGW, lane, nullptr, trb);
        transpose_matrix(IN(8), 128, 512, G2T, 512, 128, scr, gw, NGW, lane, nullptr, trb);
        const float* x = IN(0);
        {
            constexpr size_t TOT4 = (size_t)M * DM / 4;
            for (size_t i = gtid; i < TOT4; i += (size_t)NT * 8) {
                f32x4 v[8];
#pragma unroll
                for (int u = 0; u < 8; ++u) v[u] = *(const f32x4*)(x + (i + (size_t)u * NT) * 4);
#pragma unroll
                for (int u = 0; u < 8; ++u) { uint2 w; w.x = cvtpk(v[u][0], v[u][1]); w.y = cvtpk(v[u][2], v[u][3]); *(uint2*)(XB + (i + (size_t)u * NT) * 4) = w; }
            }
        }
    }
    }
    GRID_BAR();
    {
        PHASE_IDS();
    GEMM_PHASE(EpiBf16S, XB, DM, W0in, 1024, L0P, 1024, PROJ0, nullptr, L0P, 0);
    }
    GRID_BAR();
    {
        PHASE_IDS();
        const int blk = (int)blockIdx.x, m0 = blk * 128;
        {   LAS bf16_t* scr = (LAS bf16_t*)(lds3 + wave * 16384);
#pragma unroll 1
            for (int k = 0; k < 4; ++k) ssd_conv_tile((2 * blk + (k & 1)) * 16 + wave + 8 * (k >> 1), lane, scr, PROJ0, IN(14), IN(15), XB, XST, BT);
            for (int i = tid; i < 1024; i += NWAVES * 64) { const int m = m0 + (i >> 3); DT[(size_t)m * 8 + (i & 7)] = softplusf_(bf2f(PROJ0[(size_t)m * L0P + 3328 + (i & 7)]) + IN(16)[i & 7]); }
        }
        __syncthreads();
#if defined(PROBE_STAMPS)
        if (blockIdx.x == 0 && threadIdx.x == 0) MISC[16 + 29] = (unsigned)__builtin_amdgcn_s_memrealtime();
#endif
        ssd_s1_unit(blk * 8 + wave, lane, (LAS float*)(lds3 + wave * 16384), XST, BT, DT, IN(17), SLOC, ASUM);
    }
    GRID_BAR();
    {
        PHASE_IDS();
        ssd_s2_all(SLOC, ASUM, STB, gtid, NT);
#if defined(PROBE_STAMPS)
        __syncthreads(); if (blockIdx.x == 0 && threadIdx.x == 0) MISC[16 + 23] = (unsigned)__builtin_amdgcn_s_memrealtime();
#endif
        rwkv_phase((LAS float*)lds3, tid, lane, wave, (int)blockIdx.x, PROJ0, IN(3), IN(4), IN(6), IN(9), IN(10), IN(11), W2T, A2T, G2T, YRAW, GB, BONUS);
    }
    GRID_BAR();
    {
        PHASE_IDS();
        const int blk = (int)blockIdx.x;
        ssd_s3_unit(blk * 8 + wave, lane, (LAS float*)(lds3 + wave * 16384), XB, XST, STB, DT, IN(17), IN(18), YSSM);
        __syncthreads();
        ssm_gate_norm_all(YSSM, PROJ0, IN(19), YMIX, blk * 256 + wave, blk * 256 + 256, lane);
        rwkv_post_all(YRAW, PROJ0, IN(3), BONUS, GB, IN(12), IN(13), YMIX, gw, NGW, lane);
    }
    GRID_BAR();
    {
        PHASE_IDS();
    GEMM_PHASE(EpiResid, YMIX, DM, W0out, 1024, 1024, 1024, IN(0), out, ALPHA, 0);
    }
    GRID_BAR();
    {
        PHASE_IDS();
    ln_rows<1>(out, XB, STATS, IN(21), IN(22), gw, NGW, lane);
    }
    GRID_BAR();
    {
        PHASE_IDS();
        { pg8::Gemm g_{XB, Wup0, M / 32, DFF, 1024, DM, 1024, 4096, 8192, 256, 512, 1}; pg8::StaticOrder S_; S_.init(M / 32, DFF, G, (int)blockIdx.x);
          pg8::EpiBf16S E_{HALO, nullptr, DFF, 0}; pg8::gemm_phase<pg8::EpiBf16S, pg8::StaticOrder, true, true>(lds3, g_, S_, E_); }
    }
    GRID_BAR();
    {
        PHASE_IDS();
        { pg8::Gemm g_{XB, Wup0, M, 2 * DFF, 1024, DM, 1024}; pg8::StaticOrder S_; S_.init(M, 2 * DFF, G, (int)blockIdx.x);
          pg8::EpiConvAct E_{ACT, HALO, IN(24), IN(25), DFF, SEQ}; pg8::gemm_phase<pg8::EpiConvAct, pg8::StaticOrder, true, true>(lds3, g_, S_, E_); }
    }
    GRID_BAR();
    {
        PHASE_IDS();
    GEMM_PHASE(EpiResidLN, ACT, DFF, Wdn0, DFF, 1024, DFF, out, STATS, IN(21), IN(22), ALPHA, 0);
    }
    GRID_BAR();
    {
        PHASE_IDS();
    ln_rows<1>(out, XB, STATS, IN(27), IN(28), gw, NGW, lane);
    }
    GRID_BAR();
    {
        PHASE_IDS();
    GEMM_PHASE(EpiBf16S, XB, DM, W1in, 1024, L1P, 1024, PROJ1, nullptr, L1P, 0);
    }
    GRID_BAR();
    {
        PHASE_IDS();
    mla_prep_all(PROJ1, pos, RS, KPE, CSTAB, gw, NGW, lane);
    }
    GRID_BAR();
    {
        PHASE_IDS();
    GEMM_PHASE(EpiBf16S, PROJ1 + 1536, L1P, Wuq, 256, 768, 256, QM, RS, 768, 2);
    GEMM_PHASE(EpiBf16S, PROJ1 + 1792, L1P, Wukv, 256, 1024, 256, KVM, RS + 1, 1024, 2);
    }
    GRID_BAR();
    {
        PHASE_IDS();
    rope_q_all(QM, CSTAB, gtid, NT);
    {
        LAS bf16_t* scr = (LAS bf16_t*)(lds3 + wave * 16384);
        for (int it = gw; it < 8192; it += NGW) { const int which = it >> 12, r = it & 4095, bh = r >> 5, tt = r & 31, b = bh >> 3, h = bh & 7;
            if (which == 0) transpose_tile64(PROJ1 + ((size_t)b * SEQ + tt * 64) * L1P + 1024 + h * 64, L1P, VTS + (size_t)bh * 64 * SEQ + tt * 64, SEQ, scr, lane);
            else            transpose_tile64(KVM + ((size_t)b * SEQ + tt * 64) * 1024 + h * 128 + 64, 1024, VTM + (size_t)bh * 64 * SEQ + tt * 64, SEQ, scr, lane); }
    }
    }
    GRID_BAR();
    {
        PHASE_IDS();
    {
        { LAS unsigned char* wl = lds3 + wave * 16384;
          for (int g2 = gw; g2 < 2048; g2 += NGW) { const int bh = g2 >> 4, w = g2 & 15;
#pragma unroll 1
              for (int i = 0; i < 4; ++i) { const int qb = (i == 0) ? w : (i == 1) ? 31 - w : (i == 2) ? 32 + w : 63 - w; sb_wave(bh, qb, lane, PROJ1, VTS, YMIX, wl); } } }
        __syncthreads();
        for (int g2 = (int)blockIdx.x; g2 < 256; g2 += G) { const int bh = g2 >> 1, part = g2 & 1;
#pragma unroll 1
            for (int i = 0; i < 4; ++i) { const int sbk = part ? ((i == 0) ? 1 : (i == 1) ? 6 : (i == 2) ? 2 : 5) : ((i == 0) ? 0 : (i == 1) ? 7 : (i == 2) ? 3 : 4);
                mla_block(bh, sbk, tid, lane, wave, lds3, QM, KVM, KPE, VTM, YMIX); } }
    }
    }
    GRID_BAR();
    {
        PHASE_IDS();
    GEMM_PHASE(EpiResidLN, YMIX, DM, W1out, 1024, 1024, 1024, out, STATS, IN(27), IN(28), ALPHA, 0);
    }
    GRID_BAR();
    {
        PHASE_IDS();
    ln_rows<1>(out, XB, STATS, IN(35), IN(36), gw, NGW, lane);
    }
    GRID_BAR();
    {
        PHASE_IDS();
        { pg8::Gemm g_{XB, Wup1, M / 32, DFF, 1024, DM, 1024, 4096, 8192, 256, 512, 1}; pg8::StaticOrder S_; S_.init(M / 32, DFF, G, (int)blockIdx.x);
          pg8::EpiBf16S E_{HALO, nullptr, DFF, 0}; pg8::gemm_phase<pg8::EpiBf16S, pg8::StaticOrder, true, true>(lds3, g_, S_, E_); }
    }
    GRID_BAR();
    {
        PHASE_IDS();
        { pg8::Gemm g_{XB, Wup1, M, 2 * DFF, 1024, DM, 1024}; pg8::StaticOrder S_; S_.init(M, 2 * DFF, G, (int)blockIdx.x);
          pg8::EpiConvAct E_{ACT, HALO, IN(38), IN(39), DFF, SEQ}; pg8::gemm_phase<pg8::EpiConvAct, pg8::StaticOrder, true, true>(lds3, g_, S_, E_); }
    }
    GRID_BAR();
    {
        PHASE_IDS();
    GEMM_PHASE(EpiResidLN, ACT, DFF, Wdn1, DFF, 1024, DFF, out, STATS, IN(35), IN(36), ALPHA, 0);
    }
    GRID_BAR();
    {
        PHASE_IDS();
    ln_rows<2>(out, XB, STATS, IN(41), IN(42), gw, NGW, lane);
    #if defined(PROBE_STAMPS)
    __syncthreads();
    if (blockIdx.x == 0 && threadIdx.x == 0) {
        MISC[16 + 22] = (unsigned)__builtin_amdgcn_s_memrealtime();
#if defined(PROBE_ACC)
        const unsigned d1 = MISC[16 + PROBE_ACC];
#else
        const unsigned d1 = MISC[16 + PROBE_T1_HI] - MISC[16 + PROBE_T1_LO];
#endif
        const unsigned long long spin = 100ull * d1;
        const unsigned long long t0 = __builtin_amdgcn_s_memrealtime();
        while (__builtin_amdgcn_s_memrealtime() - t0 < spin) __builtin_amdgcn_s_sleep(8);
    }
#endif
}
}

extern "C" void kernel_launch(void* const* d_in, const int* in_sizes, int n_in, void* d_out, int out_size, void* d_ws, size_t ws_size, hipStream_t stream) {
    static int grid = 0;
    if (grid == 0) {
        if (n_in != 43 || ws_size < WS_NEED || out_size != M * DM) { fprintf(stderr, "kernel_launch: unexpected n_in %d / ws %zu / out %d\n", n_in, ws_size, out_size); grid = -1; return; }
        int dev = 0, cus = 0, per_cu = 0;
        if (hipGetDevice(&dev) != hipSuccess || hipDeviceGetAttribute(&cus, hipDeviceAttributeMultiprocessorCount, dev) != hipSuccess) { grid = -1; return; }
        if (hipFuncSetAttribute((const void*)fwd_mega, hipFuncAttributeMaxDynamicSharedMemorySize, LDS_BYTES) != hipSuccess) { fprintf(stderr, "kernel_launch: hipFuncSetAttribute failed\n"); grid = -1; return; }
        if (hipOccupancyMaxActiveBlocksPerMultiprocessor(&per_cu, (const void*)fwd_mega, NWAVES * 64, LDS_BYTES) != hipSuccess || per_cu < 1) fprintf(stderr, "kernel_launch: occupancy query reports %d\n", per_cu);
        (void)hipGetLastError();
        grid = cus;
    }
    if (grid < 0) return;
    (void)hipMemsetAsync((char*)d_ws + WS_CTL, 0, CTL_ZERO_BYTES, stream);
    Args a{};
    for (int i = 0; i < 43; ++i) a.in[i] = (const float*)d_in[i];
    a.out = (float*)d_out; a.ws = (unsigned char*)d_ws;
    hipLaunchKernelGGL(fwd_mega, dim3(grid), dim3(NWAVES * 64), LDS_BYTES, stream, a);
}
```

```cpp
#include <hip/hip_runtime.h>
#include <cstdio>
#include <cstdint>
#include <cmath>
namespace pg8 {
#define PG8_LAS __attribute__((address_space(3)))
typedef unsigned short bf16_t;
typedef short bf16x8 __attribute__((ext_vector_type(8)));
typedef float f32x4 __attribute__((ext_vector_type(4)));
typedef unsigned u32x4 __attribute__((ext_vector_type(4)));
constexpr int BM = 256, BK = 64, HALF = 128, HTB = HALF * BK * 2  , STAGE_BYTES = 8 * HTB, NXCD = 8, WGM = 8;

__host__ __device__ __forceinline__ int lds_byte(int r, int c) { const int st = (r >> 4) * 2 + (c >> 5), rr = r & 15, cc = c & 31, ob = rr * 64 + cc * 2; return st * 1024 + (ob ^ (((ob >> 9) & 1) << 5)); }
__host__ __device__ __forceinline__ void stage_rc(int b, int& R, int& C) { const int st = b / 1024, sb = b % 1024, swz = sb ^ (((sb >> 9) & 1) << 5); R = (st >> 1) * 16 + swz / 64; C = (st & 1) * 32 + (swz % 64) / 2; }
__host__ __device__ __forceinline__ int perm32(int rho) { const int n = rho >> 4, i = rho & 15; return 8 * (i >> 2) + 4 * n + (i & 3); }

struct Unit { int pm, pn; };
struct Gemm { const bf16_t* A; const bf16_t* Bt; int M, N, K, lda, ldb; int hrA = 128, trA = 256, hrB = 128, trB = 256, gatherA = 0; };

struct StaticOrder {
    int nM, nN, nwg, G, c;
    __host__ __device__ void init(int M, int N, int G_, int c_) { nM = M / BM; nN = N / BM; nwg = nM * nN; G = G_; c = c_; }
    __host__ __device__ bool next(int i, Unit& u) const {
        const long L = (long)i * G + c; if (L >= nwg) return false;
        int wgid = (int)L; { const int q = nwg / NXCD, r = nwg % NXCD, xcd = wgid % NXCD, off = wgid / NXCD; wgid = (xcd < r ? xcd * (q + 1) : r * (q + 1) + (xcd - r) * q) + off; }
        const int nig = WGM * nN, gid = wgid / nig, fm = gid * WGM, gsz = (nM - fm) < WGM ? (nM - fm) : WGM;
        u.pm = fm + ((wgid % nig) % gsz); u.pn = (wgid % nig) / gsz; return true;
    }
    __device__ __forceinline__ void a_ready(const Unit&) const {}
    __device__ __forceinline__ void done(const Unit&) const {}
};


__device__ __forceinline__ unsigned cvt_pk_bf16(float lo, float hi) { unsigned r; asm volatile("v_cvt_pk_bf16_f32 %0, %1, %2" : "=v"(r) : "v"(lo), "v"(hi)); return r; }
struct EpiBf16S {
    static constexpr bool PERM = true, AFTER_DRAIN = false;
    bf16_t* O; const float* rowscale; int ldc; int rs_stride;
    __device__ __forceinline__ void operator()(const f32x4 (&acc)[2][2][4][2], const Unit& u, int wr, int wc, int fr, int fq) const {
        const int row0 = u.pm * BM + wr * 64 + fr, col0 = u.pn * BM + wc * 32 + 8 * fq;
#pragma unroll
        for (int ai = 0; ai < 2; ++ai)
#pragma unroll
            for (int m = 0; m < 4; ++m) { const int row = row0 + ai * HALF + m * 16; const float sc = rowscale ? rowscale[(size_t)row * rs_stride] : 1.f;
                bf16_t* rowp = O + (size_t)row * ldc + col0;
#pragma unroll
                for (int bj = 0; bj < 2; ++bj) { const f32x4 v0 = acc[ai][bj][m][0] * sc, v1 = acc[ai][bj][m][1] * sc;
                    u32x4 w; w.x = cvt_pk_bf16(v0[0], v0[1]); w.y = cvt_pk_bf16(v0[2], v0[3]); w.z = cvt_pk_bf16(v1[0], v1[1]); w.w = cvt_pk_bf16(v1[2], v1[3]);
                    *(u32x4*)(rowp + bj * HALF) = w; } }
    }
};
struct EpiResid {
    static constexpr bool PERM = false, AFTER_DRAIN = false;
    const float* hin; float* hout; float alpha; int pad;
    __device__ __forceinline__ void operator()(const f32x4 (&acc)[2][2][4][2], const Unit& u, int wr, int wc, int fr, int fq) const {
        const int row0 = u.pm * BM + wr * 64 + fr, col0 = u.pn * BM + wc * 32 + 4 * fq;
#pragma unroll
        for (int ai = 0; ai < 2; ++ai)
#pragma unroll
            for (int m = 0; m < 4; ++m) { const size_t off = (size_t)(row0 + ai * HALF + m * 16) * 1024 + col0;
#pragma unroll
                for (int bj = 0; bj < 2; ++bj)
#pragma unroll
                    for (int n = 0; n < 2; ++n) { const size_t i = off + bj * HALF + n * 16; const f32x4 h = *(const f32x4*)(hin + i); *(f32x4*)(hout + i) = h * alpha + acc[ai][bj][m][n]; } }
    }
};

struct EpiResidLN {
    static constexpr bool PERM = false, AFTER_DRAIN = false;
    float* hio; const float* stats; const float* g; const float* b; float alpha; int pad;
    __device__ __forceinline__ void operator()(const f32x4 (&acc)[2][2][4][2], const Unit& u, int wr, int wc, int fr, int fq) const {
        const int row0 = u.pm * BM + wr * 64 + fr, col0 = u.pn * BM + wc * 32 + 4 * fq;
        f32x4 gg[2][2], bb[2][2];
#pragma unroll
        for (int bj = 0; bj < 2; ++bj)
#pragma unroll
            for (int n = 0; n < 2; ++n) { gg[bj][n] = *(const f32x4*)(g + col0 + bj * HALF + n * 16) * alpha; bb[bj][n] = *(const f32x4*)(b + col0 + bj * HALF + n * 16) * alpha; }
#pragma unroll
        for (int ai = 0; ai < 2; ++ai)
#pragma unroll
            for (int m = 0; m < 4; ++m) { const int row = row0 + ai * HALF + m * 16; const size_t off = (size_t)row * 1024 + col0;
                const float mu = stats[2 * row], rs = stats[2 * row + 1];
#pragma unroll
                for (int bj = 0; bj < 2; ++bj)
#pragma unroll
                    for (int n = 0; n < 2; ++n) { const size_t i = off + bj * HALF + n * 16; const f32x4 p = *(const f32x4*)(hio + i); *(f32x4*)(hio + i) = (p - mu) * rs * gg[bj][n] + bb[bj][n] + acc[ai][bj][m][n]; } }
    }
};

template <int CTRL> __device__ __forceinline__ float pg_dpp(float x) { return __builtin_bit_cast(float, __builtin_amdgcn_update_dpp(0, __builtin_bit_cast(int, x), CTRL, 0xF, 0xF, true)); }
struct EpiConvAct {
    static constexpr bool PERM = true, AFTER_DRAIN = false;
    bf16_t* act; const bf16_t* halo; const float* cw; const float* cb; int dff; int seq;
    __device__ __forceinline__ void operator()(const f32x4 (&acc)[2][2][4][2], const Unit& u, int wr, int wc, int fr, int fq) const {
        typedef unsigned u32x2e __attribute__((ext_vector_type(2)));
#pragma unroll
        for (int n = 0; n < 2; ++n) {
            const int ch0 = u.pn * 128 + wc * 32 + 8 * fq + 4 * n;
            const f32x4 w0 = *(const f32x4*)(cw + ch0), w1 = *(const f32x4*)(cw + dff + ch0), w2 = *(const f32x4*)(cw + 2 * dff + ch0), bb = *(const f32x4*)(cb + ch0);
#pragma unroll
            for (int ai = 0; ai < 2; ++ai) {
                const int rb64 = u.pm * BM + ai * HALF + wr * 64;
                f32x4 P = {0.f, 0.f, 0.f, 0.f};
                if ((rb64 & (seq - 1)) != 0 && fr >= 14) { const u32x2e hv = *(const u32x2e*)(halo + (size_t)(2 * (rb64 / 64 - 1) + (fr - 14)) * dff + ch0);
                    P[0] = __builtin_bit_cast(float, hv.x << 16); P[1] = __builtin_bit_cast(float, hv.x & 0xffff0000u); P[2] = __builtin_bit_cast(float, hv.y << 16); P[3] = __builtin_bit_cast(float, hv.y & 0xffff0000u); }
#pragma unroll
                for (int m = 0; m < 4; ++m) {
                    const f32x4 Gv = acc[ai][0][m][n], Uv = acc[ai][1][m][n];
                    float o[4];
#pragma unroll
                    for (int e = 0; e < 4; ++e) {
                        const float t1 = pg_dpp<0x111>(Gv[e]), t2 = pg_dpp<0x112>(Gv[e]), p1 = pg_dpp<0x10F>(P[e]), p2 = pg_dpp<0x10E>(P[e]);
                        const float g1 = (fr >= 1) ? t1 : p1, g2 = (fr >= 2) ? t2 : p2;
                        const float y = bb[e] + w0[e] * g2 + w1[e] * g1 + w2[e] * Gv[e];
                        o[e] = y * __builtin_amdgcn_rcpf(1.f + __builtin_amdgcn_exp2f(-1.4426950408889634f * y)) * Uv[e];
                    }
                    u32x2e w; w.x = cvt_pk_bf16(o[0], o[1]); w.y = cvt_pk_bf16(o[2], o[3]);
                    *(u32x2e*)(act + (size_t)(rb64 + m * 16 + fr) * dff + ch0) = w;
                    P = Gv;
                }
            }
        }
    }
};

template <class Epi, class Sched, bool ALIGN_EPI = false, bool SP2 = false>
__device__ __forceinline__ void gemm_phase(PG8_LAS unsigned char* lds, const Gemm g, const Sched& S, const Epi& E) {
    int tid = threadIdx.x; asm volatile("" : "+v"(tid));
    const int wid = __builtin_amdgcn_readfirstlane(tid >> 6), lane = tid & 63, wr = wid >> 2, wc = wid & 3, fr = lane & 15, fq = lane >> 4;
    const int K = g.K, nt = K / BK;
    unsigned voffA[2], voffB[2];
#pragma unroll
    for (int i = 0; i < 2; ++i) { int R, C; stage_rc(tid * 16 + i * 8192, R, C); const int Rb = Epi::PERM ? ((R & ~31) + perm32(R & 31)) : R;
        const int Ra = g.gatherA ? (64 * (R >> 1) + 62 + (R & 1)) : R;
        voffA[i] = (unsigned)(Ra * g.lda + C) * 2u; voffB[i] = (unsigned)(Rb * g.ldb + C) * 2u; }
    const size_t kstep = (size_t)(BK * 2);
    const size_t hstepA = (size_t)g.hrA * g.lda * 2, hstepB = (size_t)g.hrB * g.ldb * 2;
    const size_t tstepA = (size_t)g.trA * g.lda * 2, tstepB = (size_t)g.trB * g.ldb * 2;
    const unsigned ldsw = (unsigned)wid * 1024u;
    const int aoff = lds_byte(wr * 64 + fr, fq * 8), boff = lds_byte(wc * 32 + fr, fq * 8);
#define PG8_SA(b, h) (((b) * 2 + (h)) * HTB)
#define PG8_SB(b, h) ((4 + (b) * 2 + (h)) * HTB)
#define PG8_STAGE(bufoff, gbase, voff) do { _Pragma("unroll") for (int _i = 0; _i < 2; ++_i) \
        __builtin_amdgcn_global_load_lds((const unsigned*)((const char*)(gbase) + (voff)[_i]), (PG8_LAS unsigned*)(lds + (bufoff) + ldsw + _i * 8192), 16, 0, 0); } while (0)
#define PG8_LDA(dst, b, h) do { _Pragma("unroll") for (int m = 0; m < 4; ++m) _Pragma("unroll") for (int k = 0; k < 2; ++k) dst[m][k] = *(const PG8_LAS bf16x8*)(lds + PG8_SA(b, h) + aoff + m * 2048 + k * 1024); } while (0)
#define PG8_LDB(dst, b, h) do { _Pragma("unroll") for (int n = 0; n < 2; ++n) _Pragma("unroll") for (int k = 0; k < 2; ++k) dst[n][k] = *(const PG8_LAS bf16x8*)(lds + PG8_SB(b, h) + boff + n * 2048 + k * 1024); } while (0)
#define PG8_MMA(ai, bj, At, Bt) do { __builtin_amdgcn_s_setprio(1); _Pragma("unroll") for (int m = 0; m < 4; ++m) _Pragma("unroll") for (int n = 0; n < 2; ++n) _Pragma("unroll") for (int k = 0; k < 2; ++k) \
        acc[ai][bj][m][n] = __builtin_amdgcn_mfma_f32_16x16x32_bf16(Bt[n][k], At[m][k], acc[ai][bj][m][n], 0, 0, 0); __builtin_amdgcn_s_setprio(0); } while (0)
#define PG8_WAIT_V(n) asm volatile("s_waitcnt vmcnt(" #n ")" ::: "memory")
#define PG8_WAIT_L(n) asm volatile("s_waitcnt lgkmcnt(" #n ")" ::: "memory")
#define PG8_BAR __builtin_amdgcn_s_barrier()
#define PG8_SCHED __builtin_amdgcn_sched_barrier(0)
    Unit cur, nxt; int ui = 0;
    if (!S.next(0, cur)) return;
    f32x4 acc[2][2][4][2];
#pragma unroll
    for (int a = 0; a < 2; ++a)
#pragma unroll
        for (int b = 0; b < 2; ++b)
#pragma unroll
            for (int m = 0; m < 4; ++m)
#pragma unroll
                for (int n = 0; n < 2; ++n) acc[a][b][m][n] = (f32x4){0.f, 0.f, 0.f, 0.f};
    bf16x8 At[4][2], B0[2][2], B1[2][2];
    const char* cA = (const char*)g.A + (size_t)cur.pm * tstepA; const char* cB = (const char*)g.Bt + (size_t)cur.pn * tstepB;
    S.a_ready(cur);
    if constexpr (SP2) {
        PG8_STAGE(PG8_SB(0, 0), cB, voffB); PG8_STAGE(PG8_SB(0, 1), cB + hstepB, voffB); PG8_STAGE(PG8_SA(0, 0), cA, voffA); PG8_STAGE(PG8_SA(0, 1), cA + hstepA, voffA);
        if (wr == 1) PG8_BAR;
        PG8_WAIT_V(2); PG8_BAR;
        PG8_STAGE(PG8_SB(1, 0), cB + kstep, voffB); PG8_STAGE(PG8_SA(1, 0), cA + kstep, voffA); PG8_STAGE(PG8_SB(1, 1), cB + hstepB + kstep, voffB);
        PG8_WAIT_V(6); PG8_BAR;
    } else {
        PG8_STAGE(PG8_SB(0, 0), cB, voffB); PG8_STAGE(PG8_SA(0, 0), cA, voffA); PG8_STAGE(PG8_SB(0, 1), cB + hstepB, voffB); PG8_STAGE(PG8_SA(0, 1), cA + hstepA, voffA);
        if (wr == 1) PG8_BAR;
        PG8_WAIT_V(4); PG8_BAR;
        PG8_STAGE(PG8_SB(1, 0), cB + kstep, voffB); PG8_STAGE(PG8_SA(1, 0), cA + kstep, voffA); PG8_STAGE(PG8_SB(1, 1), cB + hstepB + kstep, voffB);
        PG8_WAIT_V(6); PG8_BAR;
    }
    for (;;) {
        const bool has_next = S.next(ui + 1, nxt);
        const char* nA = has_next ? (const char*)g.A + (size_t)nxt.pm * tstepA : cA; const char* nB = has_next ? (const char*)g.Bt + (size_t)nxt.pn * tstepB : cB;
        for (int t = 0; t < nt; t += 2) {
            const bool last = (t == nt - 2);
            const char* a1 = cA + (size_t)(t + 1) * kstep;
            const char* a2 = last ? nA : cA + (size_t)(t + 2) * kstep; const char* b2 = last ? nB : cB + (size_t)(t + 2) * kstep;
            const char* a3 = a2 + kstep; const char* b3 = b2 + kstep;
            if (last && has_next) S.a_ready(nxt);
            if constexpr (SP2) {
            PG8_LDB(B0, 0, 0); PG8_LDB(B1, 0, 1); PG8_SCHED; PG8_LDA(At, 0, 0); PG8_STAGE(PG8_SA(1, 1), a1 + hstepA, voffA);
            PG8_WAIT_V(8); PG8_WAIT_L(0); PG8_BAR; PG8_MMA(0, 0, At, B0); PG8_MMA(0, 1, At, B1); PG8_BAR; PG8_SCHED;
            PG8_LDA(At, 0, 1); PG8_STAGE(PG8_SB(0, 0), b2, voffB); PG8_STAGE(PG8_SB(0, 1), b2 + hstepB, voffB); PG8_STAGE(PG8_SA(0, 0), a2, voffA);
            PG8_WAIT_V(8); PG8_WAIT_L(0); PG8_BAR; PG8_MMA(1, 0, At, B0); PG8_MMA(1, 1, At, B1); PG8_BAR; PG8_SCHED;
            PG8_LDB(B0, 1, 0); PG8_LDB(B1, 1, 1); PG8_SCHED; PG8_LDA(At, 1, 0); PG8_STAGE(PG8_SA(0, 1), a2 + hstepA, voffA);
            PG8_WAIT_V(8); PG8_WAIT_L(0); PG8_BAR; PG8_MMA(0, 0, At, B0); PG8_MMA(0, 1, At, B1); PG8_BAR; PG8_SCHED;
            PG8_LDA(At, 1, 1); PG8_STAGE(PG8_SB(1, 0), b3, voffB); PG8_STAGE(PG8_SB(1, 1), b3 + hstepB, voffB); PG8_STAGE(PG8_SA(1, 0), a3, voffA);
            PG8_WAIT_V(8); PG8_WAIT_L(0); PG8_BAR; PG8_MMA(1, 0, At, B0); PG8_MMA(1, 1, At, B1); PG8_BAR; PG8_SCHED;
            } else {
            PG8_LDB(B0, 0, 0); PG8_SCHED; PG8_LDA(At, 0, 0); PG8_STAGE(PG8_SA(1, 1), a1 + hstepA, voffA);
            PG8_WAIT_L(8); PG8_BAR; PG8_WAIT_L(0); PG8_MMA(0, 0, At, B0); PG8_BAR; PG8_SCHED;
            PG8_LDB(B1, 0, 1); PG8_STAGE(PG8_SB(0, 0), b2, voffB);
            PG8_BAR; PG8_WAIT_L(0); PG8_MMA(0, 1, At, B1); PG8_BAR;
            PG8_LDA(At, 0, 1); PG8_STAGE(PG8_SA(0, 0), a2, voffA);
            PG8_BAR; PG8_WAIT_L(0); PG8_MMA(1, 0, At, B0); PG8_BAR; PG8_SCHED;
            PG8_STAGE(PG8_SB(0, 1), b2 + hstepB, voffB);
            PG8_WAIT_V(6); PG8_BAR; PG8_MMA(1, 1, At, B1); PG8_BAR;
            PG8_LDB(B0, 1, 0); PG8_SCHED; PG8_LDA(At, 1, 0); PG8_STAGE(PG8_SA(0, 1), a2 + hstepA, voffA);
            PG8_WAIT_L(8); PG8_BAR; PG8_WAIT_L(0); PG8_MMA(0, 0, At, B0); PG8_BAR; PG8_SCHED;
            PG8_LDB(B1, 1, 1); PG8_STAGE(PG8_SB(1, 0), b3, voffB);
            PG8_BAR; PG8_WAIT_L(0); PG8_MMA(0, 1, At, B1); PG8_BAR;
            PG8_LDA(At, 1, 1); PG8_STAGE(PG8_SA(1, 0), a3, voffA);
            PG8_BAR; PG8_WAIT_L(0); PG8_MMA(1, 0, At, B0); PG8_BAR; PG8_SCHED;
            PG8_STAGE(PG8_SB(1, 1), b3 + hstepB, voffB);
            PG8_WAIT_V(6); PG8_BAR; PG8_MMA(1, 1, At, B1); PG8_BAR;
            }
        }
        if constexpr (ALIGN_EPI) { if (wr == 0) PG8_BAR; }
        if constexpr (!Epi::AFTER_DRAIN) { E(acc, cur, wr, wc, fr, fq); S.done(cur); }
        if (!has_next) break;
#pragma unroll
        for (int a = 0; a < 2; ++a)
#pragma unroll
            for (int b = 0; b < 2; ++b)
#pragma unroll
                for (int m = 0; m < 4; ++m)
#pragma unroll
                    for (int n = 0; n < 2; ++n) acc[a][b][m][n] = (f32x4){0.f, 0.f, 0.f, 0.f};
        cur = nxt; cA = nA; cB = nB; ++ui;
        if constexpr (ALIGN_EPI) { if (wr == 1) PG8_BAR; }
    }
    PG8_WAIT_V(0);
    if constexpr (!ALIGN_EPI) { if (wr == 0) PG8_BAR; }
    PG8_BAR;
    if constexpr (Epi::AFTER_DRAIN) { E.fused(acc, cur, wr, wc, fr, fq, lds, wid, lane); S.done(cur); }
#undef PG8_SA
#undef PG8_SB
#undef PG8_STAGE
#undef PG8_LDA
#undef PG8_LDB
#undef PG8_MMA
#undef PG8_WAIT_V
#undef PG8_WAIT_L
#undef PG8_BAR
#undef PG8_SCHED
}
}
#define GAS __attribute__((address_space(1)))
#define LAS __attribute__((address_space(3)))
typedef unsigned short bf16;
typedef unsigned v4u __attribute__((ext_vector_type(4)));
typedef float f32x4 __attribute__((ext_vector_type(4)));
typedef short bf16x8 __attribute__((ext_vector_type(8)));
typedef GAS unsigned gu32;
typedef GAS unsigned long long gu64;
#define RLX_AGENT __ATOMIC_RELAXED, __HIP_MEMORY_SCOPE_AGENT
#define LDS_WAIT() asm volatile("s_waitcnt lgkmcnt(0)" ::: "memory")
#define VM_WAIT() asm volatile("s_waitcnt vmcnt(0)" ::: "memory")
__device__ __forceinline__ unsigned long long rt() { return __builtin_amdgcn_s_memrealtime(); }
__device__ __forceinline__ unsigned f2bf(float f) { unsigned u = __builtin_bit_cast(unsigned, f); return (u + 0x7fffu + ((u >> 16) & 1u)) >> 16; }
__device__ __forceinline__ unsigned pk2(float lo, float hi) { return f2bf(lo) | (f2bf(hi) << 16); }

#define XB_TMO      128
#define XB_XCNT(j)  (256  + 64 * (j))
#define XB_XSUB(j)  (1280 + 64 * (j))
#define XB_XGEN(j)  (2304 + 64 * (j))
#define XB_TOP      3328
#define XB_TOPGEN   3392
#define XCD_BAR_WORDS 3456
#define XB_SPIN_CAP (1u << 18)

__device__ __forceinline__ unsigned xb_ld(unsigned* p)              { return __hip_atomic_load(p, __ATOMIC_RELAXED, __HIP_MEMORY_SCOPE_AGENT); }
__device__ __forceinline__ unsigned xb_add(unsigned* p, unsigned v) { return __hip_atomic_fetch_add(p, v, __ATOMIC_RELAXED, __HIP_MEMORY_SCOPE_AGENT); }
__device__ __forceinline__ unsigned xb_xcc_id() { return (unsigned)__builtin_amdgcn_s_getreg((3 << 11) | 20) & 0xFu; }
#define XB_SPIN(cond, bar) do { unsigned _sp = 0; while (cond) { __builtin_amdgcn_s_sleep(1); \
    if ((++_sp & 255u) == 0u) { if (xb_ld(&(bar)[XB_TMO])) break; if (_sp > XB_SPIN_CAP) { atomicAdd(&(bar)[XB_TMO], 1u); break; } } } } while (0)

struct XcdBarrier {
    unsigned* bar; unsigned x;
    volatile LAS unsigned* st;
};

__device__ __forceinline__ XcdBarrier xcd_barrier_post(unsigned* bar, volatile LAS unsigned* st) {
    XcdBarrier b; b.bar = bar; b.x = xb_xcc_id(); b.st = st;
    if (threadIdx.x == 0) (void)xb_add(&bar[XB_XCNT(b.x)], 1u);
    return b;
}
__device__ __forceinline__ void xcd_barrier_complete(unsigned* bar, unsigned x, unsigned& nloc, unsigned& nx) {
    const unsigned G = gridDim.x * gridDim.y * gridDim.z;
    unsigned sum, cnt, mine, sp = 0u;
    for (;;) {
        sum = 0u; cnt = 0u; mine = 0u;
#pragma unroll
        for (unsigned j = 0; j < 16; ++j) { const unsigned c = xb_ld(&bar[XB_XCNT(j)]); sum += c; cnt += (c > 0u) ? 1u : 0u; mine = (j == x) ? c : mine; }
        if (sum == G) break;
        __builtin_amdgcn_s_sleep(1);
        if ((++sp & 255u) == 0u) { if (xb_ld(&bar[XB_TMO])) break; if (sp > XB_SPIN_CAP) { atomicAdd(&bar[XB_TMO], 1u); break; } }
    }
    nloc = mine > 0u ? mine : 1u; nx = cnt > 0u ? cnt : 1u;
}

__device__ __forceinline__ void xcd_barrier(const XcdBarrier& b) {
    asm volatile("s_waitcnt vmcnt(0)" ::: "memory");
    __syncthreads();
    if (threadIdx.x == 0) {
        unsigned* bar = b.bar;
        __builtin_amdgcn_s_waitcnt(0);
        unsigned nloc = b.st[0], nx = b.st[1];
        if (nloc == 0u) { xcd_barrier_complete(bar, b.x, nloc, nx); b.st[0] = nloc; b.st[1] = nx; }
        const unsigned old = xb_add(&bar[XB_XSUB(b.x)], 1u);
        const unsigned gen = old / nloc;
        if (old + 1u == (gen + 1u) * nloc) {
            __builtin_amdgcn_fence(__ATOMIC_RELEASE, "agent");
            asm volatile("s_waitcnt vmcnt(0)" ::: "memory");
            const unsigned og = xb_add(&bar[XB_TOP], 1u);
            const unsigned tg = og / nx;
            if (og + 1u == (tg + 1u) * nx) xb_add(&bar[XB_TOPGEN], 1u);
            else XB_SPIN(xb_ld(&bar[XB_TOPGEN]) == tg, bar);
            __builtin_amdgcn_fence(__ATOMIC_ACQUIRE, "agent");
            xb_add(&bar[XB_XGEN(b.x)], 1u);
            asm volatile("s_waitcnt vmcnt(0)" ::: "memory");
        } else {
            XB_SPIN(xb_ld(&bar[XB_XGEN(b.x)]) == gen, bar);
            __builtin_amdgcn_fence(__ATOMIC_ACQUIRE, "agent");
            asm volatile("s_waitcnt vmcnt(0)" ::: "memory");
        }
    }
    __syncthreads();
}
constexpr int NWAVES = 8;
constexpr int BATCH = 16, SEQ = 2048, DM = 1024, M = BATCH * SEQ;
constexpr int L0P = 3584;
constexpr int L1P = 2048;
constexpr int DFF = 2816;
constexpr float ALPHA = 1.4142135623730951f;
typedef unsigned short bf16_t;
typedef float f32x16 __attribute__((ext_vector_type(16)));

constexpr size_t MiB = 1u << 20;
constexpr size_t WS_CTL = 0, CTL_ZERO_BYTES = 1 * MiB;
constexpr int CW_BAR = 4096;
constexpr size_t WS_W0IN = 2 * MiB, WS_W0OUT = 9 * MiB, WS_WUP0 = 11 * MiB, WS_WDN0 = 22 * MiB, WS_W1IN = 28 * MiB, WS_WUQ = 32 * MiB, WS_WUKV = 33 * MiB,
                 WS_W1OUT = 34 * MiB, WS_WUP1 = 36 * MiB, WS_WDN1 = 47 * MiB;
constexpr size_t WS_XB = 56 * MiB, WS_YMIX = 120 * MiB, WS_BIG = 184 * MiB;
constexpr size_t WS_G = 408 * MiB, WS_BONUS = 440 * MiB, WS_DT = 441 * MiB, WS_XST = 442 * MiB, WS_BT = 474 * MiB, WS_ASUM = 490 * MiB;
constexpr size_t WS_SLOC = 120 * MiB;
constexpr size_t WS_W2T = 53 * MiB, WS_A2T = 53 * MiB + 256 * 1024, WS_G2T = 53 * MiB + 512 * 1024;
constexpr size_t WS_GU = 120 * MiB;
constexpr size_t WS_PROJ1 = 184 * MiB, WS_QM = 312 * MiB, WS_KVM = 360 * MiB, WS_KPE = 424 * MiB, WS_RS = 426 * MiB;
constexpr size_t WS_CSTAB = 492 * MiB;
constexpr size_t WS_VTS = 428 * MiB, WS_VTM = 460 * MiB;
constexpr size_t WS_NEED = 497 * MiB;

constexpr int RING_BYTES = 131072;
constexpr int LDSCTL_OFF = 146432, MISC_OFF = LDSCTL_OFF + 320;
constexpr int LDS_BYTES = 147456;

__device__ __forceinline__ float bf2f(bf16_t b) { return __builtin_bit_cast(float, (unsigned)b << 16); }
__device__ __forceinline__ float sigmoidf_(float x) { return 1.f / (1.f + expf(-x)); }
__device__ __forceinline__ float softplusf_(float x) { return fmaxf(x, 0.f) + log1pf(expf(-fabsf(x))); }
__device__ __forceinline__ float siluf_(float x) { return x / (1.f + expf(-x)); }
__device__ __forceinline__ float wave_sum(float v) {
#pragma unroll
    for (int o = 1; o < 64; o <<= 1) v += __shfl_xor(v, o);
    return v;
}
#define WSYNC() asm volatile("s_waitcnt lgkmcnt(0)" ::: "memory")
typedef float f32x2_t __attribute__((ext_vector_type(2)));
typedef __bf16 bf16x2_t __attribute__((ext_vector_type(2)));
typedef unsigned u32x2 __attribute__((ext_vector_type(2)));
__device__ __forceinline__ unsigned cvtpk(float lo, float hi) { f32x2_t v = {lo, hi}; bf16x2_t b = __builtin_convertvector(v, bf16x2_t); return __builtin_bit_cast(unsigned, b); }
__device__ __forceinline__ float bflo(unsigned u) { return __builtin_bit_cast(float, u << 16); }
__device__ __forceinline__ float bfhi(unsigned u) { return __builtin_bit_cast(float, u & 0xffff0000u); }
__device__ __forceinline__ bf16_t bf1(float x) { return (bf16_t)(cvtpk(x, x) & 0xffffu); }
__device__ __forceinline__ bf16x8 pack8(float a0, float a1, float a2, float a3, float a4, float a5, float a6, float a7) {
    v4u w; w.x = cvtpk(a0, a1); w.y = cvtpk(a2, a3); w.z = cvtpk(a4, a5); w.w = cvtpk(a6, a7); return __builtin_bit_cast(bf16x8, w); }
template <int CTRL> __device__ __forceinline__ float dpp_mov(float x) { return __builtin_bit_cast(float, __builtin_amdgcn_update_dpp(0, __builtin_bit_cast(int, x), CTRL, 0xF, 0xF, true)); }
__device__ __forceinline__ float rowsum16(float x) { x += dpp_mov<0x128>(x); x += dpp_mov<0x124>(x); x += dpp_mov<0x122>(x); x += dpp_mov<0x121>(x); return x; }
__device__ __forceinline__ float rl(float x, int l) { return __builtin_bit_cast(float, __builtin_amdgcn_readlane(__builtin_bit_cast(int, x), l)); }
__device__ __forceinline__ float wave_sum_dpp(float x) { x = rowsum16(x); return (rl(x, 0) + rl(x, 16)) + (rl(x, 32) + rl(x, 48)); }

__device__ __forceinline__ void transpose_matrix(const float* __restrict__ W, int K, int N, bf16_t* __restrict__ WT, int Npad, int ldt, LAS float* scr, int gw, int NGW, int lane, const float* __restrict__ kscale, int& tr_base, bool ffn_interleave = false) {
    (void)scr;
    const int nblk = Npad / 64, nit = (K / 64) * nblk;
    int it0 = gw - (tr_base % NGW); if (it0 < 0) it0 += NGW; tr_base += nit;
    for (int it = it0; it < nit; it += NGW) {
        const int kb = it / nblk, nb = it - kb * nblk, n = nb * 64 + lane, k0 = kb * 64;
        const bool ok = n < N; const float* src = W + (size_t)k0 * N + (ok ? n : 0);
#pragma unroll
        for (int hc = 0; hc < 2; ++hc) {
            float v[32];
#pragma unroll
            for (int i = 0; i < 32; ++i) v[i] = src[(size_t)(hc * 32 + i) * N];
#pragma unroll
            for (int c = 0; c < 4; ++c) { float u[8];
#pragma unroll
                for (int i = 0; i < 8; ++i) { u[i] = ok ? v[c * 8 + i] : 0.f; if (kscale) u[i] *= kscale[k0 + hc * 32 + c * 8 + i]; }
                v4u o; o.x = cvtpk(u[0], u[1]); o.y = cvtpk(u[2], u[3]); o.z = cvtpk(u[4], u[5]); o.w = cvtpk(u[6], u[7]);
                const int nr = ffn_interleave ? ((n < DFF) ? 256 * (n >> 7) + (n & 127) : 256 * ((n - DFF) >> 7) + 128 + ((n - DFF) & 127)) : n;
                *(v4u*)(WT + (size_t)nr * ldt + k0 + hc * 32 + c * 8) = o; }
        }
    }
}

template <int MODE> __device__ __forceinline__ void ln_rows(float* h, bf16_t* hb, float* stats, const float* __restrict__ g, const float* __restrict__ b, int gw, int NGW, int lane) {
    for (int row = gw * 2; row < M; row += NGW * 2) {
        float* p = h + (size_t)row * DM;
        f32x4 v[2][4]; float s[2] = {0.f, 0.f};
#pragma unroll
        for (int r = 0; r < 2; ++r)
#pragma unroll
            for (int j = 0; j < 4; ++j) v[r][j] = *(const f32x4*)(p + r * DM + 4 * lane + 256 * j);
#pragma unroll
        for (int r = 0; r < 2; ++r)
#pragma unroll
            for (int j = 0; j < 4; ++j) s[r] += (v[r][j][0] + v[r][j][1]) + (v[r][j][2] + v[r][j][3]);
        float mean[2], q[2] = {0.f, 0.f}, rstd[2];
#pragma unroll
        for (int r = 0; r < 2; ++r) { mean[r] = wave_sum_dpp(s[r]) * (1.f / DM);
#pragma unroll
            for (int j = 0; j < 4; ++j) { v[r][j] = v[r][j] - mean[r]; q[r] += (v[r][j][0] * v[r][j][0] + v[r][j][1] * v[r][j][1]) + (v[r][j][2] * v[r][j][2] + v[r][j][3] * v[r][j][3]); } }
#pragma unroll
        for (int r = 0; r < 2; ++r) rstd[r] = 1.0f / sqrtf(wave_sum_dpp(q[r]) * (1.f / DM) + 1e-5f);
        if (MODE == 1 && lane < 2) { stats[2 * (row + lane)] = lane ? mean[1] : mean[0]; stats[2 * (row + lane) + 1] = lane ? rstd[1] : rstd[0]; }
#pragma unroll
        for (int j = 0; j < 4; ++j) {
            const int c = 4 * lane + 256 * j;
            const f32x4 gg = *(const f32x4*)(g + c), bb = *(const f32x4*)(b + c);
#pragma unroll
            for (int r = 0; r < 2; ++r) {
                const f32x4 o = v[r][j] * rstd[r] * gg + bb;
                if (MODE == 1) { uint2 w; w.x = cvtpk(o[0], o[1]); w.y = cvtpk(o[2], o[3]); *(uint2*)(hb + (size_t)(row + r) * DM + c) = w; }
                else *(f32x4*)(p + r * DM + c) = o;
            }
        }
    }
}

__device__ __forceinline__ void rwkv_naive_chain(int chain, int lane, LAS float* sm, const bf16_t* __restrict__ proj, const float* __restrict__ mix, const float* __restrict__ w0, const float* __restrict__ w2,
                                                 const float* __restrict__ a0, const float* __restrict__ a2, const float* __restrict__ g2, const float* __restrict__ k_k,
                                                 const float* __restrict__ k_a, const float* __restrict__ r_k, const float* __restrict__ ln_g, const float* __restrict__ ln_b, bf16_t* __restrict__ ymix) {
    LAS float* s_w2 = sm; LAS float* s_a2 = sm + 4096; LAS float* s_g2 = sm + 8192; LAS float* s_tw = sm + 16384; LAS float* s_al = s_tw + 64; LAS float* s_sg = s_tw + 128;
    LAS float* s_w = s_tw + 256; LAS float* s_k = s_tw + 320; LAS float* s_a = s_tw + 384; LAS float* s_b = s_tw + 448; LAS float* s_r = s_tw + 512;
    const int b = chain >> 3, h = chain & 7, c = h * 64 + lane;
    for (int l = 0; l < 64; ++l) { s_w2[l * 64 + lane] = w2[l * 512 + c]; s_a2[l * 64 + lane] = a2[l * 512 + c]; }
    for (int l = 0; l < 128; ++l) s_g2[l * 64 + lane] = g2[l * 512 + c];
    const float mr = mix[c], mk = mix[512 + c], mv = mix[1024 + c], mw = mix[1536 + lane], ma = mix[1600 + lane], mg0 = mix[1664 + lane], mg1 = mix[1728 + lane];
    const float w0c = w0[c], a0c = a0[c], kkc = k_k[c], kac = k_a[c], rkc = r_k[c], lgc = ln_g[c], lbc = ln_b[c];
    float S[64];
#pragma unroll
    for (int j = 0; j < 64; ++j) S[j] = 0.f;
    float pr = 0.f, pk = 0.f, pv = 0.f, pw = 0.f, pa = 0.f, pg0 = 0.f, pg1 = 0.f;
    WSYNC();
    for (int t = 0; t < SEQ; ++t) {
        const bf16_t* row = proj + (size_t)(b * SEQ + t) * L0P;
        const float cr = bf2f(row[c]), ck = bf2f(row[512 + c]), cv = bf2f(row[1024 + c]), cw = bf2f(row[1536 + lane]), ca = bf2f(row[1600 + lane]),
                    cg0 = bf2f(row[1664 + lane]), cg1 = bf2f(row[1728 + lane]);
        const float r_s = cr + (pr - cr) * mr, k_s = ck + (pk - ck) * mk, v_s = cv + (pv - cv) * mv;
        const float wl = cw + (pw - cw) * mw, al = ca + (pa - ca) * ma, g0 = cg0 + (pg0 - cg0) * mg0, g1 = cg1 + (pg1 - cg1) * mg1;
        pr = cr; pk = ck; pv = cv; pw = cw; pa = ca; pg0 = cg0; pg1 = cg1;
        s_tw[lane] = tanhf(wl); s_al[lane] = al; s_sg[lane] = sigmoidf_(g0); s_sg[64 + lane] = sigmoidf_(g1);
        WSYNC();
        float wsum = w0c, asum = a0c, gsum = 0.f;
#pragma unroll 2
        for (int l = 0; l < 64; ++l) { wsum += s_tw[l] * s_w2[l * 64 + lane]; asum += s_al[l] * s_a2[l * 64 + lane]; }
#pragma unroll 2
        for (int l = 0; l < 128; ++l) gsum += s_sg[l] * s_g2[l * 64 + lane];
        const float log_w = -softplusf_(-wsum) - 0.5f;
        const float dec = expf(-expf(log_w));
        const float a = sigmoidf_(asum);
        float kkv = k_s * kkc;
        const float nrm = sqrtf(wave_sum(kkv * kkv));
        kkv = kkv / fmaxf(nrm, 1e-12f);
        const float k2 = k_s * (1.f + (a - 1.f) * kac);
        const float bonus_s = wave_sum(r_s * k2 * rkc);
        s_w[lane] = dec; s_k[lane] = k2; s_a[lane] = -kkv; s_b[lane] = kkv * a; s_r[lane] = r_s;
        WSYNC();
        float sa = 0.f;
#pragma unroll
        for (int j = 0; j < 64; ++j) sa += S[j] * s_a[j];
        float y = 0.f;
#pragma unroll
        for (int j = 0; j < 64; ++j) { S[j] = S[j] * s_w[j] + sa * s_b[j] + v_s * s_k[j]; y += S[j] * s_r[j]; }
        const float mu = wave_sum(y) * (1.f / 64.f);
        const float d = y - mu;
        const float var = wave_sum(d * d) * (1.f / 64.f);
        const float yn = d * (1.0f / sqrtf(var + 64e-5f)) * lgc + lbc;
        const float o = (yn + bonus_s * v_s) * gsum;
        ymix[(size_t)(b * SEQ + t) * DM + c] = (bf16_t)f2bf(o);
        WSYNC();
    }
}

__device__ __forceinline__ void ssm_conv_all(const bf16_t* __restrict__ proj, const float* __restrict__ cw, const float* __restrict__ cb, const float* __restrict__ dtb,
                                             bf16_t* __restrict__ xbc, float* __restrict__ dt, int gtid, int NT) {
    for (size_t i = gtid; i < (size_t)M * 1024; i += NT) {
        const int m = (int)(i >> 10), c = (int)(i & 1023), t = m & (SEQ - 1);
        float acc = cb[c];
#pragma unroll
        for (int k = 0; k < 4; ++k) { const int tt = t - 3 + k; if (tt >= 0) acc += cw[k * 1024 + c] * bf2f(proj[(size_t)(m - 3 + k) * L0P + 2304 + c]); }
        xbc[i] = (bf16_t)f2bf(siluf_(acc));
    }
    for (int i = gtid; i < M * 8; i += NT) dt[i] = softplusf_(bf2f(proj[(size_t)(i >> 3) * L0P + 3328 + (i & 7)]) + dtb[i & 7]);
}
__device__ __forceinline__ void ssd_naive_task(int task, int lane, const bf16_t* __restrict__ xbc, const float* __restrict__ dt, const float* __restrict__ a_log, const float* __restrict__ dsk, float* __restrict__ yssm) {
    const int chain = task >> 2, q = task & 3, b = chain >> 3, h = chain & 7, g = h >> 2, p = q * 16 + (lane >> 2), nq = lane & 3;
    const float A = -expf(a_log[h]), D = dsk[h];
    float st[32];
#pragma unroll
    for (int n = 0; n < 32; ++n) st[n] = 0.f;
    for (int t = 0; t < SEQ; ++t) {
        const size_t m = (size_t)b * SEQ + t;
        const float dtv = dt[m * 8 + h], dA = expf(dtv * A);
        const float x = bf2f(xbc[m * 1024 + h * 64 + p]), xdt = x * dtv;
        const bf16_t* Bp = xbc + m * 1024 + 512 + g * 128 + nq * 32;
        const bf16_t* Cp = xbc + m * 1024 + 768 + g * 128 + nq * 32;
        float yp = 0.f;
#pragma unroll
        for (int n = 0; n < 32; ++n) { st[n] = st[n] * dA + xdt * bf2f(Bp[n]); yp += st[n] * bf2f(Cp[n]); }
        yp += __shfl_xor(yp, 1); yp += __shfl_xor(yp, 2);
        if (nq == 0) yssm[m * 512 + h * 64 + p] = yp + D * x;
    }
}
template <bool ST = true> __device__ __forceinline__ void ssm_gate_norm_all(const bf16_t* __restrict__ yssm, const bf16_t* __restrict__ proj, const float* __restrict__ ng, bf16_t* __restrict__ ymix, int wv0, int wvend, int lane) {
    for (int wvb = wv0 * 4 - (wv0 & ~7) * 3; wvb < wvend; wvb += NWAVES * 4) {
        float u[4][4], q[4];
#pragma unroll
        for (int k = 0; k < 4; ++k) { const int wv = wvb + k, m = wv >> 1, g = wv & 1; q[k] = 0.f;
#pragma unroll
            for (int j = 0; j < 4; ++j) { const int c = g * 256 + j * 64 + lane; const float z = bf2f(proj[(size_t)m * L0P + 1792 + c]); u[k][j] = bf2f(yssm[(size_t)m * 512 + c]) * (z * __builtin_amdgcn_rcpf(1.f + __expf(-z))); q[k] += u[k][j] * u[k][j]; } }
#pragma unroll
        for (int k = 0; k < 4; ++k) { const int wv = wvb + k, m = wv >> 1, g = wv & 1;
            const float rs = __builtin_amdgcn_rsqf(wave_sum_dpp(q[k]) * (1.f / 256.f) + 1e-5f);
#pragma unroll
            for (int j = 0; j < 4; ++j) { const int c = g * 256 + j * 64 + lane; const float o_ = u[k][j] * rs * ng[c]; if (ST) ymix[(size_t)m * DM + 512 + c] = bf1(o_); else asm volatile("" :: "v"(o_)); } }
    }
}
template <bool ST = true> __device__ __forceinline__ void ffn_act_all(bf16_t* gu, const float* __restrict__ cw, const float* __restrict__ cb, int gtid, int NT) {
    constexpr int NCH = DFF / 8, NSTRIP = M / 32;
    for (int task = gtid; task < NSTRIP * NCH; task += NT) {
        const int strip = task / NCH, q = task - strip * NCH, c0 = q * 8, m0 = strip * 32;
        float w0[8], w1[8], w2[8], bb[8], g2[8], g1[8];
#pragma unroll
        for (int j = 0; j < 8; j += 4) { const f32x4 a = *(const f32x4*)(cw + c0 + j), b = *(const f32x4*)(cw + DFF + c0 + j), c = *(const f32x4*)(cw + 2 * DFF + c0 + j), d = *(const f32x4*)(cb + c0 + j);
#pragma unroll
            for (int k = 0; k < 4; ++k) { w0[j + k] = a[k]; w1[j + k] = b[k]; w2[j + k] = c[k]; bb[j + k] = d[k]; } }
        bf16_t* base = gu + (size_t)m0 * (2 * DFF) + c0;
        if ((m0 & (SEQ - 1)) != 0) { const v4u a = *(const v4u*)(base - 2 * (2 * DFF)), b = *(const v4u*)(base - (2 * DFF));
            g2[0] = bflo(a.x); g2[1] = bfhi(a.x); g2[2] = bflo(a.y); g2[3] = bfhi(a.y); g2[4] = bflo(a.z); g2[5] = bfhi(a.z); g2[6] = bflo(a.w); g2[7] = bfhi(a.w);
            g1[0] = bflo(b.x); g1[1] = bfhi(b.x); g1[2] = bflo(b.y); g1[3] = bfhi(b.y); g1[4] = bflo(b.z); g1[5] = bfhi(b.z); g1[6] = bflo(b.w); g1[7] = bfhi(b.w); }
        else {
#pragma unroll
            for (int j = 0; j < 8; ++j) { g2[j] = 0.f; g1[j] = 0.f; } }
#pragma unroll 4
        for (int r = 0; r < 32; ++r) {
            const v4u gv = *(const v4u*)(base + (size_t)r * (2 * DFF)), uv = *(const v4u*)(base + (size_t)r * (2 * DFF) + DFF);
            const unsigned gw_[4] = {gv.x, gv.y, gv.z, gv.w}, uw_[4] = {uv.x, uv.y, uv.z, uv.w};
            unsigned ow[4];
#pragma unroll
            for (int k = 0; k < 4; ++k) {
                const float ga = bflo(gw_[k]), gb = bfhi(gw_[k]);
                const float ya = bb[2 * k] + w0[2 * k] * g2[2 * k] + w1[2 * k] * g1[2 * k] + w2[2 * k] * ga;
                const float yb = bb[2 * k + 1] + w0[2 * k + 1] * g2[2 * k + 1] + w1[2 * k + 1] * g1[2 * k + 1] + w2[2 * k + 1] * gb;
                g2[2 * k] = g1[2 * k]; g1[2 * k] = ga; g2[2 * k + 1] = g1[2 * k + 1]; g1[2 * k + 1] = gb;
                ow[k] = cvtpk(ya / (1.f + __expf(-ya)) * bflo(uw_[k]), yb / (1.f + __expf(-yb)) * bfhi(uw_[k]));
            }
            if (ST) *(v4u*)(base + (size_t)r * (2 * DFF) + DFF) = (v4u){ow[0], ow[1], ow[2], ow[3]}; else asm volatile("" :: "v"(ow[0]), "v"(ow[1]), "v"(ow[2]), "v"(ow[3]));
        }
    }
}
template <bool ST = true> __device__ __forceinline__ void mla_prep_all(const bf16_t* __restrict__ proj1, const int* __restrict__ pos, float* __restrict__ rs, bf16_t* __restrict__ kpe, float* __restrict__ cstab, int gw, int NGW, int lane) {
    for (int m4 = gw * 4; m4 < M; m4 += NGW * 4) {
        const int mt = m4 + (lane >> 4), fi = lane & 15;
        const double inv = exp2(-(double)(2 * fi) * (13.287712379549449 / 32.0));
        const double ang = (double)pos[mt] * inv;
        const float cs = (float)cos(ang), sn = (float)sin(ang);
        cstab[(size_t)mt * 32 + fi] = cs; cstab[(size_t)mt * 32 + 16 + fi] = sn;
        { const bf16_t* row = proj1 + (size_t)mt * L1P; const float x1 = bf2f(row[1920 + fi]), x2 = bf2f(row[1936 + fi]);
          kpe[(size_t)mt * 32 + fi] = bf1(x1 * cs - x2 * sn); kpe[(size_t)mt * 32 + 16 + fi] = bf1(x2 * cs + x1 * sn); }
        float q[4], k[4];
#pragma unroll
        for (int u = 0; u < 4; ++u) { const bf16_t* row = proj1 + (size_t)(m4 + u) * L1P; q[u] = 0.f; k[u] = 0.f;
#pragma unroll
            for (int j = 0; j < 4; ++j) { const float v = bf2f(row[1536 + j * 64 + lane]); q[u] += v * v; }
#pragma unroll
            for (int j = 0; j < 2; ++j) { const float v = bf2f(row[1792 + j * 64 + lane]); k[u] += v * v; } }
#pragma unroll
        for (int u = 0; u < 4; ++u) { q[u] = wave_sum_dpp(q[u]); k[u] = wave_sum_dpp(k[u]); }
        if (lane < 4) { const float qq = lane == 0 ? q[0] : lane == 1 ? q[1] : lane == 2 ? q[2] : q[3], kk2 = lane == 0 ? k[0] : lane == 1 ? k[1] : lane == 2 ? k[2] : k[3];
            rs[(size_t)(m4 + lane) * 2] = 1.0f / sqrtf(qq * (1.f / 256.f) + 1e-6f); rs[(size_t)(m4 + lane) * 2 + 1] = 1.0f / sqrtf(kk2 * (1.f / 128.f) + 1e-6f); }
    }
}
template <bool ST = true> __device__ __forceinline__ void rope_q_all(bf16_t* qm, const float* __restrict__ cstab, int gtid, int NT) {
    for (int i = gtid; i < M * 16; i += NT) {
        const int m = i >> 4, h = (i >> 1) & 7, k0 = (i & 1) * 8;
        bf16_t* p = qm + (size_t)m * 768 + h * 96 + 64 + k0;
        const v4u a = *(const v4u*)p, b = *(const v4u*)(p + 16);
        const f32x4 c0 = *(const f32x4*)(cstab + (size_t)m * 32 + k0), c1 = *(const f32x4*)(cstab + (size_t)m * 32 + k0 + 4), s0 = *(const f32x4*)(cstab + (size_t)m * 32 + 16 + k0), s1 = *(const f32x4*)(cstab + (size_t)m * 32 + 16 + k0 + 4);
        const unsigned au[4] = {a.x, a.y, a.z, a.w}, bu[4] = {b.x, b.y, b.z, b.w};
        const float cs[8] = {c0[0], c0[1], c0[2], c0[3], c1[0], c1[1], c1[2], c1[3]}, sn[8] = {s0[0], s0[1], s0[2], s0[3], s1[0], s1[1], s1[2], s1[3]};
        unsigned o1[4], o2[4];
#pragma unroll
        for (int q = 0; q < 4; ++q) { const float x1a = bflo(au[q]), x1b = bfhi(au[q]), x2a = bflo(bu[q]), x2b = bfhi(bu[q]);
            o1[q] = cvtpk(x1a * cs[2 * q] - x2a * sn[2 * q], x1b * cs[2 * q + 1] - x2b * sn[2 * q + 1]);
            o2[q] = cvtpk(x2a * cs[2 * q] + x1a * sn[2 * q], x2b * cs[2 * q + 1] + x1b * sn[2 * q + 1]); }
        if (ST) { *(v4u*)p = (v4u){o1[0], o1[1], o1[2], o1[3]}; *(v4u*)(p + 16) = (v4u){o2[0], o2[1], o2[2], o2[3]}; }
    }
}
__device__ __forceinline__ void sb_naive_task(int qblk, int bh, int lane, const bf16_t* __restrict__ proj1, bf16_t* __restrict__ ymix) {
    const int b = bh >> 3, h = bh & 7, t = qblk * 64 + lane;
    const size_t mrow = (size_t)b * SEQ;
    float q[64], o[64];
#pragma unroll
    for (int d = 0; d < 64; ++d) { q[d] = bf2f(proj1[(mrow + t) * L1P + h * 64 + d]) * 0.125f; o[d] = 0.f; }
    float cum = 0.f;
    const int smax = qblk * 64 + 63;
    for (int s = smax - 1; s >= 0; --s) {
        const bf16_t* kr = proj1 + (mrow + s) * L1P + 512 + h * 64;
        const bf16_t* vr = proj1 + (mrow + s) * L1P + 1024 + h * 64;
        float z = 0.f;
#pragma unroll
        for (int d = 0; d < 64; ++d) z += q[d] * bf2f(kr[d]);
        if (s < t) {
            const float lsp = -softplusf_(-z);
            const float lsn = -softplusf_(z);
            const float att = expf(lsp + cum);
            cum += lsn;
#pragma unroll
            for (int d = 0; d < 64; ++d) o[d] += att * bf2f(vr[d]);
        }
    }
#pragma unroll
    for (int d = 0; d < 64; ++d) ymix[(mrow + t) * DM + h * 64 + d] = (bf16_t)f2bf(o[d]);
}
__device__ __forceinline__ void mla_naive_task(int qblk, int bh, int lane, const bf16_t* __restrict__ qm, const bf16_t* __restrict__ kvm, const bf16_t* __restrict__ kpe, bf16_t* __restrict__ ymix) {
    const int b = bh >> 3, h = bh & 7, t = qblk * 64 + lane;
    const size_t mrow = (size_t)b * SEQ;
    const float scale = 0.10206207261596577f;
    float q[96], o[64];
#pragma unroll
    for (int d = 0; d < 96; ++d) q[d] = bf2f(qm[(mrow + t) * 768 + h * 96 + d]) * scale;
#pragma unroll
    for (int d = 0; d < 64; ++d) o[d] = 0.f;
    float mx = -1e30f, l = 0.f;
    const int smax = qblk * 64 + 63;
    for (int s = 0; s <= smax; ++s) {
        const bf16_t* kr = kvm + (mrow + s) * 1024 + h * 128;
        const bf16_t* pr = kpe + (mrow + s) * 32;
        float z = 0.f;
#pragma unroll
        for (int d = 0; d < 64; ++d) z += q[d] * bf2f(kr[d]);
#pragma unroll
        for (int d = 0; d < 32; ++d) z += q[64 + d] * bf2f(pr[d]);
        if (s <= t) {
            const float mn = fmaxf(mx, z), f = expf(mx - mn), pz = expf(z - mn);
            l = l * f + pz; mx = mn;
#pragma unroll
            for (int d = 0; d < 64; ++d) o[d] = o[d] * f + pz * bf2f(kr[64 + d]);
        }
    }
    const float il = 1.f / l;
#pragma unroll
    for (int d = 0; d < 64; ++d) ymix[(mrow + t) * DM + 512 + h * 64 + d] = (bf16_t)f2bf(o[d] * il);
}


__device__ __forceinline__ int crow(int r, int hi) { return (r & 3) + 8 * (r >> 2) + 4 * hi; }
#define MFMA32(a, b, c) __builtin_amdgcn_mfma_f32_32x32x16_bf16((a), (b), (c), 0, 0, 0)
constexpr int STG_PITCH = 72;
__device__ __forceinline__ void transpose_tile64(const bf16_t* __restrict__ src, int sp, bf16_t* __restrict__ dst, int dp, LAS bf16_t* scr, int lane) {
#pragma unroll
    for (int i = 0; i < 8; ++i) { const int row = i * 8 + (lane >> 3), ch = lane & 7; const v4u v = *(const v4u*)(src + (size_t)row * sp + ch * 8); *(LAS v4u*)(scr + row * STG_PITCH + ch * 8) = v; }
    WSYNC();
#pragma unroll
    for (int i = 0; i < 8; ++i) { const int d = i * 8 + (lane >> 3), tc = lane & 7; const LAS bf16_t* p = scr + (tc * 8) * STG_PITCH + d;
        v4u o; o.x = (unsigned)p[0] | ((unsigned)p[STG_PITCH] << 16); o.y = (unsigned)p[2 * STG_PITCH] | ((unsigned)p[3 * STG_PITCH] << 16);
        o.z = (unsigned)p[4 * STG_PITCH] | ((unsigned)p[5 * STG_PITCH] << 16); o.w = (unsigned)p[6 * STG_PITCH] | ((unsigned)p[7 * STG_PITCH] << 16);
        *(v4u*)(dst + (size_t)d * dp + tc * 8) = o; }
    WSYNC();
}
__device__ __forceinline__ void store_OT(const f32x16 (&o)[2], float sc, LAS bf16_t* stg, bf16_t* __restrict__ dst, int lane) {
    const int l31 = lane & 31, hi = lane >> 5;
#pragma unroll
    for (int dt = 0; dt < 2; ++dt)
#pragma unroll
        for (int r = 0; r < 16; ++r) stg[l31 * STG_PITCH + 32 * dt + crow(r, hi)] = bf1(o[dt][r] * sc);
    WSYNC();
#pragma unroll
    for (int i = 0; i < 4; ++i) { const int row = i * 8 + (lane >> 3), ch = lane & 7; const v4u v = *(const LAS v4u*)(stg + row * STG_PITCH + ch * 8); *(v4u*)(dst + (size_t)row * DM + ch * 8) = v; }
    WSYNC();
}
__device__ __forceinline__ float softplus_fast(float z) { return fmaxf(z, 0.f) + __logf(1.f + __expf(-fabsf(z))); }

__device__ __forceinline__ void sb_task(int bh, int qblk, int lane, const bf16_t* __restrict__ P1, const bf16_t* __restrict__ VT, bf16_t* __restrict__ ymix, LAS bf16_t* stg) {
    const int b = bh >> 3, h = bh & 7, l31 = lane & 31, hi = lane >> 5, q0 = qblk * 32, t = q0 + l31;
    const size_t rowb = (size_t)b * SEQ;
    const bf16_t* Qp = P1 + (rowb + q0 + l31) * L1P + h * 64 + 8 * hi;
    bf16x8 qf[4];
#pragma unroll
    for (int kk = 0; kk < 4; ++kk) qf[kk] = *(const bf16x8*)(Qp + 16 * kk);
    const bf16_t* Kp = P1 + (rowb + l31) * L1P + 512 + h * 64 + 8 * hi;
    const bf16_t* Vp = VT + ((size_t)bh * 64 + l31) * SEQ + 4 * hi;
    f32x16 o[2];
#pragma unroll
    for (int r = 0; r < 16; ++r) { o[0][r] = 0.f; o[1][r] = 0.f; }
    float cum = 0.f;
    bf16x8 kf[4]; u32x2 va[2][2][2];
#define SB_LOAD(S0, KF, VA) do { _Pragma("unroll") for (int kk = 0; kk < 4; ++kk) KF[kk] = *(const bf16x8*)(Kp + (size_t)(S0) * L1P + 16 * kk); \
        _Pragma("unroll") for (int dt = 0; dt < 2; ++dt) _Pragma("unroll") for (int ks = 0; ks < 2; ++ks) { VA[dt][ks][0] = *(const u32x2*)(Vp + (size_t)dt * 32 * SEQ + (S0) + 16 * ks); VA[dt][ks][1] = *(const u32x2*)(Vp + (size_t)dt * 32 * SEQ + (S0) + 16 * ks + 8); } } while (0)
    SB_LOAD(q0, kf, va);
    for (int s0 = q0; s0 >= 0; s0 -= 32) {
        bf16x8 kn[4]; u32x2 vn[2][2][2];
        const int sn = (s0 >= 32) ? s0 - 32 : 0;
        SB_LOAD(sn, kn, vn);
        f32x16 acc;
#pragma unroll
        for (int r = 0; r < 16; ++r) acc[r] = 0.f;
#pragma unroll
        for (int kk = 0; kk < 4; ++kk) acc = MFMA32(kf[kk], qf[kk], acc);
        const bool diag = (s0 == q0);
        float lb[16], lk[16];
#pragma unroll
        for (int r = 0; r < 16; ++r) { const float z = acc[r] * 0.125f; const float sp = softplus_fast(z); float b_ = z - sp, k_ = -sp;
            if (diag) { const bool valid = (s0 + crow(r, hi)) < t; b_ = valid ? b_ : -1e30f; k_ = valid ? k_ : 0.f; }
            lb[r] = b_; lk[r] = k_; }
        float e[16], T[4], U[4];
#pragma unroll
        for (int i = 0; i < 4; ++i) { e[4 * i + 3] = 0.f; e[4 * i + 2] = lk[4 * i + 3]; e[4 * i + 1] = e[4 * i + 2] + lk[4 * i + 2]; e[4 * i] = e[4 * i + 1] + lk[4 * i + 1]; T[i] = e[4 * i] + lk[4 * i]; }
#pragma unroll
        for (int i = 0; i < 4; ++i) U[i] = __shfl_xor(T[i], 32);
        float off[4];
        { const float st2 = T[3], st1 = st2 + T[2], st0 = st1 + T[1]; const float su2 = U[3], su1 = su2 + U[2], su0 = su1 + U[1];
          const float x0 = hi ? 0.f : U[0], x1 = hi ? 0.f : U[1], x2 = hi ? 0.f : U[2], x3 = hi ? 0.f : U[3];
          off[3] = x3; off[2] = st2 + su2 + x2; off[1] = st1 + su1 + x1; off[0] = st0 + su0 + x0;
          const float total = st0 + T[0] + su0 + U[0];
#pragma unroll
          for (int r = 0; r < 16; ++r) acc[r] = __expf(lb[r] + (cum + off[r >> 2] + e[r]));
          cum += total; }
        bf16x8 pf[2];
#pragma unroll
        for (int ks = 0; ks < 2; ++ks) { v4u w; w.x = cvtpk(acc[8 * ks], acc[8 * ks + 1]); w.y = cvtpk(acc[8 * ks + 2], acc[8 * ks + 3]); w.z = cvtpk(acc[8 * ks + 4], acc[8 * ks + 5]); w.w = cvtpk(acc[8 * ks + 6], acc[8 * ks + 7]); pf[ks] = __builtin_bit_cast(bf16x8, w); }
#pragma unroll
        for (int dt = 0; dt < 2; ++dt)
#pragma unroll
            for (int ks = 0; ks < 2; ++ks) { v4u a; a.x = va[dt][ks][0].x; a.y = va[dt][ks][0].y; a.z = va[dt][ks][1].x; a.w = va[dt][ks][1].y; o[dt] = MFMA32(__builtin_bit_cast(bf16x8, a), pf[ks], o[dt]); }
        if (__all(cum < -110.f)) break;
#pragma unroll
        for (int kk = 0; kk < 4; ++kk) kf[kk] = kn[kk];
#pragma unroll
        for (int dt = 0; dt < 2; ++dt)
#pragma unroll
            for (int ks = 0; ks < 2; ++ks) { va[dt][ks][0] = vn[dt][ks][0]; va[dt][ks][1] = vn[dt][ks][1]; }
    }
#undef SB_LOAD
    store_OT(o, 1.0f, stg, ymix + (rowb + q0) * DM + h * 64, lane);
}
__device__ __forceinline__ void mla_task(int bh, int qblk, int lane, const bf16_t* __restrict__ QM, const bf16_t* __restrict__ KVM, const bf16_t* __restrict__ KPE, const bf16_t* __restrict__ VT,
                                         bf16_t* __restrict__ ymix, LAS bf16_t* stg) {
    const int b = bh >> 3, h = bh & 7, l31 = lane & 31, hi = lane >> 5, q0 = qblk * 32, t = q0 + l31;
    const size_t rowb = (size_t)b * SEQ;
    const bf16_t* Qp = QM + (rowb + q0 + l31) * 768 + h * 96 + 8 * hi;
    bf16x8 qf[6];
#pragma unroll
    for (int kk = 0; kk < 6; ++kk) qf[kk] = *(const bf16x8*)(Qp + 16 * kk);
    const bf16_t* Kn = KVM + (rowb + l31) * 1024 + h * 128 + 8 * hi;
    const bf16_t* Kr = KPE + (rowb + l31) * 32 + 8 * hi;
    const bf16_t* Vp = VT + ((size_t)bh * 64 + l31) * SEQ + 4 * hi;
    const float sc2 = 0.10206207261596577f * 1.4426950408889634f;
    f32x16 o[2];
#pragma unroll
    for (int r = 0; r < 16; ++r) { o[0][r] = 0.f; o[1][r] = 0.f; }
    float mrun = -1e30f, lsum = 0.f;
    bf16x8 kf[6]; u32x2 va[2][2][2];
#define ML_LOAD(S0, KF, VA) do { _Pragma("unroll") for (int kk = 0; kk < 4; ++kk) KF[kk] = *(const bf16x8*)(Kn + (size_t)(S0) * 1024 + 16 * kk); \
        _Pragma("unroll") for (int kk = 0; kk < 2; ++kk) KF[4 + kk] = *(const bf16x8*)(Kr + (size_t)(S0) * 32 + 16 * kk); \
        _Pragma("unroll") for (int dt = 0; dt < 2; ++dt) _Pragma("unroll") for (int ks = 0; ks < 2; ++ks) { VA[dt][ks][0] = *(const u32x2*)(Vp + (size_t)dt * 32 * SEQ + (S0) + 16 * ks); VA[dt][ks][1] = *(const u32x2*)(Vp + (size_t)dt * 32 * SEQ + (S0) + 16 * ks + 8); } } while (0)
    ML_LOAD(0, kf, va);
    for (int s0 = 0; s0 <= q0; s0 += 32) {
        bf16x8 kn[6]; u32x2 vn[2][2][2];
        const int sn = (s0 + 32 <= q0) ? s0 + 32 : s0;
        ML_LOAD(sn, kn, vn);
        f32x16 acc;
#pragma unroll
        for (int r = 0; r < 16; ++r) acc[r] = 0.f;
#pragma unroll
        for (int kk = 0; kk < 6; ++kk) acc = MFMA32(kf[kk], qf[kk], acc);
        const bool diag = (s0 == q0);
        float tmax = -1e30f;
#pragma unroll
        for (int r = 0; r < 16; ++r) { float z = acc[r] * sc2; if (diag && (s0 + crow(r, hi)) > t) z = -1e30f; acc[r] = z; tmax = fmaxf(tmax, z); }
        tmax = fmaxf(tmax, __shfl_xor(tmax, 32));
        const float mn = fmaxf(mrun, tmax), alpha = exp2f(mrun - mn); mrun = mn;
        float ps = 0.f;
#pragma unroll
        for (int r = 0; r < 16; ++r) { acc[r] = exp2f(acc[r] - mn); ps += acc[r]; }
        lsum = lsum * alpha + ps;
#pragma unroll
        for (int r = 0; r < 16; ++r) { o[0][r] *= alpha; o[1][r] *= alpha; }
        bf16x8 pf[2];
#pragma unroll
        for (int ks = 0; ks < 2; ++ks) { v4u w; w.x = cvtpk(acc[8 * ks], acc[8 * ks + 1]); w.y = cvtpk(acc[8 * ks + 2], acc[8 * ks + 3]); w.z = cvtpk(acc[8 * ks + 4], acc[8 * ks + 5]); w.w = cvtpk(acc[8 * ks + 6], acc[8 * ks + 7]); pf[ks] = __builtin_bit_cast(bf16x8, w); }
#pragma unroll
        for (int dt = 0; dt < 2; ++dt)
#pragma unroll
            for (int ks = 0; ks < 2; ++ks) { v4u a; a.x = va[dt][ks][0].x; a.y = va[dt][ks][0].y; a.z = va[dt][ks][1].x; a.w = va[dt][ks][1].y; o[dt] = MFMA32(__builtin_bit_cast(bf16x8, a), pf[ks], o[dt]); }
#pragma unroll
        for (int kk = 0; kk < 6; ++kk) kf[kk] = kn[kk];
#pragma unroll
        for (int dt = 0; dt < 2; ++dt)
#pragma unroll
            for (int ks = 0; ks < 2; ++ks) { va[dt][ks][0] = vn[dt][ks][0]; va[dt][ks][1] = vn[dt][ks][1]; }
    }
#undef ML_LOAD
    lsum += __shfl_xor(lsum, 32);
    store_OT(o, 1.0f / lsum, stg, ymix + (rowb + q0) * DM + 512 + h * 64, lane);
}


__device__ __forceinline__ void sb_wave(int bh, int qblk, int lane, const bf16_t* __restrict__ P1, const bf16_t* __restrict__ VT, bf16_t* __restrict__ ymix, LAS unsigned char* wl) {
    const int b = bh >> 3, h = bh & 7, l31 = lane & 31, hi = lane >> 5, q0 = qblk * 32, t = q0 + l31;
    const size_t rowb = (size_t)b * SEQ;
    bf16x8 qf[4];
    { const bf16_t* Qp = P1 + (rowb + q0 + l31) * L1P + h * 64 + 8 * hi;
#pragma unroll
      for (int kk = 0; kk < 4; ++kk) qf[kk] = *(const bf16x8*)(Qp + 16 * kk); }
    f32x16 o[2];
#pragma unroll
    for (int r = 0; r < 16; ++r) { o[0][r] = 0.f; o[1][r] = 0.f; }
    float cum = 1.f;
    const bf16_t* gK = P1 + (rowb + (lane >> 3)) * L1P + 512 + h * 64 + (lane & 7) * 8;
    const bf16_t* gV = VT + ((size_t)bh * 64 + (lane >> 2)) * SEQ + (lane & 3) * 8;
    const int lK = (lane >> 3) * 144 + (lane & 7) * 16, lV = 4608 + (lane >> 2) * 72 + (lane & 3) * 16;
    v4u rk[4], rv[4];
#pragma unroll
    for (int i = 0; i < 4; ++i) { rk[i] = *(const v4u*)(gK + (size_t)(q0 + 8 * i) * L1P); rv[i] = *(const v4u*)(gV + (size_t)(16 * i) * SEQ + q0); }
#pragma unroll 1
    for (int s0 = q0; s0 >= 0; s0 -= 32) {
#pragma unroll
        for (int i = 0; i < 4; ++i) { *(LAS v4u*)(wl + lK + i * 8 * 144) = rk[i]; *(LAS u32x2*)(wl + lV + i * 16 * 72) = (u32x2){rv[i].x, rv[i].y}; *(LAS u32x2*)(wl + lV + i * 16 * 72 + 8) = (u32x2){rv[i].z, rv[i].w}; }
        { const int sn = (s0 >= 32) ? s0 - 32 : 0;
#pragma unroll
          for (int i = 0; i < 4; ++i) { rk[i] = *(const v4u*)(gK + (size_t)(sn + 8 * i) * L1P); rv[i] = *(const v4u*)(gV + (size_t)(16 * i) * SEQ + sn); } }
        WSYNC();
        f32x16 acc;
#pragma unroll
        for (int r = 0; r < 16; ++r) acc[r] = 0.f;
#pragma unroll
        for (int kk = 0; kk < 4; ++kk) { const bf16x8 kf = *(const LAS bf16x8*)(wl + l31 * 144 + (16 * kk + 8 * hi) * 2); acc = MFMA32(kf, qf[kk], acc); }
        const bool diag = (s0 == q0);
        float bt[16], kp[16];
#pragma unroll
        for (int r = 0; r < 16; ++r) { const float ee = __builtin_amdgcn_exp2f(fminf(acc[r] * (-0.125f * 1.4426950408889634f), 100.f)); const float ri = __builtin_amdgcn_rcpf(1.f + ee);
            float b_ = ri, k_ = ee * ri;
            if (diag) { const bool valid = (s0 + crow(r, hi)) < t; b_ = valid ? b_ : 0.f; k_ = valid ? k_ : 1.f; }
            bt[r] = b_; kp[r] = k_; }
        float e[16], T[4], U[4];
#pragma unroll
        for (int q = 0; q < 4; ++q) { e[4 * q + 3] = 1.f; e[4 * q + 2] = kp[4 * q + 3]; e[4 * q + 1] = e[4 * q + 2] * kp[4 * q + 2]; e[4 * q] = e[4 * q + 1] * kp[4 * q + 1]; T[q] = e[4 * q] * kp[4 * q]; }
#pragma unroll
        for (int q = 0; q < 4; ++q) U[q] = __shfl_xor(T[q], 32);
        { const float st2 = T[3], st1 = st2 * T[2], st0 = st1 * T[1]; const float su2 = U[3], su1 = su2 * U[2], su0 = su1 * U[1];
          const float x0 = hi ? 1.f : U[0], x1 = hi ? 1.f : U[1], x2 = hi ? 1.f : U[2], x3 = hi ? 1.f : U[3];
          const float off[4] = {cum * (st0 * su0 * x0), cum * (st1 * su1 * x1), cum * (st2 * su2 * x2), cum * x3};
#pragma unroll
          for (int r = 0; r < 16; ++r) acc[r] = bt[r] * (off[r >> 2] * e[r]);
          cum *= (st0 * T[0]) * (su0 * U[0]); }
        bf16x8 pf[2];
#pragma unroll
        for (int ks = 0; ks < 2; ++ks) pf[ks] = pack8(acc[8 * ks], acc[8 * ks + 1], acc[8 * ks + 2], acc[8 * ks + 3], acc[8 * ks + 4], acc[8 * ks + 5], acc[8 * ks + 6], acc[8 * ks + 7]);
#pragma unroll
        for (int dt = 0; dt < 2; ++dt)
#pragma unroll
            for (int ks = 0; ks < 2; ++ks) { const LAS unsigned char* vp = wl + 4608 + (32 * dt + l31) * 72 + (16 * ks + 4 * hi) * 2;
                const u32x2 x0 = *(const LAS u32x2*)vp, x1 = *(const LAS u32x2*)(vp + 16);
                v4u a; a.x = x0.x; a.y = x0.y; a.z = x1.x; a.w = x1.y; o[dt] = MFMA32(__builtin_bit_cast(bf16x8, a), pf[ks], o[dt]); }
        WSYNC();
        if (__all(cum < 1e-35f)) break;
    }
    store_OT(o, 1.0f, (LAS bf16_t*)(wl + 9216), ymix + (rowb + q0) * DM + h * 64, lane);
}

constexpr int MLK_PITCH = 104, MLV_PITCH = 68, MLK_BYTES = 64 * MLK_PITCH * 2, MLV_BYTES = 64 * MLV_PITCH * 2, ML_STAGE = MLK_BYTES + MLV_BYTES;
__device__ __forceinline__ void mla_block(int bh, int sb, int tid, int lane, int wave, LAS unsigned char* lds, const bf16_t* __restrict__ QM, const bf16_t* __restrict__ KVM, const bf16_t* __restrict__ KPE,
                                          const bf16_t* __restrict__ VT, bf16_t* __restrict__ ymix) {
    const int b = bh >> 3, h = bh & 7, l31 = lane & 31, hi = lane >> 5, q0 = 256 * sb + 32 * wave, t = q0 + l31;
    const size_t rowb = (size_t)b * SEQ;
    const int nsteps = 4 * sb + 4;
    bf16x8 qf[6];
    { const bf16_t* Qp = QM + (rowb + q0 + l31) * 768 + h * 96 + 8 * hi;
#pragma unroll
      for (int kk = 0; kk < 6; ++kk) qf[kk] = *(const bf16x8*)(Qp + 16 * kk); }
    const float sc2 = 0.10206207261596577f * 1.4426950408889634f;
    f32x16 o[2];
#pragma unroll
    for (int r = 0; r < 16; ++r) { o[0][r] = 0.f; o[1][r] = 0.f; }
    float mrun = -1e30f, lsum = 0.f;
    const bf16_t* gKn = KVM + (rowb + (tid >> 3)) * 1024 + h * 128 + (tid & 7) * 8;
    const bf16_t* gKr = KPE + (rowb + ((tid & 255) >> 2)) * 32 + (tid & 3) * 8;
    const bf16_t* gVt = VT + ((size_t)bh * 64 + (tid >> 3)) * SEQ + (tid & 7) * 8;
    const int lKn = (tid >> 3) * (MLK_PITCH * 2) + (tid & 7) * 16, lKr = ((tid & 255) >> 2) * (MLK_PITCH * 2) + 128 + (tid & 3) * 16, lVt = MLK_BYTES + (tid >> 3) * (MLV_PITCH * 2) + (tid & 7) * 16;
    v4u rk, rr, rv;
    rk = *(const v4u*)gKn; rr = *(const v4u*)gKr; rv = *(const v4u*)gVt;
    *(LAS v4u*)(lds + lKn) = rk; if (tid < 256) *(LAS v4u*)(lds + lKr) = rr; *(LAS u32x2*)(lds + lVt) = (u32x2){rv.x, rv.y}; *(LAS u32x2*)(lds + lVt + 8) = (u32x2){rv.z, rv.w};
    __syncthreads();
#pragma unroll 1
    for (int step = 0; step < nsteps; ++step) {
        const int nx = (step + 1 < nsteps) ? step + 1 : step;
        rk = *(const v4u*)(gKn + (size_t)nx * 64 * 1024); rr = *(const v4u*)(gKr + (size_t)nx * 64 * 32); rv = *(const v4u*)(gVt + nx * 64);
        const LAS unsigned char* Kb = lds + (step & 1) * ML_STAGE;
        const LAS unsigned char* Vb = Kb + MLK_BYTES;
        if (64 * step <= q0) {
            f32x16 acc[2];
#pragma unroll
            for (int sub = 0; sub < 2; ++sub) {
#pragma unroll
                for (int r = 0; r < 16; ++r) acc[sub][r] = 0.f;
#pragma unroll
                for (int kk = 0; kk < 6; ++kk) { const bf16x8 kf = *(const LAS bf16x8*)(Kb + (32 * sub + l31) * (MLK_PITCH * 2) + (16 * kk + 8 * hi) * 2); acc[sub] = MFMA32(kf, qf[kk], acc[sub]); }
            }
            float tmax = -1e30f;
#pragma unroll
            for (int sub = 0; sub < 2; ++sub) { const int s0 = 64 * step + 32 * sub;
                if (s0 + 31 > q0) {
#pragma unroll
                    for (int r = 0; r < 16; ++r) if ((s0 + crow(r, hi)) > t) acc[sub][r] = -1e30f; }
#pragma unroll
                for (int r = 0; r < 16; ++r) tmax = fmaxf(tmax, acc[sub][r]); }
            tmax = fmaxf(tmax, __shfl_xor(tmax, 32)) * sc2;
            if (__any(tmax - mrun > 6.f)) {
                const float mn = fmaxf(mrun, tmax), alpha = __builtin_amdgcn_exp2f(mrun - mn); mrun = mn; lsum *= alpha;
#pragma unroll
                for (int r = 0; r < 16; ++r) { o[0][r] *= alpha; o[1][r] *= alpha; }
            }
            float ps = 0.f;
#pragma unroll
            for (int sub = 0; sub < 2; ++sub)
#pragma unroll
                for (int r = 0; r < 16; ++r) { acc[sub][r] = __builtin_amdgcn_exp2f(acc[sub][r] * sc2 - mrun); ps += acc[sub][r]; }
            lsum += ps;
#pragma unroll
            for (int sub = 0; sub < 2; ++sub) {
                bf16x8 pf[2];
#pragma unroll
                for (int ks = 0; ks < 2; ++ks) pf[ks] = pack8(acc[sub][8 * ks], acc[sub][8 * ks + 1], acc[sub][8 * ks + 2], acc[sub][8 * ks + 3], acc[sub][8 * ks + 4], acc[sub][8 * ks + 5], acc[sub][8 * ks + 6], acc[sub][8 * ks + 7]);
#pragma unroll
                for (int dt = 0; dt < 2; ++dt)
#pragma unroll
                    for (int ks = 0; ks < 2; ++ks) { const LAS unsigned char* vp = Vb + (32 * dt + l31) * (MLV_PITCH * 2) + (32 * sub + 16 * ks + 4 * hi) * 2;
                        const u32x2 x0 = *(const LAS u32x2*)vp, x1 = *(const LAS u32x2*)(vp + 16);
                        v4u a; a.x = x0.x; a.y = x0.y; a.z = x1.x; a.w = x1.y; o[dt] = MFMA32(__builtin_bit_cast(bf16x8, a), pf[ks], o[dt]); }
            }
        }
        LAS unsigned char* nb = lds + ((step + 1) & 1) * ML_STAGE;
        *(LAS v4u*)(nb + lKn) = rk; if (tid < 256) *(LAS v4u*)(nb + lKr) = rr; *(LAS u32x2*)(nb + lVt) = (u32x2){rv.x, rv.y}; *(LAS u32x2*)(nb + lVt + 8) = (u32x2){rv.z, rv.w};
        __syncthreads();
    }
    lsum += __shfl_xor(lsum, 32);
    store_OT(o, 1.0f / lsum, (LAS bf16_t*)(lds + 2 * ML_STAGE) + wave * (32 * STG_PITCH), ymix + (rowb + q0) * DM + 512 + h * 64, lane);
    __syncthreads();
}


constexpr int SBK_PITCH = 72, SBK_BYTES = 64 * SBK_PITCH * 2, SB_STAGE = SBK_BYTES + MLV_BYTES;
__device__ __forceinline__ void sb_block(int bh, int sb, int tid, int lane, int wave, LAS unsigned char* lds, const bf16_t* __restrict__ P1, const bf16_t* __restrict__ VT, bf16_t* __restrict__ ymix) {
    const int b = bh >> 3, h = bh & 7, l31 = lane & 31, hi = lane >> 5, q0 = 256 * sb + 32 * wave, t = q0 + l31;
    const size_t rowb = (size_t)b * SEQ;
    bf16x8 qf[4];
    { const bf16_t* Qp = P1 + (rowb + q0 + l31) * L1P + h * 64 + 8 * hi;
#pragma unroll
      for (int kk = 0; kk < 4; ++kk) qf[kk] = *(const bf16x8*)(Qp + 16 * kk); }
    f32x16 o[2];
#pragma unroll
    for (int r = 0; r < 16; ++r) { o[0][r] = 0.f; o[1][r] = 0.f; }
    float cum = 1.f; bool done = false;
    volatile LAS unsigned* flags = (volatile LAS unsigned*)(lds + 2 * SB_STAGE);
    const bf16_t* gK = P1 + (rowb + (tid >> 3)) * L1P + 512 + h * 64 + (tid & 7) * 8;
    const bf16_t* gVt = VT + ((size_t)bh * 64 + (tid >> 3)) * SEQ + (tid & 7) * 8;
    const int lK = (tid >> 3) * (SBK_PITCH * 2) + (tid & 7) * 16, lVt = SBK_BYTES + (tid >> 3) * (MLV_PITCH * 2) + (tid & 7) * 16;
    const int top = 4 * sb + 3;
    v4u rk, rv;
    rk = *(const v4u*)(gK + (size_t)top * 64 * L1P); rv = *(const v4u*)(gVt + top * 64);
    *(LAS v4u*)(lds + lK) = rk; *(LAS u32x2*)(lds + lVt) = (u32x2){rv.x, rv.y}; *(LAS u32x2*)(lds + lVt + 8) = (u32x2){rv.z, rv.w};
    __syncthreads();
#pragma unroll 1
    for (int i = 0; i <= top; ++i) {
        const int step = top - i, nx = (step > 0) ? step - 1 : 0;
        rk = *(const v4u*)(gK + (size_t)nx * 64 * L1P); rv = *(const v4u*)(gVt + nx * 64);
        const LAS unsigned char* Kb = lds + (i & 1) * SB_STAGE;
        const LAS unsigned char* Vb = Kb + SBK_BYTES;
#pragma unroll
        for (int sub = 1; sub >= 0; --sub) {
            const int s0 = 64 * step + 32 * sub;
            if (s0 <= q0 && !done) {
                f32x16 acc;
#pragma unroll
                for (int r = 0; r < 16; ++r) acc[r] = 0.f;
#pragma unroll
                for (int kk = 0; kk < 4; ++kk) { const bf16x8 kf = *(const LAS bf16x8*)(Kb + (32 * sub + l31) * (SBK_PITCH * 2) + (16 * kk + 8 * hi) * 2); acc = MFMA32(kf, qf[kk], acc); }
                const bool diag = (s0 == q0);
                float bt[16], kp[16];
#pragma unroll
                for (int r = 0; r < 16; ++r) { const float ee = __builtin_amdgcn_exp2f(fminf(acc[r] * (-0.125f * 1.4426950408889634f), 100.f)); const float ri = __builtin_amdgcn_rcpf(1.f + ee);
                    float b_ = ri, k_ = ee * ri;
                    if (diag) { const bool valid = (s0 + crow(r, hi)) < t; b_ = valid ? b_ : 0.f; k_ = valid ? k_ : 1.f; }
                    bt[r] = b_; kp[r] = k_; }
                float e[16], T[4], U[4];
#pragma unroll
                for (int q = 0; q < 4; ++q) { e[4 * q + 3] = 1.f; e[4 * q + 2] = kp[4 * q + 3]; e[4 * q + 1] = e[4 * q + 2] * kp[4 * q + 2]; e[4 * q] = e[4 * q + 1] * kp[4 * q + 1]; T[q] = e[4 * q] * kp[4 * q]; }
#pragma unroll
                for (int q = 0; q < 4; ++q) U[q] = __shfl_xor(T[q], 32);
                { const float st2 = T[3], st1 = st2 * T[2], st0 = st1 * T[1]; const float su2 = U[3], su1 = su2 * U[2], su0 = su1 * U[1];
                  const float x0 = hi ? 1.f : U[0], x1 = hi ? 1.f : U[1], x2 = hi ? 1.f : U[2], x3 = hi ? 1.f : U[3];
                  const float off[4] = {cum * (st0 * su0 * x0), cum * (st1 * su1 * x1), cum * (st2 * su2 * x2), cum * x3};
#pragma unroll
                  for (int r = 0; r < 16; ++r) acc[r] = bt[r] * (off[r >> 2] * e[r]);
                  cum *= (st0 * T[0]) * (su0 * U[0]); }
                bf16x8 pf[2];
#pragma unroll
                for (int ks = 0; ks < 2; ++ks) { v4u w; w.x = cvtpk(acc[8 * ks], acc[8 * ks + 1]); w.y = cvtpk(acc[8 * ks + 2], acc[8 * ks + 3]); w.z = cvtpk(acc[8 * ks + 4], acc[8 * ks + 5]); w.w = cvtpk(acc[8 * ks + 6], acc[8 * ks + 7]); pf[ks] = __builtin_bit_cast(bf16x8, w); }
#pragma unroll
                for (int dt = 0; dt < 2; ++dt)
#pragma unroll
                    for (int ks = 0; ks < 2; ++ks) { const LAS unsigned char* vp = Vb + (32 * dt + l31) * (MLV_PITCH * 2) + (32 * sub + 16 * ks + 4 * hi) * 2;
                        const u32x2 x0 = *(const LAS u32x2*)vp, x1 = *(const LAS u32x2*)(vp + 16);
                        v4u a; a.x = x0.x; a.y = x0.y; a.z = x1.x; a.w = x1.y; o[dt] = MFMA32(__builtin_bit_cast(bf16x8, a), pf[ks], o[dt]); }
                done = __all(cum < 1e-35f);
            }
        }
        if (lane == 0) flags[(i & 1) * 8 + wave] = done ? 1u : 0u;
        LAS unsigned char* nb = lds + ((i + 1) & 1) * SB_STAGE;
        *(LAS v4u*)(nb + lK) = rk; *(LAS u32x2*)(nb + lVt) = (u32x2){rv.x, rv.y}; *(LAS u32x2*)(nb + lVt + 8) = (u32x2){rv.z, rv.w};
        __syncthreads();
        unsigned nd = 0;
#pragma unroll
        for (int w8 = 0; w8 < 8; ++w8) nd += flags[(i & 1) * 8 + w8];
        if (nd == 8u) break;
    }
    store_OT(o, 1.0f, (LAS bf16_t*)(lds + 2 * SB_STAGE + 256) + wave * (32 * STG_PITCH), ymix + (rowb + q0) * DM + h * 64, lane);
    __syncthreads();
}

constexpr int RW_RAWW = 0, RW_RAWA = 2048, RW_RS = 4096, RW_KS = 6144, RW_VS = 8192;
constexpr int RW_CH0 = 10240, RW_CHSZ = 11328;
constexpr int RW_YB = RW_CH0 + 2 * RW_CHSZ;
constexpr int RW_MIX = RW_YB + 1024;
static_assert((RW_MIX + 256) * 4 <= 146432, "rwkv LDS map");
__device__ __forceinline__ float tanh_fast(float x) { return 1.f - 2.f * __builtin_amdgcn_rcpf(1.f + __expf(2.f * x)); }
__device__ __forceinline__ float sigmoid_fast(float x) { return __builtin_amdgcn_rcpf(1.f + __expf(-x)); }

#define MFMA16(a, b, c) __builtin_amdgcn_mfma_f32_16x16x32_bf16((a), (b), (c), 0, 0, 0)
constexpr int RW2_CH0 = 0, RW2_YB = 2 * RW_CHSZ, RW2_MIX = RW2_YB + 1024, RW2_STG = RW2_MIX + 448;
static_assert((RW2_STG + 2 * 3072) * 4 <= 146432, "rwkv LDS map");
__device__ __forceinline__ void rwkv_phase_scan(LAS float* sm, int tid, int lane, int wave, int blk, const bf16_t* __restrict__ proj, const float* __restrict__ mix, const float* __restrict__ w0, const float* __restrict__ a0,
                                           const float* __restrict__ k_k, const float* __restrict__ k_a, const float* __restrict__ r_k, const bf16_t* __restrict__ W2T, const bf16_t* __restrict__ A2T, const bf16_t* __restrict__ G2T,
                                           float* __restrict__ yraw, bf16_t* __restrict__ gout, float* __restrict__ bonus_out) {
    const int chain = blk >> 1, half = blk & 1, b = chain >> 3, h = chain & 7, l15 = lane & 15, kg = lane >> 4;
    const size_t rowb = (size_t)b * SEQ;
    constexpr int NCHUNK = SEQ / 32;
    if (tid < 256) sm[RW2_MIX + tid] = mix[1536 + tid];
    else if (tid < 448) { const int q = tid - 256; sm[RW2_MIX + tid] = mix[512 * (q >> 6) + h * 64 + (q & 63)]; }
    __syncthreads();
#define RW_SH8(CUR, PRV, M0, M1, OUT, PZ) do { const unsigned cu_[4] = {(CUR).x, (CUR).y, (CUR).z, (CUR).w}, pu_[4] = {(PRV).x, (PRV).y, (PRV).z, (PRV).w}; \
        const float mm_[8] = {(M0)[0], (M0)[1], (M0)[2], (M0)[3], (M1)[0], (M1)[1], (M1)[2], (M1)[3]}; \
        _Pragma("unroll") for (int q = 0; q < 4; ++q) { const float c0 = bflo(cu_[q]), c1 = bfhi(cu_[q]), p0 = bflo(pu_[q]) * (PZ), p1 = bfhi(pu_[q]) * (PZ); \
            OUT[2 * q] = c0 + (p0 - c0) * mm_[2 * q]; OUT[2 * q + 1] = c1 + (p1 - c1) * mm_[2 * q + 1]; } } while (0)
    if (wave < 4) {
        const int iA = 8 * wave + kg, iB = iA + 4, jseg = l15;
        float A0 = 0.f, A1 = 0.f, A2 = 0.f, A3 = 0.f, B0 = 0.f, B1 = 0.f, B2 = 0.f, B3 = 0.f;
        __syncthreads();
#pragma unroll 1
        for (int ch = 0; ch < NCHUNK; ++ch) {
            const int t0 = ch * 32;
            const LAS float* CHb = sm + RW2_CH0 + (ch & 1) * RW_CHSZ + 4 * jseg;
            const LAS float* CHv = sm + RW2_CH0 + (ch & 1) * RW_CHSZ + 10240 + iA;
            const LAS float* CHs = sm + RW2_CH0 + (ch & 1) * RW_CHSZ + 11264;
            f32x4 a4 = *(const LAS f32x4*)(CHb + 4096), wr4 = *(const LAS f32x4*)(CHb + 8192), w4 = *(const LAS f32x4*)(CHb), b4 = *(const LAS f32x4*)(CHb + 6144), k4 = *(const LAS f32x4*)(CHb + 2048);
            float vA = CHv[0], vB = CHv[4]; f32x2_t sc = *(const LAS f32x2_t*)(CHs);
#pragma unroll 2
            for (int t = 0; t < 32; ++t) {
                const int tq = (t + 1) & 31;
                const f32x4 a4n = *(const LAS f32x4*)(CHb + 4096 + tq * 64), wr4n = *(const LAS f32x4*)(CHb + 8192 + tq * 64), w4n = *(const LAS f32x4*)(CHb + tq * 64),
                            b4n = *(const LAS f32x4*)(CHb + 6144 + tq * 64), k4n = *(const LAS f32x4*)(CHb + 2048 + tq * 64);
                const float vAn = CHv[tq * 32], vBn = CHv[tq * 32 + 4]; const f32x2_t scn = *(const LAS f32x2_t*)(CHs + 2 * tq);
                float d1A = (A0 * a4[0] + A1 * a4[1]) + (A2 * a4[2] + A3 * a4[3]), d1B = (B0 * a4[0] + B1 * a4[1]) + (B2 * a4[2] + B3 * a4[3]);
                float d2A = (A0 * wr4[0] + A1 * wr4[1]) + (A2 * wr4[2] + A3 * wr4[3]), d2B = (B0 * wr4[0] + B1 * wr4[1]) + (B2 * wr4[2] + B3 * wr4[3]);
                d1A = rowsum16(d1A); d1B = rowsum16(d1B); d2A = rowsum16(d2A); d2B = rowsum16(d2B);
                const float yA = d2A + d1A * sc[0] + vA * sc[1], yB = d2B + d1B * sc[0] + vB * sc[1];
                A0 = A0 * w4[0] + (d1A * b4[0] + vA * k4[0]); A1 = A1 * w4[1] + (d1A * b4[1] + vA * k4[1]); A2 = A2 * w4[2] + (d1A * b4[2] + vA * k4[2]); A3 = A3 * w4[3] + (d1A * b4[3] + vA * k4[3]);
                B0 = B0 * w4[0] + (d1B * b4[0] + vB * k4[0]); B1 = B1 * w4[1] + (d1B * b4[1] + vB * k4[1]); B2 = B2 * w4[2] + (d1B * b4[2] + vB * k4[2]); B3 = B3 * w4[3] + (d1B * b4[3] + vB * k4[3]);
                if (jseg == 0) { sm[RW2_YB + t * 32 + iA] = yA; sm[RW2_YB + t * 32 + iB] = yB; }
                a4 = a4n; wr4 = wr4n; w4 = w4n; b4 = b4n; k4 = k4n; vA = vAn; vB = vBn; sc = scn;
            }
            WSYNC();
            { const int tt = lane >> 1, hh = lane & 1; const f32x4 yv = *(const LAS f32x4*)(sm + RW2_YB + tt * 32 + 8 * wave + 4 * hh);
              *(f32x4*)(yraw + (rowb + t0 + tt) * 512 + h * 64 + half * 32 + 8 * wave + 4 * hh) = yv; }
            __syncthreads();
        }
    } else if (wave < 6) {
        const int tp = wave - 4, tb = 16 * tp;
        LAS float* stg = sm + RW2_STG + tp * 3072;
        float w0c[4], a0c[4], kkc[4], kac[4], rkc[4];
#pragma unroll
        for (int nt = 0; nt < 4; ++nt) { const int c = h * 64 + 16 * nt + l15; w0c[nt] = w0[c]; a0c[nt] = a0[c]; kkc[nt] = k_k[c]; kac[nt] = k_a[c]; rkc[nt] = r_k[c]; }
        v4u ld[20];
#define PREP_ISSUE(T0) do { const int t0_ = (T0); { const size_t r_ = rowb + t0_ + tb + l15; const size_t rp_ = (t0_ + tb + l15 == 0) ? r_ : r_ - 1; \
            _Pragma("unroll") for (int lo = 0; lo < 2; ++lo) _Pragma("unroll") for (int ks = 0; ks < 2; ++ks) { const int col = 1536 + 64 * lo + 32 * ks + 8 * kg; \
                ld[(lo * 2 + ks) * 2] = *(const v4u*)(proj + r_ * L0P + col); ld[(lo * 2 + ks) * 2 + 1] = *(const v4u*)(proj + rp_ * L0P + col); } } \
            _Pragma("unroll") for (int ar = 0; ar < 3; ++ar) _Pragma("unroll") for (int i = 0; i < 2; ++i) { const int p_ = lane + 64 * i, row_ = p_ >> 3, c8_ = p_ & 7; \
                const size_t r_ = rowb + t0_ + tb + row_; const size_t rp_ = (t0_ + tb + row_ == 0) ? r_ : r_ - 1; const int col = 512 * ar + h * 64 + 8 * c8_; \
                ld[8 + (ar * 2 + i) * 2] = *(const v4u*)(proj + r_ * L0P + col); ld[8 + (ar * 2 + i) * 2 + 1] = *(const v4u*)(proj + rp_ * L0P + col); } } while (0)
#define PREP_BUILD(T0, NB) do { const int t0_ = (T0); LAS float* CHn = sm + RW2_CH0 + (NB) * RW_CHSZ; \
            f32x4 accw[4], acca[4]; \
            _Pragma("unroll") for (int nt = 0; nt < 4; ++nt) { accw[nt] = (f32x4){0.f, 0.f, 0.f, 0.f}; acca[nt] = (f32x4){0.f, 0.f, 0.f, 0.f}; } \
            { const float pz_ = (t0_ + tb + l15 == 0) ? 0.f : 1.f; \
              _Pragma("unroll") for (int lo = 0; lo < 2; ++lo) _Pragma("unroll") for (int ks = 0; ks < 2; ++ks) { float s_[8]; \
                const f32x4 m0 = *(const LAS f32x4*)(sm + RW2_MIX + 64 * lo + 32 * ks + 8 * kg), m1 = *(const LAS f32x4*)(sm + RW2_MIX + 64 * lo + 32 * ks + 8 * kg + 4); \
                RW_SH8(ld[(lo * 2 + ks) * 2], ld[(lo * 2 + ks) * 2 + 1], m0, m1, s_, pz_); \
                if (lo == 0) { _Pragma("unroll") for (int j = 0; j < 8; ++j) s_[j] = tanh_fast(s_[j]); } \
                v4u aw; aw.x = cvtpk(s_[0], s_[1]); aw.y = cvtpk(s_[2], s_[3]); aw.z = cvtpk(s_[4], s_[5]); aw.w = cvtpk(s_[6], s_[7]); const bf16x8 af = __builtin_bit_cast(bf16x8, aw); \
                const bf16_t* WT = lo ? A2T : W2T; \
                _Pragma("unroll") for (int nt = 0; nt < 4; ++nt) { const bf16x8 bfr = *(const bf16x8*)(WT + (size_t)(h * 64 + 16 * nt + l15) * 64 + 32 * ks + 8 * kg); \
                    if (lo == 0) accw[nt] = MFMA16(af, bfr, accw[nt]); else acca[nt] = MFMA16(af, bfr, acca[nt]); } } } \
            _Pragma("unroll") for (int ar = 0; ar < 3; ++ar) _Pragma("unroll") for (int i = 0; i < 2; ++i) { const int p_ = lane + 64 * i, row_ = p_ >> 3, c8_ = p_ & 7; float s_[8]; \
                const float pz_ = (t0_ + tb + row_ == 0) ? 0.f : 1.f; const f32x4 m0 = *(const LAS f32x4*)(sm + RW2_MIX + 256 + ar * 64 + c8_ * 8), m1 = *(const LAS f32x4*)(sm + RW2_MIX + 256 + ar * 64 + c8_ * 8 + 4); \
                RW_SH8(ld[8 + (ar * 2 + i) * 2], ld[8 + (ar * 2 + i) * 2 + 1], m0, m1, s_, pz_); \
                *(LAS f32x4*)(stg + ar * 1024 + row_ * 64 + c8_ * 8) = (f32x4){s_[0], s_[1], s_[2], s_[3]}; *(LAS f32x4*)(stg + ar * 1024 + row_ * 64 + c8_ * 8 + 4) = (f32x4){s_[4], s_[5], s_[6], s_[7]}; } \
            WSYNC(); \
            PREP_ISSUE(((T0) + 32 < SEQ) ? (T0) + 32 : (T0)); \
            _Pragma("unroll") for (int rg = 0; rg < 4; ++rg) { const int tl = 4 * kg + rg, t = tb + tl; \
                float r_[4], k_[4], v_[4], kkv[4], nrm2 = 0.f; \
                _Pragma("unroll") for (int nt = 0; nt < 4; ++nt) { r_[nt] = stg[tl * 64 + 16 * nt + l15]; k_[nt] = stg[1024 + tl * 64 + 16 * nt + l15]; v_[nt] = stg[2048 + tl * 64 + 16 * nt + l15]; \
                    kkv[nt] = k_[nt] * kkc[nt]; nrm2 += kkv[nt] * kkv[nt]; } \
                nrm2 = rowsum16(nrm2); const float rn = __builtin_amdgcn_rsqf(fmaxf(nrm2, 1e-24f)); \
                float br = 0.f, kr = 0.f, bon = 0.f; \
                _Pragma("unroll") for (int nt = 0; nt < 4; ++nt) { const int j = 16 * nt + l15; \
                    const float wsum = w0c[nt] + accw[nt][rg]; const float logw = -softplus_fast(-wsum) - 0.5f; const float dec = __expf(-__expf(logw)); \
                    const float a_ = sigmoid_fast(a0c[nt] + acca[nt][rg]); const float kn = kkv[nt] * rn; \
                    const float k2 = k_[nt] * (1.f + (a_ - 1.f) * kac[nt]); const float bv = kn * a_; \
                    br += bv * r_[nt]; kr += k2 * r_[nt]; bon += r_[nt] * k2 * rkc[nt]; \
                    CHn[t * 64 + j] = dec; CHn[2048 + t * 64 + j] = k2; CHn[4096 + t * 64 + j] = -kn; CHn[6144 + t * 64 + j] = bv; CHn[8192 + t * 64 + j] = dec * r_[nt]; \
                    if ((nt >> 1) == half) CHn[10240 + t * 32 + (j & 31)] = v_[nt]; } \
                br = rowsum16(br); kr = rowsum16(kr); bon = rowsum16(bon); \
                if (l15 == 0) { CHn[11264 + 2 * t] = br; CHn[11264 + 2 * t + 1] = kr; if (half == 0) bonus_out[(rowb + t0_ + t) * 8 + h] = bon; } } \
            WSYNC(); } while (0)
        PREP_ISSUE(0);
        PREP_BUILD(0, 0);
        __syncthreads();
#pragma unroll 1
        for (int ch = 0; ch < NCHUNK; ++ch) {
            if (ch + 1 < NCHUNK) PREP_BUILD(ch * 32 + 32, (ch + 1) & 1);
            __syncthreads();
        }
#undef PREP_ISSUE
#undef PREP_BUILD
    } else {
        const int tp = wave - 6, tb = 16 * tp;
        v4u ld[8];
#define G_ISSUE(T0) do { const int t0_ = (T0); const size_t r_ = rowb + t0_ + tb + l15; const size_t rp_ = (t0_ + tb + l15 == 0) ? r_ : r_ - 1; \
            _Pragma("unroll") for (int ks = 0; ks < 4; ++ks) { const int col = 1664 + 32 * ks + 8 * kg; ld[2 * ks] = *(const v4u*)(proj + r_ * L0P + col); ld[2 * ks + 1] = *(const v4u*)(proj + rp_ * L0P + col); } } while (0)
#define G_BUILD(T0) do { const int t0_ = (T0); f32x4 accg[2] = {(f32x4){0.f, 0.f, 0.f, 0.f}, (f32x4){0.f, 0.f, 0.f, 0.f}}; const float pz_ = (t0_ + tb + l15 == 0) ? 0.f : 1.f; \
            _Pragma("unroll") for (int ks = 0; ks < 4; ++ks) { float s_[8]; \
                const f32x4 m0 = *(const LAS f32x4*)(sm + RW2_MIX + 128 + 32 * ks + 8 * kg), m1 = *(const LAS f32x4*)(sm + RW2_MIX + 128 + 32 * ks + 8 * kg + 4); \
                RW_SH8(ld[2 * ks], ld[2 * ks + 1], m0, m1, s_, pz_); \
                _Pragma("unroll") for (int j = 0; j < 8; ++j) s_[j] = sigmoid_fast(s_[j]); \
                v4u aw; aw.x = cvtpk(s_[0], s_[1]); aw.y = cvtpk(s_[2], s_[3]); aw.z = cvtpk(s_[4], s_[5]); aw.w = cvtpk(s_[6], s_[7]); const bf16x8 af = __builtin_bit_cast(bf16x8, aw); \
                _Pragma("unroll") for (int nt = 0; nt < 2; ++nt) { const bf16x8 bfr = *(const bf16x8*)(G2T + (size_t)(h * 64 + half * 32 + 16 * nt + l15) * 128 + 32 * ks + 8 * kg); accg[nt] = MFMA16(af, bfr, accg[nt]); } } \
            G_ISSUE(((T0) + 32 < SEQ) ? (T0) + 32 : (T0)); \
            _Pragma("unroll") for (int nt = 0; nt < 2; ++nt) _Pragma("unroll") for (int rg = 0; rg < 4; ++rg) \
                gout[(rowb + t0_ + tb + 4 * kg + rg) * 512 + h * 64 + half * 32 + 16 * nt + l15] = (bf16_t)f2bf(accg[nt][rg]); } while (0)
        G_ISSUE(0);
        G_BUILD(0);
        __syncthreads();
#pragma unroll 1
        for (int ch = 0; ch < NCHUNK; ++ch) {
            if (ch + 1 < NCHUNK) G_BUILD(ch * 32 + 32);
            __syncthreads();
        }
#undef G_ISSUE
#undef G_BUILD
    }
#undef RW_SH8
    __syncthreads();
}

constexpr int CK_BK = 0, CK_AR = 4608, CK_BBT = 9216, CK_KBT = 12288, CK_VT = 15360, CK_GC = 16896, CK_TT = 17152, CK_SLOT = 18688, CK_NSLOT = 6, CK_NBUILD = 5;
constexpr int CK_STG = CK_SLOT * CK_NSLOT;
constexpr int CK_MIX = CK_STG + CK_NBUILD * 6144;
constexpr int CK_FLAGS = CK_MIX + 448 * 4;
static_assert(CK_FLAGS + 64 <= 146432, "rwkv chunked LDS map");
__device__ __forceinline__ void rwkv_phase(LAS float* smf, int tid, int lane, int wave, int blk, const bf16_t* __restrict__ proj, const float* __restrict__ mix, const float* __restrict__ w0, const float* __restrict__ a0,
                                           const float* __restrict__ k_k, const float* __restrict__ k_a, const float* __restrict__ r_k, const bf16_t* __restrict__ W2T, const bf16_t* __restrict__ A2T, const bf16_t* __restrict__ G2T,
                                           float* __restrict__ yraw, bf16_t* __restrict__ gout, float* __restrict__ bonus_out) {
    LAS unsigned char* lds = (LAS unsigned char*)smf;
    LAS float* mixs = (LAS float*)(lds + CK_MIX);
    volatile LAS unsigned* flags = (volatile LAS unsigned*)(lds + CK_FLAGS);
    const int chain = blk >> 1, ihalf = blk & 1, b = chain >> 3, h = chain & 7, l15 = lane & 15, kg = lane >> 4, l31 = lane & 31, hi = lane >> 5;
    const size_t rowb = (size_t)b * SEQ;
    constexpr int NCH = SEQ / 16;
    if (tid < 256) mixs[tid] = mix[1536 + tid];
    else if (tid < 448) { const int q = tid - 256; mixs[tid] = mix[512 * (q >> 6) + h * 64 + (q & 63)]; }
    if (tid < 16) flags[tid] = (tid == 9) ? (unsigned)CK_NBUILD : 0u;
    for (int q = tid; q < CK_NSLOT * 384; q += NWAVES * 64) *(LAS unsigned*)(lds + (q / 384) * CK_SLOT + CK_TT + (q % 384) * 4) = 0u;
    __syncthreads();
#define RW_SH8(CUR, PRV, M0, M1, OUT, PZ) do { const unsigned cu_[4] = {(CUR).x, (CUR).y, (CUR).z, (CUR).w}, pu_[4] = {(PRV).x, (PRV).y, (PRV).z, (PRV).w}; \
        const float mm_[8] = {(M0)[0], (M0)[1], (M0)[2], (M0)[3], (M1)[0], (M1)[1], (M1)[2], (M1)[3]}; \
        _Pragma("unroll") for (int q = 0; q < 4; ++q) { const float c0 = bflo(cu_[q]), c1 = bfhi(cu_[q]), p0 = bflo(pu_[q]) * (PZ), p1 = bfhi(pu_[q]) * (PZ); \
            OUT[2 * q] = c0 + (p0 - c0) * mm_[2 * q]; OUT[2 * q + 1] = c1 + (p1 - c1) * mm_[2 * q + 1]; } } while (0)
    if (wave == 0) {
        f32x16 ST[2];
#pragma unroll
        for (int r = 0; r < 16; ++r) { ST[0][r] = 0.f; ST[1][r] = 0.f; }
#pragma unroll 1
        for (int k = 0; k < NCH; ++k) {
#if defined(PROBE_STAMPS)
            const unsigned tw0_ = (unsigned)__builtin_amdgcn_s_memrealtime();
#endif
            { const unsigned want = (unsigned)(k + 1); const int sl = k % CK_NSLOT; while (flags[sl] != want) __builtin_amdgcn_s_sleep(1); }
#if defined(PROBE_STAMPS)
            if (blk == 0 && lane == 0) ((volatile LAS unsigned*)(lds + 146432 + 320))[16 + 24] += (unsigned)__builtin_amdgcn_s_memrealtime() - tw0_;
#endif
            asm volatile("" ::: "memory");
            const LAS unsigned char* im = lds + (k % CK_NSLOT) * CK_SLOT;
            f32x16 G;
#pragma unroll
            for (int r = 0; r < 16; ++r) G[r] = 0.f;
#pragma unroll
            for (int kk = 0; kk < 4; ++kk) { const bf16x8 fa = *(const LAS bf16x8*)(im + CK_BK + l31 * 144 + (16 * kk + 8 * hi) * 2), fb = *(const LAS bf16x8*)(im + CK_AR + l31 * 144 + (16 * kk + 8 * hi) * 2); G = MFMA32(fa, fb, G); }
            { const int tcol = l31 & 15; const bool strict = l31 < 16;
#pragma unroll
              for (int r = 0; r < 16; ++r) { const int srow = crow(r & 7, hi); const bool keep = strict ? (srow < tcol) : (srow <= tcol); G[r] = keep ? G[r] : 0.f; } }
            const bf16x8 gB = pack8(G[0], G[1], G[2], G[3], G[4], G[5], G[6], G[7]), gK = pack8(G[8], G[9], G[10], G[11], G[12], G[13], G[14], G[15]);
            f32x16 XT;
#pragma unroll
            for (int r = 0; r < 16; ++r) XT[r] = 0.f;
#pragma unroll
            for (int jt = 0; jt < 2; ++jt)
#pragma unroll
                for (int sp = 0; sp < 2; ++sp) { const LAS unsigned char* ap = im + CK_AR + l31 * 144 + (32 * jt + 16 * sp + 4 * hi) * 2;
                    const u32x2 x0 = *(const LAS u32x2*)ap, x1 = *(const LAS u32x2*)(ap + 16); v4u aw; aw.x = x0.x; aw.y = x0.y; aw.z = x1.x; aw.w = x1.y;
                    const bf16x8 sb_ = pack8(ST[jt][8 * sp], ST[jt][8 * sp + 1], ST[jt][8 * sp + 2], ST[jt][8 * sp + 3], ST[jt][8 * sp + 4], ST[jt][8 * sp + 5], ST[jt][8 * sp + 6], ST[jt][8 * sp + 7]);
                    XT = MFMA32(__builtin_bit_cast(bf16x8, aw), sb_, XT); }
            bf16x8 vP;
            { const LAS unsigned char* vp = im + CK_VT + l31 * 48 + (4 * hi) * 2; const u32x2 x0 = *(const LAS u32x2*)vp, x1 = *(const LAS u32x2*)(vp + 16); v4u vw; vw.x = x0.x; vw.y = x0.y; vw.z = x1.x; vw.w = x1.y;
              vP = __builtin_bit_cast(bf16x8, vw); XT = MFMA32(gK, vP, XT); }
            bf16x8 uP;
            { const LAS unsigned char* tp = im + CK_TT + l31 * 48 + (4 * hi) * 2; const u32x2 x0 = *(const LAS u32x2*)tp, x1 = *(const LAS u32x2*)(tp + 16); v4u tw; tw.x = x0.x; tw.y = x0.y; tw.z = x1.x; tw.w = x1.y;
              f32x16 UT;
#pragma unroll
              for (int r = 0; r < 16; ++r) UT[r] = 0.f;
              UT = MFMA32(__builtin_bit_cast(bf16x8, tw), pack8(XT[0], XT[1], XT[2], XT[3], XT[4], XT[5], XT[6], XT[7]), UT);
              uP = pack8(UT[0], UT[1], UT[2], UT[3], UT[4], UT[5], UT[6], UT[7]); }
            XT = MFMA32(gB, uP, XT);
            { float* yp = yraw + (rowb + 16 * k) * 512 + h * 64 + 32 * ihalf + l31;
#pragma unroll
              for (int q = 0; q < 8; ++q) yp[(size_t)crow(q, hi) * 512] = XT[8 + q]; }
            { const LAS float* gc = (const LAS float*)(im + CK_GC);
#pragma unroll
              for (int jt = 0; jt < 2; ++jt)
#pragma unroll
                  for (int r = 0; r < 16; ++r) ST[jt][r] *= gc[32 * jt + crow(r, hi)]; }
#pragma unroll
            for (int jt = 0; jt < 2; ++jt) { const LAS unsigned char* bp = im + CK_BBT + (32 * jt + l31) * 48 + (4 * hi) * 2; const LAS unsigned char* kp = im + CK_KBT + (32 * jt + l31) * 48 + (4 * hi) * 2;
                const u32x2 b0 = *(const LAS u32x2*)bp, b1 = *(const LAS u32x2*)(bp + 16), k0 = *(const LAS u32x2*)kp, k1 = *(const LAS u32x2*)(kp + 16);
                v4u a1; a1.x = b0.x; a1.y = b0.y; a1.z = b1.x; a1.w = b1.y; v4u a2; a2.x = k0.x; a2.y = k0.y; a2.z = k1.x; a2.w = k1.y;
                ST[jt] = MFMA32(__builtin_bit_cast(bf16x8, a1), uP, ST[jt]); ST[jt] = MFMA32(__builtin_bit_cast(bf16x8, a2), vP, ST[jt]); }
            WSYNC();
            if (lane == 0) flags[8] = (unsigned)(k + 1);
        }
    } else if (wave <= CK_NBUILD) {
        const int pw = wave - 1;
        LAS bf16_t* stg = (LAS bf16_t*)(lds + CK_STG) + pw * 3072;
        float w0c[4], a0c[4], kkc[4], kac[4], rkc[4];
#pragma unroll
        for (int nt = 0; nt < 4; ++nt) { const int c = h * 64 + 16 * nt + l15; w0c[nt] = w0[c]; a0c[nt] = a0[c]; kkc[nt] = k_k[c]; kac[nt] = k_a[c]; rkc[nt] = r_k[c]; }
        v4u ld[20];
#define CK_ISSUE_A(T0) do { const int t0_ = (T0); const size_t r_ = rowb + t0_ + l15; const size_t rp_ = (t0_ + l15 == 0) ? r_ : r_ - 1; \
            _Pragma("unroll") for (int lo = 0; lo < 2; ++lo) _Pragma("unroll") for (int ks = 0; ks < 2; ++ks) { const int col = 1536 + 64 * lo + 32 * ks + 8 * kg; \
                ld[(lo * 2 + ks) * 2] = *(const v4u*)(proj + r_ * L0P + col); ld[(lo * 2 + ks) * 2 + 1] = *(const v4u*)(proj + rp_ * L0P + col); } } while (0)
#define CK_ISSUE_B(T0) do { const int t0_ = (T0); \
            _Pragma("unroll") for (int ar = 0; ar < 3; ++ar) _Pragma("unroll") for (int i = 0; i < 2; ++i) { const int p_ = lane + 64 * i, row_ = p_ >> 3, c8_ = p_ & 7; \
                const size_t r_ = rowb + t0_ + row_; const size_t rp_ = (t0_ + row_ == 0) ? r_ : r_ - 1; const int col = 512 * ar + h * 64 + 8 * c8_; \
                ld[8 + (ar * 2 + i) * 2] = *(const v4u*)(proj + r_ * L0P + col); ld[8 + (ar * 2 + i) * 2 + 1] = *(const v4u*)(proj + rp_ * L0P + col); } } while (0)
#define CK_ISSUE(T0) do { CK_ISSUE_A(T0); CK_ISSUE_B(T0); } while (0)
        CK_ISSUE(16 * pw);
        int k = pw;
#pragma unroll 1
        while (k < NCH) {
            const int t0 = 16 * k; int kn;
#if defined(PROBE_STAMPS)
            const unsigned ts0_ = (unsigned)__builtin_amdgcn_s_memrealtime();
#endif
            f32x4 accw[4], acca[4];
#pragma unroll
            for (int nt = 0; nt < 4; ++nt) { accw[nt] = (f32x4){0.f, 0.f, 0.f, 0.f}; acca[nt] = (f32x4){0.f, 0.f, 0.f, 0.f}; }
            { const float pz_ = (t0 + l15 == 0) ? 0.f : 1.f;
#pragma unroll
              for (int lo = 0; lo < 2; ++lo)
#pragma unroll
                for (int ks = 0; ks < 2; ++ks) { float s_[8];
                    const f32x4 m0 = *(const LAS f32x4*)(mixs + 64 * lo + 32 * ks + 8 * kg), m1 = *(const LAS f32x4*)(mixs + 64 * lo + 32 * ks + 8 * kg + 4);
                    RW_SH8(ld[(lo * 2 + ks) * 2], ld[(lo * 2 + ks) * 2 + 1], m0, m1, s_, pz_);
                    if (lo == 0) {
#pragma unroll
                        for (int j = 0; j < 8; ++j) s_[j] = tanh_fast(s_[j]); }
                    const bf16x8 af = pack8(s_[0], s_[1], s_[2], s_[3], s_[4], s_[5], s_[6], s_[7]);
                    const bf16_t* WT = lo ? A2T : W2T;
#pragma unroll
                    for (int nt = 0; nt < 4; ++nt) { const bf16x8 bfr = *(const bf16x8*)(WT + (size_t)(h * 64 + 16 * nt + l15) * 64 + 32 * ks + 8 * kg);
                        if (lo == 0) accw[nt] = MFMA16(af, bfr, accw[nt]); else acca[nt] = MFMA16(af, bfr, acca[nt]); } } }
#pragma unroll
            for (int ar = 0; ar < 3; ++ar)
#pragma unroll
                for (int i = 0; i < 2; ++i) { const int p_ = lane + 64 * i, row_ = p_ >> 3, c8_ = p_ & 7; float s_[8];
                    const float pz_ = (t0 + row_ == 0) ? 0.f : 1.f; const f32x4 m0 = *(const LAS f32x4*)(mixs + 256 + ar * 64 + c8_ * 8), m1 = *(const LAS f32x4*)(mixs + 256 + ar * 64 + c8_ * 8 + 4);
                    RW_SH8(ld[8 + (ar * 2 + i) * 2], ld[8 + (ar * 2 + i) * 2 + 1], m0, m1, s_, pz_);
                    *(LAS bf16x8*)(stg + ar * 1024 + row_ * 64 + c8_ * 8) = pack8(s_[0], s_[1], s_[2], s_[3], s_[4], s_[5], s_[6], s_[7]); }
            WSYNC();
#if defined(PROBE_STAMPS)
            if (blk == 0 && wave == 1 && lane == 0) ((volatile LAS unsigned*)(lds + 146432 + 320))[16 + 26] += (unsigned)__builtin_amdgcn_s_memrealtime() - ts0_;
#endif
#if defined(PROBE_STAMPS)
            const unsigned tb0_ = (unsigned)__builtin_amdgcn_s_memrealtime();
#endif
            { const int need = k - (CK_NSLOT - 1); if (need > 0) { while ((int)flags[8] < need) __builtin_amdgcn_s_sleep(2); } }
#if defined(PROBE_STAMPS)
            if (blk == 0 && wave == 1 && lane == 0) ((volatile LAS unsigned*)(lds + 146432 + 320))[16 + 25] += (unsigned)__builtin_amdgcn_s_memrealtime() - tb0_;
#endif
            asm volatile("" ::: "memory");
            LAS unsigned char* im = lds + (k % CK_NSLOT) * CK_SLOT;
#if defined(PROBE_STAMPS)
            const unsigned ts1_ = (unsigned)__builtin_amdgcn_s_memrealtime();
#endif
            float lwv[4][4], av[4][4], knv[4][4];
#pragma unroll
            for (int rg = 0; rg < 4; ++rg) { const int tl = 4 * kg + rg;
                float kkv[4], nrm2 = 0.f, vv[4], rr_[4], kr_[4];
#pragma unroll
                for (int nt = 0; nt < 4; ++nt) { rr_[nt] = bf2f(stg[tl * 64 + 16 * nt + l15]); kr_[nt] = bf2f(stg[1024 + tl * 64 + 16 * nt + l15]); vv[nt] = bf2f(stg[2048 + tl * 64 + 16 * nt + l15]);
                    kkv[nt] = kr_[nt] * kkc[nt]; nrm2 += kkv[nt] * kkv[nt]; }
                nrm2 = rowsum16(nrm2); const float rn = __builtin_amdgcn_rsqf(fmaxf(nrm2, 1e-24f));
                float bon = 0.f;
#pragma unroll
                for (int nt = 0; nt < 4; ++nt) {
                    const float wsum = w0c[nt] + accw[nt][rg]; lwv[nt][rg] = -0.6065306597126334f * sigmoid_fast(wsum);
                    const float a_ = sigmoid_fast(a0c[nt] + acca[nt][rg]); av[nt][rg] = a_; knv[nt][rg] = kkv[nt] * rn;
                    const float k2 = kr_[nt] * (1.f + (a_ - 1.f) * kac[nt]); stg[1024 + tl * 64 + 16 * nt + l15] = bf1(k2);
                    bon += rr_[nt] * k2 * rkc[nt];
                    if ((nt >> 1) == ihalf) *(LAS bf16_t*)(im + CK_VT + (16 * (nt & 1) + l15) * 48 + tl * 2) = bf1(vv[nt]);
                }
                bon = rowsum16(bon);
                if (l15 == 0 && ihalf == 0) bonus_out[(rowb + t0 + tl) * 8 + h] = bon;
            }
            { unsigned g_ = 0; if (lane == 0) g_ = __hip_atomic_fetch_add((LAS unsigned*)(lds + CK_FLAGS + 36), 1u, __ATOMIC_RELAXED, __HIP_MEMORY_SCOPE_WORKGROUP);
              kn = (int)__builtin_amdgcn_readfirstlane(g_); }
            CK_ISSUE_A((kn < NCH) ? 16 * kn : t0);
#pragma unroll
            for (int nt = 0; nt < 4; ++nt) {
                float L[4]; L[0] = lwv[nt][0]; L[1] = L[0] + lwv[nt][1]; L[2] = L[1] + lwv[nt][2]; L[3] = L[2] + lwv[nt][3];
                const float T0 = __shfl(L[3], l15), T1 = __shfl(L[3], 16 + l15), T2 = __shfl(L[3], 32 + l15), T3 = __shfl(L[3], 48 + l15);
                const float off = (kg > 0 ? T0 : 0.f) + (kg > 1 ? T1 : 0.f) + (kg > 2 ? T2 : 0.f), LC = (T0 + T1) + (T2 + T3);
                const int j = 16 * nt + l15;
                unsigned bb2[2], kb2[2];
                const float gC = __expf(LC); float eprev = __expf(off);
#pragma unroll
                for (int rg = 0; rg < 4; ++rg) { const int tl = 4 * kg + rg; const float Lt = off + L[rg], e1 = __expf(Lt), e2 = __builtin_amdgcn_rcpf(e1), e3 = eprev, e4 = gC * e2; eprev = e1;
                    const float kn = knv[nt][rg], bvv = kn * av[nt][rg], k2 = bf2f(stg[1024 + tl * 64 + j]), rr2 = bf2f(stg[tl * 64 + j]);
                    *(LAS bf16_t*)(im + CK_BK + tl * 144 + j * 2) = bf1(bvv * e2); *(LAS bf16_t*)(im + CK_BK + (16 + tl) * 144 + j * 2) = bf1(k2 * e2);
                    *(LAS bf16_t*)(im + CK_AR + tl * 144 + j * 2) = bf1(-kn * e3); *(LAS bf16_t*)(im + CK_AR + (16 + tl) * 144 + j * 2) = bf1(rr2 * e1);
                    const unsigned bq = bf1(bvv * e4), kq = bf1(k2 * e4);
                    if (rg & 1) { bb2[rg >> 1] |= bq << 16; kb2[rg >> 1] |= kq << 16; } else { bb2[rg >> 1] = bq; kb2[rg >> 1] = kq; } }
                *(LAS u32x2*)(im + CK_BBT + j * 48 + (4 * kg) * 2) = (u32x2){bb2[0], bb2[1]}; *(LAS u32x2*)(im + CK_KBT + j * 48 + (4 * kg) * 2) = (u32x2){kb2[0], kb2[1]};
                if (kg == 0) *(LAS float*)(im + CK_GC + j * 4) = gC;
            }
            WSYNC();
#if defined(PROBE_STAMPS)
            const unsigned ts2_ = (unsigned)__builtin_amdgcn_s_memrealtime();
            if (blk == 0 && wave == 1 && lane == 0) ((volatile LAS unsigned*)(lds + 146432 + 320))[16 + 27] += ts2_ - ts1_;
#endif
            {
                f32x4 nacc = {0.f, 0.f, 0.f, 0.f};
#pragma unroll
                for (int ks = 0; ks < 2; ++ks) { const bf16x8 fa = *(const LAS bf16x8*)(im + CK_BK + l15 * 144 + (32 * ks + 8 * kg) * 2), fb = *(const LAS bf16x8*)(im + CK_AR + l15 * 144 + (32 * ks + 8 * kg) * 2); nacc = MFMA16(fa, fb, nacc); }
#pragma unroll
                for (int rg = 0; rg < 4; ++rg) nacc[rg] = ((4 * kg + rg) < l15) ? nacc[rg] : 0.f;
                float Tr[16];
#pragma unroll
                for (int t = 0; t < 16; ++t) { float acc_ = (l15 == t) ? 1.f : 0.f;
#pragma unroll
                    for (int s2 = 0; s2 < t; ++s2) acc_ += Tr[s2] * rl(nacc[s2 & 3], t + 16 * (s2 >> 2));
                    Tr[t] = acc_; }
                if (kg == 0) {
#pragma unroll
                    for (int t = 0; t < 16; ++t) *(LAS bf16_t*)(im + CK_TT + t * 48 + l15 * 2) = bf1(Tr[t]); }
            }
            WSYNC();
#if defined(PROBE_STAMPS)
            if (blk == 0 && wave == 1 && lane == 0) ((volatile LAS unsigned*)(lds + 146432 + 320))[16 + 28] += (unsigned)__builtin_amdgcn_s_memrealtime() - ts2_;
#endif
            if (lane == 0) flags[k % CK_NSLOT] = (unsigned)(k + 1);
            CK_ISSUE_B((kn < NCH) ? 16 * kn : t0);
            k = kn;
        }
#undef CK_ISSUE
#undef CK_ISSUE_A
#undef CK_ISSUE_B
    } else {
        const int gq = wave - 6;
        v4u ld[8];
#define G_ISSUE(T0) do { const int t0_ = (T0); const size_t r_ = rowb + t0_ + l15; const size_t rp_ = (t0_ + l15 == 0) ? r_ : r_ - 1; \
            _Pragma("unroll") for (int ks = 0; ks < 4; ++ks) { const int col = 1664 + 32 * ks + 8 * kg; ld[2 * ks] = *(const v4u*)(proj + r_ * L0P + col); ld[2 * ks + 1] = *(const v4u*)(proj + rp_ * L0P + col); } } while (0)
        G_ISSUE(16 * gq);
#pragma unroll 1
        for (int k = gq; k < NCH; k += 2) {
            const int t0 = 16 * k;
            f32x4 accg[2] = {(f32x4){0.f, 0.f, 0.f, 0.f}, (f32x4){0.f, 0.f, 0.f, 0.f}}; const float pz_ = (t0 + l15 == 0) ? 0.f : 1.f;
#pragma unroll
            for (int ks = 0; ks < 4; ++ks) { float s_[8];
                const f32x4 m0 = *(const LAS f32x4*)(mixs + 128 + 32 * ks + 8 * kg), m1 = *(const LAS f32x4*)(mixs + 128 + 32 * ks + 8 * kg + 4);
                RW_SH8(ld[2 * ks], ld[2 * ks + 1], m0, m1, s_, pz_);
#pragma unroll
                for (int j = 0; j < 8; ++j) s_[j] = sigmoid_fast(s_[j]);
                const bf16x8 af = pack8(s_[0], s_[1], s_[2], s_[3], s_[4], s_[5], s_[6], s_[7]);
#pragma unroll
                for (int nt = 0; nt < 2; ++nt) { const bf16x8 bfr = *(const bf16x8*)(G2T + (size_t)(h * 64 + ihalf * 32 + 16 * nt + l15) * 128 + 32 * ks + 8 * kg); accg[nt] = MFMA16(af, bfr, accg[nt]); } }
            G_ISSUE((k + 2 < NCH) ? t0 + 32 : t0);
#pragma unroll
            for (int nt = 0; nt < 2; ++nt)
#pragma unroll
                for (int rg = 0; rg < 4; ++rg) gout[(rowb + t0 + 4 * kg + rg) * 512 + h * 64 + ihalf * 32 + 16 * nt + l15] = bf1(accg[nt][rg]);
        }
#undef G_ISSUE
    }
#undef RW_SH8
    __syncthreads();
}

constexpr int CC_BK = 0, CC_AR = 4608, CC_BBT = 9216, CC_KBT = 11776, CC_VT = 14336, CC_GC = 16896, CC_TT = 17152, CC_SLOT = 18432, CC_NSLOT = 6, CC_NBUILD = 5;
constexpr int CC_STG = CC_SLOT * CC_NSLOT;
constexpr int CC_MIX = CC_STG + CC_NBUILD * 6144;
constexpr int CC_FLAGS = CC_MIX + 448 * 4;
static_assert(CC_FLAGS + 64 <= 146432, "rwkv chain LDS map");
__device__ __forceinline__ void rwkv_phase_chain(LAS float* smf, int tid, int lane, int wave, int blk, const bf16_t* __restrict__ proj, const float* __restrict__ mix, const float* __restrict__ w0, const float* __restrict__ a0,
                                           const float* __restrict__ k_k, const float* __restrict__ k_a, const float* __restrict__ r_k, const bf16_t* __restrict__ W2T, const bf16_t* __restrict__ A2T, const bf16_t* __restrict__ G2T,
                                           float* __restrict__ yraw, bf16_t* __restrict__ gout, float* __restrict__ bonus_out) {
    LAS unsigned char* lds = (LAS unsigned char*)smf;
    LAS float* mixs = (LAS float*)(lds + CC_MIX);
    volatile LAS unsigned* flags = (volatile LAS unsigned*)(lds + CC_FLAGS);
    const int chain = blk, b = chain >> 3, h = chain & 7, l15 = lane & 15, kg = lane >> 4, l31 = lane & 31, hi = lane >> 5;
    const size_t rowb = (size_t)b * SEQ;
    constexpr int NCH = SEQ / 16;
    if (tid < 256) mixs[tid] = mix[1536 + tid];
    else if (tid < 448) { const int q = tid - 256; mixs[tid] = mix[512 * (q >> 6) + h * 64 + (q & 63)]; }
    if (tid < 16) flags[tid] = (tid == 10) ? (unsigned)CC_NBUILD : 0u;
    for (int q = tid; q < CC_NSLOT * 320; q += NWAVES * 64) *(LAS unsigned*)(lds + (q / 320) * CC_SLOT + CC_TT + (q % 320) * 4) = 0u;
    __syncthreads();
#define RW_SH8(CUR, PRV, M0, M1, OUT, PZ) do { const unsigned cu_[4] = {(CUR).x, (CUR).y, (CUR).z, (CUR).w}, pu_[4] = {(PRV).x, (PRV).y, (PRV).z, (PRV).w}; \
        const float mm_[8] = {(M0)[0], (M0)[1], (M0)[2], (M0)[3], (M1)[0], (M1)[1], (M1)[2], (M1)[3]}; \
        _Pragma("unroll") for (int q = 0; q < 4; ++q) { const float c0 = bflo(cu_[q]), c1 = bfhi(cu_[q]), p0 = bflo(pu_[q]) * (PZ), p1 = bfhi(pu_[q]) * (PZ); \
            OUT[2 * q] = c0 + (p0 - c0) * mm_[2 * q]; OUT[2 * q + 1] = c1 + (p1 - c1) * mm_[2 * q + 1]; } } while (0)
    if (wave < 2) {
        const int ihalf = wave;
        f32x16 ST[2];
#pragma unroll
        for (int r = 0; r < 16; ++r) { ST[0][r] = 0.f; ST[1][r] = 0.f; }
#pragma unroll 1
        for (int k = 0; k < NCH; ++k) {
#if defined(PROBE_STAMPS)
            const unsigned tw0_ = (unsigned)__builtin_amdgcn_s_memrealtime();
#endif
            { const unsigned want = (unsigned)(k + 1); const int sl = k % CC_NSLOT; while (flags[sl] != want) __builtin_amdgcn_s_sleep(1); }
#if defined(PROBE_STAMPS)
            if (blk == 0 && lane == 0) ((volatile LAS unsigned*)(lds + 146432 + 320))[16 + 24] += (unsigned)__builtin_amdgcn_s_memrealtime() - tw0_;
#endif
            asm volatile("" ::: "memory");
            const LAS unsigned char* im = lds + (k % CC_NSLOT) * CC_SLOT;
            f32x16 G;
#pragma unroll
            for (int r = 0; r < 16; ++r) G[r] = 0.f;
#pragma unroll
            for (int kk = 0; kk < 4; ++kk) { const bf16x8 fa = *(const LAS bf16x8*)(im + CC_BK + l31 * 144 + (16 * kk + 8 * hi) * 2), fb = *(const LAS bf16x8*)(im + CC_AR + l31 * 144 + (16 * kk + 8 * hi) * 2); G = MFMA32(fa, fb, G); }
            { const int tcol = l31 & 15; const bool strict = l31 < 16;
#pragma unroll
              for (int r = 0; r < 16; ++r) { const int srow = crow(r & 7, hi); const bool keep = strict ? (srow < tcol) : (srow <= tcol); G[r] = keep ? G[r] : 0.f; } }
            const bf16x8 gB = pack8(G[0], G[1], G[2], G[3], G[4], G[5], G[6], G[7]), gK = pack8(G[8], G[9], G[10], G[11], G[12], G[13], G[14], G[15]);
            f32x16 XT;
#pragma unroll
            for (int r = 0; r < 16; ++r) XT[r] = 0.f;
#pragma unroll
            for (int jt = 0; jt < 2; ++jt)
#pragma unroll
                for (int sp = 0; sp < 2; ++sp) { const LAS unsigned char* ap = im + CC_AR + l31 * 144 + (32 * jt + 16 * sp + 4 * hi) * 2;
                    const u32x2 x0 = *(const LAS u32x2*)ap, x1 = *(const LAS u32x2*)(ap + 16); v4u aw; aw.x = x0.x; aw.y = x0.y; aw.z = x1.x; aw.w = x1.y;
                    const bf16x8 sb_ = pack8(ST[jt][8 * sp], ST[jt][8 * sp + 1], ST[jt][8 * sp + 2], ST[jt][8 * sp + 3], ST[jt][8 * sp + 4], ST[jt][8 * sp + 5], ST[jt][8 * sp + 6], ST[jt][8 * sp + 7]);
                    XT = MFMA32(__builtin_bit_cast(bf16x8, aw), sb_, XT); }
            bf16x8 vP;
            { const LAS unsigned char* vp = im + CC_VT + (32 * ihalf + l31) * 40 + (4 * hi) * 2; const u32x2 x0 = *(const LAS u32x2*)vp, x1 = *(const LAS u32x2*)(vp + 16); v4u vw; vw.x = x0.x; vw.y = x0.y; vw.z = x1.x; vw.w = x1.y;
              vP = __builtin_bit_cast(bf16x8, vw); XT = MFMA32(gK, vP, XT); }
            bf16x8 uP;
            { const LAS unsigned char* tp = im + CC_TT + l31 * 40 + (4 * hi) * 2; const u32x2 x0 = *(const LAS u32x2*)tp, x1 = *(const LAS u32x2*)(tp + 16); v4u tw; tw.x = x0.x; tw.y = x0.y; tw.z = x1.x; tw.w = x1.y;
              f32x16 UT;
#pragma unroll
              for (int r = 0; r < 16; ++r) UT[r] = 0.f;
              UT = MFMA32(__builtin_bit_cast(bf16x8, tw), pack8(XT[0], XT[1], XT[2], XT[3], XT[4], XT[5], XT[6], XT[7]), UT);
              uP = pack8(UT[0], UT[1], UT[2], UT[3], UT[4], UT[5], UT[6], UT[7]); }
            XT = MFMA32(gB, uP, XT);
            { float* yp = yraw + (rowb + 16 * k) * 512 + h * 64 + 32 * ihalf + l31;
#pragma unroll
              for (int q = 0; q < 8; ++q) yp[(size_t)crow(q, hi) * 512] = XT[8 + q]; }
            { const LAS float* gc = (const LAS float*)(im + CC_GC);
#pragma unroll
              for (int jt = 0; jt < 2; ++jt)
#pragma unroll
                  for (int r = 0; r < 16; ++r) ST[jt][r] *= gc[32 * jt + crow(r, hi)]; }
#pragma unroll
            for (int jt = 0; jt < 2; ++jt) { const LAS unsigned char* bp = im + CC_BBT + (32 * jt + l31) * 40 + (4 * hi) * 2; const LAS unsigned char* kp = im + CC_KBT + (32 * jt + l31) * 40 + (4 * hi) * 2;
                const u32x2 b0 = *(const LAS u32x2*)bp, b1 = *(const LAS u32x2*)(bp + 16), k0 = *(const LAS u32x2*)kp, k1 = *(const LAS u32x2*)(kp + 16);
                v4u a1; a1.x = b0.x; a1.y = b0.y; a1.z = b1.x; a1.w = b1.y; v4u a2; a2.x = k0.x; a2.y = k0.y; a2.z = k1.x; a2.w = k1.y;
                ST[jt] = MFMA32(__builtin_bit_cast(bf16x8, a1), uP, ST[jt]); ST[jt] = MFMA32(__builtin_bit_cast(bf16x8, a2), vP, ST[jt]); }
            WSYNC();
            if (lane == 0) flags[8 + ihalf] = (unsigned)(k + 1);
        }
    } else if (wave <= CC_NBUILD + 1) {
        const int pw = wave - 2;
        LAS bf16_t* stg = (LAS bf16_t*)(lds + CC_STG) + pw * 3072;
        float w0c[4], a0c[4], kkc[4], kac[4], rkc[4];
#pragma unroll
        for (int nt = 0; nt < 4; ++nt) { const int c = h * 64 + 16 * nt + l15; w0c[nt] = w0[c]; a0c[nt] = a0[c]; kkc[nt] = k_k[c]; kac[nt] = k_a[c]; rkc[nt] = r_k[c]; }
        v4u ld[20];
#define CC_ISSUE_A(T0) do { const int t0_ = (T0); const size_t r_ = rowb + t0_ + l15; const size_t rp_ = (t0_ + l15 == 0) ? r_ : r_ - 1; \
            _Pragma("unroll") for (int lo = 0; lo < 2; ++lo) _Pragma("unroll") for (int ks = 0; ks < 2; ++ks) { const int col = 1536 + 64 * lo + 32 * ks + 8 * kg; \
                ld[(lo * 2 + ks) * 2] = *(const v4u*)(proj + r_ * L0P + col); ld[(lo * 2 + ks) * 2 + 1] = *(const v4u*)(proj + rp_ * L0P + col); } } while (0)
#define CC_ISSUE_B(T0) do { const int t0_ = (T0); \
            _Pragma("unroll") for (int ar = 0; ar < 3; ++ar) _Pragma("unroll") for (int i = 0; i < 2; ++i) { const int p_ = lane + 64 * i, row_ = p_ >> 3, c8_ = p_ & 7; \
                const size_t r_ = rowb + t0_ + row_; const size_t rp_ = (t0_ + row_ == 0) ? r_ : r_ - 1; const int col = 512 * ar + h * 64 + 8 * c8_; \
                ld[8 + (ar * 2 + i) * 2] = *(const v4u*)(proj + r_ * L0P + col); ld[8 + (ar * 2 + i) * 2 + 1] = *(const v4u*)(proj + rp_ * L0P + col); } } while (0)
#define CC_ISSUE(T0) do { CC_ISSUE_A(T0); CC_ISSUE_B(T0); } while (0)
        CC_ISSUE(16 * pw);
        int k = pw;
#pragma unroll 1
        while (k < NCH) {
            const int t0 = 16 * k; int kn;
#if defined(PROBE_STAMPS)
            const unsigned ts0_ = (unsigned)__builtin_amdgcn_s_memrealtime();
#endif
            f32x4 accw[4], acca[4];
#pragma unroll
            for (int nt = 0; nt < 4; ++nt) { accw[nt] = (f32x4){0.f, 0.f, 0.f, 0.f}; acca[nt] = (f32x4){0.f, 0.f, 0.f, 0.f}; }
            { const float pz_ = (t0 + l15 == 0) ? 0.f : 1.f;
#pragma unroll
              for (int lo = 0; lo < 2; ++lo)
#pragma unroll
                for (int ks = 0; ks < 2; ++ks) { float s_[8];
                    const f32x4 m0 = *(const LAS f32x4*)(mixs + 64 * lo + 32 * ks + 8 * kg), m1 = *(const LAS f32x4*)(mixs + 64 * lo + 32 * ks + 8 * kg + 4);
                    RW_SH8(ld[(lo * 2 + ks) * 2], ld[(lo * 2 + ks) * 2 + 1], m0, m1, s_, pz_);
                    if (lo == 0) {
#pragma unroll
                        for (int j = 0; j < 8; ++j) s_[j] = tanh_fast(s_[j]); }
                    const bf16x8 af = pack8(s_[0], s_[1], s_[2], s_[3], s_[4], s_[5], s_[6], s_[7]);
                    const bf16_t* WT = lo ? A2T : W2T;
#pragma unroll
                    for (int nt = 0; nt < 4; ++nt) { const bf16x8 bfr = *(const bf16x8*)(WT + (size_t)(h * 64 + 16 * nt + l15) * 64 + 32 * ks + 8 * kg);
                        if (lo == 0) accw[nt] = MFMA16(af, bfr, accw[nt]); else acca[nt] = MFMA16(af, bfr, acca[nt]); } } }
#pragma unroll
            for (int ar = 0; ar < 3; ++ar)
#pragma unroll
                for (int i = 0; i < 2; ++i) { const int p_ = lane + 64 * i, row_ = p_ >> 3, c8_ = p_ & 7; float s_[8];
                    const float pz_ = (t0 + row_ == 0) ? 0.f : 1.f; const f32x4 m0 = *(const LAS f32x4*)(mixs + 256 + ar * 64 + c8_ * 8), m1 = *(const LAS f32x4*)(mixs + 256 + ar * 64 + c8_ * 8 + 4);
                    RW_SH8(ld[8 + (ar * 2 + i) * 2], ld[8 + (ar * 2 + i) * 2 + 1], m0, m1, s_, pz_);
                    *(LAS bf16x8*)(stg + ar * 1024 + row_ * 64 + c8_ * 8) = pack8(s_[0], s_[1], s_[2], s_[3], s_[4], s_[5], s_[6], s_[7]); }
            WSYNC();
#if defined(PROBE_STAMPS)
            if (blk == 0 && wave == 1 && lane == 0) ((volatile LAS unsigned*)(lds + 146432 + 320))[16 + 26] += (unsigned)__builtin_amdgcn_s_memrealtime() - ts0_;
#endif
#if defined(PROBE_STAMPS)
            const unsigned tb0_ = (unsigned)__builtin_amdgcn_s_memrealtime();
#endif
            { const int need = k - (CC_NSLOT - 1); if (need > 0) { while ((int)flags[8] < need || (int)flags[9] < need) __builtin_amdgcn_s_sleep(2); } }
#if defined(PROBE_STAMPS)
            if (blk == 0 && wave == 1 && lane == 0) ((volatile LAS unsigned*)(lds + 146432 + 320))[16 + 25] += (unsigned)__builtin_amdgcn_s_memrealtime() - tb0_;
#endif
            asm volatile("" ::: "memory");
            LAS unsigned char* im = lds + (k % CC_NSLOT) * CC_SLOT;
#if defined(PROBE_STAMPS)
            const unsigned ts1_ = (unsigned)__builtin_amdgcn_s_memrealtime();
#endif
            float lwv[4][4], av[4][4], knv[4][4];
#pragma unroll
            for (int rg = 0; rg < 4; ++rg) { const int tl = 4 * kg + rg;
                float kkv[4], nrm2 = 0.f, vv[4], rr_[4], kr_[4];
#pragma unroll
                for (int nt = 0; nt < 4; ++nt) { rr_[nt] = bf2f(stg[tl * 64 + 16 * nt + l15]); kr_[nt] = bf2f(stg[1024 + tl * 64 + 16 * nt + l15]); vv[nt] = bf2f(stg[2048 + tl * 64 + 16 * nt + l15]);
                    kkv[nt] = kr_[nt] * kkc[nt]; nrm2 += kkv[nt] * kkv[nt]; }
                nrm2 = rowsum16(nrm2); const float rn = __builtin_amdgcn_rsqf(fmaxf(nrm2, 1e-24f));
                float bon = 0.f;
#pragma unroll
                for (int nt = 0; nt < 4; ++nt) {
                    const float wsum = w0c[nt] + accw[nt][rg]; lwv[nt][rg] = -0.6065306597126334f * sigmoid_fast(wsum);
                    const float a_ = sigmoid_fast(a0c[nt] + acca[nt][rg]); av[nt][rg] = a_; knv[nt][rg] = kkv[nt] * rn;
                    const float k2 = kr_[nt] * (1.f + (a_ - 1.f) * kac[nt]); stg[1024 + tl * 64 + 16 * nt + l15] = bf1(k2);
                    bon += rr_[nt] * k2 * rkc[nt];
                    *(LAS bf16_t*)(im + CC_VT + (16 * nt + l15) * 40 + tl * 2) = bf1(vv[nt]);
                }
                bon = rowsum16(bon);
                if (l15 == 0) bonus_out[(rowb + t0 + tl) * 8 + h] = bon;
            }
            { unsigned g_ = 0; if (lane == 0) g_ = __hip_atomic_fetch_add((LAS unsigned*)(lds + CC_FLAGS + 40), 1u, __ATOMIC_RELAXED, __HIP_MEMORY_SCOPE_WORKGROUP);
              kn = (int)__builtin_amdgcn_readfirstlane(g_); }
            CC_ISSUE_A((kn < NCH) ? 16 * kn : t0);
#pragma unroll
            for (int nt = 0; nt < 4; ++nt) {
                float L[4]; L[0] = lwv[nt][0]; L[1] = L[0] + lwv[nt][1]; L[2] = L[1] + lwv[nt][2]; L[3] = L[2] + lwv[nt][3];
                const float T0 = __shfl(L[3], l15), T1 = __shfl(L[3], 16 + l15), T2 = __shfl(L[3], 32 + l15), T3 = __shfl(L[3], 48 + l15);
                const float off = (kg > 0 ? T0 : 0.f) + (kg > 1 ? T1 : 0.f) + (kg > 2 ? T2 : 0.f), LC = (T0 + T1) + (T2 + T3);
                const int j = 16 * nt + l15;
                unsigned bb2[2], kb2[2];
                const float gC = __expf(LC); float eprev = __expf(off);
#pragma unroll
                for (int rg = 0; rg < 4; ++rg) { const int tl = 4 * kg + rg; const float Lt = off + L[rg], e1 = __expf(Lt), e2 = __builtin_amdgcn_rcpf(e1), e3 = eprev, e4 = gC * e2; eprev = e1;
                    const float kn = knv[nt][rg], bvv = kn * av[nt][rg], k2 = bf2f(stg[1024 + tl * 64 + j]), rr2 = bf2f(stg[tl * 64 + j]);
                    *(LAS bf16_t*)(im + CC_BK + tl * 144 + j * 2) = bf1(bvv * e2); *(LAS bf16_t*)(im + CC_BK + (16 + tl) * 144 + j * 2) = bf1(k2 * e2);
                    *(LAS bf16_t*)(im + CC_AR + tl * 144 + j * 2) = bf1(-kn * e3); *(LAS bf16_t*)(im + CC_AR + (16 + tl) * 144 + j * 2) = bf1(rr2 * e1);
                    const unsigned bq = bf1(bvv * e4), kq = bf1(k2 * e4);
                    if (rg & 1) { bb2[rg >> 1] |= bq << 16; kb2[rg >> 1] |= kq << 16; } else { bb2[rg >> 1] = bq; kb2[rg >> 1] = kq; } }
                *(LAS u32x2*)(im + CC_BBT + j * 40 + (4 * kg) * 2) = (u32x2){bb2[0], bb2[1]}; *(LAS u32x2*)(im + CC_KBT + j * 40 + (4 * kg) * 2) = (u32x2){kb2[0], kb2[1]};
                if (kg == 0) *(LAS float*)(im + CC_GC + j * 4) = gC;
            }
            WSYNC();
#if defined(PROBE_STAMPS)
            const unsigned ts2_ = (unsigned)__builtin_amdgcn_s_memrealtime();
            if (blk == 0 && wave == 1 && lane == 0) ((volatile LAS unsigned*)(lds + 146432 + 320))[16 + 27] += ts2_ - ts1_;
#endif
            {
                f32x4 nacc = {0.f, 0.f, 0.f, 0.f};
#pragma unroll
                for (int ks = 0; ks < 2; ++ks) { const bf16x8 fa = *(const LAS bf16x8*)(im + CC_BK + l15 * 144 + (32 * ks + 8 * kg) * 2), fb = *(const LAS bf16x8*)(im + CC_AR + l15 * 144 + (32 * ks + 8 * kg) * 2); nacc = MFMA16(fa, fb, nacc); }
#pragma unroll
                for (int rg = 0; rg < 4; ++rg) nacc[rg] = ((4 * kg + rg) < l15) ? nacc[rg] : 0.f;
                float Tr[16];
#pragma unroll
                for (int t = 0; t < 16; ++t) { float acc_ = (l15 == t) ? 1.f : 0.f;
#pragma unroll
                    for (int s2 = 0; s2 < t; ++s2) acc_ += Tr[s2] * rl(nacc[s2 & 3], t + 16 * (s2 >> 2));
                    Tr[t] = acc_; }
                if (kg == 0) {
#pragma unroll
                    for (int t = 0; t < 16; ++t) *(LAS bf16_t*)(im + CC_TT + t * 40 + l15 * 2) = bf1(Tr[t]); }
            }
            WSYNC();
#if defined(PROBE_STAMPS)
            if (blk == 0 && wave == 1 && lane == 0) ((volatile LAS unsigned*)(lds + 146432 + 320))[16 + 28] += (unsigned)__builtin_amdgcn_s_memrealtime() - ts2_;
#endif
            if (lane == 0) flags[k % CC_NSLOT] = (unsigned)(k + 1);
            CC_ISSUE_B((kn < NCH) ? 16 * kn : t0);
            k = kn;
        }
#undef CC_ISSUE
#undef CC_ISSUE_A
#undef CC_ISSUE_B
    } else {
        v4u ld[8];
#define G_ISSUE(T0) do { const int t0_ = (T0); const size_t r_ = rowb + t0_ + l15; const size_t rp_ = (t0_ + l15 == 0) ? r_ : r_ - 1; \
            _Pragma("unroll") for (int ks = 0; ks < 4; ++ks) { const int col = 1664 + 32 * ks + 8 * kg; ld[2 * ks] = *(const v4u*)(proj + r_ * L0P + col); ld[2 * ks + 1] = *(const v4u*)(proj + rp_ * L0P + col); } } while (0)
        G_ISSUE(0);
#pragma unroll 1
        for (int k = 0; k < NCH; ++k) {
            const int t0 = 16 * k;
            f32x4 accg[4]; const float pz_ = (t0 + l15 == 0) ? 0.f : 1.f;
#pragma unroll
            for (int nt = 0; nt < 4; ++nt) accg[nt] = (f32x4){0.f, 0.f, 0.f, 0.f};
#pragma unroll
            for (int ks = 0; ks < 4; ++ks) { float s_[8];
                const f32x4 m0 = *(const LAS f32x4*)(mixs + 128 + 32 * ks + 8 * kg), m1 = *(const LAS f32x4*)(mixs + 128 + 32 * ks + 8 * kg + 4);
                RW_SH8(ld[2 * ks], ld[2 * ks + 1], m0, m1, s_, pz_);
#pragma unroll
                for (int j = 0; j < 8; ++j) s_[j] = sigmoid_fast(s_[j]);
                const bf16x8 af = pack8(s_[0], s_[1], s_[2], s_[3], s_[4], s_[5], s_[6], s_[7]);
#pragma unroll
                for (int nt = 0; nt < 4; ++nt) { const bf16x8 bfr = *(const bf16x8*)(G2T + (size_t)(h * 64 + 16 * nt + l15) * 128 + 32 * ks + 8 * kg); accg[nt] = MFMA16(af, bfr, accg[nt]); } }
            G_ISSUE((k + 1 < NCH) ? t0 + 16 : t0);
#pragma unroll
            for (int nt = 0; nt < 4; ++nt)
#pragma unroll
                for (int rg = 0; rg < 4; ++rg) gout[(rowb + t0 + 4 * kg + rg) * 512 + h * 64 + 16 * nt + l15] = bf1(accg[nt][rg]);
        }
#undef G_ISSUE
    }
#undef RW_SH8
    __syncthreads();
}


template <bool ST = true> __device__ __forceinline__ void rwkv_post_all(const float* __restrict__ yraw, const bf16_t* __restrict__ proj, const float* __restrict__ mix, const float* __restrict__ bonus, const bf16_t* __restrict__ gbuf,
                                              const float* __restrict__ ln_g, const float* __restrict__ ln_b, bf16_t* __restrict__ ymix, int gw, int NGW, int lane) {
    for (int m = gw; m < M; m += NGW) {
        const bool has_prev = (m & (SEQ - 1)) != 0;
        float y[8], cv[8], pv[8], gg[8], bo[8];
#pragma unroll
        for (int h = 0; h < 8; ++h) { const int c = h * 64 + lane; y[h] = yraw[(size_t)m * 512 + c]; cv[h] = bf2f(proj[(size_t)m * L0P + 1024 + c]);
            pv[h] = bf2f(proj[(size_t)(has_prev ? m - 1 : m) * L0P + 1024 + c]); gg[h] = bf2f(gbuf[(size_t)m * 512 + c]); bo[h] = bonus[(size_t)m * 8 + h]; }
#pragma unroll
        for (int h = 0; h < 8; ++h) { const int c = h * 64 + lane;
            const float mu = wave_sum_dpp(y[h]) * (1.f / 64.f), d = y[h] - mu, var = wave_sum_dpp(d * d) * (1.f / 64.f);
            const float yn = d * __builtin_amdgcn_rsqf(var + 64e-5f) * ln_g[c] + ln_b[c];
            const float pvv = has_prev ? pv[h] : 0.f;
            const float v_s = cv[h] + (pvv - cv[h]) * mix[1024 + c];
            const float o = (yn + bo[h] * v_s) * gg[h];
            if (ST) ymix[(size_t)m * DM + c] = bf1(o); else asm volatile("" :: "v"(o)); }
    }
}


__device__ __forceinline__ void ssd_conv_tile(int it, int lane, LAS bf16_t* scr, const bf16_t* __restrict__ proj, const float* __restrict__ cw, const float* __restrict__ cb,
                                              bf16_t* __restrict__ xbc, bf16_t* __restrict__ xst, bf16_t* __restrict__ bt) {
    const int tt = it >> 4, ct = it & 15, m0 = tt * 64, b = m0 >> 11, t0 = m0 & (SEQ - 1), c = ct * 64 + lane;
    const float w0 = cw[c], w1 = cw[1024 + c], w2 = cw[2048 + c], w3 = cw[3072 + c], bias = cb[c];
    const bf16_t* src = proj + (size_t)m0 * L0P + 2304 + c;
    bf16_t raw[67];
    const int lo = (t0 > 0) ? -3 : 0;
#pragma unroll
    for (int t = -3; t < 64; ++t) raw[t + 3] = src[(ptrdiff_t)((t < lo) ? lo : t) * L0P];
    float u3 = (t0 > 0) ? bf2f(raw[0]) : 0.f, u2 = (t0 > 0) ? bf2f(raw[1]) : 0.f, u1 = (t0 > 0) ? bf2f(raw[2]) : 0.f;
#pragma unroll
    for (int t = 0; t < 64; ++t) {
        const float u = bf2f(raw[t + 3]);
        const float y = bias + w0 * u3 + w1 * u2 + w2 * u1 + w3 * u;
        const bf16_t o = bf1(y * __builtin_amdgcn_rcpf(1.f + __expf(-y)));
        xbc[(size_t)(m0 + t) * 1024 + c] = o;
        scr[t * STG_PITCH + lane] = o;
        u3 = u2; u2 = u1; u1 = u;
    }
    WSYNC();
    if (ct < 12) {
        bf16_t* dst = (ct < 8) ? xst + ((size_t)(b * 8 + ct) * 64) * SEQ + t0 : bt + ((size_t)(b * 2 + ((ct - 8) >> 1)) * 128 + ((ct - 8) & 1) * 64) * SEQ + t0;
#pragma unroll
        for (int i = 0; i < 8; ++i) { const int d = i * 8 + (lane >> 3), tc = lane & 7; const LAS bf16_t* p = scr + (tc * 8) * STG_PITCH + d;
            v4u o; o.x = (unsigned)p[0] | ((unsigned)p[STG_PITCH] << 16); o.y = (unsigned)p[2 * STG_PITCH] | ((unsigned)p[3 * STG_PITCH] << 16);
            o.z = (unsigned)p[4 * STG_PITCH] | ((unsigned)p[5 * STG_PITCH] << 16); o.w = (unsigned)p[6 * STG_PITCH] | ((unsigned)p[7 * STG_PITCH] << 16);
            *(v4u*)(dst + (size_t)d * SEQ + tc * 8) = o; }
    }
    WSYNC();
}
__device__ __forceinline__ float bperm(int srclane, float x) { return __builtin_bit_cast(float, __builtin_amdgcn_ds_bpermute(srclane << 2, __builtin_bit_cast(int, x))); }
__device__ __forceinline__ void scan128(float& x0, float& x1, int lane) {
#pragma unroll
    for (int o = 1; o < 64; o <<= 1) { const int sl = (lane >= o) ? lane - o : lane; const float t0 = bperm(sl, x0), t1 = bperm(sl, x1); if (lane >= o) { x0 += t0; x1 += t1; } }
    x1 += rl(x0, 63);
}
__device__ __forceinline__ void ssd_s1_unit(int unit, int lane, LAS float* tab, const bf16_t* __restrict__ xst, const bf16_t* __restrict__ bt, const float* __restrict__ dt, const float* __restrict__ a_log,
                                            float* __restrict__ sloc, float* __restrict__ asum) {
    const int h = unit & 7, c = (unit >> 3) & 15, b = unit >> 7, g = h >> 2, l0 = c * 128, l31 = lane & 31, hi = lane >> 5;
    const size_t m0 = (size_t)b * SEQ + l0;
    const float A = -expf(a_log[h]);
    const float d0 = dt[(m0 + lane) * 8 + h], d1 = dt[(m0 + 64 + lane) * 8 + h];
    float ac0 = d0 * A, ac1 = d1 * A;
    scan128(ac0, ac1, lane);
    const float aend = rl(ac1, 63);
    tab[lane] = __expf(aend - ac0) * d0; tab[64 + lane] = __expf(aend - ac1) * d1;
    if (lane == 0) asum[unit] = aend;
    WSYNC();
    f32x16 acc[2][4];
#pragma unroll
    for (int pt = 0; pt < 2; ++pt)
#pragma unroll
        for (int nt = 0; nt < 4; ++nt)
#pragma unroll
            for (int r = 0; r < 16; ++r) acc[pt][nt][r] = 0.f;
    const bf16_t* Xp = xst + ((size_t)(b * 8 + h) * 64 + l31) * SEQ + l0 + 8 * hi;
    const bf16_t* Bp = bt + ((size_t)(b * 2 + g) * 128 + l31) * SEQ + l0 + 8 * hi;
#pragma unroll 2
    for (int kk = 0; kk < 8; ++kk) {
        const f32x4 wa = *(const LAS f32x4*)(tab + 16 * kk + 8 * hi), wb = *(const LAS f32x4*)(tab + 16 * kk + 8 * hi + 4);
        bf16x8 af[2], bfr[4];
#pragma unroll
        for (int pt = 0; pt < 2; ++pt) { const v4u raw = *(const v4u*)(Xp + (size_t)pt * 32 * SEQ + 16 * kk);
            v4u w; w.x = cvtpk(bflo(raw.x) * wa[0], bfhi(raw.x) * wa[1]); w.y = cvtpk(bflo(raw.y) * wa[2], bfhi(raw.y) * wa[3]);
            w.z = cvtpk(bflo(raw.z) * wb[0], bfhi(raw.z) * wb[1]); w.w = cvtpk(bflo(raw.w) * wb[2], bfhi(raw.w) * wb[3]); af[pt] = __builtin_bit_cast(bf16x8, w); }
#pragma unroll
        for (int nt = 0; nt < 4; ++nt) bfr[nt] = *(const bf16x8*)(Bp + (size_t)nt * 32 * SEQ + 16 * kk);
#pragma unroll
        for (int pt = 0; pt < 2; ++pt)
#pragma unroll
            for (int nt = 0; nt < 4; ++nt) acc[pt][nt] = MFMA32(af[pt], bfr[nt], acc[pt][nt]);
    }
    float* dst = sloc + (size_t)unit * 8192 + l31;
#pragma unroll
    for (int pt = 0; pt < 2; ++pt)
#pragma unroll
        for (int nt = 0; nt < 4; ++nt)
#pragma unroll
            for (int r = 0; r < 16; ++r) dst[(32 * pt + crow(r, hi)) * 128 + 32 * nt] = acc[pt][nt][r];
    WSYNC();
}
__device__ __forceinline__ void ssd_s2_all(const float* __restrict__ sloc, const float* __restrict__ asum, bf16_t* __restrict__ stb, int gtid, int NT) {
    for (int i = gtid; i < 128 * 2048; i += NT) {
        const int bh = i >> 11, e4 = i & 2047, b = bh >> 3, h = bh & 7;
        f32x4 run = {0.f, 0.f, 0.f, 0.f};
#pragma unroll 4
        for (int c = 0; c < 16; ++c) { const int unit = (b * 16 + c) * 8 + h; const f32x4 tmp = *(const f32x4*)(sloc + (size_t)unit * 8192 + e4 * 4);
            uint2 w; w.x = cvtpk(run[0], run[1]); w.y = cvtpk(run[2], run[3]); *(uint2*)(stb + (size_t)unit * 8192 + e4 * 4) = w;
            run = run * __expf(asum[unit]) + tmp; }
    }
}
__device__ __forceinline__ void ssd_s3_unit(int unit, int lane, LAS float* tab, const bf16_t* __restrict__ xbc, const bf16_t* __restrict__ xst, const bf16_t* __restrict__ stb, const float* __restrict__ dt,
                                            const float* __restrict__ a_log, const float* __restrict__ dsk, bf16_t* __restrict__ yssm) {
    const int h = unit & 7, c = (unit >> 3) & 15, b = unit >> 7, g = h >> 2, l0 = c * 128, l31 = lane & 31, hi = lane >> 5;
    const size_t m0 = (size_t)b * SEQ + l0;
    const float A = -expf(a_log[h]), D = dsk[h];
    const float d0 = dt[(m0 + lane) * 8 + h], d1 = dt[(m0 + 64 + lane) * 8 + h];
    float ac0 = d0 * A, ac1 = d1 * A;
    scan128(ac0, ac1, lane);
    tab[lane] = ac0; tab[64 + lane] = ac1; tab[128 + lane] = d0; tab[192 + lane] = d1;
    WSYNC();
    const bf16_t* Cp = xbc + (m0 + l31) * 1024 + 768 + g * 128 + 8 * hi;
    const bf16_t* Sp = stb + (size_t)unit * 8192 + l31 * 128 + 8 * hi;
    const bf16_t* Bp = xbc + (m0 + l31) * 1024 + 512 + g * 128 + 8 * hi;
    const bf16_t* Xp = xst + ((size_t)(b * 8 + h) * 64 + l31) * SEQ + l0 + 4 * hi;
    LAS float* tr = tab + 256;
    const int row = lane >> 1, p0 = (lane & 1) * 16;
#pragma unroll 1
    for (int lt = 0; lt < 4; ++lt) {
        f32x16 y[2];
#pragma unroll
        for (int r = 0; r < 16; ++r) { y[0][r] = 0.f; y[1][r] = 0.f; }
        const float acl = tab[32 * lt + l31];
        bf16x8 cfr[8];
#pragma unroll
        for (int kk = 0; kk < 8; ++kk) cfr[kk] = *(const bf16x8*)(Cp + (size_t)lt * 32 * 1024 + 16 * kk);
        {   bf16x8 s0[8], s1[8];
#pragma unroll
            for (int kk = 0; kk < 8; ++kk) { s0[kk] = *(const bf16x8*)(Sp + 16 * kk); s1[kk] = *(const bf16x8*)(Sp + 32 * 128 + 16 * kk); }
#pragma unroll
            for (int kk = 0; kk < 8; ++kk) { y[0] = MFMA32(s0[kk], cfr[kk], y[0]); y[1] = MFMA32(s1[kk], cfr[kk], y[1]); }
        }
        { const float el = __expf(acl);
#pragma unroll
          for (int r = 0; r < 16; ++r) { y[0][r] *= el; y[1][r] *= el; } }
#pragma unroll 1
        for (int st = 0; st <= lt; ++st) {
            bf16x8 bfr[8]; u32x2 xf[2][2][2];
#pragma unroll
            for (int kk = 0; kk < 8; ++kk) bfr[kk] = *(const bf16x8*)(Bp + (size_t)st * 32 * 1024 + 16 * kk);
#pragma unroll
            for (int pt = 0; pt < 2; ++pt)
#pragma unroll
                for (int ks = 0; ks < 2; ++ks) { const bf16_t* xp = Xp + (size_t)pt * 32 * SEQ + st * 32 + 16 * ks; xf[pt][ks][0] = *(const u32x2*)xp; xf[pt][ks][1] = *(const u32x2*)(xp + 8); }
            f32x16 cbt;
#pragma unroll
            for (int r = 0; r < 16; ++r) cbt[r] = 0.f;
#pragma unroll
            for (int kk = 0; kk < 8; ++kk) cbt = MFMA32(bfr[kk], cfr[kk], cbt);
#pragma unroll
            for (int r = 0; r < 16; ++r) { const int sl = 32 * st + crow(r, hi); const float acs = tab[sl], dts = tab[128 + sl];
                float v = cbt[r] * __expf(acl - acs) * dts; if (st == lt && crow(r, hi) > l31) v = 0.f; cbt[r] = v; }
            bf16x8 pf[2];
#pragma unroll
            for (int ks = 0; ks < 2; ++ks) pf[ks] = pack8(cbt[8 * ks], cbt[8 * ks + 1], cbt[8 * ks + 2], cbt[8 * ks + 3], cbt[8 * ks + 4], cbt[8 * ks + 5], cbt[8 * ks + 6], cbt[8 * ks + 7]);
#pragma unroll
            for (int pt = 0; pt < 2; ++pt)
#pragma unroll
                for (int ks = 0; ks < 2; ++ks) { v4u a; a.x = xf[pt][ks][0].x; a.y = xf[pt][ks][0].y; a.z = xf[pt][ks][1].x; a.w = xf[pt][ks][1].y; y[pt] = MFMA32(__builtin_bit_cast(bf16x8, a), pf[ks], y[pt]); }
        }
#pragma unroll
        for (int pt = 0; pt < 2; ++pt) {
#pragma unroll
            for (int r = 0; r < 16; ++r) tr[l31 * 33 + crow(r, hi)] = y[pt][r];
            WSYNC();
            const size_t m = m0 + 32 * lt + row;
            const v4u xa = *(const v4u*)(xbc + m * 1024 + h * 64 + 32 * pt + p0), xb = *(const v4u*)(xbc + m * 1024 + h * 64 + 32 * pt + p0 + 8);
            const unsigned xu[8] = {xa.x, xa.y, xa.z, xa.w, xb.x, xb.y, xb.z, xb.w};
            unsigned ow[8];
#pragma unroll
            for (int q = 0; q < 8; ++q) { const float v0 = tr[row * 33 + p0 + 2 * q] + D * bflo(xu[q]), v1 = tr[row * 33 + p0 + 2 * q + 1] + D * bfhi(xu[q]); ow[q] = cvtpk(v0, v1); }
            bf16_t* dst = yssm + m * 512 + h * 64 + 32 * pt + p0;
            *(v4u*)dst = (v4u){ow[0], ow[1], ow[2], ow[3]}; *(v4u*)(dst + 8) = (v4u){ow[4], ow[5], ow[6], ow[7]};
            WSYNC();
        }
    }
}

struct Args { const float* in[43]; float* out; unsigned char* ws; };
#define GEMM_PHASE(EPI, Aptr, LDA, Bptr, LDB, NN, KK, ...) do { pg8::Gemm g_{(Aptr), (Bptr), M, (NN), (KK), (LDA), (LDB)}; pg8::StaticOrder S_; S_.init(M, (NN), G, (int)blockIdx.x); \
        pg8::EPI E_{__VA_ARGS__}; pg8::gemm_phase<pg8::EPI, pg8::StaticOrder, true, true>(lds3, g_, S_, E_); } while (0)

__global__ void __launch_bounds__(NWAVES * 64, 2) fwd_mega(Args args) {
    extern __shared__ __attribute__((aligned(16))) unsigned char lds[];
    LAS unsigned char* lds3 = (LAS unsigned char*)lds;
    volatile LAS unsigned* MISC = (volatile LAS unsigned*)(lds3 + MISC_OFF);
    const int G = gridDim.x, NGW = G * NWAVES, NT = G * NWAVES * 64;
#define PHASE_IDS() int tid = threadIdx.x; asm volatile("" : "+v"(tid)); const int lane = tid & 63, wave = __builtin_amdgcn_readfirstlane(tid >> 6); const int gw = blockIdx.x * NWAVES + wave, gtid = blockIdx.x * (NWAVES * 64) + tid; (void)lane; (void)gw; (void)gtid
    unsigned char* ws = args.ws;
    gu32* ctl = (gu32*)(ws + WS_CTL);
    for (int u = threadIdx.x; u < (LDS_BYTES - LDSCTL_OFF) / 4; u += NWAVES * 64) ((LAS unsigned*)(lds3 + LDSCTL_OFF))[u] = 0u;
    __syncthreads();
    XcdBarrier bar = xcd_barrier_post((unsigned*)(ctl + CW_BAR), MISC + 8);
#if defined(PROBE_STAMPS)
    int nb_ = 0;
    if (blockIdx.x == 0 && threadIdx.x == 0) MISC[16] = (unsigned)__builtin_amdgcn_s_memrealtime();
#define GRID_BAR() do { xcd_barrier(bar); ++nb_; if (blockIdx.x == 0 && threadIdx.x == 0) MISC[16 + nb_] = (unsigned)__builtin_amdgcn_s_memrealtime(); } while (0)
#else
#define GRID_BAR() xcd_barrier(bar)
#endif
#define IN(i) (args.in[i])
    float* out = args.out;
    bf16_t* W0in = (bf16_t*)(ws + WS_W0IN); bf16_t* W0out = (bf16_t*)(ws + WS_W0OUT); bf16_t* Wup0 = (bf16_t*)(ws + WS_WUP0); bf16_t* Wdn0 = (bf16_t*)(ws + WS_WDN0);
    bf16_t* W1in = (bf16_t*)(ws + WS_W1IN); bf16_t* Wuq = (bf16_t*)(ws + WS_WUQ); bf16_t* Wukv = (bf16_t*)(ws + WS_WUKV); bf16_t* W1out = (bf16_t*)(ws + WS_W1OUT);
    bf16_t* Wup1 = (bf16_t*)(ws + WS_WUP1); bf16_t* Wdn1 = (bf16_t*)(ws + WS_WDN1);
    bf16_t* XB = (bf16_t*)(ws + WS_XB); bf16_t* YMIX = (bf16_t*)(ws + WS_YMIX); bf16_t* PROJ0 = (bf16_t*)(ws + WS_BIG);
    float* YRAW = out; bf16_t* YSSM = (bf16_t*)(out + (size_t)M * 512); bf16_t* STB = (bf16_t*)(out + (size_t)M * 768); bf16_t* XST = (bf16_t*)(ws + WS_XST); bf16_t* BT = (bf16_t*)(ws + WS_BT); float* ASUM = (float*)(ws + WS_ASUM); float* SLOC = (float*)(ws + WS_SLOC); float* DT = (float*)(ws + WS_DT); bf16_t* GB = (bf16_t*)(ws + WS_G); float* BONUS = (float*)(ws + WS_BONUS);
    bf16_t* W2T = (bf16_t*)(ws + WS_W2T); bf16_t* A2T = (bf16_t*)(ws + WS_A2T); bf16_t* G2T = (bf16_t*)(ws + WS_G2T); bf16_t* ACT = (bf16_t*)(ws + WS_GU); bf16_t* HALO = (bf16_t*)(ws + WS_GU + 176 * MiB);
    bf16_t* PROJ1 = (bf16_t*)(ws + WS_PROJ1); bf16_t* QM = (bf16_t*)(ws + WS_QM); bf16_t* KVM = (bf16_t*)(ws + WS_KVM); bf16_t* KPE = (bf16_t*)(ws + WS_KPE); float* RS = (float*)(ws + WS_RS); float* CSTAB = (float*)(ws + WS_CSTAB); float* STATS = (float*)(ws + WS_CSTAB + 4 * MiB); bf16_t* VTS = (bf16_t*)(ws + WS_VTS); bf16_t* VTM = (bf16_t*)(ws + WS_VTM);
    const int* pos = (const int*)args.in[1];

    {
        PHASE_IDS();
    {
        LAS float* scr = (LAS float*)(lds3 + wave * 16384); int trb = 0;
        transpose_matrix(IN(2), 1024, 3336, W0in, L0P, 1024, scr, gw, NGW, lane, nullptr, trb);
        transpose_matrix(IN(20), 1024, 1024, W0out, 1024, 1024, scr, gw, NGW, lane, nullptr, trb);
        transpose_matrix(IN(23), 1024, 5632, Wup0, 5632, 1024, scr, gw, NGW, lane, nullptr, trb, true);
        transpose_matrix(IN(26), 2816, 1024, Wdn0, 1024, 2816, scr, gw, NGW, lane, nullptr, trb);
        transpose_matrix(IN(29), 1024, 1952, W1in, L1P, 1024, scr, gw, NGW, lane, nullptr, trb);
        transpose_matrix(IN(31), 256, 768, Wuq, 768, 256, scr, gw, NGW, lane, IN(30), trb);
        transpose_matrix(IN(33), 128, 1024, Wukv, 1024, 256, scr, gw, NGW, lane, IN(32), trb);
        for (int i = gtid; i < 1024 * 16; i += NT) { const int n = i >> 4, c = i & 15; *(v4u*)(Wukv + (size_t)n * 256 + 128 + c * 8) = (v4u){0u, 0u, 0u, 0u}; }
        transpose_matrix(IN(34), 1024, 1024, W1out, 1024, 1024, scr, gw, NGW, lane, nullptr, trb);
        transpose_matrix(IN(37), 1024, 5632, Wup1, 5632, 1024, scr, gw, NGW, lane, nullptr, trb, true);
        transpose_matrix(IN(40), 2816, 1024, Wdn1, 1024, 2816, scr, gw, NGW, lane, nullptr, trb);
        transpose_matrix(IN(5), 64, 512, W2T, 512, 64, scr, gw, NGW, lane, nullptr, trb);
        transpose_matrix(IN(7), 64, 512, A2T, 512, 64, scr, gw, NGW, lane, nullptr, trb);
        transpose_matrix(IN(8), 128, 512, G2T, 512, 128, scr, gw, NGW, lane, nullptr, trb);
        const float* x = IN(0);
        {
            constexpr size_t TOT4 = (size_t)M * DM / 4;
            for (size_t i = gtid; i < TOT4; i += (size_t)NT * 8) {
                f32x4 v[8];
#pragma unroll
                for (int u = 0; u < 8; ++u) v[u] = *(const f32x4*)(x + (i + (size_t)u * NT) * 4);
#pragma unroll
                for (int u = 0; u < 8; ++u) { uint2 w; w.x = cvtpk(v[u][0], v[u][1]); w.y = cvtpk(v[u][2], v[u][3]); *(uint2*)(XB + (i + (size_t)u * NT) * 4) = w; }
            }
        }
    }
    }
    GRID_BAR();
    {
        PHASE_IDS();
    GEMM_PHASE(EpiBf16S, XB, DM, W0in, 1024, L0P, 1024, PROJ0, nullptr, L0P, 0);
    }
    GRID_BAR();
    {
        PHASE_IDS();
        const int blk = (int)blockIdx.x, m0 = blk * 128;
        {   LAS bf16_t* scr = (LAS bf16_t*)(lds3 + wave * 16384);
#pragma unroll 1
            for (int k = 0; k < 4; ++k) ssd_conv_tile((2 * blk + (k & 1)) * 16 + wave + 8 * (k >> 1), lane, scr, PROJ0, IN(14), IN(15), XB, XST, BT);
            for (int i = tid; i < 1024; i += NWAVES * 64) { const int m = m0 + (i >> 3); DT[(size_t)m * 8 + (i & 7)] = softplusf_(bf2f(PROJ0[(size_t)m * L0P + 3328 + (i & 7)]) + IN(16)[i & 7]); }
        }
        __syncthreads();
#if defined(PROBE_STAMPS)
        if (blockIdx.x == 0 && threadIdx.x == 0) MISC[16 + 29] = (unsigned)__builtin_amdgcn_s_memrealtime();
#endif
        ssd_s1_unit(blk * 8 + wave, lane, (LAS float*)(lds3 + wave * 16384), XST, BT, DT, IN(17), SLOC, ASUM);
    }
    GRID_BAR();
    {
        PHASE_IDS();
        ssd_s2_all(SLOC, ASUM, STB, gtid, NT);
    }
    GRID_BAR();
    {
        PHASE_IDS();
        const int blk = (int)blockIdx.x;
        if (blk < 128) {
            rwkv_phase_chain((LAS float*)lds3, tid, lane, wave, blk, PROJ0, IN(3), IN(4), IN(6), IN(9), IN(10), IN(11), W2T, A2T, G2T, YRAW, GB, BONUS);
        } else {
            const int bc0 = (blk - 128) * 2;
#pragma unroll 1
            for (int u = 0; u < 2; ++u) ssd_s3_unit((bc0 + u) * 8 + wave, lane, (LAS float*)(lds3 + wave * 16384), XB, XST, STB, DT, IN(17), IN(18), YSSM);
            __syncthreads();
            ssm_gate_norm_all(YSSM, PROJ0, IN(19), YMIX, bc0 * 256 + wave, bc0 * 256 + 512, lane);
        }
    }
    GRID_BAR();
    {
        PHASE_IDS();
        rwkv_post_all(YRAW, PROJ0, IN(3), BONUS, GB, IN(12), IN(13), YMIX, gw, NGW, lane);
    }
    GRID_BAR();
    {
        PHASE_IDS();
    GEMM_PHASE(EpiResid, YMIX, DM, W0out, 1024, 1024, 1024, IN(0), out, ALPHA, 0);
    }
    GRID_BAR();
    {
        PHASE_IDS();
    ln_rows<1>(out, XB, STATS, IN(21), IN(22), gw, NGW, lane);
    }
    GRID_BAR();
    {
        PHASE_IDS();
        { pg8::Gemm g_{XB, Wup0, M / 32, DFF, 1024, DM, 1024, 4096, 8192, 256, 512, 1}; pg8::StaticOrder S_; S_.init(M / 32, DFF, G, (int)blockIdx.x);
          pg8::EpiBf16S E_{HALO, nullptr, DFF, 0}; pg8::gemm_phase<pg8::EpiBf16S, pg8::StaticOrder, true, true>(lds3, g_, S_, E_); }
    }
    GRID_BAR();
    {
        PHASE_IDS();
        { pg8::Gemm g_{XB, Wup0, M, 2 * DFF, 1024, DM, 1024}; pg8::StaticOrder S_; S_.init(M, 2 * DFF, G, (int)blockIdx.x);
          pg8::EpiConvAct E_{ACT, HALO, IN(24), IN(25), DFF, SEQ}; pg8::gemm_phase<pg8::EpiConvAct, pg8::StaticOrder, true, true>(lds3, g_, S_, E_); }
    }
    GRID_BAR();
    {
        PHASE_IDS();
    GEMM_PHASE(EpiResidLN, ACT, DFF, Wdn0, DFF, 1024, DFF, out, STATS, IN(21), IN(22), ALPHA, 0);
    }
    GRID_BAR();
    {
        PHASE_IDS();
    ln_rows<1>(out, XB, STATS, IN(27), IN(28), gw, NGW, lane);
    }
    GRID_BAR();
    {
        PHASE_IDS();
    GEMM_PHASE(EpiBf16S, XB, DM, W1in, 1024, L1P, 1024, PROJ1, nullptr, L1P, 0);
    }
    GRID_BAR();
    {
        PHASE_IDS();
    mla_prep_all(PROJ1, pos, RS, KPE, CSTAB, gw, NGW, lane);
    }
    GRID_BAR();
    {
        PHASE_IDS();
    GEMM_PHASE(EpiBf16S, PROJ1 + 1536, L1P, Wuq, 256, 768, 256, QM, RS, 768, 2);
    GEMM_PHASE(EpiBf16S, PROJ1 + 1792, L1P, Wukv, 256, 1024, 256, KVM, RS + 1, 1024, 2);
    }
    GRID_BAR();
    {
        PHASE_IDS();
    rope_q_all(QM, CSTAB, gtid, NT);
    {
        LAS bf16_t* scr = (LAS bf16_t*)(lds3 + wave * 16384);
        for (int it = gw; it < 8192; it += NGW) { const int which = it >> 12, r = it & 4095, bh = r >> 5, tt = r & 31, b = bh >> 3, h = bh & 7;
            if (which == 0) transpose_tile64(PROJ1 + ((size_t)b * SEQ + tt * 64) * L1P + 1024 + h * 64, L1P, VTS + (size_t)bh * 64 * SEQ + tt * 64, SEQ, scr, lane);
            else            transpose_tile64(KVM + ((size_t)b * SEQ + tt * 64) * 1024 + h * 128 + 64, 1024, VTM + (size_t)bh * 64 * SEQ + tt * 64, SEQ, scr, lane); }
    }
    }
    GRID_BAR();
    {
        PHASE_IDS();
    {
        { LAS unsigned char* wl = lds3 + wave * 16384;
          for (int g2 = gw; g2 < 2048; g2 += NGW) { const int bh = g2 >> 4, w = g2 & 15;
#pragma unroll 1
              for (int i = 0; i < 4; ++i) { const int qb = (i == 0) ? w : (i == 1) ? 31 - w : (i == 2) ? 32 + w : 63 - w; sb_wave(bh, qb, lane, PROJ1, VTS, YMIX, wl); } } }
        __syncthreads();
        for (int g2 = (int)blockIdx.x; g2 < 256; g2 += G) { const int bh = g2 >> 1, part = g2 & 1;
#pragma unroll 1
            for (int i = 0; i < 4; ++i) { const int sbk = part ? ((i == 0) ? 1 : (i == 1) ? 6 : (i == 2) ? 2 : 5) : ((i == 0) ? 0 : (i == 1) ? 7 : (i == 2) ? 3 : 4);
                mla_block(bh, sbk, tid, lane, wave, lds3, QM, KVM, KPE, VTM, YMIX); } }
    }
    }
    GRID_BAR();
    {
        PHASE_IDS();
    GEMM_PHASE(EpiResidLN, YMIX, DM, W1out, 1024, 1024, 1024, out, STATS, IN(27), IN(28), ALPHA, 0);
    }
    GRID_BAR();
    {
        PHASE_IDS();
    ln_rows<1>(out, XB, STATS, IN(35), IN(36), gw, NGW, lane);
    }
    GRID_BAR();
    {
        PHASE_IDS();
        { pg8::Gemm g_{XB, Wup1, M / 32, DFF, 1024, DM, 1024, 4096, 8192, 256, 512, 1}; pg8::StaticOrder S_; S_.init(M / 32, DFF, G, (int)blockIdx.x);
          pg8::EpiBf16S E_{HALO, nullptr, DFF, 0}; pg8::gemm_phase<pg8::EpiBf16S, pg8::StaticOrder, true, true>(lds3, g_, S_, E_); }
    }
    GRID_BAR();
    {
        PHASE_IDS();
        { pg8::Gemm g_{XB, Wup1, M, 2 * DFF, 1024, DM, 1024}; pg8::StaticOrder S_; S_.init(M, 2 * DFF, G, (int)blockIdx.x);
          pg8::EpiConvAct E_{ACT, HALO, IN(38), IN(39), DFF, SEQ}; pg8::gemm_phase<pg8::EpiConvAct, pg8::StaticOrder, true, true>(lds3, g_, S_, E_); }
    }
    GRID_BAR();
    {
        PHASE_IDS();
    GEMM_PHASE(EpiResidLN, ACT, DFF, Wdn1, DFF, 1024, DFF, out, STATS, IN(35), IN(36), ALPHA, 0);
    }
    GRID_BAR();
    {
        PHASE_IDS();
    ln_rows<2>(out, XB, STATS, IN(41), IN(42), gw, NGW, lane);
    #if defined(PROBE_STAMPS)
    __syncthreads();
    if (blockIdx.x == 0 && threadIdx.x == 0) {
        MISC[16 + 22] = (unsigned)__builtin_amdgcn_s_memrealtime();
#if defined(PROBE_ACC)
        const unsigned d1 = MISC[16 + PROBE_ACC];
#else
        const unsigned d1 = MISC[16 + PROBE_T1_HI] - MISC[16 + PROBE_T1_LO];
#endif
        const unsigned long long spin = 100ull * d1;
        const unsigned long long t0 = __builtin_amdgcn_s_memrealtime();
        while (__builtin_amdgcn_s_memrealtime() - t0 < spin) __builtin_amdgcn_s_sleep(8);
    }
#endif
}
}

extern "C" void kernel_launch(void* const* d_in, const int* in_sizes, int n_in, void* d_out, int out_size, void* d_ws, size_t ws_size, hipStream_t stream) {
    static int grid = 0;
    if (grid == 0) {
        if (n_in != 43 || ws_size < WS_NEED || out_size != M * DM) { fprintf(stderr, "kernel_launch: unexpected n_in %d / ws %zu / out %d\n", n_in, ws_size, out_size); grid = -1; return; }
        int dev = 0, cus = 0, per_cu = 0;
        if (hipGetDevice(&dev) != hipSuccess || hipDeviceGetAttribute(&cus, hipDeviceAttributeMultiprocessorCount, dev) != hipSuccess) { grid = -1; return; }
        if (hipFuncSetAttribute((const void*)fwd_mega, hipFuncAttributeMaxDynamicSharedMemorySize, LDS_BYTES) != hipSuccess) { fprintf(stderr, "kernel_launch: hipFuncSetAttribute failed\n"); grid = -1; return; }
        if (hipOccupancyMaxActiveBlocksPerMultiprocessor(&per_cu, (const void*)fwd_mega, NWAVES * 64, LDS_BYTES) != hipSuccess || per_cu < 1) fprintf(stderr, "kernel_launch: occupancy query reports %d\n", per_cu);
        (void)hipGetLastError();
        grid = cus;
    }
    if (grid < 0) return;
    (void)hipMemsetAsync((char*)d_ws + WS_CTL, 0, CTL_ZERO_BYTES, stream);
    Args a{};
    for (int i = 0; i < 43; ++i) a.in[i] = (const float*)d_in[i];
    a.out = (float*)d_out; a.ws = (unsigned char*)d_ws;
    hipLaunchKernelGGL(fwd_mega, dim3(grid), dim3(NWAVES * 64), LDS_BYTES, stream, a);
}
```

```cpp
#include <hip/hip_runtime.h>
#include <cstdio>
#include <cstdint>
#include <cmath>
namespace pg8 {
#define PG8_LAS __attribute__((address_space(3)))
typedef unsigned short bf16_t;
typedef short bf16x8 __attribute__((ext_vector_type(8)));
typedef float f32x4 __attribute__((ext_vector_type(4)));
typedef unsigned u32x4 __attribute__((ext_vector_type(4)));
constexpr int BM = 256, BK = 64, HALF = 128, HTB = HALF * BK * 2  , STAGE_BYTES = 8 * HTB, NXCD = 8, WGM = 8;

__host__ __device__ __forceinline__ int lds_byte(int r, int c) { const int st = (r >> 4) * 2 + (c >> 5), rr = r & 15, cc = c & 31, ob = rr * 64 + cc * 2; return st * 1024 + (ob ^ (((ob >> 9) & 1) << 5)); }
__host__ __device__ __forceinline__ void stage_rc(int b, int& R, int& C) { const int st = b / 1024, sb = b % 1024, swz = sb ^ (((sb >> 9) & 1) << 5); R = (st >> 1) * 16 + swz / 64; C = (st & 1) * 32 + (swz % 64) / 2; }
__host__ __device__ __forceinline__ int perm32(int rho) { const int n = rho >> 4, i = rho & 15; return 8 * (i >> 2) + 4 * n + (i & 3); }

struct Unit { int pm, pn; };
struct Gemm { const bf16_t* A; const bf16_t* Bt; int M, N, K, lda, ldb; int hrA = 128, trA = 256, hrB = 128, trB = 256, gatherA = 0; };

struct StaticOrder {
    int nM, nN, nwg, G, c;
    __host__ __device__ void init(int M, int N, int G_, int c_) { nM = M / BM; nN = N / BM; nwg = nM * nN; G = G_; c = c_; }
    __host__ __device__ bool next(int i, Unit& u) const {
        const long L = (long)i * G + c; if (L >= nwg) return false;
        int wgid = (int)L; { const int q = nwg / NXCD, r = nwg % NXCD, xcd = wgid % NXCD, off = wgid / NXCD; wgid = (xcd < r ? xcd * (q + 1) : r * (q + 1) + (xcd - r) * q) + off; }
        const int nig = WGM * nN, gid = wgid / nig, fm = gid * WGM, gsz = (nM - fm) < WGM ? (nM - fm) : WGM;
        u.pm = fm + ((wgid % nig) % gsz); u.pn = (wgid % nig) / gsz; return true;
    }
    __device__ __forceinline__ void a_ready(const Unit&) const {}
    __device__ __forceinline__ void done(const Unit&) const {}
};


__device__ __forceinline__ unsigned cvt_pk_bf16(float lo, float hi) { unsigned r; asm volatile("v_cvt_pk_bf16_f32 %0, %1, %2" : "=v"(r) : "v"(lo), "v"(hi)); return r; }
struct EpiBf16S {
    static constexpr bool PERM = true, AFTER_DRAIN = false;
    bf16_t* O; const float* rowscale; int ldc; int rs_stride;
    __device__ __forceinline__ void operator()(const f32x4 (&acc)[2][2][4][2], const Unit& u, int wr, int wc, int fr, int fq) const {
        const int row0 = u.pm * BM + wr * 64 + fr, col0 = u.pn * BM + wc * 32 + 8 * fq;
#pragma unroll
        for (int ai = 0; ai < 2; ++ai)
#pragma unroll
            for (int m = 0; m < 4; ++m) { const int row = row0 + ai * HALF + m * 16; const float sc = rowscale ? rowscale[(size_t)row * rs_stride] : 1.f;
                bf16_t* rowp = O + (size_t)row * ldc + col0;
#pragma unroll
                for (int bj = 0; bj < 2; ++bj) { const f32x4 v0 = acc[ai][bj][m][0] * sc, v1 = acc[ai][bj][m][1] * sc;
                    u32x4 w; w.x = cvt_pk_bf16(v0[0], v0[1]); w.y = cvt_pk_bf16(v0[2], v0[3]); w.z = cvt_pk_bf16(v1[0], v1[1]); w.w = cvt_pk_bf16(v1[2], v1[3]);
                    *(u32x4*)(rowp + bj * HALF) = w; } }
    }
};
struct EpiResid {
    static constexpr bool PERM = false, AFTER_DRAIN = false;
    const float* hin; float* hout; float alpha; int pad;
    __device__ __forceinline__ void operator()(const f32x4 (&acc)[2][2][4][2], const Unit& u, int wr, int wc, int fr, int fq) const {
        const int row0 = u.pm * BM + wr * 64 + fr, col0 = u.pn * BM + wc * 32 + 4 * fq;
#pragma unroll
        for (int ai = 0; ai < 2; ++ai)
#pragma unroll
            for (int m = 0; m < 4; ++m) { const size_t off = (size_t)(row0 + ai * HALF + m * 16) * 1024 + col0;
#pragma unroll
                for (int bj = 0; bj < 2; ++bj)
#pragma unroll
                    for (int n = 0; n < 2; ++n) { const size_t i = off + bj * HALF + n * 16; const f32x4 h = *(const f32x4*)(hin + i); *(f32x4*)(hout + i) = h * alpha + acc[ai][bj][m][n]; } }
    }
};

struct EpiResidLN {
    static constexpr bool PERM = false, AFTER_DRAIN = false;
    float* hio; const float* stats; const float* g; const float* b; float alpha; int pad;
    __device__ __forceinline__ void operator()(const f32x4 (&acc)[2][2][4][2], const Unit& u, int wr, int wc, int fr, int fq) const {
        const int row0 = u.pm * BM + wr * 64 + fr, col0 = u.pn * BM + wc * 32 + 4 * fq;
        f32x4 gg[2][2], bb[2][2];
#pragma unroll
        for (int bj = 0; bj < 2; ++bj)
#pragma unroll
            for (int n = 0; n < 2; ++n) { gg[bj][n] = *(const f32x4*)(g + col0 + bj * HALF + n * 16) * alpha; bb[bj][n] = *(const f32x4*)(b + col0 + bj * HALF + n * 16) * alpha; }
#pragma unroll
        for (int ai = 0; ai < 2; ++ai)
#pragma unroll
            for (int m = 0; m < 4; ++m) { const int row = row0 + ai * HALF + m * 16; const size_t off = (size_t)row * 1024 + col0;
                const float mu = stats[2 * row], rs = stats[2 * row + 1];
#pragma unroll
                for (int bj = 0; bj < 2; ++bj)
#pragma unroll
                    for (int n = 0; n < 2; ++n) { const size_t i = off + bj * HALF + n * 16; const f32x4 p = *(const f32x4*)(hio + i); *(f32x4*)(hio + i) = (p - mu) * rs * gg[bj][n] + bb[bj][n] + acc[ai][bj][m][n]; } }
    }
};

template <int CTRL> __device__ __forceinline__ float pg_dpp(float x) { return __builtin_bit_cast(float, __builtin_amdgcn_update_dpp(0, __builtin_bit_cast(int, x), CTRL, 0xF, 0xF, true)); }
struct EpiConvAct {
    static constexpr bool PERM = true, AFTER_DRAIN = false;
    bf16_t* act; const bf16_t* halo; const float* cw; const float* cb; int dff; int seq;
    __device__ __forceinline__ void operator()(const f32x4 (&acc)[2][2][4][2], const Unit& u, int wr, int wc, int fr, int fq) const {
        typedef unsigned u32x2e __attribute__((ext_vector_type(2)));
#pragma unroll
        for (int n = 0; n < 2; ++n) {
            const int ch0 = u.pn * 128 + wc * 32 + 8 * fq + 4 * n;
            const f32x4 w0 = *(const f32x4*)(cw + ch0), w1 = *(const f32x4*)(cw + dff + ch0), w2 = *(const f32x4*)(cw + 2 * dff + ch0), bb = *(const f32x4*)(cb + ch0);
#pragma unroll
            for (int ai = 0; ai < 2; ++ai) {
                const int rb64 = u.pm * BM + ai * HALF + wr * 64;
                f32x4 P = {0.f, 0.f, 0.f, 0.f};
                if ((rb64 & (seq - 1)) != 0 && fr >= 14) { const u32x2e hv = *(const u32x2e*)(halo + (size_t)(2 * (rb64 / 64 - 1) + (fr - 14)) * dff + ch0);
                    P[0] = __builtin_bit_cast(float, hv.x << 16); P[1] = __builtin_bit_cast(float, hv.x & 0xffff0000u); P[2] = __builtin_bit_cast(float, hv.y << 16); P[3] = __builtin_bit_cast(float, hv.y & 0xffff0000u); }
#pragma unroll
                for (int m = 0; m < 4; ++m) {
                    const f32x4 Gv = acc[ai][0][m][n], Uv = acc[ai][1][m][n];
                    float o[4];
#pragma unroll
                    for (int e = 0; e < 4; ++e) {
                        const float t1 = pg_dpp<0x111>(Gv[e]), t2 = pg_dpp<0x112>(Gv[e]), p1 = pg_dpp<0x10F>(P[e]), p2 = pg_dpp<0x10E>(P[e]);
                        const float g1 = (fr >= 1) ? t1 : p1, g2 = (fr >= 2) ? t2 : p2;
                        const float y = bb[e] + w0[e] * g2 + w1[e] * g1 + w2[e] * Gv[e];
                        o[e] = y * __builtin_amdgcn_rcpf(1.f + __builtin_amdgcn_exp2f(-1.4426950408889634f * y)) * Uv[e];
                    }
                    u32x2e w; w.x = cvt_pk_bf16(o[0], o[1]); w.y = cvt_pk_bf16(o[2], o[3]);
                    *(u32x2e*)(act + (size_t)(rb64 + m * 16 + fr) * dff + ch0) = w;
                    P = Gv;
                }
            }
        }
    }
};

template <class Epi, class Sched, bool ALIGN_EPI = false, bool SP2 = false>
__device__ __forceinline__ void gemm_phase(PG8_LAS unsigned char* lds, const Gemm g, const Sched& S, const Epi& E) {
    int tid = threadIdx.x; asm volatile("" : "+v"(tid));
    const int wid = __builtin_amdgcn_readfirstlane(tid >> 6), lane = tid & 63, wr = wid >> 2, wc = wid & 3, fr = lane & 15, fq = lane >> 4;
    const int K = g.K, nt = K / BK;
    unsigned voffA[2], voffB[2];
#pragma unroll
    for (int i = 0; i < 2; ++i) { int R, C; stage_rc(tid * 16 + i * 8192, R, C); const int Rb = Epi::PERM ? ((R & ~31) + perm32(R & 31)) : R;
        const int Ra = g.gatherA ? (64 * (R >> 1) + 62 + (R & 1)) : R;
        voffA[i] = (unsigned)(Ra * g.lda + C) * 2u; voffB[i] = (unsigned)(Rb * g.ldb + C) * 2u; }
    const size_t kstep = (size_t)(BK * 2);
    const size_t hstepA = (size_t)g.hrA * g.lda * 2, hstepB = (size_t)g.hrB * g.ldb * 2;
    const size_t tstepA = (size_t)g.trA * g.lda * 2, tstepB = (size_t)g.trB * g.ldb * 2;
    const unsigned ldsw = (unsigned)wid * 1024u;
    const int aoff = lds_byte(wr * 64 + fr, fq * 8), boff = lds_byte(wc * 32 + fr, fq * 8);
#define PG8_SA(b, h) (((b) * 2 + (h)) * HTB)
#define PG8_SB(b, h) ((4 + (b) * 2 + (h)) * HTB)
#define PG8_STAGE(bufoff, gbase, voff) do { _Pragma("unroll") for (int _i = 0; _i < 2; ++_i) \
        __builtin_amdgcn_global_load_lds((const unsigned*)((const char*)(gbase) + (voff)[_i]), (PG8_LAS unsigned*)(lds + (bufoff) + ldsw + _i * 8192), 16, 0, 0); } while (0)
#define PG8_LDA(dst, b, h) do { _Pragma("unroll") for (int m = 0; m < 4; ++m) _Pragma("unroll") for (int k = 0; k < 2; ++k) dst[m][k] = *(const PG8_LAS bf16x8*)(lds + PG8_SA(b, h) + aoff + m * 2048 + k * 1024); } while (0)
#define PG8_LDB(dst, b, h) do { _Pragma("unroll") for (int n = 0; n < 2; ++n) _Pragma("unroll") for (int k = 0; k < 2; ++k) dst[n][k] = *(const PG8_LAS bf16x8*)(lds + PG8_SB(b, h) + boff + n * 2048 + k * 1024); } while (0)
#define PG8_MMA(ai, bj, At, Bt) do { __builtin_amdgcn_s_setprio(1); _Pragma("unroll") for (int m = 0; m < 4; ++m) _Pragma("unroll") for (int n = 0; n < 2; ++n) _Pragma("unroll") for (int k = 0; k < 2; ++k) \
        acc[ai][bj][m][n] = __builtin_amdgcn_mfma_f32_16x16x32_bf16(Bt[n][k], At[m][k], acc[ai][bj][m][n], 0, 0, 0); __builtin_amdgcn_s_setprio(0); } while (0)
#define PG8_WAIT_V(n) asm volatile("s_waitcnt vmcnt(" #n ")" ::: "memory")
#define PG8_WAIT_L(n) asm volatile("s_waitcnt lgkmcnt(" #n ")" ::: "memory")
#define PG8_BAR __builtin_amdgcn_s_barrier()
#define PG8_SCHED __builtin_amdgcn_sched_barrier(0)
    Unit cur, nxt; int ui = 0;
    if (!S.next(0, cur)) return;
    f32x4 acc[2][2][4][2];
#pragma unroll
    for (int a = 0; a < 2; ++a)
#pragma unroll
        for (int b = 0; b < 2; ++b)
#pragma unroll
            for (int m = 0; m < 4; ++m)
#pragma unroll
                for (int n = 0; n < 2; ++n) acc[a][b][m][n] = (f32x4){0.f, 0.f, 0.f, 0.f};
    bf16x8 At[4][2], B0[2][2], B1[2][2];
    const char* cA = (const char*)g.A + (size_t)cur.pm * tstepA; const char* cB = (const char*)g.Bt + (size_t)cur.pn * tstepB;
    S.a_ready(cur);
    if constexpr (SP2) {
        PG8_STAGE(PG8_SB(0, 0), cB, voffB); PG8_STAGE(PG8_SB(0, 1), cB + hstepB, voffB); PG8_STAGE(PG8_SA(0, 0), cA, voffA); PG8_STAGE(PG8_SA(0, 1), cA + hstepA, voffA);
        if (wr == 1) PG8_BAR;
        PG8_WAIT_V(2); PG8_BAR;
        PG8_STAGE(PG8_SB(1, 0), cB + kstep, voffB); PG8_STAGE(PG8_SA(1, 0), cA + kstep, voffA); PG8_STAGE(PG8_SB(1, 1), cB + hstepB + kstep, voffB);
        PG8_WAIT_V(6); PG8_BAR;
    } else {
        PG8_STAGE(PG8_SB(0, 0), cB, voffB); PG8_STAGE(PG8_SA(0, 0), cA, voffA); PG8_STAGE(PG8_SB(0, 1), cB + hstepB, voffB); PG8_STAGE(PG8_SA(0, 1), cA + hstepA, voffA);
        if (wr == 1) PG8_BAR;
        PG8_WAIT_V(4); PG8_BAR;
        PG8_STAGE(PG8_SB(1, 0), cB + kstep, voffB); PG8_STAGE(PG8_SA(1, 0), cA + kstep, voffA); PG8_STAGE(PG8_SB(1, 1), cB + hstepB + kstep, voffB);
        PG8_WAIT_V(6); PG8_BAR;
    }
    for (;;) {
        const bool has_next = S.next(ui + 1, nxt);
        const char* nA = has_next ? (const char*)g.A + (size_t)nxt.pm * tstepA : cA; const char* nB = has_next ? (const char*)g.Bt + (size_t)nxt.pn * tstepB : cB;
        for (int t = 0; t < nt; t += 2) {
            const bool last = (t == nt - 2);
            const char* a1 = cA + (size_t)(t + 1) * kstep;
            const char* a2 = last ? nA : cA + (size_t)(t + 2) * kstep; const char* b2 = last ? nB : cB + (size_t)(t + 2) * kstep;
            const char* a3 = a2 + kstep; const char* b3 = b2 + kstep;
            if (last && has_next) S.a_ready(nxt);
            if constexpr (SP2) {
            PG8_LDB(B0, 0, 0); PG8_LDB(B1, 0, 1); PG8_SCHED; PG8_LDA(At, 0, 0); PG8_STAGE(PG8_SA(1, 1), a1 + hstepA, voffA);
            PG8_WAIT_V(8); PG8_WAIT_L(0); PG8_BAR; PG8_MMA(0, 0, At, B0); PG8_MMA(0, 1, At, B1); PG8_BAR; PG8_SCHED;
            PG8_LDA(At, 0, 1); PG8_STAGE(PG8_SB(0, 0), b2, voffB); PG8_STAGE(PG8_SB(0, 1), b2 + hstepB, voffB); PG8_STAGE(PG8_SA(0, 0), a2, voffA);
            PG8_WAIT_V(8); PG8_WAIT_L(0); PG8_BAR; PG8_MMA(1, 0, At, B0); PG8_MMA(1, 1, At, B1); PG8_BAR; PG8_SCHED;
            PG8_LDB(B0, 1, 0); PG8_LDB(B1, 1, 1); PG8_SCHED; PG8_LDA(At, 1, 0); PG8_STAGE(PG8_SA(0, 1), a2 + hstepA, voffA);
            PG8_WAIT_V(8); PG8_WAIT_L(0); PG8_BAR; PG8_MMA(0, 0, At, B0); PG8_MMA(0, 1, At, B1); PG8_BAR; PG8_SCHED;
            PG8_LDA(At, 1, 1); PG8_STAGE(PG8_SB(1, 0), b3, voffB); PG8_STAGE(PG8_SB(1, 1), b3 + hstepB, voffB); PG8_STAGE(PG8_SA(1, 0), a3, voffA);
            PG8_WAIT_V(8); PG8_WAIT_L(0); PG8_BAR; PG8_MMA(1, 0, At, B0); PG8_MMA(1, 1, At, B1); PG8_BAR; PG8_SCHED;
            } else {
            PG8_LDB(B0, 0, 0); PG8_SCHED; PG8_LDA(At, 0, 0); PG8_STAGE(PG8_SA(1, 1), a1 + hstepA, voffA);
            PG8_WAIT_L(8); PG8_BAR; PG8_WAIT_L(0); PG8_MMA(0, 0, At, B0); PG8_BAR; PG8_SCHED;
            PG8_LDB(B1, 0, 1); PG8_STAGE(PG8_SB(0, 0), b2, voffB);
            PG8_BAR; PG8_WAIT_L(0); PG8_MMA(0, 1, At, B1); PG8_BAR;
            PG8_LDA(At, 0, 1); PG8_STAGE(PG8_SA(0, 0), a2, voffA);
            PG8_BAR; PG8_WAIT_L(0); PG8_MMA(1, 0, At, B0); PG8_BAR; PG8_SCHED;
            PG8_STAGE(PG8_SB(0, 1), b2 + hstepB, voffB);
            PG8_WAIT_V(6); PG8_BAR; PG8_MMA(1, 1, At, B1); PG8_BAR;
            PG8_LDB(B0, 1, 0); PG8_SCHED; PG8_LDA(At, 1, 0); PG8_STAGE(PG8_SA(0, 1), a2 + hstepA, voffA);
            PG8_WAIT_L(8); PG8_BAR; PG8_WAIT_L(0); PG8_MMA(0, 0, At, B0); PG8_BAR; PG8_SCHED;
            PG8_LDB(B1, 1, 1); PG8_STAGE(PG8_SB(1, 0), b3, voffB);
            PG8_BAR; PG8_WAIT_L(0); PG8_MMA(0, 1, At, B1); PG8_BAR;
            PG8_LDA(At, 1, 1); PG8_STAGE(PG8_SA(1, 0), a3, voffA);
            PG8_BAR; PG8_WAIT_L(0); PG8_MMA(1, 0, At, B0); PG8_BAR; PG8_SCHED;
            PG8_STAGE(PG8_SB(1, 1), b3 + hstepB, voffB);
            PG8_WAIT_V(6); PG8_BAR; PG8_MMA(1, 1, At, B1); PG8_BAR;
            }
        }
        if constexpr (ALIGN_EPI) { if (wr == 0) PG8_BAR; }
        if constexpr (!Epi::AFTER_DRAIN) { E(acc, cur, wr, wc, fr, fq); S.done(cur); }
        if (!has_next) break;
#pragma unroll
        for (int a = 0; a < 2; ++a)
#pragma unroll
            for (int b = 0; b < 2; ++b)
#pragma unroll
                for (int m = 0; m < 4; ++m)
#pragma unroll
                    for (int n = 0; n < 2; ++n) acc[a][b][m][n] = (f32x4){0.f, 0.f, 0.f, 0.f};
        cur = nxt; cA = nA; cB = nB; ++ui;
        if constexpr (ALIGN_EPI) { if (wr == 1) PG8_BAR; }
    }
    PG8_WAIT_V(0);
    if constexpr (!ALIGN_EPI) { if (wr == 0) PG8_BAR; }
    PG8_BAR;
    if constexpr (Epi::AFTER_DRAIN) { E.fused(acc, cur, wr, wc, fr, fq, lds, wid, lane); S.done(cur); }
#undef PG8_SA
#undef PG8_SB
#undef PG8_STAGE
#undef PG8_LDA
#undef PG8_LDB
#undef PG8_MMA
#undef PG8_WAIT_V
#undef PG8_WAIT_L
#undef PG8_BAR
#undef PG8_SCHED
}
}
#define GAS __attribute__((address_space(1)))
#define LAS __attribute__((address_space(3)))
typedef unsigned short bf16;
typedef unsigned v4u __attribute__((ext_vector_type(4)));
typedef float f32x4 __attribute__((ext_vector_type(4)));
typedef short bf16x8 __attribute__((ext_vector_type(8)));
typedef GAS unsigned gu32;
typedef GAS unsigned long long gu64;
#define RLX_AGENT __ATOMIC_RELAXED, __HIP_MEMORY_SCOPE_AGENT
#define LDS_WAIT() asm volatile("s_waitcnt lgkmcnt(0)" ::: "memory")
#define VM_WAIT() asm volatile("s_waitcnt vmcnt(0)" ::: "memory")
__device__ __forceinline__ unsigned long long rt() { return __builtin_amdgcn_s_memrealtime(); }
__device__ __forceinline__ unsigned f2bf(float f) { unsigned u = __builtin_bit_cast(unsigned, f); return (u + 0x7fffu + ((u >> 16) & 1u)) >> 16; }
__device__ __forceinline__ unsigned pk2(float lo, float hi) { return f2bf(lo) | (f2bf(hi) << 16); }

#define XB_TMO      128
#define XB_XCNT(j)  (256  + 64 * (j))
#define XB_XSUB(j)  (1280 + 64 * (j))
#define XB_XGEN(j)  (2304 + 64 * (j))
#define XB_TOP      3328
#define XB_TOPGEN   3392
#define XCD_BAR_WORDS 3456
#define XB_SPIN_CAP (1u << 18)

__device__ __forceinline__ unsigned xb_ld(unsigned* p)              { return __hip_atomic_load(p, __ATOMIC_RELAXED, __HIP_MEMORY_SCOPE_AGENT); }
__device__ __forceinline__ unsigned xb_add(unsigned* p, unsigned v) { return __hip_atomic_fetch_add(p, v, __ATOMIC_RELAXED, __HIP_MEMORY_SCOPE_AGENT); }
__device__ __forceinline__ unsigned xb_xcc_id() { return (unsigned)__builtin_amdgcn_s_getreg((3 << 11) | 20) & 0xFu; }
#define XB_SPIN(cond, bar) do { unsigned _sp = 0; while (cond) { __builtin_amdgcn_s_sleep(1); \
    if ((++_sp & 255u) == 0u) { if (xb_ld(&(bar)[XB_TMO])) break; if (_sp > XB_SPIN_CAP) { atomicAdd(&(bar)[XB_TMO], 1u); break; } } } } while (0)

struct XcdBarrier {
    unsigned* bar; unsigned x;
    volatile LAS unsigned* st;
};

__device__ __forceinline__ XcdBarrier xcd_barrier_post(unsigned* bar, volatile LAS unsigned* st) {
    XcdBarrier b; b.bar = bar; b.x = xb_xcc_id(); b.st = st;
    if (threadIdx.x == 0) (void)xb_add(&bar[XB_XCNT(b.x)], 1u);
    return b;
}
__device__ __forceinline__ void xcd_barrier_complete(unsigned* bar, unsigned x, unsigned& nloc, unsigned& nx) {
    const unsigned G = gridDim.x * gridDim.y * gridDim.z;
    unsigned sum, cnt, mine, sp = 0u;
    for (;;) {
        sum = 0u; cnt = 0u; mine = 0u;
#pragma unroll
        for (unsigned j = 0; j < 16; ++j) { const unsigned c = xb_ld(&bar[XB_XCNT(j)]); sum += c; cnt += (c > 0u) ? 1u : 0u; mine = (j == x) ? c : mine; }
        if (sum == G) break;
        __builtin_amdgcn_s_sleep(1);
        if ((++sp & 255u) == 0u) { if (xb_ld(&bar[XB_TMO])) break; if (sp > XB_SPIN_CAP) { atomicAdd(&bar[XB_TMO], 1u); break; } }
    }
    nloc = mine > 0u ? mine : 1u; nx = cnt > 0u ? cnt : 1u;
}

__device__ __forceinline__ void xcd_barrier(const XcdBarrier& b) {
    asm volatile("s_waitcnt vmcnt(0)" ::: "memory");
    __syncthreads();
    if (threadIdx.x == 0) {
        unsigned* bar = b.bar;
        __builtin_amdgcn_s_waitcnt(0);
        unsigned nloc = b.st[0], nx = b.st[1];
        if (nloc == 0u) { xcd_barrier_complete(bar, b.x, nloc, nx); b.st[0] = nloc; b.st[1] = nx; }
        const unsigned old = xb_add(&bar[XB_XSUB(b.x)], 1u);
        const unsigned gen = old / nloc;
        if (old + 1u == (gen + 1u) * nloc) {
            __builtin_amdgcn_fence(__ATOMIC_RELEASE, "agent");
            asm volatile("s_waitcnt vmcnt(0)" ::: "memory");
            const unsigned og = xb_add(&bar[XB_TOP], 1u);
            const unsigned tg = og / nx;
            if (og + 1u == (tg + 1u) * nx) xb_add(&bar[XB_TOPGEN], 1u);
            else XB_SPIN(xb_ld(&bar[XB_TOPGEN]) == tg, bar);
            __builtin_amdgcn_fence(__ATOMIC_ACQUIRE, "agent");
            xb_add(&bar[XB_XGEN(b.x)], 1u);
            asm volatile("s_waitcnt vmcnt(0)" ::: "memory");
        } else {
            XB_SPIN(xb_ld(&bar[XB_XGEN(b.x)]) == gen, bar);
            __builtin_amdgcn_fence(__ATOMIC_ACQUIRE, "agent");
            asm volatile("s_waitcnt vmcnt(0)" ::: "memory");
        }
    }
    __syncthreads();
}
constexpr int NWAVES = 8;
constexpr int BATCH = 16, SEQ = 2048, DM = 1024, M = BATCH * SEQ;
constexpr int L0P = 3584;
constexpr int L1P = 2048;
constexpr int DFF = 2816;
constexpr float ALPHA = 1.4142135623730951f;
typedef unsigned short bf16_t;
typedef float f32x16 __attribute__((ext_vector_type(16)));

constexpr size_t MiB = 1u << 20;
constexpr size_t WS_CTL = 0, CTL_ZERO_BYTES = 1 * MiB;
constexpr int CW_BAR = 4096;
constexpr size_t WS_W0IN = 2 * MiB, WS_W0OUT = 9 * MiB, WS_WUP0 = 11 * MiB, WS_WDN0 = 22 * MiB, WS_W1IN = 28 * MiB, WS_WUQ = 32 * MiB, WS_WUKV = 33 * MiB,
                 WS_W1OUT = 34 * MiB, WS_WUP1 = 36 * MiB, WS_WDN1 = 47 * MiB;
constexpr size_t WS_XB = 56 * MiB, WS_YMIX = 120 * MiB, WS_BIG = 184 * MiB;
constexpr size_t WS_G = 408 * MiB, WS_BONUS = 440 * MiB, WS_DT = 441 * MiB, WS_XST = 442 * MiB, WS_BT = 474 * MiB, WS_ASUM = 490 * MiB;
constexpr size_t WS_SLOC = 120 * MiB;
constexpr size_t WS_W2T = 53 * MiB, WS_A2T = 53 * MiB + 256 * 1024, WS_G2T = 53 * MiB + 512 * 1024;
constexpr size_t WS_GU = 120 * MiB;
constexpr size_t WS_PROJ1 = 184 * MiB, WS_QM = 312 * MiB, WS_KVM = 360 * MiB, WS_KPE = 424 * MiB, WS_RS = 426 * MiB;
constexpr size_t WS_CSTAB = 492 * MiB;
constexpr size_t WS_VTS = 428 * MiB, WS_VTM = 460 * MiB;
constexpr size_t WS_NEED = 497 * MiB;

constexpr int RING_BYTES = 131072;
constexpr int LDSCTL_OFF = 146432, MISC_OFF = LDSCTL_OFF + 320;
constexpr int LDS_BYTES = 147456;

__device__ __forceinline__ float bf2f(bf16_t b) { return __builtin_bit_cast(float, (unsigned)b << 16); }
__device__ __forceinline__ float sigmoidf_(float x) { return 1.f / (1.f + expf(-x)); }
__device__ __forceinline__ float softplusf_(float x) { return fmaxf(x, 0.f) + log1pf(expf(-fabsf(x))); }
__device__ __forceinline__ float siluf_(float x) { return x / (1.f + expf(-x)); }
__device__ __forceinline__ float wave_sum(float v) {
#pragma unroll
    for (int o = 1; o < 64; o <<= 1) v += __shfl_xor(v, o);
    return v;
}
#define WSYNC() asm volatile("s_waitcnt lgkmcnt(0)" ::: "memory")
typedef float f32x2_t __attribute__((ext_vector_type(2)));
typedef __bf16 bf16x2_t __attribute__((ext_vector_type(2)));
typedef unsigned u32x2 __attribute__((ext_vector_type(2)));
__device__ __forceinline__ unsigned cvtpk(float lo, float hi) { f32x2_t v = {lo, hi}; bf16x2_t b = __builtin_convertvector(v, bf16x2_t); return __builtin_bit_cast(unsigned, b); }
__device__ __forceinline__ float bflo(unsigned u) { return __builtin_bit_cast(float, u << 16); }
__device__ __forceinline__ float bfhi(unsigned u) { return __builtin_bit_cast(float, u & 0xffff0000u); }
__device__ __forceinline__ bf16_t bf1(float x) { return (bf16_t)(cvtpk(x, x) & 0xffffu); }
__device__ __forceinline__ bf16x8 pack8(float a0, float a1, float a2, float a3, float a4, float a5, float a6, float a7) {
    v4u w; w.x = cvtpk(a0, a1); w.y = cvtpk(a2, a3); w.z = cvtpk(a4, a5); w.w = cvtpk(a6, a7); return __builtin_bit_cast(bf16x8, w); }
template <int CTRL> __device__ __forceinline__ float dpp_mov(float x) { return __builtin_bit_cast(float, __builtin_amdgcn_update_dpp(0, __builtin_bit_cast(int, x), CTRL, 0xF, 0xF, true)); }
__device__ __forceinline__ float rowsum16(float x) { x += dpp_mov<0x128>(x); x += dpp_mov<0x124>(x); x += dpp_mov<0x122>(x); x += dpp_mov<0x121>(x); return x; }
__device__ __forceinline__ float rl(float x, int l) { return __builtin_bit_cast(float, __builtin_amdgcn_readlane(__builtin_bit_cast(int, x), l)); }
__device__ __forceinline__ float wave_sum_dpp(float x) { x = rowsum16(x); return (rl(x, 0) + rl(x, 16)) + (rl(x, 32) + rl(x, 48)); }

__device__ __forceinline__ void transpose_matrix(const float* __restrict__ W, int K, int N, bf16_t* __restrict__ WT, int Npad, int ldt, LAS float* scr, int gw, int NGW, int lane, const float* __restrict__ kscale, int& tr_base, bool ffn_interleave = false) {
    (void)scr;
    const int nblk = Npad / 64, nit = (K / 64) * nblk;
    int it0 = gw - (tr_base % NGW); if (it0 < 0) it0 += NGW; tr_base += nit;
    for (int it = it0; it < nit; it += NGW) {
        const int kb = it / nblk, nb = it - kb * nblk, n = nb * 64 + lane, k0 = kb * 64;
        const bool ok = n < N; const float* src = W + (size_t)k0 * N + (ok ? n : 0);
#pragma unroll
        for (int hc = 0; hc < 2; ++hc) {
            float v[32];
#pragma unroll
            for (int i = 0; i < 32; ++i) v[i] = src[(size_t)(hc * 32 + i) * N];
#pragma unroll
            for (int c = 0; c < 4; ++c) { float u[8];
#pragma unroll
                for (int i = 0; i < 8; ++i) { u[i] = ok ? v[c * 8 + i] : 0.f; if (kscale) u[i] *= kscale[k0 + hc * 32 + c * 8 + i]; }
                v4u o; o.x = cvtpk(u[0], u[1]); o.y = cvtpk(u[2], u[3]); o.z = cvtpk(u[4], u[5]); o.w = cvtpk(u[6], u[7]);
                const int nr = ffn_interleave ? ((n < DFF) ? 256 * (n >> 7) + (n & 127) : 256 * ((n - DFF) >> 7) + 128 + ((n - DFF) & 127)) : n;
                *(v4u*)(WT + (size_t)nr * ldt + k0 + hc * 32 + c * 8) = o; }
        }
    }
}

template <int MODE> __device__ __forceinline__ void ln_rows(float* h, bf16_t* hb, float* stats, const float* __restrict__ g, const float* __restrict__ b, int gw, int NGW, int lane) {
    for (int row = gw * 2; row < M; row += NGW * 2) {
        float* p = h + (size_t)row * DM;
        f32x4 v[2][4]; float s[2] = {0.f, 0.f};
#pragma unroll
        for (int r = 0; r < 2; ++r)
#pragma unroll
            for (int j = 0; j < 4; ++j) v[r][j] = *(const f32x4*)(p + r * DM + 4 * lane + 256 * j);
#pragma unroll
        for (int r = 0; r < 2; ++r)
#pragma unroll
            for (int j = 0; j < 4; ++j) s[r] += (v[r][j][0] + v[r][j][1]) + (v[r][j][2] + v[r][j][3]);
        float mean[2], q[2] = {0.f, 0.f}, rstd[2];
#pragma unroll
        for (int r = 0; r < 2; ++r) { mean[r] = wave_sum_dpp(s[r]) * (1.f / DM);
#pragma unroll
            for (int j = 0; j < 4; ++j) { v[r][j] = v[r][j] - mean[r]; q[r] += (v[r][j][0] * v[r][j][0] + v[r][j][1] * v[r][j][1]) + (v[r][j][2] * v[r][j][2] + v[r][j][3] * v[r][j][3]); } }
#pragma unroll
        for (int r = 0; r < 2; ++r) rstd[r] = 1.0f / sqrtf(wave_sum_dpp(q[r]) * (1.f / DM) + 1e-5f);
        if (MODE == 1 && lane < 2) { stats[2 * (row + lane)] = lane ? mean[1] : mean[0]; stats[2 * (row + lane) + 1] = lane ? rstd[1] : rstd[0]; }
#pragma unroll
        for (int j = 0; j < 4; ++j) {
            const int c = 4 * lane + 256 * j;
            const f32x4 gg = *(const f32x4*)(g + c), bb = *(const f32x4*)(b + c);
#pragma unroll
            for (int r = 0; r < 2; ++r) {
                const f32x4 o = v[r][j] * rstd[r] * gg + bb;
                if (MODE == 1) { uint2 w; w.x = cvtpk(o[0], o[1]); w.y = cvtpk(o[2], o[3]); *(uint2*)(hb + (size_t)(row + r) * DM + c) = w; }
                else *(f32x4*)(p + r * DM + c) = o;
            }
        }
    }
}

__device__ __forceinline__ void rwkv_naive_chain(int chain, int lane, LAS float* sm, const bf16_t* __restrict__ proj, const float* __restrict__ mix, const float* __restrict__ w0, const float* __restrict__ w2,
                                                 const float* __restrict__ a0, const float* __restrict__ a2, const float* __restrict__ g2, const float* __restrict__ k_k,
                                                 const float* __restrict__ k_a, const float* __restrict__ r_k, const float* __restrict__ ln_g, const float* __restrict__ ln_b, bf16_t* __restrict__ ymix) {
    LAS float* s_w2 = sm; LAS float* s_a2 = sm + 4096; LAS float* s_g2 = sm + 8192; LAS float* s_tw = sm + 16384; LAS float* s_al = s_tw + 64; LAS float* s_sg = s_tw + 128;
    LAS float* s_w = s_tw + 256; LAS float* s_k = s_tw + 320; LAS float* s_a = s_tw + 384; LAS float* s_b = s_tw + 448; LAS float* s_r = s_tw + 512;
    const int b = chain >> 3, h = chain & 7, c = h * 64 + lane;
    for (int l = 0; l < 64; ++l) { s_w2[l * 64 + lane] = w2[l * 512 + c]; s_a2[l * 64 + lane] = a2[l * 512 + c]; }
    for (int l = 0; l < 128; ++l) s_g2[l * 64 + lane] = g2[l * 512 + c];
    const float mr = mix[c], mk = mix[512 + c], mv = mix[1024 + c], mw = mix[1536 + lane], ma = mix[1600 + lane], mg0 = mix[1664 + lane], mg1 = mix[1728 + lane];
    const float w0c = w0[c], a0c = a0[c], kkc = k_k[c], kac = k_a[c], rkc = r_k[c], lgc = ln_g[c], lbc = ln_b[c];
    float S[64];
#pragma unroll
    for (int j = 0; j < 64; ++j) S[j] = 0.f;
    float pr = 0.f, pk = 0.f, pv = 0.f, pw = 0.f, pa = 0.f, pg0 = 0.f, pg1 = 0.f;
    WSYNC();
    for (int t = 0; t < SEQ; ++t) {
        const bf16_t* row = proj + (size_t)(b * SEQ + t) * L0P;
        const float cr = bf2f(row[c]), ck = bf2f(row[512 + c]), cv = bf2f(row[1024 + c]), cw = bf2f(row[1536 + lane]), ca = bf2f(row[1600 + lane]),
                    cg0 = bf2f(row[1664 + lane]), cg1 = bf2f(row[1728 + lane]);
        const float r_s = cr + (pr - cr) * mr, k_s = ck + (pk - ck) * mk, v_s = cv + (pv - cv) * mv;
        const float wl = cw + (pw - cw) * mw, al = ca + (pa - ca) * ma, g0 = cg0 + (pg0 - cg0) * mg0, g1 = cg1 + (pg1 - cg1) * mg1;
        pr = cr; pk = ck; pv = cv; pw = cw; pa = ca; pg0 = cg0; pg1 = cg1;
        s_tw[lane] = tanhf(wl); s_al[lane] = al; s_sg[lane] = sigmoidf_(g0); s_sg[64 + lane] = sigmoidf_(g1);
        WSYNC();
        float wsum = w0c, asum = a0c, gsum = 0.f;
#pragma unroll 2
        for (int l = 0; l < 64; ++l) { wsum += s_tw[l] * s_w2[l * 64 + lane]; asum += s_al[l] * s_a2[l * 64 + lane]; }
#pragma unroll 2
        for (int l = 0; l < 128; ++l) gsum += s_sg[l] * s_g2[l * 64 + lane];
        const float log_w = -softplusf_(-wsum) - 0.5f;
        const float dec = expf(-expf(log_w));
        const float a = sigmoidf_(asum);
        float kkv = k_s * kkc;
        const float nrm = sqrtf(wave_sum(kkv * kkv));
        kkv = kkv / fmaxf(nrm, 1e-12f);
        const float k2 = k_s * (1.f + (a - 1.f) * kac);
        const float bonus_s = wave_sum(r_s * k2 * rkc);
        s_w[lane] = dec; s_k[lane] = k2; s_a[lane] = -kkv; s_b[lane] = kkv * a; s_r[lane] = r_s;
        WSYNC();
        float sa = 0.f;
#pragma unroll
        for (int j = 0; j < 64; ++j) sa += S[j] * s_a[j];
        float y = 0.f;
#pragma unroll
        for (int j = 0; j < 64; ++j) { S[j] = S[j] * s_w[j] + sa * s_b[j] + v_s * s_k[j]; y += S[j] * s_r[j]; }
        const float mu = wave_sum(y) * (1.f / 64.f);
        const float d = y - mu;
        const float var = wave_sum(d * d) * (1.f / 64.f);
        const float yn = d * (1.0f / sqrtf(var + 64e-5f)) * lgc + lbc;
        const float o = (yn + bonus_s * v_s) * gsum;
        ymix[(size_t)(b * SEQ + t) * DM + c] = (bf16_t)f2bf(o);
        WSYNC();
    }
}

__device__ __forceinline__ void ssm_conv_all(const bf16_t* __restrict__ proj, const float* __restrict__ cw, const float* __restrict__ cb, const float* __restrict__ dtb,
                                             bf16_t* __restrict__ xbc, float* __restrict__ dt, int gtid, int NT) {
    for (size_t i = gtid; i < (size_t)M * 1024; i += NT) {
        const int m = (int)(i >> 10), c = (int)(i & 1023), t = m & (SEQ - 1);
        float acc = cb[c];
#pragma unroll
        for (int k = 0; k < 4; ++k) { const int tt = t - 3 + k; if (tt >= 0) acc += cw[k * 1024 + c] * bf2f(proj[(size_t)(m - 3 + k) * L0P + 2304 + c]); }
        xbc[i] = (bf16_t)f2bf(siluf_(acc));
    }
    for (int i = gtid; i < M * 8; i += NT) dt[i] = softplusf_(bf2f(proj[(size_t)(i >> 3) * L0P + 3328 + (i & 7)]) + dtb[i & 7]);
}
__device__ __forceinline__ void ssd_naive_task(int task, int lane, const bf16_t* __restrict__ xbc, const float* __restrict__ dt, const float* __restrict__ a_log, const float* __restrict__ dsk, float* __restrict__ yssm) {
    const int chain = task >> 2, q = task & 3, b = chain >> 3, h = chain & 7, g = h >> 2, p = q * 16 + (lane >> 2), nq = lane & 3;
    const float A = -expf(a_log[h]), D = dsk[h];
    float st[32];
#pragma unroll
    for (int n = 0; n < 32; ++n) st[n] = 0.f;
    for (int t = 0; t < SEQ; ++t) {
        const size_t m = (size_t)b * SEQ + t;
        const float dtv = dt[m * 8 + h], dA = expf(dtv * A);
        const float x = bf2f(xbc[m * 1024 + h * 64 + p]), xdt = x * dtv;
        const bf16_t* Bp = xbc + m * 1024 + 512 + g * 128 + nq * 32;
        const bf16_t* Cp = xbc + m * 1024 + 768 + g * 128 + nq * 32;
        float yp = 0.f;
#pragma unroll
        for (int n = 0; n < 32; ++n) { st[n] = st[n] * dA + xdt * bf2f(Bp[n]); yp += st[n] * bf2f(Cp[n]); }
        yp += __shfl_xor(yp, 1); yp += __shfl_xor(yp, 2);
        if (nq == 0) yssm[m * 512 + h * 64 + p] = yp + D * x;
    }
}
template <bool ST = true> __device__ __forceinline__ void ssm_gate_norm_all(const bf16_t* __restrict__ yssm, const bf16_t* __restrict__ proj, const float* __restrict__ ng, bf16_t* __restrict__ ymix, int wv0, int wvend, int lane) {
    for (int wvb = wv0 * 4 - (wv0 & ~7) * 3; wvb < wvend; wvb += NWAVES * 4) {
        float u[4][4], q[4];
#pragma unroll
        for (int k = 0; k < 4; ++k) { const int wv = wvb + k, m = wv >> 1, g = wv & 1; q[k] = 0.f;
#pragma unroll
            for (int j = 0; j < 4; ++j) { const int c = g * 256 + j * 64 + lane; const float z = bf2f(proj[(size_t)m * L0P + 1792 + c]); u[k][j] = bf2f(yssm[(size_t)m * 512 + c]) * (z * __builtin_amdgcn_rcpf(1.f + __expf(-z))); q[k] += u[k][j] * u[k][j]; } }
#pragma unroll
        for (int k = 0; k < 4; ++k) { const int wv = wvb + k, m = wv >> 1, g = wv & 1;
            const float rs = __builtin_amdgcn_rsqf(wave_sum_dpp(q[k]) * (1.f / 256.f) + 1e-5f);
#pragma unroll
            for (int j = 0; j < 4; ++j) { const int c = g * 256 + j * 64 + lane; const float o_ = u[k][j] * rs * ng[c]; if (ST) ymix[(size_t)m * DM + 512 + c] = bf1(o_); else asm volatile("" :: "v"(o_)); } }
    }
}
template <bool ST = true> __device__ __forceinline__ void ffn_act_all(bf16_t* gu, const float* __restrict__ cw, const float* __restrict__ cb, int gtid, int NT) {
    constexpr int NCH = DFF / 8, NSTRIP = M / 32;
    for (int task = gtid; task < NSTRIP * NCH; task += NT) {
        const int strip = task / NCH, q = task - strip * NCH, c0 = q * 8, m0 = strip * 32;
        float w0[8], w1[8], w2[8], bb[8], g2[8], g1[8];
#pragma unroll
        for (int j = 0; j < 8; j += 4) { const f32x4 a = *(const f32x4*)(cw + c0 + j), b = *(const f32x4*)(cw + DFF + c0 + j), c = *(const f32x4*)(cw + 2 * DFF + c0 + j), d = *(const f32x4*)(cb + c0 + j);
#pragma unroll
            for (int k = 0; k < 4; ++k) { w0[j + k] = a[k]; w1[j + k] = b[k]; w2[j + k] = c[k]; bb[j + k] = d[k]; } }
        bf16_t* base = gu + (size_t)m0 * (2 * DFF) + c0;
        if ((m0 & (SEQ - 1)) != 0) { const v4u a = *(const v4u*)(base - 2 * (2 * DFF)), b = *(const v4u*)(base - (2 * DFF));
            g2[0] = bflo(a.x); g2[1] = bfhi(a.x); g2[2] = bflo(a.y); g2[3] = bfhi(a.y); g2[4] = bflo(a.z); g2[5] = bfhi(a.z); g2[6] = bflo(a.w); g2[7] = bfhi(a.w);
            g1[0] = bflo(b.x); g1[1] = bfhi(b.x); g1[2] = bflo(b.y); g1[3] = bfhi(b.y); g1[4] = bflo(b.z); g1[5] = bfhi(b.z); g1[6] = bflo(b.w); g1[7] = bfhi(b.w); }
        else {
#pragma unroll
            for (int j = 0; j < 8; ++j) { g2[j] = 0.f; g1[j] = 0.f; } }
#pragma unroll 4
        for (int r = 0; r < 32; ++r) {
            const v4u gv = *(const v4u*)(base + (size_t)r * (2 * DFF)), uv = *(const v4u*)(base + (size_t)r * (2 * DFF) + DFF);
            const unsigned gw_[4] = {gv.x, gv.y, gv.z, gv.w}, uw_[4] = {uv.x, uv.y, uv.z, uv.w};
            unsigned ow[4];
#pragma unroll
            for (int k = 0; k < 4; ++k) {
                const float ga = bflo(gw_[k]), gb = bfhi(gw_[k]);
                const float ya = bb[2 * k] + w0[2 * k] * g2[2 * k] + w1[2 * k] * g1[2 * k] + w2[2 * k] * ga;
                const float yb = bb[2 * k + 1] + w0[2 * k + 1] * g2[2 * k + 1] + w1[2 * k + 1] * g1[2 * k + 1] + w2[2 * k + 1] * gb;
                g2[2 * k] = g1[2 * k]; g1[2 * k] = ga; g2[2 * k + 1] = g1[2 * k + 1]; g1[2 * k + 1] = gb;
                ow[k] = cvtpk(ya / (1.f + __expf(-ya)) * bflo(uw_[k]), yb / (1.f + __expf(-yb)) * bfhi(uw_[k]));
            }
            if (ST) *(v4u*)(base + (size_t)r * (2 * DFF) + DFF) = (v4u){ow[0], ow[1], ow[2], ow[3]}; else asm volatile("" :: "v"(ow[0]), "v"(ow[1]), "v"(ow[2]), "v"(ow[3]));
        }
    }
}
template <bool ST = true> __device__ __forceinline__ void mla_prep_all(const bf16_t* __restrict__ proj1, const int* __restrict__ pos, float* __restrict__ rs, bf16_t* __restrict__ kpe, float* __restrict__ cstab, int gw, int NGW, int lane) {
    for (int m4 = gw * 4; m4 < M; m4 += NGW * 4) {
        const int mt = m4 + (lane >> 4), fi = lane & 15;
        const double inv = exp2(-(double)(2 * fi) * (13.287712379549449 / 32.0));
        const double ang = (double)pos[mt] * inv;
        const float cs = (float)cos(ang), sn = (float)sin(ang);
        cstab[(size_t)mt * 32 + fi] = cs; cstab[(size_t)mt * 32 + 16 + fi] = sn;
        { const bf16_t* row = proj1 + (size_t)mt * L1P; const float x1 = bf2f(row[1920 + fi]), x2 = bf2f(row[1936 + fi]);
          kpe[(size_t)mt * 32 + fi] = bf1(x1 * cs - x2 * sn); kpe[(size_t)mt * 32 + 16 + fi] = bf1(x2 * cs + x1 * sn); }
        float q[4], k[4];
#pragma unroll
        for (int u = 0; u < 4; ++u) { const bf16_t* row = proj1 + (size_t)(m4 + u) * L1P; q[u] = 0.f; k[u] = 0.f;
#pragma unroll
            for (int j = 0; j < 4; ++j) { const float v = bf2f(row[1536 + j * 64 + lane]); q[u] += v * v; }
#pragma unroll
            for (int j = 0; j < 2; ++j) { const float v = bf2f(row[1792 + j * 64 + lane]); k[u] += v * v; } }
#pragma unroll
        for (int u = 0; u < 4; ++u) { q[u] = wave_sum_dpp(q[u]); k[u] = wave_sum_dpp(k[u]); }
        if (lane < 4) { const float qq = lane == 0 ? q[0] : lane == 1 ? q[1] : lane == 2 ? q[2] : q[3], kk2 = lane == 0 ? k[0] : lane == 1 ? k[1] : lane == 2 ? k[2] : k[3];
            rs[(size_t)(m4 + lane) * 2] = 1.0f / sqrtf(qq * (1.f / 256.f) + 1e-6f); rs[(size_t)(m4 + lane) * 2 + 1] = 1.0f / sqrtf(kk2 * (1.f / 128.f) + 1e-6f); }
    }
}
template <bool ST = true> __device__ __forceinline__ void rope_q_all(bf16_t* qm, const float* __restrict__ cstab, int gtid, int NT) {
    for (int i = gtid; i < M * 16; i += NT) {
        const int m = i >> 4, h = (i >> 1) & 7, k0 = (i & 1) * 8;
        bf16_t* p = qm + (size_t)m * 768 + h * 96 + 64 + k0;
        const v4u a = *(const v4u*)p, b = *(const v4u*)(p + 16);
        const f32x4 c0 = *(const f32x4*)(cstab + (size_t)m * 32 + k0), c1 = *(const f32x4*)(cstab + (size_t)m * 32 + k0 + 4), s0 = *(const f32x4*)(cstab + (size_t)m * 32 + 16 + k0), s1 = *(const f32x4*)(cstab + (size_t)m * 32 + 16 + k0 + 4);
        const unsigned au[4] = {a.x, a.y, a.z, a.w}, bu[4] = {b.x, b.y, b.z, b.w};
        const float cs[8] = {c0[0], c0[1], c0[2], c0[3], c1[0], c1[1], c1[2], c1[3]}, sn[8] = {s0[0], s0[1], s0[2], s0[3], s1[0], s1[1], s1[2], s1[3]};
        unsigned o1[4], o2[4];
#pragma unroll
        for (int q = 0; q < 4; ++q) { const float x1a = bflo(au[q]), x1b = bfhi(au[q]), x2a = bflo(bu[q]), x2b = bfhi(bu[q]);
            o1[q] = cvtpk(x1a * cs[2 * q] - x2a * sn[2 * q], x1b * cs[2 * q + 1] - x2b * sn[2 * q + 1]);
            o2[q] = cvtpk(x2a * cs[2 * q] + x1a * sn[2 * q], x2b * cs[2 * q + 1] + x1b * sn[2 * q + 1]); }
        if (ST) { *(v4u*)p = (v4u){o1[0], o1[1], o1[2], o1[3]}; *(v4u*)(p + 16) = (v4u){o2[0], o2[1], o2[2], o2[3]}; }
    }
}
__device__ __forceinline__ void sb_naive_task(int qblk, int bh, int lane, const bf16_t* __restrict__ proj1, bf16_t* __restrict__ ymix) {
    const int b = bh >> 3, h = bh & 7, t = qblk * 64 + lane;
    const size_t mrow = (size_t)b * SEQ;
    float q[64], o[64];
#pragma unroll
    for (int d = 0; d < 64; ++d) { q[d] = bf2f(proj1[(mrow + t) * L1P + h * 64 + d]) * 0.125f; o[d] = 0.f; }
    float cum = 0.f;
    const int smax = qblk * 64 + 63;
    for (int s = smax - 1; s >= 0; --s) {
        const bf16_t* kr = proj1 + (mrow + s) * L1P + 512 + h * 64;
        const bf16_t* vr = proj1 + (mrow + s) * L1P + 1024 + h * 64;
        float z = 0.f;
#pragma unroll
        for (int d = 0; d < 64; ++d) z += q[d] * bf2f(kr[d]);
        if (s < t) {
            const float lsp = -softplusf_(-z);
            const float lsn = -softplusf_(z);
            const float att = expf(lsp + cum);
            cum += lsn;
#pragma unroll
            for (int d = 0; d < 64; ++d) o[d] += att * bf2f(vr[d]);
        }
    }
#pragma unroll
    for (int d = 0; d < 64; ++d) ymix[(mrow + t) * DM + h * 64 + d] = (bf16_t)f2bf(o[d]);
}
__device__ __forceinline__ void mla_naive_task(int qblk, int bh, int lane, const bf16_t* __restrict__ qm, const bf16_t* __restrict__ kvm, const bf16_t* __restrict__ kpe, bf16_t* __restrict__ ymix) {
    const int b = bh >> 3, h = bh & 7, t = qblk * 64 + lane;
    const size_t mrow = (size_t)b * SEQ;
    const float scale = 0.10206207261596577f;
    float q[96], o[64];
#pragma unroll
    for (int d = 0; d < 96; ++d) q[d] = bf2f(qm[(mrow + t) * 768 + h * 96 + d]) * scale;
#pragma unroll
    for (int d = 0; d < 64; ++d) o[d] = 0.f;
    float mx = -1e30f, l = 0.f;
    const int smax = qblk * 64 + 63;
    for (int s = 0; s <= smax; ++s) {
        const bf16_t* kr = kvm + (mrow + s) * 1024 + h * 128;
        const bf16_t* pr = kpe + (mrow + s) * 32;
        float z = 0.f;
#pragma unroll
        for (int d = 0; d < 64; ++d) z += q[d] * bf2f(kr[d]);
#pragma unroll
        for (int d = 0; d < 32; ++d) z += q[64 + d] * bf2f(pr[d]);
        if (s <= t) {
            const float mn = fmaxf(mx, z), f = expf(mx - mn), pz = expf(z - mn);
            l = l * f + pz; mx = mn;
#pragma unroll
            for (int d = 0; d < 64; ++d) o[d] = o[d] * f + pz * bf2f(kr[64 + d]);
        }
    }
    const float il = 1.f / l;
#pragma unroll
    for (int d = 0; d < 64; ++d) ymix[(mrow + t) * DM + 512 + h * 64 + d] = (bf16_t)f2bf(o[d] * il);
}


__device__ __forceinline__ int crow(int r, int hi) { return (r & 3) + 8 * (r >> 2) + 4 * hi; }
#define MFMA32(a, b, c) __builtin_amdgcn_mfma_f32_32x32x16_bf16((a), (b), (c), 0, 0, 0)
constexpr int STG_PITCH = 72;
__device__ __forceinline__ void transpose_tile64(const bf16_t* __restrict__ src, int sp, bf16_t* __restrict__ dst, int dp, LAS bf16_t* scr, int lane) {
#pragma unroll
    for (int i = 0; i < 8; ++i) { const int row = i * 8 + (lane >> 3), ch = lane & 7; const v4u v = *(const v4u*)(src + (size_t)row * sp + ch * 8); *(LAS v4u*)(scr + row * STG_PITCH + ch * 8) = v; }
    WSYNC();
#pragma unroll
    for (int i = 0; i < 8; ++i) { const int d = i * 8 + (lane >> 3), tc = lane & 7; const LAS bf16_t* p = scr + (tc * 8) * STG_PITCH + d;
        v4u o; o.x = (unsigned)p[0] | ((unsigned)p[STG_PITCH] << 16); o.y = (unsigned)p[2 * STG_PITCH] | ((unsigned)p[3 * STG_PITCH] << 16);
        o.z = (unsigned)p[4 * STG_PITCH] | ((unsigned)p[5 * STG_PITCH] << 16); o.w = (unsigned)p[6 * STG_PITCH] | ((unsigned)p[7 * STG_PITCH] << 16);
        *(v4u*)(dst + (size_t)d * dp + tc * 8) = o; }
    WSYNC();
}
__device__ __forceinline__ void store_OT(const f32x16 (&o)[2], float sc, LAS bf16_t* stg, bf16_t* __restrict__ dst, int lane) {
    const int l31 = lane & 31, hi = lane >> 5;
#pragma unroll
    for (int dt = 0; dt < 2; ++dt)
#pragma unroll
        for (int r = 0; r < 16; ++r) stg[l31 * STG_PITCH + 32 * dt + crow(r, hi)] = bf1(o[dt][r] * sc);
    WSYNC();
#pragma unroll
    for (int i = 0; i < 4; ++i) { const int row = i * 8 + (lane >> 3), ch = lane & 7; const v4u v = *(const LAS v4u*)(stg + row * STG_PITCH + ch * 8); *(v4u*)(dst + (size_t)row * DM + ch * 8) = v; }
    WSYNC();
}
__device__ __forceinline__ float softplus_fast(float z) { return fmaxf(z, 0.f) + __logf(1.f + __expf(-fabsf(z))); }

__device__ __forceinline__ void sb_task(int bh, int qblk, int lane, const bf16_t* __restrict__ P1, const bf16_t* __restrict__ VT, bf16_t* __restrict__ ymix, LAS bf16_t* stg) {
    const int b = bh >> 3, h = bh & 7, l31 = lane & 31, hi = lane >> 5, q0 = qblk * 32, t = q0 + l31;
    const size_t rowb = (size_t)b * SEQ;
    const bf16_t* Qp = P1 + (rowb + q0 + l31) * L1P + h * 64 + 8 * hi;
    bf16x8 qf[4];
#pragma unroll
    for (int kk = 0; kk < 4; ++kk) qf[kk] = *(const bf16x8*)(Qp + 16 * kk);
    const bf16_t* Kp = P1 + (rowb + l31) * L1P + 512 + h * 64 + 8 * hi;
    const bf16_t* Vp = VT + ((size_t)bh * 64 + l31) * SEQ + 4 * hi;
    f32x16 o[2];
#pragma unroll
    for (int r = 0; r < 16; ++r) { o[0][r] = 0.f; o[1][r] = 0.f; }
    float cum = 0.f;
    bf16x8 kf[4]; u32x2 va[2][2][2];
#define SB_LOAD(S0, KF, VA) do { _Pragma("unroll") for (int kk = 0; kk < 4; ++kk) KF[kk] = *(const bf16x8*)(Kp + (size_t)(S0) * L1P + 16 * kk); \
        _Pragma("unroll") for (int dt = 0; dt < 2; ++dt) _Pragma("unroll") for (int ks = 0; ks < 2; ++ks) { VA[dt][ks][0] = *(const u32x2*)(Vp + (size_t)dt * 32 * SEQ + (S0) + 16 * ks); VA[dt][ks][1] = *(const u32x2*)(Vp + (size_t)dt * 32 * SEQ + (S0) + 16 * ks + 8); } } while (0)
    SB_LOAD(q0, kf, va);
    for (int s0 = q0; s0 >= 0; s0 -= 32) {
        bf16x8 kn[4]; u32x2 vn[2][2][2];
        const int sn = (s0 >= 32) ? s0 - 32 : 0;
        SB_LOAD(sn, kn, vn);
        f32x16 acc;
#pragma unroll
        for (int r = 0; r < 16; ++r) acc[r] = 0.f;
#pragma unroll
        for (int kk = 0; kk < 4; ++kk) acc = MFMA32(kf[kk], qf[kk], acc);
        const bool diag = (s0 == q0);
        float lb[16], lk[16];
#pragma unroll
        for (int r = 0; r < 16; ++r) { const float z = acc[r] * 0.125f; const float sp = softplus_fast(z); float b_ = z - sp, k_ = -sp;
            if (diag) { const bool valid = (s0 + crow(r, hi)) < t; b_ = valid ? b_ : -1e30f; k_ = valid ? k_ : 0.f; }
            lb[r] = b_; lk[r] = k_; }
        float e[16], T[4], U[4];
#pragma unroll
        for (int i = 0; i < 4; ++i) { e[4 * i + 3] = 0.f; e[4 * i + 2] = lk[4 * i + 3]; e[4 * i + 1] = e[4 * i + 2] + lk[4 * i + 2]; e[4 * i] = e[4 * i + 1] + lk[4 * i + 1]; T[i] = e[4 * i] + lk[4 * i]; }
#pragma unroll
        for (int i = 0; i < 4; ++i) U[i] = __shfl_xor(T[i], 32);
        float off[4];
        { const float st2 = T[3], st1 = st2 + T[2], st0 = st1 + T[1]; const float su2 = U[3], su1 = su2 + U[2], su0 = su1 + U[1];
          const float x0 = hi ? 0.f : U[0], x1 = hi ? 0.f : U[1], x2 = hi ? 0.f : U[2], x3 = hi ? 0.f : U[3];
          off[3] = x3; off[2] = st2 + su2 + x2; off[1] = st1 + su1 + x1; off[0] = st0 + su0 + x0;
          const float total = st0 + T[0] + su0 + U[0];
#pragma unroll
          for (int r = 0; r < 16; ++r) acc[r] = __expf(lb[r] + (cum + off[r >> 2] + e[r]));
          cum += total; }
        bf16x8 pf[2];
#pragma unroll
        for (int ks = 0; ks < 2; ++ks) { v4u w; w.x = cvtpk(acc[8 * ks], acc[8 * ks + 1]); w.y = cvtpk(acc[8 * ks + 2], acc[8 * ks + 3]); w.z = cvtpk(acc[8 * ks + 4], acc[8 * ks + 5]); w.w = cvtpk(acc[8 * ks + 6], acc[8 * ks + 7]); pf[ks] = __builtin_bit_cast(bf16x8, w); }
#pragma unroll
        for (int dt = 0; dt < 2; ++dt)
#pragma unroll
            for (int ks = 0; ks < 2; ++ks) { v4u a; a.x = va[dt][ks][0].x; a.y = va[dt][ks][0].y; a.z = va[dt][ks][1].x; a.w = va[dt][ks][1].y; o[dt] = MFMA32(__builtin_bit_cast(bf16x8, a), pf[ks], o[dt]); }
        if (__all(cum < -110.f)) break;
#pragma unroll
        for (int kk = 0; kk < 4; ++kk) kf[kk] = kn[kk];
#pragma unroll
        for (int dt = 0; dt < 2; ++dt)
#pragma unroll
            for (int ks = 0; ks < 2; ++ks) { va[dt][ks][0] = vn[dt][ks][0]; va[dt][ks][1] = vn[dt][ks][1]; }
    }
#undef SB_LOAD
    store_OT(o, 1.0f, stg, ymix + (rowb + q0) * DM + h * 64, lane);
}
__device__ __forceinline__ void mla_task(int bh, int qblk, int lane, const bf16_t* __restrict__ QM, const bf16_t* __restrict__ KVM, const bf16_t* __restrict__ KPE, const bf16_t* __restrict__ VT,
                                         bf16_t* __restrict__ ymix, LAS bf16_t* stg) {
    const int b = bh >> 3, h = bh & 7, l31 = lane & 31, hi = lane >> 5, q0 = qblk * 32, t = q0 + l31;
    const size_t rowb = (size_t)b * SEQ;
    const bf16_t* Qp = QM + (rowb + q0 + l31) * 768 + h * 96 + 8 * hi;
    bf16x8 qf[6];
#pragma unroll
    for (int kk = 0; kk < 6; ++kk) qf[kk] = *(const bf16x8*)(Qp + 16 * kk);
    const bf16_t* Kn = KVM + (rowb + l31) * 1024 + h * 128 + 8 * hi;
    const bf16_t* Kr = KPE + (rowb + l31) * 32 + 8 * hi;
    const bf16_t* Vp = VT + ((size_t)bh * 64 + l31) * SEQ + 4 * hi;
    const float sc2 = 0.10206207261596577f * 1.4426950408889634f;
    f32x16 o[2];
#pragma unroll
    for (int r = 0; r < 16; ++r) { o[0][r] = 0.f; o[1][r] = 0.f; }
    float mrun = -1e30f, lsum = 0.f;
    bf16x8 kf[6]; u32x2 va[2][2][2];
#define ML_LOAD(S0, KF, VA) do { _Pragma("unroll") for (int kk = 0; kk < 4; ++kk) KF[kk] = *(const bf16x8*)(Kn + (size_t)(S0) * 1024 + 16 * kk); \
        _Pragma("unroll") for (int kk = 0; kk < 2; ++kk) KF[4 + kk] = *(const bf16x8*)(Kr + (size_t)(S0) * 32 + 16 * kk); \
        _Pragma("unroll") for (int dt = 0; dt < 2; ++dt) _Pragma("unroll") for (int ks = 0; ks < 2; ++ks) { VA[dt][ks][0] = *(const u32x2*)(Vp + (size_t)dt * 32 * SEQ + (S0) + 16 * ks); VA[dt][ks][1] = *(const u32x2*)(Vp + (size_t)dt * 32 * SEQ + (S0) + 16 * ks + 8); } } while (0)
    ML_LOAD(0, kf, va);
    for (int s0 = 0; s0 <= q0; s0 += 32) {
        bf16x8 kn[6]; u32x2 vn[2][2][2];
        const int sn = (s0 + 32 <= q0) ? s0 + 32 : s0;
        ML_LOAD(sn, kn, vn);
        f32x16 acc;
#pragma unroll
        for (int r = 0; r < 16; ++r) acc[r] = 0.f;
#pragma unroll
        for (int kk = 0; kk < 6; ++kk) acc = MFMA32(kf[kk], qf[kk], acc);
        const bool diag = (s0 == q0);
        float tmax = -1e30f;
#pragma unroll
        for (int r = 0; r < 16; ++r) { float z = acc[r] * sc2; if (diag && (s0 + crow(r, hi)) > t) z = -1e30f; acc[r] = z; tmax = fmaxf(tmax, z); }
        tmax = fmaxf(tmax, __shfl_xor(tmax, 32));
        const float mn = fmaxf(mrun, tmax), alpha = exp2f(mrun - mn); mrun = mn;
        float ps = 0.f;
#pragma unroll
        for (int r = 0; r < 16; ++r) { acc[r] = exp2f(acc[r] - mn); ps += acc[r]; }
        lsum = lsum * alpha + ps;
#pragma unroll
        for (int r = 0; r < 16; ++r) { o[0][r] *= alpha; o[1][r] *= alpha; }
        bf16x8 pf[2];
#pragma unroll
        for (int ks = 0; ks < 2; ++ks) { v4u w; w.x = cvtpk(acc[8 * ks], acc[8 * ks + 1]); w.y = cvtpk(acc[8 * ks + 2], acc[8 * ks + 3]); w.z = cvtpk(acc[8 * ks + 4], acc[8 * ks + 5]); w.w = cvtpk(acc[8 * ks + 6], acc[8 * ks + 7]); pf[ks] = __builtin_bit_cast(bf16x8, w); }
#pragma unroll
        for (int dt = 0; dt < 2; ++dt)
#pragma unroll
            for (int ks = 0; ks < 2; ++ks) { v4u a; a.x = va[dt][ks][0].x; a.y = va[dt][ks][0].y; a.z = va[dt][ks][1].x; a.w = va[dt][ks][1].y; o[dt] = MFMA32(__builtin_bit_cast(bf16x8, a), pf[ks], o[dt]); }
#pragma unroll
        for (int kk = 0; kk < 6; ++kk) kf[kk] = kn[kk];
#pragma unroll
        for (int dt = 0; dt < 2; ++dt)
#pragma unroll
            for (int ks = 0; ks < 2; ++ks) { va[dt][ks][0] = vn[dt][ks][0]; va[dt][ks][1] = vn[dt][ks][1]; }
    }
#undef ML_LOAD
    lsum += __shfl_xor(lsum, 32);
    store_OT(o, 1.0f / lsum, stg, ymix + (rowb + q0) * DM + 512 + h * 64, lane);
}


__device__ __forceinline__ void sb_wave(int bh, int qblk, int lane, const bf16_t* __restrict__ P1, const bf16_t* __restrict__ VT, bf16_t* __restrict__ ymix, LAS unsigned char* wl) {
    const int b = bh >> 3, h = bh & 7, l31 = lane & 31, hi = lane >> 5, q0 = qblk * 32, t = q0 + l31;
    const size_t rowb = (size_t)b * SEQ;
    bf16x8 qf[4];
    { const bf16_t* Qp = P1 + (rowb + q0 + l31) * L1P + h * 64 + 8 * hi;
#pragma unroll
      for (int kk = 0; kk < 4; ++kk) qf[kk] = *(const bf16x8*)(Qp + 16 * kk); }
    f32x16 o[2];
#pragma unroll
    for (int r = 0; r < 16; ++r) { o[0][r] = 0.f; o[1][r] = 0.f; }
    float cum = 1.f;
    const bf16_t* gK = P1 + (rowb + (lane >> 3)) * L1P + 512 + h * 64 + (lane & 7) * 8;
    const bf16_t* gV = VT + ((size_t)bh * 64 + (lane >> 2)) * SEQ + (lane & 3) * 8;
    const int lK = (lane >> 3) * 144 + (lane & 7) * 16, lV = 4608 + (lane >> 2) * 72 + (lane & 3) * 16;
    v4u rk[4], rv[4];
#pragma unroll
    for (int i = 0; i < 4; ++i) { rk[i] = *(const v4u*)(gK + (size_t)(q0 + 8 * i) * L1P); rv[i] = *(const v4u*)(gV + (size_t)(16 * i) * SEQ + q0); }
#pragma unroll 1
    for (int s0 = q0; s0 >= 0; s0 -= 32) {
#pragma unroll
        for (int i = 0; i < 4; ++i) { *(LAS v4u*)(wl + lK + i * 8 * 144) = rk[i]; *(LAS u32x2*)(wl + lV + i * 16 * 72) = (u32x2){rv[i].x, rv[i].y}; *(LAS u32x2*)(wl + lV + i * 16 * 72 + 8) = (u32x2){rv[i].z, rv[i].w}; }
        { const int sn = (s0 >= 32) ? s0 - 32 : 0;
#pragma unroll
          for (int i = 0; i < 4; ++i) { rk[i] = *(const v4u*)(gK + (size_t)(sn + 8 * i) * L1P); rv[i] = *(const v4u*)(gV + (size_t)(16 * i) * SEQ + sn); } }
        WSYNC();
        f32x16 acc;
#pragma unroll
        for (int r = 0; r < 16; ++r) acc[r] = 0.f;
#pragma unroll
        for (int kk = 0; kk < 4; ++kk) { const bf16x8 kf = *(const LAS bf16x8*)(wl + l31 * 144 + (16 * kk + 8 * hi) * 2); acc = MFMA32(kf, qf[kk], acc); }
        const bool diag = (s0 == q0);
        float bt[16], kp[16];
#pragma unroll
        for (int r = 0; r < 16; ++r) { const float ee = __builtin_amdgcn_exp2f(fminf(acc[r] * (-0.125f * 1.4426950408889634f), 100.f)); const float ri = __builtin_amdgcn_rcpf(1.f + ee);
            float b_ = ri, k_ = ee * ri;
            if (diag) { const bool valid = (s0 + crow(r, hi)) < t; b_ = valid ? b_ : 0.f; k_ = valid ? k_ : 1.f; }
            bt[r] = b_; kp[r] = k_; }
        float e[16], T[4], U[4];
#pragma unroll
        for (int q = 0; q < 4; ++q) { e[4 * q + 3] = 1.f; e[4 * q + 2] = kp[4 * q + 3]; e[4 * q + 1] = e[4 * q + 2] * kp[4 * q + 2]; e[4 * q] = e[4 * q + 1] * kp[4 * q + 1]; T[q] = e[4 * q] * kp[4 * q]; }
#pragma unroll
        for (int q = 0; q < 4; ++q) U[q] = __shfl_xor(T[q], 32);
        { const float st2 = T[3], st1 = st2 * T[2], st0 = st1 * T[1]; const float su2 = U[3], su1 = su2 * U[2], su0 = su1 * U[1];
          const float x0 = hi ? 1.f : U[0], x1 = hi ? 1.f : U[1], x2 = hi ? 1.f : U[2], x3 = hi ? 1.f : U[3];
          const float off[4] = {cum * (st0 * su0 * x0), cum * (st1 * su1 * x1), cum * (st2 * su2 * x2), cum * x3};
#pragma unroll
          for (int r = 0; r < 16; ++r) acc[r] = bt[r] * (off[r >> 2] * e[r]);
          cum *= (st0 * T[0]) * (su0 * U[0]); }
        bf16x8 pf[2];
#pragma unroll
        for (int ks = 0; ks < 2; ++ks) pf[ks] = pack8(acc[8 * ks], acc[8 * ks + 1], acc[8 * ks + 2], acc[8 * ks + 3], acc[8 * ks + 4], acc[8 * ks + 5], acc[8 * ks + 6], acc[8 * ks + 7]);
#pragma unroll
        for (int dt = 0; dt < 2; ++dt)
#pragma unroll
            for (int ks = 0; ks < 2; ++ks) { const LAS unsigned char* vp = wl + 4608 + (32 * dt + l31) * 72 + (16 * ks + 4 * hi) * 2;
                const u32x2 x0 = *(const LAS u32x2*)vp, x1 = *(const LAS u32x2*)(vp + 16);
                v4u a; a.x = x0.x; a.y = x0.y; a.z = x1.x; a.w = x1.y; o[dt] = MFMA32(__builtin_bit_cast(bf16x8, a), pf[ks], o[dt]); }
        WSYNC();
        if (__all(cum < 1e-35f)) break;
    }
    store_OT(o, 1.0f, (LAS bf16_t*)(wl + 9216), ymix + (rowb + q0) * DM + h * 64, lane);
}

constexpr int MLK_PITCH = 104, MLV_PITCH = 68, MLK_BYTES = 64 * MLK_PITCH * 2, MLV_BYTES = 64 * MLV_PITCH * 2, ML_STAGE = MLK_BYTES + MLV_BYTES;
__device__ __forceinline__ void mla_block(int bh, int sb, int tid, int lane, int wave, LAS unsigned char* lds, const bf16_t* __restrict__ QM, const bf16_t* __restrict__ KVM, const bf16_t* __restrict__ KPE,
                                          const bf16_t* __restrict__ VT, bf16_t* __restrict__ ymix) {
    const int b = bh >> 3, h = bh & 7, l31 = lane & 31, hi = lane >> 5, q0 = 256 * sb + 32 * wave, t = q0 + l31;
    const size_t rowb = (size_t)b * SEQ;
    const int nsteps = 4 * sb + 4;
    bf16x8 qf[6];
    { const bf16_t* Qp = QM + (rowb + q0 + l31) * 768 + h * 96 + 8 * hi;
#pragma unroll
      for (int kk = 0; kk < 6; ++kk) qf[kk] = *(const bf16x8*)(Qp + 16 * kk); }
    const float sc2 = 0.10206207261596577f * 1.4426950408889634f;
    f32x16 o[2];
#pragma unroll
    for (int r = 0; r < 16; ++r) { o[0][r] = 0.f; o[1][r] = 0.f; }
    float mrun = -1e30f, lsum = 0.f;
    const bf16_t* gKn = KVM + (rowb + (tid >> 3)) * 1024 + h * 128 + (tid & 7) * 8;
    const bf16_t* gKr = KPE + (rowb + ((tid & 255) >> 2)) * 32 + (tid & 3) * 8;
    const bf16_t* gVt = VT + ((size_t)bh * 64 + (tid >> 3)) * SEQ + (tid & 7) * 8;
    const int lKn = (tid >> 3) * (MLK_PITCH * 2) + (tid & 7) * 16, lKr = ((tid & 255) >> 2) * (MLK_PITCH * 2) + 128 + (tid & 3) * 16, lVt = MLK_BYTES + (tid >> 3) * (MLV_PITCH * 2) + (tid & 7) * 16;
    v4u rk, rr, rv;
    rk = *(const v4u*)gKn; rr = *(const v4u*)gKr; rv = *(const v4u*)gVt;
    *(LAS v4u*)(lds + lKn) = rk; if (tid < 256) *(LAS v4u*)(lds + lKr) = rr; *(LAS u32x2*)(lds + lVt) = (u32x2){rv.x, rv.y}; *(LAS u32x2*)(lds + lVt + 8) = (u32x2){rv.z, rv.w};
    __syncthreads();
#pragma unroll 1
    for (int step = 0; step < nsteps; ++step) {
        const int nx = (step + 1 < nsteps) ? step + 1 : step;
        rk = *(const v4u*)(gKn + (size_t)nx * 64 * 1024); rr = *(const v4u*)(gKr + (size_t)nx * 64 * 32); rv = *(const v4u*)(gVt + nx * 64);
        const LAS unsigned char* Kb = lds + (step & 1) * ML_STAGE;
        const LAS unsigned char* Vb = Kb + MLK_BYTES;
        if (64 * step <= q0) {
            f32x16 acc[2];
#pragma unroll
            for (int sub = 0; sub < 2; ++sub) {
#pragma unroll
                for (int r = 0; r < 16; ++r) acc[sub][r] = 0.f;
#pragma unroll
                for (int kk = 0; kk < 6; ++kk) { const bf16x8 kf = *(const LAS bf16x8*)(Kb + (32 * sub + l31) * (MLK_PITCH * 2) + (16 * kk + 8 * hi) * 2); acc[sub] = MFMA32(kf, qf[kk], acc[sub]); }
            }
            float tmax = -1e30f;
#pragma unroll
            for (int sub = 0; sub < 2; ++sub) { const int s0 = 64 * step + 32 * sub;
                if (s0 + 31 > q0) {
#pragma unroll
                    for (int r = 0; r < 16; ++r) if ((s0 + crow(r, hi)) > t) acc[sub][r] = -1e30f; }
#pragma unroll
                for (int r = 0; r < 16; ++r) tmax = fmaxf(tmax, acc[sub][r]); }
            tmax = fmaxf(tmax, __shfl_xor(tmax, 32)) * sc2;
            if (__any(tmax - mrun > 6.f)) {
                const float mn = fmaxf(mrun, tmax), alpha = __builtin_amdgcn_exp2f(mrun - mn); mrun = mn; lsum *= alpha;
#pragma unroll
                for (int r = 0; r < 16; ++r) { o[0][r] *= alpha; o[1][r] *= alpha; }
            }
            float ps = 0.f;
#pragma unroll
            for (int sub = 0; sub < 2; ++sub)
#pragma unroll
                for (int r = 0; r < 16; ++r) { acc[sub][r] = __builtin_amdgcn_exp2f(acc[sub][r] * sc2 - mrun); ps += acc[sub][r]; }
            lsum += ps;
#pragma unroll
            for (int sub = 0; sub < 2; ++sub) {
                bf16x8 pf[2];
#pragma unroll
                for (int ks = 0; ks < 2; ++ks) pf[ks] = pack8(acc[sub][8 * ks], acc[sub][8 * ks + 1], acc[sub][8 * ks + 2], acc[sub][8 * ks + 3], acc[sub][8 * ks + 4], acc[sub][8 * ks + 5], acc[sub][8 * ks + 6], acc[sub][8 * ks + 7]);
#pragma unroll
                for (int dt = 0; dt < 2; ++dt)
#pragma unroll
                    for (int ks = 0; ks < 2; ++ks) { const LAS unsigned char* vp = Vb + (32 * dt + l31) * (MLV_PITCH * 2) + (32 * sub + 16 * ks + 4 * hi) * 2;
                        const u32x2 x0 = *(const LAS u32x2*)vp, x1 = *(const LAS u32x2*)(vp + 16);
                        v4u a; a.x = x0.x; a.y = x0.y; a.z = x1.x; a.w = x1.y; o[dt] = MFMA32(__builtin_bit_cast(bf16x8, a), pf[ks], o[dt]); }
            }
        }
        LAS unsigned char* nb = lds + ((step + 1) & 1) * ML_STAGE;
        *(LAS v4u*)(nb + lKn) = rk; if (tid < 256) *(LAS v4u*)(nb + lKr) = rr; *(LAS u32x2*)(nb + lVt) = (u32x2){rv.x, rv.y}; *(LAS u32x2*)(nb + lVt + 8) = (u32x2){rv.z, rv.w};
        __syncthreads();
    }
    lsum += __shfl_xor(lsum, 32);
    store_OT(o, 1.0f / lsum, (LAS bf16_t*)(lds + 2 * ML_STAGE) + wave * (32 * STG_PITCH), ymix + (rowb + q0) * DM + 512 + h * 64, lane);
    __syncthreads();
}


constexpr int SBK_PITCH = 72, SBK_BYTES = 64 * SBK_PITCH * 2, SB_STAGE = SBK_BYTES + MLV_BYTES;
__device__ __forceinline__ void sb_block(int bh, int sb, int tid, int lane, int wave, LAS unsigned char* lds, const bf16_t* __restrict__ P1, const bf16_t* __restrict__ VT, bf16_t* __restrict__ ymix) {
    const int b = bh >> 3, h = bh & 7, l31 = lane & 31, hi = lane >> 5, q0 = 256 * sb + 32 * wave, t = q0 + l31;
    const size_t rowb = (size_t)b * SEQ;
    bf16x8 qf[4];
    { const bf16_t* Qp = P1 + (rowb + q0 + l31) * L1P + h * 64 + 8 * hi;
#pragma unroll
      for (int kk = 0; kk < 4; ++kk) qf[kk] = *(const bf16x8*)(Qp + 16 * kk); }
    f32x16 o[2];
#pragma unroll
    for (int r = 0; r < 16; ++r) { o[0][r] = 0.f; o[1][r] = 0.f; }
    float cum = 1.f; bool done = false;
    volatile LAS unsigned* flags = (volatile LAS unsigned*)(lds + 2 * SB_STAGE);
    const bf16_t* gK = P1 + (rowb + (tid >> 3)) * L1P + 512 + h * 64 + (tid & 7) * 8;
    const bf16_t* gVt = VT + ((size_t)bh * 64 + (tid >> 3)) * SEQ + (tid & 7) * 8;
    const int lK = (tid >> 3) * (SBK_PITCH * 2) + (tid & 7) * 16, lVt = SBK_BYTES + (tid >> 3) * (MLV_PITCH * 2) + (tid & 7) * 16;
    const int top = 4 * sb + 3;
    v4u rk, rv;
    rk = *(const v4u*)(gK + (size_t)top * 64 * L1P); rv = *(const v4u*)(gVt + top * 64);
    *(LAS v4u*)(lds + lK) = rk; *(LAS u32x2*)(lds + lVt) = (u32x2){rv.x, rv.y}; *(LAS u32x2*)(lds + lVt + 8) = (u32x2){rv.z, rv.w};
    __syncthreads();
#pragma unroll 1
    for (int i = 0; i <= top; ++i) {
        const int step = top - i, nx = (step > 0) ? step - 1 : 0;
        rk = *(const v4u*)(gK + (size_t)nx * 64 * L1P); rv = *(const v4u*)(gVt + nx * 64);
        const LAS unsigned char* Kb = lds + (i & 1) * SB_STAGE;
        const LAS unsigned char* Vb = Kb + SBK_BYTES;
#pragma unroll
        for (int sub = 1; sub >= 0; --sub) {
            const int s0 = 64 * step + 32 * sub;
            if (s0 <= q0 && !done) {
                f32x16 acc;
#pragma unroll
                for (int r = 0; r < 16; ++r) acc[r] = 0.f;
#pragma unroll
                for (int kk = 0; kk < 4; ++kk) { const bf16x8 kf = *(const LAS bf16x8*)(Kb + (32 * sub + l31) * (SBK_PITCH * 2) + (16 * kk + 8 * hi) * 2); acc = MFMA32(kf, qf[kk], acc); }
                const bool diag = (s0 == q0);
                float bt[16], kp[16];
#pragma unroll
                for (int r = 0; r < 16; ++r) { const float ee = __builtin_amdgcn_exp2f(fminf(acc[r] * (-0.125f * 1.4426950408889634f), 100.f)); const float ri = __builtin_amdgcn_rcpf(1.f + ee);
                    float b_ = ri, k_ = ee * ri;
                    if (diag) { const bool valid = (s0 + crow(r, hi)) < t; b_ = valid ? b_ : 0.f; k_ = valid ? k_ : 1.f; }
                    bt[r] = b_; kp[r] = k_; }
                float e[16], T[4], U[4];
#pragma unroll
                for (int q = 0; q < 4; ++q) { e[4 * q + 3] = 1.f; e[4 * q + 2] = kp[4 * q + 3]; e[4 * q + 1] = e[4 * q + 2] * kp[4 * q + 2]; e[4 * q] = e[4 * q + 1] * kp[4 * q + 1]; T[q] = e[4 * q] * kp[4 * q]; }
#pragma unroll
                for (int q = 0; q < 4; ++q) U[q] = __shfl_xor(T[q], 32);
                { const float st2 = T[3], st1 = st2 * T[2], st0 = st1 * T[1]; const float su2 = U[3], su1 = su2 * U[2], su0 = su1 * U[1];
                  const float x0 = hi ? 1.f : U[0], x1 = hi ? 1.f : U[1], x2 = hi ? 1.f : U[2], x3 = hi ? 1.f : U[3];
                  const float off[4] = {cum * (st0 * su0 * x0), cum * (st1 * su1 * x1), cum * (st2 * su2 * x2), cum * x3};
#pragma unroll
                  for (int r = 0; r < 16; ++r) acc[r] = bt[r] * (off[r >> 2] * e[r]);
                  cum *= (st0 * T[0]) * (su0 * U[0]); }
                bf16x8 pf[2];
#pragma unroll
                for (int ks = 0; ks < 2; ++ks) { v4u w; w.x = cvtpk(acc[8 * ks], acc[8 * ks + 1]); w.y = cvtpk(acc[8 * ks + 2], acc[8 * ks + 3]); w.z = cvtpk(acc[8 * ks + 4], acc[8 * ks + 5]); w.w = cvtpk(acc[8 * ks + 6], acc[8 * ks + 7]); pf[ks] = __builtin_bit_cast(bf16x8, w); }
#pragma unroll
                for (int dt = 0; dt < 2; ++dt)
#pragma unroll
                    for (int ks = 0; ks < 2; ++ks) { const LAS unsigned char* vp = Vb + (32 * dt + l31) * (MLV_PITCH * 2) + (32 * sub + 16 * ks + 4 * hi) * 2;
                        const u32x2 x0 = *(const LAS u32x2*)vp, x1 = *(const LAS u32x2*)(vp + 16);
                        v4u a; a.x = x0.x; a.y = x0.y; a.z = x1.x; a.w = x1.y; o[dt] = MFMA32(__builtin_bit_cast(bf16x8, a), pf[ks], o[dt]); }
                done = __all(cum < 1e-35f);
            }
        }
        if (lane == 0) flags[(i & 1) * 8 + wave] = done ? 1u : 0u;
        LAS unsigned char* nb = lds + ((i + 1) & 1) * SB_STAGE;
        *(LAS v4u*)(nb + lK) = rk; *(LAS u32x2*)(nb + lVt) = (u32x2){rv.x, rv.y}; *(LAS u32x2*)(nb + lVt + 8) = (u32x2){rv.z, rv.w};
        __syncthreads();
        unsigned nd = 0;
#pragma unroll
        for (int w8 = 0; w8 < 8; ++w8) nd += flags[(i & 1) * 8 + w8];
        if (nd == 8u) break;
    }
    store_OT(o, 1.0f, (LAS bf16_t*)(lds + 2 * SB_STAGE + 256) + wave * (32 * STG_PITCH), ymix + (rowb + q0) * DM + h * 64, lane);
    __syncthreads();
}

constexpr int RW_RAWW = 0, RW_RAWA = 2048, RW_RS = 4096, RW_KS = 6144, RW_VS = 8192;
constexpr int RW_CH0 = 10240, RW_CHSZ = 11328;
constexpr int RW_YB = RW_CH0 + 2 * RW_CHSZ;
constexpr int RW_MIX = RW_YB + 1024;
static_assert((RW_MIX + 256) * 4 <= 146432, "rwkv LDS map");
__device__ __forceinline__ float tanh_fast(float x) { return 1.f - 2.f * __builtin_amdgcn_rcpf(1.f + __expf(2.f * x)); }
__device__ __forceinline__ float sigmoid_fast(float x) { return __builtin_amdgcn_rcpf(1.f + __expf(-x)); }

#define MFMA16(a, b, c) __builtin_amdgcn_mfma_f32_16x16x32_bf16((a), (b), (c), 0, 0, 0)
constexpr int RW2_CH0 = 0, RW2_YB = 2 * RW_CHSZ, RW2_MIX = RW2_YB + 1024, RW2_STG = RW2_MIX + 448;
static_assert((RW2_STG + 2 * 3072) * 4 <= 146432, "rwkv LDS map");
__device__ __forceinline__ void rwkv_phase_scan(LAS float* sm, int tid, int lane, int wave, int blk, const bf16_t* __restrict__ proj, const float* __restrict__ mix, const float* __restrict__ w0, const float* __restrict__ a0,
                                           const float* __restrict__ k_k, const float* __restrict__ k_a, const float* __restrict__ r_k, const bf16_t* __restrict__ W2T, const bf16_t* __restrict__ A2T, const bf16_t* __restrict__ G2T,
                                           float* __restrict__ yraw, bf16_t* __restrict__ gout, float* __restrict__ bonus_out) {
    const int chain = blk >> 1, half = blk & 1, b = chain >> 3, h = chain & 7, l15 = lane & 15, kg = lane >> 4;
    const size_t rowb = (size_t)b * SEQ;
    constexpr int NCHUNK = SEQ / 32;
    if (tid < 256) sm[RW2_MIX + tid] = mix[1536 + tid];
    else if (tid < 448) { const int q = tid - 256; sm[RW2_MIX + tid] = mix[512 * (q >> 6) + h * 64 + (q & 63)]; }
    __syncthreads();
#define RW_SH8(CUR, PRV, M0, M1, OUT, PZ) do { const unsigned cu_[4] = {(CUR).x, (CUR).y, (CUR).z, (CUR).w}, pu_[4] = {(PRV).x, (PRV).y, (PRV).z, (PRV).w}; \
        const float mm_[8] = {(M0)[0], (M0)[1], (M0)[2], (M0)[3], (M1)[0], (M1)[1], (M1)[2], (M1)[3]}; \
        _Pragma("unroll") for (int q = 0; q < 4; ++q) { const float c0 = bflo(cu_[q]), c1 = bfhi(cu_[q]), p0 = bflo(pu_[q]) * (PZ), p1 = bfhi(pu_[q]) * (PZ); \
            OUT[2 * q] = c0 + (p0 - c0) * mm_[2 * q]; OUT[2 * q + 1] = c1 + (p1 - c1) * mm_[2 * q + 1]; } } while (0)
    if (wave < 4) {
        const int iA = 8 * wave + kg, iB = iA + 4, jseg = l15;
        float A0 = 0.f, A1 = 0.f, A2 = 0.f, A3 = 0.f, B0 = 0.f, B1 = 0.f, B2 = 0.f, B3 = 0.f;
        __syncthreads();
#pragma unroll 1
        for (int ch = 0; ch < NCHUNK; ++ch) {
            const int t0 = ch * 32;
            const LAS float* CHb = sm + RW2_CH0 + (ch & 1) * RW_CHSZ + 4 * jseg;
            const LAS float* CHv = sm + RW2_CH0 + (ch & 1) * RW_CHSZ + 10240 + iA;
            const LAS float* CHs = sm + RW2_CH0 + (ch & 1) * RW_CHSZ + 11264;
            f32x4 a4 = *(const LAS f32x4*)(CHb + 4096), wr4 = *(const LAS f32x4*)(CHb + 8192), w4 = *(const LAS f32x4*)(CHb), b4 = *(const LAS f32x4*)(CHb + 6144), k4 = *(const LAS f32x4*)(CHb + 2048);
            float vA = CHv[0], vB = CHv[4]; f32x2_t sc = *(const LAS f32x2_t*)(CHs);
#pragma unroll 2
            for (int t = 0; t < 32; ++t) {
                const int tq = (t + 1) & 31;
                const f32x4 a4n = *(const LAS f32x4*)(CHb + 4096 + tq * 64), wr4n = *(const LAS f32x4*)(CHb + 8192 + tq * 64), w4n = *(const LAS f32x4*)(CHb + tq * 64),
                            b4n = *(const LAS f32x4*)(CHb + 6144 + tq * 64), k4n = *(const LAS f32x4*)(CHb + 2048 + tq * 64);
                const float vAn = CHv[tq * 32], vBn = CHv[tq * 32 + 4]; const f32x2_t scn = *(const LAS f32x2_t*)(CHs + 2 * tq);
                float d1A = (A0 * a4[0] + A1 * a4[1]) + (A2 * a4[2] + A3 * a4[3]), d1B = (B0 * a4[0] + B1 * a4[1]) + (B2 * a4[2] + B3 * a4[3]);
                float d2A = (A0 * wr4[0] + A1 * wr4[1]) + (A2 * wr4[2] + A3 * wr4[3]), d2B = (B0 * wr4[0] + B1 * wr4[1]) + (B2 * wr4[2] + B3 * wr4[3]);
                d1A = rowsum16(d1A); d1B = rowsum16(d1B); d2A = rowsum16(d2A); d2B = rowsum16(d2B);
                const float yA = d2A + d1A * sc[0] + vA * sc[1], yB = d2B + d1B * sc[0] + vB * sc[1];
                A0 = A0 * w4[0] + (d1A * b4[0] + vA * k4[0]); A1 = A1 * w4[1] + (d1A * b4[1] + vA * k4[1]); A2 = A2 * w4[2] + (d1A * b4[2] + vA * k4[2]); A3 = A3 * w4[3] + (d1A * b4[3] + vA * k4[3]);
                B0 = B0 * w4[0] + (d1B * b4[0] + vB * k4[0]); B1 = B1 * w4[1] + (d1B * b4[1] + vB * k4[1]); B2 = B2 * w4[2] + (d1B * b4[2] + vB * k4[2]); B3 = B3 * w4[3] + (d1B * b4[3] + vB * k4[3]);
                if (jseg == 0) { sm[RW2_YB + t * 32 + iA] = yA; sm[RW2_YB + t * 32 + iB] = yB; }
                a4 = a4n; wr4 = wr4n; w4 = w4n; b4 = b4n; k4 = k4n; vA = vAn; vB = vBn; sc = scn;
            }
            WSYNC();
            { const int tt = lane >> 1, hh = lane & 1; const f32x4 yv = *(const LAS f32x4*)(sm + RW2_YB + tt * 32 + 8 * wave + 4 * hh);
              *(f32x4*)(yraw + (rowb + t0 + tt) * 512 + h * 64 + half * 32 + 8 * wave + 4 * hh) = yv; }
            __syncthreads();
        }
    } else if (wave < 6) {
        const int tp = wave - 4, tb = 16 * tp;
        LAS float* stg = sm + RW2_STG + tp * 3072;
        float w0c[4], a0c[4], kkc[4], kac[4], rkc[4];
#pragma unroll
        for (int nt = 0; nt < 4; ++nt) { const int c = h * 64 + 16 * nt + l15; w0c[nt] = w0[c]; a0c[nt] = a0[c]; kkc[nt] = k_k[c]; kac[nt] = k_a[c]; rkc[nt] = r_k[c]; }
        v4u ld[20];
#define PREP_ISSUE(T0) do { const int t0_ = (T0); { const size_t r_ = rowb + t0_ + tb + l15; const size_t rp_ = (t0_ + tb + l15 == 0) ? r_ : r_ - 1; \
            _Pragma("unroll") for (int lo = 0; lo < 2; ++lo) _Pragma("unroll") for (int ks = 0; ks < 2; ++ks) { const int col = 1536 + 64 * lo + 32 * ks + 8 * kg; \
                ld[(lo * 2 + ks) * 2] = *(const v4u*)(proj + r_ * L0P + col); ld[(lo * 2 + ks) * 2 + 1] = *(const v4u*)(proj + rp_ * L0P + col); } } \
            _Pragma("unroll") for (int ar = 0; ar < 3; ++ar) _Pragma("unroll") for (int i = 0; i < 2; ++i) { const int p_ = lane + 64 * i, row_ = p_ >> 3, c8_ = p_ & 7; \
                const size_t r_ = rowb + t0_ + tb + row_; const size_t rp_ = (t0_ + tb + row_ == 0) ? r_ : r_ - 1; const int col = 512 * ar + h * 64 + 8 * c8_; \
                ld[8 + (ar * 2 + i) * 2] = *(const v4u*)(proj + r_ * L0P + col); ld[8 + (ar * 2 + i) * 2 + 1] = *(const v4u*)(proj + rp_ * L0P + col); } } while (0)
#define PREP_BUILD(T0, NB) do { const int t0_ = (T0); LAS float* CHn = sm + RW2_CH0 + (NB) * RW_CHSZ; \
            f32x4 accw[4], acca[4]; \
            _Pragma("unroll") for (int nt = 0; nt < 4; ++nt) { accw[nt] = (f32x4){0.f, 0.f, 0.f, 0.f}; acca[nt] = (f32x4){0.f, 0.f, 0.f, 0.f}; } \
            { const float pz_ = (t0_ + tb + l15 == 0) ? 0.f : 1.f; \
              _Pragma("unroll") for (int lo = 0; lo < 2; ++lo) _Pragma("unroll") for (int ks = 0; ks < 2; ++ks) { float s_[8]; \
                const f32x4 m0 = *(const LAS f32x4*)(sm + RW2_MIX + 64 * lo + 32 * ks + 8 * kg), m1 = *(const LAS f32x4*)(sm + RW2_MIX + 64 * lo + 32 * ks + 8 * kg + 4); \
                RW_SH8(ld[(lo * 2 + ks) * 2], ld[(lo * 2 + ks) * 2 + 1], m0, m1, s_, pz_); \
                if (lo == 0) { _Pragma("unroll") for (int j = 0; j < 8; ++j) s_[j] = tanh_fast(s_[j]); } \
                v4u aw; aw.x = cvtpk(s_[0], s_[1]); aw.y = cvtpk(s_[2], s_[3]); aw.z = cvtpk(s_[4], s_[5]); aw.w = cvtpk(s_[6], s_[7]); const bf16x8 af = __builtin_bit_cast(bf16x8, aw); \
                const bf16_t* WT = lo ? A2T : W2T; \
                _Pragma("unroll") for (int nt = 0; nt < 4; ++nt) { const bf16x8 bfr = *(const bf16x8*)(WT + (size_t)(h * 64 + 16 * nt + l15) * 64 + 32 * ks + 8 * kg); \
                    if (lo == 0) accw[nt] = MFMA16(af, bfr, accw[nt]); else acca[nt] = MFMA16(af, bfr, acca[nt]); } } } \
            _Pragma("unroll") for (int ar = 0; ar < 3; ++ar) _Pragma("unroll") for (int i = 0; i < 2; ++i) { const int p_ = lane + 64 * i, row_ = p_ >> 3, c8_ = p_ & 7; float s_[8]; \
                const float pz_ = (t0_ + tb + row_ == 0) ? 0.f : 1.f; const f32x4 m0 = *(const LAS f32x4*)(sm + RW2_MIX + 256 + ar * 64 + c8_ * 8), m1 = *(const LAS f32x4*)(sm + RW2_MIX + 256 + ar * 64 + c8_ * 8 + 4); \
                RW_SH8(ld[8 + (ar * 2 + i) * 2], ld[8 + (ar * 2 + i) * 2 + 1], m0, m1, s_, pz_); \
                *(LAS f32x4*)(stg + ar * 1024 + row_ * 64 + c8_ * 8) = (f32x4){s_[0], s_[1], s_[2], s_[3]}; *(LAS f32x4*)(stg + ar * 1024 + row_ * 64 + c8_ * 8 + 4) = (f32x4){s_[4], s_[5], s_[6], s_[7]}; } \
            WSYNC(); \
            PREP_ISSUE(((T0) + 32 < SEQ) ? (T0) + 32 : (T0)); \
            _Pragma("unroll") for (int rg = 0; rg < 4; ++rg) { const int tl = 4 * kg + rg, t = tb + tl; \
                float r_[4], k_[4], v_[4], kkv[4], nrm2 = 0.f; \
                _Pragma("unroll") for (int nt = 0; nt < 4; ++nt) { r_[nt] = stg[tl * 64 + 16 * nt + l15]; k_[nt] = stg[1024 + tl * 64 + 16 * nt + l15]; v_[nt] = stg[2048 + tl * 64 + 16 * nt + l15]; \
                    kkv[nt] = k_[nt] * kkc[nt]; nrm2 += kkv[nt] * kkv[nt]; } \
                nrm2 = rowsum16(nrm2); const float rn = __builtin_amdgcn_rsqf(fmaxf(nrm2, 1e-24f)); \
                float br = 0.f, kr = 0.f, bon = 0.f; \
                _Pragma("unroll") for (int nt = 0; nt < 4; ++nt) { const int j = 16 * nt + l15; \
                    const float wsum = w0c[nt] + accw[nt][rg]; const float logw = -softplus_fast(-wsum) - 0.5f; const float dec = __expf(-__expf(logw)); \
                    const float a_ = sigmoid_fast(a0c[nt] + acca[nt][rg]); const float kn = kkv[nt] * rn; \
                    const float k2 = k_[nt] * (1.f + (a_ - 1.f) * kac[nt]); const float bv = kn * a_; \
                    br += bv * r_[nt]; kr += k2 * r_[nt]; bon += r_[nt] * k2 * rkc[nt]; \
                    CHn[t * 64 + j] = dec; CHn[2048 + t * 64 + j] = k2; CHn[4096 + t * 64 + j] = -kn; CHn[6144 + t * 64 + j] = bv; CHn[8192 + t * 64 + j] = dec * r_[nt]; \
                    if ((nt >> 1) == half) CHn[10240 + t * 32 + (j & 31)] = v_[nt]; } \
                br = rowsum16(br); kr = rowsum16(kr); bon = rowsum16(bon); \
                if (l15 == 0) { CHn[11264 + 2 * t] = br; CHn[11264 + 2 * t + 1] = kr; if (half == 0) bonus_out[(rowb + t0_ + t) * 8 + h] = bon; } } \
            WSYNC(); } while (0)
        PREP_ISSUE(0);
        PREP_BUILD(0, 0);
        __syncthreads();
#pragma unroll 1
        for (int ch = 0; ch < NCHUNK; ++ch) {
            if (ch + 1 < NCHUNK) PREP_BUILD(ch * 32 + 32, (ch + 1) & 1);
            __syncthreads();
        }
#undef PREP_ISSUE
#undef PREP_BUILD
    } else {
        const int tp = wave - 6, tb = 16 * tp;
        v4u ld[8];
#define G_ISSUE(T0) do { const int t0_ = (T0); const size_t r_ = rowb + t0_ + tb + l15; const size_t rp_ = (t0_ + tb + l15 == 0) ? r_ : r_ - 1; \
            _Pragma("unroll") for (int ks = 0; ks < 4; ++ks) { const int col = 1664 + 32 * ks + 8 * kg; ld[2 * ks] = *(const v4u*)(proj + r_ * L0P + col); ld[2 * ks + 1] = *(const v4u*)(proj + rp_ * L0P + col); } } while (0)
#define G_BUILD(T0) do { const int t0_ = (T0); f32x4 accg[2] = {(f32x4){0.f, 0.f, 0.f, 0.f}, (f32x4){0.f, 0.f, 0.f, 0.f}}; const float pz_ = (t0_ + tb + l15 == 0) ? 0.f : 1.f; \
            _Pragma("unroll") for (int ks = 0; ks < 4; ++ks) { float s_[8]; \
                const f32x4 m0 = *(const LAS f32x4*)(sm + RW2_MIX + 128 + 32 * ks + 8 * kg), m1 = *(const LAS f32x4*)(sm + RW2_MIX + 128 + 32 * ks + 8 * kg + 4); \
                RW_SH8(ld[2 * ks], ld[2 * ks + 1], m0, m1, s_, pz_); \
                _Pragma("unroll") for (int j = 0; j < 8; ++j) s_[j] = sigmoid_fast(s_[j]); \
                v4u aw; aw.x = cvtpk(s_[0], s_[1]); aw.y = cvtpk(s_[2], s_[3]); aw.z = cvtpk(s_[4], s_[5]); aw.w = cvtpk(s_[6], s_[7]); const bf16x8 af = __builtin_bit_cast(bf16x8, aw); \
                _Pragma("unroll") for (int nt = 0; nt < 2; ++nt) { const bf16x8 bfr = *(const bf16x8*)(G2T + (size_t)(h * 64 + half * 32 + 16 * nt + l15) * 128 + 32 * ks + 8 * kg); accg[nt] = MFMA16(af, bfr, accg[nt]); } } \
            G_ISSUE(((T0) + 32 < SEQ) ? (T0) + 32 : (T0)); \
            _Pragma("unroll") for (int nt = 0; nt < 2; ++nt) _Pragma("unroll") for (int rg = 0; rg < 4; ++rg) \
                gout[(rowb + t0_ + tb + 4 * kg + rg) * 512 + h * 64 + half * 32 + 16 * nt + l15] = (bf16_t)f2bf(accg[nt][rg]); } while (0)
        G_ISSUE(0);
        G_BUILD(0);
        __syncthreads();
#pragma unroll 1
        for (int ch = 0; ch < NCHUNK; ++ch) {
            if (ch + 1 < NCHUNK) G_BUILD(ch * 32 + 32);
            __syncthreads();
        }
#undef G_ISSUE
#undef G_BUILD
    }
#undef RW_SH8
    __syncthreads();
}

constexpr int CK_BK = 0, CK_AR = 4608, CK_BBT = 9216, CK_KBT = 12288, CK_VT = 15360, CK_GC = 16896, CK_TT = 17152, CK_SLOT = 18688, CK_NSLOT = 6, CK_NBUILD = 5;
constexpr int CK_STG = CK_SLOT * CK_NSLOT;
constexpr int CK_MIX = CK_STG + CK_NBUILD * 6144;
constexpr int CK_FLAGS = CK_MIX + 448 * 4;
static_assert(CK_FLAGS + 64 <= 146432, "rwkv chunked LDS map");
__device__ __forceinline__ void rwkv_phase(LAS float* smf, int tid, int lane, int wave, int blk, const bf16_t* __restrict__ proj, const float* __restrict__ mix, const float* __restrict__ w0, const float* __restrict__ a0,
                                           const float* __restrict__ k_k, const float* __restrict__ k_a, const float* __restrict__ r_k, const bf16_t* __restrict__ W2T, const bf16_t* __restrict__ A2T, const bf16_t* __restrict__ G2T,
                                           float* __restrict__ yraw, bf16_t* __restrict__ gout, float* __restrict__ bonus_out) {
    LAS unsigned char* lds = (LAS unsigned char*)smf;
    LAS float* mixs = (LAS float*)(lds + CK_MIX);
    volatile LAS unsigned* flags = (volatile LAS unsigned*)(lds + CK_FLAGS);
    const int chain = blk >> 1, ihalf = blk & 1, b = chain >> 3, h = chain & 7, l15 = lane & 15, kg = lane >> 4, l31 = lane & 31, hi = lane >> 5;
    const size_t rowb = (size_t)b * SEQ;
    constexpr int NCH = SEQ / 16;
    if (tid < 256) mixs[tid] = mix[1536 + tid];
    else if (tid < 448) { const int q = tid - 256; mixs[tid] = mix[512 * (q >> 6) + h * 64 + (q & 63)]; }
    if (tid < 16) flags[tid] = (tid == 9) ? (unsigned)CK_NBUILD : 0u;
    for (int q = tid; q < CK_NSLOT * 384; q += NWAVES * 64) *(LAS unsigned*)(lds + (q / 384) * CK_SLOT + CK_TT + (q % 384) * 4) = 0u;
    __syncthreads();
#define RW_SH8(CUR, PRV, M0, M1, OUT, PZ) do { const unsigned cu_[4] = {(CUR).x, (CUR).y, (CUR).z, (CUR).w}, pu_[4] = {(PRV).x, (PRV).y, (PRV).z, (PRV).w}; \
        const float mm_[8] = {(M0)[0], (M0)[1], (M0)[2], (M0)[3], (M1)[0], (M1)[1], (M1)[2], (M1)[3]}; \
        _Pragma("unroll") for (int q = 0; q < 4; ++q) { const float c0 = bflo(cu_[q]), c1 = bfhi(cu_[q]), p0 = bflo(pu_[q]) * (PZ), p1 = bfhi(pu_[q]) * (PZ); \
            OUT[2 * q] = c0 + (p0 - c0) * mm_[2 * q]; OUT[2 * q + 1] = c1 + (p1 - c1) * mm_[2 * q + 1]; } } while (0)
    if (wave == 0) {
        f32x16 ST[2];
#pragma unroll
        for (int r = 0; r < 16; ++r) { ST[0][r] = 0.f; ST[1][r] = 0.f; }
#pragma unroll 1
        for (int k = 0; k < NCH; ++k) {
#if defined(PROBE_STAMPS)
            const unsigned tw0_ = (unsigned)__builtin_amdgcn_s_memrealtime();
#endif
            { const unsigned want = (unsigned)(k + 1); const int sl = k % CK_NSLOT; while (flags[sl] != want) __builtin_amdgcn_s_sleep(1); }
#if defined(PROBE_STAMPS)
            if (blk == 0 && lane == 0) ((volatile LAS unsigned*)(lds + 146432 + 320))[16 + 24] += (unsigned)__builtin_amdgcn_s_memrealtime() - tw0_;
#endif
            asm volatile("" ::: "memory");
            const LAS unsigned char* im = lds + (k % CK_NSLOT) * CK_SLOT;
            f32x16 G;
#pragma unroll
            for (int r = 0; r < 16; ++r) G[r] = 0.f;
#pragma unroll
            for (int kk = 0; kk < 4; ++kk) { const bf16x8 fa = *(const LAS bf16x8*)(im + CK_BK + l31 * 144 + (16 * kk + 8 * hi) * 2), fb = *(const LAS bf16x8*)(im + CK_AR + l31 * 144 + (16 * kk + 8 * hi) * 2); G = MFMA32(fa, fb, G); }
            { const int tcol = l31 & 15; const bool strict = l31 < 16;
#pragma unroll
              for (int r = 0; r < 16; ++r) { const int srow = crow(r & 7, hi); const bool keep = strict ? (srow < tcol) : (srow <= tcol); G[r] = keep ? G[r] : 0.f; } }
            const bf16x8 gB = pack8(G[0], G[1], G[2], G[3], G[4], G[5], G[6], G[7]), gK = pack8(G[8], G[9], G[10], G[11], G[12], G[13], G[14], G[15]);
            f32x16 XT;
#pragma unroll
            for (int r = 0; r < 16; ++r) XT[r] = 0.f;
#pragma unroll
            for (int jt = 0; jt < 2; ++jt)
#pragma unroll
                for (int sp = 0; sp < 2; ++sp) { const LAS unsigned char* ap = im + CK_AR + l31 * 144 + (32 * jt + 16 * sp + 4 * hi) * 2;
                    const u32x2 x0 = *(const LAS u32x2*)ap, x1 = *(const LAS u32x2*)(ap + 16); v4u aw; aw.x = x0.x; aw.y = x0.y; aw.z = x1.x; aw.w = x1.y;
                    const bf16x8 sb_ = pack8(ST[jt][8 * sp], ST[jt][8 * sp + 1], ST[jt][8 * sp + 2], ST[jt][8 * sp + 3], ST[jt][8 * sp + 4], ST[jt][8 * sp + 5], ST[jt][8 * sp + 6], ST[jt][8 * sp + 7]);
                    XT = MFMA32(__builtin_bit_cast(bf16x8, aw), sb_, XT); }
            bf16x8 vP;
            { const LAS unsigned char* vp = im + CK_VT + l31 * 48 + (4 * hi) * 2; const u32x2 x0 = *(const LAS u32x2*)vp, x1 = *(const LAS u32x2*)(vp + 16); v4u vw; vw.x = x0.x; vw.y = x0.y; vw.z = x1.x; vw.w = x1.y;
              vP = __builtin_bit_cast(bf16x8, vw); XT = MFMA32(gK, vP, XT); }
            bf16x8 uP;
            { const LAS unsigned char* tp = im + CK_TT + l31 * 48 + (4 * hi) * 2; const u32x2 x0 = *(const LAS u32x2*)tp, x1 = *(const LAS u32x2*)(tp + 16); v4u tw; tw.x = x0.x; tw.y = x0.y; tw.z = x1.x; tw.w = x1.y;
              f32x16 UT;
#pragma unroll
              for (int r = 0; r < 16; ++r) UT[r] = 0.f;
              UT = MFMA32(__builtin_bit_cast(bf16x8, tw), pack8(XT[0], XT[1], XT[2], XT[3], XT[4], XT[5], XT[6], XT[7]), UT);
              uP = pack8(UT[0], UT[1], UT[2], UT[3], UT[4], UT[5], UT[6], UT[7]); }
            XT = MFMA32(gB, uP, XT);
            { float* yp = yraw + (rowb + 16 * k) * 512 + h * 64 + 32 * ihalf + l31;
#pragma unroll
              for (int q = 0; q < 8; ++q) yp[(size_t)crow(q, hi) * 512] = XT[8 + q]; }
            { const LAS float* gc = (const LAS float*)(im + CK_GC);
#pragma unroll
              for (int jt = 0; jt < 2; ++jt)
#pragma unroll
                  for (int r = 0; r < 16; ++r) ST[jt][r] *= gc[32 * jt + crow(r, hi)]; }
#pragma unroll
            for (int jt = 0; jt < 2; ++jt) { const LAS unsigned char* bp = im + CK_BBT + (32 * jt + l31) * 48 + (4 * hi) * 2; const LAS unsigned char* kp = im + CK_KBT + (32 * jt + l31) * 48 + (4 * hi) * 2;
                const u32x2 b0 = *(const LAS u32x2*)bp, b1 = *(const LAS u32x2*)(bp + 16), k0 = *(const LAS u32x2*)kp, k1 = *(const LAS u32x2*)(kp + 16);
                v4u a1; a1.x = b0.x; a1.y = b0.y; a1.z = b1.x; a1.w = b1.y; v4u a2; a2.x = k0.x; a2.y = k0.y; a2.z = k1.x; a2.w = k1.y;
                ST[jt] = MFMA32(__builtin_bit_cast(bf16x8, a1), uP, ST[jt]); ST[jt] = MFMA32(__builtin_bit_cast(bf16x8, a2), vP, ST[jt]); }
            WSYNC();
            if (lane == 0) flags[8] = (unsigned)(k + 1);
        }
    } else if (wave <= CK_NBUILD) {
        const int pw = wave - 1;
        LAS bf16_t* stg = (LAS bf16_t*)(lds + CK_STG) + pw * 3072;
        float w0c[4], a0c[4], kkc[4], kac[4], rkc[4];
#pragma unroll
        for (int nt = 0; nt < 4; ++nt) { const int c = h * 64 + 16 * nt + l15; w0c[nt] = w0[c]; a0c[nt] = a0[c]; kkc[nt] = k_k[c]; kac[nt] = k_a[c]; rkc[nt] = r_k[c]; }
        v4u ld[20];
#define CK_ISSUE_A(T0) do { const int t0_ = (T0); const size_t r_ = rowb + t0_ + l15; const size_t rp_ = (t0_ + l15 == 0) ? r_ : r_ - 1; \
            _Pragma("unroll") for (int lo = 0; lo < 2; ++lo) _Pragma("unroll") for (int ks = 0; ks < 2; ++ks) { const int col = 1536 + 64 * lo + 32 * ks + 8 * kg; \
                ld[(lo * 2 + ks) * 2] = *(const v4u*)(proj + r_ * L0P + col); ld[(lo * 2 + ks) * 2 + 1] = *(const v4u*)(proj + rp_ * L0P + col); } } while (0)
#define CK_ISSUE_B(T0) do { const int t0_ = (T0); \
            _Pragma("unroll") for (int ar = 0; ar < 3; ++ar) _Pragma("unroll") for (int i = 0; i < 2; ++i) { const int p_ = lane + 64 * i, row_ = p_ >> 3, c8_ = p_ & 7; \
                const size_t r_ = rowb + t0_ + row_; const size_t rp_ = (t0_ + row_ == 0) ? r_ : r_ - 1; const int col = 512 * ar + h * 64 + 8 * c8_; \
                ld[8 + (ar * 2 + i) * 2] = *(const v4u*)(proj + r_ * L0P + col); ld[8 + (ar * 2 + i) * 2 + 1] = *(const v4u*)(proj + rp_ * L0P + col); } } while (0)
#define CK_ISSUE(T0) do { CK_ISSUE_A(T0); CK_ISSUE_B(T0); } while (0)
        CK_ISSUE(16 * pw);
        int k = pw;
#pragma unroll 1
        while (k < NCH) {
            const int t0 = 16 * k; int kn;
#if defined(PROBE_STAMPS)
            const unsigned ts0_ = (unsigned)__builtin_amdgcn_s_memrealtime();
#endif
            f32x4 accw[4], acca[4];
#pragma unroll
            for (int nt = 0; nt < 4; ++nt) { accw[nt] = (f32x4){0.f, 0.f, 0.f, 0.f}; acca[nt] = (f32x4){0.f, 0.f, 0.f, 0.f}; }
            { const float pz_ = (t0 + l15 == 0) ? 0.f : 1.f;
#pragma unroll
              for (int lo = 0; lo < 2; ++lo)
#pragma unroll
                for (int ks = 0; ks < 2; ++ks) { float s_[8];
                    const f32x4 m0 = *(const LAS f32x4*)(mixs + 64 * lo + 32 * ks + 8 * kg), m1 = *(const LAS f32x4*)(mixs + 64 * lo + 32 * ks + 8 * kg + 4);
                    RW_SH8(ld[(lo * 2 + ks) * 2], ld[(lo * 2 + ks) * 2 + 1], m0, m1, s_, pz_);
                    if (lo == 0) {
#pragma unroll
                        for (int j = 0; j < 8; ++j) s_[j] = tanh_fast(s_[j]); }
                    const bf16x8 af = pack8(s_[0], s_[1], s_[2], s_[3], s_[4], s_[5], s_[6], s_[7]);
                    const bf16_t* WT = lo ? A2T : W2T;
#pragma unroll
                    for (int nt = 0; nt < 4; ++nt) { const bf16x8 bfr = *(const bf16x8*)(WT + (size_t)(h * 64 + 16 * nt + l15) * 64 + 32 * ks + 8 * kg);
                        if (lo == 0) accw[nt] = MFMA16(af, bfr, accw[nt]); else acca[nt] = MFMA16(af, bfr, acca[nt]); } } }
#pragma unroll
            for (int ar = 0; ar < 3; ++ar)
#pragma unroll
                for (int i = 0; i < 2; ++i) { const int p_ = lane + 64 * i, row_ = p_ >> 3, c8_ = p_ & 7; float s_[8];
                    const float pz_ = (t0 + row_ == 0) ? 0.f : 1.f; const f32x4 m0 = *(const LAS f32x4*)(mixs + 256 + ar * 64 + c8_ * 8), m1 = *(const LAS f32x4*)(mixs + 256 + ar * 64 + c8_ * 8 + 4);
                    RW_SH8(ld[8 + (ar * 2 + i) * 2], ld[8 + (ar * 2 + i) * 2 + 1], m0, m1, s_, pz_);
                    *(LAS bf16x8*)(stg + ar * 1024 + row_ * 64 + c8_ * 8) = pack8(s_[0], s_[1], s_[2], s_[3], s_[4], s_[5], s_[6], s_[7]); }
            WSYNC();
#if defined(PROBE_STAMPS)
            if (blk == 0 && wave == 1 && lane == 0) ((volatile LAS unsigned*)(lds + 146432 + 320))[16 + 26] += (unsigned)__builtin_amdgcn_s_memrealtime() - ts0_;
#endif
#if defined(PROBE_STAMPS)
            const unsigned tb0_ = (unsigned)__builtin_amdgcn_s_memrealtime();
#endif
            { const int need = k - (CK_NSLOT - 1); if (need > 0) { while ((int)flags[8] < need) __builtin_amdgcn_s_sleep(2); } }
#if defined(PROBE_STAMPS)
            if (blk == 0 && wave == 1 && lane == 0) ((volatile LAS unsigned*)(lds + 146432 + 320))[16 + 25] += (unsigned)__builtin_amdgcn_s_memrealtime() - tb0_;
#endif
            asm volatile("" ::: "memory");
            LAS unsigned char* im = lds + (k % CK_NSLOT) * CK_SLOT;
#if defined(PROBE_STAMPS)
            const unsigned ts1_ = (unsigned)__builtin_amdgcn_s_memrealtime();
#endif
            float lwv[4][4], av[4][4], knv[4][4];
#pragma unroll
            for (int rg = 0; rg < 4; ++rg) { const int tl = 4 * kg + rg;
                float kkv[4], nrm2 = 0.f, vv[4], rr_[4], kr_[4];
#pragma unroll
                for (int nt = 0; nt < 4; ++nt) { rr_[nt] = bf2f(stg[tl * 64 + 16 * nt + l15]); kr_[nt] = bf2f(stg[1024 + tl * 64 + 16 * nt + l15]); vv[nt] = bf2f(stg[2048 + tl * 64 + 16 * nt + l15]);
                    kkv[nt] = kr_[nt] * kkc[nt]; nrm2 += kkv[nt] * kkv[nt]; }
                nrm2 = rowsum16(nrm2); const float rn = __builtin_amdgcn_rsqf(fmaxf(nrm2, 1e-24f));
                float bon = 0.f;
#pragma unroll
                for (int nt = 0; nt < 4; ++nt) {
                    const float wsum = w0c[nt] + accw[nt][rg]; lwv[nt][rg] = -0.6065306597126334f * sigmoid_fast(wsum);
                    const float a_ = sigmoid_fast(a0c[nt] + acca[nt][rg]); av[nt][rg] = a_; knv[nt][rg] = kkv[nt] * rn;
                    const float k2 = kr_[nt] * (1.f + (a_ - 1.f) * kac[nt]); stg[1024 + tl * 64 + 16 * nt + l15] = bf1(k2);
                    bon += rr_[nt] * k2 * rkc[nt];
                    if ((nt >> 1) == ihalf) *(LAS bf16_t*)(im + CK_VT + (16 * (nt & 1) + l15) * 48 + tl * 2) = bf1(vv[nt]);
                }
                bon = rowsum16(bon);
                if (l15 == 0 && ihalf == 0) bonus_out[(rowb + t0 + tl) * 8 + h] = bon;
            }
            { unsigned g_ = 0; if (lane == 0) g_ = __hip_atomic_fetch_add((LAS unsigned*)(lds + CK_FLAGS + 36), 1u, __ATOMIC_RELAXED, __HIP_MEMORY_SCOPE_WORKGROUP);
              kn = (int)__builtin_amdgcn_readfirstlane(g_); }
            CK_ISSUE_A((kn < NCH) ? 16 * kn : t0);
#pragma unroll
            for (int nt = 0; nt < 4; ++nt) {
                float L[4]; L[0] = lwv[nt][0]; L[1] = L[0] + lwv[nt][1]; L[2] = L[1] + lwv[nt][2]; L[3] = L[2] + lwv[nt][3];
                const float T0 = __shfl(L[3], l15), T1 = __shfl(L[3], 16 + l15), T2 = __shfl(L[3], 32 + l15), T3 = __shfl(L[3], 48 + l15);
                const float off = (kg > 0 ? T0 : 0.f) + (kg > 1 ? T1 : 0.f) + (kg > 2 ? T2 : 0.f), LC = (T0 + T1) + (T2 + T3);
                const int j = 16 * nt + l15;
                unsigned bb2[2], kb2[2];
                const float gC = __expf(LC); float eprev = __expf(off);
#pragma unroll
                for (int rg = 0; rg < 4; ++rg) { const int tl = 4 * kg + rg; const float Lt = off + L[rg], e1 = __expf(Lt), e2 = __builtin_amdgcn_rcpf(e1), e3 = eprev, e4 = gC * e2; eprev = e1;
                    const float kn = knv[nt][rg], bvv = kn * av[nt][rg], k2 = bf2f(stg[1024 + tl * 64 + j]), rr2 = bf2f(stg[tl * 64 + j]);
                    *(LAS bf16_t*)(im + CK_BK + tl * 144 + j * 2) = bf1(bvv * e2); *(LAS bf16_t*)(im + CK_BK + (16 + tl) * 144 + j * 2) = bf1(k2 * e2);
                    *(LAS bf16_t*)(im + CK_AR + tl * 144 + j * 2) = bf1(-kn * e3); *(LAS bf16_t*)(im + CK_AR + (16 + tl) * 144 + j * 2) = bf1(rr2 * e1);
                    const unsigned bq = bf1(bvv * e4), kq = bf1(k2 * e4);
                    if (rg & 1) { bb2[rg >> 1] |= bq << 16; kb2[rg >> 1] |= kq << 16; } else { bb2[rg >> 1] = bq; kb2[rg >> 1] = kq; } }
                *(LAS u32x2*)(im + CK_BBT + j * 48 + (4 * kg) * 2) = (u32x2){bb2[0], bb2[1]}; *(LAS u32x2*)(im + CK_KBT + j * 48 + (4 * kg) * 2) = (u32x2){kb2[0], kb2[1]};
                if (kg == 0) *(LAS float*)(im + CK_GC + j * 4) = gC;
            }
            WSYNC();
#if defined(PROBE_STAMPS)
            const unsigned ts2_ = (unsigned)__builtin_amdgcn_s_memrealtime();
            if (blk == 0 && wave == 1 && lane == 0) ((volatile LAS unsigned*)(lds + 146432 + 320))[16 + 27] += ts2_ - ts1_;
#endif
            {
                f32x4 nacc = {0.f, 0.f, 0.f, 0.f};
#pragma unroll
                for (int ks = 0; ks < 2; ++ks) { const bf16x8 fa = *(const LAS bf16x8*)(im + CK_BK + l15 * 144 + (32 * ks + 8 * kg) * 2), fb = *(const LAS bf16x8*)(im + CK_AR + l15 * 144 + (32 * ks + 8 * kg) * 2); nacc = MFMA16(fa, fb, nacc); }
#pragma unroll
                for (int rg = 0; rg < 4; ++rg) nacc[rg] = ((4 * kg + rg) < l15) ? nacc[rg] : 0.f;
                float Tr[16];
#pragma unroll
                for (int t = 0; t < 16; ++t) { float acc_ = (l15 == t) ? 1.f : 0.f;
#pragma unroll
                    for (int s2 = 0; s2 < t; ++s2) acc_ += Tr[s2] * rl(nacc[s2 & 3], t + 16 * (s2 >> 2));
                    Tr[t] = acc_; }
                if (kg == 0) {
#pragma unroll
                    for (int t = 0; t < 16; ++t) *(LAS bf16_t*)(im + CK_TT + t * 48 + l15 * 2) = bf1(Tr[t]); }
            }
            WSYNC();
#if defined(PROBE_STAMPS)
            if (blk == 0 && wave == 1 && lane == 0) ((volatile LAS unsigned*)(lds + 146432 + 320))[16 + 28] += (unsigned)__builtin_amdgcn_s_memrealtime() - ts2_;
#endif
            if (lane == 0) flags[k % CK_NSLOT] = (unsigned)(k + 1);
            CK_ISSUE_B((kn < NCH) ? 16 * kn : t0);
            k = kn;
        }
#undef CK_ISSUE
#undef CK_ISSUE_A
#undef CK_ISSUE_B
    } else {
        const int gq = wave - 6;
        v4u ld[8];
#define G_ISSUE(T0) do { const int t0_ = (T0); const size_t r_ = rowb + t0_ + l15; const size_t rp_ = (t0_ + l15 == 0) ? r_ : r_ - 1; \
            _Pragma("unroll") for (int ks = 0; ks < 4; ++ks) { const int col = 1664 + 32 * ks + 8 * kg; ld[2 * ks] = *(const v4u*)(proj + r_ * L0P + col); ld[2 * ks + 1] = *(const v4u*)(proj + rp_ * L0P + col); } } while (0)
        G_ISSUE(16 * gq);
#pragma unroll 1
        for (int k = gq; k < NCH; k += 2) {
            const int t0 = 16 * k;
            f32x4 accg[2] = {(f32x4){0.f, 0.f, 0.f, 0.f}, (f32x4){0.f, 0.f, 0.f, 0.f}}; const float pz_ = (t0 + l15 == 0) ? 0.f : 1.f;
#pragma unroll
            for (int ks = 0; ks < 4; ++ks) { float s_[8];
                const f32x4 m0 = *(const LAS f32x4*)(mixs + 128 + 32 * ks + 8 * kg), m1 = *(const LAS f32x4*)(mixs + 128 + 32 * ks + 8 * kg + 4);
                RW_SH8(ld[2 * ks], ld[2 * ks + 1], m0, m1, s_, pz_);
#pragma unroll
                for (int j = 0; j < 8; ++j) s_[j] = sigmoid_fast(s_[j]);
                const bf16x8 af = pack8(s_[0], s_[1], s_[2], s_[3], s_[4], s_[5], s_[6], s_[7]);
#pragma unroll
                for (int nt = 0; nt < 2; ++nt) { const bf16x8 bfr = *(const bf16x8*)(G2T + (size_t)(h * 64 + ihalf * 32 + 16 * nt + l15) * 128 + 32 * ks + 8 * kg); accg[nt] = MFMA16(af, bfr, accg[nt]); } }
            G_ISSUE((k + 2 < NCH) ? t0 + 32 : t0);
#pragma unroll
            for (int nt = 0; nt < 2; ++nt)
#pragma unroll
                for (int rg = 0; rg < 4; ++rg) gout[(rowb + t0 + 4 * kg + rg) * 512 + h * 64 + ihalf * 32 + 16 * nt + l15] = bf1(accg[nt][rg]);
        }
#undef G_ISSUE
    }
#undef RW_SH8
    __syncthreads();
}

constexpr int CC_BK = 0, CC_AR = 4608, CC_BBT = 9216, CC_KBT = 11776, CC_VT = 14336, CC_GC = 16896, CC_TT = 17152, CC_SLOT = 18432, CC_NSLOT = 6, CC_NBUILD = 5;
constexpr int CC_STG = CC_SLOT * CC_NSLOT;
constexpr int CC_MIX = CC_STG + CC_NBUILD * 6144;
constexpr int CC_FLAGS = CC_MIX + 448 * 4;
static_assert(CC_FLAGS + 64 <= 146432, "rwkv chain LDS map");
__device__ __forceinline__ void rwkv_phase_chain(LAS float* smf, int tid, int lane, int wave, int blk, const bf16_t* __restrict__ proj, const float* __restrict__ mix, const float* __restrict__ w0, const float* __restrict__ a0,
                                           const float* __restrict__ k_k, const float* __restrict__ k_a, const float* __restrict__ r_k, const bf16_t* __restrict__ W2T, const bf16_t* __restrict__ A2T, const bf16_t* __restrict__ G2T,
                                           float* __restrict__ yraw, bf16_t* __restrict__ gout, float* __restrict__ bonus_out) {
    LAS unsigned char* lds = (LAS unsigned char*)smf;
    LAS float* mixs = (LAS float*)(lds + CC_MIX);
    volatile LAS unsigned* flags = (volatile LAS unsigned*)(lds + CC_FLAGS);
    const int chain = blk, b = chain >> 3, h = chain & 7, l15 = lane & 15, kg = lane >> 4, l31 = lane & 31, hi = lane >> 5;
    const size_t rowb = (size_t)b * SEQ;
    constexpr int NCH = SEQ / 16;
    if (tid < 256) mixs[tid] = mix[1536 + tid];
    else if (tid < 448) { const int q = tid - 256; mixs[tid] = mix[512 * (q >> 6) + h * 64 + (q & 63)]; }
    if (tid < 16) flags[tid] = (tid == 10) ? (unsigned)CC_NBUILD : 0u;
    for (int q = tid; q < CC_NSLOT * 320; q += NWAVES * 64) *(LAS unsigned*)(lds + (q / 320) * CC_SLOT + CC_TT + (q % 320) * 4) = 0u;
    __syncthreads();
#define RW_SH8(CUR, PRV, M0, M1, OUT, PZ) do { const unsigned cu_[4] = {(CUR).x, (CUR).y, (CUR).z, (CUR).w}, pu_[4] = {(PRV).x, (PRV).y, (PRV).z, (PRV).w}; \
        const float mm_[8] = {(M0)[0], (M0)[1], (M0)[2], (M0)[3], (M1)[0], (M1)[1], (M1)[2], (M1)[3]}; \
        _Pragma("unroll") for (int q = 0; q < 4; ++q) { const float c0 = bflo(cu_[q]), c1 = bfhi(cu_[q]), p0 = bflo(pu_[q]) * (PZ), p1 = bfhi(pu_[q]) * (PZ); \
            OUT[2 * q] = c0 + (p0 - c0) * mm_[2 * q]; OUT[2 * q + 1] = c1 + (p1 - c1) * mm_[2 * q + 1]; } } while (0)
    if (wave < 2) {
        const int ihalf = wave;
        f32x16 ST[2];
#pragma unroll
        for (int r = 0; r < 16; ++r) { ST[0][r] = 0.f; ST[1][r] = 0.f; }
#pragma unroll 1
        for (int k = 0; k < NCH; ++k) {
#if defined(PROBE_STAMPS)
            const unsigned tw0_ = (unsigned)__builtin_amdgcn_s_memrealtime();
#endif
            { const unsigned want = (unsigned)(k + 1); const int sl = k % CC_NSLOT; while (flags[sl] != want) __builtin_amdgcn_s_sleep(1); }
#if defined(PROBE_STAMPS)
            if (blk == 0 && lane == 0) ((volatile LAS unsigned*)(lds + 146432 + 320))[16 + 24] += (unsigned)__builtin_amdgcn_s_memrealtime() - tw0_;
#endif
            asm volatile("" ::: "memory");
            const LAS unsigned char* im = lds + (k % CC_NSLOT) * CC_SLOT;
            f32x16 G;
#pragma unroll
            for (int r = 0; r < 16; ++r) G[r] = 0.f;
#pragma unroll
            for (int kk = 0; kk < 4; ++kk) { const bf16x8 fa = *(const LAS bf16x8*)(im + CC_BK + l31 * 144 + (16 * kk + 8 * hi) * 2), fb = *(const LAS bf16x8*)(im + CC_AR + l31 * 144 + (16 * kk + 8 * hi) * 2); G = MFMA32(fa, fb, G); }
            { const int tcol = l31 & 15; const bool strict = l31 < 16;
#pragma unroll
              for (int r = 0; r < 16; ++r) { const int srow = crow(r & 7, hi); const bool keep = strict ? (srow < tcol) : (srow <= tcol); G[r] = keep ? G[r] : 0.f; } }
            const bf16x8 gB = pack8(G[0], G[1], G[2], G[3], G[4], G[5], G[6], G[7]), gK = pack8(G[8], G[9], G[10], G[11], G[12], G[13], G[14], G[15]);
            f32x16 XT;
#pragma unroll
            for (int r = 0; r < 16; ++r) XT[r] = 0.f;
#pragma unroll
            for (int jt = 0; jt < 2; ++jt)
#pragma unroll
                for (int sp = 0; sp < 2; ++sp) { const LAS unsigned char* ap = im + CC_AR + l31 * 144 + (32 * jt + 16 * sp + 4 * hi) * 2;
                    const u32x2 x0 = *(const LAS u32x2*)ap, x1 = *(const LAS u32x2*)(ap + 16); v4u aw; aw.x = x0.x; aw.y = x0.y; aw.z = x1.x; aw.w = x1.y;
                    const bf16x8 sb_ = pack8(ST[jt][8 * sp], ST[jt][8 * sp + 1], ST[jt][8 * sp + 2], ST[jt][8 * sp + 3], ST[jt][8 * sp + 4], ST[jt][8 * sp + 5], ST[jt][8 * sp + 6], ST[jt][8 * sp + 7]);
                    XT = MFMA32(__builtin_bit_cast(bf16x8, aw), sb_, XT); }
            bf16x8 vP;
            { const LAS unsigned char* vp = im + CC_VT + (32 * ihalf + l31) * 40 + (4 * hi) * 2; const u32x2 x0 = *(const LAS u32x2*)vp, x1 = *(const LAS u32x2*)(vp + 16); v4u vw; vw.x = x0.x; vw.y = x0.y; vw.z = x1.x; vw.w = x1.y;
              vP = __builtin_bit_cast(bf16x8, vw); XT = MFMA32(gK, vP, XT); }
            bf16x8 uP;
            { const LAS unsigned char* tp = im + CC_TT + l31 * 40 + (4 * hi) * 2; const u32x2 x0 = *(const LAS u32x2*)tp, x1 = *(const LAS u32x2*)(tp + 16); v4u tw; tw.x = x0.x; tw.y = x0.y; tw.z = x1.x; tw.w = x1.y;
              f32x16 UT;
#pragma unroll
              for (int r = 0; r < 16; ++r) UT[r] = 0.f;
              UT = MFMA32(__builtin_bit_cast(bf16x8, tw), pack8(XT[0], XT[1], XT[2], XT[3], XT[4], XT[5], XT[6], XT[7]), UT);
              uP = pack8(UT[0], UT[1], UT[2], UT[3], UT[4], UT[5], UT[6], UT[7]); }
            XT = MFMA32(gB, uP, XT);
            { float* yp = yraw + (rowb + 16 * k) * 512 + h * 64 + 32 * ihalf + l31;
#pragma unroll
              for (int q = 0; q < 8; ++q) yp[(size_t)crow(q, hi) * 512] = XT[8 + q]; }
            { const LAS float* gc = (const LAS float*)(im + CC_GC);
#pragma unroll
              for (int jt = 0; jt < 2; ++jt)
#pragma unroll
                  for (int r = 0; r < 16; ++r) ST[jt][r] *= gc[32 * jt + crow(r, hi)]; }
#pragma unroll
            for (int jt = 0; jt < 2; ++jt) { const LAS unsigned char* bp = im + CC_BBT + (32 * jt + l31) * 40 + (4 * hi) * 2; const LAS unsigned char* kp = im + CC_KBT + (32 * jt + l31) * 40 + (4 * hi) * 2;
                const u32x2 b0 = *(const LAS u32x2*)bp, b1 = *(const LAS u32x2*)(bp + 16), k0 = *(const LAS u32x2*)kp, k1 = *(const LAS u32x2*)(kp + 16);
                v4u a1; a1.x = b0.x; a1.y = b0.y; a1.z = b1.x; a1.w = b1.y; v4u a2; a2.x = k0.x; a2.y = k0.y; a2.z = k1.x; a2.w = k1.y;
                ST[jt] = MFMA32(__builtin_bit_cast(bf16x8, a1), uP, ST[jt]); ST[jt] = MFMA32(__builtin_bit_cast(bf16x8, a2), vP, ST[jt]); }
            WSYNC();
            if (lane == 0) flags[8 + ihalf] = (unsigned)(k + 1);
        }
    } else if (wave <= CC_NBUILD + 1) {
        const int pw = wave - 2;
        LAS bf16_t* stg = (LAS bf16_t*)(lds + CC_STG) + pw * 3072;
        v4u ld[20];
#define CC_ISSUE_A(T0) do { const int t0_ = (T0); const size_t r_ = rowb + t0_ + l15; const size_t rp_ = (t0_ + l15 == 0) ? r_ : r_ - 1; \
            _Pragma("unroll") for (int lo = 0; lo < 2; ++lo) _Pragma("unroll") for (int ks = 0; ks < 2; ++ks) { const int col = 1536 + 64 * lo + 32 * ks + 8 * kg; \
                ld[(lo * 2 + ks) * 2] = *(const v4u*)(proj + r_ * L0P + col); ld[(lo * 2 + ks) * 2 + 1] = *(const v4u*)(proj + rp_ * L0P + col); } } while (0)
#define CC_ISSUE_B(T0) do { const int t0_ = (T0); \
            _Pragma("unroll") for (int ar = 0; ar < 3; ++ar) _Pragma("unroll") for (int i = 0; i < 2; ++i) { const int p_ = lane + 64 * i, row_ = p_ >> 3, c8_ = p_ & 7; \
                const size_t r_ = rowb + t0_ + row_; const size_t rp_ = (t0_ + row_ == 0) ? r_ : r_ - 1; const int col = 512 * ar + h * 64 + 8 * c8_; \
                ld[8 + (ar * 2 + i) * 2] = *(const v4u*)(proj + r_ * L0P + col); ld[8 + (ar * 2 + i) * 2 + 1] = *(const v4u*)(proj + rp_ * L0P + col); } } while (0)
#define CC_ISSUE(T0) do { CC_ISSUE_A(T0); CC_ISSUE_B(T0); } while (0)
        CC_ISSUE(16 * pw);
        int k = pw;
#pragma unroll 1
        while (k < NCH) {
            const int t0 = 16 * k; int kn;
#if defined(PROBE_STAMPS)
            const unsigned ts0_ = (unsigned)__builtin_amdgcn_s_memrealtime();
#endif
            f32x4 accw[4], acca[4];
#pragma unroll
            for (int nt = 0; nt < 4; ++nt) { accw[nt] = (f32x4){0.f, 0.f, 0.f, 0.f}; acca[nt] = (f32x4){0.f, 0.f, 0.f, 0.f}; }
            { const float pz_ = (t0 + l15 == 0) ? 0.f : 1.f;
#pragma unroll
              for (int lo = 0; lo < 2; ++lo)
#pragma unroll
                for (int ks = 0; ks < 2; ++ks) { float s_[8];
                    const f32x4 m0 = *(const LAS f32x4*)(mixs + 64 * lo + 32 * ks + 8 * kg), m1 = *(const LAS f32x4*)(mixs + 64 * lo + 32 * ks + 8 * kg + 4);
                    RW_SH8(ld[(lo * 2 + ks) * 2], ld[(lo * 2 + ks) * 2 + 1], m0, m1, s_, pz_);
                    if (lo == 0) {
#pragma unroll
                        for (int j = 0; j < 8; ++j) s_[j] = tanh_fast(s_[j]); }
                    const bf16x8 af = pack8(s_[0], s_[1], s_[2], s_[3], s_[4], s_[5], s_[6], s_[7]);
                    const bf16_t* WT = lo ? A2T : W2T;
#pragma unroll
                    for (int nt = 0; nt < 4; ++nt) { const bf16x8 bfr = *(const bf16x8*)(WT + (size_t)(h * 64 + 16 * nt + l15) * 64 + 32 * ks + 8 * kg);
                        if (lo == 0) accw[nt] = MFMA16(af, bfr, accw[nt]); else acca[nt] = MFMA16(af, bfr, acca[nt]); } } }
#pragma unroll
            for (int ar = 0; ar < 3; ++ar)
#pragma unroll
                for (int i = 0; i < 2; ++i) { const int p_ = lane + 64 * i, row_ = p_ >> 3, c8_ = p_ & 7; float s_[8];
                    const float pz_ = (t0 + row_ == 0) ? 0.f : 1.f; const f32x4 m0 = *(const LAS f32x4*)(mixs + 256 + ar * 64 + c8_ * 8), m1 = *(const LAS f32x4*)(mixs + 256 + ar * 64 + c8_ * 8 + 4);
                    RW_SH8(ld[8 + (ar * 2 + i) * 2], ld[8 + (ar * 2 + i) * 2 + 1], m0, m1, s_, pz_);
                    *(LAS bf16x8*)(stg + ar * 1024 + row_ * 64 + c8_ * 8) = pack8(s_[0], s_[1], s_[2], s_[3], s_[4], s_[5], s_[6], s_[7]); }
            WSYNC();
#if defined(PROBE_STAMPS)
            if (blk == 0 && wave == 1 && lane == 0) ((volatile LAS unsigned*)(lds + 146432 + 320))[16 + 26] += (unsigned)__builtin_amdgcn_s_memrealtime() - ts0_;
#endif
#if defined(PROBE_STAMPS)
            const unsigned tb0_ = (unsigned)__builtin_amdgcn_s_memrealtime();
#endif
            { const int need = k - (CC_NSLOT - 1); if (need > 0) { while ((int)flags[8] < need || (int)flags[9] < need) __builtin_amdgcn_s_sleep(2); } }
#if defined(PROBE_STAMPS)
            if (blk == 0 && wave == 1 && lane == 0) ((volatile LAS unsigned*)(lds + 146432 + 320))[16 + 25] += (unsigned)__builtin_amdgcn_s_memrealtime() - tb0_;
#endif
            asm volatile("" ::: "memory");
            LAS unsigned char* im = lds + (k % CC_NSLOT) * CC_SLOT;
#if defined(PROBE_STAMPS)
            const unsigned ts1_ = (unsigned)__builtin_amdgcn_s_memrealtime();
#endif
            float lwv[4][4], av[4][4], knv[4][4];
            float w0c[4], a0c[4], kkc[4], kac[4], rkc[4];
#pragma unroll
            for (int nt = 0; nt < 4; ++nt) { const int c = h * 64 + 16 * nt + l15; w0c[nt] = w0[c]; a0c[nt] = a0[c]; kkc[nt] = k_k[c]; kac[nt] = k_a[c]; rkc[nt] = r_k[c]; }
#pragma unroll
            for (int rg = 0; rg < 4; ++rg) { const int tl = 4 * kg + rg;
                float kkv[4], nrm2 = 0.f, vv[4], rr_[4], kr_[4];
#pragma unroll
                for (int nt = 0; nt < 4; ++nt) { rr_[nt] = bf2f(stg[tl * 64 + 16 * nt + l15]); kr_[nt] = bf2f(stg[1024 + tl * 64 + 16 * nt + l15]); vv[nt] = bf2f(stg[2048 + tl * 64 + 16 * nt + l15]);
                    kkv[nt] = kr_[nt] * kkc[nt]; nrm2 += kkv[nt] * kkv[nt]; }
                nrm2 = rowsum16(nrm2); const float rn = __builtin_amdgcn_rsqf(fmaxf(nrm2, 1e-24f));
                float bon = 0.f;
#pragma unroll
                for (int nt = 0; nt < 4; ++nt) {
                    const float wsum = w0c[nt] + accw[nt][rg]; lwv[nt][rg] = -0.6065306597126334f * sigmoid_fast(wsum);
                    const float a_ = sigmoid_fast(a0c[nt] + acca[nt][rg]); av[nt][rg] = a_; knv[nt][rg] = kkv[nt] * rn;
                    const float k2 = kr_[nt] * (1.f + (a_ - 1.f) * kac[nt]); stg[1024 + tl * 64 + 16 * nt + l15] = bf1(k2);
                    bon += rr_[nt] * k2 * rkc[nt];
                    *(LAS bf16_t*)(im + CC_VT + (16 * nt + l15) * 40 + tl * 2) = bf1(vv[nt]);
                }
                bon = rowsum16(bon);
                if (l15 == 0) bonus_out[(rowb + t0 + tl) * 8 + h] = bon;
            }
            { unsigned g_ = 0; if (lane == 0) g_ = __hip_atomic_fetch_add((LAS unsigned*)(lds + CC_FLAGS + 40), 1u, __ATOMIC_RELAXED, __HIP_MEMORY_SCOPE_WORKGROUP);
              kn = (int)__builtin_amdgcn_readfirstlane(g_); }
            CC_ISSUE_A((kn < NCH) ? 16 * kn : t0);
#pragma unroll
            for (int nt = 0; nt < 4; ++nt) {
                float L[4]; L[0] = lwv[nt][0]; L[1] = L[0] + lwv[nt][1]; L[2] = L[1] + lwv[nt][2]; L[3] = L[2] + lwv[nt][3];
                const float T0 = __shfl(L[3], l15), T1 = __shfl(L[3], 16 + l15), T2 = __shfl(L[3], 32 + l15), T3 = __shfl(L[3], 48 + l15);
                const float off = (kg > 0 ? T0 : 0.f) + (kg > 1 ? T1 : 0.f) + (kg > 2 ? T2 : 0.f), LC = (T0 + T1) + (T2 + T3);
                const int j = 16 * nt + l15;
                unsigned bb2[2], kb2[2];
                const float gC = __expf(LC); float eprev = __expf(off);
#pragma unroll
                for (int rg = 0; rg < 4; ++rg) { const int tl = 4 * kg + rg; const float Lt = off + L[rg], e1 = __expf(Lt), e2 = __builtin_amdgcn_rcpf(e1), e3 = eprev, e4 = gC * e2; eprev = e1;
                    const float kn = knv[nt][rg], bvv = kn * av[nt][rg], k2 = bf2f(stg[1024 + tl * 64 + j]), rr2 = bf2f(stg[tl * 64 + j]);
                    *(LAS bf16_t*)(im + CC_BK + tl * 144 + j * 2) = bf1(bvv * e2); *(LAS bf16_t*)(im + CC_BK + (16 + tl) * 144 + j * 2) = bf1(k2 * e2);
                    *(LAS bf16_t*)(im + CC_AR + tl * 144 + j * 2) = bf1(-kn * e3); *(LAS bf16_t*)(im + CC_AR + (16 + tl) * 144 + j * 2) = bf1(rr2 * e1);
                    const unsigned bq = bf1(bvv * e4), kq = bf1(k2 * e4);
                    if (rg & 1) { bb2[rg >> 1] |= bq << 16; kb2[rg >> 1] |= kq << 16; } else { bb2[rg >> 1] = bq; kb2[rg >> 1] = kq; } }
                *(LAS u32x2*)(im + CC_BBT + j * 40 + (4 * kg) * 2) = (u32x2){bb2[0], bb2[1]}; *(LAS u32x2*)(im + CC_KBT + j * 40 + (4 * kg) * 2) = (u32x2){kb2[0], kb2[1]};
                if (kg == 0) *(LAS float*)(im + CC_GC + j * 4) = gC;
            }
            WSYNC();
#if defined(PROBE_STAMPS)
            const unsigned ts2_ = (unsigned)__builtin_amdgcn_s_memrealtime();
            if (blk == 0 && wave == 1 && lane == 0) ((volatile LAS unsigned*)(lds + 146432 + 320))[16 + 27] += ts2_ - ts1_;
#endif
            {
                f32x4 nacc = {0.f, 0.f, 0.f, 0.f};
#pragma unroll
                for (int ks = 0; ks < 2; ++ks) { const bf16x8 fa = *(const LAS bf16x8*)(im + CC_BK + l15 * 144 + (32 * ks + 8 * kg) * 2), fb = *(const LAS bf16x8*)(im + CC_AR + l15 * 144 + (32 * ks + 8 * kg) * 2); nacc = MFMA16(fa, fb, nacc); }
#pragma unroll
                for (int rg = 0; rg < 4; ++rg) nacc[rg] = ((4 * kg + rg) < l15) ? nacc[rg] : 0.f;
                float Tr[16];
#pragma unroll
                for (int t = 0; t < 16; ++t) { float acc_ = (l15 == t) ? 1.f : 0.f;
#pragma unroll
                    for (int s2 = 0; s2 < t; ++s2) acc_ += Tr[s2] * rl(nacc[s2 & 3], t + 16 * (s2 >> 2));
                    Tr[t] = acc_; }
                if (kg == 0) {
#pragma unroll
                    for (int t = 0; t < 16; ++t) *(LAS bf16_t*)(im + CC_TT + t * 40 + l15 * 2) = bf1(Tr[t]); }
            }
            WSYNC();
#if defined(PROBE_STAMPS)
            if (blk == 0 && wave == 1 && lane == 0) ((volatile LAS unsigned*)(lds + 146432 + 320))[16 + 28] += (unsigned)__builtin_amdgcn_s_memrealtime() - ts2_;
#endif
            if (lane == 0) flags[k % CC_NSLOT] = (unsigned)(k + 1);
            CC_ISSUE_B((kn < NCH) ? 16 * kn : t0);
            k = kn;
        }
#undef CC_ISSUE
#undef CC_ISSUE_A
#undef CC_ISSUE_B
    } else {
        v4u ld[8];
#define G_ISSUE(T0) do { const int t0_ = (T0); const size_t r_ = rowb + t0_ + l15; const size_t rp_ = (t0_ + l15 == 0) ? r_ : r_ - 1; \
            _Pragma("unroll") for (int ks = 0; ks < 4; ++ks) { const int col = 1664 + 32 * ks + 8 * kg; ld[2 * ks] = *(const v4u*)(proj + r_ * L0P + col); ld[2 * ks + 1] = *(const v4u*)(proj + rp_ * L0P + col); } } while (0)
        G_ISSUE(0);
#pragma unroll 1
        for (int k = 0; k < NCH; ++k) {
            const int t0 = 16 * k;
            f32x4 accg[4]; const float pz_ = (t0 + l15 == 0) ? 0.f : 1.f;
#pragma unroll
            for (int nt = 0; nt < 4; ++nt) accg[nt] = (f32x4){0.f, 0.f, 0.f, 0.f};
#pragma unroll
            for (int ks = 0; ks < 4; ++ks) { float s_[8];
                const f32x4 m0 = *(const LAS f32x4*)(mixs + 128 + 32 * ks + 8 * kg), m1 = *(const LAS f32x4*)(mixs + 128 + 32 * ks + 8 * kg + 4);
                RW_SH8(ld[2 * ks], ld[2 * ks + 1], m0, m1, s_, pz_);
#pragma unroll
                for (int j = 0; j < 8; ++j) s_[j] = sigmoid_fast(s_[j]);
                const bf16x8 af = pack8(s_[0], s_[1], s_[2], s_[3], s_[4], s_[5], s_[6], s_[7]);
#pragma unroll
                for (int nt = 0; nt < 4; ++nt) { const bf16x8 bfr = *(const bf16x8*)(G2T + (size_t)(h * 64 + 16 * nt + l15) * 128 + 32 * ks + 8 * kg); accg[nt] = MFMA16(af, bfr, accg[nt]); } }
            G_ISSUE((k + 1 < NCH) ? t0 + 16 : t0);
#pragma unroll
            for (int nt = 0; nt < 4; ++nt)
#pragma unroll
                for (int rg = 0; rg < 4; ++rg) gout[(rowb + t0 + 4 * kg + rg) * 512 + h * 64 + 16 * nt + l15] = bf1(accg[nt][rg]);
        }
#undef G_ISSUE
    }
#undef RW_SH8
    __syncthreads();
}


template <bool ST = true> __device__ __forceinline__ void rwkv_post_all(const float* __restrict__ yraw, const bf16_t* __restrict__ proj, const float* __restrict__ mix, const float* __restrict__ bonus, const bf16_t* __restrict__ gbuf,
                                              const float* __restrict__ ln_g, const float* __restrict__ ln_b, bf16_t* __restrict__ ymix, int gw, int NGW, int lane) {
    for (int m = gw; m < M; m += NGW) {
        const bool has_prev = (m & (SEQ - 1)) != 0;
        float y[8], cv[8], pv[8], gg[8], bo[8];
#pragma unroll
        for (int h = 0; h < 8; ++h) { const int c = h * 64 + lane; y[h] = yraw[(size_t)m * 512 + c]; cv[h] = bf2f(proj[(size_t)m * L0P + 1024 + c]);
            pv[h] = bf2f(proj[(size_t)(has_prev ? m - 1 : m) * L0P + 1024 + c]); gg[h] = bf2f(gbuf[(size_t)m * 512 + c]); bo[h] = bonus[(size_t)m * 8 + h]; }
#pragma unroll
        for (int h = 0; h < 8; ++h) { const int c = h * 64 + lane;
            const float mu = wave_sum_dpp(y[h]) * (1.f / 64.f), d = y[h] - mu, var = wave_sum_dpp(d * d) * (1.f / 64.f);
            const float yn = d * __builtin_amdgcn_rsqf(var + 64e-5f) * ln_g[c] + ln_b[c];
            const float pvv = has_prev ? pv[h] : 0.f;
            const float v_s = cv[h] + (pvv - cv[h]) * mix[1024 + c];
            const float o = (yn + bo[h] * v_s) * gg[h];
            if (ST) ymix[(size_t)m * DM + c] = bf1(o); else asm volatile("" :: "v"(o)); }
    }
}


__device__ __forceinline__ void ssd_conv_tile(int it, int lane, LAS bf16_t* scr, const bf16_t* __restrict__ proj, const float* __restrict__ cw, const float* __restrict__ cb,
                                              bf16_t* __restrict__ xbc, bf16_t* __restrict__ xst, bf16_t* __restrict__ bt) {
    const int tt = it >> 4, ct = it & 15, m0 = tt * 64, b = m0 >> 11, t0 = m0 & (SEQ - 1), c = ct * 64 + lane;
    const float w0 = cw[c], w1 = cw[1024 + c], w2 = cw[2048 + c], w3 = cw[3072 + c], bias = cb[c];
    const bf16_t* src = proj + (size_t)m0 * L0P + 2304 + c;
    bf16_t raw[67];
    const int lo = (t0 > 0) ? -3 : 0;
#pragma unroll
    for (int t = -3; t < 64; ++t) raw[t + 3] = src[(ptrdiff_t)((t < lo) ? lo : t) * L0P];
    float u3 = (t0 > 0) ? bf2f(raw[0]) : 0.f, u2 = (t0 > 0) ? bf2f(raw[1]) : 0.f, u1 = (t0 > 0) ? bf2f(raw[2]) : 0.f;
#pragma unroll
    for (int t = 0; t < 64; ++t) {
        const float u = bf2f(raw[t + 3]);
        const float y = bias + w0 * u3 + w1 * u2 + w2 * u1 + w3 * u;
        const bf16_t o = bf1(y * __builtin_amdgcn_rcpf(1.f + __expf(-y)));
        xbc[(size_t)(m0 + t) * 1024 + c] = o;
        scr[t * STG_PITCH + lane] = o;
        u3 = u2; u2 = u1; u1 = u;
    }
    WSYNC();
    if (ct < 12) {
        bf16_t* dst = (ct < 8) ? xst + ((size_t)(b * 8 + ct) * 64) * SEQ + t0 : bt + ((size_t)(b * 2 + ((ct - 8) >> 1)) * 128 + ((ct - 8) & 1) * 64) * SEQ + t0;
#pragma unroll
        for (int i = 0; i < 8; ++i) { const int d = i * 8 + (lane >> 3), tc = lane & 7; const LAS bf16_t* p = scr + (tc * 8) * STG_PITCH + d;
            v4u o; o.x = (unsigned)p[0] | ((unsigned)p[STG_PITCH] << 16); o.y = (unsigned)p[2 * STG_PITCH] | ((unsigned)p[3 * STG_PITCH] << 16);
            o.z = (unsigned)p[4 * STG_PITCH] | ((unsigned)p[5 * STG_PITCH] << 16); o.w = (unsigned)p[6 * STG_PITCH] | ((unsigned)p[7 * STG_PITCH] << 16);
            *(v4u*)(dst + (size_t)d * SEQ + tc * 8) = o; }
    }
    WSYNC();
}
__device__ __forceinline__ float bperm(int srclane, float x) { return __builtin_bit_cast(float, __builtin_amdgcn_ds_bpermute(srclane << 2, __builtin_bit_cast(int, x))); }
__device__ __forceinline__ void scan128(float& x0, float& x1, int lane) {
#pragma unroll
    for (int o = 1; o < 64; o <<= 1) { const int sl = (lane >= o) ? lane - o : lane; const float t0 = bperm(sl, x0), t1 = bperm(sl, x1); if (lane >= o) { x0 += t0; x1 += t1; } }
    x1 += rl(x0, 63);
}
__device__ __forceinline__ void ssd_s1_unit(int unit, int lane, LAS float* tab, const bf16_t* __restrict__ xst, const bf16_t* __restrict__ bt, const float* __restrict__ dt, const float* __restrict__ a_log,
                                            float* __restrict__ sloc, float* __restrict__ asum) {
    const int h = unit & 7, c = (unit >> 3) & 15, b = unit >> 7, g = h >> 2, l0 = c * 128, l31 = lane & 31, hi = lane >> 5;
    const size_t m0 = (size_t)b * SEQ + l0;
    const float A = -expf(a_log[h]);
    const float d0 = dt[(m0 + lane) * 8 + h], d1 = dt[(m0 + 64 + lane) * 8 + h];
    float ac0 = d0 * A, ac1 = d1 * A;
    scan128(ac0, ac1, lane);
    const float aend = rl(ac1, 63);
    tab[lane] = __expf(aend - ac0) * d0; tab[64 + lane] = __expf(aend - ac1) * d1;
    if (lane == 0) asum[unit] = aend;
    WSYNC();
    f32x16 acc[2][4];
#pragma unroll
    for (int pt = 0; pt < 2; ++pt)
#pragma unroll
        for (int nt = 0; nt < 4; ++nt)
#pragma unroll
            for (int r = 0; r < 16; ++r) acc[pt][nt][r] = 0.f;
    const bf16_t* Xp = xst + ((size_t)(b * 8 + h) * 64 + l31) * SEQ + l0 + 8 * hi;
    const bf16_t* Bp = bt + ((size_t)(b * 2 + g) * 128 + l31) * SEQ + l0 + 8 * hi;
#pragma unroll 2
    for (int kk = 0; kk < 8; ++kk) {
        const f32x4 wa = *(const LAS f32x4*)(tab + 16 * kk + 8 * hi), wb = *(const LAS f32x4*)(tab + 16 * kk + 8 * hi + 4);
        bf16x8 af[2], bfr[4];
#pragma unroll
        for (int pt = 0; pt < 2; ++pt) { const v4u raw = *(const v4u*)(Xp + (size_t)pt * 32 * SEQ + 16 * kk);
            v4u w; w.x = cvtpk(bflo(raw.x) * wa[0], bfhi(raw.x) * wa[1]); w.y = cvtpk(bflo(raw.y) * wa[2], bfhi(raw.y) * wa[3]);
            w.z = cvtpk(bflo(raw.z) * wb[0], bfhi(raw.z) * wb[1]); w.w = cvtpk(bflo(raw.w) * wb[2], bfhi(raw.w) * wb[3]); af[pt] = __builtin_bit_cast(bf16x8, w); }
#pragma unroll
        for (int nt = 0; nt < 4; ++nt) bfr[nt] = *(const bf16x8*)(Bp + (size_t)nt * 32 * SEQ + 16 * kk);
#pragma unroll
        for (int pt = 0; pt < 2; ++pt)
#pragma unroll
            for (int nt = 0; nt < 4; ++nt) acc[pt][nt] = MFMA32(af[pt], bfr[nt], acc[pt][nt]);
    }
    float* dst = sloc + (size_t)unit * 8192 + l31;
#pragma unroll
    for (int pt = 0; pt < 2; ++pt)
#pragma unroll
        for (int nt = 0; nt < 4; ++nt)
#pragma unroll
            for (int r = 0; r < 16; ++r) dst[(32 * pt + crow(r, hi)) * 128 + 32 * nt] = acc[pt][nt][r];
    WSYNC();
}
__device__ __forceinline__ void ssd_s2_all(const float* __restrict__ sloc, const float* __restrict__ asum, bf16_t* __restrict__ stb, int gtid, int NT) {
    for (int i = gtid; i < 128 * 2048; i += NT) {
        const int bh = i >> 11, e4 = i & 2047, b = bh >> 3, h = bh & 7;
        f32x4 run = {0.f, 0.f, 0.f, 0.f};
#pragma unroll 4
        for (int c = 0; c < 16; ++c) { const int unit = (b * 16 + c) * 8 + h; const f32x4 tmp = *(const f32x4*)(sloc + (size_t)unit * 8192 + e4 * 4);
            uint2 w; w.x = cvtpk(run[0], run[1]); w.y = cvtpk(run[2], run[3]); *(uint2*)(stb + (size_t)unit * 8192 + e4 * 4) = w;
            run = run * __expf(asum[unit]) + tmp; }
    }
}
__device__ __forceinline__ void ssd_s3_unit(int unit, int lane, LAS float* tab, const bf16_t* __restrict__ xbc, const bf16_t* __restrict__ xst, const bf16_t* __restrict__ stb, const float* __restrict__ dt,
                                            const float* __restrict__ a_log, const float* __restrict__ dsk, bf16_t* __restrict__ yssm) {
    const int h = unit & 7, c = (unit >> 3) & 15, b = unit >> 7, g = h >> 2, l0 = c * 128, l31 = lane & 31, hi = lane >> 5;
    const size_t m0 = (size_t)b * SEQ + l0;
    const float A = -expf(a_log[h]), D = dsk[h];
    const float d0 = dt[(m0 + lane) * 8 + h], d1 = dt[(m0 + 64 + lane) * 8 + h];
    float ac0 = d0 * A, ac1 = d1 * A;
    scan128(ac0, ac1, lane);
    tab[lane] = ac0; tab[64 + lane] = ac1; tab[128 + lane] = d0; tab[192 + lane] = d1;
    WSYNC();
    const bf16_t* Cp = xbc + (m0 + l31) * 1024 + 768 + g * 128 + 8 * hi;
    const bf16_t* Sp = stb + (size_t)unit * 8192 + l31 * 128 + 8 * hi;
    const bf16_t* Bp = xbc + (m0 + l31) * 1024 + 512 + g * 128 + 8 * hi;
    const bf16_t* Xp = xst + ((size_t)(b * 8 + h) * 64 + l31) * SEQ + l0 + 4 * hi;
    LAS float* tr = tab + 256;
    const int row = lane >> 1, p0 = (lane & 1) * 16;
#pragma unroll 1
    for (int lt = 0; lt < 4; ++lt) {
        f32x16 y[2];
#pragma unroll
        for (int r = 0; r < 16; ++r) { y[0][r] = 0.f; y[1][r] = 0.f; }
        const float acl = tab[32 * lt + l31];
        bf16x8 cfr[8];
#pragma unroll
        for (int kk = 0; kk < 8; ++kk) cfr[kk] = *(const bf16x8*)(Cp + (size_t)lt * 32 * 1024 + 16 * kk);
        {   bf16x8 s0[8], s1[8];
#pragma unroll
            for (int kk = 0; kk < 8; ++kk) { s0[kk] = *(const bf16x8*)(Sp + 16 * kk); s1[kk] = *(const bf16x8*)(Sp + 32 * 128 + 16 * kk); }
#pragma unroll
            for (int kk = 0; kk < 8; ++kk) { y[0] = MFMA32(s0[kk], cfr[kk], y[0]); y[1] = MFMA32(s1[kk], cfr[kk], y[1]); }
        }
        { const float el = __expf(acl);
#pragma unroll
          for (int r = 0; r < 16; ++r) { y[0][r] *= el; y[1][r] *= el; } }
#pragma unroll 1
        for (int st = 0; st <= lt; ++st) {
            bf16x8 bfr[8]; u32x2 xf[2][2][2];
#pragma unroll
            for (int kk = 0; kk < 8; ++kk) bfr[kk] = *(const bf16x8*)(Bp + (size_t)st * 32 * 1024 + 16 * kk);
#pragma unroll
            for (int pt = 0; pt < 2; ++pt)
#pragma unroll
                for (int ks = 0; ks < 2; ++ks) { const bf16_t* xp = Xp + (size_t)pt * 32 * SEQ + st * 32 + 16 * ks; xf[pt][ks][0] = *(const u32x2*)xp; xf[pt][ks][1] = *(const u32x2*)(xp + 8); }
            f32x16 cbt;
#pragma unroll
            for (int r = 0; r < 16; ++r) cbt[r] = 0.f;
#pragma unroll
            for (int kk = 0; kk < 8; ++kk) cbt = MFMA32(bfr[kk], cfr[kk], cbt);
#pragma unroll
            for (int r = 0; r < 16; ++r) { const int sl = 32 * st + crow(r, hi); const float acs = tab[sl], dts = tab[128 + sl];
                float v = cbt[r] * __expf(acl - acs) * dts; if (st == lt && crow(r, hi) > l31) v = 0.f; cbt[r] = v; }
            bf16x8 pf[2];
#pragma unroll
            for (int ks = 0; ks < 2; ++ks) pf[ks] = pack8(cbt[8 * ks], cbt[8 * ks + 1], cbt[8 * ks + 2], cbt[8 * ks + 3], cbt[8 * ks + 4], cbt[8 * ks + 5], cbt[8 * ks + 6], cbt[8 * ks + 7]);
#pragma unroll
            for (int pt = 0; pt < 2; ++pt)
#pragma unroll
                for (int ks = 0; ks < 2; ++ks) { v4u a; a.x = xf[pt][ks][0].x; a.y = xf[pt][ks][0].y; a.z = xf[pt][ks][1].x; a.w = xf[pt][ks][1].y; y[pt] = MFMA32(__builtin_bit_cast(bf16x8, a), pf[ks], y[pt]); }
        }
#pragma unroll
        for (int pt = 0; pt < 2; ++pt) {
#pragma unroll
            for (int r = 0; r < 16; ++r) tr[l31 * 33 + crow(r, hi)] = y[pt][r];
            WSYNC();
            const size_t m = m0 + 32 * lt + row;
            const v4u xa = *(const v4u*)(xbc + m * 1024 + h * 64 + 32 * pt + p0), xb = *(const v4u*)(xbc + m * 1024 + h * 64 + 32 * pt + p0 + 8);
            const unsigned xu[8] = {xa.x, xa.y, xa.z, xa.w, xb.x, xb.y, xb.z, xb.w};
            unsigned ow[8];
#pragma unroll
            for (int q = 0; q < 8; ++q) { const float v0 = tr[row * 33 + p0 + 2 * q] + D * bflo(xu[q]), v1 = tr[row * 33 + p0 + 2 * q + 1] + D * bfhi(xu[q]); ow[q] = cvtpk(v0, v1); }
            bf16_t* dst = yssm + m * 512 + h * 64 + 32 * pt + p0;
            *(v4u*)dst = (v4u){ow[0], ow[1], ow[2], ow[3]}; *(v4u*)(dst + 8) = (v4u){ow[4], ow[5], ow[6], ow[7]};
            WSYNC();
        }
    }
}

struct Args { const float* in[43]; float* out; unsigned char* ws; };
#define GEMM_PHASE(EPI, Aptr, LDA, Bptr, LDB, NN, KK, ...) do { pg8::Gemm g_{(Aptr), (Bptr), M, (NN), (KK), (LDA), (LDB)}; pg8::StaticOrder S_; S_.init(M, (NN), G, (int)blockIdx.x); \
        pg8::EPI E_{__VA_ARGS__}; pg8::gemm_phase<pg8::EPI, pg8::StaticOrder, true, true>(lds3, g_, S_, E_); } while (0)

__global__ void __launch_bounds__(NWAVES * 64, 2) fwd_mega(Args args) {
    extern __shared__ __attribute__((aligned(16))) unsigned char lds[];
    LAS unsigned char* lds3 = (LAS unsigned char*)lds;
    volatile LAS unsigned* MISC = (volatile LAS unsigned*)(lds3 + MISC_OFF);
    const int G = gridDim.x, NGW = G * NWAVES, NT = G * NWAVES * 64;
#define PHASE_IDS() int tid = threadIdx.x; asm volatile("" : "+v"(tid)); const int lane = tid & 63, wave = __builtin_amdgcn_readfirstlane(tid >> 6); const int gw = blockIdx.x * NWAVES + wave, gtid = blockIdx.x * (NWAVES * 64) + tid; (void)lane; (void)gw; (void)gtid
    unsigned char* ws = args.ws;
    gu32* ctl = (gu32*)(ws + WS_CTL);
    for (int u = threadIdx.x; u < (LDS_BYTES - LDSCTL_OFF) / 4; u += NWAVES * 64) ((LAS unsigned*)(lds3 + LDSCTL_OFF))[u] = 0u;
    __syncthreads();
    XcdBarrier bar = xcd_barrier_post((unsigned*)(ctl + CW_BAR), MISC + 8);
#if defined(PROBE_STAMPS)
    int nb_ = 0;
    if (blockIdx.x == 0 && threadIdx.x == 0) MISC[16] = (unsigned)__builtin_amdgcn_s_memrealtime();
#define GRID_BAR() do { xcd_barrier(bar); ++nb_; if (blockIdx.x == 0 && threadIdx.x == 0) MISC[16 + nb_] = (unsigned)__builtin_amdgcn_s_memrealtime(); } while (0)
#else
#define GRID_BAR() xcd_barrier(bar)
#endif
#define IN(i) (args.in[i])
    float* out = args.out;
    bf16_t* W0in = (bf16_t*)(ws + WS_W0IN); bf16_t* W0out = (bf16_t*)(ws + WS_W0OUT); bf16_t* Wup0 = (bf16_t*)(ws + WS_WUP0); bf16_t* Wdn0 = (bf16_t*)(ws + WS_WDN0);
    bf16_t* W1in = (bf16_t*)(ws + WS_W1IN); bf16_t* Wuq = (bf16_t*)(ws + WS_WUQ); bf16_t* Wukv = (bf16_t*)(ws + WS_WUKV); bf16_t* W1out = (bf16_t*)(ws + WS_W1OUT);
    bf16_t* Wup1 = (bf16_t*)(ws + WS_WUP1); bf16_t* Wdn1 = (bf16_t*)(ws + WS_WDN1);
    bf16_t* XB = (bf16_t*)(ws + WS_XB); bf16_t* YMIX = (bf16_t*)(ws + WS_YMIX); bf16_t* PROJ0 = (bf16_t*)(ws + WS_BIG);
    float* YRAW = out; bf16_t* YSSM = (bf16_t*)(out + (size_t)M * 512); bf16_t* STB = (bf16_t*)(out + (size_t)M * 768); bf16_t* XST = (bf16_t*)(ws + WS_XST); bf16_t* BT = (bf16_t*)(ws + WS_BT); float* ASUM = (float*)(ws + WS_ASUM); float* SLOC = (float*)(ws + WS_SLOC); float* DT = (float*)(ws + WS_DT); bf16_t* GB = (bf16_t*)(ws + WS_G); float* BONUS = (float*)(ws + WS_BONUS);
    bf16_t* W2T = (bf16_t*)(ws + WS_W2T); bf16_t* A2T = (bf16_t*)(ws + WS_A2T); bf16_t* G2T = (bf16_t*)(ws + WS_G2T); bf16_t* ACT = (bf16_t*)(ws + WS_GU); bf16_t* HALO = (bf16_t*)(ws + WS_GU + 176 * MiB);
    bf16_t* PROJ1 = (bf16_t*)(ws + WS_PROJ1); bf16_t* QM = (bf16_t*)(ws + WS_QM); bf16_t* KVM = (bf16_t*)(ws + WS_KVM); bf16_t* KPE = (bf16_t*)(ws + WS_KPE); float* RS = (float*)(ws + WS_RS); float* CSTAB = (float*)(ws + WS_CSTAB); float* STATS = (float*)(ws + WS_CSTAB + 4 * MiB); bf16_t* VTS = (bf16_t*)(ws + WS_VTS); bf16_t* VTM = (bf16_t*)(ws + WS_VTM);
    const int* pos = (const int*)args.in[1];

    {
        PHASE_IDS();
    {
        LAS float* scr = (LAS float*)(lds3 + wave * 16384); int trb = 0;
        transpose_matrix(IN(2), 1024, 3336, W0in, L0P, 1024, scr, gw, NGW, lane, nullptr, trb);
        transpose_matrix(IN(20), 1024, 1024, W0out, 1024, 1024, scr, gw, NGW, lane, nullptr, trb);
        transpose_matrix(IN(5), 64, 512, W2T, 512, 64, scr, gw, NGW, lane, nullptr, trb);
        transpose_matrix(IN(7), 64, 512, A2T, 512, 64, scr, gw, NGW, lane, nullptr, trb);
        transpose_matrix(IN(8), 128, 512, G2T, 512, 128, scr, gw, NGW, lane, nullptr, trb);
        const float* x = IN(0);
        {
            constexpr size_t TOT4 = (size_t)M * DM / 4;
            for (size_t i = gtid; i < TOT4; i += (size_t)NT * 8) {
                f32x4 v[8];
#pragma unroll
                for (int u = 0; u < 8; ++u) v[u] = *(const f32x4*)(x + (i + (size_t)u * NT) * 4);
#pragma unroll
                for (int u = 0; u < 8; ++u) { uint2 w; w.x = cvtpk(v[u][0], v[u][1]); w.y = cvtpk(v[u][2], v[u][3]); *(uint2*)(XB + (i + (size_t)u * NT) * 4) = w; }
            }
        }
    }
    }
    GRID_BAR();
    {
        PHASE_IDS();
    GEMM_PHASE(EpiBf16S, XB, DM, W0in, 1024, L0P, 1024, PROJ0, nullptr, L0P, 0);
    }
    GRID_BAR();
    {
        PHASE_IDS();
        const int blk = (int)blockIdx.x, m0 = blk * 128;
        {   LAS bf16_t* scr = (LAS bf16_t*)(lds3 + wave * 16384);
#pragma unroll 1
            for (int k = 0; k < 4; ++k) ssd_conv_tile((2 * blk + (k & 1)) * 16 + wave + 8 * (k >> 1), lane, scr, PROJ0, IN(14), IN(15), XB, XST, BT);
            for (int i = tid; i < 1024; i += NWAVES * 64) { const int m = m0 + (i >> 3); DT[(size_t)m * 8 + (i & 7)] = softplusf_(bf2f(PROJ0[(size_t)m * L0P + 3328 + (i & 7)]) + IN(16)[i & 7]); }
        }
        __syncthreads();
#if defined(PROBE_STAMPS)
        if (blockIdx.x == 0 && threadIdx.x == 0) MISC[16 + 29] = (unsigned)__builtin_amdgcn_s_memrealtime();
#endif
        ssd_s1_unit(blk * 8 + wave, lane, (LAS float*)(lds3 + wave * 16384), XST, BT, DT, IN(17), SLOC, ASUM);
    }
    GRID_BAR();
    {
        PHASE_IDS();
        ssd_s2_all(SLOC, ASUM, STB, gtid, NT);
    }
    GRID_BAR();
    {
        PHASE_IDS();
        const int blk = (int)blockIdx.x;
        if (blk < 128) {
            rwkv_phase_chain((LAS float*)lds3, tid, lane, wave, blk, PROJ0, IN(3), IN(4), IN(6), IN(9), IN(10), IN(11), W2T, A2T, G2T, YRAW, GB, BONUS);
        } else {
            const int bc0 = (blk - 128) * 2;
#if defined(PROBE_STAMPS)
            const unsigned tu0_ = (unsigned)__builtin_amdgcn_s_memrealtime();
#endif
#pragma unroll 1
            for (int u = 0; u < 2; ++u) ssd_s3_unit((bc0 + u) * 8 + wave, lane, (LAS float*)(lds3 + wave * 16384), XB, XST, STB, DT, IN(17), IN(18), YSSM);
            __syncthreads();
            ssm_gate_norm_all(YSSM, PROJ0, IN(19), YMIX, bc0 * 256 + wave, bc0 * 256 + 512, lane);
            { const int gwu = (blk - 128) * NWAVES + wave, NGWU = 128 * NWAVES; LAS float* scr = (LAS float*)(lds3 + wave * 16384); int trb = 0;
              transpose_matrix(IN(23), 1024, 5632, Wup0, 5632, 1024, scr, gwu, NGWU, lane, nullptr, trb, true);
              transpose_matrix(IN(26), 2816, 1024, Wdn0, 1024, 2816, scr, gwu, NGWU, lane, nullptr, trb);
            }
#if defined(PROBE_STAMPS)
            __syncthreads(); if (blk == 128 && threadIdx.x == 0) __hip_atomic_store(ctl + 2048, (unsigned)__builtin_amdgcn_s_memrealtime() - tu0_, __ATOMIC_RELAXED, __HIP_MEMORY_SCOPE_AGENT);
#endif
        }
    }
    GRID_BAR();
    {
        PHASE_IDS();
        rwkv_post_all(YRAW, PROJ0, IN(3), BONUS, GB, IN(12), IN(13), YMIX, gw, NGW, lane);
    }
    GRID_BAR();
    {
        PHASE_IDS();
    GEMM_PHASE(EpiResid, YMIX, DM, W0out, 1024, 1024, 1024, IN(0), out, ALPHA, 0);
    }
    GRID_BAR();
    {
        PHASE_IDS();
    ln_rows<1>(out, XB, STATS, IN(21), IN(22), gw, NGW, lane);
    }
    GRID_BAR();
    {
        PHASE_IDS();
        { pg8::Gemm g_{XB, Wup0, M / 32, DFF, 1024, DM, 1024, 4096, 8192, 256, 512, 1}; pg8::StaticOrder S_; S_.init(M / 32, DFF, G, (int)blockIdx.x);
          pg8::EpiBf16S E_{HALO, nullptr, DFF, 0}; pg8::gemm_phase<pg8::EpiBf16S, pg8::StaticOrder, true, true>(lds3, g_, S_, E_); }
        if ((int)blockIdx.x >= 44) {
            const int gwu = ((int)blockIdx.x - 44) * NWAVES + wave, NGWU = (G - 44) * NWAVES; LAS float* scr = (LAS float*)(lds3 + wave * 16384); int trb = 0;
            transpose_matrix(IN(29), 1024, 1952, W1in, L1P, 1024, scr, gwu, NGWU, lane, nullptr, trb);
            transpose_matrix(IN(31), 256, 768, Wuq, 768, 256, scr, gwu, NGWU, lane, IN(30), trb);
            transpose_matrix(IN(33), 128, 1024, Wukv, 1024, 256, scr, gwu, NGWU, lane, IN(32), trb);
            transpose_matrix(IN(34), 1024, 1024, W1out, 1024, 1024, scr, gwu, NGWU, lane, nullptr, trb);
            transpose_matrix(IN(37), 1024, 5632, Wup1, 5632, 1024, scr, gwu, NGWU, lane, nullptr, trb, true);
            transpose_matrix(IN(40), 2816, 1024, Wdn1, 1024, 2816, scr, gwu, NGWU, lane, nullptr, trb);
            for (int i = gwu * 64 + lane; i < 1024 * 16; i += NGWU * 64) { const int n = i >> 4, c = i & 15; *(v4u*)(Wukv + (size_t)n * 256 + 128 + c * 8) = (v4u){0u, 0u, 0u, 0u}; }
        }
    }
    GRID_BAR();
    {
        PHASE_IDS();
        { pg8::Gemm g_{XB, Wup0, M, 2 * DFF, 1024, DM, 1024}; pg8::StaticOrder S_; S_.init(M, 2 * DFF, G, (int)blockIdx.x);
          pg8::EpiConvAct E_{ACT, HALO, IN(24), IN(25), DFF, SEQ}; pg8::gemm_phase<pg8::EpiConvAct, pg8::StaticOrder, true, true>(lds3, g_, S_, E_); }
    }
    GRID_BAR();
    {
        PHASE_IDS();
    GEMM_PHASE(EpiResidLN, ACT, DFF, Wdn0, DFF, 1024, DFF, out, STATS, IN(21), IN(22), ALPHA, 0);
    }
    GRID_BAR();
    {
        PHASE_IDS();
    ln_rows<1>(out, XB, STATS, IN(27), IN(28), gw, NGW, lane);
    }
    GRID_BAR();
    {
        PHASE_IDS();
    GEMM_PHASE(EpiBf16S, XB, DM, W1in, 1024, L1P, 1024, PROJ1, nullptr, L1P, 0);
    }
    GRID_BAR();
    {
        PHASE_IDS();
    mla_prep_all(PROJ1, pos, RS, KPE, CSTAB, gw, NGW, lane);
    }
    GRID_BAR();
    {
        PHASE_IDS();
    GEMM_PHASE(EpiBf16S, PROJ1 + 1536, L1P, Wuq, 256, 768, 256, QM, RS, 768, 2);
    GEMM_PHASE(EpiBf16S, PROJ1 + 1792, L1P, Wukv, 256, 1024, 256, KVM, RS + 1, 1024, 2);
    }
    GRID_BAR();
    {
        PHASE_IDS();
    rope_q_all(QM, CSTAB, gtid, NT);
    {
        LAS bf16_t* scr = (LAS bf16_t*)(lds3 + wave * 16384);
        for (int it = gw; it < 8192; it += NGW) { const int which = it >> 12, r = it & 4095, bh = r >> 5, tt = r & 31, b = bh >> 3, h = bh & 7;
            if (which == 0) transpose_tile64(PROJ1 + ((size_t)b * SEQ + tt * 64) * L1P + 1024 + h * 64, L1P, VTS + (size_t)bh * 64 * SEQ + tt * 64, SEQ, scr, lane);
            else            transpose_tile64(KVM + ((size_t)b * SEQ + tt * 64) * 1024 + h * 128 + 64, 1024, VTM + (size_t)bh * 64 * SEQ + tt * 64, SEQ, scr, lane); }
    }
    }
    GRID_BAR();
    {
        PHASE_IDS();
    {
        { LAS unsigned char* wl = lds3 + wave * 16384;
          for (int g2 = gw; g2 < 2048; g2 += NGW) { const int bh = g2 >> 4, w = g2 & 15;
#pragma unroll 1
              for (int i = 0; i < 4; ++i) { const int qb = (i == 0) ? w : (i == 1) ? 31 - w : (i == 2) ? 32 + w : 63 - w; sb_wave(bh, qb, lane, PROJ1, VTS, YMIX, wl); } } }
        __syncthreads();
        for (int g2 = (int)blockIdx.x; g2 < 256; g2 += G) { const int bh = g2 >> 1, part = g2 & 1;
#pragma unroll 1
            for (int i = 0; i < 4; ++i) { const int sbk = part ? ((i == 0) ? 1 : (i == 1) ? 6 : (i == 2) ? 2 : 5) : ((i == 0) ? 0 : (i == 1) ? 7 : (i == 2) ? 3 : 4);
                mla_block(bh, sbk, tid, lane, wave, lds3, QM, KVM, KPE, VTM, YMIX); } }
    }
    }
    GRID_BAR();
    {
        PHASE_IDS();
    GEMM_PHASE(EpiResidLN, YMIX, DM, W1out, 1024, 1024, 1024, out, STATS, IN(27), IN(28), ALPHA, 0);
    }
    GRID_BAR();
    {
        PHASE_IDS();
    ln_rows<1>(out, XB, STATS, IN(35), IN(36), gw, NGW, lane);
    }
    GRID_BAR();
    {
        PHASE_IDS();
        { pg8::Gemm g_{XB, Wup1, M / 32, DFF, 1024, DM, 1024, 4096, 8192, 256, 512, 1}; pg8::StaticOrder S_; S_.init(M / 32, DFF, G, (int)blockIdx.x);
          pg8::EpiBf16S E_{HALO, nullptr, DFF, 0}; pg8::gemm_phase<pg8::EpiBf16S, pg8::StaticOrder, true, true>(lds3, g_, S_, E_); }
    }
    GRID_BAR();
    {
        PHASE_IDS();
        { pg8::Gemm g_{XB, Wup1, M, 2 * DFF, 1024, DM, 1024}; pg8::StaticOrder S_; S_.init(M, 2 * DFF, G, (int)blockIdx.x);
          pg8::EpiConvAct E_{ACT, HALO, IN(38), IN(39), DFF, SEQ}; pg8::gemm_phase<pg8::EpiConvAct, pg8::StaticOrder, true, true>(lds3, g_, S_, E_); }
    }
    GRID_BAR();
    {
        PHASE_IDS();
    GEMM_PHASE(EpiResidLN, ACT, DFF, Wdn1, DFF, 1024, DFF, out, STATS, IN(35), IN(36), ALPHA, 0);
    }
    GRID_BAR();
    {
        PHASE_IDS();
    ln_rows<2>(out, XB, STATS, IN(41), IN(42), gw, NGW, lane);
    #if defined(PROBE_STAMPS)
    __syncthreads();
    if (blockIdx.x == 0 && threadIdx.x == 0) {
        MISC[16 + 22] = (unsigned)__builtin_amdgcn_s_memrealtime();
#if defined(PROBE_GLOBAL)
        const unsigned d1 = __hip_atomic_load(ctl + 2048, __ATOMIC_RELAXED, __HIP_MEMORY_SCOPE_AGENT);
#elif defined(PROBE_ACC)
        const unsigned d1 = MISC[16 + PROBE_ACC];
#else
        const unsigned d1 = MISC[16 + PROBE_T1_HI] - MISC[16 + PROBE_T1_LO];
#endif
        const unsigned long long spin = 100ull * d1;
        const unsigned long long t0 = __builtin_amdgcn_s_memrealtime();
        while (__builtin_amdgcn_s_memrealtime() - t0 < spin) __builtin_amdgcn_s_sleep(8);
    }
#endif
}
}

extern "C" void kernel_launch(void* const* d_in, const int* in_sizes, int n_in, void* d_out, int out_size, void* d_ws, size_t ws_size, hipStream_t stream) {
    static int grid = 0;
    if (grid == 0) {
        if (n_in != 43 || ws_size < WS_NEED || out_size != M * DM) { fprintf(stderr, "kernel_launch: unexpected n_in %d / ws %zu / out %d\n", n_in, ws_size, out_size); grid = -1; return; }
        int dev = 0, cus = 0, per_cu = 0;
        if (hipGetDevice(&dev) != hipSuccess || hipDeviceGetAttribute(&cus, hipDeviceAttributeMultiprocessorCount, dev) != hipSuccess) { grid = -1; return; }
        if (hipFuncSetAttribute((const void*)fwd_mega, hipFuncAttributeMaxDynamicSharedMemorySize, LDS_BYTES) != hipSuccess) { fprintf(stderr, "kernel_launch: hipFuncSetAttribute failed\n"); grid = -1; return; }
        if (hipOccupancyMaxActiveBlocksPerMultiprocessor(&per_cu, (const void*)fwd_mega, NWAVES * 64, LDS_BYTES) != hipSuccess || per_cu < 1) fprintf(stderr, "kernel_launch: occupancy query reports %d\n", per_cu);
        (void)hipGetLastError();
        grid = cus;
    }
    if (grid < 0) return;
    (void)hipMemsetAsync((char*)d_ws + WS_CTL, 0, CTL_ZERO_BYTES, stream);
    Args a{};
    for (int i = 0; i < 43; ++i) a.in[i] = (const float*)d_in[i];
    a.out = (float*)d_out; a.ws = (unsigned char*)d_ws;
    hipLaunchKernelGGL(fwd_mega, dim3(grid), dim3(NWAVES * 64), LDS_BYTES, stream, a);
}
```

```cpp
#include <hip/hip_runtime.h>
#include <cstdio>
#include <cstdint>
#include <cmath>
namespace pg8 {
#define PG8_LAS __attribute__((address_space(3)))
typedef unsigned short bf16_t;
typedef short bf16x8 __attribute__((ext_vector_type(8)));
typedef float f32x4 __attribute__((ext_vector_type(4)));
typedef unsigned u32x4 __attribute__((ext_vector_type(4)));
constexpr int BM = 256, BK = 64, HALF = 128, HTB = HALF * BK * 2  , STAGE_BYTES = 8 * HTB, NXCD = 8, WGM = 8;

__host__ __device__ __forceinline__ int lds_byte(int r, int c) { const int st = (r >> 4) * 2 + (c >> 5), rr = r & 15, cc = c & 31, ob = rr * 64 + cc * 2; return st * 1024 + (ob ^ (((ob >> 9) & 1) << 5)); }
__host__ __device__ __forceinline__ void stage_rc(int b, int& R, int& C) { const int st = b / 1024, sb = b % 1024, swz = sb ^ (((sb >> 9) & 1) << 5); R = (st >> 1) * 16 + swz / 64; C = (st & 1) * 32 + (swz % 64) / 2; }
__host__ __device__ __forceinline__ int perm32(int rho) { const int n = rho >> 4, i = rho & 15; return 8 * (i >> 2) + 4 * n + (i & 3); }

struct Unit { int pm, pn; };
struct Gemm { const bf16_t* A; const bf16_t* Bt; int M, N, K, lda, ldb; int hrA = 128, trA = 256, hrB = 128, trB = 256, gatherA = 0; };

struct StaticOrder {
    int nM, nN, nwg, G, c;
    __host__ __device__ void init(int M, int N, int G_, int c_) { nM = M / BM; nN = N / BM; nwg = nM * nN; G = G_; c = c_; }
    __host__ __device__ bool next(int i, Unit& u) const {
        const long L = (long)i * G + c; if (L >= nwg) return false;
        int wgid = (int)L; { const int q = nwg / NXCD, r = nwg % NXCD, xcd = wgid % NXCD, off = wgid / NXCD; wgid = (xcd < r ? xcd * (q + 1) : r * (q + 1) + (xcd - r) * q) + off; }
        const int nig = WGM * nN, gid = wgid / nig, fm = gid * WGM, gsz = (nM - fm) < WGM ? (nM - fm) : WGM;
        u.pm = fm + ((wgid % nig) % gsz); u.pn = (wgid % nig) / gsz; return true;
    }
    __device__ __forceinline__ void a_ready(const Unit&) const {}
    __device__ __forceinline__ void done(const Unit&) const {}
};


__device__ __forceinline__ unsigned cvt_pk_bf16(float lo, float hi) { unsigned r; asm volatile("v_cvt_pk_bf16_f32 %0, %1, %2" : "=v"(r) : "v"(lo), "v"(hi)); return r; }
struct EpiBf16S {
    static constexpr bool PERM = true, AFTER_DRAIN = false;
    bf16_t* O; const float* rowscale; int ldc; int rs_stride;
    __device__ __forceinline__ void operator()(const f32x4 (&acc)[2][2][4][2], const Unit& u, int wr, int wc, int fr, int fq) const {
        const int row0 = u.pm * BM + wr * 64 + fr, col0 = u.pn * BM + wc * 32 + 8 * fq;
#pragma unroll
        for (int ai = 0; ai < 2; ++ai)
#pragma unroll
            for (int m = 0; m < 4; ++m) { const int row = row0 + ai * HALF + m * 16; const float sc = rowscale ? rowscale[(size_t)row * rs_stride] : 1.f;
                bf16_t* rowp = O + (size_t)row * ldc + col0;
#pragma unroll
                for (int bj = 0; bj < 2; ++bj) { const f32x4 v0 = acc[ai][bj][m][0] * sc, v1 = acc[ai][bj][m][1] * sc;
                    u32x4 w; w.x = cvt_pk_bf16(v0[0], v0[1]); w.y = cvt_pk_bf16(v0[2], v0[3]); w.z = cvt_pk_bf16(v1[0], v1[1]); w.w = cvt_pk_bf16(v1[2], v1[3]);
                    *(u32x4*)(rowp + bj * HALF) = w; } }
    }
};
struct EpiResid {
    static constexpr bool PERM = false, AFTER_DRAIN = false;
    const float* hin; float* hout; float alpha; int pad;
    __device__ __forceinline__ void operator()(const f32x4 (&acc)[2][2][4][2], const Unit& u, int wr, int wc, int fr, int fq) const {
        const int row0 = u.pm * BM + wr * 64 + fr, col0 = u.pn * BM + wc * 32 + 4 * fq;
#pragma unroll
        for (int ai = 0; ai < 2; ++ai)
#pragma unroll
            for (int m = 0; m < 4; ++m) { const size_t off = (size_t)(row0 + ai * HALF + m * 16) * 1024 + col0;
#pragma unroll
                for (int bj = 0; bj < 2; ++bj)
#pragma unroll
                    for (int n = 0; n < 2; ++n) { const size_t i = off + bj * HALF + n * 16; const f32x4 h = *(const f32x4*)(hin + i); *(f32x4*)(hout + i) = h * alpha + acc[ai][bj][m][n]; } }
    }
};

struct EpiResidLN {
    static constexpr bool PERM = false, AFTER_DRAIN = false;
    float* hio; const float* stats; const float* g; const float* b; float alpha; int pad;
    __device__ __forceinline__ void operator()(const f32x4 (&acc)[2][2][4][2], const Unit& u, int wr, int wc, int fr, int fq) const {
        const int row0 = u.pm * BM + wr * 64 + fr, col0 = u.pn * BM + wc * 32 + 4 * fq;
        f32x4 gg[2][2], bb[2][2];
#pragma unroll
        for (int bj = 0; bj < 2; ++bj)
#pragma unroll
            for (int n = 0; n < 2; ++n) { gg[bj][n] = *(const f32x4*)(g + col0 + bj * HALF + n * 16) * alpha; bb[bj][n] = *(const f32x4*)(b + col0 + bj * HALF + n * 16) * alpha; }
#pragma unroll
        for (int ai = 0; ai < 2; ++ai)
#pragma unroll
            for (int m = 0; m < 4; ++m) { const int row = row0 + ai * HALF + m * 16; const size_t off = (size_t)row * 1024 + col0;
                const float mu = stats[2 * row], rs = stats[2 * row + 1];
#pragma unroll
                for (int bj = 0; bj < 2; ++bj)
#pragma unroll
                    for (int n = 0; n < 2; ++n) { const size_t i = off + bj * HALF + n * 16; const f32x4 p = *(const f32x4*)(hio + i); *(f32x4*)(hio + i) = (p - mu) * rs * gg[bj][n] + bb[bj][n] + acc[ai][bj][m][n]; } }
    }
};

template <int CTRL> __device__ __forceinline__ float pg_dpp(float x) { return __builtin_bit_cast(float, __builtin_amdgcn_update_dpp(0, __builtin_bit_cast(int, x), CTRL, 0xF, 0xF, true)); }
struct EpiConvAct {
    static constexpr bool PERM = true, AFTER_DRAIN = false;
    bf16_t* act; const bf16_t* halo; const float* cw; const float* cb; int dff; int seq;
    __device__ __forceinline__ void operator()(const f32x4 (&acc)[2][2][4][2], const Unit& u, int wr, int wc, int fr, int fq) const {
        typedef unsigned u32x2e __attribute__((ext_vector_type(2)));
#pragma unroll
        for (int n = 0; n < 2; ++n) {
            const int ch0 = u.pn * 128 + wc * 32 + 8 * fq + 4 * n;
            const f32x4 w0 = *(const f32x4*)(cw + ch0), w1 = *(const f32x4*)(cw + dff + ch0), w2 = *(const f32x4*)(cw + 2 * dff + ch0), bb = *(const f32x4*)(cb + ch0);
#pragma unroll
            for (int ai = 0; ai < 2; ++ai) {
                const int rb64 = u.pm * BM + ai * HALF + wr * 64;
                f32x4 P = {0.f, 0.f, 0.f, 0.f};
                if ((rb64 & (seq - 1)) != 0 && fr >= 14) { const u32x2e hv = *(const u32x2e*)(halo + (size_t)(2 * (rb64 / 64 - 1) + (fr - 14)) * dff + ch0);
                    P[0] = __builtin_bit_cast(float, hv.x << 16); P[1] = __builtin_bit_cast(float, hv.x & 0xffff0000u); P[2] = __builtin_bit_cast(float, hv.y << 16); P[3] = __builtin_bit_cast(float, hv.y & 0xffff0000u); }
#pragma unroll
                for (int m = 0; m < 4; ++m) {
                    const f32x4 Gv = acc[ai][0][m][n], Uv = acc[ai][1][m][n];
                    float o[4];
#pragma unroll
                    for (int e = 0; e < 4; ++e) {
                        const float t1 = pg_dpp<0x111>(Gv[e]), t2 = pg_dpp<0x112>(Gv[e]), p1 = pg_dpp<0x10F>(P[e]), p2 = pg_dpp<0x10E>(P[e]);
                        const float g1 = (fr >= 1) ? t1 : p1, g2 = (fr >= 2) ? t2 : p2;
                        const float y = bb[e] + w0[e] * g2 + w1[e] * g1 + w2[e] * Gv[e];
                        o[e] = y * __builtin_amdgcn_rcpf(1.f + __builtin_amdgcn_exp2f(-1.4426950408889634f * y)) * Uv[e];
                    }
                    u32x2e w; w.x = cvt_pk_bf16(o[0], o[1]); w.y = cvt_pk_bf16(o[2], o[3]);
                    *(u32x2e*)(act + (size_t)(rb64 + m * 16 + fr) * dff + ch0) = w;
                    P = Gv;
                }
            }
        }
    }
};

template <class Epi, class Sched, bool ALIGN_EPI = false, bool SP2 = false>
__device__ __forceinline__ void gemm_phase(PG8_LAS unsigned char* lds, const Gemm g, const Sched& S, const Epi& E) {
    int tid = threadIdx.x; asm volatile("" : "+v"(tid));
    const int wid = __builtin_amdgcn_readfirstlane(tid >> 6), lane = tid & 63, wr = wid >> 2, wc = wid & 3, fr = lane & 15, fq = lane >> 4;
    const int K = g.K, nt = K / BK;
    unsigned voffA[2], voffB[2];
#pragma unroll
    for (int i = 0; i < 2; ++i) { int R, C; stage_rc(tid * 16 + i * 8192, R, C); const int Rb = Epi::PERM ? ((R & ~31) + perm32(R & 31)) : R;
        const int Ra = g.gatherA ? (64 * (R >> 1) + 62 + (R & 1)) : R;
        voffA[i] = (unsigned)(Ra * g.lda + C) * 2u; voffB[i] = (unsigned)(Rb * g.ldb + C) * 2u; }
    const size_t kstep = (size_t)(BK * 2);
    const size_t hstepA = (size_t)g.hrA * g.lda * 2, hstepB = (size_t)g.hrB * g.ldb * 2;
    const size_t tstepA = (size_t)g.trA * g.lda * 2, tstepB = (size_t)g.trB * g.ldb * 2;
    const unsigned ldsw = (unsigned)wid * 1024u;
    const int aoff = lds_byte(wr * 64 + fr, fq * 8), boff = lds_byte(wc * 32 + fr, fq * 8);
#define PG8_SA(b, h) (((b) * 2 + (h)) * HTB)
#define PG8_SB(b, h) ((4 + (b) * 2 + (h)) * HTB)
#define PG8_STAGE(bufoff, gbase, voff) do { _Pragma("unroll") for (int _i = 0; _i < 2; ++_i) \
        __builtin_amdgcn_global_load_lds((const unsigned*)((const char*)(gbase) + (voff)[_i]), (PG8_LAS unsigned*)(lds + (bufoff) + ldsw + _i * 8192), 16, 0, 0); } while (0)
#define PG8_LDA(dst, b, h) do { _Pragma("unroll") for (int m = 0; m < 4; ++m) _Pragma("unroll") for (int k = 0; k < 2; ++k) dst[m][k] = *(const PG8_LAS bf16x8*)(lds + PG8_SA(b, h) + aoff + m * 2048 + k * 1024); } while (0)
#define PG8_LDB(dst, b, h) do { _Pragma("unroll") for (int n = 0; n < 2; ++n) _Pragma("unroll") for (int k = 0; k < 2; ++k) dst[n][k] = *(const PG8_LAS bf16x8*)(lds + PG8_SB(b, h) + boff + n * 2048 + k * 1024); } while (0)
#define PG8_MMA(ai, bj, At, Bt) do { __builtin_amdgcn_s_setprio(1); _Pragma("unroll") for (int m = 0; m < 4; ++m) _Pragma("unroll") for (int n = 0; n < 2; ++n) _Pragma("unroll") for (int k = 0; k < 2; ++k) \
        acc[ai][bj][m][n] = __builtin_amdgcn_mfma_f32_16x16x32_bf16(Bt[n][k], At[m][k], acc[ai][bj][m][n], 0, 0, 0); __builtin_amdgcn_s_setprio(0); } while (0)
#define PG8_WAIT_V(n) asm volatile("s_waitcnt vmcnt(" #n ")" ::: "memory")
#define PG8_WAIT_L(n) asm volatile("s_waitcnt lgkmcnt(" #n ")" ::: "memory")
#define PG8_BAR __builtin_amdgcn_s_barrier()
#define PG8_SCHED __builtin_amdgcn_sched_barrier(0)
    Unit cur, nxt; int ui = 0;
    if (!S.next(0, cur)) return;
    f32x4 acc[2][2][4][2];
#pragma unroll
    for (int a = 0; a < 2; ++a)
#pragma unroll
        for (int b = 0; b < 2; ++b)
#pragma unroll
            for (int m = 0; m < 4; ++m)
#pragma unroll
                for (int n = 0; n < 2; ++n) acc[a][b][m][n] = (f32x4){0.f, 0.f, 0.f, 0.f};
    bf16x8 At[4][2], B0[2][2], B1[2][2];
    const char* cA = (const char*)g.A + (size_t)cur.pm * tstepA; const char* cB = (const char*)g.Bt + (size_t)cur.pn * tstepB;
    S.a_ready(cur);
    if constexpr (SP2) {
        PG8_STAGE(PG8_SB(0, 0), cB, voffB); PG8_STAGE(PG8_SB(0, 1), cB + hstepB, voffB); PG8_STAGE(PG8_SA(0, 0), cA, voffA); PG8_STAGE(PG8_SA(0, 1), cA + hstepA, voffA);
        if (wr == 1) PG8_BAR;
        PG8_WAIT_V(2); PG8_BAR;
        PG8_STAGE(PG8_SB(1, 0), cB + kstep, voffB); PG8_STAGE(PG8_SA(1, 0), cA + kstep, voffA); PG8_STAGE(PG8_SB(1, 1), cB + hstepB + kstep, voffB);
        PG8_WAIT_V(6); PG8_BAR;
    } else {
        PG8_STAGE(PG8_SB(0, 0), cB, voffB); PG8_STAGE(PG8_SA(0, 0), cA, voffA); PG8_STAGE(PG8_SB(0, 1), cB + hstepB, voffB); PG8_STAGE(PG8_SA(0, 1), cA + hstepA, voffA);
        if (wr == 1) PG8_BAR;
        PG8_WAIT_V(4); PG8_BAR;
        PG8_STAGE(PG8_SB(1, 0), cB + kstep, voffB); PG8_STAGE(PG8_SA(1, 0), cA + kstep, voffA); PG8_STAGE(PG8_SB(1, 1), cB + hstepB + kstep, voffB);
        PG8_WAIT_V(6); PG8_BAR;
    }
    for (;;) {
        const bool has_next = S.next(ui + 1, nxt);
        const char* nA = has_next ? (const char*)g.A + (size_t)nxt.pm * tstepA : cA; const char* nB = has_next ? (const char*)g.Bt + (size_t)nxt.pn * tstepB : cB;
        for (int t = 0; t < nt; t += 2) {
            const bool last = (t == nt - 2);
            const char* a1 = cA + (size_t)(t + 1) * kstep;
            const char* a2 = last ? nA : cA + (size_t)(t + 2) * kstep; const char* b2 = last ? nB : cB + (size_t)(t + 2) * kstep;
            const char* a3 = a2 + kstep; const char* b3 = b2 + kstep;
            if (last && has_next) S.a_ready(nxt);
            if constexpr (SP2) {
            PG8_LDB(B0, 0, 0); PG8_LDB(B1, 0, 1); PG8_SCHED; PG8_LDA(At, 0, 0); PG8_STAGE(PG8_SA(1, 1), a1 + hstepA, voffA);
            PG8_WAIT_V(8); PG8_WAIT_L(0); PG8_BAR; PG8_MMA(0, 0, At, B0); PG8_MMA(0, 1, At, B1); PG8_BAR; PG8_SCHED;
            PG8_LDA(At, 0, 1); PG8_STAGE(PG8_SB(0, 0), b2, voffB); PG8_STAGE(PG8_SB(0, 1), b2 + hstepB, voffB); PG8_STAGE(PG8_SA(0, 0), a2, voffA);
            PG8_WAIT_V(8); PG8_WAIT_L(0); PG8_BAR; PG8_MMA(1, 0, At, B0); PG8_MMA(1, 1, At, B1); PG8_BAR; PG8_SCHED;
            PG8_LDB(B0, 1, 0); PG8_LDB(B1, 1, 1); PG8_SCHED; PG8_LDA(At, 1, 0); PG8_STAGE(PG8_SA(0, 1), a2 + hstepA, voffA);
            PG8_WAIT_V(8); PG8_WAIT_L(0); PG8_BAR; PG8_MMA(0, 0, At, B0); PG8_MMA(0, 1, At, B1); PG8_BAR; PG8_SCHED;
            PG8_LDA(At, 1, 1); PG8_STAGE(PG8_SB(1, 0), b3, voffB); PG8_STAGE(PG8_SB(1, 1), b3 + hstepB, voffB); PG8_STAGE(PG8_SA(1, 0), a3, voffA);
            PG8_WAIT_V(8); PG8_WAIT_L(0); PG8_BAR; PG8_MMA(1, 0, At, B0); PG8_MMA(1, 1, At, B1); PG8_BAR; PG8_SCHED;
            } else {
            PG8_LDB(B0, 0, 0); PG8_SCHED; PG8_LDA(At, 0, 0); PG8_STAGE(PG8_SA(1, 1), a1 + hstepA, voffA);
            PG8_WAIT_L(8); PG8_BAR; PG8_WAIT_L(0); PG8_MMA(0, 0, At, B0); PG8_BAR; PG8_SCHED;
            PG8_LDB(B1, 0, 1); PG8_STAGE(PG8_SB(0, 0), b2, voffB);
            PG8_BAR; PG8_WAIT_L(0); PG8_MMA(0, 1, At, B1); PG8_BAR;
            PG8_LDA(At, 0, 1); PG8_STAGE(PG8_SA(0, 0), a2, voffA);
            PG8_BAR; PG8_WAIT_L(0); PG8_MMA(1, 0, At, B0); PG8_BAR; PG8_SCHED;
            PG8_STAGE(PG8_SB(0, 1), b2 + hstepB, voffB);
            PG8_WAIT_V(6); PG8_BAR; PG8_MMA(1, 1, At, B1); PG8_BAR;
            PG8_LDB(B0, 1, 0); PG8_SCHED; PG8_LDA(At, 1, 0); PG8_STAGE(PG8_SA(0, 1), a2 + hstepA, voffA);
            PG8_WAIT_L(8); PG8_BAR; PG8_WAIT_L(0); PG8_MMA(0, 0, At, B0); PG8_BAR; PG8_SCHED;
            PG8_LDB(B1, 1, 1); PG8_STAGE(PG8_SB(1, 0), b3, voffB);
            PG8_BAR; PG8_WAIT_L(0); PG8_MMA(0, 1, At, B1); PG8_BAR;
            PG8_LDA(At, 1, 1); PG8_STAGE(PG8_SA(1, 0), a3, voffA);
            PG8_BAR; PG8_WAIT_L(0); PG8_MMA(1, 0, At, B0); PG8_BAR; PG8_SCHED;
            PG8_STAGE(PG8_SB(1, 1), b3 + hstepB, voffB);
            PG8_WAIT_V(6); PG8_BAR; PG8_MMA(1, 1, At, B1); PG8_BAR;
            }
        }
        if constexpr (ALIGN_EPI) { if (wr == 0) PG8_BAR; }
        if constexpr (!Epi::AFTER_DRAIN) { E(acc, cur, wr, wc, fr, fq); S.done(cur); }
        if (!has_next) break;
#pragma unroll
        for (int a = 0; a < 2; ++a)
#pragma unroll
            for (int b = 0; b < 2; ++b)
#pragma unroll
                for (int m = 0; m < 4; ++m)
#pragma unroll
                    for (int n = 0; n < 2; ++n) acc[a][b][m][n] = (f32x4){0.f, 0.f, 0.f, 0.f};
        cur = nxt; cA = nA; cB = nB; ++ui;
        if constexpr (ALIGN_EPI) { if (wr == 1) PG8_BAR; }
    }
    PG8_WAIT_V(0);
    if constexpr (!ALIGN_EPI) { if (wr == 0) PG8_BAR; }
    PG8_BAR;
    if constexpr (Epi::AFTER_DRAIN) { E.fused(acc, cur, wr, wc, fr, fq, lds, wid, lane); S.done(cur); }
#undef PG8_SA
#undef PG8_SB
#undef PG8_STAGE
#undef PG8_LDA
#undef PG8_LDB
#undef PG8_MMA
#undef PG8_WAIT_V
#undef PG8_WAIT_L
#undef PG8_BAR
#undef PG8_SCHED
}
}
#define GAS __attribute__((address_space(1)))
#define LAS __attribute__((address_space(3)))
typedef unsigned short bf16;
typedef unsigned v4u __attribute__((ext_vector_type(4)));
typedef float f32x4 __attribute__((ext_vector_type(4)));
typedef short bf16x8 __attribute__((ext_vector_type(8)));
typedef GAS unsigned gu32;
typedef GAS unsigned long long gu64;
#define RLX_AGENT __ATOMIC_RELAXED, __HIP_MEMORY_SCOPE_AGENT
#define LDS_WAIT() asm volatile("s_waitcnt lgkmcnt(0)" ::: "memory")
#define VM_WAIT() asm volatile("s_waitcnt vmcnt(0)" ::: "memory")
__device__ __forceinline__ unsigned long long rt() { return __builtin_amdgcn_s_memrealtime(); }
__device__ __forceinline__ unsigned f2bf(float f) { unsigned u = __builtin_bit_cast(unsigned, f); return (u + 0x7fffu + ((u >> 16) & 1u)) >> 16; }
__device__ __forceinline__ unsigned pk2(float lo, float hi) { return f2bf(lo) | (f2bf(hi) << 16); }

#define XB_TMO      128
#define XB_XCNT(j)  (256  + 64 * (j))
#define XB_XSUB(j)  (1280 + 64 * (j))
#define XB_XGEN(j)  (2304 + 64 * (j))
#define XB_TOP      3328
#define XB_TOPGEN   3392
#define XCD_BAR_WORDS 3456
#define XB_SPIN_CAP (1u << 18)

__device__ __forceinline__ unsigned xb_ld(unsigned* p)              { return __hip_atomic_load(p, __ATOMIC_RELAXED, __HIP_MEMORY_SCOPE_AGENT); }
__device__ __forceinline__ unsigned xb_add(unsigned* p, unsigned v) { return __hip_atomic_fetch_add(p, v, __ATOMIC_RELAXED, __HIP_MEMORY_SCOPE_AGENT); }
__device__ __forceinline__ unsigned xb_xcc_id() { return (unsigned)__builtin_amdgcn_s_getreg((3 << 11) | 20) & 0xFu; }
#define XB_SPIN(cond, bar) do { unsigned _sp = 0; while (cond) { __builtin_amdgcn_s_sleep(1); \
    if ((++_sp & 255u) == 0u) { if (xb_ld(&(bar)[XB_TMO])) break; if (_sp > XB_SPIN_CAP) { atomicAdd(&(bar)[XB_TMO], 1u); break; } } } } while (0)

struct XcdBarrier {
    unsigned* bar; unsigned x;
    volatile LAS unsigned* st;
};

__device__ __forceinline__ XcdBarrier xcd_barrier_post(unsigned* bar, volatile LAS unsigned* st) {
    XcdBarrier b; b.bar = bar; b.x = xb_xcc_id(); b.st = st;
    if (threadIdx.x == 0) (void)xb_add(&bar[XB_XCNT(b.x)], 1u);
    return b;
}
__device__ __forceinline__ void xcd_barrier_complete(unsigned* bar, unsigned x, unsigned& nloc, unsigned& nx) {
    const unsigned G = gridDim.x * gridDim.y * gridDim.z;
    unsigned sum, cnt, mine, sp = 0u;
    for (;;) {
        sum = 0u; cnt = 0u; mine = 0u;
#pragma unroll
        for (unsigned j = 0; j < 16; ++j) { const unsigned c = xb_ld(&bar[XB_XCNT(j)]); sum += c; cnt += (c > 0u) ? 1u : 0u; mine = (j == x) ? c : mine; }
        if (sum == G) break;
        __builtin_amdgcn_s_sleep(1);
        if ((++sp & 255u) == 0u) { if (xb_ld(&bar[XB_TMO])) break; if (sp > XB_SPIN_CAP) { atomicAdd(&bar[XB_TMO], 1u); break; } }
    }
    nloc = mine > 0u ? mine : 1u; nx = cnt > 0u ? cnt : 1u;
}

__device__ __forceinline__ void xcd_barrier(const XcdBarrier& b) {
    asm volatile("s_waitcnt vmcnt(0)" ::: "memory");
    __syncthreads();
    if (threadIdx.x == 0) {
        unsigned* bar = b.bar;
        __builtin_amdgcn_s_waitcnt(0);
        unsigned nloc = b.st[0], nx = b.st[1];
        if (nloc == 0u) { xcd_barrier_complete(bar, b.x, nloc, nx); b.st[0] = nloc; b.st[1] = nx; }
        const unsigned old = xb_add(&bar[XB_XSUB(b.x)], 1u);
        const unsigned gen = old / nloc;
        if (old + 1u == (gen + 1u) * nloc) {
            __builtin_amdgcn_fence(__ATOMIC_RELEASE, "agent");
            asm volatile("s_waitcnt vmcnt(0)" ::: "memory");
            const unsigned og = xb_add(&bar[XB_TOP], 1u);
            const unsigned tg = og / nx;
            if (og + 1u == (tg + 1u) * nx) xb_add(&bar[XB_TOPGEN], 1u);
            else XB_SPIN(xb_ld(&bar[XB_TOPGEN]) == tg, bar);
            __builtin_amdgcn_fence(__ATOMIC_ACQUIRE, "agent");
            xb_add(&bar[XB_XGEN(b.x)], 1u);
            asm volatile("s_waitcnt vmcnt(0)" ::: "memory");
        } else {
            XB_SPIN(xb_ld(&bar[XB_XGEN(b.x)]) == gen, bar);
            __builtin_amdgcn_fence(__ATOMIC_ACQUIRE, "agent");
            asm volatile("s_waitcnt vmcnt(0)" ::: "memory");
        }
    }
    __syncthreads();
}
constexpr int NWAVES = 8;
constexpr int BATCH = 16, SEQ = 2048, DM = 1024, M = BATCH * SEQ;
constexpr int L0P = 3584;
constexpr int L1P = 2048;
constexpr int DFF = 2816;
constexpr float ALPHA = 1.4142135623730951f;
typedef unsigned short bf16_t;
typedef float f32x16 __attribute__((ext_vector_type(16)));

constexpr size_t MiB = 1u << 20;
constexpr size_t WS_CTL = 0, CTL_ZERO_BYTES = 1 * MiB;
constexpr int CW_BAR = 4096;
constexpr size_t WS_W0IN = 2 * MiB, WS_W0OUT = 9 * MiB, WS_WUP0 = 11 * MiB, WS_WDN0 = 22 * MiB, WS_W1IN = 28 * MiB, WS_WUQ = 32 * MiB, WS_WUKV = 33 * MiB,
                 WS_W1OUT = 34 * MiB, WS_WUP1 = 36 * MiB, WS_WDN1 = 47 * MiB;
constexpr size_t WS_XB = 56 * MiB, WS_YMIX = 120 * MiB, WS_BIG = 184 * MiB;
constexpr size_t WS_G = 408 * MiB, WS_BONUS = 440 * MiB, WS_DT = 441 * MiB, WS_XST = 442 * MiB, WS_BT = 474 * MiB, WS_ASUM = 490 * MiB;
constexpr size_t WS_SLOC = 120 * MiB;
constexpr size_t WS_W2T = 53 * MiB, WS_A2T = 53 * MiB + 256 * 1024, WS_G2T = 53 * MiB + 512 * 1024;
constexpr size_t WS_GU = 120 * MiB;
constexpr size_t WS_PROJ1 = 184 * MiB, WS_QM = 312 * MiB, WS_KVM = 360 * MiB, WS_KPE = 424 * MiB, WS_RS = 426 * MiB;
constexpr size_t WS_CSTAB = 492 * MiB;
constexpr size_t WS_VTS = 428 * MiB, WS_VTM = 460 * MiB;
constexpr size_t WS_NEED = 497 * MiB;

constexpr int RING_BYTES = 131072;
constexpr int LDSCTL_OFF = 146432, MISC_OFF = LDSCTL_OFF + 320;
constexpr int LDS_BYTES = 147456;

__device__ __forceinline__ float bf2f(bf16_t b) { return __builtin_bit_cast(float, (unsigned)b << 16); }
__device__ __forceinline__ float sigmoidf_(float x) { return 1.f / (1.f + expf(-x)); }
__device__ __forceinline__ float softplusf_(float x) { return fmaxf(x, 0.f) + log1pf(expf(-fabsf(x))); }
__device__ __forceinline__ float siluf_(float x) { return x / (1.f + expf(-x)); }
__device__ __forceinline__ float wave_sum(float v) {
#pragma unroll
    for (int o = 1; o < 64; o <<= 1) v += __shfl_xor(v, o);
    return v;
}
#define WSYNC() asm volatile("s_waitcnt lgkmcnt(0)" ::: "memory")
typedef float f32x2_t __attribute__((ext_vector_type(2)));
typedef __bf16 bf16x2_t __attribute__((ext_vector_type(2)));
typedef unsigned u32x2 __attribute__((ext_vector_type(2)));
__device__ __forceinline__ unsigned cvtpk(float lo, float hi) { f32x2_t v = {lo, hi}; bf16x2_t b = __builtin_convertvector(v, bf16x2_t); return __builtin_bit_cast(unsigned, b); }
__device__ __forceinline__ float bflo(unsigned u) { return __builtin_bit_cast(float, u << 16); }
__device__ __forceinline__ float bfhi(unsigned u) { return __builtin_bit_cast(float, u & 0xffff0000u); }
__device__ __forceinline__ bf16_t bf1(float x) { return (bf16_t)(cvtpk(x, x) & 0xffffu); }
__device__ __forceinline__ bf16x8 pack8(float a0, float a1, float a2, float a3, float a4, float a5, float a6, float a7) {
    v4u w; w.x = cvtpk(a0, a1); w.y = cvtpk(a2, a3); w.z = cvtpk(a4, a5); w.w = cvtpk(a6, a7); return __builtin_bit_cast(bf16x8, w); }
template <int CTRL> __device__ __forceinline__ float dpp_mov(float x) { return __builtin_bit_cast(float, __builtin_amdgcn_update_dpp(0, __builtin_bit_cast(int, x), CTRL, 0xF, 0xF, true)); }
__device__ __forceinline__ float rowsum16(float x) { x += dpp_mov<0x128>(x); x += dpp_mov<0x124>(x); x += dpp_mov<0x122>(x); x += dpp_mov<0x121>(x); return x; }
__device__ __forceinline__ float rl(float x, int l) { return __builtin_bit_cast(float, __builtin_amdgcn_readlane(__builtin_bit_cast(int, x), l)); }
__device__ __forceinline__ float wave_sum_dpp(float x) { x = rowsum16(x); return (rl(x, 0) + rl(x, 16)) + (rl(x, 32) + rl(x, 48)); }

__device__ __forceinline__ void transpose_matrix(const float* __restrict__ W, int K, int N, bf16_t* __restrict__ WT, int Npad, int ldt, LAS float* scr, int gw, int NGW, int lane, const float* __restrict__ kscale, int& tr_base, bool ffn_interleave = false) {
    (void)scr;
    const int nblk = Npad / 64, nit = (K / 64) * nblk;
    int it0 = gw - (tr_base % NGW); if (it0 < 0) it0 += NGW; tr_base += nit;
    for (int it = it0; it < nit; it += NGW) {
        const int kb = it / nblk, nb = it - kb * nblk, n = nb * 64 + lane, k0 = kb * 64;
        const bool ok = n < N; const float* src = W + (size_t)k0 * N + (ok ? n : 0);
#pragma unroll
        for (int hc = 0; hc < 2; ++hc) {
            float v[32];
#pragma unroll
            for (int i = 0; i < 32; ++i) v[i] = src[(size_t)(hc * 32 + i) * N];
#pragma unroll
            for (int c = 0; c < 4; ++c) { float u[8];
#pragma unroll
                for (int i = 0; i < 8; ++i) { u[i] = ok ? v[c * 8 + i] : 0.f; if (kscale) u[i] *= kscale[k0 + hc * 32 + c * 8 + i]; }
                v4u o; o.x = cvtpk(u[0], u[1]); o.y = cvtpk(u[2], u[3]); o.z = cvtpk(u[4], u[5]); o.w = cvtpk(u[6], u[7]);
                const int nr = ffn_interleave ? ((n < DFF) ? 256 * (n >> 7) + (n & 127) : 256 * ((n - DFF) >> 7) + 128 + ((n - DFF) & 127)) : n;
                *(v4u*)(WT + (size_t)nr * ldt + k0 + hc * 32 + c * 8) = o; }
        }
    }
}

template <int MODE> __device__ __forceinline__ void ln_rows(float* h, bf16_t* hb, float* stats, const float* __restrict__ g, const float* __restrict__ b, int gw, int NGW, int lane) {
    for (int row = gw * 2; row < M; row += NGW * 2) {
        float* p = h + (size_t)row * DM;
        f32x4 v[2][4]; float s[2] = {0.f, 0.f};
#pragma unroll
        for (int r = 0; r < 2; ++r)
#pragma unroll
            for (int j = 0; j < 4; ++j) v[r][j] = *(const f32x4*)(p + r * DM + 4 * lane + 256 * j);
#pragma unroll
        for (int r = 0; r < 2; ++r)
#pragma unroll
            for (int j = 0; j < 4; ++j) s[r] += (v[r][j][0] + v[r][j][1]) + (v[r][j][2] + v[r][j][3]);
        float mean[2], q[2] = {0.f, 0.f}, rstd[2];
#pragma unroll
        for (int r = 0; r < 2; ++r) { mean[r] = wave_sum_dpp(s[r]) * (1.f / DM);
#pragma unroll
            for (int j = 0; j < 4; ++j) { v[r][j] = v[r][j] - mean[r]; q[r] += (v[r][j][0] * v[r][j][0] + v[r][j][1] * v[r][j][1]) + (v[r][j][2] * v[r][j][2] + v[r][j][3] * v[r][j][3]); } }
#pragma unroll
        for (int r = 0; r < 2; ++r) rstd[r] = 1.0f / sqrtf(wave_sum_dpp(q[r]) * (1.f / DM) + 1e-5f);
        if (MODE == 1 && lane < 2) { stats[2 * (row + lane)] = lane ? mean[1] : mean[0]; stats[2 * (row + lane) + 1] = lane ? rstd[1] : rstd[0]; }
#pragma unroll
        for (int j = 0; j < 4; ++j) {
            const int c = 4 * lane + 256 * j;
            const f32x4 gg = *(const f32x4*)(g + c), bb = *(const f32x4*)(b + c);
#pragma unroll
            for (int r = 0; r < 2; ++r) {
                const f32x4 o = v[r][j] * rstd[r] * gg + bb;
                if (MODE == 1) { uint2 w; w.x = cvtpk(o[0], o[1]); w.y = cvtpk(o[2], o[3]); *(uint2*)(hb + (size_t)(row + r) * DM + c) = w; }
                else *(f32x4*)(p + r * DM + c) = o;
            }
        }
    }
}

__device__ __forceinline__ void rwkv_naive_chain(int chain, int lane, LAS float* sm, const bf16_t* __restrict__ proj, const float* __restrict__ mix, const float* __restrict__ w0, const float* __restrict__ w2,
                                                 const float* __restrict__ a0, const float* __restrict__ a2, const float* __restrict__ g2, const float* __restrict__ k_k,
                                                 const float* __restrict__ k_a, const float* __restrict__ r_k, const float* __restrict__ ln_g, const float* __restrict__ ln_b, bf16_t* __restrict__ ymix) {
    LAS float* s_w2 = sm; LAS float* s_a2 = sm + 4096; LAS float* s_g2 = sm + 8192; LAS float* s_tw = sm + 16384; LAS float* s_al = s_tw + 64; LAS float* s_sg = s_tw + 128;
    LAS float* s_w = s_tw + 256; LAS float* s_k = s_tw + 320; LAS float* s_a = s_tw + 384; LAS float* s_b = s_tw + 448; LAS float* s_r = s_tw + 512;
    const int b = chain >> 3, h = chain & 7, c = h * 64 + lane;
    for (int l = 0; l < 64; ++l) { s_w2[l * 64 + lane] = w2[l * 512 + c]; s_a2[l * 64 + lane] = a2[l * 512 + c]; }
    for (int l = 0; l < 128; ++l) s_g2[l * 64 + lane] = g2[l * 512 + c];
    const float mr = mix[c], mk = mix[512 + c], mv = mix[1024 + c], mw = mix[1536 + lane], ma = mix[1600 + lane], mg0 = mix[1664 + lane], mg1 = mix[1728 + lane];
    const float w0c = w0[c], a0c = a0[c], kkc = k_k[c], kac = k_a[c], rkc = r_k[c], lgc = ln_g[c], lbc = ln_b[c];
    float S[64];
#pragma unroll
    for (int j = 0; j < 64; ++j) S[j] = 0.f;
    float pr = 0.f, pk = 0.f, pv = 0.f, pw = 0.f, pa = 0.f, pg0 = 0.f, pg1 = 0.f;
    WSYNC();
    for (int t = 0; t < SEQ; ++t) {
        const bf16_t* row = proj + (size_t)(b * SEQ + t) * L0P;
        const float cr = bf2f(row[c]), ck = bf2f(row[512 + c]), cv = bf2f(row[1024 + c]), cw = bf2f(row[1536 + lane]), ca = bf2f(row[1600 + lane]),
                    cg0 = bf2f(row[1664 + lane]), cg1 = bf2f(row[1728 + lane]);
        const float r_s = cr + (pr - cr) * mr, k_s = ck + (pk - ck) * mk, v_s = cv + (pv - cv) * mv;
        const float wl = cw + (pw - cw) * mw, al = ca + (pa - ca) * ma, g0 = cg0 + (pg0 - cg0) * mg0, g1 = cg1 + (pg1 - cg1) * mg1;
        pr = cr; pk = ck; pv = cv; pw = cw; pa = ca; pg0 = cg0; pg1 = cg1;
        s_tw[lane] = tanhf(wl); s_al[lane] = al; s_sg[lane] = sigmoidf_(g0); s_sg[64 + lane] = sigmoidf_(g1);
        WSYNC();
        float wsum = w0c, asum = a0c, gsum = 0.f;
#pragma unroll 2
        for (int l = 0; l < 64; ++l) { wsum += s_tw[l] * s_w2[l * 64 + lane]; asum += s_al[l] * s_a2[l * 64 + lane]; }
#pragma unroll 2
        for (int l = 0; l < 128; ++l) gsum += s_sg[l] * s_g2[l * 64 + lane];
        const float log_w = -softplusf_(-wsum) - 0.5f;
        const float dec = expf(-expf(log_w));
        const float a = sigmoidf_(asum);
        float kkv = k_s * kkc;
        const float nrm = sqrtf(wave_sum(kkv * kkv));
        kkv = kkv / fmaxf(nrm, 1e-12f);
        const float k2 = k_s * (1.f + (a - 1.f) * kac);
        const float bonus_s = wave_sum(r_s * k2 * rkc);
        s_w[lane] = dec; s_k[lane] = k2; s_a[lane] = -kkv; s_b[lane] = kkv * a; s_r[lane] = r_s;
        WSYNC();
        float sa = 0.f;
#pragma unroll
        for (int j = 0; j < 64; ++j) sa += S[j] * s_a[j];
        float y = 0.f;
#pragma unroll
        for (int j = 0; j < 64; ++j) { S[j] = S[j] * s_w[j] + sa * s_b[j] + v_s * s_k[j]; y += S[j] * s_r[j]; }
        const float mu = wave_sum(y) * (1.f / 64.f);
        const float d = y - mu;
        const float var = wave_sum(d * d) * (1.f / 64.f);
        const float yn = d * (1.0f / sqrtf(var + 64e-5f)) * lgc + lbc;
        const float o = (yn + bonus_s * v_s) * gsum;
        ymix[(size_t)(b * SEQ + t) * DM + c] = (bf16_t)f2bf(o);
        WSYNC();
    }
}

__device__ __forceinline__ void ssm_conv_all(const bf16_t* __restrict__ proj, const float* __restrict__ cw, const float* __restrict__ cb, const float* __restrict__ dtb,
                                             bf16_t* __restrict__ xbc, float* __restrict__ dt, int gtid, int NT) {
    for (size_t i = gtid; i < (size_t)M * 1024; i += NT) {
        const int m = (int)(i >> 10), c = (int)(i & 1023), t = m & (SEQ - 1);
        float acc = cb[c];
#pragma unroll
        for (int k = 0; k < 4; ++k) { const int tt = t - 3 + k; if (tt >= 0) acc += cw[k * 1024 + c] * bf2f(proj[(size_t)(m - 3 + k) * L0P + 2304 + c]); }
        xbc[i] = (bf16_t)f2bf(siluf_(acc));
    }
    for (int i = gtid; i < M * 8; i += NT) dt[i] = softplusf_(bf2f(proj[(size_t)(i >> 3) * L0P + 3328 + (i & 7)]) + dtb[i & 7]);
}
__device__ __forceinline__ void ssd_naive_task(int task, int lane, const bf16_t* __restrict__ xbc, const float* __restrict__ dt, const float* __restrict__ a_log, const float* __restrict__ dsk, float* __restrict__ yssm) {
    const int chain = task >> 2, q = task & 3, b = chain >> 3, h = chain & 7, g = h >> 2, p = q * 16 + (lane >> 2), nq = lane & 3;
    const float A = -expf(a_log[h]), D = dsk[h];
    float st[32];
#pragma unroll
    for (int n = 0; n < 32; ++n) st[n] = 0.f;
    for (int t = 0; t < SEQ; ++t) {
        const size_t m = (size_t)b * SEQ + t;
        const float dtv = dt[m * 8 + h], dA = expf(dtv * A);
        const float x = bf2f(xbc[m * 1024 + h * 64 + p]), xdt = x * dtv;
        const bf16_t* Bp = xbc + m * 1024 + 512 + g * 128 + nq * 32;
        const bf16_t* Cp = xbc + m * 1024 + 768 + g * 128 + nq * 32;
        float yp = 0.f;
#pragma unroll
        for (int n = 0; n < 32; ++n) { st[n] = st[n] * dA + xdt * bf2f(Bp[n]); yp += st[n] * bf2f(Cp[n]); }
        yp += __shfl_xor(yp, 1); yp += __shfl_xor(yp, 2);
        if (nq == 0) yssm[m * 512 + h * 64 + p] = yp + D * x;
    }
}
template <bool ST = true> __device__ __forceinline__ void ssm_gate_norm_all(const bf16_t* __restrict__ yssm, const bf16_t* __restrict__ proj, const float* __restrict__ ng, bf16_t* __restrict__ ymix, int wv0, int wvend, int lane) {
    for (int wvb = wv0 * 4 - (wv0 & ~7) * 3; wvb < wvend; wvb += NWAVES * 4) {
        float u[4][4], q[4];
#pragma unroll
        for (int k = 0; k < 4; ++k) { const int wv = wvb + k, m = wv >> 1, g = wv & 1; q[k] = 0.f;
#pragma unroll
            for (int j = 0; j < 4; ++j) { const int c = g * 256 + j * 64 + lane; const float z = bf2f(proj[(size_t)m * L0P + 1792 + c]); u[k][j] = bf2f(yssm[(size_t)m * 512 + c]) * (z * __builtin_amdgcn_rcpf(1.f + __expf(-z))); q[k] += u[k][j] * u[k][j]; } }
#pragma unroll
        for (int k = 0; k < 4; ++k) { const int wv = wvb + k, m = wv >> 1, g = wv & 1;
            const float rs = __builtin_amdgcn_rsqf(wave_sum_dpp(q[k]) * (1.f / 256.f) + 1e-5f);
#pragma unroll
            for (int j = 0; j < 4; ++j) { const int c = g * 256 + j * 64 + lane; const float o_ = u[k][j] * rs * ng[c]; if (ST) ymix[(size_t)m * DM + 512 + c] = bf1(o_); else asm volatile("" :: "v"(o_)); } }
    }
}
template <bool ST = true> __device__ __forceinline__ void ffn_act_all(bf16_t* gu, const float* __restrict__ cw, const float* __restrict__ cb, int gtid, int NT) {
    constexpr int NCH = DFF / 8, NSTRIP = M / 32;
    for (int task = gtid; task < NSTRIP * NCH; task += NT) {
        const int strip = task / NCH, q = task - strip * NCH, c0 = q * 8, m0 = strip * 32;
        float w0[8], w1[8], w2[8], bb[8], g2[8], g1[8];
#pragma unroll
        for (int j = 0; j < 8; j += 4) { const f32x4 a = *(const f32x4*)(cw + c0 + j), b = *(const f32x4*)(cw + DFF + c0 + j), c = *(const f32x4*)(cw + 2 * DFF + c0 + j), d = *(const f32x4*)(cb + c0 + j);
#pragma unroll
            for (int k = 0; k < 4; ++k) { w0[j + k] = a[k]; w1[j + k] = b[k]; w2[j + k] = c[k]; bb[j + k] = d[k]; } }
        bf16_t* base = gu + (size_t)m0 * (2 * DFF) + c0;
        if ((m0 & (SEQ - 1)) != 0) { const v4u a = *(const v4u*)(base - 2 * (2 * DFF)), b = *(const v4u*)(base - (2 * DFF));
            g2[0] = bflo(a.x); g2[1] = bfhi(a.x); g2[2] = bflo(a.y); g2[3] = bfhi(a.y); g2[4] = bflo(a.z); g2[5] = bfhi(a.z); g2[6] = bflo(a.w); g2[7] = bfhi(a.w);
            g1[0] = bflo(b.x); g1[1] = bfhi(b.x); g1[2] = bflo(b.y); g1[3] = bfhi(b.y); g1[4] = bflo(b.z); g1[5] = bfhi(b.z); g1[6] = bflo(b.w); g1[7] = bfhi(b.w); }
        else {
#pragma unroll
            for (int j = 0; j < 8; ++j) { g2[j] = 0.f; g1[j] = 0.f; } }
#pragma unroll 4
        for (int r = 0; r < 32; ++r) {
            const v4u gv = *(const v4u*)(base + (size_t)r * (2 * DFF)), uv = *(const v4u*)(base + (size_t)r * (2 * DFF) + DFF);
            const unsigned gw_[4] = {gv.x, gv.y, gv.z, gv.w}, uw_[4] = {uv.x, uv.y, uv.z, uv.w};
            unsigned ow[4];
#pragma unroll
            for (int k = 0; k < 4; ++k) {
                const float ga = bflo(gw_[k]), gb = bfhi(gw_[k]);
                const float ya = bb[2 * k] + w0[2 * k] * g2[2 * k] + w1[2 * k] * g1[2 * k] + w2[2 * k] * ga;
                const float yb = bb[2 * k + 1] + w0[2 * k + 1] * g2[2 * k + 1] + w1[2 * k + 1] * g1[2 * k + 1] + w2[2 * k + 1] * gb;
                g2[2 * k] = g1[2 * k]; g1[2 * k] = ga; g2[2 * k + 1] = g1[2 * k + 1]; g1[2 * k + 1] = gb;
                ow[k] = cvtpk(ya / (1.f + __expf(-ya)) * bflo(uw_[k]), yb / (1.f + __expf(-yb)) * bfhi(uw_[k]));
            }
            if (ST) *(v4u*)(base + (size_t)r * (2 * DFF) + DFF) = (v4u){ow[0], ow[1], ow[2], ow[3]}; else asm volatile("" :: "v"(ow[0]), "v"(ow[1]), "v"(ow[2]), "v"(ow[3]));
        }
    }
}
template <bool ST = true> __device__ __forceinline__ void mla_prep_all(const bf16_t* __restrict__ proj1, const int* __restrict__ pos, float* __restrict__ rs, bf16_t* __restrict__ kpe, float* __restrict__ cstab, int gw, int NGW, int lane) {
    for (int m4 = gw * 4; m4 < M; m4 += NGW * 4) {
        const int mt = m4 + (lane >> 4), fi = lane & 15;
        const double inv = exp2(-(double)(2 * fi) * (13.287712379549449 / 32.0));
        const double ang = (double)pos[mt] * inv;
        const float cs = (float)cos(ang), sn = (float)sin(ang);
        cstab[(size_t)mt * 32 + fi] = cs; cstab[(size_t)mt * 32 + 16 + fi] = sn;
        { const bf16_t* row = proj1 + (size_t)mt * L1P; const float x1 = bf2f(row[1920 + fi]), x2 = bf2f(row[1936 + fi]);
          kpe[(size_t)mt * 32 + fi] = bf1(x1 * cs - x2 * sn); kpe[(size_t)mt * 32 + 16 + fi] = bf1(x2 * cs + x1 * sn); }
        float q[4], k[4];
#pragma unroll
        for (int u = 0; u < 4; ++u) { const bf16_t* row = proj1 + (size_t)(m4 + u) * L1P; q[u] = 0.f; k[u] = 0.f;
#pragma unroll
            for (int j = 0; j < 4; ++j) { const float v = bf2f(row[1536 + j * 64 + lane]); q[u] += v * v; }
#pragma unroll
            for (int j = 0; j < 2; ++j) { const float v = bf2f(row[1792 + j * 64 + lane]); k[u] += v * v; } }
#pragma unroll
        for (int u = 0; u < 4; ++u) { q[u] = wave_sum_dpp(q[u]); k[u] = wave_sum_dpp(k[u]); }
        if (lane < 4) { const float qq = lane == 0 ? q[0] : lane == 1 ? q[1] : lane == 2 ? q[2] : q[3], kk2 = lane == 0 ? k[0] : lane == 1 ? k[1] : lane == 2 ? k[2] : k[3];
            rs[(size_t)(m4 + lane) * 2] = 1.0f / sqrtf(qq * (1.f / 256.f) + 1e-6f); rs[(size_t)(m4 + lane) * 2 + 1] = 1.0f / sqrtf(kk2 * (1.f / 128.f) + 1e-6f); }
    }
}
template <bool ST = true> __device__ __forceinline__ void rope_q_all(bf16_t* qm, const float* __restrict__ cstab, int gtid, int NT) {
    for (int i = gtid; i < M * 16; i += NT) {
        const int m = i >> 4, h = (i >> 1) & 7, k0 = (i & 1) * 8;
        bf16_t* p = qm + (size_t)m * 768 + h * 96 + 64 + k0;
        const v4u a = *(const v4u*)p, b = *(const v4u*)(p + 16);
        const f32x4 c0 = *(const f32x4*)(cstab + (size_t)m * 32 + k0), c1 = *(const f32x4*)(cstab + (size_t)m * 32 + k0 + 4), s0 = *(const f32x4*)(cstab + (size_t)m * 32 + 16 + k0), s1 = *(const f32x4*)(cstab + (size_t)m * 32 + 16 + k0 + 4);
        const unsigned au[4] = {a.x, a.y, a.z, a.w}, bu[4] = {b.x, b.y, b.z, b.w};
        const float cs[8] = {c0[0], c0[1], c0[2], c0[3], c1[0], c1[1], c1[2], c1[3]}, sn[8] = {s0[0], s0[1], s0[2], s0[3], s1[0], s1[1], s1[2], s1[3]};
        unsigned o1[4], o2[4];
#pragma unroll
        for (int q = 0; q < 4; ++q) { const float x1a = bflo(au[q]), x1b = bfhi(au[q]), x2a = bflo(bu[q]), x2b = bfhi(bu[q]);
            o1[q] = cvtpk(x1a * cs[2 * q] - x2a * sn[2 * q], x1b * cs[2 * q + 1] - x2b * sn[2 * q + 1]);
            o2[q] = cvtpk(x2a * cs[2 * q] + x1a * sn[2 * q], x2b * cs[2 * q + 1] + x1b * sn[2 * q + 1]); }
        if (ST) { *(v4u*)p = (v4u){o1[0], o1[1], o1[2], o1[3]}; *(v4u*)(p + 16) = (v4u){o2[0], o2[1], o2[2], o2[3]}; }
    }
}
__device__ __forceinline__ void sb_naive_task(int qblk, int bh, int lane, const bf16_t* __restrict__ proj1, bf16_t* __restrict__ ymix) {
    const int b = bh >> 3, h = bh & 7, t = qblk * 64 + lane;
    const size_t mrow = (size_t)b * SEQ;
    float q[64], o[64];
#pragma unroll
    for (int d = 0; d < 64; ++d) { q[d] = bf2f(proj1[(mrow + t) * L1P + h * 64 + d]) * 0.125f; o[d] = 0.f; }
    float cum = 0.f;
    const int smax = qblk * 64 + 63;
    for (int s = smax - 1; s >= 0; --s) {
        const bf16_t* kr = proj1 + (mrow + s) * L1P + 512 + h * 64;
        const bf16_t* vr = proj1 + (mrow + s) * L1P + 1024 + h * 64;
        float z = 0.f;
#pragma unroll
        for (int d = 0; d < 64; ++d) z += q[d] * bf2f(kr[d]);
        if (s < t) {
            const float lsp = -softplusf_(-z);
            const float lsn = -softplusf_(z);
            const float att = expf(lsp + cum);
            cum += lsn;
#pragma unroll
            for (int d = 0; d < 64; ++d) o[d] += att * bf2f(vr[d]);
        }
    }
#pragma unroll
    for (int d = 0; d < 64; ++d) ymix[(mrow + t) * DM + h * 64 + d] = (bf16_t)f2bf(o[d]);
}
__device__ __forceinline__ void mla_naive_task(int qblk, int bh, int lane, const bf16_t* __restrict__ qm, const bf16_t* __restrict__ kvm, const bf16_t* __restrict__ kpe, bf16_t* __restrict__ ymix) {
    const int b = bh >> 3, h = bh & 7, t = qblk * 64 + lane;
    const size_t mrow = (size_t)b * SEQ;
    const float scale = 0.10206207261596577f;
    float q[96], o[64];
#pragma unroll
    for (int d = 0; d < 96; ++d) q[d] = bf2f(qm[(mrow + t) * 768 + h * 96 + d]) * scale;
#pragma unroll
    for (int d = 0; d < 64; ++d) o[d] = 0.f;
    float mx = -1e30f, l = 0.f;
    const int smax = qblk * 64 + 63;
    for (int s = 0; s <= smax; ++s) {
        const bf16_t* kr = kvm + (mrow + s) * 1024 + h * 128;
        const bf16_t* pr = kpe + (mrow + s) * 32;
        float z = 0.f;
#pragma unroll
        for (int d = 0; d < 64; ++d) z += q[d] * bf2f(kr[d]);
#pragma unroll
        for (int d = 0; d < 32; ++d) z += q[64 + d] * bf2f(pr[d]);
        if (s <= t) {
            const float mn = fmaxf(mx, z), f = expf(mx - mn), pz = expf(z - mn);
            l = l * f + pz; mx = mn;
#pragma unroll
            for (int d = 0; d < 64; ++d) o[d] = o[d] * f + pz * bf2f(kr[64 + d]);
        }
    }
    const float il = 1.f / l;
#pragma unroll
    for (int d = 0; d < 64; ++d) ymix[(mrow + t) * DM + 512 + h * 64 + d] = (bf16_t)f2bf(o[d] * il);
}


__device__ __forceinline__ int crow(int r, int hi) { return (r & 3) + 8 * (r >> 2) + 4 * hi; }
#define MFMA32(a, b, c) __builtin_amdgcn_mfma_f32_32x32x16_bf16((a), (b), (c), 0, 0, 0)
constexpr int STG_PITCH = 72;
__device__ __forceinline__ void transpose_tile64(const bf16_t* __restrict__ src, int sp, bf16_t* __restrict__ dst, int dp, LAS bf16_t* scr, int lane) {
#pragma unroll
    for (int i = 0; i < 8; ++i) { const int row = i * 8 + (lane >> 3), ch = lane & 7; const v4u v = *(const v4u*)(src + (size_t)row * sp + ch * 8); *(LAS v4u*)(scr + row * STG_PITCH + ch * 8) = v; }
    WSYNC();
#pragma unroll
    for (int i = 0; i < 8; ++i) { const int d = i * 8 + (lane >> 3), tc = lane & 7; const LAS bf16_t* p = scr + (tc * 8) * STG_PITCH + d;
        v4u o; o.x = (unsigned)p[0] | ((unsigned)p[STG_PITCH] << 16); o.y = (unsigned)p[2 * STG_PITCH] | ((unsigned)p[3 * STG_PITCH] << 16);
        o.z = (unsigned)p[4 * STG_PITCH] | ((unsigned)p[5 * STG_PITCH] << 16); o.w = (unsigned)p[6 * STG_PITCH] | ((unsigned)p[7 * STG_PITCH] << 16);
        *(v4u*)(dst + (size_t)d * dp + tc * 8) = o; }
    WSYNC();
}
__device__ __forceinline__ void store_OT(const f32x16 (&o)[2], float sc, LAS bf16_t* stg, bf16_t* __restrict__ dst, int lane) {
    const int l31 = lane & 31, hi = lane >> 5;
#pragma unroll
    for (int dt = 0; dt < 2; ++dt)
#pragma unroll
        for (int r = 0; r < 16; ++r) stg[l31 * STG_PITCH + 32 * dt + crow(r, hi)] = bf1(o[dt][r] * sc);
    WSYNC();
#pragma unroll
    for (int i = 0; i < 4; ++i) { const int row = i * 8 + (lane >> 3), ch = lane & 7; const v4u v = *(const LAS v4u*)(stg + row * STG_PITCH + ch * 8); *(v4u*)(dst + (size_t)row * DM + ch * 8) = v; }
    WSYNC();
}
__device__ __forceinline__ float softplus_fast(float z) { return fmaxf(z, 0.f) + __logf(1.f + __expf(-fabsf(z))); }

__device__ __forceinline__ void sb_task(int bh, int qblk, int lane, const bf16_t* __restrict__ P1, const bf16_t* __restrict__ VT, bf16_t* __restrict__ ymix, LAS bf16_t* stg) {
    const int b = bh >> 3, h = bh & 7, l31 = lane & 31, hi = lane >> 5, q0 = qblk * 32, t = q0 + l31;
    const size_t rowb = (size_t)b * SEQ;
    const bf16_t* Qp = P1 + (rowb + q0 + l31) * L1P + h * 64 + 8 * hi;
    bf16x8 qf[4];
#pragma unroll
    for (int kk = 0; kk < 4; ++kk) qf[kk] = *(const bf16x8*)(Qp + 16 * kk);
    const bf16_t* Kp = P1 + (rowb + l31) * L1P + 512 + h * 64 + 8 * hi;
    const bf16_t* Vp = VT + ((size_t)bh * 64 + l31) * SEQ + 4 * hi;
    f32x16 o[2];
#pragma unroll
    for (int r = 0; r < 16; ++r) { o[0][r] = 0.f; o[1][r] = 0.f; }
    float cum = 0.f;
    bf16x8 kf[4]; u32x2 va[2][2][2];
#define SB_LOAD(S0, KF, VA) do { _Pragma("unroll") for (int kk = 0; kk < 4; ++kk) KF[kk] = *(const bf16x8*)(Kp + (size_t)(S0) * L1P + 16 * kk); \
        _Pragma("unroll") for (int dt = 0; dt < 2; ++dt) _Pragma("unroll") for (int ks = 0; ks < 2; ++ks) { VA[dt][ks][0] = *(const u32x2*)(Vp + (size_t)dt * 32 * SEQ + (S0) + 16 * ks); VA[dt][ks][1] = *(const u32x2*)(Vp + (size_t)dt * 32 * SEQ + (S0) + 16 * ks + 8); } } while (0)
    SB_LOAD(q0, kf, va);
    for (int s0 = q0; s0 >= 0; s0 -= 32) {
        bf16x8 kn[4]; u32x2 vn[2][2][2];
        const int sn = (s0 >= 32) ? s0 - 32 : 0;
        SB_LOAD(sn, kn, vn);
        f32x16 acc;
#pragma unroll
        for (int r = 0; r < 16; ++r) acc[r] = 0.f;
#pragma unroll
        for (int kk = 0; kk < 4; ++kk) acc = MFMA32(kf[kk], qf[kk], acc);
        const bool diag = (s0 == q0);
        float lb[16], lk[16];
#pragma unroll
        for (int r = 0; r < 16; ++r) { const float z = acc[r] * 0.125f; const float sp = softplus_fast(z); float b_ = z - sp, k_ = -sp;
            if (diag) { const bool valid = (s0 + crow(r, hi)) < t; b_ = valid ? b_ : -1e30f; k_ = valid ? k_ : 0.f; }
            lb[r] = b_; lk[r] = k_; }
        float e[16], T[4], U[4];
#pragma unroll
        for (int i = 0; i < 4; ++i) { e[4 * i + 3] = 0.f; e[4 * i + 2] = lk[4 * i + 3]; e[4 * i + 1] = e[4 * i + 2] + lk[4 * i + 2]; e[4 * i] = e[4 * i + 1] + lk[4 * i + 1]; T[i] = e[4 * i] + lk[4 * i]; }
#pragma unroll
        for (int i = 0; i < 4; ++i) U[i] = __shfl_xor(T[i], 32);
        float off[4];
        { const float st2 = T[3], st1 = st2 + T[2], st0 = st1 + T[1]; const float su2 = U[3], su1 = su2 + U[2], su0 = su1 + U[1];
          const float x0 = hi ? 0.f : U[0], x1 = hi ? 0.f : U[1], x2 = hi ? 0.f : U[2], x3 = hi ? 0.f : U[3];
          off[3] = x3; off[2] = st2 + su2 + x2; off[1] = st1 + su1 + x1; off[0] = st0 + su0 + x0;
          const float total = st0 + T[0] + su0 + U[0];
#pragma unroll
          for (int r = 0; r < 16; ++r) acc[r] = __expf(lb[r] + (cum + off[r >> 2] + e[r]));
          cum += total; }
        bf16x8 pf[2];
#pragma unroll
        for (int ks = 0; ks < 2; ++ks) { v4u w; w.x = cvtpk(acc[8 * ks], acc[8 * ks + 1]); w.y = cvtpk(acc[8 * ks + 2], acc[8 * ks + 3]); w.z = cvtpk(acc[8 * ks + 4], acc[8 * ks + 5]); w.w = cvtpk(acc[8 * ks + 6], acc[8 * ks + 7]); pf[ks] = __builtin_bit_cast(bf16x8, w); }
#pragma unroll
        for (int dt = 0; dt < 2; ++dt)
#pragma unroll
            for (int ks = 0; ks < 2; ++ks) { v4u a; a.x = va[dt][ks][0].x; a.y = va[dt][ks][0].y; a.z = va[dt][ks][1].x; a.w = va[dt][ks][1].y; o[dt] = MFMA32(__builtin_bit_cast(bf16x8, a), pf[ks], o[dt]); }
        if (__all(cum < -110.f)) break;
#pragma unroll
        for (int kk = 0; kk < 4; ++kk) kf[kk] = kn[kk];
#pragma unroll
        for (int dt = 0; dt < 2; ++dt)
#pragma unroll
            for (int ks = 0; ks < 2; ++ks) { va[dt][ks][0] = vn[dt][ks][0]; va[dt][ks][1] = vn[dt][ks][1]; }
    }
#undef SB_LOAD
    store_OT(o, 1.0f, stg, ymix + (rowb + q0) * DM + h * 64, lane);
}
__device__ __forceinline__ void mla_task(int bh, int qblk, int lane, const bf16_t* __restrict__ QM, const bf16_t* __restrict__ KVM, const bf16_t* __restrict__ KPE, const bf16_t* __restrict__ VT,
                                         bf16_t* __restrict__ ymix, LAS bf16_t* stg) {
    const int b = bh >> 3, h = bh & 7, l31 = lane & 31, hi = lane >> 5, q0 = qblk * 32, t = q0 + l31;
    const size_t rowb = (size_t)b * SEQ;
    const bf16_t* Qp = QM + (rowb + q0 + l31) * 768 + h * 96 + 8 * hi;
    bf16x8 qf[6];
#pragma unroll
    for (int kk = 0; kk < 6; ++kk) qf[kk] = *(const bf16x8*)(Qp + 16 * kk);
    const bf16_t* Kn = KVM + (rowb + l31) * 1024 + h * 128 + 8 * hi;
    const bf16_t* Kr = KPE + (rowb + l31) * 32 + 8 * hi;
    const bf16_t* Vp = VT + ((size_t)bh * 64 + l31) * SEQ + 4 * hi;
    const float sc2 = 0.10206207261596577f * 1.4426950408889634f;
    f32x16 o[2];
#pragma unroll
    for (int r = 0; r < 16; ++r) { o[0][r] = 0.f; o[1][r] = 0.f; }
    float mrun = -1e30f, lsum = 0.f;
    bf16x8 kf[6]; u32x2 va[2][2][2];
#define ML_LOAD(S0, KF, VA) do { _Pragma("unroll") for (int kk = 0; kk < 4; ++kk) KF[kk] = *(const bf16x8*)(Kn + (size_t)(S0) * 1024 + 16 * kk); \
        _Pragma("unroll") for (int kk = 0; kk < 2; ++kk) KF[4 + kk] = *(const bf16x8*)(Kr + (size_t)(S0) * 32 + 16 * kk); \
        _Pragma("unroll") for (int dt = 0; dt < 2; ++dt) _Pragma("unroll") for (int ks = 0; ks < 2; ++ks) { VA[dt][ks][0] = *(const u32x2*)(Vp + (size_t)dt * 32 * SEQ + (S0) + 16 * ks); VA[dt][ks][1] = *(const u32x2*)(Vp + (size_t)dt * 32 * SEQ + (S0) + 16 * ks + 8); } } while (0)
    ML_LOAD(0, kf, va);
    for (int s0 = 0; s0 <= q0; s0 += 32) {
        bf16x8 kn[6]; u32x2 vn[2][2][2];
        const int sn = (s0 + 32 <= q0) ? s0 + 32 : s0;
        ML_LOAD(sn, kn, vn);
        f32x16 acc;
#pragma unroll
        for (int r = 0; r < 16; ++r) acc[r] = 0.f;
#pragma unroll
        for (int kk = 0; kk < 6; ++kk) acc = MFMA32(kf[kk], qf[kk], acc);
        const bool diag = (s0 == q0);
        float tmax = -1e30f;
#pragma unroll
        for (int r = 0; r < 16; ++r) { float z = acc[r] * sc2; if (diag && (s0 + crow(r, hi)) > t) z = -1e30f; acc[r] = z; tmax = fmaxf(tmax, z); }
        tmax = fmaxf(tmax, __shfl_xor(tmax, 32));
        const float mn = fmaxf(mrun, tmax), alpha = exp2f(mrun - mn); mrun = mn;
        float ps = 0.f;
#pragma unroll
        for (int r = 0; r < 16; ++r) { acc[r] = exp2f(acc[r] - mn); ps += acc[r]; }
        lsum = lsum * alpha + ps;
#pragma unroll
        for (int r = 0; r < 16; ++r) { o[0][r] *= alpha; o[1][r] *= alpha; }
        bf16x8 pf[2];
#pragma unroll
        for (int ks = 0; ks < 2; ++ks) { v4u w; w.x = cvtpk(acc[8 * ks], acc[8 * ks + 1]); w.y = cvtpk(acc[8 * ks + 2], acc[8 * ks + 3]); w.z = cvtpk(acc[8 * ks + 4], acc[8 * ks + 5]); w.w = cvtpk(acc[8 * ks + 6], acc[8 * ks + 7]); pf[ks] = __builtin_bit_cast(bf16x8, w); }
#pragma unroll
        for (int dt = 0; dt < 2; ++dt)
#pragma unroll
            for (int ks = 0; ks < 2; ++ks) { v4u a; a.x = va[dt][ks][0].x; a.y = va[dt][ks][0].y; a.z = va[dt][ks][1].x; a.w = va[dt][ks][1].y; o[dt] = MFMA32(__builtin_bit_cast(bf16x8, a), pf[ks], o[dt]); }
#pragma unroll
        for (int kk = 0; kk < 6; ++kk) kf[kk] = kn[kk];
#pragma unroll
        for (int dt = 0; dt < 2; ++dt)
#pragma unroll
            for (int ks = 0; ks < 2; ++ks) { va[dt][ks][0] = vn[dt][ks][0]; va[dt][ks][1] = vn[dt][ks][1]; }
    }
#undef ML_LOAD
    lsum += __shfl_xor(lsum, 32);
    store_OT(o, 1.0f / lsum, stg, ymix + (rowb + q0) * DM + 512 + h * 64, lane);
}


__device__ __forceinline__ void sb_wave(int bh, int qblk, int lane, const bf16_t* __restrict__ P1, const bf16_t* __restrict__ VT, bf16_t* __restrict__ ymix, LAS unsigned char* wl) {
    const int b = bh >> 3, h = bh & 7, l31 = lane & 31, hi = lane >> 5, q0 = qblk * 32, t = q0 + l31;
    const size_t rowb = (size_t)b * SEQ;
    bf16x8 qf[4];
    { const bf16_t* Qp = P1 + (rowb + q0 + l31) * L1P + h * 64 + 8 * hi;
#pragma unroll
      for (int kk = 0; kk < 4; ++kk) qf[kk] = *(const bf16x8*)(Qp + 16 * kk); }
    f32x16 o[2];
#pragma unroll
    for (int r = 0; r < 16; ++r) { o[0][r] = 0.f; o[1][r] = 0.f; }
    float cum = 1.f;
    const bf16_t* gK = P1 + (rowb + (lane >> 3)) * L1P + 512 + h * 64 + (lane & 7) * 8;
    const bf16_t* gV = VT + ((size_t)bh * 64 + (lane >> 2)) * SEQ + (lane & 3) * 8;
    const int lK = (lane >> 3) * 144 + (lane & 7) * 16, lV = 4608 + (lane >> 2) * 72 + (lane & 3) * 16;
    v4u rk[4], rv[4];
#pragma unroll
    for (int i = 0; i < 4; ++i) { rk[i] = *(const v4u*)(gK + (size_t)(q0 + 8 * i) * L1P); rv[i] = *(const v4u*)(gV + (size_t)(16 * i) * SEQ + q0); }
#pragma unroll 1
    for (int s0 = q0; s0 >= 0; s0 -= 32) {
#pragma unroll
        for (int i = 0; i < 4; ++i) { *(LAS v4u*)(wl + lK + i * 8 * 144) = rk[i]; *(LAS u32x2*)(wl + lV + i * 16 * 72) = (u32x2){rv[i].x, rv[i].y}; *(LAS u32x2*)(wl + lV + i * 16 * 72 + 8) = (u32x2){rv[i].z, rv[i].w}; }
        { const int sn = (s0 >= 32) ? s0 - 32 : 0;
#pragma unroll
          for (int i = 0; i < 4; ++i) { rk[i] = *(const v4u*)(gK + (size_t)(sn + 8 * i) * L1P); rv[i] = *(const v4u*)(gV + (size_t)(16 * i) * SEQ + sn); } }
        WSYNC();
        f32x16 acc;
#pragma unroll
        for (int r = 0; r < 16; ++r) acc[r] = 0.f;
#pragma unroll
        for (int kk = 0; kk < 4; ++kk) { const bf16x8 kf = *(const LAS bf16x8*)(wl + l31 * 144 + (16 * kk + 8 * hi) * 2); acc = MFMA32(kf, qf[kk], acc); }
        const bool diag = (s0 == q0);
        float bt[16], kp[16];
#pragma unroll
        for (int r = 0; r < 16; ++r) { const float ee = __builtin_amdgcn_exp2f(fminf(acc[r] * (-0.125f * 1.4426950408889634f), 100.f)); const float ri = __builtin_amdgcn_rcpf(1.f + ee);
            float b_ = ri, k_ = ee * ri;
            if (diag) { const bool valid = (s0 + crow(r, hi)) < t; b_ = valid ? b_ : 0.f; k_ = valid ? k_ : 1.f; }
            bt[r] = b_; kp[r] = k_; }
        float e[16], T[4], U[4];
#pragma unroll
        for (int q = 0; q < 4; ++q) { e[4 * q + 3] = 1.f; e[4 * q + 2] = kp[4 * q + 3]; e[4 * q + 1] = e[4 * q + 2] * kp[4 * q + 2]; e[4 * q] = e[4 * q + 1] * kp[4 * q + 1]; T[q] = e[4 * q] * kp[4 * q]; }
#pragma unroll
        for (int q = 0; q < 4; ++q) U[q] = __shfl_xor(T[q], 32);
        { const float st2 = T[3], st1 = st2 * T[2], st0 = st1 * T[1]; const float su2 = U[3], su1 = su2 * U[2], su0 = su1 * U[1];
          const float x0 = hi ? 1.f : U[0], x1 = hi ? 1.f : U[1], x2 = hi ? 1.f : U[2], x3 = hi ? 1.f : U[3];
          const float off[4] = {cum * (st0 * su0 * x0), cum * (st1 * su1 * x1), cum * (st2 * su2 * x2), cum * x3};
#pragma unroll
          for (int r = 0; r < 16; ++r) acc[r] = bt[r] * (off[r >> 2] * e[r]);
          cum *= (st0 * T[0]) * (su0 * U[0]); }
        bf16x8 pf[2];
#pragma unroll
        for (int ks = 0; ks < 2; ++ks) pf[ks] = pack8(acc[8 * ks], acc[8 * ks + 1], acc[8 * ks + 2], acc[8 * ks + 3], acc[8 * ks + 4], acc[8 * ks + 5], acc[8 * ks + 6], acc[8 * ks + 7]);
#pragma unroll
        for (int dt = 0; dt < 2; ++dt)
#pragma unroll
            for (int ks = 0; ks < 2; ++ks) { const LAS unsigned char* vp = wl + 4608 + (32 * dt + l31) * 72 + (16 * ks + 4 * hi) * 2;
                const u32x2 x0 = *(const LAS u32x2*)vp, x1 = *(const LAS u32x2*)(vp + 16);
                v4u a; a.x = x0.x; a.y = x0.y; a.z = x1.x; a.w = x1.y; o[dt] = MFMA32(__builtin_bit_cast(bf16x8, a), pf[ks], o[dt]); }
        WSYNC();
        if (__all(cum < 1e-35f)) break;
    }
    store_OT(o, 1.0f, (LAS bf16_t*)(wl + 9216), ymix + (rowb + q0) * DM + h * 64, lane);
}

constexpr int MLK_PITCH = 104, MLV_PITCH = 68, MLK_BYTES = 64 * MLK_PITCH * 2, MLV_BYTES = 64 * MLV_PITCH * 2, ML_STAGE = MLK_BYTES + MLV_BYTES;
__device__ __forceinline__ void mla_block(int bh, int sb, int tid, int lane, int wave, LAS unsigned char* lds, const bf16_t* __restrict__ QM, const bf16_t* __restrict__ KVM, const bf16_t* __restrict__ KPE,
                                          const bf16_t* __restrict__ VT, bf16_t* __restrict__ ymix) {
    const int b = bh >> 3, h = bh & 7, l31 = lane & 31, hi = lane >> 5, q0 = 256 * sb + 32 * wave, t = q0 + l31;
    const size_t rowb = (size_t)b * SEQ;
    const int nsteps = 4 * sb + 4;
    bf16x8 qf[6];
    { const bf16_t* Qp = QM + (rowb + q0 + l31) * 768 + h * 96 + 8 * hi;
#pragma unroll
      for (int kk = 0; kk < 6; ++kk) qf[kk] = *(const bf16x8*)(Qp + 16 * kk); }
    const float sc2 = 0.10206207261596577f * 1.4426950408889634f;
    f32x16 o[2];
#pragma unroll
    for (int r = 0; r < 16; ++r) { o[0][r] = 0.f; o[1][r] = 0.f; }
    float mrun = -1e30f, lsum = 0.f;
    const bf16_t* gKn = KVM + (rowb + (tid >> 3)) * 1024 + h * 128 + (tid & 7) * 8;
    const bf16_t* gKr = KPE + (rowb + ((tid & 255) >> 2)) * 32 + (tid & 3) * 8;
    const bf16_t* gVt = VT + ((size_t)bh * 64 + (tid >> 3)) * SEQ + (tid & 7) * 8;
    const int lKn = (tid >> 3) * (MLK_PITCH * 2) + (tid & 7) * 16, lKr = ((tid & 255) >> 2) * (MLK_PITCH * 2) + 128 + (tid & 3) * 16, lVt = MLK_BYTES + (tid >> 3) * (MLV_PITCH * 2) + (tid & 7) * 16;
    v4u rk, rr, rv;
    rk = *(const v4u*)gKn; rr = *(const v4u*)gKr; rv = *(const v4u*)gVt;
    *(LAS v4u*)(lds + lKn) = rk; if (tid < 256) *(LAS v4u*)(lds + lKr) = rr; *(LAS u32x2*)(lds + lVt) = (u32x2){rv.x, rv.y}; *(LAS u32x2*)(lds + lVt + 8) = (u32x2){rv.z, rv.w};
    __syncthreads();
#pragma unroll 1
    for (int step = 0; step < nsteps; ++step) {
        const int nx = (step + 1 < nsteps) ? step + 1 : step;
        rk = *(const v4u*)(gKn + (size_t)nx * 64 * 1024); rr = *(const v4u*)(gKr + (size_t)nx * 64 * 32); rv = *(const v4u*)(gVt + nx * 64);
        const LAS unsigned char* Kb = lds + (step & 1) * ML_STAGE;
        const LAS unsigned char* Vb = Kb + MLK_BYTES;
        if (64 * step <= q0) {
            f32x16 acc[2];
#pragma unroll
            for (int sub = 0; sub < 2; ++sub) {
#pragma unroll
                for (int r = 0; r < 16; ++r) acc[sub][r] = 0.f;
#pragma unroll
                for (int kk = 0; kk < 6; ++kk) { const bf16x8 kf = *(const LAS bf16x8*)(Kb + (32 * sub + l31) * (MLK_PITCH * 2) + (16 * kk + 8 * hi) * 2); acc[sub] = MFMA32(kf, qf[kk], acc[sub]); }
            }
            float tmax = -1e30f;
#pragma unroll
            for (int sub = 0; sub < 2; ++sub) { const int s0 = 64 * step + 32 * sub;
                if (s0 + 31 > q0) {
#pragma unroll
                    for (int r = 0; r < 16; ++r) if ((s0 + crow(r, hi)) > t) acc[sub][r] = -1e30f; }
#pragma unroll
                for (int r = 0; r < 16; ++r) tmax = fmaxf(tmax, acc[sub][r]); }
            tmax = fmaxf(tmax, __shfl_xor(tmax, 32)) * sc2;
            if (__any(tmax - mrun > 6.f)) {
                const float mn = fmaxf(mrun, tmax), alpha = __builtin_amdgcn_exp2f(mrun - mn); mrun = mn; lsum *= alpha;
#pragma unroll
                for (int r = 0; r < 16; ++r) { o[0][r] *= alpha; o[1][r] *= alpha; }
            }
            float ps = 0.f;
#pragma unroll
            for (int sub = 0; sub < 2; ++sub)
#pragma unroll
                for (int r = 0; r < 16; ++r) { acc[sub][r] = __builtin_amdgcn_exp2f(acc[sub][r] * sc2 - mrun); ps += acc[sub][r]; }
            lsum += ps;
#pragma unroll
            for (int sub = 0; sub < 2; ++sub) {
                bf16x8 pf[2];
#pragma unroll
                for (int ks = 0; ks < 2; ++ks) pf[ks] = pack8(acc[sub][8 * ks], acc[sub][8 * ks + 1], acc[sub][8 * ks + 2], acc[sub][8 * ks + 3], acc[sub][8 * ks + 4], acc[sub][8 * ks + 5], acc[sub][8 * ks + 6], acc[sub][8 * ks + 7]);
#pragma unroll
                for (int dt = 0; dt < 2; ++dt)
#pragma unroll
                    for (int ks = 0; ks < 2; ++ks) { const LAS unsigned char* vp = Vb + (32 * dt + l31) * (MLV_PITCH * 2) + (32 * sub + 16 * ks + 4 * hi) * 2;
                        const u32x2 x0 = *(const LAS u32x2*)vp, x1 = *(const LAS u32x2*)(vp + 16);
                        v4u a; a.x = x0.x; a.y = x0.y; a.z = x1.x; a.w = x1.y; o[dt] = MFMA32(__builtin_bit_cast(bf16x8, a), pf[ks], o[dt]); }
            }
        }
        LAS unsigned char* nb = lds + ((step + 1) & 1) * ML_STAGE;
        *(LAS v4u*)(nb + lKn) = rk; if (tid < 256) *(LAS v4u*)(nb + lKr) = rr; *(LAS u32x2*)(nb + lVt) = (u32x2){rv.x, rv.y}; *(LAS u32x2*)(nb + lVt + 8) = (u32x2){rv.z, rv.w};
        __syncthreads();
    }
    lsum += __shfl_xor(lsum, 32);
    store_OT(o, 1.0f / lsum, (LAS bf16_t*)(lds + 2 * ML_STAGE) + wave * (32 * STG_PITCH), ymix + (rowb + q0) * DM + 512 + h * 64, lane);
    __syncthreads();
}


constexpr int SBK_PITCH = 72, SBK_BYTES = 64 * SBK_PITCH * 2, SB_STAGE = SBK_BYTES + MLV_BYTES;
__device__ __forceinline__ void sb_block(int bh, int sb, int tid, int lane, int wave, LAS unsigned char* lds, const bf16_t* __restrict__ P1, const bf16_t* __restrict__ VT, bf16_t* __restrict__ ymix) {
    const int b = bh >> 3, h = bh & 7, l31 = lane & 31, hi = lane >> 5, q0 = 256 * sb + 32 * wave, t = q0 + l31;
    const size_t rowb = (size_t)b * SEQ;
    bf16x8 qf[4];
    { const bf16_t* Qp = P1 + (rowb + q0 + l31) * L1P + h * 64 + 8 * hi;
#pragma unroll
      for (int kk = 0; kk < 4; ++kk) qf[kk] = *(const bf16x8*)(Qp + 16 * kk); }
    f32x16 o[2];
#pragma unroll
    for (int r = 0; r < 16; ++r) { o[0][r] = 0.f; o[1][r] = 0.f; }
    float cum = 1.f; bool done = false;
    volatile LAS unsigned* flags = (volatile LAS unsigned*)(lds + 2 * SB_STAGE);
    const bf16_t* gK = P1 + (rowb + (tid >> 3)) * L1P + 512 + h * 64 + (tid & 7) * 8;
    const bf16_t* gVt = VT + ((size_t)bh * 64 + (tid >> 3)) * SEQ + (tid & 7) * 8;
    const int lK = (tid >> 3) * (SBK_PITCH * 2) + (tid & 7) * 16, lVt = SBK_BYTES + (tid >> 3) * (MLV_PITCH * 2) + (tid & 7) * 16;
    const int top = 4 * sb + 3;
    v4u rk, rv;
    rk = *(const v4u*)(gK + (size_t)top * 64 * L1P); rv = *(const v4u*)(gVt + top * 64);
    *(LAS v4u*)(lds + lK) = rk; *(LAS u32x2*)(lds + lVt) = (u32x2){rv.x, rv.y}; *(LAS u32x2*)(lds + lVt + 8) = (u32x2){rv.z, rv.w};
    __syncthreads();
#pragma unroll 1
    for (int i = 0; i <= top; ++i) {
        const int step = top - i, nx = (step > 0) ? step - 1 : 0;
        rk = *(const v4u*)(gK + (size_t)nx * 64 * L1P); rv = *(const v4u*)(gVt + nx * 64);
        const LAS unsigned char* Kb = lds + (i & 1) * SB_STAGE;
        const LAS unsigned char* Vb = Kb + SBK_BYTES;
#pragma unroll
        for (int sub = 1; sub >= 0; --sub) {
            const int s0 = 64 * step + 32 * sub;
            if (s0 <= q0 && !done) {
                f32x16 acc;
#pragma unroll
                for (int r = 0; r < 16; ++r) acc[r] = 0.f;
#pragma unroll
                for (int kk = 0; kk < 4; ++kk) { const bf16x8 kf = *(const LAS bf16x8*)(Kb + (32 * sub + l31) * (SBK_PITCH * 2) + (16 * kk + 8 * hi) * 2); acc = MFMA32(kf, qf[kk], acc); }
                const bool diag = (s0 == q0);
                float bt[16], kp[16];
#pragma unroll
                for (int r = 0; r < 16; ++r) { const float ee = __builtin_amdgcn_exp2f(fminf(acc[r] * (-0.125f * 1.4426950408889634f), 100.f)); const float ri = __builtin_amdgcn_rcpf(1.f + ee);
                    float b_ = ri, k_ = ee * ri;
                    if (diag) { const bool valid = (s0 + crow(r, hi)) < t; b_ = valid ? b_ : 0.f; k_ = valid ? k_ : 1.f; }
                    bt[r] = b_; kp[r] = k_; }
                float e[16], T[4], U[4];
#pragma unroll
                for (int q = 0; q < 4; ++q) { e[4 * q + 3] = 1.f; e[4 * q + 2] = kp[4 * q + 3]; e[4 * q + 1] = e[4 * q + 2] * kp[4 * q + 2]; e[4 * q] = e[4 * q + 1] * kp[4 * q + 1]; T[q] = e[4 * q] * kp[4 * q]; }
#pragma unroll
                for (int q = 0; q < 4; ++q) U[q] = __shfl_xor(T[q], 32);
                { const float st2 = T[3], st1 = st2 * T[2], st0 = st1 * T[1]; const float su2 = U[3], su1 = su2 * U[2], su0 = su1 * U[1];
                  const float x0 = hi ? 1.f : U[0], x1 = hi ? 1.f : U[1], x2 = hi ? 1.f : U[2], x3 = hi ? 1.f : U[3];
                  const float off[4] = {cum * (st0 * su0 * x0), cum * (st1 * su1 * x1), cum * (st2 * su2 * x2), cum * x3};
#pragma unroll
                  for (int r = 0; r < 16; ++r) acc[r] = bt[r] * (off[r >> 2] * e[r]);
                  cum *= (st0 * T[0]) * (su0 * U[0]); }
                bf16x8 pf[2];
#pragma unroll
                for (int ks = 0; ks < 2; ++ks) { v4u w; w.x = cvtpk(acc[8 * ks], acc[8 * ks + 1]); w.y = cvtpk(acc[8 * ks + 2], acc[8 * ks + 3]); w.z = cvtpk(acc[8 * ks + 4], acc[8 * ks + 5]); w.w = cvtpk(acc[8 * ks + 6], acc[8 * ks + 7]); pf[ks] = __builtin_bit_cast(bf16x8, w); }
#pragma unroll
                for (int dt = 0; dt < 2; ++dt)
#pragma unroll
                    for (int ks = 0; ks < 2; ++ks) { const LAS unsigned char* vp = Vb + (32 * dt + l31) * (MLV_PITCH * 2) + (32 * sub + 16 * ks + 4 * hi) * 2;
                        const u32x2 x0 = *(const LAS u32x2*)vp, x1 = *(const LAS u32x2*)(vp + 16);
                        v4u a; a.x = x0.x; a.y = x0.y; a.z = x1.x; a.w = x1.y; o[dt] = MFMA32(__builtin_bit_cast(bf16x8, a), pf[ks], o[dt]); }
                done = __all(cum < 1e-35f);
            }
        }
        if (lane == 0) flags[(i & 1) * 8 + wave] = done ? 1u : 0u;
        LAS unsigned char* nb = lds + ((i + 1) & 1) * SB_STAGE;
        *(LAS v4u*)(nb + lK) = rk; *(LAS u32x2*)(nb + lVt) = (u32x2){rv.x, rv.y}; *(LAS u32x2*)(nb + lVt + 8) = (u32x2){rv.z, rv.w};
        __syncthreads();
        unsigned nd = 0;
#pragma unroll
        for (int w8 = 0; w8 < 8; ++w8) nd += flags[(i & 1) * 8 + w8];
        if (nd == 8u) break;
    }
    store_OT(o, 1.0f, (LAS bf16_t*)(lds + 2 * SB_STAGE + 256) + wave * (32 * STG_PITCH), ymix + (rowb + q0) * DM + h * 64, lane);
    __syncthreads();
}

constexpr int RW_RAWW = 0, RW_RAWA = 2048, RW_RS = 4096, RW_KS = 6144, RW_VS = 8192;
constexpr int RW_CH0 = 10240, RW_CHSZ = 11328;
constexpr int RW_YB = RW_CH0 + 2 * RW_CHSZ;
constexpr int RW_MIX = RW_YB + 1024;
static_assert((RW_MIX + 256) * 4 <= 146432, "rwkv LDS map");
__device__ __forceinline__ float tanh_fast(float x) { return 1.f - 2.f * __builtin_amdgcn_rcpf(1.f + __expf(2.f * x)); }
__device__ __forceinline__ float sigmoid_fast(float x) { return __builtin_amdgcn_rcpf(1.f + __expf(-x)); }

#define MFMA16(a, b, c) __builtin_amdgcn_mfma_f32_16x16x32_bf16((a), (b), (c), 0, 0, 0)
constexpr int RW2_CH0 = 0, RW2_YB = 2 * RW_CHSZ, RW2_MIX = RW2_YB + 1024, RW2_STG = RW2_MIX + 448;
static_assert((RW2_STG + 2 * 3072) * 4 <= 146432, "rwkv LDS map");
__device__ __forceinline__ void rwkv_phase_scan(LAS float* sm, int tid, int lane, int wave, int blk, const bf16_t* __restrict__ proj, const float* __restrict__ mix, const float* __restrict__ w0, const float* __restrict__ a0,
                                           const float* __restrict__ k_k, const float* __restrict__ k_a, const float* __restrict__ r_k, const bf16_t* __restrict__ W2T, const bf16_t* __restrict__ A2T, const bf16_t* __restrict__ G2T,
                                           float* __restrict__ yraw, bf16_t* __restrict__ gout, float* __restrict__ bonus_out) {
    const int chain = blk >> 1, half = blk & 1, b = chain >> 3, h = chain & 7, l15 = lane & 15, kg = lane >> 4;
    const size_t rowb = (size_t)b * SEQ;
    constexpr int NCHUNK = SEQ / 32;
    if (tid < 256) sm[RW2_MIX + tid] = mix[1536 + tid];
    else if (tid < 448) { const int q = tid - 256; sm[RW2_MIX + tid] = mix[512 * (q >> 6) + h * 64 + (q & 63)]; }
    __syncthreads();
#define RW_SH8(CUR, PRV, M0, M1, OUT, PZ) do { const unsigned cu_[4] = {(CUR).x, (CUR).y, (CUR).z, (CUR).w}, pu_[4] = {(PRV).x, (PRV).y, (PRV).z, (PRV).w}; \
        const float mm_[8] = {(M0)[0], (M0)[1], (M0)[2], (M0)[3], (M1)[0], (M1)[1], (M1)[2], (M1)[3]}; \
        _Pragma("unroll") for (int q = 0; q < 4; ++q) { const float c0 = bflo(cu_[q]), c1 = bfhi(cu_[q]), p0 = bflo(pu_[q]) * (PZ), p1 = bfhi(pu_[q]) * (PZ); \
            OUT[2 * q] = c0 + (p0 - c0) * mm_[2 * q]; OUT[2 * q + 1] = c1 + (p1 - c1) * mm_[2 * q + 1]; } } while (0)
    if (wave < 4) {
        const int iA = 8 * wave + kg, iB = iA + 4, jseg = l15;
        float A0 = 0.f, A1 = 0.f, A2 = 0.f, A3 = 0.f, B0 = 0.f, B1 = 0.f, B2 = 0.f, B3 = 0.f;
        __syncthreads();
#pragma unroll 1
        for (int ch = 0; ch < NCHUNK; ++ch) {
            const int t0 = ch * 32;
            const LAS float* CHb = sm + RW2_CH0 + (ch & 1) * RW_CHSZ + 4 * jseg;
            const LAS float* CHv = sm + RW2_CH0 + (ch & 1) * RW_CHSZ + 10240 + iA;
            const LAS float* CHs = sm + RW2_CH0 + (ch & 1) * RW_CHSZ + 11264;
            f32x4 a4 = *(const LAS f32x4*)(CHb + 4096), wr4 = *(const LAS f32x4*)(CHb + 8192), w4 = *(const LAS f32x4*)(CHb), b4 = *(const LAS f32x4*)(CHb + 6144), k4 = *(const LAS f32x4*)(CHb + 2048);
            float vA = CHv[0], vB = CHv[4]; f32x2_t sc = *(const LAS f32x2_t*)(CHs);
#pragma unroll 2
            for (int t = 0; t < 32; ++t) {
                const int tq = (t + 1) & 31;
                const f32x4 a4n = *(const LAS f32x4*)(CHb + 4096 + tq * 64), wr4n = *(const LAS f32x4*)(CHb + 8192 + tq * 64), w4n = *(const LAS f32x4*)(CHb + tq * 64),
                            b4n = *(const LAS f32x4*)(CHb + 6144 + tq * 64), k4n = *(const LAS f32x4*)(CHb + 2048 + tq * 64);
                const float vAn = CHv[tq * 32], vBn = CHv[tq * 32 + 4]; const f32x2_t scn = *(const LAS f32x2_t*)(CHs + 2 * tq);
                float d1A = (A0 * a4[0] + A1 * a4[1]) + (A2 * a4[2] + A3 * a4[3]), d1B = (B0 * a4[0] + B1 * a4[1]) + (B2 * a4[2] + B3 * a4[3]);
                float d2A = (A0 * wr4[0] + A1 * wr4[1]) + (A2 * wr4[2] + A3 * wr4[3]), d2B = (B0 * wr4[0] + B1 * wr4[1]) + (B2 * wr4[2] + B3 * wr4[3]);
                d1A = rowsum16(d1A); d1B = rowsum16(d1B); d2A = rowsum16(d2A); d2B = rowsum16(d2B);
                const float yA = d2A + d1A * sc[0] + vA * sc[1], yB = d2B + d1B * sc[0] + vB * sc[1];
                A0 = A0 * w4[0] + (d1A * b4[0] + vA * k4[0]); A1 = A1 * w4[1] + (d1A * b4[1] + vA * k4[1]); A2 = A2 * w4[2] + (d1A * b4[2] + vA * k4[2]); A3 = A3 * w4[3] + (d1A * b4[3] + vA * k4[3]);
                B0 = B0 * w4[0] + (d1B * b4[0] + vB * k4[0]); B1 = B1 * w4[1] + (d1B * b4[1] + vB * k4[1]); B2 = B2 * w4[2] + (d1B * b4[2] + vB * k4[2]); B3 = B3 * w4[3] + (d1B * b4[3] + vB * k4[3]);
                if (jseg == 0) { sm[RW2_YB + t * 32 + iA] = yA; sm[RW2_YB + t * 32 + iB] = yB; }
                a4 = a4n; wr4 = wr4n; w4 = w4n; b4 = b4n; k4 = k4n; vA = vAn; vB = vBn; sc = scn;
            }
            WSYNC();
            { const int tt = lane >> 1, hh = lane & 1; const f32x4 yv = *(const LAS f32x4*)(sm + RW2_YB + tt * 32 + 8 * wave + 4 * hh);
              *(f32x4*)(yraw + (rowb + t0 + tt) * 512 + h * 64 + half * 32 + 8 * wave + 4 * hh) = yv; }
            __syncthreads();
        }
    } else if (wave < 6) {
        const int tp = wave - 4, tb = 16 * tp;
        LAS float* stg = sm + RW2_STG + tp * 3072;
        float w0c[4], a0c[4], kkc[4], kac[4], rkc[4];
#pragma unroll
        for (int nt = 0; nt < 4; ++nt) { const int c = h * 64 + 16 * nt + l15; w0c[nt] = w0[c]; a0c[nt] = a0[c]; kkc[nt] = k_k[c]; kac[nt] = k_a[c]; rkc[nt] = r_k[c]; }
        v4u ld[20];
#define PREP_ISSUE(T0) do { const int t0_ = (T0); { const size_t r_ = rowb + t0_ + tb + l15; const size_t rp_ = (t0_ + tb + l15 == 0) ? r_ : r_ - 1; \
            _Pragma("unroll") for (int lo = 0; lo < 2; ++lo) _Pragma("unroll") for (int ks = 0; ks < 2; ++ks) { const int col = 1536 + 64 * lo + 32 * ks + 8 * kg; \
                ld[(lo * 2 + ks) * 2] = *(const v4u*)(proj + r_ * L0P + col); ld[(lo * 2 + ks) * 2 + 1] = *(const v4u*)(proj + rp_ * L0P + col); } } \
            _Pragma("unroll") for (int ar = 0; ar < 3; ++ar) _Pragma("unroll") for (int i = 0; i < 2; ++i) { const int p_ = lane + 64 * i, row_ = p_ >> 3, c8_ = p_ & 7; \
                const size_t r_ = rowb + t0_ + tb + row_; const size_t rp_ = (t0_ + tb + row_ == 0) ? r_ : r_ - 1; const int col = 512 * ar + h * 64 + 8 * c8_; \
                ld[8 + (ar * 2 + i) * 2] = *(const v4u*)(proj + r_ * L0P + col); ld[8 + (ar * 2 + i) * 2 + 1] = *(const v4u*)(proj + rp_ * L0P + col); } } while (0)
#define PREP_BUILD(T0, NB) do { const int t0_ = (T0); LAS float* CHn = sm + RW2_CH0 + (NB) * RW_CHSZ; \
            f32x4 accw[4], acca[4]; \
            _Pragma("unroll") for (int nt = 0; nt < 4; ++nt) { accw[nt] = (f32x4){0.f, 0.f, 0.f, 0.f}; acca[nt] = (f32x4){0.f, 0.f, 0.f, 0.f}; } \
            { const float pz_ = (t0_ + tb + l15 == 0) ? 0.f : 1.f; \
              _Pragma("unroll") for (int lo = 0; lo < 2; ++lo) _Pragma("unroll") for (int ks = 0; ks < 2; ++ks) { float s_[8]; \
                const f32x4 m0 = *(const LAS f32x4*)(sm + RW2_MIX + 64 * lo + 32 * ks + 8 * kg), m1 = *(const LAS f32x4*)(sm + RW2_MIX + 64 * lo + 32 * ks + 8 * kg + 4); \
                RW_SH8(ld[(lo * 2 + ks) * 2], ld[(lo * 2 + ks) * 2 + 1], m0, m1, s_, pz_); \
                if (lo == 0) { _Pragma("unroll") for (int j = 0; j < 8; ++j) s_[j] = tanh_fast(s_[j]); } \
                v4u aw; aw.x = cvtpk(s_[0], s_[1]); aw.y = cvtpk(s_[2], s_[3]); aw.z = cvtpk(s_[4], s_[5]); aw.w = cvtpk(s_[6], s_[7]); const bf16x8 af = __builtin_bit_cast(bf16x8, aw); \
                const bf16_t* WT = lo ? A2T : W2T; \
                _Pragma("unroll") for (int nt = 0; nt < 4; ++nt) { const bf16x8 bfr = *(const bf16x8*)(WT + (size_t)(h * 64 + 16 * nt + l15) * 64 + 32 * ks + 8 * kg); \
                    if (lo == 0) accw[nt] = MFMA16(af, bfr, accw[nt]); else acca[nt] = MFMA16(af, bfr, acca[nt]); } } } \
            _Pragma("unroll") for (int ar = 0; ar < 3; ++ar) _Pragma("unroll") for (int i = 0; i < 2; ++i) { const int p_ = lane + 64 * i, row_ = p_ >> 3, c8_ = p_ & 7; float s_[8]; \
                const float pz_ = (t0_ + tb + row_ == 0) ? 0.f : 1.f; const f32x4 m0 = *(const LAS f32x4*)(sm + RW2_MIX + 256 + ar * 64 + c8_ * 8), m1 = *(const LAS f32x4*)(sm + RW2_MIX + 256 + ar * 64 + c8_ * 8 + 4); \
                RW_SH8(ld[8 + (ar * 2 + i) * 2], ld[8 + (ar * 2 + i) * 2 + 1], m0, m1, s_, pz_); \
                *(LAS f32x4*)(stg + ar * 1024 + row_ * 64 + c8_ * 8) = (f32x4){s_[0], s_[1], s_[2], s_[3]}; *(LAS f32x4*)(stg + ar * 1024 + row_ * 64 + c8_ * 8 + 4) = (f32x4){s_[4], s_[5], s_[6], s_[7]}; } \
            WSYNC(); \
            PREP_ISSUE(((T0) + 32 < SEQ) ? (T0) + 32 : (T0)); \
            _Pragma("unroll") for (int rg = 0; rg < 4; ++rg) { const int tl = 4 * kg + rg, t = tb + tl; \
                float r_[4], k_[4], v_[4], kkv[4], nrm2 = 0.f; \
                _Pragma("unroll") for (int nt = 0; nt < 4; ++nt) { r_[nt] = stg[tl * 64 + 16 * nt + l15]; k_[nt] = stg[1024 + tl * 64 + 16 * nt + l15]; v_[nt] = stg[2048 + tl * 64 + 16 * nt + l15]; \
                    kkv[nt] = k_[nt] * kkc[nt]; nrm2 += kkv[nt] * kkv[nt]; } \
                nrm2 = rowsum16(nrm2); const float rn = __builtin_amdgcn_rsqf(fmaxf(nrm2, 1e-24f)); \
                float br = 0.f, kr = 0.f, bon = 0.f; \
                _Pragma("unroll") for (int nt = 0; nt < 4; ++nt) { const int j = 16 * nt + l15; \
                    const float wsum = w0c[nt] + accw[nt][rg]; const float logw = -softplus_fast(-wsum) - 0.5f; const float dec = __expf(-__expf(logw)); \
                    const float a_ = sigmoid_fast(a0c[nt] + acca[nt][rg]); const float kn = kkv[nt] * rn; \
                    const float k2 = k_[nt] * (1.f + (a_ - 1.f) * kac[nt]); const float bv = kn * a_; \
                    br += bv * r_[nt]; kr += k2 * r_[nt]; bon += r_[nt] * k2 * rkc[nt]; \
                    CHn[t * 64 + j] = dec; CHn[2048 + t * 64 + j] = k2; CHn[4096 + t * 64 + j] = -kn; CHn[6144 + t * 64 + j] = bv; CHn[8192 + t * 64 + j] = dec * r_[nt]; \
                    if ((nt >> 1) == half) CHn[10240 + t * 32 + (j & 31)] = v_[nt]; } \
                br = rowsum16(br); kr = rowsum16(kr); bon = rowsum16(bon); \
                if (l15 == 0) { CHn[11264 + 2 * t] = br; CHn[11264 + 2 * t + 1] = kr; if (half == 0) bonus_out[(rowb + t0_ + t) * 8 + h] = bon; } } \
            WSYNC(); } while (0)
        PREP_ISSUE(0);
        PREP_BUILD(0, 0);
        __syncthreads();
#pragma unroll 1
        for (int ch = 0; ch < NCHUNK; ++ch) {
            if (ch + 1 < NCHUNK) PREP_BUILD(ch * 32 + 32, (ch + 1) & 1);
            __syncthreads();
        }
#undef PREP_ISSUE
#undef PREP_BUILD
    } else {
        const int tp = wave - 6, tb = 16 * tp;
        v4u ld[8];
#define G_ISSUE(T0) do { const int t0_ = (T0); const size_t r_ = rowb + t0_ + tb + l15; const size_t rp_ = (t0_ + tb + l15 == 0) ? r_ : r_ - 1; \
            _Pragma("unroll") for (int ks = 0; ks < 4; ++ks) { const int col = 1664 + 32 * ks + 8 * kg; ld[2 * ks] = *(const v4u*)(proj + r_ * L0P + col); ld[2 * ks + 1] = *(const v4u*)(proj + rp_ * L0P + col); } } while (0)
#define G_BUILD(T0) do { const int t0_ = (T0); f32x4 accg[2] = {(f32x4){0.f, 0.f, 0.f, 0.f}, (f32x4){0.f, 0.f, 0.f, 0.f}}; const float pz_ = (t0_ + tb + l15 == 0) ? 0.f : 1.f; \
            _Pragma("unroll") for (int ks = 0; ks < 4; ++ks) { float s_[8]; \
                const f32x4 m0 = *(const LAS f32x4*)(sm + RW2_MIX + 128 + 32 * ks + 8 * kg), m1 = *(const LAS f32x4*)(sm + RW2_MIX + 128 + 32 * ks + 8 * kg + 4); \
                RW_SH8(ld[2 * ks], ld[2 * ks + 1], m0, m1, s_, pz_); \
                _Pragma("unroll") for (int j = 0; j < 8; ++j) s_[j] = sigmoid_fast(s_[j]); \
                v4u aw; aw.x = cvtpk(s_[0], s_[1]); aw.y = cvtpk(s_[2], s_[3]); aw.z = cvtpk(s_[4], s_[5]); aw.w = cvtpk(s_[6], s_[7]); const bf16x8 af = __builtin_bit_cast(bf16x8, aw); \
                _Pragma("unroll") for (int nt = 0; nt < 2; ++nt) { const bf16x8 bfr = *(const bf16x8*)(G2T + (size_t)(h * 64 + half * 32 + 16 * nt + l15) * 128 + 32 * ks + 8 * kg); accg[nt] = MFMA16(af, bfr, accg[nt]); } } \
            G_ISSUE(((T0) + 32 < SEQ) ? (T0) + 32 : (T0)); \
            _Pragma("unroll") for (int nt = 0; nt < 2; ++nt) _Pragma("unroll") for (int rg = 0; rg < 4; ++rg) \
                gout[(rowb + t0_ + tb + 4 * kg + rg) * 512 + h * 64 + half * 32 + 16 * nt + l15] = (bf16_t)f2bf(accg[nt][rg]); } while (0)
        G_ISSUE(0);
        G_BUILD(0);
        __syncthreads();
#pragma unroll 1
        for (int ch = 0; ch < NCHUNK; ++ch) {
            if (ch + 1 < NCHUNK) G_BUILD(ch * 32 + 32);
            __syncthreads();
        }
#undef G_ISSUE
#undef G_BUILD
    }
#undef RW_SH8
    __syncthreads();
}

constexpr int CK_BK = 0, CK_AR = 4608, CK_BBT = 9216, CK_KBT = 12288, CK_VT = 15360, CK_GC = 16896, CK_TT = 17152, CK_SLOT = 18688, CK_NSLOT = 6, CK_NBUILD = 5;
constexpr int CK_STG = CK_SLOT * CK_NSLOT;
constexpr int CK_MIX = CK_STG + CK_NBUILD * 6144;
constexpr int CK_FLAGS = CK_MIX + 448 * 4;
static_assert(CK_FLAGS + 64 <= 146432, "rwkv chunked LDS map");
__device__ __forceinline__ void rwkv_phase(LAS float* smf, int tid, int lane, int wave, int blk, const bf16_t* __restrict__ proj, const float* __restrict__ mix, const float* __restrict__ w0, const float* __restrict__ a0,
                                           const float* __restrict__ k_k, const float* __restrict__ k_a, const float* __restrict__ r_k, const bf16_t* __restrict__ W2T, const bf16_t* __restrict__ A2T, const bf16_t* __restrict__ G2T,
                                           float* __restrict__ yraw, bf16_t* __restrict__ gout, float* __restrict__ bonus_out) {
    LAS unsigned char* lds = (LAS unsigned char*)smf;
    LAS float* mixs = (LAS float*)(lds + CK_MIX);
    volatile LAS unsigned* flags = (volatile LAS unsigned*)(lds + CK_FLAGS);
    const int chain = blk >> 1, ihalf = blk & 1, b = chain >> 3, h = chain & 7, l15 = lane & 15, kg = lane >> 4, l31 = lane & 31, hi = lane >> 5;
    const size_t rowb = (size_t)b * SEQ;
    constexpr int NCH = SEQ / 16;
    if (tid < 256) mixs[tid] = mix[1536 + tid];
    else if (tid < 448) { const int q = tid - 256; mixs[tid] = mix[512 * (q >> 6) + h * 64 + (q & 63)]; }
    if (tid < 16) flags[tid] = (tid == 9) ? (unsigned)CK_NBUILD : 0u;
    for (int q = tid; q < CK_NSLOT * 384; q += NWAVES * 64) *(LAS unsigned*)(lds + (q / 384) * CK_SLOT + CK_TT + (q % 384) * 4) = 0u;
    __syncthreads();
#define RW_SH8(CUR, PRV, M0, M1, OUT, PZ) do { const unsigned cu_[4] = {(CUR).x, (CUR).y, (CUR).z, (CUR).w}, pu_[4] = {(PRV).x, (PRV).y, (PRV).z, (PRV).w}; \
        const float mm_[8] = {(M0)[0], (M0)[1], (M0)[2], (M0)[3], (M1)[0], (M1)[1], (M1)[2], (M1)[3]}; \
        _Pragma("unroll") for (int q = 0; q < 4; ++q) { const float c0 = bflo(cu_[q]), c1 = bfhi(cu_[q]), p0 = bflo(pu_[q]) * (PZ), p1 = bfhi(pu_[q]) * (PZ); \
            OUT[2 * q] = c0 + (p0 - c0) * mm_[2 * q]; OUT[2 * q + 1] = c1 + (p1 - c1) * mm_[2 * q + 1]; } } while (0)
    if (wave == 0) {
        f32x16 ST[2];
#pragma unroll
        for (int r = 0; r < 16; ++r) { ST[0][r] = 0.f; ST[1][r] = 0.f; }
#pragma unroll 1
        for (int k = 0; k < NCH; ++k) {
#if defined(PROBE_STAMPS)
            const unsigned tw0_ = (unsigned)__builtin_amdgcn_s_memrealtime();
#endif
            { const unsigned want = (unsigned)(k + 1); const int sl = k % CK_NSLOT; while (flags[sl] != want) __builtin_amdgcn_s_sleep(1); }
#if defined(PROBE_STAMPS)
            if (blk == 0 && lane == 0) ((volatile LAS unsigned*)(lds + 146432 + 320))[16 + 24] += (unsigned)__builtin_amdgcn_s_memrealtime() - tw0_;
#endif
            asm volatile("" ::: "memory");
            const LAS unsigned char* im = lds + (k % CK_NSLOT) * CK_SLOT;
            f32x16 G;
#pragma unroll
            for (int r = 0; r < 16; ++r) G[r] = 0.f;
#pragma unroll
            for (int kk = 0; kk < 4; ++kk) { const bf16x8 fa = *(const LAS bf16x8*)(im + CK_BK + l31 * 144 + (16 * kk + 8 * hi) * 2), fb = *(const LAS bf16x8*)(im + CK_AR + l31 * 144 + (16 * kk + 8 * hi) * 2); G = MFMA32(fa, fb, G); }
            { const int tcol = l31 & 15; const bool strict = l31 < 16;
#pragma unroll
              for (int r = 0; r < 16; ++r) { const int srow = crow(r & 7, hi); const bool keep = strict ? (srow < tcol) : (srow <= tcol); G[r] = keep ? G[r] : 0.f; } }
            const bf16x8 gB = pack8(G[0], G[1], G[2], G[3], G[4], G[5], G[6], G[7]), gK = pack8(G[8], G[9], G[10], G[11], G[12], G[13], G[14], G[15]);
            f32x16 XT;
#pragma unroll
            for (int r = 0; r < 16; ++r) XT[r] = 0.f;
#pragma unroll
            for (int jt = 0; jt < 2; ++jt)
#pragma unroll
                for (int sp = 0; sp < 2; ++sp) { const LAS unsigned char* ap = im + CK_AR + l31 * 144 + (32 * jt + 16 * sp + 4 * hi) * 2;
                    const u32x2 x0 = *(const LAS u32x2*)ap, x1 = *(const LAS u32x2*)(ap + 16); v4u aw; aw.x = x0.x; aw.y = x0.y; aw.z = x1.x; aw.w = x1.y;
                    const bf16x8 sb_ = pack8(ST[jt][8 * sp], ST[jt][8 * sp + 1], ST[jt][8 * sp + 2], ST[jt][8 * sp + 3], ST[jt][8 * sp + 4], ST[jt][8 * sp + 5], ST[jt][8 * sp + 6], ST[jt][8 * sp + 7]);
                    XT = MFMA32(__builtin_bit_cast(bf16x8, aw), sb_, XT); }
            bf16x8 vP;
            { const LAS unsigned char* vp = im + CK_VT + l31 * 48 + (4 * hi) * 2; const u32x2 x0 = *(const LAS u32x2*)vp, x1 = *(const LAS u32x2*)(vp + 16); v4u vw; vw.x = x0.x; vw.y = x0.y; vw.z = x1.x; vw.w = x1.y;
              vP = __builtin_bit_cast(bf16x8, vw); XT = MFMA32(gK, vP, XT); }
            bf16x8 uP;
            { const LAS unsigned char* tp = im + CK_TT + l31 * 48 + (4 * hi) * 2; const u32x2 x0 = *(const LAS u32x2*)tp, x1 = *(const LAS u32x2*)(tp + 16); v4u tw; tw.x = x0.x; tw.y = x0.y; tw.z = x1.x; tw.w = x1.y;
              f32x16 UT;
#pragma unroll
              for (int r = 0; r < 16; ++r) UT[r] = 0.f;
              UT = MFMA32(__builtin_bit_cast(bf16x8, tw), pack8(XT[0], XT[1], XT[2], XT[3], XT[4], XT[5], XT[6], XT[7]), UT);
              uP = pack8(UT[0], UT[1], UT[2], UT[3], UT[4], UT[5], UT[6], UT[7]); }
            XT = MFMA32(gB, uP, XT);
            { float* yp = yraw + (rowb + 16 * k) * 512 + h * 64 + 32 * ihalf + l31;
#pragma unroll
              for (int q = 0; q < 8; ++q) yp[(size_t)crow(q, hi) * 512] = XT[8 + q]; }
            { const LAS float* gc = (const LAS float*)(im + CK_GC);
#pragma unroll
              for (int jt = 0; jt < 2; ++jt)
#pragma unroll
                  for (int r = 0; r < 16; ++r) ST[jt][r] *= gc[32 * jt + crow(r, hi)]; }
#pragma unroll
            for (int jt = 0; jt < 2; ++jt) { const LAS unsigned char* bp = im + CK_BBT + (32 * jt + l31) * 48 + (4 * hi) * 2; const LAS unsigned char* kp = im + CK_KBT + (32 * jt + l31) * 48 + (4 * hi) * 2;
                const u32x2 b0 = *(const LAS u32x2*)bp, b1 = *(const LAS u32x2*)(bp + 16), k0 = *(const LAS u32x2*)kp, k1 = *(const LAS u32x2*)(kp + 16);
                v4u a1; a1.x = b0.x; a1.y = b0.y; a1.z = b1.x; a1.w = b1.y; v4u a2; a2.x = k0.x; a2.y = k0.y; a2.z = k1.x; a2.w = k1.y;
                ST[jt] = MFMA32(__builtin_bit_cast(bf16x8, a1), uP, ST[jt]); ST[jt] = MFMA32(__builtin_bit_cast(bf16x8, a2), vP, ST[jt]); }
            WSYNC();
            if (lane == 0) flags[8] = (unsigned)(k + 1);
        }
    } else if (wave <= CK_NBUILD) {
        const int pw = wave - 1;
        LAS bf16_t* stg = (LAS bf16_t*)(lds + CK_STG) + pw * 3072;
        float w0c[4], a0c[4], kkc[4], kac[4], rkc[4];
#pragma unroll
        for (int nt = 0; nt < 4; ++nt) { const int c = h * 64 + 16 * nt + l15; w0c[nt] = w0[c]; a0c[nt] = a0[c]; kkc[nt] = k_k[c]; kac[nt] = k_a[c]; rkc[nt] = r_k[c]; }
        v4u ld[20];
#define CK_ISSUE_A(T0) do { const int t0_ = (T0); const size_t r_ = rowb + t0_ + l15; const size_t rp_ = (t0_ + l15 == 0) ? r_ : r_ - 1; \
            _Pragma("unroll") for (int lo = 0; lo < 2; ++lo) _Pragma("unroll") for (int ks = 0; ks < 2; ++ks) { const int col = 1536 + 64 * lo + 32 * ks + 8 * kg; \
                ld[(lo * 2 + ks) * 2] = *(const v4u*)(proj + r_ * L0P + col); ld[(lo * 2 + ks) * 2 + 1] = *(const v4u*)(proj + rp_ * L0P + col); } } while (0)
#define CK_ISSUE_B(T0) do { const int t0_ = (T0); \
            _Pragma("unroll") for (int ar = 0; ar < 3; ++ar) _Pragma("unroll") for (int i = 0; i < 2; ++i) { const int p_ = lane + 64 * i, row_ = p_ >> 3, c8_ = p_ & 7; \
                const size_t r_ = rowb + t0_ + row_; const size_t rp_ = (t0_ + row_ == 0) ? r_ : r_ - 1; const int col = 512 * ar + h * 64 + 8 * c8_; \
                ld[8 + (ar * 2 + i) * 2] = *(const v4u*)(proj + r_ * L0P + col); ld[8 + (ar * 2 + i) * 2 + 1] = *(const v4u*)(proj + rp_ * L0P + col); } } while (0)
#define CK_ISSUE(T0) do { CK_ISSUE_A(T0); CK_ISSUE_B(T0); } while (0)
        CK_ISSUE(16 * pw);
        int k = pw;
#pragma unroll 1
        while (k < NCH) {
            const int t0 = 16 * k; int kn;
#if defined(PROBE_STAMPS)
            const unsigned ts0_ = (unsigned)__builtin_amdgcn_s_memrealtime();
#endif
            f32x4 accw[4], acca[4];
#pragma unroll
            for (int nt = 0; nt < 4; ++nt) { accw[nt] = (f32x4){0.f, 0.f, 0.f, 0.f}; acca[nt] = (f32x4){0.f, 0.f, 0.f, 0.f}; }
            { const float pz_ = (t0 + l15 == 0) ? 0.f : 1.f;
#pragma unroll
              for (int lo = 0; lo < 2; ++lo)
#pragma unroll
                for (int ks = 0; ks < 2; ++ks) { float s_[8];
                    const f32x4 m0 = *(const LAS f32x4*)(mixs + 64 * lo + 32 * ks + 8 * kg), m1 = *(const LAS f32x4*)(mixs + 64 * lo + 32 * ks + 8 * kg + 4);
                    RW_SH8(ld[(lo * 2 + ks) * 2], ld[(lo * 2 + ks) * 2 + 1], m0, m1, s_, pz_);
                    if (lo == 0) {
#pragma unroll
                        for (int j = 0; j < 8; ++j) s_[j] = tanh_fast(s_[j]); }
                    const bf16x8 af = pack8(s_[0], s_[1], s_[2], s_[3], s_[4], s_[5], s_[6], s_[7]);
                    const bf16_t* WT = lo ? A2T : W2T;
#pragma unroll
                    for (int nt = 0; nt < 4; ++nt) { const bf16x8 bfr = *(const bf16x8*)(WT + (size_t)(h * 64 + 16 * nt + l15) * 64 + 32 * ks + 8 * kg);
                        if (lo == 0) accw[nt] = MFMA16(af, bfr, accw[nt]); else acca[nt] = MFMA16(af, bfr, acca[nt]); } } }
#pragma unroll
            for (int ar = 0; ar < 3; ++ar)
#pragma unroll
                for (int i = 0; i < 2; ++i) { const int p_ = lane + 64 * i, row_ = p_ >> 3, c8_ = p_ & 7; float s_[8];
                    const float pz_ = (t0 + row_ == 0) ? 0.f : 1.f; const f32x4 m0 = *(const LAS f32x4*)(mixs + 256 + ar * 64 + c8_ * 8), m1 = *(const LAS f32x4*)(mixs + 256 + ar * 64 + c8_ * 8 + 4);
                    RW_SH8(ld[8 + (ar * 2 + i) * 2], ld[8 + (ar * 2 + i) * 2 + 1], m0, m1, s_, pz_);
                    *(LAS bf16x8*)(stg + ar * 1024 + row_ * 64 + c8_ * 8) = pack8(s_[0], s_[1], s_[2], s_[3], s_[4], s_[5], s_[6], s_[7]); }
            WSYNC();
#if defined(PROBE_STAMPS)
            if (blk == 0 && wave == 1 && lane == 0) ((volatile LAS unsigned*)(lds + 146432 + 320))[16 + 26] += (unsigned)__builtin_amdgcn_s_memrealtime() - ts0_;
#endif
#if defined(PROBE_STAMPS)
            const unsigned tb0_ = (unsigned)__builtin_amdgcn_s_memrealtime();
#endif
            { const int need = k - (CK_NSLOT - 1); if (need > 0) { while ((int)flags[8] < need) __builtin_amdgcn_s_sleep(2); } }
#if defined(PROBE_STAMPS)
            if (blk == 0 && wave == 1 && lane == 0) ((volatile LAS unsigned*)(lds + 146432 + 320))[16 + 25] += (unsigned)__builtin_amdgcn_s_memrealtime() - tb0_;
#endif
            asm volatile("" ::: "memory");
            LAS unsigned char* im = lds + (k % CK_NSLOT) * CK_SLOT;
#if defined(PROBE_STAMPS)
            const unsigned ts1_ = (unsigned)__builtin_amdgcn_s_memrealtime();
#endif
            float lwv[4][4], av[4][4], knv[4][4];
#pragma unroll
            for (int rg = 0; rg < 4; ++rg) { const int tl = 4 * kg + rg;
                float kkv[4], nrm2 = 0.f, vv[4], rr_[4], kr_[4];
#pragma unroll
                for (int nt = 0; nt < 4; ++nt) { rr_[nt] = bf2f(stg[tl * 64 + 16 * nt + l15]); kr_[nt] = bf2f(stg[1024 + tl * 64 + 16 * nt + l15]); vv[nt] = bf2f(stg[2048 + tl * 64 + 16 * nt + l15]);
                    kkv[nt] = kr_[nt] * kkc[nt]; nrm2 += kkv[nt] * kkv[nt]; }
                nrm2 = rowsum16(nrm2); const float rn = __builtin_amdgcn_rsqf(fmaxf(nrm2, 1e-24f));
                float bon = 0.f;
#pragma unroll
                for (int nt = 0; nt < 4; ++nt) {
                    const float wsum = w0c[nt] + accw[nt][rg]; lwv[nt][rg] = -0.6065306597126334f * sigmoid_fast(wsum);
                    const float a_ = sigmoid_fast(a0c[nt] + acca[nt][rg]); av[nt][rg] = a_; knv[nt][rg] = kkv[nt] * rn;
                    const float k2 = kr_[nt] * (1.f + (a_ - 1.f) * kac[nt]); stg[1024 + tl * 64 + 16 * nt + l15] = bf1(k2);
                    bon += rr_[nt] * k2 * rkc[nt];
                    if ((nt >> 1) == ihalf) *(LAS bf16_t*)(im + CK_VT + (16 * (nt & 1) + l15) * 48 + tl * 2) = bf1(vv[nt]);
                }
                bon = rowsum16(bon);
                if (l15 == 0 && ihalf == 0) bonus_out[(rowb + t0 + tl) * 8 + h] = bon;
            }
            { unsigned g_ = 0; if (lane == 0) g_ = __hip_atomic_fetch_add((LAS unsigned*)(lds + CK_FLAGS + 36), 1u, __ATOMIC_RELAXED, __HIP_MEMORY_SCOPE_WORKGROUP);
              kn = (int)__builtin_amdgcn_readfirstlane(g_); }
            CK_ISSUE_A((kn < NCH) ? 16 * kn : t0);
#pragma unroll
            for (int nt = 0; nt < 4; ++nt) {
                float L[4]; L[0] = lwv[nt][0]; L[1] = L[0] + lwv[nt][1]; L[2] = L[1] + lwv[nt][2]; L[3] = L[2] + lwv[nt][3];
                const float T0 = __shfl(L[3], l15), T1 = __shfl(L[3], 16 + l15), T2 = __shfl(L[3], 32 + l15), T3 = __shfl(L[3], 48 + l15);
                const float off = (kg > 0 ? T0 : 0.f) + (kg > 1 ? T1 : 0.f) + (kg > 2 ? T2 : 0.f), LC = (T0 + T1) + (T2 + T3);
                const int j = 16 * nt + l15;
                unsigned bb2[2], kb2[2];
                const float gC = __expf(LC); float eprev = __expf(off);
#pragma unroll
                for (int rg = 0; rg < 4; ++rg) { const int tl = 4 * kg + rg; const float Lt = off + L[rg], e1 = __expf(Lt), e2 = __builtin_amdgcn_rcpf(e1), e3 = eprev, e4 = gC * e2; eprev = e1;
                    const float kn = knv[nt][rg], bvv = kn * av[nt][rg], k2 = bf2f(stg[1024 + tl * 64 + j]), rr2 = bf2f(stg[tl * 64 + j]);
                    *(LAS bf16_t*)(im + CK_BK + tl * 144 + j * 2) = bf1(bvv * e2); *(LAS bf16_t*)(im + CK_BK + (16 + tl) * 144 + j * 2) = bf1(k2 * e2);
                    *(LAS bf16_t*)(im + CK_AR + tl * 144 + j * 2) = bf1(-kn * e3); *(LAS bf16_t*)(im + CK_AR + (16 + tl) * 144 + j * 2) = bf1(rr2 * e1);
                    const unsigned bq = bf1(bvv * e4), kq = bf1(k2 * e4);
                    if (rg & 1) { bb2[rg >> 1] |= bq << 16; kb2[rg >> 1] |= kq << 16; } else { bb2[rg >> 1] = bq; kb2[rg >> 1] = kq; } }
                *(LAS u32x2*)(im + CK_BBT + j * 48 + (4 * kg) * 2) = (u32x2){bb2[0], bb2[1]}; *(LAS u32x2*)(im + CK_KBT + j * 48 + (4 * kg) * 2) = (u32x2){kb2[0], kb2[1]};
                if (kg == 0) *(LAS float*)(im + CK_GC + j * 4) = gC;
            }
            WSYNC();
#if defined(PROBE_STAMPS)
            const unsigned ts2_ = (unsigned)__builtin_amdgcn_s_memrealtime();
            if (blk == 0 && wave == 1 && lane == 0) ((volatile LAS unsigned*)(lds + 146432 + 320))[16 + 27] += ts2_ - ts1_;
#endif
            {
                f32x4 nacc = {0.f, 0.f, 0.f, 0.f};
#pragma unroll
                for (int ks = 0; ks < 2; ++ks) { const bf16x8 fa = *(const LAS bf16x8*)(im + CK_BK + l15 * 144 + (32 * ks + 8 * kg) * 2), fb = *(const LAS bf16x8*)(im + CK_AR + l15 * 144 + (32 * ks + 8 * kg) * 2); nacc = MFMA16(fa, fb, nacc); }
#pragma unroll
                for (int rg = 0; rg < 4; ++rg) nacc[rg] = ((4 * kg + rg) < l15) ? nacc[rg] : 0.f;
                float Tr[16];
#pragma unroll
                for (int t = 0; t < 16; ++t) { float acc_ = (l15 == t) ? 1.f : 0.f;
#pragma unroll
                    for (int s2 = 0; s2 < t; ++s2) acc_ += Tr[s2] * rl(nacc[s2 & 3], t + 16 * (s2 >> 2));
                    Tr[t] = acc_; }
                if (kg == 0) {
#pragma unroll
                    for (int t = 0; t < 16; ++t) *(LAS bf16_t*)(im + CK_TT + t * 48 + l15 * 2) = bf1(Tr[t]); }
            }
            WSYNC();
#if defined(PROBE_STAMPS)
            if (blk == 0 && wave == 1 && lane == 0) ((volatile LAS unsigned*)(lds + 146432 + 320))[16 + 28] += (unsigned)__builtin_amdgcn_s_memrealtime() - ts2_;
#endif
            if (lane == 0) flags[k % CK_NSLOT] = (unsigned)(k + 1);
            CK_ISSUE_B((kn < NCH) ? 16 * kn : t0);
            k = kn;
        }
#undef CK_ISSUE
#undef CK_ISSUE_A
#undef CK_ISSUE_B
    } else {
        const int gq = wave - 6;
        v4u ld[8];
#define G_ISSUE(T0) do { const int t0_ = (T0); const size_t r_ = rowb + t0_ + l15; const size_t rp_ = (t0_ + l15 == 0) ? r_ : r_ - 1; \
            _Pragma("unroll") for (int ks = 0; ks < 4; ++ks) { const int col = 1664 + 32 * ks + 8 * kg; ld[2 * ks] = *(const v4u*)(proj + r_ * L0P + col); ld[2 * ks + 1] = *(const v4u*)(proj + rp_ * L0P + col); } } while (0)
        G_ISSUE(16 * gq);
#pragma unroll 1
        for (int k = gq; k < NCH; k += 2) {
            const int t0 = 16 * k;
            f32x4 accg[2] = {(f32x4){0.f, 0.f, 0.f, 0.f}, (f32x4){0.f, 0.f, 0.f, 0.f}}; const float pz_ = (t0 + l15 == 0) ? 0.f : 1.f;
#pragma unroll
            for (int ks = 0; ks < 4; ++ks) { float s_[8];
                const f32x4 m0 = *(const LAS f32x4*)(mixs + 128 + 32 * ks + 8 * kg), m1 = *(const LAS f32x4*)(mixs + 128 + 32 * ks + 8 * kg + 4);
                RW_SH8(ld[2 * ks], ld[2 * ks + 1], m0, m1, s_, pz_);
#pragma unroll
                for (int j = 0; j < 8; ++j) s_[j] = sigmoid_fast(s_[j]);
                const bf16x8 af = pack8(s_[0], s_[1], s_[2], s_[3], s_[4], s_[5], s_[6], s_[7]);
#pragma unroll
                for (int nt = 0; nt < 2; ++nt) { const bf16x8 bfr = *(const bf16x8*)(G2T + (size_t)(h * 64 + ihalf * 32 + 16 * nt + l15) * 128 + 32 * ks + 8 * kg); accg[nt] = MFMA16(af, bfr, accg[nt]); } }
            G_ISSUE((k + 2 < NCH) ? t0 + 32 : t0);
#pragma unroll
            for (int nt = 0; nt < 2; ++nt)
#pragma unroll
                for (int rg = 0; rg < 4; ++rg) gout[(rowb + t0 + 4 * kg + rg) * 512 + h * 64 + ihalf * 32 + 16 * nt + l15] = bf1(accg[nt][rg]);
        }
#undef G_ISSUE
    }
#undef RW_SH8
    __syncthreads();
}

constexpr int CC_BK = 0, CC_AR = 4608, CC_BBT = 9216, CC_KBT = 11776, CC_VT = 14336, CC_GC = 16896, CC_TT = 17152, CC_SLOT = 18432, CC_NSLOT = 6, CC_NBUILD = 6;
constexpr int CC_STG = CC_SLOT * CC_NSLOT;
constexpr int CC_MIX = CC_STG + CC_NBUILD * 4096;
constexpr int CC_FLAGS = CC_MIX + 448 * 4;
static_assert(CC_FLAGS + 64 <= 146432, "rwkv chain LDS map");
__device__ __forceinline__ void rwkv_phase_chain(LAS float* smf, int tid, int lane, int wave, int blk, const bf16_t* __restrict__ proj, const float* __restrict__ mix, const float* __restrict__ w0, const float* __restrict__ a0,
                                           const float* __restrict__ k_k, const float* __restrict__ k_a, const float* __restrict__ r_k, const bf16_t* __restrict__ W2T, const bf16_t* __restrict__ A2T, const bf16_t* __restrict__ G2T,
                                           float* __restrict__ yraw, bf16_t* __restrict__ gout, float* __restrict__ bonus_out) {
    LAS unsigned char* lds = (LAS unsigned char*)smf;
    LAS float* mixs = (LAS float*)(lds + CC_MIX);
    volatile LAS unsigned* flags = (volatile LAS unsigned*)(lds + CC_FLAGS);
    const int chain = blk, b = chain >> 3, h = chain & 7, l15 = lane & 15, kg = lane >> 4, l31 = lane & 31, hi = lane >> 5;
    const size_t rowb = (size_t)b * SEQ;
    constexpr int NCH = SEQ / 16;
    if (tid < 256) mixs[tid] = mix[1536 + tid];
    else if (tid < 448) { const int q = tid - 256; mixs[tid] = mix[512 * (q >> 6) + h * 64 + (q & 63)]; }
    if (tid < 16) flags[tid] = (tid == 10) ? (unsigned)CC_NBUILD : 0u;
    for (int q = tid; q < CC_NSLOT * 320; q += NWAVES * 64) *(LAS unsigned*)(lds + (q / 320) * CC_SLOT + CC_TT + (q % 320) * 4) = 0u;
    __syncthreads();
#define RW_SH8(CUR, PRV, M0, M1, OUT, PZ) do { const unsigned cu_[4] = {(CUR).x, (CUR).y, (CUR).z, (CUR).w}, pu_[4] = {(PRV).x, (PRV).y, (PRV).z, (PRV).w}; \
        const float mm_[8] = {(M0)[0], (M0)[1], (M0)[2], (M0)[3], (M1)[0], (M1)[1], (M1)[2], (M1)[3]}; \
        _Pragma("unroll") for (int q = 0; q < 4; ++q) { const float c0 = bflo(cu_[q]), c1 = bfhi(cu_[q]), p0 = bflo(pu_[q]) * (PZ), p1 = bfhi(pu_[q]) * (PZ); \
            OUT[2 * q] = c0 + (p0 - c0) * mm_[2 * q]; OUT[2 * q + 1] = c1 + (p1 - c1) * mm_[2 * q + 1]; } } while (0)
    if (wave < 2) {
        const int ihalf = wave;
        f32x16 ST[2];
#pragma unroll
        for (int r = 0; r < 16; ++r) { ST[0][r] = 0.f; ST[1][r] = 0.f; }
#pragma unroll 1
        for (int k = 0; k < NCH; ++k) {
            { const unsigned want = (unsigned)(k + 1); const int sl = k % CC_NSLOT; while (flags[sl] != want) __builtin_amdgcn_s_sleep(1); }
            asm volatile("" ::: "memory");
            const LAS unsigned char* im = lds + (k % CC_NSLOT) * CC_SLOT;
            f32x16 G;
#pragma unroll
            for (int r = 0; r < 16; ++r) G[r] = 0.f;
#pragma unroll
            for (int kk = 0; kk < 4; ++kk) { const bf16x8 fa = *(const LAS bf16x8*)(im + CC_BK + l31 * 144 + (16 * kk + 8 * hi) * 2), fb = *(const LAS bf16x8*)(im + CC_AR + l31 * 144 + (16 * kk + 8 * hi) * 2); G = MFMA32(fa, fb, G); }
            { const int tcol = l31 & 15; const bool strict = l31 < 16;
#pragma unroll
              for (int r = 0; r < 16; ++r) { const int srow = crow(r & 7, hi); const bool keep = strict ? (srow < tcol) : (srow <= tcol); G[r] = keep ? G[r] : 0.f; } }
            const bf16x8 gB = pack8(G[0], G[1], G[2], G[3], G[4], G[5], G[6], G[7]), gK = pack8(G[8], G[9], G[10], G[11], G[12], G[13], G[14], G[15]);
            f32x16 XT;
#pragma unroll
            for (int r = 0; r < 16; ++r) XT[r] = 0.f;
#pragma unroll
            for (int jt = 0; jt < 2; ++jt)
#pragma unroll
                for (int sp = 0; sp < 2; ++sp) { const LAS unsigned char* ap = im + CC_AR + l31 * 144 + (32 * jt + 16 * sp + 4 * hi) * 2;
                    const u32x2 x0 = *(const LAS u32x2*)ap, x1 = *(const LAS u32x2*)(ap + 16); v4u aw; aw.x = x0.x; aw.y = x0.y; aw.z = x1.x; aw.w = x1.y;
                    const bf16x8 sb_ = pack8(ST[jt][8 * sp], ST[jt][8 * sp + 1], ST[jt][8 * sp + 2], ST[jt][8 * sp + 3], ST[jt][8 * sp + 4], ST[jt][8 * sp + 5], ST[jt][8 * sp + 6], ST[jt][8 * sp + 7]);
                    XT = MFMA32(__builtin_bit_cast(bf16x8, aw), sb_, XT); }
            bf16x8 vP;
            { const LAS unsigned char* vp = im + CC_VT + (32 * ihalf + l31) * 40 + (4 * hi) * 2; const u32x2 x0 = *(const LAS u32x2*)vp, x1 = *(const LAS u32x2*)(vp + 16); v4u vw; vw.x = x0.x; vw.y = x0.y; vw.z = x1.x; vw.w = x1.y;
              vP = __builtin_bit_cast(bf16x8, vw); XT = MFMA32(gK, vP, XT); }
            bf16x8 uP;
            { const LAS unsigned char* tp = im + CC_TT + l31 * 40 + (4 * hi) * 2; const u32x2 x0 = *(const LAS u32x2*)tp, x1 = *(const LAS u32x2*)(tp + 16); v4u tw; tw.x = x0.x; tw.y = x0.y; tw.z = x1.x; tw.w = x1.y;
              f32x16 UT;
#pragma unroll
              for (int r = 0; r < 16; ++r) UT[r] = 0.f;
              UT = MFMA32(__builtin_bit_cast(bf16x8, tw), pack8(XT[0], XT[1], XT[2], XT[3], XT[4], XT[5], XT[6], XT[7]), UT);
              uP = pack8(UT[0], UT[1], UT[2], UT[3], UT[4], UT[5], UT[6], UT[7]); }
            XT = MFMA32(gB, uP, XT);
            { float* yp = yraw + (rowb + 16 * k) * 512 + h * 64 + 32 * ihalf + l31;
#pragma unroll
              for (int q = 0; q < 8; ++q) yp[(size_t)crow(q, hi) * 512] = XT[8 + q]; }
            { const LAS float* gc = (const LAS float*)(im + CC_GC);
#pragma unroll
              for (int jt = 0; jt < 2; ++jt)
#pragma unroll
                  for (int r = 0; r < 16; ++r) ST[jt][r] *= gc[32 * jt + crow(r, hi)]; }
#pragma unroll
            for (int jt = 0; jt < 2; ++jt) { const LAS unsigned char* bp = im + CC_BBT + (32 * jt + l31) * 40 + (4 * hi) * 2; const LAS unsigned char* kp = im + CC_KBT + (32 * jt + l31) * 40 + (4 * hi) * 2;
                const u32x2 b0 = *(const LAS u32x2*)bp, b1 = *(const LAS u32x2*)(bp + 16), k0 = *(const LAS u32x2*)kp, k1 = *(const LAS u32x2*)(kp + 16);
                v4u a1; a1.x = b0.x; a1.y = b0.y; a1.z = b1.x; a1.w = b1.y; v4u a2; a2.x = k0.x; a2.y = k0.y; a2.z = k1.x; a2.w = k1.y;
                ST[jt] = MFMA32(__builtin_bit_cast(bf16x8, a1), uP, ST[jt]); ST[jt] = MFMA32(__builtin_bit_cast(bf16x8, a2), vP, ST[jt]); }
            WSYNC();
            if (lane == 0) flags[8 + ihalf] = (unsigned)(k + 1);
        }
    } else {
        const int pw = wave - 2;
        LAS bf16_t* stg = (LAS bf16_t*)(lds + CC_STG) + pw * 2048;
        v4u ld[20];
#define CC_ISSUE_A(T0) do { const int t0_ = (T0); const size_t r_ = rowb + t0_ + l15; const size_t rp_ = (t0_ + l15 == 0) ? r_ : r_ - 1; \
            _Pragma("unroll") for (int lo = 0; lo < 2; ++lo) _Pragma("unroll") for (int ks = 0; ks < 2; ++ks) { const int col = 1536 + 64 * lo + 32 * ks + 8 * kg; \
                ld[(lo * 2 + ks) * 2] = *(const v4u*)(proj + r_ * L0P + col); ld[(lo * 2 + ks) * 2 + 1] = *(const v4u*)(proj + rp_ * L0P + col); } } while (0)
#define CC_ISSUE_B(T0) do { const int t0_ = (T0); \
            _Pragma("unroll") for (int ar = 0; ar < 3; ++ar) _Pragma("unroll") for (int i = 0; i < 2; ++i) { const int p_ = lane + 64 * i, row_ = p_ >> 3, c8_ = p_ & 7; \
                const size_t r_ = rowb + t0_ + row_; const size_t rp_ = (t0_ + row_ == 0) ? r_ : r_ - 1; const int col = 512 * ar + h * 64 + 8 * c8_; \
                ld[8 + (ar * 2 + i) * 2] = *(const v4u*)(proj + r_ * L0P + col); ld[8 + (ar * 2 + i) * 2 + 1] = *(const v4u*)(proj + rp_ * L0P + col); } } while (0)
#define CC_ISSUE(T0) do { CC_ISSUE_A(T0); CC_ISSUE_B(T0); } while (0)
        CC_ISSUE(16 * pw);
        int k = pw;
#pragma unroll 1
        while (k < NCH) {
            const int t0 = 16 * k; int kn;
            f32x4 accw[4], acca[4];
#pragma unroll
            for (int nt = 0; nt < 4; ++nt) { accw[nt] = (f32x4){0.f, 0.f, 0.f, 0.f}; acca[nt] = (f32x4){0.f, 0.f, 0.f, 0.f}; }
            { const float pz_ = (t0 + l15 == 0) ? 0.f : 1.f;
#pragma unroll
              for (int lo = 0; lo < 2; ++lo)
#pragma unroll
                for (int ks = 0; ks < 2; ++ks) { float s_[8];
                    const f32x4 m0 = *(const LAS f32x4*)(mixs + 64 * lo + 32 * ks + 8 * kg), m1 = *(const LAS f32x4*)(mixs + 64 * lo + 32 * ks + 8 * kg + 4);
                    RW_SH8(ld[(lo * 2 + ks) * 2], ld[(lo * 2 + ks) * 2 + 1], m0, m1, s_, pz_);
                    if (lo == 0) {
#pragma unroll
                        for (int j = 0; j < 8; ++j) s_[j] = tanh_fast(s_[j]); }
                    const bf16x8 af = pack8(s_[0], s_[1], s_[2], s_[3], s_[4], s_[5], s_[6], s_[7]);
                    const bf16_t* WT = lo ? A2T : W2T;
#pragma unroll
                    for (int nt = 0; nt < 4; ++nt) { const bf16x8 bfr = *(const bf16x8*)(WT + (size_t)(h * 64 + 16 * nt + l15) * 64 + 32 * ks + 8 * kg);
                        if (lo == 0) accw[nt] = MFMA16(af, bfr, accw[nt]); else acca[nt] = MFMA16(af, bfr, acca[nt]); } } }
            { const int need = k - (CC_NSLOT - 1); if (need > 0) { while ((int)flags[8] < need || (int)flags[9] < need) __builtin_amdgcn_s_sleep(2); } }
            asm volatile("" ::: "memory");
            LAS unsigned char* im = lds + (k % CC_NSLOT) * CC_SLOT;
#pragma unroll
            for (int ar = 0; ar < 3; ++ar)
#pragma unroll
                for (int i = 0; i < 2; ++i) { const int p_ = lane + 64 * i, row_ = p_ >> 3, c8_ = p_ & 7; float s_[8];
                    const float pz_ = (t0 + row_ == 0) ? 0.f : 1.f; const f32x4 m0 = *(const LAS f32x4*)(mixs + 256 + ar * 64 + c8_ * 8), m1 = *(const LAS f32x4*)(mixs + 256 + ar * 64 + c8_ * 8 + 4);
                    RW_SH8(ld[8 + (ar * 2 + i) * 2], ld[8 + (ar * 2 + i) * 2 + 1], m0, m1, s_, pz_);
                    if (ar < 2) *(LAS bf16x8*)(stg + ar * 1024 + row_ * 64 + c8_ * 8) = pack8(s_[0], s_[1], s_[2], s_[3], s_[4], s_[5], s_[6], s_[7]);
                    else {
#pragma unroll
                        for (int j = 0; j < 8; ++j) *(LAS bf16_t*)(im + CC_VT + (c8_ * 8 + j) * 40 + row_ * 2) = bf1(s_[j]); } }
            WSYNC();
            float lwv[4][4], av[4][4], knv[4][4];
            float w0c[4], a0c[4], kkc[4], kac[4], rkc[4];
#pragma unroll
            for (int nt = 0; nt < 4; ++nt) { const int c = h * 64 + 16 * nt + l15; w0c[nt] = w0[c]; a0c[nt] = a0[c]; kkc[nt] = k_k[c]; kac[nt] = k_a[c]; rkc[nt] = r_k[c]; }
#pragma unroll
            for (int rg = 0; rg < 4; ++rg) { const int tl = 4 * kg + rg;
                float kkv[4], nrm2 = 0.f, rr_[4], kr_[4];
#pragma unroll
                for (int nt = 0; nt < 4; ++nt) { rr_[nt] = bf2f(stg[tl * 64 + 16 * nt + l15]); kr_[nt] = bf2f(stg[1024 + tl * 64 + 16 * nt + l15]);
                    kkv[nt] = kr_[nt] * kkc[nt]; nrm2 += kkv[nt] * kkv[nt]; }
                nrm2 = rowsum16(nrm2); const float rn = __builtin_amdgcn_rsqf(fmaxf(nrm2, 1e-24f));
                float bon = 0.f;
#pragma unroll
                for (int nt = 0; nt < 4; ++nt) {
                    const float wsum = w0c[nt] + accw[nt][rg]; lwv[nt][rg] = -0.6065306597126334f * sigmoid_fast(wsum);
                    const float a_ = sigmoid_fast(a0c[nt] + acca[nt][rg]); av[nt][rg] = a_; knv[nt][rg] = kkv[nt] * rn;
                    const float k2 = kr_[nt] * (1.f + (a_ - 1.f) * kac[nt]); stg[1024 + tl * 64 + 16 * nt + l15] = bf1(k2);
                    bon += rr_[nt] * k2 * rkc[nt];
                }
                bon = rowsum16(bon);
                if (l15 == 0) bonus_out[(rowb + t0 + tl) * 8 + h] = bon;
            }
            { unsigned g_ = 0; if (lane == 0) g_ = __hip_atomic_fetch_add((LAS unsigned*)(lds + CC_FLAGS + 40), 1u, __ATOMIC_RELAXED, __HIP_MEMORY_SCOPE_WORKGROUP);
              kn = (int)__builtin_amdgcn_readfirstlane(g_); }
            CC_ISSUE_A((kn < NCH) ? 16 * kn : t0);
#pragma unroll
            for (int nt = 0; nt < 4; ++nt) {
                float L[4]; L[0] = lwv[nt][0]; L[1] = L[0] + lwv[nt][1]; L[2] = L[1] + lwv[nt][2]; L[3] = L[2] + lwv[nt][3];
                const float T0 = __shfl(L[3], l15), T1 = __shfl(L[3], 16 + l15), T2 = __shfl(L[3], 32 + l15), T3 = __shfl(L[3], 48 + l15);
                const float off = (kg > 0 ? T0 : 0.f) + (kg > 1 ? T1 : 0.f) + (kg > 2 ? T2 : 0.f), LC = (T0 + T1) + (T2 + T3);
                const int j = 16 * nt + l15;
                unsigned bb2[2], kb2[2];
                const float gC = __expf(LC); float eprev = __expf(off);
#pragma unroll
                for (int rg = 0; rg < 4; ++rg) { const int tl = 4 * kg + rg; const float Lt = off + L[rg], e1 = __expf(Lt), e2 = __builtin_amdgcn_rcpf(e1), e3 = eprev, e4 = gC * e2; eprev = e1;
                    const float kn = knv[nt][rg], bvv = kn * av[nt][rg], k2 = bf2f(stg[1024 + tl * 64 + j]), rr2 = bf2f(stg[tl * 64 + j]);
                    *(LAS bf16_t*)(im + CC_BK + tl * 144 + j * 2) = bf1(bvv * e2); *(LAS bf16_t*)(im + CC_BK + (16 + tl) * 144 + j * 2) = bf1(k2 * e2);
                    *(LAS bf16_t*)(im + CC_AR + tl * 144 + j * 2) = bf1(-kn * e3); *(LAS bf16_t*)(im + CC_AR + (16 + tl) * 144 + j * 2) = bf1(rr2 * e1);
                    const unsigned bq = bf1(bvv * e4), kq = bf1(k2 * e4);
                    if (rg & 1) { bb2[rg >> 1] |= bq << 16; kb2[rg >> 1] |= kq << 16; } else { bb2[rg >> 1] = bq; kb2[rg >> 1] = kq; } }
                *(LAS u32x2*)(im + CC_BBT + j * 40 + (4 * kg) * 2) = (u32x2){bb2[0], bb2[1]}; *(LAS u32x2*)(im + CC_KBT + j * 40 + (4 * kg) * 2) = (u32x2){kb2[0], kb2[1]};
                if (kg == 0) *(LAS float*)(im + CC_GC + j * 4) = gC;
            }
            WSYNC();
            {
                f32x4 nacc = {0.f, 0.f, 0.f, 0.f};
#pragma unroll
                for (int ks = 0; ks < 2; ++ks) { const bf16x8 fa = *(const LAS bf16x8*)(im + CC_BK + l15 * 144 + (32 * ks + 8 * kg) * 2), fb = *(const LAS bf16x8*)(im + CC_AR + l15 * 144 + (32 * ks + 8 * kg) * 2); nacc = MFMA16(fa, fb, nacc); }
#pragma unroll
                for (int rg = 0; rg < 4; ++rg) nacc[rg] = ((4 * kg + rg) < l15) ? nacc[rg] : 0.f;
                float Tr[16];
#pragma unroll
                for (int t = 0; t < 16; ++t) { float acc_ = (l15 == t) ? 1.f : 0.f;
#pragma unroll
                    for (int s2 = 0; s2 < t; ++s2) acc_ += Tr[s2] * rl(nacc[s2 & 3], t + 16 * (s2 >> 2));
                    Tr[t] = acc_; }
                if (kg == 0) {
#pragma unroll
                    for (int t = 0; t < 16; ++t) *(LAS bf16_t*)(im + CC_TT + t * 40 + l15 * 2) = bf1(Tr[t]); }
            }
            WSYNC();
            if (lane == 0) flags[k % CC_NSLOT] = (unsigned)(k + 1);
            CC_ISSUE_B((kn < NCH) ? 16 * kn : t0);
            k = kn;
        }
#undef CC_ISSUE
#undef CC_ISSUE_A
#undef CC_ISSUE_B
    }
#undef RW_SH8
    __syncthreads();
}


__device__ __forceinline__ void gate_lora_task(int chain, int k, int lane, const bf16_t* __restrict__ proj, const float* __restrict__ mix, const bf16_t* __restrict__ G2T, bf16_t* __restrict__ gout) {
    const int b = chain >> 3, h = chain & 7, l15 = lane & 15, kg = lane >> 4, t0 = 16 * k;
    const size_t rowb = (size_t)b * SEQ, r_ = rowb + t0 + l15, rp_ = (t0 + l15 == 0) ? r_ : r_ - 1;
    const float pz_ = (t0 + l15 == 0) ? 0.f : 1.f;
    v4u cu[4], pv[4];
#pragma unroll
    for (int ks = 0; ks < 4; ++ks) { const int col = 1664 + 32 * ks + 8 * kg; cu[ks] = *(const v4u*)(proj + r_ * L0P + col); pv[ks] = *(const v4u*)(proj + rp_ * L0P + col); }
    f32x4 accg[4];
#pragma unroll
    for (int nt = 0; nt < 4; ++nt) accg[nt] = (f32x4){0.f, 0.f, 0.f, 0.f};
#pragma unroll
    for (int ks = 0; ks < 4; ++ks) {
        const f32x4 m0 = *(const f32x4*)(mix + 1664 + 32 * ks + 8 * kg), m1 = *(const f32x4*)(mix + 1664 + 32 * ks + 8 * kg + 4);
        const float mm[8] = {m0[0], m0[1], m0[2], m0[3], m1[0], m1[1], m1[2], m1[3]};
        const unsigned cw[4] = {cu[ks].x, cu[ks].y, cu[ks].z, cu[ks].w}, pw[4] = {pv[ks].x, pv[ks].y, pv[ks].z, pv[ks].w};
        float s_[8];
#pragma unroll
        for (int q = 0; q < 4; ++q) { const float c0 = bflo(cw[q]), c1 = bfhi(cw[q]), p0 = bflo(pw[q]) * pz_, p1 = bfhi(pw[q]) * pz_;
            s_[2 * q] = sigmoid_fast(c0 + (p0 - c0) * mm[2 * q]); s_[2 * q + 1] = sigmoid_fast(c1 + (p1 - c1) * mm[2 * q + 1]); }
        const bf16x8 af = pack8(s_[0], s_[1], s_[2], s_[3], s_[4], s_[5], s_[6], s_[7]);
#pragma unroll
        for (int nt = 0; nt < 4; ++nt) { const bf16x8 bfr = *(const bf16x8*)(G2T + (size_t)(h * 64 + 16 * nt + l15) * 128 + 32 * ks + 8 * kg); accg[nt] = MFMA16(af, bfr, accg[nt]); }
    }
#pragma unroll
    for (int nt = 0; nt < 4; ++nt)
#pragma unroll
        for (int rg = 0; rg < 4; ++rg) gout[(rowb + t0 + 4 * kg + rg) * 512 + h * 64 + 16 * nt + l15] = bf1(accg[nt][rg]);
}

template <bool ST = true> __device__ __forceinline__ void rwkv_post_all(const float* __restrict__ yraw, const bf16_t* __restrict__ proj, const float* __restrict__ mix, const float* __restrict__ bonus, const bf16_t* __restrict__ gbuf,
                                              const float* __restrict__ ln_g, const float* __restrict__ ln_b, bf16_t* __restrict__ ymix, int gw, int NGW, int lane) {
    for (int m = gw; m < M; m += NGW) {
        const bool has_prev = (m & (SEQ - 1)) != 0;
        float y[8], cv[8], pv[8], gg[8], bo[8];
#pragma unroll
        for (int h = 0; h < 8; ++h) { const int c = h * 64 + lane; y[h] = yraw[(size_t)m * 512 + c]; cv[h] = bf2f(proj[(size_t)m * L0P + 1024 + c]);
            pv[h] = bf2f(proj[(size_t)(has_prev ? m - 1 : m) * L0P + 1024 + c]); gg[h] = bf2f(gbuf[(size_t)m * 512 + c]); bo[h] = bonus[(size_t)m * 8 + h]; }
#pragma unroll
        for (int h = 0; h < 8; ++h) { const int c = h * 64 + lane;
            const float mu = wave_sum_dpp(y[h]) * (1.f / 64.f), d = y[h] - mu, var = wave_sum_dpp(d * d) * (1.f / 64.f);
            const float yn = d * __builtin_amdgcn_rsqf(var + 64e-5f) * ln_g[c] + ln_b[c];
            const float pvv = has_prev ? pv[h] : 0.f;
            const float v_s = cv[h] + (pvv - cv[h]) * mix[1024 + c];
            const float o = (yn + bo[h] * v_s) * gg[h];
            if (ST) ymix[(size_t)m * DM + c] = bf1(o); else asm volatile("" :: "v"(o)); }
    }
}


__device__ __forceinline__ void ssd_conv_tile(int it, int lane, LAS bf16_t* scr, const bf16_t* __restrict__ proj, const float* __restrict__ cw, const float* __restrict__ cb,
                                              bf16_t* __restrict__ xbc, bf16_t* __restrict__ xst, bf16_t* __restrict__ bt) {
    const int tt = it >> 4, ct = it & 15, m0 = tt * 64, b = m0 >> 11, t0 = m0 & (SEQ - 1), c = ct * 64 + lane;
    const float w0 = cw[c], w1 = cw[1024 + c], w2 = cw[2048 + c], w3 = cw[3072 + c], bias = cb[c];
    const bf16_t* src = proj + (size_t)m0 * L0P + 2304 + c;
    bf16_t raw[67];
    const int lo = (t0 > 0) ? -3 : 0;
#pragma unroll
    for (int t = -3; t < 64; ++t) raw[t + 3] = src[(ptrdiff_t)((t < lo) ? lo : t) * L0P];
    float u3 = (t0 > 0) ? bf2f(raw[0]) : 0.f, u2 = (t0 > 0) ? bf2f(raw[1]) : 0.f, u1 = (t0 > 0) ? bf2f(raw[2]) : 0.f;
#pragma unroll
    for (int t = 0; t < 64; ++t) {
        const float u = bf2f(raw[t + 3]);
        const float y = bias + w0 * u3 + w1 * u2 + w2 * u1 + w3 * u;
        const bf16_t o = bf1(y * __builtin_amdgcn_rcpf(1.f + __expf(-y)));
        xbc[(size_t)(m0 + t) * 1024 + c] = o;
        scr[t * STG_PITCH + lane] = o;
        u3 = u2; u2 = u1; u1 = u;
    }
    WSYNC();
    if (ct < 12) {
        bf16_t* dst = (ct < 8) ? xst + ((size_t)(b * 8 + ct) * 64) * SEQ + t0 : bt + ((size_t)(b * 2 + ((ct - 8) >> 1)) * 128 + ((ct - 8) & 1) * 64) * SEQ + t0;
#pragma unroll
        for (int i = 0; i < 8; ++i) { const int d = i * 8 + (lane >> 3), tc = lane & 7; const LAS bf16_t* p = scr + (tc * 8) * STG_PITCH + d;
            v4u o; o.x = (unsigned)p[0] | ((unsigned)p[STG_PITCH] << 16); o.y = (unsigned)p[2 * STG_PITCH] | ((unsigned)p[3 * STG_PITCH] << 16);
            o.z = (unsigned)p[4 * STG_PITCH] | ((unsigned)p[5 * STG_PITCH] << 16); o.w = (unsigned)p[6 * STG_PITCH] | ((unsigned)p[7 * STG_PITCH] << 16);
            *(v4u*)(dst + (size_t)d * SEQ + tc * 8) = o; }
    }
    WSYNC();
}
__device__ __forceinline__ float bperm(int srclane, float x) { return __builtin_bit_cast(float, __builtin_amdgcn_ds_bpermute(srclane << 2, __builtin_bit_cast(int, x))); }
__device__ __forceinline__ void scan128(float& x0, float& x1, int lane) {
#pragma unroll
    for (int o = 1; o < 64; o <<= 1) { const int sl = (lane >= o) ? lane - o : lane; const float t0 = bperm(sl, x0), t1 = bperm(sl, x1); if (lane >= o) { x0 += t0; x1 += t1; } }
    x1 += rl(x0, 63);
}

__device__ __forceinline__ void ssd_s3_block(int bc, int tid, int lane, int wave, LAS unsigned char* lds, const bf16_t* __restrict__ xbc, const bf16_t* __restrict__ xst, const bf16_t* __restrict__ stb,
                                             const float* __restrict__ dt, const float* __restrict__ a_log, const float* __restrict__ dsk, bf16_t* __restrict__ yssm) {
    const int b = bc >> 4, c = bc & 15, h = wave, g = h >> 2, l0 = c * 128, l31 = lane & 31, hi = lane >> 5, unit = bc * 8 + h;
    const size_t m0 = (size_t)b * SEQ + l0;
    __syncthreads();
    {
        const int mat = lane >> 4, ch = lane & 15;
        v4u rr[16];
#pragma unroll
        for (int i = 0; i < 16; ++i) rr[i] = *(const v4u*)(xbc + (m0 + wave * 16 + i) * 1024 + 512 + lane * 8);
#pragma unroll
        for (int i = 0; i < 16; ++i) { const int row = wave * 16 + i; *(LAS v4u*)(lds + mat * 34816 + row * 272 + ch * 16) = rr[i]; }
    }
#define S3TAB(i) (*(LAS float*)(lds + ((wave * 64) + ((i) >> 2)) * 272 + 256 + ((i) & 3) * 4))
    const float A = -expf(a_log[h]), D = dsk[h];
    { const float d0 = dt[(m0 + lane) * 8 + h], d1 = dt[(m0 + 64 + lane) * 8 + h];
      float ac0 = d0 * A, ac1 = d1 * A;
      scan128(ac0, ac1, lane);
      S3TAB(lane) = ac0; S3TAB(64 + lane) = ac1; S3TAB(128 + lane) = d0; S3TAB(192 + lane) = d1; }
    u32x2 xf[4][2][2][2];
    const bf16_t* Sp = stb + (size_t)unit * 8192 + l31 * 128 + 8 * hi;
    { const bf16_t* Xp = xst + ((size_t)(b * 8 + h) * 64 + l31) * SEQ + l0 + 4 * hi;
#pragma unroll
      for (int st = 0; st < 4; ++st)
#pragma unroll
          for (int pt = 0; pt < 2; ++pt)
#pragma unroll
              for (int ks = 0; ks < 2; ++ks) { const bf16_t* xp = Xp + (size_t)pt * 32 * SEQ + st * 32 + 16 * ks; xf[st][pt][ks][0] = *(const u32x2*)xp; xf[st][pt][ks][1] = *(const u32x2*)(xp + 8); } }
    __syncthreads();
    const LAS unsigned char* Bl = lds + g * 34816 + 16 * hi;
    const LAS unsigned char* Cl = lds + (2 + g) * 34816 + 16 * hi;
#pragma unroll 1
    for (int lt = 0; lt < 4; ++lt) {
        asm volatile("" ::: "memory");
        f32x16 y[2];
#pragma unroll
        for (int r = 0; r < 16; ++r) { y[0][r] = 0.f; y[1][r] = 0.f; }
        const float acl = S3TAB(32 * lt + l31);
        const int crw = 32 * lt + l31;
        { bf16x8 sfr[2][8];
#pragma unroll
          for (int pt = 0; pt < 2; ++pt)
#pragma unroll
              for (int kk = 0; kk < 8; ++kk) sfr[pt][kk] = *(const bf16x8*)(Sp + pt * 32 * 128 + 16 * kk);
#pragma unroll
          for (int kk = 0; kk < 8; ++kk) { const bf16x8 cf = *(const LAS bf16x8*)(Cl + crw * 272 + 32 * kk); y[0] = MFMA32(sfr[0][kk], cf, y[0]); y[1] = MFMA32(sfr[1][kk], cf, y[1]); } }
        { const float el = __expf(acl);
#pragma unroll
          for (int r = 0; r < 16; ++r) { y[0][r] *= el; y[1][r] *= el; } }
        u32x2 xd[2][4];
#pragma unroll
        for (int pt = 0; pt < 2; ++pt)
#pragma unroll
            for (int q = 0; q < 4; ++q) xd[pt][q] = *(const u32x2*)(xbc + (m0 + crw) * 1024 + h * 64 + 32 * pt + 8 * q + 4 * hi);
#pragma unroll
        for (int st = 0; st < 4; ++st) if (st <= lt) {
            const int brw = 32 * st + l31;
            f32x16 cbt;
#pragma unroll
            for (int r = 0; r < 16; ++r) cbt[r] = 0.f;
#pragma unroll
            for (int kk = 0; kk < 8; ++kk) { const bf16x8 bf_ = *(const LAS bf16x8*)(Bl + brw * 272 + 32 * kk), cf_ = *(const LAS bf16x8*)(Cl + crw * 272 + 32 * kk); cbt = MFMA32(bf_, cf_, cbt); }
#pragma unroll
            for (int r = 0; r < 16; ++r) { const int sl = 32 * st + crow(r, hi); const float acs = S3TAB(sl), dts = S3TAB(128 + sl);
                float v = cbt[r] * __expf(acl - acs) * dts; if (st == lt && crow(r, hi) > l31) v = 0.f; cbt[r] = v; }
            bf16x8 pf[2];
#pragma unroll
            for (int ks = 0; ks < 2; ++ks) pf[ks] = pack8(cbt[8 * ks], cbt[8 * ks + 1], cbt[8 * ks + 2], cbt[8 * ks + 3], cbt[8 * ks + 4], cbt[8 * ks + 5], cbt[8 * ks + 6], cbt[8 * ks + 7]);
#pragma unroll
            for (int pt = 0; pt < 2; ++pt)
#pragma unroll
                for (int ks = 0; ks < 2; ++ks) { v4u a; a.x = xf[st][pt][ks][0].x; a.y = xf[st][pt][ks][0].y; a.z = xf[st][pt][ks][1].x; a.w = xf[st][pt][ks][1].y; y[pt] = MFMA32(__builtin_bit_cast(bf16x8, a), pf[ks], y[pt]); }
        }
#pragma unroll
        for (int pt = 0; pt < 2; ++pt)
#pragma unroll
            for (int q = 0; q < 4; ++q) { const u32x2 xx = xd[pt][q];
                const unsigned o0 = cvtpk(y[pt][4 * q] + D * bflo(xx.x), y[pt][4 * q + 1] + D * bfhi(xx.x)), o1 = cvtpk(y[pt][4 * q + 2] + D * bflo(xx.y), y[pt][4 * q + 3] + D * bfhi(xx.y));
                *(u32x2*)(yssm + (m0 + crw) * 512 + h * 64 + 32 * pt + 8 * q + 4 * hi) = (u32x2){o0, o1}; }
    }
#undef S3TAB
}
__device__ __forceinline__ void ssd_s1_unit(int unit, int lane, LAS float* tab, const bf16_t* __restrict__ xst, const bf16_t* __restrict__ bt, const float* __restrict__ dt, const float* __restrict__ a_log,
                                            float* __restrict__ sloc, float* __restrict__ asum) {
    const int h = unit & 7, c = (unit >> 3) & 15, b = unit >> 7, g = h >> 2, l0 = c * 128, l31 = lane & 31, hi = lane >> 5;
    const size_t m0 = (size_t)b * SEQ + l0;
    const float A = -expf(a_log[h]);
    const float d0 = dt[(m0 + lane) * 8 + h], d1 = dt[(m0 + 64 + lane) * 8 + h];
    float ac0 = d0 * A, ac1 = d1 * A;
    scan128(ac0, ac1, lane);
    const float aend = rl(ac1, 63);
    tab[lane] = __expf(aend - ac0) * d0; tab[64 + lane] = __expf(aend - ac1) * d1;
    if (lane == 0) asum[unit] = aend;
    WSYNC();
    f32x16 acc[2][4];
#pragma unroll
    for (int pt = 0; pt < 2; ++pt)
#pragma unroll
        for (int nt = 0; nt < 4; ++nt)
#pragma unroll
            for (int r = 0; r < 16; ++r) acc[pt][nt][r] = 0.f;
    const bf16_t* Xp = xst + ((size_t)(b * 8 + h) * 64 + l31) * SEQ + l0 + 8 * hi;
    const bf16_t* Bp = bt + ((size_t)(b * 2 + g) * 128 + l31) * SEQ + l0 + 8 * hi;
#pragma unroll 2
    for (int kk = 0; kk < 8; ++kk) {
        const f32x4 wa = *(const LAS f32x4*)(tab + 16 * kk + 8 * hi), wb = *(const LAS f32x4*)(tab + 16 * kk + 8 * hi + 4);
        bf16x8 af[2], bfr[4];
#pragma unroll
        for (int pt = 0; pt < 2; ++pt) { const v4u raw = *(const v4u*)(Xp + (size_t)pt * 32 * SEQ + 16 * kk);
            v4u w; w.x = cvtpk(bflo(raw.x) * wa[0], bfhi(raw.x) * wa[1]); w.y = cvtpk(bflo(raw.y) * wa[2], bfhi(raw.y) * wa[3]);
            w.z = cvtpk(bflo(raw.z) * wb[0], bfhi(raw.z) * wb[1]); w.w = cvtpk(bflo(raw.w) * wb[2], bfhi(raw.w) * wb[3]); af[pt] = __builtin_bit_cast(bf16x8, w); }
#pragma unroll
        for (int nt = 0; nt < 4; ++nt) bfr[nt] = *(const bf16x8*)(Bp + (size_t)nt * 32 * SEQ + 16 * kk);
#pragma unroll
        for (int pt = 0; pt < 2; ++pt)
#pragma unroll
            for (int nt = 0; nt < 4; ++nt) acc[pt][nt] = MFMA32(af[pt], bfr[nt], acc[pt][nt]);
    }
    float* dst = sloc + (size_t)unit * 8192 + l31;
#pragma unroll
    for (int pt = 0; pt < 2; ++pt)
#pragma unroll
        for (int nt = 0; nt < 4; ++nt)
#pragma unroll
            for (int r = 0; r < 16; ++r) dst[(32 * pt + crow(r, hi)) * 128 + 32 * nt] = acc[pt][nt][r];
    WSYNC();
}
__device__ __forceinline__ void ssd_s2_all(const float* __restrict__ sloc, const float* __restrict__ asum, bf16_t* __restrict__ stb, int gtid, int NT) {
    for (int i = gtid; i < 128 * 2048; i += NT) {
        const int bh = i >> 11, e4 = i & 2047, b = bh >> 3, h = bh & 7;
        f32x4 run = {0.f, 0.f, 0.f, 0.f};
#pragma unroll 4
        for (int c = 0; c < 16; ++c) { const int unit = (b * 16 + c) * 8 + h; const f32x4 tmp = *(const f32x4*)(sloc + (size_t)unit * 8192 + e4 * 4);
            uint2 w; w.x = cvtpk(run[0], run[1]); w.y = cvtpk(run[2], run[3]); *(uint2*)(stb + (size_t)unit * 8192 + e4 * 4) = w;
            run = run * __expf(asum[unit]) + tmp; }
    }
}
__device__ __forceinline__ void ssd_s3_unit(int unit, int lane, LAS float* tab, const bf16_t* __restrict__ xbc, const bf16_t* __restrict__ xst, const bf16_t* __restrict__ stb, const float* __restrict__ dt,
                                            const float* __restrict__ a_log, const float* __restrict__ dsk, bf16_t* __restrict__ yssm) {
    const int h = unit & 7, c = (unit >> 3) & 15, b = unit >> 7, g = h >> 2, l0 = c * 128, l31 = lane & 31, hi = lane >> 5;
    const size_t m0 = (size_t)b * SEQ + l0;
    const float A = -expf(a_log[h]), D = dsk[h];
    const float d0 = dt[(m0 + lane) * 8 + h], d1 = dt[(m0 + 64 + lane) * 8 + h];
    float ac0 = d0 * A, ac1 = d1 * A;
    scan128(ac0, ac1, lane);
    tab[lane] = ac0; tab[64 + lane] = ac1; tab[128 + lane] = d0; tab[192 + lane] = d1;
    WSYNC();
    const bf16_t* Cp = xbc + (m0 + l31) * 1024 + 768 + g * 128 + 8 * hi;
    const bf16_t* Sp = stb + (size_t)unit * 8192 + l31 * 128 + 8 * hi;
    const bf16_t* Bp = xbc + (m0 + l31) * 1024 + 512 + g * 128 + 8 * hi;
    const bf16_t* Xp = xst + ((size_t)(b * 8 + h) * 64 + l31) * SEQ + l0 + 4 * hi;
    LAS float* tr = tab + 256;
    const int row = lane >> 1, p0 = (lane & 1) * 16;
#pragma unroll 1
    for (int lt = 0; lt < 4; ++lt) {
        f32x16 y[2];
#pragma unroll
        for (int r = 0; r < 16; ++r) { y[0][r] = 0.f; y[1][r] = 0.f; }
        const float acl = tab[32 * lt + l31];
        bf16x8 cfr[8];
#pragma unroll
        for (int kk = 0; kk < 8; ++kk) cfr[kk] = *(const bf16x8*)(Cp + (size_t)lt * 32 * 1024 + 16 * kk);
        {   bf16x8 s0[8], s1[8];
#pragma unroll
            for (int kk = 0; kk < 8; ++kk) { s0[kk] = *(const bf16x8*)(Sp + 16 * kk); s1[kk] = *(const bf16x8*)(Sp + 32 * 128 + 16 * kk); }
#pragma unroll
            for (int kk = 0; kk < 8; ++kk) { y[0] = MFMA32(s0[kk], cfr[kk], y[0]); y[1] = MFMA32(s1[kk], cfr[kk], y[1]); }
        }
        { const float el = __expf(acl);
#pragma unroll
          for (int r = 0; r < 16; ++r) { y[0][r] *= el; y[1][r] *= el; } }
#pragma unroll 1
        for (int st = 0; st <= lt; ++st) {
            bf16x8 bfr[8]; u32x2 xf[2][2][2];
#pragma unroll
            for (int kk = 0; kk < 8; ++kk) bfr[kk] = *(const bf16x8*)(Bp + (size_t)st * 32 * 1024 + 16 * kk);
#pragma unroll
            for (int pt = 0; pt < 2; ++pt)
#pragma unroll
                for (int ks = 0; ks < 2; ++ks) { const bf16_t* xp = Xp + (size_t)pt * 32 * SEQ + st * 32 + 16 * ks; xf[pt][ks][0] = *(const u32x2*)xp; xf[pt][ks][1] = *(const u32x2*)(xp + 8); }
            f32x16 cbt;
#pragma unroll
            for (int r = 0; r < 16; ++r) cbt[r] = 0.f;
#pragma unroll
            for (int kk = 0; kk < 8; ++kk) cbt = MFMA32(bfr[kk], cfr[kk], cbt);
#pragma unroll
            for (int r = 0; r < 16; ++r) { const int sl = 32 * st + crow(r, hi); const float acs = tab[sl], dts = tab[128 + sl];
                float v = cbt[r] * __expf(acl - acs) * dts; if (st == lt && crow(r, hi) > l31) v = 0.f; cbt[r] = v; }
            bf16x8 pf[2];
#pragma unroll
            for (int ks = 0; ks < 2; ++ks) pf[ks] = pack8(cbt[8 * ks], cbt[8 * ks + 1], cbt[8 * ks + 2], cbt[8 * ks + 3], cbt[8 * ks + 4], cbt[8 * ks + 5], cbt[8 * ks + 6], cbt[8 * ks + 7]);
#pragma unroll
            for (int pt = 0; pt < 2; ++pt)
#pragma unroll
                for (int ks = 0; ks < 2; ++ks) { v4u a; a.x = xf[pt][ks][0].x; a.y = xf[pt][ks][0].y; a.z = xf[pt][ks][1].x; a.w = xf[pt][ks][1].y; y[pt] = MFMA32(__builtin_bit_cast(bf16x8, a), pf[ks], y[pt]); }
        }
#pragma unroll
        for (int pt = 0; pt < 2; ++pt) {
#pragma unroll
            for (int r = 0; r < 16; ++r) tr[l31 * 33 + crow(r, hi)] = y[pt][r];
            WSYNC();
            const size_t m = m0 + 32 * lt + row;
            const v4u xa = *(const v4u*)(xbc + m * 1024 + h * 64 + 32 * pt + p0), xb = *(const v4u*)(xbc + m * 1024 + h * 64 + 32 * pt + p0 + 8);
            const unsigned xu[8] = {xa.x, xa.y, xa.z, xa.w, xb.x, xb.y, xb.z, xb.w};
            unsigned ow[8];
#pragma unroll
            for (int q = 0; q < 8; ++q) { const float v0 = tr[row * 33 + p0 + 2 * q] + D * bflo(xu[q]), v1 = tr[row * 33 + p0 + 2 * q + 1] + D * bfhi(xu[q]); ow[q] = cvtpk(v0, v1); }
            bf16_t* dst = yssm + m * 512 + h * 64 + 32 * pt + p0;
            *(v4u*)dst = (v4u){ow[0], ow[1], ow[2], ow[3]}; *(v4u*)(dst + 8) = (v4u){ow[4], ow[5], ow[6], ow[7]};
            WSYNC();
        }
    }
}


__device__ __forceinline__ float sum8(float x) { x += dpp_mov<0xB1>(x); x += dpp_mov<0x4E>(x); x += dpp_mov<0x141>(x); return x; }
__device__ __forceinline__ float sum32(float x, int lane) { x = rowsum16(x); return x + bperm(lane ^ 16, x); }
__device__ __forceinline__ void unpack8(const v4u& w, float (&f)[8]) { f[0] = bflo(w.x); f[1] = bfhi(w.x); f[2] = bflo(w.y); f[3] = bfhi(w.y); f[4] = bflo(w.z); f[5] = bfhi(w.z); f[6] = bflo(w.w); f[7] = bfhi(w.w); }
__device__ __forceinline__ void ssm_gate_norm_vec(const bf16_t* __restrict__ yssm, const bf16_t* __restrict__ proj, const float* __restrict__ ng, bf16_t* __restrict__ ymix, int m0, int m1, int w, int nw, int lane) {
    const int c0 = lane * 8;
    float gn[8];
    { const f32x4 a = *(const f32x4*)(ng + c0), b = *(const f32x4*)(ng + c0 + 4); gn[0] = a[0]; gn[1] = a[1]; gn[2] = a[2]; gn[3] = a[3]; gn[4] = b[0]; gn[5] = b[1]; gn[6] = b[2]; gn[7] = b[3]; }
    for (int mb = m0 + w; mb < m1; mb += nw * 4) {
        v4u yv[4], zv[4];
#pragma unroll
        for (int k = 0; k < 4; ++k) { const int m = (mb + k * nw < m1) ? mb + k * nw : mb; yv[k] = *(const v4u*)(yssm + (size_t)m * 512 + c0); zv[k] = *(const v4u*)(proj + (size_t)m * L0P + 1792 + c0); }
#pragma unroll
        for (int k = 0; k < 4; ++k) { const int m = mb + k * nw;
            float y[8], z[8], u[8], q = 0.f; unpack8(yv[k], y); unpack8(zv[k], z);
#pragma unroll
            for (int j = 0; j < 8; ++j) { u[j] = y[j] * z[j] * __builtin_amdgcn_rcpf(1.f + __builtin_amdgcn_exp2f(-1.4426950408889634f * z[j])); q += u[j] * u[j]; }
            const float rs = __builtin_amdgcn_rsqf(sum32(q, lane) * (1.f / 256.f) + 1e-5f);
            v4u o; o.x = cvtpk(u[0] * rs * gn[0], u[1] * rs * gn[1]); o.y = cvtpk(u[2] * rs * gn[2], u[3] * rs * gn[3]); o.z = cvtpk(u[4] * rs * gn[4], u[5] * rs * gn[5]); o.w = cvtpk(u[6] * rs * gn[6], u[7] * rs * gn[7]);
            if (m < m1) *(v4u*)(ymix + (size_t)m * DM + 512 + c0) = o; }
    }
}
__device__ __forceinline__ void rwkv_post_vec(const float* __restrict__ yraw, const bf16_t* __restrict__ proj, const float* __restrict__ mix, const float* __restrict__ bonus, const bf16_t* __restrict__ gbuf,
                                              const float* __restrict__ ln_g, const float* __restrict__ ln_b, bf16_t* __restrict__ ymix, int gw, int NGW, int lane) {
    const int c0 = lane * 8, h = lane >> 3;
    float lg[8], lb[8], mx[8];
    { const f32x4 a = *(const f32x4*)(ln_g + c0), b = *(const f32x4*)(ln_g + c0 + 4), c = *(const f32x4*)(ln_b + c0), d = *(const f32x4*)(ln_b + c0 + 4), e = *(const f32x4*)(mix + 1024 + c0), f = *(const f32x4*)(mix + 1024 + c0 + 4);
#pragma unroll
      for (int j = 0; j < 4; ++j) { lg[j] = a[j]; lg[4 + j] = b[j]; lb[j] = c[j]; lb[4 + j] = d[j]; mx[j] = e[j]; mx[4 + j] = f[j]; } }
    for (int mb = gw; mb < M; mb += NGW * 2) {
        f32x4 ya[2], yb[2]; v4u cv[2], pv[2], gv[2]; float bo[2];
#pragma unroll
        for (int k = 0; k < 2; ++k) { const int m = mb + k * NGW; const bool hp = (m & (SEQ - 1)) != 0;
            ya[k] = *(const f32x4*)(yraw + (size_t)m * 512 + c0); yb[k] = *(const f32x4*)(yraw + (size_t)m * 512 + c0 + 4);
            cv[k] = *(const v4u*)(proj + (size_t)m * L0P + 1024 + c0); pv[k] = *(const v4u*)(proj + (size_t)(hp ? m - 1 : m) * L0P + 1024 + c0);
            gv[k] = *(const v4u*)(gbuf + (size_t)m * 512 + c0); bo[k] = bonus[(size_t)m * 8 + h]; }
#pragma unroll
        for (int k = 0; k < 2; ++k) { const int m = mb + k * NGW; const float pz = ((m & (SEQ - 1)) != 0) ? 1.f : 0.f;
            float y[8] = {ya[k][0], ya[k][1], ya[k][2], ya[k][3], yb[k][0], yb[k][1], yb[k][2], yb[k][3]}, cc[8], pp[8], gg[8];
            unpack8(cv[k], cc); unpack8(pv[k], pp); unpack8(gv[k], gg);
            float sm = 0.f;
#pragma unroll
            for (int j = 0; j < 8; ++j) sm += y[j];
            const float mu = sum8(sm) * (1.f / 64.f);
            float qv = 0.f;
#pragma unroll
            for (int j = 0; j < 8; ++j) { y[j] -= mu; qv += y[j] * y[j]; }
            const float rs = __builtin_amdgcn_rsqf(sum8(qv) * (1.f / 64.f) + 64e-5f);
            float o[8];
#pragma unroll
            for (int j = 0; j < 8; ++j) { const float vs = cc[j] + (pp[j] * pz - cc[j]) * mx[j]; o[j] = (y[j] * rs * lg[j] + lb[j] + bo[k] * vs) * gg[j]; }
            v4u w; w.x = cvtpk(o[0], o[1]); w.y = cvtpk(o[2], o[3]); w.z = cvtpk(o[4], o[5]); w.w = cvtpk(o[6], o[7]);
            *(v4u*)(ymix + (size_t)m * DM + c0) = w; }
    }
}

struct Args { const float* in[43]; float* out; unsigned char* ws; };
#define GEMM_PHASE(EPI, Aptr, LDA, Bptr, LDB, NN, KK, ...) do { pg8::Gemm g_{(Aptr), (Bptr), M, (NN), (KK), (LDA), (LDB)}; pg8::StaticOrder S_; S_.init(M, (NN), G, (int)blockIdx.x); \
        pg8::EPI E_{__VA_ARGS__}; pg8::gemm_phase<pg8::EPI, pg8::StaticOrder, true, true>(lds3, g_, S_, E_); } while (0)

__global__ void __launch_bounds__(NWAVES * 64, 2) fwd_mega(Args args) {
    extern __shared__ __attribute__((aligned(16))) unsigned char lds[];
    LAS unsigned char* lds3 = (LAS unsigned char*)lds;
    volatile LAS unsigned* MISC = (volatile LAS unsigned*)(lds3 + MISC_OFF);
    const int G = gridDim.x, NGW = G * NWAVES, NT = G * NWAVES * 64;
#define PHASE_IDS() int tid = threadIdx.x; asm volatile("" : "+v"(tid)); const int lane = tid & 63, wave = __builtin_amdgcn_readfirstlane(tid >> 6); const int gw = blockIdx.x * NWAVES + wave, gtid = blockIdx.x * (NWAVES * 64) + tid; (void)lane; (void)gw; (void)gtid
    unsigned char* ws = args.ws;
    gu32* ctl = (gu32*)(ws + WS_CTL);
    for (int u = threadIdx.x; u < (LDS_BYTES - LDSCTL_OFF) / 4; u += NWAVES * 64) ((LAS unsigned*)(lds3 + LDSCTL_OFF))[u] = 0u;
    __syncthreads();
    XcdBarrier bar = xcd_barrier_post((unsigned*)(ctl + CW_BAR), MISC + 8);
#if defined(PROBE_STAMPS)
    int nb_ = 0;
    if (blockIdx.x == 0 && threadIdx.x == 0) MISC[16] = (unsigned)__builtin_amdgcn_s_memrealtime();
#define GRID_BAR() do { xcd_barrier(bar); ++nb_; if (blockIdx.x == 0 && threadIdx.x == 0) MISC[16 + nb_] = (unsigned)__builtin_amdgcn_s_memrealtime(); } while (0)
#else
#define GRID_BAR() xcd_barrier(bar)
#endif
#define IN(i) (args.in[i])
    float* out = args.out;
    bf16_t* W0in = (bf16_t*)(ws + WS_W0IN); bf16_t* W0out = (bf16_t*)(ws + WS_W0OUT); bf16_t* Wup0 = (bf16_t*)(ws + WS_WUP0); bf16_t* Wdn0 = (bf16_t*)(ws + WS_WDN0);
    bf16_t* W1in = (bf16_t*)(ws + WS_W1IN); bf16_t* Wuq = (bf16_t*)(ws + WS_WUQ); bf16_t* Wukv = (bf16_t*)(ws + WS_WUKV); bf16_t* W1out = (bf16_t*)(ws + WS_W1OUT);
    bf16_t* Wup1 = (bf16_t*)(ws + WS_WUP1); bf16_t* Wdn1 = (bf16_t*)(ws + WS_WDN1);
    bf16_t* XB = (bf16_t*)(ws + WS_XB); bf16_t* YMIX = (bf16_t*)(ws + WS_YMIX); bf16_t* PROJ0 = (bf16_t*)(ws + WS_BIG);
    float* YRAW = out; bf16_t* YSSM = (bf16_t*)(out + (size_t)M * 512); bf16_t* STB = (bf16_t*)(out + (size_t)M * 768); bf16_t* XST = (bf16_t*)(ws + WS_XST); bf16_t* BT = (bf16_t*)(ws + WS_BT); float* ASUM = (float*)(ws + WS_ASUM); float* SLOC = (float*)(ws + WS_SLOC); float* DT = (float*)(ws + WS_DT); bf16_t* GB = (bf16_t*)(ws + WS_G); float* BONUS = (float*)(ws + WS_BONUS);
    bf16_t* W2T = (bf16_t*)(ws + WS_W2T); bf16_t* A2T = (bf16_t*)(ws + WS_A2T); bf16_t* G2T = (bf16_t*)(ws + WS_G2T); bf16_t* ACT = (bf16_t*)(ws + WS_GU); bf16_t* HALO = (bf16_t*)(ws + WS_GU + 176 * MiB);
    bf16_t* PROJ1 = (bf16_t*)(ws + WS_PROJ1); bf16_t* QM = (bf16_t*)(ws + WS_QM); bf16_t* KVM = (bf16_t*)(ws + WS_KVM); bf16_t* KPE = (bf16_t*)(ws + WS_KPE); float* RS = (float*)(ws + WS_RS); float* CSTAB = (float*)(ws + WS_CSTAB); float* STATS = (float*)(ws + WS_CSTAB + 4 * MiB); bf16_t* VTS = (bf16_t*)(ws + WS_VTS); bf16_t* VTM = (bf16_t*)(ws + WS_VTM);
    const int* pos = (const int*)args.in[1];

    {
        PHASE_IDS();
    {
        LAS float* scr = (LAS float*)(lds3 + wave * 16384); int trb = 0;
        transpose_matrix(IN(2), 1024, 3336, W0in, L0P, 1024, scr, gw, NGW, lane, nullptr, trb);
        transpose_matrix(IN(20), 1024, 1024, W0out, 1024, 1024, scr, gw, NGW, lane, nullptr, trb);
        transpose_matrix(IN(5), 64, 512, W2T, 512, 64, scr, gw, NGW, lane, nullptr, trb);
        transpose_matrix(IN(7), 64, 512, A2T, 512, 64, scr, gw, NGW, lane, nullptr, trb);
        transpose_matrix(IN(8), 128, 512, G2T, 512, 128, scr, gw, NGW, lane, nullptr, trb);
        const float* x = IN(0);
        {
            constexpr size_t TOT4 = (size_t)M * DM / 4;
            for (size_t i = gtid; i < TOT4; i += (size_t)NT * 8) {
                f32x4 v[8];
#pragma unroll
                for (int u = 0; u < 8; ++u) v[u] = *(const f32x4*)(x + (i + (size_t)u * NT) * 4);
#pragma unroll
                for (int u = 0; u < 8; ++u) { uint2 w; w.x = cvtpk(v[u][0], v[u][1]); w.y = cvtpk(v[u][2], v[u][3]); *(uint2*)(XB + (i + (size_t)u * NT) * 4) = w; }
            }
        }
    }
    }
    GRID_BAR();
    {
        PHASE_IDS();
    GEMM_PHASE(EpiBf16S, XB, DM, W0in, 1024, L0P, 1024, PROJ0, nullptr, L0P, 0);
    }
    GRID_BAR();
    {
        PHASE_IDS();
        const int blk = (int)blockIdx.x, m0 = blk * 128;
        {   LAS bf16_t* scr = (LAS bf16_t*)(lds3 + wave * 16384);
#pragma unroll 1
            for (int k = 0; k < 4; ++k) ssd_conv_tile((2 * blk + (k & 1)) * 16 + wave + 8 * (k >> 1), lane, scr, PROJ0, IN(14), IN(15), XB, XST, BT);
            for (int i = tid; i < 1024; i += NWAVES * 64) { const int m = m0 + (i >> 3); DT[(size_t)m * 8 + (i & 7)] = softplusf_(bf2f(PROJ0[(size_t)m * L0P + 3328 + (i & 7)]) + IN(16)[i & 7]); }
        }
        __syncthreads();
#if defined(PROBE_STAMPS)
        if (blockIdx.x == 0 && threadIdx.x == 0) MISC[16 + 29] = (unsigned)__builtin_amdgcn_s_memrealtime();
#endif
        ssd_s1_unit(blk * 8 + wave, lane, (LAS float*)(lds3 + wave * 16384), XST, BT, DT, IN(17), SLOC, ASUM);
    }
    GRID_BAR();
    {
        PHASE_IDS();
        ssd_s2_all(SLOC, ASUM, STB, gtid, NT);
    }
    GRID_BAR();
    {
        PHASE_IDS();
        const int blk = (int)blockIdx.x;
        if (blk < 128) {
            rwkv_phase_chain((LAS float*)lds3, tid, lane, wave, blk, PROJ0, IN(3), IN(4), IN(6), IN(9), IN(10), IN(11), W2T, A2T, G2T, YRAW, GB, BONUS);
#if defined(PROBE_STAMPS)
            if (blk == 0 && threadIdx.x == 0) MISC[16 + 23] = (unsigned)__builtin_amdgcn_s_memrealtime();
#endif
        } else {
            const int bc0 = (blk - 128) * 2;
#if defined(PROBE_STAMPS)
            const unsigned tu0_ = (unsigned)__builtin_amdgcn_s_memrealtime();
#endif
            {
                const int gwu = (blk - 128) * NWAVES + wave;
#pragma unroll 1
                for (int tk = gwu; tk < 128 * 128; tk += 128 * NWAVES) gate_lora_task(tk >> 7, tk & 127, lane, PROJ0, IN(3), G2T, GB);
            }
#if defined(PROBE_STAMPS)
            __syncthreads(); if (blk == 128 && threadIdx.x == 0) __hip_atomic_store(ctl + 2049, (unsigned)__builtin_amdgcn_s_memrealtime() - tu0_, __ATOMIC_RELAXED, __HIP_MEMORY_SCOPE_AGENT);
#endif
#pragma unroll 1
            for (int u = 0; u < 2; ++u) ssd_s3_block(bc0 + u, tid, lane, wave, lds3, XB, XST, STB, DT, IN(17), IN(18), YSSM);
            __syncthreads();
#if defined(PROBE_STAMPS)
            __syncthreads(); if (blk == 128 && threadIdx.x == 0) __hip_atomic_store(ctl + 2050, (unsigned)__builtin_amdgcn_s_memrealtime() - tu0_, __ATOMIC_RELAXED, __HIP_MEMORY_SCOPE_AGENT);
#endif
            ssm_gate_norm_vec(YSSM, PROJ0, IN(19), YMIX, bc0 * 128, bc0 * 128 + 256, wave, NWAVES, lane);
#if defined(PROBE_STAMPS)
            __syncthreads(); if (blk == 128 && threadIdx.x == 0) __hip_atomic_store(ctl + 2051, (unsigned)__builtin_amdgcn_s_memrealtime() - tu0_, __ATOMIC_RELAXED, __HIP_MEMORY_SCOPE_AGENT);
#endif
            { const int gwu = (blk - 128) * NWAVES + wave, NGWU = 128 * NWAVES; LAS float* scr = (LAS float*)(lds3 + wave * 16384); int trb = 0;
              transpose_matrix(IN(23), 1024, 5632, Wup0, 5632, 1024, scr, gwu, NGWU, lane, nullptr, trb, true);
              transpose_matrix(IN(26), 2816, 1024, Wdn0, 1024, 2816, scr, gwu, NGWU, lane, nullptr, trb);
            }
#if defined(PROBE_STAMPS)
            __syncthreads(); if (blk == 128 && threadIdx.x == 0) __hip_atomic_store(ctl + 2048, (unsigned)__builtin_amdgcn_s_memrealtime() - tu0_, __ATOMIC_RELAXED, __HIP_MEMORY_SCOPE_AGENT);
#endif
        }
    }
    GRID_BAR();
    {
        PHASE_IDS();
        rwkv_post_vec(YRAW, PROJ0, IN(3), BONUS, GB, IN(12), IN(13), YMIX, gw, NGW, lane);
    }
    GRID_BAR();
    {
        PHASE_IDS();
    GEMM_PHASE(EpiResid, YMIX, DM, W0out, 1024, 1024, 1024, IN(0), out, ALPHA, 0);
    }
    GRID_BAR();
    {
        PHASE_IDS();
    ln_rows<1>(out, XB, STATS, IN(21), IN(22), gw, NGW, lane);
    }
    GRID_BAR();
    {
        PHASE_IDS();
        { pg8::Gemm g_{XB, Wup0, M / 32, DFF, 1024, DM, 1024, 4096, 8192, 256, 512, 1}; pg8::StaticOrder S_; S_.init(M / 32, DFF, G, (int)blockIdx.x);
          pg8::EpiBf16S E_{HALO, nullptr, DFF, 0}; pg8::gemm_phase<pg8::EpiBf16S, pg8::StaticOrder, true, true>(lds3, g_, S_, E_); }
        if ((int)blockIdx.x >= 44) {
            const int gwu = ((int)blockIdx.x - 44) * NWAVES + wave, NGWU = (G - 44) * NWAVES; LAS float* scr = (LAS float*)(lds3 + wave * 16384); int trb = 0;
            transpose_matrix(IN(29), 1024, 1952, W1in, L1P, 1024, scr, gwu, NGWU, lane, nullptr, trb);
            transpose_matrix(IN(31), 256, 768, Wuq, 768, 256, scr, gwu, NGWU, lane, IN(30), trb);
            transpose_matrix(IN(33), 128, 1024, Wukv, 1024, 256, scr, gwu, NGWU, lane, IN(32), trb);
            transpose_matrix(IN(34), 1024, 1024, W1out, 1024, 1024, scr, gwu, NGWU, lane, nullptr, trb);
            transpose_matrix(IN(37), 1024, 5632, Wup1, 5632, 1024, scr, gwu, NGWU, lane, nullptr, trb, true);
            transpose_matrix(IN(40), 2816, 1024, Wdn1, 1024, 2816, scr, gwu, NGWU, lane, nullptr, trb);
            for (int i = gwu * 64 + lane; i < 1024 * 16; i += NGWU * 64) { const int n = i >> 4, c = i & 15; *(v4u*)(Wukv + (size_t)n * 256 + 128 + c * 8) = (v4u){0u, 0u, 0u, 0u}; }
        }
    }
    GRID_BAR();
    {
        PHASE_IDS();
        { pg8::Gemm g_{XB, Wup0, M, 2 * DFF, 1024, DM, 1024}; pg8::StaticOrder S_; S_.init(M, 2 * DFF, G, (int)blockIdx.x);
          pg8::EpiConvAct E_{ACT, HALO, IN(24), IN(25), DFF, SEQ}; pg8::gemm_phase<pg8::EpiConvAct, pg8::StaticOrder, true, true>(lds3, g_, S_, E_); }
    }
    GRID_BAR();
    {
        PHASE_IDS();
    GEMM_PHASE(EpiResidLN, ACT, DFF, Wdn0, DFF, 1024, DFF, out, STATS, IN(21), IN(22), ALPHA, 0);
    }
    GRID_BAR();
    {
        PHASE_IDS();
    ln_rows<1>(out, XB, STATS, IN(27), IN(28), gw, NGW, lane);
    }
    GRID_BAR();
    {
        PHASE_IDS();
    GEMM_PHASE(EpiBf16S, XB, DM, W1in, 1024, L1P, 1024, PROJ1, nullptr, L1P, 0);
    }
    GRID_BAR();
    {
        PHASE_IDS();
    mla_prep_all(PROJ1, pos, RS, KPE, CSTAB, gw, NGW, lane);
    }
    GRID_BAR();
    {
        PHASE_IDS();
    GEMM_PHASE(EpiBf16S, PROJ1 + 1536, L1P, Wuq, 256, 768, 256, QM, RS, 768, 2);
    GEMM_PHASE(EpiBf16S, PROJ1 + 1792, L1P, Wukv, 256, 1024, 256, KVM, RS + 1, 1024, 2);
    }
    GRID_BAR();
    {
        PHASE_IDS();
    rope_q_all(QM, CSTAB, gtid, NT);
    {
        LAS bf16_t* scr = (LAS bf16_t*)(lds3 + wave * 16384);
        for (int it = gw; it < 8192; it += NGW) { const int which = it >> 12, r = it & 4095, bh = r >> 5, tt = r & 31, b = bh >> 3, h = bh & 7;
            if (which == 0) transpose_tile64(PROJ1 + ((size_t)b * SEQ + tt * 64) * L1P + 1024 + h * 64, L1P, VTS + (size_t)bh * 64 * SEQ + tt * 64, SEQ, scr, lane);
            else            transpose_tile64(KVM + ((size_t)b * SEQ + tt * 64) * 1024 + h * 128 + 64, 1024, VTM + (size_t)bh * 64 * SEQ + tt * 64, SEQ, scr, lane); }
    }
    }
    GRID_BAR();
    {
        PHASE_IDS();
    {
        { LAS unsigned char* wl = lds3 + wave * 16384;
          for (int g2 = gw; g2 < 2048; g2 += NGW) { const int bh = g2 >> 4, w = g2 & 15;
#pragma unroll 1
              for (int i = 0; i < 4; ++i) { const int qb = (i == 0) ? w : (i == 1) ? 31 - w : (i == 2) ? 32 + w : 63 - w; sb_wave(bh, qb, lane, PROJ1, VTS, YMIX, wl); } } }
        __syncthreads();
        for (int g2 = (int)blockIdx.x; g2 < 256; g2 += G) { const int bh = g2 >> 1, part = g2 & 1;
#pragma unroll 1
            for (int i = 0; i < 4; ++i) { const int sbk = part ? ((i == 0) ? 1 : (i == 1) ? 6 : (i == 2) ? 2 : 5) : ((i == 0) ? 0 : (i == 1) ? 7 : (i == 2) ? 3 : 4);
                mla_block(bh, sbk, tid, lane, wave, lds3, QM, KVM, KPE, VTM, YMIX); } }
    }
    }
    GRID_BAR();
    {
        PHASE_IDS();
    GEMM_PHASE(EpiResidLN, YMIX, DM, W1out, 1024, 1024, 1024, out, STATS, IN(27), IN(28), ALPHA, 0);
    }
    GRID_BAR();
    {
        PHASE_IDS();
    ln_rows<1>(out, XB, STATS, IN(35), IN(36), gw, NGW, lane);
    }
    GRID_BAR();
    {
        PHASE_IDS();
        { pg8::Gemm g_{XB, Wup1, M / 32, DFF, 1024, DM, 1024, 4096, 8192, 256, 512, 1}; pg8::StaticOrder S_; S_.init(M / 32, DFF, G, (int)blockIdx.x);
          pg8::EpiBf16S E_{HALO, nullptr, DFF, 0}; pg8::gemm_phase<pg8::EpiBf16S, pg8::StaticOrder, true, true>(lds3, g_, S_, E_); }
    }
    GRID_BAR();
    {
        PHASE_IDS();
        { pg8::Gemm g_{XB, Wup1, M, 2 * DFF, 1024, DM, 1024}; pg8::StaticOrder S_; S_.init(M, 2 * DFF, G, (int)blockIdx.x);
          pg8::EpiConvAct E_{ACT, HALO, IN(38), IN(39), DFF, SEQ}; pg8::gemm_phase<pg8::EpiConvAct, pg8::StaticOrder, true, true>(lds3, g_, S_, E_); }
    }
    GRID_BAR();
    {
        PHASE_IDS();
    GEMM_PHASE(EpiResidLN, ACT, DFF, Wdn1, DFF, 1024, DFF, out, STATS, IN(35), IN(36), ALPHA, 0);
    }
    GRID_BAR();
    {
        PHASE_IDS();
    ln_rows<2>(out, XB, STATS, IN(41), IN(42), gw, NGW, lane);
    #if defined(PROBE_STAMPS)
    __syncthreads();
    if (blockIdx.x == 0 && threadIdx.x == 0) {
        MISC[16 + 22] = (unsigned)__builtin_amdgcn_s_memrealtime();
#if defined(PROBE_GLOBAL)
#ifndef PROBE_GIDX
#define PROBE_GIDX 0
#endif
        const unsigned d1 = __hip_atomic_load(ctl + 2048 + PROBE_GIDX, __ATOMIC_RELAXED, __HIP_MEMORY_SCOPE_AGENT);
#elif defined(PROBE_ACC)
        const unsigned d1 = MISC[16 + PROBE_ACC];
#else
        const unsigned d1 = MISC[16 + PROBE_T1_HI] - MISC[16 + PROBE_T1_LO];
#endif
        const unsigned long long spin = 100ull * d1;
        const unsigned long long t0 = __builtin_amdgcn_s_memrealtime();
        while (__builtin_amdgcn_s_memrealtime() - t0 < spin) __builtin_amdgcn_s_sleep(8);
    }
#endif
}
}

extern "C" void kernel_launch(void* const* d_in, const int* in_sizes, int n_in, void* d_out, int out_size, void* d_ws, size_t ws_size, hipStream_t stream) {
    static int grid = 0;
    if (grid == 0) {
        if (n_in != 43 || ws_size < WS_NEED || out_size != M * DM) { fprintf(stderr, "kernel_launch: unexpected n_in %d / ws %zu / out %d\n", n_in, ws_size, out_size); grid = -1; return; }
        int dev = 0, cus = 0, per_cu = 0;
        if (hipGetDevice(&dev) != hipSuccess || hipDeviceGetAttribute(&cus, hipDeviceAttributeMultiprocessorCount, dev) != hipSuccess) { grid = -1; return; }
        if (hipFuncSetAttribute((const void*)fwd_mega, hipFuncAttributeMaxDynamicSharedMemorySize, LDS_BYTES) != hipSuccess) { fprintf(stderr, "kernel_launch: hipFuncSetAttribute failed\n"); grid = -1; return; }
        if (hipOccupancyMaxActiveBlocksPerMultiprocessor(&per_cu, (const void*)fwd_mega, NWAVES * 64, LDS_BYTES) != hipSuccess || per_cu < 1) fprintf(stderr, "kernel_launch: occupancy query reports %d\n", per_cu);
        (void)hipGetLastError();
        grid = cus;
    }
    if (grid < 0) return;
    (void)hipMemsetAsync((char*)d_ws + WS_CTL, 0, CTL_ZERO_BYTES, stream);
    Args a{};
    for (int i = 0; i < 43; ++i) a.in[i] = (const float*)d_in[i];
    a.out = (float*)d_out; a.ws = (unsigned char*)d_ws;
    hipLaunchKernelGGL(fwd_mega, dim3(grid), dim3(NWAVES * 64), LDS_BYTES, stream, a);
}
```

```cpp
#include <hip/hip_runtime.h>
#include <cstdio>
#include <cstdint>
#include <cmath>
namespace pg8 {
#define PG8_LAS __attribute__((address_space(3)))
typedef unsigned short bf16_t;
typedef short bf16x8 __attribute__((ext_vector_type(8)));
typedef float f32x4 __attribute__((ext_vector_type(4)));
typedef unsigned u32x4 __attribute__((ext_vector_type(4)));
constexpr int BM = 256, BK = 64, HALF = 128, HTB = HALF * BK * 2  , STAGE_BYTES = 8 * HTB, NXCD = 8, WGM = 8;

__host__ __device__ __forceinline__ int lds_byte(int r, int c) { const int st = (r >> 4) * 2 + (c >> 5), rr = r & 15, cc = c & 31, ob = rr * 64 + cc * 2; return st * 1024 + (ob ^ (((ob >> 9) & 1) << 5)); }
__host__ __device__ __forceinline__ void stage_rc(int b, int& R, int& C) { const int st = b / 1024, sb = b % 1024, swz = sb ^ (((sb >> 9) & 1) << 5); R = (st >> 1) * 16 + swz / 64; C = (st & 1) * 32 + (swz % 64) / 2; }
__host__ __device__ __forceinline__ int perm32(int rho) { const int n = rho >> 4, i = rho & 15; return 8 * (i >> 2) + 4 * n + (i & 3); }

struct Unit { int pm, pn; };
struct Gemm { const bf16_t* A; const bf16_t* Bt; int M, N, K, lda, ldb; int hrA = 128, trA = 256, hrB = 128, trB = 256, gatherA = 0; };

struct StaticOrder {
    int nM, nN, nwg, G, c;
    __host__ __device__ void init(int M, int N, int G_, int c_) { nM = M / BM; nN = N / BM; nwg = nM * nN; G = G_; c = c_; }
    __host__ __device__ bool next(int i, Unit& u) const {
        const long L = (long)i * G + c; if (L >= nwg) return false;
        int wgid = (int)L; { const int q = nwg / NXCD, r = nwg % NXCD, xcd = wgid % NXCD, off = wgid / NXCD; wgid = (xcd < r ? xcd * (q + 1) : r * (q + 1) + (xcd - r) * q) + off; }
        const int nig = WGM * nN, gid = wgid / nig, fm = gid * WGM, gsz = (nM - fm) < WGM ? (nM - fm) : WGM;
        u.pm = fm + ((wgid % nig) % gsz); u.pn = (wgid % nig) / gsz; return true;
    }
    __device__ __forceinline__ void a_ready(const Unit&) const {}
    __device__ __forceinline__ void done(const Unit&) const {}
};


__device__ __forceinline__ unsigned cvt_pk_bf16(float lo, float hi) { unsigned r; asm volatile("v_cvt_pk_bf16_f32 %0, %1, %2" : "=v"(r) : "v"(lo), "v"(hi)); return r; }
struct EpiBf16S {
    static constexpr bool PERM = true, AFTER_DRAIN = false;
    bf16_t* O; const float* rowscale; int ldc; int rs_stride;
    __device__ __forceinline__ void operator()(const f32x4 (&acc)[2][2][4][2], const Unit& u, int wr, int wc, int fr, int fq) const {
        const int row0 = u.pm * BM + wr * 64 + fr, col0 = u.pn * BM + wc * 32 + 8 * fq;
#pragma unroll
        for (int ai = 0; ai < 2; ++ai)
#pragma unroll
            for (int m = 0; m < 4; ++m) { const int row = row0 + ai * HALF + m * 16; const float sc = rowscale ? rowscale[(size_t)row * rs_stride] : 1.f;
                bf16_t* rowp = O + (size_t)row * ldc + col0;
#pragma unroll
                for (int bj = 0; bj < 2; ++bj) { const f32x4 v0 = acc[ai][bj][m][0] * sc, v1 = acc[ai][bj][m][1] * sc;
                    u32x4 w; w.x = cvt_pk_bf16(v0[0], v0[1]); w.y = cvt_pk_bf16(v0[2], v0[3]); w.z = cvt_pk_bf16(v1[0], v1[1]); w.w = cvt_pk_bf16(v1[2], v1[3]);
                    *(u32x4*)(rowp + bj * HALF) = w; } }
    }
};
struct EpiResid {
    static constexpr bool PERM = false, AFTER_DRAIN = false;
    const float* hin; float* hout; float alpha; int pad;
    __device__ __forceinline__ void operator()(const f32x4 (&acc)[2][2][4][2], const Unit& u, int wr, int wc, int fr, int fq) const {
        const int row0 = u.pm * BM + wr * 64 + fr, col0 = u.pn * BM + wc * 32 + 4 * fq;
#pragma unroll
        for (int ai = 0; ai < 2; ++ai)
#pragma unroll
            for (int m = 0; m < 4; ++m) { const size_t off = (size_t)(row0 + ai * HALF + m * 16) * 1024 + col0;
#pragma unroll
                for (int bj = 0; bj < 2; ++bj)
#pragma unroll
                    for (int n = 0; n < 2; ++n) { const size_t i = off + bj * HALF + n * 16; const f32x4 h = *(const f32x4*)(hin + i); *(f32x4*)(hout + i) = h * alpha + acc[ai][bj][m][n]; } }
    }
};

struct EpiResidLN {
    static constexpr bool PERM = false, AFTER_DRAIN = false;
    float* hio; const float* stats; const float* g; const float* b; float alpha; int pad;
    __device__ __forceinline__ void operator()(const f32x4 (&acc)[2][2][4][2], const Unit& u, int wr, int wc, int fr, int fq) const {
        const int row0 = u.pm * BM + wr * 64 + fr, col0 = u.pn * BM + wc * 32 + 4 * fq;
        f32x4 gg[2][2], bb[2][2];
#pragma unroll
        for (int bj = 0; bj < 2; ++bj)
#pragma unroll
            for (int n = 0; n < 2; ++n) { gg[bj][n] = *(const f32x4*)(g + col0 + bj * HALF + n * 16) * alpha; bb[bj][n] = *(const f32x4*)(b + col0 + bj * HALF + n * 16) * alpha; }
#pragma unroll
        for (int ai = 0; ai < 2; ++ai)
#pragma unroll
            for (int m = 0; m < 4; ++m) { const int row = row0 + ai * HALF + m * 16; const size_t off = (size_t)row * 1024 + col0;
                const float mu = stats[2 * row], rs = stats[2 * row + 1];
#pragma unroll
                for (int bj = 0; bj < 2; ++bj)
#pragma unroll
                    for (int n = 0; n < 2; ++n) { const size_t i = off + bj * HALF + n * 16; const f32x4 p = *(const f32x4*)(hio + i); *(f32x4*)(hio + i) = (p - mu) * rs * gg[bj][n] + bb[bj][n] + acc[ai][bj][m][n]; } }
    }
};

template <int CTRL> __device__ __forceinline__ float pg_dpp(float x) { return __builtin_bit_cast(float, __builtin_amdgcn_update_dpp(0, __builtin_bit_cast(int, x), CTRL, 0xF, 0xF, true)); }
struct EpiConvAct {
    static constexpr bool PERM = true, AFTER_DRAIN = false;
    bf16_t* act; const bf16_t* halo; const float* cw; const float* cb; int dff; int seq;
    __device__ __forceinline__ void operator()(const f32x4 (&acc)[2][2][4][2], const Unit& u, int wr, int wc, int fr, int fq) const {
        typedef unsigned u32x2e __attribute__((ext_vector_type(2)));
#pragma unroll
        for (int n = 0; n < 2; ++n) {
            const int ch0 = u.pn * 128 + wc * 32 + 8 * fq + 4 * n;
            const f32x4 w0 = *(const f32x4*)(cw + ch0), w1 = *(const f32x4*)(cw + dff + ch0), w2 = *(const f32x4*)(cw + 2 * dff + ch0), bb = *(const f32x4*)(cb + ch0);
#pragma unroll
            for (int ai = 0; ai < 2; ++ai) {
                const int rb64 = u.pm * BM + ai * HALF + wr * 64;
                f32x4 P = {0.f, 0.f, 0.f, 0.f};
                if ((rb64 & (seq - 1)) != 0 && fr >= 14) { const u32x2e hv = *(const u32x2e*)(halo + (size_t)(2 * (rb64 / 64 - 1) + (fr - 14)) * dff + ch0);
                    P[0] = __builtin_bit_cast(float, hv.x << 16); P[1] = __builtin_bit_cast(float, hv.x & 0xffff0000u); P[2] = __builtin_bit_cast(float, hv.y << 16); P[3] = __builtin_bit_cast(float, hv.y & 0xffff0000u); }
#pragma unroll
                for (int m = 0; m < 4; ++m) {
                    const f32x4 Gv = acc[ai][0][m][n], Uv = acc[ai][1][m][n];
                    float o[4];
#pragma unroll
                    for (int e = 0; e < 4; ++e) {
                        const float t1 = pg_dpp<0x111>(Gv[e]), t2 = pg_dpp<0x112>(Gv[e]), p1 = pg_dpp<0x10F>(P[e]), p2 = pg_dpp<0x10E>(P[e]);
                        const float g1 = (fr >= 1) ? t1 : p1, g2 = (fr >= 2) ? t2 : p2;
                        const float y = bb[e] + w0[e] * g2 + w1[e] * g1 + w2[e] * Gv[e];
                        o[e] = y * __builtin_amdgcn_rcpf(1.f + __builtin_amdgcn_exp2f(-1.4426950408889634f * y)) * Uv[e];
                    }
                    u32x2e w; w.x = cvt_pk_bf16(o[0], o[1]); w.y = cvt_pk_bf16(o[2], o[3]);
                    *(u32x2e*)(act + (size_t)(rb64 + m * 16 + fr) * dff + ch0) = w;
                    P = Gv;
                }
            }
        }
    }
};

template <class Epi, class Sched, bool ALIGN_EPI = false, bool SP2 = false>
__device__ __forceinline__ void gemm_phase(PG8_LAS unsigned char* lds, const Gemm g, const Sched& S, const Epi& E) {
    int tid = threadIdx.x; asm volatile("" : "+v"(tid));
    const int wid = __builtin_amdgcn_readfirstlane(tid >> 6), lane = tid & 63, wr = wid >> 2, wc = wid & 3, fr = lane & 15, fq = lane >> 4;
    const int K = g.K, nt = K / BK;
    unsigned voffA[2], voffB[2];
#pragma unroll
    for (int i = 0; i < 2; ++i) { int R, C; stage_rc(tid * 16 + i * 8192, R, C); const int Rb = Epi::PERM ? ((R & ~31) + perm32(R & 31)) : R;
        const int Ra = g.gatherA ? (64 * (R >> 1) + 62 + (R & 1)) : R;
        voffA[i] = (unsigned)(Ra * g.lda + C) * 2u; voffB[i] = (unsigned)(Rb * g.ldb + C) * 2u; }
    const size_t kstep = (size_t)(BK * 2);
    const size_t hstepA = (size_t)g.hrA * g.lda * 2, hstepB = (size_t)g.hrB * g.ldb * 2;
    const size_t tstepA = (size_t)g.trA * g.lda * 2, tstepB = (size_t)g.trB * g.ldb * 2;
    const unsigned ldsw = (unsigned)wid * 1024u;
    const int aoff = lds_byte(wr * 64 + fr, fq * 8), boff = lds_byte(wc * 32 + fr, fq * 8);
#define PG8_SA(b, h) (((b) * 2 + (h)) * HTB)
#define PG8_SB(b, h) ((4 + (b) * 2 + (h)) * HTB)
#define PG8_STAGE(bufoff, gbase, voff) do { _Pragma("unroll") for (int _i = 0; _i < 2; ++_i) \
        __builtin_amdgcn_global_load_lds((const unsigned*)((const char*)(gbase) + (voff)[_i]), (PG8_LAS unsigned*)(lds + (bufoff) + ldsw + _i * 8192), 16, 0, 0); } while (0)
#define PG8_LDA(dst, b, h) do { _Pragma("unroll") for (int m = 0; m < 4; ++m) _Pragma("unroll") for (int k = 0; k < 2; ++k) dst[m][k] = *(const PG8_LAS bf16x8*)(lds + PG8_SA(b, h) + aoff + m * 2048 + k * 1024); } while (0)
#define PG8_LDB(dst, b, h) do { _Pragma("unroll") for (int n = 0; n < 2; ++n) _Pragma("unroll") for (int k = 0; k < 2; ++k) dst[n][k] = *(const PG8_LAS bf16x8*)(lds + PG8_SB(b, h) + boff + n * 2048 + k * 1024); } while (0)
#define PG8_MMA(ai, bj, At, Bt) do { __builtin_amdgcn_s_setprio(1); _Pragma("unroll") for (int m = 0; m < 4; ++m) _Pragma("unroll") for (int n = 0; n < 2; ++n) _Pragma("unroll") for (int k = 0; k < 2; ++k) \
        acc[ai][bj][m][n] = __builtin_amdgcn_mfma_f32_16x16x32_bf16(Bt[n][k], At[m][k], acc[ai][bj][m][n], 0, 0, 0); __builtin_amdgcn_s_setprio(0); } while (0)
#define PG8_WAIT_V(n) asm volatile("s_waitcnt vmcnt(" #n ")" ::: "memory")
#define PG8_WAIT_L(n) asm volatile("s_waitcnt lgkmcnt(" #n ")" ::: "memory")
#define PG8_BAR __builtin_amdgcn_s_barrier()
#define PG8_SCHED __builtin_amdgcn_sched_barrier(0)
    Unit cur, nxt; int ui = 0;
    if (!S.next(0, cur)) return;
    f32x4 acc[2][2][4][2];
#pragma unroll
    for (int a = 0; a < 2; ++a)
#pragma unroll
        for (int b = 0; b < 2; ++b)
#pragma unroll
            for (int m = 0; m < 4; ++m)
#pragma unroll
                for (int n = 0; n < 2; ++n) acc[a][b][m][n] = (f32x4){0.f, 0.f, 0.f, 0.f};
    bf16x8 At[4][2], B0[2][2], B1[2][2];
    const char* cA = (const char*)g.A + (size_t)cur.pm * tstepA; const char* cB = (const char*)g.Bt + (size_t)cur.pn * tstepB;
    S.a_ready(cur);
    if constexpr (SP2) {
        PG8_STAGE(PG8_SB(0, 0), cB, voffB); PG8_STAGE(PG8_SB(0, 1), cB + hstepB, voffB); PG8_STAGE(PG8_SA(0, 0), cA, voffA); PG8_STAGE(PG8_SA(0, 1), cA + hstepA, voffA);
        if (wr == 1) PG8_BAR;
        PG8_WAIT_V(2); PG8_BAR;
        PG8_STAGE(PG8_SB(1, 0), cB + kstep, voffB); PG8_STAGE(PG8_SA(1, 0), cA + kstep, voffA); PG8_STAGE(PG8_SB(1, 1), cB + hstepB + kstep, voffB);
        PG8_WAIT_V(6); PG8_BAR;
    } else {
        PG8_STAGE(PG8_SB(0, 0), cB, voffB); PG8_STAGE(PG8_SA(0, 0), cA, voffA); PG8_STAGE(PG8_SB(0, 1), cB + hstepB, voffB); PG8_STAGE(PG8_SA(0, 1), cA + hstepA, voffA);
        if (wr == 1) PG8_BAR;
        PG8_WAIT_V(4); PG8_BAR;
        PG8_STAGE(PG8_SB(1, 0), cB + kstep, voffB); PG8_STAGE(PG8_SA(1, 0), cA + kstep, voffA); PG8_STAGE(PG8_SB(1, 1), cB + hstepB + kstep, voffB);
        PG8_WAIT_V(6); PG8_BAR;
    }
    for (;;) {
        const bool has_next = S.next(ui + 1, nxt);
        const char* nA = has_next ? (const char*)g.A + (size_t)nxt.pm * tstepA : cA; const char* nB = has_next ? (const char*)g.Bt + (size_t)nxt.pn * tstepB : cB;
        for (int t = 0; t < nt; t += 2) {
            const bool last = (t == nt - 2);
            const char* a1 = cA + (size_t)(t + 1) * kstep;
            const char* a2 = last ? nA : cA + (size_t)(t + 2) * kstep; const char* b2 = last ? nB : cB + (size_t)(t + 2) * kstep;
            const char* a3 = a2 + kstep; const char* b3 = b2 + kstep;
            if (last && has_next) S.a_ready(nxt);
            if constexpr (SP2) {
            PG8_LDB(B0, 0, 0); PG8_LDB(B1, 0, 1); PG8_SCHED; PG8_LDA(At, 0, 0); PG8_STAGE(PG8_SA(1, 1), a1 + hstepA, voffA);
            PG8_WAIT_V(8); PG8_WAIT_L(0); PG8_BAR; PG8_MMA(0, 0, At, B0); PG8_MMA(0, 1, At, B1); PG8_BAR; PG8_SCHED;
            PG8_LDA(At, 0, 1); PG8_STAGE(PG8_SB(0, 0), b2, voffB); PG8_STAGE(PG8_SB(0, 1), b2 + hstepB, voffB); PG8_STAGE(PG8_SA(0, 0), a2, voffA);
            PG8_WAIT_V(8); PG8_WAIT_L(0); PG8_BAR; PG8_MMA(1, 0, At, B0); PG8_MMA(1, 1, At, B1); PG8_BAR; PG8_SCHED;
            PG8_LDB(B0, 1, 0); PG8_LDB(B1, 1, 1); PG8_SCHED; PG8_LDA(At, 1, 0); PG8_STAGE(PG8_SA(0, 1), a2 + hstepA, voffA);
            PG8_WAIT_V(8); PG8_WAIT_L(0); PG8_BAR; PG8_MMA(0, 0, At, B0); PG8_MMA(0, 1, At, B1); PG8_BAR; PG8_SCHED;
            PG8_LDA(At, 1, 1); PG8_STAGE(PG8_SB(1, 0), b3, voffB); PG8_STAGE(PG8_SB(1, 1), b3 + hstepB, voffB); PG8_STAGE(PG8_SA(1, 0), a3, voffA);
            PG8_WAIT_V(8); PG8_WAIT_L(0); PG8_BAR; PG8_MMA(1, 0, At, B0); PG8_MMA(1, 1, At, B1); PG8_BAR; PG8_SCHED;
            } else {
            PG8_LDB(B0, 0, 0); PG8_SCHED; PG8_LDA(At, 0, 0); PG8_STAGE(PG8_SA(1, 1), a1 + hstepA, voffA);
            PG8_WAIT_L(8); PG8_BAR; PG8_WAIT_L(0); PG8_MMA(0, 0, At, B0); PG8_BAR; PG8_SCHED;
            PG8_LDB(B1, 0, 1); PG8_STAGE(PG8_SB(0, 0), b2, voffB);
            PG8_BAR; PG8_WAIT_L(0); PG8_MMA(0, 1, At, B1); PG8_BAR;
            PG8_LDA(At, 0, 1); PG8_STAGE(PG8_SA(0, 0), a2, voffA);
            PG8_BAR; PG8_WAIT_L(0); PG8_MMA(1, 0, At, B0); PG8_BAR; PG8_SCHED;
            PG8_STAGE(PG8_SB(0, 1), b2 + hstepB, voffB);
            PG8_WAIT_V(6); PG8_BAR; PG8_MMA(1, 1, At, B1); PG8_BAR;
            PG8_LDB(B0, 1, 0); PG8_SCHED; PG8_LDA(At, 1, 0); PG8_STAGE(PG8_SA(0, 1), a2 + hstepA, voffA);
            PG8_WAIT_L(8); PG8_BAR; PG8_WAIT_L(0); PG8_MMA(0, 0, At, B0); PG8_BAR; PG8_SCHED;
            PG8_LDB(B1, 1, 1); PG8_STAGE(PG8_SB(1, 0), b3, voffB);
            PG8_BAR; PG8_WAIT_L(0); PG8_MMA(0, 1, At, B1); PG8_BAR;
            PG8_LDA(At, 1, 1); PG8_STAGE(PG8_SA(1, 0), a3, voffA);
            PG8_BAR; PG8_WAIT_L(0); PG8_MMA(1, 0, At, B0); PG8_BAR; PG8_SCHED;
            PG8_STAGE(PG8_SB(1, 1), b3 + hstepB, voffB);
            PG8_WAIT_V(6); PG8_BAR; PG8_MMA(1, 1, At, B1); PG8_BAR;
            }
        }
        if constexpr (ALIGN_EPI) { if (wr == 0) PG8_BAR; }
        if constexpr (!Epi::AFTER_DRAIN) { E(acc, cur, wr, wc, fr, fq); S.done(cur); }
        if (!has_next) break;
#pragma unroll
        for (int a = 0; a < 2; ++a)
#pragma unroll
            for (int b = 0; b < 2; ++b)
#pragma unroll
                for (int m = 0; m < 4; ++m)
#pragma unroll
                    for (int n = 0; n < 2; ++n) acc[a][b][m][n] = (f32x4){0.f, 0.f, 0.f, 0.f};
        cur = nxt; cA = nA; cB = nB; ++ui;
        if constexpr (ALIGN_EPI) { if (wr == 1) PG8_BAR; }
    }
    PG8_WAIT_V(0);
    if constexpr (!ALIGN_EPI) { if (wr == 0) PG8_BAR; }
    PG8_BAR;
    if constexpr (Epi::AFTER_DRAIN) { E.fused(acc, cur, wr, wc, fr, fq, lds, wid, lane); S.done(cur); }
#undef PG8_SA
#undef PG8_SB
#undef PG8_STAGE
#undef PG8_LDA
#undef PG8_LDB
#undef PG8_MMA
#undef PG8_WAIT_V
#undef PG8_WAIT_L
#undef PG8_BAR
#undef PG8_SCHED
}
}
#define GAS __attribute__((address_space(1)))
#define LAS __attribute__((address_space(3)))
typedef unsigned short bf16;
typedef unsigned v4u __attribute__((ext_vector_type(4)));
typedef float f32x4 __attribute__((ext_vector_type(4)));
typedef short bf16x8 __attribute__((ext_vector_type(8)));
typedef GAS unsigned gu32;
typedef GAS unsigned long long gu64;
#define RLX_AGENT __ATOMIC_RELAXED, __HIP_MEMORY_SCOPE_AGENT
#define LDS_WAIT() asm volatile("s_waitcnt lgkmcnt(0)" ::: "memory")
#define VM_WAIT() asm volatile("s_waitcnt vmcnt(0)" ::: "memory")
__device__ __forceinline__ unsigned long long rt() { return __builtin_amdgcn_s_memrealtime(); }
__device__ __forceinline__ unsigned f2bf(float f) { unsigned u = __builtin_bit_cast(unsigned, f); return (u + 0x7fffu + ((u >> 16) & 1u)) >> 16; }
__device__ __forceinline__ unsigned pk2(float lo, float hi) { return f2bf(lo) | (f2bf(hi) << 16); }

#define XB_TMO      128
#define XB_XCNT(j)  (256  + 64 * (j))
#define XB_XSUB(j)  (1280 + 64 * (j))
#define XB_XGEN(j)  (2304 + 64 * (j))
#define XB_TOP      3328
#define XB_TOPGEN   3392
#define XCD_BAR_WORDS 3456
#define XB_SPIN_CAP (1u << 18)

__device__ __forceinline__ unsigned xb_ld(unsigned* p)              { return __hip_atomic_load(p, __ATOMIC_RELAXED, __HIP_MEMORY_SCOPE_AGENT); }
__device__ __forceinline__ unsigned xb_add(unsigned* p, unsigned v) { return __hip_atomic_fetch_add(p, v, __ATOMIC_RELAXED, __HIP_MEMORY_SCOPE_AGENT); }
__device__ __forceinline__ unsigned xb_xcc_id() { return (unsigned)__builtin_amdgcn_s_getreg((3 << 11) | 20) & 0xFu; }
#define XB_SPIN(cond, bar) do { unsigned _sp = 0; while (cond) { __builtin_amdgcn_s_sleep(1); \
    if ((++_sp & 255u) == 0u) { if (xb_ld(&(bar)[XB_TMO])) break; if (_sp > XB_SPIN_CAP) { atomicAdd(&(bar)[XB_TMO], 1u); break; } } } } while (0)

struct XcdBarrier {
    unsigned* bar; unsigned x;
    volatile LAS unsigned* st;
};

__device__ __forceinline__ XcdBarrier xcd_barrier_post(unsigned* bar, volatile LAS unsigned* st) {
    XcdBarrier b; b.bar = bar; b.x = xb_xcc_id(); b.st = st;
    if (threadIdx.x == 0) (void)xb_add(&bar[XB_XCNT(b.x)], 1u);
    return b;
}
__device__ __forceinline__ void xcd_barrier_complete(unsigned* bar, unsigned x, unsigned& nloc, unsigned& nx) {
    const unsigned G = gridDim.x * gridDim.y * gridDim.z;
    unsigned sum, cnt, mine, sp = 0u;
    for (;;) {
        sum = 0u; cnt = 0u; mine = 0u;
#pragma unroll
        for (unsigned j = 0; j < 16; ++j) { const unsigned c = xb_ld(&bar[XB_XCNT(j)]); sum += c; cnt += (c > 0u) ? 1u : 0u; mine = (j == x) ? c : mine; }
        if (sum == G) break;
        __builtin_amdgcn_s_sleep(1);
        if ((++sp & 255u) == 0u) { if (xb_ld(&bar[XB_TMO])) break; if (sp > XB_SPIN_CAP) { atomicAdd(&bar[XB_TMO], 1u); break; } }
    }
    nloc = mine > 0u ? mine : 1u; nx = cnt > 0u ? cnt : 1u;
}

__device__ __forceinline__ void xcd_barrier(const XcdBarrier& b) {
    asm volatile("s_waitcnt vmcnt(0)" ::: "memory");
    __syncthreads();
    if (threadIdx.x == 0) {
        unsigned* bar = b.bar;
        __builtin_amdgcn_s_waitcnt(0);
        unsigned nloc = b.st[0], nx = b.st[1];
        if (nloc == 0u) { xcd_barrier_complete(bar, b.x, nloc, nx); b.st[0] = nloc; b.st[1] = nx; }
        const unsigned old = xb_add(&bar[XB_XSUB(b.x)], 1u);
        const unsigned gen = old / nloc;
        if (old + 1u == (gen + 1u) * nloc) {
            __builtin_amdgcn_fence(__ATOMIC_RELEASE, "agent");
            asm volatile("s_waitcnt vmcnt(0)" ::: "memory");
            const unsigned og = xb_add(&bar[XB_TOP], 1u);
            const unsigned tg = og / nx;
            if (og + 1u == (tg + 1u) * nx) xb_add(&bar[XB_TOPGEN], 1u);
            else XB_SPIN(xb_ld(&bar[XB_TOPGEN]) == tg, bar);
            __builtin_amdgcn_fence(__ATOMIC_ACQUIRE, "agent");
            xb_add(&bar[XB_XGEN(b.x)], 1u);
            asm volatile("s_waitcnt vmcnt(0)" ::: "memory");
        } else {
            XB_SPIN(xb_ld(&bar[XB_XGEN(b.x)]) == gen, bar);
            __builtin_amdgcn_fence(__ATOMIC_ACQUIRE, "agent");
            asm volatile("s_waitcnt vmcnt(0)" ::: "memory");
        }
    }
    __syncthreads();
}
constexpr int NWAVES = 8;
constexpr int BATCH = 16, SEQ = 2048, DM = 1024, M = BATCH * SEQ;
constexpr int L0P = 3584;
constexpr int L1P = 2048;
constexpr int DFF = 2816;
constexpr float ALPHA = 1.4142135623730951f;
typedef unsigned short bf16_t;
typedef float f32x16 __attribute__((ext_vector_type(16)));

constexpr size_t MiB = 1u << 20;
constexpr size_t WS_CTL = 0, CTL_ZERO_BYTES = 1 * MiB;
constexpr int CW_BAR = 4096;
constexpr size_t WS_W0IN = 2 * MiB, WS_W0OUT = 9 * MiB, WS_WUP0 = 11 * MiB, WS_WDN0 = 22 * MiB, WS_W1IN = 28 * MiB, WS_WUQ = 32 * MiB, WS_WUKV = 33 * MiB,
                 WS_W1OUT = 34 * MiB, WS_WUP1 = 36 * MiB, WS_WDN1 = 47 * MiB;
constexpr size_t WS_XB = 56 * MiB, WS_YMIX = 120 * MiB, WS_BIG = 184 * MiB;
constexpr size_t WS_G = 408 * MiB, WS_BONUS = 440 * MiB, WS_DT = 441 * MiB, WS_XST = 442 * MiB, WS_BT = 474 * MiB, WS_ASUM = 490 * MiB;
constexpr size_t WS_SLOC = 120 * MiB;
constexpr size_t WS_W2T = 53 * MiB, WS_A2T = 53 * MiB + 256 * 1024, WS_G2T = 53 * MiB + 512 * 1024;
constexpr size_t WS_GU = 120 * MiB;
constexpr size_t WS_PROJ1 = 184 * MiB, WS_QM = 312 * MiB, WS_KVM = 360 * MiB, WS_KPE = 424 * MiB, WS_RS = 426 * MiB;
constexpr size_t WS_CSTAB = 492 * MiB;
constexpr size_t WS_VTS = 428 * MiB, WS_VTM = 460 * MiB;
constexpr size_t WS_NEED = 497 * MiB;

constexpr int RING_BYTES = 131072;
constexpr int LDSCTL_OFF = 146432, MISC_OFF = LDSCTL_OFF + 320;
constexpr int LDS_BYTES = 147456;

__device__ __forceinline__ float bf2f(bf16_t b) { return __builtin_bit_cast(float, (unsigned)b << 16); }
__device__ __forceinline__ float sigmoidf_(float x) { return 1.f / (1.f + expf(-x)); }
__device__ __forceinline__ float softplusf_(float x) { return fmaxf(x, 0.f) + log1pf(expf(-fabsf(x))); }
__device__ __forceinline__ float siluf_(float x) { return x / (1.f + expf(-x)); }
__device__ __forceinline__ float wave_sum(float v) {
#pragma unroll
    for (int o = 1; o < 64; o <<= 1) v += __shfl_xor(v, o);
    return v;
}
#define WSYNC() asm volatile("s_waitcnt lgkmcnt(0)" ::: "memory")
typedef float f32x2_t __attribute__((ext_vector_type(2)));
typedef __bf16 bf16x2_t __attribute__((ext_vector_type(2)));
typedef unsigned u32x2 __attribute__((ext_vector_type(2)));
__device__ __forceinline__ unsigned cvtpk(float lo, float hi) { f32x2_t v = {lo, hi}; bf16x2_t b = __builtin_convertvector(v, bf16x2_t); return __builtin_bit_cast(unsigned, b); }
__device__ __forceinline__ float bflo(unsigned u) { return __builtin_bit_cast(float, u << 16); }
__device__ __forceinline__ float bfhi(unsigned u) { return __builtin_bit_cast(float, u & 0xffff0000u); }
__device__ __forceinline__ bf16_t bf1(float x) { return (bf16_t)(cvtpk(x, x) & 0xffffu); }
__device__ __forceinline__ bf16x8 pack8(float a0, float a1, float a2, float a3, float a4, float a5, float a6, float a7) {
    v4u w; w.x = cvtpk(a0, a1); w.y = cvtpk(a2, a3); w.z = cvtpk(a4, a5); w.w = cvtpk(a6, a7); return __builtin_bit_cast(bf16x8, w); }
template <int CTRL> __device__ __forceinline__ float dpp_mov(float x) { return __builtin_bit_cast(float, __builtin_amdgcn_update_dpp(0, __builtin_bit_cast(int, x), CTRL, 0xF, 0xF, true)); }
__device__ __forceinline__ float rowsum16(float x) { x += dpp_mov<0x128>(x); x += dpp_mov<0x124>(x); x += dpp_mov<0x122>(x); x += dpp_mov<0x121>(x); return x; }
__device__ __forceinline__ float rl(float x, int l) { return __builtin_bit_cast(float, __builtin_amdgcn_readlane(__builtin_bit_cast(int, x), l)); }
__device__ __forceinline__ float wave_sum_dpp(float x) { x = rowsum16(x); return (rl(x, 0) + rl(x, 16)) + (rl(x, 32) + rl(x, 48)); }

__device__ __forceinline__ void transpose_matrix(const float* __restrict__ W, int K, int N, bf16_t* __restrict__ WT, int Npad, int ldt, LAS float* scr, int gw, int NGW, int lane, const float* __restrict__ kscale, int& tr_base, bool ffn_interleave = false) {
    (void)scr;
    const int nblk = Npad / 64, nit = (K / 64) * nblk;
    int it0 = gw - (tr_base % NGW); if (it0 < 0) it0 += NGW; tr_base += nit;
    for (int it = it0; it < nit; it += NGW) {
        const int kb = it / nblk, nb = it - kb * nblk, n = nb * 64 + lane, k0 = kb * 64;
        const bool ok = n < N; const float* src = W + (size_t)k0 * N + (ok ? n : 0);
#pragma unroll
        for (int hc = 0; hc < 2; ++hc) {
            float v[32];
#pragma unroll
            for (int i = 0; i < 32; ++i) v[i] = src[(size_t)(hc * 32 + i) * N];
#pragma unroll
            for (int c = 0; c < 4; ++c) { float u[8];
#pragma unroll
                for (int i = 0; i < 8; ++i) { u[i] = ok ? v[c * 8 + i] : 0.f; if (kscale) u[i] *= kscale[k0 + hc * 32 + c * 8 + i]; }
                v4u o; o.x = cvtpk(u[0], u[1]); o.y = cvtpk(u[2], u[3]); o.z = cvtpk(u[4], u[5]); o.w = cvtpk(u[6], u[7]);
                const int nr = ffn_interleave ? ((n < DFF) ? 256 * (n >> 7) + (n & 127) : 256 * ((n - DFF) >> 7) + 128 + ((n - DFF) & 127)) : n;
                *(v4u*)(WT + (size_t)nr * ldt + k0 + hc * 32 + c * 8) = o; }
        }
    }
}

template <int MODE> __device__ __forceinline__ void ln_rows(float* h, bf16_t* hb, float* stats, const float* __restrict__ g, const float* __restrict__ b, int gw, int NGW, int lane) {
    for (int row = gw * 2; row < M; row += NGW * 2) {
        float* p = h + (size_t)row * DM;
        f32x4 v[2][4]; float s[2] = {0.f, 0.f};
#pragma unroll
        for (int r = 0; r < 2; ++r)
#pragma unroll
            for (int j = 0; j < 4; ++j) v[r][j] = *(const f32x4*)(p + r * DM + 4 * lane + 256 * j);
#pragma unroll
        for (int r = 0; r < 2; ++r)
#pragma unroll
            for (int j = 0; j < 4; ++j) s[r] += (v[r][j][0] + v[r][j][1]) + (v[r][j][2] + v[r][j][3]);
        float mean[2], q[2] = {0.f, 0.f}, rstd[2];
#pragma unroll
        for (int r = 0; r < 2; ++r) { mean[r] = wave_sum_dpp(s[r]) * (1.f / DM);
#pragma unroll
            for (int j = 0; j < 4; ++j) { v[r][j] = v[r][j] - mean[r]; q[r] += (v[r][j][0] * v[r][j][0] + v[r][j][1] * v[r][j][1]) + (v[r][j][2] * v[r][j][2] + v[r][j][3] * v[r][j][3]); } }
#pragma unroll
        for (int r = 0; r < 2; ++r) rstd[r] = 1.0f / sqrtf(wave_sum_dpp(q[r]) * (1.f / DM) + 1e-5f);
        if (MODE == 1 && lane < 2) { stats[2 * (row + lane)] = lane ? mean[1] : mean[0]; stats[2 * (row + lane) + 1] = lane ? rstd[1] : rstd[0]; }
#pragma unroll
        for (int j = 0; j < 4; ++j) {
            const int c = 4 * lane + 256 * j;
            const f32x4 gg = *(const f32x4*)(g + c), bb = *(const f32x4*)(b + c);
#pragma unroll
            for (int r = 0; r < 2; ++r) {
                const f32x4 o = v[r][j] * rstd[r] * gg + bb;
                if (MODE == 1) { uint2 w; w.x = cvtpk(o[0], o[1]); w.y = cvtpk(o[2], o[3]); *(uint2*)(hb + (size_t)(row + r) * DM + c) = w; }
                else *(f32x4*)(p + r * DM + c) = o;
            }
        }
    }
}

__device__ __forceinline__ void rwkv_naive_chain(int chain, int lane, LAS float* sm, const bf16_t* __restrict__ proj, const float* __restrict__ mix, const float* __restrict__ w0, const float* __restrict__ w2,
                                                 const float* __restrict__ a0, const float* __restrict__ a2, const float* __restrict__ g2, const float* __restrict__ k_k,
                                                 const float* __restrict__ k_a, const float* __restrict__ r_k, const float* __restrict__ ln_g, const float* __restrict__ ln_b, bf16_t* __restrict__ ymix) {
    LAS float* s_w2 = sm; LAS float* s_a2 = sm + 4096; LAS float* s_g2 = sm + 8192; LAS float* s_tw = sm + 16384; LAS float* s_al = s_tw + 64; LAS float* s_sg = s_tw + 128;
    LAS float* s_w = s_tw + 256; LAS float* s_k = s_tw + 320; LAS float* s_a = s_tw + 384; LAS float* s_b = s_tw + 448; LAS float* s_r = s_tw + 512;
    const int b = chain >> 3, h = chain & 7, c = h * 64 + lane;
    for (int l = 0; l < 64; ++l) { s_w2[l * 64 + lane] = w2[l * 512 + c]; s_a2[l * 64 + lane] = a2[l * 512 + c]; }
    for (int l = 0; l < 128; ++l) s_g2[l * 64 + lane] = g2[l * 512 + c];
    const float mr = mix[c], mk = mix[512 + c], mv = mix[1024 + c], mw = mix[1536 + lane], ma = mix[1600 + lane], mg0 = mix[1664 + lane], mg1 = mix[1728 + lane];
    const float w0c = w0[c], a0c = a0[c], kkc = k_k[c], kac = k_a[c], rkc = r_k[c], lgc = ln_g[c], lbc = ln_b[c];
    float S[64];
#pragma unroll
    for (int j = 0; j < 64; ++j) S[j] = 0.f;
    float pr = 0.f, pk = 0.f, pv = 0.f, pw = 0.f, pa = 0.f, pg0 = 0.f, pg1 = 0.f;
    WSYNC();
    for (int t = 0; t < SEQ; ++t) {
        const bf16_t* row = proj + (size_t)(b * SEQ + t) * L0P;
        const float cr = bf2f(row[c]), ck = bf2f(row[512 + c]), cv = bf2f(row[1024 + c]), cw = bf2f(row[1536 + lane]), ca = bf2f(row[1600 + lane]),
                    cg0 = bf2f(row[1664 + lane]), cg1 = bf2f(row[1728 + lane]);
        const float r_s = cr + (pr - cr) * mr, k_s = ck + (pk - ck) * mk, v_s = cv + (pv - cv) * mv;
        const float wl = cw + (pw - cw) * mw, al = ca + (pa - ca) * ma, g0 = cg0 + (pg0 - cg0) * mg0, g1 = cg1 + (pg1 - cg1) * mg1;
        pr = cr; pk = ck; pv = cv; pw = cw; pa = ca; pg0 = cg0; pg1 = cg1;
        s_tw[lane] = tanhf(wl); s_al[lane] = al; s_sg[lane] = sigmoidf_(g0); s_sg[64 + lane] = sigmoidf_(g1);
        WSYNC();
        float wsum = w0c, asum = a0c, gsum = 0.f;
#pragma unroll 2
        for (int l = 0; l < 64; ++l) { wsum += s_tw[l] * s_w2[l * 64 + lane]; asum += s_al[l] * s_a2[l * 64 + lane]; }
#pragma unroll 2
        for (int l = 0; l < 128; ++l) gsum += s_sg[l] * s_g2[l * 64 + lane];
        const float log_w = -softplusf_(-wsum) - 0.5f;
        const float dec = expf(-expf(log_w));
        const float a = sigmoidf_(asum);
        float kkv = k_s * kkc;
        const float nrm = sqrtf(wave_sum(kkv * kkv));
        kkv = kkv / fmaxf(nrm, 1e-12f);
        const float k2 = k_s * (1.f + (a - 1.f) * kac);
        const float bonus_s = wave_sum(r_s * k2 * rkc);
        s_w[lane] = dec; s_k[lane] = k2; s_a[lane] = -kkv; s_b[lane] = kkv * a; s_r[lane] = r_s;
        WSYNC();
        float sa = 0.f;
#pragma unroll
        for (int j = 0; j < 64; ++j) sa += S[j] * s_a[j];
        float y = 0.f;
#pragma unroll
        for (int j = 0; j < 64; ++j) { S[j] = S[j] * s_w[j] + sa * s_b[j] + v_s * s_k[j]; y += S[j] * s_r[j]; }
        const float mu = wave_sum(y) * (1.f / 64.f);
        const float d = y - mu;
        const float var = wave_sum(d * d) * (1.f / 64.f);
        const float yn = d * (1.0f / sqrtf(var + 64e-5f)) * lgc + lbc;
        const float o = (yn + bonus_s * v_s) * gsum;
        ymix[(size_t)(b * SEQ + t) * DM + c] = (bf16_t)f2bf(o);
        WSYNC();
    }
}

__device__ __forceinline__ void ssm_conv_all(const bf16_t* __restrict__ proj, const float* __restrict__ cw, const float* __restrict__ cb, const float* __restrict__ dtb,
                                             bf16_t* __restrict__ xbc, float* __restrict__ dt, int gtid, int NT) {
    for (size_t i = gtid; i < (size_t)M * 1024; i += NT) {
        const int m = (int)(i >> 10), c = (int)(i & 1023), t = m & (SEQ - 1);
        float acc = cb[c];
#pragma unroll
        for (int k = 0; k < 4; ++k) { const int tt = t - 3 + k; if (tt >= 0) acc += cw[k * 1024 + c] * bf2f(proj[(size_t)(m - 3 + k) * L0P + 2304 + c]); }
        xbc[i] = (bf16_t)f2bf(siluf_(acc));
    }
    for (int i = gtid; i < M * 8; i += NT) dt[i] = softplusf_(bf2f(proj[(size_t)(i >> 3) * L0P + 3328 + (i & 7)]) + dtb[i & 7]);
}
__device__ __forceinline__ void ssd_naive_task(int task, int lane, const bf16_t* __restrict__ xbc, const float* __restrict__ dt, const float* __restrict__ a_log, const float* __restrict__ dsk, float* __restrict__ yssm) {
    const int chain = task >> 2, q = task & 3, b = chain >> 3, h = chain & 7, g = h >> 2, p = q * 16 + (lane >> 2), nq = lane & 3;
    const float A = -expf(a_log[h]), D = dsk[h];
    float st[32];
#pragma unroll
    for (int n = 0; n < 32; ++n) st[n] = 0.f;
    for (int t = 0; t < SEQ; ++t) {
        const size_t m = (size_t)b * SEQ + t;
        const float dtv = dt[m * 8 + h], dA = expf(dtv * A);
        const float x = bf2f(xbc[m * 1024 + h * 64 + p]), xdt = x * dtv;
        const bf16_t* Bp = xbc + m * 1024 + 512 + g * 128 + nq * 32;
        const bf16_t* Cp = xbc + m * 1024 + 768 + g * 128 + nq * 32;
        float yp = 0.f;
#pragma unroll
        for (int n = 0; n < 32; ++n) { st[n] = st[n] * dA + xdt * bf2f(Bp[n]); yp += st[n] * bf2f(Cp[n]); }
        yp += __shfl_xor(yp, 1); yp += __shfl_xor(yp, 2);
        if (nq == 0) yssm[m * 512 + h * 64 + p] = yp + D * x;
    }
}
template <bool ST = true> __device__ __forceinline__ void ssm_gate_norm_all(const bf16_t* __restrict__ yssm, const bf16_t* __restrict__ proj, const float* __restrict__ ng, bf16_t* __restrict__ ymix, int wv0, int wvend, int lane) {
    for (int wvb = wv0 * 4 - (wv0 & ~7) * 3; wvb < wvend; wvb += NWAVES * 4) {
        float u[4][4], q[4];
#pragma unroll
        for (int k = 0; k < 4; ++k) { const int wv = wvb + k, m = wv >> 1, g = wv & 1; q[k] = 0.f;
#pragma unroll
            for (int j = 0; j < 4; ++j) { const int c = g * 256 + j * 64 + lane; const float z = bf2f(proj[(size_t)m * L0P + 1792 + c]); u[k][j] = bf2f(yssm[(size_t)m * 512 + c]) * (z * __builtin_amdgcn_rcpf(1.f + __expf(-z))); q[k] += u[k][j] * u[k][j]; } }
#pragma unroll
        for (int k = 0; k < 4; ++k) { const int wv = wvb + k, m = wv >> 1, g = wv & 1;
            const float rs = __builtin_amdgcn_rsqf(wave_sum_dpp(q[k]) * (1.f / 256.f) + 1e-5f);
#pragma unroll
            for (int j = 0; j < 4; ++j) { const int c = g * 256 + j * 64 + lane; const float o_ = u[k][j] * rs * ng[c]; if (ST) ymix[(size_t)m * DM + 512 + c] = bf1(o_); else asm volatile("" :: "v"(o_)); } }
    }
}
template <bool ST = true> __device__ __forceinline__ void ffn_act_all(bf16_t* gu, const float* __restrict__ cw, const float* __restrict__ cb, int gtid, int NT) {
    constexpr int NCH = DFF / 8, NSTRIP = M / 32;
    for (int task = gtid; task < NSTRIP * NCH; task += NT) {
        const int strip = task / NCH, q = task - strip * NCH, c0 = q * 8, m0 = strip * 32;
        float w0[8], w1[8], w2[8], bb[8], g2[8], g1[8];
#pragma unroll
        for (int j = 0; j < 8; j += 4) { const f32x4 a = *(const f32x4*)(cw + c0 + j), b = *(const f32x4*)(cw + DFF + c0 + j), c = *(const f32x4*)(cw + 2 * DFF + c0 + j), d = *(const f32x4*)(cb + c0 + j);
#pragma unroll
            for (int k = 0; k < 4; ++k) { w0[j + k] = a[k]; w1[j + k] = b[k]; w2[j + k] = c[k]; bb[j + k] = d[k]; } }
        bf16_t* base = gu + (size_t)m0 * (2 * DFF) + c0;
        if ((m0 & (SEQ - 1)) != 0) { const v4u a = *(const v4u*)(base - 2 * (2 * DFF)), b = *(const v4u*)(base - (2 * DFF));
            g2[0] = bflo(a.x); g2[1] = bfhi(a.x); g2[2] = bflo(a.y); g2[3] = bfhi(a.y); g2[4] = bflo(a.z); g2[5] = bfhi(a.z); g2[6] = bflo(a.w); g2[7] = bfhi(a.w);
            g1[0] = bflo(b.x); g1[1] = bfhi(b.x); g1[2] = bflo(b.y); g1[3] = bfhi(b.y); g1[4] = bflo(b.z); g1[5] = bfhi(b.z); g1[6] = bflo(b.w); g1[7] = bfhi(b.w); }
        else {
#pragma unroll
            for (int j = 0; j < 8; ++j) { g2[j] = 0.f; g1[j] = 0.f; } }
#pragma unroll 4
        for (int r = 0; r < 32; ++r) {
            const v4u gv = *(const v4u*)(base + (size_t)r * (2 * DFF)), uv = *(const v4u*)(base + (size_t)r * (2 * DFF) + DFF);
            const unsigned gw_[4] = {gv.x, gv.y, gv.z, gv.w}, uw_[4] = {uv.x, uv.y, uv.z, uv.w};
            unsigned ow[4];
#pragma unroll
            for (int k = 0; k < 4; ++k) {
                const float ga = bflo(gw_[k]), gb = bfhi(gw_[k]);
                const float ya = bb[2 * k] + w0[2 * k] * g2[2 * k] + w1[2 * k] * g1[2 * k] + w2[2 * k] * ga;
                const float yb = bb[2 * k + 1] + w0[2 * k + 1] * g2[2 * k + 1] + w1[2 * k + 1] * g1[2 * k + 1] + w2[2 * k + 1] * gb;
                g2[2 * k] = g1[2 * k]; g1[2 * k] = ga; g2[2 * k + 1] = g1[2 * k + 1]; g1[2 * k + 1] = gb;
                ow[k] = cvtpk(ya / (1.f + __expf(-ya)) * bflo(uw_[k]), yb / (1.f + __expf(-yb)) * bfhi(uw_[k]));
            }
            if (ST) *(v4u*)(base + (size_t)r * (2 * DFF) + DFF) = (v4u){ow[0], ow[1], ow[2], ow[3]}; else asm volatile("" :: "v"(ow[0]), "v"(ow[1]), "v"(ow[2]), "v"(ow[3]));
        }
    }
}
template <bool ST = true> __device__ __forceinline__ void mla_prep_all(const bf16_t* __restrict__ proj1, const int* __restrict__ pos, float* __restrict__ rs, bf16_t* __restrict__ kpe, float* __restrict__ cstab, int gw, int NGW, int lane) {
    for (int m4 = gw * 4; m4 < M; m4 += NGW * 4) {
        const int mt = m4 + (lane >> 4), fi = lane & 15;
        const double inv = exp2(-(double)(2 * fi) * (13.287712379549449 / 32.0));
        const double ang = (double)pos[mt] * inv;
        const float cs = (float)cos(ang), sn = (float)sin(ang);
        cstab[(size_t)mt * 32 + fi] = cs; cstab[(size_t)mt * 32 + 16 + fi] = sn;
        { const bf16_t* row = proj1 + (size_t)mt * L1P; const float x1 = bf2f(row[1920 + fi]), x2 = bf2f(row[1936 + fi]);
          kpe[(size_t)mt * 32 + fi] = bf1(x1 * cs - x2 * sn); kpe[(size_t)mt * 32 + 16 + fi] = bf1(x2 * cs + x1 * sn); }
        float q[4], k[4];
#pragma unroll
        for (int u = 0; u < 4; ++u) { const bf16_t* row = proj1 + (size_t)(m4 + u) * L1P; q[u] = 0.f; k[u] = 0.f;
#pragma unroll
            for (int j = 0; j < 4; ++j) { const float v = bf2f(row[1536 + j * 64 + lane]); q[u] += v * v; }
#pragma unroll
            for (int j = 0; j < 2; ++j) { const float v = bf2f(row[1792 + j * 64 + lane]); k[u] += v * v; } }
#pragma unroll
        for (int u = 0; u < 4; ++u) { q[u] = wave_sum_dpp(q[u]); k[u] = wave_sum_dpp(k[u]); }
        if (lane < 4) { const float qq = lane == 0 ? q[0] : lane == 1 ? q[1] : lane == 2 ? q[2] : q[3], kk2 = lane == 0 ? k[0] : lane == 1 ? k[1] : lane == 2 ? k[2] : k[3];
            rs[(size_t)(m4 + lane) * 2] = 1.0f / sqrtf(qq * (1.f / 256.f) + 1e-6f); rs[(size_t)(m4 + lane) * 2 + 1] = 1.0f / sqrtf(kk2 * (1.f / 128.f) + 1e-6f); }
    }
}
template <bool ST = true> __device__ __forceinline__ void rope_q_all(bf16_t* qm, const float* __restrict__ cstab, int gtid, int NT) {
    for (int i = gtid; i < M * 16; i += NT) {
        const int m = i >> 4, h = (i >> 1) & 7, k0 = (i & 1) * 8;
        bf16_t* p = qm + (size_t)m * 768 + h * 96 + 64 + k0;
        const v4u a = *(const v4u*)p, b = *(const v4u*)(p + 16);
        const f32x4 c0 = *(const f32x4*)(cstab + (size_t)m * 32 + k0), c1 = *(const f32x4*)(cstab + (size_t)m * 32 + k0 + 4), s0 = *(const f32x4*)(cstab + (size_t)m * 32 + 16 + k0), s1 = *(const f32x4*)(cstab + (size_t)m * 32 + 16 + k0 + 4);
        const unsigned au[4] = {a.x, a.y, a.z, a.w}, bu[4] = {b.x, b.y, b.z, b.w};
        const float cs[8] = {c0[0], c0[1], c0[2], c0[3], c1[0], c1[1], c1[2], c1[3]}, sn[8] = {s0[0], s0[1], s0[2], s0[3], s1[0], s1[1], s1[2], s1[3]};
        unsigned o1[4], o2[4];
#pragma unroll
        for (int q = 0; q < 4; ++q) { const float x1a = bflo(au[q]), x1b = bfhi(au[q]), x2a = bflo(bu[q]), x2b = bfhi(bu[q]);
            o1[q] = cvtpk(x1a * cs[2 * q] - x2a * sn[2 * q], x1b * cs[2 * q + 1] - x2b * sn[2 * q + 1]);
            o2[q] = cvtpk(x2a * cs[2 * q] + x1a * sn[2 * q], x2b * cs[2 * q + 1] + x1b * sn[2 * q + 1]); }
        if (ST) { *(v4u*)p = (v4u){o1[0], o1[1], o1[2], o1[3]}; *(v4u*)(p + 16) = (v4u){o2[0], o2[1], o2[2], o2[3]}; }
    }
}
__device__ __forceinline__ void sb_naive_task(int qblk, int bh, int lane, const bf16_t* __restrict__ proj1, bf16_t* __restrict__ ymix) {
    const int b = bh >> 3, h = bh & 7, t = qblk * 64 + lane;
    const size_t mrow = (size_t)b * SEQ;
    float q[64], o[64];
#pragma unroll
    for (int d = 0; d < 64; ++d) { q[d] = bf2f(proj1[(mrow + t) * L1P + h * 64 + d]) * 0.125f; o[d] = 0.f; }
    float cum = 0.f;
    const int smax = qblk * 64 + 63;
    for (int s = smax - 1; s >= 0; --s) {
        const bf16_t* kr = proj1 + (mrow + s) * L1P + 512 + h * 64;
        const bf16_t* vr = proj1 + (mrow + s) * L1P + 1024 + h * 64;
        float z = 0.f;
#pragma unroll
        for (int d = 0; d < 64; ++d) z += q[d] * bf2f(kr[d]);
        if (s < t) {
            const float lsp = -softplusf_(-z);
            const float lsn = -softplusf_(z);
            const float att = expf(lsp + cum);
            cum += lsn;
#pragma unroll
            for (int d = 0; d < 64; ++d) o[d] += att * bf2f(vr[d]);
        }
    }
#pragma unroll
    for (int d = 0; d < 64; ++d) ymix[(mrow + t) * DM + h * 64 + d] = (bf16_t)f2bf(o[d]);
}
__device__ __forceinline__ void mla_naive_task(int qblk, int bh, int lane, const bf16_t* __restrict__ qm, const bf16_t* __restrict__ kvm, const bf16_t* __restrict__ kpe, bf16_t* __restrict__ ymix) {
    const int b = bh >> 3, h = bh & 7, t = qblk * 64 + lane;
    const size_t mrow = (size_t)b * SEQ;
    const float scale = 0.10206207261596577f;
    float q[96], o[64];
#pragma unroll
    for (int d = 0; d < 96; ++d) q[d] = bf2f(qm[(mrow + t) * 768 + h * 96 + d]) * scale;
#pragma unroll
    for (int d = 0; d < 64; ++d) o[d] = 0.f;
    float mx = -1e30f, l = 0.f;
    const int smax = qblk * 64 + 63;
    for (int s = 0; s <= smax; ++s) {
        const bf16_t* kr = kvm + (mrow + s) * 1024 + h * 128;
        const bf16_t* pr = kpe + (mrow + s) * 32;
        float z = 0.f;
#pragma unroll
        for (int d = 0; d < 64; ++d) z += q[d] * bf2f(kr[d]);
#pragma unroll
        for (int d = 0; d < 32; ++d) z += q[64 + d] * bf2f(pr[d]);
        if (s <= t) {
            const float mn = fmaxf(mx, z), f = expf(mx - mn), pz = expf(z - mn);
            l = l * f + pz; mx = mn;
#pragma unroll
            for (int d = 0; d < 64; ++d) o[d] = o[d] * f + pz * bf2f(kr[64 + d]);
        }
    }
    const float il = 1.f / l;
#pragma unroll
    for (int d = 0; d < 64; ++d) ymix[(mrow + t) * DM + 512 + h * 64 + d] = (bf16_t)f2bf(o[d] * il);
}


__device__ __forceinline__ int crow(int r, int hi) { return (r & 3) + 8 * (r >> 2) + 4 * hi; }
#define MFMA32(a, b, c) __builtin_amdgcn_mfma_f32_32x32x16_bf16((a), (b), (c), 0, 0, 0)
constexpr int STG_PITCH = 72;
__device__ __forceinline__ void transpose_tile64(const bf16_t* __restrict__ src, int sp, bf16_t* __restrict__ dst, int dp, LAS bf16_t* scr, int lane) {
#pragma unroll
    for (int i = 0; i < 8; ++i) { const int row = i * 8 + (lane >> 3), ch = lane & 7; const v4u v = *(const v4u*)(src + (size_t)row * sp + ch * 8); *(LAS v4u*)(scr + row * STG_PITCH + ch * 8) = v; }
    WSYNC();
#pragma unroll
    for (int i = 0; i < 8; ++i) { const int d = i * 8 + (lane >> 3), tc = lane & 7; const LAS bf16_t* p = scr + (tc * 8) * STG_PITCH + d;
        v4u o; o.x = (unsigned)p[0] | ((unsigned)p[STG_PITCH] << 16); o.y = (unsigned)p[2 * STG_PITCH] | ((unsigned)p[3 * STG_PITCH] << 16);
        o.z = (unsigned)p[4 * STG_PITCH] | ((unsigned)p[5 * STG_PITCH] << 16); o.w = (unsigned)p[6 * STG_PITCH] | ((unsigned)p[7 * STG_PITCH] << 16);
        *(v4u*)(dst + (size_t)d * dp + tc * 8) = o; }
    WSYNC();
}
__device__ __forceinline__ void store_OT(const f32x16 (&o)[2], float sc, LAS bf16_t* stg, bf16_t* __restrict__ dst, int lane) {
    const int l31 = lane & 31, hi = lane >> 5;
#pragma unroll
    for (int dt = 0; dt < 2; ++dt)
#pragma unroll
        for (int r = 0; r < 16; ++r) stg[l31 * STG_PITCH + 32 * dt + crow(r, hi)] = bf1(o[dt][r] * sc);
    WSYNC();
#pragma unroll
    for (int i = 0; i < 4; ++i) { const int row = i * 8 + (lane >> 3), ch = lane & 7; const v4u v = *(const LAS v4u*)(stg + row * STG_PITCH + ch * 8); *(v4u*)(dst + (size_t)row * DM + ch * 8) = v; }
    WSYNC();
}
__device__ __forceinline__ float softplus_fast(float z) { return fmaxf(z, 0.f) + __logf(1.f + __expf(-fabsf(z))); }

__device__ __forceinline__ void sb_task(int bh, int qblk, int lane, const bf16_t* __restrict__ P1, const bf16_t* __restrict__ VT, bf16_t* __restrict__ ymix, LAS bf16_t* stg) {
    const int b = bh >> 3, h = bh & 7, l31 = lane & 31, hi = lane >> 5, q0 = qblk * 32, t = q0 + l31;
    const size_t rowb = (size_t)b * SEQ;
    const bf16_t* Qp = P1 + (rowb + q0 + l31) * L1P + h * 64 + 8 * hi;
    bf16x8 qf[4];
#pragma unroll
    for (int kk = 0; kk < 4; ++kk) qf[kk] = *(const bf16x8*)(Qp + 16 * kk);
    const bf16_t* Kp = P1 + (rowb + l31) * L1P + 512 + h * 64 + 8 * hi;
    const bf16_t* Vp = VT + ((size_t)bh * 64 + l31) * SEQ + 4 * hi;
    f32x16 o[2];
#pragma unroll
    for (int r = 0; r < 16; ++r) { o[0][r] = 0.f; o[1][r] = 0.f; }
    float cum = 0.f;
    bf16x8 kf[4]; u32x2 va[2][2][2];
#define SB_LOAD(S0, KF, VA) do { _Pragma("unroll") for (int kk = 0; kk < 4; ++kk) KF[kk] = *(const bf16x8*)(Kp + (size_t)(S0) * L1P + 16 * kk); \
        _Pragma("unroll") for (int dt = 0; dt < 2; ++dt) _Pragma("unroll") for (int ks = 0; ks < 2; ++ks) { VA[dt][ks][0] = *(const u32x2*)(Vp + (size_t)dt * 32 * SEQ + (S0) + 16 * ks); VA[dt][ks][1] = *(const u32x2*)(Vp + (size_t)dt * 32 * SEQ + (S0) + 16 * ks + 8); } } while (0)
    SB_LOAD(q0, kf, va);
    for (int s0 = q0; s0 >= 0; s0 -= 32) {
        bf16x8 kn[4]; u32x2 vn[2][2][2];
        const int sn = (s0 >= 32) ? s0 - 32 : 0;
        SB_LOAD(sn, kn, vn);
        f32x16 acc;
#pragma unroll
        for (int r = 0; r < 16; ++r) acc[r] = 0.f;
#pragma unroll
        for (int kk = 0; kk < 4; ++kk) acc = MFMA32(kf[kk], qf[kk], acc);
        const bool diag = (s0 == q0);
        float lb[16], lk[16];
#pragma unroll
        for (int r = 0; r < 16; ++r) { const float z = acc[r] * 0.125f; const float sp = softplus_fast(z); float b_ = z - sp, k_ = -sp;
            if (diag) { const bool valid = (s0 + crow(r, hi)) < t; b_ = valid ? b_ : -1e30f; k_ = valid ? k_ : 0.f; }
            lb[r] = b_; lk[r] = k_; }
        float e[16], T[4], U[4];
#pragma unroll
        for (int i = 0; i < 4; ++i) { e[4 * i + 3] = 0.f; e[4 * i + 2] = lk[4 * i + 3]; e[4 * i + 1] = e[4 * i + 2] + lk[4 * i + 2]; e[4 * i] = e[4 * i + 1] + lk[4 * i + 1]; T[i] = e[4 * i] + lk[4 * i]; }
#pragma unroll
        for (int i = 0; i < 4; ++i) U[i] = __shfl_xor(T[i], 32);
        float off[4];
        { const float st2 = T[3], st1 = st2 + T[2], st0 = st1 + T[1]; const float su2 = U[3], su1 = su2 + U[2], su0 = su1 + U[1];
          const float x0 = hi ? 0.f : U[0], x1 = hi ? 0.f : U[1], x2 = hi ? 0.f : U[2], x3 = hi ? 0.f : U[3];
          off[3] = x3; off[2] = st2 + su2 + x2; off[1] = st1 + su1 + x1; off[0] = st0 + su0 + x0;
          const float total = st0 + T[0] + su0 + U[0];
#pragma unroll
          for (int r = 0; r < 16; ++r) acc[r] = __expf(lb[r] + (cum + off[r >> 2] + e[r]));
          cum += total; }
        bf16x8 pf[2];
#pragma unroll
        for (int ks = 0; ks < 2; ++ks) { v4u w; w.x = cvtpk(acc[8 * ks], acc[8 * ks + 1]); w.y = cvtpk(acc[8 * ks + 2], acc[8 * ks + 3]); w.z = cvtpk(acc[8 * ks + 4], acc[8 * ks + 5]); w.w = cvtpk(acc[8 * ks + 6], acc[8 * ks + 7]); pf[ks] = __builtin_bit_cast(bf16x8, w); }
#pragma unroll
        for (int dt = 0; dt < 2; ++dt)
#pragma unroll
            for (int ks = 0; ks < 2; ++ks) { v4u a; a.x = va[dt][ks][0].x; a.y = va[dt][ks][0].y; a.z = va[dt][ks][1].x; a.w = va[dt][ks][1].y; o[dt] = MFMA32(__builtin_bit_cast(bf16x8, a), pf[ks], o[dt]); }
        if (__all(cum < -110.f)) break;
#pragma unroll
        for (int kk = 0; kk < 4; ++kk) kf[kk] = kn[kk];
#pragma unroll
        for (int dt = 0; dt < 2; ++dt)
#pragma unroll
            for (int ks = 0; ks < 2; ++ks) { va[dt][ks][0] = vn[dt][ks][0]; va[dt][ks][1] = vn[dt][ks][1]; }
    }
#undef SB_LOAD
    store_OT(o, 1.0f, stg, ymix + (rowb + q0) * DM + h * 64, lane);
}
__device__ __forceinline__ void mla_task(int bh, int qblk, int lane, const bf16_t* __restrict__ QM, const bf16_t* __restrict__ KVM, const bf16_t* __restrict__ KPE, const bf16_t* __restrict__ VT,
                                         bf16_t* __restrict__ ymix, LAS bf16_t* stg) {
    const int b = bh >> 3, h = bh & 7, l31 = lane & 31, hi = lane >> 5, q0 = qblk * 32, t = q0 + l31;
    const size_t rowb = (size_t)b * SEQ;
    const bf16_t* Qp = QM + (rowb + q0 + l31) * 768 + h * 96 + 8 * hi;
    bf16x8 qf[6];
#pragma unroll
    for (int kk = 0; kk < 6; ++kk) qf[kk] = *(const bf16x8*)(Qp + 16 * kk);
    const bf16_t* Kn = KVM + (rowb + l31) * 1024 + h * 128 + 8 * hi;
    const bf16_t* Kr = KPE + (rowb + l31) * 32 + 8 * hi;
    const bf16_t* Vp = VT + ((size_t)bh * 64 + l31) * SEQ + 4 * hi;
    const float sc2 = 0.10206207261596577f * 1.4426950408889634f;
    f32x16 o[2];
#pragma unroll
    for (int r = 0; r < 16; ++r) { o[0][r] = 0.f; o[1][r] = 0.f; }
    float mrun = -1e30f, lsum = 0.f;
    bf16x8 kf[6]; u32x2 va[2][2][2];
#define ML_LOAD(S0, KF, VA) do { _Pragma("unroll") for (int kk = 0; kk < 4; ++kk) KF[kk] = *(const bf16x8*)(Kn + (size_t)(S0) * 1024 + 16 * kk); \
        _Pragma("unroll") for (int kk = 0; kk < 2; ++kk) KF[4 + kk] = *(const bf16x8*)(Kr + (size_t)(S0) * 32 + 16 * kk); \
        _Pragma("unroll") for (int dt = 0; dt < 2; ++dt) _Pragma("unroll") for (int ks = 0; ks < 2; ++ks) { VA[dt][ks][0] = *(const u32x2*)(Vp + (size_t)dt * 32 * SEQ + (S0) + 16 * ks); VA[dt][ks][1] = *(const u32x2*)(Vp + (size_t)dt * 32 * SEQ + (S0) + 16 * ks + 8); } } while (0)
    ML_LOAD(0, kf, va);
    for (int s0 = 0; s0 <= q0; s0 += 32) {
        bf16x8 kn[6]; u32x2 vn[2][2][2];
        const int sn = (s0 + 32 <= q0) ? s0 + 32 : s0;
        ML_LOAD(sn, kn, vn);
        f32x16 acc;
#pragma unroll
        for (int r = 0; r < 16; ++r) acc[r] = 0.f;
#pragma unroll
        for (int kk = 0; kk < 6; ++kk) acc = MFMA32(kf[kk], qf[kk], acc);
        const bool diag = (s0 == q0);
        float tmax = -1e30f;
#pragma unroll
        for (int r = 0; r < 16; ++r) { float z = acc[r] * sc2; if (diag && (s0 + crow(r, hi)) > t) z = -1e30f; acc[r] = z; tmax = fmaxf(tmax, z); }
        tmax = fmaxf(tmax, __shfl_xor(tmax, 32));
        const float mn = fmaxf(mrun, tmax), alpha = exp2f(mrun - mn); mrun = mn;
        float ps = 0.f;
#pragma unroll
        for (int r = 0; r < 16; ++r) { acc[r] = exp2f(acc[r] - mn); ps += acc[r]; }
        lsum = lsum * alpha + ps;
#pragma unroll
        for (int r = 0; r < 16; ++r) { o[0][r] *= alpha; o[1][r] *= alpha; }
        bf16x8 pf[2];
#pragma unroll
        for (int ks = 0; ks < 2; ++ks) { v4u w; w.x = cvtpk(acc[8 * ks], acc[8 * ks + 1]); w.y = cvtpk(acc[8 * ks + 2], acc[8 * ks + 3]); w.z = cvtpk(acc[8 * ks + 4], acc[8 * ks + 5]); w.w = cvtpk(acc[8 * ks + 6], acc[8 * ks + 7]); pf[ks] = __builtin_bit_cast(bf16x8, w); }
#pragma unroll
        for (int dt = 0; dt < 2; ++dt)
#pragma unroll
            for (int ks = 0; ks < 2; ++ks) { v4u a; a.x = va[dt][ks][0].x; a.y = va[dt][ks][0].y; a.z = va[dt][ks][1].x; a.w = va[dt][ks][1].y; o[dt] = MFMA32(__builtin_bit_cast(bf16x8, a), pf[ks], o[dt]); }
#pragma unroll
        for (int kk = 0; kk < 6; ++kk) kf[kk] = kn[kk];
#pragma unroll
        for (int dt = 0; dt < 2; ++dt)
#pragma unroll
            for (int ks = 0; ks < 2; ++ks) { va[dt][ks][0] = vn[dt][ks][0]; va[dt][ks][1] = vn[dt][ks][1]; }
    }
#undef ML_LOAD
    lsum += __shfl_xor(lsum, 32);
    store_OT(o, 1.0f / lsum, stg, ymix + (rowb + q0) * DM + 512 + h * 64, lane);
}


__device__ __forceinline__ void sb_wave(int bh, int qblk, int lane, const bf16_t* __restrict__ P1, const bf16_t* __restrict__ VT, bf16_t* __restrict__ ymix, LAS unsigned char* wl) {
    const int b = bh >> 3, h = bh & 7, l31 = lane & 31, hi = lane >> 5, q0 = qblk * 32, t = q0 + l31;
    const size_t rowb = (size_t)b * SEQ;
    bf16x8 qf[4];
    { const bf16_t* Qp = P1 + (rowb + q0 + l31) * L1P + h * 64 + 8 * hi;
#pragma unroll
      for (int kk = 0; kk < 4; ++kk) qf[kk] = *(const bf16x8*)(Qp + 16 * kk); }
    f32x16 o[2];
#pragma unroll
    for (int r = 0; r < 16; ++r) { o[0][r] = 0.f; o[1][r] = 0.f; }
    float cum = 1.f;
    const bf16_t* gK = P1 + (rowb + (lane >> 3)) * L1P + 512 + h * 64 + (lane & 7) * 8;
    const bf16_t* gV = VT + ((size_t)bh * 64 + (lane >> 2)) * SEQ + (lane & 3) * 8;
    const int lK = (lane >> 3) * 144 + (lane & 7) * 16, lV = 4608 + (lane >> 2) * 72 + (lane & 3) * 16;
    v4u rk[4], rv[4];
#pragma unroll
    for (int i = 0; i < 4; ++i) { rk[i] = *(const v4u*)(gK + (size_t)(q0 + 8 * i) * L1P); rv[i] = *(const v4u*)(gV + (size_t)(16 * i) * SEQ + q0); }
#pragma unroll 1
    for (int s0 = q0; s0 >= 0; s0 -= 32) {
#pragma unroll
        for (int i = 0; i < 4; ++i) { *(LAS v4u*)(wl + lK + i * 8 * 144) = rk[i]; *(LAS u32x2*)(wl + lV + i * 16 * 72) = (u32x2){rv[i].x, rv[i].y}; *(LAS u32x2*)(wl + lV + i * 16 * 72 + 8) = (u32x2){rv[i].z, rv[i].w}; }
        { const int sn = (s0 >= 32) ? s0 - 32 : 0;
#pragma unroll
          for (int i = 0; i < 4; ++i) { rk[i] = *(const v4u*)(gK + (size_t)(sn + 8 * i) * L1P); rv[i] = *(const v4u*)(gV + (size_t)(16 * i) * SEQ + sn); } }
        WSYNC();
        f32x16 acc;
#pragma unroll
        for (int r = 0; r < 16; ++r) acc[r] = 0.f;
#pragma unroll
        for (int kk = 0; kk < 4; ++kk) { const bf16x8 kf = *(const LAS bf16x8*)(wl + l31 * 144 + (16 * kk + 8 * hi) * 2); acc = MFMA32(kf, qf[kk], acc); }
        const bool diag = (s0 == q0);
        float bt[16], kp[16];
#pragma unroll
        for (int r = 0; r < 16; ++r) { const float ee = __builtin_amdgcn_exp2f(fminf(acc[r] * (-0.125f * 1.4426950408889634f), 100.f)); const float ri = __builtin_amdgcn_rcpf(1.f + ee);
            float b_ = ri, k_ = ee * ri;
            if (diag) { const bool valid = (s0 + crow(r, hi)) < t; b_ = valid ? b_ : 0.f; k_ = valid ? k_ : 1.f; }
            bt[r] = b_; kp[r] = k_; }
        float e[16], T[4], U[4];
#pragma unroll
        for (int q = 0; q < 4; ++q) { e[4 * q + 3] = 1.f; e[4 * q + 2] = kp[4 * q + 3]; e[4 * q + 1] = e[4 * q + 2] * kp[4 * q + 2]; e[4 * q] = e[4 * q + 1] * kp[4 * q + 1]; T[q] = e[4 * q] * kp[4 * q]; }
#pragma unroll
        for (int q = 0; q < 4; ++q) U[q] = __shfl_xor(T[q], 32);
        { const float st2 = T[3], st1 = st2 * T[2], st0 = st1 * T[1]; const float su2 = U[3], su1 = su2 * U[2], su0 = su1 * U[1];
          const float x0 = hi ? 1.f : U[0], x1 = hi ? 1.f : U[1], x2 = hi ? 1.f : U[2], x3 = hi ? 1.f : U[3];
          const float off[4] = {cum * (st0 * su0 * x0), cum * (st1 * su1 * x1), cum * (st2 * su2 * x2), cum * x3};
#pragma unroll
          for (int r = 0; r < 16; ++r) acc[r] = bt[r] * (off[r >> 2] * e[r]);
          cum *= (st0 * T[0]) * (su0 * U[0]); }
        bf16x8 pf[2];
#pragma unroll
        for (int ks = 0; ks < 2; ++ks) pf[ks] = pack8(acc[8 * ks], acc[8 * ks + 1], acc[8 * ks + 2], acc[8 * ks + 3], acc[8 * ks + 4], acc[8 * ks + 5], acc[8 * ks + 6], acc[8 * ks + 7]);
#pragma unroll
        for (int dt = 0; dt < 2; ++dt)
#pragma unroll
            for (int ks = 0; ks < 2; ++ks) { const LAS unsigned char* vp = wl + 4608 + (32 * dt + l31) * 72 + (16 * ks + 4 * hi) * 2;
                const u32x2 x0 = *(const LAS u32x2*)vp, x1 = *(const LAS u32x2*)(vp + 16);
                v4u a; a.x = x0.x; a.y = x0.y; a.z = x1.x; a.w = x1.y; o[dt] = MFMA32(__builtin_bit_cast(bf16x8, a), pf[ks], o[dt]); }
        WSYNC();
        if (__all(cum < 1e-35f)) break;
    }
    store_OT(o, 1.0f, (LAS bf16_t*)(wl + 9216), ymix + (rowb + q0) * DM + h * 64, lane);
}

constexpr int MLK_PITCH = 104, MLV_PITCH = 68, MLK_BYTES = 64 * MLK_PITCH * 2, MLV_BYTES = 64 * MLV_PITCH * 2, ML_STAGE = MLK_BYTES + MLV_BYTES;
__device__ __forceinline__ void mla_block(int bh, int sb, int tid, int lane, int wave, LAS unsigned char* lds, const bf16_t* __restrict__ QM, const bf16_t* __restrict__ KVM, const bf16_t* __restrict__ KPE,
                                          const bf16_t* __restrict__ VT, bf16_t* __restrict__ ymix) {
    const int b = bh >> 3, h = bh & 7, l31 = lane & 31, hi = lane >> 5, q0 = 256 * sb + 32 * wave, t = q0 + l31;
    const size_t rowb = (size_t)b * SEQ;
    const int nsteps = 4 * sb + 4;
    bf16x8 qf[6];
    { const bf16_t* Qp = QM + (rowb + q0 + l31) * 768 + h * 96 + 8 * hi;
#pragma unroll
      for (int kk = 0; kk < 6; ++kk) qf[kk] = *(const bf16x8*)(Qp + 16 * kk); }
    const float sc2 = 0.10206207261596577f * 1.4426950408889634f;
    f32x16 o[2];
#pragma unroll
    for (int r = 0; r < 16; ++r) { o[0][r] = 0.f; o[1][r] = 0.f; }
    float mrun = -1e30f, lsum = 0.f;
    const bf16_t* gKn = KVM + (rowb + (tid >> 3)) * 1024 + h * 128 + (tid & 7) * 8;
    const bf16_t* gKr = KPE + (rowb + ((tid & 255) >> 2)) * 32 + (tid & 3) * 8;
    const bf16_t* gVt = VT + ((size_t)bh * 64 + (tid >> 3)) * SEQ + (tid & 7) * 8;
    const int lKn = (tid >> 3) * (MLK_PITCH * 2) + (tid & 7) * 16, lKr = ((tid & 255) >> 2) * (MLK_PITCH * 2) + 128 + (tid & 3) * 16, lVt = MLK_BYTES + (tid >> 3) * (MLV_PITCH * 2) + (tid & 7) * 16;
    v4u rk, rr, rv;
    rk = *(const v4u*)gKn; rr = *(const v4u*)gKr; rv = *(const v4u*)gVt;
    *(LAS v4u*)(lds + lKn) = rk; if (tid < 256) *(LAS v4u*)(lds + lKr) = rr; *(LAS u32x2*)(lds + lVt) = (u32x2){rv.x, rv.y}; *(LAS u32x2*)(lds + lVt + 8) = (u32x2){rv.z, rv.w};
    __syncthreads();
#pragma unroll 1
    for (int step = 0; step < nsteps; ++step) {
        const int nx = (step + 1 < nsteps) ? step + 1 : step;
        rk = *(const v4u*)(gKn + (size_t)nx * 64 * 1024); rr = *(const v4u*)(gKr + (size_t)nx * 64 * 32); rv = *(const v4u*)(gVt + nx * 64);
        const LAS unsigned char* Kb = lds + (step & 1) * ML_STAGE;
        const LAS unsigned char* Vb = Kb + MLK_BYTES;
        if (64 * step <= q0) {
            f32x16 acc[2];
#pragma unroll
            for (int sub = 0; sub < 2; ++sub) {
#pragma unroll
                for (int r = 0; r < 16; ++r) acc[sub][r] = 0.f;
#pragma unroll
                for (int kk = 0; kk < 6; ++kk) { const bf16x8 kf = *(const LAS bf16x8*)(Kb + (32 * sub + l31) * (MLK_PITCH * 2) + (16 * kk + 8 * hi) * 2); acc[sub] = MFMA32(kf, qf[kk], acc[sub]); }
            }
            float tmax = -1e30f;
#pragma unroll
            for (int sub = 0; sub < 2; ++sub) { const int s0 = 64 * step + 32 * sub;
                if (s0 + 31 > q0) {
#pragma unroll
                    for (int r = 0; r < 16; ++r) if ((s0 + crow(r, hi)) > t) acc[sub][r] = -1e30f; }
#pragma unroll
                for (int r = 0; r < 16; ++r) tmax = fmaxf(tmax, acc[sub][r]); }
            tmax = fmaxf(tmax, __shfl_xor(tmax, 32)) * sc2;
            if (__any(tmax - mrun > 6.f)) {
                const float mn = fmaxf(mrun, tmax), alpha = __builtin_amdgcn_exp2f(mrun - mn); mrun = mn; lsum *= alpha;
#pragma unroll
                for (int r = 0; r < 16; ++r) { o[0][r] *= alpha; o[1][r] *= alpha; }
            }
            float ps = 0.f;
#pragma unroll
            for (int sub = 0; sub < 2; ++sub)
#pragma unroll
                for (int r = 0; r < 16; ++r) { acc[sub][r] = __builtin_amdgcn_exp2f(acc[sub][r] * sc2 - mrun); ps += acc[sub][r]; }
            lsum += ps;
#pragma unroll
            for (int sub = 0; sub < 2; ++sub) {
                bf16x8 pf[2];
#pragma unroll
                for (int ks = 0; ks < 2; ++ks) pf[ks] = pack8(acc[sub][8 * ks], acc[sub][8 * ks + 1], acc[sub][8 * ks + 2], acc[sub][8 * ks + 3], acc[sub][8 * ks + 4], acc[sub][8 * ks + 5], acc[sub][8 * ks + 6], acc[sub][8 * ks + 7]);
#pragma unroll
                for (int dt = 0; dt < 2; ++dt)
#pragma unroll
                    for (int ks = 0; ks < 2; ++ks) { const LAS unsigned char* vp = Vb + (32 * dt + l31) * (MLV_PITCH * 2) + (32 * sub + 16 * ks + 4 * hi) * 2;
                        const u32x2 x0 = *(const LAS u32x2*)vp, x1 = *(const LAS u32x2*)(vp + 16);
                        v4u a; a.x = x0.x; a.y = x0.y; a.z = x1.x; a.w = x1.y; o[dt] = MFMA32(__builtin_bit_cast(bf16x8, a), pf[ks], o[dt]); }
            }
        }
        LAS unsigned char* nb = lds + ((step + 1) & 1) * ML_STAGE;
        *(LAS v4u*)(nb + lKn) = rk; if (tid < 256) *(LAS v4u*)(nb + lKr) = rr; *(LAS u32x2*)(nb + lVt) = (u32x2){rv.x, rv.y}; *(LAS u32x2*)(nb + lVt + 8) = (u32x2){rv.z, rv.w};
        __syncthreads();
    }
    lsum += __shfl_xor(lsum, 32);
    store_OT(o, 1.0f / lsum, (LAS bf16_t*)(lds + 2 * ML_STAGE) + wave * (32 * STG_PITCH), ymix + (rowb + q0) * DM + 512 + h * 64, lane);
    __syncthreads();
}


constexpr int SBK_PITCH = 72, SBK_BYTES = 64 * SBK_PITCH * 2, SB_STAGE = SBK_BYTES + MLV_BYTES;
__device__ __forceinline__ void sb_block(int bh, int sb, int tid, int lane, int wave, LAS unsigned char* lds, const bf16_t* __restrict__ P1, const bf16_t* __restrict__ VT, bf16_t* __restrict__ ymix) {
    const int b = bh >> 3, h = bh & 7, l31 = lane & 31, hi = lane >> 5, q0 = 256 * sb + 32 * wave, t = q0 + l31;
    const size_t rowb = (size_t)b * SEQ;
    bf16x8 qf[4];
    { const bf16_t* Qp = P1 + (rowb + q0 + l31) * L1P + h * 64 + 8 * hi;
#pragma unroll
      for (int kk = 0; kk < 4; ++kk) qf[kk] = *(const bf16x8*)(Qp + 16 * kk); }
    f32x16 o[2];
#pragma unroll
    for (int r = 0; r < 16; ++r) { o[0][r] = 0.f; o[1][r] = 0.f; }
    float cum = 1.f; bool done = false;
    volatile LAS unsigned* flags = (volatile LAS unsigned*)(lds + 2 * SB_STAGE);
    const bf16_t* gK = P1 + (rowb + (tid >> 3)) * L1P + 512 + h * 64 + (tid & 7) * 8;
    const bf16_t* gVt = VT + ((size_t)bh * 64 + (tid >> 3)) * SEQ + (tid & 7) * 8;
    const int lK = (tid >> 3) * (SBK_PITCH * 2) + (tid & 7) * 16, lVt = SBK_BYTES + (tid >> 3) * (MLV_PITCH * 2) + (tid & 7) * 16;
    const int top = 4 * sb + 3;
    v4u rk, rv;
    rk = *(const v4u*)(gK + (size_t)top * 64 * L1P); rv = *(const v4u*)(gVt + top * 64);
    *(LAS v4u*)(lds + lK) = rk; *(LAS u32x2*)(lds + lVt) = (u32x2){rv.x, rv.y}; *(LAS u32x2*)(lds + lVt + 8) = (u32x2){rv.z, rv.w};
    __syncthreads();
#pragma unroll 1
    for (int i = 0; i <= top; ++i) {
        const int step = top - i, nx = (step > 0) ? step - 1 : 0;
        rk = *(const v4u*)(gK + (size_t)nx * 64 * L1P); rv = *(const v4u*)(gVt + nx * 64);
        const LAS unsigned char* Kb = lds + (i & 1) * SB_STAGE;
        const LAS unsigned char* Vb = Kb + SBK_BYTES;
#pragma unroll
        for (int sub = 1; sub >= 0; --sub) {
            const int s0 = 64 * step + 32 * sub;
            if (s0 <= q0 && !done) {
                f32x16 acc;
#pragma unroll
                for (int r = 0; r < 16; ++r) acc[r] = 0.f;
#pragma unroll
                for (int kk = 0; kk < 4; ++kk) { const bf16x8 kf = *(const LAS bf16x8*)(Kb + (32 * sub + l31) * (SBK_PITCH * 2) + (16 * kk + 8 * hi) * 2); acc = MFMA32(kf, qf[kk], acc); }
                const bool diag = (s0 == q0);
                float bt[16], kp[16];
#pragma unroll
                for (int r = 0; r < 16; ++r) { const float ee = __builtin_amdgcn_exp2f(fminf(acc[r] * (-0.125f * 1.4426950408889634f), 100.f)); const float ri = __builtin_amdgcn_rcpf(1.f + ee);
                    float b_ = ri, k_ = ee * ri;
                    if (diag) { const bool valid = (s0 + crow(r, hi)) < t; b_ = valid ? b_ : 0.f; k_ = valid ? k_ : 1.f; }
                    bt[r] = b_; kp[r] = k_; }
                float e[16], T[4], U[4];
#pragma unroll
                for (int q = 0; q < 4; ++q) { e[4 * q + 3] = 1.f; e[4 * q + 2] = kp[4 * q + 3]; e[4 * q + 1] = e[4 * q + 2] * kp[4 * q + 2]; e[4 * q] = e[4 * q + 1] * kp[4 * q + 1]; T[q] = e[4 * q] * kp[4 * q]; }
#pragma unroll
                for (int q = 0; q < 4; ++q) U[q] = __shfl_xor(T[q], 32);
                { const float st2 = T[3], st1 = st2 * T[2], st0 = st1 * T[1]; const float su2 = U[3], su1 = su2 * U[2], su0 = su1 * U[1];
                  const float x0 = hi ? 1.f : U[0], x1 = hi ? 1.f : U[1], x2 = hi ? 1.f : U[2], x3 = hi ? 1.f : U[3];
                  const float off[4] = {cum * (st0 * su0 * x0), cum * (st1 * su1 * x1), cum * (st2 * su2 * x2), cum * x3};
#pragma unroll
                  for (int r = 0; r < 16; ++r) acc[r] = bt[r] * (off[r >> 2] * e[r]);
                  cum *= (st0 * T[0]) * (su0 * U[0]); }
                bf16x8 pf[2];
#pragma unroll
                for (int ks = 0; ks < 2; ++ks) { v4u w; w.x = cvtpk(acc[8 * ks], acc[8 * ks + 1]); w.y = cvtpk(acc[8 * ks + 2], acc[8 * ks + 3]); w.z = cvtpk(acc[8 * ks + 4], acc[8 * ks + 5]); w.w = cvtpk(acc[8 * ks + 6], acc[8 * ks + 7]); pf[ks] = __builtin_bit_cast(bf16x8, w); }
#pragma unroll
                for (int dt = 0; dt < 2; ++dt)
#pragma unroll
                    for (int ks = 0; ks < 2; ++ks) { const LAS unsigned char* vp = Vb + (32 * dt + l31) * (MLV_PITCH * 2) + (32 * sub + 16 * ks + 4 * hi) * 2;
                        const u32x2 x0 = *(const LAS u32x2*)vp, x1 = *(const LAS u32x2*)(vp + 16);
                        v4u a; a.x = x0.x; a.y = x0.y; a.z = x1.x; a.w = x1.y; o[dt] = MFMA32(__builtin_bit_cast(bf16x8, a), pf[ks], o[dt]); }
                done = __all(cum < 1e-35f);
            }
        }
        if (lane == 0) flags[(i & 1) * 8 + wave] = done ? 1u : 0u;
        LAS unsigned char* nb = lds + ((i + 1) & 1) * SB_STAGE;
        *(LAS v4u*)(nb + lK) = rk; *(LAS u32x2*)(nb + lVt) = (u32x2){rv.x, rv.y}; *(LAS u32x2*)(nb + lVt + 8) = (u32x2){rv.z, rv.w};
        __syncthreads();
        unsigned nd = 0;
#pragma unroll
        for (int w8 = 0; w8 < 8; ++w8) nd += flags[(i & 1) * 8 + w8];
        if (nd == 8u) break;
    }
    store_OT(o, 1.0f, (LAS bf16_t*)(lds + 2 * SB_STAGE + 256) + wave * (32 * STG_PITCH), ymix + (rowb + q0) * DM + h * 64, lane);
    __syncthreads();
}

constexpr int RW_RAWW = 0, RW_RAWA = 2048, RW_RS = 4096, RW_KS = 6144, RW_VS = 8192;
constexpr int RW_CH0 = 10240, RW_CHSZ = 11328;
constexpr int RW_YB = RW_CH0 + 2 * RW_CHSZ;
constexpr int RW_MIX = RW_YB + 1024;
static_assert((RW_MIX + 256) * 4 <= 146432, "rwkv LDS map");
__device__ __forceinline__ float tanh_fast(float x) { return 1.f - 2.f * __builtin_amdgcn_rcpf(1.f + __expf(2.f * x)); }
__device__ __forceinline__ float sigmoid_fast(float x) { return __builtin_amdgcn_rcpf(1.f + __expf(-x)); }

#define MFMA16(a, b, c) __builtin_amdgcn_mfma_f32_16x16x32_bf16((a), (b), (c), 0, 0, 0)
constexpr int RW2_CH0 = 0, RW2_YB = 2 * RW_CHSZ, RW2_MIX = RW2_YB + 1024, RW2_STG = RW2_MIX + 448;
static_assert((RW2_STG + 2 * 3072) * 4 <= 146432, "rwkv LDS map");
__device__ __forceinline__ void rwkv_phase_scan(LAS float* sm, int tid, int lane, int wave, int blk, const bf16_t* __restrict__ proj, const float* __restrict__ mix, const float* __restrict__ w0, const float* __restrict__ a0,
                                           const float* __restrict__ k_k, const float* __restrict__ k_a, const float* __restrict__ r_k, const bf16_t* __restrict__ W2T, const bf16_t* __restrict__ A2T, const bf16_t* __restrict__ G2T,
                                           float* __restrict__ yraw, bf16_t* __restrict__ gout, float* __restrict__ bonus_out) {
    const int chain = blk >> 1, half = blk & 1, b = chain >> 3, h = chain & 7, l15 = lane & 15, kg = lane >> 4;
    const size_t rowb = (size_t)b * SEQ;
    constexpr int NCHUNK = SEQ / 32;
    if (tid < 256) sm[RW2_MIX + tid] = mix[1536 + tid];
    else if (tid < 448) { const int q = tid - 256; sm[RW2_MIX + tid] = mix[512 * (q >> 6) + h * 64 + (q & 63)]; }
    __syncthreads();
#define RW_SH8(CUR, PRV, M0, M1, OUT, PZ) do { const unsigned cu_[4] = {(CUR).x, (CUR).y, (CUR).z, (CUR).w}, pu_[4] = {(PRV).x, (PRV).y, (PRV).z, (PRV).w}; \
        const float mm_[8] = {(M0)[0], (M0)[1], (M0)[2], (M0)[3], (M1)[0], (M1)[1], (M1)[2], (M1)[3]}; \
        _Pragma("unroll") for (int q = 0; q < 4; ++q) { const float c0 = bflo(cu_[q]), c1 = bfhi(cu_[q]), p0 = bflo(pu_[q]) * (PZ), p1 = bfhi(pu_[q]) * (PZ); \
            OUT[2 * q] = c0 + (p0 - c0) * mm_[2 * q]; OUT[2 * q + 1] = c1 + (p1 - c1) * mm_[2 * q + 1]; } } while (0)
    if (wave < 4) {
        const int iA = 8 * wave + kg, iB = iA + 4, jseg = l15;
        float A0 = 0.f, A1 = 0.f, A2 = 0.f, A3 = 0.f, B0 = 0.f, B1 = 0.f, B2 = 0.f, B3 = 0.f;
        __syncthreads();
#pragma unroll 1
        for (int ch = 0; ch < NCHUNK; ++ch) {
            const int t0 = ch * 32;
            const LAS float* CHb = sm + RW2_CH0 + (ch & 1) * RW_CHSZ + 4 * jseg;
            const LAS float* CHv = sm + RW2_CH0 + (ch & 1) * RW_CHSZ + 10240 + iA;
            const LAS float* CHs = sm + RW2_CH0 + (ch & 1) * RW_CHSZ + 11264;
            f32x4 a4 = *(const LAS f32x4*)(CHb + 4096), wr4 = *(const LAS f32x4*)(CHb + 8192), w4 = *(const LAS f32x4*)(CHb), b4 = *(const LAS f32x4*)(CHb + 6144), k4 = *(const LAS f32x4*)(CHb + 2048);
            float vA = CHv[0], vB = CHv[4]; f32x2_t sc = *(const LAS f32x2_t*)(CHs);
#pragma unroll 2
            for (int t = 0; t < 32; ++t) {
                const int tq = (t + 1) & 31;
                const f32x4 a4n = *(const LAS f32x4*)(CHb + 4096 + tq * 64), wr4n = *(const LAS f32x4*)(CHb + 8192 + tq * 64), w4n = *(const LAS f32x4*)(CHb + tq * 64),
                            b4n = *(const LAS f32x4*)(CHb + 6144 + tq * 64), k4n = *(const LAS f32x4*)(CHb + 2048 + tq * 64);
                const float vAn = CHv[tq * 32], vBn = CHv[tq * 32 + 4]; const f32x2_t scn = *(const LAS f32x2_t*)(CHs + 2 * tq);
                float d1A = (A0 * a4[0] + A1 * a4[1]) + (A2 * a4[2] + A3 * a4[3]), d1B = (B0 * a4[0] + B1 * a4[1]) + (B2 * a4[2] + B3 * a4[3]);
                float d2A = (A0 * wr4[0] + A1 * wr4[1]) + (A2 * wr4[2] + A3 * wr4[3]), d2B = (B0 * wr4[0] + B1 * wr4[1]) + (B2 * wr4[2] + B3 * wr4[3]);
                d1A = rowsum16(d1A); d1B = rowsum16(d1B); d2A = rowsum16(d2A); d2B = rowsum16(d2B);
                const float yA = d2A + d1A * sc[0] + vA * sc[1], yB = d2B + d1B * sc[0] + vB * sc[1];
                A0 = A0 * w4[0] + (d1A * b4[0] + vA * k4[0]); A1 = A1 * w4[1] + (d1A * b4[1] + vA * k4[1]); A2 = A2 * w4[2] + (d1A * b4[2] + vA * k4[2]); A3 = A3 * w4[3] + (d1A * b4[3] + vA * k4[3]);
                B0 = B0 * w4[0] + (d1B * b4[0] + vB * k4[0]); B1 = B1 * w4[1] + (d1B * b4[1] + vB * k4[1]); B2 = B2 * w4[2] + (d1B * b4[2] + vB * k4[2]); B3 = B3 * w4[3] + (d1B * b4[3] + vB * k4[3]);
                if (jseg == 0) { sm[RW2_YB + t * 32 + iA] = yA; sm[RW2_YB + t * 32 + iB] = yB; }
                a4 = a4n; wr4 = wr4n; w4 = w4n; b4 = b4n; k4 = k4n; vA = vAn; vB = vBn; sc = scn;
            }
            WSYNC();
            { const int tt = lane >> 1, hh = lane & 1; const f32x4 yv = *(const LAS f32x4*)(sm + RW2_YB + tt * 32 + 8 * wave + 4 * hh);
              *(f32x4*)(yraw + (rowb + t0 + tt) * 512 + h * 64 + half * 32 + 8 * wave + 4 * hh) = yv; }
            __syncthreads();
        }
    } else if (wave < 6) {
        const int tp = wave - 4, tb = 16 * tp;
        LAS float* stg = sm + RW2_STG + tp * 3072;
        float w0c[4], a0c[4], kkc[4], kac[4], rkc[4];
#pragma unroll
        for (int nt = 0; nt < 4; ++nt) { const int c = h * 64 + 16 * nt + l15; w0c[nt] = w0[c]; a0c[nt] = a0[c]; kkc[nt] = k_k[c]; kac[nt] = k_a[c]; rkc[nt] = r_k[c]; }
        v4u ld[20];
#define PREP_ISSUE(T0) do { const int t0_ = (T0); { const size_t r_ = rowb + t0_ + tb + l15; const size_t rp_ = (t0_ + tb + l15 == 0) ? r_ : r_ - 1; \
            _Pragma("unroll") for (int lo = 0; lo < 2; ++lo) _Pragma("unroll") for (int ks = 0; ks < 2; ++ks) { const int col = 1536 + 64 * lo + 32 * ks + 8 * kg; \
                ld[(lo * 2 + ks) * 2] = *(const v4u*)(proj + r_ * L0P + col); ld[(lo * 2 + ks) * 2 + 1] = *(const v4u*)(proj + rp_ * L0P + col); } } \
            _Pragma("unroll") for (int ar = 0; ar < 3; ++ar) _Pragma("unroll") for (int i = 0; i < 2; ++i) { const int p_ = lane + 64 * i, row_ = p_ >> 3, c8_ = p_ & 7; \
                const size_t r_ = rowb + t0_ + tb + row_; const size_t rp_ = (t0_ + tb + row_ == 0) ? r_ : r_ - 1; const int col = 512 * ar + h * 64 + 8 * c8_; \
                ld[8 + (ar * 2 + i) * 2] = *(const v4u*)(proj + r_ * L0P + col); ld[8 + (ar * 2 + i) * 2 + 1] = *(const v4u*)(proj + rp_ * L0P + col); } } while (0)
#define PREP_BUILD(T0, NB) do { const int t0_ = (T0); LAS float* CHn = sm + RW2_CH0 + (NB) * RW_CHSZ; \
            f32x4 accw[4], acca[4]; \
            _Pragma("unroll") for (int nt = 0; nt < 4; ++nt) { accw[nt] = (f32x4){0.f, 0.f, 0.f, 0.f}; acca[nt] = (f32x4){0.f, 0.f, 0.f, 0.f}; } \
            { const float pz_ = (t0_ + tb + l15 == 0) ? 0.f : 1.f; \
              _Pragma("unroll") for (int lo = 0; lo < 2; ++lo) _Pragma("unroll") for (int ks = 0; ks < 2; ++ks) { float s_[8]; \
                const f32x4 m0 = *(const LAS f32x4*)(sm + RW2_MIX + 64 * lo + 32 * ks + 8 * kg), m1 = *(const LAS f32x4*)(sm + RW2_MIX + 64 * lo + 32 * ks + 8 * kg + 4); \
                RW_SH8(ld[(lo * 2 + ks) * 2], ld[(lo * 2 + ks) * 2 + 1], m0, m1, s_, pz_); \
                if (lo == 0) { _Pragma("unroll") for (int j = 0; j < 8; ++j) s_[j] = tanh_fast(s_[j]); } \
                v4u aw; aw.x = cvtpk(s_[0], s_[1]); aw.y = cvtpk(s_[2], s_[3]); aw.z = cvtpk(s_[4], s_[5]); aw.w = cvtpk(s_[6], s_[7]); const bf16x8 af = __builtin_bit_cast(bf16x8, aw); \
                const bf16_t* WT = lo ? A2T : W2T; \
                _Pragma("unroll") for (int nt = 0; nt < 4; ++nt) { const bf16x8 bfr = *(const bf16x8*)(WT + (size_t)(h * 64 + 16 * nt + l15) * 64 + 32 * ks + 8 * kg); \
                    if (lo == 0) accw[nt] = MFMA16(af, bfr, accw[nt]); else acca[nt] = MFMA16(af, bfr, acca[nt]); } } } \
            _Pragma("unroll") for (int ar = 0; ar < 3; ++ar) _Pragma("unroll") for (int i = 0; i < 2; ++i) { const int p_ = lane + 64 * i, row_ = p_ >> 3, c8_ = p_ & 7; float s_[8]; \
                const float pz_ = (t0_ + tb + row_ == 0) ? 0.f : 1.f; const f32x4 m0 = *(const LAS f32x4*)(sm + RW2_MIX + 256 + ar * 64 + c8_ * 8), m1 = *(const LAS f32x4*)(sm + RW2_MIX + 256 + ar * 64 + c8_ * 8 + 4); \
                RW_SH8(ld[8 + (ar * 2 + i) * 2], ld[8 + (ar * 2 + i) * 2 + 1], m0, m1, s_, pz_); \
                *(LAS f32x4*)(stg + ar * 1024 + row_ * 64 + c8_ * 8) = (f32x4){s_[0], s_[1], s_[2], s_[3]}; *(LAS f32x4*)(stg + ar * 1024 + row_ * 64 + c8_ * 8 + 4) = (f32x4){s_[4], s_[5], s_[6], s_[7]}; } \
            WSYNC(); \
            PREP_ISSUE(((T0) + 32 < SEQ) ? (T0) + 32 : (T0)); \
            _Pragma("unroll") for (int rg = 0; rg < 4; ++rg) { const int tl = 4 * kg + rg, t = tb + tl; \
                float r_[4], k_[4], v_[4], kkv[4], nrm2 = 0.f; \
                _Pragma("unroll") for (int nt = 0; nt < 4; ++nt) { r_[nt] = stg[tl * 64 + 16 * nt + l15]; k_[nt] = stg[1024 + tl * 64 + 16 * nt + l15]; v_[nt] = stg[2048 + tl * 64 + 16 * nt + l15]; \
                    kkv[nt] = k_[nt] * kkc[nt]; nrm2 += kkv[nt] * kkv[nt]; } \
                nrm2 = rowsum16(nrm2); const float rn = __builtin_amdgcn_rsqf(fmaxf(nrm2, 1e-24f)); \
                float br = 0.f, kr = 0.f, bon = 0.f; \
                _Pragma("unroll") for (int nt = 0; nt < 4; ++nt) { const int j = 16 * nt + l15; \
                    const float wsum = w0c[nt] + accw[nt][rg]; const float logw = -softplus_fast(-wsum) - 0.5f; const float dec = __expf(-__expf(logw)); \
                    const float a_ = sigmoid_fast(a0c[nt] + acca[nt][rg]); const float kn = kkv[nt] * rn; \
                    const float k2 = k_[nt] * (1.f + (a_ - 1.f) * kac[nt]); const float bv = kn * a_; \
                    br += bv * r_[nt]; kr += k2 * r_[nt]; bon += r_[nt] * k2 * rkc[nt]; \
                    CHn[t * 64 + j] = dec; CHn[2048 + t * 64 + j] = k2; CHn[4096 + t * 64 + j] = -kn; CHn[6144 + t * 64 + j] = bv; CHn[8192 + t * 64 + j] = dec * r_[nt]; \
                    if ((nt >> 1) == half) CHn[10240 + t * 32 + (j & 31)] = v_[nt]; } \
                br = rowsum16(br); kr = rowsum16(kr); bon = rowsum16(bon); \
                if (l15 == 0) { CHn[11264 + 2 * t] = br; CHn[11264 + 2 * t + 1] = kr; if (half == 0) bonus_out[(rowb + t0_ + t) * 8 + h] = bon; } } \
            WSYNC(); } while (0)
        PREP_ISSUE(0);
        PREP_BUILD(0, 0);
        __syncthreads();
#pragma unroll 1
        for (int ch = 0; ch < NCHUNK; ++ch) {
            if (ch + 1 < NCHUNK) PREP_BUILD(ch * 32 + 32, (ch + 1) & 1);
            __syncthreads();
        }
#undef PREP_ISSUE
#undef PREP_BUILD
    } else {
        const int tp = wave - 6, tb = 16 * tp;
        v4u ld[8];
#define G_ISSUE(T0) do { const int t0_ = (T0); const size_t r_ = rowb + t0_ + tb + l15; const size_t rp_ = (t0_ + tb + l15 == 0) ? r_ : r_ - 1; \
            _Pragma("unroll") for (int ks = 0; ks < 4; ++ks) { const int col = 1664 + 32 * ks + 8 * kg; ld[2 * ks] = *(const v4u*)(proj + r_ * L0P + col); ld[2 * ks + 1] = *(const v4u*)(proj + rp_ * L0P + col); } } while (0)
#define G_BUILD(T0) do { const int t0_ = (T0); f32x4 accg[2] = {(f32x4){0.f, 0.f, 0.f, 0.f}, (f32x4){0.f, 0.f, 0.f, 0.f}}; const float pz_ = (t0_ + tb + l15 == 0) ? 0.f : 1.f; \
            _Pragma("unroll") for (int ks = 0; ks < 4; ++ks) { float s_[8]; \
                const f32x4 m0 = *(const LAS f32x4*)(sm + RW2_MIX + 128 + 32 * ks + 8 * kg), m1 = *(const LAS f32x4*)(sm + RW2_MIX + 128 + 32 * ks + 8 * kg + 4); \
                RW_SH8(ld[2 * ks], ld[2 * ks + 1], m0, m1, s_, pz_); \
                _Pragma("unroll") for (int j = 0; j < 8; ++j) s_[j] = sigmoid_fast(s_[j]); \
                v4u aw; aw.x = cvtpk(s_[0], s_[1]); aw.y = cvtpk(s_[2], s_[3]); aw.z = cvtpk(s_[4], s_[5]); aw.w = cvtpk(s_[6], s_[7]); const bf16x8 af = __builtin_bit_cast(bf16x8, aw); \
                _Pragma("unroll") for (int nt = 0; nt < 2; ++nt) { const bf16x8 bfr = *(const bf16x8*)(G2T + (size_t)(h * 64 + half * 32 + 16 * nt + l15) * 128 + 32 * ks + 8 * kg); accg[nt] = MFMA16(af, bfr, accg[nt]); } } \
            G_ISSUE(((T0) + 32 < SEQ) ? (T0) + 32 : (T0)); \
            _Pragma("unroll") for (int nt = 0; nt < 2; ++nt) _Pragma("unroll") for (int rg = 0; rg < 4; ++rg) \
                gout[(rowb + t0_ + tb + 4 * kg + rg) * 512 + h * 64 + half * 32 + 16 * nt + l15] = (bf16_t)f2bf(accg[nt][rg]); } while (0)
        G_ISSUE(0);
        G_BUILD(0);
        __syncthreads();
#pragma unroll 1
        for (int ch = 0; ch < NCHUNK; ++ch) {
            if (ch + 1 < NCHUNK) G_BUILD(ch * 32 + 32);
            __syncthreads();
        }
#undef G_ISSUE
#undef G_BUILD
    }
#undef RW_SH8
    __syncthreads();
}

constexpr int CK_BK = 0, CK_AR = 4608, CK_BBT = 9216, CK_KBT = 12288, CK_VT = 15360, CK_GC = 16896, CK_TT = 17152, CK_SLOT = 18688, CK_NSLOT = 6, CK_NBUILD = 5;
constexpr int CK_STG = CK_SLOT * CK_NSLOT;
constexpr int CK_MIX = CK_STG + CK_NBUILD * 6144;
constexpr int CK_FLAGS = CK_MIX + 448 * 4;
static_assert(CK_FLAGS + 64 <= 146432, "rwkv chunked LDS map");
__device__ __forceinline__ void rwkv_phase(LAS float* smf, int tid, int lane, int wave, int blk, const bf16_t* __restrict__ proj, const float* __restrict__ mix, const float* __restrict__ w0, const float* __restrict__ a0,
                                           const float* __restrict__ k_k, const float* __restrict__ k_a, const float* __restrict__ r_k, const bf16_t* __restrict__ W2T, const bf16_t* __restrict__ A2T, const bf16_t* __restrict__ G2T,
                                           float* __restrict__ yraw, bf16_t* __restrict__ gout, float* __restrict__ bonus_out) {
    LAS unsigned char* lds = (LAS unsigned char*)smf;
    LAS float* mixs = (LAS float*)(lds + CK_MIX);
    volatile LAS unsigned* flags = (volatile LAS unsigned*)(lds + CK_FLAGS);
    const int chain = blk >> 1, ihalf = blk & 1, b = chain >> 3, h = chain & 7, l15 = lane & 15, kg = lane >> 4, l31 = lane & 31, hi = lane >> 5;
    const size_t rowb = (size_t)b * SEQ;
    constexpr int NCH = SEQ / 16;
    if (tid < 256) mixs[tid] = mix[1536 + tid];
    else if (tid < 448) { const int q = tid - 256; mixs[tid] = mix[512 * (q >> 6) + h * 64 + (q & 63)]; }
    if (tid < 16) flags[tid] = (tid == 9) ? (unsigned)CK_NBUILD : 0u;
    for (int q = tid; q < CK_NSLOT * 384; q += NWAVES * 64) *(LAS unsigned*)(lds + (q / 384) * CK_SLOT + CK_TT + (q % 384) * 4) = 0u;
    __syncthreads();
#define RW_SH8(CUR, PRV, M0, M1, OUT, PZ) do { const unsigned cu_[4] = {(CUR).x, (CUR).y, (CUR).z, (CUR).w}, pu_[4] = {(PRV).x, (PRV).y, (PRV).z, (PRV).w}; \
        const float mm_[8] = {(M0)[0], (M0)[1], (M0)[2], (M0)[3], (M1)[0], (M1)[1], (M1)[2], (M1)[3]}; \
        _Pragma("unroll") for (int q = 0; q < 4; ++q) { const float c0 = bflo(cu_[q]), c1 = bfhi(cu_[q]), p0 = bflo(pu_[q]) * (PZ), p1 = bfhi(pu_[q]) * (PZ); \
            OUT[2 * q] = c0 + (p0 - c0) * mm_[2 * q]; OUT[2 * q + 1] = c1 + (p1 - c1) * mm_[2 * q + 1]; } } while (0)
    if (wave == 0) {
        f32x16 ST[2];
#pragma unroll
        for (int r = 0; r < 16; ++r) { ST[0][r] = 0.f; ST[1][r] = 0.f; }
#pragma unroll 1
        for (int k = 0; k < NCH; ++k) {
#if defined(PROBE_STAMPS)
            const unsigned tw0_ = (unsigned)__builtin_amdgcn_s_memrealtime();
#endif
            { const unsigned want = (unsigned)(k + 1); const int sl = k % CK_NSLOT; while (flags[sl] != want) __builtin_amdgcn_s_sleep(1); }
#if defined(PROBE_STAMPS)
            if (blk == 0 && lane == 0) ((volatile LAS unsigned*)(lds + 146432 + 320))[16 + 24] += (unsigned)__builtin_amdgcn_s_memrealtime() - tw0_;
#endif
            asm volatile("" ::: "memory");
            const LAS unsigned char* im = lds + (k % CK_NSLOT) * CK_SLOT;
            f32x16 G;
#pragma unroll
            for (int r = 0; r < 16; ++r) G[r] = 0.f;
#pragma unroll
            for (int kk = 0; kk < 4; ++kk) { const bf16x8 fa = *(const LAS bf16x8*)(im + CK_BK + l31 * 144 + (16 * kk + 8 * hi) * 2), fb = *(const LAS bf16x8*)(im + CK_AR + l31 * 144 + (16 * kk + 8 * hi) * 2); G = MFMA32(fa, fb, G); }
            { const int tcol = l31 & 15; const bool strict = l31 < 16;
#pragma unroll
              for (int r = 0; r < 16; ++r) { const int srow = crow(r & 7, hi); const bool keep = strict ? (srow < tcol) : (srow <= tcol); G[r] = keep ? G[r] : 0.f; } }
            const bf16x8 gB = pack8(G[0], G[1], G[2], G[3], G[4], G[5], G[6], G[7]), gK = pack8(G[8], G[9], G[10], G[11], G[12], G[13], G[14], G[15]);
            f32x16 XT;
#pragma unroll
            for (int r = 0; r < 16; ++r) XT[r] = 0.f;
#pragma unroll
            for (int jt = 0; jt < 2; ++jt)
#pragma unroll
                for (int sp = 0; sp < 2; ++sp) { const LAS unsigned char* ap = im + CK_AR + l31 * 144 + (32 * jt + 16 * sp + 4 * hi) * 2;
                    const u32x2 x0 = *(const LAS u32x2*)ap, x1 = *(const LAS u32x2*)(ap + 16); v4u aw; aw.x = x0.x; aw.y = x0.y; aw.z = x1.x; aw.w = x1.y;
                    const bf16x8 sb_ = pack8(ST[jt][8 * sp], ST[jt][8 * sp + 1], ST[jt][8 * sp + 2], ST[jt][8 * sp + 3], ST[jt][8 * sp + 4], ST[jt][8 * sp + 5], ST[jt][8 * sp + 6], ST[jt][8 * sp + 7]);
                    XT = MFMA32(__builtin_bit_cast(bf16x8, aw), sb_, XT); }
            bf16x8 vP;
            { const LAS unsigned char* vp = im + CK_VT + l31 * 48 + (4 * hi) * 2; const u32x2 x0 = *(const LAS u32x2*)vp, x1 = *(const LAS u32x2*)(vp + 16); v4u vw; vw.x = x0.x; vw.y = x0.y; vw.z = x1.x; vw.w = x1.y;
              vP = __builtin_bit_cast(bf16x8, vw); XT = MFMA32(gK, vP, XT); }
            bf16x8 uP;
            { const LAS unsigned char* tp = im + CK_TT + l31 * 48 + (4 * hi) * 2; const u32x2 x0 = *(const LAS u32x2*)tp, x1 = *(const LAS u32x2*)(tp + 16); v4u tw; tw.x = x0.x; tw.y = x0.y; tw.z = x1.x; tw.w = x1.y;
              f32x16 UT;
#pragma unroll
              for (int r = 0; r < 16; ++r) UT[r] = 0.f;
              UT = MFMA32(__builtin_bit_cast(bf16x8, tw), pack8(XT[0], XT[1], XT[2], XT[3], XT[4], XT[5], XT[6], XT[7]), UT);
              uP = pack8(UT[0], UT[1], UT[2], UT[3], UT[4], UT[5], UT[6], UT[7]); }
            XT = MFMA32(gB, uP, XT);
            { float* yp = yraw + (rowb + 16 * k) * 512 + h * 64 + 32 * ihalf + l31;
#pragma unroll
              for (int q = 0; q < 8; ++q) yp[(size_t)crow(q, hi) * 512] = XT[8 + q]; }
            { const LAS float* gc = (const LAS float*)(im + CK_GC);
#pragma unroll
              for (int jt = 0; jt < 2; ++jt)
#pragma unroll
                  for (int r = 0; r < 16; ++r) ST[jt][r] *= gc[32 * jt + crow(r, hi)]; }
#pragma unroll
            for (int jt = 0; jt < 2; ++jt) { const LAS unsigned char* bp = im + CK_BBT + (32 * jt + l31) * 48 + (4 * hi) * 2; const LAS unsigned char* kp = im + CK_KBT + (32 * jt + l31) * 48 + (4 * hi) * 2;
                const u32x2 b0 = *(const LAS u32x2*)bp, b1 = *(const LAS u32x2*)(bp + 16), k0 = *(const LAS u32x2*)kp, k1 = *(const LAS u32x2*)(kp + 16);
                v4u a1; a1.x = b0.x; a1.y = b0.y; a1.z = b1.x; a1.w = b1.y; v4u a2; a2.x = k0.x; a2.y = k0.y; a2.z = k1.x; a2.w = k1.y;
                ST[jt] = MFMA32(__builtin_bit_cast(bf16x8, a1), uP, ST[jt]); ST[jt] = MFMA32(__builtin_bit_cast(bf16x8, a2), vP, ST[jt]); }
            WSYNC();
            if (lane == 0) flags[8] = (unsigned)(k + 1);
        }
    } else if (wave <= CK_NBUILD) {
        const int pw = wave - 1;
        LAS bf16_t* stg = (LAS bf16_t*)(lds + CK_STG) + pw * 3072;
        float w0c[4], a0c[4], kkc[4], kac[4], rkc[4];
#pragma unroll
        for (int nt = 0; nt < 4; ++nt) { const int c = h * 64 + 16 * nt + l15; w0c[nt] = w0[c]; a0c[nt] = a0[c]; kkc[nt] = k_k[c]; kac[nt] = k_a[c]; rkc[nt] = r_k[c]; }
        v4u ld[20];
#define CK_ISSUE_A(T0) do { const int t0_ = (T0); const size_t r_ = rowb + t0_ + l15; const size_t rp_ = (t0_ + l15 == 0) ? r_ : r_ - 1; \
            _Pragma("unroll") for (int lo = 0; lo < 2; ++lo) _Pragma("unroll") for (int ks = 0; ks < 2; ++ks) { const int col = 1536 + 64 * lo + 32 * ks + 8 * kg; \
                ld[(lo * 2 + ks) * 2] = *(const v4u*)(proj + r_ * L0P + col); ld[(lo * 2 + ks) * 2 + 1] = *(const v4u*)(proj + rp_ * L0P + col); } } while (0)
#define CK_ISSUE_B(T0) do { const int t0_ = (T0); \
            _Pragma("unroll") for (int ar = 0; ar < 3; ++ar) _Pragma("unroll") for (int i = 0; i < 2; ++i) { const int p_ = lane + 64 * i, row_ = p_ >> 3, c8_ = p_ & 7; \
                const size_t r_ = rowb + t0_ + row_; const size_t rp_ = (t0_ + row_ == 0) ? r_ : r_ - 1; const int col = 512 * ar + h * 64 + 8 * c8_; \
                ld[8 + (ar * 2 + i) * 2] = *(const v4u*)(proj + r_ * L0P + col); ld[8 + (ar * 2 + i) * 2 + 1] = *(const v4u*)(proj + rp_ * L0P + col); } } while (0)
#define CK_ISSUE(T0) do { CK_ISSUE_A(T0); CK_ISSUE_B(T0); } while (0)
        CK_ISSUE(16 * pw);
        int k = pw;
#pragma unroll 1
        while (k < NCH) {
            const int t0 = 16 * k; int kn;
#if defined(PROBE_STAMPS)
            const unsigned ts0_ = (unsigned)__builtin_amdgcn_s_memrealtime();
#endif
            f32x4 accw[4], acca[4];
#pragma unroll
            for (int nt = 0; nt < 4; ++nt) { accw[nt] = (f32x4){0.f, 0.f, 0.f, 0.f}; acca[nt] = (f32x4){0.f, 0.f, 0.f, 0.f}; }
            { const float pz_ = (t0 + l15 == 0) ? 0.f : 1.f;
#pragma unroll
              for (int lo = 0; lo < 2; ++lo)
#pragma unroll
                for (int ks = 0; ks < 2; ++ks) { float s_[8];
                    const f32x4 m0 = *(const LAS f32x4*)(mixs + 64 * lo + 32 * ks + 8 * kg), m1 = *(const LAS f32x4*)(mixs + 64 * lo + 32 * ks + 8 * kg + 4);
                    RW_SH8(ld[(lo * 2 + ks) * 2], ld[(lo * 2 + ks) * 2 + 1], m0, m1, s_, pz_);
                    if (lo == 0) {
#pragma unroll
                        for (int j = 0; j < 8; ++j) s_[j] = tanh_fast(s_[j]); }
                    const bf16x8 af = pack8(s_[0], s_[1], s_[2], s_[3], s_[4], s_[5], s_[6], s_[7]);
                    const bf16_t* WT = lo ? A2T : W2T;
#pragma unroll
                    for (int nt = 0; nt < 4; ++nt) { const bf16x8 bfr = *(const bf16x8*)(WT + (size_t)(h * 64 + 16 * nt + l15) * 64 + 32 * ks + 8 * kg);
                        if (lo == 0) accw[nt] = MFMA16(af, bfr, accw[nt]); else acca[nt] = MFMA16(af, bfr, acca[nt]); } } }
#pragma unroll
            for (int ar = 0; ar < 3; ++ar)
#pragma unroll
                for (int i = 0; i < 2; ++i) { const int p_ = lane + 64 * i, row_ = p_ >> 3, c8_ = p_ & 7; float s_[8];
                    const float pz_ = (t0 + row_ == 0) ? 0.f : 1.f; const f32x4 m0 = *(const LAS f32x4*)(mixs + 256 + ar * 64 + c8_ * 8), m1 = *(const LAS f32x4*)(mixs + 256 + ar * 64 + c8_ * 8 + 4);
                    RW_SH8(ld[8 + (ar * 2 + i) * 2], ld[8 + (ar * 2 + i) * 2 + 1], m0, m1, s_, pz_);
                    *(LAS bf16x8*)(stg + ar * 1024 + row_ * 64 + c8_ * 8) = pack8(s_[0], s_[1], s_[2], s_[3], s_[4], s_[5], s_[6], s_[7]); }
            WSYNC();
#if defined(PROBE_STAMPS)
            if (blk == 0 && wave == 1 && lane == 0) ((volatile LAS unsigned*)(lds + 146432 + 320))[16 + 26] += (unsigned)__builtin_amdgcn_s_memrealtime() - ts0_;
#endif
#if defined(PROBE_STAMPS)
            const unsigned tb0_ = (unsigned)__builtin_amdgcn_s_memrealtime();
#endif
            { const int need = k - (CK_NSLOT - 1); if (need > 0) { while ((int)flags[8] < need) __builtin_amdgcn_s_sleep(2); } }
#if defined(PROBE_STAMPS)
            if (blk == 0 && wave == 1 && lane == 0) ((volatile LAS unsigned*)(lds + 146432 + 320))[16 + 25] += (unsigned)__builtin_amdgcn_s_memrealtime() - tb0_;
#endif
            asm volatile("" ::: "memory");
            LAS unsigned char* im = lds + (k % CK_NSLOT) * CK_SLOT;
#if defined(PROBE_STAMPS)
            const unsigned ts1_ = (unsigned)__builtin_amdgcn_s_memrealtime();
#endif
            float lwv[4][4], av[4][4], knv[4][4];
#pragma unroll
            for (int rg = 0; rg < 4; ++rg) { const int tl = 4 * kg + rg;
                float kkv[4], nrm2 = 0.f, vv[4], rr_[4], kr_[4];
#pragma unroll
                for (int nt = 0; nt < 4; ++nt) { rr_[nt] = bf2f(stg[tl * 64 + 16 * nt + l15]); kr_[nt] = bf2f(stg[1024 + tl * 64 + 16 * nt + l15]); vv[nt] = bf2f(stg[2048 + tl * 64 + 16 * nt + l15]);
                    kkv[nt] = kr_[nt] * kkc[nt]; nrm2 += kkv[nt] * kkv[nt]; }
                nrm2 = rowsum16(nrm2); const float rn = __builtin_amdgcn_rsqf(fmaxf(nrm2, 1e-24f));
                float bon = 0.f;
#pragma unroll
                for (int nt = 0; nt < 4; ++nt) {
                    const float wsum = w0c[nt] + accw[nt][rg]; lwv[nt][rg] = -0.6065306597126334f * sigmoid_fast(wsum);
                    const float a_ = sigmoid_fast(a0c[nt] + acca[nt][rg]); av[nt][rg] = a_; knv[nt][rg] = kkv[nt] * rn;
                    const float k2 = kr_[nt] * (1.f + (a_ - 1.f) * kac[nt]); stg[1024 + tl * 64 + 16 * nt + l15] = bf1(k2);
                    bon += rr_[nt] * k2 * rkc[nt];
                    if ((nt >> 1) == ihalf) *(LAS bf16_t*)(im + CK_VT + (16 * (nt & 1) + l15) * 48 + tl * 2) = bf1(vv[nt]);
                }
                bon = rowsum16(bon);
                if (l15 == 0 && ihalf == 0) bonus_out[(rowb + t0 + tl) * 8 + h] = bon;
            }
            { unsigned g_ = 0; if (lane == 0) g_ = __hip_atomic_fetch_add((LAS unsigned*)(lds + CK_FLAGS + 36), 1u, __ATOMIC_RELAXED, __HIP_MEMORY_SCOPE_WORKGROUP);
              kn = (int)__builtin_amdgcn_readfirstlane(g_); }
            CK_ISSUE_A((kn < NCH) ? 16 * kn : t0);
#pragma unroll
            for (int nt = 0; nt < 4; ++nt) {
                float L[4]; L[0] = lwv[nt][0]; L[1] = L[0] + lwv[nt][1]; L[2] = L[1] + lwv[nt][2]; L[3] = L[2] + lwv[nt][3];
                const float T0 = __shfl(L[3], l15), T1 = __shfl(L[3], 16 + l15), T2 = __shfl(L[3], 32 + l15), T3 = __shfl(L[3], 48 + l15);
                const float off = (kg > 0 ? T0 : 0.f) + (kg > 1 ? T1 : 0.f) + (kg > 2 ? T2 : 0.f), LC = (T0 + T1) + (T2 + T3);
                const int j = 16 * nt + l15;
                unsigned bb2[2], kb2[2];
                const float gC = __expf(LC); float eprev = __expf(off);
#pragma unroll
                for (int rg = 0; rg < 4; ++rg) { const int tl = 4 * kg + rg; const float Lt = off + L[rg], e1 = __expf(Lt), e2 = __builtin_amdgcn_rcpf(e1), e3 = eprev, e4 = gC * e2; eprev = e1;
                    const float kn = knv[nt][rg], bvv = kn * av[nt][rg], k2 = bf2f(stg[1024 + tl * 64 + j]), rr2 = bf2f(stg[tl * 64 + j]);
                    *(LAS bf16_t*)(im + CK_BK + tl * 144 + j * 2) = bf1(bvv * e2); *(LAS bf16_t*)(im + CK_BK + (16 + tl) * 144 + j * 2) = bf1(k2 * e2);
                    *(LAS bf16_t*)(im + CK_AR + tl * 144 + j * 2) = bf1(-kn * e3); *(LAS bf16_t*)(im + CK_AR + (16 + tl) * 144 + j * 2) = bf1(rr2 * e1);
                    const unsigned bq = bf1(bvv * e4), kq = bf1(k2 * e4);
                    if (rg & 1) { bb2[rg >> 1] |= bq << 16; kb2[rg >> 1] |= kq << 16; } else { bb2[rg >> 1] = bq; kb2[rg >> 1] = kq; } }
                *(LAS u32x2*)(im + CK_BBT + j * 48 + (4 * kg) * 2) = (u32x2){bb2[0], bb2[1]}; *(LAS u32x2*)(im + CK_KBT + j * 48 + (4 * kg) * 2) = (u32x2){kb2[0], kb2[1]};
                if (kg == 0) *(LAS float*)(im + CK_GC + j * 4) = gC;
            }
            WSYNC();
#if defined(PROBE_STAMPS)
            const unsigned ts2_ = (unsigned)__builtin_amdgcn_s_memrealtime();
            if (blk == 0 && wave == 1 && lane == 0) ((volatile LAS unsigned*)(lds + 146432 + 320))[16 + 27] += ts2_ - ts1_;
#endif
            {
                f32x4 nacc = {0.f, 0.f, 0.f, 0.f};
#pragma unroll
                for (int ks = 0; ks < 2; ++ks) { const bf16x8 fa = *(const LAS bf16x8*)(im + CK_BK + l15 * 144 + (32 * ks + 8 * kg) * 2), fb = *(const LAS bf16x8*)(im + CK_AR + l15 * 144 + (32 * ks + 8 * kg) * 2); nacc = MFMA16(fa, fb, nacc); }
#pragma unroll
                for (int rg = 0; rg < 4; ++rg) nacc[rg] = ((4 * kg + rg) < l15) ? nacc[rg] : 0.f;
                float Tr[16];
#pragma unroll
                for (int t = 0; t < 16; ++t) { float acc_ = (l15 == t) ? 1.f : 0.f;
#pragma unroll
                    for (int s2 = 0; s2 < t; ++s2) acc_ += Tr[s2] * rl(nacc[s2 & 3], t + 16 * (s2 >> 2));
                    Tr[t] = acc_; }
                if (kg == 0) {
#pragma unroll
                    for (int t = 0; t < 16; ++t) *(LAS bf16_t*)(im + CK_TT + t * 48 + l15 * 2) = bf1(Tr[t]); }
            }
            WSYNC();
#if defined(PROBE_STAMPS)
            if (blk == 0 && wave == 1 && lane == 0) ((volatile LAS unsigned*)(lds + 146432 + 320))[16 + 28] += (unsigned)__builtin_amdgcn_s_memrealtime() - ts2_;
#endif
            if (lane == 0) flags[k % CK_NSLOT] = (unsigned)(k + 1);
            CK_ISSUE_B((kn < NCH) ? 16 * kn : t0);
            k = kn;
        }
#undef CK_ISSUE
#undef CK_ISSUE_A
#undef CK_ISSUE_B
    } else {
        const int gq = wave - 6;
        v4u ld[8];
#define G_ISSUE(T0) do { const int t0_ = (T0); const size_t r_ = rowb + t0_ + l15; const size_t rp_ = (t0_ + l15 == 0) ? r_ : r_ - 1; \
            _Pragma("unroll") for (int ks = 0; ks < 4; ++ks) { const int col = 1664 + 32 * ks + 8 * kg; ld[2 * ks] = *(const v4u*)(proj + r_ * L0P + col); ld[2 * ks + 1] = *(const v4u*)(proj + rp_ * L0P + col); } } while (0)
        G_ISSUE(16 * gq);
#pragma unroll 1
        for (int k = gq; k < NCH; k += 2) {
            const int t0 = 16 * k;
            f32x4 accg[2] = {(f32x4){0.f, 0.f, 0.f, 0.f}, (f32x4){0.f, 0.f, 0.f, 0.f}}; const float pz_ = (t0 + l15 == 0) ? 0.f : 1.f;
#pragma unroll
            for (int ks = 0; ks < 4; ++ks) { float s_[8];
                const f32x4 m0 = *(const LAS f32x4*)(mixs + 128 + 32 * ks + 8 * kg), m1 = *(const LAS f32x4*)(mixs + 128 + 32 * ks + 8 * kg + 4);
                RW_SH8(ld[2 * ks], ld[2 * ks + 1], m0, m1, s_, pz_);
#pragma unroll
                for (int j = 0; j < 8; ++j) s_[j] = sigmoid_fast(s_[j]);
                const bf16x8 af = pack8(s_[0], s_[1], s_[2], s_[3], s_[4], s_[5], s_[6], s_[7]);
#pragma unroll
                for (int nt = 0; nt < 2; ++nt) { const bf16x8 bfr = *(const bf16x8*)(G2T + (size_t)(h * 64 + ihalf * 32 + 16 * nt + l15) * 128 + 32 * ks + 8 * kg); accg[nt] = MFMA16(af, bfr, accg[nt]); } }
            G_ISSUE((k + 2 < NCH) ? t0 + 32 : t0);
#pragma unroll
            for (int nt = 0; nt < 2; ++nt)
#pragma unroll
                for (int rg = 0; rg < 4; ++rg) gout[(rowb + t0 + 4 * kg + rg) * 512 + h * 64 + ihalf * 32 + 16 * nt + l15] = bf1(accg[nt][rg]);
        }
#undef G_ISSUE
    }
#undef RW_SH8
    __syncthreads();
}

constexpr int CC_BK = 0, CC_AR = 4608, CC_BBT = 9216, CC_KBT = 11776, CC_VT = 14336, CC_GC = 16896, CC_TT = 17152, CC_SLOT = 18432, CC_NSLOT = 6, CC_NBUILD = 6;
constexpr int CC_STG = CC_SLOT * CC_NSLOT;
constexpr int CC_MIX = CC_STG + CC_NBUILD * 4096;
constexpr int CC_FLAGS = CC_MIX + 448 * 4;
static_assert(CC_FLAGS + 64 <= 146432, "rwkv chain LDS map");
__device__ __forceinline__ void rwkv_phase_chain(LAS float* smf, int tid, int lane, int wave, int blk, const bf16_t* __restrict__ proj, const float* __restrict__ mix, const float* __restrict__ w0, const float* __restrict__ a0,
                                           const float* __restrict__ k_k, const float* __restrict__ k_a, const float* __restrict__ r_k, const bf16_t* __restrict__ W2T, const bf16_t* __restrict__ A2T, const bf16_t* __restrict__ G2T,
                                           float* __restrict__ yraw, bf16_t* __restrict__ gout, float* __restrict__ bonus_out) {
    LAS unsigned char* lds = (LAS unsigned char*)smf;
    LAS float* mixs = (LAS float*)(lds + CC_MIX);
    volatile LAS unsigned* flags = (volatile LAS unsigned*)(lds + CC_FLAGS);
    const int chain = blk, b = chain >> 3, h = chain & 7, l15 = lane & 15, kg = lane >> 4, l31 = lane & 31, hi = lane >> 5;
    const size_t rowb = (size_t)b * SEQ;
    constexpr int NCH = SEQ / 16;
    if (tid < 256) mixs[tid] = mix[1536 + tid];
    else if (tid < 448) { const int q = tid - 256; mixs[tid] = mix[512 * (q >> 6) + h * 64 + (q & 63)]; }
    if (tid < 16) flags[tid] = (tid == 10) ? (unsigned)CC_NBUILD : 0u;
    for (int q = tid; q < CC_NSLOT * 320; q += NWAVES * 64) *(LAS unsigned*)(lds + (q / 320) * CC_SLOT + CC_TT + (q % 320) * 4) = 0u;
    __syncthreads();
#define RW_SH8(CUR, PRV, M0, M1, OUT, PZ) do { const unsigned cu_[4] = {(CUR).x, (CUR).y, (CUR).z, (CUR).w}, pu_[4] = {(PRV).x, (PRV).y, (PRV).z, (PRV).w}; \
        const float mm_[8] = {(M0)[0], (M0)[1], (M0)[2], (M0)[3], (M1)[0], (M1)[1], (M1)[2], (M1)[3]}; \
        _Pragma("unroll") for (int q = 0; q < 4; ++q) { const float c0 = bflo(cu_[q]), c1 = bfhi(cu_[q]), p0 = bflo(pu_[q]) * (PZ), p1 = bfhi(pu_[q]) * (PZ); \
            OUT[2 * q] = c0 + (p0 - c0) * mm_[2 * q]; OUT[2 * q + 1] = c1 + (p1 - c1) * mm_[2 * q + 1]; } } while (0)
    if (wave < 2) {
        const int ihalf = wave;
        f32x16 ST[2];
#pragma unroll
        for (int r = 0; r < 16; ++r) { ST[0][r] = 0.f; ST[1][r] = 0.f; }
#pragma unroll 1
        for (int k = 0; k < NCH; ++k) {
            { const unsigned want = (unsigned)(k + 1); const int sl = k % CC_NSLOT; while (flags[sl] != want) __builtin_amdgcn_s_sleep(1); }
            asm volatile("" ::: "memory");
            const LAS unsigned char* im = lds + (k % CC_NSLOT) * CC_SLOT;
            f32x16 G;
#pragma unroll
            for (int r = 0; r < 16; ++r) G[r] = 0.f;
#pragma unroll
            for (int kk = 0; kk < 4; ++kk) { const bf16x8 fa = *(const LAS bf16x8*)(im + CC_BK + l31 * 144 + (16 * kk + 8 * hi) * 2), fb = *(const LAS bf16x8*)(im + CC_AR + l31 * 144 + (16 * kk + 8 * hi) * 2); G = MFMA32(fa, fb, G); }
            { const int tcol = l31 & 15; const bool strict = l31 < 16;
#pragma unroll
              for (int r = 0; r < 16; ++r) { const int srow = crow(r & 7, hi); const bool keep = strict ? (srow < tcol) : (srow <= tcol); G[r] = keep ? G[r] : 0.f; } }
            const bf16x8 gB = pack8(G[0], G[1], G[2], G[3], G[4], G[5], G[6], G[7]), gK = pack8(G[8], G[9], G[10], G[11], G[12], G[13], G[14], G[15]);
            f32x16 XT;
#pragma unroll
            for (int r = 0; r < 16; ++r) XT[r] = 0.f;
#pragma unroll
            for (int jt = 0; jt < 2; ++jt)
#pragma unroll
                for (int sp = 0; sp < 2; ++sp) { const LAS unsigned char* ap = im + CC_AR + l31 * 144 + (32 * jt + 16 * sp + 4 * hi) * 2;
                    const u32x2 x0 = *(const LAS u32x2*)ap, x1 = *(const LAS u32x2*)(ap + 16); v4u aw; aw.x = x0.x; aw.y = x0.y; aw.z = x1.x; aw.w = x1.y;
                    const bf16x8 sb_ = pack8(ST[jt][8 * sp], ST[jt][8 * sp + 1], ST[jt][8 * sp + 2], ST[jt][8 * sp + 3], ST[jt][8 * sp + 4], ST[jt][8 * sp + 5], ST[jt][8 * sp + 6], ST[jt][8 * sp + 7]);
                    XT = MFMA32(__builtin_bit_cast(bf16x8, aw), sb_, XT); }
            bf16x8 vP;
            { const LAS unsigned char* vp = im + CC_VT + (32 * ihalf + l31) * 40 + (4 * hi) * 2; const u32x2 x0 = *(const LAS u32x2*)vp, x1 = *(const LAS u32x2*)(vp + 16); v4u vw; vw.x = x0.x; vw.y = x0.y; vw.z = x1.x; vw.w = x1.y;
              vP = __builtin_bit_cast(bf16x8, vw); XT = MFMA32(gK, vP, XT); }
            bf16x8 uP;
            { const LAS unsigned char* tp = im + CC_TT + l31 * 40 + (4 * hi) * 2; const u32x2 x0 = *(const LAS u32x2*)tp, x1 = *(const LAS u32x2*)(tp + 16); v4u tw; tw.x = x0.x; tw.y = x0.y; tw.z = x1.x; tw.w = x1.y;
              f32x16 UT;
#pragma unroll
              for (int r = 0; r < 16; ++r) UT[r] = 0.f;
              UT = MFMA32(__builtin_bit_cast(bf16x8, tw), pack8(XT[0], XT[1], XT[2], XT[3], XT[4], XT[5], XT[6], XT[7]), UT);
              uP = pack8(UT[0], UT[1], UT[2], UT[3], UT[4], UT[5], UT[6], UT[7]); }
            XT = MFMA32(gB, uP, XT);
            { float* yp = yraw + (rowb + 16 * k) * 512 + h * 64 + 32 * ihalf + l31;
#pragma unroll
              for (int q = 0; q < 8; ++q) yp[(size_t)crow(q, hi) * 512] = XT[8 + q]; }
            { const LAS float* gc = (const LAS float*)(im + CC_GC);
#pragma unroll
              for (int jt = 0; jt < 2; ++jt)
#pragma unroll
                  for (int r = 0; r < 16; ++r) ST[jt][r] *= gc[32 * jt + crow(r, hi)]; }
#pragma unroll
            for (int jt = 0; jt < 2; ++jt) { const LAS unsigned char* bp = im + CC_BBT + (32 * jt + l31) * 40 + (4 * hi) * 2; const LAS unsigned char* kp = im + CC_KBT + (32 * jt + l31) * 40 + (4 * hi) * 2;
                const u32x2 b0 = *(const LAS u32x2*)bp, b1 = *(const LAS u32x2*)(bp + 16), k0 = *(const LAS u32x2*)kp, k1 = *(const LAS u32x2*)(kp + 16);
                v4u a1; a1.x = b0.x; a1.y = b0.y; a1.z = b1.x; a1.w = b1.y; v4u a2; a2.x = k0.x; a2.y = k0.y; a2.z = k1.x; a2.w = k1.y;
                ST[jt] = MFMA32(__builtin_bit_cast(bf16x8, a1), uP, ST[jt]); ST[jt] = MFMA32(__builtin_bit_cast(bf16x8, a2), vP, ST[jt]); }
            WSYNC();
            if (lane == 0) flags[8 + ihalf] = (unsigned)(k + 1);
        }
    } else {
        const int pw = wave - 2;
        LAS bf16_t* stg = (LAS bf16_t*)(lds + CC_STG) + pw * 2048;
        v4u ld[20];
#define CC_ISSUE_A(T0) do { const int t0_ = (T0); const size_t r_ = rowb + t0_ + l15; const size_t rp_ = (t0_ + l15 == 0) ? r_ : r_ - 1; \
            _Pragma("unroll") for (int lo = 0; lo < 2; ++lo) _Pragma("unroll") for (int ks = 0; ks < 2; ++ks) { const int col = 1536 + 64 * lo + 32 * ks + 8 * kg; \
                ld[(lo * 2 + ks) * 2] = *(const v4u*)(proj + r_ * L0P + col); ld[(lo * 2 + ks) * 2 + 1] = *(const v4u*)(proj + rp_ * L0P + col); } } while (0)
#define CC_ISSUE_B(T0) do { const int t0_ = (T0); \
            _Pragma("unroll") for (int ar = 0; ar < 3; ++ar) _Pragma("unroll") for (int i = 0; i < 2; ++i) { const int p_ = lane + 64 * i, row_ = p_ >> 3, c8_ = p_ & 7; \
                const size_t r_ = rowb + t0_ + row_; const size_t rp_ = (t0_ + row_ == 0) ? r_ : r_ - 1; const int col = 512 * ar + h * 64 + 8 * c8_; \
                ld[8 + (ar * 2 + i) * 2] = *(const v4u*)(proj + r_ * L0P + col); ld[8 + (ar * 2 + i) * 2 + 1] = *(const v4u*)(proj + rp_ * L0P + col); } } while (0)
#define CC_ISSUE(T0) do { CC_ISSUE_A(T0); CC_ISSUE_B(T0); } while (0)
        CC_ISSUE(16 * pw);
        int k = pw;
#pragma unroll 1
        while (k < NCH) {
            const int t0 = 16 * k; int kn;
            f32x4 accw[4], acca[4];
#pragma unroll
            for (int nt = 0; nt < 4; ++nt) { accw[nt] = (f32x4){0.f, 0.f, 0.f, 0.f}; acca[nt] = (f32x4){0.f, 0.f, 0.f, 0.f}; }
            { const float pz_ = (t0 + l15 == 0) ? 0.f : 1.f;
#pragma unroll
              for (int lo = 0; lo < 2; ++lo)
#pragma unroll
                for (int ks = 0; ks < 2; ++ks) { float s_[8];
                    const f32x4 m0 = *(const LAS f32x4*)(mixs + 64 * lo + 32 * ks + 8 * kg), m1 = *(const LAS f32x4*)(mixs + 64 * lo + 32 * ks + 8 * kg + 4);
                    RW_SH8(ld[(lo * 2 + ks) * 2], ld[(lo * 2 + ks) * 2 + 1], m0, m1, s_, pz_);
                    if (lo == 0) {
#pragma unroll
                        for (int j = 0; j < 8; ++j) s_[j] = tanh_fast(s_[j]); }
                    const bf16x8 af = pack8(s_[0], s_[1], s_[2], s_[3], s_[4], s_[5], s_[6], s_[7]);
                    const bf16_t* WT = lo ? A2T : W2T;
#pragma unroll
                    for (int nt = 0; nt < 4; ++nt) { const bf16x8 bfr = *(const bf16x8*)(WT + (size_t)(h * 64 + 16 * nt + l15) * 64 + 32 * ks + 8 * kg);
                        if (lo == 0) accw[nt] = MFMA16(af, bfr, accw[nt]); else acca[nt] = MFMA16(af, bfr, acca[nt]); } } }
            { const int need = k - (CC_NSLOT - 1); if (need > 0) { while ((int)flags[8] < need || (int)flags[9] < need) __builtin_amdgcn_s_sleep(2); } }
            asm volatile("" ::: "memory");
            LAS unsigned char* im = lds + (k % CC_NSLOT) * CC_SLOT;
#pragma unroll
            for (int ar = 0; ar < 3; ++ar)
#pragma unroll
                for (int i = 0; i < 2; ++i) { const int p_ = lane + 64 * i, row_ = p_ >> 3, c8_ = p_ & 7; float s_[8];
                    const float pz_ = (t0 + row_ == 0) ? 0.f : 1.f; const f32x4 m0 = *(const LAS f32x4*)(mixs + 256 + ar * 64 + c8_ * 8), m1 = *(const LAS f32x4*)(mixs + 256 + ar * 64 + c8_ * 8 + 4);
                    RW_SH8(ld[8 + (ar * 2 + i) * 2], ld[8 + (ar * 2 + i) * 2 + 1], m0, m1, s_, pz_);
                    if (ar < 2) *(LAS bf16x8*)(stg + ar * 1024 + row_ * 64 + c8_ * 8) = pack8(s_[0], s_[1], s_[2], s_[3], s_[4], s_[5], s_[6], s_[7]);
                    else {
#pragma unroll
                        for (int j = 0; j < 8; ++j) *(LAS bf16_t*)(im + CC_VT + (c8_ * 8 + j) * 40 + row_ * 2) = bf1(s_[j]); } }
            WSYNC();
            float lwv[4][4], av[4][4], knv[4][4];
            float w0c[4], a0c[4], kkc[4], kac[4], rkc[4];
#pragma unroll
            for (int nt = 0; nt < 4; ++nt) { const int c = h * 64 + 16 * nt + l15; w0c[nt] = w0[c]; a0c[nt] = a0[c]; kkc[nt] = k_k[c]; kac[nt] = k_a[c]; rkc[nt] = r_k[c]; }
#pragma unroll
            for (int rg = 0; rg < 4; ++rg) { const int tl = 4 * kg + rg;
                float kkv[4], nrm2 = 0.f, rr_[4], kr_[4];
#pragma unroll
                for (int nt = 0; nt < 4; ++nt) { rr_[nt] = bf2f(stg[tl * 64 + 16 * nt + l15]); kr_[nt] = bf2f(stg[1024 + tl * 64 + 16 * nt + l15]);
                    kkv[nt] = kr_[nt] * kkc[nt]; nrm2 += kkv[nt] * kkv[nt]; }
                nrm2 = rowsum16(nrm2); const float rn = __builtin_amdgcn_rsqf(fmaxf(nrm2, 1e-24f));
                float bon = 0.f;
#pragma unroll
                for (int nt = 0; nt < 4; ++nt) {
                    const float wsum = w0c[nt] + accw[nt][rg]; lwv[nt][rg] = -0.6065306597126334f * sigmoid_fast(wsum);
                    const float a_ = sigmoid_fast(a0c[nt] + acca[nt][rg]); av[nt][rg] = a_; knv[nt][rg] = kkv[nt] * rn;
                    const float k2 = kr_[nt] * (1.f + (a_ - 1.f) * kac[nt]); stg[1024 + tl * 64 + 16 * nt + l15] = bf1(k2);
                    bon += rr_[nt] * k2 * rkc[nt];
                }
                bon = rowsum16(bon);
                if (l15 == 0) bonus_out[(rowb + t0 + tl) * 8 + h] = bon;
            }
            { unsigned g_ = 0; if (lane == 0) g_ = __hip_atomic_fetch_add((LAS unsigned*)(lds + CC_FLAGS + 40), 1u, __ATOMIC_RELAXED, __HIP_MEMORY_SCOPE_WORKGROUP);
              kn = (int)__builtin_amdgcn_readfirstlane(g_); }
            CC_ISSUE_A((kn < NCH) ? 16 * kn : t0);
#pragma unroll
            for (int nt = 0; nt < 4; ++nt) {
                float L[4]; L[0] = lwv[nt][0]; L[1] = L[0] + lwv[nt][1]; L[2] = L[1] + lwv[nt][2]; L[3] = L[2] + lwv[nt][3];
                const float T0 = __shfl(L[3], l15), T1 = __shfl(L[3], 16 + l15), T2 = __shfl(L[3], 32 + l15), T3 = __shfl(L[3], 48 + l15);
                const float off = (kg > 0 ? T0 : 0.f) + (kg > 1 ? T1 : 0.f) + (kg > 2 ? T2 : 0.f), LC = (T0 + T1) + (T2 + T3);
                const int j = 16 * nt + l15;
                unsigned bb2[2], kb2[2];
                const float gC = __expf(LC); float eprev = __expf(off);
#pragma unroll
                for (int rg = 0; rg < 4; ++rg) { const int tl = 4 * kg + rg; const float Lt = off + L[rg], e1 = __expf(Lt), e2 = __builtin_amdgcn_rcpf(e1), e3 = eprev, e4 = gC * e2; eprev = e1;
                    const float kn = knv[nt][rg], bvv = kn * av[nt][rg], k2 = bf2f(stg[1024 + tl * 64 + j]), rr2 = bf2f(stg[tl * 64 + j]);
                    *(LAS bf16_t*)(im + CC_BK + tl * 144 + j * 2) = bf1(bvv * e2); *(LAS bf16_t*)(im + CC_BK + (16 + tl) * 144 + j * 2) = bf1(k2 * e2);
                    *(LAS bf16_t*)(im + CC_AR + tl * 144 + j * 2) = bf1(-kn * e3); *(LAS bf16_t*)(im + CC_AR + (16 + tl) * 144 + j * 2) = bf1(rr2 * e1);
                    const unsigned bq = bf1(bvv * e4), kq = bf1(k2 * e4);
                    if (rg & 1) { bb2[rg >> 1] |= bq << 16; kb2[rg >> 1] |= kq << 16; } else { bb2[rg >> 1] = bq; kb2[rg >> 1] = kq; } }
                *(LAS u32x2*)(im + CC_BBT + j * 40 + (4 * kg) * 2) = (u32x2){bb2[0], bb2[1]}; *(LAS u32x2*)(im + CC_KBT + j * 40 + (4 * kg) * 2) = (u32x2){kb2[0], kb2[1]};
                if (kg == 0) *(LAS float*)(im + CC_GC + j * 4) = gC;
            }
            WSYNC();
            {
                f32x4 nacc = {0.f, 0.f, 0.f, 0.f};
#pragma unroll
                for (int ks = 0; ks < 2; ++ks) { const bf16x8 fa = *(const LAS bf16x8*)(im + CC_BK + l15 * 144 + (32 * ks + 8 * kg) * 2), fb = *(const LAS bf16x8*)(im + CC_AR + l15 * 144 + (32 * ks + 8 * kg) * 2); nacc = MFMA16(fa, fb, nacc); }
#pragma unroll
                for (int rg = 0; rg < 4; ++rg) nacc[rg] = ((4 * kg + rg) < l15) ? nacc[rg] : 0.f;
                float Tr[16];
#pragma unroll
                for (int t = 0; t < 16; ++t) { float acc_ = (l15 == t) ? 1.f : 0.f;
#pragma unroll
                    for (int s2 = 0; s2 < t; ++s2) acc_ += Tr[s2] * rl(nacc[s2 & 3], t + 16 * (s2 >> 2));
                    Tr[t] = acc_; }
                if (kg == 0) {
#pragma unroll
                    for (int t = 0; t < 16; ++t) *(LAS bf16_t*)(im + CC_TT + t * 40 + l15 * 2) = bf1(Tr[t]); }
            }
            WSYNC();
            if (lane == 0) flags[k % CC_NSLOT] = (unsigned)(k + 1);
            CC_ISSUE_B((kn < NCH) ? 16 * kn : t0);
            k = kn;
        }
#undef CC_ISSUE
#undef CC_ISSUE_A
#undef CC_ISSUE_B
    }
#undef RW_SH8
    __syncthreads();
}


__device__ __forceinline__ void gate_lora_task(int chain, int k, int lane, const bf16_t* __restrict__ proj, const float* __restrict__ mix, const bf16_t* __restrict__ G2T, bf16_t* __restrict__ gout) {
    const int b = chain >> 3, h = chain & 7, l15 = lane & 15, kg = lane >> 4, t0 = 16 * k;
    const size_t rowb = (size_t)b * SEQ, r_ = rowb + t0 + l15, rp_ = (t0 + l15 == 0) ? r_ : r_ - 1;
    const float pz_ = (t0 + l15 == 0) ? 0.f : 1.f;
    v4u cu[4], pv[4];
#pragma unroll
    for (int ks = 0; ks < 4; ++ks) { const int col = 1664 + 32 * ks + 8 * kg; cu[ks] = *(const v4u*)(proj + r_ * L0P + col); pv[ks] = *(const v4u*)(proj + rp_ * L0P + col); }
    f32x4 accg[4];
#pragma unroll
    for (int nt = 0; nt < 4; ++nt) accg[nt] = (f32x4){0.f, 0.f, 0.f, 0.f};
#pragma unroll
    for (int ks = 0; ks < 4; ++ks) {
        const f32x4 m0 = *(const f32x4*)(mix + 1664 + 32 * ks + 8 * kg), m1 = *(const f32x4*)(mix + 1664 + 32 * ks + 8 * kg + 4);
        const float mm[8] = {m0[0], m0[1], m0[2], m0[3], m1[0], m1[1], m1[2], m1[3]};
        const unsigned cw[4] = {cu[ks].x, cu[ks].y, cu[ks].z, cu[ks].w}, pw[4] = {pv[ks].x, pv[ks].y, pv[ks].z, pv[ks].w};
        float s_[8];
#pragma unroll
        for (int q = 0; q < 4; ++q) { const float c0 = bflo(cw[q]), c1 = bfhi(cw[q]), p0 = bflo(pw[q]) * pz_, p1 = bfhi(pw[q]) * pz_;
            s_[2 * q] = sigmoid_fast(c0 + (p0 - c0) * mm[2 * q]); s_[2 * q + 1] = sigmoid_fast(c1 + (p1 - c1) * mm[2 * q + 1]); }
        const bf16x8 af = pack8(s_[0], s_[1], s_[2], s_[3], s_[4], s_[5], s_[6], s_[7]);
#pragma unroll
        for (int nt = 0; nt < 4; ++nt) { const bf16x8 bfr = *(const bf16x8*)(G2T + (size_t)(h * 64 + 16 * nt + l15) * 128 + 32 * ks + 8 * kg); accg[nt] = MFMA16(af, bfr, accg[nt]); }
    }
#pragma unroll
    for (int nt = 0; nt < 4; ++nt)
#pragma unroll
        for (int rg = 0; rg < 4; ++rg) gout[(rowb + t0 + 4 * kg + rg) * 512 + h * 64 + 16 * nt + l15] = bf1(accg[nt][rg]);
}


__device__ __forceinline__ void gate_lora_wave(int first, int stride, int lane, const bf16_t* __restrict__ proj, const float* __restrict__ mix, const bf16_t* __restrict__ G2T, bf16_t* __restrict__ gout) {
    const int l15 = lane & 15, kg = lane >> 4, h = (first >> 7) & 7;
    bf16x8 bfr[4][4];
#pragma unroll
    for (int ks = 0; ks < 4; ++ks)
#pragma unroll
        for (int nt = 0; nt < 4; ++nt) bfr[ks][nt] = *(const bf16x8*)(G2T + (size_t)(h * 64 + 16 * nt + l15) * 128 + 32 * ks + 8 * kg);
    float mm[4][8];
#pragma unroll
    for (int ks = 0; ks < 4; ++ks) { const f32x4 m0 = *(const f32x4*)(mix + 1664 + 32 * ks + 8 * kg), m1 = *(const f32x4*)(mix + 1664 + 32 * ks + 8 * kg + 4);
        mm[ks][0] = m0[0]; mm[ks][1] = m0[1]; mm[ks][2] = m0[2]; mm[ks][3] = m0[3]; mm[ks][4] = m1[0]; mm[ks][5] = m1[1]; mm[ks][6] = m1[2]; mm[ks][7] = m1[3]; }
    v4u cu[4], pv[4];
#define GL_LOAD(TK) do { const int ch_ = (TK) >> 7, t0_ = 16 * ((TK) & 127); const size_t r_ = (size_t)(ch_ >> 3) * SEQ + t0_ + l15, rp_ = (t0_ + l15 == 0) ? r_ : r_ - 1; \
        _Pragma("unroll") for (int ks = 0; ks < 4; ++ks) { const int col = 1664 + 32 * ks + 8 * kg; cu[ks] = *(const v4u*)(proj + r_ * L0P + col); pv[ks] = *(const v4u*)(proj + rp_ * L0P + col); } } while (0)
    GL_LOAD(first);
#pragma unroll 1
    for (int tk = first; tk < 128 * 128; tk += stride) {
        const int chain = tk >> 7, t0 = 16 * (tk & 127); const size_t rowb = (size_t)(chain >> 3) * SEQ;
        const float pz_ = (t0 + l15 == 0) ? 0.f : 1.f;
        f32x4 accg[4];
#pragma unroll
        for (int nt = 0; nt < 4; ++nt) accg[nt] = (f32x4){0.f, 0.f, 0.f, 0.f};
        bf16x8 af[4];
#pragma unroll
        for (int ks = 0; ks < 4; ++ks) { const unsigned cw[4] = {cu[ks].x, cu[ks].y, cu[ks].z, cu[ks].w}, pw[4] = {pv[ks].x, pv[ks].y, pv[ks].z, pv[ks].w}; float s_[8];
#pragma unroll
            for (int q = 0; q < 4; ++q) { const float c0 = bflo(cw[q]), c1 = bfhi(cw[q]), p0 = bflo(pw[q]) * pz_, p1 = bfhi(pw[q]) * pz_;
                s_[2 * q] = sigmoid_fast(c0 + (p0 - c0) * mm[ks][2 * q]); s_[2 * q + 1] = sigmoid_fast(c1 + (p1 - c1) * mm[ks][2 * q + 1]); }
            af[ks] = pack8(s_[0], s_[1], s_[2], s_[3], s_[4], s_[5], s_[6], s_[7]); }
        { const int tn = (tk + stride < 128 * 128) ? tk + stride : tk; GL_LOAD(tn); }
#pragma unroll
        for (int ks = 0; ks < 4; ++ks)
#pragma unroll
            for (int nt = 0; nt < 4; ++nt) accg[nt] = MFMA16(af[ks], bfr[ks][nt], accg[nt]);
#pragma unroll
        for (int nt = 0; nt < 4; ++nt)
#pragma unroll
            for (int rg = 0; rg < 4; ++rg) gout[(rowb + t0 + 4 * kg + rg) * 512 + h * 64 + 16 * nt + l15] = bf1(accg[nt][rg]);
    }
#undef GL_LOAD
}

template <bool ST = true> __device__ __forceinline__ void rwkv_post_all(const float* __restrict__ yraw, const bf16_t* __restrict__ proj, const float* __restrict__ mix, const float* __restrict__ bonus, const bf16_t* __restrict__ gbuf,
                                              const float* __restrict__ ln_g, const float* __restrict__ ln_b, bf16_t* __restrict__ ymix, int gw, int NGW, int lane) {
    for (int m = gw; m < M; m += NGW) {
        const bool has_prev = (m & (SEQ - 1)) != 0;
        float y[8], cv[8], pv[8], gg[8], bo[8];
#pragma unroll
        for (int h = 0; h < 8; ++h) { const int c = h * 64 + lane; y[h] = yraw[(size_t)m * 512 + c]; cv[h] = bf2f(proj[(size_t)m * L0P + 1024 + c]);
            pv[h] = bf2f(proj[(size_t)(has_prev ? m - 1 : m) * L0P + 1024 + c]); gg[h] = bf2f(gbuf[(size_t)m * 512 + c]); bo[h] = bonus[(size_t)m * 8 + h]; }
#pragma unroll
        for (int h = 0; h < 8; ++h) { const int c = h * 64 + lane;
            const float mu = wave_sum_dpp(y[h]) * (1.f / 64.f), d = y[h] - mu, var = wave_sum_dpp(d * d) * (1.f / 64.f);
            const float yn = d * __builtin_amdgcn_rsqf(var + 64e-5f) * ln_g[c] + ln_b[c];
            const float pvv = has_prev ? pv[h] : 0.f;
            const float v_s = cv[h] + (pvv - cv[h]) * mix[1024 + c];
            const float o = (yn + bo[h] * v_s) * gg[h];
            if (ST) ymix[(size_t)m * DM + c] = bf1(o); else asm volatile("" :: "v"(o)); }
    }
}


__device__ __forceinline__ void ssd_conv_tile(int it, int lane, LAS bf16_t* scr, const bf16_t* __restrict__ proj, const float* __restrict__ cw, const float* __restrict__ cb,
                                              bf16_t* __restrict__ xbc, bf16_t* __restrict__ xst, bf16_t* __restrict__ bt) {
    const int tt = it >> 4, ct = it & 15, m0 = tt * 64, b = m0 >> 11, t0 = m0 & (SEQ - 1), c = ct * 64 + lane;
    const float w0 = cw[c], w1 = cw[1024 + c], w2 = cw[2048 + c], w3 = cw[3072 + c], bias = cb[c];
    const bf16_t* src = proj + (size_t)m0 * L0P + 2304 + c;
    bf16_t raw[67];
    const int lo = (t0 > 0) ? -3 : 0;
#pragma unroll
    for (int t = -3; t < 64; ++t) raw[t + 3] = src[(ptrdiff_t)((t < lo) ? lo : t) * L0P];
    float u3 = (t0 > 0) ? bf2f(raw[0]) : 0.f, u2 = (t0 > 0) ? bf2f(raw[1]) : 0.f, u1 = (t0 > 0) ? bf2f(raw[2]) : 0.f;
#pragma unroll
    for (int t = 0; t < 64; ++t) {
        const float u = bf2f(raw[t + 3]);
        const float y = bias + w0 * u3 + w1 * u2 + w2 * u1 + w3 * u;
        const bf16_t o = bf1(y * __builtin_amdgcn_rcpf(1.f + __expf(-y)));
        xbc[(size_t)(m0 + t) * 1024 + c] = o;
        scr[t * STG_PITCH + lane] = o;
        u3 = u2; u2 = u1; u1 = u;
    }
    WSYNC();
    if (ct < 12) {
        bf16_t* dst = (ct < 8) ? xst + ((size_t)(b * 8 + ct) * 64) * SEQ + t0 : bt + ((size_t)(b * 2 + ((ct - 8) >> 1)) * 128 + ((ct - 8) & 1) * 64) * SEQ + t0;
#pragma unroll
        for (int i = 0; i < 8; ++i) { const int d = i * 8 + (lane >> 3), tc = lane & 7; const LAS bf16_t* p = scr + (tc * 8) * STG_PITCH + d;
            v4u o; o.x = (unsigned)p[0] | ((unsigned)p[STG_PITCH] << 16); o.y = (unsigned)p[2 * STG_PITCH] | ((unsigned)p[3 * STG_PITCH] << 16);
            o.z = (unsigned)p[4 * STG_PITCH] | ((unsigned)p[5 * STG_PITCH] << 16); o.w = (unsigned)p[6 * STG_PITCH] | ((unsigned)p[7 * STG_PITCH] << 16);
            *(v4u*)(dst + (size_t)d * SEQ + tc * 8) = o; }
    }
    WSYNC();
}
__device__ __forceinline__ float bperm(int srclane, float x) { return __builtin_bit_cast(float, __builtin_amdgcn_ds_bpermute(srclane << 2, __builtin_bit_cast(int, x))); }
__device__ __forceinline__ void scan128(float& x0, float& x1, int lane) {
#pragma unroll
    for (int o = 1; o < 64; o <<= 1) { const int sl = (lane >= o) ? lane - o : lane; const float t0 = bperm(sl, x0), t1 = bperm(sl, x1); if (lane >= o) { x0 += t0; x1 += t1; } }
    x1 += rl(x0, 63);
}

__device__ __forceinline__ void ssd_s3_block(int bc, int tid, int lane, int wave, LAS unsigned char* lds, const bf16_t* __restrict__ xbc, const bf16_t* __restrict__ xst, const bf16_t* __restrict__ stb,
                                             const float* __restrict__ dt, const float* __restrict__ a_log, const float* __restrict__ dsk, bf16_t* __restrict__ yssm) {
    const int b = bc >> 4, c = bc & 15, h = wave, g = h >> 2, l0 = c * 128, l31 = lane & 31, hi = lane >> 5, unit = bc * 8 + h;
    const size_t m0 = (size_t)b * SEQ + l0;
    __syncthreads();
    {
        const int mat = lane >> 4, ch = lane & 15;
        v4u rr[16];
#pragma unroll
        for (int i = 0; i < 16; ++i) rr[i] = *(const v4u*)(xbc + (m0 + wave * 16 + i) * 1024 + 512 + lane * 8);
#pragma unroll
        for (int i = 0; i < 16; ++i) { const int row = wave * 16 + i; *(LAS v4u*)(lds + mat * 34816 + row * 272 + ch * 16) = rr[i]; }
    }
#define S3TAB(i) (*(LAS float*)(lds + ((wave * 64) + ((i) >> 2)) * 272 + 256 + ((i) & 3) * 4))
    const float A = -expf(a_log[h]), D = dsk[h];
    { const float d0 = dt[(m0 + lane) * 8 + h], d1 = dt[(m0 + 64 + lane) * 8 + h];
      float ac0 = d0 * A, ac1 = d1 * A;
      scan128(ac0, ac1, lane);
      S3TAB(lane) = ac0; S3TAB(64 + lane) = ac1; S3TAB(128 + lane) = d0; S3TAB(192 + lane) = d1; }
    u32x2 xf[4][2][2][2];
    const bf16_t* Sp = stb + (size_t)unit * 8192 + l31 * 128 + 8 * hi;
    { const bf16_t* Xp = xst + ((size_t)(b * 8 + h) * 64 + l31) * SEQ + l0 + 4 * hi;
#pragma unroll
      for (int st = 0; st < 4; ++st)
#pragma unroll
          for (int pt = 0; pt < 2; ++pt)
#pragma unroll
              for (int ks = 0; ks < 2; ++ks) { const bf16_t* xp = Xp + (size_t)pt * 32 * SEQ + st * 32 + 16 * ks; xf[st][pt][ks][0] = *(const u32x2*)xp; xf[st][pt][ks][1] = *(const u32x2*)(xp + 8); } }
    __syncthreads();
    const LAS unsigned char* Bl = lds + g * 34816 + 16 * hi;
    const LAS unsigned char* Cl = lds + (2 + g) * 34816 + 16 * hi;
#pragma unroll 1
    for (int lt = 0; lt < 4; ++lt) {
        asm volatile("" ::: "memory");
        f32x16 y[2];
#pragma unroll
        for (int r = 0; r < 16; ++r) { y[0][r] = 0.f; y[1][r] = 0.f; }
        const float acl = S3TAB(32 * lt + l31);
        const int crw = 32 * lt + l31;
        { bf16x8 sfr[2][8];
#pragma unroll
          for (int pt = 0; pt < 2; ++pt)
#pragma unroll
              for (int kk = 0; kk < 8; ++kk) sfr[pt][kk] = *(const bf16x8*)(Sp + pt * 32 * 128 + 16 * kk);
#pragma unroll
          for (int kk = 0; kk < 8; ++kk) { const bf16x8 cf = *(const LAS bf16x8*)(Cl + crw * 272 + 32 * kk); y[0] = MFMA32(sfr[0][kk], cf, y[0]); y[1] = MFMA32(sfr[1][kk], cf, y[1]); } }
        { const float el = __expf(acl);
#pragma unroll
          for (int r = 0; r < 16; ++r) { y[0][r] *= el; y[1][r] *= el; } }
        u32x2 xd[2][4];
#pragma unroll
        for (int pt = 0; pt < 2; ++pt)
#pragma unroll
            for (int q = 0; q < 4; ++q) xd[pt][q] = *(const u32x2*)(xbc + (m0 + crw) * 1024 + h * 64 + 32 * pt + 8 * q + 4 * hi);
#pragma unroll
        for (int st = 0; st < 4; ++st) if (st <= lt) {
            const int brw = 32 * st + l31;
            f32x16 cbt;
#pragma unroll
            for (int r = 0; r < 16; ++r) cbt[r] = 0.f;
#pragma unroll
            for (int kk = 0; kk < 8; ++kk) { const bf16x8 bf_ = *(const LAS bf16x8*)(Bl + brw * 272 + 32 * kk), cf_ = *(const LAS bf16x8*)(Cl + crw * 272 + 32 * kk); cbt = MFMA32(bf_, cf_, cbt); }
#pragma unroll
            for (int r = 0; r < 16; ++r) { const int sl = 32 * st + crow(r, hi); const float acs = S3TAB(sl), dts = S3TAB(128 + sl);
                float v = cbt[r] * __expf(acl - acs) * dts; if (st == lt && crow(r, hi) > l31) v = 0.f; cbt[r] = v; }
            bf16x8 pf[2];
#pragma unroll
            for (int ks = 0; ks < 2; ++ks) pf[ks] = pack8(cbt[8 * ks], cbt[8 * ks + 1], cbt[8 * ks + 2], cbt[8 * ks + 3], cbt[8 * ks + 4], cbt[8 * ks + 5], cbt[8 * ks + 6], cbt[8 * ks + 7]);
#pragma unroll
            for (int pt = 0; pt < 2; ++pt)
#pragma unroll
                for (int ks = 0; ks < 2; ++ks) { v4u a; a.x = xf[st][pt][ks][0].x; a.y = xf[st][pt][ks][0].y; a.z = xf[st][pt][ks][1].x; a.w = xf[st][pt][ks][1].y; y[pt] = MFMA32(__builtin_bit_cast(bf16x8, a), pf[ks], y[pt]); }
        }
#pragma unroll
        for (int pt = 0; pt < 2; ++pt)
#pragma unroll
            for (int q = 0; q < 4; ++q) { const u32x2 xx = xd[pt][q];
                const unsigned o0 = cvtpk(y[pt][4 * q] + D * bflo(xx.x), y[pt][4 * q + 1] + D * bfhi(xx.x)), o1 = cvtpk(y[pt][4 * q + 2] + D * bflo(xx.y), y[pt][4 * q + 3] + D * bfhi(xx.y));
                *(u32x2*)(yssm + (m0 + crw) * 512 + h * 64 + 32 * pt + 8 * q + 4 * hi) = (u32x2){o0, o1}; }
    }
#undef S3TAB
}
__device__ __forceinline__ void ssd_s1_unit(int unit, int lane, LAS float* tab, const bf16_t* __restrict__ xst, const bf16_t* __restrict__ bt, const float* __restrict__ dt, const float* __restrict__ a_log,
                                            float* __restrict__ sloc, float* __restrict__ asum) {
    const int h = unit & 7, c = (unit >> 3) & 15, b = unit >> 7, g = h >> 2, l0 = c * 128, l31 = lane & 31, hi = lane >> 5;
    const size_t m0 = (size_t)b * SEQ + l0;
    const float A = -expf(a_log[h]);
    const float d0 = dt[(m0 + lane) * 8 + h], d1 = dt[(m0 + 64 + lane) * 8 + h];
    float ac0 = d0 * A, ac1 = d1 * A;
    scan128(ac0, ac1, lane);
    const float aend = rl(ac1, 63);
    tab[lane] = __expf(aend - ac0) * d0; tab[64 + lane] = __expf(aend - ac1) * d1;
    if (lane == 0) asum[unit] = aend;
    WSYNC();
    f32x16 acc[2][4];
#pragma unroll
    for (int pt = 0; pt < 2; ++pt)
#pragma unroll
        for (int nt = 0; nt < 4; ++nt)
#pragma unroll
            for (int r = 0; r < 16; ++r) acc[pt][nt][r] = 0.f;
    const bf16_t* Xp = xst + ((size_t)(b * 8 + h) * 64 + l31) * SEQ + l0 + 8 * hi;
    const bf16_t* Bp = bt + ((size_t)(b * 2 + g) * 128 + l31) * SEQ + l0 + 8 * hi;
#pragma unroll 2
    for (int kk = 0; kk < 8; ++kk) {
        const f32x4 wa = *(const LAS f32x4*)(tab + 16 * kk + 8 * hi), wb = *(const LAS f32x4*)(tab + 16 * kk + 8 * hi + 4);
        bf16x8 af[2], bfr[4];
#pragma unroll
        for (int pt = 0; pt < 2; ++pt) { const v4u raw = *(const v4u*)(Xp + (size_t)pt * 32 * SEQ + 16 * kk);
            v4u w; w.x = cvtpk(bflo(raw.x) * wa[0], bfhi(raw.x) * wa[1]); w.y = cvtpk(bflo(raw.y) * wa[2], bfhi(raw.y) * wa[3]);
            w.z = cvtpk(bflo(raw.z) * wb[0], bfhi(raw.z) * wb[1]); w.w = cvtpk(bflo(raw.w) * wb[2], bfhi(raw.w) * wb[3]); af[pt] = __builtin_bit_cast(bf16x8, w); }
#pragma unroll
        for (int nt = 0; nt < 4; ++nt) bfr[nt] = *(const bf16x8*)(Bp + (size_t)nt * 32 * SEQ + 16 * kk);
#pragma unroll
        for (int pt = 0; pt < 2; ++pt)
#pragma unroll
            for (int nt = 0; nt < 4; ++nt) acc[pt][nt] = MFMA32(af[pt], bfr[nt], acc[pt][nt]);
    }
    float* dst = sloc + (size_t)unit * 8192 + l31;
#pragma unroll
    for (int pt = 0; pt < 2; ++pt)
#pragma unroll
        for (int nt = 0; nt < 4; ++nt)
#pragma unroll
            for (int r = 0; r < 16; ++r) dst[(32 * pt + crow(r, hi)) * 128 + 32 * nt] = acc[pt][nt][r];
    WSYNC();
}
__device__ __forceinline__ void ssd_s2_all(const float* __restrict__ sloc, const float* __restrict__ asum, bf16_t* __restrict__ stb, int gtid, int NT) {
    for (int i = gtid; i < 128 * 2048; i += NT) {
        const int bh = i >> 11, e4 = i & 2047, b = bh >> 3, h = bh & 7;
        f32x4 run = {0.f, 0.f, 0.f, 0.f};
#pragma unroll 4
        for (int c = 0; c < 16; ++c) { const int unit = (b * 16 + c) * 8 + h; const f32x4 tmp = *(const f32x4*)(sloc + (size_t)unit * 8192 + e4 * 4);
            uint2 w; w.x = cvtpk(run[0], run[1]); w.y = cvtpk(run[2], run[3]); *(uint2*)(stb + (size_t)unit * 8192 + e4 * 4) = w;
            run = run * __expf(asum[unit]) + tmp; }
    }
}
__device__ __forceinline__ void ssd_s3_unit(int unit, int lane, LAS float* tab, const bf16_t* __restrict__ xbc, const bf16_t* __restrict__ xst, const bf16_t* __restrict__ stb, const float* __restrict__ dt,
                                            const float* __restrict__ a_log, const float* __restrict__ dsk, bf16_t* __restrict__ yssm) {
    const int h = unit & 7, c = (unit >> 3) & 15, b = unit >> 7, g = h >> 2, l0 = c * 128, l31 = lane & 31, hi = lane >> 5;
    const size_t m0 = (size_t)b * SEQ + l0;
    const float A = -expf(a_log[h]), D = dsk[h];
    const float d0 = dt[(m0 + lane) * 8 + h], d1 = dt[(m0 + 64 + lane) * 8 + h];
    float ac0 = d0 * A, ac1 = d1 * A;
    scan128(ac0, ac1, lane);
    tab[lane] = ac0; tab[64 + lane] = ac1; tab[128 + lane] = d0; tab[192 + lane] = d1;
    WSYNC();
    const bf16_t* Cp = xbc + (m0 + l31) * 1024 + 768 + g * 128 + 8 * hi;
    const bf16_t* Sp = stb + (size_t)unit * 8192 + l31 * 128 + 8 * hi;
    const bf16_t* Bp = xbc + (m0 + l31) * 1024 + 512 + g * 128 + 8 * hi;
    const bf16_t* Xp = xst + ((size_t)(b * 8 + h) * 64 + l31) * SEQ + l0 + 4 * hi;
    LAS float* tr = tab + 256;
    const int row = lane >> 1, p0 = (lane & 1) * 16;
#pragma unroll 1
    for (int lt = 0; lt < 4; ++lt) {
        f32x16 y[2];
#pragma unroll
        for (int r = 0; r < 16; ++r) { y[0][r] = 0.f; y[1][r] = 0.f; }
        const float acl = tab[32 * lt + l31];
        bf16x8 cfr[8];
#pragma unroll
        for (int kk = 0; kk < 8; ++kk) cfr[kk] = *(const bf16x8*)(Cp + (size_t)lt * 32 * 1024 + 16 * kk);
        {   bf16x8 s0[8], s1[8];
#pragma unroll
            for (int kk = 0; kk < 8; ++kk) { s0[kk] = *(const bf16x8*)(Sp + 16 * kk); s1[kk] = *(const bf16x8*)(Sp + 32 * 128 + 16 * kk); }
#pragma unroll
            for (int kk = 0; kk < 8; ++kk) { y[0] = MFMA32(s0[kk], cfr[kk], y[0]); y[1] = MFMA32(s1[kk], cfr[kk], y[1]); }
        }
        { const float el = __expf(acl);
#pragma unroll
          for (int r = 0; r < 16; ++r) { y[0][r] *= el; y[1][r] *= el; } }
#pragma unroll 1
        for (int st = 0; st <= lt; ++st) {
            bf16x8 bfr[8]; u32x2 xf[2][2][2];
#pragma unroll
            for (int kk = 0; kk < 8; ++kk) bfr[kk] = *(const bf16x8*)(Bp + (size_t)st * 32 * 1024 + 16 * kk);
#pragma unroll
            for (int pt = 0; pt < 2; ++pt)
#pragma unroll
                for (int ks = 0; ks < 2; ++ks) { const bf16_t* xp = Xp + (size_t)pt * 32 * SEQ + st * 32 + 16 * ks; xf[pt][ks][0] = *(const u32x2*)xp; xf[pt][ks][1] = *(const u32x2*)(xp + 8); }
            f32x16 cbt;
#pragma unroll
            for (int r = 0; r < 16; ++r) cbt[r] = 0.f;
#pragma unroll
            for (int kk = 0; kk < 8; ++kk) cbt = MFMA32(bfr[kk], cfr[kk], cbt);
#pragma unroll
            for (int r = 0; r < 16; ++r) { const int sl = 32 * st + crow(r, hi); const float acs = tab[sl], dts = tab[128 + sl];
                float v = cbt[r] * __expf(acl - acs) * dts; if (st == lt && crow(r, hi) > l31) v = 0.f; cbt[r] = v; }
            bf16x8 pf[2];
#pragma unroll
            for (int ks = 0; ks < 2; ++ks) pf[ks] = pack8(cbt[8 * ks], cbt[8 * ks + 1], cbt[8 * ks + 2], cbt[8 * ks + 3], cbt[8 * ks + 4], cbt[8 * ks + 5], cbt[8 * ks + 6], cbt[8 * ks + 7]);
#pragma unroll
            for (int pt = 0; pt < 2; ++pt)
#pragma unroll
                for (int ks = 0; ks < 2; ++ks) { v4u a; a.x = xf[pt][ks][0].x; a.y = xf[pt][ks][0].y; a.z = xf[pt][ks][1].x; a.w = xf[pt][ks][1].y; y[pt] = MFMA32(__builtin_bit_cast(bf16x8, a), pf[ks], y[pt]); }
        }
#pragma unroll
        for (int pt = 0; pt < 2; ++pt) {
#pragma unroll
            for (int r = 0; r < 16; ++r) tr[l31 * 33 + crow(r, hi)] = y[pt][r];
            WSYNC();
            const size_t m = m0 + 32 * lt + row;
            const v4u xa = *(const v4u*)(xbc + m * 1024 + h * 64 + 32 * pt + p0), xb = *(const v4u*)(xbc + m * 1024 + h * 64 + 32 * pt + p0 + 8);
            const unsigned xu[8] = {xa.x, xa.y, xa.z, xa.w, xb.x, xb.y, xb.z, xb.w};
            unsigned ow[8];
#pragma unroll
            for (int q = 0; q < 8; ++q) { const float v0 = tr[row * 33 + p0 + 2 * q] + D * bflo(xu[q]), v1 = tr[row * 33 + p0 + 2 * q + 1] + D * bfhi(xu[q]); ow[q] = cvtpk(v0, v1); }
            bf16_t* dst = yssm + m * 512 + h * 64 + 32 * pt + p0;
            *(v4u*)dst = (v4u){ow[0], ow[1], ow[2], ow[3]}; *(v4u*)(dst + 8) = (v4u){ow[4], ow[5], ow[6], ow[7]};
            WSYNC();
        }
    }
}


__device__ __forceinline__ float sum8(float x) { x += dpp_mov<0xB1>(x); x += dpp_mov<0x4E>(x); x += dpp_mov<0x141>(x); return x; }
__device__ __forceinline__ float sum32(float x, int lane) { x = rowsum16(x); return x + bperm(lane ^ 16, x); }
__device__ __forceinline__ void unpack8(const v4u& w, float (&f)[8]) { f[0] = bflo(w.x); f[1] = bfhi(w.x); f[2] = bflo(w.y); f[3] = bfhi(w.y); f[4] = bflo(w.z); f[5] = bfhi(w.z); f[6] = bflo(w.w); f[7] = bfhi(w.w); }
__device__ __forceinline__ void ssm_gate_norm_vec(const bf16_t* __restrict__ yssm, const bf16_t* __restrict__ proj, const float* __restrict__ ng, bf16_t* __restrict__ ymix, int m0, int m1, int w, int nw, int lane) {
    const int c0 = lane * 8;
    float gn[8];
    { const f32x4 a = *(const f32x4*)(ng + c0), b = *(const f32x4*)(ng + c0 + 4); gn[0] = a[0]; gn[1] = a[1]; gn[2] = a[2]; gn[3] = a[3]; gn[4] = b[0]; gn[5] = b[1]; gn[6] = b[2]; gn[7] = b[3]; }
    for (int mb = m0 + w; mb < m1; mb += nw * 4) {
        v4u yv[4], zv[4];
#pragma unroll
        for (int k = 0; k < 4; ++k) { const int m = (mb + k * nw < m1) ? mb + k * nw : mb; yv[k] = *(const v4u*)(yssm + (size_t)m * 512 + c0); zv[k] = *(const v4u*)(proj + (size_t)m * L0P + 1792 + c0); }
#pragma unroll
        for (int k = 0; k < 4; ++k) { const int m = mb + k * nw;
            float y[8], z[8], u[8], q = 0.f; unpack8(yv[k], y); unpack8(zv[k], z);
#pragma unroll
            for (int j = 0; j < 8; ++j) { u[j] = y[j] * z[j] * __builtin_amdgcn_rcpf(1.f + __builtin_amdgcn_exp2f(-1.4426950408889634f * z[j])); q += u[j] * u[j]; }
            const float rs = __builtin_amdgcn_rsqf(sum32(q, lane) * (1.f / 256.f) + 1e-5f);
            v4u o; o.x = cvtpk(u[0] * rs * gn[0], u[1] * rs * gn[1]); o.y = cvtpk(u[2] * rs * gn[2], u[3] * rs * gn[3]); o.z = cvtpk(u[4] * rs * gn[4], u[5] * rs * gn[5]); o.w = cvtpk(u[6] * rs * gn[6], u[7] * rs * gn[7]);
            if (m < m1) *(v4u*)(ymix + (size_t)m * DM + 512 + c0) = o; }
    }
}
__device__ __forceinline__ void rwkv_post_vec(const float* __restrict__ yraw, const bf16_t* __restrict__ proj, const float* __restrict__ mix, const float* __restrict__ bonus, const bf16_t* __restrict__ gbuf,
                                              const float* __restrict__ ln_g, const float* __restrict__ ln_b, bf16_t* __restrict__ ymix, int gw, int NGW, int lane) {
    const int c0 = lane * 8, h = lane >> 3;
    float lg[8], lb[8], mx[8];
    { const f32x4 a = *(const f32x4*)(ln_g + c0), b = *(const f32x4*)(ln_g + c0 + 4), c = *(const f32x4*)(ln_b + c0), d = *(const f32x4*)(ln_b + c0 + 4), e = *(const f32x4*)(mix + 1024 + c0), f = *(const f32x4*)(mix + 1024 + c0 + 4);
#pragma unroll
      for (int j = 0; j < 4; ++j) { lg[j] = a[j]; lg[4 + j] = b[j]; lb[j] = c[j]; lb[4 + j] = d[j]; mx[j] = e[j]; mx[4 + j] = f[j]; } }
    for (int mb = gw; mb < M; mb += NGW * 2) {
        f32x4 ya[2], yb[2]; v4u cv[2], pv[2], gv[2]; float bo[2];
#pragma unroll
        for (int k = 0; k < 2; ++k) { const int m = mb + k * NGW; const bool hp = (m & (SEQ - 1)) != 0;
            ya[k] = *(const f32x4*)(yraw + (size_t)m * 512 + c0); yb[k] = *(const f32x4*)(yraw + (size_t)m * 512 + c0 + 4);
            cv[k] = *(const v4u*)(proj + (size_t)m * L0P + 1024 + c0); pv[k] = *(const v4u*)(proj + (size_t)(hp ? m - 1 : m) * L0P + 1024 + c0);
            gv[k] = *(const v4u*)(gbuf + (size_t)m * 512 + c0); bo[k] = bonus[(size_t)m * 8 + h]; }
#pragma unroll
        for (int k = 0; k < 2; ++k) { const int m = mb + k * NGW; const float pz = ((m & (SEQ - 1)) != 0) ? 1.f : 0.f;
            float y[8] = {ya[k][0], ya[k][1], ya[k][2], ya[k][3], yb[k][0], yb[k][1], yb[k][2], yb[k][3]}, cc[8], pp[8], gg[8];
            unpack8(cv[k], cc); unpack8(pv[k], pp); unpack8(gv[k], gg);
            float sm = 0.f;
#pragma unroll
            for (int j = 0; j < 8; ++j) sm += y[j];
            const float mu = sum8(sm) * (1.f / 64.f);
            float qv = 0.f;
#pragma unroll
            for (int j = 0; j < 8; ++j) { y[j] -= mu; qv += y[j] * y[j]; }
            const float rs = __builtin_amdgcn_rsqf(sum8(qv) * (1.f / 64.f) + 64e-5f);
            float o[8];
#pragma unroll
            for (int j = 0; j < 8; ++j) { const float vs = cc[j] + (pp[j] * pz - cc[j]) * mx[j]; o[j] = (y[j] * rs * lg[j] + lb[j] + bo[k] * vs) * gg[j]; }
            v4u w; w.x = cvtpk(o[0], o[1]); w.y = cvtpk(o[2], o[3]); w.z = cvtpk(o[4], o[5]); w.w = cvtpk(o[6], o[7]);
            *(v4u*)(ymix + (size_t)m * DM + c0) = w; }
    }
}

struct Args { const float* in[43]; float* out; unsigned char* ws; };
#define GEMM_PHASE(EPI, Aptr, LDA, Bptr, LDB, NN, KK, ...) do { pg8::Gemm g_{(Aptr), (Bptr), M, (NN), (KK), (LDA), (LDB)}; pg8::StaticOrder S_; S_.init(M, (NN), G, (int)blockIdx.x); \
        pg8::EPI E_{__VA_ARGS__}; pg8::gemm_phase<pg8::EPI, pg8::StaticOrder, true, true>(lds3, g_, S_, E_); } while (0)

__global__ void __launch_bounds__(NWAVES * 64, 2) fwd_mega(Args args) {
    extern __shared__ __attribute__((aligned(16))) unsigned char lds[];
    LAS unsigned char* lds3 = (LAS unsigned char*)lds;
    volatile LAS unsigned* MISC = (volatile LAS unsigned*)(lds3 + MISC_OFF);
    const int G = gridDim.x, NGW = G * NWAVES, NT = G * NWAVES * 64;
#define PHASE_IDS() int tid = threadIdx.x; asm volatile("" : "+v"(tid)); const int lane = tid & 63, wave = __builtin_amdgcn_readfirstlane(tid >> 6); const int gw = blockIdx.x * NWAVES + wave, gtid = blockIdx.x * (NWAVES * 64) + tid; (void)lane; (void)gw; (void)gtid
    unsigned char* ws = args.ws;
    gu32* ctl = (gu32*)(ws + WS_CTL);
    for (int u = threadIdx.x; u < (LDS_BYTES - LDSCTL_OFF) / 4; u += NWAVES * 64) ((LAS unsigned*)(lds3 + LDSCTL_OFF))[u] = 0u;
    __syncthreads();
    XcdBarrier bar = xcd_barrier_post((unsigned*)(ctl + CW_BAR), MISC + 8);
#if defined(PROBE_STAMPS)
    int nb_ = 0;
    if (blockIdx.x == 0 && threadIdx.x == 0) MISC[16] = (unsigned)__builtin_amdgcn_s_memrealtime();
#define GRID_BAR() do { xcd_barrier(bar); ++nb_; if (blockIdx.x == 0 && threadIdx.x == 0) MISC[16 + nb_] = (unsigned)__builtin_amdgcn_s_memrealtime(); } while (0)
#else
#define GRID_BAR() xcd_barrier(bar)
#endif
#define IN(i) (args.in[i])
    float* out = args.out;
    bf16_t* W0in = (bf16_t*)(ws + WS_W0IN); bf16_t* W0out = (bf16_t*)(ws + WS_W0OUT); bf16_t* Wup0 = (bf16_t*)(ws + WS_WUP0); bf16_t* Wdn0 = (bf16_t*)(ws + WS_WDN0);
    bf16_t* W1in = (bf16_t*)(ws + WS_W1IN); bf16_t* Wuq = (bf16_t*)(ws + WS_WUQ); bf16_t* Wukv = (bf16_t*)(ws + WS_WUKV); bf16_t* W1out = (bf16_t*)(ws + WS_W1OUT);
    bf16_t* Wup1 = (bf16_t*)(ws + WS_WUP1); bf16_t* Wdn1 = (bf16_t*)(ws + WS_WDN1);
    bf16_t* XB = (bf16_t*)(ws + WS_XB); bf16_t* YMIX = (bf16_t*)(ws + WS_YMIX); bf16_t* PROJ0 = (bf16_t*)(ws + WS_BIG);
    float* YRAW = out; bf16_t* YSSM = (bf16_t*)(out + (size_t)M * 512); bf16_t* STB = (bf16_t*)(out + (size_t)M * 768); bf16_t* XST = (bf16_t*)(ws + WS_XST); bf16_t* BT = (bf16_t*)(ws + WS_BT); float* ASUM = (float*)(ws + WS_ASUM); float* SLOC = (float*)(ws + WS_SLOC); float* DT = (float*)(ws + WS_DT); bf16_t* GB = (bf16_t*)(ws + WS_G); float* BONUS = (float*)(ws + WS_BONUS);
    bf16_t* W2T = (bf16_t*)(ws + WS_W2T); bf16_t* A2T = (bf16_t*)(ws + WS_A2T); bf16_t* G2T = (bf16_t*)(ws + WS_G2T); bf16_t* ACT = (bf16_t*)(ws + WS_GU); bf16_t* HALO = (bf16_t*)(ws + WS_GU + 176 * MiB);
    bf16_t* PROJ1 = (bf16_t*)(ws + WS_PROJ1); bf16_t* QM = (bf16_t*)(ws + WS_QM); bf16_t* KVM = (bf16_t*)(ws + WS_KVM); bf16_t* KPE = (bf16_t*)(ws + WS_KPE); float* RS = (float*)(ws + WS_RS); float* CSTAB = (float*)(ws + WS_CSTAB); float* STATS = (float*)(ws + WS_CSTAB + 4 * MiB); bf16_t* VTS = (bf16_t*)(ws + WS_VTS); bf16_t* VTM = (bf16_t*)(ws + WS_VTM);
    const int* pos = (const int*)args.in[1];

    {
        PHASE_IDS();
    {
        LAS float* scr = (LAS float*)(lds3 + wave * 16384); int trb = 0;
        transpose_matrix(IN(2), 1024, 3336, W0in, L0P, 1024, scr, gw, NGW, lane, nullptr, trb);
        transpose_matrix(IN(20), 1024, 1024, W0out, 1024, 1024, scr, gw, NGW, lane, nullptr, trb);
        transpose_matrix(IN(5), 64, 512, W2T, 512, 64, scr, gw, NGW, lane, nullptr, trb);
        transpose_matrix(IN(7), 64, 512, A2T, 512, 64, scr, gw, NGW, lane, nullptr, trb);
        transpose_matrix(IN(8), 128, 512, G2T, 512, 128, scr, gw, NGW, lane, nullptr, trb);
        const float* x = IN(0);
        {
            constexpr size_t TOT4 = (size_t)M * DM / 4;
            for (size_t i = gtid; i < TOT4; i += (size_t)NT * 8) {
                f32x4 v[8];
#pragma unroll
                for (int u = 0; u < 8; ++u) v[u] = *(const f32x4*)(x + (i + (size_t)u * NT) * 4);
#pragma unroll
                for (int u = 0; u < 8; ++u) { uint2 w; w.x = cvtpk(v[u][0], v[u][1]); w.y = cvtpk(v[u][2], v[u][3]); *(uint2*)(XB + (i + (size_t)u * NT) * 4) = w; }
            }
        }
    }
    }
    GRID_BAR();
    {
        PHASE_IDS();
    GEMM_PHASE(EpiBf16S, XB, DM, W0in, 1024, L0P, 1024, PROJ0, nullptr, L0P, 0);
    }
    GRID_BAR();
    {
        PHASE_IDS();
        const int blk = (int)blockIdx.x, m0 = blk * 128;
        {   LAS bf16_t* scr = (LAS bf16_t*)(lds3 + wave * 16384);
#pragma unroll 1
            for (int k = 0; k < 4; ++k) ssd_conv_tile((2 * blk + (k & 1)) * 16 + wave + 8 * (k >> 1), lane, scr, PROJ0, IN(14), IN(15), XB, XST, BT);
            for (int i = tid; i < 1024; i += NWAVES * 64) { const int m = m0 + (i >> 3); DT[(size_t)m * 8 + (i & 7)] = softplusf_(bf2f(PROJ0[(size_t)m * L0P + 3328 + (i & 7)]) + IN(16)[i & 7]); }
        }
        __syncthreads();
#if defined(PROBE_STAMPS)
        if (blockIdx.x == 0 && threadIdx.x == 0) MISC[16 + 29] = (unsigned)__builtin_amdgcn_s_memrealtime();
#endif
        ssd_s1_unit(blk * 8 + wave, lane, (LAS float*)(lds3 + wave * 16384), XST, BT, DT, IN(17), SLOC, ASUM);
    }
    GRID_BAR();
    {
        PHASE_IDS();
        ssd_s2_all(SLOC, ASUM, STB, gtid, NT);
    }
    GRID_BAR();
    {
        PHASE_IDS();
        const int blk = (int)blockIdx.x;
        if (blk < 128) {
            rwkv_phase_chain((LAS float*)lds3, tid, lane, wave, blk, PROJ0, IN(3), IN(4), IN(6), IN(9), IN(10), IN(11), W2T, A2T, G2T, YRAW, GB, BONUS);
#if defined(PROBE_STAMPS)
            if (blk == 0 && threadIdx.x == 0) MISC[16 + 23] = (unsigned)__builtin_amdgcn_s_memrealtime();
#endif
        } else {
            const int bc0 = (blk - 128) * 2;
#if defined(PROBE_STAMPS)
            const unsigned tu0_ = (unsigned)__builtin_amdgcn_s_memrealtime();
#endif
            {
                const int gwu = (blk - 128) * NWAVES + wave;
                gate_lora_wave(gwu, 128 * NWAVES, lane, PROJ0, IN(3), G2T, GB);
            }
#if defined(PROBE_STAMPS)
            __syncthreads(); if (blk == 128 && threadIdx.x == 0) __hip_atomic_store(ctl + 2049, (unsigned)__builtin_amdgcn_s_memrealtime() - tu0_, __ATOMIC_RELAXED, __HIP_MEMORY_SCOPE_AGENT);
#endif
#pragma unroll 1
            for (int u = 0; u < 2; ++u) ssd_s3_block(bc0 + u, tid, lane, wave, lds3, XB, XST, STB, DT, IN(17), IN(18), YSSM);
            __syncthreads();
#if defined(PROBE_STAMPS)
            __syncthreads(); if (blk == 128 && threadIdx.x == 0) __hip_atomic_store(ctl + 2050, (unsigned)__builtin_amdgcn_s_memrealtime() - tu0_, __ATOMIC_RELAXED, __HIP_MEMORY_SCOPE_AGENT);
#endif
            ssm_gate_norm_vec(YSSM, PROJ0, IN(19), YMIX, bc0 * 128, bc0 * 128 + 256, wave, NWAVES, lane);
#if defined(PROBE_STAMPS)
            __syncthreads(); if (blk == 128 && threadIdx.x == 0) __hip_atomic_store(ctl + 2051, (unsigned)__builtin_amdgcn_s_memrealtime() - tu0_, __ATOMIC_RELAXED, __HIP_MEMORY_SCOPE_AGENT);
#endif
            { const int gwu = (blk - 128) * NWAVES + wave, NGWU = 128 * NWAVES; LAS float* scr = (LAS float*)(lds3 + wave * 16384); int trb = 0;
              transpose_matrix(IN(23), 1024, 5632, Wup0, 5632, 1024, scr, gwu, NGWU, lane, nullptr, trb, true);
              transpose_matrix(IN(26), 2816, 1024, Wdn0, 1024, 2816, scr, gwu, NGWU, lane, nullptr, trb);
            }
#if defined(PROBE_STAMPS)
            __syncthreads(); if (blk == 128 && threadIdx.x == 0) __hip_atomic_store(ctl + 2048, (unsigned)__builtin_amdgcn_s_memrealtime() - tu0_, __ATOMIC_RELAXED, __HIP_MEMORY_SCOPE_AGENT);
#endif
        }
    }
    GRID_BAR();
    {
        PHASE_IDS();
        rwkv_post_vec(YRAW, PROJ0, IN(3), BONUS, GB, IN(12), IN(13), YMIX, gw, NGW, lane);
    }
    GRID_BAR();
    {
        PHASE_IDS();
    GEMM_PHASE(EpiResid, YMIX, DM, W0out, 1024, 1024, 1024, IN(0), out, ALPHA, 0);
    }
    GRID_BAR();
    {
        PHASE_IDS();
    ln_rows<1>(out, XB, STATS, IN(21), IN(22), gw, NGW, lane);
    }
    GRID_BAR();
    {
        PHASE_IDS();
        { pg8::Gemm g_{XB, Wup0, M / 32, DFF, 1024, DM, 1024, 4096, 8192, 256, 512, 1}; pg8::StaticOrder S_; S_.init(M / 32, DFF, G, (int)blockIdx.x);
          pg8::EpiBf16S E_{HALO, nullptr, DFF, 0}; pg8::gemm_phase<pg8::EpiBf16S, pg8::StaticOrder, true, true>(lds3, g_, S_, E_); }
        if ((int)blockIdx.x >= 44) {
            const int gwu = ((int)blockIdx.x - 44) * NWAVES + wave, NGWU = (G - 44) * NWAVES; LAS float* scr = (LAS float*)(lds3 + wave * 16384); int trb = 0;
            transpose_matrix(IN(29), 1024, 1952, W1in, L1P, 1024, scr, gwu, NGWU, lane, nullptr, trb);
            transpose_matrix(IN(31), 256, 768, Wuq, 768, 256, scr, gwu, NGWU, lane, IN(30), trb);
            transpose_matrix(IN(33), 128, 1024, Wukv, 1024, 256, scr, gwu, NGWU, lane, IN(32), trb);
            transpose_matrix(IN(34), 1024, 1024, W1out, 1024, 1024, scr, gwu, NGWU, lane, nullptr, trb);
            transpose_matrix(IN(37), 1024, 5632, Wup1, 5632, 1024, scr, gwu, NGWU, lane, nullptr, trb, true);
            transpose_matrix(IN(40), 2816, 1024, Wdn1, 1024, 2816, scr, gwu, NGWU, lane, nullptr, trb);
            for (int i = gwu * 64 + lane; i < 1024 * 16; i += NGWU * 64) { const int n = i >> 4, c = i & 15; *(v4u*)(Wukv + (size_t)n * 256 + 128 + c * 8) = (v4u){0u, 0u, 0u, 0u}; }
        }
    }
    GRID_BAR();
    {
        PHASE_IDS();
        { pg8::Gemm g_{XB, Wup0, M, 2 * DFF, 1024, DM, 1024}; pg8::StaticOrder S_; S_.init(M, 2 * DFF, G, (int)blockIdx.x);
          pg8::EpiConvAct E_{ACT, HALO, IN(24), IN(25), DFF, SEQ}; pg8::gemm_phase<pg8::EpiConvAct, pg8::StaticOrder, true, true>(lds3, g_, S_, E_); }
    }
    GRID_BAR();
    {
        PHASE_IDS();
    GEMM_PHASE(EpiResidLN, ACT, DFF, Wdn0, DFF, 1024, DFF, out, STATS, IN(21), IN(22), ALPHA, 0);
    }
    GRID_BAR();
    {
        PHASE_IDS();
    ln_rows<1>(out, XB, STATS, IN(27), IN(28), gw, NGW, lane);
    }
    GRID_BAR();
    {
        PHASE_IDS();
    GEMM_PHASE(EpiBf16S, XB, DM, W1in, 1024, L1P, 1024, PROJ1, nullptr, L1P, 0);
    }
    GRID_BAR();
    {
        PHASE_IDS();
    mla_prep_all(PROJ1, pos, RS, KPE, CSTAB, gw, NGW, lane);
    }
    GRID_BAR();
    {
        PHASE_IDS();
    GEMM_PHASE(EpiBf16S, PROJ1 + 1536, L1P, Wuq, 256, 768, 256, QM, RS, 768, 2);
    GEMM_PHASE(EpiBf16S, PROJ1 + 1792, L1P, Wukv, 256, 1024, 256, KVM, RS + 1, 1024, 2);
    }
    GRID_BAR();
    {
        PHASE_IDS();
    rope_q_all(QM, CSTAB, gtid, NT);
    {
        LAS bf16_t* scr = (LAS bf16_t*)(lds3 + wave * 16384);
        for (int it = gw; it < 8192; it += NGW) { const int which = it >> 12, r = it & 4095, bh = r >> 5, tt = r & 31, b = bh >> 3, h = bh & 7;
            if (which == 0) transpose_tile64(PROJ1 + ((size_t)b * SEQ + tt * 64) * L1P + 1024 + h * 64, L1P, VTS + (size_t)bh * 64 * SEQ + tt * 64, SEQ, scr, lane);
            else            transpose_tile64(KVM + ((size_t)b * SEQ + tt * 64) * 1024 + h * 128 + 64, 1024, VTM + (size_t)bh * 64 * SEQ + tt * 64, SEQ, scr, lane); }
    }
    }
    GRID_BAR();
    {
        PHASE_IDS();
    {
        { LAS unsigned char* wl = lds3 + wave * 16384;
          for (int g2 = gw; g2 < 2048; g2 += NGW) { const int bh = g2 >> 4, w = g2 & 15;
#pragma unroll 1
              for (int i = 0; i < 4; ++i) { const int qb = (i == 0) ? w : (i == 1) ? 31 - w : (i == 2) ? 32 + w : 63 - w; sb_wave(bh, qb, lane, PROJ1, VTS, YMIX, wl); } } }
        __syncthreads();
        for (int g2 = (int)blockIdx.x; g2 < 256; g2 += G) { const int bh = g2 >> 1, part = g2 & 1;
#pragma unroll 1
            for (int i = 0; i < 4; ++i) { const int sbk = part ? ((i == 0) ? 1 : (i == 1) ? 6 : (i == 2) ? 2 : 5) : ((i == 0) ? 0 : (i == 1) ? 7 : (i == 2) ? 3 : 4);
                mla_block(bh, sbk, tid, lane, wave, lds3, QM, KVM, KPE, VTM, YMIX); } }
    }
    }
    GRID_BAR();
    {
        PHASE_IDS();
    GEMM_PHASE(EpiResidLN, YMIX, DM, W1out, 1024, 1024, 1024, out, STATS, IN(27), IN(28), ALPHA, 0);
    }
    GRID_BAR();
    {
        PHASE_IDS();
    ln_rows<1>(out, XB, STATS, IN(35), IN(36), gw, NGW, lane);
    }
    GRID_BAR();
    {
        PHASE_IDS();
        { pg8::Gemm g_{XB, Wup1, M / 32, DFF, 1024, DM, 1024, 4096, 8192, 256, 512, 1}; pg8::StaticOrder S_; S_.init(M / 32, DFF, G, (int)blockIdx.x);
          pg8::EpiBf16S E_{HALO, nullptr, DFF, 0}; pg8::gemm_phase<pg8::EpiBf16S, pg8::StaticOrder, true, true>(lds3, g_, S_, E_); }
    }
    GRID_BAR();
    {
        PHASE_IDS();
        { pg8::Gemm g_{XB, Wup1, M, 2 * DFF, 1024, DM, 1024}; pg8::StaticOrder S_; S_.init(M, 2 * DFF, G, (int)blockIdx.x);
          pg8::EpiConvAct E_{ACT, HALO, IN(38), IN(39), DFF, SEQ}; pg8::gemm_phase<pg8::EpiConvAct, pg8::StaticOrder, true, true>(lds3, g_, S_, E_); }
    }
    GRID_BAR();
    {
        PHASE_IDS();
    GEMM_PHASE(EpiResidLN, ACT, DFF, Wdn1, DFF, 1024, DFF, out, STATS, IN(35), IN(36), ALPHA, 0);
    }
    GRID_BAR();
    {
        PHASE_IDS();
    ln_rows<2>(out, XB, STATS, IN(41), IN(42), gw, NGW, lane);
    #if defined(PROBE_STAMPS)
    __syncthreads();
    if (blockIdx.x == 0 && threadIdx.x == 0) {
        MISC[16 + 22] = (unsigned)__builtin_amdgcn_s_memrealtime();
#if defined(PROBE_GLOBAL)
#ifndef PROBE_GIDX
#define PROBE_GIDX 0
#endif
        const unsigned d1 = __hip_atomic_load(ctl + 2048 + PROBE_GIDX, __ATOMIC_RELAXED, __HIP_MEMORY_SCOPE_AGENT);
#elif defined(PROBE_ACC)
        const unsigned d1 = MISC[16 + PROBE_ACC];
#else
        const unsigned d1 = MISC[16 + PROBE_T1_HI] - MISC[16 + PROBE_T1_LO];
#endif
        const unsigned long long spin = 100ull * d1;
        const unsigned long long t0 = __builtin_amdgcn_s_memrealtime();
        while (__builtin_amdgcn_s_memrealtime() - t0 < spin) __builtin_amdgcn_s_sleep(8);
    }
#endif
}
}

extern "C" void kernel_launch(void* const* d_in, const int* in_sizes, int n_in, void* d_out, int out_size, void* d_ws, size_t ws_size, hipStream_t stream) {
    static int grid = 0;
    if (grid == 0) {
        if (n_in != 43 || ws_size < WS_NEED || out_size != M * DM) { fprintf(stderr, "kernel_launch: unexpected n_in %d / ws %zu / out %d\n", n_in, ws_size, out_size); grid = -1; return; }
        int dev = 0, cus = 0, per_cu = 0;
        if (hipGetDevice(&dev) != hipSuccess || hipDeviceGetAttribute(&cus, hipDeviceAttributeMultiprocessorCount, dev) != hipSuccess) { grid = -1; return; }
        if (hipFuncSetAttribute((const void*)fwd_mega, hipFuncAttributeMaxDynamicSharedMemorySize, LDS_BYTES) != hipSuccess) { fprintf(stderr, "kernel_launch: hipFuncSetAttribute failed\n"); grid = -1; return; }
        if (hipOccupancyMaxActiveBlocksPerMultiprocessor(&per_cu, (const void*)fwd_mega, NWAVES * 64, LDS_BYTES) != hipSuccess || per_cu < 1) fprintf(stderr, "kernel_launch: occupancy query reports %d\n", per_cu);
        (void)hipGetLastError();
        grid = cus;
    }
    if (grid < 0) return;
    (void)hipMemsetAsync((char*)d_ws + WS_CTL, 0, CTL_ZERO_BYTES, stream);
    Args a{};
    for (int i = 0; i < 43; ++i) a.in[i] = (const float*)d_in[i];
    a.out = (float*)d_out; a.ws = (unsigned char*)d_ws;
    hipLaunchKernelGGL(fwd_mega, dim3(grid), dim3(NWAVES * 64), LDS_BYTES, stream, a);
}
```

```cpp
#include <hip/hip_runtime.h>
#include <cstdio>
#include <cstdint>
#include <cmath>
namespace pg8 {
#define PG8_LAS __attribute__((address_space(3)))
typedef unsigned short bf16_t;
typedef short bf16x8 __attribute__((ext_vector_type(8)));
typedef float f32x4 __attribute__((ext_vector_type(4)));
typedef unsigned u32x4 __attribute__((ext_vector_type(4)));
constexpr int BM = 256, BK = 64, HALF = 128, HTB = HALF * BK * 2  , STAGE_BYTES = 8 * HTB, NXCD = 8, WGM = 8;

__host__ __device__ __forceinline__ int lds_byte(int r, int c) { const int st = (r >> 4) * 2 + (c >> 5), rr = r & 15, cc = c & 31, ob = rr * 64 + cc * 2; return st * 1024 + (ob ^ (((ob >> 9) & 1) << 5)); }
__host__ __device__ __forceinline__ void stage_rc(int b, int& R, int& C) { const int st = b / 1024, sb = b % 1024, swz = sb ^ (((sb >> 9) & 1) << 5); R = (st >> 1) * 16 + swz / 64; C = (st & 1) * 32 + (swz % 64) / 2; }
__host__ __device__ __forceinline__ int perm32(int rho) { const int n = rho >> 4, i = rho & 15; return 8 * (i >> 2) + 4 * n + (i & 3); }

struct Unit { int pm, pn; };
struct Gemm { const bf16_t* A; const bf16_t* Bt; int M, N, K, lda, ldb; int hrA = 128, trA = 256, hrB = 128, trB = 256, gatherA = 0; };

struct StaticOrder {
    int nM, nN, nwg, G, c;
    __host__ __device__ void init(int M, int N, int G_, int c_) { nM = M / BM; nN = N / BM; nwg = nM * nN; G = G_; c = c_; }
    __host__ __device__ bool next(int i, Unit& u) const {
        const long L = (long)i * G + c; if (L >= nwg) return false;
        int wgid = (int)L; { const int q = nwg / NXCD, r = nwg % NXCD, xcd = wgid % NXCD, off = wgid / NXCD; wgid = (xcd < r ? xcd * (q + 1) : r * (q + 1) + (xcd - r) * q) + off; }
        const int nig = WGM * nN, gid = wgid / nig, fm = gid * WGM, gsz = (nM - fm) < WGM ? (nM - fm) : WGM;
        u.pm = fm + ((wgid % nig) % gsz); u.pn = (wgid % nig) / gsz; return true;
    }
    __device__ __forceinline__ void a_ready(const Unit&) const {}
    __device__ __forceinline__ void done(const Unit&) const {}
};


__device__ __forceinline__ unsigned cvt_pk_bf16(float lo, float hi) { unsigned r; asm volatile("v_cvt_pk_bf16_f32 %0, %1, %2" : "=v"(r) : "v"(lo), "v"(hi)); return r; }
struct EpiBf16S {
    static constexpr bool PERM = true, AFTER_DRAIN = false;
    bf16_t* O; const float* rowscale; int ldc; int rs_stride;
    __device__ __forceinline__ void operator()(const f32x4 (&acc)[2][2][4][2], const Unit& u, int wr, int wc, int fr, int fq) const {
        const int row0 = u.pm * BM + wr * 64 + fr, col0 = u.pn * BM + wc * 32 + 8 * fq;
#pragma unroll
        for (int ai = 0; ai < 2; ++ai)
#pragma unroll
            for (int m = 0; m < 4; ++m) { const int row = row0 + ai * HALF + m * 16; const float sc = rowscale ? rowscale[(size_t)row * rs_stride] : 1.f;
                bf16_t* rowp = O + (size_t)row * ldc + col0;
#pragma unroll
                for (int bj = 0; bj < 2; ++bj) { const f32x4 v0 = acc[ai][bj][m][0] * sc, v1 = acc[ai][bj][m][1] * sc;
                    u32x4 w; w.x = cvt_pk_bf16(v0[0], v0[1]); w.y = cvt_pk_bf16(v0[2], v0[3]); w.z = cvt_pk_bf16(v1[0], v1[1]); w.w = cvt_pk_bf16(v1[2], v1[3]);
                    *(u32x4*)(rowp + bj * HALF) = w; } }
    }
};
struct EpiResid {
    static constexpr bool PERM = false, AFTER_DRAIN = false;
    const float* hin; bf16_t* hout; float alpha; int pad;
    __device__ __forceinline__ void operator()(const f32x4 (&acc)[2][2][4][2], const Unit& u, int wr, int wc, int fr, int fq) const {
        typedef unsigned u32x2r __attribute__((ext_vector_type(2)));
        const int row0 = u.pm * BM + wr * 64 + fr, col0 = u.pn * BM + wc * 32 + 4 * fq;
#pragma unroll
        for (int ai = 0; ai < 2; ++ai)
#pragma unroll
            for (int m = 0; m < 4; ++m) { const size_t off = (size_t)(row0 + ai * HALF + m * 16) * 1024 + col0;
#pragma unroll
                for (int bj = 0; bj < 2; ++bj)
#pragma unroll
                    for (int n = 0; n < 2; ++n) { const size_t i = off + bj * HALF + n * 16; const f32x4 h = *(const f32x4*)(hin + i); const f32x4 o = h * alpha + acc[ai][bj][m][n];
                        u32x2r w; w.x = cvt_pk_bf16(o[0], o[1]); w.y = cvt_pk_bf16(o[2], o[3]); *(u32x2r*)(hout + i) = w; } }
    }
};

struct EpiResidLN {
    static constexpr bool PERM = false, AFTER_DRAIN = false;
    const bf16_t* hin; bf16_t* hout; const float* stats; const float* g; const float* b; float alpha; int pad;
    __device__ __forceinline__ void operator()(const f32x4 (&acc)[2][2][4][2], const Unit& u, int wr, int wc, int fr, int fq) const {
        typedef unsigned u32x2r __attribute__((ext_vector_type(2)));
        const int row0 = u.pm * BM + wr * 64 + fr, col0 = u.pn * BM + wc * 32 + 4 * fq;
        f32x4 gg[2][2], bb[2][2];
#pragma unroll
        for (int bj = 0; bj < 2; ++bj)
#pragma unroll
            for (int n = 0; n < 2; ++n) { gg[bj][n] = *(const f32x4*)(g + col0 + bj * HALF + n * 16) * alpha; bb[bj][n] = *(const f32x4*)(b + col0 + bj * HALF + n * 16) * alpha; }
#pragma unroll
        for (int ai = 0; ai < 2; ++ai)
#pragma unroll
            for (int m = 0; m < 4; ++m) { const int row = row0 + ai * HALF + m * 16; const size_t off = (size_t)row * 1024 + col0;
                const float mu = stats[2 * row], rs = stats[2 * row + 1];
#pragma unroll
                for (int bj = 0; bj < 2; ++bj)
#pragma unroll
                    for (int n = 0; n < 2; ++n) { const size_t i = off + bj * HALF + n * 16; const u32x2r pw = *(const u32x2r*)(hin + i);
                        f32x4 p; p[0] = __builtin_bit_cast(float, pw.x << 16); p[1] = __builtin_bit_cast(float, pw.x & 0xffff0000u); p[2] = __builtin_bit_cast(float, pw.y << 16); p[3] = __builtin_bit_cast(float, pw.y & 0xffff0000u);
                        const f32x4 o = (p - mu) * rs * gg[bj][n] + bb[bj][n] + acc[ai][bj][m][n];
                        u32x2r w; w.x = cvt_pk_bf16(o[0], o[1]); w.y = cvt_pk_bf16(o[2], o[3]); *(u32x2r*)(hout + i) = w; } }
    }
};

template <int CTRL> __device__ __forceinline__ float pg_dpp(float x) { return __builtin_bit_cast(float, __builtin_amdgcn_update_dpp(0, __builtin_bit_cast(int, x), CTRL, 0xF, 0xF, true)); }
struct EpiConvAct {
    static constexpr bool PERM = true, AFTER_DRAIN = false;
    bf16_t* act; const bf16_t* halo; const float* cw; const float* cb; int dff; int seq;
    __device__ __forceinline__ void operator()(const f32x4 (&acc)[2][2][4][2], const Unit& u, int wr, int wc, int fr, int fq) const {
        typedef unsigned u32x2e __attribute__((ext_vector_type(2)));
#pragma unroll
        for (int n = 0; n < 2; ++n) {
            const int ch0 = u.pn * 128 + wc * 32 + 8 * fq + 4 * n;
            const f32x4 w0 = *(const f32x4*)(cw + ch0), w1 = *(const f32x4*)(cw + dff + ch0), w2 = *(const f32x4*)(cw + 2 * dff + ch0), bb = *(const f32x4*)(cb + ch0);
#pragma unroll
            for (int ai = 0; ai < 2; ++ai) {
                const int rb64 = u.pm * BM + ai * HALF + wr * 64;
                f32x4 P = {0.f, 0.f, 0.f, 0.f};
                if ((rb64 & (seq - 1)) != 0 && fr >= 14) { const u32x2e hv = *(const u32x2e*)(halo + (size_t)(2 * (rb64 / 64 - 1) + (fr - 14)) * dff + ch0);
                    P[0] = __builtin_bit_cast(float, hv.x << 16); P[1] = __builtin_bit_cast(float, hv.x & 0xffff0000u); P[2] = __builtin_bit_cast(float, hv.y << 16); P[3] = __builtin_bit_cast(float, hv.y & 0xffff0000u); }
#pragma unroll
                for (int m = 0; m < 4; ++m) {
                    const f32x4 Gv = acc[ai][0][m][n], Uv = acc[ai][1][m][n];
                    float o[4];
#pragma unroll
                    for (int e = 0; e < 4; ++e) {
                        const float t1 = pg_dpp<0x111>(Gv[e]), t2 = pg_dpp<0x112>(Gv[e]), p1 = pg_dpp<0x10F>(P[e]), p2 = pg_dpp<0x10E>(P[e]);
                        const float g1 = (fr >= 1) ? t1 : p1, g2 = (fr >= 2) ? t2 : p2;
                        const float y = bb[e] + w0[e] * g2 + w1[e] * g1 + w2[e] * Gv[e];
                        o[e] = y * __builtin_amdgcn_rcpf(1.f + __builtin_amdgcn_exp2f(-1.4426950408889634f * y)) * Uv[e];
                    }
                    u32x2e w; w.x = cvt_pk_bf16(o[0], o[1]); w.y = cvt_pk_bf16(o[2], o[3]);
                    *(u32x2e*)(act + (size_t)(rb64 + m * 16 + fr) * dff + ch0) = w;
                    P = Gv;
                }
            }
        }
    }
};

template <class Epi, class Sched, bool ALIGN_EPI = false, bool SP2 = false>
__device__ __forceinline__ void gemm_phase(PG8_LAS unsigned char* lds, const Gemm g, const Sched& S, const Epi& E) {
    int tid = threadIdx.x; asm volatile("" : "+v"(tid));
    const int wid = __builtin_amdgcn_readfirstlane(tid >> 6), lane = tid & 63, wr = wid >> 2, wc = wid & 3, fr = lane & 15, fq = lane >> 4;
    const int K = g.K, nt = K / BK;
    unsigned voffA[2], voffB[2];
#pragma unroll
    for (int i = 0; i < 2; ++i) { int R, C; stage_rc(tid * 16 + i * 8192, R, C); const int Rb = Epi::PERM ? ((R & ~31) + perm32(R & 31)) : R;
        const int Ra = g.gatherA ? (64 * (R >> 1) + 62 + (R & 1)) : R;
        voffA[i] = (unsigned)(Ra * g.lda + C) * 2u; voffB[i] = (unsigned)(Rb * g.ldb + C) * 2u; }
    const size_t kstep = (size_t)(BK * 2);
    const size_t hstepA = (size_t)g.hrA * g.lda * 2, hstepB = (size_t)g.hrB * g.ldb * 2;
    const size_t tstepA = (size_t)g.trA * g.lda * 2, tstepB = (size_t)g.trB * g.ldb * 2;
    const unsigned ldsw = (unsigned)wid * 1024u;
    const int aoff = lds_byte(wr * 64 + fr, fq * 8), boff = lds_byte(wc * 32 + fr, fq * 8);
#define PG8_SA(b, h) (((b) * 2 + (h)) * HTB)
#define PG8_SB(b, h) ((4 + (b) * 2 + (h)) * HTB)
#define PG8_STAGE(bufoff, gbase, voff) do { _Pragma("unroll") for (int _i = 0; _i < 2; ++_i) \
        __builtin_amdgcn_global_load_lds((const unsigned*)((const char*)(gbase) + (voff)[_i]), (PG8_LAS unsigned*)(lds + (bufoff) + ldsw + _i * 8192), 16, 0, 0); } while (0)
#define PG8_LDA(dst, b, h) do { _Pragma("unroll") for (int m = 0; m < 4; ++m) _Pragma("unroll") for (int k = 0; k < 2; ++k) dst[m][k] = *(const PG8_LAS bf16x8*)(lds + PG8_SA(b, h) + aoff + m * 2048 + k * 1024); } while (0)
#define PG8_LDB(dst, b, h) do { _Pragma("unroll") for (int n = 0; n < 2; ++n) _Pragma("unroll") for (int k = 0; k < 2; ++k) dst[n][k] = *(const PG8_LAS bf16x8*)(lds + PG8_SB(b, h) + boff + n * 2048 + k * 1024); } while (0)
#define PG8_MMA(ai, bj, At, Bt) do { __builtin_amdgcn_s_setprio(1); _Pragma("unroll") for (int m = 0; m < 4; ++m) _Pragma("unroll") for (int n = 0; n < 2; ++n) _Pragma("unroll") for (int k = 0; k < 2; ++k) \
        acc[ai][bj][m][n] = __builtin_amdgcn_mfma_f32_16x16x32_bf16(Bt[n][k], At[m][k], acc[ai][bj][m][n], 0, 0, 0); __builtin_amdgcn_s_setprio(0); } while (0)
#define PG8_WAIT_V(n) asm volatile("s_waitcnt vmcnt(" #n ")" ::: "memory")
#define PG8_WAIT_L(n) asm volatile("s_waitcnt lgkmcnt(" #n ")" ::: "memory")
#define PG8_BAR __builtin_amdgcn_s_barrier()
#define PG8_SCHED __builtin_amdgcn_sched_barrier(0)
    Unit cur, nxt; int ui = 0;
    if (!S.next(0, cur)) return;
    f32x4 acc[2][2][4][2];
#pragma unroll
    for (int a = 0; a < 2; ++a)
#pragma unroll
        for (int b = 0; b < 2; ++b)
#pragma unroll
            for (int m = 0; m < 4; ++m)
#pragma unroll
                for (int n = 0; n < 2; ++n) acc[a][b][m][n] = (f32x4){0.f, 0.f, 0.f, 0.f};
    bf16x8 At[4][2], B0[2][2], B1[2][2];
    const char* cA = (const char*)g.A + (size_t)cur.pm * tstepA; const char* cB = (const char*)g.Bt + (size_t)cur.pn * tstepB;
    S.a_ready(cur);
    if constexpr (SP2) {
        PG8_STAGE(PG8_SB(0, 0), cB, voffB); PG8_STAGE(PG8_SB(0, 1), cB + hstepB, voffB); PG8_STAGE(PG8_SA(0, 0), cA, voffA); PG8_STAGE(PG8_SA(0, 1), cA + hstepA, voffA);
        if (wr == 1) PG8_BAR;
        PG8_WAIT_V(2); PG8_BAR;
        PG8_STAGE(PG8_SB(1, 0), cB + kstep, voffB); PG8_STAGE(PG8_SA(1, 0), cA + kstep, voffA); PG8_STAGE(PG8_SB(1, 1), cB + hstepB + kstep, voffB);
        PG8_WAIT_V(6); PG8_BAR;
    } else {
        PG8_STAGE(PG8_SB(0, 0), cB, voffB); PG8_STAGE(PG8_SA(0, 0), cA, voffA); PG8_STAGE(PG8_SB(0, 1), cB + hstepB, voffB); PG8_STAGE(PG8_SA(0, 1), cA + hstepA, voffA);
        if (wr == 1) PG8_BAR;
        PG8_WAIT_V(4); PG8_BAR;
        PG8_STAGE(PG8_SB(1, 0), cB + kstep, voffB); PG8_STAGE(PG8_SA(1, 0), cA + kstep, voffA); PG8_STAGE(PG8_SB(1, 1), cB + hstepB + kstep, voffB);
        PG8_WAIT_V(6); PG8_BAR;
    }
    for (;;) {
        const bool has_next = S.next(ui + 1, nxt);
        const char* nA = has_next ? (const char*)g.A + (size_t)nxt.pm * tstepA : cA; const char* nB = has_next ? (const char*)g.Bt + (size_t)nxt.pn * tstepB : cB;
        for (int t = 0; t < nt; t += 2) {
            const bool last = (t == nt - 2);
            const char* a1 = cA + (size_t)(t + 1) * kstep;
            const char* a2 = last ? nA : cA + (size_t)(t + 2) * kstep; const char* b2 = last ? nB : cB + (size_t)(t + 2) * kstep;
            const char* a3 = a2 + kstep; const char* b3 = b2 + kstep;
            if (last && has_next) S.a_ready(nxt);
            if constexpr (SP2) {
            PG8_LDB(B0, 0, 0); PG8_LDB(B1, 0, 1); PG8_SCHED; PG8_LDA(At, 0, 0); PG8_STAGE(PG8_SA(1, 1), a1 + hstepA, voffA);
            PG8_WAIT_V(8); PG8_WAIT_L(0); PG8_BAR; PG8_MMA(0, 0, At, B0); PG8_MMA(0, 1, At, B1); PG8_BAR; PG8_SCHED;
            PG8_LDA(At, 0, 1); PG8_STAGE(PG8_SB(0, 0), b2, voffB); PG8_STAGE(PG8_SB(0, 1), b2 + hstepB, voffB); PG8_STAGE(PG8_SA(0, 0), a2, voffA);
            PG8_WAIT_V(8); PG8_WAIT_L(0); PG8_BAR; PG8_MMA(1, 0, At, B0); PG8_MMA(1, 1, At, B1); PG8_BAR; PG8_SCHED;
            PG8_LDB(B0, 1, 0); PG8_LDB(B1, 1, 1); PG8_SCHED; PG8_LDA(At, 1, 0); PG8_STAGE(PG8_SA(0, 1), a2 + hstepA, voffA);
            PG8_WAIT_V(8); PG8_WAIT_L(0); PG8_BAR; PG8_MMA(0, 0, At, B0); PG8_MMA(0, 1, At, B1); PG8_BAR; PG8_SCHED;
            PG8_LDA(At, 1, 1); PG8_STAGE(PG8_SB(1, 0), b3, voffB); PG8_STAGE(PG8_SB(1, 1), b3 + hstepB, voffB); PG8_STAGE(PG8_SA(1, 0), a3, voffA);
            PG8_WAIT_V(8); PG8_WAIT_L(0); PG8_BAR; PG8_MMA(1, 0, At, B0); PG8_MMA(1, 1, At, B1); PG8_BAR; PG8_SCHED;
            } else {
            PG8_LDB(B0, 0, 0); PG8_SCHED; PG8_LDA(At, 0, 0); PG8_STAGE(PG8_SA(1, 1), a1 + hstepA, voffA);
            PG8_WAIT_L(8); PG8_BAR; PG8_WAIT_L(0); PG8_MMA(0, 0, At, B0); PG8_BAR; PG8_SCHED;
            PG8_LDB(B1, 0, 1); PG8_STAGE(PG8_SB(0, 0), b2, voffB);
            PG8_BAR; PG8_WAIT_L(0); PG8_MMA(0, 1, At, B1); PG8_BAR;
            PG8_LDA(At, 0, 1); PG8_STAGE(PG8_SA(0, 0), a2, voffA);
            PG8_BAR; PG8_WAIT_L(0); PG8_MMA(1, 0, At, B0); PG8_BAR; PG8_SCHED;
            PG8_STAGE(PG8_SB(0, 1), b2 + hstepB, voffB);
            PG8_WAIT_V(6); PG8_BAR; PG8_MMA(1, 1, At, B1); PG8_BAR;
            PG8_LDB(B0, 1, 0); PG8_SCHED; PG8_LDA(At, 1, 0); PG8_STAGE(PG8_SA(0, 1), a2 + hstepA, voffA);
            PG8_WAIT_L(8); PG8_BAR; PG8_WAIT_L(0); PG8_MMA(0, 0, At, B0); PG8_BAR; PG8_SCHED;
            PG8_LDB(B1, 1, 1); PG8_STAGE(PG8_SB(1, 0), b3, voffB);
            PG8_BAR; PG8_WAIT_L(0); PG8_MMA(0, 1, At, B1); PG8_BAR;
            PG8_LDA(At, 1, 1); PG8_STAGE(PG8_SA(1, 0), a3, voffA);
            PG8_BAR; PG8_WAIT_L(0); PG8_MMA(1, 0, At, B0); PG8_BAR; PG8_SCHED;
            PG8_STAGE(PG8_SB(1, 1), b3 + hstepB, voffB);
            PG8_WAIT_V(6); PG8_BAR; PG8_MMA(1, 1, At, B1); PG8_BAR;
            }
        }
        if constexpr (ALIGN_EPI) { if (wr == 0) PG8_BAR; }
        if constexpr (!Epi::AFTER_DRAIN) { E(acc, cur, wr, wc, fr, fq); S.done(cur); }
        if (!has_next) break;
#pragma unroll
        for (int a = 0; a < 2; ++a)
#pragma unroll
            for (int b = 0; b < 2; ++b)
#pragma unroll
                for (int m = 0; m < 4; ++m)
#pragma unroll
                    for (int n = 0; n < 2; ++n) acc[a][b][m][n] = (f32x4){0.f, 0.f, 0.f, 0.f};
        cur = nxt; cA = nA; cB = nB; ++ui;
        if constexpr (ALIGN_EPI) { if (wr == 1) PG8_BAR; }
    }
    PG8_WAIT_V(0);
    if constexpr (!ALIGN_EPI) { if (wr == 0) PG8_BAR; }
    PG8_BAR;
    if constexpr (Epi::AFTER_DRAIN) { E.fused(acc, cur, wr, wc, fr, fq, lds, wid, lane); S.done(cur); }
#undef PG8_SA
#undef PG8_SB
#undef PG8_STAGE
#undef PG8_LDA
#undef PG8_LDB
#undef PG8_MMA
#undef PG8_WAIT_V
#undef PG8_WAIT_L
#undef PG8_BAR
#undef PG8_SCHED
}
}
#define GAS __attribute__((address_space(1)))
#define LAS __attribute__((address_space(3)))
typedef unsigned short bf16;
typedef unsigned v4u __attribute__((ext_vector_type(4)));
typedef float f32x4 __attribute__((ext_vector_type(4)));
typedef short bf16x8 __attribute__((ext_vector_type(8)));
typedef GAS unsigned gu32;
typedef GAS unsigned long long gu64;
#define RLX_AGENT __ATOMIC_RELAXED, __HIP_MEMORY_SCOPE_AGENT
#define LDS_WAIT() asm volatile("s_waitcnt lgkmcnt(0)" ::: "memory")
#define VM_WAIT() asm volatile("s_waitcnt vmcnt(0)" ::: "memory")
__device__ __forceinline__ unsigned long long rt() { return __builtin_amdgcn_s_memrealtime(); }
__device__ __forceinline__ unsigned f2bf(float f) { unsigned u = __builtin_bit_cast(unsigned, f); return (u + 0x7fffu + ((u >> 16) & 1u)) >> 16; }
__device__ __forceinline__ unsigned pk2(float lo, float hi) { return f2bf(lo) | (f2bf(hi) << 16); }

#define XB_TMO      128
#define XB_XCNT(j)  (256  + 64 * (j))
#define XB_XSUB(j)  (1280 + 64 * (j))
#define XB_XGEN(j)  (2304 + 64 * (j))
#define XB_TOP      3328
#define XB_TOPGEN   3392
#define XCD_BAR_WORDS 3456
#define XB_SPIN_CAP (1u << 18)

__device__ __forceinline__ unsigned xb_ld(unsigned* p)              { return __hip_atomic_load(p, __ATOMIC_RELAXED, __HIP_MEMORY_SCOPE_AGENT); }
__device__ __forceinline__ unsigned xb_add(unsigned* p, unsigned v) { return __hip_atomic_fetch_add(p, v, __ATOMIC_RELAXED, __HIP_MEMORY_SCOPE_AGENT); }
__device__ __forceinline__ unsigned xb_xcc_id() { return (unsigned)__builtin_amdgcn_s_getreg((3 << 11) | 20) & 0xFu; }
#define XB_SPIN(cond, bar) do { unsigned _sp = 0; while (cond) { __builtin_amdgcn_s_sleep(1); \
    if ((++_sp & 255u) == 0u) { if (xb_ld(&(bar)[XB_TMO])) break; if (_sp > XB_SPIN_CAP) { atomicAdd(&(bar)[XB_TMO], 1u); break; } } } } while (0)

struct XcdBarrier {
    unsigned* bar; unsigned x;
    volatile LAS unsigned* st;
};

__device__ __forceinline__ XcdBarrier xcd_barrier_post(unsigned* bar, volatile LAS unsigned* st) {
    XcdBarrier b; b.bar = bar; b.x = xb_xcc_id(); b.st = st;
    if (threadIdx.x == 0) (void)xb_add(&bar[XB_XCNT(b.x)], 1u);
    return b;
}
__device__ __forceinline__ void xcd_barrier_complete(unsigned* bar, unsigned x, unsigned& nloc, unsigned& nx) {
    const unsigned G = gridDim.x * gridDim.y * gridDim.z;
    unsigned sum, cnt, mine, sp = 0u;
    for (;;) {
        sum = 0u; cnt = 0u; mine = 0u;
#pragma unroll
        for (unsigned j = 0; j < 16; ++j) { const unsigned c = xb_ld(&bar[XB_XCNT(j)]); sum += c; cnt += (c > 0u) ? 1u : 0u; mine = (j == x) ? c : mine; }
        if (sum == G) break;
        __builtin_amdgcn_s_sleep(1);
        if ((++sp & 255u) == 0u) { if (xb_ld(&bar[XB_TMO])) break; if (sp > XB_SPIN_CAP) { atomicAdd(&bar[XB_TMO], 1u); break; } }
    }
    nloc = mine > 0u ? mine : 1u; nx = cnt > 0u ? cnt : 1u;
}

__device__ __forceinline__ void xcd_barrier(const XcdBarrier& b) {
    asm volatile("s_waitcnt vmcnt(0)" ::: "memory");
    __syncthreads();
    if (threadIdx.x == 0) {
        unsigned* bar = b.bar;
        __builtin_amdgcn_s_waitcnt(0);
        unsigned nloc = b.st[0], nx = b.st[1];
        if (nloc == 0u) { xcd_barrier_complete(bar, b.x, nloc, nx); b.st[0] = nloc; b.st[1] = nx; }
        const unsigned old = xb_add(&bar[XB_XSUB(b.x)], 1u);
        const unsigned gen = old / nloc;
        if (old + 1u == (gen + 1u) * nloc) {
            __builtin_amdgcn_fence(__ATOMIC_RELEASE, "agent");
            asm volatile("s_waitcnt vmcnt(0)" ::: "memory");
            const unsigned og = xb_add(&bar[XB_TOP], 1u);
            const unsigned tg = og / nx;
            if (og + 1u == (tg + 1u) * nx) xb_add(&bar[XB_TOPGEN], 1u);
            else XB_SPIN(xb_ld(&bar[XB_TOPGEN]) == tg, bar);
            __builtin_amdgcn_fence(__ATOMIC_ACQUIRE, "agent");
            xb_add(&bar[XB_XGEN(b.x)], 1u);
            asm volatile("s_waitcnt vmcnt(0)" ::: "memory");
        } else {
            XB_SPIN(xb_ld(&bar[XB_XGEN(b.x)]) == gen, bar);
            __builtin_amdgcn_fence(__ATOMIC_ACQUIRE, "agent");
            asm volatile("s_waitcnt vmcnt(0)" ::: "memory");
        }
    }
    __syncthreads();
}
constexpr int NWAVES = 8;
constexpr int BATCH = 16, SEQ = 2048, DM = 1024, M = BATCH * SEQ;
constexpr int L0P = 3584;
constexpr int L1P = 2048;
constexpr int DFF = 2816;
constexpr float ALPHA = 1.4142135623730951f;
typedef unsigned short bf16_t;
typedef float f32x16 __attribute__((ext_vector_type(16)));

constexpr size_t MiB = 1u << 20;
constexpr size_t WS_CTL = 0, CTL_ZERO_BYTES = 1 * MiB;
constexpr int CW_BAR = 4096;
constexpr size_t WS_W0IN = 2 * MiB, WS_W0OUT = 9 * MiB, WS_WUP0 = 11 * MiB, WS_WDN0 = 22 * MiB, WS_W1IN = 28 * MiB, WS_WUQ = 32 * MiB, WS_WUKV = 33 * MiB,
                 WS_W1OUT = 34 * MiB, WS_WUP1 = 36 * MiB, WS_WDN1 = 47 * MiB;
constexpr size_t WS_XB = 56 * MiB, WS_YMIX = 120 * MiB, WS_BIG = 184 * MiB;
constexpr size_t WS_G = 408 * MiB, WS_BONUS = 440 * MiB, WS_DT = 441 * MiB, WS_XST = 442 * MiB, WS_BT = 474 * MiB, WS_ASUM = 490 * MiB;
constexpr size_t WS_SLOC = 120 * MiB;
constexpr size_t WS_W2T = 53 * MiB, WS_A2T = 53 * MiB + 256 * 1024, WS_G2T = 53 * MiB + 512 * 1024;
constexpr size_t WS_GU = 120 * MiB;
constexpr size_t WS_PROJ1 = 184 * MiB, WS_QM = 312 * MiB, WS_KVM = 360 * MiB, WS_KPE = 424 * MiB, WS_RS = 426 * MiB;
constexpr size_t WS_CSTAB = 492 * MiB;
constexpr size_t WS_VTS = 428 * MiB, WS_VTM = 460 * MiB;
constexpr size_t WS_NEED = 497 * MiB;

constexpr int RING_BYTES = 131072;
constexpr int LDSCTL_OFF = 146432, MISC_OFF = LDSCTL_OFF + 320;
constexpr int LDS_BYTES = 147456;

__device__ __forceinline__ float bf2f(bf16_t b) { return __builtin_bit_cast(float, (unsigned)b << 16); }
__device__ __forceinline__ float sigmoidf_(float x) { return 1.f / (1.f + expf(-x)); }
__device__ __forceinline__ float softplusf_(float x) { return fmaxf(x, 0.f) + log1pf(expf(-fabsf(x))); }
__device__ __forceinline__ float siluf_(float x) { return x / (1.f + expf(-x)); }
__device__ __forceinline__ float wave_sum(float v) {
#pragma unroll
    for (int o = 1; o < 64; o <<= 1) v += __shfl_xor(v, o);
    return v;
}
#define WSYNC() asm volatile("s_waitcnt lgkmcnt(0)" ::: "memory")
typedef float f32x2_t __attribute__((ext_vector_type(2)));
typedef __bf16 bf16x2_t __attribute__((ext_vector_type(2)));
typedef unsigned u32x2 __attribute__((ext_vector_type(2)));
__device__ __forceinline__ unsigned cvtpk(float lo, float hi) { f32x2_t v = {lo, hi}; bf16x2_t b = __builtin_convertvector(v, bf16x2_t); return __builtin_bit_cast(unsigned, b); }
__device__ __forceinline__ float bflo(unsigned u) { return __builtin_bit_cast(float, u << 16); }
__device__ __forceinline__ float bfhi(unsigned u) { return __builtin_bit_cast(float, u & 0xffff0000u); }
__device__ __forceinline__ bf16_t bf1(float x) { return (bf16_t)(cvtpk(x, x) & 0xffffu); }
__device__ __forceinline__ bf16x8 pack8(float a0, float a1, float a2, float a3, float a4, float a5, float a6, float a7) {
    v4u w; w.x = cvtpk(a0, a1); w.y = cvtpk(a2, a3); w.z = cvtpk(a4, a5); w.w = cvtpk(a6, a7); return __builtin_bit_cast(bf16x8, w); }
template <int CTRL> __device__ __forceinline__ float dpp_mov(float x) { return __builtin_bit_cast(float, __builtin_amdgcn_update_dpp(0, __builtin_bit_cast(int, x), CTRL, 0xF, 0xF, true)); }
__device__ __forceinline__ float rowsum16(float x) { x += dpp_mov<0x128>(x); x += dpp_mov<0x124>(x); x += dpp_mov<0x122>(x); x += dpp_mov<0x121>(x); return x; }
__device__ __forceinline__ float rl(float x, int l) { return __builtin_bit_cast(float, __builtin_amdgcn_readlane(__builtin_bit_cast(int, x), l)); }
__device__ __forceinline__ float wave_sum_dpp(float x) { x = rowsum16(x); return (rl(x, 0) + rl(x, 16)) + (rl(x, 32) + rl(x, 48)); }

__device__ __forceinline__ void transpose_matrix(const float* __restrict__ W, int K, int N, bf16_t* __restrict__ WT, int Npad, int ldt, LAS float* scr, int gw, int NGW, int lane, const float* __restrict__ kscale, int& tr_base, bool ffn_interleave = false) {
    (void)scr;
    const int nblk = Npad / 64, nit = (K / 64) * nblk;
    int it0 = gw - (tr_base % NGW); if (it0 < 0) it0 += NGW; tr_base += nit;
    for (int it = it0; it < nit; it += NGW) {
        const int kb = it / nblk, nb = it - kb * nblk, n = nb * 64 + lane, k0 = kb * 64;
        const bool ok = n < N; const float* src = W + (size_t)k0 * N + (ok ? n : 0);
#pragma unroll
        for (int hc = 0; hc < 2; ++hc) {
            float v[32];
#pragma unroll
            for (int i = 0; i < 32; ++i) v[i] = src[(size_t)(hc * 32 + i) * N];
#pragma unroll
            for (int c = 0; c < 4; ++c) { float u[8];
#pragma unroll
                for (int i = 0; i < 8; ++i) { u[i] = ok ? v[c * 8 + i] : 0.f; if (kscale) u[i] *= kscale[k0 + hc * 32 + c * 8 + i]; }
                v4u o; o.x = cvtpk(u[0], u[1]); o.y = cvtpk(u[2], u[3]); o.z = cvtpk(u[4], u[5]); o.w = cvtpk(u[6], u[7]);
                const int nr = ffn_interleave ? ((n < DFF) ? 256 * (n >> 7) + (n & 127) : 256 * ((n - DFF) >> 7) + 128 + ((n - DFF) & 127)) : n;
                *(v4u*)(WT + (size_t)nr * ldt + k0 + hc * 32 + c * 8) = o; }
        }
    }
}

template <int MODE> __device__ __forceinline__ void ln_rows(const bf16_t* z, bf16_t* hb, float* outf, float* stats, const float* __restrict__ g, const float* __restrict__ b, int gw, int NGW, int lane) {
    for (int row = gw * 2; row < M; row += NGW * 2) {
        const bf16_t* p = z + (size_t)row * DM;
        pg8::u32x4 raw[2][2];
#pragma unroll
        for (int r = 0; r < 2; ++r)
#pragma unroll
            for (int j = 0; j < 2; ++j) raw[r][j] = *(const pg8::u32x4*)(p + r * DM + 8 * lane + 512 * j);
        f32x4 v[2][4]; float s[2] = {0.f, 0.f};
#pragma unroll
        for (int r = 0; r < 2; ++r)
#pragma unroll
            for (int j = 0; j < 2; ++j) {
                v[r][2 * j][0] = __builtin_bit_cast(float, raw[r][j].x << 16); v[r][2 * j][1] = __builtin_bit_cast(float, raw[r][j].x & 0xffff0000u);
                v[r][2 * j][2] = __builtin_bit_cast(float, raw[r][j].y << 16); v[r][2 * j][3] = __builtin_bit_cast(float, raw[r][j].y & 0xffff0000u);
                v[r][2 * j + 1][0] = __builtin_bit_cast(float, raw[r][j].z << 16); v[r][2 * j + 1][1] = __builtin_bit_cast(float, raw[r][j].z & 0xffff0000u);
                v[r][2 * j + 1][2] = __builtin_bit_cast(float, raw[r][j].w << 16); v[r][2 * j + 1][3] = __builtin_bit_cast(float, raw[r][j].w & 0xffff0000u); }
#pragma unroll
        for (int r = 0; r < 2; ++r)
#pragma unroll
            for (int j = 0; j < 4; ++j) s[r] += (v[r][j][0] + v[r][j][1]) + (v[r][j][2] + v[r][j][3]);
        float mean[2], q[2] = {0.f, 0.f}, rstd[2];
#pragma unroll
        for (int r = 0; r < 2; ++r) { mean[r] = wave_sum_dpp(s[r]) * (1.f / DM);
#pragma unroll
            for (int j = 0; j < 4; ++j) { v[r][j] = v[r][j] - mean[r]; q[r] += (v[r][j][0] * v[r][j][0] + v[r][j][1] * v[r][j][1]) + (v[r][j][2] * v[r][j][2] + v[r][j][3] * v[r][j][3]); } }
#pragma unroll
        for (int r = 0; r < 2; ++r) rstd[r] = 1.0f / sqrtf(wave_sum_dpp(q[r]) * (1.f / DM) + 1e-5f);
        if (MODE == 1 && lane < 2) { stats[2 * (row + lane)] = lane ? mean[1] : mean[0]; stats[2 * (row + lane) + 1] = lane ? rstd[1] : rstd[0]; }
#pragma unroll
        for (int j = 0; j < 2; ++j) {
            const int c = 8 * lane + 512 * j;
            const f32x4 g0 = *(const f32x4*)(g + c), g1 = *(const f32x4*)(g + c + 4), b0 = *(const f32x4*)(b + c), b1 = *(const f32x4*)(b + c + 4);
#pragma unroll
            for (int r = 0; r < 2; ++r) {
                const f32x4 o0 = v[r][2 * j] * rstd[r] * g0 + b0, o1 = v[r][2 * j + 1] * rstd[r] * g1 + b1;
                if (MODE == 1) { pg8::u32x4 w; w.x = cvtpk(o0[0], o0[1]); w.y = cvtpk(o0[2], o0[3]); w.z = cvtpk(o1[0], o1[1]); w.w = cvtpk(o1[2], o1[3]); *(pg8::u32x4*)(hb + (size_t)(row + r) * DM + c) = w; }
                else { *(f32x4*)(outf + (size_t)(row + r) * DM + c) = o0; *(f32x4*)(outf + (size_t)(row + r) * DM + c + 4) = o1; }
            }
        }
    }
}

__device__ __forceinline__ void rwkv_naive_chain(int chain, int lane, LAS float* sm, const bf16_t* __restrict__ proj, const float* __restrict__ mix, const float* __restrict__ w0, const float* __restrict__ w2,
                                                 const float* __restrict__ a0, const float* __restrict__ a2, const float* __restrict__ g2, const float* __restrict__ k_k,
                                                 const float* __restrict__ k_a, const float* __restrict__ r_k, const float* __restrict__ ln_g, const float* __restrict__ ln_b, bf16_t* __restrict__ ymix) {
    LAS float* s_w2 = sm; LAS float* s_a2 = sm + 4096; LAS float* s_g2 = sm + 8192; LAS float* s_tw = sm + 16384; LAS float* s_al = s_tw + 64; LAS float* s_sg = s_tw + 128;
    LAS float* s_w = s_tw + 256; LAS float* s_k = s_tw + 320; LAS float* s_a = s_tw + 384; LAS float* s_b = s_tw + 448; LAS float* s_r = s_tw + 512;
    const int b = chain >> 3, h = chain & 7, c = h * 64 + lane;
    for (int l = 0; l < 64; ++l) { s_w2[l * 64 + lane] = w2[l * 512 + c]; s_a2[l * 64 + lane] = a2[l * 512 + c]; }
    for (int l = 0; l < 128; ++l) s_g2[l * 64 + lane] = g2[l * 512 + c];
    const float mr = mix[c], mk = mix[512 + c], mv = mix[1024 + c], mw = mix[1536 + lane], ma = mix[1600 + lane], mg0 = mix[1664 + lane], mg1 = mix[1728 + lane];
    const float w0c = w0[c], a0c = a0[c], kkc = k_k[c], kac = k_a[c], rkc = r_k[c], lgc = ln_g[c], lbc = ln_b[c];
    float S[64];
#pragma unroll
    for (int j = 0; j < 64; ++j) S[j] = 0.f;
    float pr = 0.f, pk = 0.f, pv = 0.f, pw = 0.f, pa = 0.f, pg0 = 0.f, pg1 = 0.f;
    WSYNC();
    for (int t = 0; t < SEQ; ++t) {
        const bf16_t* row = proj + (size_t)(b * SEQ + t) * L0P;
        const float cr = bf2f(row[c]), ck = bf2f(row[512 + c]), cv = bf2f(row[1024 + c]), cw = bf2f(row[1536 + lane]), ca = bf2f(row[1600 + lane]),
                    cg0 = bf2f(row[1664 + lane]), cg1 = bf2f(row[1728 + lane]);
        const float r_s = cr + (pr - cr) * mr, k_s = ck + (pk - ck) * mk, v_s = cv + (pv - cv) * mv;
        const float wl = cw + (pw - cw) * mw, al = ca + (pa - ca) * ma, g0 = cg0 + (pg0 - cg0) * mg0, g1 = cg1 + (pg1 - cg1) * mg1;
        pr = cr; pk = ck; pv = cv; pw = cw; pa = ca; pg0 = cg0; pg1 = cg1;
        s_tw[lane] = tanhf(wl); s_al[lane] = al; s_sg[lane] = sigmoidf_(g0); s_sg[64 + lane] = sigmoidf_(g1);
        WSYNC();
        float wsum = w0c, asum = a0c, gsum = 0.f;
#pragma unroll 2
        for (int l = 0; l < 64; ++l) { wsum += s_tw[l] * s_w2[l * 64 + lane]; asum += s_al[l] * s_a2[l * 64 + lane]; }
#pragma unroll 2
        for (int l = 0; l < 128; ++l) gsum += s_sg[l] * s_g2[l * 64 + lane];
        const float log_w = -softplusf_(-wsum) - 0.5f;
        const float dec = expf(-expf(log_w));
        const float a = sigmoidf_(asum);
        float kkv = k_s * kkc;
        const float nrm = sqrtf(wave_sum(kkv * kkv));
        kkv = kkv / fmaxf(nrm, 1e-12f);
        const float k2 = k_s * (1.f + (a - 1.f) * kac);
        const float bonus_s = wave_sum(r_s * k2 * rkc);
        s_w[lane] = dec; s_k[lane] = k2; s_a[lane] = -kkv; s_b[lane] = kkv * a; s_r[lane] = r_s;
        WSYNC();
        float sa = 0.f;
#pragma unroll
        for (int j = 0; j < 64; ++j) sa += S[j] * s_a[j];
        float y = 0.f;
#pragma unroll
        for (int j = 0; j < 64; ++j) { S[j] = S[j] * s_w[j] + sa * s_b[j] + v_s * s_k[j]; y += S[j] * s_r[j]; }
        const float mu = wave_sum(y) * (1.f / 64.f);
        const float d = y - mu;
        const float var = wave_sum(d * d) * (1.f / 64.f);
        const float yn = d * (1.0f / sqrtf(var + 64e-5f)) * lgc + lbc;
        const float o = (yn + bonus_s * v_s) * gsum;
        ymix[(size_t)(b * SEQ + t) * DM + c] = (bf16_t)f2bf(o);
        WSYNC();
    }
}

__device__ __forceinline__ void ssm_conv_all(const bf16_t* __restrict__ proj, const float* __restrict__ cw, const float* __restrict__ cb, const float* __restrict__ dtb,
                                             bf16_t* __restrict__ xbc, float* __restrict__ dt, int gtid, int NT) {
    for (size_t i = gtid; i < (size_t)M * 1024; i += NT) {
        const int m = (int)(i >> 10), c = (int)(i & 1023), t = m & (SEQ - 1);
        float acc = cb[c];
#pragma unroll
        for (int k = 0; k < 4; ++k) { const int tt = t - 3 + k; if (tt >= 0) acc += cw[k * 1024 + c] * bf2f(proj[(size_t)(m - 3 + k) * L0P + 2304 + c]); }
        xbc[i] = (bf16_t)f2bf(siluf_(acc));
    }
    for (int i = gtid; i < M * 8; i += NT) dt[i] = softplusf_(bf2f(proj[(size_t)(i >> 3) * L0P + 3328 + (i & 7)]) + dtb[i & 7]);
}
__device__ __forceinline__ void ssd_naive_task(int task, int lane, const bf16_t* __restrict__ xbc, const float* __restrict__ dt, const float* __restrict__ a_log, const float* __restrict__ dsk, float* __restrict__ yssm) {
    const int chain = task >> 2, q = task & 3, b = chain >> 3, h = chain & 7, g = h >> 2, p = q * 16 + (lane >> 2), nq = lane & 3;
    const float A = -expf(a_log[h]), D = dsk[h];
    float st[32];
#pragma unroll
    for (int n = 0; n < 32; ++n) st[n] = 0.f;
    for (int t = 0; t < SEQ; ++t) {
        const size_t m = (size_t)b * SEQ + t;
        const float dtv = dt[m * 8 + h], dA = expf(dtv * A);
        const float x = bf2f(xbc[m * 1024 + h * 64 + p]), xdt = x * dtv;
        const bf16_t* Bp = xbc + m * 1024 + 512 + g * 128 + nq * 32;
        const bf16_t* Cp = xbc + m * 1024 + 768 + g * 128 + nq * 32;
        float yp = 0.f;
#pragma unroll
        for (int n = 0; n < 32; ++n) { st[n] = st[n] * dA + xdt * bf2f(Bp[n]); yp += st[n] * bf2f(Cp[n]); }
        yp += __shfl_xor(yp, 1); yp += __shfl_xor(yp, 2);
        if (nq == 0) yssm[m * 512 + h * 64 + p] = yp + D * x;
    }
}
template <bool ST = true> __device__ __forceinline__ void ssm_gate_norm_all(const bf16_t* __restrict__ yssm, const bf16_t* __restrict__ proj, const float* __restrict__ ng, bf16_t* __restrict__ ymix, int wv0, int wvend, int lane) {
    for (int wvb = wv0 * 4 - (wv0 & ~7) * 3; wvb < wvend; wvb += NWAVES * 4) {
        float u[4][4], q[4];
#pragma unroll
        for (int k = 0; k < 4; ++k) { const int wv = wvb + k, m = wv >> 1, g = wv & 1; q[k] = 0.f;
#pragma unroll
            for (int j = 0; j < 4; ++j) { const int c = g * 256 + j * 64 + lane; const float z = bf2f(proj[(size_t)m * L0P + 1792 + c]); u[k][j] = bf2f(yssm[(size_t)m * 512 + c]) * (z * __builtin_amdgcn_rcpf(1.f + __expf(-z))); q[k] += u[k][j] * u[k][j]; } }
#pragma unroll
        for (int k = 0; k < 4; ++k) { const int wv = wvb + k, m = wv >> 1, g = wv & 1;
            const float rs = __builtin_amdgcn_rsqf(wave_sum_dpp(q[k]) * (1.f / 256.f) + 1e-5f);
#pragma unroll
            for (int j = 0; j < 4; ++j) { const int c = g * 256 + j * 64 + lane; const float o_ = u[k][j] * rs * ng[c]; if (ST) ymix[(size_t)m * DM + 512 + c] = bf1(o_); else asm volatile("" :: "v"(o_)); } }
    }
}
template <bool ST = true> __device__ __forceinline__ void ffn_act_all(bf16_t* gu, const float* __restrict__ cw, const float* __restrict__ cb, int gtid, int NT) {
    constexpr int NCH = DFF / 8, NSTRIP = M / 32;
    for (int task = gtid; task < NSTRIP * NCH; task += NT) {
        const int strip = task / NCH, q = task - strip * NCH, c0 = q * 8, m0 = strip * 32;
        float w0[8], w1[8], w2[8], bb[8], g2[8], g1[8];
#pragma unroll
        for (int j = 0; j < 8; j += 4) { const f32x4 a = *(const f32x4*)(cw + c0 + j), b = *(const f32x4*)(cw + DFF + c0 + j), c = *(const f32x4*)(cw + 2 * DFF + c0 + j), d = *(const f32x4*)(cb + c0 + j);
#pragma unroll
            for (int k = 0; k < 4; ++k) { w0[j + k] = a[k]; w1[j + k] = b[k]; w2[j + k] = c[k]; bb[j + k] = d[k]; } }
        bf16_t* base = gu + (size_t)m0 * (2 * DFF) + c0;
        if ((m0 & (SEQ - 1)) != 0) { const v4u a = *(const v4u*)(base - 2 * (2 * DFF)), b = *(const v4u*)(base - (2 * DFF));
            g2[0] = bflo(a.x); g2[1] = bfhi(a.x); g2[2] = bflo(a.y); g2[3] = bfhi(a.y); g2[4] = bflo(a.z); g2[5] = bfhi(a.z); g2[6] = bflo(a.w); g2[7] = bfhi(a.w);
            g1[0] = bflo(b.x); g1[1] = bfhi(b.x); g1[2] = bflo(b.y); g1[3] = bfhi(b.y); g1[4] = bflo(b.z); g1[5] = bfhi(b.z); g1[6] = bflo(b.w); g1[7] = bfhi(b.w); }
        else {
#pragma unroll
            for (int j = 0; j < 8; ++j) { g2[j] = 0.f; g1[j] = 0.f; } }
#pragma unroll 4
        for (int r = 0; r < 32; ++r) {
            const v4u gv = *(const v4u*)(base + (size_t)r * (2 * DFF)), uv = *(const v4u*)(base + (size_t)r * (2 * DFF) + DFF);
            const unsigned gw_[4] = {gv.x, gv.y, gv.z, gv.w}, uw_[4] = {uv.x, uv.y, uv.z, uv.w};
            unsigned ow[4];
#pragma unroll
            for (int k = 0; k < 4; ++k) {
                const float ga = bflo(gw_[k]), gb = bfhi(gw_[k]);
                const float ya = bb[2 * k] + w0[2 * k] * g2[2 * k] + w1[2 * k] * g1[2 * k] + w2[2 * k] * ga;
                const float yb = bb[2 * k + 1] + w0[2 * k + 1] * g2[2 * k + 1] + w1[2 * k + 1] * g1[2 * k + 1] + w2[2 * k + 1] * gb;
                g2[2 * k] = g1[2 * k]; g1[2 * k] = ga; g2[2 * k + 1] = g1[2 * k + 1]; g1[2 * k + 1] = gb;
                ow[k] = cvtpk(ya / (1.f + __expf(-ya)) * bflo(uw_[k]), yb / (1.f + __expf(-yb)) * bfhi(uw_[k]));
            }
            if (ST) *(v4u*)(base + (size_t)r * (2 * DFF) + DFF) = (v4u){ow[0], ow[1], ow[2], ow[3]}; else asm volatile("" :: "v"(ow[0]), "v"(ow[1]), "v"(ow[2]), "v"(ow[3]));
        }
    }
}
template <bool ST = true> __device__ __forceinline__ void mla_prep_all(const bf16_t* __restrict__ proj1, const int* __restrict__ pos, float* __restrict__ rs, bf16_t* __restrict__ kpe, float* __restrict__ cstab, int gw, int NGW, int lane) {
    for (int m4 = gw * 4; m4 < M; m4 += NGW * 4) {
        const int mt = m4 + (lane >> 4), fi = lane & 15;
        const double inv = exp2(-(double)(2 * fi) * (13.287712379549449 / 32.0));
        const double ang = (double)pos[mt] * inv;
        const float cs = (float)cos(ang), sn = (float)sin(ang);
        cstab[(size_t)mt * 32 + fi] = cs; cstab[(size_t)mt * 32 + 16 + fi] = sn;
        { const bf16_t* row = proj1 + (size_t)mt * L1P; const float x1 = bf2f(row[1920 + fi]), x2 = bf2f(row[1936 + fi]);
          kpe[(size_t)mt * 32 + fi] = bf1(x1 * cs - x2 * sn); kpe[(size_t)mt * 32 + 16 + fi] = bf1(x2 * cs + x1 * sn); }
        float q[4], k[4];
#pragma unroll
        for (int u = 0; u < 4; ++u) { const bf16_t* row = proj1 + (size_t)(m4 + u) * L1P; q[u] = 0.f; k[u] = 0.f;
#pragma unroll
            for (int j = 0; j < 4; ++j) { const float v = bf2f(row[1536 + j * 64 + lane]); q[u] += v * v; }
#pragma unroll
            for (int j = 0; j < 2; ++j) { const float v = bf2f(row[1792 + j * 64 + lane]); k[u] += v * v; } }
#pragma unroll
        for (int u = 0; u < 4; ++u) { q[u] = wave_sum_dpp(q[u]); k[u] = wave_sum_dpp(k[u]); }
        if (lane < 4) { const float qq = lane == 0 ? q[0] : lane == 1 ? q[1] : lane == 2 ? q[2] : q[3], kk2 = lane == 0 ? k[0] : lane == 1 ? k[1] : lane == 2 ? k[2] : k[3];
            rs[(size_t)(m4 + lane) * 2] = 1.0f / sqrtf(qq * (1.f / 256.f) + 1e-6f); rs[(size_t)(m4 + lane) * 2 + 1] = 1.0f / sqrtf(kk2 * (1.f / 128.f) + 1e-6f); }
    }
}
template <bool ST = true> __device__ __forceinline__ void rope_q_all(bf16_t* qm, const float* __restrict__ cstab, int gtid, int NT) {
    for (int i = gtid; i < M * 16; i += NT) {
        const int m = i >> 4, h = (i >> 1) & 7, k0 = (i & 1) * 8;
        bf16_t* p = qm + (size_t)m * 768 + h * 96 + 64 + k0;
        const v4u a = *(const v4u*)p, b = *(const v4u*)(p + 16);
        const f32x4 c0 = *(const f32x4*)(cstab + (size_t)m * 32 + k0), c1 = *(const f32x4*)(cstab + (size_t)m * 32 + k0 + 4), s0 = *(const f32x4*)(cstab + (size_t)m * 32 + 16 + k0), s1 = *(const f32x4*)(cstab + (size_t)m * 32 + 16 + k0 + 4);
        const unsigned au[4] = {a.x, a.y, a.z, a.w}, bu[4] = {b.x, b.y, b.z, b.w};
        const float cs[8] = {c0[0], c0[1], c0[2], c0[3], c1[0], c1[1], c1[2], c1[3]}, sn[8] = {s0[0], s0[1], s0[2], s0[3], s1[0], s1[1], s1[2], s1[3]};
        unsigned o1[4], o2[4];
#pragma unroll
        for (int q = 0; q < 4; ++q) { const float x1a = bflo(au[q]), x1b = bfhi(au[q]), x2a = bflo(bu[q]), x2b = bfhi(bu[q]);
            o1[q] = cvtpk(x1a * cs[2 * q] - x2a * sn[2 * q], x1b * cs[2 * q + 1] - x2b * sn[2 * q + 1]);
            o2[q] = cvtpk(x2a * cs[2 * q] + x1a * sn[2 * q], x2b * cs[2 * q + 1] + x1b * sn[2 * q + 1]); }
        if (ST) { *(v4u*)p = (v4u){o1[0], o1[1], o1[2], o1[3]}; *(v4u*)(p + 16) = (v4u){o2[0], o2[1], o2[2], o2[3]}; }
    }
}
__device__ __forceinline__ void sb_naive_task(int qblk, int bh, int lane, const bf16_t* __restrict__ proj1, bf16_t* __restrict__ ymix) {
    const int b = bh >> 3, h = bh & 7, t = qblk * 64 + lane;
    const size_t mrow = (size_t)b * SEQ;
    float q[64], o[64];
#pragma unroll
    for (int d = 0; d < 64; ++d) { q[d] = bf2f(proj1[(mrow + t) * L1P + h * 64 + d]) * 0.125f; o[d] = 0.f; }
    float cum = 0.f;
    const int smax = qblk * 64 + 63;
    for (int s = smax - 1; s >= 0; --s) {
        const bf16_t* kr = proj1 + (mrow + s) * L1P + 512 + h * 64;
        const bf16_t* vr = proj1 + (mrow + s) * L1P + 1024 + h * 64;
        float z = 0.f;
#pragma unroll
        for (int d = 0; d < 64; ++d) z += q[d] * bf2f(kr[d]);
        if (s < t) {
            const float lsp = -softplusf_(-z);
            const float lsn = -softplusf_(z);
            const float att = expf(lsp + cum);
            cum += lsn;
#pragma unroll
            for (int d = 0; d < 64; ++d) o[d] += att * bf2f(vr[d]);
        }
    }
#pragma unroll
    for (int d = 0; d < 64; ++d) ymix[(mrow + t) * DM + h * 64 + d] = (bf16_t)f2bf(o[d]);
}
__device__ __forceinline__ void mla_naive_task(int qblk, int bh, int lane, const bf16_t* __restrict__ qm, const bf16_t* __restrict__ kvm, const bf16_t* __restrict__ kpe, bf16_t* __restrict__ ymix) {
    const int b = bh >> 3, h = bh & 7, t = qblk * 64 + lane;
    const size_t mrow = (size_t)b * SEQ;
    const float scale = 0.10206207261596577f;
    float q[96], o[64];
#pragma unroll
    for (int d = 0; d < 96; ++d) q[d] = bf2f(qm[(mrow + t) * 768 + h * 96 + d]) * scale;
#pragma unroll
    for (int d = 0; d < 64; ++d) o[d] = 0.f;
    float mx = -1e30f, l = 0.f;
    const int smax = qblk * 64 + 63;
    for (int s = 0; s <= smax; ++s) {
        const bf16_t* kr = kvm + (mrow + s) * 1024 + h * 128;
        const bf16_t* pr = kpe + (mrow + s) * 32;
        float z = 0.f;
#pragma unroll
        for (int d = 0; d < 64; ++d) z += q[d] * bf2f(kr[d]);
#pragma unroll
        for (int d = 0; d < 32; ++d) z += q[64 + d] * bf2f(pr[d]);
        if (s <= t) {
            const float mn = fmaxf(mx, z), f = expf(mx - mn), pz = expf(z - mn);
            l = l * f + pz; mx = mn;
#pragma unroll
            for (int d = 0; d < 64; ++d) o[d] = o[d] * f + pz * bf2f(kr[64 + d]);
        }
    }
    const float il = 1.f / l;
#pragma unroll
    for (int d = 0; d < 64; ++d) ymix[(mrow + t) * DM + 512 + h * 64 + d] = (bf16_t)f2bf(o[d] * il);
}


__device__ __forceinline__ int crow(int r, int hi) { return (r & 3) + 8 * (r >> 2) + 4 * hi; }
#define MFMA32(a, b, c) __builtin_amdgcn_mfma_f32_32x32x16_bf16((a), (b), (c), 0, 0, 0)
constexpr int STG_PITCH = 72;
__device__ __forceinline__ void transpose_tile64(const bf16_t* __restrict__ src, int sp, bf16_t* __restrict__ dst, int dp, LAS bf16_t* scr, int lane) {
#pragma unroll
    for (int i = 0; i < 8; ++i) { const int row = i * 8 + (lane >> 3), ch = lane & 7; const v4u v = *(const v4u*)(src + (size_t)row * sp + ch * 8); *(LAS v4u*)(scr + row * STG_PITCH + ch * 8) = v; }
    WSYNC();
#pragma unroll
    for (int i = 0; i < 8; ++i) { const int d = i * 8 + (lane >> 3), tc = lane & 7; const LAS bf16_t* p = scr + (tc * 8) * STG_PITCH + d;
        v4u o; o.x = (unsigned)p[0] | ((unsigned)p[STG_PITCH] << 16); o.y = (unsigned)p[2 * STG_PITCH] | ((unsigned)p[3 * STG_PITCH] << 16);
        o.z = (unsigned)p[4 * STG_PITCH] | ((unsigned)p[5 * STG_PITCH] << 16); o.w = (unsigned)p[6 * STG_PITCH] | ((unsigned)p[7 * STG_PITCH] << 16);
        *(v4u*)(dst + (size_t)d * dp + tc * 8) = o; }
    WSYNC();
}
__device__ __forceinline__ void store_OT(const f32x16 (&o)[2], float sc, LAS bf16_t* stg, bf16_t* __restrict__ dst, int lane) {
    const int l31 = lane & 31, hi = lane >> 5;
#pragma unroll
    for (int dt = 0; dt < 2; ++dt)
#pragma unroll
        for (int r = 0; r < 16; ++r) stg[l31 * STG_PITCH + 32 * dt + crow(r, hi)] = bf1(o[dt][r] * sc);
    WSYNC();
#pragma unroll
    for (int i = 0; i < 4; ++i) { const int row = i * 8 + (lane >> 3), ch = lane & 7; const v4u v = *(const LAS v4u*)(stg + row * STG_PITCH + ch * 8); *(v4u*)(dst + (size_t)row * DM + ch * 8) = v; }
    WSYNC();
}
__device__ __forceinline__ float softplus_fast(float z) { return fmaxf(z, 0.f) + __logf(1.f + __expf(-fabsf(z))); }

__device__ __forceinline__ void sb_task(int bh, int qblk, int lane, const bf16_t* __restrict__ P1, const bf16_t* __restrict__ VT, bf16_t* __restrict__ ymix, LAS bf16_t* stg) {
    const int b = bh >> 3, h = bh & 7, l31 = lane & 31, hi = lane >> 5, q0 = qblk * 32, t = q0 + l31;
    const size_t rowb = (size_t)b * SEQ;
    const bf16_t* Qp = P1 + (rowb + q0 + l31) * L1P + h * 64 + 8 * hi;
    bf16x8 qf[4];
#pragma unroll
    for (int kk = 0; kk < 4; ++kk) qf[kk] = *(const bf16x8*)(Qp + 16 * kk);
    const bf16_t* Kp = P1 + (rowb + l31) * L1P + 512 + h * 64 + 8 * hi;
    const bf16_t* Vp = VT + ((size_t)bh * 64 + l31) * SEQ + 4 * hi;
    f32x16 o[2];
#pragma unroll
    for (int r = 0; r < 16; ++r) { o[0][r] = 0.f; o[1][r] = 0.f; }
    float cum = 0.f;
    bf16x8 kf[4]; u32x2 va[2][2][2];
#define SB_LOAD(S0, KF, VA) do { _Pragma("unroll") for (int kk = 0; kk < 4; ++kk) KF[kk] = *(const bf16x8*)(Kp + (size_t)(S0) * L1P + 16 * kk); \
        _Pragma("unroll") for (int dt = 0; dt < 2; ++dt) _Pragma("unroll") for (int ks = 0; ks < 2; ++ks) { VA[dt][ks][0] = *(const u32x2*)(Vp + (size_t)dt * 32 * SEQ + (S0) + 16 * ks); VA[dt][ks][1] = *(const u32x2*)(Vp + (size_t)dt * 32 * SEQ + (S0) + 16 * ks + 8); } } while (0)
    SB_LOAD(q0, kf, va);
    for (int s0 = q0; s0 >= 0; s0 -= 32) {
        bf16x8 kn[4]; u32x2 vn[2][2][2];
        const int sn = (s0 >= 32) ? s0 - 32 : 0;
        SB_LOAD(sn, kn, vn);
        f32x16 acc;
#pragma unroll
        for (int r = 0; r < 16; ++r) acc[r] = 0.f;
#pragma unroll
        for (int kk = 0; kk < 4; ++kk) acc = MFMA32(kf[kk], qf[kk], acc);
        const bool diag = (s0 == q0);
        float lb[16], lk[16];
#pragma unroll
        for (int r = 0; r < 16; ++r) { const float z = acc[r] * 0.125f; const float sp = softplus_fast(z); float b_ = z - sp, k_ = -sp;
            if (diag) { const bool valid = (s0 + crow(r, hi)) < t; b_ = valid ? b_ : -1e30f; k_ = valid ? k_ : 0.f; }
            lb[r] = b_; lk[r] = k_; }
        float e[16], T[4], U[4];
#pragma unroll
        for (int i = 0; i < 4; ++i) { e[4 * i + 3] = 0.f; e[4 * i + 2] = lk[4 * i + 3]; e[4 * i + 1] = e[4 * i + 2] + lk[4 * i + 2]; e[4 * i] = e[4 * i + 1] + lk[4 * i + 1]; T[i] = e[4 * i] + lk[4 * i]; }
#pragma unroll
        for (int i = 0; i < 4; ++i) U[i] = __shfl_xor(T[i], 32);
        float off[4];
        { const float st2 = T[3], st1 = st2 + T[2], st0 = st1 + T[1]; const float su2 = U[3], su1 = su2 + U[2], su0 = su1 + U[1];
          const float x0 = hi ? 0.f : U[0], x1 = hi ? 0.f : U[1], x2 = hi ? 0.f : U[2], x3 = hi ? 0.f : U[3];
          off[3] = x3; off[2] = st2 + su2 + x2; off[1] = st1 + su1 + x1; off[0] = st0 + su0 + x0;
          const float total = st0 + T[0] + su0 + U[0];
#pragma unroll
          for (int r = 0; r < 16; ++r) acc[r] = __expf(lb[r] + (cum + off[r >> 2] + e[r]));
          cum += total; }
        bf16x8 pf[2];
#pragma unroll
        for (int ks = 0; ks < 2; ++ks) { v4u w; w.x = cvtpk(acc[8 * ks], acc[8 * ks + 1]); w.y = cvtpk(acc[8 * ks + 2], acc[8 * ks + 3]); w.z = cvtpk(acc[8 * ks + 4], acc[8 * ks + 5]); w.w = cvtpk(acc[8 * ks + 6], acc[8 * ks + 7]); pf[ks] = __builtin_bit_cast(bf16x8, w); }
#pragma unroll
        for (int dt = 0; dt < 2; ++dt)
#pragma unroll
            for (int ks = 0; ks < 2; ++ks) { v4u a; a.x = va[dt][ks][0].x; a.y = va[dt][ks][0].y; a.z = va[dt][ks][1].x; a.w = va[dt][ks][1].y; o[dt] = MFMA32(__builtin_bit_cast(bf16x8, a), pf[ks], o[dt]); }
        if (__all(cum < -110.f)) break;
#pragma unroll
        for (int kk = 0; kk < 4; ++kk) kf[kk] = kn[kk];
#pragma unroll
        for (int dt = 0; dt < 2; ++dt)
#pragma unroll
            for (int ks = 0; ks < 2; ++ks) { va[dt][ks][0] = vn[dt][ks][0]; va[dt][ks][1] = vn[dt][ks][1]; }
    }
#undef SB_LOAD
    store_OT(o, 1.0f, stg, ymix + (rowb + q0) * DM + h * 64, lane);
}
__device__ __forceinline__ void mla_task(int bh, int qblk, int lane, const bf16_t* __restrict__ QM, const bf16_t* __restrict__ KVM, const bf16_t* __restrict__ KPE, const bf16_t* __restrict__ VT,
                                         bf16_t* __restrict__ ymix, LAS bf16_t* stg) {
    const int b = bh >> 3, h = bh & 7, l31 = lane & 31, hi = lane >> 5, q0 = qblk * 32, t = q0 + l31;
    const size_t rowb = (size_t)b * SEQ;
    const bf16_t* Qp = QM + (rowb + q0 + l31) * 768 + h * 96 + 8 * hi;
    bf16x8 qf[6];
#pragma unroll
    for (int kk = 0; kk < 6; ++kk) qf[kk] = *(const bf16x8*)(Qp + 16 * kk);
    const bf16_t* Kn = KVM + (rowb + l31) * 1024 + h * 128 + 8 * hi;
    const bf16_t* Kr = KPE + (rowb + l31) * 32 + 8 * hi;
    const bf16_t* Vp = VT + ((size_t)bh * 64 + l31) * SEQ + 4 * hi;
    const float sc2 = 0.10206207261596577f * 1.4426950408889634f;
    f32x16 o[2];
#pragma unroll
    for (int r = 0; r < 16; ++r) { o[0][r] = 0.f; o[1][r] = 0.f; }
    float mrun = -1e30f, lsum = 0.f;
    bf16x8 kf[6]; u32x2 va[2][2][2];
#define ML_LOAD(S0, KF, VA) do { _Pragma("unroll") for (int kk = 0; kk < 4; ++kk) KF[kk] = *(const bf16x8*)(Kn + (size_t)(S0) * 1024 + 16 * kk); \
        _Pragma("unroll") for (int kk = 0; kk < 2; ++kk) KF[4 + kk] = *(const bf16x8*)(Kr + (size_t)(S0) * 32 + 16 * kk); \
        _Pragma("unroll") for (int dt = 0; dt < 2; ++dt) _Pragma("unroll") for (int ks = 0; ks < 2; ++ks) { VA[dt][ks][0] = *(const u32x2*)(Vp + (size_t)dt * 32 * SEQ + (S0) + 16 * ks); VA[dt][ks][1] = *(const u32x2*)(Vp + (size_t)dt * 32 * SEQ + (S0) + 16 * ks + 8); } } while (0)
    ML_LOAD(0, kf, va);
    for (int s0 = 0; s0 <= q0; s0 += 32) {
        bf16x8 kn[6]; u32x2 vn[2][2][2];
        const int sn = (s0 + 32 <= q0) ? s0 + 32 : s0;
        ML_LOAD(sn, kn, vn);
        f32x16 acc;
#pragma unroll
        for (int r = 0; r < 16; ++r) acc[r] = 0.f;
#pragma unroll
        for (int kk = 0; kk < 6; ++kk) acc = MFMA32(kf[kk], qf[kk], acc);
        const bool diag = (s0 == q0);
        float tmax = -1e30f;
#pragma unroll
        for (int r = 0; r < 16; ++r) { float z = acc[r] * sc2; if (diag && (s0 + crow(r, hi)) > t) z = -1e30f; acc[r] = z; tmax = fmaxf(tmax, z); }
        tmax = fmaxf(tmax, __shfl_xor(tmax, 32));
        const float mn = fmaxf(mrun, tmax), alpha = exp2f(mrun - mn); mrun = mn;
        float ps = 0.f;
#pragma unroll
        for (int r = 0; r < 16; ++r) { acc[r] = exp2f(acc[r] - mn); ps += acc[r]; }
        lsum = lsum * alpha + ps;
#pragma unroll
        for (int r = 0; r < 16; ++r) { o[0][r] *= alpha; o[1][r] *= alpha; }
        bf16x8 pf[2];
#pragma unroll
        for (int ks = 0; ks < 2; ++ks) { v4u w; w.x = cvtpk(acc[8 * ks], acc[8 * ks + 1]); w.y = cvtpk(acc[8 * ks + 2], acc[8 * ks + 3]); w.z = cvtpk(acc[8 * ks + 4], acc[8 * ks + 5]); w.w = cvtpk(acc[8 * ks + 6], acc[8 * ks + 7]); pf[ks] = __builtin_bit_cast(bf16x8, w); }
#pragma unroll
        for (int dt = 0; dt < 2; ++dt)
#pragma unroll
            for (int ks = 0; ks < 2; ++ks) { v4u a; a.x = va[dt][ks][0].x; a.y = va[dt][ks][0].y; a.z = va[dt][ks][1].x; a.w = va[dt][ks][1].y; o[dt] = MFMA32(__builtin_bit_cast(bf16x8, a), pf[ks], o[dt]); }
#pragma unroll
        for (int kk = 0; kk < 6; ++kk) kf[kk] = kn[kk];
#pragma unroll
        for (int dt = 0; dt < 2; ++dt)
#pragma unroll
            for (int ks = 0; ks < 2; ++ks) { va[dt][ks][0] = vn[dt][ks][0]; va[dt][ks][1] = vn[dt][ks][1]; }
    }
#undef ML_LOAD
    lsum += __shfl_xor(lsum, 32);
    store_OT(o, 1.0f / lsum, stg, ymix + (rowb + q0) * DM + 512 + h * 64, lane);
}


__device__ __forceinline__ void sb_wave(int bh, int qblk, int lane, const bf16_t* __restrict__ P1, const bf16_t* __restrict__ VT, bf16_t* __restrict__ ymix, LAS unsigned char* wl) {
    const int b = bh >> 3, h = bh & 7, l31 = lane & 31, hi = lane >> 5, q0 = qblk * 32, t = q0 + l31;
    const size_t rowb = (size_t)b * SEQ;
    bf16x8 qf[4];
    { const bf16_t* Qp = P1 + (rowb + q0 + l31) * L1P + h * 64 + 8 * hi;
#pragma unroll
      for (int kk = 0; kk < 4; ++kk) qf[kk] = *(const bf16x8*)(Qp + 16 * kk); }
    f32x16 o[2];
#pragma unroll
    for (int r = 0; r < 16; ++r) { o[0][r] = 0.f; o[1][r] = 0.f; }
    float cum = 1.f;
    const bf16_t* gK = P1 + (rowb + (lane >> 3)) * L1P + 512 + h * 64 + (lane & 7) * 8;
    const bf16_t* gV = VT + ((size_t)bh * 64 + (lane >> 2)) * SEQ + (lane & 3) * 8;
    const int lK = (lane >> 3) * 144 + (lane & 7) * 16, lV = 4608 + (lane >> 2) * 72 + (lane & 3) * 16;
    v4u rk[4], rv[4];
#pragma unroll
    for (int i = 0; i < 4; ++i) { rk[i] = *(const v4u*)(gK + (size_t)(q0 + 8 * i) * L1P); rv[i] = *(const v4u*)(gV + (size_t)(16 * i) * SEQ + q0); }
#pragma unroll 1
    for (int s0 = q0; s0 >= 0; s0 -= 32) {
#pragma unroll
        for (int i = 0; i < 4; ++i) { *(LAS v4u*)(wl + lK + i * 8 * 144) = rk[i]; *(LAS u32x2*)(wl + lV + i * 16 * 72) = (u32x2){rv[i].x, rv[i].y}; *(LAS u32x2*)(wl + lV + i * 16 * 72 + 8) = (u32x2){rv[i].z, rv[i].w}; }
        { const int sn = (s0 >= 32) ? s0 - 32 : 0;
#pragma unroll
          for (int i = 0; i < 4; ++i) { rk[i] = *(const v4u*)(gK + (size_t)(sn + 8 * i) * L1P); rv[i] = *(const v4u*)(gV + (size_t)(16 * i) * SEQ + sn); } }
        WSYNC();
        f32x16 acc;
#pragma unroll
        for (int r = 0; r < 16; ++r) acc[r] = 0.f;
#pragma unroll
        for (int kk = 0; kk < 4; ++kk) { const bf16x8 kf = *(const LAS bf16x8*)(wl + l31 * 144 + (16 * kk + 8 * hi) * 2); acc = MFMA32(kf, qf[kk], acc); }
        const bool diag = (s0 == q0);
        float bt[16], kp[16];
#pragma unroll
        for (int r = 0; r < 16; ++r) { const float ee = __builtin_amdgcn_exp2f(fminf(acc[r] * (-0.125f * 1.4426950408889634f), 100.f)); const float ri = __builtin_amdgcn_rcpf(1.f + ee);
            float b_ = ri, k_ = ee * ri;
            if (diag) { const bool valid = (s0 + crow(r, hi)) < t; b_ = valid ? b_ : 0.f; k_ = valid ? k_ : 1.f; }
            bt[r] = b_; kp[r] = k_; }
        float e[16], T[4], U[4];
#pragma unroll
        for (int q = 0; q < 4; ++q) { e[4 * q + 3] = 1.f; e[4 * q + 2] = kp[4 * q + 3]; e[4 * q + 1] = e[4 * q + 2] * kp[4 * q + 2]; e[4 * q] = e[4 * q + 1] * kp[4 * q + 1]; T[q] = e[4 * q] * kp[4 * q]; }
#pragma unroll
        for (int q = 0; q < 4; ++q) U[q] = __shfl_xor(T[q], 32);
        { const float st2 = T[3], st1 = st2 * T[2], st0 = st1 * T[1]; const float su2 = U[3], su1 = su2 * U[2], su0 = su1 * U[1];
          const float x0 = hi ? 1.f : U[0], x1 = hi ? 1.f : U[1], x2 = hi ? 1.f : U[2], x3 = hi ? 1.f : U[3];
          const float off[4] = {cum * (st0 * su0 * x0), cum * (st1 * su1 * x1), cum * (st2 * su2 * x2), cum * x3};
#pragma unroll
          for (int r = 0; r < 16; ++r) acc[r] = bt[r] * (off[r >> 2] * e[r]);
          cum *= (st0 * T[0]) * (su0 * U[0]); }
        bf16x8 pf[2];
#pragma unroll
        for (int ks = 0; ks < 2; ++ks) pf[ks] = pack8(acc[8 * ks], acc[8 * ks + 1], acc[8 * ks + 2], acc[8 * ks + 3], acc[8 * ks + 4], acc[8 * ks + 5], acc[8 * ks + 6], acc[8 * ks + 7]);
#pragma unroll
        for (int dt = 0; dt < 2; ++dt)
#pragma unroll
            for (int ks = 0; ks < 2; ++ks) { const LAS unsigned char* vp = wl + 4608 + (32 * dt + l31) * 72 + (16 * ks + 4 * hi) * 2;
                const u32x2 x0 = *(const LAS u32x2*)vp, x1 = *(const LAS u32x2*)(vp + 16);
                v4u a; a.x = x0.x; a.y = x0.y; a.z = x1.x; a.w = x1.y; o[dt] = MFMA32(__builtin_bit_cast(bf16x8, a), pf[ks], o[dt]); }
        WSYNC();
        if (__all(cum < 1e-35f)) break;
    }
    store_OT(o, 1.0f, (LAS bf16_t*)(wl + 9216), ymix + (rowb + q0) * DM + h * 64, lane);
}

constexpr int MLK_PITCH = 104, MLV_PITCH = 68, MLK_BYTES = 64 * MLK_PITCH * 2, MLV_BYTES = 64 * MLV_PITCH * 2, ML_STAGE = MLK_BYTES + MLV_BYTES;
__device__ __forceinline__ void mla_block(int bh, int sb, int tid, int lane, int wave, LAS unsigned char* lds, const bf16_t* __restrict__ QM, const bf16_t* __restrict__ KVM, const bf16_t* __restrict__ KPE,
                                          const bf16_t* __restrict__ VT, bf16_t* __restrict__ ymix) {
    const int b = bh >> 3, h = bh & 7, l31 = lane & 31, hi = lane >> 5, q0 = 256 * sb + 32 * wave, t = q0 + l31;
    const size_t rowb = (size_t)b * SEQ;
    const int nsteps = 4 * sb + 4;
    bf16x8 qf[6];
    { const bf16_t* Qp = QM + (rowb + q0 + l31) * 768 + h * 96 + 8 * hi;
#pragma unroll
      for (int kk = 0; kk < 6; ++kk) qf[kk] = *(const bf16x8*)(Qp + 16 * kk); }
    const float sc2 = 0.10206207261596577f * 1.4426950408889634f;
    f32x16 o[2];
#pragma unroll
    for (int r = 0; r < 16; ++r) { o[0][r] = 0.f; o[1][r] = 0.f; }
    float mrun = -1e30f, lsum = 0.f;
    const bf16_t* gKn = KVM + (rowb + (tid >> 3)) * 1024 + h * 128 + (tid & 7) * 8;
    const bf16_t* gKr = KPE + (rowb + ((tid & 255) >> 2)) * 32 + (tid & 3) * 8;
    const bf16_t* gVt = VT + ((size_t)bh * 64 + (tid >> 3)) * SEQ + (tid & 7) * 8;
    const int lKn = (tid >> 3) * (MLK_PITCH * 2) + (tid & 7) * 16, lKr = ((tid & 255) >> 2) * (MLK_PITCH * 2) + 128 + (tid & 3) * 16, lVt = MLK_BYTES + (tid >> 3) * (MLV_PITCH * 2) + (tid & 7) * 16;
    v4u rk, rr, rv;
    rk = *(const v4u*)gKn; rr = *(const v4u*)gKr; rv = *(const v4u*)gVt;
    *(LAS v4u*)(lds + lKn) = rk; if (tid < 256) *(LAS v4u*)(lds + lKr) = rr; *(LAS u32x2*)(lds + lVt) = (u32x2){rv.x, rv.y}; *(LAS u32x2*)(lds + lVt + 8) = (u32x2){rv.z, rv.w};
    __syncthreads();
#pragma unroll 1
    for (int step = 0; step < nsteps; ++step) {
        const int nx = (step + 1 < nsteps) ? step + 1 : step;
        rk = *(const v4u*)(gKn + (size_t)nx * 64 * 1024); rr = *(const v4u*)(gKr + (size_t)nx * 64 * 32); rv = *(const v4u*)(gVt + nx * 64);
        const LAS unsigned char* Kb = lds + (step & 1) * ML_STAGE;
        const LAS unsigned char* Vb = Kb + MLK_BYTES;
        if (64 * step <= q0) {
            f32x16 acc[2];
#pragma unroll
            for (int sub = 0; sub < 2; ++sub) {
#pragma unroll
                for (int r = 0; r < 16; ++r) acc[sub][r] = 0.f;
#pragma unroll
                for (int kk = 0; kk < 6; ++kk) { const bf16x8 kf = *(const LAS bf16x8*)(Kb + (32 * sub + l31) * (MLK_PITCH * 2) + (16 * kk + 8 * hi) * 2); acc[sub] = MFMA32(kf, qf[kk], acc[sub]); }
            }
            float tmax = -1e30f;
#pragma unroll
            for (int sub = 0; sub < 2; ++sub) { const int s0 = 64 * step + 32 * sub;
                if (s0 + 31 > q0) {
#pragma unroll
                    for (int r = 0; r < 16; ++r) if ((s0 + crow(r, hi)) > t) acc[sub][r] = -1e30f; }
#pragma unroll
                for (int r = 0; r < 16; ++r) tmax = fmaxf(tmax, acc[sub][r]); }
            tmax = fmaxf(tmax, __shfl_xor(tmax, 32)) * sc2;
            if (__any(tmax - mrun > 6.f)) {
                const float mn = fmaxf(mrun, tmax), alpha = __builtin_amdgcn_exp2f(mrun - mn); mrun = mn; lsum *= alpha;
#pragma unroll
                for (int r = 0; r < 16; ++r) { o[0][r] *= alpha; o[1][r] *= alpha; }
            }
            float ps = 0.f;
#pragma unroll
            for (int sub = 0; sub < 2; ++sub)
#pragma unroll
                for (int r = 0; r < 16; ++r) { acc[sub][r] = __builtin_amdgcn_exp2f(acc[sub][r] * sc2 - mrun); ps += acc[sub][r]; }
            lsum += ps;
#pragma unroll
            for (int sub = 0; sub < 2; ++sub) {
                bf16x8 pf[2];
#pragma unroll
                for (int ks = 0; ks < 2; ++ks) pf[ks] = pack8(acc[sub][8 * ks], acc[sub][8 * ks + 1], acc[sub][8 * ks + 2], acc[sub][8 * ks + 3], acc[sub][8 * ks + 4], acc[sub][8 * ks + 5], acc[sub][8 * ks + 6], acc[sub][8 * ks + 7]);
#pragma unroll
                for (int dt = 0; dt < 2; ++dt)
#pragma unroll
                    for (int ks = 0; ks < 2; ++ks) { const LAS unsigned char* vp = Vb + (32 * dt + l31) * (MLV_PITCH * 2) + (32 * sub + 16 * ks + 4 * hi) * 2;
                        const u32x2 x0 = *(const LAS u32x2*)vp, x1 = *(const LAS u32x2*)(vp + 16);
                        v4u a; a.x = x0.x; a.y = x0.y; a.z = x1.x; a.w = x1.y; o[dt] = MFMA32(__builtin_bit_cast(bf16x8, a), pf[ks], o[dt]); }
            }
        }
        LAS unsigned char* nb = lds + ((step + 1) & 1) * ML_STAGE;
        *(LAS v4u*)(nb + lKn) = rk; if (tid < 256) *(LAS v4u*)(nb + lKr) = rr; *(LAS u32x2*)(nb + lVt) = (u32x2){rv.x, rv.y}; *(LAS u32x2*)(nb + lVt + 8) = (u32x2){rv.z, rv.w};
        __syncthreads();
    }
    lsum += __shfl_xor(lsum, 32);
    store_OT(o, 1.0f / lsum, (LAS bf16_t*)(lds + 2 * ML_STAGE) + wave * (32 * STG_PITCH), ymix + (rowb + q0) * DM + 512 + h * 64, lane);
    __syncthreads();
}


constexpr int SBK_PITCH = 72, SBK_BYTES = 64 * SBK_PITCH * 2, SB_STAGE = SBK_BYTES + MLV_BYTES;
__device__ __forceinline__ void sb_block(int bh, int sb, int tid, int lane, int wave, LAS unsigned char* lds, const bf16_t* __restrict__ P1, const bf16_t* __restrict__ VT, bf16_t* __restrict__ ymix) {
    const int b = bh >> 3, h = bh & 7, l31 = lane & 31, hi = lane >> 5, q0 = 256 * sb + 32 * wave, t = q0 + l31;
    const size_t rowb = (size_t)b * SEQ;
    bf16x8 qf[4];
    { const bf16_t* Qp = P1 + (rowb + q0 + l31) * L1P + h * 64 + 8 * hi;
#pragma unroll
      for (int kk = 0; kk < 4; ++kk) qf[kk] = *(const bf16x8*)(Qp + 16 * kk); }
    f32x16 o[2];
#pragma unroll
    for (int r = 0; r < 16; ++r) { o[0][r] = 0.f; o[1][r] = 0.f; }
    float cum = 1.f; bool done = false;
    volatile LAS unsigned* flags = (volatile LAS unsigned*)(lds + 2 * SB_STAGE);
    const bf16_t* gK = P1 + (rowb + (tid >> 3)) * L1P + 512 + h * 64 + (tid & 7) * 8;
    const bf16_t* gVt = VT + ((size_t)bh * 64 + (tid >> 3)) * SEQ + (tid & 7) * 8;
    const int lK = (tid >> 3) * (SBK_PITCH * 2) + (tid & 7) * 16, lVt = SBK_BYTES + (tid >> 3) * (MLV_PITCH * 2) + (tid & 7) * 16;
    const int top = 4 * sb + 3;
    v4u rk, rv;
    rk = *(const v4u*)(gK + (size_t)top * 64 * L1P); rv = *(const v4u*)(gVt + top * 64);
    *(LAS v4u*)(lds + lK) = rk; *(LAS u32x2*)(lds + lVt) = (u32x2){rv.x, rv.y}; *(LAS u32x2*)(lds + lVt + 8) = (u32x2){rv.z, rv.w};
    __syncthreads();
#pragma unroll 1
    for (int i = 0; i <= top; ++i) {
        const int step = top - i, nx = (step > 0) ? step - 1 : 0;
        rk = *(const v4u*)(gK + (size_t)nx * 64 * L1P); rv = *(const v4u*)(gVt + nx * 64);
        const LAS unsigned char* Kb = lds + (i & 1) * SB_STAGE;
        const LAS unsigned char* Vb = Kb + SBK_BYTES;
#pragma unroll
        for (int sub = 1; sub >= 0; --sub) {
            const int s0 = 64 * step + 32 * sub;
            if (s0 <= q0 && !done) {
                f32x16 acc;
#pragma unroll
                for (int r = 0; r < 16; ++r) acc[r] = 0.f;
#pragma unroll
                for (int kk = 0; kk < 4; ++kk) { const bf16x8 kf = *(const LAS bf16x8*)(Kb + (32 * sub + l31) * (SBK_PITCH * 2) + (16 * kk + 8 * hi) * 2); acc = MFMA32(kf, qf[kk], acc); }
                const bool diag = (s0 == q0);
                float bt[16], kp[16];
#pragma unroll
                for (int r = 0; r < 16; ++r) { const float ee = __builtin_amdgcn_exp2f(fminf(acc[r] * (-0.125f * 1.4426950408889634f), 100.f)); const float ri = __builtin_amdgcn_rcpf(1.f + ee);
                    float b_ = ri, k_ = ee * ri;
                    if (diag) { const bool valid = (s0 + crow(r, hi)) < t; b_ = valid ? b_ : 0.f; k_ = valid ? k_ : 1.f; }
                    bt[r] = b_; kp[r] = k_; }
                float e[16], T[4], U[4];
#pragma unroll
                for (int q = 0; q < 4; ++q) { e[4 * q + 3] = 1.f; e[4 * q + 2] = kp[4 * q + 3]; e[4 * q + 1] = e[4 * q + 2] * kp[4 * q + 2]; e[4 * q] = e[4 * q + 1] * kp[4 * q + 1]; T[q] = e[4 * q] * kp[4 * q]; }
#pragma unroll
                for (int q = 0; q < 4; ++q) U[q] = __shfl_xor(T[q], 32);
                { const float st2 = T[3], st1 = st2 * T[2], st0 = st1 * T[1]; const float su2 = U[3], su1 = su2 * U[2], su0 = su1 * U[1];
                  const float x0 = hi ? 1.f : U[0], x1 = hi ? 1.f : U[1], x2 = hi ? 1.f : U[2], x3 = hi ? 1.f : U[3];
                  const float off[4] = {cum * (st0 * su0 * x0), cum * (st1 * su1 * x1), cum * (st2 * su2 * x2), cum * x3};
#pragma unroll
                  for (int r = 0; r < 16; ++r) acc[r] = bt[r] * (off[r >> 2] * e[r]);
                  cum *= (st0 * T[0]) * (su0 * U[0]); }
                bf16x8 pf[2];
#pragma unroll
                for (int ks = 0; ks < 2; ++ks) { v4u w; w.x = cvtpk(acc[8 * ks], acc[8 * ks + 1]); w.y = cvtpk(acc[8 * ks + 2], acc[8 * ks + 3]); w.z = cvtpk(acc[8 * ks + 4], acc[8 * ks + 5]); w.w = cvtpk(acc[8 * ks + 6], acc[8 * ks + 7]); pf[ks] = __builtin_bit_cast(bf16x8, w); }
#pragma unroll
                for (int dt = 0; dt < 2; ++dt)
#pragma unroll
                    for (int ks = 0; ks < 2; ++ks) { const LAS unsigned char* vp = Vb + (32 * dt + l31) * (MLV_PITCH * 2) + (32 * sub + 16 * ks + 4 * hi) * 2;
                        const u32x2 x0 = *(const LAS u32x2*)vp, x1 = *(const LAS u32x2*)(vp + 16);
                        v4u a; a.x = x0.x; a.y = x0.y; a.z = x1.x; a.w = x1.y; o[dt] = MFMA32(__builtin_bit_cast(bf16x8, a), pf[ks], o[dt]); }
                done = __all(cum < 1e-35f);
            }
        }
        if (lane == 0) flags[(i & 1) * 8 + wave] = done ? 1u : 0u;
        LAS unsigned char* nb = lds + ((i + 1) & 1) * SB_STAGE;
        *(LAS v4u*)(nb + lK) = rk; *(LAS u32x2*)(nb + lVt) = (u32x2){rv.x, rv.y}; *(LAS u32x2*)(nb + lVt + 8) = (u32x2){rv.z, rv.w};
        __syncthreads();
        unsigned nd = 0;
#pragma unroll
        for (int w8 = 0; w8 < 8; ++w8) nd += flags[(i & 1) * 8 + w8];
        if (nd == 8u) break;
    }
    store_OT(o, 1.0f, (LAS bf16_t*)(lds + 2 * SB_STAGE + 256) + wave * (32 * STG_PITCH), ymix + (rowb + q0) * DM + h * 64, lane);
    __syncthreads();
}

constexpr int RW_RAWW = 0, RW_RAWA = 2048, RW_RS = 4096, RW_KS = 6144, RW_VS = 8192;
constexpr int RW_CH0 = 10240, RW_CHSZ = 11328;
constexpr int RW_YB = RW_CH0 + 2 * RW_CHSZ;
constexpr int RW_MIX = RW_YB + 1024;
static_assert((RW_MIX + 256) * 4 <= 146432, "rwkv LDS map");
__device__ __forceinline__ float tanh_fast(float x) { return 1.f - 2.f * __builtin_amdgcn_rcpf(1.f + __expf(2.f * x)); }
__device__ __forceinline__ float sigmoid_fast(float x) { return __builtin_amdgcn_rcpf(1.f + __expf(-x)); }

#define MFMA16(a, b, c) __builtin_amdgcn_mfma_f32_16x16x32_bf16((a), (b), (c), 0, 0, 0)
constexpr int RW2_CH0 = 0, RW2_YB = 2 * RW_CHSZ, RW2_MIX = RW2_YB + 1024, RW2_STG = RW2_MIX + 448;
static_assert((RW2_STG + 2 * 3072) * 4 <= 146432, "rwkv LDS map");
__device__ __forceinline__ void rwkv_phase_scan(LAS float* sm, int tid, int lane, int wave, int blk, const bf16_t* __restrict__ proj, const float* __restrict__ mix, const float* __restrict__ w0, const float* __restrict__ a0,
                                           const float* __restrict__ k_k, const float* __restrict__ k_a, const float* __restrict__ r_k, const bf16_t* __restrict__ W2T, const bf16_t* __restrict__ A2T, const bf16_t* __restrict__ G2T,
                                           float* __restrict__ yraw, bf16_t* __restrict__ gout, float* __restrict__ bonus_out) {
    const int chain = blk >> 1, half = blk & 1, b = chain >> 3, h = chain & 7, l15 = lane & 15, kg = lane >> 4;
    const size_t rowb = (size_t)b * SEQ;
    constexpr int NCHUNK = SEQ / 32;
    if (tid < 256) sm[RW2_MIX + tid] = mix[1536 + tid];
    else if (tid < 448) { const int q = tid - 256; sm[RW2_MIX + tid] = mix[512 * (q >> 6) + h * 64 + (q & 63)]; }
    __syncthreads();
#define RW_SH8(CUR, PRV, M0, M1, OUT, PZ) do { const unsigned cu_[4] = {(CUR).x, (CUR).y, (CUR).z, (CUR).w}, pu_[4] = {(PRV).x, (PRV).y, (PRV).z, (PRV).w}; \
        const float mm_[8] = {(M0)[0], (M0)[1], (M0)[2], (M0)[3], (M1)[0], (M1)[1], (M1)[2], (M1)[3]}; \
        _Pragma("unroll") for (int q = 0; q < 4; ++q) { const float c0 = bflo(cu_[q]), c1 = bfhi(cu_[q]), p0 = bflo(pu_[q]) * (PZ), p1 = bfhi(pu_[q]) * (PZ); \
            OUT[2 * q] = c0 + (p0 - c0) * mm_[2 * q]; OUT[2 * q + 1] = c1 + (p1 - c1) * mm_[2 * q + 1]; } } while (0)
    if (wave < 4) {
        const int iA = 8 * wave + kg, iB = iA + 4, jseg = l15;
        float A0 = 0.f, A1 = 0.f, A2 = 0.f, A3 = 0.f, B0 = 0.f, B1 = 0.f, B2 = 0.f, B3 = 0.f;
        __syncthreads();
#pragma unroll 1
        for (int ch = 0; ch < NCHUNK; ++ch) {
            const int t0 = ch * 32;
            const LAS float* CHb = sm + RW2_CH0 + (ch & 1) * RW_CHSZ + 4 * jseg;
            const LAS float* CHv = sm + RW2_CH0 + (ch & 1) * RW_CHSZ + 10240 + iA;
            const LAS float* CHs = sm + RW2_CH0 + (ch & 1) * RW_CHSZ + 11264;
            f32x4 a4 = *(const LAS f32x4*)(CHb + 4096), wr4 = *(const LAS f32x4*)(CHb + 8192), w4 = *(const LAS f32x4*)(CHb), b4 = *(const LAS f32x4*)(CHb + 6144), k4 = *(const LAS f32x4*)(CHb + 2048);
            float vA = CHv[0], vB = CHv[4]; f32x2_t sc = *(const LAS f32x2_t*)(CHs);
#pragma unroll 2
            for (int t = 0; t < 32; ++t) {
                const int tq = (t + 1) & 31;
                const f32x4 a4n = *(const LAS f32x4*)(CHb + 4096 + tq * 64), wr4n = *(const LAS f32x4*)(CHb + 8192 + tq * 64), w4n = *(const LAS f32x4*)(CHb + tq * 64),
                            b4n = *(const LAS f32x4*)(CHb + 6144 + tq * 64), k4n = *(const LAS f32x4*)(CHb + 2048 + tq * 64);
                const float vAn = CHv[tq * 32], vBn = CHv[tq * 32 + 4]; const f32x2_t scn = *(const LAS f32x2_t*)(CHs + 2 * tq);
                float d1A = (A0 * a4[0] + A1 * a4[1]) + (A2 * a4[2] + A3 * a4[3]), d1B = (B0 * a4[0] + B1 * a4[1]) + (B2 * a4[2] + B3 * a4[3]);
                float d2A = (A0 * wr4[0] + A1 * wr4[1]) + (A2 * wr4[2] + A3 * wr4[3]), d2B = (B0 * wr4[0] + B1 * wr4[1]) + (B2 * wr4[2] + B3 * wr4[3]);
                d1A = rowsum16(d1A); d1B = rowsum16(d1B); d2A = rowsum16(d2A); d2B = rowsum16(d2B);
                const float yA = d2A + d1A * sc[0] + vA * sc[1], yB = d2B + d1B * sc[0] + vB * sc[1];
                A0 = A0 * w4[0] + (d1A * b4[0] + vA * k4[0]); A1 = A1 * w4[1] + (d1A * b4[1] + vA * k4[1]); A2 = A2 * w4[2] + (d1A * b4[2] + vA * k4[2]); A3 = A3 * w4[3] + (d1A * b4[3] + vA * k4[3]);
                B0 = B0 * w4[0] + (d1B * b4[0] + vB * k4[0]); B1 = B1 * w4[1] + (d1B * b4[1] + vB * k4[1]); B2 = B2 * w4[2] + (d1B * b4[2] + vB * k4[2]); B3 = B3 * w4[3] + (d1B * b4[3] + vB * k4[3]);
                if (jseg == 0) { sm[RW2_YB + t * 32 + iA] = yA; sm[RW2_YB + t * 32 + iB] = yB; }
                a4 = a4n; wr4 = wr4n; w4 = w4n; b4 = b4n; k4 = k4n; vA = vAn; vB = vBn; sc = scn;
            }
            WSYNC();
            { const int tt = lane >> 1, hh = lane & 1; const f32x4 yv = *(const LAS f32x4*)(sm + RW2_YB + tt * 32 + 8 * wave + 4 * hh);
              *(f32x4*)(yraw + (rowb + t0 + tt) * 512 + h * 64 + half * 32 + 8 * wave + 4 * hh) = yv; }
            __syncthreads();
        }
    } else if (wave < 6) {
        const int tp = wave - 4, tb = 16 * tp;
        LAS float* stg = sm + RW2_STG + tp * 3072;
        float w0c[4], a0c[4], kkc[4], kac[4], rkc[4];
#pragma unroll
        for (int nt = 0; nt < 4; ++nt) { const int c = h * 64 + 16 * nt + l15; w0c[nt] = w0[c]; a0c[nt] = a0[c]; kkc[nt] = k_k[c]; kac[nt] = k_a[c]; rkc[nt] = r_k[c]; }
        v4u ld[20];
#define PREP_ISSUE(T0) do { const int t0_ = (T0); { const size_t r_ = rowb + t0_ + tb + l15; const size_t rp_ = (t0_ + tb + l15 == 0) ? r_ : r_ - 1; \
            _Pragma("unroll") for (int lo = 0; lo < 2; ++lo) _Pragma("unroll") for (int ks = 0; ks < 2; ++ks) { const int col = 1536 + 64 * lo + 32 * ks + 8 * kg; \
                ld[(lo * 2 + ks) * 2] = *(const v4u*)(proj + r_ * L0P + col); ld[(lo * 2 + ks) * 2 + 1] = *(const v4u*)(proj + rp_ * L0P + col); } } \
            _Pragma("unroll") for (int ar = 0; ar < 3; ++ar) _Pragma("unroll") for (int i = 0; i < 2; ++i) { const int p_ = lane + 64 * i, row_ = p_ >> 3, c8_ = p_ & 7; \
                const size_t r_ = rowb + t0_ + tb + row_; const size_t rp_ = (t0_ + tb + row_ == 0) ? r_ : r_ - 1; const int col = 512 * ar + h * 64 + 8 * c8_; \
                ld[8 + (ar * 2 + i) * 2] = *(const v4u*)(proj + r_ * L0P + col); ld[8 + (ar * 2 + i) * 2 + 1] = *(const v4u*)(proj + rp_ * L0P + col); } } while (0)
#define PREP_BUILD(T0, NB) do { const int t0_ = (T0); LAS float* CHn = sm + RW2_CH0 + (NB) * RW_CHSZ; \
            f32x4 accw[4], acca[4]; \
            _Pragma("unroll") for (int nt = 0; nt < 4; ++nt) { accw[nt] = (f32x4){0.f, 0.f, 0.f, 0.f}; acca[nt] = (f32x4){0.f, 0.f, 0.f, 0.f}; } \
            { const float pz_ = (t0_ + tb + l15 == 0) ? 0.f : 1.f; \
              _Pragma("unroll") for (int lo = 0; lo < 2; ++lo) _Pragma("unroll") for (int ks = 0; ks < 2; ++ks) { float s_[8]; \
                const f32x4 m0 = *(const LAS f32x4*)(sm + RW2_MIX + 64 * lo + 32 * ks + 8 * kg), m1 = *(const LAS f32x4*)(sm + RW2_MIX + 64 * lo + 32 * ks + 8 * kg + 4); \
                RW_SH8(ld[(lo * 2 + ks) * 2], ld[(lo * 2 + ks) * 2 + 1], m0, m1, s_, pz_); \
                if (lo == 0) { _Pragma("unroll") for (int j = 0; j < 8; ++j) s_[j] = tanh_fast(s_[j]); } \
                v4u aw; aw.x = cvtpk(s_[0], s_[1]); aw.y = cvtpk(s_[2], s_[3]); aw.z = cvtpk(s_[4], s_[5]); aw.w = cvtpk(s_[6], s_[7]); const bf16x8 af = __builtin_bit_cast(bf16x8, aw); \
                const bf16_t* WT = lo ? A2T : W2T; \
                _Pragma("unroll") for (int nt = 0; nt < 4; ++nt) { const bf16x8 bfr = *(const bf16x8*)(WT + (size_t)(h * 64 + 16 * nt + l15) * 64 + 32 * ks + 8 * kg); \
                    if (lo == 0) accw[nt] = MFMA16(af, bfr, accw[nt]); else acca[nt] = MFMA16(af, bfr, acca[nt]); } } } \
            _Pragma("unroll") for (int ar = 0; ar < 3; ++ar) _Pragma("unroll") for (int i = 0; i < 2; ++i) { const int p_ = lane + 64 * i, row_ = p_ >> 3, c8_ = p_ & 7; float s_[8]; \
                const float pz_ = (t0_ + tb + row_ == 0) ? 0.f : 1.f; const f32x4 m0 = *(const LAS f32x4*)(sm + RW2_MIX + 256 + ar * 64 + c8_ * 8), m1 = *(const LAS f32x4*)(sm + RW2_MIX + 256 + ar * 64 + c8_ * 8 + 4); \
                RW_SH8(ld[8 + (ar * 2 + i) * 2], ld[8 + (ar * 2 + i) * 2 + 1], m0, m1, s_, pz_); \
                *(LAS f32x4*)(stg + ar * 1024 + row_ * 64 + c8_ * 8) = (f32x4){s_[0], s_[1], s_[2], s_[3]}; *(LAS f32x4*)(stg + ar * 1024 + row_ * 64 + c8_ * 8 + 4) = (f32x4){s_[4], s_[5], s_[6], s_[7]}; } \
            WSYNC(); \
            PREP_ISSUE(((T0) + 32 < SEQ) ? (T0) + 32 : (T0)); \
            _Pragma("unroll") for (int rg = 0; rg < 4; ++rg) { const int tl = 4 * kg + rg, t = tb + tl; \
                float r_[4], k_[4], v_[4], kkv[4], nrm2 = 0.f; \
                _Pragma("unroll") for (int nt = 0; nt < 4; ++nt) { r_[nt] = stg[tl * 64 + 16 * nt + l15]; k_[nt] = stg[1024 + tl * 64 + 16 * nt + l15]; v_[nt] = stg[2048 + tl * 64 + 16 * nt + l15]; \
                    kkv[nt] = k_[nt] * kkc[nt]; nrm2 += kkv[nt] * kkv[nt]; } \
                nrm2 = rowsum16(nrm2); const float rn = __builtin_amdgcn_rsqf(fmaxf(nrm2, 1e-24f)); \
                float br = 0.f, kr = 0.f, bon = 0.f; \
                _Pragma("unroll") for (int nt = 0; nt < 4; ++nt) { const int j = 16 * nt + l15; \
                    const float wsum = w0c[nt] + accw[nt][rg]; const float logw = -softplus_fast(-wsum) - 0.5f; const float dec = __expf(-__expf(logw)); \
                    const float a_ = sigmoid_fast(a0c[nt] + acca[nt][rg]); const float kn = kkv[nt] * rn; \
                    const float k2 = k_[nt] * (1.f + (a_ - 1.f) * kac[nt]); const float bv = kn * a_; \
                    br += bv * r_[nt]; kr += k2 * r_[nt]; bon += r_[nt] * k2 * rkc[nt]; \
                    CHn[t * 64 + j] = dec; CHn[2048 + t * 64 + j] = k2; CHn[4096 + t * 64 + j] = -kn; CHn[6144 + t * 64 + j] = bv; CHn[8192 + t * 64 + j] = dec * r_[nt]; \
                    if ((nt >> 1) == half) CHn[10240 + t * 32 + (j & 31)] = v_[nt]; } \
                br = rowsum16(br); kr = rowsum16(kr); bon = rowsum16(bon); \
                if (l15 == 0) { CHn[11264 + 2 * t] = br; CHn[11264 + 2 * t + 1] = kr; if (half == 0) bonus_out[(rowb + t0_ + t) * 8 + h] = bon; } } \
            WSYNC(); } while (0)
        PREP_ISSUE(0);
        PREP_BUILD(0, 0);
        __syncthreads();
#pragma unroll 1
        for (int ch = 0; ch < NCHUNK; ++ch) {
            if (ch + 1 < NCHUNK) PREP_BUILD(ch * 32 + 32, (ch + 1) & 1);
            __syncthreads();
        }
#undef PREP_ISSUE
#undef PREP_BUILD
    } else {
        const int tp = wave - 6, tb = 16 * tp;
        v4u ld[8];
#define G_ISSUE(T0) do { const int t0_ = (T0); const size_t r_ = rowb + t0_ + tb + l15; const size_t rp_ = (t0_ + tb + l15 == 0) ? r_ : r_ - 1; \
            _Pragma("unroll") for (int ks = 0; ks < 4; ++ks) { const int col = 1664 + 32 * ks + 8 * kg; ld[2 * ks] = *(const v4u*)(proj + r_ * L0P + col); ld[2 * ks + 1] = *(const v4u*)(proj + rp_ * L0P + col); } } while (0)
#define G_BUILD(T0) do { const int t0_ = (T0); f32x4 accg[2] = {(f32x4){0.f, 0.f, 0.f, 0.f}, (f32x4){0.f, 0.f, 0.f, 0.f}}; const float pz_ = (t0_ + tb + l15 == 0) ? 0.f : 1.f; \
            _Pragma("unroll") for (int ks = 0; ks < 4; ++ks) { float s_[8]; \
                const f32x4 m0 = *(const LAS f32x4*)(sm + RW2_MIX + 128 + 32 * ks + 8 * kg), m1 = *(const LAS f32x4*)(sm + RW2_MIX + 128 + 32 * ks + 8 * kg + 4); \
                RW_SH8(ld[2 * ks], ld[2 * ks + 1], m0, m1, s_, pz_); \
                _Pragma("unroll") for (int j = 0; j < 8; ++j) s_[j] = sigmoid_fast(s_[j]); \
                v4u aw; aw.x = cvtpk(s_[0], s_[1]); aw.y = cvtpk(s_[2], s_[3]); aw.z = cvtpk(s_[4], s_[5]); aw.w = cvtpk(s_[6], s_[7]); const bf16x8 af = __builtin_bit_cast(bf16x8, aw); \
                _Pragma("unroll") for (int nt = 0; nt < 2; ++nt) { const bf16x8 bfr = *(const bf16x8*)(G2T + (size_t)(h * 64 + half * 32 + 16 * nt + l15) * 128 + 32 * ks + 8 * kg); accg[nt] = MFMA16(af, bfr, accg[nt]); } } \
            G_ISSUE(((T0) + 32 < SEQ) ? (T0) + 32 : (T0)); \
            _Pragma("unroll") for (int nt = 0; nt < 2; ++nt) _Pragma("unroll") for (int rg = 0; rg < 4; ++rg) \
                gout[(rowb + t0_ + tb + 4 * kg + rg) * 512 + h * 64 + half * 32 + 16 * nt + l15] = (bf16_t)f2bf(accg[nt][rg]); } while (0)
        G_ISSUE(0);
        G_BUILD(0);
        __syncthreads();
#pragma unroll 1
        for (int ch = 0; ch < NCHUNK; ++ch) {
            if (ch + 1 < NCHUNK) G_BUILD(ch * 32 + 32);
            __syncthreads();
        }
#undef G_ISSUE
#undef G_BUILD
    }
#undef RW_SH8
    __syncthreads();
}

constexpr int CK_BK = 0, CK_AR = 4608, CK_BBT = 9216, CK_KBT = 12288, CK_VT = 15360, CK_GC = 16896, CK_TT = 17152, CK_SLOT = 18688, CK_NSLOT = 6, CK_NBUILD = 5;
constexpr int CK_STG = CK_SLOT * CK_NSLOT;
constexpr int CK_MIX = CK_STG + CK_NBUILD * 6144;
constexpr int CK_FLAGS = CK_MIX + 448 * 4;
static_assert(CK_FLAGS + 64 <= 146432, "rwkv chunked LDS map");
__device__ __forceinline__ void rwkv_phase(LAS float* smf, int tid, int lane, int wave, int blk, const bf16_t* __restrict__ proj, const float* __restrict__ mix, const float* __restrict__ w0, const float* __restrict__ a0,
                                           const float* __restrict__ k_k, const float* __restrict__ k_a, const float* __restrict__ r_k, const bf16_t* __restrict__ W2T, const bf16_t* __restrict__ A2T, const bf16_t* __restrict__ G2T,
                                           float* __restrict__ yraw, bf16_t* __restrict__ gout, float* __restrict__ bonus_out) {
    LAS unsigned char* lds = (LAS unsigned char*)smf;
    LAS float* mixs = (LAS float*)(lds + CK_MIX);
    volatile LAS unsigned* flags = (volatile LAS unsigned*)(lds + CK_FLAGS);
    const int chain = blk >> 1, ihalf = blk & 1, b = chain >> 3, h = chain & 7, l15 = lane & 15, kg = lane >> 4, l31 = lane & 31, hi = lane >> 5;
    const size_t rowb = (size_t)b * SEQ;
    constexpr int NCH = SEQ / 16;
    if (tid < 256) mixs[tid] = mix[1536 + tid];
    else if (tid < 448) { const int q = tid - 256; mixs[tid] = mix[512 * (q >> 6) + h * 64 + (q & 63)]; }
    if (tid < 16) flags[tid] = (tid == 9) ? (unsigned)CK_NBUILD : 0u;
    for (int q = tid; q < CK_NSLOT * 384; q += NWAVES * 64) *(LAS unsigned*)(lds + (q / 384) * CK_SLOT + CK_TT + (q % 384) * 4) = 0u;
    __syncthreads();
#define RW_SH8(CUR, PRV, M0, M1, OUT, PZ) do { const unsigned cu_[4] = {(CUR).x, (CUR).y, (CUR).z, (CUR).w}, pu_[4] = {(PRV).x, (PRV).y, (PRV).z, (PRV).w}; \
        const float mm_[8] = {(M0)[0], (M0)[1], (M0)[2], (M0)[3], (M1)[0], (M1)[1], (M1)[2], (M1)[3]}; \
        _Pragma("unroll") for (int q = 0; q < 4; ++q) { const float c0 = bflo(cu_[q]), c1 = bfhi(cu_[q]), p0 = bflo(pu_[q]) * (PZ), p1 = bfhi(pu_[q]) * (PZ); \
            OUT[2 * q] = c0 + (p0 - c0) * mm_[2 * q]; OUT[2 * q + 1] = c1 + (p1 - c1) * mm_[2 * q + 1]; } } while (0)
    if (wave == 0) {
        f32x16 ST[2];
#pragma unroll
        for (int r = 0; r < 16; ++r) { ST[0][r] = 0.f; ST[1][r] = 0.f; }
#pragma unroll 1
        for (int k = 0; k < NCH; ++k) {
#if defined(PROBE_STAMPS)
            const unsigned tw0_ = (unsigned)__builtin_amdgcn_s_memrealtime();
#endif
            { const unsigned want = (unsigned)(k + 1); const int sl = k % CK_NSLOT; while (flags[sl] != want) __builtin_amdgcn_s_sleep(1); }
#if defined(PROBE_STAMPS)
            if (blk == 0 && lane == 0) ((volatile LAS unsigned*)(lds + 146432 + 320))[16 + 24] += (unsigned)__builtin_amdgcn_s_memrealtime() - tw0_;
#endif
            asm volatile("" ::: "memory");
            const LAS unsigned char* im = lds + (k % CK_NSLOT) * CK_SLOT;
            f32x16 G;
#pragma unroll
            for (int r = 0; r < 16; ++r) G[r] = 0.f;
#pragma unroll
            for (int kk = 0; kk < 4; ++kk) { const bf16x8 fa = *(const LAS bf16x8*)(im + CK_BK + l31 * 144 + (16 * kk + 8 * hi) * 2), fb = *(const LAS bf16x8*)(im + CK_AR + l31 * 144 + (16 * kk + 8 * hi) * 2); G = MFMA32(fa, fb, G); }
            { const int tcol = l31 & 15; const bool strict = l31 < 16;
#pragma unroll
              for (int r = 0; r < 16; ++r) { const int srow = crow(r & 7, hi); const bool keep = strict ? (srow < tcol) : (srow <= tcol); G[r] = keep ? G[r] : 0.f; } }
            const bf16x8 gB = pack8(G[0], G[1], G[2], G[3], G[4], G[5], G[6], G[7]), gK = pack8(G[8], G[9], G[10], G[11], G[12], G[13], G[14], G[15]);
            f32x16 XT;
#pragma unroll
            for (int r = 0; r < 16; ++r) XT[r] = 0.f;
#pragma unroll
            for (int jt = 0; jt < 2; ++jt)
#pragma unroll
                for (int sp = 0; sp < 2; ++sp) { const LAS unsigned char* ap = im + CK_AR + l31 * 144 + (32 * jt + 16 * sp + 4 * hi) * 2;
                    const u32x2 x0 = *(const LAS u32x2*)ap, x1 = *(const LAS u32x2*)(ap + 16); v4u aw; aw.x = x0.x; aw.y = x0.y; aw.z = x1.x; aw.w = x1.y;
                    const bf16x8 sb_ = pack8(ST[jt][8 * sp], ST[jt][8 * sp + 1], ST[jt][8 * sp + 2], ST[jt][8 * sp + 3], ST[jt][8 * sp + 4], ST[jt][8 * sp + 5], ST[jt][8 * sp + 6], ST[jt][8 * sp + 7]);
                    XT = MFMA32(__builtin_bit_cast(bf16x8, aw), sb_, XT); }
            bf16x8 vP;
            { const LAS unsigned char* vp = im + CK_VT + l31 * 48 + (4 * hi) * 2; const u32x2 x0 = *(const LAS u32x2*)vp, x1 = *(const LAS u32x2*)(vp + 16); v4u vw; vw.x = x0.x; vw.y = x0.y; vw.z = x1.x; vw.w = x1.y;
              vP = __builtin_bit_cast(bf16x8, vw); XT = MFMA32(gK, vP, XT); }
            bf16x8 uP;
            { const LAS unsigned char* tp = im + CK_TT + l31 * 48 + (4 * hi) * 2; const u32x2 x0 = *(const LAS u32x2*)tp, x1 = *(const LAS u32x2*)(tp + 16); v4u tw; tw.x = x0.x; tw.y = x0.y; tw.z = x1.x; tw.w = x1.y;
              f32x16 UT;
#pragma unroll
              for (int r = 0; r < 16; ++r) UT[r] = 0.f;
              UT = MFMA32(__builtin_bit_cast(bf16x8, tw), pack8(XT[0], XT[1], XT[2], XT[3], XT[4], XT[5], XT[6], XT[7]), UT);
              uP = pack8(UT[0], UT[1], UT[2], UT[3], UT[4], UT[5], UT[6], UT[7]); }
            XT = MFMA32(gB, uP, XT);
            { float* yp = yraw + (rowb + 16 * k) * 512 + h * 64 + 32 * ihalf + l31;
#pragma unroll
              for (int q = 0; q < 8; ++q) yp[(size_t)crow(q, hi) * 512] = XT[8 + q]; }
            { const LAS float* gc = (const LAS float*)(im + CK_GC);
#pragma unroll
              for (int jt = 0; jt < 2; ++jt)
#pragma unroll
                  for (int r = 0; r < 16; ++r) ST[jt][r] *= gc[32 * jt + crow(r, hi)]; }
#pragma unroll
            for (int jt = 0; jt < 2; ++jt) { const LAS unsigned char* bp = im + CK_BBT + (32 * jt + l31) * 48 + (4 * hi) * 2; const LAS unsigned char* kp = im + CK_KBT + (32 * jt + l31) * 48 + (4 * hi) * 2;
                const u32x2 b0 = *(const LAS u32x2*)bp, b1 = *(const LAS u32x2*)(bp + 16), k0 = *(const LAS u32x2*)kp, k1 = *(const LAS u32x2*)(kp + 16);
                v4u a1; a1.x = b0.x; a1.y = b0.y; a1.z = b1.x; a1.w = b1.y; v4u a2; a2.x = k0.x; a2.y = k0.y; a2.z = k1.x; a2.w = k1.y;
                ST[jt] = MFMA32(__builtin_bit_cast(bf16x8, a1), uP, ST[jt]); ST[jt] = MFMA32(__builtin_bit_cast(bf16x8, a2), vP, ST[jt]); }
            WSYNC();
            if (lane == 0) flags[8] = (unsigned)(k + 1);
        }
    } else if (wave <= CK_NBUILD) {
        const int pw = wave - 1;
        LAS bf16_t* stg = (LAS bf16_t*)(lds + CK_STG) + pw * 3072;
        float w0c[4], a0c[4], kkc[4], kac[4], rkc[4];
#pragma unroll
        for (int nt = 0; nt < 4; ++nt) { const int c = h * 64 + 16 * nt + l15; w0c[nt] = w0[c]; a0c[nt] = a0[c]; kkc[nt] = k_k[c]; kac[nt] = k_a[c]; rkc[nt] = r_k[c]; }
        v4u ld[20];
#define CK_ISSUE_A(T0) do { const int t0_ = (T0); const size_t r_ = rowb + t0_ + l15; const size_t rp_ = (t0_ + l15 == 0) ? r_ : r_ - 1; \
            _Pragma("unroll") for (int lo = 0; lo < 2; ++lo) _Pragma("unroll") for (int ks = 0; ks < 2; ++ks) { const int col = 1536 + 64 * lo + 32 * ks + 8 * kg; \
                ld[(lo * 2 + ks) * 2] = *(const v4u*)(proj + r_ * L0P + col); ld[(lo * 2 + ks) * 2 + 1] = *(const v4u*)(proj + rp_ * L0P + col); } } while (0)
#define CK_ISSUE_B(T0) do { const int t0_ = (T0); \
            _Pragma("unroll") for (int ar = 0; ar < 3; ++ar) _Pragma("unroll") for (int i = 0; i < 2; ++i) { const int p_ = lane + 64 * i, row_ = p_ >> 3, c8_ = p_ & 7; \
                const size_t r_ = rowb + t0_ + row_; const size_t rp_ = (t0_ + row_ == 0) ? r_ : r_ - 1; const int col = 512 * ar + h * 64 + 8 * c8_; \
                ld[8 + (ar * 2 + i) * 2] = *(const v4u*)(proj + r_ * L0P + col); ld[8 + (ar * 2 + i) * 2 + 1] = *(const v4u*)(proj + rp_ * L0P + col); } } while (0)
#define CK_ISSUE(T0) do { CK_ISSUE_A(T0); CK_ISSUE_B(T0); } while (0)
        CK_ISSUE(16 * pw);
        int k = pw;
#pragma unroll 1
        while (k < NCH) {
            const int t0 = 16 * k; int kn;
#if defined(PROBE_STAMPS)
            const unsigned ts0_ = (unsigned)__builtin_amdgcn_s_memrealtime();
#endif
            f32x4 accw[4], acca[4];
#pragma unroll
            for (int nt = 0; nt < 4; ++nt) { accw[nt] = (f32x4){0.f, 0.f, 0.f, 0.f}; acca[nt] = (f32x4){0.f, 0.f, 0.f, 0.f}; }
            { const float pz_ = (t0 + l15 == 0) ? 0.f : 1.f;
#pragma unroll
              for (int lo = 0; lo < 2; ++lo)
#pragma unroll
                for (int ks = 0; ks < 2; ++ks) { float s_[8];
                    const f32x4 m0 = *(const LAS f32x4*)(mixs + 64 * lo + 32 * ks + 8 * kg), m1 = *(const LAS f32x4*)(mixs + 64 * lo + 32 * ks + 8 * kg + 4);
                    RW_SH8(ld[(lo * 2 + ks) * 2], ld[(lo * 2 + ks) * 2 + 1], m0, m1, s_, pz_);
                    if (lo == 0) {
#pragma unroll
                        for (int j = 0; j < 8; ++j) s_[j] = tanh_fast(s_[j]); }
                    const bf16x8 af = pack8(s_[0], s_[1], s_[2], s_[3], s_[4], s_[5], s_[6], s_[7]);
                    const bf16_t* WT = lo ? A2T : W2T;
#pragma unroll
                    for (int nt = 0; nt < 4; ++nt) { const bf16x8 bfr = *(const bf16x8*)(WT + (size_t)(h * 64 + 16 * nt + l15) * 64 + 32 * ks + 8 * kg);
                        if (lo == 0) accw[nt] = MFMA16(af, bfr, accw[nt]); else acca[nt] = MFMA16(af, bfr, acca[nt]); } } }
#pragma unroll
            for (int ar = 0; ar < 3; ++ar)
#pragma unroll
                for (int i = 0; i < 2; ++i) { const int p_ = lane + 64 * i, row_ = p_ >> 3, c8_ = p_ & 7; float s_[8];
                    const float pz_ = (t0 + row_ == 0) ? 0.f : 1.f; const f32x4 m0 = *(const LAS f32x4*)(mixs + 256 + ar * 64 + c8_ * 8), m1 = *(const LAS f32x4*)(mixs + 256 + ar * 64 + c8_ * 8 + 4);
                    RW_SH8(ld[8 + (ar * 2 + i) * 2], ld[8 + (ar * 2 + i) * 2 + 1], m0, m1, s_, pz_);
                    *(LAS bf16x8*)(stg + ar * 1024 + row_ * 64 + c8_ * 8) = pack8(s_[0], s_[1], s_[2], s_[3], s_[4], s_[5], s_[6], s_[7]); }
            WSYNC();
#if defined(PROBE_STAMPS)
            if (blk == 0 && wave == 1 && lane == 0) ((volatile LAS unsigned*)(lds + 146432 + 320))[16 + 26] += (unsigned)__builtin_amdgcn_s_memrealtime() - ts0_;
#endif
#if defined(PROBE_STAMPS)
            const unsigned tb0_ = (unsigned)__builtin_amdgcn_s_memrealtime();
#endif
            { const int need = k - (CK_NSLOT - 1); if (need > 0) { while ((int)flags[8] < need) __builtin_amdgcn_s_sleep(2); } }
#if defined(PROBE_STAMPS)
            if (blk == 0 && wave == 1 && lane == 0) ((volatile LAS unsigned*)(lds + 146432 + 320))[16 + 25] += (unsigned)__builtin_amdgcn_s_memrealtime() - tb0_;
#endif
            asm volatile("" ::: "memory");
            LAS unsigned char* im = lds + (k % CK_NSLOT) * CK_SLOT;
#if defined(PROBE_STAMPS)
            const unsigned ts1_ = (unsigned)__builtin_amdgcn_s_memrealtime();
#endif
            float lwv[4][4], av[4][4], knv[4][4];
#pragma unroll
            for (int rg = 0; rg < 4; ++rg) { const int tl = 4 * kg + rg;
                float kkv[4], nrm2 = 0.f, vv[4], rr_[4], kr_[4];
#pragma unroll
                for (int nt = 0; nt < 4; ++nt) { rr_[nt] = bf2f(stg[tl * 64 + 16 * nt + l15]); kr_[nt] = bf2f(stg[1024 + tl * 64 + 16 * nt + l15]); vv[nt] = bf2f(stg[2048 + tl * 64 + 16 * nt + l15]);
                    kkv[nt] = kr_[nt] * kkc[nt]; nrm2 += kkv[nt] * kkv[nt]; }
                nrm2 = rowsum16(nrm2); const float rn = __builtin_amdgcn_rsqf(fmaxf(nrm2, 1e-24f));
                float bon = 0.f;
#pragma unroll
                for (int nt = 0; nt < 4; ++nt) {
                    const float wsum = w0c[nt] + accw[nt][rg]; lwv[nt][rg] = -0.6065306597126334f * sigmoid_fast(wsum);
                    const float a_ = sigmoid_fast(a0c[nt] + acca[nt][rg]); av[nt][rg] = a_; knv[nt][rg] = kkv[nt] * rn;
                    const float k2 = kr_[nt] * (1.f + (a_ - 1.f) * kac[nt]); stg[1024 + tl * 64 + 16 * nt + l15] = bf1(k2);
                    bon += rr_[nt] * k2 * rkc[nt];
                    if ((nt >> 1) == ihalf) *(LAS bf16_t*)(im + CK_VT + (16 * (nt & 1) + l15) * 48 + tl * 2) = bf1(vv[nt]);
                }
                bon = rowsum16(bon);
                if (l15 == 0 && ihalf == 0) bonus_out[(rowb + t0 + tl) * 8 + h] = bon;
            }
            { unsigned g_ = 0; if (lane == 0) g_ = __hip_atomic_fetch_add((LAS unsigned*)(lds + CK_FLAGS + 36), 1u, __ATOMIC_RELAXED, __HIP_MEMORY_SCOPE_WORKGROUP);
              kn = (int)__builtin_amdgcn_readfirstlane(g_); }
            CK_ISSUE_A((kn < NCH) ? 16 * kn : t0);
#pragma unroll
            for (int nt = 0; nt < 4; ++nt) {
                float L[4]; L[0] = lwv[nt][0]; L[1] = L[0] + lwv[nt][1]; L[2] = L[1] + lwv[nt][2]; L[3] = L[2] + lwv[nt][3];
                const float T0 = __shfl(L[3], l15), T1 = __shfl(L[3], 16 + l15), T2 = __shfl(L[3], 32 + l15), T3 = __shfl(L[3], 48 + l15);
                const float off = (kg > 0 ? T0 : 0.f) + (kg > 1 ? T1 : 0.f) + (kg > 2 ? T2 : 0.f), LC = (T0 + T1) + (T2 + T3);
                const int j = 16 * nt + l15;
                unsigned bb2[2], kb2[2];
                const float gC = __expf(LC); float eprev = __expf(off);
#pragma unroll
                for (int rg = 0; rg < 4; ++rg) { const int tl = 4 * kg + rg; const float Lt = off + L[rg], e1 = __expf(Lt), e2 = __builtin_amdgcn_rcpf(e1), e3 = eprev, e4 = gC * e2; eprev = e1;
                    const float kn = knv[nt][rg], bvv = kn * av[nt][rg], k2 = bf2f(stg[1024 + tl * 64 + j]), rr2 = bf2f(stg[tl * 64 + j]);
                    *(LAS bf16_t*)(im + CK_BK + tl * 144 + j * 2) = bf1(bvv * e2); *(LAS bf16_t*)(im + CK_BK + (16 + tl) * 144 + j * 2) = bf1(k2 * e2);
                    *(LAS bf16_t*)(im + CK_AR + tl * 144 + j * 2) = bf1(-kn * e3); *(LAS bf16_t*)(im + CK_AR + (16 + tl) * 144 + j * 2) = bf1(rr2 * e1);
                    const unsigned bq = bf1(bvv * e4), kq = bf1(k2 * e4);
                    if (rg & 1) { bb2[rg >> 1] |= bq << 16; kb2[rg >> 1] |= kq << 16; } else { bb2[rg >> 1] = bq; kb2[rg >> 1] = kq; } }
                *(LAS u32x2*)(im + CK_BBT + j * 48 + (4 * kg) * 2) = (u32x2){bb2[0], bb2[1]}; *(LAS u32x2*)(im + CK_KBT + j * 48 + (4 * kg) * 2) = (u32x2){kb2[0], kb2[1]};
                if (kg == 0) *(LAS float*)(im + CK_GC + j * 4) = gC;
            }
            WSYNC();
#if defined(PROBE_STAMPS)
            const unsigned ts2_ = (unsigned)__builtin_amdgcn_s_memrealtime();
            if (blk == 0 && wave == 1 && lane == 0) ((volatile LAS unsigned*)(lds + 146432 + 320))[16 + 27] += ts2_ - ts1_;
#endif
            {
                f32x4 nacc = {0.f, 0.f, 0.f, 0.f};
#pragma unroll
                for (int ks = 0; ks < 2; ++ks) { const bf16x8 fa = *(const LAS bf16x8*)(im + CK_BK + l15 * 144 + (32 * ks + 8 * kg) * 2), fb = *(const LAS bf16x8*)(im + CK_AR + l15 * 144 + (32 * ks + 8 * kg) * 2); nacc = MFMA16(fa, fb, nacc); }
#pragma unroll
                for (int rg = 0; rg < 4; ++rg) nacc[rg] = ((4 * kg + rg) < l15) ? nacc[rg] : 0.f;
                float Tr[16];
#pragma unroll
                for (int t = 0; t < 16; ++t) { float acc_ = (l15 == t) ? 1.f : 0.f;
#pragma unroll
                    for (int s2 = 0; s2 < t; ++s2) acc_ += Tr[s2] * rl(nacc[s2 & 3], t + 16 * (s2 >> 2));
                    Tr[t] = acc_; }
                if (kg == 0) {
#pragma unroll
                    for (int t = 0; t < 16; ++t) *(LAS bf16_t*)(im + CK_TT + t * 48 + l15 * 2) = bf1(Tr[t]); }
            }
            WSYNC();
#if defined(PROBE_STAMPS)
            if (blk == 0 && wave == 1 && lane == 0) ((volatile LAS unsigned*)(lds + 146432 + 320))[16 + 28] += (unsigned)__builtin_amdgcn_s_memrealtime() - ts2_;
#endif
            if (lane == 0) flags[k % CK_NSLOT] = (unsigned)(k + 1);
            CK_ISSUE_B((kn < NCH) ? 16 * kn : t0);
            k = kn;
        }
#undef CK_ISSUE
#undef CK_ISSUE_A
#undef CK_ISSUE_B
    } else {
        const int gq = wave - 6;
        v4u ld[8];
#define G_ISSUE(T0) do { const int t0_ = (T0); const size_t r_ = rowb + t0_ + l15; const size_t rp_ = (t0_ + l15 == 0) ? r_ : r_ - 1; \
            _Pragma("unroll") for (int ks = 0; ks < 4; ++ks) { const int col = 1664 + 32 * ks + 8 * kg; ld[2 * ks] = *(const v4u*)(proj + r_ * L0P + col); ld[2 * ks + 1] = *(const v4u*)(proj + rp_ * L0P + col); } } while (0)
        G_ISSUE(16 * gq);
#pragma unroll 1
        for (int k = gq; k < NCH; k += 2) {
            const int t0 = 16 * k;
            f32x4 accg[2] = {(f32x4){0.f, 0.f, 0.f, 0.f}, (f32x4){0.f, 0.f, 0.f, 0.f}}; const float pz_ = (t0 + l15 == 0) ? 0.f : 1.f;
#pragma unroll
            for (int ks = 0; ks < 4; ++ks) { float s_[8];
                const f32x4 m0 = *(const LAS f32x4*)(mixs + 128 + 32 * ks + 8 * kg), m1 = *(const LAS f32x4*)(mixs + 128 + 32 * ks + 8 * kg + 4);
                RW_SH8(ld[2 * ks], ld[2 * ks + 1], m0, m1, s_, pz_);
#pragma unroll
                for (int j = 0; j < 8; ++j) s_[j] = sigmoid_fast(s_[j]);
                const bf16x8 af = pack8(s_[0], s_[1], s_[2], s_[3], s_[4], s_[5], s_[6], s_[7]);
#pragma unroll
                for (int nt = 0; nt < 2; ++nt) { const bf16x8 bfr = *(const bf16x8*)(G2T + (size_t)(h * 64 + ihalf * 32 + 16 * nt + l15) * 128 + 32 * ks + 8 * kg); accg[nt] = MFMA16(af, bfr, accg[nt]); } }
            G_ISSUE((k + 2 < NCH) ? t0 + 32 : t0);
#pragma unroll
            for (int nt = 0; nt < 2; ++nt)
#pragma unroll
                for (int rg = 0; rg < 4; ++rg) gout[(rowb + t0 + 4 * kg + rg) * 512 + h * 64 + ihalf * 32 + 16 * nt + l15] = bf1(accg[nt][rg]);
        }
#undef G_ISSUE
    }
#undef RW_SH8
    __syncthreads();
}

constexpr int CC_BK = 0, CC_AR = 4608, CC_BBT = 9216, CC_KBT = 11776, CC_VT = 14336, CC_GC = 16896, CC_TT = 17152, CC_SLOT = 18432, CC_NSLOT = 6, CC_NBUILD = 6;
constexpr int CC_STG = CC_SLOT * CC_NSLOT;
constexpr int CC_MIX = CC_STG + CC_NBUILD * 4096;
constexpr int CC_FLAGS = CC_MIX + 448 * 4;
static_assert(CC_FLAGS + 64 <= 146432, "rwkv chain LDS map");
__device__ __forceinline__ void rwkv_phase_chain(LAS float* smf, int tid, int lane, int wave, int blk, const bf16_t* __restrict__ proj, const float* __restrict__ mix, const float* __restrict__ w0, const float* __restrict__ a0,
                                           const float* __restrict__ k_k, const float* __restrict__ k_a, const float* __restrict__ r_k, const bf16_t* __restrict__ W2T, const bf16_t* __restrict__ A2T, const bf16_t* __restrict__ G2T,
                                           float* __restrict__ yraw, bf16_t* __restrict__ gout, float* __restrict__ bonus_out) {
    LAS unsigned char* lds = (LAS unsigned char*)smf;
    LAS float* mixs = (LAS float*)(lds + CC_MIX);
    volatile LAS unsigned* flags = (volatile LAS unsigned*)(lds + CC_FLAGS);
    const int chain = blk, b = chain >> 3, h = chain & 7, l15 = lane & 15, kg = lane >> 4, l31 = lane & 31, hi = lane >> 5;
    const size_t rowb = (size_t)b * SEQ;
    constexpr int NCH = SEQ / 16;
    if (tid < 256) mixs[tid] = mix[1536 + tid];
    else if (tid < 448) { const int q = tid - 256; mixs[tid] = mix[512 * (q >> 6) + h * 64 + (q & 63)]; }
    if (tid < 16) flags[tid] = (tid == 10) ? (unsigned)CC_NBUILD : 0u;
    for (int q = tid; q < CC_NSLOT * 320; q += NWAVES * 64) *(LAS unsigned*)(lds + (q / 320) * CC_SLOT + CC_TT + (q % 320) * 4) = 0u;
    __syncthreads();
#define RW_SH8(CUR, PRV, M0, M1, OUT, PZ) do { const unsigned cu_[4] = {(CUR).x, (CUR).y, (CUR).z, (CUR).w}, pu_[4] = {(PRV).x, (PRV).y, (PRV).z, (PRV).w}; \
        const float mm_[8] = {(M0)[0], (M0)[1], (M0)[2], (M0)[3], (M1)[0], (M1)[1], (M1)[2], (M1)[3]}; \
        _Pragma("unroll") for (int q = 0; q < 4; ++q) { const float c0 = bflo(cu_[q]), c1 = bfhi(cu_[q]), p0 = bflo(pu_[q]) * (PZ), p1 = bfhi(pu_[q]) * (PZ); \
            OUT[2 * q] = c0 + (p0 - c0) * mm_[2 * q]; OUT[2 * q + 1] = c1 + (p1 - c1) * mm_[2 * q + 1]; } } while (0)
    if (wave < 2) {
        const int ihalf = wave;
        f32x16 ST[2];
#pragma unroll
        for (int r = 0; r < 16; ++r) { ST[0][r] = 0.f; ST[1][r] = 0.f; }
#pragma unroll 1
        for (int k = 0; k < NCH; ++k) {
            { const unsigned want = (unsigned)(k + 1); const int sl = k % CC_NSLOT; while (flags[sl] != want) __builtin_amdgcn_s_sleep(1); }
            asm volatile("" ::: "memory");
            const LAS unsigned char* im = lds + (k % CC_NSLOT) * CC_SLOT;
            f32x16 G;
#pragma unroll
            for (int r = 0; r < 16; ++r) G[r] = 0.f;
#pragma unroll
            for (int kk = 0; kk < 4; ++kk) { const bf16x8 fa = *(const LAS bf16x8*)(im + CC_BK + l31 * 144 + (16 * kk + 8 * hi) * 2), fb = *(const LAS bf16x8*)(im + CC_AR + l31 * 144 + (16 * kk + 8 * hi) * 2); G = MFMA32(fa, fb, G); }
            { const int tcol = l31 & 15; const bool strict = l31 < 16;
#pragma unroll
              for (int r = 0; r < 16; ++r) { const int srow = crow(r & 7, hi); const bool keep = strict ? (srow < tcol) : (srow <= tcol); G[r] = keep ? G[r] : 0.f; } }
            const bf16x8 gB = pack8(G[0], G[1], G[2], G[3], G[4], G[5], G[6], G[7]), gK = pack8(G[8], G[9], G[10], G[11], G[12], G[13], G[14], G[15]);
            f32x16 XT;
#pragma unroll
            for (int r = 0; r < 16; ++r) XT[r] = 0.f;
#pragma unroll
            for (int jt = 0; jt < 2; ++jt)
#pragma unroll
                for (int sp = 0; sp < 2; ++sp) { const LAS unsigned char* ap = im + CC_AR + l31 * 144 + (32 * jt + 16 * sp + 4 * hi) * 2;
                    const u32x2 x0 = *(const LAS u32x2*)ap, x1 = *(const LAS u32x2*)(ap + 16); v4u aw; aw.x = x0.x; aw.y = x0.y; aw.z = x1.x; aw.w = x1.y;
                    const bf16x8 sb_ = pack8(ST[jt][8 * sp], ST[jt][8 * sp + 1], ST[jt][8 * sp + 2], ST[jt][8 * sp + 3], ST[jt][8 * sp + 4], ST[jt][8 * sp + 5], ST[jt][8 * sp + 6], ST[jt][8 * sp + 7]);
                    XT = MFMA32(__builtin_bit_cast(bf16x8, aw), sb_, XT); }
            bf16x8 vP;
            { const LAS unsigned char* vp = im + CC_VT + (32 * ihalf + l31) * 40 + (4 * hi) * 2; const u32x2 x0 = *(const LAS u32x2*)vp, x1 = *(const LAS u32x2*)(vp + 16); v4u vw; vw.x = x0.x; vw.y = x0.y; vw.z = x1.x; vw.w = x1.y;
              vP = __builtin_bit_cast(bf16x8, vw); XT = MFMA32(gK, vP, XT); }
            bf16x8 uP;
            { const LAS unsigned char* tp = im + CC_TT + l31 * 40 + (4 * hi) * 2; const u32x2 x0 = *(const LAS u32x2*)tp, x1 = *(const LAS u32x2*)(tp + 16); v4u tw; tw.x = x0.x; tw.y = x0.y; tw.z = x1.x; tw.w = x1.y;
              f32x16 UT;
#pragma unroll
              for (int r = 0; r < 16; ++r) UT[r] = 0.f;
              UT = MFMA32(__builtin_bit_cast(bf16x8, tw), pack8(XT[0], XT[1], XT[2], XT[3], XT[4], XT[5], XT[6], XT[7]), UT);
              uP = pack8(UT[0], UT[1], UT[2], UT[3], UT[4], UT[5], UT[6], UT[7]); }
            XT = MFMA32(gB, uP, XT);
            { float* yp = yraw + (rowb + 16 * k) * 512 + h * 64 + 32 * ihalf + l31;
#pragma unroll
              for (int q = 0; q < 8; ++q) yp[(size_t)crow(q, hi) * 512] = XT[8 + q]; }
            { const LAS float* gc = (const LAS float*)(im + CC_GC);
#pragma unroll
              for (int jt = 0; jt < 2; ++jt)
#pragma unroll
                  for (int r = 0; r < 16; ++r) ST[jt][r] *= gc[32 * jt + crow(r, hi)]; }
#pragma unroll
            for (int jt = 0; jt < 2; ++jt) { const LAS unsigned char* bp = im + CC_BBT + (32 * jt + l31) * 40 + (4 * hi) * 2; const LAS unsigned char* kp = im + CC_KBT + (32 * jt + l31) * 40 + (4 * hi) * 2;
                const u32x2 b0 = *(const LAS u32x2*)bp, b1 = *(const LAS u32x2*)(bp + 16), k0 = *(const LAS u32x2*)kp, k1 = *(const LAS u32x2*)(kp + 16);
                v4u a1; a1.x = b0.x; a1.y = b0.y; a1.z = b1.x; a1.w = b1.y; v4u a2; a2.x = k0.x; a2.y = k0.y; a2.z = k1.x; a2.w = k1.y;
                ST[jt] = MFMA32(__builtin_bit_cast(bf16x8, a1), uP, ST[jt]); ST[jt] = MFMA32(__builtin_bit_cast(bf16x8, a2), vP, ST[jt]); }
            WSYNC();
            if (lane == 0) flags[8 + ihalf] = (unsigned)(k + 1);
        }
    } else {
        const int pw = wave - 2;
        LAS bf16_t* stg = (LAS bf16_t*)(lds + CC_STG) + pw * 2048;
        v4u ld[20];
#define CC_ISSUE_A(T0) do { const int t0_ = (T0); const size_t r_ = rowb + t0_ + l15; const size_t rp_ = (t0_ + l15 == 0) ? r_ : r_ - 1; \
            _Pragma("unroll") for (int lo = 0; lo < 2; ++lo) _Pragma("unroll") for (int ks = 0; ks < 2; ++ks) { const int col = 1536 + 64 * lo + 32 * ks + 8 * kg; \
                ld[(lo * 2 + ks) * 2] = *(const v4u*)(proj + r_ * L0P + col); ld[(lo * 2 + ks) * 2 + 1] = *(const v4u*)(proj + rp_ * L0P + col); } } while (0)
#define CC_ISSUE_B(T0) do { const int t0_ = (T0); \
            _Pragma("unroll") for (int ar = 0; ar < 3; ++ar) _Pragma("unroll") for (int i = 0; i < 2; ++i) { const int p_ = lane + 64 * i, row_ = p_ >> 3, c8_ = p_ & 7; \
                const size_t r_ = rowb + t0_ + row_; const size_t rp_ = (t0_ + row_ == 0) ? r_ : r_ - 1; const int col = 512 * ar + h * 64 + 8 * c8_; \
                ld[8 + (ar * 2 + i) * 2] = *(const v4u*)(proj + r_ * L0P + col); ld[8 + (ar * 2 + i) * 2 + 1] = *(const v4u*)(proj + rp_ * L0P + col); } } while (0)
#define CC_ISSUE(T0) do { CC_ISSUE_A(T0); CC_ISSUE_B(T0); } while (0)
        CC_ISSUE(16 * pw);
        int k = pw;
#pragma unroll 1
        while (k < NCH) {
            const int t0 = 16 * k; int kn;
            f32x4 accw[4], acca[4];
#pragma unroll
            for (int nt = 0; nt < 4; ++nt) { accw[nt] = (f32x4){0.f, 0.f, 0.f, 0.f}; acca[nt] = (f32x4){0.f, 0.f, 0.f, 0.f}; }
            { const float pz_ = (t0 + l15 == 0) ? 0.f : 1.f;
#pragma unroll
              for (int lo = 0; lo < 2; ++lo)
#pragma unroll
                for (int ks = 0; ks < 2; ++ks) { float s_[8];
                    const f32x4 m0 = *(const LAS f32x4*)(mixs + 64 * lo + 32 * ks + 8 * kg), m1 = *(const LAS f32x4*)(mixs + 64 * lo + 32 * ks + 8 * kg + 4);
                    RW_SH8(ld[(lo * 2 + ks) * 2], ld[(lo * 2 + ks) * 2 + 1], m0, m1, s_, pz_);
                    if (lo == 0) {
#pragma unroll
                        for (int j = 0; j < 8; ++j) s_[j] = tanh_fast(s_[j]); }
                    const bf16x8 af = pack8(s_[0], s_[1], s_[2], s_[3], s_[4], s_[5], s_[6], s_[7]);
                    const bf16_t* WT = lo ? A2T : W2T;
#pragma unroll
                    for (int nt = 0; nt < 4; ++nt) { const bf16x8 bfr = *(const bf16x8*)(WT + (size_t)(h * 64 + 16 * nt + l15) * 64 + 32 * ks + 8 * kg);
                        if (lo == 0) accw[nt] = MFMA16(af, bfr, accw[nt]); else acca[nt] = MFMA16(af, bfr, acca[nt]); } } }
            { const int need = k - (CC_NSLOT - 1); if (need > 0) { while ((int)flags[8] < need || (int)flags[9] < need) __builtin_amdgcn_s_sleep(2); } }
            asm volatile("" ::: "memory");
            LAS unsigned char* im = lds + (k % CC_NSLOT) * CC_SLOT;
#pragma unroll
            for (int ar = 0; ar < 3; ++ar)
#pragma unroll
                for (int i = 0; i < 2; ++i) { const int p_ = lane + 64 * i, row_ = p_ >> 3, c8_ = p_ & 7; float s_[8];
                    const float pz_ = (t0 + row_ == 0) ? 0.f : 1.f; const f32x4 m0 = *(const LAS f32x4*)(mixs + 256 + ar * 64 + c8_ * 8), m1 = *(const LAS f32x4*)(mixs + 256 + ar * 64 + c8_ * 8 + 4);
                    RW_SH8(ld[8 + (ar * 2 + i) * 2], ld[8 + (ar * 2 + i) * 2 + 1], m0, m1, s_, pz_);
                    if (ar < 2) *(LAS bf16x8*)(stg + ar * 1024 + row_ * 64 + c8_ * 8) = pack8(s_[0], s_[1], s_[2], s_[3], s_[4], s_[5], s_[6], s_[7]);
                    else {
#pragma unroll
                        for (int j = 0; j < 8; ++j) *(LAS bf16_t*)(im + CC_VT + (c8_ * 8 + j) * 40 + row_ * 2) = bf1(s_[j]); } }
            WSYNC();
            float lwv[4][4], av[4][4], knv[4][4];
            float w0c[4], a0c[4], kkc[4], kac[4], rkc[4];
#pragma unroll
            for (int nt = 0; nt < 4; ++nt) { const int c = h * 64 + 16 * nt + l15; w0c[nt] = w0[c]; a0c[nt] = a0[c]; kkc[nt] = k_k[c]; kac[nt] = k_a[c]; rkc[nt] = r_k[c]; }
#pragma unroll
            for (int rg = 0; rg < 4; ++rg) { const int tl = 4 * kg + rg;
                float kkv[4], nrm2 = 0.f, rr_[4], kr_[4];
#pragma unroll
                for (int nt = 0; nt < 4; ++nt) { rr_[nt] = bf2f(stg[tl * 64 + 16 * nt + l15]); kr_[nt] = bf2f(stg[1024 + tl * 64 + 16 * nt + l15]);
                    kkv[nt] = kr_[nt] * kkc[nt]; nrm2 += kkv[nt] * kkv[nt]; }
                nrm2 = rowsum16(nrm2); const float rn = __builtin_amdgcn_rsqf(fmaxf(nrm2, 1e-24f));
                float bon = 0.f;
#pragma unroll
                for (int nt = 0; nt < 4; ++nt) {
                    const float wsum = w0c[nt] + accw[nt][rg]; lwv[nt][rg] = -0.6065306597126334f * sigmoid_fast(wsum);
                    const float a_ = sigmoid_fast(a0c[nt] + acca[nt][rg]); av[nt][rg] = a_; knv[nt][rg] = kkv[nt] * rn;
                    const float k2 = kr_[nt] * (1.f + (a_ - 1.f) * kac[nt]); stg[1024 + tl * 64 + 16 * nt + l15] = bf1(k2);
                    bon += rr_[nt] * k2 * rkc[nt];
                }
                bon = rowsum16(bon);
                if (l15 == 0) bonus_out[(rowb + t0 + tl) * 8 + h] = bon;
            }
            { unsigned g_ = 0; if (lane == 0) g_ = __hip_atomic_fetch_add((LAS unsigned*)(lds + CC_FLAGS + 40), 1u, __ATOMIC_RELAXED, __HIP_MEMORY_SCOPE_WORKGROUP);
              kn = (int)__builtin_amdgcn_readfirstlane(g_); }
            CC_ISSUE_A((kn < NCH) ? 16 * kn : t0);
#pragma unroll
            for (int nt = 0; nt < 4; ++nt) {
                float L[4]; L[0] = lwv[nt][0]; L[1] = L[0] + lwv[nt][1]; L[2] = L[1] + lwv[nt][2]; L[3] = L[2] + lwv[nt][3];
                const float T0 = __shfl(L[3], l15), T1 = __shfl(L[3], 16 + l15), T2 = __shfl(L[3], 32 + l15), T3 = __shfl(L[3], 48 + l15);
                const float off = (kg > 0 ? T0 : 0.f) + (kg > 1 ? T1 : 0.f) + (kg > 2 ? T2 : 0.f), LC = (T0 + T1) + (T2 + T3);
                const int j = 16 * nt + l15;
                unsigned bb2[2], kb2[2];
                const float gC = __expf(LC); float eprev = __expf(off);
#pragma unroll
                for (int rg = 0; rg < 4; ++rg) { const int tl = 4 * kg + rg; const float Lt = off + L[rg], e1 = __expf(Lt), e2 = __builtin_amdgcn_rcpf(e1), e3 = eprev, e4 = gC * e2; eprev = e1;
                    const float kn = knv[nt][rg], bvv = kn * av[nt][rg], k2 = bf2f(stg[1024 + tl * 64 + j]), rr2 = bf2f(stg[tl * 64 + j]);
                    *(LAS bf16_t*)(im + CC_BK + tl * 144 + j * 2) = bf1(bvv * e2); *(LAS bf16_t*)(im + CC_BK + (16 + tl) * 144 + j * 2) = bf1(k2 * e2);
                    *(LAS bf16_t*)(im + CC_AR + tl * 144 + j * 2) = bf1(-kn * e3); *(LAS bf16_t*)(im + CC_AR + (16 + tl) * 144 + j * 2) = bf1(rr2 * e1);
                    const unsigned bq = bf1(bvv * e4), kq = bf1(k2 * e4);
                    if (rg & 1) { bb2[rg >> 1] |= bq << 16; kb2[rg >> 1] |= kq << 16; } else { bb2[rg >> 1] = bq; kb2[rg >> 1] = kq; } }
                *(LAS u32x2*)(im + CC_BBT + j * 40 + (4 * kg) * 2) = (u32x2){bb2[0], bb2[1]}; *(LAS u32x2*)(im + CC_KBT + j * 40 + (4 * kg) * 2) = (u32x2){kb2[0], kb2[1]};
                if (kg == 0) *(LAS float*)(im + CC_GC + j * 4) = gC;
            }
            WSYNC();
            {
                f32x4 nacc = {0.f, 0.f, 0.f, 0.f};
#pragma unroll
                for (int ks = 0; ks < 2; ++ks) { const bf16x8 fa = *(const LAS bf16x8*)(im + CC_BK + l15 * 144 + (32 * ks + 8 * kg) * 2), fb = *(const LAS bf16x8*)(im + CC_AR + l15 * 144 + (32 * ks + 8 * kg) * 2); nacc = MFMA16(fa, fb, nacc); }
#pragma unroll
                for (int rg = 0; rg < 4; ++rg) nacc[rg] = ((4 * kg + rg) < l15) ? nacc[rg] : 0.f;
                float Tr[16];
#pragma unroll
                for (int t = 0; t < 16; ++t) { float acc_ = (l15 == t) ? 1.f : 0.f;
#pragma unroll
                    for (int s2 = 0; s2 < t; ++s2) acc_ += Tr[s2] * rl(nacc[s2 & 3], t + 16 * (s2 >> 2));
                    Tr[t] = acc_; }
                if (kg == 0) {
#pragma unroll
                    for (int t = 0; t < 16; ++t) *(LAS bf16_t*)(im + CC_TT + t * 40 + l15 * 2) = bf1(Tr[t]); }
            }
            WSYNC();
            if (lane == 0) flags[k % CC_NSLOT] = (unsigned)(k + 1);
            CC_ISSUE_B((kn < NCH) ? 16 * kn : t0);
            k = kn;
        }
#undef CC_ISSUE
#undef CC_ISSUE_A
#undef CC_ISSUE_B
    }
#undef RW_SH8
    __syncthreads();
}


__device__ __forceinline__ void gate_lora_task(int chain, int k, int lane, const bf16_t* __restrict__ proj, const float* __restrict__ mix, const bf16_t* __restrict__ G2T, bf16_t* __restrict__ gout) {
    const int b = chain >> 3, h = chain & 7, l15 = lane & 15, kg = lane >> 4, t0 = 16 * k;
    const size_t rowb = (size_t)b * SEQ, r_ = rowb + t0 + l15, rp_ = (t0 + l15 == 0) ? r_ : r_ - 1;
    const float pz_ = (t0 + l15 == 0) ? 0.f : 1.f;
    v4u cu[4], pv[4];
#pragma unroll
    for (int ks = 0; ks < 4; ++ks) { const int col = 1664 + 32 * ks + 8 * kg; cu[ks] = *(const v4u*)(proj + r_ * L0P + col); pv[ks] = *(const v4u*)(proj + rp_ * L0P + col); }
    f32x4 accg[4];
#pragma unroll
    for (int nt = 0; nt < 4; ++nt) accg[nt] = (f32x4){0.f, 0.f, 0.f, 0.f};
#pragma unroll
    for (int ks = 0; ks < 4; ++ks) {
        const f32x4 m0 = *(const f32x4*)(mix + 1664 + 32 * ks + 8 * kg), m1 = *(const f32x4*)(mix + 1664 + 32 * ks + 8 * kg + 4);
        const float mm[8] = {m0[0], m0[1], m0[2], m0[3], m1[0], m1[1], m1[2], m1[3]};
        const unsigned cw[4] = {cu[ks].x, cu[ks].y, cu[ks].z, cu[ks].w}, pw[4] = {pv[ks].x, pv[ks].y, pv[ks].z, pv[ks].w};
        float s_[8];
#pragma unroll
        for (int q = 0; q < 4; ++q) { const float c0 = bflo(cw[q]), c1 = bfhi(cw[q]), p0 = bflo(pw[q]) * pz_, p1 = bfhi(pw[q]) * pz_;
            s_[2 * q] = sigmoid_fast(c0 + (p0 - c0) * mm[2 * q]); s_[2 * q + 1] = sigmoid_fast(c1 + (p1 - c1) * mm[2 * q + 1]); }
        const bf16x8 af = pack8(s_[0], s_[1], s_[2], s_[3], s_[4], s_[5], s_[6], s_[7]);
#pragma unroll
        for (int nt = 0; nt < 4; ++nt) { const bf16x8 bfr = *(const bf16x8*)(G2T + (size_t)(h * 64 + 16 * nt + l15) * 128 + 32 * ks + 8 * kg); accg[nt] = MFMA16(af, bfr, accg[nt]); }
    }
#pragma unroll
    for (int nt = 0; nt < 4; ++nt)
#pragma unroll
        for (int rg = 0; rg < 4; ++rg) gout[(rowb + t0 + 4 * kg + rg) * 512 + h * 64 + 16 * nt + l15] = bf1(accg[nt][rg]);
}


__device__ __forceinline__ void gate_lora_wave(int first, int stride, int lane, const bf16_t* __restrict__ proj, const float* __restrict__ mix, const bf16_t* __restrict__ G2T, bf16_t* __restrict__ gout) {
    const int l15 = lane & 15, kg = lane >> 4, h = (first >> 7) & 7;
    bf16x8 bfr[4][4];
#pragma unroll
    for (int ks = 0; ks < 4; ++ks)
#pragma unroll
        for (int nt = 0; nt < 4; ++nt) bfr[ks][nt] = *(const bf16x8*)(G2T + (size_t)(h * 64 + 16 * nt + l15) * 128 + 32 * ks + 8 * kg);
    float mm[4][8];
#pragma unroll
    for (int ks = 0; ks < 4; ++ks) { const f32x4 m0 = *(const f32x4*)(mix + 1664 + 32 * ks + 8 * kg), m1 = *(const f32x4*)(mix + 1664 + 32 * ks + 8 * kg + 4);
        mm[ks][0] = m0[0]; mm[ks][1] = m0[1]; mm[ks][2] = m0[2]; mm[ks][3] = m0[3]; mm[ks][4] = m1[0]; mm[ks][5] = m1[1]; mm[ks][6] = m1[2]; mm[ks][7] = m1[3]; }
    v4u cu[4], pv[4];
#define GL_LOAD(TK) do { const int ch_ = (TK) >> 7, t0_ = 16 * ((TK) & 127); const size_t r_ = (size_t)(ch_ >> 3) * SEQ + t0_ + l15, rp_ = (t0_ + l15 == 0) ? r_ : r_ - 1; \
        _Pragma("unroll") for (int ks = 0; ks < 4; ++ks) { const int col = 1664 + 32 * ks + 8 * kg; cu[ks] = *(const v4u*)(proj + r_ * L0P + col); pv[ks] = *(const v4u*)(proj + rp_ * L0P + col); } } while (0)
    GL_LOAD(first);
#pragma unroll 1
    for (int tk = first; tk < 128 * 128; tk += stride) {
        const int chain = tk >> 7, t0 = 16 * (tk & 127); const size_t rowb = (size_t)(chain >> 3) * SEQ;
        const float pz_ = (t0 + l15 == 0) ? 0.f : 1.f;
        f32x4 accg[4];
#pragma unroll
        for (int nt = 0; nt < 4; ++nt) accg[nt] = (f32x4){0.f, 0.f, 0.f, 0.f};
        bf16x8 af[4];
#pragma unroll
        for (int ks = 0; ks < 4; ++ks) { const unsigned cw[4] = {cu[ks].x, cu[ks].y, cu[ks].z, cu[ks].w}, pw[4] = {pv[ks].x, pv[ks].y, pv[ks].z, pv[ks].w}; float s_[8];
#pragma unroll
            for (int q = 0; q < 4; ++q) { const float c0 = bflo(cw[q]), c1 = bfhi(cw[q]), p0 = bflo(pw[q]) * pz_, p1 = bfhi(pw[q]) * pz_;
                s_[2 * q] = sigmoid_fast(c0 + (p0 - c0) * mm[ks][2 * q]); s_[2 * q + 1] = sigmoid_fast(c1 + (p1 - c1) * mm[ks][2 * q + 1]); }
            af[ks] = pack8(s_[0], s_[1], s_[2], s_[3], s_[4], s_[5], s_[6], s_[7]); }
        { const int tn = (tk + stride < 128 * 128) ? tk + stride : tk; GL_LOAD(tn); }
#pragma unroll
        for (int ks = 0; ks < 4; ++ks)
#pragma unroll
            for (int nt = 0; nt < 4; ++nt) accg[nt] = MFMA16(af[ks], bfr[ks][nt], accg[nt]);
#pragma unroll
        for (int nt = 0; nt < 4; ++nt)
#pragma unroll
            for (int rg = 0; rg < 4; ++rg) gout[(rowb + t0 + 4 * kg + rg) * 512 + h * 64 + 16 * nt + l15] = bf1(accg[nt][rg]);
    }
#undef GL_LOAD
}

template <bool ST = true> __device__ __forceinline__ void rwkv_post_all(const float* __restrict__ yraw, const bf16_t* __restrict__ proj, const float* __restrict__ mix, const float* __restrict__ bonus, const bf16_t* __restrict__ gbuf,
                                              const float* __restrict__ ln_g, const float* __restrict__ ln_b, bf16_t* __restrict__ ymix, int gw, int NGW, int lane) {
    for (int m = gw; m < M; m += NGW) {
        const bool has_prev = (m & (SEQ - 1)) != 0;
        float y[8], cv[8], pv[8], gg[8], bo[8];
#pragma unroll
        for (int h = 0; h < 8; ++h) { const int c = h * 64 + lane; y[h] = yraw[(size_t)m * 512 + c]; cv[h] = bf2f(proj[(size_t)m * L0P + 1024 + c]);
            pv[h] = bf2f(proj[(size_t)(has_prev ? m - 1 : m) * L0P + 1024 + c]); gg[h] = bf2f(gbuf[(size_t)m * 512 + c]); bo[h] = bonus[(size_t)m * 8 + h]; }
#pragma unroll
        for (int h = 0; h < 8; ++h) { const int c = h * 64 + lane;
            const float mu = wave_sum_dpp(y[h]) * (1.f / 64.f), d = y[h] - mu, var = wave_sum_dpp(d * d) * (1.f / 64.f);
            const float yn = d * __builtin_amdgcn_rsqf(var + 64e-5f) * ln_g[c] + ln_b[c];
            const float pvv = has_prev ? pv[h] : 0.f;
            const float v_s = cv[h] + (pvv - cv[h]) * mix[1024 + c];
            const float o = (yn + bo[h] * v_s) * gg[h];
            if (ST) ymix[(size_t)m * DM + c] = bf1(o); else asm volatile("" :: "v"(o)); }
    }
}


__device__ __forceinline__ void ssd_conv_tile(int it, int lane, LAS bf16_t* scr, const bf16_t* __restrict__ proj, const float* __restrict__ cw, const float* __restrict__ cb,
                                              bf16_t* __restrict__ xbc, bf16_t* __restrict__ xst, bf16_t* __restrict__ bt) {
    const int tt = it >> 4, ct = it & 15, m0 = tt * 64, b = m0 >> 11, t0 = m0 & (SEQ - 1), c = ct * 64 + lane;
    const float w0 = cw[c], w1 = cw[1024 + c], w2 = cw[2048 + c], w3 = cw[3072 + c], bias = cb[c];
    const bf16_t* src = proj + (size_t)m0 * L0P + 2304 + c;
    bf16_t raw[67];
    const int lo = (t0 > 0) ? -3 : 0;
#pragma unroll
    for (int t = -3; t < 64; ++t) raw[t + 3] = src[(ptrdiff_t)((t < lo) ? lo : t) * L0P];
    float u3 = (t0 > 0) ? bf2f(raw[0]) : 0.f, u2 = (t0 > 0) ? bf2f(raw[1]) : 0.f, u1 = (t0 > 0) ? bf2f(raw[2]) : 0.f;
#pragma unroll
    for (int t = 0; t < 64; ++t) {
        const float u = bf2f(raw[t + 3]);
        const float y = bias + w0 * u3 + w1 * u2 + w2 * u1 + w3 * u;
        const bf16_t o = bf1(y * __builtin_amdgcn_rcpf(1.f + __expf(-y)));
        xbc[(size_t)(m0 + t) * 1024 + c] = o;
        scr[t * STG_PITCH + lane] = o;
        u3 = u2; u2 = u1; u1 = u;
    }
    WSYNC();
    if (ct < 12) {
        bf16_t* dst = (ct < 8) ? xst + ((size_t)(b * 8 + ct) * 64) * SEQ + t0 : bt + ((size_t)(b * 2 + ((ct - 8) >> 1)) * 128 + ((ct - 8) & 1) * 64) * SEQ + t0;
#pragma unroll
        for (int i = 0; i < 8; ++i) { const int d = i * 8 + (lane >> 3), tc = lane & 7; const LAS bf16_t* p = scr + (tc * 8) * STG_PITCH + d;
            v4u o; o.x = (unsigned)p[0] | ((unsigned)p[STG_PITCH] << 16); o.y = (unsigned)p[2 * STG_PITCH] | ((unsigned)p[3 * STG_PITCH] << 16);
            o.z = (unsigned)p[4 * STG_PITCH] | ((unsigned)p[5 * STG_PITCH] << 16); o.w = (unsigned)p[6 * STG_PITCH] | ((unsigned)p[7 * STG_PITCH] << 16);
            *(v4u*)(dst + (size_t)d * SEQ + tc * 8) = o; }
    }
    WSYNC();
}
__device__ __forceinline__ float bperm(int srclane, float x) { return __builtin_bit_cast(float, __builtin_amdgcn_ds_bpermute(srclane << 2, __builtin_bit_cast(int, x))); }
__device__ __forceinline__ void scan128(float& x0, float& x1, int lane) {
#pragma unroll
    for (int o = 1; o < 64; o <<= 1) { const int sl = (lane >= o) ? lane - o : lane; const float t0 = bperm(sl, x0), t1 = bperm(sl, x1); if (lane >= o) { x0 += t0; x1 += t1; } }
    x1 += rl(x0, 63);
}

__device__ __forceinline__ void ssd_s3_block(int bc, int tid, int lane, int wave, LAS unsigned char* lds, const bf16_t* __restrict__ xbc, const bf16_t* __restrict__ xst, const bf16_t* __restrict__ stb,
                                             const float* __restrict__ dt, const float* __restrict__ a_log, const float* __restrict__ dsk, bf16_t* __restrict__ yssm) {
    const int b = bc >> 4, c = bc & 15, h = wave, g = h >> 2, l0 = c * 128, l31 = lane & 31, hi = lane >> 5, unit = bc * 8 + h;
    const size_t m0 = (size_t)b * SEQ + l0;
    __syncthreads();
    {
        const int mat = lane >> 4, ch = lane & 15;
        v4u rr[16];
#pragma unroll
        for (int i = 0; i < 16; ++i) rr[i] = *(const v4u*)(xbc + (m0 + wave * 16 + i) * 1024 + 512 + lane * 8);
#pragma unroll
        for (int i = 0; i < 16; ++i) { const int row = wave * 16 + i; *(LAS v4u*)(lds + mat * 34816 + row * 272 + ch * 16) = rr[i]; }
    }
#define S3TAB(i) (*(LAS float*)(lds + ((wave * 64) + ((i) >> 2)) * 272 + 256 + ((i) & 3) * 4))
    const float A = -expf(a_log[h]), D = dsk[h];
    { const float d0 = dt[(m0 + lane) * 8 + h], d1 = dt[(m0 + 64 + lane) * 8 + h];
      float ac0 = d0 * A, ac1 = d1 * A;
      scan128(ac0, ac1, lane);
      S3TAB(lane) = ac0; S3TAB(64 + lane) = ac1; S3TAB(128 + lane) = d0; S3TAB(192 + lane) = d1; }
    u32x2 xf[4][2][2][2];
    const bf16_t* Sp = stb + (size_t)unit * 8192 + l31 * 128 + 8 * hi;
    { const bf16_t* Xp = xst + ((size_t)(b * 8 + h) * 64 + l31) * SEQ + l0 + 4 * hi;
#pragma unroll
      for (int st = 0; st < 4; ++st)
#pragma unroll
          for (int pt = 0; pt < 2; ++pt)
#pragma unroll
              for (int ks = 0; ks < 2; ++ks) { const bf16_t* xp = Xp + (size_t)pt * 32 * SEQ + st * 32 + 16 * ks; xf[st][pt][ks][0] = *(const u32x2*)xp; xf[st][pt][ks][1] = *(const u32x2*)(xp + 8); } }
    __syncthreads();
    const LAS unsigned char* Bl = lds + g * 34816 + 16 * hi;
    const LAS unsigned char* Cl = lds + (2 + g) * 34816 + 16 * hi;
#pragma unroll 1
    for (int lt = 0; lt < 4; ++lt) {
        asm volatile("" ::: "memory");
        f32x16 y[2];
#pragma unroll
        for (int r = 0; r < 16; ++r) { y[0][r] = 0.f; y[1][r] = 0.f; }
        const float acl = S3TAB(32 * lt + l31);
        const int crw = 32 * lt + l31;
        { bf16x8 sfr[2][8];
#pragma unroll
          for (int pt = 0; pt < 2; ++pt)
#pragma unroll
              for (int kk = 0; kk < 8; ++kk) sfr[pt][kk] = *(const bf16x8*)(Sp + pt * 32 * 128 + 16 * kk);
#pragma unroll
          for (int kk = 0; kk < 8; ++kk) { const bf16x8 cf = *(const LAS bf16x8*)(Cl + crw * 272 + 32 * kk); y[0] = MFMA32(sfr[0][kk], cf, y[0]); y[1] = MFMA32(sfr[1][kk], cf, y[1]); } }
        { const float el = __expf(acl);
#pragma unroll
          for (int r = 0; r < 16; ++r) { y[0][r] *= el; y[1][r] *= el; } }
        u32x2 xd[2][4];
#pragma unroll
        for (int pt = 0; pt < 2; ++pt)
#pragma unroll
            for (int q = 0; q < 4; ++q) xd[pt][q] = *(const u32x2*)(xbc + (m0 + crw) * 1024 + h * 64 + 32 * pt + 8 * q + 4 * hi);
#pragma unroll
        for (int st = 0; st < 4; ++st) if (st <= lt) {
            const int brw = 32 * st + l31;
            f32x16 cbt;
#pragma unroll
            for (int r = 0; r < 16; ++r) cbt[r] = 0.f;
#pragma unroll
            for (int kk = 0; kk < 8; ++kk) { const bf16x8 bf_ = *(const LAS bf16x8*)(Bl + brw * 272 + 32 * kk), cf_ = *(const LAS bf16x8*)(Cl + crw * 272 + 32 * kk); cbt = MFMA32(bf_, cf_, cbt); }
#pragma unroll
            for (int r = 0; r < 16; ++r) { const int sl = 32 * st + crow(r, hi); const float acs = S3TAB(sl), dts = S3TAB(128 + sl);
                float v = cbt[r] * __expf(acl - acs) * dts; if (st == lt && crow(r, hi) > l31) v = 0.f; cbt[r] = v; }
            bf16x8 pf[2];
#pragma unroll
            for (int ks = 0; ks < 2; ++ks) pf[ks] = pack8(cbt[8 * ks], cbt[8 * ks + 1], cbt[8 * ks + 2], cbt[8 * ks + 3], cbt[8 * ks + 4], cbt[8 * ks + 5], cbt[8 * ks + 6], cbt[8 * ks + 7]);
#pragma unroll
            for (int pt = 0; pt < 2; ++pt)
#pragma unroll
                for (int ks = 0; ks < 2; ++ks) { v4u a; a.x = xf[st][pt][ks][0].x; a.y = xf[st][pt][ks][0].y; a.z = xf[st][pt][ks][1].x; a.w = xf[st][pt][ks][1].y; y[pt] = MFMA32(__builtin_bit_cast(bf16x8, a), pf[ks], y[pt]); }
        }
#pragma unroll
        for (int pt = 0; pt < 2; ++pt)
#pragma unroll
            for (int q = 0; q < 4; ++q) { const u32x2 xx = xd[pt][q];
                const unsigned o0 = cvtpk(y[pt][4 * q] + D * bflo(xx.x), y[pt][4 * q + 1] + D * bfhi(xx.x)), o1 = cvtpk(y[pt][4 * q + 2] + D * bflo(xx.y), y[pt][4 * q + 3] + D * bfhi(xx.y));
                *(u32x2*)(yssm + (m0 + crw) * 512 + h * 64 + 32 * pt + 8 * q + 4 * hi) = (u32x2){o0, o1}; }
    }
#undef S3TAB
}
__device__ __forceinline__ void ssd_s1_unit(int unit, int lane, LAS float* tab, const bf16_t* __restrict__ xst, const bf16_t* __restrict__ bt, const float* __restrict__ dt, const float* __restrict__ a_log,
                                            float* __restrict__ sloc, float* __restrict__ asum) {
    const int h = unit & 7, c = (unit >> 3) & 15, b = unit >> 7, g = h >> 2, l0 = c * 128, l31 = lane & 31, hi = lane >> 5;
    const size_t m0 = (size_t)b * SEQ + l0;
    const float A = -expf(a_log[h]);
    const float d0 = dt[(m0 + lane) * 8 + h], d1 = dt[(m0 + 64 + lane) * 8 + h];
    float ac0 = d0 * A, ac1 = d1 * A;
    scan128(ac0, ac1, lane);
    const float aend = rl(ac1, 63);
    tab[lane] = __expf(aend - ac0) * d0; tab[64 + lane] = __expf(aend - ac1) * d1;
    if (lane == 0) asum[unit] = aend;
    WSYNC();
    f32x16 acc[2][4];
#pragma unroll
    for (int pt = 0; pt < 2; ++pt)
#pragma unroll
        for (int nt = 0; nt < 4; ++nt)
#pragma unroll
            for (int r = 0; r < 16; ++r) acc[pt][nt][r] = 0.f;
    const bf16_t* Xp = xst + ((size_t)(b * 8 + h) * 64 + l31) * SEQ + l0 + 8 * hi;
    const bf16_t* Bp = bt + ((size_t)(b * 2 + g) * 128 + l31) * SEQ + l0 + 8 * hi;
#pragma unroll 2
    for (int kk = 0; kk < 8; ++kk) {
        const f32x4 wa = *(const LAS f32x4*)(tab + 16 * kk + 8 * hi), wb = *(const LAS f32x4*)(tab + 16 * kk + 8 * hi + 4);
        bf16x8 af[2], bfr[4];
#pragma unroll
        for (int pt = 0; pt < 2; ++pt) { const v4u raw = *(const v4u*)(Xp + (size_t)pt * 32 * SEQ + 16 * kk);
            v4u w; w.x = cvtpk(bflo(raw.x) * wa[0], bfhi(raw.x) * wa[1]); w.y = cvtpk(bflo(raw.y) * wa[2], bfhi(raw.y) * wa[3]);
            w.z = cvtpk(bflo(raw.z) * wb[0], bfhi(raw.z) * wb[1]); w.w = cvtpk(bflo(raw.w) * wb[2], bfhi(raw.w) * wb[3]); af[pt] = __builtin_bit_cast(bf16x8, w); }
#pragma unroll
        for (int nt = 0; nt < 4; ++nt) bfr[nt] = *(const bf16x8*)(Bp + (size_t)nt * 32 * SEQ + 16 * kk);
#pragma unroll
        for (int pt = 0; pt < 2; ++pt)
#pragma unroll
            for (int nt = 0; nt < 4; ++nt) acc[pt][nt] = MFMA32(af[pt], bfr[nt], acc[pt][nt]);
    }
    float* dst = sloc + (size_t)unit * 8192 + l31;
#pragma unroll
    for (int pt = 0; pt < 2; ++pt)
#pragma unroll
        for (int nt = 0; nt < 4; ++nt)
#pragma unroll
            for (int r = 0; r < 16; ++r) dst[(32 * pt + crow(r, hi)) * 128 + 32 * nt] = acc[pt][nt][r];
    WSYNC();
}
__device__ __forceinline__ void ssd_s2_all(const float* __restrict__ sloc, const float* __restrict__ asum, bf16_t* __restrict__ stb, int gtid, int NT) {
    for (int i = gtid; i < 128 * 2048; i += NT) {
        const int bh = i >> 11, e4 = i & 2047, b = bh >> 3, h = bh & 7;
        f32x4 run = {0.f, 0.f, 0.f, 0.f};
#pragma unroll 4
        for (int c = 0; c < 16; ++c) { const int unit = (b * 16 + c) * 8 + h; const f32x4 tmp = *(const f32x4*)(sloc + (size_t)unit * 8192 + e4 * 4);
            uint2 w; w.x = cvtpk(run[0], run[1]); w.y = cvtpk(run[2], run[3]); *(uint2*)(stb + (size_t)unit * 8192 + e4 * 4) = w;
            run = run * __expf(asum[unit]) + tmp; }
    }
}
__device__ __forceinline__ void ssd_s3_unit(int unit, int lane, LAS float* tab, const bf16_t* __restrict__ xbc, const bf16_t* __restrict__ xst, const bf16_t* __restrict__ stb, const float* __restrict__ dt,
                                            const float* __restrict__ a_log, const float* __restrict__ dsk, bf16_t* __restrict__ yssm) {
    const int h = unit & 7, c = (unit >> 3) & 15, b = unit >> 7, g = h >> 2, l0 = c * 128, l31 = lane & 31, hi = lane >> 5;
    const size_t m0 = (size_t)b * SEQ + l0;
    const float A = -expf(a_log[h]), D = dsk[h];
    const float d0 = dt[(m0 + lane) * 8 + h], d1 = dt[(m0 + 64 + lane) * 8 + h];
    float ac0 = d0 * A, ac1 = d1 * A;
    scan128(ac0, ac1, lane);
    tab[lane] = ac0; tab[64 + lane] = ac1; tab[128 + lane] = d0; tab[192 + lane] = d1;
    WSYNC();
    const bf16_t* Cp = xbc + (m0 + l31) * 1024 + 768 + g * 128 + 8 * hi;
    const bf16_t* Sp = stb + (size_t)unit * 8192 + l31 * 128 + 8 * hi;
    const bf16_t* Bp = xbc + (m0 + l31) * 1024 + 512 + g * 128 + 8 * hi;
    const bf16_t* Xp = xst + ((size_t)(b * 8 + h) * 64 + l31) * SEQ + l0 + 4 * hi;
    LAS float* tr = tab + 256;
    const int row = lane >> 1, p0 = (lane & 1) * 16;
#pragma unroll 1
    for (int lt = 0; lt < 4; ++lt) {
        f32x16 y[2];
#pragma unroll
        for (int r = 0; r < 16; ++r) { y[0][r] = 0.f; y[1][r] = 0.f; }
        const float acl = tab[32 * lt + l31];
        bf16x8 cfr[8];
#pragma unroll
        for (int kk = 0; kk < 8; ++kk) cfr[kk] = *(const bf16x8*)(Cp + (size_t)lt * 32 * 1024 + 16 * kk);
        {   bf16x8 s0[8], s1[8];
#pragma unroll
            for (int kk = 0; kk < 8; ++kk) { s0[kk] = *(const bf16x8*)(Sp + 16 * kk); s1[kk] = *(const bf16x8*)(Sp + 32 * 128 + 16 * kk); }
#pragma unroll
            for (int kk = 0; kk < 8; ++kk) { y[0] = MFMA32(s0[kk], cfr[kk], y[0]); y[1] = MFMA32(s1[kk], cfr[kk], y[1]); }
        }
        { const float el = __expf(acl);
#pragma unroll
          for (int r = 0; r < 16; ++r) { y[0][r] *= el; y[1][r] *= el; } }
#pragma unroll 1
        for (int st = 0; st <= lt; ++st) {
            bf16x8 bfr[8]; u32x2 xf[2][2][2];
#pragma unroll
            for (int kk = 0; kk < 8; ++kk) bfr[kk] = *(const bf16x8*)(Bp + (size_t)st * 32 * 1024 + 16 * kk);
#pragma unroll
            for (int pt = 0; pt < 2; ++pt)
#pragma unroll
                for (int ks = 0; ks < 2; ++ks) { const bf16_t* xp = Xp + (size_t)pt * 32 * SEQ + st * 32 + 16 * ks; xf[pt][ks][0] = *(const u32x2*)xp; xf[pt][ks][1] = *(const u32x2*)(xp + 8); }
            f32x16 cbt;
#pragma unroll
            for (int r = 0; r < 16; ++r) cbt[r] = 0.f;
#pragma unroll
            for (int kk = 0; kk < 8; ++kk) cbt = MFMA32(bfr[kk], cfr[kk], cbt);
#pragma unroll
            for (int r = 0; r < 16; ++r) { const int sl = 32 * st + crow(r, hi); const float acs = tab[sl], dts = tab[128 + sl];
                float v = cbt[r] * __expf(acl - acs) * dts; if (st == lt && crow(r, hi) > l31) v = 0.f; cbt[r] = v; }
            bf16x8 pf[2];
#pragma unroll
            for (int ks = 0; ks < 2; ++ks) pf[ks] = pack8(cbt[8 * ks], cbt[8 * ks + 1], cbt[8 * ks + 2], cbt[8 * ks + 3], cbt[8 * ks + 4], cbt[8 * ks + 5], cbt[8 * ks + 6], cbt[8 * ks + 7]);
#pragma unroll
            for (int pt = 0; pt < 2; ++pt)
#pragma unroll
                for (int ks = 0; ks < 2; ++ks) { v4u a; a.x = xf[pt][ks][0].x; a.y = xf[pt][ks][0].y; a.z = xf[pt][ks][1].x; a.w = xf[pt][ks][1].y; y[pt] = MFMA32(__builtin_bit_cast(bf16x8, a), pf[ks], y[pt]); }
        }
#pragma unroll
        for (int pt = 0; pt < 2; ++pt) {
#pragma unroll
            for (int r = 0; r < 16; ++r) tr[l31 * 33 + crow(r, hi)] = y[pt][r];
            WSYNC();
            const size_t m = m0 + 32 * lt + row;
            const v4u xa = *(const v4u*)(xbc + m * 1024 + h * 64 + 32 * pt + p0), xb = *(const v4u*)(xbc + m * 1024 + h * 64 + 32 * pt + p0 + 8);
            const unsigned xu[8] = {xa.x, xa.y, xa.z, xa.w, xb.x, xb.y, xb.z, xb.w};
            unsigned ow[8];
#pragma unroll
            for (int q = 0; q < 8; ++q) { const float v0 = tr[row * 33 + p0 + 2 * q] + D * bflo(xu[q]), v1 = tr[row * 33 + p0 + 2 * q + 1] + D * bfhi(xu[q]); ow[q] = cvtpk(v0, v1); }
            bf16_t* dst = yssm + m * 512 + h * 64 + 32 * pt + p0;
            *(v4u*)dst = (v4u){ow[0], ow[1], ow[2], ow[3]}; *(v4u*)(dst + 8) = (v4u){ow[4], ow[5], ow[6], ow[7]};
            WSYNC();
        }
    }
}


__device__ __forceinline__ float sum8(float x) { x += dpp_mov<0xB1>(x); x += dpp_mov<0x4E>(x); x += dpp_mov<0x141>(x); return x; }
__device__ __forceinline__ float sum32(float x, int lane) { x = rowsum16(x); return x + bperm(lane ^ 16, x); }
__device__ __forceinline__ void unpack8(const v4u& w, float (&f)[8]) { f[0] = bflo(w.x); f[1] = bfhi(w.x); f[2] = bflo(w.y); f[3] = bfhi(w.y); f[4] = bflo(w.z); f[5] = bfhi(w.z); f[6] = bflo(w.w); f[7] = bfhi(w.w); }
__device__ __forceinline__ void ssm_gate_norm_vec(const bf16_t* __restrict__ yssm, const bf16_t* __restrict__ proj, const float* __restrict__ ng, bf16_t* __restrict__ ymix, int m0, int m1, int w, int nw, int lane) {
    const int c0 = lane * 8;
    float gn[8];
    { const f32x4 a = *(const f32x4*)(ng + c0), b = *(const f32x4*)(ng + c0 + 4); gn[0] = a[0]; gn[1] = a[1]; gn[2] = a[2]; gn[3] = a[3]; gn[4] = b[0]; gn[5] = b[1]; gn[6] = b[2]; gn[7] = b[3]; }
    for (int mb = m0 + w; mb < m1; mb += nw * 4) {
        v4u yv[4], zv[4];
#pragma unroll
        for (int k = 0; k < 4; ++k) { const int m = (mb + k * nw < m1) ? mb + k * nw : mb; yv[k] = *(const v4u*)(yssm + (size_t)m * 512 + c0); zv[k] = *(const v4u*)(proj + (size_t)m * L0P + 1792 + c0); }
#pragma unroll
        for (int k = 0; k < 4; ++k) { const int m = mb + k * nw;
            float y[8], z[8], u[8], q = 0.f; unpack8(yv[k], y); unpack8(zv[k], z);
#pragma unroll
            for (int j = 0; j < 8; ++j) { u[j] = y[j] * z[j] * __builtin_amdgcn_rcpf(1.f + __builtin_amdgcn_exp2f(-1.4426950408889634f * z[j])); q += u[j] * u[j]; }
            const float rs = __builtin_amdgcn_rsqf(sum32(q, lane) * (1.f / 256.f) + 1e-5f);
            v4u o; o.x = cvtpk(u[0] * rs * gn[0], u[1] * rs * gn[1]); o.y = cvtpk(u[2] * rs * gn[2], u[3] * rs * gn[3]); o.z = cvtpk(u[4] * rs * gn[4], u[5] * rs * gn[5]); o.w = cvtpk(u[6] * rs * gn[6], u[7] * rs * gn[7]);
            if (m < m1) *(v4u*)(ymix + (size_t)m * DM + 512 + c0) = o; }
    }
}
__device__ __forceinline__ void rwkv_post_vec(const float* __restrict__ yraw, const bf16_t* __restrict__ proj, const float* __restrict__ mix, const float* __restrict__ bonus, const bf16_t* __restrict__ gbuf,
                                              const float* __restrict__ ln_g, const float* __restrict__ ln_b, bf16_t* __restrict__ ymix, int gw, int NGW, int lane) {
    const int c0 = lane * 8, h = lane >> 3;
    float lg[8], lb[8], mx[8];
    { const f32x4 a = *(const f32x4*)(ln_g + c0), b = *(const f32x4*)(ln_g + c0 + 4), c = *(const f32x4*)(ln_b + c0), d = *(const f32x4*)(ln_b + c0 + 4), e = *(const f32x4*)(mix + 1024 + c0), f = *(const f32x4*)(mix + 1024 + c0 + 4);
#pragma unroll
      for (int j = 0; j < 4; ++j) { lg[j] = a[j]; lg[4 + j] = b[j]; lb[j] = c[j]; lb[4 + j] = d[j]; mx[j] = e[j]; mx[4 + j] = f[j]; } }
    for (int mb = gw; mb < M; mb += NGW * 2) {
        f32x4 ya[2], yb[2]; v4u cv[2], pv[2], gv[2]; float bo[2];
#pragma unroll
        for (int k = 0; k < 2; ++k) { const int m = mb + k * NGW; const bool hp = (m & (SEQ - 1)) != 0;
            ya[k] = *(const f32x4*)(yraw + (size_t)m * 512 + c0); yb[k] = *(const f32x4*)(yraw + (size_t)m * 512 + c0 + 4);
            cv[k] = *(const v4u*)(proj + (size_t)m * L0P + 1024 + c0); pv[k] = *(const v4u*)(proj + (size_t)(hp ? m - 1 : m) * L0P + 1024 + c0);
            gv[k] = *(const v4u*)(gbuf + (size_t)m * 512 + c0); bo[k] = bonus[(size_t)m * 8 + h]; }
#pragma unroll
        for (int k = 0; k < 2; ++k) { const int m = mb + k * NGW; const float pz = ((m & (SEQ - 1)) != 0) ? 1.f : 0.f;
            float y[8] = {ya[k][0], ya[k][1], ya[k][2], ya[k][3], yb[k][0], yb[k][1], yb[k][2], yb[k][3]}, cc[8], pp[8], gg[8];
            unpack8(cv[k], cc); unpack8(pv[k], pp); unpack8(gv[k], gg);
            float sm = 0.f;
#pragma unroll
            for (int j = 0; j < 8; ++j) sm += y[j];
            const float mu = sum8(sm) * (1.f / 64.f);
            float qv = 0.f;
#pragma unroll
            for (int j = 0; j < 8; ++j) { y[j] -= mu; qv += y[j] * y[j]; }
            const float rs = __builtin_amdgcn_rsqf(sum8(qv) * (1.f / 64.f) + 64e-5f);
            float o[8];
#pragma unroll
            for (int j = 0; j < 8; ++j) { const float vs = cc[j] + (pp[j] * pz - cc[j]) * mx[j]; o[j] = (y[j] * rs * lg[j] + lb[j] + bo[k] * vs) * gg[j]; }
            v4u w; w.x = cvtpk(o[0], o[1]); w.y = cvtpk(o[2], o[3]); w.z = cvtpk(o[4], o[5]); w.w = cvtpk(o[6], o[7]);
            *(v4u*)(ymix + (size_t)m * DM + c0) = w; }
    }
}

struct Args { const float* in[43]; float* out; unsigned char* ws; };
#define GEMM_PHASE(EPI, Aptr, LDA, Bptr, LDB, NN, KK, ...) do { pg8::Gemm g_{(Aptr), (Bptr), M, (NN), (KK), (LDA), (LDB)}; pg8::StaticOrder S_; S_.init(M, (NN), G, (int)blockIdx.x); \
        pg8::EPI E_{__VA_ARGS__}; pg8::gemm_phase<pg8::EPI, pg8::StaticOrder, true, true>(lds3, g_, S_, E_); } while (0)

__global__ void __launch_bounds__(NWAVES * 64, 2) fwd_mega(Args args) {
    extern __shared__ __attribute__((aligned(16))) unsigned char lds[];
    LAS unsigned char* lds3 = (LAS unsigned char*)lds;
    volatile LAS unsigned* MISC = (volatile LAS unsigned*)(lds3 + MISC_OFF);
    const int G = gridDim.x, NGW = G * NWAVES, NT = G * NWAVES * 64;
#define PHASE_IDS() int tid = threadIdx.x; asm volatile("" : "+v"(tid)); const int lane = tid & 63, wave = __builtin_amdgcn_readfirstlane(tid >> 6); const int gw = blockIdx.x * NWAVES + wave, gtid = blockIdx.x * (NWAVES * 64) + tid; (void)lane; (void)gw; (void)gtid
    unsigned char* ws = args.ws;
    gu32* ctl = (gu32*)(ws + WS_CTL);
    for (int u = threadIdx.x; u < (LDS_BYTES - LDSCTL_OFF) / 4; u += NWAVES * 64) ((LAS unsigned*)(lds3 + LDSCTL_OFF))[u] = 0u;
    __syncthreads();
    XcdBarrier bar = xcd_barrier_post((unsigned*)(ctl + CW_BAR), MISC + 8);
#if defined(PROBE_STAMPS)
    int nb_ = 0;
    if (blockIdx.x == 0 && threadIdx.x == 0) MISC[16] = (unsigned)__builtin_amdgcn_s_memrealtime();
#define GRID_BAR() do { xcd_barrier(bar); ++nb_; if (blockIdx.x == 0 && threadIdx.x == 0) MISC[16 + nb_] = (unsigned)__builtin_amdgcn_s_memrealtime(); } while (0)
#else
#define GRID_BAR() xcd_barrier(bar)
#endif
#define IN(i) (args.in[i])
    float* out = args.out;
    bf16_t* W0in = (bf16_t*)(ws + WS_W0IN); bf16_t* W0out = (bf16_t*)(ws + WS_W0OUT); bf16_t* Wup0 = (bf16_t*)(ws + WS_WUP0); bf16_t* Wdn0 = (bf16_t*)(ws + WS_WDN0);
    bf16_t* W1in = (bf16_t*)(ws + WS_W1IN); bf16_t* Wuq = (bf16_t*)(ws + WS_WUQ); bf16_t* Wukv = (bf16_t*)(ws + WS_WUKV); bf16_t* W1out = (bf16_t*)(ws + WS_W1OUT);
    bf16_t* Wup1 = (bf16_t*)(ws + WS_WUP1); bf16_t* Wdn1 = (bf16_t*)(ws + WS_WDN1);
    bf16_t* XB = (bf16_t*)(ws + WS_XB); bf16_t* YMIX = (bf16_t*)(ws + WS_YMIX); bf16_t* PROJ0 = (bf16_t*)(ws + WS_BIG);
    bf16_t* ZB = (bf16_t*)out; float* YRAW = out; bf16_t* YSSM = (bf16_t*)(out + (size_t)M * 512); bf16_t* STB = (bf16_t*)(out + (size_t)M * 768); bf16_t* XST = (bf16_t*)(ws + WS_XST); bf16_t* BT = (bf16_t*)(ws + WS_BT); float* ASUM = (float*)(ws + WS_ASUM); float* SLOC = (float*)(ws + WS_SLOC); float* DT = (float*)(ws + WS_DT); bf16_t* GB = (bf16_t*)(ws + WS_G); float* BONUS = (float*)(ws + WS_BONUS);
    bf16_t* W2T = (bf16_t*)(ws + WS_W2T); bf16_t* A2T = (bf16_t*)(ws + WS_A2T); bf16_t* G2T = (bf16_t*)(ws + WS_G2T); bf16_t* ACT = (bf16_t*)(ws + WS_GU); bf16_t* HALO = (bf16_t*)(ws + WS_GU + 176 * MiB);
    bf16_t* PROJ1 = (bf16_t*)(ws + WS_PROJ1); bf16_t* QM = (bf16_t*)(ws + WS_QM); bf16_t* KVM = (bf16_t*)(ws + WS_KVM); bf16_t* KPE = (bf16_t*)(ws + WS_KPE); float* RS = (float*)(ws + WS_RS); float* CSTAB = (float*)(ws + WS_CSTAB); float* STATS = (float*)(ws + WS_CSTAB + 4 * MiB); bf16_t* VTS = (bf16_t*)(ws + WS_VTS); bf16_t* VTM = (bf16_t*)(ws + WS_VTM);
    const int* pos = (const int*)args.in[1];

    {
        PHASE_IDS();
    {
        LAS float* scr = (LAS float*)(lds3 + wave * 16384); int trb = 0;
        transpose_matrix(IN(2), 1024, 3336, W0in, L0P, 1024, scr, gw, NGW, lane, nullptr, trb);
        transpose_matrix(IN(20), 1024, 1024, W0out, 1024, 1024, scr, gw, NGW, lane, nullptr, trb);
        transpose_matrix(IN(5), 64, 512, W2T, 512, 64, scr, gw, NGW, lane, nullptr, trb);
        transpose_matrix(IN(7), 64, 512, A2T, 512, 64, scr, gw, NGW, lane, nullptr, trb);
        transpose_matrix(IN(8), 128, 512, G2T, 512, 128, scr, gw, NGW, lane, nullptr, trb);
        const float* x = IN(0);
        {
            constexpr size_t TOT4 = (size_t)M * DM / 4;
            for (size_t i = gtid; i < TOT4; i += (size_t)NT * 8) {
                f32x4 v[8];
#pragma unroll
                for (int u = 0; u < 8; ++u) v[u] = *(const f32x4*)(x + (i + (size_t)u * NT) * 4);
#pragma unroll
                for (int u = 0; u < 8; ++u) { uint2 w; w.x = cvtpk(v[u][0], v[u][1]); w.y = cvtpk(v[u][2], v[u][3]); *(uint2*)(XB + (i + (size_t)u * NT) * 4) = w; }
            }
        }
    }
    }
    GRID_BAR();
    {
        PHASE_IDS();
    GEMM_PHASE(EpiBf16S, XB, DM, W0in, 1024, L0P, 1024, PROJ0, nullptr, L0P, 0);
    }
    GRID_BAR();
    {
        PHASE_IDS();
        const int blk = (int)blockIdx.x, m0 = blk * 128;
        {   LAS bf16_t* scr = (LAS bf16_t*)(lds3 + wave * 16384);
#pragma unroll 1
            for (int k = 0; k < 4; ++k) ssd_conv_tile((2 * blk + (k & 1)) * 16 + wave + 8 * (k >> 1), lane, scr, PROJ0, IN(14), IN(15), XB, XST, BT);
            for (int i = tid; i < 1024; i += NWAVES * 64) { const int m = m0 + (i >> 3); DT[(size_t)m * 8 + (i & 7)] = softplusf_(bf2f(PROJ0[(size_t)m * L0P + 3328 + (i & 7)]) + IN(16)[i & 7]); }
        }
        __syncthreads();
#if defined(PROBE_STAMPS)
        if (blockIdx.x == 0 && threadIdx.x == 0) MISC[16 + 29] = (unsigned)__builtin_amdgcn_s_memrealtime();
#endif
        ssd_s1_unit(blk * 8 + wave, lane, (LAS float*)(lds3 + wave * 16384), XST, BT, DT, IN(17), SLOC, ASUM);
    }
    GRID_BAR();
    {
        PHASE_IDS();
        ssd_s2_all(SLOC, ASUM, STB, gtid, NT);
    }
    GRID_BAR();
    {
        PHASE_IDS();
        const int blk = (int)blockIdx.x;
        if (blk < 128) {
            rwkv_phase_chain((LAS float*)lds3, tid, lane, wave, blk, PROJ0, IN(3), IN(4), IN(6), IN(9), IN(10), IN(11), W2T, A2T, G2T, YRAW, GB, BONUS);
#if defined(PROBE_STAMPS)
            if (blk == 0 && threadIdx.x == 0) MISC[16 + 23] = (unsigned)__builtin_amdgcn_s_memrealtime();
#endif
        } else {
            const int bc0 = (blk - 128) * 2;
#if defined(PROBE_STAMPS)
            const unsigned tu0_ = (unsigned)__builtin_amdgcn_s_memrealtime();
#endif
            {
                const int gwu = (blk - 128) * NWAVES + wave;
                gate_lora_wave(gwu, 128 * NWAVES, lane, PROJ0, IN(3), G2T, GB);
            }
#if defined(PROBE_STAMPS)
            __syncthreads(); if (blk == 128 && threadIdx.x == 0) __hip_atomic_store(ctl + 2049, (unsigned)__builtin_amdgcn_s_memrealtime() - tu0_, __ATOMIC_RELAXED, __HIP_MEMORY_SCOPE_AGENT);
#endif
#pragma unroll 1
            for (int u = 0; u < 2; ++u) ssd_s3_block(bc0 + u, tid, lane, wave, lds3, XB, XST, STB, DT, IN(17), IN(18), YSSM);
            __syncthreads();
#if defined(PROBE_STAMPS)
            __syncthreads(); if (blk == 128 && threadIdx.x == 0) __hip_atomic_store(ctl + 2050, (unsigned)__builtin_amdgcn_s_memrealtime() - tu0_, __ATOMIC_RELAXED, __HIP_MEMORY_SCOPE_AGENT);
#endif
            ssm_gate_norm_vec(YSSM, PROJ0, IN(19), YMIX, bc0 * 128, bc0 * 128 + 256, wave, NWAVES, lane);
#if defined(PROBE_STAMPS)
            __syncthreads(); if (blk == 128 && threadIdx.x == 0) __hip_atomic_store(ctl + 2051, (unsigned)__builtin_amdgcn_s_memrealtime() - tu0_, __ATOMIC_RELAXED, __HIP_MEMORY_SCOPE_AGENT);
#endif
            { const int gwu = (blk - 128) * NWAVES + wave, NGWU = 128 * NWAVES; LAS float* scr = (LAS float*)(lds3 + wave * 16384); int trb = 0;
              transpose_matrix(IN(23), 1024, 5632, Wup0, 5632, 1024, scr, gwu, NGWU, lane, nullptr, trb, true);
              transpose_matrix(IN(26), 2816, 1024, Wdn0, 1024, 2816, scr, gwu, NGWU, lane, nullptr, trb);
            }
#if defined(PROBE_STAMPS)
            __syncthreads(); if (blk == 128 && threadIdx.x == 0) __hip_atomic_store(ctl + 2048, (unsigned)__builtin_amdgcn_s_memrealtime() - tu0_, __ATOMIC_RELAXED, __HIP_MEMORY_SCOPE_AGENT);
#endif
        }
    }
    GRID_BAR();
    {
        PHASE_IDS();
        rwkv_post_vec(YRAW, PROJ0, IN(3), BONUS, GB, IN(12), IN(13), YMIX, gw, NGW, lane);
    }
    GRID_BAR();
    {
        PHASE_IDS();
    GEMM_PHASE(EpiResid, YMIX, DM, W0out, 1024, 1024, 1024, IN(0), ZB, ALPHA, 0);
    }
    GRID_BAR();
    {
        PHASE_IDS();
    ln_rows<1>(ZB, XB, nullptr, STATS, IN(21), IN(22), gw, NGW, lane);
    }
    GRID_BAR();
    {
        PHASE_IDS();
        { pg8::Gemm g_{XB, Wup0, M / 32, DFF, 1024, DM, 1024, 4096, 8192, 256, 512, 1}; pg8::StaticOrder S_; S_.init(M / 32, DFF, G, (int)blockIdx.x);
          pg8::EpiBf16S E_{HALO, nullptr, DFF, 0}; pg8::gemm_phase<pg8::EpiBf16S, pg8::StaticOrder, true, true>(lds3, g_, S_, E_); }
        if ((int)blockIdx.x >= 44) {
            const int gwu = ((int)blockIdx.x - 44) * NWAVES + wave, NGWU = (G - 44) * NWAVES; LAS float* scr = (LAS float*)(lds3 + wave * 16384); int trb = 0;
            transpose_matrix(IN(29), 1024, 1952, W1in, L1P, 1024, scr, gwu, NGWU, lane, nullptr, trb);
            transpose_matrix(IN(31), 256, 768, Wuq, 768, 256, scr, gwu, NGWU, lane, IN(30), trb);
            transpose_matrix(IN(33), 128, 1024, Wukv, 1024, 256, scr, gwu, NGWU, lane, IN(32), trb);
            transpose_matrix(IN(34), 1024, 1024, W1out, 1024, 1024, scr, gwu, NGWU, lane, nullptr, trb);
            transpose_matrix(IN(37), 1024, 5632, Wup1, 5632, 1024, scr, gwu, NGWU, lane, nullptr, trb, true);
            transpose_matrix(IN(40), 2816, 1024, Wdn1, 1024, 2816, scr, gwu, NGWU, lane, nullptr, trb);
            for (int i = gwu * 64 + lane; i < 1024 * 16; i += NGWU * 64) { const int n = i >> 4, c = i & 15; *(v4u*)(Wukv + (size_t)n * 256 + 128 + c * 8) = (v4u){0u, 0u, 0u, 0u}; }
        }
    }
    GRID_BAR();
    {
        PHASE_IDS();
        { pg8::Gemm g_{XB, Wup0, M, 2 * DFF, 1024, DM, 1024}; pg8::StaticOrder S_; S_.init(M, 2 * DFF, G, (int)blockIdx.x);
          pg8::EpiConvAct E_{ACT, HALO, IN(24), IN(25), DFF, SEQ}; pg8::gemm_phase<pg8::EpiConvAct, pg8::StaticOrder, true, true>(lds3, g_, S_, E_); }
    }
    GRID_BAR();
    {
        PHASE_IDS();
    GEMM_PHASE(EpiResidLN, ACT, DFF, Wdn0, DFF, 1024, DFF, ZB, ZB, STATS, IN(21), IN(22), ALPHA, 0);
    }
    GRID_BAR();
    {
        PHASE_IDS();
    ln_rows<1>(ZB, XB, nullptr, STATS, IN(27), IN(28), gw, NGW, lane);
    }
    GRID_BAR();
    {
        PHASE_IDS();
    GEMM_PHASE(EpiBf16S, XB, DM, W1in, 1024, L1P, 1024, PROJ1, nullptr, L1P, 0);
    }
    GRID_BAR();
    {
        PHASE_IDS();
    mla_prep_all(PROJ1, pos, RS, KPE, CSTAB, gw, NGW, lane);
    }
    GRID_BAR();
    {
        PHASE_IDS();
    GEMM_PHASE(EpiBf16S, PROJ1 + 1536, L1P, Wuq, 256, 768, 256, QM, RS, 768, 2);
    GEMM_PHASE(EpiBf16S, PROJ1 + 1792, L1P, Wukv, 256, 1024, 256, KVM, RS + 1, 1024, 2);
    }
    GRID_BAR();
    {
        PHASE_IDS();
    rope_q_all(QM, CSTAB, gtid, NT);
    {
        LAS bf16_t* scr = (LAS bf16_t*)(lds3 + wave * 16384);
        for (int it = gw; it < 8192; it += NGW) { const int which = it >> 12, r = it & 4095, bh = r >> 5, tt = r & 31, b = bh >> 3, h = bh & 7;
            if (which == 0) transpose_tile64(PROJ1 + ((size_t)b * SEQ + tt * 64) * L1P + 1024 + h * 64, L1P, VTS + (size_t)bh * 64 * SEQ + tt * 64, SEQ, scr, lane);
            else            transpose_tile64(KVM + ((size_t)b * SEQ + tt * 64) * 1024 + h * 128 + 64, 1024, VTM + (size_t)bh * 64 * SEQ + tt * 64, SEQ, scr, lane); }
    }
    }
    GRID_BAR();
    {
        PHASE_IDS();
    {
        { LAS unsigned char* wl = lds3 + wave * 16384;
          for (int g2 = gw; g2 < 2048; g2 += NGW) { const int bh = g2 >> 4, w = g2 & 15;
#pragma unroll 1
              for (int i = 0; i < 4; ++i) { const int qb = (i == 0) ? w : (i == 1) ? 31 - w : (i == 2) ? 32 + w : 63 - w; sb_wave(bh, qb, lane, PROJ1, VTS, YMIX, wl); } } }
        __syncthreads();
        for (int g2 = (int)blockIdx.x; g2 < 256; g2 += G) { const int bh = g2 >> 1, part = g2 & 1;
#pragma unroll 1
            for (int i = 0; i < 4; ++i) { const int sbk = part ? ((i == 0) ? 1 : (i == 1) ? 6 : (i == 2) ? 2 : 5) : ((i == 0) ? 0 : (i == 1) ? 7 : (i == 2) ? 3 : 4);
                mla_block(bh, sbk, tid, lane, wave, lds3, QM, KVM, KPE, VTM, YMIX); } }
    }
    }
    GRID_BAR();
    {
        PHASE_IDS();
    GEMM_PHASE(EpiResidLN, YMIX, DM, W1out, 1024, 1024, 1024, ZB, ZB, STATS, IN(27), IN(28), ALPHA, 0);
    }
    GRID_BAR();
    {
        PHASE_IDS();
    ln_rows<1>(ZB, XB, nullptr, STATS, IN(35), IN(36), gw, NGW, lane);
    }
    GRID_BAR();
    {
        PHASE_IDS();
        { pg8::Gemm g_{XB, Wup1, M / 32, DFF, 1024, DM, 1024, 4096, 8192, 256, 512, 1}; pg8::StaticOrder S_; S_.init(M / 32, DFF, G, (int)blockIdx.x);
          pg8::EpiBf16S E_{HALO, nullptr, DFF, 0}; pg8::gemm_phase<pg8::EpiBf16S, pg8::StaticOrder, true, true>(lds3, g_, S_, E_); }
    }
    GRID_BAR();
    {
        PHASE_IDS();
        { pg8::Gemm g_{XB, Wup1, M, 2 * DFF, 1024, DM, 1024}; pg8::StaticOrder S_; S_.init(M, 2 * DFF, G, (int)blockIdx.x);
          pg8::EpiConvAct E_{ACT, HALO, IN(38), IN(39), DFF, SEQ}; pg8::gemm_phase<pg8::EpiConvAct, pg8::StaticOrder, true, true>(lds3, g_, S_, E_); }
    }
    GRID_BAR();
    {
        PHASE_IDS();
    GEMM_PHASE(EpiResidLN, ACT, DFF, Wdn1, DFF, 1024, DFF, ZB, XB, STATS, IN(35), IN(36), ALPHA, 0);
    }
    GRID_BAR();
    {
        PHASE_IDS();
    ln_rows<2>(XB, nullptr, out, STATS, IN(41), IN(42), gw, NGW, lane);
    #if defined(PROBE_STAMPS)
    __syncthreads();
    if (blockIdx.x == 0 && threadIdx.x == 0) {
        MISC[16 + 22] = (unsigned)__builtin_amdgcn_s_memrealtime();
#if defined(PROBE_GLOBAL)
#ifndef PROBE_GIDX
#define PROBE_GIDX 0
#endif
        const unsigned d1 = __hip_atomic_load(ctl + 2048 + PROBE_GIDX, __ATOMIC_RELAXED, __HIP_MEMORY_SCOPE_AGENT);
#elif defined(PROBE_ACC)
        const unsigned d1 = MISC[16 + PROBE_ACC];
#else
        const unsigned d1 = MISC[16 + PROBE_T1_HI] - MISC[16 + PROBE_T1_LO];
#endif
        const unsigned long long spin = 100ull * d1;
        const unsigned long long t0 = __builtin_amdgcn_s_memrealtime();
        while (__builtin_amdgcn_s_memrealtime() - t0 < spin) __builtin_amdgcn_s_sleep(8);
    }
#endif
}
}

extern "C" void kernel_launch(void* const* d_in, const int* in_sizes, int n_in, void* d_out, int out_size, void* d_ws, size_t ws_size, hipStream_t stream) {
    static int grid = 0;
    if (grid == 0) {
        if (n_in != 43 || ws_size < WS_NEED || out_size != M * DM) { fprintf(stderr, "kernel_launch: unexpected n_in %d / ws %zu / out %d\n", n_in, ws_size, out_size); grid = -1; return; }
        int dev = 0, cus = 0, per_cu = 0;
        if (hipGetDevice(&dev) != hipSuccess || hipDeviceGetAttribute(&cus, hipDeviceAttributeMultiprocessorCount, dev) != hipSuccess) { grid = -1; return; }
        if (hipFuncSetAttribute((const void*)fwd_mega, hipFuncAttributeMaxDynamicSharedMemorySize, LDS_BYTES) != hipSuccess) { fprintf(stderr, "kernel_launch: hipFuncSetAttribute failed\n"); grid = -1; return; }
        if (hipOccupancyMaxActiveBlocksPerMultiprocessor(&per_cu, (const void*)fwd_mega, NWAVES * 64, LDS_BYTES) != hipSuccess || per_cu < 1) fprintf(stderr, "kernel_launch: occupancy query reports %d\n", per_cu);
        (void)hipGetLastError();
        grid = cus;
    }
    if (grid < 0) return;
    (void)hipMemsetAsync((char*)d_ws + WS_CTL, 0, CTL_ZERO_BYTES, stream);
    Args a{};
    for (int i = 0; i < 43; ++i) a.in[i] = (const float*)d_in[i];
    a.out = (float*)d_out; a.ws = (unsigned char*)d_ws;
    hipLaunchKernelGGL(fwd_mega, dim3(grid), dim3(NWAVES * 64), LDS_BYTES, stream, a);
}
```

```cpp
#include <hip/hip_runtime.h>
#include <cstdio>
#include <cstdint>
#include <cmath>
namespace pg8 {
#define PG8_LAS __attribute__((address_space(3)))
typedef unsigned short bf16_t;
typedef short bf16x8 __attribute__((ext_vector_type(8)));
typedef float f32x4 __attribute__((ext_vector_type(4)));
typedef unsigned u32x4 __attribute__((ext_vector_type(4)));
constexpr int BM = 256, BK = 64, HALF = 128, HTB = HALF * BK * 2  , STAGE_BYTES = 8 * HTB, NXCD = 8, WGM = 8;

__host__ __device__ __forceinline__ int lds_byte(int r, int c) { const int st = (r >> 4) * 2 + (c >> 5), rr = r & 15, cc = c & 31, ob = rr * 64 + cc * 2; return st * 1024 + (ob ^ (((ob >> 9) & 1) << 5)); }
__host__ __device__ __forceinline__ void stage_rc(int b, int& R, int& C) { const int st = b / 1024, sb = b % 1024, swz = sb ^ (((sb >> 9) & 1) << 5); R = (st >> 1) * 16 + swz / 64; C = (st & 1) * 32 + (swz % 64) / 2; }
__host__ __device__ __forceinline__ int perm32(int rho) { const int n = rho >> 4, i = rho & 15; return 8 * (i >> 2) + 4 * n + (i & 3); }

struct Unit { int pm, pn; };
struct Gemm { const bf16_t* A; const bf16_t* Bt; int M, N, K, lda, ldb; int hrA = 128, trA = 256, hrB = 128, trB = 256, gatherA = 0; };

struct StaticOrder {
    int nM, nN, nwg, G, c;
    __host__ __device__ void init(int M, int N, int G_, int c_) { nM = M / BM; nN = N / BM; nwg = nM * nN; G = G_; c = c_; }
    __host__ __device__ bool next(int i, Unit& u) const {
        const long L = (long)i * G + c; if (L >= nwg) return false;
        int wgid = (int)L; { const int q = nwg / NXCD, r = nwg % NXCD, xcd = wgid % NXCD, off = wgid / NXCD; wgid = (xcd < r ? xcd * (q + 1) : r * (q + 1) + (xcd - r) * q) + off; }
        const int nig = WGM * nN, gid = wgid / nig, fm = gid * WGM, gsz = (nM - fm) < WGM ? (nM - fm) : WGM;
        u.pm = fm + ((wgid % nig) % gsz); u.pn = (wgid % nig) / gsz; return true;
    }
    __device__ __forceinline__ void a_ready(const Unit&) const {}
    __device__ __forceinline__ void done(const Unit&) const {}
};


__device__ __forceinline__ unsigned cvt_pk_bf16(float lo, float hi) { unsigned r; asm volatile("v_cvt_pk_bf16_f32 %0, %1, %2" : "=v"(r) : "v"(lo), "v"(hi)); return r; }
struct EpiBf16S {
    static constexpr bool PERM = true, AFTER_DRAIN = false;
    bf16_t* O; const float* rowscale; int ldc; int rs_stride;
    __device__ __forceinline__ void operator()(const f32x4 (&acc)[2][2][4][2], const Unit& u, int wr, int wc, int fr, int fq) const {
        const int row0 = u.pm * BM + wr * 64 + fr, col0 = u.pn * BM + wc * 32 + 8 * fq;
#pragma unroll
        for (int ai = 0; ai < 2; ++ai)
#pragma unroll
            for (int m = 0; m < 4; ++m) { const int row = row0 + ai * HALF + m * 16; const float sc = rowscale ? rowscale[(size_t)row * rs_stride] : 1.f;
                bf16_t* rowp = O + (size_t)row * ldc + col0;
#pragma unroll
                for (int bj = 0; bj < 2; ++bj) { const f32x4 v0 = acc[ai][bj][m][0] * sc, v1 = acc[ai][bj][m][1] * sc;
                    u32x4 w; w.x = cvt_pk_bf16(v0[0], v0[1]); w.y = cvt_pk_bf16(v0[2], v0[3]); w.z = cvt_pk_bf16(v1[0], v1[1]); w.w = cvt_pk_bf16(v1[2], v1[3]);
                    *(u32x4*)(rowp + bj * HALF) = w; } }
    }
};
struct EpiResid {
    static constexpr bool PERM = false, AFTER_DRAIN = false;
    const float* hin; bf16_t* hout; float alpha; int pad;
    __device__ __forceinline__ void operator()(const f32x4 (&acc)[2][2][4][2], const Unit& u, int wr, int wc, int fr, int fq) const {
        typedef unsigned u32x2r __attribute__((ext_vector_type(2)));
        const int row0 = u.pm * BM + wr * 64 + fr, col0 = u.pn * BM + wc * 32 + 4 * fq;
#pragma unroll
        for (int ai = 0; ai < 2; ++ai)
#pragma unroll
            for (int m = 0; m < 4; ++m) { const size_t off = (size_t)(row0 + ai * HALF + m * 16) * 1024 + col0;
#pragma unroll
                for (int bj = 0; bj < 2; ++bj)
#pragma unroll
                    for (int n = 0; n < 2; ++n) { const size_t i = off + bj * HALF + n * 16; const f32x4 h = *(const f32x4*)(hin + i); const f32x4 o = h * alpha + acc[ai][bj][m][n];
                        u32x2r w; w.x = cvt_pk_bf16(o[0], o[1]); w.y = cvt_pk_bf16(o[2], o[3]); *(u32x2r*)(hout + i) = w; } }
    }
};

struct EpiResidLN {
    static constexpr bool PERM = false, AFTER_DRAIN = false;
    const bf16_t* hin; bf16_t* hout; const float* stats; const float* g; const float* b; float alpha; int pad;
    __device__ __forceinline__ void operator()(const f32x4 (&acc)[2][2][4][2], const Unit& u, int wr, int wc, int fr, int fq) const {
        typedef unsigned u32x2r __attribute__((ext_vector_type(2)));
        const int row0 = u.pm * BM + wr * 64 + fr, col0 = u.pn * BM + wc * 32 + 4 * fq;
        f32x4 gg[2][2], bb[2][2];
#pragma unroll
        for (int bj = 0; bj < 2; ++bj)
#pragma unroll
            for (int n = 0; n < 2; ++n) { gg[bj][n] = *(const f32x4*)(g + col0 + bj * HALF + n * 16) * alpha; bb[bj][n] = *(const f32x4*)(b + col0 + bj * HALF + n * 16) * alpha; }
#pragma unroll
        for (int ai = 0; ai < 2; ++ai)
#pragma unroll
            for (int m = 0; m < 4; ++m) { const int row = row0 + ai * HALF + m * 16; const size_t off = (size_t)row * 1024 + col0;
                const float mu = stats[2 * row], rs = stats[2 * row + 1];
#pragma unroll
                for (int bj = 0; bj < 2; ++bj)
#pragma unroll
                    for (int n = 0; n < 2; ++n) { const size_t i = off + bj * HALF + n * 16; const u32x2r pw = *(const u32x2r*)(hin + i);
                        f32x4 p; p[0] = __builtin_bit_cast(float, pw.x << 16); p[1] = __builtin_bit_cast(float, pw.x & 0xffff0000u); p[2] = __builtin_bit_cast(float, pw.y << 16); p[3] = __builtin_bit_cast(float, pw.y & 0xffff0000u);
                        const f32x4 o = (p - mu) * rs * gg[bj][n] + bb[bj][n] + acc[ai][bj][m][n];
                        u32x2r w; w.x = cvt_pk_bf16(o[0], o[1]); w.y = cvt_pk_bf16(o[2], o[3]); *(u32x2r*)(hout + i) = w; } }
    }
};

template <int CTRL> __device__ __forceinline__ float pg_dpp(float x) { return __builtin_bit_cast(float, __builtin_amdgcn_update_dpp(0, __builtin_bit_cast(int, x), CTRL, 0xF, 0xF, true)); }
struct EpiConvAct {
    static constexpr bool PERM = true, AFTER_DRAIN = false;
    bf16_t* act; const bf16_t* halo; const float* cw; const float* cb; int dff; int seq;
    __device__ __forceinline__ void operator()(const f32x4 (&acc)[2][2][4][2], const Unit& u, int wr, int wc, int fr, int fq) const {
        typedef unsigned u32x2e __attribute__((ext_vector_type(2)));
#pragma unroll
        for (int n = 0; n < 2; ++n) {
            const int ch0 = u.pn * 128 + wc * 32 + 8 * fq + 4 * n;
            const f32x4 w0 = *(const f32x4*)(cw + ch0), w1 = *(const f32x4*)(cw + dff + ch0), w2 = *(const f32x4*)(cw + 2 * dff + ch0), bb = *(const f32x4*)(cb + ch0);
#pragma unroll
            for (int ai = 0; ai < 2; ++ai) {
                const int rb64 = u.pm * BM + ai * HALF + wr * 64;
                f32x4 P = {0.f, 0.f, 0.f, 0.f};
                if ((rb64 & (seq - 1)) != 0 && fr >= 14) { const u32x2e hv = *(const u32x2e*)(halo + (size_t)(2 * (rb64 / 64 - 1) + (fr - 14)) * dff + ch0);
                    P[0] = __builtin_bit_cast(float, hv.x << 16); P[1] = __builtin_bit_cast(float, hv.x & 0xffff0000u); P[2] = __builtin_bit_cast(float, hv.y << 16); P[3] = __builtin_bit_cast(float, hv.y & 0xffff0000u); }
#pragma unroll
                for (int m = 0; m < 4; ++m) {
                    const f32x4 Gv = acc[ai][0][m][n], Uv = acc[ai][1][m][n];
                    float o[4];
#pragma unroll
                    for (int e = 0; e < 4; ++e) {
                        const float t1 = pg_dpp<0x111>(Gv[e]), t2 = pg_dpp<0x112>(Gv[e]), p1 = pg_dpp<0x10F>(P[e]), p2 = pg_dpp<0x10E>(P[e]);
                        const float g1 = (fr >= 1) ? t1 : p1, g2 = (fr >= 2) ? t2 : p2;
                        const float y = bb[e] + w0[e] * g2 + w1[e] * g1 + w2[e] * Gv[e];
                        o[e] = y * __builtin_amdgcn_rcpf(1.f + __builtin_amdgcn_exp2f(-1.4426950408889634f * y)) * Uv[e];
                    }
                    u32x2e w; w.x = cvt_pk_bf16(o[0], o[1]); w.y = cvt_pk_bf16(o[2], o[3]);
                    *(u32x2e*)(act + (size_t)(rb64 + m * 16 + fr) * dff + ch0) = w;
                    P = Gv;
                }
            }
        }
    }
};

template <class Epi, class Sched, bool ALIGN_EPI = false, bool SP2 = false>
__device__ __forceinline__ void gemm_phase(PG8_LAS unsigned char* lds, const Gemm g, const Sched& S, const Epi& E) {
    int tid = threadIdx.x; asm volatile("" : "+v"(tid));
    const int wid = __builtin_amdgcn_readfirstlane(tid >> 6), lane = tid & 63, wr = wid >> 2, wc = wid & 3, fr = lane & 15, fq = lane >> 4;
    const int K = g.K, nt = K / BK;
    unsigned voffA[2], voffB[2];
#pragma unroll
    for (int i = 0; i < 2; ++i) { int R, C; stage_rc(tid * 16 + i * 8192, R, C); const int Rb = Epi::PERM ? ((R & ~31) + perm32(R & 31)) : R;
        const int Ra = g.gatherA ? (64 * (R >> 1) + 62 + (R & 1)) : R;
        voffA[i] = (unsigned)(Ra * g.lda + C) * 2u; voffB[i] = (unsigned)(Rb * g.ldb + C) * 2u; }
    const size_t kstep = (size_t)(BK * 2);
    const size_t hstepA = (size_t)g.hrA * g.lda * 2, hstepB = (size_t)g.hrB * g.ldb * 2;
    const size_t tstepA = (size_t)g.trA * g.lda * 2, tstepB = (size_t)g.trB * g.ldb * 2;
    const unsigned ldsw = (unsigned)wid * 1024u;
    const int aoff = lds_byte(wr * 64 + fr, fq * 8), boff = lds_byte(wc * 32 + fr, fq * 8);
#define PG8_SA(b, h) (((b) * 2 + (h)) * HTB)
#define PG8_SB(b, h) ((4 + (b) * 2 + (h)) * HTB)
#define PG8_STAGE(bufoff, gbase, voff) do { _Pragma("unroll") for (int _i = 0; _i < 2; ++_i) \
        __builtin_amdgcn_global_load_lds((const unsigned*)((const char*)(gbase) + (voff)[_i]), (PG8_LAS unsigned*)(lds + (bufoff) + ldsw + _i * 8192), 16, 0, 0); } while (0)
#define PG8_LDA(dst, b, h) do { _Pragma("unroll") for (int m = 0; m < 4; ++m) _Pragma("unroll") for (int k = 0; k < 2; ++k) dst[m][k] = *(const PG8_LAS bf16x8*)(lds + PG8_SA(b, h) + aoff + m * 2048 + k * 1024); } while (0)
#define PG8_LDB(dst, b, h) do { _Pragma("unroll") for (int n = 0; n < 2; ++n) _Pragma("unroll") for (int k = 0; k < 2; ++k) dst[n][k] = *(const PG8_LAS bf16x8*)(lds + PG8_SB(b, h) + boff + n * 2048 + k * 1024); } while (0)
#define PG8_MMA(ai, bj, At, Bt) do { __builtin_amdgcn_s_setprio(1); _Pragma("unroll") for (int m = 0; m < 4; ++m) _Pragma("unroll") for (int n = 0; n < 2; ++n) _Pragma("unroll") for (int k = 0; k < 2; ++k) \
        acc[ai][bj][m][n] = __builtin_amdgcn_mfma_f32_16x16x32_bf16(Bt[n][k], At[m][k], acc[ai][bj][m][n], 0, 0, 0); __builtin_amdgcn_s_setprio(0); } while (0)
#define PG8_WAIT_V(n) asm volatile("s_waitcnt vmcnt(" #n ")" ::: "memory")
#define PG8_WAIT_L(n) asm volatile("s_waitcnt lgkmcnt(" #n ")" ::: "memory")
#define PG8_BAR __builtin_amdgcn_s_barrier()
#define PG8_SCHED __builtin_amdgcn_sched_barrier(0)
    Unit cur, nxt; int ui = 0;
    if (!S.next(0, cur)) return;
    f32x4 acc[2][2][4][2];
#pragma unroll
    for (int a = 0; a < 2; ++a)
#pragma unroll
        for (int b = 0; b < 2; ++b)
#pragma unroll
            for (int m = 0; m < 4; ++m)
#pragma unroll
                for (int n = 0; n < 2; ++n) acc[a][b][m][n] = (f32x4){0.f, 0.f, 0.f, 0.f};
    bf16x8 At[4][2], B0[2][2], B1[2][2];
    const char* cA = (const char*)g.A + (size_t)cur.pm * tstepA; const char* cB = (const char*)g.Bt + (size_t)cur.pn * tstepB;
    S.a_ready(cur);
    if constexpr (SP2) {
        PG8_STAGE(PG8_SB(0, 0), cB, voffB); PG8_STAGE(PG8_SB(0, 1), cB + hstepB, voffB); PG8_STAGE(PG8_SA(0, 0), cA, voffA); PG8_STAGE(PG8_SA(0, 1), cA + hstepA, voffA);
        if (wr == 1) PG8_BAR;
        PG8_WAIT_V(2); PG8_BAR;
        PG8_STAGE(PG8_SB(1, 0), cB + kstep, voffB); PG8_STAGE(PG8_SA(1, 0), cA + kstep, voffA); PG8_STAGE(PG8_SB(1, 1), cB + hstepB + kstep, voffB);
        PG8_WAIT_V(6); PG8_BAR;
    } else {
        PG8_STAGE(PG8_SB(0, 0), cB, voffB); PG8_STAGE(PG8_SA(0, 0), cA, voffA); PG8_STAGE(PG8_SB(0, 1), cB + hstepB, voffB); PG8_STAGE(PG8_SA(0, 1), cA + hstepA, voffA);
        if (wr == 1) PG8_BAR;
        PG8_WAIT_V(4); PG8_BAR;
        PG8_STAGE(PG8_SB(1, 0), cB + kstep, voffB); PG8_STAGE(PG8_SA(1, 0), cA + kstep, voffA); PG8_STAGE(PG8_SB(1, 1), cB + hstepB + kstep, voffB);
        PG8_WAIT_V(6); PG8_BAR;
    }
    for (;;) {
        const bool has_next = S.next(ui + 1, nxt);
        const char* nA = has_next ? (const char*)g.A + (size_t)nxt.pm * tstepA : cA; const char* nB = has_next ? (const char*)g.Bt + (size_t)nxt.pn * tstepB : cB;
        for (int t = 0; t < nt; t += 2) {
            const bool last = (t == nt - 2);
            const char* a1 = cA + (size_t)(t + 1) * kstep;
            const char* a2 = last ? nA : cA + (size_t)(t + 2) * kstep; const char* b2 = last ? nB : cB + (size_t)(t + 2) * kstep;
            const char* a3 = a2 + kstep; const char* b3 = b2 + kstep;
            if (last && has_next) S.a_ready(nxt);
            if constexpr (SP2) {
            PG8_LDB(B0, 0, 0); PG8_LDB(B1, 0, 1); PG8_SCHED; PG8_LDA(At, 0, 0); PG8_STAGE(PG8_SA(1, 1), a1 + hstepA, voffA);
            PG8_WAIT_V(8); PG8_WAIT_L(0); PG8_BAR; PG8_MMA(0, 0, At, B0); PG8_MMA(0, 1, At, B1); PG8_BAR; PG8_SCHED;
            PG8_LDA(At, 0, 1); PG8_STAGE(PG8_SB(0, 0), b2, voffB); PG8_STAGE(PG8_SB(0, 1), b2 + hstepB, voffB); PG8_STAGE(PG8_SA(0, 0), a2, voffA);
            PG8_WAIT_V(8); PG8_WAIT_L(0); PG8_BAR; PG8_MMA(1, 0, At, B0); PG8_MMA(1, 1, At, B1); PG8_BAR; PG8_SCHED;
            PG8_LDB(B0, 1, 0); PG8_LDB(B1, 1, 1); PG8_SCHED; PG8_LDA(At, 1, 0); PG8_STAGE(PG8_SA(0, 1), a2 + hstepA, voffA);
            PG8_WAIT_V(8); PG8_WAIT_L(0); PG8_BAR; PG8_MMA(0, 0, At, B0); PG8_MMA(0, 1, At, B1); PG8_BAR; PG8_SCHED;
            PG8_LDA(At, 1, 1); PG8_STAGE(PG8_SB(1, 0), b3, voffB); PG8_STAGE(PG8_SB(1, 1), b3 + hstepB, voffB); PG8_STAGE(PG8_SA(1, 0), a3, voffA);
            PG8_WAIT_V(8); PG8_WAIT_L(0); PG8_BAR; PG8_MMA(1, 0, At, B0); PG8_MMA(1, 1, At, B1); PG8_BAR; PG8_SCHED;
            } else {
            PG8_LDB(B0, 0, 0); PG8_SCHED; PG8_LDA(At, 0, 0); PG8_STAGE(PG8_SA(1, 1), a1 + hstepA, voffA);
            PG8_WAIT_L(8); PG8_BAR; PG8_WAIT_L(0); PG8_MMA(0, 0, At, B0); PG8_BAR; PG8_SCHED;
            PG8_LDB(B1, 0, 1); PG8_STAGE(PG8_SB(0, 0), b2, voffB);
            PG8_BAR; PG8_WAIT_L(0); PG8_MMA(0, 1, At, B1); PG8_BAR;
            PG8_LDA(At, 0, 1); PG8_STAGE(PG8_SA(0, 0), a2, voffA);
            PG8_BAR; PG8_WAIT_L(0); PG8_MMA(1, 0, At, B0); PG8_BAR; PG8_SCHED;
            PG8_STAGE(PG8_SB(0, 1), b2 + hstepB, voffB);
            PG8_WAIT_V(6); PG8_BAR; PG8_MMA(1, 1, At, B1); PG8_BAR;
            PG8_LDB(B0, 1, 0); PG8_SCHED; PG8_LDA(At, 1, 0); PG8_STAGE(PG8_SA(0, 1), a2 + hstepA, voffA);
            PG8_WAIT_L(8); PG8_BAR; PG8_WAIT_L(0); PG8_MMA(0, 0, At, B0); PG8_BAR; PG8_SCHED;
            PG8_LDB(B1, 1, 1); PG8_STAGE(PG8_SB(1, 0), b3, voffB);
            PG8_BAR; PG8_WAIT_L(0); PG8_MMA(0, 1, At, B1); PG8_BAR;
            PG8_LDA(At, 1, 1); PG8_STAGE(PG8_SA(1, 0), a3, voffA);
            PG8_BAR; PG8_WAIT_L(0); PG8_MMA(1, 0, At, B0); PG8_BAR; PG8_SCHED;
            PG8_STAGE(PG8_SB(1, 1), b3 + hstepB, voffB);
            PG8_WAIT_V(6); PG8_BAR; PG8_MMA(1, 1, At, B1); PG8_BAR;
            }
        }
        if constexpr (ALIGN_EPI) { if (wr == 0) PG8_BAR; }
        if constexpr (!Epi::AFTER_DRAIN) { E(acc, cur, wr, wc, fr, fq); S.done(cur); }
        if (!has_next) break;
#pragma unroll
        for (int a = 0; a < 2; ++a)
#pragma unroll
            for (int b = 0; b < 2; ++b)
#pragma unroll
                for (int m = 0; m < 4; ++m)
#pragma unroll
                    for (int n = 0; n < 2; ++n) acc[a][b][m][n] = (f32x4){0.f, 0.f, 0.f, 0.f};
        cur = nxt; cA = nA; cB = nB; ++ui;
        if constexpr (ALIGN_EPI) { if (wr == 1) PG8_BAR; }
    }
    PG8_WAIT_V(0);
    if constexpr (!ALIGN_EPI) { if (wr == 0) PG8_BAR; }
    PG8_BAR;
    if constexpr (Epi::AFTER_DRAIN) { E.fused(acc, cur, wr, wc, fr, fq, lds, wid, lane); S.done(cur); }
#undef PG8_SA
#undef PG8_SB
#undef PG8_STAGE
#undef PG8_LDA
#undef PG8_LDB
#undef PG8_MMA
#undef PG8_WAIT_V
#undef PG8_WAIT_L
#undef PG8_BAR
#undef PG8_SCHED
}
}
#define GAS __attribute__((address_space(1)))
#define LAS __attribute__((address_space(3)))
typedef unsigned short bf16;
typedef unsigned v4u __attribute__((ext_vector_type(4)));
typedef float f32x4 __attribute__((ext_vector_type(4)));
typedef short bf16x8 __attribute__((ext_vector_type(8)));
typedef GAS unsigned gu32;
typedef GAS unsigned long long gu64;
#define RLX_AGENT __ATOMIC_RELAXED, __HIP_MEMORY_SCOPE_AGENT
#define LDS_WAIT() asm volatile("s_waitcnt lgkmcnt(0)" ::: "memory")
#define VM_WAIT() asm volatile("s_waitcnt vmcnt(0)" ::: "memory")
__device__ __forceinline__ unsigned long long rt() { return __builtin_amdgcn_s_memrealtime(); }
__device__ __forceinline__ unsigned f2bf(float f) { unsigned u = __builtin_bit_cast(unsigned, f); return (u + 0x7fffu + ((u >> 16) & 1u)) >> 16; }
__device__ __forceinline__ unsigned pk2(float lo, float hi) { return f2bf(lo) | (f2bf(hi) << 16); }

#define XB_TMO      128
#define XB_XCNT(j)  (256  + 64 * (j))
#define XB_XSUB(j)  (1280 + 64 * (j))
#define XB_XGEN(j)  (2304 + 64 * (j))
#define XB_TOP      3328
#define XB_TOPGEN   3392
#define XCD_BAR_WORDS 3456
#define XB_SPIN_CAP (1u << 18)

__device__ __forceinline__ unsigned xb_ld(unsigned* p)              { return __hip_atomic_load(p, __ATOMIC_RELAXED, __HIP_MEMORY_SCOPE_AGENT); }
__device__ __forceinline__ unsigned xb_add(unsigned* p, unsigned v) { return __hip_atomic_fetch_add(p, v, __ATOMIC_RELAXED, __HIP_MEMORY_SCOPE_AGENT); }
__device__ __forceinline__ unsigned xb_xcc_id() { return (unsigned)__builtin_amdgcn_s_getreg((3 << 11) | 20) & 0xFu; }
#define XB_SPIN(cond, bar) do { unsigned _sp = 0; while (cond) { __builtin_amdgcn_s_sleep(1); \
    if ((++_sp & 255u) == 0u) { if (xb_ld(&(bar)[XB_TMO])) break; if (_sp > XB_SPIN_CAP) { atomicAdd(&(bar)[XB_TMO], 1u); break; } } } } while (0)

struct XcdBarrier {
    unsigned* bar; unsigned x;
    volatile LAS unsigned* st;
};

__device__ __forceinline__ XcdBarrier xcd_barrier_post(unsigned* bar, volatile LAS unsigned* st) {
    XcdBarrier b; b.bar = bar; b.x = xb_xcc_id(); b.st = st;
    if (threadIdx.x == 0) (void)xb_add(&bar[XB_XCNT(b.x)], 1u);
    return b;
}
__device__ __forceinline__ void xcd_barrier_complete(unsigned* bar, unsigned x, unsigned& nloc, unsigned& nx) {
    const unsigned G = gridDim.x * gridDim.y * gridDim.z;
    unsigned sum, cnt, mine, sp = 0u;
    for (;;) {
        sum = 0u; cnt = 0u; mine = 0u;
#pragma unroll
        for (unsigned j = 0; j < 16; ++j) { const unsigned c = xb_ld(&bar[XB_XCNT(j)]); sum += c; cnt += (c > 0u) ? 1u : 0u; mine = (j == x) ? c : mine; }
        if (sum == G) break;
        __builtin_amdgcn_s_sleep(1);
        if ((++sp & 255u) == 0u) { if (xb_ld(&bar[XB_TMO])) break; if (sp > XB_SPIN_CAP) { atomicAdd(&bar[XB_TMO], 1u); break; } }
    }
    nloc = mine > 0u ? mine : 1u; nx = cnt > 0u ? cnt : 1u;
}

__device__ __forceinline__ void xcd_barrier(const XcdBarrier& b) {
    asm volatile("s_waitcnt vmcnt(0)" ::: "memory");
    __syncthreads();
    if (threadIdx.x == 0) {
        unsigned* bar = b.bar;
        __builtin_amdgcn_s_waitcnt(0);
        unsigned nloc = b.st[0], nx = b.st[1];
        if (nloc == 0u) { xcd_barrier_complete(bar, b.x, nloc, nx); b.st[0] = nloc; b.st[1] = nx; }
        const unsigned old = xb_add(&bar[XB_XSUB(b.x)], 1u);
        const unsigned gen = old / nloc;
        if (old + 1u == (gen + 1u) * nloc) {
            __builtin_amdgcn_fence(__ATOMIC_RELEASE, "agent");
            asm volatile("s_waitcnt vmcnt(0)" ::: "memory");
            const unsigned og = xb_add(&bar[XB_TOP], 1u);
            const unsigned tg = og / nx;
            if (og + 1u == (tg + 1u) * nx) xb_add(&bar[XB_TOPGEN], 1u);
            else XB_SPIN(xb_ld(&bar[XB_TOPGEN]) == tg, bar);
            __builtin_amdgcn_fence(__ATOMIC_ACQUIRE, "agent");
            xb_add(&bar[XB_XGEN(b.x)], 1u);
            asm volatile("s_waitcnt vmcnt(0)" ::: "memory");
        } else {
            XB_SPIN(xb_ld(&bar[XB_XGEN(b.x)]) == gen, bar);
            __builtin_amdgcn_fence(__ATOMIC_ACQUIRE, "agent");
            asm volatile("s_waitcnt vmcnt(0)" ::: "memory");
        }
    }
    __syncthreads();
}
constexpr int NWAVES = 8;
constexpr int BATCH = 16, SEQ = 2048, DM = 1024, M = BATCH * SEQ;
constexpr int L0P = 3584;
constexpr int L1P = 2048;
constexpr int DFF = 2816;
constexpr float ALPHA = 1.4142135623730951f;
typedef unsigned short bf16_t;
typedef float f32x16 __attribute__((ext_vector_type(16)));

constexpr size_t MiB = 1u << 20;
constexpr size_t WS_CTL = 0, CTL_ZERO_BYTES = 1 * MiB;
constexpr int CW_BAR = 4096;
constexpr size_t WS_W0IN = 2 * MiB, WS_W0OUT = 9 * MiB, WS_WUP0 = 11 * MiB, WS_WDN0 = 22 * MiB, WS_W1IN = 28 * MiB, WS_WUQ = 32 * MiB, WS_WUKV = 33 * MiB,
                 WS_W1OUT = 34 * MiB, WS_WUP1 = 36 * MiB, WS_WDN1 = 47 * MiB;
constexpr size_t WS_XB = 56 * MiB, WS_YMIX = 120 * MiB, WS_BIG = 184 * MiB;
constexpr size_t WS_G = 408 * MiB, WS_BONUS = 440 * MiB, WS_DT = 441 * MiB, WS_XST = 442 * MiB, WS_BT = 474 * MiB, WS_ASUM = 490 * MiB;
constexpr size_t WS_SLOC = 120 * MiB;
constexpr size_t WS_W2T = 53 * MiB, WS_A2T = 53 * MiB + 256 * 1024, WS_G2T = 53 * MiB + 512 * 1024;
constexpr size_t WS_GU = 120 * MiB;
constexpr size_t WS_PROJ1 = 184 * MiB, WS_QM = 312 * MiB, WS_KVM = 360 * MiB, WS_KPE = 424 * MiB, WS_RS = 426 * MiB;
constexpr size_t WS_CSTAB = 492 * MiB;
constexpr size_t WS_VTS = 428 * MiB, WS_VTM = 460 * MiB;
constexpr size_t WS_NEED = 497 * MiB;

constexpr int RING_BYTES = 131072;
constexpr int LDSCTL_OFF = 146432, MISC_OFF = LDSCTL_OFF + 320;
constexpr int LDS_BYTES = 147456;

__device__ __forceinline__ float bf2f(bf16_t b) { return __builtin_bit_cast(float, (unsigned)b << 16); }
__device__ __forceinline__ float sigmoidf_(float x) { return 1.f / (1.f + expf(-x)); }
__device__ __forceinline__ float softplusf_(float x) { return fmaxf(x, 0.f) + log1pf(expf(-fabsf(x))); }
__device__ __forceinline__ float siluf_(float x) { return x / (1.f + expf(-x)); }
__device__ __forceinline__ float wave_sum(float v) {
#pragma unroll
    for (int o = 1; o < 64; o <<= 1) v += __shfl_xor(v, o);
    return v;
}
#define WSYNC() asm volatile("s_waitcnt lgkmcnt(0)" ::: "memory")
typedef float f32x2_t __attribute__((ext_vector_type(2)));
typedef __bf16 bf16x2_t __attribute__((ext_vector_type(2)));
typedef unsigned u32x2 __attribute__((ext_vector_type(2)));
__device__ __forceinline__ unsigned cvtpk(float lo, float hi) { f32x2_t v = {lo, hi}; bf16x2_t b = __builtin_convertvector(v, bf16x2_t); return __builtin_bit_cast(unsigned, b); }
__device__ __forceinline__ float bflo(unsigned u) { return __builtin_bit_cast(float, u << 16); }
__device__ __forceinline__ float bfhi(unsigned u) { return __builtin_bit_cast(float, u & 0xffff0000u); }
__device__ __forceinline__ bf16_t bf1(float x) { return (bf16_t)(cvtpk(x, x) & 0xffffu); }
__device__ __forceinline__ bf16x8 pack8(float a0, float a1, float a2, float a3, float a4, float a5, float a6, float a7) {
    v4u w; w.x = cvtpk(a0, a1); w.y = cvtpk(a2, a3); w.z = cvtpk(a4, a5); w.w = cvtpk(a6, a7); return __builtin_bit_cast(bf16x8, w); }
template <int CTRL> __device__ __forceinline__ float dpp_mov(float x) { return __builtin_bit_cast(float, __builtin_amdgcn_update_dpp(0, __builtin_bit_cast(int, x), CTRL, 0xF, 0xF, true)); }
__device__ __forceinline__ float rowsum16(float x) { x += dpp_mov<0x128>(x); x += dpp_mov<0x124>(x); x += dpp_mov<0x122>(x); x += dpp_mov<0x121>(x); return x; }
__device__ __forceinline__ float rl(float x, int l) { return __builtin_bit_cast(float, __builtin_amdgcn_readlane(__builtin_bit_cast(int, x), l)); }
__device__ __forceinline__ float wave_sum_dpp(float x) { x = rowsum16(x); return (rl(x, 0) + rl(x, 16)) + (rl(x, 32) + rl(x, 48)); }

__device__ __forceinline__ void transpose_matrix(const float* __restrict__ W, int K, int N, bf16_t* __restrict__ WT, int Npad, int ldt, LAS float* scr, int gw, int NGW, int lane, const float* __restrict__ kscale, int& tr_base, bool ffn_interleave = false) {
    (void)scr;
    const int nblk = Npad / 64, nit = (K / 64) * nblk;
    int it0 = gw - (tr_base % NGW); if (it0 < 0) it0 += NGW; tr_base += nit;
    for (int it = it0; it < nit; it += NGW) {
        const int kb = it / nblk, nb = it - kb * nblk, n = nb * 64 + lane, k0 = kb * 64;
        const bool ok = n < N; const float* src = W + (size_t)k0 * N + (ok ? n : 0);
#pragma unroll
        for (int hc = 0; hc < 2; ++hc) {
            float v[32];
#pragma unroll
            for (int i = 0; i < 32; ++i) v[i] = src[(size_t)(hc * 32 + i) * N];
#pragma unroll
            for (int c = 0; c < 4; ++c) { float u[8];
#pragma unroll
                for (int i = 0; i < 8; ++i) { u[i] = ok ? v[c * 8 + i] : 0.f; if (kscale) u[i] *= kscale[k0 + hc * 32 + c * 8 + i]; }
                v4u o; o.x = cvtpk(u[0], u[1]); o.y = cvtpk(u[2], u[3]); o.z = cvtpk(u[4], u[5]); o.w = cvtpk(u[6], u[7]);
                const int nr = ffn_interleave ? ((n < DFF) ? 256 * (n >> 7) + (n & 127) : 256 * ((n - DFF) >> 7) + 128 + ((n - DFF) & 127)) : n;
                *(v4u*)(WT + (size_t)nr * ldt + k0 + hc * 32 + c * 8) = o; }
        }
    }
}

template <int MODE> __device__ __forceinline__ void ln_rows(const bf16_t* z, bf16_t* hb, float* outf, float* stats, const float* __restrict__ g, const float* __restrict__ b, int gw, int NGW, int lane) {
    for (int row = gw * 2; row < M; row += NGW * 2) {
        const bf16_t* p = z + (size_t)row * DM;
        pg8::u32x4 raw[2][2];
#pragma unroll
        for (int r = 0; r < 2; ++r)
#pragma unroll
            for (int j = 0; j < 2; ++j) raw[r][j] = *(const pg8::u32x4*)(p + r * DM + 8 * lane + 512 * j);
        f32x4 v[2][4]; float s[2] = {0.f, 0.f};
#pragma unroll
        for (int r = 0; r < 2; ++r)
#pragma unroll
            for (int j = 0; j < 2; ++j) {
                v[r][2 * j][0] = __builtin_bit_cast(float, raw[r][j].x << 16); v[r][2 * j][1] = __builtin_bit_cast(float, raw[r][j].x & 0xffff0000u);
                v[r][2 * j][2] = __builtin_bit_cast(float, raw[r][j].y << 16); v[r][2 * j][3] = __builtin_bit_cast(float, raw[r][j].y & 0xffff0000u);
                v[r][2 * j + 1][0] = __builtin_bit_cast(float, raw[r][j].z << 16); v[r][2 * j + 1][1] = __builtin_bit_cast(float, raw[r][j].z & 0xffff0000u);
                v[r][2 * j + 1][2] = __builtin_bit_cast(float, raw[r][j].w << 16); v[r][2 * j + 1][3] = __builtin_bit_cast(float, raw[r][j].w & 0xffff0000u); }
#pragma unroll
        for (int r = 0; r < 2; ++r)
#pragma unroll
            for (int j = 0; j < 4; ++j) s[r] += (v[r][j][0] + v[r][j][1]) + (v[r][j][2] + v[r][j][3]);
        float mean[2], q[2] = {0.f, 0.f}, rstd[2];
#pragma unroll
        for (int r = 0; r < 2; ++r) { mean[r] = wave_sum_dpp(s[r]) * (1.f / DM);
#pragma unroll
            for (int j = 0; j < 4; ++j) { v[r][j] = v[r][j] - mean[r]; q[r] += (v[r][j][0] * v[r][j][0] + v[r][j][1] * v[r][j][1]) + (v[r][j][2] * v[r][j][2] + v[r][j][3] * v[r][j][3]); } }
#pragma unroll
        for (int r = 0; r < 2; ++r) rstd[r] = 1.0f / sqrtf(wave_sum_dpp(q[r]) * (1.f / DM) + 1e-5f);
        if (MODE == 1 && lane < 2) { stats[2 * (row + lane)] = lane ? mean[1] : mean[0]; stats[2 * (row + lane) + 1] = lane ? rstd[1] : rstd[0]; }
#pragma unroll
        for (int j = 0; j < 2; ++j) {
            const int c = 8 * lane + 512 * j;
            const f32x4 g0 = *(const f32x4*)(g + c), g1 = *(const f32x4*)(g + c + 4), b0 = *(const f32x4*)(b + c), b1 = *(const f32x4*)(b + c + 4);
#pragma unroll
            for (int r = 0; r < 2; ++r) {
                const f32x4 o0 = v[r][2 * j] * rstd[r] * g0 + b0, o1 = v[r][2 * j + 1] * rstd[r] * g1 + b1;
                if (MODE == 1) { pg8::u32x4 w; w.x = cvtpk(o0[0], o0[1]); w.y = cvtpk(o0[2], o0[3]); w.z = cvtpk(o1[0], o1[1]); w.w = cvtpk(o1[2], o1[3]); *(pg8::u32x4*)(hb + (size_t)(row + r) * DM + c) = w; }
                else { *(f32x4*)(outf + (size_t)(row + r) * DM + c) = o0; *(f32x4*)(outf + (size_t)(row + r) * DM + c + 4) = o1; }
            }
        }
    }
}

__device__ __forceinline__ void rwkv_naive_chain(int chain, int lane, LAS float* sm, const bf16_t* __restrict__ proj, const float* __restrict__ mix, const float* __restrict__ w0, const float* __restrict__ w2,
                                                 const float* __restrict__ a0, const float* __restrict__ a2, const float* __restrict__ g2, const float* __restrict__ k_k,
                                                 const float* __restrict__ k_a, const float* __restrict__ r_k, const float* __restrict__ ln_g, const float* __restrict__ ln_b, bf16_t* __restrict__ ymix) {
    LAS float* s_w2 = sm; LAS float* s_a2 = sm + 4096; LAS float* s_g2 = sm + 8192; LAS float* s_tw = sm + 16384; LAS float* s_al = s_tw + 64; LAS float* s_sg = s_tw + 128;
    LAS float* s_w = s_tw + 256; LAS float* s_k = s_tw + 320; LAS float* s_a = s_tw + 384; LAS float* s_b = s_tw + 448; LAS float* s_r = s_tw + 512;
    const int b = chain >> 3, h = chain & 7, c = h * 64 + lane;
    for (int l = 0; l < 64; ++l) { s_w2[l * 64 + lane] = w2[l * 512 + c]; s_a2[l * 64 + lane] = a2[l * 512 + c]; }
    for (int l = 0; l < 128; ++l) s_g2[l * 64 + lane] = g2[l * 512 + c];
    const float mr = mix[c], mk = mix[512 + c], mv = mix[1024 + c], mw = mix[1536 + lane], ma = mix[1600 + lane], mg0 = mix[1664 + lane], mg1 = mix[1728 + lane];
    const float w0c = w0[c], a0c = a0[c], kkc = k_k[c], kac = k_a[c], rkc = r_k[c], lgc = ln_g[c], lbc = ln_b[c];
    float S[64];
#pragma unroll
    for (int j = 0; j < 64; ++j) S[j] = 0.f;
    float pr = 0.f, pk = 0.f, pv = 0.f, pw = 0.f, pa = 0.f, pg0 = 0.f, pg1 = 0.f;
    WSYNC();
    for (int t = 0; t < SEQ; ++t) {
        const bf16_t* row = proj + (size_t)(b * SEQ + t) * L0P;
        const float cr = bf2f(row[c]), ck = bf2f(row[512 + c]), cv = bf2f(row[1024 + c]), cw = bf2f(row[1536 + lane]), ca = bf2f(row[1600 + lane]),
                    cg0 = bf2f(row[1664 + lane]), cg1 = bf2f(row[1728 + lane]);
        const float r_s = cr + (pr - cr) * mr, k_s = ck + (pk - ck) * mk, v_s = cv + (pv - cv) * mv;
        const float wl = cw + (pw - cw) * mw, al = ca + (pa - ca) * ma, g0 = cg0 + (pg0 - cg0) * mg0, g1 = cg1 + (pg1 - cg1) * mg1;
        pr = cr; pk = ck; pv = cv; pw = cw; pa = ca; pg0 = cg0; pg1 = cg1;
        s_tw[lane] = tanhf(wl); s_al[lane] = al; s_sg[lane] = sigmoidf_(g0); s_sg[64 + lane] = sigmoidf_(g1);
        WSYNC();
        float wsum = w0c, asum = a0c, gsum = 0.f;
#pragma unroll 2
        for (int l = 0; l < 64; ++l) { wsum += s_tw[l] * s_w2[l * 64 + lane]; asum += s_al[l] * s_a2[l * 64 + lane]; }
#pragma unroll 2
        for (int l = 0; l < 128; ++l) gsum += s_sg[l] * s_g2[l * 64 + lane];
        const float log_w = -softplusf_(-wsum) - 0.5f;
        const float dec = expf(-expf(log_w));
        const float a = sigmoidf_(asum);
        float kkv = k_s * kkc;
        const float nrm = sqrtf(wave_sum(kkv * kkv));
        kkv = kkv / fmaxf(nrm, 1e-12f);
        const float k2 = k_s * (1.f + (a - 1.f) * kac);
        const float bonus_s = wave_sum(r_s * k2 * rkc);
        s_w[lane] = dec; s_k[lane] = k2; s_a[lane] = -kkv; s_b[lane] = kkv * a; s_r[lane] = r_s;
        WSYNC();
        float sa = 0.f;
#pragma unroll
        for (int j = 0; j < 64; ++j) sa += S[j] * s_a[j];
        float y = 0.f;
#pragma unroll
        for (int j = 0; j < 64; ++j) { S[j] = S[j] * s_w[j] + sa * s_b[j] + v_s * s_k[j]; y += S[j] * s_r[j]; }
        const float mu = wave_sum(y) * (1.f / 64.f);
        const float d = y - mu;
        const float var = wave_sum(d * d) * (1.f / 64.f);
        const float yn = d * (1.0f / sqrtf(var + 64e-5f)) * lgc + lbc;
        const float o = (yn + bonus_s * v_s) * gsum;
        ymix[(size_t)(b * SEQ + t) * DM + c] = (bf16_t)f2bf(o);
        WSYNC();
    }
}

__device__ __forceinline__ void ssm_conv_all(const bf16_t* __restrict__ proj, const float* __restrict__ cw, const float* __restrict__ cb, const float* __restrict__ dtb,
                                             bf16_t* __restrict__ xbc, float* __restrict__ dt, int gtid, int NT) {
    for (size_t i = gtid; i < (size_t)M * 1024; i += NT) {
        const int m = (int)(i >> 10), c = (int)(i & 1023), t = m & (SEQ - 1);
        float acc = cb[c];
#pragma unroll
        for (int k = 0; k < 4; ++k) { const int tt = t - 3 + k; if (tt >= 0) acc += cw[k * 1024 + c] * bf2f(proj[(size_t)(m - 3 + k) * L0P + 2304 + c]); }
        xbc[i] = (bf16_t)f2bf(siluf_(acc));
    }
    for (int i = gtid; i < M * 8; i += NT) dt[i] = softplusf_(bf2f(proj[(size_t)(i >> 3) * L0P + 3328 + (i & 7)]) + dtb[i & 7]);
}
__device__ __forceinline__ void ssd_naive_task(int task, int lane, const bf16_t* __restrict__ xbc, const float* __restrict__ dt, const float* __restrict__ a_log, const float* __restrict__ dsk, float* __restrict__ yssm) {
    const int chain = task >> 2, q = task & 3, b = chain >> 3, h = chain & 7, g = h >> 2, p = q * 16 + (lane >> 2), nq = lane & 3;
    const float A = -expf(a_log[h]), D = dsk[h];
    float st[32];
#pragma unroll
    for (int n = 0; n < 32; ++n) st[n] = 0.f;
    for (int t = 0; t < SEQ; ++t) {
        const size_t m = (size_t)b * SEQ + t;
        const float dtv = dt[m * 8 + h], dA = expf(dtv * A);
        const float x = bf2f(xbc[m * 1024 + h * 64 + p]), xdt = x * dtv;
        const bf16_t* Bp = xbc + m * 1024 + 512 + g * 128 + nq * 32;
        const bf16_t* Cp = xbc + m * 1024 + 768 + g * 128 + nq * 32;
        float yp = 0.f;
#pragma unroll
        for (int n = 0; n < 32; ++n) { st[n] = st[n] * dA + xdt * bf2f(Bp[n]); yp += st[n] * bf2f(Cp[n]); }
        yp += __shfl_xor(yp, 1); yp += __shfl_xor(yp, 2);
        if (nq == 0) yssm[m * 512 + h * 64 + p] = yp + D * x;
    }
}
template <bool ST = true> __device__ __forceinline__ void ssm_gate_norm_all(const bf16_t* __restrict__ yssm, const bf16_t* __restrict__ proj, const float* __restrict__ ng, bf16_t* __restrict__ ymix, int wv0, int wvend, int lane) {
    for (int wvb = wv0 * 4 - (wv0 & ~7) * 3; wvb < wvend; wvb += NWAVES * 4) {
        float u[4][4], q[4];
#pragma unroll
        for (int k = 0; k < 4; ++k) { const int wv = wvb + k, m = wv >> 1, g = wv & 1; q[k] = 0.f;
#pragma unroll
            for (int j = 0; j < 4; ++j) { const int c = g * 256 + j * 64 + lane; const float z = bf2f(proj[(size_t)m * L0P + 1792 + c]); u[k][j] = bf2f(yssm[(size_t)m * 512 + c]) * (z * __builtin_amdgcn_rcpf(1.f + __expf(-z))); q[k] += u[k][j] * u[k][j]; } }
#pragma unroll
        for (int k = 0; k < 4; ++k) { const int wv = wvb + k, m = wv >> 1, g = wv & 1;
            const float rs = __builtin_amdgcn_rsqf(wave_sum_dpp(q[k]) * (1.f / 256.f) + 1e-5f);
#pragma unroll
            for (int j = 0; j < 4; ++j) { const int c = g * 256 + j * 64 + lane; const float o_ = u[k][j] * rs * ng[c]; if (ST) ymix[(size_t)m * DM + 512 + c] = bf1(o_); else asm volatile("" :: "v"(o_)); } }
    }
}
template <bool ST = true> __device__ __forceinline__ void ffn_act_all(bf16_t* gu, const float* __restrict__ cw, const float* __restrict__ cb, int gtid, int NT) {
    constexpr int NCH = DFF / 8, NSTRIP = M / 32;
    for (int task = gtid; task < NSTRIP * NCH; task += NT) {
        const int strip = task / NCH, q = task - strip * NCH, c0 = q * 8, m0 = strip * 32;
        float w0[8], w1[8], w2[8], bb[8], g2[8], g1[8];
#pragma unroll
        for (int j = 0; j < 8; j += 4) { const f32x4 a = *(const f32x4*)(cw + c0 + j), b = *(const f32x4*)(cw + DFF + c0 + j), c = *(const f32x4*)(cw + 2 * DFF + c0 + j), d = *(const f32x4*)(cb + c0 + j);
#pragma unroll
            for (int k = 0; k < 4; ++k) { w0[j + k] = a[k]; w1[j + k] = b[k]; w2[j + k] = c[k]; bb[j + k] = d[k]; } }
        bf16_t* base = gu + (size_t)m0 * (2 * DFF) + c0;
        if ((m0 & (SEQ - 1)) != 0) { const v4u a = *(const v4u*)(base - 2 * (2 * DFF)), b = *(const v4u*)(base - (2 * DFF));
            g2[0] = bflo(a.x); g2[1] = bfhi(a.x); g2[2] = bflo(a.y); g2[3] = bfhi(a.y); g2[4] = bflo(a.z); g2[5] = bfhi(a.z); g2[6] = bflo(a.w); g2[7] = bfhi(a.w);
            g1[0] = bflo(b.x); g1[1] = bfhi(b.x); g1[2] = bflo(b.y); g1[3] = bfhi(b.y); g1[4] = bflo(b.z); g1[5] = bfhi(b.z); g1[6] = bflo(b.w); g1[7] = bfhi(b.w); }
        else {
#pragma unroll
            for (int j = 0; j < 8; ++j) { g2[j] = 0.f; g1[j] = 0.f; } }
#pragma unroll 4
        for (int r = 0; r < 32; ++r) {
            const v4u gv = *(const v4u*)(base + (size_t)r * (2 * DFF)), uv = *(const v4u*)(base + (size_t)r * (2 * DFF) + DFF);
            const unsigned gw_[4] = {gv.x, gv.y, gv.z, gv.w}, uw_[4] = {uv.x, uv.y, uv.z, uv.w};
            unsigned ow[4];
#pragma unroll
            for (int k = 0; k < 4; ++k) {
                const float ga = bflo(gw_[k]), gb = bfhi(gw_[k]);
                const float ya = bb[2 * k] + w0[2 * k] * g2[2 * k] + w1[2 * k] * g1[2 * k] + w2[2 * k] * ga;
                const float yb = bb[2 * k + 1] + w0[2 * k + 1] * g2[2 * k + 1] + w1[2 * k + 1] * g1[2 * k + 1] + w2[2 * k + 1] * gb;
                g2[2 * k] = g1[2 * k]; g1[2 * k] = ga; g2[2 * k + 1] = g1[2 * k + 1]; g1[2 * k + 1] = gb;
                ow[k] = cvtpk(ya / (1.f + __expf(-ya)) * bflo(uw_[k]), yb / (1.f + __expf(-yb)) * bfhi(uw_[k]));
            }
            if (ST) *(v4u*)(base + (size_t)r * (2 * DFF) + DFF) = (v4u){ow[0], ow[1], ow[2], ow[3]}; else asm volatile("" :: "v"(ow[0]), "v"(ow[1]), "v"(ow[2]), "v"(ow[3]));
        }
    }
}
template <bool ST = true> __device__ __forceinline__ void mla_prep_all(const bf16_t* __restrict__ proj1, const int* __restrict__ pos, float* __restrict__ rs, bf16_t* __restrict__ kpe, float* __restrict__ cstab, int gw, int NGW, int lane) {
    const int fi = lane & 15, tk = lane >> 4;
    const double inv_rev = exp2(-(double)(2 * fi) * (13.287712379549449 / 32.0)) * 0.15915494309189535;
    for (int m4 = gw * 4; m4 < M; m4 += NGW * 4) {
        const int mt = m4 + tk;
        const bf16_t* row = proj1 + (size_t)mt * L1P;
        const v4u qa = *(const v4u*)(row + 1536 + 8 * fi), qb = *(const v4u*)(row + 1664 + 8 * fi), ka = *(const v4u*)(row + 1792 + 8 * fi);
        const float x1 = bf2f(row[1920 + fi]), x2 = bf2f(row[1936 + fi]);
        const double rev = (double)pos[mt] * inv_rev;
        const float fr = (float)(rev - floor(rev));
        const float cs = __builtin_amdgcn_cosf(fr), sn = __builtin_amdgcn_sinf(fr);
        cstab[(size_t)mt * 32 + fi] = cs; cstab[(size_t)mt * 32 + 16 + fi] = sn;
        kpe[(size_t)mt * 32 + fi] = bf1(x1 * cs - x2 * sn); kpe[(size_t)mt * 32 + 16 + fi] = bf1(x2 * cs + x1 * sn);
        float q = 0.f, k = 0.f;
#pragma unroll
        for (int e = 0; e < 4; ++e) { const float a0 = bflo(qa[e]), a1 = bfhi(qa[e]), b0 = bflo(qb[e]), b1 = bfhi(qb[e]), c0 = bflo(ka[e]), c1 = bfhi(ka[e]);
            q += (a0 * a0 + a1 * a1) + (b0 * b0 + b1 * b1); k += c0 * c0 + c1 * c1; }
        q = rowsum16(q); k = rowsum16(k);
        if (fi == 0) { rs[(size_t)mt * 2] = 1.0f / sqrtf(q * (1.f / 256.f) + 1e-6f); rs[(size_t)mt * 2 + 1] = 1.0f / sqrtf(k * (1.f / 128.f) + 1e-6f); }
    }
}
template <bool ST = true> __device__ __forceinline__ void rope_q_all(bf16_t* qm, const float* __restrict__ cstab, int gtid, int NT) {
    for (int i = gtid; i < M * 16; i += NT) {
        const int m = i >> 4, h = (i >> 1) & 7, k0 = (i & 1) * 8;
        bf16_t* p = qm + (size_t)m * 768 + h * 96 + 64 + k0;
        const v4u a = *(const v4u*)p, b = *(const v4u*)(p + 16);
        const f32x4 c0 = *(const f32x4*)(cstab + (size_t)m * 32 + k0), c1 = *(const f32x4*)(cstab + (size_t)m * 32 + k0 + 4), s0 = *(const f32x4*)(cstab + (size_t)m * 32 + 16 + k0), s1 = *(const f32x4*)(cstab + (size_t)m * 32 + 16 + k0 + 4);
        const unsigned au[4] = {a.x, a.y, a.z, a.w}, bu[4] = {b.x, b.y, b.z, b.w};
        const float cs[8] = {c0[0], c0[1], c0[2], c0[3], c1[0], c1[1], c1[2], c1[3]}, sn[8] = {s0[0], s0[1], s0[2], s0[3], s1[0], s1[1], s1[2], s1[3]};
        unsigned o1[4], o2[4];
#pragma unroll
        for (int q = 0; q < 4; ++q) { const float x1a = bflo(au[q]), x1b = bfhi(au[q]), x2a = bflo(bu[q]), x2b = bfhi(bu[q]);
            o1[q] = cvtpk(x1a * cs[2 * q] - x2a * sn[2 * q], x1b * cs[2 * q + 1] - x2b * sn[2 * q + 1]);
            o2[q] = cvtpk(x2a * cs[2 * q] + x1a * sn[2 * q], x2b * cs[2 * q + 1] + x1b * sn[2 * q + 1]); }
        if (ST) { *(v4u*)p = (v4u){o1[0], o1[1], o1[2], o1[3]}; *(v4u*)(p + 16) = (v4u){o2[0], o2[1], o2[2], o2[3]}; }
    }
}
__device__ __forceinline__ void sb_naive_task(int qblk, int bh, int lane, const bf16_t* __restrict__ proj1, bf16_t* __restrict__ ymix) {
    const int b = bh >> 3, h = bh & 7, t = qblk * 64 + lane;
    const size_t mrow = (size_t)b * SEQ;
    float q[64], o[64];
#pragma unroll
    for (int d = 0; d < 64; ++d) { q[d] = bf2f(proj1[(mrow + t) * L1P + h * 64 + d]) * 0.125f; o[d] = 0.f; }
    float cum = 0.f;
    const int smax = qblk * 64 + 63;
    for (int s = smax - 1; s >= 0; --s) {
        const bf16_t* kr = proj1 + (mrow + s) * L1P + 512 + h * 64;
        const bf16_t* vr = proj1 + (mrow + s) * L1P + 1024 + h * 64;
        float z = 0.f;
#pragma unroll
        for (int d = 0; d < 64; ++d) z += q[d] * bf2f(kr[d]);
        if (s < t) {
            const float lsp = -softplusf_(-z);
            const float lsn = -softplusf_(z);
            const float att = expf(lsp + cum);
            cum += lsn;
#pragma unroll
            for (int d = 0; d < 64; ++d) o[d] += att * bf2f(vr[d]);
        }
    }
#pragma unroll
    for (int d = 0; d < 64; ++d) ymix[(mrow + t) * DM + h * 64 + d] = (bf16_t)f2bf(o[d]);
}
__device__ __forceinline__ void mla_naive_task(int qblk, int bh, int lane, const bf16_t* __restrict__ qm, const bf16_t* __restrict__ kvm, const bf16_t* __restrict__ kpe, bf16_t* __restrict__ ymix) {
    const int b = bh >> 3, h = bh & 7, t = qblk * 64 + lane;
    const size_t mrow = (size_t)b * SEQ;
    const float scale = 0.10206207261596577f;
    float q[96], o[64];
#pragma unroll
    for (int d = 0; d < 96; ++d) q[d] = bf2f(qm[(mrow + t) * 768 + h * 96 + d]) * scale;
#pragma unroll
    for (int d = 0; d < 64; ++d) o[d] = 0.f;
    float mx = -1e30f, l = 0.f;
    const int smax = qblk * 64 + 63;
    for (int s = 0; s <= smax; ++s) {
        const bf16_t* kr = kvm + (mrow + s) * 1024 + h * 128;
        const bf16_t* pr = kpe + (mrow + s) * 32;
        float z = 0.f;
#pragma unroll
        for (int d = 0; d < 64; ++d) z += q[d] * bf2f(kr[d]);
#pragma unroll
        for (int d = 0; d < 32; ++d) z += q[64 + d] * bf2f(pr[d]);
        if (s <= t) {
            const float mn = fmaxf(mx, z), f = expf(mx - mn), pz = expf(z - mn);
            l = l * f + pz; mx = mn;
#pragma unroll
            for (int d = 0; d < 64; ++d) o[d] = o[d] * f + pz * bf2f(kr[64 + d]);
        }
    }
    const float il = 1.f / l;
#pragma unroll
    for (int d = 0; d < 64; ++d) ymix[(mrow + t) * DM + 512 + h * 64 + d] = (bf16_t)f2bf(o[d] * il);
}


__device__ __forceinline__ int crow(int r, int hi) { return (r & 3) + 8 * (r >> 2) + 4 * hi; }
#define MFMA32(a, b, c) __builtin_amdgcn_mfma_f32_32x32x16_bf16((a), (b), (c), 0, 0, 0)
constexpr int STG_PITCH = 72;
__device__ __forceinline__ void transpose_tile64(const bf16_t* __restrict__ src, int sp, bf16_t* __restrict__ dst, int dp, LAS bf16_t* scr, int lane) {
#pragma unroll
    for (int i = 0; i < 8; ++i) { const int row = i * 8 + (lane >> 3), ch = lane & 7; const v4u v = *(const v4u*)(src + (size_t)row * sp + ch * 8); *(LAS v4u*)(scr + row * STG_PITCH + ch * 8) = v; }
    WSYNC();
#pragma unroll
    for (int i = 0; i < 8; ++i) { const int d = i * 8 + (lane >> 3), tc = lane & 7; const LAS bf16_t* p = scr + (tc * 8) * STG_PITCH + d;
        v4u o; o.x = (unsigned)p[0] | ((unsigned)p[STG_PITCH] << 16); o.y = (unsigned)p[2 * STG_PITCH] | ((unsigned)p[3 * STG_PITCH] << 16);
        o.z = (unsigned)p[4 * STG_PITCH] | ((unsigned)p[5 * STG_PITCH] << 16); o.w = (unsigned)p[6 * STG_PITCH] | ((unsigned)p[7 * STG_PITCH] << 16);
        *(v4u*)(dst + (size_t)d * dp + tc * 8) = o; }
    WSYNC();
}
__device__ __forceinline__ void store_OT(const f32x16 (&o)[2], float sc, LAS bf16_t* stg, bf16_t* __restrict__ dst, int lane) {
    const int l31 = lane & 31, hi = lane >> 5;
#pragma unroll
    for (int dt = 0; dt < 2; ++dt)
#pragma unroll
        for (int r = 0; r < 16; ++r) stg[l31 * STG_PITCH + 32 * dt + crow(r, hi)] = bf1(o[dt][r] * sc);
    WSYNC();
#pragma unroll
    for (int i = 0; i < 4; ++i) { const int row = i * 8 + (lane >> 3), ch = lane & 7; const v4u v = *(const LAS v4u*)(stg + row * STG_PITCH + ch * 8); *(v4u*)(dst + (size_t)row * DM + ch * 8) = v; }
    WSYNC();
}
__device__ __forceinline__ float softplus_fast(float z) { return fmaxf(z, 0.f) + __logf(1.f + __expf(-fabsf(z))); }

__device__ __forceinline__ void sb_task(int bh, int qblk, int lane, const bf16_t* __restrict__ P1, const bf16_t* __restrict__ VT, bf16_t* __restrict__ ymix, LAS bf16_t* stg) {
    const int b = bh >> 3, h = bh & 7, l31 = lane & 31, hi = lane >> 5, q0 = qblk * 32, t = q0 + l31;
    const size_t rowb = (size_t)b * SEQ;
    const bf16_t* Qp = P1 + (rowb + q0 + l31) * L1P + h * 64 + 8 * hi;
    bf16x8 qf[4];
#pragma unroll
    for (int kk = 0; kk < 4; ++kk) qf[kk] = *(const bf16x8*)(Qp + 16 * kk);
    const bf16_t* Kp = P1 + (rowb + l31) * L1P + 512 + h * 64 + 8 * hi;
    const bf16_t* Vp = VT + ((size_t)bh * 64 + l31) * SEQ + 4 * hi;
    f32x16 o[2];
#pragma unroll
    for (int r = 0; r < 16; ++r) { o[0][r] = 0.f; o[1][r] = 0.f; }
    float cum = 0.f;
    bf16x8 kf[4]; u32x2 va[2][2][2];
#define SB_LOAD(S0, KF, VA) do { _Pragma("unroll") for (int kk = 0; kk < 4; ++kk) KF[kk] = *(const bf16x8*)(Kp + (size_t)(S0) * L1P + 16 * kk); \
        _Pragma("unroll") for (int dt = 0; dt < 2; ++dt) _Pragma("unroll") for (int ks = 0; ks < 2; ++ks) { VA[dt][ks][0] = *(const u32x2*)(Vp + (size_t)dt * 32 * SEQ + (S0) + 16 * ks); VA[dt][ks][1] = *(const u32x2*)(Vp + (size_t)dt * 32 * SEQ + (S0) + 16 * ks + 8); } } while (0)
    SB_LOAD(q0, kf, va);
    for (int s0 = q0; s0 >= 0; s0 -= 32) {
        bf16x8 kn[4]; u32x2 vn[2][2][2];
        const int sn = (s0 >= 32) ? s0 - 32 : 0;
        SB_LOAD(sn, kn, vn);
        f32x16 acc;
#pragma unroll
        for (int r = 0; r < 16; ++r) acc[r] = 0.f;
#pragma unroll
        for (int kk = 0; kk < 4; ++kk) acc = MFMA32(kf[kk], qf[kk], acc);
        const bool diag = (s0 == q0);
        float lb[16], lk[16];
#pragma unroll
        for (int r = 0; r < 16; ++r) { const float z = acc[r] * 0.125f; const float sp = softplus_fast(z); float b_ = z - sp, k_ = -sp;
            if (diag) { const bool valid = (s0 + crow(r, hi)) < t; b_ = valid ? b_ : -1e30f; k_ = valid ? k_ : 0.f; }
            lb[r] = b_; lk[r] = k_; }
        float e[16], T[4], U[4];
#pragma unroll
        for (int i = 0; i < 4; ++i) { e[4 * i + 3] = 0.f; e[4 * i + 2] = lk[4 * i + 3]; e[4 * i + 1] = e[4 * i + 2] + lk[4 * i + 2]; e[4 * i] = e[4 * i + 1] + lk[4 * i + 1]; T[i] = e[4 * i] + lk[4 * i]; }
#pragma unroll
        for (int i = 0; i < 4; ++i) U[i] = __shfl_xor(T[i], 32);
        float off[4];
        { const float st2 = T[3], st1 = st2 + T[2], st0 = st1 + T[1]; const float su2 = U[3], su1 = su2 + U[2], su0 = su1 + U[1];
          const float x0 = hi ? 0.f : U[0], x1 = hi ? 0.f : U[1], x2 = hi ? 0.f : U[2], x3 = hi ? 0.f : U[3];
          off[3] = x3; off[2] = st2 + su2 + x2; off[1] = st1 + su1 + x1; off[0] = st0 + su0 + x0;
          const float total = st0 + T[0] + su0 + U[0];
#pragma unroll
          for (int r = 0; r < 16; ++r) acc[r] = __expf(lb[r] + (cum + off[r >> 2] + e[r]));
          cum += total; }
        bf16x8 pf[2];
#pragma unroll
        for (int ks = 0; ks < 2; ++ks) { v4u w; w.x = cvtpk(acc[8 * ks], acc[8 * ks + 1]); w.y = cvtpk(acc[8 * ks + 2], acc[8 * ks + 3]); w.z = cvtpk(acc[8 * ks + 4], acc[8 * ks + 5]); w.w = cvtpk(acc[8 * ks + 6], acc[8 * ks + 7]); pf[ks] = __builtin_bit_cast(bf16x8, w); }
#pragma unroll
        for (int dt = 0; dt < 2; ++dt)
#pragma unroll
            for (int ks = 0; ks < 2; ++ks) { v4u a; a.x = va[dt][ks][0].x; a.y = va[dt][ks][0].y; a.z = va[dt][ks][1].x; a.w = va[dt][ks][1].y; o[dt] = MFMA32(__builtin_bit_cast(bf16x8, a), pf[ks], o[dt]); }
        if (__all(cum < -110.f)) break;
#pragma unroll
        for (int kk = 0; kk < 4; ++kk) kf[kk] = kn[kk];
#pragma unroll
        for (int dt = 0; dt < 2; ++dt)
#pragma unroll
            for (int ks = 0; ks < 2; ++ks) { va[dt][ks][0] = vn[dt][ks][0]; va[dt][ks][1] = vn[dt][ks][1]; }
    }
#undef SB_LOAD
    store_OT(o, 1.0f, stg, ymix + (rowb + q0) * DM + h * 64, lane);
}
__device__ __forceinline__ void mla_task(int bh, int qblk, int lane, const bf16_t* __restrict__ QM, const bf16_t* __restrict__ KVM, const bf16_t* __restrict__ KPE, const bf16_t* __restrict__ VT,
                                         bf16_t* __restrict__ ymix, LAS bf16_t* stg) {
    const int b = bh >> 3, h = bh & 7, l31 = lane & 31, hi = lane >> 5, q0 = qblk * 32, t = q0 + l31;
    const size_t rowb = (size_t)b * SEQ;
    const bf16_t* Qp = QM + (rowb + q0 + l31) * 768 + h * 96 + 8 * hi;
    bf16x8 qf[6];
#pragma unroll
    for (int kk = 0; kk < 6; ++kk) qf[kk] = *(const bf16x8*)(Qp + 16 * kk);
    const bf16_t* Kn = KVM + (rowb + l31) * 1024 + h * 128 + 8 * hi;
    const bf16_t* Kr = KPE + (rowb + l31) * 32 + 8 * hi;
    const bf16_t* Vp = VT + ((size_t)bh * 64 + l31) * SEQ + 4 * hi;
    const float sc2 = 0.10206207261596577f * 1.4426950408889634f;
    f32x16 o[2];
#pragma unroll
    for (int r = 0; r < 16; ++r) { o[0][r] = 0.f; o[1][r] = 0.f; }
    float mrun = -1e30f, lsum = 0.f;
    bf16x8 kf[6]; u32x2 va[2][2][2];
#define ML_LOAD(S0, KF, VA) do { _Pragma("unroll") for (int kk = 0; kk < 4; ++kk) KF[kk] = *(const bf16x8*)(Kn + (size_t)(S0) * 1024 + 16 * kk); \
        _Pragma("unroll") for (int kk = 0; kk < 2; ++kk) KF[4 + kk] = *(const bf16x8*)(Kr + (size_t)(S0) * 32 + 16 * kk); \
        _Pragma("unroll") for (int dt = 0; dt < 2; ++dt) _Pragma("unroll") for (int ks = 0; ks < 2; ++ks) { VA[dt][ks][0] = *(const u32x2*)(Vp + (size_t)dt * 32 * SEQ + (S0) + 16 * ks); VA[dt][ks][1] = *(const u32x2*)(Vp + (size_t)dt * 32 * SEQ + (S0) + 16 * ks + 8); } } while (0)
    ML_LOAD(0, kf, va);
    for (int s0 = 0; s0 <= q0; s0 += 32) {
        bf16x8 kn[6]; u32x2 vn[2][2][2];
        const int sn = (s0 + 32 <= q0) ? s0 + 32 : s0;
        ML_LOAD(sn, kn, vn);
        f32x16 acc;
#pragma unroll
        for (int r = 0; r < 16; ++r) acc[r] = 0.f;
#pragma unroll
        for (int kk = 0; kk < 6; ++kk) acc = MFMA32(kf[kk], qf[kk], acc);
        const bool diag = (s0 == q0);
        float tmax = -1e30f;
#pragma unroll
        for (int r = 0; r < 16; ++r) { float z = acc[r] * sc2; if (diag && (s0 + crow(r, hi)) > t) z = -1e30f; acc[r] = z; tmax = fmaxf(tmax, z); }
        tmax = fmaxf(tmax, __shfl_xor(tmax, 32));
        const float mn = fmaxf(mrun, tmax), alpha = exp2f(mrun - mn); mrun = mn;
        float ps = 0.f;
#pragma unroll
        for (int r = 0; r < 16; ++r) { acc[r] = exp2f(acc[r] - mn); ps += acc[r]; }
        lsum = lsum * alpha + ps;
#pragma unroll
        for (int r = 0; r < 16; ++r) { o[0][r] *= alpha; o[1][r] *= alpha; }
        bf16x8 pf[2];
#pragma unroll
        for (int ks = 0; ks < 2; ++ks) { v4u w; w.x = cvtpk(acc[8 * ks], acc[8 * ks + 1]); w.y = cvtpk(acc[8 * ks + 2], acc[8 * ks + 3]); w.z = cvtpk(acc[8 * ks + 4], acc[8 * ks + 5]); w.w = cvtpk(acc[8 * ks + 6], acc[8 * ks + 7]); pf[ks] = __builtin_bit_cast(bf16x8, w); }
#pragma unroll
        for (int dt = 0; dt < 2; ++dt)
#pragma unroll
            for (int ks = 0; ks < 2; ++ks) { v4u a; a.x = va[dt][ks][0].x; a.y = va[dt][ks][0].y; a.z = va[dt][ks][1].x; a.w = va[dt][ks][1].y; o[dt] = MFMA32(__builtin_bit_cast(bf16x8, a), pf[ks], o[dt]); }
#pragma unroll
        for (int kk = 0; kk < 6; ++kk) kf[kk] = kn[kk];
#pragma unroll
        for (int dt = 0; dt < 2; ++dt)
#pragma unroll
            for (int ks = 0; ks < 2; ++ks) { va[dt][ks][0] = vn[dt][ks][0]; va[dt][ks][1] = vn[dt][ks][1]; }
    }
#undef ML_LOAD
    lsum += __shfl_xor(lsum, 32);
    store_OT(o, 1.0f / lsum, stg, ymix + (rowb + q0) * DM + 512 + h * 64, lane);
}


__device__ __forceinline__ void sb_wave(int bh, int qblk, int lane, const bf16_t* __restrict__ P1, const bf16_t* __restrict__ VT, bf16_t* __restrict__ ymix, LAS unsigned char* wl) {
    const int b = bh >> 3, h = bh & 7, l31 = lane & 31, hi = lane >> 5, q0 = qblk * 32, t = q0 + l31;
    const size_t rowb = (size_t)b * SEQ;
    bf16x8 qf[4];
    { const bf16_t* Qp = P1 + (rowb + q0 + l31) * L1P + h * 64 + 8 * hi;
#pragma unroll
      for (int kk = 0; kk < 4; ++kk) qf[kk] = *(const bf16x8*)(Qp + 16 * kk); }
    f32x16 o[2];
#pragma unroll
    for (int r = 0; r < 16; ++r) { o[0][r] = 0.f; o[1][r] = 0.f; }
    float cum = 1.f;
    const bf16_t* gK = P1 + (rowb + (lane >> 3)) * L1P + 512 + h * 64 + (lane & 7) * 8;
    const bf16_t* gV = VT + ((size_t)bh * 64 + (lane >> 2)) * SEQ + (lane & 3) * 8;
    const int lK = (lane >> 3) * 144 + (lane & 7) * 16, lV = 4608 + (lane >> 2) * 72 + (lane & 3) * 16;
    v4u rk[4], rv[4];
#pragma unroll
    for (int i = 0; i < 4; ++i) { rk[i] = *(const v4u*)(gK + (size_t)(q0 + 8 * i) * L1P); rv[i] = *(const v4u*)(gV + (size_t)(16 * i) * SEQ + q0); }
#pragma unroll 1
    for (int s0 = q0; s0 >= 0; s0 -= 32) {
#pragma unroll
        for (int i = 0; i < 4; ++i) { *(LAS v4u*)(wl + lK + i * 8 * 144) = rk[i]; *(LAS u32x2*)(wl + lV + i * 16 * 72) = (u32x2){rv[i].x, rv[i].y}; *(LAS u32x2*)(wl + lV + i * 16 * 72 + 8) = (u32x2){rv[i].z, rv[i].w}; }
        { const int sn = (s0 >= 32) ? s0 - 32 : 0;
#pragma unroll
          for (int i = 0; i < 4; ++i) { rk[i] = *(const v4u*)(gK + (size_t)(sn + 8 * i) * L1P); rv[i] = *(const v4u*)(gV + (size_t)(16 * i) * SEQ + sn); } }
        WSYNC();
        f32x16 acc;
#pragma unroll
        for (int r = 0; r < 16; ++r) acc[r] = 0.f;
#pragma unroll
        for (int kk = 0; kk < 4; ++kk) { const bf16x8 kf = *(const LAS bf16x8*)(wl + l31 * 144 + (16 * kk + 8 * hi) * 2); acc = MFMA32(kf, qf[kk], acc); }
        const bool diag = (s0 == q0);
        float bt[16], kp[16];
#pragma unroll
        for (int r = 0; r < 16; ++r) { const float ee = __builtin_amdgcn_exp2f(fminf(acc[r] * (-0.125f * 1.4426950408889634f), 100.f)); const float ri = __builtin_amdgcn_rcpf(1.f + ee);
            float b_ = ri, k_ = ee * ri;
            if (diag) { const bool valid = (s0 + crow(r, hi)) < t; b_ = valid ? b_ : 0.f; k_ = valid ? k_ : 1.f; }
            bt[r] = b_; kp[r] = k_; }
        float e[16], T[4], U[4];
#pragma unroll
        for (int q = 0; q < 4; ++q) { e[4 * q + 3] = 1.f; e[4 * q + 2] = kp[4 * q + 3]; e[4 * q + 1] = e[4 * q + 2] * kp[4 * q + 2]; e[4 * q] = e[4 * q + 1] * kp[4 * q + 1]; T[q] = e[4 * q] * kp[4 * q]; }
#pragma unroll
        for (int q = 0; q < 4; ++q) U[q] = __shfl_xor(T[q], 32);
        { const float st2 = T[3], st1 = st2 * T[2], st0 = st1 * T[1]; const float su2 = U[3], su1 = su2 * U[2], su0 = su1 * U[1];
          const float x0 = hi ? 1.f : U[0], x1 = hi ? 1.f : U[1], x2 = hi ? 1.f : U[2], x3 = hi ? 1.f : U[3];
          const float off[4] = {cum * (st0 * su0 * x0), cum * (st1 * su1 * x1), cum * (st2 * su2 * x2), cum * x3};
#pragma unroll
          for (int r = 0; r < 16; ++r) acc[r] = bt[r] * (off[r >> 2] * e[r]);
          cum *= (st0 * T[0]) * (su0 * U[0]); }
        bf16x8 pf[2];
#pragma unroll
        for (int ks = 0; ks < 2; ++ks) pf[ks] = pack8(acc[8 * ks], acc[8 * ks + 1], acc[8 * ks + 2], acc[8 * ks + 3], acc[8 * ks + 4], acc[8 * ks + 5], acc[8 * ks + 6], acc[8 * ks + 7]);
#pragma unroll
        for (int dt = 0; dt < 2; ++dt)
#pragma unroll
            for (int ks = 0; ks < 2; ++ks) { const LAS unsigned char* vp = wl + 4608 + (32 * dt + l31) * 72 + (16 * ks + 4 * hi) * 2;
                const u32x2 x0 = *(const LAS u32x2*)vp, x1 = *(const LAS u32x2*)(vp + 16);
                v4u a; a.x = x0.x; a.y = x0.y; a.z = x1.x; a.w = x1.y; o[dt] = MFMA32(__builtin_bit_cast(bf16x8, a), pf[ks], o[dt]); }
        WSYNC();
        if (__all(cum < 1e-35f)) break;
    }
    store_OT(o, 1.0f, (LAS bf16_t*)(wl + 9216), ymix + (rowb + q0) * DM + h * 64, lane);
}

constexpr int MLK_PITCH = 104, MLV_PITCH = 68, MLK_BYTES = 64 * MLK_PITCH * 2, MLV_BYTES = 64 * MLV_PITCH * 2, ML_STAGE = MLK_BYTES + MLV_BYTES;
__device__ __forceinline__ void mla_block(int bh, int sb, int tid, int lane, int wave, LAS unsigned char* lds, const bf16_t* __restrict__ QM, const bf16_t* __restrict__ KVM, const bf16_t* __restrict__ KPE,
                                          const bf16_t* __restrict__ VT, bf16_t* __restrict__ ymix, const float* __restrict__ cstab) {
    const int b = bh >> 3, h = bh & 7, l31 = lane & 31, hi = lane >> 5, q0 = 256 * sb + 32 * wave, t = q0 + l31;
    const size_t rowb = (size_t)b * SEQ;
    const int nsteps = 4 * sb + 4;
    bf16x8 qf[6];
    { const bf16_t* Qp = QM + (rowb + q0 + l31) * 768 + h * 96 + 8 * hi;
#pragma unroll
      for (int kk = 0; kk < 6; ++kk) qf[kk] = *(const bf16x8*)(Qp + 16 * kk);
      const float* ct = cstab + (rowb + q0 + l31) * 32 + 8 * hi;
      const f32x4 c0 = *(const f32x4*)ct, c1 = *(const f32x4*)(ct + 4), s0 = *(const f32x4*)(ct + 16), s1 = *(const f32x4*)(ct + 20);
#pragma unroll
      for (int j = 0; j < 8; ++j) { const float cs = j < 4 ? c0[j & 3] : c1[j & 3], sn = j < 4 ? s0[j & 3] : s1[j & 3];
          const float x1 = bf2f((bf16_t)qf[4][j]), x2 = bf2f((bf16_t)qf[5][j]);
          qf[4][j] = (short)bf1(x1 * cs - x2 * sn); qf[5][j] = (short)bf1(x2 * cs + x1 * sn); } }
    const float sc2 = 0.10206207261596577f * 1.4426950408889634f;
    f32x16 o[2];
#pragma unroll
    for (int r = 0; r < 16; ++r) { o[0][r] = 0.f; o[1][r] = 0.f; }
    float mrun = -1e30f, lsum = 0.f;
    const bf16_t* gKn = KVM + (rowb + (tid >> 3)) * 1024 + h * 128 + (tid & 7) * 8;
    const bf16_t* gKr = KPE + (rowb + ((tid & 255) >> 2)) * 32 + (tid & 3) * 8;
    const bf16_t* gVt = VT + ((size_t)bh * 64 + (tid >> 3)) * SEQ + (tid & 7) * 8;
    const int lKn = (tid >> 3) * (MLK_PITCH * 2) + (tid & 7) * 16, lKr = ((tid & 255) >> 2) * (MLK_PITCH * 2) + 128 + (tid & 3) * 16, lVt = MLK_BYTES + (tid >> 3) * (MLV_PITCH * 2) + (tid & 7) * 16;
    v4u rk, rr, rv;
    rk = *(const v4u*)gKn; rr = *(const v4u*)gKr; rv = *(const v4u*)gVt;
    *(LAS v4u*)(lds + lKn) = rk; if (tid < 256) *(LAS v4u*)(lds + lKr) = rr; *(LAS u32x2*)(lds + lVt) = (u32x2){rv.x, rv.y}; *(LAS u32x2*)(lds + lVt + 8) = (u32x2){rv.z, rv.w};
    __syncthreads();
#pragma unroll 1
    for (int step = 0; step < nsteps; ++step) {
        const int nx = (step + 1 < nsteps) ? step + 1 : step;
        rk = *(const v4u*)(gKn + (size_t)nx * 64 * 1024); rr = *(const v4u*)(gKr + (size_t)nx * 64 * 32); rv = *(const v4u*)(gVt + nx * 64);
        const LAS unsigned char* Kb = lds + (step & 1) * ML_STAGE;
        const LAS unsigned char* Vb = Kb + MLK_BYTES;
        if (64 * step <= q0) {
            f32x16 acc[2];
#pragma unroll
            for (int sub = 0; sub < 2; ++sub) {
#pragma unroll
                for (int r = 0; r < 16; ++r) acc[sub][r] = 0.f;
#pragma unroll
                for (int kk = 0; kk < 6; ++kk) { const bf16x8 kf = *(const LAS bf16x8*)(Kb + (32 * sub + l31) * (MLK_PITCH * 2) + (16 * kk + 8 * hi) * 2); acc[sub] = MFMA32(kf, qf[kk], acc[sub]); }
            }
            float tmax = -1e30f;
#pragma unroll
            for (int sub = 0; sub < 2; ++sub) { const int s0 = 64 * step + 32 * sub;
                if (s0 + 31 > q0) {
#pragma unroll
                    for (int r = 0; r < 16; ++r) if ((s0 + crow(r, hi)) > t) acc[sub][r] = -1e30f; }
#pragma unroll
                for (int r = 0; r < 16; ++r) tmax = fmaxf(tmax, acc[sub][r]); }
            tmax = fmaxf(tmax, __shfl_xor(tmax, 32)) * sc2;
            if (__any(tmax - mrun > 6.f)) {
                const float mn = fmaxf(mrun, tmax), alpha = __builtin_amdgcn_exp2f(mrun - mn); mrun = mn; lsum *= alpha;
#pragma unroll
                for (int r = 0; r < 16; ++r) { o[0][r] *= alpha; o[1][r] *= alpha; }
            }
            float ps = 0.f;
#pragma unroll
            for (int sub = 0; sub < 2; ++sub)
#pragma unroll
                for (int r = 0; r < 16; ++r) { acc[sub][r] = __builtin_amdgcn_exp2f(acc[sub][r] * sc2 - mrun); ps += acc[sub][r]; }
            lsum += ps;
#pragma unroll
            for (int sub = 0; sub < 2; ++sub) {
                bf16x8 pf[2];
#pragma unroll
                for (int ks = 0; ks < 2; ++ks) pf[ks] = pack8(acc[sub][8 * ks], acc[sub][8 * ks + 1], acc[sub][8 * ks + 2], acc[sub][8 * ks + 3], acc[sub][8 * ks + 4], acc[sub][8 * ks + 5], acc[sub][8 * ks + 6], acc[sub][8 * ks + 7]);
#pragma unroll
                for (int dt = 0; dt < 2; ++dt)
#pragma unroll
                    for (int ks = 0; ks < 2; ++ks) { const LAS unsigned char* vp = Vb + (32 * dt + l31) * (MLV_PITCH * 2) + (32 * sub + 16 * ks + 4 * hi) * 2;
                        const u32x2 x0 = *(const LAS u32x2*)vp, x1 = *(const LAS u32x2*)(vp + 16);
                        v4u a; a.x = x0.x; a.y = x0.y; a.z = x1.x; a.w = x1.y; o[dt] = MFMA32(__builtin_bit_cast(bf16x8, a), pf[ks], o[dt]); }
            }
        }
        LAS unsigned char* nb = lds + ((step + 1) & 1) * ML_STAGE;
        *(LAS v4u*)(nb + lKn) = rk; if (tid < 256) *(LAS v4u*)(nb + lKr) = rr; *(LAS u32x2*)(nb + lVt) = (u32x2){rv.x, rv.y}; *(LAS u32x2*)(nb + lVt + 8) = (u32x2){rv.z, rv.w};
        __syncthreads();
    }
    lsum += __shfl_xor(lsum, 32);
    store_OT(o, 1.0f / lsum, (LAS bf16_t*)(lds + 2 * ML_STAGE) + wave * (32 * STG_PITCH), ymix + (rowb + q0) * DM + 512 + h * 64, lane);
    __syncthreads();
}


constexpr int SBK_PITCH = 72, SBK_BYTES = 64 * SBK_PITCH * 2, SB_STAGE = SBK_BYTES + MLV_BYTES;
__device__ __forceinline__ void sb_block(int bh, int sb, int tid, int lane, int wave, LAS unsigned char* lds, const bf16_t* __restrict__ P1, const bf16_t* __restrict__ VT, bf16_t* __restrict__ ymix) {
    const int b = bh >> 3, h = bh & 7, l31 = lane & 31, hi = lane >> 5, q0 = 256 * sb + 32 * wave, t = q0 + l31;
    const size_t rowb = (size_t)b * SEQ;
    bf16x8 qf[4];
    { const bf16_t* Qp = P1 + (rowb + q0 + l31) * L1P + h * 64 + 8 * hi;
#pragma unroll
      for (int kk = 0; kk < 4; ++kk) qf[kk] = *(const bf16x8*)(Qp + 16 * kk); }
    f32x16 o[2];
#pragma unroll
    for (int r = 0; r < 16; ++r) { o[0][r] = 0.f; o[1][r] = 0.f; }
    float cum = 1.f; bool done = false;
    volatile LAS unsigned* flags = (volatile LAS unsigned*)(lds + 2 * SB_STAGE);
    const bf16_t* gK = P1 + (rowb + (tid >> 3)) * L1P + 512 + h * 64 + (tid & 7) * 8;
    const bf16_t* gVt = VT + ((size_t)bh * 64 + (tid >> 3)) * SEQ + (tid & 7) * 8;
    const int lK = (tid >> 3) * (SBK_PITCH * 2) + (tid & 7) * 16, lVt = SBK_BYTES + (tid >> 3) * (MLV_PITCH * 2) + (tid & 7) * 16;
    const int top = 4 * sb + 3;
    v4u rk, rv;
    rk = *(const v4u*)(gK + (size_t)top * 64 * L1P); rv = *(const v4u*)(gVt + top * 64);
    *(LAS v4u*)(lds + lK) = rk; *(LAS u32x2*)(lds + lVt) = (u32x2){rv.x, rv.y}; *(LAS u32x2*)(lds + lVt + 8) = (u32x2){rv.z, rv.w};
    __syncthreads();
#pragma unroll 1
    for (int i = 0; i <= top; ++i) {
        const int step = top - i, nx = (step > 0) ? step - 1 : 0;
        rk = *(const v4u*)(gK + (size_t)nx * 64 * L1P); rv = *(const v4u*)(gVt + nx * 64);
        const LAS unsigned char* Kb = lds + (i & 1) * SB_STAGE;
        const LAS unsigned char* Vb = Kb + SBK_BYTES;
#pragma unroll
        for (int sub = 1; sub >= 0; --sub) {
            const int s0 = 64 * step + 32 * sub;
            if (s0 <= q0 && !done) {
                f32x16 acc;
#pragma unroll
                for (int r = 0; r < 16; ++r) acc[r] = 0.f;
#pragma unroll
                for (int kk = 0; kk < 4; ++kk) { const bf16x8 kf = *(const LAS bf16x8*)(Kb + (32 * sub + l31) * (SBK_PITCH * 2) + (16 * kk + 8 * hi) * 2); acc = MFMA32(kf, qf[kk], acc); }
                const bool diag = (s0 == q0);
                float bt[16], kp[16];
#pragma unroll
                for (int r = 0; r < 16; ++r) { const float ee = __builtin_amdgcn_exp2f(fminf(acc[r] * (-0.125f * 1.4426950408889634f), 100.f)); const float ri = __builtin_amdgcn_rcpf(1.f + ee);
                    float b_ = ri, k_ = ee * ri;
                    if (diag) { const bool valid = (s0 + crow(r, hi)) < t; b_ = valid ? b_ : 0.f; k_ = valid ? k_ : 1.f; }
                    bt[r] = b_; kp[r] = k_; }
                float e[16], T[4], U[4];
#pragma unroll
                for (int q = 0; q < 4; ++q) { e[4 * q + 3] = 1.f; e[4 * q + 2] = kp[4 * q + 3]; e[4 * q + 1] = e[4 * q + 2] * kp[4 * q + 2]; e[4 * q] = e[4 * q + 1] * kp[4 * q + 1]; T[q] = e[4 * q] * kp[4 * q]; }
#pragma unroll
                for (int q = 0; q < 4; ++q) U[q] = __shfl_xor(T[q], 32);
                { const float st2 = T[3], st1 = st2 * T[2], st0 = st1 * T[1]; const float su2 = U[3], su1 = su2 * U[2], su0 = su1 * U[1];
                  const float x0 = hi ? 1.f : U[0], x1 = hi ? 1.f : U[1], x2 = hi ? 1.f : U[2], x3 = hi ? 1.f : U[3];
                  const float off[4] = {cum * (st0 * su0 * x0), cum * (st1 * su1 * x1), cum * (st2 * su2 * x2), cum * x3};
#pragma unroll
                  for (int r = 0; r < 16; ++r) acc[r] = bt[r] * (off[r >> 2] * e[r]);
                  cum *= (st0 * T[0]) * (su0 * U[0]); }
                bf16x8 pf[2];
#pragma unroll
                for (int ks = 0; ks < 2; ++ks) { v4u w; w.x = cvtpk(acc[8 * ks], acc[8 * ks + 1]); w.y = cvtpk(acc[8 * ks + 2], acc[8 * ks + 3]); w.z = cvtpk(acc[8 * ks + 4], acc[8 * ks + 5]); w.w = cvtpk(acc[8 * ks + 6], acc[8 * ks + 7]); pf[ks] = __builtin_bit_cast(bf16x8, w); }
#pragma unroll
                for (int dt = 0; dt < 2; ++dt)
#pragma unroll
                    for (int ks = 0; ks < 2; ++ks) { const LAS unsigned char* vp = Vb + (32 * dt + l31) * (MLV_PITCH * 2) + (32 * sub + 16 * ks + 4 * hi) * 2;
                        const u32x2 x0 = *(const LAS u32x2*)vp, x1 = *(const LAS u32x2*)(vp + 16);
                        v4u a; a.x = x0.x; a.y = x0.y; a.z = x1.x; a.w = x1.y; o[dt] = MFMA32(__builtin_bit_cast(bf16x8, a), pf[ks], o[dt]); }
                done = __all(cum < 1e-35f);
            }
        }
        if (lane == 0) flags[(i & 1) * 8 + wave] = done ? 1u : 0u;
        LAS unsigned char* nb = lds + ((i + 1) & 1) * SB_STAGE;
        *(LAS v4u*)(nb + lK) = rk; *(LAS u32x2*)(nb + lVt) = (u32x2){rv.x, rv.y}; *(LAS u32x2*)(nb + lVt + 8) = (u32x2){rv.z, rv.w};
        __syncthreads();
        unsigned nd = 0;
#pragma unroll
        for (int w8 = 0; w8 < 8; ++w8) nd += flags[(i & 1) * 8 + w8];
        if (nd == 8u) break;
    }
    store_OT(o, 1.0f, (LAS bf16_t*)(lds + 2 * SB_STAGE + 256) + wave * (32 * STG_PITCH), ymix + (rowb + q0) * DM + h * 64, lane);
    __syncthreads();
}

constexpr int RW_RAWW = 0, RW_RAWA = 2048, RW_RS = 4096, RW_KS = 6144, RW_VS = 8192;
constexpr int RW_CH0 = 10240, RW_CHSZ = 11328;
constexpr int RW_YB = RW_CH0 + 2 * RW_CHSZ;
constexpr int RW_MIX = RW_YB + 1024;
static_assert((RW_MIX + 256) * 4 <= 146432, "rwkv LDS map");
__device__ __forceinline__ float tanh_fast(float x) { return 1.f - 2.f * __builtin_amdgcn_rcpf(1.f + __expf(2.f * x)); }
__device__ __forceinline__ float sigmoid_fast(float x) { return __builtin_amdgcn_rcpf(1.f + __expf(-x)); }

#define MFMA16(a, b, c) __builtin_amdgcn_mfma_f32_16x16x32_bf16((a), (b), (c), 0, 0, 0)
constexpr int RW2_CH0 = 0, RW2_YB = 2 * RW_CHSZ, RW2_MIX = RW2_YB + 1024, RW2_STG = RW2_MIX + 448;
static_assert((RW2_STG + 2 * 3072) * 4 <= 146432, "rwkv LDS map");
__device__ __forceinline__ void rwkv_phase_scan(LAS float* sm, int tid, int lane, int wave, int blk, const bf16_t* __restrict__ proj, const float* __restrict__ mix, const float* __restrict__ w0, const float* __restrict__ a0,
                                           const float* __restrict__ k_k, const float* __restrict__ k_a, const float* __restrict__ r_k, const bf16_t* __restrict__ W2T, const bf16_t* __restrict__ A2T, const bf16_t* __restrict__ G2T,
                                           float* __restrict__ yraw, bf16_t* __restrict__ gout, float* __restrict__ bonus_out) {
    const int chain = blk >> 1, half = blk & 1, b = chain >> 3, h = chain & 7, l15 = lane & 15, kg = lane >> 4;
    const size_t rowb = (size_t)b * SEQ;
    constexpr int NCHUNK = SEQ / 32;
    if (tid < 256) sm[RW2_MIX + tid] = mix[1536 + tid];
    else if (tid < 448) { const int q = tid - 256; sm[RW2_MIX + tid] = mix[512 * (q >> 6) + h * 64 + (q & 63)]; }
    __syncthreads();
#define RW_SH8(CUR, PRV, M0, M1, OUT, PZ) do { const unsigned cu_[4] = {(CUR).x, (CUR).y, (CUR).z, (CUR).w}, pu_[4] = {(PRV).x, (PRV).y, (PRV).z, (PRV).w}; \
        const float mm_[8] = {(M0)[0], (M0)[1], (M0)[2], (M0)[3], (M1)[0], (M1)[1], (M1)[2], (M1)[3]}; \
        _Pragma("unroll") for (int q = 0; q < 4; ++q) { const float c0 = bflo(cu_[q]), c1 = bfhi(cu_[q]), p0 = bflo(pu_[q]) * (PZ), p1 = bfhi(pu_[q]) * (PZ); \
            OUT[2 * q] = c0 + (p0 - c0) * mm_[2 * q]; OUT[2 * q + 1] = c1 + (p1 - c1) * mm_[2 * q + 1]; } } while (0)
    if (wave < 4) {
        const int iA = 8 * wave + kg, iB = iA + 4, jseg = l15;
        float A0 = 0.f, A1 = 0.f, A2 = 0.f, A3 = 0.f, B0 = 0.f, B1 = 0.f, B2 = 0.f, B3 = 0.f;
        __syncthreads();
#pragma unroll 1
        for (int ch = 0; ch < NCHUNK; ++ch) {
            const int t0 = ch * 32;
            const LAS float* CHb = sm + RW2_CH0 + (ch & 1) * RW_CHSZ + 4 * jseg;
            const LAS float* CHv = sm + RW2_CH0 + (ch & 1) * RW_CHSZ + 10240 + iA;
            const LAS float* CHs = sm + RW2_CH0 + (ch & 1) * RW_CHSZ + 11264;
            f32x4 a4 = *(const LAS f32x4*)(CHb + 4096), wr4 = *(const LAS f32x4*)(CHb + 8192), w4 = *(const LAS f32x4*)(CHb), b4 = *(const LAS f32x4*)(CHb + 6144), k4 = *(const LAS f32x4*)(CHb + 2048);
            float vA = CHv[0], vB = CHv[4]; f32x2_t sc = *(const LAS f32x2_t*)(CHs);
#pragma unroll 2
            for (int t = 0; t < 32; ++t) {
                const int tq = (t + 1) & 31;
                const f32x4 a4n = *(const LAS f32x4*)(CHb + 4096 + tq * 64), wr4n = *(const LAS f32x4*)(CHb + 8192 + tq * 64), w4n = *(const LAS f32x4*)(CHb + tq * 64),
                            b4n = *(const LAS f32x4*)(CHb + 6144 + tq * 64), k4n = *(const LAS f32x4*)(CHb + 2048 + tq * 64);
                const float vAn = CHv[tq * 32], vBn = CHv[tq * 32 + 4]; const f32x2_t scn = *(const LAS f32x2_t*)(CHs + 2 * tq);
                float d1A = (A0 * a4[0] + A1 * a4[1]) + (A2 * a4[2] + A3 * a4[3]), d1B = (B0 * a4[0] + B1 * a4[1]) + (B2 * a4[2] + B3 * a4[3]);
                float d2A = (A0 * wr4[0] + A1 * wr4[1]) + (A2 * wr4[2] + A3 * wr4[3]), d2B = (B0 * wr4[0] + B1 * wr4[1]) + (B2 * wr4[2] + B3 * wr4[3]);
                d1A = rowsum16(d1A); d1B = rowsum16(d1B); d2A = rowsum16(d2A); d2B = rowsum16(d2B);
                const float yA = d2A + d1A * sc[0] + vA * sc[1], yB = d2B + d1B * sc[0] + vB * sc[1];
                A0 = A0 * w4[0] + (d1A * b4[0] + vA * k4[0]); A1 = A1 * w4[1] + (d1A * b4[1] + vA * k4[1]); A2 = A2 * w4[2] + (d1A * b4[2] + vA * k4[2]); A3 = A3 * w4[3] + (d1A * b4[3] + vA * k4[3]);
                B0 = B0 * w4[0] + (d1B * b4[0] + vB * k4[0]); B1 = B1 * w4[1] + (d1B * b4[1] + vB * k4[1]); B2 = B2 * w4[2] + (d1B * b4[2] + vB * k4[2]); B3 = B3 * w4[3] + (d1B * b4[3] + vB * k4[3]);
                if (jseg == 0) { sm[RW2_YB + t * 32 + iA] = yA; sm[RW2_YB + t * 32 + iB] = yB; }
                a4 = a4n; wr4 = wr4n; w4 = w4n; b4 = b4n; k4 = k4n; vA = vAn; vB = vBn; sc = scn;
            }
            WSYNC();
            { const int tt = lane >> 1, hh = lane & 1; const f32x4 yv = *(const LAS f32x4*)(sm + RW2_YB + tt * 32 + 8 * wave + 4 * hh);
              *(f32x4*)(yraw + (rowb + t0 + tt) * 512 + h * 64 + half * 32 + 8 * wave + 4 * hh) = yv; }
            __syncthreads();
        }
    } else if (wave < 6) {
        const int tp = wave - 4, tb = 16 * tp;
        LAS float* stg = sm + RW2_STG + tp * 3072;
        float w0c[4], a0c[4], kkc[4], kac[4], rkc[4];
#pragma unroll
        for (int nt = 0; nt < 4; ++nt) { const int c = h * 64 + 16 * nt + l15; w0c[nt] = w0[c]; a0c[nt] = a0[c]; kkc[nt] = k_k[c]; kac[nt] = k_a[c]; rkc[nt] = r_k[c]; }
        v4u ld[20];
#define PREP_ISSUE(T0) do { const int t0_ = (T0); { const size_t r_ = rowb + t0_ + tb + l15; const size_t rp_ = (t0_ + tb + l15 == 0) ? r_ : r_ - 1; \
            _Pragma("unroll") for (int lo = 0; lo < 2; ++lo) _Pragma("unroll") for (int ks = 0; ks < 2; ++ks) { const int col = 1536 + 64 * lo + 32 * ks + 8 * kg; \
                ld[(lo * 2 + ks) * 2] = *(const v4u*)(proj + r_ * L0P + col); ld[(lo * 2 + ks) * 2 + 1] = *(const v4u*)(proj + rp_ * L0P + col); } } \
            _Pragma("unroll") for (int ar = 0; ar < 3; ++ar) _Pragma("unroll") for (int i = 0; i < 2; ++i) { const int p_ = lane + 64 * i, row_ = p_ >> 3, c8_ = p_ & 7; \
                const size_t r_ = rowb + t0_ + tb + row_; const size_t rp_ = (t0_ + tb + row_ == 0) ? r_ : r_ - 1; const int col = 512 * ar + h * 64 + 8 * c8_; \
                ld[8 + (ar * 2 + i) * 2] = *(const v4u*)(proj + r_ * L0P + col); ld[8 + (ar * 2 + i) * 2 + 1] = *(const v4u*)(proj + rp_ * L0P + col); } } while (0)
#define PREP_BUILD(T0, NB) do { const int t0_ = (T0); LAS float* CHn = sm + RW2_CH0 + (NB) * RW_CHSZ; \
            f32x4 accw[4], acca[4]; \
            _Pragma("unroll") for (int nt = 0; nt < 4; ++nt) { accw[nt] = (f32x4){0.f, 0.f, 0.f, 0.f}; acca[nt] = (f32x4){0.f, 0.f, 0.f, 0.f}; } \
            { const float pz_ = (t0_ + tb + l15 == 0) ? 0.f : 1.f; \
              _Pragma("unroll") for (int lo = 0; lo < 2; ++lo) _Pragma("unroll") for (int ks = 0; ks < 2; ++ks) { float s_[8]; \
                const f32x4 m0 = *(const LAS f32x4*)(sm + RW2_MIX + 64 * lo + 32 * ks + 8 * kg), m1 = *(const LAS f32x4*)(sm + RW2_MIX + 64 * lo + 32 * ks + 8 * kg + 4); \
                RW_SH8(ld[(lo * 2 + ks) * 2], ld[(lo * 2 + ks) * 2 + 1], m0, m1, s_, pz_); \
                if (lo == 0) { _Pragma("unroll") for (int j = 0; j < 8; ++j) s_[j] = tanh_fast(s_[j]); } \
                v4u aw; aw.x = cvtpk(s_[0], s_[1]); aw.y = cvtpk(s_[2], s_[3]); aw.z = cvtpk(s_[4], s_[5]); aw.w = cvtpk(s_[6], s_[7]); const bf16x8 af = __builtin_bit_cast(bf16x8, aw); \
                const bf16_t* WT = lo ? A2T : W2T; \
                _Pragma("unroll") for (int nt = 0; nt < 4; ++nt) { const bf16x8 bfr = *(const bf16x8*)(WT + (size_t)(h * 64 + 16 * nt + l15) * 64 + 32 * ks + 8 * kg); \
                    if (lo == 0) accw[nt] = MFMA16(af, bfr, accw[nt]); else acca[nt] = MFMA16(af, bfr, acca[nt]); } } } \
            _Pragma("unroll") for (int ar = 0; ar < 3; ++ar) _Pragma("unroll") for (int i = 0; i < 2; ++i) { const int p_ = lane + 64 * i, row_ = p_ >> 3, c8_ = p_ & 7; float s_[8]; \
                const float pz_ = (t0_ + tb + row_ == 0) ? 0.f : 1.f; const f32x4 m0 = *(const LAS f32x4*)(sm + RW2_MIX + 256 + ar * 64 + c8_ * 8), m1 = *(const LAS f32x4*)(sm + RW2_MIX + 256 + ar * 64 + c8_ * 8 + 4); \
                RW_SH8(ld[8 + (ar * 2 + i) * 2], ld[8 + (ar * 2 + i) * 2 + 1], m0, m1, s_, pz_); \
                *(LAS f32x4*)(stg + ar * 1024 + row_ * 64 + c8_ * 8) = (f32x4){s_[0], s_[1], s_[2], s_[3]}; *(LAS f32x4*)(stg + ar * 1024 + row_ * 64 + c8_ * 8 + 4) = (f32x4){s_[4], s_[5], s_[6], s_[7]}; } \
            WSYNC(); \
            PREP_ISSUE(((T0) + 32 < SEQ) ? (T0) + 32 : (T0)); \
            _Pragma("unroll") for (int rg = 0; rg < 4; ++rg) { const int tl = 4 * kg + rg, t = tb + tl; \
                float r_[4], k_[4], v_[4], kkv[4], nrm2 = 0.f; \
                _Pragma("unroll") for (int nt = 0; nt < 4; ++nt) { r_[nt] = stg[tl * 64 + 16 * nt + l15]; k_[nt] = stg[1024 + tl * 64 + 16 * nt + l15]; v_[nt] = stg[2048 + tl * 64 + 16 * nt + l15]; \
                    kkv[nt] = k_[nt] * kkc[nt]; nrm2 += kkv[nt] * kkv[nt]; } \
                nrm2 = rowsum16(nrm2); const float rn = __builtin_amdgcn_rsqf(fmaxf(nrm2, 1e-24f)); \
                float br = 0.f, kr = 0.f, bon = 0.f; \
                _Pragma("unroll") for (int nt = 0; nt < 4; ++nt) { const int j = 16 * nt + l15; \
                    const float wsum = w0c[nt] + accw[nt][rg]; const float logw = -softplus_fast(-wsum) - 0.5f; const float dec = __expf(-__expf(logw)); \
                    const float a_ = sigmoid_fast(a0c[nt] + acca[nt][rg]); const float kn = kkv[nt] * rn; \
                    const float k2 = k_[nt] * (1.f + (a_ - 1.f) * kac[nt]); const float bv = kn * a_; \
                    br += bv * r_[nt]; kr += k2 * r_[nt]; bon += r_[nt] * k2 * rkc[nt]; \
                    CHn[t * 64 + j] = dec; CHn[2048 + t * 64 + j] = k2; CHn[4096 + t * 64 + j] = -kn; CHn[6144 + t * 64 + j] = bv; CHn[8192 + t * 64 + j] = dec * r_[nt]; \
                    if ((nt >> 1) == half) CHn[10240 + t * 32 + (j & 31)] = v_[nt]; } \
                br = rowsum16(br); kr = rowsum16(kr); bon = rowsum16(bon); \
                if (l15 == 0) { CHn[11264 + 2 * t] = br; CHn[11264 + 2 * t + 1] = kr; if (half == 0) bonus_out[(rowb + t0_ + t) * 8 + h] = bon; } } \
            WSYNC(); } while (0)
        PREP_ISSUE(0);
        PREP_BUILD(0, 0);
        __syncthreads();
#pragma unroll 1
        for (int ch = 0; ch < NCHUNK; ++ch) {
            if (ch + 1 < NCHUNK) PREP_BUILD(ch * 32 + 32, (ch + 1) & 1);
            __syncthreads();
        }
#undef PREP_ISSUE
#undef PREP_BUILD
    } else {
        const int tp = wave - 6, tb = 16 * tp;
        v4u ld[8];
#define G_ISSUE(T0) do { const int t0_ = (T0); const size_t r_ = rowb + t0_ + tb + l15; const size_t rp_ = (t0_ + tb + l15 == 0) ? r_ : r_ - 1; \
            _Pragma("unroll") for (int ks = 0; ks < 4; ++ks) { const int col = 1664 + 32 * ks + 8 * kg; ld[2 * ks] = *(const v4u*)(proj + r_ * L0P + col); ld[2 * ks + 1] = *(const v4u*)(proj + rp_ * L0P + col); } } while (0)
#define G_BUILD(T0) do { const int t0_ = (T0); f32x4 accg[2] = {(f32x4){0.f, 0.f, 0.f, 0.f}, (f32x4){0.f, 0.f, 0.f, 0.f}}; const float pz_ = (t0_ + tb + l15 == 0) ? 0.f : 1.f; \
            _Pragma("unroll") for (int ks = 0; ks < 4; ++ks) { float s_[8]; \
                const f32x4 m0 = *(const LAS f32x4*)(sm + RW2_MIX + 128 + 32 * ks + 8 * kg), m1 = *(const LAS f32x4*)(sm + RW2_MIX + 128 + 32 * ks + 8 * kg + 4); \
                RW_SH8(ld[2 * ks], ld[2 * ks + 1], m0, m1, s_, pz_); \
                _Pragma("unroll") for (int j = 0; j < 8; ++j) s_[j] = sigmoid_fast(s_[j]); \
                v4u aw; aw.x = cvtpk(s_[0], s_[1]); aw.y = cvtpk(s_[2], s_[3]); aw.z = cvtpk(s_[4], s_[5]); aw.w = cvtpk(s_[6], s_[7]); const bf16x8 af = __builtin_bit_cast(bf16x8, aw); \
                _Pragma("unroll") for (int nt = 0; nt < 2; ++nt) { const bf16x8 bfr = *(const bf16x8*)(G2T + (size_t)(h * 64 + half * 32 + 16 * nt + l15) * 128 + 32 * ks + 8 * kg); accg[nt] = MFMA16(af, bfr, accg[nt]); } } \
            G_ISSUE(((T0) + 32 < SEQ) ? (T0) + 32 : (T0)); \
            _Pragma("unroll") for (int nt = 0; nt < 2; ++nt) _Pragma("unroll") for (int rg = 0; rg < 4; ++rg) \
                gout[(rowb + t0_ + tb + 4 * kg + rg) * 512 + h * 64 + half * 32 + 16 * nt + l15] = (bf16_t)f2bf(accg[nt][rg]); } while (0)
        G_ISSUE(0);
        G_BUILD(0);
        __syncthreads();
#pragma unroll 1
        for (int ch = 0; ch < NCHUNK; ++ch) {
            if (ch + 1 < NCHUNK) G_BUILD(ch * 32 + 32);
            __syncthreads();
        }
#undef G_ISSUE
#undef G_BUILD
    }
#undef RW_SH8
    __syncthreads();
}

constexpr int CK_BK = 0, CK_AR = 4608, CK_BBT = 9216, CK_KBT = 12288, CK_VT = 15360, CK_GC = 16896, CK_TT = 17152, CK_SLOT = 18688, CK_NSLOT = 6, CK_NBUILD = 5;
constexpr int CK_STG = CK_SLOT * CK_NSLOT;
constexpr int CK_MIX = CK_STG + CK_NBUILD * 6144;
constexpr int CK_FLAGS = CK_MIX + 448 * 4;
static_assert(CK_FLAGS + 64 <= 146432, "rwkv chunked LDS map");
__device__ __forceinline__ void rwkv_phase(LAS float* smf, int tid, int lane, int wave, int blk, const bf16_t* __restrict__ proj, const float* __restrict__ mix, const float* __restrict__ w0, const float* __restrict__ a0,
                                           const float* __restrict__ k_k, const float* __restrict__ k_a, const float* __restrict__ r_k, const bf16_t* __restrict__ W2T, const bf16_t* __restrict__ A2T, const bf16_t* __restrict__ G2T,
                                           float* __restrict__ yraw, bf16_t* __restrict__ gout, float* __restrict__ bonus_out) {
    LAS unsigned char* lds = (LAS unsigned char*)smf;
    LAS float* mixs = (LAS float*)(lds + CK_MIX);
    volatile LAS unsigned* flags = (volatile LAS unsigned*)(lds + CK_FLAGS);
    const int chain = blk >> 1, ihalf = blk & 1, b = chain >> 3, h = chain & 7, l15 = lane & 15, kg = lane >> 4, l31 = lane & 31, hi = lane >> 5;
    const size_t rowb = (size_t)b * SEQ;
    constexpr int NCH = SEQ / 16;
    if (tid < 256) mixs[tid] = mix[1536 + tid];
    else if (tid < 448) { const int q = tid - 256; mixs[tid] = mix[512 * (q >> 6) + h * 64 + (q & 63)]; }
    if (tid < 16) flags[tid] = (tid == 9) ? (unsigned)CK_NBUILD : 0u;
    for (int q = tid; q < CK_NSLOT * 384; q += NWAVES * 64) *(LAS unsigned*)(lds + (q / 384) * CK_SLOT + CK_TT + (q % 384) * 4) = 0u;
    __syncthreads();
#define RW_SH8(CUR, PRV, M0, M1, OUT, PZ) do { const unsigned cu_[4] = {(CUR).x, (CUR).y, (CUR).z, (CUR).w}, pu_[4] = {(PRV).x, (PRV).y, (PRV).z, (PRV).w}; \
        const float mm_[8] = {(M0)[0], (M0)[1], (M0)[2], (M0)[3], (M1)[0], (M1)[1], (M1)[2], (M1)[3]}; \
        _Pragma("unroll") for (int q = 0; q < 4; ++q) { const float c0 = bflo(cu_[q]), c1 = bfhi(cu_[q]), p0 = bflo(pu_[q]) * (PZ), p1 = bfhi(pu_[q]) * (PZ); \
            OUT[2 * q] = c0 + (p0 - c0) * mm_[2 * q]; OUT[2 * q + 1] = c1 + (p1 - c1) * mm_[2 * q + 1]; } } while (0)
    if (wave == 0) {
        f32x16 ST[2];
#pragma unroll
        for (int r = 0; r < 16; ++r) { ST[0][r] = 0.f; ST[1][r] = 0.f; }
#pragma unroll 1
        for (int k = 0; k < NCH; ++k) {
#if defined(PROBE_STAMPS)
            const unsigned tw0_ = (unsigned)__builtin_amdgcn_s_memrealtime();
#endif
            { const unsigned want = (unsigned)(k + 1); const int sl = k % CK_NSLOT; while (flags[sl] != want) __builtin_amdgcn_s_sleep(1); }
#if defined(PROBE_STAMPS)
            if (blk == 0 && lane == 0) ((volatile LAS unsigned*)(lds + 146432 + 320))[16 + 24] += (unsigned)__builtin_amdgcn_s_memrealtime() - tw0_;
#endif
            asm volatile("" ::: "memory");
            const LAS unsigned char* im = lds + (k % CK_NSLOT) * CK_SLOT;
            f32x16 G;
#pragma unroll
            for (int r = 0; r < 16; ++r) G[r] = 0.f;
#pragma unroll
            for (int kk = 0; kk < 4; ++kk) { const bf16x8 fa = *(const LAS bf16x8*)(im + CK_BK + l31 * 144 + (16 * kk + 8 * hi) * 2), fb = *(const LAS bf16x8*)(im + CK_AR + l31 * 144 + (16 * kk + 8 * hi) * 2); G = MFMA32(fa, fb, G); }
            { const int tcol = l31 & 15; const bool strict = l31 < 16;
#pragma unroll
              for (int r = 0; r < 16; ++r) { const int srow = crow(r & 7, hi); const bool keep = strict ? (srow < tcol) : (srow <= tcol); G[r] = keep ? G[r] : 0.f; } }
            const bf16x8 gB = pack8(G[0], G[1], G[2], G[3], G[4], G[5], G[6], G[7]), gK = pack8(G[8], G[9], G[10], G[11], G[12], G[13], G[14], G[15]);
            f32x16 XT;
#pragma unroll
            for (int r = 0; r < 16; ++r) XT[r] = 0.f;
#pragma unroll
            for (int jt = 0; jt < 2; ++jt)
#pragma unroll
                for (int sp = 0; sp < 2; ++sp) { const LAS unsigned char* ap = im + CK_AR + l31 * 144 + (32 * jt + 16 * sp + 4 * hi) * 2;
                    const u32x2 x0 = *(const LAS u32x2*)ap, x1 = *(const LAS u32x2*)(ap + 16); v4u aw; aw.x = x0.x; aw.y = x0.y; aw.z = x1.x; aw.w = x1.y;
                    const bf16x8 sb_ = pack8(ST[jt][8 * sp], ST[jt][8 * sp + 1], ST[jt][8 * sp + 2], ST[jt][8 * sp + 3], ST[jt][8 * sp + 4], ST[jt][8 * sp + 5], ST[jt][8 * sp + 6], ST[jt][8 * sp + 7]);
                    XT = MFMA32(__builtin_bit_cast(bf16x8, aw), sb_, XT); }
            bf16x8 vP;
            { const LAS unsigned char* vp = im + CK_VT + l31 * 48 + (4 * hi) * 2; const u32x2 x0 = *(const LAS u32x2*)vp, x1 = *(const LAS u32x2*)(vp + 16); v4u vw; vw.x = x0.x; vw.y = x0.y; vw.z = x1.x; vw.w = x1.y;
              vP = __builtin_bit_cast(bf16x8, vw); XT = MFMA32(gK, vP, XT); }
            bf16x8 uP;
            { const LAS unsigned char* tp = im + CK_TT + l31 * 48 + (4 * hi) * 2; const u32x2 x0 = *(const LAS u32x2*)tp, x1 = *(const LAS u32x2*)(tp + 16); v4u tw; tw.x = x0.x; tw.y = x0.y; tw.z = x1.x; tw.w = x1.y;
              f32x16 UT;
#pragma unroll
              for (int r = 0; r < 16; ++r) UT[r] = 0.f;
              UT = MFMA32(__builtin_bit_cast(bf16x8, tw), pack8(XT[0], XT[1], XT[2], XT[3], XT[4], XT[5], XT[6], XT[7]), UT);
              uP = pack8(UT[0], UT[1], UT[2], UT[3], UT[4], UT[5], UT[6], UT[7]); }
            XT = MFMA32(gB, uP, XT);
            { float* yp = yraw + (rowb + 16 * k) * 512 + h * 64 + 32 * ihalf + l31;
#pragma unroll
              for (int q = 0; q < 8; ++q) yp[(size_t)crow(q, hi) * 512] = XT[8 + q]; }
            { const LAS float* gc = (const LAS float*)(im + CK_GC);
#pragma unroll
              for (int jt = 0; jt < 2; ++jt)
#pragma unroll
                  for (int r = 0; r < 16; ++r) ST[jt][r] *= gc[32 * jt + crow(r, hi)]; }
#pragma unroll
            for (int jt = 0; jt < 2; ++jt) { const LAS unsigned char* bp = im + CK_BBT + (32 * jt + l31) * 48 + (4 * hi) * 2; const LAS unsigned char* kp = im + CK_KBT + (32 * jt + l31) * 48 + (4 * hi) * 2;
                const u32x2 b0 = *(const LAS u32x2*)bp, b1 = *(const LAS u32x2*)(bp + 16), k0 = *(const LAS u32x2*)kp, k1 = *(const LAS u32x2*)(kp + 16);
                v4u a1; a1.x = b0.x; a1.y = b0.y; a1.z = b1.x; a1.w = b1.y; v4u a2; a2.x = k0.x; a2.y = k0.y; a2.z = k1.x; a2.w = k1.y;
                ST[jt] = MFMA32(__builtin_bit_cast(bf16x8, a1), uP, ST[jt]); ST[jt] = MFMA32(__builtin_bit_cast(bf16x8, a2), vP, ST[jt]); }
            WSYNC();
            if (lane == 0) flags[8] = (unsigned)(k + 1);
        }
    } else if (wave <= CK_NBUILD) {
        const int pw = wave - 1;
        LAS bf16_t* stg = (LAS bf16_t*)(lds + CK_STG) + pw * 3072;
        float w0c[4], a0c[4], kkc[4], kac[4], rkc[4];
#pragma unroll
        for (int nt = 0; nt < 4; ++nt) { const int c = h * 64 + 16 * nt + l15; w0c[nt] = w0[c]; a0c[nt] = a0[c]; kkc[nt] = k_k[c]; kac[nt] = k_a[c]; rkc[nt] = r_k[c]; }
        v4u ld[20];
#define CK_ISSUE_A(T0) do { const int t0_ = (T0); const size_t r_ = rowb + t0_ + l15; const size_t rp_ = (t0_ + l15 == 0) ? r_ : r_ - 1; \
            _Pragma("unroll") for (int lo = 0; lo < 2; ++lo) _Pragma("unroll") for (int ks = 0; ks < 2; ++ks) { const int col = 1536 + 64 * lo + 32 * ks + 8 * kg; \
                ld[(lo * 2 + ks) * 2] = *(const v4u*)(proj + r_ * L0P + col); ld[(lo * 2 + ks) * 2 + 1] = *(const v4u*)(proj + rp_ * L0P + col); } } while (0)
#define CK_ISSUE_B(T0) do { const int t0_ = (T0); \
            _Pragma("unroll") for (int ar = 0; ar < 3; ++ar) _Pragma("unroll") for (int i = 0; i < 2; ++i) { const int p_ = lane + 64 * i, row_ = p_ >> 3, c8_ = p_ & 7; \
                const size_t r_ = rowb + t0_ + row_; const size_t rp_ = (t0_ + row_ == 0) ? r_ : r_ - 1; const int col = 512 * ar + h * 64 + 8 * c8_; \
                ld[8 + (ar * 2 + i) * 2] = *(const v4u*)(proj + r_ * L0P + col); ld[8 + (ar * 2 + i) * 2 + 1] = *(const v4u*)(proj + rp_ * L0P + col); } } while (0)
#define CK_ISSUE(T0) do { CK_ISSUE_A(T0); CK_ISSUE_B(T0); } while (0)
        CK_ISSUE(16 * pw);
        int k = pw;
#pragma unroll 1
        while (k < NCH) {
            const int t0 = 16 * k; int kn;
#if defined(PROBE_STAMPS)
            const unsigned ts0_ = (unsigned)__builtin_amdgcn_s_memrealtime();
#endif
            f32x4 accw[4], acca[4];
#pragma unroll
            for (int nt = 0; nt < 4; ++nt) { accw[nt] = (f32x4){0.f, 0.f, 0.f, 0.f}; acca[nt] = (f32x4){0.f, 0.f, 0.f, 0.f}; }
            { const float pz_ = (t0 + l15 == 0) ? 0.f : 1.f;
#pragma unroll
              for (int lo = 0; lo < 2; ++lo)
#pragma unroll
                for (int ks = 0; ks < 2; ++ks) { float s_[8];
                    const f32x4 m0 = *(const LAS f32x4*)(mixs + 64 * lo + 32 * ks + 8 * kg), m1 = *(const LAS f32x4*)(mixs + 64 * lo + 32 * ks + 8 * kg + 4);
                    RW_SH8(ld[(lo * 2 + ks) * 2], ld[(lo * 2 + ks) * 2 + 1], m0, m1, s_, pz_);
                    if (lo == 0) {
#pragma unroll
                        for (int j = 0; j < 8; ++j) s_[j] = tanh_fast(s_[j]); }
                    const bf16x8 af = pack8(s_[0], s_[1], s_[2], s_[3], s_[4], s_[5], s_[6], s_[7]);
                    const bf16_t* WT = lo ? A2T : W2T;
#pragma unroll
                    for (int nt = 0; nt < 4; ++nt) { const bf16x8 bfr = *(const bf16x8*)(WT + (size_t)(h * 64 + 16 * nt + l15) * 64 + 32 * ks + 8 * kg);
                        if (lo == 0) accw[nt] = MFMA16(af, bfr, accw[nt]); else acca[nt] = MFMA16(af, bfr, acca[nt]); } } }
#pragma unroll
            for (int ar = 0; ar < 3; ++ar)
#pragma unroll
                for (int i = 0; i < 2; ++i) { const int p_ = lane + 64 * i, row_ = p_ >> 3, c8_ = p_ & 7; float s_[8];
                    const float pz_ = (t0 + row_ == 0) ? 0.f : 1.f; const f32x4 m0 = *(const LAS f32x4*)(mixs + 256 + ar * 64 + c8_ * 8), m1 = *(const LAS f32x4*)(mixs + 256 + ar * 64 + c8_ * 8 + 4);
                    RW_SH8(ld[8 + (ar * 2 + i) * 2], ld[8 + (ar * 2 + i) * 2 + 1], m0, m1, s_, pz_);
                    *(LAS bf16x8*)(stg + ar * 1024 + row_ * 64 + c8_ * 8) = pack8(s_[0], s_[1], s_[2], s_[3], s_[4], s_[5], s_[6], s_[7]); }
            WSYNC();
#if defined(PROBE_STAMPS)
            if (blk == 0 && wave == 1 && lane == 0) ((volatile LAS unsigned*)(lds + 146432 + 320))[16 + 26] += (unsigned)__builtin_amdgcn_s_memrealtime() - ts0_;
#endif
#if defined(PROBE_STAMPS)
            const unsigned tb0_ = (unsigned)__builtin_amdgcn_s_memrealtime();
#endif
            { const int need = k - (CK_NSLOT - 1); if (need > 0) { while ((int)flags[8] < need) __builtin_amdgcn_s_sleep(2); } }
#if defined(PROBE_STAMPS)
            if (blk == 0 && wave == 1 && lane == 0) ((volatile LAS unsigned*)(lds + 146432 + 320))[16 + 25] += (unsigned)__builtin_amdgcn_s_memrealtime() - tb0_;
#endif
            asm volatile("" ::: "memory");
            LAS unsigned char* im = lds + (k % CK_NSLOT) * CK_SLOT;
#if defined(PROBE_STAMPS)
            const unsigned ts1_ = (unsigned)__builtin_amdgcn_s_memrealtime();
#endif
            float lwv[4][4], av[4][4], knv[4][4];
#pragma unroll
            for (int rg = 0; rg < 4; ++rg) { const int tl = 4 * kg + rg;
                float kkv[4], nrm2 = 0.f, vv[4], rr_[4], kr_[4];
#pragma unroll
                for (int nt = 0; nt < 4; ++nt) { rr_[nt] = bf2f(stg[tl * 64 + 16 * nt + l15]); kr_[nt] = bf2f(stg[1024 + tl * 64 + 16 * nt + l15]); vv[nt] = bf2f(stg[2048 + tl * 64 + 16 * nt + l15]);
                    kkv[nt] = kr_[nt] * kkc[nt]; nrm2 += kkv[nt] * kkv[nt]; }
                nrm2 = rowsum16(nrm2); const float rn = __builtin_amdgcn_rsqf(fmaxf(nrm2, 1e-24f));
                float bon = 0.f;
#pragma unroll
                for (int nt = 0; nt < 4; ++nt) {
                    const float wsum = w0c[nt] + accw[nt][rg]; lwv[nt][rg] = -0.6065306597126334f * sigmoid_fast(wsum);
                    const float a_ = sigmoid_fast(a0c[nt] + acca[nt][rg]); av[nt][rg] = a_; knv[nt][rg] = kkv[nt] * rn;
                    const float k2 = kr_[nt] * (1.f + (a_ - 1.f) * kac[nt]); stg[1024 + tl * 64 + 16 * nt + l15] = bf1(k2);
                    bon += rr_[nt] * k2 * rkc[nt];
                    if ((nt >> 1) == ihalf) *(LAS bf16_t*)(im + CK_VT + (16 * (nt & 1) + l15) * 48 + tl * 2) = bf1(vv[nt]);
                }
                bon = rowsum16(bon);
                if (l15 == 0 && ihalf == 0) bonus_out[(rowb + t0 + tl) * 8 + h] = bon;
            }
            { unsigned g_ = 0; if (lane == 0) g_ = __hip_atomic_fetch_add((LAS unsigned*)(lds + CK_FLAGS + 36), 1u, __ATOMIC_RELAXED, __HIP_MEMORY_SCOPE_WORKGROUP);
              kn = (int)__builtin_amdgcn_readfirstlane(g_); }
            CK_ISSUE_A((kn < NCH) ? 16 * kn : t0);
#pragma unroll
            for (int nt = 0; nt < 4; ++nt) {
                float L[4]; L[0] = lwv[nt][0]; L[1] = L[0] + lwv[nt][1]; L[2] = L[1] + lwv[nt][2]; L[3] = L[2] + lwv[nt][3];
                const float T0 = __shfl(L[3], l15), T1 = __shfl(L[3], 16 + l15), T2 = __shfl(L[3], 32 + l15), T3 = __shfl(L[3], 48 + l15);
                const float off = (kg > 0 ? T0 : 0.f) + (kg > 1 ? T1 : 0.f) + (kg > 2 ? T2 : 0.f), LC = (T0 + T1) + (T2 + T3);
                const int j = 16 * nt + l15;
                unsigned bb2[2], kb2[2];
                const float gC = __expf(LC); float eprev = __expf(off);
#pragma unroll
                for (int rg = 0; rg < 4; ++rg) { const int tl = 4 * kg + rg; const float Lt = off + L[rg], e1 = __expf(Lt), e2 = __builtin_amdgcn_rcpf(e1), e3 = eprev, e4 = gC * e2; eprev = e1;
                    const float kn = knv[nt][rg], bvv = kn * av[nt][rg], k2 = bf2f(stg[1024 + tl * 64 + j]), rr2 = bf2f(stg[tl * 64 + j]);
                    *(LAS bf16_t*)(im + CK_BK + tl * 144 + j * 2) = bf1(bvv * e2); *(LAS bf16_t*)(im + CK_BK + (16 + tl) * 144 + j * 2) = bf1(k2 * e2);
                    *(LAS bf16_t*)(im + CK_AR + tl * 144 + j * 2) = bf1(-kn * e3); *(LAS bf16_t*)(im + CK_AR + (16 + tl) * 144 + j * 2) = bf1(rr2 * e1);
                    const unsigned bq = bf1(bvv * e4), kq = bf1(k2 * e4);
                    if (rg & 1) { bb2[rg >> 1] |= bq << 16; kb2[rg >> 1] |= kq << 16; } else { bb2[rg >> 1] = bq; kb2[rg >> 1] = kq; } }
                *(LAS u32x2*)(im + CK_BBT + j * 48 + (4 * kg) * 2) = (u32x2){bb2[0], bb2[1]}; *(LAS u32x2*)(im + CK_KBT + j * 48 + (4 * kg) * 2) = (u32x2){kb2[0], kb2[1]};
                if (kg == 0) *(LAS float*)(im + CK_GC + j * 4) = gC;
            }
            WSYNC();
#if defined(PROBE_STAMPS)
            const unsigned ts2_ = (unsigned)__builtin_amdgcn_s_memrealtime();
            if (blk == 0 && wave == 1 && lane == 0) ((volatile LAS unsigned*)(lds + 146432 + 320))[16 + 27] += ts2_ - ts1_;
#endif
            {
                f32x4 nacc = {0.f, 0.f, 0.f, 0.f};
#pragma unroll
                for (int ks = 0; ks < 2; ++ks) { const bf16x8 fa = *(const LAS bf16x8*)(im + CK_BK + l15 * 144 + (32 * ks + 8 * kg) * 2), fb = *(const LAS bf16x8*)(im + CK_AR + l15 * 144 + (32 * ks + 8 * kg) * 2); nacc = MFMA16(fa, fb, nacc); }
#pragma unroll
                for (int rg = 0; rg < 4; ++rg) nacc[rg] = ((4 * kg + rg) < l15) ? nacc[rg] : 0.f;
                float Tr[16];
#pragma unroll
                for (int t = 0; t < 16; ++t) { float acc_ = (l15 == t) ? 1.f : 0.f;
#pragma unroll
                    for (int s2 = 0; s2 < t; ++s2) acc_ += Tr[s2] * rl(nacc[s2 & 3], t + 16 * (s2 >> 2));
                    Tr[t] = acc_; }
                if (kg == 0) {
#pragma unroll
                    for (int t = 0; t < 16; ++t) *(LAS bf16_t*)(im + CK_TT + t * 48 + l15 * 2) = bf1(Tr[t]); }
            }
            WSYNC();
#if defined(PROBE_STAMPS)
            if (blk == 0 && wave == 1 && lane == 0) ((volatile LAS unsigned*)(lds + 146432 + 320))[16 + 28] += (unsigned)__builtin_amdgcn_s_memrealtime() - ts2_;
#endif
            if (lane == 0) flags[k % CK_NSLOT] = (unsigned)(k + 1);
            CK_ISSUE_B((kn < NCH) ? 16 * kn : t0);
            k = kn;
        }
#undef CK_ISSUE
#undef CK_ISSUE_A
#undef CK_ISSUE_B
    } else {
        const int gq = wave - 6;
        v4u ld[8];
#define G_ISSUE(T0) do { const int t0_ = (T0); const size_t r_ = rowb + t0_ + l15; const size_t rp_ = (t0_ + l15 == 0) ? r_ : r_ - 1; \
            _Pragma("unroll") for (int ks = 0; ks < 4; ++ks) { const int col = 1664 + 32 * ks + 8 * kg; ld[2 * ks] = *(const v4u*)(proj + r_ * L0P + col); ld[2 * ks + 1] = *(const v4u*)(proj + rp_ * L0P + col); } } while (0)
        G_ISSUE(16 * gq);
#pragma unroll 1
        for (int k = gq; k < NCH; k += 2) {
            const int t0 = 16 * k;
            f32x4 accg[2] = {(f32x4){0.f, 0.f, 0.f, 0.f}, (f32x4){0.f, 0.f, 0.f, 0.f}}; const float pz_ = (t0 + l15 == 0) ? 0.f : 1.f;
#pragma unroll
            for (int ks = 0; ks < 4; ++ks) { float s_[8];
                const f32x4 m0 = *(const LAS f32x4*)(mixs + 128 + 32 * ks + 8 * kg), m1 = *(const LAS f32x4*)(mixs + 128 + 32 * ks + 8 * kg + 4);
                RW_SH8(ld[2 * ks], ld[2 * ks + 1], m0, m1, s_, pz_);
#pragma unroll
                for (int j = 0; j < 8; ++j) s_[j] = sigmoid_fast(s_[j]);
                const bf16x8 af = pack8(s_[0], s_[1], s_[2], s_[3], s_[4], s_[5], s_[6], s_[7]);
#pragma unroll
                for (int nt = 0; nt < 2; ++nt) { const bf16x8 bfr = *(const bf16x8*)(G2T + (size_t)(h * 64 + ihalf * 32 + 16 * nt + l15) * 128 + 32 * ks + 8 * kg); accg[nt] = MFMA16(af, bfr, accg[nt]); } }
            G_ISSUE((k + 2 < NCH) ? t0 + 32 : t0);
#pragma unroll
            for (int nt = 0; nt < 2; ++nt)
#pragma unroll
                for (int rg = 0; rg < 4; ++rg) gout[(rowb + t0 + 4 * kg + rg) * 512 + h * 64 + ihalf * 32 + 16 * nt + l15] = bf1(accg[nt][rg]);
        }
#undef G_ISSUE
    }
#undef RW_SH8
    __syncthreads();
}

constexpr int CC_BK = 0, CC_AR = 4608, CC_BBT = 9216, CC_KBT = 11776, CC_VT = 14336, CC_GC = 16896, CC_TT = 17152, CC_SLOT = 18432, CC_NSLOT = 6, CC_NBUILD = 6;
constexpr int CC_STG = CC_SLOT * CC_NSLOT;
constexpr int CC_MIX = CC_STG + CC_NBUILD * 4096;
constexpr int CC_FLAGS = CC_MIX + 448 * 4;
static_assert(CC_FLAGS + 64 <= 146432, "rwkv chain LDS map");
__device__ __forceinline__ void rwkv_phase_chain(LAS float* smf, int tid, int lane, int wave, int blk, const bf16_t* __restrict__ proj, const float* __restrict__ mix, const float* __restrict__ w0, const float* __restrict__ a0,
                                           const float* __restrict__ k_k, const float* __restrict__ k_a, const float* __restrict__ r_k, const bf16_t* __restrict__ W2T, const bf16_t* __restrict__ A2T, const bf16_t* __restrict__ G2T,
                                           float* __restrict__ yraw, bf16_t* __restrict__ gout, float* __restrict__ bonus_out) {
    LAS unsigned char* lds = (LAS unsigned char*)smf;
    LAS float* mixs = (LAS float*)(lds + CC_MIX);
    volatile LAS unsigned* flags = (volatile LAS unsigned*)(lds + CC_FLAGS);
    const int chain = blk, b = chain >> 3, h = chain & 7, l15 = lane & 15, kg = lane >> 4, l31 = lane & 31, hi = lane >> 5;
    const size_t rowb = (size_t)b * SEQ;
    constexpr int NCH = SEQ / 16;
    if (tid < 256) mixs[tid] = mix[1536 + tid];
    else if (tid < 448) { const int q = tid - 256; mixs[tid] = mix[512 * (q >> 6) + h * 64 + (q & 63)]; }
    if (tid < 16) flags[tid] = (tid == 10) ? (unsigned)CC_NBUILD : 0u;
    for (int q = tid; q < CC_NSLOT * 320; q += NWAVES * 64) *(LAS unsigned*)(lds + (q / 320) * CC_SLOT + CC_TT + (q % 320) * 4) = 0u;
    __syncthreads();
#define RW_SH8(CUR, PRV, M0, M1, OUT, PZ) do { const unsigned cu_[4] = {(CUR).x, (CUR).y, (CUR).z, (CUR).w}, pu_[4] = {(PRV).x, (PRV).y, (PRV).z, (PRV).w}; \
        const float mm_[8] = {(M0)[0], (M0)[1], (M0)[2], (M0)[3], (M1)[0], (M1)[1], (M1)[2], (M1)[3]}; \
        _Pragma("unroll") for (int q = 0; q < 4; ++q) { const float c0 = bflo(cu_[q]), c1 = bfhi(cu_[q]), p0 = bflo(pu_[q]) * (PZ), p1 = bfhi(pu_[q]) * (PZ); \
            OUT[2 * q] = c0 + (p0 - c0) * mm_[2 * q]; OUT[2 * q + 1] = c1 + (p1 - c1) * mm_[2 * q + 1]; } } while (0)
    if (wave < 2) {
        const int ihalf = wave;
        f32x16 ST[2];
#pragma unroll
        for (int r = 0; r < 16; ++r) { ST[0][r] = 0.f; ST[1][r] = 0.f; }
#pragma unroll 1
        for (int k = 0; k < NCH; ++k) {
            { const unsigned want = (unsigned)(k + 1); const int sl = k % CC_NSLOT; while (flags[sl] != want) __builtin_amdgcn_s_sleep(1); }
            asm volatile("" ::: "memory");
            const LAS unsigned char* im = lds + (k % CC_NSLOT) * CC_SLOT;
            f32x16 G;
#pragma unroll
            for (int r = 0; r < 16; ++r) G[r] = 0.f;
#pragma unroll
            for (int kk = 0; kk < 4; ++kk) { const bf16x8 fa = *(const LAS bf16x8*)(im + CC_BK + l31 * 144 + (16 * kk + 8 * hi) * 2), fb = *(const LAS bf16x8*)(im + CC_AR + l31 * 144 + (16 * kk + 8 * hi) * 2); G = MFMA32(fa, fb, G); }
            { const int tcol = l31 & 15; const bool strict = l31 < 16;
#pragma unroll
              for (int r = 0; r < 16; ++r) { const int srow = crow(r & 7, hi); const bool keep = strict ? (srow < tcol) : (srow <= tcol); G[r] = keep ? G[r] : 0.f; } }
            const bf16x8 gB = pack8(G[0], G[1], G[2], G[3], G[4], G[5], G[6], G[7]), gK = pack8(G[8], G[9], G[10], G[11], G[12], G[13], G[14], G[15]);
            f32x16 XT;
#pragma unroll
            for (int r = 0; r < 16; ++r) XT[r] = 0.f;
#pragma unroll
            for (int jt = 0; jt < 2; ++jt)
#pragma unroll
                for (int sp = 0; sp < 2; ++sp) { const LAS unsigned char* ap = im + CC_AR + l31 * 144 + (32 * jt + 16 * sp + 4 * hi) * 2;
                    const u32x2 x0 = *(const LAS u32x2*)ap, x1 = *(const LAS u32x2*)(ap + 16); v4u aw; aw.x = x0.x; aw.y = x0.y; aw.z = x1.x; aw.w = x1.y;
                    const bf16x8 sb_ = pack8(ST[jt][8 * sp], ST[jt][8 * sp + 1], ST[jt][8 * sp + 2], ST[jt][8 * sp + 3], ST[jt][8 * sp + 4], ST[jt][8 * sp + 5], ST[jt][8 * sp + 6], ST[jt][8 * sp + 7]);
                    XT = MFMA32(__builtin_bit_cast(bf16x8, aw), sb_, XT); }
            bf16x8 vP;
            { const LAS unsigned char* vp = im + CC_VT + (32 * ihalf + l31) * 40 + (4 * hi) * 2; const u32x2 x0 = *(const LAS u32x2*)vp, x1 = *(const LAS u32x2*)(vp + 16); v4u vw; vw.x = x0.x; vw.y = x0.y; vw.z = x1.x; vw.w = x1.y;
              vP = __builtin_bit_cast(bf16x8, vw); XT = MFMA32(gK, vP, XT); }
            bf16x8 uP;
            { const LAS unsigned char* tp = im + CC_TT + l31 * 40 + (4 * hi) * 2; const u32x2 x0 = *(const LAS u32x2*)tp, x1 = *(const LAS u32x2*)(tp + 16); v4u tw; tw.x = x0.x; tw.y = x0.y; tw.z = x1.x; tw.w = x1.y;
              f32x16 UT;
#pragma unroll
              for (int r = 0; r < 16; ++r) UT[r] = 0.f;
              UT = MFMA32(__builtin_bit_cast(bf16x8, tw), pack8(XT[0], XT[1], XT[2], XT[3], XT[4], XT[5], XT[6], XT[7]), UT);
              uP = pack8(UT[0], UT[1], UT[2], UT[3], UT[4], UT[5], UT[6], UT[7]); }
            XT = MFMA32(gB, uP, XT);
            { float* yp = yraw + (rowb + 16 * k) * 512 + h * 64 + 32 * ihalf + l31;
#pragma unroll
              for (int q = 0; q < 8; ++q) yp[(size_t)crow(q, hi) * 512] = XT[8 + q]; }
            { const LAS float* gc = (const LAS float*)(im + CC_GC);
#pragma unroll
              for (int jt = 0; jt < 2; ++jt)
#pragma unroll
                  for (int r = 0; r < 16; ++r) ST[jt][r] *= gc[32 * jt + crow(r, hi)]; }
#pragma unroll
            for (int jt = 0; jt < 2; ++jt) { const LAS unsigned char* bp = im + CC_BBT + (32 * jt + l31) * 40 + (4 * hi) * 2; const LAS unsigned char* kp = im + CC_KBT + (32 * jt + l31) * 40 + (4 * hi) * 2;
                const u32x2 b0 = *(const LAS u32x2*)bp, b1 = *(const LAS u32x2*)(bp + 16), k0 = *(const LAS u32x2*)kp, k1 = *(const LAS u32x2*)(kp + 16);
                v4u a1; a1.x = b0.x; a1.y = b0.y; a1.z = b1.x; a1.w = b1.y; v4u a2; a2.x = k0.x; a2.y = k0.y; a2.z = k1.x; a2.w = k1.y;
                ST[jt] = MFMA32(__builtin_bit_cast(bf16x8, a1), uP, ST[jt]); ST[jt] = MFMA32(__builtin_bit_cast(bf16x8, a2), vP, ST[jt]); }
            WSYNC();
            if (lane == 0) flags[8 + ihalf] = (unsigned)(k + 1);
        }
    } else {
        const int pw = wave - 2;
        LAS bf16_t* stg = (LAS bf16_t*)(lds + CC_STG) + pw * 2048;
        v4u ld[20];
#define CC_ISSUE_A(T0) do { const int t0_ = (T0); const size_t r_ = rowb + t0_ + l15; const size_t rp_ = (t0_ + l15 == 0) ? r_ : r_ - 1; \
            _Pragma("unroll") for (int lo = 0; lo < 2; ++lo) _Pragma("unroll") for (int ks = 0; ks < 2; ++ks) { const int col = 1536 + 64 * lo + 32 * ks + 8 * kg; \
                ld[(lo * 2 + ks) * 2] = *(const v4u*)(proj + r_ * L0P + col); ld[(lo * 2 + ks) * 2 + 1] = *(const v4u*)(proj + rp_ * L0P + col); } } while (0)
#define CC_ISSUE_B(T0) do { const int t0_ = (T0); \
            _Pragma("unroll") for (int ar = 0; ar < 3; ++ar) _Pragma("unroll") for (int i = 0; i < 2; ++i) { const int p_ = lane + 64 * i, row_ = p_ >> 3, c8_ = p_ & 7; \
                const size_t r_ = rowb + t0_ + row_; const size_t rp_ = (t0_ + row_ == 0) ? r_ : r_ - 1; const int col = 512 * ar + h * 64 + 8 * c8_; \
                ld[8 + (ar * 2 + i) * 2] = *(const v4u*)(proj + r_ * L0P + col); ld[8 + (ar * 2 + i) * 2 + 1] = *(const v4u*)(proj + rp_ * L0P + col); } } while (0)
#define CC_ISSUE(T0) do { CC_ISSUE_A(T0); CC_ISSUE_B(T0); } while (0)
        CC_ISSUE(16 * pw);
        int k = pw;
#pragma unroll 1
        while (k < NCH) {
            const int t0 = 16 * k; int kn;
            f32x4 accw[4], acca[4];
#pragma unroll
            for (int nt = 0; nt < 4; ++nt) { accw[nt] = (f32x4){0.f, 0.f, 0.f, 0.f}; acca[nt] = (f32x4){0.f, 0.f, 0.f, 0.f}; }
            { const float pz_ = (t0 + l15 == 0) ? 0.f : 1.f;
#pragma unroll
              for (int lo = 0; lo < 2; ++lo)
#pragma unroll
                for (int ks = 0; ks < 2; ++ks) { float s_[8];
                    const f32x4 m0 = *(const LAS f32x4*)(mixs + 64 * lo + 32 * ks + 8 * kg), m1 = *(const LAS f32x4*)(mixs + 64 * lo + 32 * ks + 8 * kg + 4);
                    RW_SH8(ld[(lo * 2 + ks) * 2], ld[(lo * 2 + ks) * 2 + 1], m0, m1, s_, pz_);
                    if (lo == 0) {
#pragma unroll
                        for (int j = 0; j < 8; ++j) s_[j] = tanh_fast(s_[j]); }
                    const bf16x8 af = pack8(s_[0], s_[1], s_[2], s_[3], s_[4], s_[5], s_[6], s_[7]);
                    const bf16_t* WT = lo ? A2T : W2T;
#pragma unroll
                    for (int nt = 0; nt < 4; ++nt) { const bf16x8 bfr = *(const bf16x8*)(WT + (size_t)(h * 64 + 16 * nt + l15) * 64 + 32 * ks + 8 * kg);
                        if (lo == 0) accw[nt] = MFMA16(af, bfr, accw[nt]); else acca[nt] = MFMA16(af, bfr, acca[nt]); } } }
            { const int need = k - (CC_NSLOT - 1); if (need > 0) { while ((int)flags[8] < need || (int)flags[9] < need) __builtin_amdgcn_s_sleep(2); } }
            asm volatile("" ::: "memory");
            LAS unsigned char* im = lds + (k % CC_NSLOT) * CC_SLOT;
#pragma unroll
            for (int ar = 0; ar < 3; ++ar)
#pragma unroll
                for (int i = 0; i < 2; ++i) { const int p_ = lane + 64 * i, row_ = p_ >> 3, c8_ = p_ & 7; float s_[8];
                    const float pz_ = (t0 + row_ == 0) ? 0.f : 1.f; const f32x4 m0 = *(const LAS f32x4*)(mixs + 256 + ar * 64 + c8_ * 8), m1 = *(const LAS f32x4*)(mixs + 256 + ar * 64 + c8_ * 8 + 4);
                    RW_SH8(ld[8 + (ar * 2 + i) * 2], ld[8 + (ar * 2 + i) * 2 + 1], m0, m1, s_, pz_);
                    if (ar < 2) *(LAS bf16x8*)(stg + ar * 1024 + row_ * 64 + c8_ * 8) = pack8(s_[0], s_[1], s_[2], s_[3], s_[4], s_[5], s_[6], s_[7]);
                    else {
#pragma unroll
                        for (int j = 0; j < 8; ++j) *(LAS bf16_t*)(im + CC_VT + (c8_ * 8 + j) * 40 + row_ * 2) = bf1(s_[j]); } }
            WSYNC();
            float lwv[4][4], av[4][4], knv[4][4];
            float w0c[4], a0c[4], kkc[4], kac[4], rkc[4];
#pragma unroll
            for (int nt = 0; nt < 4; ++nt) { const int c = h * 64 + 16 * nt + l15; w0c[nt] = w0[c]; a0c[nt] = a0[c]; kkc[nt] = k_k[c]; kac[nt] = k_a[c]; rkc[nt] = r_k[c]; }
#pragma unroll
            for (int rg = 0; rg < 4; ++rg) { const int tl = 4 * kg + rg;
                float kkv[4], nrm2 = 0.f, rr_[4], kr_[4];
#pragma unroll
                for (int nt = 0; nt < 4; ++nt) { rr_[nt] = bf2f(stg[tl * 64 + 16 * nt + l15]); kr_[nt] = bf2f(stg[1024 + tl * 64 + 16 * nt + l15]);
                    kkv[nt] = kr_[nt] * kkc[nt]; nrm2 += kkv[nt] * kkv[nt]; }
                nrm2 = rowsum16(nrm2); const float rn = __builtin_amdgcn_rsqf(fmaxf(nrm2, 1e-24f));
                float bon = 0.f;
#pragma unroll
                for (int nt = 0; nt < 4; ++nt) {
                    const float wsum = w0c[nt] + accw[nt][rg]; lwv[nt][rg] = -0.6065306597126334f * sigmoid_fast(wsum);
                    const float a_ = sigmoid_fast(a0c[nt] + acca[nt][rg]); av[nt][rg] = a_; knv[nt][rg] = kkv[nt] * rn;
                    const float k2 = kr_[nt] * (1.f + (a_ - 1.f) * kac[nt]); stg[1024 + tl * 64 + 16 * nt + l15] = bf1(k2);
                    bon += rr_[nt] * k2 * rkc[nt];
                }
                bon = rowsum16(bon);
                if (l15 == 0) bonus_out[(rowb + t0 + tl) * 8 + h] = bon;
            }
            { unsigned g_ = 0; if (lane == 0) g_ = __hip_atomic_fetch_add((LAS unsigned*)(lds + CC_FLAGS + 40), 1u, __ATOMIC_RELAXED, __HIP_MEMORY_SCOPE_WORKGROUP);
              kn = (int)__builtin_amdgcn_readfirstlane(g_); }
            CC_ISSUE_A((kn < NCH) ? 16 * kn : t0);
#pragma unroll
            for (int nt = 0; nt < 4; ++nt) {
                float L[4]; L[0] = lwv[nt][0]; L[1] = L[0] + lwv[nt][1]; L[2] = L[1] + lwv[nt][2]; L[3] = L[2] + lwv[nt][3];
                const float T0 = __shfl(L[3], l15), T1 = __shfl(L[3], 16 + l15), T2 = __shfl(L[3], 32 + l15), T3 = __shfl(L[3], 48 + l15);
                const float off = (kg > 0 ? T0 : 0.f) + (kg > 1 ? T1 : 0.f) + (kg > 2 ? T2 : 0.f), LC = (T0 + T1) + (T2 + T3);
                const int j = 16 * nt + l15;
                unsigned bb2[2], kb2[2];
                const float gC = __expf(LC); float eprev = __expf(off);
#pragma unroll
                for (int rg = 0; rg < 4; ++rg) { const int tl = 4 * kg + rg; const float Lt = off + L[rg], e1 = __expf(Lt), e2 = __builtin_amdgcn_rcpf(e1), e3 = eprev, e4 = gC * e2; eprev = e1;
                    const float kn = knv[nt][rg], bvv = kn * av[nt][rg], k2 = bf2f(stg[1024 + tl * 64 + j]), rr2 = bf2f(stg[tl * 64 + j]);
                    *(LAS bf16_t*)(im + CC_BK + tl * 144 + j * 2) = bf1(bvv * e2); *(LAS bf16_t*)(im + CC_BK + (16 + tl) * 144 + j * 2) = bf1(k2 * e2);
                    *(LAS bf16_t*)(im + CC_AR + tl * 144 + j * 2) = bf1(-kn * e3); *(LAS bf16_t*)(im + CC_AR + (16 + tl) * 144 + j * 2) = bf1(rr2 * e1);
                    const unsigned bq = bf1(bvv * e4), kq = bf1(k2 * e4);
                    if (rg & 1) { bb2[rg >> 1] |= bq << 16; kb2[rg >> 1] |= kq << 16; } else { bb2[rg >> 1] = bq; kb2[rg >> 1] = kq; } }
                *(LAS u32x2*)(im + CC_BBT + j * 40 + (4 * kg) * 2) = (u32x2){bb2[0], bb2[1]}; *(LAS u32x2*)(im + CC_KBT + j * 40 + (4 * kg) * 2) = (u32x2){kb2[0], kb2[1]};
                if (kg == 0) *(LAS float*)(im + CC_GC + j * 4) = gC;
            }
            WSYNC();
            {
                f32x4 nacc = {0.f, 0.f, 0.f, 0.f};
#pragma unroll
                for (int ks = 0; ks < 2; ++ks) { const bf16x8 fa = *(const LAS bf16x8*)(im + CC_BK + l15 * 144 + (32 * ks + 8 * kg) * 2), fb = *(const LAS bf16x8*)(im + CC_AR + l15 * 144 + (32 * ks + 8 * kg) * 2); nacc = MFMA16(fa, fb, nacc); }
#pragma unroll
                for (int rg = 0; rg < 4; ++rg) nacc[rg] = ((4 * kg + rg) < l15) ? nacc[rg] : 0.f;
                float Tr[16];
#pragma unroll
                for (int t = 0; t < 16; ++t) { float acc_ = (l15 == t) ? 1.f : 0.f;
#pragma unroll
                    for (int s2 = 0; s2 < t; ++s2) acc_ += Tr[s2] * rl(nacc[s2 & 3], t + 16 * (s2 >> 2));
                    Tr[t] = acc_; }
                if (kg == 0) {
#pragma unroll
                    for (int t = 0; t < 16; ++t) *(LAS bf16_t*)(im + CC_TT + t * 40 + l15 * 2) = bf1(Tr[t]); }
            }
            WSYNC();
            if (lane == 0) flags[k % CC_NSLOT] = (unsigned)(k + 1);
            CC_ISSUE_B((kn < NCH) ? 16 * kn : t0);
            k = kn;
        }
#undef CC_ISSUE
#undef CC_ISSUE_A
#undef CC_ISSUE_B
    }
#undef RW_SH8
    __syncthreads();
}


__device__ __forceinline__ void gate_lora_task(int chain, int k, int lane, const bf16_t* __restrict__ proj, const float* __restrict__ mix, const bf16_t* __restrict__ G2T, bf16_t* __restrict__ gout) {
    const int b = chain >> 3, h = chain & 7, l15 = lane & 15, kg = lane >> 4, t0 = 16 * k;
    const size_t rowb = (size_t)b * SEQ, r_ = rowb + t0 + l15, rp_ = (t0 + l15 == 0) ? r_ : r_ - 1;
    const float pz_ = (t0 + l15 == 0) ? 0.f : 1.f;
    v4u cu[4], pv[4];
#pragma unroll
    for (int ks = 0; ks < 4; ++ks) { const int col = 1664 + 32 * ks + 8 * kg; cu[ks] = *(const v4u*)(proj + r_ * L0P + col); pv[ks] = *(const v4u*)(proj + rp_ * L0P + col); }
    f32x4 accg[4];
#pragma unroll
    for (int nt = 0; nt < 4; ++nt) accg[nt] = (f32x4){0.f, 0.f, 0.f, 0.f};
#pragma unroll
    for (int ks = 0; ks < 4; ++ks) {
        const f32x4 m0 = *(const f32x4*)(mix + 1664 + 32 * ks + 8 * kg), m1 = *(const f32x4*)(mix + 1664 + 32 * ks + 8 * kg + 4);
        const float mm[8] = {m0[0], m0[1], m0[2], m0[3], m1[0], m1[1], m1[2], m1[3]};
        const unsigned cw[4] = {cu[ks].x, cu[ks].y, cu[ks].z, cu[ks].w}, pw[4] = {pv[ks].x, pv[ks].y, pv[ks].z, pv[ks].w};
        float s_[8];
#pragma unroll
        for (int q = 0; q < 4; ++q) { const float c0 = bflo(cw[q]), c1 = bfhi(cw[q]), p0 = bflo(pw[q]) * pz_, p1 = bfhi(pw[q]) * pz_;
            s_[2 * q] = sigmoid_fast(c0 + (p0 - c0) * mm[2 * q]); s_[2 * q + 1] = sigmoid_fast(c1 + (p1 - c1) * mm[2 * q + 1]); }
        const bf16x8 af = pack8(s_[0], s_[1], s_[2], s_[3], s_[4], s_[5], s_[6], s_[7]);
#pragma unroll
        for (int nt = 0; nt < 4; ++nt) { const bf16x8 bfr = *(const bf16x8*)(G2T + (size_t)(h * 64 + 16 * nt + l15) * 128 + 32 * ks + 8 * kg); accg[nt] = MFMA16(af, bfr, accg[nt]); }
    }
#pragma unroll
    for (int nt = 0; nt < 4; ++nt)
#pragma unroll
        for (int rg = 0; rg < 4; ++rg) gout[(rowb + t0 + 4 * kg + rg) * 512 + h * 64 + 16 * nt + l15] = bf1(accg[nt][rg]);
}


__device__ __forceinline__ void gate_lora_wave(int first, int stride, int lane, const bf16_t* __restrict__ proj, const float* __restrict__ mix, const bf16_t* __restrict__ G2T, bf16_t* __restrict__ gout) {
    const int l15 = lane & 15, kg = lane >> 4, h = (first >> 7) & 7;
    bf16x8 bfr[4][4];
#pragma unroll
    for (int ks = 0; ks < 4; ++ks)
#pragma unroll
        for (int nt = 0; nt < 4; ++nt) bfr[ks][nt] = *(const bf16x8*)(G2T + (size_t)(h * 64 + 16 * nt + l15) * 128 + 32 * ks + 8 * kg);
    float mm[4][8];
#pragma unroll
    for (int ks = 0; ks < 4; ++ks) { const f32x4 m0 = *(const f32x4*)(mix + 1664 + 32 * ks + 8 * kg), m1 = *(const f32x4*)(mix + 1664 + 32 * ks + 8 * kg + 4);
        mm[ks][0] = m0[0]; mm[ks][1] = m0[1]; mm[ks][2] = m0[2]; mm[ks][3] = m0[3]; mm[ks][4] = m1[0]; mm[ks][5] = m1[1]; mm[ks][6] = m1[2]; mm[ks][7] = m1[3]; }
    v4u cu[4], pv[4];
#define GL_LOAD(TK) do { const int ch_ = (TK) >> 7, t0_ = 16 * ((TK) & 127); const size_t r_ = (size_t)(ch_ >> 3) * SEQ + t0_ + l15, rp_ = (t0_ + l15 == 0) ? r_ : r_ - 1; \
        _Pragma("unroll") for (int ks = 0; ks < 4; ++ks) { const int col = 1664 + 32 * ks + 8 * kg; cu[ks] = *(const v4u*)(proj + r_ * L0P + col); pv[ks] = *(const v4u*)(proj + rp_ * L0P + col); } } while (0)
    GL_LOAD(first);
#pragma unroll 1
    for (int tk = first; tk < 128 * 128; tk += stride) {
        const int chain = tk >> 7, t0 = 16 * (tk & 127); const size_t rowb = (size_t)(chain >> 3) * SEQ;
        const float pz_ = (t0 + l15 == 0) ? 0.f : 1.f;
        f32x4 accg[4];
#pragma unroll
        for (int nt = 0; nt < 4; ++nt) accg[nt] = (f32x4){0.f, 0.f, 0.f, 0.f};
        bf16x8 af[4];
#pragma unroll
        for (int ks = 0; ks < 4; ++ks) { const unsigned cw[4] = {cu[ks].x, cu[ks].y, cu[ks].z, cu[ks].w}, pw[4] = {pv[ks].x, pv[ks].y, pv[ks].z, pv[ks].w}; float s_[8];
#pragma unroll
            for (int q = 0; q < 4; ++q) { const float c0 = bflo(cw[q]), c1 = bfhi(cw[q]), p0 = bflo(pw[q]) * pz_, p1 = bfhi(pw[q]) * pz_;
                s_[2 * q] = sigmoid_fast(c0 + (p0 - c0) * mm[ks][2 * q]); s_[2 * q + 1] = sigmoid_fast(c1 + (p1 - c1) * mm[ks][2 * q + 1]); }
            af[ks] = pack8(s_[0], s_[1], s_[2], s_[3], s_[4], s_[5], s_[6], s_[7]); }
        { const int tn = (tk + stride < 128 * 128) ? tk + stride : tk; GL_LOAD(tn); }
#pragma unroll
        for (int ks = 0; ks < 4; ++ks)
#pragma unroll
            for (int nt = 0; nt < 4; ++nt) accg[nt] = MFMA16(af[ks], bfr[ks][nt], accg[nt]);
#pragma unroll
        for (int nt = 0; nt < 4; ++nt)
#pragma unroll
            for (int rg = 0; rg < 4; ++rg) gout[(rowb + t0 + 4 * kg + rg) * 512 + h * 64 + 16 * nt + l15] = bf1(accg[nt][rg]);
    }
#undef GL_LOAD
}

template <bool ST = true> __device__ __forceinline__ void rwkv_post_all(const float* __restrict__ yraw, const bf16_t* __restrict__ proj, const float* __restrict__ mix, const float* __restrict__ bonus, const bf16_t* __restrict__ gbuf,
                                              const float* __restrict__ ln_g, const float* __restrict__ ln_b, bf16_t* __restrict__ ymix, int gw, int NGW, int lane) {
    for (int m = gw; m < M; m += NGW) {
        const bool has_prev = (m & (SEQ - 1)) != 0;
        float y[8], cv[8], pv[8], gg[8], bo[8];
#pragma unroll
        for (int h = 0; h < 8; ++h) { const int c = h * 64 + lane; y[h] = yraw[(size_t)m * 512 + c]; cv[h] = bf2f(proj[(size_t)m * L0P + 1024 + c]);
            pv[h] = bf2f(proj[(size_t)(has_prev ? m - 1 : m) * L0P + 1024 + c]); gg[h] = bf2f(gbuf[(size_t)m * 512 + c]); bo[h] = bonus[(size_t)m * 8 + h]; }
#pragma unroll
        for (int h = 0; h < 8; ++h) { const int c = h * 64 + lane;
            const float mu = wave_sum_dpp(y[h]) * (1.f / 64.f), d = y[h] - mu, var = wave_sum_dpp(d * d) * (1.f / 64.f);
            const float yn = d * __builtin_amdgcn_rsqf(var + 64e-5f) * ln_g[c] + ln_b[c];
            const float pvv = has_prev ? pv[h] : 0.f;
            const float v_s = cv[h] + (pvv - cv[h]) * mix[1024 + c];
            const float o = (yn + bo[h] * v_s) * gg[h];
            if (ST) ymix[(size_t)m * DM + c] = bf1(o); else asm volatile("" :: "v"(o)); }
    }
}


__device__ __forceinline__ void ssd_conv_tile(int it, int lane, LAS bf16_t* scr, const bf16_t* __restrict__ proj, const float* __restrict__ cw, const float* __restrict__ cb,
                                              bf16_t* __restrict__ xbc, bf16_t* __restrict__ xst, bf16_t* __restrict__ bt) {
    const int tt = it >> 4, ct = it & 15, m0 = tt * 64, b = m0 >> 11, t0 = m0 & (SEQ - 1), c = ct * 64 + lane;
    const float w0 = cw[c], w1 = cw[1024 + c], w2 = cw[2048 + c], w3 = cw[3072 + c], bias = cb[c];
    const bf16_t* src = proj + (size_t)m0 * L0P + 2304 + c;
    bf16_t raw[67];
    const int lo = (t0 > 0) ? -3 : 0;
#pragma unroll
    for (int t = -3; t < 64; ++t) raw[t + 3] = src[(ptrdiff_t)((t < lo) ? lo : t) * L0P];
    float u3 = (t0 > 0) ? bf2f(raw[0]) : 0.f, u2 = (t0 > 0) ? bf2f(raw[1]) : 0.f, u1 = (t0 > 0) ? bf2f(raw[2]) : 0.f;
#pragma unroll
    for (int t = 0; t < 64; ++t) {
        const float u = bf2f(raw[t + 3]);
        const float y = bias + w0 * u3 + w1 * u2 + w2 * u1 + w3 * u;
        const bf16_t o = bf1(y * __builtin_amdgcn_rcpf(1.f + __expf(-y)));
        xbc[(size_t)(m0 + t) * 1024 + c] = o;
        scr[t * STG_PITCH + lane] = o;
        u3 = u2; u2 = u1; u1 = u;
    }
    WSYNC();
    if (ct < 12) {
        bf16_t* dst = (ct < 8) ? xst + ((size_t)(b * 8 + ct) * 64) * SEQ + t0 : bt + ((size_t)(b * 2 + ((ct - 8) >> 1)) * 128 + ((ct - 8) & 1) * 64) * SEQ + t0;
#pragma unroll
        for (int i = 0; i < 8; ++i) { const int d = i * 8 + (lane >> 3), tc = lane & 7; const LAS bf16_t* p = scr + (tc * 8) * STG_PITCH + d;
            v4u o; o.x = (unsigned)p[0] | ((unsigned)p[STG_PITCH] << 16); o.y = (unsigned)p[2 * STG_PITCH] | ((unsigned)p[3 * STG_PITCH] << 16);
            o.z = (unsigned)p[4 * STG_PITCH] | ((unsigned)p[5 * STG_PITCH] << 16); o.w = (unsigned)p[6 * STG_PITCH] | ((unsigned)p[7 * STG_PITCH] << 16);
            *(v4u*)(dst + (size_t)d * SEQ + tc * 8) = o; }
    }
    WSYNC();
}
__device__ __forceinline__ float bperm(int srclane, float x) { return __builtin_bit_cast(float, __builtin_amdgcn_ds_bpermute(srclane << 2, __builtin_bit_cast(int, x))); }
__device__ __forceinline__ void scan128(float& x0, float& x1, int lane) {
#pragma unroll
    for (int o = 1; o < 64; o <<= 1) { const int sl = (lane >= o) ? lane - o : lane; const float t0 = bperm(sl, x0), t1 = bperm(sl, x1); if (lane >= o) { x0 += t0; x1 += t1; } }
    x1 += rl(x0, 63);
}

__device__ __forceinline__ void ssd_s3_block(int bc, int tid, int lane, int wave, LAS unsigned char* lds, const bf16_t* __restrict__ xbc, const bf16_t* __restrict__ xst, const bf16_t* __restrict__ stb,
                                             const float* __restrict__ dt, const float* __restrict__ a_log, const float* __restrict__ dsk, bf16_t* __restrict__ yssm) {
    const int b = bc >> 4, c = bc & 15, h = wave, g = h >> 2, l0 = c * 128, l31 = lane & 31, hi = lane >> 5, unit = bc * 8 + h;
    const size_t m0 = (size_t)b * SEQ + l0;
    __syncthreads();
    {
        const int mat = lane >> 4, ch = lane & 15;
        v4u rr[16];
#pragma unroll
        for (int i = 0; i < 16; ++i) rr[i] = *(const v4u*)(xbc + (m0 + wave * 16 + i) * 1024 + 512 + lane * 8);
#pragma unroll
        for (int i = 0; i < 16; ++i) { const int row = wave * 16 + i; *(LAS v4u*)(lds + mat * 34816 + row * 272 + ch * 16) = rr[i]; }
    }
#define S3TAB(i) (*(LAS float*)(lds + ((wave * 64) + ((i) >> 2)) * 272 + 256 + ((i) & 3) * 4))
    const float A = -expf(a_log[h]), D = dsk[h];
    { const float d0 = dt[(m0 + lane) * 8 + h], d1 = dt[(m0 + 64 + lane) * 8 + h];
      float ac0 = d0 * A, ac1 = d1 * A;
      scan128(ac0, ac1, lane);
      S3TAB(lane) = ac0; S3TAB(64 + lane) = ac1; S3TAB(128 + lane) = d0; S3TAB(192 + lane) = d1; }
    u32x2 xf[4][2][2][2];
    const bf16_t* Sp = stb + (size_t)unit * 8192 + l31 * 128 + 8 * hi;
    { const bf16_t* Xp = xst + ((size_t)(b * 8 + h) * 64 + l31) * SEQ + l0 + 4 * hi;
#pragma unroll
      for (int st = 0; st < 4; ++st)
#pragma unroll
          for (int pt = 0; pt < 2; ++pt)
#pragma unroll
              for (int ks = 0; ks < 2; ++ks) { const bf16_t* xp = Xp + (size_t)pt * 32 * SEQ + st * 32 + 16 * ks; xf[st][pt][ks][0] = *(const u32x2*)xp; xf[st][pt][ks][1] = *(const u32x2*)(xp + 8); } }
    __syncthreads();
    const LAS unsigned char* Bl = lds + g * 34816 + 16 * hi;
    const LAS unsigned char* Cl = lds + (2 + g) * 34816 + 16 * hi;
#pragma unroll 1
    for (int lt = 0; lt < 4; ++lt) {
        asm volatile("" ::: "memory");
        f32x16 y[2];
#pragma unroll
        for (int r = 0; r < 16; ++r) { y[0][r] = 0.f; y[1][r] = 0.f; }
        const float acl = S3TAB(32 * lt + l31);
        const int crw = 32 * lt + l31;
        { bf16x8 sfr[2][8];
#pragma unroll
          for (int pt = 0; pt < 2; ++pt)
#pragma unroll
              for (int kk = 0; kk < 8; ++kk) sfr[pt][kk] = *(const bf16x8*)(Sp + pt * 32 * 128 + 16 * kk);
#pragma unroll
          for (int kk = 0; kk < 8; ++kk) { const bf16x8 cf = *(const LAS bf16x8*)(Cl + crw * 272 + 32 * kk); y[0] = MFMA32(sfr[0][kk], cf, y[0]); y[1] = MFMA32(sfr[1][kk], cf, y[1]); } }
        { const float el = __expf(acl);
#pragma unroll
          for (int r = 0; r < 16; ++r) { y[0][r] *= el; y[1][r] *= el; } }
        u32x2 xd[2][4];
#pragma unroll
        for (int pt = 0; pt < 2; ++pt)
#pragma unroll
            for (int q = 0; q < 4; ++q) xd[pt][q] = *(const u32x2*)(xbc + (m0 + crw) * 1024 + h * 64 + 32 * pt + 8 * q + 4 * hi);
#pragma unroll
        for (int st = 0; st < 4; ++st) if (st <= lt) {
            const int brw = 32 * st + l31;
            f32x16 cbt;
#pragma unroll
            for (int r = 0; r < 16; ++r) cbt[r] = 0.f;
#pragma unroll
            for (int kk = 0; kk < 8; ++kk) { const bf16x8 bf_ = *(const LAS bf16x8*)(Bl + brw * 272 + 32 * kk), cf_ = *(const LAS bf16x8*)(Cl + crw * 272 + 32 * kk); cbt = MFMA32(bf_, cf_, cbt); }
#pragma unroll
            for (int r = 0; r < 16; ++r) { const int sl = 32 * st + crow(r, hi); const float acs = S3TAB(sl), dts = S3TAB(128 + sl);
                float v = cbt[r] * __expf(acl - acs) * dts; if (st == lt && crow(r, hi) > l31) v = 0.f; cbt[r] = v; }
            bf16x8 pf[2];
#pragma unroll
            for (int ks = 0; ks < 2; ++ks) pf[ks] = pack8(cbt[8 * ks], cbt[8 * ks + 1], cbt[8 * ks + 2], cbt[8 * ks + 3], cbt[8 * ks + 4], cbt[8 * ks + 5], cbt[8 * ks + 6], cbt[8 * ks + 7]);
#pragma unroll
            for (int pt = 0; pt < 2; ++pt)
#pragma unroll
                for (int ks = 0; ks < 2; ++ks) { v4u a; a.x = xf[st][pt][ks][0].x; a.y = xf[st][pt][ks][0].y; a.z = xf[st][pt][ks][1].x; a.w = xf[st][pt][ks][1].y; y[pt] = MFMA32(__builtin_bit_cast(bf16x8, a), pf[ks], y[pt]); }
        }
#pragma unroll
        for (int pt = 0; pt < 2; ++pt)
#pragma unroll
            for (int q = 0; q < 4; ++q) { const u32x2 xx = xd[pt][q];
                const unsigned o0 = cvtpk(y[pt][4 * q] + D * bflo(xx.x), y[pt][4 * q + 1] + D * bfhi(xx.x)), o1 = cvtpk(y[pt][4 * q + 2] + D * bflo(xx.y), y[pt][4 * q + 3] + D * bfhi(xx.y));
                *(u32x2*)(yssm + (m0 + crw) * 512 + h * 64 + 32 * pt + 8 * q + 4 * hi) = (u32x2){o0, o1}; }
    }
#undef S3TAB
}
__device__ __forceinline__ void ssd_s1_unit(int unit, int lane, LAS float* tab, const bf16_t* __restrict__ xst, const bf16_t* __restrict__ bt, const float* __restrict__ dt, const float* __restrict__ a_log,
                                            float* __restrict__ sloc, float* __restrict__ asum) {
    const int h = unit & 7, c = (unit >> 3) & 15, b = unit >> 7, g = h >> 2, l0 = c * 128, l31 = lane & 31, hi = lane >> 5;
    const size_t m0 = (size_t)b * SEQ + l0;
    const float A = -expf(a_log[h]);
    const float d0 = dt[(m0 + lane) * 8 + h], d1 = dt[(m0 + 64 + lane) * 8 + h];
    float ac0 = d0 * A, ac1 = d1 * A;
    scan128(ac0, ac1, lane);
    const float aend = rl(ac1, 63);
    tab[lane] = __expf(aend - ac0) * d0; tab[64 + lane] = __expf(aend - ac1) * d1;
    if (lane == 0) asum[unit] = aend;
    WSYNC();
    f32x16 acc[2][4];
#pragma unroll
    for (int pt = 0; pt < 2; ++pt)
#pragma unroll
        for (int nt = 0; nt < 4; ++nt)
#pragma unroll
            for (int r = 0; r < 16; ++r) acc[pt][nt][r] = 0.f;
    const bf16_t* Xp = xst + ((size_t)(b * 8 + h) * 64 + l31) * SEQ + l0 + 8 * hi;
    const bf16_t* Bp = bt + ((size_t)(b * 2 + g) * 128 + l31) * SEQ + l0 + 8 * hi;
#pragma unroll 2
    for (int kk = 0; kk < 8; ++kk) {
        const f32x4 wa = *(const LAS f32x4*)(tab + 16 * kk + 8 * hi), wb = *(const LAS f32x4*)(tab + 16 * kk + 8 * hi + 4);
        bf16x8 af[2], bfr[4];
#pragma unroll
        for (int pt = 0; pt < 2; ++pt) { const v4u raw = *(const v4u*)(Xp + (size_t)pt * 32 * SEQ + 16 * kk);
            v4u w; w.x = cvtpk(bflo(raw.x) * wa[0], bfhi(raw.x) * wa[1]); w.y = cvtpk(bflo(raw.y) * wa[2], bfhi(raw.y) * wa[3]);
            w.z = cvtpk(bflo(raw.z) * wb[0], bfhi(raw.z) * wb[1]); w.w = cvtpk(bflo(raw.w) * wb[2], bfhi(raw.w) * wb[3]); af[pt] = __builtin_bit_cast(bf16x8, w); }
#pragma unroll
        for (int nt = 0; nt < 4; ++nt) bfr[nt] = *(const bf16x8*)(Bp + (size_t)nt * 32 * SEQ + 16 * kk);
#pragma unroll
        for (int pt = 0; pt < 2; ++pt)
#pragma unroll
            for (int nt = 0; nt < 4; ++nt) acc[pt][nt] = MFMA32(af[pt], bfr[nt], acc[pt][nt]);
    }
    float* dst = sloc + (size_t)unit * 8192 + l31;
#pragma unroll
    for (int pt = 0; pt < 2; ++pt)
#pragma unroll
        for (int nt = 0; nt < 4; ++nt)
#pragma unroll
            for (int r = 0; r < 16; ++r) dst[(32 * pt + crow(r, hi)) * 128 + 32 * nt] = acc[pt][nt][r];
    WSYNC();
}
__device__ __forceinline__ void ssd_s2_all(const float* __restrict__ sloc, const float* __restrict__ asum, bf16_t* __restrict__ stb, int gtid, int NT) {
    for (int i = gtid; i < 128 * 2048; i += NT) {
        const int bh = i >> 11, e4 = i & 2047, b = bh >> 3, h = bh & 7;
        f32x4 run = {0.f, 0.f, 0.f, 0.f};
#pragma unroll 4
        for (int c = 0; c < 16; ++c) { const int unit = (b * 16 + c) * 8 + h; const f32x4 tmp = *(const f32x4*)(sloc + (size_t)unit * 8192 + e4 * 4);
            uint2 w; w.x = cvtpk(run[0], run[1]); w.y = cvtpk(run[2], run[3]); *(uint2*)(stb + (size_t)unit * 8192 + e4 * 4) = w;
            run = run * __expf(asum[unit]) + tmp; }
    }
}
__device__ __forceinline__ void ssd_s3_unit(int unit, int lane, LAS float* tab, const bf16_t* __restrict__ xbc, const bf16_t* __restrict__ xst, const bf16_t* __restrict__ stb, const float* __restrict__ dt,
                                            const float* __restrict__ a_log, const float* __restrict__ dsk, bf16_t* __restrict__ yssm) {
    const int h = unit & 7, c = (unit >> 3) & 15, b = unit >> 7, g = h >> 2, l0 = c * 128, l31 = lane & 31, hi = lane >> 5;
    const size_t m0 = (size_t)b * SEQ + l0;
    const float A = -expf(a_log[h]), D = dsk[h];
    const float d0 = dt[(m0 + lane) * 8 + h], d1 = dt[(m0 + 64 + lane) * 8 + h];
    float ac0 = d0 * A, ac1 = d1 * A;
    scan128(ac0, ac1, lane);
    tab[lane] = ac0; tab[64 + lane] = ac1; tab[128 + lane] = d0; tab[192 + lane] = d1;
    WSYNC();
    const bf16_t* Cp = xbc + (m0 + l31) * 1024 + 768 + g * 128 + 8 * hi;
    const bf16_t* Sp = stb + (size_t)unit * 8192 + l31 * 128 + 8 * hi;
    const bf16_t* Bp = xbc + (m0 + l31) * 1024 + 512 + g * 128 + 8 * hi;
    const bf16_t* Xp = xst + ((size_t)(b * 8 + h) * 64 + l31) * SEQ + l0 + 4 * hi;
    LAS float* tr = tab + 256;
    const int row = lane >> 1, p0 = (lane & 1) * 16;
#pragma unroll 1
    for (int lt = 0; lt < 4; ++lt) {
        f32x16 y[2];
#pragma unroll
        for (int r = 0; r < 16; ++r) { y[0][r] = 0.f; y[1][r] = 0.f; }
        const float acl = tab[32 * lt + l31];
        bf16x8 cfr[8];
#pragma unroll
        for (int kk = 0; kk < 8; ++kk) cfr[kk] = *(const bf16x8*)(Cp + (size_t)lt * 32 * 1024 + 16 * kk);
        {   bf16x8 s0[8], s1[8];
#pragma unroll
            for (int kk = 0; kk < 8; ++kk) { s0[kk] = *(const bf16x8*)(Sp + 16 * kk); s1[kk] = *(const bf16x8*)(Sp + 32 * 128 + 16 * kk); }
#pragma unroll
            for (int kk = 0; kk < 8; ++kk) { y[0] = MFMA32(s0[kk], cfr[kk], y[0]); y[1] = MFMA32(s1[kk], cfr[kk], y[1]); }
        }
        { const float el = __expf(acl);
#pragma unroll
          for (int r = 0; r < 16; ++r) { y[0][r] *= el; y[1][r] *= el; } }
#pragma unroll 1
        for (int st = 0; st <= lt; ++st) {
            bf16x8 bfr[8]; u32x2 xf[2][2][2];
#pragma unroll
            for (int kk = 0; kk < 8; ++kk) bfr[kk] = *(const bf16x8*)(Bp + (size_t)st * 32 * 1024 + 16 * kk);
#pragma unroll
            for (int pt = 0; pt < 2; ++pt)
#pragma unroll
                for (int ks = 0; ks < 2; ++ks) { const bf16_t* xp = Xp + (size_t)pt * 32 * SEQ + st * 32 + 16 * ks; xf[pt][ks][0] = *(const u32x2*)xp; xf[pt][ks][1] = *(const u32x2*)(xp + 8); }
            f32x16 cbt;
#pragma unroll
            for (int r = 0; r < 16; ++r) cbt[r] = 0.f;
#pragma unroll
            for (int kk = 0; kk < 8; ++kk) cbt = MFMA32(bfr[kk], cfr[kk], cbt);
#pragma unroll
            for (int r = 0; r < 16; ++r) { const int sl = 32 * st + crow(r, hi); const float acs = tab[sl], dts = tab[128 + sl];
                float v = cbt[r] * __expf(acl - acs) * dts; if (st == lt && crow(r, hi) > l31) v = 0.f; cbt[r] = v; }
            bf16x8 pf[2];
#pragma unroll
            for (int ks = 0; ks < 2; ++ks) pf[ks] = pack8(cbt[8 * ks], cbt[8 * ks + 1], cbt[8 * ks + 2], cbt[8 * ks + 3], cbt[8 * ks + 4], cbt[8 * ks + 5], cbt[8 * ks + 6], cbt[8 * ks + 7]);
#pragma unroll
            for (int pt = 0; pt < 2; ++pt)
#pragma unroll
                for (int ks = 0; ks < 2; ++ks) { v4u a; a.x = xf[pt][ks][0].x; a.y = xf[pt][ks][0].y; a.z = xf[pt][ks][1].x; a.w = xf[pt][ks][1].y; y[pt] = MFMA32(__builtin_bit_cast(bf16x8, a), pf[ks], y[pt]); }
        }
#pragma unroll
        for (int pt = 0; pt < 2; ++pt) {
#pragma unroll
            for (int r = 0; r < 16; ++r) tr[l31 * 33 + crow(r, hi)] = y[pt][r];
            WSYNC();
            const size_t m = m0 + 32 * lt + row;
            const v4u xa = *(const v4u*)(xbc + m * 1024 + h * 64 + 32 * pt + p0), xb = *(const v4u*)(xbc + m * 1024 + h * 64 + 32 * pt + p0 + 8);
            const unsigned xu[8] = {xa.x, xa.y, xa.z, xa.w, xb.x, xb.y, xb.z, xb.w};
            unsigned ow[8];
#pragma unroll
            for (int q = 0; q < 8; ++q) { const float v0 = tr[row * 33 + p0 + 2 * q] + D * bflo(xu[q]), v1 = tr[row * 33 + p0 + 2 * q + 1] + D * bfhi(xu[q]); ow[q] = cvtpk(v0, v1); }
            bf16_t* dst = yssm + m * 512 + h * 64 + 32 * pt + p0;
            *(v4u*)dst = (v4u){ow[0], ow[1], ow[2], ow[3]}; *(v4u*)(dst + 8) = (v4u){ow[4], ow[5], ow[6], ow[7]};
            WSYNC();
        }
    }
}


__device__ __forceinline__ float sum8(float x) { x += dpp_mov<0xB1>(x); x += dpp_mov<0x4E>(x); x += dpp_mov<0x141>(x); return x; }
__device__ __forceinline__ float sum32(float x, int lane) { x = rowsum16(x); return x + bperm(lane ^ 16, x); }
__device__ __forceinline__ void unpack8(const v4u& w, float (&f)[8]) { f[0] = bflo(w.x); f[1] = bfhi(w.x); f[2] = bflo(w.y); f[3] = bfhi(w.y); f[4] = bflo(w.z); f[5] = bfhi(w.z); f[6] = bflo(w.w); f[7] = bfhi(w.w); }
__device__ __forceinline__ void ssm_gate_norm_vec(const bf16_t* __restrict__ yssm, const bf16_t* __restrict__ proj, const float* __restrict__ ng, bf16_t* __restrict__ ymix, int m0, int m1, int w, int nw, int lane) {
    const int c0 = lane * 8;
    float gn[8];
    { const f32x4 a = *(const f32x4*)(ng + c0), b = *(const f32x4*)(ng + c0 + 4); gn[0] = a[0]; gn[1] = a[1]; gn[2] = a[2]; gn[3] = a[3]; gn[4] = b[0]; gn[5] = b[1]; gn[6] = b[2]; gn[7] = b[3]; }
    for (int mb = m0 + w; mb < m1; mb += nw * 4) {
        v4u yv[4], zv[4];
#pragma unroll
        for (int k = 0; k < 4; ++k) { const int m = (mb + k * nw < m1) ? mb + k * nw : mb; yv[k] = *(const v4u*)(yssm + (size_t)m * 512 + c0); zv[k] = *(const v4u*)(proj + (size_t)m * L0P + 1792 + c0); }
#pragma unroll
        for (int k = 0; k < 4; ++k) { const int m = mb + k * nw;
            float y[8], z[8], u[8], q = 0.f; unpack8(yv[k], y); unpack8(zv[k], z);
#pragma unroll
            for (int j = 0; j < 8; ++j) { u[j] = y[j] * z[j] * __builtin_amdgcn_rcpf(1.f + __builtin_amdgcn_exp2f(-1.4426950408889634f * z[j])); q += u[j] * u[j]; }
            const float rs = __builtin_amdgcn_rsqf(sum32(q, lane) * (1.f / 256.f) + 1e-5f);
            v4u o; o.x = cvtpk(u[0] * rs * gn[0], u[1] * rs * gn[1]); o.y = cvtpk(u[2] * rs * gn[2], u[3] * rs * gn[3]); o.z = cvtpk(u[4] * rs * gn[4], u[5] * rs * gn[5]); o.w = cvtpk(u[6] * rs * gn[6], u[7] * rs * gn[7]);
            if (m < m1) *(v4u*)(ymix + (size_t)m * DM + 512 + c0) = o; }
    }
}
__device__ __forceinline__ void rwkv_post_vec(const float* __restrict__ yraw, const bf16_t* __restrict__ proj, const float* __restrict__ mix, const float* __restrict__ bonus, const bf16_t* __restrict__ gbuf,
                                              const float* __restrict__ ln_g, const float* __restrict__ ln_b, bf16_t* __restrict__ ymix, int gw, int NGW, int lane) {
    const int c0 = lane * 8, h = lane >> 3;
    float lg[8], lb[8], mx[8];
    { const f32x4 a = *(const f32x4*)(ln_g + c0), b = *(const f32x4*)(ln_g + c0 + 4), c = *(const f32x4*)(ln_b + c0), d = *(const f32x4*)(ln_b + c0 + 4), e = *(const f32x4*)(mix + 1024 + c0), f = *(const f32x4*)(mix + 1024 + c0 + 4);
#pragma unroll
      for (int j = 0; j < 4; ++j) { lg[j] = a[j]; lg[4 + j] = b[j]; lb[j] = c[j]; lb[4 + j] = d[j]; mx[j] = e[j]; mx[4 + j] = f[j]; } }
    for (int mb = gw; mb < M; mb += NGW * 2) {
        f32x4 ya[2], yb[2]; v4u cv[2], pv[2], gv[2]; float bo[2];
#pragma unroll
        for (int k = 0; k < 2; ++k) { const int m = mb + k * NGW; const bool hp = (m & (SEQ - 1)) != 0;
            ya[k] = *(const f32x4*)(yraw + (size_t)m * 512 + c0); yb[k] = *(const f32x4*)(yraw + (size_t)m * 512 + c0 + 4);
            cv[k] = *(const v4u*)(proj + (size_t)m * L0P + 1024 + c0); pv[k] = *(const v4u*)(proj + (size_t)(hp ? m - 1 : m) * L0P + 1024 + c0);
            gv[k] = *(const v4u*)(gbuf + (size_t)m * 512 + c0); bo[k] = bonus[(size_t)m * 8 + h]; }
#pragma unroll
        for (int k = 0; k < 2; ++k) { const int m = mb + k * NGW; const float pz = ((m & (SEQ - 1)) != 0) ? 1.f : 0.f;
            float y[8] = {ya[k][0], ya[k][1], ya[k][2], ya[k][3], yb[k][0], yb[k][1], yb[k][2], yb[k][3]}, cc[8], pp[8], gg[8];
            unpack8(cv[k], cc); unpack8(pv[k], pp); unpack8(gv[k], gg);
            float sm = 0.f;
#pragma unroll
            for (int j = 0; j < 8; ++j) sm += y[j];
            const float mu = sum8(sm) * (1.f / 64.f);
            float qv = 0.f;
#pragma unroll
            for (int j = 0; j < 8; ++j) { y[j] -= mu; qv += y[j] * y[j]; }
            const float rs = __builtin_amdgcn_rsqf(sum8(qv) * (1.f / 64.f) + 64e-5f);
            float o[8];
#pragma unroll
            for (int j = 0; j < 8; ++j) { const float vs = cc[j] + (pp[j] * pz - cc[j]) * mx[j]; o[j] = (y[j] * rs * lg[j] + lb[j] + bo[k] * vs) * gg[j]; }
            v4u w; w.x = cvtpk(o[0], o[1]); w.y = cvtpk(o[2], o[3]); w.z = cvtpk(o[4], o[5]); w.w = cvtpk(o[6], o[7]);
            *(v4u*)(ymix + (size_t)m * DM + c0) = w; }
    }
}

struct Args { const float* in[43]; float* out; unsigned char* ws; };
#define GEMM_PHASE(EPI, Aptr, LDA, Bptr, LDB, NN, KK, ...) do { pg8::Gemm g_{(Aptr), (Bptr), M, (NN), (KK), (LDA), (LDB)}; pg8::StaticOrder S_; S_.init(M, (NN), G, (int)blockIdx.x); \
        pg8::EPI E_{__VA_ARGS__}; pg8::gemm_phase<pg8::EPI, pg8::StaticOrder, true, true>(lds3, g_, S_, E_); } while (0)

__global__ void __launch_bounds__(NWAVES * 64, 2) fwd_mega(Args args) {
    extern __shared__ __attribute__((aligned(16))) unsigned char lds[];
    LAS unsigned char* lds3 = (LAS unsigned char*)lds;
    volatile LAS unsigned* MISC = (volatile LAS unsigned*)(lds3 + MISC_OFF);
    const int G = gridDim.x, NGW = G * NWAVES, NT = G * NWAVES * 64;
#define PHASE_IDS() int tid = threadIdx.x; asm volatile("" : "+v"(tid)); const int lane = tid & 63, wave = __builtin_amdgcn_readfirstlane(tid >> 6); const int gw = blockIdx.x * NWAVES + wave, gtid = blockIdx.x * (NWAVES * 64) + tid; (void)lane; (void)gw; (void)gtid
    unsigned char* ws = args.ws;
    gu32* ctl = (gu32*)(ws + WS_CTL);
    for (int u = threadIdx.x; u < (LDS_BYTES - LDSCTL_OFF) / 4; u += NWAVES * 64) ((LAS unsigned*)(lds3 + LDSCTL_OFF))[u] = 0u;
    __syncthreads();
    XcdBarrier bar = xcd_barrier_post((unsigned*)(ctl + CW_BAR), MISC + 8);
#if defined(PROBE_STAMPS)
    int nb_ = 0;
    if (blockIdx.x == 0 && threadIdx.x == 0) MISC[16] = (unsigned)__builtin_amdgcn_s_memrealtime();
#define GRID_BAR() do { xcd_barrier(bar); ++nb_; if (blockIdx.x == 0 && threadIdx.x == 0) MISC[16 + nb_] = (unsigned)__builtin_amdgcn_s_memrealtime(); } while (0)
#else
#define GRID_BAR() xcd_barrier(bar)
#endif
#define IN(i) (args.in[i])
    float* out = args.out;
    bf16_t* W0in = (bf16_t*)(ws + WS_W0IN); bf16_t* W0out = (bf16_t*)(ws + WS_W0OUT); bf16_t* Wup0 = (bf16_t*)(ws + WS_WUP0); bf16_t* Wdn0 = (bf16_t*)(ws + WS_WDN0);
    bf16_t* W1in = (bf16_t*)(ws + WS_W1IN); bf16_t* Wuq = (bf16_t*)(ws + WS_WUQ); bf16_t* Wukv = (bf16_t*)(ws + WS_WUKV); bf16_t* W1out = (bf16_t*)(ws + WS_W1OUT);
    bf16_t* Wup1 = (bf16_t*)(ws + WS_WUP1); bf16_t* Wdn1 = (bf16_t*)(ws + WS_WDN1);
    bf16_t* XB = (bf16_t*)(ws + WS_XB); bf16_t* YMIX = (bf16_t*)(ws + WS_YMIX); bf16_t* PROJ0 = (bf16_t*)(ws + WS_BIG);
    bf16_t* ZB = (bf16_t*)out; float* YRAW = out; bf16_t* YSSM = (bf16_t*)(out + (size_t)M * 512); bf16_t* STB = (bf16_t*)(out + (size_t)M * 768); bf16_t* XST = (bf16_t*)(ws + WS_XST); bf16_t* BT = (bf16_t*)(ws + WS_BT); float* ASUM = (float*)(ws + WS_ASUM); float* SLOC = (float*)(ws + WS_SLOC); float* DT = (float*)(ws + WS_DT); bf16_t* GB = (bf16_t*)(ws + WS_G); float* BONUS = (float*)(ws + WS_BONUS);
    bf16_t* W2T = (bf16_t*)(ws + WS_W2T); bf16_t* A2T = (bf16_t*)(ws + WS_A2T); bf16_t* G2T = (bf16_t*)(ws + WS_G2T); bf16_t* ACT = (bf16_t*)(ws + WS_GU); bf16_t* HALO = (bf16_t*)(ws + WS_GU + 176 * MiB);
    bf16_t* PROJ1 = (bf16_t*)(ws + WS_PROJ1); bf16_t* QM = (bf16_t*)(ws + WS_QM); bf16_t* KVM = (bf16_t*)(ws + WS_KVM); bf16_t* KPE = (bf16_t*)(ws + WS_KPE); float* RS = (float*)(ws + WS_RS); float* CSTAB = (float*)(ws + WS_CSTAB); float* STATS = (float*)(ws + WS_CSTAB + 4 * MiB); bf16_t* VTS = (bf16_t*)(ws + WS_VTS); bf16_t* VTM = (bf16_t*)(ws + WS_VTM);
    const int* pos = (const int*)args.in[1];

    {
        PHASE_IDS();
    {
        LAS float* scr = (LAS float*)(lds3 + wave * 16384); int trb = 0;
        transpose_matrix(IN(2), 1024, 3336, W0in, L0P, 1024, scr, gw, NGW, lane, nullptr, trb);
        transpose_matrix(IN(20), 1024, 1024, W0out, 1024, 1024, scr, gw, NGW, lane, nullptr, trb);
        transpose_matrix(IN(5), 64, 512, W2T, 512, 64, scr, gw, NGW, lane, nullptr, trb);
        transpose_matrix(IN(7), 64, 512, A2T, 512, 64, scr, gw, NGW, lane, nullptr, trb);
        transpose_matrix(IN(8), 128, 512, G2T, 512, 128, scr, gw, NGW, lane, nullptr, trb);
        const float* x = IN(0);
        {
            constexpr size_t TOT4 = (size_t)M * DM / 4;
            for (size_t i = gtid; i < TOT4; i += (size_t)NT * 8) {
                f32x4 v[8];
#pragma unroll
                for (int u = 0; u < 8; ++u) v[u] = *(const f32x4*)(x + (i + (size_t)u * NT) * 4);
#pragma unroll
                for (int u = 0; u < 8; ++u) { uint2 w; w.x = cvtpk(v[u][0], v[u][1]); w.y = cvtpk(v[u][2], v[u][3]); *(uint2*)(XB + (i + (size_t)u * NT) * 4) = w; }
            }
        }
    }
    }
    GRID_BAR();
    {
        PHASE_IDS();
    GEMM_PHASE(EpiBf16S, XB, DM, W0in, 1024, L0P, 1024, PROJ0, nullptr, L0P, 0);
    }
    GRID_BAR();
    {
        PHASE_IDS();
        const int blk = (int)blockIdx.x, m0 = blk * 128;
        {   LAS bf16_t* scr = (LAS bf16_t*)(lds3 + wave * 16384);
#pragma unroll 1
            for (int k = 0; k < 4; ++k) ssd_conv_tile((2 * blk + (k & 1)) * 16 + wave + 8 * (k >> 1), lane, scr, PROJ0, IN(14), IN(15), XB, XST, BT);
            for (int i = tid; i < 1024; i += NWAVES * 64) { const int m = m0 + (i >> 3); DT[(size_t)m * 8 + (i & 7)] = softplusf_(bf2f(PROJ0[(size_t)m * L0P + 3328 + (i & 7)]) + IN(16)[i & 7]); }
        }
        __syncthreads();
#if defined(PROBE_STAMPS)
        if (blockIdx.x == 0 && threadIdx.x == 0) MISC[16 + 29] = (unsigned)__builtin_amdgcn_s_memrealtime();
#endif
        ssd_s1_unit(blk * 8 + wave, lane, (LAS float*)(lds3 + wave * 16384), XST, BT, DT, IN(17), SLOC, ASUM);
    }
    GRID_BAR();
    {
        PHASE_IDS();
        ssd_s2_all(SLOC, ASUM, STB, gtid, NT);
    }
    GRID_BAR();
    {
        PHASE_IDS();
        const int blk = (int)blockIdx.x;
        if (blk < 128) {
            rwkv_phase_chain((LAS float*)lds3, tid, lane, wave, blk, PROJ0, IN(3), IN(4), IN(6), IN(9), IN(10), IN(11), W2T, A2T, G2T, YRAW, GB, BONUS);
#if defined(PROBE_STAMPS)
            if (blk == 0 && threadIdx.x == 0) MISC[16 + 23] = (unsigned)__builtin_amdgcn_s_memrealtime();
#endif
        } else {
            const int bc0 = (blk - 128) * 2;
#if defined(PROBE_STAMPS)
            const unsigned tu0_ = (unsigned)__builtin_amdgcn_s_memrealtime();
#endif
            {
                const int gwu = (blk - 128) * NWAVES + wave;
                gate_lora_wave(gwu, 128 * NWAVES, lane, PROJ0, IN(3), G2T, GB);
            }
#if defined(PROBE_STAMPS)
            __syncthreads(); if (blk == 128 && threadIdx.x == 0) __hip_atomic_store(ctl + 2049, (unsigned)__builtin_amdgcn_s_memrealtime() - tu0_, __ATOMIC_RELAXED, __HIP_MEMORY_SCOPE_AGENT);
#endif
#pragma unroll 1
            for (int u = 0; u < 2; ++u) ssd_s3_block(bc0 + u, tid, lane, wave, lds3, XB, XST, STB, DT, IN(17), IN(18), YSSM);
            __syncthreads();
#if defined(PROBE_STAMPS)
            __syncthreads(); if (blk == 128 && threadIdx.x == 0) __hip_atomic_store(ctl + 2050, (unsigned)__builtin_amdgcn_s_memrealtime() - tu0_, __ATOMIC_RELAXED, __HIP_MEMORY_SCOPE_AGENT);
#endif
            ssm_gate_norm_vec(YSSM, PROJ0, IN(19), YMIX, bc0 * 128, bc0 * 128 + 256, wave, NWAVES, lane);
#if defined(PROBE_STAMPS)
            __syncthreads(); if (blk == 128 && threadIdx.x == 0) __hip_atomic_store(ctl + 2051, (unsigned)__builtin_amdgcn_s_memrealtime() - tu0_, __ATOMIC_RELAXED, __HIP_MEMORY_SCOPE_AGENT);
#endif
            { const int gwu = (blk - 128) * NWAVES + wave, NGWU = 128 * NWAVES; LAS float* scr = (LAS float*)(lds3 + wave * 16384); int trb = 0;
              transpose_matrix(IN(23), 1024, 5632, Wup0, 5632, 1024, scr, gwu, NGWU, lane, nullptr, trb, true);
              transpose_matrix(IN(26), 2816, 1024, Wdn0, 1024, 2816, scr, gwu, NGWU, lane, nullptr, trb);
            }
#if defined(PROBE_STAMPS)
            __syncthreads(); if (blk == 128 && threadIdx.x == 0) __hip_atomic_store(ctl + 2048, (unsigned)__builtin_amdgcn_s_memrealtime() - tu0_, __ATOMIC_RELAXED, __HIP_MEMORY_SCOPE_AGENT);
#endif
        }
    }
    GRID_BAR();
    {
        PHASE_IDS();
        rwkv_post_vec(YRAW, PROJ0, IN(3), BONUS, GB, IN(12), IN(13), YMIX, gw, NGW, lane);
    }
    GRID_BAR();
    {
        PHASE_IDS();
    GEMM_PHASE(EpiResid, YMIX, DM, W0out, 1024, 1024, 1024, IN(0), ZB, ALPHA, 0);
    }
    GRID_BAR();
    {
        PHASE_IDS();
    ln_rows<1>(ZB, XB, nullptr, STATS, IN(21), IN(22), gw, NGW, lane);
    }
    GRID_BAR();
    {
        PHASE_IDS();
        { pg8::Gemm g_{XB, Wup0, M / 32, DFF, 1024, DM, 1024, 4096, 8192, 256, 512, 1}; pg8::StaticOrder S_; S_.init(M / 32, DFF, G, (int)blockIdx.x);
          pg8::EpiBf16S E_{HALO, nullptr, DFF, 0}; pg8::gemm_phase<pg8::EpiBf16S, pg8::StaticOrder, true, true>(lds3, g_, S_, E_); }
        if ((int)blockIdx.x >= 44) {
            const int gwu = ((int)blockIdx.x - 44) * NWAVES + wave, NGWU = (G - 44) * NWAVES; LAS float* scr = (LAS float*)(lds3 + wave * 16384); int trb = 0;
            transpose_matrix(IN(29), 1024, 1952, W1in, L1P, 1024, scr, gwu, NGWU, lane, nullptr, trb);
            transpose_matrix(IN(31), 256, 768, Wuq, 768, 256, scr, gwu, NGWU, lane, IN(30), trb);
            transpose_matrix(IN(33), 128, 1024, Wukv, 1024, 256, scr, gwu, NGWU, lane, IN(32), trb);
            transpose_matrix(IN(34), 1024, 1024, W1out, 1024, 1024, scr, gwu, NGWU, lane, nullptr, trb);
            transpose_matrix(IN(37), 1024, 5632, Wup1, 5632, 1024, scr, gwu, NGWU, lane, nullptr, trb, true);
            transpose_matrix(IN(40), 2816, 1024, Wdn1, 1024, 2816, scr, gwu, NGWU, lane, nullptr, trb);
            for (int i = gwu * 64 + lane; i < 1024 * 16; i += NGWU * 64) { const int n = i >> 4, c = i & 15; *(v4u*)(Wukv + (size_t)n * 256 + 128 + c * 8) = (v4u){0u, 0u, 0u, 0u}; }
        }
    }
    GRID_BAR();
    {
        PHASE_IDS();
        { pg8::Gemm g_{XB, Wup0, M, 2 * DFF, 1024, DM, 1024}; pg8::StaticOrder S_; S_.init(M, 2 * DFF, G, (int)blockIdx.x);
          pg8::EpiConvAct E_{ACT, HALO, IN(24), IN(25), DFF, SEQ}; pg8::gemm_phase<pg8::EpiConvAct, pg8::StaticOrder, true, true>(lds3, g_, S_, E_); }
    }
    GRID_BAR();
    {
        PHASE_IDS();
    GEMM_PHASE(EpiResidLN, ACT, DFF, Wdn0, DFF, 1024, DFF, ZB, ZB, STATS, IN(21), IN(22), ALPHA, 0);
    }
    GRID_BAR();
    {
        PHASE_IDS();
    ln_rows<1>(ZB, XB, nullptr, STATS, IN(27), IN(28), gw, NGW, lane);
    }
    GRID_BAR();
    {
        PHASE_IDS();
    GEMM_PHASE(EpiBf16S, XB, DM, W1in, 1024, L1P, 1024, PROJ1, nullptr, L1P, 0);
    }
    GRID_BAR();
    {
        PHASE_IDS();
    mla_prep_all(PROJ1, pos, RS, KPE, CSTAB, gw, NGW, lane);
    {
        LAS bf16_t* scr = (LAS bf16_t*)(lds3 + wave * 16384);
        for (int r = gw; r < 4096; r += NGW) { const int bh = r >> 5, tt = r & 31, b = bh >> 3, h = bh & 7;
            transpose_tile64(PROJ1 + ((size_t)b * SEQ + tt * 64) * L1P + 1024 + h * 64, L1P, VTS + (size_t)bh * 64 * SEQ + tt * 64, SEQ, scr, lane); }
    }
    }
    GRID_BAR();
    {
        PHASE_IDS();
    GEMM_PHASE(EpiBf16S, PROJ1 + 1536, L1P, Wuq, 256, 768, 256, QM, RS, 768, 2);
    GEMM_PHASE(EpiBf16S, PROJ1 + 1792, L1P, Wukv, 256, 1024, 256, KVM, RS + 1, 1024, 2);
    }
    GRID_BAR();
    {
        PHASE_IDS();
    {
        LAS bf16_t* scr = (LAS bf16_t*)(lds3 + wave * 16384);
        for (int r = gw; r < 4096; r += NGW) { const int bh = r >> 5, tt = r & 31, b = bh >> 3, h = bh & 7;
            transpose_tile64(KVM + ((size_t)b * SEQ + tt * 64) * 1024 + h * 128 + 64, 1024, VTM + (size_t)bh * 64 * SEQ + tt * 64, SEQ, scr, lane); }
    }
    }
    GRID_BAR();
    {
        PHASE_IDS();
    {
        { LAS unsigned char* wl = lds3 + wave * 16384;
          for (int g2 = gw; g2 < 2048; g2 += NGW) { const int bh = g2 >> 4, w = g2 & 15;
#pragma unroll 1
              for (int i = 0; i < 4; ++i) { const int qb = (i == 0) ? w : (i == 1) ? 31 - w : (i == 2) ? 32 + w : 63 - w; sb_wave(bh, qb, lane, PROJ1, VTS, YMIX, wl); } } }
        __syncthreads();
        for (int g2 = (int)blockIdx.x; g2 < 256; g2 += G) { const int bh = g2 >> 1, part = g2 & 1;
#pragma unroll 1
            for (int i = 0; i < 4; ++i) { const int sbk = part ? ((i == 0) ? 1 : (i == 1) ? 6 : (i == 2) ? 2 : 5) : ((i == 0) ? 0 : (i == 1) ? 7 : (i == 2) ? 3 : 4);
                mla_block(bh, sbk, tid, lane, wave, lds3, QM, KVM, KPE, VTM, YMIX, CSTAB); } }
    }
    }
    GRID_BAR();
    {
        PHASE_IDS();
    GEMM_PHASE(EpiResidLN, YMIX, DM, W1out, 1024, 1024, 1024, ZB, ZB, STATS, IN(27), IN(28), ALPHA, 0);
    }
    GRID_BAR();
    {
        PHASE_IDS();
    ln_rows<1>(ZB, XB, nullptr, STATS, IN(35), IN(36), gw, NGW, lane);
    }
    GRID_BAR();
    {
        PHASE_IDS();
        { pg8::Gemm g_{XB, Wup1, M / 32, DFF, 1024, DM, 1024, 4096, 8192, 256, 512, 1}; pg8::StaticOrder S_; S_.init(M / 32, DFF, G, (int)blockIdx.x);
          pg8::EpiBf16S E_{HALO, nullptr, DFF, 0}; pg8::gemm_phase<pg8::EpiBf16S, pg8::StaticOrder, true, true>(lds3, g_, S_, E_); }
    }
    GRID_BAR();
    {
        PHASE_IDS();
        { pg8::Gemm g_{XB, Wup1, M, 2 * DFF, 1024, DM, 1024}; pg8::StaticOrder S_; S_.init(M, 2 * DFF, G, (int)blockIdx.x);
          pg8::EpiConvAct E_{ACT, HALO, IN(38), IN(39), DFF, SEQ}; pg8::gemm_phase<pg8::EpiConvAct, pg8::StaticOrder, true, true>(lds3, g_, S_, E_); }
    }
    GRID_BAR();
    {
        PHASE_IDS();
    GEMM_PHASE(EpiResidLN, ACT, DFF, Wdn1, DFF, 1024, DFF, ZB, XB, STATS, IN(35), IN(36), ALPHA, 0);
    }
    GRID_BAR();
    {
        PHASE_IDS();
    ln_rows<2>(XB, nullptr, out, STATS, IN(41), IN(42), gw, NGW, lane);
    #if defined(PROBE_STAMPS)
    __syncthreads();
    if (blockIdx.x == 0 && threadIdx.x == 0) {
        MISC[16 + 22] = (unsigned)__builtin_amdgcn_s_memrealtime();
#if defined(PROBE_GLOBAL)
#ifndef PROBE_GIDX
#define PROBE_GIDX 0
#endif
        const unsigned d1 = __hip_atomic_load(ctl + 2048 + PROBE_GIDX, __ATOMIC_RELAXED, __HIP_MEMORY_SCOPE_AGENT);
#elif defined(PROBE_ACC)
        const unsigned d1 = MISC[16 + PROBE_ACC];
#else
        const unsigned d1 = MISC[16 + PROBE_T1_HI] - MISC[16 + PROBE_T1_LO];
#endif
        const unsigned long long spin = 100ull * d1;
        const unsigned long long t0 = __builtin_amdgcn_s_memrealtime();
        while (__builtin_amdgcn_s_memrealtime() - t0 < spin) __builtin_amdgcn_s_sleep(8);
    }
#endif
}
}

extern "C" void kernel_launch(void* const* d_in, const int* in_sizes, int n_in, void* d_out, int out_size, void* d_ws, size_t ws_size, hipStream_t stream) {
    static int grid = 0;
    if (grid == 0) {
        if (n_in != 43 || ws_size < WS_NEED || out_size != M * DM) { fprintf(stderr, "kernel_launch: unexpected n_in %d / ws %zu / out %d\n", n_in, ws_size, out_size); grid = -1; return; }
        int dev = 0, cus = 0, per_cu = 0;
        if (hipGetDevice(&dev) != hipSuccess || hipDeviceGetAttribute(&cus, hipDeviceAttributeMultiprocessorCount, dev) != hipSuccess) { grid = -1; return; }
        if (hipFuncSetAttribute((const void*)fwd_mega, hipFuncAttributeMaxDynamicSharedMemorySize, LDS_BYTES) != hipSuccess) { fprintf(stderr, "kernel_launch: hipFuncSetAttribute failed\n"); grid = -1; return; }
        if (hipOccupancyMaxActiveBlocksPerMultiprocessor(&per_cu, (const void*)fwd_mega, NWAVES * 64, LDS_BYTES) != hipSuccess || per_cu < 1) fprintf(stderr, "kernel_launch: occupancy query reports %d\n", per_cu);
        (void)hipGetLastError();
        grid = cus;
    }
    if (grid < 0) return;
    (void)hipMemsetAsync((char*)d_ws + WS_CTL, 0, CTL_ZERO_BYTES, stream);
    Args a{};
    for (int i = 0; i < 43; ++i) a.in[i] = (const float*)d_in[i];
    a.out = (float*)d_out; a.ws = (unsigned char*)d_ws;
    hipLaunchKernelGGL(fwd_mega, dim3(grid), dim3(NWAVES * 64), LDS_BYTES, stream, a);
}
```

```cpp
#include <hip/hip_runtime.h>
#include <cstdio>
#include <cstdint>
#include <cmath>
namespace pg8 {
#define PG8_LAS __attribute__((address_space(3)))
typedef unsigned short bf16_t;
typedef short bf16x8 __attribute__((ext_vector_type(8)));
typedef float f32x4 __attribute__((ext_vector_type(4)));
typedef unsigned u32x4 __attribute__((ext_vector_type(4)));
constexpr int BM = 256, BK = 64, HALF = 128, HTB = HALF * BK * 2  , STAGE_BYTES = 8 * HTB, NXCD = 8, WGM = 8;

__host__ __device__ __forceinline__ int lds_byte(int r, int c) { const int st = (r >> 4) * 2 + (c >> 5), rr = r & 15, cc = c & 31, ob = rr * 64 + cc * 2; return st * 1024 + (ob ^ (((ob >> 9) & 1) << 5)); }
__host__ __device__ __forceinline__ void stage_rc(int b, int& R, int& C) { const int st = b / 1024, sb = b % 1024, swz = sb ^ (((sb >> 9) & 1) << 5); R = (st >> 1) * 16 + swz / 64; C = (st & 1) * 32 + (swz % 64) / 2; }
__host__ __device__ __forceinline__ int perm32(int rho) { const int n = rho >> 4, i = rho & 15; return 8 * (i >> 2) + 4 * n + (i & 3); }

struct Unit { int pm, pn; };
struct Gemm { const bf16_t* A; const bf16_t* Bt; int M, N, K, lda, ldb; int hrA = 128, trA = 256, hrB = 128, trB = 256, gatherA = 0, permA = 0; };

struct StaticOrder {
    int nM, nN, nwg, G, c;
    __host__ __device__ void init(int M, int N, int G_, int c_) { nM = M / BM; nN = N / BM; nwg = nM * nN; G = G_; c = c_; }
    __host__ __device__ bool next(int i, Unit& u) const {
        const long L = (long)i * G + c; if (L >= nwg) return false;
        int wgid = (int)L; { const int q = nwg / NXCD, r = nwg % NXCD, xcd = wgid % NXCD, off = wgid / NXCD; wgid = (xcd < r ? xcd * (q + 1) : r * (q + 1) + (xcd - r) * q) + off; }
        const int nig = WGM * nN, gid = wgid / nig, fm = gid * WGM, gsz = (nM - fm) < WGM ? (nM - fm) : WGM;
        u.pm = fm + ((wgid % nig) % gsz); u.pn = (wgid % nig) / gsz; return true;
    }
    __device__ __forceinline__ void a_ready(const Unit&) const {}
    __device__ __forceinline__ void done(const Unit&) const {}
};


__device__ __forceinline__ unsigned cvt_pk_bf16(float lo, float hi) { unsigned r; asm volatile("v_cvt_pk_bf16_f32 %0, %1, %2" : "=v"(r) : "v"(lo), "v"(hi)); return r; }
struct EpiBf16S {
    static constexpr bool PERM = true, AFTER_DRAIN = false;
    bf16_t* O; const float* rowscale; int ldc; int rs_stride;
    __device__ __forceinline__ void operator()(const f32x4 (&acc)[2][2][4][2], const Unit& u, int wr, int wc, int fr, int fq) const {
        const int row0 = u.pm * BM + wr * 64 + fr, col0 = u.pn * BM + wc * 32 + 8 * fq;
#pragma unroll
        for (int ai = 0; ai < 2; ++ai)
#pragma unroll
            for (int m = 0; m < 4; ++m) { const int row = row0 + ai * HALF + m * 16; const float sc = rowscale ? rowscale[(size_t)row * rs_stride] : 1.f;
                bf16_t* rowp = O + (size_t)row * ldc + col0;
#pragma unroll
                for (int bj = 0; bj < 2; ++bj) { const f32x4 v0 = acc[ai][bj][m][0] * sc, v1 = acc[ai][bj][m][1] * sc;
                    u32x4 w; w.x = cvt_pk_bf16(v0[0], v0[1]); w.y = cvt_pk_bf16(v0[2], v0[3]); w.z = cvt_pk_bf16(v1[0], v1[1]); w.w = cvt_pk_bf16(v1[2], v1[3]);
                    *(u32x4*)(rowp + bj * HALF) = w; } }
    }
};
struct EpiResid {
    static constexpr bool PERM = false, AFTER_DRAIN = false;
    const float* hin; bf16_t* hout; float alpha; int pad;
    __device__ __forceinline__ void operator()(const f32x4 (&acc)[2][2][4][2], const Unit& u, int wr, int wc, int fr, int fq) const {
        typedef unsigned u32x2r __attribute__((ext_vector_type(2)));
        const int row0 = u.pm * BM + wr * 64 + fr, col0 = u.pn * BM + wc * 32 + 4 * fq;
#pragma unroll
        for (int ai = 0; ai < 2; ++ai)
#pragma unroll
            for (int m = 0; m < 4; ++m) { const size_t off = (size_t)(row0 + ai * HALF + m * 16) * 1024 + col0;
#pragma unroll
                for (int bj = 0; bj < 2; ++bj)
#pragma unroll
                    for (int n = 0; n < 2; ++n) { const size_t i = off + bj * HALF + n * 16; const f32x4 h = *(const f32x4*)(hin + i); const f32x4 al4 = {alpha, alpha, alpha, alpha}; const f32x4 o = __builtin_elementwise_fma(h, al4, acc[ai][bj][m][n]);
                        u32x2r w; w.x = cvt_pk_bf16(o[0], o[1]); w.y = cvt_pk_bf16(o[2], o[3]); *(u32x2r*)(hout + i) = w; } }
    }
};

struct EpiResidLN {
    static constexpr bool PERM = false, AFTER_DRAIN = false;
    const bf16_t* hin; bf16_t* hout; const float* stats; const float* g; const float* b; float alpha; int pad;
    __device__ __forceinline__ void operator()(const f32x4 (&acc)[2][2][4][2], const Unit& u, int wr, int wc, int fr, int fq) const {
        typedef unsigned u32x2r __attribute__((ext_vector_type(2)));
        const int row0 = u.pm * BM + wr * 64 + fr, col0 = u.pn * BM + wc * 32 + 4 * fq;
        f32x4 gg[2][2], bb[2][2];
#pragma unroll
        for (int bj = 0; bj < 2; ++bj)
#pragma unroll
            for (int n = 0; n < 2; ++n) { gg[bj][n] = *(const f32x4*)(g + col0 + bj * HALF + n * 16) * alpha; bb[bj][n] = *(const f32x4*)(b + col0 + bj * HALF + n * 16) * alpha; }
#pragma unroll
        for (int ai = 0; ai < 2; ++ai)
#pragma unroll
            for (int m = 0; m < 4; ++m) { const int row = row0 + ai * HALF + m * 16; const size_t off = (size_t)row * 1024 + col0;
                const float mu = stats[2 * row], rs = stats[2 * row + 1];
#pragma unroll
                for (int bj = 0; bj < 2; ++bj)
#pragma unroll
                    for (int n = 0; n < 2; ++n) { const size_t i = off + bj * HALF + n * 16; const u32x2r pw = *(const u32x2r*)(hin + i);
                        f32x4 p; p[0] = __builtin_bit_cast(float, pw.x << 16); p[1] = __builtin_bit_cast(float, pw.x & 0xffff0000u); p[2] = __builtin_bit_cast(float, pw.y << 16); p[3] = __builtin_bit_cast(float, pw.y & 0xffff0000u);
                        const f32x4 A4 = gg[bj][n] * rs, nmu4 = {-mu, -mu, -mu, -mu};
                        const f32x4 o = __builtin_elementwise_fma(p, A4, __builtin_elementwise_fma(A4, nmu4, bb[bj][n]) + acc[ai][bj][m][n]);
                        u32x2r w; w.x = cvt_pk_bf16(o[0], o[1]); w.y = cvt_pk_bf16(o[2], o[3]); *(u32x2r*)(hout + i) = w; } }
    }
};

template <int CTRL> __device__ __forceinline__ float pg_dpp(float x) { return __builtin_bit_cast(float, __builtin_amdgcn_update_dpp(0, __builtin_bit_cast(int, x), CTRL, 0xF, 0xF, true)); }
struct EpiConvAct {
    static constexpr bool PERM = true, AFTER_DRAIN = false;
    bf16_t* act; const bf16_t* halo; const float* cw; const float* cb; int dff; int seq;
    template <int CTRL> static __device__ __forceinline__ float dpp_old(float old, float x) { return __builtin_bit_cast(float, __builtin_amdgcn_update_dpp(__builtin_bit_cast(int, old), __builtin_bit_cast(int, x), CTRL, 0xF, 0xF, false)); }
    __device__ __forceinline__ void operator()(const f32x4 (&acc)[2][2][4][2], const Unit& u, int wr, int wc, int fr, int fq) const {
        typedef unsigned u32x2e __attribute__((ext_vector_type(2)));
#pragma unroll
        for (int n = 0; n < 2; ++n) {
            const int ch0 = u.pn * 128 + wc * 32 + 8 * fq + 4 * n;
            const f32x4 w0 = *(const f32x4*)(cw + ch0), w1 = *(const f32x4*)(cw + dff + ch0), w2 = *(const f32x4*)(cw + 2 * dff + ch0), bb = *(const f32x4*)(cb + ch0);
#pragma unroll
            for (int ai = 0; ai < 2; ++ai) {
                const int rb64 = u.pm * BM + ai * HALF + wr * 64;
                f32x4 H2 = {0.f, 0.f, 0.f, 0.f}, H3 = {0.f, 0.f, 0.f, 0.f};
                if ((rb64 & (seq - 1)) != 0 && fr == 0) { const bf16_t* hp = halo + (size_t)(2 * (rb64 / 64 - 1)) * dff + ch0; const u32x2e h2 = *(const u32x2e*)hp, h3 = *(const u32x2e*)(hp + dff);
                    H2[0] = __builtin_bit_cast(float, h2.x << 16); H2[1] = __builtin_bit_cast(float, h2.x & 0xffff0000u); H2[2] = __builtin_bit_cast(float, h2.y << 16); H2[3] = __builtin_bit_cast(float, h2.y & 0xffff0000u);
                    H3[0] = __builtin_bit_cast(float, h3.x << 16); H3[1] = __builtin_bit_cast(float, h3.x & 0xffff0000u); H3[2] = __builtin_bit_cast(float, h3.y << 16); H3[3] = __builtin_bit_cast(float, h3.y & 0xffff0000u); }
                const f32x4 G0 = acc[ai][0][0][n], G1 = acc[ai][0][1][n], G2 = acc[ai][0][2][n], G3 = acc[ai][0][3][n];
                f32x4 S2, S3;
#pragma unroll
                for (int e = 0; e < 4; ++e) { S2[e] = dpp_old<0x111>(H2[e], G2[e]); S3[e] = dpp_old<0x111>(H3[e], G3[e]); }
#pragma unroll
                for (int m = 0; m < 4; ++m) {
                    const f32x4 Gv = acc[ai][0][m][n], Uv = acc[ai][1][m][n];
                    const f32x4 g1 = (m == 0) ? S3 : (m == 1) ? G0 : (m == 2) ? G1 : G2, g2 = (m == 0) ? S2 : (m == 1) ? S3 : (m == 2) ? G0 : G1;
                    typedef float f32x2e __attribute__((ext_vector_type(2)));
                    f32x2e oh[2];
#pragma unroll
                    for (int hq = 0; hq < 2; ++hq) {
                        const f32x2e g2p = hq ? g2.hi : g2.lo, g1p = hq ? g1.hi : g1.lo, Gp = hq ? Gv.hi : Gv.lo, Up = hq ? Uv.hi : Uv.lo;
                        const f32x2e w0p = hq ? w0.hi : w0.lo, w1p = hq ? w1.hi : w1.lo, w2p = hq ? w2.hi : w2.lo, bp = hq ? bb.hi : bb.lo;
                        const f32x2e y = __builtin_elementwise_fma(w0p, g2p, __builtin_elementwise_fma(w1p, g1p, __builtin_elementwise_fma(w2p, Gp, bp)));
                        const f32x2e t = y * -1.4426950408889634f;
                        f32x2e den; den.x = __builtin_amdgcn_exp2f(t.x); den.y = __builtin_amdgcn_exp2f(t.y); den = den + 1.f;
                        f32x2e r; r.x = __builtin_amdgcn_rcpf(den.x); r.y = __builtin_amdgcn_rcpf(den.y);
                        oh[hq] = y * r * Up;
                    }
                    u32x2e w; w.x = cvt_pk_bf16(oh[0].x, oh[0].y); w.y = cvt_pk_bf16(oh[1].x, oh[1].y);
                    *(u32x2e*)(act + (size_t)(rb64 + 4 * fr + m) * dff + ch0) = w;
                }
            }
        }
    }
};

template <class Epi, class Sched, bool ALIGN_EPI = false, bool SP2 = false>
__device__ __forceinline__ void gemm_phase(PG8_LAS unsigned char* lds, const Gemm g, const Sched& S, const Epi& E) {
    int tid = threadIdx.x; asm volatile("" : "+v"(tid));
    const int wid = __builtin_amdgcn_readfirstlane(tid >> 6), lane = tid & 63, wr = wid >> 2, wc = wid & 3, fr = lane & 15, fq = lane >> 4;
    const int K = g.K, nt = K / BK;
    unsigned voffA[2], voffB[2];
#pragma unroll
    for (int i = 0; i < 2; ++i) { int R, C; stage_rc(tid * 16 + i * 8192, R, C); const int Rb = Epi::PERM ? ((R & ~31) + perm32(R & 31)) : R;
        const int Ra = g.gatherA ? (64 * (R >> 1) + 62 + (R & 1)) : g.permA ? ((R & ~63) | ((R & 15) << 2) | ((R >> 4) & 3)) : R;
        voffA[i] = (unsigned)(Ra * g.lda + C) * 2u; voffB[i] = (unsigned)(Rb * g.ldb + C) * 2u; }
    const size_t kstep = (size_t)(BK * 2);
    const size_t hstepA = (size_t)g.hrA * g.lda * 2, hstepB = (size_t)g.hrB * g.ldb * 2;
    const size_t tstepA = (size_t)g.trA * g.lda * 2, tstepB = (size_t)g.trB * g.ldb * 2;
    const unsigned ldsw = (unsigned)wid * 1024u;
    const int aoff = lds_byte(wr * 64 + fr, fq * 8), boff = lds_byte(wc * 32 + fr, fq * 8);
#define PG8_SA(b, h) (((b) * 2 + (h)) * HTB)
#define PG8_SB(b, h) ((4 + (b) * 2 + (h)) * HTB)
#define PG8_STAGE(bufoff, gbase, voff) do { _Pragma("unroll") for (int _i = 0; _i < 2; ++_i) \
        __builtin_amdgcn_global_load_lds((const unsigned*)((const char*)(gbase) + (voff)[_i]), (PG8_LAS unsigned*)(lds + (bufoff) + ldsw + _i * 8192), 16, 0, 0); } while (0)
#define PG8_LDA(dst, b, h) do { _Pragma("unroll") for (int m = 0; m < 4; ++m) _Pragma("unroll") for (int k = 0; k < 2; ++k) dst[m][k] = *(const PG8_LAS bf16x8*)(lds + PG8_SA(b, h) + aoff + m * 2048 + k * 1024); } while (0)
#define PG8_LDB(dst, b, h) do { _Pragma("unroll") for (int n = 0; n < 2; ++n) _Pragma("unroll") for (int k = 0; k < 2; ++k) dst[n][k] = *(const PG8_LAS bf16x8*)(lds + PG8_SB(b, h) + boff + n * 2048 + k * 1024); } while (0)
#define PG8_MMA(ai, bj, At, Bt) do { __builtin_amdgcn_s_setprio(1); _Pragma("unroll") for (int m = 0; m < 4; ++m) _Pragma("unroll") for (int n = 0; n < 2; ++n) _Pragma("unroll") for (int k = 0; k < 2; ++k) \
        acc[ai][bj][m][n] = __builtin_amdgcn_mfma_f32_16x16x32_bf16(Bt[n][k], At[m][k], acc[ai][bj][m][n], 0, 0, 0); __builtin_amdgcn_s_setprio(0); } while (0)
#define PG8_WAIT_V(n) asm volatile("s_waitcnt vmcnt(" #n ")" ::: "memory")
#define PG8_WAIT_L(n) asm volatile("s_waitcnt lgkmcnt(" #n ")" ::: "memory")
#define PG8_BAR __builtin_amdgcn_s_barrier()
#define PG8_SCHED __builtin_amdgcn_sched_barrier(0)
    Unit cur, nxt; int ui = 0;
    if (!S.next(0, cur)) return;
    f32x4 acc[2][2][4][2];
#pragma unroll
    for (int a = 0; a < 2; ++a)
#pragma unroll
        for (int b = 0; b < 2; ++b)
#pragma unroll
            for (int m = 0; m < 4; ++m)
#pragma unroll
                for (int n = 0; n < 2; ++n) acc[a][b][m][n] = (f32x4){0.f, 0.f, 0.f, 0.f};
    bf16x8 At[4][2], B0[2][2], B1[2][2];
    const char* cA = (const char*)g.A + (size_t)cur.pm * tstepA; const char* cB = (const char*)g.Bt + (size_t)cur.pn * tstepB;
    S.a_ready(cur);
    if constexpr (SP2) {
        PG8_STAGE(PG8_SB(0, 0), cB, voffB); PG8_STAGE(PG8_SB(0, 1), cB + hstepB, voffB); PG8_STAGE(PG8_SA(0, 0), cA, voffA); PG8_STAGE(PG8_SA(0, 1), cA + hstepA, voffA);
        if (wr == 1) PG8_BAR;
        PG8_WAIT_V(2); PG8_BAR;
        PG8_STAGE(PG8_SB(1, 0), cB + kstep, voffB); PG8_STAGE(PG8_SA(1, 0), cA + kstep, voffA); PG8_STAGE(PG8_SB(1, 1), cB + hstepB + kstep, voffB);
        PG8_WAIT_V(6); PG8_BAR;
    } else {
        PG8_STAGE(PG8_SB(0, 0), cB, voffB); PG8_STAGE(PG8_SA(0, 0), cA, voffA); PG8_STAGE(PG8_SB(0, 1), cB + hstepB, voffB); PG8_STAGE(PG8_SA(0, 1), cA + hstepA, voffA);
        if (wr == 1) PG8_BAR;
        PG8_WAIT_V(4); PG8_BAR;
        PG8_STAGE(PG8_SB(1, 0), cB + kstep, voffB); PG8_STAGE(PG8_SA(1, 0), cA + kstep, voffA); PG8_STAGE(PG8_SB(1, 1), cB + hstepB + kstep, voffB);
        PG8_WAIT_V(6); PG8_BAR;
    }
    for (;;) {
        const bool has_next = S.next(ui + 1, nxt);
        const char* nA = has_next ? (const char*)g.A + (size_t)nxt.pm * tstepA : cA; const char* nB = has_next ? (const char*)g.Bt + (size_t)nxt.pn * tstepB : cB;
        for (int t = 0; t < nt; t += 2) {
            const bool last = (t == nt - 2);
            const char* a1 = cA + (size_t)(t + 1) * kstep;
            const char* a2 = last ? nA : cA + (size_t)(t + 2) * kstep; const char* b2 = last ? nB : cB + (size_t)(t + 2) * kstep;
            const char* a3 = a2 + kstep; const char* b3 = b2 + kstep;
            if (last && has_next) S.a_ready(nxt);
            if constexpr (SP2) {
            PG8_LDB(B0, 0, 0); PG8_LDB(B1, 0, 1); PG8_SCHED; PG8_LDA(At, 0, 0); PG8_STAGE(PG8_SA(1, 1), a1 + hstepA, voffA);
            PG8_WAIT_V(8); PG8_WAIT_L(0); PG8_BAR; PG8_MMA(0, 0, At, B0); PG8_MMA(0, 1, At, B1); PG8_BAR; PG8_SCHED;
            PG8_LDA(At, 0, 1); PG8_STAGE(PG8_SB(0, 0), b2, voffB); PG8_STAGE(PG8_SB(0, 1), b2 + hstepB, voffB); PG8_STAGE(PG8_SA(0, 0), a2, voffA);
            PG8_WAIT_V(8); PG8_WAIT_L(0); PG8_BAR; PG8_MMA(1, 0, At, B0); PG8_MMA(1, 1, At, B1); PG8_BAR; PG8_SCHED;
            PG8_LDB(B0, 1, 0); PG8_LDB(B1, 1, 1); PG8_SCHED; PG8_LDA(At, 1, 0); PG8_STAGE(PG8_SA(0, 1), a2 + hstepA, voffA);
            PG8_WAIT_V(8); PG8_WAIT_L(0); PG8_BAR; PG8_MMA(0, 0, At, B0); PG8_MMA(0, 1, At, B1); PG8_BAR; PG8_SCHED;
            PG8_LDA(At, 1, 1); PG8_STAGE(PG8_SB(1, 0), b3, voffB); PG8_STAGE(PG8_SB(1, 1), b3 + hstepB, voffB); PG8_STAGE(PG8_SA(1, 0), a3, voffA);
            PG8_WAIT_V(8); PG8_WAIT_L(0); PG8_BAR; PG8_MMA(1, 0, At, B0); PG8_MMA(1, 1, At, B1); PG8_BAR; PG8_SCHED;
            } else {
            PG8_LDB(B0, 0, 0); PG8_SCHED; PG8_LDA(At, 0, 0); PG8_STAGE(PG8_SA(1, 1), a1 + hstepA, voffA);
            PG8_WAIT_L(8); PG8_BAR; PG8_WAIT_L(0); PG8_MMA(0, 0, At, B0); PG8_BAR; PG8_SCHED;
            PG8_LDB(B1, 0, 1); PG8_STAGE(PG8_SB(0, 0), b2, voffB);
            PG8_BAR; PG8_WAIT_L(0); PG8_MMA(0, 1, At, B1); PG8_BAR;
            PG8_LDA(At, 0, 1); PG8_STAGE(PG8_SA(0, 0), a2, voffA);
            PG8_BAR; PG8_WAIT_L(0); PG8_MMA(1, 0, At, B0); PG8_BAR; PG8_SCHED;
            PG8_STAGE(PG8_SB(0, 1), b2 + hstepB, voffB);
            PG8_WAIT_V(6); PG8_BAR; PG8_MMA(1, 1, At, B1); PG8_BAR;
            PG8_LDB(B0, 1, 0); PG8_SCHED; PG8_LDA(At, 1, 0); PG8_STAGE(PG8_SA(0, 1), a2 + hstepA, voffA);
            PG8_WAIT_L(8); PG8_BAR; PG8_WAIT_L(0); PG8_MMA(0, 0, At, B0); PG8_BAR; PG8_SCHED;
            PG8_LDB(B1, 1, 1); PG8_STAGE(PG8_SB(1, 0), b3, voffB);
            PG8_BAR; PG8_WAIT_L(0); PG8_MMA(0, 1, At, B1); PG8_BAR;
            PG8_LDA(At, 1, 1); PG8_STAGE(PG8_SA(1, 0), a3, voffA);
            PG8_BAR; PG8_WAIT_L(0); PG8_MMA(1, 0, At, B0); PG8_BAR; PG8_SCHED;
            PG8_STAGE(PG8_SB(1, 1), b3 + hstepB, voffB);
            PG8_WAIT_V(6); PG8_BAR; PG8_MMA(1, 1, At, B1); PG8_BAR;
            }
        }
        if constexpr (ALIGN_EPI) { if (wr == 0) PG8_BAR; }
        if constexpr (!Epi::AFTER_DRAIN) { E(acc, cur, wr, wc, fr, fq); S.done(cur); }
        if (!has_next) break;
#pragma unroll
        for (int a = 0; a < 2; ++a)
#pragma unroll
            for (int b = 0; b < 2; ++b)
#pragma unroll
                for (int m = 0; m < 4; ++m)
#pragma unroll
                    for (int n = 0; n < 2; ++n) acc[a][b][m][n] = (f32x4){0.f, 0.f, 0.f, 0.f};
        cur = nxt; cA = nA; cB = nB; ++ui;
        if constexpr (ALIGN_EPI) { if (wr == 1) PG8_BAR; }
    }
    PG8_WAIT_V(0);
    if constexpr (!ALIGN_EPI) { if (wr == 0) PG8_BAR; }
    PG8_BAR;
    if constexpr (Epi::AFTER_DRAIN) { E.fused(acc, cur, wr, wc, fr, fq, lds, wid, lane); S.done(cur); }
#undef PG8_SA
#undef PG8_SB
#undef PG8_STAGE
#undef PG8_LDA
#undef PG8_LDB
#undef PG8_MMA
#undef PG8_WAIT_V
#undef PG8_WAIT_L
#undef PG8_BAR
#undef PG8_SCHED
}
}
#define GAS __attribute__((address_space(1)))
#define LAS __attribute__((address_space(3)))
typedef unsigned short bf16;
typedef unsigned v4u __attribute__((ext_vector_type(4)));
typedef float f32x4 __attribute__((ext_vector_type(4)));
typedef short bf16x8 __attribute__((ext_vector_type(8)));
typedef GAS unsigned gu32;
typedef GAS unsigned long long gu64;
#define RLX_AGENT __ATOMIC_RELAXED, __HIP_MEMORY_SCOPE_AGENT
#define LDS_WAIT() asm volatile("s_waitcnt lgkmcnt(0)" ::: "memory")
#define VM_WAIT() asm volatile("s_waitcnt vmcnt(0)" ::: "memory")
__device__ __forceinline__ unsigned long long rt() { return __builtin_amdgcn_s_memrealtime(); }
__device__ __forceinline__ unsigned f2bf(float f) { unsigned u = __builtin_bit_cast(unsigned, f); return (u + 0x7fffu + ((u >> 16) & 1u)) >> 16; }
__device__ __forceinline__ unsigned pk2(float lo, float hi) { return f2bf(lo) | (f2bf(hi) << 16); }

#define XB_TMO      128
#define XB_XCNT(j)  (256  + 64 * (j))
#define XB_XSUB(j)  (1280 + 64 * (j))
#define XB_XGEN(j)  (2304 + 64 * (j))
#define XB_TOP      3328
#define XB_TOPGEN   3392
#define XCD_BAR_WORDS 3456
#define XB_SPIN_CAP (1u << 18)

__device__ __forceinline__ unsigned xb_ld(unsigned* p)              { return __hip_atomic_load(p, __ATOMIC_RELAXED, __HIP_MEMORY_SCOPE_AGENT); }
__device__ __forceinline__ unsigned xb_add(unsigned* p, unsigned v) { return __hip_atomic_fetch_add(p, v, __ATOMIC_RELAXED, __HIP_MEMORY_SCOPE_AGENT); }
__device__ __forceinline__ unsigned xb_xcc_id() { return (unsigned)__builtin_amdgcn_s_getreg((3 << 11) | 20) & 0xFu; }
#define XB_SPIN(cond, bar) do { unsigned _sp = 0; while (cond) { __builtin_amdgcn_s_sleep(1); \
    if ((++_sp & 255u) == 0u) { if (xb_ld(&(bar)[XB_TMO])) break; if (_sp > XB_SPIN_CAP) { atomicAdd(&(bar)[XB_TMO], 1u); break; } } } } while (0)

struct XcdBarrier {
    unsigned* bar; unsigned x;
    volatile LAS unsigned* st;
};

__device__ __forceinline__ XcdBarrier xcd_barrier_post(unsigned* bar, volatile LAS unsigned* st) {
    XcdBarrier b; b.bar = bar; b.x = xb_xcc_id(); b.st = st;
    if (threadIdx.x == 0) (void)xb_add(&bar[XB_XCNT(b.x)], 1u);
    return b;
}
__device__ __forceinline__ void xcd_barrier_complete(unsigned* bar, unsigned x, unsigned& nloc, unsigned& nx) {
    const unsigned G = gridDim.x * gridDim.y * gridDim.z;
    unsigned sum, cnt, mine, sp = 0u;
    for (;;) {
        sum = 0u; cnt = 0u; mine = 0u;
#pragma unroll
        for (unsigned j = 0; j < 16; ++j) { const unsigned c = xb_ld(&bar[XB_XCNT(j)]); sum += c; cnt += (c > 0u) ? 1u : 0u; mine = (j == x) ? c : mine; }
        if (sum == G) break;
        __builtin_amdgcn_s_sleep(1);
        if ((++sp & 255u) == 0u) { if (xb_ld(&bar[XB_TMO])) break; if (sp > XB_SPIN_CAP) { atomicAdd(&bar[XB_TMO], 1u); break; } }
    }
    nloc = mine > 0u ? mine : 1u; nx = cnt > 0u ? cnt : 1u;
}

__device__ __forceinline__ void xcd_barrier(const XcdBarrier& b) {
    asm volatile("s_waitcnt vmcnt(0)" ::: "memory");
    __syncthreads();
    if (threadIdx.x == 0) {
        unsigned* bar = b.bar;
        __builtin_amdgcn_s_waitcnt(0);
        unsigned nloc = b.st[0], nx = b.st[1];
        if (nloc == 0u) { xcd_barrier_complete(bar, b.x, nloc, nx); b.st[0] = nloc; b.st[1] = nx; }
        const unsigned old = xb_add(&bar[XB_XSUB(b.x)], 1u);
        const unsigned gen = old / nloc;
        if (old + 1u == (gen + 1u) * nloc) {
            __builtin_amdgcn_fence(__ATOMIC_RELEASE, "agent");
            asm volatile("s_waitcnt vmcnt(0)" ::: "memory");
            const unsigned og = xb_add(&bar[XB_TOP], 1u);
            const unsigned tg = og / nx;
            if (og + 1u == (tg + 1u) * nx) xb_add(&bar[XB_TOPGEN], 1u);
            else XB_SPIN(xb_ld(&bar[XB_TOPGEN]) == tg, bar);
            __builtin_amdgcn_fence(__ATOMIC_ACQUIRE, "agent");
            xb_add(&bar[XB_XGEN(b.x)], 1u);
            asm volatile("s_waitcnt vmcnt(0)" ::: "memory");
        } else {
            XB_SPIN(xb_ld(&bar[XB_XGEN(b.x)]) == gen, bar);
            __builtin_amdgcn_fence(__ATOMIC_ACQUIRE, "agent");
            asm volatile("s_waitcnt vmcnt(0)" ::: "memory");
        }
    }
    __syncthreads();
}
constexpr int NWAVES = 8;
constexpr int BATCH = 16, SEQ = 2048, DM = 1024, M = BATCH * SEQ;
constexpr int L0P = 3584;
constexpr int L1P = 2048;
constexpr int DFF = 2816;
constexpr float ALPHA = 1.4142135623730951f;
typedef unsigned short bf16_t;
typedef float f32x16 __attribute__((ext_vector_type(16)));

constexpr size_t MiB = 1u << 20;
constexpr size_t WS_CTL = 0, CTL_ZERO_BYTES = 1 * MiB;
constexpr int CW_BAR = 4096;
constexpr size_t WS_W0IN = 2 * MiB, WS_W0OUT = 9 * MiB, WS_WUP0 = 11 * MiB, WS_WDN0 = 22 * MiB, WS_W1IN = 28 * MiB, WS_WUQ = 32 * MiB, WS_WUKV = 33 * MiB,
                 WS_W1OUT = 34 * MiB, WS_WUP1 = 36 * MiB, WS_WDN1 = 47 * MiB;
constexpr size_t WS_XB = 56 * MiB, WS_YMIX = 120 * MiB, WS_BIG = 184 * MiB;
constexpr size_t WS_G = 408 * MiB, WS_BONUS = 440 * MiB, WS_DT = 441 * MiB, WS_XST = 442 * MiB, WS_BT = 474 * MiB, WS_ASUM = 490 * MiB;
constexpr size_t WS_SLOC = 120 * MiB;
constexpr size_t WS_W2T = 53 * MiB, WS_A2T = 53 * MiB + 256 * 1024, WS_G2T = 53 * MiB + 512 * 1024;
constexpr size_t WS_GU = 120 * MiB;
constexpr size_t WS_PROJ1 = 184 * MiB, WS_QM = 312 * MiB, WS_KVM = 360 * MiB, WS_KPE = 424 * MiB, WS_RS = 426 * MiB;
constexpr size_t WS_CSTAB = 492 * MiB;
constexpr size_t WS_VTS = 428 * MiB, WS_VTM = 460 * MiB;
constexpr size_t WS_NEED = 497 * MiB;

constexpr int RING_BYTES = 131072;
constexpr int LDSCTL_OFF = 146432, MISC_OFF = LDSCTL_OFF + 320;
constexpr int LDS_BYTES = 147456;

__device__ __forceinline__ float bf2f(bf16_t b) { return __builtin_bit_cast(float, (unsigned)b << 16); }
__device__ __forceinline__ float sigmoidf_(float x) { return 1.f / (1.f + expf(-x)); }
__device__ __forceinline__ float softplusf_(float x) { return fmaxf(x, 0.f) + log1pf(expf(-fabsf(x))); }
__device__ __forceinline__ float siluf_(float x) { return x / (1.f + expf(-x)); }
__device__ __forceinline__ float wave_sum(float v) {
#pragma unroll
    for (int o = 1; o < 64; o <<= 1) v += __shfl_xor(v, o);
    return v;
}
#define WSYNC() asm volatile("s_waitcnt lgkmcnt(0)" ::: "memory")
typedef float f32x2_t __attribute__((ext_vector_type(2)));
typedef __bf16 bf16x2_t __attribute__((ext_vector_type(2)));
typedef unsigned u32x2 __attribute__((ext_vector_type(2)));
__device__ __forceinline__ unsigned cvtpk(float lo, float hi) { f32x2_t v = {lo, hi}; bf16x2_t b = __builtin_convertvector(v, bf16x2_t); return __builtin_bit_cast(unsigned, b); }
__device__ __forceinline__ float bflo(unsigned u) { return __builtin_bit_cast(float, u << 16); }
__device__ __forceinline__ float bfhi(unsigned u) { return __builtin_bit_cast(float, u & 0xffff0000u); }
__device__ __forceinline__ bf16_t bf1(float x) { return (bf16_t)(cvtpk(x, x) & 0xffffu); }
__device__ __forceinline__ bf16x8 pack8(float a0, float a1, float a2, float a3, float a4, float a5, float a6, float a7) {
    v4u w; w.x = cvtpk(a0, a1); w.y = cvtpk(a2, a3); w.z = cvtpk(a4, a5); w.w = cvtpk(a6, a7); return __builtin_bit_cast(bf16x8, w); }
template <int CTRL> __device__ __forceinline__ float dpp_mov(float x) { return __builtin_bit_cast(float, __builtin_amdgcn_update_dpp(0, __builtin_bit_cast(int, x), CTRL, 0xF, 0xF, true)); }
__device__ __forceinline__ float rowsum16(float x) { x += dpp_mov<0x128>(x); x += dpp_mov<0x124>(x); x += dpp_mov<0x122>(x); x += dpp_mov<0x121>(x); return x; }
__device__ __forceinline__ float rl(float x, int l) { return __builtin_bit_cast(float, __builtin_amdgcn_readlane(__builtin_bit_cast(int, x), l)); }
__device__ __forceinline__ float wave_sum_dpp(float x) { x = rowsum16(x); return (rl(x, 0) + rl(x, 16)) + (rl(x, 32) + rl(x, 48)); }

__device__ __forceinline__ void transpose_matrix(const float* __restrict__ W, int K, int N, bf16_t* __restrict__ WT, int Npad, int ldt, LAS float* scr, int gw, int NGW, int lane, const float* __restrict__ kscale, int& tr_base, bool ffn_interleave = false) {
    (void)scr;
    const int nblk = Npad / 64, nit = (K / 64) * nblk;
    int it0 = gw - (tr_base % NGW); if (it0 < 0) it0 += NGW; tr_base += nit;
    for (int it = it0; it < nit; it += NGW) {
        const int kb = it / nblk, nb = it - kb * nblk, n = nb * 64 + lane, k0 = kb * 64;
        const bool ok = n < N; const float* src = W + (size_t)k0 * N + (ok ? n : 0);
#pragma unroll
        for (int hc = 0; hc < 2; ++hc) {
            float v[32];
#pragma unroll
            for (int i = 0; i < 32; ++i) v[i] = src[(size_t)(hc * 32 + i) * N];
#pragma unroll
            for (int c = 0; c < 4; ++c) { float u[8];
#pragma unroll
                for (int i = 0; i < 8; ++i) { u[i] = ok ? v[c * 8 + i] : 0.f; if (kscale) u[i] *= kscale[k0 + hc * 32 + c * 8 + i]; }
                v4u o; o.x = cvtpk(u[0], u[1]); o.y = cvtpk(u[2], u[3]); o.z = cvtpk(u[4], u[5]); o.w = cvtpk(u[6], u[7]);
                const int nr = ffn_interleave ? ((n < DFF) ? 256 * (n >> 7) + (n & 127) : 256 * ((n - DFF) >> 7) + 128 + ((n - DFF) & 127)) : n;
                *(v4u*)(WT + (size_t)nr * ldt + k0 + hc * 32 + c * 8) = o; }
        }
    }
}

template <int MODE, int SEL = 0> __device__ __forceinline__ void ln_rows_range(const bf16_t* z, bf16_t* hb, float* outf, float* stats, const float* __restrict__ g, const float* __restrict__ b, int p0, int p1, int pstep, int lane) {
    auto rowof = [](int pi) { return SEL == 0 ? 2 * pi : SEL == 1 ? 64 * pi + 62 : 64 * (pi / 31) + 2 * (pi % 31); };
    pg8::u32x4 raw[2][2];
    if (p0 < p1) { const bf16_t* p = z + (size_t)rowof(p0) * DM;
#pragma unroll
        for (int r = 0; r < 2; ++r)
#pragma unroll
            for (int j = 0; j < 2; ++j) raw[r][j] = *(const pg8::u32x4*)(p + r * DM + 8 * lane + 512 * j); }
    for (int pi = p0; pi < p1; pi += pstep) {
        const int row = rowof(pi);
        f32x4 v[2][4]; float s[2] = {0.f, 0.f};
#pragma unroll
        for (int r = 0; r < 2; ++r)
#pragma unroll
            for (int j = 0; j < 2; ++j) {
                v[r][2 * j][0] = __builtin_bit_cast(float, raw[r][j].x << 16); v[r][2 * j][1] = __builtin_bit_cast(float, raw[r][j].x & 0xffff0000u);
                v[r][2 * j][2] = __builtin_bit_cast(float, raw[r][j].y << 16); v[r][2 * j][3] = __builtin_bit_cast(float, raw[r][j].y & 0xffff0000u);
                v[r][2 * j + 1][0] = __builtin_bit_cast(float, raw[r][j].z << 16); v[r][2 * j + 1][1] = __builtin_bit_cast(float, raw[r][j].z & 0xffff0000u);
                v[r][2 * j + 1][2] = __builtin_bit_cast(float, raw[r][j].w << 16); v[r][2 * j + 1][3] = __builtin_bit_cast(float, raw[r][j].w & 0xffff0000u); }
        { const int nxt = pi + pstep; const bf16_t* pn = z + (size_t)rowof(nxt < p1 ? nxt : pi) * DM;
#pragma unroll
          for (int r = 0; r < 2; ++r)
#pragma unroll
              for (int j = 0; j < 2; ++j) raw[r][j] = *(const pg8::u32x4*)(pn + r * DM + 8 * lane + 512 * j); }
#pragma unroll
        for (int r = 0; r < 2; ++r)
#pragma unroll
            for (int j = 0; j < 4; ++j) s[r] += (v[r][j][0] + v[r][j][1]) + (v[r][j][2] + v[r][j][3]);
        float mean[2], q[2] = {0.f, 0.f}, rstd[2];
#pragma unroll
        for (int r = 0; r < 2; ++r) { mean[r] = wave_sum_dpp(s[r]) * (1.f / DM);
#pragma unroll
            for (int j = 0; j < 4; ++j) { v[r][j] = v[r][j] - mean[r]; q[r] += (v[r][j][0] * v[r][j][0] + v[r][j][1] * v[r][j][1]) + (v[r][j][2] * v[r][j][2] + v[r][j][3] * v[r][j][3]); } }
#pragma unroll
        for (int r = 0; r < 2; ++r) rstd[r] = 1.0f / sqrtf(wave_sum_dpp(q[r]) * (1.f / DM) + 1e-5f);
        if (MODE == 1 && lane < 2) { stats[2 * (row + lane)] = lane ? mean[1] : mean[0]; stats[2 * (row + lane) + 1] = lane ? rstd[1] : rstd[0]; }
#pragma unroll
        for (int j = 0; j < 2; ++j) {
            const int c = 8 * lane + 512 * j;
            const f32x4 g0 = *(const f32x4*)(g + c), g1 = *(const f32x4*)(g + c + 4), b0 = *(const f32x4*)(b + c), b1 = *(const f32x4*)(b + c + 4);
#pragma unroll
            for (int r = 0; r < 2; ++r) {
                const f32x4 o0 = __builtin_elementwise_fma(v[r][2 * j], g0 * rstd[r], b0), o1 = __builtin_elementwise_fma(v[r][2 * j + 1], g1 * rstd[r], b1);
                if (MODE == 1) { pg8::u32x4 w; w.x = cvtpk(o0[0], o0[1]); w.y = cvtpk(o0[2], o0[3]); w.z = cvtpk(o1[0], o1[1]); w.w = cvtpk(o1[2], o1[3]); *(pg8::u32x4*)(hb + (size_t)(row + r) * DM + c) = w; }
                else { *(f32x4*)(outf + (size_t)(row + r) * DM + c) = o0; *(f32x4*)(outf + (size_t)(row + r) * DM + c + 4) = o1; }
            }
        }
    }
}

template <int MODE> __device__ __forceinline__ void ln_rows(const bf16_t* z, bf16_t* hb, float* outf, float* stats, const float* __restrict__ g, const float* __restrict__ b, int gw, int NGW, int lane) {
    ln_rows_range<MODE, 0>(z, hb, outf, stats, g, b, gw, M / 2, NGW, lane);
}
__device__ __forceinline__ void rwkv_naive_chain(int chain, int lane, LAS float* sm, const bf16_t* __restrict__ proj, const float* __restrict__ mix, const float* __restrict__ w0, const float* __restrict__ w2,
                                                 const float* __restrict__ a0, const float* __restrict__ a2, const float* __restrict__ g2, const float* __restrict__ k_k,
                                                 const float* __restrict__ k_a, const float* __restrict__ r_k, const float* __restrict__ ln_g, const float* __restrict__ ln_b, bf16_t* __restrict__ ymix) {
    LAS float* s_w2 = sm; LAS float* s_a2 = sm + 4096; LAS float* s_g2 = sm + 8192; LAS float* s_tw = sm + 16384; LAS float* s_al = s_tw + 64; LAS float* s_sg = s_tw + 128;
    LAS float* s_w = s_tw + 256; LAS float* s_k = s_tw + 320; LAS float* s_a = s_tw + 384; LAS float* s_b = s_tw + 448; LAS float* s_r = s_tw + 512;
    const int b = chain >> 3, h = chain & 7, c = h * 64 + lane;
    for (int l = 0; l < 64; ++l) { s_w2[l * 64 + lane] = w2[l * 512 + c]; s_a2[l * 64 + lane] = a2[l * 512 + c]; }
    for (int l = 0; l < 128; ++l) s_g2[l * 64 + lane] = g2[l * 512 + c];
    const float mr = mix[c], mk = mix[512 + c], mv = mix[1024 + c], mw = mix[1536 + lane], ma = mix[1600 + lane], mg0 = mix[1664 + lane], mg1 = mix[1728 + lane];
    const float w0c = w0[c], a0c = a0[c], kkc = k_k[c], kac = k_a[c], rkc = r_k[c], lgc = ln_g[c], lbc = ln_b[c];
    float S[64];
#pragma unroll
    for (int j = 0; j < 64; ++j) S[j] = 0.f;
    float pr = 0.f, pk = 0.f, pv = 0.f, pw = 0.f, pa = 0.f, pg0 = 0.f, pg1 = 0.f;
    WSYNC();
    for (int t = 0; t < SEQ; ++t) {
        const bf16_t* row = proj + (size_t)(b * SEQ + t) * L0P;
        const float cr = bf2f(row[c]), ck = bf2f(row[512 + c]), cv = bf2f(row[1024 + c]), cw = bf2f(row[1536 + lane]), ca = bf2f(row[1600 + lane]),
                    cg0 = bf2f(row[1664 + lane]), cg1 = bf2f(row[1728 + lane]);
        const float r_s = cr + (pr - cr) * mr, k_s = ck + (pk - ck) * mk, v_s = cv + (pv - cv) * mv;
        const float wl = cw + (pw - cw) * mw, al = ca + (pa - ca) * ma, g0 = cg0 + (pg0 - cg0) * mg0, g1 = cg1 + (pg1 - cg1) * mg1;
        pr = cr; pk = ck; pv = cv; pw = cw; pa = ca; pg0 = cg0; pg1 = cg1;
        s_tw[lane] = tanhf(wl); s_al[lane] = al; s_sg[lane] = sigmoidf_(g0); s_sg[64 + lane] = sigmoidf_(g1);
        WSYNC();
        float wsum = w0c, asum = a0c, gsum = 0.f;
#pragma unroll 2
        for (int l = 0; l < 64; ++l) { wsum += s_tw[l] * s_w2[l * 64 + lane]; asum += s_al[l] * s_a2[l * 64 + lane]; }
#pragma unroll 2
        for (int l = 0; l < 128; ++l) gsum += s_sg[l] * s_g2[l * 64 + lane];
        const float log_w = -softplusf_(-wsum) - 0.5f;
        const float dec = expf(-expf(log_w));
        const float a = sigmoidf_(asum);
        float kkv = k_s * kkc;
        const float nrm = sqrtf(wave_sum(kkv * kkv));
        kkv = kkv / fmaxf(nrm, 1e-12f);
        const float k2 = k_s * (1.f + (a - 1.f) * kac);
        const float bonus_s = wave_sum(r_s * k2 * rkc);
        s_w[lane] = dec; s_k[lane] = k2; s_a[lane] = -kkv; s_b[lane] = kkv * a; s_r[lane] = r_s;
        WSYNC();
        float sa = 0.f;
#pragma unroll
        for (int j = 0; j < 64; ++j) sa += S[j] * s_a[j];
        float y = 0.f;
#pragma unroll
        for (int j = 0; j < 64; ++j) { S[j] = S[j] * s_w[j] + sa * s_b[j] + v_s * s_k[j]; y += S[j] * s_r[j]; }
        const float mu = wave_sum(y) * (1.f / 64.f);
        const float d = y - mu;
        const float var = wave_sum(d * d) * (1.f / 64.f);
        const float yn = d * (1.0f / sqrtf(var + 64e-5f)) * lgc + lbc;
        const float o = (yn + bonus_s * v_s) * gsum;
        ymix[(size_t)(b * SEQ + t) * DM + c] = (bf16_t)f2bf(o);
        WSYNC();
    }
}

__device__ __forceinline__ void ssm_conv_all(const bf16_t* __restrict__ proj, const float* __restrict__ cw, const float* __restrict__ cb, const float* __restrict__ dtb,
                                             bf16_t* __restrict__ xbc, float* __restrict__ dt, int gtid, int NT) {
    for (size_t i = gtid; i < (size_t)M * 1024; i += NT) {
        const int m = (int)(i >> 10), c = (int)(i & 1023), t = m & (SEQ - 1);
        float acc = cb[c];
#pragma unroll
        for (int k = 0; k < 4; ++k) { const int tt = t - 3 + k; if (tt >= 0) acc += cw[k * 1024 + c] * bf2f(proj[(size_t)(m - 3 + k) * L0P + 2304 + c]); }
        xbc[i] = (bf16_t)f2bf(siluf_(acc));
    }
    for (int i = gtid; i < M * 8; i += NT) dt[i] = softplusf_(bf2f(proj[(size_t)(i >> 3) * L0P + 3328 + (i & 7)]) + dtb[i & 7]);
}
__device__ __forceinline__ void ssd_naive_task(int task, int lane, const bf16_t* __restrict__ xbc, const float* __restrict__ dt, const float* __restrict__ a_log, const float* __restrict__ dsk, float* __restrict__ yssm) {
    const int chain = task >> 2, q = task & 3, b = chain >> 3, h = chain & 7, g = h >> 2, p = q * 16 + (lane >> 2), nq = lane & 3;
    const float A = -expf(a_log[h]), D = dsk[h];
    float st[32];
#pragma unroll
    for (int n = 0; n < 32; ++n) st[n] = 0.f;
    for (int t = 0; t < SEQ; ++t) {
        const size_t m = (size_t)b * SEQ + t;
        const float dtv = dt[m * 8 + h], dA = expf(dtv * A);
        const float x = bf2f(xbc[m * 1024 + h * 64 + p]), xdt = x * dtv;
        const bf16_t* Bp = xbc + m * 1024 + 512 + g * 128 + nq * 32;
        const bf16_t* Cp = xbc + m * 1024 + 768 + g * 128 + nq * 32;
        float yp = 0.f;
#pragma unroll
        for (int n = 0; n < 32; ++n) { st[n] = st[n] * dA + xdt * bf2f(Bp[n]); yp += st[n] * bf2f(Cp[n]); }
        yp += __shfl_xor(yp, 1); yp += __shfl_xor(yp, 2);
        if (nq == 0) yssm[m * 512 + h * 64 + p] = yp + D * x;
    }
}
template <bool ST = true> __device__ __forceinline__ void ssm_gate_norm_all(const bf16_t* __restrict__ yssm, const bf16_t* __restrict__ proj, const float* __restrict__ ng, bf16_t* __restrict__ ymix, int wv0, int wvend, int lane) {
    for (int wvb = wv0 * 4 - (wv0 & ~7) * 3; wvb < wvend; wvb += NWAVES * 4) {
        float u[4][4], q[4];
#pragma unroll
        for (int k = 0; k < 4; ++k) { const int wv = wvb + k, m = wv >> 1, g = wv & 1; q[k] = 0.f;
#pragma unroll
            for (int j = 0; j < 4; ++j) { const int c = g * 256 + j * 64 + lane; const float z = bf2f(proj[(size_t)m * L0P + 1792 + c]); u[k][j] = bf2f(yssm[(size_t)m * 512 + c]) * (z * __builtin_amdgcn_rcpf(1.f + __expf(-z))); q[k] += u[k][j] * u[k][j]; } }
#pragma unroll
        for (int k = 0; k < 4; ++k) { const int wv = wvb + k, m = wv >> 1, g = wv & 1;
            const float rs = __builtin_amdgcn_rsqf(wave_sum_dpp(q[k]) * (1.f / 256.f) + 1e-5f);
#pragma unroll
            for (int j = 0; j < 4; ++j) { const int c = g * 256 + j * 64 + lane; const float o_ = u[k][j] * rs * ng[c]; if (ST) ymix[(size_t)m * DM + 512 + c] = bf1(o_); else asm volatile("" :: "v"(o_)); } }
    }
}
template <bool ST = true> __device__ __forceinline__ void ffn_act_all(bf16_t* gu, const float* __restrict__ cw, const float* __restrict__ cb, int gtid, int NT) {
    constexpr int NCH = DFF / 8, NSTRIP = M / 32;
    for (int task = gtid; task < NSTRIP * NCH; task += NT) {
        const int strip = task / NCH, q = task - strip * NCH, c0 = q * 8, m0 = strip * 32;
        float w0[8], w1[8], w2[8], bb[8], g2[8], g1[8];
#pragma unroll
        for (int j = 0; j < 8; j += 4) { const f32x4 a = *(const f32x4*)(cw + c0 + j), b = *(const f32x4*)(cw + DFF + c0 + j), c = *(const f32x4*)(cw + 2 * DFF + c0 + j), d = *(const f32x4*)(cb + c0 + j);
#pragma unroll
            for (int k = 0; k < 4; ++k) { w0[j + k] = a[k]; w1[j + k] = b[k]; w2[j + k] = c[k]; bb[j + k] = d[k]; } }
        bf16_t* base = gu + (size_t)m0 * (2 * DFF) + c0;
        if ((m0 & (SEQ - 1)) != 0) { const v4u a = *(const v4u*)(base - 2 * (2 * DFF)), b = *(const v4u*)(base - (2 * DFF));
            g2[0] = bflo(a.x); g2[1] = bfhi(a.x); g2[2] = bflo(a.y); g2[3] = bfhi(a.y); g2[4] = bflo(a.z); g2[5] = bfhi(a.z); g2[6] = bflo(a.w); g2[7] = bfhi(a.w);
            g1[0] = bflo(b.x); g1[1] = bfhi(b.x); g1[2] = bflo(b.y); g1[3] = bfhi(b.y); g1[4] = bflo(b.z); g1[5] = bfhi(b.z); g1[6] = bflo(b.w); g1[7] = bfhi(b.w); }
        else {
#pragma unroll
            for (int j = 0; j < 8; ++j) { g2[j] = 0.f; g1[j] = 0.f; } }
#pragma unroll 4
        for (int r = 0; r < 32; ++r) {
            const v4u gv = *(const v4u*)(base + (size_t)r * (2 * DFF)), uv = *(const v4u*)(base + (size_t)r * (2 * DFF) + DFF);
            const unsigned gw_[4] = {gv.x, gv.y, gv.z, gv.w}, uw_[4] = {uv.x, uv.y, uv.z, uv.w};
            unsigned ow[4];
#pragma unroll
            for (int k = 0; k < 4; ++k) {
                const float ga = bflo(gw_[k]), gb = bfhi(gw_[k]);
                const float ya = bb[2 * k] + w0[2 * k] * g2[2 * k] + w1[2 * k] * g1[2 * k] + w2[2 * k] * ga;
                const float yb = bb[2 * k + 1] + w0[2 * k + 1] * g2[2 * k + 1] + w1[2 * k + 1] * g1[2 * k + 1] + w2[2 * k + 1] * gb;
                g2[2 * k] = g1[2 * k]; g1[2 * k] = ga; g2[2 * k + 1] = g1[2 * k + 1]; g1[2 * k + 1] = gb;
                ow[k] = cvtpk(ya / (1.f + __expf(-ya)) * bflo(uw_[k]), yb / (1.f + __expf(-yb)) * bfhi(uw_[k]));
            }
            if (ST) *(v4u*)(base + (size_t)r * (2 * DFF) + DFF) = (v4u){ow[0], ow[1], ow[2], ow[3]}; else asm volatile("" :: "v"(ow[0]), "v"(ow[1]), "v"(ow[2]), "v"(ow[3]));
        }
    }
}
template <bool ST = true> __device__ __forceinline__ void mla_prep_all(const bf16_t* __restrict__ proj1, const int* __restrict__ pos, float* __restrict__ rs, bf16_t* __restrict__ kpe, float* __restrict__ cstab, int gw, int NGW, int lane) {
    const int fi = lane & 15, tk = lane >> 4;
    const double inv_rev = exp2(-(double)(2 * fi) * (13.287712379549449 / 32.0)) * 0.15915494309189535;
    for (int m4 = gw * 4; m4 < M; m4 += NGW * 4) {
        const int mt = m4 + tk;
        const bf16_t* row = proj1 + (size_t)mt * L1P;
        const v4u qa = *(const v4u*)(row + 1536 + 8 * fi), qb = *(const v4u*)(row + 1664 + 8 * fi), ka = *(const v4u*)(row + 1792 + 8 * fi);
        const float x1 = bf2f(row[1920 + fi]), x2 = bf2f(row[1936 + fi]);
        const double rev = (double)pos[mt] * inv_rev;
        const float fr = (float)(rev - floor(rev));
        const float cs = __builtin_amdgcn_cosf(fr), sn = __builtin_amdgcn_sinf(fr);
        cstab[(size_t)mt * 32 + fi] = cs; cstab[(size_t)mt * 32 + 16 + fi] = sn;
        kpe[(size_t)mt * 32 + fi] = bf1(x1 * cs - x2 * sn); kpe[(size_t)mt * 32 + 16 + fi] = bf1(x2 * cs + x1 * sn);
        float q = 0.f, k = 0.f;
#pragma unroll
        for (int e = 0; e < 4; ++e) { const float a0 = bflo(qa[e]), a1 = bfhi(qa[e]), b0 = bflo(qb[e]), b1 = bfhi(qb[e]), c0 = bflo(ka[e]), c1 = bfhi(ka[e]);
            q += (a0 * a0 + a1 * a1) + (b0 * b0 + b1 * b1); k += c0 * c0 + c1 * c1; }
        q = rowsum16(q); k = rowsum16(k);
        if (fi == 0) { rs[(size_t)mt * 2] = 1.0f / sqrtf(q * (1.f / 256.f) + 1e-6f); rs[(size_t)mt * 2 + 1] = 1.0f / sqrtf(k * (1.f / 128.f) + 1e-6f); }
    }
}
template <bool ST = true> __device__ __forceinline__ void rope_q_all(bf16_t* qm, const float* __restrict__ cstab, int gtid, int NT) {
    for (int i = gtid; i < M * 16; i += NT) {
        const int m = i >> 4, h = (i >> 1) & 7, k0 = (i & 1) * 8;
        bf16_t* p = qm + (size_t)m * 768 + h * 96 + 64 + k0;
        const v4u a = *(const v4u*)p, b = *(const v4u*)(p + 16);
        const f32x4 c0 = *(const f32x4*)(cstab + (size_t)m * 32 + k0), c1 = *(const f32x4*)(cstab + (size_t)m * 32 + k0 + 4), s0 = *(const f32x4*)(cstab + (size_t)m * 32 + 16 + k0), s1 = *(const f32x4*)(cstab + (size_t)m * 32 + 16 + k0 + 4);
        const unsigned au[4] = {a.x, a.y, a.z, a.w}, bu[4] = {b.x, b.y, b.z, b.w};
        const float cs[8] = {c0[0], c0[1], c0[2], c0[3], c1[0], c1[1], c1[2], c1[3]}, sn[8] = {s0[0], s0[1], s0[2], s0[3], s1[0], s1[1], s1[2], s1[3]};
        unsigned o1[4], o2[4];
#pragma unroll
        for (int q = 0; q < 4; ++q) { const float x1a = bflo(au[q]), x1b = bfhi(au[q]), x2a = bflo(bu[q]), x2b = bfhi(bu[q]);
            o1[q] = cvtpk(x1a * cs[2 * q] - x2a * sn[2 * q], x1b * cs[2 * q + 1] - x2b * sn[2 * q + 1]);
            o2[q] = cvtpk(x2a * cs[2 * q] + x1a * sn[2 * q], x2b * cs[2 * q + 1] + x1b * sn[2 * q + 1]); }
        if (ST) { *(v4u*)p = (v4u){o1[0], o1[1], o1[2], o1[3]}; *(v4u*)(p + 16) = (v4u){o2[0], o2[1], o2[2], o2[3]}; }
    }
}
__device__ __forceinline__ void sb_naive_task(int qblk, int bh, int lane, const bf16_t* __restrict__ proj1, bf16_t* __restrict__ ymix) {
    const int b = bh >> 3, h = bh & 7, t = qblk * 64 + lane;
    const size_t mrow = (size_t)b * SEQ;
    float q[64], o[64];
#pragma unroll
    for (int d = 0; d < 64; ++d) { q[d] = bf2f(proj1[(mrow + t) * L1P + h * 64 + d]) * 0.125f; o[d] = 0.f; }
    float cum = 0.f;
    const int smax = qblk * 64 + 63;
    for (int s = smax - 1; s >= 0; --s) {
        const bf16_t* kr = proj1 + (mrow + s) * L1P + 512 + h * 64;
        const bf16_t* vr = proj1 + (mrow + s) * L1P + 1024 + h * 64;
        float z = 0.f;
#pragma unroll
        for (int d = 0; d < 64; ++d) z += q[d] * bf2f(kr[d]);
        if (s < t) {
            const float lsp = -softplusf_(-z);
            const float lsn = -softplusf_(z);
            const float att = expf(lsp + cum);
            cum += lsn;
#pragma unroll
            for (int d = 0; d < 64; ++d) o[d] += att * bf2f(vr[d]);
        }
    }
#pragma unroll
    for (int d = 0; d < 64; ++d) ymix[(mrow + t) * DM + h * 64 + d] = (bf16_t)f2bf(o[d]);
}
__device__ __forceinline__ void mla_naive_task(int qblk, int bh, int lane, const bf16_t* __restrict__ qm, const bf16_t* __restrict__ kvm, const bf16_t* __restrict__ kpe, bf16_t* __restrict__ ymix) {
    const int b = bh >> 3, h = bh & 7, t = qblk * 64 + lane;
    const size_t mrow = (size_t)b * SEQ;
    const float scale = 0.10206207261596577f;
    float q[96], o[64];
#pragma unroll
    for (int d = 0; d < 96; ++d) q[d] = bf2f(qm[(mrow + t) * 768 + h * 96 + d]) * scale;
#pragma unroll
    for (int d = 0; d < 64; ++d) o[d] = 0.f;
    float mx = -1e30f, l = 0.f;
    const int smax = qblk * 64 + 63;
    for (int s = 0; s <= smax; ++s) {
        const bf16_t* kr = kvm + (mrow + s) * 1024 + h * 128;
        const bf16_t* pr = kpe + (mrow + s) * 32;
        float z = 0.f;
#pragma unroll
        for (int d = 0; d < 64; ++d) z += q[d] * bf2f(kr[d]);
#pragma unroll
        for (int d = 0; d < 32; ++d) z += q[64 + d] * bf2f(pr[d]);
        if (s <= t) {
            const float mn = fmaxf(mx, z), f = expf(mx - mn), pz = expf(z - mn);
            l = l * f + pz; mx = mn;
#pragma unroll
            for (int d = 0; d < 64; ++d) o[d] = o[d] * f + pz * bf2f(kr[64 + d]);
        }
    }
    const float il = 1.f / l;
#pragma unroll
    for (int d = 0; d < 64; ++d) ymix[(mrow + t) * DM + 512 + h * 64 + d] = (bf16_t)f2bf(o[d] * il);
}


__device__ __forceinline__ int crow(int r, int hi) { return (r & 3) + 8 * (r >> 2) + 4 * hi; }
#define MFMA32(a, b, c) __builtin_amdgcn_mfma_f32_32x32x16_bf16((a), (b), (c), 0, 0, 0)
constexpr int STG_PITCH = 72;
__device__ __forceinline__ void transpose_tile64(const bf16_t* __restrict__ src, int sp, bf16_t* __restrict__ dst, int dp, LAS bf16_t* scr, int lane) {
#pragma unroll
    for (int i = 0; i < 8; ++i) { const int row = i * 8 + (lane >> 3), ch = lane & 7; const v4u v = *(const v4u*)(src + (size_t)row * sp + ch * 8); *(LAS v4u*)(scr + row * STG_PITCH + ch * 8) = v; }
    WSYNC();
#pragma unroll
    for (int i = 0; i < 8; ++i) { const int d = i * 8 + (lane >> 3), tc = lane & 7; const LAS bf16_t* p = scr + (tc * 8) * STG_PITCH + d;
        v4u o; o.x = (unsigned)p[0] | ((unsigned)p[STG_PITCH] << 16); o.y = (unsigned)p[2 * STG_PITCH] | ((unsigned)p[3 * STG_PITCH] << 16);
        o.z = (unsigned)p[4 * STG_PITCH] | ((unsigned)p[5 * STG_PITCH] << 16); o.w = (unsigned)p[6 * STG_PITCH] | ((unsigned)p[7 * STG_PITCH] << 16);
        *(v4u*)(dst + (size_t)d * dp + tc * 8) = o; }
    WSYNC();
}
__device__ __forceinline__ void store_OT(const f32x16 (&o)[2], float sc, LAS bf16_t* stg, bf16_t* __restrict__ dst, int lane) {
    const int l31 = lane & 31, hi = lane >> 5;
#pragma unroll
    for (int dt = 0; dt < 2; ++dt)
#pragma unroll
        for (int r = 0; r < 16; ++r) stg[l31 * STG_PITCH + 32 * dt + crow(r, hi)] = bf1(o[dt][r] * sc);
    WSYNC();
#pragma unroll
    for (int i = 0; i < 4; ++i) { const int row = i * 8 + (lane >> 3), ch = lane & 7; const v4u v = *(const LAS v4u*)(stg + row * STG_PITCH + ch * 8); *(v4u*)(dst + (size_t)row * DM + ch * 8) = v; }
    WSYNC();
}
__device__ __forceinline__ float softplus_fast(float z) { return fmaxf(z, 0.f) + __logf(1.f + __expf(-fabsf(z))); }

__device__ __forceinline__ void sb_task(int bh, int qblk, int lane, const bf16_t* __restrict__ P1, const bf16_t* __restrict__ VT, bf16_t* __restrict__ ymix, LAS bf16_t* stg) {
    const int b = bh >> 3, h = bh & 7, l31 = lane & 31, hi = lane >> 5, q0 = qblk * 32, t = q0 + l31;
    const size_t rowb = (size_t)b * SEQ;
    const bf16_t* Qp = P1 + (rowb + q0 + l31) * L1P + h * 64 + 8 * hi;
    bf16x8 qf[4];
#pragma unroll
    for (int kk = 0; kk < 4; ++kk) qf[kk] = *(const bf16x8*)(Qp + 16 * kk);
    const bf16_t* Kp = P1 + (rowb + l31) * L1P + 512 + h * 64 + 8 * hi;
    const bf16_t* Vp = VT + ((size_t)bh * 64 + l31) * SEQ + 4 * hi;
    f32x16 o[2];
#pragma unroll
    for (int r = 0; r < 16; ++r) { o[0][r] = 0.f; o[1][r] = 0.f; }
    float cum = 0.f;
    bf16x8 kf[4]; u32x2 va[2][2][2];
#define SB_LOAD(S0, KF, VA) do { _Pragma("unroll") for (int kk = 0; kk < 4; ++kk) KF[kk] = *(const bf16x8*)(Kp + (size_t)(S0) * L1P + 16 * kk); \
        _Pragma("unroll") for (int dt = 0; dt < 2; ++dt) _Pragma("unroll") for (int ks = 0; ks < 2; ++ks) { VA[dt][ks][0] = *(const u32x2*)(Vp + (size_t)dt * 32 * SEQ + (S0) + 16 * ks); VA[dt][ks][1] = *(const u32x2*)(Vp + (size_t)dt * 32 * SEQ + (S0) + 16 * ks + 8); } } while (0)
    SB_LOAD(q0, kf, va);
    for (int s0 = q0; s0 >= 0; s0 -= 32) {
        bf16x8 kn[4]; u32x2 vn[2][2][2];
        const int sn = (s0 >= 32) ? s0 - 32 : 0;
        SB_LOAD(sn, kn, vn);
        f32x16 acc;
#pragma unroll
        for (int r = 0; r < 16; ++r) acc[r] = 0.f;
#pragma unroll
        for (int kk = 0; kk < 4; ++kk) acc = MFMA32(kf[kk], qf[kk], acc);
        const bool diag = (s0 == q0);
        float lb[16], lk[16];
#pragma unroll
        for (int r = 0; r < 16; ++r) { const float z = acc[r] * 0.125f; const float sp = softplus_fast(z); float b_ = z - sp, k_ = -sp;
            if (diag) { const bool valid = (s0 + crow(r, hi)) < t; b_ = valid ? b_ : -1e30f; k_ = valid ? k_ : 0.f; }
            lb[r] = b_; lk[r] = k_; }
        float e[16], T[4], U[4];
#pragma unroll
        for (int i = 0; i < 4; ++i) { e[4 * i + 3] = 0.f; e[4 * i + 2] = lk[4 * i + 3]; e[4 * i + 1] = e[4 * i + 2] + lk[4 * i + 2]; e[4 * i] = e[4 * i + 1] + lk[4 * i + 1]; T[i] = e[4 * i] + lk[4 * i]; }
#pragma unroll
        for (int i = 0; i < 4; ++i) U[i] = __shfl_xor(T[i], 32);
        float off[4];
        { const float st2 = T[3], st1 = st2 + T[2], st0 = st1 + T[1]; const float su2 = U[3], su1 = su2 + U[2], su0 = su1 + U[1];
          const float x0 = hi ? 0.f : U[0], x1 = hi ? 0.f : U[1], x2 = hi ? 0.f : U[2], x3 = hi ? 0.f : U[3];
          off[3] = x3; off[2] = st2 + su2 + x2; off[1] = st1 + su1 + x1; off[0] = st0 + su0 + x0;
          const float total = st0 + T[0] + su0 + U[0];
#pragma unroll
          for (int r = 0; r < 16; ++r) acc[r] = __expf(lb[r] + (cum + off[r >> 2] + e[r]));
          cum += total; }
        bf16x8 pf[2];
#pragma unroll
        for (int ks = 0; ks < 2; ++ks) { v4u w; w.x = cvtpk(acc[8 * ks], acc[8 * ks + 1]); w.y = cvtpk(acc[8 * ks + 2], acc[8 * ks + 3]); w.z = cvtpk(acc[8 * ks + 4], acc[8 * ks + 5]); w.w = cvtpk(acc[8 * ks + 6], acc[8 * ks + 7]); pf[ks] = __builtin_bit_cast(bf16x8, w); }
#pragma unroll
        for (int dt = 0; dt < 2; ++dt)
#pragma unroll
            for (int ks = 0; ks < 2; ++ks) { v4u a; a.x = va[dt][ks][0].x; a.y = va[dt][ks][0].y; a.z = va[dt][ks][1].x; a.w = va[dt][ks][1].y; o[dt] = MFMA32(__builtin_bit_cast(bf16x8, a), pf[ks], o[dt]); }
        if (__all(cum < -110.f)) break;
#pragma unroll
        for (int kk = 0; kk < 4; ++kk) kf[kk] = kn[kk];
#pragma unroll
        for (int dt = 0; dt < 2; ++dt)
#pragma unroll
            for (int ks = 0; ks < 2; ++ks) { va[dt][ks][0] = vn[dt][ks][0]; va[dt][ks][1] = vn[dt][ks][1]; }
    }
#undef SB_LOAD
    store_OT(o, 1.0f, stg, ymix + (rowb + q0) * DM + h * 64, lane);
}
__device__ __forceinline__ void mla_task(int bh, int qblk, int lane, const bf16_t* __restrict__ QM, const bf16_t* __restrict__ KVM, const bf16_t* __restrict__ KPE, const bf16_t* __restrict__ VT,
                                         bf16_t* __restrict__ ymix, LAS bf16_t* stg) {
    const int b = bh >> 3, h = bh & 7, l31 = lane & 31, hi = lane >> 5, q0 = qblk * 32, t = q0 + l31;
    const size_t rowb = (size_t)b * SEQ;
    const bf16_t* Qp = QM + (rowb + q0 + l31) * 768 + h * 96 + 8 * hi;
    bf16x8 qf[6];
#pragma unroll
    for (int kk = 0; kk < 6; ++kk) qf[kk] = *(const bf16x8*)(Qp + 16 * kk);
    const bf16_t* Kn = KVM + (rowb + l31) * 1024 + h * 128 + 8 * hi;
    const bf16_t* Kr = KPE + (rowb + l31) * 32 + 8 * hi;
    const bf16_t* Vp = VT + ((size_t)bh * 64 + l31) * SEQ + 4 * hi;
    const float sc2 = 0.10206207261596577f * 1.4426950408889634f;
    f32x16 o[2];
#pragma unroll
    for (int r = 0; r < 16; ++r) { o[0][r] = 0.f; o[1][r] = 0.f; }
    float mrun = -1e30f, lsum = 0.f;
    bf16x8 kf[6]; u32x2 va[2][2][2];
#define ML_LOAD(S0, KF, VA) do { _Pragma("unroll") for (int kk = 0; kk < 4; ++kk) KF[kk] = *(const bf16x8*)(Kn + (size_t)(S0) * 1024 + 16 * kk); \
        _Pragma("unroll") for (int kk = 0; kk < 2; ++kk) KF[4 + kk] = *(const bf16x8*)(Kr + (size_t)(S0) * 32 + 16 * kk); \
        _Pragma("unroll") for (int dt = 0; dt < 2; ++dt) _Pragma("unroll") for (int ks = 0; ks < 2; ++ks) { VA[dt][ks][0] = *(const u32x2*)(Vp + (size_t)dt * 32 * SEQ + (S0) + 16 * ks); VA[dt][ks][1] = *(const u32x2*)(Vp + (size_t)dt * 32 * SEQ + (S0) + 16 * ks + 8); } } while (0)
    ML_LOAD(0, kf, va);
    for (int s0 = 0; s0 <= q0; s0 += 32) {
        bf16x8 kn[6]; u32x2 vn[2][2][2];
        const int sn = (s0 + 32 <= q0) ? s0 + 32 : s0;
        ML_LOAD(sn, kn, vn);
        f32x16 acc;
#pragma unroll
        for (int r = 0; r < 16; ++r) acc[r] = 0.f;
#pragma unroll
        for (int kk = 0; kk < 6; ++kk) acc = MFMA32(kf[kk], qf[kk], acc);
        const bool diag = (s0 == q0);
        float tmax = -1e30f;
#pragma unroll
        for (int r = 0; r < 16; ++r) { float z = acc[r] * sc2; if (diag && (s0 + crow(r, hi)) > t) z = -1e30f; acc[r] = z; tmax = fmaxf(tmax, z); }
        tmax = fmaxf(tmax, __shfl_xor(tmax, 32));
        const float mn = fmaxf(mrun, tmax), alpha = exp2f(mrun - mn); mrun = mn;
        float ps = 0.f;
#pragma unroll
        for (int r = 0; r < 16; ++r) { acc[r] = exp2f(acc[r] - mn); ps += acc[r]; }
        lsum = lsum * alpha + ps;
#pragma unroll
        for (int r = 0; r < 16; ++r) { o[0][r] *= alpha; o[1][r] *= alpha; }
        bf16x8 pf[2];
#pragma unroll
        for (int ks = 0; ks < 2; ++ks) { v4u w; w.x = cvtpk(acc[8 * ks], acc[8 * ks + 1]); w.y = cvtpk(acc[8 * ks + 2], acc[8 * ks + 3]); w.z = cvtpk(acc[8 * ks + 4], acc[8 * ks + 5]); w.w = cvtpk(acc[8 * ks + 6], acc[8 * ks + 7]); pf[ks] = __builtin_bit_cast(bf16x8, w); }
#pragma unroll
        for (int dt = 0; dt < 2; ++dt)
#pragma unroll
            for (int ks = 0; ks < 2; ++ks) { v4u a; a.x = va[dt][ks][0].x; a.y = va[dt][ks][0].y; a.z = va[dt][ks][1].x; a.w = va[dt][ks][1].y; o[dt] = MFMA32(__builtin_bit_cast(bf16x8, a), pf[ks], o[dt]); }
#pragma unroll
        for (int kk = 0; kk < 6; ++kk) kf[kk] = kn[kk];
#pragma unroll
        for (int dt = 0; dt < 2; ++dt)
#pragma unroll
            for (int ks = 0; ks < 2; ++ks) { va[dt][ks][0] = vn[dt][ks][0]; va[dt][ks][1] = vn[dt][ks][1]; }
    }
#undef ML_LOAD
    lsum += __shfl_xor(lsum, 32);
    store_OT(o, 1.0f / lsum, stg, ymix + (rowb + q0) * DM + 512 + h * 64, lane);
}


__device__ __forceinline__ void sb_wave(int bh, int qblk, int lane, const bf16_t* __restrict__ P1, const bf16_t* __restrict__ VT, bf16_t* __restrict__ ymix, LAS unsigned char* wl) {
    const int b = bh >> 3, h = bh & 7, l31 = lane & 31, hi = lane >> 5, q0 = qblk * 32, t = q0 + l31;
    const size_t rowb = (size_t)b * SEQ;
    bf16x8 qf[4];
    { const bf16_t* Qp = P1 + (rowb + q0 + l31) * L1P + h * 64 + 8 * hi;
#pragma unroll
      for (int kk = 0; kk < 4; ++kk) qf[kk] = *(const bf16x8*)(Qp + 16 * kk); }
    f32x16 o[2];
#pragma unroll
    for (int r = 0; r < 16; ++r) { o[0][r] = 0.f; o[1][r] = 0.f; }
    float cum = 1.f;
    const bf16_t* gK = P1 + (rowb + (lane >> 3)) * L1P + 512 + h * 64 + (lane & 7) * 8;
    const bf16_t* gV = VT + ((size_t)bh * 64 + (lane >> 2)) * SEQ + (lane & 3) * 8;
    const int lK = (lane >> 3) * 144 + (lane & 7) * 16, lV = 4608 + (lane >> 2) * 72 + (lane & 3) * 16;
    v4u rk[4], rv[4];
#pragma unroll
    for (int i = 0; i < 4; ++i) { rk[i] = *(const v4u*)(gK + (size_t)(q0 + 8 * i) * L1P); rv[i] = *(const v4u*)(gV + (size_t)(16 * i) * SEQ + q0); }
#pragma unroll 1
    for (int s0 = q0; s0 >= 0; s0 -= 32) {
#pragma unroll
        for (int i = 0; i < 4; ++i) { *(LAS v4u*)(wl + lK + i * 8 * 144) = rk[i]; *(LAS u32x2*)(wl + lV + i * 16 * 72) = (u32x2){rv[i].x, rv[i].y}; *(LAS u32x2*)(wl + lV + i * 16 * 72 + 8) = (u32x2){rv[i].z, rv[i].w}; }
        { const int sn = (s0 >= 32) ? s0 - 32 : 0;
#pragma unroll
          for (int i = 0; i < 4; ++i) { rk[i] = *(const v4u*)(gK + (size_t)(sn + 8 * i) * L1P); rv[i] = *(const v4u*)(gV + (size_t)(16 * i) * SEQ + sn); } }
        WSYNC();
        f32x16 acc;
#pragma unroll
        for (int r = 0; r < 16; ++r) acc[r] = 0.f;
#pragma unroll
        for (int kk = 0; kk < 4; ++kk) { const bf16x8 kf = *(const LAS bf16x8*)(wl + l31 * 144 + (16 * kk + 8 * hi) * 2); acc = MFMA32(kf, qf[kk], acc); }
        const bool diag = (s0 == q0);
        float bt[16], kp[16];
#pragma unroll
        for (int r = 0; r < 16; ++r) { const float ee = __builtin_amdgcn_exp2f(fminf(acc[r] * (-0.125f * 1.4426950408889634f), 100.f)); const float ri = __builtin_amdgcn_rcpf(1.f + ee);
            float b_ = ri, k_ = ee * ri;
            if (diag) { const bool valid = (s0 + crow(r, hi)) < t; b_ = valid ? b_ : 0.f; k_ = valid ? k_ : 1.f; }
            bt[r] = b_; kp[r] = k_; }
        float e[16], T[4], U[4];
#pragma unroll
        for (int q = 0; q < 4; ++q) { e[4 * q + 3] = 1.f; e[4 * q + 2] = kp[4 * q + 3]; e[4 * q + 1] = e[4 * q + 2] * kp[4 * q + 2]; e[4 * q] = e[4 * q + 1] * kp[4 * q + 1]; T[q] = e[4 * q] * kp[4 * q]; }
#pragma unroll
        for (int q = 0; q < 4; ++q) U[q] = __shfl_xor(T[q], 32);
        { const float st2 = T[3], st1 = st2 * T[2], st0 = st1 * T[1]; const float su2 = U[3], su1 = su2 * U[2], su0 = su1 * U[1];
          const float x0 = hi ? 1.f : U[0], x1 = hi ? 1.f : U[1], x2 = hi ? 1.f : U[2], x3 = hi ? 1.f : U[3];
          const float off[4] = {cum * (st0 * su0 * x0), cum * (st1 * su1 * x1), cum * (st2 * su2 * x2), cum * x3};
#pragma unroll
          for (int r = 0; r < 16; ++r) acc[r] = bt[r] * (off[r >> 2] * e[r]);
          cum *= (st0 * T[0]) * (su0 * U[0]); }
        bf16x8 pf[2];
#pragma unroll
        for (int ks = 0; ks < 2; ++ks) pf[ks] = pack8(acc[8 * ks], acc[8 * ks + 1], acc[8 * ks + 2], acc[8 * ks + 3], acc[8 * ks + 4], acc[8 * ks + 5], acc[8 * ks + 6], acc[8 * ks + 7]);
#pragma unroll
        for (int dt = 0; dt < 2; ++dt)
#pragma unroll
            for (int ks = 0; ks < 2; ++ks) { const LAS unsigned char* vp = wl + 4608 + (32 * dt + l31) * 72 + (16 * ks + 4 * hi) * 2;
                const u32x2 x0 = *(const LAS u32x2*)vp, x1 = *(const LAS u32x2*)(vp + 16);
                v4u a; a.x = x0.x; a.y = x0.y; a.z = x1.x; a.w = x1.y; o[dt] = MFMA32(__builtin_bit_cast(bf16x8, a), pf[ks], o[dt]); }
        WSYNC();
        if (__all(cum < 1e-35f)) break;
    }
    store_OT(o, 1.0f, (LAS bf16_t*)(wl + 9216), ymix + (rowb + q0) * DM + h * 64, lane);
}

constexpr int MLK_PITCH = 104, MLV_PITCH = 68, MLK_BYTES = 64 * MLK_PITCH * 2, MLV_BYTES = 64 * MLV_PITCH * 2, ML_STAGE = MLK_BYTES + MLV_BYTES;
__device__ __forceinline__ void mla_block(int bh, int sb, int tid, int lane, int wave, LAS unsigned char* lds, const bf16_t* __restrict__ QM, const bf16_t* __restrict__ KVM, const bf16_t* __restrict__ KPE,
                                          const bf16_t* __restrict__ VT, bf16_t* __restrict__ ymix, const float* __restrict__ cstab) {
    const int b = bh >> 3, h = bh & 7, l31 = lane & 31, hi = lane >> 5, q0 = 256 * sb + 32 * wave, t = q0 + l31;
    const size_t rowb = (size_t)b * SEQ;
    const int nsteps = 4 * sb + 4;
    bf16x8 qf[6];
    { const bf16_t* Qp = QM + (rowb + q0 + l31) * 768 + h * 96 + 8 * hi;
#pragma unroll
      for (int kk = 0; kk < 6; ++kk) qf[kk] = *(const bf16x8*)(Qp + 16 * kk);
      const float* ct = cstab + (rowb + q0 + l31) * 32 + 8 * hi;
      const f32x4 c0 = *(const f32x4*)ct, c1 = *(const f32x4*)(ct + 4), s0 = *(const f32x4*)(ct + 16), s1 = *(const f32x4*)(ct + 20);
#pragma unroll
      for (int j = 0; j < 8; ++j) { const float cs = j < 4 ? c0[j & 3] : c1[j & 3], sn = j < 4 ? s0[j & 3] : s1[j & 3];
          const float x1 = bf2f((bf16_t)qf[4][j]), x2 = bf2f((bf16_t)qf[5][j]);
          qf[4][j] = (short)bf1(x1 * cs - x2 * sn); qf[5][j] = (short)bf1(x2 * cs + x1 * sn); } }
    const float sc2 = 0.10206207261596577f * 1.4426950408889634f;
    f32x16 o[2];
#pragma unroll
    for (int r = 0; r < 16; ++r) { o[0][r] = 0.f; o[1][r] = 0.f; }
    float mrun = -1e30f, lsum = 0.f;
    const bf16_t* gKn = KVM + (rowb + (tid >> 3)) * 1024 + h * 128 + (tid & 7) * 8;
    const bf16_t* gKr = KPE + (rowb + ((tid & 255) >> 2)) * 32 + (tid & 3) * 8;
    const bf16_t* gVt = VT + ((size_t)bh * 64 + (tid >> 3)) * SEQ + (tid & 7) * 8;
    const int lKn = (tid >> 3) * (MLK_PITCH * 2) + (tid & 7) * 16, lKr = ((tid & 255) >> 2) * (MLK_PITCH * 2) + 128 + (tid & 3) * 16, lVt = MLK_BYTES + (tid >> 3) * (MLV_PITCH * 2) + (tid & 7) * 16;
    v4u rk, rr, rv;
    rk = *(const v4u*)gKn; rr = *(const v4u*)gKr; rv = *(const v4u*)gVt;
    *(LAS v4u*)(lds + lKn) = rk; if (tid < 256) *(LAS v4u*)(lds + lKr) = rr; *(LAS u32x2*)(lds + lVt) = (u32x2){rv.x, rv.y}; *(LAS u32x2*)(lds + lVt + 8) = (u32x2){rv.z, rv.w};
    __syncthreads();
#pragma unroll 1
    for (int step = 0; step < nsteps; ++step) {
        const int nx = (step + 1 < nsteps) ? step + 1 : step;
        rk = *(const v4u*)(gKn + (size_t)nx * 64 * 1024); rr = *(const v4u*)(gKr + (size_t)nx * 64 * 32); rv = *(const v4u*)(gVt + nx * 64);
        const LAS unsigned char* Kb = lds + (step & 1) * ML_STAGE;
        const LAS unsigned char* Vb = Kb + MLK_BYTES;
        if (64 * step <= q0) {
            f32x16 acc[2];
            {
                bf16x8 kf[2][6];
#pragma unroll
                for (int sub = 0; sub < 2; ++sub)
#pragma unroll
                    for (int kk = 0; kk < 6; ++kk) kf[sub][kk] = *(const LAS bf16x8*)(Kb + (32 * sub + l31) * (MLK_PITCH * 2) + (16 * kk + 8 * hi) * 2);
                __builtin_amdgcn_sched_barrier(0);
#pragma unroll
                for (int r = 0; r < 16; ++r) { acc[0][r] = 0.f; acc[1][r] = 0.f; }
#pragma unroll
                for (int kk = 0; kk < 6; ++kk) { acc[0] = MFMA32(kf[0][kk], qf[kk], acc[0]); acc[1] = MFMA32(kf[1][kk], qf[kk], acc[1]); }
            }
            u32x2 vx[2][2][2][2];
#pragma unroll
            for (int sub = 0; sub < 2; ++sub)
#pragma unroll
                for (int dt = 0; dt < 2; ++dt)
#pragma unroll
                    for (int ks = 0; ks < 2; ++ks) { const LAS unsigned char* vp = Vb + (32 * dt + l31) * (MLV_PITCH * 2) + (32 * sub + 16 * ks + 4 * hi) * 2;
                        vx[sub][dt][ks][0] = *(const LAS u32x2*)vp; vx[sub][dt][ks][1] = *(const LAS u32x2*)(vp + 16); }
            __builtin_amdgcn_sched_barrier(0);
            float tmax = -1e30f;
#pragma unroll
            for (int sub = 0; sub < 2; ++sub) { const int s0 = 64 * step + 32 * sub;
                if (s0 + 31 > q0) {
#pragma unroll
                    for (int r = 0; r < 16; ++r) if ((s0 + crow(r, hi)) > t) acc[sub][r] = -1e30f; }
#pragma unroll
                for (int r = 0; r < 16; ++r) tmax = fmaxf(tmax, acc[sub][r]); }
            tmax = fmaxf(tmax, __shfl_xor(tmax, 32)) * sc2;
            if (__any(tmax - mrun > 6.f)) {
                const float mn = fmaxf(mrun, tmax), alpha = __builtin_amdgcn_exp2f(mrun - mn); mrun = mn; lsum *= alpha;
#pragma unroll
                for (int r = 0; r < 16; ++r) { o[0][r] *= alpha; o[1][r] *= alpha; }
            }
            float ps = 0.f;
#pragma unroll
            for (int sub = 0; sub < 2; ++sub)
#pragma unroll
                for (int r = 0; r < 16; ++r) { acc[sub][r] = __builtin_amdgcn_exp2f(acc[sub][r] * sc2 - mrun); ps += acc[sub][r]; }
            lsum += ps;
#pragma unroll
            for (int sub = 0; sub < 2; ++sub) {
                bf16x8 pf[2];
#pragma unroll
                for (int ks = 0; ks < 2; ++ks) pf[ks] = pack8(acc[sub][8 * ks], acc[sub][8 * ks + 1], acc[sub][8 * ks + 2], acc[sub][8 * ks + 3], acc[sub][8 * ks + 4], acc[sub][8 * ks + 5], acc[sub][8 * ks + 6], acc[sub][8 * ks + 7]);
#pragma unroll
                for (int ks = 0; ks < 2; ++ks)
#pragma unroll
                    for (int dt = 0; dt < 2; ++dt) { v4u a; a.x = vx[sub][dt][ks][0].x; a.y = vx[sub][dt][ks][0].y; a.z = vx[sub][dt][ks][1].x; a.w = vx[sub][dt][ks][1].y;
                        o[dt] = MFMA32(__builtin_bit_cast(bf16x8, a), pf[ks], o[dt]); }
            }
        }
        LAS unsigned char* nb = lds + ((step + 1) & 1) * ML_STAGE;
        *(LAS v4u*)(nb + lKn) = rk; if (tid < 256) *(LAS v4u*)(nb + lKr) = rr; *(LAS u32x2*)(nb + lVt) = (u32x2){rv.x, rv.y}; *(LAS u32x2*)(nb + lVt + 8) = (u32x2){rv.z, rv.w};
        __syncthreads();
    }
    lsum += __shfl_xor(lsum, 32);
    store_OT(o, 1.0f / lsum, (LAS bf16_t*)(lds + 2 * ML_STAGE) + wave * (32 * STG_PITCH), ymix + (rowb + q0) * DM + 512 + h * 64, lane);
    __syncthreads();
}


constexpr int SBK_PITCH = 72, SBK_BYTES = 64 * SBK_PITCH * 2, SB_STAGE = SBK_BYTES + MLV_BYTES;
__device__ __forceinline__ void sb_block(int bh, int sb, int tid, int lane, int wave, LAS unsigned char* lds, const bf16_t* __restrict__ P1, const bf16_t* __restrict__ VT, bf16_t* __restrict__ ymix) {
    const int b = bh >> 3, h = bh & 7, l31 = lane & 31, hi = lane >> 5, q0 = 256 * sb + 32 * wave, t = q0 + l31;
    const size_t rowb = (size_t)b * SEQ;
    bf16x8 qf[4];
    { const bf16_t* Qp = P1 + (rowb + q0 + l31) * L1P + h * 64 + 8 * hi;
#pragma unroll
      for (int kk = 0; kk < 4; ++kk) qf[kk] = *(const bf16x8*)(Qp + 16 * kk); }
    f32x16 o[2];
#pragma unroll
    for (int r = 0; r < 16; ++r) { o[0][r] = 0.f; o[1][r] = 0.f; }
    float cum = 1.f; bool done = false;
    volatile LAS unsigned* flags = (volatile LAS unsigned*)(lds + 2 * SB_STAGE);
    const bf16_t* gK = P1 + (rowb + (tid >> 3)) * L1P + 512 + h * 64 + (tid & 7) * 8;
    const bf16_t* gVt = VT + ((size_t)bh * 64 + (tid >> 3)) * SEQ + (tid & 7) * 8;
    const int lK = (tid >> 3) * (SBK_PITCH * 2) + (tid & 7) * 16, lVt = SBK_BYTES + (tid >> 3) * (MLV_PITCH * 2) + (tid & 7) * 16;
    const int top = 4 * sb + 3;
    v4u rk, rv;
    rk = *(const v4u*)(gK + (size_t)top * 64 * L1P); rv = *(const v4u*)(gVt + top * 64);
    *(LAS v4u*)(lds + lK) = rk; *(LAS u32x2*)(lds + lVt) = (u32x2){rv.x, rv.y}; *(LAS u32x2*)(lds + lVt + 8) = (u32x2){rv.z, rv.w};
    __syncthreads();
#pragma unroll 1
    for (int i = 0; i <= top; ++i) {
        const int step = top - i, nx = (step > 0) ? step - 1 : 0;
        rk = *(const v4u*)(gK + (size_t)nx * 64 * L1P); rv = *(const v4u*)(gVt + nx * 64);
        const LAS unsigned char* Kb = lds + (i & 1) * SB_STAGE;
        const LAS unsigned char* Vb = Kb + SBK_BYTES;
#pragma unroll
        for (int sub = 1; sub >= 0; --sub) {
            const int s0 = 64 * step + 32 * sub;
            if (s0 <= q0 && !done) {
                f32x16 acc;
#pragma unroll
                for (int r = 0; r < 16; ++r) acc[r] = 0.f;
#pragma unroll
                for (int kk = 0; kk < 4; ++kk) { const bf16x8 kf = *(const LAS bf16x8*)(Kb + (32 * sub + l31) * (SBK_PITCH * 2) + (16 * kk + 8 * hi) * 2); acc = MFMA32(kf, qf[kk], acc); }
                const bool diag = (s0 == q0);
                float bt[16], kp[16];
#pragma unroll
                for (int r = 0; r < 16; ++r) { const float ee = __builtin_amdgcn_exp2f(fminf(acc[r] * (-0.125f * 1.4426950408889634f), 100.f)); const float ri = __builtin_amdgcn_rcpf(1.f + ee);
                    float b_ = ri, k_ = ee * ri;
                    if (diag) { const bool valid = (s0 + crow(r, hi)) < t; b_ = valid ? b_ : 0.f; k_ = valid ? k_ : 1.f; }
                    bt[r] = b_; kp[r] = k_; }
                float e[16], T[4], U[4];
#pragma unroll
                for (int q = 0; q < 4; ++q) { e[4 * q + 3] = 1.f; e[4 * q + 2] = kp[4 * q + 3]; e[4 * q + 1] = e[4 * q + 2] * kp[4 * q + 2]; e[4 * q] = e[4 * q + 1] * kp[4 * q + 1]; T[q] = e[4 * q] * kp[4 * q]; }
#pragma unroll
                for (int q = 0; q < 4; ++q) U[q] = __shfl_xor(T[q], 32);
                { const float st2 = T[3], st1 = st2 * T[2], st0 = st1 * T[1]; const float su2 = U[3], su1 = su2 * U[2], su0 = su1 * U[1];
                  const float x0 = hi ? 1.f : U[0], x1 = hi ? 1.f : U[1], x2 = hi ? 1.f : U[2], x3 = hi ? 1.f : U[3];
                  const float off[4] = {cum * (st0 * su0 * x0), cum * (st1 * su1 * x1), cum * (st2 * su2 * x2), cum * x3};
#pragma unroll
                  for (int r = 0; r < 16; ++r) acc[r] = bt[r] * (off[r >> 2] * e[r]);
                  cum *= (st0 * T[0]) * (su0 * U[0]); }
                bf16x8 pf[2];
#pragma unroll
                for (int ks = 0; ks < 2; ++ks) { v4u w; w.x = cvtpk(acc[8 * ks], acc[8 * ks + 1]); w.y = cvtpk(acc[8 * ks + 2], acc[8 * ks + 3]); w.z = cvtpk(acc[8 * ks + 4], acc[8 * ks + 5]); w.w = cvtpk(acc[8 * ks + 6], acc[8 * ks + 7]); pf[ks] = __builtin_bit_cast(bf16x8, w); }
#pragma unroll
                for (int dt = 0; dt < 2; ++dt)
#pragma unroll
                    for (int ks = 0; ks < 2; ++ks) { const LAS unsigned char* vp = Vb + (32 * dt + l31) * (MLV_PITCH * 2) + (32 * sub + 16 * ks + 4 * hi) * 2;
                        const u32x2 x0 = *(const LAS u32x2*)vp, x1 = *(const LAS u32x2*)(vp + 16);
                        v4u a; a.x = x0.x; a.y = x0.y; a.z = x1.x; a.w = x1.y; o[dt] = MFMA32(__builtin_bit_cast(bf16x8, a), pf[ks], o[dt]); }
                done = __all(cum < 1e-35f);
            }
        }
        if (lane == 0) flags[(i & 1) * 8 + wave] = done ? 1u : 0u;
        LAS unsigned char* nb = lds + ((i + 1) & 1) * SB_STAGE;
        *(LAS v4u*)(nb + lK) = rk; *(LAS u32x2*)(nb + lVt) = (u32x2){rv.x, rv.y}; *(LAS u32x2*)(nb + lVt + 8) = (u32x2){rv.z, rv.w};
        __syncthreads();
        unsigned nd = 0;
#pragma unroll
        for (int w8 = 0; w8 < 8; ++w8) nd += flags[(i & 1) * 8 + w8];
        if (nd == 8u) break;
    }
    store_OT(o, 1.0f, (LAS bf16_t*)(lds + 2 * SB_STAGE + 256) + wave * (32 * STG_PITCH), ymix + (rowb + q0) * DM + h * 64, lane);
    __syncthreads();
}

constexpr int RW_RAWW = 0, RW_RAWA = 2048, RW_RS = 4096, RW_KS = 6144, RW_VS = 8192;
constexpr int RW_CH0 = 10240, RW_CHSZ = 11328;
constexpr int RW_YB = RW_CH0 + 2 * RW_CHSZ;
constexpr int RW_MIX = RW_YB + 1024;
static_assert((RW_MIX + 256) * 4 <= 146432, "rwkv LDS map");
__device__ __forceinline__ float tanh_fast(float x) { return 1.f - 2.f * __builtin_amdgcn_rcpf(1.f + __expf(2.f * x)); }
__device__ __forceinline__ float sigmoid_fast(float x) { return __builtin_amdgcn_rcpf(1.f + __expf(-x)); }

#define MFMA16(a, b, c) __builtin_amdgcn_mfma_f32_16x16x32_bf16((a), (b), (c), 0, 0, 0)
constexpr int RW2_CH0 = 0, RW2_YB = 2 * RW_CHSZ, RW2_MIX = RW2_YB + 1024, RW2_STG = RW2_MIX + 448;
static_assert((RW2_STG + 2 * 3072) * 4 <= 146432, "rwkv LDS map");
__device__ __forceinline__ void rwkv_phase_scan(LAS float* sm, int tid, int lane, int wave, int blk, const bf16_t* __restrict__ proj, const float* __restrict__ mix, const float* __restrict__ w0, const float* __restrict__ a0,
                                           const float* __restrict__ k_k, const float* __restrict__ k_a, const float* __restrict__ r_k, const bf16_t* __restrict__ W2T, const bf16_t* __restrict__ A2T, const bf16_t* __restrict__ G2T,
                                           float* __restrict__ yraw, bf16_t* __restrict__ gout, float* __restrict__ bonus_out) {
    const int chain = blk >> 1, half = blk & 1, b = chain >> 3, h = chain & 7, l15 = lane & 15, kg = lane >> 4;
    const size_t rowb = (size_t)b * SEQ;
    constexpr int NCHUNK = SEQ / 32;
    if (tid < 256) sm[RW2_MIX + tid] = mix[1536 + tid];
    else if (tid < 448) { const int q = tid - 256; sm[RW2_MIX + tid] = mix[512 * (q >> 6) + h * 64 + (q & 63)]; }
    __syncthreads();
#define RW_SH8(CUR, PRV, M0, M1, OUT, PZ) do { const unsigned cu_[4] = {(CUR).x, (CUR).y, (CUR).z, (CUR).w}, pu_[4] = {(PRV).x, (PRV).y, (PRV).z, (PRV).w}; \
        const float mm_[8] = {(M0)[0], (M0)[1], (M0)[2], (M0)[3], (M1)[0], (M1)[1], (M1)[2], (M1)[3]}; \
        _Pragma("unroll") for (int q = 0; q < 4; ++q) { const float c0 = bflo(cu_[q]), c1 = bfhi(cu_[q]), p0 = bflo(pu_[q]) * (PZ), p1 = bfhi(pu_[q]) * (PZ); \
            OUT[2 * q] = c0 + (p0 - c0) * mm_[2 * q]; OUT[2 * q + 1] = c1 + (p1 - c1) * mm_[2 * q + 1]; } } while (0)
    if (wave < 4) {
        const int iA = 8 * wave + kg, iB = iA + 4, jseg = l15;
        float A0 = 0.f, A1 = 0.f, A2 = 0.f, A3 = 0.f, B0 = 0.f, B1 = 0.f, B2 = 0.f, B3 = 0.f;
        __syncthreads();
#pragma unroll 1
        for (int ch = 0; ch < NCHUNK; ++ch) {
            const int t0 = ch * 32;
            const LAS float* CHb = sm + RW2_CH0 + (ch & 1) * RW_CHSZ + 4 * jseg;
            const LAS float* CHv = sm + RW2_CH0 + (ch & 1) * RW_CHSZ + 10240 + iA;
            const LAS float* CHs = sm + RW2_CH0 + (ch & 1) * RW_CHSZ + 11264;
            f32x4 a4 = *(const LAS f32x4*)(CHb + 4096), wr4 = *(const LAS f32x4*)(CHb + 8192), w4 = *(const LAS f32x4*)(CHb), b4 = *(const LAS f32x4*)(CHb + 6144), k4 = *(const LAS f32x4*)(CHb + 2048);
            float vA = CHv[0], vB = CHv[4]; f32x2_t sc = *(const LAS f32x2_t*)(CHs);
#pragma unroll 2
            for (int t = 0; t < 32; ++t) {
                const int tq = (t + 1) & 31;
                const f32x4 a4n = *(const LAS f32x4*)(CHb + 4096 + tq * 64), wr4n = *(const LAS f32x4*)(CHb + 8192 + tq * 64), w4n = *(const LAS f32x4*)(CHb + tq * 64),
                            b4n = *(const LAS f32x4*)(CHb + 6144 + tq * 64), k4n = *(const LAS f32x4*)(CHb + 2048 + tq * 64);
                const float vAn = CHv[tq * 32], vBn = CHv[tq * 32 + 4]; const f32x2_t scn = *(const LAS f32x2_t*)(CHs + 2 * tq);
                float d1A = (A0 * a4[0] + A1 * a4[1]) + (A2 * a4[2] + A3 * a4[3]), d1B = (B0 * a4[0] + B1 * a4[1]) + (B2 * a4[2] + B3 * a4[3]);
                float d2A = (A0 * wr4[0] + A1 * wr4[1]) + (A2 * wr4[2] + A3 * wr4[3]), d2B = (B0 * wr4[0] + B1 * wr4[1]) + (B2 * wr4[2] + B3 * wr4[3]);
                d1A = rowsum16(d1A); d1B = rowsum16(d1B); d2A = rowsum16(d2A); d2B = rowsum16(d2B);
                const float yA = d2A + d1A * sc[0] + vA * sc[1], yB = d2B + d1B * sc[0] + vB * sc[1];
                A0 = A0 * w4[0] + (d1A * b4[0] + vA * k4[0]); A1 = A1 * w4[1] + (d1A * b4[1] + vA * k4[1]); A2 = A2 * w4[2] + (d1A * b4[2] + vA * k4[2]); A3 = A3 * w4[3] + (d1A * b4[3] + vA * k4[3]);
                B0 = B0 * w4[0] + (d1B * b4[0] + vB * k4[0]); B1 = B1 * w4[1] + (d1B * b4[1] + vB * k4[1]); B2 = B2 * w4[2] + (d1B * b4[2] + vB * k4[2]); B3 = B3 * w4[3] + (d1B * b4[3] + vB * k4[3]);
                if (jseg == 0) { sm[RW2_YB + t * 32 + iA] = yA; sm[RW2_YB + t * 32 + iB] = yB; }
                a4 = a4n; wr4 = wr4n; w4 = w4n; b4 = b4n; k4 = k4n; vA = vAn; vB = vBn; sc = scn;
            }
            WSYNC();
            { const int tt = lane >> 1, hh = lane & 1; const f32x4 yv = *(const LAS f32x4*)(sm + RW2_YB + tt * 32 + 8 * wave + 4 * hh);
              *(f32x4*)(yraw + (rowb + t0 + tt) * 512 + h * 64 + half * 32 + 8 * wave + 4 * hh) = yv; }
            __syncthreads();
        }
    } else if (wave < 6) {
        const int tp = wave - 4, tb = 16 * tp;
        LAS float* stg = sm + RW2_STG + tp * 3072;
        float w0c[4], a0c[4], kkc[4], kac[4], rkc[4];
#pragma unroll
        for (int nt = 0; nt < 4; ++nt) { const int c = h * 64 + 16 * nt + l15; w0c[nt] = w0[c]; a0c[nt] = a0[c]; kkc[nt] = k_k[c]; kac[nt] = k_a[c]; rkc[nt] = r_k[c]; }
        v4u ld[20];
#define PREP_ISSUE(T0) do { const int t0_ = (T0); { const size_t r_ = rowb + t0_ + tb + l15; const size_t rp_ = (t0_ + tb + l15 == 0) ? r_ : r_ - 1; \
            _Pragma("unroll") for (int lo = 0; lo < 2; ++lo) _Pragma("unroll") for (int ks = 0; ks < 2; ++ks) { const int col = 1536 + 64 * lo + 32 * ks + 8 * kg; \
                ld[(lo * 2 + ks) * 2] = *(const v4u*)(proj + r_ * L0P + col); ld[(lo * 2 + ks) * 2 + 1] = *(const v4u*)(proj + rp_ * L0P + col); } } \
            _Pragma("unroll") for (int ar = 0; ar < 3; ++ar) _Pragma("unroll") for (int i = 0; i < 2; ++i) { const int p_ = lane + 64 * i, row_ = p_ >> 3, c8_ = p_ & 7; \
                const size_t r_ = rowb + t0_ + tb + row_; const size_t rp_ = (t0_ + tb + row_ == 0) ? r_ : r_ - 1; const int col = 512 * ar + h * 64 + 8 * c8_; \
                ld[8 + (ar * 2 + i) * 2] = *(const v4u*)(proj + r_ * L0P + col); ld[8 + (ar * 2 + i) * 2 + 1] = *(const v4u*)(proj + rp_ * L0P + col); } } while (0)
#define PREP_BUILD(T0, NB) do { const int t0_ = (T0); LAS float* CHn = sm + RW2_CH0 + (NB) * RW_CHSZ; \
            f32x4 accw[4], acca[4]; \
            _Pragma("unroll") for (int nt = 0; nt < 4; ++nt) { accw[nt] = (f32x4){0.f, 0.f, 0.f, 0.f}; acca[nt] = (f32x4){0.f, 0.f, 0.f, 0.f}; } \
            { const float pz_ = (t0_ + tb + l15 == 0) ? 0.f : 1.f; \
              _Pragma("unroll") for (int lo = 0; lo < 2; ++lo) _Pragma("unroll") for (int ks = 0; ks < 2; ++ks) { float s_[8]; \
                const f32x4 m0 = *(const LAS f32x4*)(sm + RW2_MIX + 64 * lo + 32 * ks + 8 * kg), m1 = *(const LAS f32x4*)(sm + RW2_MIX + 64 * lo + 32 * ks + 8 * kg + 4); \
                RW_SH8(ld[(lo * 2 + ks) * 2], ld[(lo * 2 + ks) * 2 + 1], m0, m1, s_, pz_); \
                if (lo == 0) { _Pragma("unroll") for (int j = 0; j < 8; ++j) s_[j] = tanh_fast(s_[j]); } \
                v4u aw; aw.x = cvtpk(s_[0], s_[1]); aw.y = cvtpk(s_[2], s_[3]); aw.z = cvtpk(s_[4], s_[5]); aw.w = cvtpk(s_[6], s_[7]); const bf16x8 af = __builtin_bit_cast(bf16x8, aw); \
                const bf16_t* WT = lo ? A2T : W2T; \
                _Pragma("unroll") for (int nt = 0; nt < 4; ++nt) { const bf16x8 bfr = *(const bf16x8*)(WT + (size_t)(h * 64 + 16 * nt + l15) * 64 + 32 * ks + 8 * kg); \
                    if (lo == 0) accw[nt] = MFMA16(af, bfr, accw[nt]); else acca[nt] = MFMA16(af, bfr, acca[nt]); } } } \
            _Pragma("unroll") for (int ar = 0; ar < 3; ++ar) _Pragma("unroll") for (int i = 0; i < 2; ++i) { const int p_ = lane + 64 * i, row_ = p_ >> 3, c8_ = p_ & 7; float s_[8]; \
                const float pz_ = (t0_ + tb + row_ == 0) ? 0.f : 1.f; const f32x4 m0 = *(const LAS f32x4*)(sm + RW2_MIX + 256 + ar * 64 + c8_ * 8), m1 = *(const LAS f32x4*)(sm + RW2_MIX + 256 + ar * 64 + c8_ * 8 + 4); \
                RW_SH8(ld[8 + (ar * 2 + i) * 2], ld[8 + (ar * 2 + i) * 2 + 1], m0, m1, s_, pz_); \
                *(LAS f32x4*)(stg + ar * 1024 + row_ * 64 + c8_ * 8) = (f32x4){s_[0], s_[1], s_[2], s_[3]}; *(LAS f32x4*)(stg + ar * 1024 + row_ * 64 + c8_ * 8 + 4) = (f32x4){s_[4], s_[5], s_[6], s_[7]}; } \
            WSYNC(); \
            PREP_ISSUE(((T0) + 32 < SEQ) ? (T0) + 32 : (T0)); \
            _Pragma("unroll") for (int rg = 0; rg < 4; ++rg) { const int tl = 4 * kg + rg, t = tb + tl; \
                float r_[4], k_[4], v_[4], kkv[4], nrm2 = 0.f; \
                _Pragma("unroll") for (int nt = 0; nt < 4; ++nt) { r_[nt] = stg[tl * 64 + 16 * nt + l15]; k_[nt] = stg[1024 + tl * 64 + 16 * nt + l15]; v_[nt] = stg[2048 + tl * 64 + 16 * nt + l15]; \
                    kkv[nt] = k_[nt] * kkc[nt]; nrm2 += kkv[nt] * kkv[nt]; } \
                nrm2 = rowsum16(nrm2); const float rn = __builtin_amdgcn_rsqf(fmaxf(nrm2, 1e-24f)); \
                float br = 0.f, kr = 0.f, bon = 0.f; \
                _Pragma("unroll") for (int nt = 0; nt < 4; ++nt) { const int j = 16 * nt + l15; \
                    const float wsum = w0c[nt] + accw[nt][rg]; const float logw = -softplus_fast(-wsum) - 0.5f; const float dec = __expf(-__expf(logw)); \
                    const float a_ = sigmoid_fast(a0c[nt] + acca[nt][rg]); const float kn = kkv[nt] * rn; \
                    const float k2 = k_[nt] * (1.f + (a_ - 1.f) * kac[nt]); const float bv = kn * a_; \
                    br += bv * r_[nt]; kr += k2 * r_[nt]; bon += r_[nt] * k2 * rkc[nt]; \
                    CHn[t * 64 + j] = dec; CHn[2048 + t * 64 + j] = k2; CHn[4096 + t * 64 + j] = -kn; CHn[6144 + t * 64 + j] = bv; CHn[8192 + t * 64 + j] = dec * r_[nt]; \
                    if ((nt >> 1) == half) CHn[10240 + t * 32 + (j & 31)] = v_[nt]; } \
                br = rowsum16(br); kr = rowsum16(kr); bon = rowsum16(bon); \
                if (l15 == 0) { CHn[11264 + 2 * t] = br; CHn[11264 + 2 * t + 1] = kr; if (half == 0) bonus_out[(rowb + t0_ + t) * 8 + h] = bon; } } \
            WSYNC(); } while (0)
        PREP_ISSUE(0);
        PREP_BUILD(0, 0);
        __syncthreads();
#pragma unroll 1
        for (int ch = 0; ch < NCHUNK; ++ch) {
            if (ch + 1 < NCHUNK) PREP_BUILD(ch * 32 + 32, (ch + 1) & 1);
            __syncthreads();
        }
#undef PREP_ISSUE
#undef PREP_BUILD
    } else {
        const int tp = wave - 6, tb = 16 * tp;
        v4u ld[8];
#define G_ISSUE(T0) do { const int t0_ = (T0); const size_t r_ = rowb + t0_ + tb + l15; const size_t rp_ = (t0_ + tb + l15 == 0) ? r_ : r_ - 1; \
            _Pragma("unroll") for (int ks = 0; ks < 4; ++ks) { const int col = 1664 + 32 * ks + 8 * kg; ld[2 * ks] = *(const v4u*)(proj + r_ * L0P + col); ld[2 * ks + 1] = *(const v4u*)(proj + rp_ * L0P + col); } } while (0)
#define G_BUILD(T0) do { const int t0_ = (T0); f32x4 accg[2] = {(f32x4){0.f, 0.f, 0.f, 0.f}, (f32x4){0.f, 0.f, 0.f, 0.f}}; const float pz_ = (t0_ + tb + l15 == 0) ? 0.f : 1.f; \
            _Pragma("unroll") for (int ks = 0; ks < 4; ++ks) { float s_[8]; \
                const f32x4 m0 = *(const LAS f32x4*)(sm + RW2_MIX + 128 + 32 * ks + 8 * kg), m1 = *(const LAS f32x4*)(sm + RW2_MIX + 128 + 32 * ks + 8 * kg + 4); \
                RW_SH8(ld[2 * ks], ld[2 * ks + 1], m0, m1, s_, pz_); \
                _Pragma("unroll") for (int j = 0; j < 8; ++j) s_[j] = sigmoid_fast(s_[j]); \
                v4u aw; aw.x = cvtpk(s_[0], s_[1]); aw.y = cvtpk(s_[2], s_[3]); aw.z = cvtpk(s_[4], s_[5]); aw.w = cvtpk(s_[6], s_[7]); const bf16x8 af = __builtin_bit_cast(bf16x8, aw); \
                _Pragma("unroll") for (int nt = 0; nt < 2; ++nt) { const bf16x8 bfr = *(const bf16x8*)(G2T + (size_t)(h * 64 + half * 32 + 16 * nt + l15) * 128 + 32 * ks + 8 * kg); accg[nt] = MFMA16(af, bfr, accg[nt]); } } \
            G_ISSUE(((T0) + 32 < SEQ) ? (T0) + 32 : (T0)); \
            _Pragma("unroll") for (int nt = 0; nt < 2; ++nt) _Pragma("unroll") for (int rg = 0; rg < 4; ++rg) \
                gout[(rowb + t0_ + tb + 4 * kg + rg) * 512 + h * 64 + half * 32 + 16 * nt + l15] = (bf16_t)f2bf(accg[nt][rg]); } while (0)
        G_ISSUE(0);
        G_BUILD(0);
        __syncthreads();
#pragma unroll 1
        for (int ch = 0; ch < NCHUNK; ++ch) {
            if (ch + 1 < NCHUNK) G_BUILD(ch * 32 + 32);
            __syncthreads();
        }
#undef G_ISSUE
#undef G_BUILD
    }
#undef RW_SH8
    __syncthreads();
}

constexpr int CK_BK = 0, CK_AR = 4608, CK_BBT = 9216, CK_KBT = 12288, CK_VT = 15360, CK_GC = 16896, CK_TT = 17152, CK_SLOT = 18688, CK_NSLOT = 6, CK_NBUILD = 5;
constexpr int CK_STG = CK_SLOT * CK_NSLOT;
constexpr int CK_MIX = CK_STG + CK_NBUILD * 6144;
constexpr int CK_FLAGS = CK_MIX + 448 * 4;
static_assert(CK_FLAGS + 64 <= 146432, "rwkv chunked LDS map");
__device__ __forceinline__ void rwkv_phase(LAS float* smf, int tid, int lane, int wave, int blk, const bf16_t* __restrict__ proj, const float* __restrict__ mix, const float* __restrict__ w0, const float* __restrict__ a0,
                                           const float* __restrict__ k_k, const float* __restrict__ k_a, const float* __restrict__ r_k, const bf16_t* __restrict__ W2T, const bf16_t* __restrict__ A2T, const bf16_t* __restrict__ G2T,
                                           float* __restrict__ yraw, bf16_t* __restrict__ gout, float* __restrict__ bonus_out) {
    LAS unsigned char* lds = (LAS unsigned char*)smf;
    LAS float* mixs = (LAS float*)(lds + CK_MIX);
    volatile LAS unsigned* flags = (volatile LAS unsigned*)(lds + CK_FLAGS);
    const int chain = blk >> 1, ihalf = blk & 1, b = chain >> 3, h = chain & 7, l15 = lane & 15, kg = lane >> 4, l31 = lane & 31, hi = lane >> 5;
    const size_t rowb = (size_t)b * SEQ;
    constexpr int NCH = SEQ / 16;
    if (tid < 256) mixs[tid] = mix[1536 + tid];
    else if (tid < 448) { const int q = tid - 256; mixs[tid] = mix[512 * (q >> 6) + h * 64 + (q & 63)]; }
    if (tid < 16) flags[tid] = (tid == 9) ? (unsigned)CK_NBUILD : 0u;
    for (int q = tid; q < CK_NSLOT * 384; q += NWAVES * 64) *(LAS unsigned*)(lds + (q / 384) * CK_SLOT + CK_TT + (q % 384) * 4) = 0u;
    __syncthreads();
#define RW_SH8(CUR, PRV, M0, M1, OUT, PZ) do { const unsigned cu_[4] = {(CUR).x, (CUR).y, (CUR).z, (CUR).w}, pu_[4] = {(PRV).x, (PRV).y, (PRV).z, (PRV).w}; \
        const float mm_[8] = {(M0)[0], (M0)[1], (M0)[2], (M0)[3], (M1)[0], (M1)[1], (M1)[2], (M1)[3]}; \
        _Pragma("unroll") for (int q = 0; q < 4; ++q) { const float c0 = bflo(cu_[q]), c1 = bfhi(cu_[q]), p0 = bflo(pu_[q]) * (PZ), p1 = bfhi(pu_[q]) * (PZ); \
            OUT[2 * q] = c0 + (p0 - c0) * mm_[2 * q]; OUT[2 * q + 1] = c1 + (p1 - c1) * mm_[2 * q + 1]; } } while (0)
    if (wave == 0) {
        f32x16 ST[2];
#pragma unroll
        for (int r = 0; r < 16; ++r) { ST[0][r] = 0.f; ST[1][r] = 0.f; }
#pragma unroll 1
        for (int k = 0; k < NCH; ++k) {
#if defined(PROBE_STAMPS)
            const unsigned tw0_ = (unsigned)__builtin_amdgcn_s_memrealtime();
#endif
            { const unsigned want = (unsigned)(k + 1); const int sl = k % CK_NSLOT; while (flags[sl] != want) __builtin_amdgcn_s_sleep(1); }
#if defined(PROBE_STAMPS)
            if (blk == 0 && lane == 0) ((volatile LAS unsigned*)(lds + 146432 + 320))[16 + 24] += (unsigned)__builtin_amdgcn_s_memrealtime() - tw0_;
#endif
            asm volatile("" ::: "memory");
            const LAS unsigned char* im = lds + (k % CK_NSLOT) * CK_SLOT;
            f32x16 G;
#pragma unroll
            for (int r = 0; r < 16; ++r) G[r] = 0.f;
#pragma unroll
            for (int kk = 0; kk < 4; ++kk) { const bf16x8 fa = *(const LAS bf16x8*)(im + CK_BK + l31 * 144 + (16 * kk + 8 * hi) * 2), fb = *(const LAS bf16x8*)(im + CK_AR + l31 * 144 + (16 * kk + 8 * hi) * 2); G = MFMA32(fa, fb, G); }
            { const int tcol = l31 & 15; const bool strict = l31 < 16;
#pragma unroll
              for (int r = 0; r < 16; ++r) { const int srow = crow(r & 7, hi); const bool keep = strict ? (srow < tcol) : (srow <= tcol); G[r] = keep ? G[r] : 0.f; } }
            const bf16x8 gB = pack8(G[0], G[1], G[2], G[3], G[4], G[5], G[6], G[7]), gK = pack8(G[8], G[9], G[10], G[11], G[12], G[13], G[14], G[15]);
            f32x16 XT;
#pragma unroll
            for (int r = 0; r < 16; ++r) XT[r] = 0.f;
#pragma unroll
            for (int jt = 0; jt < 2; ++jt)
#pragma unroll
                for (int sp = 0; sp < 2; ++sp) { const LAS unsigned char* ap = im + CK_AR + l31 * 144 + (32 * jt + 16 * sp + 4 * hi) * 2;
                    const u32x2 x0 = *(const LAS u32x2*)ap, x1 = *(const LAS u32x2*)(ap + 16); v4u aw; aw.x = x0.x; aw.y = x0.y; aw.z = x1.x; aw.w = x1.y;
                    const bf16x8 sb_ = pack8(ST[jt][8 * sp], ST[jt][8 * sp + 1], ST[jt][8 * sp + 2], ST[jt][8 * sp + 3], ST[jt][8 * sp + 4], ST[jt][8 * sp + 5], ST[jt][8 * sp + 6], ST[jt][8 * sp + 7]);
                    XT = MFMA32(__builtin_bit_cast(bf16x8, aw), sb_, XT); }
            bf16x8 vP;
            { const LAS unsigned char* vp = im + CK_VT + l31 * 48 + (4 * hi) * 2; const u32x2 x0 = *(const LAS u32x2*)vp, x1 = *(const LAS u32x2*)(vp + 16); v4u vw; vw.x = x0.x; vw.y = x0.y; vw.z = x1.x; vw.w = x1.y;
              vP = __builtin_bit_cast(bf16x8, vw); XT = MFMA32(gK, vP, XT); }
            bf16x8 uP;
            { const LAS unsigned char* tp = im + CK_TT + l31 * 48 + (4 * hi) * 2; const u32x2 x0 = *(const LAS u32x2*)tp, x1 = *(const LAS u32x2*)(tp + 16); v4u tw; tw.x = x0.x; tw.y = x0.y; tw.z = x1.x; tw.w = x1.y;
              f32x16 UT;
#pragma unroll
              for (int r = 0; r < 16; ++r) UT[r] = 0.f;
              UT = MFMA32(__builtin_bit_cast(bf16x8, tw), pack8(XT[0], XT[1], XT[2], XT[3], XT[4], XT[5], XT[6], XT[7]), UT);
              uP = pack8(UT[0], UT[1], UT[2], UT[3], UT[4], UT[5], UT[6], UT[7]); }
            XT = MFMA32(gB, uP, XT);
            { float* yp = yraw + (rowb + 16 * k) * 512 + h * 64 + 32 * ihalf + l31;
#pragma unroll
              for (int q = 0; q < 8; ++q) yp[(size_t)crow(q, hi) * 512] = XT[8 + q]; }
            { const LAS float* gc = (const LAS float*)(im + CK_GC);
#pragma unroll
              for (int jt = 0; jt < 2; ++jt)
#pragma unroll
                  for (int r = 0; r < 16; ++r) ST[jt][r] *= gc[32 * jt + crow(r, hi)]; }
#pragma unroll
            for (int jt = 0; jt < 2; ++jt) { const LAS unsigned char* bp = im + CK_BBT + (32 * jt + l31) * 48 + (4 * hi) * 2; const LAS unsigned char* kp = im + CK_KBT + (32 * jt + l31) * 48 + (4 * hi) * 2;
                const u32x2 b0 = *(const LAS u32x2*)bp, b1 = *(const LAS u32x2*)(bp + 16), k0 = *(const LAS u32x2*)kp, k1 = *(const LAS u32x2*)(kp + 16);
                v4u a1; a1.x = b0.x; a1.y = b0.y; a1.z = b1.x; a1.w = b1.y; v4u a2; a2.x = k0.x; a2.y = k0.y; a2.z = k1.x; a2.w = k1.y;
                ST[jt] = MFMA32(__builtin_bit_cast(bf16x8, a1), uP, ST[jt]); ST[jt] = MFMA32(__builtin_bit_cast(bf16x8, a2), vP, ST[jt]); }
            WSYNC();
            if (lane == 0) flags[8] = (unsigned)(k + 1);
        }
    } else if (wave <= CK_NBUILD) {
        const int pw = wave - 1;
        LAS bf16_t* stg = (LAS bf16_t*)(lds + CK_STG) + pw * 3072;
        float w0c[4], a0c[4], kkc[4], kac[4], rkc[4];
#pragma unroll
        for (int nt = 0; nt < 4; ++nt) { const int c = h * 64 + 16 * nt + l15; w0c[nt] = w0[c]; a0c[nt] = a0[c]; kkc[nt] = k_k[c]; kac[nt] = k_a[c]; rkc[nt] = r_k[c]; }
        v4u ld[20];
#define CK_ISSUE_A(T0) do { const int t0_ = (T0); const size_t r_ = rowb + t0_ + l15; const size_t rp_ = (t0_ + l15 == 0) ? r_ : r_ - 1; \
            _Pragma("unroll") for (int lo = 0; lo < 2; ++lo) _Pragma("unroll") for (int ks = 0; ks < 2; ++ks) { const int col = 1536 + 64 * lo + 32 * ks + 8 * kg; \
                ld[(lo * 2 + ks) * 2] = *(const v4u*)(proj + r_ * L0P + col); ld[(lo * 2 + ks) * 2 + 1] = *(const v4u*)(proj + rp_ * L0P + col); } } while (0)
#define CK_ISSUE_B(T0) do { const int t0_ = (T0); \
            _Pragma("unroll") for (int ar = 0; ar < 3; ++ar) _Pragma("unroll") for (int i = 0; i < 2; ++i) { const int p_ = lane + 64 * i, row_ = p_ >> 3, c8_ = p_ & 7; \
                const size_t r_ = rowb + t0_ + row_; const size_t rp_ = (t0_ + row_ == 0) ? r_ : r_ - 1; const int col = 512 * ar + h * 64 + 8 * c8_; \
                ld[8 + (ar * 2 + i) * 2] = *(const v4u*)(proj + r_ * L0P + col); ld[8 + (ar * 2 + i) * 2 + 1] = *(const v4u*)(proj + rp_ * L0P + col); } } while (0)
#define CK_ISSUE(T0) do { CK_ISSUE_A(T0); CK_ISSUE_B(T0); } while (0)
        CK_ISSUE(16 * pw);
        int k = pw;
#pragma unroll 1
        while (k < NCH) {
            const int t0 = 16 * k; int kn;
#if defined(PROBE_STAMPS)
            const unsigned ts0_ = (unsigned)__builtin_amdgcn_s_memrealtime();
#endif
            f32x4 accw[4], acca[4];
#pragma unroll
            for (int nt = 0; nt < 4; ++nt) { accw[nt] = (f32x4){0.f, 0.f, 0.f, 0.f}; acca[nt] = (f32x4){0.f, 0.f, 0.f, 0.f}; }
            { const float pz_ = (t0 + l15 == 0) ? 0.f : 1.f;
#pragma unroll
              for (int lo = 0; lo < 2; ++lo)
#pragma unroll
                for (int ks = 0; ks < 2; ++ks) { float s_[8];
                    const f32x4 m0 = *(const LAS f32x4*)(mixs + 64 * lo + 32 * ks + 8 * kg), m1 = *(const LAS f32x4*)(mixs + 64 * lo + 32 * ks + 8 * kg + 4);
                    RW_SH8(ld[(lo * 2 + ks) * 2], ld[(lo * 2 + ks) * 2 + 1], m0, m1, s_, pz_);
                    if (lo == 0) {
#pragma unroll
                        for (int j = 0; j < 8; ++j) s_[j] = tanh_fast(s_[j]); }
                    const bf16x8 af = pack8(s_[0], s_[1], s_[2], s_[3], s_[4], s_[5], s_[6], s_[7]);
                    const bf16_t* WT = lo ? A2T : W2T;
#pragma unroll
                    for (int nt = 0; nt < 4; ++nt) { const bf16x8 bfr = *(const bf16x8*)(WT + (size_t)(h * 64 + 16 * nt + l15) * 64 + 32 * ks + 8 * kg);
                        if (lo == 0) accw[nt] = MFMA16(af, bfr, accw[nt]); else acca[nt] = MFMA16(af, bfr, acca[nt]); } } }
#pragma unroll
            for (int ar = 0; ar < 3; ++ar)
#pragma unroll
                for (int i = 0; i < 2; ++i) { const int p_ = lane + 64 * i, row_ = p_ >> 3, c8_ = p_ & 7; float s_[8];
                    const float pz_ = (t0 + row_ == 0) ? 0.f : 1.f; const f32x4 m0 = *(const LAS f32x4*)(mixs + 256 + ar * 64 + c8_ * 8), m1 = *(const LAS f32x4*)(mixs + 256 + ar * 64 + c8_ * 8 + 4);
                    RW_SH8(ld[8 + (ar * 2 + i) * 2], ld[8 + (ar * 2 + i) * 2 + 1], m0, m1, s_, pz_);
                    *(LAS bf16x8*)(stg + ar * 1024 + row_ * 64 + c8_ * 8) = pack8(s_[0], s_[1], s_[2], s_[3], s_[4], s_[5], s_[6], s_[7]); }
            WSYNC();
#if defined(PROBE_STAMPS)
            if (blk == 0 && wave == 1 && lane == 0) ((volatile LAS unsigned*)(lds + 146432 + 320))[16 + 26] += (unsigned)__builtin_amdgcn_s_memrealtime() - ts0_;
#endif
#if defined(PROBE_STAMPS)
            const unsigned tb0_ = (unsigned)__builtin_amdgcn_s_memrealtime();
#endif
            { const int need = k - (CK_NSLOT - 1); if (need > 0) { while ((int)flags[8] < need) __builtin_amdgcn_s_sleep(2); } }
#if defined(PROBE_STAMPS)
            if (blk == 0 && wave == 1 && lane == 0) ((volatile LAS unsigned*)(lds + 146432 + 320))[16 + 25] += (unsigned)__builtin_amdgcn_s_memrealtime() - tb0_;
#endif
            asm volatile("" ::: "memory");
            LAS unsigned char* im = lds + (k % CK_NSLOT) * CK_SLOT;
#if defined(PROBE_STAMPS)
            const unsigned ts1_ = (unsigned)__builtin_amdgcn_s_memrealtime();
#endif
            float lwv[4][4], av[4][4], knv[4][4];
#pragma unroll
            for (int rg = 0; rg < 4; ++rg) { const int tl = 4 * kg + rg;
                float kkv[4], nrm2 = 0.f, vv[4], rr_[4], kr_[4];
#pragma unroll
                for (int nt = 0; nt < 4; ++nt) { rr_[nt] = bf2f(stg[tl * 64 + 16 * nt + l15]); kr_[nt] = bf2f(stg[1024 + tl * 64 + 16 * nt + l15]); vv[nt] = bf2f(stg[2048 + tl * 64 + 16 * nt + l15]);
                    kkv[nt] = kr_[nt] * kkc[nt]; nrm2 += kkv[nt] * kkv[nt]; }
                nrm2 = rowsum16(nrm2); const float rn = __builtin_amdgcn_rsqf(fmaxf(nrm2, 1e-24f));
                float bon = 0.f;
#pragma unroll
                for (int nt = 0; nt < 4; ++nt) {
                    const float wsum = w0c[nt] + accw[nt][rg]; lwv[nt][rg] = -0.6065306597126334f * sigmoid_fast(wsum);
                    const float a_ = sigmoid_fast(a0c[nt] + acca[nt][rg]); av[nt][rg] = a_; knv[nt][rg] = kkv[nt] * rn;
                    const float k2 = kr_[nt] * (1.f + (a_ - 1.f) * kac[nt]); stg[1024 + tl * 64 + 16 * nt + l15] = bf1(k2);
                    bon += rr_[nt] * k2 * rkc[nt];
                    if ((nt >> 1) == ihalf) *(LAS bf16_t*)(im + CK_VT + (16 * (nt & 1) + l15) * 48 + tl * 2) = bf1(vv[nt]);
                }
                bon = rowsum16(bon);
                if (l15 == 0 && ihalf == 0) bonus_out[(rowb + t0 + tl) * 8 + h] = bon;
            }
            { unsigned g_ = 0; if (lane == 0) g_ = __hip_atomic_fetch_add((LAS unsigned*)(lds + CK_FLAGS + 36), 1u, __ATOMIC_RELAXED, __HIP_MEMORY_SCOPE_WORKGROUP);
              kn = (int)__builtin_amdgcn_readfirstlane(g_); }
            CK_ISSUE_A((kn < NCH) ? 16 * kn : t0);
#pragma unroll
            for (int nt = 0; nt < 4; ++nt) {
                float L[4]; L[0] = lwv[nt][0]; L[1] = L[0] + lwv[nt][1]; L[2] = L[1] + lwv[nt][2]; L[3] = L[2] + lwv[nt][3];
                const float T0 = __shfl(L[3], l15), T1 = __shfl(L[3], 16 + l15), T2 = __shfl(L[3], 32 + l15), T3 = __shfl(L[3], 48 + l15);
                const float off = (kg > 0 ? T0 : 0.f) + (kg > 1 ? T1 : 0.f) + (kg > 2 ? T2 : 0.f), LC = (T0 + T1) + (T2 + T3);
                const int j = 16 * nt + l15;
                unsigned bb2[2], kb2[2];
                const float gC = __expf(LC); float eprev = __expf(off);
#pragma unroll
                for (int rg = 0; rg < 4; ++rg) { const int tl = 4 * kg + rg; const float Lt = off + L[rg], e1 = __expf(Lt), e2 = __builtin_amdgcn_rcpf(e1), e3 = eprev, e4 = gC * e2; eprev = e1;
                    const float kn = knv[nt][rg], bvv = kn * av[nt][rg], k2 = bf2f(stg[1024 + tl * 64 + j]), rr2 = bf2f(stg[tl * 64 + j]);
                    *(LAS bf16_t*)(im + CK_BK + tl * 144 + j * 2) = bf1(bvv * e2); *(LAS bf16_t*)(im + CK_BK + (16 + tl) * 144 + j * 2) = bf1(k2 * e2);
                    *(LAS bf16_t*)(im + CK_AR + tl * 144 + j * 2) = bf1(-kn * e3); *(LAS bf16_t*)(im + CK_AR + (16 + tl) * 144 + j * 2) = bf1(rr2 * e1);
                    const unsigned bq = bf1(bvv * e4), kq = bf1(k2 * e4);
                    if (rg & 1) { bb2[rg >> 1] |= bq << 16; kb2[rg >> 1] |= kq << 16; } else { bb2[rg >> 1] = bq; kb2[rg >> 1] = kq; } }
                *(LAS u32x2*)(im + CK_BBT + j * 48 + (4 * kg) * 2) = (u32x2){bb2[0], bb2[1]}; *(LAS u32x2*)(im + CK_KBT + j * 48 + (4 * kg) * 2) = (u32x2){kb2[0], kb2[1]};
                if (kg == 0) *(LAS float*)(im + CK_GC + j * 4) = gC;
            }
            WSYNC();
#if defined(PROBE_STAMPS)
            const unsigned ts2_ = (unsigned)__builtin_amdgcn_s_memrealtime();
            if (blk == 0 && wave == 1 && lane == 0) ((volatile LAS unsigned*)(lds + 146432 + 320))[16 + 27] += ts2_ - ts1_;
#endif
            {
                f32x4 nacc = {0.f, 0.f, 0.f, 0.f};
#pragma unroll
                for (int ks = 0; ks < 2; ++ks) { const bf16x8 fa = *(const LAS bf16x8*)(im + CK_BK + l15 * 144 + (32 * ks + 8 * kg) * 2), fb = *(const LAS bf16x8*)(im + CK_AR + l15 * 144 + (32 * ks + 8 * kg) * 2); nacc = MFMA16(fa, fb, nacc); }
#pragma unroll
                for (int rg = 0; rg < 4; ++rg) nacc[rg] = ((4 * kg + rg) < l15) ? nacc[rg] : 0.f;
                float Tr[16];
#pragma unroll
                for (int t = 0; t < 16; ++t) { float acc_ = (l15 == t) ? 1.f : 0.f;
#pragma unroll
                    for (int s2 = 0; s2 < t; ++s2) acc_ += Tr[s2] * rl(nacc[s2 & 3], t + 16 * (s2 >> 2));
                    Tr[t] = acc_; }
                if (kg == 0) {
#pragma unroll
                    for (int t = 0; t < 16; ++t) *(LAS bf16_t*)(im + CK_TT + t * 48 + l15 * 2) = bf1(Tr[t]); }
            }
            WSYNC();
#if defined(PROBE_STAMPS)
            if (blk == 0 && wave == 1 && lane == 0) ((volatile LAS unsigned*)(lds + 146432 + 320))[16 + 28] += (unsigned)__builtin_amdgcn_s_memrealtime() - ts2_;
#endif
            if (lane == 0) flags[k % CK_NSLOT] = (unsigned)(k + 1);
            CK_ISSUE_B((kn < NCH) ? 16 * kn : t0);
            k = kn;
        }
#undef CK_ISSUE
#undef CK_ISSUE_A
#undef CK_ISSUE_B
    } else {
        const int gq = wave - 6;
        v4u ld[8];
#define G_ISSUE(T0) do { const int t0_ = (T0); const size_t r_ = rowb + t0_ + l15; const size_t rp_ = (t0_ + l15 == 0) ? r_ : r_ - 1; \
            _Pragma("unroll") for (int ks = 0; ks < 4; ++ks) { const int col = 1664 + 32 * ks + 8 * kg; ld[2 * ks] = *(const v4u*)(proj + r_ * L0P + col); ld[2 * ks + 1] = *(const v4u*)(proj + rp_ * L0P + col); } } while (0)
        G_ISSUE(16 * gq);
#pragma unroll 1
        for (int k = gq; k < NCH; k += 2) {
            const int t0 = 16 * k;
            f32x4 accg[2] = {(f32x4){0.f, 0.f, 0.f, 0.f}, (f32x4){0.f, 0.f, 0.f, 0.f}}; const float pz_ = (t0 + l15 == 0) ? 0.f : 1.f;
#pragma unroll
            for (int ks = 0; ks < 4; ++ks) { float s_[8];
                const f32x4 m0 = *(const LAS f32x4*)(mixs + 128 + 32 * ks + 8 * kg), m1 = *(const LAS f32x4*)(mixs + 128 + 32 * ks + 8 * kg + 4);
                RW_SH8(ld[2 * ks], ld[2 * ks + 1], m0, m1, s_, pz_);
#pragma unroll
                for (int j = 0; j < 8; ++j) s_[j] = sigmoid_fast(s_[j]);
                const bf16x8 af = pack8(s_[0], s_[1], s_[2], s_[3], s_[4], s_[5], s_[6], s_[7]);
#pragma unroll
                for (int nt = 0; nt < 2; ++nt) { const bf16x8 bfr = *(const bf16x8*)(G2T + (size_t)(h * 64 + ihalf * 32 + 16 * nt + l15) * 128 + 32 * ks + 8 * kg); accg[nt] = MFMA16(af, bfr, accg[nt]); } }
            G_ISSUE((k + 2 < NCH) ? t0 + 32 : t0);
#pragma unroll
            for (int nt = 0; nt < 2; ++nt)
#pragma unroll
                for (int rg = 0; rg < 4; ++rg) gout[(rowb + t0 + 4 * kg + rg) * 512 + h * 64 + ihalf * 32 + 16 * nt + l15] = bf1(accg[nt][rg]);
        }
#undef G_ISSUE
    }
#undef RW_SH8
    __syncthreads();
}

constexpr int CC_BK = 0, CC_AR = 4608, CC_BBT = 9216, CC_KBT = 11776, CC_VT = 14336, CC_GC = 16896, CC_TT = 17152, CC_SLOT = 18432, CC_NSLOT = 6, CC_NBUILD = 6;
constexpr int CC_STG = CC_SLOT * CC_NSLOT;
constexpr int CC_MIX = CC_STG + CC_NBUILD * 4096;
constexpr int CC_FLAGS = CC_MIX + 448 * 4;
static_assert(CC_FLAGS + 64 <= 146432, "rwkv chain LDS map");
__device__ __forceinline__ void rwkv_phase_chain(LAS float* smf, int tid, int lane, int wave, int blk, const bf16_t* __restrict__ proj, const float* __restrict__ mix, const float* __restrict__ w0, const float* __restrict__ a0,
                                           const float* __restrict__ k_k, const float* __restrict__ k_a, const float* __restrict__ r_k, const bf16_t* __restrict__ W2T, const bf16_t* __restrict__ A2T, const bf16_t* __restrict__ G2T,
                                           float* __restrict__ yraw, bf16_t* __restrict__ gout, float* __restrict__ bonus_out) {
    LAS unsigned char* lds = (LAS unsigned char*)smf;
    LAS float* mixs = (LAS float*)(lds + CC_MIX);
    volatile LAS unsigned* flags = (volatile LAS unsigned*)(lds + CC_FLAGS);
    const int chain = blk, b = chain >> 3, h = chain & 7, l15 = lane & 15, kg = lane >> 4, l31 = lane & 31, hi = lane >> 5;
    const size_t rowb = (size_t)b * SEQ;
    constexpr int NCH = SEQ / 16;
    if (tid < 256) mixs[tid] = mix[1536 + tid];
    else if (tid < 448) { const int q = tid - 256; mixs[tid] = mix[512 * (q >> 6) + h * 64 + (q & 63)]; }
    if (tid < 16) flags[tid] = (tid == 10) ? (unsigned)CC_NBUILD : 0u;
    for (int q = tid; q < CC_NSLOT * 320; q += NWAVES * 64) *(LAS unsigned*)(lds + (q / 320) * CC_SLOT + CC_TT + (q % 320) * 4) = 0u;
    __syncthreads();
#define RW_SH8(CUR, PRV, M0, M1, OUT, PZ) do { const unsigned cu_[4] = {(CUR).x, (CUR).y, (CUR).z, (CUR).w}, pu_[4] = {(PRV).x, (PRV).y, (PRV).z, (PRV).w}; \
        const float mm_[8] = {(M0)[0], (M0)[1], (M0)[2], (M0)[3], (M1)[0], (M1)[1], (M1)[2], (M1)[3]}; \
        _Pragma("unroll") for (int q = 0; q < 4; ++q) { const float c0 = bflo(cu_[q]), c1 = bfhi(cu_[q]), p0 = bflo(pu_[q]) * (PZ), p1 = bfhi(pu_[q]) * (PZ); \
            OUT[2 * q] = c0 + (p0 - c0) * mm_[2 * q]; OUT[2 * q + 1] = c1 + (p1 - c1) * mm_[2 * q + 1]; } } while (0)
    if (wave < 2) {
        const int ihalf = wave;
        f32x16 ST[2];
#pragma unroll
        for (int r = 0; r < 16; ++r) { ST[0][r] = 0.f; ST[1][r] = 0.f; }
#pragma unroll 1
        for (int k = 0; k < NCH; ++k) {
            { const unsigned want = (unsigned)(k + 1); const int sl = k % CC_NSLOT; while (flags[sl] != want) __builtin_amdgcn_s_sleep(1); }
            asm volatile("" ::: "memory");
            const LAS unsigned char* im = lds + (k % CC_NSLOT) * CC_SLOT;
            f32x16 G;
#pragma unroll
            for (int r = 0; r < 16; ++r) G[r] = 0.f;
#pragma unroll
            for (int kk = 0; kk < 4; ++kk) { const bf16x8 fa = *(const LAS bf16x8*)(im + CC_BK + l31 * 144 + (16 * kk + 8 * hi) * 2), fb = *(const LAS bf16x8*)(im + CC_AR + l31 * 144 + (16 * kk + 8 * hi) * 2); G = MFMA32(fa, fb, G); }
            { const int tcol = l31 & 15; const bool strict = l31 < 16;
#pragma unroll
              for (int r = 0; r < 16; ++r) { const int srow = crow(r & 7, hi); const bool keep = strict ? (srow < tcol) : (srow <= tcol); G[r] = keep ? G[r] : 0.f; } }
            const bf16x8 gB = pack8(G[0], G[1], G[2], G[3], G[4], G[5], G[6], G[7]), gK = pack8(G[8], G[9], G[10], G[11], G[12], G[13], G[14], G[15]);
            f32x16 XT;
#pragma unroll
            for (int r = 0; r < 16; ++r) XT[r] = 0.f;
#pragma unroll
            for (int jt = 0; jt < 2; ++jt)
#pragma unroll
                for (int sp = 0; sp < 2; ++sp) { const LAS unsigned char* ap = im + CC_AR + l31 * 144 + (32 * jt + 16 * sp + 4 * hi) * 2;
                    const u32x2 x0 = *(const LAS u32x2*)ap, x1 = *(const LAS u32x2*)(ap + 16); v4u aw; aw.x = x0.x; aw.y = x0.y; aw.z = x1.x; aw.w = x1.y;
                    const bf16x8 sb_ = pack8(ST[jt][8 * sp], ST[jt][8 * sp + 1], ST[jt][8 * sp + 2], ST[jt][8 * sp + 3], ST[jt][8 * sp + 4], ST[jt][8 * sp + 5], ST[jt][8 * sp + 6], ST[jt][8 * sp + 7]);
                    XT = MFMA32(__builtin_bit_cast(bf16x8, aw), sb_, XT); }
            bf16x8 vP;
            { const LAS unsigned char* vp = im + CC_VT + (32 * ihalf + l31) * 40 + (4 * hi) * 2; const u32x2 x0 = *(const LAS u32x2*)vp, x1 = *(const LAS u32x2*)(vp + 16); v4u vw; vw.x = x0.x; vw.y = x0.y; vw.z = x1.x; vw.w = x1.y;
              vP = __builtin_bit_cast(bf16x8, vw); XT = MFMA32(gK, vP, XT); }
            bf16x8 uP;
            { const LAS unsigned char* tp = im + CC_TT + l31 * 40 + (4 * hi) * 2; const u32x2 x0 = *(const LAS u32x2*)tp, x1 = *(const LAS u32x2*)(tp + 16); v4u tw; tw.x = x0.x; tw.y = x0.y; tw.z = x1.x; tw.w = x1.y;
              f32x16 UT;
#pragma unroll
              for (int r = 0; r < 16; ++r) UT[r] = 0.f;
              UT = MFMA32(__builtin_bit_cast(bf16x8, tw), pack8(XT[0], XT[1], XT[2], XT[3], XT[4], XT[5], XT[6], XT[7]), UT);
              uP = pack8(UT[0], UT[1], UT[2], UT[3], UT[4], UT[5], UT[6], UT[7]); }
            XT = MFMA32(gB, uP, XT);
            { float* yp = yraw + (rowb + 16 * k) * 512 + h * 64 + 32 * ihalf + l31;
#pragma unroll
              for (int q = 0; q < 8; ++q) yp[(size_t)crow(q, hi) * 512] = XT[8 + q]; }
            { const LAS float* gc = (const LAS float*)(im + CC_GC);
#pragma unroll
              for (int jt = 0; jt < 2; ++jt)
#pragma unroll
                  for (int r = 0; r < 16; ++r) ST[jt][r] *= gc[32 * jt + crow(r, hi)]; }
#pragma unroll
            for (int jt = 0; jt < 2; ++jt) { const LAS unsigned char* bp = im + CC_BBT + (32 * jt + l31) * 40 + (4 * hi) * 2; const LAS unsigned char* kp = im + CC_KBT + (32 * jt + l31) * 40 + (4 * hi) * 2;
                const u32x2 b0 = *(const LAS u32x2*)bp, b1 = *(const LAS u32x2*)(bp + 16), k0 = *(const LAS u32x2*)kp, k1 = *(const LAS u32x2*)(kp + 16);
                v4u a1; a1.x = b0.x; a1.y = b0.y; a1.z = b1.x; a1.w = b1.y; v4u a2; a2.x = k0.x; a2.y = k0.y; a2.z = k1.x; a2.w = k1.y;
                ST[jt] = MFMA32(__builtin_bit_cast(bf16x8, a1), uP, ST[jt]); ST[jt] = MFMA32(__builtin_bit_cast(bf16x8, a2), vP, ST[jt]); }
            WSYNC();
            if (lane == 0) flags[8 + ihalf] = (unsigned)(k + 1);
        }
    } else {
        const int pw = wave - 2;
        LAS bf16_t* stg = (LAS bf16_t*)(lds + CC_STG) + pw * 2048;
        v4u ld[20];
#define CC_ISSUE_A(T0) do { const int t0_ = (T0); const size_t r_ = rowb + t0_ + l15; const size_t rp_ = (t0_ + l15 == 0) ? r_ : r_ - 1; \
            _Pragma("unroll") for (int lo = 0; lo < 2; ++lo) _Pragma("unroll") for (int ks = 0; ks < 2; ++ks) { const int col = 1536 + 64 * lo + 32 * ks + 8 * kg; \
                ld[(lo * 2 + ks) * 2] = *(const v4u*)(proj + r_ * L0P + col); ld[(lo * 2 + ks) * 2 + 1] = *(const v4u*)(proj + rp_ * L0P + col); } } while (0)
#define CC_ISSUE_B(T0) do { const int t0_ = (T0); \
            _Pragma("unroll") for (int ar = 0; ar < 3; ++ar) _Pragma("unroll") for (int i = 0; i < 2; ++i) { const int p_ = lane + 64 * i, row_ = p_ >> 3, c8_ = p_ & 7; \
                const size_t r_ = rowb + t0_ + row_; const size_t rp_ = (t0_ + row_ == 0) ? r_ : r_ - 1; const int col = 512 * ar + h * 64 + 8 * c8_; \
                ld[8 + (ar * 2 + i) * 2] = *(const v4u*)(proj + r_ * L0P + col); ld[8 + (ar * 2 + i) * 2 + 1] = *(const v4u*)(proj + rp_ * L0P + col); } } while (0)
#define CC_ISSUE(T0) do { CC_ISSUE_A(T0); CC_ISSUE_B(T0); } while (0)
        CC_ISSUE(16 * pw);
        int k = pw;
#pragma unroll 1
        while (k < NCH) {
            const int t0 = 16 * k; int kn;
            f32x4 accw[4], acca[4];
#pragma unroll
            for (int nt = 0; nt < 4; ++nt) { accw[nt] = (f32x4){0.f, 0.f, 0.f, 0.f}; acca[nt] = (f32x4){0.f, 0.f, 0.f, 0.f}; }
            { const float pz_ = (t0 + l15 == 0) ? 0.f : 1.f;
#pragma unroll
              for (int lo = 0; lo < 2; ++lo)
#pragma unroll
                for (int ks = 0; ks < 2; ++ks) { float s_[8];
                    const f32x4 m0 = *(const LAS f32x4*)(mixs + 64 * lo + 32 * ks + 8 * kg), m1 = *(const LAS f32x4*)(mixs + 64 * lo + 32 * ks + 8 * kg + 4);
                    RW_SH8(ld[(lo * 2 + ks) * 2], ld[(lo * 2 + ks) * 2 + 1], m0, m1, s_, pz_);
                    if (lo == 0) {
#pragma unroll
                        for (int j = 0; j < 8; ++j) s_[j] = tanh_fast(s_[j]); }
                    const bf16x8 af = pack8(s_[0], s_[1], s_[2], s_[3], s_[4], s_[5], s_[6], s_[7]);
                    const bf16_t* WT = lo ? A2T : W2T;
#pragma unroll
                    for (int nt = 0; nt < 4; ++nt) { const bf16x8 bfr = *(const bf16x8*)(WT + (size_t)(h * 64 + 16 * nt + l15) * 64 + 32 * ks + 8 * kg);
                        if (lo == 0) accw[nt] = MFMA16(af, bfr, accw[nt]); else acca[nt] = MFMA16(af, bfr, acca[nt]); } } }
            { const int need = k - (CC_NSLOT - 1); if (need > 0) { while ((int)flags[8] < need || (int)flags[9] < need) __builtin_amdgcn_s_sleep(2); } }
            asm volatile("" ::: "memory");
            LAS unsigned char* im = lds + (k % CC_NSLOT) * CC_SLOT;
#pragma unroll
            for (int ar = 0; ar < 3; ++ar)
#pragma unroll
                for (int i = 0; i < 2; ++i) { const int p_ = lane + 64 * i, row_ = p_ >> 3, c8_ = p_ & 7; float s_[8];
                    const float pz_ = (t0 + row_ == 0) ? 0.f : 1.f; const f32x4 m0 = *(const LAS f32x4*)(mixs + 256 + ar * 64 + c8_ * 8), m1 = *(const LAS f32x4*)(mixs + 256 + ar * 64 + c8_ * 8 + 4);
                    RW_SH8(ld[8 + (ar * 2 + i) * 2], ld[8 + (ar * 2 + i) * 2 + 1], m0, m1, s_, pz_);
                    if (ar < 2) *(LAS bf16x8*)(stg + ar * 1024 + row_ * 64 + c8_ * 8) = pack8(s_[0], s_[1], s_[2], s_[3], s_[4], s_[5], s_[6], s_[7]);
                    else {
#pragma unroll
                        for (int j = 0; j < 8; ++j) *(LAS bf16_t*)(im + CC_VT + (c8_ * 8 + j) * 40 + row_ * 2) = bf1(s_[j]); } }
            WSYNC();
            float lwv[4][4], av[4][4], knv[4][4];
            float w0c[4], a0c[4], kkc[4], kac[4], rkc[4];
#pragma unroll
            for (int nt = 0; nt < 4; ++nt) { const int c = h * 64 + 16 * nt + l15; w0c[nt] = w0[c]; a0c[nt] = a0[c]; kkc[nt] = k_k[c]; kac[nt] = k_a[c]; rkc[nt] = r_k[c]; }
#pragma unroll
            for (int rg = 0; rg < 4; ++rg) { const int tl = 4 * kg + rg;
                float kkv[4], nrm2 = 0.f, rr_[4], kr_[4];
#pragma unroll
                for (int nt = 0; nt < 4; ++nt) { rr_[nt] = bf2f(stg[tl * 64 + 16 * nt + l15]); kr_[nt] = bf2f(stg[1024 + tl * 64 + 16 * nt + l15]);
                    kkv[nt] = kr_[nt] * kkc[nt]; nrm2 += kkv[nt] * kkv[nt]; }
                nrm2 = rowsum16(nrm2); const float rn = __builtin_amdgcn_rsqf(fmaxf(nrm2, 1e-24f));
                float bon = 0.f;
#pragma unroll
                for (int nt = 0; nt < 4; ++nt) {
                    const float wsum = w0c[nt] + accw[nt][rg]; lwv[nt][rg] = -0.6065306597126334f * sigmoid_fast(wsum);
                    const float a_ = sigmoid_fast(a0c[nt] + acca[nt][rg]); av[nt][rg] = a_; knv[nt][rg] = kkv[nt] * rn;
                    const float k2 = kr_[nt] * (1.f + (a_ - 1.f) * kac[nt]); stg[1024 + tl * 64 + 16 * nt + l15] = bf1(k2);
                    bon += rr_[nt] * k2 * rkc[nt];
                }
                bon = rowsum16(bon);
                if (l15 == 0) bonus_out[(rowb + t0 + tl) * 8 + h] = bon;
            }
            { unsigned g_ = 0; if (lane == 0) g_ = __hip_atomic_fetch_add((LAS unsigned*)(lds + CC_FLAGS + 40), 1u, __ATOMIC_RELAXED, __HIP_MEMORY_SCOPE_WORKGROUP);
              kn = (int)__builtin_amdgcn_readfirstlane(g_); }
            CC_ISSUE_A((kn < NCH) ? 16 * kn : t0);
#pragma unroll
            for (int nt = 0; nt < 4; ++nt) {
                float L[4]; L[0] = lwv[nt][0]; L[1] = L[0] + lwv[nt][1]; L[2] = L[1] + lwv[nt][2]; L[3] = L[2] + lwv[nt][3];
                const float T0 = __shfl(L[3], l15), T1 = __shfl(L[3], 16 + l15), T2 = __shfl(L[3], 32 + l15), T3 = __shfl(L[3], 48 + l15);
                const float off = (kg > 0 ? T0 : 0.f) + (kg > 1 ? T1 : 0.f) + (kg > 2 ? T2 : 0.f), LC = (T0 + T1) + (T2 + T3);
                const int j = 16 * nt + l15;
                unsigned bb2[2], kb2[2];
                const float gC = __expf(LC); float eprev = __expf(off);
#pragma unroll
                for (int rg = 0; rg < 4; ++rg) { const int tl = 4 * kg + rg; const float Lt = off + L[rg], e1 = __expf(Lt), e2 = __builtin_amdgcn_rcpf(e1), e3 = eprev, e4 = gC * e2; eprev = e1;
                    const float kn = knv[nt][rg], bvv = kn * av[nt][rg], k2 = bf2f(stg[1024 + tl * 64 + j]), rr2 = bf2f(stg[tl * 64 + j]);
                    *(LAS bf16_t*)(im + CC_BK + tl * 144 + j * 2) = bf1(bvv * e2); *(LAS bf16_t*)(im + CC_BK + (16 + tl) * 144 + j * 2) = bf1(k2 * e2);
                    *(LAS bf16_t*)(im + CC_AR + tl * 144 + j * 2) = bf1(-kn * e3); *(LAS bf16_t*)(im + CC_AR + (16 + tl) * 144 + j * 2) = bf1(rr2 * e1);
                    const unsigned bq = bf1(bvv * e4), kq = bf1(k2 * e4);
                    if (rg & 1) { bb2[rg >> 1] |= bq << 16; kb2[rg >> 1] |= kq << 16; } else { bb2[rg >> 1] = bq; kb2[rg >> 1] = kq; } }
                *(LAS u32x2*)(im + CC_BBT + j * 40 + (4 * kg) * 2) = (u32x2){bb2[0], bb2[1]}; *(LAS u32x2*)(im + CC_KBT + j * 40 + (4 * kg) * 2) = (u32x2){kb2[0], kb2[1]};
                if (kg == 0) *(LAS float*)(im + CC_GC + j * 4) = gC;
            }
            WSYNC();
            {
                f32x4 nacc = {0.f, 0.f, 0.f, 0.f};
#pragma unroll
                for (int ks = 0; ks < 2; ++ks) { const bf16x8 fa = *(const LAS bf16x8*)(im + CC_BK + l15 * 144 + (32 * ks + 8 * kg) * 2), fb = *(const LAS bf16x8*)(im + CC_AR + l15 * 144 + (32 * ks + 8 * kg) * 2); nacc = MFMA16(fa, fb, nacc); }
#pragma unroll
                for (int rg = 0; rg < 4; ++rg) nacc[rg] = ((4 * kg + rg) < l15) ? nacc[rg] : 0.f;
                float Tr[16];
#pragma unroll
                for (int t = 0; t < 16; ++t) { float acc_ = (l15 == t) ? 1.f : 0.f;
#pragma unroll
                    for (int s2 = 0; s2 < t; ++s2) acc_ += Tr[s2] * rl(nacc[s2 & 3], t + 16 * (s2 >> 2));
                    Tr[t] = acc_; }
                if (kg == 0) {
#pragma unroll
                    for (int t = 0; t < 16; ++t) *(LAS bf16_t*)(im + CC_TT + t * 40 + l15 * 2) = bf1(Tr[t]); }
            }
            WSYNC();
            if (lane == 0) flags[k % CC_NSLOT] = (unsigned)(k + 1);
            CC_ISSUE_B((kn < NCH) ? 16 * kn : t0);
            k = kn;
        }
#undef CC_ISSUE
#undef CC_ISSUE_A
#undef CC_ISSUE_B
    }
#undef RW_SH8
    __syncthreads();
}


__device__ __forceinline__ void gate_lora_task(int chain, int k, int lane, const bf16_t* __restrict__ proj, const float* __restrict__ mix, const bf16_t* __restrict__ G2T, bf16_t* __restrict__ gout) {
    const int b = chain >> 3, h = chain & 7, l15 = lane & 15, kg = lane >> 4, t0 = 16 * k;
    const size_t rowb = (size_t)b * SEQ, r_ = rowb + t0 + l15, rp_ = (t0 + l15 == 0) ? r_ : r_ - 1;
    const float pz_ = (t0 + l15 == 0) ? 0.f : 1.f;
    v4u cu[4], pv[4];
#pragma unroll
    for (int ks = 0; ks < 4; ++ks) { const int col = 1664 + 32 * ks + 8 * kg; cu[ks] = *(const v4u*)(proj + r_ * L0P + col); pv[ks] = *(const v4u*)(proj + rp_ * L0P + col); }
    f32x4 accg[4];
#pragma unroll
    for (int nt = 0; nt < 4; ++nt) accg[nt] = (f32x4){0.f, 0.f, 0.f, 0.f};
#pragma unroll
    for (int ks = 0; ks < 4; ++ks) {
        const f32x4 m0 = *(const f32x4*)(mix + 1664 + 32 * ks + 8 * kg), m1 = *(const f32x4*)(mix + 1664 + 32 * ks + 8 * kg + 4);
        const float mm[8] = {m0[0], m0[1], m0[2], m0[3], m1[0], m1[1], m1[2], m1[3]};
        const unsigned cw[4] = {cu[ks].x, cu[ks].y, cu[ks].z, cu[ks].w}, pw[4] = {pv[ks].x, pv[ks].y, pv[ks].z, pv[ks].w};
        float s_[8];
#pragma unroll
        for (int q = 0; q < 4; ++q) { const float c0 = bflo(cw[q]), c1 = bfhi(cw[q]), p0 = bflo(pw[q]) * pz_, p1 = bfhi(pw[q]) * pz_;
            s_[2 * q] = sigmoid_fast(c0 + (p0 - c0) * mm[2 * q]); s_[2 * q + 1] = sigmoid_fast(c1 + (p1 - c1) * mm[2 * q + 1]); }
        const bf16x8 af = pack8(s_[0], s_[1], s_[2], s_[3], s_[4], s_[5], s_[6], s_[7]);
#pragma unroll
        for (int nt = 0; nt < 4; ++nt) { const bf16x8 bfr = *(const bf16x8*)(G2T + (size_t)(h * 64 + 16 * nt + l15) * 128 + 32 * ks + 8 * kg); accg[nt] = MFMA16(af, bfr, accg[nt]); }
    }
#pragma unroll
    for (int nt = 0; nt < 4; ++nt)
#pragma unroll
        for (int rg = 0; rg < 4; ++rg) gout[(rowb + t0 + 4 * kg + rg) * 512 + h * 64 + 16 * nt + l15] = bf1(accg[nt][rg]);
}


__device__ __forceinline__ void gate_lora_wave(int first, int stride, int lane, const bf16_t* __restrict__ proj, const float* __restrict__ mix, const bf16_t* __restrict__ G2T, bf16_t* __restrict__ gout) {
    const int l15 = lane & 15, kg = lane >> 4, h = (first >> 7) & 7;
    bf16x8 bfr[4][4];
#pragma unroll
    for (int ks = 0; ks < 4; ++ks)
#pragma unroll
        for (int nt = 0; nt < 4; ++nt) bfr[ks][nt] = *(const bf16x8*)(G2T + (size_t)(h * 64 + 16 * nt + l15) * 128 + 32 * ks + 8 * kg);
    float mm[4][8];
#pragma unroll
    for (int ks = 0; ks < 4; ++ks) { const f32x4 m0 = *(const f32x4*)(mix + 1664 + 32 * ks + 8 * kg), m1 = *(const f32x4*)(mix + 1664 + 32 * ks + 8 * kg + 4);
        mm[ks][0] = m0[0]; mm[ks][1] = m0[1]; mm[ks][2] = m0[2]; mm[ks][3] = m0[3]; mm[ks][4] = m1[0]; mm[ks][5] = m1[1]; mm[ks][6] = m1[2]; mm[ks][7] = m1[3]; }
    v4u cu[4], pv[4];
#define GL_LOAD(TK) do { const int ch_ = (TK) >> 7, t0_ = 16 * ((TK) & 127); const size_t r_ = (size_t)(ch_ >> 3) * SEQ + t0_ + l15, rp_ = (t0_ + l15 == 0) ? r_ : r_ - 1; \
        _Pragma("unroll") for (int ks = 0; ks < 4; ++ks) { const int col = 1664 + 32 * ks + 8 * kg; cu[ks] = *(const v4u*)(proj + r_ * L0P + col); pv[ks] = *(const v4u*)(proj + rp_ * L0P + col); } } while (0)
    GL_LOAD(first);
#pragma unroll 1
    for (int tk = first; tk < 128 * 128; tk += stride) {
        const int chain = tk >> 7, t0 = 16 * (tk & 127); const size_t rowb = (size_t)(chain >> 3) * SEQ;
        const float pz_ = (t0 + l15 == 0) ? 0.f : 1.f;
        f32x4 accg[4];
#pragma unroll
        for (int nt = 0; nt < 4; ++nt) accg[nt] = (f32x4){0.f, 0.f, 0.f, 0.f};
        bf16x8 af[4];
#pragma unroll
        for (int ks = 0; ks < 4; ++ks) { const unsigned cw[4] = {cu[ks].x, cu[ks].y, cu[ks].z, cu[ks].w}, pw[4] = {pv[ks].x, pv[ks].y, pv[ks].z, pv[ks].w}; float s_[8];
#pragma unroll
            for (int q = 0; q < 4; ++q) { const float c0 = bflo(cw[q]), c1 = bfhi(cw[q]), p0 = bflo(pw[q]) * pz_, p1 = bfhi(pw[q]) * pz_;
                s_[2 * q] = sigmoid_fast(c0 + (p0 - c0) * mm[ks][2 * q]); s_[2 * q + 1] = sigmoid_fast(c1 + (p1 - c1) * mm[ks][2 * q + 1]); }
            af[ks] = pack8(s_[0], s_[1], s_[2], s_[3], s_[4], s_[5], s_[6], s_[7]); }
        { const int tn = (tk + stride < 128 * 128) ? tk + stride : tk; GL_LOAD(tn); }
#pragma unroll
        for (int ks = 0; ks < 4; ++ks)
#pragma unroll
            for (int nt = 0; nt < 4; ++nt) accg[nt] = MFMA16(af[ks], bfr[ks][nt], accg[nt]);
#pragma unroll
        for (int nt = 0; nt < 4; ++nt)
#pragma unroll
            for (int rg = 0; rg < 4; ++rg) gout[(rowb + t0 + 4 * kg + rg) * 512 + h * 64 + 16 * nt + l15] = bf1(accg[nt][rg]);
    }
#undef GL_LOAD
}

template <bool ST = true> __device__ __forceinline__ void rwkv_post_all(const float* __restrict__ yraw, const bf16_t* __restrict__ proj, const float* __restrict__ mix, const float* __restrict__ bonus, const bf16_t* __restrict__ gbuf,
                                              const float* __restrict__ ln_g, const float* __restrict__ ln_b, bf16_t* __restrict__ ymix, int gw, int NGW, int lane) {
    for (int m = gw; m < M; m += NGW) {
        const bool has_prev = (m & (SEQ - 1)) != 0;
        float y[8], cv[8], pv[8], gg[8], bo[8];
#pragma unroll
        for (int h = 0; h < 8; ++h) { const int c = h * 64 + lane; y[h] = yraw[(size_t)m * 512 + c]; cv[h] = bf2f(proj[(size_t)m * L0P + 1024 + c]);
            pv[h] = bf2f(proj[(size_t)(has_prev ? m - 1 : m) * L0P + 1024 + c]); gg[h] = bf2f(gbuf[(size_t)m * 512 + c]); bo[h] = bonus[(size_t)m * 8 + h]; }
#pragma unroll
        for (int h = 0; h < 8; ++h) { const int c = h * 64 + lane;
            const float mu = wave_sum_dpp(y[h]) * (1.f / 64.f), d = y[h] - mu, var = wave_sum_dpp(d * d) * (1.f / 64.f);
            const float yn = d * __builtin_amdgcn_rsqf(var + 64e-5f) * ln_g[c] + ln_b[c];
            const float pvv = has_prev ? pv[h] : 0.f;
            const float v_s = cv[h] + (pvv - cv[h]) * mix[1024 + c];
            const float o = (yn + bo[h] * v_s) * gg[h];
            if (ST) ymix[(size_t)m * DM + c] = bf1(o); else asm volatile("" :: "v"(o)); }
    }
}


__device__ __forceinline__ void ssd_conv_tile(int it, int lane, LAS bf16_t* scr, const bf16_t* __restrict__ proj, const float* __restrict__ cw, const float* __restrict__ cb,
                                              bf16_t* __restrict__ xbc, bf16_t* __restrict__ xst, bf16_t* __restrict__ bt) {
    const int tt = it >> 4, ct = it & 15, m0 = tt * 64, b = m0 >> 11, t0 = m0 & (SEQ - 1), c = ct * 64 + lane;
    const float w0 = cw[c], w1 = cw[1024 + c], w2 = cw[2048 + c], w3 = cw[3072 + c], bias = cb[c];
    const bf16_t* src = proj + (size_t)m0 * L0P + 2304 + c;
    bf16_t raw[67];
    const int lo = (t0 > 0) ? -3 : 0;
#pragma unroll
    for (int t = -3; t < 64; ++t) raw[t + 3] = src[(ptrdiff_t)((t < lo) ? lo : t) * L0P];
    float u3 = (t0 > 0) ? bf2f(raw[0]) : 0.f, u2 = (t0 > 0) ? bf2f(raw[1]) : 0.f, u1 = (t0 > 0) ? bf2f(raw[2]) : 0.f;
#pragma unroll
    for (int t = 0; t < 64; ++t) {
        const float u = bf2f(raw[t + 3]);
        const float y = bias + w0 * u3 + w1 * u2 + w2 * u1 + w3 * u;
        const bf16_t o = bf1(y * __builtin_amdgcn_rcpf(1.f + __expf(-y)));
        xbc[(size_t)(m0 + t) * 1024 + c] = o;
        scr[t * STG_PITCH + lane] = o;
        u3 = u2; u2 = u1; u1 = u;
    }
    WSYNC();
    if (ct < 12) {
        bf16_t* dst = (ct < 8) ? xst + ((size_t)(b * 8 + ct) * 64) * SEQ + t0 : bt + ((size_t)(b * 2 + ((ct - 8) >> 1)) * 128 + ((ct - 8) & 1) * 64) * SEQ + t0;
#pragma unroll
        for (int i = 0; i < 8; ++i) { const int d = i * 8 + (lane >> 3), tc = lane & 7; const LAS bf16_t* p = scr + (tc * 8) * STG_PITCH + d;
            v4u o; o.x = (unsigned)p[0] | ((unsigned)p[STG_PITCH] << 16); o.y = (unsigned)p[2 * STG_PITCH] | ((unsigned)p[3 * STG_PITCH] << 16);
            o.z = (unsigned)p[4 * STG_PITCH] | ((unsigned)p[5 * STG_PITCH] << 16); o.w = (unsigned)p[6 * STG_PITCH] | ((unsigned)p[7 * STG_PITCH] << 16);
            *(v4u*)(dst + (size_t)d * SEQ + tc * 8) = o; }
    }
    WSYNC();
}
__device__ __forceinline__ float bperm(int srclane, float x) { return __builtin_bit_cast(float, __builtin_amdgcn_ds_bpermute(srclane << 2, __builtin_bit_cast(int, x))); }
__device__ __forceinline__ void scan128(float& x0, float& x1, int lane) {
#pragma unroll
    for (int o = 1; o < 64; o <<= 1) { const int sl = (lane >= o) ? lane - o : lane; const float t0 = bperm(sl, x0), t1 = bperm(sl, x1); if (lane >= o) { x0 += t0; x1 += t1; } }
    x1 += rl(x0, 63);
}

__device__ __forceinline__ void ssd_s3_block(int bc, int tid, int lane, int wave, LAS unsigned char* lds, const bf16_t* __restrict__ xbc, const bf16_t* __restrict__ xst, const bf16_t* __restrict__ stb,
                                             const float* __restrict__ dt, const float* __restrict__ a_log, const float* __restrict__ dsk, bf16_t* __restrict__ yssm) {
    const int b = bc >> 4, c = bc & 15, h = wave, g = h >> 2, l0 = c * 128, l31 = lane & 31, hi = lane >> 5, unit = bc * 8 + h;
    const size_t m0 = (size_t)b * SEQ + l0;
    __syncthreads();
    {
        const int mat = lane >> 4, ch = lane & 15;
        v4u rr[16];
#pragma unroll
        for (int i = 0; i < 16; ++i) rr[i] = *(const v4u*)(xbc + (m0 + wave * 16 + i) * 1024 + 512 + lane * 8);
#pragma unroll
        for (int i = 0; i < 16; ++i) { const int row = wave * 16 + i; *(LAS v4u*)(lds + mat * 34816 + row * 272 + ch * 16) = rr[i]; }
    }
#define S3TAB(i) (*(LAS float*)(lds + ((wave * 64) + ((i) >> 2)) * 272 + 256 + ((i) & 3) * 4))
    const float A = -expf(a_log[h]), D = dsk[h];
    { const float d0 = dt[(m0 + lane) * 8 + h], d1 = dt[(m0 + 64 + lane) * 8 + h];
      float ac0 = d0 * A, ac1 = d1 * A;
      scan128(ac0, ac1, lane);
      S3TAB(lane) = ac0; S3TAB(64 + lane) = ac1; S3TAB(128 + lane) = d0; S3TAB(192 + lane) = d1; }
    u32x2 xf[4][2][2][2];
    const bf16_t* Sp = stb + (size_t)unit * 8192 + l31 * 128 + 8 * hi;
    { const bf16_t* Xp = xst + ((size_t)(b * 8 + h) * 64 + l31) * SEQ + l0 + 4 * hi;
#pragma unroll
      for (int st = 0; st < 4; ++st)
#pragma unroll
          for (int pt = 0; pt < 2; ++pt)
#pragma unroll
              for (int ks = 0; ks < 2; ++ks) { const bf16_t* xp = Xp + (size_t)pt * 32 * SEQ + st * 32 + 16 * ks; xf[st][pt][ks][0] = *(const u32x2*)xp; xf[st][pt][ks][1] = *(const u32x2*)(xp + 8); } }
    __syncthreads();
    const LAS unsigned char* Bl = lds + g * 34816 + 16 * hi;
    const LAS unsigned char* Cl = lds + (2 + g) * 34816 + 16 * hi;
#pragma unroll 1
    for (int lt = 0; lt < 4; ++lt) {
        asm volatile("" ::: "memory");
        f32x16 y[2];
#pragma unroll
        for (int r = 0; r < 16; ++r) { y[0][r] = 0.f; y[1][r] = 0.f; }
        const float acl = S3TAB(32 * lt + l31);
        const int crw = 32 * lt + l31;
        { bf16x8 sfr[2][8];
#pragma unroll
          for (int pt = 0; pt < 2; ++pt)
#pragma unroll
              for (int kk = 0; kk < 8; ++kk) sfr[pt][kk] = *(const bf16x8*)(Sp + pt * 32 * 128 + 16 * kk);
#pragma unroll
          for (int kk = 0; kk < 8; ++kk) { const bf16x8 cf = *(const LAS bf16x8*)(Cl + crw * 272 + 32 * kk); y[0] = MFMA32(sfr[0][kk], cf, y[0]); y[1] = MFMA32(sfr[1][kk], cf, y[1]); } }
        { const float el = __expf(acl);
#pragma unroll
          for (int r = 0; r < 16; ++r) { y[0][r] *= el; y[1][r] *= el; } }
        u32x2 xd[2][4];
#pragma unroll
        for (int pt = 0; pt < 2; ++pt)
#pragma unroll
            for (int q = 0; q < 4; ++q) xd[pt][q] = *(const u32x2*)(xbc + (m0 + crw) * 1024 + h * 64 + 32 * pt + 8 * q + 4 * hi);
#pragma unroll
        for (int st = 0; st < 4; ++st) if (st <= lt) {
            const int brw = 32 * st + l31;
            f32x16 cbt;
#pragma unroll
            for (int r = 0; r < 16; ++r) cbt[r] = 0.f;
#pragma unroll
            for (int kk = 0; kk < 8; ++kk) { const bf16x8 bf_ = *(const LAS bf16x8*)(Bl + brw * 272 + 32 * kk), cf_ = *(const LAS bf16x8*)(Cl + crw * 272 + 32 * kk); cbt = MFMA32(bf_, cf_, cbt); }
#pragma unroll
            for (int r = 0; r < 16; ++r) { const int sl = 32 * st + crow(r, hi); const float acs = S3TAB(sl), dts = S3TAB(128 + sl);
                float v = cbt[r] * __expf(acl - acs) * dts; if (st == lt && crow(r, hi) > l31) v = 0.f; cbt[r] = v; }
            bf16x8 pf[2];
#pragma unroll
            for (int ks = 0; ks < 2; ++ks) pf[ks] = pack8(cbt[8 * ks], cbt[8 * ks + 1], cbt[8 * ks + 2], cbt[8 * ks + 3], cbt[8 * ks + 4], cbt[8 * ks + 5], cbt[8 * ks + 6], cbt[8 * ks + 7]);
#pragma unroll
            for (int pt = 0; pt < 2; ++pt)
#pragma unroll
                for (int ks = 0; ks < 2; ++ks) { v4u a; a.x = xf[st][pt][ks][0].x; a.y = xf[st][pt][ks][0].y; a.z = xf[st][pt][ks][1].x; a.w = xf[st][pt][ks][1].y; y[pt] = MFMA32(__builtin_bit_cast(bf16x8, a), pf[ks], y[pt]); }
        }
#pragma unroll
        for (int pt = 0; pt < 2; ++pt)
#pragma unroll
            for (int q = 0; q < 4; ++q) { const u32x2 xx = xd[pt][q];
                const unsigned o0 = cvtpk(y[pt][4 * q] + D * bflo(xx.x), y[pt][4 * q + 1] + D * bfhi(xx.x)), o1 = cvtpk(y[pt][4 * q + 2] + D * bflo(xx.y), y[pt][4 * q + 3] + D * bfhi(xx.y));
                *(u32x2*)(yssm + (m0 + crw) * 512 + h * 64 + 32 * pt + 8 * q + 4 * hi) = (u32x2){o0, o1}; }
    }
#undef S3TAB
}
__device__ __forceinline__ void ssd_s1_unit(int unit, int lane, LAS float* tab, const bf16_t* __restrict__ xst, const bf16_t* __restrict__ bt, const float* __restrict__ dt, const float* __restrict__ a_log,
                                            float* __restrict__ sloc, float* __restrict__ asum) {
    const int h = unit & 7, c = (unit >> 3) & 15, b = unit >> 7, g = h >> 2, l0 = c * 128, l31 = lane & 31, hi = lane >> 5;
    const size_t m0 = (size_t)b * SEQ + l0;
    const float A = -expf(a_log[h]);
    const float d0 = dt[(m0 + lane) * 8 + h], d1 = dt[(m0 + 64 + lane) * 8 + h];
    float ac0 = d0 * A, ac1 = d1 * A;
    scan128(ac0, ac1, lane);
    const float aend = rl(ac1, 63);
    tab[lane] = __expf(aend - ac0) * d0; tab[64 + lane] = __expf(aend - ac1) * d1;
    if (lane == 0) asum[unit] = aend;
    WSYNC();
    f32x16 acc[2][4];
#pragma unroll
    for (int pt = 0; pt < 2; ++pt)
#pragma unroll
        for (int nt = 0; nt < 4; ++nt)
#pragma unroll
            for (int r = 0; r < 16; ++r) acc[pt][nt][r] = 0.f;
    const bf16_t* Xp = xst + ((size_t)(b * 8 + h) * 64 + l31) * SEQ + l0 + 8 * hi;
    const bf16_t* Bp = bt + ((size_t)(b * 2 + g) * 128 + l31) * SEQ + l0 + 8 * hi;
#pragma unroll 2
    for (int kk = 0; kk < 8; ++kk) {
        const f32x4 wa = *(const LAS f32x4*)(tab + 16 * kk + 8 * hi), wb = *(const LAS f32x4*)(tab + 16 * kk + 8 * hi + 4);
        bf16x8 af[2], bfr[4];
#pragma unroll
        for (int pt = 0; pt < 2; ++pt) { const v4u raw = *(const v4u*)(Xp + (size_t)pt * 32 * SEQ + 16 * kk);
            v4u w; w.x = cvtpk(bflo(raw.x) * wa[0], bfhi(raw.x) * wa[1]); w.y = cvtpk(bflo(raw.y) * wa[2], bfhi(raw.y) * wa[3]);
            w.z = cvtpk(bflo(raw.z) * wb[0], bfhi(raw.z) * wb[1]); w.w = cvtpk(bflo(raw.w) * wb[2], bfhi(raw.w) * wb[3]); af[pt] = __builtin_bit_cast(bf16x8, w); }
#pragma unroll
        for (int nt = 0; nt < 4; ++nt) bfr[nt] = *(const bf16x8*)(Bp + (size_t)nt * 32 * SEQ + 16 * kk);
#pragma unroll
        for (int pt = 0; pt < 2; ++pt)
#pragma unroll
            for (int nt = 0; nt < 4; ++nt) acc[pt][nt] = MFMA32(af[pt], bfr[nt], acc[pt][nt]);
    }
    float* dst = sloc + (size_t)unit * 8192 + l31;
#pragma unroll
    for (int pt = 0; pt < 2; ++pt)
#pragma unroll
        for (int nt = 0; nt < 4; ++nt)
#pragma unroll
            for (int r = 0; r < 16; ++r) dst[(32 * pt + crow(r, hi)) * 128 + 32 * nt] = acc[pt][nt][r];
    WSYNC();
}
__device__ __forceinline__ void ssd_s2_all(const float* __restrict__ sloc, const float* __restrict__ asum, bf16_t* __restrict__ stb, int gtid, int NT) {
    for (int i = gtid; i < 128 * 2048; i += NT) {
        const int bh = i >> 11, e4 = i & 2047, b = bh >> 3, h = bh & 7;
        f32x4 run = {0.f, 0.f, 0.f, 0.f};
#pragma unroll 4
        for (int c = 0; c < 16; ++c) { const int unit = (b * 16 + c) * 8 + h; const f32x4 tmp = *(const f32x4*)(sloc + (size_t)unit * 8192 + e4 * 4);
            uint2 w; w.x = cvtpk(run[0], run[1]); w.y = cvtpk(run[2], run[3]); *(uint2*)(stb + (size_t)unit * 8192 + e4 * 4) = w;
            run = run * __expf(asum[unit]) + tmp; }
    }
}
__device__ __forceinline__ void ssd_s3_unit(int unit, int lane, LAS float* tab, const bf16_t* __restrict__ xbc, const bf16_t* __restrict__ xst, const bf16_t* __restrict__ stb, const float* __restrict__ dt,
                                            const float* __restrict__ a_log, const float* __restrict__ dsk, bf16_t* __restrict__ yssm) {
    const int h = unit & 7, c = (unit >> 3) & 15, b = unit >> 7, g = h >> 2, l0 = c * 128, l31 = lane & 31, hi = lane >> 5;
    const size_t m0 = (size_t)b * SEQ + l0;
    const float A = -expf(a_log[h]), D = dsk[h];
    const float d0 = dt[(m0 + lane) * 8 + h], d1 = dt[(m0 + 64 + lane) * 8 + h];
    float ac0 = d0 * A, ac1 = d1 * A;
    scan128(ac0, ac1, lane);
    tab[lane] = ac0; tab[64 + lane] = ac1; tab[128 + lane] = d0; tab[192 + lane] = d1;
    WSYNC();
    const bf16_t* Cp = xbc + (m0 + l31) * 1024 + 768 + g * 128 + 8 * hi;
    const bf16_t* Sp = stb + (size_t)unit * 8192 + l31 * 128 + 8 * hi;
    const bf16_t* Bp = xbc + (m0 + l31) * 1024 + 512 + g * 128 + 8 * hi;
    const bf16_t* Xp = xst + ((size_t)(b * 8 + h) * 64 + l31) * SEQ + l0 + 4 * hi;
    LAS float* tr = tab + 256;
    const int row = lane >> 1, p0 = (lane & 1) * 16;
#pragma unroll 1
    for (int lt = 0; lt < 4; ++lt) {
        f32x16 y[2];
#pragma unroll
        for (int r = 0; r < 16; ++r) { y[0][r] = 0.f; y[1][r] = 0.f; }
        const float acl = tab[32 * lt + l31];
        bf16x8 cfr[8];
#pragma unroll
        for (int kk = 0; kk < 8; ++kk) cfr[kk] = *(const bf16x8*)(Cp + (size_t)lt * 32 * 1024 + 16 * kk);
        {   bf16x8 s0[8], s1[8];
#pragma unroll
            for (int kk = 0; kk < 8; ++kk) { s0[kk] = *(const bf16x8*)(Sp + 16 * kk); s1[kk] = *(const bf16x8*)(Sp + 32 * 128 + 16 * kk); }
#pragma unroll
            for (int kk = 0; kk < 8; ++kk) { y[0] = MFMA32(s0[kk], cfr[kk], y[0]); y[1] = MFMA32(s1[kk], cfr[kk], y[1]); }
        }
        { const float el = __expf(acl);
#pragma unroll
          for (int r = 0; r < 16; ++r) { y[0][r] *= el; y[1][r] *= el; } }
#pragma unroll 1
        for (int st = 0; st <= lt; ++st) {
            bf16x8 bfr[8]; u32x2 xf[2][2][2];
#pragma unroll
            for (int kk = 0; kk < 8; ++kk) bfr[kk] = *(const bf16x8*)(Bp + (size_t)st * 32 * 1024 + 16 * kk);
#pragma unroll
            for (int pt = 0; pt < 2; ++pt)
#pragma unroll
                for (int ks = 0; ks < 2; ++ks) { const bf16_t* xp = Xp + (size_t)pt * 32 * SEQ + st * 32 + 16 * ks; xf[pt][ks][0] = *(const u32x2*)xp; xf[pt][ks][1] = *(const u32x2*)(xp + 8); }
            f32x16 cbt;
#pragma unroll
            for (int r = 0; r < 16; ++r) cbt[r] = 0.f;
#pragma unroll
            for (int kk = 0; kk < 8; ++kk) cbt = MFMA32(bfr[kk], cfr[kk], cbt);
#pragma unroll
            for (int r = 0; r < 16; ++r) { const int sl = 32 * st + crow(r, hi); const float acs = tab[sl], dts = tab[128 + sl];
                float v = cbt[r] * __expf(acl - acs) * dts; if (st == lt && crow(r, hi) > l31) v = 0.f; cbt[r] = v; }
            bf16x8 pf[2];
#pragma unroll
            for (int ks = 0; ks < 2; ++ks) pf[ks] = pack8(cbt[8 * ks], cbt[8 * ks + 1], cbt[8 * ks + 2], cbt[8 * ks + 3], cbt[8 * ks + 4], cbt[8 * ks + 5], cbt[8 * ks + 6], cbt[8 * ks + 7]);
#pragma unroll
            for (int pt = 0; pt < 2; ++pt)
#pragma unroll
                for (int ks = 0; ks < 2; ++ks) { v4u a; a.x = xf[pt][ks][0].x; a.y = xf[pt][ks][0].y; a.z = xf[pt][ks][1].x; a.w = xf[pt][ks][1].y; y[pt] = MFMA32(__builtin_bit_cast(bf16x8, a), pf[ks], y[pt]); }
        }
#pragma unroll
        for (int pt = 0; pt < 2; ++pt) {
#pragma unroll
            for (int r = 0; r < 16; ++r) tr[l31 * 33 + crow(r, hi)] = y[pt][r];
            WSYNC();
            const size_t m = m0 + 32 * lt + row;
            const v4u xa = *(const v4u*)(xbc + m * 1024 + h * 64 + 32 * pt + p0), xb = *(const v4u*)(xbc + m * 1024 + h * 64 + 32 * pt + p0 + 8);
            const unsigned xu[8] = {xa.x, xa.y, xa.z, xa.w, xb.x, xb.y, xb.z, xb.w};
            unsigned ow[8];
#pragma unroll
            for (int q = 0; q < 8; ++q) { const float v0 = tr[row * 33 + p0 + 2 * q] + D * bflo(xu[q]), v1 = tr[row * 33 + p0 + 2 * q + 1] + D * bfhi(xu[q]); ow[q] = cvtpk(v0, v1); }
            bf16_t* dst = yssm + m * 512 + h * 64 + 32 * pt + p0;
            *(v4u*)dst = (v4u){ow[0], ow[1], ow[2], ow[3]}; *(v4u*)(dst + 8) = (v4u){ow[4], ow[5], ow[6], ow[7]};
            WSYNC();
        }
    }
}


__device__ __forceinline__ float sum8(float x) { x += dpp_mov<0xB1>(x); x += dpp_mov<0x4E>(x); x += dpp_mov<0x141>(x); return x; }
__device__ __forceinline__ float sum32(float x, int lane) { x = rowsum16(x); return x + bperm(lane ^ 16, x); }
__device__ __forceinline__ void unpack8(const v4u& w, float (&f)[8]) { f[0] = bflo(w.x); f[1] = bfhi(w.x); f[2] = bflo(w.y); f[3] = bfhi(w.y); f[4] = bflo(w.z); f[5] = bfhi(w.z); f[6] = bflo(w.w); f[7] = bfhi(w.w); }
__device__ __forceinline__ void ssm_gate_norm_vec(const bf16_t* __restrict__ yssm, const bf16_t* __restrict__ proj, const float* __restrict__ ng, bf16_t* __restrict__ ymix, int m0, int m1, int w, int nw, int lane) {
    const int c0 = lane * 8;
    float gn[8];
    { const f32x4 a = *(const f32x4*)(ng + c0), b = *(const f32x4*)(ng + c0 + 4); gn[0] = a[0]; gn[1] = a[1]; gn[2] = a[2]; gn[3] = a[3]; gn[4] = b[0]; gn[5] = b[1]; gn[6] = b[2]; gn[7] = b[3]; }
    for (int mb = m0 + w; mb < m1; mb += nw * 4) {
        v4u yv[4], zv[4];
#pragma unroll
        for (int k = 0; k < 4; ++k) { const int m = (mb + k * nw < m1) ? mb + k * nw : mb; yv[k] = *(const v4u*)(yssm + (size_t)m * 512 + c0); zv[k] = *(const v4u*)(proj + (size_t)m * L0P + 1792 + c0); }
#pragma unroll
        for (int k = 0; k < 4; ++k) { const int m = mb + k * nw;
            float y[8], z[8], u[8], q = 0.f; unpack8(yv[k], y); unpack8(zv[k], z);
#pragma unroll
            for (int j = 0; j < 8; ++j) { u[j] = y[j] * z[j] * __builtin_amdgcn_rcpf(1.f + __builtin_amdgcn_exp2f(-1.4426950408889634f * z[j])); q += u[j] * u[j]; }
            const float rs = __builtin_amdgcn_rsqf(sum32(q, lane) * (1.f / 256.f) + 1e-5f);
            v4u o; o.x = cvtpk(u[0] * rs * gn[0], u[1] * rs * gn[1]); o.y = cvtpk(u[2] * rs * gn[2], u[3] * rs * gn[3]); o.z = cvtpk(u[4] * rs * gn[4], u[5] * rs * gn[5]); o.w = cvtpk(u[6] * rs * gn[6], u[7] * rs * gn[7]);
            if (m < m1) *(v4u*)(ymix + (size_t)m * DM + 512 + c0) = o; }
    }
}
__device__ __forceinline__ void rwkv_post_vec(const float* __restrict__ yraw, const bf16_t* __restrict__ proj, const float* __restrict__ mix, const float* __restrict__ bonus, const bf16_t* __restrict__ gbuf,
                                              const float* __restrict__ ln_g, const float* __restrict__ ln_b, bf16_t* __restrict__ ymix, int gw, int NGW, int lane) {
    const int c0 = lane * 8, h = lane >> 3;
    float lg[8], lb[8], mx[8];
    { const f32x4 a = *(const f32x4*)(ln_g + c0), b = *(const f32x4*)(ln_g + c0 + 4), c = *(const f32x4*)(ln_b + c0), d = *(const f32x4*)(ln_b + c0 + 4), e = *(const f32x4*)(mix + 1024 + c0), f = *(const f32x4*)(mix + 1024 + c0 + 4);
#pragma unroll
      for (int j = 0; j < 4; ++j) { lg[j] = a[j]; lg[4 + j] = b[j]; lb[j] = c[j]; lb[4 + j] = d[j]; mx[j] = e[j]; mx[4 + j] = f[j]; } }
    for (int mb = gw; mb < M; mb += NGW * 2) {
        f32x4 ya[2], yb[2]; v4u cv[2], pv[2], gv[2]; float bo[2];
#pragma unroll
        for (int k = 0; k < 2; ++k) { const int m = mb + k * NGW; const bool hp = (m & (SEQ - 1)) != 0;
            ya[k] = *(const f32x4*)(yraw + (size_t)m * 512 + c0); yb[k] = *(const f32x4*)(yraw + (size_t)m * 512 + c0 + 4);
            cv[k] = *(const v4u*)(proj + (size_t)m * L0P + 1024 + c0); pv[k] = *(const v4u*)(proj + (size_t)(hp ? m - 1 : m) * L0P + 1024 + c0);
            gv[k] = *(const v4u*)(gbuf + (size_t)m * 512 + c0); bo[k] = bonus[(size_t)m * 8 + h]; }
#pragma unroll
        for (int k = 0; k < 2; ++k) { const int m = mb + k * NGW; const float pz = ((m & (SEQ - 1)) != 0) ? 1.f : 0.f;
            float y[8] = {ya[k][0], ya[k][1], ya[k][2], ya[k][3], yb[k][0], yb[k][1], yb[k][2], yb[k][3]}, cc[8], pp[8], gg[8];
            unpack8(cv[k], cc); unpack8(pv[k], pp); unpack8(gv[k], gg);
            float sm = 0.f;
#pragma unroll
            for (int j = 0; j < 8; ++j) sm += y[j];
            const float mu = sum8(sm) * (1.f / 64.f);
            float qv = 0.f;
#pragma unroll
            for (int j = 0; j < 8; ++j) { y[j] -= mu; qv += y[j] * y[j]; }
            const float rs = __builtin_amdgcn_rsqf(sum8(qv) * (1.f / 64.f) + 64e-5f);
            float o[8];
#pragma unroll
            for (int j = 0; j < 8; ++j) { const float vs = cc[j] + (pp[j] * pz - cc[j]) * mx[j]; o[j] = (y[j] * rs * lg[j] + lb[j] + bo[k] * vs) * gg[j]; }
            v4u w; w.x = cvtpk(o[0], o[1]); w.y = cvtpk(o[2], o[3]); w.z = cvtpk(o[4], o[5]); w.w = cvtpk(o[6], o[7]);
            *(v4u*)(ymix + (size_t)m * DM + c0) = w; }
    }
}

struct Args { const float* in[43]; float* out; unsigned char* ws; };
constexpr int HG_PITCH = 144, HG_A_BYTES = 128 * HG_PITCH, HG_STAGE = (128 + 256) * HG_PITCH;
__device__ __forceinline__ void halo_gemm_unit(int unit, int tid, int lane, int wave, LAS unsigned char* lds, const bf16_t* __restrict__ XBp, const bf16_t* __restrict__ Wup, bf16_t* __restrict__ HALOp) {
    const int pm = unit / 11, pn = unit - pm * 11, wr = wave >> 2, wc = wave & 3, l31 = lane & 31, hi = lane >> 5;
    const int srow = tid >> 3, sch = tid & 7;
    const bf16_t* gA[2]; const bf16_t* gB[4]; int lA[2], lB[4];
#pragma unroll
    for (int i = 0; i < 2; ++i) { const int row = srow + 64 * i, R = 128 * pm + row; gA[i] = XBp + (size_t)(64 * (R >> 1) + 62 + (R & 1)) * DM + sch * 8; lA[i] = row * HG_PITCH + sch * 16; }
#pragma unroll
    for (int i = 0; i < 4; ++i) { const int row = srow + 64 * i, ch = 256 * pn + row; gB[i] = Wup + (size_t)(256 * (ch >> 7) + (ch & 127)) * 1024 + sch * 8; lB[i] = HG_A_BYTES + row * HG_PITCH + sch * 16; }
    f32x16 acc[2][2];
#pragma unroll
    for (int a = 0; a < 2; ++a)
#pragma unroll
        for (int b = 0; b < 2; ++b)
#pragma unroll
            for (int r = 0; r < 16; ++r) acc[a][b][r] = 0.f;
    v4u ra0[2], rb0[4], ra1[2], rb1[4];
#pragma unroll
    for (int i = 0; i < 2; ++i) ra0[i] = *(const v4u*)gA[i];
#pragma unroll
    for (int i = 0; i < 4; ++i) rb0[i] = *(const v4u*)gB[i];
#pragma unroll
    for (int i = 0; i < 2; ++i) ra1[i] = *(const v4u*)(gA[i] + 64);
#pragma unroll
    for (int i = 0; i < 4; ++i) rb1[i] = *(const v4u*)(gB[i] + 64);
#pragma unroll
    for (int i = 0; i < 2; ++i) *(LAS v4u*)(lds + lA[i]) = ra0[i];
#pragma unroll
    for (int i = 0; i < 4; ++i) *(LAS v4u*)(lds + lB[i]) = rb0[i];
    __syncthreads();
    const int fA = (64 * wr + l31) * HG_PITCH + 16 * hi, fB = HG_A_BYTES + (64 * wc + l31) * HG_PITCH + 16 * hi;
#define HG_COMPUTE(S) do { _Pragma("unroll") for (int st = 0; st < 4; ++st) { bf16x8 fa[2], fb[2]; \
        _Pragma("unroll") for (int x = 0; x < 2; ++x) { fa[x] = *(const LAS bf16x8*)((S) + fA + 32 * x * HG_PITCH + 32 * st); fb[x] = *(const LAS bf16x8*)((S) + fB + 32 * x * HG_PITCH + 32 * st); } \
        _Pragma("unroll") for (int a = 0; a < 2; ++a) _Pragma("unroll") for (int b = 0; b < 2; ++b) acc[a][b] = MFMA32(fb[b], fa[a], acc[a][b]); } } while (0)
#pragma unroll 1
    for (int c = 0; c < 16; c += 2) {
        { const int k2 = (c + 2 < 16) ? 64 * (c + 2) : 0;
#pragma unroll
          for (int i = 0; i < 2; ++i) ra0[i] = *(const v4u*)(gA[i] + k2);
#pragma unroll
          for (int i = 0; i < 4; ++i) rb0[i] = *(const v4u*)(gB[i] + k2);
          HG_COMPUTE(lds);
#pragma unroll
          for (int i = 0; i < 2; ++i) *(LAS v4u*)(lds + HG_STAGE + lA[i]) = ra1[i];
#pragma unroll
          for (int i = 0; i < 4; ++i) *(LAS v4u*)(lds + HG_STAGE + lB[i]) = rb1[i];
          __syncthreads(); }
        { const int k3 = (c + 3 < 16) ? 64 * (c + 3) : 0;
#pragma unroll
          for (int i = 0; i < 2; ++i) ra1[i] = *(const v4u*)(gA[i] + k3);
#pragma unroll
          for (int i = 0; i < 4; ++i) rb1[i] = *(const v4u*)(gB[i] + k3);
          HG_COMPUTE(lds + HG_STAGE);
          if (c + 2 < 16) {
#pragma unroll
              for (int i = 0; i < 2; ++i) *(LAS v4u*)(lds + lA[i]) = ra0[i];
#pragma unroll
              for (int i = 0; i < 4; ++i) *(LAS v4u*)(lds + lB[i]) = rb0[i];
          }
          __syncthreads(); }
    }
#undef HG_COMPUTE
#pragma unroll
    for (int a = 0; a < 2; ++a) { const int R = 128 * pm + 64 * wr + 32 * a + l31;
#pragma unroll
        for (int b = 0; b < 2; ++b)
#pragma unroll
            for (int g = 0; g < 4; ++g) { const int ch = 256 * pn + 64 * wc + 32 * b + 8 * g + 4 * hi;
                u32x2 w; w.x = cvtpk(acc[a][b][4 * g], acc[a][b][4 * g + 1]); w.y = cvtpk(acc[a][b][4 * g + 2], acc[a][b][4 * g + 3]);
                *(u32x2*)(HALOp + (size_t)R * DFF + ch) = w; } }
}
__device__ __forceinline__ void halo_signal(unsigned* cnt) {
    asm volatile("s_waitcnt vmcnt(0)" ::: "memory");
    __syncthreads();
    if (threadIdx.x == 0) { __builtin_amdgcn_fence(__ATOMIC_RELEASE, "agent"); asm volatile("s_waitcnt vmcnt(0)" ::: "memory"); (void)xb_add(cnt, 1u); }
}
__device__ __forceinline__ void halo_wait(unsigned* cnt, unsigned need, unsigned* bar) {
    if (threadIdx.x == 0) { XB_SPIN(xb_ld(cnt) < need, bar); __builtin_amdgcn_fence(__ATOMIC_ACQUIRE, "agent"); asm volatile("s_waitcnt vmcnt(0)" ::: "memory"); }
    __syncthreads();
}
#define GEMM_PHASE(EPI, Aptr, LDA, Bptr, LDB, NN, KK, ...) do { pg8::Gemm g_{(Aptr), (Bptr), M, (NN), (KK), (LDA), (LDB)}; pg8::StaticOrder S_; S_.init(M, (NN), G, (int)blockIdx.x); \
        pg8::EPI E_{__VA_ARGS__}; pg8::gemm_phase<pg8::EPI, pg8::StaticOrder, true, true>(lds3, g_, S_, E_); } while (0)

__global__ void __launch_bounds__(NWAVES * 64, 2) fwd_mega(Args args) {
    extern __shared__ __attribute__((aligned(16))) unsigned char lds[];
    LAS unsigned char* lds3 = (LAS unsigned char*)lds;
    volatile LAS unsigned* MISC = (volatile LAS unsigned*)(lds3 + MISC_OFF);
    const int G = gridDim.x, NGW = G * NWAVES, NT = G * NWAVES * 64;
#define PHASE_IDS() int tid = threadIdx.x; asm volatile("" : "+v"(tid)); const int lane = tid & 63, wave = __builtin_amdgcn_readfirstlane(tid >> 6); const int gw = blockIdx.x * NWAVES + wave, gtid = blockIdx.x * (NWAVES * 64) + tid; (void)lane; (void)gw; (void)gtid
    unsigned char* ws = args.ws;
    gu32* ctl = (gu32*)(ws + WS_CTL);
    for (int u = threadIdx.x; u < (LDS_BYTES - LDSCTL_OFF) / 4; u += NWAVES * 64) ((LAS unsigned*)(lds3 + LDSCTL_OFF))[u] = 0u;
    __syncthreads();
    XcdBarrier bar = xcd_barrier_post((unsigned*)(ctl + CW_BAR), MISC + 8);
#if defined(PROBE_STAMPS)
    int nb_ = 0;
    if (blockIdx.x == 0 && threadIdx.x == 0) MISC[16] = (unsigned)__builtin_amdgcn_s_memrealtime();
#define GRID_BAR() do { xcd_barrier(bar); ++nb_; if (blockIdx.x == 0 && threadIdx.x == 0) MISC[16 + nb_] = (unsigned)__builtin_amdgcn_s_memrealtime(); } while (0)
#else
#define GRID_BAR() xcd_barrier(bar)
#endif
#define IN(i) (args.in[i])
    float* out = args.out;
    bf16_t* W0in = (bf16_t*)(ws + WS_W0IN); bf16_t* W0out = (bf16_t*)(ws + WS_W0OUT); bf16_t* Wup0 = (bf16_t*)(ws + WS_WUP0); bf16_t* Wdn0 = (bf16_t*)(ws + WS_WDN0);
    bf16_t* W1in = (bf16_t*)(ws + WS_W1IN); bf16_t* Wuq = (bf16_t*)(ws + WS_WUQ); bf16_t* Wukv = (bf16_t*)(ws + WS_WUKV); bf16_t* W1out = (bf16_t*)(ws + WS_W1OUT);
    bf16_t* Wup1 = (bf16_t*)(ws + WS_WUP1); bf16_t* Wdn1 = (bf16_t*)(ws + WS_WDN1);
    bf16_t* XB = (bf16_t*)(ws + WS_XB); bf16_t* YMIX = (bf16_t*)(ws + WS_YMIX); bf16_t* PROJ0 = (bf16_t*)(ws + WS_BIG);
    bf16_t* ZB = (bf16_t*)out; float* YRAW = out; bf16_t* YSSM = (bf16_t*)(out + (size_t)M * 512); bf16_t* STB = (bf16_t*)(out + (size_t)M * 768); bf16_t* XST = (bf16_t*)(ws + WS_XST); bf16_t* BT = (bf16_t*)(ws + WS_BT); float* ASUM = (float*)(ws + WS_ASUM); float* SLOC = (float*)(ws + WS_SLOC); float* DT = (float*)(ws + WS_DT); bf16_t* GB = (bf16_t*)(ws + WS_G); float* BONUS = (float*)(ws + WS_BONUS);
    bf16_t* W2T = (bf16_t*)(ws + WS_W2T); bf16_t* A2T = (bf16_t*)(ws + WS_A2T); bf16_t* G2T = (bf16_t*)(ws + WS_G2T); bf16_t* ACT = (bf16_t*)(ws + WS_GU); bf16_t* HALO = (bf16_t*)(ws + WS_GU + 176 * MiB);
    bf16_t* PROJ1 = (bf16_t*)(ws + WS_PROJ1); bf16_t* QM = (bf16_t*)(ws + WS_QM); bf16_t* KVM = (bf16_t*)(ws + WS_KVM); bf16_t* KPE = (bf16_t*)(ws + WS_KPE); float* RS = (float*)(ws + WS_RS); float* CSTAB = (float*)(ws + WS_CSTAB); float* STATS = (float*)(ws + WS_CSTAB + 4 * MiB); bf16_t* VTS = (bf16_t*)(ws + WS_VTS); bf16_t* VTM = (bf16_t*)(ws + WS_VTM);
    const int* pos = (const int*)args.in[1];

    {
        PHASE_IDS();
    {
        LAS float* scr = (LAS float*)(lds3 + wave * 16384); int trb = 0;
        transpose_matrix(IN(2), 1024, 3336, W0in, L0P, 1024, scr, gw, NGW, lane, nullptr, trb);
        transpose_matrix(IN(20), 1024, 1024, W0out, 1024, 1024, scr, gw, NGW, lane, nullptr, trb);
        transpose_matrix(IN(5), 64, 512, W2T, 512, 64, scr, gw, NGW, lane, nullptr, trb);
        transpose_matrix(IN(7), 64, 512, A2T, 512, 64, scr, gw, NGW, lane, nullptr, trb);
        transpose_matrix(IN(8), 128, 512, G2T, 512, 128, scr, gw, NGW, lane, nullptr, trb);
        const float* x = IN(0);
        {
            constexpr size_t TOT4 = (size_t)M * DM / 4;
            for (size_t i = gtid; i < TOT4; i += (size_t)NT * 8) {
                f32x4 v[8];
#pragma unroll
                for (int u = 0; u < 8; ++u) v[u] = *(const f32x4*)(x + (i + (size_t)u * NT) * 4);
#pragma unroll
                for (int u = 0; u < 8; ++u) { uint2 w; w.x = cvtpk(v[u][0], v[u][1]); w.y = cvtpk(v[u][2], v[u][3]); *(uint2*)(XB + (i + (size_t)u * NT) * 4) = w; }
            }
        }
    }
    }
    GRID_BAR();
    {
        PHASE_IDS();
    GEMM_PHASE(EpiBf16S, XB, DM, W0in, 1024, L0P, 1024, PROJ0, nullptr, L0P, 0);
    }
    GRID_BAR();
    {
        PHASE_IDS();
        const int blk = (int)blockIdx.x, m0 = blk * 128;
        {   LAS bf16_t* scr = (LAS bf16_t*)(lds3 + wave * 16384);
#pragma unroll 1
            for (int k = 0; k < 4; ++k) ssd_conv_tile((2 * blk + (k & 1)) * 16 + wave + 8 * (k >> 1), lane, scr, PROJ0, IN(14), IN(15), XB, XST, BT);
            for (int i = tid; i < 1024; i += NWAVES * 64) { const int m = m0 + (i >> 3); DT[(size_t)m * 8 + (i & 7)] = softplusf_(bf2f(PROJ0[(size_t)m * L0P + 3328 + (i & 7)]) + IN(16)[i & 7]); }
        }
        __syncthreads();
#if defined(PROBE_STAMPS)
        if (blockIdx.x == 0 && threadIdx.x == 0) MISC[16 + 29] = (unsigned)__builtin_amdgcn_s_memrealtime();
#endif
        ssd_s1_unit(blk * 8 + wave, lane, (LAS float*)(lds3 + wave * 16384), XST, BT, DT, IN(17), SLOC, ASUM);
    }
    GRID_BAR();
    {
        PHASE_IDS();
        ssd_s2_all(SLOC, ASUM, STB, gtid, NT);
    }
    GRID_BAR();
    {
        PHASE_IDS();
        const int blk = (int)blockIdx.x;
        if (blk < 128) {
            rwkv_phase_chain((LAS float*)lds3, tid, lane, wave, blk, PROJ0, IN(3), IN(4), IN(6), IN(9), IN(10), IN(11), W2T, A2T, G2T, YRAW, GB, BONUS);
#if defined(PROBE_STAMPS)
            if (blk == 0 && threadIdx.x == 0) MISC[16 + 23] = (unsigned)__builtin_amdgcn_s_memrealtime();
#endif
        } else {
            const int bc0 = (blk - 128) * 2;
#if defined(PROBE_STAMPS)
            const unsigned tu0_ = (unsigned)__builtin_amdgcn_s_memrealtime();
#endif
            {
                const int gwu = (blk - 128) * NWAVES + wave;
                gate_lora_wave(gwu, 128 * NWAVES, lane, PROJ0, IN(3), G2T, GB);
            }
#if defined(PROBE_STAMPS)
            __syncthreads(); if (blk == 128 && threadIdx.x == 0) __hip_atomic_store(ctl + 2049, (unsigned)__builtin_amdgcn_s_memrealtime() - tu0_, __ATOMIC_RELAXED, __HIP_MEMORY_SCOPE_AGENT);
#endif
#pragma unroll 1
            for (int u = 0; u < 2; ++u) ssd_s3_block(bc0 + u, tid, lane, wave, lds3, XB, XST, STB, DT, IN(17), IN(18), YSSM);
            __syncthreads();
#if defined(PROBE_STAMPS)
            __syncthreads(); if (blk == 128 && threadIdx.x == 0) __hip_atomic_store(ctl + 2050, (unsigned)__builtin_amdgcn_s_memrealtime() - tu0_, __ATOMIC_RELAXED, __HIP_MEMORY_SCOPE_AGENT);
#endif
            ssm_gate_norm_vec(YSSM, PROJ0, IN(19), YMIX, bc0 * 128, bc0 * 128 + 256, wave, NWAVES, lane);
#if defined(PROBE_STAMPS)
            __syncthreads(); if (blk == 128 && threadIdx.x == 0) __hip_atomic_store(ctl + 2051, (unsigned)__builtin_amdgcn_s_memrealtime() - tu0_, __ATOMIC_RELAXED, __HIP_MEMORY_SCOPE_AGENT);
#endif
            { const int gwu = (blk - 128) * NWAVES + wave, NGWU = 128 * NWAVES; LAS float* scr = (LAS float*)(lds3 + wave * 16384); int trb = 0;
              transpose_matrix(IN(23), 1024, 5632, Wup0, 5632, 1024, scr, gwu, NGWU, lane, nullptr, trb, true);
              transpose_matrix(IN(26), 2816, 1024, Wdn0, 1024, 2816, scr, gwu, NGWU, lane, nullptr, trb);
            }
#if defined(PROBE_STAMPS)
            __syncthreads(); if (blk == 128 && threadIdx.x == 0) __hip_atomic_store(ctl + 2048, (unsigned)__builtin_amdgcn_s_memrealtime() - tu0_, __ATOMIC_RELAXED, __HIP_MEMORY_SCOPE_AGENT);
#endif
        }
    }
    GRID_BAR();
    {
        PHASE_IDS();
        rwkv_post_vec(YRAW, PROJ0, IN(3), BONUS, GB, IN(12), IN(13), YMIX, gw, NGW, lane);
    }
    GRID_BAR();
    {
        PHASE_IDS();
    GEMM_PHASE(EpiResid, YMIX, DM, W0out, 1024, 1024, 1024, IN(0), ZB, ALPHA, 0);
    }
    GRID_BAR();
    {
        PHASE_IDS();
        if ((int)blockIdx.x >= 88) {
            ln_rows_range<1, 2>(ZB, XB, nullptr, STATS, IN(21), IN(22), ((int)blockIdx.x - 88) * NWAVES + wave, (M / 64) * 31, (G - 88) * NWAVES, lane);
        } else {
            const int pm_ = (int)blockIdx.x / 11;
            ln_rows_range<1, 1>(ZB, XB, nullptr, STATS, IN(21), IN(22), 64 * pm_ + wave, 64 * pm_ + 64, NWAVES, lane);
            asm volatile("s_waitcnt vmcnt(0)" ::: "memory");
            __syncthreads();
            if (threadIdx.x == 0) { __builtin_amdgcn_fence(__ATOMIC_ACQUIRE, "agent"); asm volatile("s_waitcnt vmcnt(0)" ::: "memory"); }
            __syncthreads();
            halo_gemm_unit((int)blockIdx.x, tid, lane, wave, lds3, XB, Wup0, HALO);
        }
        {
            const int gwu = gw, NGWU = NGW; LAS float* scr = (LAS float*)(lds3 + wave * 16384); int trb = 0;
            transpose_matrix(IN(29), 1024, 1952, W1in, L1P, 1024, scr, gwu, NGWU, lane, nullptr, trb);
            transpose_matrix(IN(31), 256, 768, Wuq, 768, 256, scr, gwu, NGWU, lane, IN(30), trb);
            transpose_matrix(IN(33), 128, 1024, Wukv, 1024, 256, scr, gwu, NGWU, lane, IN(32), trb);
            transpose_matrix(IN(34), 1024, 1024, W1out, 1024, 1024, scr, gwu, NGWU, lane, nullptr, trb);
            transpose_matrix(IN(37), 1024, 5632, Wup1, 5632, 1024, scr, gwu, NGWU, lane, nullptr, trb, true);
            transpose_matrix(IN(40), 2816, 1024, Wdn1, 1024, 2816, scr, gwu, NGWU, lane, nullptr, trb);
            for (int i = gwu * 64 + lane; i < 1024 * 16; i += NGWU * 64) { const int n = i >> 4, c = i & 15; *(v4u*)(Wukv + (size_t)n * 256 + 128 + c * 8) = (v4u){0u, 0u, 0u, 0u}; }
        }
    }
    GRID_BAR();
    {
        PHASE_IDS();
        { pg8::Gemm g_{XB, Wup0, M, 2 * DFF, 1024, DM, 1024, 128, 256, 128, 256, 0, 1}; pg8::StaticOrder S_; S_.init(M, 2 * DFF, G, (int)blockIdx.x);
          pg8::EpiConvAct E_{ACT, HALO, IN(24), IN(25), DFF, SEQ}; pg8::gemm_phase<pg8::EpiConvAct, pg8::StaticOrder, true, true>(lds3, g_, S_, E_); }
    }
    GRID_BAR();
    {
        PHASE_IDS();
    GEMM_PHASE(EpiResidLN, ACT, DFF, Wdn0, DFF, 1024, DFF, ZB, ZB, STATS, IN(21), IN(22), ALPHA, 0);
    }
    GRID_BAR();
    {
        PHASE_IDS();
    ln_rows<1>(ZB, XB, nullptr, STATS, IN(27), IN(28), gw, NGW, lane);
    }
    GRID_BAR();
    {
        PHASE_IDS();
    GEMM_PHASE(EpiBf16S, XB, DM, W1in, 1024, L1P, 1024, PROJ1, nullptr, L1P, 0);
    }
    GRID_BAR();
    {
        PHASE_IDS();
    mla_prep_all(PROJ1, pos, RS, KPE, CSTAB, gw, NGW, lane);
    {
        LAS bf16_t* scr = (LAS bf16_t*)(lds3 + wave * 16384);
        for (int r = gw; r < 4096; r += NGW) { const int bh = r >> 5, tt = r & 31, b = bh >> 3, h = bh & 7;
            transpose_tile64(PROJ1 + ((size_t)b * SEQ + tt * 64) * L1P + 1024 + h * 64, L1P, VTS + (size_t)bh * 64 * SEQ + tt * 64, SEQ, scr, lane); }
    }
    }
    GRID_BAR();
    {
        PHASE_IDS();
    GEMM_PHASE(EpiBf16S, PROJ1 + 1536, L1P, Wuq, 256, 768, 256, QM, RS, 768, 2);
    GEMM_PHASE(EpiBf16S, PROJ1 + 1792, L1P, Wukv, 256, 1024, 256, KVM, RS + 1, 1024, 2);
    }
    GRID_BAR();
    {
        PHASE_IDS();
    {
        LAS bf16_t* scr = (LAS bf16_t*)(lds3 + wave * 16384);
        for (int r = gw; r < 4096; r += NGW) { const int bh = r >> 5, tt = r & 31, b = bh >> 3, h = bh & 7;
            transpose_tile64(KVM + ((size_t)b * SEQ + tt * 64) * 1024 + h * 128 + 64, 1024, VTM + (size_t)bh * 64 * SEQ + tt * 64, SEQ, scr, lane); }
    }
    }
    GRID_BAR();
    {
        PHASE_IDS();
    {
        { LAS unsigned char* wl = lds3 + wave * 16384;
          for (int g2 = gw; g2 < 2048; g2 += NGW) { const int bh = g2 >> 4, w = g2 & 15;
#pragma unroll 1
              for (int i = 0; i < 4; ++i) { const int qb = (i == 0) ? w : (i == 1) ? 31 - w : (i == 2) ? 32 + w : 63 - w; sb_wave(bh, qb, lane, PROJ1, VTS, YMIX, wl); } } }
        __syncthreads();
        for (int g2 = (int)blockIdx.x; g2 < 256; g2 += G) { const int bh = g2 >> 1, part = g2 & 1;
#pragma unroll 1
            for (int i = 0; i < 4; ++i) { const int sbk = part ? ((i == 0) ? 1 : (i == 1) ? 6 : (i == 2) ? 2 : 5) : ((i == 0) ? 0 : (i == 1) ? 7 : (i == 2) ? 3 : 4);
                mla_block(bh, sbk, tid, lane, wave, lds3, QM, KVM, KPE, VTM, YMIX, CSTAB); } }
    }
    }
    GRID_BAR();
    {
        PHASE_IDS();
    GEMM_PHASE(EpiResidLN, YMIX, DM, W1out, 1024, 1024, 1024, ZB, ZB, STATS, IN(27), IN(28), ALPHA, 0);
    }
    GRID_BAR();
    {
        PHASE_IDS();
        if ((int)blockIdx.x >= 88) {
            ln_rows_range<1, 2>(ZB, XB, nullptr, STATS, IN(35), IN(36), ((int)blockIdx.x - 88) * NWAVES + wave, (M / 64) * 31, (G - 88) * NWAVES, lane);
        } else {
            const int pm_ = (int)blockIdx.x / 11;
            ln_rows_range<1, 1>(ZB, XB, nullptr, STATS, IN(35), IN(36), 64 * pm_ + wave, 64 * pm_ + 64, NWAVES, lane);
            asm volatile("s_waitcnt vmcnt(0)" ::: "memory");
            __syncthreads();
            if (threadIdx.x == 0) { __builtin_amdgcn_fence(__ATOMIC_ACQUIRE, "agent"); asm volatile("s_waitcnt vmcnt(0)" ::: "memory"); }
            __syncthreads();
            halo_gemm_unit((int)blockIdx.x, tid, lane, wave, lds3, XB, Wup1, HALO);
        }
    }
    GRID_BAR();
    {
        PHASE_IDS();
        { pg8::Gemm g_{XB, Wup1, M, 2 * DFF, 1024, DM, 1024, 128, 256, 128, 256, 0, 1}; pg8::StaticOrder S_; S_.init(M, 2 * DFF, G, (int)blockIdx.x);
          pg8::EpiConvAct E_{ACT, HALO, IN(38), IN(39), DFF, SEQ}; pg8::gemm_phase<pg8::EpiConvAct, pg8::StaticOrder, true, true>(lds3, g_, S_, E_); }
    }
    GRID_BAR();
    {
        PHASE_IDS();
    GEMM_PHASE(EpiResidLN, ACT, DFF, Wdn1, DFF, 1024, DFF, ZB, XB, STATS, IN(35), IN(36), ALPHA, 0);
    }
    GRID_BAR();
    {
        PHASE_IDS();
    ln_rows<2>(XB, nullptr, out, STATS, IN(41), IN(42), gw, NGW, lane);
    #if defined(PROBE_STAMPS)
    __syncthreads();
    if (blockIdx.x == 0 && threadIdx.x == 0) {
        MISC[16 + 22] = (unsigned)__builtin_amdgcn_s_memrealtime();
#if defined(PROBE_GLOBAL)
#ifndef PROBE_GIDX
#define PROBE_GIDX 0
#endif
        const unsigned d1 = __hip_atomic_load(ctl + 2048 + PROBE_GIDX, __ATOMIC_RELAXED, __HIP_MEMORY_SCOPE_AGENT);
#elif defined(PROBE_ACC)
        const unsigned d1 = MISC[16 + PROBE_ACC];
#else
        const unsigned d1 = MISC[16 + PROBE_T1_HI] - MISC[16 + PROBE_T1_LO];
#endif
        const unsigned long long spin = 100ull * d1;
        const unsigned long long t0 = __builtin_amdgcn_s_memrealtime();
        while (__builtin_amdgcn_s_memrealtime() - t0 < spin) __builtin_amdgcn_s_sleep(8);
    }
#endif
}
}

extern "C" void kernel_launch(void* const* d_in, const int* in_sizes, int n_in, void* d_out, int out_size, void* d_ws, size_t ws_size, hipStream_t stream) {
    static int grid = 0;
    if (grid == 0) {
        if (n_in != 43 || ws_size < WS_NEED || out_size != M * DM) { fprintf(stderr, "kernel_launch: unexpected n_in %d / ws %zu / out %d\n", n_in, ws_size, out_size); grid = -1; return; }
        int dev = 0, cus = 0, per_cu = 0;
        if (hipGetDevice(&dev) != hipSuccess || hipDeviceGetAttribute(&cus, hipDeviceAttributeMultiprocessorCount, dev) != hipSuccess) { grid = -1; return; }
        if (hipFuncSetAttribute((const void*)fwd_mega, hipFuncAttributeMaxDynamicSharedMemorySize, LDS_BYTES) != hipSuccess) { fprintf(stderr, "kernel_launch: hipFuncSetAttribute failed\n"); grid = -1; return; }
        if (hipOccupancyMaxActiveBlocksPerMultiprocessor(&per_cu, (const void*)fwd_mega, NWAVES * 64, LDS_BYTES) != hipSuccess || per_cu < 1) fprintf(stderr, "kernel_launch: occupancy query reports %d\n", per_cu);
        (void)hipGetLastError();
        grid = cus;
    }
    if (grid < 0) return;
    (void)hipMemsetAsync((char*)d_ws + WS_CTL, 0, CTL_ZERO_BYTES, stream);
    Args a{};
    for (int i = 0; i < 43; ++i) a.in[i] = (const float*)d_in[i];
    a.out = (float*)d_out; a.ws = (unsigned char*)d_ws;
    hipLaunchKernelGGL(fwd_mega, dim3(grid), dim3(NWAVES * 64), LDS_BYTES, stream, a);
}
```

```cpp
#include <hip/hip_runtime.h>
#include <cstdio>
#include <cstdint>
#include <cmath>
namespace pg8 {
#define PG8_LAS __attribute__((address_space(3)))
typedef unsigned short bf16_t;
typedef short bf16x8 __attribute__((ext_vector_type(8)));
typedef float f32x4 __attribute__((ext_vector_type(4)));
typedef unsigned u32x4 __attribute__((ext_vector_type(4)));
constexpr int BM = 256, BK = 64, HALF = 128, HTB = HALF * BK * 2  , STAGE_BYTES = 8 * HTB, NXCD = 8, WGM = 8;

__host__ __device__ __forceinline__ int lds_byte(int r, int c) { const int st = (r >> 4) * 2 + (c >> 5), rr = r & 15, cc = c & 31, ob = rr * 64 + cc * 2; return st * 1024 + (ob ^ (((ob >> 9) & 1) << 5)); }
__host__ __device__ __forceinline__ void stage_rc(int b, int& R, int& C) { const int st = b / 1024, sb = b % 1024, swz = sb ^ (((sb >> 9) & 1) << 5); R = (st >> 1) * 16 + swz / 64; C = (st & 1) * 32 + (swz % 64) / 2; }
__host__ __device__ __forceinline__ int perm32(int rho) { const int n = rho >> 4, i = rho & 15; return 8 * (i >> 2) + 4 * n + (i & 3); }

struct Unit { int pm, pn; };
struct Gemm { const bf16_t* A; const bf16_t* Bt; int M, N, K, lda, ldb; int hrA = 128, trA = 256, hrB = 128, trB = 256, gatherA = 0, permA = 0; };

struct StaticOrder {
    int nM, nN, nwg, G, c;
    __host__ __device__ void init(int M, int N, int G_, int c_) { nM = M / BM; nN = N / BM; nwg = nM * nN; G = G_; c = c_; }
    __host__ __device__ bool next(int i, Unit& u) const {
        const long L = (long)i * G + c; if (L >= nwg) return false;
        int wgid = (int)L; { const int q = nwg / NXCD, r = nwg % NXCD, xcd = wgid % NXCD, off = wgid / NXCD; wgid = (xcd < r ? xcd * (q + 1) : r * (q + 1) + (xcd - r) * q) + off; }
        const int nig = WGM * nN, gid = wgid / nig, fm = gid * WGM, gsz = (nM - fm) < WGM ? (nM - fm) : WGM;
        u.pm = fm + ((wgid % nig) % gsz); u.pn = (wgid % nig) / gsz; return true;
    }
    __device__ __forceinline__ void a_ready(const Unit&) const {}
    __device__ __forceinline__ void done(const Unit&) const {}
};


__device__ __forceinline__ unsigned cvt_pk_bf16(float lo, float hi) { unsigned r; asm volatile("v_cvt_pk_bf16_f32 %0, %1, %2" : "=v"(r) : "v"(lo), "v"(hi)); return r; }
struct EpiBf16S {
    static constexpr bool PERM = true, AFTER_DRAIN = false;
    bf16_t* O; const float* rowscale; int ldc; int rs_stride;
    __device__ __forceinline__ void operator()(const f32x4 (&acc)[2][2][4][2], const Unit& u, int wr, int wc, int fr, int fq) const {
        const int row0 = u.pm * BM + wr * 64 + fr, col0 = u.pn * BM + wc * 32 + 8 * fq;
#pragma unroll
        for (int ai = 0; ai < 2; ++ai)
#pragma unroll
            for (int m = 0; m < 4; ++m) { const int row = row0 + ai * HALF + m * 16; const float sc = rowscale ? rowscale[(size_t)row * rs_stride] : 1.f;
                bf16_t* rowp = O + (size_t)row * ldc + col0;
#pragma unroll
                for (int bj = 0; bj < 2; ++bj) { const f32x4 v0 = acc[ai][bj][m][0] * sc, v1 = acc[ai][bj][m][1] * sc;
                    u32x4 w; w.x = cvt_pk_bf16(v0[0], v0[1]); w.y = cvt_pk_bf16(v0[2], v0[3]); w.z = cvt_pk_bf16(v1[0], v1[1]); w.w = cvt_pk_bf16(v1[2], v1[3]);
                    *(u32x4*)(rowp + bj * HALF) = w; } }
    }
};
struct EpiResid {
    static constexpr bool PERM = false, AFTER_DRAIN = false;
    const float* hin; bf16_t* hout; float alpha; int pad;
    __device__ __forceinline__ void operator()(const f32x4 (&acc)[2][2][4][2], const Unit& u, int wr, int wc, int fr, int fq) const {
        typedef unsigned u32x2r __attribute__((ext_vector_type(2)));
        const int row0 = u.pm * BM + wr * 64 + fr, col0 = u.pn * BM + wc * 32 + 4 * fq;
#pragma unroll
        for (int ai = 0; ai < 2; ++ai)
#pragma unroll
            for (int m = 0; m < 4; ++m) { const size_t off = (size_t)(row0 + ai * HALF + m * 16) * 1024 + col0;
#pragma unroll
                for (int bj = 0; bj < 2; ++bj)
#pragma unroll
                    for (int n = 0; n < 2; ++n) { const size_t i = off + bj * HALF + n * 16; const f32x4 h = *(const f32x4*)(hin + i); const f32x4 o = h * alpha + acc[ai][bj][m][n];
                        u32x2r w; w.x = cvt_pk_bf16(o[0], o[1]); w.y = cvt_pk_bf16(o[2], o[3]); *(u32x2r*)(hout + i) = w; } }
    }
};

struct EpiResidLN {
    static constexpr bool PERM = false, AFTER_DRAIN = false;
    const bf16_t* hin; bf16_t* hout; const float* stats; const float* g; const float* b; float alpha; int pad;
    __device__ __forceinline__ void operator()(const f32x4 (&acc)[2][2][4][2], const Unit& u, int wr, int wc, int fr, int fq) const {
        typedef unsigned u32x2r __attribute__((ext_vector_type(2)));
        const int row0 = u.pm * BM + wr * 64 + fr, col0 = u.pn * BM + wc * 32 + 4 * fq;
        f32x4 gg[2][2], bb[2][2];
#pragma unroll
        for (int bj = 0; bj < 2; ++bj)
#pragma unroll
            for (int n = 0; n < 2; ++n) { gg[bj][n] = *(const f32x4*)(g + col0 + bj * HALF + n * 16) * alpha; bb[bj][n] = *(const f32x4*)(b + col0 + bj * HALF + n * 16) * alpha; }
#pragma unroll
        for (int ai = 0; ai < 2; ++ai)
#pragma unroll
            for (int m = 0; m < 4; ++m) { const int row = row0 + ai * HALF + m * 16; const size_t off = (size_t)row * 1024 + col0;
                const float mu = stats[2 * row], rs = stats[2 * row + 1];
#pragma unroll
                for (int bj = 0; bj < 2; ++bj)
#pragma unroll
                    for (int n = 0; n < 2; ++n) { const size_t i = off + bj * HALF + n * 16; const u32x2r pw = *(const u32x2r*)(hin + i);
                        f32x4 p; p[0] = __builtin_bit_cast(float, pw.x << 16); p[1] = __builtin_bit_cast(float, pw.x & 0xffff0000u); p[2] = __builtin_bit_cast(float, pw.y << 16); p[3] = __builtin_bit_cast(float, pw.y & 0xffff0000u);
                        const f32x4 o = (p - mu) * rs * gg[bj][n] + bb[bj][n] + acc[ai][bj][m][n];
                        u32x2r w; w.x = cvt_pk_bf16(o[0], o[1]); w.y = cvt_pk_bf16(o[2], o[3]); *(u32x2r*)(hout + i) = w; } }
    }
};

template <int CTRL> __device__ __forceinline__ float pg_dpp(float x) { return __builtin_bit_cast(float, __builtin_amdgcn_update_dpp(0, __builtin_bit_cast(int, x), CTRL, 0xF, 0xF, true)); }
struct EpiConvAct {
    static constexpr bool PERM = true, AFTER_DRAIN = false;
    bf16_t* act; const bf16_t* halo; const float* cw; const float* cb; int dff; int seq;
    template <int CTRL> static __device__ __forceinline__ float dpp_old(float old, float x) { return __builtin_bit_cast(float, __builtin_amdgcn_update_dpp(__builtin_bit_cast(int, old), __builtin_bit_cast(int, x), CTRL, 0xF, 0xF, false)); }
    __device__ __forceinline__ void operator()(const f32x4 (&acc)[2][2][4][2], const Unit& u, int wr, int wc, int fr, int fq) const {
        typedef unsigned u32x2e __attribute__((ext_vector_type(2)));
#pragma unroll
        for (int n = 0; n < 2; ++n) {
            const int ch0 = u.pn * 128 + wc * 32 + 8 * fq + 4 * n;
            const f32x4 w0 = *(const f32x4*)(cw + ch0), w1 = *(const f32x4*)(cw + dff + ch0), w2 = *(const f32x4*)(cw + 2 * dff + ch0), bb = *(const f32x4*)(cb + ch0);
#pragma unroll
            for (int ai = 0; ai < 2; ++ai) {
                const int rb64 = u.pm * BM + ai * HALF + wr * 64;
                f32x4 H2 = {0.f, 0.f, 0.f, 0.f}, H3 = {0.f, 0.f, 0.f, 0.f};
                if ((rb64 & (seq - 1)) != 0 && fr == 0) { const bf16_t* hp = halo + (size_t)(2 * (rb64 / 64 - 1)) * dff + ch0; const u32x2e h2 = *(const u32x2e*)hp, h3 = *(const u32x2e*)(hp + dff);
                    H2[0] = __builtin_bit_cast(float, h2.x << 16); H2[1] = __builtin_bit_cast(float, h2.x & 0xffff0000u); H2[2] = __builtin_bit_cast(float, h2.y << 16); H2[3] = __builtin_bit_cast(float, h2.y & 0xffff0000u);
                    H3[0] = __builtin_bit_cast(float, h3.x << 16); H3[1] = __builtin_bit_cast(float, h3.x & 0xffff0000u); H3[2] = __builtin_bit_cast(float, h3.y << 16); H3[3] = __builtin_bit_cast(float, h3.y & 0xffff0000u); }
                const f32x4 G0 = acc[ai][0][0][n], G1 = acc[ai][0][1][n], G2 = acc[ai][0][2][n], G3 = acc[ai][0][3][n];
                f32x4 S2, S3;
#pragma unroll
                for (int e = 0; e < 4; ++e) { S2[e] = dpp_old<0x111>(H2[e], G2[e]); S3[e] = dpp_old<0x111>(H3[e], G3[e]); }
#pragma unroll
                for (int m = 0; m < 4; ++m) {
                    const f32x4 Gv = acc[ai][0][m][n], Uv = acc[ai][1][m][n];
                    const f32x4 g1 = (m == 0) ? S3 : (m == 1) ? G0 : (m == 2) ? G1 : G2, g2 = (m == 0) ? S2 : (m == 1) ? S3 : (m == 2) ? G0 : G1;
                    typedef float f32x2e __attribute__((ext_vector_type(2)));
                    f32x2e oh[2];
#pragma unroll
                    for (int hq = 0; hq < 2; ++hq) {
                        const f32x2e g2p = hq ? g2.hi : g2.lo, g1p = hq ? g1.hi : g1.lo, Gp = hq ? Gv.hi : Gv.lo, Up = hq ? Uv.hi : Uv.lo;
                        const f32x2e w0p = hq ? w0.hi : w0.lo, w1p = hq ? w1.hi : w1.lo, w2p = hq ? w2.hi : w2.lo, bp = hq ? bb.hi : bb.lo;
                        const f32x2e y = __builtin_elementwise_fma(w0p, g2p, __builtin_elementwise_fma(w1p, g1p, __builtin_elementwise_fma(w2p, Gp, bp)));
                        const f32x2e t = y * -1.4426950408889634f;
                        f32x2e den; den.x = __builtin_amdgcn_exp2f(t.x); den.y = __builtin_amdgcn_exp2f(t.y); den = den + 1.f;
                        f32x2e r; r.x = __builtin_amdgcn_rcpf(den.x); r.y = __builtin_amdgcn_rcpf(den.y);
                        oh[hq] = y * r * Up;
                    }
                    u32x2e w; w.x = cvt_pk_bf16(oh[0].x, oh[0].y); w.y = cvt_pk_bf16(oh[1].x, oh[1].y);
                    *(u32x2e*)(act + (size_t)(rb64 + 4 * fr + m) * dff + ch0) = w;
                }
            }
        }
    }
};

template <class Epi, class Sched, bool ALIGN_EPI = false, bool SP2 = false>
__device__ __forceinline__ void gemm_phase(PG8_LAS unsigned char* lds, const Gemm g, const Sched& S, const Epi& E) {
    int tid = threadIdx.x; asm volatile("" : "+v"(tid));
    const int wid = __builtin_amdgcn_readfirstlane(tid >> 6), lane = tid & 63, wr = wid >> 2, wc = wid & 3, fr = lane & 15, fq = lane >> 4;
    const int K = g.K, nt = K / BK;
    unsigned voffA[2], voffB[2];
#pragma unroll
    for (int i = 0; i < 2; ++i) { int R, C; stage_rc(tid * 16 + i * 8192, R, C); const int Rb = Epi::PERM ? ((R & ~31) + perm32(R & 31)) : R;
        const int Ra = g.gatherA ? (64 * (R >> 1) + 62 + (R & 1)) : g.permA ? ((R & ~63) | ((R & 15) << 2) | ((R >> 4) & 3)) : R;
        voffA[i] = (unsigned)(Ra * g.lda + C) * 2u; voffB[i] = (unsigned)(Rb * g.ldb + C) * 2u; }
    const size_t kstep = (size_t)(BK * 2);
    const size_t hstepA = (size_t)g.hrA * g.lda * 2, hstepB = (size_t)g.hrB * g.ldb * 2;
    const size_t tstepA = (size_t)g.trA * g.lda * 2, tstepB = (size_t)g.trB * g.ldb * 2;
    const unsigned ldsw = (unsigned)wid * 1024u;
    const int aoff = lds_byte(wr * 64 + fr, fq * 8), boff = lds_byte(wc * 32 + fr, fq * 8);
#define PG8_SA(b, h) (((b) * 2 + (h)) * HTB)
#define PG8_SB(b, h) ((4 + (b) * 2 + (h)) * HTB)
#define PG8_STAGE(bufoff, gbase, voff) do { _Pragma("unroll") for (int _i = 0; _i < 2; ++_i) \
        __builtin_amdgcn_global_load_lds((const unsigned*)((const char*)(gbase) + (voff)[_i]), (PG8_LAS unsigned*)(lds + (bufoff) + ldsw + _i * 8192), 16, 0, 0); } while (0)
#define PG8_LDA(dst, b, h) do { _Pragma("unroll") for (int m = 0; m < 4; ++m) _Pragma("unroll") for (int k = 0; k < 2; ++k) dst[m][k] = *(const PG8_LAS bf16x8*)(lds + PG8_SA(b, h) + aoff + m * 2048 + k * 1024); } while (0)
#define PG8_LDB(dst, b, h) do { _Pragma("unroll") for (int n = 0; n < 2; ++n) _Pragma("unroll") for (int k = 0; k < 2; ++k) dst[n][k] = *(const PG8_LAS bf16x8*)(lds + PG8_SB(b, h) + boff + n * 2048 + k * 1024); } while (0)
#define PG8_MMA(ai, bj, At, Bt) do { __builtin_amdgcn_s_setprio(1); _Pragma("unroll") for (int m = 0; m < 4; ++m) _Pragma("unroll") for (int n = 0; n < 2; ++n) _Pragma("unroll") for (int k = 0; k < 2; ++k) \
        acc[ai][bj][m][n] = __builtin_amdgcn_mfma_f32_16x16x32_bf16(Bt[n][k], At[m][k], acc[ai][bj][m][n], 0, 0, 0); __builtin_amdgcn_s_setprio(0); } while (0)
#define PG8_WAIT_V(n) asm volatile("s_waitcnt vmcnt(" #n ")" ::: "memory")
#define PG8_WAIT_L(n) asm volatile("s_waitcnt lgkmcnt(" #n ")" ::: "memory")
#define PG8_BAR __builtin_amdgcn_s_barrier()
#define PG8_SCHED __builtin_amdgcn_sched_barrier(0)
    Unit cur, nxt; int ui = 0;
    if (!S.next(0, cur)) return;
    f32x4 acc[2][2][4][2];
#pragma unroll
    for (int a = 0; a < 2; ++a)
#pragma unroll
        for (int b = 0; b < 2; ++b)
#pragma unroll
            for (int m = 0; m < 4; ++m)
#pragma unroll
                for (int n = 0; n < 2; ++n) acc[a][b][m][n] = (f32x4){0.f, 0.f, 0.f, 0.f};
    bf16x8 At[4][2], B0[2][2], B1[2][2];
    const char* cA = (const char*)g.A + (size_t)cur.pm * tstepA; const char* cB = (const char*)g.Bt + (size_t)cur.pn * tstepB;
    S.a_ready(cur);
    if constexpr (SP2) {
        PG8_STAGE(PG8_SB(0, 0), cB, voffB); PG8_STAGE(PG8_SB(0, 1), cB + hstepB, voffB); PG8_STAGE(PG8_SA(0, 0), cA, voffA); PG8_STAGE(PG8_SA(0, 1), cA + hstepA, voffA);
        if (wr == 1) PG8_BAR;
        PG8_WAIT_V(2); PG8_BAR;
        PG8_STAGE(PG8_SB(1, 0), cB + kstep, voffB); PG8_STAGE(PG8_SA(1, 0), cA + kstep, voffA); PG8_STAGE(PG8_SB(1, 1), cB + hstepB + kstep, voffB);
        PG8_WAIT_V(6); PG8_BAR;
    } else {
        PG8_STAGE(PG8_SB(0, 0), cB, voffB); PG8_STAGE(PG8_SA(0, 0), cA, voffA); PG8_STAGE(PG8_SB(0, 1), cB + hstepB, voffB); PG8_STAGE(PG8_SA(0, 1), cA + hstepA, voffA);
        if (wr == 1) PG8_BAR;
        PG8_WAIT_V(4); PG8_BAR;
        PG8_STAGE(PG8_SB(1, 0), cB + kstep, voffB); PG8_STAGE(PG8_SA(1, 0), cA + kstep, voffA); PG8_STAGE(PG8_SB(1, 1), cB + hstepB + kstep, voffB);
        PG8_WAIT_V(6); PG8_BAR;
    }
    for (;;) {
        const bool has_next = S.next(ui + 1, nxt);
        const char* nA = has_next ? (const char*)g.A + (size_t)nxt.pm * tstepA : cA; const char* nB = has_next ? (const char*)g.Bt + (size_t)nxt.pn * tstepB : cB;
        for (int t = 0; t < nt; t += 2) {
            const bool last = (t == nt - 2);
            const char* a1 = cA + (size_t)(t + 1) * kstep;
            const char* a2 = last ? nA : cA + (size_t)(t + 2) * kstep; const char* b2 = last ? nB : cB + (size_t)(t + 2) * kstep;
            const char* a3 = a2 + kstep; const char* b3 = b2 + kstep;
            if (last && has_next) S.a_ready(nxt);
            if constexpr (SP2) {
            PG8_LDB(B0, 0, 0); PG8_LDB(B1, 0, 1); PG8_SCHED; PG8_LDA(At, 0, 0); PG8_STAGE(PG8_SA(1, 1), a1 + hstepA, voffA);
            PG8_WAIT_V(8); PG8_WAIT_L(0); PG8_BAR; PG8_MMA(0, 0, At, B0); PG8_MMA(0, 1, At, B1); PG8_BAR; PG8_SCHED;
            PG8_LDA(At, 0, 1); PG8_STAGE(PG8_SB(0, 0), b2, voffB); PG8_STAGE(PG8_SB(0, 1), b2 + hstepB, voffB); PG8_STAGE(PG8_SA(0, 0), a2, voffA);
            PG8_WAIT_V(8); PG8_WAIT_L(0); PG8_BAR; PG8_MMA(1, 0, At, B0); PG8_MMA(1, 1, At, B1); PG8_BAR; PG8_SCHED;
            PG8_LDB(B0, 1, 0); PG8_LDB(B1, 1, 1); PG8_SCHED; PG8_LDA(At, 1, 0); PG8_STAGE(PG8_SA(0, 1), a2 + hstepA, voffA);
            PG8_WAIT_V(8); PG8_WAIT_L(0); PG8_BAR; PG8_MMA(0, 0, At, B0); PG8_MMA(0, 1, At, B1); PG8_BAR; PG8_SCHED;
            PG8_LDA(At, 1, 1); PG8_STAGE(PG8_SB(1, 0), b3, voffB); PG8_STAGE(PG8_SB(1, 1), b3 + hstepB, voffB); PG8_STAGE(PG8_SA(1, 0), a3, voffA);
            PG8_WAIT_V(8); PG8_WAIT_L(0); PG8_BAR; PG8_MMA(1, 0, At, B0); PG8_MMA(1, 1, At, B1); PG8_BAR; PG8_SCHED;
            } else {
            PG8_LDB(B0, 0, 0); PG8_SCHED; PG8_LDA(At, 0, 0); PG8_STAGE(PG8_SA(1, 1), a1 + hstepA, voffA);
            PG8_WAIT_L(8); PG8_BAR; PG8_WAIT_L(0); PG8_MMA(0, 0, At, B0); PG8_BAR; PG8_SCHED;
            PG8_LDB(B1, 0, 1); PG8_STAGE(PG8_SB(0, 0), b2, voffB);
            PG8_BAR; PG8_WAIT_L(0); PG8_MMA(0, 1, At, B1); PG8_BAR;
            PG8_LDA(At, 0, 1); PG8_STAGE(PG8_SA(0, 0), a2, voffA);
            PG8_BAR; PG8_WAIT_L(0); PG8_MMA(1, 0, At, B0); PG8_BAR; PG8_SCHED;
            PG8_STAGE(PG8_SB(0, 1), b2 + hstepB, voffB);
            PG8_WAIT_V(6); PG8_BAR; PG8_MMA(1, 1, At, B1); PG8_BAR;
            PG8_LDB(B0, 1, 0); PG8_SCHED; PG8_LDA(At, 1, 0); PG8_STAGE(PG8_SA(0, 1), a2 + hstepA, voffA);
            PG8_WAIT_L(8); PG8_BAR; PG8_WAIT_L(0); PG8_MMA(0, 0, At, B0); PG8_BAR; PG8_SCHED;
            PG8_LDB(B1, 1, 1); PG8_STAGE(PG8_SB(1, 0), b3, voffB);
            PG8_BAR; PG8_WAIT_L(0); PG8_MMA(0, 1, At, B1); PG8_BAR;
            PG8_LDA(At, 1, 1); PG8_STAGE(PG8_SA(1, 0), a3, voffA);
            PG8_BAR; PG8_WAIT_L(0); PG8_MMA(1, 0, At, B0); PG8_BAR; PG8_SCHED;
            PG8_STAGE(PG8_SB(1, 1), b3 + hstepB, voffB);
            PG8_WAIT_V(6); PG8_BAR; PG8_MMA(1, 1, At, B1); PG8_BAR;
            }
        }
        if constexpr (ALIGN_EPI) { if (wr == 0) PG8_BAR; }
        if constexpr (!Epi::AFTER_DRAIN) { E(acc, cur, wr, wc, fr, fq); S.done(cur); }
        if (!has_next) break;
#pragma unroll
        for (int a = 0; a < 2; ++a)
#pragma unroll
            for (int b = 0; b < 2; ++b)
#pragma unroll
                for (int m = 0; m < 4; ++m)
#pragma unroll
                    for (int n = 0; n < 2; ++n) acc[a][b][m][n] = (f32x4){0.f, 0.f, 0.f, 0.f};
        cur = nxt; cA = nA; cB = nB; ++ui;
        if constexpr (ALIGN_EPI) { if (wr == 1) PG8_BAR; }
    }
    PG8_WAIT_V(0);
    if constexpr (!ALIGN_EPI) { if (wr == 0) PG8_BAR; }
    PG8_BAR;
    if constexpr (Epi::AFTER_DRAIN) { E.fused(acc, cur, wr, wc, fr, fq, lds, wid, lane); S.done(cur); }
#undef PG8_SA
#undef PG8_SB
#undef PG8_STAGE
#undef PG8_LDA
#undef PG8_LDB
#undef PG8_MMA
#undef PG8_WAIT_V
#undef PG8_WAIT_L
#undef PG8_BAR
#undef PG8_SCHED
}
}
#define GAS __attribute__((address_space(1)))
#define LAS __attribute__((address_space(3)))
typedef unsigned short bf16;
typedef unsigned v4u __attribute__((ext_vector_type(4)));
typedef float f32x4 __attribute__((ext_vector_type(4)));
typedef short bf16x8 __attribute__((ext_vector_type(8)));
typedef GAS unsigned gu32;
typedef GAS unsigned long long gu64;
#define RLX_AGENT __ATOMIC_RELAXED, __HIP_MEMORY_SCOPE_AGENT
#define LDS_WAIT() asm volatile("s_waitcnt lgkmcnt(0)" ::: "memory")
#define VM_WAIT() asm volatile("s_waitcnt vmcnt(0)" ::: "memory")
__device__ __forceinline__ unsigned long long rt() { return __builtin_amdgcn_s_memrealtime(); }
__device__ __forceinline__ unsigned f2bf(float f) { unsigned u = __builtin_bit_cast(unsigned, f); return (u + 0x7fffu + ((u >> 16) & 1u)) >> 16; }
__device__ __forceinline__ unsigned pk2(float lo, float hi) { return f2bf(lo) | (f2bf(hi) << 16); }

#define XB_TMO      128
#define XB_XCNT(j)  (256  + 64 * (j))
#define XB_XSUB(j)  (1280 + 64 * (j))
#define XB_XGEN(j)  (2304 + 64 * (j))
#define XB_TOP      3328
#define XB_TOPGEN   3392
#define XCD_BAR_WORDS 3456
#define XB_SPIN_CAP (1u << 18)

__device__ __forceinline__ unsigned xb_ld(unsigned* p)              { return __hip_atomic_load(p, __ATOMIC_RELAXED, __HIP_MEMORY_SCOPE_AGENT); }
__device__ __forceinline__ unsigned xb_add(unsigned* p, unsigned v) { return __hip_atomic_fetch_add(p, v, __ATOMIC_RELAXED, __HIP_MEMORY_SCOPE_AGENT); }
__device__ __forceinline__ unsigned xb_xcc_id() { return (unsigned)__builtin_amdgcn_s_getreg((3 << 11) | 20) & 0xFu; }
#define XB_SPIN(cond, bar) do { unsigned _sp = 0; while (cond) { __builtin_amdgcn_s_sleep(1); \
    if ((++_sp & 255u) == 0u) { if (xb_ld(&(bar)[XB_TMO])) break; if (_sp > XB_SPIN_CAP) { atomicAdd(&(bar)[XB_TMO], 1u); break; } } } } while (0)

struct XcdBarrier {
    unsigned* bar; unsigned x;
    volatile LAS unsigned* st;
};

__device__ __forceinline__ XcdBarrier xcd_barrier_post(unsigned* bar, volatile LAS unsigned* st) {
    XcdBarrier b; b.bar = bar; b.x = xb_xcc_id(); b.st = st;
    if (threadIdx.x == 0) (void)xb_add(&bar[XB_XCNT(b.x)], 1u);
    return b;
}
__device__ __forceinline__ void xcd_barrier_complete(unsigned* bar, unsigned x, unsigned& nloc, unsigned& nx) {
    const unsigned G = gridDim.x * gridDim.y * gridDim.z;
    unsigned sum, cnt, mine, sp = 0u;
    for (;;) {
        sum = 0u; cnt = 0u; mine = 0u;
#pragma unroll
        for (unsigned j = 0; j < 16; ++j) { const unsigned c = xb_ld(&bar[XB_XCNT(j)]); sum += c; cnt += (c > 0u) ? 1u : 0u; mine = (j == x) ? c : mine; }
        if (sum == G) break;
        __builtin_amdgcn_s_sleep(1);
        if ((++sp & 255u) == 0u) { if (xb_ld(&bar[XB_TMO])) break; if (sp > XB_SPIN_CAP) { atomicAdd(&bar[XB_TMO], 1u); break; } }
    }
    nloc = mine > 0u ? mine : 1u; nx = cnt > 0u ? cnt : 1u;
}

__device__ __forceinline__ void xcd_barrier(const XcdBarrier& b) {
    asm volatile("s_waitcnt vmcnt(0)" ::: "memory");
    __syncthreads();
    if (threadIdx.x == 0) {
        unsigned* bar = b.bar;
        __builtin_amdgcn_s_waitcnt(0);
        unsigned nloc = b.st[0], nx = b.st[1];
        if (nloc == 0u) { xcd_barrier_complete(bar, b.x, nloc, nx); b.st[0] = nloc; b.st[1] = nx; }
        const unsigned old = xb_add(&bar[XB_XSUB(b.x)], 1u);
        const unsigned gen = old / nloc;
        if (old + 1u == (gen + 1u) * nloc) {
            __builtin_amdgcn_fence(__ATOMIC_RELEASE, "agent");
            asm volatile("s_waitcnt vmcnt(0)" ::: "memory");
            const unsigned og = xb_add(&bar[XB_TOP], 1u);
            const unsigned tg = og / nx;
            if (og + 1u == (tg + 1u) * nx) xb_add(&bar[XB_TOPGEN], 1u);
            else XB_SPIN(xb_ld(&bar[XB_TOPGEN]) == tg, bar);
            __builtin_amdgcn_fence(__ATOMIC_ACQUIRE, "agent");
            xb_add(&bar[XB_XGEN(b.x)], 1u);
            asm volatile("s_waitcnt vmcnt(0)" ::: "memory");
        } else {
            XB_SPIN(xb_ld(&bar[XB_XGEN(b.x)]) == gen, bar);
            __builtin_amdgcn_fence(__ATOMIC_ACQUIRE, "agent");
            asm volatile("s_waitcnt vmcnt(0)" ::: "memory");
        }
    }
    __syncthreads();
}
constexpr int NWAVES = 8;
constexpr int BATCH = 16, SEQ = 2048, DM = 1024, M = BATCH * SEQ;
constexpr int L0P = 3584;
constexpr int L1P = 2048;
constexpr int DFF = 2816;
constexpr float ALPHA = 1.4142135623730951f;
typedef unsigned short bf16_t;
typedef float f32x16 __attribute__((ext_vector_type(16)));

constexpr size_t MiB = 1u << 20;
constexpr size_t WS_CTL = 0, CTL_ZERO_BYTES = 1 * MiB;
constexpr int CW_BAR = 4096;
constexpr size_t WS_W0IN = 2 * MiB, WS_W0OUT = 9 * MiB, WS_WUP0 = 11 * MiB, WS_WDN0 = 22 * MiB, WS_W1IN = 28 * MiB, WS_WUQ = 32 * MiB, WS_WUKV = 33 * MiB,
                 WS_W1OUT = 34 * MiB, WS_WUP1 = 36 * MiB, WS_WDN1 = 47 * MiB;
constexpr size_t WS_XB = 56 * MiB, WS_YMIX = 120 * MiB, WS_BIG = 184 * MiB;
constexpr size_t WS_G = 408 * MiB, WS_BONUS = 440 * MiB, WS_DT = 441 * MiB, WS_XST = 442 * MiB, WS_BT = 474 * MiB, WS_ASUM = 490 * MiB;
constexpr size_t WS_SLOC = 120 * MiB;
constexpr size_t WS_W2T = 53 * MiB, WS_A2T = 53 * MiB + 256 * 1024, WS_G2T = 53 * MiB + 512 * 1024;
constexpr size_t WS_GU = 120 * MiB;
constexpr size_t WS_PROJ1 = 184 * MiB, WS_QM = 312 * MiB, WS_KVM = 360 * MiB, WS_KPE = 424 * MiB, WS_RS = 426 * MiB;
constexpr size_t WS_CSTAB = 492 * MiB;
constexpr size_t WS_VTS = 428 * MiB, WS_VTM = 460 * MiB;
constexpr size_t WS_NEED = 497 * MiB;

constexpr int RING_BYTES = 131072;
constexpr int LDSCTL_OFF = 146432, MISC_OFF = LDSCTL_OFF + 320;
constexpr int LDS_BYTES = 147456;

__device__ __forceinline__ float bf2f(bf16_t b) { return __builtin_bit_cast(float, (unsigned)b << 16); }
__device__ __forceinline__ float sigmoidf_(float x) { return 1.f / (1.f + expf(-x)); }
__device__ __forceinline__ float softplusf_(float x) { return fmaxf(x, 0.f) + log1pf(expf(-fabsf(x))); }
__device__ __forceinline__ float siluf_(float x) { return x / (1.f + expf(-x)); }
__device__ __forceinline__ float wave_sum(float v) {
#pragma unroll
    for (int o = 1; o < 64; o <<= 1) v += __shfl_xor(v, o);
    return v;
}
#define WSYNC() asm volatile("s_waitcnt lgkmcnt(0)" ::: "memory")
typedef float f32x2_t __attribute__((ext_vector_type(2)));
typedef __bf16 bf16x2_t __attribute__((ext_vector_type(2)));
typedef unsigned u32x2 __attribute__((ext_vector_type(2)));
__device__ __forceinline__ unsigned cvtpk(float lo, float hi) { f32x2_t v = {lo, hi}; bf16x2_t b = __builtin_convertvector(v, bf16x2_t); return __builtin_bit_cast(unsigned, b); }
__device__ __forceinline__ float bflo(unsigned u) { return __builtin_bit_cast(float, u << 16); }
__device__ __forceinline__ float bfhi(unsigned u) { return __builtin_bit_cast(float, u & 0xffff0000u); }
__device__ __forceinline__ bf16_t bf1(float x) { return (bf16_t)(cvtpk(x, x) & 0xffffu); }
__device__ __forceinline__ bf16x8 pack8(float a0, float a1, float a2, float a3, float a4, float a5, float a6, float a7) {
    v4u w; w.x = cvtpk(a0, a1); w.y = cvtpk(a2, a3); w.z = cvtpk(a4, a5); w.w = cvtpk(a6, a7); return __builtin_bit_cast(bf16x8, w); }
template <int CTRL> __device__ __forceinline__ float dpp_mov(float x) { return __builtin_bit_cast(float, __builtin_amdgcn_update_dpp(0, __builtin_bit_cast(int, x), CTRL, 0xF, 0xF, true)); }
__device__ __forceinline__ float rowsum16(float x) { x += dpp_mov<0x128>(x); x += dpp_mov<0x124>(x); x += dpp_mov<0x122>(x); x += dpp_mov<0x121>(x); return x; }
__device__ __forceinline__ float rl(float x, int l) { return __builtin_bit_cast(float, __builtin_amdgcn_readlane(__builtin_bit_cast(int, x), l)); }
__device__ __forceinline__ float wave_sum_dpp(float x) { x = rowsum16(x); return (rl(x, 0) + rl(x, 16)) + (rl(x, 32) + rl(x, 48)); }

__device__ __forceinline__ void transpose_matrix(const float* __restrict__ W, int K, int N, bf16_t* __restrict__ WT, int Npad, int ldt, LAS float* scr, int gw, int NGW, int lane, const float* __restrict__ kscale, int& tr_base, bool ffn_interleave = false) {
    (void)scr;
    const int nblk = Npad / 64, nit = (K / 64) * nblk;
    int it0 = gw - (tr_base % NGW); if (it0 < 0) it0 += NGW; tr_base += nit;
    for (int it = it0; it < nit; it += NGW) {
        const int kb = it / nblk, nb = it - kb * nblk, n = nb * 64 + lane, k0 = kb * 64;
        const bool ok = n < N; const float* src = W + (size_t)k0 * N + (ok ? n : 0);
#pragma unroll
        for (int hc = 0; hc < 2; ++hc) {
            float v[32];
#pragma unroll
            for (int i = 0; i < 32; ++i) v[i] = src[(size_t)(hc * 32 + i) * N];
#pragma unroll
            for (int c = 0; c < 4; ++c) { float u[8];
#pragma unroll
                for (int i = 0; i < 8; ++i) { u[i] = ok ? v[c * 8 + i] : 0.f; if (kscale) u[i] *= kscale[k0 + hc * 32 + c * 8 + i]; }
                v4u o; o.x = cvtpk(u[0], u[1]); o.y = cvtpk(u[2], u[3]); o.z = cvtpk(u[4], u[5]); o.w = cvtpk(u[6], u[7]);
                const int nr = ffn_interleave ? ((n < DFF) ? 256 * (n >> 7) + (n & 127) : 256 * ((n - DFF) >> 7) + 128 + ((n - DFF) & 127)) : n;
                *(v4u*)(WT + (size_t)nr * ldt + k0 + hc * 32 + c * 8) = o; }
        }
    }
}

template <int MODE, int SEL = 0> __device__ __forceinline__ void ln_rows_range(const bf16_t* z, bf16_t* hb, float* outf, float* stats, const float* __restrict__ g, const float* __restrict__ b, int p0, int p1, int pstep, int lane) {
    auto rowof = [](int pi) { return SEL == 0 ? 2 * pi : SEL == 1 ? 64 * pi + 62 : 64 * (pi / 31) + 2 * (pi % 31); };
    pg8::u32x4 raw[2][2];
    if (p0 < p1) { const bf16_t* p = z + (size_t)rowof(p0) * DM;
#pragma unroll
        for (int r = 0; r < 2; ++r)
#pragma unroll
            for (int j = 0; j < 2; ++j) raw[r][j] = *(const pg8::u32x4*)(p + r * DM + 8 * lane + 512 * j); }
    for (int pi = p0; pi < p1; pi += pstep) {
        const int row = rowof(pi);
        f32x4 v[2][4]; float s[2] = {0.f, 0.f};
#pragma unroll
        for (int r = 0; r < 2; ++r)
#pragma unroll
            for (int j = 0; j < 2; ++j) {
                v[r][2 * j][0] = __builtin_bit_cast(float, raw[r][j].x << 16); v[r][2 * j][1] = __builtin_bit_cast(float, raw[r][j].x & 0xffff0000u);
                v[r][2 * j][2] = __builtin_bit_cast(float, raw[r][j].y << 16); v[r][2 * j][3] = __builtin_bit_cast(float, raw[r][j].y & 0xffff0000u);
                v[r][2 * j + 1][0] = __builtin_bit_cast(float, raw[r][j].z << 16); v[r][2 * j + 1][1] = __builtin_bit_cast(float, raw[r][j].z & 0xffff0000u);
                v[r][2 * j + 1][2] = __builtin_bit_cast(float, raw[r][j].w << 16); v[r][2 * j + 1][3] = __builtin_bit_cast(float, raw[r][j].w & 0xffff0000u); }
        { const int nxt = pi + pstep; const bf16_t* pn = z + (size_t)rowof(nxt < p1 ? nxt : pi) * DM;
#pragma unroll
          for (int r = 0; r < 2; ++r)
#pragma unroll
              for (int j = 0; j < 2; ++j) raw[r][j] = *(const pg8::u32x4*)(pn + r * DM + 8 * lane + 512 * j); }
#pragma unroll
        for (int r = 0; r < 2; ++r)
#pragma unroll
            for (int j = 0; j < 4; ++j) s[r] += (v[r][j][0] + v[r][j][1]) + (v[r][j][2] + v[r][j][3]);
        float mean[2], q[2] = {0.f, 0.f}, rstd[2];
#pragma unroll
        for (int r = 0; r < 2; ++r) { mean[r] = wave_sum_dpp(s[r]) * (1.f / DM);
#pragma unroll
            for (int j = 0; j < 4; ++j) { v[r][j] = v[r][j] - mean[r]; q[r] += (v[r][j][0] * v[r][j][0] + v[r][j][1] * v[r][j][1]) + (v[r][j][2] * v[r][j][2] + v[r][j][3] * v[r][j][3]); } }
#pragma unroll
        for (int r = 0; r < 2; ++r) rstd[r] = 1.0f / sqrtf(wave_sum_dpp(q[r]) * (1.f / DM) + 1e-5f);
        if (MODE == 1 && lane < 2) { stats[2 * (row + lane)] = lane ? mean[1] : mean[0]; stats[2 * (row + lane) + 1] = lane ? rstd[1] : rstd[0]; }
#pragma unroll
        for (int j = 0; j < 2; ++j) {
            const int c = 8 * lane + 512 * j;
            const f32x4 g0 = *(const f32x4*)(g + c), g1 = *(const f32x4*)(g + c + 4), b0 = *(const f32x4*)(b + c), b1 = *(const f32x4*)(b + c + 4);
#pragma unroll
            for (int r = 0; r < 2; ++r) {
                const f32x4 o0 = v[r][2 * j] * rstd[r] * g0 + b0, o1 = v[r][2 * j + 1] * rstd[r] * g1 + b1;
                if (MODE == 1) { pg8::u32x4 w; w.x = cvtpk(o0[0], o0[1]); w.y = cvtpk(o0[2], o0[3]); w.z = cvtpk(o1[0], o1[1]); w.w = cvtpk(o1[2], o1[3]); *(pg8::u32x4*)(hb + (size_t)(row + r) * DM + c) = w; }
                else { *(f32x4*)(outf + (size_t)(row + r) * DM + c) = o0; *(f32x4*)(outf + (size_t)(row + r) * DM + c + 4) = o1; }
            }
        }
    }
}

template <int MODE> __device__ __forceinline__ void ln_rows(const bf16_t* z, bf16_t* hb, float* outf, float* stats, const float* __restrict__ g, const float* __restrict__ b, int gw, int NGW, int lane) {
    ln_rows_range<MODE, 0>(z, hb, outf, stats, g, b, gw, M / 2, NGW, lane);
}
__device__ __forceinline__ void rwkv_naive_chain(int chain, int lane, LAS float* sm, const bf16_t* __restrict__ proj, const float* __restrict__ mix, const float* __restrict__ w0, const float* __restrict__ w2,
                                                 const float* __restrict__ a0, const float* __restrict__ a2, const float* __restrict__ g2, const float* __restrict__ k_k,
                                                 const float* __restrict__ k_a, const float* __restrict__ r_k, const float* __restrict__ ln_g, const float* __restrict__ ln_b, bf16_t* __restrict__ ymix) {
    LAS float* s_w2 = sm; LAS float* s_a2 = sm + 4096; LAS float* s_g2 = sm + 8192; LAS float* s_tw = sm + 16384; LAS float* s_al = s_tw + 64; LAS float* s_sg = s_tw + 128;
    LAS float* s_w = s_tw + 256; LAS float* s_k = s_tw + 320; LAS float* s_a = s_tw + 384; LAS float* s_b = s_tw + 448; LAS float* s_r = s_tw + 512;
    const int b = chain >> 3, h = chain & 7, c = h * 64 + lane;
    for (int l = 0; l < 64; ++l) { s_w2[l * 64 + lane] = w2[l * 512 + c]; s_a2[l * 64 + lane] = a2[l * 512 + c]; }
    for (int l = 0; l < 128; ++l) s_g2[l * 64 + lane] = g2[l * 512 + c];
    const float mr = mix[c], mk = mix[512 + c], mv = mix[1024 + c], mw = mix[1536 + lane], ma = mix[1600 + lane], mg0 = mix[1664 + lane], mg1 = mix[1728 + lane];
    const float w0c = w0[c], a0c = a0[c], kkc = k_k[c], kac = k_a[c], rkc = r_k[c], lgc = ln_g[c], lbc = ln_b[c];
    float S[64];
#pragma unroll
    for (int j = 0; j < 64; ++j) S[j] = 0.f;
    float pr = 0.f, pk = 0.f, pv = 0.f, pw = 0.f, pa = 0.f, pg0 = 0.f, pg1 = 0.f;
    WSYNC();
    for (int t = 0; t < SEQ; ++t) {
        const bf16_t* row = proj + (size_t)(b * SEQ + t) * L0P;
        const float cr = bf2f(row[c]), ck = bf2f(row[512 + c]), cv = bf2f(row[1024 + c]), cw = bf2f(row[1536 + lane]), ca = bf2f(row[1600 + lane]),
                    cg0 = bf2f(row[1664 + lane]), cg1 = bf2f(row[1728 + lane]);
        const float r_s = cr + (pr - cr) * mr, k_s = ck + (pk - ck) * mk, v_s = cv + (pv - cv) * mv;
        const float wl = cw + (pw - cw) * mw, al = ca + (pa - ca) * ma, g0 = cg0 + (pg0 - cg0) * mg0, g1 = cg1 + (pg1 - cg1) * mg1;
        pr = cr; pk = ck; pv = cv; pw = cw; pa = ca; pg0 = cg0; pg1 = cg1;
        s_tw[lane] = tanhf(wl); s_al[lane] = al; s_sg[lane] = sigmoidf_(g0); s_sg[64 + lane] = sigmoidf_(g1);
        WSYNC();
        float wsum = w0c, asum = a0c, gsum = 0.f;
#pragma unroll 2
        for (int l = 0; l < 64; ++l) { wsum += s_tw[l] * s_w2[l * 64 + lane]; asum += s_al[l] * s_a2[l * 64 + lane]; }
#pragma unroll 2
        for (int l = 0; l < 128; ++l) gsum += s_sg[l] * s_g2[l * 64 + lane];
        const float log_w = -softplusf_(-wsum) - 0.5f;
        const float dec = expf(-expf(log_w));
        const float a = sigmoidf_(asum);
        float kkv = k_s * kkc;
        const float nrm = sqrtf(wave_sum(kkv * kkv));
        kkv = kkv / fmaxf(nrm, 1e-12f);
        const float k2 = k_s * (1.f + (a - 1.f) * kac);
        const float bonus_s = wave_sum(r_s * k2 * rkc);
        s_w[lane] = dec; s_k[lane] = k2; s_a[lane] = -kkv; s_b[lane] = kkv * a; s_r[lane] = r_s;
        WSYNC();
        float sa = 0.f;
#pragma unroll
        for (int j = 0; j < 64; ++j) sa += S[j] * s_a[j];
        float y = 0.f;
#pragma unroll
        for (int j = 0; j < 64; ++j) { S[j] = S[j] * s_w[j] + sa * s_b[j] + v_s * s_k[j]; y += S[j] * s_r[j]; }
        const float mu = wave_sum(y) * (1.f / 64.f);
        const float d = y - mu;
        const float var = wave_sum(d * d) * (1.f / 64.f);
        const float yn = d * (1.0f / sqrtf(var + 64e-5f)) * lgc + lbc;
        const float o = (yn + bonus_s * v_s) * gsum;
        ymix[(size_t)(b * SEQ + t) * DM + c] = (bf16_t)f2bf(o);
        WSYNC();
    }
}

__device__ __forceinline__ void ssm_conv_all(const bf16_t* __restrict__ proj, const float* __restrict__ cw, const float* __restrict__ cb, const float* __restrict__ dtb,
                                             bf16_t* __restrict__ xbc, float* __restrict__ dt, int gtid, int NT) {
    for (size_t i = gtid; i < (size_t)M * 1024; i += NT) {
        const int m = (int)(i >> 10), c = (int)(i & 1023), t = m & (SEQ - 1);
        float acc = cb[c];
#pragma unroll
        for (int k = 0; k < 4; ++k) { const int tt = t - 3 + k; if (tt >= 0) acc += cw[k * 1024 + c] * bf2f(proj[(size_t)(m - 3 + k) * L0P + 2304 + c]); }
        xbc[i] = (bf16_t)f2bf(siluf_(acc));
    }
    for (int i = gtid; i < M * 8; i += NT) dt[i] = softplusf_(bf2f(proj[(size_t)(i >> 3) * L0P + 3328 + (i & 7)]) + dtb[i & 7]);
}
__device__ __forceinline__ void ssd_naive_task(int task, int lane, const bf16_t* __restrict__ xbc, const float* __restrict__ dt, const float* __restrict__ a_log, const float* __restrict__ dsk, float* __restrict__ yssm) {
    const int chain = task >> 2, q = task & 3, b = chain >> 3, h = chain & 7, g = h >> 2, p = q * 16 + (lane >> 2), nq = lane & 3;
    const float A = -expf(a_log[h]), D = dsk[h];
    float st[32];
#pragma unroll
    for (int n = 0; n < 32; ++n) st[n] = 0.f;
    for (int t = 0; t < SEQ; ++t) {
        const size_t m = (size_t)b * SEQ + t;
        const float dtv = dt[m * 8 + h], dA = expf(dtv * A);
        const float x = bf2f(xbc[m * 1024 + h * 64 + p]), xdt = x * dtv;
        const bf16_t* Bp = xbc + m * 1024 + 512 + g * 128 + nq * 32;
        const bf16_t* Cp = xbc + m * 1024 + 768 + g * 128 + nq * 32;
        float yp = 0.f;
#pragma unroll
        for (int n = 0; n < 32; ++n) { st[n] = st[n] * dA + xdt * bf2f(Bp[n]); yp += st[n] * bf2f(Cp[n]); }
        yp += __shfl_xor(yp, 1); yp += __shfl_xor(yp, 2);
        if (nq == 0) yssm[m * 512 + h * 64 + p] = yp + D * x;
    }
}
template <bool ST = true> __device__ __forceinline__ void ssm_gate_norm_all(const bf16_t* __restrict__ yssm, const bf16_t* __restrict__ proj, const float* __restrict__ ng, bf16_t* __restrict__ ymix, int wv0, int wvend, int lane) {
    for (int wvb = wv0 * 4 - (wv0 & ~7) * 3; wvb < wvend; wvb += NWAVES * 4) {
        float u[4][4], q[4];
#pragma unroll
        for (int k = 0; k < 4; ++k) { const int wv = wvb + k, m = wv >> 1, g = wv & 1; q[k] = 0.f;
#pragma unroll
            for (int j = 0; j < 4; ++j) { const int c = g * 256 + j * 64 + lane; const float z = bf2f(proj[(size_t)m * L0P + 1792 + c]); u[k][j] = bf2f(yssm[(size_t)m * 512 + c]) * (z * __builtin_amdgcn_rcpf(1.f + __expf(-z))); q[k] += u[k][j] * u[k][j]; } }
#pragma unroll
        for (int k = 0; k < 4; ++k) { const int wv = wvb + k, m = wv >> 1, g = wv & 1;
            const float rs = __builtin_amdgcn_rsqf(wave_sum_dpp(q[k]) * (1.f / 256.f) + 1e-5f);
#pragma unroll
            for (int j = 0; j < 4; ++j) { const int c = g * 256 + j * 64 + lane; const float o_ = u[k][j] * rs * ng[c]; if (ST) ymix[(size_t)m * DM + 512 + c] = bf1(o_); else asm volatile("" :: "v"(o_)); } }
    }
}
template <bool ST = true> __device__ __forceinline__ void ffn_act_all(bf16_t* gu, const float* __restrict__ cw, const float* __restrict__ cb, int gtid, int NT) {
    constexpr int NCH = DFF / 8, NSTRIP = M / 32;
    for (int task = gtid; task < NSTRIP * NCH; task += NT) {
        const int strip = task / NCH, q = task - strip * NCH, c0 = q * 8, m0 = strip * 32;
        float w0[8], w1[8], w2[8], bb[8], g2[8], g1[8];
#pragma unroll
        for (int j = 0; j < 8; j += 4) { const f32x4 a = *(const f32x4*)(cw + c0 + j), b = *(const f32x4*)(cw + DFF + c0 + j), c = *(const f32x4*)(cw + 2 * DFF + c0 + j), d = *(const f32x4*)(cb + c0 + j);
#pragma unroll
            for (int k = 0; k < 4; ++k) { w0[j + k] = a[k]; w1[j + k] = b[k]; w2[j + k] = c[k]; bb[j + k] = d[k]; } }
        bf16_t* base = gu + (size_t)m0 * (2 * DFF) + c0;
        if ((m0 & (SEQ - 1)) != 0) { const v4u a = *(const v4u*)(base - 2 * (2 * DFF)), b = *(const v4u*)(base - (2 * DFF));
            g2[0] = bflo(a.x); g2[1] = bfhi(a.x); g2[2] = bflo(a.y); g2[3] = bfhi(a.y); g2[4] = bflo(a.z); g2[5] = bfhi(a.z); g2[6] = bflo(a.w); g2[7] = bfhi(a.w);
            g1[0] = bflo(b.x); g1[1] = bfhi(b.x); g1[2] = bflo(b.y); g1[3] = bfhi(b.y); g1[4] = bflo(b.z); g1[5] = bfhi(b.z); g1[6] = bflo(b.w); g1[7] = bfhi(b.w); }
        else {
#pragma unroll
            for (int j = 0; j < 8; ++j) { g2[j] = 0.f; g1[j] = 0.f; } }
#pragma unroll 4
        for (int r = 0; r < 32; ++r) {
            const v4u gv = *(const v4u*)(base + (size_t)r * (2 * DFF)), uv = *(const v4u*)(base + (size_t)r * (2 * DFF) + DFF);
            const unsigned gw_[4] = {gv.x, gv.y, gv.z, gv.w}, uw_[4] = {uv.x, uv.y, uv.z, uv.w};
            unsigned ow[4];
#pragma unroll
            for (int k = 0; k < 4; ++k) {
                const float ga = bflo(gw_[k]), gb = bfhi(gw_[k]);
                const float ya = bb[2 * k] + w0[2 * k] * g2[2 * k] + w1[2 * k] * g1[2 * k] + w2[2 * k] * ga;
                const float yb = bb[2 * k + 1] + w0[2 * k + 1] * g2[2 * k + 1] + w1[2 * k + 1] * g1[2 * k + 1] + w2[2 * k + 1] * gb;
                g2[2 * k] = g1[2 * k]; g1[2 * k] = ga; g2[2 * k + 1] = g1[2 * k + 1]; g1[2 * k + 1] = gb;
                ow[k] = cvtpk(ya / (1.f + __expf(-ya)) * bflo(uw_[k]), yb / (1.f + __expf(-yb)) * bfhi(uw_[k]));
            }
            if (ST) *(v4u*)(base + (size_t)r * (2 * DFF) + DFF) = (v4u){ow[0], ow[1], ow[2], ow[3]}; else asm volatile("" :: "v"(ow[0]), "v"(ow[1]), "v"(ow[2]), "v"(ow[3]));
        }
    }
}
template <bool ST = true> __device__ __forceinline__ void mla_prep_all(const bf16_t* __restrict__ proj1, const int* __restrict__ pos, float* __restrict__ rs, bf16_t* __restrict__ kpe, float* __restrict__ cstab, int gw, int NGW, int lane) {
    const int fi = lane & 15, tk = lane >> 4;
    const double inv_rev = exp2(-(double)(2 * fi) * (13.287712379549449 / 32.0)) * 0.15915494309189535;
    for (int m4 = gw * 4; m4 < M; m4 += NGW * 4) {
        const int mt = m4 + tk;
        const bf16_t* row = proj1 + (size_t)mt * L1P;
        const v4u qa = *(const v4u*)(row + 1536 + 8 * fi), qb = *(const v4u*)(row + 1664 + 8 * fi), ka = *(const v4u*)(row + 1792 + 8 * fi);
        const float x1 = bf2f(row[1920 + fi]), x2 = bf2f(row[1936 + fi]);
        const double rev = (double)pos[mt] * inv_rev;
        const float fr = (float)(rev - floor(rev));
        const float cs = __builtin_amdgcn_cosf(fr), sn = __builtin_amdgcn_sinf(fr);
        cstab[(size_t)mt * 32 + fi] = cs; cstab[(size_t)mt * 32 + 16 + fi] = sn;
        kpe[(size_t)mt * 32 + fi] = bf1(x1 * cs - x2 * sn); kpe[(size_t)mt * 32 + 16 + fi] = bf1(x2 * cs + x1 * sn);
        float q = 0.f, k = 0.f;
#pragma unroll
        for (int e = 0; e < 4; ++e) { const float a0 = bflo(qa[e]), a1 = bfhi(qa[e]), b0 = bflo(qb[e]), b1 = bfhi(qb[e]), c0 = bflo(ka[e]), c1 = bfhi(ka[e]);
            q += (a0 * a0 + a1 * a1) + (b0 * b0 + b1 * b1); k += c0 * c0 + c1 * c1; }
        q = rowsum16(q); k = rowsum16(k);
        if (fi == 0) { rs[(size_t)mt * 2] = 1.0f / sqrtf(q * (1.f / 256.f) + 1e-6f); rs[(size_t)mt * 2 + 1] = 1.0f / sqrtf(k * (1.f / 128.f) + 1e-6f); }
    }
}
template <bool ST = true> __device__ __forceinline__ void rope_q_all(bf16_t* qm, const float* __restrict__ cstab, int gtid, int NT) {
    for (int i = gtid; i < M * 16; i += NT) {
        const int m = i >> 4, h = (i >> 1) & 7, k0 = (i & 1) * 8;
        bf16_t* p = qm + (size_t)m * 768 + h * 96 + 64 + k0;
        const v4u a = *(const v4u*)p, b = *(const v4u*)(p + 16);
        const f32x4 c0 = *(const f32x4*)(cstab + (size_t)m * 32 + k0), c1 = *(const f32x4*)(cstab + (size_t)m * 32 + k0 + 4), s0 = *(const f32x4*)(cstab + (size_t)m * 32 + 16 + k0), s1 = *(const f32x4*)(cstab + (size_t)m * 32 + 16 + k0 + 4);
        const unsigned au[4] = {a.x, a.y, a.z, a.w}, bu[4] = {b.x, b.y, b.z, b.w};
        const float cs[8] = {c0[0], c0[1], c0[2], c0[3], c1[0], c1[1], c1[2], c1[3]}, sn[8] = {s0[0], s0[1], s0[2], s0[3], s1[0], s1[1], s1[2], s1[3]};
        unsigned o1[4], o2[4];
#pragma unroll
        for (int q = 0; q < 4; ++q) { const float x1a = bflo(au[q]), x1b = bfhi(au[q]), x2a = bflo(bu[q]), x2b = bfhi(bu[q]);
            o1[q] = cvtpk(x1a * cs[2 * q] - x2a * sn[2 * q], x1b * cs[2 * q + 1] - x2b * sn[2 * q + 1]);
            o2[q] = cvtpk(x2a * cs[2 * q] + x1a * sn[2 * q], x2b * cs[2 * q + 1] + x1b * sn[2 * q + 1]); }
        if (ST) { *(v4u*)p = (v4u){o1[0], o1[1], o1[2], o1[3]}; *(v4u*)(p + 16) = (v4u){o2[0], o2[1], o2[2], o2[3]}; }
    }
}
__device__ __forceinline__ void sb_naive_task(int qblk, int bh, int lane, const bf16_t* __restrict__ proj1, bf16_t* __restrict__ ymix) {
    const int b = bh >> 3, h = bh & 7, t = qblk * 64 + lane;
    const size_t mrow = (size_t)b * SEQ;
    float q[64], o[64];
#pragma unroll
    for (int d = 0; d < 64; ++d) { q[d] = bf2f(proj1[(mrow + t) * L1P + h * 64 + d]) * 0.125f; o[d] = 0.f; }
    float cum = 0.f;
    const int smax = qblk * 64 + 63;
    for (int s = smax - 1; s >= 0; --s) {
        const bf16_t* kr = proj1 + (mrow + s) * L1P + 512 + h * 64;
        const bf16_t* vr = proj1 + (mrow + s) * L1P + 1024 + h * 64;
        float z = 0.f;
#pragma unroll
        for (int d = 0; d < 64; ++d) z += q[d] * bf2f(kr[d]);
        if (s < t) {
            const float lsp = -softplusf_(-z);
            const float lsn = -softplusf_(z);
            const float att = expf(lsp + cum);
            cum += lsn;
#pragma unroll
            for (int d = 0; d < 64; ++d) o[d] += att * bf2f(vr[d]);
        }
    }
#pragma unroll
    for (int d = 0; d < 64; ++d) ymix[(mrow + t) * DM + h * 64 + d] = (bf16_t)f2bf(o[d]);
}
__device__ __forceinline__ void mla_naive_task(int qblk, int bh, int lane, const bf16_t* __restrict__ qm, const bf16_t* __restrict__ kvm, const bf16_t* __restrict__ kpe, bf16_t* __restrict__ ymix) {
    const int b = bh >> 3, h = bh & 7, t = qblk * 64 + lane;
    const size_t mrow = (size_t)b * SEQ;
    const float scale = 0.10206207261596577f;
    float q[96], o[64];
#pragma unroll
    for (int d = 0; d < 96; ++d) q[d] = bf2f(qm[(mrow + t) * 768 + h * 96 + d]) * scale;
#pragma unroll
    for (int d = 0; d < 64; ++d) o[d] = 0.f;
    float mx = -1e30f, l = 0.f;
    const int smax = qblk * 64 + 63;
    for (int s = 0; s <= smax; ++s) {
        const bf16_t* kr = kvm + (mrow + s) * 1024 + h * 128;
        const bf16_t* pr = kpe + (mrow + s) * 32;
        float z = 0.f;
#pragma unroll
        for (int d = 0; d < 64; ++d) z += q[d] * bf2f(kr[d]);
#pragma unroll
        for (int d = 0; d < 32; ++d) z += q[64 + d] * bf2f(pr[d]);
        if (s <= t) {
            const float mn = fmaxf(mx, z), f = expf(mx - mn), pz = expf(z - mn);
            l = l * f + pz; mx = mn;
#pragma unroll
            for (int d = 0; d < 64; ++d) o[d] = o[d] * f + pz * bf2f(kr[64 + d]);
        }
    }
    const float il = 1.f / l;
#pragma unroll
    for (int d = 0; d < 64; ++d) ymix[(mrow + t) * DM + 512 + h * 64 + d] = (bf16_t)f2bf(o[d] * il);
}


__device__ __forceinline__ int crow(int r, int hi) { return (r & 3) + 8 * (r >> 2) + 4 * hi; }
#define MFMA32(a, b, c) __builtin_amdgcn_mfma_f32_32x32x16_bf16((a), (b), (c), 0, 0, 0)
constexpr int STG_PITCH = 72;
__device__ __forceinline__ void transpose_tile64(const bf16_t* __restrict__ src, int sp, bf16_t* __restrict__ dst, int dp, LAS bf16_t* scr, int lane) {
#pragma unroll
    for (int i = 0; i < 8; ++i) { const int row = i * 8 + (lane >> 3), ch = lane & 7; const v4u v = *(const v4u*)(src + (size_t)row * sp + ch * 8); *(LAS v4u*)(scr + row * STG_PITCH + ch * 8) = v; }
    WSYNC();
#pragma unroll
    for (int i = 0; i < 8; ++i) { const int d = i * 8 + (lane >> 3), tc = lane & 7; const LAS bf16_t* p = scr + (tc * 8) * STG_PITCH + d;
        v4u o; o.x = (unsigned)p[0] | ((unsigned)p[STG_PITCH] << 16); o.y = (unsigned)p[2 * STG_PITCH] | ((unsigned)p[3 * STG_PITCH] << 16);
        o.z = (unsigned)p[4 * STG_PITCH] | ((unsigned)p[5 * STG_PITCH] << 16); o.w = (unsigned)p[6 * STG_PITCH] | ((unsigned)p[7 * STG_PITCH] << 16);
        *(v4u*)(dst + (size_t)d * dp + tc * 8) = o; }
    WSYNC();
}
__device__ __forceinline__ void store_OT(const f32x16 (&o)[2], float sc, LAS bf16_t* stg, bf16_t* __restrict__ dst, int lane) {
    const int l31 = lane & 31, hi = lane >> 5;
#pragma unroll
    for (int dt = 0; dt < 2; ++dt)
#pragma unroll
        for (int r = 0; r < 16; ++r) stg[l31 * STG_PITCH + 32 * dt + crow(r, hi)] = bf1(o[dt][r] * sc);
    WSYNC();
#pragma unroll
    for (int i = 0; i < 4; ++i) { const int row = i * 8 + (lane >> 3), ch = lane & 7; const v4u v = *(const LAS v4u*)(stg + row * STG_PITCH + ch * 8); *(v4u*)(dst + (size_t)row * DM + ch * 8) = v; }
    WSYNC();
}
__device__ __forceinline__ float softplus_fast(float z) { return fmaxf(z, 0.f) + __logf(1.f + __expf(-fabsf(z))); }

__device__ __forceinline__ void sb_task(int bh, int qblk, int lane, const bf16_t* __restrict__ P1, const bf16_t* __restrict__ VT, bf16_t* __restrict__ ymix, LAS bf16_t* stg) {
    const int b = bh >> 3, h = bh & 7, l31 = lane & 31, hi = lane >> 5, q0 = qblk * 32, t = q0 + l31;
    const size_t rowb = (size_t)b * SEQ;
    const bf16_t* Qp = P1 + (rowb + q0 + l31) * L1P + h * 64 + 8 * hi;
    bf16x8 qf[4];
#pragma unroll
    for (int kk = 0; kk < 4; ++kk) qf[kk] = *(const bf16x8*)(Qp + 16 * kk);
    const bf16_t* Kp = P1 + (rowb + l31) * L1P + 512 + h * 64 + 8 * hi;
    const bf16_t* Vp = VT + ((size_t)bh * 64 + l31) * SEQ + 4 * hi;
    f32x16 o[2];
#pragma unroll
    for (int r = 0; r < 16; ++r) { o[0][r] = 0.f; o[1][r] = 0.f; }
    float cum = 0.f;
    bf16x8 kf[4]; u32x2 va[2][2][2];
#define SB_LOAD(S0, KF, VA) do { _Pragma("unroll") for (int kk = 0; kk < 4; ++kk) KF[kk] = *(const bf16x8*)(Kp + (size_t)(S0) * L1P + 16 * kk); \
        _Pragma("unroll") for (int dt = 0; dt < 2; ++dt) _Pragma("unroll") for (int ks = 0; ks < 2; ++ks) { VA[dt][ks][0] = *(const u32x2*)(Vp + (size_t)dt * 32 * SEQ + (S0) + 16 * ks); VA[dt][ks][1] = *(const u32x2*)(Vp + (size_t)dt * 32 * SEQ + (S0) + 16 * ks + 8); } } while (0)
    SB_LOAD(q0, kf, va);
    for (int s0 = q0; s0 >= 0; s0 -= 32) {
        bf16x8 kn[4]; u32x2 vn[2][2][2];
        const int sn = (s0 >= 32) ? s0 - 32 : 0;
        SB_LOAD(sn, kn, vn);
        f32x16 acc;
#pragma unroll
        for (int r = 0; r < 16; ++r) acc[r] = 0.f;
#pragma unroll
        for (int kk = 0; kk < 4; ++kk) acc = MFMA32(kf[kk], qf[kk], acc);
        const bool diag = (s0 == q0);
        float lb[16], lk[16];
#pragma unroll
        for (int r = 0; r < 16; ++r) { const float z = acc[r] * 0.125f; const float sp = softplus_fast(z); float b_ = z - sp, k_ = -sp;
            if (diag) { const bool valid = (s0 + crow(r, hi)) < t; b_ = valid ? b_ : -1e30f; k_ = valid ? k_ : 0.f; }
            lb[r] = b_; lk[r] = k_; }
        float e[16], T[4], U[4];
#pragma unroll
        for (int i = 0; i < 4; ++i) { e[4 * i + 3] = 0.f; e[4 * i + 2] = lk[4 * i + 3]; e[4 * i + 1] = e[4 * i + 2] + lk[4 * i + 2]; e[4 * i] = e[4 * i + 1] + lk[4 * i + 1]; T[i] = e[4 * i] + lk[4 * i]; }
#pragma unroll
        for (int i = 0; i < 4; ++i) U[i] = __shfl_xor(T[i], 32);
        float off[4];
        { const float st2 = T[3], st1 = st2 + T[2], st0 = st1 + T[1]; const float su2 = U[3], su1 = su2 + U[2], su0 = su1 + U[1];
          const float x0 = hi ? 0.f : U[0], x1 = hi ? 0.f : U[1], x2 = hi ? 0.f : U[2], x3 = hi ? 0.f : U[3];
          off[3] = x3; off[2] = st2 + su2 + x2; off[1] = st1 + su1 + x1; off[0] = st0 + su0 + x0;
          const float total = st0 + T[0] + su0 + U[0];
#pragma unroll
          for (int r = 0; r < 16; ++r) acc[r] = __expf(lb[r] + (cum + off[r >> 2] + e[r]));
          cum += total; }
        bf16x8 pf[2];
#pragma unroll
        for (int ks = 0; ks < 2; ++ks) { v4u w; w.x = cvtpk(acc[8 * ks], acc[8 * ks + 1]); w.y = cvtpk(acc[8 * ks + 2], acc[8 * ks + 3]); w.z = cvtpk(acc[8 * ks + 4], acc[8 * ks + 5]); w.w = cvtpk(acc[8 * ks + 6], acc[8 * ks + 7]); pf[ks] = __builtin_bit_cast(bf16x8, w); }
#pragma unroll
        for (int dt = 0; dt < 2; ++dt)
#pragma unroll
            for (int ks = 0; ks < 2; ++ks) { v4u a; a.x = va[dt][ks][0].x; a.y = va[dt][ks][0].y; a.z = va[dt][ks][1].x; a.w = va[dt][ks][1].y; o[dt] = MFMA32(__builtin_bit_cast(bf16x8, a), pf[ks], o[dt]); }
        if (__all(cum < -110.f)) break;
#pragma unroll
        for (int kk = 0; kk < 4; ++kk) kf[kk] = kn[kk];
#pragma unroll
        for (int dt = 0; dt < 2; ++dt)
#pragma unroll
            for (int ks = 0; ks < 2; ++ks) { va[dt][ks][0] = vn[dt][ks][0]; va[dt][ks][1] = vn[dt][ks][1]; }
    }
#undef SB_LOAD
    store_OT(o, 1.0f, stg, ymix + (rowb + q0) * DM + h * 64, lane);
}
__device__ __forceinline__ void mla_task(int bh, int qblk, int lane, const bf16_t* __restrict__ QM, const bf16_t* __restrict__ KVM, const bf16_t* __restrict__ KPE, const bf16_t* __restrict__ VT,
                                         bf16_t* __restrict__ ymix, LAS bf16_t* stg) {
    const int b = bh >> 3, h = bh & 7, l31 = lane & 31, hi = lane >> 5, q0 = qblk * 32, t = q0 + l31;
    const size_t rowb = (size_t)b * SEQ;
    const bf16_t* Qp = QM + (rowb + q0 + l31) * 768 + h * 96 + 8 * hi;
    bf16x8 qf[6];
#pragma unroll
    for (int kk = 0; kk < 6; ++kk) qf[kk] = *(const bf16x8*)(Qp + 16 * kk);
    const bf16_t* Kn = KVM + (rowb + l31) * 1024 + h * 128 + 8 * hi;
    const bf16_t* Kr = KPE + (rowb + l31) * 32 + 8 * hi;
    const bf16_t* Vp = VT + ((size_t)bh * 64 + l31) * SEQ + 4 * hi;
    const float sc2 = 0.10206207261596577f * 1.4426950408889634f;
    f32x16 o[2];
#pragma unroll
    for (int r = 0; r < 16; ++r) { o[0][r] = 0.f; o[1][r] = 0.f; }
    float mrun = -1e30f, lsum = 0.f;
    bf16x8 kf[6]; u32x2 va[2][2][2];
#define ML_LOAD(S0, KF, VA) do { _Pragma("unroll") for (int kk = 0; kk < 4; ++kk) KF[kk] = *(const bf16x8*)(Kn + (size_t)(S0) * 1024 + 16 * kk); \
        _Pragma("unroll") for (int kk = 0; kk < 2; ++kk) KF[4 + kk] = *(const bf16x8*)(Kr + (size_t)(S0) * 32 + 16 * kk); \
        _Pragma("unroll") for (int dt = 0; dt < 2; ++dt) _Pragma("unroll") for (int ks = 0; ks < 2; ++ks) { VA[dt][ks][0] = *(const u32x2*)(Vp + (size_t)dt * 32 * SEQ + (S0) + 16 * ks); VA[dt][ks][1] = *(const u32x2*)(Vp + (size_t)dt * 32 * SEQ + (S0) + 16 * ks + 8); } } while (0)
    ML_LOAD(0, kf, va);
    for (int s0 = 0; s0 <= q0; s0 += 32) {
        bf16x8 kn[6]; u32x2 vn[2][2][2];
        const int sn = (s0 + 32 <= q0) ? s0 + 32 : s0;
        ML_LOAD(sn, kn, vn);
        f32x16 acc;
#pragma unroll
        for (int r = 0; r < 16; ++r) acc[r] = 0.f;
#pragma unroll
        for (int kk = 0; kk < 6; ++kk) acc = MFMA32(kf[kk], qf[kk], acc);
        const bool diag = (s0 == q0);
        float tmax = -1e30f;
#pragma unroll
        for (int r = 0; r < 16; ++r) { float z = acc[r] * sc2; if (diag && (s0 + crow(r, hi)) > t) z = -1e30f; acc[r] = z; tmax = fmaxf(tmax, z); }
        tmax = fmaxf(tmax, __shfl_xor(tmax, 32));
        const float mn = fmaxf(mrun, tmax), alpha = exp2f(mrun - mn); mrun = mn;
        float ps = 0.f;
#pragma unroll
        for (int r = 0; r < 16; ++r) { acc[r] = exp2f(acc[r] - mn); ps += acc[r]; }
        lsum = lsum * alpha + ps;
#pragma unroll
        for (int r = 0; r < 16; ++r) { o[0][r] *= alpha; o[1][r] *= alpha; }
        bf16x8 pf[2];
#pragma unroll
        for (int ks = 0; ks < 2; ++ks) { v4u w; w.x = cvtpk(acc[8 * ks], acc[8 * ks + 1]); w.y = cvtpk(acc[8 * ks + 2], acc[8 * ks + 3]); w.z = cvtpk(acc[8 * ks + 4], acc[8 * ks + 5]); w.w = cvtpk(acc[8 * ks + 6], acc[8 * ks + 7]); pf[ks] = __builtin_bit_cast(bf16x8, w); }
#pragma unroll
        for (int dt = 0; dt < 2; ++dt)
#pragma unroll
            for (int ks = 0; ks < 2; ++ks) { v4u a; a.x = va[dt][ks][0].x; a.y = va[dt][ks][0].y; a.z = va[dt][ks][1].x; a.w = va[dt][ks][1].y; o[dt] = MFMA32(__builtin_bit_cast(bf16x8, a), pf[ks], o[dt]); }
#pragma unroll
        for (int kk = 0; kk < 6; ++kk) kf[kk] = kn[kk];
#pragma unroll
        for (int dt = 0; dt < 2; ++dt)
#pragma unroll
            for (int ks = 0; ks < 2; ++ks) { va[dt][ks][0] = vn[dt][ks][0]; va[dt][ks][1] = vn[dt][ks][1]; }
    }
#undef ML_LOAD
    lsum += __shfl_xor(lsum, 32);
    store_OT(o, 1.0f / lsum, stg, ymix + (rowb + q0) * DM + 512 + h * 64, lane);
}


__device__ __forceinline__ void sb_wave(int bh, int qblk, int lane, const bf16_t* __restrict__ P1, const bf16_t* __restrict__ VT, bf16_t* __restrict__ ymix, LAS unsigned char* wl) {
    const int b = bh >> 3, h = bh & 7, l31 = lane & 31, hi = lane >> 5, q0 = qblk * 32, t = q0 + l31;
    const size_t rowb = (size_t)b * SEQ;
    bf16x8 qf[4];
    { const bf16_t* Qp = P1 + (rowb + q0 + l31) * L1P + h * 64 + 8 * hi;
#pragma unroll
      for (int kk = 0; kk < 4; ++kk) qf[kk] = *(const bf16x8*)(Qp + 16 * kk); }
    f32x16 o[2];
#pragma unroll
    for (int r = 0; r < 16; ++r) { o[0][r] = 0.f; o[1][r] = 0.f; }
    float cum = 1.f;
    const bf16_t* gK = P1 + (rowb + (lane >> 3)) * L1P + 512 + h * 64 + (lane & 7) * 8;
    const bf16_t* gV = VT + ((size_t)bh * 64 + (lane >> 2)) * SEQ + (lane & 3) * 8;
    const int lK = (lane >> 3) * 144 + (lane & 7) * 16, lV = 4608 + (lane >> 2) * 72 + (lane & 3) * 16;
    v4u rk[4], rv[4];
#pragma unroll
    for (int i = 0; i < 4; ++i) { rk[i] = *(const v4u*)(gK + (size_t)(q0 + 8 * i) * L1P); rv[i] = *(const v4u*)(gV + (size_t)(16 * i) * SEQ + q0); }
#pragma unroll 1
    for (int s0 = q0; s0 >= 0; s0 -= 32) {
#pragma unroll
        for (int i = 0; i < 4; ++i) { *(LAS v4u*)(wl + lK + i * 8 * 144) = rk[i]; *(LAS u32x2*)(wl + lV + i * 16 * 72) = (u32x2){rv[i].x, rv[i].y}; *(LAS u32x2*)(wl + lV + i * 16 * 72 + 8) = (u32x2){rv[i].z, rv[i].w}; }
        { const int sn = (s0 >= 32) ? s0 - 32 : 0;
#pragma unroll
          for (int i = 0; i < 4; ++i) { rk[i] = *(const v4u*)(gK + (size_t)(sn + 8 * i) * L1P); rv[i] = *(const v4u*)(gV + (size_t)(16 * i) * SEQ + sn); } }
        WSYNC();
        f32x16 acc;
#pragma unroll
        for (int r = 0; r < 16; ++r) acc[r] = 0.f;
#pragma unroll
        for (int kk = 0; kk < 4; ++kk) { const bf16x8 kf = *(const LAS bf16x8*)(wl + l31 * 144 + (16 * kk + 8 * hi) * 2); acc = MFMA32(kf, qf[kk], acc); }
        const bool diag = (s0 == q0);
        float bt[16], kp[16];
#pragma unroll
        for (int r = 0; r < 16; ++r) { const float ee = __builtin_amdgcn_exp2f(fminf(acc[r] * (-0.125f * 1.4426950408889634f), 100.f)); const float ri = __builtin_amdgcn_rcpf(1.f + ee);
            float b_ = ri, k_ = ee * ri;
            if (diag) { const bool valid = (s0 + crow(r, hi)) < t; b_ = valid ? b_ : 0.f; k_ = valid ? k_ : 1.f; }
            bt[r] = b_; kp[r] = k_; }
        float e[16], T[4], U[4];
#pragma unroll
        for (int q = 0; q < 4; ++q) { e[4 * q + 3] = 1.f; e[4 * q + 2] = kp[4 * q + 3]; e[4 * q + 1] = e[4 * q + 2] * kp[4 * q + 2]; e[4 * q] = e[4 * q + 1] * kp[4 * q + 1]; T[q] = e[4 * q] * kp[4 * q]; }
#pragma unroll
        for (int q = 0; q < 4; ++q) U[q] = __shfl_xor(T[q], 32);
        { const float st2 = T[3], st1 = st2 * T[2], st0 = st1 * T[1]; const float su2 = U[3], su1 = su2 * U[2], su0 = su1 * U[1];
          const float x0 = hi ? 1.f : U[0], x1 = hi ? 1.f : U[1], x2 = hi ? 1.f : U[2], x3 = hi ? 1.f : U[3];
          const float off[4] = {cum * (st0 * su0 * x0), cum * (st1 * su1 * x1), cum * (st2 * su2 * x2), cum * x3};
#pragma unroll
          for (int r = 0; r < 16; ++r) acc[r] = bt[r] * (off[r >> 2] * e[r]);
          cum *= (st0 * T[0]) * (su0 * U[0]); }
        bf16x8 pf[2];
#pragma unroll
        for (int ks = 0; ks < 2; ++ks) pf[ks] = pack8(acc[8 * ks], acc[8 * ks + 1], acc[8 * ks + 2], acc[8 * ks + 3], acc[8 * ks + 4], acc[8 * ks + 5], acc[8 * ks + 6], acc[8 * ks + 7]);
#pragma unroll
        for (int dt = 0; dt < 2; ++dt)
#pragma unroll
            for (int ks = 0; ks < 2; ++ks) { const LAS unsigned char* vp = wl + 4608 + (32 * dt + l31) * 72 + (16 * ks + 4 * hi) * 2;
                const u32x2 x0 = *(const LAS u32x2*)vp, x1 = *(const LAS u32x2*)(vp + 16);
                v4u a; a.x = x0.x; a.y = x0.y; a.z = x1.x; a.w = x1.y; o[dt] = MFMA32(__builtin_bit_cast(bf16x8, a), pf[ks], o[dt]); }
        WSYNC();
        if (__all(cum < 1e-35f)) break;
    }
    store_OT(o, 1.0f, (LAS bf16_t*)(wl + 9216), ymix + (rowb + q0) * DM + h * 64, lane);
}

constexpr int MLK_PITCH = 104, MLV_PITCH = 68, MLK_BYTES = 64 * MLK_PITCH * 2, MLV_BYTES = 64 * MLV_PITCH * 2, ML_STAGE = MLK_BYTES + MLV_BYTES;
__device__ __forceinline__ void mla_block(int bh, int sb, int tid, int lane, int wave, LAS unsigned char* lds, const bf16_t* __restrict__ QM, const bf16_t* __restrict__ KVM, const bf16_t* __restrict__ KPE,
                                          const bf16_t* __restrict__ VT, bf16_t* __restrict__ ymix, const float* __restrict__ cstab) {
    const int b = bh >> 3, h = bh & 7, l31 = lane & 31, hi = lane >> 5, q0 = 256 * sb + 32 * wave, t = q0 + l31;
    const size_t rowb = (size_t)b * SEQ;
    const int nsteps = 4 * sb + 4;
    bf16x8 qf[6];
    { const bf16_t* Qp = QM + (rowb + q0 + l31) * 768 + h * 96 + 8 * hi;
#pragma unroll
      for (int kk = 0; kk < 6; ++kk) qf[kk] = *(const bf16x8*)(Qp + 16 * kk);
      const float* ct = cstab + (rowb + q0 + l31) * 32 + 8 * hi;
      const f32x4 c0 = *(const f32x4*)ct, c1 = *(const f32x4*)(ct + 4), s0 = *(const f32x4*)(ct + 16), s1 = *(const f32x4*)(ct + 20);
#pragma unroll
      for (int j = 0; j < 8; ++j) { const float cs = j < 4 ? c0[j & 3] : c1[j & 3], sn = j < 4 ? s0[j & 3] : s1[j & 3];
          const float x1 = bf2f((bf16_t)qf[4][j]), x2 = bf2f((bf16_t)qf[5][j]);
          qf[4][j] = (short)bf1(x1 * cs - x2 * sn); qf[5][j] = (short)bf1(x2 * cs + x1 * sn); } }
    const float sc2 = 0.10206207261596577f * 1.4426950408889634f;
    f32x16 o[2];
#pragma unroll
    for (int r = 0; r < 16; ++r) { o[0][r] = 0.f; o[1][r] = 0.f; }
    float mrun = -1e30f, lsum = 0.f;
    const bf16_t* gKn = KVM + (rowb + (tid >> 3)) * 1024 + h * 128 + (tid & 7) * 8;
    const bf16_t* gKr = KPE + (rowb + ((tid & 255) >> 2)) * 32 + (tid & 3) * 8;
    const bf16_t* gVt = VT + ((size_t)bh * 64 + (tid >> 3)) * SEQ + (tid & 7) * 8;
    const int lKn = (tid >> 3) * (MLK_PITCH * 2) + (tid & 7) * 16, lKr = ((tid & 255) >> 2) * (MLK_PITCH * 2) + 128 + (tid & 3) * 16, lVt = MLK_BYTES + (tid >> 3) * (MLV_PITCH * 2) + (tid & 7) * 16;
    v4u rk, rr, rv;
    rk = *(const v4u*)gKn; rr = *(const v4u*)gKr; rv = *(const v4u*)gVt;
    *(LAS v4u*)(lds + lKn) = rk; if (tid < 256) *(LAS v4u*)(lds + lKr) = rr; *(LAS u32x2*)(lds + lVt) = (u32x2){rv.x, rv.y}; *(LAS u32x2*)(lds + lVt + 8) = (u32x2){rv.z, rv.w};
    __syncthreads();
#pragma unroll 1
    for (int step = 0; step < nsteps; ++step) {
        const int nx = (step + 1 < nsteps) ? step + 1 : step;
        rk = *(const v4u*)(gKn + (size_t)nx * 64 * 1024); rr = *(const v4u*)(gKr + (size_t)nx * 64 * 32); rv = *(const v4u*)(gVt + nx * 64);
        const LAS unsigned char* Kb = lds + (step & 1) * ML_STAGE;
        const LAS unsigned char* Vb = Kb + MLK_BYTES;
        if (64 * step <= q0) {
            f32x16 acc[2];
            {
                bf16x8 kf[2][6];
#pragma unroll
                for (int sub = 0; sub < 2; ++sub)
#pragma unroll
                    for (int kk = 0; kk < 6; ++kk) kf[sub][kk] = *(const LAS bf16x8*)(Kb + (32 * sub + l31) * (MLK_PITCH * 2) + (16 * kk + 8 * hi) * 2);
                __builtin_amdgcn_sched_barrier(0);
#pragma unroll
                for (int r = 0; r < 16; ++r) { acc[0][r] = 0.f; acc[1][r] = 0.f; }
#pragma unroll
                for (int kk = 0; kk < 6; ++kk) { acc[0] = MFMA32(kf[0][kk], qf[kk], acc[0]); acc[1] = MFMA32(kf[1][kk], qf[kk], acc[1]); }
            }
            u32x2 vx[2][2][2][2];
#pragma unroll
            for (int sub = 0; sub < 2; ++sub)
#pragma unroll
                for (int dt = 0; dt < 2; ++dt)
#pragma unroll
                    for (int ks = 0; ks < 2; ++ks) { const LAS unsigned char* vp = Vb + (32 * dt + l31) * (MLV_PITCH * 2) + (32 * sub + 16 * ks + 4 * hi) * 2;
                        vx[sub][dt][ks][0] = *(const LAS u32x2*)vp; vx[sub][dt][ks][1] = *(const LAS u32x2*)(vp + 16); }
            __builtin_amdgcn_sched_barrier(0);
            float tmax = -1e30f;
#pragma unroll
            for (int sub = 0; sub < 2; ++sub) { const int s0 = 64 * step + 32 * sub;
                if (s0 + 31 > q0) {
#pragma unroll
                    for (int r = 0; r < 16; ++r) if ((s0 + crow(r, hi)) > t) acc[sub][r] = -1e30f; }
#pragma unroll
                for (int r = 0; r < 16; ++r) tmax = fmaxf(tmax, acc[sub][r]); }
            tmax = fmaxf(tmax, __shfl_xor(tmax, 32)) * sc2;
            if (__any(tmax - mrun > 6.f)) {
                const float mn = fmaxf(mrun, tmax), alpha = __builtin_amdgcn_exp2f(mrun - mn); mrun = mn; lsum *= alpha;
#pragma unroll
                for (int r = 0; r < 16; ++r) { o[0][r] *= alpha; o[1][r] *= alpha; }
            }
            float ps = 0.f;
#pragma unroll
            for (int sub = 0; sub < 2; ++sub)
#pragma unroll
                for (int r = 0; r < 16; ++r) { acc[sub][r] = __builtin_amdgcn_exp2f(acc[sub][r] * sc2 - mrun); ps += acc[sub][r]; }
            lsum += ps;
#pragma unroll
            for (int sub = 0; sub < 2; ++sub) {
                bf16x8 pf[2];
#pragma unroll
                for (int ks = 0; ks < 2; ++ks) pf[ks] = pack8(acc[sub][8 * ks], acc[sub][8 * ks + 1], acc[sub][8 * ks + 2], acc[sub][8 * ks + 3], acc[sub][8 * ks + 4], acc[sub][8 * ks + 5], acc[sub][8 * ks + 6], acc[sub][8 * ks + 7]);
#pragma unroll
                for (int ks = 0; ks < 2; ++ks)
#pragma unroll
                    for (int dt = 0; dt < 2; ++dt) { v4u a; a.x = vx[sub][dt][ks][0].x; a.y = vx[sub][dt][ks][0].y; a.z = vx[sub][dt][ks][1].x; a.w = vx[sub][dt][ks][1].y;
                        o[dt] = MFMA32(__builtin_bit_cast(bf16x8, a), pf[ks], o[dt]); }
            }
        }
        LAS unsigned char* nb = lds + ((step + 1) & 1) * ML_STAGE;
        *(LAS v4u*)(nb + lKn) = rk; if (tid < 256) *(LAS v4u*)(nb + lKr) = rr; *(LAS u32x2*)(nb + lVt) = (u32x2){rv.x, rv.y}; *(LAS u32x2*)(nb + lVt + 8) = (u32x2){rv.z, rv.w};
        __syncthreads();
    }
    lsum += __shfl_xor(lsum, 32);
    store_OT(o, 1.0f / lsum, (LAS bf16_t*)(lds + 2 * ML_STAGE) + wave * (32 * STG_PITCH), ymix + (rowb + q0) * DM + 512 + h * 64, lane);
    __syncthreads();
}


constexpr int SBK_PITCH = 72, SBK_BYTES = 64 * SBK_PITCH * 2, SB_STAGE = SBK_BYTES + MLV_BYTES;
__device__ __forceinline__ void sb_block(int bh, int sb, int tid, int lane, int wave, LAS unsigned char* lds, const bf16_t* __restrict__ P1, const bf16_t* __restrict__ VT, bf16_t* __restrict__ ymix) {
    const int b = bh >> 3, h = bh & 7, l31 = lane & 31, hi = lane >> 5, q0 = 256 * sb + 32 * wave, t = q0 + l31;
    const size_t rowb = (size_t)b * SEQ;
    bf16x8 qf[4];
    { const bf16_t* Qp = P1 + (rowb + q0 + l31) * L1P + h * 64 + 8 * hi;
#pragma unroll
      for (int kk = 0; kk < 4; ++kk) qf[kk] = *(const bf16x8*)(Qp + 16 * kk); }
    f32x16 o[2];
#pragma unroll
    for (int r = 0; r < 16; ++r) { o[0][r] = 0.f; o[1][r] = 0.f; }
    float cum = 1.f; bool done = false;
    volatile LAS unsigned* flags = (volatile LAS unsigned*)(lds + 2 * SB_STAGE);
    const bf16_t* gK = P1 + (rowb + (tid >> 3)) * L1P + 512 + h * 64 + (tid & 7) * 8;
    const bf16_t* gVt = VT + ((size_t)bh * 64 + (tid >> 3)) * SEQ + (tid & 7) * 8;
    const int lK = (tid >> 3) * (SBK_PITCH * 2) + (tid & 7) * 16, lVt = SBK_BYTES + (tid >> 3) * (MLV_PITCH * 2) + (tid & 7) * 16;
    const int top = 4 * sb + 3;
    v4u rk, rv;
    rk = *(const v4u*)(gK + (size_t)top * 64 * L1P); rv = *(const v4u*)(gVt + top * 64);
    *(LAS v4u*)(lds + lK) = rk; *(LAS u32x2*)(lds + lVt) = (u32x2){rv.x, rv.y}; *(LAS u32x2*)(lds + lVt + 8) = (u32x2){rv.z, rv.w};
    __syncthreads();
#pragma unroll 1
    for (int i = 0; i <= top; ++i) {
        const int step = top - i, nx = (step > 0) ? step - 1 : 0;
        rk = *(const v4u*)(gK + (size_t)nx * 64 * L1P); rv = *(const v4u*)(gVt + nx * 64);
        const LAS unsigned char* Kb = lds + (i & 1) * SB_STAGE;
        const LAS unsigned char* Vb = Kb + SBK_BYTES;
#pragma unroll
        for (int sub = 1; sub >= 0; --sub) {
            const int s0 = 64 * step + 32 * sub;
            if (s0 <= q0 && !done) {
                f32x16 acc;
#pragma unroll
                for (int r = 0; r < 16; ++r) acc[r] = 0.f;
#pragma unroll
                for (int kk = 0; kk < 4; ++kk) { const bf16x8 kf = *(const LAS bf16x8*)(Kb + (32 * sub + l31) * (SBK_PITCH * 2) + (16 * kk + 8 * hi) * 2); acc = MFMA32(kf, qf[kk], acc); }
                const bool diag = (s0 == q0);
                float bt[16], kp[16];
#pragma unroll
                for (int r = 0; r < 16; ++r) { const float ee = __builtin_amdgcn_exp2f(fminf(acc[r] * (-0.125f * 1.4426950408889634f), 100.f)); const float ri = __builtin_amdgcn_rcpf(1.f + ee);
                    float b_ = ri, k_ = ee * ri;
                    if (diag) { const bool valid = (s0 + crow(r, hi)) < t; b_ = valid ? b_ : 0.f; k_ = valid ? k_ : 1.f; }
                    bt[r] = b_; kp[r] = k_; }
                float e[16], T[4], U[4];
#pragma unroll
                for (int q = 0; q < 4; ++q) { e[4 * q + 3] = 1.f; e[4 * q + 2] = kp[4 * q + 3]; e[4 * q + 1] = e[4 * q + 2] * kp[4 * q + 2]; e[4 * q] = e[4 * q + 1] * kp[4 * q + 1]; T[q] = e[4 * q] * kp[4 * q]; }
#pragma unroll
                for (int q = 0; q < 4; ++q) U[q] = __shfl_xor(T[q], 32);
                { const float st2 = T[3], st1 = st2 * T[2], st0 = st1 * T[1]; const float su2 = U[3], su1 = su2 * U[2], su0 = su1 * U[1];
                  const float x0 = hi ? 1.f : U[0], x1 = hi ? 1.f : U[1], x2 = hi ? 1.f : U[2], x3 = hi ? 1.f : U[3];
                  const float off[4] = {cum * (st0 * su0 * x0), cum * (st1 * su1 * x1), cum * (st2 * su2 * x2), cum * x3};
#pragma unroll
                  for (int r = 0; r < 16; ++r) acc[r] = bt[r] * (off[r >> 2] * e[r]);
                  cum *= (st0 * T[0]) * (su0 * U[0]); }
                bf16x8 pf[2];
#pragma unroll
                for (int ks = 0; ks < 2; ++ks) { v4u w; w.x = cvtpk(acc[8 * ks], acc[8 * ks + 1]); w.y = cvtpk(acc[8 * ks + 2], acc[8 * ks + 3]); w.z = cvtpk(acc[8 * ks + 4], acc[8 * ks + 5]); w.w = cvtpk(acc[8 * ks + 6], acc[8 * ks + 7]); pf[ks] = __builtin_bit_cast(bf16x8, w); }
#pragma unroll
                for (int dt = 0; dt < 2; ++dt)
#pragma unroll
                    for (int ks = 0; ks < 2; ++ks) { const LAS unsigned char* vp = Vb + (32 * dt + l31) * (MLV_PITCH * 2) + (32 * sub + 16 * ks + 4 * hi) * 2;
                        const u32x2 x0 = *(const LAS u32x2*)vp, x1 = *(const LAS u32x2*)(vp + 16);
                        v4u a; a.x = x0.x; a.y = x0.y; a.z = x1.x; a.w = x1.y; o[dt] = MFMA32(__builtin_bit_cast(bf16x8, a), pf[ks], o[dt]); }
                done = __all(cum < 1e-35f);
            }
        }
        if (lane == 0) flags[(i & 1) * 8 + wave] = done ? 1u : 0u;
        LAS unsigned char* nb = lds + ((i + 1) & 1) * SB_STAGE;
        *(LAS v4u*)(nb + lK) = rk; *(LAS u32x2*)(nb + lVt) = (u32x2){rv.x, rv.y}; *(LAS u32x2*)(nb + lVt + 8) = (u32x2){rv.z, rv.w};
        __syncthreads();
        unsigned nd = 0;
#pragma unroll
        for (int w8 = 0; w8 < 8; ++w8) nd += flags[(i & 1) * 8 + w8];
        if (nd == 8u) break;
    }
    store_OT(o, 1.0f, (LAS bf16_t*)(lds + 2 * SB_STAGE + 256) + wave * (32 * STG_PITCH), ymix + (rowb + q0) * DM + h * 64, lane);
    __syncthreads();
}

constexpr int RW_RAWW = 0, RW_RAWA = 2048, RW_RS = 4096, RW_KS = 6144, RW_VS = 8192;
constexpr int RW_CH0 = 10240, RW_CHSZ = 11328;
constexpr int RW_YB = RW_CH0 + 2 * RW_CHSZ;
constexpr int RW_MIX = RW_YB + 1024;
static_assert((RW_MIX + 256) * 4 <= 146432, "rwkv LDS map");
__device__ __forceinline__ float tanh_fast(float x) { return 1.f - 2.f * __builtin_amdgcn_rcpf(1.f + __expf(2.f * x)); }
__device__ __forceinline__ float sigmoid_fast(float x) { return __builtin_amdgcn_rcpf(1.f + __expf(-x)); }

#define MFMA16(a, b, c) __builtin_amdgcn_mfma_f32_16x16x32_bf16((a), (b), (c), 0, 0, 0)
constexpr int RW2_CH0 = 0, RW2_YB = 2 * RW_CHSZ, RW2_MIX = RW2_YB + 1024, RW2_STG = RW2_MIX + 448;
static_assert((RW2_STG + 2 * 3072) * 4 <= 146432, "rwkv LDS map");
__device__ __forceinline__ void rwkv_phase_scan(LAS float* sm, int tid, int lane, int wave, int blk, const bf16_t* __restrict__ proj, const float* __restrict__ mix, const float* __restrict__ w0, const float* __restrict__ a0,
                                           const float* __restrict__ k_k, const float* __restrict__ k_a, const float* __restrict__ r_k, const bf16_t* __restrict__ W2T, const bf16_t* __restrict__ A2T, const bf16_t* __restrict__ G2T,
                                           float* __restrict__ yraw, bf16_t* __restrict__ gout, float* __restrict__ bonus_out) {
    const int chain = blk >> 1, half = blk & 1, b = chain >> 3, h = chain & 7, l15 = lane & 15, kg = lane >> 4;
    const size_t rowb = (size_t)b * SEQ;
    constexpr int NCHUNK = SEQ / 32;
    if (tid < 256) sm[RW2_MIX + tid] = mix[1536 + tid];
    else if (tid < 448) { const int q = tid - 256; sm[RW2_MIX + tid] = mix[512 * (q >> 6) + h * 64 + (q & 63)]; }
    __syncthreads();
#define RW_SH8(CUR, PRV, M0, M1, OUT, PZ) do { const unsigned cu_[4] = {(CUR).x, (CUR).y, (CUR).z, (CUR).w}, pu_[4] = {(PRV).x, (PRV).y, (PRV).z, (PRV).w}; \
        const float mm_[8] = {(M0)[0], (M0)[1], (M0)[2], (M0)[3], (M1)[0], (M1)[1], (M1)[2], (M1)[3]}; \
        _Pragma("unroll") for (int q = 0; q < 4; ++q) { const float c0 = bflo(cu_[q]), c1 = bfhi(cu_[q]), p0 = bflo(pu_[q]) * (PZ), p1 = bfhi(pu_[q]) * (PZ); \
            OUT[2 * q] = c0 + (p0 - c0) * mm_[2 * q]; OUT[2 * q + 1] = c1 + (p1 - c1) * mm_[2 * q + 1]; } } while (0)
    if (wave < 4) {
        const int iA = 8 * wave + kg, iB = iA + 4, jseg = l15;
        float A0 = 0.f, A1 = 0.f, A2 = 0.f, A3 = 0.f, B0 = 0.f, B1 = 0.f, B2 = 0.f, B3 = 0.f;
        __syncthreads();
#pragma unroll 1
        for (int ch = 0; ch < NCHUNK; ++ch) {
            const int t0 = ch * 32;
            const LAS float* CHb = sm + RW2_CH0 + (ch & 1) * RW_CHSZ + 4 * jseg;
            const LAS float* CHv = sm + RW2_CH0 + (ch & 1) * RW_CHSZ + 10240 + iA;
            const LAS float* CHs = sm + RW2_CH0 + (ch & 1) * RW_CHSZ + 11264;
            f32x4 a4 = *(const LAS f32x4*)(CHb + 4096), wr4 = *(const LAS f32x4*)(CHb + 8192), w4 = *(const LAS f32x4*)(CHb), b4 = *(const LAS f32x4*)(CHb + 6144), k4 = *(const LAS f32x4*)(CHb + 2048);
            float vA = CHv[0], vB = CHv[4]; f32x2_t sc = *(const LAS f32x2_t*)(CHs);
#pragma unroll 2
            for (int t = 0; t < 32; ++t) {
                const int tq = (t + 1) & 31;
                const f32x4 a4n = *(const LAS f32x4*)(CHb + 4096 + tq * 64), wr4n = *(const LAS f32x4*)(CHb + 8192 + tq * 64), w4n = *(const LAS f32x4*)(CHb + tq * 64),
                            b4n = *(const LAS f32x4*)(CHb + 6144 + tq * 64), k4n = *(const LAS f32x4*)(CHb + 2048 + tq * 64);
                const float vAn = CHv[tq * 32], vBn = CHv[tq * 32 + 4]; const f32x2_t scn = *(const LAS f32x2_t*)(CHs + 2 * tq);
                float d1A = (A0 * a4[0] + A1 * a4[1]) + (A2 * a4[2] + A3 * a4[3]), d1B = (B0 * a4[0] + B1 * a4[1]) + (B2 * a4[2] + B3 * a4[3]);
                float d2A = (A0 * wr4[0] + A1 * wr4[1]) + (A2 * wr4[2] + A3 * wr4[3]), d2B = (B0 * wr4[0] + B1 * wr4[1]) + (B2 * wr4[2] + B3 * wr4[3]);
                d1A = rowsum16(d1A); d1B = rowsum16(d1B); d2A = rowsum16(d2A); d2B = rowsum16(d2B);
                const float yA = d2A + d1A * sc[0] + vA * sc[1], yB = d2B + d1B * sc[0] + vB * sc[1];
                A0 = A0 * w4[0] + (d1A * b4[0] + vA * k4[0]); A1 = A1 * w4[1] + (d1A * b4[1] + vA * k4[1]); A2 = A2 * w4[2] + (d1A * b4[2] + vA * k4[2]); A3 = A3 * w4[3] + (d1A * b4[3] + vA * k4[3]);
                B0 = B0 * w4[0] + (d1B * b4[0] + vB * k4[0]); B1 = B1 * w4[1] + (d1B * b4[1] + vB * k4[1]); B2 = B2 * w4[2] + (d1B * b4[2] + vB * k4[2]); B3 = B3 * w4[3] + (d1B * b4[3] + vB * k4[3]);
                if (jseg == 0) { sm[RW2_YB + t * 32 + iA] = yA; sm[RW2_YB + t * 32 + iB] = yB; }
                a4 = a4n; wr4 = wr4n; w4 = w4n; b4 = b4n; k4 = k4n; vA = vAn; vB = vBn; sc = scn;
            }
            WSYNC();
            { const int tt = lane >> 1, hh = lane & 1; const f32x4 yv = *(const LAS f32x4*)(sm + RW2_YB + tt * 32 + 8 * wave + 4 * hh);
              *(f32x4*)(yraw + (rowb + t0 + tt) * 512 + h * 64 + half * 32 + 8 * wave + 4 * hh) = yv; }
            __syncthreads();
        }
    } else if (wave < 6) {
        const int tp = wave - 4, tb = 16 * tp;
        LAS float* stg = sm + RW2_STG + tp * 3072;
        float w0c[4], a0c[4], kkc[4], kac[4], rkc[4];
#pragma unroll
        for (int nt = 0; nt < 4; ++nt) { const int c = h * 64 + 16 * nt + l15; w0c[nt] = w0[c]; a0c[nt] = a0[c]; kkc[nt] = k_k[c]; kac[nt] = k_a[c]; rkc[nt] = r_k[c]; }
        v4u ld[20];
#define PREP_ISSUE(T0) do { const int t0_ = (T0); { const size_t r_ = rowb + t0_ + tb + l15; const size_t rp_ = (t0_ + tb + l15 == 0) ? r_ : r_ - 1; \
            _Pragma("unroll") for (int lo = 0; lo < 2; ++lo) _Pragma("unroll") for (int ks = 0; ks < 2; ++ks) { const int col = 1536 + 64 * lo + 32 * ks + 8 * kg; \
                ld[(lo * 2 + ks) * 2] = *(const v4u*)(proj + r_ * L0P + col); ld[(lo * 2 + ks) * 2 + 1] = *(const v4u*)(proj + rp_ * L0P + col); } } \
            _Pragma("unroll") for (int ar = 0; ar < 3; ++ar) _Pragma("unroll") for (int i = 0; i < 2; ++i) { const int p_ = lane + 64 * i, row_ = p_ >> 3, c8_ = p_ & 7; \
                const size_t r_ = rowb + t0_ + tb + row_; const size_t rp_ = (t0_ + tb + row_ == 0) ? r_ : r_ - 1; const int col = 512 * ar + h * 64 + 8 * c8_; \
                ld[8 + (ar * 2 + i) * 2] = *(const v4u*)(proj + r_ * L0P + col); ld[8 + (ar * 2 + i) * 2 + 1] = *(const v4u*)(proj + rp_ * L0P + col); } } while (0)
#define PREP_BUILD(T0, NB) do { const int t0_ = (T0); LAS float* CHn = sm + RW2_CH0 + (NB) * RW_CHSZ; \
            f32x4 accw[4], acca[4]; \
            _Pragma("unroll") for (int nt = 0; nt < 4; ++nt) { accw[nt] = (f32x4){0.f, 0.f, 0.f, 0.f}; acca[nt] = (f32x4){0.f, 0.f, 0.f, 0.f}; } \
            { const float pz_ = (t0_ + tb + l15 == 0) ? 0.f : 1.f; \
              _Pragma("unroll") for (int lo = 0; lo < 2; ++lo) _Pragma("unroll") for (int ks = 0; ks < 2; ++ks) { float s_[8]; \
                const f32x4 m0 = *(const LAS f32x4*)(sm + RW2_MIX + 64 * lo + 32 * ks + 8 * kg), m1 = *(const LAS f32x4*)(sm + RW2_MIX + 64 * lo + 32 * ks + 8 * kg + 4); \
                RW_SH8(ld[(lo * 2 + ks) * 2], ld[(lo * 2 + ks) * 2 + 1], m0, m1, s_, pz_); \
                if (lo == 0) { _Pragma("unroll") for (int j = 0; j < 8; ++j) s_[j] = tanh_fast(s_[j]); } \
                v4u aw; aw.x = cvtpk(s_[0], s_[1]); aw.y = cvtpk(s_[2], s_[3]); aw.z = cvtpk(s_[4], s_[5]); aw.w = cvtpk(s_[6], s_[7]); const bf16x8 af = __builtin_bit_cast(bf16x8, aw); \
                const bf16_t* WT = lo ? A2T : W2T; \
                _Pragma("unroll") for (int nt = 0; nt < 4; ++nt) { const bf16x8 bfr = *(const bf16x8*)(WT + (size_t)(h * 64 + 16 * nt + l15) * 64 + 32 * ks + 8 * kg); \
                    if (lo == 0) accw[nt] = MFMA16(af, bfr, accw[nt]); else acca[nt] = MFMA16(af, bfr, acca[nt]); } } } \
            _Pragma("unroll") for (int ar = 0; ar < 3; ++ar) _Pragma("unroll") for (int i = 0; i < 2; ++i) { const int p_ = lane + 64 * i, row_ = p_ >> 3, c8_ = p_ & 7; float s_[8]; \
                const float pz_ = (t0_ + tb + row_ == 0) ? 0.f : 1.f; const f32x4 m0 = *(const LAS f32x4*)(sm + RW2_MIX + 256 + ar * 64 + c8_ * 8), m1 = *(const LAS f32x4*)(sm + RW2_MIX + 256 + ar * 64 + c8_ * 8 + 4); \
                RW_SH8(ld[8 + (ar * 2 + i) * 2], ld[8 + (ar * 2 + i) * 2 + 1], m0, m1, s_, pz_); \
                *(LAS f32x4*)(stg + ar * 1024 + row_ * 64 + c8_ * 8) = (f32x4){s_[0], s_[1], s_[2], s_[3]}; *(LAS f32x4*)(stg + ar * 1024 + row_ * 64 + c8_ * 8 + 4) = (f32x4){s_[4], s_[5], s_[6], s_[7]}; } \
            WSYNC(); \
            PREP_ISSUE(((T0) + 32 < SEQ) ? (T0) + 32 : (T0)); \
            _Pragma("unroll") for (int rg = 0; rg < 4; ++rg) { const int tl = 4 * kg + rg, t = tb + tl; \
                float r_[4], k_[4], v_[4], kkv[4], nrm2 = 0.f; \
                _Pragma("unroll") for (int nt = 0; nt < 4; ++nt) { r_[nt] = stg[tl * 64 + 16 * nt + l15]; k_[nt] = stg[1024 + tl * 64 + 16 * nt + l15]; v_[nt] = stg[2048 + tl * 64 + 16 * nt + l15]; \
                    kkv[nt] = k_[nt] * kkc[nt]; nrm2 += kkv[nt] * kkv[nt]; } \
                nrm2 = rowsum16(nrm2); const float rn = __builtin_amdgcn_rsqf(fmaxf(nrm2, 1e-24f)); \
                float br = 0.f, kr = 0.f, bon = 0.f; \
                _Pragma("unroll") for (int nt = 0; nt < 4; ++nt) { const int j = 16 * nt + l15; \
                    const float wsum = w0c[nt] + accw[nt][rg]; const float logw = -softplus_fast(-wsum) - 0.5f; const float dec = __expf(-__expf(logw)); \
                    const float a_ = sigmoid_fast(a0c[nt] + acca[nt][rg]); const float kn = kkv[nt] * rn; \
                    const float k2 = k_[nt] * (1.f + (a_ - 1.f) * kac[nt]); const float bv = kn * a_; \
                    br += bv * r_[nt]; kr += k2 * r_[nt]; bon += r_[nt] * k2 * rkc[nt]; \
                    CHn[t * 64 + j] = dec; CHn[2048 + t * 64 + j] = k2; CHn[4096 + t * 64 + j] = -kn; CHn[6144 + t * 64 + j] = bv; CHn[8192 + t * 64 + j] = dec * r_[nt]; \
                    if ((nt >> 1) == half) CHn[10240 + t * 32 + (j & 31)] = v_[nt]; } \
                br = rowsum16(br); kr = rowsum16(kr); bon = rowsum16(bon); \
                if (l15 == 0) { CHn[11264 + 2 * t] = br; CHn[11264 + 2 * t + 1] = kr; if (half == 0) bonus_out[(rowb + t0_ + t) * 8 + h] = bon; } } \
            WSYNC(); } while (0)
        PREP_ISSUE(0);
        PREP_BUILD(0, 0);
        __syncthreads();
#pragma unroll 1
        for (int ch = 0; ch < NCHUNK; ++ch) {
            if (ch + 1 < NCHUNK) PREP_BUILD(ch * 32 + 32, (ch + 1) & 1);
            __syncthreads();
        }
#undef PREP_ISSUE
#undef PREP_BUILD
    } else {
        const int tp = wave - 6, tb = 16 * tp;
        v4u ld[8];
#define G_ISSUE(T0) do { const int t0_ = (T0); const size_t r_ = rowb + t0_ + tb + l15; const size_t rp_ = (t0_ + tb + l15 == 0) ? r_ : r_ - 1; \
            _Pragma("unroll") for (int ks = 0; ks < 4; ++ks) { const int col = 1664 + 32 * ks + 8 * kg; ld[2 * ks] = *(const v4u*)(proj + r_ * L0P + col); ld[2 * ks + 1] = *(const v4u*)(proj + rp_ * L0P + col); } } while (0)
#define G_BUILD(T0) do { const int t0_ = (T0); f32x4 accg[2] = {(f32x4){0.f, 0.f, 0.f, 0.f}, (f32x4){0.f, 0.f, 0.f, 0.f}}; const float pz_ = (t0_ + tb + l15 == 0) ? 0.f : 1.f; \
            _Pragma("unroll") for (int ks = 0; ks < 4; ++ks) { float s_[8]; \
                const f32x4 m0 = *(const LAS f32x4*)(sm + RW2_MIX + 128 + 32 * ks + 8 * kg), m1 = *(const LAS f32x4*)(sm + RW2_MIX + 128 + 32 * ks + 8 * kg + 4); \
                RW_SH8(ld[2 * ks], ld[2 * ks + 1], m0, m1, s_, pz_); \
                _Pragma("unroll") for (int j = 0; j < 8; ++j) s_[j] = sigmoid_fast(s_[j]); \
                v4u aw; aw.x = cvtpk(s_[0], s_[1]); aw.y = cvtpk(s_[2], s_[3]); aw.z = cvtpk(s_[4], s_[5]); aw.w = cvtpk(s_[6], s_[7]); const bf16x8 af = __builtin_bit_cast(bf16x8, aw); \
                _Pragma("unroll") for (int nt = 0; nt < 2; ++nt) { const bf16x8 bfr = *(const bf16x8*)(G2T + (size_t)(h * 64 + half * 32 + 16 * nt + l15) * 128 + 32 * ks + 8 * kg); accg[nt] = MFMA16(af, bfr, accg[nt]); } } \
            G_ISSUE(((T0) + 32 < SEQ) ? (T0) + 32 : (T0)); \
            _Pragma("unroll") for (int nt = 0; nt < 2; ++nt) _Pragma("unroll") for (int rg = 0; rg < 4; ++rg) \
                gout[(rowb + t0_ + tb + 4 * kg + rg) * 512 + h * 64 + half * 32 + 16 * nt + l15] = (bf16_t)f2bf(accg[nt][rg]); } while (0)
        G_ISSUE(0);
        G_BUILD(0);
        __syncthreads();
#pragma unroll 1
        for (int ch = 0; ch < NCHUNK; ++ch) {
            if (ch + 1 < NCHUNK) G_BUILD(ch * 32 + 32);
            __syncthreads();
        }
#undef G_ISSUE
#undef G_BUILD
    }
#undef RW_SH8
    __syncthreads();
}

constexpr int CK_BK = 0, CK_AR = 4608, CK_BBT = 9216, CK_KBT = 12288, CK_VT = 15360, CK_GC = 16896, CK_TT = 17152, CK_SLOT = 18688, CK_NSLOT = 6, CK_NBUILD = 5;
constexpr int CK_STG = CK_SLOT * CK_NSLOT;
constexpr int CK_MIX = CK_STG + CK_NBUILD * 6144;
constexpr int CK_FLAGS = CK_MIX + 448 * 4;
static_assert(CK_FLAGS + 64 <= 146432, "rwkv chunked LDS map");
__device__ __forceinline__ void rwkv_phase(LAS float* smf, int tid, int lane, int wave, int blk, const bf16_t* __restrict__ proj, const float* __restrict__ mix, const float* __restrict__ w0, const float* __restrict__ a0,
                                           const float* __restrict__ k_k, const float* __restrict__ k_a, const float* __restrict__ r_k, const bf16_t* __restrict__ W2T, const bf16_t* __restrict__ A2T, const bf16_t* __restrict__ G2T,
                                           float* __restrict__ yraw, bf16_t* __restrict__ gout, float* __restrict__ bonus_out) {
    LAS unsigned char* lds = (LAS unsigned char*)smf;
    LAS float* mixs = (LAS float*)(lds + CK_MIX);
    volatile LAS unsigned* flags = (volatile LAS unsigned*)(lds + CK_FLAGS);
    const int chain = blk >> 1, ihalf = blk & 1, b = chain >> 3, h = chain & 7, l15 = lane & 15, kg = lane >> 4, l31 = lane & 31, hi = lane >> 5;
    const size_t rowb = (size_t)b * SEQ;
    constexpr int NCH = SEQ / 16;
    if (tid < 256) mixs[tid] = mix[1536 + tid];
    else if (tid < 448) { const int q = tid - 256; mixs[tid] = mix[512 * (q >> 6) + h * 64 + (q & 63)]; }
    if (tid < 16) flags[tid] = (tid == 9) ? (unsigned)CK_NBUILD : 0u;
    for (int q = tid; q < CK_NSLOT * 384; q += NWAVES * 64) *(LAS unsigned*)(lds + (q / 384) * CK_SLOT + CK_TT + (q % 384) * 4) = 0u;
    __syncthreads();
#define RW_SH8(CUR, PRV, M0, M1, OUT, PZ) do { const unsigned cu_[4] = {(CUR).x, (CUR).y, (CUR).z, (CUR).w}, pu_[4] = {(PRV).x, (PRV).y, (PRV).z, (PRV).w}; \
        const float mm_[8] = {(M0)[0], (M0)[1], (M0)[2], (M0)[3], (M1)[0], (M1)[1], (M1)[2], (M1)[3]}; \
        _Pragma("unroll") for (int q = 0; q < 4; ++q) { const float c0 = bflo(cu_[q]), c1 = bfhi(cu_[q]), p0 = bflo(pu_[q]) * (PZ), p1 = bfhi(pu_[q]) * (PZ); \
            OUT[2 * q] = c0 + (p0 - c0) * mm_[2 * q]; OUT[2 * q + 1] = c1 + (p1 - c1) * mm_[2 * q + 1]; } } while (0)
    if (wave == 0) {
        f32x16 ST[2];
#pragma unroll
        for (int r = 0; r < 16; ++r) { ST[0][r] = 0.f; ST[1][r] = 0.f; }
#pragma unroll 1
        for (int k = 0; k < NCH; ++k) {
#if defined(PROBE_STAMPS)
            const unsigned tw0_ = (unsigned)__builtin_amdgcn_s_memrealtime();
#endif
            { const unsigned want = (unsigned)(k + 1); const int sl = k % CK_NSLOT; while (flags[sl] != want) __builtin_amdgcn_s_sleep(1); }
#if defined(PROBE_STAMPS)
            if (blk == 0 && lane == 0) ((volatile LAS unsigned*)(lds + 146432 + 320))[16 + 24] += (unsigned)__builtin_amdgcn_s_memrealtime() - tw0_;
#endif
            asm volatile("" ::: "memory");
            const LAS unsigned char* im = lds + (k % CK_NSLOT) * CK_SLOT;
            f32x16 G;
#pragma unroll
            for (int r = 0; r < 16; ++r) G[r] = 0.f;
#pragma unroll
            for (int kk = 0; kk < 4; ++kk) { const bf16x8 fa = *(const LAS bf16x8*)(im + CK_BK + l31 * 144 + (16 * kk + 8 * hi) * 2), fb = *(const LAS bf16x8*)(im + CK_AR + l31 * 144 + (16 * kk + 8 * hi) * 2); G = MFMA32(fa, fb, G); }
            { const int tcol = l31 & 15; const bool strict = l31 < 16;
#pragma unroll
              for (int r = 0; r < 16; ++r) { const int srow = crow(r & 7, hi); const bool keep = strict ? (srow < tcol) : (srow <= tcol); G[r] = keep ? G[r] : 0.f; } }
            const bf16x8 gB = pack8(G[0], G[1], G[2], G[3], G[4], G[5], G[6], G[7]), gK = pack8(G[8], G[9], G[10], G[11], G[12], G[13], G[14], G[15]);
            f32x16 XT;
#pragma unroll
            for (int r = 0; r < 16; ++r) XT[r] = 0.f;
#pragma unroll
            for (int jt = 0; jt < 2; ++jt)
#pragma unroll
                for (int sp = 0; sp < 2; ++sp) { const LAS unsigned char* ap = im + CK_AR + l31 * 144 + (32 * jt + 16 * sp + 4 * hi) * 2;
                    const u32x2 x0 = *(const LAS u32x2*)ap, x1 = *(const LAS u32x2*)(ap + 16); v4u aw; aw.x = x0.x; aw.y = x0.y; aw.z = x1.x; aw.w = x1.y;
                    const bf16x8 sb_ = pack8(ST[jt][8 * sp], ST[jt][8 * sp + 1], ST[jt][8 * sp + 2], ST[jt][8 * sp + 3], ST[jt][8 * sp + 4], ST[jt][8 * sp + 5], ST[jt][8 * sp + 6], ST[jt][8 * sp + 7]);
                    XT = MFMA32(__builtin_bit_cast(bf16x8, aw), sb_, XT); }
            bf16x8 vP;
            { const LAS unsigned char* vp = im + CK_VT + l31 * 48 + (4 * hi) * 2; const u32x2 x0 = *(const LAS u32x2*)vp, x1 = *(const LAS u32x2*)(vp + 16); v4u vw; vw.x = x0.x; vw.y = x0.y; vw.z = x1.x; vw.w = x1.y;
              vP = __builtin_bit_cast(bf16x8, vw); XT = MFMA32(gK, vP, XT); }
            bf16x8 uP;
            { const LAS unsigned char* tp = im + CK_TT + l31 * 48 + (4 * hi) * 2; const u32x2 x0 = *(const LAS u32x2*)tp, x1 = *(const LAS u32x2*)(tp + 16); v4u tw; tw.x = x0.x; tw.y = x0.y; tw.z = x1.x; tw.w = x1.y;
              f32x16 UT;
#pragma unroll
              for (int r = 0; r < 16; ++r) UT[r] = 0.f;
              UT = MFMA32(__builtin_bit_cast(bf16x8, tw), pack8(XT[0], XT[1], XT[2], XT[3], XT[4], XT[5], XT[6], XT[7]), UT);
              uP = pack8(UT[0], UT[1], UT[2], UT[3], UT[4], UT[5], UT[6], UT[7]); }
            XT = MFMA32(gB, uP, XT);
            { float* yp = yraw + (rowb + 16 * k) * 512 + h * 64 + 32 * ihalf + l31;
#pragma unroll
              for (int q = 0; q < 8; ++q) yp[(size_t)crow(q, hi) * 512] = XT[8 + q]; }
            { const LAS float* gc = (const LAS float*)(im + CK_GC);
#pragma unroll
              for (int jt = 0; jt < 2; ++jt)
#pragma unroll
                  for (int r = 0; r < 16; ++r) ST[jt][r] *= gc[32 * jt + crow(r, hi)]; }
#pragma unroll
            for (int jt = 0; jt < 2; ++jt) { const LAS unsigned char* bp = im + CK_BBT + (32 * jt + l31) * 48 + (4 * hi) * 2; const LAS unsigned char* kp = im + CK_KBT + (32 * jt + l31) * 48 + (4 * hi) * 2;
                const u32x2 b0 = *(const LAS u32x2*)bp, b1 = *(const LAS u32x2*)(bp + 16), k0 = *(const LAS u32x2*)kp, k1 = *(const LAS u32x2*)(kp + 16);
                v4u a1; a1.x = b0.x; a1.y = b0.y; a1.z = b1.x; a1.w = b1.y; v4u a2; a2.x = k0.x; a2.y = k0.y; a2.z = k1.x; a2.w = k1.y;
                ST[jt] = MFMA32(__builtin_bit_cast(bf16x8, a1), uP, ST[jt]); ST[jt] = MFMA32(__builtin_bit_cast(bf16x8, a2), vP, ST[jt]); }
            WSYNC();
            if (lane == 0) flags[8] = (unsigned)(k + 1);
        }
    } else if (wave <= CK_NBUILD) {
        const int pw = wave - 1;
        LAS bf16_t* stg = (LAS bf16_t*)(lds + CK_STG) + pw * 3072;
        float w0c[4], a0c[4], kkc[4], kac[4], rkc[4];
#pragma unroll
        for (int nt = 0; nt < 4; ++nt) { const int c = h * 64 + 16 * nt + l15; w0c[nt] = w0[c]; a0c[nt] = a0[c]; kkc[nt] = k_k[c]; kac[nt] = k_a[c]; rkc[nt] = r_k[c]; }
        v4u ld[20];
#define CK_ISSUE_A(T0) do { const int t0_ = (T0); const size_t r_ = rowb + t0_ + l15; const size_t rp_ = (t0_ + l15 == 0) ? r_ : r_ - 1; \
            _Pragma("unroll") for (int lo = 0; lo < 2; ++lo) _Pragma("unroll") for (int ks = 0; ks < 2; ++ks) { const int col = 1536 + 64 * lo + 32 * ks + 8 * kg; \
                ld[(lo * 2 + ks) * 2] = *(const v4u*)(proj + r_ * L0P + col); ld[(lo * 2 + ks) * 2 + 1] = *(const v4u*)(proj + rp_ * L0P + col); } } while (0)
#define CK_ISSUE_B(T0) do { const int t0_ = (T0); \
            _Pragma("unroll") for (int ar = 0; ar < 3; ++ar) _Pragma("unroll") for (int i = 0; i < 2; ++i) { const int p_ = lane + 64 * i, row_ = p_ >> 3, c8_ = p_ & 7; \
                const size_t r_ = rowb + t0_ + row_; const size_t rp_ = (t0_ + row_ == 0) ? r_ : r_ - 1; const int col = 512 * ar + h * 64 + 8 * c8_; \
                ld[8 + (ar * 2 + i) * 2] = *(const v4u*)(proj + r_ * L0P + col); ld[8 + (ar * 2 + i) * 2 + 1] = *(const v4u*)(proj + rp_ * L0P + col); } } while (0)
#define CK_ISSUE(T0) do { CK_ISSUE_A(T0); CK_ISSUE_B(T0); } while (0)
        CK_ISSUE(16 * pw);
        int k = pw;
#pragma unroll 1
        while (k < NCH) {
            const int t0 = 16 * k; int kn;
#if defined(PROBE_STAMPS)
            const unsigned ts0_ = (unsigned)__builtin_amdgcn_s_memrealtime();
#endif
            f32x4 accw[4], acca[4];
#pragma unroll
            for (int nt = 0; nt < 4; ++nt) { accw[nt] = (f32x4){0.f, 0.f, 0.f, 0.f}; acca[nt] = (f32x4){0.f, 0.f, 0.f, 0.f}; }
            { const float pz_ = (t0 + l15 == 0) ? 0.f : 1.f;
#pragma unroll
              for (int lo = 0; lo < 2; ++lo)
#pragma unroll
                for (int ks = 0; ks < 2; ++ks) { float s_[8];
                    const f32x4 m0 = *(const LAS f32x4*)(mixs + 64 * lo + 32 * ks + 8 * kg), m1 = *(const LAS f32x4*)(mixs + 64 * lo + 32 * ks + 8 * kg + 4);
                    RW_SH8(ld[(lo * 2 + ks) * 2], ld[(lo * 2 + ks) * 2 + 1], m0, m1, s_, pz_);
                    if (lo == 0) {
#pragma unroll
                        for (int j = 0; j < 8; ++j) s_[j] = tanh_fast(s_[j]); }
                    const bf16x8 af = pack8(s_[0], s_[1], s_[2], s_[3], s_[4], s_[5], s_[6], s_[7]);
                    const bf16_t* WT = lo ? A2T : W2T;
#pragma unroll
                    for (int nt = 0; nt < 4; ++nt) { const bf16x8 bfr = *(const bf16x8*)(WT + (size_t)(h * 64 + 16 * nt + l15) * 64 + 32 * ks + 8 * kg);
                        if (lo == 0) accw[nt] = MFMA16(af, bfr, accw[nt]); else acca[nt] = MFMA16(af, bfr, acca[nt]); } } }
#pragma unroll
            for (int ar = 0; ar < 3; ++ar)
#pragma unroll
                for (int i = 0; i < 2; ++i) { const int p_ = lane + 64 * i, row_ = p_ >> 3, c8_ = p_ & 7; float s_[8];
                    const float pz_ = (t0 + row_ == 0) ? 0.f : 1.f; const f32x4 m0 = *(const LAS f32x4*)(mixs + 256 + ar * 64 + c8_ * 8), m1 = *(const LAS f32x4*)(mixs + 256 + ar * 64 + c8_ * 8 + 4);
                    RW_SH8(ld[8 + (ar * 2 + i) * 2], ld[8 + (ar * 2 + i) * 2 + 1], m0, m1, s_, pz_);
                    *(LAS bf16x8*)(stg + ar * 1024 + row_ * 64 + c8_ * 8) = pack8(s_[0], s_[1], s_[2], s_[3], s_[4], s_[5], s_[6], s_[7]); }
            WSYNC();
#if defined(PROBE_STAMPS)
            if (blk == 0 && wave == 1 && lane == 0) ((volatile LAS unsigned*)(lds + 146432 + 320))[16 + 26] += (unsigned)__builtin_amdgcn_s_memrealtime() - ts0_;
#endif
#if defined(PROBE_STAMPS)
            const unsigned tb0_ = (unsigned)__builtin_amdgcn_s_memrealtime();
#endif
            { const int need = k - (CK_NSLOT - 1); if (need > 0) { while ((int)flags[8] < need) __builtin_amdgcn_s_sleep(2); } }
#if defined(PROBE_STAMPS)
            if (blk == 0 && wave == 1 && lane == 0) ((volatile LAS unsigned*)(lds + 146432 + 320))[16 + 25] += (unsigned)__builtin_amdgcn_s_memrealtime() - tb0_;
#endif
            asm volatile("" ::: "memory");
            LAS unsigned char* im = lds + (k % CK_NSLOT) * CK_SLOT;
#if defined(PROBE_STAMPS)
            const unsigned ts1_ = (unsigned)__builtin_amdgcn_s_memrealtime();
#endif
            float lwv[4][4], av[4][4], knv[4][4];
#pragma unroll
            for (int rg = 0; rg < 4; ++rg) { const int tl = 4 * kg + rg;
                float kkv[4], nrm2 = 0.f, vv[4], rr_[4], kr_[4];
#pragma unroll
                for (int nt = 0; nt < 4; ++nt) { rr_[nt] = bf2f(stg[tl * 64 + 16 * nt + l15]); kr_[nt] = bf2f(stg[1024 + tl * 64 + 16 * nt + l15]); vv[nt] = bf2f(stg[2048 + tl * 64 + 16 * nt + l15]);
                    kkv[nt] = kr_[nt] * kkc[nt]; nrm2 += kkv[nt] * kkv[nt]; }
                nrm2 = rowsum16(nrm2); const float rn = __builtin_amdgcn_rsqf(fmaxf(nrm2, 1e-24f));
                float bon = 0.f;
#pragma unroll
                for (int nt = 0; nt < 4; ++nt) {
                    const float wsum = w0c[nt] + accw[nt][rg]; lwv[nt][rg] = -0.6065306597126334f * sigmoid_fast(wsum);
                    const float a_ = sigmoid_fast(a0c[nt] + acca[nt][rg]); av[nt][rg] = a_; knv[nt][rg] = kkv[nt] * rn;
                    const float k2 = kr_[nt] * (1.f + (a_ - 1.f) * kac[nt]); stg[1024 + tl * 64 + 16 * nt + l15] = bf1(k2);
                    bon += rr_[nt] * k2 * rkc[nt];
                    if ((nt >> 1) == ihalf) *(LAS bf16_t*)(im + CK_VT + (16 * (nt & 1) + l15) * 48 + tl * 2) = bf1(vv[nt]);
                }
                bon = rowsum16(bon);
                if (l15 == 0 && ihalf == 0) bonus_out[(rowb + t0 + tl) * 8 + h] = bon;
            }
            { unsigned g_ = 0; if (lane == 0) g_ = __hip_atomic_fetch_add((LAS unsigned*)(lds + CK_FLAGS + 36), 1u, __ATOMIC_RELAXED, __HIP_MEMORY_SCOPE_WORKGROUP);
              kn = (int)__builtin_amdgcn_readfirstlane(g_); }
            CK_ISSUE_A((kn < NCH) ? 16 * kn : t0);
#pragma unroll
            for (int nt = 0; nt < 4; ++nt) {
                float L[4]; L[0] = lwv[nt][0]; L[1] = L[0] + lwv[nt][1]; L[2] = L[1] + lwv[nt][2]; L[3] = L[2] + lwv[nt][3];
                const float T0 = __shfl(L[3], l15), T1 = __shfl(L[3], 16 + l15), T2 = __shfl(L[3], 32 + l15), T3 = __shfl(L[3], 48 + l15);
                const float off = (kg > 0 ? T0 : 0.f) + (kg > 1 ? T1 : 0.f) + (kg > 2 ? T2 : 0.f), LC = (T0 + T1) + (T2 + T3);
                const int j = 16 * nt + l15;
                unsigned bb2[2], kb2[2];
                const float gC = __expf(LC); float eprev = __expf(off);
#pragma unroll
                for (int rg = 0; rg < 4; ++rg) { const int tl = 4 * kg + rg; const float Lt = off + L[rg], e1 = __expf(Lt), e2 = __builtin_amdgcn_rcpf(e1), e3 = eprev, e4 = gC * e2; eprev = e1;
                    const float kn = knv[nt][rg], bvv = kn * av[nt][rg], k2 = bf2f(stg[1024 + tl * 64 + j]), rr2 = bf2f(stg[tl * 64 + j]);
                    *(LAS bf16_t*)(im + CK_BK + tl * 144 + j * 2) = bf1(bvv * e2); *(LAS bf16_t*)(im + CK_BK + (16 + tl) * 144 + j * 2) = bf1(k2 * e2);
                    *(LAS bf16_t*)(im + CK_AR + tl * 144 + j * 2) = bf1(-kn * e3); *(LAS bf16_t*)(im + CK_AR + (16 + tl) * 144 + j * 2) = bf1(rr2 * e1);
                    const unsigned bq = bf1(bvv * e4), kq = bf1(k2 * e4);
                    if (rg & 1) { bb2[rg >> 1] |= bq << 16; kb2[rg >> 1] |= kq << 16; } else { bb2[rg >> 1] = bq; kb2[rg >> 1] = kq; } }
                *(LAS u32x2*)(im + CK_BBT + j * 48 + (4 * kg) * 2) = (u32x2){bb2[0], bb2[1]}; *(LAS u32x2*)(im + CK_KBT + j * 48 + (4 * kg) * 2) = (u32x2){kb2[0], kb2[1]};
                if (kg == 0) *(LAS float*)(im + CK_GC + j * 4) = gC;
            }
            WSYNC();
#if defined(PROBE_STAMPS)
            const unsigned ts2_ = (unsigned)__builtin_amdgcn_s_memrealtime();
            if (blk == 0 && wave == 1 && lane == 0) ((volatile LAS unsigned*)(lds + 146432 + 320))[16 + 27] += ts2_ - ts1_;
#endif
            {
                f32x4 nacc = {0.f, 0.f, 0.f, 0.f};
#pragma unroll
                for (int ks = 0; ks < 2; ++ks) { const bf16x8 fa = *(const LAS bf16x8*)(im + CK_BK + l15 * 144 + (32 * ks + 8 * kg) * 2), fb = *(const LAS bf16x8*)(im + CK_AR + l15 * 144 + (32 * ks + 8 * kg) * 2); nacc = MFMA16(fa, fb, nacc); }
#pragma unroll
                for (int rg = 0; rg < 4; ++rg) nacc[rg] = ((4 * kg + rg) < l15) ? nacc[rg] : 0.f;
                float Tr[16];
#pragma unroll
                for (int t = 0; t < 16; ++t) { float acc_ = (l15 == t) ? 1.f : 0.f;
#pragma unroll
                    for (int s2 = 0; s2 < t; ++s2) acc_ += Tr[s2] * rl(nacc[s2 & 3], t + 16 * (s2 >> 2));
                    Tr[t] = acc_; }
                if (kg == 0) {
#pragma unroll
                    for (int t = 0; t < 16; ++t) *(LAS bf16_t*)(im + CK_TT + t * 48 + l15 * 2) = bf1(Tr[t]); }
            }
            WSYNC();
#if defined(PROBE_STAMPS)
            if (blk == 0 && wave == 1 && lane == 0) ((volatile LAS unsigned*)(lds + 146432 + 320))[16 + 28] += (unsigned)__builtin_amdgcn_s_memrealtime() - ts2_;
#endif
            if (lane == 0) flags[k % CK_NSLOT] = (unsigned)(k + 1);
            CK_ISSUE_B((kn < NCH) ? 16 * kn : t0);
            k = kn;
        }
#undef CK_ISSUE
#undef CK_ISSUE_A
#undef CK_ISSUE_B
    } else {
        const int gq = wave - 6;
        v4u ld[8];
#define G_ISSUE(T0) do { const int t0_ = (T0); const size_t r_ = rowb + t0_ + l15; const size_t rp_ = (t0_ + l15 == 0) ? r_ : r_ - 1; \
            _Pragma("unroll") for (int ks = 0; ks < 4; ++ks) { const int col = 1664 + 32 * ks + 8 * kg; ld[2 * ks] = *(const v4u*)(proj + r_ * L0P + col); ld[2 * ks + 1] = *(const v4u*)(proj + rp_ * L0P + col); } } while (0)
        G_ISSUE(16 * gq);
#pragma unroll 1
        for (int k = gq; k < NCH; k += 2) {
            const int t0 = 16 * k;
            f32x4 accg[2] = {(f32x4){0.f, 0.f, 0.f, 0.f}, (f32x4){0.f, 0.f, 0.f, 0.f}}; const float pz_ = (t0 + l15 == 0) ? 0.f : 1.f;
#pragma unroll
            for (int ks = 0; ks < 4; ++ks) { float s_[8];
                const f32x4 m0 = *(const LAS f32x4*)(mixs + 128 + 32 * ks + 8 * kg), m1 = *(const LAS f32x4*)(mixs + 128 + 32 * ks + 8 * kg + 4);
                RW_SH8(ld[2 * ks], ld[2 * ks + 1], m0, m1, s_, pz_);
#pragma unroll
                for (int j = 0; j < 8; ++j) s_[j] = sigmoid_fast(s_[j]);
                const bf16x8 af = pack8(s_[0], s_[1], s_[2], s_[3], s_[4], s_[5], s_[6], s_[7]);
#pragma unroll
                for (int nt = 0; nt < 2; ++nt) { const bf16x8 bfr = *(const bf16x8*)(G2T + (size_t)(h * 64 + ihalf * 32 + 16 * nt + l15) * 128 + 32 * ks + 8 * kg); accg[nt] = MFMA16(af, bfr, accg[nt]); } }
            G_ISSUE((k + 2 < NCH) ? t0 + 32 : t0);
#pragma unroll
            for (int nt = 0; nt < 2; ++nt)
#pragma unroll
                for (int rg = 0; rg < 4; ++rg) gout[(rowb + t0 + 4 * kg + rg) * 512 + h * 64 + ihalf * 32 + 16 * nt + l15] = bf1(accg[nt][rg]);
        }
#undef G_ISSUE
    }
#undef RW_SH8
    __syncthreads();
}

constexpr int CC_BK = 0, CC_AR = 4608, CC_BBT = 9216, CC_KBT = 11776, CC_VT = 14336, CC_GC = 16896, CC_TT = 17152, CC_SLOT = 18432, CC_NSLOT = 6, CC_NBUILD = 6;
constexpr int CC_STG = CC_SLOT * CC_NSLOT;
constexpr int CC_MIX = CC_STG + CC_NBUILD * 4096;
constexpr int CC_FLAGS = CC_MIX + 448 * 4;
static_assert(CC_FLAGS + 64 <= 146432, "rwkv chain LDS map");
__device__ __forceinline__ void rwkv_phase_chain(LAS float* smf, int tid, int lane, int wave, int blk, const bf16_t* __restrict__ proj, const float* __restrict__ mix, const float* __restrict__ w0, const float* __restrict__ a0,
                                           const float* __restrict__ k_k, const float* __restrict__ k_a, const float* __restrict__ r_k, const bf16_t* __restrict__ W2T, const bf16_t* __restrict__ A2T, const bf16_t* __restrict__ G2T,
                                           float* __restrict__ yraw, bf16_t* __restrict__ gout, float* __restrict__ bonus_out) {
    LAS unsigned char* lds = (LAS unsigned char*)smf;
    LAS float* mixs = (LAS float*)(lds + CC_MIX);
    volatile LAS unsigned* flags = (volatile LAS unsigned*)(lds + CC_FLAGS);
    const int chain = blk, b = chain >> 3, h = chain & 7, l15 = lane & 15, kg = lane >> 4, l31 = lane & 31, hi = lane >> 5;
    const size_t rowb = (size_t)b * SEQ;
    constexpr int NCH = SEQ / 16;
    if (tid < 256) mixs[tid] = mix[1536 + tid];
    else if (tid < 448) { const int q = tid - 256; mixs[tid] = mix[512 * (q >> 6) + h * 64 + (q & 63)]; }
    if (tid < 16) flags[tid] = (tid == 10) ? (unsigned)CC_NBUILD : 0u;
    for (int q = tid; q < CC_NSLOT * 320; q += NWAVES * 64) *(LAS unsigned*)(lds + (q / 320) * CC_SLOT + CC_TT + (q % 320) * 4) = 0u;
    __syncthreads();
#define RW_SH8(CUR, PRV, M0, M1, OUT, PZ) do { const unsigned cu_[4] = {(CUR).x, (CUR).y, (CUR).z, (CUR).w}, pu_[4] = {(PRV).x, (PRV).y, (PRV).z, (PRV).w}; \
        const float mm_[8] = {(M0)[0], (M0)[1], (M0)[2], (M0)[3], (M1)[0], (M1)[1], (M1)[2], (M1)[3]}; \
        _Pragma("unroll") for (int q = 0; q < 4; ++q) { const float c0 = bflo(cu_[q]), c1 = bfhi(cu_[q]), p0 = bflo(pu_[q]) * (PZ), p1 = bfhi(pu_[q]) * (PZ); \
            OUT[2 * q] = c0 + (p0 - c0) * mm_[2 * q]; OUT[2 * q + 1] = c1 + (p1 - c1) * mm_[2 * q + 1]; } } while (0)
    if (wave < 2) {
        const int ihalf = wave;
        f32x16 ST[2];
#pragma unroll
        for (int r = 0; r < 16; ++r) { ST[0][r] = 0.f; ST[1][r] = 0.f; }
#pragma unroll 1
        for (int k = 0; k < NCH; ++k) {
            { const unsigned want = (unsigned)(k + 1); const int sl = k % CC_NSLOT; while (flags[sl] != want) __builtin_amdgcn_s_sleep(1); }
            asm volatile("" ::: "memory");
            const LAS unsigned char* im = lds + (k % CC_NSLOT) * CC_SLOT;
            f32x16 G;
#pragma unroll
            for (int r = 0; r < 16; ++r) G[r] = 0.f;
#pragma unroll
            for (int kk = 0; kk < 4; ++kk) { const bf16x8 fa = *(const LAS bf16x8*)(im + CC_BK + l31 * 144 + (16 * kk + 8 * hi) * 2), fb = *(const LAS bf16x8*)(im + CC_AR + l31 * 144 + (16 * kk + 8 * hi) * 2); G = MFMA32(fa, fb, G); }
            { const int tcol = l31 & 15; const bool strict = l31 < 16;
#pragma unroll
              for (int r = 0; r < 16; ++r) { const int srow = crow(r & 7, hi); const bool keep = strict ? (srow < tcol) : (srow <= tcol); G[r] = keep ? G[r] : 0.f; } }
            const bf16x8 gB = pack8(G[0], G[1], G[2], G[3], G[4], G[5], G[6], G[7]), gK = pack8(G[8], G[9], G[10], G[11], G[12], G[13], G[14], G[15]);
            f32x16 XT;
#pragma unroll
            for (int r = 0; r < 16; ++r) XT[r] = 0.f;
#pragma unroll
            for (int jt = 0; jt < 2; ++jt)
#pragma unroll
                for (int sp = 0; sp < 2; ++sp) { const LAS unsigned char* ap = im + CC_AR + l31 * 144 + (32 * jt + 16 * sp + 4 * hi) * 2;
                    const u32x2 x0 = *(const LAS u32x2*)ap, x1 = *(const LAS u32x2*)(ap + 16); v4u aw; aw.x = x0.x; aw.y = x0.y; aw.z = x1.x; aw.w = x1.y;
                    const bf16x8 sb_ = pack8(ST[jt][8 * sp], ST[jt][8 * sp + 1], ST[jt][8 * sp + 2], ST[jt][8 * sp + 3], ST[jt][8 * sp + 4], ST[jt][8 * sp + 5], ST[jt][8 * sp + 6], ST[jt][8 * sp + 7]);
                    XT = MFMA32(__builtin_bit_cast(bf16x8, aw), sb_, XT); }
            bf16x8 vP;
            { const LAS unsigned char* vp = im + CC_VT + (32 * ihalf + l31) * 40 + (4 * hi) * 2; const u32x2 x0 = *(const LAS u32x2*)vp, x1 = *(const LAS u32x2*)(vp + 16); v4u vw; vw.x = x0.x; vw.y = x0.y; vw.z = x1.x; vw.w = x1.y;
              vP = __builtin_bit_cast(bf16x8, vw); XT = MFMA32(gK, vP, XT); }
            bf16x8 uP;
            { const LAS unsigned char* tp = im + CC_TT + l31 * 40 + (4 * hi) * 2; const u32x2 x0 = *(const LAS u32x2*)tp, x1 = *(const LAS u32x2*)(tp + 16); v4u tw; tw.x = x0.x; tw.y = x0.y; tw.z = x1.x; tw.w = x1.y;
              f32x16 UT;
#pragma unroll
              for (int r = 0; r < 16; ++r) UT[r] = 0.f;
              UT = MFMA32(__builtin_bit_cast(bf16x8, tw), pack8(XT[0], XT[1], XT[2], XT[3], XT[4], XT[5], XT[6], XT[7]), UT);
              uP = pack8(UT[0], UT[1], UT[2], UT[3], UT[4], UT[5], UT[6], UT[7]); }
            XT = MFMA32(gB, uP, XT);
            { float* yp = yraw + (rowb + 16 * k) * 512 + h * 64 + 32 * ihalf + l31;
#pragma unroll
              for (int q = 0; q < 8; ++q) yp[(size_t)crow(q, hi) * 512] = XT[8 + q]; }
            { const LAS float* gc = (const LAS float*)(im + CC_GC);
#pragma unroll
              for (int jt = 0; jt < 2; ++jt)
#pragma unroll
                  for (int r = 0; r < 16; ++r) ST[jt][r] *= gc[32 * jt + crow(r, hi)]; }
#pragma unroll
            for (int jt = 0; jt < 2; ++jt) { const LAS unsigned char* bp = im + CC_BBT + (32 * jt + l31) * 40 + (4 * hi) * 2; const LAS unsigned char* kp = im + CC_KBT + (32 * jt + l31) * 40 + (4 * hi) * 2;
                const u32x2 b0 = *(const LAS u32x2*)bp, b1 = *(const LAS u32x2*)(bp + 16), k0 = *(const LAS u32x2*)kp, k1 = *(const LAS u32x2*)(kp + 16);
                v4u a1; a1.x = b0.x; a1.y = b0.y; a1.z = b1.x; a1.w = b1.y; v4u a2; a2.x = k0.x; a2.y = k0.y; a2.z = k1.x; a2.w = k1.y;
                ST[jt] = MFMA32(__builtin_bit_cast(bf16x8, a1), uP, ST[jt]); ST[jt] = MFMA32(__builtin_bit_cast(bf16x8, a2), vP, ST[jt]); }
            WSYNC();
            if (lane == 0) flags[8 + ihalf] = (unsigned)(k + 1);
        }
    } else {
        const int pw = wave - 2;
        LAS bf16_t* stg = (LAS bf16_t*)(lds + CC_STG) + pw * 2048;
        v4u ld[20];
#define CC_ISSUE_A(T0) do { const int t0_ = (T0); const size_t r_ = rowb + t0_ + l15; const size_t rp_ = (t0_ + l15 == 0) ? r_ : r_ - 1; \
            _Pragma("unroll") for (int lo = 0; lo < 2; ++lo) _Pragma("unroll") for (int ks = 0; ks < 2; ++ks) { const int col = 1536 + 64 * lo + 32 * ks + 8 * kg; \
                ld[(lo * 2 + ks) * 2] = *(const v4u*)(proj + r_ * L0P + col); ld[(lo * 2 + ks) * 2 + 1] = *(const v4u*)(proj + rp_ * L0P + col); } } while (0)
#define CC_ISSUE_B(T0) do { const int t0_ = (T0); \
            _Pragma("unroll") for (int ar = 0; ar < 3; ++ar) _Pragma("unroll") for (int i = 0; i < 2; ++i) { const int p_ = lane + 64 * i, row_ = p_ >> 3, c8_ = p_ & 7; \
                const size_t r_ = rowb + t0_ + row_; const size_t rp_ = (t0_ + row_ == 0) ? r_ : r_ - 1; const int col = 512 * ar + h * 64 + 8 * c8_; \
                ld[8 + (ar * 2 + i) * 2] = *(const v4u*)(proj + r_ * L0P + col); ld[8 + (ar * 2 + i) * 2 + 1] = *(const v4u*)(proj + rp_ * L0P + col); } } while (0)
#define CC_ISSUE(T0) do { CC_ISSUE_A(T0); CC_ISSUE_B(T0); } while (0)
        CC_ISSUE(16 * pw);
        int k = pw;
#pragma unroll 1
        while (k < NCH) {
            const int t0 = 16 * k; int kn;
            f32x4 accw[4], acca[4];
#pragma unroll
            for (int nt = 0; nt < 4; ++nt) { accw[nt] = (f32x4){0.f, 0.f, 0.f, 0.f}; acca[nt] = (f32x4){0.f, 0.f, 0.f, 0.f}; }
            { const float pz_ = (t0 + l15 == 0) ? 0.f : 1.f;
#pragma unroll
              for (int lo = 0; lo < 2; ++lo)
#pragma unroll
                for (int ks = 0; ks < 2; ++ks) { float s_[8];
                    const f32x4 m0 = *(const LAS f32x4*)(mixs + 64 * lo + 32 * ks + 8 * kg), m1 = *(const LAS f32x4*)(mixs + 64 * lo + 32 * ks + 8 * kg + 4);
                    RW_SH8(ld[(lo * 2 + ks) * 2], ld[(lo * 2 + ks) * 2 + 1], m0, m1, s_, pz_);
                    if (lo == 0) {
#pragma unroll
                        for (int j = 0; j < 8; ++j) s_[j] = tanh_fast(s_[j]); }
                    const bf16x8 af = pack8(s_[0], s_[1], s_[2], s_[3], s_[4], s_[5], s_[6], s_[7]);
                    const bf16_t* WT = lo ? A2T : W2T;
#pragma unroll
                    for (int nt = 0; nt < 4; ++nt) { const bf16x8 bfr = *(const bf16x8*)(WT + (size_t)(h * 64 + 16 * nt + l15) * 64 + 32 * ks + 8 * kg);
                        if (lo == 0) accw[nt] = MFMA16(af, bfr, accw[nt]); else acca[nt] = MFMA16(af, bfr, acca[nt]); } } }
            { const int need = k - (CC_NSLOT - 1); if (need > 0) { while ((int)flags[8] < need || (int)flags[9] < need) __builtin_amdgcn_s_sleep(2); } }
            asm volatile("" ::: "memory");
            LAS unsigned char* im = lds + (k % CC_NSLOT) * CC_SLOT;
#pragma unroll
            for (int ar = 0; ar < 3; ++ar)
#pragma unroll
                for (int i = 0; i < 2; ++i) { const int p_ = lane + 64 * i, row_ = p_ >> 3, c8_ = p_ & 7; float s_[8];
                    const float pz_ = (t0 + row_ == 0) ? 0.f : 1.f; const f32x4 m0 = *(const LAS f32x4*)(mixs + 256 + ar * 64 + c8_ * 8), m1 = *(const LAS f32x4*)(mixs + 256 + ar * 64 + c8_ * 8 + 4);
                    RW_SH8(ld[8 + (ar * 2 + i) * 2], ld[8 + (ar * 2 + i) * 2 + 1], m0, m1, s_, pz_);
                    if (ar < 2) *(LAS bf16x8*)(stg + ar * 1024 + row_ * 64 + c8_ * 8) = pack8(s_[0], s_[1], s_[2], s_[3], s_[4], s_[5], s_[6], s_[7]);
                    else {
#pragma unroll
                        for (int j = 0; j < 8; ++j) *(LAS bf16_t*)(im + CC_VT + (c8_ * 8 + j) * 40 + row_ * 2) = bf1(s_[j]); } }
            WSYNC();
            float lwv[4][4], av[4][4], knv[4][4];
            float w0c[4], a0c[4], kkc[4], kac[4], rkc[4];
#pragma unroll
            for (int nt = 0; nt < 4; ++nt) { const int c = h * 64 + 16 * nt + l15; w0c[nt] = w0[c]; a0c[nt] = a0[c]; kkc[nt] = k_k[c]; kac[nt] = k_a[c]; rkc[nt] = r_k[c]; }
#pragma unroll
            for (int rg = 0; rg < 4; ++rg) { const int tl = 4 * kg + rg;
                float kkv[4], nrm2 = 0.f, rr_[4], kr_[4];
#pragma unroll
                for (int nt = 0; nt < 4; ++nt) { rr_[nt] = bf2f(stg[tl * 64 + 16 * nt + l15]); kr_[nt] = bf2f(stg[1024 + tl * 64 + 16 * nt + l15]);
                    kkv[nt] = kr_[nt] * kkc[nt]; nrm2 += kkv[nt] * kkv[nt]; }
                nrm2 = rowsum16(nrm2); const float rn = __builtin_amdgcn_rsqf(fmaxf(nrm2, 1e-24f));
                float bon = 0.f;
#pragma unroll
                for (int nt = 0; nt < 4; ++nt) {
                    const float wsum = w0c[nt] + accw[nt][rg]; lwv[nt][rg] = -0.6065306597126334f * sigmoid_fast(wsum);
                    const float a_ = sigmoid_fast(a0c[nt] + acca[nt][rg]); av[nt][rg] = a_; knv[nt][rg] = kkv[nt] * rn;
                    const float k2 = kr_[nt] * (1.f + (a_ - 1.f) * kac[nt]); stg[1024 + tl * 64 + 16 * nt + l15] = bf1(k2);
                    bon += rr_[nt] * k2 * rkc[nt];
                }
                bon = rowsum16(bon);
                if (l15 == 0) bonus_out[(rowb + t0 + tl) * 8 + h] = bon;
            }
            { unsigned g_ = 0; if (lane == 0) g_ = __hip_atomic_fetch_add((LAS unsigned*)(lds + CC_FLAGS + 40), 1u, __ATOMIC_RELAXED, __HIP_MEMORY_SCOPE_WORKGROUP);
              kn = (int)__builtin_amdgcn_readfirstlane(g_); }
            CC_ISSUE_A((kn < NCH) ? 16 * kn : t0);
#pragma unroll
            for (int nt = 0; nt < 4; ++nt) {
                float L[4]; L[0] = lwv[nt][0]; L[1] = L[0] + lwv[nt][1]; L[2] = L[1] + lwv[nt][2]; L[3] = L[2] + lwv[nt][3];
                const float T0 = __shfl(L[3], l15), T1 = __shfl(L[3], 16 + l15), T2 = __shfl(L[3], 32 + l15), T3 = __shfl(L[3], 48 + l15);
                const float off = (kg > 0 ? T0 : 0.f) + (kg > 1 ? T1 : 0.f) + (kg > 2 ? T2 : 0.f), LC = (T0 + T1) + (T2 + T3);
                const int j = 16 * nt + l15;
                unsigned bb2[2], kb2[2];
                const float gC = __expf(LC); float eprev = __expf(off);
#pragma unroll
                for (int rg = 0; rg < 4; ++rg) { const int tl = 4 * kg + rg; const float Lt = off + L[rg], e1 = __expf(Lt), e2 = __builtin_amdgcn_rcpf(e1), e3 = eprev, e4 = gC * e2; eprev = e1;
                    const float kn = knv[nt][rg], bvv = kn * av[nt][rg], k2 = bf2f(stg[1024 + tl * 64 + j]), rr2 = bf2f(stg[tl * 64 + j]);
                    *(LAS bf16_t*)(im + CC_BK + tl * 144 + j * 2) = bf1(bvv * e2); *(LAS bf16_t*)(im + CC_BK + (16 + tl) * 144 + j * 2) = bf1(k2 * e2);
                    *(LAS bf16_t*)(im + CC_AR + tl * 144 + j * 2) = bf1(-kn * e3); *(LAS bf16_t*)(im + CC_AR + (16 + tl) * 144 + j * 2) = bf1(rr2 * e1);
                    const unsigned bq = bf1(bvv * e4), kq = bf1(k2 * e4);
                    if (rg & 1) { bb2[rg >> 1] |= bq << 16; kb2[rg >> 1] |= kq << 16; } else { bb2[rg >> 1] = bq; kb2[rg >> 1] = kq; } }
                *(LAS u32x2*)(im + CC_BBT + j * 40 + (4 * kg) * 2) = (u32x2){bb2[0], bb2[1]}; *(LAS u32x2*)(im + CC_KBT + j * 40 + (4 * kg) * 2) = (u32x2){kb2[0], kb2[1]};
                if (kg == 0) *(LAS float*)(im + CC_GC + j * 4) = gC;
            }
            WSYNC();
            {
                f32x4 nacc = {0.f, 0.f, 0.f, 0.f};
#pragma unroll
                for (int ks = 0; ks < 2; ++ks) { const bf16x8 fa = *(const LAS bf16x8*)(im + CC_BK + l15 * 144 + (32 * ks + 8 * kg) * 2), fb = *(const LAS bf16x8*)(im + CC_AR + l15 * 144 + (32 * ks + 8 * kg) * 2); nacc = MFMA16(fa, fb, nacc); }
#pragma unroll
                for (int rg = 0; rg < 4; ++rg) nacc[rg] = ((4 * kg + rg) < l15) ? nacc[rg] : 0.f;
                float Tr[16];
#pragma unroll
                for (int t = 0; t < 16; ++t) { float acc_ = (l15 == t) ? 1.f : 0.f;
#pragma unroll
                    for (int s2 = 0; s2 < t; ++s2) acc_ += Tr[s2] * rl(nacc[s2 & 3], t + 16 * (s2 >> 2));
                    Tr[t] = acc_; }
                if (kg == 0) {
#pragma unroll
                    for (int t = 0; t < 16; ++t) *(LAS bf16_t*)(im + CC_TT + t * 40 + l15 * 2) = bf1(Tr[t]); }
            }
            WSYNC();
            if (lane == 0) flags[k % CC_NSLOT] = (unsigned)(k + 1);
            CC_ISSUE_B((kn < NCH) ? 16 * kn : t0);
            k = kn;
        }
#undef CC_ISSUE
#undef CC_ISSUE_A
#undef CC_ISSUE_B
    }
#undef RW_SH8
    __syncthreads();
}


__device__ __forceinline__ void gate_lora_task(int chain, int k, int lane, const bf16_t* __restrict__ proj, const float* __restrict__ mix, const bf16_t* __restrict__ G2T, bf16_t* __restrict__ gout) {
    const int b = chain >> 3, h = chain & 7, l15 = lane & 15, kg = lane >> 4, t0 = 16 * k;
    const size_t rowb = (size_t)b * SEQ, r_ = rowb + t0 + l15, rp_ = (t0 + l15 == 0) ? r_ : r_ - 1;
    const float pz_ = (t0 + l15 == 0) ? 0.f : 1.f;
    v4u cu[4], pv[4];
#pragma unroll
    for (int ks = 0; ks < 4; ++ks) { const int col = 1664 + 32 * ks + 8 * kg; cu[ks] = *(const v4u*)(proj + r_ * L0P + col); pv[ks] = *(const v4u*)(proj + rp_ * L0P + col); }
    f32x4 accg[4];
#pragma unroll
    for (int nt = 0; nt < 4; ++nt) accg[nt] = (f32x4){0.f, 0.f, 0.f, 0.f};
#pragma unroll
    for (int ks = 0; ks < 4; ++ks) {
        const f32x4 m0 = *(const f32x4*)(mix + 1664 + 32 * ks + 8 * kg), m1 = *(const f32x4*)(mix + 1664 + 32 * ks + 8 * kg + 4);
        const float mm[8] = {m0[0], m0[1], m0[2], m0[3], m1[0], m1[1], m1[2], m1[3]};
        const unsigned cw[4] = {cu[ks].x, cu[ks].y, cu[ks].z, cu[ks].w}, pw[4] = {pv[ks].x, pv[ks].y, pv[ks].z, pv[ks].w};
        float s_[8];
#pragma unroll
        for (int q = 0; q < 4; ++q) { const float c0 = bflo(cw[q]), c1 = bfhi(cw[q]), p0 = bflo(pw[q]) * pz_, p1 = bfhi(pw[q]) * pz_;
            s_[2 * q] = sigmoid_fast(c0 + (p0 - c0) * mm[2 * q]); s_[2 * q + 1] = sigmoid_fast(c1 + (p1 - c1) * mm[2 * q + 1]); }
        const bf16x8 af = pack8(s_[0], s_[1], s_[2], s_[3], s_[4], s_[5], s_[6], s_[7]);
#pragma unroll
        for (int nt = 0; nt < 4; ++nt) { const bf16x8 bfr = *(const bf16x8*)(G2T + (size_t)(h * 64 + 16 * nt + l15) * 128 + 32 * ks + 8 * kg); accg[nt] = MFMA16(af, bfr, accg[nt]); }
    }
#pragma unroll
    for (int nt = 0; nt < 4; ++nt)
#pragma unroll
        for (int rg = 0; rg < 4; ++rg) gout[(rowb + t0 + 4 * kg + rg) * 512 + h * 64 + 16 * nt + l15] = bf1(accg[nt][rg]);
}


__device__ __forceinline__ void gate_lora_wave(int first, int stride, int lane, const bf16_t* __restrict__ proj, const float* __restrict__ mix, const bf16_t* __restrict__ G2T, bf16_t* __restrict__ gout) {
    const int l15 = lane & 15, kg = lane >> 4, h = (first >> 7) & 7;
    bf16x8 bfr[4][4];
#pragma unroll
    for (int ks = 0; ks < 4; ++ks)
#pragma unroll
        for (int nt = 0; nt < 4; ++nt) bfr[ks][nt] = *(const bf16x8*)(G2T + (size_t)(h * 64 + 16 * nt + l15) * 128 + 32 * ks + 8 * kg);
    float mm[4][8];
#pragma unroll
    for (int ks = 0; ks < 4; ++ks) { const f32x4 m0 = *(const f32x4*)(mix + 1664 + 32 * ks + 8 * kg), m1 = *(const f32x4*)(mix + 1664 + 32 * ks + 8 * kg + 4);
        mm[ks][0] = m0[0]; mm[ks][1] = m0[1]; mm[ks][2] = m0[2]; mm[ks][3] = m0[3]; mm[ks][4] = m1[0]; mm[ks][5] = m1[1]; mm[ks][6] = m1[2]; mm[ks][7] = m1[3]; }
    v4u cu[4], pv[4];
#define GL_LOAD(TK) do { const int ch_ = (TK) >> 7, t0_ = 16 * ((TK) & 127); const size_t r_ = (size_t)(ch_ >> 3) * SEQ + t0_ + l15, rp_ = (t0_ + l15 == 0) ? r_ : r_ - 1; \
        _Pragma("unroll") for (int ks = 0; ks < 4; ++ks) { const int col = 1664 + 32 * ks + 8 * kg; cu[ks] = *(const v4u*)(proj + r_ * L0P + col); pv[ks] = *(const v4u*)(proj + rp_ * L0P + col); } } while (0)
    GL_LOAD(first);
#pragma unroll 1
    for (int tk = first; tk < 128 * 128; tk += stride) {
        const int chain = tk >> 7, t0 = 16 * (tk & 127); const size_t rowb = (size_t)(chain >> 3) * SEQ;
        const float pz_ = (t0 + l15 == 0) ? 0.f : 1.f;
        f32x4 accg[4];
#pragma unroll
        for (int nt = 0; nt < 4; ++nt) accg[nt] = (f32x4){0.f, 0.f, 0.f, 0.f};
        bf16x8 af[4];
#pragma unroll
        for (int ks = 0; ks < 4; ++ks) { const unsigned cw[4] = {cu[ks].x, cu[ks].y, cu[ks].z, cu[ks].w}, pw[4] = {pv[ks].x, pv[ks].y, pv[ks].z, pv[ks].w}; float s_[8];
#pragma unroll
            for (int q = 0; q < 4; ++q) { const float c0 = bflo(cw[q]), c1 = bfhi(cw[q]), p0 = bflo(pw[q]) * pz_, p1 = bfhi(pw[q]) * pz_;
                s_[2 * q] = sigmoid_fast(c0 + (p0 - c0) * mm[ks][2 * q]); s_[2 * q + 1] = sigmoid_fast(c1 + (p1 - c1) * mm[ks][2 * q + 1]); }
            af[ks] = pack8(s_[0], s_[1], s_[2], s_[3], s_[4], s_[5], s_[6], s_[7]); }
        { const int tn = (tk + stride < 128 * 128) ? tk + stride : tk; GL_LOAD(tn); }
#pragma unroll
        for (int ks = 0; ks < 4; ++ks)
#pragma unroll
            for (int nt = 0; nt < 4; ++nt) accg[nt] = MFMA16(af[ks], bfr[ks][nt], accg[nt]);
#pragma unroll
        for (int nt = 0; nt < 4; ++nt)
#pragma unroll
            for (int rg = 0; rg < 4; ++rg) gout[(rowb + t0 + 4 * kg + rg) * 512 + h * 64 + 16 * nt + l15] = bf1(accg[nt][rg]);
    }
#undef GL_LOAD
}

template <bool ST = true> __device__ __forceinline__ void rwkv_post_all(const float* __restrict__ yraw, const bf16_t* __restrict__ proj, const float* __restrict__ mix, const float* __restrict__ bonus, const bf16_t* __restrict__ gbuf,
                                              const float* __restrict__ ln_g, const float* __restrict__ ln_b, bf16_t* __restrict__ ymix, int gw, int NGW, int lane) {
    for (int m = gw; m < M; m += NGW) {
        const bool has_prev = (m & (SEQ - 1)) != 0;
        float y[8], cv[8], pv[8], gg[8], bo[8];
#pragma unroll
        for (int h = 0; h < 8; ++h) { const int c = h * 64 + lane; y[h] = yraw[(size_t)m * 512 + c]; cv[h] = bf2f(proj[(size_t)m * L0P + 1024 + c]);
            pv[h] = bf2f(proj[(size_t)(has_prev ? m - 1 : m) * L0P + 1024 + c]); gg[h] = bf2f(gbuf[(size_t)m * 512 + c]); bo[h] = bonus[(size_t)m * 8 + h]; }
#pragma unroll
        for (int h = 0; h < 8; ++h) { const int c = h * 64 + lane;
            const float mu = wave_sum_dpp(y[h]) * (1.f / 64.f), d = y[h] - mu, var = wave_sum_dpp(d * d) * (1.f / 64.f);
            const float yn = d * __builtin_amdgcn_rsqf(var + 64e-5f) * ln_g[c] + ln_b[c];
            const float pvv = has_prev ? pv[h] : 0.f;
            const float v_s = cv[h] + (pvv - cv[h]) * mix[1024 + c];
            const float o = (yn + bo[h] * v_s) * gg[h];
            if (ST) ymix[(size_t)m * DM + c] = bf1(o); else asm volatile("" :: "v"(o)); }
    }
}


__device__ __forceinline__ void ssd_conv_tile(int it, int lane, LAS bf16_t* scr, const bf16_t* __restrict__ proj, const float* __restrict__ cw, const float* __restrict__ cb,
                                              bf16_t* __restrict__ xbc, bf16_t* __restrict__ xst, bf16_t* __restrict__ bt) {
    const int tt = it >> 4, ct = it & 15, m0 = tt * 64, b = m0 >> 11, t0 = m0 & (SEQ - 1), c = ct * 64 + lane;
    const float w0 = cw[c], w1 = cw[1024 + c], w2 = cw[2048 + c], w3 = cw[3072 + c], bias = cb[c];
    const bf16_t* src = proj + (size_t)m0 * L0P + 2304 + c;
    bf16_t raw[67];
    const int lo = (t0 > 0) ? -3 : 0;
#pragma unroll
    for (int t = -3; t < 64; ++t) raw[t + 3] = src[(ptrdiff_t)((t < lo) ? lo : t) * L0P];
    float u3 = (t0 > 0) ? bf2f(raw[0]) : 0.f, u2 = (t0 > 0) ? bf2f(raw[1]) : 0.f, u1 = (t0 > 0) ? bf2f(raw[2]) : 0.f;
#pragma unroll
    for (int t = 0; t < 64; ++t) {
        const float u = bf2f(raw[t + 3]);
        const float y = bias + w0 * u3 + w1 * u2 + w2 * u1 + w3 * u;
        const bf16_t o = bf1(y * __builtin_amdgcn_rcpf(1.f + __expf(-y)));
        xbc[(size_t)(m0 + t) * 1024 + c] = o;
        scr[t * STG_PITCH + lane] = o;
        u3 = u2; u2 = u1; u1 = u;
    }
    WSYNC();
    if (ct < 12) {
        bf16_t* dst = (ct < 8) ? xst + ((size_t)(b * 8 + ct) * 64) * SEQ + t0 : bt + ((size_t)(b * 2 + ((ct - 8) >> 1)) * 128 + ((ct - 8) & 1) * 64) * SEQ + t0;
#pragma unroll
        for (int i = 0; i < 8; ++i) { const int d = i * 8 + (lane >> 3), tc = lane & 7; const LAS bf16_t* p = scr + (tc * 8) * STG_PITCH + d;
            v4u o; o.x = (unsigned)p[0] | ((unsigned)p[STG_PITCH] << 16); o.y = (unsigned)p[2 * STG_PITCH] | ((unsigned)p[3 * STG_PITCH] << 16);
            o.z = (unsigned)p[4 * STG_PITCH] | ((unsigned)p[5 * STG_PITCH] << 16); o.w = (unsigned)p[6 * STG_PITCH] | ((unsigned)p[7 * STG_PITCH] << 16);
            *(v4u*)(dst + (size_t)d * SEQ + tc * 8) = o; }
    }
    WSYNC();
}
__device__ __forceinline__ float bperm(int srclane, float x) { return __builtin_bit_cast(float, __builtin_amdgcn_ds_bpermute(srclane << 2, __builtin_bit_cast(int, x))); }
__device__ __forceinline__ void scan128(float& x0, float& x1, int lane) {
#pragma unroll
    for (int o = 1; o < 64; o <<= 1) { const int sl = (lane >= o) ? lane - o : lane; const float t0 = bperm(sl, x0), t1 = bperm(sl, x1); if (lane >= o) { x0 += t0; x1 += t1; } }
    x1 += rl(x0, 63);
}

__device__ __forceinline__ void ssd_s3_block(int bc, int tid, int lane, int wave, LAS unsigned char* lds, const bf16_t* __restrict__ xbc, const bf16_t* __restrict__ xst, const bf16_t* __restrict__ stb,
                                             const float* __restrict__ dt, const float* __restrict__ a_log, const float* __restrict__ dsk, bf16_t* __restrict__ yssm) {
    const int b = bc >> 4, c = bc & 15, h = wave, g = h >> 2, l0 = c * 128, l31 = lane & 31, hi = lane >> 5, unit = bc * 8 + h;
    const size_t m0 = (size_t)b * SEQ + l0;
    __syncthreads();
    {
        const int mat = lane >> 4, ch = lane & 15;
        v4u rr[16];
#pragma unroll
        for (int i = 0; i < 16; ++i) rr[i] = *(const v4u*)(xbc + (m0 + wave * 16 + i) * 1024 + 512 + lane * 8);
#pragma unroll
        for (int i = 0; i < 16; ++i) { const int row = wave * 16 + i; *(LAS v4u*)(lds + mat * 34816 + row * 272 + ch * 16) = rr[i]; }
    }
#define S3TAB(i) (*(LAS float*)(lds + ((wave * 64) + ((i) >> 2)) * 272 + 256 + ((i) & 3) * 4))
    const float A = -expf(a_log[h]), D = dsk[h];
    { const float d0 = dt[(m0 + lane) * 8 + h], d1 = dt[(m0 + 64 + lane) * 8 + h];
      float ac0 = d0 * A, ac1 = d1 * A;
      scan128(ac0, ac1, lane);
      S3TAB(lane) = ac0; S3TAB(64 + lane) = ac1; S3TAB(128 + lane) = d0; S3TAB(192 + lane) = d1; }
    u32x2 xf[4][2][2][2];
    const bf16_t* Sp = stb + (size_t)unit * 8192 + l31 * 128 + 8 * hi;
    { const bf16_t* Xp = xst + ((size_t)(b * 8 + h) * 64 + l31) * SEQ + l0 + 4 * hi;
#pragma unroll
      for (int st = 0; st < 4; ++st)
#pragma unroll
          for (int pt = 0; pt < 2; ++pt)
#pragma unroll
              for (int ks = 0; ks < 2; ++ks) { const bf16_t* xp = Xp + (size_t)pt * 32 * SEQ + st * 32 + 16 * ks; xf[st][pt][ks][0] = *(const u32x2*)xp; xf[st][pt][ks][1] = *(const u32x2*)(xp + 8); } }
    __syncthreads();
    const LAS unsigned char* Bl = lds + g * 34816 + 16 * hi;
    const LAS unsigned char* Cl = lds + (2 + g) * 34816 + 16 * hi;
#pragma unroll 1
    for (int lt = 0; lt < 4; ++lt) {
        asm volatile("" ::: "memory");
        f32x16 y[2];
#pragma unroll
        for (int r = 0; r < 16; ++r) { y[0][r] = 0.f; y[1][r] = 0.f; }
        const float acl = S3TAB(32 * lt + l31);
        const int crw = 32 * lt + l31;
        { bf16x8 sfr[2][8];
#pragma unroll
          for (int pt = 0; pt < 2; ++pt)
#pragma unroll
              for (int kk = 0; kk < 8; ++kk) sfr[pt][kk] = *(const bf16x8*)(Sp + pt * 32 * 128 + 16 * kk);
#pragma unroll
          for (int kk = 0; kk < 8; ++kk) { const bf16x8 cf = *(const LAS bf16x8*)(Cl + crw * 272 + 32 * kk); y[0] = MFMA32(sfr[0][kk], cf, y[0]); y[1] = MFMA32(sfr[1][kk], cf, y[1]); } }
        { const float el = __expf(acl);
#pragma unroll
          for (int r = 0; r < 16; ++r) { y[0][r] *= el; y[1][r] *= el; } }
        u32x2 xd[2][4];
#pragma unroll
        for (int pt = 0; pt < 2; ++pt)
#pragma unroll
            for (int q = 0; q < 4; ++q) xd[pt][q] = *(const u32x2*)(xbc + (m0 + crw) * 1024 + h * 64 + 32 * pt + 8 * q + 4 * hi);
#pragma unroll
        for (int st = 0; st < 4; ++st) if (st <= lt) {
            const int brw = 32 * st + l31;
            f32x16 cbt;
#pragma unroll
            for (int r = 0; r < 16; ++r) cbt[r] = 0.f;
#pragma unroll
            for (int kk = 0; kk < 8; ++kk) { const bf16x8 bf_ = *(const LAS bf16x8*)(Bl + brw * 272 + 32 * kk), cf_ = *(const LAS bf16x8*)(Cl + crw * 272 + 32 * kk); cbt = MFMA32(bf_, cf_, cbt); }
#pragma unroll
            for (int r = 0; r < 16; ++r) { const int sl = 32 * st + crow(r, hi); const float acs = S3TAB(sl), dts = S3TAB(128 + sl);
                float v = cbt[r] * __expf(acl - acs) * dts; if (st == lt && crow(r, hi) > l31) v = 0.f; cbt[r] = v; }
            bf16x8 pf[2];
#pragma unroll
            for (int ks = 0; ks < 2; ++ks) pf[ks] = pack8(cbt[8 * ks], cbt[8 * ks + 1], cbt[8 * ks + 2], cbt[8 * ks + 3], cbt[8 * ks + 4], cbt[8 * ks + 5], cbt[8 * ks + 6], cbt[8 * ks + 7]);
#pragma unroll
            for (int pt = 0; pt < 2; ++pt)
#pragma unroll
                for (int ks = 0; ks < 2; ++ks) { v4u a; a.x = xf[st][pt][ks][0].x; a.y = xf[st][pt][ks][0].y; a.z = xf[st][pt][ks][1].x; a.w = xf[st][pt][ks][1].y; y[pt] = MFMA32(__builtin_bit_cast(bf16x8, a), pf[ks], y[pt]); }
        }
#pragma unroll
        for (int pt = 0; pt < 2; ++pt)
#pragma unroll
            for (int q = 0; q < 4; ++q) { const u32x2 xx = xd[pt][q];
                const unsigned o0 = cvtpk(y[pt][4 * q] + D * bflo(xx.x), y[pt][4 * q + 1] + D * bfhi(xx.x)), o1 = cvtpk(y[pt][4 * q + 2] + D * bflo(xx.y), y[pt][4 * q + 3] + D * bfhi(xx.y));
                *(u32x2*)(yssm + (m0 + crw) * 512 + h * 64 + 32 * pt + 8 * q + 4 * hi) = (u32x2){o0, o1}; }
    }
#undef S3TAB
}
__device__ __forceinline__ void ssd_s1_unit(int unit, int lane, LAS float* tab, const bf16_t* __restrict__ xst, const bf16_t* __restrict__ bt, const float* __restrict__ dt, const float* __restrict__ a_log,
                                            float* __restrict__ sloc, float* __restrict__ asum) {
    const int h = unit & 7, c = (unit >> 3) & 15, b = unit >> 7, g = h >> 2, l0 = c * 128, l31 = lane & 31, hi = lane >> 5;
    const size_t m0 = (size_t)b * SEQ + l0;
    const float A = -expf(a_log[h]);
    const float d0 = dt[(m0 + lane) * 8 + h], d1 = dt[(m0 + 64 + lane) * 8 + h];
    float ac0 = d0 * A, ac1 = d1 * A;
    scan128(ac0, ac1, lane);
    const float aend = rl(ac1, 63);
    tab[lane] = __expf(aend - ac0) * d0; tab[64 + lane] = __expf(aend - ac1) * d1;
    if (lane == 0) asum[unit] = aend;
    WSYNC();
    f32x16 acc[2][4];
#pragma unroll
    for (int pt = 0; pt < 2; ++pt)
#pragma unroll
        for (int nt = 0; nt < 4; ++nt)
#pragma unroll
            for (int r = 0; r < 16; ++r) acc[pt][nt][r] = 0.f;
    const bf16_t* Xp = xst + ((size_t)(b * 8 + h) * 64 + l31) * SEQ + l0 + 8 * hi;
    const bf16_t* Bp = bt + ((size_t)(b * 2 + g) * 128 + l31) * SEQ + l0 + 8 * hi;
#pragma unroll 2
    for (int kk = 0; kk < 8; ++kk) {
        const f32x4 wa = *(const LAS f32x4*)(tab + 16 * kk + 8 * hi), wb = *(const LAS f32x4*)(tab + 16 * kk + 8 * hi + 4);
        bf16x8 af[2], bfr[4];
#pragma unroll
        for (int pt = 0; pt < 2; ++pt) { const v4u raw = *(const v4u*)(Xp + (size_t)pt * 32 * SEQ + 16 * kk);
            v4u w; w.x = cvtpk(bflo(raw.x) * wa[0], bfhi(raw.x) * wa[1]); w.y = cvtpk(bflo(raw.y) * wa[2], bfhi(raw.y) * wa[3]);
            w.z = cvtpk(bflo(raw.z) * wb[0], bfhi(raw.z) * wb[1]); w.w = cvtpk(bflo(raw.w) * wb[2], bfhi(raw.w) * wb[3]); af[pt] = __builtin_bit_cast(bf16x8, w); }
#pragma unroll
        for (int nt = 0; nt < 4; ++nt) bfr[nt] = *(const bf16x8*)(Bp + (size_t)nt * 32 * SEQ + 16 * kk);
#pragma unroll
        for (int pt = 0; pt < 2; ++pt)
#pragma unroll
            for (int nt = 0; nt < 4; ++nt) acc[pt][nt] = MFMA32(af[pt], bfr[nt], acc[pt][nt]);
    }
    float* dst = sloc + (size_t)unit * 8192 + l31;
#pragma unroll
    for (int pt = 0; pt < 2; ++pt)
#pragma unroll
        for (int nt = 0; nt < 4; ++nt)
#pragma unroll
            for (int r = 0; r < 16; ++r) dst[(32 * pt + crow(r, hi)) * 128 + 32 * nt] = acc[pt][nt][r];
    WSYNC();
}
__device__ __forceinline__ void ssd_s2_all(const float* __restrict__ sloc, const float* __restrict__ asum, bf16_t* __restrict__ stb, int gtid, int NT) {
    for (int i = gtid; i < 128 * 2048; i += NT) {
        const int bh = i >> 11, e4 = i & 2047, b = bh >> 3, h = bh & 7;
        f32x4 run = {0.f, 0.f, 0.f, 0.f};
#pragma unroll 4
        for (int c = 0; c < 16; ++c) { const int unit = (b * 16 + c) * 8 + h; const f32x4 tmp = *(const f32x4*)(sloc + (size_t)unit * 8192 + e4 * 4);
            uint2 w; w.x = cvtpk(run[0], run[1]); w.y = cvtpk(run[2], run[3]); *(uint2*)(stb + (size_t)unit * 8192 + e4 * 4) = w;
            run = run * __expf(asum[unit]) + tmp; }
    }
}
__device__ __forceinline__ void ssd_s3_unit(int unit, int lane, LAS float* tab, const bf16_t* __restrict__ xbc, const bf16_t* __restrict__ xst, const bf16_t* __restrict__ stb, const float* __restrict__ dt,
                                            const float* __restrict__ a_log, const float* __restrict__ dsk, bf16_t* __restrict__ yssm) {
    const int h = unit & 7, c = (unit >> 3) & 15, b = unit >> 7, g = h >> 2, l0 = c * 128, l31 = lane & 31, hi = lane >> 5;
    const size_t m0 = (size_t)b * SEQ + l0;
    const float A = -expf(a_log[h]), D = dsk[h];
    const float d0 = dt[(m0 + lane) * 8 + h], d1 = dt[(m0 + 64 + lane) * 8 + h];
    float ac0 = d0 * A, ac1 = d1 * A;
    scan128(ac0, ac1, lane);
    tab[lane] = ac0; tab[64 + lane] = ac1; tab[128 + lane] = d0; tab[192 + lane] = d1;
    WSYNC();
    const bf16_t* Cp = xbc + (m0 + l31) * 1024 + 768 + g * 128 + 8 * hi;
    const bf16_t* Sp = stb + (size_t)unit * 8192 + l31 * 128 + 8 * hi;
    const bf16_t* Bp = xbc + (m0 + l31) * 1024 + 512 + g * 128 + 8 * hi;
    const bf16_t* Xp = xst + ((size_t)(b * 8 + h) * 64 + l31) * SEQ + l0 + 4 * hi;
    LAS float* tr = tab + 256;
    const int row = lane >> 1, p0 = (lane & 1) * 16;
#pragma unroll 1
    for (int lt = 0; lt < 4; ++lt) {
        f32x16 y[2];
#pragma unroll
        for (int r = 0; r < 16; ++r) { y[0][r] = 0.f; y[1][r] = 0.f; }
        const float acl = tab[32 * lt + l31];
        bf16x8 cfr[8];
#pragma unroll
        for (int kk = 0; kk < 8; ++kk) cfr[kk] = *(const bf16x8*)(Cp + (size_t)lt * 32 * 1024 + 16 * kk);
        {   bf16x8 s0[8], s1[8];
#pragma unroll
            for (int kk = 0; kk < 8; ++kk) { s0[kk] = *(const bf16x8*)(Sp + 16 * kk); s1[kk] = *(const bf16x8*)(Sp + 32 * 128 + 16 * kk); }
#pragma unroll
            for (int kk = 0; kk < 8; ++kk) { y[0] = MFMA32(s0[kk], cfr[kk], y[0]); y[1] = MFMA32(s1[kk], cfr[kk], y[1]); }
        }
        { const float el = __expf(acl);
#pragma unroll
          for (int r = 0; r < 16; ++r) { y[0][r] *= el; y[1][r] *= el; } }
#pragma unroll 1
        for (int st = 0; st <= lt; ++st) {
            bf16x8 bfr[8]; u32x2 xf[2][2][2];
#pragma unroll
            for (int kk = 0; kk < 8; ++kk) bfr[kk] = *(const bf16x8*)(Bp + (size_t)st * 32 * 1024 + 16 * kk);
#pragma unroll
            for (int pt = 0; pt < 2; ++pt)
#pragma unroll
                for (int ks = 0; ks < 2; ++ks) { const bf16_t* xp = Xp + (size_t)pt * 32 * SEQ + st * 32 + 16 * ks; xf[pt][ks][0] = *(const u32x2*)xp; xf[pt][ks][1] = *(const u32x2*)(xp + 8); }
            f32x16 cbt;
#pragma unroll
            for (int r = 0; r < 16; ++r) cbt[r] = 0.f;
#pragma unroll
            for (int kk = 0; kk < 8; ++kk) cbt = MFMA32(bfr[kk], cfr[kk], cbt);
#pragma unroll
            for (int r = 0; r < 16; ++r) { const int sl = 32 * st + crow(r, hi); const float acs = tab[sl], dts = tab[128 + sl];
                float v = cbt[r] * __expf(acl - acs) * dts; if (st == lt && crow(r, hi) > l31) v = 0.f; cbt[r] = v; }
            bf16x8 pf[2];
#pragma unroll
            for (int ks = 0; ks < 2; ++ks) pf[ks] = pack8(cbt[8 * ks], cbt[8 * ks + 1], cbt[8 * ks + 2], cbt[8 * ks + 3], cbt[8 * ks + 4], cbt[8 * ks + 5], cbt[8 * ks + 6], cbt[8 * ks + 7]);
#pragma unroll
            for (int pt = 0; pt < 2; ++pt)
#pragma unroll
                for (int ks = 0; ks < 2; ++ks) { v4u a; a.x = xf[pt][ks][0].x; a.y = xf[pt][ks][0].y; a.z = xf[pt][ks][1].x; a.w = xf[pt][ks][1].y; y[pt] = MFMA32(__builtin_bit_cast(bf16x8, a), pf[ks], y[pt]); }
        }
#pragma unroll
        for (int pt = 0; pt < 2; ++pt) {
#pragma unroll
            for (int r = 0; r < 16; ++r) tr[l31 * 33 + crow(r, hi)] = y[pt][r];
            WSYNC();
            const size_t m = m0 + 32 * lt + row;
            const v4u xa = *(const v4u*)(xbc + m * 1024 + h * 64 + 32 * pt + p0), xb = *(const v4u*)(xbc + m * 1024 + h * 64 + 32 * pt + p0 + 8);
            const unsigned xu[8] = {xa.x, xa.y, xa.z, xa.w, xb.x, xb.y, xb.z, xb.w};
            unsigned ow[8];
#pragma unroll
            for (int q = 0; q < 8; ++q) { const float v0 = tr[row * 33 + p0 + 2 * q] + D * bflo(xu[q]), v1 = tr[row * 33 + p0 + 2 * q + 1] + D * bfhi(xu[q]); ow[q] = cvtpk(v0, v1); }
            bf16_t* dst = yssm + m * 512 + h * 64 + 32 * pt + p0;
            *(v4u*)dst = (v4u){ow[0], ow[1], ow[2], ow[3]}; *(v4u*)(dst + 8) = (v4u){ow[4], ow[5], ow[6], ow[7]};
            WSYNC();
        }
    }
}


__device__ __forceinline__ float sum8(float x) { x += dpp_mov<0xB1>(x); x += dpp_mov<0x4E>(x); x += dpp_mov<0x141>(x); return x; }
__device__ __forceinline__ float sum32(float x, int lane) { x = rowsum16(x); return x + bperm(lane ^ 16, x); }
__device__ __forceinline__ void unpack8(const v4u& w, float (&f)[8]) { f[0] = bflo(w.x); f[1] = bfhi(w.x); f[2] = bflo(w.y); f[3] = bfhi(w.y); f[4] = bflo(w.z); f[5] = bfhi(w.z); f[6] = bflo(w.w); f[7] = bfhi(w.w); }
__device__ __forceinline__ void ssm_gate_norm_vec(const bf16_t* __restrict__ yssm, const bf16_t* __restrict__ proj, const float* __restrict__ ng, bf16_t* __restrict__ ymix, int m0, int m1, int w, int nw, int lane) {
    const int c0 = lane * 8;
    float gn[8];
    { const f32x4 a = *(const f32x4*)(ng + c0), b = *(const f32x4*)(ng + c0 + 4); gn[0] = a[0]; gn[1] = a[1]; gn[2] = a[2]; gn[3] = a[3]; gn[4] = b[0]; gn[5] = b[1]; gn[6] = b[2]; gn[7] = b[3]; }
    for (int mb = m0 + w; mb < m1; mb += nw * 4) {
        v4u yv[4], zv[4];
#pragma unroll
        for (int k = 0; k < 4; ++k) { const int m = (mb + k * nw < m1) ? mb + k * nw : mb; yv[k] = *(const v4u*)(yssm + (size_t)m * 512 + c0); zv[k] = *(const v4u*)(proj + (size_t)m * L0P + 1792 + c0); }
#pragma unroll
        for (int k = 0; k < 4; ++k) { const int m = mb + k * nw;
            float y[8], z[8], u[8], q = 0.f; unpack8(yv[k], y); unpack8(zv[k], z);
#pragma unroll
            for (int j = 0; j < 8; ++j) { u[j] = y[j] * z[j] * __builtin_amdgcn_rcpf(1.f + __builtin_amdgcn_exp2f(-1.4426950408889634f * z[j])); q += u[j] * u[j]; }
            const float rs = __builtin_amdgcn_rsqf(sum32(q, lane) * (1.f / 256.f) + 1e-5f);
            v4u o; o.x = cvtpk(u[0] * rs * gn[0], u[1] * rs * gn[1]); o.y = cvtpk(u[2] * rs * gn[2], u[3] * rs * gn[3]); o.z = cvtpk(u[4] * rs * gn[4], u[5] * rs * gn[5]); o.w = cvtpk(u[6] * rs * gn[6], u[7] * rs * gn[7]);
            if (m < m1) *(v4u*)(ymix + (size_t)m * DM + 512 + c0) = o; }
    }
}
__device__ __forceinline__ void rwkv_post_vec(const float* __restrict__ yraw, const bf16_t* __restrict__ proj, const float* __restrict__ mix, const float* __restrict__ bonus, const bf16_t* __restrict__ gbuf,
                                              const float* __restrict__ ln_g, const float* __restrict__ ln_b, bf16_t* __restrict__ ymix, int gw, int NGW, int lane) {
    const int c0 = lane * 8, h = lane >> 3;
    float lg[8], lb[8], mx[8];
    { const f32x4 a = *(const f32x4*)(ln_g + c0), b = *(const f32x4*)(ln_g + c0 + 4), c = *(const f32x4*)(ln_b + c0), d = *(const f32x4*)(ln_b + c0 + 4), e = *(const f32x4*)(mix + 1024 + c0), f = *(const f32x4*)(mix + 1024 + c0 + 4);
#pragma unroll
      for (int j = 0; j < 4; ++j) { lg[j] = a[j]; lg[4 + j] = b[j]; lb[j] = c[j]; lb[4 + j] = d[j]; mx[j] = e[j]; mx[4 + j] = f[j]; } }
    for (int mb = gw; mb < M; mb += NGW * 2) {
        f32x4 ya[2], yb[2]; v4u cv[2], pv[2], gv[2]; float bo[2];
#pragma unroll
        for (int k = 0; k < 2; ++k) { const int m = mb + k * NGW; const bool hp = (m & (SEQ - 1)) != 0;
            ya[k] = *(const f32x4*)(yraw + (size_t)m * 512 + c0); yb[k] = *(const f32x4*)(yraw + (size_t)m * 512 + c0 + 4);
            cv[k] = *(const v4u*)(proj + (size_t)m * L0P + 1024 + c0); pv[k] = *(const v4u*)(proj + (size_t)(hp ? m - 1 : m) * L0P + 1024 + c0);
            gv[k] = *(const v4u*)(gbuf + (size_t)m * 512 + c0); bo[k] = bonus[(size_t)m * 8 + h]; }
#pragma unroll
        for (int k = 0; k < 2; ++k) { const int m = mb + k * NGW; const float pz = ((m & (SEQ - 1)) != 0) ? 1.f : 0.f;
            float y[8] = {ya[k][0], ya[k][1], ya[k][2], ya[k][3], yb[k][0], yb[k][1], yb[k][2], yb[k][3]}, cc[8], pp[8], gg[8];
            unpack8(cv[k], cc); unpack8(pv[k], pp); unpack8(gv[k], gg);
            float sm = 0.f;
#pragma unroll
            for (int j = 0; j < 8; ++j) sm += y[j];
            const float mu = sum8(sm) * (1.f / 64.f);
            float qv = 0.f;
#pragma unroll
            for (int j = 0; j < 8; ++j) { y[j] -= mu; qv += y[j] * y[j]; }
            const float rs = __builtin_amdgcn_rsqf(sum8(qv) * (1.f / 64.f) + 64e-5f);
            float o[8];
#pragma unroll
            for (int j = 0; j < 8; ++j) { const float vs = cc[j] + (pp[j] * pz - cc[j]) * mx[j]; o[j] = (y[j] * rs * lg[j] + lb[j] + bo[k] * vs) * gg[j]; }
            v4u w; w.x = cvtpk(o[0], o[1]); w.y = cvtpk(o[2], o[3]); w.z = cvtpk(o[4], o[5]); w.w = cvtpk(o[6], o[7]);
            *(v4u*)(ymix + (size_t)m * DM + c0) = w; }
    }
}

struct Args { const float* in[43]; float* out; unsigned char* ws; };
constexpr int HG_PITCH = 144, HG_A_BYTES = 128 * HG_PITCH, HG_STAGE = (128 + 256) * HG_PITCH;
__device__ __forceinline__ void halo_gemm_unit(int unit, int tid, int lane, int wave, LAS unsigned char* lds, const bf16_t* __restrict__ XBp, const bf16_t* __restrict__ Wup, bf16_t* __restrict__ HALOp) {
    const int pm = unit / 11, pn = unit - pm * 11, wr = wave >> 2, wc = wave & 3, l31 = lane & 31, hi = lane >> 5;
    const int srow = tid >> 3, sch = tid & 7;
    const bf16_t* gA[2]; const bf16_t* gB[4]; int lA[2], lB[4];
#pragma unroll
    for (int i = 0; i < 2; ++i) { const int row = srow + 64 * i, R = 128 * pm + row; gA[i] = XBp + (size_t)(64 * (R >> 1) + 62 + (R & 1)) * DM + sch * 8; lA[i] = row * HG_PITCH + sch * 16; }
#pragma unroll
    for (int i = 0; i < 4; ++i) { const int row = srow + 64 * i, ch = 256 * pn + row; gB[i] = Wup + (size_t)(256 * (ch >> 7) + (ch & 127)) * 1024 + sch * 8; lB[i] = HG_A_BYTES + row * HG_PITCH + sch * 16; }
    f32x16 acc[2][2];
#pragma unroll
    for (int a = 0; a < 2; ++a)
#pragma unroll
        for (int b = 0; b < 2; ++b)
#pragma unroll
            for (int r = 0; r < 16; ++r) acc[a][b][r] = 0.f;
    v4u ra0[2], rb0[4], ra1[2], rb1[4];
#pragma unroll
    for (int i = 0; i < 2; ++i) ra0[i] = *(const v4u*)gA[i];
#pragma unroll
    for (int i = 0; i < 4; ++i) rb0[i] = *(const v4u*)gB[i];
#pragma unroll
    for (int i = 0; i < 2; ++i) ra1[i] = *(const v4u*)(gA[i] + 64);
#pragma unroll
    for (int i = 0; i < 4; ++i) rb1[i] = *(const v4u*)(gB[i] + 64);
#pragma unroll
    for (int i = 0; i < 2; ++i) *(LAS v4u*)(lds + lA[i]) = ra0[i];
#pragma unroll
    for (int i = 0; i < 4; ++i) *(LAS v4u*)(lds + lB[i]) = rb0[i];
    __syncthreads();
    const int fA = (64 * wr + l31) * HG_PITCH + 16 * hi, fB = HG_A_BYTES + (64 * wc + l31) * HG_PITCH + 16 * hi;
#define HG_COMPUTE(S) do { _Pragma("unroll") for (int st = 0; st < 4; ++st) { bf16x8 fa[2], fb[2]; \
        _Pragma("unroll") for (int x = 0; x < 2; ++x) { fa[x] = *(const LAS bf16x8*)((S) + fA + 32 * x * HG_PITCH + 32 * st); fb[x] = *(const LAS bf16x8*)((S) + fB + 32 * x * HG_PITCH + 32 * st); } \
        _Pragma("unroll") for (int a = 0; a < 2; ++a) _Pragma("unroll") for (int b = 0; b < 2; ++b) acc[a][b] = MFMA32(fb[b], fa[a], acc[a][b]); } } while (0)
#pragma unroll 1
    for (int c = 0; c < 16; c += 2) {
        { const int k2 = (c + 2 < 16) ? 64 * (c + 2) : 0;
#pragma unroll
          for (int i = 0; i < 2; ++i) ra0[i] = *(const v4u*)(gA[i] + k2);
#pragma unroll
          for (int i = 0; i < 4; ++i) rb0[i] = *(const v4u*)(gB[i] + k2);
          HG_COMPUTE(lds);
#pragma unroll
          for (int i = 0; i < 2; ++i) *(LAS v4u*)(lds + HG_STAGE + lA[i]) = ra1[i];
#pragma unroll
          for (int i = 0; i < 4; ++i) *(LAS v4u*)(lds + HG_STAGE + lB[i]) = rb1[i];
          __syncthreads(); }
        { const int k3 = (c + 3 < 16) ? 64 * (c + 3) : 0;
#pragma unroll
          for (int i = 0; i < 2; ++i) ra1[i] = *(const v4u*)(gA[i] + k3);
#pragma unroll
          for (int i = 0; i < 4; ++i) rb1[i] = *(const v4u*)(gB[i] + k3);
          HG_COMPUTE(lds + HG_STAGE);
          if (c + 2 < 16) {
#pragma unroll
              for (int i = 0; i < 2; ++i) *(LAS v4u*)(lds + lA[i]) = ra0[i];
#pragma unroll
              for (int i = 0; i < 4; ++i) *(LAS v4u*)(lds + lB[i]) = rb0[i];
          }
          __syncthreads(); }
    }
#undef HG_COMPUTE
#pragma unroll
    for (int a = 0; a < 2; ++a) { const int R = 128 * pm + 64 * wr + 32 * a + l31;
#pragma unroll
        for (int b = 0; b < 2; ++b)
#pragma unroll
            for (int g = 0; g < 4; ++g) { const int ch = 256 * pn + 64 * wc + 32 * b + 8 * g + 4 * hi;
                u32x2 w; w.x = cvtpk(acc[a][b][4 * g], acc[a][b][4 * g + 1]); w.y = cvtpk(acc[a][b][4 * g + 2], acc[a][b][4 * g + 3]);
                *(u32x2*)(HALOp + (size_t)R * DFF + ch) = w; } }
}
__device__ __forceinline__ void halo_signal(unsigned* cnt) {
    asm volatile("s_waitcnt vmcnt(0)" ::: "memory");
    __syncthreads();
    if (threadIdx.x == 0) { __builtin_amdgcn_fence(__ATOMIC_RELEASE, "agent"); asm volatile("s_waitcnt vmcnt(0)" ::: "memory"); (void)xb_add(cnt, 1u); }
}
__device__ __forceinline__ void halo_wait(unsigned* cnt, unsigned need, unsigned* bar) {
    if (threadIdx.x == 0) { XB_SPIN(xb_ld(cnt) < need, bar); __builtin_amdgcn_fence(__ATOMIC_ACQUIRE, "agent"); asm volatile("s_waitcnt vmcnt(0)" ::: "memory"); }
    __syncthreads();
}
#define GEMM_PHASE(EPI, Aptr, LDA, Bptr, LDB, NN, KK, ...) do { pg8::Gemm g_{(Aptr), (Bptr), M, (NN), (KK), (LDA), (LDB)}; pg8::StaticOrder S_; S_.init(M, (NN), G, (int)blockIdx.x); \
        pg8::EPI E_{__VA_ARGS__}; pg8::gemm_phase<pg8::EPI, pg8::StaticOrder, true, true>(lds3, g_, S_, E_); } while (0)

__global__ void __launch_bounds__(NWAVES * 64, 2) fwd_mega(Args args) {
    extern __shared__ __attribute__((aligned(16))) unsigned char lds[];
    LAS unsigned char* lds3 = (LAS unsigned char*)lds;
    volatile LAS unsigned* MISC = (volatile LAS unsigned*)(lds3 + MISC_OFF);
    const int G = gridDim.x, NGW = G * NWAVES, NT = G * NWAVES * 64;
#define PHASE_IDS() int tid = threadIdx.x; asm volatile("" : "+v"(tid)); const int lane = tid & 63, wave = __builtin_amdgcn_readfirstlane(tid >> 6); const int gw = blockIdx.x * NWAVES + wave, gtid = blockIdx.x * (NWAVES * 64) + tid; (void)lane; (void)gw; (void)gtid
    unsigned char* ws = args.ws;
    gu32* ctl = (gu32*)(ws + WS_CTL);
    for (int u = threadIdx.x; u < (LDS_BYTES - LDSCTL_OFF) / 4; u += NWAVES * 64) ((LAS unsigned*)(lds3 + LDSCTL_OFF))[u] = 0u;
    __syncthreads();
    XcdBarrier bar = xcd_barrier_post((unsigned*)(ctl + CW_BAR), MISC + 8);
#if defined(PROBE_STAMPS)
    int nb_ = 0;
    if (blockIdx.x == 0 && threadIdx.x == 0) MISC[16] = (unsigned)__builtin_amdgcn_s_memrealtime();
#define GRID_BAR() do { xcd_barrier(bar); ++nb_; if (blockIdx.x == 0 && threadIdx.x == 0) MISC[16 + nb_] = (unsigned)__builtin_amdgcn_s_memrealtime(); } while (0)
#else
#define GRID_BAR() xcd_barrier(bar)
#endif
#define IN(i) (args.in[i])
    float* out = args.out;
    bf16_t* W0in = (bf16_t*)(ws + WS_W0IN); bf16_t* W0out = (bf16_t*)(ws + WS_W0OUT); bf16_t* Wup0 = (bf16_t*)(ws + WS_WUP0); bf16_t* Wdn0 = (bf16_t*)(ws + WS_WDN0);
    bf16_t* W1in = (bf16_t*)(ws + WS_W1IN); bf16_t* Wuq = (bf16_t*)(ws + WS_WUQ); bf16_t* Wukv = (bf16_t*)(ws + WS_WUKV); bf16_t* W1out = (bf16_t*)(ws + WS_W1OUT);
    bf16_t* Wup1 = (bf16_t*)(ws + WS_WUP1); bf16_t* Wdn1 = (bf16_t*)(ws + WS_WDN1);
    bf16_t* XB = (bf16_t*)(ws + WS_XB); bf16_t* YMIX = (bf16_t*)(ws + WS_YMIX); bf16_t* PROJ0 = (bf16_t*)(ws + WS_BIG);
    bf16_t* ZB = (bf16_t*)out; float* YRAW = out; bf16_t* YSSM = (bf16_t*)(out + (size_t)M * 512); bf16_t* STB = (bf16_t*)(out + (size_t)M * 768); bf16_t* XST = (bf16_t*)(ws + WS_XST); bf16_t* BT = (bf16_t*)(ws + WS_BT); float* ASUM = (float*)(ws + WS_ASUM); float* SLOC = (float*)(ws + WS_SLOC); float* DT = (float*)(ws + WS_DT); bf16_t* GB = (bf16_t*)(ws + WS_G); float* BONUS = (float*)(ws + WS_BONUS);
    bf16_t* W2T = (bf16_t*)(ws + WS_W2T); bf16_t* A2T = (bf16_t*)(ws + WS_A2T); bf16_t* G2T = (bf16_t*)(ws + WS_G2T); bf16_t* ACT = (bf16_t*)(ws + WS_GU); bf16_t* HALO = (bf16_t*)(ws + WS_GU + 176 * MiB);
    bf16_t* PROJ1 = (bf16_t*)(ws + WS_PROJ1); bf16_t* QM = (bf16_t*)(ws + WS_QM); bf16_t* KVM = (bf16_t*)(ws + WS_KVM); bf16_t* KPE = (bf16_t*)(ws + WS_KPE); float* RS = (float*)(ws + WS_RS); float* CSTAB = (float*)(ws + WS_CSTAB); float* STATS = (float*)(ws + WS_CSTAB + 4 * MiB); bf16_t* VTS = (bf16_t*)(ws + WS_VTS); bf16_t* VTM = (bf16_t*)(ws + WS_VTM);
    const int* pos = (const int*)args.in[1];

    {
        PHASE_IDS();
    {
        LAS float* scr = (LAS float*)(lds3 + wave * 16384); int trb = 0;
        transpose_matrix(IN(2), 1024, 3336, W0in, L0P, 1024, scr, gw, NGW, lane, nullptr, trb);
        transpose_matrix(IN(20), 1024, 1024, W0out, 1024, 1024, scr, gw, NGW, lane, nullptr, trb);
        transpose_matrix(IN(5), 64, 512, W2T, 512, 64, scr, gw, NGW, lane, nullptr, trb);
        transpose_matrix(IN(7), 64, 512, A2T, 512, 64, scr, gw, NGW, lane, nullptr, trb);
        transpose_matrix(IN(8), 128, 512, G2T, 512, 128, scr, gw, NGW, lane, nullptr, trb);
        const float* x = IN(0);
        {
            constexpr size_t TOT4 = (size_t)M * DM / 4;
            for (size_t i = gtid; i < TOT4; i += (size_t)NT * 8) {
                f32x4 v[8];
#pragma unroll
                for (int u = 0; u < 8; ++u) v[u] = *(const f32x4*)(x + (i + (size_t)u * NT) * 4);
#pragma unroll
                for (int u = 0; u < 8; ++u) { uint2 w; w.x = cvtpk(v[u][0], v[u][1]); w.y = cvtpk(v[u][2], v[u][3]); *(uint2*)(XB + (i + (size_t)u * NT) * 4) = w; }
            }
        }
    }
    }
    GRID_BAR();
    {
        PHASE_IDS();
    GEMM_PHASE(EpiBf16S, XB, DM, W0in, 1024, L0P, 1024, PROJ0, nullptr, L0P, 0);
    }
    GRID_BAR();
    {
        PHASE_IDS();
        const int blk = (int)blockIdx.x, m0 = blk * 128;
        {   LAS bf16_t* scr = (LAS bf16_t*)(lds3 + wave * 16384);
#pragma unroll 1
            for (int k = 0; k < 4; ++k) ssd_conv_tile((2 * blk + (k & 1)) * 16 + wave + 8 * (k >> 1), lane, scr, PROJ0, IN(14), IN(15), XB, XST, BT);
            for (int i = tid; i < 1024; i += NWAVES * 64) { const int m = m0 + (i >> 3); DT[(size_t)m * 8 + (i & 7)] = softplusf_(bf2f(PROJ0[(size_t)m * L0P + 3328 + (i & 7)]) + IN(16)[i & 7]); }
        }
        __syncthreads();
#if defined(PROBE_STAMPS)
        if (blockIdx.x == 0 && threadIdx.x == 0) MISC[16 + 29] = (unsigned)__builtin_amdgcn_s_memrealtime();
#endif
        ssd_s1_unit(blk * 8 + wave, lane, (LAS float*)(lds3 + wave * 16384), XST, BT, DT, IN(17), SLOC, ASUM);
    }
    GRID_BAR();
    {
        PHASE_IDS();
        ssd_s2_all(SLOC, ASUM, STB, gtid, NT);
    }
    GRID_BAR();
    {
        PHASE_IDS();
        const int blk = (int)blockIdx.x;
        if (blk < 128) {
            rwkv_phase_chain((LAS float*)lds3, tid, lane, wave, blk, PROJ0, IN(3), IN(4), IN(6), IN(9), IN(10), IN(11), W2T, A2T, G2T, YRAW, GB, BONUS);
#if defined(PROBE_STAMPS)
            if (blk == 0 && threadIdx.x == 0) MISC[16 + 23] = (unsigned)__builtin_amdgcn_s_memrealtime();
#endif
        } else {
            const int bc0 = (blk - 128) * 2;
#if defined(PROBE_STAMPS)
            const unsigned tu0_ = (unsigned)__builtin_amdgcn_s_memrealtime();
#endif
            {
                const int gwu = (blk - 128) * NWAVES + wave;
                gate_lora_wave(gwu, 128 * NWAVES, lane, PROJ0, IN(3), G2T, GB);
            }
#if defined(PROBE_STAMPS)
            __syncthreads(); if (blk == 128 && threadIdx.x == 0) __hip_atomic_store(ctl + 2049, (unsigned)__builtin_amdgcn_s_memrealtime() - tu0_, __ATOMIC_RELAXED, __HIP_MEMORY_SCOPE_AGENT);
#endif
#pragma unroll 1
            for (int u = 0; u < 2; ++u) ssd_s3_block(bc0 + u, tid, lane, wave, lds3, XB, XST, STB, DT, IN(17), IN(18), YSSM);
            __syncthreads();
#if defined(PROBE_STAMPS)
            __syncthreads(); if (blk == 128 && threadIdx.x == 0) __hip_atomic_store(ctl + 2050, (unsigned)__builtin_amdgcn_s_memrealtime() - tu0_, __ATOMIC_RELAXED, __HIP_MEMORY_SCOPE_AGENT);
#endif
            ssm_gate_norm_vec(YSSM, PROJ0, IN(19), YMIX, bc0 * 128, bc0 * 128 + 256, wave, NWAVES, lane);
#if defined(PROBE_STAMPS)
            __syncthreads(); if (blk == 128 && threadIdx.x == 0) __hip_atomic_store(ctl + 2051, (unsigned)__builtin_amdgcn_s_memrealtime() - tu0_, __ATOMIC_RELAXED, __HIP_MEMORY_SCOPE_AGENT);
#endif
            { const int gwu = (blk - 128) * NWAVES + wave, NGWU = 128 * NWAVES; LAS float* scr = (LAS float*)(lds3 + wave * 16384); int trb = 0;
              transpose_matrix(IN(23), 1024, 5632, Wup0, 5632, 1024, scr, gwu, NGWU, lane, nullptr, trb, true);
              transpose_matrix(IN(26), 2816, 1024, Wdn0, 1024, 2816, scr, gwu, NGWU, lane, nullptr, trb);
            }
#if defined(PROBE_STAMPS)
            __syncthreads(); if (blk == 128 && threadIdx.x == 0) __hip_atomic_store(ctl + 2048, (unsigned)__builtin_amdgcn_s_memrealtime() - tu0_, __ATOMIC_RELAXED, __HIP_MEMORY_SCOPE_AGENT);
#endif
        }
    }
    GRID_BAR();
    {
        PHASE_IDS();
        rwkv_post_vec(YRAW, PROJ0, IN(3), BONUS, GB, IN(12), IN(13), YMIX, gw, NGW, lane);
    }
    GRID_BAR();
    {
        PHASE_IDS();
    GEMM_PHASE(EpiResid, YMIX, DM, W0out, 1024, 1024, 1024, IN(0), ZB, ALPHA, 0);
    }
    GRID_BAR();
    {
        PHASE_IDS();
        if ((int)blockIdx.x >= 88) {
            ln_rows_range<1, 2>(ZB, XB, nullptr, STATS, IN(21), IN(22), ((int)blockIdx.x - 88) * NWAVES + wave, (M / 64) * 31, (G - 88) * NWAVES, lane);
        } else {
            const int pm_ = (int)blockIdx.x / 11;
            ln_rows_range<1, 1>(ZB, XB, nullptr, STATS, IN(21), IN(22), 64 * pm_ + wave, 64 * pm_ + 64, NWAVES, lane);
            asm volatile("s_waitcnt vmcnt(0)" ::: "memory");
            __syncthreads();
            if (threadIdx.x == 0) { __builtin_amdgcn_fence(__ATOMIC_ACQUIRE, "agent"); asm volatile("s_waitcnt vmcnt(0)" ::: "memory"); }
            __syncthreads();
            halo_gemm_unit((int)blockIdx.x, tid, lane, wave, lds3, XB, Wup0, HALO);
        }
        {
            const int gwu = gw, NGWU = NGW; LAS float* scr = (LAS float*)(lds3 + wave * 16384); int trb = 0;
            transpose_matrix(IN(29), 1024, 1952, W1in, L1P, 1024, scr, gwu, NGWU, lane, nullptr, trb);
            transpose_matrix(IN(31), 256, 768, Wuq, 768, 256, scr, gwu, NGWU, lane, IN(30), trb);
            transpose_matrix(IN(33), 128, 1024, Wukv, 1024, 256, scr, gwu, NGWU, lane, IN(32), trb);
            transpose_matrix(IN(34), 1024, 1024, W1out, 1024, 1024, scr, gwu, NGWU, lane, nullptr, trb);
            transpose_matrix(IN(37), 1024, 5632, Wup1, 5632, 1024, scr, gwu, NGWU, lane, nullptr, trb, true);
            transpose_matrix(IN(40), 2816, 1024, Wdn1, 1024, 2816, scr, gwu, NGWU, lane, nullptr, trb);
            for (int i = gwu * 64 + lane; i < 1024 * 16; i += NGWU * 64) { const int n = i >> 4, c = i & 15; *(v4u*)(Wukv + (size_t)n * 256 + 128 + c * 8) = (v4u){0u, 0u, 0u, 0u}; }
        }
    }
    GRID_BAR();
    {
        PHASE_IDS();
        { pg8::Gemm g_{XB, Wup0, M, 2 * DFF, 1024, DM, 1024, 128, 256, 128, 256, 0, 1}; pg8::StaticOrder S_; S_.init(M, 2 * DFF, G, (int)blockIdx.x);
          pg8::EpiConvAct E_{ACT, HALO, IN(24), IN(25), DFF, SEQ}; pg8::gemm_phase<pg8::EpiConvAct, pg8::StaticOrder, true, true>(lds3, g_, S_, E_); }
    }
    GRID_BAR();
    {
        PHASE_IDS();
    GEMM_PHASE(EpiResidLN, ACT, DFF, Wdn0, DFF, 1024, DFF, ZB, ZB, STATS, IN(21), IN(22), ALPHA, 0);
    }
    GRID_BAR();
    {
        PHASE_IDS();
    ln_rows<1>(ZB, XB, nullptr, STATS, IN(27), IN(28), gw, NGW, lane);
    }
    GRID_BAR();
    {
        PHASE_IDS();
    GEMM_PHASE(EpiBf16S, XB, DM, W1in, 1024, L1P, 1024, PROJ1, nullptr, L1P, 0);
    }
    GRID_BAR();
    {
        PHASE_IDS();
    mla_prep_all(PROJ1, pos, RS, KPE, CSTAB, gw, NGW, lane);
    {
        LAS bf16_t* scr = (LAS bf16_t*)(lds3 + wave * 16384);
        for (int r = gw; r < 4096; r += NGW) { const int bh = r >> 5, tt = r & 31, b = bh >> 3, h = bh & 7;
            transpose_tile64(PROJ1 + ((size_t)b * SEQ + tt * 64) * L1P + 1024 + h * 64, L1P, VTS + (size_t)bh * 64 * SEQ + tt * 64, SEQ, scr, lane); }
    }
    }
    GRID_BAR();
    {
        PHASE_IDS();
    GEMM_PHASE(EpiBf16S, PROJ1 + 1536, L1P, Wuq, 256, 768, 256, QM, RS, 768, 2);
    GEMM_PHASE(EpiBf16S, PROJ1 + 1792, L1P, Wukv, 256, 1024, 256, KVM, RS + 1, 1024, 2);
    }
    GRID_BAR();
    {
        PHASE_IDS();
    {
        LAS bf16_t* scr = (LAS bf16_t*)(lds3 + wave * 16384);
        for (int r = gw; r < 4096; r += NGW) { const int bh = r >> 5, tt = r & 31, b = bh >> 3, h = bh & 7;
            transpose_tile64(KVM + ((size_t)b * SEQ + tt * 64) * 1024 + h * 128 + 64, 1024, VTM + (size_t)bh * 64 * SEQ + tt * 64, SEQ, scr, lane); }
    }
    }
    GRID_BAR();
    {
        PHASE_IDS();
    {
        { LAS unsigned char* wl = lds3 + wave * 16384;
          for (int g2 = gw; g2 < 2048; g2 += NGW) { const int bh = g2 >> 4, w = g2 & 15;
#pragma unroll 1
              for (int i = 0; i < 4; ++i) { const int qb = (i == 0) ? w : (i == 1) ? 31 - w : (i == 2) ? 32 + w : 63 - w; sb_wave(bh, qb, lane, PROJ1, VTS, YMIX, wl); } } }
        __syncthreads();
        for (int g2 = (int)blockIdx.x; g2 < 256; g2 += G) { const int bh = g2 >> 1, part = g2 & 1;
#pragma unroll 1
            for (int i = 0; i < 4; ++i) { const int sbk = part ? ((i == 0) ? 1 : (i == 1) ? 6 : (i == 2) ? 2 : 5) : ((i == 0) ? 0 : (i == 1) ? 7 : (i == 2) ? 3 : 4);
                mla_block(bh, sbk, tid, lane, wave, lds3, QM, KVM, KPE, VTM, YMIX, CSTAB); } }
    }
    }
    GRID_BAR();
    {
        PHASE_IDS();
    GEMM_PHASE(EpiResidLN, YMIX, DM, W1out, 1024, 1024, 1024, ZB, ZB, STATS, IN(27), IN(28), ALPHA, 0);
    }
    GRID_BAR();
    {
        PHASE_IDS();
        if ((int)blockIdx.x >= 88) {
            ln_rows_range<1, 2>(ZB, XB, nullptr, STATS, IN(35), IN(36), ((int)blockIdx.x - 88) * NWAVES + wave, (M / 64) * 31, (G - 88) * NWAVES, lane);
        } else {
            const int pm_ = (int)blockIdx.x / 11;
            ln_rows_range<1, 1>(ZB, XB, nullptr, STATS, IN(35), IN(36), 64 * pm_ + wave, 64 * pm_ + 64, NWAVES, lane);
            asm volatile("s_waitcnt vmcnt(0)" ::: "memory");
            __syncthreads();
            if (threadIdx.x == 0) { __builtin_amdgcn_fence(__ATOMIC_ACQUIRE, "agent"); asm volatile("s_waitcnt vmcnt(0)" ::: "memory"); }
            __syncthreads();
            halo_gemm_unit((int)blockIdx.x, tid, lane, wave, lds3, XB, Wup1, HALO);
        }
    }
    GRID_BAR();
    {
        PHASE_IDS();
        { pg8::Gemm g_{XB, Wup1, M, 2 * DFF, 1024, DM, 1024, 128, 256, 128, 256, 0, 1}; pg8::StaticOrder S_; S_.init(M, 2 * DFF, G, (int)blockIdx.x);
          pg8::EpiConvAct E_{ACT, HALO, IN(38), IN(39), DFF, SEQ}; pg8::gemm_phase<pg8::EpiConvAct, pg8::StaticOrder, true, true>(lds3, g_, S_, E_); }
    }
    GRID_BAR();
    {
        PHASE_IDS();
    GEMM_PHASE(EpiResidLN, ACT, DFF, Wdn1, DFF, 1024, DFF, ZB, XB, STATS, IN(35), IN(36), ALPHA, 0);
    }
    GRID_BAR();
    {
        PHASE_IDS();
    ln_rows<2>(XB, nullptr, out, STATS, IN(41), IN(42), gw, NGW, lane);
    #if defined(PROBE_STAMPS)
    __syncthreads();
    if (blockIdx.x == 0 && threadIdx.x == 0) {
        MISC[16 + 22] = (unsigned)__builtin_amdgcn_s_memrealtime();
#if defined(PROBE_GLOBAL)
#ifndef PROBE_GIDX
#define PROBE_GIDX 0
#endif
        const unsigned d1 = __hip_atomic_load(ctl + 2048 + PROBE_GIDX, __ATOMIC_RELAXED, __HIP_MEMORY_SCOPE_AGENT);
#elif defined(PROBE_ACC)
        const unsigned d1 = MISC[16 + PROBE_ACC];
#else
        const unsigned d1 = MISC[16 + PROBE_T1_HI] - MISC[16 + PROBE_T1_LO];
#endif
        const unsigned long long spin = 100ull * d1;
        const unsigned long long t0 = __builtin_amdgcn_s_memrealtime();
        while (__builtin_amdgcn_s_memrealtime() - t0 < spin) __builtin_amdgcn_s_sleep(8);
    }
#endif
}
}

extern "C" void kernel_launch(void* const* d_in, const int* in_sizes, int n_in, void* d_out, int out_size, void* d_ws, size_t ws_size, hipStream_t stream) {
    static int grid = 0;
    if (grid == 0) {
        if (n_in != 43 || ws_size < WS_NEED || out_size != M * DM) { fprintf(stderr, "kernel_launch: unexpected n_in %d / ws %zu / out %d\n", n_in, ws_size, out_size); grid = -1; return; }
        int dev = 0, cus = 0, per_cu = 0;
        if (hipGetDevice(&dev) != hipSuccess || hipDeviceGetAttribute(&cus, hipDeviceAttributeMultiprocessorCount, dev) != hipSuccess) { grid = -1; return; }
        if (hipFuncSetAttribute((const void*)fwd_mega, hipFuncAttributeMaxDynamicSharedMemorySize, LDS_BYTES) != hipSuccess) { fprintf(stderr, "kernel_launch: hipFuncSetAttribute failed\n"); grid = -1; return; }
        if (hipOccupancyMaxActiveBlocksPerMultiprocessor(&per_cu, (const void*)fwd_mega, NWAVES * 64, LDS_BYTES) != hipSuccess || per_cu < 1) fprintf(stderr, "kernel_launch: occupancy query reports %d\n", per_cu);
        (void)hipGetLastError();
        grid = cus;
    }
    if (grid < 0) return;
    (void)hipMemsetAsync((char*)d_ws + WS_CTL, 0, CTL_ZERO_BYTES, stream);
    Args a{};
    for (int i = 0; i < 43; ++i) a.in[i] = (const float*)d_in[i];
    a.out = (float*)d_out; a.ws = (unsigned char*)d_ws;
    hipLaunchKernelGGL(fwd_mega, dim3(grid), dim3(NWAVES * 64), LDS_BYTES, stream, a);
}
```

```cpp
#include <hip/hip_runtime.h>
#include <cstdio>
#include <cstdint>
#include <cmath>
namespace pg8 {
#define PG8_LAS __attribute__((address_space(3)))
typedef unsigned short bf16_t;
typedef short bf16x8 __attribute__((ext_vector_type(8)));
typedef float f32x4 __attribute__((ext_vector_type(4)));
typedef unsigned u32x4 __attribute__((ext_vector_type(4)));
constexpr int BM = 256, BK = 64, HALF = 128, HTB = HALF * BK * 2  , STAGE_BYTES = 8 * HTB, NXCD = 8, WGM = 8;

__host__ __device__ __forceinline__ int lds_byte(int r, int c) { const int st = (r >> 4) * 2 + (c >> 5), rr = r & 15, cc = c & 31, ob = rr * 64 + cc * 2; return st * 1024 + (ob ^ (((ob >> 9) & 1) << 5)); }
__host__ __device__ __forceinline__ void stage_rc(int b, int& R, int& C) { const int st = b / 1024, sb = b % 1024, swz = sb ^ (((sb >> 9) & 1) << 5); R = (st >> 1) * 16 + swz / 64; C = (st & 1) * 32 + (swz % 64) / 2; }
__host__ __device__ __forceinline__ int perm32(int rho) { const int n = rho >> 4, i = rho & 15; return 8 * (i >> 2) + 4 * n + (i & 3); }

struct Unit { int pm, pn; };
struct Gemm { const bf16_t* A; const bf16_t* Bt; int M, N, K, lda, ldb; int hrA = 128, trA = 256, hrB = 128, trB = 256, gatherA = 0, permA = 0; };

struct StaticOrder {
    int nM, nN, nwg, G, c;
    __host__ __device__ void init(int M, int N, int G_, int c_) { nM = M / BM; nN = N / BM; nwg = nM * nN; G = G_; c = c_; }
    __host__ __device__ bool next(int i, Unit& u) const {
        const long L = (long)i * G + c; if (L >= nwg) return false;
        int wgid = (int)L; { const int q = nwg / NXCD, r = nwg % NXCD, xcd = wgid % NXCD, off = wgid / NXCD; wgid = (xcd < r ? xcd * (q + 1) : r * (q + 1) + (xcd - r) * q) + off; }
        const int nig = WGM * nN, gid = wgid / nig, fm = gid * WGM, gsz = (nM - fm) < WGM ? (nM - fm) : WGM;
        u.pm = fm + ((wgid % nig) % gsz); u.pn = (wgid % nig) / gsz; return true;
    }
    __device__ __forceinline__ void a_ready(const Unit&) const {}
    __device__ __forceinline__ void done(const Unit&) const {}
};


__device__ __forceinline__ unsigned cvt_pk_bf16(float lo, float hi) { unsigned r; asm volatile("v_cvt_pk_bf16_f32 %0, %1, %2" : "=v"(r) : "v"(lo), "v"(hi)); return r; }
struct EpiBf16S {
    static constexpr bool PERM = true, AFTER_DRAIN = false;
    bf16_t* O; const float* rowscale; int ldc; int rs_stride;
    __device__ __forceinline__ void operator()(const f32x4 (&acc)[2][2][4][2], const Unit& u, int wr, int wc, int fr, int fq) const {
        const int row0 = u.pm * BM + wr * 64 + fr, col0 = u.pn * BM + wc * 32 + 8 * fq;
#pragma unroll
        for (int ai = 0; ai < 2; ++ai)
#pragma unroll
            for (int m = 0; m < 4; ++m) { const int row = row0 + ai * HALF + m * 16; const float sc = rowscale ? rowscale[(size_t)row * rs_stride] : 1.f;
                bf16_t* rowp = O + (size_t)row * ldc + col0;
#pragma unroll
                for (int bj = 0; bj < 2; ++bj) { const f32x4 v0 = acc[ai][bj][m][0] * sc, v1 = acc[ai][bj][m][1] * sc;
                    u32x4 w; w.x = cvt_pk_bf16(v0[0], v0[1]); w.y = cvt_pk_bf16(v0[2], v0[3]); w.z = cvt_pk_bf16(v1[0], v1[1]); w.w = cvt_pk_bf16(v1[2], v1[3]);
                    *(u32x4*)(rowp + bj * HALF) = w; } }
    }
};
struct EpiResid {
    static constexpr bool PERM = false, AFTER_DRAIN = false;
    const float* hin; bf16_t* hout; float alpha; int pad;
    __device__ __forceinline__ void operator()(const f32x4 (&acc)[2][2][4][2], const Unit& u, int wr, int wc, int fr, int fq) const {
        typedef unsigned u32x2r __attribute__((ext_vector_type(2)));
        const int row0 = u.pm * BM + wr * 64 + fr, col0 = u.pn * BM + wc * 32 + 4 * fq;
#pragma unroll
        for (int ai = 0; ai < 2; ++ai)
#pragma unroll
            for (int m = 0; m < 4; ++m) { const size_t off = (size_t)(row0 + ai * HALF + m * 16) * 1024 + col0;
#pragma unroll
                for (int bj = 0; bj < 2; ++bj)
#pragma unroll
                    for (int n = 0; n < 2; ++n) { const size_t i = off + bj * HALF + n * 16; const f32x4 h = *(const f32x4*)(hin + i); const f32x4 o = h * alpha + acc[ai][bj][m][n];
                        u32x2r w; w.x = cvt_pk_bf16(o[0], o[1]); w.y = cvt_pk_bf16(o[2], o[3]); *(u32x2r*)(hout + i) = w; } }
    }
};

struct EpiResidLN {
    static constexpr bool PERM = false, AFTER_DRAIN = false;
    const bf16_t* hin; bf16_t* hout; const float* stats; const float* g; const float* b; float alpha; int pad;
    __device__ __forceinline__ void operator()(const f32x4 (&acc)[2][2][4][2], const Unit& u, int wr, int wc, int fr, int fq) const {
        typedef unsigned u32x2r __attribute__((ext_vector_type(2)));
        const int row0 = u.pm * BM + wr * 64 + fr, col0 = u.pn * BM + wc * 32 + 4 * fq;
        f32x4 gg[2][2], bb[2][2];
#pragma unroll
        for (int bj = 0; bj < 2; ++bj)
#pragma unroll
            for (int n = 0; n < 2; ++n) { gg[bj][n] = *(const f32x4*)(g + col0 + bj * HALF + n * 16) * alpha; bb[bj][n] = *(const f32x4*)(b + col0 + bj * HALF + n * 16) * alpha; }
#pragma unroll
        for (int ai = 0; ai < 2; ++ai)
#pragma unroll
            for (int m = 0; m < 4; ++m) { const int row = row0 + ai * HALF + m * 16; const size_t off = (size_t)row * 1024 + col0;
                const float mu = stats[2 * row], rs = stats[2 * row + 1];
#pragma unroll
                for (int bj = 0; bj < 2; ++bj)
#pragma unroll
                    for (int n = 0; n < 2; ++n) { const size_t i = off + bj * HALF + n * 16; const u32x2r pw = *(const u32x2r*)(hin + i);
                        f32x4 p; p[0] = __builtin_bit_cast(float, pw.x << 16); p[1] = __builtin_bit_cast(float, pw.x & 0xffff0000u); p[2] = __builtin_bit_cast(float, pw.y << 16); p[3] = __builtin_bit_cast(float, pw.y & 0xffff0000u);
                        const f32x4 o = (p - mu) * rs * gg[bj][n] + bb[bj][n] + acc[ai][bj][m][n];
                        u32x2r w; w.x = cvt_pk_bf16(o[0], o[1]); w.y = cvt_pk_bf16(o[2], o[3]); *(u32x2r*)(hout + i) = w; } }
    }
};

template <int CTRL> __device__ __forceinline__ float pg_dpp(float x) { return __builtin_bit_cast(float, __builtin_amdgcn_update_dpp(0, __builtin_bit_cast(int, x), CTRL, 0xF, 0xF, true)); }
struct EpiConvAct {
    static constexpr bool PERM = true, AFTER_DRAIN = false;
    bf16_t* act; const bf16_t* halo; const float* cw; const float* cb; int dff; int seq;
    template <int CTRL> static __device__ __forceinline__ float dpp_old(float old, float x) { return __builtin_bit_cast(float, __builtin_amdgcn_update_dpp(__builtin_bit_cast(int, old), __builtin_bit_cast(int, x), CTRL, 0xF, 0xF, false)); }
    __device__ __forceinline__ void operator()(const f32x4 (&acc)[2][2][4][2], const Unit& u, int wr, int wc, int fr, int fq) const {
        typedef unsigned u32x2e __attribute__((ext_vector_type(2)));
        typedef float f32x2e __attribute__((ext_vector_type(2)));
        const int ch0 = u.pn * 128 + wc * 32 + 8 * fq;
        f32x4 w0[2], w1[2], w2[2], bb[2];
#pragma unroll
        for (int n = 0; n < 2; ++n) { w0[n] = *(const f32x4*)(cw + ch0 + 4 * n); w1[n] = *(const f32x4*)(cw + dff + ch0 + 4 * n); w2[n] = *(const f32x4*)(cw + 2 * dff + ch0 + 4 * n); bb[n] = *(const f32x4*)(cb + ch0 + 4 * n); }
#pragma unroll
        for (int ai = 0; ai < 2; ++ai) {
            const int rb64 = u.pm * BM + ai * HALF + wr * 64;
            f32x4 H2[2], H3[2];
#pragma unroll
            for (int n = 0; n < 2; ++n) { H2[n] = (f32x4){0.f, 0.f, 0.f, 0.f}; H3[n] = (f32x4){0.f, 0.f, 0.f, 0.f}; }
            if ((rb64 & (seq - 1)) != 0 && fr == 0) { const bf16_t* hp = halo + (size_t)(2 * (rb64 / 64 - 1)) * dff + ch0; const u32x4 h2 = *(const u32x4*)hp, h3 = *(const u32x4*)(hp + dff);
                const unsigned a2[4] = {h2.x, h2.y, h2.z, h2.w}, a3[4] = {h3.x, h3.y, h3.z, h3.w};
#pragma unroll
                for (int q = 0; q < 4; ++q) { H2[q >> 1][2 * (q & 1)] = __builtin_bit_cast(float, a2[q] << 16); H2[q >> 1][2 * (q & 1) + 1] = __builtin_bit_cast(float, a2[q] & 0xffff0000u);
                                              H3[q >> 1][2 * (q & 1)] = __builtin_bit_cast(float, a3[q] << 16); H3[q >> 1][2 * (q & 1) + 1] = __builtin_bit_cast(float, a3[q] & 0xffff0000u); } }
            f32x4 S2[2], S3[2];
#pragma unroll
            for (int n = 0; n < 2; ++n)
#pragma unroll
                for (int e = 0; e < 4; ++e) { S2[n][e] = dpp_old<0x111>(H2[n][e], acc[ai][0][2][n][e]); S3[n][e] = dpp_old<0x111>(H3[n][e], acc[ai][0][3][n][e]); }
#pragma unroll
            for (int m = 0; m < 4; ++m) {
                u32x4 w;
#pragma unroll
                for (int n = 0; n < 2; ++n) {
                    const f32x4 G0 = acc[ai][0][0][n], G1 = acc[ai][0][1][n], G2 = acc[ai][0][2][n];
                    const f32x4 Gv = acc[ai][0][m][n], Uv = acc[ai][1][m][n];
                    const f32x4 g1 = (m == 0) ? S3[n] : (m == 1) ? G0 : (m == 2) ? G1 : G2, g2 = (m == 0) ? S2[n] : (m == 1) ? S3[n] : (m == 2) ? G0 : G1;
                    f32x2e oh[2];
#pragma unroll
                    for (int hq = 0; hq < 2; ++hq) {
                        const f32x2e g2p = hq ? g2.hi : g2.lo, g1p = hq ? g1.hi : g1.lo, Gp = hq ? Gv.hi : Gv.lo, Up = hq ? Uv.hi : Uv.lo;
                        const f32x2e w0p = hq ? w0[n].hi : w0[n].lo, w1p = hq ? w1[n].hi : w1[n].lo, w2p = hq ? w2[n].hi : w2[n].lo, bp = hq ? bb[n].hi : bb[n].lo;
                        const f32x2e y = __builtin_elementwise_fma(w0p, g2p, __builtin_elementwise_fma(w1p, g1p, __builtin_elementwise_fma(w2p, Gp, bp)));
                        const f32x2e t = y * -1.4426950408889634f;
                        f32x2e den; den.x = __builtin_amdgcn_exp2f(t.x); den.y = __builtin_amdgcn_exp2f(t.y); den = den + 1.f;
                        f32x2e r; r.x = __builtin_amdgcn_rcpf(den.x); r.y = __builtin_amdgcn_rcpf(den.y);
                        oh[hq] = y * r * Up;
                    }
                    if (n == 0) { w.x = cvt_pk_bf16(oh[0].x, oh[0].y); w.y = cvt_pk_bf16(oh[1].x, oh[1].y); } else { w.z = cvt_pk_bf16(oh[0].x, oh[0].y); w.w = cvt_pk_bf16(oh[1].x, oh[1].y); }
                }
                *(u32x4*)(act + (size_t)(rb64 + 4 * fr + m) * dff + ch0) = w;
            }
        }
    }
};

template <class Epi, class Sched, bool ALIGN_EPI = false, bool SP2 = false>
__device__ __forceinline__ void gemm_phase(PG8_LAS unsigned char* lds, const Gemm g, const Sched& S, const Epi& E) {
    int tid = threadIdx.x; asm volatile("" : "+v"(tid));
    const int wid = __builtin_amdgcn_readfirstlane(tid >> 6), lane = tid & 63, wr = wid >> 2, wc = wid & 3, fr = lane & 15, fq = lane >> 4;
    const int K = g.K, nt = K / BK;
    unsigned voffA[2], voffB[2];
#pragma unroll
    for (int i = 0; i < 2; ++i) { int R, C; stage_rc(tid * 16 + i * 8192, R, C); const int Rb = Epi::PERM ? ((R & ~31) + perm32(R & 31)) : R;
        const int Ra = g.gatherA ? (64 * (R >> 1) + 62 + (R & 1)) : g.permA ? ((R & ~63) | ((R & 15) << 2) | ((R >> 4) & 3)) : R;
        voffA[i] = (unsigned)(Ra * g.lda + C) * 2u; voffB[i] = (unsigned)(Rb * g.ldb + C) * 2u; }
    const size_t kstep = (size_t)(BK * 2);
    const size_t hstepA = (size_t)g.hrA * g.lda * 2, hstepB = (size_t)g.hrB * g.ldb * 2;
    const size_t tstepA = (size_t)g.trA * g.lda * 2, tstepB = (size_t)g.trB * g.ldb * 2;
    const unsigned ldsw = (unsigned)wid * 1024u;
    const int aoff = lds_byte(wr * 64 + fr, fq * 8), boff = lds_byte(wc * 32 + fr, fq * 8);
#define PG8_SA(b, h) (((b) * 2 + (h)) * HTB)
#define PG8_SB(b, h) ((4 + (b) * 2 + (h)) * HTB)
#define PG8_STAGE(bufoff, gbase, voff) do { _Pragma("unroll") for (int _i = 0; _i < 2; ++_i) \
        __builtin_amdgcn_global_load_lds((const unsigned*)((const char*)(gbase) + (voff)[_i]), (PG8_LAS unsigned*)(lds + (bufoff) + ldsw + _i * 8192), 16, 0, 0); } while (0)
#define PG8_LDA(dst, b, h) do { _Pragma("unroll") for (int m = 0; m < 4; ++m) _Pragma("unroll") for (int k = 0; k < 2; ++k) dst[m][k] = *(const PG8_LAS bf16x8*)(lds + PG8_SA(b, h) + aoff + m * 2048 + k * 1024); } while (0)
#define PG8_LDB(dst, b, h) do { _Pragma("unroll") for (int n = 0; n < 2; ++n) _Pragma("unroll") for (int k = 0; k < 2; ++k) dst[n][k] = *(const PG8_LAS bf16x8*)(lds + PG8_SB(b, h) + boff + n * 2048 + k * 1024); } while (0)
#define PG8_MMA(ai, bj, At, Bt) do { __builtin_amdgcn_s_setprio(1); _Pragma("unroll") for (int m = 0; m < 4; ++m) _Pragma("unroll") for (int n = 0; n < 2; ++n) _Pragma("unroll") for (int k = 0; k < 2; ++k) \
        acc[ai][bj][m][n] = __builtin_amdgcn_mfma_f32_16x16x32_bf16(Bt[n][k], At[m][k], acc[ai][bj][m][n], 0, 0, 0); __builtin_amdgcn_s_setprio(0); } while (0)
#define PG8_WAIT_V(n) asm volatile("s_waitcnt vmcnt(" #n ")" ::: "memory")
#define PG8_WAIT_L(n) asm volatile("s_waitcnt lgkmcnt(" #n ")" ::: "memory")
#define PG8_BAR __builtin_amdgcn_s_barrier()
#define PG8_SCHED __builtin_amdgcn_sched_barrier(0)
    Unit cur, nxt; int ui = 0;
    if (!S.next(0, cur)) return;
    f32x4 acc[2][2][4][2];
#pragma unroll
    for (int a = 0; a < 2; ++a)
#pragma unroll
        for (int b = 0; b < 2; ++b)
#pragma unroll
            for (int m = 0; m < 4; ++m)
#pragma unroll
                for (int n = 0; n < 2; ++n) acc[a][b][m][n] = (f32x4){0.f, 0.f, 0.f, 0.f};
    bf16x8 At[4][2], B0[2][2], B1[2][2];
    const char* cA = (const char*)g.A + (size_t)cur.pm * tstepA; const char* cB = (const char*)g.Bt + (size_t)cur.pn * tstepB;
    S.a_ready(cur);
    if constexpr (SP2) {
        PG8_STAGE(PG8_SB(0, 0), cB, voffB); PG8_STAGE(PG8_SB(0, 1), cB + hstepB, voffB); PG8_STAGE(PG8_SA(0, 0), cA, voffA); PG8_STAGE(PG8_SA(0, 1), cA + hstepA, voffA);
        if (wr == 1) PG8_BAR;
        PG8_WAIT_V(2); PG8_BAR;
        PG8_STAGE(PG8_SB(1, 0), cB + kstep, voffB); PG8_STAGE(PG8_SA(1, 0), cA + kstep, voffA); PG8_STAGE(PG8_SB(1, 1), cB + hstepB + kstep, voffB);
        PG8_WAIT_V(6); PG8_BAR;
    } else {
        PG8_STAGE(PG8_SB(0, 0), cB, voffB); PG8_STAGE(PG8_SA(0, 0), cA, voffA); PG8_STAGE(PG8_SB(0, 1), cB + hstepB, voffB); PG8_STAGE(PG8_SA(0, 1), cA + hstepA, voffA);
        if (wr == 1) PG8_BAR;
        PG8_WAIT_V(4); PG8_BAR;
        PG8_STAGE(PG8_SB(1, 0), cB + kstep, voffB); PG8_STAGE(PG8_SA(1, 0), cA + kstep, voffA); PG8_STAGE(PG8_SB(1, 1), cB + hstepB + kstep, voffB);
        PG8_WAIT_V(6); PG8_BAR;
    }
    for (;;) {
        const bool has_next = S.next(ui + 1, nxt);
        const char* nA = has_next ? (const char*)g.A + (size_t)nxt.pm * tstepA : cA; const char* nB = has_next ? (const char*)g.Bt + (size_t)nxt.pn * tstepB : cB;
        for (int t = 0; t < nt; t += 2) {
            const bool last = (t == nt - 2);
            const char* a1 = cA + (size_t)(t + 1) * kstep;
            const char* a2 = last ? nA : cA + (size_t)(t + 2) * kstep; const char* b2 = last ? nB : cB + (size_t)(t + 2) * kstep;
            const char* a3 = a2 + kstep; const char* b3 = b2 + kstep;
            if (last && has_next) S.a_ready(nxt);
            if constexpr (SP2) {
            PG8_LDB(B0, 0, 0); PG8_LDB(B1, 0, 1); PG8_SCHED; PG8_LDA(At, 0, 0); PG8_STAGE(PG8_SA(1, 1), a1 + hstepA, voffA);
            PG8_WAIT_V(8); PG8_WAIT_L(0); PG8_BAR; PG8_MMA(0, 0, At, B0); PG8_MMA(0, 1, At, B1); PG8_BAR; PG8_SCHED;
            PG8_LDA(At, 0, 1); PG8_STAGE(PG8_SB(0, 0), b2, voffB); PG8_STAGE(PG8_SB(0, 1), b2 + hstepB, voffB); PG8_STAGE(PG8_SA(0, 0), a2, voffA);
            PG8_WAIT_V(8); PG8_WAIT_L(0); PG8_BAR; PG8_MMA(1, 0, At, B0); PG8_MMA(1, 1, At, B1); PG8_BAR; PG8_SCHED;
            PG8_LDB(B0, 1, 0); PG8_LDB(B1, 1, 1); PG8_SCHED; PG8_LDA(At, 1, 0); PG8_STAGE(PG8_SA(0, 1), a2 + hstepA, voffA);
            PG8_WAIT_V(8); PG8_WAIT_L(0); PG8_BAR; PG8_MMA(0, 0, At, B0); PG8_MMA(0, 1, At, B1); PG8_BAR; PG8_SCHED;
            PG8_LDA(At, 1, 1); PG8_STAGE(PG8_SB(1, 0), b3, voffB); PG8_STAGE(PG8_SB(1, 1), b3 + hstepB, voffB); PG8_STAGE(PG8_SA(1, 0), a3, voffA);
            PG8_WAIT_V(8); PG8_WAIT_L(0); PG8_BAR; PG8_MMA(1, 0, At, B0); PG8_MMA(1, 1, At, B1); PG8_BAR; PG8_SCHED;
            } else {
            PG8_LDB(B0, 0, 0); PG8_SCHED; PG8_LDA(At, 0, 0); PG8_STAGE(PG8_SA(1, 1), a1 + hstepA, voffA);
            PG8_WAIT_L(8); PG8_BAR; PG8_WAIT_L(0); PG8_MMA(0, 0, At, B0); PG8_BAR; PG8_SCHED;
            PG8_LDB(B1, 0, 1); PG8_STAGE(PG8_SB(0, 0), b2, voffB);
            PG8_BAR; PG8_WAIT_L(0); PG8_MMA(0, 1, At, B1); PG8_BAR;
            PG8_LDA(At, 0, 1); PG8_STAGE(PG8_SA(0, 0), a2, voffA);
            PG8_BAR; PG8_WAIT_L(0); PG8_MMA(1, 0, At, B0); PG8_BAR; PG8_SCHED;
            PG8_STAGE(PG8_SB(0, 1), b2 + hstepB, voffB);
            PG8_WAIT_V(6); PG8_BAR; PG8_MMA(1, 1, At, B1); PG8_BAR;
            PG8_LDB(B0, 1, 0); PG8_SCHED; PG8_LDA(At, 1, 0); PG8_STAGE(PG8_SA(0, 1), a2 + hstepA, voffA);
            PG8_WAIT_L(8); PG8_BAR; PG8_WAIT_L(0); PG8_MMA(0, 0, At, B0); PG8_BAR; PG8_SCHED;
            PG8_LDB(B1, 1, 1); PG8_STAGE(PG8_SB(1, 0), b3, voffB);
            PG8_BAR; PG8_WAIT_L(0); PG8_MMA(0, 1, At, B1); PG8_BAR;
            PG8_LDA(At, 1, 1); PG8_STAGE(PG8_SA(1, 0), a3, voffA);
            PG8_BAR; PG8_WAIT_L(0); PG8_MMA(1, 0, At, B0); PG8_BAR; PG8_SCHED;
            PG8_STAGE(PG8_SB(1, 1), b3 + hstepB, voffB);
            PG8_WAIT_V(6); PG8_BAR; PG8_MMA(1, 1, At, B1); PG8_BAR;
            }
        }
        if constexpr (ALIGN_EPI) { if (wr == 0) PG8_BAR; }
        if constexpr (!Epi::AFTER_DRAIN) { E(acc, cur, wr, wc, fr, fq); S.done(cur); }
        if (!has_next) break;
#pragma unroll
        for (int a = 0; a < 2; ++a)
#pragma unroll
            for (int b = 0; b < 2; ++b)
#pragma unroll
                for (int m = 0; m < 4; ++m)
#pragma unroll
                    for (int n = 0; n < 2; ++n) acc[a][b][m][n] = (f32x4){0.f, 0.f, 0.f, 0.f};
        cur = nxt; cA = nA; cB = nB; ++ui;
        if constexpr (ALIGN_EPI) { if (wr == 1) PG8_BAR; }
    }
    PG8_WAIT_V(0);
    if constexpr (!ALIGN_EPI) { if (wr == 0) PG8_BAR; }
    PG8_BAR;
    if constexpr (Epi::AFTER_DRAIN) { E.fused(acc, cur, wr, wc, fr, fq, lds, wid, lane); S.done(cur); }
#undef PG8_SA
#undef PG8_SB
#undef PG8_STAGE
#undef PG8_LDA
#undef PG8_LDB
#undef PG8_MMA
#undef PG8_WAIT_V
#undef PG8_WAIT_L
#undef PG8_BAR
#undef PG8_SCHED
}
}
#define GAS __attribute__((address_space(1)))
#define LAS __attribute__((address_space(3)))
typedef unsigned short bf16;
typedef unsigned v4u __attribute__((ext_vector_type(4)));
typedef float f32x4 __attribute__((ext_vector_type(4)));
typedef short bf16x8 __attribute__((ext_vector_type(8)));
typedef GAS unsigned gu32;
typedef GAS unsigned long long gu64;
#define RLX_AGENT __ATOMIC_RELAXED, __HIP_MEMORY_SCOPE_AGENT
#define LDS_WAIT() asm volatile("s_waitcnt lgkmcnt(0)" ::: "memory")
#define VM_WAIT() asm volatile("s_waitcnt vmcnt(0)" ::: "memory")
__device__ __forceinline__ unsigned long long rt() { return __builtin_amdgcn_s_memrealtime(); }
__device__ __forceinline__ unsigned f2bf(float f) { unsigned u = __builtin_bit_cast(unsigned, f); return (u + 0x7fffu + ((u >> 16) & 1u)) >> 16; }
__device__ __forceinline__ unsigned pk2(float lo, float hi) { return f2bf(lo) | (f2bf(hi) << 16); }

#define XB_TMO      128
#define XB_XCNT(j)  (256  + 64 * (j))
#define XB_XSUB(j)  (1280 + 64 * (j))
#define XB_XGEN(j)  (2304 + 64 * (j))
#define XB_TOP      3328
#define XB_TOPGEN   3392
#define XCD_BAR_WORDS 3456
#define XB_SPIN_CAP (1u << 18)

__device__ __forceinline__ unsigned xb_ld(unsigned* p)              { return __hip_atomic_load(p, __ATOMIC_RELAXED, __HIP_MEMORY_SCOPE_AGENT); }
__device__ __forceinline__ unsigned xb_add(unsigned* p, unsigned v) { return __hip_atomic_fetch_add(p, v, __ATOMIC_RELAXED, __HIP_MEMORY_SCOPE_AGENT); }
__device__ __forceinline__ unsigned xb_xcc_id() { return (unsigned)__builtin_amdgcn_s_getreg((3 << 11) | 20) & 0xFu; }
#define XB_SPIN(cond, bar) do { unsigned _sp = 0; while (cond) { __builtin_amdgcn_s_sleep(1); \
    if ((++_sp & 255u) == 0u) { if (xb_ld(&(bar)[XB_TMO])) break; if (_sp > XB_SPIN_CAP) { atomicAdd(&(bar)[XB_TMO], 1u); break; } } } } while (0)

struct XcdBarrier {
    unsigned* bar; unsigned x;
    volatile LAS unsigned* st;
};

__device__ __forceinline__ XcdBarrier xcd_barrier_post(unsigned* bar, volatile LAS unsigned* st) {
    XcdBarrier b; b.bar = bar; b.x = xb_xcc_id(); b.st = st;
    if (threadIdx.x == 0) (void)xb_add(&bar[XB_XCNT(b.x)], 1u);
    return b;
}
__device__ __forceinline__ void xcd_barrier_complete(unsigned* bar, unsigned x, unsigned& nloc, unsigned& nx) {
    const unsigned G = gridDim.x * gridDim.y * gridDim.z;
    unsigned sum, cnt, mine, sp = 0u;
    for (;;) {
        sum = 0u; cnt = 0u; mine = 0u;
#pragma unroll
        for (unsigned j = 0; j < 16; ++j) { const unsigned c = xb_ld(&bar[XB_XCNT(j)]); sum += c; cnt += (c > 0u) ? 1u : 0u; mine = (j == x) ? c : mine; }
        if (sum == G) break;
        __builtin_amdgcn_s_sleep(1);
        if ((++sp & 255u) == 0u) { if (xb_ld(&bar[XB_TMO])) break; if (sp > XB_SPIN_CAP) { atomicAdd(&bar[XB_TMO], 1u); break; } }
    }
    nloc = mine > 0u ? mine : 1u; nx = cnt > 0u ? cnt : 1u;
}

__device__ __forceinline__ void xcd_barrier(const XcdBarrier& b) {
    asm volatile("s_waitcnt vmcnt(0)" ::: "memory");
    __syncthreads();
    if (threadIdx.x == 0) {
        unsigned* bar = b.bar;
        __builtin_amdgcn_s_waitcnt(0);
        unsigned nloc = b.st[0], nx = b.st[1];
        if (nloc == 0u) { xcd_barrier_complete(bar, b.x, nloc, nx); b.st[0] = nloc; b.st[1] = nx; }
        const unsigned old = xb_add(&bar[XB_XSUB(b.x)], 1u);
        const unsigned gen = old / nloc;
        if (old + 1u == (gen + 1u) * nloc) {
            __builtin_amdgcn_fence(__ATOMIC_RELEASE, "agent");
            asm volatile("s_waitcnt vmcnt(0)" ::: "memory");
            const unsigned og = xb_add(&bar[XB_TOP], 1u);
            const unsigned tg = og / nx;
            if (og + 1u == (tg + 1u) * nx) xb_add(&bar[XB_TOPGEN], 1u);
            else XB_SPIN(xb_ld(&bar[XB_TOPGEN]) == tg, bar);
            __builtin_amdgcn_fence(__ATOMIC_ACQUIRE, "agent");
            xb_add(&bar[XB_XGEN(b.x)], 1u);
            asm volatile("s_waitcnt vmcnt(0)" ::: "memory");
        } else {
            XB_SPIN(xb_ld(&bar[XB_XGEN(b.x)]) == gen, bar);
            __builtin_amdgcn_fence(__ATOMIC_ACQUIRE, "agent");
            asm volatile("s_waitcnt vmcnt(0)" ::: "memory");
        }
    }
    __syncthreads();
}
constexpr int NWAVES = 8;
constexpr int BATCH = 16, SEQ = 2048, DM = 1024, M = BATCH * SEQ;
constexpr int L0P = 3584;
constexpr int L1P = 2048;
constexpr int DFF = 2816;
constexpr float ALPHA = 1.4142135623730951f;
typedef unsigned short bf16_t;
typedef float f32x16 __attribute__((ext_vector_type(16)));

constexpr size_t MiB = 1u << 20;
constexpr size_t WS_CTL = 0, CTL_ZERO_BYTES = 1 * MiB;
constexpr int CW_BAR = 4096;
constexpr size_t WS_W0IN = 2 * MiB, WS_W0OUT = 9 * MiB, WS_WUP0 = 11 * MiB, WS_WDN0 = 22 * MiB, WS_W1IN = 28 * MiB, WS_WUQ = 32 * MiB, WS_WUKV = 33 * MiB,
                 WS_W1OUT = 34 * MiB, WS_WUP1 = 36 * MiB, WS_WDN1 = 47 * MiB;
constexpr size_t WS_XB = 56 * MiB, WS_YMIX = 120 * MiB, WS_BIG = 184 * MiB;
constexpr size_t WS_G = 408 * MiB, WS_BONUS = 440 * MiB, WS_DT = 441 * MiB, WS_XST = 442 * MiB, WS_BT = 474 * MiB, WS_ASUM = 490 * MiB;
constexpr size_t WS_SLOC = 120 * MiB;
constexpr size_t WS_W2T = 53 * MiB, WS_A2T = 53 * MiB + 256 * 1024, WS_G2T = 53 * MiB + 512 * 1024;
constexpr size_t WS_GU = 120 * MiB;
constexpr size_t WS_PROJ1 = 184 * MiB, WS_QM = 312 * MiB, WS_KVM = 360 * MiB, WS_KPE = 424 * MiB, WS_RS = 426 * MiB;
constexpr size_t WS_CSTAB = 492 * MiB;
constexpr size_t WS_VTS = 428 * MiB, WS_VTM = 460 * MiB;
constexpr size_t WS_NEED = 497 * MiB;

constexpr int RING_BYTES = 131072;
constexpr int LDSCTL_OFF = 146432, MISC_OFF = LDSCTL_OFF + 320;
constexpr int LDS_BYTES = 147456;

__device__ __forceinline__ float bf2f(bf16_t b) { return __builtin_bit_cast(float, (unsigned)b << 16); }
__device__ __forceinline__ float sigmoidf_(float x) { return 1.f / (1.f + expf(-x)); }
__device__ __forceinline__ float softplusf_(float x) { return fmaxf(x, 0.f) + log1pf(expf(-fabsf(x))); }
__device__ __forceinline__ float siluf_(float x) { return x / (1.f + expf(-x)); }
__device__ __forceinline__ float wave_sum(float v) {
#pragma unroll
    for (int o = 1; o < 64; o <<= 1) v += __shfl_xor(v, o);
    return v;
}
#define WSYNC() asm volatile("s_waitcnt lgkmcnt(0)" ::: "memory")
typedef float f32x2_t __attribute__((ext_vector_type(2)));
typedef __bf16 bf16x2_t __attribute__((ext_vector_type(2)));
typedef unsigned u32x2 __attribute__((ext_vector_type(2)));
__device__ __forceinline__ unsigned cvtpk(float lo, float hi) { f32x2_t v = {lo, hi}; bf16x2_t b = __builtin_convertvector(v, bf16x2_t); return __builtin_bit_cast(unsigned, b); }
__device__ __forceinline__ float bflo(unsigned u) { return __builtin_bit_cast(float, u << 16); }
__device__ __forceinline__ float bfhi(unsigned u) { return __builtin_bit_cast(float, u & 0xffff0000u); }
__device__ __forceinline__ bf16_t bf1(float x) { return (bf16_t)(cvtpk(x, x) & 0xffffu); }
__device__ __forceinline__ bf16x8 pack8(float a0, float a1, float a2, float a3, float a4, float a5, float a6, float a7) {
    v4u w; w.x = cvtpk(a0, a1); w.y = cvtpk(a2, a3); w.z = cvtpk(a4, a5); w.w = cvtpk(a6, a7); return __builtin_bit_cast(bf16x8, w); }
template <int CTRL> __device__ __forceinline__ float dpp_mov(float x) { return __builtin_bit_cast(float, __builtin_amdgcn_update_dpp(0, __builtin_bit_cast(int, x), CTRL, 0xF, 0xF, true)); }
__device__ __forceinline__ float rowsum16(float x) { x += dpp_mov<0x128>(x); x += dpp_mov<0x124>(x); x += dpp_mov<0x122>(x); x += dpp_mov<0x121>(x); return x; }
__device__ __forceinline__ float rl(float x, int l) { return __builtin_bit_cast(float, __builtin_amdgcn_readlane(__builtin_bit_cast(int, x), l)); }
__device__ __forceinline__ float wave_sum_dpp(float x) { x = rowsum16(x); return (rl(x, 0) + rl(x, 16)) + (rl(x, 32) + rl(x, 48)); }

__device__ __forceinline__ void transpose_matrix(const float* __restrict__ W, int K, int N, bf16_t* __restrict__ WT, int Npad, int ldt, LAS float* scr, int gw, int NGW, int lane, const float* __restrict__ kscale, int& tr_base, bool ffn_interleave = false) {
    (void)scr;
    const int nblk = Npad / 64, nit = (K / 64) * nblk;
    int it0 = gw - (tr_base % NGW); if (it0 < 0) it0 += NGW; tr_base += nit;
    for (int it = it0; it < nit; it += NGW) {
        const int kb = it / nblk, nb = it - kb * nblk, n = nb * 64 + lane, k0 = kb * 64;
        const bool ok = n < N; const float* src = W + (size_t)k0 * N + (ok ? n : 0);
#pragma unroll
        for (int hc = 0; hc < 2; ++hc) {
            float v[32];
#pragma unroll
            for (int i = 0; i < 32; ++i) v[i] = src[(size_t)(hc * 32 + i) * N];
#pragma unroll
            for (int c = 0; c < 4; ++c) { float u[8];
#pragma unroll
                for (int i = 0; i < 8; ++i) { u[i] = ok ? v[c * 8 + i] : 0.f; if (kscale) u[i] *= kscale[k0 + hc * 32 + c * 8 + i]; }
                v4u o; o.x = cvtpk(u[0], u[1]); o.y = cvtpk(u[2], u[3]); o.z = cvtpk(u[4], u[5]); o.w = cvtpk(u[6], u[7]);
                const int nr = ffn_interleave ? ((n < DFF) ? 256 * (n >> 7) + (n & 127) : 256 * ((n - DFF) >> 7) + 128 + ((n - DFF) & 127)) : n;
                *(v4u*)(WT + (size_t)nr * ldt + k0 + hc * 32 + c * 8) = o; }
        }
    }
}

template <int MODE, int SEL = 0> __device__ __forceinline__ void ln_rows_range(const bf16_t* z, bf16_t* hb, float* outf, float* stats, const float* __restrict__ g, const float* __restrict__ b, int p0, int p1, int pstep, int lane) {
    auto rowof = [](int pi) { return SEL == 0 ? 2 * pi : SEL == 1 ? 64 * pi + 62 : 64 * (pi / 31) + 2 * (pi % 31); };
    pg8::u32x4 raw[2][2];
    if (p0 < p1) { const bf16_t* p = z + (size_t)rowof(p0) * DM;
#pragma unroll
        for (int r = 0; r < 2; ++r)
#pragma unroll
            for (int j = 0; j < 2; ++j) raw[r][j] = *(const pg8::u32x4*)(p + r * DM + 8 * lane + 512 * j); }
    for (int pi = p0; pi < p1; pi += pstep) {
        const int row = rowof(pi);
        f32x4 v[2][4]; float s[2] = {0.f, 0.f};
#pragma unroll
        for (int r = 0; r < 2; ++r)
#pragma unroll
            for (int j = 0; j < 2; ++j) {
                v[r][2 * j][0] = __builtin_bit_cast(float, raw[r][j].x << 16); v[r][2 * j][1] = __builtin_bit_cast(float, raw[r][j].x & 0xffff0000u);
                v[r][2 * j][2] = __builtin_bit_cast(float, raw[r][j].y << 16); v[r][2 * j][3] = __builtin_bit_cast(float, raw[r][j].y & 0xffff0000u);
                v[r][2 * j + 1][0] = __builtin_bit_cast(float, raw[r][j].z << 16); v[r][2 * j + 1][1] = __builtin_bit_cast(float, raw[r][j].z & 0xffff0000u);
                v[r][2 * j + 1][2] = __builtin_bit_cast(float, raw[r][j].w << 16); v[r][2 * j + 1][3] = __builtin_bit_cast(float, raw[r][j].w & 0xffff0000u); }
        { const int nxt = pi + pstep; const bf16_t* pn = z + (size_t)rowof(nxt < p1 ? nxt : pi) * DM;
#pragma unroll
          for (int r = 0; r < 2; ++r)
#pragma unroll
              for (int j = 0; j < 2; ++j) raw[r][j] = *(const pg8::u32x4*)(pn + r * DM + 8 * lane + 512 * j); }
#pragma unroll
        for (int r = 0; r < 2; ++r)
#pragma unroll
            for (int j = 0; j < 4; ++j) s[r] += (v[r][j][0] + v[r][j][1]) + (v[r][j][2] + v[r][j][3]);
        float mean[2], q[2] = {0.f, 0.f}, rstd[2];
#pragma unroll
        for (int r = 0; r < 2; ++r) { mean[r] = wave_sum_dpp(s[r]) * (1.f / DM);
#pragma unroll
            for (int j = 0; j < 4; ++j) { v[r][j] = v[r][j] - mean[r]; q[r] += (v[r][j][0] * v[r][j][0] + v[r][j][1] * v[r][j][1]) + (v[r][j][2] * v[r][j][2] + v[r][j][3] * v[r][j][3]); } }
#pragma unroll
        for (int r = 0; r < 2; ++r) rstd[r] = 1.0f / sqrtf(wave_sum_dpp(q[r]) * (1.f / DM) + 1e-5f);
        if (MODE == 1 && lane < 2) { stats[2 * (row + lane)] = lane ? mean[1] : mean[0]; stats[2 * (row + lane) + 1] = lane ? rstd[1] : rstd[0]; }
#pragma unroll
        for (int j = 0; j < 2; ++j) {
            const int c = 8 * lane + 512 * j;
            const f32x4 g0 = *(const f32x4*)(g + c), g1 = *(const f32x4*)(g + c + 4), b0 = *(const f32x4*)(b + c), b1 = *(const f32x4*)(b + c + 4);
#pragma unroll
            for (int r = 0; r < 2; ++r) {
                const f32x4 o0 = v[r][2 * j] * rstd[r] * g0 + b0, o1 = v[r][2 * j + 1] * rstd[r] * g1 + b1;
                if (MODE == 1) { pg8::u32x4 w; w.x = cvtpk(o0[0], o0[1]); w.y = cvtpk(o0[2], o0[3]); w.z = cvtpk(o1[0], o1[1]); w.w = cvtpk(o1[2], o1[3]); *(pg8::u32x4*)(hb + (size_t)(row + r) * DM + c) = w; }
                else { *(f32x4*)(outf + (size_t)(row + r) * DM + c) = o0; *(f32x4*)(outf + (size_t)(row + r) * DM + c + 4) = o1; }
            }
        }
    }
}

template <int MODE> __device__ __forceinline__ void ln_rows(const bf16_t* z, bf16_t* hb, float* outf, float* stats, const float* __restrict__ g, const float* __restrict__ b, int gw, int NGW, int lane) {
    ln_rows_range<MODE, 0>(z, hb, outf, stats, g, b, gw, M / 2, NGW, lane);
}
__device__ __forceinline__ void rwkv_naive_chain(int chain, int lane, LAS float* sm, const bf16_t* __restrict__ proj, const float* __restrict__ mix, const float* __restrict__ w0, const float* __restrict__ w2,
                                                 const float* __restrict__ a0, const float* __restrict__ a2, const float* __restrict__ g2, const float* __restrict__ k_k,
                                                 const float* __restrict__ k_a, const float* __restrict__ r_k, const float* __restrict__ ln_g, const float* __restrict__ ln_b, bf16_t* __restrict__ ymix) {
    LAS float* s_w2 = sm; LAS float* s_a2 = sm + 4096; LAS float* s_g2 = sm + 8192; LAS float* s_tw = sm + 16384; LAS float* s_al = s_tw + 64; LAS float* s_sg = s_tw + 128;
    LAS float* s_w = s_tw + 256; LAS float* s_k = s_tw + 320; LAS float* s_a = s_tw + 384; LAS float* s_b = s_tw + 448; LAS float* s_r = s_tw + 512;
    const int b = chain >> 3, h = chain & 7, c = h * 64 + lane;
    for (int l = 0; l < 64; ++l) { s_w2[l * 64 + lane] = w2[l * 512 + c]; s_a2[l * 64 + lane] = a2[l * 512 + c]; }
    for (int l = 0; l < 128; ++l) s_g2[l * 64 + lane] = g2[l * 512 + c];
    const float mr = mix[c], mk = mix[512 + c], mv = mix[1024 + c], mw = mix[1536 + lane], ma = mix[1600 + lane], mg0 = mix[1664 + lane], mg1 = mix[1728 + lane];
    const float w0c = w0[c], a0c = a0[c], kkc = k_k[c], kac = k_a[c], rkc = r_k[c], lgc = ln_g[c], lbc = ln_b[c];
    float S[64];
#pragma unroll
    for (int j = 0; j < 64; ++j) S[j] = 0.f;
    float pr = 0.f, pk = 0.f, pv = 0.f, pw = 0.f, pa = 0.f, pg0 = 0.f, pg1 = 0.f;
    WSYNC();
    for (int t = 0; t < SEQ; ++t) {
        const bf16_t* row = proj + (size_t)(b * SEQ + t) * L0P;
        const float cr = bf2f(row[c]), ck = bf2f(row[512 + c]), cv = bf2f(row[1024 + c]), cw = bf2f(row[1536 + lane]), ca = bf2f(row[1600 + lane]),
                    cg0 = bf2f(row[1664 + lane]), cg1 = bf2f(row[1728 + lane]);
        const float r_s = cr + (pr - cr) * mr, k_s = ck + (pk - ck) * mk, v_s = cv + (pv - cv) * mv;
        const float wl = cw + (pw - cw) * mw, al = ca + (pa - ca) * ma, g0 = cg0 + (pg0 - cg0) * mg0, g1 = cg1 + (pg1 - cg1) * mg1;
        pr = cr; pk = ck; pv = cv; pw = cw; pa = ca; pg0 = cg0; pg1 = cg1;
        s_tw[lane] = tanhf(wl); s_al[lane] = al; s_sg[lane] = sigmoidf_(g0); s_sg[64 + lane] = sigmoidf_(g1);
        WSYNC();
        float wsum = w0c, asum = a0c, gsum = 0.f;
#pragma unroll 2
        for (int l = 0; l < 64; ++l) { wsum += s_tw[l] * s_w2[l * 64 + lane]; asum += s_al[l] * s_a2[l * 64 + lane]; }
#pragma unroll 2
        for (int l = 0; l < 128; ++l) gsum += s_sg[l] * s_g2[l * 64 + lane];
        const float log_w = -softplusf_(-wsum) - 0.5f;
        const float dec = expf(-expf(log_w));
        const float a = sigmoidf_(asum);
        float kkv = k_s * kkc;
        const float nrm = sqrtf(wave_sum(kkv * kkv));
        kkv = kkv / fmaxf(nrm, 1e-12f);
        const float k2 = k_s * (1.f + (a - 1.f) * kac);
        const float bonus_s = wave_sum(r_s * k2 * rkc);
        s_w[lane] = dec; s_k[lane] = k2; s_a[lane] = -kkv; s_b[lane] = kkv * a; s_r[lane] = r_s;
        WSYNC();
        float sa = 0.f;
#pragma unroll
        for (int j = 0; j < 64; ++j) sa += S[j] * s_a[j];
        float y = 0.f;
#pragma unroll
        for (int j = 0; j < 64; ++j) { S[j] = S[j] * s_w[j] + sa * s_b[j] + v_s * s_k[j]; y += S[j] * s_r[j]; }
        const float mu = wave_sum(y) * (1.f / 64.f);
        const float d = y - mu;
        const float var = wave_sum(d * d) * (1.f / 64.f);
        const float yn = d * (1.0f / sqrtf(var + 64e-5f)) * lgc + lbc;
        const float o = (yn + bonus_s * v_s) * gsum;
        ymix[(size_t)(b * SEQ + t) * DM + c] = (bf16_t)f2bf(o);
        WSYNC();
    }
}

__device__ __forceinline__ void ssm_conv_all(const bf16_t* __restrict__ proj, const float* __restrict__ cw, const float* __restrict__ cb, const float* __restrict__ dtb,
                                             bf16_t* __restrict__ xbc, float* __restrict__ dt, int gtid, int NT) {
    for (size_t i = gtid; i < (size_t)M * 1024; i += NT) {
        const int m = (int)(i >> 10), c = (int)(i & 1023), t = m & (SEQ - 1);
        float acc = cb[c];
#pragma unroll
        for (int k = 0; k < 4; ++k) { const int tt = t - 3 + k; if (tt >= 0) acc += cw[k * 1024 + c] * bf2f(proj[(size_t)(m - 3 + k) * L0P + 2304 + c]); }
        xbc[i] = (bf16_t)f2bf(siluf_(acc));
    }
    for (int i = gtid; i < M * 8; i += NT) dt[i] = softplusf_(bf2f(proj[(size_t)(i >> 3) * L0P + 3328 + (i & 7)]) + dtb[i & 7]);
}
__device__ __forceinline__ void ssd_naive_task(int task, int lane, const bf16_t* __restrict__ xbc, const float* __restrict__ dt, const float* __restrict__ a_log, const float* __restrict__ dsk, float* __restrict__ yssm) {
    const int chain = task >> 2, q = task & 3, b = chain >> 3, h = chain & 7, g = h >> 2, p = q * 16 + (lane >> 2), nq = lane & 3;
    const float A = -expf(a_log[h]), D = dsk[h];
    float st[32];
#pragma unroll
    for (int n = 0; n < 32; ++n) st[n] = 0.f;
    for (int t = 0; t < SEQ; ++t) {
        const size_t m = (size_t)b * SEQ + t;
        const float dtv = dt[m * 8 + h], dA = expf(dtv * A);
        const float x = bf2f(xbc[m * 1024 + h * 64 + p]), xdt = x * dtv;
        const bf16_t* Bp = xbc + m * 1024 + 512 + g * 128 + nq * 32;
        const bf16_t* Cp = xbc + m * 1024 + 768 + g * 128 + nq * 32;
        float yp = 0.f;
#pragma unroll
        for (int n = 0; n < 32; ++n) { st[n] = st[n] * dA + xdt * bf2f(Bp[n]); yp += st[n] * bf2f(Cp[n]); }
        yp += __shfl_xor(yp, 1); yp += __shfl_xor(yp, 2);
        if (nq == 0) yssm[m * 512 + h * 64 + p] = yp + D * x;
    }
}
template <bool ST = true> __device__ __forceinline__ void ssm_gate_norm_all(const bf16_t* __restrict__ yssm, const bf16_t* __restrict__ proj, const float* __restrict__ ng, bf16_t* __restrict__ ymix, int wv0, int wvend, int lane) {
    for (int wvb = wv0 * 4 - (wv0 & ~7) * 3; wvb < wvend; wvb += NWAVES * 4) {
        float u[4][4], q[4];
#pragma unroll
        for (int k = 0; k < 4; ++k) { const int wv = wvb + k, m = wv >> 1, g = wv & 1; q[k] = 0.f;
#pragma unroll
            for (int j = 0; j < 4; ++j) { const int c = g * 256 + j * 64 + lane; const float z = bf2f(proj[(size_t)m * L0P + 1792 + c]); u[k][j] = bf2f(yssm[(size_t)m * 512 + c]) * (z * __builtin_amdgcn_rcpf(1.f + __expf(-z))); q[k] += u[k][j] * u[k][j]; } }
#pragma unroll
        for (int k = 0; k < 4; ++k) { const int wv = wvb + k, m = wv >> 1, g = wv & 1;
            const float rs = __builtin_amdgcn_rsqf(wave_sum_dpp(q[k]) * (1.f / 256.f) + 1e-5f);
#pragma unroll
            for (int j = 0; j < 4; ++j) { const int c = g * 256 + j * 64 + lane; const float o_ = u[k][j] * rs * ng[c]; if (ST) ymix[(size_t)m * DM + 512 + c] = bf1(o_); else asm volatile("" :: "v"(o_)); } }
    }
}
template <bool ST = true> __device__ __forceinline__ void ffn_act_all(bf16_t* gu, const float* __restrict__ cw, const float* __restrict__ cb, int gtid, int NT) {
    constexpr int NCH = DFF / 8, NSTRIP = M / 32;
    for (int task = gtid; task < NSTRIP * NCH; task += NT) {
        const int strip = task / NCH, q = task - strip * NCH, c0 = q * 8, m0 = strip * 32;
        float w0[8], w1[8], w2[8], bb[8], g2[8], g1[8];
#pragma unroll
        for (int j = 0; j < 8; j += 4) { const f32x4 a = *(const f32x4*)(cw + c0 + j), b = *(const f32x4*)(cw + DFF + c0 + j), c = *(const f32x4*)(cw + 2 * DFF + c0 + j), d = *(const f32x4*)(cb + c0 + j);
#pragma unroll
            for (int k = 0; k < 4; ++k) { w0[j + k] = a[k]; w1[j + k] = b[k]; w2[j + k] = c[k]; bb[j + k] = d[k]; } }
        bf16_t* base = gu + (size_t)m0 * (2 * DFF) + c0;
        if ((m0 & (SEQ - 1)) != 0) { const v4u a = *(const v4u*)(base - 2 * (2 * DFF)), b = *(const v4u*)(base - (2 * DFF));
            g2[0] = bflo(a.x); g2[1] = bfhi(a.x); g2[2] = bflo(a.y); g2[3] = bfhi(a.y); g2[4] = bflo(a.z); g2[5] = bfhi(a.z); g2[6] = bflo(a.w); g2[7] = bfhi(a.w);
            g1[0] = bflo(b.x); g1[1] = bfhi(b.x); g1[2] = bflo(b.y); g1[3] = bfhi(b.y); g1[4] = bflo(b.z); g1[5] = bfhi(b.z); g1[6] = bflo(b.w); g1[7] = bfhi(b.w); }
        else {
#pragma unroll
            for (int j = 0; j < 8; ++j) { g2[j] = 0.f; g1[j] = 0.f; } }
#pragma unroll 4
        for (int r = 0; r < 32; ++r) {
            const v4u gv = *(const v4u*)(base + (size_t)r * (2 * DFF)), uv = *(const v4u*)(base + (size_t)r * (2 * DFF) + DFF);
            const unsigned gw_[4] = {gv.x, gv.y, gv.z, gv.w}, uw_[4] = {uv.x, uv.y, uv.z, uv.w};
            unsigned ow[4];
#pragma unroll
            for (int k = 0; k < 4; ++k) {
                const float ga = bflo(gw_[k]), gb = bfhi(gw_[k]);
                const float ya = bb[2 * k] + w0[2 * k] * g2[2 * k] + w1[2 * k] * g1[2 * k] + w2[2 * k] * ga;
                const float yb = bb[2 * k + 1] + w0[2 * k + 1] * g2[2 * k + 1] + w1[2 * k + 1] * g1[2 * k + 1] + w2[2 * k + 1] * gb;
                g2[2 * k] = g1[2 * k]; g1[2 * k] = ga; g2[2 * k + 1] = g1[2 * k + 1]; g1[2 * k + 1] = gb;
                ow[k] = cvtpk(ya / (1.f + __expf(-ya)) * bflo(uw_[k]), yb / (1.f + __expf(-yb)) * bfhi(uw_[k]));
            }
            if (ST) *(v4u*)(base + (size_t)r * (2 * DFF) + DFF) = (v4u){ow[0], ow[1], ow[2], ow[3]}; else asm volatile("" :: "v"(ow[0]), "v"(ow[1]), "v"(ow[2]), "v"(ow[3]));
        }
    }
}
template <bool ST = true> __device__ __forceinline__ void mla_prep_all(const bf16_t* __restrict__ proj1, const int* __restrict__ pos, float* __restrict__ rs, bf16_t* __restrict__ kpe, float* __restrict__ cstab, int gw, int NGW, int lane) {
    const int fi = lane & 15, tk = lane >> 4;
    const double inv_rev = exp2(-(double)(2 * fi) * (13.287712379549449 / 32.0)) * 0.15915494309189535;
    for (int m4 = gw * 4; m4 < M; m4 += NGW * 4) {
        const int mt = m4 + tk;
        const bf16_t* row = proj1 + (size_t)mt * L1P;
        const v4u qa = *(const v4u*)(row + 1536 + 8 * fi), qb = *(const v4u*)(row + 1664 + 8 * fi), ka = *(const v4u*)(row + 1792 + 8 * fi);
        const float x1 = bf2f(row[1920 + fi]), x2 = bf2f(row[1936 + fi]);
        const double rev = (double)pos[mt] * inv_rev;
        const float fr = (float)(rev - floor(rev));
        const float cs = __builtin_amdgcn_cosf(fr), sn = __builtin_amdgcn_sinf(fr);
        cstab[(size_t)mt * 32 + fi] = cs; cstab[(size_t)mt * 32 + 16 + fi] = sn;
        kpe[(size_t)mt * 32 + fi] = bf1(x1 * cs - x2 * sn); kpe[(size_t)mt * 32 + 16 + fi] = bf1(x2 * cs + x1 * sn);
        float q = 0.f, k = 0.f;
#pragma unroll
        for (int e = 0; e < 4; ++e) { const float a0 = bflo(qa[e]), a1 = bfhi(qa[e]), b0 = bflo(qb[e]), b1 = bfhi(qb[e]), c0 = bflo(ka[e]), c1 = bfhi(ka[e]);
            q += (a0 * a0 + a1 * a1) + (b0 * b0 + b1 * b1); k += c0 * c0 + c1 * c1; }
        q = rowsum16(q); k = rowsum16(k);
        if (fi == 0) { rs[(size_t)mt * 2] = 1.0f / sqrtf(q * (1.f / 256.f) + 1e-6f); rs[(size_t)mt * 2 + 1] = 1.0f / sqrtf(k * (1.f / 128.f) + 1e-6f); }
    }
}
template <bool ST = true> __device__ __forceinline__ void rope_q_all(bf16_t* qm, const float* __restrict__ cstab, int gtid, int NT) {
    for (int i = gtid; i < M * 16; i += NT) {
        const int m = i >> 4, h = (i >> 1) & 7, k0 = (i & 1) * 8;
        bf16_t* p = qm + (size_t)m * 768 + h * 96 + 64 + k0;
        const v4u a = *(const v4u*)p, b = *(const v4u*)(p + 16);
        const f32x4 c0 = *(const f32x4*)(cstab + (size_t)m * 32 + k0), c1 = *(const f32x4*)(cstab + (size_t)m * 32 + k0 + 4), s0 = *(const f32x4*)(cstab + (size_t)m * 32 + 16 + k0), s1 = *(const f32x4*)(cstab + (size_t)m * 32 + 16 + k0 + 4);
        const unsigned au[4] = {a.x, a.y, a.z, a.w}, bu[4] = {b.x, b.y, b.z, b.w};
        const float cs[8] = {c0[0], c0[1], c0[2], c0[3], c1[0], c1[1], c1[2], c1[3]}, sn[8] = {s0[0], s0[1], s0[2], s0[3], s1[0], s1[1], s1[2], s1[3]};
        unsigned o1[4], o2[4];
#pragma unroll
        for (int q = 0; q < 4; ++q) { const float x1a = bflo(au[q]), x1b = bfhi(au[q]), x2a = bflo(bu[q]), x2b = bfhi(bu[q]);
            o1[q] = cvtpk(x1a * cs[2 * q] - x2a * sn[2 * q], x1b * cs[2 * q + 1] - x2b * sn[2 * q + 1]);
            o2[q] = cvtpk(x2a * cs[2 * q] + x1a * sn[2 * q], x2b * cs[2 * q + 1] + x1b * sn[2 * q + 1]); }
        if (ST) { *(v4u*)p = (v4u){o1[0], o1[1], o1[2], o1[3]}; *(v4u*)(p + 16) = (v4u){o2[0], o2[1], o2[2], o2[3]}; }
    }
}
__device__ __forceinline__ void sb_naive_task(int qblk, int bh, int lane, const bf16_t* __restrict__ proj1, bf16_t* __restrict__ ymix) {
    const int b = bh >> 3, h = bh & 7, t = qblk * 64 + lane;
    const size_t mrow = (size_t)b * SEQ;
    float q[64], o[64];
#pragma unroll
    for (int d = 0; d < 64; ++d) { q[d] = bf2f(proj1[(mrow + t) * L1P + h * 64 + d]) * 0.125f; o[d] = 0.f; }
    float cum = 0.f;
    const int smax = qblk * 64 + 63;
    for (int s = smax - 1; s >= 0; --s) {
        const bf16_t* kr = proj1 + (mrow + s) * L1P + 512 + h * 64;
        const bf16_t* vr = proj1 + (mrow + s) * L1P + 1024 + h * 64;
        float z = 0.f;
#pragma unroll
        for (int d = 0; d < 64; ++d) z += q[d] * bf2f(kr[d]);
        if (s < t) {
            const float lsp = -softplusf_(-z);
            const float lsn = -softplusf_(z);
            const float att = expf(lsp + cum);
            cum += lsn;
#pragma unroll
            for (int d = 0; d < 64; ++d) o[d] += att * bf2f(vr[d]);
        }
    }
#pragma unroll
    for (int d = 0; d < 64; ++d) ymix[(mrow + t) * DM + h * 64 + d] = (bf16_t)f2bf(o[d]);
}
__device__ __forceinline__ void mla_naive_task(int qblk, int bh, int lane, const bf16_t* __restrict__ qm, const bf16_t* __restrict__ kvm, const bf16_t* __restrict__ kpe, bf16_t* __restrict__ ymix) {
    const int b = bh >> 3, h = bh & 7, t = qblk * 64 + lane;
    const size_t mrow = (size_t)b * SEQ;
    const float scale = 0.10206207261596577f;
    float q[96], o[64];
#pragma unroll
    for (int d = 0; d < 96; ++d) q[d] = bf2f(qm[(mrow + t) * 768 + h * 96 + d]) * scale;
#pragma unroll
    for (int d = 0; d < 64; ++d) o[d] = 0.f;
    float mx = -1e30f, l = 0.f;
    const int smax = qblk * 64 + 63;
    for (int s = 0; s <= smax; ++s) {
        const bf16_t* kr = kvm + (mrow + s) * 1024 + h * 128;
        const bf16_t* pr = kpe + (mrow + s) * 32;
        float z = 0.f;
#pragma unroll
        for (int d = 0; d < 64; ++d) z += q[d] * bf2f(kr[d]);
#pragma unroll
        for (int d = 0; d < 32; ++d) z += q[64 + d] * bf2f(pr[d]);
        if (s <= t) {
            const float mn = fmaxf(mx, z), f = expf(mx - mn), pz = expf(z - mn);
            l = l * f + pz; mx = mn;
#pragma unroll
            for (int d = 0; d < 64; ++d) o[d] = o[d] * f + pz * bf2f(kr[64 + d]);
        }
    }
    const float il = 1.f / l;
#pragma unroll
    for (int d = 0; d < 64; ++d) ymix[(mrow + t) * DM + 512 + h * 64 + d] = (bf16_t)f2bf(o[d] * il);
}


__device__ __forceinline__ int crow(int r, int hi) { return (r & 3) + 8 * (r >> 2) + 4 * hi; }
#define MFMA32(a, b, c) __builtin_amdgcn_mfma_f32_32x32x16_bf16((a), (b), (c), 0, 0, 0)
constexpr int STG_PITCH = 72;
__device__ __forceinline__ void transpose_tile64(const bf16_t* __restrict__ src, int sp, bf16_t* __restrict__ dst, int dp, LAS bf16_t* scr, int lane) {
#pragma unroll
    for (int i = 0; i < 8; ++i) { const int row = i * 8 + (lane >> 3), ch = lane & 7; const v4u v = *(const v4u*)(src + (size_t)row * sp + ch * 8); *(LAS v4u*)(scr + row * STG_PITCH + ch * 8) = v; }
    WSYNC();
#pragma unroll
    for (int i = 0; i < 8; ++i) { const int d = i * 8 + (lane >> 3), tc = lane & 7; const LAS bf16_t* p = scr + (tc * 8) * STG_PITCH + d;
        v4u o; o.x = (unsigned)p[0] | ((unsigned)p[STG_PITCH] << 16); o.y = (unsigned)p[2 * STG_PITCH] | ((unsigned)p[3 * STG_PITCH] << 16);
        o.z = (unsigned)p[4 * STG_PITCH] | ((unsigned)p[5 * STG_PITCH] << 16); o.w = (unsigned)p[6 * STG_PITCH] | ((unsigned)p[7 * STG_PITCH] << 16);
        *(v4u*)(dst + (size_t)d * dp + tc * 8) = o; }
    WSYNC();
}
__device__ __forceinline__ void store_OT(const f32x16 (&o)[2], float sc, LAS bf16_t* stg, bf16_t* __restrict__ dst, int lane) {
    const int l31 = lane & 31, hi = lane >> 5;
#pragma unroll
    for (int dt = 0; dt < 2; ++dt)
#pragma unroll
        for (int r = 0; r < 16; ++r) stg[l31 * STG_PITCH + 32 * dt + crow(r, hi)] = bf1(o[dt][r] * sc);
    WSYNC();
#pragma unroll
    for (int i = 0; i < 4; ++i) { const int row = i * 8 + (lane >> 3), ch = lane & 7; const v4u v = *(const LAS v4u*)(stg + row * STG_PITCH + ch * 8); *(v4u*)(dst + (size_t)row * DM + ch * 8) = v; }
    WSYNC();
}
__device__ __forceinline__ float softplus_fast(float z) { return fmaxf(z, 0.f) + __logf(1.f + __expf(-fabsf(z))); }

__device__ __forceinline__ void sb_task(int bh, int qblk, int lane, const bf16_t* __restrict__ P1, const bf16_t* __restrict__ VT, bf16_t* __restrict__ ymix, LAS bf16_t* stg) {
    const int b = bh >> 3, h = bh & 7, l31 = lane & 31, hi = lane >> 5, q0 = qblk * 32, t = q0 + l31;
    const size_t rowb = (size_t)b * SEQ;
    const bf16_t* Qp = P1 + (rowb + q0 + l31) * L1P + h * 64 + 8 * hi;
    bf16x8 qf[4];
#pragma unroll
    for (int kk = 0; kk < 4; ++kk) qf[kk] = *(const bf16x8*)(Qp + 16 * kk);
    const bf16_t* Kp = P1 + (rowb + l31) * L1P + 512 + h * 64 + 8 * hi;
    const bf16_t* Vp = VT + ((size_t)bh * 64 + l31) * SEQ + 4 * hi;
    f32x16 o[2];
#pragma unroll
    for (int r = 0; r < 16; ++r) { o[0][r] = 0.f; o[1][r] = 0.f; }
    float cum = 0.f;
    bf16x8 kf[4]; u32x2 va[2][2][2];
#define SB_LOAD(S0, KF, VA) do { _Pragma("unroll") for (int kk = 0; kk < 4; ++kk) KF[kk] = *(const bf16x8*)(Kp + (size_t)(S0) * L1P + 16 * kk); \
        _Pragma("unroll") for (int dt = 0; dt < 2; ++dt) _Pragma("unroll") for (int ks = 0; ks < 2; ++ks) { VA[dt][ks][0] = *(const u32x2*)(Vp + (size_t)dt * 32 * SEQ + (S0) + 16 * ks); VA[dt][ks][1] = *(const u32x2*)(Vp + (size_t)dt * 32 * SEQ + (S0) + 16 * ks + 8); } } while (0)
    SB_LOAD(q0, kf, va);
    for (int s0 = q0; s0 >= 0; s0 -= 32) {
        bf16x8 kn[4]; u32x2 vn[2][2][2];
        const int sn = (s0 >= 32) ? s0 - 32 : 0;
        SB_LOAD(sn, kn, vn);
        f32x16 acc;
#pragma unroll
        for (int r = 0; r < 16; ++r) acc[r] = 0.f;
#pragma unroll
        for (int kk = 0; kk < 4; ++kk) acc = MFMA32(kf[kk], qf[kk], acc);
        const bool diag = (s0 == q0);
        float lb[16], lk[16];
#pragma unroll
        for (int r = 0; r < 16; ++r) { const float z = acc[r] * 0.125f; const float sp = softplus_fast(z); float b_ = z - sp, k_ = -sp;
            if (diag) { const bool valid = (s0 + crow(r, hi)) < t; b_ = valid ? b_ : -1e30f; k_ = valid ? k_ : 0.f; }
            lb[r] = b_; lk[r] = k_; }
        float e[16], T[4], U[4];
#pragma unroll
        for (int i = 0; i < 4; ++i) { e[4 * i + 3] = 0.f; e[4 * i + 2] = lk[4 * i + 3]; e[4 * i + 1] = e[4 * i + 2] + lk[4 * i + 2]; e[4 * i] = e[4 * i + 1] + lk[4 * i + 1]; T[i] = e[4 * i] + lk[4 * i]; }
#pragma unroll
        for (int i = 0; i < 4; ++i) U[i] = __shfl_xor(T[i], 32);
        float off[4];
        { const float st2 = T[3], st1 = st2 + T[2], st0 = st1 + T[1]; const float su2 = U[3], su1 = su2 + U[2], su0 = su1 + U[1];
          const float x0 = hi ? 0.f : U[0], x1 = hi ? 0.f : U[1], x2 = hi ? 0.f : U[2], x3 = hi ? 0.f : U[3];
          off[3] = x3; off[2] = st2 + su2 + x2; off[1] = st1 + su1 + x1; off[0] = st0 + su0 + x0;
          const float total = st0 + T[0] + su0 + U[0];
#pragma unroll
          for (int r = 0; r < 16; ++r) acc[r] = __expf(lb[r] + (cum + off[r >> 2] + e[r]));
          cum += total; }
        bf16x8 pf[2];
#pragma unroll
        for (int ks = 0; ks < 2; ++ks) { v4u w; w.x = cvtpk(acc[8 * ks], acc[8 * ks + 1]); w.y = cvtpk(acc[8 * ks + 2], acc[8 * ks + 3]); w.z = cvtpk(acc[8 * ks + 4], acc[8 * ks + 5]); w.w = cvtpk(acc[8 * ks + 6], acc[8 * ks + 7]); pf[ks] = __builtin_bit_cast(bf16x8, w); }
#pragma unroll
        for (int dt = 0; dt < 2; ++dt)
#pragma unroll
            for (int ks = 0; ks < 2; ++ks) { v4u a; a.x = va[dt][ks][0].x; a.y = va[dt][ks][0].y; a.z = va[dt][ks][1].x; a.w = va[dt][ks][1].y; o[dt] = MFMA32(__builtin_bit_cast(bf16x8, a), pf[ks], o[dt]); }
        if (__all(cum < -110.f)) break;
#pragma unroll
        for (int kk = 0; kk < 4; ++kk) kf[kk] = kn[kk];
#pragma unroll
        for (int dt = 0; dt < 2; ++dt)
#pragma unroll
            for (int ks = 0; ks < 2; ++ks) { va[dt][ks][0] = vn[dt][ks][0]; va[dt][ks][1] = vn[dt][ks][1]; }
    }
#undef SB_LOAD
    store_OT(o, 1.0f, stg, ymix + (rowb + q0) * DM + h * 64, lane);
}
__device__ __forceinline__ void mla_task(int bh, int qblk, int lane, const bf16_t* __restrict__ QM, const bf16_t* __restrict__ KVM, const bf16_t* __restrict__ KPE, const bf16_t* __restrict__ VT,
                                         bf16_t* __restrict__ ymix, LAS bf16_t* stg) {
    const int b = bh >> 3, h = bh & 7, l31 = lane & 31, hi = lane >> 5, q0 = qblk * 32, t = q0 + l31;
    const size_t rowb = (size_t)b * SEQ;
    const bf16_t* Qp = QM + (rowb + q0 + l31) * 768 + h * 96 + 8 * hi;
    bf16x8 qf[6];
#pragma unroll
    for (int kk = 0; kk < 6; ++kk) qf[kk] = *(const bf16x8*)(Qp + 16 * kk);
    const bf16_t* Kn = KVM + (rowb + l31) * 1024 + h * 128 + 8 * hi;
    const bf16_t* Kr = KPE + (rowb + l31) * 32 + 8 * hi;
    const bf16_t* Vp = VT + ((size_t)bh * 64 + l31) * SEQ + 4 * hi;
    const float sc2 = 0.10206207261596577f * 1.4426950408889634f;
    f32x16 o[2];
#pragma unroll
    for (int r = 0; r < 16; ++r) { o[0][r] = 0.f; o[1][r] = 0.f; }
    float mrun = -1e30f, lsum = 0.f;
    bf16x8 kf[6]; u32x2 va[2][2][2];
#define ML_LOAD(S0, KF, VA) do { _Pragma("unroll") for (int kk = 0; kk < 4; ++kk) KF[kk] = *(const bf16x8*)(Kn + (size_t)(S0) * 1024 + 16 * kk); \
        _Pragma("unroll") for (int kk = 0; kk < 2; ++kk) KF[4 + kk] = *(const bf16x8*)(Kr + (size_t)(S0) * 32 + 16 * kk); \
        _Pragma("unroll") for (int dt = 0; dt < 2; ++dt) _Pragma("unroll") for (int ks = 0; ks < 2; ++ks) { VA[dt][ks][0] = *(const u32x2*)(Vp + (size_t)dt * 32 * SEQ + (S0) + 16 * ks); VA[dt][ks][1] = *(const u32x2*)(Vp + (size_t)dt * 32 * SEQ + (S0) + 16 * ks + 8); } } while (0)
    ML_LOAD(0, kf, va);
    for (int s0 = 0; s0 <= q0; s0 += 32) {
        bf16x8 kn[6]; u32x2 vn[2][2][2];
        const int sn = (s0 + 32 <= q0) ? s0 + 32 : s0;
        ML_LOAD(sn, kn, vn);
        f32x16 acc;
#pragma unroll
        for (int r = 0; r < 16; ++r) acc[r] = 0.f;
#pragma unroll
        for (int kk = 0; kk < 6; ++kk) acc = MFMA32(kf[kk], qf[kk], acc);
        const bool diag = (s0 == q0);
        float tmax = -1e30f;
#pragma unroll
        for (int r = 0; r < 16; ++r) { float z = acc[r] * sc2; if (diag && (s0 + crow(r, hi)) > t) z = -1e30f; acc[r] = z; tmax = fmaxf(tmax, z); }
        tmax = fmaxf(tmax, __shfl_xor(tmax, 32));
        const float mn = fmaxf(mrun, tmax), alpha = exp2f(mrun - mn); mrun = mn;
        float ps = 0.f;
#pragma unroll
        for (int r = 0; r < 16; ++r) { acc[r] = exp2f(acc[r] - mn); ps += acc[r]; }
        lsum = lsum * alpha + ps;
#pragma unroll
        for (int r = 0; r < 16; ++r) { o[0][r] *= alpha; o[1][r] *= alpha; }
        bf16x8 pf[2];
#pragma unroll
        for (int ks = 0; ks < 2; ++ks) { v4u w; w.x = cvtpk(acc[8 * ks], acc[8 * ks + 1]); w.y = cvtpk(acc[8 * ks + 2], acc[8 * ks + 3]); w.z = cvtpk(acc[8 * ks + 4], acc[8 * ks + 5]); w.w = cvtpk(acc[8 * ks + 6], acc[8 * ks + 7]); pf[ks] = __builtin_bit_cast(bf16x8, w); }
#pragma unroll
        for (int dt = 0; dt < 2; ++dt)
#pragma unroll
            for (int ks = 0; ks < 2; ++ks) { v4u a; a.x = va[dt][ks][0].x; a.y = va[dt][ks][0].y; a.z = va[dt][ks][1].x; a.w = va[dt][ks][1].y; o[dt] = MFMA32(__builtin_bit_cast(bf16x8, a), pf[ks], o[dt]); }
#pragma unroll
        for (int kk = 0; kk < 6; ++kk) kf[kk] = kn[kk];
#pragma unroll
        for (int dt = 0; dt < 2; ++dt)
#pragma unroll
            for (int ks = 0; ks < 2; ++ks) { va[dt][ks][0] = vn[dt][ks][0]; va[dt][ks][1] = vn[dt][ks][1]; }
    }
#undef ML_LOAD
    lsum += __shfl_xor(lsum, 32);
    store_OT(o, 1.0f / lsum, stg, ymix + (rowb + q0) * DM + 512 + h * 64, lane);
}


__device__ __forceinline__ void sb_wave(int bh, int qblk, int lane, const bf16_t* __restrict__ P1, const bf16_t* __restrict__ VT, bf16_t* __restrict__ ymix, LAS unsigned char* wl) {
    const int b = bh >> 3, h = bh & 7, l31 = lane & 31, hi = lane >> 5, q0 = qblk * 32, t = q0 + l31;
    const size_t rowb = (size_t)b * SEQ;
    bf16x8 qf[4];
    { const bf16_t* Qp = P1 + (rowb + q0 + l31) * L1P + h * 64 + 8 * hi;
#pragma unroll
      for (int kk = 0; kk < 4; ++kk) qf[kk] = *(const bf16x8*)(Qp + 16 * kk); }
    f32x16 o[2];
#pragma unroll
    for (int r = 0; r < 16; ++r) { o[0][r] = 0.f; o[1][r] = 0.f; }
    float cum = 1.f;
    const bf16_t* gK = P1 + (rowb + (lane >> 3)) * L1P + 512 + h * 64 + (lane & 7) * 8;
    const bf16_t* gV = VT + ((size_t)bh * 64 + (lane >> 2)) * SEQ + (lane & 3) * 8;
    const int lK = (lane >> 3) * 144 + (lane & 7) * 16, lV = 4608 + (lane >> 2) * 72 + (lane & 3) * 16;
    v4u rk[4], rv[4];
#pragma unroll
    for (int i = 0; i < 4; ++i) { rk[i] = *(const v4u*)(gK + (size_t)(q0 + 8 * i) * L1P); rv[i] = *(const v4u*)(gV + (size_t)(16 * i) * SEQ + q0); }
#pragma unroll 1
    for (int s0 = q0; s0 >= 0; s0 -= 32) {
#pragma unroll
        for (int i = 0; i < 4; ++i) { *(LAS v4u*)(wl + lK + i * 8 * 144) = rk[i]; *(LAS u32x2*)(wl + lV + i * 16 * 72) = (u32x2){rv[i].x, rv[i].y}; *(LAS u32x2*)(wl + lV + i * 16 * 72 + 8) = (u32x2){rv[i].z, rv[i].w}; }
        { const int sn = (s0 >= 32) ? s0 - 32 : 0;
#pragma unroll
          for (int i = 0; i < 4; ++i) { rk[i] = *(const v4u*)(gK + (size_t)(sn + 8 * i) * L1P); rv[i] = *(const v4u*)(gV + (size_t)(16 * i) * SEQ + sn); } }
        WSYNC();
        f32x16 acc;
#pragma unroll
        for (int r = 0; r < 16; ++r) acc[r] = 0.f;
#pragma unroll
        for (int kk = 0; kk < 4; ++kk) { const bf16x8 kf = *(const LAS bf16x8*)(wl + l31 * 144 + (16 * kk + 8 * hi) * 2); acc = MFMA32(kf, qf[kk], acc); }
        const bool diag = (s0 == q0);
        float bt[16], kp[16];
#pragma unroll
        for (int r = 0; r < 16; ++r) { const float ee = __builtin_amdgcn_exp2f(fminf(acc[r] * (-0.125f * 1.4426950408889634f), 100.f)); const float ri = __builtin_amdgcn_rcpf(1.f + ee);
            float b_ = ri, k_ = ee * ri;
            if (diag) { const bool valid = (s0 + crow(r, hi)) < t; b_ = valid ? b_ : 0.f; k_ = valid ? k_ : 1.f; }
            bt[r] = b_; kp[r] = k_; }
        float e[16], T[4], U[4];
#pragma unroll
        for (int q = 0; q < 4; ++q) { e[4 * q + 3] = 1.f; e[4 * q + 2] = kp[4 * q + 3]; e[4 * q + 1] = e[4 * q + 2] * kp[4 * q + 2]; e[4 * q] = e[4 * q + 1] * kp[4 * q + 1]; T[q] = e[4 * q] * kp[4 * q]; }
#pragma unroll
        for (int q = 0; q < 4; ++q) U[q] = __shfl_xor(T[q], 32);
        { const float st2 = T[3], st1 = st2 * T[2], st0 = st1 * T[1]; const float su2 = U[3], su1 = su2 * U[2], su0 = su1 * U[1];
          const float x0 = hi ? 1.f : U[0], x1 = hi ? 1.f : U[1], x2 = hi ? 1.f : U[2], x3 = hi ? 1.f : U[3];
          const float off[4] = {cum * (st0 * su0 * x0), cum * (st1 * su1 * x1), cum * (st2 * su2 * x2), cum * x3};
#pragma unroll
          for (int r = 0; r < 16; ++r) acc[r] = bt[r] * (off[r >> 2] * e[r]);
          cum *= (st0 * T[0]) * (su0 * U[0]); }
        bf16x8 pf[2];
#pragma unroll
        for (int ks = 0; ks < 2; ++ks) pf[ks] = pack8(acc[8 * ks], acc[8 * ks + 1], acc[8 * ks + 2], acc[8 * ks + 3], acc[8 * ks + 4], acc[8 * ks + 5], acc[8 * ks + 6], acc[8 * ks + 7]);
#pragma unroll
        for (int dt = 0; dt < 2; ++dt)
#pragma unroll
            for (int ks = 0; ks < 2; ++ks) { const LAS unsigned char* vp = wl + 4608 + (32 * dt + l31) * 72 + (16 * ks + 4 * hi) * 2;
                const u32x2 x0 = *(const LAS u32x2*)vp, x1 = *(const LAS u32x2*)(vp + 16);
                v4u a; a.x = x0.x; a.y = x0.y; a.z = x1.x; a.w = x1.y; o[dt] = MFMA32(__builtin_bit_cast(bf16x8, a), pf[ks], o[dt]); }
        WSYNC();
        if (__all(cum < 1e-35f)) break;
    }
    store_OT(o, 1.0f, (LAS bf16_t*)(wl + 9216), ymix + (rowb + q0) * DM + h * 64, lane);
}

constexpr int MLK_PITCH = 104, MLV_PITCH = 68, MLK_BYTES = 64 * MLK_PITCH * 2, MLV_BYTES = 64 * MLV_PITCH * 2, ML_STAGE = MLK_BYTES + MLV_BYTES;
__device__ __forceinline__ void mla_block(int bh, int sb, int tid, int lane, int wave, LAS unsigned char* lds, const bf16_t* __restrict__ QM, const bf16_t* __restrict__ KVM, const bf16_t* __restrict__ KPE,
                                          const bf16_t* __restrict__ VT, bf16_t* __restrict__ ymix, const float* __restrict__ cstab) {
    const int b = bh >> 3, h = bh & 7, l31 = lane & 31, hi = lane >> 5, q0 = 256 * sb + 32 * wave, t = q0 + l31;
    const size_t rowb = (size_t)b * SEQ;
    const int nsteps = 4 * sb + 4;
    bf16x8 qf[6];
    { const bf16_t* Qp = QM + (rowb + q0 + l31) * 768 + h * 96 + 8 * hi;
#pragma unroll
      for (int kk = 0; kk < 6; ++kk) qf[kk] = *(const bf16x8*)(Qp + 16 * kk);
      const float* ct = cstab + (rowb + q0 + l31) * 32 + 8 * hi;
      const f32x4 c0 = *(const f32x4*)ct, c1 = *(const f32x4*)(ct + 4), s0 = *(const f32x4*)(ct + 16), s1 = *(const f32x4*)(ct + 20);
#pragma unroll
      for (int j = 0; j < 8; ++j) { const float cs = j < 4 ? c0[j & 3] : c1[j & 3], sn = j < 4 ? s0[j & 3] : s1[j & 3];
          const float x1 = bf2f((bf16_t)qf[4][j]), x2 = bf2f((bf16_t)qf[5][j]);
          qf[4][j] = (short)bf1(x1 * cs - x2 * sn); qf[5][j] = (short)bf1(x2 * cs + x1 * sn); } }
    const float sc2 = 0.10206207261596577f * 1.4426950408889634f;
    f32x16 o[2];
#pragma unroll
    for (int r = 0; r < 16; ++r) { o[0][r] = 0.f; o[1][r] = 0.f; }
    float mrun = -1e30f, lsum = 0.f;
    const bf16_t* gKn = KVM + (rowb + (tid >> 3)) * 1024 + h * 128 + (tid & 7) * 8;
    const bf16_t* gKr = KPE + (rowb + ((tid & 255) >> 2)) * 32 + (tid & 3) * 8;
    const bf16_t* gVt = VT + ((size_t)bh * 64 + (tid >> 3)) * SEQ + (tid & 7) * 8;
    const int lKn = (tid >> 3) * (MLK_PITCH * 2) + (tid & 7) * 16, lKr = ((tid & 255) >> 2) * (MLK_PITCH * 2) + 128 + (tid & 3) * 16, lVt = MLK_BYTES + (tid >> 3) * (MLV_PITCH * 2) + (tid & 7) * 16;
    v4u rk, rr, rv;
    rk = *(const v4u*)gKn; rr = *(const v4u*)gKr; rv = *(const v4u*)gVt;
    *(LAS v4u*)(lds + lKn) = rk; if (tid < 256) *(LAS v4u*)(lds + lKr) = rr; *(LAS u32x2*)(lds + lVt) = (u32x2){rv.x, rv.y}; *(LAS u32x2*)(lds + lVt + 8) = (u32x2){rv.z, rv.w};
    __syncthreads();
#pragma unroll 1
    for (int step = 0; step < nsteps; ++step) {
        const int nx = (step + 1 < nsteps) ? step + 1 : step;
        rk = *(const v4u*)(gKn + (size_t)nx * 64 * 1024); rr = *(const v4u*)(gKr + (size_t)nx * 64 * 32); rv = *(const v4u*)(gVt + nx * 64);
        const LAS unsigned char* Kb = lds + (step & 1) * ML_STAGE;
        const LAS unsigned char* Vb = Kb + MLK_BYTES;
        if (64 * step <= q0) {
            f32x16 acc[2];
            {
                bf16x8 kf[2][6];
#pragma unroll
                for (int sub = 0; sub < 2; ++sub)
#pragma unroll
                    for (int kk = 0; kk < 6; ++kk) kf[sub][kk] = *(const LAS bf16x8*)(Kb + (32 * sub + l31) * (MLK_PITCH * 2) + (16 * kk + 8 * hi) * 2);
                __builtin_amdgcn_sched_barrier(0);
#pragma unroll
                for (int r = 0; r < 16; ++r) { acc[0][r] = 0.f; acc[1][r] = 0.f; }
#pragma unroll
                for (int kk = 0; kk < 6; ++kk) { acc[0] = MFMA32(kf[0][kk], qf[kk], acc[0]); acc[1] = MFMA32(kf[1][kk], qf[kk], acc[1]); }
            }
            u32x2 vx[2][2][2][2];
#pragma unroll
            for (int sub = 0; sub < 2; ++sub)
#pragma unroll
                for (int dt = 0; dt < 2; ++dt)
#pragma unroll
                    for (int ks = 0; ks < 2; ++ks) { const LAS unsigned char* vp = Vb + (32 * dt + l31) * (MLV_PITCH * 2) + (32 * sub + 16 * ks + 4 * hi) * 2;
                        vx[sub][dt][ks][0] = *(const LAS u32x2*)vp; vx[sub][dt][ks][1] = *(const LAS u32x2*)(vp + 16); }
            __builtin_amdgcn_sched_barrier(0);
            float tmax = -1e30f;
#pragma unroll
            for (int sub = 0; sub < 2; ++sub) { const int s0 = 64 * step + 32 * sub;
                if (s0 + 31 > q0) {
#pragma unroll
                    for (int r = 0; r < 16; ++r) if ((s0 + crow(r, hi)) > t) acc[sub][r] = -1e30f; }
#pragma unroll
                for (int r = 0; r < 16; ++r) tmax = fmaxf(tmax, acc[sub][r]); }
            tmax = fmaxf(tmax, __shfl_xor(tmax, 32)) * sc2;
            if (__any(tmax - mrun > 6.f)) {
                const float mn = fmaxf(mrun, tmax), alpha = __builtin_amdgcn_exp2f(mrun - mn); mrun = mn; lsum *= alpha;
#pragma unroll
                for (int r = 0; r < 16; ++r) { o[0][r] *= alpha; o[1][r] *= alpha; }
            }
            float ps = 0.f;
#pragma unroll
            for (int sub = 0; sub < 2; ++sub)
#pragma unroll
                for (int r = 0; r < 16; ++r) { acc[sub][r] = __builtin_amdgcn_exp2f(acc[sub][r] * sc2 - mrun); ps += acc[sub][r]; }
            lsum += ps;
#pragma unroll
            for (int sub = 0; sub < 2; ++sub) {
                bf16x8 pf[2];
#pragma unroll
                for (int ks = 0; ks < 2; ++ks) pf[ks] = pack8(acc[sub][8 * ks], acc[sub][8 * ks + 1], acc[sub][8 * ks + 2], acc[sub][8 * ks + 3], acc[sub][8 * ks + 4], acc[sub][8 * ks + 5], acc[sub][8 * ks + 6], acc[sub][8 * ks + 7]);
#pragma unroll
                for (int ks = 0; ks < 2; ++ks)
#pragma unroll
                    for (int dt = 0; dt < 2; ++dt) { v4u a; a.x = vx[sub][dt][ks][0].x; a.y = vx[sub][dt][ks][0].y; a.z = vx[sub][dt][ks][1].x; a.w = vx[sub][dt][ks][1].y;
                        o[dt] = MFMA32(__builtin_bit_cast(bf16x8, a), pf[ks], o[dt]); }
            }
        }
        LAS unsigned char* nb = lds + ((step + 1) & 1) * ML_STAGE;
        *(LAS v4u*)(nb + lKn) = rk; if (tid < 256) *(LAS v4u*)(nb + lKr) = rr; *(LAS u32x2*)(nb + lVt) = (u32x2){rv.x, rv.y}; *(LAS u32x2*)(nb + lVt + 8) = (u32x2){rv.z, rv.w};
        __syncthreads();
    }
    lsum += __shfl_xor(lsum, 32);
    store_OT(o, 1.0f / lsum, (LAS bf16_t*)(lds + 2 * ML_STAGE) + wave * (32 * STG_PITCH), ymix + (rowb + q0) * DM + 512 + h * 64, lane);
    __syncthreads();
}


constexpr int SBK_PITCH = 72, SBK_BYTES = 64 * SBK_PITCH * 2, SB_STAGE = SBK_BYTES + MLV_BYTES;
__device__ __forceinline__ void sb_block(int bh, int sb, int tid, int lane, int wave, LAS unsigned char* lds, const bf16_t* __restrict__ P1, const bf16_t* __restrict__ VT, bf16_t* __restrict__ ymix) {
    const int b = bh >> 3, h = bh & 7, l31 = lane & 31, hi = lane >> 5, q0 = 256 * sb + 32 * wave, t = q0 + l31;
    const size_t rowb = (size_t)b * SEQ;
    bf16x8 qf[4];
    { const bf16_t* Qp = P1 + (rowb + q0 + l31) * L1P + h * 64 + 8 * hi;
#pragma unroll
      for (int kk = 0; kk < 4; ++kk) qf[kk] = *(const bf16x8*)(Qp + 16 * kk); }
    f32x16 o[2];
#pragma unroll
    for (int r = 0; r < 16; ++r) { o[0][r] = 0.f; o[1][r] = 0.f; }
    float cum = 1.f; bool done = false;
    volatile LAS unsigned* flags = (volatile LAS unsigned*)(lds + 2 * SB_STAGE);
    const bf16_t* gK = P1 + (rowb + (tid >> 3)) * L1P + 512 + h * 64 + (tid & 7) * 8;
    const bf16_t* gVt = VT + ((size_t)bh * 64 + (tid >> 3)) * SEQ + (tid & 7) * 8;
    const int lK = (tid >> 3) * (SBK_PITCH * 2) + (tid & 7) * 16, lVt = SBK_BYTES + (tid >> 3) * (MLV_PITCH * 2) + (tid & 7) * 16;
    const int top = 4 * sb + 3;
    v4u rk, rv;
    rk = *(const v4u*)(gK + (size_t)top * 64 * L1P); rv = *(const v4u*)(gVt + top * 64);
    *(LAS v4u*)(lds + lK) = rk; *(LAS u32x2*)(lds + lVt) = (u32x2){rv.x, rv.y}; *(LAS u32x2*)(lds + lVt + 8) = (u32x2){rv.z, rv.w};
    __syncthreads();
#pragma unroll 1
    for (int i = 0; i <= top; ++i) {
        const int step = top - i, nx = (step > 0) ? step - 1 : 0;
        rk = *(const v4u*)(gK + (size_t)nx * 64 * L1P); rv = *(const v4u*)(gVt + nx * 64);
        const LAS unsigned char* Kb = lds + (i & 1) * SB_STAGE;
        const LAS unsigned char* Vb = Kb + SBK_BYTES;
#pragma unroll
        for (int sub = 1; sub >= 0; --sub) {
            const int s0 = 64 * step + 32 * sub;
            if (s0 <= q0 && !done) {
                f32x16 acc;
#pragma unroll
                for (int r = 0; r < 16; ++r) acc[r] = 0.f;
#pragma unroll
                for (int kk = 0; kk < 4; ++kk) { const bf16x8 kf = *(const LAS bf16x8*)(Kb + (32 * sub + l31) * (SBK_PITCH * 2) + (16 * kk + 8 * hi) * 2); acc = MFMA32(kf, qf[kk], acc); }
                const bool diag = (s0 == q0);
                float bt[16], kp[16];
#pragma unroll
                for (int r = 0; r < 16; ++r) { const float ee = __builtin_amdgcn_exp2f(fminf(acc[r] * (-0.125f * 1.4426950408889634f), 100.f)); const float ri = __builtin_amdgcn_rcpf(1.f + ee);
                    float b_ = ri, k_ = ee * ri;
                    if (diag) { const bool valid = (s0 + crow(r, hi)) < t; b_ = valid ? b_ : 0.f; k_ = valid ? k_ : 1.f; }
                    bt[r] = b_; kp[r] = k_; }
                float e[16], T[4], U[4];
#pragma unroll
                for (int q = 0; q < 4; ++q) { e[4 * q + 3] = 1.f; e[4 * q + 2] = kp[4 * q + 3]; e[4 * q + 1] = e[4 * q + 2] * kp[4 * q + 2]; e[4 * q] = e[4 * q + 1] * kp[4 * q + 1]; T[q] = e[4 * q] * kp[4 * q]; }
#pragma unroll
                for (int q = 0; q < 4; ++q) U[q] = __shfl_xor(T[q], 32);
                { const float st2 = T[3], st1 = st2 * T[2], st0 = st1 * T[1]; const float su2 = U[3], su1 = su2 * U[2], su0 = su1 * U[1];
                  const float x0 = hi ? 1.f : U[0], x1 = hi ? 1.f : U[1], x2 = hi ? 1.f : U[2], x3 = hi ? 1.f : U[3];
                  const float off[4] = {cum * (st0 * su0 * x0), cum * (st1 * su1 * x1), cum * (st2 * su2 * x2), cum * x3};
#pragma unroll
                  for (int r = 0; r < 16; ++r) acc[r] = bt[r] * (off[r >> 2] * e[r]);
                  cum *= (st0 * T[0]) * (su0 * U[0]); }
                bf16x8 pf[2];
#pragma unroll
                for (int ks = 0; ks < 2; ++ks) { v4u w; w.x = cvtpk(acc[8 * ks], acc[8 * ks + 1]); w.y = cvtpk(acc[8 * ks + 2], acc[8 * ks + 3]); w.z = cvtpk(acc[8 * ks + 4], acc[8 * ks + 5]); w.w = cvtpk(acc[8 * ks + 6], acc[8 * ks + 7]); pf[ks] = __builtin_bit_cast(bf16x8, w); }
#pragma unroll
                for (int dt = 0; dt < 2; ++dt)
#pragma unroll
                    for (int ks = 0; ks < 2; ++ks) { const LAS unsigned char* vp = Vb + (32 * dt + l31) * (MLV_PITCH * 2) + (32 * sub + 16 * ks + 4 * hi) * 2;
                        const u32x2 x0 = *(const LAS u32x2*)vp, x1 = *(const LAS u32x2*)(vp + 16);
                        v4u a; a.x = x0.x; a.y = x0.y; a.z = x1.x; a.w = x1.y; o[dt] = MFMA32(__builtin_bit_cast(bf16x8, a), pf[ks], o[dt]); }
                done = __all(cum < 1e-35f);
            }
        }
        if (lane == 0) flags[(i & 1) * 8 + wave] = done ? 1u : 0u;
        LAS unsigned char* nb = lds + ((i + 1) & 1) * SB_STAGE;
        *(LAS v4u*)(nb + lK) = rk; *(LAS u32x2*)(nb + lVt) = (u32x2){rv.x, rv.y}; *(LAS u32x2*)(nb + lVt + 8) = (u32x2){rv.z, rv.w};
        __syncthreads();
        unsigned nd = 0;
#pragma unroll
        for (int w8 = 0; w8 < 8; ++w8) nd += flags[(i & 1) * 8 + w8];
        if (nd == 8u) break;
    }
    store_OT(o, 1.0f, (LAS bf16_t*)(lds + 2 * SB_STAGE + 256) + wave * (32 * STG_PITCH), ymix + (rowb + q0) * DM + h * 64, lane);
    __syncthreads();
}

constexpr int RW_RAWW = 0, RW_RAWA = 2048, RW_RS = 4096, RW_KS = 6144, RW_VS = 8192;
constexpr int RW_CH0 = 10240, RW_CHSZ = 11328;
constexpr int RW_YB = RW_CH0 + 2 * RW_CHSZ;
constexpr int RW_MIX = RW_YB + 1024;
static_assert((RW_MIX + 256) * 4 <= 146432, "rwkv LDS map");
__device__ __forceinline__ float tanh_fast(float x) { return 1.f - 2.f * __builtin_amdgcn_rcpf(1.f + __expf(2.f * x)); }
__device__ __forceinline__ float sigmoid_fast(float x) { return __builtin_amdgcn_rcpf(1.f + __expf(-x)); }

#define MFMA16(a, b, c) __builtin_amdgcn_mfma_f32_16x16x32_bf16((a), (b), (c), 0, 0, 0)
constexpr int RW2_CH0 = 0, RW2_YB = 2 * RW_CHSZ, RW2_MIX = RW2_YB + 1024, RW2_STG = RW2_MIX + 448;
static_assert((RW2_STG + 2 * 3072) * 4 <= 146432, "rwkv LDS map");
__device__ __forceinline__ void rwkv_phase_scan(LAS float* sm, int tid, int lane, int wave, int blk, const bf16_t* __restrict__ proj, const float* __restrict__ mix, const float* __restrict__ w0, const float* __restrict__ a0,
                                           const float* __restrict__ k_k, const float* __restrict__ k_a, const float* __restrict__ r_k, const bf16_t* __restrict__ W2T, const bf16_t* __restrict__ A2T, const bf16_t* __restrict__ G2T,
                                           float* __restrict__ yraw, bf16_t* __restrict__ gout, float* __restrict__ bonus_out) {
    const int chain = blk >> 1, half = blk & 1, b = chain >> 3, h = chain & 7, l15 = lane & 15, kg = lane >> 4;
    const size_t rowb = (size_t)b * SEQ;
    constexpr int NCHUNK = SEQ / 32;
    if (tid < 256) sm[RW2_MIX + tid] = mix[1536 + tid];
    else if (tid < 448) { const int q = tid - 256; sm[RW2_MIX + tid] = mix[512 * (q >> 6) + h * 64 + (q & 63)]; }
    __syncthreads();
#define RW_SH8(CUR, PRV, M0, M1, OUT, PZ) do { const unsigned cu_[4] = {(CUR).x, (CUR).y, (CUR).z, (CUR).w}, pu_[4] = {(PRV).x, (PRV).y, (PRV).z, (PRV).w}; \
        const float mm_[8] = {(M0)[0], (M0)[1], (M0)[2], (M0)[3], (M1)[0], (M1)[1], (M1)[2], (M1)[3]}; \
        _Pragma("unroll") for (int q = 0; q < 4; ++q) { const float c0 = bflo(cu_[q]), c1 = bfhi(cu_[q]), p0 = bflo(pu_[q]) * (PZ), p1 = bfhi(pu_[q]) * (PZ); \
            OUT[2 * q] = c0 + (p0 - c0) * mm_[2 * q]; OUT[2 * q + 1] = c1 + (p1 - c1) * mm_[2 * q + 1]; } } while (0)
    if (wave < 4) {
        const int iA = 8 * wave + kg, iB = iA + 4, jseg = l15;
        float A0 = 0.f, A1 = 0.f, A2 = 0.f, A3 = 0.f, B0 = 0.f, B1 = 0.f, B2 = 0.f, B3 = 0.f;
        __syncthreads();
#pragma unroll 1
        for (int ch = 0; ch < NCHUNK; ++ch) {
            const int t0 = ch * 32;
            const LAS float* CHb = sm + RW2_CH0 + (ch & 1) * RW_CHSZ + 4 * jseg;
            const LAS float* CHv = sm + RW2_CH0 + (ch & 1) * RW_CHSZ + 10240 + iA;
            const LAS float* CHs = sm + RW2_CH0 + (ch & 1) * RW_CHSZ + 11264;
            f32x4 a4 = *(const LAS f32x4*)(CHb + 4096), wr4 = *(const LAS f32x4*)(CHb + 8192), w4 = *(const LAS f32x4*)(CHb), b4 = *(const LAS f32x4*)(CHb + 6144), k4 = *(const LAS f32x4*)(CHb + 2048);
            float vA = CHv[0], vB = CHv[4]; f32x2_t sc = *(const LAS f32x2_t*)(CHs);
#pragma unroll 2
            for (int t = 0; t < 32; ++t) {
                const int tq = (t + 1) & 31;
                const f32x4 a4n = *(const LAS f32x4*)(CHb + 4096 + tq * 64), wr4n = *(const LAS f32x4*)(CHb + 8192 + tq * 64), w4n = *(const LAS f32x4*)(CHb + tq * 64),
                            b4n = *(const LAS f32x4*)(CHb + 6144 + tq * 64), k4n = *(const LAS f32x4*)(CHb + 2048 + tq * 64);
                const float vAn = CHv[tq * 32], vBn = CHv[tq * 32 + 4]; const f32x2_t scn = *(const LAS f32x2_t*)(CHs + 2 * tq);
                float d1A = (A0 * a4[0] + A1 * a4[1]) + (A2 * a4[2] + A3 * a4[3]), d1B = (B0 * a4[0] + B1 * a4[1]) + (B2 * a4[2] + B3 * a4[3]);
                float d2A = (A0 * wr4[0] + A1 * wr4[1]) + (A2 * wr4[2] + A3 * wr4[3]), d2B = (B0 * wr4[0] + B1 * wr4[1]) + (B2 * wr4[2] + B3 * wr4[3]);
                d1A = rowsum16(d1A); d1B = rowsum16(d1B); d2A = rowsum16(d2A); d2B = rowsum16(d2B);
                const float yA = d2A + d1A * sc[0] + vA * sc[1], yB = d2B + d1B * sc[0] + vB * sc[1];
                A0 = A0 * w4[0] + (d1A * b4[0] + vA * k4[0]); A1 = A1 * w4[1] + (d1A * b4[1] + vA * k4[1]); A2 = A2 * w4[2] + (d1A * b4[2] + vA * k4[2]); A3 = A3 * w4[3] + (d1A * b4[3] + vA * k4[3]);
                B0 = B0 * w4[0] + (d1B * b4[0] + vB * k4[0]); B1 = B1 * w4[1] + (d1B * b4[1] + vB * k4[1]); B2 = B2 * w4[2] + (d1B * b4[2] + vB * k4[2]); B3 = B3 * w4[3] + (d1B * b4[3] + vB * k4[3]);
                if (jseg == 0) { sm[RW2_YB + t * 32 + iA] = yA; sm[RW2_YB + t * 32 + iB] = yB; }
                a4 = a4n; wr4 = wr4n; w4 = w4n; b4 = b4n; k4 = k4n; vA = vAn; vB = vBn; sc = scn;
            }
            WSYNC();
            { const int tt = lane >> 1, hh = lane & 1; const f32x4 yv = *(const LAS f32x4*)(sm + RW2_YB + tt * 32 + 8 * wave + 4 * hh);
              *(f32x4*)(yraw + (rowb + t0 + tt) * 512 + h * 64 + half * 32 + 8 * wave + 4 * hh) = yv; }
            __syncthreads();
        }
    } else if (wave < 6) {
        const int tp = wave - 4, tb = 16 * tp;
        LAS float* stg = sm + RW2_STG + tp * 3072;
        float w0c[4], a0c[4], kkc[4], kac[4], rkc[4];
#pragma unroll
        for (int nt = 0; nt < 4; ++nt) { const int c = h * 64 + 16 * nt + l15; w0c[nt] = w0[c]; a0c[nt] = a0[c]; kkc[nt] = k_k[c]; kac[nt] = k_a[c]; rkc[nt] = r_k[c]; }
        v4u ld[20];
#define PREP_ISSUE(T0) do { const int t0_ = (T0); { const size_t r_ = rowb + t0_ + tb + l15; const size_t rp_ = (t0_ + tb + l15 == 0) ? r_ : r_ - 1; \
            _Pragma("unroll") for (int lo = 0; lo < 2; ++lo) _Pragma("unroll") for (int ks = 0; ks < 2; ++ks) { const int col = 1536 + 64 * lo + 32 * ks + 8 * kg; \
                ld[(lo * 2 + ks) * 2] = *(const v4u*)(proj + r_ * L0P + col); ld[(lo * 2 + ks) * 2 + 1] = *(const v4u*)(proj + rp_ * L0P + col); } } \
            _Pragma("unroll") for (int ar = 0; ar < 3; ++ar) _Pragma("unroll") for (int i = 0; i < 2; ++i) { const int p_ = lane + 64 * i, row_ = p_ >> 3, c8_ = p_ & 7; \
                const size_t r_ = rowb + t0_ + tb + row_; const size_t rp_ = (t0_ + tb + row_ == 0) ? r_ : r_ - 1; const int col = 512 * ar + h * 64 + 8 * c8_; \
                ld[8 + (ar * 2 + i) * 2] = *(const v4u*)(proj + r_ * L0P + col); ld[8 + (ar * 2 + i) * 2 + 1] = *(const v4u*)(proj + rp_ * L0P + col); } } while (0)
#define PREP_BUILD(T0, NB) do { const int t0_ = (T0); LAS float* CHn = sm + RW2_CH0 + (NB) * RW_CHSZ; \
            f32x4 accw[4], acca[4]; \
            _Pragma("unroll") for (int nt = 0; nt < 4; ++nt) { accw[nt] = (f32x4){0.f, 0.f, 0.f, 0.f}; acca[nt] = (f32x4){0.f, 0.f, 0.f, 0.f}; } \
            { const float pz_ = (t0_ + tb + l15 == 0) ? 0.f : 1.f; \
              _Pragma("unroll") for (int lo = 0; lo < 2; ++lo) _Pragma("unroll") for (int ks = 0; ks < 2; ++ks) { float s_[8]; \
                const f32x4 m0 = *(const LAS f32x4*)(sm + RW2_MIX + 64 * lo + 32 * ks + 8 * kg), m1 = *(const LAS f32x4*)(sm + RW2_MIX + 64 * lo + 32 * ks + 8 * kg + 4); \
                RW_SH8(ld[(lo * 2 + ks) * 2], ld[(lo * 2 + ks) * 2 + 1], m0, m1, s_, pz_); \
                if (lo == 0) { _Pragma("unroll") for (int j = 0; j < 8; ++j) s_[j] = tanh_fast(s_[j]); } \
                v4u aw; aw.x = cvtpk(s_[0], s_[1]); aw.y = cvtpk(s_[2], s_[3]); aw.z = cvtpk(s_[4], s_[5]); aw.w = cvtpk(s_[6], s_[7]); const bf16x8 af = __builtin_bit_cast(bf16x8, aw); \
                const bf16_t* WT = lo ? A2T : W2T; \
                _Pragma("unroll") for (int nt = 0; nt < 4; ++nt) { const bf16x8 bfr = *(const bf16x8*)(WT + (size_t)(h * 64 + 16 * nt + l15) * 64 + 32 * ks + 8 * kg); \
                    if (lo == 0) accw[nt] = MFMA16(af, bfr, accw[nt]); else acca[nt] = MFMA16(af, bfr, acca[nt]); } } } \
            _Pragma("unroll") for (int ar = 0; ar < 3; ++ar) _Pragma("unroll") for (int i = 0; i < 2; ++i) { const int p_ = lane + 64 * i, row_ = p_ >> 3, c8_ = p_ & 7; float s_[8]; \
                const float pz_ = (t0_ + tb + row_ == 0) ? 0.f : 1.f; const f32x4 m0 = *(const LAS f32x4*)(sm + RW2_MIX + 256 + ar * 64 + c8_ * 8), m1 = *(const LAS f32x4*)(sm + RW2_MIX + 256 + ar * 64 + c8_ * 8 + 4); \
                RW_SH8(ld[8 + (ar * 2 + i) * 2], ld[8 + (ar * 2 + i) * 2 + 1], m0, m1, s_, pz_); \
                *(LAS f32x4*)(stg + ar * 1024 + row_ * 64 + c8_ * 8) = (f32x4){s_[0], s_[1], s_[2], s_[3]}; *(LAS f32x4*)(stg + ar * 1024 + row_ * 64 + c8_ * 8 + 4) = (f32x4){s_[4], s_[5], s_[6], s_[7]}; } \
            WSYNC(); \
            PREP_ISSUE(((T0) + 32 < SEQ) ? (T0) + 32 : (T0)); \
            _Pragma("unroll") for (int rg = 0; rg < 4; ++rg) { const int tl = 4 * kg + rg, t = tb + tl; \
                float r_[4], k_[4], v_[4], kkv[4], nrm2 = 0.f; \
                _Pragma("unroll") for (int nt = 0; nt < 4; ++nt) { r_[nt] = stg[tl * 64 + 16 * nt + l15]; k_[nt] = stg[1024 + tl * 64 + 16 * nt + l15]; v_[nt] = stg[2048 + tl * 64 + 16 * nt + l15]; \
                    kkv[nt] = k_[nt] * kkc[nt]; nrm2 += kkv[nt] * kkv[nt]; } \
                nrm2 = rowsum16(nrm2); const float rn = __builtin_amdgcn_rsqf(fmaxf(nrm2, 1e-24f)); \
                float br = 0.f, kr = 0.f, bon = 0.f; \
                _Pragma("unroll") for (int nt = 0; nt < 4; ++nt) { const int j = 16 * nt + l15; \
                    const float wsum = w0c[nt] + accw[nt][rg]; const float logw = -softplus_fast(-wsum) - 0.5f; const float dec = __expf(-__expf(logw)); \
                    const float a_ = sigmoid_fast(a0c[nt] + acca[nt][rg]); const float kn = kkv[nt] * rn; \
                    const float k2 = k_[nt] * (1.f + (a_ - 1.f) * kac[nt]); const float bv = kn * a_; \
                    br += bv * r_[nt]; kr += k2 * r_[nt]; bon += r_[nt] * k2 * rkc[nt]; \
                    CHn[t * 64 + j] = dec; CHn[2048 + t * 64 + j] = k2; CHn[4096 + t * 64 + j] = -kn; CHn[6144 + t * 64 + j] = bv; CHn[8192 + t * 64 + j] = dec * r_[nt]; \
                    if ((nt >> 1) == half) CHn[10240 + t * 32 + (j & 31)] = v_[nt]; } \
                br = rowsum16(br); kr = rowsum16(kr); bon = rowsum16(bon); \
                if (l15 == 0) { CHn[11264 + 2 * t] = br; CHn[11264 + 2 * t + 1] = kr; if (half == 0) bonus_out[(rowb + t0_ + t) * 8 + h] = bon; } } \
            WSYNC(); } while (0)
        PREP_ISSUE(0);
        PREP_BUILD(0, 0);
        __syncthreads();
#pragma unroll 1
        for (int ch = 0; ch < NCHUNK; ++ch) {
            if (ch + 1 < NCHUNK) PREP_BUILD(ch * 32 + 32, (ch + 1) & 1);
            __syncthreads();
        }
#undef PREP_ISSUE
#undef PREP_BUILD
    } else {
        const int tp = wave - 6, tb = 16 * tp;
        v4u ld[8];
#define G_ISSUE(T0) do { const int t0_ = (T0); const size_t r_ = rowb + t0_ + tb + l15; const size_t rp_ = (t0_ + tb + l15 == 0) ? r_ : r_ - 1; \
            _Pragma("unroll") for (int ks = 0; ks < 4; ++ks) { const int col = 1664 + 32 * ks + 8 * kg; ld[2 * ks] = *(const v4u*)(proj + r_ * L0P + col); ld[2 * ks + 1] = *(const v4u*)(proj + rp_ * L0P + col); } } while (0)
#define G_BUILD(T0) do { const int t0_ = (T0); f32x4 accg[2] = {(f32x4){0.f, 0.f, 0.f, 0.f}, (f32x4){0.f, 0.f, 0.f, 0.f}}; const float pz_ = (t0_ + tb + l15 == 0) ? 0.f : 1.f; \
            _Pragma("unroll") for (int ks = 0; ks < 4; ++ks) { float s_[8]; \
                const f32x4 m0 = *(const LAS f32x4*)(sm + RW2_MIX + 128 + 32 * ks + 8 * kg), m1 = *(const LAS f32x4*)(sm + RW2_MIX + 128 + 32 * ks + 8 * kg + 4); \
                RW_SH8(ld[2 * ks], ld[2 * ks + 1], m0, m1, s_, pz_); \
                _Pragma("unroll") for (int j = 0; j < 8; ++j) s_[j] = sigmoid_fast(s_[j]); \
                v4u aw; aw.x = cvtpk(s_[0], s_[1]); aw.y = cvtpk(s_[2], s_[3]); aw.z = cvtpk(s_[4], s_[5]); aw.w = cvtpk(s_[6], s_[7]); const bf16x8 af = __builtin_bit_cast(bf16x8, aw); \
                _Pragma("unroll") for (int nt = 0; nt < 2; ++nt) { const bf16x8 bfr = *(const bf16x8*)(G2T + (size_t)(h * 64 + half * 32 + 16 * nt + l15) * 128 + 32 * ks + 8 * kg); accg[nt] = MFMA16(af, bfr, accg[nt]); } } \
            G_ISSUE(((T0) + 32 < SEQ) ? (T0) + 32 : (T0)); \
            _Pragma("unroll") for (int nt = 0; nt < 2; ++nt) _Pragma("unroll") for (int rg = 0; rg < 4; ++rg) \
                gout[(rowb + t0_ + tb + 4 * kg + rg) * 512 + h * 64 + half * 32 + 16 * nt + l15] = (bf16_t)f2bf(accg[nt][rg]); } while (0)
        G_ISSUE(0);
        G_BUILD(0);
        __syncthreads();
#pragma unroll 1
        for (int ch = 0; ch < NCHUNK; ++ch) {
            if (ch + 1 < NCHUNK) G_BUILD(ch * 32 + 32);
            __syncthreads();
        }
#undef G_ISSUE
#undef G_BUILD
    }
#undef RW_SH8
    __syncthreads();
}

constexpr int CK_BK = 0, CK_AR = 4608, CK_BBT = 9216, CK_KBT = 12288, CK_VT = 15360, CK_GC = 16896, CK_TT = 17152, CK_SLOT = 18688, CK_NSLOT = 6, CK_NBUILD = 5;
constexpr int CK_STG = CK_SLOT * CK_NSLOT;
constexpr int CK_MIX = CK_STG + CK_NBUILD * 6144;
constexpr int CK_FLAGS = CK_MIX + 448 * 4;
static_assert(CK_FLAGS + 64 <= 146432, "rwkv chunked LDS map");
__device__ __forceinline__ void rwkv_phase(LAS float* smf, int tid, int lane, int wave, int blk, const bf16_t* __restrict__ proj, const float* __restrict__ mix, const float* __restrict__ w0, const float* __restrict__ a0,
                                           const float* __restrict__ k_k, const float* __restrict__ k_a, const float* __restrict__ r_k, const bf16_t* __restrict__ W2T, const bf16_t* __restrict__ A2T, const bf16_t* __restrict__ G2T,
                                           float* __restrict__ yraw, bf16_t* __restrict__ gout, float* __restrict__ bonus_out) {
    LAS unsigned char* lds = (LAS unsigned char*)smf;
    LAS float* mixs = (LAS float*)(lds + CK_MIX);
    volatile LAS unsigned* flags = (volatile LAS unsigned*)(lds + CK_FLAGS);
    const int chain = blk >> 1, ihalf = blk & 1, b = chain >> 3, h = chain & 7, l15 = lane & 15, kg = lane >> 4, l31 = lane & 31, hi = lane >> 5;
    const size_t rowb = (size_t)b * SEQ;
    constexpr int NCH = SEQ / 16;
    if (tid < 256) mixs[tid] = mix[1536 + tid];
    else if (tid < 448) { const int q = tid - 256; mixs[tid] = mix[512 * (q >> 6) + h * 64 + (q & 63)]; }
    if (tid < 16) flags[tid] = (tid == 9) ? (unsigned)CK_NBUILD : 0u;
    for (int q = tid; q < CK_NSLOT * 384; q += NWAVES * 64) *(LAS unsigned*)(lds + (q / 384) * CK_SLOT + CK_TT + (q % 384) * 4) = 0u;
    __syncthreads();
#define RW_SH8(CUR, PRV, M0, M1, OUT, PZ) do { const unsigned cu_[4] = {(CUR).x, (CUR).y, (CUR).z, (CUR).w}, pu_[4] = {(PRV).x, (PRV).y, (PRV).z, (PRV).w}; \
        const float mm_[8] = {(M0)[0], (M0)[1], (M0)[2], (M0)[3], (M1)[0], (M1)[1], (M1)[2], (M1)[3]}; \
        _Pragma("unroll") for (int q = 0; q < 4; ++q) { const float c0 = bflo(cu_[q]), c1 = bfhi(cu_[q]), p0 = bflo(pu_[q]) * (PZ), p1 = bfhi(pu_[q]) * (PZ); \
            OUT[2 * q] = c0 + (p0 - c0) * mm_[2 * q]; OUT[2 * q + 1] = c1 + (p1 - c1) * mm_[2 * q + 1]; } } while (0)
    if (wave == 0) {
        f32x16 ST[2];
#pragma unroll
        for (int r = 0; r < 16; ++r) { ST[0][r] = 0.f; ST[1][r] = 0.f; }
#pragma unroll 1
        for (int k = 0; k < NCH; ++k) {
#if defined(PROBE_STAMPS)
            const unsigned tw0_ = (unsigned)__builtin_amdgcn_s_memrealtime();
#endif
            { const unsigned want = (unsigned)(k + 1); const int sl = k % CK_NSLOT; while (flags[sl] != want) __builtin_amdgcn_s_sleep(1); }
#if defined(PROBE_STAMPS)
            if (blk == 0 && lane == 0) ((volatile LAS unsigned*)(lds + 146432 + 320))[16 + 24] += (unsigned)__builtin_amdgcn_s_memrealtime() - tw0_;
#endif
            asm volatile("" ::: "memory");
            const LAS unsigned char* im = lds + (k % CK_NSLOT) * CK_SLOT;
            f32x16 G;
#pragma unroll
            for (int r = 0; r < 16; ++r) G[r] = 0.f;
#pragma unroll
            for (int kk = 0; kk < 4; ++kk) { const bf16x8 fa = *(const LAS bf16x8*)(im + CK_BK + l31 * 144 + (16 * kk + 8 * hi) * 2), fb = *(const LAS bf16x8*)(im + CK_AR + l31 * 144 + (16 * kk + 8 * hi) * 2); G = MFMA32(fa, fb, G); }
            { const int tcol = l31 & 15; const bool strict = l31 < 16;
#pragma unroll
              for (int r = 0; r < 16; ++r) { const int srow = crow(r & 7, hi); const bool keep = strict ? (srow < tcol) : (srow <= tcol); G[r] = keep ? G[r] : 0.f; } }
            const bf16x8 gB = pack8(G[0], G[1], G[2], G[3], G[4], G[5], G[6], G[7]), gK = pack8(G[8], G[9], G[10], G[11], G[12], G[13], G[14], G[15]);
            f32x16 XT;
#pragma unroll
            for (int r = 0; r < 16; ++r) XT[r] = 0.f;
#pragma unroll
            for (int jt = 0; jt < 2; ++jt)
#pragma unroll
                for (int sp = 0; sp < 2; ++sp) { const LAS unsigned char* ap = im + CK_AR + l31 * 144 + (32 * jt + 16 * sp + 4 * hi) * 2;
                    const u32x2 x0 = *(const LAS u32x2*)ap, x1 = *(const LAS u32x2*)(ap + 16); v4u aw; aw.x = x0.x; aw.y = x0.y; aw.z = x1.x; aw.w = x1.y;
                    const bf16x8 sb_ = pack8(ST[jt][8 * sp], ST[jt][8 * sp + 1], ST[jt][8 * sp + 2], ST[jt][8 * sp + 3], ST[jt][8 * sp + 4], ST[jt][8 * sp + 5], ST[jt][8 * sp + 6], ST[jt][8 * sp + 7]);
                    XT = MFMA32(__builtin_bit_cast(bf16x8, aw), sb_, XT); }
            bf16x8 vP;
            { const LAS unsigned char* vp = im + CK_VT + l31 * 48 + (4 * hi) * 2; const u32x2 x0 = *(const LAS u32x2*)vp, x1 = *(const LAS u32x2*)(vp + 16); v4u vw; vw.x = x0.x; vw.y = x0.y; vw.z = x1.x; vw.w = x1.y;
              vP = __builtin_bit_cast(bf16x8, vw); XT = MFMA32(gK, vP, XT); }
            bf16x8 uP;
            { const LAS unsigned char* tp = im + CK_TT + l31 * 48 + (4 * hi) * 2; const u32x2 x0 = *(const LAS u32x2*)tp, x1 = *(const LAS u32x2*)(tp + 16); v4u tw; tw.x = x0.x; tw.y = x0.y; tw.z = x1.x; tw.w = x1.y;
              f32x16 UT;
#pragma unroll
              for (int r = 0; r < 16; ++r) UT[r] = 0.f;
              UT = MFMA32(__builtin_bit_cast(bf16x8, tw), pack8(XT[0], XT[1], XT[2], XT[3], XT[4], XT[5], XT[6], XT[7]), UT);
              uP = pack8(UT[0], UT[1], UT[2], UT[3], UT[4], UT[5], UT[6], UT[7]); }
            XT = MFMA32(gB, uP, XT);
            { float* yp = yraw + (rowb + 16 * k) * 512 + h * 64 + 32 * ihalf + l31;
#pragma unroll
              for (int q = 0; q < 8; ++q) yp[(size_t)crow(q, hi) * 512] = XT[8 + q]; }
            { const LAS float* gc = (const LAS float*)(im + CK_GC);
#pragma unroll
              for (int jt = 0; jt < 2; ++jt)
#pragma unroll
                  for (int r = 0; r < 16; ++r) ST[jt][r] *= gc[32 * jt + crow(r, hi)]; }
#pragma unroll
            for (int jt = 0; jt < 2; ++jt) { const LAS unsigned char* bp = im + CK_BBT + (32 * jt + l31) * 48 + (4 * hi) * 2; const LAS unsigned char* kp = im + CK_KBT + (32 * jt + l31) * 48 + (4 * hi) * 2;
                const u32x2 b0 = *(const LAS u32x2*)bp, b1 = *(const LAS u32x2*)(bp + 16), k0 = *(const LAS u32x2*)kp, k1 = *(const LAS u32x2*)(kp + 16);
                v4u a1; a1.x = b0.x; a1.y = b0.y; a1.z = b1.x; a1.w = b1.y; v4u a2; a2.x = k0.x; a2.y = k0.y; a2.z = k1.x; a2.w = k1.y;
                ST[jt] = MFMA32(__builtin_bit_cast(bf16x8, a1), uP, ST[jt]); ST[jt] = MFMA32(__builtin_bit_cast(bf16x8, a2), vP, ST[jt]); }
            WSYNC();
            if (lane == 0) flags[8] = (unsigned)(k + 1);
        }
    } else if (wave <= CK_NBUILD) {
        const int pw = wave - 1;
        LAS bf16_t* stg = (LAS bf16_t*)(lds + CK_STG) + pw * 3072;
        float w0c[4], a0c[4], kkc[4], kac[4], rkc[4];
#pragma unroll
        for (int nt = 0; nt < 4; ++nt) { const int c = h * 64 + 16 * nt + l15; w0c[nt] = w0[c]; a0c[nt] = a0[c]; kkc[nt] = k_k[c]; kac[nt] = k_a[c]; rkc[nt] = r_k[c]; }
        v4u ld[20];
#define CK_ISSUE_A(T0) do { const int t0_ = (T0); const size_t r_ = rowb + t0_ + l15; const size_t rp_ = (t0_ + l15 == 0) ? r_ : r_ - 1; \
            _Pragma("unroll") for (int lo = 0; lo < 2; ++lo) _Pragma("unroll") for (int ks = 0; ks < 2; ++ks) { const int col = 1536 + 64 * lo + 32 * ks + 8 * kg; \
                ld[(lo * 2 + ks) * 2] = *(const v4u*)(proj + r_ * L0P + col); ld[(lo * 2 + ks) * 2 + 1] = *(const v4u*)(proj + rp_ * L0P + col); } } while (0)
#define CK_ISSUE_B(T0) do { const int t0_ = (T0); \
            _Pragma("unroll") for (int ar = 0; ar < 3; ++ar) _Pragma("unroll") for (int i = 0; i < 2; ++i) { const int p_ = lane + 64 * i, row_ = p_ >> 3, c8_ = p_ & 7; \
                const size_t r_ = rowb + t0_ + row_; const size_t rp_ = (t0_ + row_ == 0) ? r_ : r_ - 1; const int col = 512 * ar + h * 64 + 8 * c8_; \
                ld[8 + (ar * 2 + i) * 2] = *(const v4u*)(proj + r_ * L0P + col); ld[8 + (ar * 2 + i) * 2 + 1] = *(const v4u*)(proj + rp_ * L0P + col); } } while (0)
#define CK_ISSUE(T0) do { CK_ISSUE_A(T0); CK_ISSUE_B(T0); } while (0)
        CK_ISSUE(16 * pw);
        int k = pw;
#pragma unroll 1
        while (k < NCH) {
            const int t0 = 16 * k; int kn;
#if defined(PROBE_STAMPS)
            const unsigned ts0_ = (unsigned)__builtin_amdgcn_s_memrealtime();
#endif
            f32x4 accw[4], acca[4];
#pragma unroll
            for (int nt = 0; nt < 4; ++nt) { accw[nt] = (f32x4){0.f, 0.f, 0.f, 0.f}; acca[nt] = (f32x4){0.f, 0.f, 0.f, 0.f}; }
            { const float pz_ = (t0 + l15 == 0) ? 0.f : 1.f;
#pragma unroll
              for (int lo = 0; lo < 2; ++lo)
#pragma unroll
                for (int ks = 0; ks < 2; ++ks) { float s_[8];
                    const f32x4 m0 = *(const LAS f32x4*)(mixs + 64 * lo + 32 * ks + 8 * kg), m1 = *(const LAS f32x4*)(mixs + 64 * lo + 32 * ks + 8 * kg + 4);
                    RW_SH8(ld[(lo * 2 + ks) * 2], ld[(lo * 2 + ks) * 2 + 1], m0, m1, s_, pz_);
                    if (lo == 0) {
#pragma unroll
                        for (int j = 0; j < 8; ++j) s_[j] = tanh_fast(s_[j]); }
                    const bf16x8 af = pack8(s_[0], s_[1], s_[2], s_[3], s_[4], s_[5], s_[6], s_[7]);
                    const bf16_t* WT = lo ? A2T : W2T;
#pragma unroll
                    for (int nt = 0; nt < 4; ++nt) { const bf16x8 bfr = *(const bf16x8*)(WT + (size_t)(h * 64 + 16 * nt + l15) * 64 + 32 * ks + 8 * kg);
                        if (lo == 0) accw[nt] = MFMA16(af, bfr, accw[nt]); else acca[nt] = MFMA16(af, bfr, acca[nt]); } } }
#pragma unroll
            for (int ar = 0; ar < 3; ++ar)
#pragma unroll
                for (int i = 0; i < 2; ++i) { const int p_ = lane + 64 * i, row_ = p_ >> 3, c8_ = p_ & 7; float s_[8];
                    const float pz_ = (t0 + row_ == 0) ? 0.f : 1.f; const f32x4 m0 = *(const LAS f32x4*)(mixs + 256 + ar * 64 + c8_ * 8), m1 = *(const LAS f32x4*)(mixs + 256 + ar * 64 + c8_ * 8 + 4);
                    RW_SH8(ld[8 + (ar * 2 + i) * 2], ld[8 + (ar * 2 + i) * 2 + 1], m0, m1, s_, pz_);
                    *(LAS bf16x8*)(stg + ar * 1024 + row_ * 64 + c8_ * 8) = pack8(s_[0], s_[1], s_[2], s_[3], s_[4], s_[5], s_[6], s_[7]); }
            WSYNC();
#if defined(PROBE_STAMPS)
            if (blk == 0 && wave == 1 && lane == 0) ((volatile LAS unsigned*)(lds + 146432 + 320))[16 + 26] += (unsigned)__builtin_amdgcn_s_memrealtime() - ts0_;
#endif
#if defined(PROBE_STAMPS)
            const unsigned tb0_ = (unsigned)__builtin_amdgcn_s_memrealtime();
#endif
            { const int need = k - (CK_NSLOT - 1); if (need > 0) { while ((int)flags[8] < need) __builtin_amdgcn_s_sleep(2); } }
#if defined(PROBE_STAMPS)
            if (blk == 0 && wave == 1 && lane == 0) ((volatile LAS unsigned*)(lds + 146432 + 320))[16 + 25] += (unsigned)__builtin_amdgcn_s_memrealtime() - tb0_;
#endif
            asm volatile("" ::: "memory");
            LAS unsigned char* im = lds + (k % CK_NSLOT) * CK_SLOT;
#if defined(PROBE_STAMPS)
            const unsigned ts1_ = (unsigned)__builtin_amdgcn_s_memrealtime();
#endif
            float lwv[4][4], av[4][4], knv[4][4];
#pragma unroll
            for (int rg = 0; rg < 4; ++rg) { const int tl = 4 * kg + rg;
                float kkv[4], nrm2 = 0.f, vv[4], rr_[4], kr_[4];
#pragma unroll
                for (int nt = 0; nt < 4; ++nt) { rr_[nt] = bf2f(stg[tl * 64 + 16 * nt + l15]); kr_[nt] = bf2f(stg[1024 + tl * 64 + 16 * nt + l15]); vv[nt] = bf2f(stg[2048 + tl * 64 + 16 * nt + l15]);
                    kkv[nt] = kr_[nt] * kkc[nt]; nrm2 += kkv[nt] * kkv[nt]; }
                nrm2 = rowsum16(nrm2); const float rn = __builtin_amdgcn_rsqf(fmaxf(nrm2, 1e-24f));
                float bon = 0.f;
#pragma unroll
                for (int nt = 0; nt < 4; ++nt) {
                    const float wsum = w0c[nt] + accw[nt][rg]; lwv[nt][rg] = -0.6065306597126334f * sigmoid_fast(wsum);
                    const float a_ = sigmoid_fast(a0c[nt] + acca[nt][rg]); av[nt][rg] = a_; knv[nt][rg] = kkv[nt] * rn;
                    const float k2 = kr_[nt] * (1.f + (a_ - 1.f) * kac[nt]); stg[1024 + tl * 64 + 16 * nt + l15] = bf1(k2);
                    bon += rr_[nt] * k2 * rkc[nt];
                    if ((nt >> 1) == ihalf) *(LAS bf16_t*)(im + CK_VT + (16 * (nt & 1) + l15) * 48 + tl * 2) = bf1(vv[nt]);
                }
                bon = rowsum16(bon);
                if (l15 == 0 && ihalf == 0) bonus_out[(rowb + t0 + tl) * 8 + h] = bon;
            }
            { unsigned g_ = 0; if (lane == 0) g_ = __hip_atomic_fetch_add((LAS unsigned*)(lds + CK_FLAGS + 36), 1u, __ATOMIC_RELAXED, __HIP_MEMORY_SCOPE_WORKGROUP);
              kn = (int)__builtin_amdgcn_readfirstlane(g_); }
            CK_ISSUE_A((kn < NCH) ? 16 * kn : t0);
#pragma unroll
            for (int nt = 0; nt < 4; ++nt) {
                float L[4]; L[0] = lwv[nt][0]; L[1] = L[0] + lwv[nt][1]; L[2] = L[1] + lwv[nt][2]; L[3] = L[2] + lwv[nt][3];
                const float T0 = __shfl(L[3], l15), T1 = __shfl(L[3], 16 + l15), T2 = __shfl(L[3], 32 + l15), T3 = __shfl(L[3], 48 + l15);
                const float off = (kg > 0 ? T0 : 0.f) + (kg > 1 ? T1 : 0.f) + (kg > 2 ? T2 : 0.f), LC = (T0 + T1) + (T2 + T3);
                const int j = 16 * nt + l15;
                unsigned bb2[2], kb2[2];
                const float gC = __expf(LC); float eprev = __expf(off);
#pragma unroll
                for (int rg = 0; rg < 4; ++rg) { const int tl = 4 * kg + rg; const float Lt = off + L[rg], e1 = __expf(Lt), e2 = __builtin_amdgcn_rcpf(e1), e3 = eprev, e4 = gC * e2; eprev = e1;
                    const float kn = knv[nt][rg], bvv = kn * av[nt][rg], k2 = bf2f(stg[1024 + tl * 64 + j]), rr2 = bf2f(stg[tl * 64 + j]);
                    *(LAS bf16_t*)(im + CK_BK + tl * 144 + j * 2) = bf1(bvv * e2); *(LAS bf16_t*)(im + CK_BK + (16 + tl) * 144 + j * 2) = bf1(k2 * e2);
                    *(LAS bf16_t*)(im + CK_AR + tl * 144 + j * 2) = bf1(-kn * e3); *(LAS bf16_t*)(im + CK_AR + (16 + tl) * 144 + j * 2) = bf1(rr2 * e1);
                    const unsigned bq = bf1(bvv * e4), kq = bf1(k2 * e4);
                    if (rg & 1) { bb2[rg >> 1] |= bq << 16; kb2[rg >> 1] |= kq << 16; } else { bb2[rg >> 1] = bq; kb2[rg >> 1] = kq; } }
                *(LAS u32x2*)(im + CK_BBT + j * 48 + (4 * kg) * 2) = (u32x2){bb2[0], bb2[1]}; *(LAS u32x2*)(im + CK_KBT + j * 48 + (4 * kg) * 2) = (u32x2){kb2[0], kb2[1]};
                if (kg == 0) *(LAS float*)(im + CK_GC + j * 4) = gC;
            }
            WSYNC();
#if defined(PROBE_STAMPS)
            const unsigned ts2_ = (unsigned)__builtin_amdgcn_s_memrealtime();
            if (blk == 0 && wave == 1 && lane == 0) ((volatile LAS unsigned*)(lds + 146432 + 320))[16 + 27] += ts2_ - ts1_;
#endif
            {
                f32x4 nacc = {0.f, 0.f, 0.f, 0.f};
#pragma unroll
                for (int ks = 0; ks < 2; ++ks) { const bf16x8 fa = *(const LAS bf16x8*)(im + CK_BK + l15 * 144 + (32 * ks + 8 * kg) * 2), fb = *(const LAS bf16x8*)(im + CK_AR + l15 * 144 + (32 * ks + 8 * kg) * 2); nacc = MFMA16(fa, fb, nacc); }
#pragma unroll
                for (int rg = 0; rg < 4; ++rg) nacc[rg] = ((4 * kg + rg) < l15) ? nacc[rg] : 0.f;
                float Tr[16];
#pragma unroll
                for (int t = 0; t < 16; ++t) { float acc_ = (l15 == t) ? 1.f : 0.f;
#pragma unroll
                    for (int s2 = 0; s2 < t; ++s2) acc_ += Tr[s2] * rl(nacc[s2 & 3], t + 16 * (s2 >> 2));
                    Tr[t] = acc_; }
                if (kg == 0) {
#pragma unroll
                    for (int t = 0; t < 16; ++t) *(LAS bf16_t*)(im + CK_TT + t * 48 + l15 * 2) = bf1(Tr[t]); }
            }
            WSYNC();
#if defined(PROBE_STAMPS)
            if (blk == 0 && wave == 1 && lane == 0) ((volatile LAS unsigned*)(lds + 146432 + 320))[16 + 28] += (unsigned)__builtin_amdgcn_s_memrealtime() - ts2_;
#endif
            if (lane == 0) flags[k % CK_NSLOT] = (unsigned)(k + 1);
            CK_ISSUE_B((kn < NCH) ? 16 * kn : t0);
            k = kn;
        }
#undef CK_ISSUE
#undef CK_ISSUE_A
#undef CK_ISSUE_B
    } else {
        const int gq = wave - 6;
        v4u ld[8];
#define G_ISSUE(T0) do { const int t0_ = (T0); const size_t r_ = rowb + t0_ + l15; const size_t rp_ = (t0_ + l15 == 0) ? r_ : r_ - 1; \
            _Pragma("unroll") for (int ks = 0; ks < 4; ++ks) { const int col = 1664 + 32 * ks + 8 * kg; ld[2 * ks] = *(const v4u*)(proj + r_ * L0P + col); ld[2 * ks + 1] = *(const v4u*)(proj + rp_ * L0P + col); } } while (0)
        G_ISSUE(16 * gq);
#pragma unroll 1
        for (int k = gq; k < NCH; k += 2) {
            const int t0 = 16 * k;
            f32x4 accg[2] = {(f32x4){0.f, 0.f, 0.f, 0.f}, (f32x4){0.f, 0.f, 0.f, 0.f}}; const float pz_ = (t0 + l15 == 0) ? 0.f : 1.f;
#pragma unroll
            for (int ks = 0; ks < 4; ++ks) { float s_[8];
                const f32x4 m0 = *(const LAS f32x4*)(mixs + 128 + 32 * ks + 8 * kg), m1 = *(const LAS f32x4*)(mixs + 128 + 32 * ks + 8 * kg + 4);
                RW_SH8(ld[2 * ks], ld[2 * ks + 1], m0, m1, s_, pz_);
#pragma unroll
                for (int j = 0; j < 8; ++j) s_[j] = sigmoid_fast(s_[j]);
                const bf16x8 af = pack8(s_[0], s_[1], s_[2], s_[3], s_[4], s_[5], s_[6], s_[7]);
#pragma unroll
                for (int nt = 0; nt < 2; ++nt) { const bf16x8 bfr = *(const bf16x8*)(G2T + (size_t)(h * 64 + ihalf * 32 + 16 * nt + l15) * 128 + 32 * ks + 8 * kg); accg[nt] = MFMA16(af, bfr, accg[nt]); } }
            G_ISSUE((k + 2 < NCH) ? t0 + 32 : t0);
#pragma unroll
            for (int nt = 0; nt < 2; ++nt)
#pragma unroll
                for (int rg = 0; rg < 4; ++rg) gout[(rowb + t0 + 4 * kg + rg) * 512 + h * 64 + ihalf * 32 + 16 * nt + l15] = bf1(accg[nt][rg]);
        }
#undef G_ISSUE
    }
#undef RW_SH8
    __syncthreads();
}

constexpr int CC_BK = 0, CC_AR = 4608, CC_BBT = 9216, CC_KBT = 11776, CC_VT = 14336, CC_GC = 16896, CC_TT = 17152, CC_SLOT = 18432, CC_NSLOT = 6, CC_NBUILD = 6;
constexpr int CC_STG = CC_SLOT * CC_NSLOT;
constexpr int CC_MIX = CC_STG + CC_NBUILD * 4096;
constexpr int CC_FLAGS = CC_MIX + 448 * 4;
static_assert(CC_FLAGS + 64 <= 146432, "rwkv chain LDS map");
__device__ __forceinline__ void rwkv_phase_chain(LAS float* smf, int tid, int lane, int wave, int blk, const bf16_t* __restrict__ proj, const float* __restrict__ mix, const float* __restrict__ w0, const float* __restrict__ a0,
                                           const float* __restrict__ k_k, const float* __restrict__ k_a, const float* __restrict__ r_k, const bf16_t* __restrict__ W2T, const bf16_t* __restrict__ A2T, const bf16_t* __restrict__ G2T,
                                           float* __restrict__ yraw, bf16_t* __restrict__ gout, float* __restrict__ bonus_out) {
    LAS unsigned char* lds = (LAS unsigned char*)smf;
    LAS float* mixs = (LAS float*)(lds + CC_MIX);
    volatile LAS unsigned* flags = (volatile LAS unsigned*)(lds + CC_FLAGS);
    const int chain = blk, b = chain >> 3, h = chain & 7, l15 = lane & 15, kg = lane >> 4, l31 = lane & 31, hi = lane >> 5;
    const size_t rowb = (size_t)b * SEQ;
    constexpr int NCH = SEQ / 16;
    if (tid < 256) mixs[tid] = mix[1536 + tid];
    else if (tid < 448) { const int q = tid - 256; mixs[tid] = mix[512 * (q >> 6) + h * 64 + (q & 63)]; }
    if (tid < 16) flags[tid] = (tid == 10) ? (unsigned)CC_NBUILD : 0u;
    for (int q = tid; q < CC_NSLOT * 320; q += NWAVES * 64) *(LAS unsigned*)(lds + (q / 320) * CC_SLOT + CC_TT + (q % 320) * 4) = 0u;
    __syncthreads();
#define RW_SH8(CUR, PRV, M0, M1, OUT, PZ) do { const unsigned cu_[4] = {(CUR).x, (CUR).y, (CUR).z, (CUR).w}, pu_[4] = {(PRV).x, (PRV).y, (PRV).z, (PRV).w}; \
        const float mm_[8] = {(M0)[0], (M0)[1], (M0)[2], (M0)[3], (M1)[0], (M1)[1], (M1)[2], (M1)[3]}; \
        _Pragma("unroll") for (int q = 0; q < 4; ++q) { const float c0 = bflo(cu_[q]), c1 = bfhi(cu_[q]), p0 = bflo(pu_[q]) * (PZ), p1 = bfhi(pu_[q]) * (PZ); \
            OUT[2 * q] = c0 + (p0 - c0) * mm_[2 * q]; OUT[2 * q + 1] = c1 + (p1 - c1) * mm_[2 * q + 1]; } } while (0)
    if (wave < 2) {
        const int ihalf = wave;
        f32x16 ST[2];
#pragma unroll
        for (int r = 0; r < 16; ++r) { ST[0][r] = 0.f; ST[1][r] = 0.f; }
#pragma unroll 1
        for (int k = 0; k < NCH; ++k) {
            { const unsigned want = (unsigned)(k + 1); const int sl = k % CC_NSLOT; while (flags[sl] != want) __builtin_amdgcn_s_sleep(1); }
            asm volatile("" ::: "memory");
            const LAS unsigned char* im = lds + (k % CC_NSLOT) * CC_SLOT;
            f32x16 G;
#pragma unroll
            for (int r = 0; r < 16; ++r) G[r] = 0.f;
#pragma unroll
            for (int kk = 0; kk < 4; ++kk) { const bf16x8 fa = *(const LAS bf16x8*)(im + CC_BK + l31 * 144 + (16 * kk + 8 * hi) * 2), fb = *(const LAS bf16x8*)(im + CC_AR + l31 * 144 + (16 * kk + 8 * hi) * 2); G = MFMA32(fa, fb, G); }
            { const int tcol = l31 & 15; const bool strict = l31 < 16;
#pragma unroll
              for (int r = 0; r < 16; ++r) { const int srow = crow(r & 7, hi); const bool keep = strict ? (srow < tcol) : (srow <= tcol); G[r] = keep ? G[r] : 0.f; } }
            const bf16x8 gB = pack8(G[0], G[1], G[2], G[3], G[4], G[5], G[6], G[7]), gK = pack8(G[8], G[9], G[10], G[11], G[12], G[13], G[14], G[15]);
            f32x16 XT;
#pragma unroll
            for (int r = 0; r < 16; ++r) XT[r] = 0.f;
#pragma unroll
            for (int jt = 0; jt < 2; ++jt)
#pragma unroll
                for (int sp = 0; sp < 2; ++sp) { const LAS unsigned char* ap = im + CC_AR + l31 * 144 + (32 * jt + 16 * sp + 4 * hi) * 2;
                    const u32x2 x0 = *(const LAS u32x2*)ap, x1 = *(const LAS u32x2*)(ap + 16); v4u aw; aw.x = x0.x; aw.y = x0.y; aw.z = x1.x; aw.w = x1.y;
                    const bf16x8 sb_ = pack8(ST[jt][8 * sp], ST[jt][8 * sp + 1], ST[jt][8 * sp + 2], ST[jt][8 * sp + 3], ST[jt][8 * sp + 4], ST[jt][8 * sp + 5], ST[jt][8 * sp + 6], ST[jt][8 * sp + 7]);
                    XT = MFMA32(__builtin_bit_cast(bf16x8, aw), sb_, XT); }
            bf16x8 vP;
            { const LAS unsigned char* vp = im + CC_VT + (32 * ihalf + l31) * 40 + (4 * hi) * 2; const u32x2 x0 = *(const LAS u32x2*)vp, x1 = *(const LAS u32x2*)(vp + 16); v4u vw; vw.x = x0.x; vw.y = x0.y; vw.z = x1.x; vw.w = x1.y;
              vP = __builtin_bit_cast(bf16x8, vw); XT = MFMA32(gK, vP, XT); }
            bf16x8 uP;
            { const LAS unsigned char* tp = im + CC_TT + l31 * 40 + (4 * hi) * 2; const u32x2 x0 = *(const LAS u32x2*)tp, x1 = *(const LAS u32x2*)(tp + 16); v4u tw; tw.x = x0.x; tw.y = x0.y; tw.z = x1.x; tw.w = x1.y;
              f32x16 UT;
#pragma unroll
              for (int r = 0; r < 16; ++r) UT[r] = 0.f;
              UT = MFMA32(__builtin_bit_cast(bf16x8, tw), pack8(XT[0], XT[1], XT[2], XT[3], XT[4], XT[5], XT[6], XT[7]), UT);
              uP = pack8(UT[0], UT[1], UT[2], UT[3], UT[4], UT[5], UT[6], UT[7]); }
            XT = MFMA32(gB, uP, XT);
            { float* yp = yraw + (rowb + 16 * k) * 512 + h * 64 + 32 * ihalf + l31;
#pragma unroll
              for (int q = 0; q < 8; ++q) yp[(size_t)crow(q, hi) * 512] = XT[8 + q]; }
            { const LAS float* gc = (const LAS float*)(im + CC_GC);
#pragma unroll
              for (int jt = 0; jt < 2; ++jt)
#pragma unroll
                  for (int r = 0; r < 16; ++r) ST[jt][r] *= gc[32 * jt + crow(r, hi)]; }
#pragma unroll
            for (int jt = 0; jt < 2; ++jt) { const LAS unsigned char* bp = im + CC_BBT + (32 * jt + l31) * 40 + (4 * hi) * 2; const LAS unsigned char* kp = im + CC_KBT + (32 * jt + l31) * 40 + (4 * hi) * 2;
                const u32x2 b0 = *(const LAS u32x2*)bp, b1 = *(const LAS u32x2*)(bp + 16), k0 = *(const LAS u32x2*)kp, k1 = *(const LAS u32x2*)(kp + 16);
                v4u a1; a1.x = b0.x; a1.y = b0.y; a1.z = b1.x; a1.w = b1.y; v4u a2; a2.x = k0.x; a2.y = k0.y; a2.z = k1.x; a2.w = k1.y;
                ST[jt] = MFMA32(__builtin_bit_cast(bf16x8, a1), uP, ST[jt]); ST[jt] = MFMA32(__builtin_bit_cast(bf16x8, a2), vP, ST[jt]); }
            WSYNC();
            if (lane == 0) flags[8 + ihalf] = (unsigned)(k + 1);
        }
    } else {
        const int pw = wave - 2;
        LAS bf16_t* stg = (LAS bf16_t*)(lds + CC_STG) + pw * 2048;
        v4u ld[20];
#define CC_ISSUE_A(T0) do { const int t0_ = (T0); const size_t r_ = rowb + t0_ + l15; const size_t rp_ = (t0_ + l15 == 0) ? r_ : r_ - 1; \
            _Pragma("unroll") for (int lo = 0; lo < 2; ++lo) _Pragma("unroll") for (int ks = 0; ks < 2; ++ks) { const int col = 1536 + 64 * lo + 32 * ks + 8 * kg; \
                ld[(lo * 2 + ks) * 2] = *(const v4u*)(proj + r_ * L0P + col); ld[(lo * 2 + ks) * 2 + 1] = *(const v4u*)(proj + rp_ * L0P + col); } } while (0)
#define CC_ISSUE_B(T0) do { const int t0_ = (T0); \
            _Pragma("unroll") for (int ar = 0; ar < 3; ++ar) _Pragma("unroll") for (int i = 0; i < 2; ++i) { const int p_ = lane + 64 * i, row_ = p_ >> 3, c8_ = p_ & 7; \
                const size_t r_ = rowb + t0_ + row_; const size_t rp_ = (t0_ + row_ == 0) ? r_ : r_ - 1; const int col = 512 * ar + h * 64 + 8 * c8_; \
                ld[8 + (ar * 2 + i) * 2] = *(const v4u*)(proj + r_ * L0P + col); ld[8 + (ar * 2 + i) * 2 + 1] = *(const v4u*)(proj + rp_ * L0P + col); } } while (0)
#define CC_ISSUE(T0) do { CC_ISSUE_A(T0); CC_ISSUE_B(T0); } while (0)
        CC_ISSUE(16 * pw);
        int k = pw;
#pragma unroll 1
        while (k < NCH) {
            const int t0 = 16 * k; int kn;
            f32x4 accw[4], acca[4];
#pragma unroll
            for (int nt = 0; nt < 4; ++nt) { accw[nt] = (f32x4){0.f, 0.f, 0.f, 0.f}; acca[nt] = (f32x4){0.f, 0.f, 0.f, 0.f}; }
            { const float pz_ = (t0 + l15 == 0) ? 0.f : 1.f;
#pragma unroll
              for (int lo = 0; lo < 2; ++lo)
#pragma unroll
                for (int ks = 0; ks < 2; ++ks) { float s_[8];
                    const f32x4 m0 = *(const LAS f32x4*)(mixs + 64 * lo + 32 * ks + 8 * kg), m1 = *(const LAS f32x4*)(mixs + 64 * lo + 32 * ks + 8 * kg + 4);
                    RW_SH8(ld[(lo * 2 + ks) * 2], ld[(lo * 2 + ks) * 2 + 1], m0, m1, s_, pz_);
                    if (lo == 0) {
#pragma unroll
                        for (int j = 0; j < 8; ++j) s_[j] = tanh_fast(s_[j]); }
                    const bf16x8 af = pack8(s_[0], s_[1], s_[2], s_[3], s_[4], s_[5], s_[6], s_[7]);
                    const bf16_t* WT = lo ? A2T : W2T;
#pragma unroll
                    for (int nt = 0; nt < 4; ++nt) { const bf16x8 bfr = *(const bf16x8*)(WT + (size_t)(h * 64 + 16 * nt + l15) * 64 + 32 * ks + 8 * kg);
                        if (lo == 0) accw[nt] = MFMA16(af, bfr, accw[nt]); else acca[nt] = MFMA16(af, bfr, acca[nt]); } } }
            { const int need = k - (CC_NSLOT - 1); if (need > 0) { while ((int)flags[8] < need || (int)flags[9] < need) __builtin_amdgcn_s_sleep(2); } }
            asm volatile("" ::: "memory");
            LAS unsigned char* im = lds + (k % CC_NSLOT) * CC_SLOT;
#pragma unroll
            for (int ar = 0; ar < 3; ++ar)
#pragma unroll
                for (int i = 0; i < 2; ++i) { const int p_ = lane + 64 * i, row_ = p_ >> 3, c8_ = p_ & 7; float s_[8];
                    const float pz_ = (t0 + row_ == 0) ? 0.f : 1.f; const f32x4 m0 = *(const LAS f32x4*)(mixs + 256 + ar * 64 + c8_ * 8), m1 = *(const LAS f32x4*)(mixs + 256 + ar * 64 + c8_ * 8 + 4);
                    RW_SH8(ld[8 + (ar * 2 + i) * 2], ld[8 + (ar * 2 + i) * 2 + 1], m0, m1, s_, pz_);
                    if (ar < 2) *(LAS bf16x8*)(stg + ar * 1024 + row_ * 64 + c8_ * 8) = pack8(s_[0], s_[1], s_[2], s_[3], s_[4], s_[5], s_[6], s_[7]);
                    else {
#pragma unroll
                        for (int j = 0; j < 8; ++j) *(LAS bf16_t*)(im + CC_VT + (c8_ * 8 + j) * 40 + row_ * 2) = bf1(s_[j]); } }
            WSYNC();
            float lwv[4][4], av[4][4], knv[4][4];
            float w0c[4], a0c[4], kkc[4], kac[4], rkc[4];
#pragma unroll
            for (int nt = 0; nt < 4; ++nt) { const int c = h * 64 + 16 * nt + l15; w0c[nt] = w0[c]; a0c[nt] = a0[c]; kkc[nt] = k_k[c]; kac[nt] = k_a[c]; rkc[nt] = r_k[c]; }
#pragma unroll
            for (int rg = 0; rg < 4; ++rg) { const int tl = 4 * kg + rg;
                float kkv[4], nrm2 = 0.f, rr_[4], kr_[4];
#pragma unroll
                for (int nt = 0; nt < 4; ++nt) { rr_[nt] = bf2f(stg[tl * 64 + 16 * nt + l15]); kr_[nt] = bf2f(stg[1024 + tl * 64 + 16 * nt + l15]);
                    kkv[nt] = kr_[nt] * kkc[nt]; nrm2 += kkv[nt] * kkv[nt]; }
                nrm2 = rowsum16(nrm2); const float rn = __builtin_amdgcn_rsqf(fmaxf(nrm2, 1e-24f));
                float bon = 0.f;
#pragma unroll
                for (int nt = 0; nt < 4; ++nt) {
                    const float wsum = w0c[nt] + accw[nt][rg]; lwv[nt][rg] = -0.6065306597126334f * sigmoid_fast(wsum);
                    const float a_ = sigmoid_fast(a0c[nt] + acca[nt][rg]); av[nt][rg] = a_; knv[nt][rg] = kkv[nt] * rn;
                    const float k2 = kr_[nt] * (1.f + (a_ - 1.f) * kac[nt]); stg[1024 + tl * 64 + 16 * nt + l15] = bf1(k2);
                    bon += rr_[nt] * k2 * rkc[nt];
                }
                bon = rowsum16(bon);
                if (l15 == 0) bonus_out[(rowb + t0 + tl) * 8 + h] = bon;
            }
            { unsigned g_ = 0; if (lane == 0) g_ = __hip_atomic_fetch_add((LAS unsigned*)(lds + CC_FLAGS + 40), 1u, __ATOMIC_RELAXED, __HIP_MEMORY_SCOPE_WORKGROUP);
              kn = (int)__builtin_amdgcn_readfirstlane(g_); }
            CC_ISSUE_A((kn < NCH) ? 16 * kn : t0);
#pragma unroll
            for (int nt = 0; nt < 4; ++nt) {
                float L[4]; L[0] = lwv[nt][0]; L[1] = L[0] + lwv[nt][1]; L[2] = L[1] + lwv[nt][2]; L[3] = L[2] + lwv[nt][3];
                const float T0 = __shfl(L[3], l15), T1 = __shfl(L[3], 16 + l15), T2 = __shfl(L[3], 32 + l15), T3 = __shfl(L[3], 48 + l15);
                const float off = (kg > 0 ? T0 : 0.f) + (kg > 1 ? T1 : 0.f) + (kg > 2 ? T2 : 0.f), LC = (T0 + T1) + (T2 + T3);
                const int j = 16 * nt + l15;
                unsigned bb2[2], kb2[2];
                const float gC = __expf(LC); float eprev = __expf(off);
#pragma unroll
                for (int rg = 0; rg < 4; ++rg) { const int tl = 4 * kg + rg; const float Lt = off + L[rg], e1 = __expf(Lt), e2 = __builtin_amdgcn_rcpf(e1), e3 = eprev, e4 = gC * e2; eprev = e1;
                    const float kn = knv[nt][rg], bvv = kn * av[nt][rg], k2 = bf2f(stg[1024 + tl * 64 + j]), rr2 = bf2f(stg[tl * 64 + j]);
                    *(LAS bf16_t*)(im + CC_BK + tl * 144 + j * 2) = bf1(bvv * e2); *(LAS bf16_t*)(im + CC_BK + (16 + tl) * 144 + j * 2) = bf1(k2 * e2);
                    *(LAS bf16_t*)(im + CC_AR + tl * 144 + j * 2) = bf1(-kn * e3); *(LAS bf16_t*)(im + CC_AR + (16 + tl) * 144 + j * 2) = bf1(rr2 * e1);
                    const unsigned bq = bf1(bvv * e4), kq = bf1(k2 * e4);
                    if (rg & 1) { bb2[rg >> 1] |= bq << 16; kb2[rg >> 1] |= kq << 16; } else { bb2[rg >> 1] = bq; kb2[rg >> 1] = kq; } }
                *(LAS u32x2*)(im + CC_BBT + j * 40 + (4 * kg) * 2) = (u32x2){bb2[0], bb2[1]}; *(LAS u32x2*)(im + CC_KBT + j * 40 + (4 * kg) * 2) = (u32x2){kb2[0], kb2[1]};
                if (kg == 0) *(LAS float*)(im + CC_GC + j * 4) = gC;
            }
            WSYNC();
            {
                f32x4 nacc = {0.f, 0.f, 0.f, 0.f};
#pragma unroll
                for (int ks = 0; ks < 2; ++ks) { const bf16x8 fa = *(const LAS bf16x8*)(im + CC_BK + l15 * 144 + (32 * ks + 8 * kg) * 2), fb = *(const LAS bf16x8*)(im + CC_AR + l15 * 144 + (32 * ks + 8 * kg) * 2); nacc = MFMA16(fa, fb, nacc); }
#pragma unroll
                for (int rg = 0; rg < 4; ++rg) nacc[rg] = ((4 * kg + rg) < l15) ? nacc[rg] : 0.f;
                float Tr[16];
#pragma unroll
                for (int t = 0; t < 16; ++t) { float acc_ = (l15 == t) ? 1.f : 0.f;
#pragma unroll
                    for (int s2 = 0; s2 < t; ++s2) acc_ += Tr[s2] * rl(nacc[s2 & 3], t + 16 * (s2 >> 2));
                    Tr[t] = acc_; }
                if (kg == 0) {
#pragma unroll
                    for (int t = 0; t < 16; ++t) *(LAS bf16_t*)(im + CC_TT + t * 40 + l15 * 2) = bf1(Tr[t]); }
            }
            WSYNC();
            if (lane == 0) flags[k % CC_NSLOT] = (unsigned)(k + 1);
            CC_ISSUE_B((kn < NCH) ? 16 * kn : t0);
            k = kn;
        }
#undef CC_ISSUE
#undef CC_ISSUE_A
#undef CC_ISSUE_B
    }
#undef RW_SH8
    __syncthreads();
}


__device__ __forceinline__ void gate_lora_task(int chain, int k, int lane, const bf16_t* __restrict__ proj, const float* __restrict__ mix, const bf16_t* __restrict__ G2T, bf16_t* __restrict__ gout) {
    const int b = chain >> 3, h = chain & 7, l15 = lane & 15, kg = lane >> 4, t0 = 16 * k;
    const size_t rowb = (size_t)b * SEQ, r_ = rowb + t0 + l15, rp_ = (t0 + l15 == 0) ? r_ : r_ - 1;
    const float pz_ = (t0 + l15 == 0) ? 0.f : 1.f;
    v4u cu[4], pv[4];
#pragma unroll
    for (int ks = 0; ks < 4; ++ks) { const int col = 1664 + 32 * ks + 8 * kg; cu[ks] = *(const v4u*)(proj + r_ * L0P + col); pv[ks] = *(const v4u*)(proj + rp_ * L0P + col); }
    f32x4 accg[4];
#pragma unroll
    for (int nt = 0; nt < 4; ++nt) accg[nt] = (f32x4){0.f, 0.f, 0.f, 0.f};
#pragma unroll
    for (int ks = 0; ks < 4; ++ks) {
        const f32x4 m0 = *(const f32x4*)(mix + 1664 + 32 * ks + 8 * kg), m1 = *(const f32x4*)(mix + 1664 + 32 * ks + 8 * kg + 4);
        const float mm[8] = {m0[0], m0[1], m0[2], m0[3], m1[0], m1[1], m1[2], m1[3]};
        const unsigned cw[4] = {cu[ks].x, cu[ks].y, cu[ks].z, cu[ks].w}, pw[4] = {pv[ks].x, pv[ks].y, pv[ks].z, pv[ks].w};
        float s_[8];
#pragma unroll
        for (int q = 0; q < 4; ++q) { const float c0 = bflo(cw[q]), c1 = bfhi(cw[q]), p0 = bflo(pw[q]) * pz_, p1 = bfhi(pw[q]) * pz_;
            s_[2 * q] = sigmoid_fast(c0 + (p0 - c0) * mm[2 * q]); s_[2 * q + 1] = sigmoid_fast(c1 + (p1 - c1) * mm[2 * q + 1]); }
        const bf16x8 af = pack8(s_[0], s_[1], s_[2], s_[3], s_[4], s_[5], s_[6], s_[7]);
#pragma unroll
        for (int nt = 0; nt < 4; ++nt) { const bf16x8 bfr = *(const bf16x8*)(G2T + (size_t)(h * 64 + 16 * nt + l15) * 128 + 32 * ks + 8 * kg); accg[nt] = MFMA16(af, bfr, accg[nt]); }
    }
#pragma unroll
    for (int nt = 0; nt < 4; ++nt)
#pragma unroll
        for (int rg = 0; rg < 4; ++rg) gout[(rowb + t0 + 4 * kg + rg) * 512 + h * 64 + 16 * nt + l15] = bf1(accg[nt][rg]);
}


__device__ __forceinline__ void gate_lora_wave(int first, int stride, int lane, const bf16_t* __restrict__ proj, const float* __restrict__ mix, const bf16_t* __restrict__ G2T, bf16_t* __restrict__ gout) {
    const int l15 = lane & 15, kg = lane >> 4, h = (first >> 7) & 7;
    bf16x8 bfr[4][4];
#pragma unroll
    for (int ks = 0; ks < 4; ++ks)
#pragma unroll
        for (int nt = 0; nt < 4; ++nt) bfr[ks][nt] = *(const bf16x8*)(G2T + (size_t)(h * 64 + 16 * nt + l15) * 128 + 32 * ks + 8 * kg);
    float mm[4][8];
#pragma unroll
    for (int ks = 0; ks < 4; ++ks) { const f32x4 m0 = *(const f32x4*)(mix + 1664 + 32 * ks + 8 * kg), m1 = *(const f32x4*)(mix + 1664 + 32 * ks + 8 * kg + 4);
        mm[ks][0] = m0[0]; mm[ks][1] = m0[1]; mm[ks][2] = m0[2]; mm[ks][3] = m0[3]; mm[ks][4] = m1[0]; mm[ks][5] = m1[1]; mm[ks][6] = m1[2]; mm[ks][7] = m1[3]; }
    v4u cu[4], pv[4];
#define GL_LOAD(TK) do { const int ch_ = (TK) >> 7, t0_ = 16 * ((TK) & 127); const size_t r_ = (size_t)(ch_ >> 3) * SEQ + t0_ + l15, rp_ = (t0_ + l15 == 0) ? r_ : r_ - 1; \
        _Pragma("unroll") for (int ks = 0; ks < 4; ++ks) { const int col = 1664 + 32 * ks + 8 * kg; cu[ks] = *(const v4u*)(proj + r_ * L0P + col); pv[ks] = *(const v4u*)(proj + rp_ * L0P + col); } } while (0)
    GL_LOAD(first);
#pragma unroll 1
    for (int tk = first; tk < 128 * 128; tk += stride) {
        const int chain = tk >> 7, t0 = 16 * (tk & 127); const size_t rowb = (size_t)(chain >> 3) * SEQ;
        const float pz_ = (t0 + l15 == 0) ? 0.f : 1.f;
        f32x4 accg[4];
#pragma unroll
        for (int nt = 0; nt < 4; ++nt) accg[nt] = (f32x4){0.f, 0.f, 0.f, 0.f};
        bf16x8 af[4];
#pragma unroll
        for (int ks = 0; ks < 4; ++ks) { const unsigned cw[4] = {cu[ks].x, cu[ks].y, cu[ks].z, cu[ks].w}, pw[4] = {pv[ks].x, pv[ks].y, pv[ks].z, pv[ks].w}; float s_[8];
#pragma unroll
            for (int q = 0; q < 4; ++q) { const float c0 = bflo(cw[q]), c1 = bfhi(cw[q]), p0 = bflo(pw[q]) * pz_, p1 = bfhi(pw[q]) * pz_;
                s_[2 * q] = sigmoid_fast(c0 + (p0 - c0) * mm[ks][2 * q]); s_[2 * q + 1] = sigmoid_fast(c1 + (p1 - c1) * mm[ks][2 * q + 1]); }
            af[ks] = pack8(s_[0], s_[1], s_[2], s_[3], s_[4], s_[5], s_[6], s_[7]); }
        { const int tn = (tk + stride < 128 * 128) ? tk + stride : tk; GL_LOAD(tn); }
#pragma unroll
        for (int ks = 0; ks < 4; ++ks)
#pragma unroll
            for (int nt = 0; nt < 4; ++nt) accg[nt] = MFMA16(af[ks], bfr[ks][nt], accg[nt]);
#pragma unroll
        for (int nt = 0; nt < 4; ++nt)
#pragma unroll
            for (int rg = 0; rg < 4; ++rg) gout[(rowb + t0 + 4 * kg + rg) * 512 + h * 64 + 16 * nt + l15] = bf1(accg[nt][rg]);
    }
#undef GL_LOAD
}

template <bool ST = true> __device__ __forceinline__ void rwkv_post_all(const float* __restrict__ yraw, const bf16_t* __restrict__ proj, const float* __restrict__ mix, const float* __restrict__ bonus, const bf16_t* __restrict__ gbuf,
                                              const float* __restrict__ ln_g, const float* __restrict__ ln_b, bf16_t* __restrict__ ymix, int gw, int NGW, int lane) {
    for (int m = gw; m < M; m += NGW) {
        const bool has_prev = (m & (SEQ - 1)) != 0;
        float y[8], cv[8], pv[8], gg[8], bo[8];
#pragma unroll
        for (int h = 0; h < 8; ++h) { const int c = h * 64 + lane; y[h] = yraw[(size_t)m * 512 + c]; cv[h] = bf2f(proj[(size_t)m * L0P + 1024 + c]);
            pv[h] = bf2f(proj[(size_t)(has_prev ? m - 1 : m) * L0P + 1024 + c]); gg[h] = bf2f(gbuf[(size_t)m * 512 + c]); bo[h] = bonus[(size_t)m * 8 + h]; }
#pragma unroll
        for (int h = 0; h < 8; ++h) { const int c = h * 64 + lane;
            const float mu = wave_sum_dpp(y[h]) * (1.f / 64.f), d = y[h] - mu, var = wave_sum_dpp(d * d) * (1.f / 64.f);
            const float yn = d * __builtin_amdgcn_rsqf(var + 64e-5f) * ln_g[c] + ln_b[c];
            const float pvv = has_prev ? pv[h] : 0.f;
            const float v_s = cv[h] + (pvv - cv[h]) * mix[1024 + c];
            const float o = (yn + bo[h] * v_s) * gg[h];
            if (ST) ymix[(size_t)m * DM + c] = bf1(o); else asm volatile("" :: "v"(o)); }
    }
}


__device__ __forceinline__ void ssd_conv_tile(int it, int lane, LAS bf16_t* scr, const bf16_t* __restrict__ proj, const float* __restrict__ cw, const float* __restrict__ cb,
                                              bf16_t* __restrict__ xbc, bf16_t* __restrict__ xst, bf16_t* __restrict__ bt) {
    const int tt = it >> 4, ct = it & 15, m0 = tt * 64, b = m0 >> 11, t0 = m0 & (SEQ - 1), c = ct * 64 + lane;
    const float w0 = cw[c], w1 = cw[1024 + c], w2 = cw[2048 + c], w3 = cw[3072 + c], bias = cb[c];
    const bf16_t* src = proj + (size_t)m0 * L0P + 2304 + c;
    bf16_t raw[67];
    const int lo = (t0 > 0) ? -3 : 0;
#pragma unroll
    for (int t = -3; t < 64; ++t) raw[t + 3] = src[(ptrdiff_t)((t < lo) ? lo : t) * L0P];
    float u3 = (t0 > 0) ? bf2f(raw[0]) : 0.f, u2 = (t0 > 0) ? bf2f(raw[1]) : 0.f, u1 = (t0 > 0) ? bf2f(raw[2]) : 0.f;
#pragma unroll
    for (int t = 0; t < 64; ++t) {
        const float u = bf2f(raw[t + 3]);
        const float y = bias + w0 * u3 + w1 * u2 + w2 * u1 + w3 * u;
        const bf16_t o = bf1(y * __builtin_amdgcn_rcpf(1.f + __expf(-y)));
        xbc[(size_t)(m0 + t) * 1024 + c] = o;
        scr[t * STG_PITCH + lane] = o;
        u3 = u2; u2 = u1; u1 = u;
    }
    WSYNC();
    if (ct < 12) {
        bf16_t* dst = (ct < 8) ? xst + ((size_t)(b * 8 + ct) * 64) * SEQ + t0 : bt + ((size_t)(b * 2 + ((ct - 8) >> 1)) * 128 + ((ct - 8) & 1) * 64) * SEQ + t0;
#pragma unroll
        for (int i = 0; i < 8; ++i) { const int d = i * 8 + (lane >> 3), tc = lane & 7; const LAS bf16_t* p = scr + (tc * 8) * STG_PITCH + d;
            v4u o; o.x = (unsigned)p[0] | ((unsigned)p[STG_PITCH] << 16); o.y = (unsigned)p[2 * STG_PITCH] | ((unsigned)p[3 * STG_PITCH] << 16);
            o.z = (unsigned)p[4 * STG_PITCH] | ((unsigned)p[5 * STG_PITCH] << 16); o.w = (unsigned)p[6 * STG_PITCH] | ((unsigned)p[7 * STG_PITCH] << 16);
            *(v4u*)(dst + (size_t)d * SEQ + tc * 8) = o; }
    }
    WSYNC();
}
__device__ __forceinline__ float bperm(int srclane, float x) { return __builtin_bit_cast(float, __builtin_amdgcn_ds_bpermute(srclane << 2, __builtin_bit_cast(int, x))); }
__device__ __forceinline__ void scan128(float& x0, float& x1, int lane) {
#pragma unroll
    for (int o = 1; o < 64; o <<= 1) { const int sl = (lane >= o) ? lane - o : lane; const float t0 = bperm(sl, x0), t1 = bperm(sl, x1); if (lane >= o) { x0 += t0; x1 += t1; } }
    x1 += rl(x0, 63);
}

__device__ __forceinline__ void ssd_s3_block(int bc, int tid, int lane, int wave, LAS unsigned char* lds, const bf16_t* __restrict__ xbc, const bf16_t* __restrict__ xst, const bf16_t* __restrict__ stb,
                                             const float* __restrict__ dt, const float* __restrict__ a_log, const float* __restrict__ dsk, bf16_t* __restrict__ yssm) {
    const int b = bc >> 4, c = bc & 15, h = wave, g = h >> 2, l0 = c * 128, l31 = lane & 31, hi = lane >> 5, unit = bc * 8 + h;
    const size_t m0 = (size_t)b * SEQ + l0;
    __syncthreads();
    {
        const int mat = lane >> 4, ch = lane & 15;
        v4u rr[16];
#pragma unroll
        for (int i = 0; i < 16; ++i) rr[i] = *(const v4u*)(xbc + (m0 + wave * 16 + i) * 1024 + 512 + lane * 8);
#pragma unroll
        for (int i = 0; i < 16; ++i) { const int row = wave * 16 + i; *(LAS v4u*)(lds + mat * 34816 + row * 272 + ch * 16) = rr[i]; }
    }
#define S3TAB(i) (*(LAS float*)(lds + ((wave * 64) + ((i) >> 2)) * 272 + 256 + ((i) & 3) * 4))
    const float A = -expf(a_log[h]), D = dsk[h];
    { const float d0 = dt[(m0 + lane) * 8 + h], d1 = dt[(m0 + 64 + lane) * 8 + h];
      float ac0 = d0 * A, ac1 = d1 * A;
      scan128(ac0, ac1, lane);
      S3TAB(lane) = ac0; S3TAB(64 + lane) = ac1; S3TAB(128 + lane) = d0; S3TAB(192 + lane) = d1; }
    u32x2 xf[4][2][2][2];
    const bf16_t* Sp = stb + (size_t)unit * 8192 + l31 * 128 + 8 * hi;
    { const bf16_t* Xp = xst + ((size_t)(b * 8 + h) * 64 + l31) * SEQ + l0 + 4 * hi;
#pragma unroll
      for (int st = 0; st < 4; ++st)
#pragma unroll
          for (int pt = 0; pt < 2; ++pt)
#pragma unroll
              for (int ks = 0; ks < 2; ++ks) { const bf16_t* xp = Xp + (size_t)pt * 32 * SEQ + st * 32 + 16 * ks; xf[st][pt][ks][0] = *(const u32x2*)xp; xf[st][pt][ks][1] = *(const u32x2*)(xp + 8); } }
    __syncthreads();
    const LAS unsigned char* Bl = lds + g * 34816 + 16 * hi;
    const LAS unsigned char* Cl = lds + (2 + g) * 34816 + 16 * hi;
#pragma unroll 1
    for (int lt = 0; lt < 4; ++lt) {
        asm volatile("" ::: "memory");
        f32x16 y[2];
#pragma unroll
        for (int r = 0; r < 16; ++r) { y[0][r] = 0.f; y[1][r] = 0.f; }
        const float acl = S3TAB(32 * lt + l31);
        const int crw = 32 * lt + l31;
        { bf16x8 sfr[2][8];
#pragma unroll
          for (int pt = 0; pt < 2; ++pt)
#pragma unroll
              for (int kk = 0; kk < 8; ++kk) sfr[pt][kk] = *(const bf16x8*)(Sp + pt * 32 * 128 + 16 * kk);
#pragma unroll
          for (int kk = 0; kk < 8; ++kk) { const bf16x8 cf = *(const LAS bf16x8*)(Cl + crw * 272 + 32 * kk); y[0] = MFMA32(sfr[0][kk], cf, y[0]); y[1] = MFMA32(sfr[1][kk], cf, y[1]); } }
        { const float el = __expf(acl);
#pragma unroll
          for (int r = 0; r < 16; ++r) { y[0][r] *= el; y[1][r] *= el; } }
        u32x2 xd[2][4];
#pragma unroll
        for (int pt = 0; pt < 2; ++pt)
#pragma unroll
            for (int q = 0; q < 4; ++q) xd[pt][q] = *(const u32x2*)(xbc + (m0 + crw) * 1024 + h * 64 + 32 * pt + 8 * q + 4 * hi);
#pragma unroll
        for (int st = 0; st < 4; ++st) if (st <= lt) {
            const int brw = 32 * st + l31;
            f32x16 cbt;
#pragma unroll
            for (int r = 0; r < 16; ++r) cbt[r] = 0.f;
#pragma unroll
            for (int kk = 0; kk < 8; ++kk) { const bf16x8 bf_ = *(const LAS bf16x8*)(Bl + brw * 272 + 32 * kk), cf_ = *(const LAS bf16x8*)(Cl + crw * 272 + 32 * kk); cbt = MFMA32(bf_, cf_, cbt); }
#pragma unroll
            for (int r = 0; r < 16; ++r) { const int sl = 32 * st + crow(r, hi); const float acs = S3TAB(sl), dts = S3TAB(128 + sl);
                float v = cbt[r] * __expf(acl - acs) * dts; if (st == lt && crow(r, hi) > l31) v = 0.f; cbt[r] = v; }
            bf16x8 pf[2];
#pragma unroll
            for (int ks = 0; ks < 2; ++ks) pf[ks] = pack8(cbt[8 * ks], cbt[8 * ks + 1], cbt[8 * ks + 2], cbt[8 * ks + 3], cbt[8 * ks + 4], cbt[8 * ks + 5], cbt[8 * ks + 6], cbt[8 * ks + 7]);
#pragma unroll
            for (int pt = 0; pt < 2; ++pt)
#pragma unroll
                for (int ks = 0; ks < 2; ++ks) { v4u a; a.x = xf[st][pt][ks][0].x; a.y = xf[st][pt][ks][0].y; a.z = xf[st][pt][ks][1].x; a.w = xf[st][pt][ks][1].y; y[pt] = MFMA32(__builtin_bit_cast(bf16x8, a), pf[ks], y[pt]); }
        }
#pragma unroll
        for (int pt = 0; pt < 2; ++pt)
#pragma unroll
            for (int q = 0; q < 4; ++q) { const u32x2 xx = xd[pt][q];
                const unsigned o0 = cvtpk(y[pt][4 * q] + D * bflo(xx.x), y[pt][4 * q + 1] + D * bfhi(xx.x)), o1 = cvtpk(y[pt][4 * q + 2] + D * bflo(xx.y), y[pt][4 * q + 3] + D * bfhi(xx.y));
                *(u32x2*)(yssm + (m0 + crw) * 512 + h * 64 + 32 * pt + 8 * q + 4 * hi) = (u32x2){o0, o1}; }
    }
#undef S3TAB
}
__device__ __forceinline__ void ssd_s1_unit(int unit, int lane, LAS float* tab, const bf16_t* __restrict__ xst, const bf16_t* __restrict__ bt, const float* __restrict__ dt, const float* __restrict__ a_log,
                                            float* __restrict__ sloc, float* __restrict__ asum) {
    const int h = unit & 7, c = (unit >> 3) & 15, b = unit >> 7, g = h >> 2, l0 = c * 128, l31 = lane & 31, hi = lane >> 5;
    const size_t m0 = (size_t)b * SEQ + l0;
    const float A = -expf(a_log[h]);
    const float d0 = dt[(m0 + lane) * 8 + h], d1 = dt[(m0 + 64 + lane) * 8 + h];
    float ac0 = d0 * A, ac1 = d1 * A;
    scan128(ac0, ac1, lane);
    const float aend = rl(ac1, 63);
    tab[lane] = __expf(aend - ac0) * d0; tab[64 + lane] = __expf(aend - ac1) * d1;
    if (lane == 0) asum[unit] = aend;
    WSYNC();
    f32x16 acc[2][4];
#pragma unroll
    for (int pt = 0; pt < 2; ++pt)
#pragma unroll
        for (int nt = 0; nt < 4; ++nt)
#pragma unroll
            for (int r = 0; r < 16; ++r) acc[pt][nt][r] = 0.f;
    const bf16_t* Xp = xst + ((size_t)(b * 8 + h) * 64 + l31) * SEQ + l0 + 8 * hi;
    const bf16_t* Bp = bt + ((size_t)(b * 2 + g) * 128 + l31) * SEQ + l0 + 8 * hi;
#pragma unroll 2
    for (int kk = 0; kk < 8; ++kk) {
        const f32x4 wa = *(const LAS f32x4*)(tab + 16 * kk + 8 * hi), wb = *(const LAS f32x4*)(tab + 16 * kk + 8 * hi + 4);
        bf16x8 af[2], bfr[4];
#pragma unroll
        for (int pt = 0; pt < 2; ++pt) { const v4u raw = *(const v4u*)(Xp + (size_t)pt * 32 * SEQ + 16 * kk);
            v4u w; w.x = cvtpk(bflo(raw.x) * wa[0], bfhi(raw.x) * wa[1]); w.y = cvtpk(bflo(raw.y) * wa[2], bfhi(raw.y) * wa[3]);
            w.z = cvtpk(bflo(raw.z) * wb[0], bfhi(raw.z) * wb[1]); w.w = cvtpk(bflo(raw.w) * wb[2], bfhi(raw.w) * wb[3]); af[pt] = __builtin_bit_cast(bf16x8, w); }
#pragma unroll
        for (int nt = 0; nt < 4; ++nt) bfr[nt] = *(const bf16x8*)(Bp + (size_t)nt * 32 * SEQ + 16 * kk);
#pragma unroll
        for (int pt = 0; pt < 2; ++pt)
#pragma unroll
            for (int nt = 0; nt < 4; ++nt) acc[pt][nt] = MFMA32(af[pt], bfr[nt], acc[pt][nt]);
    }
    float* dst = sloc + (size_t)unit * 8192 + l31;
#pragma unroll
    for (int pt = 0; pt < 2; ++pt)
#pragma unroll
        for (int nt = 0; nt < 4; ++nt)
#pragma unroll
            for (int r = 0; r < 16; ++r) dst[(32 * pt + crow(r, hi)) * 128 + 32 * nt] = acc[pt][nt][r];
    WSYNC();
}
__device__ __forceinline__ void ssd_s2_all(const float* __restrict__ sloc, const float* __restrict__ asum, bf16_t* __restrict__ stb, int gtid, int NT) {
    for (int i = gtid; i < 128 * 2048; i += NT) {
        const int bh = i >> 11, e4 = i & 2047, b = bh >> 3, h = bh & 7;
        f32x4 run = {0.f, 0.f, 0.f, 0.f};
#pragma unroll 4
        for (int c = 0; c < 16; ++c) { const int unit = (b * 16 + c) * 8 + h; const f32x4 tmp = *(const f32x4*)(sloc + (size_t)unit * 8192 + e4 * 4);
            uint2 w; w.x = cvtpk(run[0], run[1]); w.y = cvtpk(run[2], run[3]); *(uint2*)(stb + (size_t)unit * 8192 + e4 * 4) = w;
            run = run * __expf(asum[unit]) + tmp; }
    }
}
__device__ __forceinline__ void ssd_s3_unit(int unit, int lane, LAS float* tab, const bf16_t* __restrict__ xbc, const bf16_t* __restrict__ xst, const bf16_t* __restrict__ stb, const float* __restrict__ dt,
                                            const float* __restrict__ a_log, const float* __restrict__ dsk, bf16_t* __restrict__ yssm) {
    const int h = unit & 7, c = (unit >> 3) & 15, b = unit >> 7, g = h >> 2, l0 = c * 128, l31 = lane & 31, hi = lane >> 5;
    const size_t m0 = (size_t)b * SEQ + l0;
    const float A = -expf(a_log[h]), D = dsk[h];
    const float d0 = dt[(m0 + lane) * 8 + h], d1 = dt[(m0 + 64 + lane) * 8 + h];
    float ac0 = d0 * A, ac1 = d1 * A;
    scan128(ac0, ac1, lane);
    tab[lane] = ac0; tab[64 + lane] = ac1; tab[128 + lane] = d0; tab[192 + lane] = d1;
    WSYNC();
    const bf16_t* Cp = xbc + (m0 + l31) * 1024 + 768 + g * 128 + 8 * hi;
    const bf16_t* Sp = stb + (size_t)unit * 8192 + l31 * 128 + 8 * hi;
    const bf16_t* Bp = xbc + (m0 + l31) * 1024 + 512 + g * 128 + 8 * hi;
    const bf16_t* Xp = xst + ((size_t)(b * 8 + h) * 64 + l31) * SEQ + l0 + 4 * hi;
    LAS float* tr = tab + 256;
    const int row = lane >> 1, p0 = (lane & 1) * 16;
#pragma unroll 1
    for (int lt = 0; lt < 4; ++lt) {
        f32x16 y[2];
#pragma unroll
        for (int r = 0; r < 16; ++r) { y[0][r] = 0.f; y[1][r] = 0.f; }
        const float acl = tab[32 * lt + l31];
        bf16x8 cfr[8];
#pragma unroll
        for (int kk = 0; kk < 8; ++kk) cfr[kk] = *(const bf16x8*)(Cp + (size_t)lt * 32 * 1024 + 16 * kk);
        {   bf16x8 s0[8], s1[8];
#pragma unroll
            for (int kk = 0; kk < 8; ++kk) { s0[kk] = *(const bf16x8*)(Sp + 16 * kk); s1[kk] = *(const bf16x8*)(Sp + 32 * 128 + 16 * kk); }
#pragma unroll
            for (int kk = 0; kk < 8; ++kk) { y[0] = MFMA32(s0[kk], cfr[kk], y[0]); y[1] = MFMA32(s1[kk], cfr[kk], y[1]); }
        }
        { const float el = __expf(acl);
#pragma unroll
          for (int r = 0; r < 16; ++r) { y[0][r] *= el; y[1][r] *= el; } }
#pragma unroll 1
        for (int st = 0; st <= lt; ++st) {
            bf16x8 bfr[8]; u32x2 xf[2][2][2];
#pragma unroll
            for (int kk = 0; kk < 8; ++kk) bfr[kk] = *(const bf16x8*)(Bp + (size_t)st * 32 * 1024 + 16 * kk);
#pragma unroll
            for (int pt = 0; pt < 2; ++pt)
#pragma unroll
                for (int ks = 0; ks < 2; ++ks) { const bf16_t* xp = Xp + (size_t)pt * 32 * SEQ + st * 32 + 16 * ks; xf[pt][ks][0] = *(const u32x2*)xp; xf[pt][ks][1] = *(const u32x2*)(xp + 8); }
            f32x16 cbt;
#pragma unroll
            for (int r = 0; r < 16; ++r) cbt[r] = 0.f;
#pragma unroll
            for (int kk = 0; kk < 8; ++kk) cbt = MFMA32(bfr[kk], cfr[kk], cbt);
#pragma unroll
            for (int r = 0; r < 16; ++r) { const int sl = 32 * st + crow(r, hi); const float acs = tab[sl], dts = tab[128 + sl];
                float v = cbt[r] * __expf(acl - acs) * dts; if (st == lt && crow(r, hi) > l31) v = 0.f; cbt[r] = v; }
            bf16x8 pf[2];
#pragma unroll
            for (int ks = 0; ks < 2; ++ks) pf[ks] = pack8(cbt[8 * ks], cbt[8 * ks + 1], cbt[8 * ks + 2], cbt[8 * ks + 3], cbt[8 * ks + 4], cbt[8 * ks + 5], cbt[8 * ks + 6], cbt[8 * ks + 7]);
#pragma unroll
            for (int pt = 0; pt < 2; ++pt)
#pragma unroll
                for (int ks = 0; ks < 2; ++ks) { v4u a; a.x = xf[pt][ks][0].x; a.y = xf[pt][ks][0].y; a.z = xf[pt][ks][1].x; a.w = xf[pt][ks][1].y; y[pt] = MFMA32(__builtin_bit_cast(bf16x8, a), pf[ks], y[pt]); }
        }
#pragma unroll
        for (int pt = 0; pt < 2; ++pt) {
#pragma unroll
            for (int r = 0; r < 16; ++r) tr[l31 * 33 + crow(r, hi)] = y[pt][r];
            WSYNC();
            const size_t m = m0 + 32 * lt + row;
            const v4u xa = *(const v4u*)(xbc + m * 1024 + h * 64 + 32 * pt + p0), xb = *(const v4u*)(xbc + m * 1024 + h * 64 + 32 * pt + p0 + 8);
            const unsigned xu[8] = {xa.x, xa.y, xa.z, xa.w, xb.x, xb.y, xb.z, xb.w};
            unsigned ow[8];
#pragma unroll
            for (int q = 0; q < 8; ++q) { const float v0 = tr[row * 33 + p0 + 2 * q] + D * bflo(xu[q]), v1 = tr[row * 33 + p0 + 2 * q + 1] + D * bfhi(xu[q]); ow[q] = cvtpk(v0, v1); }
            bf16_t* dst = yssm + m * 512 + h * 64 + 32 * pt + p0;
            *(v4u*)dst = (v4u){ow[0], ow[1], ow[2], ow[3]}; *(v4u*)(dst + 8) = (v4u){ow[4], ow[5], ow[6], ow[7]};
            WSYNC();
        }
    }
}


__device__ __forceinline__ float sum8(float x) { x += dpp_mov<0xB1>(x); x += dpp_mov<0x4E>(x); x += dpp_mov<0x141>(x); return x; }
__device__ __forceinline__ float sum32(float x, int lane) { x = rowsum16(x); return x + bperm(lane ^ 16, x); }
__device__ __forceinline__ void unpack8(const v4u& w, float (&f)[8]) { f[0] = bflo(w.x); f[1] = bfhi(w.x); f[2] = bflo(w.y); f[3] = bfhi(w.y); f[4] = bflo(w.z); f[5] = bfhi(w.z); f[6] = bflo(w.w); f[7] = bfhi(w.w); }
__device__ __forceinline__ void ssm_gate_norm_vec(const bf16_t* __restrict__ yssm, const bf16_t* __restrict__ proj, const float* __restrict__ ng, bf16_t* __restrict__ ymix, int m0, int m1, int w, int nw, int lane) {
    const int c0 = lane * 8;
    float gn[8];
    { const f32x4 a = *(const f32x4*)(ng + c0), b = *(const f32x4*)(ng + c0 + 4); gn[0] = a[0]; gn[1] = a[1]; gn[2] = a[2]; gn[3] = a[3]; gn[4] = b[0]; gn[5] = b[1]; gn[6] = b[2]; gn[7] = b[3]; }
    for (int mb = m0 + w; mb < m1; mb += nw * 4) {
        v4u yv[4], zv[4];
#pragma unroll
        for (int k = 0; k < 4; ++k) { const int m = (mb + k * nw < m1) ? mb + k * nw : mb; yv[k] = *(const v4u*)(yssm + (size_t)m * 512 + c0); zv[k] = *(const v4u*)(proj + (size_t)m * L0P + 1792 + c0); }
#pragma unroll
        for (int k = 0; k < 4; ++k) { const int m = mb + k * nw;
            float y[8], z[8], u[8], q = 0.f; unpack8(yv[k], y); unpack8(zv[k], z);
#pragma unroll
            for (int j = 0; j < 8; ++j) { u[j] = y[j] * z[j] * __builtin_amdgcn_rcpf(1.f + __builtin_amdgcn_exp2f(-1.4426950408889634f * z[j])); q += u[j] * u[j]; }
            const float rs = __builtin_amdgcn_rsqf(sum32(q, lane) * (1.f / 256.f) + 1e-5f);
            v4u o; o.x = cvtpk(u[0] * rs * gn[0], u[1] * rs * gn[1]); o.y = cvtpk(u[2] * rs * gn[2], u[3] * rs * gn[3]); o.z = cvtpk(u[4] * rs * gn[4], u[5] * rs * gn[5]); o.w = cvtpk(u[6] * rs * gn[6], u[7] * rs * gn[7]);
            if (m < m1) *(v4u*)(ymix + (size_t)m * DM + 512 + c0) = o; }
    }
}
__device__ __forceinline__ void rwkv_post_vec(const float* __restrict__ yraw, const bf16_t* __restrict__ proj, const float* __restrict__ mix, const float* __restrict__ bonus, const bf16_t* __restrict__ gbuf,
                                              const float* __restrict__ ln_g, const float* __restrict__ ln_b, bf16_t* __restrict__ ymix, int gw, int NGW, int lane) {
    const int c0 = lane * 8, h = lane >> 3;
    float lg[8], lb[8], mx[8];
    { const f32x4 a = *(const f32x4*)(ln_g + c0), b = *(const f32x4*)(ln_g + c0 + 4), c = *(const f32x4*)(ln_b + c0), d = *(const f32x4*)(ln_b + c0 + 4), e = *(const f32x4*)(mix + 1024 + c0), f = *(const f32x4*)(mix + 1024 + c0 + 4);
#pragma unroll
      for (int j = 0; j < 4; ++j) { lg[j] = a[j]; lg[4 + j] = b[j]; lb[j] = c[j]; lb[4 + j] = d[j]; mx[j] = e[j]; mx[4 + j] = f[j]; } }
    for (int mb = gw; mb < M; mb += NGW * 2) {
        f32x4 ya[2], yb[2]; v4u cv[2], pv[2], gv[2]; float bo[2];
#pragma unroll
        for (int k = 0; k < 2; ++k) { const int m = mb + k * NGW; const bool hp = (m & (SEQ - 1)) != 0;
            ya[k] = *(const f32x4*)(yraw + (size_t)m * 512 + c0); yb[k] = *(const f32x4*)(yraw + (size_t)m * 512 + c0 + 4);
            cv[k] = *(const v4u*)(proj + (size_t)m * L0P + 1024 + c0); pv[k] = *(const v4u*)(proj + (size_t)(hp ? m - 1 : m) * L0P + 1024 + c0);
            gv[k] = *(const v4u*)(gbuf + (size_t)m * 512 + c0); bo[k] = bonus[(size_t)m * 8 + h]; }
#pragma unroll
        for (int k = 0; k < 2; ++k) { const int m = mb + k * NGW; const float pz = ((m & (SEQ - 1)) != 0) ? 1.f : 0.f;
            float y[8] = {ya[k][0], ya[k][1], ya[k][2], ya[k][3], yb[k][0], yb[k][1], yb[k][2], yb[k][3]}, cc[8], pp[8], gg[8];
            unpack8(cv[k], cc); unpack8(pv[k], pp); unpack8(gv[k], gg);
            float sm = 0.f;
#pragma unroll
            for (int j = 0; j < 8; ++j) sm += y[j];
            const float mu = sum8(sm) * (1.f / 64.f);
            float qv = 0.f;
#pragma unroll
            for (int j = 0; j < 8; ++j) { y[j] -= mu; qv += y[j] * y[j]; }
            const float rs = __builtin_amdgcn_rsqf(sum8(qv) * (1.f / 64.f) + 64e-5f);
            float o[8];
#pragma unroll
            for (int j = 0; j < 8; ++j) { const float vs = cc[j] + (pp[j] * pz - cc[j]) * mx[j]; o[j] = (y[j] * rs * lg[j] + lb[j] + bo[k] * vs) * gg[j]; }
            v4u w; w.x = cvtpk(o[0], o[1]); w.y = cvtpk(o[2], o[3]); w.z = cvtpk(o[4], o[5]); w.w = cvtpk(o[6], o[7]);
            *(v4u*)(ymix + (size_t)m * DM + c0) = w; }
    }
}

struct Args { const float* in[43]; float* out; unsigned char* ws; };
constexpr int HG_PITCH = 144, HG_A_BYTES = 128 * HG_PITCH, HG_STAGE = (128 + 256) * HG_PITCH;
__device__ __forceinline__ void halo_gemm_unit(int unit, int tid, int lane, int wave, LAS unsigned char* lds, const bf16_t* __restrict__ XBp, const bf16_t* __restrict__ Wup, bf16_t* __restrict__ HALOp) {
    const int pm = unit / 11, pn = unit - pm * 11, wr = wave >> 2, wc = wave & 3, l31 = lane & 31, hi = lane >> 5;
    const int srow = tid >> 3, sch = tid & 7;
    const bf16_t* gA[2]; const bf16_t* gB[4]; int lA[2], lB[4];
#pragma unroll
    for (int i = 0; i < 2; ++i) { const int row = srow + 64 * i, R = 128 * pm + row; gA[i] = XBp + (size_t)(64 * (R >> 1) + 62 + (R & 1)) * DM + sch * 8; lA[i] = row * HG_PITCH + sch * 16; }
#pragma unroll
    for (int i = 0; i < 4; ++i) { const int row = srow + 64 * i, ch = 256 * pn + row; gB[i] = Wup + (size_t)(256 * (ch >> 7) + (ch & 127)) * 1024 + sch * 8; lB[i] = HG_A_BYTES + row * HG_PITCH + sch * 16; }
    f32x16 acc[2][2];
#pragma unroll
    for (int a = 0; a < 2; ++a)
#pragma unroll
        for (int b = 0; b < 2; ++b)
#pragma unroll
            for (int r = 0; r < 16; ++r) acc[a][b][r] = 0.f;
    v4u ra0[2], rb0[4], ra1[2], rb1[4];
#pragma unroll
    for (int i = 0; i < 2; ++i) ra0[i] = *(const v4u*)gA[i];
#pragma unroll
    for (int i = 0; i < 4; ++i) rb0[i] = *(const v4u*)gB[i];
#pragma unroll
    for (int i = 0; i < 2; ++i) ra1[i] = *(const v4u*)(gA[i] + 64);
#pragma unroll
    for (int i = 0; i < 4; ++i) rb1[i] = *(const v4u*)(gB[i] + 64);
#pragma unroll
    for (int i = 0; i < 2; ++i) *(LAS v4u*)(lds + lA[i]) = ra0[i];
#pragma unroll
    for (int i = 0; i < 4; ++i) *(LAS v4u*)(lds + lB[i]) = rb0[i];
    __syncthreads();
    const int fA = (64 * wr + l31) * HG_PITCH + 16 * hi, fB = HG_A_BYTES + (64 * wc + l31) * HG_PITCH + 16 * hi;
#define HG_COMPUTE(S) do { _Pragma("unroll") for (int st = 0; st < 4; ++st) { bf16x8 fa[2], fb[2]; \
        _Pragma("unroll") for (int x = 0; x < 2; ++x) { fa[x] = *(const LAS bf16x8*)((S) + fA + 32 * x * HG_PITCH + 32 * st); fb[x] = *(const LAS bf16x8*)((S) + fB + 32 * x * HG_PITCH + 32 * st); } \
        _Pragma("unroll") for (int a = 0; a < 2; ++a) _Pragma("unroll") for (int b = 0; b < 2; ++b) acc[a][b] = MFMA32(fb[b], fa[a], acc[a][b]); } } while (0)
#pragma unroll 1
    for (int c = 0; c < 16; c += 2) {
        { const int k2 = (c + 2 < 16) ? 64 * (c + 2) : 0;
#pragma unroll
          for (int i = 0; i < 2; ++i) ra0[i] = *(const v4u*)(gA[i] + k2);
#pragma unroll
          for (int i = 0; i < 4; ++i) rb0[i] = *(const v4u*)(gB[i] + k2);
          HG_COMPUTE(lds);
#pragma unroll
          for (int i = 0; i < 2; ++i) *(LAS v4u*)(lds + HG_STAGE + lA[i]) = ra1[i];
#pragma unroll
          for (int i = 0; i < 4; ++i) *(LAS v4u*)(lds + HG_STAGE + lB[i]) = rb1[i];
          __syncthreads(); }
        { const int k3 = (c + 3 < 16) ? 64 * (c + 3) : 0;
#pragma unroll
          for (int i = 0; i < 2; ++i) ra1[i] = *(const v4u*)(gA[i] + k3);
#pragma unroll
          for (int i = 0; i < 4; ++i) rb1[i] = *(const v4u*)(gB[i] + k3);
          HG_COMPUTE(lds + HG_STAGE);
          if (c + 2 < 16) {
#pragma unroll
              for (int i = 0; i < 2; ++i) *(LAS v4u*)(lds + lA[i]) = ra0[i];
#pragma unroll
              for (int i = 0; i < 4; ++i) *(LAS v4u*)(lds + lB[i]) = rb0[i];
          }
          __syncthreads(); }
    }
#undef HG_COMPUTE
#pragma unroll
    for (int a = 0; a < 2; ++a) { const int R = 128 * pm + 64 * wr + 32 * a + l31;
#pragma unroll
        for (int b = 0; b < 2; ++b)
#pragma unroll
            for (int g = 0; g < 4; ++g) { const int ch = 256 * pn + 64 * wc + 32 * b + 8 * g + 4 * hi;
                u32x2 w; w.x = cvtpk(acc[a][b][4 * g], acc[a][b][4 * g + 1]); w.y = cvtpk(acc[a][b][4 * g + 2], acc[a][b][4 * g + 3]);
                *(u32x2*)(HALOp + (size_t)R * DFF + ch) = w; } }
}
__device__ __forceinline__ void halo_signal(unsigned* cnt) {
    asm volatile("s_waitcnt vmcnt(0)" ::: "memory");
    __syncthreads();
    if (threadIdx.x == 0) { __builtin_amdgcn_fence(__ATOMIC_RELEASE, "agent"); asm volatile("s_waitcnt vmcnt(0)" ::: "memory"); (void)xb_add(cnt, 1u); }
}
__device__ __forceinline__ void halo_wait(unsigned* cnt, unsigned need, unsigned* bar) {
    if (threadIdx.x == 0) { XB_SPIN(xb_ld(cnt) < need, bar); __builtin_amdgcn_fence(__ATOMIC_ACQUIRE, "agent"); asm volatile("s_waitcnt vmcnt(0)" ::: "memory"); }
    __syncthreads();
}
#define GEMM_PHASE(EPI, Aptr, LDA, Bptr, LDB, NN, KK, ...) do { pg8::Gemm g_{(Aptr), (Bptr), M, (NN), (KK), (LDA), (LDB)}; pg8::StaticOrder S_; S_.init(M, (NN), G, (int)blockIdx.x); \
        pg8::EPI E_{__VA_ARGS__}; pg8::gemm_phase<pg8::EPI, pg8::StaticOrder, true, true>(lds3, g_, S_, E_); } while (0)

__global__ void __launch_bounds__(NWAVES * 64, 2) fwd_mega(Args args) {
    extern __shared__ __attribute__((aligned(16))) unsigned char lds[];
    LAS unsigned char* lds3 = (LAS unsigned char*)lds;
    volatile LAS unsigned* MISC = (volatile LAS unsigned*)(lds3 + MISC_OFF);
    const int G = gridDim.x, NGW = G * NWAVES, NT = G * NWAVES * 64;
#define PHASE_IDS() int tid = threadIdx.x; asm volatile("" : "+v"(tid)); const int lane = tid & 63, wave = __builtin_amdgcn_readfirstlane(tid >> 6); const int gw = blockIdx.x * NWAVES + wave, gtid = blockIdx.x * (NWAVES * 64) + tid; (void)lane; (void)gw; (void)gtid
    unsigned char* ws = args.ws;
    gu32* ctl = (gu32*)(ws + WS_CTL);
    for (int u = threadIdx.x; u < (LDS_BYTES - LDSCTL_OFF) / 4; u += NWAVES * 64) ((LAS unsigned*)(lds3 + LDSCTL_OFF))[u] = 0u;
    __syncthreads();
    XcdBarrier bar = xcd_barrier_post((unsigned*)(ctl + CW_BAR), MISC + 8);
#if defined(PROBE_STAMPS)
    int nb_ = 0;
    if (blockIdx.x == 0 && threadIdx.x == 0) MISC[16] = (unsigned)__builtin_amdgcn_s_memrealtime();
#define GRID_BAR() do { xcd_barrier(bar); ++nb_; if (blockIdx.x == 0 && threadIdx.x == 0) MISC[16 + nb_] = (unsigned)__builtin_amdgcn_s_memrealtime(); } while (0)
#else
#define GRID_BAR() xcd_barrier(bar)
#endif
#define IN(i) (args.in[i])
    float* out = args.out;
    bf16_t* W0in = (bf16_t*)(ws + WS_W0IN); bf16_t* W0out = (bf16_t*)(ws + WS_W0OUT); bf16_t* Wup0 = (bf16_t*)(ws + WS_WUP0); bf16_t* Wdn0 = (bf16_t*)(ws + WS_WDN0);
    bf16_t* W1in = (bf16_t*)(ws + WS_W1IN); bf16_t* Wuq = (bf16_t*)(ws + WS_WUQ); bf16_t* Wukv = (bf16_t*)(ws + WS_WUKV); bf16_t* W1out = (bf16_t*)(ws + WS_W1OUT);
    bf16_t* Wup1 = (bf16_t*)(ws + WS_WUP1); bf16_t* Wdn1 = (bf16_t*)(ws + WS_WDN1);
    bf16_t* XB = (bf16_t*)(ws + WS_XB); bf16_t* YMIX = (bf16_t*)(ws + WS_YMIX); bf16_t* PROJ0 = (bf16_t*)(ws + WS_BIG);
    bf16_t* ZB = (bf16_t*)out; float* YRAW = out; bf16_t* YSSM = (bf16_t*)(out + (size_t)M * 512); bf16_t* STB = (bf16_t*)(out + (size_t)M * 768); bf16_t* XST = (bf16_t*)(ws + WS_XST); bf16_t* BT = (bf16_t*)(ws + WS_BT); float* ASUM = (float*)(ws + WS_ASUM); float* SLOC = (float*)(ws + WS_SLOC); float* DT = (float*)(ws + WS_DT); bf16_t* GB = (bf16_t*)(ws + WS_G); float* BONUS = (float*)(ws + WS_BONUS);
    bf16_t* W2T = (bf16_t*)(ws + WS_W2T); bf16_t* A2T = (bf16_t*)(ws + WS_A2T); bf16_t* G2T = (bf16_t*)(ws + WS_G2T); bf16_t* ACT = (bf16_t*)(ws + WS_GU); bf16_t* HALO = (bf16_t*)(ws + WS_GU + 176 * MiB);
    bf16_t* PROJ1 = (bf16_t*)(ws + WS_PROJ1); bf16_t* QM = (bf16_t*)(ws + WS_QM); bf16_t* KVM = (bf16_t*)(ws + WS_KVM); bf16_t* KPE = (bf16_t*)(ws + WS_KPE); float* RS = (float*)(ws + WS_RS); float* CSTAB = (float*)(ws + WS_CSTAB); float* STATS = (float*)(ws + WS_CSTAB + 4 * MiB); bf16_t* VTS = (bf16_t*)(ws + WS_VTS); bf16_t* VTM = (bf16_t*)(ws + WS_VTM);
    const int* pos = (const int*)args.in[1];

    {
        PHASE_IDS();
    {
        LAS float* scr = (LAS float*)(lds3 + wave * 16384); int trb = 0;
        transpose_matrix(IN(2), 1024, 3336, W0in, L0P, 1024, scr, gw, NGW, lane, nullptr, trb);
        transpose_matrix(IN(20), 1024, 1024, W0out, 1024, 1024, scr, gw, NGW, lane, nullptr, trb);
        transpose_matrix(IN(5), 64, 512, W2T, 512, 64, scr, gw, NGW, lane, nullptr, trb);
        transpose_matrix(IN(7), 64, 512, A2T, 512, 64, scr, gw, NGW, lane, nullptr, trb);
        transpose_matrix(IN(8), 128, 512, G2T, 512, 128, scr, gw, NGW, lane, nullptr, trb);
        const float* x = IN(0);
        {
            constexpr size_t TOT4 = (size_t)M * DM / 4;
            for (size_t i = gtid; i < TOT4; i += (size_t)NT * 8) {
                f32x4 v[8];
#pragma unroll
                for (int u = 0; u < 8; ++u) v[u] = *(const f32x4*)(x + (i + (size_t)u * NT) * 4);
#pragma unroll
                for (int u = 0; u < 8; ++u) { uint2 w; w.x = cvtpk(v[u][0], v[u][1]); w.y = cvtpk(v[u][2], v[u][3]); *(uint2*)(XB + (i + (size_t)u * NT) * 4) = w; }
            }
        }
    }
    }
    GRID_BAR();
    {
        PHASE_IDS();
    GEMM_PHASE(EpiBf16S, XB, DM, W0in, 1024, L0P, 1024, PROJ0, nullptr, L0P, 0);
    }
    GRID_BAR();
    {
        PHASE_IDS();
        const int blk = (int)blockIdx.x, m0 = blk * 128;
        {   LAS bf16_t* scr = (LAS bf16_t*)(lds3 + wave * 16384);
#pragma unroll 1
            for (int k = 0; k < 4; ++k) ssd_conv_tile((2 * blk + (k & 1)) * 16 + wave + 8 * (k >> 1), lane, scr, PROJ0, IN(14), IN(15), XB, XST, BT);
            for (int i = tid; i < 1024; i += NWAVES * 64) { const int m = m0 + (i >> 3); DT[(size_t)m * 8 + (i & 7)] = softplusf_(bf2f(PROJ0[(size_t)m * L0P + 3328 + (i & 7)]) + IN(16)[i & 7]); }
        }
        __syncthreads();
#if defined(PROBE_STAMPS)
        if (blockIdx.x == 0 && threadIdx.x == 0) MISC[16 + 29] = (unsigned)__builtin_amdgcn_s_memrealtime();
#endif
        ssd_s1_unit(blk * 8 + wave, lane, (LAS float*)(lds3 + wave * 16384), XST, BT, DT, IN(17), SLOC, ASUM);
    }
    GRID_BAR();
    {
        PHASE_IDS();
        ssd_s2_all(SLOC, ASUM, STB, gtid, NT);
    }
    GRID_BAR();
    {
        PHASE_IDS();
        const int blk = (int)blockIdx.x;
        if (blk < 128) {
            rwkv_phase_chain((LAS float*)lds3, tid, lane, wave, blk, PROJ0, IN(3), IN(4), IN(6), IN(9), IN(10), IN(11), W2T, A2T, G2T, YRAW, GB, BONUS);
#if defined(PROBE_STAMPS)
            if (blk == 0 && threadIdx.x == 0) MISC[16 + 23] = (unsigned)__builtin_amdgcn_s_memrealtime();
#endif
        } else {
            const int bc0 = (blk - 128) * 2;
#if defined(PROBE_STAMPS)
            const unsigned tu0_ = (unsigned)__builtin_amdgcn_s_memrealtime();
#endif
            {
                const int gwu = (blk - 128) * NWAVES + wave;
                gate_lora_wave(gwu, 128 * NWAVES, lane, PROJ0, IN(3), G2T, GB);
            }
#if defined(PROBE_STAMPS)
            __syncthreads(); if (blk == 128 && threadIdx.x == 0) __hip_atomic_store(ctl + 2049, (unsigned)__builtin_amdgcn_s_memrealtime() - tu0_, __ATOMIC_RELAXED, __HIP_MEMORY_SCOPE_AGENT);
#endif
#pragma unroll 1
            for (int u = 0; u < 2; ++u) ssd_s3_block(bc0 + u, tid, lane, wave, lds3, XB, XST, STB, DT, IN(17), IN(18), YSSM);
            __syncthreads();
#if defined(PROBE_STAMPS)
            __syncthreads(); if (blk == 128 && threadIdx.x == 0) __hip_atomic_store(ctl + 2050, (unsigned)__builtin_amdgcn_s_memrealtime() - tu0_, __ATOMIC_RELAXED, __HIP_MEMORY_SCOPE_AGENT);
#endif
            ssm_gate_norm_vec(YSSM, PROJ0, IN(19), YMIX, bc0 * 128, bc0 * 128 + 256, wave, NWAVES, lane);
#if defined(PROBE_STAMPS)
            __syncthreads(); if (blk == 128 && threadIdx.x == 0) __hip_atomic_store(ctl + 2051, (unsigned)__builtin_amdgcn_s_memrealtime() - tu0_, __ATOMIC_RELAXED, __HIP_MEMORY_SCOPE_AGENT);
#endif
            { const int gwu = (blk - 128) * NWAVES + wave, NGWU = 128 * NWAVES; LAS float* scr = (LAS float*)(lds3 + wave * 16384); int trb = 0;
              transpose_matrix(IN(23), 1024, 5632, Wup0, 5632, 1024, scr, gwu, NGWU, lane, nullptr, trb, true);
              transpose_matrix(IN(26), 2816, 1024, Wdn0, 1024, 2816, scr, gwu, NGWU, lane, nullptr, trb);
            }
#if defined(PROBE_STAMPS)
            __syncthreads(); if (blk == 128 && threadIdx.x == 0) __hip_atomic_store(ctl + 2048, (unsigned)__builtin_amdgcn_s_memrealtime() - tu0_, __ATOMIC_RELAXED, __HIP_MEMORY_SCOPE_AGENT);
#endif
        }
    }
    GRID_BAR();
    {
        PHASE_IDS();
        rwkv_post_vec(YRAW, PROJ0, IN(3), BONUS, GB, IN(12), IN(13), YMIX, gw, NGW, lane);
    }
    GRID_BAR();
    {
        PHASE_IDS();
    GEMM_PHASE(EpiResid, YMIX, DM, W0out, 1024, 1024, 1024, IN(0), ZB, ALPHA, 0);
    }
    GRID_BAR();
    {
        PHASE_IDS();
        if ((int)blockIdx.x >= 88) {
            ln_rows_range<1, 2>(ZB, XB, nullptr, STATS, IN(21), IN(22), ((int)blockIdx.x - 88) * NWAVES + wave, (M / 64) * 31, (G - 88) * NWAVES, lane);
        } else {
            const int pm_ = (int)blockIdx.x / 11;
            ln_rows_range<1, 1>(ZB, XB, nullptr, STATS, IN(21), IN(22), 64 * pm_ + wave, 64 * pm_ + 64, NWAVES, lane);
            asm volatile("s_waitcnt vmcnt(0)" ::: "memory");
            __syncthreads();
            if (threadIdx.x == 0) { __builtin_amdgcn_fence(__ATOMIC_ACQUIRE, "agent"); asm volatile("s_waitcnt vmcnt(0)" ::: "memory"); }
            __syncthreads();
            halo_gemm_unit((int)blockIdx.x, tid, lane, wave, lds3, XB, Wup0, HALO);
        }
        {
            const int gwu = gw, NGWU = NGW; LAS float* scr = (LAS float*)(lds3 + wave * 16384); int trb = 0;
            transpose_matrix(IN(29), 1024, 1952, W1in, L1P, 1024, scr, gwu, NGWU, lane, nullptr, trb);
            transpose_matrix(IN(31), 256, 768, Wuq, 768, 256, scr, gwu, NGWU, lane, IN(30), trb);
            transpose_matrix(IN(33), 128, 1024, Wukv, 1024, 256, scr, gwu, NGWU, lane, IN(32), trb);
            transpose_matrix(IN(34), 1024, 1024, W1out, 1024, 1024, scr, gwu, NGWU, lane, nullptr, trb);
            transpose_matrix(IN(37), 1024, 5632, Wup1, 5632, 1024, scr, gwu, NGWU, lane, nullptr, trb, true);
            transpose_matrix(IN(40), 2816, 1024, Wdn1, 1024, 2816, scr, gwu, NGWU, lane, nullptr, trb);
            for (int i = gwu * 64 + lane; i < 1024 * 16; i += NGWU * 64) { const int n = i >> 4, c = i & 15; *(v4u*)(Wukv + (size_t)n * 256 + 128 + c * 8) = (v4u){0u, 0u, 0u, 0u}; }
        }
    }
    GRID_BAR();
    {
        PHASE_IDS();
        { pg8::Gemm g_{XB, Wup0, M, 2 * DFF, 1024, DM, 1024, 128, 256, 128, 256, 0, 1}; pg8::StaticOrder S_; S_.init(M, 2 * DFF, G, (int)blockIdx.x);
          pg8::EpiConvAct E_{ACT, HALO, IN(24), IN(25), DFF, SEQ}; pg8::gemm_phase<pg8::EpiConvAct, pg8::StaticOrder, true, true>(lds3, g_, S_, E_); }
    }
    GRID_BAR();
    {
        PHASE_IDS();
    GEMM_PHASE(EpiResidLN, ACT, DFF, Wdn0, DFF, 1024, DFF, ZB, ZB, STATS, IN(21), IN(22), ALPHA, 0);
    }
    GRID_BAR();
    {
        PHASE_IDS();
    ln_rows<1>(ZB, XB, nullptr, STATS, IN(27), IN(28), gw, NGW, lane);
    }
    GRID_BAR();
    {
        PHASE_IDS();
    GEMM_PHASE(EpiBf16S, XB, DM, W1in, 1024, L1P, 1024, PROJ1, nullptr, L1P, 0);
    }
    GRID_BAR();
    {
        PHASE_IDS();
    mla_prep_all(PROJ1, pos, RS, KPE, CSTAB, gw, NGW, lane);
    {
        LAS bf16_t* scr = (LAS bf16_t*)(lds3 + wave * 16384);
        for (int r = gw; r < 4096; r += NGW) { const int bh = r >> 5, tt = r & 31, b = bh >> 3, h = bh & 7;
            transpose_tile64(PROJ1 + ((size_t)b * SEQ + tt * 64) * L1P + 1024 + h * 64, L1P, VTS + (size_t)bh * 64 * SEQ + tt * 64, SEQ, scr, lane); }
    }
    }
    GRID_BAR();
    {
        PHASE_IDS();
    GEMM_PHASE(EpiBf16S, PROJ1 + 1536, L1P, Wuq, 256, 768, 256, QM, RS, 768, 2);
    GEMM_PHASE(EpiBf16S, PROJ1 + 1792, L1P, Wukv, 256, 1024, 256, KVM, RS + 1, 1024, 2);
    }
    GRID_BAR();
    {
        PHASE_IDS();
    {
        LAS bf16_t* scr = (LAS bf16_t*)(lds3 + wave * 16384);
        for (int r = gw; r < 4096; r += NGW) { const int bh = r >> 5, tt = r & 31, b = bh >> 3, h = bh & 7;
            transpose_tile64(KVM + ((size_t)b * SEQ + tt * 64) * 1024 + h * 128 + 64, 1024, VTM + (size_t)bh * 64 * SEQ + tt * 64, SEQ, scr, lane); }
    }
    }
    GRID_BAR();
    {
        PHASE_IDS();
    {
        { LAS unsigned char* wl = lds3 + wave * 16384;
          for (int g2 = gw; g2 < 2048; g2 += NGW) { const int bh = g2 >> 4, w = g2 & 15;
#pragma unroll 1
              for (int i = 0; i < 4; ++i) { const int qb = (i == 0) ? w : (i == 1) ? 31 - w : (i == 2) ? 32 + w : 63 - w; sb_wave(bh, qb, lane, PROJ1, VTS, YMIX, wl); } } }
        __syncthreads();
        for (int g2 = (int)blockIdx.x; g2 < 256; g2 += G) { const int bh = g2 >> 1, part = g2 & 1;
#pragma unroll 1
            for (int i = 0; i < 4; ++i) { const int sbk = part ? ((i == 0) ? 1 : (i == 1) ? 6 : (i == 2) ? 2 : 5) : ((i == 0) ? 0 : (i == 1) ? 7 : (i == 2) ? 3 : 4);
                mla_block(bh, sbk, tid, lane, wave, lds3, QM, KVM, KPE, VTM, YMIX, CSTAB); } }
    }
    }
    GRID_BAR();
    {
        PHASE_IDS();
    GEMM_PHASE(EpiResidLN, YMIX, DM, W1out, 1024, 1024, 1024, ZB, ZB, STATS, IN(27), IN(28), ALPHA, 0);
    }
    GRID_BAR();
    {
        PHASE_IDS();
        if ((int)blockIdx.x >= 88) {
            ln_rows_range<1, 2>(ZB, XB, nullptr, STATS, IN(35), IN(36), ((int)blockIdx.x - 88) * NWAVES + wave, (M / 64) * 31, (G - 88) * NWAVES, lane);
        } else {
            const int pm_ = (int)blockIdx.x / 11;
            ln_rows_range<1, 1>(ZB, XB, nullptr, STATS, IN(35), IN(36), 64 * pm_ + wave, 64 * pm_ + 64, NWAVES, lane);
            asm volatile("s_waitcnt vmcnt(0)" ::: "memory");
            __syncthreads();
            if (threadIdx.x == 0) { __builtin_amdgcn_fence(__ATOMIC_ACQUIRE, "agent"); asm volatile("s_waitcnt vmcnt(0)" ::: "memory"); }
            __syncthreads();
            halo_gemm_unit((int)blockIdx.x, tid, lane, wave, lds3, XB, Wup1, HALO);
        }
    }
    GRID_BAR();
    {
        PHASE_IDS();
        { pg8::Gemm g_{XB, Wup1, M, 2 * DFF, 1024, DM, 1024, 128, 256, 128, 256, 0, 1}; pg8::StaticOrder S_; S_.init(M, 2 * DFF, G, (int)blockIdx.x);
          pg8::EpiConvAct E_{ACT, HALO, IN(38), IN(39), DFF, SEQ}; pg8::gemm_phase<pg8::EpiConvAct, pg8::StaticOrder, true, true>(lds3, g_, S_, E_); }
    }
    GRID_BAR();
    {
        PHASE_IDS();
    GEMM_PHASE(EpiResidLN, ACT, DFF, Wdn1, DFF, 1024, DFF, ZB, XB, STATS, IN(35), IN(36), ALPHA, 0);
    }
    GRID_BAR();
    {
        PHASE_IDS();
    ln_rows<2>(XB, nullptr, out, STATS, IN(41), IN(42), gw, NGW, lane);
    #if defined(PROBE_STAMPS)
    __syncthreads();
    if (blockIdx.x == 0 && threadIdx.x == 0) {
        MISC[16 + 22] = (unsigned)__builtin_amdgcn_s_memrealtime();
#if defined(PROBE_GLOBAL)
#ifndef PROBE_GIDX
#define PROBE_GIDX 0
#endif
        const unsigned d1 = __hip_atomic_load(ctl + 2048 + PROBE_GIDX, __ATOMIC_RELAXED, __HIP_MEMORY_SCOPE_AGENT);
#elif defined(PROBE_ACC)
        const unsigned d1 = MISC[16 + PROBE_ACC];
#else
        const unsigned d1 = MISC[16 + PROBE_T1_HI] - MISC[16 + PROBE_T1_LO];
#endif
        const unsigned long long spin = 100ull * d1;
        const unsigned long long t0 = __builtin_amdgcn_s_memrealtime();
        while (__builtin_amdgcn_s_memrealtime() - t0 < spin) __builtin_amdgcn_s_sleep(8);
    }
#endif
}
}

extern "C" void kernel_launch(void* const* d_in, const int* in_sizes, int n_in, void* d_out, int out_size, void* d_ws, size_t ws_size, hipStream_t stream) {
    static int grid = 0;
    if (grid == 0) {
        if (n_in != 43 || ws_size < WS_NEED || out_size != M * DM) { fprintf(stderr, "kernel_launch: unexpected n_in %d / ws %zu / out %d\n", n_in, ws_size, out_size); grid = -1; return; }
        int dev = 0, cus = 0, per_cu = 0;
        if (hipGetDevice(&dev) != hipSuccess || hipDeviceGetAttribute(&cus, hipDeviceAttributeMultiprocessorCount, dev) != hipSuccess) { grid = -1; return; }
        if (hipFuncSetAttribute((const void*)fwd_mega, hipFuncAttributeMaxDynamicSharedMemorySize, LDS_BYTES) != hipSuccess) { fprintf(stderr, "kernel_launch: hipFuncSetAttribute failed\n"); grid = -1; return; }
        if (hipOccupancyMaxActiveBlocksPerMultiprocessor(&per_cu, (const void*)fwd_mega, NWAVES * 64, LDS_BYTES) != hipSuccess || per_cu < 1) fprintf(stderr, "kernel_launch: occupancy query reports %d\n", per_cu);
        (void)hipGetLastError();
        grid = cus;
    }
    if (grid < 0) return;
    (void)hipMemsetAsync((char*)d_ws + WS_CTL, 0, CTL_ZERO_BYTES, stream);
    Args a{};
    for (int i = 0; i < 43; ++i) a.in[i] = (const float*)d_in[i];
    a.out = (float*)d_out; a.ws = (unsigned char*)d_ws;
    hipLaunchKernelGGL(fwd_mega, dim3(grid), dim3(NWAVES * 64), LDS_BYTES, stream, a);
}
```

```cpp
#include <hip/hip_runtime.h>
#include <cstdio>
#include <cstdint>
#include <cmath>
namespace pg8 {
#define PG8_LAS __attribute__((address_space(3)))
typedef unsigned short bf16_t;
typedef short bf16x8 __attribute__((ext_vector_type(8)));
typedef float f32x4 __attribute__((ext_vector_type(4)));
typedef unsigned u32x4 __attribute__((ext_vector_type(4)));
constexpr int BM = 256, BK = 64, HALF = 128, HTB = HALF * BK * 2  , STAGE_BYTES = 8 * HTB, NXCD = 8, WGM = 8;

__host__ __device__ __forceinline__ int lds_byte(int r, int c) { const int st = (r >> 4) * 2 + (c >> 5), rr = r & 15, cc = c & 31, ob = rr * 64 + cc * 2; return st * 1024 + (ob ^ (((ob >> 9) & 1) << 5)); }
__host__ __device__ __forceinline__ void stage_rc(int b, int& R, int& C) { const int st = b / 1024, sb = b % 1024, swz = sb ^ (((sb >> 9) & 1) << 5); R = (st >> 1) * 16 + swz / 64; C = (st & 1) * 32 + (swz % 64) / 2; }
__host__ __device__ __forceinline__ int perm32(int rho) { const int n = rho >> 4, i = rho & 15; return 8 * (i >> 2) + 4 * n + (i & 3); }

struct Unit { int pm, pn; };
struct Gemm { const bf16_t* A; const bf16_t* Bt; int M, N, K, lda, ldb; int hrA = 128, trA = 256, hrB = 128, trB = 256, gatherA = 0, permA = 0; };

struct StaticOrder {
    int nM, nN, nwg, G, c;
    __host__ __device__ void init(int M, int N, int G_, int c_) { nM = M / BM; nN = N / BM; nwg = nM * nN; G = G_; c = c_; }
    __host__ __device__ bool next(int i, Unit& u) const {
        const long L = (long)i * G + c; if (L >= nwg) return false;
        int wgid = (int)L; { const int q = nwg / NXCD, r = nwg % NXCD, xcd = wgid % NXCD, off = wgid / NXCD; wgid = (xcd < r ? xcd * (q + 1) : r * (q + 1) + (xcd - r) * q) + off; }
        const int nig = WGM * nN, gid = wgid / nig, fm = gid * WGM, gsz = (nM - fm) < WGM ? (nM - fm) : WGM;
        u.pm = fm + ((wgid % nig) % gsz); u.pn = (wgid % nig) / gsz; return true;
    }
    __device__ __forceinline__ void a_ready(const Unit&) const {}
    __device__ __forceinline__ void done(const Unit&) const {}
};


__device__ __forceinline__ unsigned cvt_pk_bf16(float lo, float hi) { unsigned r; asm volatile("v_cvt_pk_bf16_f32 %0, %1, %2" : "=v"(r) : "v"(lo), "v"(hi)); return r; }
struct EpiBf16S {
    static constexpr bool PERM = true, AFTER_DRAIN = false;
    bf16_t* O; const float* rowscale; int ldc; int rs_stride;
    __device__ __forceinline__ void operator()(const f32x4 (&acc)[2][2][4][2], const Unit& u, int wr, int wc, int fr, int fq) const {
        const int row0 = u.pm * BM + wr * 64 + fr, col0 = u.pn * BM + wc * 32 + 8 * fq;
#pragma unroll
        for (int ai = 0; ai < 2; ++ai)
#pragma unroll
            for (int m = 0; m < 4; ++m) { const int row = row0 + ai * HALF + m * 16; const float sc = rowscale ? rowscale[(size_t)row * rs_stride] : 1.f;
                bf16_t* rowp = O + (size_t)row * ldc + col0;
#pragma unroll
                for (int bj = 0; bj < 2; ++bj) { const f32x4 v0 = acc[ai][bj][m][0] * sc, v1 = acc[ai][bj][m][1] * sc;
                    u32x4 w; w.x = cvt_pk_bf16(v0[0], v0[1]); w.y = cvt_pk_bf16(v0[2], v0[3]); w.z = cvt_pk_bf16(v1[0], v1[1]); w.w = cvt_pk_bf16(v1[2], v1[3]);
                    *(u32x4*)(rowp + bj * HALF) = w; } }
    }
};
struct EpiResid {
    static constexpr bool PERM = true, AFTER_DRAIN = false;
    const float* hin; bf16_t* hout; float alpha; int pad;
    __device__ __forceinline__ void operator()(const f32x4 (&acc)[2][2][4][2], const Unit& u, int wr, int wc, int fr, int fq) const {
        const int row0 = u.pm * BM + wr * 64 + fr, col0 = u.pn * BM + wc * 32 + 8 * fq;
#pragma unroll
        for (int ai = 0; ai < 2; ++ai)
#pragma unroll
            for (int m = 0; m < 4; ++m) { const size_t off = (size_t)(row0 + ai * HALF + m * 16) * 1024 + col0;
#pragma unroll
                for (int bj = 0; bj < 2; ++bj) { const size_t i = off + bj * HALF;
                    const f32x4 h0 = *(const f32x4*)(hin + i), h1 = *(const f32x4*)(hin + i + 4);
                    const f32x4 o0 = h0 * alpha + acc[ai][bj][m][0], o1 = h1 * alpha + acc[ai][bj][m][1];
                    u32x4 w; w.x = cvt_pk_bf16(o0[0], o0[1]); w.y = cvt_pk_bf16(o0[2], o0[3]); w.z = cvt_pk_bf16(o1[0], o1[1]); w.w = cvt_pk_bf16(o1[2], o1[3]);
                    *(u32x4*)(hout + i) = w; } }
    }
};

struct EpiResidLN {
    static constexpr bool PERM = true, AFTER_DRAIN = false;
    const bf16_t* hin; bf16_t* hout; const float* stats; const float* g; const float* b; float alpha; int pad;
    __device__ __forceinline__ void operator()(const f32x4 (&acc)[2][2][4][2], const Unit& u, int wr, int wc, int fr, int fq) const {
        const int row0 = u.pm * BM + wr * 64 + fr, col0 = u.pn * BM + wc * 32 + 8 * fq;
        f32x4 gg[2][2], bb[2][2];
#pragma unroll
        for (int bj = 0; bj < 2; ++bj)
#pragma unroll
            for (int n = 0; n < 2; ++n) { gg[bj][n] = *(const f32x4*)(g + col0 + bj * HALF + n * 4) * alpha; bb[bj][n] = *(const f32x4*)(b + col0 + bj * HALF + n * 4) * alpha; }
#pragma unroll
        for (int ai = 0; ai < 2; ++ai)
#pragma unroll
            for (int m = 0; m < 4; ++m) { const int row = row0 + ai * HALF + m * 16; const size_t off = (size_t)row * 1024 + col0;
                const float mu = stats[2 * row], rs = stats[2 * row + 1];
#pragma unroll
                for (int bj = 0; bj < 2; ++bj) { const size_t i = off + bj * HALF; const u32x4 pw = *(const u32x4*)(hin + i);
                    f32x4 p0, p1; p0[0] = __builtin_bit_cast(float, pw.x << 16); p0[1] = __builtin_bit_cast(float, pw.x & 0xffff0000u); p0[2] = __builtin_bit_cast(float, pw.y << 16); p0[3] = __builtin_bit_cast(float, pw.y & 0xffff0000u);
                    p1[0] = __builtin_bit_cast(float, pw.z << 16); p1[1] = __builtin_bit_cast(float, pw.z & 0xffff0000u); p1[2] = __builtin_bit_cast(float, pw.w << 16); p1[3] = __builtin_bit_cast(float, pw.w & 0xffff0000u);
                    const f32x4 o0 = (p0 - mu) * rs * gg[bj][0] + bb[bj][0] + acc[ai][bj][m][0], o1 = (p1 - mu) * rs * gg[bj][1] + bb[bj][1] + acc[ai][bj][m][1];
                    u32x4 w; w.x = cvt_pk_bf16(o0[0], o0[1]); w.y = cvt_pk_bf16(o0[2], o0[3]); w.z = cvt_pk_bf16(o1[0], o1[1]); w.w = cvt_pk_bf16(o1[2], o1[3]);
                    *(u32x4*)(hout + i) = w; } }
    }
};

template <int CTRL> __device__ __forceinline__ float pg_dpp(float x) { return __builtin_bit_cast(float, __builtin_amdgcn_update_dpp(0, __builtin_bit_cast(int, x), CTRL, 0xF, 0xF, true)); }
struct EpiConvAct {
    static constexpr bool PERM = true, AFTER_DRAIN = false;
    bf16_t* act; const bf16_t* halo; const float* cw; const float* cb; int dff; int seq;
    template <int CTRL> static __device__ __forceinline__ float dpp_old(float old, float x) { return __builtin_bit_cast(float, __builtin_amdgcn_update_dpp(__builtin_bit_cast(int, old), __builtin_bit_cast(int, x), CTRL, 0xF, 0xF, false)); }
    __device__ __forceinline__ void operator()(const f32x4 (&acc)[2][2][4][2], const Unit& u, int wr, int wc, int fr, int fq) const {
        typedef unsigned u32x2e __attribute__((ext_vector_type(2)));
        typedef float f32x2e __attribute__((ext_vector_type(2)));
        const int ch0 = u.pn * 128 + wc * 32 + 8 * fq;
        f32x4 w0[2], w1[2], w2[2], bb[2];
#pragma unroll
        for (int n = 0; n < 2; ++n) { w0[n] = *(const f32x4*)(cw + ch0 + 4 * n); w1[n] = *(const f32x4*)(cw + dff + ch0 + 4 * n); w2[n] = *(const f32x4*)(cw + 2 * dff + ch0 + 4 * n); bb[n] = *(const f32x4*)(cb + ch0 + 4 * n); }
#pragma unroll
        for (int ai = 0; ai < 2; ++ai) {
            const int rb64 = u.pm * BM + ai * HALF + wr * 64;
            f32x4 H2[2], H3[2];
#pragma unroll
            for (int n = 0; n < 2; ++n) { H2[n] = (f32x4){0.f, 0.f, 0.f, 0.f}; H3[n] = (f32x4){0.f, 0.f, 0.f, 0.f}; }
            if ((rb64 & (seq - 1)) != 0 && fr == 0) { const bf16_t* hp = halo + (size_t)(2 * (rb64 / 64 - 1)) * dff + ch0; const u32x4 h2 = *(const u32x4*)hp, h3 = *(const u32x4*)(hp + dff);
                const unsigned a2[4] = {h2.x, h2.y, h2.z, h2.w}, a3[4] = {h3.x, h3.y, h3.z, h3.w};
#pragma unroll
                for (int q = 0; q < 4; ++q) { H2[q >> 1][2 * (q & 1)] = __builtin_bit_cast(float, a2[q] << 16); H2[q >> 1][2 * (q & 1) + 1] = __builtin_bit_cast(float, a2[q] & 0xffff0000u);
                                              H3[q >> 1][2 * (q & 1)] = __builtin_bit_cast(float, a3[q] << 16); H3[q >> 1][2 * (q & 1) + 1] = __builtin_bit_cast(float, a3[q] & 0xffff0000u); } }
            f32x4 S2[2], S3[2];
#pragma unroll
            for (int n = 0; n < 2; ++n)
#pragma unroll
                for (int e = 0; e < 4; ++e) { S2[n][e] = dpp_old<0x111>(H2[n][e], acc[ai][0][2][n][e]); S3[n][e] = dpp_old<0x111>(H3[n][e], acc[ai][0][3][n][e]); }
#pragma unroll
            for (int m = 0; m < 4; ++m) {
                u32x4 w;
#pragma unroll
                for (int n = 0; n < 2; ++n) {
                    const f32x4 G0 = acc[ai][0][0][n], G1 = acc[ai][0][1][n], G2 = acc[ai][0][2][n];
                    const f32x4 Gv = acc[ai][0][m][n], Uv = acc[ai][1][m][n];
                    const f32x4 g1 = (m == 0) ? S3[n] : (m == 1) ? G0 : (m == 2) ? G1 : G2, g2 = (m == 0) ? S2[n] : (m == 1) ? S3[n] : (m == 2) ? G0 : G1;
                    f32x2e oh[2];
#pragma unroll
                    for (int hq = 0; hq < 2; ++hq) {
                        const f32x2e g2p = hq ? g2.hi : g2.lo, g1p = hq ? g1.hi : g1.lo, Gp = hq ? Gv.hi : Gv.lo, Up = hq ? Uv.hi : Uv.lo;
                        const f32x2e w0p = hq ? w0[n].hi : w0[n].lo, w1p = hq ? w1[n].hi : w1[n].lo, w2p = hq ? w2[n].hi : w2[n].lo, bp = hq ? bb[n].hi : bb[n].lo;
                        const f32x2e y = __builtin_elementwise_fma(w0p, g2p, __builtin_elementwise_fma(w1p, g1p, __builtin_elementwise_fma(w2p, Gp, bp)));
                        const f32x2e t = y * -1.4426950408889634f;
                        f32x2e den; den.x = __builtin_amdgcn_exp2f(t.x); den.y = __builtin_amdgcn_exp2f(t.y); den = den + 1.f;
                        f32x2e r; r.x = __builtin_amdgcn_rcpf(den.x); r.y = __builtin_amdgcn_rcpf(den.y);
                        oh[hq] = y * r * Up;
                    }
                    if (n == 0) { w.x = cvt_pk_bf16(oh[0].x, oh[0].y); w.y = cvt_pk_bf16(oh[1].x, oh[1].y); } else { w.z = cvt_pk_bf16(oh[0].x, oh[0].y); w.w = cvt_pk_bf16(oh[1].x, oh[1].y); }
                }
                *(u32x4*)(act + (size_t)(rb64 + 4 * fr + m) * dff + ch0) = w;
            }
        }
    }
};

template <class Epi, class Sched, bool ALIGN_EPI = false, bool SP2 = false>
__device__ __forceinline__ void gemm_phase(PG8_LAS unsigned char* lds, const Gemm g, const Sched& S, const Epi& E) {
    int tid = threadIdx.x; asm volatile("" : "+v"(tid));
    const int wid = __builtin_amdgcn_readfirstlane(tid >> 6), lane = tid & 63, wr = wid >> 2, wc = wid & 3, fr = lane & 15, fq = lane >> 4;
    const int K = g.K, nt = K / BK;
    unsigned voffA[2], voffB[2];
#pragma unroll
    for (int i = 0; i < 2; ++i) { int R, C; stage_rc(tid * 16 + i * 8192, R, C); const int Rb = Epi::PERM ? ((R & ~31) + perm32(R & 31)) : R;
        const int Ra = g.gatherA ? (64 * (R >> 1) + 62 + (R & 1)) : g.permA ? ((R & ~63) | ((R & 15) << 2) | ((R >> 4) & 3)) : R;
        voffA[i] = (unsigned)(Ra * g.lda + C) * 2u; voffB[i] = (unsigned)(Rb * g.ldb + C) * 2u; }
    const size_t kstep = (size_t)(BK * 2);
    const size_t hstepA = (size_t)g.hrA * g.lda * 2, hstepB = (size_t)g.hrB * g.ldb * 2;
    const size_t tstepA = (size_t)g.trA * g.lda * 2, tstepB = (size_t)g.trB * g.ldb * 2;
    const unsigned ldsw = (unsigned)wid * 1024u;
    const int aoff = lds_byte(wr * 64 + fr, fq * 8), boff = lds_byte(wc * 32 + fr, fq * 8);
#define PG8_SA(b, h) (((b) * 2 + (h)) * HTB)
#define PG8_SB(b, h) ((4 + (b) * 2 + (h)) * HTB)
#define PG8_STAGE(bufoff, gbase, voff) do { _Pragma("unroll") for (int _i = 0; _i < 2; ++_i) \
        __builtin_amdgcn_global_load_lds((const unsigned*)((const char*)(gbase) + (voff)[_i]), (PG8_LAS unsigned*)(lds + (bufoff) + ldsw + _i * 8192), 16, 0, 0); } while (0)
#define PG8_LDA(dst, b, h) do { _Pragma("unroll") for (int m = 0; m < 4; ++m) _Pragma("unroll") for (int k = 0; k < 2; ++k) dst[m][k] = *(const PG8_LAS bf16x8*)(lds + PG8_SA(b, h) + aoff + m * 2048 + k * 1024); } while (0)
#define PG8_LDB(dst, b, h) do { _Pragma("unroll") for (int n = 0; n < 2; ++n) _Pragma("unroll") for (int k = 0; k < 2; ++k) dst[n][k] = *(const PG8_LAS bf16x8*)(lds + PG8_SB(b, h) + boff + n * 2048 + k * 1024); } while (0)
#define PG8_MMA(ai, bj, At, Bt) do { __builtin_amdgcn_s_setprio(1); _Pragma("unroll") for (int m = 0; m < 4; ++m) _Pragma("unroll") for (int n = 0; n < 2; ++n) _Pragma("unroll") for (int k = 0; k < 2; ++k) \
        acc[ai][bj][m][n] = __builtin_amdgcn_mfma_f32_16x16x32_bf16(Bt[n][k], At[m][k], acc[ai][bj][m][n], 0, 0, 0); __builtin_amdgcn_s_setprio(0); } while (0)
#define PG8_WAIT_V(n) asm volatile("s_waitcnt vmcnt(" #n ")" ::: "memory")
#define PG8_WAIT_L(n) asm volatile("s_waitcnt lgkmcnt(" #n ")" ::: "memory")
#define PG8_BAR __builtin_amdgcn_s_barrier()
#define PG8_SCHED __builtin_amdgcn_sched_barrier(0)
    Unit cur, nxt; int ui = 0;
    if (!S.next(0, cur)) return;
    f32x4 acc[2][2][4][2];
#pragma unroll
    for (int a = 0; a < 2; ++a)
#pragma unroll
        for (int b = 0; b < 2; ++b)
#pragma unroll
            for (int m = 0; m < 4; ++m)
#pragma unroll
                for (int n = 0; n < 2; ++n) acc[a][b][m][n] = (f32x4){0.f, 0.f, 0.f, 0.f};
    bf16x8 At[4][2], B0[2][2], B1[2][2];
    const char* cA = (const char*)g.A + (size_t)cur.pm * tstepA; const char* cB = (const char*)g.Bt + (size_t)cur.pn * tstepB;
    S.a_ready(cur);
    if constexpr (SP2) {
        PG8_STAGE(PG8_SB(0, 0), cB, voffB); PG8_STAGE(PG8_SB(0, 1), cB + hstepB, voffB); PG8_STAGE(PG8_SA(0, 0), cA, voffA); PG8_STAGE(PG8_SA(0, 1), cA + hstepA, voffA);
        if (wr == 1) PG8_BAR;
        PG8_WAIT_V(2); PG8_BAR;
        PG8_STAGE(PG8_SB(1, 0), cB + kstep, voffB); PG8_STAGE(PG8_SA(1, 0), cA + kstep, voffA); PG8_STAGE(PG8_SB(1, 1), cB + hstepB + kstep, voffB);
        PG8_WAIT_V(6); PG8_BAR;
    } else {
        PG8_STAGE(PG8_SB(0, 0), cB, voffB); PG8_STAGE(PG8_SA(0, 0), cA, voffA); PG8_STAGE(PG8_SB(0, 1), cB + hstepB, voffB); PG8_STAGE(PG8_SA(0, 1), cA + hstepA, voffA);
        if (wr == 1) PG8_BAR;
        PG8_WAIT_V(4); PG8_BAR;
        PG8_STAGE(PG8_SB(1, 0), cB + kstep, voffB); PG8_STAGE(PG8_SA(1, 0), cA + kstep, voffA); PG8_STAGE(PG8_SB(1, 1), cB + hstepB + kstep, voffB);
        PG8_WAIT_V(6); PG8_BAR;
    }
    for (;;) {
        const bool has_next = S.next(ui + 1, nxt);
        const char* nA = has_next ? (const char*)g.A + (size_t)nxt.pm * tstepA : cA; const char* nB = has_next ? (const char*)g.Bt + (size_t)nxt.pn * tstepB : cB;
        for (int t = 0; t < nt; t += 2) {
            const bool last = (t == nt - 2);
            const char* a1 = cA + (size_t)(t + 1) * kstep;
            const char* a2 = last ? nA : cA + (size_t)(t + 2) * kstep; const char* b2 = last ? nB : cB + (size_t)(t + 2) * kstep;
            const char* a3 = a2 + kstep; const char* b3 = b2 + kstep;
            if (last && has_next) S.a_ready(nxt);
            if constexpr (SP2) {
            PG8_LDB(B0, 0, 0); PG8_LDB(B1, 0, 1); PG8_SCHED; PG8_LDA(At, 0, 0); PG8_STAGE(PG8_SA(1, 1), a1 + hstepA, voffA);
            PG8_WAIT_V(8); PG8_WAIT_L(0); PG8_BAR; PG8_MMA(0, 0, At, B0); PG8_MMA(0, 1, At, B1); PG8_BAR; PG8_SCHED;
            PG8_LDA(At, 0, 1); PG8_STAGE(PG8_SB(0, 0), b2, voffB); PG8_STAGE(PG8_SB(0, 1), b2 + hstepB, voffB); PG8_STAGE(PG8_SA(0, 0), a2, voffA);
            PG8_WAIT_V(8); PG8_WAIT_L(0); PG8_BAR; PG8_MMA(1, 0, At, B0); PG8_MMA(1, 1, At, B1); PG8_BAR; PG8_SCHED;
            PG8_LDB(B0, 1, 0); PG8_LDB(B1, 1, 1); PG8_SCHED; PG8_LDA(At, 1, 0); PG8_STAGE(PG8_SA(0, 1), a2 + hstepA, voffA);
            PG8_WAIT_V(8); PG8_WAIT_L(0); PG8_BAR; PG8_MMA(0, 0, At, B0); PG8_MMA(0, 1, At, B1); PG8_BAR; PG8_SCHED;
            PG8_LDA(At, 1, 1); PG8_STAGE(PG8_SB(1, 0), b3, voffB); PG8_STAGE(PG8_SB(1, 1), b3 + hstepB, voffB); PG8_STAGE(PG8_SA(1, 0), a3, voffA);
            PG8_WAIT_V(8); PG8_WAIT_L(0); PG8_BAR; PG8_MMA(1, 0, At, B0); PG8_MMA(1, 1, At, B1); PG8_BAR; PG8_SCHED;
            } else {
            PG8_LDB(B0, 0, 0); PG8_SCHED; PG8_LDA(At, 0, 0); PG8_STAGE(PG8_SA(1, 1), a1 + hstepA, voffA);
            PG8_WAIT_L(8); PG8_BAR; PG8_WAIT_L(0); PG8_MMA(0, 0, At, B0); PG8_BAR; PG8_SCHED;
            PG8_LDB(B1, 0, 1); PG8_STAGE(PG8_SB(0, 0), b2, voffB);
            PG8_BAR; PG8_WAIT_L(0); PG8_MMA(0, 1, At, B1); PG8_BAR;
            PG8_LDA(At, 0, 1); PG8_STAGE(PG8_SA(0, 0), a2, voffA);
            PG8_BAR; PG8_WAIT_L(0); PG8_MMA(1, 0, At, B0); PG8_BAR; PG8_SCHED;
            PG8_STAGE(PG8_SB(0, 1), b2 + hstepB, voffB);
            PG8_WAIT_V(6); PG8_BAR; PG8_MMA(1, 1, At, B1); PG8_BAR;
            PG8_LDB(B0, 1, 0); PG8_SCHED; PG8_LDA(At, 1, 0); PG8_STAGE(PG8_SA(0, 1), a2 + hstepA, voffA);
            PG8_WAIT_L(8); PG8_BAR; PG8_WAIT_L(0); PG8_MMA(0, 0, At, B0); PG8_BAR; PG8_SCHED;
            PG8_LDB(B1, 1, 1); PG8_STAGE(PG8_SB(1, 0), b3, voffB);
            PG8_BAR; PG8_WAIT_L(0); PG8_MMA(0, 1, At, B1); PG8_BAR;
            PG8_LDA(At, 1, 1); PG8_STAGE(PG8_SA(1, 0), a3, voffA);
            PG8_BAR; PG8_WAIT_L(0); PG8_MMA(1, 0, At, B0); PG8_BAR; PG8_SCHED;
            PG8_STAGE(PG8_SB(1, 1), b3 + hstepB, voffB);
            PG8_WAIT_V(6); PG8_BAR; PG8_MMA(1, 1, At, B1); PG8_BAR;
            }
        }
        if constexpr (ALIGN_EPI) { if (wr == 0) PG8_BAR; }
        if constexpr (!Epi::AFTER_DRAIN) { E(acc, cur, wr, wc, fr, fq); S.done(cur); }
        if (!has_next) break;
#pragma unroll
        for (int a = 0; a < 2; ++a)
#pragma unroll
            for (int b = 0; b < 2; ++b)
#pragma unroll
                for (int m = 0; m < 4; ++m)
#pragma unroll
                    for (int n = 0; n < 2; ++n) acc[a][b][m][n] = (f32x4){0.f, 0.f, 0.f, 0.f};
        cur = nxt; cA = nA; cB = nB; ++ui;
        if constexpr (ALIGN_EPI) { if (wr == 1) PG8_BAR; }
    }
    PG8_WAIT_V(0);
    if constexpr (!ALIGN_EPI) { if (wr == 0) PG8_BAR; }
    PG8_BAR;
    if constexpr (Epi::AFTER_DRAIN) { E.fused(acc, cur, wr, wc, fr, fq, lds, wid, lane); S.done(cur); }
#undef PG8_SA
#undef PG8_SB
#undef PG8_STAGE
#undef PG8_LDA
#undef PG8_LDB
#undef PG8_MMA
#undef PG8_WAIT_V
#undef PG8_WAIT_L
#undef PG8_BAR
#undef PG8_SCHED
}
}
#define GAS __attribute__((address_space(1)))
#define LAS __attribute__((address_space(3)))
typedef unsigned short bf16;
typedef unsigned v4u __attribute__((ext_vector_type(4)));
typedef float f32x4 __attribute__((ext_vector_type(4)));
typedef short bf16x8 __attribute__((ext_vector_type(8)));
typedef GAS unsigned gu32;
typedef GAS unsigned long long gu64;
#define RLX_AGENT __ATOMIC_RELAXED, __HIP_MEMORY_SCOPE_AGENT
#define LDS_WAIT() asm volatile("s_waitcnt lgkmcnt(0)" ::: "memory")
#define VM_WAIT() asm volatile("s_waitcnt vmcnt(0)" ::: "memory")
__device__ __forceinline__ unsigned long long rt() { return __builtin_amdgcn_s_memrealtime(); }
__device__ __forceinline__ unsigned f2bf(float f) { unsigned u = __builtin_bit_cast(unsigned, f); return (u + 0x7fffu + ((u >> 16) & 1u)) >> 16; }
__device__ __forceinline__ unsigned pk2(float lo, float hi) { return f2bf(lo) | (f2bf(hi) << 16); }

#define XB_TMO      128
#define XB_XCNT(j)  (256  + 64 * (j))
#define XB_XSUB(j)  (1280 + 64 * (j))
#define XB_XGEN(j)  (2304 + 64 * (j))
#define XB_TOP      3328
#define XB_TOPGEN   3392
#define XCD_BAR_WORDS 3456
#define XB_SPIN_CAP (1u << 18)

__device__ __forceinline__ unsigned xb_ld(unsigned* p)              { return __hip_atomic_load(p, __ATOMIC_RELAXED, __HIP_MEMORY_SCOPE_AGENT); }
__device__ __forceinline__ unsigned xb_add(unsigned* p, unsigned v) { return __hip_atomic_fetch_add(p, v, __ATOMIC_RELAXED, __HIP_MEMORY_SCOPE_AGENT); }
__device__ __forceinline__ unsigned xb_xcc_id() { return (unsigned)__builtin_amdgcn_s_getreg((3 << 11) | 20) & 0xFu; }
#define XB_SPIN(cond, bar) do { unsigned _sp = 0; while (cond) { __builtin_amdgcn_s_sleep(1); \
    if ((++_sp & 255u) == 0u) { if (xb_ld(&(bar)[XB_TMO])) break; if (_sp > XB_SPIN_CAP) { atomicAdd(&(bar)[XB_TMO], 1u); break; } } } } while (0)

struct XcdBarrier {
    unsigned* bar; unsigned x;
    volatile LAS unsigned* st;
};

__device__ __forceinline__ XcdBarrier xcd_barrier_post(unsigned* bar, volatile LAS unsigned* st) {
    XcdBarrier b; b.bar = bar; b.x = xb_xcc_id(); b.st = st;
    if (threadIdx.x == 0) (void)xb_add(&bar[XB_XCNT(b.x)], 1u);
    return b;
}
__device__ __forceinline__ void xcd_barrier_complete(unsigned* bar, unsigned x, unsigned& nloc, unsigned& nx) {
    const unsigned G = gridDim.x * gridDim.y * gridDim.z;
    unsigned sum, cnt, mine, sp = 0u;
    for (;;) {
        sum = 0u; cnt = 0u; mine = 0u;
#pragma unroll
        for (unsigned j = 0; j < 16; ++j) { const unsigned c = xb_ld(&bar[XB_XCNT(j)]); sum += c; cnt += (c > 0u) ? 1u : 0u; mine = (j == x) ? c : mine; }
        if (sum == G) break;
        __builtin_amdgcn_s_sleep(1);
        if ((++sp & 255u) == 0u) { if (xb_ld(&bar[XB_TMO])) break; if (sp > XB_SPIN_CAP) { atomicAdd(&bar[XB_TMO], 1u); break; } }
    }
    nloc = mine > 0u ? mine : 1u; nx = cnt > 0u ? cnt : 1u;
}

__device__ __forceinline__ void xcd_barrier(const XcdBarrier& b) {
    asm volatile("s_waitcnt vmcnt(0)" ::: "memory");
    __syncthreads();
    if (threadIdx.x == 0) {
        unsigned* bar = b.bar;
        __builtin_amdgcn_s_waitcnt(0);
        unsigned nloc = b.st[0], nx = b.st[1];
        if (nloc == 0u) { xcd_barrier_complete(bar, b.x, nloc, nx); b.st[0] = nloc; b.st[1] = nx; }
        const unsigned old = xb_add(&bar[XB_XSUB(b.x)], 1u);
        const unsigned gen = old / nloc;
        if (old + 1u == (gen + 1u) * nloc) {
            __builtin_amdgcn_fence(__ATOMIC_RELEASE, "agent");
            asm volatile("s_waitcnt vmcnt(0)" ::: "memory");
            const unsigned og = xb_add(&bar[XB_TOP], 1u);
            const unsigned tg = og / nx;
            if (og + 1u == (tg + 1u) * nx) xb_add(&bar[XB_TOPGEN], 1u);
            else XB_SPIN(xb_ld(&bar[XB_TOPGEN]) == tg, bar);
            __builtin_amdgcn_fence(__ATOMIC_ACQUIRE, "agent");
            xb_add(&bar[XB_XGEN(b.x)], 1u);
            asm volatile("s_waitcnt vmcnt(0)" ::: "memory");
        } else {
            XB_SPIN(xb_ld(&bar[XB_XGEN(b.x)]) == gen, bar);
            __builtin_amdgcn_fence(__ATOMIC_ACQUIRE, "agent");
            asm volatile("s_waitcnt vmcnt(0)" ::: "memory");
        }
    }
    __syncthreads();
}
constexpr int NWAVES = 8;
constexpr int BATCH = 16, SEQ = 2048, DM = 1024, M = BATCH * SEQ;
constexpr int L0P = 3584;
constexpr int L1P = 2048;
constexpr int DFF = 2816;
constexpr float ALPHA = 1.4142135623730951f;
typedef unsigned short bf16_t;
typedef float f32x16 __attribute__((ext_vector_type(16)));

constexpr size_t MiB = 1u << 20;
constexpr size_t WS_CTL = 0, CTL_ZERO_BYTES = 1 * MiB;
constexpr int CW_BAR = 4096;
constexpr size_t WS_W0IN = 2 * MiB, WS_W0OUT = 9 * MiB, WS_WUP0 = 11 * MiB, WS_WDN0 = 22 * MiB, WS_W1IN = 28 * MiB, WS_WUQ = 32 * MiB, WS_WUKV = 33 * MiB,
                 WS_W1OUT = 34 * MiB, WS_WUP1 = 36 * MiB, WS_WDN1 = 47 * MiB;
constexpr size_t WS_XB = 56 * MiB, WS_YMIX = 120 * MiB, WS_BIG = 184 * MiB;
constexpr size_t WS_G = 408 * MiB, WS_BONUS = 440 * MiB, WS_DT = 441 * MiB, WS_XST = 442 * MiB, WS_BT = 474 * MiB, WS_ASUM = 490 * MiB;
constexpr size_t WS_SLOC = 120 * MiB;
constexpr size_t WS_W2T = 53 * MiB, WS_A2T = 53 * MiB + 256 * 1024, WS_G2T = 53 * MiB + 512 * 1024;
constexpr size_t WS_GU = 120 * MiB;
constexpr size_t WS_PROJ1 = 184 * MiB, WS_QM = 312 * MiB, WS_KVM = 360 * MiB, WS_KPE = 424 * MiB, WS_RS = 426 * MiB;
constexpr size_t WS_CSTAB = 492 * MiB;
constexpr size_t WS_VTS = 428 * MiB, WS_VTM = 460 * MiB;
constexpr size_t WS_NEED = 497 * MiB;

constexpr int RING_BYTES = 131072;
constexpr int LDSCTL_OFF = 146432, MISC_OFF = LDSCTL_OFF + 320;
constexpr int LDS_BYTES = 147456;

__device__ __forceinline__ float bf2f(bf16_t b) { return __builtin_bit_cast(float, (unsigned)b << 16); }
__device__ __forceinline__ float sigmoidf_(float x) { return 1.f / (1.f + expf(-x)); }
__device__ __forceinline__ float softplusf_(float x) { return fmaxf(x, 0.f) + log1pf(expf(-fabsf(x))); }
__device__ __forceinline__ float siluf_(float x) { return x / (1.f + expf(-x)); }
__device__ __forceinline__ float wave_sum(float v) {
#pragma unroll
    for (int o = 1; o < 64; o <<= 1) v += __shfl_xor(v, o);
    return v;
}
#define WSYNC() asm volatile("s_waitcnt lgkmcnt(0)" ::: "memory")
typedef float f32x2_t __attribute__((ext_vector_type(2)));
typedef __bf16 bf16x2_t __attribute__((ext_vector_type(2)));
typedef unsigned u32x2 __attribute__((ext_vector_type(2)));
__device__ __forceinline__ unsigned cvtpk(float lo, float hi) { f32x2_t v = {lo, hi}; bf16x2_t b = __builtin_convertvector(v, bf16x2_t); return __builtin_bit_cast(unsigned, b); }
__device__ __forceinline__ float bflo(unsigned u) { return __builtin_bit_cast(float, u << 16); }
__device__ __forceinline__ float bfhi(unsigned u) { return __builtin_bit_cast(float, u & 0xffff0000u); }
__device__ __forceinline__ bf16_t bf1(float x) { return (bf16_t)(cvtpk(x, x) & 0xffffu); }
__device__ __forceinline__ bf16x8 pack8(float a0, float a1, float a2, float a3, float a4, float a5, float a6, float a7) {
    v4u w; w.x = cvtpk(a0, a1); w.y = cvtpk(a2, a3); w.z = cvtpk(a4, a5); w.w = cvtpk(a6, a7); return __builtin_bit_cast(bf16x8, w); }
template <int CTRL> __device__ __forceinline__ float dpp_mov(float x) { return __builtin_bit_cast(float, __builtin_amdgcn_update_dpp(0, __builtin_bit_cast(int, x), CTRL, 0xF, 0xF, true)); }
__device__ __forceinline__ float rowsum16(float x) { x += dpp_mov<0x128>(x); x += dpp_mov<0x124>(x); x += dpp_mov<0x122>(x); x += dpp_mov<0x121>(x); return x; }
__device__ __forceinline__ float rl(float x, int l) { return __builtin_bit_cast(float, __builtin_amdgcn_readlane(__builtin_bit_cast(int, x), l)); }
__device__ __forceinline__ float wave_sum_dpp(float x) { x = rowsum16(x); return (rl(x, 0) + rl(x, 16)) + (rl(x, 32) + rl(x, 48)); }

__device__ __forceinline__ void transpose_matrix(const float* __restrict__ W, int K, int N, bf16_t* __restrict__ WT, int Npad, int ldt, LAS float* scr, int gw, int NGW, int lane, const float* __restrict__ kscale, int& tr_base, bool ffn_interleave = false) {
    (void)scr;
    const int nblk = Npad / 64, nit = (K / 64) * nblk;
    int it0 = gw - (tr_base % NGW); if (it0 < 0) it0 += NGW; tr_base += nit;
    for (int it = it0; it < nit; it += NGW) {
        const int kb = it / nblk, nb = it - kb * nblk, n = nb * 64 + lane, k0 = kb * 64;
        const bool ok = n < N; const float* src = W + (size_t)k0 * N + (ok ? n : 0);
#pragma unroll
        for (int hc = 0; hc < 2; ++hc) {
            float v[32];
#pragma unroll
            for (int i = 0; i < 32; ++i) v[i] = src[(size_t)(hc * 32 + i) * N];
#pragma unroll
            for (int c = 0; c < 4; ++c) { float u[8];
#pragma unroll
                for (int i = 0; i < 8; ++i) { u[i] = ok ? v[c * 8 + i] : 0.f; if (kscale) u[i] *= kscale[k0 + hc * 32 + c * 8 + i]; }
                v4u o; o.x = cvtpk(u[0], u[1]); o.y = cvtpk(u[2], u[3]); o.z = cvtpk(u[4], u[5]); o.w = cvtpk(u[6], u[7]);
                const int nr = ffn_interleave ? ((n < DFF) ? 256 * (n >> 7) + (n & 127) : 256 * ((n - DFF) >> 7) + 128 + ((n - DFF) & 127)) : n;
                *(v4u*)(WT + (size_t)nr * ldt + k0 + hc * 32 + c * 8) = o; }
        }
    }
}

template <int MODE, int SEL = 0> __device__ __forceinline__ void ln_rows_range(const bf16_t* z, bf16_t* hb, float* outf, float* stats, const float* __restrict__ g, const float* __restrict__ b, int p0, int p1, int pstep, int lane) {
    auto rowof = [](int pi) { return SEL == 0 ? 2 * pi : SEL == 1 ? 64 * pi + 62 : 64 * (pi / 31) + 2 * (pi % 31); };
    pg8::u32x4 raw[2][2];
    if (p0 < p1) { const bf16_t* p = z + (size_t)rowof(p0) * DM;
#pragma unroll
        for (int r = 0; r < 2; ++r)
#pragma unroll
            for (int j = 0; j < 2; ++j) raw[r][j] = *(const pg8::u32x4*)(p + r * DM + 8 * lane + 512 * j); }
    for (int pi = p0; pi < p1; pi += pstep) {
        const int row = rowof(pi);
        f32x4 v[2][4]; float s[2] = {0.f, 0.f};
#pragma unroll
        for (int r = 0; r < 2; ++r)
#pragma unroll
            for (int j = 0; j < 2; ++j) {
                v[r][2 * j][0] = __builtin_bit_cast(float, raw[r][j].x << 16); v[r][2 * j][1] = __builtin_bit_cast(float, raw[r][j].x & 0xffff0000u);
                v[r][2 * j][2] = __builtin_bit_cast(float, raw[r][j].y << 16); v[r][2 * j][3] = __builtin_bit_cast(float, raw[r][j].y & 0xffff0000u);
                v[r][2 * j + 1][0] = __builtin_bit_cast(float, raw[r][j].z << 16); v[r][2 * j + 1][1] = __builtin_bit_cast(float, raw[r][j].z & 0xffff0000u);
                v[r][2 * j + 1][2] = __builtin_bit_cast(float, raw[r][j].w << 16); v[r][2 * j + 1][3] = __builtin_bit_cast(float, raw[r][j].w & 0xffff0000u); }
        { const int nxt = pi + pstep; const bf16_t* pn = z + (size_t)rowof(nxt < p1 ? nxt : pi) * DM;
#pragma unroll
          for (int r = 0; r < 2; ++r)
#pragma unroll
              for (int j = 0; j < 2; ++j) raw[r][j] = *(const pg8::u32x4*)(pn + r * DM + 8 * lane + 512 * j); }
#pragma unroll
        for (int r = 0; r < 2; ++r)
#pragma unroll
            for (int j = 0; j < 4; ++j) s[r] += (v[r][j][0] + v[r][j][1]) + (v[r][j][2] + v[r][j][3]);
        float mean[2], q[2] = {0.f, 0.f}, rstd[2];
#pragma unroll
        for (int r = 0; r < 2; ++r) { mean[r] = wave_sum_dpp(s[r]) * (1.f / DM);
#pragma unroll
            for (int j = 0; j < 4; ++j) { v[r][j] = v[r][j] - mean[r]; q[r] += (v[r][j][0] * v[r][j][0] + v[r][j][1] * v[r][j][1]) + (v[r][j][2] * v[r][j][2] + v[r][j][3] * v[r][j][3]); } }
#pragma unroll
        for (int r = 0; r < 2; ++r) rstd[r] = 1.0f / sqrtf(wave_sum_dpp(q[r]) * (1.f / DM) + 1e-5f);
        if (MODE == 1 && lane < 2) { stats[2 * (row + lane)] = lane ? mean[1] : mean[0]; stats[2 * (row + lane) + 1] = lane ? rstd[1] : rstd[0]; }
#pragma unroll
        for (int j = 0; j < 2; ++j) {
            const int c = 8 * lane + 512 * j;
            const f32x4 g0 = *(const f32x4*)(g + c), g1 = *(const f32x4*)(g + c + 4), b0 = *(const f32x4*)(b + c), b1 = *(const f32x4*)(b + c + 4);
#pragma unroll
            for (int r = 0; r < 2; ++r) {
                const f32x4 o0 = v[r][2 * j] * rstd[r] * g0 + b0, o1 = v[r][2 * j + 1] * rstd[r] * g1 + b1;
                if (MODE == 1) { pg8::u32x4 w; w.x = cvtpk(o0[0], o0[1]); w.y = cvtpk(o0[2], o0[3]); w.z = cvtpk(o1[0], o1[1]); w.w = cvtpk(o1[2], o1[3]); *(pg8::u32x4*)(hb + (size_t)(row + r) * DM + c) = w; }
                else { *(f32x4*)(outf + (size_t)(row + r) * DM + c) = o0; *(f32x4*)(outf + (size_t)(row + r) * DM + c + 4) = o1; }
            }
        }
    }
}

template <int MODE> __device__ __forceinline__ void ln_rows(const bf16_t* z, bf16_t* hb, float* outf, float* stats, const float* __restrict__ g, const float* __restrict__ b, int gw, int NGW, int lane) {
    ln_rows_range<MODE, 0>(z, hb, outf, stats, g, b, gw, M / 2, NGW, lane);
}
__device__ __forceinline__ void rwkv_naive_chain(int chain, int lane, LAS float* sm, const bf16_t* __restrict__ proj, const float* __restrict__ mix, const float* __restrict__ w0, const float* __restrict__ w2,
                                                 const float* __restrict__ a0, const float* __restrict__ a2, const float* __restrict__ g2, const float* __restrict__ k_k,
                                                 const float* __restrict__ k_a, const float* __restrict__ r_k, const float* __restrict__ ln_g, const float* __restrict__ ln_b, bf16_t* __restrict__ ymix) {
    LAS float* s_w2 = sm; LAS float* s_a2 = sm + 4096; LAS float* s_g2 = sm + 8192; LAS float* s_tw = sm + 16384; LAS float* s_al = s_tw + 64; LAS float* s_sg = s_tw + 128;
    LAS float* s_w = s_tw + 256; LAS float* s_k = s_tw + 320; LAS float* s_a = s_tw + 384; LAS float* s_b = s_tw + 448; LAS float* s_r = s_tw + 512;
    const int b = chain >> 3, h = chain & 7, c = h * 64 + lane;
    for (int l = 0; l < 64; ++l) { s_w2[l * 64 + lane] = w2[l * 512 + c]; s_a2[l * 64 + lane] = a2[l * 512 + c]; }
    for (int l = 0; l < 128; ++l) s_g2[l * 64 + lane] = g2[l * 512 + c];
    const float mr = mix[c], mk = mix[512 + c], mv = mix[1024 + c], mw = mix[1536 + lane], ma = mix[1600 + lane], mg0 = mix[1664 + lane], mg1 = mix[1728 + lane];
    const float w0c = w0[c], a0c = a0[c], kkc = k_k[c], kac = k_a[c], rkc = r_k[c], lgc = ln_g[c], lbc = ln_b[c];
    float S[64];
#pragma unroll
    for (int j = 0; j < 64; ++j) S[j] = 0.f;
    float pr = 0.f, pk = 0.f, pv = 0.f, pw = 0.f, pa = 0.f, pg0 = 0.f, pg1 = 0.f;
    WSYNC();
    for (int t = 0; t < SEQ; ++t) {
        const bf16_t* row = proj + (size_t)(b * SEQ + t) * L0P;
        const float cr = bf2f(row[c]), ck = bf2f(row[512 + c]), cv = bf2f(row[1024 + c]), cw = bf2f(row[1536 + lane]), ca = bf2f(row[1600 + lane]),
                    cg0 = bf2f(row[1664 + lane]), cg1 = bf2f(row[1728 + lane]);
        const float r_s = cr + (pr - cr) * mr, k_s = ck + (pk - ck) * mk, v_s = cv + (pv - cv) * mv;
        const float wl = cw + (pw - cw) * mw, al = ca + (pa - ca) * ma, g0 = cg0 + (pg0 - cg0) * mg0, g1 = cg1 + (pg1 - cg1) * mg1;
        pr = cr; pk = ck; pv = cv; pw = cw; pa = ca; pg0 = cg0; pg1 = cg1;
        s_tw[lane] = tanhf(wl); s_al[lane] = al; s_sg[lane] = sigmoidf_(g0); s_sg[64 + lane] = sigmoidf_(g1);
        WSYNC();
        float wsum = w0c, asum = a0c, gsum = 0.f;
#pragma unroll 2
        for (int l = 0; l < 64; ++l) { wsum += s_tw[l] * s_w2[l * 64 + lane]; asum += s_al[l] * s_a2[l * 64 + lane]; }
#pragma unroll 2
        for (int l = 0; l < 128; ++l) gsum += s_sg[l] * s_g2[l * 64 + lane];
        const float log_w = -softplusf_(-wsum) - 0.5f;
        const float dec = expf(-expf(log_w));
        const float a = sigmoidf_(asum);
        float kkv = k_s * kkc;
        const float nrm = sqrtf(wave_sum(kkv * kkv));
        kkv = kkv / fmaxf(nrm, 1e-12f);
        const float k2 = k_s * (1.f + (a - 1.f) * kac);
        const float bonus_s = wave_sum(r_s * k2 * rkc);
        s_w[lane] = dec; s_k[lane] = k2; s_a[lane] = -kkv; s_b[lane] = kkv * a; s_r[lane] = r_s;
        WSYNC();
        float sa = 0.f;
#pragma unroll
        for (int j = 0; j < 64; ++j) sa += S[j] * s_a[j];
        float y = 0.f;
#pragma unroll
        for (int j = 0; j < 64; ++j) { S[j] = S[j] * s_w[j] + sa * s_b[j] + v_s * s_k[j]; y += S[j] * s_r[j]; }
        const float mu = wave_sum(y) * (1.f / 64.f);
        const float d = y - mu;
        const float var = wave_sum(d * d) * (1.f / 64.f);
        const float yn = d * (1.0f / sqrtf(var + 64e-5f)) * lgc + lbc;
        const float o = (yn + bonus_s * v_s) * gsum;
        ymix[(size_t)(b * SEQ + t) * DM + c] = (bf16_t)f2bf(o);
        WSYNC();
    }
}

__device__ __forceinline__ void ssm_conv_all(const bf16_t* __restrict__ proj, const float* __restrict__ cw, const float* __restrict__ cb, const float* __restrict__ dtb,
                                             bf16_t* __restrict__ xbc, float* __restrict__ dt, int gtid, int NT) {
    for (size_t i = gtid; i < (size_t)M * 1024; i += NT) {
        const int m = (int)(i >> 10), c = (int)(i & 1023), t = m & (SEQ - 1);
        float acc = cb[c];
#pragma unroll
        for (int k = 0; k < 4; ++k) { const int tt = t - 3 + k; if (tt >= 0) acc += cw[k * 1024 + c] * bf2f(proj[(size_t)(m - 3 + k) * L0P + 2304 + c]); }
        xbc[i] = (bf16_t)f2bf(siluf_(acc));
    }
    for (int i = gtid; i < M * 8; i += NT) dt[i] = softplusf_(bf2f(proj[(size_t)(i >> 3) * L0P + 3328 + (i & 7)]) + dtb[i & 7]);
}
__device__ __forceinline__ void ssd_naive_task(int task, int lane, const bf16_t* __restrict__ xbc, const float* __restrict__ dt, const float* __restrict__ a_log, const float* __restrict__ dsk, float* __restrict__ yssm) {
    const int chain = task >> 2, q = task & 3, b = chain >> 3, h = chain & 7, g = h >> 2, p = q * 16 + (lane >> 2), nq = lane & 3;
    const float A = -expf(a_log[h]), D = dsk[h];
    float st[32];
#pragma unroll
    for (int n = 0; n < 32; ++n) st[n] = 0.f;
    for (int t = 0; t < SEQ; ++t) {
        const size_t m = (size_t)b * SEQ + t;
        const float dtv = dt[m * 8 + h], dA = expf(dtv * A);
        const float x = bf2f(xbc[m * 1024 + h * 64 + p]), xdt = x * dtv;
        const bf16_t* Bp = xbc + m * 1024 + 512 + g * 128 + nq * 32;
        const bf16_t* Cp = xbc + m * 1024 + 768 + g * 128 + nq * 32;
        float yp = 0.f;
#pragma unroll
        for (int n = 0; n < 32; ++n) { st[n] = st[n] * dA + xdt * bf2f(Bp[n]); yp += st[n] * bf2f(Cp[n]); }
        yp += __shfl_xor(yp, 1); yp += __shfl_xor(yp, 2);
        if (nq == 0) yssm[m * 512 + h * 64 + p] = yp + D * x;
    }
}
template <bool ST = true> __device__ __forceinline__ void ssm_gate_norm_all(const bf16_t* __restrict__ yssm, const bf16_t* __restrict__ proj, const float* __restrict__ ng, bf16_t* __restrict__ ymix, int wv0, int wvend, int lane) {
    for (int wvb = wv0 * 4 - (wv0 & ~7) * 3; wvb < wvend; wvb += NWAVES * 4) {
        float u[4][4], q[4];
#pragma unroll
        for (int k = 0; k < 4; ++k) { const int wv = wvb + k, m = wv >> 1, g = wv & 1; q[k] = 0.f;
#pragma unroll
            for (int j = 0; j < 4; ++j) { const int c = g * 256 + j * 64 + lane; const float z = bf2f(proj[(size_t)m * L0P + 1792 + c]); u[k][j] = bf2f(yssm[(size_t)m * 512 + c]) * (z * __builtin_amdgcn_rcpf(1.f + __expf(-z))); q[k] += u[k][j] * u[k][j]; } }
#pragma unroll
        for (int k = 0; k < 4; ++k) { const int wv = wvb + k, m = wv >> 1, g = wv & 1;
            const float rs = __builtin_amdgcn_rsqf(wave_sum_dpp(q[k]) * (1.f / 256.f) + 1e-5f);
#pragma unroll
            for (int j = 0; j < 4; ++j) { const int c = g * 256 + j * 64 + lane; const float o_ = u[k][j] * rs * ng[c]; if (ST) ymix[(size_t)m * DM + 512 + c] = bf1(o_); else asm volatile("" :: "v"(o_)); } }
    }
}
template <bool ST = true> __device__ __forceinline__ void ffn_act_all(bf16_t* gu, const float* __restrict__ cw, const float* __restrict__ cb, int gtid, int NT) {
    constexpr int NCH = DFF / 8, NSTRIP = M / 32;
    for (int task = gtid; task < NSTRIP * NCH; task += NT) {
        const int strip = task / NCH, q = task - strip * NCH, c0 = q * 8, m0 = strip * 32;
        float w0[8], w1[8], w2[8], bb[8], g2[8], g1[8];
#pragma unroll
        for (int j = 0; j < 8; j += 4) { const f32x4 a = *(const f32x4*)(cw + c0 + j), b = *(const f32x4*)(cw + DFF + c0 + j), c = *(const f32x4*)(cw + 2 * DFF + c0 + j), d = *(const f32x4*)(cb + c0 + j);
#pragma unroll
            for (int k = 0; k < 4; ++k) { w0[j + k] = a[k]; w1[j + k] = b[k]; w2[j + k] = c[k]; bb[j + k] = d[k]; } }
        bf16_t* base = gu + (size_t)m0 * (2 * DFF) + c0;
        if ((m0 & (SEQ - 1)) != 0) { const v4u a = *(const v4u*)(base - 2 * (2 * DFF)), b = *(const v4u*)(base - (2 * DFF));
            g2[0] = bflo(a.x); g2[1] = bfhi(a.x); g2[2] = bflo(a.y); g2[3] = bfhi(a.y); g2[4] = bflo(a.z); g2[5] = bfhi(a.z); g2[6] = bflo(a.w); g2[7] = bfhi(a.w);
            g1[0] = bflo(b.x); g1[1] = bfhi(b.x); g1[2] = bflo(b.y); g1[3] = bfhi(b.y); g1[4] = bflo(b.z); g1[5] = bfhi(b.z); g1[6] = bflo(b.w); g1[7] = bfhi(b.w); }
        else {
#pragma unroll
            for (int j = 0; j < 8; ++j) { g2[j] = 0.f; g1[j] = 0.f; } }
#pragma unroll 4
        for (int r = 0; r < 32; ++r) {
            const v4u gv = *(const v4u*)(base + (size_t)r * (2 * DFF)), uv = *(const v4u*)(base + (size_t)r * (2 * DFF) + DFF);
            const unsigned gw_[4] = {gv.x, gv.y, gv.z, gv.w}, uw_[4] = {uv.x, uv.y, uv.z, uv.w};
            unsigned ow[4];
#pragma unroll
            for (int k = 0; k < 4; ++k) {
                const float ga = bflo(gw_[k]), gb = bfhi(gw_[k]);
                const float ya = bb[2 * k] + w0[2 * k] * g2[2 * k] + w1[2 * k] * g1[2 * k] + w2[2 * k] * ga;
                const float yb = bb[2 * k + 1] + w0[2 * k + 1] * g2[2 * k + 1] + w1[2 * k + 1] * g1[2 * k + 1] + w2[2 * k + 1] * gb;
                g2[2 * k] = g1[2 * k]; g1[2 * k] = ga; g2[2 * k + 1] = g1[2 * k + 1]; g1[2 * k + 1] = gb;
                ow[k] = cvtpk(ya / (1.f + __expf(-ya)) * bflo(uw_[k]), yb / (1.f + __expf(-yb)) * bfhi(uw_[k]));
            }
            if (ST) *(v4u*)(base + (size_t)r * (2 * DFF) + DFF) = (v4u){ow[0], ow[1], ow[2], ow[3]}; else asm volatile("" :: "v"(ow[0]), "v"(ow[1]), "v"(ow[2]), "v"(ow[3]));
        }
    }
}
template <bool ST = true> __device__ __forceinline__ void mla_prep_all(const bf16_t* __restrict__ proj1, const int* __restrict__ pos, float* __restrict__ rs, bf16_t* __restrict__ kpe, float* __restrict__ cstab, int gw, int NGW, int lane) {
    const int fi = lane & 15, tk = lane >> 4;
    const double inv_rev = exp2(-(double)(2 * fi) * (13.287712379549449 / 32.0)) * 0.15915494309189535;
    for (int m4 = gw * 4; m4 < M; m4 += NGW * 4) {
        const int mt = m4 + tk;
        const bf16_t* row = proj1 + (size_t)mt * L1P;
        const v4u qa = *(const v4u*)(row + 1536 + 8 * fi), qb = *(const v4u*)(row + 1664 + 8 * fi), ka = *(const v4u*)(row + 1792 + 8 * fi);
        const float x1 = bf2f(row[1920 + fi]), x2 = bf2f(row[1936 + fi]);
        const double rev = (double)pos[mt] * inv_rev;
        const float fr = (float)(rev - floor(rev));
        const float cs = __builtin_amdgcn_cosf(fr), sn = __builtin_amdgcn_sinf(fr);
        cstab[(size_t)mt * 32 + fi] = cs; cstab[(size_t)mt * 32 + 16 + fi] = sn;
        kpe[(size_t)mt * 32 + fi] = bf1(x1 * cs - x2 * sn); kpe[(size_t)mt * 32 + 16 + fi] = bf1(x2 * cs + x1 * sn);
        float q = 0.f, k = 0.f;
#pragma unroll
        for (int e = 0; e < 4; ++e) { const float a0 = bflo(qa[e]), a1 = bfhi(qa[e]), b0 = bflo(qb[e]), b1 = bfhi(qb[e]), c0 = bflo(ka[e]), c1 = bfhi(ka[e]);
            q += (a0 * a0 + a1 * a1) + (b0 * b0 + b1 * b1); k += c0 * c0 + c1 * c1; }
        q = rowsum16(q); k = rowsum16(k);
        if (fi == 0) { rs[(size_t)mt * 2] = 1.0f / sqrtf(q * (1.f / 256.f) + 1e-6f); rs[(size_t)mt * 2 + 1] = 1.0f / sqrtf(k * (1.f / 128.f) + 1e-6f); }
    }
}
template <bool ST = true> __device__ __forceinline__ void rope_q_all(bf16_t* qm, const float* __restrict__ cstab, int gtid, int NT) {
    for (int i = gtid; i < M * 16; i += NT) {
        const int m = i >> 4, h = (i >> 1) & 7, k0 = (i & 1) * 8;
        bf16_t* p = qm + (size_t)m * 768 + h * 96 + 64 + k0;
        const v4u a = *(const v4u*)p, b = *(const v4u*)(p + 16);
        const f32x4 c0 = *(const f32x4*)(cstab + (size_t)m * 32 + k0), c1 = *(const f32x4*)(cstab + (size_t)m * 32 + k0 + 4), s0 = *(const f32x4*)(cstab + (size_t)m * 32 + 16 + k0), s1 = *(const f32x4*)(cstab + (size_t)m * 32 + 16 + k0 + 4);
        const unsigned au[4] = {a.x, a.y, a.z, a.w}, bu[4] = {b.x, b.y, b.z, b.w};
        const float cs[8] = {c0[0], c0[1], c0[2], c0[3], c1[0], c1[1], c1[2], c1[3]}, sn[8] = {s0[0], s0[1], s0[2], s0[3], s1[0], s1[1], s1[2], s1[3]};
        unsigned o1[4], o2[4];
#pragma unroll
        for (int q = 0; q < 4; ++q) { const float x1a = bflo(au[q]), x1b = bfhi(au[q]), x2a = bflo(bu[q]), x2b = bfhi(bu[q]);
            o1[q] = cvtpk(x1a * cs[2 * q] - x2a * sn[2 * q], x1b * cs[2 * q + 1] - x2b * sn[2 * q + 1]);
            o2[q] = cvtpk(x2a * cs[2 * q] + x1a * sn[2 * q], x2b * cs[2 * q + 1] + x1b * sn[2 * q + 1]); }
        if (ST) { *(v4u*)p = (v4u){o1[0], o1[1], o1[2], o1[3]}; *(v4u*)(p + 16) = (v4u){o2[0], o2[1], o2[2], o2[3]}; }
    }
}
__device__ __forceinline__ void sb_naive_task(int qblk, int bh, int lane, const bf16_t* __restrict__ proj1, bf16_t* __restrict__ ymix) {
    const int b = bh >> 3, h = bh & 7, t = qblk * 64 + lane;
    const size_t mrow = (size_t)b * SEQ;
    float q[64], o[64];
#pragma unroll
    for (int d = 0; d < 64; ++d) { q[d] = bf2f(proj1[(mrow + t) * L1P + h * 64 + d]) * 0.125f; o[d] = 0.f; }
    float cum = 0.f;
    const int smax = qblk * 64 + 63;
    for (int s = smax - 1; s >= 0; --s) {
        const bf16_t* kr = proj1 + (mrow + s) * L1P + 512 + h * 64;
        const bf16_t* vr = proj1 + (mrow + s) * L1P + 1024 + h * 64;
        float z = 0.f;
#pragma unroll
        for (int d = 0; d < 64; ++d) z += q[d] * bf2f(kr[d]);
        if (s < t) {
            const float lsp = -softplusf_(-z);
            const float lsn = -softplusf_(z);
            const float att = expf(lsp + cum);
            cum += lsn;
#pragma unroll
            for (int d = 0; d < 64; ++d) o[d] += att * bf2f(vr[d]);
        }
    }
#pragma unroll
    for (int d = 0; d < 64; ++d) ymix[(mrow + t) * DM + h * 64 + d] = (bf16_t)f2bf(o[d]);
}
__device__ __forceinline__ void mla_naive_task(int qblk, int bh, int lane, const bf16_t* __restrict__ qm, const bf16_t* __restrict__ kvm, const bf16_t* __restrict__ kpe, bf16_t* __restrict__ ymix) {
    const int b = bh >> 3, h = bh & 7, t = qblk * 64 + lane;
    const size_t mrow = (size_t)b * SEQ;
    const float scale = 0.10206207261596577f;
    float q[96], o[64];
#pragma unroll
    for (int d = 0; d < 96; ++d) q[d] = bf2f(qm[(mrow + t) * 768 + h * 96 + d]) * scale;
#pragma unroll
    for (int d = 0; d < 64; ++d) o[d] = 0.f;
    float mx = -1e30f, l = 0.f;
    const int smax = qblk * 64 + 63;
    for (int s = 0; s <= smax; ++s) {
        const bf16_t* kr = kvm + (mrow + s) * 1024 + h * 128;
        const bf16_t* pr = kpe + (mrow + s) * 32;
        float z = 0.f;
#pragma unroll
        for (int d = 0; d < 64; ++d) z += q[d] * bf2f(kr[d]);
#pragma unroll
        for (int d = 0; d < 32; ++d) z += q[64 + d] * bf2f(pr[d]);
        if (s <= t) {
            const float mn = fmaxf(mx, z), f = expf(mx - mn), pz = expf(z - mn);
            l = l * f + pz; mx = mn;
#pragma unroll
            for (int d = 0; d < 64; ++d) o[d] = o[d] * f + pz * bf2f(kr[64 + d]);
        }
    }
    const float il = 1.f / l;
#pragma unroll
    for (int d = 0; d < 64; ++d) ymix[(mrow + t) * DM + 512 + h * 64 + d] = (bf16_t)f2bf(o[d] * il);
}


__device__ __forceinline__ int crow(int r, int hi) { return (r & 3) + 8 * (r >> 2) + 4 * hi; }
#define MFMA32(a, b, c) __builtin_amdgcn_mfma_f32_32x32x16_bf16((a), (b), (c), 0, 0, 0)
constexpr int STG_PITCH = 72;
__device__ __forceinline__ void transpose_tile64(const bf16_t* __restrict__ src, int sp, bf16_t* __restrict__ dst, int dp, LAS bf16_t* scr, int lane) {
#pragma unroll
    for (int i = 0; i < 8; ++i) { const int row = i * 8 + (lane >> 3), ch = lane & 7; const v4u v = *(const v4u*)(src + (size_t)row * sp + ch * 8); *(LAS v4u*)(scr + row * STG_PITCH + ch * 8) = v; }
    WSYNC();
#pragma unroll
    for (int i = 0; i < 8; ++i) { const int d = i * 8 + (lane >> 3), tc = lane & 7; const LAS bf16_t* p = scr + (tc * 8) * STG_PITCH + d;
        v4u o; o.x = (unsigned)p[0] | ((unsigned)p[STG_PITCH] << 16); o.y = (unsigned)p[2 * STG_PITCH] | ((unsigned)p[3 * STG_PITCH] << 16);
        o.z = (unsigned)p[4 * STG_PITCH] | ((unsigned)p[5 * STG_PITCH] << 16); o.w = (unsigned)p[6 * STG_PITCH] | ((unsigned)p[7 * STG_PITCH] << 16);
        *(v4u*)(dst + (size_t)d * dp + tc * 8) = o; }
    WSYNC();
}
__device__ __forceinline__ void store_OT(const f32x16 (&o)[2], float sc, LAS bf16_t* stg, bf16_t* __restrict__ dst, int lane) {
    const int l31 = lane & 31, hi = lane >> 5;
#pragma unroll
    for (int dt = 0; dt < 2; ++dt)
#pragma unroll
        for (int r = 0; r < 16; ++r) stg[l31 * STG_PITCH + 32 * dt + crow(r, hi)] = bf1(o[dt][r] * sc);
    WSYNC();
#pragma unroll
    for (int i = 0; i < 4; ++i) { const int row = i * 8 + (lane >> 3), ch = lane & 7; const v4u v = *(const LAS v4u*)(stg + row * STG_PITCH + ch * 8); *(v4u*)(dst + (size_t)row * DM + ch * 8) = v; }
    WSYNC();
}
__device__ __forceinline__ float softplus_fast(float z) { return fmaxf(z, 0.f) + __logf(1.f + __expf(-fabsf(z))); }

__device__ __forceinline__ void sb_task(int bh, int qblk, int lane, const bf16_t* __restrict__ P1, const bf16_t* __restrict__ VT, bf16_t* __restrict__ ymix, LAS bf16_t* stg) {
    const int b = bh >> 3, h = bh & 7, l31 = lane & 31, hi = lane >> 5, q0 = qblk * 32, t = q0 + l31;
    const size_t rowb = (size_t)b * SEQ;
    const bf16_t* Qp = P1 + (rowb + q0 + l31) * L1P + h * 64 + 8 * hi;
    bf16x8 qf[4];
#pragma unroll
    for (int kk = 0; kk < 4; ++kk) qf[kk] = *(const bf16x8*)(Qp + 16 * kk);
    const bf16_t* Kp = P1 + (rowb + l31) * L1P + 512 + h * 64 + 8 * hi;
    const bf16_t* Vp = VT + ((size_t)bh * 64 + l31) * SEQ + 4 * hi;
    f32x16 o[2];
#pragma unroll
    for (int r = 0; r < 16; ++r) { o[0][r] = 0.f; o[1][r] = 0.f; }
    float cum = 0.f;
    bf16x8 kf[4]; u32x2 va[2][2][2];
#define SB_LOAD(S0, KF, VA) do { _Pragma("unroll") for (int kk = 0; kk < 4; ++kk) KF[kk] = *(const bf16x8*)(Kp + (size_t)(S0) * L1P + 16 * kk); \
        _Pragma("unroll") for (int dt = 0; dt < 2; ++dt) _Pragma("unroll") for (int ks = 0; ks < 2; ++ks) { VA[dt][ks][0] = *(const u32x2*)(Vp + (size_t)dt * 32 * SEQ + (S0) + 16 * ks); VA[dt][ks][1] = *(const u32x2*)(Vp + (size_t)dt * 32 * SEQ + (S0) + 16 * ks + 8); } } while (0)
    SB_LOAD(q0, kf, va);
    for (int s0 = q0; s0 >= 0; s0 -= 32) {
        bf16x8 kn[4]; u32x2 vn[2][2][2];
        const int sn = (s0 >= 32) ? s0 - 32 : 0;
        SB_LOAD(sn, kn, vn);
        f32x16 acc;
#pragma unroll
        for (int r = 0; r < 16; ++r) acc[r] = 0.f;
#pragma unroll
        for (int kk = 0; kk < 4; ++kk) acc = MFMA32(kf[kk], qf[kk], acc);
        const bool diag = (s0 == q0);
        float lb[16], lk[16];
#pragma unroll
        for (int r = 0; r < 16; ++r) { const float z = acc[r] * 0.125f; const float sp = softplus_fast(z); float b_ = z - sp, k_ = -sp;
            if (diag) { const bool valid = (s0 + crow(r, hi)) < t; b_ = valid ? b_ : -1e30f; k_ = valid ? k_ : 0.f; }
            lb[r] = b_; lk[r] = k_; }
        float e[16], T[4], U[4];
#pragma unroll
        for (int i = 0; i < 4; ++i) { e[4 * i + 3] = 0.f; e[4 * i + 2] = lk[4 * i + 3]; e[4 * i + 1] = e[4 * i + 2] + lk[4 * i + 2]; e[4 * i] = e[4 * i + 1] + lk[4 * i + 1]; T[i] = e[4 * i] + lk[4 * i]; }
#pragma unroll
        for (int i = 0; i < 4; ++i) U[i] = __shfl_xor(T[i], 32);
        float off[4];
        { const float st2 = T[3], st1 = st2 + T[2], st0 = st1 + T[1]; const float su2 = U[3], su1 = su2 + U[2], su0 = su1 + U[1];
          const float x0 = hi ? 0.f : U[0], x1 = hi ? 0.f : U[1], x2 = hi ? 0.f : U[2], x3 = hi ? 0.f : U[3];
          off[3] = x3; off[2] = st2 + su2 + x2; off[1] = st1 + su1 + x1; off[0] = st0 + su0 + x0;
          const float total = st0 + T[0] + su0 + U[0];
#pragma unroll
          for (int r = 0; r < 16; ++r) acc[r] = __expf(lb[r] + (cum + off[r >> 2] + e[r]));
          cum += total; }
        bf16x8 pf[2];
#pragma unroll
        for (int ks = 0; ks < 2; ++ks) { v4u w; w.x = cvtpk(acc[8 * ks], acc[8 * ks + 1]); w.y = cvtpk(acc[8 * ks + 2], acc[8 * ks + 3]); w.z = cvtpk(acc[8 * ks + 4], acc[8 * ks + 5]); w.w = cvtpk(acc[8 * ks + 6], acc[8 * ks + 7]); pf[ks] = __builtin_bit_cast(bf16x8, w); }
#pragma unroll
        for (int dt = 0; dt < 2; ++dt)
#pragma unroll
            for (int ks = 0; ks < 2; ++ks) { v4u a; a.x = va[dt][ks][0].x; a.y = va[dt][ks][0].y; a.z = va[dt][ks][1].x; a.w = va[dt][ks][1].y; o[dt] = MFMA32(__builtin_bit_cast(bf16x8, a), pf[ks], o[dt]); }
        if (__all(cum < -110.f)) break;
#pragma unroll
        for (int kk = 0; kk < 4; ++kk) kf[kk] = kn[kk];
#pragma unroll
        for (int dt = 0; dt < 2; ++dt)
#pragma unroll
            for (int ks = 0; ks < 2; ++ks) { va[dt][ks][0] = vn[dt][ks][0]; va[dt][ks][1] = vn[dt][ks][1]; }
    }
#undef SB_LOAD
    store_OT(o, 1.0f, stg, ymix + (rowb + q0) * DM + h * 64, lane);
}
__device__ __forceinline__ void mla_task(int bh, int qblk, int lane, const bf16_t* __restrict__ QM, const bf16_t* __restrict__ KVM, const bf16_t* __restrict__ KPE, const bf16_t* __restrict__ VT,
                                         bf16_t* __restrict__ ymix, LAS bf16_t* stg) {
    const int b = bh >> 3, h = bh & 7, l31 = lane & 31, hi = lane >> 5, q0 = qblk * 32, t = q0 + l31;
    const size_t rowb = (size_t)b * SEQ;
    const bf16_t* Qp = QM + (rowb + q0 + l31) * 768 + h * 96 + 8 * hi;
    bf16x8 qf[6];
#pragma unroll
    for (int kk = 0; kk < 6; ++kk) qf[kk] = *(const bf16x8*)(Qp + 16 * kk);
    const bf16_t* Kn = KVM + (rowb + l31) * 1024 + h * 128 + 8 * hi;
    const bf16_t* Kr = KPE + (rowb + l31) * 32 + 8 * hi;
    const bf16_t* Vp = VT + ((size_t)bh * 64 + l31) * SEQ + 4 * hi;
    const float sc2 = 0.10206207261596577f * 1.4426950408889634f;
    f32x16 o[2];
#pragma unroll
    for (int r = 0; r < 16; ++r) { o[0][r] = 0.f; o[1][r] = 0.f; }
    float mrun = -1e30f, lsum = 0.f;
    bf16x8 kf[6]; u32x2 va[2][2][2];
#define ML_LOAD(S0, KF, VA) do { _Pragma("unroll") for (int kk = 0; kk < 4; ++kk) KF[kk] = *(const bf16x8*)(Kn + (size_t)(S0) * 1024 + 16 * kk); \
        _Pragma("unroll") for (int kk = 0; kk < 2; ++kk) KF[4 + kk] = *(const bf16x8*)(Kr + (size_t)(S0) * 32 + 16 * kk); \
        _Pragma("unroll") for (int dt = 0; dt < 2; ++dt) _Pragma("unroll") for (int ks = 0; ks < 2; ++ks) { VA[dt][ks][0] = *(const u32x2*)(Vp + (size_t)dt * 32 * SEQ + (S0) + 16 * ks); VA[dt][ks][1] = *(const u32x2*)(Vp + (size_t)dt * 32 * SEQ + (S0) + 16 * ks + 8); } } while (0)
    ML_LOAD(0, kf, va);
    for (int s0 = 0; s0 <= q0; s0 += 32) {
        bf16x8 kn[6]; u32x2 vn[2][2][2];
        const int sn = (s0 + 32 <= q0) ? s0 + 32 : s0;
        ML_LOAD(sn, kn, vn);
        f32x16 acc;
#pragma unroll
        for (int r = 0; r < 16; ++r) acc[r] = 0.f;
#pragma unroll
        for (int kk = 0; kk < 6; ++kk) acc = MFMA32(kf[kk], qf[kk], acc);
        const bool diag = (s0 == q0);
        float tmax = -1e30f;
#pragma unroll
        for (int r = 0; r < 16; ++r) { float z = acc[r] * sc2; if (diag && (s0 + crow(r, hi)) > t) z = -1e30f; acc[r] = z; tmax = fmaxf(tmax, z); }
        tmax = fmaxf(tmax, __shfl_xor(tmax, 32));
        const float mn = fmaxf(mrun, tmax), alpha = exp2f(mrun - mn); mrun = mn;
        float ps = 0.f;
#pragma unroll
        for (int r = 0; r < 16; ++r) { acc[r] = exp2f(acc[r] - mn); ps += acc[r]; }
        lsum = lsum * alpha + ps;
#pragma unroll
        for (int r = 0; r < 16; ++r) { o[0][r] *= alpha; o[1][r] *= alpha; }
        bf16x8 pf[2];
#pragma unroll
        for (int ks = 0; ks < 2; ++ks) { v4u w; w.x = cvtpk(acc[8 * ks], acc[8 * ks + 1]); w.y = cvtpk(acc[8 * ks + 2], acc[8 * ks + 3]); w.z = cvtpk(acc[8 * ks + 4], acc[8 * ks + 5]); w.w = cvtpk(acc[8 * ks + 6], acc[8 * ks + 7]); pf[ks] = __builtin_bit_cast(bf16x8, w); }
#pragma unroll
        for (int dt = 0; dt < 2; ++dt)
#pragma unroll
            for (int ks = 0; ks < 2; ++ks) { v4u a; a.x = va[dt][ks][0].x; a.y = va[dt][ks][0].y; a.z = va[dt][ks][1].x; a.w = va[dt][ks][1].y; o[dt] = MFMA32(__builtin_bit_cast(bf16x8, a), pf[ks], o[dt]); }
#pragma unroll
        for (int kk = 0; kk < 6; ++kk) kf[kk] = kn[kk];
#pragma unroll
        for (int dt = 0; dt < 2; ++dt)
#pragma unroll
            for (int ks = 0; ks < 2; ++ks) { va[dt][ks][0] = vn[dt][ks][0]; va[dt][ks][1] = vn[dt][ks][1]; }
    }
#undef ML_LOAD
    lsum += __shfl_xor(lsum, 32);
    store_OT(o, 1.0f / lsum, stg, ymix + (rowb + q0) * DM + 512 + h * 64, lane);
}


__device__ __forceinline__ void sb_wave(int bh, int qblk, int lane, const bf16_t* __restrict__ P1, const bf16_t* __restrict__ VT, bf16_t* __restrict__ ymix, LAS unsigned char* wl) {
    const int b = bh >> 3, h = bh & 7, l31 = lane & 31, hi = lane >> 5, q0 = qblk * 32, t = q0 + l31;
    const size_t rowb = (size_t)b * SEQ;
    bf16x8 qf[4];
    { const bf16_t* Qp = P1 + (rowb + q0 + l31) * L1P + h * 64 + 8 * hi;
#pragma unroll
      for (int kk = 0; kk < 4; ++kk) qf[kk] = *(const bf16x8*)(Qp + 16 * kk); }
    f32x16 o[2];
#pragma unroll
    for (int r = 0; r < 16; ++r) { o[0][r] = 0.f; o[1][r] = 0.f; }
    float cum = 1.f;
    const bf16_t* gK = P1 + (rowb + (lane >> 3)) * L1P + 512 + h * 64 + (lane & 7) * 8;
    const bf16_t* gV = VT + ((size_t)bh * 64 + (lane >> 2)) * SEQ + (lane & 3) * 8;
    const int lK = (lane >> 3) * 144 + (lane & 7) * 16, lV = 4608 + (lane >> 2) * 72 + (lane & 3) * 16;
    v4u rk[4], rv[4];
#pragma unroll
    for (int i = 0; i < 4; ++i) { rk[i] = *(const v4u*)(gK + (size_t)(q0 + 8 * i) * L1P); rv[i] = *(const v4u*)(gV + (size_t)(16 * i) * SEQ + q0); }
#pragma unroll 1
    for (int s0 = q0; s0 >= 0; s0 -= 32) {
#pragma unroll
        for (int i = 0; i < 4; ++i) { *(LAS v4u*)(wl + lK + i * 8 * 144) = rk[i]; *(LAS u32x2*)(wl + lV + i * 16 * 72) = (u32x2){rv[i].x, rv[i].y}; *(LAS u32x2*)(wl + lV + i * 16 * 72 + 8) = (u32x2){rv[i].z, rv[i].w}; }
        { const int sn = (s0 >= 32) ? s0 - 32 : 0;
#pragma unroll
          for (int i = 0; i < 4; ++i) { rk[i] = *(const v4u*)(gK + (size_t)(sn + 8 * i) * L1P); rv[i] = *(const v4u*)(gV + (size_t)(16 * i) * SEQ + sn); } }
        WSYNC();
        f32x16 acc;
#pragma unroll
        for (int r = 0; r < 16; ++r) acc[r] = 0.f;
#pragma unroll
        for (int kk = 0; kk < 4; ++kk) { const bf16x8 kf = *(const LAS bf16x8*)(wl + l31 * 144 + (16 * kk + 8 * hi) * 2); acc = MFMA32(kf, qf[kk], acc); }
        const bool diag = (s0 == q0);
        float bt[16], kp[16];
#pragma unroll
        for (int r = 0; r < 16; ++r) { const float ee = __builtin_amdgcn_exp2f(fminf(acc[r] * (-0.125f * 1.4426950408889634f), 100.f)); const float ri = __builtin_amdgcn_rcpf(1.f + ee);
            float b_ = ri, k_ = ee * ri;
            if (diag) { const bool valid = (s0 + crow(r, hi)) < t; b_ = valid ? b_ : 0.f; k_ = valid ? k_ : 1.f; }
            bt[r] = b_; kp[r] = k_; }
        float e[16], T[4], U[4];
#pragma unroll
        for (int q = 0; q < 4; ++q) { e[4 * q + 3] = 1.f; e[4 * q + 2] = kp[4 * q + 3]; e[4 * q + 1] = e[4 * q + 2] * kp[4 * q + 2]; e[4 * q] = e[4 * q + 1] * kp[4 * q + 1]; T[q] = e[4 * q] * kp[4 * q]; }
#pragma unroll
        for (int q = 0; q < 4; ++q) U[q] = __shfl_xor(T[q], 32);
        { const float st2 = T[3], st1 = st2 * T[2], st0 = st1 * T[1]; const float su2 = U[3], su1 = su2 * U[2], su0 = su1 * U[1];
          const float x0 = hi ? 1.f : U[0], x1 = hi ? 1.f : U[1], x2 = hi ? 1.f : U[2], x3 = hi ? 1.f : U[3];
          const float off[4] = {cum * (st0 * su0 * x0), cum * (st1 * su1 * x1), cum * (st2 * su2 * x2), cum * x3};
#pragma unroll
          for (int r = 0; r < 16; ++r) acc[r] = bt[r] * (off[r >> 2] * e[r]);
          cum *= (st0 * T[0]) * (su0 * U[0]); }
        bf16x8 pf[2];
#pragma unroll
        for (int ks = 0; ks < 2; ++ks) pf[ks] = pack8(acc[8 * ks], acc[8 * ks + 1], acc[8 * ks + 2], acc[8 * ks + 3], acc[8 * ks + 4], acc[8 * ks + 5], acc[8 * ks + 6], acc[8 * ks + 7]);
#pragma unroll
        for (int dt = 0; dt < 2; ++dt)
#pragma unroll
            for (int ks = 0; ks < 2; ++ks) { const LAS unsigned char* vp = wl + 4608 + (32 * dt + l31) * 72 + (16 * ks + 4 * hi) * 2;
                const u32x2 x0 = *(const LAS u32x2*)vp, x1 = *(const LAS u32x2*)(vp + 16);
                v4u a; a.x = x0.x; a.y = x0.y; a.z = x1.x; a.w = x1.y; o[dt] = MFMA32(__builtin_bit_cast(bf16x8, a), pf[ks], o[dt]); }
        WSYNC();
        if (__all(cum < 1e-35f)) break;
    }
    store_OT(o, 1.0f, (LAS bf16_t*)(wl + 9216), ymix + (rowb + q0) * DM + h * 64, lane);
}

constexpr int MLK_PITCH = 104, MLV_PITCH = 68, MLK_BYTES = 64 * MLK_PITCH * 2, MLV_BYTES = 64 * MLV_PITCH * 2, ML_STAGE = MLK_BYTES + MLV_BYTES;
__device__ __forceinline__ void mla_block(int bh, int sb, int tid, int lane, int wave, LAS unsigned char* lds, const bf16_t* __restrict__ QM, const bf16_t* __restrict__ KVM, const bf16_t* __restrict__ KPE,
                                          const bf16_t* __restrict__ VT, bf16_t* __restrict__ ymix, const float* __restrict__ cstab) {
    const int b = bh >> 3, h = bh & 7, l31 = lane & 31, hi = lane >> 5, q0 = 256 * sb + 32 * wave, t = q0 + l31;
    const size_t rowb = (size_t)b * SEQ;
    const int nsteps = 4 * sb + 4;
    bf16x8 qf[6];
    { const bf16_t* Qp = QM + (rowb + q0 + l31) * 768 + h * 96 + 8 * hi;
#pragma unroll
      for (int kk = 0; kk < 6; ++kk) qf[kk] = *(const bf16x8*)(Qp + 16 * kk);
      const float* ct = cstab + (rowb + q0 + l31) * 32 + 8 * hi;
      const f32x4 c0 = *(const f32x4*)ct, c1 = *(const f32x4*)(ct + 4), s0 = *(const f32x4*)(ct + 16), s1 = *(const f32x4*)(ct + 20);
#pragma unroll
      for (int j = 0; j < 8; ++j) { const float cs = j < 4 ? c0[j & 3] : c1[j & 3], sn = j < 4 ? s0[j & 3] : s1[j & 3];
          const float x1 = bf2f((bf16_t)qf[4][j]), x2 = bf2f((bf16_t)qf[5][j]);
          qf[4][j] = (short)bf1(x1 * cs - x2 * sn); qf[5][j] = (short)bf1(x2 * cs + x1 * sn); } }
    const float sc2 = 0.10206207261596577f * 1.4426950408889634f;
    f32x16 o[2];
#pragma unroll
    for (int r = 0; r < 16; ++r) { o[0][r] = 0.f; o[1][r] = 0.f; }
    float mrun = -1e30f, lsum = 0.f;
    const bf16_t* gKn = KVM + (rowb + (tid >> 3)) * 1024 + h * 128 + (tid & 7) * 8;
    const bf16_t* gKr = KPE + (rowb + ((tid & 255) >> 2)) * 32 + (tid & 3) * 8;
    const bf16_t* gVt = VT + ((size_t)bh * 64 + (tid >> 3)) * SEQ + (tid & 7) * 8;
    const int lKn = (tid >> 3) * (MLK_PITCH * 2) + (tid & 7) * 16, lKr = ((tid & 255) >> 2) * (MLK_PITCH * 2) + 128 + (tid & 3) * 16, lVt = MLK_BYTES + (tid >> 3) * (MLV_PITCH * 2) + (tid & 7) * 16;
    v4u rk, rr, rv;
    rk = *(const v4u*)gKn; rr = *(const v4u*)gKr; rv = *(const v4u*)gVt;
    *(LAS v4u*)(lds + lKn) = rk; if (tid < 256) *(LAS v4u*)(lds + lKr) = rr; *(LAS u32x2*)(lds + lVt) = (u32x2){rv.x, rv.y}; *(LAS u32x2*)(lds + lVt + 8) = (u32x2){rv.z, rv.w};
    __syncthreads();
#pragma unroll 1
    for (int step = 0; step < nsteps; ++step) {
        const int nx = (step + 1 < nsteps) ? step + 1 : step;
        rk = *(const v4u*)(gKn + (size_t)nx * 64 * 1024); rr = *(const v4u*)(gKr + (size_t)nx * 64 * 32); rv = *(const v4u*)(gVt + nx * 64);
        const LAS unsigned char* Kb = lds + (step & 1) * ML_STAGE;
        const LAS unsigned char* Vb = Kb + MLK_BYTES;
        if (64 * step <= q0) {
            f32x16 acc[2];
            {
                bf16x8 kf[2][6];
#pragma unroll
                for (int sub = 0; sub < 2; ++sub)
#pragma unroll
                    for (int kk = 0; kk < 6; ++kk) kf[sub][kk] = *(const LAS bf16x8*)(Kb + (32 * sub + l31) * (MLK_PITCH * 2) + (16 * kk + 8 * hi) * 2);
                __builtin_amdgcn_sched_barrier(0);
#pragma unroll
                for (int r = 0; r < 16; ++r) { acc[0][r] = 0.f; acc[1][r] = 0.f; }
#pragma unroll
                for (int kk = 0; kk < 6; ++kk) { acc[0] = MFMA32(kf[0][kk], qf[kk], acc[0]); acc[1] = MFMA32(kf[1][kk], qf[kk], acc[1]); }
            }
            u32x2 vx[2][2][2][2];
#pragma unroll
            for (int sub = 0; sub < 2; ++sub)
#pragma unroll
                for (int dt = 0; dt < 2; ++dt)
#pragma unroll
                    for (int ks = 0; ks < 2; ++ks) { const LAS unsigned char* vp = Vb + (32 * dt + l31) * (MLV_PITCH * 2) + (32 * sub + 16 * ks + 4 * hi) * 2;
                        vx[sub][dt][ks][0] = *(const LAS u32x2*)vp; vx[sub][dt][ks][1] = *(const LAS u32x2*)(vp + 16); }
            __builtin_amdgcn_sched_barrier(0);
            float tmax = -1e30f;
#pragma unroll
            for (int sub = 0; sub < 2; ++sub) { const int s0 = 64 * step + 32 * sub;
                if (s0 + 31 > q0) {
#pragma unroll
                    for (int r = 0; r < 16; ++r) if ((s0 + crow(r, hi)) > t) acc[sub][r] = -1e30f; }
#pragma unroll
                for (int r = 0; r < 16; ++r) tmax = fmaxf(tmax, acc[sub][r]); }
            tmax = fmaxf(tmax, __shfl_xor(tmax, 32)) * sc2;
            if (__any(tmax - mrun > 6.f)) {
                const float mn = fmaxf(mrun, tmax), alpha = __builtin_amdgcn_exp2f(mrun - mn); mrun = mn; lsum *= alpha;
#pragma unroll
                for (int r = 0; r < 16; ++r) { o[0][r] *= alpha; o[1][r] *= alpha; }
            }
            float ps = 0.f;
#pragma unroll
            for (int sub = 0; sub < 2; ++sub)
#pragma unroll
                for (int r = 0; r < 16; ++r) { acc[sub][r] = __builtin_amdgcn_exp2f(acc[sub][r] * sc2 - mrun); ps += acc[sub][r]; }
            lsum += ps;
#pragma unroll
            for (int sub = 0; sub < 2; ++sub) {
                bf16x8 pf[2];
#pragma unroll
                for (int ks = 0; ks < 2; ++ks) pf[ks] = pack8(acc[sub][8 * ks], acc[sub][8 * ks + 1], acc[sub][8 * ks + 2], acc[sub][8 * ks + 3], acc[sub][8 * ks + 4], acc[sub][8 * ks + 5], acc[sub][8 * ks + 6], acc[sub][8 * ks + 7]);
#pragma unroll
                for (int ks = 0; ks < 2; ++ks)
#pragma unroll
                    for (int dt = 0; dt < 2; ++dt) { v4u a; a.x = vx[sub][dt][ks][0].x; a.y = vx[sub][dt][ks][0].y; a.z = vx[sub][dt][ks][1].x; a.w = vx[sub][dt][ks][1].y;
                        o[dt] = MFMA32(__builtin_bit_cast(bf16x8, a), pf[ks], o[dt]); }
            }
        }
        LAS unsigned char* nb = lds + ((step + 1) & 1) * ML_STAGE;
        *(LAS v4u*)(nb + lKn) = rk; if (tid < 256) *(LAS v4u*)(nb + lKr) = rr; *(LAS u32x2*)(nb + lVt) = (u32x2){rv.x, rv.y}; *(LAS u32x2*)(nb + lVt + 8) = (u32x2){rv.z, rv.w};
        __syncthreads();
    }
    lsum += __shfl_xor(lsum, 32);
    store_OT(o, 1.0f / lsum, (LAS bf16_t*)(lds + 2 * ML_STAGE) + wave * (32 * STG_PITCH), ymix + (rowb + q0) * DM + 512 + h * 64, lane);
    __syncthreads();
}


constexpr int SBK_PITCH = 72, SBK_BYTES = 64 * SBK_PITCH * 2, SB_STAGE = SBK_BYTES + MLV_BYTES;
__device__ __forceinline__ void sb_block(int bh, int sb, int tid, int lane, int wave, LAS unsigned char* lds, const bf16_t* __restrict__ P1, const bf16_t* __restrict__ VT, bf16_t* __restrict__ ymix) {
    const int b = bh >> 3, h = bh & 7, l31 = lane & 31, hi = lane >> 5, q0 = 256 * sb + 32 * wave, t = q0 + l31;
    const size_t rowb = (size_t)b * SEQ;
    bf16x8 qf[4];
    { const bf16_t* Qp = P1 + (rowb + q0 + l31) * L1P + h * 64 + 8 * hi;
#pragma unroll
      for (int kk = 0; kk < 4; ++kk) qf[kk] = *(const bf16x8*)(Qp + 16 * kk); }
    f32x16 o[2];
#pragma unroll
    for (int r = 0; r < 16; ++r) { o[0][r] = 0.f; o[1][r] = 0.f; }
    float cum = 1.f; bool done = false;
    volatile LAS unsigned* flags = (volatile LAS unsigned*)(lds + 2 * SB_STAGE);
    const bf16_t* gK = P1 + (rowb + (tid >> 3)) * L1P + 512 + h * 64 + (tid & 7) * 8;
    const bf16_t* gVt = VT + ((size_t)bh * 64 + (tid >> 3)) * SEQ + (tid & 7) * 8;
    const int lK = (tid >> 3) * (SBK_PITCH * 2) + (tid & 7) * 16, lVt = SBK_BYTES + (tid >> 3) * (MLV_PITCH * 2) + (tid & 7) * 16;
    const int top = 4 * sb + 3;
    v4u rk, rv;
    rk = *(const v4u*)(gK + (size_t)top * 64 * L1P); rv = *(const v4u*)(gVt + top * 64);
    *(LAS v4u*)(lds + lK) = rk; *(LAS u32x2*)(lds + lVt) = (u32x2){rv.x, rv.y}; *(LAS u32x2*)(lds + lVt + 8) = (u32x2){rv.z, rv.w};
    __syncthreads();
#pragma unroll 1
    for (int i = 0; i <= top; ++i) {
        const int step = top - i, nx = (step > 0) ? step - 1 : 0;
        rk = *(const v4u*)(gK + (size_t)nx * 64 * L1P); rv = *(const v4u*)(gVt + nx * 64);
        const LAS unsigned char* Kb = lds + (i & 1) * SB_STAGE;
        const LAS unsigned char* Vb = Kb + SBK_BYTES;
#pragma unroll
        for (int sub = 1; sub >= 0; --sub) {
            const int s0 = 64 * step + 32 * sub;
            if (s0 <= q0 && !done) {
                f32x16 acc;
#pragma unroll
                for (int r = 0; r < 16; ++r) acc[r] = 0.f;
#pragma unroll
                for (int kk = 0; kk < 4; ++kk) { const bf16x8 kf = *(const LAS bf16x8*)(Kb + (32 * sub + l31) * (SBK_PITCH * 2) + (16 * kk + 8 * hi) * 2); acc = MFMA32(kf, qf[kk], acc); }
                const bool diag = (s0 == q0);
                float bt[16], kp[16];
#pragma unroll
                for (int r = 0; r < 16; ++r) { const float ee = __builtin_amdgcn_exp2f(fminf(acc[r] * (-0.125f * 1.4426950408889634f), 100.f)); const float ri = __builtin_amdgcn_rcpf(1.f + ee);
                    float b_ = ri, k_ = ee * ri;
                    if (diag) { const bool valid = (s0 + crow(r, hi)) < t; b_ = valid ? b_ : 0.f; k_ = valid ? k_ : 1.f; }
                    bt[r] = b_; kp[r] = k_; }
                float e[16], T[4], U[4];
#pragma unroll
                for (int q = 0; q < 4; ++q) { e[4 * q + 3] = 1.f; e[4 * q + 2] = kp[4 * q + 3]; e[4 * q + 1] = e[4 * q + 2] * kp[4 * q + 2]; e[4 * q] = e[4 * q + 1] * kp[4 * q + 1]; T[q] = e[4 * q] * kp[4 * q]; }
#pragma unroll
                for (int q = 0; q < 4; ++q) U[q] = __shfl_xor(T[q], 32);
                { const float st2 = T[3], st1 = st2 * T[2], st0 = st1 * T[1]; const float su2 = U[3], su1 = su2 * U[2], su0 = su1 * U[1];
                  const float x0 = hi ? 1.f : U[0], x1 = hi ? 1.f : U[1], x2 = hi ? 1.f : U[2], x3 = hi ? 1.f : U[3];
                  const float off[4] = {cum * (st0 * su0 * x0), cum * (st1 * su1 * x1), cum * (st2 * su2 * x2), cum * x3};
#pragma unroll
                  for (int r = 0; r < 16; ++r) acc[r] = bt[r] * (off[r >> 2] * e[r]);
                  cum *= (st0 * T[0]) * (su0 * U[0]); }
                bf16x8 pf[2];
#pragma unroll
                for (int ks = 0; ks < 2; ++ks) { v4u w; w.x = cvtpk(acc[8 * ks], acc[8 * ks + 1]); w.y = cvtpk(acc[8 * ks + 2], acc[8 * ks + 3]); w.z = cvtpk(acc[8 * ks + 4], acc[8 * ks + 5]); w.w = cvtpk(acc[8 * ks + 6], acc[8 * ks + 7]); pf[ks] = __builtin_bit_cast(bf16x8, w); }
#pragma unroll
                for (int dt = 0; dt < 2; ++dt)
#pragma unroll
                    for (int ks = 0; ks < 2; ++ks) { const LAS unsigned char* vp = Vb + (32 * dt + l31) * (MLV_PITCH * 2) + (32 * sub + 16 * ks + 4 * hi) * 2;
                        const u32x2 x0 = *(const LAS u32x2*)vp, x1 = *(const LAS u32x2*)(vp + 16);
                        v4u a; a.x = x0.x; a.y = x0.y; a.z = x1.x; a.w = x1.y; o[dt] = MFMA32(__builtin_bit_cast(bf16x8, a), pf[ks], o[dt]); }
                done = __all(cum < 1e-35f);
            }
        }
        if (lane == 0) flags[(i & 1) * 8 + wave] = done ? 1u : 0u;
        LAS unsigned char* nb = lds + ((i + 1) & 1) * SB_STAGE;
        *(LAS v4u*)(nb + lK) = rk; *(LAS u32x2*)(nb + lVt) = (u32x2){rv.x, rv.y}; *(LAS u32x2*)(nb + lVt + 8) = (u32x2){rv.z, rv.w};
        __syncthreads();
        unsigned nd = 0;
#pragma unroll
        for (int w8 = 0; w8 < 8; ++w8) nd += flags[(i & 1) * 8 + w8];
        if (nd == 8u) break;
    }
    store_OT(o, 1.0f, (LAS bf16_t*)(lds + 2 * SB_STAGE + 256) + wave * (32 * STG_PITCH), ymix + (rowb + q0) * DM + h * 64, lane);
    __syncthreads();
}

constexpr int RW_RAWW = 0, RW_RAWA = 2048, RW_RS = 4096, RW_KS = 6144, RW_VS = 8192;
constexpr int RW_CH0 = 10240, RW_CHSZ = 11328;
constexpr int RW_YB = RW_CH0 + 2 * RW_CHSZ;
constexpr int RW_MIX = RW_YB + 1024;
static_assert((RW_MIX + 256) * 4 <= 146432, "rwkv LDS map");
__device__ __forceinline__ float tanh_fast(float x) { return 1.f - 2.f * __builtin_amdgcn_rcpf(1.f + __expf(2.f * x)); }
__device__ __forceinline__ float sigmoid_fast(float x) { return __builtin_amdgcn_rcpf(1.f + __expf(-x)); }

#define MFMA16(a, b, c) __builtin_amdgcn_mfma_f32_16x16x32_bf16((a), (b), (c), 0, 0, 0)
constexpr int RW2_CH0 = 0, RW2_YB = 2 * RW_CHSZ, RW2_MIX = RW2_YB + 1024, RW2_STG = RW2_MIX + 448;
static_assert((RW2_STG + 2 * 3072) * 4 <= 146432, "rwkv LDS map");
__device__ __forceinline__ void rwkv_phase_scan(LAS float* sm, int tid, int lane, int wave, int blk, const bf16_t* __restrict__ proj, const float* __restrict__ mix, const float* __restrict__ w0, const float* __restrict__ a0,
                                           const float* __restrict__ k_k, const float* __restrict__ k_a, const float* __restrict__ r_k, const bf16_t* __restrict__ W2T, const bf16_t* __restrict__ A2T, const bf16_t* __restrict__ G2T,
                                           float* __restrict__ yraw, bf16_t* __restrict__ gout, float* __restrict__ bonus_out) {
    const int chain = blk >> 1, half = blk & 1, b = chain >> 3, h = chain & 7, l15 = lane & 15, kg = lane >> 4;
    const size_t rowb = (size_t)b * SEQ;
    constexpr int NCHUNK = SEQ / 32;
    if (tid < 256) sm[RW2_MIX + tid] = mix[1536 + tid];
    else if (tid < 448) { const int q = tid - 256; sm[RW2_MIX + tid] = mix[512 * (q >> 6) + h * 64 + (q & 63)]; }
    __syncthreads();
#define RW_SH8(CUR, PRV, M0, M1, OUT, PZ) do { const unsigned cu_[4] = {(CUR).x, (CUR).y, (CUR).z, (CUR).w}, pu_[4] = {(PRV).x, (PRV).y, (PRV).z, (PRV).w}; \
        const float mm_[8] = {(M0)[0], (M0)[1], (M0)[2], (M0)[3], (M1)[0], (M1)[1], (M1)[2], (M1)[3]}; \
        _Pragma("unroll") for (int q = 0; q < 4; ++q) { const float c0 = bflo(cu_[q]), c1 = bfhi(cu_[q]), p0 = bflo(pu_[q]) * (PZ), p1 = bfhi(pu_[q]) * (PZ); \
            OUT[2 * q] = c0 + (p0 - c0) * mm_[2 * q]; OUT[2 * q + 1] = c1 + (p1 - c1) * mm_[2 * q + 1]; } } while (0)
    if (wave < 4) {
        const int iA = 8 * wave + kg, iB = iA + 4, jseg = l15;
        float A0 = 0.f, A1 = 0.f, A2 = 0.f, A3 = 0.f, B0 = 0.f, B1 = 0.f, B2 = 0.f, B3 = 0.f;
        __syncthreads();
#pragma unroll 1
        for (int ch = 0; ch < NCHUNK; ++ch) {
            const int t0 = ch * 32;
            const LAS float* CHb = sm + RW2_CH0 + (ch & 1) * RW_CHSZ + 4 * jseg;
            const LAS float* CHv = sm + RW2_CH0 + (ch & 1) * RW_CHSZ + 10240 + iA;
            const LAS float* CHs = sm + RW2_CH0 + (ch & 1) * RW_CHSZ + 11264;
            f32x4 a4 = *(const LAS f32x4*)(CHb + 4096), wr4 = *(const LAS f32x4*)(CHb + 8192), w4 = *(const LAS f32x4*)(CHb), b4 = *(const LAS f32x4*)(CHb + 6144), k4 = *(const LAS f32x4*)(CHb + 2048);
            float vA = CHv[0], vB = CHv[4]; f32x2_t sc = *(const LAS f32x2_t*)(CHs);
#pragma unroll 2
            for (int t = 0; t < 32; ++t) {
                const int tq = (t + 1) & 31;
                const f32x4 a4n = *(const LAS f32x4*)(CHb + 4096 + tq * 64), wr4n = *(const LAS f32x4*)(CHb + 8192 + tq * 64), w4n = *(const LAS f32x4*)(CHb + tq * 64),
                            b4n = *(const LAS f32x4*)(CHb + 6144 + tq * 64), k4n = *(const LAS f32x4*)(CHb + 2048 + tq * 64);
                const float vAn = CHv[tq * 32], vBn = CHv[tq * 32 + 4]; const f32x2_t scn = *(const LAS f32x2_t*)(CHs + 2 * tq);
                float d1A = (A0 * a4[0] + A1 * a4[1]) + (A2 * a4[2] + A3 * a4[3]), d1B = (B0 * a4[0] + B1 * a4[1]) + (B2 * a4[2] + B3 * a4[3]);
                float d2A = (A0 * wr4[0] + A1 * wr4[1]) + (A2 * wr4[2] + A3 * wr4[3]), d2B = (B0 * wr4[0] + B1 * wr4[1]) + (B2 * wr4[2] + B3 * wr4[3]);
                d1A = rowsum16(d1A); d1B = rowsum16(d1B); d2A = rowsum16(d2A); d2B = rowsum16(d2B);
                const float yA = d2A + d1A * sc[0] + vA * sc[1], yB = d2B + d1B * sc[0] + vB * sc[1];
                A0 = A0 * w4[0] + (d1A * b4[0] + vA * k4[0]); A1 = A1 * w4[1] + (d1A * b4[1] + vA * k4[1]); A2 = A2 * w4[2] + (d1A * b4[2] + vA * k4[2]); A3 = A3 * w4[3] + (d1A * b4[3] + vA * k4[3]);
                B0 = B0 * w4[0] + (d1B * b4[0] + vB * k4[0]); B1 = B1 * w4[1] + (d1B * b4[1] + vB * k4[1]); B2 = B2 * w4[2] + (d1B * b4[2] + vB * k4[2]); B3 = B3 * w4[3] + (d1B * b4[3] + vB * k4[3]);
                if (jseg == 0) { sm[RW2_YB + t * 32 + iA] = yA; sm[RW2_YB + t * 32 + iB] = yB; }
                a4 = a4n; wr4 = wr4n; w4 = w4n; b4 = b4n; k4 = k4n; vA = vAn; vB = vBn; sc = scn;
            }
            WSYNC();
            { const int tt = lane >> 1, hh = lane & 1; const f32x4 yv = *(const LAS f32x4*)(sm + RW2_YB + tt * 32 + 8 * wave + 4 * hh);
              *(f32x4*)(yraw + (rowb + t0 + tt) * 512 + h * 64 + half * 32 + 8 * wave + 4 * hh) = yv; }
            __syncthreads();
        }
    } else if (wave < 6) {
        const int tp = wave - 4, tb = 16 * tp;
        LAS float* stg = sm + RW2_STG + tp * 3072;
        float w0c[4], a0c[4], kkc[4], kac[4], rkc[4];
#pragma unroll
        for (int nt = 0; nt < 4; ++nt) { const int c = h * 64 + 16 * nt + l15; w0c[nt] = w0[c]; a0c[nt] = a0[c]; kkc[nt] = k_k[c]; kac[nt] = k_a[c]; rkc[nt] = r_k[c]; }
        v4u ld[20];
#define PREP_ISSUE(T0) do { const int t0_ = (T0); { const size_t r_ = rowb + t0_ + tb + l15; const size_t rp_ = (t0_ + tb + l15 == 0) ? r_ : r_ - 1; \
            _Pragma("unroll") for (int lo = 0; lo < 2; ++lo) _Pragma("unroll") for (int ks = 0; ks < 2; ++ks) { const int col = 1536 + 64 * lo + 32 * ks + 8 * kg; \
                ld[(lo * 2 + ks) * 2] = *(const v4u*)(proj + r_ * L0P + col); ld[(lo * 2 + ks) * 2 + 1] = *(const v4u*)(proj + rp_ * L0P + col); } } \
            _Pragma("unroll") for (int ar = 0; ar < 3; ++ar) _Pragma("unroll") for (int i = 0; i < 2; ++i) { const int p_ = lane + 64 * i, row_ = p_ >> 3, c8_ = p_ & 7; \
                const size_t r_ = rowb + t0_ + tb + row_; const size_t rp_ = (t0_ + tb + row_ == 0) ? r_ : r_ - 1; const int col = 512 * ar + h * 64 + 8 * c8_; \
                ld[8 + (ar * 2 + i) * 2] = *(const v4u*)(proj + r_ * L0P + col); ld[8 + (ar * 2 + i) * 2 + 1] = *(const v4u*)(proj + rp_ * L0P + col); } } while (0)
#define PREP_BUILD(T0, NB) do { const int t0_ = (T0); LAS float* CHn = sm + RW2_CH0 + (NB) * RW_CHSZ; \
            f32x4 accw[4], acca[4]; \
            _Pragma("unroll") for (int nt = 0; nt < 4; ++nt) { accw[nt] = (f32x4){0.f, 0.f, 0.f, 0.f}; acca[nt] = (f32x4){0.f, 0.f, 0.f, 0.f}; } \
            { const float pz_ = (t0_ + tb + l15 == 0) ? 0.f : 1.f; \
              _Pragma("unroll") for (int lo = 0; lo < 2; ++lo) _Pragma("unroll") for (int ks = 0; ks < 2; ++ks) { float s_[8]; \
                const f32x4 m0 = *(const LAS f32x4*)(sm + RW2_MIX + 64 * lo + 32 * ks + 8 * kg), m1 = *(const LAS f32x4*)(sm + RW2_MIX + 64 * lo + 32 * ks + 8 * kg + 4); \
                RW_SH8(ld[(lo * 2 + ks) * 2], ld[(lo * 2 + ks) * 2 + 1], m0, m1, s_, pz_); \
                if (lo == 0) { _Pragma("unroll") for (int j = 0; j < 8; ++j) s_[j] = tanh_fast(s_[j]); } \
                v4u aw; aw.x = cvtpk(s_[0], s_[1]); aw.y = cvtpk(s_[2], s_[3]); aw.z = cvtpk(s_[4], s_[5]); aw.w = cvtpk(s_[6], s_[7]); const bf16x8 af = __builtin_bit_cast(bf16x8, aw); \
                const bf16_t* WT = lo ? A2T : W2T; \
                _Pragma("unroll") for (int nt = 0; nt < 4; ++nt) { const bf16x8 bfr = *(const bf16x8*)(WT + (size_t)(h * 64 + 16 * nt + l15) * 64 + 32 * ks + 8 * kg); \
                    if (lo == 0) accw[nt] = MFMA16(af, bfr, accw[nt]); else acca[nt] = MFMA16(af, bfr, acca[nt]); } } } \
            _Pragma("unroll") for (int ar = 0; ar < 3; ++ar) _Pragma("unroll") for (int i = 0; i < 2; ++i) { const int p_ = lane + 64 * i, row_ = p_ >> 3, c8_ = p_ & 7; float s_[8]; \
                const float pz_ = (t0_ + tb + row_ == 0) ? 0.f : 1.f; const f32x4 m0 = *(const LAS f32x4*)(sm + RW2_MIX + 256 + ar * 64 + c8_ * 8), m1 = *(const LAS f32x4*)(sm + RW2_MIX + 256 + ar * 64 + c8_ * 8 + 4); \
                RW_SH8(ld[8 + (ar * 2 + i) * 2], ld[8 + (ar * 2 + i) * 2 + 1], m0, m1, s_, pz_); \
                *(LAS f32x4*)(stg + ar * 1024 + row_ * 64 + c8_ * 8) = (f32x4){s_[0], s_[1], s_[2], s_[3]}; *(LAS f32x4*)(stg + ar * 1024 + row_ * 64 + c8_ * 8 + 4) = (f32x4){s_[4], s_[5], s_[6], s_[7]}; } \
            WSYNC(); \
            PREP_ISSUE(((T0) + 32 < SEQ) ? (T0) + 32 : (T0)); \
            _Pragma("unroll") for (int rg = 0; rg < 4; ++rg) { const int tl = 4 * kg + rg, t = tb + tl; \
                float r_[4], k_[4], v_[4], kkv[4], nrm2 = 0.f; \
                _Pragma("unroll") for (int nt = 0; nt < 4; ++nt) { r_[nt] = stg[tl * 64 + 16 * nt + l15]; k_[nt] = stg[1024 + tl * 64 + 16 * nt + l15]; v_[nt] = stg[2048 + tl * 64 + 16 * nt + l15]; \
                    kkv[nt] = k_[nt] * kkc[nt]; nrm2 += kkv[nt] * kkv[nt]; } \
                nrm2 = rowsum16(nrm2); const float rn = __builtin_amdgcn_rsqf(fmaxf(nrm2, 1e-24f)); \
                float br = 0.f, kr = 0.f, bon = 0.f; \
                _Pragma("unroll") for (int nt = 0; nt < 4; ++nt) { const int j = 16 * nt + l15; \
                    const float wsum = w0c[nt] + accw[nt][rg]; const float logw = -softplus_fast(-wsum) - 0.5f; const float dec = __expf(-__expf(logw)); \
                    const float a_ = sigmoid_fast(a0c[nt] + acca[nt][rg]); const float kn = kkv[nt] * rn; \
                    const float k2 = k_[nt] * (1.f + (a_ - 1.f) * kac[nt]); const float bv = kn * a_; \
                    br += bv * r_[nt]; kr += k2 * r_[nt]; bon += r_[nt] * k2 * rkc[nt]; \
                    CHn[t * 64 + j] = dec; CHn[2048 + t * 64 + j] = k2; CHn[4096 + t * 64 + j] = -kn; CHn[6144 + t * 64 + j] = bv; CHn[8192 + t * 64 + j] = dec * r_[nt]; \
                    if ((nt >> 1) == half) CHn[10240 + t * 32 + (j & 31)] = v_[nt]; } \
                br = rowsum16(br); kr = rowsum16(kr); bon = rowsum16(bon); \
                if (l15 == 0) { CHn[11264 + 2 * t] = br; CHn[11264 + 2 * t + 1] = kr; if (half == 0) bonus_out[(rowb + t0_ + t) * 8 + h] = bon; } } \
            WSYNC(); } while (0)
        PREP_ISSUE(0);
        PREP_BUILD(0, 0);
        __syncthreads();
#pragma unroll 1
        for (int ch = 0; ch < NCHUNK; ++ch) {
            if (ch + 1 < NCHUNK) PREP_BUILD(ch * 32 + 32, (ch + 1) & 1);
            __syncthreads();
        }
#undef PREP_ISSUE
#undef PREP_BUILD
    } else {
        const int tp = wave - 6, tb = 16 * tp;
        v4u ld[8];
#define G_ISSUE(T0) do { const int t0_ = (T0); const size_t r_ = rowb + t0_ + tb + l15; const size_t rp_ = (t0_ + tb + l15 == 0) ? r_ : r_ - 1; \
            _Pragma("unroll") for (int ks = 0; ks < 4; ++ks) { const int col = 1664 + 32 * ks + 8 * kg; ld[2 * ks] = *(const v4u*)(proj + r_ * L0P + col); ld[2 * ks + 1] = *(const v4u*)(proj + rp_ * L0P + col); } } while (0)
#define G_BUILD(T0) do { const int t0_ = (T0); f32x4 accg[2] = {(f32x4){0.f, 0.f, 0.f, 0.f}, (f32x4){0.f, 0.f, 0.f, 0.f}}; const float pz_ = (t0_ + tb + l15 == 0) ? 0.f : 1.f; \
            _Pragma("unroll") for (int ks = 0; ks < 4; ++ks) { float s_[8]; \
                const f32x4 m0 = *(const LAS f32x4*)(sm + RW2_MIX + 128 + 32 * ks + 8 * kg), m1 = *(const LAS f32x4*)(sm + RW2_MIX + 128 + 32 * ks + 8 * kg + 4); \
                RW_SH8(ld[2 * ks], ld[2 * ks + 1], m0, m1, s_, pz_); \
                _Pragma("unroll") for (int j = 0; j < 8; ++j) s_[j] = sigmoid_fast(s_[j]); \
                v4u aw; aw.x = cvtpk(s_[0], s_[1]); aw.y = cvtpk(s_[2], s_[3]); aw.z = cvtpk(s_[4], s_[5]); aw.w = cvtpk(s_[6], s_[7]); const bf16x8 af = __builtin_bit_cast(bf16x8, aw); \
                _Pragma("unroll") for (int nt = 0; nt < 2; ++nt) { const bf16x8 bfr = *(const bf16x8*)(G2T + (size_t)(h * 64 + half * 32 + 16 * nt + l15) * 128 + 32 * ks + 8 * kg); accg[nt] = MFMA16(af, bfr, accg[nt]); } } \
            G_ISSUE(((T0) + 32 < SEQ) ? (T0) + 32 : (T0)); \
            _Pragma("unroll") for (int nt = 0; nt < 2; ++nt) _Pragma("unroll") for (int rg = 0; rg < 4; ++rg) \
                gout[(rowb + t0_ + tb + 4 * kg + rg) * 512 + h * 64 + half * 32 + 16 * nt + l15] = (bf16_t)f2bf(accg[nt][rg]); } while (0)
        G_ISSUE(0);
        G_BUILD(0);
        __syncthreads();
#pragma unroll 1
        for (int ch = 0; ch < NCHUNK; ++ch) {
            if (ch + 1 < NCHUNK) G_BUILD(ch * 32 + 32);
            __syncthreads();
        }
#undef G_ISSUE
#undef G_BUILD
    }
#undef RW_SH8
    __syncthreads();
}

constexpr int CK_BK = 0, CK_AR = 4608, CK_BBT = 9216, CK_KBT = 12288, CK_VT = 15360, CK_GC = 16896, CK_TT = 17152, CK_SLOT = 18688, CK_NSLOT = 6, CK_NBUILD = 5;
constexpr int CK_STG = CK_SLOT * CK_NSLOT;
constexpr int CK_MIX = CK_STG + CK_NBUILD * 6144;
constexpr int CK_FLAGS = CK_MIX + 448 * 4;
static_assert(CK_FLAGS + 64 <= 146432, "rwkv chunked LDS map");
__device__ __forceinline__ void rwkv_phase(LAS float* smf, int tid, int lane, int wave, int blk, const bf16_t* __restrict__ proj, const float* __restrict__ mix, const float* __restrict__ w0, const float* __restrict__ a0,
                                           const float* __restrict__ k_k, const float* __restrict__ k_a, const float* __restrict__ r_k, const bf16_t* __restrict__ W2T, const bf16_t* __restrict__ A2T, const bf16_t* __restrict__ G2T,
                                           float* __restrict__ yraw, bf16_t* __restrict__ gout, float* __restrict__ bonus_out) {
    LAS unsigned char* lds = (LAS unsigned char*)smf;
    LAS float* mixs = (LAS float*)(lds + CK_MIX);
    volatile LAS unsigned* flags = (volatile LAS unsigned*)(lds + CK_FLAGS);
    const int chain = blk >> 1, ihalf = blk & 1, b = chain >> 3, h = chain & 7, l15 = lane & 15, kg = lane >> 4, l31 = lane & 31, hi = lane >> 5;
    const size_t rowb = (size_t)b * SEQ;
    constexpr int NCH = SEQ / 16;
    if (tid < 256) mixs[tid] = mix[1536 + tid];
    else if (tid < 448) { const int q = tid - 256; mixs[tid] = mix[512 * (q >> 6) + h * 64 + (q & 63)]; }
    if (tid < 16) flags[tid] = (tid == 9) ? (unsigned)CK_NBUILD : 0u;
    for (int q = tid; q < CK_NSLOT * 384; q += NWAVES * 64) *(LAS unsigned*)(lds + (q / 384) * CK_SLOT + CK_TT + (q % 384) * 4) = 0u;
    __syncthreads();
#define RW_SH8(CUR, PRV, M0, M1, OUT, PZ) do { const unsigned cu_[4] = {(CUR).x, (CUR).y, (CUR).z, (CUR).w}, pu_[4] = {(PRV).x, (PRV).y, (PRV).z, (PRV).w}; \
        const float mm_[8] = {(M0)[0], (M0)[1], (M0)[2], (M0)[3], (M1)[0], (M1)[1], (M1)[2], (M1)[3]}; \
        _Pragma("unroll") for (int q = 0; q < 4; ++q) { const float c0 = bflo(cu_[q]), c1 = bfhi(cu_[q]), p0 = bflo(pu_[q]) * (PZ), p1 = bfhi(pu_[q]) * (PZ); \
            OUT[2 * q] = c0 + (p0 - c0) * mm_[2 * q]; OUT[2 * q + 1] = c1 + (p1 - c1) * mm_[2 * q + 1]; } } while (0)
    if (wave == 0) {
        f32x16 ST[2];
#pragma unroll
        for (int r = 0; r < 16; ++r) { ST[0][r] = 0.f; ST[1][r] = 0.f; }
#pragma unroll 1
        for (int k = 0; k < NCH; ++k) {
#if defined(PROBE_STAMPS)
            const unsigned tw0_ = (unsigned)__builtin_amdgcn_s_memrealtime();
#endif
            { const unsigned want = (unsigned)(k + 1); const int sl = k % CK_NSLOT; while (flags[sl] != want) __builtin_amdgcn_s_sleep(1); }
#if defined(PROBE_STAMPS)
            if (blk == 0 && lane == 0) ((volatile LAS unsigned*)(lds + 146432 + 320))[16 + 24] += (unsigned)__builtin_amdgcn_s_memrealtime() - tw0_;
#endif
            asm volatile("" ::: "memory");
            const LAS unsigned char* im = lds + (k % CK_NSLOT) * CK_SLOT;
            f32x16 G;
#pragma unroll
            for (int r = 0; r < 16; ++r) G[r] = 0.f;
#pragma unroll
            for (int kk = 0; kk < 4; ++kk) { const bf16x8 fa = *(const LAS bf16x8*)(im + CK_BK + l31 * 144 + (16 * kk + 8 * hi) * 2), fb = *(const LAS bf16x8*)(im + CK_AR + l31 * 144 + (16 * kk + 8 * hi) * 2); G = MFMA32(fa, fb, G); }
            { const int tcol = l31 & 15; const bool strict = l31 < 16;
#pragma unroll
              for (int r = 0; r < 16; ++r) { const int srow = crow(r & 7, hi); const bool keep = strict ? (srow < tcol) : (srow <= tcol); G[r] = keep ? G[r] : 0.f; } }
            const bf16x8 gB = pack8(G[0], G[1], G[2], G[3], G[4], G[5], G[6], G[7]), gK = pack8(G[8], G[9], G[10], G[11], G[12], G[13], G[14], G[15]);
            f32x16 XT;
#pragma unroll
            for (int r = 0; r < 16; ++r) XT[r] = 0.f;
#pragma unroll
            for (int jt = 0; jt < 2; ++jt)
#pragma unroll
                for (int sp = 0; sp < 2; ++sp) { const LAS unsigned char* ap = im + CK_AR + l31 * 144 + (32 * jt + 16 * sp + 4 * hi) * 2;
                    const u32x2 x0 = *(const LAS u32x2*)ap, x1 = *(const LAS u32x2*)(ap + 16); v4u aw; aw.x = x0.x; aw.y = x0.y; aw.z = x1.x; aw.w = x1.y;
                    const bf16x8 sb_ = pack8(ST[jt][8 * sp], ST[jt][8 * sp + 1], ST[jt][8 * sp + 2], ST[jt][8 * sp + 3], ST[jt][8 * sp + 4], ST[jt][8 * sp + 5], ST[jt][8 * sp + 6], ST[jt][8 * sp + 7]);
                    XT = MFMA32(__builtin_bit_cast(bf16x8, aw), sb_, XT); }
            bf16x8 vP;
            { const LAS unsigned char* vp = im + CK_VT + l31 * 48 + (4 * hi) * 2; const u32x2 x0 = *(const LAS u32x2*)vp, x1 = *(const LAS u32x2*)(vp + 16); v4u vw; vw.x = x0.x; vw.y = x0.y; vw.z = x1.x; vw.w = x1.y;
              vP = __builtin_bit_cast(bf16x8, vw); XT = MFMA32(gK, vP, XT); }
            bf16x8 uP;
            { const LAS unsigned char* tp = im + CK_TT + l31 * 48 + (4 * hi) * 2; const u32x2 x0 = *(const LAS u32x2*)tp, x1 = *(const LAS u32x2*)(tp + 16); v4u tw; tw.x = x0.x; tw.y = x0.y; tw.z = x1.x; tw.w = x1.y;
              f32x16 UT;
#pragma unroll
              for (int r = 0; r < 16; ++r) UT[r] = 0.f;
              UT = MFMA32(__builtin_bit_cast(bf16x8, tw), pack8(XT[0], XT[1], XT[2], XT[3], XT[4], XT[5], XT[6], XT[7]), UT);
              uP = pack8(UT[0], UT[1], UT[2], UT[3], UT[4], UT[5], UT[6], UT[7]); }
            XT = MFMA32(gB, uP, XT);
            { float* yp = yraw + (rowb + 16 * k) * 512 + h * 64 + 32 * ihalf + l31;
#pragma unroll
              for (int q = 0; q < 8; ++q) yp[(size_t)crow(q, hi) * 512] = XT[8 + q]; }
            { const LAS float* gc = (const LAS float*)(im + CK_GC);
#pragma unroll
              for (int jt = 0; jt < 2; ++jt)
#pragma unroll
                  for (int r = 0; r < 16; ++r) ST[jt][r] *= gc[32 * jt + crow(r, hi)]; }
#pragma unroll
            for (int jt = 0; jt < 2; ++jt) { const LAS unsigned char* bp = im + CK_BBT + (32 * jt + l31) * 48 + (4 * hi) * 2; const LAS unsigned char* kp = im + CK_KBT + (32 * jt + l31) * 48 + (4 * hi) * 2;
                const u32x2 b0 = *(const LAS u32x2*)bp, b1 = *(const LAS u32x2*)(bp + 16), k0 = *(const LAS u32x2*)kp, k1 = *(const LAS u32x2*)(kp + 16);
                v4u a1; a1.x = b0.x; a1.y = b0.y; a1.z = b1.x; a1.w = b1.y; v4u a2; a2.x = k0.x; a2.y = k0.y; a2.z = k1.x; a2.w = k1.y;
                ST[jt] = MFMA32(__builtin_bit_cast(bf16x8, a1), uP, ST[jt]); ST[jt] = MFMA32(__builtin_bit_cast(bf16x8, a2), vP, ST[jt]); }
            WSYNC();
            if (lane == 0) flags[8] = (unsigned)(k + 1);
        }
    } else if (wave <= CK_NBUILD) {
        const int pw = wave - 1;
        LAS bf16_t* stg = (LAS bf16_t*)(lds + CK_STG) + pw * 3072;
        float w0c[4], a0c[4], kkc[4], kac[4], rkc[4];
#pragma unroll
        for (int nt = 0; nt < 4; ++nt) { const int c = h * 64 + 16 * nt + l15; w0c[nt] = w0[c]; a0c[nt] = a0[c]; kkc[nt] = k_k[c]; kac[nt] = k_a[c]; rkc[nt] = r_k[c]; }
        v4u ld[20];
#define CK_ISSUE_A(T0) do { const int t0_ = (T0); const size_t r_ = rowb + t0_ + l15; const size_t rp_ = (t0_ + l15 == 0) ? r_ : r_ - 1; \
            _Pragma("unroll") for (int lo = 0; lo < 2; ++lo) _Pragma("unroll") for (int ks = 0; ks < 2; ++ks) { const int col = 1536 + 64 * lo + 32 * ks + 8 * kg; \
                ld[(lo * 2 + ks) * 2] = *(const v4u*)(proj + r_ * L0P + col); ld[(lo * 2 + ks) * 2 + 1] = *(const v4u*)(proj + rp_ * L0P + col); } } while (0)
#define CK_ISSUE_B(T0) do { const int t0_ = (T0); \
            _Pragma("unroll") for (int ar = 0; ar < 3; ++ar) _Pragma("unroll") for (int i = 0; i < 2; ++i) { const int p_ = lane + 64 * i, row_ = p_ >> 3, c8_ = p_ & 7; \
                const size_t r_ = rowb + t0_ + row_; const size_t rp_ = (t0_ + row_ == 0) ? r_ : r_ - 1; const int col = 512 * ar + h * 64 + 8 * c8_; \
                ld[8 + (ar * 2 + i) * 2] = *(const v4u*)(proj + r_ * L0P + col); ld[8 + (ar * 2 + i) * 2 + 1] = *(const v4u*)(proj + rp_ * L0P + col); } } while (0)
#define CK_ISSUE(T0) do { CK_ISSUE_A(T0); CK_ISSUE_B(T0); } while (0)
        CK_ISSUE(16 * pw);
        int k = pw;
#pragma unroll 1
        while (k < NCH) {
            const int t0 = 16 * k; int kn;
#if defined(PROBE_STAMPS)
            const unsigned ts0_ = (unsigned)__builtin_amdgcn_s_memrealtime();
#endif
            f32x4 accw[4], acca[4];
#pragma unroll
            for (int nt = 0; nt < 4; ++nt) { accw[nt] = (f32x4){0.f, 0.f, 0.f, 0.f}; acca[nt] = (f32x4){0.f, 0.f, 0.f, 0.f}; }
            { const float pz_ = (t0 + l15 == 0) ? 0.f : 1.f;
#pragma unroll
              for (int lo = 0; lo < 2; ++lo)
#pragma unroll
                for (int ks = 0; ks < 2; ++ks) { float s_[8];
                    const f32x4 m0 = *(const LAS f32x4*)(mixs + 64 * lo + 32 * ks + 8 * kg), m1 = *(const LAS f32x4*)(mixs + 64 * lo + 32 * ks + 8 * kg + 4);
                    RW_SH8(ld[(lo * 2 + ks) * 2], ld[(lo * 2 + ks) * 2 + 1], m0, m1, s_, pz_);
                    if (lo == 0) {
#pragma unroll
                        for (int j = 0; j < 8; ++j) s_[j] = tanh_fast(s_[j]); }
                    const bf16x8 af = pack8(s_[0], s_[1], s_[2], s_[3], s_[4], s_[5], s_[6], s_[7]);
                    const bf16_t* WT = lo ? A2T : W2T;
#pragma unroll
                    for (int nt = 0; nt < 4; ++nt) { const bf16x8 bfr = *(const bf16x8*)(WT + (size_t)(h * 64 + 16 * nt + l15) * 64 + 32 * ks + 8 * kg);
                        if (lo == 0) accw[nt] = MFMA16(af, bfr, accw[nt]); else acca[nt] = MFMA16(af, bfr, acca[nt]); } } }
#pragma unroll
            for (int ar = 0; ar < 3; ++ar)
#pragma unroll
                for (int i = 0; i < 2; ++i) { const int p_ = lane + 64 * i, row_ = p_ >> 3, c8_ = p_ & 7; float s_[8];
                    const float pz_ = (t0 + row_ == 0) ? 0.f : 1.f; const f32x4 m0 = *(const LAS f32x4*)(mixs + 256 + ar * 64 + c8_ * 8), m1 = *(const LAS f32x4*)(mixs + 256 + ar * 64 + c8_ * 8 + 4);
                    RW_SH8(ld[8 + (ar * 2 + i) * 2], ld[8 + (ar * 2 + i) * 2 + 1], m0, m1, s_, pz_);
                    *(LAS bf16x8*)(stg + ar * 1024 + row_ * 64 + c8_ * 8) = pack8(s_[0], s_[1], s_[2], s_[3], s_[4], s_[5], s_[6], s_[7]); }
            WSYNC();
#if defined(PROBE_STAMPS)
            if (blk == 0 && wave == 1 && lane == 0) ((volatile LAS unsigned*)(lds + 146432 + 320))[16 + 26] += (unsigned)__builtin_amdgcn_s_memrealtime() - ts0_;
#endif
#if defined(PROBE_STAMPS)
            const unsigned tb0_ = (unsigned)__builtin_amdgcn_s_memrealtime();
#endif
            { const int need = k - (CK_NSLOT - 1); if (need > 0) { while ((int)flags[8] < need) __builtin_amdgcn_s_sleep(2); } }
#if defined(PROBE_STAMPS)
            if (blk == 0 && wave == 1 && lane == 0) ((volatile LAS unsigned*)(lds + 146432 + 320))[16 + 25] += (unsigned)__builtin_amdgcn_s_memrealtime() - tb0_;
#endif
            asm volatile("" ::: "memory");
            LAS unsigned char* im = lds + (k % CK_NSLOT) * CK_SLOT;
#if defined(PROBE_STAMPS)
            const unsigned ts1_ = (unsigned)__builtin_amdgcn_s_memrealtime();
#endif
            float lwv[4][4], av[4][4], knv[4][4];
#pragma unroll
            for (int rg = 0; rg < 4; ++rg) { const int tl = 4 * kg + rg;
                float kkv[4], nrm2 = 0.f, vv[4], rr_[4], kr_[4];
#pragma unroll
                for (int nt = 0; nt < 4; ++nt) { rr_[nt] = bf2f(stg[tl * 64 + 16 * nt + l15]); kr_[nt] = bf2f(stg[1024 + tl * 64 + 16 * nt + l15]); vv[nt] = bf2f(stg[2048 + tl * 64 + 16 * nt + l15]);
                    kkv[nt] = kr_[nt] * kkc[nt]; nrm2 += kkv[nt] * kkv[nt]; }
                nrm2 = rowsum16(nrm2); const float rn = __builtin_amdgcn_rsqf(fmaxf(nrm2, 1e-24f));
                float bon = 0.f;
#pragma unroll
                for (int nt = 0; nt < 4; ++nt) {
                    const float wsum = w0c[nt] + accw[nt][rg]; lwv[nt][rg] = -0.6065306597126334f * sigmoid_fast(wsum);
                    const float a_ = sigmoid_fast(a0c[nt] + acca[nt][rg]); av[nt][rg] = a_; knv[nt][rg] = kkv[nt] * rn;
                    const float k2 = kr_[nt] * (1.f + (a_ - 1.f) * kac[nt]); stg[1024 + tl * 64 + 16 * nt + l15] = bf1(k2);
                    bon += rr_[nt] * k2 * rkc[nt];
                    if ((nt >> 1) == ihalf) *(LAS bf16_t*)(im + CK_VT + (16 * (nt & 1) + l15) * 48 + tl * 2) = bf1(vv[nt]);
                }
                bon = rowsum16(bon);
                if (l15 == 0 && ihalf == 0) bonus_out[(rowb + t0 + tl) * 8 + h] = bon;
            }
            { unsigned g_ = 0; if (lane == 0) g_ = __hip_atomic_fetch_add((LAS unsigned*)(lds + CK_FLAGS + 36), 1u, __ATOMIC_RELAXED, __HIP_MEMORY_SCOPE_WORKGROUP);
              kn = (int)__builtin_amdgcn_readfirstlane(g_); }
            CK_ISSUE_A((kn < NCH) ? 16 * kn : t0);
#pragma unroll
            for (int nt = 0; nt < 4; ++nt) {
                float L[4]; L[0] = lwv[nt][0]; L[1] = L[0] + lwv[nt][1]; L[2] = L[1] + lwv[nt][2]; L[3] = L[2] + lwv[nt][3];
                const float T0 = __shfl(L[3], l15), T1 = __shfl(L[3], 16 + l15), T2 = __shfl(L[3], 32 + l15), T3 = __shfl(L[3], 48 + l15);
                const float off = (kg > 0 ? T0 : 0.f) + (kg > 1 ? T1 : 0.f) + (kg > 2 ? T2 : 0.f), LC = (T0 + T1) + (T2 + T3);
                const int j = 16 * nt + l15;
                unsigned bb2[2], kb2[2];
                const float gC = __expf(LC); float eprev = __expf(off);
#pragma unroll
                for (int rg = 0; rg < 4; ++rg) { const int tl = 4 * kg + rg; const float Lt = off + L[rg], e1 = __expf(Lt), e2 = __builtin_amdgcn_rcpf(e1), e3 = eprev, e4 = gC * e2; eprev = e1;
                    const float kn = knv[nt][rg], bvv = kn * av[nt][rg], k2 = bf2f(stg[1024 + tl * 64 + j]), rr2 = bf2f(stg[tl * 64 + j]);
                    *(LAS bf16_t*)(im + CK_BK + tl * 144 + j * 2) = bf1(bvv * e2); *(LAS bf16_t*)(im + CK_BK + (16 + tl) * 144 + j * 2) = bf1(k2 * e2);
                    *(LAS bf16_t*)(im + CK_AR + tl * 144 + j * 2) = bf1(-kn * e3); *(LAS bf16_t*)(im + CK_AR + (16 + tl) * 144 + j * 2) = bf1(rr2 * e1);
                    const unsigned bq = bf1(bvv * e4), kq = bf1(k2 * e4);
                    if (rg & 1) { bb2[rg >> 1] |= bq << 16; kb2[rg >> 1] |= kq << 16; } else { bb2[rg >> 1] = bq; kb2[rg >> 1] = kq; } }
                *(LAS u32x2*)(im + CK_BBT + j * 48 + (4 * kg) * 2) = (u32x2){bb2[0], bb2[1]}; *(LAS u32x2*)(im + CK_KBT + j * 48 + (4 * kg) * 2) = (u32x2){kb2[0], kb2[1]};
                if (kg == 0) *(LAS float*)(im + CK_GC + j * 4) = gC;
            }
            WSYNC();
#if defined(PROBE_STAMPS)
            const unsigned ts2_ = (unsigned)__builtin_amdgcn_s_memrealtime();
            if (blk == 0 && wave == 1 && lane == 0) ((volatile LAS unsigned*)(lds + 146432 + 320))[16 + 27] += ts2_ - ts1_;
#endif
            {
                f32x4 nacc = {0.f, 0.f, 0.f, 0.f};
#pragma unroll
                for (int ks = 0; ks < 2; ++ks) { const bf16x8 fa = *(const LAS bf16x8*)(im + CK_BK + l15 * 144 + (32 * ks + 8 * kg) * 2), fb = *(const LAS bf16x8*)(im + CK_AR + l15 * 144 + (32 * ks + 8 * kg) * 2); nacc = MFMA16(fa, fb, nacc); }
#pragma unroll
                for (int rg = 0; rg < 4; ++rg) nacc[rg] = ((4 * kg + rg) < l15) ? nacc[rg] : 0.f;
                float Tr[16];
#pragma unroll
                for (int t = 0; t < 16; ++t) { float acc_ = (l15 == t) ? 1.f : 0.f;
#pragma unroll
                    for (int s2 = 0; s2 < t; ++s2) acc_ += Tr[s2] * rl(nacc[s2 & 3], t + 16 * (s2 >> 2));
                    Tr[t] = acc_; }
                if (kg == 0) {
#pragma unroll
                    for (int t = 0; t < 16; ++t) *(LAS bf16_t*)(im + CK_TT + t * 48 + l15 * 2) = bf1(Tr[t]); }
            }
            WSYNC();
#if defined(PROBE_STAMPS)
            if (blk == 0 && wave == 1 && lane == 0) ((volatile LAS unsigned*)(lds + 146432 + 320))[16 + 28] += (unsigned)__builtin_amdgcn_s_memrealtime() - ts2_;
#endif
            if (lane == 0) flags[k % CK_NSLOT] = (unsigned)(k + 1);
            CK_ISSUE_B((kn < NCH) ? 16 * kn : t0);
            k = kn;
        }
#undef CK_ISSUE
#undef CK_ISSUE_A
#undef CK_ISSUE_B
    } else {
        const int gq = wave - 6;
        v4u ld[8];
#define G_ISSUE(T0) do { const int t0_ = (T0); const size_t r_ = rowb + t0_ + l15; const size_t rp_ = (t0_ + l15 == 0) ? r_ : r_ - 1; \
            _Pragma("unroll") for (int ks = 0; ks < 4; ++ks) { const int col = 1664 + 32 * ks + 8 * kg; ld[2 * ks] = *(const v4u*)(proj + r_ * L0P + col); ld[2 * ks + 1] = *(const v4u*)(proj + rp_ * L0P + col); } } while (0)
        G_ISSUE(16 * gq);
#pragma unroll 1
        for (int k = gq; k < NCH; k += 2) {
            const int t0 = 16 * k;
            f32x4 accg[2] = {(f32x4){0.f, 0.f, 0.f, 0.f}, (f32x4){0.f, 0.f, 0.f, 0.f}}; const float pz_ = (t0 + l15 == 0) ? 0.f : 1.f;
#pragma unroll
            for (int ks = 0; ks < 4; ++ks) { float s_[8];
                const f32x4 m0 = *(const LAS f32x4*)(mixs + 128 + 32 * ks + 8 * kg), m1 = *(const LAS f32x4*)(mixs + 128 + 32 * ks + 8 * kg + 4);
                RW_SH8(ld[2 * ks], ld[2 * ks + 1], m0, m1, s_, pz_);
#pragma unroll
                for (int j = 0; j < 8; ++j) s_[j] = sigmoid_fast(s_[j]);
                const bf16x8 af = pack8(s_[0], s_[1], s_[2], s_[3], s_[4], s_[5], s_[6], s_[7]);
#pragma unroll
                for (int nt = 0; nt < 2; ++nt) { const bf16x8 bfr = *(const bf16x8*)(G2T + (size_t)(h * 64 + ihalf * 32 + 16 * nt + l15) * 128 + 32 * ks + 8 * kg); accg[nt] = MFMA16(af, bfr, accg[nt]); } }
            G_ISSUE((k + 2 < NCH) ? t0 + 32 : t0);
#pragma unroll
            for (int nt = 0; nt < 2; ++nt)
#pragma unroll
                for (int rg = 0; rg < 4; ++rg) gout[(rowb + t0 + 4 * kg + rg) * 512 + h * 64 + ihalf * 32 + 16 * nt + l15] = bf1(accg[nt][rg]);
        }
#undef G_ISSUE
    }
#undef RW_SH8
    __syncthreads();
}

constexpr int CC_BK = 0, CC_AR = 4608, CC_BBT = 9216, CC_KBT = 11776, CC_VT = 14336, CC_GC = 16896, CC_TT = 17152, CC_SLOT = 18432, CC_NSLOT = 6, CC_NBUILD = 6;
constexpr int CC_STG = CC_SLOT * CC_NSLOT;
constexpr int CC_MIX = CC_STG + CC_NBUILD * 4096;
constexpr int CC_FLAGS = CC_MIX + 448 * 4;
static_assert(CC_FLAGS + 64 <= 146432, "rwkv chain LDS map");
__device__ __forceinline__ void rwkv_phase_chain(LAS float* smf, int tid, int lane, int wave, int blk, const bf16_t* __restrict__ proj, const float* __restrict__ mix, const float* __restrict__ w0, const float* __restrict__ a0,
                                           const float* __restrict__ k_k, const float* __restrict__ k_a, const float* __restrict__ r_k, const bf16_t* __restrict__ W2T, const bf16_t* __restrict__ A2T, const bf16_t* __restrict__ G2T,
                                           float* __restrict__ yraw, bf16_t* __restrict__ gout, float* __restrict__ bonus_out) {
    LAS unsigned char* lds = (LAS unsigned char*)smf;
    LAS float* mixs = (LAS float*)(lds + CC_MIX);
    volatile LAS unsigned* flags = (volatile LAS unsigned*)(lds + CC_FLAGS);
    const int chain = blk, b = chain >> 3, h = chain & 7, l15 = lane & 15, kg = lane >> 4, l31 = lane & 31, hi = lane >> 5;
    const size_t rowb = (size_t)b * SEQ;
    constexpr int NCH = SEQ / 16;
    if (tid < 256) mixs[tid] = mix[1536 + tid];
    else if (tid < 448) { const int q = tid - 256; mixs[tid] = mix[512 * (q >> 6) + h * 64 + (q & 63)]; }
    if (tid < 16) flags[tid] = (tid == 10) ? (unsigned)CC_NBUILD : 0u;
    for (int q = tid; q < CC_NSLOT * 320; q += NWAVES * 64) *(LAS unsigned*)(lds + (q / 320) * CC_SLOT + CC_TT + (q % 320) * 4) = 0u;
    __syncthreads();
#define RW_SH8(CUR, PRV, M0, M1, OUT, PZ) do { const unsigned cu_[4] = {(CUR).x, (CUR).y, (CUR).z, (CUR).w}, pu_[4] = {(PRV).x, (PRV).y, (PRV).z, (PRV).w}; \
        const float mm_[8] = {(M0)[0], (M0)[1], (M0)[2], (M0)[3], (M1)[0], (M1)[1], (M1)[2], (M1)[3]}; \
        _Pragma("unroll") for (int q = 0; q < 4; ++q) { const float c0 = bflo(cu_[q]), c1 = bfhi(cu_[q]), p0 = bflo(pu_[q]) * (PZ), p1 = bfhi(pu_[q]) * (PZ); \
            OUT[2 * q] = c0 + (p0 - c0) * mm_[2 * q]; OUT[2 * q + 1] = c1 + (p1 - c1) * mm_[2 * q + 1]; } } while (0)
    if (wave < 2) {
        const int ihalf = wave;
        f32x16 ST[2];
#pragma unroll
        for (int r = 0; r < 16; ++r) { ST[0][r] = 0.f; ST[1][r] = 0.f; }
#pragma unroll 1
        for (int k = 0; k < NCH; ++k) {
            { const unsigned want = (unsigned)(k + 1); const int sl = k % CC_NSLOT; while (flags[sl] != want) __builtin_amdgcn_s_sleep(1); }
            asm volatile("" ::: "memory");
            const LAS unsigned char* im = lds + (k % CC_NSLOT) * CC_SLOT;
            f32x16 G;
#pragma unroll
            for (int r = 0; r < 16; ++r) G[r] = 0.f;
#pragma unroll
            for (int kk = 0; kk < 4; ++kk) { const bf16x8 fa = *(const LAS bf16x8*)(im + CC_BK + l31 * 144 + (16 * kk + 8 * hi) * 2), fb = *(const LAS bf16x8*)(im + CC_AR + l31 * 144 + (16 * kk + 8 * hi) * 2); G = MFMA32(fa, fb, G); }
            { const int tcol = l31 & 15; const bool strict = l31 < 16;
#pragma unroll
              for (int r = 0; r < 16; ++r) { const int srow = crow(r & 7, hi); const bool keep = strict ? (srow < tcol) : (srow <= tcol); G[r] = keep ? G[r] : 0.f; } }
            const bf16x8 gB = pack8(G[0], G[1], G[2], G[3], G[4], G[5], G[6], G[7]), gK = pack8(G[8], G[9], G[10], G[11], G[12], G[13], G[14], G[15]);
            f32x16 XT;
#pragma unroll
            for (int r = 0; r < 16; ++r) XT[r] = 0.f;
#pragma unroll
            for (int jt = 0; jt < 2; ++jt)
#pragma unroll
                for (int sp = 0; sp < 2; ++sp) { const LAS unsigned char* ap = im + CC_AR + l31 * 144 + (32 * jt + 16 * sp + 4 * hi) * 2;
                    const u32x2 x0 = *(const LAS u32x2*)ap, x1 = *(const LAS u32x2*)(ap + 16); v4u aw; aw.x = x0.x; aw.y = x0.y; aw.z = x1.x; aw.w = x1.y;
                    const bf16x8 sb_ = pack8(ST[jt][8 * sp], ST[jt][8 * sp + 1], ST[jt][8 * sp + 2], ST[jt][8 * sp + 3], ST[jt][8 * sp + 4], ST[jt][8 * sp + 5], ST[jt][8 * sp + 6], ST[jt][8 * sp + 7]);
                    XT = MFMA32(__builtin_bit_cast(bf16x8, aw), sb_, XT); }
            bf16x8 vP;
            { const LAS unsigned char* vp = im + CC_VT + (32 * ihalf + l31) * 40 + (4 * hi) * 2; const u32x2 x0 = *(const LAS u32x2*)vp, x1 = *(const LAS u32x2*)(vp + 16); v4u vw; vw.x = x0.x; vw.y = x0.y; vw.z = x1.x; vw.w = x1.y;
              vP = __builtin_bit_cast(bf16x8, vw); XT = MFMA32(gK, vP, XT); }
            bf16x8 uP;
            { const LAS unsigned char* tp = im + CC_TT + l31 * 40 + (4 * hi) * 2; const u32x2 x0 = *(const LAS u32x2*)tp, x1 = *(const LAS u32x2*)(tp + 16); v4u tw; tw.x = x0.x; tw.y = x0.y; tw.z = x1.x; tw.w = x1.y;
              f32x16 UT;
#pragma unroll
              for (int r = 0; r < 16; ++r) UT[r] = 0.f;
              UT = MFMA32(__builtin_bit_cast(bf16x8, tw), pack8(XT[0], XT[1], XT[2], XT[3], XT[4], XT[5], XT[6], XT[7]), UT);
              uP = pack8(UT[0], UT[1], UT[2], UT[3], UT[4], UT[5], UT[6], UT[7]); }
            XT = MFMA32(gB, uP, XT);
            { float* yp = yraw + (rowb + 16 * k) * 512 + h * 64 + 32 * ihalf + l31;
#pragma unroll
              for (int q = 0; q < 8; ++q) yp[(size_t)crow(q, hi) * 512] = XT[8 + q]; }
            { const LAS float* gc = (const LAS float*)(im + CC_GC);
#pragma unroll
              for (int jt = 0; jt < 2; ++jt)
#pragma unroll
                  for (int r = 0; r < 16; ++r) ST[jt][r] *= gc[32 * jt + crow(r, hi)]; }
#pragma unroll
            for (int jt = 0; jt < 2; ++jt) { const LAS unsigned char* bp = im + CC_BBT + (32 * jt + l31) * 40 + (4 * hi) * 2; const LAS unsigned char* kp = im + CC_KBT + (32 * jt + l31) * 40 + (4 * hi) * 2;
                const u32x2 b0 = *(const LAS u32x2*)bp, b1 = *(const LAS u32x2*)(bp + 16), k0 = *(const LAS u32x2*)kp, k1 = *(const LAS u32x2*)(kp + 16);
                v4u a1; a1.x = b0.x; a1.y = b0.y; a1.z = b1.x; a1.w = b1.y; v4u a2; a2.x = k0.x; a2.y = k0.y; a2.z = k1.x; a2.w = k1.y;
                ST[jt] = MFMA32(__builtin_bit_cast(bf16x8, a1), uP, ST[jt]); ST[jt] = MFMA32(__builtin_bit_cast(bf16x8, a2), vP, ST[jt]); }
            WSYNC();
            if (lane == 0) flags[8 + ihalf] = (unsigned)(k + 1);
        }
    } else {
        const int pw = wave - 2;
        LAS bf16_t* stg = (LAS bf16_t*)(lds + CC_STG) + pw * 2048;
        v4u ld[20];
#define CC_ISSUE_A(T0) do { const int t0_ = (T0); const size_t r_ = rowb + t0_ + l15; const size_t rp_ = (t0_ + l15 == 0) ? r_ : r_ - 1; \
            _Pragma("unroll") for (int lo = 0; lo < 2; ++lo) _Pragma("unroll") for (int ks = 0; ks < 2; ++ks) { const int col = 1536 + 64 * lo + 32 * ks + 8 * kg; \
                ld[(lo * 2 + ks) * 2] = *(const v4u*)(proj + r_ * L0P + col); ld[(lo * 2 + ks) * 2 + 1] = *(const v4u*)(proj + rp_ * L0P + col); } } while (0)
#define CC_ISSUE_B(T0) do { const int t0_ = (T0); \
            _Pragma("unroll") for (int ar = 0; ar < 3; ++ar) _Pragma("unroll") for (int i = 0; i < 2; ++i) { const int p_ = lane + 64 * i, row_ = p_ >> 3, c8_ = p_ & 7; \
                const size_t r_ = rowb + t0_ + row_; const size_t rp_ = (t0_ + row_ == 0) ? r_ : r_ - 1; const int col = 512 * ar + h * 64 + 8 * c8_; \
                ld[8 + (ar * 2 + i) * 2] = *(const v4u*)(proj + r_ * L0P + col); ld[8 + (ar * 2 + i) * 2 + 1] = *(const v4u*)(proj + rp_ * L0P + col); } } while (0)
#define CC_ISSUE(T0) do { CC_ISSUE_A(T0); CC_ISSUE_B(T0); } while (0)
        CC_ISSUE(16 * pw);
        int k = pw;
#pragma unroll 1
        while (k < NCH) {
            const int t0 = 16 * k; int kn;
            f32x4 accw[4], acca[4];
#pragma unroll
            for (int nt = 0; nt < 4; ++nt) { accw[nt] = (f32x4){0.f, 0.f, 0.f, 0.f}; acca[nt] = (f32x4){0.f, 0.f, 0.f, 0.f}; }
            { const float pz_ = (t0 + l15 == 0) ? 0.f : 1.f;
#pragma unroll
              for (int lo = 0; lo < 2; ++lo)
#pragma unroll
                for (int ks = 0; ks < 2; ++ks) { float s_[8];
                    const f32x4 m0 = *(const LAS f32x4*)(mixs + 64 * lo + 32 * ks + 8 * kg), m1 = *(const LAS f32x4*)(mixs + 64 * lo + 32 * ks + 8 * kg + 4);
                    RW_SH8(ld[(lo * 2 + ks) * 2], ld[(lo * 2 + ks) * 2 + 1], m0, m1, s_, pz_);
                    if (lo == 0) {
#pragma unroll
                        for (int j = 0; j < 8; ++j) s_[j] = tanh_fast(s_[j]); }
                    const bf16x8 af = pack8(s_[0], s_[1], s_[2], s_[3], s_[4], s_[5], s_[6], s_[7]);
                    const bf16_t* WT = lo ? A2T : W2T;
#pragma unroll
                    for (int nt = 0; nt < 4; ++nt) { const bf16x8 bfr = *(const bf16x8*)(WT + (size_t)(h * 64 + 16 * nt + l15) * 64 + 32 * ks + 8 * kg);
                        if (lo == 0) accw[nt] = MFMA16(af, bfr, accw[nt]); else acca[nt] = MFMA16(af, bfr, acca[nt]); } } }
            { const int need = k - (CC_NSLOT - 1); if (need > 0) { while ((int)flags[8] < need || (int)flags[9] < need) __builtin_amdgcn_s_sleep(2); } }
            asm volatile("" ::: "memory");
            LAS unsigned char* im = lds + (k % CC_NSLOT) * CC_SLOT;
#pragma unroll
            for (int ar = 0; ar < 3; ++ar)
#pragma unroll
                for (int i = 0; i < 2; ++i) { const int p_ = lane + 64 * i, row_ = p_ >> 3, c8_ = p_ & 7; float s_[8];
                    const float pz_ = (t0 + row_ == 0) ? 0.f : 1.f; const f32x4 m0 = *(const LAS f32x4*)(mixs + 256 + ar * 64 + c8_ * 8), m1 = *(const LAS f32x4*)(mixs + 256 + ar * 64 + c8_ * 8 + 4);
                    RW_SH8(ld[8 + (ar * 2 + i) * 2], ld[8 + (ar * 2 + i) * 2 + 1], m0, m1, s_, pz_);
                    if (ar < 2) *(LAS bf16x8*)(stg + ar * 1024 + row_ * 64 + c8_ * 8) = pack8(s_[0], s_[1], s_[2], s_[3], s_[4], s_[5], s_[6], s_[7]);
                    else {
#pragma unroll
                        for (int j = 0; j < 8; ++j) *(LAS bf16_t*)(im + CC_VT + (c8_ * 8 + j) * 40 + row_ * 2) = bf1(s_[j]); } }
            WSYNC();
            float lwv[4][4], av[4][4], knv[4][4];
            float w0c[4], a0c[4], kkc[4], kac[4], rkc[4];
#pragma unroll
            for (int nt = 0; nt < 4; ++nt) { const int c = h * 64 + 16 * nt + l15; w0c[nt] = w0[c]; a0c[nt] = a0[c]; kkc[nt] = k_k[c]; kac[nt] = k_a[c]; rkc[nt] = r_k[c]; }
#pragma unroll
            for (int rg = 0; rg < 4; ++rg) { const int tl = 4 * kg + rg;
                float kkv[4], nrm2 = 0.f, rr_[4], kr_[4];
#pragma unroll
                for (int nt = 0; nt < 4; ++nt) { rr_[nt] = bf2f(stg[tl * 64 + 16 * nt + l15]); kr_[nt] = bf2f(stg[1024 + tl * 64 + 16 * nt + l15]);
                    kkv[nt] = kr_[nt] * kkc[nt]; nrm2 += kkv[nt] * kkv[nt]; }
                nrm2 = rowsum16(nrm2); const float rn = __builtin_amdgcn_rsqf(fmaxf(nrm2, 1e-24f));
                float bon = 0.f;
#pragma unroll
                for (int nt = 0; nt < 4; ++nt) {
                    const float wsum = w0c[nt] + accw[nt][rg]; lwv[nt][rg] = -0.6065306597126334f * sigmoid_fast(wsum);
                    const float a_ = sigmoid_fast(a0c[nt] + acca[nt][rg]); av[nt][rg] = a_; knv[nt][rg] = kkv[nt] * rn;
                    const float k2 = kr_[nt] * (1.f + (a_ - 1.f) * kac[nt]); stg[1024 + tl * 64 + 16 * nt + l15] = bf1(k2);
                    bon += rr_[nt] * k2 * rkc[nt];
                }
                bon = rowsum16(bon);
                if (l15 == 0) bonus_out[(rowb + t0 + tl) * 8 + h] = bon;
            }
            { unsigned g_ = 0; if (lane == 0) g_ = __hip_atomic_fetch_add((LAS unsigned*)(lds + CC_FLAGS + 40), 1u, __ATOMIC_RELAXED, __HIP_MEMORY_SCOPE_WORKGROUP);
              kn = (int)__builtin_amdgcn_readfirstlane(g_); }
            CC_ISSUE_A((kn < NCH) ? 16 * kn : t0);
#pragma unroll
            for (int nt = 0; nt < 4; ++nt) {
                float L[4]; L[0] = lwv[nt][0]; L[1] = L[0] + lwv[nt][1]; L[2] = L[1] + lwv[nt][2]; L[3] = L[2] + lwv[nt][3];
                const float T0 = __shfl(L[3], l15), T1 = __shfl(L[3], 16 + l15), T2 = __shfl(L[3], 32 + l15), T3 = __shfl(L[3], 48 + l15);
                const float off = (kg > 0 ? T0 : 0.f) + (kg > 1 ? T1 : 0.f) + (kg > 2 ? T2 : 0.f), LC = (T0 + T1) + (T2 + T3);
                const int j = 16 * nt + l15;
                unsigned bb2[2], kb2[2];
                const float gC = __expf(LC); float eprev = __expf(off);
#pragma unroll
                for (int rg = 0; rg < 4; ++rg) { const int tl = 4 * kg + rg; const float Lt = off + L[rg], e1 = __expf(Lt), e2 = __builtin_amdgcn_rcpf(e1), e3 = eprev, e4 = gC * e2; eprev = e1;
                    const float kn = knv[nt][rg], bvv = kn * av[nt][rg], k2 = bf2f(stg[1024 + tl * 64 + j]), rr2 = bf2f(stg[tl * 64 + j]);
                    *(LAS bf16_t*)(im + CC_BK + tl * 144 + j * 2) = bf1(bvv * e2); *(LAS bf16_t*)(im + CC_BK + (16 + tl) * 144 + j * 2) = bf1(k2 * e2);
                    *(LAS bf16_t*)(im + CC_AR + tl * 144 + j * 2) = bf1(-kn * e3); *(LAS bf16_t*)(im + CC_AR + (16 + tl) * 144 + j * 2) = bf1(rr2 * e1);
                    const unsigned bq = bf1(bvv * e4), kq = bf1(k2 * e4);
                    if (rg & 1) { bb2[rg >> 1] |= bq << 16; kb2[rg >> 1] |= kq << 16; } else { bb2[rg >> 1] = bq; kb2[rg >> 1] = kq; } }
                *(LAS u32x2*)(im + CC_BBT + j * 40 + (4 * kg) * 2) = (u32x2){bb2[0], bb2[1]}; *(LAS u32x2*)(im + CC_KBT + j * 40 + (4 * kg) * 2) = (u32x2){kb2[0], kb2[1]};
                if (kg == 0) *(LAS float*)(im + CC_GC + j * 4) = gC;
            }
            WSYNC();
            {
                f32x4 nacc = {0.f, 0.f, 0.f, 0.f};
#pragma unroll
                for (int ks = 0; ks < 2; ++ks) { const bf16x8 fa = *(const LAS bf16x8*)(im + CC_BK + l15 * 144 + (32 * ks + 8 * kg) * 2), fb = *(const LAS bf16x8*)(im + CC_AR + l15 * 144 + (32 * ks + 8 * kg) * 2); nacc = MFMA16(fa, fb, nacc); }
#pragma unroll
                for (int rg = 0; rg < 4; ++rg) nacc[rg] = ((4 * kg + rg) < l15) ? nacc[rg] : 0.f;
                float Tr[16];
#pragma unroll
                for (int t = 0; t < 16; ++t) { float acc_ = (l15 == t) ? 1.f : 0.f;
#pragma unroll
                    for (int s2 = 0; s2 < t; ++s2) acc_ += Tr[s2] * rl(nacc[s2 & 3], t + 16 * (s2 >> 2));
                    Tr[t] = acc_; }
                if (kg == 0) {
#pragma unroll
                    for (int t = 0; t < 16; ++t) *(LAS bf16_t*)(im + CC_TT + t * 40 + l15 * 2) = bf1(Tr[t]); }
            }
            WSYNC();
            if (lane == 0) flags[k % CC_NSLOT] = (unsigned)(k + 1);
            CC_ISSUE_B((kn < NCH) ? 16 * kn : t0);
            k = kn;
        }
#undef CC_ISSUE
#undef CC_ISSUE_A
#undef CC_ISSUE_B
    }
#undef RW_SH8
    __syncthreads();
}


__device__ __forceinline__ void gate_lora_task(int chain, int k, int lane, const bf16_t* __restrict__ proj, const float* __restrict__ mix, const bf16_t* __restrict__ G2T, bf16_t* __restrict__ gout) {
    const int b = chain >> 3, h = chain & 7, l15 = lane & 15, kg = lane >> 4, t0 = 16 * k;
    const size_t rowb = (size_t)b * SEQ, r_ = rowb + t0 + l15, rp_ = (t0 + l15 == 0) ? r_ : r_ - 1;
    const float pz_ = (t0 + l15 == 0) ? 0.f : 1.f;
    v4u cu[4], pv[4];
#pragma unroll
    for (int ks = 0; ks < 4; ++ks) { const int col = 1664 + 32 * ks + 8 * kg; cu[ks] = *(const v4u*)(proj + r_ * L0P + col); pv[ks] = *(const v4u*)(proj + rp_ * L0P + col); }
    f32x4 accg[4];
#pragma unroll
    for (int nt = 0; nt < 4; ++nt) accg[nt] = (f32x4){0.f, 0.f, 0.f, 0.f};
#pragma unroll
    for (int ks = 0; ks < 4; ++ks) {
        const f32x4 m0 = *(const f32x4*)(mix + 1664 + 32 * ks + 8 * kg), m1 = *(const f32x4*)(mix + 1664 + 32 * ks + 8 * kg + 4);
        const float mm[8] = {m0[0], m0[1], m0[2], m0[3], m1[0], m1[1], m1[2], m1[3]};
        const unsigned cw[4] = {cu[ks].x, cu[ks].y, cu[ks].z, cu[ks].w}, pw[4] = {pv[ks].x, pv[ks].y, pv[ks].z, pv[ks].w};
        float s_[8];
#pragma unroll
        for (int q = 0; q < 4; ++q) { const float c0 = bflo(cw[q]), c1 = bfhi(cw[q]), p0 = bflo(pw[q]) * pz_, p1 = bfhi(pw[q]) * pz_;
            s_[2 * q] = sigmoid_fast(c0 + (p0 - c0) * mm[2 * q]); s_[2 * q + 1] = sigmoid_fast(c1 + (p1 - c1) * mm[2 * q + 1]); }
        const bf16x8 af = pack8(s_[0], s_[1], s_[2], s_[3], s_[4], s_[5], s_[6], s_[7]);
#pragma unroll
        for (int nt = 0; nt < 4; ++nt) { const bf16x8 bfr = *(const bf16x8*)(G2T + (size_t)(h * 64 + 16 * nt + l15) * 128 + 32 * ks + 8 * kg); accg[nt] = MFMA16(af, bfr, accg[nt]); }
    }
#pragma unroll
    for (int nt = 0; nt < 4; ++nt)
#pragma unroll
        for (int rg = 0; rg < 4; ++rg) gout[(rowb + t0 + 4 * kg + rg) * 512 + h * 64 + 16 * nt + l15] = bf1(accg[nt][rg]);
}


__device__ __forceinline__ void gate_lora_wave(int first, int stride, int lane, const bf16_t* __restrict__ proj, const float* __restrict__ mix, const bf16_t* __restrict__ G2T, bf16_t* __restrict__ gout) {
    const int l15 = lane & 15, kg = lane >> 4, h = (first >> 7) & 7;
    bf16x8 bfr[4][4];
#pragma unroll
    for (int ks = 0; ks < 4; ++ks)
#pragma unroll
        for (int nt = 0; nt < 4; ++nt) bfr[ks][nt] = *(const bf16x8*)(G2T + (size_t)(h * 64 + 16 * nt + l15) * 128 + 32 * ks + 8 * kg);
    float mm[4][8];
#pragma unroll
    for (int ks = 0; ks < 4; ++ks) { const f32x4 m0 = *(const f32x4*)(mix + 1664 + 32 * ks + 8 * kg), m1 = *(const f32x4*)(mix + 1664 + 32 * ks + 8 * kg + 4);
        mm[ks][0] = m0[0]; mm[ks][1] = m0[1]; mm[ks][2] = m0[2]; mm[ks][3] = m0[3]; mm[ks][4] = m1[0]; mm[ks][5] = m1[1]; mm[ks][6] = m1[2]; mm[ks][7] = m1[3]; }
    v4u cu[4], pv[4];
#define GL_LOAD(TK) do { const int ch_ = (TK) >> 7, t0_ = 16 * ((TK) & 127); const size_t r_ = (size_t)(ch_ >> 3) * SEQ + t0_ + l15, rp_ = (t0_ + l15 == 0) ? r_ : r_ - 1; \
        _Pragma("unroll") for (int ks = 0; ks < 4; ++ks) { const int col = 1664 + 32 * ks + 8 * kg; cu[ks] = *(const v4u*)(proj + r_ * L0P + col); pv[ks] = *(const v4u*)(proj + rp_ * L0P + col); } } while (0)
    GL_LOAD(first);
#pragma unroll 1
    for (int tk = first; tk < 128 * 128; tk += stride) {
        const int chain = tk >> 7, t0 = 16 * (tk & 127); const size_t rowb = (size_t)(chain >> 3) * SEQ;
        const float pz_ = (t0 + l15 == 0) ? 0.f : 1.f;
        f32x4 accg[4];
#pragma unroll
        for (int nt = 0; nt < 4; ++nt) accg[nt] = (f32x4){0.f, 0.f, 0.f, 0.f};
        bf16x8 af[4];
#pragma unroll
        for (int ks = 0; ks < 4; ++ks) { const unsigned cw[4] = {cu[ks].x, cu[ks].y, cu[ks].z, cu[ks].w}, pw[4] = {pv[ks].x, pv[ks].y, pv[ks].z, pv[ks].w}; float s_[8];
#pragma unroll
            for (int q = 0; q < 4; ++q) { const float c0 = bflo(cw[q]), c1 = bfhi(cw[q]), p0 = bflo(pw[q]) * pz_, p1 = bfhi(pw[q]) * pz_;
                s_[2 * q] = sigmoid_fast(c0 + (p0 - c0) * mm[ks][2 * q]); s_[2 * q + 1] = sigmoid_fast(c1 + (p1 - c1) * mm[ks][2 * q + 1]); }
            af[ks] = pack8(s_[0], s_[1], s_[2], s_[3], s_[4], s_[5], s_[6], s_[7]); }
        { const int tn = (tk + stride < 128 * 128) ? tk + stride : tk; GL_LOAD(tn); }
#pragma unroll
        for (int ks = 0; ks < 4; ++ks)
#pragma unroll
            for (int nt = 0; nt < 4; ++nt) accg[nt] = MFMA16(af[ks], bfr[ks][nt], accg[nt]);
#pragma unroll
        for (int nt = 0; nt < 4; ++nt)
#pragma unroll
            for (int rg = 0; rg < 4; ++rg) gout[(rowb + t0 + 4 * kg + rg) * 512 + h * 64 + 16 * nt + l15] = bf1(accg[nt][rg]);
    }
#undef GL_LOAD
}

template <bool ST = true> __device__ __forceinline__ void rwkv_post_all(const float* __restrict__ yraw, const bf16_t* __restrict__ proj, const float* __restrict__ mix, const float* __restrict__ bonus, const bf16_t* __restrict__ gbuf,
                                              const float* __restrict__ ln_g, const float* __restrict__ ln_b, bf16_t* __restrict__ ymix, int gw, int NGW, int lane) {
    for (int m = gw; m < M; m += NGW) {
        const bool has_prev = (m & (SEQ - 1)) != 0;
        float y[8], cv[8], pv[8], gg[8], bo[8];
#pragma unroll
        for (int h = 0; h < 8; ++h) { const int c = h * 64 + lane; y[h] = yraw[(size_t)m * 512 + c]; cv[h] = bf2f(proj[(size_t)m * L0P + 1024 + c]);
            pv[h] = bf2f(proj[(size_t)(has_prev ? m - 1 : m) * L0P + 1024 + c]); gg[h] = bf2f(gbuf[(size_t)m * 512 + c]); bo[h] = bonus[(size_t)m * 8 + h]; }
#pragma unroll
        for (int h = 0; h < 8; ++h) { const int c = h * 64 + lane;
            const float mu = wave_sum_dpp(y[h]) * (1.f / 64.f), d = y[h] - mu, var = wave_sum_dpp(d * d) * (1.f / 64.f);
            const float yn = d * __builtin_amdgcn_rsqf(var + 64e-5f) * ln_g[c] + ln_b[c];
            const float pvv = has_prev ? pv[h] : 0.f;
            const float v_s = cv[h] + (pvv - cv[h]) * mix[1024 + c];
            const float o = (yn + bo[h] * v_s) * gg[h];
            if (ST) ymix[(size_t)m * DM + c] = bf1(o); else asm volatile("" :: "v"(o)); }
    }
}


__device__ __forceinline__ void ssd_conv_tile(int it, int lane, LAS bf16_t* scr, const bf16_t* __restrict__ proj, const float* __restrict__ cw, const float* __restrict__ cb,
                                              bf16_t* __restrict__ xbc, bf16_t* __restrict__ xst, bf16_t* __restrict__ bt) {
    const int tt = it >> 4, ct = it & 15, m0 = tt * 64, b = m0 >> 11, t0 = m0 & (SEQ - 1), c = ct * 64 + lane;
    const float w0 = cw[c], w1 = cw[1024 + c], w2 = cw[2048 + c], w3 = cw[3072 + c], bias = cb[c];
    const bf16_t* src = proj + (size_t)m0 * L0P + 2304 + c;
    bf16_t raw[67];
    const int lo = (t0 > 0) ? -3 : 0;
#pragma unroll
    for (int t = -3; t < 64; ++t) raw[t + 3] = src[(ptrdiff_t)((t < lo) ? lo : t) * L0P];
    float u3 = (t0 > 0) ? bf2f(raw[0]) : 0.f, u2 = (t0 > 0) ? bf2f(raw[1]) : 0.f, u1 = (t0 > 0) ? bf2f(raw[2]) : 0.f;
#pragma unroll
    for (int t = 0; t < 64; ++t) {
        const float u = bf2f(raw[t + 3]);
        const float y = bias + w0 * u3 + w1 * u2 + w2 * u1 + w3 * u;
        const bf16_t o = bf1(y * __builtin_amdgcn_rcpf(1.f + __expf(-y)));
        xbc[(size_t)(m0 + t) * 1024 + c] = o;
        scr[t * STG_PITCH + lane] = o;
        u3 = u2; u2 = u1; u1 = u;
    }
    WSYNC();
    if (ct < 12) {
        bf16_t* dst = (ct < 8) ? xst + ((size_t)(b * 8 + ct) * 64) * SEQ + t0 : bt + ((size_t)(b * 2 + ((ct - 8) >> 1)) * 128 + ((ct - 8) & 1) * 64) * SEQ + t0;
#pragma unroll
        for (int i = 0; i < 8; ++i) { const int d = i * 8 + (lane >> 3), tc = lane & 7; const LAS bf16_t* p = scr + (tc * 8) * STG_PITCH + d;
            v4u o; o.x = (unsigned)p[0] | ((unsigned)p[STG_PITCH] << 16); o.y = (unsigned)p[2 * STG_PITCH] | ((unsigned)p[3 * STG_PITCH] << 16);
            o.z = (unsigned)p[4 * STG_PITCH] | ((unsigned)p[5 * STG_PITCH] << 16); o.w = (unsigned)p[6 * STG_PITCH] | ((unsigned)p[7 * STG_PITCH] << 16);
            *(v4u*)(dst + (size_t)d * SEQ + tc * 8) = o; }
    }
    WSYNC();
}
__device__ __forceinline__ float bperm(int srclane, float x) { return __builtin_bit_cast(float, __builtin_amdgcn_ds_bpermute(srclane << 2, __builtin_bit_cast(int, x))); }
__device__ __forceinline__ void scan128(float& x0, float& x1, int lane) {
#pragma unroll
    for (int o = 1; o < 64; o <<= 1) { const int sl = (lane >= o) ? lane - o : lane; const float t0 = bperm(sl, x0), t1 = bperm(sl, x1); if (lane >= o) { x0 += t0; x1 += t1; } }
    x1 += rl(x0, 63);
}

__device__ __forceinline__ void ssd_s3_block(int bc, int tid, int lane, int wave, LAS unsigned char* lds, const bf16_t* __restrict__ xbc, const bf16_t* __restrict__ xst, const bf16_t* __restrict__ stb,
                                             const float* __restrict__ dt, const float* __restrict__ a_log, const float* __restrict__ dsk, bf16_t* __restrict__ yssm) {
    const int b = bc >> 4, c = bc & 15, h = wave, g = h >> 2, l0 = c * 128, l31 = lane & 31, hi = lane >> 5, unit = bc * 8 + h;
    const size_t m0 = (size_t)b * SEQ + l0;
    __syncthreads();
    {
        const int mat = lane >> 4, ch = lane & 15;
        v4u rr[16];
#pragma unroll
        for (int i = 0; i < 16; ++i) rr[i] = *(const v4u*)(xbc + (m0 + wave * 16 + i) * 1024 + 512 + lane * 8);
#pragma unroll
        for (int i = 0; i < 16; ++i) { const int row = wave * 16 + i; *(LAS v4u*)(lds + mat * 34816 + row * 272 + ch * 16) = rr[i]; }
    }
#define S3TAB(i) (*(LAS float*)(lds + ((wave * 64) + ((i) >> 2)) * 272 + 256 + ((i) & 3) * 4))
    const float A = -expf(a_log[h]), D = dsk[h];
    { const float d0 = dt[(m0 + lane) * 8 + h], d1 = dt[(m0 + 64 + lane) * 8 + h];
      float ac0 = d0 * A, ac1 = d1 * A;
      scan128(ac0, ac1, lane);
      S3TAB(lane) = ac0; S3TAB(64 + lane) = ac1; S3TAB(128 + lane) = d0; S3TAB(192 + lane) = d1; }
    u32x2 xf[4][2][2][2];
    const bf16_t* Sp = stb + (size_t)unit * 8192 + l31 * 128 + 8 * hi;
    { const bf16_t* Xp = xst + ((size_t)(b * 8 + h) * 64 + l31) * SEQ + l0 + 4 * hi;
#pragma unroll
      for (int st = 0; st < 4; ++st)
#pragma unroll
          for (int pt = 0; pt < 2; ++pt)
#pragma unroll
              for (int ks = 0; ks < 2; ++ks) { const bf16_t* xp = Xp + (size_t)pt * 32 * SEQ + st * 32 + 16 * ks; xf[st][pt][ks][0] = *(const u32x2*)xp; xf[st][pt][ks][1] = *(const u32x2*)(xp + 8); } }
    __syncthreads();
    const LAS unsigned char* Bl = lds + g * 34816 + 16 * hi;
    const LAS unsigned char* Cl = lds + (2 + g) * 34816 + 16 * hi;
#pragma unroll 1
    for (int lt = 0; lt < 4; ++lt) {
        asm volatile("" ::: "memory");
        f32x16 y[2];
#pragma unroll
        for (int r = 0; r < 16; ++r) { y[0][r] = 0.f; y[1][r] = 0.f; }
        const float acl = S3TAB(32 * lt + l31);
        const int crw = 32 * lt + l31;
        { bf16x8 sfr[2][8];
#pragma unroll
          for (int pt = 0; pt < 2; ++pt)
#pragma unroll
              for (int kk = 0; kk < 8; ++kk) sfr[pt][kk] = *(const bf16x8*)(Sp + pt * 32 * 128 + 16 * kk);
#pragma unroll
          for (int kk = 0; kk < 8; ++kk) { const bf16x8 cf = *(const LAS bf16x8*)(Cl + crw * 272 + 32 * kk); y[0] = MFMA32(sfr[0][kk], cf, y[0]); y[1] = MFMA32(sfr[1][kk], cf, y[1]); } }
        { const float el = __expf(acl);
#pragma unroll
          for (int r = 0; r < 16; ++r) { y[0][r] *= el; y[1][r] *= el; } }
        u32x2 xd[2][4];
#pragma unroll
        for (int pt = 0; pt < 2; ++pt)
#pragma unroll
            for (int q = 0; q < 4; ++q) xd[pt][q] = *(const u32x2*)(xbc + (m0 + crw) * 1024 + h * 64 + 32 * pt + 8 * q + 4 * hi);
#pragma unroll
        for (int st = 0; st < 4; ++st) if (st <= lt) {
            const int brw = 32 * st + l31;
            f32x16 cbt;
#pragma unroll
            for (int r = 0; r < 16; ++r) cbt[r] = 0.f;
#pragma unroll
            for (int kk = 0; kk < 8; ++kk) { const bf16x8 bf_ = *(const LAS bf16x8*)(Bl + brw * 272 + 32 * kk), cf_ = *(const LAS bf16x8*)(Cl + crw * 272 + 32 * kk); cbt = MFMA32(bf_, cf_, cbt); }
#pragma unroll
            for (int r = 0; r < 16; ++r) { const int sl = 32 * st + crow(r, hi); const float acs = S3TAB(sl), dts = S3TAB(128 + sl);
                float v = cbt[r] * __expf(acl - acs) * dts; if (st == lt && crow(r, hi) > l31) v = 0.f; cbt[r] = v; }
            bf16x8 pf[2];
#pragma unroll
            for (int ks = 0; ks < 2; ++ks) pf[ks] = pack8(cbt[8 * ks], cbt[8 * ks + 1], cbt[8 * ks + 2], cbt[8 * ks + 3], cbt[8 * ks + 4], cbt[8 * ks + 5], cbt[8 * ks + 6], cbt[8 * ks + 7]);
#pragma unroll
            for (int pt = 0; pt < 2; ++pt)
#pragma unroll
                for (int ks = 0; ks < 2; ++ks) { v4u a; a.x = xf[st][pt][ks][0].x; a.y = xf[st][pt][ks][0].y; a.z = xf[st][pt][ks][1].x; a.w = xf[st][pt][ks][1].y; y[pt] = MFMA32(__builtin_bit_cast(bf16x8, a), pf[ks], y[pt]); }
        }
#pragma unroll
        for (int pt = 0; pt < 2; ++pt)
#pragma unroll
            for (int q = 0; q < 4; ++q) { const u32x2 xx = xd[pt][q];
                const unsigned o0 = cvtpk(y[pt][4 * q] + D * bflo(xx.x), y[pt][4 * q + 1] + D * bfhi(xx.x)), o1 = cvtpk(y[pt][4 * q + 2] + D * bflo(xx.y), y[pt][4 * q + 3] + D * bfhi(xx.y));
                *(u32x2*)(yssm + (m0 + crw) * 512 + h * 64 + 32 * pt + 8 * q + 4 * hi) = (u32x2){o0, o1}; }
    }
#undef S3TAB
}
__device__ __forceinline__ void ssd_s1_unit(int unit, int lane, LAS float* tab, const bf16_t* __restrict__ xst, const bf16_t* __restrict__ bt, const float* __restrict__ dt, const float* __restrict__ a_log,
                                            float* __restrict__ sloc, float* __restrict__ asum) {
    const int h = unit & 7, c = (unit >> 3) & 15, b = unit >> 7, g = h >> 2, l0 = c * 128, l31 = lane & 31, hi = lane >> 5;
    const size_t m0 = (size_t)b * SEQ + l0;
    const float A = -expf(a_log[h]);
    const float d0 = dt[(m0 + lane) * 8 + h], d1 = dt[(m0 + 64 + lane) * 8 + h];
    float ac0 = d0 * A, ac1 = d1 * A;
    scan128(ac0, ac1, lane);
    const float aend = rl(ac1, 63);
    tab[lane] = __expf(aend - ac0) * d0; tab[64 + lane] = __expf(aend - ac1) * d1;
    if (lane == 0) asum[unit] = aend;
    WSYNC();
    f32x16 acc[2][4];
#pragma unroll
    for (int pt = 0; pt < 2; ++pt)
#pragma unroll
        for (int nt = 0; nt < 4; ++nt)
#pragma unroll
            for (int r = 0; r < 16; ++r) acc[pt][nt][r] = 0.f;
    const bf16_t* Xp = xst + ((size_t)(b * 8 + h) * 64 + l31) * SEQ + l0 + 8 * hi;
    const bf16_t* Bp = bt + ((size_t)(b * 2 + g) * 128 + l31) * SEQ + l0 + 8 * hi;
#pragma unroll 2
    for (int kk = 0; kk < 8; ++kk) {
        const f32x4 wa = *(const LAS f32x4*)(tab + 16 * kk + 8 * hi), wb = *(const LAS f32x4*)(tab + 16 * kk + 8 * hi + 4);
        bf16x8 af[2], bfr[4];
#pragma unroll
        for (int pt = 0; pt < 2; ++pt) { const v4u raw = *(const v4u*)(Xp + (size_t)pt * 32 * SEQ + 16 * kk);
            v4u w; w.x = cvtpk(bflo(raw.x) * wa[0], bfhi(raw.x) * wa[1]); w.y = cvtpk(bflo(raw.y) * wa[2], bfhi(raw.y) * wa[3]);
            w.z = cvtpk(bflo(raw.z) * wb[0], bfhi(raw.z) * wb[1]); w.w = cvtpk(bflo(raw.w) * wb[2], bfhi(raw.w) * wb[3]); af[pt] = __builtin_bit_cast(bf16x8, w); }
#pragma unroll
        for (int nt = 0; nt < 4; ++nt) bfr[nt] = *(const bf16x8*)(Bp + (size_t)nt * 32 * SEQ + 16 * kk);
#pragma unroll
        for (int pt = 0; pt < 2; ++pt)
#pragma unroll
            for (int nt = 0; nt < 4; ++nt) acc[pt][nt] = MFMA32(af[pt], bfr[nt], acc[pt][nt]);
    }
    float* dst = sloc + (size_t)unit * 8192 + l31;
#pragma unroll
    for (int pt = 0; pt < 2; ++pt)
#pragma unroll
        for (int nt = 0; nt < 4; ++nt)
#pragma unroll
            for (int r = 0; r < 16; ++r) dst[(32 * pt + crow(r, hi)) * 128 + 32 * nt] = acc[pt][nt][r];
    WSYNC();
}
__device__ __forceinline__ void ssd_s2_all(const float* __restrict__ sloc, const float* __restrict__ asum, bf16_t* __restrict__ stb, int gtid, int NT) {
    for (int i = gtid; i < 128 * 2048; i += NT) {
        const int bh = i >> 11, e4 = i & 2047, b = bh >> 3, h = bh & 7;
        f32x4 run = {0.f, 0.f, 0.f, 0.f};
#pragma unroll 4
        for (int c = 0; c < 16; ++c) { const int unit = (b * 16 + c) * 8 + h; const f32x4 tmp = *(const f32x4*)(sloc + (size_t)unit * 8192 + e4 * 4);
            uint2 w; w.x = cvtpk(run[0], run[1]); w.y = cvtpk(run[2], run[3]); *(uint2*)(stb + (size_t)unit * 8192 + e4 * 4) = w;
            run = run * __expf(asum[unit]) + tmp; }
    }
}
__device__ __forceinline__ void ssd_s3_unit(int unit, int lane, LAS float* tab, const bf16_t* __restrict__ xbc, const bf16_t* __restrict__ xst, const bf16_t* __restrict__ stb, const float* __restrict__ dt,
                                            const float* __restrict__ a_log, const float* __restrict__ dsk, bf16_t* __restrict__ yssm) {
    const int h = unit & 7, c = (unit >> 3) & 15, b = unit >> 7, g = h >> 2, l0 = c * 128, l31 = lane & 31, hi = lane >> 5;
    const size_t m0 = (size_t)b * SEQ + l0;
    const float A = -expf(a_log[h]), D = dsk[h];
    const float d0 = dt[(m0 + lane) * 8 + h], d1 = dt[(m0 + 64 + lane) * 8 + h];
    float ac0 = d0 * A, ac1 = d1 * A;
    scan128(ac0, ac1, lane);
    tab[lane] = ac0; tab[64 + lane] = ac1; tab[128 + lane] = d0; tab[192 + lane] = d1;
    WSYNC();
    const bf16_t* Cp = xbc + (m0 + l31) * 1024 + 768 + g * 128 + 8 * hi;
    const bf16_t* Sp = stb + (size_t)unit * 8192 + l31 * 128 + 8 * hi;
    const bf16_t* Bp = xbc + (m0 + l31) * 1024 + 512 + g * 128 + 8 * hi;
    const bf16_t* Xp = xst + ((size_t)(b * 8 + h) * 64 + l31) * SEQ + l0 + 4 * hi;
    LAS float* tr = tab + 256;
    const int row = lane >> 1, p0 = (lane & 1) * 16;
#pragma unroll 1
    for (int lt = 0; lt < 4; ++lt) {
        f32x16 y[2];
#pragma unroll
        for (int r = 0; r < 16; ++r) { y[0][r] = 0.f; y[1][r] = 0.f; }
        const float acl = tab[32 * lt + l31];
        bf16x8 cfr[8];
#pragma unroll
        for (int kk = 0; kk < 8; ++kk) cfr[kk] = *(const bf16x8*)(Cp + (size_t)lt * 32 * 1024 + 16 * kk);
        {   bf16x8 s0[8], s1[8];
#pragma unroll
            for (int kk = 0; kk < 8; ++kk) { s0[kk] = *(const bf16x8*)(Sp + 16 * kk); s1[kk] = *(const bf16x8*)(Sp + 32 * 128 + 16 * kk); }
#pragma unroll
            for (int kk = 0; kk < 8; ++kk) { y[0] = MFMA32(s0[kk], cfr[kk], y[0]); y[1] = MFMA32(s1[kk], cfr[kk], y[1]); }
        }
        { const float el = __expf(acl);
#pragma unroll
          for (int r = 0; r < 16; ++r) { y[0][r] *= el; y[1][r] *= el; } }
#pragma unroll 1
        for (int st = 0; st <= lt; ++st) {
            bf16x8 bfr[8]; u32x2 xf[2][2][2];
#pragma unroll
            for (int kk = 0; kk < 8; ++kk) bfr[kk] = *(const bf16x8*)(Bp + (size_t)st * 32 * 1024 + 16 * kk);
#pragma unroll
            for (int pt = 0; pt < 2; ++pt)
#pragma unroll
                for (int ks = 0; ks < 2; ++ks) { const bf16_t* xp = Xp + (size_t)pt * 32 * SEQ + st * 32 + 16 * ks; xf[pt][ks][0] = *(const u32x2*)xp; xf[pt][ks][1] = *(const u32x2*)(xp + 8); }
            f32x16 cbt;
#pragma unroll
            for (int r = 0; r < 16; ++r) cbt[r] = 0.f;
#pragma unroll
            for (int kk = 0; kk < 8; ++kk) cbt = MFMA32(bfr[kk], cfr[kk], cbt);
#pragma unroll
            for (int r = 0; r < 16; ++r) { const int sl = 32 * st + crow(r, hi); const float acs = tab[sl], dts = tab[128 + sl];
                float v = cbt[r] * __expf(acl - acs) * dts; if (st == lt && crow(r, hi) > l31) v = 0.f; cbt[r] = v; }
            bf16x8 pf[2];
#pragma unroll
            for (int ks = 0; ks < 2; ++ks) pf[ks] = pack8(cbt[8 * ks], cbt[8 * ks + 1], cbt[8 * ks + 2], cbt[8 * ks + 3], cbt[8 * ks + 4], cbt[8 * ks + 5], cbt[8 * ks + 6], cbt[8 * ks + 7]);
#pragma unroll
            for (int pt = 0; pt < 2; ++pt)
#pragma unroll
                for (int ks = 0; ks < 2; ++ks) { v4u a; a.x = xf[pt][ks][0].x; a.y = xf[pt][ks][0].y; a.z = xf[pt][ks][1].x; a.w = xf[pt][ks][1].y; y[pt] = MFMA32(__builtin_bit_cast(bf16x8, a), pf[ks], y[pt]); }
        }
#pragma unroll
        for (int pt = 0; pt < 2; ++pt) {
#pragma unroll
            for (int r = 0; r < 16; ++r) tr[l31 * 33 + crow(r, hi)] = y[pt][r];
            WSYNC();
            const size_t m = m0 + 32 * lt + row;
            const v4u xa = *(const v4u*)(xbc + m * 1024 + h * 64 + 32 * pt + p0), xb = *(const v4u*)(xbc + m * 1024 + h * 64 + 32 * pt + p0 + 8);
            const unsigned xu[8] = {xa.x, xa.y, xa.z, xa.w, xb.x, xb.y, xb.z, xb.w};
            unsigned ow[8];
#pragma unroll
            for (int q = 0; q < 8; ++q) { const float v0 = tr[row * 33 + p0 + 2 * q] + D * bflo(xu[q]), v1 = tr[row * 33 + p0 + 2 * q + 1] + D * bfhi(xu[q]); ow[q] = cvtpk(v0, v1); }
            bf16_t* dst = yssm + m * 512 + h * 64 + 32 * pt + p0;
            *(v4u*)dst = (v4u){ow[0], ow[1], ow[2], ow[3]}; *(v4u*)(dst + 8) = (v4u){ow[4], ow[5], ow[6], ow[7]};
            WSYNC();
        }
    }
}


__device__ __forceinline__ float sum8(float x) { x += dpp_mov<0xB1>(x); x += dpp_mov<0x4E>(x); x += dpp_mov<0x141>(x); return x; }
__device__ __forceinline__ float sum32(float x, int lane) { x = rowsum16(x); return x + bperm(lane ^ 16, x); }
__device__ __forceinline__ void unpack8(const v4u& w, float (&f)[8]) { f[0] = bflo(w.x); f[1] = bfhi(w.x); f[2] = bflo(w.y); f[3] = bfhi(w.y); f[4] = bflo(w.z); f[5] = bfhi(w.z); f[6] = bflo(w.w); f[7] = bfhi(w.w); }
__device__ __forceinline__ void ssm_gate_norm_vec(const bf16_t* __restrict__ yssm, const bf16_t* __restrict__ proj, const float* __restrict__ ng, bf16_t* __restrict__ ymix, int m0, int m1, int w, int nw, int lane) {
    const int c0 = lane * 8;
    float gn[8];
    { const f32x4 a = *(const f32x4*)(ng + c0), b = *(const f32x4*)(ng + c0 + 4); gn[0] = a[0]; gn[1] = a[1]; gn[2] = a[2]; gn[3] = a[3]; gn[4] = b[0]; gn[5] = b[1]; gn[6] = b[2]; gn[7] = b[3]; }
    for (int mb = m0 + w; mb < m1; mb += nw * 4) {
        v4u yv[4], zv[4];
#pragma unroll
        for (int k = 0; k < 4; ++k) { const int m = (mb + k * nw < m1) ? mb + k * nw : mb; yv[k] = *(const v4u*)(yssm + (size_t)m * 512 + c0); zv[k] = *(const v4u*)(proj + (size_t)m * L0P + 1792 + c0); }
#pragma unroll
        for (int k = 0; k < 4; ++k) { const int m = mb + k * nw;
            float y[8], z[8], u[8], q = 0.f; unpack8(yv[k], y); unpack8(zv[k], z);
#pragma unroll
            for (int j = 0; j < 8; ++j) { u[j] = y[j] * z[j] * __builtin_amdgcn_rcpf(1.f + __builtin_amdgcn_exp2f(-1.4426950408889634f * z[j])); q += u[j] * u[j]; }
            const float rs = __builtin_amdgcn_rsqf(sum32(q, lane) * (1.f / 256.f) + 1e-5f);
            v4u o; o.x = cvtpk(u[0] * rs * gn[0], u[1] * rs * gn[1]); o.y = cvtpk(u[2] * rs * gn[2], u[3] * rs * gn[3]); o.z = cvtpk(u[4] * rs * gn[4], u[5] * rs * gn[5]); o.w = cvtpk(u[6] * rs * gn[6], u[7] * rs * gn[7]);
            if (m < m1) *(v4u*)(ymix + (size_t)m * DM + 512 + c0) = o; }
    }
}
__device__ __forceinline__ void rwkv_post_vec(const float* __restrict__ yraw, const bf16_t* __restrict__ proj, const float* __restrict__ mix, const float* __restrict__ bonus, const bf16_t* __restrict__ gbuf,
                                              const float* __restrict__ ln_g, const float* __restrict__ ln_b, bf16_t* __restrict__ ymix, int gw, int NGW, int lane) {
    const int c0 = lane * 8, h = lane >> 3;
    float lg[8], lb[8], mx[8];
    { const f32x4 a = *(const f32x4*)(ln_g + c0), b = *(const f32x4*)(ln_g + c0 + 4), c = *(const f32x4*)(ln_b + c0), d = *(const f32x4*)(ln_b + c0 + 4), e = *(const f32x4*)(mix + 1024 + c0), f = *(const f32x4*)(mix + 1024 + c0 + 4);
#pragma unroll
      for (int j = 0; j < 4; ++j) { lg[j] = a[j]; lg[4 + j] = b[j]; lb[j] = c[j]; lb[4 + j] = d[j]; mx[j] = e[j]; mx[4 + j] = f[j]; } }
    for (int mb = gw; mb < M; mb += NGW * 2) {
        f32x4 ya[2], yb[2]; v4u cv[2], pv[2], gv[2]; float bo[2];
#pragma unroll
        for (int k = 0; k < 2; ++k) { const int m = mb + k * NGW; const bool hp = (m & (SEQ - 1)) != 0;
            ya[k] = *(const f32x4*)(yraw + (size_t)m * 512 + c0); yb[k] = *(const f32x4*)(yraw + (size_t)m * 512 + c0 + 4);
            cv[k] = *(const v4u*)(proj + (size_t)m * L0P + 1024 + c0); pv[k] = *(const v4u*)(proj + (size_t)(hp ? m - 1 : m) * L0P + 1024 + c0);
            gv[k] = *(const v4u*)(gbuf + (size_t)m * 512 + c0); bo[k] = bonus[(size_t)m * 8 + h]; }
#pragma unroll
        for (int k = 0; k < 2; ++k) { const int m = mb + k * NGW; const float pz = ((m & (SEQ - 1)) != 0) ? 1.f : 0.f;
            float y[8] = {ya[k][0], ya[k][1], ya[k][2], ya[k][3], yb[k][0], yb[k][1], yb[k][2], yb[k][3]}, cc[8], pp[8], gg[8];
            unpack8(cv[k], cc); unpack8(pv[k], pp); unpack8(gv[k], gg);
            float sm = 0.f;
#pragma unroll
            for (int j = 0; j < 8; ++j) sm += y[j];
            const float mu = sum8(sm) * (1.f / 64.f);
            float qv = 0.f;
#pragma unroll
            for (int j = 0; j < 8; ++j) { y[j] -= mu; qv += y[j] * y[j]; }
            const float rs = __builtin_amdgcn_rsqf(sum8(qv) * (1.f / 64.f) + 64e-5f);
            float o[8];
#pragma unroll
            for (int j = 0; j < 8; ++j) { const float vs = cc[j] + (pp[j] * pz - cc[j]) * mx[j]; o[j] = (y[j] * rs * lg[j] + lb[j] + bo[k] * vs) * gg[j]; }
            v4u w; w.x = cvtpk(o[0], o[1]); w.y = cvtpk(o[2], o[3]); w.z = cvtpk(o[4], o[5]); w.w = cvtpk(o[6], o[7]);
            *(v4u*)(ymix + (size_t)m * DM + c0) = w; }
    }
}

struct Args { const float* in[43]; float* out; unsigned char* ws; };
constexpr int HG_PITCH = 144, HG_A_BYTES = 128 * HG_PITCH, HG_STAGE = (128 + 256) * HG_PITCH;
__device__ __forceinline__ void halo_gemm_unit(int unit, int tid, int lane, int wave, LAS unsigned char* lds, const bf16_t* __restrict__ XBp, const bf16_t* __restrict__ Wup, bf16_t* __restrict__ HALOp) {
    const int pm = unit / 11, pn = unit - pm * 11, wr = wave >> 2, wc = wave & 3, l31 = lane & 31, hi = lane >> 5;
    const int srow = tid >> 3, sch = tid & 7;
    const bf16_t* gA[2]; const bf16_t* gB[4]; int lA[2], lB[4];
#pragma unroll
    for (int i = 0; i < 2; ++i) { const int row = srow + 64 * i, R = 128 * pm + row; gA[i] = XBp + (size_t)(64 * (R >> 1) + 62 + (R & 1)) * DM + sch * 8; lA[i] = row * HG_PITCH + sch * 16; }
#pragma unroll
    for (int i = 0; i < 4; ++i) { const int row = srow + 64 * i, ch = 256 * pn + row; gB[i] = Wup + (size_t)(256 * (ch >> 7) + (ch & 127)) * 1024 + sch * 8; lB[i] = HG_A_BYTES + row * HG_PITCH + sch * 16; }
    f32x16 acc[2][2];
#pragma unroll
    for (int a = 0; a < 2; ++a)
#pragma unroll
        for (int b = 0; b < 2; ++b)
#pragma unroll
            for (int r = 0; r < 16; ++r) acc[a][b][r] = 0.f;
    v4u ra0[2], rb0[4], ra1[2], rb1[4];
#pragma unroll
    for (int i = 0; i < 2; ++i) ra0[i] = *(const v4u*)gA[i];
#pragma unroll
    for (int i = 0; i < 4; ++i) rb0[i] = *(const v4u*)gB[i];
#pragma unroll
    for (int i = 0; i < 2; ++i) ra1[i] = *(const v4u*)(gA[i] + 64);
#pragma unroll
    for (int i = 0; i < 4; ++i) rb1[i] = *(const v4u*)(gB[i] + 64);
#pragma unroll
    for (int i = 0; i < 2; ++i) *(LAS v4u*)(lds + lA[i]) = ra0[i];
#pragma unroll
    for (int i = 0; i < 4; ++i) *(LAS v4u*)(lds + lB[i]) = rb0[i];
    __syncthreads();
    const int fA = (64 * wr + l31) * HG_PITCH + 16 * hi, fB = HG_A_BYTES + (64 * wc + l31) * HG_PITCH + 16 * hi;
#define HG_COMPUTE(S) do { _Pragma("unroll") for (int st = 0; st < 4; ++st) { bf16x8 fa[2], fb[2]; \
        _Pragma("unroll") for (int x = 0; x < 2; ++x) { fa[x] = *(const LAS bf16x8*)((S) + fA + 32 * x * HG_PITCH + 32 * st); fb[x] = *(const LAS bf16x8*)((S) + fB + 32 * x * HG_PITCH + 32 * st); } \
        _Pragma("unroll") for (int a = 0; a < 2; ++a) _Pragma("unroll") for (int b = 0; b < 2; ++b) acc[a][b] = MFMA32(fb[b], fa[a], acc[a][b]); } } while (0)
#pragma unroll 1
    for (int c = 0; c < 16; c += 2) {
        { const int k2 = (c + 2 < 16) ? 64 * (c + 2) : 0;
#pragma unroll
          for (int i = 0; i < 2; ++i) ra0[i] = *(const v4u*)(gA[i] + k2);
#pragma unroll
          for (int i = 0; i < 4; ++i) rb0[i] = *(const v4u*)(gB[i] + k2);
          HG_COMPUTE(lds);
#pragma unroll
          for (int i = 0; i < 2; ++i) *(LAS v4u*)(lds + HG_STAGE + lA[i]) = ra1[i];
#pragma unroll
          for (int i = 0; i < 4; ++i) *(LAS v4u*)(lds + HG_STAGE + lB[i]) = rb1[i];
          __syncthreads(); }
        { const int k3 = (c + 3 < 16) ? 64 * (c + 3) : 0;
#pragma unroll
          for (int i = 0; i < 2; ++i) ra1[i] = *(const v4u*)(gA[i] + k3);
#pragma unroll
          for (int i = 0; i < 4; ++i) rb1[i] = *(const v4u*)(gB[i] + k3);
          HG_COMPUTE(lds + HG_STAGE);
          if (c + 2 < 16) {
#pragma unroll
              for (int i = 0; i < 2; ++i) *(LAS v4u*)(lds + lA[i]) = ra0[i];
#pragma unroll
              for (int i = 0; i < 4; ++i) *(LAS v4u*)(lds + lB[i]) = rb0[i];
          }
          __syncthreads(); }
    }
#undef HG_COMPUTE
#pragma unroll
    for (int a = 0; a < 2; ++a) { const int R = 128 * pm + 64 * wr + 32 * a + l31;
#pragma unroll
        for (int b = 0; b < 2; ++b)
#pragma unroll
            for (int g = 0; g < 4; ++g) { const int ch = 256 * pn + 64 * wc + 32 * b + 8 * g + 4 * hi;
                u32x2 w; w.x = cvtpk(acc[a][b][4 * g], acc[a][b][4 * g + 1]); w.y = cvtpk(acc[a][b][4 * g + 2], acc[a][b][4 * g + 3]);
                *(u32x2*)(HALOp + (size_t)R * DFF + ch) = w; } }
}
__device__ __forceinline__ void halo_signal(unsigned* cnt) {
    asm volatile("s_waitcnt vmcnt(0)" ::: "memory");
    __syncthreads();
    if (threadIdx.x == 0) { __builtin_amdgcn_fence(__ATOMIC_RELEASE, "agent"); asm volatile("s_waitcnt vmcnt(0)" ::: "memory"); (void)xb_add(cnt, 1u); }
}
__device__ __forceinline__ void halo_wait(unsigned* cnt, unsigned need, unsigned* bar) {
    if (threadIdx.x == 0) { XB_SPIN(xb_ld(cnt) < need, bar); __builtin_amdgcn_fence(__ATOMIC_ACQUIRE, "agent"); asm volatile("s_waitcnt vmcnt(0)" ::: "memory"); }
    __syncthreads();
}
#define GEMM_PHASE(EPI, Aptr, LDA, Bptr, LDB, NN, KK, ...) do { pg8::Gemm g_{(Aptr), (Bptr), M, (NN), (KK), (LDA), (LDB)}; pg8::StaticOrder S_; S_.init(M, (NN), G, (int)blockIdx.x); \
        pg8::EPI E_{__VA_ARGS__}; pg8::gemm_phase<pg8::EPI, pg8::StaticOrder, true, true>(lds3, g_, S_, E_); } while (0)

__global__ void __launch_bounds__(NWAVES * 64, 2) fwd_mega(Args args) {
    extern __shared__ __attribute__((aligned(16))) unsigned char lds[];
    LAS unsigned char* lds3 = (LAS unsigned char*)lds;
    volatile LAS unsigned* MISC = (volatile LAS unsigned*)(lds3 + MISC_OFF);
    const int G = gridDim.x, NGW = G * NWAVES, NT = G * NWAVES * 64;
#define PHASE_IDS() int tid = threadIdx.x; asm volatile("" : "+v"(tid)); const int lane = tid & 63, wave = __builtin_amdgcn_readfirstlane(tid >> 6); const int gw = blockIdx.x * NWAVES + wave, gtid = blockIdx.x * (NWAVES * 64) + tid; (void)lane; (void)gw; (void)gtid
    unsigned char* ws = args.ws;
    gu32* ctl = (gu32*)(ws + WS_CTL);
    for (int u = threadIdx.x; u < (LDS_BYTES - LDSCTL_OFF) / 4; u += NWAVES * 64) ((LAS unsigned*)(lds3 + LDSCTL_OFF))[u] = 0u;
    __syncthreads();
    XcdBarrier bar = xcd_barrier_post((unsigned*)(ctl + CW_BAR), MISC + 8);
#if defined(PROBE_STAMPS)
    int nb_ = 0;
    if (blockIdx.x == 0 && threadIdx.x == 0) MISC[16] = (unsigned)__builtin_amdgcn_s_memrealtime();
#define GRID_BAR() do { xcd_barrier(bar); ++nb_; if (blockIdx.x == 0 && threadIdx.x == 0) MISC[16 + nb_] = (unsigned)__builtin_amdgcn_s_memrealtime(); } while (0)
#else
#define GRID_BAR() xcd_barrier(bar)
#endif
#define IN(i) (args.in[i])
    float* out = args.out;
    bf16_t* W0in = (bf16_t*)(ws + WS_W0IN); bf16_t* W0out = (bf16_t*)(ws + WS_W0OUT); bf16_t* Wup0 = (bf16_t*)(ws + WS_WUP0); bf16_t* Wdn0 = (bf16_t*)(ws + WS_WDN0);
    bf16_t* W1in = (bf16_t*)(ws + WS_W1IN); bf16_t* Wuq = (bf16_t*)(ws + WS_WUQ); bf16_t* Wukv = (bf16_t*)(ws + WS_WUKV); bf16_t* W1out = (bf16_t*)(ws + WS_W1OUT);
    bf16_t* Wup1 = (bf16_t*)(ws + WS_WUP1); bf16_t* Wdn1 = (bf16_t*)(ws + WS_WDN1);
    bf16_t* XB = (bf16_t*)(ws + WS_XB); bf16_t* YMIX = (bf16_t*)(ws + WS_YMIX); bf16_t* PROJ0 = (bf16_t*)(ws + WS_BIG);
    bf16_t* ZB = (bf16_t*)out; float* YRAW = out; bf16_t* YSSM = (bf16_t*)(out + (size_t)M * 512); bf16_t* STB = (bf16_t*)(out + (size_t)M * 768); bf16_t* XST = (bf16_t*)(ws + WS_XST); bf16_t* BT = (bf16_t*)(ws + WS_BT); float* ASUM = (float*)(ws + WS_ASUM); float* SLOC = (float*)(ws + WS_SLOC); float* DT = (float*)(ws + WS_DT); bf16_t* GB = (bf16_t*)(ws + WS_G); float* BONUS = (float*)(ws + WS_BONUS);
    bf16_t* W2T = (bf16_t*)(ws + WS_W2T); bf16_t* A2T = (bf16_t*)(ws + WS_A2T); bf16_t* G2T = (bf16_t*)(ws + WS_G2T); bf16_t* ACT = (bf16_t*)(ws + WS_GU); bf16_t* HALO = (bf16_t*)(ws + WS_GU + 176 * MiB);
    bf16_t* PROJ1 = (bf16_t*)(ws + WS_PROJ1); bf16_t* QM = (bf16_t*)(ws + WS_QM); bf16_t* KVM = (bf16_t*)(ws + WS_KVM); bf16_t* KPE = (bf16_t*)(ws + WS_KPE); float* RS = (float*)(ws + WS_RS); float* CSTAB = (float*)(ws + WS_CSTAB); float* STATS = (float*)(ws + WS_CSTAB + 4 * MiB); bf16_t* VTS = (bf16_t*)(ws + WS_VTS); bf16_t* VTM = (bf16_t*)(ws + WS_VTM);
    const int* pos = (const int*)args.in[1];

    {
        PHASE_IDS();
    {
        LAS float* scr = (LAS float*)(lds3 + wave * 16384); int trb = 0;
        transpose_matrix(IN(2), 1024, 3336, W0in, L0P, 1024, scr, gw, NGW, lane, nullptr, trb);
        transpose_matrix(IN(20), 1024, 1024, W0out, 1024, 1024, scr, gw, NGW, lane, nullptr, trb);
        transpose_matrix(IN(5), 64, 512, W2T, 512, 64, scr, gw, NGW, lane, nullptr, trb);
        transpose_matrix(IN(7), 64, 512, A2T, 512, 64, scr, gw, NGW, lane, nullptr, trb);
        transpose_matrix(IN(8), 128, 512, G2T, 512, 128, scr, gw, NGW, lane, nullptr, trb);
        const float* x = IN(0);
        {
            constexpr size_t TOT4 = (size_t)M * DM / 4;
            for (size_t i = gtid; i < TOT4; i += (size_t)NT * 8) {
                f32x4 v[8];
#pragma unroll
                for (int u = 0; u < 8; ++u) v[u] = *(const f32x4*)(x + (i + (size_t)u * NT) * 4);
#pragma unroll
                for (int u = 0; u < 8; ++u) { uint2 w; w.x = cvtpk(v[u][0], v[u][1]); w.y = cvtpk(v[u][2], v[u][3]); *(uint2*)(XB + (i + (size_t)u * NT) * 4) = w; }
            }
        }
    }
    }
    GRID_BAR();
    {
        PHASE_IDS();
    GEMM_PHASE(EpiBf16S, XB, DM, W0in, 1024, L0P, 1024, PROJ0, nullptr, L0P, 0);
    }
    GRID_BAR();
    {
        PHASE_IDS();
        const int blk = (int)blockIdx.x, m0 = blk * 128;
        {   LAS bf16_t* scr = (LAS bf16_t*)(lds3 + wave * 16384);
#pragma unroll 1
            for (int k = 0; k < 4; ++k) ssd_conv_tile((2 * blk + (k & 1)) * 16 + wave + 8 * (k >> 1), lane, scr, PROJ0, IN(14), IN(15), XB, XST, BT);
            for (int i = tid; i < 1024; i += NWAVES * 64) { const int m = m0 + (i >> 3); DT[(size_t)m * 8 + (i & 7)] = softplusf_(bf2f(PROJ0[(size_t)m * L0P + 3328 + (i & 7)]) + IN(16)[i & 7]); }
        }
        __syncthreads();
#if defined(PROBE_STAMPS)
        if (blockIdx.x == 0 && threadIdx.x == 0) MISC[16 + 29] = (unsigned)__builtin_amdgcn_s_memrealtime();
#endif
        ssd_s1_unit(blk * 8 + wave, lane, (LAS float*)(lds3 + wave * 16384), XST, BT, DT, IN(17), SLOC, ASUM);
    }
    GRID_BAR();
    {
        PHASE_IDS();
        ssd_s2_all(SLOC, ASUM, STB, gtid, NT);
    }
    GRID_BAR();
    {
        PHASE_IDS();
        const int blk = (int)blockIdx.x;
        if (blk < 128) {
            rwkv_phase_chain((LAS float*)lds3, tid, lane, wave, blk, PROJ0, IN(3), IN(4), IN(6), IN(9), IN(10), IN(11), W2T, A2T, G2T, YRAW, GB, BONUS);
#if defined(PROBE_STAMPS)
            if (blk == 0 && threadIdx.x == 0) MISC[16 + 23] = (unsigned)__builtin_amdgcn_s_memrealtime();
#endif
        } else {
            const int bc0 = (blk - 128) * 2;
#if defined(PROBE_STAMPS)
            const unsigned tu0_ = (unsigned)__builtin_amdgcn_s_memrealtime();
#endif
            {
                const int gwu = (blk - 128) * NWAVES + wave;
                gate_lora_wave(gwu, 128 * NWAVES, lane, PROJ0, IN(3), G2T, GB);
            }
#if defined(PROBE_STAMPS)
            __syncthreads(); if (blk == 128 && threadIdx.x == 0) __hip_atomic_store(ctl + 2049, (unsigned)__builtin_amdgcn_s_memrealtime() - tu0_, __ATOMIC_RELAXED, __HIP_MEMORY_SCOPE_AGENT);
#endif
#pragma unroll 1
            for (int u = 0; u < 2; ++u) ssd_s3_block(bc0 + u, tid, lane, wave, lds3, XB, XST, STB, DT, IN(17), IN(18), YSSM);
            __syncthreads();
#if defined(PROBE_STAMPS)
            __syncthreads(); if (blk == 128 && threadIdx.x == 0) __hip_atomic_store(ctl + 2050, (unsigned)__builtin_amdgcn_s_memrealtime() - tu0_, __ATOMIC_RELAXED, __HIP_MEMORY_SCOPE_AGENT);
#endif
            ssm_gate_norm_vec(YSSM, PROJ0, IN(19), YMIX, bc0 * 128, bc0 * 128 + 256, wave, NWAVES, lane);
#if defined(PROBE_STAMPS)
            __syncthreads(); if (blk == 128 && threadIdx.x == 0) __hip_atomic_store(ctl + 2051, (unsigned)__builtin_amdgcn_s_memrealtime() - tu0_, __ATOMIC_RELAXED, __HIP_MEMORY_SCOPE_AGENT);
#endif
            { const int gwu = (blk - 128) * NWAVES + wave, NGWU = 128 * NWAVES; LAS float* scr = (LAS float*)(lds3 + wave * 16384); int trb = 0;
              transpose_matrix(IN(23), 1024, 5632, Wup0, 5632, 1024, scr, gwu, NGWU, lane, nullptr, trb, true);
              transpose_matrix(IN(26), 2816, 1024, Wdn0, 1024, 2816, scr, gwu, NGWU, lane, nullptr, trb);
            }
#if defined(PROBE_STAMPS)
            __syncthreads(); if (blk == 128 && threadIdx.x == 0) __hip_atomic_store(ctl + 2048, (unsigned)__builtin_amdgcn_s_memrealtime() - tu0_, __ATOMIC_RELAXED, __HIP_MEMORY_SCOPE_AGENT);
#endif
        }
    }
    GRID_BAR();
    {
        PHASE_IDS();
        rwkv_post_vec(YRAW, PROJ0, IN(3), BONUS, GB, IN(12), IN(13), YMIX, gw, NGW, lane);
    }
    GRID_BAR();
    {
        PHASE_IDS();
    GEMM_PHASE(EpiResid, YMIX, DM, W0out, 1024, 1024, 1024, IN(0), ZB, ALPHA, 0);
    }
    GRID_BAR();
    {
        PHASE_IDS();
        if ((int)blockIdx.x >= 88) {
            ln_rows_range<1, 2>(ZB, XB, nullptr, STATS, IN(21), IN(22), ((int)blockIdx.x - 88) * NWAVES + wave, (M / 64) * 31, (G - 88) * NWAVES, lane);
        } else {
            const int pm_ = (int)blockIdx.x / 11;
            ln_rows_range<1, 1>(ZB, XB, nullptr, STATS, IN(21), IN(22), 64 * pm_ + wave, 64 * pm_ + 64, NWAVES, lane);
            asm volatile("s_waitcnt vmcnt(0)" ::: "memory");
            __syncthreads();
            if (threadIdx.x == 0) { __builtin_amdgcn_fence(__ATOMIC_ACQUIRE, "agent"); asm volatile("s_waitcnt vmcnt(0)" ::: "memory"); }
            __syncthreads();
            halo_gemm_unit((int)blockIdx.x, tid, lane, wave, lds3, XB, Wup0, HALO);
        }
        {
            const int gwu = gw, NGWU = NGW; LAS float* scr = (LAS float*)(lds3 + wave * 16384); int trb = 0;
            transpose_matrix(IN(29), 1024, 1952, W1in, L1P, 1024, scr, gwu, NGWU, lane, nullptr, trb);
            transpose_matrix(IN(31), 256, 768, Wuq, 768, 256, scr, gwu, NGWU, lane, IN(30), trb);
            transpose_matrix(IN(33), 128, 1024, Wukv, 1024, 256, scr, gwu, NGWU, lane, IN(32), trb);
            transpose_matrix(IN(34), 1024, 1024, W1out, 1024, 1024, scr, gwu, NGWU, lane, nullptr, trb);
            transpose_matrix(IN(37), 1024, 5632, Wup1, 5632, 1024, scr, gwu, NGWU, lane, nullptr, trb, true);
            transpose_matrix(IN(40), 2816, 1024, Wdn1, 1024, 2816, scr, gwu, NGWU, lane, nullptr, trb);
            for (int i = gwu * 64 + lane; i < 1024 * 16; i += NGWU * 64) { const int n = i >> 4, c = i & 15; *(v4u*)(Wukv + (size_t)n * 256 + 128 + c * 8) = (v4u){0u, 0u, 0u, 0u}; }
        }
    }
    GRID_BAR();
    {
        PHASE_IDS();
        { pg8::Gemm g_{XB, Wup0, M, 2 * DFF, 1024, DM, 1024, 128, 256, 128, 256, 0, 1}; pg8::StaticOrder S_; S_.init(M, 2 * DFF, G, (int)blockIdx.x);
          pg8::EpiConvAct E_{ACT, HALO, IN(24), IN(25), DFF, SEQ}; pg8::gemm_phase<pg8::EpiConvAct, pg8::StaticOrder, true, true>(lds3, g_, S_, E_); }
    }
    GRID_BAR();
    {
        PHASE_IDS();
    GEMM_PHASE(EpiResidLN, ACT, DFF, Wdn0, DFF, 1024, DFF, ZB, ZB, STATS, IN(21), IN(22), ALPHA, 0);
    }
    GRID_BAR();
    {
        PHASE_IDS();
    ln_rows<1>(ZB, XB, nullptr, STATS, IN(27), IN(28), gw, NGW, lane);
    }
    GRID_BAR();
    {
        PHASE_IDS();
    GEMM_PHASE(EpiBf16S, XB, DM, W1in, 1024, L1P, 1024, PROJ1, nullptr, L1P, 0);
    }
    GRID_BAR();
    {
        PHASE_IDS();
    mla_prep_all(PROJ1, pos, RS, KPE, CSTAB, gw, NGW, lane);
    {
        LAS bf16_t* scr = (LAS bf16_t*)(lds3 + wave * 16384);
        for (int r = gw; r < 4096; r += NGW) { const int bh = r >> 5, tt = r & 31, b = bh >> 3, h = bh & 7;
            transpose_tile64(PROJ1 + ((size_t)b * SEQ + tt * 64) * L1P + 1024 + h * 64, L1P, VTS + (size_t)bh * 64 * SEQ + tt * 64, SEQ, scr, lane); }
    }
    }
    GRID_BAR();
    {
        PHASE_IDS();
    GEMM_PHASE(EpiBf16S, PROJ1 + 1536, L1P, Wuq, 256, 768, 256, QM, RS, 768, 2);
    GEMM_PHASE(EpiBf16S, PROJ1 + 1792, L1P, Wukv, 256, 1024, 256, KVM, RS + 1, 1024, 2);
    }
    GRID_BAR();
    {
        PHASE_IDS();
    {
        LAS bf16_t* scr = (LAS bf16_t*)(lds3 + wave * 16384);
        for (int r = gw; r < 4096; r += NGW) { const int bh = r >> 5, tt = r & 31, b = bh >> 3, h = bh & 7;
            transpose_tile64(KVM + ((size_t)b * SEQ + tt * 64) * 1024 + h * 128 + 64, 1024, VTM + (size_t)bh * 64 * SEQ + tt * 64, SEQ, scr, lane); }
    }
    }
    GRID_BAR();
    {
        PHASE_IDS();
    {
        { LAS unsigned char* wl = lds3 + wave * 16384;
          for (int g2 = gw; g2 < 2048; g2 += NGW) { const int bh = g2 >> 4, w = g2 & 15;
#pragma unroll 1
              for (int i = 0; i < 4; ++i) { const int qb = (i == 0) ? w : (i == 1) ? 31 - w : (i == 2) ? 32 + w : 63 - w; sb_wave(bh, qb, lane, PROJ1, VTS, YMIX, wl); } } }
        __syncthreads();
        for (int g2 = (int)blockIdx.x; g2 < 256; g2 += G) { const int bh = g2 >> 1, part = g2 & 1;
#pragma unroll 1
            for (int i = 0; i < 4; ++i) { const int sbk = part ? ((i == 0) ? 1 : (i == 1) ? 6 : (i == 2) ? 2 : 5) : ((i == 0) ? 0 : (i == 1) ? 7 : (i == 2) ? 3 : 4);
                mla_block(bh, sbk, tid, lane, wave, lds3, QM, KVM, KPE, VTM, YMIX, CSTAB); } }
    }
    }
    GRID_BAR();
    {
        PHASE_IDS();
    GEMM_PHASE(EpiResidLN, YMIX, DM, W1out, 1024, 1024, 1024, ZB, ZB, STATS, IN(27), IN(28), ALPHA, 0);
    }
    GRID_BAR();
    {
        PHASE_IDS();
        if ((int)blockIdx.x >= 88) {
            ln_rows_range<1, 2>(ZB, XB, nullptr, STATS, IN(35), IN(36), ((int)blockIdx.x - 88) * NWAVES + wave, (M / 64) * 31, (G - 88) * NWAVES, lane);
        } else {
            const int pm_ = (int)blockIdx.x / 11;
            ln_rows_range<1, 1>(ZB, XB, nullptr, STATS, IN(35), IN(36), 64 * pm_ + wave, 64 * pm_ + 64, NWAVES, lane);
            asm volatile("s_waitcnt vmcnt(0)" ::: "memory");
            __syncthreads();
            if (threadIdx.x == 0) { __builtin_amdgcn_fence(__ATOMIC_ACQUIRE, "agent"); asm volatile("s_waitcnt vmcnt(0)" ::: "memory"); }
            __syncthreads();
            halo_gemm_unit((int)blockIdx.x, tid, lane, wave, lds3, XB, Wup1, HALO);
        }
    }
    GRID_BAR();
    {
        PHASE_IDS();
        { pg8::Gemm g_{XB, Wup1, M, 2 * DFF, 1024, DM, 1024, 128, 256, 128, 256, 0, 1}; pg8::StaticOrder S_; S_.init(M, 2 * DFF, G, (int)blockIdx.x);
          pg8::EpiConvAct E_{ACT, HALO, IN(38), IN(39), DFF, SEQ}; pg8::gemm_phase<pg8::EpiConvAct, pg8::StaticOrder, true, true>(lds3, g_, S_, E_); }
    }
    GRID_BAR();
    {
        PHASE_IDS();
    GEMM_PHASE(EpiResidLN, ACT, DFF, Wdn1, DFF, 1024, DFF, ZB, XB, STATS, IN(35), IN(36), ALPHA, 0);
    }
    GRID_BAR();
    {
        PHASE_IDS();
    ln_rows<2>(XB, nullptr, out, STATS, IN(41), IN(42), gw, NGW, lane);
    #if defined(PROBE_STAMPS)
    __syncthreads();
    if (blockIdx.x == 0 && threadIdx.x == 0) {
        MISC[16 + 22] = (unsigned)__builtin_amdgcn_s_memrealtime();
#if defined(PROBE_GLOBAL)
#ifndef PROBE_GIDX
#define PROBE_GIDX 0
#endif
        const unsigned d1 = __hip_atomic_load(ctl + 2048 + PROBE_GIDX, __ATOMIC_RELAXED, __HIP_MEMORY_SCOPE_AGENT);
#elif defined(PROBE_ACC)
        const unsigned d1 = MISC[16 + PROBE_ACC];
#else
        const unsigned d1 = MISC[16 + PROBE_T1_HI] - MISC[16 + PROBE_T1_LO];
#endif
        const unsigned long long spin = 100ull * d1;
        const unsigned long long t0 = __builtin_amdgcn_s_memrealtime();
        while (__builtin_amdgcn_s_memrealtime() - t0 < spin) __builtin_amdgcn_s_sleep(8);
    }
#endif
}
}

extern "C" void kernel_launch(void* const* d_in, const int* in_sizes, int n_in, void* d_out, int out_size, void* d_ws, size_t ws_size, hipStream_t stream) {
    static int grid = 0;
    if (grid == 0) {
        if (n_in != 43 || ws_size < WS_NEED || out_size != M * DM) { fprintf(stderr, "kernel_launch: unexpected n_in %d / ws %zu / out %d\n", n_in, ws_size, out_size); grid = -1; return; }
        int dev = 0, cus = 0, per_cu = 0;
        if (hipGetDevice(&dev) != hipSuccess || hipDeviceGetAttribute(&cus, hipDeviceAttributeMultiprocessorCount, dev) != hipSuccess) { grid = -1; return; }
        if (hipFuncSetAttribute((const void*)fwd_mega, hipFuncAttributeMaxDynamicSharedMemorySize, LDS_BYTES) != hipSuccess) { fprintf(stderr, "kernel_launch: hipFuncSetAttribute failed\n"); grid = -1; return; }
        if (hipOccupancyMaxActiveBlocksPerMultiprocessor(&per_cu, (const void*)fwd_mega, NWAVES * 64, LDS_BYTES) != hipSuccess || per_cu < 1) fprintf(stderr, "kernel_launch: occupancy query reports %d\n", per_cu);
        (void)hipGetLastError();
        grid = cus;
    }
    if (grid < 0) return;
    (void)hipMemsetAsync((char*)d_ws + WS_CTL, 0, CTL_ZERO_BYTES, stream);
    Args a{};
    for (int i = 0; i < 43; ++i) a.in[i] = (const float*)d_in[i];
    a.out = (float*)d_out; a.ws = (unsigned char*)d_ws;
    hipLaunchKernelGGL(fwd_mega, dim3(grid), dim3(NWAVES * 64), LDS_BYTES, stream, a);
}
```
